# Optimizing an MI355X kernel written in HIP

```python
import math
import jax
import jax.numpy as jnp
from jax import lax
import numpy as np

D_MODEL = 1024
BATCH = 4
SEQ = 8192
DEPTH = 4

GRID_W = 64
CTX_LEN = 256
N_MOD = 6
EPS = 1e-6
SSD_HEADS = 16
SSD_HEAD_DIM = 64
SSD_INNER = SSD_HEADS * SSD_HEAD_DIM
SSD_GROUPS = 2
SSD_STATE = 128
SSD_BC = SSD_GROUPS * SSD_STATE
SSD_CONV = 5
SSD_CONV_DIM = SSD_INNER + 2 * SSD_BC
SSD_CHUNK = 128
MLA_HEADS = 8
MLA_Q_RANK = 384
MLA_KV_RANK = 256
MLA_NOPE = 128
MLA_ROPE = 64
MLA_V = 128
MLA_SCALE = (MLA_NOPE + MLA_ROPE) ** -0.5
ATTN_BLOCK = 128
ROPE_BASE = 10000.0
HYB_SPLITS = (SSD_INNER, SSD_CONV_DIM, SSD_HEADS, MLA_Q_RANK, MLA_KV_RANK, MLA_ROPE)
HYB_IN = SSD_INNER + SSD_CONV_DIM + SSD_HEADS + MLA_Q_RANK + MLA_KV_RANK + MLA_ROPE
HYB_CAT = SSD_INNER + MLA_HEADS * MLA_V
GM_CHUNK = 128
GM_INNER = 2 * D_MODEL
GM_GROUPS = 8
PEER_HEADS = 8
PEER_NKEYS = 128
PEER_EXPERTS = PEER_NKEYS * PEER_NKEYS
PEER_DKEY = 256
PEER_TOPK = 16
PEER_BLOCK = 128

kernel_name = 'hybrid_ssd_mla_gmlp_peer_dit'


def _rmsnorm(x, g):
    xf = x.astype(jnp.float32)
    y = xf * lax.rsqrt(jnp.mean(xf * xf, axis=-1, keepdims=True) + EPS)
    return y.astype(x.dtype) * g


def _layernorm(x, g, b):
    xf = x.astype(jnp.float32)
    mu = jnp.mean(xf, axis=-1, keepdims=True)
    var = jnp.mean(jnp.square(xf - mu), axis=-1, keepdims=True)
    return ((xf - mu) * lax.rsqrt(var + EPS)).astype(x.dtype) * g + b


def _modulate(h, shift, scale):
    return h * (1 + scale) + shift


def _split_cols(p, sizes):
    out, start = [], 0
    for s in sizes:
        out.append(p[..., start:start + s])
        start += s
    return out


def _axial_rope(n_lat):
    rows = n_lat // GRID_W
    row = jnp.broadcast_to(jnp.arange(rows, dtype=jnp.float32)[:, None], (rows, GRID_W)).reshape(-1)
    col = jnp.broadcast_to(jnp.arange(GRID_W, dtype=jnp.float32)[None, :], (rows, GRID_W)).reshape(-1)
    n_freq = MLA_ROPE // 4
    inv = ROPE_BASE ** (-jnp.arange(n_freq, dtype=jnp.float32) / n_freq)
    ang = jnp.concatenate([row[:, None] * inv, col[:, None] * inv], axis=-1)
    return jnp.cos(ang), jnp.sin(ang)


def _apply_rope(x, cos, sin):
    half = x.shape[-1] // 2
    x1, x2 = x[..., :half], x[..., half:]
    cos = cos.astype(x.dtype)
    sin = sin.astype(x.dtype)
    return jnp.concatenate([x1 * cos - x2 * sin, x1 * sin + x2 * cos], axis=-1)


def _dwconv_centred(x, w, b):
    k = w.shape[-1]
    kern = jnp.transpose(w)[:, None, :].astype(x.dtype)
    y = lax.conv_general_dilated(x, kern, window_strides=(1,), padding=[(k // 2, k // 2)],
                                 dimension_numbers=('NWC', 'WIO', 'NWC'),
                                 feature_group_count=x.shape[-1])
    return y + b


def _ssd_scan(xs, dt, a, bm, cm, h0):
    b, l = xs.shape[:2]
    nc, q = l // SSD_CHUNK, SSD_CHUNK
    g, e = SSD_GROUPS, SSD_HEADS // SSD_GROUPS
    dt = dt.astype(jnp.float32)
    da = (dt * a).reshape(b, nc, q, g, e)
    xd = (xs * dt[..., None]).reshape(b, nc, q, g, e, SSD_HEAD_DIM)
    bm = bm.reshape(b, nc, q, g, SSD_STATE)
    cm = cm.reshape(b, nc, q, g, SSD_STATE)
    cum = jnp.cumsum(da, axis=2)
    scan_order = jnp.tril(jnp.ones((q, q), bool))[None, None, :, :, None, None]
    seg = cum[:, :, :, None] - cum[:, :, None, :]
    decay_in = jnp.exp(jnp.where(scan_order, seg, -jnp.inf))
    cb = jnp.einsum('bctgn,bcsgn->bctsg', cm, bm)
    y_diag = jnp.einsum('bctsge,bcsgep->bctgep', cb[..., None] * decay_in, xd)
    to_end = jnp.exp(cum[:, :, -1:] - cum)
    states = jnp.einsum('bcsgn,bcsgep->bcgepn', bm, xd * to_end[..., None])
    chunk_decay = jnp.exp(cum[:, :, -1])

    def step(h, inp):
        st, dec = inp
        return h * dec[..., None, None] + st, h

    h_fin, h_in = lax.scan(step, h0, (jnp.moveaxis(states, 1, 0), jnp.moveaxis(chunk_decay, 1, 0)))
    h_in = jnp.moveaxis(h_in, 0, 1)
    y_off = jnp.einsum('bctgn,bcgepn->bctgep', cm, h_in) * jnp.exp(cum)[..., None]
    return (y_diag + y_off).reshape(b, l, SSD_HEADS, SSD_HEAD_DIM), h_fin


def _ssd_inputs(xbc_raw, conv_w, conv_b):
    xbc = jax.nn.silu(_dwconv_centred(xbc_raw, conv_w, conv_b))
    b, l, _ = xbc.shape
    xs = xbc[..., :SSD_INNER].reshape(b, l, SSD_HEADS, SSD_HEAD_DIM)
    bm = xbc[..., SSD_INNER:SSD_INNER + SSD_BC].reshape(b, l, SSD_GROUPS, SSD_STATE)
    cm = xbc[..., SSD_INNER + SSD_BC:].reshape(b, l, SSD_GROUPS, SSD_STATE)
    return xs, bm, cm


def _ssd_bidir(ctx_in, lat_in, a_log, dt_bias):
    b = lat_in[0].shape[0]
    ys_c, ys_l = [], []
    for d in range(2):
        a = -jnp.exp(a_log[d].astype(jnp.float32))
        c_in, l_in = ctx_in, lat_in
        if d == 1:
            c_in = tuple(t[:, ::-1] for t in ctx_in)
            l_in = tuple(t[:, ::-1] for t in lat_in)
        h0 = jnp.zeros((b, SSD_GROUPS, SSD_HEADS // SSD_GROUPS, SSD_HEAD_DIM, SSD_STATE), jnp.float32)
        yc, hc = _ssd_scan(c_in[0], jax.nn.softplus(c_in[3] + dt_bias[d]), a, c_in[1], c_in[2], h0)
        yl, _ = _ssd_scan(l_in[0], jax.nn.softplus(l_in[3] + dt_bias[d]), a, l_in[1], l_in[2], hc)
        if d == 1:
            yc, yl = yc[:, ::-1], yl[:, ::-1]
        ys_c.append(yc)
        ys_l.append(yl)
    return ys_c[0] + ys_c[1], ys_l[0] + ys_l[1]


def _ssd_out(y, xs, z, d_skip, norm_g):
    b, l = z.shape[:2]
    y = (y + d_skip[:, None] * xs).reshape(b, l, SSD_INNER).astype(z.dtype) * jax.nn.silu(z)
    y = _rmsnorm(y.reshape(b, l, SSD_GROUPS, SSD_INNER // SSD_GROUPS), norm_g.reshape(SSD_GROUPS, -1))
    return y.reshape(b, l, SSD_INNER)


def _mla_project(cq, ckv, kr, q_norm_g, w_qb, kv_norm_g, w_kvb, rope):
    b, l, _ = cq.shape
    q = (_rmsnorm(cq, q_norm_g) @ w_qb).reshape(b, l, MLA_HEADS, MLA_NOPE + MLA_ROPE)
    kv = (_rmsnorm(ckv, kv_norm_g) @ w_kvb).reshape(b, l, MLA_HEADS, MLA_NOPE + MLA_V)
    q_nope, q_rope = q[..., :MLA_NOPE], q[..., MLA_NOPE:]
    k_nope, v = kv[..., :MLA_NOPE], kv[..., MLA_NOPE:]
    if rope is not None:
        cos, sin = rope
        q_rope = _apply_rope(q_rope, cos[:, None, :], sin[:, None, :])
        kr = _apply_rope(kr, cos, sin)
    return q_nope, q_rope, k_nope, kr, v


def _attend(qn, qr, kn, kr, v):
    s = jnp.einsum('bqhd,bkhd->bhqk', qn, kn) + jnp.einsum('bqhr,bkr->bhqk', qr, kr)
    p = jax.nn.softmax(s.astype(jnp.float32) * MLA_SCALE, axis=-1).astype(v.dtype)
    return jnp.einsum('bhqk,bkhd->bqhd', p, v)


def _latent_attention(qn, qr, kn, kr, v):
    b, l = qn.shape[:2]
    nb = l // ATTN_BLOCK
    blocks = lambda t: jnp.moveaxis(t.reshape(b, nb, ATTN_BLOCK, *t.shape[2:]), 1, 0)
    out = lax.map(lambda qs: _attend(qs[0], qs[1], kn, kr, v), (blocks(qn), blocks(qr)))
    return jnp.moveaxis(out, 0, 1).reshape(b, l, MLA_HEADS * MLA_V)


def _hybrid_mix(h_c, h_l, rope, w_in, conv_w, conv_b, a_log, dt_bias, d_skip, ssd_norm_g,
                q_norm_g, w_qb, kv_norm_g, w_kvb, w_out, ctx_out):
    z_c, xbc_c, dt_c, cq_c, ckv_c, kr_c = _split_cols(h_c @ w_in, HYB_SPLITS)
    z_l, xbc_l, dt_l, cq_l, ckv_l, kr_l = _split_cols(h_l @ w_in, HYB_SPLITS)
    xs_c, b_c, c_c = _ssd_inputs(xbc_c, conv_w, conv_b)
    xs_l, b_l, c_l = _ssd_inputs(xbc_l, conv_w, conv_b)
    ys_c, ys_l = _ssd_bidir((xs_c, b_c, c_c, dt_c), (xs_l, b_l, c_l, dt_l), a_log, dt_bias)
    qn_c, qr_c, kn_c, krc, v_c = _mla_project(cq_c, ckv_c, kr_c, q_norm_g, w_qb, kv_norm_g, w_kvb, None)
    qn_l, qr_l, kn_l, krl, v_l = _mla_project(cq_l, ckv_l, kr_l, q_norm_g, w_qb, kv_norm_g, w_kvb, rope)
    att_l = _latent_attention(qn_l, qr_l, jnp.concatenate([kn_c, kn_l], axis=1),
                              jnp.concatenate([krc, krl], axis=1), jnp.concatenate([v_c, v_l], axis=1))
    y_l = jnp.concatenate([_ssd_out(ys_l, xs_l, z_l, d_skip, ssd_norm_g), att_l], axis=-1) @ w_out
    if not ctx_out:
        return None, y_l
    b, lc = h_c.shape[:2]
    att_c = _attend(qn_c, qr_c, kn_c, krc, v_c).reshape(b, lc, MLA_HEADS * MLA_V)
    y_c = jnp.concatenate([_ssd_out(ys_c, xs_c, z_c, d_skip, ssd_norm_g), att_c], axis=-1) @ w_out
    return y_c, y_l


def _chunk_gmlp(h, w_in, ln_g, ln_b, ws, bs, w_out):
    b, l, _ = h.shape
    u, v = jnp.split(jax.nn.gelu(h @ w_in, approximate=False), 2, axis=-1)
    v = _layernorm(v, ln_g, ln_b).reshape(b, l // GM_CHUNK, GM_CHUNK, GM_GROUPS, GM_INNER // GM_GROUPS)
    sv = jnp.einsum('gts,bcsgd->bctgd', ws, v) + jnp.transpose(bs)[:, :, None]
    return (u * sv.reshape(b, l, GM_INNER)) @ w_out


def _peer(h, wq, k1, k2, u_tab, v_tab):
    b, l, d = h.shape
    n_tok = b * l
    t = h.reshape(n_tok, d)
    half = PEER_DKEY // 2
    q = (t @ wq).reshape(n_tok, PEER_HEADS, PEER_DKEY)
    s1 = jnp.einsum('thd,hkd->thk', q[..., :half], k1)
    s2 = jnp.einsum('thd,hkd->thk', q[..., half:], k2)
    v1, i1 = lax.top_k(s1, PEER_TOPK)
    v2, i2 = lax.top_k(s2, PEER_TOPK)
    cand_s = (v1[..., :, None] + v2[..., None, :]).reshape(n_tok, PEER_HEADS, PEER_TOPK * PEER_TOPK)
    cand_i = (i1[..., :, None] * PEER_NKEYS + i2[..., None, :]).reshape(n_tok, PEER_HEADS, PEER_TOPK * PEER_TOPK)
    top_s, j = lax.top_k(cand_s, PEER_TOPK)
    idx = jnp.take_along_axis(cand_i, j, axis=-1)
    gate = jax.nn.softmax(top_s.astype(jnp.float32), axis=-1).astype(h.dtype)
    nb = n_tok // PEER_BLOCK

    def expert_block(args):
        tb, ib, gb = args
        act = jax.nn.gelu(jnp.einsum('phkd,pd->phk', jnp.take(u_tab, ib, axis=0), tb), approximate=False)
        return jnp.einsum('phk,phkd->pd', gb * act, jnp.take(v_tab, ib, axis=0))

    out = lax.map(expert_block, (t.reshape(nb, PEER_BLOCK, d),
                                 idx.reshape(nb, PEER_BLOCK, PEER_HEADS, PEER_TOPK),
                                 gate.reshape(nb, PEER_BLOCK, PEER_HEADS, PEER_TOPK)))
    return out.reshape(b, l, d)


def setup_inputs(seed: int = 0) -> dict:
    key = jax.random.key(seed)
    ks = iter(jax.random.split(key, 40))
    nrm = lambda shape, std: std * jax.random.normal(next(ks), shape, jnp.float32)
    ne, no = (DEPTH + 1) // 2, DEPTH // 2
    D = D_MODEL
    x = nrm((BATCH, SEQ, D), 1.0)
    c = nrm((BATCH, D), 1.0)
    ctx = nrm((BATCH, CTX_LEN, D), 1.0)
    c_ctx = nrm((D,), 1.0)
    ada_w = nrm((DEPTH, D, N_MOD * D), 0.02)
    ada_b = nrm((DEPTH, N_MOD * D), 0.02)
    norm1_g = 1.0 + nrm((DEPTH, D), 0.02)
    norm2_g = 1.0 + nrm((DEPTH, D), 0.02)
    hyb_w_in = nrm((ne, D, HYB_IN), D ** -0.5)
    ssd_conv_w = nrm((ne, SSD_CONV_DIM, SSD_CONV), SSD_CONV ** -0.5)
    ssd_conv_b = nrm((ne, SSD_CONV_DIM), 0.02)
    ssd_a_log = jnp.log(jax.random.uniform(next(ks), (ne, 2, SSD_HEADS), jnp.float32, 1.0, 16.0))
    dt0 = jnp.exp(jax.random.uniform(next(ks), (ne, 2, SSD_HEADS), jnp.float32, math.log(1e-3), math.log(1e-1)))
    ssd_dt_bias = dt0 + jnp.log(-jnp.expm1(-dt0))
    ssd_d = 1.0 + nrm((ne, SSD_HEADS), 0.02)
    ssd_norm_g = 1.0 + nrm((ne, SSD_INNER), 0.02)
    mla_q_norm_g = 1.0 + nrm((ne, MLA_Q_RANK), 0.02)
    mla_w_qb = nrm((ne, MLA_Q_RANK, MLA_HEADS * (MLA_NOPE + MLA_ROPE)), MLA_Q_RANK ** -0.5)
    mla_kv_norm_g = 1.0 + nrm((ne, MLA_KV_RANK), 0.02)
    mla_w_kvb = nrm((ne, MLA_KV_RANK, MLA_HEADS * (MLA_NOPE + MLA_V)), MLA_KV_RANK ** -0.5)
    hyb_w_out = nrm((ne, HYB_CAT, D), HYB_CAT ** -0.5)
    gm_w_in = nrm((no, D, 2 * GM_INNER), D ** -0.5)
    gm_ln_g = 1.0 + nrm((no, GM_INNER), 0.02)
    gm_ln_b = nrm((no, GM_INNER), 0.02)
    gm_ws = nrm((no, GM_GROUPS, GM_CHUNK, GM_CHUNK), GM_CHUNK ** -0.5)
    gm_bs = 1.0 + nrm((no, GM_GROUPS, GM_CHUNK), 0.02)
    gm_w_out = nrm((no, GM_INNER, D), GM_INNER ** -0.5)
    peer_wq = nrm((DEPTH, D, PEER_HEADS * PEER_DKEY), D ** -0.5)
    peer_k1 = nrm((DEPTH, PEER_HEADS, PEER_NKEYS, PEER_DKEY // 2), (PEER_DKEY // 2) ** -0.5)
    peer_k2 = nrm((DEPTH, PEER_HEADS, PEER_NKEYS, PEER_DKEY // 2), (PEER_DKEY // 2) ** -0.5)
    peer_u = nrm((DEPTH, PEER_EXPERTS, D), D ** -0.5)
    peer_v = nrm((DEPTH, PEER_EXPERTS, D), PEER_HEADS ** -0.5)
    final_norm_g = 1.0 + nrm((D,), 0.02)
    return {'x': x, 'c': c, 'ctx': ctx, 'c_ctx': c_ctx, 'ada_w': ada_w, 'ada_b': ada_b,
            'norm1_g': norm1_g, 'norm2_g': norm2_g, 'hyb_w_in': hyb_w_in, 'ssd_conv_w': ssd_conv_w,
            'ssd_conv_b': ssd_conv_b, 'ssd_a_log': ssd_a_log, 'ssd_dt_bias': ssd_dt_bias, 'ssd_d': ssd_d,
            'ssd_norm_g': ssd_norm_g, 'mla_q_norm_g': mla_q_norm_g, 'mla_w_qb': mla_w_qb,
            'mla_kv_norm_g': mla_kv_norm_g, 'mla_w_kvb': mla_w_kvb, 'hyb_w_out': hyb_w_out,
            'gm_w_in': gm_w_in, 'gm_ln_g': gm_ln_g, 'gm_ln_b': gm_ln_b, 'gm_ws': gm_ws, 'gm_bs': gm_bs,
            'gm_w_out': gm_w_out, 'peer_wq': peer_wq, 'peer_k1': peer_k1, 'peer_k2': peer_k2,
            'peer_u': peer_u, 'peer_v': peer_v, 'final_norm_g': final_norm_g}


def reference(x, c, ctx, c_ctx, ada_w, ada_b, norm1_g, norm2_g, hyb_w_in, ssd_conv_w, ssd_conv_b,
              ssd_a_log, ssd_dt_bias, ssd_d, ssd_norm_g, mla_q_norm_g, mla_w_qb, mla_kv_norm_g, mla_w_kvb,
              hyb_w_out, gm_w_in, gm_ln_g, gm_ln_b, gm_ws, gm_bs, gm_w_out, peer_wq, peer_k1, peer_k2,
              peer_u, peer_v, final_norm_g):
    rope = _axial_rope(x.shape[1])
    cond_lat = jax.nn.silu(c)
    cond_ctx = jax.nn.silu(c_ctx)
    xc = ctx
    for layer in range(DEPTH):
        i = layer // 2
        even = layer % 2 == 0
        keep_ctx = any(j % 2 == 0 for j in range(layer + 1, DEPTH))
        need_ctx = even or keep_ctx
        sh1, sc1, g1, sh2, sc2, g2 = jnp.split((cond_lat @ ada_w[layer] + ada_b[layer])[:, None, :], N_MOD, axis=-1)
        h_l = _modulate(_rmsnorm(x, norm1_g[layer]), sh1, sc1)
        if need_ctx:
            csh1, csc1, cg1, csh2, csc2, cg2 = jnp.split(cond_ctx @ ada_w[layer] + ada_b[layer], N_MOD, axis=-1)
            h_c = _modulate(_rmsnorm(xc, norm1_g[layer]), csh1, csc1)
        if even:
            y_c, y_l = _hybrid_mix(h_c, h_l, rope, hyb_w_in[i], ssd_conv_w[i], ssd_conv_b[i], ssd_a_log[i],
                                   ssd_dt_bias[i], ssd_d[i], ssd_norm_g[i], mla_q_norm_g[i], mla_w_qb[i],
                                   mla_kv_norm_g[i], mla_w_kvb[i], hyb_w_out[i], keep_ctx)
        else:
            y_l = _chunk_gmlp(h_l, gm_w_in[i], gm_ln_g[i], gm_ln_b[i], gm_ws[i], gm_bs[i], gm_w_out[i])
            y_c = _chunk_gmlp(h_c, gm_w_in[i], gm_ln_g[i], gm_ln_b[i], gm_ws[i], gm_bs[i], gm_w_out[i]) if keep_ctx else None
        x = x + g1 * y_l
        x = x + g2 * _peer(_modulate(_rmsnorm(x, norm2_g[layer]), sh2, sc2),
                           peer_wq[layer], peer_k1[layer], peer_k2[layer], peer_u[layer], peer_v[layer])
        if keep_ctx:
            xc = xc + cg1 * y_c
            xc = xc + cg2 * _peer(_modulate(_rmsnorm(xc, norm2_g[layer]), csh2, csc2),
                                  peer_wq[layer], peer_k1[layer], peer_k2[layer], peer_u[layer], peer_v[layer])
    return _rmsnorm(x, final_norm_g)
```

```cpp
#include <hip/hip_runtime.h>
#include <cstdio>
#include <cstdint>

#define LAS __attribute__((address_space(3)))
typedef unsigned short bf16_t;
typedef short bf16x8 __attribute__((ext_vector_type(8)));
typedef short s16x4 __attribute__((ext_vector_type(4)));
typedef float f32x2 __attribute__((ext_vector_type(2)));
typedef float f32x4 __attribute__((ext_vector_type(4)));
typedef float f32x16 __attribute__((ext_vector_type(16)));
typedef unsigned u32x2 __attribute__((ext_vector_type(2)));
typedef unsigned u32x4 __attribute__((ext_vector_type(4)));

constexpr int D = 1024, NB = 4, SEQ = 8192, DEPTH = 4, CTXL = 256;
constexpr int NLAT = NB * SEQ, NCTX = NB * CTXL, NROW = NLAT + NCTX;
constexpr int HYB_IN = 3280, HYB_INP = 3328;
constexpr int C_Z = 0, C_XBC = 1024, C_DT = 2560, C_CQ = 2576, C_CKV = 2960, C_KR = 3216;
constexpr int NKEY = SEQ + CTXL, NKT = NKEY / 64;
constexpr float EPS = 1e-6f;
constexpr float QSCALE = 0.07216878364870322f * 1.4426950408889634f;
constexpr int NEXP = 16384;

enum { I_X = 0, I_C, I_CTX, I_CCTX, I_ADAW, I_ADAB, I_N1G, I_N2G, I_HWIN, I_CONVW, I_CONVB, I_ALOG, I_DTB, I_SSDD, I_SSDNG, I_QNG, I_WQB, I_KVNG, I_WKVB,
       I_HWOUT, I_GWIN, I_GLNG, I_GLNB, I_GWS, I_GBS, I_GWOUT, I_PWQ, I_PK1, I_PK2, I_PU, I_PV, I_FNG, N_IN };

constexpr size_t al256(size_t x) { return (x + 255) & ~(size_t)255; }
constexpr size_t WS_CTL = 0, CTL_BYTES = 65536;
constexpr size_t WS_MOD = WS_CTL + CTL_BYTES;
constexpr size_t WS_ROPE = WS_MOD + al256((size_t)DEPTH * 5 * 6144 * 4);
constexpr size_t WS_RSTD = WS_ROPE + (size_t)2 * SEQ * 32 * 4;
constexpr size_t WS_W = WS_RSTD + al256((size_t)2 * NROW * 4);
constexpr size_t W_HYB = 0;
constexpr size_t WH_IN = 0, WH_QB = WH_IN + (size_t)HYB_INP * 1024 * 2, WH_KVB = WH_QB + (size_t)1536 * 384 * 2, WH_OUT = WH_KVB + (size_t)2048 * 256 * 2,
                 WH_SZ = WH_OUT + (size_t)1024 * 2048 * 2;
constexpr size_t W_GM = W_HYB + 2 * WH_SZ;
constexpr size_t WG_IN = 0, WG_OUT = WG_IN + (size_t)4096 * 1024 * 2, WG_WS = WG_OUT + (size_t)1024 * 2048 * 2, WG_SZ = WG_WS + (size_t)8 * 128 * 128 * 2;
constexpr size_t W_PEER = W_GM + 2 * WG_SZ;
constexpr size_t WP_Q = 0, WP_K1 = WP_Q + (size_t)2048 * 1024 * 2, WP_K2 = WP_K1 + (size_t)8 * 128 * 128 * 2, WP_SZ = WP_K2 + (size_t)8 * 128 * 128 * 2;
constexpr size_t W_TOTAL = W_PEER + 4 * WP_SZ;
constexpr size_t WS_TAB = WS_W + al256(W_TOTAL);
constexpr size_t TAB_HALF = (size_t)NEXP * 1024 * 2;
constexpr size_t WS_XC = WS_TAB + 2 * TAB_HALF;
constexpr size_t WS_H = WS_XC + (size_t)NCTX * D * 4;
constexpr size_t WS_BIG = WS_H + (size_t)NROW * D * 2;
constexpr size_t BIG_BYTES = (size_t)NROW * 4096 * 2;
constexpr size_t BIG_DT = (size_t)NROW * HYB_INP * 2;
constexpr size_t BIG_G = BIG_DT + (size_t)NROW * 32 * 4;
constexpr size_t BIG_KR = BIG_G + (size_t)528 * 128 * 128 * 2;
constexpr size_t BIG_PART = (size_t)NROW * 2048 * 2;
static_assert(BIG_KR + (size_t)NB * NKT * 8192 <= BIG_BYTES, "BIG tail");
constexpr size_t WS_R1 = WS_BIG + BIG_BYTES;
constexpr size_t R1_Q = 0, R1_KN = R1_Q + (size_t)NB * 8 * NKEY * 192 * 2, R1_V = R1_KN + (size_t)NB * 8 * NKT * 16384, R1_BYTES = R1_V + (size_t)NB * 8 * NKT * 16384;
constexpr size_t WS_R2 = WS_R1 + R1_BYTES;
constexpr size_t R2_BC = (size_t)NROW * 1024 * 2, R2_BYTES = R2_BC + (size_t)NROW * 512 * 2;
constexpr size_t R2_GATE = (size_t)NROW * 128 * 4, R2_COEF = 2 * R2_GATE;
constexpr size_t WS_R3 = WS_R2 + R2_BYTES;
constexpr size_t R3_CAT = (size_t)NROW * 1024 * 2, R3_BYTES = R3_CAT + (size_t)NROW * 2048 * 2;
constexpr size_t WS_END = WS_R3 + R3_BYTES;
static_assert(WS_END <= ((size_t)1 << 30), "workspace must fit 1 GiB");

constexpr int CW_QUEUE = 4096;

typedef __bf16 bf16x2_t __attribute__((ext_vector_type(2)));
__device__ __forceinline__ unsigned cvt_pk_bf16(float lo, float hi) { const f32x2 v = {lo, hi}; const bf16x2_t b = __builtin_convertvector(v, bf16x2_t); return __builtin_bit_cast(unsigned, b); }
__device__ __forceinline__ bf16_t f2bf(float f) { return (bf16_t)(cvt_pk_bf16(f, 0.f) & 0xffffu); }
__device__ __forceinline__ float bf2f(unsigned b) { return __uint_as_float(b << 16); }
__device__ __forceinline__ float bflo(unsigned w) { return __uint_as_float(w << 16); }
__device__ __forceinline__ float bfhi(unsigned w) { return __uint_as_float(w & 0xffff0000u); }
__device__ __forceinline__ float wave_sum(float v) {
#pragma unroll
    for (int o = 32; o >= 1; o >>= 1) v += __shfl_xor(v, o);
    return v;
}
__device__ __forceinline__ int otid() { int t = threadIdx.x; asm volatile("" : "+v"(t)); return t; }
__device__ __forceinline__ float silu_f(float x) { return x / (1.f + __expf(-x)); }
__device__ __forceinline__ float softplus_f(float x) { return x > 20.f ? x : log1pf(__expf(x)); }
__device__ __forceinline__ f32x2 gelu_pk(f32x2 v) {
    const f32x2 av = __builtin_elementwise_abs(v), d = av * 0.2316418882f + 1.0f;
    f32x2 t; t.x = __builtin_amdgcn_rcpf(d.x); t.y = __builtin_amdgcn_rcpf(d.y);
    f32x2 q = t * 0.5307027145f + (-0.7265760135f); q = q * t + 0.7107068705f; q = q * t + (-0.142248368f); q = q * t + 0.127414796f; q = q * t;
    const f32x2 s = (v * v) * (-0.72134752044f);
    f32x2 e; e.x = __builtin_amdgcn_exp2f(s.x); e.y = __builtin_amdgcn_exp2f(s.y);
    const f32x2 m = v * (q * e), r = v - m;
    f32x2 o; o.x = v.x < 0.f ? m.x : r.x; o.y = v.y < 0.f ? m.y : r.y; return o;
}
__device__ __forceinline__ float gelu_f(float x) { f32x2 v = {x, 0.f}; return gelu_pk(v).x; }

__device__ __forceinline__ int row_mb(int r) { return r < NLAT ? (r >> 13) : 4; }

#define XB_TMO      128
#define XB_XCNT(j)  (256  + 64 * (j))
#define XB_XSUB(j)  (1280 + 64 * (j))
#define XB_XGEN(j)  (2304 + 64 * (j))
#define XB_TOP      3328
#define XB_TOPGEN   3392
#define XCD_BAR_WORDS 3456
#define XB_SPIN_CAP (1u << 22)
__device__ __forceinline__ unsigned xb_ld(unsigned* p)              { return __hip_atomic_load(p, __ATOMIC_RELAXED, __HIP_MEMORY_SCOPE_AGENT); }
__device__ __forceinline__ unsigned xb_add(unsigned* p, unsigned v) { return __hip_atomic_fetch_add(p, v, __ATOMIC_RELAXED, __HIP_MEMORY_SCOPE_AGENT); }
__device__ __forceinline__ unsigned xb_xcc_id() { return (unsigned)__builtin_amdgcn_s_getreg((3 << 11) | 20) & 0xFu; }
#define XB_SPIN(cond, bar) do { unsigned _sp = 0; while (cond) { __builtin_amdgcn_s_sleep(1); \
    if ((++_sp & 255u) == 0u) { if (xb_ld(&(bar)[XB_TMO])) break; if (_sp > XB_SPIN_CAP) { atomicAdd(&(bar)[XB_TMO], 1u); break; } } } } while (0)
struct XcdBarrier { unsigned* bar; unsigned x; volatile LAS unsigned* st; };
__device__ __forceinline__ XcdBarrier xcd_barrier_post(unsigned* bar, volatile LAS unsigned* st) {
    XcdBarrier b; b.bar = bar; b.x = xb_xcc_id(); b.st = st;
    if (threadIdx.x == 0) (void)xb_add(&bar[XB_XCNT(b.x)], 1u);
    return b;
}
__device__ __forceinline__ void xcd_barrier_complete(unsigned* bar, unsigned x, unsigned& nloc, unsigned& nx) {
    const unsigned G = gridDim.x * gridDim.y * gridDim.z;
    unsigned sum, cnt, mine, sp = 0u;
    for (;;) {
        sum = 0u; cnt = 0u; mine = 0u;
#pragma unroll
        for (unsigned j = 0; j < 16; ++j) { const unsigned c = xb_ld(&bar[XB_XCNT(j)]); sum += c; cnt += (c > 0u) ? 1u : 0u; mine = (j == x) ? c : mine; }
        if (sum == G) break;
        __builtin_amdgcn_s_sleep(1);
        if ((++sp & 255u) == 0u) { if (xb_ld(&bar[XB_TMO])) break; if (sp > XB_SPIN_CAP) { atomicAdd(&bar[XB_TMO], 1u); break; } }
    }
    nloc = mine > 0u ? mine : 1u; nx = cnt > 0u ? cnt : 1u;
}
__device__ __forceinline__ void xcd_barrier(const XcdBarrier& b) {
    asm volatile("s_waitcnt vmcnt(0)" ::: "memory");
    __syncthreads();
    if (threadIdx.x == 0) {
        unsigned* bar = b.bar;
        __builtin_amdgcn_s_waitcnt(0);
        unsigned nloc = b.st[0], nx = b.st[1];
        if (nloc == 0u) { xcd_barrier_complete(bar, b.x, nloc, nx); b.st[0] = nloc; b.st[1] = nx; }
        const unsigned old = xb_add(&bar[XB_XSUB(b.x)], 1u);
        const unsigned gen = old / nloc;
        if (old + 1u == (gen + 1u) * nloc) {
            __builtin_amdgcn_fence(__ATOMIC_RELEASE, "agent");
            asm volatile("s_waitcnt vmcnt(0)" ::: "memory");
            const unsigned og = xb_add(&bar[XB_TOP], 1u);
            const unsigned tg = og / nx;
            if (og + 1u == (tg + 1u) * nx) xb_add(&bar[XB_TOPGEN], 1u);
            else XB_SPIN(xb_ld(&bar[XB_TOPGEN]) == tg, bar);
            __builtin_amdgcn_fence(__ATOMIC_ACQUIRE, "agent");
            xb_add(&bar[XB_XGEN(b.x)], 1u);
            asm volatile("s_waitcnt vmcnt(0)" ::: "memory");
        } else {
            XB_SPIN(xb_ld(&bar[XB_XGEN(b.x)]) == gen, bar);
            __builtin_amdgcn_fence(__ATOMIC_ACQUIRE, "agent");
            asm volatile("s_waitcnt vmcnt(0)" ::: "memory");
        }
    }
    __syncthreads();
}

namespace pg8 {
constexpr int BM = 256, BK = 64, HALF = 128, HTB = HALF * BK * 2, STAGE_BYTES = 8 * HTB, NXCD = 8, WGM = 8;
__host__ __device__ __forceinline__ int lds_byte(int r, int c) { const int st = (r >> 4) * 2 + (c >> 5), rr = r & 15, cc = c & 31, ob = rr * 64 + cc * 2; return st * 1024 + (ob ^ (((ob >> 9) & 1) << 5)); }
__host__ __device__ __forceinline__ void stage_rc(int b, int& R, int& C) { const int st = b / 1024, sb = b % 1024, swz = sb ^ (((sb >> 9) & 1) << 5); R = (st >> 1) * 16 + swz / 64; C = (st & 1) * 32 + (swz % 64) / 2; }
__host__ __device__ __forceinline__ int perm32(int rho) { const int n = rho >> 4, i = rho & 15; return 8 * (i >> 2) + 4 * n + (i & 3); }
struct Unit { int pm, pn; };
struct Gemm { const bf16_t* A; const bf16_t* Bt; int M, N, K, lda, ldb; };
struct StaticOrder {
    int nM, nN, nwg, G, c;
    __device__ void init(int M, int N, int G_, int c_) { nM = M / BM; nN = N / BM; nwg = nM * nN; G = G_; c = c_; }
    __device__ bool next(int i, Unit& u) const {
        const long L = (long)i * G + c; if (L >= nwg) return false;
        int wgid = (int)L; { const int q = nwg / NXCD, r = nwg % NXCD, xcd = wgid % NXCD, off = wgid / NXCD; wgid = (xcd < r ? xcd * (q + 1) : r * (q + 1) + (xcd - r) * q) + off; }
        const int nig = WGM * nN, gid = wgid / nig, fm = gid * WGM, gsz = (nM - fm) < WGM ? (nM - fm) : WGM;
        u.pm = fm + ((wgid % nig) % gsz); u.pn = (wgid % nig) / gsz; return true;
    }
};
template <class Epi>
__device__ __forceinline__ void gemm_phase(LAS unsigned char* lds, const Gemm g, const Epi& E) {
    const int tid = otid(), wid = __builtin_amdgcn_readfirstlane(tid >> 6), lane = tid & 63, wr = wid >> 2, wc = wid & 3, fr = lane & 15, fq = lane >> 4;
    StaticOrder S; S.init(g.M, g.N, (int)gridDim.x, (int)blockIdx.x);
    int K = g.K; asm volatile("" : "+s"(K));
    const int nt = K / BK;
    unsigned voffA[2], voffB[2];
#pragma unroll
    for (int i = 0; i < 2; ++i) { int R, C; stage_rc(tid * 16 + i * 8192, R, C); const int Rb = Epi::PERM ? ((R & ~31) + perm32(R & 31)) : R;
        voffA[i] = (unsigned)(R * g.lda + C) * 2u; voffB[i] = (unsigned)(Rb * g.ldb + C) * 2u; }
    const size_t kstep = (size_t)(BK * 2);
    const size_t hstepA = (size_t)HALF * g.lda * 2, hstepB = (size_t)HALF * g.ldb * 2;
    const size_t tstepA = 2 * hstepA, tstepB = 2 * hstepB;
    const unsigned ldsw = (unsigned)wid * 1024u;
    const int aoff = lds_byte(wr * 64 + fr, fq * 8), boff = lds_byte(wc * 32 + fr, fq * 8);
#define PG8_SA(b, h) (((b) * 2 + (h)) * HTB)
#define PG8_SB(b, h) ((4 + (b) * 2 + (h)) * HTB)
#define PG8_STAGE(bufoff, gbase, voff) do { _Pragma("unroll") for (int _i = 0; _i < 2; ++_i) \
        __builtin_amdgcn_global_load_lds((const unsigned*)((const char*)(gbase) + (voff)[_i]), (LAS unsigned*)(lds + (bufoff) + ldsw + _i * 8192), 16, 0, 0); } while (0)
#define PG8_LDA(dst, b, h) do { _Pragma("unroll") for (int m = 0; m < 4; ++m) _Pragma("unroll") for (int k = 0; k < 2; ++k) dst[m][k] = *(const LAS bf16x8*)(lds + PG8_SA(b, h) + aoff + m * 2048 + k * 1024); } while (0)
#define PG8_LDB(dst, b, h) do { _Pragma("unroll") for (int n = 0; n < 2; ++n) _Pragma("unroll") for (int k = 0; k < 2; ++k) dst[n][k] = *(const LAS bf16x8*)(lds + PG8_SB(b, h) + boff + n * 2048 + k * 1024); } while (0)
#define PG8_MMA(ai, bj, At, Bt) do { __builtin_amdgcn_s_setprio(1); _Pragma("unroll") for (int m = 0; m < 4; ++m) _Pragma("unroll") for (int n = 0; n < 2; ++n) _Pragma("unroll") for (int k = 0; k < 2; ++k) \
        acc[ai][bj][m][n] = __builtin_amdgcn_mfma_f32_16x16x32_bf16(Bt[n][k], At[m][k], acc[ai][bj][m][n], 0, 0, 0); __builtin_amdgcn_s_setprio(0); } while (0)
#define PG8_WAIT_V(n) asm volatile("s_waitcnt vmcnt(" #n ")" ::: "memory")
#define PG8_WAIT_L(n) asm volatile("s_waitcnt lgkmcnt(" #n ")" ::: "memory")
#define PG8_BAR __builtin_amdgcn_s_barrier()
#define PG8_SCHED __builtin_amdgcn_sched_barrier(0)
    Unit cur, nxt; int ui = 0;
    if (!S.next(0, cur)) return;
    f32x4 acc[2][2][4][2];
#pragma unroll
    for (int a = 0; a < 2; ++a)
#pragma unroll
        for (int b = 0; b < 2; ++b)
#pragma unroll
            for (int m = 0; m < 4; ++m)
#pragma unroll
                for (int n = 0; n < 2; ++n) acc[a][b][m][n] = (f32x4){0.f, 0.f, 0.f, 0.f};
    bf16x8 At[4][2], B0[2][2], B1[2][2];
    const char* cA = (const char*)g.A + (size_t)cur.pm * tstepA; const char* cB = (const char*)g.Bt + (size_t)cur.pn * tstepB;
    PG8_STAGE(PG8_SB(0, 0), cB, voffB); PG8_STAGE(PG8_SB(0, 1), cB + hstepB, voffB); PG8_STAGE(PG8_SA(0, 0), cA, voffA); PG8_STAGE(PG8_SA(0, 1), cA + hstepA, voffA);
    if (wr == 1) PG8_BAR;
    PG8_WAIT_V(2); PG8_BAR;
    PG8_STAGE(PG8_SB(1, 0), cB + kstep, voffB); PG8_STAGE(PG8_SA(1, 0), cA + kstep, voffA); PG8_STAGE(PG8_SB(1, 1), cB + hstepB + kstep, voffB);
    PG8_WAIT_V(6); PG8_BAR;
    for (;;) {
        const bool has_next = S.next(ui + 1, nxt);
        const char* nA = has_next ? (const char*)g.A + (size_t)nxt.pm * tstepA : cA; const char* nB = has_next ? (const char*)g.Bt + (size_t)nxt.pn * tstepB : cB;
        for (int t = 0; t < nt; t += 2) {
            const bool last = (t == nt - 2);
            const char* a1 = cA + (size_t)(t + 1) * kstep;
            const char* a2 = last ? nA : cA + (size_t)(t + 2) * kstep; const char* b2 = last ? nB : cB + (size_t)(t + 2) * kstep;
            const char* a3 = a2 + kstep; const char* b3 = b2 + kstep;
            PG8_LDB(B0, 0, 0); PG8_LDB(B1, 0, 1); PG8_SCHED; PG8_LDA(At, 0, 0); PG8_STAGE(PG8_SA(1, 1), a1 + hstepA, voffA);
            PG8_WAIT_V(8); PG8_WAIT_L(0); PG8_BAR; PG8_MMA(0, 0, At, B0); PG8_MMA(0, 1, At, B1); PG8_BAR; PG8_SCHED;
            PG8_LDA(At, 0, 1); PG8_STAGE(PG8_SB(0, 0), b2, voffB); PG8_STAGE(PG8_SB(0, 1), b2 + hstepB, voffB); PG8_STAGE(PG8_SA(0, 0), a2, voffA);
            PG8_WAIT_V(8); PG8_WAIT_L(0); PG8_BAR; PG8_MMA(1, 0, At, B0); PG8_MMA(1, 1, At, B1); PG8_BAR; PG8_SCHED;
            PG8_LDB(B0, 1, 0); PG8_LDB(B1, 1, 1); PG8_SCHED; PG8_LDA(At, 1, 0); PG8_STAGE(PG8_SA(0, 1), a2 + hstepA, voffA);
            PG8_WAIT_V(8); PG8_WAIT_L(0); PG8_BAR; PG8_MMA(0, 0, At, B0); PG8_MMA(0, 1, At, B1); PG8_BAR; PG8_SCHED;
            PG8_LDA(At, 1, 1); PG8_STAGE(PG8_SB(1, 0), b3, voffB); PG8_STAGE(PG8_SB(1, 1), b3 + hstepB, voffB); PG8_STAGE(PG8_SA(1, 0), a3, voffA);
            PG8_WAIT_V(8); PG8_WAIT_L(0); PG8_BAR; PG8_MMA(1, 0, At, B0); PG8_MMA(1, 1, At, B1); PG8_BAR; PG8_SCHED;
        }
        if (wr == 0) PG8_BAR;
        { const int l2_ = otid() & 63; E(acc, cur, wr, wc, l2_ & 15, l2_ >> 4); }
        if (!has_next) break;
#pragma unroll
        for (int a = 0; a < 2; ++a)
#pragma unroll
            for (int b = 0; b < 2; ++b)
#pragma unroll
                for (int m = 0; m < 4; ++m)
#pragma unroll
                    for (int n = 0; n < 2; ++n) acc[a][b][m][n] = (f32x4){0.f, 0.f, 0.f, 0.f};
        cur = nxt; cA = nA; cB = nB; ++ui;
        if (wr == 1) PG8_BAR;
    }
    PG8_WAIT_V(0);
    PG8_BAR;
#undef PG8_SA
#undef PG8_SB
#undef PG8_STAGE
#undef PG8_LDA
#undef PG8_LDB
#undef PG8_MMA
#undef PG8_WAIT_V
#undef PG8_WAIT_L
#undef PG8_BAR
#undef PG8_SCHED
}

template <int ACT> struct EpiBf16 {
    static constexpr bool PERM = true;
    bf16_t* O; int ldc;
    __device__ __forceinline__ void operator()(const f32x4 (&acc)[2][2][4][2], const Unit& u, int wr, int wc, int fr, int fq) const {
        const int row0 = u.pm * BM + wr * 64 + fr, col0 = u.pn * BM + wc * 32 + 8 * fq;
#pragma unroll
        for (int ai = 0; ai < 2; ++ai)
#pragma unroll
            for (int m = 0; m < 4; ++m) { bf16_t* rowp = O + (size_t)(row0 + ai * HALF + m * 16) * ldc + col0;
#pragma unroll
                for (int bj = 0; bj < 2; ++bj) { f32x4 v0 = acc[ai][bj][m][0], v1 = acc[ai][bj][m][1];
                    if (ACT == 1) { f32x2 a = gelu_pk((f32x2){v0[0], v0[1]}), b = gelu_pk((f32x2){v0[2], v0[3]}), c = gelu_pk((f32x2){v1[0], v1[1]}), d = gelu_pk((f32x2){v1[2], v1[3]});
                        v0 = (f32x4){a.x, a.y, b.x, b.y}; v1 = (f32x4){c.x, c.y, d.x, d.y}; }
                    u32x4 w; w.x = cvt_pk_bf16(v0[0], v0[1]); w.y = cvt_pk_bf16(v0[2], v0[3]); w.z = cvt_pk_bf16(v1[0], v1[1]); w.w = cvt_pk_bf16(v1[2], v1[3]);
                    *(u32x4*)(rowp + bj * HALF) = w; } }
    }
};
struct EpiResid {
    static constexpr bool PERM = false;
    float* xl; float* xc; const float* gate;
    __device__ __forceinline__ void operator()(const f32x4 (&acc)[2][2][4][2], const Unit& u, int wr, int wc, int fr, int fq) const {
        const int rbase = u.pm * BM; const bool lat = rbase < NLAT;
        float* X = lat ? xl + (size_t)rbase * D : xc + (size_t)(rbase - NLAT) * D;
        const float* gp = gate + (size_t)(lat ? (rbase >> 13) : 4) * 6144;
        const int row0 = wr * 64 + fr, col0 = u.pn * BM + wc * 32 + 4 * fq;
        f32x4 gv[2][2];
#pragma unroll
        for (int bj = 0; bj < 2; ++bj)
#pragma unroll
            for (int n = 0; n < 2; ++n) gv[bj][n] = *(const f32x4*)(gp + col0 + bj * HALF + n * 16);
#pragma unroll
        for (int ai = 0; ai < 2; ++ai)
#pragma unroll
            for (int m = 0; m < 4; ++m) { float* rowp = X + (size_t)(row0 + ai * HALF + m * 16) * D + col0;
#pragma unroll
                for (int bj = 0; bj < 2; ++bj)
#pragma unroll
                    for (int n = 0; n < 2; ++n) { f32x4* p = (f32x4*)(rowp + bj * HALF + n * 16); *p = *p + gv[bj][n] * acc[ai][bj][m][n]; } }
    }
};
}

namespace att {
constexpr int SLOT = 40960, KN_OFF = 0, KR_OFF = 16384, V_OFF = 24576, LDS_BYTES = 3 * SLOT + 8 * 256;
constexpr float THR2 = 11.0f;
#define KSWZ(row, colB) ((row) * 256 + ((colB) ^ (((row) & 7) << 4)))
#define KRSWZ(row, colB) ((row) * 128 + ((colB) ^ ((((row) >> 1) & 7) << 4)))
#define SBAR() __builtin_amdgcn_sched_barrier(0)
__device__ __forceinline__ int crow(int r, int hi) { return (r & 3) + 8 * (r >> 2) + 4 * hi; }
__host__ __device__ __forceinline__ int v_st(int k, int c) { const int kk = (k & ~0xC) | ((k & 4) << 1) | ((k & 8) >> 1); return ((kk >> 3) * 4 + (c >> 5)) * 512 + ((kk & 7) * 32 + (c & 31)) * 2; }
__device__ __forceinline__ int v_rd_base(int lane) { return ((lane & 3) << 3) | (((lane >> 2) & 3) << 6) | (((lane >> 4) & 1) << 5) | (((lane >> 5) & 1) << 8); }
constexpr int v_rd_off(int d0, int ks, int half) { return d0 * 512 + ks * 4096 + half * 2048; }
template <int OFF> __device__ __forceinline__ s16x4 tr_read(int vb) {
    s16x4 r; asm volatile("ds_read_b64_tr_b16 %0, %1 offset:%2" : "=&v"(r) : "v"(vb), "i"(OFF) : "memory"); return r;
}
template <int D0> __device__ __forceinline__ void pv_one(f32x16& od, int vb, bf16x8 pa0, bf16x8 pa1, bf16x8 pa2, bf16x8 pa3) {
    const s16x4 l0 = tr_read<v_rd_off(D0, 0, 0)>(vb), h0 = tr_read<v_rd_off(D0, 0, 1)>(vb), l1 = tr_read<v_rd_off(D0, 1, 0)>(vb), h1 = tr_read<v_rd_off(D0, 1, 1)>(vb);
    const s16x4 l2 = tr_read<v_rd_off(D0, 2, 0)>(vb), h2 = tr_read<v_rd_off(D0, 2, 1)>(vb), l3 = tr_read<v_rd_off(D0, 3, 0)>(vb), h3 = tr_read<v_rd_off(D0, 3, 1)>(vb);
    asm volatile("s_waitcnt lgkmcnt(0)" ::: "memory"); SBAR();
#define PK(L, H) (bf16x8){L[0], L[1], L[2], L[3], H[0], H[1], H[2], H[3]}
    od = __builtin_amdgcn_mfma_f32_32x32x16_bf16(pa0, PK(l0, h0), od, 0, 0, 0);
    od = __builtin_amdgcn_mfma_f32_32x32x16_bf16(pa1, PK(l1, h1), od, 0, 0, 0);
    od = __builtin_amdgcn_mfma_f32_32x32x16_bf16(pa2, PK(l2, h2), od, 0, 0, 0);
    od = __builtin_amdgcn_mfma_f32_32x32x16_bf16(pa3, PK(l3, h3), od, 0, 0, 0);
#undef PK
}
__device__ __forceinline__ void pv_d0(f32x16* o, int vb, bf16x8 pa0, bf16x8 pa1, bf16x8 pa2, bf16x8 pa3) {
    pv_one<0>(o[0], vb, pa0, pa1, pa2, pa3); pv_one<1>(o[1], vb, pa0, pa1, pa2, pa3); pv_one<2>(o[2], vb, pa0, pa1, pa2, pa3); pv_one<3>(o[3], vb, pa0, pa1, pa2, pa3);
}
__device__ __forceinline__ void partialSM(f32x16& p0, f32x16& p1, float& m_reg, float& mn, float& alpha) {
    float pmax = p0[0];
#pragma unroll
    for (int r = 1; r < 16; ++r) pmax = fmaxf(pmax, p0[r]);
#pragma unroll
    for (int r = 0; r < 16; ++r) pmax = fmaxf(pmax, p1[r]);
    { auto rr = __builtin_amdgcn_permlane32_swap(__float_as_uint(pmax), __float_as_uint(pmax), false, false);
      pmax = fmaxf(__uint_as_float(rr[0]), __uint_as_float(rr[1])); }
    if (__builtin_expect(__all(pmax - m_reg <= THR2), 1)) { mn = m_reg; alpha = 1.f; }
    else { mn = fmaxf(m_reg, pmax); alpha = __builtin_amdgcn_exp2f(m_reg - mn); m_reg = mn; }
#pragma unroll
    for (int r = 0; r < 16; ++r) p0[r] = __builtin_amdgcn_exp2f(p0[r] - mn);
#pragma unroll
    for (int r = 0; r < 16; ++r) p1[r] = p1[r] - mn;
}
__device__ __forceinline__ void finishSM(f32x16& p0, f32x16& p1, float alpha, float& l_reg, bf16x8& pa0, bf16x8& pa1, bf16x8& pa2, bf16x8& pa3) {
#pragma unroll
    for (int r = 0; r < 16; ++r) p1[r] = __builtin_amdgcn_exp2f(p1[r]);
    float ps = 0;
#pragma unroll
    for (int r = 0; r < 16; ++r) ps += p0[r];
#pragma unroll
    for (int r = 0; r < 16; ++r) ps += p1[r];
    { auto rr = __builtin_amdgcn_permlane32_swap(__float_as_uint(ps), __float_as_uint(ps), false, false);
      ps = __uint_as_float(rr[0]) + __uint_as_float(rr[1]); }
    l_reg = l_reg * alpha + ps;
#define PK4(P, BASE, OUT) do { unsigned a0 = cvt_pk_bf16(P[BASE + 0], P[BASE + 1]), a1 = cvt_pk_bf16(P[BASE + 2], P[BASE + 3]);   \
    unsigned b0 = cvt_pk_bf16(P[BASE + 4], P[BASE + 5]), b1 = cvt_pk_bf16(P[BASE + 6], P[BASE + 7]);                              \
    auto r0 = __builtin_amdgcn_permlane32_swap(a0, b0, false, false); auto r1 = __builtin_amdgcn_permlane32_swap(a1, b1, false, false); \
    u32x4 w = {r0[0], r1[0], r0[1], r1[1]}; OUT = *reinterpret_cast<bf16x8*>(&w); } while (0)
    PK4(p0, 0, pa0); PK4(p0, 8, pa1); PK4(p1, 0, pa2); PK4(p1, 8, pa3);
#undef PK4
}
__device__ __forceinline__ void qkt(f32x16& p0, f32x16& p1, LAS unsigned char* slot, const bf16x8* qr, int r32, int hi) {
    p0 = f32x16{}; p1 = f32x16{};
#pragma unroll
    for (int d0 = 0; d0 < 8; ++d0) { const int cb = (d0 * 16 + hi * 8) * 2;
        bf16x8 b0 = *(const LAS bf16x8*)(slot + KN_OFF + KSWZ(r32, cb));
        bf16x8 b1 = *(const LAS bf16x8*)(slot + KN_OFF + KSWZ(32 + r32, cb));
        p0 = __builtin_amdgcn_mfma_f32_32x32x16_bf16(b0, qr[d0], p0, 0, 0, 0);
        p1 = __builtin_amdgcn_mfma_f32_32x32x16_bf16(b1, qr[d0], p1, 0, 0, 0); }
#pragma unroll
    for (int d0 = 0; d0 < 4; ++d0) { const int cb = (d0 * 16 + hi * 8) * 2;
        bf16x8 b0 = *(const LAS bf16x8*)(slot + KR_OFF + KRSWZ(r32, cb));
        bf16x8 b1 = *(const LAS bf16x8*)(slot + KR_OFF + KRSWZ(32 + r32, cb));
        p0 = __builtin_amdgcn_mfma_f32_32x32x16_bf16(b0, qr[8 + d0], p0, 0, 0, 0);
        p1 = __builtin_amdgcn_mfma_f32_32x32x16_bf16(b1, qr[8 + d0], p1, 0, 0, 0); }
}
__device__ __forceinline__ void attn_unit(const bf16_t* __restrict__ Qb, const unsigned char* __restrict__ KNt, const unsigned char* __restrict__ KRt, const unsigned char* __restrict__ Vt,
                                          bf16_t* __restrict__ Ob, int NT, LAS unsigned char* lds) {
    const int tid = otid(), wid = __builtin_amdgcn_readfirstlane(tid >> 6), lane = tid & 63, r32 = lane & 31, hi = lane >> 5;
    LAS float* wsf = (LAS float*)(lds + 3 * SLOT) + wid * 64; LAS float* li_l = wsf; LAS float* al_l = wsf + 32;
    float m_reg = -1e30f, l_reg = 0; f32x16 o[4] = {}; bf16x8 qr[12];
    const bf16_t* Qw = Qb + (size_t)(wid * 32 + r32) * 192 + hi * 8;
#pragma unroll
    for (int d0 = 0; d0 < 12; ++d0) qr[d0] = *(const bf16x8*)(Qw + d0 * 16);
    const int vrb = (int)(unsigned)(uintptr_t)(lds) + V_OFF + v_rd_base(lane);
    const unsigned lo16 = (unsigned)lane * 16u;
#define ATT_DMA(tile, slotoff) do { const size_t t_ = (size_t)(tile); LAS unsigned char* sl_ = lds + (slotoff); \
        __builtin_amdgcn_global_load_lds((const unsigned*)(KNt + t_ * 16384 + wid * 1024 + lo16), (LAS unsigned*)(sl_ + KN_OFF + wid * 1024), 16, 0, 0); \
        __builtin_amdgcn_global_load_lds((const unsigned*)(KNt + t_ * 16384 + (wid + 8) * 1024 + lo16), (LAS unsigned*)(sl_ + KN_OFF + (wid + 8) * 1024), 16, 0, 0); \
        __builtin_amdgcn_global_load_lds((const unsigned*)(KRt + t_ * 8192 + wid * 1024 + lo16), (LAS unsigned*)(sl_ + KR_OFF + wid * 1024), 16, 0, 0); \
        __builtin_amdgcn_global_load_lds((const unsigned*)(Vt + t_ * 16384 + wid * 1024 + lo16), (LAS unsigned*)(sl_ + V_OFF + wid * 1024), 16, 0, 0); \
        __builtin_amdgcn_global_load_lds((const unsigned*)(Vt + t_ * 16384 + (wid + 8) * 1024 + lo16), (LAS unsigned*)(sl_ + V_OFF + (wid + 8) * 1024), 16, 0, 0); } while (0)
#define ATT_SYNC() do { asm volatile("s_waitcnt vmcnt(0)" ::: "memory"); __builtin_amdgcn_s_barrier(); asm volatile("" ::: "memory"); } while (0)
#define RESC(a) do { if (__any((a) < 1.f)) { if (hi == 0) al_l[r32] = (a); asm volatile("s_waitcnt lgkmcnt(0)" ::: "memory"); \
        _Pragma("unroll") for (int d = 0; d < 4; ++d) _Pragma("unroll") for (int r = 0; r < 16; ++r) o[d][r] *= al_l[crow(r, hi)]; } } while (0)
    f32x16 pA0, pA1, pB0, pB1; float mnA, mnB, alA, alB; bf16x8 pa0, pa1, pa2, pa3;
    int sp = 0, sc = SLOT, sn = 2 * SLOT;
    ATT_DMA(0, 0); ATT_DMA(1, SLOT);
    asm volatile("s_waitcnt vmcnt(5)" ::: "memory"); __builtin_amdgcn_s_barrier(); asm volatile("" ::: "memory");
    qkt(pA0, pA1, lds, qr, r32, hi); partialSM(pA0, pA1, m_reg, mnA, alA);
    for (int j = 1; j + 1 < NT; j += 2) {
        ATT_SYNC(); ATT_DMA(j + 1, sn);
        SBAR(); qkt(pB0, pB1, lds + sc, qr, r32, hi);
        finishSM(pA0, pA1, alA, l_reg, pa0, pa1, pa2, pa3); SBAR();
        pv_d0(o, vrb + sp, pa0, pa1, pa2, pa3); partialSM(pB0, pB1, m_reg, mnB, alB);
        RESC(alB);
        { const int t_ = sp; sp = sc; sc = sn; sn = t_; }
        ATT_SYNC(); if (j + 2 < NT) ATT_DMA(j + 2, sn);
        SBAR(); qkt(pA0, pA1, lds + sc, qr, r32, hi);
        finishSM(pB0, pB1, alB, l_reg, pa0, pa1, pa2, pa3); SBAR();
        pv_d0(o, vrb + sp, pa0, pa1, pa2, pa3); partialSM(pA0, pA1, m_reg, mnA, alA);
        RESC(alA);
        { const int t_ = sp; sp = sc; sc = sn; sn = t_; }
    }
    ATT_SYNC();
    SBAR(); qkt(pB0, pB1, lds + sc, qr, r32, hi);
    finishSM(pA0, pA1, alA, l_reg, pa0, pa1, pa2, pa3); SBAR();
    pv_d0(o, vrb + sp, pa0, pa1, pa2, pa3); partialSM(pB0, pB1, m_reg, mnB, alB);
    RESC(alB);
    finishSM(pB0, pB1, alB, l_reg, pa0, pa1, pa2, pa3); SBAR();
    pv_d0(o, vrb + sc, pa0, pa1, pa2, pa3);
    if (hi == 0) li_l[r32] = l_reg; asm volatile("s_waitcnt lgkmcnt(0)" ::: "memory");
    float rli[16];
#pragma unroll
    for (int r = 0; r < 16; ++r) rli[r] = __builtin_amdgcn_rcpf(li_l[crow(r, hi)]);
    bf16_t* Ow = Ob + (size_t)(wid * 32) * 2048;
#pragma unroll
    for (int r = 0; r < 16; ++r) { const int orow = crow(r, hi);
#pragma unroll
        for (int d0 = 0; d0 < 4; ++d0) Ow[(size_t)orow * 2048 + d0 * 32 + r32] = f2bf(o[d0][r] * rli[r]); }
    __builtin_amdgcn_s_barrier(); asm volatile("" ::: "memory");
#undef ATT_DMA
#undef ATT_SYNC
#undef RESC
}
}

namespace ssd {
constexpr int XT_OFF = 0, XTW_OFF = 8704, BT_OFF = 17408, HB_OFF = 52224, SET = 60928, CW_OFF = 2 * SET, LDS_BYTES = CW_OFF + 8 * 512;
constexpr int PITCH = 272;
constexpr float L2E = 1.4426950408889634f;
__device__ __forceinline__ void g_unit(const bf16_t* __restrict__ BC, bf16_t* __restrict__ G, int unit) {
    const int cid = unit >> 1, g = unit & 1;
    const int r0 = cid < 256 ? cid * 128 : NLAT + (cid - 256) * 128;
    const int tid = otid(), wid = tid >> 6, lane = tid & 63, fr = lane & 15, fq = lane >> 4;
    const bf16_t* Cp = BC + (size_t)(r0 + 16 * wid + fr) * 512 + 256 + 128 * g + 8 * fq;
    bf16x8 cf[4];
#pragma unroll
    for (int ks = 0; ks < 4; ++ks) cf[ks] = *(const bf16x8*)(Cp + 32 * ks);
    bf16_t* Gp = G + ((size_t)unit * 128 + 16 * wid + fr) * 128 + 4 * fq;
#pragma unroll
    for (int sb = 0; sb < 8; ++sb) {
        const bf16_t* Bp = BC + (size_t)(r0 + 16 * sb + fr) * 512 + 128 * g + 8 * fq;
        f32x4 acc = {0.f, 0.f, 0.f, 0.f};
#pragma unroll
        for (int ks = 0; ks < 4; ++ks) { const bf16x8 bfr = *(const bf16x8*)(Bp + 32 * ks); acc = __builtin_amdgcn_mfma_f32_16x16x32_bf16(bfr, cf[ks], acc, 0, 0, 0); }
        u32x2 w; w.x = cvt_pk_bf16(acc[0], acc[1]); w.y = cvt_pk_bf16(acc[2], acc[3]);
        *(u32x2*)(Gp + 16 * sb) = w;
    }
}
__device__ __forceinline__ void ssd_unit(int u, const bf16_t* __restrict__ XS, const bf16_t* __restrict__ BC, const float* __restrict__ DT, const bf16_t* __restrict__ G,
                                         const float* __restrict__ a_log, bf16_t* __restrict__ Y0, bf16_t* __restrict__ Y1, LAS unsigned char* lds) {
    const int b = u >> 6, h = (u >> 2) & 15, d = (u >> 1) & 1, ph = u & 1, g = h >> 3;
    const int tid = otid(), wid = tid >> 6, lane = tid & 63, fr = lane & 15, fq = lane >> 4;
    const float a = -__expf(a_log[d * 16 + h]);
    bf16_t* Y = d ? Y1 : Y0;
    LAS float* cw = (LAS float*)(lds + CW_OFF + wid * 512);
    f32x4 hs[2] = {{0.f, 0.f, 0.f, 0.f}, {0.f, 0.f, 0.f, 0.f}};
    for (int i = tid; i < 8704 / 4; i += 512) ((LAS unsigned*)(lds + HB_OFF))[i] = 0u;
    float cend = 0.f;
#define SSD_ROWS(step, r0v, gidv) do { if ((step) < 2) { const int oc_ = d ? 1 - (step) : (step); r0v = NLAT + b * 256 + oc_ * 128; gidv = 256 + b * 2 + oc_; } \
        else { const int lc_ = (step) - 2, oc_ = d ? 63 - lc_ : lc_; r0v = b * 8192 + oc_ * 128; gidv = b * 64 + oc_; } } while (0)
#define SSD_STAGE(step) do { int r0_, gid_; SSD_ROWS(step, r0_, gid_); (void)gid_; LAS unsigned char* set_ = lds + ((step) & 1) * SET; \
        const float da0 = DT[(size_t)(r0_ + 2 * lane) * 32 + d * 16 + h] * a, da1 = DT[(size_t)(r0_ + 2 * lane + 1) * 32 + d * 16 + h] * a; \
        float sc_ = da0 + da1; \
        if (d == 0) { _Pragma("unroll") for (int o_ = 1; o_ < 64; o_ <<= 1) { const float t_ = __shfl_up(sc_, o_); if (lane >= o_) sc_ += t_; } \
            cw[2 * lane] = sc_ - da1; cw[2 * lane + 1] = sc_; cend = __shfl(sc_, 63); } \
        else { _Pragma("unroll") for (int o_ = 1; o_ < 64; o_ <<= 1) { const float t_ = __shfl_down(sc_, o_); if (lane + o_ < 64) sc_ += t_; } \
            cw[2 * lane] = sc_; cw[2 * lane + 1] = sc_ - da0; cend = __shfl(sc_, 0); } \
        asm volatile("s_waitcnt lgkmcnt(0)" ::: "memory"); \
        { const int s_ = tid & 127, pq_ = tid >> 7; const int row_ = r0_ + s_; \
          const u32x4 xv_ = *(const u32x4*)(XS + (size_t)row_ * 1024 + 64 * h + 32 * ph + 8 * pq_); \
          const float dt_ = DT[(size_t)row_ * 32 + d * 16 + h]; const float wg_ = __builtin_amdgcn_exp2f((cend - cw[s_]) * L2E); \
          LAS bf16_t* xt_ = (LAS bf16_t*)(set_ + XT_OFF) + (8 * pq_) * 136 + s_; LAS bf16_t* xw_ = (LAS bf16_t*)(set_ + XTW_OFF) + (8 * pq_) * 136 + s_; \
          _Pragma("unroll") for (int i_ = 0; i_ < 4; ++i_) { const float lo_ = bflo(xv_[i_]) * dt_, hi_ = bfhi(xv_[i_]) * dt_; \
              xt_[(2 * i_) * 136] = f2bf(lo_); xt_[(2 * i_ + 1) * 136] = f2bf(hi_); xw_[(2 * i_) * 136] = f2bf(lo_ * wg_); xw_[(2 * i_ + 1) * 136] = f2bf(hi_ * wg_); } } \
        _Pragma("unroll") for (int j_ = 0; j_ < 4; ++j_) { const int idx_ = tid + 512 * j_, s_ = idx_ & 127, n8_ = idx_ >> 7; \
          const u32x4 bv_ = *(const u32x4*)(BC + (size_t)(r0_ + s_) * 512 + 128 * g + 8 * n8_); \
          LAS bf16_t* bt_ = (LAS bf16_t*)(set_ + BT_OFF) + (8 * n8_) * 136 + s_; \
          _Pragma("unroll") for (int i_ = 0; i_ < 4; ++i_) { bt_[(2 * i_) * 136] = (bf16_t)(bv_[i_] & 0xffffu); bt_[(2 * i_ + 1) * 136] = (bf16_t)(bv_[i_] >> 16); } } \
    } while (0)
    SSD_STAGE(0);
    for (int step = 0; step < 66; ++step) {
        __syncthreads();
        int r0, gid; SSD_ROWS(step, r0, gid);
        LAS unsigned char* set = lds + (step & 1) * SET;
        const float cend_cur = cend;
        {
            const int t = 16 * wid + fr; const float ct = cw[t];
            f32x4 y[2] = {{0.f, 0.f, 0.f, 0.f}, {0.f, 0.f, 0.f, 0.f}};
            const bf16_t* Gp = G + ((size_t)(gid * 2 + g) * 128 + t) * 128 + 8 * fq;
            const bf16_t* Cp = BC + (size_t)(r0 + t) * 512 + 256 + 128 * g + 8 * fq;
            u32x4 gv[4], cv[4];
#pragma unroll
            for (int ks = 0; ks < 4; ++ks) { gv[ks] = *(const u32x4*)(Gp + 32 * ks); cv[ks] = *(const u32x4*)(Cp + 32 * ks); }
            const float et = __builtin_amdgcn_exp2f(ct * L2E);
#pragma unroll
            for (int ks = 0; ks < 4; ++ks) {
                const bool live = d == 0 ? (32 * ks <= 16 * wid + 15) : (32 * ks + 31 >= 16 * wid);
                if (live) {
                    const int s0 = 32 * ks + 8 * fq;
                    const f32x4 c0 = *(const LAS f32x4*)(cw + s0), c1 = *(const LAS f32x4*)(cw + s0 + 4);
                    float m[8];
#pragma unroll
                    for (int i = 0; i < 8; ++i) { const float cs = i < 4 ? c0[i & 3] : c1[i & 3]; const int s = s0 + i;
                        const bool ok = d == 0 ? (s <= t) : (s >= t);
                        const float gval = (i & 1) ? bfhi(gv[ks][i >> 1]) : bflo(gv[ks][i >> 1]);
                        m[i] = ok ? gval * __builtin_amdgcn_exp2f((ct - cs) * L2E) : 0.f; }
                    u32x4 mw; mw.x = cvt_pk_bf16(m[0], m[1]); mw.y = cvt_pk_bf16(m[2], m[3]); mw.z = cvt_pk_bf16(m[4], m[5]); mw.w = cvt_pk_bf16(m[6], m[7]);
                    const bf16x8 mb = __builtin_bit_cast(bf16x8, mw);
#pragma unroll
                    for (int q = 0; q < 2; ++q) { const bf16x8 af = *(const LAS bf16x8*)(set + XT_OFF + (16 * q + fr) * PITCH + (32 * ks + 8 * fq) * 2);
                        y[q] = __builtin_amdgcn_mfma_f32_16x16x32_bf16(af, mb, y[q], 0, 0, 0); }
                }
            }
#pragma unroll
            for (int ks = 0; ks < 4; ++ks) {
                u32x4 cwv;
#pragma unroll
                for (int i = 0; i < 4; ++i) cwv[i] = cvt_pk_bf16(bflo(cv[ks][i]) * et, bfhi(cv[ks][i]) * et);
                const bf16x8 cb = __builtin_bit_cast(bf16x8, cwv);
#pragma unroll
                for (int q = 0; q < 2; ++q) { const bf16x8 af = *(const LAS bf16x8*)(set + HB_OFF + (16 * q + fr) * PITCH + (32 * ks + 8 * fq) * 2);
                    y[q] = __builtin_amdgcn_mfma_f32_16x16x32_bf16(af, cb, y[q], 0, 0, 0); }
            }
            bf16_t* yp = Y + (size_t)(r0 + t) * 1024 + 64 * h + 32 * ph + 4 * fq;
#pragma unroll
            for (int q = 0; q < 2; ++q) { u32x2 w; w.x = cvt_pk_bf16(y[q][0], y[q][1]); w.y = cvt_pk_bf16(y[q][2], y[q][3]); *(u32x2*)(yp + 16 * q) = w; }
        }
        {
            const float dec = __builtin_amdgcn_exp2f(cend_cur * L2E);
            hs[0] = hs[0] * dec; hs[1] = hs[1] * dec;
#pragma unroll
            for (int ks = 0; ks < 4; ++ks) {
                const bf16x8 bfr = *(const LAS bf16x8*)(set + BT_OFF + (16 * wid + fr) * PITCH + (32 * ks + 8 * fq) * 2);
#pragma unroll
                for (int q = 0; q < 2; ++q) { const bf16x8 af = *(const LAS bf16x8*)(set + XTW_OFF + (16 * q + fr) * PITCH + (32 * ks + 8 * fq) * 2);
                    hs[q] = __builtin_amdgcn_mfma_f32_16x16x32_bf16(af, bfr, hs[q], 0, 0, 0); }
            }
            LAS bf16_t* hb = (LAS bf16_t*)(lds + ((step + 1) & 1) * SET + HB_OFF) + 16 * wid + fr;
#pragma unroll
            for (int q = 0; q < 2; ++q)
#pragma unroll
                for (int i = 0; i < 4; ++i) hb[(16 * q + 4 * fq + i) * 136] = f2bf(hs[q][i]);
        }
        if (step + 1 < 66) SSD_STAGE(step + 1);
    }
    __syncthreads();
#undef SSD_ROWS
#undef SSD_STAGE
}
}

struct Args { const float* in[32]; float* out; unsigned char* ws; int ph_lo, ph_hi; };
constexpr int NTHR = 512;
constexpr int LDS_BASE = 256;
constexpr int LDS_PHASE = 133120;
constexpr int LDS_BYTES = LDS_BASE + LDS_PHASE;
static_assert(att::LDS_BYTES <= LDS_PHASE && ssd::LDS_BYTES <= LDS_PHASE && pg8::STAGE_BYTES <= LDS_PHASE, "LDS");

__device__ __forceinline__ void tjob(int j, const Args& A, const float*& src, bf16_t*& dst, int& K, int& N, int& Npad, int& mode, const float*& ks) {
    unsigned char* W = A.ws + WS_W; mode = 0; ks = nullptr;
    if (j < 8) { const int i = j >> 2, w = j & 3; unsigned char* base = W + W_HYB + (size_t)i * WH_SZ;
        if (w == 0)      { src = A.in[I_HWIN] + (size_t)i * 1024 * HYB_IN; dst = (bf16_t*)(base + WH_IN); K = 1024; N = HYB_IN; Npad = HYB_INP; mode = 1; }
        else if (w == 1) { src = A.in[I_WQB] + (size_t)i * 384 * 1536; dst = (bf16_t*)(base + WH_QB); K = 384; N = 1536; Npad = 1536; mode = 2; ks = A.in[I_QNG] + i * 384; }
        else if (w == 2) { src = A.in[I_WKVB] + (size_t)i * 256 * 2048; dst = (bf16_t*)(base + WH_KVB); K = 256; N = 2048; Npad = 2048; ks = A.in[I_KVNG] + i * 256; }
        else             { src = A.in[I_HWOUT] + (size_t)i * 2048 * 1024; dst = (bf16_t*)(base + WH_OUT); K = 2048; N = 1024; Npad = 1024; }
    } else if (j < 12) { const int i = (j - 8) >> 1, w = (j - 8) & 1; unsigned char* base = W + W_GM + (size_t)i * WG_SZ;
        if (w == 0) { src = A.in[I_GWIN] + (size_t)i * 1024 * 4096; dst = (bf16_t*)(base + WG_IN); K = 1024; N = 4096; Npad = 4096; }
        else        { src = A.in[I_GWOUT] + (size_t)i * 2048 * 1024; dst = (bf16_t*)(base + WG_OUT); K = 2048; N = 1024; Npad = 1024; }
    } else { const int l = j - 12; src = A.in[I_PWQ] + (size_t)l * 1024 * 2048; dst = (bf16_t*)(W + W_PEER + (size_t)l * WP_SZ + WP_Q); K = 1024; N = 2048; Npad = 2048; }
}
__device__ __forceinline__ int colmap(int mode, int n, int N) {
    if (mode == 1) { if (n >= N) return -1; if (n < C_KR) return n; const int m = n - C_KR; return C_KR + (m >> 1) + 32 * (m & 1); }
    if (mode == 2) { if (n < 1024) return (n >> 7) * 192 + (n & 127); const int m = n - 1024, h = m >> 6, mm = m & 63; return h * 192 + 128 + (mm >> 1) + 32 * (mm & 1); }
    return n;
}
__device__ __forceinline__ void phase_prologue(const Args& A, LAS unsigned char* lds) {
    const int tid = otid();
    {
        LAS float* tile = (LAS float*)lds;
        int item = blockIdx.x;
        for (int j = 0; j < 16; ++j) {
            const float* src; bf16_t* dst; int K, N, Npad, mode; const float* ks; tjob(j, A, src, dst, K, N, Npad, mode, ks);
            const int tk = K / 64, tn = Npad / 64, nt = tk * tn;
            for (; item < nt; item += gridDim.x) {
                const int k0 = (item % tk) * 64, n0 = (item / tk) * 64;
                { const int k = tid >> 3, cg = tid & 7; const float sc = ks ? ks[k0 + k] : 1.f;
#pragma unroll
                  for (int jj = 0; jj < 8; ++jj) { const int oc = colmap(mode, n0 + 8 * cg + jj, N); tile[k * 65 + 8 * cg + jj] = oc >= 0 ? src[(size_t)(k0 + k) * N + oc] * sc : 0.f; } }
                __syncthreads();
                { const int n = tid >> 3, kg = tid & 7; float v[8];
#pragma unroll
                  for (int jj = 0; jj < 8; ++jj) v[jj] = tile[(8 * kg + jj) * 65 + n];
                  u32x4 w; w.x = cvt_pk_bf16(v[0], v[1]); w.y = cvt_pk_bf16(v[2], v[3]); w.z = cvt_pk_bf16(v[4], v[5]); w.w = cvt_pk_bf16(v[6], v[7]);
                  *(u32x4*)(dst + (size_t)(n0 + n) * K + k0 + 8 * kg) = w; }
                __syncthreads();
            }
            item -= nt;
        }
    }
    {
        const int gthr = blockIdx.x * NTHR + tid, nthr = gridDim.x * NTHR;
        for (int p = gthr; p < 10 * 16384; p += nthr) {
            const int mat = p >> 14, off = (p & 16383) * 8; const float* src; bf16_t* dst;
            if (mat < 2)      { src = A.in[I_GWS] + (size_t)mat * 131072; dst = (bf16_t*)(A.ws + WS_W + W_GM + (size_t)mat * WG_SZ + WG_WS); }
            else if (mat < 6) { src = A.in[I_PK1] + (size_t)(mat - 2) * 131072; dst = (bf16_t*)(A.ws + WS_W + W_PEER + (size_t)(mat - 2) * WP_SZ + WP_K1); }
            else              { src = A.in[I_PK2] + (size_t)(mat - 6) * 131072; dst = (bf16_t*)(A.ws + WS_W + W_PEER + (size_t)(mat - 6) * WP_SZ + WP_K2); }
            const f32x4 a = *(const f32x4*)(src + off), b = *(const f32x4*)(src + off + 4);
            u32x4 w; w.x = cvt_pk_bf16(a[0], a[1]); w.y = cvt_pk_bf16(a[2], a[3]); w.z = cvt_pk_bf16(b[0], b[1]); w.w = cvt_pk_bf16(b[2], b[3]);
            *(u32x4*)(dst + off) = w;
        }
        float* rope = (float*)(A.ws + WS_ROPE);
        for (int p = gthr; p < SEQ * 32; p += nthr) { const int l = p >> 5, i = p & 31; const float pos = (float)(i < 16 ? (l >> 6) : (l & 63));
            const float inv = powf(10000.f, -(float)(i & 15) / 16.f), ang = pos * inv; rope[p] = cosf(ang); rope[SEQ * 32 + p] = sinf(ang); }
    }
    {
        LAS float* scond = (LAS float*)lds;
        LAS float* red = scond + 5 * 1024;
        __syncthreads();
        for (int i = tid; i < 5 * 1024; i += NTHR) { const int m = i >> 10, k = i & 1023; const float c = m < 4 ? A.in[I_C][m * 1024 + k] : A.in[I_CCTX][k]; scond[i] = silu_f(c); }
        __syncthreads();
        float* MOD = (float*)(A.ws + WS_MOD);
        for (int item = blockIdx.x; item < 4 * 48; item += gridDim.x) {
            const int layer = item / 48, j0 = (item % 48) * 128; const int c4 = tid & 31, ksl = tid >> 5;
            f32x4 acc[5];
#pragma unroll
            for (int m = 0; m < 5; ++m) acc[m] = (f32x4){0.f, 0.f, 0.f, 0.f};
            const float* wp = A.in[I_ADAW] + ((size_t)layer * 1024 + ksl * 64) * 6144 + j0 + 4 * c4;
            for (int k = 0; k < 64; ++k) { const f32x4 w = *(const f32x4*)(wp + (size_t)k * 6144);
#pragma unroll
                for (int m = 0; m < 5; ++m) acc[m] += w * scond[m * 1024 + ksl * 64 + k]; }
#pragma unroll
            for (int m = 0; m < 5; ++m) *(LAS f32x4*)(red + (ksl * 5 + m) * 128 + 4 * c4) = acc[m];
            __syncthreads();
            for (int i = tid; i < 640; i += NTHR) { const int m = i >> 7, c = i & 127; float s = A.in[I_ADAB][layer * 6144 + j0 + c];
#pragma unroll
                for (int q = 0; q < 16; ++q) s += red[(q * 5 + m) * 128 + c];
                MOD[((size_t)layer * 5 + m) * 6144 + j0 + c] = s; }
            __syncthreads();
        }
    }
}

__device__ __forceinline__ void phase_norm_mod(const float* xl, const float* xc, float* cl, float* cc, const float* g, const float* modl, int sh_idx, bf16_t* H, int nrows) {
    const int tid_ = otid(); const int lane = tid_ & 63, gw = blockIdx.x * 8 + (tid_ >> 6), nw = gridDim.x * 8;
    f32x4 gv[4];
#pragma unroll
    for (int i = 0; i < 4; ++i) gv[i] = *(const f32x4*)(g + 256 * i + 4 * lane);
    for (int r = gw; r < nrows; r += nw) {
        const bool lat = r < NLAT; const float* xp = lat ? xl + (size_t)r * D : xc + (size_t)(r - NLAT) * D;
        f32x4 x[4]; float ss = 0.f;
#pragma unroll
        for (int i = 0; i < 4; ++i) { x[i] = *(const f32x4*)(xp + 256 * i + 4 * lane); ss += x[i][0] * x[i][0] + x[i][1] * x[i][1] + x[i][2] * x[i][2] + x[i][3] * x[i][3]; }
        if (cl) { float* cp = lat ? cl + (size_t)r * D : cc + (size_t)(r - NLAT) * D;
#pragma unroll
            for (int i = 0; i < 4; ++i) *(f32x4*)(cp + 256 * i + 4 * lane) = x[i]; }
        ss = wave_sum(ss); const float rstd = rsqrtf(ss * (1.f / 1024.f) + EPS);
        const float* mp = modl + (size_t)(lat ? (r >> 13) : 4) * 6144 + sh_idx * 1024;
#pragma unroll
        for (int i = 0; i < 4; ++i) { const f32x4 sh = *(const f32x4*)(mp + 256 * i + 4 * lane), sc = *(const f32x4*)(mp + 1024 + 256 * i + 4 * lane);
            const f32x4 hv = (x[i] * rstd) * gv[i] * (sc + 1.f) + sh;
            u32x2 w; w.x = cvt_pk_bf16(hv[0], hv[1]); w.y = cvt_pk_bf16(hv[2], hv[3]);
            *(u32x2*)(H + (size_t)r * D + 256 * i + 4 * lane) = w; }
    }
}
__device__ __forceinline__ void phase_final_norm(float* xl, const float* g) {
    const int tid_ = otid(); const int lane = tid_ & 63, gw = blockIdx.x * 8 + (tid_ >> 6), nw = gridDim.x * 8;
    f32x4 gv[4];
#pragma unroll
    for (int i = 0; i < 4; ++i) gv[i] = *(const f32x4*)(g + 256 * i + 4 * lane);
    for (int r = gw; r < NLAT; r += nw) {
        float* xp = xl + (size_t)r * D; f32x4 x[4]; float ss = 0.f;
#pragma unroll
        for (int i = 0; i < 4; ++i) { x[i] = *(const f32x4*)(xp + 256 * i + 4 * lane); ss += x[i][0] * x[i][0] + x[i][1] * x[i][1] + x[i][2] * x[i][2] + x[i][3] * x[i][3]; }
        ss = wave_sum(ss); const float rstd = rsqrtf(ss * (1.f / 1024.f) + EPS);
#pragma unroll
        for (int i = 0; i < 4; ++i) *(f32x4*)(xp + 256 * i + 4 * lane) = (x[i] * rstd) * gv[i];
    }
}

__device__ __forceinline__ void phase_conv(const Args& A, int li) {
    const bf16_t* PROJ = (const bf16_t*)(A.ws + WS_BIG);
    bf16_t* XS = (bf16_t*)(A.ws + WS_R2); bf16_t* BC = (bf16_t*)(A.ws + WS_R2 + R2_BC);
    const int tid = otid();
    if (tid < 384) {
        const int cg = tid % 192, half = tid / 192, c0 = 8 * cg;
        const float* cw = A.in[I_CONVW] + ((size_t)li * 1536 + c0) * 5; const float* cb = A.in[I_CONVB] + (size_t)li * 1536 + c0;
        float w[8][5], bia[8];
#pragma unroll
        for (int j = 0; j < 8; ++j) { bia[j] = cb[j];
#pragma unroll
            for (int k = 0; k < 5; ++k) w[j][k] = cw[j * 5 + k]; }
        for (int blk = blockIdx.x; blk < NROW / 64; blk += gridDim.x) {
            const int rbeg = blk * 64 + half * 32; int s0, s1;
            if (rbeg < NLAT) { s0 = rbeg & ~8191; s1 = s0 + 8192; } else { s0 = NLAT + ((rbeg - NLAT) & ~255); s1 = s0 + 256; }
            float win[5][8];
#define CONV_LD(dst, r) do { const int r_ = (r); if (r_ >= s0 && r_ < s1) { const u32x4 v_ = *(const u32x4*)(PROJ + (size_t)r_ * HYB_INP + C_XBC + c0); \
                _Pragma("unroll") for (int q_ = 0; q_ < 4; ++q_) { dst[2 * q_] = bflo(v_[q_]); dst[2 * q_ + 1] = bfhi(v_[q_]); } } \
                else { _Pragma("unroll") for (int q_ = 0; q_ < 8; ++q_) dst[q_] = 0.f; } } while (0)
            CONV_LD(win[0], rbeg - 2); CONV_LD(win[1], rbeg - 1); CONV_LD(win[2], rbeg); CONV_LD(win[3], rbeg + 1); CONV_LD(win[4], rbeg + 2);
            for (int r = rbeg; r < rbeg + 32; ++r) {
                float o[8];
#pragma unroll
                for (int j = 0; j < 8; ++j) { float s = bia[j];
#pragma unroll
                    for (int k = 0; k < 5; ++k) s += w[j][k] * win[k][j];
                    o[j] = silu_f(s); }
                u32x4 pk; pk.x = cvt_pk_bf16(o[0], o[1]); pk.y = cvt_pk_bf16(o[2], o[3]); pk.z = cvt_pk_bf16(o[4], o[5]); pk.w = cvt_pk_bf16(o[6], o[7]);
                if (c0 < 1024) *(u32x4*)(XS + (size_t)r * 1024 + c0) = pk; else *(u32x4*)(BC + (size_t)r * 512 + (c0 - 1024)) = pk;
#pragma unroll
                for (int k = 0; k < 4; ++k)
#pragma unroll
                    for (int j = 0; j < 8; ++j) win[k][j] = win[k + 1][j];
                CONV_LD(win[4], r + 3);
            }
#undef CONV_LD
        }
    }
    {
        const int lane = tid & 63, gw = blockIdx.x * 8 + (tid >> 6), nw = gridDim.x * 8;
        float* DT = (float*)(A.ws + WS_BIG + BIG_DT); float* RQ = (float*)(A.ws + WS_RSTD); float* RKV = RQ + NROW;
        unsigned char* KR = A.ws + WS_BIG + BIG_KR; const float* rope = (const float*)(A.ws + WS_ROPE);
        const float dtb = lane < 32 ? A.in[I_DTB][li * 32 + lane] : 0.f;
        for (int r = gw; r < NROW; r += nw) {
            const bf16_t* p = PROJ + (size_t)r * HYB_INP;
            if (lane < 32) DT[(size_t)r * 32 + lane] = softplus_f(bf2f(p[C_DT + (lane & 15)]) + dtb);
            { const unsigned* q = (const unsigned*)(p + C_CQ + 6 * lane); float ss = 0.f;
#pragma unroll
              for (int j = 0; j < 3; ++j) { const unsigned w = q[j]; const float a = bflo(w), b = bfhi(w); ss += a * a + b * b; }
              ss = wave_sum(ss); if (lane == 0) RQ[r] = rsqrtf(ss * (1.f / 384.f) + EPS); }
            { const u32x2 w = *(const u32x2*)(p + C_CKV + 4 * lane); const float a = bflo(w.x), b = bfhi(w.x), c = bflo(w.y), d = bfhi(w.y);
              float ss = a * a + b * b + c * c + d * d; ss = wave_sum(ss); if (lane == 0) RKV[r] = rsqrtf(ss * (1.f / 256.f) + EPS); }
            if (lane < 32) { const unsigned w = *(const unsigned*)(p + C_KR + 2 * lane); float x1 = bflo(w), x2 = bfhi(w); int b, key;
                if (r < NLAT) { const int l = r & 8191; const float c = rope[l * 32 + lane], s = rope[SEQ * 32 + l * 32 + lane];
                    const float o1 = x1 * c - x2 * s, o2 = x1 * s + x2 * c; x1 = o1; x2 = o2; b = r >> 13; key = 256 + l; }
                else { b = (r - NLAT) >> 8; key = (r - NLAT) & 255; }
                *(unsigned*)(KR + (size_t)(b * NKT + (key >> 6)) * 8192 + KRSWZ(key & 63, 4 * lane)) = cvt_pk_bf16(x1, x2); }
        }
    }
}

struct EpiQ {
    static constexpr bool PERM = true;
    bf16_t* Q; const float* rstd; const float* rope;
    __device__ __forceinline__ void operator()(const f32x4 (&acc)[2][2][4][2], const pg8::Unit& u, int wr, int wc, int fr, int fq) const {
        const bool lat = u.pm < 128;
        const int b = lat ? (u.pm >> 5) : ((u.pm - 128) >> 0), q0 = lat ? 256 + ((u.pm & 31) << 8) : 0;
        const bool isrope = u.pn >= 4;
#pragma unroll
        for (int ai = 0; ai < 2; ++ai) {
            const int rl = 128 * ai + 64 * wr + fr;
            const float* rsp = rstd + u.pm * 256 + rl;
            const float* rp = rope + (size_t)(((u.pm & 31) << 8) + rl) * 32;
#pragma unroll
            for (int bj = 0; bj < 2; ++bj) {
                const int c0 = u.pn * 256 + 128 * bj + 32 * wc + 8 * fq; int h, dcol;
                if (!isrope) { h = c0 >> 7; dcol = c0 & 127; } else { const int mq = c0 - 1024; h = mq >> 6; dcol = 128 + (mq & 63); }
                bf16_t* dst = Q + ((size_t)(b * 8 + h) * NKEY + q0 + rl) * 192 + dcol;
                const int ro = (dcol - 128) >> 1;
#pragma unroll
                for (int m = 0; m < 4; ++m) {
                    const float rs = rsp[16 * m] * QSCALE;
                    f32x4 v0 = acc[ai][bj][m][0] * rs, v1 = acc[ai][bj][m][1] * rs;
                    if (isrope && lat) { const f32x4 cs = *(const f32x4*)(rp + 16 * m * 32 + ro), sn = *(const f32x4*)(rp + SEQ * 32 + 16 * m * 32 + ro);
                        const f32x4 a0 = v0, a1 = v1;
                        v0[0] = a0[0] * cs[0] - a0[1] * sn[0]; v0[1] = a0[0] * sn[0] + a0[1] * cs[0]; v0[2] = a0[2] * cs[1] - a0[3] * sn[1]; v0[3] = a0[2] * sn[1] + a0[3] * cs[1];
                        v1[0] = a1[0] * cs[2] - a1[1] * sn[2]; v1[1] = a1[0] * sn[2] + a1[1] * cs[2]; v1[2] = a1[2] * cs[3] - a1[3] * sn[3]; v1[3] = a1[2] * sn[3] + a1[3] * cs[3]; }
                    u32x4 w; w.x = cvt_pk_bf16(v0[0], v0[1]); w.y = cvt_pk_bf16(v0[2], v0[3]); w.z = cvt_pk_bf16(v1[0], v1[1]); w.w = cvt_pk_bf16(v1[2], v1[3]);
                    *(u32x4*)(dst + 16 * m * 192) = w;
                    asm volatile("" ::: "memory");
                }
            }
        }
    }
};
struct EpiKV {
    static constexpr bool PERM = true;
    unsigned char* KN; unsigned char* V; const float* rstd;
    __device__ __forceinline__ void operator()(const f32x4 (&acc)[2][2][4][2], const pg8::Unit& u, int wr, int wc, int fr, int fq) const {
        const bool lat = u.pm < 128;
        const int b = lat ? (u.pm >> 5) : (u.pm - 128), t0 = lat ? 4 + ((u.pm & 31) << 2) : 0;
        const int dd = 32 * wc + 8 * fq;
        const int offK = fr * 256 + ((dd * 2) ^ ((fr & 7) << 4));
        const int offV = att::v_st(fr, dd);
#pragma unroll
        for (int ai = 0; ai < 2; ++ai) {
            const size_t tb = ((size_t)(b * 8 + u.pn) * NKT + t0 + 2 * ai + wr) * 16384;
            const float* rsp = rstd + u.pm * 256 + 128 * ai + 64 * wr + fr;
            unsigned char* kp = KN + tb + offK; unsigned char* vp = V + tb + offV;
#pragma unroll
            for (int m = 0; m < 4; ++m) {
                const float rs = rsp[16 * m];
#pragma unroll
                for (int bj = 0; bj < 2; ++bj) {
                    const f32x4 v0 = acc[ai][bj][m][0] * rs, v1 = acc[ai][bj][m][1] * rs;
                    u32x4 w; w.x = cvt_pk_bf16(v0[0], v0[1]); w.y = cvt_pk_bf16(v0[2], v0[3]); w.z = cvt_pk_bf16(v1[0], v1[1]); w.w = cvt_pk_bf16(v1[2], v1[3]);
                    if (bj == 0) *(u32x4*)(kp + m * 4096) = w; else *(u32x4*)(vp + m * 4096) = w;
                }
                asm volatile("" ::: "memory");
            }
        }
    }
};

__device__ __forceinline__ void phase_ssd_out(const Args& A, int li, int nrows) {
    const bf16_t* PROJ = (const bf16_t*)(A.ws + WS_BIG); const bf16_t* XS = (const bf16_t*)(A.ws + WS_R2);
    const bf16_t* Y0 = (const bf16_t*)(A.ws + WS_H); const bf16_t* Y1 = (const bf16_t*)(A.ws + WS_R3); bf16_t* CAT = (bf16_t*)(A.ws + WS_R3 + R3_CAT);
    const int tid_ = otid(); const int lane = tid_ & 63, gw = blockIdx.x * 8 + (tid_ >> 6), nw = gridDim.x * 8;
    const float dsk = A.in[I_SSDD][li * 16 + (lane >> 2)];
    float ng[16];
#pragma unroll
    for (int j = 0; j < 16; ++j) ng[j] = A.in[I_SSDNG][li * 1024 + 16 * lane + j];
    for (int r = gw; r < nrows; r += nw) {
        float v[16]; float ss = 0.f;
#pragma unroll
        for (int hh = 0; hh < 2; ++hh) {
            const u32x4 a = *(const u32x4*)(Y0 + (size_t)r * 1024 + 16 * lane + 8 * hh), b = *(const u32x4*)(Y1 + (size_t)r * 1024 + 16 * lane + 8 * hh);
            const u32x4 x = *(const u32x4*)(XS + (size_t)r * 1024 + 16 * lane + 8 * hh), z = *(const u32x4*)(PROJ + (size_t)r * HYB_INP + 16 * lane + 8 * hh);
#pragma unroll
            for (int q = 0; q < 4; ++q) {
                const float y0 = (bflo(a[q]) + bflo(b[q]) + dsk * bflo(x[q])) * silu_f(bflo(z[q])), y1 = (bfhi(a[q]) + bfhi(b[q]) + dsk * bfhi(x[q])) * silu_f(bfhi(z[q]));
                v[8 * hh + 2 * q] = y0; v[8 * hh + 2 * q + 1] = y1; ss += y0 * y0 + y1 * y1; }
        }
#pragma unroll
        for (int o = 16; o >= 1; o >>= 1) ss += __shfl_xor(ss, o);
        const float rstd = rsqrtf(ss * (1.f / 512.f) + EPS);
#pragma unroll
        for (int hh = 0; hh < 2; ++hh) { u32x4 w;
#pragma unroll
            for (int q = 0; q < 4; ++q) w[q] = cvt_pk_bf16(v[8 * hh + 2 * q] * rstd * ng[8 * hh + 2 * q], v[8 * hh + 2 * q + 1] * rstd * ng[8 * hh + 2 * q + 1]);
            *(u32x4*)(CAT + (size_t)r * 2048 + 16 * lane + 8 * hh) = w; }
    }
}

__device__ __forceinline__ void phase_ln_stats(const Args& A, int nrows) {
    const bf16_t* Gb = (const bf16_t*)(A.ws + WS_BIG); float* ST = (float*)(A.ws + WS_RSTD);
    const int tid_ = otid(); const int lane = tid_ & 63, gw = blockIdx.x * 8 + (tid_ >> 6), nw = gridDim.x * 8;
    for (int r = gw; r < nrows; r += nw) {
        float v[32]; float s = 0.f;
#pragma unroll
        for (int j = 0; j < 4; ++j) { const u32x4 w = *(const u32x4*)(Gb + (size_t)r * 4096 + 2048 + 512 * j + 8 * lane);
#pragma unroll
            for (int q = 0; q < 4; ++q) { v[8 * j + 2 * q] = bflo(w[q]); v[8 * j + 2 * q + 1] = bfhi(w[q]); s += v[8 * j + 2 * q] + v[8 * j + 2 * q + 1]; } }
        s = wave_sum(s); const float mu = s * (1.f / 2048.f); float q2 = 0.f;
#pragma unroll
        for (int j = 0; j < 32; ++j) { const float dd = v[j] - mu; q2 += dd * dd; }
        q2 = wave_sum(q2);
        if (lane == 0) { ST[r] = mu; ST[NROW + r] = rsqrtf(q2 * (1.f / 2048.f) + EPS); }
    }
}
__device__ __forceinline__ void phase_spatial(const Args& A, int gi, int nrows, LAS unsigned char* lds) {
    const bf16_t* Gb = (const bf16_t*)(A.ws + WS_BIG); const float* ST = (const float*)(A.ws + WS_RSTD); bf16_t* Ab = (bf16_t*)(A.ws + WS_R1);
    const bf16_t* WSg = (const bf16_t*)(A.ws + WS_W + W_GM + (size_t)gi * WG_SZ + WG_WS);
    const float* lng = A.in[I_GLNG] + (size_t)gi * 2048; const float* lnb = A.in[I_GLNB] + (size_t)gi * 2048; const float* bs = A.in[I_GBS] + (size_t)gi * 1024;
    const int tid = otid(), wid = tid >> 6, lane = tid & 63, r32 = lane & 31, hi = lane >> 5, tb = wid & 3, dh = wid >> 2;
    const int ldsaddr = (int)(unsigned)(uintptr_t)lds;
    for (int unit = blockIdx.x; unit < (nrows / 128) * 8; unit += gridDim.x) {
        const int cb = unit >> 3, gg = unit & 7, r0 = cb * 128;
        __syncthreads();
#pragma unroll
        for (int j = 0; j < 8; ++j) { const int idx = tid + 512 * j, s = idx >> 5, dd = (idx & 31) * 8;
            const u32x4 w = *(const u32x4*)(Gb + (size_t)(r0 + s) * 4096 + 2048 + 256 * gg + dd);
            const float mu = ST[r0 + s], rs = ST[NROW + r0 + s];
            const f32x4 g0 = *(const f32x4*)(lng + 256 * gg + dd), g1 = *(const f32x4*)(lng + 256 * gg + dd + 4), b0 = *(const f32x4*)(lnb + 256 * gg + dd), b1 = *(const f32x4*)(lnb + 256 * gg + dd + 4);
            u32x4 o;
            o.x = cvt_pk_bf16((bflo(w.x) - mu) * rs * g0[0] + b0[0], (bfhi(w.x) - mu) * rs * g0[1] + b0[1]); o.y = cvt_pk_bf16((bflo(w.y) - mu) * rs * g0[2] + b0[2], (bfhi(w.y) - mu) * rs * g0[3] + b0[3]);
            o.z = cvt_pk_bf16((bflo(w.z) - mu) * rs * g1[0] + b1[0], (bfhi(w.z) - mu) * rs * g1[1] + b1[1]); o.w = cvt_pk_bf16((bflo(w.w) - mu) * rs * g1[2] + b1[2], (bfhi(w.w) - mu) * rs * g1[3] + b1[3]);
            *(LAS u32x4*)(lds + ((s >> 6) * 2 + (dd >> 7)) * 16384 + att::v_st(s & 63, dd & 127)) = o; }
        bf16x8 pa[8];
#pragma unroll
        for (int ks = 0; ks < 8; ++ks) pa[ks] = *(const bf16x8*)(WSg + ((size_t)gg * 128 + 32 * tb + r32) * 128 + 16 * ks + 8 * hi);
        __syncthreads();
        f32x16 o[4] = {};
        att::pv_d0(o, ldsaddr + (0 * 2 + dh) * 16384 + att::v_rd_base(lane), pa[0], pa[1], pa[2], pa[3]);
        att::pv_d0(o, ldsaddr + (1 * 2 + dh) * 16384 + att::v_rd_base(lane), pa[4], pa[5], pa[6], pa[7]);
#pragma unroll
        for (int r = 0; r < 16; ++r) { const int t = 32 * tb + att::crow(r, hi), row = r0 + t; const float bsv = bs[gg * 128 + t];
#pragma unroll
            for (int d0 = 0; d0 < 4; ++d0) { const int col = 256 * gg + 128 * dh + 32 * d0 + r32;
                Ab[(size_t)row * 2048 + col] = f2bf(bf2f(Gb[(size_t)row * 4096 + col]) * (o[d0][r] + bsv)); } }
    }
}

__device__ __forceinline__ void phase_tabcvt(const Args& A, int layer) {
    const int gthr = blockIdx.x * NTHR + otid(), nthr = gridDim.x * NTHR;
    for (int p = gthr; p < 2 * NEXP * 128; p += nthr) {
        const int tab = p >> 21, rem = p & ((1 << 21) - 1), e = rem >> 7, p8 = rem & 127, x = p8 >> 4, m = p8 & 15;
        const float* src = (tab ? A.in[I_PV] : A.in[I_PU]) + ((size_t)layer * NEXP + e) * 1024 + 8 * p8;
        const f32x4 a = *(const f32x4*)src, b = *(const f32x4*)(src + 4);
        u32x4 w; w.x = cvt_pk_bf16(a[0], a[1]); w.y = cvt_pk_bf16(a[2], a[3]); w.z = cvt_pk_bf16(b[0], b[1]); w.w = cvt_pk_bf16(b[2], b[3]);
        *(u32x4*)(A.ws + WS_TAB + (size_t)tab * TAB_HALF + (((size_t)x * NEXP + e) * 128 + 8 * m) * 2) = w;
    }
}
#define CASD(a, b) do { const float hi_ = fmaxf(a, b), lo_ = fminf(a, b); a = hi_; b = lo_; } while (0)
__device__ __forceinline__ void sort16(float (&k)[16]) {
#pragma unroll
    for (int sz = 2; sz <= 16; sz <<= 1)
#pragma unroll
        for (int j = sz >> 1; j > 0; j >>= 1)
#pragma unroll
            for (int i = 0; i < 16; ++i) { const int l = i ^ j; if (l > i) { if ((i & sz) == 0 || sz == 16) CASD(k[i], k[l]); else CASD(k[l], k[i]); } }
}
__device__ __forceinline__ void bmerge16(float (&k)[16]) {
#pragma unroll
    for (int j = 8; j > 0; j >>= 1)
#pragma unroll
        for (int i = 0; i < 16; ++i) { const int l = i ^ j; if (l > i) CASD(k[i], k[l]); }
}
__device__ __forceinline__ void merge_top16(float (&a)[16], const float (&b)[16]) {
#pragma unroll
    for (int i = 0; i < 16; ++i) a[i] = fmaxf(a[i], b[15 - i]);
    bmerge16(a);
}
__device__ __forceinline__ void xmerge_top16(float (&a)[16], int mask) {
    float t[16];
#pragma unroll
    for (int i = 0; i < 16; ++i) t[i] = __shfl_xor(a[15 - i], mask);
#pragma unroll
    for (int i = 0; i < 16; ++i) a[i] = fmaxf(a[i], t[i]);
    bmerge16(a);
}
__device__ __forceinline__ void phase_topk(const Args& A, int layer, int nrows, LAS unsigned char* lds) {
    const bf16_t* QP = (const bf16_t*)(A.ws + WS_BIG); int* IDX = (int*)(A.ws + WS_R2); float* GATE = (float*)(A.ws + WS_R2 + R2_GATE);
    const int tid = otid(), wid = tid >> 6, lane = tid & 63, fr = lane & 15, fq = lane >> 4;
    LAS unsigned* scr = (LAS unsigned*)(lds + 2 * 34816) + wid * 512 + fr * 32;
    for (int unit = blockIdx.x; unit < (nrows / 128) * 8; unit += gridDim.x) {
        const int h = unit & 7, r0 = (unit >> 3) * 128;
        __syncthreads();
        { const bf16_t* k1 = (const bf16_t*)(A.ws + WS_W + W_PEER + (size_t)layer * WP_SZ + WP_K1) + (size_t)h * 16384;
#pragma unroll
          for (int j = 0; j < 8; ++j) { const int idx = tid + 512 * j, half = idx >> 11, rem = idx & 2047, key = rem >> 4, c8 = rem & 15;
              const u32x4 w = *(const u32x4*)(k1 + (size_t)half * 8 * 16384 + key * 128 + 8 * c8);
              *(LAS u32x4*)(lds + half * 34816 + key * 272 + c8 * 16) = w; } }
        __syncthreads();
        const int tok = r0 + 16 * wid + fr;
        float top[2][16];
#pragma unroll
        for (int half = 0; half < 2; ++half) {
            bf16x8 qf[4];
#pragma unroll
            for (int ks = 0; ks < 4; ++ks) qf[ks] = *(const bf16x8*)(QP + (size_t)tok * 2048 + 256 * h + 128 * half + 32 * ks + 8 * fq);
            float loc[16];
#pragma unroll
            for (int grp = 0; grp < 2; ++grp) {
                float kk[16];
#pragma unroll
                for (int nbb = 0; nbb < 4; ++nbb) { const int nb = 4 * grp + nbb; f32x4 acc = {0.f, 0.f, 0.f, 0.f};
#pragma unroll
                    for (int ks = 0; ks < 4; ++ks) { const bf16x8 kf = *(const LAS bf16x8*)(lds + half * 34816 + (16 * nb + fr) * 272 + (32 * ks + 8 * fq) * 2);
                        acc = __builtin_amdgcn_mfma_f32_16x16x32_bf16(kf, qf[ks], acc, 0, 0, 0); }
#pragma unroll
                    for (int i = 0; i < 4; ++i) { const unsigned code = 127u - (unsigned)(16 * nb + 4 * fq + i); kk[4 * nbb + i] = __uint_as_float((__float_as_uint(acc[i]) & ~127u) | code); } }
                sort16(kk);
                if (grp == 0) {
#pragma unroll
                    for (int i = 0; i < 16; ++i) loc[i] = kk[i];
                } else merge_top16(loc, kk);
            }
            xmerge_top16(loc, 16); xmerge_top16(loc, 32);
#pragma unroll
            for (int i = 0; i < 16; ++i) top[half][i] = loc[i];
        }
        if (fq < 2) {
#pragma unroll
            for (int i = 0; i < 16; ++i) scr[16 * fq + i] = __float_as_uint(fq == 0 ? top[0][i] : top[1][i]); }
        float fin[16];
#pragma unroll
        for (int aa = 0; aa < 4; ++aa) {
            const float va_k = fq == 0 ? top[0][aa] : fq == 1 ? top[0][4 + aa] : fq == 2 ? top[0][8 + aa] : top[0][12 + aa];
            const float va = __uint_as_float(__float_as_uint(va_k) & ~127u);
            float c[16];
#pragma unroll
            for (int bb = 0; bb < 16; ++bb) { const float s = va + __uint_as_float(__float_as_uint(top[1][bb]) & ~127u);
                c[bb] = __uint_as_float((__float_as_uint(s) & ~255u) | (255u - (unsigned)((4 * fq + aa) * 16 + bb))); }
            if (aa == 0) {
#pragma unroll
                for (int i = 0; i < 16; ++i) fin[i] = c[i];
            } else merge_top16(fin, c);
        }
        xmerge_top16(fin, 16); xmerge_top16(fin, 32);
        float ev[16], es = 0.f; const float mx = __uint_as_float(__float_as_uint(fin[0]) & ~255u);
#pragma unroll
        for (int i = 0; i < 16; ++i) { ev[i] = __expf(__uint_as_float(__float_as_uint(fin[i]) & ~255u) - mx); es += ev[i]; }
        const float inv = 1.f / es;
        asm volatile("s_waitcnt lgkmcnt(0)" ::: "memory");
        int oi[4]; float og[4];
#pragma unroll
        for (int kq = 0; kq < 4; ++kq) {
            const float fk = fq == 0 ? fin[kq] : fq == 1 ? fin[4 + kq] : fq == 2 ? fin[8 + kq] : fin[12 + kq];
            const float fe = fq == 0 ? ev[kq] : fq == 1 ? ev[4 + kq] : fq == 2 ? ev[8 + kq] : ev[12 + kq];
            const unsigned code = 255u - (__float_as_uint(fk) & 255u), a = code >> 4, bq = code & 15u;
            const unsigned i1 = 127u - (scr[a] & 127u), i2 = 127u - (scr[16 + bq] & 127u);
            oi[kq] = (int)(i1 * 128u + i2); og[kq] = fe * inv; }
        *(int4*)(IDX + (size_t)tok * 128 + 16 * h + 4 * fq) = make_int4(oi[0], oi[1], oi[2], oi[3]);
        *(f32x4*)(GATE + (size_t)tok * 128 + 16 * h + 4 * fq) = (f32x4){og[0], og[1], og[2], og[3]};
    }
}
template <class F>
__device__ __forceinline__ void peer_queue_loop(const Args& A, int layer, int phsel, int nrows, LAS unsigned char* smem, F body) {
    unsigned* ctl = (unsigned*)(A.ws + WS_CTL); const int x0 = (int)(xb_xcc_id() & 7u), nblk = nrows / 64;
    LAS unsigned* bcw = (LAS unsigned*)(smem + 16);
    for (int sl = 0; sl < 8; ++sl) { const int x = (x0 + sl) & 7; unsigned* q = ctl + CW_QUEUE + ((layer * 2 + phsel) * 8 + x) * 32;
        for (;;) { __syncthreads(); if (threadIdx.x == 0) *bcw = atomicAdd(q, 1u); __syncthreads(); const int blk = (int)*bcw; if (blk >= nblk) break; body(x, blk); } }
}
__device__ __forceinline__ void phase_peer_u(const Args& A, int layer, int nrows, LAS unsigned char* smem) {
    const bf16_t* H = (const bf16_t*)(A.ws + WS_H); const int* IDX = (const int*)(A.ws + WS_R2); float* PART = (float*)(A.ws + WS_BIG + BIG_PART);
    const bf16_t* U = (const bf16_t*)(A.ws + WS_TAB);
    const int tid_ = otid(); const int wid = tid_ >> 6, lane = tid_ & 63, m = lane & 15, q = lane >> 4;
    peer_queue_loop(A, layer, 0, nrows, smem, [&](int x, int blk) {
        for (int ti = 0; ti < 8; ++ti) {
            const int tok = blk * 64 + wid * 8 + ti;
            const u32x4 hv = *(const u32x4*)(H + (size_t)tok * 1024 + 128 * x + 8 * m);
            float hf[8];
#pragma unroll
            for (int j = 0; j < 4; ++j) { hf[2 * j] = bflo(hv[j]); hf[2 * j + 1] = bfhi(hv[j]); }
            const int* ip = IDX + (size_t)tok * 128 + q; const bf16_t* ub = U + (size_t)x * NEXP * 128 + 8 * m;
            float res0 = 0.f, res1 = 0.f;
#pragma unroll 8
            for (int i = 0; i < 32; ++i) {
                const int e = ip[4 * i]; const u32x4 uv = *(const u32x4*)(ub + (size_t)e * 128);
                float d = 0.f;
#pragma unroll
                for (int j = 0; j < 4; ++j) d += hf[2 * j] * bflo(uv[j]) + hf[2 * j + 1] * bfhi(uv[j]);
                d += __shfl_xor(d, 1); d += __shfl_xor(d, 2); d += __shfl_xor(d, 4); d += __shfl_xor(d, 8);
                if (m == (i & 15)) { if (i < 16) res0 = d; else res1 = d; }
            }
            float* pp = PART + ((size_t)x * NROW + tok) * 128 + q;
            pp[4 * m] = res0; pp[4 * (m + 16)] = res1;
        }
    });
}
__device__ __forceinline__ void phase_coef(const Args& A, int nrows) {
    const float* PART = (const float*)(A.ws + WS_BIG + BIG_PART); const float* GATE = (const float*)(A.ws + WS_R2 + R2_GATE); float* COEF = (float*)(A.ws + WS_R2 + R2_COEF);
    const int gthr = blockIdx.x * NTHR + otid(), nthr = gridDim.x * NTHR;
    for (int p = gthr; p < nrows * 128; p += nthr) { float s = 0.f;
#pragma unroll
        for (int x = 0; x < 8; ++x) s += PART[(size_t)x * NROW * 128 + p];
        COEF[p] = GATE[p] * gelu_f(s); }
}
__device__ __forceinline__ void phase_peer_v(const Args& A, int layer, int nrows, LAS unsigned char* smem) {
    const int* IDX = (const int*)(A.ws + WS_R2); const float* COEF = (const float*)(A.ws + WS_R2 + R2_COEF);
    const bf16_t* V = (const bf16_t*)(A.ws + WS_TAB + TAB_HALF); const float* MODL = (const float*)(A.ws + WS_MOD) + (size_t)layer * 5 * 6144 + 5 * 1024;
    float* XC = (float*)(A.ws + WS_XC);
    const int tid_ = otid(); const int wid = tid_ >> 6, lane = tid_ & 63, m = lane & 15, q = lane >> 4;
    peer_queue_loop(A, layer, 1, nrows, smem, [&](int x, int blk) {
        for (int ti = 0; ti < 8; ++ti) {
            const int tok = blk * 64 + wid * 8 + ti;
            const int* ip = IDX + (size_t)tok * 128 + q; const float* cp = COEF + (size_t)tok * 128 + q; const bf16_t* vb = V + (size_t)x * NEXP * 128 + 8 * m;
            float acc[8];
#pragma unroll
            for (int j = 0; j < 8; ++j) acc[j] = 0.f;
#pragma unroll 8
            for (int i = 0; i < 32; ++i) {
                const int e = ip[4 * i]; const float c = cp[4 * i]; const u32x4 vv = *(const u32x4*)(vb + (size_t)e * 128);
#pragma unroll
                for (int j = 0; j < 4; ++j) { acc[2 * j] += c * bflo(vv[j]); acc[2 * j + 1] += c * bfhi(vv[j]); }
            }
#pragma unroll
            for (int j = 0; j < 8; ++j) { acc[j] += __shfl_xor(acc[j], 16); acc[j] += __shfl_xor(acc[j], 32); }
            if (q == 0) {
                const bool lat = tok < NLAT; float* xp = (lat ? A.out + (size_t)tok * D : XC + (size_t)(tok - NLAT) * D) + 128 * x + 8 * m;
                const float* gp = MODL + (size_t)(lat ? (tok >> 13) : 4) * 6144 + 128 * x + 8 * m;
                const f32x4 g0 = *(const f32x4*)gp, g1 = *(const f32x4*)(gp + 4); f32x4 x0 = *(f32x4*)xp, x1 = *(f32x4*)(xp + 4);
                x0 += g0 * (f32x4){acc[0], acc[1], acc[2], acc[3]}; x1 += g1 * (f32x4){acc[4], acc[5], acc[6], acc[7]};
                *(f32x4*)xp = x0; *(f32x4*)(xp + 4) = x1;
            }
        }
    });
}

#ifndef MK_PER_PHASE
#define MK_PER_PHASE 1
#endif
__device__ __forceinline__ int nr_in(int L) { return L <= 2 ? NROW : NLAT; }
__device__ __forceinline__ int nr_out(int L) { return L <= 1 ? NROW : NLAT; }

__global__ void __launch_bounds__(NTHR, 2) fwd(Args A) {
    extern __shared__ __attribute__((aligned(256))) unsigned char smem_raw[];
    LAS unsigned char* smem = (LAS unsigned char*)smem_raw;
    LAS unsigned char* lds = smem + LDS_BASE;
    const int tid = otid();
    if (tid < 64) ((LAS unsigned*)smem)[tid] = 0u;
    __syncthreads();
    XcdBarrier bar = xcd_barrier_post((unsigned*)(A.ws + WS_CTL), (volatile LAS unsigned*)smem);
    bool need_bar = false;
    const int lo = A.ph_lo, hi = A.ph_hi;
#ifndef PHMASK
#define PHMASK 0xffffffffu
#endif
#define SITE(k) if constexpr (((PHMASK) >> (k)) & 1u)
#define PH(id) if ([&]() -> bool { if ((id) < lo || (id) >= hi) return false; if (need_bar) xcd_barrier(bar); need_bar = true; return true; }())
    unsigned char* ws = A.ws;
    float* XL = A.out; float* XC = (float*)(ws + WS_XC);
    bf16_t* H = (bf16_t*)(ws + WS_H);
    const float* MOD = (const float*)(ws + WS_MOD);

    SITE(0) PH(0) { phase_prologue(A, lds); }
    SITE(1) PH(1) { phase_norm_mod(A.in[I_X], A.in[I_CTX], XL, XC, A.in[I_N1G], MOD, 0, H, NROW); }
    for (int L = 0; L < DEPTH; ++L) {
        const int base = 2 + 16 * L, li = L >> 1; const bool hyb = (L & 1) == 0;
        const float* MODL = MOD + (size_t)L * 5 * 6144;
        unsigned char* WH = ws + WS_W + W_HYB + (size_t)li * WH_SZ; unsigned char* WG = ws + WS_W + W_GM + (size_t)li * WG_SZ; unsigned char* WP = ws + WS_W + W_PEER + (size_t)L * WP_SZ;
        if (hyb) {
            SITE(2) PH(base + 0) { pg8::Gemm g{H, (const bf16_t*)(WH + WH_IN), nr_in(L), HYB_INP, 1024, 1024, 1024};
                pg8::EpiBf16<0> e{(bf16_t*)(ws + WS_BIG), HYB_INP}; pg8::gemm_phase(lds, g, e); }
            SITE(3) PH(base + 1) { phase_conv(A, li); }
            SITE(4) PH(base + 2) {
                SITE(18) { pg8::Gemm g{(const bf16_t*)(ws + WS_BIG) + C_CQ, (const bf16_t*)(WH + WH_QB), L == 0 ? NROW : NLAT, 1536, 384, HYB_INP, 384};
                  EpiQ e{(bf16_t*)(ws + WS_R1 + R1_Q), (const float*)(ws + WS_RSTD), (const float*)(ws + WS_ROPE)}; pg8::gemm_phase(lds, g, e); }
                SITE(19) { pg8::Gemm g{(const bf16_t*)(ws + WS_BIG) + C_CKV, (const bf16_t*)(WH + WH_KVB), NROW, 2048, 256, HYB_INP, 256};
                  EpiKV e{ws + WS_R1 + R1_KN, ws + WS_R1 + R1_V, (const float*)(ws + WS_RSTD) + NROW}; pg8::gemm_phase(lds, g, e); }
                SITE(20) for (int u = blockIdx.x; u < 528; u += gridDim.x) ssd::g_unit((const bf16_t*)(ws + WS_R2 + R2_BC), (bf16_t*)(ws + WS_BIG + BIG_G), u);
            }
            SITE(5) PH(base + 3) {
                SITE(21) for (int u = blockIdx.x; u < 256; u += gridDim.x)
                    ssd::ssd_unit(u, (const bf16_t*)(ws + WS_R2), (const bf16_t*)(ws + WS_R2 + R2_BC), (const float*)(ws + WS_BIG + BIG_DT), (const bf16_t*)(ws + WS_BIG + BIG_G),
                                  A.in[I_ALOG] + li * 32, (bf16_t*)(ws + WS_H), (bf16_t*)(ws + WS_R3), lds);
                const int nau = L == 0 ? 1024 + 32 : 1024;
                SITE(22) for (int au = blockIdx.x; au < nau; au += gridDim.x) {
                    int b, h, qrow0, orow0, nt;
                    if (au < 1024) { b = au >> 8; h = au & 7; const int qb = (au >> 3) & 31; qrow0 = 256 + 256 * qb; orow0 = b * 8192 + 256 * qb; nt = NKT; }
                    else { const int cu = au - 1024; b = cu >> 3; h = cu & 7; qrow0 = 0; orow0 = NLAT + 256 * b; nt = 4; }
                    const size_t bh = (size_t)(b * 8 + h);
                    att::attn_unit((const bf16_t*)(ws + WS_R1 + R1_Q) + (bh * NKEY + qrow0) * 192, ws + WS_R1 + R1_KN + bh * NKT * 16384, ws + WS_BIG + BIG_KR + (size_t)b * NKT * 8192,
                                   ws + WS_R1 + R1_V + bh * NKT * 16384, (bf16_t*)(ws + WS_R3 + R3_CAT) + (size_t)orow0 * 2048 + 1024 + 128 * h, nt, lds);
                }
            }
            SITE(6) PH(base + 4) { phase_ssd_out(A, li, nr_out(L)); }
        } else {
            SITE(7) PH(base + 0) { pg8::Gemm g{H, (const bf16_t*)(WG + WG_IN), nr_out(L), 4096, 1024, 1024, 1024};
                pg8::EpiBf16<1> e{(bf16_t*)(ws + WS_BIG), 4096}; pg8::gemm_phase(lds, g, e); }
            SITE(8) PH(base + 1) { phase_ln_stats(A, nr_out(L)); }
            SITE(9) PH(base + 2) { phase_spatial(A, li, nr_out(L), lds); }
        }
        SITE(10) PH(base + 5) { pg8::Gemm g{hyb ? (const bf16_t*)(ws + WS_R3 + R3_CAT) : (const bf16_t*)(ws + WS_R1), hyb ? (const bf16_t*)(WH + WH_OUT) : (const bf16_t*)(WG + WG_OUT), nr_out(L), 1024, 2048, 2048, 2048};
            pg8::EpiResid e{XL, XC, MODL + 2 * 1024}; pg8::gemm_phase(lds, g, e); }
        SITE(11) PH(base + 6) { phase_norm_mod(XL, XC, nullptr, nullptr, A.in[I_N2G] + L * 1024, MODL, 3, H, nr_out(L)); phase_tabcvt(A, L); }
        SITE(12) PH(base + 7) { pg8::Gemm g{H, (const bf16_t*)(WP + WP_Q), nr_out(L), 2048, 1024, 1024, 1024};
            pg8::EpiBf16<0> e{(bf16_t*)(ws + WS_BIG), 2048}; pg8::gemm_phase(lds, g, e); }
        SITE(13) PH(base + 8) { phase_topk(A, L, nr_out(L), lds); }
        SITE(14) PH(base + 9) { phase_peer_u(A, L, nr_out(L), smem); }
        SITE(15) PH(base + 10) { phase_coef(A, nr_out(L)); }
        SITE(16) PH(base + 11) { phase_peer_v(A, L, nr_out(L), smem); }
        SITE(17) PH(base + 12) { if (L < DEPTH - 1) phase_norm_mod(XL, XC, nullptr, nullptr, A.in[I_N1G] + (L + 1) * 1024, MOD + (size_t)(L + 1) * 5 * 6144, 0, H, nr_in(L + 1));
                        else phase_final_norm(XL, A.in[I_FNG]); }
    }
#undef PH
}

#ifdef MK_TAP
__global__ void tap_kernel(const unsigned short* buf, size_t pitch, size_t col0, size_t ncols, size_t nrows, float* out) {
    const size_t n = ncols * nrows;
    for (size_t i = (size_t)blockIdx.x * blockDim.x + threadIdx.x; i < (size_t)NLAT * D; i += (size_t)gridDim.x * blockDim.x) {
        float s = 0.f; for (size_t j = i; j < n; j += (size_t)NLAT * D) s += (float)buf[(j / ncols) * pitch + col0 + (j % ncols)]; out[i] = s; }
}
#endif
extern "C" void kernel_launch(void* const* d_in, const int* in_sizes, int n_in, void* d_out, int out_size, void* d_ws, size_t ws_size, hipStream_t stream) {
    static int grid = 0;
    if (grid == 0) {
        if (n_in != N_IN || out_size != NLAT * D || ws_size < WS_END) { fprintf(stderr, "kernel_launch: unexpected shapes (n_in %d out %d ws %zu, need %zu)\n", n_in, out_size, ws_size, (size_t)WS_END); grid = -1; return; }
        int dev = 0, cus = 0, per_cu = 0;
        if (hipGetDevice(&dev) != hipSuccess || hipDeviceGetAttribute(&cus, hipDeviceAttributeMultiprocessorCount, dev) != hipSuccess) { grid = -1; return; }
        if (hipFuncSetAttribute((const void*)fwd, hipFuncAttributeMaxDynamicSharedMemorySize, LDS_BYTES) != hipSuccess) { fprintf(stderr, "kernel_launch: hipFuncSetAttribute failed\n"); grid = -1; return; }
        if (hipOccupancyMaxActiveBlocksPerMultiprocessor(&per_cu, (const void*)fwd, NTHR, LDS_BYTES) != hipSuccess || per_cu < 1) { fprintf(stderr, "kernel_launch: occupancy query says %d\n", per_cu); }
        (void)hipGetLastError();
        grid = cus;
    }
    if (grid < 0) return;
    (void)hipMemsetAsync((char*)d_ws + WS_CTL, 0, CTL_BYTES, stream);
    Args a{};
    for (int i = 0; i < N_IN; ++i) a.in[i] = (const float*)d_in[i];
    a.out = (float*)d_out; a.ws = (unsigned char*)d_ws;
#if MK_PER_PHASE
    for (int id = 0; id < 2 + 16 * DEPTH; ++id) {
        if (id >= 2) { const int L = (id - 2) / 16, s = (id - 2) % 16; if (s > 12) continue; if ((L & 1) && (s == 3 || s == 4)) continue; }
#ifdef MK_CUT
#ifdef MK_TAP
        if (id >= MK_CUT) continue;
#else
        if (id >= MK_CUT && id != 2 + 16 * (DEPTH - 1) + 12) continue;
#endif
#endif
        a.ph_lo = id; a.ph_hi = id + 1;
        hipLaunchKernelGGL(fwd, dim3(grid), dim3(NTHR), LDS_BYTES, stream, a);
    }
#ifdef MK_TAP
    { const size_t tp[5] = {MK_TAP}; hipLaunchKernelGGL(tap_kernel, dim3(2048), dim3(256), 0, stream, (const unsigned short*)((const char*)d_ws + tp[0]), tp[1], tp[2], tp[3], tp[4], (float*)d_out); }
#endif
#else
    a.ph_lo = 0; a.ph_hi = 2 + 16 * DEPTH;
    hipLaunchKernelGGL(fwd, dim3(grid), dim3(NTHR), LDS_BYTES, stream, a);
#endif
    const hipError_t le = hipPeekAtLastError();
    if (le != hipSuccess) fprintf(stderr, "kernel_launch: launch failed: %s\n", hipGetErrorName(le));
}
```

```cpp
#include <hip/hip_runtime.h>
#include <cstdio>
#include <cstdint>

#define LAS __attribute__((address_space(3)))
typedef unsigned short bf16_t;
typedef short bf16x8 __attribute__((ext_vector_type(8)));
typedef short s16x4 __attribute__((ext_vector_type(4)));
typedef float f32x2 __attribute__((ext_vector_type(2)));
typedef float f32x4 __attribute__((ext_vector_type(4)));
typedef float f32x16 __attribute__((ext_vector_type(16)));
typedef unsigned u32x2 __attribute__((ext_vector_type(2)));
typedef unsigned u32x4 __attribute__((ext_vector_type(4)));

constexpr int D = 1024, NB = 4, SEQ = 8192, DEPTH = 4, CTXL = 256;
constexpr int NLAT = NB * SEQ, NCTX = NB * CTXL, NROW = NLAT + NCTX;
constexpr int HYB_IN = 3280, HYB_INP = 3328;
constexpr int C_Z = 0, C_XBC = 1024, C_DT = 2560, C_CQ = 2576, C_CKV = 2960, C_KR = 3216;
constexpr int NKEY = SEQ + CTXL, NKT = NKEY / 64;
constexpr float EPS = 1e-6f;
constexpr float QSCALE = 0.07216878364870322f * 1.4426950408889634f;
constexpr int NEXP = 16384;

enum { I_X = 0, I_C, I_CTX, I_CCTX, I_ADAW, I_ADAB, I_N1G, I_N2G, I_HWIN, I_CONVW, I_CONVB, I_ALOG, I_DTB, I_SSDD, I_SSDNG, I_QNG, I_WQB, I_KVNG, I_WKVB,
       I_HWOUT, I_GWIN, I_GLNG, I_GLNB, I_GWS, I_GBS, I_GWOUT, I_PWQ, I_PK1, I_PK2, I_PU, I_PV, I_FNG, N_IN };

constexpr size_t al256(size_t x) { return (x + 255) & ~(size_t)255; }
constexpr size_t WS_CTL = 0, CTL_BYTES = 65536;
constexpr size_t WS_MOD = WS_CTL + CTL_BYTES;
constexpr size_t WS_ROPE = WS_MOD + al256((size_t)DEPTH * 5 * 6144 * 4);
constexpr size_t WS_RSTD = WS_ROPE + (size_t)2 * SEQ * 32 * 4;
constexpr size_t WS_W = WS_RSTD + al256((size_t)2 * NROW * 4);
constexpr size_t W_HYB = 0;
constexpr size_t WH_IN = 0, WH_QB = WH_IN + (size_t)HYB_INP * 1024 * 2, WH_KVB = WH_QB + (size_t)1536 * 384 * 2, WH_OUT = WH_KVB + (size_t)2048 * 256 * 2,
                 WH_SZ = WH_OUT + (size_t)1024 * 2048 * 2;
constexpr size_t W_GM = W_HYB + 2 * WH_SZ;
constexpr size_t WG_IN = 0, WG_OUT = WG_IN + (size_t)4096 * 1024 * 2, WG_WS = WG_OUT + (size_t)1024 * 2048 * 2, WG_SZ = WG_WS + (size_t)8 * 128 * 128 * 2;
constexpr size_t W_PEER = W_GM + 2 * WG_SZ;
constexpr size_t WP_Q = 0, WP_K1 = WP_Q + (size_t)2048 * 1024 * 2, WP_K2 = WP_K1 + (size_t)8 * 128 * 128 * 2, WP_SZ = WP_K2 + (size_t)8 * 128 * 128 * 2;
constexpr size_t W_TOTAL = W_PEER + 4 * WP_SZ;
constexpr size_t WS_TAB = WS_W + al256(W_TOTAL);
constexpr size_t TAB_HALF = (size_t)NEXP * 1024 * 2;
constexpr size_t WS_XC = WS_TAB + 2 * TAB_HALF;
constexpr size_t WS_H = WS_XC + (size_t)NCTX * D * 4;
constexpr size_t WS_BIG = WS_H + (size_t)NROW * D * 2;
constexpr size_t BIG_BYTES = (size_t)NROW * 4096 * 2;
constexpr size_t BIG_DT = (size_t)NROW * HYB_INP * 2;
constexpr size_t BIG_G = BIG_DT + (size_t)NROW * 32 * 4;
constexpr size_t BIG_KR = BIG_G + (size_t)528 * 128 * 128 * 2;
constexpr size_t BIG_PART = (size_t)NROW * 2048 * 2;
static_assert(BIG_KR + (size_t)NB * NKT * 8192 <= BIG_BYTES, "BIG tail");
constexpr size_t WS_R1 = WS_BIG + BIG_BYTES;
constexpr size_t R1_Q = 0, R1_KN = R1_Q + (size_t)NB * 8 * NKEY * 192 * 2, R1_V = R1_KN + (size_t)NB * 8 * NKT * 16384, R1_BYTES = R1_V + (size_t)NB * 8 * NKT * 16384;
constexpr size_t WS_R2 = WS_R1 + R1_BYTES;
constexpr size_t R2_BC = (size_t)NROW * 1024 * 2, R2_BYTES = R2_BC + (size_t)NROW * 512 * 2;
constexpr size_t R2_GATE = (size_t)NROW * 128 * 4, R2_COEF = 2 * R2_GATE;
constexpr size_t WS_R3 = WS_R2 + R2_BYTES;
constexpr size_t R3_CAT = (size_t)NROW * 1024 * 2, R3_BYTES = R3_CAT + (size_t)NROW * 2048 * 2;
constexpr size_t WS_END = WS_R3 + R3_BYTES;
static_assert(WS_END <= ((size_t)1 << 30), "workspace must fit 1 GiB");

constexpr int CW_QUEUE = 4096;

typedef __bf16 bf16x2_t __attribute__((ext_vector_type(2)));
__device__ __forceinline__ unsigned cvt_pk_bf16(float lo, float hi) { const f32x2 v = {lo, hi}; const bf16x2_t b = __builtin_convertvector(v, bf16x2_t); return __builtin_bit_cast(unsigned, b); }
__device__ __forceinline__ bf16_t f2bf(float f) { return (bf16_t)(cvt_pk_bf16(f, 0.f) & 0xffffu); }
__device__ __forceinline__ float bf2f(unsigned b) { return __uint_as_float(b << 16); }
__device__ __forceinline__ float bflo(unsigned w) { return __uint_as_float(w << 16); }
__device__ __forceinline__ float bfhi(unsigned w) { return __uint_as_float(w & 0xffff0000u); }
__device__ __forceinline__ float wave_sum(float v) {
#pragma unroll
    for (int o = 32; o >= 1; o >>= 1) v += __shfl_xor(v, o);
    return v;
}
__device__ __forceinline__ int otid() { int t = threadIdx.x; asm volatile("" : "+v"(t)); return t; }
__device__ __forceinline__ float silu_f(float x) { return x / (1.f + __expf(-x)); }
__device__ __forceinline__ float softplus_f(float x) { return x > 20.f ? x : log1pf(__expf(x)); }
__device__ __forceinline__ f32x2 gelu_pk(f32x2 v) {
    const f32x2 av = __builtin_elementwise_abs(v), d = av * 0.2316418882f + 1.0f;
    f32x2 t; t.x = __builtin_amdgcn_rcpf(d.x); t.y = __builtin_amdgcn_rcpf(d.y);
    f32x2 q = t * 0.5307027145f + (-0.7265760135f); q = q * t + 0.7107068705f; q = q * t + (-0.142248368f); q = q * t + 0.127414796f; q = q * t;
    const f32x2 s = (v * v) * (-0.72134752044f);
    f32x2 e; e.x = __builtin_amdgcn_exp2f(s.x); e.y = __builtin_amdgcn_exp2f(s.y);
    const f32x2 m = v * (q * e), r = v - m;
    f32x2 o; o.x = v.x < 0.f ? m.x : r.x; o.y = v.y < 0.f ? m.y : r.y; return o;
}
__device__ __forceinline__ float gelu_f(float x) { f32x2 v = {x, 0.f}; return gelu_pk(v).x; }

__device__ __forceinline__ int row_mb(int r) { return r < NLAT ? (r >> 13) : 4; }

#define XB_TMO      128
#define XB_XCNT(j)  (256  + 64 * (j))
#define XB_XSUB(j)  (1280 + 64 * (j))
#define XB_XGEN(j)  (2304 + 64 * (j))
#define XB_TOP      3328
#define XB_TOPGEN   3392
#define XCD_BAR_WORDS 3456
#define XB_SPIN_CAP (1u << 22)
__device__ __forceinline__ unsigned xb_ld(unsigned* p)              { return __hip_atomic_load(p, __ATOMIC_RELAXED, __HIP_MEMORY_SCOPE_AGENT); }
__device__ __forceinline__ unsigned xb_add(unsigned* p, unsigned v) { return __hip_atomic_fetch_add(p, v, __ATOMIC_RELAXED, __HIP_MEMORY_SCOPE_AGENT); }
__device__ __forceinline__ unsigned xb_xcc_id() { return (unsigned)__builtin_amdgcn_s_getreg((3 << 11) | 20) & 0xFu; }
#define XB_SPIN(cond, bar) do { unsigned _sp = 0; while (cond) { __builtin_amdgcn_s_sleep(1); \
    if ((++_sp & 255u) == 0u) { if (xb_ld(&(bar)[XB_TMO])) break; if (_sp > XB_SPIN_CAP) { atomicAdd(&(bar)[XB_TMO], 1u); break; } } } } while (0)
struct XcdBarrier { unsigned* bar; unsigned x; volatile LAS unsigned* st; };
__device__ __forceinline__ XcdBarrier xcd_barrier_post(unsigned* bar, volatile LAS unsigned* st) {
    XcdBarrier b; b.bar = bar; b.x = xb_xcc_id(); b.st = st;
    if (threadIdx.x == 0) (void)xb_add(&bar[XB_XCNT(b.x)], 1u);
    return b;
}
__device__ __forceinline__ void xcd_barrier_complete(unsigned* bar, unsigned x, unsigned& nloc, unsigned& nx) {
    const unsigned G = gridDim.x * gridDim.y * gridDim.z;
    unsigned sum, cnt, mine, sp = 0u;
    for (;;) {
        sum = 0u; cnt = 0u; mine = 0u;
#pragma unroll
        for (unsigned j = 0; j < 16; ++j) { const unsigned c = xb_ld(&bar[XB_XCNT(j)]); sum += c; cnt += (c > 0u) ? 1u : 0u; mine = (j == x) ? c : mine; }
        if (sum == G) break;
        __builtin_amdgcn_s_sleep(1);
        if ((++sp & 255u) == 0u) { if (xb_ld(&bar[XB_TMO])) break; if (sp > XB_SPIN_CAP) { atomicAdd(&bar[XB_TMO], 1u); break; } }
    }
    nloc = mine > 0u ? mine : 1u; nx = cnt > 0u ? cnt : 1u;
}
__device__ __forceinline__ void xcd_barrier(const XcdBarrier& b) {
    asm volatile("s_waitcnt vmcnt(0)" ::: "memory");
    __syncthreads();
    if (threadIdx.x == 0) {
        unsigned* bar = b.bar;
        __builtin_amdgcn_s_waitcnt(0);
        unsigned nloc = b.st[0], nx = b.st[1];
        if (nloc == 0u) { xcd_barrier_complete(bar, b.x, nloc, nx); b.st[0] = nloc; b.st[1] = nx; }
        const unsigned old = xb_add(&bar[XB_XSUB(b.x)], 1u);
        const unsigned gen = old / nloc;
        if (old + 1u == (gen + 1u) * nloc) {
            __builtin_amdgcn_fence(__ATOMIC_RELEASE, "agent");
            asm volatile("s_waitcnt vmcnt(0)" ::: "memory");
            const unsigned og = xb_add(&bar[XB_TOP], 1u);
            const unsigned tg = og / nx;
            if (og + 1u == (tg + 1u) * nx) xb_add(&bar[XB_TOPGEN], 1u);
            else XB_SPIN(xb_ld(&bar[XB_TOPGEN]) == tg, bar);
            __builtin_amdgcn_fence(__ATOMIC_ACQUIRE, "agent");
            xb_add(&bar[XB_XGEN(b.x)], 1u);
            asm volatile("s_waitcnt vmcnt(0)" ::: "memory");
        } else {
            XB_SPIN(xb_ld(&bar[XB_XGEN(b.x)]) == gen, bar);
            __builtin_amdgcn_fence(__ATOMIC_ACQUIRE, "agent");
            asm volatile("s_waitcnt vmcnt(0)" ::: "memory");
        }
    }
    __syncthreads();
}

namespace pg8 {
constexpr int BM = 256, BK = 64, HALF = 128, HTB = HALF * BK * 2, STAGE_BYTES = 8 * HTB, NXCD = 8, WGM = 8;
__host__ __device__ __forceinline__ int lds_byte(int r, int c) { const int st = (r >> 4) * 2 + (c >> 5), rr = r & 15, cc = c & 31, ob = rr * 64 + cc * 2; return st * 1024 + (ob ^ (((ob >> 9) & 1) << 5)); }
__host__ __device__ __forceinline__ void stage_rc(int b, int& R, int& C) { const int st = b / 1024, sb = b % 1024, swz = sb ^ (((sb >> 9) & 1) << 5); R = (st >> 1) * 16 + swz / 64; C = (st & 1) * 32 + (swz % 64) / 2; }
__host__ __device__ __forceinline__ int perm32(int rho) { const int n = rho >> 4, i = rho & 15; return 8 * (i >> 2) + 4 * n + (i & 3); }
struct Unit { int pm, pn; };
struct Gemm { const bf16_t* A; const bf16_t* Bt; int M, N, K, lda, ldb; };
struct StaticOrder {
    int nM, nN, nwg, G, c;
    __device__ void init(int M, int N, int G_, int c_) { nM = M / BM; nN = N / BM; nwg = nM * nN; G = G_; c = c_; }
    __device__ bool next(int i, Unit& u) const {
        const long L = (long)i * G + c; if (L >= nwg) return false;
        int wgid = (int)L; { const int q = nwg / NXCD, r = nwg % NXCD, xcd = wgid % NXCD, off = wgid / NXCD; wgid = (xcd < r ? xcd * (q + 1) : r * (q + 1) + (xcd - r) * q) + off; }
        const int nig = WGM * nN, gid = wgid / nig, fm = gid * WGM, gsz = (nM - fm) < WGM ? (nM - fm) : WGM;
        u.pm = fm + ((wgid % nig) % gsz); u.pn = (wgid % nig) / gsz; return true;
    }
};
template <class Epi>
__device__ __forceinline__ void gemm_phase(LAS unsigned char* lds, const Gemm g, const Epi& E) {
    const int tid = otid(), wid = __builtin_amdgcn_readfirstlane(tid >> 6), lane = tid & 63, wr = wid >> 2, wc = wid & 3, fr = lane & 15, fq = lane >> 4;
    StaticOrder S; S.init(g.M, g.N, (int)gridDim.x, (int)blockIdx.x);
    int K = g.K; asm volatile("" : "+s"(K));
    const int nt = K / BK;
    unsigned voffA[2], voffB[2];
#pragma unroll
    for (int i = 0; i < 2; ++i) { int R, C; stage_rc(tid * 16 + i * 8192, R, C); const int Rb = Epi::PERM ? ((R & ~31) + perm32(R & 31)) : R;
        voffA[i] = (unsigned)(R * g.lda + C) * 2u; voffB[i] = (unsigned)(Rb * g.ldb + C) * 2u; }
    const size_t kstep = (size_t)(BK * 2);
    const size_t hstepA = (size_t)HALF * g.lda * 2, hstepB = (size_t)HALF * g.ldb * 2;
    const size_t tstepA = 2 * hstepA, tstepB = 2 * hstepB;
    const unsigned ldsw = (unsigned)wid * 1024u;
    const int aoff = lds_byte(wr * 64 + fr, fq * 8), boff = lds_byte(wc * 32 + fr, fq * 8);
#define PG8_SA(b, h) (((b) * 2 + (h)) * HTB)
#define PG8_SB(b, h) ((4 + (b) * 2 + (h)) * HTB)
#define PG8_STAGE(bufoff, gbase, voff) do { _Pragma("unroll") for (int _i = 0; _i < 2; ++_i) \
        __builtin_amdgcn_global_load_lds((const unsigned*)((const char*)(gbase) + (voff)[_i]), (LAS unsigned*)(lds + (bufoff) + ldsw + _i * 8192), 16, 0, 0); } while (0)
#define PG8_LDA(dst, b, h) do { _Pragma("unroll") for (int m = 0; m < 4; ++m) _Pragma("unroll") for (int k = 0; k < 2; ++k) dst[m][k] = *(const LAS bf16x8*)(lds + PG8_SA(b, h) + aoff + m * 2048 + k * 1024); } while (0)
#define PG8_LDB(dst, b, h) do { _Pragma("unroll") for (int n = 0; n < 2; ++n) _Pragma("unroll") for (int k = 0; k < 2; ++k) dst[n][k] = *(const LAS bf16x8*)(lds + PG8_SB(b, h) + boff + n * 2048 + k * 1024); } while (0)
#define PG8_MMA(ai, bj, At, Bt) do { __builtin_amdgcn_s_setprio(1); _Pragma("unroll") for (int m = 0; m < 4; ++m) _Pragma("unroll") for (int n = 0; n < 2; ++n) _Pragma("unroll") for (int k = 0; k < 2; ++k) \
        acc[ai][bj][m][n] = __builtin_amdgcn_mfma_f32_16x16x32_bf16(Bt[n][k], At[m][k], acc[ai][bj][m][n], 0, 0, 0); __builtin_amdgcn_s_setprio(0); } while (0)
#define PG8_WAIT_V(n) asm volatile("s_waitcnt vmcnt(" #n ")" ::: "memory")
#define PG8_WAIT_L(n) asm volatile("s_waitcnt lgkmcnt(" #n ")" ::: "memory")
#define PG8_BAR __builtin_amdgcn_s_barrier()
#define PG8_SCHED __builtin_amdgcn_sched_barrier(0)
    Unit cur, nxt; int ui = 0;
    if (!S.next(0, cur)) return;
    f32x4 acc[2][2][4][2];
#pragma unroll
    for (int a = 0; a < 2; ++a)
#pragma unroll
        for (int b = 0; b < 2; ++b)
#pragma unroll
            for (int m = 0; m < 4; ++m)
#pragma unroll
                for (int n = 0; n < 2; ++n) acc[a][b][m][n] = (f32x4){0.f, 0.f, 0.f, 0.f};
    bf16x8 At[4][2], B0[2][2], B1[2][2];
    const char* cA = (const char*)g.A + (size_t)cur.pm * tstepA; const char* cB = (const char*)g.Bt + (size_t)cur.pn * tstepB;
    PG8_STAGE(PG8_SB(0, 0), cB, voffB); PG8_STAGE(PG8_SB(0, 1), cB + hstepB, voffB); PG8_STAGE(PG8_SA(0, 0), cA, voffA); PG8_STAGE(PG8_SA(0, 1), cA + hstepA, voffA);
    if (wr == 1) PG8_BAR;
    PG8_WAIT_V(2); PG8_BAR;
    PG8_STAGE(PG8_SB(1, 0), cB + kstep, voffB); PG8_STAGE(PG8_SA(1, 0), cA + kstep, voffA); PG8_STAGE(PG8_SB(1, 1), cB + hstepB + kstep, voffB);
    PG8_WAIT_V(6); PG8_BAR;
    for (;;) {
        const bool has_next = S.next(ui + 1, nxt);
        const char* nA = has_next ? (const char*)g.A + (size_t)nxt.pm * tstepA : cA; const char* nB = has_next ? (const char*)g.Bt + (size_t)nxt.pn * tstepB : cB;
        for (int t = 0; t < nt; t += 2) {
            const bool last = (t == nt - 2);
            const char* a1 = cA + (size_t)(t + 1) * kstep;
            const char* a2 = last ? nA : cA + (size_t)(t + 2) * kstep; const char* b2 = last ? nB : cB + (size_t)(t + 2) * kstep;
            const char* a3 = a2 + kstep; const char* b3 = b2 + kstep;
            PG8_LDB(B0, 0, 0); PG8_LDB(B1, 0, 1); PG8_SCHED; PG8_LDA(At, 0, 0); PG8_STAGE(PG8_SA(1, 1), a1 + hstepA, voffA);
            PG8_WAIT_V(8); PG8_WAIT_L(0); PG8_BAR; PG8_MMA(0, 0, At, B0); PG8_MMA(0, 1, At, B1); PG8_BAR; PG8_SCHED;
            PG8_LDA(At, 0, 1); PG8_STAGE(PG8_SB(0, 0), b2, voffB); PG8_STAGE(PG8_SB(0, 1), b2 + hstepB, voffB); PG8_STAGE(PG8_SA(0, 0), a2, voffA);
            PG8_WAIT_V(8); PG8_WAIT_L(0); PG8_BAR; PG8_MMA(1, 0, At, B0); PG8_MMA(1, 1, At, B1); PG8_BAR; PG8_SCHED;
            PG8_LDB(B0, 1, 0); PG8_LDB(B1, 1, 1); PG8_SCHED; PG8_LDA(At, 1, 0); PG8_STAGE(PG8_SA(0, 1), a2 + hstepA, voffA);
            PG8_WAIT_V(8); PG8_WAIT_L(0); PG8_BAR; PG8_MMA(0, 0, At, B0); PG8_MMA(0, 1, At, B1); PG8_BAR; PG8_SCHED;
            PG8_LDA(At, 1, 1); PG8_STAGE(PG8_SB(1, 0), b3, voffB); PG8_STAGE(PG8_SB(1, 1), b3 + hstepB, voffB); PG8_STAGE(PG8_SA(1, 0), a3, voffA);
            PG8_WAIT_V(8); PG8_WAIT_L(0); PG8_BAR; PG8_MMA(1, 0, At, B0); PG8_MMA(1, 1, At, B1); PG8_BAR; PG8_SCHED;
        }
        if (wr == 0) PG8_BAR;
        { const int l2_ = otid() & 63; E(acc, cur, wr, wc, l2_ & 15, l2_ >> 4); }
        if (!has_next) break;
#pragma unroll
        for (int a = 0; a < 2; ++a)
#pragma unroll
            for (int b = 0; b < 2; ++b)
#pragma unroll
                for (int m = 0; m < 4; ++m)
#pragma unroll
                    for (int n = 0; n < 2; ++n) acc[a][b][m][n] = (f32x4){0.f, 0.f, 0.f, 0.f};
        cur = nxt; cA = nA; cB = nB; ++ui;
        if (wr == 1) PG8_BAR;
    }
    PG8_WAIT_V(0);
    PG8_BAR;
#undef PG8_SA
#undef PG8_SB
#undef PG8_STAGE
#undef PG8_LDA
#undef PG8_LDB
#undef PG8_MMA
#undef PG8_WAIT_V
#undef PG8_WAIT_L
#undef PG8_BAR
#undef PG8_SCHED
}

template <int ACT> struct EpiBf16 {
    static constexpr bool PERM = true;
    bf16_t* O; int ldc;
    __device__ __forceinline__ void operator()(const f32x4 (&acc)[2][2][4][2], const Unit& u, int wr, int wc, int fr, int fq) const {
        const int row0 = u.pm * BM + wr * 64 + fr, col0 = u.pn * BM + wc * 32 + 8 * fq;
#pragma unroll
        for (int ai = 0; ai < 2; ++ai)
#pragma unroll
            for (int m = 0; m < 4; ++m) { bf16_t* rowp = O + (size_t)(row0 + ai * HALF + m * 16) * ldc + col0;
#pragma unroll
                for (int bj = 0; bj < 2; ++bj) { f32x4 v0 = acc[ai][bj][m][0], v1 = acc[ai][bj][m][1];
                    if (ACT == 1) { f32x2 a = gelu_pk((f32x2){v0[0], v0[1]}), b = gelu_pk((f32x2){v0[2], v0[3]}), c = gelu_pk((f32x2){v1[0], v1[1]}), d = gelu_pk((f32x2){v1[2], v1[3]});
                        v0 = (f32x4){a.x, a.y, b.x, b.y}; v1 = (f32x4){c.x, c.y, d.x, d.y}; }
                    u32x4 w; w.x = cvt_pk_bf16(v0[0], v0[1]); w.y = cvt_pk_bf16(v0[2], v0[3]); w.z = cvt_pk_bf16(v1[0], v1[1]); w.w = cvt_pk_bf16(v1[2], v1[3]);
                    *(u32x4*)(rowp + bj * HALF) = w; } }
    }
};
struct EpiResid {
    static constexpr bool PERM = false;
    float* xl; float* xc; const float* gate;
    __device__ __forceinline__ void operator()(const f32x4 (&acc)[2][2][4][2], const Unit& u, int wr, int wc, int fr, int fq) const {
        const int rbase = u.pm * BM; const bool lat = rbase < NLAT;
        float* X = lat ? xl + (size_t)rbase * D : xc + (size_t)(rbase - NLAT) * D;
        const float* gp = gate + (size_t)(lat ? (rbase >> 13) : 4) * 6144;
        const int row0 = wr * 64 + fr, col0 = u.pn * BM + wc * 32 + 4 * fq;
        f32x4 gv[2][2];
#pragma unroll
        for (int bj = 0; bj < 2; ++bj)
#pragma unroll
            for (int n = 0; n < 2; ++n) gv[bj][n] = *(const f32x4*)(gp + col0 + bj * HALF + n * 16);
#pragma unroll
        for (int ai = 0; ai < 2; ++ai)
#pragma unroll
            for (int m = 0; m < 4; ++m) { float* rowp = X + (size_t)(row0 + ai * HALF + m * 16) * D + col0;
#pragma unroll
                for (int bj = 0; bj < 2; ++bj)
#pragma unroll
                    for (int n = 0; n < 2; ++n) { f32x4* p = (f32x4*)(rowp + bj * HALF + n * 16); *p = *p + gv[bj][n] * acc[ai][bj][m][n]; } }
    }
};
}

namespace att {
constexpr int SLOT = 40960, KN_OFF = 0, KR_OFF = 16384, V_OFF = 24576, LDS_BYTES = 3 * SLOT + 8 * 256;
constexpr float THR2 = 11.0f;
#define KSWZ(row, colB) ((row) * 256 + ((colB) ^ (((row) & 7) << 4)))
#define KRSWZ(row, colB) ((row) * 128 + ((colB) ^ ((((row) >> 1) & 7) << 4)))
#define SBAR() __builtin_amdgcn_sched_barrier(0)
__device__ __forceinline__ int crow(int r, int hi) { return (r & 3) + 8 * (r >> 2) + 4 * hi; }
__host__ __device__ __forceinline__ int v_st(int k, int c) { const int kk = (k & ~0xC) | ((k & 4) << 1) | ((k & 8) >> 1); return ((kk >> 3) * 4 + (c >> 5)) * 512 + ((kk & 7) * 32 + (c & 31)) * 2; }
__device__ __forceinline__ int v_rd_base(int lane) { return ((lane & 3) << 3) | (((lane >> 2) & 3) << 6) | (((lane >> 4) & 1) << 5) | (((lane >> 5) & 1) << 8); }
constexpr int v_rd_off(int d0, int ks, int half) { return d0 * 512 + ks * 4096 + half * 2048; }
template <int OFF> __device__ __forceinline__ s16x4 tr_read(int vb) {
    s16x4 r; asm volatile("ds_read_b64_tr_b16 %0, %1 offset:%2" : "=&v"(r) : "v"(vb), "i"(OFF) : "memory"); return r;
}
template <int D0> __device__ __forceinline__ void pv_one(f32x16& od, int vb, bf16x8 pa0, bf16x8 pa1, bf16x8 pa2, bf16x8 pa3) {
    const s16x4 l0 = tr_read<v_rd_off(D0, 0, 0)>(vb), h0 = tr_read<v_rd_off(D0, 0, 1)>(vb), l1 = tr_read<v_rd_off(D0, 1, 0)>(vb), h1 = tr_read<v_rd_off(D0, 1, 1)>(vb);
    const s16x4 l2 = tr_read<v_rd_off(D0, 2, 0)>(vb), h2 = tr_read<v_rd_off(D0, 2, 1)>(vb), l3 = tr_read<v_rd_off(D0, 3, 0)>(vb), h3 = tr_read<v_rd_off(D0, 3, 1)>(vb);
    asm volatile("s_waitcnt lgkmcnt(0)" ::: "memory"); SBAR();
#define PK(L, H) (bf16x8){L[0], L[1], L[2], L[3], H[0], H[1], H[2], H[3]}
    od = __builtin_amdgcn_mfma_f32_32x32x16_bf16(pa0, PK(l0, h0), od, 0, 0, 0);
    od = __builtin_amdgcn_mfma_f32_32x32x16_bf16(pa1, PK(l1, h1), od, 0, 0, 0);
    od = __builtin_amdgcn_mfma_f32_32x32x16_bf16(pa2, PK(l2, h2), od, 0, 0, 0);
    od = __builtin_amdgcn_mfma_f32_32x32x16_bf16(pa3, PK(l3, h3), od, 0, 0, 0);
#undef PK
}
__device__ __forceinline__ void pv_d0(f32x16* o, int vb, bf16x8 pa0, bf16x8 pa1, bf16x8 pa2, bf16x8 pa3) {
    pv_one<0>(o[0], vb, pa0, pa1, pa2, pa3); pv_one<1>(o[1], vb, pa0, pa1, pa2, pa3); pv_one<2>(o[2], vb, pa0, pa1, pa2, pa3); pv_one<3>(o[3], vb, pa0, pa1, pa2, pa3);
}
__device__ __forceinline__ void partialSM(f32x16& p0, f32x16& p1, float& m_reg, float& mn, float& alpha) {
    float pmax = p0[0];
#pragma unroll
    for (int r = 1; r < 16; ++r) pmax = fmaxf(pmax, p0[r]);
#pragma unroll
    for (int r = 0; r < 16; ++r) pmax = fmaxf(pmax, p1[r]);
    { auto rr = __builtin_amdgcn_permlane32_swap(__float_as_uint(pmax), __float_as_uint(pmax), false, false);
      pmax = fmaxf(__uint_as_float(rr[0]), __uint_as_float(rr[1])); }
    if (__builtin_expect(__all(pmax - m_reg <= THR2), 1)) { mn = m_reg; alpha = 1.f; }
    else { mn = fmaxf(m_reg, pmax); alpha = __builtin_amdgcn_exp2f(m_reg - mn); m_reg = mn; }
#pragma unroll
    for (int r = 0; r < 16; ++r) p0[r] = __builtin_amdgcn_exp2f(p0[r] - mn);
#pragma unroll
    for (int r = 0; r < 16; ++r) p1[r] = p1[r] - mn;
}
__device__ __forceinline__ void finishSM(f32x16& p0, f32x16& p1, float alpha, float& l_reg, bf16x8& pa0, bf16x8& pa1, bf16x8& pa2, bf16x8& pa3) {
#pragma unroll
    for (int r = 0; r < 16; ++r) p1[r] = __builtin_amdgcn_exp2f(p1[r]);
    float ps = 0;
#pragma unroll
    for (int r = 0; r < 16; ++r) ps += p0[r];
#pragma unroll
    for (int r = 0; r < 16; ++r) ps += p1[r];
    { auto rr = __builtin_amdgcn_permlane32_swap(__float_as_uint(ps), __float_as_uint(ps), false, false);
      ps = __uint_as_float(rr[0]) + __uint_as_float(rr[1]); }
    l_reg = l_reg * alpha + ps;
#define PK4(P, BASE, OUT) do { unsigned a0 = cvt_pk_bf16(P[BASE + 0], P[BASE + 1]), a1 = cvt_pk_bf16(P[BASE + 2], P[BASE + 3]);   \
    unsigned b0 = cvt_pk_bf16(P[BASE + 4], P[BASE + 5]), b1 = cvt_pk_bf16(P[BASE + 6], P[BASE + 7]);                              \
    auto r0 = __builtin_amdgcn_permlane32_swap(a0, b0, false, false); auto r1 = __builtin_amdgcn_permlane32_swap(a1, b1, false, false); \
    u32x4 w = {r0[0], r1[0], r0[1], r1[1]}; OUT = *reinterpret_cast<bf16x8*>(&w); } while (0)
    PK4(p0, 0, pa0); PK4(p0, 8, pa1); PK4(p1, 0, pa2); PK4(p1, 8, pa3);
#undef PK4
}
__device__ __forceinline__ void qkt(f32x16& p0, f32x16& p1, LAS unsigned char* slot, const bf16x8* qr, int r32, int hi) {
    p0 = f32x16{}; p1 = f32x16{};
#pragma unroll
    for (int d0 = 0; d0 < 8; ++d0) { const int cb = (d0 * 16 + hi * 8) * 2;
        bf16x8 b0 = *(const LAS bf16x8*)(slot + KN_OFF + KSWZ(r32, cb));
        bf16x8 b1 = *(const LAS bf16x8*)(slot + KN_OFF + KSWZ(32 + r32, cb));
        p0 = __builtin_amdgcn_mfma_f32_32x32x16_bf16(b0, qr[d0], p0, 0, 0, 0);
        p1 = __builtin_amdgcn_mfma_f32_32x32x16_bf16(b1, qr[d0], p1, 0, 0, 0); }
#pragma unroll
    for (int d0 = 0; d0 < 4; ++d0) { const int cb = (d0 * 16 + hi * 8) * 2;
        bf16x8 b0 = *(const LAS bf16x8*)(slot + KR_OFF + KRSWZ(r32, cb));
        bf16x8 b1 = *(const LAS bf16x8*)(slot + KR_OFF + KRSWZ(32 + r32, cb));
        p0 = __builtin_amdgcn_mfma_f32_32x32x16_bf16(b0, qr[8 + d0], p0, 0, 0, 0);
        p1 = __builtin_amdgcn_mfma_f32_32x32x16_bf16(b1, qr[8 + d0], p1, 0, 0, 0); }
}
__device__ __forceinline__ void attn_unit(const bf16_t* __restrict__ Qb, const unsigned char* __restrict__ KNt, const unsigned char* __restrict__ KRt, const unsigned char* __restrict__ Vt,
                                          bf16_t* __restrict__ Ob, int NT, LAS unsigned char* lds) {
    const int tid = otid(), wid = __builtin_amdgcn_readfirstlane(tid >> 6), lane = tid & 63, r32 = lane & 31, hi = lane >> 5;
    LAS float* wsf = (LAS float*)(lds + 3 * SLOT) + wid * 64; LAS float* li_l = wsf; LAS float* al_l = wsf + 32;
    float m_reg = -1e30f, l_reg = 0; f32x16 o[4] = {}; bf16x8 qr[12];
    const bf16_t* Qw = Qb + (size_t)(wid * 32 + r32) * 192 + hi * 8;
#pragma unroll
    for (int d0 = 0; d0 < 12; ++d0) qr[d0] = *(const bf16x8*)(Qw + d0 * 16);
    const int vrb = (int)(unsigned)(uintptr_t)(lds) + V_OFF + v_rd_base(lane);
    const unsigned lo16 = (unsigned)lane * 16u;
#define ATT_DMA(tile, slotoff) do { const size_t t_ = (size_t)(tile); LAS unsigned char* sl_ = lds + (slotoff); \
        __builtin_amdgcn_global_load_lds((const unsigned*)(KNt + t_ * 16384 + wid * 1024 + lo16), (LAS unsigned*)(sl_ + KN_OFF + wid * 1024), 16, 0, 0); \
        __builtin_amdgcn_global_load_lds((const unsigned*)(KNt + t_ * 16384 + (wid + 8) * 1024 + lo16), (LAS unsigned*)(sl_ + KN_OFF + (wid + 8) * 1024), 16, 0, 0); \
        __builtin_amdgcn_global_load_lds((const unsigned*)(KRt + t_ * 8192 + wid * 1024 + lo16), (LAS unsigned*)(sl_ + KR_OFF + wid * 1024), 16, 0, 0); \
        __builtin_amdgcn_global_load_lds((const unsigned*)(Vt + t_ * 16384 + wid * 1024 + lo16), (LAS unsigned*)(sl_ + V_OFF + wid * 1024), 16, 0, 0); \
        __builtin_amdgcn_global_load_lds((const unsigned*)(Vt + t_ * 16384 + (wid + 8) * 1024 + lo16), (LAS unsigned*)(sl_ + V_OFF + (wid + 8) * 1024), 16, 0, 0); } while (0)
#define ATT_SYNC() do { asm volatile("s_waitcnt vmcnt(0)" ::: "memory"); __builtin_amdgcn_s_barrier(); asm volatile("" ::: "memory"); } while (0)
#define RESC(a) do { if (__any((a) < 1.f)) { if (hi == 0) al_l[r32] = (a); asm volatile("s_waitcnt lgkmcnt(0)" ::: "memory"); \
        _Pragma("unroll") for (int d = 0; d < 4; ++d) _Pragma("unroll") for (int r = 0; r < 16; ++r) o[d][r] *= al_l[crow(r, hi)]; } } while (0)
    f32x16 pA0, pA1, pB0, pB1; float mnA, mnB, alA, alB; bf16x8 pa0, pa1, pa2, pa3;
    int sp = 0, sc = SLOT, sn = 2 * SLOT;
    ATT_DMA(0, 0); ATT_DMA(1, SLOT);
    asm volatile("s_waitcnt vmcnt(5)" ::: "memory"); __builtin_amdgcn_s_barrier(); asm volatile("" ::: "memory");
    qkt(pA0, pA1, lds, qr, r32, hi); partialSM(pA0, pA1, m_reg, mnA, alA);
    for (int j = 1; j + 1 < NT; j += 2) {
        ATT_SYNC(); ATT_DMA(j + 1, sn);
        SBAR(); qkt(pB0, pB1, lds + sc, qr, r32, hi);
        finishSM(pA0, pA1, alA, l_reg, pa0, pa1, pa2, pa3); SBAR();
        pv_d0(o, vrb + sp, pa0, pa1, pa2, pa3); partialSM(pB0, pB1, m_reg, mnB, alB);
        RESC(alB);
        { const int t_ = sp; sp = sc; sc = sn; sn = t_; }
        ATT_SYNC(); if (j + 2 < NT) ATT_DMA(j + 2, sn);
        SBAR(); qkt(pA0, pA1, lds + sc, qr, r32, hi);
        finishSM(pB0, pB1, alB, l_reg, pa0, pa1, pa2, pa3); SBAR();
        pv_d0(o, vrb + sp, pa0, pa1, pa2, pa3); partialSM(pA0, pA1, m_reg, mnA, alA);
        RESC(alA);
        { const int t_ = sp; sp = sc; sc = sn; sn = t_; }
    }
    ATT_SYNC();
    SBAR(); qkt(pB0, pB1, lds + sc, qr, r32, hi);
    finishSM(pA0, pA1, alA, l_reg, pa0, pa1, pa2, pa3); SBAR();
    pv_d0(o, vrb + sp, pa0, pa1, pa2, pa3); partialSM(pB0, pB1, m_reg, mnB, alB);
    RESC(alB);
    finishSM(pB0, pB1, alB, l_reg, pa0, pa1, pa2, pa3); SBAR();
    pv_d0(o, vrb + sc, pa0, pa1, pa2, pa3);
    if (hi == 0) li_l[r32] = l_reg; asm volatile("s_waitcnt lgkmcnt(0)" ::: "memory");
    float rli[16];
#pragma unroll
    for (int r = 0; r < 16; ++r) rli[r] = __builtin_amdgcn_rcpf(li_l[crow(r, hi)]);
    bf16_t* Ow = Ob + (size_t)(wid * 32) * 2048;
#pragma unroll
    for (int r = 0; r < 16; ++r) { const int orow = crow(r, hi);
#pragma unroll
        for (int d0 = 0; d0 < 4; ++d0) Ow[(size_t)orow * 2048 + d0 * 32 + r32] = f2bf(o[d0][r] * rli[r]); }
    __builtin_amdgcn_s_barrier(); asm volatile("" ::: "memory");
#undef ATT_DMA
#undef ATT_SYNC
#undef RESC
}
}

namespace ssd {
constexpr int XT_OFF = 0, XTW_OFF = 8704, BT_OFF = 17408, HB_OFF = 52224, SET = 60928, CW_OFF = 2 * SET, LDS_BYTES = CW_OFF + 8 * 512;
constexpr int PITCH = 272;
constexpr float L2E = 1.4426950408889634f;
__device__ __forceinline__ void g_unit(const bf16_t* __restrict__ BC, bf16_t* __restrict__ G, int unit) {
    const int cid = unit >> 1, g = unit & 1;
    const int r0 = cid < 256 ? cid * 128 : NLAT + (cid - 256) * 128;
    const int tid = otid(), wid = tid >> 6, lane = tid & 63, fr = lane & 15, fq = lane >> 4;
    const bf16_t* Cp = BC + (size_t)(r0 + 16 * wid + fr) * 512 + 256 + 128 * g + 8 * fq;
    bf16x8 cf[4];
#pragma unroll
    for (int ks = 0; ks < 4; ++ks) cf[ks] = *(const bf16x8*)(Cp + 32 * ks);
    bf16_t* Gp = G + ((size_t)unit * 128 + 16 * wid + fr) * 128 + 4 * fq;
#pragma unroll
    for (int sb = 0; sb < 8; ++sb) {
        const bf16_t* Bp = BC + (size_t)(r0 + 16 * sb + fr) * 512 + 128 * g + 8 * fq;
        f32x4 acc = {0.f, 0.f, 0.f, 0.f};
#pragma unroll
        for (int ks = 0; ks < 4; ++ks) { const bf16x8 bfr = *(const bf16x8*)(Bp + 32 * ks); acc = __builtin_amdgcn_mfma_f32_16x16x32_bf16(bfr, cf[ks], acc, 0, 0, 0); }
        u32x2 w; w.x = cvt_pk_bf16(acc[0], acc[1]); w.y = cvt_pk_bf16(acc[2], acc[3]);
        *(u32x2*)(Gp + 16 * sb) = w;
    }
}
__device__ __forceinline__ void ssd_unit(int u, const bf16_t* __restrict__ XS, const bf16_t* __restrict__ BC, const float* __restrict__ DT, const bf16_t* __restrict__ G,
                                         const float* __restrict__ a_log, bf16_t* __restrict__ Y0, bf16_t* __restrict__ Y1, LAS unsigned char* lds) {
    const int b = u >> 6, h = (u >> 2) & 15, d = (u >> 1) & 1, ph = u & 1, g = h >> 3;
    const int tid = otid(), wid = tid >> 6, lane = tid & 63, fr = lane & 15, fq = lane >> 4;
    const float a = -__expf(a_log[d * 16 + h]);
    bf16_t* Y = d ? Y1 : Y0;
    LAS float* cw = (LAS float*)(lds + CW_OFF + wid * 512);
    f32x4 hs[2] = {{0.f, 0.f, 0.f, 0.f}, {0.f, 0.f, 0.f, 0.f}};
    for (int i = tid; i < 8704 / 4; i += 512) ((LAS unsigned*)(lds + HB_OFF))[i] = 0u;
    float cend = 0.f;
#define SSD_ROWS(step, r0v, gidv) do { if ((step) < 2) { const int oc_ = d ? 1 - (step) : (step); r0v = NLAT + b * 256 + oc_ * 128; gidv = 256 + b * 2 + oc_; } \
        else { const int lc_ = (step) - 2, oc_ = d ? 63 - lc_ : lc_; r0v = b * 8192 + oc_ * 128; gidv = b * 64 + oc_; } } while (0)
#define SSD_STAGE(step) do { int r0_, gid_; SSD_ROWS(step, r0_, gid_); (void)gid_; LAS unsigned char* set_ = lds + ((step) & 1) * SET; \
        const float da0 = DT[(size_t)(r0_ + 2 * lane) * 32 + d * 16 + h] * a, da1 = DT[(size_t)(r0_ + 2 * lane + 1) * 32 + d * 16 + h] * a; \
        float sc_ = da0 + da1; \
        if (d == 0) { _Pragma("unroll") for (int o_ = 1; o_ < 64; o_ <<= 1) { const float t_ = __shfl_up(sc_, o_); if (lane >= o_) sc_ += t_; } \
            cw[2 * lane] = sc_ - da1; cw[2 * lane + 1] = sc_; cend = __shfl(sc_, 63); } \
        else { _Pragma("unroll") for (int o_ = 1; o_ < 64; o_ <<= 1) { const float t_ = __shfl_down(sc_, o_); if (lane + o_ < 64) sc_ += t_; } \
            cw[2 * lane] = sc_; cw[2 * lane + 1] = sc_ - da0; cend = __shfl(sc_, 0); } \
        asm volatile("s_waitcnt lgkmcnt(0)" ::: "memory"); \
        { const int s_ = tid & 127, pq_ = tid >> 7; const int row_ = r0_ + s_; \
          const u32x4 xv_ = *(const u32x4*)(XS + (size_t)row_ * 1024 + 64 * h + 32 * ph + 8 * pq_); \
          const float dt_ = DT[(size_t)row_ * 32 + d * 16 + h]; const float wg_ = __builtin_amdgcn_exp2f((cend - cw[s_]) * L2E); \
          LAS bf16_t* xt_ = (LAS bf16_t*)(set_ + XT_OFF) + (8 * pq_) * 136 + s_; LAS bf16_t* xw_ = (LAS bf16_t*)(set_ + XTW_OFF) + (8 * pq_) * 136 + s_; \
          _Pragma("unroll") for (int i_ = 0; i_ < 4; ++i_) { const float lo_ = bflo(xv_[i_]) * dt_, hi_ = bfhi(xv_[i_]) * dt_; \
              xt_[(2 * i_) * 136] = f2bf(lo_); xt_[(2 * i_ + 1) * 136] = f2bf(hi_); xw_[(2 * i_) * 136] = f2bf(lo_ * wg_); xw_[(2 * i_ + 1) * 136] = f2bf(hi_ * wg_); } } \
        _Pragma("unroll") for (int j_ = 0; j_ < 4; ++j_) { const int idx_ = tid + 512 * j_, s_ = idx_ & 127, n8_ = idx_ >> 7; \
          const u32x4 bv_ = *(const u32x4*)(BC + (size_t)(r0_ + s_) * 512 + 128 * g + 8 * n8_); \
          LAS bf16_t* bt_ = (LAS bf16_t*)(set_ + BT_OFF) + (8 * n8_) * 136 + s_; \
          _Pragma("unroll") for (int i_ = 0; i_ < 4; ++i_) { bt_[(2 * i_) * 136] = (bf16_t)(bv_[i_] & 0xffffu); bt_[(2 * i_ + 1) * 136] = (bf16_t)(bv_[i_] >> 16); } } \
    } while (0)
    SSD_STAGE(0);
    for (int step = 0; step < 66; ++step) {
        __syncthreads();
        int r0, gid; SSD_ROWS(step, r0, gid);
        LAS unsigned char* set = lds + (step & 1) * SET;
        const float cend_cur = cend;
        {
            const int t = 16 * wid + fr; const float ct = cw[t];
            f32x4 y[2] = {{0.f, 0.f, 0.f, 0.f}, {0.f, 0.f, 0.f, 0.f}};
            const bf16_t* Gp = G + ((size_t)(gid * 2 + g) * 128 + t) * 128 + 8 * fq;
            const bf16_t* Cp = BC + (size_t)(r0 + t) * 512 + 256 + 128 * g + 8 * fq;
            u32x4 gv[4], cv[4];
#pragma unroll
            for (int ks = 0; ks < 4; ++ks) { gv[ks] = *(const u32x4*)(Gp + 32 * ks); cv[ks] = *(const u32x4*)(Cp + 32 * ks); }
            const float et = __builtin_amdgcn_exp2f(ct * L2E);
#pragma unroll
            for (int ks = 0; ks < 4; ++ks) {
                const bool live = d == 0 ? (32 * ks <= 16 * wid + 15) : (32 * ks + 31 >= 16 * wid);
                if (live) {
                    const int s0 = 32 * ks + 8 * fq;
                    const f32x4 c0 = *(const LAS f32x4*)(cw + s0), c1 = *(const LAS f32x4*)(cw + s0 + 4);
                    float m[8];
#pragma unroll
                    for (int i = 0; i < 8; ++i) { const float cs = i < 4 ? c0[i & 3] : c1[i & 3]; const int s = s0 + i;
                        const bool ok = d == 0 ? (s <= t) : (s >= t);
                        const float gval = (i & 1) ? bfhi(gv[ks][i >> 1]) : bflo(gv[ks][i >> 1]);
                        m[i] = ok ? gval * __builtin_amdgcn_exp2f((ct - cs) * L2E) : 0.f; }
                    u32x4 mw; mw.x = cvt_pk_bf16(m[0], m[1]); mw.y = cvt_pk_bf16(m[2], m[3]); mw.z = cvt_pk_bf16(m[4], m[5]); mw.w = cvt_pk_bf16(m[6], m[7]);
                    const bf16x8 mb = __builtin_bit_cast(bf16x8, mw);
#pragma unroll
                    for (int q = 0; q < 2; ++q) { const bf16x8 af = *(const LAS bf16x8*)(set + XT_OFF + (16 * q + fr) * PITCH + (32 * ks + 8 * fq) * 2);
                        y[q] = __builtin_amdgcn_mfma_f32_16x16x32_bf16(af, mb, y[q], 0, 0, 0); }
                }
            }
#pragma unroll
            for (int ks = 0; ks < 4; ++ks) {
                u32x4 cwv;
#pragma unroll
                for (int i = 0; i < 4; ++i) cwv[i] = cvt_pk_bf16(bflo(cv[ks][i]) * et, bfhi(cv[ks][i]) * et);
                const bf16x8 cb = __builtin_bit_cast(bf16x8, cwv);
#pragma unroll
                for (int q = 0; q < 2; ++q) { const bf16x8 af = *(const LAS bf16x8*)(set + HB_OFF + (16 * q + fr) * PITCH + (32 * ks + 8 * fq) * 2);
                    y[q] = __builtin_amdgcn_mfma_f32_16x16x32_bf16(af, cb, y[q], 0, 0, 0); }
            }
            bf16_t* yp = Y + (size_t)(r0 + t) * 1024 + 64 * h + 32 * ph + 4 * fq;
#pragma unroll
            for (int q = 0; q < 2; ++q) { u32x2 w; w.x = cvt_pk_bf16(y[q][0], y[q][1]); w.y = cvt_pk_bf16(y[q][2], y[q][3]); *(u32x2*)(yp + 16 * q) = w; }
        }
        {
            const float dec = __builtin_amdgcn_exp2f(cend_cur * L2E);
            hs[0] = hs[0] * dec; hs[1] = hs[1] * dec;
#pragma unroll
            for (int ks = 0; ks < 4; ++ks) {
                const bf16x8 bfr = *(const LAS bf16x8*)(set + BT_OFF + (16 * wid + fr) * PITCH + (32 * ks + 8 * fq) * 2);
#pragma unroll
                for (int q = 0; q < 2; ++q) { const bf16x8 af = *(const LAS bf16x8*)(set + XTW_OFF + (16 * q + fr) * PITCH + (32 * ks + 8 * fq) * 2);
                    hs[q] = __builtin_amdgcn_mfma_f32_16x16x32_bf16(af, bfr, hs[q], 0, 0, 0); }
            }
            LAS bf16_t* hb = (LAS bf16_t*)(lds + ((step + 1) & 1) * SET + HB_OFF) + 16 * wid + fr;
#pragma unroll
            for (int q = 0; q < 2; ++q)
#pragma unroll
                for (int i = 0; i < 4; ++i) hb[(16 * q + 4 * fq + i) * 136] = f2bf(hs[q][i]);
        }
        if (step + 1 < 66) SSD_STAGE(step + 1);
    }
    __syncthreads();
#undef SSD_ROWS
#undef SSD_STAGE
}
}

struct Args { const float* in[32]; float* out; unsigned char* ws; int ph_lo, ph_hi; };
constexpr int NTHR = 512;
constexpr int LDS_BASE = 256;
constexpr int LDS_PHASE = 133120;
constexpr int LDS_BYTES = LDS_BASE + LDS_PHASE;
static_assert(att::LDS_BYTES <= LDS_PHASE && ssd::LDS_BYTES <= LDS_PHASE && pg8::STAGE_BYTES <= LDS_PHASE, "LDS");

__device__ __forceinline__ void tjob(int j, const Args& A, const float*& src, bf16_t*& dst, int& K, int& N, int& Npad, int& mode, const float*& ks) {
    unsigned char* W = A.ws + WS_W; mode = 0; ks = nullptr;
    if (j < 8) { const int i = j >> 2, w = j & 3; unsigned char* base = W + W_HYB + (size_t)i * WH_SZ;
        if (w == 0)      { src = A.in[I_HWIN] + (size_t)i * 1024 * HYB_IN; dst = (bf16_t*)(base + WH_IN); K = 1024; N = HYB_IN; Npad = HYB_INP; mode = 1; }
        else if (w == 1) { src = A.in[I_WQB] + (size_t)i * 384 * 1536; dst = (bf16_t*)(base + WH_QB); K = 384; N = 1536; Npad = 1536; mode = 2; ks = A.in[I_QNG] + i * 384; }
        else if (w == 2) { src = A.in[I_WKVB] + (size_t)i * 256 * 2048; dst = (bf16_t*)(base + WH_KVB); K = 256; N = 2048; Npad = 2048; ks = A.in[I_KVNG] + i * 256; }
        else             { src = A.in[I_HWOUT] + (size_t)i * 2048 * 1024; dst = (bf16_t*)(base + WH_OUT); K = 2048; N = 1024; Npad = 1024; }
    } else if (j < 12) { const int i = (j - 8) >> 1, w = (j - 8) & 1; unsigned char* base = W + W_GM + (size_t)i * WG_SZ;
        if (w == 0) { src = A.in[I_GWIN] + (size_t)i * 1024 * 4096; dst = (bf16_t*)(base + WG_IN); K = 1024; N = 4096; Npad = 4096; }
        else        { src = A.in[I_GWOUT] + (size_t)i * 2048 * 1024; dst = (bf16_t*)(base + WG_OUT); K = 2048; N = 1024; Npad = 1024; }
    } else { const int l = j - 12; src = A.in[I_PWQ] + (size_t)l * 1024 * 2048; dst = (bf16_t*)(W + W_PEER + (size_t)l * WP_SZ + WP_Q); K = 1024; N = 2048; Npad = 2048; }
}
__device__ __forceinline__ int colmap(int mode, int n, int N) {
    if (mode == 1) { if (n >= N) return -1; if (n < C_KR) return n; const int m = n - C_KR; return C_KR + (m >> 1) + 32 * (m & 1); }
    if (mode == 2) { if (n < 1024) return (n >> 7) * 192 + (n & 127); const int m = n - 1024, h = m >> 6, mm = m & 63; return h * 192 + 128 + (mm >> 1) + 32 * (mm & 1); }
    return n;
}
__device__ __forceinline__ void phase_prologue(const Args& A, LAS unsigned char* lds) {
    const int tid = otid();
    {
        LAS float* tile = (LAS float*)lds;
        int item = blockIdx.x;
        for (int j = 0; j < 16; ++j) {
            const float* src; bf16_t* dst; int K, N, Npad, mode; const float* ks; tjob(j, A, src, dst, K, N, Npad, mode, ks);
            const int tk = K / 64, tn = Npad / 64, nt = tk * tn;
            for (; item < nt; item += gridDim.x) {
                const int k0 = (item % tk) * 64, n0 = (item / tk) * 64;
                { const int k = tid >> 3, cg = tid & 7; const float sc = ks ? ks[k0 + k] : 1.f;
#pragma unroll
                  for (int jj = 0; jj < 8; ++jj) { const int oc = colmap(mode, n0 + 8 * cg + jj, N); tile[k * 65 + 8 * cg + jj] = oc >= 0 ? src[(size_t)(k0 + k) * N + oc] * sc : 0.f; } }
                __syncthreads();
                { const int n = tid >> 3, kg = tid & 7; float v[8];
#pragma unroll
                  for (int jj = 0; jj < 8; ++jj) v[jj] = tile[(8 * kg + jj) * 65 + n];
                  u32x4 w; w.x = cvt_pk_bf16(v[0], v[1]); w.y = cvt_pk_bf16(v[2], v[3]); w.z = cvt_pk_bf16(v[4], v[5]); w.w = cvt_pk_bf16(v[6], v[7]);
                  *(u32x4*)(dst + (size_t)(n0 + n) * K + k0 + 8 * kg) = w; }
                __syncthreads();
            }
            item -= nt;
        }
    }
    {
        const int gthr = blockIdx.x * NTHR + tid, nthr = gridDim.x * NTHR;
        for (int p = gthr; p < 10 * 16384; p += nthr) {
            const int mat = p >> 14, off = (p & 16383) * 8; const float* src; bf16_t* dst;
            if (mat < 2)      { src = A.in[I_GWS] + (size_t)mat * 131072; dst = (bf16_t*)(A.ws + WS_W + W_GM + (size_t)mat * WG_SZ + WG_WS); }
            else if (mat < 6) { src = A.in[I_PK1] + (size_t)(mat - 2) * 131072; dst = (bf16_t*)(A.ws + WS_W + W_PEER + (size_t)(mat - 2) * WP_SZ + WP_K1); }
            else              { src = A.in[I_PK2] + (size_t)(mat - 6) * 131072; dst = (bf16_t*)(A.ws + WS_W + W_PEER + (size_t)(mat - 6) * WP_SZ + WP_K2); }
            const f32x4 a = *(const f32x4*)(src + off), b = *(const f32x4*)(src + off + 4);
            u32x4 w; w.x = cvt_pk_bf16(a[0], a[1]); w.y = cvt_pk_bf16(a[2], a[3]); w.z = cvt_pk_bf16(b[0], b[1]); w.w = cvt_pk_bf16(b[2], b[3]);
            *(u32x4*)(dst + off) = w;
        }
        float* rope = (float*)(A.ws + WS_ROPE);
        for (int p = gthr; p < SEQ * 32; p += nthr) { const int l = p >> 5, i = p & 31; const float pos = (float)(i < 16 ? (l >> 6) : (l & 63));
            const float inv = powf(10000.f, -(float)(i & 15) / 16.f), ang = pos * inv; rope[p] = cosf(ang); rope[SEQ * 32 + p] = sinf(ang); }
    }
    {
        LAS float* scond = (LAS float*)lds;
        LAS float* red = scond + 5 * 1024;
        __syncthreads();
        for (int i = tid; i < 5 * 1024; i += NTHR) { const int m = i >> 10, k = i & 1023; const float c = m < 4 ? A.in[I_C][m * 1024 + k] : A.in[I_CCTX][k]; scond[i] = silu_f(c); }
        __syncthreads();
        float* MOD = (float*)(A.ws + WS_MOD);
        for (int item = blockIdx.x; item < 4 * 48; item += gridDim.x) {
            const int layer = item / 48, j0 = (item % 48) * 128; const int c4 = tid & 31, ksl = tid >> 5;
            f32x4 acc[5];
#pragma unroll
            for (int m = 0; m < 5; ++m) acc[m] = (f32x4){0.f, 0.f, 0.f, 0.f};
            const float* wp = A.in[I_ADAW] + ((size_t)layer * 1024 + ksl * 64) * 6144 + j0 + 4 * c4;
            for (int k = 0; k < 64; ++k) { const f32x4 w = *(const f32x4*)(wp + (size_t)k * 6144);
#pragma unroll
                for (int m = 0; m < 5; ++m) acc[m] += w * scond[m * 1024 + ksl * 64 + k]; }
#pragma unroll
            for (int m = 0; m < 5; ++m) *(LAS f32x4*)(red + (ksl * 5 + m) * 128 + 4 * c4) = acc[m];
            __syncthreads();
            for (int i = tid; i < 640; i += NTHR) { const int m = i >> 7, c = i & 127; float s = A.in[I_ADAB][layer * 6144 + j0 + c];
#pragma unroll
                for (int q = 0; q < 16; ++q) s += red[(q * 5 + m) * 128 + c];
                MOD[((size_t)layer * 5 + m) * 6144 + j0 + c] = s; }
            __syncthreads();
        }
    }
}

__device__ __forceinline__ void phase_norm_mod(const float* xl, const float* xc, float* cl, float* cc, const float* g, const float* modl, int sh_idx, bf16_t* H, int nrows) {
    const int tid_ = otid(); const int lane = tid_ & 63, gw = blockIdx.x * 8 + (tid_ >> 6), nw = gridDim.x * 8;
    f32x4 gv[4];
#pragma unroll
    for (int i = 0; i < 4; ++i) gv[i] = *(const f32x4*)(g + 256 * i + 4 * lane);
    for (int r = gw; r < nrows; r += nw) {
        const bool lat = r < NLAT; const float* xp = lat ? xl + (size_t)r * D : xc + (size_t)(r - NLAT) * D;
        f32x4 x[4]; float ss = 0.f;
#pragma unroll
        for (int i = 0; i < 4; ++i) { x[i] = *(const f32x4*)(xp + 256 * i + 4 * lane); ss += x[i][0] * x[i][0] + x[i][1] * x[i][1] + x[i][2] * x[i][2] + x[i][3] * x[i][3]; }
        if (cl) { float* cp = lat ? cl + (size_t)r * D : cc + (size_t)(r - NLAT) * D;
#pragma unroll
            for (int i = 0; i < 4; ++i) *(f32x4*)(cp + 256 * i + 4 * lane) = x[i]; }
        ss = wave_sum(ss); const float rstd = rsqrtf(ss * (1.f / 1024.f) + EPS);
        const float* mp = modl + (size_t)(lat ? (r >> 13) : 4) * 6144 + sh_idx * 1024;
#pragma unroll
        for (int i = 0; i < 4; ++i) { const f32x4 sh = *(const f32x4*)(mp + 256 * i + 4 * lane), sc = *(const f32x4*)(mp + 1024 + 256 * i + 4 * lane);
            const f32x4 hv = (x[i] * rstd) * gv[i] * (sc + 1.f) + sh;
            u32x2 w; w.x = cvt_pk_bf16(hv[0], hv[1]); w.y = cvt_pk_bf16(hv[2], hv[3]);
            *(u32x2*)(H + (size_t)r * D + 256 * i + 4 * lane) = w; }
    }
}
__device__ __forceinline__ void phase_final_norm(float* xl, const float* g) {
    const int tid_ = otid(); const int lane = tid_ & 63, gw = blockIdx.x * 8 + (tid_ >> 6), nw = gridDim.x * 8;
    f32x4 gv[4];
#pragma unroll
    for (int i = 0; i < 4; ++i) gv[i] = *(const f32x4*)(g + 256 * i + 4 * lane);
    for (int r = gw; r < NLAT; r += nw) {
        float* xp = xl + (size_t)r * D; f32x4 x[4]; float ss = 0.f;
#pragma unroll
        for (int i = 0; i < 4; ++i) { x[i] = *(const f32x4*)(xp + 256 * i + 4 * lane); ss += x[i][0] * x[i][0] + x[i][1] * x[i][1] + x[i][2] * x[i][2] + x[i][3] * x[i][3]; }
        ss = wave_sum(ss); const float rstd = rsqrtf(ss * (1.f / 1024.f) + EPS);
#pragma unroll
        for (int i = 0; i < 4; ++i) *(f32x4*)(xp + 256 * i + 4 * lane) = (x[i] * rstd) * gv[i];
    }
}

__device__ __forceinline__ void phase_conv(const Args& A, int li) {
    const bf16_t* PROJ = (const bf16_t*)(A.ws + WS_BIG);
    bf16_t* XS = (bf16_t*)(A.ws + WS_R2); bf16_t* BC = (bf16_t*)(A.ws + WS_R2 + R2_BC);
    const int tid = otid();
    if (tid < 384) {
        const int cg = tid % 192, half = tid / 192, c0 = 8 * cg;
        const float* cw = A.in[I_CONVW] + ((size_t)li * 1536 + c0) * 5; const float* cb = A.in[I_CONVB] + (size_t)li * 1536 + c0;
        float w[8][5], bia[8];
#pragma unroll
        for (int j = 0; j < 8; ++j) { bia[j] = cb[j];
#pragma unroll
            for (int k = 0; k < 5; ++k) w[j][k] = cw[j * 5 + k]; }
        for (int blk = blockIdx.x; blk < NROW / 64; blk += gridDim.x) {
            const int rbeg = blk * 64 + half * 32; int s0, s1;
            if (rbeg < NLAT) { s0 = rbeg & ~8191; s1 = s0 + 8192; } else { s0 = NLAT + ((rbeg - NLAT) & ~255); s1 = s0 + 256; }
            float win[5][8];
#define CONV_LD(dst, r) do { const int r_ = (r); if (r_ >= s0 && r_ < s1) { const u32x4 v_ = *(const u32x4*)(PROJ + (size_t)r_ * HYB_INP + C_XBC + c0); \
                _Pragma("unroll") for (int q_ = 0; q_ < 4; ++q_) { dst[2 * q_] = bflo(v_[q_]); dst[2 * q_ + 1] = bfhi(v_[q_]); } } \
                else { _Pragma("unroll") for (int q_ = 0; q_ < 8; ++q_) dst[q_] = 0.f; } } while (0)
            CONV_LD(win[0], rbeg - 2); CONV_LD(win[1], rbeg - 1); CONV_LD(win[2], rbeg); CONV_LD(win[3], rbeg + 1); CONV_LD(win[4], rbeg + 2);
            for (int r = rbeg; r < rbeg + 32; ++r) {
                float o[8];
#pragma unroll
                for (int j = 0; j < 8; ++j) { float s = bia[j];
#pragma unroll
                    for (int k = 0; k < 5; ++k) s += w[j][k] * win[k][j];
                    o[j] = silu_f(s); }
                u32x4 pk; pk.x = cvt_pk_bf16(o[0], o[1]); pk.y = cvt_pk_bf16(o[2], o[3]); pk.z = cvt_pk_bf16(o[4], o[5]); pk.w = cvt_pk_bf16(o[6], o[7]);
                if (c0 < 1024) *(u32x4*)(XS + (size_t)r * 1024 + c0) = pk; else *(u32x4*)(BC + (size_t)r * 512 + (c0 - 1024)) = pk;
#pragma unroll
                for (int k = 0; k < 4; ++k)
#pragma unroll
                    for (int j = 0; j < 8; ++j) win[k][j] = win[k + 1][j];
                CONV_LD(win[4], r + 3);
            }
#undef CONV_LD
        }
    }
    {
        const int lane = tid & 63, gw = blockIdx.x * 8 + (tid >> 6), nw = gridDim.x * 8;
        float* DT = (float*)(A.ws + WS_BIG + BIG_DT); float* RQ = (float*)(A.ws + WS_RSTD); float* RKV = RQ + NROW;
        unsigned char* KR = A.ws + WS_BIG + BIG_KR; const float* rope = (const float*)(A.ws + WS_ROPE);
        const float dtb = lane < 32 ? A.in[I_DTB][li * 32 + lane] : 0.f;
        for (int r = gw; r < NROW; r += nw) {
            const bf16_t* p = PROJ + (size_t)r * HYB_INP;
            if (lane < 32) DT[(size_t)r * 32 + lane] = softplus_f(bf2f(p[C_DT + (lane & 15)]) + dtb);
            { const unsigned* q = (const unsigned*)(p + C_CQ + 6 * lane); float ss = 0.f;
#pragma unroll
              for (int j = 0; j < 3; ++j) { const unsigned w = q[j]; const float a = bflo(w), b = bfhi(w); ss += a * a + b * b; }
              ss = wave_sum(ss); if (lane == 0) RQ[r] = rsqrtf(ss * (1.f / 384.f) + EPS); }
            { const u32x2 w = *(const u32x2*)(p + C_CKV + 4 * lane); const float a = bflo(w.x), b = bfhi(w.x), c = bflo(w.y), d = bfhi(w.y);
              float ss = a * a + b * b + c * c + d * d; ss = wave_sum(ss); if (lane == 0) RKV[r] = rsqrtf(ss * (1.f / 256.f) + EPS); }
            if (lane < 32) { const unsigned w = *(const unsigned*)(p + C_KR + 2 * lane); float x1 = bflo(w), x2 = bfhi(w); int b, key;
                if (r < NLAT) { const int l = r & 8191; const float c = rope[l * 32 + lane], s = rope[SEQ * 32 + l * 32 + lane];
                    const float o1 = x1 * c - x2 * s, o2 = x1 * s + x2 * c; x1 = o1; x2 = o2; b = r >> 13; key = 256 + l; }
                else { b = (r - NLAT) >> 8; key = (r - NLAT) & 255; }
                *(unsigned*)(KR + (size_t)(b * NKT + (key >> 6)) * 8192 + KRSWZ(key & 63, 4 * lane)) = cvt_pk_bf16(x1, x2); }
        }
    }
}

struct EpiQ {
    static constexpr bool PERM = true;
    bf16_t* Q; const float* rstd; const float* rope;
    __device__ __forceinline__ void operator()(const f32x4 (&acc)[2][2][4][2], const pg8::Unit& u, int wr, int wc, int fr, int fq) const {
        const bool lat = u.pm < 128;
        const int b = lat ? (u.pm >> 5) : ((u.pm - 128) >> 0), q0 = lat ? 256 + ((u.pm & 31) << 8) : 0;
        const bool isrope = u.pn >= 4;
#pragma unroll
        for (int ai = 0; ai < 2; ++ai) {
            const int rl = 128 * ai + 64 * wr + fr;
            const float* rsp = rstd + u.pm * 256 + rl;
            const float* rp = rope + (size_t)(((u.pm & 31) << 8) + rl) * 32;
#pragma unroll
            for (int bj = 0; bj < 2; ++bj) {
                const int c0 = u.pn * 256 + 128 * bj + 32 * wc + 8 * fq; int h, dcol;
                if (!isrope) { h = c0 >> 7; dcol = c0 & 127; } else { const int mq = c0 - 1024; h = mq >> 6; dcol = 128 + (mq & 63); }
                bf16_t* dst = Q + ((size_t)(b * 8 + h) * NKEY + q0 + rl) * 192 + dcol;
                const int ro = (dcol - 128) >> 1;
#pragma unroll
                for (int m = 0; m < 4; ++m) {
                    const float rs = rsp[16 * m] * QSCALE;
                    f32x4 v0 = acc[ai][bj][m][0] * rs, v1 = acc[ai][bj][m][1] * rs;
                    if (isrope && lat) { const f32x4 cs = *(const f32x4*)(rp + 16 * m * 32 + ro), sn = *(const f32x4*)(rp + SEQ * 32 + 16 * m * 32 + ro);
                        const f32x4 a0 = v0, a1 = v1;
                        v0[0] = a0[0] * cs[0] - a0[1] * sn[0]; v0[1] = a0[0] * sn[0] + a0[1] * cs[0]; v0[2] = a0[2] * cs[1] - a0[3] * sn[1]; v0[3] = a0[2] * sn[1] + a0[3] * cs[1];
                        v1[0] = a1[0] * cs[2] - a1[1] * sn[2]; v1[1] = a1[0] * sn[2] + a1[1] * cs[2]; v1[2] = a1[2] * cs[3] - a1[3] * sn[3]; v1[3] = a1[2] * sn[3] + a1[3] * cs[3]; }
                    u32x4 w; w.x = cvt_pk_bf16(v0[0], v0[1]); w.y = cvt_pk_bf16(v0[2], v0[3]); w.z = cvt_pk_bf16(v1[0], v1[1]); w.w = cvt_pk_bf16(v1[2], v1[3]);
                    *(u32x4*)(dst + 16 * m * 192) = w;
                    asm volatile("" ::: "memory");
                }
            }
        }
    }
};
struct EpiKV {
    static constexpr bool PERM = true;
    unsigned char* KN; unsigned char* V; const float* rstd;
    __device__ __forceinline__ void operator()(const f32x4 (&acc)[2][2][4][2], const pg8::Unit& u, int wr, int wc, int fr, int fq) const {
        const bool lat = u.pm < 128;
        const int b = lat ? (u.pm >> 5) : (u.pm - 128), t0 = lat ? 4 + ((u.pm & 31) << 2) : 0;
        const int dd = 32 * wc + 8 * fq;
        const int offK = fr * 256 + ((dd * 2) ^ ((fr & 7) << 4));
        const int offV = att::v_st(fr, dd);
#pragma unroll
        for (int ai = 0; ai < 2; ++ai) {
            const size_t tb = ((size_t)(b * 8 + u.pn) * NKT + t0 + 2 * ai + wr) * 16384;
            const float* rsp = rstd + u.pm * 256 + 128 * ai + 64 * wr + fr;
            unsigned char* kp = KN + tb + offK; unsigned char* vp = V + tb + offV;
#pragma unroll
            for (int m = 0; m < 4; ++m) {
                const float rs = rsp[16 * m];
#pragma unroll
                for (int bj = 0; bj < 2; ++bj) {
                    const f32x4 v0 = acc[ai][bj][m][0] * rs, v1 = acc[ai][bj][m][1] * rs;
                    u32x4 w; w.x = cvt_pk_bf16(v0[0], v0[1]); w.y = cvt_pk_bf16(v0[2], v0[3]); w.z = cvt_pk_bf16(v1[0], v1[1]); w.w = cvt_pk_bf16(v1[2], v1[3]);
                    if (bj == 0) *(u32x4*)(kp + m * 4096) = w; else *(u32x4*)(vp + m * 4096) = w;
                }
                asm volatile("" ::: "memory");
            }
        }
    }
};

__device__ __forceinline__ void phase_ssd_out(const Args& A, int li, int nrows) {
    const bf16_t* PROJ = (const bf16_t*)(A.ws + WS_BIG); const bf16_t* XS = (const bf16_t*)(A.ws + WS_R2);
    const bf16_t* Y0 = (const bf16_t*)(A.ws + WS_H); const bf16_t* Y1 = (const bf16_t*)(A.ws + WS_R3); bf16_t* CAT = (bf16_t*)(A.ws + WS_R3 + R3_CAT);
    const int tid_ = otid(); const int lane = tid_ & 63, gw = blockIdx.x * 8 + (tid_ >> 6), nw = gridDim.x * 8;
    const float dsk = A.in[I_SSDD][li * 16 + (lane >> 2)];
    float ng[16];
#pragma unroll
    for (int j = 0; j < 16; ++j) ng[j] = A.in[I_SSDNG][li * 1024 + 16 * lane + j];
    for (int r = gw; r < nrows; r += nw) {
        float v[16]; float ss = 0.f;
#pragma unroll
        for (int hh = 0; hh < 2; ++hh) {
            const u32x4 a = *(const u32x4*)(Y0 + (size_t)r * 1024 + 16 * lane + 8 * hh), b = *(const u32x4*)(Y1 + (size_t)r * 1024 + 16 * lane + 8 * hh);
            const u32x4 x = *(const u32x4*)(XS + (size_t)r * 1024 + 16 * lane + 8 * hh), z = *(const u32x4*)(PROJ + (size_t)r * HYB_INP + 16 * lane + 8 * hh);
#pragma unroll
            for (int q = 0; q < 4; ++q) {
                const float y0 = (bflo(a[q]) + bflo(b[q]) + dsk * bflo(x[q])) * silu_f(bflo(z[q])), y1 = (bfhi(a[q]) + bfhi(b[q]) + dsk * bfhi(x[q])) * silu_f(bfhi(z[q]));
                v[8 * hh + 2 * q] = y0; v[8 * hh + 2 * q + 1] = y1; ss += y0 * y0 + y1 * y1; }
        }
#pragma unroll
        for (int o = 16; o >= 1; o >>= 1) ss += __shfl_xor(ss, o);
        const float rstd = rsqrtf(ss * (1.f / 512.f) + EPS);
#pragma unroll
        for (int hh = 0; hh < 2; ++hh) { u32x4 w;
#pragma unroll
            for (int q = 0; q < 4; ++q) w[q] = cvt_pk_bf16(v[8 * hh + 2 * q] * rstd * ng[8 * hh + 2 * q], v[8 * hh + 2 * q + 1] * rstd * ng[8 * hh + 2 * q + 1]);
            *(u32x4*)(CAT + (size_t)r * 2048 + 16 * lane + 8 * hh) = w; }
    }
}

__device__ __forceinline__ void phase_ln_stats(const Args& A, int nrows) {
    const bf16_t* Gb = (const bf16_t*)(A.ws + WS_BIG); float* ST = (float*)(A.ws + WS_RSTD);
    const int tid_ = otid(); const int lane = tid_ & 63, gw = blockIdx.x * 8 + (tid_ >> 6), nw = gridDim.x * 8;
    for (int r = gw; r < nrows; r += nw) {
        float v[32]; float s = 0.f;
#pragma unroll
        for (int j = 0; j < 4; ++j) { const u32x4 w = *(const u32x4*)(Gb + (size_t)r * 4096 + 2048 + 512 * j + 8 * lane);
#pragma unroll
            for (int q = 0; q < 4; ++q) { v[8 * j + 2 * q] = bflo(w[q]); v[8 * j + 2 * q + 1] = bfhi(w[q]); s += v[8 * j + 2 * q] + v[8 * j + 2 * q + 1]; } }
        s = wave_sum(s); const float mu = s * (1.f / 2048.f); float q2 = 0.f;
#pragma unroll
        for (int j = 0; j < 32; ++j) { const float dd = v[j] - mu; q2 += dd * dd; }
        q2 = wave_sum(q2);
        if (lane == 0) { ST[r] = mu; ST[NROW + r] = rsqrtf(q2 * (1.f / 2048.f) + EPS); }
    }
}
__device__ __forceinline__ void phase_spatial(const Args& A, int gi, int nrows, LAS unsigned char* lds) {
    const bf16_t* Gb = (const bf16_t*)(A.ws + WS_BIG); const float* ST = (const float*)(A.ws + WS_RSTD); bf16_t* Ab = (bf16_t*)(A.ws + WS_R1);
    const bf16_t* WSg = (const bf16_t*)(A.ws + WS_W + W_GM + (size_t)gi * WG_SZ + WG_WS);
    const float* lng = A.in[I_GLNG] + (size_t)gi * 2048; const float* lnb = A.in[I_GLNB] + (size_t)gi * 2048; const float* bs = A.in[I_GBS] + (size_t)gi * 1024;
    const int tid = otid(), wid = tid >> 6, lane = tid & 63, r32 = lane & 31, hi = lane >> 5, tb = wid & 3, dh = wid >> 2;
    const int ldsaddr = (int)(unsigned)(uintptr_t)lds;
    for (int unit = blockIdx.x; unit < (nrows / 128) * 8; unit += gridDim.x) {
        const int cb = unit >> 3, gg = unit & 7, r0 = cb * 128;
        __syncthreads();
#pragma unroll
        for (int j = 0; j < 8; ++j) { const int idx = tid + 512 * j, s = idx >> 5, dd = (idx & 31) * 8;
            const u32x4 w = *(const u32x4*)(Gb + (size_t)(r0 + s) * 4096 + 2048 + 256 * gg + dd);
            const float mu = ST[r0 + s], rs = ST[NROW + r0 + s];
            const f32x4 g0 = *(const f32x4*)(lng + 256 * gg + dd), g1 = *(const f32x4*)(lng + 256 * gg + dd + 4), b0 = *(const f32x4*)(lnb + 256 * gg + dd), b1 = *(const f32x4*)(lnb + 256 * gg + dd + 4);
            u32x4 o;
            o.x = cvt_pk_bf16((bflo(w.x) - mu) * rs * g0[0] + b0[0], (bfhi(w.x) - mu) * rs * g0[1] + b0[1]); o.y = cvt_pk_bf16((bflo(w.y) - mu) * rs * g0[2] + b0[2], (bfhi(w.y) - mu) * rs * g0[3] + b0[3]);
            o.z = cvt_pk_bf16((bflo(w.z) - mu) * rs * g1[0] + b1[0], (bfhi(w.z) - mu) * rs * g1[1] + b1[1]); o.w = cvt_pk_bf16((bflo(w.w) - mu) * rs * g1[2] + b1[2], (bfhi(w.w) - mu) * rs * g1[3] + b1[3]);
            *(LAS u32x4*)(lds + ((s >> 6) * 2 + (dd >> 7)) * 16384 + att::v_st(s & 63, dd & 127)) = o; }
        bf16x8 pa[8];
#pragma unroll
        for (int ks = 0; ks < 8; ++ks) pa[ks] = *(const bf16x8*)(WSg + ((size_t)gg * 128 + 32 * tb + r32) * 128 + 16 * ks + 8 * hi);
        __syncthreads();
        f32x16 o[4] = {};
        att::pv_d0(o, ldsaddr + (0 * 2 + dh) * 16384 + att::v_rd_base(lane), pa[0], pa[1], pa[2], pa[3]);
        att::pv_d0(o, ldsaddr + (1 * 2 + dh) * 16384 + att::v_rd_base(lane), pa[4], pa[5], pa[6], pa[7]);
#pragma unroll
        for (int r = 0; r < 16; ++r) { const int t = 32 * tb + att::crow(r, hi), row = r0 + t; const float bsv = bs[gg * 128 + t];
#pragma unroll
            for (int d0 = 0; d0 < 4; ++d0) { const int col = 256 * gg + 128 * dh + 32 * d0 + r32;
                Ab[(size_t)row * 2048 + col] = f2bf(bf2f(Gb[(size_t)row * 4096 + col]) * (o[d0][r] + bsv)); } }
    }
}

__device__ __forceinline__ void phase_tabcvt(const Args& A, int layer) {
    const int gthr = blockIdx.x * NTHR + otid(), nthr = gridDim.x * NTHR;
    for (int p = gthr; p < 2 * NEXP * 128; p += nthr) {
        const int tab = p >> 21, rem = p & ((1 << 21) - 1), e = rem >> 7, p8 = rem & 127, x = p8 >> 4, m = p8 & 15;
        const float* src = (tab ? A.in[I_PV] : A.in[I_PU]) + ((size_t)layer * NEXP + e) * 1024 + 8 * p8;
        const f32x4 a = *(const f32x4*)src, b = *(const f32x4*)(src + 4);
        u32x4 w; w.x = cvt_pk_bf16(a[0], a[1]); w.y = cvt_pk_bf16(a[2], a[3]); w.z = cvt_pk_bf16(b[0], b[1]); w.w = cvt_pk_bf16(b[2], b[3]);
        *(u32x4*)(A.ws + WS_TAB + (size_t)tab * TAB_HALF + (((size_t)x * NEXP + e) * 128 + 8 * m) * 2) = w;
    }
}
#define CASD(a, b) do { const float hi_ = fmaxf(a, b), lo_ = fminf(a, b); a = hi_; b = lo_; } while (0)
__device__ __forceinline__ void sort16(float (&k)[16]) {
#pragma unroll
    for (int sz = 2; sz <= 16; sz <<= 1)
#pragma unroll
        for (int j = sz >> 1; j > 0; j >>= 1)
#pragma unroll
            for (int i = 0; i < 16; ++i) { const int l = i ^ j; if (l > i) { if ((i & sz) == 0 || sz == 16) CASD(k[i], k[l]); else CASD(k[l], k[i]); } }
}
__device__ __forceinline__ void bmerge16(float (&k)[16]) {
#pragma unroll
    for (int j = 8; j > 0; j >>= 1)
#pragma unroll
        for (int i = 0; i < 16; ++i) { const int l = i ^ j; if (l > i) CASD(k[i], k[l]); }
}
__device__ __forceinline__ void merge_top16(float (&a)[16], const float (&b)[16]) {
#pragma unroll
    for (int i = 0; i < 16; ++i) a[i] = fmaxf(a[i], b[15 - i]);
    bmerge16(a);
}
__device__ __forceinline__ void xmerge_top16(float (&a)[16], int mask) {
    float t[16];
#pragma unroll
    for (int i = 0; i < 16; ++i) t[i] = __shfl_xor(a[15 - i], mask);
#pragma unroll
    for (int i = 0; i < 16; ++i) a[i] = fmaxf(a[i], t[i]);
    bmerge16(a);
}
__device__ __forceinline__ void phase_topk(const Args& A, int layer, int nrows, LAS unsigned char* lds) {
    const bf16_t* QP = (const bf16_t*)(A.ws + WS_BIG); int* IDX = (int*)(A.ws + WS_R2); float* GATE = (float*)(A.ws + WS_R2 + R2_GATE);
    const int tid = otid(), wid = tid >> 6, lane = tid & 63, fr = lane & 15, fq = lane >> 4;
    LAS unsigned* scr = (LAS unsigned*)(lds + 2 * 34816) + wid * 512 + fr * 32;
    for (int unit = blockIdx.x; unit < (nrows / 128) * 8; unit += gridDim.x) {
        const int h = unit & 7, r0 = (unit >> 3) * 128;
        __syncthreads();
        { const bf16_t* k1 = (const bf16_t*)(A.ws + WS_W + W_PEER + (size_t)layer * WP_SZ + WP_K1) + (size_t)h * 16384;
#pragma unroll
          for (int j = 0; j < 8; ++j) { const int idx = tid + 512 * j, half = idx >> 11, rem = idx & 2047, key = rem >> 4, c8 = rem & 15;
              const u32x4 w = *(const u32x4*)(k1 + (size_t)half * 8 * 16384 + key * 128 + 8 * c8);
              *(LAS u32x4*)(lds + half * 34816 + key * 272 + c8 * 16) = w; } }
        __syncthreads();
        const int tok = r0 + 16 * wid + fr;
        float top[2][16];
#pragma unroll
        for (int half = 0; half < 2; ++half) {
            bf16x8 qf[4];
#pragma unroll
            for (int ks = 0; ks < 4; ++ks) qf[ks] = *(const bf16x8*)(QP + (size_t)tok * 2048 + 256 * h + 128 * half + 32 * ks + 8 * fq);
            float loc[16];
#pragma unroll
            for (int grp = 0; grp < 2; ++grp) {
                float kk[16];
#pragma unroll
                for (int nbb = 0; nbb < 4; ++nbb) { const int nb = 4 * grp + nbb; f32x4 acc = {0.f, 0.f, 0.f, 0.f};
#pragma unroll
                    for (int ks = 0; ks < 4; ++ks) { const bf16x8 kf = *(const LAS bf16x8*)(lds + half * 34816 + (16 * nb + fr) * 272 + (32 * ks + 8 * fq) * 2);
                        acc = __builtin_amdgcn_mfma_f32_16x16x32_bf16(kf, qf[ks], acc, 0, 0, 0); }
#pragma unroll
                    for (int i = 0; i < 4; ++i) { const unsigned code = 127u - (unsigned)(16 * nb + 4 * fq + i); kk[4 * nbb + i] = __uint_as_float((__float_as_uint(acc[i]) & ~127u) | code); } }
                sort16(kk);
                if (grp == 0) {
#pragma unroll
                    for (int i = 0; i < 16; ++i) loc[i] = kk[i];
                } else merge_top16(loc, kk);
            }
            xmerge_top16(loc, 16); xmerge_top16(loc, 32);
#pragma unroll
            for (int i = 0; i < 16; ++i) top[half][i] = loc[i];
        }
        if (fq < 2) {
#pragma unroll
            for (int i = 0; i < 16; ++i) scr[16 * fq + i] = __float_as_uint(fq == 0 ? top[0][i] : top[1][i]); }
        float fin[16];
#pragma unroll
        for (int aa = 0; aa < 4; ++aa) {
            const float va_k = fq == 0 ? top[0][aa] : fq == 1 ? top[0][4 + aa] : fq == 2 ? top[0][8 + aa] : top[0][12 + aa];
            const float va = __uint_as_float(__float_as_uint(va_k) & ~127u);
            float c[16];
#pragma unroll
            for (int bb = 0; bb < 16; ++bb) { const float s = va + __uint_as_float(__float_as_uint(top[1][bb]) & ~127u);
                c[bb] = __uint_as_float((__float_as_uint(s) & ~255u) | (255u - (unsigned)((4 * fq + aa) * 16 + bb))); }
            if (aa == 0) {
#pragma unroll
                for (int i = 0; i < 16; ++i) fin[i] = c[i];
            } else merge_top16(fin, c);
        }
        xmerge_top16(fin, 16); xmerge_top16(fin, 32);
        float ev[16], es = 0.f; const float mx = __uint_as_float(__float_as_uint(fin[0]) & ~255u);
#pragma unroll
        for (int i = 0; i < 16; ++i) { ev[i] = __expf(__uint_as_float(__float_as_uint(fin[i]) & ~255u) - mx); es += ev[i]; }
        const float inv = 1.f / es;
        asm volatile("s_waitcnt lgkmcnt(0)" ::: "memory");
        int oi[4]; float og[4];
#pragma unroll
        for (int kq = 0; kq < 4; ++kq) {
            const float fk = fq == 0 ? fin[kq] : fq == 1 ? fin[4 + kq] : fq == 2 ? fin[8 + kq] : fin[12 + kq];
            const float fe = fq == 0 ? ev[kq] : fq == 1 ? ev[4 + kq] : fq == 2 ? ev[8 + kq] : ev[12 + kq];
            const unsigned code = 255u - (__float_as_uint(fk) & 255u), a = code >> 4, bq = code & 15u;
            const unsigned i1 = 127u - (scr[a] & 127u), i2 = 127u - (scr[16 + bq] & 127u);
            oi[kq] = (int)(i1 * 128u + i2); og[kq] = fe * inv; }
        *(int4*)(IDX + (size_t)tok * 128 + 16 * h + 4 * fq) = make_int4(oi[0], oi[1], oi[2], oi[3]);
        *(f32x4*)(GATE + (size_t)tok * 128 + 16 * h + 4 * fq) = (f32x4){og[0], og[1], og[2], og[3]};
    }
}
template <class F>
__device__ __forceinline__ void peer_queue_loop(const Args& A, int layer, int phsel, int nrows, LAS unsigned char* smem, F body) {
    unsigned* ctl = (unsigned*)(A.ws + WS_CTL); const int x0 = (int)(xb_xcc_id() & 7u), nblk = nrows / 64;
    LAS unsigned* bcw = (LAS unsigned*)(smem + 16);
    for (int sl = 0; sl < 8; ++sl) { const int x = (x0 + sl) & 7; unsigned* q = ctl + CW_QUEUE + ((layer * 2 + phsel) * 8 + x) * 32;
        for (;;) { __syncthreads(); if (threadIdx.x == 0) *bcw = atomicAdd(q, 1u); __syncthreads(); const int blk = (int)*bcw; if (blk >= nblk) break; body(x, blk); } }
}
__device__ __forceinline__ void phase_peer_u(const Args& A, int layer, int nrows, LAS unsigned char* smem) {
    const bf16_t* H = (const bf16_t*)(A.ws + WS_H); const int* IDX = (const int*)(A.ws + WS_R2); float* PART = (float*)(A.ws + WS_BIG + BIG_PART);
    const bf16_t* U = (const bf16_t*)(A.ws + WS_TAB);
    const int tid_ = otid(); const int wid = tid_ >> 6, lane = tid_ & 63, m = lane & 15, q = lane >> 4;
    peer_queue_loop(A, layer, 0, nrows, smem, [&](int x, int blk) {
        for (int ti = 0; ti < 8; ++ti) {
            const int tok = blk * 64 + wid * 8 + ti;
            const u32x4 hv = *(const u32x4*)(H + (size_t)tok * 1024 + 128 * x + 8 * m);
            float hf[8];
#pragma unroll
            for (int j = 0; j < 4; ++j) { hf[2 * j] = bflo(hv[j]); hf[2 * j + 1] = bfhi(hv[j]); }
            const int* ip = IDX + (size_t)tok * 128 + q; const bf16_t* ub = U + (size_t)x * NEXP * 128 + 8 * m;
            float res0 = 0.f, res1 = 0.f;
#pragma unroll 8
            for (int i = 0; i < 32; ++i) {
                const int e = ip[4 * i]; const u32x4 uv = *(const u32x4*)(ub + (size_t)e * 128);
                float d = 0.f;
#pragma unroll
                for (int j = 0; j < 4; ++j) d += hf[2 * j] * bflo(uv[j]) + hf[2 * j + 1] * bfhi(uv[j]);
                d += __shfl_xor(d, 1); d += __shfl_xor(d, 2); d += __shfl_xor(d, 4); d += __shfl_xor(d, 8);
                if (m == (i & 15)) { if (i < 16) res0 = d; else res1 = d; }
            }
            float* pp = PART + ((size_t)x * NROW + tok) * 128 + q;
            pp[4 * m] = res0; pp[4 * (m + 16)] = res1;
        }
    });
}
__device__ __forceinline__ void phase_coef(const Args& A, int nrows) {
    const float* PART = (const float*)(A.ws + WS_BIG + BIG_PART); const float* GATE = (const float*)(A.ws + WS_R2 + R2_GATE); float* COEF = (float*)(A.ws + WS_R2 + R2_COEF);
    const int gthr = blockIdx.x * NTHR + otid(), nthr = gridDim.x * NTHR;
    for (int p = gthr; p < nrows * 128; p += nthr) { float s = 0.f;
#pragma unroll
        for (int x = 0; x < 8; ++x) s += PART[(size_t)x * NROW * 128 + p];
        COEF[p] = GATE[p] * gelu_f(s); }
}
__device__ __forceinline__ void phase_peer_v(const Args& A, int layer, int nrows, LAS unsigned char* smem) {
    const int* IDX = (const int*)(A.ws + WS_R2); const float* COEF = (const float*)(A.ws + WS_R2 + R2_COEF);
    const bf16_t* V = (const bf16_t*)(A.ws + WS_TAB + TAB_HALF); const float* MODL = (const float*)(A.ws + WS_MOD) + (size_t)layer * 5 * 6144 + 5 * 1024;
    float* XC = (float*)(A.ws + WS_XC);
    const int tid_ = otid(); const int wid = tid_ >> 6, lane = tid_ & 63, m = lane & 15, q = lane >> 4;
    peer_queue_loop(A, layer, 1, nrows, smem, [&](int x, int blk) {
        for (int ti = 0; ti < 8; ++ti) {
            const int tok = blk * 64 + wid * 8 + ti;
            const int* ip = IDX + (size_t)tok * 128 + q; const float* cp = COEF + (size_t)tok * 128 + q; const bf16_t* vb = V + (size_t)x * NEXP * 128 + 8 * m;
            float acc[8];
#pragma unroll
            for (int j = 0; j < 8; ++j) acc[j] = 0.f;
#pragma unroll 8
            for (int i = 0; i < 32; ++i) {
                const int e = ip[4 * i]; const float c = cp[4 * i]; const u32x4 vv = *(const u32x4*)(vb + (size_t)e * 128);
#pragma unroll
                for (int j = 0; j < 4; ++j) { acc[2 * j] += c * bflo(vv[j]); acc[2 * j + 1] += c * bfhi(vv[j]); }
            }
#pragma unroll
            for (int j = 0; j < 8; ++j) { acc[j] += __shfl_xor(acc[j], 16); acc[j] += __shfl_xor(acc[j], 32); }
            if (q == 0) {
                const bool lat = tok < NLAT; float* xp = (lat ? A.out + (size_t)tok * D : XC + (size_t)(tok - NLAT) * D) + 128 * x + 8 * m;
                const float* gp = MODL + (size_t)(lat ? (tok >> 13) : 4) * 6144 + 128 * x + 8 * m;
                const f32x4 g0 = *(const f32x4*)gp, g1 = *(const f32x4*)(gp + 4); f32x4 x0 = *(f32x4*)xp, x1 = *(f32x4*)(xp + 4);
                x0 += g0 * (f32x4){acc[0], acc[1], acc[2], acc[3]}; x1 += g1 * (f32x4){acc[4], acc[5], acc[6], acc[7]};
                *(f32x4*)xp = x0; *(f32x4*)(xp + 4) = x1;
            }
        }
    });
}

#ifndef MK_PER_PHASE
#define MK_PER_PHASE 0
#endif
__device__ __forceinline__ int nr_in(int L) { return L <= 2 ? NROW : NLAT; }
__device__ __forceinline__ int nr_out(int L) { return L <= 1 ? NROW : NLAT; }

__global__ void __launch_bounds__(NTHR, 2) fwd(Args A) {
    extern __shared__ __attribute__((aligned(256))) unsigned char smem_raw[];
    LAS unsigned char* smem = (LAS unsigned char*)smem_raw;
    LAS unsigned char* lds = smem + LDS_BASE;
    const int tid = otid();
    if (tid < 64) ((LAS unsigned*)smem)[tid] = 0u;
    __syncthreads();
    XcdBarrier bar = xcd_barrier_post((unsigned*)(A.ws + WS_CTL), (volatile LAS unsigned*)smem);
    bool need_bar = false;
    const int lo = A.ph_lo, hi = A.ph_hi;
#ifndef PHMASK
#define PHMASK 0xffffffffu
#endif
#define SITE(k) if constexpr (((PHMASK) >> (k)) & 1u)
#define PH(id) if ([&]() -> bool { if ((id) < lo || (id) >= hi) return false; if (need_bar) xcd_barrier(bar); need_bar = true; return true; }())
    unsigned char* ws = A.ws;
    float* XL = A.out; float* XC = (float*)(ws + WS_XC);
    bf16_t* H = (bf16_t*)(ws + WS_H);
    const float* MOD = (const float*)(ws + WS_MOD);

    SITE(0) PH(0) { phase_prologue(A, lds); }
    SITE(1) PH(1) { phase_norm_mod(A.in[I_X], A.in[I_CTX], XL, XC, A.in[I_N1G], MOD, 0, H, NROW); }
    for (int L = 0; L < DEPTH; ++L) {
        const int base = 2 + 16 * L, li = L >> 1; const bool hyb = (L & 1) == 0;
        const float* MODL = MOD + (size_t)L * 5 * 6144;
        unsigned char* WH = ws + WS_W + W_HYB + (size_t)li * WH_SZ; unsigned char* WG = ws + WS_W + W_GM + (size_t)li * WG_SZ; unsigned char* WP = ws + WS_W + W_PEER + (size_t)L * WP_SZ;
        if (hyb) {
            SITE(2) PH(base + 0) { pg8::Gemm g{H, (const bf16_t*)(WH + WH_IN), nr_in(L), HYB_INP, 1024, 1024, 1024};
                pg8::EpiBf16<0> e{(bf16_t*)(ws + WS_BIG), HYB_INP}; pg8::gemm_phase(lds, g, e); }
            SITE(3) PH(base + 1) { phase_conv(A, li); }
            SITE(4) PH(base + 2) {
                SITE(18) { pg8::Gemm g{(const bf16_t*)(ws + WS_BIG) + C_CQ, (const bf16_t*)(WH + WH_QB), L == 0 ? NROW : NLAT, 1536, 384, HYB_INP, 384};
                  EpiQ e{(bf16_t*)(ws + WS_R1 + R1_Q), (const float*)(ws + WS_RSTD), (const float*)(ws + WS_ROPE)}; pg8::gemm_phase(lds, g, e); }
                SITE(19) { pg8::Gemm g{(const bf16_t*)(ws + WS_BIG) + C_CKV, (const bf16_t*)(WH + WH_KVB), NROW, 2048, 256, HYB_INP, 256};
                  EpiKV e{ws + WS_R1 + R1_KN, ws + WS_R1 + R1_V, (const float*)(ws + WS_RSTD) + NROW}; pg8::gemm_phase(lds, g, e); }
                SITE(20) for (int u = blockIdx.x; u < 528; u += gridDim.x) ssd::g_unit((const bf16_t*)(ws + WS_R2 + R2_BC), (bf16_t*)(ws + WS_BIG + BIG_G), u);
            }
            SITE(5) PH(base + 3) {
                SITE(21) for (int u = blockIdx.x; u < 256; u += gridDim.x)
                    ssd::ssd_unit(u, (const bf16_t*)(ws + WS_R2), (const bf16_t*)(ws + WS_R2 + R2_BC), (const float*)(ws + WS_BIG + BIG_DT), (const bf16_t*)(ws + WS_BIG + BIG_G),
                                  A.in[I_ALOG] + li * 32, (bf16_t*)(ws + WS_H), (bf16_t*)(ws + WS_R3), lds);
                const int nau = L == 0 ? 1024 + 32 : 1024;
                SITE(22) for (int au = blockIdx.x; au < nau; au += gridDim.x) {
                    int b, h, qrow0, orow0, nt;
                    if (au < 1024) { b = au >> 8; h = au & 7; const int qb = (au >> 3) & 31; qrow0 = 256 + 256 * qb; orow0 = b * 8192 + 256 * qb; nt = NKT; }
                    else { const int cu = au - 1024; b = cu >> 3; h = cu & 7; qrow0 = 0; orow0 = NLAT + 256 * b; nt = 4; }
                    const size_t bh = (size_t)(b * 8 + h);
                    att::attn_unit((const bf16_t*)(ws + WS_R1 + R1_Q) + (bh * NKEY + qrow0) * 192, ws + WS_R1 + R1_KN + bh * NKT * 16384, ws + WS_BIG + BIG_KR + (size_t)b * NKT * 8192,
                                   ws + WS_R1 + R1_V + bh * NKT * 16384, (bf16_t*)(ws + WS_R3 + R3_CAT) + (size_t)orow0 * 2048 + 1024 + 128 * h, nt, lds);
                }
            }
            SITE(6) PH(base + 4) { phase_ssd_out(A, li, nr_out(L)); }
        } else {
            SITE(7) PH(base + 0) { pg8::Gemm g{H, (const bf16_t*)(WG + WG_IN), nr_out(L), 4096, 1024, 1024, 1024};
                pg8::EpiBf16<1> e{(bf16_t*)(ws + WS_BIG), 4096}; pg8::gemm_phase(lds, g, e); }
            SITE(8) PH(base + 1) { phase_ln_stats(A, nr_out(L)); }
            SITE(9) PH(base + 2) { phase_spatial(A, li, nr_out(L), lds); }
        }
        SITE(10) PH(base + 5) { pg8::Gemm g{hyb ? (const bf16_t*)(ws + WS_R3 + R3_CAT) : (const bf16_t*)(ws + WS_R1), hyb ? (const bf16_t*)(WH + WH_OUT) : (const bf16_t*)(WG + WG_OUT), nr_out(L), 1024, 2048, 2048, 2048};
            pg8::EpiResid e{XL, XC, MODL + 2 * 1024}; pg8::gemm_phase(lds, g, e); }
        SITE(11) PH(base + 6) { phase_norm_mod(XL, XC, nullptr, nullptr, A.in[I_N2G] + L * 1024, MODL, 3, H, nr_out(L)); phase_tabcvt(A, L); }
        SITE(12) PH(base + 7) { pg8::Gemm g{H, (const bf16_t*)(WP + WP_Q), nr_out(L), 2048, 1024, 1024, 1024};
            pg8::EpiBf16<0> e{(bf16_t*)(ws + WS_BIG), 2048}; pg8::gemm_phase(lds, g, e); }
        SITE(13) PH(base + 8) { phase_topk(A, L, nr_out(L), lds); }
        SITE(14) PH(base + 9) { phase_peer_u(A, L, nr_out(L), smem); }
        SITE(15) PH(base + 10) { phase_coef(A, nr_out(L)); }
        SITE(16) PH(base + 11) { phase_peer_v(A, L, nr_out(L), smem); }
        SITE(17) PH(base + 12) { if (L < DEPTH - 1) phase_norm_mod(XL, XC, nullptr, nullptr, A.in[I_N1G] + (L + 1) * 1024, MOD + (size_t)(L + 1) * 5 * 6144, 0, H, nr_in(L + 1));
                        else phase_final_norm(XL, A.in[I_FNG]); }
    }
#undef PH
}

#ifdef MK_TAP
__global__ void tap_kernel(const unsigned short* buf, size_t pitch, size_t col0, size_t ncols, size_t nrows, float* out) {
    const size_t n = ncols * nrows;
    for (size_t i = (size_t)blockIdx.x * blockDim.x + threadIdx.x; i < (size_t)NLAT * D; i += (size_t)gridDim.x * blockDim.x) {
        float s = 0.f; for (size_t j = i; j < n; j += (size_t)NLAT * D) s += (float)buf[(j / ncols) * pitch + col0 + (j % ncols)]; out[i] = s; }
}
#endif
extern "C" void kernel_launch(void* const* d_in, const int* in_sizes, int n_in, void* d_out, int out_size, void* d_ws, size_t ws_size, hipStream_t stream) {
    static int grid = 0;
    if (grid == 0) {
        if (n_in != N_IN || out_size != NLAT * D || ws_size < WS_END) { fprintf(stderr, "kernel_launch: unexpected shapes (n_in %d out %d ws %zu, need %zu)\n", n_in, out_size, ws_size, (size_t)WS_END); grid = -1; return; }
        int dev = 0, cus = 0, per_cu = 0;
        if (hipGetDevice(&dev) != hipSuccess || hipDeviceGetAttribute(&cus, hipDeviceAttributeMultiprocessorCount, dev) != hipSuccess) { grid = -1; return; }
        if (hipFuncSetAttribute((const void*)fwd, hipFuncAttributeMaxDynamicSharedMemorySize, LDS_BYTES) != hipSuccess) { fprintf(stderr, "kernel_launch: hipFuncSetAttribute failed\n"); grid = -1; return; }
        if (hipOccupancyMaxActiveBlocksPerMultiprocessor(&per_cu, (const void*)fwd, NTHR, LDS_BYTES) != hipSuccess || per_cu < 1) { fprintf(stderr, "kernel_launch: occupancy query says %d\n", per_cu); }
        (void)hipGetLastError();
        grid = cus;
    }
    if (grid < 0) return;
    (void)hipMemsetAsync((char*)d_ws + WS_CTL, 0, CTL_BYTES, stream);
    Args a{};
    for (int i = 0; i < N_IN; ++i) a.in[i] = (const float*)d_in[i];
    a.out = (float*)d_out; a.ws = (unsigned char*)d_ws;
#if MK_PER_PHASE
    for (int id = 0; id < 2 + 16 * DEPTH; ++id) {
        if (id >= 2) { const int L = (id - 2) / 16, s = (id - 2) % 16; if (s > 12) continue; if ((L & 1) && (s == 3 || s == 4)) continue; }
#ifdef MK_CUT
#ifdef MK_TAP
        if (id >= MK_CUT) continue;
#else
        if (id >= MK_CUT && id != 2 + 16 * (DEPTH - 1) + 12) continue;
#endif
#endif
        a.ph_lo = id; a.ph_hi = id + 1;
        hipLaunchKernelGGL(fwd, dim3(grid), dim3(NTHR), LDS_BYTES, stream, a);
    }
#ifdef MK_TAP
    { const size_t tp[5] = {MK_TAP}; hipLaunchKernelGGL(tap_kernel, dim3(2048), dim3(256), 0, stream, (const unsigned short*)((const char*)d_ws + tp[0]), tp[1], tp[2], tp[3], tp[4], (float*)d_out); }
#endif
#else
    a.ph_lo = 0; a.ph_hi = 2 + 16 * DEPTH;
    hipLaunchKernelGGL(fwd, dim3(grid), dim3(NTHR), LDS_BYTES, stream, a);
#endif
    const hipError_t le = hipPeekAtLastError();
    if (le != hipSuccess) fprintf(stderr, "kernel_launch: launch failed: %s\n", hipGetErrorName(le));
}
```

```cpp
#include <hip/hip_runtime.h>
#include <cstdio>
#include <cstdint>

#define LAS __attribute__((address_space(3)))
typedef unsigned short bf16_t;
typedef short bf16x8 __attribute__((ext_vector_type(8)));
typedef short s16x4 __attribute__((ext_vector_type(4)));
typedef float f32x2 __attribute__((ext_vector_type(2)));
typedef float f32x4 __attribute__((ext_vector_type(4)));
typedef float f32x16 __attribute__((ext_vector_type(16)));
typedef unsigned u32x2 __attribute__((ext_vector_type(2)));
typedef unsigned u32x4 __attribute__((ext_vector_type(4)));

constexpr int D = 1024, NB = 4, SEQ = 8192, DEPTH = 4, CTXL = 256;
constexpr int NLAT = NB * SEQ, NCTX = NB * CTXL, NROW = NLAT + NCTX;
constexpr int HYB_IN = 3280, HYB_INP = 3328;
constexpr int C_Z = 0, C_XBC = 1024, C_DT = 2560, C_CQ = 2576, C_CKV = 2960, C_KR = 3216;
constexpr int NKEY = SEQ + CTXL, NKT = NKEY / 64;
constexpr float EPS = 1e-6f;
constexpr float QSCALE = 0.07216878364870322f * 1.4426950408889634f;
constexpr int NEXP = 16384;

enum { I_X = 0, I_C, I_CTX, I_CCTX, I_ADAW, I_ADAB, I_N1G, I_N2G, I_HWIN, I_CONVW, I_CONVB, I_ALOG, I_DTB, I_SSDD, I_SSDNG, I_QNG, I_WQB, I_KVNG, I_WKVB,
       I_HWOUT, I_GWIN, I_GLNG, I_GLNB, I_GWS, I_GBS, I_GWOUT, I_PWQ, I_PK1, I_PK2, I_PU, I_PV, I_FNG, N_IN };

constexpr size_t al256(size_t x) { return (x + 255) & ~(size_t)255; }
constexpr size_t WS_CTL = 0, CTL_BYTES = 65536;
constexpr size_t WS_MOD = WS_CTL + CTL_BYTES;
constexpr size_t WS_ROPE = WS_MOD + al256((size_t)DEPTH * 5 * 6144 * 4);
constexpr size_t WS_RSTD = WS_ROPE + (size_t)2 * SEQ * 32 * 4;
constexpr size_t WS_W = WS_RSTD + al256((size_t)2 * NROW * 4);
constexpr size_t W_HYB = 0;
constexpr size_t WH_IN = 0, WH_QB = WH_IN + (size_t)HYB_INP * 1024 * 2, WH_KVB = WH_QB + (size_t)1536 * 384 * 2, WH_OUT = WH_KVB + (size_t)2048 * 256 * 2,
                 WH_SZ = WH_OUT + (size_t)1024 * 2048 * 2;
constexpr size_t W_GM = W_HYB + 2 * WH_SZ;
constexpr size_t WG_IN = 0, WG_OUT = WG_IN + (size_t)4096 * 1024 * 2, WG_WS = WG_OUT + (size_t)1024 * 2048 * 2, WG_SZ = WG_WS + (size_t)8 * 128 * 128 * 2;
constexpr size_t W_PEER = W_GM + 2 * WG_SZ;
constexpr size_t WP_Q = 0, WP_K1 = WP_Q + (size_t)2048 * 1024 * 2, WP_K2 = WP_K1 + (size_t)8 * 128 * 128 * 2, WP_SZ = WP_K2 + (size_t)8 * 128 * 128 * 2;
constexpr size_t W_TOTAL = W_PEER + 4 * WP_SZ;
constexpr size_t WS_TAB = WS_W + al256(W_TOTAL);
constexpr size_t TAB_HALF = (size_t)NEXP * 1024 * 2;
constexpr size_t WS_XC = WS_TAB + 2 * TAB_HALF;
constexpr size_t WS_H = WS_XC + (size_t)NCTX * D * 4;
constexpr size_t WS_BIG = WS_H + (size_t)NROW * D * 2;
constexpr size_t BIG_BYTES = (size_t)NROW * 4096 * 2;
constexpr size_t BIG_DT = (size_t)NROW * HYB_INP * 2;
constexpr size_t BIG_G = BIG_DT + (size_t)NROW * 32 * 4;
constexpr size_t BIG_KR = BIG_G + (size_t)528 * 128 * 128 * 2;
constexpr size_t BIG_PART = (size_t)NROW * 2048 * 2;
static_assert(BIG_KR + (size_t)NB * NKT * 8192 <= BIG_BYTES, "BIG tail");
constexpr size_t WS_R1 = WS_BIG + BIG_BYTES;
constexpr size_t R1_Q = 0, R1_KN = R1_Q + (size_t)NB * 8 * NKEY * 192 * 2, R1_V = R1_KN + (size_t)NB * 8 * NKT * 16384, R1_BYTES = R1_V + (size_t)NB * 8 * NKT * 16384;
constexpr size_t WS_R2 = WS_R1 + R1_BYTES;
constexpr size_t R2_BC = (size_t)NROW * 1024 * 2, R2_BYTES = R2_BC + (size_t)NROW * 512 * 2;
constexpr size_t R2_GATE = (size_t)NROW * 128 * 4, R2_COEF = 2 * R2_GATE;
constexpr size_t WS_R3 = WS_R2 + R2_BYTES;
constexpr size_t R3_CAT = (size_t)NROW * 1024 * 2, R3_BYTES = R3_CAT + (size_t)NROW * 2048 * 2;
constexpr size_t WS_END = WS_R3 + R3_BYTES;
static_assert(WS_END <= ((size_t)1 << 30), "workspace must fit 1 GiB");

constexpr int CW_QUEUE = 4096;

typedef __bf16 bf16x2_t __attribute__((ext_vector_type(2)));
__device__ __forceinline__ unsigned cvt_pk_bf16(float lo, float hi) { const f32x2 v = {lo, hi}; const bf16x2_t b = __builtin_convertvector(v, bf16x2_t); return __builtin_bit_cast(unsigned, b); }
__device__ __forceinline__ bf16_t f2bf(float f) { return (bf16_t)(cvt_pk_bf16(f, 0.f) & 0xffffu); }
__device__ __forceinline__ float bf2f(unsigned b) { return __uint_as_float(b << 16); }
__device__ __forceinline__ float bflo(unsigned w) { return __uint_as_float(w << 16); }
__device__ __forceinline__ float bfhi(unsigned w) { return __uint_as_float(w & 0xffff0000u); }
__device__ __forceinline__ float wave_sum(float v) {
#pragma unroll
    for (int o = 32; o >= 1; o >>= 1) v += __shfl_xor(v, o);
    return v;
}
__device__ __forceinline__ int otid() { int t = threadIdx.x; asm volatile("" : "+v"(t)); return t; }
__device__ __forceinline__ float silu_f(float x) { return x / (1.f + __expf(-x)); }
__device__ __forceinline__ float softplus_f(float x) { return x > 20.f ? x : log1pf(__expf(x)); }
__device__ __forceinline__ f32x2 gelu_pk(f32x2 v) {
    const f32x2 av = __builtin_elementwise_abs(v), d = av * 0.2316418882f + 1.0f;
    f32x2 t; t.x = __builtin_amdgcn_rcpf(d.x); t.y = __builtin_amdgcn_rcpf(d.y);
    f32x2 q = t * 0.5307027145f + (-0.7265760135f); q = q * t + 0.7107068705f; q = q * t + (-0.142248368f); q = q * t + 0.127414796f; q = q * t;
    const f32x2 s = (v * v) * (-0.72134752044f);
    f32x2 e; e.x = __builtin_amdgcn_exp2f(s.x); e.y = __builtin_amdgcn_exp2f(s.y);
    const f32x2 m = v * (q * e), r = v - m;
    f32x2 o; o.x = v.x < 0.f ? m.x : r.x; o.y = v.y < 0.f ? m.y : r.y; return o;
}
__device__ __forceinline__ float gelu_f(float x) { f32x2 v = {x, 0.f}; return gelu_pk(v).x; }

__device__ __forceinline__ int row_mb(int r) { return r < NLAT ? (r >> 13) : 4; }

#define XB_TMO      128
#define XB_XCNT(j)  (256  + 64 * (j))
#define XB_XSUB(j)  (1280 + 64 * (j))
#define XB_XGEN(j)  (2304 + 64 * (j))
#define XB_TOP      3328
#define XB_TOPGEN   3392
#define XCD_BAR_WORDS 3456
#define XB_SPIN_CAP (1u << 22)
__device__ __forceinline__ unsigned xb_ld(unsigned* p)              { return __hip_atomic_load(p, __ATOMIC_RELAXED, __HIP_MEMORY_SCOPE_AGENT); }
__device__ __forceinline__ unsigned xb_add(unsigned* p, unsigned v) { return __hip_atomic_fetch_add(p, v, __ATOMIC_RELAXED, __HIP_MEMORY_SCOPE_AGENT); }
__device__ __forceinline__ unsigned xb_xcc_id() { return (unsigned)__builtin_amdgcn_s_getreg((3 << 11) | 20) & 0xFu; }
#define XB_SPIN(cond, bar) do { unsigned _sp = 0; while (cond) { __builtin_amdgcn_s_sleep(1); \
    if ((++_sp & 255u) == 0u) { if (xb_ld(&(bar)[XB_TMO])) break; if (_sp > XB_SPIN_CAP) { atomicAdd(&(bar)[XB_TMO], 1u); break; } } } } while (0)
struct XcdBarrier { unsigned* bar; unsigned x; volatile LAS unsigned* st; };
__device__ __forceinline__ XcdBarrier xcd_barrier_post(unsigned* bar, volatile LAS unsigned* st) {
    XcdBarrier b; b.bar = bar; b.x = xb_xcc_id(); b.st = st;
    if (threadIdx.x == 0) (void)xb_add(&bar[XB_XCNT(b.x)], 1u);
    return b;
}
__device__ __forceinline__ void xcd_barrier_complete(unsigned* bar, unsigned x, unsigned& nloc, unsigned& nx) {
    const unsigned G = gridDim.x * gridDim.y * gridDim.z;
    unsigned sum, cnt, mine, sp = 0u;
    for (;;) {
        sum = 0u; cnt = 0u; mine = 0u;
#pragma unroll
        for (unsigned j = 0; j < 16; ++j) { const unsigned c = xb_ld(&bar[XB_XCNT(j)]); sum += c; cnt += (c > 0u) ? 1u : 0u; mine = (j == x) ? c : mine; }
        if (sum == G) break;
        __builtin_amdgcn_s_sleep(1);
        if ((++sp & 255u) == 0u) { if (xb_ld(&bar[XB_TMO])) break; if (sp > XB_SPIN_CAP) { atomicAdd(&bar[XB_TMO], 1u); break; } }
    }
    nloc = mine > 0u ? mine : 1u; nx = cnt > 0u ? cnt : 1u;
}
__device__ __forceinline__ void xcd_barrier(const XcdBarrier& b) {
    asm volatile("s_waitcnt vmcnt(0)" ::: "memory");
    __syncthreads();
    if (threadIdx.x == 0) {
        unsigned* bar = b.bar;
        __builtin_amdgcn_s_waitcnt(0);
        unsigned nloc = b.st[0], nx = b.st[1];
        if (nloc == 0u) { xcd_barrier_complete(bar, b.x, nloc, nx); b.st[0] = nloc; b.st[1] = nx; }
        const unsigned old = xb_add(&bar[XB_XSUB(b.x)], 1u);
        const unsigned gen = old / nloc;
        if (old + 1u == (gen + 1u) * nloc) {
            __builtin_amdgcn_fence(__ATOMIC_RELEASE, "agent");
            asm volatile("s_waitcnt vmcnt(0)" ::: "memory");
            const unsigned og = xb_add(&bar[XB_TOP], 1u);
            const unsigned tg = og / nx;
            if (og + 1u == (tg + 1u) * nx) xb_add(&bar[XB_TOPGEN], 1u);
            else XB_SPIN(xb_ld(&bar[XB_TOPGEN]) == tg, bar);
            __builtin_amdgcn_fence(__ATOMIC_ACQUIRE, "agent");
            xb_add(&bar[XB_XGEN(b.x)], 1u);
            asm volatile("s_waitcnt vmcnt(0)" ::: "memory");
        } else {
            XB_SPIN(xb_ld(&bar[XB_XGEN(b.x)]) == gen, bar);
            __builtin_amdgcn_fence(__ATOMIC_ACQUIRE, "agent");
            asm volatile("s_waitcnt vmcnt(0)" ::: "memory");
        }
    }
    __syncthreads();
}

namespace pg8 {
constexpr int BM = 256, BK = 64, HALF = 128, HTB = HALF * BK * 2, STAGE_BYTES = 8 * HTB, NXCD = 8, WGM = 8;
__host__ __device__ __forceinline__ int lds_byte(int r, int c) { const int st = (r >> 4) * 2 + (c >> 5), rr = r & 15, cc = c & 31, ob = rr * 64 + cc * 2; return st * 1024 + (ob ^ (((ob >> 9) & 1) << 5)); }
__host__ __device__ __forceinline__ void stage_rc(int b, int& R, int& C) { const int st = b / 1024, sb = b % 1024, swz = sb ^ (((sb >> 9) & 1) << 5); R = (st >> 1) * 16 + swz / 64; C = (st & 1) * 32 + (swz % 64) / 2; }
__host__ __device__ __forceinline__ int perm32(int rho) { const int n = rho >> 4, i = rho & 15; return 8 * (i >> 2) + 4 * n + (i & 3); }
struct Unit { int pm, pn; };
struct Gemm { const bf16_t* A; const bf16_t* Bt; int M, N, K, lda, ldb; };
struct StaticOrder {
    int nM, nN, nwg, G, c;
    __device__ void init(int M, int N, int G_, int c_) { nM = M / BM; nN = N / BM; nwg = nM * nN; G = G_; c = c_; }
    __device__ bool next(int i, Unit& u) const {
        const long L = (long)i * G + c; if (L >= nwg) return false;
        int wgid = (int)L; { const int q = nwg / NXCD, r = nwg % NXCD, xcd = wgid % NXCD, off = wgid / NXCD; wgid = (xcd < r ? xcd * (q + 1) : r * (q + 1) + (xcd - r) * q) + off; }
        const int nig = WGM * nN, gid = wgid / nig, fm = gid * WGM, gsz = (nM - fm) < WGM ? (nM - fm) : WGM;
        u.pm = fm + ((wgid % nig) % gsz); u.pn = (wgid % nig) / gsz; return true;
    }
};
template <class Epi>
__device__ __forceinline__ void gemm_phase(LAS unsigned char* lds, const Gemm g, const Epi& E) {
    const int tid = otid(), wid = __builtin_amdgcn_readfirstlane(tid >> 6), lane = tid & 63, wr = wid >> 2, wc = wid & 3, fr = lane & 15, fq = lane >> 4;
    StaticOrder S; S.init(g.M, g.N, (int)gridDim.x, (int)blockIdx.x);
    int K = g.K; asm volatile("" : "+s"(K));
    const int nt = K / BK;
    unsigned voffA[2], voffB[2];
#pragma unroll
    for (int i = 0; i < 2; ++i) { int R, C; stage_rc(tid * 16 + i * 8192, R, C); const int Rb = Epi::PERM ? ((R & ~31) + perm32(R & 31)) : R;
        voffA[i] = (unsigned)(R * g.lda + C) * 2u; voffB[i] = (unsigned)(Rb * g.ldb + C) * 2u; }
    const size_t kstep = (size_t)(BK * 2);
    const size_t hstepA = (size_t)HALF * g.lda * 2, hstepB = (size_t)HALF * g.ldb * 2;
    const size_t tstepA = 2 * hstepA, tstepB = 2 * hstepB;
    const unsigned ldsw = (unsigned)wid * 1024u;
    const int aoff = lds_byte(wr * 64 + fr, fq * 8), boff = lds_byte(wc * 32 + fr, fq * 8);
#define PG8_SA(b, h) (((b) * 2 + (h)) * HTB)
#define PG8_SB(b, h) ((4 + (b) * 2 + (h)) * HTB)
#define PG8_STAGE(bufoff, gbase, voff) do { _Pragma("unroll") for (int _i = 0; _i < 2; ++_i) \
        __builtin_amdgcn_global_load_lds((const unsigned*)((const char*)(gbase) + (voff)[_i]), (LAS unsigned*)(lds + (bufoff) + ldsw + _i * 8192), 16, 0, 0); } while (0)
#define PG8_LDA(dst, b, h) do { _Pragma("unroll") for (int m = 0; m < 4; ++m) _Pragma("unroll") for (int k = 0; k < 2; ++k) dst[m][k] = *(const LAS bf16x8*)(lds + PG8_SA(b, h) + aoff + m * 2048 + k * 1024); } while (0)
#define PG8_LDB(dst, b, h) do { _Pragma("unroll") for (int n = 0; n < 2; ++n) _Pragma("unroll") for (int k = 0; k < 2; ++k) dst[n][k] = *(const LAS bf16x8*)(lds + PG8_SB(b, h) + boff + n * 2048 + k * 1024); } while (0)
#define PG8_MMA(ai, bj, At, Bt) do { __builtin_amdgcn_s_setprio(1); _Pragma("unroll") for (int m = 0; m < 4; ++m) _Pragma("unroll") for (int n = 0; n < 2; ++n) _Pragma("unroll") for (int k = 0; k < 2; ++k) \
        acc[ai][bj][m][n] = __builtin_amdgcn_mfma_f32_16x16x32_bf16(Bt[n][k], At[m][k], acc[ai][bj][m][n], 0, 0, 0); __builtin_amdgcn_s_setprio(0); } while (0)
#define PG8_WAIT_V(n) asm volatile("s_waitcnt vmcnt(" #n ")" ::: "memory")
#define PG8_WAIT_L(n) asm volatile("s_waitcnt lgkmcnt(" #n ")" ::: "memory")
#define PG8_BAR __builtin_amdgcn_s_barrier()
#define PG8_SCHED __builtin_amdgcn_sched_barrier(0)
    Unit cur, nxt; int ui = 0;
    if (!S.next(0, cur)) return;
    f32x4 acc[2][2][4][2];
#pragma unroll
    for (int a = 0; a < 2; ++a)
#pragma unroll
        for (int b = 0; b < 2; ++b)
#pragma unroll
            for (int m = 0; m < 4; ++m)
#pragma unroll
                for (int n = 0; n < 2; ++n) acc[a][b][m][n] = (f32x4){0.f, 0.f, 0.f, 0.f};
    bf16x8 At[4][2], B0[2][2], B1[2][2];
    const char* cA = (const char*)g.A + (size_t)cur.pm * tstepA; const char* cB = (const char*)g.Bt + (size_t)cur.pn * tstepB;
    PG8_STAGE(PG8_SB(0, 0), cB, voffB); PG8_STAGE(PG8_SB(0, 1), cB + hstepB, voffB); PG8_STAGE(PG8_SA(0, 0), cA, voffA); PG8_STAGE(PG8_SA(0, 1), cA + hstepA, voffA);
    if (wr == 1) PG8_BAR;
    PG8_WAIT_V(2); PG8_BAR;
    PG8_STAGE(PG8_SB(1, 0), cB + kstep, voffB); PG8_STAGE(PG8_SA(1, 0), cA + kstep, voffA); PG8_STAGE(PG8_SB(1, 1), cB + hstepB + kstep, voffB);
    PG8_WAIT_V(6); PG8_BAR;
    for (;;) {
        const bool has_next = S.next(ui + 1, nxt);
        const char* nA = has_next ? (const char*)g.A + (size_t)nxt.pm * tstepA : cA; const char* nB = has_next ? (const char*)g.Bt + (size_t)nxt.pn * tstepB : cB;
        for (int t = 0; t < nt; t += 2) {
            const bool last = (t == nt - 2);
            const char* a1 = cA + (size_t)(t + 1) * kstep;
            const char* a2 = last ? nA : cA + (size_t)(t + 2) * kstep; const char* b2 = last ? nB : cB + (size_t)(t + 2) * kstep;
            const char* a3 = a2 + kstep; const char* b3 = b2 + kstep;
            PG8_LDB(B0, 0, 0); PG8_LDB(B1, 0, 1); PG8_SCHED; PG8_LDA(At, 0, 0); PG8_STAGE(PG8_SA(1, 1), a1 + hstepA, voffA);
            PG8_WAIT_V(8); PG8_WAIT_L(0); PG8_BAR; PG8_MMA(0, 0, At, B0); PG8_MMA(0, 1, At, B1); PG8_BAR; PG8_SCHED;
            PG8_LDA(At, 0, 1); PG8_STAGE(PG8_SB(0, 0), b2, voffB); PG8_STAGE(PG8_SB(0, 1), b2 + hstepB, voffB); PG8_STAGE(PG8_SA(0, 0), a2, voffA);
            PG8_WAIT_V(8); PG8_WAIT_L(0); PG8_BAR; PG8_MMA(1, 0, At, B0); PG8_MMA(1, 1, At, B1); PG8_BAR; PG8_SCHED;
            PG8_LDB(B0, 1, 0); PG8_LDB(B1, 1, 1); PG8_SCHED; PG8_LDA(At, 1, 0); PG8_STAGE(PG8_SA(0, 1), a2 + hstepA, voffA);
            PG8_WAIT_V(8); PG8_WAIT_L(0); PG8_BAR; PG8_MMA(0, 0, At, B0); PG8_MMA(0, 1, At, B1); PG8_BAR; PG8_SCHED;
            PG8_LDA(At, 1, 1); PG8_STAGE(PG8_SB(1, 0), b3, voffB); PG8_STAGE(PG8_SB(1, 1), b3 + hstepB, voffB); PG8_STAGE(PG8_SA(1, 0), a3, voffA);
            PG8_WAIT_V(8); PG8_WAIT_L(0); PG8_BAR; PG8_MMA(1, 0, At, B0); PG8_MMA(1, 1, At, B1); PG8_BAR; PG8_SCHED;
        }
        if (wr == 0) PG8_BAR;
        { const int l2_ = otid() & 63; E(acc, cur, wr, wc, l2_ & 15, l2_ >> 4); }
        if (!has_next) break;
#pragma unroll
        for (int a = 0; a < 2; ++a)
#pragma unroll
            for (int b = 0; b < 2; ++b)
#pragma unroll
                for (int m = 0; m < 4; ++m)
#pragma unroll
                    for (int n = 0; n < 2; ++n) acc[a][b][m][n] = (f32x4){0.f, 0.f, 0.f, 0.f};
        cur = nxt; cA = nA; cB = nB; ++ui;
        if (wr == 1) PG8_BAR;
    }
    PG8_WAIT_V(0);
    PG8_BAR;
#undef PG8_SA
#undef PG8_SB
#undef PG8_STAGE
#undef PG8_LDA
#undef PG8_LDB
#undef PG8_MMA
#undef PG8_WAIT_V
#undef PG8_WAIT_L
#undef PG8_BAR
#undef PG8_SCHED
}

template <int ACT> struct EpiBf16 {
    static constexpr bool PERM = true;
    bf16_t* O; int ldc;
    __device__ __forceinline__ void operator()(const f32x4 (&acc)[2][2][4][2], const Unit& u, int wr, int wc, int fr, int fq) const {
        const int row0 = u.pm * BM + wr * 64 + fr, col0 = u.pn * BM + wc * 32 + 8 * fq;
#pragma unroll
        for (int ai = 0; ai < 2; ++ai)
#pragma unroll
            for (int m = 0; m < 4; ++m) { bf16_t* rowp = O + (size_t)(row0 + ai * HALF + m * 16) * ldc + col0;
#pragma unroll
                for (int bj = 0; bj < 2; ++bj) { f32x4 v0 = acc[ai][bj][m][0], v1 = acc[ai][bj][m][1];
                    if (ACT == 1) { f32x2 a = gelu_pk((f32x2){v0[0], v0[1]}), b = gelu_pk((f32x2){v0[2], v0[3]}), c = gelu_pk((f32x2){v1[0], v1[1]}), d = gelu_pk((f32x2){v1[2], v1[3]});
                        v0 = (f32x4){a.x, a.y, b.x, b.y}; v1 = (f32x4){c.x, c.y, d.x, d.y}; }
                    u32x4 w; w.x = cvt_pk_bf16(v0[0], v0[1]); w.y = cvt_pk_bf16(v0[2], v0[3]); w.z = cvt_pk_bf16(v1[0], v1[1]); w.w = cvt_pk_bf16(v1[2], v1[3]);
                    *(u32x4*)(rowp + bj * HALF) = w; } }
    }
};
struct EpiResid {
    static constexpr bool PERM = false;
    float* xl; float* xc; const float* gate;
    __device__ __forceinline__ void operator()(const f32x4 (&acc)[2][2][4][2], const Unit& u, int wr, int wc, int fr, int fq) const {
        const int rbase = u.pm * BM; const bool lat = rbase < NLAT;
        float* X = lat ? xl + (size_t)rbase * D : xc + (size_t)(rbase - NLAT) * D;
        const float* gp = gate + (size_t)(lat ? (rbase >> 13) : 4) * 6144;
        const int row0 = wr * 64 + fr, col0 = u.pn * BM + wc * 32 + 4 * fq;
        f32x4 gv[2][2];
#pragma unroll
        for (int bj = 0; bj < 2; ++bj)
#pragma unroll
            for (int n = 0; n < 2; ++n) gv[bj][n] = *(const f32x4*)(gp + col0 + bj * HALF + n * 16);
#pragma unroll
        for (int ai = 0; ai < 2; ++ai)
#pragma unroll
            for (int m = 0; m < 4; ++m) { float* rowp = X + (size_t)(row0 + ai * HALF + m * 16) * D + col0;
#pragma unroll
                for (int bj = 0; bj < 2; ++bj)
#pragma unroll
                    for (int n = 0; n < 2; ++n) { f32x4* p = (f32x4*)(rowp + bj * HALF + n * 16); *p = *p + gv[bj][n] * acc[ai][bj][m][n]; } }
    }
};
}

namespace att {
constexpr int SLOT = 40960, KN_OFF = 0, KR_OFF = 16384, V_OFF = 24576, LDS_BYTES = 3 * SLOT + 8 * 256;
constexpr float THR2 = 11.0f;
#define KSWZ(row, colB) ((row) * 256 + ((colB) ^ (((row) & 7) << 4)))
#define KRSWZ(row, colB) ((row) * 128 + ((colB) ^ ((((row) >> 1) & 7) << 4)))
#define SBAR() __builtin_amdgcn_sched_barrier(0)
__device__ __forceinline__ int crow(int r, int hi) { return (r & 3) + 8 * (r >> 2) + 4 * hi; }
__host__ __device__ __forceinline__ int v_st(int k, int c) { const int kk = (k & ~0xC) | ((k & 4) << 1) | ((k & 8) >> 1); return ((kk >> 3) * 4 + (c >> 5)) * 512 + ((kk & 7) * 32 + (c & 31)) * 2; }
__device__ __forceinline__ int v_rd_base(int lane) { return ((lane & 3) << 3) | (((lane >> 2) & 3) << 6) | (((lane >> 4) & 1) << 5) | (((lane >> 5) & 1) << 8); }
constexpr int v_rd_off(int d0, int ks, int half) { return d0 * 512 + ks * 4096 + half * 2048; }
template <int OFF> __device__ __forceinline__ s16x4 tr_read(int vb) {
    s16x4 r; asm volatile("ds_read_b64_tr_b16 %0, %1 offset:%2" : "=&v"(r) : "v"(vb), "i"(OFF) : "memory"); return r;
}
template <int D0> __device__ __forceinline__ void pv_one(f32x16& od, int vb, bf16x8 pa0, bf16x8 pa1, bf16x8 pa2, bf16x8 pa3) {
    const s16x4 l0 = tr_read<v_rd_off(D0, 0, 0)>(vb), h0 = tr_read<v_rd_off(D0, 0, 1)>(vb), l1 = tr_read<v_rd_off(D0, 1, 0)>(vb), h1 = tr_read<v_rd_off(D0, 1, 1)>(vb);
    const s16x4 l2 = tr_read<v_rd_off(D0, 2, 0)>(vb), h2 = tr_read<v_rd_off(D0, 2, 1)>(vb), l3 = tr_read<v_rd_off(D0, 3, 0)>(vb), h3 = tr_read<v_rd_off(D0, 3, 1)>(vb);
    asm volatile("s_waitcnt lgkmcnt(0)" ::: "memory"); SBAR();
#define PK(L, H) (bf16x8){L[0], L[1], L[2], L[3], H[0], H[1], H[2], H[3]}
    od = __builtin_amdgcn_mfma_f32_32x32x16_bf16(pa0, PK(l0, h0), od, 0, 0, 0);
    od = __builtin_amdgcn_mfma_f32_32x32x16_bf16(pa1, PK(l1, h1), od, 0, 0, 0);
    od = __builtin_amdgcn_mfma_f32_32x32x16_bf16(pa2, PK(l2, h2), od, 0, 0, 0);
    od = __builtin_amdgcn_mfma_f32_32x32x16_bf16(pa3, PK(l3, h3), od, 0, 0, 0);
#undef PK
}
__device__ __forceinline__ void pv_d0(f32x16* o, int vb, bf16x8 pa0, bf16x8 pa1, bf16x8 pa2, bf16x8 pa3) {
    pv_one<0>(o[0], vb, pa0, pa1, pa2, pa3); pv_one<1>(o[1], vb, pa0, pa1, pa2, pa3); pv_one<2>(o[2], vb, pa0, pa1, pa2, pa3); pv_one<3>(o[3], vb, pa0, pa1, pa2, pa3);
}
__device__ __forceinline__ void partialSM(f32x16& p0, f32x16& p1, float& m_reg, float& mn, float& alpha) {
    float pmax = p0[0];
#pragma unroll
    for (int r = 1; r < 16; ++r) pmax = fmaxf(pmax, p0[r]);
#pragma unroll
    for (int r = 0; r < 16; ++r) pmax = fmaxf(pmax, p1[r]);
    { auto rr = __builtin_amdgcn_permlane32_swap(__float_as_uint(pmax), __float_as_uint(pmax), false, false);
      pmax = fmaxf(__uint_as_float(rr[0]), __uint_as_float(rr[1])); }
    if (__builtin_expect(__all(pmax - m_reg <= THR2), 1)) { mn = m_reg; alpha = 1.f; }
    else { mn = fmaxf(m_reg, pmax); alpha = __builtin_amdgcn_exp2f(m_reg - mn); m_reg = mn; }
#pragma unroll
    for (int r = 0; r < 16; ++r) p0[r] = __builtin_amdgcn_exp2f(p0[r] - mn);
#pragma unroll
    for (int r = 0; r < 16; ++r) p1[r] = p1[r] - mn;
}
__device__ __forceinline__ void finishSM(f32x16& p0, f32x16& p1, float alpha, float& l_reg, bf16x8& pa0, bf16x8& pa1, bf16x8& pa2, bf16x8& pa3) {
#pragma unroll
    for (int r = 0; r < 16; ++r) p1[r] = __builtin_amdgcn_exp2f(p1[r]);
    float ps = 0;
#pragma unroll
    for (int r = 0; r < 16; ++r) ps += p0[r];
#pragma unroll
    for (int r = 0; r < 16; ++r) ps += p1[r];
    { auto rr = __builtin_amdgcn_permlane32_swap(__float_as_uint(ps), __float_as_uint(ps), false, false);
      ps = __uint_as_float(rr[0]) + __uint_as_float(rr[1]); }
    l_reg = l_reg * alpha + ps;
#define PK4(P, BASE, OUT) do { unsigned a0 = cvt_pk_bf16(P[BASE + 0], P[BASE + 1]), a1 = cvt_pk_bf16(P[BASE + 2], P[BASE + 3]);   \
    unsigned b0 = cvt_pk_bf16(P[BASE + 4], P[BASE + 5]), b1 = cvt_pk_bf16(P[BASE + 6], P[BASE + 7]);                              \
    auto r0 = __builtin_amdgcn_permlane32_swap(a0, b0, false, false); auto r1 = __builtin_amdgcn_permlane32_swap(a1, b1, false, false); \
    u32x4 w = {r0[0], r1[0], r0[1], r1[1]}; OUT = *reinterpret_cast<bf16x8*>(&w); } while (0)
    PK4(p0, 0, pa0); PK4(p0, 8, pa1); PK4(p1, 0, pa2); PK4(p1, 8, pa3);
#undef PK4
}
__device__ __forceinline__ void qkt(f32x16& p0, f32x16& p1, LAS unsigned char* slot, const bf16x8* qr, int r32, int hi) {
    p0 = f32x16{}; p1 = f32x16{};
#pragma unroll
    for (int d0 = 0; d0 < 8; ++d0) { const int cb = (d0 * 16 + hi * 8) * 2;
        bf16x8 b0 = *(const LAS bf16x8*)(slot + KN_OFF + KSWZ(r32, cb));
        bf16x8 b1 = *(const LAS bf16x8*)(slot + KN_OFF + KSWZ(32 + r32, cb));
        p0 = __builtin_amdgcn_mfma_f32_32x32x16_bf16(b0, qr[d0], p0, 0, 0, 0);
        p1 = __builtin_amdgcn_mfma_f32_32x32x16_bf16(b1, qr[d0], p1, 0, 0, 0); }
#pragma unroll
    for (int d0 = 0; d0 < 4; ++d0) { const int cb = (d0 * 16 + hi * 8) * 2;
        bf16x8 b0 = *(const LAS bf16x8*)(slot + KR_OFF + KRSWZ(r32, cb));
        bf16x8 b1 = *(const LAS bf16x8*)(slot + KR_OFF + KRSWZ(32 + r32, cb));
        p0 = __builtin_amdgcn_mfma_f32_32x32x16_bf16(b0, qr[8 + d0], p0, 0, 0, 0);
        p1 = __builtin_amdgcn_mfma_f32_32x32x16_bf16(b1, qr[8 + d0], p1, 0, 0, 0); }
}
__device__ __forceinline__ void attn_unit(const bf16_t* __restrict__ Qb, const unsigned char* __restrict__ KNt, const unsigned char* __restrict__ KRt, const unsigned char* __restrict__ Vt,
                                          bf16_t* __restrict__ Ob, int NT, LAS unsigned char* lds) {
    const int tid = otid(), wid = __builtin_amdgcn_readfirstlane(tid >> 6), lane = tid & 63, r32 = lane & 31, hi = lane >> 5;
    LAS float* wsf = (LAS float*)(lds + 3 * SLOT) + wid * 64; LAS float* li_l = wsf; LAS float* al_l = wsf + 32;
    float m_reg = -1e30f, l_reg = 0; f32x16 o[4] = {}; bf16x8 qr[12];
    const bf16_t* Qw = Qb + (size_t)(wid * 32 + r32) * 192 + hi * 8;
#pragma unroll
    for (int d0 = 0; d0 < 12; ++d0) qr[d0] = *(const bf16x8*)(Qw + d0 * 16);
    const int vrb = (int)(unsigned)(uintptr_t)(lds) + V_OFF + v_rd_base(lane);
    const unsigned lo16 = (unsigned)lane * 16u;
#define ATT_DMA(tile, slotoff) do { const size_t t_ = (size_t)(tile); LAS unsigned char* sl_ = lds + (slotoff); \
        __builtin_amdgcn_global_load_lds((const unsigned*)(KNt + t_ * 16384 + wid * 1024 + lo16), (LAS unsigned*)(sl_ + KN_OFF + wid * 1024), 16, 0, 0); \
        __builtin_amdgcn_global_load_lds((const unsigned*)(KNt + t_ * 16384 + (wid + 8) * 1024 + lo16), (LAS unsigned*)(sl_ + KN_OFF + (wid + 8) * 1024), 16, 0, 0); \
        __builtin_amdgcn_global_load_lds((const unsigned*)(KRt + t_ * 8192 + wid * 1024 + lo16), (LAS unsigned*)(sl_ + KR_OFF + wid * 1024), 16, 0, 0); \
        __builtin_amdgcn_global_load_lds((const unsigned*)(Vt + t_ * 16384 + wid * 1024 + lo16), (LAS unsigned*)(sl_ + V_OFF + wid * 1024), 16, 0, 0); \
        __builtin_amdgcn_global_load_lds((const unsigned*)(Vt + t_ * 16384 + (wid + 8) * 1024 + lo16), (LAS unsigned*)(sl_ + V_OFF + (wid + 8) * 1024), 16, 0, 0); } while (0)
#define ATT_SYNC() do { asm volatile("s_waitcnt vmcnt(0)" ::: "memory"); __builtin_amdgcn_s_barrier(); asm volatile("" ::: "memory"); } while (0)
#define RESC(a) do { if (__any((a) < 1.f)) { if (hi == 0) al_l[r32] = (a); asm volatile("s_waitcnt lgkmcnt(0)" ::: "memory"); \
        _Pragma("unroll") for (int d = 0; d < 4; ++d) _Pragma("unroll") for (int r = 0; r < 16; ++r) o[d][r] *= al_l[crow(r, hi)]; } } while (0)
    f32x16 pA0, pA1, pB0, pB1; float mnA, mnB, alA, alB; bf16x8 pa0, pa1, pa2, pa3;
    int sp = 0, sc = SLOT, sn = 2 * SLOT;
    ATT_DMA(0, 0); ATT_DMA(1, SLOT);
    asm volatile("s_waitcnt vmcnt(5)" ::: "memory"); __builtin_amdgcn_s_barrier(); asm volatile("" ::: "memory");
    qkt(pA0, pA1, lds, qr, r32, hi); partialSM(pA0, pA1, m_reg, mnA, alA);
    for (int j = 1; j + 1 < NT; j += 2) {
        ATT_SYNC(); ATT_DMA(j + 1, sn);
        SBAR(); qkt(pB0, pB1, lds + sc, qr, r32, hi);
        finishSM(pA0, pA1, alA, l_reg, pa0, pa1, pa2, pa3); SBAR();
        pv_d0(o, vrb + sp, pa0, pa1, pa2, pa3); partialSM(pB0, pB1, m_reg, mnB, alB);
        RESC(alB);
        { const int t_ = sp; sp = sc; sc = sn; sn = t_; }
        ATT_SYNC(); if (j + 2 < NT) ATT_DMA(j + 2, sn);
        SBAR(); qkt(pA0, pA1, lds + sc, qr, r32, hi);
        finishSM(pB0, pB1, alB, l_reg, pa0, pa1, pa2, pa3); SBAR();
        pv_d0(o, vrb + sp, pa0, pa1, pa2, pa3); partialSM(pA0, pA1, m_reg, mnA, alA);
        RESC(alA);
        { const int t_ = sp; sp = sc; sc = sn; sn = t_; }
    }
    ATT_SYNC();
    SBAR(); qkt(pB0, pB1, lds + sc, qr, r32, hi);
    finishSM(pA0, pA1, alA, l_reg, pa0, pa1, pa2, pa3); SBAR();
    pv_d0(o, vrb + sp, pa0, pa1, pa2, pa3); partialSM(pB0, pB1, m_reg, mnB, alB);
    RESC(alB);
    finishSM(pB0, pB1, alB, l_reg, pa0, pa1, pa2, pa3); SBAR();
    pv_d0(o, vrb + sc, pa0, pa1, pa2, pa3);
    if (hi == 0) li_l[r32] = l_reg; asm volatile("s_waitcnt lgkmcnt(0)" ::: "memory");
    float rli[16];
#pragma unroll
    for (int r = 0; r < 16; ++r) rli[r] = __builtin_amdgcn_rcpf(li_l[crow(r, hi)]);
    bf16_t* Ow = Ob + (size_t)(wid * 32) * 2048;
#pragma unroll
    for (int r = 0; r < 16; ++r) { const int orow = crow(r, hi);
#pragma unroll
        for (int d0 = 0; d0 < 4; ++d0) Ow[(size_t)orow * 2048 + d0 * 32 + r32] = f2bf(o[d0][r] * rli[r]); }
    __builtin_amdgcn_s_barrier(); asm volatile("" ::: "memory");
#undef ATT_DMA
#undef ATT_SYNC
#undef RESC
}
}

namespace ssd {
constexpr int XT_OFF = 0, XTW_OFF = 8704, BT_OFF = 17408, HB_OFF = 52224, SET = 60928, CW_OFF = 2 * SET, LDS_BYTES = CW_OFF + 8 * 512;
constexpr int PITCH = 272;
constexpr float L2E = 1.4426950408889634f;
__device__ __forceinline__ void g_unit(const bf16_t* __restrict__ BC, bf16_t* __restrict__ G, int unit) {
    const int cid = unit >> 1, g = unit & 1;
    const int r0 = cid < 256 ? cid * 128 : NLAT + (cid - 256) * 128;
    const int tid = otid(), wid = tid >> 6, lane = tid & 63, fr = lane & 15, fq = lane >> 4;
    const bf16_t* Cp = BC + (size_t)(r0 + 16 * wid + fr) * 512 + 256 + 128 * g + 8 * fq;
    bf16x8 cf[4];
#pragma unroll
    for (int ks = 0; ks < 4; ++ks) cf[ks] = *(const bf16x8*)(Cp + 32 * ks);
    bf16_t* Gp = G + ((size_t)unit * 128 + 16 * wid + fr) * 128 + 4 * fq;
#pragma unroll
    for (int sb = 0; sb < 8; ++sb) {
        const bf16_t* Bp = BC + (size_t)(r0 + 16 * sb + fr) * 512 + 128 * g + 8 * fq;
        f32x4 acc = {0.f, 0.f, 0.f, 0.f};
#pragma unroll
        for (int ks = 0; ks < 4; ++ks) { const bf16x8 bfr = *(const bf16x8*)(Bp + 32 * ks); acc = __builtin_amdgcn_mfma_f32_16x16x32_bf16(bfr, cf[ks], acc, 0, 0, 0); }
        u32x2 w; w.x = cvt_pk_bf16(acc[0], acc[1]); w.y = cvt_pk_bf16(acc[2], acc[3]);
        *(u32x2*)(Gp + 16 * sb) = w;
    }
}
__device__ __forceinline__ void ssd_unit(int u, const bf16_t* __restrict__ XS, const bf16_t* __restrict__ BC, const float* __restrict__ DT, const bf16_t* __restrict__ G,
                                         const float* __restrict__ a_log, bf16_t* __restrict__ Y0, bf16_t* __restrict__ Y1, LAS unsigned char* lds) {
    const int b = u >> 6, h = (u >> 2) & 15, d = (u >> 1) & 1, ph = u & 1, g = h >> 3;
    const int tid = otid(), wid = tid >> 6, lane = tid & 63, fr = lane & 15, fq = lane >> 4;
    const float a = -__expf(a_log[d * 16 + h]);
    bf16_t* Y = d ? Y1 : Y0;
    LAS float* cw = (LAS float*)(lds + CW_OFF + wid * 512);
    f32x4 hs[2] = {{0.f, 0.f, 0.f, 0.f}, {0.f, 0.f, 0.f, 0.f}};
    for (int i = tid; i < 8704 / 4; i += 512) ((LAS unsigned*)(lds + HB_OFF))[i] = 0u;
    float cend = 0.f;
#define SSD_ROWS(step, r0v, gidv) do { if ((step) < 2) { const int oc_ = d ? 1 - (step) : (step); r0v = NLAT + b * 256 + oc_ * 128; gidv = 256 + b * 2 + oc_; } \
        else { const int lc_ = (step) - 2, oc_ = d ? 63 - lc_ : lc_; r0v = b * 8192 + oc_ * 128; gidv = b * 64 + oc_; } } while (0)
#define SSD_STAGE(step) do { int r0_, gid_; SSD_ROWS(step, r0_, gid_); (void)gid_; LAS unsigned char* set_ = lds + ((step) & 1) * SET; \
        const float da0 = DT[(size_t)(r0_ + 2 * lane) * 32 + d * 16 + h] * a, da1 = DT[(size_t)(r0_ + 2 * lane + 1) * 32 + d * 16 + h] * a; \
        float sc_ = da0 + da1; \
        if (d == 0) { _Pragma("unroll") for (int o_ = 1; o_ < 64; o_ <<= 1) { const float t_ = __shfl_up(sc_, o_); if (lane >= o_) sc_ += t_; } \
            cw[2 * lane] = sc_ - da1; cw[2 * lane + 1] = sc_; cend = __shfl(sc_, 63); } \
        else { _Pragma("unroll") for (int o_ = 1; o_ < 64; o_ <<= 1) { const float t_ = __shfl_down(sc_, o_); if (lane + o_ < 64) sc_ += t_; } \
            cw[2 * lane] = sc_; cw[2 * lane + 1] = sc_ - da0; cend = __shfl(sc_, 0); } \
        asm volatile("s_waitcnt lgkmcnt(0)" ::: "memory"); \
        { const int s_ = tid & 127, pq_ = tid >> 7; const int row_ = r0_ + s_; \
          const u32x4 xv_ = *(const u32x4*)(XS + (size_t)row_ * 1024 + 64 * h + 32 * ph + 8 * pq_); \
          const float dt_ = DT[(size_t)row_ * 32 + d * 16 + h]; const float wg_ = __builtin_amdgcn_exp2f((cend - cw[s_]) * L2E); \
          LAS bf16_t* xt_ = (LAS bf16_t*)(set_ + XT_OFF) + (8 * pq_) * 136 + s_; LAS bf16_t* xw_ = (LAS bf16_t*)(set_ + XTW_OFF) + (8 * pq_) * 136 + s_; \
          _Pragma("unroll") for (int i_ = 0; i_ < 4; ++i_) { const float lo_ = bflo(xv_[i_]) * dt_, hi_ = bfhi(xv_[i_]) * dt_; \
              xt_[(2 * i_) * 136] = f2bf(lo_); xt_[(2 * i_ + 1) * 136] = f2bf(hi_); xw_[(2 * i_) * 136] = f2bf(lo_ * wg_); xw_[(2 * i_ + 1) * 136] = f2bf(hi_ * wg_); } } \
        _Pragma("unroll") for (int j_ = 0; j_ < 4; ++j_) { const int idx_ = tid + 512 * j_, s_ = idx_ & 127, n8_ = idx_ >> 7; \
          const u32x4 bv_ = *(const u32x4*)(BC + (size_t)(r0_ + s_) * 512 + 128 * g + 8 * n8_); \
          LAS bf16_t* bt_ = (LAS bf16_t*)(set_ + BT_OFF) + (8 * n8_) * 136 + s_; \
          _Pragma("unroll") for (int i_ = 0; i_ < 4; ++i_) { bt_[(2 * i_) * 136] = (bf16_t)(bv_[i_] & 0xffffu); bt_[(2 * i_ + 1) * 136] = (bf16_t)(bv_[i_] >> 16); } } \
    } while (0)
    SSD_STAGE(0);
    for (int step = 0; step < 66; ++step) {
        __syncthreads();
        int r0, gid; SSD_ROWS(step, r0, gid);
        LAS unsigned char* set = lds + (step & 1) * SET;
        const float cend_cur = cend;
        {
            const int t = 16 * wid + fr; const float ct = cw[t];
            f32x4 y[2] = {{0.f, 0.f, 0.f, 0.f}, {0.f, 0.f, 0.f, 0.f}};
            const bf16_t* Gp = G + ((size_t)(gid * 2 + g) * 128 + t) * 128 + 8 * fq;
            const bf16_t* Cp = BC + (size_t)(r0 + t) * 512 + 256 + 128 * g + 8 * fq;
            u32x4 gv[4], cv[4];
#pragma unroll
            for (int ks = 0; ks < 4; ++ks) { gv[ks] = *(const u32x4*)(Gp + 32 * ks); cv[ks] = *(const u32x4*)(Cp + 32 * ks); }
            const float et = __builtin_amdgcn_exp2f(ct * L2E);
#pragma unroll
            for (int ks = 0; ks < 4; ++ks) {
                const bool live = d == 0 ? (32 * ks <= 16 * wid + 15) : (32 * ks + 31 >= 16 * wid);
                if (live) {
                    const int s0 = 32 * ks + 8 * fq;
                    const f32x4 c0 = *(const LAS f32x4*)(cw + s0), c1 = *(const LAS f32x4*)(cw + s0 + 4);
                    float m[8];
#pragma unroll
                    for (int i = 0; i < 8; ++i) { const float cs = i < 4 ? c0[i & 3] : c1[i & 3]; const int s = s0 + i;
                        const bool ok = d == 0 ? (s <= t) : (s >= t);
                        const float gval = (i & 1) ? bfhi(gv[ks][i >> 1]) : bflo(gv[ks][i >> 1]);
                        m[i] = ok ? gval * __builtin_amdgcn_exp2f((ct - cs) * L2E) : 0.f; }
                    u32x4 mw; mw.x = cvt_pk_bf16(m[0], m[1]); mw.y = cvt_pk_bf16(m[2], m[3]); mw.z = cvt_pk_bf16(m[4], m[5]); mw.w = cvt_pk_bf16(m[6], m[7]);
                    const bf16x8 mb = __builtin_bit_cast(bf16x8, mw);
#pragma unroll
                    for (int q = 0; q < 2; ++q) { const bf16x8 af = *(const LAS bf16x8*)(set + XT_OFF + (16 * q + fr) * PITCH + (32 * ks + 8 * fq) * 2);
                        y[q] = __builtin_amdgcn_mfma_f32_16x16x32_bf16(af, mb, y[q], 0, 0, 0); }
                }
            }
#pragma unroll
            for (int ks = 0; ks < 4; ++ks) {
                u32x4 cwv;
#pragma unroll
                for (int i = 0; i < 4; ++i) cwv[i] = cvt_pk_bf16(bflo(cv[ks][i]) * et, bfhi(cv[ks][i]) * et);
                const bf16x8 cb = __builtin_bit_cast(bf16x8, cwv);
#pragma unroll
                for (int q = 0; q < 2; ++q) { const bf16x8 af = *(const LAS bf16x8*)(set + HB_OFF + (16 * q + fr) * PITCH + (32 * ks + 8 * fq) * 2);
                    y[q] = __builtin_amdgcn_mfma_f32_16x16x32_bf16(af, cb, y[q], 0, 0, 0); }
            }
            bf16_t* yp = Y + (size_t)(r0 + t) * 1024 + 64 * h + 32 * ph + 4 * fq;
#pragma unroll
            for (int q = 0; q < 2; ++q) { u32x2 w; w.x = cvt_pk_bf16(y[q][0], y[q][1]); w.y = cvt_pk_bf16(y[q][2], y[q][3]); *(u32x2*)(yp + 16 * q) = w; }
        }
        {
            const float dec = __builtin_amdgcn_exp2f(cend_cur * L2E);
            hs[0] = hs[0] * dec; hs[1] = hs[1] * dec;
#pragma unroll
            for (int ks = 0; ks < 4; ++ks) {
                const bf16x8 bfr = *(const LAS bf16x8*)(set + BT_OFF + (16 * wid + fr) * PITCH + (32 * ks + 8 * fq) * 2);
#pragma unroll
                for (int q = 0; q < 2; ++q) { const bf16x8 af = *(const LAS bf16x8*)(set + XTW_OFF + (16 * q + fr) * PITCH + (32 * ks + 8 * fq) * 2);
                    hs[q] = __builtin_amdgcn_mfma_f32_16x16x32_bf16(af, bfr, hs[q], 0, 0, 0); }
            }
            LAS bf16_t* hb = (LAS bf16_t*)(lds + ((step + 1) & 1) * SET + HB_OFF) + 16 * wid + fr;
#pragma unroll
            for (int q = 0; q < 2; ++q)
#pragma unroll
                for (int i = 0; i < 4; ++i) hb[(16 * q + 4 * fq + i) * 136] = f2bf(hs[q][i]);
        }
        if (step + 1 < 66) SSD_STAGE(step + 1);
    }
    __syncthreads();
#undef SSD_ROWS
#undef SSD_STAGE
}
}

struct Args { const float* in[32]; float* out; unsigned char* ws; int ph_lo, ph_hi; };
constexpr int NTHR = 512;
constexpr int LDS_BASE = 256;
constexpr int LDS_PHASE = 133120;
constexpr int LDS_BYTES = LDS_BASE + LDS_PHASE;
static_assert(att::LDS_BYTES <= LDS_PHASE && ssd::LDS_BYTES <= LDS_PHASE && pg8::STAGE_BYTES <= LDS_PHASE, "LDS");

__device__ __forceinline__ void tjob(int j, const Args& A, const float*& src, bf16_t*& dst, int& K, int& N, int& Npad, int& mode, const float*& ks) {
    unsigned char* W = A.ws + WS_W; mode = 0; ks = nullptr;
    if (j < 8) { const int i = j >> 2, w = j & 3; unsigned char* base = W + W_HYB + (size_t)i * WH_SZ;
        if (w == 0)      { src = A.in[I_HWIN] + (size_t)i * 1024 * HYB_IN; dst = (bf16_t*)(base + WH_IN); K = 1024; N = HYB_IN; Npad = HYB_INP; mode = 1; }
        else if (w == 1) { src = A.in[I_WQB] + (size_t)i * 384 * 1536; dst = (bf16_t*)(base + WH_QB); K = 384; N = 1536; Npad = 1536; mode = 2; ks = A.in[I_QNG] + i * 384; }
        else if (w == 2) { src = A.in[I_WKVB] + (size_t)i * 256 * 2048; dst = (bf16_t*)(base + WH_KVB); K = 256; N = 2048; Npad = 2048; ks = A.in[I_KVNG] + i * 256; }
        else             { src = A.in[I_HWOUT] + (size_t)i * 2048 * 1024; dst = (bf16_t*)(base + WH_OUT); K = 2048; N = 1024; Npad = 1024; }
    } else if (j < 12) { const int i = (j - 8) >> 1, w = (j - 8) & 1; unsigned char* base = W + W_GM + (size_t)i * WG_SZ;
        if (w == 0) { src = A.in[I_GWIN] + (size_t)i * 1024 * 4096; dst = (bf16_t*)(base + WG_IN); K = 1024; N = 4096; Npad = 4096; }
        else        { src = A.in[I_GWOUT] + (size_t)i * 2048 * 1024; dst = (bf16_t*)(base + WG_OUT); K = 2048; N = 1024; Npad = 1024; }
    } else { const int l = j - 12; src = A.in[I_PWQ] + (size_t)l * 1024 * 2048; dst = (bf16_t*)(W + W_PEER + (size_t)l * WP_SZ + WP_Q); K = 1024; N = 2048; Npad = 2048; }
}
__device__ __forceinline__ int colmap(int mode, int n, int N) {
    if (mode == 1) { if (n >= N) return -1; if (n < C_KR) return n; const int m = n - C_KR; return C_KR + (m >> 1) + 32 * (m & 1); }
    if (mode == 2) { if (n < 1024) return (n >> 7) * 192 + (n & 127); const int m = n - 1024, h = m >> 6, mm = m & 63; return h * 192 + 128 + (mm >> 1) + 32 * (mm & 1); }
    return n;
}
__device__ __forceinline__ void phase_prologue(const Args& A, LAS unsigned char* lds) {
    const int tid = otid();
    {
        LAS float* tile = (LAS float*)lds;
        int item = blockIdx.x;
        for (int j = 0; j < 16; ++j) {
            const float* src; bf16_t* dst; int K, N, Npad, mode; const float* ks; tjob(j, A, src, dst, K, N, Npad, mode, ks);
            const int tk = K / 64, tn = Npad / 64, nt = tk * tn;
            for (; item < nt; item += gridDim.x) {
                const int k0 = (item % tk) * 64, n0 = (item / tk) * 64;
                { const int k = tid >> 3, cg = tid & 7; const float sc = ks ? ks[k0 + k] : 1.f;
#pragma unroll
                  for (int jj = 0; jj < 8; ++jj) { const int oc = colmap(mode, n0 + 8 * cg + jj, N); tile[k * 65 + 8 * cg + jj] = oc >= 0 ? src[(size_t)(k0 + k) * N + oc] * sc : 0.f; } }
                __syncthreads();
                { const int n = tid >> 3, kg = tid & 7; float v[8];
#pragma unroll
                  for (int jj = 0; jj < 8; ++jj) v[jj] = tile[(8 * kg + jj) * 65 + n];
                  u32x4 w; w.x = cvt_pk_bf16(v[0], v[1]); w.y = cvt_pk_bf16(v[2], v[3]); w.z = cvt_pk_bf16(v[4], v[5]); w.w = cvt_pk_bf16(v[6], v[7]);
                  *(u32x4*)(dst + (size_t)(n0 + n) * K + k0 + 8 * kg) = w; }
                __syncthreads();
            }
            item -= nt;
        }
    }
    {
        const int gthr = blockIdx.x * NTHR + tid, nthr = gridDim.x * NTHR;
        for (int p = gthr; p < 10 * 16384; p += nthr) {
            const int mat = p >> 14, off = (p & 16383) * 8; const float* src; bf16_t* dst;
            if (mat < 2)      { src = A.in[I_GWS] + (size_t)mat * 131072; dst = (bf16_t*)(A.ws + WS_W + W_GM + (size_t)mat * WG_SZ + WG_WS); }
            else if (mat < 6) { src = A.in[I_PK1] + (size_t)(mat - 2) * 131072; dst = (bf16_t*)(A.ws + WS_W + W_PEER + (size_t)(mat - 2) * WP_SZ + WP_K1); }
            else              { src = A.in[I_PK2] + (size_t)(mat - 6) * 131072; dst = (bf16_t*)(A.ws + WS_W + W_PEER + (size_t)(mat - 6) * WP_SZ + WP_K2); }
            const f32x4 a = *(const f32x4*)(src + off), b = *(const f32x4*)(src + off + 4);
            u32x4 w; w.x = cvt_pk_bf16(a[0], a[1]); w.y = cvt_pk_bf16(a[2], a[3]); w.z = cvt_pk_bf16(b[0], b[1]); w.w = cvt_pk_bf16(b[2], b[3]);
            *(u32x4*)(dst + off) = w;
        }
        float* rope = (float*)(A.ws + WS_ROPE);
        for (int p = gthr; p < SEQ * 32; p += nthr) { const int l = p >> 5, i = p & 31; const float pos = (float)(i < 16 ? (l >> 6) : (l & 63));
            const float inv = powf(10000.f, -(float)(i & 15) / 16.f), ang = pos * inv; rope[p] = cosf(ang); rope[SEQ * 32 + p] = sinf(ang); }
    }
    {
        LAS float* scond = (LAS float*)lds;
        LAS float* red = scond + 5 * 1024;
        __syncthreads();
        for (int i = tid; i < 5 * 1024; i += NTHR) { const int m = i >> 10, k = i & 1023; const float c = m < 4 ? A.in[I_C][m * 1024 + k] : A.in[I_CCTX][k]; scond[i] = silu_f(c); }
        __syncthreads();
        float* MOD = (float*)(A.ws + WS_MOD);
        for (int item = blockIdx.x; item < 4 * 48; item += gridDim.x) {
            const int layer = item / 48, j0 = (item % 48) * 128; const int c4 = tid & 31, ksl = tid >> 5;
            f32x4 acc[5];
#pragma unroll
            for (int m = 0; m < 5; ++m) acc[m] = (f32x4){0.f, 0.f, 0.f, 0.f};
            const float* wp = A.in[I_ADAW] + ((size_t)layer * 1024 + ksl * 64) * 6144 + j0 + 4 * c4;
            for (int k = 0; k < 64; ++k) { const f32x4 w = *(const f32x4*)(wp + (size_t)k * 6144);
#pragma unroll
                for (int m = 0; m < 5; ++m) acc[m] += w * scond[m * 1024 + ksl * 64 + k]; }
#pragma unroll
            for (int m = 0; m < 5; ++m) *(LAS f32x4*)(red + (ksl * 5 + m) * 128 + 4 * c4) = acc[m];
            __syncthreads();
            for (int i = tid; i < 640; i += NTHR) { const int m = i >> 7, c = i & 127; float s = A.in[I_ADAB][layer * 6144 + j0 + c];
#pragma unroll
                for (int q = 0; q < 16; ++q) s += red[(q * 5 + m) * 128 + c];
                MOD[((size_t)layer * 5 + m) * 6144 + j0 + c] = s; }
            __syncthreads();
        }
    }
}

__device__ __forceinline__ void phase_norm_mod(const float* xl, const float* xc, float* cl, float* cc, const float* g, const float* modl, int sh_idx, bf16_t* H, int nrows) {
    const int tid_ = otid(); const int lane = tid_ & 63, gw = blockIdx.x * 8 + (tid_ >> 6), nw = gridDim.x * 8;
    f32x4 gv[4];
#pragma unroll
    for (int i = 0; i < 4; ++i) gv[i] = *(const f32x4*)(g + 256 * i + 4 * lane);
    for (int r = gw; r < nrows; r += nw) {
        const bool lat = r < NLAT; const float* xp = lat ? xl + (size_t)r * D : xc + (size_t)(r - NLAT) * D;
        f32x4 x[4]; float ss = 0.f;
#pragma unroll
        for (int i = 0; i < 4; ++i) { x[i] = *(const f32x4*)(xp + 256 * i + 4 * lane); ss += x[i][0] * x[i][0] + x[i][1] * x[i][1] + x[i][2] * x[i][2] + x[i][3] * x[i][3]; }
        if (cl) { float* cp = lat ? cl + (size_t)r * D : cc + (size_t)(r - NLAT) * D;
#pragma unroll
            for (int i = 0; i < 4; ++i) *(f32x4*)(cp + 256 * i + 4 * lane) = x[i]; }
        ss = wave_sum(ss); const float rstd = rsqrtf(ss * (1.f / 1024.f) + EPS);
        const float* mp = modl + (size_t)(lat ? (r >> 13) : 4) * 6144 + sh_idx * 1024;
#pragma unroll
        for (int i = 0; i < 4; ++i) { const f32x4 sh = *(const f32x4*)(mp + 256 * i + 4 * lane), sc = *(const f32x4*)(mp + 1024 + 256 * i + 4 * lane);
            const f32x4 hv = (x[i] * rstd) * gv[i] * (sc + 1.f) + sh;
            u32x2 w; w.x = cvt_pk_bf16(hv[0], hv[1]); w.y = cvt_pk_bf16(hv[2], hv[3]);
            *(u32x2*)(H + (size_t)r * D + 256 * i + 4 * lane) = w; }
    }
}
__device__ __forceinline__ void phase_final_norm(float* xl, const float* g) {
    const int tid_ = otid(); const int lane = tid_ & 63, gw = blockIdx.x * 8 + (tid_ >> 6), nw = gridDim.x * 8;
    f32x4 gv[4];
#pragma unroll
    for (int i = 0; i < 4; ++i) gv[i] = *(const f32x4*)(g + 256 * i + 4 * lane);
    for (int r = gw; r < NLAT; r += nw) {
        float* xp = xl + (size_t)r * D; f32x4 x[4]; float ss = 0.f;
#pragma unroll
        for (int i = 0; i < 4; ++i) { x[i] = *(const f32x4*)(xp + 256 * i + 4 * lane); ss += x[i][0] * x[i][0] + x[i][1] * x[i][1] + x[i][2] * x[i][2] + x[i][3] * x[i][3]; }
        ss = wave_sum(ss); const float rstd = rsqrtf(ss * (1.f / 1024.f) + EPS);
#pragma unroll
        for (int i = 0; i < 4; ++i) *(f32x4*)(xp + 256 * i + 4 * lane) = (x[i] * rstd) * gv[i];
    }
}

__device__ __forceinline__ void phase_conv(const Args& A, int li) {
    const bf16_t* PROJ = (const bf16_t*)(A.ws + WS_BIG);
    bf16_t* XS = (bf16_t*)(A.ws + WS_R2); bf16_t* BC = (bf16_t*)(A.ws + WS_R2 + R2_BC);
    const int tid = otid();
    if (tid < 384) {
        const int cg = tid % 192, half = tid / 192, c0 = 8 * cg;
        const float* cw = A.in[I_CONVW] + ((size_t)li * 1536 + c0) * 5; const float* cb = A.in[I_CONVB] + (size_t)li * 1536 + c0;
        float w[8][5], bia[8];
#pragma unroll
        for (int j = 0; j < 8; ++j) { bia[j] = cb[j];
#pragma unroll
            for (int k = 0; k < 5; ++k) w[j][k] = cw[j * 5 + k]; }
        for (int blk = blockIdx.x; blk < NROW / 64; blk += gridDim.x) {
            const int rbeg = blk * 64 + half * 32; int s0, s1;
            if (rbeg < NLAT) { s0 = rbeg & ~8191; s1 = s0 + 8192; } else { s0 = NLAT + ((rbeg - NLAT) & ~255); s1 = s0 + 256; }
            float win[5][8];
#define CONV_LD(dst, r) do { const int r_ = (r); if (r_ >= s0 && r_ < s1) { const u32x4 v_ = *(const u32x4*)(PROJ + (size_t)r_ * HYB_INP + C_XBC + c0); \
                _Pragma("unroll") for (int q_ = 0; q_ < 4; ++q_) { dst[2 * q_] = bflo(v_[q_]); dst[2 * q_ + 1] = bfhi(v_[q_]); } } \
                else { _Pragma("unroll") for (int q_ = 0; q_ < 8; ++q_) dst[q_] = 0.f; } } while (0)
            CONV_LD(win[0], rbeg - 2); CONV_LD(win[1], rbeg - 1); CONV_LD(win[2], rbeg); CONV_LD(win[3], rbeg + 1); CONV_LD(win[4], rbeg + 2);
            for (int r = rbeg; r < rbeg + 32; ++r) {
                float o[8];
#pragma unroll
                for (int j = 0; j < 8; ++j) { float s = bia[j];
#pragma unroll
                    for (int k = 0; k < 5; ++k) s += w[j][k] * win[k][j];
                    o[j] = silu_f(s); }
                u32x4 pk; pk.x = cvt_pk_bf16(o[0], o[1]); pk.y = cvt_pk_bf16(o[2], o[3]); pk.z = cvt_pk_bf16(o[4], o[5]); pk.w = cvt_pk_bf16(o[6], o[7]);
                if (c0 < 1024) *(u32x4*)(XS + (size_t)r * 1024 + c0) = pk; else *(u32x4*)(BC + (size_t)r * 512 + (c0 - 1024)) = pk;
#pragma unroll
                for (int k = 0; k < 4; ++k)
#pragma unroll
                    for (int j = 0; j < 8; ++j) win[k][j] = win[k + 1][j];
                CONV_LD(win[4], r + 3);
            }
#undef CONV_LD
        }
    }
    {
        const int lane = tid & 63, gw = blockIdx.x * 8 + (tid >> 6), nw = gridDim.x * 8;
        float* DT = (float*)(A.ws + WS_BIG + BIG_DT); float* RQ = (float*)(A.ws + WS_RSTD); float* RKV = RQ + NROW;
        unsigned char* KR = A.ws + WS_BIG + BIG_KR; const float* rope = (const float*)(A.ws + WS_ROPE);
        const float dtb = lane < 32 ? A.in[I_DTB][li * 32 + lane] : 0.f;
        for (int r = gw; r < NROW; r += nw) {
            const bf16_t* p = PROJ + (size_t)r * HYB_INP;
            if (lane < 32) DT[(size_t)r * 32 + lane] = softplus_f(bf2f(p[C_DT + (lane & 15)]) + dtb);
            { const unsigned* q = (const unsigned*)(p + C_CQ + 6 * lane); float ss = 0.f;
#pragma unroll
              for (int j = 0; j < 3; ++j) { const unsigned w = q[j]; const float a = bflo(w), b = bfhi(w); ss += a * a + b * b; }
              ss = wave_sum(ss); if (lane == 0) RQ[r] = rsqrtf(ss * (1.f / 384.f) + EPS); }
            { const u32x2 w = *(const u32x2*)(p + C_CKV + 4 * lane); const float a = bflo(w.x), b = bfhi(w.x), c = bflo(w.y), d = bfhi(w.y);
              float ss = a * a + b * b + c * c + d * d; ss = wave_sum(ss); if (lane == 0) RKV[r] = rsqrtf(ss * (1.f / 256.f) + EPS); }
            if (lane < 32) { const unsigned w = *(const unsigned*)(p + C_KR + 2 * lane); float x1 = bflo(w), x2 = bfhi(w); int b, key;
                if (r < NLAT) { const int l = r & 8191; const float c = rope[l * 32 + lane], s = rope[SEQ * 32 + l * 32 + lane];
                    const float o1 = x1 * c - x2 * s, o2 = x1 * s + x2 * c; x1 = o1; x2 = o2; b = r >> 13; key = 256 + l; }
                else { b = (r - NLAT) >> 8; key = (r - NLAT) & 255; }
                *(unsigned*)(KR + (size_t)(b * NKT + (key >> 6)) * 8192 + KRSWZ(key & 63, 4 * lane)) = cvt_pk_bf16(x1, x2); }
        }
    }
}

struct EpiQ {
    static constexpr bool PERM = true;
    bf16_t* Q; const float* rstd; const float* rope;
    __device__ __forceinline__ void operator()(const f32x4 (&acc)[2][2][4][2], const pg8::Unit& u, int wr, int wc, int fr, int fq) const {
        const bool lat = u.pm < 128;
        const int b = lat ? (u.pm >> 5) : ((u.pm - 128) >> 0), q0 = lat ? 256 + ((u.pm & 31) << 8) : 0;
        const bool isrope = u.pn >= 4;
#pragma unroll
        for (int ai = 0; ai < 2; ++ai) {
            const int rl = 128 * ai + 64 * wr + fr;
            const float* rsp = rstd + u.pm * 256 + rl;
            const float* rp = rope + (size_t)(((u.pm & 31) << 8) + rl) * 32;
#pragma unroll
            for (int bj = 0; bj < 2; ++bj) {
                const int c0 = u.pn * 256 + 128 * bj + 32 * wc + 8 * fq; int h, dcol;
                if (!isrope) { h = c0 >> 7; dcol = c0 & 127; } else { const int mq = c0 - 1024; h = mq >> 6; dcol = 128 + (mq & 63); }
                bf16_t* dst = Q + ((size_t)(b * 8 + h) * NKEY + q0 + rl) * 192 + dcol;
                const int ro = (dcol - 128) >> 1;
#pragma unroll
                for (int m = 0; m < 4; ++m) {
                    const float rs = rsp[16 * m] * QSCALE;
                    f32x4 v0 = acc[ai][bj][m][0] * rs, v1 = acc[ai][bj][m][1] * rs;
                    if (isrope && lat) { const f32x4 cs = *(const f32x4*)(rp + 16 * m * 32 + ro), sn = *(const f32x4*)(rp + SEQ * 32 + 16 * m * 32 + ro);
                        const f32x4 a0 = v0, a1 = v1;
                        v0[0] = a0[0] * cs[0] - a0[1] * sn[0]; v0[1] = a0[0] * sn[0] + a0[1] * cs[0]; v0[2] = a0[2] * cs[1] - a0[3] * sn[1]; v0[3] = a0[2] * sn[1] + a0[3] * cs[1];
                        v1[0] = a1[0] * cs[2] - a1[1] * sn[2]; v1[1] = a1[0] * sn[2] + a1[1] * cs[2]; v1[2] = a1[2] * cs[3] - a1[3] * sn[3]; v1[3] = a1[2] * sn[3] + a1[3] * cs[3]; }
                    u32x4 w; w.x = cvt_pk_bf16(v0[0], v0[1]); w.y = cvt_pk_bf16(v0[2], v0[3]); w.z = cvt_pk_bf16(v1[0], v1[1]); w.w = cvt_pk_bf16(v1[2], v1[3]);
                    *(u32x4*)(dst + 16 * m * 192) = w;
                    asm volatile("" ::: "memory");
                }
            }
        }
    }
};
struct EpiKV {
    static constexpr bool PERM = true;
    unsigned char* KN; unsigned char* V; const float* rstd;
    __device__ __forceinline__ void operator()(const f32x4 (&acc)[2][2][4][2], const pg8::Unit& u, int wr, int wc, int fr, int fq) const {
        const bool lat = u.pm < 128;
        const int b = lat ? (u.pm >> 5) : (u.pm - 128), t0 = lat ? 4 + ((u.pm & 31) << 2) : 0;
        const int dd = 32 * wc + 8 * fq;
        const int offK = fr * 256 + ((dd * 2) ^ ((fr & 7) << 4));
        const int offV = att::v_st(fr, dd);
#pragma unroll
        for (int ai = 0; ai < 2; ++ai) {
            const size_t tb = ((size_t)(b * 8 + u.pn) * NKT + t0 + 2 * ai + wr) * 16384;
            const float* rsp = rstd + u.pm * 256 + 128 * ai + 64 * wr + fr;
            unsigned char* kp = KN + tb + offK; unsigned char* vp = V + tb + offV;
#pragma unroll
            for (int m = 0; m < 4; ++m) {
                const float rs = rsp[16 * m];
#pragma unroll
                for (int bj = 0; bj < 2; ++bj) {
                    const f32x4 v0 = acc[ai][bj][m][0] * rs, v1 = acc[ai][bj][m][1] * rs;
                    u32x4 w; w.x = cvt_pk_bf16(v0[0], v0[1]); w.y = cvt_pk_bf16(v0[2], v0[3]); w.z = cvt_pk_bf16(v1[0], v1[1]); w.w = cvt_pk_bf16(v1[2], v1[3]);
                    if (bj == 0) *(u32x4*)(kp + m * 4096) = w; else *(u32x4*)(vp + m * 4096) = w;
                }
                asm volatile("" ::: "memory");
            }
        }
    }
};

__device__ __forceinline__ void phase_ssd_out(const Args& A, int li, int nrows) {
    const bf16_t* PROJ = (const bf16_t*)(A.ws + WS_BIG); const bf16_t* XS = (const bf16_t*)(A.ws + WS_R2);
    const bf16_t* Y0 = (const bf16_t*)(A.ws + WS_H); const bf16_t* Y1 = (const bf16_t*)(A.ws + WS_R3); bf16_t* CAT = (bf16_t*)(A.ws + WS_R3 + R3_CAT);
    const int tid_ = otid(); const int lane = tid_ & 63, gw = blockIdx.x * 8 + (tid_ >> 6), nw = gridDim.x * 8;
    const float dsk = A.in[I_SSDD][li * 16 + (lane >> 2)];
    float ng[16];
#pragma unroll
    for (int j = 0; j < 16; ++j) ng[j] = A.in[I_SSDNG][li * 1024 + 16 * lane + j];
    for (int r = gw; r < nrows; r += nw) {
        float v[16]; float ss = 0.f;
#pragma unroll
        for (int hh = 0; hh < 2; ++hh) {
            const u32x4 a = *(const u32x4*)(Y0 + (size_t)r * 1024 + 16 * lane + 8 * hh), b = *(const u32x4*)(Y1 + (size_t)r * 1024 + 16 * lane + 8 * hh);
            const u32x4 x = *(const u32x4*)(XS + (size_t)r * 1024 + 16 * lane + 8 * hh), z = *(const u32x4*)(PROJ + (size_t)r * HYB_INP + 16 * lane + 8 * hh);
#pragma unroll
            for (int q = 0; q < 4; ++q) {
                const float y0 = (bflo(a[q]) + bflo(b[q]) + dsk * bflo(x[q])) * silu_f(bflo(z[q])), y1 = (bfhi(a[q]) + bfhi(b[q]) + dsk * bfhi(x[q])) * silu_f(bfhi(z[q]));
                v[8 * hh + 2 * q] = y0; v[8 * hh + 2 * q + 1] = y1; ss += y0 * y0 + y1 * y1; }
        }
#pragma unroll
        for (int o = 16; o >= 1; o >>= 1) ss += __shfl_xor(ss, o);
        const float rstd = rsqrtf(ss * (1.f / 512.f) + EPS);
#pragma unroll
        for (int hh = 0; hh < 2; ++hh) { u32x4 w;
#pragma unroll
            for (int q = 0; q < 4; ++q) w[q] = cvt_pk_bf16(v[8 * hh + 2 * q] * rstd * ng[8 * hh + 2 * q], v[8 * hh + 2 * q + 1] * rstd * ng[8 * hh + 2 * q + 1]);
            *(u32x4*)(CAT + (size_t)r * 2048 + 16 * lane + 8 * hh) = w; }
    }
}

__device__ __forceinline__ void phase_ln_stats(const Args& A, int nrows) {
    const bf16_t* Gb = (const bf16_t*)(A.ws + WS_BIG); float* ST = (float*)(A.ws + WS_RSTD);
    const int tid_ = otid(); const int lane = tid_ & 63, gw = blockIdx.x * 8 + (tid_ >> 6), nw = gridDim.x * 8;
    for (int r = gw; r < nrows; r += nw) {
        float v[32]; float s = 0.f;
#pragma unroll
        for (int j = 0; j < 4; ++j) { const u32x4 w = *(const u32x4*)(Gb + (size_t)r * 4096 + 2048 + 512 * j + 8 * lane);
#pragma unroll
            for (int q = 0; q < 4; ++q) { v[8 * j + 2 * q] = bflo(w[q]); v[8 * j + 2 * q + 1] = bfhi(w[q]); s += v[8 * j + 2 * q] + v[8 * j + 2 * q + 1]; } }
        s = wave_sum(s); const float mu = s * (1.f / 2048.f); float q2 = 0.f;
#pragma unroll
        for (int j = 0; j < 32; ++j) { const float dd = v[j] - mu; q2 += dd * dd; }
        q2 = wave_sum(q2);
        if (lane == 0) { ST[r] = mu; ST[NROW + r] = rsqrtf(q2 * (1.f / 2048.f) + EPS); }
    }
}
__device__ __forceinline__ void phase_spatial(const Args& A, int gi, int nrows, LAS unsigned char* lds) {
    const bf16_t* Gb = (const bf16_t*)(A.ws + WS_BIG); const float* ST = (const float*)(A.ws + WS_RSTD); bf16_t* Ab = (bf16_t*)(A.ws + WS_R1);
    const bf16_t* WSg = (const bf16_t*)(A.ws + WS_W + W_GM + (size_t)gi * WG_SZ + WG_WS);
    const float* lng = A.in[I_GLNG] + (size_t)gi * 2048; const float* lnb = A.in[I_GLNB] + (size_t)gi * 2048; const float* bs = A.in[I_GBS] + (size_t)gi * 1024;
    const int tid = otid(), wid = tid >> 6, lane = tid & 63, r32 = lane & 31, hi = lane >> 5, tb = wid & 3, dh = wid >> 2;
    const int ldsaddr = (int)(unsigned)(uintptr_t)lds;
    for (int unit = blockIdx.x; unit < (nrows / 128) * 8; unit += gridDim.x) {
        const int cb = unit >> 3, gg = unit & 7, r0 = cb * 128;
        __syncthreads();
#pragma unroll
        for (int j = 0; j < 8; ++j) { const int idx = tid + 512 * j, s = idx >> 5, dd = (idx & 31) * 8;
            const u32x4 w = *(const u32x4*)(Gb + (size_t)(r0 + s) * 4096 + 2048 + 256 * gg + dd);
            const float mu = ST[r0 + s], rs = ST[NROW + r0 + s];
            const f32x4 g0 = *(const f32x4*)(lng + 256 * gg + dd), g1 = *(const f32x4*)(lng + 256 * gg + dd + 4), b0 = *(const f32x4*)(lnb + 256 * gg + dd), b1 = *(const f32x4*)(lnb + 256 * gg + dd + 4);
            u32x4 o;
            o.x = cvt_pk_bf16((bflo(w.x) - mu) * rs * g0[0] + b0[0], (bfhi(w.x) - mu) * rs * g0[1] + b0[1]); o.y = cvt_pk_bf16((bflo(w.y) - mu) * rs * g0[2] + b0[2], (bfhi(w.y) - mu) * rs * g0[3] + b0[3]);
            o.z = cvt_pk_bf16((bflo(w.z) - mu) * rs * g1[0] + b1[0], (bfhi(w.z) - mu) * rs * g1[1] + b1[1]); o.w = cvt_pk_bf16((bflo(w.w) - mu) * rs * g1[2] + b1[2], (bfhi(w.w) - mu) * rs * g1[3] + b1[3]);
            *(LAS u32x4*)(lds + ((s >> 6) * 2 + (dd >> 7)) * 16384 + att::v_st(s & 63, dd & 127)) = o; }
        bf16x8 pa[8];
#pragma unroll
        for (int ks = 0; ks < 8; ++ks) pa[ks] = *(const bf16x8*)(WSg + ((size_t)gg * 128 + 32 * tb + r32) * 128 + 16 * ks + 8 * hi);
        __syncthreads();
        f32x16 o[4] = {};
        att::pv_d0(o, ldsaddr + (0 * 2 + dh) * 16384 + att::v_rd_base(lane), pa[0], pa[1], pa[2], pa[3]);
        att::pv_d0(o, ldsaddr + (1 * 2 + dh) * 16384 + att::v_rd_base(lane), pa[4], pa[5], pa[6], pa[7]);
#pragma unroll
        for (int r = 0; r < 16; ++r) { const int t = 32 * tb + att::crow(r, hi), row = r0 + t; const float bsv = bs[gg * 128 + t];
#pragma unroll
            for (int d0 = 0; d0 < 4; ++d0) { const int col = 256 * gg + 128 * dh + 32 * d0 + r32;
                Ab[(size_t)row * 2048 + col] = f2bf(bf2f(Gb[(size_t)row * 4096 + col]) * (o[d0][r] + bsv)); } }
    }
}

constexpr int NSL = 16, SW = 1024 / NSL;
__device__ __forceinline__ void phase_tabcvt(const Args& A, int layer) {
    const int gthr = blockIdx.x * NTHR + otid(), nthr = gridDim.x * NTHR;
    for (int p = gthr; p < 2 * NEXP * 128; p += nthr) {
        const int tab = p >> 21, rem = p & ((1 << 21) - 1), e = rem >> 7, p8 = rem & 127, sl = (8 * p8) / SW, c = (8 * p8) % SW;
        const float* src = (tab ? A.in[I_PV] : A.in[I_PU]) + ((size_t)layer * NEXP + e) * 1024 + 8 * p8;
        const f32x4 a = *(const f32x4*)src, b = *(const f32x4*)(src + 4);
        u32x4 w; w.x = cvt_pk_bf16(a[0], a[1]); w.y = cvt_pk_bf16(a[2], a[3]); w.z = cvt_pk_bf16(b[0], b[1]); w.w = cvt_pk_bf16(b[2], b[3]);
        *(u32x4*)(A.ws + WS_TAB + (size_t)tab * TAB_HALF + (((size_t)sl * NEXP + e) * SW + c) * 2) = w;
    }
}
#define CASD(a, b) do { const float hi_ = fmaxf(a, b), lo_ = fminf(a, b); a = hi_; b = lo_; } while (0)
__device__ __forceinline__ void sort16(float (&k)[16]) {
#pragma unroll
    for (int sz = 2; sz <= 16; sz <<= 1)
#pragma unroll
        for (int j = sz >> 1; j > 0; j >>= 1)
#pragma unroll
            for (int i = 0; i < 16; ++i) { const int l = i ^ j; if (l > i) { if ((i & sz) == 0 || sz == 16) CASD(k[i], k[l]); else CASD(k[l], k[i]); } }
}
__device__ __forceinline__ void bmerge16(float (&k)[16]) {
#pragma unroll
    for (int j = 8; j > 0; j >>= 1)
#pragma unroll
        for (int i = 0; i < 16; ++i) { const int l = i ^ j; if (l > i) CASD(k[i], k[l]); }
}
__device__ __forceinline__ void merge_top16(float (&a)[16], const float (&b)[16]) {
#pragma unroll
    for (int i = 0; i < 16; ++i) a[i] = fmaxf(a[i], b[15 - i]);
    bmerge16(a);
}
__device__ __forceinline__ void xmerge_top16(float (&a)[16], int mask) {
    float t[16];
#pragma unroll
    for (int i = 0; i < 16; ++i) t[i] = __shfl_xor(a[15 - i], mask);
#pragma unroll
    for (int i = 0; i < 16; ++i) a[i] = fmaxf(a[i], t[i]);
    bmerge16(a);
}
__device__ __forceinline__ void phase_topk(const Args& A, int layer, int nrows, LAS unsigned char* lds) {
    const bf16_t* QP = (const bf16_t*)(A.ws + WS_BIG); int* IDX = (int*)(A.ws + WS_R2); float* GATE = (float*)(A.ws + WS_R2 + R2_GATE);
    const int tid = otid(), wid = tid >> 6, lane = tid & 63, fr = lane & 15, fq = lane >> 4;
    LAS unsigned* scr = (LAS unsigned*)(lds + 2 * 34816) + wid * 512 + fr * 32;
    for (int unit = blockIdx.x; unit < (nrows / 128) * 8; unit += gridDim.x) {
        const int h = unit & 7, r0 = (unit >> 3) * 128;
        __syncthreads();
        { const bf16_t* k1 = (const bf16_t*)(A.ws + WS_W + W_PEER + (size_t)layer * WP_SZ + WP_K1) + (size_t)h * 16384;
#pragma unroll
          for (int j = 0; j < 8; ++j) { const int idx = tid + 512 * j, half = idx >> 11, rem = idx & 2047, key = rem >> 4, c8 = rem & 15;
              const u32x4 w = *(const u32x4*)(k1 + (size_t)half * 8 * 16384 + key * 128 + 8 * c8);
              *(LAS u32x4*)(lds + half * 34816 + key * 272 + c8 * 16) = w; } }
        __syncthreads();
        const int tok = r0 + 16 * wid + fr;
        float top[2][16];
#pragma unroll
        for (int half = 0; half < 2; ++half) {
            bf16x8 qf[4];
#pragma unroll
            for (int ks = 0; ks < 4; ++ks) qf[ks] = *(const bf16x8*)(QP + (size_t)tok * 2048 + 256 * h + 128 * half + 32 * ks + 8 * fq);
            float loc[16];
#pragma unroll
            for (int grp = 0; grp < 2; ++grp) {
                float kk[16];
#pragma unroll
                for (int nbb = 0; nbb < 4; ++nbb) { const int nb = 4 * grp + nbb; f32x4 acc = {0.f, 0.f, 0.f, 0.f};
#pragma unroll
                    for (int ks = 0; ks < 4; ++ks) { const bf16x8 kf = *(const LAS bf16x8*)(lds + half * 34816 + (16 * nb + fr) * 272 + (32 * ks + 8 * fq) * 2);
                        acc = __builtin_amdgcn_mfma_f32_16x16x32_bf16(kf, qf[ks], acc, 0, 0, 0); }
#pragma unroll
                    for (int i = 0; i < 4; ++i) { const unsigned code = 127u - (unsigned)(16 * nb + 4 * fq + i); kk[4 * nbb + i] = __uint_as_float((__float_as_uint(acc[i]) & ~127u) | code); } }
                sort16(kk);
                if (grp == 0) {
#pragma unroll
                    for (int i = 0; i < 16; ++i) loc[i] = kk[i];
                } else merge_top16(loc, kk);
            }
            xmerge_top16(loc, 16); xmerge_top16(loc, 32);
#pragma unroll
            for (int i = 0; i < 16; ++i) top[half][i] = loc[i];
        }
        if (fq < 2) {
#pragma unroll
            for (int i = 0; i < 16; ++i) scr[16 * fq + i] = __float_as_uint(fq == 0 ? top[0][i] : top[1][i]); }
        float fin[16];
#pragma unroll
        for (int aa = 0; aa < 4; ++aa) {
            const float va_k = fq == 0 ? top[0][aa] : fq == 1 ? top[0][4 + aa] : fq == 2 ? top[0][8 + aa] : top[0][12 + aa];
            const float va = __uint_as_float(__float_as_uint(va_k) & ~127u);
            float c[16];
#pragma unroll
            for (int bb = 0; bb < 16; ++bb) { const float s = va + __uint_as_float(__float_as_uint(top[1][bb]) & ~127u);
                c[bb] = __uint_as_float((__float_as_uint(s) & ~255u) | (255u - (unsigned)((4 * fq + aa) * 16 + bb))); }
            if (aa == 0) {
#pragma unroll
                for (int i = 0; i < 16; ++i) fin[i] = c[i];
            } else merge_top16(fin, c);
        }
        xmerge_top16(fin, 16); xmerge_top16(fin, 32);
        float ev[16], es = 0.f; const float mx = __uint_as_float(__float_as_uint(fin[0]) & ~255u);
#pragma unroll
        for (int i = 0; i < 16; ++i) { ev[i] = __expf(__uint_as_float(__float_as_uint(fin[i]) & ~255u) - mx); es += ev[i]; }
        const float inv = 1.f / es;
        asm volatile("s_waitcnt lgkmcnt(0)" ::: "memory");
        int oi[4]; float og[4];
#pragma unroll
        for (int kq = 0; kq < 4; ++kq) {
            const float fk = fq == 0 ? fin[kq] : fq == 1 ? fin[4 + kq] : fq == 2 ? fin[8 + kq] : fin[12 + kq];
            const float fe = fq == 0 ? ev[kq] : fq == 1 ? ev[4 + kq] : fq == 2 ? ev[8 + kq] : ev[12 + kq];
            const unsigned code = 255u - (__float_as_uint(fk) & 255u), a = code >> 4, bq = code & 15u;
            const unsigned i1 = 127u - (scr[a] & 127u), i2 = 127u - (scr[16 + bq] & 127u);
            oi[kq] = (int)(i1 * 128u + i2); og[kq] = fe * inv; }
        *(int4*)(IDX + (size_t)tok * 128 + 16 * h + 4 * fq) = make_int4(oi[0], oi[1], oi[2], oi[3]);
        *(f32x4*)(GATE + (size_t)tok * 128 + 16 * h + 4 * fq) = (f32x4){og[0], og[1], og[2], og[3]};
    }
}
template <class F>
__device__ __forceinline__ void peer_queue_loop(const Args& A, int layer, int phsel, int nrows, LAS unsigned char* smem, F body) {
    unsigned* ctl = (unsigned*)(A.ws + WS_CTL); const int x0 = (int)(xb_xcc_id() & 7u), nblk = nrows / 64;
    LAS unsigned* bcw = (LAS unsigned*)(smem + 16);
    for (int k = 0; k < NSL; ++k) { const int sl = ((x0 + k / (NSL / 8)) & 7) + 8 * (k % (NSL / 8)); unsigned* q = ctl + CW_QUEUE + ((layer * 4 + phsel) * NSL + sl) * 32;
        for (;;) { __syncthreads(); if (threadIdx.x == 0) *bcw = atomicAdd(q, 1u); __syncthreads(); const int blk = (int)*bcw; if (blk >= nblk) break; body(sl, blk); } }
}
__device__ __forceinline__ void phase_peer_u(const Args& A, int layer, int nrows, LAS unsigned char* smem, int rep) {
    const bf16_t* H = (const bf16_t*)(A.ws + WS_H); const int* IDX = (const int*)(A.ws + WS_R2); bf16_t* PART = (bf16_t*)(A.ws + WS_BIG + BIG_PART);
    const bf16_t* U = (const bf16_t*)(A.ws + WS_TAB);
    const int tid_ = otid(); const int wid = tid_ >> 6, lane = tid_ & 63, fr = lane & 15, fq = lane >> 4;
    peer_queue_loop(A, layer, 0 + 2 * rep, nrows, smem, [&](int sl, int blk) {
        const bf16_t* ub = U + (size_t)sl * NEXP * SW + 8 * fq;
        for (int ti = 0; ti < 8; ++ti) {
            const int tok = blk * 64 + wid * 8 + ti;
            bf16x8 tb[SW / 32];
#pragma unroll
            for (int ks = 0; ks < SW / 32; ++ks) tb[ks] = *(const bf16x8*)(H + (size_t)tok * 1024 + SW * sl + 32 * ks + 8 * fq);
            int e[8];
#pragma unroll
            for (int g = 0; g < 8; ++g) e[g] = IDX[(size_t)tok * 128 + 16 * g + fr];
            bf16x8 uf[8][SW / 32];
#pragma unroll
            for (int g = 0; g < 8; ++g)
#pragma unroll
                for (int ks = 0; ks < SW / 32; ++ks) uf[g][ks] = *(const bf16x8*)(ub + (size_t)e[g] * SW + 32 * ks);
            float v0 = 0.f, v1 = 0.f;
#pragma unroll
            for (int g = 0; g < 8; ++g) { f32x4 acc = {0.f, 0.f, 0.f, 0.f};
#pragma unroll
                for (int ks = 0; ks < SW / 32; ++ks) acc = __builtin_amdgcn_mfma_f32_16x16x32_bf16(tb[ks], uf[g][ks], acc, 0, 0, 0);
                if (g < 4) v0 = fq == g ? acc[0] : v0; else v1 = fq == g - 4 ? acc[0] : v1; }
            bf16_t* pp = PART + ((size_t)sl * NROW + tok) * 128 + 16 * fq + fr;
            pp[0] = f2bf(v0); pp[64] = f2bf(v1);
        }
    });
}
__device__ __forceinline__ void phase_coef(const Args& A, int nrows) {
    const bf16_t* PART = (const bf16_t*)(A.ws + WS_BIG + BIG_PART); const float* GATE = (const float*)(A.ws + WS_R2 + R2_GATE); float* COEF = (float*)(A.ws + WS_R2 + R2_COEF);
    const int gthr = blockIdx.x * NTHR + otid(), nthr = gridDim.x * NTHR;
    for (int p = gthr; p < nrows * 64; p += nthr) { float s0 = 0.f, s1 = 0.f;
#pragma unroll
        for (int x = 0; x < NSL; ++x) { const unsigned w = *(const unsigned*)(PART + (size_t)x * NROW * 128 + 2 * p); s0 += bflo(w); s1 += bfhi(w); }
        const f32x2 gt = *(const f32x2*)(GATE + 2 * p); const f32x2 ge = gelu_pk((f32x2){s0, s1});
        *(f32x2*)(COEF + 2 * p) = gt * ge; }
}
__device__ __forceinline__ void phase_peer_v(const Args& A, int layer, int nrows, LAS unsigned char* smem, int rep) {
    const int* IDX = (const int*)(A.ws + WS_R2); const float* COEF = (const float*)(A.ws + WS_R2 + R2_COEF);
    const bf16_t* V = (const bf16_t*)(A.ws + WS_TAB + TAB_HALF); const float* MODL = (const float*)(A.ws + WS_MOD) + (size_t)layer * 5 * 6144 + 5 * 1024;
    float* XC = (float*)(A.ws + WS_XC);
    constexpr int LPR = SW / 8, NQ = 64 / LPR, EPQ = 128 / NQ;
    const int tid_ = otid(); const int wid = tid_ >> 6, lane = tid_ & 63, m = lane % LPR, q = lane / LPR;
    peer_queue_loop(A, layer, 1 + 2 * rep, nrows, smem, [&](int sl, int blk) {
        const bf16_t* vb = V + (size_t)sl * NEXP * SW + 8 * m;
        for (int ti = 0; ti < 8; ++ti) {
            const int tok = blk * 64 + wid * 8 + ti;
            int4 ei[EPQ / 4]; f32x4 cf[EPQ / 4];
#pragma unroll
            for (int i = 0; i < EPQ / 4; ++i) { ei[i] = *(const int4*)(IDX + (size_t)tok * 128 + EPQ * q + 4 * i); cf[i] = *(const f32x4*)(COEF + (size_t)tok * 128 + EPQ * q + 4 * i); }
            float acc[8];
#pragma unroll
            for (int j = 0; j < 8; ++j) acc[j] = 0.f;
#pragma unroll
            for (int i = 0; i < EPQ / 4; ++i) {
                u32x4 vv[4];
                vv[0] = *(const u32x4*)(vb + (size_t)ei[i].x * SW); vv[1] = *(const u32x4*)(vb + (size_t)ei[i].y * SW);
                vv[2] = *(const u32x4*)(vb + (size_t)ei[i].z * SW); vv[3] = *(const u32x4*)(vb + (size_t)ei[i].w * SW);
#pragma unroll
                for (int k = 0; k < 4; ++k) { const float c = cf[i][k];
#pragma unroll
                    for (int j = 0; j < 4; ++j) { acc[2 * j] += c * bflo(vv[k][j]); acc[2 * j + 1] += c * bfhi(vv[k][j]); } }
            }
#pragma unroll
            for (int j = 0; j < 8; ++j) {
#pragma unroll
                for (int o = LPR; o < 64; o <<= 1) acc[j] += __shfl_xor(acc[j], o); }
            if (q == 0) {
                const bool lat = tok < NLAT; float* xp = (lat ? A.out + (size_t)tok * D : XC + (size_t)(tok - NLAT) * D) + SW * sl + 8 * m;
                const float* gp = MODL + (size_t)(lat ? (tok >> 13) : 4) * 6144 + SW * sl + 8 * m;
                const f32x4 g0 = *(const f32x4*)gp, g1 = *(const f32x4*)(gp + 4); f32x4 x0 = *(f32x4*)xp, x1 = *(f32x4*)(xp + 4);
                x0 += g0 * (f32x4){acc[0], acc[1], acc[2], acc[3]}; x1 += g1 * (f32x4){acc[4], acc[5], acc[6], acc[7]};
                *(f32x4*)xp = x0; *(f32x4*)(xp + 4) = x1;
            }
        }
    });
}

#ifndef MK_PER_PHASE
#define MK_PER_PHASE 0
#endif
__device__ __forceinline__ int nr_in(int L) { return L <= 2 ? NROW : NLAT; }
__device__ __forceinline__ int nr_out(int L) { return L <= 1 ? NROW : NLAT; }

__global__ void __launch_bounds__(NTHR, 2) fwd(Args A) {
    extern __shared__ __attribute__((aligned(256))) unsigned char smem_raw[];
    LAS unsigned char* smem = (LAS unsigned char*)smem_raw;
    LAS unsigned char* lds = smem + LDS_BASE;
    const int tid = otid();
    if (tid < 64) ((LAS unsigned*)smem)[tid] = 0u;
    __syncthreads();
    XcdBarrier bar = xcd_barrier_post((unsigned*)(A.ws + WS_CTL), (volatile LAS unsigned*)smem);
    bool need_bar = false;
    const int lo = A.ph_lo, hi = A.ph_hi;
#ifndef PHMASK
#define PHMASK 0xffffffffu
#endif
#define SITE(k) if constexpr (((PHMASK) >> (k)) & 1u)
#ifndef MK_REPEAT_SITE
#define MK_REPEAT_SITE -1
#endif
#define REP(k) for (int rep = 0; rep < ((k) == (MK_REPEAT_SITE) ? 2 : 1); ++rep)
#define PH(id) if ([&]() -> bool { if ((id) < lo || (id) >= hi) return false; if (need_bar) xcd_barrier(bar); need_bar = true; return true; }())
    unsigned char* ws = A.ws;
    float* XL = A.out; float* XC = (float*)(ws + WS_XC);
    bf16_t* H = (bf16_t*)(ws + WS_H);
    const float* MOD = (const float*)(ws + WS_MOD);

    SITE(0) PH(0) { phase_prologue(A, lds); }
    SITE(1) PH(1) { phase_norm_mod(A.in[I_X], A.in[I_CTX], XL, XC, A.in[I_N1G], MOD, 0, H, NROW); }
    for (int L = 0; L < DEPTH; ++L) {
        const int base = 2 + 16 * L, li = L >> 1; const bool hyb = (L & 1) == 0;
        const float* MODL = MOD + (size_t)L * 5 * 6144;
        unsigned char* WH = ws + WS_W + W_HYB + (size_t)li * WH_SZ; unsigned char* WG = ws + WS_W + W_GM + (size_t)li * WG_SZ; unsigned char* WP = ws + WS_W + W_PEER + (size_t)L * WP_SZ;
        if (hyb) {
            SITE(2) PH(base + 0) REP(2) { pg8::Gemm g{H, (const bf16_t*)(WH + WH_IN), nr_in(L), HYB_INP, 1024, 1024, 1024};
                pg8::EpiBf16<0> e{(bf16_t*)(ws + WS_BIG), HYB_INP}; pg8::gemm_phase(lds, g, e); }
            SITE(3) PH(base + 1) REP(3) { phase_conv(A, li); }
            SITE(4) PH(base + 2) {
                SITE(18) REP(18) { pg8::Gemm g{(const bf16_t*)(ws + WS_BIG) + C_CQ, (const bf16_t*)(WH + WH_QB), L == 0 ? NROW : NLAT, 1536, 384, HYB_INP, 384};
                  EpiQ e{(bf16_t*)(ws + WS_R1 + R1_Q), (const float*)(ws + WS_RSTD), (const float*)(ws + WS_ROPE)}; pg8::gemm_phase(lds, g, e); }
                SITE(19) REP(19) { pg8::Gemm g{(const bf16_t*)(ws + WS_BIG) + C_CKV, (const bf16_t*)(WH + WH_KVB), NROW, 2048, 256, HYB_INP, 256};
                  EpiKV e{ws + WS_R1 + R1_KN, ws + WS_R1 + R1_V, (const float*)(ws + WS_RSTD) + NROW}; pg8::gemm_phase(lds, g, e); }
                SITE(20) REP(20) for (int u = blockIdx.x; u < 528; u += gridDim.x) ssd::g_unit((const bf16_t*)(ws + WS_R2 + R2_BC), (bf16_t*)(ws + WS_BIG + BIG_G), u);
            }
            SITE(5) PH(base + 3) {
                SITE(21) REP(21) for (int u = blockIdx.x; u < 256; u += gridDim.x)
                    ssd::ssd_unit(u, (const bf16_t*)(ws + WS_R2), (const bf16_t*)(ws + WS_R2 + R2_BC), (const float*)(ws + WS_BIG + BIG_DT), (const bf16_t*)(ws + WS_BIG + BIG_G),
                                  A.in[I_ALOG] + li * 32, (bf16_t*)(ws + WS_H), (bf16_t*)(ws + WS_R3), lds);
                const int nau = L == 0 ? 1024 + 32 : 1024;
                SITE(22) REP(22) for (int au = blockIdx.x; au < nau; au += gridDim.x) {
                    int b, h, qrow0, orow0, nt;
                    if (au < 1024) { b = au >> 8; h = au & 7; const int qb = (au >> 3) & 31; qrow0 = 256 + 256 * qb; orow0 = b * 8192 + 256 * qb; nt = NKT; }
                    else { const int cu = au - 1024; b = cu >> 3; h = cu & 7; qrow0 = 0; orow0 = NLAT + 256 * b; nt = 4; }
                    const size_t bh = (size_t)(b * 8 + h);
                    att::attn_unit((const bf16_t*)(ws + WS_R1 + R1_Q) + (bh * NKEY + qrow0) * 192, ws + WS_R1 + R1_KN + bh * NKT * 16384, ws + WS_BIG + BIG_KR + (size_t)b * NKT * 8192,
                                   ws + WS_R1 + R1_V + bh * NKT * 16384, (bf16_t*)(ws + WS_R3 + R3_CAT) + (size_t)orow0 * 2048 + 1024 + 128 * h, nt, lds);
                }
            }
            SITE(6) PH(base + 4) REP(6) { phase_ssd_out(A, li, nr_out(L)); }
        } else {
            SITE(7) PH(base + 0) REP(7) { pg8::Gemm g{H, (const bf16_t*)(WG + WG_IN), nr_out(L), 4096, 1024, 1024, 1024};
                pg8::EpiBf16<1> e{(bf16_t*)(ws + WS_BIG), 4096}; pg8::gemm_phase(lds, g, e); }
            SITE(8) PH(base + 1) REP(8) { phase_ln_stats(A, nr_out(L)); }
            SITE(9) PH(base + 2) REP(9) { phase_spatial(A, li, nr_out(L), lds); }
        }
        SITE(10) PH(base + 5) { pg8::Gemm g{hyb ? (const bf16_t*)(ws + WS_R3 + R3_CAT) : (const bf16_t*)(ws + WS_R1), hyb ? (const bf16_t*)(WH + WH_OUT) : (const bf16_t*)(WG + WG_OUT), nr_out(L), 1024, 2048, 2048, 2048};
            pg8::EpiResid e{XL, XC, MODL + 2 * 1024}; pg8::gemm_phase(lds, g, e); }
        SITE(11) PH(base + 6) REP(11) { phase_norm_mod(XL, XC, nullptr, nullptr, A.in[I_N2G] + L * 1024, MODL, 3, H, nr_out(L)); phase_tabcvt(A, L); }
        SITE(12) PH(base + 7) REP(12) { pg8::Gemm g{H, (const bf16_t*)(WP + WP_Q), nr_out(L), 2048, 1024, 1024, 1024};
            pg8::EpiBf16<0> e{(bf16_t*)(ws + WS_BIG), 2048}; pg8::gemm_phase(lds, g, e); }
        SITE(13) PH(base + 8) REP(13) { phase_topk(A, L, nr_out(L), lds); }
        SITE(14) PH(base + 9) REP(14) { phase_peer_u(A, L, nr_out(L), smem, rep); }
        SITE(15) PH(base + 10) REP(15) { phase_coef(A, nr_out(L)); }
        SITE(16) PH(base + 11) { phase_peer_v(A, L, nr_out(L), smem, 0); }
        SITE(17) PH(base + 12) { if (L < DEPTH - 1) phase_norm_mod(XL, XC, nullptr, nullptr, A.in[I_N1G] + (L + 1) * 1024, MOD + (size_t)(L + 1) * 5 * 6144, 0, H, nr_in(L + 1));
                        else phase_final_norm(XL, A.in[I_FNG]); }
    }
#undef PH
}

#ifdef MK_TAP
__global__ void tap_kernel(const unsigned short* buf, size_t pitch, size_t col0, size_t ncols, size_t nrows, float* out) {
    const size_t n = ncols * nrows;
    for (size_t i = (size_t)blockIdx.x * blockDim.x + threadIdx.x; i < (size_t)NLAT * D; i += (size_t)gridDim.x * blockDim.x) {
        float s = 0.f; for (size_t j = i; j < n; j += (size_t)NLAT * D) s += (float)buf[(j / ncols) * pitch + col0 + (j % ncols)]; out[i] = s; }
}
#endif
extern "C" void kernel_launch(void* const* d_in, const int* in_sizes, int n_in, void* d_out, int out_size, void* d_ws, size_t ws_size, hipStream_t stream) {
    static int grid = 0;
    if (grid == 0) {
        if (n_in != N_IN || out_size != NLAT * D || ws_size < WS_END) { fprintf(stderr, "kernel_launch: unexpected shapes (n_in %d out %d ws %zu, need %zu)\n", n_in, out_size, ws_size, (size_t)WS_END); grid = -1; return; }
        int dev = 0, cus = 0, per_cu = 0;
        if (hipGetDevice(&dev) != hipSuccess || hipDeviceGetAttribute(&cus, hipDeviceAttributeMultiprocessorCount, dev) != hipSuccess) { grid = -1; return; }
        if (hipFuncSetAttribute((const void*)fwd, hipFuncAttributeMaxDynamicSharedMemorySize, LDS_BYTES) != hipSuccess) { fprintf(stderr, "kernel_launch: hipFuncSetAttribute failed\n"); grid = -1; return; }
        if (hipOccupancyMaxActiveBlocksPerMultiprocessor(&per_cu, (const void*)fwd, NTHR, LDS_BYTES) != hipSuccess || per_cu < 1) { fprintf(stderr, "kernel_launch: occupancy query says %d\n", per_cu); }
        (void)hipGetLastError();
        grid = cus;
    }
    if (grid < 0) return;
    (void)hipMemsetAsync((char*)d_ws + WS_CTL, 0, CTL_BYTES, stream);
    Args a{};
    for (int i = 0; i < N_IN; ++i) a.in[i] = (const float*)d_in[i];
    a.out = (float*)d_out; a.ws = (unsigned char*)d_ws;
#if MK_PER_PHASE
    for (int id = 0; id < 2 + 16 * DEPTH; ++id) {
        if (id >= 2) { const int L = (id - 2) / 16, s = (id - 2) % 16; if (s > 12) continue; if ((L & 1) && (s == 3 || s == 4)) continue; }
#ifdef MK_CUT
#ifdef MK_TAP
        if (id >= MK_CUT) continue;
#else
        if (id >= MK_CUT && id != 2 + 16 * (DEPTH - 1) + 12) continue;
#endif
#endif
        a.ph_lo = id; a.ph_hi = id + 1;
        hipLaunchKernelGGL(fwd, dim3(grid), dim3(NTHR), LDS_BYTES, stream, a);
    }
#ifdef MK_TAP
    { const size_t tp[5] = {MK_TAP}; hipLaunchKernelGGL(tap_kernel, dim3(2048), dim3(256), 0, stream, (const unsigned short*)((const char*)d_ws + tp[0]), tp[1], tp[2], tp[3], tp[4], (float*)d_out); }
#endif
#else
    a.ph_lo = 0; a.ph_hi = 2 + 16 * DEPTH;
    hipLaunchKernelGGL(fwd, dim3(grid), dim3(NTHR), LDS_BYTES, stream, a);
#endif
    const hipError_t le = hipPeekAtLastError();
    if (le != hipSuccess) fprintf(stderr, "kernel_launch: launch failed: %s\n", hipGetErrorName(le));
}
```

```cpp
#include <hip/hip_runtime.h>
#include <cstdio>
#include <cstdint>

#define LAS __attribute__((address_space(3)))
typedef unsigned short bf16_t;
typedef short bf16x8 __attribute__((ext_vector_type(8)));
typedef short s16x4 __attribute__((ext_vector_type(4)));
typedef float f32x2 __attribute__((ext_vector_type(2)));
typedef float f32x4 __attribute__((ext_vector_type(4)));
typedef float f32x16 __attribute__((ext_vector_type(16)));
typedef unsigned u32x2 __attribute__((ext_vector_type(2)));
typedef unsigned u32x4 __attribute__((ext_vector_type(4)));
typedef int i32x4 __attribute__((ext_vector_type(4)));

constexpr int D = 1024, NB = 4, SEQ = 8192, DEPTH = 4, CTXL = 256;
constexpr int NLAT = NB * SEQ, NCTX = NB * CTXL, NROW = NLAT + NCTX;
constexpr int HYB_IN = 3280, HYB_INP = 3328;
constexpr int C_Z = 0, C_XBC = 1024, C_DT = 2560, C_CQ = 2576, C_CKV = 2960, C_KR = 3216;
constexpr int NKEY = SEQ + CTXL, NKT = NKEY / 64;
constexpr float EPS = 1e-6f;
constexpr float QSCALE = 0.07216878364870322f * 1.4426950408889634f;
constexpr int NEXP = 16384;

enum { I_X = 0, I_C, I_CTX, I_CCTX, I_ADAW, I_ADAB, I_N1G, I_N2G, I_HWIN, I_CONVW, I_CONVB, I_ALOG, I_DTB, I_SSDD, I_SSDNG, I_QNG, I_WQB, I_KVNG, I_WKVB,
       I_HWOUT, I_GWIN, I_GLNG, I_GLNB, I_GWS, I_GBS, I_GWOUT, I_PWQ, I_PK1, I_PK2, I_PU, I_PV, I_FNG, N_IN };

constexpr size_t al256(size_t x) { return (x + 255) & ~(size_t)255; }
constexpr size_t WS_CTL = 0, CTL_BYTES = 65536;
constexpr size_t WS_MOD = WS_CTL + CTL_BYTES;
constexpr size_t WS_ROPE = WS_MOD + al256((size_t)DEPTH * 5 * 6144 * 4);
constexpr size_t WS_RSTD = WS_ROPE + (size_t)2 * SEQ * 32 * 4;
constexpr size_t WS_W = WS_RSTD + al256((size_t)2 * NROW * 4);
constexpr size_t W_HYB = 0;
constexpr size_t WH_IN = 0, WH_QB = WH_IN + (size_t)HYB_INP * 1024 * 2, WH_KVB = WH_QB + (size_t)1536 * 384 * 2, WH_OUT = WH_KVB + (size_t)2048 * 256 * 2,
                 WH_SZ = WH_OUT + (size_t)1024 * 2048 * 2;
constexpr size_t W_GM = W_HYB + 2 * WH_SZ;
constexpr size_t WG_IN = 0, WG_OUT = WG_IN + (size_t)4096 * 1024 * 2, WG_WS = WG_OUT + (size_t)1024 * 2048 * 2, WG_SZ = WG_WS + (size_t)8 * 128 * 128 * 2;
constexpr size_t W_PEER = W_GM + 2 * WG_SZ;
constexpr size_t WP_Q = 0, WP_K1 = WP_Q + (size_t)2048 * 1024 * 2, WP_K2 = WP_K1 + (size_t)8 * 128 * 128 * 2, WP_SZ = WP_K2 + (size_t)8 * 128 * 128 * 2;
constexpr size_t W_TOTAL = W_PEER + 4 * WP_SZ;
constexpr size_t WS_TAB = WS_W + al256(W_TOTAL);
constexpr size_t TAB_HALF = (size_t)NEXP * 1024 * 2;
constexpr size_t WS_XC = WS_TAB + 2 * TAB_HALF;
constexpr size_t WS_H = WS_XC + (size_t)NCTX * D * 4;
constexpr size_t WS_BIG = WS_H + (size_t)NROW * D * 2;
constexpr size_t BIG_BYTES = (size_t)NROW * 4096 * 2;
constexpr size_t BIG_DT = (size_t)NROW * HYB_INP * 2;
constexpr size_t BIG_G = BIG_DT + (size_t)NROW * 32 * 4;
constexpr size_t BIG_KR = BIG_G + (size_t)528 * 128 * 128 * 2;
constexpr size_t BIG_PART = (size_t)NROW * 2048 * 2;
static_assert(BIG_KR + (size_t)NB * NKT * 8192 <= BIG_BYTES, "BIG tail");
constexpr size_t WS_R1 = WS_BIG + BIG_BYTES;
constexpr size_t R1_Q = 0, R1_KN = R1_Q + (size_t)NB * 8 * NKEY * 192 * 2, R1_V = R1_KN + (size_t)NB * 8 * NKT * 16384, R1_BYTES = R1_V + (size_t)NB * 8 * NKT * 16384;
constexpr size_t WS_R2 = WS_R1 + R1_BYTES;
constexpr size_t R2_BC = (size_t)NROW * 1024 * 2, R2_BYTES = R2_BC + (size_t)NROW * 512 * 2;
constexpr size_t R2_GATE = (size_t)NROW * 128 * 4, R2_COEF = 2 * R2_GATE;
constexpr size_t WS_R3 = WS_R2 + R2_BYTES;
constexpr size_t R3_CAT = (size_t)NROW * 1024 * 2, R3_BYTES = R3_CAT + (size_t)NROW * 2048 * 2;
constexpr size_t WS_END = WS_R3 + R3_BYTES;
static_assert(WS_END <= ((size_t)1 << 30), "workspace must fit 1 GiB");

constexpr int CW_RANK = 3584;
constexpr int CW_QUEUE = 4096;

typedef __bf16 bf16x2_t __attribute__((ext_vector_type(2)));
__device__ __forceinline__ unsigned cvt_pk_bf16(float lo, float hi) { const f32x2 v = {lo, hi}; const bf16x2_t b = __builtin_convertvector(v, bf16x2_t); return __builtin_bit_cast(unsigned, b); }
__device__ __forceinline__ bf16_t f2bf(float f) { return (bf16_t)(cvt_pk_bf16(f, 0.f) & 0xffffu); }
__device__ __forceinline__ float bf2f(unsigned b) { return __uint_as_float(b << 16); }
__device__ __forceinline__ float bflo(unsigned w) { return __uint_as_float(w << 16); }
__device__ __forceinline__ float bfhi(unsigned w) { return __uint_as_float(w & 0xffff0000u); }
__device__ __forceinline__ float wave_sum(float v) {
#pragma unroll
    for (int o = 32; o >= 1; o >>= 1) v += __shfl_xor(v, o);
    return v;
}
__device__ __forceinline__ int otid() { int t = threadIdx.x; asm volatile("" : "+v"(t)); return t; }
__device__ __forceinline__ float silu_f(float x) { return x / (1.f + __expf(-x)); }
__device__ __forceinline__ float softplus_f(float x) { return x > 20.f ? x : log1pf(__expf(x)); }
__device__ __forceinline__ f32x2 gelu_pk(f32x2 v) {
    const f32x2 av = __builtin_elementwise_abs(v), d = av * 0.2316418882f + 1.0f;
    f32x2 t; t.x = __builtin_amdgcn_rcpf(d.x); t.y = __builtin_amdgcn_rcpf(d.y);
    f32x2 q = t * 0.5307027145f + (-0.7265760135f); q = q * t + 0.7107068705f; q = q * t + (-0.142248368f); q = q * t + 0.127414796f; q = q * t;
    const f32x2 s = (v * v) * (-0.72134752044f);
    f32x2 e; e.x = __builtin_amdgcn_exp2f(s.x); e.y = __builtin_amdgcn_exp2f(s.y);
    const f32x2 m = v * (q * e), r = v - m;
    f32x2 o; o.x = v.x < 0.f ? m.x : r.x; o.y = v.y < 0.f ? m.y : r.y; return o;
}
__device__ __forceinline__ float gelu_f(float x) { f32x2 v = {x, 0.f}; return gelu_pk(v).x; }

__device__ __forceinline__ int row_mb(int r) { return r < NLAT ? (r >> 13) : 4; }

#define XB_TMO      128
#define XB_XCNT(j)  (256  + 64 * (j))
#define XB_XSUB(j)  (1280 + 64 * (j))
#define XB_XGEN(j)  (2304 + 64 * (j))
#define XB_TOP      3328
#define XB_TOPGEN   3392
#define XCD_BAR_WORDS 3456
#define XB_SPIN_CAP (1u << 22)
__device__ __forceinline__ unsigned xb_ld(unsigned* p)              { return __hip_atomic_load(p, __ATOMIC_RELAXED, __HIP_MEMORY_SCOPE_AGENT); }
__device__ __forceinline__ unsigned xb_add(unsigned* p, unsigned v) { return __hip_atomic_fetch_add(p, v, __ATOMIC_RELAXED, __HIP_MEMORY_SCOPE_AGENT); }
__device__ __forceinline__ unsigned xb_xcc_id() { return (unsigned)__builtin_amdgcn_s_getreg((3 << 11) | 20) & 0xFu; }
#define XB_SPIN(cond, bar) do { unsigned _sp = 0; while (cond) { __builtin_amdgcn_s_sleep(1); \
    if ((++_sp & 255u) == 0u) { if (xb_ld(&(bar)[XB_TMO])) break; if (_sp > XB_SPIN_CAP) { atomicAdd(&(bar)[XB_TMO], 1u); break; } } } } while (0)
struct XcdBarrier { unsigned* bar; unsigned x; volatile LAS unsigned* st; };
__device__ __forceinline__ XcdBarrier xcd_barrier_post(unsigned* bar, volatile LAS unsigned* st) {
    XcdBarrier b; b.bar = bar; b.x = xb_xcc_id(); b.st = st;
    if (threadIdx.x == 0) (void)xb_add(&bar[XB_XCNT(b.x)], 1u);
    return b;
}
__device__ __forceinline__ void xcd_barrier_complete(unsigned* bar, unsigned x, unsigned& nloc, unsigned& nx) {
    const unsigned G = gridDim.x * gridDim.y * gridDim.z;
    unsigned sum, cnt, mine, sp = 0u;
    for (;;) {
        sum = 0u; cnt = 0u; mine = 0u;
#pragma unroll
        for (unsigned j = 0; j < 16; ++j) { const unsigned c = xb_ld(&bar[XB_XCNT(j)]); sum += c; cnt += (c > 0u) ? 1u : 0u; mine = (j == x) ? c : mine; }
        if (sum == G) break;
        __builtin_amdgcn_s_sleep(1);
        if ((++sp & 255u) == 0u) { if (xb_ld(&bar[XB_TMO])) break; if (sp > XB_SPIN_CAP) { atomicAdd(&bar[XB_TMO], 1u); break; } }
    }
    nloc = mine > 0u ? mine : 1u; nx = cnt > 0u ? cnt : 1u;
}
__device__ __forceinline__ void xcd_barrier(const XcdBarrier& b) {
    asm volatile("s_waitcnt vmcnt(0)" ::: "memory");
    __syncthreads();
    if (threadIdx.x == 0) {
        unsigned* bar = b.bar;
        __builtin_amdgcn_s_waitcnt(0);
        unsigned nloc = b.st[0], nx = b.st[1];
        if (nloc == 0u) { xcd_barrier_complete(bar, b.x, nloc, nx); b.st[0] = nloc; b.st[1] = nx; }
        const unsigned old = xb_add(&bar[XB_XSUB(b.x)], 1u);
        const unsigned gen = old / nloc;
        if (old + 1u == (gen + 1u) * nloc) {
            __builtin_amdgcn_fence(__ATOMIC_RELEASE, "agent");
            asm volatile("s_waitcnt vmcnt(0)" ::: "memory");
            const unsigned og = xb_add(&bar[XB_TOP], 1u);
            const unsigned tg = og / nx;
            if (og + 1u == (tg + 1u) * nx) xb_add(&bar[XB_TOPGEN], 1u);
            else XB_SPIN(xb_ld(&bar[XB_TOPGEN]) == tg, bar);
            __builtin_amdgcn_fence(__ATOMIC_ACQUIRE, "agent");
            xb_add(&bar[XB_XGEN(b.x)], 1u);
            asm volatile("s_waitcnt vmcnt(0)" ::: "memory");
        } else {
            XB_SPIN(xb_ld(&bar[XB_XGEN(b.x)]) == gen, bar);
            __builtin_amdgcn_fence(__ATOMIC_ACQUIRE, "agent");
            asm volatile("s_waitcnt vmcnt(0)" ::: "memory");
        }
    }
    __syncthreads();
}

namespace pg8 {
constexpr int BM = 256, BK = 64, HALF = 128, HTB = HALF * BK * 2, STAGE_BYTES = 8 * HTB, NXCD = 8, WGM = 8;
__host__ __device__ __forceinline__ int lds_byte(int r, int c) { const int st = (r >> 4) * 2 + (c >> 5), rr = r & 15, cc = c & 31, ob = rr * 64 + cc * 2; return st * 1024 + (ob ^ (((ob >> 9) & 1) << 5)); }
__host__ __device__ __forceinline__ void stage_rc(int b, int& R, int& C) { const int st = b / 1024, sb = b % 1024, swz = sb ^ (((sb >> 9) & 1) << 5); R = (st >> 1) * 16 + swz / 64; C = (st & 1) * 32 + (swz % 64) / 2; }
__host__ __device__ __forceinline__ int perm32(int rho) { const int n = rho >> 4, i = rho & 15; return 8 * (i >> 2) + 4 * n + (i & 3); }
struct Unit { int pm, pn; };
struct Gemm { const bf16_t* A; const bf16_t* Bt; int M, N, K, lda, ldb; };
struct StaticOrder {
    int nM, nN, nwg, G, c;
    __device__ void init(int M, int N, int G_, int c_) { nM = M / BM; nN = N / BM; nwg = nM * nN; G = G_; c = c_; }
    __device__ bool next(int i, Unit& u) const {
        const long L = (long)i * G + c; if (L >= nwg) return false;
        int wgid = (int)L; { const int q = nwg / NXCD, r = nwg % NXCD, xcd = wgid % NXCD, off = wgid / NXCD; wgid = (xcd < r ? xcd * (q + 1) : r * (q + 1) + (xcd - r) * q) + off; }
        const int nig = WGM * nN, gid = wgid / nig, fm = gid * WGM, gsz = (nM - fm) < WGM ? (nM - fm) : WGM;
        u.pm = fm + ((wgid % nig) % gsz); u.pn = (wgid % nig) / gsz; return true;
    }
};
template <class Epi>
__device__ __forceinline__ void gemm_phase(LAS unsigned char* lds, const Gemm g, const Epi& E) {
    const int tid = otid(), wid = __builtin_amdgcn_readfirstlane(tid >> 6), lane = tid & 63, wr = wid >> 2, wc = wid & 3, fr = lane & 15, fq = lane >> 4;
    StaticOrder S; S.init(g.M, g.N, (int)gridDim.x, (int)blockIdx.x);
    int K = g.K; asm volatile("" : "+s"(K));
    const int nt = K / BK;
    unsigned voffA[2], voffB[2];
#pragma unroll
    for (int i = 0; i < 2; ++i) { int R, C; stage_rc(tid * 16 + i * 8192, R, C); const int Rb = Epi::PERM ? ((R & ~31) + perm32(R & 31)) : R;
        voffA[i] = (unsigned)(R * g.lda + C) * 2u; voffB[i] = (unsigned)(Rb * g.ldb + C) * 2u; }
    const size_t kstep = (size_t)(BK * 2);
    const size_t hstepA = (size_t)HALF * g.lda * 2, hstepB = (size_t)HALF * g.ldb * 2;
    const size_t tstepA = 2 * hstepA, tstepB = 2 * hstepB;
    const unsigned ldsw = (unsigned)wid * 1024u;
    const int aoff = lds_byte(wr * 64 + fr, fq * 8), boff = lds_byte(wc * 32 + fr, fq * 8);
#define PG8_SA(b, h) (((b) * 2 + (h)) * HTB)
#define PG8_SB(b, h) ((4 + (b) * 2 + (h)) * HTB)
#define PG8_STAGE(bufoff, gbase, voff) do { _Pragma("unroll") for (int _i = 0; _i < 2; ++_i) \
        __builtin_amdgcn_global_load_lds((const unsigned*)((const char*)(gbase) + (voff)[_i]), (LAS unsigned*)(lds + (bufoff) + ldsw + _i * 8192), 16, 0, 0); } while (0)
#define PG8_LDA(dst, b, h) do { _Pragma("unroll") for (int m = 0; m < 4; ++m) _Pragma("unroll") for (int k = 0; k < 2; ++k) dst[m][k] = *(const LAS bf16x8*)(lds + PG8_SA(b, h) + aoff + m * 2048 + k * 1024); } while (0)
#define PG8_LDB(dst, b, h) do { _Pragma("unroll") for (int n = 0; n < 2; ++n) _Pragma("unroll") for (int k = 0; k < 2; ++k) dst[n][k] = *(const LAS bf16x8*)(lds + PG8_SB(b, h) + boff + n * 2048 + k * 1024); } while (0)
#define PG8_MMA(ai, bj, At, Bt) do { __builtin_amdgcn_s_setprio(1); _Pragma("unroll") for (int m = 0; m < 4; ++m) _Pragma("unroll") for (int n = 0; n < 2; ++n) _Pragma("unroll") for (int k = 0; k < 2; ++k) \
        acc[ai][bj][m][n] = __builtin_amdgcn_mfma_f32_16x16x32_bf16(Bt[n][k], At[m][k], acc[ai][bj][m][n], 0, 0, 0); __builtin_amdgcn_s_setprio(0); } while (0)
#define PG8_WAIT_V(n) asm volatile("s_waitcnt vmcnt(" #n ")" ::: "memory")
#define PG8_WAIT_L(n) asm volatile("s_waitcnt lgkmcnt(" #n ")" ::: "memory")
#define PG8_BAR __builtin_amdgcn_s_barrier()
#define PG8_SCHED __builtin_amdgcn_sched_barrier(0)
    Unit cur, nxt; int ui = 0;
    if (!S.next(0, cur)) return;
    f32x4 acc[2][2][4][2];
#pragma unroll
    for (int a = 0; a < 2; ++a)
#pragma unroll
        for (int b = 0; b < 2; ++b)
#pragma unroll
            for (int m = 0; m < 4; ++m)
#pragma unroll
                for (int n = 0; n < 2; ++n) acc[a][b][m][n] = (f32x4){0.f, 0.f, 0.f, 0.f};
    bf16x8 At[4][2], B0[2][2], B1[2][2];
    const char* cA = (const char*)g.A + (size_t)cur.pm * tstepA; const char* cB = (const char*)g.Bt + (size_t)cur.pn * tstepB;
    PG8_STAGE(PG8_SB(0, 0), cB, voffB); PG8_STAGE(PG8_SB(0, 1), cB + hstepB, voffB); PG8_STAGE(PG8_SA(0, 0), cA, voffA); PG8_STAGE(PG8_SA(0, 1), cA + hstepA, voffA);
    if (wr == 1) PG8_BAR;
    PG8_WAIT_V(2); PG8_BAR;
    PG8_STAGE(PG8_SB(1, 0), cB + kstep, voffB); PG8_STAGE(PG8_SA(1, 0), cA + kstep, voffA); PG8_STAGE(PG8_SB(1, 1), cB + hstepB + kstep, voffB);
    PG8_WAIT_V(6); PG8_BAR;
    for (;;) {
        const bool has_next = S.next(ui + 1, nxt);
        const char* nA = has_next ? (const char*)g.A + (size_t)nxt.pm * tstepA : cA; const char* nB = has_next ? (const char*)g.Bt + (size_t)nxt.pn * tstepB : cB;
        for (int t = 0; t < nt; t += 2) {
            const bool last = (t == nt - 2);
            const char* a1 = cA + (size_t)(t + 1) * kstep;
            const char* a2 = last ? nA : cA + (size_t)(t + 2) * kstep; const char* b2 = last ? nB : cB + (size_t)(t + 2) * kstep;
            const char* a3 = a2 + kstep; const char* b3 = b2 + kstep;
            PG8_LDB(B0, 0, 0); PG8_LDB(B1, 0, 1); PG8_SCHED; PG8_LDA(At, 0, 0); PG8_STAGE(PG8_SA(1, 1), a1 + hstepA, voffA);
            PG8_WAIT_V(8); PG8_WAIT_L(0); PG8_BAR; PG8_MMA(0, 0, At, B0); PG8_MMA(0, 1, At, B1); PG8_BAR; PG8_SCHED;
            PG8_LDA(At, 0, 1); PG8_STAGE(PG8_SB(0, 0), b2, voffB); PG8_STAGE(PG8_SB(0, 1), b2 + hstepB, voffB); PG8_STAGE(PG8_SA(0, 0), a2, voffA);
            PG8_WAIT_V(8); PG8_WAIT_L(0); PG8_BAR; PG8_MMA(1, 0, At, B0); PG8_MMA(1, 1, At, B1); PG8_BAR; PG8_SCHED;
            PG8_LDB(B0, 1, 0); PG8_LDB(B1, 1, 1); PG8_SCHED; PG8_LDA(At, 1, 0); PG8_STAGE(PG8_SA(0, 1), a2 + hstepA, voffA);
            PG8_WAIT_V(8); PG8_WAIT_L(0); PG8_BAR; PG8_MMA(0, 0, At, B0); PG8_MMA(0, 1, At, B1); PG8_BAR; PG8_SCHED;
            PG8_LDA(At, 1, 1); PG8_STAGE(PG8_SB(1, 0), b3, voffB); PG8_STAGE(PG8_SB(1, 1), b3 + hstepB, voffB); PG8_STAGE(PG8_SA(1, 0), a3, voffA);
            PG8_WAIT_V(8); PG8_WAIT_L(0); PG8_BAR; PG8_MMA(1, 0, At, B0); PG8_MMA(1, 1, At, B1); PG8_BAR; PG8_SCHED;
        }
        if (wr == 0) PG8_BAR;
        { const int l2_ = otid() & 63; E(acc, cur, wr, wc, l2_ & 15, l2_ >> 4); }
        if (!has_next) break;
#pragma unroll
        for (int a = 0; a < 2; ++a)
#pragma unroll
            for (int b = 0; b < 2; ++b)
#pragma unroll
                for (int m = 0; m < 4; ++m)
#pragma unroll
                    for (int n = 0; n < 2; ++n) acc[a][b][m][n] = (f32x4){0.f, 0.f, 0.f, 0.f};
        cur = nxt; cA = nA; cB = nB; ++ui;
        if (wr == 1) PG8_BAR;
    }
    PG8_WAIT_V(0);
    PG8_BAR;
#undef PG8_SA
#undef PG8_SB
#undef PG8_STAGE
#undef PG8_LDA
#undef PG8_LDB
#undef PG8_MMA
#undef PG8_WAIT_V
#undef PG8_WAIT_L
#undef PG8_BAR
#undef PG8_SCHED
}

template <int ACT> struct EpiBf16 {
    static constexpr bool PERM = true;
    bf16_t* O; int ldc;
    __device__ __forceinline__ void operator()(const f32x4 (&acc)[2][2][4][2], const Unit& u, int wr, int wc, int fr, int fq) const {
        const int row0 = u.pm * BM + wr * 64 + fr, col0 = u.pn * BM + wc * 32 + 8 * fq;
#pragma unroll
        for (int ai = 0; ai < 2; ++ai)
#pragma unroll
            for (int m = 0; m < 4; ++m) { bf16_t* rowp = O + (size_t)(row0 + ai * HALF + m * 16) * ldc + col0;
#pragma unroll
                for (int bj = 0; bj < 2; ++bj) { f32x4 v0 = acc[ai][bj][m][0], v1 = acc[ai][bj][m][1];
                    if (ACT == 1) { f32x2 a = gelu_pk((f32x2){v0[0], v0[1]}), b = gelu_pk((f32x2){v0[2], v0[3]}), c = gelu_pk((f32x2){v1[0], v1[1]}), d = gelu_pk((f32x2){v1[2], v1[3]});
                        v0 = (f32x4){a.x, a.y, b.x, b.y}; v1 = (f32x4){c.x, c.y, d.x, d.y}; }
                    u32x4 w; w.x = cvt_pk_bf16(v0[0], v0[1]); w.y = cvt_pk_bf16(v0[2], v0[3]); w.z = cvt_pk_bf16(v1[0], v1[1]); w.w = cvt_pk_bf16(v1[2], v1[3]);
                    *(u32x4*)(rowp + bj * HALF) = w; } }
    }
};
struct EpiResid {
    static constexpr bool PERM = false;
    float* xl; float* xc; const float* gate;
    __device__ __forceinline__ void operator()(const f32x4 (&acc)[2][2][4][2], const Unit& u, int wr, int wc, int fr, int fq) const {
        const int rbase = u.pm * BM; const bool lat = rbase < NLAT;
        float* X = lat ? xl + (size_t)rbase * D : xc + (size_t)(rbase - NLAT) * D;
        const float* gp = gate + (size_t)(lat ? (rbase >> 13) : 4) * 6144;
        const int row0 = wr * 64 + fr, col0 = u.pn * BM + wc * 32 + 4 * fq;
        f32x4 gv[2][2];
#pragma unroll
        for (int bj = 0; bj < 2; ++bj)
#pragma unroll
            for (int n = 0; n < 2; ++n) gv[bj][n] = *(const f32x4*)(gp + col0 + bj * HALF + n * 16);
#pragma unroll
        for (int ai = 0; ai < 2; ++ai)
#pragma unroll
            for (int m = 0; m < 4; ++m) { float* rowp = X + (size_t)(row0 + ai * HALF + m * 16) * D + col0;
#pragma unroll
                for (int bj = 0; bj < 2; ++bj)
#pragma unroll
                    for (int n = 0; n < 2; ++n) { f32x4* p = (f32x4*)(rowp + bj * HALF + n * 16); *p = *p + gv[bj][n] * acc[ai][bj][m][n]; } }
    }
};
}

namespace att {
constexpr int SLOT = 40960, KN_OFF = 0, KR_OFF = 16384, V_OFF = 24576, LDS_BYTES = 3 * SLOT + 8 * 256;
constexpr float THR2 = 11.0f;
#define KSWZ(row, colB) ((row) * 256 + ((colB) ^ (((row) & 7) << 4)))
#define KRSWZ(row, colB) ((row) * 128 + ((colB) ^ ((((row) >> 1) & 7) << 4)))
#define SBAR() __builtin_amdgcn_sched_barrier(0)
__device__ __forceinline__ int crow(int r, int hi) { return (r & 3) + 8 * (r >> 2) + 4 * hi; }
__host__ __device__ __forceinline__ int v_st(int k, int c) { const int kk = (k & ~0xC) | ((k & 4) << 1) | ((k & 8) >> 1); return ((kk >> 3) * 4 + (c >> 5)) * 512 + ((kk & 7) * 32 + (c & 31)) * 2; }
__device__ __forceinline__ int v_rd_base(int lane) { return ((lane & 3) << 3) | (((lane >> 2) & 3) << 6) | (((lane >> 4) & 1) << 5) | (((lane >> 5) & 1) << 8); }
constexpr int v_rd_off(int d0, int ks, int half) { return d0 * 512 + ks * 4096 + half * 2048; }
template <int OFF> __device__ __forceinline__ s16x4 tr_read(int vb) {
    s16x4 r; asm volatile("ds_read_b64_tr_b16 %0, %1 offset:%2" : "=&v"(r) : "v"(vb), "i"(OFF) : "memory"); return r;
}
template <int D0> __device__ __forceinline__ void pv_one(f32x16& od, int vb, bf16x8 pa0, bf16x8 pa1, bf16x8 pa2, bf16x8 pa3) {
    const s16x4 l0 = tr_read<v_rd_off(D0, 0, 0)>(vb), h0 = tr_read<v_rd_off(D0, 0, 1)>(vb), l1 = tr_read<v_rd_off(D0, 1, 0)>(vb), h1 = tr_read<v_rd_off(D0, 1, 1)>(vb);
    const s16x4 l2 = tr_read<v_rd_off(D0, 2, 0)>(vb), h2 = tr_read<v_rd_off(D0, 2, 1)>(vb), l3 = tr_read<v_rd_off(D0, 3, 0)>(vb), h3 = tr_read<v_rd_off(D0, 3, 1)>(vb);
    asm volatile("s_waitcnt lgkmcnt(0)" ::: "memory"); SBAR();
#define PK(L, H) (bf16x8){L[0], L[1], L[2], L[3], H[0], H[1], H[2], H[3]}
    od = __builtin_amdgcn_mfma_f32_32x32x16_bf16(pa0, PK(l0, h0), od, 0, 0, 0);
    od = __builtin_amdgcn_mfma_f32_32x32x16_bf16(pa1, PK(l1, h1), od, 0, 0, 0);
    od = __builtin_amdgcn_mfma_f32_32x32x16_bf16(pa2, PK(l2, h2), od, 0, 0, 0);
    od = __builtin_amdgcn_mfma_f32_32x32x16_bf16(pa3, PK(l3, h3), od, 0, 0, 0);
#undef PK
}
__device__ __forceinline__ void pv_d0(f32x16* o, int vb, bf16x8 pa0, bf16x8 pa1, bf16x8 pa2, bf16x8 pa3) {
    pv_one<0>(o[0], vb, pa0, pa1, pa2, pa3); pv_one<1>(o[1], vb, pa0, pa1, pa2, pa3); pv_one<2>(o[2], vb, pa0, pa1, pa2, pa3); pv_one<3>(o[3], vb, pa0, pa1, pa2, pa3);
}
__device__ __forceinline__ void partialSM(f32x16& p0, f32x16& p1, float& m_reg, float& mn, float& alpha) {
    float pmax = p0[0];
#pragma unroll
    for (int r = 1; r < 16; ++r) pmax = fmaxf(pmax, p0[r]);
#pragma unroll
    for (int r = 0; r < 16; ++r) pmax = fmaxf(pmax, p1[r]);
    { auto rr = __builtin_amdgcn_permlane32_swap(__float_as_uint(pmax), __float_as_uint(pmax), false, false);
      pmax = fmaxf(__uint_as_float(rr[0]), __uint_as_float(rr[1])); }
    if (__builtin_expect(__all(pmax - m_reg <= THR2), 1)) { mn = m_reg; alpha = 1.f; }
    else { mn = fmaxf(m_reg, pmax); alpha = __builtin_amdgcn_exp2f(m_reg - mn); m_reg = mn; }
#pragma unroll
    for (int r = 0; r < 16; ++r) p0[r] = __builtin_amdgcn_exp2f(p0[r] - mn);
#pragma unroll
    for (int r = 0; r < 16; ++r) p1[r] = p1[r] - mn;
}
__device__ __forceinline__ void finishSM(f32x16& p0, f32x16& p1, float alpha, float& l_reg, bf16x8& pa0, bf16x8& pa1, bf16x8& pa2, bf16x8& pa3) {
#pragma unroll
    for (int r = 0; r < 16; ++r) p1[r] = __builtin_amdgcn_exp2f(p1[r]);
    float ps = 0;
#pragma unroll
    for (int r = 0; r < 16; ++r) ps += p0[r];
#pragma unroll
    for (int r = 0; r < 16; ++r) ps += p1[r];
    { auto rr = __builtin_amdgcn_permlane32_swap(__float_as_uint(ps), __float_as_uint(ps), false, false);
      ps = __uint_as_float(rr[0]) + __uint_as_float(rr[1]); }
    l_reg = l_reg * alpha + ps;
#define PK4(P, BASE, OUT) do { unsigned a0 = cvt_pk_bf16(P[BASE + 0], P[BASE + 1]), a1 = cvt_pk_bf16(P[BASE + 2], P[BASE + 3]);   \
    unsigned b0 = cvt_pk_bf16(P[BASE + 4], P[BASE + 5]), b1 = cvt_pk_bf16(P[BASE + 6], P[BASE + 7]);                              \
    auto r0 = __builtin_amdgcn_permlane32_swap(a0, b0, false, false); auto r1 = __builtin_amdgcn_permlane32_swap(a1, b1, false, false); \
    u32x4 w = {r0[0], r1[0], r0[1], r1[1]}; OUT = *reinterpret_cast<bf16x8*>(&w); } while (0)
    PK4(p0, 0, pa0); PK4(p0, 8, pa1); PK4(p1, 0, pa2); PK4(p1, 8, pa3);
#undef PK4
}
__device__ __forceinline__ void qkt(f32x16& p0, f32x16& p1, LAS unsigned char* slot, const bf16x8* qr, int r32, int hi) {
    p0 = f32x16{}; p1 = f32x16{};
#pragma unroll
    for (int d0 = 0; d0 < 8; ++d0) { const int cb = (d0 * 16 + hi * 8) * 2;
        bf16x8 b0 = *(const LAS bf16x8*)(slot + KN_OFF + KSWZ(r32, cb));
        bf16x8 b1 = *(const LAS bf16x8*)(slot + KN_OFF + KSWZ(32 + r32, cb));
        p0 = __builtin_amdgcn_mfma_f32_32x32x16_bf16(b0, qr[d0], p0, 0, 0, 0);
        p1 = __builtin_amdgcn_mfma_f32_32x32x16_bf16(b1, qr[d0], p1, 0, 0, 0); }
#pragma unroll
    for (int d0 = 0; d0 < 4; ++d0) { const int cb = (d0 * 16 + hi * 8) * 2;
        bf16x8 b0 = *(const LAS bf16x8*)(slot + KR_OFF + KRSWZ(r32, cb));
        bf16x8 b1 = *(const LAS bf16x8*)(slot + KR_OFF + KRSWZ(32 + r32, cb));
        p0 = __builtin_amdgcn_mfma_f32_32x32x16_bf16(b0, qr[8 + d0], p0, 0, 0, 0);
        p1 = __builtin_amdgcn_mfma_f32_32x32x16_bf16(b1, qr[8 + d0], p1, 0, 0, 0); }
}
__device__ __forceinline__ void attn_unit(const bf16_t* __restrict__ Qb, const unsigned char* __restrict__ KNt, const unsigned char* __restrict__ KRt, const unsigned char* __restrict__ Vt,
                                          bf16_t* __restrict__ Ob, int NT, LAS unsigned char* lds) {
    const int tid = otid(), wid = __builtin_amdgcn_readfirstlane(tid >> 6), lane = tid & 63, r32 = lane & 31, hi = lane >> 5;
    LAS float* wsf = (LAS float*)(lds + 3 * SLOT) + wid * 64; LAS float* li_l = wsf; LAS float* al_l = wsf + 32;
    float m_reg = -1e30f, l_reg = 0; f32x16 o[4] = {}; bf16x8 qr[12];
    const bf16_t* Qw = Qb + (size_t)(wid * 32 + r32) * 192 + hi * 8;
#pragma unroll
    for (int d0 = 0; d0 < 12; ++d0) qr[d0] = *(const bf16x8*)(Qw + d0 * 16);
    const int vrb = (int)(unsigned)(uintptr_t)(lds) + V_OFF + v_rd_base(lane);
    const unsigned lo16 = (unsigned)lane * 16u;
#define ATT_DMA(tile, slotoff) do { const size_t t_ = (size_t)(tile); LAS unsigned char* sl_ = lds + (slotoff); \
        __builtin_amdgcn_global_load_lds((const unsigned*)(KNt + t_ * 16384 + wid * 1024 + lo16), (LAS unsigned*)(sl_ + KN_OFF + wid * 1024), 16, 0, 0); \
        __builtin_amdgcn_global_load_lds((const unsigned*)(KNt + t_ * 16384 + (wid + 8) * 1024 + lo16), (LAS unsigned*)(sl_ + KN_OFF + (wid + 8) * 1024), 16, 0, 0); \
        __builtin_amdgcn_global_load_lds((const unsigned*)(KRt + t_ * 8192 + wid * 1024 + lo16), (LAS unsigned*)(sl_ + KR_OFF + wid * 1024), 16, 0, 0); \
        __builtin_amdgcn_global_load_lds((const unsigned*)(Vt + t_ * 16384 + wid * 1024 + lo16), (LAS unsigned*)(sl_ + V_OFF + wid * 1024), 16, 0, 0); \
        __builtin_amdgcn_global_load_lds((const unsigned*)(Vt + t_ * 16384 + (wid + 8) * 1024 + lo16), (LAS unsigned*)(sl_ + V_OFF + (wid + 8) * 1024), 16, 0, 0); } while (0)
#define ATT_SYNC() do { asm volatile("s_waitcnt vmcnt(0)" ::: "memory"); __builtin_amdgcn_s_barrier(); asm volatile("" ::: "memory"); } while (0)
#define RESC(a) do { if (__any((a) < 1.f)) { if (hi == 0) al_l[r32] = (a); asm volatile("s_waitcnt lgkmcnt(0)" ::: "memory"); \
        _Pragma("unroll") for (int d = 0; d < 4; ++d) _Pragma("unroll") for (int r = 0; r < 16; ++r) o[d][r] *= al_l[crow(r, hi)]; } } while (0)
    f32x16 pA0, pA1, pB0, pB1; float mnA, mnB, alA, alB; bf16x8 pa0, pa1, pa2, pa3;
    int sp = 0, sc = SLOT, sn = 2 * SLOT;
    ATT_DMA(0, 0); ATT_DMA(1, SLOT);
    asm volatile("s_waitcnt vmcnt(5)" ::: "memory"); __builtin_amdgcn_s_barrier(); asm volatile("" ::: "memory");
    qkt(pA0, pA1, lds, qr, r32, hi); partialSM(pA0, pA1, m_reg, mnA, alA);
    for (int j = 1; j + 1 < NT; j += 2) {
        ATT_SYNC(); ATT_DMA(j + 1, sn);
        SBAR(); qkt(pB0, pB1, lds + sc, qr, r32, hi);
        finishSM(pA0, pA1, alA, l_reg, pa0, pa1, pa2, pa3); SBAR();
        pv_d0(o, vrb + sp, pa0, pa1, pa2, pa3); partialSM(pB0, pB1, m_reg, mnB, alB);
        RESC(alB);
        { const int t_ = sp; sp = sc; sc = sn; sn = t_; }
        ATT_SYNC(); if (j + 2 < NT) ATT_DMA(j + 2, sn);
        SBAR(); qkt(pA0, pA1, lds + sc, qr, r32, hi);
        finishSM(pB0, pB1, alB, l_reg, pa0, pa1, pa2, pa3); SBAR();
        pv_d0(o, vrb + sp, pa0, pa1, pa2, pa3); partialSM(pA0, pA1, m_reg, mnA, alA);
        RESC(alA);
        { const int t_ = sp; sp = sc; sc = sn; sn = t_; }
    }
    ATT_SYNC();
    SBAR(); qkt(pB0, pB1, lds + sc, qr, r32, hi);
    finishSM(pA0, pA1, alA, l_reg, pa0, pa1, pa2, pa3); SBAR();
    pv_d0(o, vrb + sp, pa0, pa1, pa2, pa3); partialSM(pB0, pB1, m_reg, mnB, alB);
    RESC(alB);
    finishSM(pB0, pB1, alB, l_reg, pa0, pa1, pa2, pa3); SBAR();
    pv_d0(o, vrb + sc, pa0, pa1, pa2, pa3);
    if (hi == 0) li_l[r32] = l_reg; asm volatile("s_waitcnt lgkmcnt(0)" ::: "memory");
    float rli[16];
#pragma unroll
    for (int r = 0; r < 16; ++r) rli[r] = __builtin_amdgcn_rcpf(li_l[crow(r, hi)]);
    bf16_t* Ow = Ob + (size_t)(wid * 32) * 2048;
#pragma unroll
    for (int r = 0; r < 16; ++r) { const int orow = crow(r, hi);
#pragma unroll
        for (int d0 = 0; d0 < 4; ++d0) Ow[(size_t)orow * 2048 + d0 * 32 + r32] = f2bf(o[d0][r] * rli[r]); }
    __builtin_amdgcn_s_barrier(); asm volatile("" ::: "memory");
#undef ATT_DMA
#undef ATT_SYNC
#undef RESC
}
}

namespace ssd {
constexpr int XT_OFF = 0, XTW_OFF = 8704, BT_OFF = 17408, HB_OFF = 52224, SET = 60928, CW_OFF = 2 * SET, LDS_BYTES = CW_OFF + 8 * 512;
constexpr int PITCH = 272;
constexpr float L2E = 1.4426950408889634f;
__device__ __forceinline__ void g_unit(const bf16_t* __restrict__ BC, bf16_t* __restrict__ G, int unit) {
    const int cid = unit >> 1, g = unit & 1;
    const int r0 = cid < 256 ? cid * 128 : NLAT + (cid - 256) * 128;
    const int tid = otid(), wid = tid >> 6, lane = tid & 63, fr = lane & 15, fq = lane >> 4;
    const bf16_t* Cp = BC + (size_t)(r0 + 16 * wid + fr) * 512 + 256 + 128 * g + 8 * fq;
    bf16x8 cf[4];
#pragma unroll
    for (int ks = 0; ks < 4; ++ks) cf[ks] = *(const bf16x8*)(Cp + 32 * ks);
    bf16_t* Gp = G + ((size_t)unit * 128 + 16 * wid + fr) * 128 + 4 * fq;
#pragma unroll
    for (int sb = 0; sb < 8; ++sb) {
        const bf16_t* Bp = BC + (size_t)(r0 + 16 * sb + fr) * 512 + 128 * g + 8 * fq;
        f32x4 acc = {0.f, 0.f, 0.f, 0.f};
#pragma unroll
        for (int ks = 0; ks < 4; ++ks) { const bf16x8 bfr = *(const bf16x8*)(Bp + 32 * ks); acc = __builtin_amdgcn_mfma_f32_16x16x32_bf16(bfr, cf[ks], acc, 0, 0, 0); }
        u32x2 w; w.x = cvt_pk_bf16(acc[0], acc[1]); w.y = cvt_pk_bf16(acc[2], acc[3]);
        *(u32x2*)(Gp + 16 * sb) = w;
    }
}
__device__ __forceinline__ void ssd_unit(int u, const bf16_t* __restrict__ XS, const bf16_t* __restrict__ BC, const float* __restrict__ DT, const bf16_t* __restrict__ G,
                                         const float* __restrict__ a_log, bf16_t* __restrict__ Y0, bf16_t* __restrict__ Y1, LAS unsigned char* lds) {
    const int b = u >> 6, h = (u >> 2) & 15, d = (u >> 1) & 1, ph = u & 1, g = h >> 3;
    const int tid = otid(), wid = tid >> 6, lane = tid & 63, fr = lane & 15, fq = lane >> 4;
    const float a = -__expf(a_log[d * 16 + h]);
    bf16_t* Y = d ? Y1 : Y0;
    LAS float* cw = (LAS float*)(lds + CW_OFF + wid * 512);
    f32x4 hs[2] = {{0.f, 0.f, 0.f, 0.f}, {0.f, 0.f, 0.f, 0.f}};
    for (int i = tid; i < 8704 / 4; i += 512) ((LAS unsigned*)(lds + HB_OFF))[i] = 0u;
    float cend = 0.f;
#define SSD_ROWS(step, r0v, gidv) do { if ((step) < 2) { const int oc_ = d ? 1 - (step) : (step); r0v = NLAT + b * 256 + oc_ * 128; gidv = 256 + b * 2 + oc_; } \
        else { const int lc_ = (step) - 2, oc_ = d ? 63 - lc_ : lc_; r0v = b * 8192 + oc_ * 128; gidv = b * 64 + oc_; } } while (0)
#define SSD_STAGE(step) do { int r0_, gid_; SSD_ROWS(step, r0_, gid_); (void)gid_; LAS unsigned char* set_ = lds + ((step) & 1) * SET; \
        const float da0 = DT[(size_t)(r0_ + 2 * lane) * 32 + d * 16 + h] * a, da1 = DT[(size_t)(r0_ + 2 * lane + 1) * 32 + d * 16 + h] * a; \
        float sc_ = da0 + da1; \
        if (d == 0) { _Pragma("unroll") for (int o_ = 1; o_ < 64; o_ <<= 1) { const float t_ = __shfl_up(sc_, o_); if (lane >= o_) sc_ += t_; } \
            cw[2 * lane] = sc_ - da1; cw[2 * lane + 1] = sc_; cend = __shfl(sc_, 63); } \
        else { _Pragma("unroll") for (int o_ = 1; o_ < 64; o_ <<= 1) { const float t_ = __shfl_down(sc_, o_); if (lane + o_ < 64) sc_ += t_; } \
            cw[2 * lane] = sc_; cw[2 * lane + 1] = sc_ - da0; cend = __shfl(sc_, 0); } \
        asm volatile("s_waitcnt lgkmcnt(0)" ::: "memory"); \
        { const int s_ = tid & 127, pq_ = tid >> 7; const int row_ = r0_ + s_; \
          const u32x4 xv_ = *(const u32x4*)(XS + (size_t)row_ * 1024 + 64 * h + 32 * ph + 8 * pq_); \
          const float dt_ = DT[(size_t)row_ * 32 + d * 16 + h]; const float wg_ = __builtin_amdgcn_exp2f((cend - cw[s_]) * L2E); \
          LAS bf16_t* xt_ = (LAS bf16_t*)(set_ + XT_OFF) + (8 * pq_) * 136 + s_; LAS bf16_t* xw_ = (LAS bf16_t*)(set_ + XTW_OFF) + (8 * pq_) * 136 + s_; \
          _Pragma("unroll") for (int i_ = 0; i_ < 4; ++i_) { const float lo_ = bflo(xv_[i_]) * dt_, hi_ = bfhi(xv_[i_]) * dt_; \
              xt_[(2 * i_) * 136] = f2bf(lo_); xt_[(2 * i_ + 1) * 136] = f2bf(hi_); xw_[(2 * i_) * 136] = f2bf(lo_ * wg_); xw_[(2 * i_ + 1) * 136] = f2bf(hi_ * wg_); } } \
        _Pragma("unroll") for (int j_ = 0; j_ < 4; ++j_) { const int idx_ = tid + 512 * j_, s_ = idx_ & 127, n8_ = idx_ >> 7; \
          const u32x4 bv_ = *(const u32x4*)(BC + (size_t)(r0_ + s_) * 512 + 128 * g + 8 * n8_); \
          LAS bf16_t* bt_ = (LAS bf16_t*)(set_ + BT_OFF) + (8 * n8_) * 136 + s_; \
          _Pragma("unroll") for (int i_ = 0; i_ < 4; ++i_) { bt_[(2 * i_) * 136] = (bf16_t)(bv_[i_] & 0xffffu); bt_[(2 * i_ + 1) * 136] = (bf16_t)(bv_[i_] >> 16); } } \
    } while (0)
    SSD_STAGE(0);
    for (int step = 0; step < 66; ++step) {
        __syncthreads();
        int r0, gid; SSD_ROWS(step, r0, gid);
        LAS unsigned char* set = lds + (step & 1) * SET;
        const float cend_cur = cend;
        {
            const int t = 16 * wid + fr; const float ct = cw[t];
            f32x4 y[2] = {{0.f, 0.f, 0.f, 0.f}, {0.f, 0.f, 0.f, 0.f}};
            const bf16_t* Gp = G + ((size_t)(gid * 2 + g) * 128 + t) * 128 + 8 * fq;
            const bf16_t* Cp = BC + (size_t)(r0 + t) * 512 + 256 + 128 * g + 8 * fq;
            u32x4 gv[4], cv[4];
#pragma unroll
            for (int ks = 0; ks < 4; ++ks) { gv[ks] = *(const u32x4*)(Gp + 32 * ks); cv[ks] = *(const u32x4*)(Cp + 32 * ks); }
            const float et = __builtin_amdgcn_exp2f(ct * L2E);
#pragma unroll
            for (int ks = 0; ks < 4; ++ks) {
                const bool live = d == 0 ? (32 * ks <= 16 * wid + 15) : (32 * ks + 31 >= 16 * wid);
                if (live) {
                    const int s0 = 32 * ks + 8 * fq;
                    const f32x4 c0 = *(const LAS f32x4*)(cw + s0), c1 = *(const LAS f32x4*)(cw + s0 + 4);
                    float m[8];
#pragma unroll
                    for (int i = 0; i < 8; ++i) { const float cs = i < 4 ? c0[i & 3] : c1[i & 3]; const int s = s0 + i;
                        const bool ok = d == 0 ? (s <= t) : (s >= t);
                        const float gval = (i & 1) ? bfhi(gv[ks][i >> 1]) : bflo(gv[ks][i >> 1]);
                        m[i] = ok ? gval * __builtin_amdgcn_exp2f((ct - cs) * L2E) : 0.f; }
                    u32x4 mw; mw.x = cvt_pk_bf16(m[0], m[1]); mw.y = cvt_pk_bf16(m[2], m[3]); mw.z = cvt_pk_bf16(m[4], m[5]); mw.w = cvt_pk_bf16(m[6], m[7]);
                    const bf16x8 mb = __builtin_bit_cast(bf16x8, mw);
#pragma unroll
                    for (int q = 0; q < 2; ++q) { const bf16x8 af = *(const LAS bf16x8*)(set + XT_OFF + (16 * q + fr) * PITCH + (32 * ks + 8 * fq) * 2);
                        y[q] = __builtin_amdgcn_mfma_f32_16x16x32_bf16(af, mb, y[q], 0, 0, 0); }
                }
            }
#pragma unroll
            for (int ks = 0; ks < 4; ++ks) {
                u32x4 cwv;
#pragma unroll
                for (int i = 0; i < 4; ++i) cwv[i] = cvt_pk_bf16(bflo(cv[ks][i]) * et, bfhi(cv[ks][i]) * et);
                const bf16x8 cb = __builtin_bit_cast(bf16x8, cwv);
#pragma unroll
                for (int q = 0; q < 2; ++q) { const bf16x8 af = *(const LAS bf16x8*)(set + HB_OFF + (16 * q + fr) * PITCH + (32 * ks + 8 * fq) * 2);
                    y[q] = __builtin_amdgcn_mfma_f32_16x16x32_bf16(af, cb, y[q], 0, 0, 0); }
            }
            bf16_t* yp = Y + (size_t)(r0 + t) * 1024 + 64 * h + 32 * ph + 4 * fq;
#pragma unroll
            for (int q = 0; q < 2; ++q) { u32x2 w; w.x = cvt_pk_bf16(y[q][0], y[q][1]); w.y = cvt_pk_bf16(y[q][2], y[q][3]); *(u32x2*)(yp + 16 * q) = w; }
        }
        {
            const float dec = __builtin_amdgcn_exp2f(cend_cur * L2E);
            hs[0] = hs[0] * dec; hs[1] = hs[1] * dec;
#pragma unroll
            for (int ks = 0; ks < 4; ++ks) {
                const bf16x8 bfr = *(const LAS bf16x8*)(set + BT_OFF + (16 * wid + fr) * PITCH + (32 * ks + 8 * fq) * 2);
#pragma unroll
                for (int q = 0; q < 2; ++q) { const bf16x8 af = *(const LAS bf16x8*)(set + XTW_OFF + (16 * q + fr) * PITCH + (32 * ks + 8 * fq) * 2);
                    hs[q] = __builtin_amdgcn_mfma_f32_16x16x32_bf16(af, bfr, hs[q], 0, 0, 0); }
            }
            LAS bf16_t* hb = (LAS bf16_t*)(lds + ((step + 1) & 1) * SET + HB_OFF) + 16 * wid + fr;
#pragma unroll
            for (int q = 0; q < 2; ++q)
#pragma unroll
                for (int i = 0; i < 4; ++i) hb[(16 * q + 4 * fq + i) * 136] = f2bf(hs[q][i]);
        }
        if (step + 1 < 66) SSD_STAGE(step + 1);
    }
    __syncthreads();
#undef SSD_ROWS
#undef SSD_STAGE
}
}

struct Args { const float* in[32]; float* out; unsigned char* ws; int ph_lo, ph_hi; };
constexpr int NTHR = 512;
constexpr int LDS_BASE = 256;
constexpr int LDS_PHASE = 133120;
constexpr int LDS_BYTES = LDS_BASE + LDS_PHASE;
static_assert(att::LDS_BYTES <= LDS_PHASE && ssd::LDS_BYTES <= LDS_PHASE && pg8::STAGE_BYTES <= LDS_PHASE, "LDS");

__device__ __forceinline__ void tjob(int j, const Args& A, const float*& src, bf16_t*& dst, int& K, int& N, int& Npad, int& mode, const float*& ks) {
    unsigned char* W = A.ws + WS_W; mode = 0; ks = nullptr;
    if (j < 8) { const int i = j >> 2, w = j & 3; unsigned char* base = W + W_HYB + (size_t)i * WH_SZ;
        if (w == 0)      { src = A.in[I_HWIN] + (size_t)i * 1024 * HYB_IN; dst = (bf16_t*)(base + WH_IN); K = 1024; N = HYB_IN; Npad = HYB_INP; mode = 1; }
        else if (w == 1) { src = A.in[I_WQB] + (size_t)i * 384 * 1536; dst = (bf16_t*)(base + WH_QB); K = 384; N = 1536; Npad = 1536; mode = 2; ks = A.in[I_QNG] + i * 384; }
        else if (w == 2) { src = A.in[I_WKVB] + (size_t)i * 256 * 2048; dst = (bf16_t*)(base + WH_KVB); K = 256; N = 2048; Npad = 2048; ks = A.in[I_KVNG] + i * 256; }
        else             { src = A.in[I_HWOUT] + (size_t)i * 2048 * 1024; dst = (bf16_t*)(base + WH_OUT); K = 2048; N = 1024; Npad = 1024; }
    } else if (j < 12) { const int i = (j - 8) >> 1, w = (j - 8) & 1; unsigned char* base = W + W_GM + (size_t)i * WG_SZ;
        if (w == 0) { src = A.in[I_GWIN] + (size_t)i * 1024 * 4096; dst = (bf16_t*)(base + WG_IN); K = 1024; N = 4096; Npad = 4096; }
        else        { src = A.in[I_GWOUT] + (size_t)i * 2048 * 1024; dst = (bf16_t*)(base + WG_OUT); K = 2048; N = 1024; Npad = 1024; }
    } else { const int l = j - 12; src = A.in[I_PWQ] + (size_t)l * 1024 * 2048; dst = (bf16_t*)(W + W_PEER + (size_t)l * WP_SZ + WP_Q); K = 1024; N = 2048; Npad = 2048; }
}
__device__ __forceinline__ int colmap(int mode, int n, int N) {
    if (mode == 1) { if (n >= N) return -1; if (n < C_KR) return n; const int m = n - C_KR; return C_KR + (m >> 1) + 32 * (m & 1); }
    if (mode == 2) { if (n < 1024) return (n >> 7) * 192 + (n & 127); const int m = n - 1024, h = m >> 6, mm = m & 63; return h * 192 + 128 + (mm >> 1) + 32 * (mm & 1); }
    return n;
}
__device__ __forceinline__ void phase_prologue(const Args& A, LAS unsigned char* lds) {
    const int tid = otid();
    {
        LAS float* tile = (LAS float*)lds;
        int item = blockIdx.x;
        for (int j = 0; j < 16; ++j) {
            const float* src; bf16_t* dst; int K, N, Npad, mode; const float* ks; tjob(j, A, src, dst, K, N, Npad, mode, ks);
            const int tk = K / 64, tn = Npad / 64, nt = tk * tn;
            for (; item < nt; item += gridDim.x) {
                const int k0 = (item % tk) * 64, n0 = (item / tk) * 64;
                { const int k = tid >> 3, cg = tid & 7; const float sc = ks ? ks[k0 + k] : 1.f;
#pragma unroll
                  for (int jj = 0; jj < 8; ++jj) { const int oc = colmap(mode, n0 + 8 * cg + jj, N); tile[k * 65 + 8 * cg + jj] = oc >= 0 ? src[(size_t)(k0 + k) * N + oc] * sc : 0.f; } }
                __syncthreads();
                { const int n = tid >> 3, kg = tid & 7; float v[8];
#pragma unroll
                  for (int jj = 0; jj < 8; ++jj) v[jj] = tile[(8 * kg + jj) * 65 + n];
                  u32x4 w; w.x = cvt_pk_bf16(v[0], v[1]); w.y = cvt_pk_bf16(v[2], v[3]); w.z = cvt_pk_bf16(v[4], v[5]); w.w = cvt_pk_bf16(v[6], v[7]);
                  *(u32x4*)(dst + (size_t)(n0 + n) * K + k0 + 8 * kg) = w; }
                __syncthreads();
            }
            item -= nt;
        }
    }
    {
        const int gthr = blockIdx.x * NTHR + tid, nthr = gridDim.x * NTHR;
        for (int p = gthr; p < 10 * 16384; p += nthr) {
            const int mat = p >> 14, off = (p & 16383) * 8; const float* src; bf16_t* dst;
            if (mat < 2)      { src = A.in[I_GWS] + (size_t)mat * 131072; dst = (bf16_t*)(A.ws + WS_W + W_GM + (size_t)mat * WG_SZ + WG_WS); }
            else if (mat < 6) { src = A.in[I_PK1] + (size_t)(mat - 2) * 131072; dst = (bf16_t*)(A.ws + WS_W + W_PEER + (size_t)(mat - 2) * WP_SZ + WP_K1); }
            else              { src = A.in[I_PK2] + (size_t)(mat - 6) * 131072; dst = (bf16_t*)(A.ws + WS_W + W_PEER + (size_t)(mat - 6) * WP_SZ + WP_K2); }
            const f32x4 a = *(const f32x4*)(src + off), b = *(const f32x4*)(src + off + 4);
            u32x4 w; w.x = cvt_pk_bf16(a[0], a[1]); w.y = cvt_pk_bf16(a[2], a[3]); w.z = cvt_pk_bf16(b[0], b[1]); w.w = cvt_pk_bf16(b[2], b[3]);
            *(u32x4*)(dst + off) = w;
        }
        float* rope = (float*)(A.ws + WS_ROPE);
        for (int p = gthr; p < SEQ * 32; p += nthr) { const int l = p >> 5, i = p & 31; const float pos = (float)(i < 16 ? (l >> 6) : (l & 63));
            const float inv = powf(10000.f, -(float)(i & 15) / 16.f), ang = pos * inv; rope[p] = cosf(ang); rope[SEQ * 32 + p] = sinf(ang); }
    }
    {
        LAS float* scond = (LAS float*)lds;
        LAS float* red = scond + 5 * 1024;
        __syncthreads();
        for (int i = tid; i < 5 * 1024; i += NTHR) { const int m = i >> 10, k = i & 1023; const float c = m < 4 ? A.in[I_C][m * 1024 + k] : A.in[I_CCTX][k]; scond[i] = silu_f(c); }
        __syncthreads();
        float* MOD = (float*)(A.ws + WS_MOD);
        for (int item = blockIdx.x; item < 4 * 48; item += gridDim.x) {
            const int layer = item / 48, j0 = (item % 48) * 128; const int c4 = tid & 31, ksl = tid >> 5;
            f32x4 acc[5];
#pragma unroll
            for (int m = 0; m < 5; ++m) acc[m] = (f32x4){0.f, 0.f, 0.f, 0.f};
            const float* wp = A.in[I_ADAW] + ((size_t)layer * 1024 + ksl * 64) * 6144 + j0 + 4 * c4;
            for (int k = 0; k < 64; ++k) { const f32x4 w = *(const f32x4*)(wp + (size_t)k * 6144);
#pragma unroll
                for (int m = 0; m < 5; ++m) acc[m] += w * scond[m * 1024 + ksl * 64 + k]; }
#pragma unroll
            for (int m = 0; m < 5; ++m) *(LAS f32x4*)(red + (ksl * 5 + m) * 128 + 4 * c4) = acc[m];
            __syncthreads();
            for (int i = tid; i < 640; i += NTHR) { const int m = i >> 7, c = i & 127; float s = A.in[I_ADAB][layer * 6144 + j0 + c];
#pragma unroll
                for (int q = 0; q < 16; ++q) s += red[(q * 5 + m) * 128 + c];
                MOD[((size_t)layer * 5 + m) * 6144 + j0 + c] = s; }
            __syncthreads();
        }
    }
}

__device__ __forceinline__ void phase_norm_mod(const float* xl, const float* xc, float* cl, float* cc, const float* g, const float* modl, int sh_idx, bf16_t* H, int nrows) {
    const int tid_ = otid(); const int lane = tid_ & 63, gw = blockIdx.x * 8 + (tid_ >> 6), nw = gridDim.x * 8;
    f32x4 gv[4];
#pragma unroll
    for (int i = 0; i < 4; ++i) gv[i] = *(const f32x4*)(g + 256 * i + 4 * lane);
    for (int r = gw; r < nrows; r += nw) {
        const bool lat = r < NLAT; const float* xp = lat ? xl + (size_t)r * D : xc + (size_t)(r - NLAT) * D;
        f32x4 x[4]; float ss = 0.f;
#pragma unroll
        for (int i = 0; i < 4; ++i) { x[i] = *(const f32x4*)(xp + 256 * i + 4 * lane); ss += x[i][0] * x[i][0] + x[i][1] * x[i][1] + x[i][2] * x[i][2] + x[i][3] * x[i][3]; }
        if (cl) { float* cp = lat ? cl + (size_t)r * D : cc + (size_t)(r - NLAT) * D;
#pragma unroll
            for (int i = 0; i < 4; ++i) *(f32x4*)(cp + 256 * i + 4 * lane) = x[i]; }
        ss = wave_sum(ss); const float rstd = rsqrtf(ss * (1.f / 1024.f) + EPS);
        const float* mp = modl + (size_t)(lat ? (r >> 13) : 4) * 6144 + sh_idx * 1024;
#pragma unroll
        for (int i = 0; i < 4; ++i) { const f32x4 sh = *(const f32x4*)(mp + 256 * i + 4 * lane), sc = *(const f32x4*)(mp + 1024 + 256 * i + 4 * lane);
            const f32x4 hv = (x[i] * rstd) * gv[i] * (sc + 1.f) + sh;
            u32x2 w; w.x = cvt_pk_bf16(hv[0], hv[1]); w.y = cvt_pk_bf16(hv[2], hv[3]);
            *(u32x2*)(H + (size_t)r * D + 256 * i + 4 * lane) = w; }
    }
}
__device__ __forceinline__ void phase_final_norm(float* xl, const float* g) {
    const int tid_ = otid(); const int lane = tid_ & 63, gw = blockIdx.x * 8 + (tid_ >> 6), nw = gridDim.x * 8;
    f32x4 gv[4];
#pragma unroll
    for (int i = 0; i < 4; ++i) gv[i] = *(const f32x4*)(g + 256 * i + 4 * lane);
    for (int r = gw; r < NLAT; r += nw) {
        float* xp = xl + (size_t)r * D; f32x4 x[4]; float ss = 0.f;
#pragma unroll
        for (int i = 0; i < 4; ++i) { x[i] = *(const f32x4*)(xp + 256 * i + 4 * lane); ss += x[i][0] * x[i][0] + x[i][1] * x[i][1] + x[i][2] * x[i][2] + x[i][3] * x[i][3]; }
        ss = wave_sum(ss); const float rstd = rsqrtf(ss * (1.f / 1024.f) + EPS);
#pragma unroll
        for (int i = 0; i < 4; ++i) *(f32x4*)(xp + 256 * i + 4 * lane) = (x[i] * rstd) * gv[i];
    }
}

__device__ __forceinline__ void phase_conv(const Args& A, int li) {
    const bf16_t* PROJ = (const bf16_t*)(A.ws + WS_BIG);
    bf16_t* XS = (bf16_t*)(A.ws + WS_R2); bf16_t* BC = (bf16_t*)(A.ws + WS_R2 + R2_BC);
    const int tid = otid();
    if (tid < 384) {
        const int cg = tid % 192, half = tid / 192, c0 = 8 * cg;
        const float* cw = A.in[I_CONVW] + ((size_t)li * 1536 + c0) * 5; const float* cb = A.in[I_CONVB] + (size_t)li * 1536 + c0;
        float w[8][5], bia[8];
#pragma unroll
        for (int j = 0; j < 8; ++j) { bia[j] = cb[j];
#pragma unroll
            for (int k = 0; k < 5; ++k) w[j][k] = cw[j * 5 + k]; }
        for (int blk = blockIdx.x; blk < NROW / 64; blk += gridDim.x) {
            const int rbeg = blk * 64 + half * 32; int s0, s1;
            if (rbeg < NLAT) { s0 = rbeg & ~8191; s1 = s0 + 8192; } else { s0 = NLAT + ((rbeg - NLAT) & ~255); s1 = s0 + 256; }
            float win[5][8];
#define CONV_LD(dst, r) do { const int r_ = (r); if (r_ >= s0 && r_ < s1) { const u32x4 v_ = *(const u32x4*)(PROJ + (size_t)r_ * HYB_INP + C_XBC + c0); \
                _Pragma("unroll") for (int q_ = 0; q_ < 4; ++q_) { dst[2 * q_] = bflo(v_[q_]); dst[2 * q_ + 1] = bfhi(v_[q_]); } } \
                else { _Pragma("unroll") for (int q_ = 0; q_ < 8; ++q_) dst[q_] = 0.f; } } while (0)
            CONV_LD(win[0], rbeg - 2); CONV_LD(win[1], rbeg - 1); CONV_LD(win[2], rbeg); CONV_LD(win[3], rbeg + 1); CONV_LD(win[4], rbeg + 2);
            for (int r = rbeg; r < rbeg + 32; ++r) {
                float o[8];
#pragma unroll
                for (int j = 0; j < 8; ++j) { float s = bia[j];
#pragma unroll
                    for (int k = 0; k < 5; ++k) s += w[j][k] * win[k][j];
                    o[j] = silu_f(s); }
                u32x4 pk; pk.x = cvt_pk_bf16(o[0], o[1]); pk.y = cvt_pk_bf16(o[2], o[3]); pk.z = cvt_pk_bf16(o[4], o[5]); pk.w = cvt_pk_bf16(o[6], o[7]);
                if (c0 < 1024) *(u32x4*)(XS + (size_t)r * 1024 + c0) = pk; else *(u32x4*)(BC + (size_t)r * 512 + (c0 - 1024)) = pk;
#pragma unroll
                for (int k = 0; k < 4; ++k)
#pragma unroll
                    for (int j = 0; j < 8; ++j) win[k][j] = win[k + 1][j];
                CONV_LD(win[4], r + 3);
            }
#undef CONV_LD
        }
    }
    {
        const int lane = tid & 63, gw = blockIdx.x * 8 + (tid >> 6), nw = gridDim.x * 8;
        float* DT = (float*)(A.ws + WS_BIG + BIG_DT); float* RQ = (float*)(A.ws + WS_RSTD); float* RKV = RQ + NROW;
        unsigned char* KR = A.ws + WS_BIG + BIG_KR; const float* rope = (const float*)(A.ws + WS_ROPE);
        const float dtb = lane < 32 ? A.in[I_DTB][li * 32 + lane] : 0.f;
        for (int r = gw; r < NROW; r += nw) {
            const bf16_t* p = PROJ + (size_t)r * HYB_INP;
            if (lane < 32) DT[(size_t)r * 32 + lane] = softplus_f(bf2f(p[C_DT + (lane & 15)]) + dtb);
            { const unsigned* q = (const unsigned*)(p + C_CQ + 6 * lane); float ss = 0.f;
#pragma unroll
              for (int j = 0; j < 3; ++j) { const unsigned w = q[j]; const float a = bflo(w), b = bfhi(w); ss += a * a + b * b; }
              ss = wave_sum(ss); if (lane == 0) RQ[r] = rsqrtf(ss * (1.f / 384.f) + EPS); }
            { const u32x2 w = *(const u32x2*)(p + C_CKV + 4 * lane); const float a = bflo(w.x), b = bfhi(w.x), c = bflo(w.y), d = bfhi(w.y);
              float ss = a * a + b * b + c * c + d * d; ss = wave_sum(ss); if (lane == 0) RKV[r] = rsqrtf(ss * (1.f / 256.f) + EPS); }
            if (lane < 32) { const unsigned w = *(const unsigned*)(p + C_KR + 2 * lane); float x1 = bflo(w), x2 = bfhi(w); int b, key;
                if (r < NLAT) { const int l = r & 8191; const float c = rope[l * 32 + lane], s = rope[SEQ * 32 + l * 32 + lane];
                    const float o1 = x1 * c - x2 * s, o2 = x1 * s + x2 * c; x1 = o1; x2 = o2; b = r >> 13; key = 256 + l; }
                else { b = (r - NLAT) >> 8; key = (r - NLAT) & 255; }
                *(unsigned*)(KR + (size_t)(b * NKT + (key >> 6)) * 8192 + KRSWZ(key & 63, 4 * lane)) = cvt_pk_bf16(x1, x2); }
        }
    }
}

struct EpiQ {
    static constexpr bool PERM = true;
    bf16_t* Q; const float* rstd; const float* rope;
    __device__ __forceinline__ void operator()(const f32x4 (&acc)[2][2][4][2], const pg8::Unit& u, int wr, int wc, int fr, int fq) const {
        const bool lat = u.pm < 128;
        const int b = lat ? (u.pm >> 5) : ((u.pm - 128) >> 0), q0 = lat ? 256 + ((u.pm & 31) << 8) : 0;
        const bool isrope = u.pn >= 4;
#pragma unroll
        for (int ai = 0; ai < 2; ++ai) {
            const int rl = 128 * ai + 64 * wr + fr;
            const float* rsp = rstd + u.pm * 256 + rl;
            const float* rp = rope + (size_t)(((u.pm & 31) << 8) + rl) * 32;
#pragma unroll
            for (int bj = 0; bj < 2; ++bj) {
                const int c0 = u.pn * 256 + 128 * bj + 32 * wc + 8 * fq; int h, dcol;
                if (!isrope) { h = c0 >> 7; dcol = c0 & 127; } else { const int mq = c0 - 1024; h = mq >> 6; dcol = 128 + (mq & 63); }
                bf16_t* dst = Q + ((size_t)(b * 8 + h) * NKEY + q0 + rl) * 192 + dcol;
                const int ro = (dcol - 128) >> 1;
#pragma unroll
                for (int m = 0; m < 4; ++m) {
                    const float rs = rsp[16 * m] * QSCALE;
                    f32x4 v0 = acc[ai][bj][m][0] * rs, v1 = acc[ai][bj][m][1] * rs;
                    if (isrope && lat) { const f32x4 cs = *(const f32x4*)(rp + 16 * m * 32 + ro), sn = *(const f32x4*)(rp + SEQ * 32 + 16 * m * 32 + ro);
                        const f32x4 a0 = v0, a1 = v1;
                        v0[0] = a0[0] * cs[0] - a0[1] * sn[0]; v0[1] = a0[0] * sn[0] + a0[1] * cs[0]; v0[2] = a0[2] * cs[1] - a0[3] * sn[1]; v0[3] = a0[2] * sn[1] + a0[3] * cs[1];
                        v1[0] = a1[0] * cs[2] - a1[1] * sn[2]; v1[1] = a1[0] * sn[2] + a1[1] * cs[2]; v1[2] = a1[2] * cs[3] - a1[3] * sn[3]; v1[3] = a1[2] * sn[3] + a1[3] * cs[3]; }
                    u32x4 w; w.x = cvt_pk_bf16(v0[0], v0[1]); w.y = cvt_pk_bf16(v0[2], v0[3]); w.z = cvt_pk_bf16(v1[0], v1[1]); w.w = cvt_pk_bf16(v1[2], v1[3]);
                    *(u32x4*)(dst + 16 * m * 192) = w;
                    asm volatile("" ::: "memory");
                }
            }
        }
    }
};
struct EpiKV {
    static constexpr bool PERM = true;
    unsigned char* KN; unsigned char* V; const float* rstd;
    __device__ __forceinline__ void operator()(const f32x4 (&acc)[2][2][4][2], const pg8::Unit& u, int wr, int wc, int fr, int fq) const {
        const bool lat = u.pm < 128;
        const int b = lat ? (u.pm >> 5) : (u.pm - 128), t0 = lat ? 4 + ((u.pm & 31) << 2) : 0;
        const int dd = 32 * wc + 8 * fq;
        const int offK = fr * 256 + ((dd * 2) ^ ((fr & 7) << 4));
        const int offV = att::v_st(fr, dd);
#pragma unroll
        for (int ai = 0; ai < 2; ++ai) {
            const size_t tb = ((size_t)(b * 8 + u.pn) * NKT + t0 + 2 * ai + wr) * 16384;
            const float* rsp = rstd + u.pm * 256 + 128 * ai + 64 * wr + fr;
            unsigned char* kp = KN + tb + offK; unsigned char* vp = V + tb + offV;
#pragma unroll
            for (int m = 0; m < 4; ++m) {
                const float rs = rsp[16 * m];
#pragma unroll
                for (int bj = 0; bj < 2; ++bj) {
                    const f32x4 v0 = acc[ai][bj][m][0] * rs, v1 = acc[ai][bj][m][1] * rs;
                    u32x4 w; w.x = cvt_pk_bf16(v0[0], v0[1]); w.y = cvt_pk_bf16(v0[2], v0[3]); w.z = cvt_pk_bf16(v1[0], v1[1]); w.w = cvt_pk_bf16(v1[2], v1[3]);
                    if (bj == 0) *(u32x4*)(kp + m * 4096) = w; else *(u32x4*)(vp + m * 4096) = w;
                }
                asm volatile("" ::: "memory");
            }
        }
    }
};

__device__ __forceinline__ void phase_ssd_out(const Args& A, int li, int nrows) {
    const bf16_t* PROJ = (const bf16_t*)(A.ws + WS_BIG); const bf16_t* XS = (const bf16_t*)(A.ws + WS_R2);
    const bf16_t* Y0 = (const bf16_t*)(A.ws + WS_H); const bf16_t* Y1 = (const bf16_t*)(A.ws + WS_R3); bf16_t* CAT = (bf16_t*)(A.ws + WS_R3 + R3_CAT);
    const int tid_ = otid(); const int lane = tid_ & 63, gw = blockIdx.x * 8 + (tid_ >> 6), nw = gridDim.x * 8;
    const float dsk = A.in[I_SSDD][li * 16 + (lane >> 2)];
    float ng[16];
#pragma unroll
    for (int j = 0; j < 16; ++j) ng[j] = A.in[I_SSDNG][li * 1024 + 16 * lane + j];
    for (int r = gw; r < nrows; r += nw) {
        float v[16]; float ss = 0.f;
#pragma unroll
        for (int hh = 0; hh < 2; ++hh) {
            const u32x4 a = *(const u32x4*)(Y0 + (size_t)r * 1024 + 16 * lane + 8 * hh), b = *(const u32x4*)(Y1 + (size_t)r * 1024 + 16 * lane + 8 * hh);
            const u32x4 x = *(const u32x4*)(XS + (size_t)r * 1024 + 16 * lane + 8 * hh), z = *(const u32x4*)(PROJ + (size_t)r * HYB_INP + 16 * lane + 8 * hh);
#pragma unroll
            for (int q = 0; q < 4; ++q) {
                const float y0 = (bflo(a[q]) + bflo(b[q]) + dsk * bflo(x[q])) * silu_f(bflo(z[q])), y1 = (bfhi(a[q]) + bfhi(b[q]) + dsk * bfhi(x[q])) * silu_f(bfhi(z[q]));
                v[8 * hh + 2 * q] = y0; v[8 * hh + 2 * q + 1] = y1; ss += y0 * y0 + y1 * y1; }
        }
#pragma unroll
        for (int o = 16; o >= 1; o >>= 1) ss += __shfl_xor(ss, o);
        const float rstd = rsqrtf(ss * (1.f / 512.f) + EPS);
#pragma unroll
        for (int hh = 0; hh < 2; ++hh) { u32x4 w;
#pragma unroll
            for (int q = 0; q < 4; ++q) w[q] = cvt_pk_bf16(v[8 * hh + 2 * q] * rstd * ng[8 * hh + 2 * q], v[8 * hh + 2 * q + 1] * rstd * ng[8 * hh + 2 * q + 1]);
            *(u32x4*)(CAT + (size_t)r * 2048 + 16 * lane + 8 * hh) = w; }
    }
}

__device__ __forceinline__ void phase_ln_stats(const Args& A, int nrows) {
    const bf16_t* Gb = (const bf16_t*)(A.ws + WS_BIG); float* ST = (float*)(A.ws + WS_RSTD);
    const int tid_ = otid(); const int lane = tid_ & 63, gw = blockIdx.x * 8 + (tid_ >> 6), nw = gridDim.x * 8;
    for (int r = gw; r < nrows; r += nw) {
        float v[32]; float s = 0.f;
#pragma unroll
        for (int j = 0; j < 4; ++j) { const u32x4 w = *(const u32x4*)(Gb + (size_t)r * 4096 + 2048 + 512 * j + 8 * lane);
#pragma unroll
            for (int q = 0; q < 4; ++q) { v[8 * j + 2 * q] = bflo(w[q]); v[8 * j + 2 * q + 1] = bfhi(w[q]); s += v[8 * j + 2 * q] + v[8 * j + 2 * q + 1]; } }
        s = wave_sum(s); const float mu = s * (1.f / 2048.f); float q2 = 0.f;
#pragma unroll
        for (int j = 0; j < 32; ++j) { const float dd = v[j] - mu; q2 += dd * dd; }
        q2 = wave_sum(q2);
        if (lane == 0) { ST[r] = mu; ST[NROW + r] = rsqrtf(q2 * (1.f / 2048.f) + EPS); }
    }
}
__device__ __forceinline__ void phase_spatial(const Args& A, int gi, int nrows, LAS unsigned char* lds) {
    const bf16_t* Gb = (const bf16_t*)(A.ws + WS_BIG); const float* ST = (const float*)(A.ws + WS_RSTD); bf16_t* Ab = (bf16_t*)(A.ws + WS_R1);
    const bf16_t* WSg = (const bf16_t*)(A.ws + WS_W + W_GM + (size_t)gi * WG_SZ + WG_WS);
    const float* lng = A.in[I_GLNG] + (size_t)gi * 2048; const float* lnb = A.in[I_GLNB] + (size_t)gi * 2048; const float* bs = A.in[I_GBS] + (size_t)gi * 1024;
    const int tid = otid(), wid = tid >> 6, lane = tid & 63, r32 = lane & 31, hi = lane >> 5, tb = wid & 3, dh = wid >> 2;
    const int ldsaddr = (int)(unsigned)(uintptr_t)lds;
    for (int unit = blockIdx.x; unit < (nrows / 128) * 8; unit += gridDim.x) {
        const int cb = unit >> 3, gg = unit & 7, r0 = cb * 128;
        __syncthreads();
#pragma unroll
        for (int j = 0; j < 8; ++j) { const int idx = tid + 512 * j, s = idx >> 5, dd = (idx & 31) * 8;
            const u32x4 w = *(const u32x4*)(Gb + (size_t)(r0 + s) * 4096 + 2048 + 256 * gg + dd);
            const float mu = ST[r0 + s], rs = ST[NROW + r0 + s];
            const f32x4 g0 = *(const f32x4*)(lng + 256 * gg + dd), g1 = *(const f32x4*)(lng + 256 * gg + dd + 4), b0 = *(const f32x4*)(lnb + 256 * gg + dd), b1 = *(const f32x4*)(lnb + 256 * gg + dd + 4);
            u32x4 o;
            o.x = cvt_pk_bf16((bflo(w.x) - mu) * rs * g0[0] + b0[0], (bfhi(w.x) - mu) * rs * g0[1] + b0[1]); o.y = cvt_pk_bf16((bflo(w.y) - mu) * rs * g0[2] + b0[2], (bfhi(w.y) - mu) * rs * g0[3] + b0[3]);
            o.z = cvt_pk_bf16((bflo(w.z) - mu) * rs * g1[0] + b1[0], (bfhi(w.z) - mu) * rs * g1[1] + b1[1]); o.w = cvt_pk_bf16((bflo(w.w) - mu) * rs * g1[2] + b1[2], (bfhi(w.w) - mu) * rs * g1[3] + b1[3]);
            *(LAS u32x4*)(lds + ((s >> 6) * 2 + (dd >> 7)) * 16384 + att::v_st(s & 63, dd & 127)) = o; }
        bf16x8 pa[8];
#pragma unroll
        for (int ks = 0; ks < 8; ++ks) pa[ks] = *(const bf16x8*)(WSg + ((size_t)gg * 128 + 32 * tb + r32) * 128 + 16 * ks + 8 * hi);
        __syncthreads();
        f32x16 o[4] = {};
        att::pv_d0(o, ldsaddr + (0 * 2 + dh) * 16384 + att::v_rd_base(lane), pa[0], pa[1], pa[2], pa[3]);
        att::pv_d0(o, ldsaddr + (1 * 2 + dh) * 16384 + att::v_rd_base(lane), pa[4], pa[5], pa[6], pa[7]);
#pragma unroll
        for (int r = 0; r < 16; ++r) { const int t = 32 * tb + att::crow(r, hi), row = r0 + t; const float bsv = bs[gg * 128 + t];
#pragma unroll
            for (int d0 = 0; d0 < 4; ++d0) { const int col = 256 * gg + 128 * dh + 32 * d0 + r32;
                Ab[(size_t)row * 2048 + col] = f2bf(bf2f(Gb[(size_t)row * 4096 + col]) * (o[d0][r] + bsv)); } }
    }
}

constexpr int NSL = 8, SW = 1024 / NSL;
constexpr size_t TAB8_HALF = (size_t)NEXP * 1024, TAB_SCL = 2 * TAB8_HALF;
constexpr float HS = 4.f;
__device__ __forceinline__ unsigned pk4_fp8(float a, float b, float c, float d) { int w = 0; w = __builtin_amdgcn_cvt_pk_fp8_f32(a, b, w, false); w = __builtin_amdgcn_cvt_pk_fp8_f32(c, d, w, true); return (unsigned)w; }
__device__ __forceinline__ void phase_tabcvt(const Args& A, int layer) {
    const int tid_ = otid(); const int lane = tid_ & 63, gw = blockIdx.x * 8 + (tid_ >> 6), nw = gridDim.x * 8;
    float* SCL = (float*)(A.ws + WS_TAB + TAB_SCL);
    for (int r = gw; r < 2 * NEXP; r += nw) {
        const int tab = r >> 14, e = r & (NEXP - 1);
        const float* src = (tab ? A.in[I_PV] : A.in[I_PU]) + ((size_t)layer * NEXP + e) * 1024 + 16 * lane;
        f32x4 v[4]; float am = 0.f;
#pragma unroll
        for (int i = 0; i < 4; ++i) { v[i] = *(const f32x4*)(src + 4 * i); am = fmaxf(am, fmaxf(fmaxf(fabsf(v[i][0]), fabsf(v[i][1])), fmaxf(fabsf(v[i][2]), fabsf(v[i][3])))); }
#pragma unroll
        for (int o = 32; o >= 1; o >>= 1) am = fmaxf(am, __shfl_xor(am, o));
        float sc = 1.f; if (am > 0.f) { int ex; (void)frexpf(448.f / am, &ex); sc = ldexpf(1.f, ex - 1); }
        if (lane == 0) SCL[tab * NEXP + e] = 1.f / sc;
        u32x4 w;
#pragma unroll
        for (int i = 0; i < 4; ++i) w[i] = pk4_fp8(v[i][0] * sc, v[i][1] * sc, v[i][2] * sc, v[i][3] * sc);
        *(u32x4*)(A.ws + WS_TAB + (size_t)tab * TAB8_HALF + ((size_t)(lane >> 3) * NEXP + e) * SW + 16 * (lane & 7)) = w;
    }
}
#define CASD(a, b) do { const float hi_ = fmaxf(a, b), lo_ = fminf(a, b); a = hi_; b = lo_; } while (0)
__device__ __forceinline__ void sort16(float (&k)[16]) {
#pragma unroll
    for (int sz = 2; sz <= 16; sz <<= 1)
#pragma unroll
        for (int j = sz >> 1; j > 0; j >>= 1)
#pragma unroll
            for (int i = 0; i < 16; ++i) { const int l = i ^ j; if (l > i) { if ((i & sz) == 0 || sz == 16) CASD(k[i], k[l]); else CASD(k[l], k[i]); } }
}
__device__ __forceinline__ void bmerge16(float (&k)[16]) {
#pragma unroll
    for (int j = 8; j > 0; j >>= 1)
#pragma unroll
        for (int i = 0; i < 16; ++i) { const int l = i ^ j; if (l > i) CASD(k[i], k[l]); }
}
__device__ __forceinline__ void merge_top16(float (&a)[16], const float (&b)[16]) {
#pragma unroll
    for (int i = 0; i < 16; ++i) a[i] = fmaxf(a[i], b[15 - i]);
    bmerge16(a);
}
__device__ __forceinline__ void xmerge_top16(float (&a)[16], int mask) {
    float t[16];
#pragma unroll
    for (int i = 0; i < 16; ++i) t[i] = __shfl_xor(a[15 - i], mask);
#pragma unroll
    for (int i = 0; i < 16; ++i) a[i] = fmaxf(a[i], t[i]);
    bmerge16(a);
}
__device__ __forceinline__ void phase_topk(const Args& A, int layer, int nrows, LAS unsigned char* lds) {
    const bf16_t* QP = (const bf16_t*)(A.ws + WS_BIG); int* IDX = (int*)(A.ws + WS_R2); float* GATE = (float*)(A.ws + WS_R2 + R2_GATE);
    const int tid = otid(), wid = tid >> 6, lane = tid & 63, fr = lane & 15, fq = lane >> 4;
    LAS unsigned* scr = (LAS unsigned*)(lds + 2 * 34816) + wid * 512 + fr * 32;
    for (int unit = blockIdx.x; unit < (nrows / 128) * 8; unit += gridDim.x) {
        const int h = unit & 7, r0 = (unit >> 3) * 128;
        __syncthreads();
        { const bf16_t* k1 = (const bf16_t*)(A.ws + WS_W + W_PEER + (size_t)layer * WP_SZ + WP_K1) + (size_t)h * 16384;
#pragma unroll
          for (int j = 0; j < 8; ++j) { const int idx = tid + 512 * j, half = idx >> 11, rem = idx & 2047, key = rem >> 4, c8 = rem & 15;
              const u32x4 w = *(const u32x4*)(k1 + (size_t)half * 8 * 16384 + key * 128 + 8 * c8);
              *(LAS u32x4*)(lds + half * 34816 + key * 272 + c8 * 16) = w; } }
        __syncthreads();
        const int tok = r0 + 16 * wid + fr;
        float top[2][16];
#pragma unroll
        for (int half = 0; half < 2; ++half) {
            bf16x8 qf[4];
#pragma unroll
            for (int ks = 0; ks < 4; ++ks) qf[ks] = *(const bf16x8*)(QP + (size_t)tok * 2048 + 256 * h + 128 * half + 32 * ks + 8 * fq);
            float loc[16];
#pragma unroll
            for (int grp = 0; grp < 2; ++grp) {
                float kk[16];
#pragma unroll
                for (int nbb = 0; nbb < 4; ++nbb) { const int nb = 4 * grp + nbb; f32x4 acc = {0.f, 0.f, 0.f, 0.f};
#pragma unroll
                    for (int ks = 0; ks < 4; ++ks) { const bf16x8 kf = *(const LAS bf16x8*)(lds + half * 34816 + (16 * nb + fr) * 272 + (32 * ks + 8 * fq) * 2);
                        acc = __builtin_amdgcn_mfma_f32_16x16x32_bf16(kf, qf[ks], acc, 0, 0, 0); }
#pragma unroll
                    for (int i = 0; i < 4; ++i) { const unsigned code = 127u - (unsigned)(16 * nb + 4 * fq + i); kk[4 * nbb + i] = __uint_as_float((__float_as_uint(acc[i]) & ~127u) | code); } }
                sort16(kk);
                if (grp == 0) {
#pragma unroll
                    for (int i = 0; i < 16; ++i) loc[i] = kk[i];
                } else merge_top16(loc, kk);
            }
            xmerge_top16(loc, 16); xmerge_top16(loc, 32);
#pragma unroll
            for (int i = 0; i < 16; ++i) top[half][i] = loc[i];
        }
        if (fq < 2) {
#pragma unroll
            for (int i = 0; i < 16; ++i) scr[16 * fq + i] = __float_as_uint(fq == 0 ? top[0][i] : top[1][i]); }
        float fin[16];
#pragma unroll
        for (int aa = 0; aa < 4; ++aa) {
            const float va_k = fq == 0 ? top[0][aa] : fq == 1 ? top[0][4 + aa] : fq == 2 ? top[0][8 + aa] : top[0][12 + aa];
            const float va = __uint_as_float(__float_as_uint(va_k) & ~127u);
            float c[16];
#pragma unroll
            for (int bb = 0; bb < 16; ++bb) { const float s = va + __uint_as_float(__float_as_uint(top[1][bb]) & ~127u);
                c[bb] = __uint_as_float((__float_as_uint(s) & ~255u) | (255u - (unsigned)((4 * fq + aa) * 16 + bb))); }
            if (aa == 0) {
#pragma unroll
                for (int i = 0; i < 16; ++i) fin[i] = c[i];
            } else merge_top16(fin, c);
        }
        xmerge_top16(fin, 16); xmerge_top16(fin, 32);
        float ev[16], es = 0.f; const float mx = __uint_as_float(__float_as_uint(fin[0]) & ~255u);
#pragma unroll
        for (int i = 0; i < 16; ++i) { ev[i] = __expf(__uint_as_float(__float_as_uint(fin[i]) & ~255u) - mx); es += ev[i]; }
        const float inv = 1.f / es;
        asm volatile("s_waitcnt lgkmcnt(0)" ::: "memory");
        int oi[4]; float og[4];
#pragma unroll
        for (int kq = 0; kq < 4; ++kq) {
            const float fk = fq == 0 ? fin[kq] : fq == 1 ? fin[4 + kq] : fq == 2 ? fin[8 + kq] : fin[12 + kq];
            const float fe = fq == 0 ? ev[kq] : fq == 1 ? ev[4 + kq] : fq == 2 ? ev[8 + kq] : ev[12 + kq];
            const unsigned code = 255u - (__float_as_uint(fk) & 255u), a = code >> 4, bq = code & 15u;
            const unsigned i1 = 127u - (scr[a] & 127u), i2 = 127u - (scr[16 + bq] & 127u);
            oi[kq] = (int)(i1 * 128u + i2); og[kq] = fe * inv; }
        *(int4*)(IDX + (size_t)tok * 128 + 16 * h + 4 * fq) = make_int4(oi[0], oi[1], oi[2], oi[3]);
        *(f32x4*)(GATE + (size_t)tok * 128 + 16 * h + 4 * fq) = (f32x4){og[0], og[1], og[2], og[3]};
    }
}
struct PeerSched {
    int x0, rank, nloc, nblk, nown; unsigned orphan;
    __device__ __forceinline__ void init(const Args& A, int nrows, LAS unsigned char* smem) {
        unsigned* ctl = (unsigned*)(A.ws + WS_CTL);
        x0 = (int)(xb_xcc_id() & 7u); rank = __builtin_amdgcn_readfirstlane((int)((LAS unsigned*)smem)[8]); nblk = nrows / 64; orphan = 0u; nloc = 1;
        for (int j = 0; j < 8; ++j) { unsigned c = xb_ld(&ctl[XB_XCNT(j)]) + xb_ld(&ctl[XB_XCNT(j + 8)]); c = __builtin_amdgcn_readfirstlane(c); if (c == 0u) orphan |= 1u << j; if (j == x0) nloc = (int)c; }
        const int tot = (NSL / 8) * nblk; nown = rank < tot ? (tot - rank + nloc - 1) / nloc : 0;
    }
    __device__ __forceinline__ bool item(int j, int& sl, int& blk) const {
        if (j < nown) { const int i = rank + j * nloc; sl = x0 + 8 * (i / nblk); blk = i % nblk; return true; }
        int jj = j - nown; const int tot = (NSL / 8) * nblk, per = ((int)gridDim.x > tot) ? 1 : 0; (void)per;
        for (int o = 0; o < 8; ++o) if ((orphan >> o) & 1u) { const int cnt = ((int)blockIdx.x < tot) ? (tot - (int)blockIdx.x + (int)gridDim.x - 1) / (int)gridDim.x : 0;
            if (jj < cnt) { const int i = (int)blockIdx.x + jj * (int)gridDim.x; sl = o + 8 * (i / nblk); blk = i % nblk; return true; } jj -= cnt; }
        return false;
    }
};
template <class LD, class ST, class PR>
__device__ __forceinline__ void peer_items(const PeerSched& S, LD ld, ST st, PR pr) {
    int sl, blk, sln, blkn, j = 0, buf = 0; bool have = S.item(0, sl, blk);
    if (have) { ld(sl, blk, 0); st(0); }
    while (have) {
        const bool haven = S.item(j + 1, sln, blkn);
        asm volatile("s_waitcnt vmcnt(0)" ::: "memory");
        __syncthreads();
        if (haven) ld(sln, blkn, buf ^ 1);
        pr(sl, blk, buf);
        if (haven) st(buf ^ 1);
        sl = sln; blk = blkn; have = haven; buf ^= 1; ++j;
    }
    __syncthreads();
}
#ifndef MK_UVAR
#define MK_UVAR 0
#endif
__device__ __forceinline__ void phase_peer_u(const Args& A, int layer, int nrows, LAS unsigned char* smem, int rep) {
    const int var = rep ? MK_UVAR : 0;
    const bf16_t* H = (const bf16_t*)(A.ws + WS_H); const int* IDX = (const int*)(A.ws + WS_R2); float* PART = var ? (float*)(A.ws + WS_R1) : (float*)(A.ws + WS_BIG + BIG_PART);
    const unsigned char* U = A.ws + WS_TAB;
    LAS unsigned char* lds = smem + LDS_BASE;
    constexpr int BUF = 32768 + 64 * SW;
    const int tid = otid(), wid = tid >> 6, lane = tid & 63, fr = lane & 15, fq = lane >> 4;
    PeerSched S; S.init(A, nrows, smem);
    u32x4 ri[4], rh[2];
    peer_items(S,
        [&](int sl, int blk, int) {
#pragma unroll
            for (int i = 0; i < 4; ++i) ri[i] = *(const u32x4*)(IDX + (size_t)blk * 64 * 128 + 4 * (tid + 512 * i));
            const bf16_t* hp = H + (size_t)(blk * 64 + (tid >> 3)) * 1024 + SW * sl + 16 * (tid & 7);
            rh[0] = *(const u32x4*)hp; rh[1] = *(const u32x4*)(hp + 8); },
        [&](int buf) {
#pragma unroll
            for (int i = 0; i < 4; ++i) *(LAS u32x4*)(lds + buf * BUF + 16 * (tid + 512 * i)) = ri[i];
            u32x4 w;
#pragma unroll
            for (int i = 0; i < 2; ++i) { w[2 * i] = pk4_fp8(bflo(rh[i].x) * HS, bfhi(rh[i].x) * HS, bflo(rh[i].y) * HS, bfhi(rh[i].y) * HS);
                                          w[2 * i + 1] = pk4_fp8(bflo(rh[i].z) * HS, bfhi(rh[i].z) * HS, bflo(rh[i].w) * HS, bfhi(rh[i].w) * HS); }
            *(LAS u32x4*)(lds + buf * BUF + 32768 + 16 * tid) = w; },
        [&](int sl, int blk, int buf) {
            const unsigned char* ub = U + (size_t)sl * NEXP * SW + 32 * fq;
            const LAS int* ib = (const LAS int*)(lds + buf * BUF) + (wid * 8) * 128 + fr; const LAS unsigned char* hb = lds + buf * BUF + 32768 + (wid * 8) * SW + 32 * fq;
            u32x4 uf[2][8][2];
#define PU_ROWS(T, t) do { _Pragma("unroll") for (int g = 0; g < 8; ++g) { int e_ = ib[(t) * 128 + 16 * g]; if (var == 3) e_ &= 63; \
                _Pragma("unroll") for (int hh = 0; hh < 2; ++hh) { if (var == 4) uf[T][g][hh] = (u32x4){(unsigned)e_, (unsigned)e_, 0u, 0u}; else uf[T][g][hh] = *(const u32x4*)(ub + (size_t)e_ * SW + 16 * hh); } } } while (0)
            PU_ROWS(0, 0);
#define PU_TOKEN(T, t) do { \
                const u32x4 h0 = *(const LAS u32x4*)(hb + (t) * SW), h1 = *(const LAS u32x4*)(hb + (t) * SW + 16); \
                const long ha0 = (long)(((unsigned long long)h0.y << 32) | h0.x), ha1 = (long)(((unsigned long long)h0.w << 32) | h0.z), ha2 = (long)(((unsigned long long)h1.y << 32) | h1.x), ha3 = (long)(((unsigned long long)h1.w << 32) | h1.z); \
                float v0 = 0.f, v1 = 0.f; \
                _Pragma("unroll") for (int g = 0; g < 8; ++g) { f32x4 acc = {0.f, 0.f, 0.f, 0.f}; const u32x4 ua = uf[T][g][0], ub2 = uf[T][g][1]; \
                    acc = __builtin_amdgcn_mfma_f32_16x16x32_fp8_fp8(ha0, (long)(((unsigned long long)ua.y << 32) | ua.x), acc, 0, 0, 0); \
                    acc = __builtin_amdgcn_mfma_f32_16x16x32_fp8_fp8(ha1, (long)(((unsigned long long)ua.w << 32) | ua.z), acc, 0, 0, 0); \
                    acc = __builtin_amdgcn_mfma_f32_16x16x32_fp8_fp8(ha2, (long)(((unsigned long long)ub2.y << 32) | ub2.x), acc, 0, 0, 0); \
                    acc = __builtin_amdgcn_mfma_f32_16x16x32_fp8_fp8(ha3, (long)(((unsigned long long)ub2.w << 32) | ub2.z), acc, 0, 0, 0); \
                    if (g < 4) v0 = fq == g ? acc[0] : v0; else v1 = fq == g - 4 ? acc[0] : v1; }        \
                float* pp = PART + ((size_t)sl * NROW + blk * 64 + wid * 8 + (t)) * 128 + 16 * fq + fr; \
                pp[0] = v0; pp[64] = v1; } while (0)
#pragma unroll 1
            for (int tp = 0; tp < 4; ++tp) {
                PU_ROWS(1, 2 * tp + 1);
                __builtin_amdgcn_sched_barrier(0);
                PU_TOKEN(0, 2 * tp);
                __builtin_amdgcn_sched_barrier(0);
                if (tp + 1 < 4) PU_ROWS(0, 2 * tp + 2);
                __builtin_amdgcn_sched_barrier(0);
                PU_TOKEN(1, 2 * tp + 1);
                __builtin_amdgcn_sched_barrier(0);
            }
#undef PU_TOKEN
#undef PU_ROWS
        });
}
__device__ __forceinline__ void phase_coef(const Args& A, int nrows) {
    const float* PART = (const float*)(A.ws + WS_BIG + BIG_PART); const float* GATE = (const float*)(A.ws + WS_R2 + R2_GATE); float* COEF = (float*)(A.ws + WS_R2 + R2_COEF);
    const int* IDX = (const int*)(A.ws + WS_R2); const float* SCL = (const float*)(A.ws + WS_TAB + TAB_SCL);
    const int gthr = blockIdx.x * NTHR + otid(), nthr = gridDim.x * NTHR;
    for (int p = gthr; p < nrows * 128; p += nthr) { float s = 0.f;
#pragma unroll
        for (int x = 0; x < NSL; ++x) s += PART[(size_t)x * NROW * 128 + p];
        const int e = IDX[p];
        COEF[p] = GATE[p] * gelu_f(s * (1.f / HS) * SCL[e]) * SCL[NEXP + e]; }
}
__device__ __forceinline__ void phase_peer_v(const Args& A, int layer, int nrows, LAS unsigned char* smem, int rep) {
    const int* IDX = (const int*)(A.ws + WS_R2); const float* COEF = (const float*)(A.ws + WS_R2 + R2_COEF);
    const unsigned char* V = A.ws + WS_TAB + TAB8_HALF; const float* MODL = (const float*)(A.ws + WS_MOD) + (size_t)layer * 5 * 6144 + 5 * 1024;
    float* XC = (float*)(A.ws + WS_XC);
    LAS unsigned char* lds = smem + LDS_BASE;
    constexpr int BUF = 65536;
    constexpr int LPR = SW / 16, NQ = 64 / LPR, EPQ = 128 / NQ, NI = EPQ / 4;
    const int tid = otid(), wid = tid >> 6, lane = tid & 63, m = lane % LPR, q = lane / LPR;
    PeerSched S; S.init(A, nrows, smem);
    const int wu = __builtin_amdgcn_readfirstlane(wid);
    peer_items(S,
        [&](int sl, int blk, int buf) {
#pragma unroll
            for (int i = 0; i < 4; ++i) {
                __builtin_amdgcn_global_load_lds((const unsigned*)(IDX + (size_t)blk * 64 * 128 + 256 * (wu + 8 * i) + 4 * lane), (LAS unsigned*)(lds + buf * BUF + 1024 * (wu + 8 * i)), 16, 0, 0);
                __builtin_amdgcn_global_load_lds((const unsigned*)(COEF + (size_t)blk * 64 * 128 + 256 * (wu + 8 * i) + 4 * lane), (LAS unsigned*)(lds + buf * BUF + 32768 + 1024 * (wu + 8 * i)), 16, 0, 0); } },
        [&](int buf) { },
        [&](int sl, int blk, int buf) {
            const unsigned char* vb = V + (size_t)sl * NEXP * SW + 16 * m;
            const LAS int* ib = (const LAS int*)(lds + buf * BUF) + (wid * 8) * 128 + EPQ * q; const LAS float* cb = (const LAS float*)(lds + buf * BUF + 32768) + (wid * 8) * 128 + EPQ * q;
            u32x4 vv[2][NI / 2][4];
#define PV_ROWS(T, c) do { _Pragma("unroll") for (int i = 0; i < NI / 2; ++i) { const i32x4 e_ = *(const LAS i32x4*)(ib + ((c) >> 1) * 128 + ((c) & 1) * (EPQ / 2) + 4 * i); \
                vv[T][i][0] = *(const u32x4*)(vb + (size_t)e_.x * SW); vv[T][i][1] = *(const u32x4*)(vb + (size_t)e_.y * SW); \
                vv[T][i][2] = *(const u32x4*)(vb + (size_t)e_.z * SW); vv[T][i][3] = *(const u32x4*)(vb + (size_t)e_.w * SW); } } while (0)
            PV_ROWS(0, 0);
#pragma unroll 1
            for (int t = 0; t < 8; ++t) {
                const int tok = blk * 64 + wid * 8 + t; const bool lat = tok < NLAT;
                float* xp = (lat ? A.out + (size_t)tok * D : XC + (size_t)(tok - NLAT) * D) + SW * sl + 16 * m;
                float acc[16]; f32x4 xr[4];
#pragma unroll
                for (int j = 0; j < 16; ++j) acc[j] = 0.f;
                if (q == 0) {
#pragma unroll
                    for (int j = 0; j < 4; ++j) xr[j] = *(f32x4*)(xp + 4 * j); }
#define PV_FMA(T, half) do { _Pragma("unroll") for (int i = 0; i < NI / 2; ++i) { const f32x4 c4 = *(const LAS f32x4*)(cb + t * 128 + (half) * (EPQ / 2) + 4 * i); \
                    _Pragma("unroll") for (int k = 0; k < 4; ++k) { const float cf = c4[k]; \
                        _Pragma("unroll") for (int j = 0; j < 4; ++j) { const int w = (int)vv[T][i][k][j]; \
                            const f32x2 lo = __builtin_amdgcn_cvt_pk_f32_fp8(w, false), hi = __builtin_amdgcn_cvt_pk_f32_fp8(w, true); \
                            acc[4 * j] += cf * lo.x; acc[4 * j + 1] += cf * lo.y; acc[4 * j + 2] += cf * hi.x; acc[4 * j + 3] += cf * hi.y; } } } } while (0)
                PV_ROWS(1, 2 * t + 1);
                __builtin_amdgcn_sched_barrier(0);
                PV_FMA(0, 0);
                __builtin_amdgcn_sched_barrier(0);
                if (t + 1 < 8) PV_ROWS(0, 2 * t + 2);
                __builtin_amdgcn_sched_barrier(0);
                PV_FMA(1, 1);
#pragma unroll
                for (int j = 0; j < 16; ++j) {
#pragma unroll
                    for (int o = LPR; o < 64; o <<= 1) acc[j] += __shfl_xor(acc[j], o); }
                if (q == 0) {
                    const float* gp = MODL + (size_t)(lat ? (tok >> 13) : 4) * 6144 + SW * sl + 16 * m;
#pragma unroll
                    for (int j = 0; j < 4; ++j) { const f32x4 g = *(const f32x4*)(gp + 4 * j);
                        *(f32x4*)(xp + 4 * j) = xr[j] + g * (f32x4){acc[4 * j], acc[4 * j + 1], acc[4 * j + 2], acc[4 * j + 3]}; }
                }
                __builtin_amdgcn_sched_barrier(0);
            }
#undef PV_FMA
#undef PV_ROWS
        });
}

#ifndef MK_PER_PHASE
#define MK_PER_PHASE 0
#endif
__device__ __forceinline__ int nr_in(int L) { return L <= 2 ? NROW : NLAT; }
__device__ __forceinline__ int nr_out(int L) { return L <= 1 ? NROW : NLAT; }

__global__ void __launch_bounds__(NTHR, 2) fwd(Args A) {
    extern __shared__ __attribute__((aligned(256))) unsigned char smem_raw[];
    LAS unsigned char* smem = (LAS unsigned char*)smem_raw;
    LAS unsigned char* lds = smem + LDS_BASE;
    const int tid = otid();
    if (tid < 64) ((LAS unsigned*)smem)[tid] = 0u;
    __syncthreads();
    XcdBarrier bar = xcd_barrier_post((unsigned*)(A.ws + WS_CTL), (volatile LAS unsigned*)smem);
    if (tid == 0) ((LAS unsigned*)smem)[8] = atomicAdd((unsigned*)(A.ws + WS_CTL) + CW_RANK + 32 * (xb_xcc_id() & 7u), 1u);
    __syncthreads();
    bool need_bar = false;
    const int lo = A.ph_lo, hi = A.ph_hi;
#ifndef PHMASK
#define PHMASK 0xffffffffu
#endif
#define SITE(k) if constexpr (((PHMASK) >> (k)) & 1u)
#ifndef MK_REPEAT_SITE
#define MK_REPEAT_SITE -1
#endif
#define REP(k) for (int rep = 0; rep < ((k) == (MK_REPEAT_SITE) ? 2 : 1); ++rep)
#define PH(id) if ([&]() -> bool { if ((id) < lo || (id) >= hi) return false; if (need_bar) xcd_barrier(bar); need_bar = true; return true; }())
    unsigned char* ws = A.ws;
    float* XL = A.out; float* XC = (float*)(ws + WS_XC);
    bf16_t* H = (bf16_t*)(ws + WS_H);
    const float* MOD = (const float*)(ws + WS_MOD);

    SITE(0) PH(0) { phase_prologue(A, lds); }
    SITE(1) PH(1) { phase_norm_mod(A.in[I_X], A.in[I_CTX], XL, XC, A.in[I_N1G], MOD, 0, H, NROW); }
    for (int L = 0; L < DEPTH; ++L) {
        const int base = 2 + 16 * L, li = L >> 1; const bool hyb = (L & 1) == 0;
        const float* MODL = MOD + (size_t)L * 5 * 6144;
        unsigned char* WH = ws + WS_W + W_HYB + (size_t)li * WH_SZ; unsigned char* WG = ws + WS_W + W_GM + (size_t)li * WG_SZ; unsigned char* WP = ws + WS_W + W_PEER + (size_t)L * WP_SZ;
        if (hyb) {
            SITE(2) PH(base + 0) REP(2) { pg8::Gemm g{H, (const bf16_t*)(WH + WH_IN), nr_in(L), HYB_INP, 1024, 1024, 1024};
                pg8::EpiBf16<0> e{(bf16_t*)(ws + WS_BIG), HYB_INP}; pg8::gemm_phase(lds, g, e); }
            SITE(3) PH(base + 1) REP(3) { phase_conv(A, li); }
            SITE(4) PH(base + 2) {
                SITE(18) REP(18) { pg8::Gemm g{(const bf16_t*)(ws + WS_BIG) + C_CQ, (const bf16_t*)(WH + WH_QB), L == 0 ? NROW : NLAT, 1536, 384, HYB_INP, 384};
                  EpiQ e{(bf16_t*)(ws + WS_R1 + R1_Q), (const float*)(ws + WS_RSTD), (const float*)(ws + WS_ROPE)}; pg8::gemm_phase(lds, g, e); }
                SITE(19) REP(19) { pg8::Gemm g{(const bf16_t*)(ws + WS_BIG) + C_CKV, (const bf16_t*)(WH + WH_KVB), NROW, 2048, 256, HYB_INP, 256};
                  EpiKV e{ws + WS_R1 + R1_KN, ws + WS_R1 + R1_V, (const float*)(ws + WS_RSTD) + NROW}; pg8::gemm_phase(lds, g, e); }
                SITE(20) REP(20) for (int u = blockIdx.x; u < 528; u += gridDim.x) ssd::g_unit((const bf16_t*)(ws + WS_R2 + R2_BC), (bf16_t*)(ws + WS_BIG + BIG_G), u);
            }
            SITE(5) PH(base + 3) {
                SITE(21) REP(21) for (int u = blockIdx.x; u < 256; u += gridDim.x)
                    ssd::ssd_unit(u, (const bf16_t*)(ws + WS_R2), (const bf16_t*)(ws + WS_R2 + R2_BC), (const float*)(ws + WS_BIG + BIG_DT), (const bf16_t*)(ws + WS_BIG + BIG_G),
                                  A.in[I_ALOG] + li * 32, (bf16_t*)(ws + WS_H), (bf16_t*)(ws + WS_R3), lds);
                const int nau = L == 0 ? 1024 + 32 : 1024;
                SITE(22) REP(22) for (int au = blockIdx.x; au < nau; au += gridDim.x) {
                    int b, h, qrow0, orow0, nt;
                    if (au < 1024) { b = au >> 8; h = au & 7; const int qb = (au >> 3) & 31; qrow0 = 256 + 256 * qb; orow0 = b * 8192 + 256 * qb; nt = NKT; }
                    else { const int cu = au - 1024; b = cu >> 3; h = cu & 7; qrow0 = 0; orow0 = NLAT + 256 * b; nt = 4; }
                    const size_t bh = (size_t)(b * 8 + h);
                    att::attn_unit((const bf16_t*)(ws + WS_R1 + R1_Q) + (bh * NKEY + qrow0) * 192, ws + WS_R1 + R1_KN + bh * NKT * 16384, ws + WS_BIG + BIG_KR + (size_t)b * NKT * 8192,
                                   ws + WS_R1 + R1_V + bh * NKT * 16384, (bf16_t*)(ws + WS_R3 + R3_CAT) + (size_t)orow0 * 2048 + 1024 + 128 * h, nt, lds);
                }
            }
            SITE(6) PH(base + 4) REP(6) { phase_ssd_out(A, li, nr_out(L)); }
        } else {
            SITE(7) PH(base + 0) REP(7) { pg8::Gemm g{H, (const bf16_t*)(WG + WG_IN), nr_out(L), 4096, 1024, 1024, 1024};
                pg8::EpiBf16<1> e{(bf16_t*)(ws + WS_BIG), 4096}; pg8::gemm_phase(lds, g, e); }
            SITE(8) PH(base + 1) REP(8) { phase_ln_stats(A, nr_out(L)); }
            SITE(9) PH(base + 2) REP(9) { phase_spatial(A, li, nr_out(L), lds); }
        }
        SITE(10) PH(base + 5) { pg8::Gemm g{hyb ? (const bf16_t*)(ws + WS_R3 + R3_CAT) : (const bf16_t*)(ws + WS_R1), hyb ? (const bf16_t*)(WH + WH_OUT) : (const bf16_t*)(WG + WG_OUT), nr_out(L), 1024, 2048, 2048, 2048};
            pg8::EpiResid e{XL, XC, MODL + 2 * 1024}; pg8::gemm_phase(lds, g, e); }
        SITE(11) PH(base + 6) REP(11) { phase_norm_mod(XL, XC, nullptr, nullptr, A.in[I_N2G] + L * 1024, MODL, 3, H, nr_out(L)); phase_tabcvt(A, L); }
        SITE(12) PH(base + 7) REP(12) { pg8::Gemm g{H, (const bf16_t*)(WP + WP_Q), nr_out(L), 2048, 1024, 1024, 1024};
            pg8::EpiBf16<0> e{(bf16_t*)(ws + WS_BIG), 2048}; pg8::gemm_phase(lds, g, e); }
        SITE(13) PH(base + 8) REP(13) { phase_topk(A, L, nr_out(L), lds); }
        SITE(14) PH(base + 9) REP(14) { phase_peer_u(A, L, nr_out(L), smem, rep); }
        SITE(15) PH(base + 10) REP(15) { phase_coef(A, nr_out(L)); }
        SITE(16) PH(base + 11) { phase_peer_v(A, L, nr_out(L), smem, 0); }
        SITE(17) PH(base + 12) { if (L < DEPTH - 1) phase_norm_mod(XL, XC, nullptr, nullptr, A.in[I_N1G] + (L + 1) * 1024, MOD + (size_t)(L + 1) * 5 * 6144, 0, H, nr_in(L + 1));
                        else phase_final_norm(XL, A.in[I_FNG]); }
    }
#undef PH
}

#ifdef MK_TAP
__global__ void tap_kernel(const unsigned short* buf, size_t pitch, size_t col0, size_t ncols, size_t nrows, float* out) {
    const size_t n = ncols * nrows;
    for (size_t i = (size_t)blockIdx.x * blockDim.x + threadIdx.x; i < (size_t)NLAT * D; i += (size_t)gridDim.x * blockDim.x) {
        float s = 0.f; for (size_t j = i; j < n; j += (size_t)NLAT * D) s += (float)buf[(j / ncols) * pitch + col0 + (j % ncols)]; out[i] = s; }
}
#endif
extern "C" void kernel_launch(void* const* d_in, const int* in_sizes, int n_in, void* d_out, int out_size, void* d_ws, size_t ws_size, hipStream_t stream) {
    static int grid = 0;
    if (grid == 0) {
        if (n_in != N_IN || out_size != NLAT * D || ws_size < WS_END) { fprintf(stderr, "kernel_launch: unexpected shapes (n_in %d out %d ws %zu, need %zu)\n", n_in, out_size, ws_size, (size_t)WS_END); grid = -1; return; }
        int dev = 0, cus = 0, per_cu = 0;
        if (hipGetDevice(&dev) != hipSuccess || hipDeviceGetAttribute(&cus, hipDeviceAttributeMultiprocessorCount, dev) != hipSuccess) { grid = -1; return; }
        if (hipFuncSetAttribute((const void*)fwd, hipFuncAttributeMaxDynamicSharedMemorySize, LDS_BYTES) != hipSuccess) { fprintf(stderr, "kernel_launch: hipFuncSetAttribute failed\n"); grid = -1; return; }
        if (hipOccupancyMaxActiveBlocksPerMultiprocessor(&per_cu, (const void*)fwd, NTHR, LDS_BYTES) != hipSuccess || per_cu < 1) { fprintf(stderr, "kernel_launch: occupancy query says %d\n", per_cu); }
        (void)hipGetLastError();
        grid = cus;
    }
    if (grid < 0) return;
    (void)hipMemsetAsync((char*)d_ws + WS_CTL, 0, CTL_BYTES, stream);
    Args a{};
    for (int i = 0; i < N_IN; ++i) a.in[i] = (const float*)d_in[i];
    a.out = (float*)d_out; a.ws = (unsigned char*)d_ws;
#if MK_PER_PHASE
    for (int id = 0; id < 2 + 16 * DEPTH; ++id) {
        if (id >= 2) { const int L = (id - 2) / 16, s = (id - 2) % 16; if (s > 12) continue; if ((L & 1) && (s == 3 || s == 4)) continue; }
#ifdef MK_CUT
#ifdef MK_TAP
        if (id >= MK_CUT) continue;
#else
        if (id >= MK_CUT && id != 2 + 16 * (DEPTH - 1) + 12) continue;
#endif
#endif
        a.ph_lo = id; a.ph_hi = id + 1;
        hipLaunchKernelGGL(fwd, dim3(grid), dim3(NTHR), LDS_BYTES, stream, a);
    }
#ifdef MK_TAP
    { const size_t tp[5] = {MK_TAP}; hipLaunchKernelGGL(tap_kernel, dim3(2048), dim3(256), 0, stream, (const unsigned short*)((const char*)d_ws + tp[0]), tp[1], tp[2], tp[3], tp[4], (float*)d_out); }
#endif
#else
    a.ph_lo = 0; a.ph_hi = 2 + 16 * DEPTH;
    hipLaunchKernelGGL(fwd, dim3(grid), dim3(NTHR), LDS_BYTES, stream, a);
#endif
    const hipError_t le = hipPeekAtLastError();
    if (le != hipSuccess) fprintf(stderr, "kernel_launch: launch failed: %s\n", hipGetErrorName(le));
}
```

```cpp
#include <hip/hip_runtime.h>
#include <cstdio>
#include <cstdint>

#define LAS __attribute__((address_space(3)))
typedef unsigned short bf16_t;
typedef short bf16x8 __attribute__((ext_vector_type(8)));
typedef short s16x4 __attribute__((ext_vector_type(4)));
typedef float f32x2 __attribute__((ext_vector_type(2)));
typedef float f32x4 __attribute__((ext_vector_type(4)));
typedef float f32x16 __attribute__((ext_vector_type(16)));
typedef unsigned u32x2 __attribute__((ext_vector_type(2)));
typedef unsigned u32x4 __attribute__((ext_vector_type(4)));
typedef int i32x4 __attribute__((ext_vector_type(4)));

constexpr int D = 1024, NB = 4, SEQ = 8192, DEPTH = 4, CTXL = 256;
constexpr int NLAT = NB * SEQ, NCTX = NB * CTXL, NROW = NLAT + NCTX;
constexpr int HYB_IN = 3280, HYB_INP = 3328;
constexpr int C_Z = 0, C_XBC = 1024, C_DT = 2560, C_CQ = 2576, C_CKV = 2960, C_KR = 3216;
constexpr int NKEY = SEQ + CTXL, NKT = NKEY / 64;
constexpr float EPS = 1e-6f;
constexpr float QSCALE = 0.07216878364870322f * 1.4426950408889634f;
constexpr int NEXP = 16384;

enum { I_X = 0, I_C, I_CTX, I_CCTX, I_ADAW, I_ADAB, I_N1G, I_N2G, I_HWIN, I_CONVW, I_CONVB, I_ALOG, I_DTB, I_SSDD, I_SSDNG, I_QNG, I_WQB, I_KVNG, I_WKVB,
       I_HWOUT, I_GWIN, I_GLNG, I_GLNB, I_GWS, I_GBS, I_GWOUT, I_PWQ, I_PK1, I_PK2, I_PU, I_PV, I_FNG, N_IN };

constexpr size_t al256(size_t x) { return (x + 255) & ~(size_t)255; }
constexpr size_t WS_CTL = 0, CTL_BYTES = 65536;
constexpr size_t WS_MOD = WS_CTL + CTL_BYTES;
constexpr size_t WS_ROPE = WS_MOD + al256((size_t)DEPTH * 5 * 6144 * 4);
constexpr size_t WS_RSTD = WS_ROPE + (size_t)2 * SEQ * 32 * 4;
constexpr size_t WS_W = WS_RSTD + al256((size_t)2 * NROW * 4);
constexpr size_t W_HYB = 0;
constexpr size_t WH_IN = 0, WH_QB = WH_IN + (size_t)HYB_INP * 1024 * 2, WH_KVB = WH_QB + (size_t)1536 * 384 * 2, WH_OUT = WH_KVB + (size_t)2048 * 256 * 2,
                 WH_SZ = WH_OUT + (size_t)1024 * 2048 * 2;
constexpr size_t W_GM = W_HYB + 2 * WH_SZ;
constexpr size_t WG_IN = 0, WG_OUT = WG_IN + (size_t)4096 * 1024 * 2, WG_WS = WG_OUT + (size_t)1024 * 2048 * 2, WG_SZ = WG_WS + (size_t)8 * 128 * 128 * 2;
constexpr size_t W_PEER = W_GM + 2 * WG_SZ;
constexpr size_t WP_Q = 0, WP_K1 = WP_Q + (size_t)2048 * 1024 * 2, WP_K2 = WP_K1 + (size_t)8 * 128 * 128 * 2, WP_SZ = WP_K2 + (size_t)8 * 128 * 128 * 2;
constexpr size_t W_TOTAL = W_PEER + 4 * WP_SZ;
constexpr size_t WS_TAB = WS_W + al256(W_TOTAL);
constexpr size_t TAB_HALF = (size_t)NEXP * 1024 * 2;
constexpr size_t WS_XC = WS_TAB + 2 * TAB_HALF;
constexpr size_t WS_H = WS_XC + (size_t)NCTX * D * 4;
constexpr size_t WS_BIG = WS_H + (size_t)NROW * D * 2;
constexpr size_t BIG_BYTES = (size_t)NROW * 4096 * 2;
constexpr size_t BIG_DT = (size_t)NROW * HYB_INP * 2;
constexpr size_t BIG_G = BIG_DT + (size_t)NROW * 32 * 4;
constexpr size_t BIG_KR = BIG_G + (size_t)528 * 128 * 128 * 2;
constexpr size_t BIG_PART = (size_t)NROW * 2048 * 2;
static_assert(BIG_KR + (size_t)NB * NKT * 8192 <= BIG_BYTES, "BIG tail");
constexpr size_t WS_R1 = WS_BIG + BIG_BYTES;
constexpr size_t R1_Q = 0, R1_KN = R1_Q + (size_t)NB * 8 * NKEY * 192 * 2, R1_V = R1_KN + (size_t)NB * 8 * NKT * 16384, R1_BYTES = R1_V + (size_t)NB * 8 * NKT * 16384;
constexpr size_t WS_R2 = WS_R1 + R1_BYTES;
constexpr size_t R2_BC = (size_t)NROW * 1024 * 2, R2_BYTES = R2_BC + (size_t)NROW * 512 * 2;
constexpr size_t R2_GATE = (size_t)NROW * 128 * 4, R2_COEF = 2 * R2_GATE;
constexpr size_t WS_R3 = WS_R2 + R2_BYTES;
constexpr size_t R3_CAT = (size_t)NROW * 1024 * 2, R3_BYTES = R3_CAT + (size_t)NROW * 2048 * 2;
constexpr size_t WS_END = WS_R3 + R3_BYTES;
static_assert(WS_END <= ((size_t)1 << 30), "workspace must fit 1 GiB");

constexpr int CW_RANK = 3584;
constexpr int CW_QUEUE = 4096;

typedef __bf16 bf16x2_t __attribute__((ext_vector_type(2)));
__device__ __forceinline__ unsigned cvt_pk_bf16(float lo, float hi) { const f32x2 v = {lo, hi}; const bf16x2_t b = __builtin_convertvector(v, bf16x2_t); return __builtin_bit_cast(unsigned, b); }
__device__ __forceinline__ bf16_t f2bf(float f) { return (bf16_t)(cvt_pk_bf16(f, 0.f) & 0xffffu); }
__device__ __forceinline__ float bf2f(unsigned b) { return __uint_as_float(b << 16); }
__device__ __forceinline__ float bflo(unsigned w) { return __uint_as_float(w << 16); }
__device__ __forceinline__ float bfhi(unsigned w) { return __uint_as_float(w & 0xffff0000u); }
__device__ __forceinline__ float wave_sum(float v) {
#pragma unroll
    for (int o = 32; o >= 1; o >>= 1) v += __shfl_xor(v, o);
    return v;
}
__device__ __forceinline__ int otid() { int t = threadIdx.x; asm volatile("" : "+v"(t)); return t; }
__device__ __forceinline__ float silu_f(float x) { return x / (1.f + __expf(-x)); }
__device__ __forceinline__ float softplus_f(float x) { return x > 20.f ? x : log1pf(__expf(x)); }
__device__ __forceinline__ f32x2 gelu_pk(f32x2 v) {
    const f32x2 av = __builtin_elementwise_abs(v), d = av * 0.2316418882f + 1.0f;
    f32x2 t; t.x = __builtin_amdgcn_rcpf(d.x); t.y = __builtin_amdgcn_rcpf(d.y);
    f32x2 q = t * 0.5307027145f + (-0.7265760135f); q = q * t + 0.7107068705f; q = q * t + (-0.142248368f); q = q * t + 0.127414796f; q = q * t;
    const f32x2 s = (v * v) * (-0.72134752044f);
    f32x2 e; e.x = __builtin_amdgcn_exp2f(s.x); e.y = __builtin_amdgcn_exp2f(s.y);
    const f32x2 m = v * (q * e), r = v - m;
    f32x2 o; o.x = v.x < 0.f ? m.x : r.x; o.y = v.y < 0.f ? m.y : r.y; return o;
}
__device__ __forceinline__ float gelu_f(float x) { f32x2 v = {x, 0.f}; return gelu_pk(v).x; }

__device__ __forceinline__ int row_mb(int r) { return r < NLAT ? (r >> 13) : 4; }

#define XB_TMO      128
#define XB_XCNT(j)  (256  + 64 * (j))
#define XB_XSUB(j)  (1280 + 64 * (j))
#define XB_XGEN(j)  (2304 + 64 * (j))
#define XB_TOP      3328
#define XB_TOPGEN   3392
#define XCD_BAR_WORDS 3456
#define XB_SPIN_CAP (1u << 22)
__device__ __forceinline__ unsigned xb_ld(unsigned* p)              { return __hip_atomic_load(p, __ATOMIC_RELAXED, __HIP_MEMORY_SCOPE_AGENT); }
__device__ __forceinline__ unsigned xb_add(unsigned* p, unsigned v) { return __hip_atomic_fetch_add(p, v, __ATOMIC_RELAXED, __HIP_MEMORY_SCOPE_AGENT); }
__device__ __forceinline__ unsigned xb_xcc_id() { return (unsigned)__builtin_amdgcn_s_getreg((3 << 11) | 20) & 0xFu; }
#define XB_SPIN(cond, bar) do { unsigned _sp = 0; while (cond) { __builtin_amdgcn_s_sleep(1); \
    if ((++_sp & 255u) == 0u) { if (xb_ld(&(bar)[XB_TMO])) break; if (_sp > XB_SPIN_CAP) { atomicAdd(&(bar)[XB_TMO], 1u); break; } } } } while (0)
struct XcdBarrier { unsigned* bar; unsigned x; volatile LAS unsigned* st; };
__device__ __forceinline__ XcdBarrier xcd_barrier_post(unsigned* bar, volatile LAS unsigned* st) {
    XcdBarrier b; b.bar = bar; b.x = xb_xcc_id(); b.st = st;
    if (threadIdx.x == 0) (void)xb_add(&bar[XB_XCNT(b.x)], 1u);
    return b;
}
__device__ __forceinline__ void xcd_barrier_complete(unsigned* bar, unsigned x, unsigned& nloc, unsigned& nx) {
    const unsigned G = gridDim.x * gridDim.y * gridDim.z;
    unsigned sum, cnt, mine, sp = 0u;
    for (;;) {
        sum = 0u; cnt = 0u; mine = 0u;
#pragma unroll
        for (unsigned j = 0; j < 16; ++j) { const unsigned c = xb_ld(&bar[XB_XCNT(j)]); sum += c; cnt += (c > 0u) ? 1u : 0u; mine = (j == x) ? c : mine; }
        if (sum == G) break;
        __builtin_amdgcn_s_sleep(1);
        if ((++sp & 255u) == 0u) { if (xb_ld(&bar[XB_TMO])) break; if (sp > XB_SPIN_CAP) { atomicAdd(&bar[XB_TMO], 1u); break; } }
    }
    nloc = mine > 0u ? mine : 1u; nx = cnt > 0u ? cnt : 1u;
}
__device__ __forceinline__ void xcd_barrier(const XcdBarrier& b) {
    asm volatile("s_waitcnt vmcnt(0)" ::: "memory");
    __syncthreads();
    if (threadIdx.x == 0) {
        unsigned* bar = b.bar;
        __builtin_amdgcn_s_waitcnt(0);
        unsigned nloc = b.st[0], nx = b.st[1];
        if (nloc == 0u) { xcd_barrier_complete(bar, b.x, nloc, nx); b.st[0] = nloc; b.st[1] = nx; }
        const unsigned old = xb_add(&bar[XB_XSUB(b.x)], 1u);
        const unsigned gen = old / nloc;
        if (old + 1u == (gen + 1u) * nloc) {
            __builtin_amdgcn_fence(__ATOMIC_RELEASE, "agent");
            asm volatile("s_waitcnt vmcnt(0)" ::: "memory");
            const unsigned og = xb_add(&bar[XB_TOP], 1u);
            const unsigned tg = og / nx;
            if (og + 1u == (tg + 1u) * nx) xb_add(&bar[XB_TOPGEN], 1u);
            else XB_SPIN(xb_ld(&bar[XB_TOPGEN]) == tg, bar);
            __builtin_amdgcn_fence(__ATOMIC_ACQUIRE, "agent");
            xb_add(&bar[XB_XGEN(b.x)], 1u);
            asm volatile("s_waitcnt vmcnt(0)" ::: "memory");
        } else {
            XB_SPIN(xb_ld(&bar[XB_XGEN(b.x)]) == gen, bar);
            __builtin_amdgcn_fence(__ATOMIC_ACQUIRE, "agent");
            asm volatile("s_waitcnt vmcnt(0)" ::: "memory");
        }
    }
    __syncthreads();
}

namespace pg8 {
constexpr int BM = 256, BK = 64, HALF = 128, HTB = HALF * BK * 2, STAGE_BYTES = 8 * HTB, NXCD = 8, WGM = 8;
__host__ __device__ __forceinline__ int lds_byte(int r, int c) { const int st = (r >> 4) * 2 + (c >> 5), rr = r & 15, cc = c & 31, ob = rr * 64 + cc * 2; return st * 1024 + (ob ^ (((ob >> 9) & 1) << 5)); }
__host__ __device__ __forceinline__ void stage_rc(int b, int& R, int& C) { const int st = b / 1024, sb = b % 1024, swz = sb ^ (((sb >> 9) & 1) << 5); R = (st >> 1) * 16 + swz / 64; C = (st & 1) * 32 + (swz % 64) / 2; }
__host__ __device__ __forceinline__ int perm32(int rho) { const int n = rho >> 4, i = rho & 15; return 8 * (i >> 2) + 4 * n + (i & 3); }
struct Unit { int pm, pn; };
struct Gemm { const bf16_t* A; const bf16_t* Bt; int M, N, K, lda, ldb; };
struct StaticOrder {
    int nM, nN, nwg, G, c;
    __device__ void init(int M, int N, int G_, int c_) { nM = M / BM; nN = N / BM; nwg = nM * nN; G = G_; c = c_; }
    __device__ bool next(int i, Unit& u) const {
        const long L = (long)i * G + c; if (L >= nwg) return false;
        int wgid = (int)L; { const int q = nwg / NXCD, r = nwg % NXCD, xcd = wgid % NXCD, off = wgid / NXCD; wgid = (xcd < r ? xcd * (q + 1) : r * (q + 1) + (xcd - r) * q) + off; }
        const int nig = WGM * nN, gid = wgid / nig, fm = gid * WGM, gsz = (nM - fm) < WGM ? (nM - fm) : WGM;
        u.pm = fm + ((wgid % nig) % gsz); u.pn = (wgid % nig) / gsz; return true;
    }
};
template <class Epi>
__device__ __forceinline__ void gemm_phase(LAS unsigned char* lds, const Gemm g, const Epi& E) {
    const int tid = otid(), wid = __builtin_amdgcn_readfirstlane(tid >> 6), lane = tid & 63, wr = wid >> 2, wc = wid & 3, fr = lane & 15, fq = lane >> 4;
    StaticOrder S; S.init(g.M, g.N, (int)gridDim.x, (int)blockIdx.x);
    int K = g.K; asm volatile("" : "+s"(K));
    const int nt = K / BK;
    unsigned voffA[2], voffB[2];
#pragma unroll
    for (int i = 0; i < 2; ++i) { int R, C; stage_rc(tid * 16 + i * 8192, R, C); const int Rb = Epi::PERM ? ((R & ~31) + perm32(R & 31)) : R;
        voffA[i] = (unsigned)(R * g.lda + C) * 2u; voffB[i] = (unsigned)(Rb * g.ldb + C) * 2u; }
    const size_t kstep = (size_t)(BK * 2);
    const size_t hstepA = (size_t)HALF * g.lda * 2, hstepB = (size_t)HALF * g.ldb * 2;
    const size_t tstepA = 2 * hstepA, tstepB = 2 * hstepB;
    const unsigned ldsw = (unsigned)wid * 1024u;
    const int aoff = lds_byte(wr * 64 + fr, fq * 8), boff = lds_byte(wc * 32 + fr, fq * 8);
#define PG8_SA(b, h) (((b) * 2 + (h)) * HTB)
#define PG8_SB(b, h) ((4 + (b) * 2 + (h)) * HTB)
#define PG8_STAGE(bufoff, gbase, voff) do { _Pragma("unroll") for (int _i = 0; _i < 2; ++_i) \
        __builtin_amdgcn_global_load_lds((const unsigned*)((const char*)(gbase) + (voff)[_i]), (LAS unsigned*)(lds + (bufoff) + ldsw + _i * 8192), 16, 0, 0); } while (0)
#define PG8_LDA(dst, b, h) do { _Pragma("unroll") for (int m = 0; m < 4; ++m) _Pragma("unroll") for (int k = 0; k < 2; ++k) dst[m][k] = *(const LAS bf16x8*)(lds + PG8_SA(b, h) + aoff + m * 2048 + k * 1024); } while (0)
#define PG8_LDB(dst, b, h) do { _Pragma("unroll") for (int n = 0; n < 2; ++n) _Pragma("unroll") for (int k = 0; k < 2; ++k) dst[n][k] = *(const LAS bf16x8*)(lds + PG8_SB(b, h) + boff + n * 2048 + k * 1024); } while (0)
#define PG8_MMA(ai, bj, At, Bt) do { __builtin_amdgcn_s_setprio(1); _Pragma("unroll") for (int m = 0; m < 4; ++m) _Pragma("unroll") for (int n = 0; n < 2; ++n) _Pragma("unroll") for (int k = 0; k < 2; ++k) \
        acc[ai][bj][m][n] = __builtin_amdgcn_mfma_f32_16x16x32_bf16(Bt[n][k], At[m][k], acc[ai][bj][m][n], 0, 0, 0); __builtin_amdgcn_s_setprio(0); } while (0)
#define PG8_WAIT_V(n) asm volatile("s_waitcnt vmcnt(" #n ")" ::: "memory")
#define PG8_WAIT_L(n) asm volatile("s_waitcnt lgkmcnt(" #n ")" ::: "memory")
#define PG8_BAR __builtin_amdgcn_s_barrier()
#define PG8_SCHED __builtin_amdgcn_sched_barrier(0)
    Unit cur, nxt; int ui = 0;
    if (!S.next(0, cur)) return;
    f32x4 acc[2][2][4][2];
#pragma unroll
    for (int a = 0; a < 2; ++a)
#pragma unroll
        for (int b = 0; b < 2; ++b)
#pragma unroll
            for (int m = 0; m < 4; ++m)
#pragma unroll
                for (int n = 0; n < 2; ++n) acc[a][b][m][n] = (f32x4){0.f, 0.f, 0.f, 0.f};
    bf16x8 At[4][2], B0[2][2], B1[2][2];
    const char* cA = (const char*)g.A + (size_t)cur.pm * tstepA; const char* cB = (const char*)g.Bt + (size_t)cur.pn * tstepB;
    PG8_STAGE(PG8_SB(0, 0), cB, voffB); PG8_STAGE(PG8_SB(0, 1), cB + hstepB, voffB); PG8_STAGE(PG8_SA(0, 0), cA, voffA); PG8_STAGE(PG8_SA(0, 1), cA + hstepA, voffA);
    if (wr == 1) PG8_BAR;
    PG8_WAIT_V(2); PG8_BAR;
    PG8_STAGE(PG8_SB(1, 0), cB + kstep, voffB); PG8_STAGE(PG8_SA(1, 0), cA + kstep, voffA); PG8_STAGE(PG8_SB(1, 1), cB + hstepB + kstep, voffB);
    PG8_WAIT_V(6); PG8_BAR;
    for (;;) {
        const bool has_next = S.next(ui + 1, nxt);
        const char* nA = has_next ? (const char*)g.A + (size_t)nxt.pm * tstepA : cA; const char* nB = has_next ? (const char*)g.Bt + (size_t)nxt.pn * tstepB : cB;
        for (int t = 0; t < nt; t += 2) {
            const bool last = (t == nt - 2);
            const char* a1 = cA + (size_t)(t + 1) * kstep;
            const char* a2 = last ? nA : cA + (size_t)(t + 2) * kstep; const char* b2 = last ? nB : cB + (size_t)(t + 2) * kstep;
            const char* a3 = a2 + kstep; const char* b3 = b2 + kstep;
            PG8_LDB(B0, 0, 0); PG8_LDB(B1, 0, 1); PG8_SCHED; PG8_LDA(At, 0, 0); PG8_STAGE(PG8_SA(1, 1), a1 + hstepA, voffA);
            PG8_WAIT_V(8); PG8_WAIT_L(0); PG8_BAR; PG8_MMA(0, 0, At, B0); PG8_MMA(0, 1, At, B1); PG8_BAR; PG8_SCHED;
            PG8_LDA(At, 0, 1); PG8_STAGE(PG8_SB(0, 0), b2, voffB); PG8_STAGE(PG8_SB(0, 1), b2 + hstepB, voffB); PG8_STAGE(PG8_SA(0, 0), a2, voffA);
            PG8_WAIT_V(8); PG8_WAIT_L(0); PG8_BAR; PG8_MMA(1, 0, At, B0); PG8_MMA(1, 1, At, B1); PG8_BAR; PG8_SCHED;
            PG8_LDB(B0, 1, 0); PG8_LDB(B1, 1, 1); PG8_SCHED; PG8_LDA(At, 1, 0); PG8_STAGE(PG8_SA(0, 1), a2 + hstepA, voffA);
            PG8_WAIT_V(8); PG8_WAIT_L(0); PG8_BAR; PG8_MMA(0, 0, At, B0); PG8_MMA(0, 1, At, B1); PG8_BAR; PG8_SCHED;
            PG8_LDA(At, 1, 1); PG8_STAGE(PG8_SB(1, 0), b3, voffB); PG8_STAGE(PG8_SB(1, 1), b3 + hstepB, voffB); PG8_STAGE(PG8_SA(1, 0), a3, voffA);
            PG8_WAIT_V(8); PG8_WAIT_L(0); PG8_BAR; PG8_MMA(1, 0, At, B0); PG8_MMA(1, 1, At, B1); PG8_BAR; PG8_SCHED;
        }
        if (wr == 0) PG8_BAR;
        { const int l2_ = otid() & 63; E(acc, cur, wr, wc, l2_ & 15, l2_ >> 4); }
        if (!has_next) break;
#pragma unroll
        for (int a = 0; a < 2; ++a)
#pragma unroll
            for (int b = 0; b < 2; ++b)
#pragma unroll
                for (int m = 0; m < 4; ++m)
#pragma unroll
                    for (int n = 0; n < 2; ++n) acc[a][b][m][n] = (f32x4){0.f, 0.f, 0.f, 0.f};
        cur = nxt; cA = nA; cB = nB; ++ui;
        if (wr == 1) PG8_BAR;
    }
    PG8_WAIT_V(0);
    PG8_BAR;
#undef PG8_SA
#undef PG8_SB
#undef PG8_STAGE
#undef PG8_LDA
#undef PG8_LDB
#undef PG8_MMA
#undef PG8_WAIT_V
#undef PG8_WAIT_L
#undef PG8_BAR
#undef PG8_SCHED
}

template <int ACT> struct EpiBf16 {
    static constexpr bool PERM = true;
    bf16_t* O; int ldc;
    __device__ __forceinline__ void operator()(const f32x4 (&acc)[2][2][4][2], const Unit& u, int wr, int wc, int fr, int fq) const {
        const int row0 = u.pm * BM + wr * 64 + fr, col0 = u.pn * BM + wc * 32 + 8 * fq;
#pragma unroll
        for (int ai = 0; ai < 2; ++ai)
#pragma unroll
            for (int m = 0; m < 4; ++m) { bf16_t* rowp = O + (size_t)(row0 + ai * HALF + m * 16) * ldc + col0;
#pragma unroll
                for (int bj = 0; bj < 2; ++bj) { f32x4 v0 = acc[ai][bj][m][0], v1 = acc[ai][bj][m][1];
                    if (ACT == 1) { f32x2 a = gelu_pk((f32x2){v0[0], v0[1]}), b = gelu_pk((f32x2){v0[2], v0[3]}), c = gelu_pk((f32x2){v1[0], v1[1]}), d = gelu_pk((f32x2){v1[2], v1[3]});
                        v0 = (f32x4){a.x, a.y, b.x, b.y}; v1 = (f32x4){c.x, c.y, d.x, d.y}; }
                    u32x4 w; w.x = cvt_pk_bf16(v0[0], v0[1]); w.y = cvt_pk_bf16(v0[2], v0[3]); w.z = cvt_pk_bf16(v1[0], v1[1]); w.w = cvt_pk_bf16(v1[2], v1[3]);
                    *(u32x4*)(rowp + bj * HALF) = w; } }
    }
};
struct EpiResid {
    static constexpr bool PERM = false;
    float* xl; float* xc; const float* gate;
    __device__ __forceinline__ void operator()(const f32x4 (&acc)[2][2][4][2], const Unit& u, int wr, int wc, int fr, int fq) const {
        const int rbase = u.pm * BM; const bool lat = rbase < NLAT;
        float* X = lat ? xl + (size_t)rbase * D : xc + (size_t)(rbase - NLAT) * D;
        const float* gp = gate + (size_t)(lat ? (rbase >> 13) : 4) * 6144;
        const int row0 = wr * 64 + fr, col0 = u.pn * BM + wc * 32 + 4 * fq;
        f32x4 gv[2][2];
#pragma unroll
        for (int bj = 0; bj < 2; ++bj)
#pragma unroll
            for (int n = 0; n < 2; ++n) gv[bj][n] = *(const f32x4*)(gp + col0 + bj * HALF + n * 16);
#pragma unroll
        for (int ai = 0; ai < 2; ++ai)
#pragma unroll
            for (int m = 0; m < 4; ++m) { float* rowp = X + (size_t)(row0 + ai * HALF + m * 16) * D + col0;
#pragma unroll
                for (int bj = 0; bj < 2; ++bj)
#pragma unroll
                    for (int n = 0; n < 2; ++n) { f32x4* p = (f32x4*)(rowp + bj * HALF + n * 16); *p = *p + gv[bj][n] * acc[ai][bj][m][n]; } }
    }
};
}

namespace att {
constexpr int SLOT = 40960, KN_OFF = 0, KR_OFF = 16384, V_OFF = 24576, LDS_BYTES = 3 * SLOT + 8 * 256;
constexpr float THR2 = 11.0f;
#define KSWZ(row, colB) ((row) * 256 + ((colB) ^ (((row) & 7) << 4)))
#define KRSWZ(row, colB) ((row) * 128 + ((colB) ^ ((((row) >> 1) & 7) << 4)))
#define SBAR() __builtin_amdgcn_sched_barrier(0)
__device__ __forceinline__ int crow(int r, int hi) { return (r & 3) + 8 * (r >> 2) + 4 * hi; }
__host__ __device__ __forceinline__ int v_st(int k, int c) { const int kk = (k & ~0xC) | ((k & 4) << 1) | ((k & 8) >> 1); return ((kk >> 3) * 4 + (c >> 5)) * 512 + ((kk & 7) * 32 + (c & 31)) * 2; }
__device__ __forceinline__ int v_rd_base(int lane) { return ((lane & 3) << 3) | (((lane >> 2) & 3) << 6) | (((lane >> 4) & 1) << 5) | (((lane >> 5) & 1) << 8); }
constexpr int v_rd_off(int d0, int ks, int half) { return d0 * 512 + ks * 4096 + half * 2048; }
template <int OFF> __device__ __forceinline__ s16x4 tr_read(int vb) {
    s16x4 r; asm volatile("ds_read_b64_tr_b16 %0, %1 offset:%2" : "=&v"(r) : "v"(vb), "i"(OFF) : "memory"); return r;
}
template <int D0> __device__ __forceinline__ void pv_one(f32x16& od, int vb, bf16x8 pa0, bf16x8 pa1, bf16x8 pa2, bf16x8 pa3) {
    const s16x4 l0 = tr_read<v_rd_off(D0, 0, 0)>(vb), h0 = tr_read<v_rd_off(D0, 0, 1)>(vb), l1 = tr_read<v_rd_off(D0, 1, 0)>(vb), h1 = tr_read<v_rd_off(D0, 1, 1)>(vb);
    const s16x4 l2 = tr_read<v_rd_off(D0, 2, 0)>(vb), h2 = tr_read<v_rd_off(D0, 2, 1)>(vb), l3 = tr_read<v_rd_off(D0, 3, 0)>(vb), h3 = tr_read<v_rd_off(D0, 3, 1)>(vb);
    asm volatile("s_waitcnt lgkmcnt(0)" ::: "memory"); SBAR();
#define PK(L, H) (bf16x8){L[0], L[1], L[2], L[3], H[0], H[1], H[2], H[3]}
    od = __builtin_amdgcn_mfma_f32_32x32x16_bf16(pa0, PK(l0, h0), od, 0, 0, 0);
    od = __builtin_amdgcn_mfma_f32_32x32x16_bf16(pa1, PK(l1, h1), od, 0, 0, 0);
    od = __builtin_amdgcn_mfma_f32_32x32x16_bf16(pa2, PK(l2, h2), od, 0, 0, 0);
    od = __builtin_amdgcn_mfma_f32_32x32x16_bf16(pa3, PK(l3, h3), od, 0, 0, 0);
#undef PK
}
__device__ __forceinline__ void pv_d0(f32x16* o, int vb, bf16x8 pa0, bf16x8 pa1, bf16x8 pa2, bf16x8 pa3) {
    pv_one<0>(o[0], vb, pa0, pa1, pa2, pa3); pv_one<1>(o[1], vb, pa0, pa1, pa2, pa3); pv_one<2>(o[2], vb, pa0, pa1, pa2, pa3); pv_one<3>(o[3], vb, pa0, pa1, pa2, pa3);
}
__device__ __forceinline__ void partialSM(f32x16& p0, f32x16& p1, float& m_reg, float& mn, float& alpha) {
    float pmax = p0[0];
#pragma unroll
    for (int r = 1; r < 16; ++r) pmax = fmaxf(pmax, p0[r]);
#pragma unroll
    for (int r = 0; r < 16; ++r) pmax = fmaxf(pmax, p1[r]);
    { auto rr = __builtin_amdgcn_permlane32_swap(__float_as_uint(pmax), __float_as_uint(pmax), false, false);
      pmax = fmaxf(__uint_as_float(rr[0]), __uint_as_float(rr[1])); }
    if (__builtin_expect(__all(pmax - m_reg <= THR2), 1)) { mn = m_reg; alpha = 1.f; }
    else { mn = fmaxf(m_reg, pmax); alpha = __builtin_amdgcn_exp2f(m_reg - mn); m_reg = mn; }
#pragma unroll
    for (int r = 0; r < 16; ++r) p0[r] = __builtin_amdgcn_exp2f(p0[r] - mn);
#pragma unroll
    for (int r = 0; r < 16; ++r) p1[r] = p1[r] - mn;
}
__device__ __forceinline__ void finishSM(f32x16& p0, f32x16& p1, float alpha, float& l_reg, bf16x8& pa0, bf16x8& pa1, bf16x8& pa2, bf16x8& pa3) {
#pragma unroll
    for (int r = 0; r < 16; ++r) p1[r] = __builtin_amdgcn_exp2f(p1[r]);
    float ps = 0;
#pragma unroll
    for (int r = 0; r < 16; ++r) ps += p0[r];
#pragma unroll
    for (int r = 0; r < 16; ++r) ps += p1[r];
    { auto rr = __builtin_amdgcn_permlane32_swap(__float_as_uint(ps), __float_as_uint(ps), false, false);
      ps = __uint_as_float(rr[0]) + __uint_as_float(rr[1]); }
    l_reg = l_reg * alpha + ps;
#define PK4(P, BASE, OUT) do { unsigned a0 = cvt_pk_bf16(P[BASE + 0], P[BASE + 1]), a1 = cvt_pk_bf16(P[BASE + 2], P[BASE + 3]);   \
    unsigned b0 = cvt_pk_bf16(P[BASE + 4], P[BASE + 5]), b1 = cvt_pk_bf16(P[BASE + 6], P[BASE + 7]);                              \
    auto r0 = __builtin_amdgcn_permlane32_swap(a0, b0, false, false); auto r1 = __builtin_amdgcn_permlane32_swap(a1, b1, false, false); \
    u32x4 w = {r0[0], r1[0], r0[1], r1[1]}; OUT = *reinterpret_cast<bf16x8*>(&w); } while (0)
    PK4(p0, 0, pa0); PK4(p0, 8, pa1); PK4(p1, 0, pa2); PK4(p1, 8, pa3);
#undef PK4
}
__device__ __forceinline__ void qkt(f32x16& p0, f32x16& p1, LAS unsigned char* slot, const bf16x8* qr, int r32, int hi) {
    p0 = f32x16{}; p1 = f32x16{};
#pragma unroll
    for (int d0 = 0; d0 < 8; ++d0) { const int cb = (d0 * 16 + hi * 8) * 2;
        bf16x8 b0 = *(const LAS bf16x8*)(slot + KN_OFF + KSWZ(r32, cb));
        bf16x8 b1 = *(const LAS bf16x8*)(slot + KN_OFF + KSWZ(32 + r32, cb));
        p0 = __builtin_amdgcn_mfma_f32_32x32x16_bf16(b0, qr[d0], p0, 0, 0, 0);
        p1 = __builtin_amdgcn_mfma_f32_32x32x16_bf16(b1, qr[d0], p1, 0, 0, 0); }
#pragma unroll
    for (int d0 = 0; d0 < 4; ++d0) { const int cb = (d0 * 16 + hi * 8) * 2;
        bf16x8 b0 = *(const LAS bf16x8*)(slot + KR_OFF + KRSWZ(r32, cb));
        bf16x8 b1 = *(const LAS bf16x8*)(slot + KR_OFF + KRSWZ(32 + r32, cb));
        p0 = __builtin_amdgcn_mfma_f32_32x32x16_bf16(b0, qr[8 + d0], p0, 0, 0, 0);
        p1 = __builtin_amdgcn_mfma_f32_32x32x16_bf16(b1, qr[8 + d0], p1, 0, 0, 0); }
}
__device__ __forceinline__ void attn_unit(const bf16_t* __restrict__ Qb, const unsigned char* __restrict__ KNt, const unsigned char* __restrict__ KRt, const unsigned char* __restrict__ Vt,
                                          bf16_t* __restrict__ Ob, int NT, LAS unsigned char* lds) {
    const int tid = otid(), wid = __builtin_amdgcn_readfirstlane(tid >> 6), lane = tid & 63, r32 = lane & 31, hi = lane >> 5;
    LAS float* wsf = (LAS float*)(lds + 3 * SLOT) + wid * 64; LAS float* li_l = wsf; LAS float* al_l = wsf + 32;
    float m_reg = -1e30f, l_reg = 0; f32x16 o[4] = {}; bf16x8 qr[12];
    const bf16_t* Qw = Qb + (size_t)(wid * 32 + r32) * 192 + hi * 8;
#pragma unroll
    for (int d0 = 0; d0 < 12; ++d0) qr[d0] = *(const bf16x8*)(Qw + d0 * 16);
    const int vrb = (int)(unsigned)(uintptr_t)(lds) + V_OFF + v_rd_base(lane);
    const unsigned lo16 = (unsigned)lane * 16u;
#define ATT_DMA(tile, slotoff) do { const size_t t_ = (size_t)(tile); LAS unsigned char* sl_ = lds + (slotoff); \
        __builtin_amdgcn_global_load_lds((const unsigned*)(KNt + t_ * 16384 + wid * 1024 + lo16), (LAS unsigned*)(sl_ + KN_OFF + wid * 1024), 16, 0, 0); \
        __builtin_amdgcn_global_load_lds((const unsigned*)(KNt + t_ * 16384 + (wid + 8) * 1024 + lo16), (LAS unsigned*)(sl_ + KN_OFF + (wid + 8) * 1024), 16, 0, 0); \
        __builtin_amdgcn_global_load_lds((const unsigned*)(KRt + t_ * 8192 + wid * 1024 + lo16), (LAS unsigned*)(sl_ + KR_OFF + wid * 1024), 16, 0, 0); \
        __builtin_amdgcn_global_load_lds((const unsigned*)(Vt + t_ * 16384 + wid * 1024 + lo16), (LAS unsigned*)(sl_ + V_OFF + wid * 1024), 16, 0, 0); \
        __builtin_amdgcn_global_load_lds((const unsigned*)(Vt + t_ * 16384 + (wid + 8) * 1024 + lo16), (LAS unsigned*)(sl_ + V_OFF + (wid + 8) * 1024), 16, 0, 0); } while (0)
#define ATT_SYNC() do { asm volatile("s_waitcnt vmcnt(0)" ::: "memory"); __builtin_amdgcn_s_barrier(); asm volatile("" ::: "memory"); } while (0)
#define RESC(a) do { if (__any((a) < 1.f)) { if (hi == 0) al_l[r32] = (a); asm volatile("s_waitcnt lgkmcnt(0)" ::: "memory"); \
        _Pragma("unroll") for (int d = 0; d < 4; ++d) _Pragma("unroll") for (int r = 0; r < 16; ++r) o[d][r] *= al_l[crow(r, hi)]; } } while (0)
    f32x16 pA0, pA1, pB0, pB1; float mnA, mnB, alA, alB; bf16x8 pa0, pa1, pa2, pa3;
    int sp = 0, sc = SLOT, sn = 2 * SLOT;
    ATT_DMA(0, 0); ATT_DMA(1, SLOT);
    asm volatile("s_waitcnt vmcnt(5)" ::: "memory"); __builtin_amdgcn_s_barrier(); asm volatile("" ::: "memory");
    qkt(pA0, pA1, lds, qr, r32, hi); partialSM(pA0, pA1, m_reg, mnA, alA);
    for (int j = 1; j + 1 < NT; j += 2) {
        ATT_SYNC(); ATT_DMA(j + 1, sn);
        SBAR(); qkt(pB0, pB1, lds + sc, qr, r32, hi);
        finishSM(pA0, pA1, alA, l_reg, pa0, pa1, pa2, pa3); SBAR();
        pv_d0(o, vrb + sp, pa0, pa1, pa2, pa3); partialSM(pB0, pB1, m_reg, mnB, alB);
        RESC(alB);
        { const int t_ = sp; sp = sc; sc = sn; sn = t_; }
        ATT_SYNC(); if (j + 2 < NT) ATT_DMA(j + 2, sn);
        SBAR(); qkt(pA0, pA1, lds + sc, qr, r32, hi);
        finishSM(pB0, pB1, alB, l_reg, pa0, pa1, pa2, pa3); SBAR();
        pv_d0(o, vrb + sp, pa0, pa1, pa2, pa3); partialSM(pA0, pA1, m_reg, mnA, alA);
        RESC(alA);
        { const int t_ = sp; sp = sc; sc = sn; sn = t_; }
    }
    ATT_SYNC();
    SBAR(); qkt(pB0, pB1, lds + sc, qr, r32, hi);
    finishSM(pA0, pA1, alA, l_reg, pa0, pa1, pa2, pa3); SBAR();
    pv_d0(o, vrb + sp, pa0, pa1, pa2, pa3); partialSM(pB0, pB1, m_reg, mnB, alB);
    RESC(alB);
    finishSM(pB0, pB1, alB, l_reg, pa0, pa1, pa2, pa3); SBAR();
    pv_d0(o, vrb + sc, pa0, pa1, pa2, pa3);
    if (hi == 0) li_l[r32] = l_reg; asm volatile("s_waitcnt lgkmcnt(0)" ::: "memory");
    float rli[16];
#pragma unroll
    for (int r = 0; r < 16; ++r) rli[r] = __builtin_amdgcn_rcpf(li_l[crow(r, hi)]);
    bf16_t* Ow = Ob + (size_t)(wid * 32) * 2048;
#pragma unroll
    for (int r = 0; r < 16; ++r) { const int orow = crow(r, hi);
#pragma unroll
        for (int d0 = 0; d0 < 4; ++d0) Ow[(size_t)orow * 2048 + d0 * 32 + r32] = f2bf(o[d0][r] * rli[r]); }
    __builtin_amdgcn_s_barrier(); asm volatile("" ::: "memory");
#undef ATT_DMA
#undef ATT_SYNC
#undef RESC
}
}

namespace ssd {
constexpr int XT_OFF = 0, XTW_OFF = 8704, BT_OFF = 17408, HB_OFF = 52224, SET = 60928, CW_OFF = 2 * SET, LDS_BYTES = CW_OFF + 8 * 512;
constexpr int PITCH = 272;
constexpr float L2E = 1.4426950408889634f;
__device__ __forceinline__ void g_unit(const bf16_t* __restrict__ BC, bf16_t* __restrict__ G, int unit) {
    const int cid = unit >> 1, g = unit & 1;
    const int r0 = cid < 256 ? cid * 128 : NLAT + (cid - 256) * 128;
    const int tid = otid(), wid = tid >> 6, lane = tid & 63, fr = lane & 15, fq = lane >> 4;
    const bf16_t* Cp = BC + (size_t)(r0 + 16 * wid + fr) * 512 + 256 + 128 * g + 8 * fq;
    bf16x8 cf[4];
#pragma unroll
    for (int ks = 0; ks < 4; ++ks) cf[ks] = *(const bf16x8*)(Cp + 32 * ks);
    bf16_t* Gp = G + ((size_t)unit * 128 + 16 * wid + fr) * 128 + 4 * fq;
#pragma unroll
    for (int sb = 0; sb < 8; ++sb) {
        const bf16_t* Bp = BC + (size_t)(r0 + 16 * sb + fr) * 512 + 128 * g + 8 * fq;
        f32x4 acc = {0.f, 0.f, 0.f, 0.f};
#pragma unroll
        for (int ks = 0; ks < 4; ++ks) { const bf16x8 bfr = *(const bf16x8*)(Bp + 32 * ks); acc = __builtin_amdgcn_mfma_f32_16x16x32_bf16(bfr, cf[ks], acc, 0, 0, 0); }
        u32x2 w; w.x = cvt_pk_bf16(acc[0], acc[1]); w.y = cvt_pk_bf16(acc[2], acc[3]);
        *(u32x2*)(Gp + 16 * sb) = w;
    }
}
__device__ __forceinline__ void ssd_unit(int u, const bf16_t* __restrict__ XS, const bf16_t* __restrict__ BC, const float* __restrict__ DT, const bf16_t* __restrict__ G,
                                         const float* __restrict__ a_log, bf16_t* __restrict__ Y0, bf16_t* __restrict__ Y1, LAS unsigned char* lds) {
    const int b = u >> 6, h = (u >> 2) & 15, d = (u >> 1) & 1, ph = u & 1, g = h >> 3;
    const int tid = otid(), wid = tid >> 6, lane = tid & 63, fr = lane & 15, fq = lane >> 4;
    const float a = -__expf(a_log[d * 16 + h]);
    bf16_t* Y = d ? Y1 : Y0;
    LAS float* cw = (LAS float*)(lds + CW_OFF + wid * 512);
    f32x4 hs[2] = {{0.f, 0.f, 0.f, 0.f}, {0.f, 0.f, 0.f, 0.f}};
    for (int i = tid; i < 8704 / 4; i += 512) ((LAS unsigned*)(lds + HB_OFF))[i] = 0u;
    float cend = 0.f;
#define SSD_ROWS(step, r0v, gidv) do { if ((step) < 2) { const int oc_ = d ? 1 - (step) : (step); r0v = NLAT + b * 256 + oc_ * 128; gidv = 256 + b * 2 + oc_; } \
        else { const int lc_ = (step) - 2, oc_ = d ? 63 - lc_ : lc_; r0v = b * 8192 + oc_ * 128; gidv = b * 64 + oc_; } } while (0)
    const int sg = tid & 31, n8 = tid >> 5, p4 = (tid >> 5) & 7, arr = tid >> 8;
    f32x2 n_da; f32x4 n_dt4; u32x2 n_xv[4]; u32x4 n_bv[4], n_gv[4], n_cv[4];
#define SSD_LOAD(step) do { int r0_, gid_; SSD_ROWS(step, r0_, gid_); const float* dtp_ = DT + (size_t)(d * 16 + h) * NROW + r0_; \
        n_da = *(const f32x2*)(dtp_ + 2 * lane); n_dt4 = *(const f32x4*)(dtp_ + 4 * sg); \
        _Pragma("unroll") for (int j_ = 0; j_ < 4; ++j_) { n_xv[j_] = *(const u32x2*)(XS + (size_t)(r0_ + 4 * sg + j_) * 1024 + 64 * h + 32 * ph + 4 * p4); \
                                                         n_bv[j_] = *(const u32x4*)(BC + (size_t)(r0_ + 4 * sg + j_) * 512 + 128 * g + 8 * n8); } \
        { const int t_ = 16 * wid + fr; const bf16_t* Gp_ = G + ((size_t)(gid_ * 2 + g) * 128 + t_) * 128 + 8 * fq; const bf16_t* Cp_ = BC + (size_t)(r0_ + t_) * 512 + 256 + 128 * g + 8 * fq; \
          _Pragma("unroll") for (int ks_ = 0; ks_ < 4; ++ks_) { n_gv[ks_] = *(const u32x4*)(Gp_ + 32 * ks_); n_cv[ks_] = *(const u32x4*)(Cp_ + 32 * ks_); } } } while (0)
#define SSD_WRITE(step) do { LAS unsigned char* set_ = lds + ((step) & 1) * SET; \
        const float da0 = n_da.x * a, da1 = n_da.y * a; \
        float sc_ = da0 + da1; \
        if (d == 0) { _Pragma("unroll") for (int o_ = 1; o_ < 64; o_ <<= 1) { const float t_ = __shfl_up(sc_, o_); if (lane >= o_) sc_ += t_; } \
            cw[2 * lane] = sc_ - da1; cw[2 * lane + 1] = sc_; cend = __shfl(sc_, 63); } \
        else { _Pragma("unroll") for (int o_ = 1; o_ < 64; o_ <<= 1) { const float t_ = __shfl_down(sc_, o_); if (lane + o_ < 64) sc_ += t_; } \
            cw[2 * lane] = sc_; cw[2 * lane + 1] = sc_ - da0; cend = __shfl(sc_, 0); } \
        asm volatile("s_waitcnt lgkmcnt(0)" ::: "memory"); \
        { const f32x4 cs_ = *(const LAS f32x4*)(cw + 4 * sg); float sc4_[4]; \
          _Pragma("unroll") for (int j_ = 0; j_ < 4; ++j_) sc4_[j_] = arr ? n_dt4[j_] * __builtin_amdgcn_exp2f((cend - cs_[j_]) * L2E) : n_dt4[j_]; \
          LAS unsigned char* xt_ = set_ + (arr ? XTW_OFF : XT_OFF) + (4 * p4) * PITCH + 8 * sg; \
          _Pragma("unroll") for (int i_ = 0; i_ < 4; ++i_) { float v_[4]; \
              _Pragma("unroll") for (int j_ = 0; j_ < 4; ++j_) { const unsigned w_ = (i_ & 2) ? n_xv[j_].y : n_xv[j_].x; v_[j_] = ((i_ & 1) ? bfhi(w_) : bflo(w_)) * sc4_[j_]; } \
              u32x2 o_; o_.x = cvt_pk_bf16(v_[0], v_[1]); o_.y = cvt_pk_bf16(v_[2], v_[3]); *(LAS u32x2*)(xt_ + i_ * PITCH) = o_; } } \
        { LAS unsigned char* bt_ = set_ + BT_OFF + (8 * n8) * PITCH + 8 * sg; \
          _Pragma("unroll") for (int i_ = 0; i_ < 8; ++i_) { unsigned e_[4]; \
              _Pragma("unroll") for (int j_ = 0; j_ < 4; ++j_) { const unsigned w_ = n_bv[j_][i_ >> 1]; e_[j_] = (i_ & 1) ? (w_ >> 16) : (w_ & 0xffffu); } \
              u32x2 o_; o_.x = e_[0] | (e_[1] << 16); o_.y = e_[2] | (e_[3] << 16); *(LAS u32x2*)(bt_ + i_ * PITCH) = o_; } } \
    } while (0)
    SSD_LOAD(0); SSD_WRITE(0);
    for (int step = 0; step < 66; ++step) {
        __syncthreads();
        int r0, gid; SSD_ROWS(step, r0, gid); (void)gid;
        LAS unsigned char* set = lds + (step & 1) * SET;
        const float cend_cur = cend;
        u32x4 gv[4], cv[4];
#pragma unroll
        for (int ks = 0; ks < 4; ++ks) { gv[ks] = n_gv[ks]; cv[ks] = n_cv[ks]; }
        if (step + 1 < 66) SSD_LOAD(step + 1);
        {
            const int t = 16 * wid + fr; const float ct = cw[t];
            f32x4 y[2] = {{0.f, 0.f, 0.f, 0.f}, {0.f, 0.f, 0.f, 0.f}};
            const float et = __builtin_amdgcn_exp2f(ct * L2E);
#pragma unroll
            for (int ks = 0; ks < 4; ++ks) {
                const bool live = d == 0 ? (32 * ks <= 16 * wid + 15) : (32 * ks + 31 >= 16 * wid);
                if (live) {
                    const int s0 = 32 * ks + 8 * fq;
                    const f32x4 c0 = *(const LAS f32x4*)(cw + s0), c1 = *(const LAS f32x4*)(cw + s0 + 4);
                    float m[8];
#pragma unroll
                    for (int i = 0; i < 8; ++i) { const float cs = i < 4 ? c0[i & 3] : c1[i & 3]; const int s = s0 + i;
                        const bool ok = d == 0 ? (s <= t) : (s >= t);
                        const float gval = (i & 1) ? bfhi(gv[ks][i >> 1]) : bflo(gv[ks][i >> 1]);
                        m[i] = ok ? gval * __builtin_amdgcn_exp2f((ct - cs) * L2E) : 0.f; }
                    u32x4 mw; mw.x = cvt_pk_bf16(m[0], m[1]); mw.y = cvt_pk_bf16(m[2], m[3]); mw.z = cvt_pk_bf16(m[4], m[5]); mw.w = cvt_pk_bf16(m[6], m[7]);
                    const bf16x8 mb = __builtin_bit_cast(bf16x8, mw);
#pragma unroll
                    for (int q = 0; q < 2; ++q) { const bf16x8 af = *(const LAS bf16x8*)(set + XT_OFF + (16 * q + fr) * PITCH + (32 * ks + 8 * fq) * 2);
                        y[q] = __builtin_amdgcn_mfma_f32_16x16x32_bf16(af, mb, y[q], 0, 0, 0); }
                }
            }
#pragma unroll
            for (int ks = 0; ks < 4; ++ks) {
                u32x4 cwv;
#pragma unroll
                for (int i = 0; i < 4; ++i) cwv[i] = cvt_pk_bf16(bflo(cv[ks][i]) * et, bfhi(cv[ks][i]) * et);
                const bf16x8 cb = __builtin_bit_cast(bf16x8, cwv);
#pragma unroll
                for (int q = 0; q < 2; ++q) { const bf16x8 af = *(const LAS bf16x8*)(set + HB_OFF + (16 * q + fr) * PITCH + (32 * ks + 8 * fq) * 2);
                    y[q] = __builtin_amdgcn_mfma_f32_16x16x32_bf16(af, cb, y[q], 0, 0, 0); }
            }
            bf16_t* yp = Y + (size_t)(r0 + t) * 1024 + 64 * h + 32 * ph + 4 * fq;
#pragma unroll
            for (int q = 0; q < 2; ++q) { u32x2 w; w.x = cvt_pk_bf16(y[q][0], y[q][1]); w.y = cvt_pk_bf16(y[q][2], y[q][3]); *(u32x2*)(yp + 16 * q) = w; }
        }
        {
            const float dec = __builtin_amdgcn_exp2f(cend_cur * L2E);
            hs[0] = hs[0] * dec; hs[1] = hs[1] * dec;
#pragma unroll
            for (int ks = 0; ks < 4; ++ks) {
                const bf16x8 bfr = *(const LAS bf16x8*)(set + BT_OFF + (16 * wid + fr) * PITCH + (32 * ks + 8 * fq) * 2);
#pragma unroll
                for (int q = 0; q < 2; ++q) { const bf16x8 af = *(const LAS bf16x8*)(set + XTW_OFF + (16 * q + fr) * PITCH + (32 * ks + 8 * fq) * 2);
                    hs[q] = __builtin_amdgcn_mfma_f32_16x16x32_bf16(af, bfr, hs[q], 0, 0, 0); }
            }
            LAS bf16_t* hb = (LAS bf16_t*)(lds + ((step + 1) & 1) * SET + HB_OFF) + 16 * wid + fr;
#pragma unroll
            for (int q = 0; q < 2; ++q)
#pragma unroll
                for (int i = 0; i < 4; ++i) hb[(16 * q + 4 * fq + i) * 136] = f2bf(hs[q][i]);
        }
        if (step + 1 < 66) SSD_WRITE(step + 1);
    }
    __syncthreads();
#undef SSD_ROWS
#undef SSD_LOAD
#undef SSD_WRITE
}
}

struct Args { const float* in[32]; float* out; unsigned char* ws; int ph_lo, ph_hi; };
constexpr int NTHR = 512;
constexpr int LDS_BASE = 256;
constexpr int LDS_PHASE = 133120;
constexpr int LDS_BYTES = LDS_BASE + LDS_PHASE;
static_assert(att::LDS_BYTES <= LDS_PHASE && ssd::LDS_BYTES <= LDS_PHASE && pg8::STAGE_BYTES <= LDS_PHASE, "LDS");

__device__ __forceinline__ void tjob(int j, const Args& A, const float*& src, bf16_t*& dst, int& K, int& N, int& Npad, int& mode, const float*& ks) {
    unsigned char* W = A.ws + WS_W; mode = 0; ks = nullptr;
    if (j < 8) { const int i = j >> 2, w = j & 3; unsigned char* base = W + W_HYB + (size_t)i * WH_SZ;
        if (w == 0)      { src = A.in[I_HWIN] + (size_t)i * 1024 * HYB_IN; dst = (bf16_t*)(base + WH_IN); K = 1024; N = HYB_IN; Npad = HYB_INP; mode = 1; }
        else if (w == 1) { src = A.in[I_WQB] + (size_t)i * 384 * 1536; dst = (bf16_t*)(base + WH_QB); K = 384; N = 1536; Npad = 1536; mode = 2; ks = A.in[I_QNG] + i * 384; }
        else if (w == 2) { src = A.in[I_WKVB] + (size_t)i * 256 * 2048; dst = (bf16_t*)(base + WH_KVB); K = 256; N = 2048; Npad = 2048; ks = A.in[I_KVNG] + i * 256; }
        else             { src = A.in[I_HWOUT] + (size_t)i * 2048 * 1024; dst = (bf16_t*)(base + WH_OUT); K = 2048; N = 1024; Npad = 1024; }
    } else if (j < 12) { const int i = (j - 8) >> 1, w = (j - 8) & 1; unsigned char* base = W + W_GM + (size_t)i * WG_SZ;
        if (w == 0) { src = A.in[I_GWIN] + (size_t)i * 1024 * 4096; dst = (bf16_t*)(base + WG_IN); K = 1024; N = 4096; Npad = 4096; }
        else        { src = A.in[I_GWOUT] + (size_t)i * 2048 * 1024; dst = (bf16_t*)(base + WG_OUT); K = 2048; N = 1024; Npad = 1024; }
    } else { const int l = j - 12; src = A.in[I_PWQ] + (size_t)l * 1024 * 2048; dst = (bf16_t*)(W + W_PEER + (size_t)l * WP_SZ + WP_Q); K = 1024; N = 2048; Npad = 2048; }
}
__device__ __forceinline__ int colmap(int mode, int n, int N) {
    if (mode == 1) { if (n >= N) return -1; if (n < C_KR) return n; const int m = n - C_KR; return C_KR + (m >> 1) + 32 * (m & 1); }
    if (mode == 2) { if (n < 1024) return (n >> 7) * 192 + (n & 127); const int m = n - 1024, h = m >> 6, mm = m & 63; return h * 192 + 128 + (mm >> 1) + 32 * (mm & 1); }
    return n;
}
__device__ __forceinline__ void phase_prologue(const Args& A, LAS unsigned char* lds) {
    const int tid = otid();
    {
        LAS float* tile = (LAS float*)lds;
        int item = blockIdx.x;
        for (int j = 0; j < 16; ++j) {
            const float* src; bf16_t* dst; int K, N, Npad, mode; const float* ks; tjob(j, A, src, dst, K, N, Npad, mode, ks);
            const int tk = K / 64, tn = Npad / 64, nt = tk * tn;
            for (; item < nt; item += gridDim.x) {
                const int k0 = (item % tk) * 64, n0 = (item / tk) * 64;
                { const int k = tid >> 3, cg = tid & 7; const float sc = ks ? ks[k0 + k] : 1.f;
#pragma unroll
                  for (int jj = 0; jj < 8; ++jj) { const int oc = colmap(mode, n0 + 8 * cg + jj, N); tile[k * 65 + 8 * cg + jj] = oc >= 0 ? src[(size_t)(k0 + k) * N + oc] * sc : 0.f; } }
                __syncthreads();
                { const int n = tid >> 3, kg = tid & 7; float v[8];
#pragma unroll
                  for (int jj = 0; jj < 8; ++jj) v[jj] = tile[(8 * kg + jj) * 65 + n];
                  u32x4 w; w.x = cvt_pk_bf16(v[0], v[1]); w.y = cvt_pk_bf16(v[2], v[3]); w.z = cvt_pk_bf16(v[4], v[5]); w.w = cvt_pk_bf16(v[6], v[7]);
                  *(u32x4*)(dst + (size_t)(n0 + n) * K + k0 + 8 * kg) = w; }
                __syncthreads();
            }
            item -= nt;
        }
    }
    {
        const int gthr = blockIdx.x * NTHR + tid, nthr = gridDim.x * NTHR;
        for (int p = gthr; p < 10 * 16384; p += nthr) {
            const int mat = p >> 14, off = (p & 16383) * 8; const float* src; bf16_t* dst;
            if (mat < 2)      { src = A.in[I_GWS] + (size_t)mat * 131072; dst = (bf16_t*)(A.ws + WS_W + W_GM + (size_t)mat * WG_SZ + WG_WS); }
            else if (mat < 6) { src = A.in[I_PK1] + (size_t)(mat - 2) * 131072; dst = (bf16_t*)(A.ws + WS_W + W_PEER + (size_t)(mat - 2) * WP_SZ + WP_K1); }
            else              { src = A.in[I_PK2] + (size_t)(mat - 6) * 131072; dst = (bf16_t*)(A.ws + WS_W + W_PEER + (size_t)(mat - 6) * WP_SZ + WP_K2); }
            const f32x4 a = *(const f32x4*)(src + off), b = *(const f32x4*)(src + off + 4);
            u32x4 w; w.x = cvt_pk_bf16(a[0], a[1]); w.y = cvt_pk_bf16(a[2], a[3]); w.z = cvt_pk_bf16(b[0], b[1]); w.w = cvt_pk_bf16(b[2], b[3]);
            *(u32x4*)(dst + off) = w;
        }
        float* rope = (float*)(A.ws + WS_ROPE);
        for (int p = gthr; p < SEQ * 32; p += nthr) { const int l = p >> 5, i = p & 31; const float pos = (float)(i < 16 ? (l >> 6) : (l & 63));
            const float inv = powf(10000.f, -(float)(i & 15) / 16.f), ang = pos * inv; rope[p] = cosf(ang); rope[SEQ * 32 + p] = sinf(ang); }
    }
    {
        LAS float* scond = (LAS float*)lds;
        LAS float* red = scond + 5 * 1024;
        __syncthreads();
        for (int i = tid; i < 5 * 1024; i += NTHR) { const int m = i >> 10, k = i & 1023; const float c = m < 4 ? A.in[I_C][m * 1024 + k] : A.in[I_CCTX][k]; scond[i] = silu_f(c); }
        __syncthreads();
        float* MOD = (float*)(A.ws + WS_MOD);
        for (int item = blockIdx.x; item < 4 * 48; item += gridDim.x) {
            const int layer = item / 48, j0 = (item % 48) * 128; const int c4 = tid & 31, ksl = tid >> 5;
            f32x4 acc[5];
#pragma unroll
            for (int m = 0; m < 5; ++m) acc[m] = (f32x4){0.f, 0.f, 0.f, 0.f};
            const float* wp = A.in[I_ADAW] + ((size_t)layer * 1024 + ksl * 64) * 6144 + j0 + 4 * c4;
            for (int k = 0; k < 64; ++k) { const f32x4 w = *(const f32x4*)(wp + (size_t)k * 6144);
#pragma unroll
                for (int m = 0; m < 5; ++m) acc[m] += w * scond[m * 1024 + ksl * 64 + k]; }
#pragma unroll
            for (int m = 0; m < 5; ++m) *(LAS f32x4*)(red + (ksl * 5 + m) * 128 + 4 * c4) = acc[m];
            __syncthreads();
            for (int i = tid; i < 640; i += NTHR) { const int m = i >> 7, c = i & 127; float s = A.in[I_ADAB][layer * 6144 + j0 + c];
#pragma unroll
                for (int q = 0; q < 16; ++q) s += red[(q * 5 + m) * 128 + c];
                MOD[((size_t)layer * 5 + m) * 6144 + j0 + c] = s; }
            __syncthreads();
        }
    }
}

__device__ __forceinline__ void phase_norm_mod(const float* xl, const float* xc, float* cl, float* cc, const float* g, const float* modl, int sh_idx, bf16_t* H, int nrows) {
    const int tid_ = otid(); const int lane = tid_ & 63, gw = blockIdx.x * 8 + (tid_ >> 6), nw = gridDim.x * 8;
    f32x4 gv[4];
#pragma unroll
    for (int i = 0; i < 4; ++i) gv[i] = *(const f32x4*)(g + 256 * i + 4 * lane);
    for (int r = gw; r < nrows; r += nw) {
        const bool lat = r < NLAT; const float* xp = lat ? xl + (size_t)r * D : xc + (size_t)(r - NLAT) * D;
        f32x4 x[4]; float ss = 0.f;
#pragma unroll
        for (int i = 0; i < 4; ++i) { x[i] = *(const f32x4*)(xp + 256 * i + 4 * lane); ss += x[i][0] * x[i][0] + x[i][1] * x[i][1] + x[i][2] * x[i][2] + x[i][3] * x[i][3]; }
        if (cl) { float* cp = lat ? cl + (size_t)r * D : cc + (size_t)(r - NLAT) * D;
#pragma unroll
            for (int i = 0; i < 4; ++i) *(f32x4*)(cp + 256 * i + 4 * lane) = x[i]; }
        ss = wave_sum(ss); const float rstd = rsqrtf(ss * (1.f / 1024.f) + EPS);
        const float* mp = modl + (size_t)(lat ? (r >> 13) : 4) * 6144 + sh_idx * 1024;
#pragma unroll
        for (int i = 0; i < 4; ++i) { const f32x4 sh = *(const f32x4*)(mp + 256 * i + 4 * lane), sc = *(const f32x4*)(mp + 1024 + 256 * i + 4 * lane);
            const f32x4 hv = (x[i] * rstd) * gv[i] * (sc + 1.f) + sh;
            u32x2 w; w.x = cvt_pk_bf16(hv[0], hv[1]); w.y = cvt_pk_bf16(hv[2], hv[3]);
            *(u32x2*)(H + (size_t)r * D + 256 * i + 4 * lane) = w; }
    }
}
__device__ __forceinline__ void phase_final_norm(float* xl, const float* g) {
    const int tid_ = otid(); const int lane = tid_ & 63, gw = blockIdx.x * 8 + (tid_ >> 6), nw = gridDim.x * 8;
    f32x4 gv[4];
#pragma unroll
    for (int i = 0; i < 4; ++i) gv[i] = *(const f32x4*)(g + 256 * i + 4 * lane);
    for (int r = gw; r < NLAT; r += nw) {
        float* xp = xl + (size_t)r * D; f32x4 x[4]; float ss = 0.f;
#pragma unroll
        for (int i = 0; i < 4; ++i) { x[i] = *(const f32x4*)(xp + 256 * i + 4 * lane); ss += x[i][0] * x[i][0] + x[i][1] * x[i][1] + x[i][2] * x[i][2] + x[i][3] * x[i][3]; }
        ss = wave_sum(ss); const float rstd = rsqrtf(ss * (1.f / 1024.f) + EPS);
#pragma unroll
        for (int i = 0; i < 4; ++i) *(f32x4*)(xp + 256 * i + 4 * lane) = (x[i] * rstd) * gv[i];
    }
}

__device__ __forceinline__ void phase_conv(const Args& A, int li) {
    const bf16_t* PROJ = (const bf16_t*)(A.ws + WS_BIG);
    bf16_t* XS = (bf16_t*)(A.ws + WS_R2); bf16_t* BC = (bf16_t*)(A.ws + WS_R2 + R2_BC);
    const int tid = otid();
    if (tid < 384) {
        const int cg = tid % 192, half = tid / 192, c0 = 8 * cg;
        const float* cw = A.in[I_CONVW] + ((size_t)li * 1536 + c0) * 5; const float* cb = A.in[I_CONVB] + (size_t)li * 1536 + c0;
        float w[8][5], bia[8];
#pragma unroll
        for (int j = 0; j < 8; ++j) { bia[j] = cb[j];
#pragma unroll
            for (int k = 0; k < 5; ++k) w[j][k] = cw[j * 5 + k]; }
        for (int blk = blockIdx.x; blk < NROW / 64; blk += gridDim.x) {
            const int rbeg = blk * 64 + half * 32; int s0, s1;
            if (rbeg < NLAT) { s0 = rbeg & ~8191; s1 = s0 + 8192; } else { s0 = NLAT + ((rbeg - NLAT) & ~255); s1 = s0 + 256; }
            float win[5][8];
#define CONV_LD(dst, r) do { const int r_ = (r); if (r_ >= s0 && r_ < s1) { const u32x4 v_ = *(const u32x4*)(PROJ + (size_t)r_ * HYB_INP + C_XBC + c0); \
                _Pragma("unroll") for (int q_ = 0; q_ < 4; ++q_) { dst[2 * q_] = bflo(v_[q_]); dst[2 * q_ + 1] = bfhi(v_[q_]); } } \
                else { _Pragma("unroll") for (int q_ = 0; q_ < 8; ++q_) dst[q_] = 0.f; } } while (0)
            CONV_LD(win[0], rbeg - 2); CONV_LD(win[1], rbeg - 1); CONV_LD(win[2], rbeg); CONV_LD(win[3], rbeg + 1); CONV_LD(win[4], rbeg + 2);
            for (int r = rbeg; r < rbeg + 32; ++r) {
                float o[8];
#pragma unroll
                for (int j = 0; j < 8; ++j) { float s = bia[j];
#pragma unroll
                    for (int k = 0; k < 5; ++k) s += w[j][k] * win[k][j];
                    o[j] = silu_f(s); }
                u32x4 pk; pk.x = cvt_pk_bf16(o[0], o[1]); pk.y = cvt_pk_bf16(o[2], o[3]); pk.z = cvt_pk_bf16(o[4], o[5]); pk.w = cvt_pk_bf16(o[6], o[7]);
                if (c0 < 1024) *(u32x4*)(XS + (size_t)r * 1024 + c0) = pk; else *(u32x4*)(BC + (size_t)r * 512 + (c0 - 1024)) = pk;
#pragma unroll
                for (int k = 0; k < 4; ++k)
#pragma unroll
                    for (int j = 0; j < 8; ++j) win[k][j] = win[k + 1][j];
                CONV_LD(win[4], r + 3);
            }
#undef CONV_LD
        }
    }
    {
        const int lane = tid & 63, gw = blockIdx.x * 8 + (tid >> 6), nw = gridDim.x * 8;
        float* DT = (float*)(A.ws + WS_BIG + BIG_DT); float* RQ = (float*)(A.ws + WS_RSTD); float* RKV = RQ + NROW;
        unsigned char* KR = A.ws + WS_BIG + BIG_KR; const float* rope = (const float*)(A.ws + WS_ROPE);
        const float dtb = lane < 32 ? A.in[I_DTB][li * 32 + lane] : 0.f;
        for (int r = gw; r < NROW; r += nw) {
            const bf16_t* p = PROJ + (size_t)r * HYB_INP;
            if (lane < 32) DT[(size_t)lane * NROW + r] = softplus_f(bf2f(p[C_DT + (lane & 15)]) + dtb);
            { const unsigned* q = (const unsigned*)(p + C_CQ + 6 * lane); float ss = 0.f;
#pragma unroll
              for (int j = 0; j < 3; ++j) { const unsigned w = q[j]; const float a = bflo(w), b = bfhi(w); ss += a * a + b * b; }
              ss = wave_sum(ss); if (lane == 0) RQ[r] = rsqrtf(ss * (1.f / 384.f) + EPS); }
            { const u32x2 w = *(const u32x2*)(p + C_CKV + 4 * lane); const float a = bflo(w.x), b = bfhi(w.x), c = bflo(w.y), d = bfhi(w.y);
              float ss = a * a + b * b + c * c + d * d; ss = wave_sum(ss); if (lane == 0) RKV[r] = rsqrtf(ss * (1.f / 256.f) + EPS); }
            if (lane < 32) { const unsigned w = *(const unsigned*)(p + C_KR + 2 * lane); float x1 = bflo(w), x2 = bfhi(w); int b, key;
                if (r < NLAT) { const int l = r & 8191; const float c = rope[l * 32 + lane], s = rope[SEQ * 32 + l * 32 + lane];
                    const float o1 = x1 * c - x2 * s, o2 = x1 * s + x2 * c; x1 = o1; x2 = o2; b = r >> 13; key = 256 + l; }
                else { b = (r - NLAT) >> 8; key = (r - NLAT) & 255; }
                *(unsigned*)(KR + (size_t)(b * NKT + (key >> 6)) * 8192 + KRSWZ(key & 63, 4 * lane)) = cvt_pk_bf16(x1, x2); }
        }
    }
}

struct EpiQ {
    static constexpr bool PERM = true;
    bf16_t* Q; const float* rstd; const float* rope;
    __device__ __forceinline__ void operator()(const f32x4 (&acc)[2][2][4][2], const pg8::Unit& u, int wr, int wc, int fr, int fq) const {
        const bool lat = u.pm < 128;
        const int b = lat ? (u.pm >> 5) : ((u.pm - 128) >> 0), q0 = lat ? 256 + ((u.pm & 31) << 8) : 0;
        const bool isrope = u.pn >= 4;
#pragma unroll
        for (int ai = 0; ai < 2; ++ai) {
            const int rl = 128 * ai + 64 * wr + fr;
            const float* rsp = rstd + u.pm * 256 + rl;
            const float* rp = rope + (size_t)(((u.pm & 31) << 8) + rl) * 32;
#pragma unroll
            for (int bj = 0; bj < 2; ++bj) {
                const int c0 = u.pn * 256 + 128 * bj + 32 * wc + 8 * fq; int h, dcol;
                if (!isrope) { h = c0 >> 7; dcol = c0 & 127; } else { const int mq = c0 - 1024; h = mq >> 6; dcol = 128 + (mq & 63); }
                bf16_t* dst = Q + ((size_t)(b * 8 + h) * NKEY + q0 + rl) * 192 + dcol;
                const int ro = (dcol - 128) >> 1;
#pragma unroll
                for (int m = 0; m < 4; ++m) {
                    const float rs = rsp[16 * m] * QSCALE;
                    f32x4 v0 = acc[ai][bj][m][0] * rs, v1 = acc[ai][bj][m][1] * rs;
                    if (isrope && lat) { const f32x4 cs = *(const f32x4*)(rp + 16 * m * 32 + ro), sn = *(const f32x4*)(rp + SEQ * 32 + 16 * m * 32 + ro);
                        const f32x4 a0 = v0, a1 = v1;
                        v0[0] = a0[0] * cs[0] - a0[1] * sn[0]; v0[1] = a0[0] * sn[0] + a0[1] * cs[0]; v0[2] = a0[2] * cs[1] - a0[3] * sn[1]; v0[3] = a0[2] * sn[1] + a0[3] * cs[1];
                        v1[0] = a1[0] * cs[2] - a1[1] * sn[2]; v1[1] = a1[0] * sn[2] + a1[1] * cs[2]; v1[2] = a1[2] * cs[3] - a1[3] * sn[3]; v1[3] = a1[2] * sn[3] + a1[3] * cs[3]; }
                    u32x4 w; w.x = cvt_pk_bf16(v0[0], v0[1]); w.y = cvt_pk_bf16(v0[2], v0[3]); w.z = cvt_pk_bf16(v1[0], v1[1]); w.w = cvt_pk_bf16(v1[2], v1[3]);
                    *(u32x4*)(dst + 16 * m * 192) = w;
                    asm volatile("" ::: "memory");
                }
            }
        }
    }
};
struct EpiKV {
    static constexpr bool PERM = true;
    unsigned char* KN; unsigned char* V; const float* rstd;
    __device__ __forceinline__ void operator()(const f32x4 (&acc)[2][2][4][2], const pg8::Unit& u, int wr, int wc, int fr, int fq) const {
        const bool lat = u.pm < 128;
        const int b = lat ? (u.pm >> 5) : (u.pm - 128), t0 = lat ? 4 + ((u.pm & 31) << 2) : 0;
        const int dd = 32 * wc + 8 * fq;
        const int offK = fr * 256 + ((dd * 2) ^ ((fr & 7) << 4));
        const int offV = att::v_st(fr, dd);
#pragma unroll
        for (int ai = 0; ai < 2; ++ai) {
            const size_t tb = ((size_t)(b * 8 + u.pn) * NKT + t0 + 2 * ai + wr) * 16384;
            const float* rsp = rstd + u.pm * 256 + 128 * ai + 64 * wr + fr;
            unsigned char* kp = KN + tb + offK; unsigned char* vp = V + tb + offV;
#pragma unroll
            for (int m = 0; m < 4; ++m) {
                const float rs = rsp[16 * m];
#pragma unroll
                for (int bj = 0; bj < 2; ++bj) {
                    const f32x4 v0 = acc[ai][bj][m][0] * rs, v1 = acc[ai][bj][m][1] * rs;
                    u32x4 w; w.x = cvt_pk_bf16(v0[0], v0[1]); w.y = cvt_pk_bf16(v0[2], v0[3]); w.z = cvt_pk_bf16(v1[0], v1[1]); w.w = cvt_pk_bf16(v1[2], v1[3]);
                    if (bj == 0) *(u32x4*)(kp + m * 4096) = w; else *(u32x4*)(vp + m * 4096) = w;
                }
                asm volatile("" ::: "memory");
            }
        }
    }
};

__device__ __forceinline__ void phase_ssd_out(const Args& A, int li, int nrows) {
    const bf16_t* PROJ = (const bf16_t*)(A.ws + WS_BIG); const bf16_t* XS = (const bf16_t*)(A.ws + WS_R2);
    const bf16_t* Y0 = (const bf16_t*)(A.ws + WS_H); const bf16_t* Y1 = (const bf16_t*)(A.ws + WS_R3); bf16_t* CAT = (bf16_t*)(A.ws + WS_R3 + R3_CAT);
    const int tid_ = otid(); const int lane = tid_ & 63, gw = blockIdx.x * 8 + (tid_ >> 6), nw = gridDim.x * 8;
    const float dsk = A.in[I_SSDD][li * 16 + (lane >> 2)];
    float ng[16];
#pragma unroll
    for (int j = 0; j < 16; ++j) ng[j] = A.in[I_SSDNG][li * 1024 + 16 * lane + j];
    for (int r = gw; r < nrows; r += nw) {
        float v[16]; float ss = 0.f;
#pragma unroll
        for (int hh = 0; hh < 2; ++hh) {
            const u32x4 a = *(const u32x4*)(Y0 + (size_t)r * 1024 + 16 * lane + 8 * hh), b = *(const u32x4*)(Y1 + (size_t)r * 1024 + 16 * lane + 8 * hh);
            const u32x4 x = *(const u32x4*)(XS + (size_t)r * 1024 + 16 * lane + 8 * hh), z = *(const u32x4*)(PROJ + (size_t)r * HYB_INP + 16 * lane + 8 * hh);
#pragma unroll
            for (int q = 0; q < 4; ++q) {
                const float y0 = (bflo(a[q]) + bflo(b[q]) + dsk * bflo(x[q])) * silu_f(bflo(z[q])), y1 = (bfhi(a[q]) + bfhi(b[q]) + dsk * bfhi(x[q])) * silu_f(bfhi(z[q]));
                v[8 * hh + 2 * q] = y0; v[8 * hh + 2 * q + 1] = y1; ss += y0 * y0 + y1 * y1; }
        }
#pragma unroll
        for (int o = 16; o >= 1; o >>= 1) ss += __shfl_xor(ss, o);
        const float rstd = rsqrtf(ss * (1.f / 512.f) + EPS);
#pragma unroll
        for (int hh = 0; hh < 2; ++hh) { u32x4 w;
#pragma unroll
            for (int q = 0; q < 4; ++q) w[q] = cvt_pk_bf16(v[8 * hh + 2 * q] * rstd * ng[8 * hh + 2 * q], v[8 * hh + 2 * q + 1] * rstd * ng[8 * hh + 2 * q + 1]);
            *(u32x4*)(CAT + (size_t)r * 2048 + 16 * lane + 8 * hh) = w; }
    }
}

__device__ __forceinline__ void phase_ln_stats(const Args& A, int nrows) {
    const bf16_t* Gb = (const bf16_t*)(A.ws + WS_BIG); float* ST = (float*)(A.ws + WS_RSTD);
    const int tid_ = otid(); const int lane = tid_ & 63, gw = blockIdx.x * 8 + (tid_ >> 6), nw = gridDim.x * 8;
    for (int r = gw; r < nrows; r += nw) {
        float v[32]; float s = 0.f;
#pragma unroll
        for (int j = 0; j < 4; ++j) { const u32x4 w = *(const u32x4*)(Gb + (size_t)r * 4096 + 2048 + 512 * j + 8 * lane);
#pragma unroll
            for (int q = 0; q < 4; ++q) { v[8 * j + 2 * q] = bflo(w[q]); v[8 * j + 2 * q + 1] = bfhi(w[q]); s += v[8 * j + 2 * q] + v[8 * j + 2 * q + 1]; } }
        s = wave_sum(s); const float mu = s * (1.f / 2048.f); float q2 = 0.f;
#pragma unroll
        for (int j = 0; j < 32; ++j) { const float dd = v[j] - mu; q2 += dd * dd; }
        q2 = wave_sum(q2);
        if (lane == 0) { ST[r] = mu; ST[NROW + r] = rsqrtf(q2 * (1.f / 2048.f) + EPS); }
    }
}
__device__ __forceinline__ void phase_spatial(const Args& A, int gi, int nrows, LAS unsigned char* lds) {
    const bf16_t* Gb = (const bf16_t*)(A.ws + WS_BIG); const float* ST = (const float*)(A.ws + WS_RSTD); bf16_t* Ab = (bf16_t*)(A.ws + WS_R1);
    const bf16_t* WSg = (const bf16_t*)(A.ws + WS_W + W_GM + (size_t)gi * WG_SZ + WG_WS);
    const float* lng = A.in[I_GLNG] + (size_t)gi * 2048; const float* lnb = A.in[I_GLNB] + (size_t)gi * 2048; const float* bs = A.in[I_GBS] + (size_t)gi * 1024;
    const int tid = otid(), wid = tid >> 6, lane = tid & 63, r32 = lane & 31, hi = lane >> 5, tb = wid & 3, dh = wid >> 2;
    const int ldsaddr = (int)(unsigned)(uintptr_t)lds;
    for (int unit = blockIdx.x; unit < (nrows / 128) * 8; unit += gridDim.x) {
        const int cb = unit >> 3, gg = unit & 7, r0 = cb * 128;
        __syncthreads();
#pragma unroll
        for (int j = 0; j < 8; ++j) { const int idx = tid + 512 * j, s = idx >> 5, dd = (idx & 31) * 8;
            const u32x4 w = *(const u32x4*)(Gb + (size_t)(r0 + s) * 4096 + 2048 + 256 * gg + dd);
            const float mu = ST[r0 + s], rs = ST[NROW + r0 + s];
            const f32x4 g0 = *(const f32x4*)(lng + 256 * gg + dd), g1 = *(const f32x4*)(lng + 256 * gg + dd + 4), b0 = *(const f32x4*)(lnb + 256 * gg + dd), b1 = *(const f32x4*)(lnb + 256 * gg + dd + 4);
            u32x4 o;
            o.x = cvt_pk_bf16((bflo(w.x) - mu) * rs * g0[0] + b0[0], (bfhi(w.x) - mu) * rs * g0[1] + b0[1]); o.y = cvt_pk_bf16((bflo(w.y) - mu) * rs * g0[2] + b0[2], (bfhi(w.y) - mu) * rs * g0[3] + b0[3]);
            o.z = cvt_pk_bf16((bflo(w.z) - mu) * rs * g1[0] + b1[0], (bfhi(w.z) - mu) * rs * g1[1] + b1[1]); o.w = cvt_pk_bf16((bflo(w.w) - mu) * rs * g1[2] + b1[2], (bfhi(w.w) - mu) * rs * g1[3] + b1[3]);
            *(LAS u32x4*)(lds + ((s >> 6) * 2 + (dd >> 7)) * 16384 + att::v_st(s & 63, dd & 127)) = o; }
        bf16x8 pa[8];
#pragma unroll
        for (int ks = 0; ks < 8; ++ks) pa[ks] = *(const bf16x8*)(WSg + ((size_t)gg * 128 + 32 * tb + r32) * 128 + 16 * ks + 8 * hi);
        __syncthreads();
        f32x16 o[4] = {};
#define SP_PV(D0, vbase, p0, p1, p2, p3) do { \
            const s16x4 l0 = att::tr_read<att::v_rd_off(D0, 0, 0)>(vbase), h0 = att::tr_read<att::v_rd_off(D0, 0, 1)>(vbase), l1 = att::tr_read<att::v_rd_off(D0, 1, 0)>(vbase), h1 = att::tr_read<att::v_rd_off(D0, 1, 1)>(vbase); \
            const s16x4 l2 = att::tr_read<att::v_rd_off(D0, 2, 0)>(vbase), h2 = att::tr_read<att::v_rd_off(D0, 2, 1)>(vbase), l3 = att::tr_read<att::v_rd_off(D0, 3, 0)>(vbase), h3 = att::tr_read<att::v_rd_off(D0, 3, 1)>(vbase); \
            asm volatile("s_waitcnt lgkmcnt(0)" ::: "memory"); __builtin_amdgcn_sched_barrier(0); \
            o[D0] = __builtin_amdgcn_mfma_f32_32x32x16_bf16((bf16x8){l0[0], l0[1], l0[2], l0[3], h0[0], h0[1], h0[2], h0[3]}, p0, o[D0], 0, 0, 0); \
            o[D0] = __builtin_amdgcn_mfma_f32_32x32x16_bf16((bf16x8){l1[0], l1[1], l1[2], l1[3], h1[0], h1[1], h1[2], h1[3]}, p1, o[D0], 0, 0, 0); \
            o[D0] = __builtin_amdgcn_mfma_f32_32x32x16_bf16((bf16x8){l2[0], l2[1], l2[2], l2[3], h2[0], h2[1], h2[2], h2[3]}, p2, o[D0], 0, 0, 0); \
            o[D0] = __builtin_amdgcn_mfma_f32_32x32x16_bf16((bf16x8){l3[0], l3[1], l3[2], l3[3], h3[0], h3[1], h3[2], h3[3]}, p3, o[D0], 0, 0, 0); } while (0)
        { const int vb0 = ldsaddr + (0 * 2 + dh) * 16384 + att::v_rd_base(lane), vb1 = ldsaddr + (1 * 2 + dh) * 16384 + att::v_rd_base(lane);
          SP_PV(0, vb0, pa[0], pa[1], pa[2], pa[3]); SP_PV(1, vb0, pa[0], pa[1], pa[2], pa[3]); SP_PV(2, vb0, pa[0], pa[1], pa[2], pa[3]); SP_PV(3, vb0, pa[0], pa[1], pa[2], pa[3]);
          SP_PV(0, vb1, pa[4], pa[5], pa[6], pa[7]); SP_PV(1, vb1, pa[4], pa[5], pa[6], pa[7]); SP_PV(2, vb1, pa[4], pa[5], pa[6], pa[7]); SP_PV(3, vb1, pa[4], pa[5], pa[6], pa[7]); }
#undef SP_PV
        { const int t = 32 * tb + r32, row = r0 + t; const float bsv = bs[gg * 128 + t];
          const bf16_t* up = Gb + (size_t)row * 4096 + 256 * gg + 128 * dh + 4 * hi; bf16_t* ap = Ab + (size_t)row * 2048 + 256 * gg + 128 * dh + 4 * hi;
#pragma unroll
          for (int d0 = 0; d0 < 4; ++d0)
#pragma unroll
              for (int k = 0; k < 4; ++k) {
                  const u32x2 uu = *(const u32x2*)(up + 32 * d0 + 8 * k);
                  u32x2 w; w.x = cvt_pk_bf16(bflo(uu.x) * (o[d0][4 * k] + bsv), bfhi(uu.x) * (o[d0][4 * k + 1] + bsv)); w.y = cvt_pk_bf16(bflo(uu.y) * (o[d0][4 * k + 2] + bsv), bfhi(uu.y) * (o[d0][4 * k + 3] + bsv));
                  *(u32x2*)(ap + 32 * d0 + 8 * k) = w; } }
    }
}

constexpr int NSL = 8, SW = 1024 / NSL;
constexpr size_t TAB8_HALF = (size_t)NEXP * 1024, TAB_SCL = 2 * TAB8_HALF;
constexpr float HS = 4.f;
__device__ __forceinline__ unsigned pk4_fp8(float a, float b, float c, float d) { int w = 0; w = __builtin_amdgcn_cvt_pk_fp8_f32(a, b, w, false); w = __builtin_amdgcn_cvt_pk_fp8_f32(c, d, w, true); return (unsigned)w; }
__device__ __forceinline__ void phase_tabcvt(const Args& A, int layer) {
    const int tid_ = otid(); const int lane = tid_ & 63, gw = blockIdx.x * 8 + (tid_ >> 6), nw = gridDim.x * 8;
    float* SCL = (float*)(A.ws + WS_TAB + TAB_SCL);
    for (int r = gw; r < 2 * NEXP; r += nw) {
        const int tab = r >> 14, e = r & (NEXP - 1);
        const float* src = (tab ? A.in[I_PV] : A.in[I_PU]) + ((size_t)layer * NEXP + e) * 1024 + 16 * lane;
        f32x4 v[4]; float am = 0.f;
#pragma unroll
        for (int i = 0; i < 4; ++i) { v[i] = *(const f32x4*)(src + 4 * i); am = fmaxf(am, fmaxf(fmaxf(fabsf(v[i][0]), fabsf(v[i][1])), fmaxf(fabsf(v[i][2]), fabsf(v[i][3])))); }
#pragma unroll
        for (int o = 32; o >= 1; o >>= 1) am = fmaxf(am, __shfl_xor(am, o));
        float sc = 1.f; if (am > 0.f) { int ex; (void)frexpf(448.f / am, &ex); sc = ldexpf(1.f, ex - 1); }
        if (lane == 0) SCL[tab * NEXP + e] = 1.f / sc;
        u32x4 w;
#pragma unroll
        for (int i = 0; i < 4; ++i) w[i] = pk4_fp8(v[i][0] * sc, v[i][1] * sc, v[i][2] * sc, v[i][3] * sc);
        *(u32x4*)(A.ws + WS_TAB + (size_t)tab * TAB8_HALF + ((size_t)(lane >> 3) * NEXP + e) * SW + 16 * (lane & 7)) = w;
    }
}
#define CASD(a, b) do { const float hi_ = fmaxf(a, b), lo_ = fminf(a, b); a = hi_; b = lo_; } while (0)
__device__ __forceinline__ void sort16(float (&k)[16]) {
#pragma unroll
    for (int sz = 2; sz <= 16; sz <<= 1)
#pragma unroll
        for (int j = sz >> 1; j > 0; j >>= 1)
#pragma unroll
            for (int i = 0; i < 16; ++i) { const int l = i ^ j; if (l > i) { if ((i & sz) == 0 || sz == 16) CASD(k[i], k[l]); else CASD(k[l], k[i]); } }
}
__device__ __forceinline__ void bmerge16(float (&k)[16]) {
#pragma unroll
    for (int j = 8; j > 0; j >>= 1)
#pragma unroll
        for (int i = 0; i < 16; ++i) { const int l = i ^ j; if (l > i) CASD(k[i], k[l]); }
}
__device__ __forceinline__ void merge_top16(float (&a)[16], const float (&b)[16]) {
#pragma unroll
    for (int i = 0; i < 16; ++i) a[i] = fmaxf(a[i], b[15 - i]);
    bmerge16(a);
}
__device__ __forceinline__ void xmerge_top16(float (&a)[16], int mask) {
    float t[16];
#pragma unroll
    for (int i = 0; i < 16; ++i) t[i] = __shfl_xor(a[15 - i], mask);
#pragma unroll
    for (int i = 0; i < 16; ++i) a[i] = fmaxf(a[i], t[i]);
    bmerge16(a);
}
__device__ __forceinline__ void phase_topk(const Args& A, int layer, int nrows, LAS unsigned char* lds) {
    const bf16_t* QP = (const bf16_t*)(A.ws + WS_BIG); int* IDX = (int*)(A.ws + WS_R2); float* GATE = (float*)(A.ws + WS_R2 + R2_GATE);
    const int tid = otid(), wid = tid >> 6, lane = tid & 63, fr = lane & 15, fq = lane >> 4;
    LAS unsigned* scr = (LAS unsigned*)(lds + 2 * 34816) + wid * 512 + fr * 32;
    for (int unit = blockIdx.x; unit < (nrows / 128) * 8; unit += gridDim.x) {
        const int h = unit & 7, r0 = (unit >> 3) * 128;
        __syncthreads();
        { const bf16_t* k1 = (const bf16_t*)(A.ws + WS_W + W_PEER + (size_t)layer * WP_SZ + WP_K1) + (size_t)h * 16384;
#pragma unroll
          for (int j = 0; j < 8; ++j) { const int idx = tid + 512 * j, half = idx >> 11, rem = idx & 2047, key = rem >> 4, c8 = rem & 15;
              const u32x4 w = *(const u32x4*)(k1 + (size_t)half * 8 * 16384 + key * 128 + 8 * c8);
              *(LAS u32x4*)(lds + half * 34816 + key * 272 + c8 * 16) = w; } }
        __syncthreads();
        const int tok = r0 + 16 * wid + fr;
        float top[2][16];
#pragma unroll
        for (int half = 0; half < 2; ++half) {
            bf16x8 qf[4];
#pragma unroll
            for (int ks = 0; ks < 4; ++ks) qf[ks] = *(const bf16x8*)(QP + (size_t)tok * 2048 + 256 * h + 128 * half + 32 * ks + 8 * fq);
            float loc[16];
#pragma unroll
            for (int grp = 0; grp < 2; ++grp) {
                float kk[16];
#pragma unroll
                for (int nbb = 0; nbb < 4; ++nbb) { const int nb = 4 * grp + nbb; f32x4 acc = {0.f, 0.f, 0.f, 0.f};
#pragma unroll
                    for (int ks = 0; ks < 4; ++ks) { const bf16x8 kf = *(const LAS bf16x8*)(lds + half * 34816 + (16 * nb + fr) * 272 + (32 * ks + 8 * fq) * 2);
                        acc = __builtin_amdgcn_mfma_f32_16x16x32_bf16(kf, qf[ks], acc, 0, 0, 0); }
#pragma unroll
                    for (int i = 0; i < 4; ++i) { const unsigned code = 127u - (unsigned)(16 * nb + 4 * fq + i); kk[4 * nbb + i] = __uint_as_float((__float_as_uint(acc[i]) & ~127u) | code); } }
                sort16(kk);
                if (grp == 0) {
#pragma unroll
                    for (int i = 0; i < 16; ++i) loc[i] = kk[i];
                } else merge_top16(loc, kk);
            }
            xmerge_top16(loc, 16); xmerge_top16(loc, 32);
#pragma unroll
            for (int i = 0; i < 16; ++i) top[half][i] = loc[i];
        }
        if (fq < 2) {
#pragma unroll
            for (int i = 0; i < 16; ++i) scr[16 * fq + i] = __float_as_uint(fq == 0 ? top[0][i] : top[1][i]); }
        float fin[16];
#pragma unroll
        for (int aa = 0; aa < 4; ++aa) {
            const float va_k = fq == 0 ? top[0][aa] : fq == 1 ? top[0][4 + aa] : fq == 2 ? top[0][8 + aa] : top[0][12 + aa];
            const float va = __uint_as_float(__float_as_uint(va_k) & ~127u);
            float c[16];
#pragma unroll
            for (int bb = 0; bb < 16; ++bb) { const float s = va + __uint_as_float(__float_as_uint(top[1][bb]) & ~127u);
                c[bb] = __uint_as_float((__float_as_uint(s) & ~255u) | (255u - (unsigned)((4 * fq + aa) * 16 + bb))); }
            if (aa == 0) {
#pragma unroll
                for (int i = 0; i < 16; ++i) fin[i] = c[i];
            } else merge_top16(fin, c);
        }
        xmerge_top16(fin, 16); xmerge_top16(fin, 32);
        float ev[16], es = 0.f; const float mx = __uint_as_float(__float_as_uint(fin[0]) & ~255u);
#pragma unroll
        for (int i = 0; i < 16; ++i) { ev[i] = __expf(__uint_as_float(__float_as_uint(fin[i]) & ~255u) - mx); es += ev[i]; }
        const float inv = 1.f / es;
        asm volatile("s_waitcnt lgkmcnt(0)" ::: "memory");
        int oi[4]; float og[4];
#pragma unroll
        for (int kq = 0; kq < 4; ++kq) {
            const float fk = fq == 0 ? fin[kq] : fq == 1 ? fin[4 + kq] : fq == 2 ? fin[8 + kq] : fin[12 + kq];
            const float fe = fq == 0 ? ev[kq] : fq == 1 ? ev[4 + kq] : fq == 2 ? ev[8 + kq] : ev[12 + kq];
            const unsigned code = 255u - (__float_as_uint(fk) & 255u), a = code >> 4, bq = code & 15u;
            const unsigned i1 = 127u - (scr[a] & 127u), i2 = 127u - (scr[16 + bq] & 127u);
            oi[kq] = (int)(i1 * 128u + i2); og[kq] = fe * inv; }
        *(int4*)(IDX + (size_t)tok * 128 + 16 * h + 4 * fq) = make_int4(oi[0], oi[1], oi[2], oi[3]);
        *(f32x4*)(GATE + (size_t)tok * 128 + 16 * h + 4 * fq) = (f32x4){og[0], og[1], og[2], og[3]};
    }
}
struct PeerSched {
    int x0, rank, nloc, nblk, nown; unsigned orphan;
    __device__ __forceinline__ void init(const Args& A, int nrows, LAS unsigned char* smem) {
        unsigned* ctl = (unsigned*)(A.ws + WS_CTL);
        x0 = (int)(xb_xcc_id() & 7u); rank = __builtin_amdgcn_readfirstlane((int)((LAS unsigned*)smem)[8]); nblk = nrows / 64;
        unsigned cached = __builtin_amdgcn_readfirstlane(((LAS unsigned*)smem)[9]);
        if (cached == 0u) { unsigned orph = 0u, nl = 1u;
            for (int j = 0; j < 8; ++j) { unsigned c = xb_ld(&ctl[XB_XCNT(j)]) + xb_ld(&ctl[XB_XCNT(j + 8)]); c = __builtin_amdgcn_readfirstlane(c); if (c == 0u) orph |= 1u << j; if (j == x0) nl = c; }
            cached = (nl << 8) | orph; __syncthreads(); if (threadIdx.x == 0) ((LAS unsigned*)smem)[9] = cached; __syncthreads(); }
        nloc = (int)(cached >> 8); orphan = cached & 0xffu;
        const int tot = (NSL / 8) * nblk; nown = rank < tot ? (tot - rank + nloc - 1) / nloc : 0;
    }
    __device__ __forceinline__ bool item(int j, int& sl, int& blk) const {
        if (j < nown) { const int i = rank + j * nloc; sl = x0 + 8 * (i / nblk); blk = i % nblk; return true; }
        int jj = j - nown; const int tot = (NSL / 8) * nblk, per = ((int)gridDim.x > tot) ? 1 : 0; (void)per;
        for (int o = 0; o < 8; ++o) if ((orphan >> o) & 1u) { const int cnt = ((int)blockIdx.x < tot) ? (tot - (int)blockIdx.x + (int)gridDim.x - 1) / (int)gridDim.x : 0;
            if (jj < cnt) { const int i = (int)blockIdx.x + jj * (int)gridDim.x; sl = o + 8 * (i / nblk); blk = i % nblk; return true; } jj -= cnt; }
        return false;
    }
};
template <class LD, class ST, class PR>
__device__ __forceinline__ void peer_items(const PeerSched& S, LD ld, ST st, PR pr) {
    int sl, blk, sln, blkn, j = 0, buf = 0; bool have = S.item(0, sl, blk);
    if (have) { ld(sl, blk, 0); st(0); }
    while (have) {
        const bool haven = S.item(j + 1, sln, blkn);
        asm volatile("s_waitcnt vmcnt(0)" ::: "memory");
        __syncthreads();
        if (haven) ld(sln, blkn, buf ^ 1);
        pr(sl, blk, buf);
        if (haven) st(buf ^ 1);
        sl = sln; blk = blkn; have = haven; buf ^= 1; ++j;
    }
    __syncthreads();
}
#ifndef MK_UVAR
#define MK_UVAR 0
#endif
__device__ __forceinline__ void phase_peer_u(const Args& A, int layer, int nrows, LAS unsigned char* smem, int rep) {
    const int var = rep ? MK_UVAR : 0;
    const bf16_t* H = (const bf16_t*)(A.ws + WS_H); const int* IDX = (const int*)(A.ws + WS_R2); float* PART = var ? (float*)(A.ws + WS_R1) : (float*)(A.ws + WS_BIG + BIG_PART);
    const unsigned char* U = A.ws + WS_TAB;
    LAS unsigned char* lds = smem + LDS_BASE;
    constexpr int BUF = 32768 + 64 * SW;
    const int tid = otid(), wid = tid >> 6, lane = tid & 63, fr = lane & 15, fq = lane >> 4;
    PeerSched S; S.init(A, nrows, smem);
    u32x4 ri[4], rh[2];
    peer_items(S,
        [&](int sl, int blk, int) {
#pragma unroll
            for (int i = 0; i < 4; ++i) ri[i] = *(const u32x4*)(IDX + (size_t)blk * 64 * 128 + 4 * (tid + 512 * i));
            const bf16_t* hp = H + (size_t)(blk * 64 + (tid >> 3)) * 1024 + SW * sl + 16 * (tid & 7);
            rh[0] = *(const u32x4*)hp; rh[1] = *(const u32x4*)(hp + 8); },
        [&](int buf) {
#pragma unroll
            for (int i = 0; i < 4; ++i) *(LAS u32x4*)(lds + buf * BUF + 16 * (tid + 512 * i)) = ri[i];
            u32x4 w;
#pragma unroll
            for (int i = 0; i < 2; ++i) { w[2 * i] = pk4_fp8(bflo(rh[i].x) * HS, bfhi(rh[i].x) * HS, bflo(rh[i].y) * HS, bfhi(rh[i].y) * HS);
                                          w[2 * i + 1] = pk4_fp8(bflo(rh[i].z) * HS, bfhi(rh[i].z) * HS, bflo(rh[i].w) * HS, bfhi(rh[i].w) * HS); }
            *(LAS u32x4*)(lds + buf * BUF + 32768 + 16 * tid) = w; },
        [&](int sl, int blk, int buf) {
            const unsigned char* ub = U + (size_t)sl * NEXP * SW + 32 * fq;
            const LAS int* ib = (const LAS int*)(lds + buf * BUF) + (wid * 8) * 128 + fr; const LAS unsigned char* hb = lds + buf * BUF + 32768 + (wid * 8) * SW + 32 * fq;
            u32x4 uf[2][8][2];
#define PU_ROWS(T, t) do { _Pragma("unroll") for (int g = 0; g < 8; ++g) { int e_ = ib[(t) * 128 + 16 * g]; if (var == 3) e_ &= 63; \
                _Pragma("unroll") for (int hh = 0; hh < 2; ++hh) { if (var == 4) uf[T][g][hh] = (u32x4){(unsigned)e_, (unsigned)e_, 0u, 0u}; else uf[T][g][hh] = *(const u32x4*)(ub + (size_t)e_ * SW + 16 * hh); } } } while (0)
            PU_ROWS(0, 0);
#define PU_TOKEN(T, t) do { \
                const u32x4 h0 = *(const LAS u32x4*)(hb + (t) * SW), h1 = *(const LAS u32x4*)(hb + (t) * SW + 16); \
                const long ha0 = (long)(((unsigned long long)h0.y << 32) | h0.x), ha1 = (long)(((unsigned long long)h0.w << 32) | h0.z), ha2 = (long)(((unsigned long long)h1.y << 32) | h1.x), ha3 = (long)(((unsigned long long)h1.w << 32) | h1.z); \
                float v0 = 0.f, v1 = 0.f; \
                _Pragma("unroll") for (int g = 0; g < 8; ++g) { f32x4 acc = {0.f, 0.f, 0.f, 0.f}; const u32x4 ua = uf[T][g][0], ub2 = uf[T][g][1]; \
                    acc = __builtin_amdgcn_mfma_f32_16x16x32_fp8_fp8(ha0, (long)(((unsigned long long)ua.y << 32) | ua.x), acc, 0, 0, 0); \
                    acc = __builtin_amdgcn_mfma_f32_16x16x32_fp8_fp8(ha1, (long)(((unsigned long long)ua.w << 32) | ua.z), acc, 0, 0, 0); \
                    acc = __builtin_amdgcn_mfma_f32_16x16x32_fp8_fp8(ha2, (long)(((unsigned long long)ub2.y << 32) | ub2.x), acc, 0, 0, 0); \
                    acc = __builtin_amdgcn_mfma_f32_16x16x32_fp8_fp8(ha3, (long)(((unsigned long long)ub2.w << 32) | ub2.z), acc, 0, 0, 0); \
                    if (g < 4) v0 = fq == g ? acc[0] : v0; else v1 = fq == g - 4 ? acc[0] : v1; }        \
                float* pp = PART + ((size_t)sl * NROW + blk * 64 + wid * 8 + (t)) * 128 + 16 * fq + fr; \
                pp[0] = v0; pp[64] = v1; } while (0)
#pragma unroll 1
            for (int tp = 0; tp < 4; ++tp) {
                PU_ROWS(1, 2 * tp + 1);
                __builtin_amdgcn_sched_barrier(0);
                PU_TOKEN(0, 2 * tp);
                __builtin_amdgcn_sched_barrier(0);
                if (tp + 1 < 4) PU_ROWS(0, 2 * tp + 2);
                __builtin_amdgcn_sched_barrier(0);
                PU_TOKEN(1, 2 * tp + 1);
                __builtin_amdgcn_sched_barrier(0);
            }
#undef PU_TOKEN
#undef PU_ROWS
        });
}
__device__ __forceinline__ void phase_coef(const Args& A, int nrows) {
    const float* PART = (const float*)(A.ws + WS_BIG + BIG_PART); const float* GATE = (const float*)(A.ws + WS_R2 + R2_GATE); float* COEF = (float*)(A.ws + WS_R2 + R2_COEF);
    const int* IDX = (const int*)(A.ws + WS_R2); const float* SCL = (const float*)(A.ws + WS_TAB + TAB_SCL);
    const int gthr = blockIdx.x * NTHR + otid(), nthr = gridDim.x * NTHR;
    for (int p = gthr; p < nrows * 32; p += nthr) {
        f32x4 s = {0.f, 0.f, 0.f, 0.f};
#pragma unroll
        for (int x = 0; x < NSL; ++x) s += *(const f32x4*)(PART + (size_t)x * NROW * 128 + 4 * p);
        const i32x4 e = *(const i32x4*)(IDX + 4 * p); const f32x4 gt = *(const f32x4*)(GATE + 4 * p);
        const f32x4 su = {SCL[e.x], SCL[e.y], SCL[e.z], SCL[e.w]}, sv = {SCL[NEXP + e.x], SCL[NEXP + e.y], SCL[NEXP + e.z], SCL[NEXP + e.w]};
        const f32x4 a = s * (1.f / HS) * su; const f32x2 g0 = gelu_pk((f32x2){a[0], a[1]}), g1 = gelu_pk((f32x2){a[2], a[3]});
        *(f32x4*)(COEF + 4 * p) = gt * (f32x4){g0.x, g0.y, g1.x, g1.y} * sv; }

}
__device__ __forceinline__ void phase_peer_v(const Args& A, int layer, int nrows, LAS unsigned char* smem, int rep) {
    const int* IDX = (const int*)(A.ws + WS_R2); const float* COEF = (const float*)(A.ws + WS_R2 + R2_COEF);
    const unsigned char* V = A.ws + WS_TAB + TAB8_HALF; const float* MODL = (const float*)(A.ws + WS_MOD) + (size_t)layer * 5 * 6144 + 5 * 1024;
    float* XC = (float*)(A.ws + WS_XC);
    LAS unsigned char* lds = smem + LDS_BASE;
    constexpr int BUF = 65536;
    const int tid = otid(), wid = tid >> 6, lane = tid & 63, m = lane & 7, tk = lane >> 3;
    PeerSched S; S.init(A, nrows, smem);
    const int wu = __builtin_amdgcn_readfirstlane(wid);
    peer_items(S,
        [&](int sl, int blk, int buf) {
#pragma unroll
            for (int i = 0; i < 4; ++i) {
                __builtin_amdgcn_global_load_lds((const unsigned*)(IDX + (size_t)blk * 64 * 128 + 256 * (wu + 8 * i) + 4 * lane), (LAS unsigned*)(lds + buf * BUF + 1024 * (wu + 8 * i)), 16, 0, 0);
                __builtin_amdgcn_global_load_lds((const unsigned*)(COEF + (size_t)blk * 64 * 128 + 256 * (wu + 8 * i) + 4 * lane), (LAS unsigned*)(lds + buf * BUF + 32768 + 1024 * (wu + 8 * i)), 16, 0, 0); } },
        [&](int buf) { },
        [&](int sl, int blk, int buf) {
            const unsigned char* vb = V + (size_t)sl * NEXP * SW + 16 * m;
            const int tokl = wid * 8 + tk, tok = blk * 64 + tokl; const bool lat = tok < NLAT;
            const LAS int* ib = (const LAS int*)(lds + buf * BUF) + tokl * 128; const LAS float* cb = (const LAS float*)(lds + buf * BUF + 32768) + tokl * 128;
            float* xp = (lat ? A.out + (size_t)tok * D : XC + (size_t)(tok - NLAT) * D) + SW * sl + 16 * m;
            f32x4 xr[4];
#pragma unroll
            for (int j = 0; j < 4; ++j) xr[j] = *(f32x4*)(xp + 4 * j);
            float acc[16];
#pragma unroll
            for (int j = 0; j < 16; ++j) acc[j] = 0.f;
            u32x4 vv[2][8];
#define PV_ROWS(T, c) do { const i32x4 e0_ = *(const LAS i32x4*)(ib + 8 * (c)), e1_ = *(const LAS i32x4*)(ib + 8 * (c) + 4); \
                vv[T][0] = *(const u32x4*)(vb + (size_t)e0_.x * SW); vv[T][1] = *(const u32x4*)(vb + (size_t)e0_.y * SW); vv[T][2] = *(const u32x4*)(vb + (size_t)e0_.z * SW); vv[T][3] = *(const u32x4*)(vb + (size_t)e0_.w * SW); \
                vv[T][4] = *(const u32x4*)(vb + (size_t)e1_.x * SW); vv[T][5] = *(const u32x4*)(vb + (size_t)e1_.y * SW); vv[T][6] = *(const u32x4*)(vb + (size_t)e1_.z * SW); vv[T][7] = *(const u32x4*)(vb + (size_t)e1_.w * SW); } while (0)
#define PV_FMA(T, c) do { const f32x4 c0_ = *(const LAS f32x4*)(cb + 8 * (c)), c1_ = *(const LAS f32x4*)(cb + 8 * (c) + 4); \
                _Pragma("unroll") for (int k = 0; k < 8; ++k) { const float cf = k < 4 ? c0_[k & 3] : c1_[k & 3]; \
                    _Pragma("unroll") for (int j = 0; j < 4; ++j) { const int w = (int)vv[T][k][j]; \
                        const f32x2 lo = __builtin_amdgcn_cvt_pk_f32_fp8(w, false), hi = __builtin_amdgcn_cvt_pk_f32_fp8(w, true); \
                        acc[4 * j] += cf * lo.x; acc[4 * j + 1] += cf * lo.y; acc[4 * j + 2] += cf * hi.x; acc[4 * j + 3] += cf * hi.y; } } } while (0)
            PV_ROWS(0, 0);
#pragma unroll 1
            for (int c = 0; c < 16; c += 2) {
                PV_ROWS(1, c + 1);
                __builtin_amdgcn_sched_barrier(0);
                PV_FMA(0, c);
                __builtin_amdgcn_sched_barrier(0);
                if (c + 2 < 16) PV_ROWS(0, c + 2);
                __builtin_amdgcn_sched_barrier(0);
                PV_FMA(1, c + 1);
                __builtin_amdgcn_sched_barrier(0);
            }
#undef PV_ROWS
#undef PV_FMA
            const float* gp = MODL + (size_t)(lat ? (tok >> 13) : 4) * 6144 + SW * sl + 16 * m;
#pragma unroll
            for (int j = 0; j < 4; ++j) { const f32x4 g = *(const f32x4*)(gp + 4 * j);
                *(f32x4*)(xp + 4 * j) = xr[j] + g * (f32x4){acc[4 * j], acc[4 * j + 1], acc[4 * j + 2], acc[4 * j + 3]}; }
        });
}

#ifndef MK_PER_PHASE
#define MK_PER_PHASE 0
#endif
__device__ __forceinline__ int nr_in(int L) { return L <= 2 ? NROW : NLAT; }
__device__ __forceinline__ int nr_out(int L) { return L <= 1 ? NROW : NLAT; }

__global__ void __launch_bounds__(NTHR, 2) fwd(Args A) {
    extern __shared__ __attribute__((aligned(256))) unsigned char smem_raw[];
    LAS unsigned char* smem = (LAS unsigned char*)smem_raw;
    LAS unsigned char* lds = smem + LDS_BASE;
    const int tid = otid();
    if (tid < 64) ((LAS unsigned*)smem)[tid] = 0u;
    __syncthreads();
    XcdBarrier bar = xcd_barrier_post((unsigned*)(A.ws + WS_CTL), (volatile LAS unsigned*)smem);
    if (tid == 0) ((LAS unsigned*)smem)[8] = atomicAdd((unsigned*)(A.ws + WS_CTL) + CW_RANK + 32 * (xb_xcc_id() & 7u), 1u);
    __syncthreads();
    bool need_bar = false;
    const int lo = A.ph_lo, hi = A.ph_hi;
#ifndef PHMASK
#define PHMASK 0xffffffffu
#endif
#define SITE(k) if constexpr (((PHMASK) >> (k)) & 1u)
#ifndef MK_REPEAT_SITE
#define MK_REPEAT_SITE -1
#endif
#define REP(k) for (int rep = 0; rep < ((k) == (MK_REPEAT_SITE) ? 2 : 1); ++rep)
#define PH(id) if ([&]() -> bool { if ((id) < lo || (id) >= hi) return false; if (need_bar) xcd_barrier(bar); need_bar = true; return true; }())
    unsigned char* ws = A.ws;
    float* XL = A.out; float* XC = (float*)(ws + WS_XC);
    bf16_t* H = (bf16_t*)(ws + WS_H);
    const float* MOD = (const float*)(ws + WS_MOD);

    SITE(0) PH(0) { phase_prologue(A, lds); }
    SITE(1) PH(1) { phase_norm_mod(A.in[I_X], A.in[I_CTX], XL, XC, A.in[I_N1G], MOD, 0, H, NROW); }
    for (int L = 0; L < DEPTH; ++L) {
        const int base = 2 + 16 * L, li = L >> 1; const bool hyb = (L & 1) == 0;
        const float* MODL = MOD + (size_t)L * 5 * 6144;
        unsigned char* WH = ws + WS_W + W_HYB + (size_t)li * WH_SZ; unsigned char* WG = ws + WS_W + W_GM + (size_t)li * WG_SZ; unsigned char* WP = ws + WS_W + W_PEER + (size_t)L * WP_SZ;
        if (hyb) {
            SITE(2) PH(base + 0) REP(2) { pg8::Gemm g{H, (const bf16_t*)(WH + WH_IN), nr_in(L), HYB_INP, 1024, 1024, 1024};
                pg8::EpiBf16<0> e{(bf16_t*)(ws + WS_BIG), HYB_INP}; pg8::gemm_phase(lds, g, e); }
            SITE(3) PH(base + 1) REP(3) { phase_conv(A, li); }
            SITE(4) PH(base + 2) {
                SITE(18) REP(18) { pg8::Gemm g{(const bf16_t*)(ws + WS_BIG) + C_CQ, (const bf16_t*)(WH + WH_QB), L == 0 ? NROW : NLAT, 1536, 384, HYB_INP, 384};
                  EpiQ e{(bf16_t*)(ws + WS_R1 + R1_Q), (const float*)(ws + WS_RSTD), (const float*)(ws + WS_ROPE)}; pg8::gemm_phase(lds, g, e); }
                SITE(19) REP(19) { pg8::Gemm g{(const bf16_t*)(ws + WS_BIG) + C_CKV, (const bf16_t*)(WH + WH_KVB), NROW, 2048, 256, HYB_INP, 256};
                  EpiKV e{ws + WS_R1 + R1_KN, ws + WS_R1 + R1_V, (const float*)(ws + WS_RSTD) + NROW}; pg8::gemm_phase(lds, g, e); }
                SITE(20) REP(20) for (int u = blockIdx.x; u < 528; u += gridDim.x) ssd::g_unit((const bf16_t*)(ws + WS_R2 + R2_BC), (bf16_t*)(ws + WS_BIG + BIG_G), u);
            }
            SITE(5) PH(base + 3) {
                SITE(21) REP(21) for (int u = blockIdx.x; u < 256; u += gridDim.x)
                    ssd::ssd_unit(u, (const bf16_t*)(ws + WS_R2), (const bf16_t*)(ws + WS_R2 + R2_BC), (const float*)(ws + WS_BIG + BIG_DT), (const bf16_t*)(ws + WS_BIG + BIG_G),
                                  A.in[I_ALOG] + li * 32, (bf16_t*)(ws + WS_H), (bf16_t*)(ws + WS_R3), lds);
                const int nau = L == 0 ? 1024 + 32 : 1024;
                SITE(22) REP(22) for (int au = blockIdx.x; au < nau; au += gridDim.x) {
                    int b, h, qrow0, orow0, nt;
                    if (au < 1024) { b = au >> 8; h = au & 7; const int qb = (au >> 3) & 31; qrow0 = 256 + 256 * qb; orow0 = b * 8192 + 256 * qb; nt = NKT; }
                    else { const int cu = au - 1024; b = cu >> 3; h = cu & 7; qrow0 = 0; orow0 = NLAT + 256 * b; nt = 4; }
                    const size_t bh = (size_t)(b * 8 + h);
                    att::attn_unit((const bf16_t*)(ws + WS_R1 + R1_Q) + (bh * NKEY + qrow0) * 192, ws + WS_R1 + R1_KN + bh * NKT * 16384, ws + WS_BIG + BIG_KR + (size_t)b * NKT * 8192,
                                   ws + WS_R1 + R1_V + bh * NKT * 16384, (bf16_t*)(ws + WS_R3 + R3_CAT) + (size_t)orow0 * 2048 + 1024 + 128 * h, nt, lds);
                }
            }
            SITE(6) PH(base + 4) REP(6) { phase_ssd_out(A, li, nr_out(L)); }
        } else {
            SITE(7) PH(base + 0) REP(7) { pg8::Gemm g{H, (const bf16_t*)(WG + WG_IN), nr_out(L), 4096, 1024, 1024, 1024};
                pg8::EpiBf16<1> e{(bf16_t*)(ws + WS_BIG), 4096}; pg8::gemm_phase(lds, g, e); }
            SITE(8) PH(base + 1) REP(8) { phase_ln_stats(A, nr_out(L)); }
            SITE(9) PH(base + 2) REP(9) { phase_spatial(A, li, nr_out(L), lds); }
        }
        SITE(10) PH(base + 5) { pg8::Gemm g{hyb ? (const bf16_t*)(ws + WS_R3 + R3_CAT) : (const bf16_t*)(ws + WS_R1), hyb ? (const bf16_t*)(WH + WH_OUT) : (const bf16_t*)(WG + WG_OUT), nr_out(L), 1024, 2048, 2048, 2048};
            pg8::EpiResid e{XL, XC, MODL + 2 * 1024}; pg8::gemm_phase(lds, g, e); }
        SITE(11) PH(base + 6) REP(11) { phase_norm_mod(XL, XC, nullptr, nullptr, A.in[I_N2G] + L * 1024, MODL, 3, H, nr_out(L)); phase_tabcvt(A, L); }
        SITE(12) PH(base + 7) REP(12) { pg8::Gemm g{H, (const bf16_t*)(WP + WP_Q), nr_out(L), 2048, 1024, 1024, 1024};
            pg8::EpiBf16<0> e{(bf16_t*)(ws + WS_BIG), 2048}; pg8::gemm_phase(lds, g, e); }
        SITE(13) PH(base + 8) REP(13) { phase_topk(A, L, nr_out(L), lds); }
        SITE(14) PH(base + 9) REP(14) { phase_peer_u(A, L, nr_out(L), smem, rep); }
        SITE(15) PH(base + 10) REP(15) { phase_coef(A, nr_out(L)); }
        SITE(16) PH(base + 11) { phase_peer_v(A, L, nr_out(L), smem, 0); }
        SITE(17) PH(base + 12) { if (L < DEPTH - 1) phase_norm_mod(XL, XC, nullptr, nullptr, A.in[I_N1G] + (L + 1) * 1024, MOD + (size_t)(L + 1) * 5 * 6144, 0, H, nr_in(L + 1));
                        else phase_final_norm(XL, A.in[I_FNG]); }
    }
#undef PH
}

#ifdef MK_TAP
__global__ void tap_kernel(const unsigned short* buf, size_t pitch, size_t col0, size_t ncols, size_t nrows, float* out) {
    const size_t n = ncols * nrows;
    for (size_t i = (size_t)blockIdx.x * blockDim.x + threadIdx.x; i < (size_t)NLAT * D; i += (size_t)gridDim.x * blockDim.x) {
        float s = 0.f; for (size_t j = i; j < n; j += (size_t)NLAT * D) s += (float)buf[(j / ncols) * pitch + col0 + (j % ncols)]; out[i] = s; }
}
#endif
extern "C" void kernel_launch(void* const* d_in, const int* in_sizes, int n_in, void* d_out, int out_size, void* d_ws, size_t ws_size, hipStream_t stream) {
    static int grid = 0;
    if (grid == 0) {
        if (n_in != N_IN || out_size != NLAT * D || ws_size < WS_END) { fprintf(stderr, "kernel_launch: unexpected shapes (n_in %d out %d ws %zu, need %zu)\n", n_in, out_size, ws_size, (size_t)WS_END); grid = -1; return; }
        int dev = 0, cus = 0, per_cu = 0;
        if (hipGetDevice(&dev) != hipSuccess || hipDeviceGetAttribute(&cus, hipDeviceAttributeMultiprocessorCount, dev) != hipSuccess) { grid = -1; return; }
        if (hipFuncSetAttribute((const void*)fwd, hipFuncAttributeMaxDynamicSharedMemorySize, LDS_BYTES) != hipSuccess) { fprintf(stderr, "kernel_launch: hipFuncSetAttribute failed\n"); grid = -1; return; }
        if (hipOccupancyMaxActiveBlocksPerMultiprocessor(&per_cu, (const void*)fwd, NTHR, LDS_BYTES) != hipSuccess || per_cu < 1) { fprintf(stderr, "kernel_launch: occupancy query says %d\n", per_cu); }
        (void)hipGetLastError();
        grid = cus;
    }
    if (grid < 0) return;
    (void)hipMemsetAsync((char*)d_ws + WS_CTL, 0, CTL_BYTES, stream);
    Args a{};
    for (int i = 0; i < N_IN; ++i) a.in[i] = (const float*)d_in[i];
    a.out = (float*)d_out; a.ws = (unsigned char*)d_ws;
#if MK_PER_PHASE
    for (int id = 0; id < 2 + 16 * DEPTH; ++id) {
        if (id >= 2) { const int L = (id - 2) / 16, s = (id - 2) % 16; if (s > 12) continue; if ((L & 1) && (s == 3 || s == 4)) continue; }
#ifdef MK_CUT
#ifdef MK_TAP
        if (id >= MK_CUT) continue;
#else
        if (id >= MK_CUT && id != 2 + 16 * (DEPTH - 1) + 12) continue;
#endif
#endif
        a.ph_lo = id; a.ph_hi = id + 1;
        hipLaunchKernelGGL(fwd, dim3(grid), dim3(NTHR), LDS_BYTES, stream, a);
    }
#ifdef MK_TAP
    { const size_t tp[5] = {MK_TAP}; hipLaunchKernelGGL(tap_kernel, dim3(2048), dim3(256), 0, stream, (const unsigned short*)((const char*)d_ws + tp[0]), tp[1], tp[2], tp[3], tp[4], (float*)d_out); }
#endif
#else
    a.ph_lo = 0; a.ph_hi = 2 + 16 * DEPTH;
    hipLaunchKernelGGL(fwd, dim3(grid), dim3(NTHR), LDS_BYTES, stream, a);
#endif
    const hipError_t le = hipPeekAtLastError();
    if (le != hipSuccess) fprintf(stderr, "kernel_launch: launch failed: %s\n", hipGetErrorName(le));
}
```

```cpp
#include <hip/hip_runtime.h>
#include <cstdio>
#include <cstdint>

#define LAS __attribute__((address_space(3)))
typedef unsigned short bf16_t;
typedef short bf16x8 __attribute__((ext_vector_type(8)));
typedef short s16x4 __attribute__((ext_vector_type(4)));
typedef float f32x2 __attribute__((ext_vector_type(2)));
typedef float f32x4 __attribute__((ext_vector_type(4)));
typedef float f32x16 __attribute__((ext_vector_type(16)));
typedef unsigned u32x2 __attribute__((ext_vector_type(2)));
typedef unsigned u32x4 __attribute__((ext_vector_type(4)));
typedef int i32x4 __attribute__((ext_vector_type(4)));
typedef int i32x8 __attribute__((ext_vector_type(8)));

constexpr int D = 1024, NB = 4, SEQ = 8192, DEPTH = 4, CTXL = 256;
constexpr int NLAT = NB * SEQ, NCTX = NB * CTXL, NROW = NLAT + NCTX;
constexpr int HYB_IN = 3280, HYB_INP = 3328;
constexpr int C_Z = 0, C_XBC = 1024, C_DT = 2560, C_CQ = 2576, C_CKV = 2960, C_KR = 3216;
constexpr int NKEY = SEQ + CTXL, NKT = NKEY / 64;
constexpr float EPS = 1e-6f;
constexpr float QSCALE = 0.07216878364870322f * 1.4426950408889634f;
constexpr int NEXP = 16384;

enum { I_X = 0, I_C, I_CTX, I_CCTX, I_ADAW, I_ADAB, I_N1G, I_N2G, I_HWIN, I_CONVW, I_CONVB, I_ALOG, I_DTB, I_SSDD, I_SSDNG, I_QNG, I_WQB, I_KVNG, I_WKVB,
       I_HWOUT, I_GWIN, I_GLNG, I_GLNB, I_GWS, I_GBS, I_GWOUT, I_PWQ, I_PK1, I_PK2, I_PU, I_PV, I_FNG, N_IN };

constexpr size_t al256(size_t x) { return (x + 255) & ~(size_t)255; }
constexpr size_t WS_CTL = 0, CTL_BYTES = 65536;
constexpr size_t WS_MOD = WS_CTL + CTL_BYTES;
constexpr size_t WS_ROPE = WS_MOD + al256((size_t)DEPTH * 5 * 6144 * 4);
constexpr size_t WS_RSTD = WS_ROPE + (size_t)2 * SEQ * 32 * 4;
constexpr size_t WS_W = WS_RSTD + al256((size_t)2 * NROW * 4);
constexpr size_t W_HYB = 0;
constexpr size_t WH_IN = 0, WH_QB = WH_IN + (size_t)HYB_INP * 1024 * 2, WH_KVB = WH_QB + (size_t)1536 * 384 * 2, WH_OUT = WH_KVB + (size_t)2048 * 256 * 2,
                 WH_SZ = WH_OUT + (size_t)1024 * 2048 * 2;
constexpr size_t W_GM = W_HYB + 2 * WH_SZ;
constexpr size_t WG_IN = 0, WG_OUT = WG_IN + (size_t)4096 * 1024 * 2, WG_WS = WG_OUT + (size_t)1024 * 2048 * 2, WG_SZ = WG_WS + (size_t)8 * 128 * 128 * 2;
constexpr size_t W_PEER = W_GM + 2 * WG_SZ;
constexpr size_t WP_Q = 0, WP_K1 = WP_Q + (size_t)2048 * 1024 * 2, WP_K2 = WP_K1 + (size_t)8 * 128 * 128 * 2, WP_SZ = WP_K2 + (size_t)8 * 128 * 128 * 2;
constexpr size_t W_TOTAL = W_PEER + 4 * WP_SZ;
constexpr size_t WS_TAB = WS_W + al256(W_TOTAL);
constexpr size_t TAB_HALF = (size_t)NEXP * 1024 * 2;
constexpr size_t WS_XC = WS_TAB + 2 * TAB_HALF;
constexpr size_t WS_H = WS_XC + (size_t)NCTX * D * 4;
constexpr size_t WS_BIG = WS_H + (size_t)NROW * D * 2;
constexpr size_t BIG_BYTES = (size_t)NROW * 4096 * 2;
constexpr size_t BIG_DT = (size_t)NROW * HYB_INP * 2;
constexpr size_t BIG_G = BIG_DT + (size_t)NROW * 32 * 4;
constexpr size_t BIG_KR = BIG_G + (size_t)528 * 128 * 128 * 2;
constexpr size_t BIG_PART = (size_t)NROW * 2048 * 2;
static_assert(BIG_KR + (size_t)NB * NKT * 8192 <= BIG_BYTES, "BIG tail");
constexpr size_t WS_R1 = WS_BIG + BIG_BYTES;
constexpr size_t R1_Q = 0, R1_KN = R1_Q + (size_t)NB * 8 * NKEY * 192 * 2, R1_V = R1_KN + (size_t)NB * 8 * NKT * 16384, R1_BYTES = R1_V + (size_t)NB * 8 * NKT * 16384;
constexpr size_t WS_R2 = WS_R1 + R1_BYTES;
constexpr size_t R2_BC = (size_t)NROW * 1024 * 2, R2_BYTES = R2_BC + (size_t)NROW * 512 * 2;
constexpr size_t R2_GATE = (size_t)NROW * 128 * 4, R2_COEF = 2 * R2_GATE;
constexpr size_t WS_R3 = WS_R2 + R2_BYTES;
constexpr size_t R3_CAT = (size_t)NROW * 1024 * 2, R3_BYTES = R3_CAT + (size_t)NROW * 2048 * 2;
constexpr size_t WS_END = WS_R3 + R3_BYTES;
static_assert(WS_END <= ((size_t)1 << 30), "workspace must fit 1 GiB");

constexpr int CW_RANK = 3584;
constexpr int CW_QUEUE = 4096;

typedef __bf16 bf16x2_t __attribute__((ext_vector_type(2)));
__device__ __forceinline__ unsigned cvt_pk_bf16(float lo, float hi) { const f32x2 v = {lo, hi}; const bf16x2_t b = __builtin_convertvector(v, bf16x2_t); return __builtin_bit_cast(unsigned, b); }
__device__ __forceinline__ bf16_t f2bf(float f) { return (bf16_t)(cvt_pk_bf16(f, 0.f) & 0xffffu); }
__device__ __forceinline__ float bf2f(unsigned b) { return __uint_as_float(b << 16); }
__device__ __forceinline__ float bflo(unsigned w) { return __uint_as_float(w << 16); }
__device__ __forceinline__ float bfhi(unsigned w) { return __uint_as_float(w & 0xffff0000u); }
__device__ __forceinline__ float wave_sum(float v) {
#pragma unroll
    for (int o = 32; o >= 1; o >>= 1) v += __shfl_xor(v, o);
    return v;
}
__device__ __forceinline__ int otid() { int t = threadIdx.x; asm volatile("" : "+v"(t)); return t; }
__device__ __forceinline__ float silu_f(float x) { return x / (1.f + __expf(-x)); }
__device__ __forceinline__ float softplus_f(float x) { return x > 20.f ? x : log1pf(__expf(x)); }
__device__ __forceinline__ f32x2 gelu_pk(f32x2 v) {
    const f32x2 av = __builtin_elementwise_abs(v), d = av * 0.2316418882f + 1.0f;
    f32x2 t; t.x = __builtin_amdgcn_rcpf(d.x); t.y = __builtin_amdgcn_rcpf(d.y);
    f32x2 q = t * 0.5307027145f + (-0.7265760135f); q = q * t + 0.7107068705f; q = q * t + (-0.142248368f); q = q * t + 0.127414796f; q = q * t;
    const f32x2 s = (v * v) * (-0.72134752044f);
    f32x2 e; e.x = __builtin_amdgcn_exp2f(s.x); e.y = __builtin_amdgcn_exp2f(s.y);
    const f32x2 m = v * (q * e), r = v - m;
    f32x2 o; o.x = v.x < 0.f ? m.x : r.x; o.y = v.y < 0.f ? m.y : r.y; return o;
}
__device__ __forceinline__ float gelu_f(float x) { f32x2 v = {x, 0.f}; return gelu_pk(v).x; }

__device__ __forceinline__ unsigned pk4_fp8(float a, float b, float c, float d) { int w = 0; w = __builtin_amdgcn_cvt_pk_fp8_f32(a, b, w, false); w = __builtin_amdgcn_cvt_pk_fp8_f32(c, d, w, true); return (unsigned)w; }
__device__ __forceinline__ int row_mb(int r) { return r < NLAT ? (r >> 13) : 4; }

#define XB_TMO      128
#define XB_XCNT(j)  (256  + 64 * (j))
#define XB_XSUB(j)  (1280 + 64 * (j))
#define XB_XGEN(j)  (2304 + 64 * (j))
#define XB_TOP      3328
#define XB_TOPGEN   3392
#define XCD_BAR_WORDS 3456
#define XB_SPIN_CAP (1u << 22)
__device__ __forceinline__ unsigned xb_ld(unsigned* p)              { return __hip_atomic_load(p, __ATOMIC_RELAXED, __HIP_MEMORY_SCOPE_AGENT); }
__device__ __forceinline__ unsigned xb_add(unsigned* p, unsigned v) { return __hip_atomic_fetch_add(p, v, __ATOMIC_RELAXED, __HIP_MEMORY_SCOPE_AGENT); }
__device__ __forceinline__ unsigned xb_xcc_id() { return (unsigned)__builtin_amdgcn_s_getreg((3 << 11) | 20) & 0xFu; }
#define XB_SPIN(cond, bar) do { unsigned _sp = 0; while (cond) { __builtin_amdgcn_s_sleep(1); \
    if ((++_sp & 255u) == 0u) { if (xb_ld(&(bar)[XB_TMO])) break; if (_sp > XB_SPIN_CAP) { atomicAdd(&(bar)[XB_TMO], 1u); break; } } } } while (0)
struct XcdBarrier { unsigned* bar; unsigned x; volatile LAS unsigned* st; };
__device__ __forceinline__ XcdBarrier xcd_barrier_post(unsigned* bar, volatile LAS unsigned* st) {
    XcdBarrier b; b.bar = bar; b.x = xb_xcc_id(); b.st = st;
    if (threadIdx.x == 0) (void)xb_add(&bar[XB_XCNT(b.x)], 1u);
    return b;
}
__device__ __forceinline__ void xcd_barrier_complete(unsigned* bar, unsigned x, unsigned& nloc, unsigned& nx) {
    const unsigned G = gridDim.x * gridDim.y * gridDim.z;
    unsigned sum, cnt, mine, sp = 0u;
    for (;;) {
        sum = 0u; cnt = 0u; mine = 0u;
#pragma unroll
        for (unsigned j = 0; j < 16; ++j) { const unsigned c = xb_ld(&bar[XB_XCNT(j)]); sum += c; cnt += (c > 0u) ? 1u : 0u; mine = (j == x) ? c : mine; }
        if (sum == G) break;
        __builtin_amdgcn_s_sleep(1);
        if ((++sp & 255u) == 0u) { if (xb_ld(&bar[XB_TMO])) break; if (sp > XB_SPIN_CAP) { atomicAdd(&bar[XB_TMO], 1u); break; } }
    }
    nloc = mine > 0u ? mine : 1u; nx = cnt > 0u ? cnt : 1u;
}
__device__ __forceinline__ void xcd_barrier(const XcdBarrier& b) {
    asm volatile("s_waitcnt vmcnt(0)" ::: "memory");
    __syncthreads();
    if (threadIdx.x == 0) {
        unsigned* bar = b.bar;
        __builtin_amdgcn_s_waitcnt(0);
        unsigned nloc = b.st[0], nx = b.st[1];
        if (nloc == 0u) { xcd_barrier_complete(bar, b.x, nloc, nx); b.st[0] = nloc; b.st[1] = nx; }
        const unsigned old = xb_add(&bar[XB_XSUB(b.x)], 1u);
        const unsigned gen = old / nloc;
        if (old + 1u == (gen + 1u) * nloc) {
            __builtin_amdgcn_fence(__ATOMIC_RELEASE, "agent");
            asm volatile("s_waitcnt vmcnt(0)" ::: "memory");
            const unsigned og = xb_add(&bar[XB_TOP], 1u);
            const unsigned tg = og / nx;
            if (og + 1u == (tg + 1u) * nx) xb_add(&bar[XB_TOPGEN], 1u);
            else XB_SPIN(xb_ld(&bar[XB_TOPGEN]) == tg, bar);
            __builtin_amdgcn_fence(__ATOMIC_ACQUIRE, "agent");
            xb_add(&bar[XB_XGEN(b.x)], 1u);
            asm volatile("s_waitcnt vmcnt(0)" ::: "memory");
        } else {
            XB_SPIN(xb_ld(&bar[XB_XGEN(b.x)]) == gen, bar);
            __builtin_amdgcn_fence(__ATOMIC_ACQUIRE, "agent");
            asm volatile("s_waitcnt vmcnt(0)" ::: "memory");
        }
    }
    __syncthreads();
}

namespace pg8 {
constexpr int BM = 256, BK = 64, HALF = 128, HTB = HALF * BK * 2, STAGE_BYTES = 8 * HTB, NXCD = 8, WGM = 8;
__host__ __device__ __forceinline__ int lds_byte(int r, int c) { const int st = (r >> 4) * 2 + (c >> 5), rr = r & 15, cc = c & 31, ob = rr * 64 + cc * 2; return st * 1024 + (ob ^ (((ob >> 9) & 1) << 5)); }
__host__ __device__ __forceinline__ void stage_rc(int b, int& R, int& C) { const int st = b / 1024, sb = b % 1024, swz = sb ^ (((sb >> 9) & 1) << 5); R = (st >> 1) * 16 + swz / 64; C = (st & 1) * 32 + (swz % 64) / 2; }
__host__ __device__ __forceinline__ int perm32(int rho) { const int n = rho >> 4, i = rho & 15; return 8 * (i >> 2) + 4 * n + (i & 3); }
struct Unit { int pm, pn; };
struct Gemm { const bf16_t* A; const bf16_t* Bt; int M, N, K, lda, ldb; };
struct StaticOrder {
    int nM, nN, nwg, G, c;
    __device__ void init(int M, int N, int G_, int c_) { nM = M / BM; nN = N / BM; nwg = nM * nN; G = G_; c = c_; }
    __device__ bool next(int i, Unit& u) const {
        const long L = (long)i * G + c; if (L >= nwg) return false;
        int wgid = (int)L; { const int q = nwg / NXCD, r = nwg % NXCD, xcd = wgid % NXCD, off = wgid / NXCD; wgid = (xcd < r ? xcd * (q + 1) : r * (q + 1) + (xcd - r) * q) + off; }
        const int nig = WGM * nN, gid = wgid / nig, fm = gid * WGM, gsz = (nM - fm) < WGM ? (nM - fm) : WGM;
        u.pm = fm + ((wgid % nig) % gsz); u.pn = (wgid % nig) / gsz; return true;
    }
};
template <class Epi>
__device__ __forceinline__ void gemm_phase(LAS unsigned char* lds, const Gemm g, const Epi& E) {
    const int tid = otid(), wid = __builtin_amdgcn_readfirstlane(tid >> 6), lane = tid & 63, wr = wid >> 2, wc = wid & 3, fr = lane & 15, fq = lane >> 4;
    StaticOrder S; S.init(g.M, g.N, (int)gridDim.x, (int)blockIdx.x);
    int K = g.K; asm volatile("" : "+s"(K));
    const int nt = K / BK;
    unsigned voffA[2], voffB[2];
#pragma unroll
    for (int i = 0; i < 2; ++i) { int R, C; stage_rc(tid * 16 + i * 8192, R, C); const int Rb = Epi::PERM ? ((R & ~31) + perm32(R & 31)) : R;
        voffA[i] = (unsigned)(R * g.lda + C) * 2u; voffB[i] = (unsigned)(Rb * g.ldb + C) * 2u; }
    const size_t kstep = (size_t)(BK * 2);
    const size_t hstepA = (size_t)HALF * g.lda * 2, hstepB = (size_t)HALF * g.ldb * 2;
    const size_t tstepA = 2 * hstepA, tstepB = 2 * hstepB;
    const unsigned ldsw = (unsigned)wid * 1024u;
    const int aoff = lds_byte(wr * 64 + fr, fq * 8), boff = lds_byte(wc * 32 + fr, fq * 8);
#define PG8_SA(b, h) (((b) * 2 + (h)) * HTB)
#define PG8_SB(b, h) ((4 + (b) * 2 + (h)) * HTB)
#define PG8_STAGE(bufoff, gbase, voff) do { _Pragma("unroll") for (int _i = 0; _i < 2; ++_i) \
        __builtin_amdgcn_global_load_lds((const unsigned*)((const char*)(gbase) + (voff)[_i]), (LAS unsigned*)(lds + (bufoff) + ldsw + _i * 8192), 16, 0, 0); } while (0)
#define PG8_LDA(dst, b, h) do { _Pragma("unroll") for (int m = 0; m < 4; ++m) _Pragma("unroll") for (int k = 0; k < 2; ++k) dst[m][k] = *(const LAS bf16x8*)(lds + PG8_SA(b, h) + aoff + m * 2048 + k * 1024); } while (0)
#define PG8_LDB(dst, b, h) do { _Pragma("unroll") for (int n = 0; n < 2; ++n) _Pragma("unroll") for (int k = 0; k < 2; ++k) dst[n][k] = *(const LAS bf16x8*)(lds + PG8_SB(b, h) + boff + n * 2048 + k * 1024); } while (0)
#define PG8_MMA(ai, bj, At, Bt) do { __builtin_amdgcn_s_setprio(1); _Pragma("unroll") for (int m = 0; m < 4; ++m) _Pragma("unroll") for (int n = 0; n < 2; ++n) _Pragma("unroll") for (int k = 0; k < 2; ++k) \
        acc[ai][bj][m][n] = __builtin_amdgcn_mfma_f32_16x16x32_bf16(Bt[n][k], At[m][k], acc[ai][bj][m][n], 0, 0, 0); __builtin_amdgcn_s_setprio(0); } while (0)
#define PG8_WAIT_V(n) asm volatile("s_waitcnt vmcnt(" #n ")" ::: "memory")
#define PG8_WAIT_L(n) asm volatile("s_waitcnt lgkmcnt(" #n ")" ::: "memory")
#define PG8_BAR __builtin_amdgcn_s_barrier()
#define PG8_SCHED __builtin_amdgcn_sched_barrier(0)
    Unit cur, nxt; int ui = 0;
    if (!S.next(0, cur)) return;
    f32x4 acc[2][2][4][2];
#pragma unroll
    for (int a = 0; a < 2; ++a)
#pragma unroll
        for (int b = 0; b < 2; ++b)
#pragma unroll
            for (int m = 0; m < 4; ++m)
#pragma unroll
                for (int n = 0; n < 2; ++n) acc[a][b][m][n] = (f32x4){0.f, 0.f, 0.f, 0.f};
    bf16x8 At[4][2], B0[2][2], B1[2][2];
    const char* cA = (const char*)g.A + (size_t)cur.pm * tstepA; const char* cB = (const char*)g.Bt + (size_t)cur.pn * tstepB;
    PG8_STAGE(PG8_SB(0, 0), cB, voffB); PG8_STAGE(PG8_SB(0, 1), cB + hstepB, voffB); PG8_STAGE(PG8_SA(0, 0), cA, voffA); PG8_STAGE(PG8_SA(0, 1), cA + hstepA, voffA);
    if (wr == 1) PG8_BAR;
    PG8_WAIT_V(2); PG8_BAR;
    PG8_STAGE(PG8_SB(1, 0), cB + kstep, voffB); PG8_STAGE(PG8_SA(1, 0), cA + kstep, voffA); PG8_STAGE(PG8_SB(1, 1), cB + hstepB + kstep, voffB);
    PG8_WAIT_V(6); PG8_BAR;
    for (;;) {
        const bool has_next = S.next(ui + 1, nxt);
        const char* nA = has_next ? (const char*)g.A + (size_t)nxt.pm * tstepA : cA; const char* nB = has_next ? (const char*)g.Bt + (size_t)nxt.pn * tstepB : cB;
        for (int t = 0; t < nt; t += 2) {
            const bool last = (t == nt - 2);
            const char* a1 = cA + (size_t)(t + 1) * kstep;
            const char* a2 = last ? nA : cA + (size_t)(t + 2) * kstep; const char* b2 = last ? nB : cB + (size_t)(t + 2) * kstep;
            const char* a3 = a2 + kstep; const char* b3 = b2 + kstep;
            PG8_LDB(B0, 0, 0); PG8_LDB(B1, 0, 1); PG8_SCHED; PG8_LDA(At, 0, 0); PG8_STAGE(PG8_SA(1, 1), a1 + hstepA, voffA);
            PG8_WAIT_V(8); PG8_WAIT_L(0); PG8_BAR; PG8_MMA(0, 0, At, B0); PG8_MMA(0, 1, At, B1); PG8_BAR; PG8_SCHED;
            PG8_LDA(At, 0, 1); PG8_STAGE(PG8_SB(0, 0), b2, voffB); PG8_STAGE(PG8_SB(0, 1), b2 + hstepB, voffB); PG8_STAGE(PG8_SA(0, 0), a2, voffA);
            PG8_WAIT_V(8); PG8_WAIT_L(0); PG8_BAR; PG8_MMA(1, 0, At, B0); PG8_MMA(1, 1, At, B1); PG8_BAR; PG8_SCHED;
            PG8_LDB(B0, 1, 0); PG8_LDB(B1, 1, 1); PG8_SCHED; PG8_LDA(At, 1, 0); PG8_STAGE(PG8_SA(0, 1), a2 + hstepA, voffA);
            PG8_WAIT_V(8); PG8_WAIT_L(0); PG8_BAR; PG8_MMA(0, 0, At, B0); PG8_MMA(0, 1, At, B1); PG8_BAR; PG8_SCHED;
            PG8_LDA(At, 1, 1); PG8_STAGE(PG8_SB(1, 0), b3, voffB); PG8_STAGE(PG8_SB(1, 1), b3 + hstepB, voffB); PG8_STAGE(PG8_SA(1, 0), a3, voffA);
            PG8_WAIT_V(8); PG8_WAIT_L(0); PG8_BAR; PG8_MMA(1, 0, At, B0); PG8_MMA(1, 1, At, B1); PG8_BAR; PG8_SCHED;
        }
        if (wr == 0) PG8_BAR;
        { const int l2_ = otid() & 63; E(acc, cur, wr, wc, l2_ & 15, l2_ >> 4); }
        if (!has_next) break;
#pragma unroll
        for (int a = 0; a < 2; ++a)
#pragma unroll
            for (int b = 0; b < 2; ++b)
#pragma unroll
                for (int m = 0; m < 4; ++m)
#pragma unroll
                    for (int n = 0; n < 2; ++n) acc[a][b][m][n] = (f32x4){0.f, 0.f, 0.f, 0.f};
        cur = nxt; cA = nA; cB = nB; ++ui;
        if (wr == 1) PG8_BAR;
    }
    PG8_WAIT_V(0);
    PG8_BAR;
#undef PG8_SA
#undef PG8_SB
#undef PG8_STAGE
#undef PG8_LDA
#undef PG8_LDB
#undef PG8_MMA
#undef PG8_WAIT_V
#undef PG8_WAIT_L
#undef PG8_BAR
#undef PG8_SCHED
}

template <int ACT> struct EpiBf16 {
    static constexpr bool PERM = true;
    bf16_t* O; int ldc;
    __device__ __forceinline__ void operator()(const f32x4 (&acc)[2][2][4][2], const Unit& u, int wr, int wc, int fr, int fq) const {
        const int row0 = u.pm * BM + wr * 64 + fr, col0 = u.pn * BM + wc * 32 + 8 * fq;
#pragma unroll
        for (int ai = 0; ai < 2; ++ai)
#pragma unroll
            for (int m = 0; m < 4; ++m) { bf16_t* rowp = O + (size_t)(row0 + ai * HALF + m * 16) * ldc + col0;
#pragma unroll
                for (int bj = 0; bj < 2; ++bj) { f32x4 v0 = acc[ai][bj][m][0], v1 = acc[ai][bj][m][1];
                    if (ACT == 1) { f32x2 a = gelu_pk((f32x2){v0[0], v0[1]}), b = gelu_pk((f32x2){v0[2], v0[3]}), c = gelu_pk((f32x2){v1[0], v1[1]}), d = gelu_pk((f32x2){v1[2], v1[3]});
                        v0 = (f32x4){a.x, a.y, b.x, b.y}; v1 = (f32x4){c.x, c.y, d.x, d.y}; }
                    u32x4 w; w.x = cvt_pk_bf16(v0[0], v0[1]); w.y = cvt_pk_bf16(v0[2], v0[3]); w.z = cvt_pk_bf16(v1[0], v1[1]); w.w = cvt_pk_bf16(v1[2], v1[3]);
                    *(u32x4*)(rowp + bj * HALF) = w; } }
    }
};
struct EpiResid {
    static constexpr bool PERM = false;
    float* xl; float* xc; const float* gate;
    __device__ __forceinline__ void operator()(const f32x4 (&acc)[2][2][4][2], const Unit& u, int wr, int wc, int fr, int fq) const {
        const int rbase = u.pm * BM; const bool lat = rbase < NLAT;
        float* X = lat ? xl + (size_t)rbase * D : xc + (size_t)(rbase - NLAT) * D;
        const float* gp = gate + (size_t)(lat ? (rbase >> 13) : 4) * 6144;
        const int row0 = wr * 64 + fr, col0 = u.pn * BM + wc * 32 + 4 * fq;
        f32x4 gv[2][2];
#pragma unroll
        for (int bj = 0; bj < 2; ++bj)
#pragma unroll
            for (int n = 0; n < 2; ++n) gv[bj][n] = *(const f32x4*)(gp + col0 + bj * HALF + n * 16);
#pragma unroll
        for (int ai = 0; ai < 2; ++ai)
#pragma unroll
            for (int m = 0; m < 4; ++m) { float* rowp = X + (size_t)(row0 + ai * HALF + m * 16) * D + col0;
#pragma unroll
                for (int bj = 0; bj < 2; ++bj)
#pragma unroll
                    for (int n = 0; n < 2; ++n) { f32x4* p = (f32x4*)(rowp + bj * HALF + n * 16); *p = *p + gv[bj][n] * acc[ai][bj][m][n]; } }
    }
};
}

namespace att {
constexpr int SLOT = 40960, KN_OFF = 0, KR_OFF = 16384, V_OFF = 24576, LDS_BYTES = 3 * SLOT + 8 * 256;
constexpr float THR2 = 11.0f;
#define KSWZ(row, colB) ((row) * 256 + ((colB) ^ (((row) & 7) << 4)))
#define KRSWZ(row, colB) ((row) * 128 + ((colB) ^ ((((row) >> 1) & 7) << 4)))
#define SBAR() __builtin_amdgcn_sched_barrier(0)
__device__ __forceinline__ int crow(int r, int hi) { return (r & 3) + 8 * (r >> 2) + 4 * hi; }
__host__ __device__ __forceinline__ int v_st(int k, int c) { const int kk = (k & ~0xC) | ((k & 4) << 1) | ((k & 8) >> 1); return ((kk >> 3) * 4 + (c >> 5)) * 512 + ((kk & 7) * 32 + (c & 31)) * 2; }
__device__ __forceinline__ int v_rd_base(int lane) { return ((lane & 3) << 3) | (((lane >> 2) & 3) << 6) | (((lane >> 4) & 1) << 5) | (((lane >> 5) & 1) << 8); }
constexpr int v_rd_off(int d0, int ks, int half) { return d0 * 512 + ks * 4096 + half * 2048; }
template <int OFF> __device__ __forceinline__ s16x4 tr_read(int vb) {
    s16x4 r; asm volatile("ds_read_b64_tr_b16 %0, %1 offset:%2" : "=&v"(r) : "v"(vb), "i"(OFF) : "memory"); return r;
}
template <int D0> __device__ __forceinline__ void pv_one(f32x16& od, int vb, bf16x8 pa0, bf16x8 pa1, bf16x8 pa2, bf16x8 pa3) {
    const s16x4 l0 = tr_read<v_rd_off(D0, 0, 0)>(vb), h0 = tr_read<v_rd_off(D0, 0, 1)>(vb), l1 = tr_read<v_rd_off(D0, 1, 0)>(vb), h1 = tr_read<v_rd_off(D0, 1, 1)>(vb);
    const s16x4 l2 = tr_read<v_rd_off(D0, 2, 0)>(vb), h2 = tr_read<v_rd_off(D0, 2, 1)>(vb), l3 = tr_read<v_rd_off(D0, 3, 0)>(vb), h3 = tr_read<v_rd_off(D0, 3, 1)>(vb);
    asm volatile("s_waitcnt lgkmcnt(0)" ::: "memory"); SBAR();
#define PK(L, H) (bf16x8){L[0], L[1], L[2], L[3], H[0], H[1], H[2], H[3]}
    od = __builtin_amdgcn_mfma_f32_32x32x16_bf16(pa0, PK(l0, h0), od, 0, 0, 0);
    od = __builtin_amdgcn_mfma_f32_32x32x16_bf16(pa1, PK(l1, h1), od, 0, 0, 0);
    od = __builtin_amdgcn_mfma_f32_32x32x16_bf16(pa2, PK(l2, h2), od, 0, 0, 0);
    od = __builtin_amdgcn_mfma_f32_32x32x16_bf16(pa3, PK(l3, h3), od, 0, 0, 0);
#undef PK
}
__device__ __forceinline__ void pv_d0(f32x16* o, int vb, bf16x8 pa0, bf16x8 pa1, bf16x8 pa2, bf16x8 pa3) {
    pv_one<0>(o[0], vb, pa0, pa1, pa2, pa3); pv_one<1>(o[1], vb, pa0, pa1, pa2, pa3); pv_one<2>(o[2], vb, pa0, pa1, pa2, pa3); pv_one<3>(o[3], vb, pa0, pa1, pa2, pa3);
}
__device__ __forceinline__ void partialSM(f32x16& p0, f32x16& p1, float& m_reg, float& mn, float& alpha) {
    float pmax = p0[0];
#pragma unroll
    for (int r = 1; r < 16; ++r) pmax = fmaxf(pmax, p0[r]);
#pragma unroll
    for (int r = 0; r < 16; ++r) pmax = fmaxf(pmax, p1[r]);
    { auto rr = __builtin_amdgcn_permlane32_swap(__float_as_uint(pmax), __float_as_uint(pmax), false, false);
      pmax = fmaxf(__uint_as_float(rr[0]), __uint_as_float(rr[1])); }
    if (__builtin_expect(__all(pmax - m_reg <= THR2), 1)) { mn = m_reg; alpha = 1.f; }
    else { mn = fmaxf(m_reg, pmax); alpha = __builtin_amdgcn_exp2f(m_reg - mn); m_reg = mn; }
#pragma unroll
    for (int r = 0; r < 16; ++r) p0[r] = __builtin_amdgcn_exp2f(p0[r] - mn);
#pragma unroll
    for (int r = 0; r < 16; ++r) p1[r] = p1[r] - mn;
}
__device__ __forceinline__ void finishSM(f32x16& p0, f32x16& p1, float alpha, float& l_reg, bf16x8& pa0, bf16x8& pa1, bf16x8& pa2, bf16x8& pa3) {
#pragma unroll
    for (int r = 0; r < 16; ++r) p1[r] = __builtin_amdgcn_exp2f(p1[r]);
    float ps = 0;
#pragma unroll
    for (int r = 0; r < 16; ++r) ps += p0[r];
#pragma unroll
    for (int r = 0; r < 16; ++r) ps += p1[r];
    { auto rr = __builtin_amdgcn_permlane32_swap(__float_as_uint(ps), __float_as_uint(ps), false, false);
      ps = __uint_as_float(rr[0]) + __uint_as_float(rr[1]); }
    l_reg = l_reg * alpha + ps;
#define PK4(P, BASE, OUT) do { unsigned a0 = cvt_pk_bf16(P[BASE + 0], P[BASE + 1]), a1 = cvt_pk_bf16(P[BASE + 2], P[BASE + 3]);   \
    unsigned b0 = cvt_pk_bf16(P[BASE + 4], P[BASE + 5]), b1 = cvt_pk_bf16(P[BASE + 6], P[BASE + 7]);                              \
    auto r0 = __builtin_amdgcn_permlane32_swap(a0, b0, false, false); auto r1 = __builtin_amdgcn_permlane32_swap(a1, b1, false, false); \
    u32x4 w = {r0[0], r1[0], r0[1], r1[1]}; OUT = *reinterpret_cast<bf16x8*>(&w); } while (0)
    PK4(p0, 0, pa0); PK4(p0, 8, pa1); PK4(p1, 0, pa2); PK4(p1, 8, pa3);
#undef PK4
}
__device__ __forceinline__ void qkt(f32x16& p0, f32x16& p1, LAS unsigned char* slot, const bf16x8* qr, int r32, int hi) {
    p0 = f32x16{}; p1 = f32x16{};
#pragma unroll
    for (int d0 = 0; d0 < 8; ++d0) { const int cb = (d0 * 16 + hi * 8) * 2;
        bf16x8 b0 = *(const LAS bf16x8*)(slot + KN_OFF + KSWZ(r32, cb));
        bf16x8 b1 = *(const LAS bf16x8*)(slot + KN_OFF + KSWZ(32 + r32, cb));
        p0 = __builtin_amdgcn_mfma_f32_32x32x16_bf16(b0, qr[d0], p0, 0, 0, 0);
        p1 = __builtin_amdgcn_mfma_f32_32x32x16_bf16(b1, qr[d0], p1, 0, 0, 0); }
#pragma unroll
    for (int d0 = 0; d0 < 4; ++d0) { const int cb = (d0 * 16 + hi * 8) * 2;
        bf16x8 b0 = *(const LAS bf16x8*)(slot + KR_OFF + KRSWZ(r32, cb));
        bf16x8 b1 = *(const LAS bf16x8*)(slot + KR_OFF + KRSWZ(32 + r32, cb));
        p0 = __builtin_amdgcn_mfma_f32_32x32x16_bf16(b0, qr[8 + d0], p0, 0, 0, 0);
        p1 = __builtin_amdgcn_mfma_f32_32x32x16_bf16(b1, qr[8 + d0], p1, 0, 0, 0); }
}
__device__ __forceinline__ void attn_unit(const bf16_t* __restrict__ Qb, const unsigned char* __restrict__ KNt, const unsigned char* __restrict__ KRt, const unsigned char* __restrict__ Vt,
                                          bf16_t* __restrict__ Ob, int NT, LAS unsigned char* lds) {
    const int tid = otid(), wid = __builtin_amdgcn_readfirstlane(tid >> 6), lane = tid & 63, r32 = lane & 31, hi = lane >> 5;
    LAS float* wsf = (LAS float*)(lds + 3 * SLOT) + wid * 64; LAS float* li_l = wsf; LAS float* al_l = wsf + 32;
    float m_reg = -1e30f, l_reg = 0; f32x16 o[4] = {}; bf16x8 qr[12];
    const bf16_t* Qw = Qb + (size_t)(wid * 32 + r32) * 192 + hi * 8;
#pragma unroll
    for (int d0 = 0; d0 < 12; ++d0) qr[d0] = *(const bf16x8*)(Qw + d0 * 16);
    const int vrb = (int)(unsigned)(uintptr_t)(lds) + V_OFF + v_rd_base(lane);
    const unsigned lo16 = (unsigned)lane * 16u;
#define ATT_DMA(tile, slotoff) do { const size_t t_ = (size_t)(tile); LAS unsigned char* sl_ = lds + (slotoff); \
        __builtin_amdgcn_global_load_lds((const unsigned*)(KNt + t_ * 16384 + wid * 1024 + lo16), (LAS unsigned*)(sl_ + KN_OFF + wid * 1024), 16, 0, 0); \
        __builtin_amdgcn_global_load_lds((const unsigned*)(KNt + t_ * 16384 + (wid + 8) * 1024 + lo16), (LAS unsigned*)(sl_ + KN_OFF + (wid + 8) * 1024), 16, 0, 0); \
        __builtin_amdgcn_global_load_lds((const unsigned*)(KRt + t_ * 8192 + wid * 1024 + lo16), (LAS unsigned*)(sl_ + KR_OFF + wid * 1024), 16, 0, 0); \
        __builtin_amdgcn_global_load_lds((const unsigned*)(Vt + t_ * 16384 + wid * 1024 + lo16), (LAS unsigned*)(sl_ + V_OFF + wid * 1024), 16, 0, 0); \
        __builtin_amdgcn_global_load_lds((const unsigned*)(Vt + t_ * 16384 + (wid + 8) * 1024 + lo16), (LAS unsigned*)(sl_ + V_OFF + (wid + 8) * 1024), 16, 0, 0); } while (0)
#define ATT_SYNC() do { asm volatile("s_waitcnt vmcnt(0)" ::: "memory"); __builtin_amdgcn_s_barrier(); asm volatile("" ::: "memory"); } while (0)
#define RESC(a) do { if (__any((a) < 1.f)) { if (hi == 0) al_l[r32] = (a); asm volatile("s_waitcnt lgkmcnt(0)" ::: "memory"); \
        _Pragma("unroll") for (int d = 0; d < 4; ++d) _Pragma("unroll") for (int r = 0; r < 16; ++r) o[d][r] *= al_l[crow(r, hi)]; } } while (0)
    f32x16 pA0, pA1, pB0, pB1; float mnA, mnB, alA, alB; bf16x8 pa0, pa1, pa2, pa3;
    int sp = 0, sc = SLOT, sn = 2 * SLOT;
    ATT_DMA(0, 0); ATT_DMA(1, SLOT);
    asm volatile("s_waitcnt vmcnt(5)" ::: "memory"); __builtin_amdgcn_s_barrier(); asm volatile("" ::: "memory");
    qkt(pA0, pA1, lds, qr, r32, hi); partialSM(pA0, pA1, m_reg, mnA, alA);
    for (int j = 1; j + 1 < NT; j += 2) {
        ATT_SYNC(); ATT_DMA(j + 1, sn);
        SBAR(); qkt(pB0, pB1, lds + sc, qr, r32, hi);
        finishSM(pA0, pA1, alA, l_reg, pa0, pa1, pa2, pa3); SBAR();
        pv_d0(o, vrb + sp, pa0, pa1, pa2, pa3); partialSM(pB0, pB1, m_reg, mnB, alB);
        RESC(alB);
        { const int t_ = sp; sp = sc; sc = sn; sn = t_; }
        ATT_SYNC(); if (j + 2 < NT) ATT_DMA(j + 2, sn);
        SBAR(); qkt(pA0, pA1, lds + sc, qr, r32, hi);
        finishSM(pB0, pB1, alB, l_reg, pa0, pa1, pa2, pa3); SBAR();
        pv_d0(o, vrb + sp, pa0, pa1, pa2, pa3); partialSM(pA0, pA1, m_reg, mnA, alA);
        RESC(alA);
        { const int t_ = sp; sp = sc; sc = sn; sn = t_; }
    }
    ATT_SYNC();
    SBAR(); qkt(pB0, pB1, lds + sc, qr, r32, hi);
    finishSM(pA0, pA1, alA, l_reg, pa0, pa1, pa2, pa3); SBAR();
    pv_d0(o, vrb + sp, pa0, pa1, pa2, pa3); partialSM(pB0, pB1, m_reg, mnB, alB);
    RESC(alB);
    finishSM(pB0, pB1, alB, l_reg, pa0, pa1, pa2, pa3); SBAR();
    pv_d0(o, vrb + sc, pa0, pa1, pa2, pa3);
    if (hi == 0) li_l[r32] = l_reg; asm volatile("s_waitcnt lgkmcnt(0)" ::: "memory");
    float rli[16];
#pragma unroll
    for (int r = 0; r < 16; ++r) rli[r] = __builtin_amdgcn_rcpf(li_l[crow(r, hi)]);
    bf16_t* Ow = Ob + (size_t)(wid * 32) * 2048;
#pragma unroll
    for (int r = 0; r < 16; ++r) { const int orow = crow(r, hi);
#pragma unroll
        for (int d0 = 0; d0 < 4; ++d0) Ow[(size_t)orow * 2048 + d0 * 32 + r32] = f2bf(o[d0][r] * rli[r]); }
    __builtin_amdgcn_s_barrier(); asm volatile("" ::: "memory");
#undef ATT_DMA
#undef ATT_SYNC
#undef RESC
}
}

namespace att8 {
constexpr int SLOT = 20480, KN_OFF = 0, KR_OFF = 8192, V_OFF = 12288, LDS_BYTES = 3 * SLOT + 8 * 256;
constexpr float THR2 = 8.0f;
constexpr float QUP = 8.f; constexpr int SC_ONE = 0x7f7f7f7f, SC_Q = 0x7c7c7c7c;
__host__ __device__ __forceinline__ int kn8(int key, int b) { return key * 128 + ((((b >> 4) ^ ((key >> 1) & 7))) << 4) + (b & 15); }
__host__ __device__ __forceinline__ int kr8(int key, int b) { return key * 64 + ((((b >> 4) ^ ((key >> 2) & 3))) << 4) + (b & 15); }
__host__ __device__ __forceinline__ int vslot(int k) { return 32 * ((k >> 2) & 1) + 16 * (k >> 5) + (k & 3) + 4 * ((k & 31) >> 3); }
__host__ __device__ __forceinline__ int v8(int d, int k) { const int sl = vslot(k); return d * 64 + ((((sl >> 4) ^ ((d >> 2) & 3))) << 4) + (sl & 15); }
__device__ __forceinline__ i32x8 ld32(const LAS unsigned char* a0, const LAS unsigned char* a1) { const u32x4 x = *(const LAS u32x4*)a0, y = *(const LAS u32x4*)a1;
    return (i32x8){(int)x.x, (int)x.y, (int)x.z, (int)x.w, (int)y.x, (int)y.y, (int)y.z, (int)y.w}; }
__device__ __forceinline__ void qkt(f32x16& p0, f32x16& p1, LAS unsigned char* slot, const i32x8* qf, int r32, int hi) {
    p0 = f32x16{}; p1 = f32x16{};
#pragma unroll
    for (int ks = 0; ks < 2; ++ks) { const int b = 64 * ks + 32 * hi;
        const i32x8 a0 = ld32(slot + KN_OFF + kn8(r32, b), slot + KN_OFF + kn8(r32, b + 16)), a1 = ld32(slot + KN_OFF + kn8(32 + r32, b), slot + KN_OFF + kn8(32 + r32, b + 16));
        p0 = __builtin_amdgcn_mfma_scale_f32_32x32x64_f8f6f4(a0, qf[ks], p0, 0, 0, 0, SC_ONE, 0, SC_Q);
        p1 = __builtin_amdgcn_mfma_scale_f32_32x32x64_f8f6f4(a1, qf[ks], p1, 0, 0, 0, SC_ONE, 0, SC_Q); }
    { const int b = 32 * hi;
        const i32x8 a0 = ld32(slot + KR_OFF + kr8(r32, b), slot + KR_OFF + kr8(r32, b + 16)), a1 = ld32(slot + KR_OFF + kr8(32 + r32, b), slot + KR_OFF + kr8(32 + r32, b + 16));
        p0 = __builtin_amdgcn_mfma_scale_f32_32x32x64_f8f6f4(a0, qf[2], p0, 0, 0, 0, SC_ONE, 0, SC_Q);
        p1 = __builtin_amdgcn_mfma_scale_f32_32x32x64_f8f6f4(a1, qf[2], p1, 0, 0, 0, SC_ONE, 0, SC_Q); }
}
__device__ __forceinline__ void partialSM(f32x16& p0, f32x16& p1, float& m_reg, float& mn, float& alpha) {
    float pmax = p0[0];
#pragma unroll
    for (int r = 1; r < 16; ++r) pmax = fmaxf(pmax, p0[r]);
#pragma unroll
    for (int r = 0; r < 16; ++r) pmax = fmaxf(pmax, p1[r]);
    { auto rr = __builtin_amdgcn_permlane32_swap(__float_as_uint(pmax), __float_as_uint(pmax), false, false);
      pmax = fmaxf(__uint_as_float(rr[0]), __uint_as_float(rr[1])); }
    if (__builtin_expect(__all(pmax - m_reg <= THR2), 1)) { mn = m_reg; alpha = 1.f; }
    else { mn = fmaxf(m_reg, pmax); alpha = __builtin_amdgcn_exp2f(m_reg - mn); m_reg = mn; }
#pragma unroll
    for (int r = 0; r < 16; ++r) p0[r] = __builtin_amdgcn_exp2f(p0[r] - mn);
#pragma unroll
    for (int r = 0; r < 16; ++r) p1[r] = p1[r] - mn;
}
__device__ __forceinline__ void finishSM(f32x16& p0, f32x16& p1, float alpha, float& l_reg, i32x8& pf) {
#pragma unroll
    for (int r = 0; r < 16; ++r) p1[r] = __builtin_amdgcn_exp2f(p1[r]);
    float ps = 0;
#pragma unroll
    for (int r = 0; r < 16; ++r) ps += p0[r];
#pragma unroll
    for (int r = 0; r < 16; ++r) ps += p1[r];
    { auto rr = __builtin_amdgcn_permlane32_swap(__float_as_uint(ps), __float_as_uint(ps), false, false);
      ps = __uint_as_float(rr[0]) + __uint_as_float(rr[1]); }
    l_reg = l_reg * alpha + ps;
#pragma unroll
    for (int w = 0; w < 4; ++w) { pf[w] = (int)pk4_fp8(p0[4 * w], p0[4 * w + 1], p0[4 * w + 2], p0[4 * w + 3]); pf[4 + w] = (int)pk4_fp8(p1[4 * w], p1[4 * w + 1], p1[4 * w + 2], p1[4 * w + 3]); }
}
__device__ __forceinline__ void pv(f32x16* o, LAS unsigned char* slot, const i32x8 pf, int r32, int hi) {
#pragma unroll
    for (int d0 = 0; d0 < 4; ++d0) { const int d = 32 * d0 + r32, sw = (d >> 2) & 3;
        const i32x8 b = ld32(slot + V_OFF + d * 64 + (((2 * hi) ^ sw) << 4), slot + V_OFF + d * 64 + (((2 * hi + 1) ^ sw) << 4));
        o[d0] = __builtin_amdgcn_mfma_scale_f32_32x32x64_f8f6f4(pf, b, o[d0], 0, 0, 0, SC_ONE, 0, SC_ONE); }
}
__device__ __forceinline__ int crow(int r, int hi) { return (r & 3) + 8 * (r >> 2) + 4 * hi; }
__device__ __forceinline__ void attn_unit(const unsigned char* __restrict__ Qb, const unsigned char* __restrict__ KNt, const unsigned char* __restrict__ KRt, const unsigned char* __restrict__ Vt,
                                          bf16_t* __restrict__ Ob, int NT, LAS unsigned char* lds) {
    const int tid = otid(), wid = __builtin_amdgcn_readfirstlane(tid >> 6), lane = tid & 63, r32 = lane & 31, hi = lane >> 5;
    LAS float* wsf = (LAS float*)(lds + 3 * SLOT) + wid * 64; LAS float* li_l = wsf; LAS float* al_l = wsf + 32;
    float m_reg = -1e30f, l_reg = 0; f32x16 o[4] = {}; i32x8 qf[3];
    const unsigned char* Qw = Qb + (size_t)(wid * 32 + r32) * 192 + 32 * hi;
#pragma unroll
    for (int ks = 0; ks < 3; ++ks) { const u32x4 x = *(const u32x4*)(Qw + 64 * ks), y = *(const u32x4*)(Qw + 64 * ks + 16); qf[ks] = (i32x8){(int)x.x, (int)x.y, (int)x.z, (int)x.w, (int)y.x, (int)y.y, (int)y.z, (int)y.w}; }
    const unsigned lo16 = (unsigned)lane * 16u;
#define ATT_DMA(tile, slotoff) do { const size_t t_ = (size_t)(tile); LAS unsigned char* sl_ = lds + (slotoff); \
        __builtin_amdgcn_global_load_lds((const unsigned*)(KNt + t_ * 8192 + wid * 1024 + lo16), (LAS unsigned*)(sl_ + KN_OFF + wid * 1024), 16, 0, 0); \
        __builtin_amdgcn_global_load_lds((const unsigned*)(Vt + t_ * 8192 + wid * 1024 + lo16), (LAS unsigned*)(sl_ + V_OFF + wid * 1024), 16, 0, 0); \
        if (wid < 4) __builtin_amdgcn_global_load_lds((const unsigned*)(KRt + t_ * 4096 + wid * 1024 + lo16), (LAS unsigned*)(sl_ + KR_OFF + wid * 1024), 16, 0, 0); } while (0)
#define ATT_SYNC() do { asm volatile("s_waitcnt vmcnt(0)" ::: "memory"); __builtin_amdgcn_s_barrier(); asm volatile("" ::: "memory"); } while (0)
#define RESC(a) do { if (__any((a) < 1.f)) { if (hi == 0) al_l[r32] = (a); asm volatile("s_waitcnt lgkmcnt(0)" ::: "memory"); \
        _Pragma("unroll") for (int d = 0; d < 4; ++d) _Pragma("unroll") for (int r = 0; r < 16; ++r) o[d][r] *= al_l[crow(r, hi)]; } } while (0)
    f32x16 pA0, pA1, pB0, pB1; float mnA, mnB, alA, alB; i32x8 pf;
    int sp = 0, sc = SLOT, sn = 2 * SLOT;
    ATT_DMA(0, 0);
    ATT_SYNC();
    ATT_DMA(1, SLOT);
    qkt(pA0, pA1, lds, qf, r32, hi); partialSM(pA0, pA1, m_reg, mnA, alA);
    for (int j = 1; j + 1 < NT; j += 2) {
        ATT_SYNC(); ATT_DMA(j + 1, sn);
        SBAR(); qkt(pB0, pB1, lds + sc, qf, r32, hi);
        finishSM(pA0, pA1, alA, l_reg, pf); SBAR();
        pv(o, lds + sp, pf, r32, hi); partialSM(pB0, pB1, m_reg, mnB, alB);
        RESC(alB);
        { const int t_ = sp; sp = sc; sc = sn; sn = t_; }
        ATT_SYNC(); if (j + 2 < NT) ATT_DMA(j + 2, sn);
        SBAR(); qkt(pA0, pA1, lds + sc, qf, r32, hi);
        finishSM(pB0, pB1, alB, l_reg, pf); SBAR();
        pv(o, lds + sp, pf, r32, hi); partialSM(pA0, pA1, m_reg, mnA, alA);
        RESC(alA);
        { const int t_ = sp; sp = sc; sc = sn; sn = t_; }
    }
    ATT_SYNC();
    SBAR(); qkt(pB0, pB1, lds + sc, qf, r32, hi);
    finishSM(pA0, pA1, alA, l_reg, pf); SBAR();
    pv(o, lds + sp, pf, r32, hi); partialSM(pB0, pB1, m_reg, mnB, alB);
    RESC(alB);
    finishSM(pB0, pB1, alB, l_reg, pf); SBAR();
    pv(o, lds + sc, pf, r32, hi);
    if (hi == 0) li_l[r32] = l_reg; asm volatile("s_waitcnt lgkmcnt(0)" ::: "memory");
    float rli[16];
#pragma unroll
    for (int r = 0; r < 16; ++r) rli[r] = __builtin_amdgcn_rcpf(li_l[crow(r, hi)]);
    bf16_t* Ow = Ob + (size_t)(wid * 32) * 2048;
#pragma unroll
    for (int r = 0; r < 16; ++r) { const int orow = crow(r, hi);
#pragma unroll
        for (int d0 = 0; d0 < 4; ++d0) Ow[(size_t)orow * 2048 + d0 * 32 + r32] = f2bf(o[d0][r] * rli[r]); }
    __builtin_amdgcn_s_barrier(); asm volatile("" ::: "memory");
#undef ATT_DMA
#undef ATT_SYNC
#undef RESC
}
}

namespace ssd {
constexpr int XT_OFF = 0, XTW_OFF = 8704, BT_OFF = 17408, HB_OFF = 52224, SET = 60928, CW_OFF = 2 * SET, LDS_BYTES = CW_OFF + 8 * 512;
constexpr int PITCH = 272;
constexpr float L2E = 1.4426950408889634f;
__device__ __forceinline__ void g_unit(const bf16_t* __restrict__ BC, bf16_t* __restrict__ G, int unit) {
    const int cid = unit >> 1, g = unit & 1;
    const int r0 = cid < 256 ? cid * 128 : NLAT + (cid - 256) * 128;
    const int tid = otid(), wid = tid >> 6, lane = tid & 63, fr = lane & 15, fq = lane >> 4;
    const bf16_t* Cp = BC + (size_t)(r0 + 16 * wid + fr) * 512 + 256 + 128 * g + 8 * fq;
    bf16x8 cf[4];
#pragma unroll
    for (int ks = 0; ks < 4; ++ks) cf[ks] = *(const bf16x8*)(Cp + 32 * ks);
    bf16_t* Gp = G + ((size_t)unit * 128 + 16 * wid + fr) * 128 + 4 * fq;
#pragma unroll
    for (int sb = 0; sb < 8; ++sb) {
        const bf16_t* Bp = BC + (size_t)(r0 + 16 * sb + fr) * 512 + 128 * g + 8 * fq;
        f32x4 acc = {0.f, 0.f, 0.f, 0.f};
#pragma unroll
        for (int ks = 0; ks < 4; ++ks) { const bf16x8 bfr = *(const bf16x8*)(Bp + 32 * ks); acc = __builtin_amdgcn_mfma_f32_16x16x32_bf16(bfr, cf[ks], acc, 0, 0, 0); }
        u32x2 w; w.x = cvt_pk_bf16(acc[0], acc[1]); w.y = cvt_pk_bf16(acc[2], acc[3]);
        *(u32x2*)(Gp + 16 * sb) = w;
    }
}
__device__ __forceinline__ void ssd_unit(int u, const bf16_t* __restrict__ XS, const bf16_t* __restrict__ BC, const float* __restrict__ DT, const bf16_t* __restrict__ G,
                                         const float* __restrict__ a_log, bf16_t* __restrict__ Y0, bf16_t* __restrict__ Y1, LAS unsigned char* lds) {
    const int b = u >> 6, h = (u >> 2) & 15, d = (u >> 1) & 1, ph = u & 1, g = h >> 3;
    const int tid = otid(), wid = tid >> 6, lane = tid & 63, fr = lane & 15, fq = lane >> 4;
    const float a = -__expf(a_log[d * 16 + h]);
    bf16_t* Y = d ? Y1 : Y0;
    LAS float* cw = (LAS float*)(lds + CW_OFF + wid * 512);
    f32x4 hs[2] = {{0.f, 0.f, 0.f, 0.f}, {0.f, 0.f, 0.f, 0.f}};
    for (int i = tid; i < 8704 / 4; i += 512) ((LAS unsigned*)(lds + HB_OFF))[i] = 0u;
    float cend = 0.f;
#define SSD_ROWS(step, r0v, gidv) do { if ((step) < 2) { const int oc_ = d ? 1 - (step) : (step); r0v = NLAT + b * 256 + oc_ * 128; gidv = 256 + b * 2 + oc_; } \
        else { const int lc_ = (step) - 2, oc_ = d ? 63 - lc_ : lc_; r0v = b * 8192 + oc_ * 128; gidv = b * 64 + oc_; } } while (0)
    const int sg = tid & 31, n8 = tid >> 5, p4 = (tid >> 5) & 7, arr = tid >> 8;
    f32x2 P_da, Q_da; f32x4 P_dt4, Q_dt4; u32x2 P_xv[4], Q_xv[4]; u32x4 P_bv[4], Q_bv[4], n_gv[4], n_cv[4], c_gv[4], c_cv[4];
#define SSD_LOAD(step, X) do { int r0_, gid_; SSD_ROWS(step, r0_, gid_); const float* dtp_ = DT + (size_t)(d * 16 + h) * NROW + r0_; \
        X##_da = *(const f32x2*)(dtp_ + 2 * lane); X##_dt4 = *(const f32x4*)(dtp_ + 4 * sg); \
        _Pragma("unroll") for (int j_ = 0; j_ < 4; ++j_) { X##_xv[j_] = *(const u32x2*)(XS + (size_t)(r0_ + 4 * sg + j_) * 1024 + 64 * h + 32 * ph + 4 * p4); \
                                                         X##_bv[j_] = *(const u32x4*)(BC + (size_t)(r0_ + 4 * sg + j_) * 512 + 128 * g + 8 * n8); } \
        } while (0)
#define SSD_LOADGC(step) do { int r0_, gid_; SSD_ROWS(step, r0_, gid_); const int t_ = 16 * wid + fr; const bf16_t* Gp_ = G + ((size_t)(gid_ * 2 + g) * 128 + t_) * 128 + 8 * fq; const bf16_t* Cp_ = BC + (size_t)(r0_ + t_) * 512 + 256 + 128 * g + 8 * fq; \
          _Pragma("unroll") for (int ks_ = 0; ks_ < 4; ++ks_) { n_gv[ks_] = *(const u32x4*)(Gp_ + 32 * ks_); n_cv[ks_] = *(const u32x4*)(Cp_ + 32 * ks_); } } while (0)
#define SSD_GCROT() do { _Pragma("unroll") for (int ks_ = 0; ks_ < 4; ++ks_) { c_gv[ks_] = n_gv[ks_]; c_cv[ks_] = n_cv[ks_]; } } while (0)
#define SSD_WRITE(step, X) do { LAS unsigned char* set_ = lds + ((step) & 1) * SET; \
        const float da0 = X##_da.x * a, da1 = X##_da.y * a; \
        float sc_ = da0 + da1; \
        if (d == 0) { _Pragma("unroll") for (int o_ = 1; o_ < 64; o_ <<= 1) { const float t_ = __shfl_up(sc_, o_); if (lane >= o_) sc_ += t_; } \
            cw[2 * lane] = sc_ - da1; cw[2 * lane + 1] = sc_; cend = __shfl(sc_, 63); } \
        else { _Pragma("unroll") for (int o_ = 1; o_ < 64; o_ <<= 1) { const float t_ = __shfl_down(sc_, o_); if (lane + o_ < 64) sc_ += t_; } \
            cw[2 * lane] = sc_; cw[2 * lane + 1] = sc_ - da0; cend = __shfl(sc_, 0); } \
        asm volatile("s_waitcnt lgkmcnt(0)" ::: "memory"); \
        { const f32x4 cs_ = *(const LAS f32x4*)(cw + 4 * sg); float sc4_[4]; \
          _Pragma("unroll") for (int j_ = 0; j_ < 4; ++j_) sc4_[j_] = arr ? X##_dt4[j_] * __builtin_amdgcn_exp2f((cend - cs_[j_]) * L2E) : X##_dt4[j_]; \
          LAS unsigned char* xt_ = set_ + (arr ? XTW_OFF : XT_OFF) + (4 * p4) * PITCH + 8 * sg; \
          _Pragma("unroll") for (int i_ = 0; i_ < 4; ++i_) { float v_[4]; \
              _Pragma("unroll") for (int j_ = 0; j_ < 4; ++j_) { const unsigned w_ = (i_ & 2) ? X##_xv[j_].y : X##_xv[j_].x; v_[j_] = ((i_ & 1) ? bfhi(w_) : bflo(w_)) * sc4_[j_]; } \
              u32x2 o_; o_.x = cvt_pk_bf16(v_[0], v_[1]); o_.y = cvt_pk_bf16(v_[2], v_[3]); *(LAS u32x2*)(xt_ + i_ * PITCH) = o_; } } \
        { LAS unsigned char* bt_ = set_ + BT_OFF + (8 * n8) * PITCH + 8 * sg; \
          _Pragma("unroll") for (int i_ = 0; i_ < 8; ++i_) { unsigned e_[4]; \
              _Pragma("unroll") for (int j_ = 0; j_ < 4; ++j_) { const unsigned w_ = X##_bv[j_][i_ >> 1]; e_[j_] = (i_ & 1) ? (w_ >> 16) : (w_ & 0xffffu); } \
              u32x2 o_; o_.x = e_[0] | (e_[1] << 16); o_.y = e_[2] | (e_[3] << 16); *(LAS u32x2*)(bt_ + i_ * PITCH) = o_; } } \
    } while (0)
    SSD_LOAD(0, Q); SSD_LOADGC(0); SSD_WRITE(0, Q); SSD_LOAD(1, P);
    for (int step2 = 0; step2 < 66; step2 += 2)
#pragma unroll
    for (int par = 0; par < 2; ++par) {
        const int step = step2 + par;
        __syncthreads();
        int r0, gid; SSD_ROWS(step, r0, gid); (void)gid;
        LAS unsigned char* set = lds + (step & 1) * SET;
        const float cend_cur = cend;
        SSD_GCROT();
        if (step + 1 < 66) SSD_LOADGC(step + 1);
        if (step + 2 < 66) { if (par == 0) SSD_LOAD(step + 2, Q); else SSD_LOAD(step + 2, P); }
        {
            const int t = 16 * wid + fr; const float ct = cw[t];
            f32x4 y[2] = {{0.f, 0.f, 0.f, 0.f}, {0.f, 0.f, 0.f, 0.f}};
            const float et = __builtin_amdgcn_exp2f(ct * L2E);
#pragma unroll
            for (int ks = 0; ks < 4; ++ks) {
                const bool live = d == 0 ? (32 * ks <= 16 * wid + 15) : (32 * ks + 31 >= 16 * wid);
                if (live) {
                    const int s0 = 32 * ks + 8 * fq;
                    const f32x4 c0 = *(const LAS f32x4*)(cw + s0), c1 = *(const LAS f32x4*)(cw + s0 + 4);
                    float m[8];
#pragma unroll
                    for (int i = 0; i < 8; ++i) { const float cs = i < 4 ? c0[i & 3] : c1[i & 3]; const int s = s0 + i;
                        const bool ok = d == 0 ? (s <= t) : (s >= t);
                        const float gval = (i & 1) ? bfhi(c_gv[ks][i >> 1]) : bflo(c_gv[ks][i >> 1]);
                        m[i] = ok ? gval * __builtin_amdgcn_exp2f((ct - cs) * L2E) : 0.f; }
                    u32x4 mw; mw.x = cvt_pk_bf16(m[0], m[1]); mw.y = cvt_pk_bf16(m[2], m[3]); mw.z = cvt_pk_bf16(m[4], m[5]); mw.w = cvt_pk_bf16(m[6], m[7]);
                    const bf16x8 mb = __builtin_bit_cast(bf16x8, mw);
#pragma unroll
                    for (int q = 0; q < 2; ++q) { const bf16x8 af = *(const LAS bf16x8*)(set + XT_OFF + (16 * q + fr) * PITCH + (32 * ks + 8 * fq) * 2);
                        y[q] = __builtin_amdgcn_mfma_f32_16x16x32_bf16(af, mb, y[q], 0, 0, 0); }
                }
            }
#pragma unroll
            for (int ks = 0; ks < 4; ++ks) {
                u32x4 cwv;
#pragma unroll
                for (int i = 0; i < 4; ++i) cwv[i] = cvt_pk_bf16(bflo(c_cv[ks][i]) * et, bfhi(c_cv[ks][i]) * et);
                const bf16x8 cb = __builtin_bit_cast(bf16x8, cwv);
#pragma unroll
                for (int q = 0; q < 2; ++q) { const bf16x8 af = *(const LAS bf16x8*)(set + HB_OFF + (16 * q + fr) * PITCH + (32 * ks + 8 * fq) * 2);
                    y[q] = __builtin_amdgcn_mfma_f32_16x16x32_bf16(af, cb, y[q], 0, 0, 0); }
            }
            bf16_t* yp = Y + (size_t)(r0 + t) * 1024 + 64 * h + 32 * ph + 4 * fq;
#pragma unroll
            for (int q = 0; q < 2; ++q) { u32x2 w; w.x = cvt_pk_bf16(y[q][0], y[q][1]); w.y = cvt_pk_bf16(y[q][2], y[q][3]); *(u32x2*)(yp + 16 * q) = w; }
        }
        {
            const float dec = __builtin_amdgcn_exp2f(cend_cur * L2E);
            hs[0] = hs[0] * dec; hs[1] = hs[1] * dec;
#pragma unroll
            for (int ks = 0; ks < 4; ++ks) {
                const bf16x8 bfr = *(const LAS bf16x8*)(set + BT_OFF + (16 * wid + fr) * PITCH + (32 * ks + 8 * fq) * 2);
#pragma unroll
                for (int q = 0; q < 2; ++q) { const bf16x8 af = *(const LAS bf16x8*)(set + XTW_OFF + (16 * q + fr) * PITCH + (32 * ks + 8 * fq) * 2);
                    hs[q] = __builtin_amdgcn_mfma_f32_16x16x32_bf16(af, bfr, hs[q], 0, 0, 0); }
            }
            LAS bf16_t* hb = (LAS bf16_t*)(lds + ((step + 1) & 1) * SET + HB_OFF) + 16 * wid + fr;
#pragma unroll
            for (int q = 0; q < 2; ++q)
#pragma unroll
                for (int i = 0; i < 4; ++i) hb[(16 * q + 4 * fq + i) * 136] = f2bf(hs[q][i]);
        }
        if (step + 1 < 66) { if (par == 0) SSD_WRITE(step + 1, P); else SSD_WRITE(step + 1, Q); }
    }
    __syncthreads();
#undef SSD_ROWS
#undef SSD_LOAD
#undef SSD_LOADGC
#undef SSD_GCROT
#undef SSD_WRITE
}
}

struct Args { const float* in[32]; float* out; unsigned char* ws; int ph_lo, ph_hi; };
constexpr int NTHR = 512;
constexpr int LDS_BASE = 256;
constexpr int LDS_PHASE = 133120;
constexpr int LDS_BYTES = LDS_BASE + LDS_PHASE;
static_assert(att::LDS_BYTES <= LDS_PHASE && att8::LDS_BYTES <= LDS_PHASE && ssd::LDS_BYTES <= LDS_PHASE && pg8::STAGE_BYTES <= LDS_PHASE, "LDS");

__device__ __forceinline__ void tjob(int j, const Args& A, const float*& src, bf16_t*& dst, int& K, int& N, int& Npad, int& mode, const float*& ks) {
    unsigned char* W = A.ws + WS_W; mode = 0; ks = nullptr;
    if (j < 8) { const int i = j >> 2, w = j & 3; unsigned char* base = W + W_HYB + (size_t)i * WH_SZ;
        if (w == 0)      { src = A.in[I_HWIN] + (size_t)i * 1024 * HYB_IN; dst = (bf16_t*)(base + WH_IN); K = 1024; N = HYB_IN; Npad = HYB_INP; mode = 1; }
        else if (w == 1) { src = A.in[I_WQB] + (size_t)i * 384 * 1536; dst = (bf16_t*)(base + WH_QB); K = 384; N = 1536; Npad = 1536; mode = 2; ks = A.in[I_QNG] + i * 384; }
        else if (w == 2) { src = A.in[I_WKVB] + (size_t)i * 256 * 2048; dst = (bf16_t*)(base + WH_KVB); K = 256; N = 2048; Npad = 2048; ks = A.in[I_KVNG] + i * 256; }
        else             { src = A.in[I_HWOUT] + (size_t)i * 2048 * 1024; dst = (bf16_t*)(base + WH_OUT); K = 2048; N = 1024; Npad = 1024; }
    } else if (j < 12) { const int i = (j - 8) >> 1, w = (j - 8) & 1; unsigned char* base = W + W_GM + (size_t)i * WG_SZ;
        if (w == 0) { src = A.in[I_GWIN] + (size_t)i * 1024 * 4096; dst = (bf16_t*)(base + WG_IN); K = 1024; N = 4096; Npad = 4096; }
        else        { src = A.in[I_GWOUT] + (size_t)i * 2048 * 1024; dst = (bf16_t*)(base + WG_OUT); K = 2048; N = 1024; Npad = 1024; }
    } else { const int l = j - 12; src = A.in[I_PWQ] + (size_t)l * 1024 * 2048; dst = (bf16_t*)(W + W_PEER + (size_t)l * WP_SZ + WP_Q); K = 1024; N = 2048; Npad = 2048; }
}
__device__ __forceinline__ int colmap(int mode, int n, int N) {
    if (mode == 1) { if (n >= N) return -1; if (n < C_KR) return n; const int m = n - C_KR; return C_KR + (m >> 1) + 32 * (m & 1); }
    if (mode == 2) { if (n < 1024) return (n >> 7) * 192 + (n & 127); const int m = n - 1024, h = m >> 6, mm = m & 63; return h * 192 + 128 + (mm >> 1) + 32 * (mm & 1); }
    return n;
}
__device__ __forceinline__ void phase_prologue(const Args& A, LAS unsigned char* lds) {
    const int tid = otid();
    {
        LAS float* tile = (LAS float*)lds;
        int item = blockIdx.x;
        for (int j = 0; j < 16; ++j) {
            const float* src; bf16_t* dst; int K, N, Npad, mode; const float* ks; tjob(j, A, src, dst, K, N, Npad, mode, ks);
            const int tk = K / 64, tn = Npad / 64, nt = tk * tn;
            for (; item < nt; item += gridDim.x) {
                const int k0 = (item % tk) * 64, n0 = (item / tk) * 64;
                { const int k = tid >> 3, cg = tid & 7; const float sc = ks ? ks[k0 + k] : 1.f;
#pragma unroll
                  for (int jj = 0; jj < 8; ++jj) { const int oc = colmap(mode, n0 + 8 * cg + jj, N); tile[k * 65 + 8 * cg + jj] = oc >= 0 ? src[(size_t)(k0 + k) * N + oc] * sc : 0.f; } }
                __syncthreads();
                { const int n = tid >> 3, kg = tid & 7; float v[8];
#pragma unroll
                  for (int jj = 0; jj < 8; ++jj) v[jj] = tile[(8 * kg + jj) * 65 + n];
                  u32x4 w; w.x = cvt_pk_bf16(v[0], v[1]); w.y = cvt_pk_bf16(v[2], v[3]); w.z = cvt_pk_bf16(v[4], v[5]); w.w = cvt_pk_bf16(v[6], v[7]);
                  *(u32x4*)(dst + (size_t)(n0 + n) * K + k0 + 8 * kg) = w; }
                __syncthreads();
            }
            item -= nt;
        }
    }
    {
        const int gthr = blockIdx.x * NTHR + tid, nthr = gridDim.x * NTHR;
        for (int p = gthr; p < 10 * 16384; p += nthr) {
            const int mat = p >> 14, off = (p & 16383) * 8; const float* src; bf16_t* dst;
            if (mat < 2)      { src = A.in[I_GWS] + (size_t)mat * 131072; dst = (bf16_t*)(A.ws + WS_W + W_GM + (size_t)mat * WG_SZ + WG_WS); }
            else if (mat < 6) { src = A.in[I_PK1] + (size_t)(mat - 2) * 131072; dst = (bf16_t*)(A.ws + WS_W + W_PEER + (size_t)(mat - 2) * WP_SZ + WP_K1); }
            else              { src = A.in[I_PK2] + (size_t)(mat - 6) * 131072; dst = (bf16_t*)(A.ws + WS_W + W_PEER + (size_t)(mat - 6) * WP_SZ + WP_K2); }
            const f32x4 a = *(const f32x4*)(src + off), b = *(const f32x4*)(src + off + 4);
            u32x4 w; w.x = cvt_pk_bf16(a[0], a[1]); w.y = cvt_pk_bf16(a[2], a[3]); w.z = cvt_pk_bf16(b[0], b[1]); w.w = cvt_pk_bf16(b[2], b[3]);
            *(u32x4*)(dst + off) = w;
        }
        float* rope = (float*)(A.ws + WS_ROPE);
        for (int p = gthr; p < SEQ * 32; p += nthr) { const int l = p >> 5, i = p & 31; const float pos = (float)(i < 16 ? (l >> 6) : (l & 63));
            const float inv = powf(10000.f, -(float)(i & 15) / 16.f), ang = pos * inv; rope[p] = cosf(ang); rope[SEQ * 32 + p] = sinf(ang); }
    }
    {
        LAS float* scond = (LAS float*)lds;
        LAS float* red = scond + 5 * 1024;
        __syncthreads();
        for (int i = tid; i < 5 * 1024; i += NTHR) { const int m = i >> 10, k = i & 1023; const float c = m < 4 ? A.in[I_C][m * 1024 + k] : A.in[I_CCTX][k]; scond[i] = silu_f(c); }
        __syncthreads();
        float* MOD = (float*)(A.ws + WS_MOD);
        for (int item = blockIdx.x; item < 4 * 48; item += gridDim.x) {
            const int layer = item / 48, j0 = (item % 48) * 128; const int c4 = tid & 31, ksl = tid >> 5;
            f32x4 acc[5];
#pragma unroll
            for (int m = 0; m < 5; ++m) acc[m] = (f32x4){0.f, 0.f, 0.f, 0.f};
            const float* wp = A.in[I_ADAW] + ((size_t)layer * 1024 + ksl * 64) * 6144 + j0 + 4 * c4;
            for (int k = 0; k < 64; ++k) { const f32x4 w = *(const f32x4*)(wp + (size_t)k * 6144);
#pragma unroll
                for (int m = 0; m < 5; ++m) acc[m] += w * scond[m * 1024 + ksl * 64 + k]; }
#pragma unroll
            for (int m = 0; m < 5; ++m) *(LAS f32x4*)(red + (ksl * 5 + m) * 128 + 4 * c4) = acc[m];
            __syncthreads();
            for (int i = tid; i < 640; i += NTHR) { const int m = i >> 7, c = i & 127; float s = A.in[I_ADAB][layer * 6144 + j0 + c];
#pragma unroll
                for (int q = 0; q < 16; ++q) s += red[(q * 5 + m) * 128 + c];
                MOD[((size_t)layer * 5 + m) * 6144 + j0 + c] = s; }
            __syncthreads();
        }
    }
}

__device__ __forceinline__ void phase_norm_mod(const float* xl, const float* xc, float* cl, float* cc, const float* g, const float* modl, int sh_idx, bf16_t* H, int nrows) {
    const int tid_ = otid(); const int lane = tid_ & 63, gw = blockIdx.x * 8 + (tid_ >> 6), nw = gridDim.x * 8;
    f32x4 gv[4];
#pragma unroll
    for (int i = 0; i < 4; ++i) gv[i] = *(const f32x4*)(g + 256 * i + 4 * lane);
    for (int r = gw; r < nrows; r += nw) {
        const bool lat = r < NLAT; const float* xp = lat ? xl + (size_t)r * D : xc + (size_t)(r - NLAT) * D;
        f32x4 x[4]; float ss = 0.f;
#pragma unroll
        for (int i = 0; i < 4; ++i) { x[i] = *(const f32x4*)(xp + 256 * i + 4 * lane); ss += x[i][0] * x[i][0] + x[i][1] * x[i][1] + x[i][2] * x[i][2] + x[i][3] * x[i][3]; }
        if (cl) { float* cp = lat ? cl + (size_t)r * D : cc + (size_t)(r - NLAT) * D;
#pragma unroll
            for (int i = 0; i < 4; ++i) *(f32x4*)(cp + 256 * i + 4 * lane) = x[i]; }
        ss = wave_sum(ss); const float rstd = rsqrtf(ss * (1.f / 1024.f) + EPS);
        const float* mp = modl + (size_t)(lat ? (r >> 13) : 4) * 6144 + sh_idx * 1024;
#pragma unroll
        for (int i = 0; i < 4; ++i) { const f32x4 sh = *(const f32x4*)(mp + 256 * i + 4 * lane), sc = *(const f32x4*)(mp + 1024 + 256 * i + 4 * lane);
            const f32x4 hv = (x[i] * rstd) * gv[i] * (sc + 1.f) + sh;
            u32x2 w; w.x = cvt_pk_bf16(hv[0], hv[1]); w.y = cvt_pk_bf16(hv[2], hv[3]);
            *(u32x2*)(H + (size_t)r * D + 256 * i + 4 * lane) = w; }
    }
}
__device__ __forceinline__ void phase_final_norm(float* xl, const float* g, float oscale) {
    const int tid_ = otid(); const int lane = tid_ & 63, gw = blockIdx.x * 8 + (tid_ >> 6), nw = gridDim.x * 8;
    f32x4 gv[4];
#pragma unroll
    for (int i = 0; i < 4; ++i) gv[i] = *(const f32x4*)(g + 256 * i + 4 * lane);
    for (int r = gw; r < NLAT; r += nw) {
        float* xp = xl + (size_t)r * D; f32x4 x[4]; float ss = 0.f;
#pragma unroll
        for (int i = 0; i < 4; ++i) { x[i] = *(const f32x4*)(xp + 256 * i + 4 * lane); ss += x[i][0] * x[i][0] + x[i][1] * x[i][1] + x[i][2] * x[i][2] + x[i][3] * x[i][3]; }
        ss = wave_sum(ss); const float rstd = rsqrtf(ss * (1.f / 1024.f) + EPS);
#pragma unroll
        for (int i = 0; i < 4; ++i) *(f32x4*)(xp + 256 * i + 4 * lane) = (x[i] * (rstd * oscale)) * gv[i];
    }
}

__device__ __forceinline__ void phase_conv(const Args& A, int li) {
    const bf16_t* PROJ = (const bf16_t*)(A.ws + WS_BIG);
    bf16_t* XS = (bf16_t*)(A.ws + WS_R2); bf16_t* BC = (bf16_t*)(A.ws + WS_R2 + R2_BC);
    const int tid = otid();
    if (tid < 384) {
        const int cg = tid % 192, half = tid / 192, c0 = 8 * cg;
        const float* cw = A.in[I_CONVW] + ((size_t)li * 1536 + c0) * 5; const float* cb = A.in[I_CONVB] + (size_t)li * 1536 + c0;
        float w[8][5], bia[8];
#pragma unroll
        for (int j = 0; j < 8; ++j) { bia[j] = cb[j];
#pragma unroll
            for (int k = 0; k < 5; ++k) w[j][k] = cw[j * 5 + k]; }
        for (int blk = blockIdx.x; blk < NROW / 64; blk += gridDim.x) {
            const int rbeg = blk * 64 + half * 32; int s0, s1;
            if (rbeg < NLAT) { s0 = rbeg & ~8191; s1 = s0 + 8192; } else { s0 = NLAT + ((rbeg - NLAT) & ~255); s1 = s0 + 256; }
            float win[5][8];
#define CONV_LD(dst, r) do { const int r_ = (r); if (r_ >= s0 && r_ < s1) { const u32x4 v_ = *(const u32x4*)(PROJ + (size_t)r_ * HYB_INP + C_XBC + c0); \
                _Pragma("unroll") for (int q_ = 0; q_ < 4; ++q_) { dst[2 * q_] = bflo(v_[q_]); dst[2 * q_ + 1] = bfhi(v_[q_]); } } \
                else { _Pragma("unroll") for (int q_ = 0; q_ < 8; ++q_) dst[q_] = 0.f; } } while (0)
            CONV_LD(win[0], rbeg - 2); CONV_LD(win[1], rbeg - 1); CONV_LD(win[2], rbeg); CONV_LD(win[3], rbeg + 1); CONV_LD(win[4], rbeg + 2);
            for (int r = rbeg; r < rbeg + 32; ++r) {
                float o[8];
#pragma unroll
                for (int j = 0; j < 8; ++j) { float s = bia[j];
#pragma unroll
                    for (int k = 0; k < 5; ++k) s += w[j][k] * win[k][j];
                    o[j] = silu_f(s); }
                u32x4 pk; pk.x = cvt_pk_bf16(o[0], o[1]); pk.y = cvt_pk_bf16(o[2], o[3]); pk.z = cvt_pk_bf16(o[4], o[5]); pk.w = cvt_pk_bf16(o[6], o[7]);
                if (c0 < 1024) *(u32x4*)(XS + (size_t)r * 1024 + c0) = pk; else *(u32x4*)(BC + (size_t)r * 512 + (c0 - 1024)) = pk;
#pragma unroll
                for (int k = 0; k < 4; ++k)
#pragma unroll
                    for (int j = 0; j < 8; ++j) win[k][j] = win[k + 1][j];
                CONV_LD(win[4], r + 3);
            }
#undef CONV_LD
        }
    }
    {
        const int lane = tid & 63, gw = blockIdx.x * 8 + (tid >> 6), nw = gridDim.x * 8;
        float* DT = (float*)(A.ws + WS_BIG + BIG_DT); float* RQ = (float*)(A.ws + WS_RSTD); float* RKV = RQ + NROW;
        unsigned char* KR = A.ws + WS_BIG + BIG_KR; const float* rope = (const float*)(A.ws + WS_ROPE);
        const float dtb = lane < 32 ? A.in[I_DTB][li * 32 + lane] : 0.f;
        for (int r = gw; r < NROW; r += nw) {
            const bf16_t* p = PROJ + (size_t)r * HYB_INP;
            if (lane < 32) DT[(size_t)lane * NROW + r] = softplus_f(bf2f(p[C_DT + (lane & 15)]) + dtb);
            { const unsigned* q = (const unsigned*)(p + C_CQ + 6 * lane); float ss = 0.f;
#pragma unroll
              for (int j = 0; j < 3; ++j) { const unsigned w = q[j]; const float a = bflo(w), b = bfhi(w); ss += a * a + b * b; }
              ss = wave_sum(ss); if (lane == 0) RQ[r] = rsqrtf(ss * (1.f / 384.f) + EPS); }
            { const u32x2 w = *(const u32x2*)(p + C_CKV + 4 * lane); const float a = bflo(w.x), b = bfhi(w.x), c = bflo(w.y), d = bfhi(w.y);
              float ss = a * a + b * b + c * c + d * d; ss = wave_sum(ss); if (lane == 0) RKV[r] = rsqrtf(ss * (1.f / 256.f) + EPS); }
            if (lane < 32) { const unsigned w = *(const unsigned*)(p + C_KR + 2 * lane); float x1 = bflo(w), x2 = bfhi(w); int b, key;
                if (r < NLAT) { const int l = r & 8191; const float c = rope[l * 32 + lane], s = rope[SEQ * 32 + l * 32 + lane];
                    const float o1 = x1 * c - x2 * s, o2 = x1 * s + x2 * c; x1 = o1; x2 = o2; b = r >> 13; key = 256 + l; }
                else { b = (r - NLAT) >> 8; key = (r - NLAT) & 255; }
                { int w8 = 0; w8 = __builtin_amdgcn_cvt_pk_fp8_f32(x1, x2, w8, false);
                  *(unsigned short*)(KR + (size_t)(b * NKT + (key >> 6)) * 4096 + att8::kr8(key & 63, 2 * lane)) = (unsigned short)(w8 & 0xffff); } }
        }
    }
}

struct EpiQ {
    static constexpr bool PERM = true;
    unsigned char* Q; const float* rstd; const float* rope;
    __device__ __forceinline__ void operator()(const f32x4 (&acc)[2][2][4][2], const pg8::Unit& u, int wr, int wc, int fr, int fq) const {
        const bool lat = u.pm < 128;
        const int b = lat ? (u.pm >> 5) : (u.pm - 128), q0 = lat ? 256 + ((u.pm & 31) << 8) : 0;
        const bool isrope = u.pn >= 4;
#pragma unroll
        for (int ai = 0; ai < 2; ++ai) {
            const int rl = 128 * ai + 64 * wr + fr;
            const float* rsp = rstd + u.pm * 256 + rl;
            const float* rp = rope + (size_t)(((u.pm & 31) << 8) + rl) * 32;
#pragma unroll
            for (int bj = 0; bj < 2; ++bj) {
                const int c0 = u.pn * 256 + 128 * bj + 32 * wc + 8 * fq; int h, dcol;
                if (!isrope) { h = c0 >> 7; dcol = c0 & 127; } else { const int mq = c0 - 1024; h = mq >> 6; dcol = 128 + (mq & 63); }
                unsigned char* dst = Q + ((size_t)(b * 8 + h) * NKEY + q0 + rl) * 192 + dcol;
                const int ro = (dcol - 128) >> 1;
#pragma unroll
                for (int m = 0; m < 4; ++m) {
                    const float rs = rsp[16 * m] * (QSCALE * att8::QUP);
                    f32x4 v0 = acc[ai][bj][m][0] * rs, v1 = acc[ai][bj][m][1] * rs;
                    if (isrope && lat) { const f32x4 cs = *(const f32x4*)(rp + 16 * m * 32 + ro), sn = *(const f32x4*)(rp + SEQ * 32 + 16 * m * 32 + ro);
                        const f32x4 a0 = v0, a1 = v1;
                        v0[0] = a0[0] * cs[0] - a0[1] * sn[0]; v0[1] = a0[0] * sn[0] + a0[1] * cs[0]; v0[2] = a0[2] * cs[1] - a0[3] * sn[1]; v0[3] = a0[2] * sn[1] + a0[3] * cs[1];
                        v1[0] = a1[0] * cs[2] - a1[1] * sn[2]; v1[1] = a1[0] * sn[2] + a1[1] * cs[2]; v1[2] = a1[2] * cs[3] - a1[3] * sn[3]; v1[3] = a1[2] * sn[3] + a1[3] * cs[3]; }
                    u32x2 w; w.x = pk4_fp8(v0[0], v0[1], v0[2], v0[3]); w.y = pk4_fp8(v1[0], v1[1], v1[2], v1[3]);
                    *(u32x2*)(dst + 16 * m * 192) = w;
                    asm volatile("" ::: "memory");
                }
            }
        }
    }
};
struct EpiKV {
    static constexpr bool PERM = true;
    unsigned char* KN; unsigned char* V; const float* rstd;
    __device__ __forceinline__ void operator()(const f32x4 (&acc)[2][2][4][2], const pg8::Unit& u, int wr, int wc, int fr, int fq) const {
        const bool lat = u.pm < 128;
        const int b = lat ? (u.pm >> 5) : (u.pm - 128), t0 = lat ? 4 + ((u.pm & 31) << 2) : 0;
        const int dd = 32 * wc + 8 * fq;
        const int offK = fr * 128 + ((((dd >> 4) ^ ((fr >> 1) & 7))) << 4) + (dd & 15);
#pragma unroll
        for (int ai = 0; ai < 2; ++ai) {
            const size_t tb = ((size_t)(b * 8 + u.pn) * NKT + t0 + 2 * ai + wr) * 8192;
            const float* rsp = rstd + u.pm * 256 + 128 * ai + 64 * wr + fr;
            unsigned char* kp = KN + tb + offK; unsigned char* vp = V + tb;
#pragma unroll
            for (int m = 0; m < 4; ++m) {
                const float rs = rsp[16 * m];
                { const f32x4 v0 = acc[ai][0][m][0] * rs, v1 = acc[ai][0][m][1] * rs; u32x2 w; w.x = pk4_fp8(v0[0], v0[1], v0[2], v0[3]); w.y = pk4_fp8(v1[0], v1[1], v1[2], v1[3]);
                  *(u32x2*)(kp + m * 2048) = w; }
                { const f32x4 v0 = acc[ai][1][m][0] * rs, v1 = acc[ai][1][m][1] * rs; const unsigned w0 = pk4_fp8(v0[0], v0[1], v0[2], v0[3]), w1 = pk4_fp8(v1[0], v1[1], v1[2], v1[3]);
                  const int sl = att8::vslot(16 * m + fr);
#pragma unroll
                  for (int i = 0; i < 8; ++i) { const int d = dd + i; vp[d * 64 + ((((sl >> 4) ^ ((d >> 2) & 3))) << 4) + (sl & 15)] = (unsigned char)(((i < 4 ? w0 : w1) >> (8 * (i & 3))) & 0xffu); } }
                asm volatile("" ::: "memory");
            }
        }
    }
};

__device__ __forceinline__ void phase_ssd_out(const Args& A, int li, int nrows) {
    const bf16_t* PROJ = (const bf16_t*)(A.ws + WS_BIG); const bf16_t* XS = (const bf16_t*)(A.ws + WS_R2);
    const bf16_t* Y0 = (const bf16_t*)(A.ws + WS_H); const bf16_t* Y1 = (const bf16_t*)(A.ws + WS_R3); bf16_t* CAT = (bf16_t*)(A.ws + WS_R3 + R3_CAT);
    const int tid_ = otid(); const int lane = tid_ & 63, gw = blockIdx.x * 8 + (tid_ >> 6), nw = gridDim.x * 8;
    const float dsk = A.in[I_SSDD][li * 16 + (lane >> 2)];
    float ng[16];
#pragma unroll
    for (int j = 0; j < 16; ++j) ng[j] = A.in[I_SSDNG][li * 1024 + 16 * lane + j];
    for (int r = gw; r < nrows; r += nw) {
        float v[16]; float ss = 0.f;
#pragma unroll
        for (int hh = 0; hh < 2; ++hh) {
            const u32x4 a = *(const u32x4*)(Y0 + (size_t)r * 1024 + 16 * lane + 8 * hh), b = *(const u32x4*)(Y1 + (size_t)r * 1024 + 16 * lane + 8 * hh);
            const u32x4 x = *(const u32x4*)(XS + (size_t)r * 1024 + 16 * lane + 8 * hh), z = *(const u32x4*)(PROJ + (size_t)r * HYB_INP + 16 * lane + 8 * hh);
#pragma unroll
            for (int q = 0; q < 4; ++q) {
                const float y0 = (bflo(a[q]) + bflo(b[q]) + dsk * bflo(x[q])) * silu_f(bflo(z[q])), y1 = (bfhi(a[q]) + bfhi(b[q]) + dsk * bfhi(x[q])) * silu_f(bfhi(z[q]));
                v[8 * hh + 2 * q] = y0; v[8 * hh + 2 * q + 1] = y1; ss += y0 * y0 + y1 * y1; }
        }
#pragma unroll
        for (int o = 16; o >= 1; o >>= 1) ss += __shfl_xor(ss, o);
        const float rstd = rsqrtf(ss * (1.f / 512.f) + EPS);
#pragma unroll
        for (int hh = 0; hh < 2; ++hh) { u32x4 w;
#pragma unroll
            for (int q = 0; q < 4; ++q) w[q] = cvt_pk_bf16(v[8 * hh + 2 * q] * rstd * ng[8 * hh + 2 * q], v[8 * hh + 2 * q + 1] * rstd * ng[8 * hh + 2 * q + 1]);
            *(u32x4*)(CAT + (size_t)r * 2048 + 16 * lane + 8 * hh) = w; }
    }
}

__device__ __forceinline__ void phase_ln_stats(const Args& A, int nrows) {
    const bf16_t* Gb = (const bf16_t*)(A.ws + WS_BIG); float* ST = (float*)(A.ws + WS_RSTD);
    const int tid_ = otid(); const int lane = tid_ & 63, gw = blockIdx.x * 8 + (tid_ >> 6), nw = gridDim.x * 8;
    for (int r = gw; r < nrows; r += nw) {
        float v[32]; float s = 0.f;
#pragma unroll
        for (int j = 0; j < 4; ++j) { const u32x4 w = *(const u32x4*)(Gb + (size_t)r * 4096 + 2048 + 512 * j + 8 * lane);
#pragma unroll
            for (int q = 0; q < 4; ++q) { v[8 * j + 2 * q] = bflo(w[q]); v[8 * j + 2 * q + 1] = bfhi(w[q]); s += v[8 * j + 2 * q] + v[8 * j + 2 * q + 1]; } }
        s = wave_sum(s); const float mu = s * (1.f / 2048.f); float q2 = 0.f;
#pragma unroll
        for (int j = 0; j < 32; ++j) { const float dd = v[j] - mu; q2 += dd * dd; }
        q2 = wave_sum(q2);
        if (lane == 0) { ST[r] = mu; ST[NROW + r] = rsqrtf(q2 * (1.f / 2048.f) + EPS); }
    }
}
__device__ __forceinline__ void phase_spatial(const Args& A, int gi, int nrows, LAS unsigned char* lds) {
    const bf16_t* Gb = (const bf16_t*)(A.ws + WS_BIG); const float* ST = (const float*)(A.ws + WS_RSTD); bf16_t* Ab = (bf16_t*)(A.ws + WS_R1);
    const bf16_t* WSg = (const bf16_t*)(A.ws + WS_W + W_GM + (size_t)gi * WG_SZ + WG_WS);
    const float* lng = A.in[I_GLNG] + (size_t)gi * 2048; const float* lnb = A.in[I_GLNB] + (size_t)gi * 2048; const float* bs = A.in[I_GBS] + (size_t)gi * 1024;
    const int tid = otid(), wid = tid >> 6, lane = tid & 63, r32 = lane & 31, hi = lane >> 5, tb = wid & 3, dh = wid >> 2;
    const int ldsaddr = (int)(unsigned)(uintptr_t)lds;
    for (int unit = blockIdx.x; unit < (nrows / 128) * 8; unit += gridDim.x) {
        const int cb = unit >> 3, gg = unit & 7, r0 = cb * 128;
        __syncthreads();
#pragma unroll
        for (int j = 0; j < 8; ++j) { const int idx = tid + 512 * j, s = idx >> 5, dd = (idx & 31) * 8;
            const u32x4 w = *(const u32x4*)(Gb + (size_t)(r0 + s) * 4096 + 2048 + 256 * gg + dd);
            const float mu = ST[r0 + s], rs = ST[NROW + r0 + s];
            const f32x4 g0 = *(const f32x4*)(lng + 256 * gg + dd), g1 = *(const f32x4*)(lng + 256 * gg + dd + 4), b0 = *(const f32x4*)(lnb + 256 * gg + dd), b1 = *(const f32x4*)(lnb + 256 * gg + dd + 4);
            u32x4 o;
            o.x = cvt_pk_bf16((bflo(w.x) - mu) * rs * g0[0] + b0[0], (bfhi(w.x) - mu) * rs * g0[1] + b0[1]); o.y = cvt_pk_bf16((bflo(w.y) - mu) * rs * g0[2] + b0[2], (bfhi(w.y) - mu) * rs * g0[3] + b0[3]);
            o.z = cvt_pk_bf16((bflo(w.z) - mu) * rs * g1[0] + b1[0], (bfhi(w.z) - mu) * rs * g1[1] + b1[1]); o.w = cvt_pk_bf16((bflo(w.w) - mu) * rs * g1[2] + b1[2], (bfhi(w.w) - mu) * rs * g1[3] + b1[3]);
            *(LAS u32x4*)(lds + ((s >> 6) * 2 + (dd >> 7)) * 16384 + att::v_st(s & 63, dd & 127)) = o; }
        bf16x8 pa[8];
#pragma unroll
        for (int ks = 0; ks < 8; ++ks) pa[ks] = *(const bf16x8*)(WSg + ((size_t)gg * 128 + 32 * tb + r32) * 128 + 16 * ks + 8 * hi);
        __syncthreads();
        f32x16 o[4] = {};
#define SP_PV(D0, vbase, p0, p1, p2, p3) do { \
            const s16x4 l0 = att::tr_read<att::v_rd_off(D0, 0, 0)>(vbase), h0 = att::tr_read<att::v_rd_off(D0, 0, 1)>(vbase), l1 = att::tr_read<att::v_rd_off(D0, 1, 0)>(vbase), h1 = att::tr_read<att::v_rd_off(D0, 1, 1)>(vbase); \
            const s16x4 l2 = att::tr_read<att::v_rd_off(D0, 2, 0)>(vbase), h2 = att::tr_read<att::v_rd_off(D0, 2, 1)>(vbase), l3 = att::tr_read<att::v_rd_off(D0, 3, 0)>(vbase), h3 = att::tr_read<att::v_rd_off(D0, 3, 1)>(vbase); \
            asm volatile("s_waitcnt lgkmcnt(0)" ::: "memory"); __builtin_amdgcn_sched_barrier(0); \
            o[D0] = __builtin_amdgcn_mfma_f32_32x32x16_bf16((bf16x8){l0[0], l0[1], l0[2], l0[3], h0[0], h0[1], h0[2], h0[3]}, p0, o[D0], 0, 0, 0); \
            o[D0] = __builtin_amdgcn_mfma_f32_32x32x16_bf16((bf16x8){l1[0], l1[1], l1[2], l1[3], h1[0], h1[1], h1[2], h1[3]}, p1, o[D0], 0, 0, 0); \
            o[D0] = __builtin_amdgcn_mfma_f32_32x32x16_bf16((bf16x8){l2[0], l2[1], l2[2], l2[3], h2[0], h2[1], h2[2], h2[3]}, p2, o[D0], 0, 0, 0); \
            o[D0] = __builtin_amdgcn_mfma_f32_32x32x16_bf16((bf16x8){l3[0], l3[1], l3[2], l3[3], h3[0], h3[1], h3[2], h3[3]}, p3, o[D0], 0, 0, 0); } while (0)
        { const int vb0 = ldsaddr + (0 * 2 + dh) * 16384 + att::v_rd_base(lane), vb1 = ldsaddr + (1 * 2 + dh) * 16384 + att::v_rd_base(lane);
          SP_PV(0, vb0, pa[0], pa[1], pa[2], pa[3]); SP_PV(1, vb0, pa[0], pa[1], pa[2], pa[3]); SP_PV(2, vb0, pa[0], pa[1], pa[2], pa[3]); SP_PV(3, vb0, pa[0], pa[1], pa[2], pa[3]);
          SP_PV(0, vb1, pa[4], pa[5], pa[6], pa[7]); SP_PV(1, vb1, pa[4], pa[5], pa[6], pa[7]); SP_PV(2, vb1, pa[4], pa[5], pa[6], pa[7]); SP_PV(3, vb1, pa[4], pa[5], pa[6], pa[7]); }
#undef SP_PV
        { const int t = 32 * tb + r32, row = r0 + t; const float bsv = bs[gg * 128 + t];
          const bf16_t* up = Gb + (size_t)row * 4096 + 256 * gg + 128 * dh + 4 * hi; bf16_t* ap = Ab + (size_t)row * 2048 + 256 * gg + 128 * dh + 4 * hi;
#pragma unroll
          for (int d0 = 0; d0 < 4; ++d0)
#pragma unroll
              for (int k = 0; k < 4; ++k) {
                  const u32x2 uu = *(const u32x2*)(up + 32 * d0 + 8 * k);
                  u32x2 w; w.x = cvt_pk_bf16(bflo(uu.x) * (o[d0][4 * k] + bsv), bfhi(uu.x) * (o[d0][4 * k + 1] + bsv)); w.y = cvt_pk_bf16(bflo(uu.y) * (o[d0][4 * k + 2] + bsv), bfhi(uu.y) * (o[d0][4 * k + 3] + bsv));
                  *(u32x2*)(ap + 32 * d0 + 8 * k) = w; } }
    }
}

constexpr int NSL = 8, SW = 1024 / NSL;
constexpr size_t TAB8_HALF = (size_t)NEXP * 1024, TAB_SCL = 2 * TAB8_HALF;
constexpr float HS = 4.f;
__device__ __forceinline__ void phase_tabcvt(const Args& A, int layer) {
    const int tid_ = otid(); const int lane = tid_ & 63, gw = blockIdx.x * 8 + (tid_ >> 6), nw = gridDim.x * 8;
    float* SCL = (float*)(A.ws + WS_TAB + TAB_SCL);
    for (int r = gw; r < 2 * NEXP; r += nw) {
        const int tab = r >> 14, e = r & (NEXP - 1);
        const float* src = (tab ? A.in[I_PV] : A.in[I_PU]) + ((size_t)layer * NEXP + e) * 1024 + 16 * lane;
        f32x4 v[4]; float am = 0.f;
#pragma unroll
        for (int i = 0; i < 4; ++i) { v[i] = *(const f32x4*)(src + 4 * i); am = fmaxf(am, fmaxf(fmaxf(fabsf(v[i][0]), fabsf(v[i][1])), fmaxf(fabsf(v[i][2]), fabsf(v[i][3])))); }
#pragma unroll
        for (int o = 32; o >= 1; o >>= 1) am = fmaxf(am, __shfl_xor(am, o));
        float sc = 1.f; if (am > 0.f) { int ex; (void)frexpf(448.f / am, &ex); sc = ldexpf(1.f, ex - 1); }
        if (lane == 0) SCL[tab * NEXP + e] = 1.f / sc;
        u32x4 w;
#pragma unroll
        for (int i = 0; i < 4; ++i) w[i] = pk4_fp8(v[i][0] * sc, v[i][1] * sc, v[i][2] * sc, v[i][3] * sc);
        *(u32x4*)(A.ws + WS_TAB + (size_t)tab * TAB8_HALF + ((size_t)(lane >> 3) * NEXP + e) * SW + 16 * (lane & 7)) = w;
    }
}
#define CASD(a, b) do { const float hi_ = fmaxf(a, b), lo_ = fminf(a, b); a = hi_; b = lo_; } while (0)
__device__ __forceinline__ void sort16(float (&k)[16]) {
#pragma unroll
    for (int sz = 2; sz <= 16; sz <<= 1)
#pragma unroll
        for (int j = sz >> 1; j > 0; j >>= 1)
#pragma unroll
            for (int i = 0; i < 16; ++i) { const int l = i ^ j; if (l > i) { if ((i & sz) == 0 || sz == 16) CASD(k[i], k[l]); else CASD(k[l], k[i]); } }
}
__device__ __forceinline__ void bmerge16(float (&k)[16]) {
#pragma unroll
    for (int j = 8; j > 0; j >>= 1)
#pragma unroll
        for (int i = 0; i < 16; ++i) { const int l = i ^ j; if (l > i) CASD(k[i], k[l]); }
}
__device__ __forceinline__ void merge_top16(float (&a)[16], const float (&b)[16]) {
#pragma unroll
    for (int i = 0; i < 16; ++i) a[i] = fmaxf(a[i], b[15 - i]);
    bmerge16(a);
}
__device__ __forceinline__ void xmerge_top16(float (&a)[16], int mask) {
    float t[16];
#pragma unroll
    for (int i = 0; i < 16; ++i) t[i] = __shfl_xor(a[15 - i], mask);
#pragma unroll
    for (int i = 0; i < 16; ++i) a[i] = fmaxf(a[i], t[i]);
    bmerge16(a);
}
__device__ __forceinline__ void phase_topk(const Args& A, int layer, int nrows, LAS unsigned char* lds) {
    const bf16_t* QP = (const bf16_t*)(A.ws + WS_BIG); int* IDX = (int*)(A.ws + WS_R2); float* GATE = (float*)(A.ws + WS_R2 + R2_GATE);
    const int tid = otid(), wid = tid >> 6, lane = tid & 63, fr = lane & 15, fq = lane >> 4;
    LAS unsigned* scr = (LAS unsigned*)(lds + 2 * 34816) + wid * 512 + fr * 32;
    for (int unit = blockIdx.x; unit < (nrows / 128) * 8; unit += gridDim.x) {
        const int h = unit & 7, r0 = (unit >> 3) * 128;
        __syncthreads();
        { const bf16_t* k1 = (const bf16_t*)(A.ws + WS_W + W_PEER + (size_t)layer * WP_SZ + WP_K1) + (size_t)h * 16384;
#pragma unroll
          for (int j = 0; j < 8; ++j) { const int idx = tid + 512 * j, half = idx >> 11, rem = idx & 2047, key = rem >> 4, c8 = rem & 15;
              const u32x4 w = *(const u32x4*)(k1 + (size_t)half * 8 * 16384 + key * 128 + 8 * c8);
              *(LAS u32x4*)(lds + half * 34816 + key * 272 + c8 * 16) = w; } }
        __syncthreads();
        const int tok = r0 + 16 * wid + fr;
        float top[2][16];
#pragma unroll
        for (int half = 0; half < 2; ++half) {
            bf16x8 qf[4];
#pragma unroll
            for (int ks = 0; ks < 4; ++ks) qf[ks] = *(const bf16x8*)(QP + (size_t)tok * 2048 + 256 * h + 128 * half + 32 * ks + 8 * fq);
            float loc[16];
#pragma unroll
            for (int grp = 0; grp < 2; ++grp) {
                float kk[16];
#pragma unroll
                for (int nbb = 0; nbb < 4; ++nbb) { const int nb = 4 * grp + nbb; f32x4 acc = {0.f, 0.f, 0.f, 0.f};
#pragma unroll
                    for (int ks = 0; ks < 4; ++ks) { const bf16x8 kf = *(const LAS bf16x8*)(lds + half * 34816 + (16 * nb + fr) * 272 + (32 * ks + 8 * fq) * 2);
                        acc = __builtin_amdgcn_mfma_f32_16x16x32_bf16(kf, qf[ks], acc, 0, 0, 0); }
#pragma unroll
                    for (int i = 0; i < 4; ++i) { const unsigned code = 127u - (unsigned)(16 * nb + 4 * fq + i); kk[4 * nbb + i] = __uint_as_float((__float_as_uint(acc[i]) & ~127u) | code); } }
                sort16(kk);
                if (grp == 0) {
#pragma unroll
                    for (int i = 0; i < 16; ++i) loc[i] = kk[i];
                } else merge_top16(loc, kk);
            }
            xmerge_top16(loc, 16); xmerge_top16(loc, 32);
#pragma unroll
            for (int i = 0; i < 16; ++i) top[half][i] = loc[i];
        }
        if (fq < 2) {
#pragma unroll
            for (int i = 0; i < 16; ++i) scr[16 * fq + i] = __float_as_uint(fq == 0 ? top[0][i] : top[1][i]); }
        float fin[16];
#pragma unroll
        for (int aa = 0; aa < 4; ++aa) {
            const float va_k = fq == 0 ? top[0][aa] : fq == 1 ? top[0][4 + aa] : fq == 2 ? top[0][8 + aa] : top[0][12 + aa];
            const float va = __uint_as_float(__float_as_uint(va_k) & ~127u);
            float c[16];
#pragma unroll
            for (int bb = 0; bb < 16; ++bb) { const float s = va + __uint_as_float(__float_as_uint(top[1][bb]) & ~127u);
                c[bb] = __uint_as_float((__float_as_uint(s) & ~255u) | (255u - (unsigned)((4 * fq + aa) * 16 + bb))); }
            if (aa == 0) {
#pragma unroll
                for (int i = 0; i < 16; ++i) fin[i] = c[i];
            } else merge_top16(fin, c);
        }
        xmerge_top16(fin, 16); xmerge_top16(fin, 32);
        float ev[16], es = 0.f; const float mx = __uint_as_float(__float_as_uint(fin[0]) & ~255u);
#pragma unroll
        for (int i = 0; i < 16; ++i) { ev[i] = __expf(__uint_as_float(__float_as_uint(fin[i]) & ~255u) - mx); es += ev[i]; }
        const float inv = 1.f / es;
        asm volatile("s_waitcnt lgkmcnt(0)" ::: "memory");
        int oi[4]; float og[4];
#pragma unroll
        for (int kq = 0; kq < 4; ++kq) {
            const float fk = fq == 0 ? fin[kq] : fq == 1 ? fin[4 + kq] : fq == 2 ? fin[8 + kq] : fin[12 + kq];
            const float fe = fq == 0 ? ev[kq] : fq == 1 ? ev[4 + kq] : fq == 2 ? ev[8 + kq] : ev[12 + kq];
            const unsigned code = 255u - (__float_as_uint(fk) & 255u), a = code >> 4, bq = code & 15u;
            const unsigned i1 = 127u - (scr[a] & 127u), i2 = 127u - (scr[16 + bq] & 127u);
            oi[kq] = (int)(i1 * 128u + i2); og[kq] = fe * inv; }
        *(int4*)(IDX + (size_t)tok * 128 + 16 * h + 4 * fq) = make_int4(oi[0], oi[1], oi[2], oi[3]);
        *(f32x4*)(GATE + (size_t)tok * 128 + 16 * h + 4 * fq) = (f32x4){og[0], og[1], og[2], og[3]};
    }
}
struct PeerSched {
    int x0, rank, nloc, nblk, nown; unsigned orphan;
    __device__ __forceinline__ void init(const Args& A, int nrows, LAS unsigned char* smem) {
        unsigned* ctl = (unsigned*)(A.ws + WS_CTL);
        x0 = (int)(xb_xcc_id() & 7u); rank = __builtin_amdgcn_readfirstlane((int)((LAS unsigned*)smem)[8]); nblk = nrows / 64;
        unsigned cached = __builtin_amdgcn_readfirstlane(((LAS unsigned*)smem)[9]);
        if (cached == 0u) { unsigned orph = 0u, nl = 1u;
            for (int j = 0; j < 8; ++j) { unsigned c = xb_ld(&ctl[XB_XCNT(j)]) + xb_ld(&ctl[XB_XCNT(j + 8)]); c = __builtin_amdgcn_readfirstlane(c); if (c == 0u) orph |= 1u << j; if (j == x0) nl = c; }
            cached = (nl << 8) | orph; __syncthreads(); if (threadIdx.x == 0) ((LAS unsigned*)smem)[9] = cached; __syncthreads(); }
        nloc = (int)(cached >> 8); orphan = cached & 0xffu;
        const int tot = (NSL / 8) * nblk; nown = rank < tot ? (tot - rank + nloc - 1) / nloc : 0;
    }
    __device__ __forceinline__ bool item(int j, int& sl, int& blk) const {
        if (j < nown) { const int i = rank + j * nloc; sl = x0 + 8 * (i / nblk); blk = i % nblk; return true; }
        int jj = j - nown; const int tot = (NSL / 8) * nblk, per = ((int)gridDim.x > tot) ? 1 : 0; (void)per;
        for (int o = 0; o < 8; ++o) if ((orphan >> o) & 1u) { const int cnt = ((int)blockIdx.x < tot) ? (tot - (int)blockIdx.x + (int)gridDim.x - 1) / (int)gridDim.x : 0;
            if (jj < cnt) { const int i = (int)blockIdx.x + jj * (int)gridDim.x; sl = o + 8 * (i / nblk); blk = i % nblk; return true; } jj -= cnt; }
        return false;
    }
};
template <class LD, class ST, class PR>
__device__ __forceinline__ void peer_items(const PeerSched& S, LD ld, ST st, PR pr) {
    int sl, blk, sln, blkn, j = 0, buf = 0; bool have = S.item(0, sl, blk);
    if (have) { ld(sl, blk, 0); st(0); }
    while (have) {
        const bool haven = S.item(j + 1, sln, blkn);
        asm volatile("s_waitcnt vmcnt(0)" ::: "memory");
        __syncthreads();
        if (haven) ld(sln, blkn, buf ^ 1);
        pr(sl, blk, buf);
        if (haven) st(buf ^ 1);
        sl = sln; blk = blkn; have = haven; buf ^= 1; ++j;
    }
    __syncthreads();
}
#ifndef MK_UVAR
#define MK_UVAR 0
#endif
__device__ __forceinline__ void phase_peer_u(const Args& A, int layer, int nrows, LAS unsigned char* smem, int rep) {
    const int var = rep ? MK_UVAR : 0;
    const bf16_t* H = (const bf16_t*)(A.ws + WS_H); const int* IDX = (const int*)(A.ws + WS_R2); float* PART = var ? (float*)(A.ws + WS_R1) : (float*)(A.ws + WS_BIG + BIG_PART);
    const unsigned char* U = A.ws + WS_TAB;
    LAS unsigned char* lds = smem + LDS_BASE;
    constexpr int BUF = 32768 + 64 * SW;
    const int tid = otid(), wid = tid >> 6, lane = tid & 63, fr = lane & 15, fq = lane >> 4;
    PeerSched S; S.init(A, nrows, smem);
    u32x4 ri[4], rh[2];
    peer_items(S,
        [&](int sl, int blk, int) {
#pragma unroll
            for (int i = 0; i < 4; ++i) ri[i] = *(const u32x4*)(IDX + (size_t)blk * 64 * 128 + 4 * (tid + 512 * i));
            const bf16_t* hp = H + (size_t)(blk * 64 + (tid >> 3)) * 1024 + SW * sl + 16 * (tid & 7);
            rh[0] = *(const u32x4*)hp; rh[1] = *(const u32x4*)(hp + 8); },
        [&](int buf) {
#pragma unroll
            for (int i = 0; i < 4; ++i) *(LAS u32x4*)(lds + buf * BUF + 16 * (tid + 512 * i)) = ri[i];
            u32x4 w;
#pragma unroll
            for (int i = 0; i < 2; ++i) { w[2 * i] = pk4_fp8(bflo(rh[i].x) * HS, bfhi(rh[i].x) * HS, bflo(rh[i].y) * HS, bfhi(rh[i].y) * HS);
                                          w[2 * i + 1] = pk4_fp8(bflo(rh[i].z) * HS, bfhi(rh[i].z) * HS, bflo(rh[i].w) * HS, bfhi(rh[i].w) * HS); }
            *(LAS u32x4*)(lds + buf * BUF + 32768 + 16 * tid) = w; },
        [&](int sl, int blk, int buf) {
            const unsigned char* ub = U + (size_t)sl * NEXP * SW + 32 * fq;
            const LAS int* ib = (const LAS int*)(lds + buf * BUF) + (wid * 8) * 128 + fr; const LAS unsigned char* hb = lds + buf * BUF + 32768 + (wid * 8) * SW + 32 * fq;
            u32x4 uf[2][8][2];
#define PU_ROWS(T, t) do { _Pragma("unroll") for (int g = 0; g < 8; ++g) { int e_ = ib[(t) * 128 + 16 * g]; if (var == 3) e_ &= 63; \
                _Pragma("unroll") for (int hh = 0; hh < 2; ++hh) { if (var == 4) uf[T][g][hh] = (u32x4){(unsigned)e_, (unsigned)e_, 0u, 0u}; else uf[T][g][hh] = *(const u32x4*)(ub + (size_t)e_ * SW + 16 * hh); } } } while (0)
            PU_ROWS(0, 0);
#define PU_TOKEN(T, t) do { \
                const u32x4 h0 = *(const LAS u32x4*)(hb + (t) * SW), h1 = *(const LAS u32x4*)(hb + (t) * SW + 16); \
                const i32x8 hv = {(int)h0.x, (int)h0.y, (int)h0.z, (int)h0.w, (int)h1.x, (int)h1.y, (int)h1.z, (int)h1.w}; \
                float v0 = 0.f, v1 = 0.f; \
                _Pragma("unroll") for (int g = 0; g < 8; ++g) { const u32x4 ua = uf[T][g][0], ub2 = uf[T][g][1]; \
                    const i32x8 uv = {(int)ua.x, (int)ua.y, (int)ua.z, (int)ua.w, (int)ub2.x, (int)ub2.y, (int)ub2.z, (int)ub2.w}; \
                    const f32x4 acc = __builtin_amdgcn_mfma_scale_f32_16x16x128_f8f6f4(hv, uv, (f32x4){0.f, 0.f, 0.f, 0.f}, 0, 0, 0, 0x7f7f7f7f, 0, 0x7f7f7f7f);     \
                    if (g < 4) v0 = fq == g ? acc[0] : v0; else v1 = fq == g - 4 ? acc[0] : v1; }        \
                float* pp = PART + ((size_t)sl * NROW + blk * 64 + wid * 8 + (t)) * 128 + 16 * fq + fr; \
                pp[0] = v0; pp[64] = v1; } while (0)
#pragma unroll 1
            for (int tp = 0; tp < 4; ++tp) {
                PU_ROWS(1, 2 * tp + 1);
                __builtin_amdgcn_sched_barrier(0);
                PU_TOKEN(0, 2 * tp);
                __builtin_amdgcn_sched_barrier(0);
                if (tp + 1 < 4) PU_ROWS(0, 2 * tp + 2);
                __builtin_amdgcn_sched_barrier(0);
                PU_TOKEN(1, 2 * tp + 1);
                __builtin_amdgcn_sched_barrier(0);
            }
#undef PU_TOKEN
#undef PU_ROWS
        });
}
__device__ __forceinline__ void phase_coef(const Args& A, int nrows) {
    const float* PART = (const float*)(A.ws + WS_BIG + BIG_PART); const float* GATE = (const float*)(A.ws + WS_R2 + R2_GATE); float* COEF = (float*)(A.ws + WS_R2 + R2_COEF);
    const int* IDX = (const int*)(A.ws + WS_R2); const float* SCL = (const float*)(A.ws + WS_TAB + TAB_SCL);
    const int gthr = blockIdx.x * NTHR + otid(), nthr = gridDim.x * NTHR;
    for (int p = gthr; p < nrows * 32; p += nthr) {
        f32x4 s = {0.f, 0.f, 0.f, 0.f};
#pragma unroll
        for (int x = 0; x < NSL; ++x) s += *(const f32x4*)(PART + (size_t)x * NROW * 128 + 4 * p);
        const i32x4 e = *(const i32x4*)(IDX + 4 * p); const f32x4 gt = *(const f32x4*)(GATE + 4 * p);
        const f32x4 su = {SCL[e.x], SCL[e.y], SCL[e.z], SCL[e.w]}, sv = {SCL[NEXP + e.x], SCL[NEXP + e.y], SCL[NEXP + e.z], SCL[NEXP + e.w]};
        const f32x4 a = s * (1.f / HS) * su; const f32x2 g0 = gelu_pk((f32x2){a[0], a[1]}), g1 = gelu_pk((f32x2){a[2], a[3]});
        *(f32x4*)(COEF + 4 * p) = gt * (f32x4){g0.x, g0.y, g1.x, g1.y} * sv; }

}
__device__ __forceinline__ void phase_peer_v(const Args& A, int layer, int nrows, LAS unsigned char* smem, int rep) {
    const int* IDX = (const int*)(A.ws + WS_R2); const float* COEF = (const float*)(A.ws + WS_R2 + R2_COEF);
    const unsigned char* V = A.ws + WS_TAB + TAB8_HALF; const float* MODL = (const float*)(A.ws + WS_MOD) + (size_t)layer * 5 * 6144 + 5 * 1024;
    float* XC = (float*)(A.ws + WS_XC);
    LAS unsigned char* lds = smem + LDS_BASE;
    constexpr int BUF = 65536;
    const int tid = otid(), wid = tid >> 6, lane = tid & 63, m = lane & 7, tk = lane >> 3;
    PeerSched S; S.init(A, nrows, smem);
    const int wu = __builtin_amdgcn_readfirstlane(wid);
    peer_items(S,
        [&](int sl, int blk, int buf) {
#pragma unroll
            for (int i = 0; i < 4; ++i) {
                __builtin_amdgcn_global_load_lds((const unsigned*)(IDX + (size_t)blk * 64 * 128 + 256 * (wu + 8 * i) + 4 * lane), (LAS unsigned*)(lds + buf * BUF + 1024 * (wu + 8 * i)), 16, 0, 0);
                __builtin_amdgcn_global_load_lds((const unsigned*)(COEF + (size_t)blk * 64 * 128 + 256 * (wu + 8 * i) + 4 * lane), (LAS unsigned*)(lds + buf * BUF + 32768 + 1024 * (wu + 8 * i)), 16, 0, 0); } },
        [&](int buf) { },
        [&](int sl, int blk, int buf) {
            const unsigned char* vb = V + (size_t)sl * NEXP * SW + 16 * m;
            const int tokl = wid * 8 + tk, tok = blk * 64 + tokl; const bool lat = tok < NLAT;
            const LAS int* ib = (const LAS int*)(lds + buf * BUF) + tokl * 128; const LAS float* cb = (const LAS float*)(lds + buf * BUF + 32768) + tokl * 128;
            float* xp = (lat ? A.out + (size_t)tok * D : XC + (size_t)(tok - NLAT) * D) + SW * sl + 16 * m;
            f32x4 xr[4];
#pragma unroll
            for (int j = 0; j < 4; ++j) xr[j] = *(f32x4*)(xp + 4 * j);
            float acc[16];
#pragma unroll
            for (int j = 0; j < 16; ++j) acc[j] = 0.f;
            u32x4 vv[2][8];
#define PV_ROWS(T, c) do { const i32x4 e0_ = *(const LAS i32x4*)(ib + 8 * (c)), e1_ = *(const LAS i32x4*)(ib + 8 * (c) + 4); \
                vv[T][0] = *(const u32x4*)(vb + (size_t)e0_.x * SW); vv[T][1] = *(const u32x4*)(vb + (size_t)e0_.y * SW); vv[T][2] = *(const u32x4*)(vb + (size_t)e0_.z * SW); vv[T][3] = *(const u32x4*)(vb + (size_t)e0_.w * SW); \
                vv[T][4] = *(const u32x4*)(vb + (size_t)e1_.x * SW); vv[T][5] = *(const u32x4*)(vb + (size_t)e1_.y * SW); vv[T][6] = *(const u32x4*)(vb + (size_t)e1_.z * SW); vv[T][7] = *(const u32x4*)(vb + (size_t)e1_.w * SW); } while (0)
#define PV_FMA(T, c) do { const f32x4 c0_ = *(const LAS f32x4*)(cb + 8 * (c)), c1_ = *(const LAS f32x4*)(cb + 8 * (c) + 4); \
                _Pragma("unroll") for (int k = 0; k < 8; ++k) { const float cf = k < 4 ? c0_[k & 3] : c1_[k & 3]; \
                    _Pragma("unroll") for (int j = 0; j < 4; ++j) { const int w = (int)vv[T][k][j]; \
                        const f32x2 lo = __builtin_amdgcn_cvt_pk_f32_fp8(w, false), hi = __builtin_amdgcn_cvt_pk_f32_fp8(w, true); \
                        acc[4 * j] += cf * lo.x; acc[4 * j + 1] += cf * lo.y; acc[4 * j + 2] += cf * hi.x; acc[4 * j + 3] += cf * hi.y; } } } while (0)
            PV_ROWS(0, 0);
#pragma unroll 1
            for (int c = 0; c < 16; c += 2) {
                PV_ROWS(1, c + 1);
                __builtin_amdgcn_sched_barrier(0);
                PV_FMA(0, c);
                __builtin_amdgcn_sched_barrier(0);
                if (c + 2 < 16) PV_ROWS(0, c + 2);
                __builtin_amdgcn_sched_barrier(0);
                PV_FMA(1, c + 1);
                __builtin_amdgcn_sched_barrier(0);
            }
#undef PV_ROWS
#undef PV_FMA
            const float* gp = MODL + (size_t)(lat ? (tok >> 13) : 4) * 6144 + SW * sl + 16 * m;
#pragma unroll
            for (int j = 0; j < 4; ++j) { const f32x4 g = *(const f32x4*)(gp + 4 * j);
                *(f32x4*)(xp + 4 * j) = xr[j] + g * (f32x4){acc[4 * j], acc[4 * j + 1], acc[4 * j + 2], acc[4 * j + 3]}; }
        });
}

#ifdef MK_CHECK
constexpr int CW_CHK = 3840;
__device__ __forceinline__ float blk_sum(float v, LAS float* red) {
    const int t_ = otid(); v = wave_sum(v); __syncthreads(); if ((t_ & 63) == 0) red[t_ >> 6] = v; __syncthreads();
    float s = 0.f; for (int i = 0; i < 8; ++i) s += red[i]; __syncthreads(); return s;
}
__device__ __forceinline__ float fp8f(unsigned b) { const unsigned e = (b >> 3) & 15u, m = b & 7u; const float v = e ? ldexpf(1.f + (float)m * 0.125f, (int)e - 7) : ldexpf((float)m * 0.125f, -6); return (b & 0x80u) ? -v : v; }
__device__ __forceinline__ void check_attn(const Args& A, LAS unsigned char* lds) {
    const unsigned char* Q = A.ws + WS_R1 + R1_Q; const unsigned char* KN = A.ws + WS_R1 + R1_KN; const unsigned char* KR = A.ws + WS_BIG + BIG_KR; const unsigned char* V = A.ws + WS_R1 + R1_V;
    const bf16_t* CAT = (const bf16_t*)(A.ws + WS_R3 + R3_CAT); float* chk = (float*)(A.ws + WS_CTL) + CW_CHK;
    LAS float* p = (LAS float*)lds; LAS float* qv = p + NKEY; LAS float* red = qv + 192;
    const int tid = otid(), sidx = blockIdx.x;
    const int b = sidx & 3, h = (sidx >> 2) & 7, l = (int)(((unsigned)sidx * 2654435761u) >> 19) & 8191;
    const size_t bh = (size_t)(b * 8 + h);
    if (tid < 192) qv[tid] = fp8f(Q[(bh * NKEY + 256 + l) * 192 + tid]) * (1.f / att8::QUP);
    __syncthreads();
    float mx = -1e30f;
    for (int key = tid; key < NKEY; key += 512) { const int t = key >> 6, k = key & 63; float s = 0.f;
        for (int d = 0; d < 128; ++d) s += qv[d] * fp8f(KN[(bh * NKT + t) * 8192 + att8::kn8(k, d)]);
        for (int d = 0; d < 64; ++d) s += qv[128 + d] * fp8f(KR[((size_t)b * NKT + t) * 4096 + att8::kr8(k, d)]);
        p[key] = s; mx = fmaxf(mx, s); }
    for (int o = 32; o >= 1; o >>= 1) mx = fmaxf(mx, __shfl_xor(mx, o));
    __syncthreads(); if ((tid & 63) == 0) red[tid >> 6] = mx; __syncthreads(); mx = red[0]; for (int i = 1; i < 8; ++i) mx = fmaxf(mx, red[i]); __syncthreads();
    float ls = 0.f; for (int key = tid; key < NKEY; key += 512) { const float e = exp2f(p[key] - mx); p[key] = e; ls += e; }
    ls = blk_sum(ls, red);
    float num = 0.f, den = 0.f;
    if (tid < 128) { float o = 0.f; for (int key = 0; key < NKEY; ++key) o += p[key] * fp8f(V[(bh * NKT + (key >> 6)) * 8192 + att8::v8(tid, key & 63)]);
        o /= ls; const float got = bf2f(CAT[(size_t)(b * 8192 + l) * 2048 + 1024 + 128 * h + tid]); num = (got - o) * (got - o); den = o * o; }
    num = blk_sum(num, red); den = blk_sum(den, red);
    if (tid == 0) { atomicAdd(chk, num); atomicAdd(chk + 1, den); }
}
__device__ __forceinline__ void check_qkv(const Args& A, int li, LAS unsigned char* lds) {
    float* chk = (float*)(A.ws + WS_CTL) + CW_CHK;
    const unsigned char* Q = A.ws + WS_R1 + R1_Q; const unsigned char* KN = A.ws + WS_R1 + R1_KN; const unsigned char* KR = A.ws + WS_BIG + BIG_KR; const unsigned char* V = A.ws + WS_R1 + R1_V;
    LAS float* hv = (LAS float*)lds; LAS float* cq = hv + 1024; LAS float* ckv = cq + 384; LAS float* kr = ckv + 256; LAS float* red = kr + 64; LAS float* ov = red + 16;
    const int tid = otid(), sidx = blockIdx.x;
    const int hd = sidx & 7; const int r = (sidx & 8) ? NLAT + (int)(((unsigned)sidx * 2654435761u) >> 22) : (int)(((unsigned)sidx * 2654435761u) >> 17);
    const float* win = A.in[I_HWIN] + (size_t)li * 1024 * HYB_IN;
    {
        const float* xp = r < NLAT ? A.out + (size_t)r * D : (const float*)(A.ws + WS_XC) + (size_t)(r - NLAT) * D; const float* MODL = (const float*)(A.ws + WS_MOD) + (size_t)(2 * li) * 5 * 6144 + (size_t)row_mb(r) * 6144;
        float ss = 0.f; for (int i = tid; i < 1024; i += 512) ss += xp[i] * xp[i];
        ss = blk_sum(ss, red); const float rstd = rsqrtf(ss / 1024.f + EPS);
        for (int i = tid; i < 1024; i += 512) hv[i] = bf2f(f2bf(xp[i] * rstd * A.in[I_N1G][(2 * li) * 1024 + i] * (1.f + MODL[1024 + i]) + MODL[i])); }
    __syncthreads();
    for (int j = tid; j < 704; j += 512) { float s = 0.f; for (int k = 0; k < 1024; ++k) s += hv[k] * win[(size_t)k * HYB_IN + C_CQ + j];
        s = bf2f(f2bf(s)); if (j < 384) cq[j] = s; else if (j < 640) ckv[j - 384] = s; else kr[j - 640] = s; }
    __syncthreads();
    float sq = 0.f, sk = 0.f; for (int j = tid; j < 384; j += 512) sq += cq[j] * cq[j]; for (int j = tid; j < 256; j += 512) sk += ckv[j] * ckv[j];
    sq = blk_sum(sq, red); sk = blk_sum(sk, red);
    const float rq = rsqrtf(sq / 384.f + EPS), rk = rsqrtf(sk / 256.f + EPS);
    const float* wqb = A.in[I_WQB] + (size_t)li * 384 * 1536; const float* wkvb = A.in[I_WKVB] + (size_t)li * 256 * 2048; const float* qg = A.in[I_QNG] + li * 384; const float* kg = A.in[I_KVNG] + li * 256;
    if (tid < 192) { float s = 0.f; for (int k = 0; k < 384; ++k) s += cq[k] * rq * qg[k] * wqb[(size_t)k * 1536 + hd * 192 + tid]; ov[tid] = s; }
    else if (tid < 448) { const int c = tid - 192; float s = 0.f; for (int k = 0; k < 256; ++k) s += ckv[k] * rk * kg[k] * wkvb[(size_t)k * 2048 + hd * 256 + c]; ov[tid] = s; }
    __syncthreads();
    const bool lat = r < NLAT; const int b = lat ? (r >> 13) : ((r - NLAT) >> 8), l = lat ? (r & 8191) : 0, key = lat ? 256 + l : ((r - NLAT) & 255), qrow = key;
    const size_t bh = (size_t)(b * 8 + hd); const float qs = QSCALE * att8::QUP;
    float num = 0.f, den = 0.f;
    if (tid < 128) {
        const float q = ov[tid] * qs, gq = fp8f(Q[(bh * NKEY + qrow) * 192 + tid]);
        const float kk = ov[192 + tid], gk = fp8f(KN[(bh * NKT + (key >> 6)) * 8192 + att8::kn8(key & 63, tid)]);
        const float vv = ov[320 + tid], gv = fp8f(V[(bh * NKT + (key >> 6)) * 8192 + att8::v8(tid, key & 63)]);
        num = (gq - q) * (gq - q) + (gk - kk) * (gk - kk) + (gv - vv) * (gv - vv); den = q * q + kk * kk + vv * vv;
    } else if (tid < 160) {
        const int i = tid - 128; float c = 1.f, sn = 0.f;
        if (lat) { const float pos = (float)(i < 16 ? (l >> 6) : (l & 63)); const float ang = pos * powf(10000.f, -(float)(i & 15) / 16.f); c = cosf(ang); sn = sinf(ang); }
        const float q1 = ov[128 + i] * qs, q2 = ov[160 + i] * qs, k1 = kr[i], k2 = kr[32 + i];
        const float rq1 = q1 * c - q2 * sn, rq2 = q1 * sn + q2 * c, rk1 = k1 * c - k2 * sn, rk2 = k1 * sn + k2 * c;
        const float gq1 = fp8f(Q[(bh * NKEY + qrow) * 192 + 128 + 2 * i]), gq2 = fp8f(Q[(bh * NKEY + qrow) * 192 + 128 + 2 * i + 1]);
        const float gk1 = fp8f(KR[((size_t)b * NKT + (key >> 6)) * 4096 + att8::kr8(key & 63, 2 * i)]), gk2 = fp8f(KR[((size_t)b * NKT + (key >> 6)) * 4096 + att8::kr8(key & 63, 2 * i + 1)]);
        num = (gq1 - rq1) * (gq1 - rq1) + (gq2 - rq2) * (gq2 - rq2) + (gk1 - rk1) * (gk1 - rk1) + (gk2 - rk2) * (gk2 - rk2); den = rq1 * rq1 + rq2 * rq2 + rk1 * rk1 + rk2 * rk2;
    }
    num = blk_sum(num, red); den = blk_sum(den, red);
    if (tid == 0) { atomicAdd(chk, num); atomicAdd(chk + 1, den); }
}
#endif
#ifndef MK_PER_PHASE
#define MK_PER_PHASE 0
#endif
__device__ __forceinline__ int nr_in(int L) { return L <= 2 ? NROW : NLAT; }
__device__ __forceinline__ int nr_out(int L) { return L <= 1 ? NROW : NLAT; }

__global__ void __launch_bounds__(NTHR, 2) fwd(Args A) {
    extern __shared__ __attribute__((aligned(256))) unsigned char smem_raw[];
    LAS unsigned char* smem = (LAS unsigned char*)smem_raw;
    LAS unsigned char* lds = smem + LDS_BASE;
    const int tid = otid();
    if (tid < 64) ((LAS unsigned*)smem)[tid] = 0u;
    __syncthreads();
    XcdBarrier bar = xcd_barrier_post((unsigned*)(A.ws + WS_CTL), (volatile LAS unsigned*)smem);
    if (tid == 0) ((LAS unsigned*)smem)[8] = atomicAdd((unsigned*)(A.ws + WS_CTL) + CW_RANK + 32 * (xb_xcc_id() & 7u), 1u);
    __syncthreads();
    bool need_bar = false;
    const int lo = A.ph_lo, hi = A.ph_hi;
#ifndef PHMASK
#define PHMASK 0xffffffffu
#endif
#define SITE(k) if constexpr (((PHMASK) >> (k)) & 1u)
#ifndef MK_REPEAT_SITE
#define MK_REPEAT_SITE -1
#endif
#define REP(k) for (int rep = 0; rep < ((k) == (MK_REPEAT_SITE) ? 2 : 1); ++rep)
#define PH(id) if ([&]() -> bool { if ((id) < lo || (id) >= hi) return false; if (need_bar) xcd_barrier(bar); need_bar = true; return true; }())
    unsigned char* ws = A.ws;
    float* XL = A.out; float* XC = (float*)(ws + WS_XC);
    bf16_t* H = (bf16_t*)(ws + WS_H);
    const float* MOD = (const float*)(ws + WS_MOD);

    SITE(0) PH(0) { phase_prologue(A, lds); }
    SITE(1) PH(1) { phase_norm_mod(A.in[I_X], A.in[I_CTX], XL, XC, A.in[I_N1G], MOD, 0, H, NROW); }
    for (int L = 0; L < DEPTH; ++L) {
        const int base = 2 + 16 * L, li = L >> 1; const bool hyb = (L & 1) == 0;
        const float* MODL = MOD + (size_t)L * 5 * 6144;
        unsigned char* WH = ws + WS_W + W_HYB + (size_t)li * WH_SZ; unsigned char* WG = ws + WS_W + W_GM + (size_t)li * WG_SZ; unsigned char* WP = ws + WS_W + W_PEER + (size_t)L * WP_SZ;
        if (hyb) {
            SITE(2) PH(base + 0) REP(2) { pg8::Gemm g{H, (const bf16_t*)(WH + WH_IN), nr_in(L), HYB_INP, 1024, 1024, 1024};
                pg8::EpiBf16<0> e{(bf16_t*)(ws + WS_BIG), HYB_INP}; pg8::gemm_phase(lds, g, e); }
            SITE(3) PH(base + 1) REP(3) { phase_conv(A, li); }
            SITE(4) PH(base + 2) {
                SITE(18) REP(18) { pg8::Gemm g{(const bf16_t*)(ws + WS_BIG) + C_CQ, (const bf16_t*)(WH + WH_QB), L == 0 ? NROW : NLAT, 1536, 384, HYB_INP, 384};
                  EpiQ e{ws + WS_R1 + R1_Q, (const float*)(ws + WS_RSTD), (const float*)(ws + WS_ROPE)}; pg8::gemm_phase(lds, g, e); }
                SITE(19) REP(19) { pg8::Gemm g{(const bf16_t*)(ws + WS_BIG) + C_CKV, (const bf16_t*)(WH + WH_KVB), NROW, 2048, 256, HYB_INP, 256};
                  EpiKV e{ws + WS_R1 + R1_KN, ws + WS_R1 + R1_V, (const float*)(ws + WS_RSTD) + NROW}; pg8::gemm_phase(lds, g, e); }
                SITE(20) REP(20) for (int u = blockIdx.x; u < 528; u += gridDim.x) ssd::g_unit((const bf16_t*)(ws + WS_R2 + R2_BC), (bf16_t*)(ws + WS_BIG + BIG_G), u);
            }
            SITE(5) PH(base + 3) {
                SITE(21) REP(21) for (int u = blockIdx.x; u < 256; u += gridDim.x)
                    ssd::ssd_unit(u, (const bf16_t*)(ws + WS_R2), (const bf16_t*)(ws + WS_R2 + R2_BC), (const float*)(ws + WS_BIG + BIG_DT), (const bf16_t*)(ws + WS_BIG + BIG_G),
                                  A.in[I_ALOG] + li * 32, (bf16_t*)(ws + WS_H), (bf16_t*)(ws + WS_R3), lds);
                const int nau = L == 0 ? 1024 + 32 : 1024;
                SITE(22) REP(22) for (int au = blockIdx.x; au < nau; au += gridDim.x) {
                    int b, h, qrow0, orow0, nt;
                    if (au < 1024) { b = au >> 8; h = au & 7; const int qb = (au >> 3) & 31; qrow0 = 256 + 256 * qb; orow0 = b * 8192 + 256 * qb; nt = NKT; }
                    else { const int cu = au - 1024; b = cu >> 3; h = cu & 7; qrow0 = 0; orow0 = NLAT + 256 * b; nt = 4; }
                    const size_t bh = (size_t)(b * 8 + h);
                    att8::attn_unit(ws + WS_R1 + R1_Q + (bh * NKEY + qrow0) * 192, ws + WS_R1 + R1_KN + bh * NKT * 8192, ws + WS_BIG + BIG_KR + (size_t)b * NKT * 4096,
                                    ws + WS_R1 + R1_V + bh * NKT * 8192, (bf16_t*)(ws + WS_R3 + R3_CAT) + (size_t)orow0 * 2048 + 1024 + 128 * h, nt, lds);
                }
            }
            SITE(6) PH(base + 4) REP(6) { phase_ssd_out(A, li, nr_out(L));
#if defined(MK_CHECK) && MK_CHECK == 1
                if (L == 0) check_attn(A, lds);
#elif defined(MK_CHECK) && MK_CHECK == 2
                if (L == 0) check_qkv(A, li, lds);
#elif defined(MK_CHECK) && MK_CHECK == 3
                if (L == 2) check_attn(A, lds);
#endif
            }
        } else {
            SITE(7) PH(base + 0) REP(7) { pg8::Gemm g{H, (const bf16_t*)(WG + WG_IN), nr_out(L), 4096, 1024, 1024, 1024};
                pg8::EpiBf16<1> e{(bf16_t*)(ws + WS_BIG), 4096}; pg8::gemm_phase(lds, g, e); }
            SITE(8) PH(base + 1) REP(8) { phase_ln_stats(A, nr_out(L)); }
            SITE(9) PH(base + 2) REP(9) { phase_spatial(A, li, nr_out(L), lds); }
        }
        SITE(10) PH(base + 5) { pg8::Gemm g{hyb ? (const bf16_t*)(ws + WS_R3 + R3_CAT) : (const bf16_t*)(ws + WS_R1), hyb ? (const bf16_t*)(WH + WH_OUT) : (const bf16_t*)(WG + WG_OUT), nr_out(L), 1024, 2048, 2048, 2048};
            pg8::EpiResid e{XL, XC, MODL + 2 * 1024}; pg8::gemm_phase(lds, g, e); }
        SITE(11) PH(base + 6) REP(11) { phase_norm_mod(XL, XC, nullptr, nullptr, A.in[I_N2G] + L * 1024, MODL, 3, H, nr_out(L)); phase_tabcvt(A, L); }
        SITE(12) PH(base + 7) REP(12) { pg8::Gemm g{H, (const bf16_t*)(WP + WP_Q), nr_out(L), 2048, 1024, 1024, 1024};
            pg8::EpiBf16<0> e{(bf16_t*)(ws + WS_BIG), 2048}; pg8::gemm_phase(lds, g, e); }
        SITE(13) PH(base + 8) REP(13) { phase_topk(A, L, nr_out(L), lds); }
        SITE(14) PH(base + 9) REP(14) { phase_peer_u(A, L, nr_out(L), smem, rep); }
        SITE(15) PH(base + 10) REP(15) { phase_coef(A, nr_out(L)); }
        SITE(16) PH(base + 11) { phase_peer_v(A, L, nr_out(L), smem, 0); }
        SITE(17) PH(base + 12) { if (L < DEPTH - 1) phase_norm_mod(XL, XC, nullptr, nullptr, A.in[I_N1G] + (L + 1) * 1024, MOD + (size_t)(L + 1) * 5 * 6144, 0, H, nr_in(L + 1));
                        else {
#ifdef MK_CHECK
                            const float* chk = (const float*)(ws + WS_CTL) + CW_CHK; const float err = sqrtf(chk[0] / fmaxf(chk[1], 1e-30f));
                            phase_final_norm(XL, A.in[I_FNG], 1.f + 10.f * err);
#else
                            phase_final_norm(XL, A.in[I_FNG], 1.f);
#endif
                        } }
    }
#undef PH
}

#ifdef MK_TAP
__global__ void tap_kernel(const unsigned short* buf, size_t pitch, size_t col0, size_t ncols, size_t nrows, float* out) {
    const size_t n = ncols * nrows;
    for (size_t i = (size_t)blockIdx.x * blockDim.x + threadIdx.x; i < (size_t)NLAT * D; i += (size_t)gridDim.x * blockDim.x) {
        float s = 0.f; for (size_t j = i; j < n; j += (size_t)NLAT * D) s += (float)buf[(j / ncols) * pitch + col0 + (j % ncols)]; out[i] = s; }
}
#endif
extern "C" void kernel_launch(void* const* d_in, const int* in_sizes, int n_in, void* d_out, int out_size, void* d_ws, size_t ws_size, hipStream_t stream) {
    static int grid = 0;
    if (grid == 0) {
        if (n_in != N_IN || out_size != NLAT * D || ws_size < WS_END) { fprintf(stderr, "kernel_launch: unexpected shapes (n_in %d out %d ws %zu, need %zu)\n", n_in, out_size, ws_size, (size_t)WS_END); grid = -1; return; }
        int dev = 0, cus = 0, per_cu = 0;
        if (hipGetDevice(&dev) != hipSuccess || hipDeviceGetAttribute(&cus, hipDeviceAttributeMultiprocessorCount, dev) != hipSuccess) { grid = -1; return; }
        if (hipFuncSetAttribute((const void*)fwd, hipFuncAttributeMaxDynamicSharedMemorySize, LDS_BYTES) != hipSuccess) { fprintf(stderr, "kernel_launch: hipFuncSetAttribute failed\n"); grid = -1; return; }
        if (hipOccupancyMaxActiveBlocksPerMultiprocessor(&per_cu, (const void*)fwd, NTHR, LDS_BYTES) != hipSuccess || per_cu < 1) { fprintf(stderr, "kernel_launch: occupancy query says %d\n", per_cu); }
        (void)hipGetLastError();
        grid = cus;
    }
    if (grid < 0) return;
    (void)hipMemsetAsync((char*)d_ws + WS_CTL, 0, CTL_BYTES, stream);
    Args a{};
    for (int i = 0; i < N_IN; ++i) a.in[i] = (const float*)d_in[i];
    a.out = (float*)d_out; a.ws = (unsigned char*)d_ws;
#if MK_PER_PHASE
    for (int id = 0; id < 2 + 16 * DEPTH; ++id) {
        if (id >= 2) { const int L = (id - 2) / 16, s = (id - 2) % 16; if (s > 12) continue; if ((L & 1) && (s == 3 || s == 4)) continue; }
#ifdef MK_CUT
#ifdef MK_TAP
        if (id >= MK_CUT) continue;
#else
        if (id >= MK_CUT && id != 2 + 16 * (DEPTH - 1) + 12) continue;
#endif
#endif
        a.ph_lo = id; a.ph_hi = id + 1;
        hipLaunchKernelGGL(fwd, dim3(grid), dim3(NTHR), LDS_BYTES, stream, a);
    }
#ifdef MK_TAP
    { const size_t tp[5] = {MK_TAP}; hipLaunchKernelGGL(tap_kernel, dim3(2048), dim3(256), 0, stream, (const unsigned short*)((const char*)d_ws + tp[0]), tp[1], tp[2], tp[3], tp[4], (float*)d_out); }
#endif
#else
    a.ph_lo = 0; a.ph_hi = 2 + 16 * DEPTH;
    hipLaunchKernelGGL(fwd, dim3(grid), dim3(NTHR), LDS_BYTES, stream, a);
#endif
    const hipError_t le = hipPeekAtLastError();
    if (le != hipSuccess) fprintf(stderr, "kernel_launch: launch failed: %s\n", hipGetErrorName(le));
}
```

```cpp
#include <hip/hip_runtime.h>
#include <cstdio>
#include <cstdint>

#define LAS __attribute__((address_space(3)))
typedef unsigned short bf16_t;
typedef short bf16x8 __attribute__((ext_vector_type(8)));
typedef short s16x4 __attribute__((ext_vector_type(4)));
typedef float f32x2 __attribute__((ext_vector_type(2)));
typedef float f32x4 __attribute__((ext_vector_type(4)));
typedef float f32x16 __attribute__((ext_vector_type(16)));
typedef unsigned u32x2 __attribute__((ext_vector_type(2)));
typedef unsigned u32x4 __attribute__((ext_vector_type(4)));
typedef int i32x4 __attribute__((ext_vector_type(4)));
typedef int i32x8 __attribute__((ext_vector_type(8)));

constexpr int D = 1024, NB = 4, SEQ = 8192, DEPTH = 4, CTXL = 256;
constexpr int NLAT = NB * SEQ, NCTX = NB * CTXL, NROW = NLAT + NCTX;
constexpr int HYB_IN = 3280, HYB_INP = 3328;
constexpr int C_Z = 0, C_XBC = 1024, C_DT = 2560, C_CQ = 2576, C_CKV = 2960, C_KR = 3216;
constexpr int NKEY = SEQ + CTXL, NKT = NKEY / 64;
constexpr float EPS = 1e-6f;
constexpr float QSCALE = 0.07216878364870322f * 1.4426950408889634f;
constexpr int NEXP = 16384;

enum { I_X = 0, I_C, I_CTX, I_CCTX, I_ADAW, I_ADAB, I_N1G, I_N2G, I_HWIN, I_CONVW, I_CONVB, I_ALOG, I_DTB, I_SSDD, I_SSDNG, I_QNG, I_WQB, I_KVNG, I_WKVB,
       I_HWOUT, I_GWIN, I_GLNG, I_GLNB, I_GWS, I_GBS, I_GWOUT, I_PWQ, I_PK1, I_PK2, I_PU, I_PV, I_FNG, N_IN };

constexpr size_t al256(size_t x) { return (x + 255) & ~(size_t)255; }
constexpr size_t WS_CTL = 0, CTL_BYTES = 65536;
constexpr size_t WS_MOD = WS_CTL + CTL_BYTES;
constexpr size_t WS_ROPE = WS_MOD + al256((size_t)DEPTH * 5 * 6144 * 4);
constexpr size_t WS_RSTD = WS_ROPE + (size_t)2 * SEQ * 32 * 4;
constexpr size_t WS_W = WS_RSTD + al256((size_t)2 * NROW * 4);
constexpr size_t W_HYB = 0;
constexpr size_t WH_IN = 0, WH_QB = WH_IN + (size_t)HYB_INP * 1024 * 2, WH_KVB = WH_QB + (size_t)1536 * 384 * 2, WH_OUT = WH_KVB + (size_t)2048 * 256 * 2,
                 WH_SZ = WH_OUT + (size_t)1024 * 2048 * 2;
constexpr size_t W_GM = W_HYB + 2 * WH_SZ;
constexpr size_t WG_IN = 0, WG_OUT = WG_IN + (size_t)4096 * 1024 * 2, WG_WS = WG_OUT + (size_t)1024 * 2048 * 2, WG_SZ = WG_WS + (size_t)8 * 128 * 128 * 2;
constexpr size_t W_PEER = W_GM + 2 * WG_SZ;
constexpr size_t WP_Q = 0, WP_K1 = WP_Q + (size_t)2048 * 1024 * 2, WP_K2 = WP_K1 + (size_t)8 * 128 * 128 * 2, WP_SZ = WP_K2 + (size_t)8 * 128 * 128 * 2;
constexpr size_t W_TOTAL = W_PEER + 4 * WP_SZ;
constexpr size_t WS_TAB = WS_W + al256(W_TOTAL);
constexpr size_t TAB_HALF = (size_t)NEXP * 1024 * 2;
constexpr size_t WS_XC = WS_TAB + 2 * TAB_HALF;
constexpr size_t WS_H = WS_XC + (size_t)NCTX * D * 4;
constexpr size_t WS_BIG = WS_H + (size_t)NROW * D * 2;
constexpr size_t BIG_BYTES = (size_t)NROW * 4096 * 2;
constexpr size_t BIG_DT = (size_t)NROW * HYB_INP * 2;
constexpr size_t BIG_G = BIG_DT + (size_t)NROW * 32 * 4;
constexpr size_t BIG_KR = BIG_G + (size_t)528 * 128 * 128 * 2;
constexpr size_t BIG_PART = (size_t)NROW * 2048 * 2;
static_assert(BIG_KR + (size_t)NB * NKT * 8192 <= BIG_BYTES, "BIG tail");
constexpr size_t WS_R1 = WS_BIG + BIG_BYTES;
constexpr size_t R1_Q = 0, R1_KN = R1_Q + (size_t)NB * 8 * NKEY * 192 * 2, R1_V = R1_KN + (size_t)NB * 8 * NKT * 16384, R1_BYTES = R1_V + (size_t)NB * 8 * NKT * 16384;
constexpr size_t WS_R2 = WS_R1 + R1_BYTES;
constexpr size_t R2_BC = (size_t)NROW * 1024 * 2, R2_BYTES = R2_BC + (size_t)NROW * 512 * 2;
constexpr size_t R2_GATE = (size_t)NROW * 128 * 4, R2_COEF = 2 * R2_GATE;
constexpr size_t WS_R3 = WS_R2 + R2_BYTES;
constexpr size_t R3_CAT = (size_t)NROW * 1024 * 2, R3_BYTES = R3_CAT + (size_t)NROW * 2048 * 2;
constexpr size_t WS_END = WS_R3 + R3_BYTES;
static_assert(WS_END <= ((size_t)1 << 30), "workspace must fit 1 GiB");

constexpr int CW_RANK = 3584;
constexpr int CW_QUEUE = 4096;

typedef __bf16 bf16x2_t __attribute__((ext_vector_type(2)));
__device__ __forceinline__ unsigned cvt_pk_bf16(float lo, float hi) { const f32x2 v = {lo, hi}; const bf16x2_t b = __builtin_convertvector(v, bf16x2_t); return __builtin_bit_cast(unsigned, b); }
__device__ __forceinline__ bf16_t f2bf(float f) { return (bf16_t)(cvt_pk_bf16(f, 0.f) & 0xffffu); }
__device__ __forceinline__ float bf2f(unsigned b) { return __uint_as_float(b << 16); }
__device__ __forceinline__ float bflo(unsigned w) { return __uint_as_float(w << 16); }
__device__ __forceinline__ float bfhi(unsigned w) { return __uint_as_float(w & 0xffff0000u); }
__device__ __forceinline__ float wave_sum(float v) {
#pragma unroll
    for (int o = 32; o >= 1; o >>= 1) v += __shfl_xor(v, o);
    return v;
}
__device__ __forceinline__ int otid() { int t = threadIdx.x; asm volatile("" : "+v"(t)); return t; }
__device__ __forceinline__ float silu_f(float x) { return x / (1.f + __expf(-x)); }
__device__ __forceinline__ float softplus_f(float x) { return x > 20.f ? x : log1pf(__expf(x)); }
__device__ __forceinline__ f32x2 gelu_pk(f32x2 v) {
    const f32x2 av = __builtin_elementwise_abs(v), d = av * 0.2316418882f + 1.0f;
    f32x2 t; t.x = __builtin_amdgcn_rcpf(d.x); t.y = __builtin_amdgcn_rcpf(d.y);
    f32x2 q = t * 0.5307027145f + (-0.7265760135f); q = q * t + 0.7107068705f; q = q * t + (-0.142248368f); q = q * t + 0.127414796f; q = q * t;
    const f32x2 s = (v * v) * (-0.72134752044f);
    f32x2 e; e.x = __builtin_amdgcn_exp2f(s.x); e.y = __builtin_amdgcn_exp2f(s.y);
    const f32x2 m = v * (q * e), r = v - m;
    f32x2 o; o.x = v.x < 0.f ? m.x : r.x; o.y = v.y < 0.f ? m.y : r.y; return o;
}
__device__ __forceinline__ float gelu_f(float x) { f32x2 v = {x, 0.f}; return gelu_pk(v).x; }

__device__ __forceinline__ unsigned pk4_fp8(float a, float b, float c, float d) { int w = 0; w = __builtin_amdgcn_cvt_pk_fp8_f32(a, b, w, false); w = __builtin_amdgcn_cvt_pk_fp8_f32(c, d, w, true); return (unsigned)w; }
__device__ __forceinline__ int row_mb(int r) { return r < NLAT ? (r >> 13) : 4; }

#define XB_TMO      128
#define XB_XCNT(j)  (256  + 64 * (j))
#define XB_XSUB(j)  (1280 + 64 * (j))
#define XB_XGEN(j)  (2304 + 64 * (j))
#define XB_TOP      3328
#define XB_TOPGEN   3392
#define XCD_BAR_WORDS 3456
#define XB_SPIN_CAP (1u << 22)
__device__ __forceinline__ unsigned xb_ld(unsigned* p)              { return __hip_atomic_load(p, __ATOMIC_RELAXED, __HIP_MEMORY_SCOPE_AGENT); }
__device__ __forceinline__ unsigned xb_add(unsigned* p, unsigned v) { return __hip_atomic_fetch_add(p, v, __ATOMIC_RELAXED, __HIP_MEMORY_SCOPE_AGENT); }
__device__ __forceinline__ unsigned xb_xcc_id() { return (unsigned)__builtin_amdgcn_s_getreg((3 << 11) | 20) & 0xFu; }
#define XB_SPIN(cond, bar) do { unsigned _sp = 0; while (cond) { __builtin_amdgcn_s_sleep(1); \
    if ((++_sp & 255u) == 0u) { if (xb_ld(&(bar)[XB_TMO])) break; if (_sp > XB_SPIN_CAP) { atomicAdd(&(bar)[XB_TMO], 1u); break; } } } } while (0)
struct XcdBarrier { unsigned* bar; unsigned x; volatile LAS unsigned* st; };
__device__ __forceinline__ XcdBarrier xcd_barrier_post(unsigned* bar, volatile LAS unsigned* st) {
    XcdBarrier b; b.bar = bar; b.x = xb_xcc_id(); b.st = st;
    if (threadIdx.x == 0) (void)xb_add(&bar[XB_XCNT(b.x)], 1u);
    return b;
}
__device__ __forceinline__ void xcd_barrier_complete(unsigned* bar, unsigned x, unsigned& nloc, unsigned& nx) {
    const unsigned G = gridDim.x * gridDim.y * gridDim.z;
    unsigned sum, cnt, mine, sp = 0u;
    for (;;) {
        sum = 0u; cnt = 0u; mine = 0u;
#pragma unroll
        for (unsigned j = 0; j < 16; ++j) { const unsigned c = xb_ld(&bar[XB_XCNT(j)]); sum += c; cnt += (c > 0u) ? 1u : 0u; mine = (j == x) ? c : mine; }
        if (sum == G) break;
        __builtin_amdgcn_s_sleep(1);
        if ((++sp & 255u) == 0u) { if (xb_ld(&bar[XB_TMO])) break; if (sp > XB_SPIN_CAP) { atomicAdd(&bar[XB_TMO], 1u); break; } }
    }
    nloc = mine > 0u ? mine : 1u; nx = cnt > 0u ? cnt : 1u;
}
__device__ __forceinline__ void xcd_barrier(const XcdBarrier& b) {
    asm volatile("s_waitcnt vmcnt(0)" ::: "memory");
    __syncthreads();
    if (threadIdx.x == 0) {
        unsigned* bar = b.bar;
        __builtin_amdgcn_s_waitcnt(0);
        unsigned nloc = b.st[0], nx = b.st[1];
        if (nloc == 0u) { xcd_barrier_complete(bar, b.x, nloc, nx); b.st[0] = nloc; b.st[1] = nx; }
        const unsigned old = xb_add(&bar[XB_XSUB(b.x)], 1u);
        const unsigned gen = old / nloc;
        if (old + 1u == (gen + 1u) * nloc) {
            __builtin_amdgcn_fence(__ATOMIC_RELEASE, "agent");
            asm volatile("s_waitcnt vmcnt(0)" ::: "memory");
            const unsigned og = xb_add(&bar[XB_TOP], 1u);
            const unsigned tg = og / nx;
            if (og + 1u == (tg + 1u) * nx) xb_add(&bar[XB_TOPGEN], 1u);
            else XB_SPIN(xb_ld(&bar[XB_TOPGEN]) == tg, bar);
            __builtin_amdgcn_fence(__ATOMIC_ACQUIRE, "agent");
            xb_add(&bar[XB_XGEN(b.x)], 1u);
            asm volatile("s_waitcnt vmcnt(0)" ::: "memory");
        } else {
            XB_SPIN(xb_ld(&bar[XB_XGEN(b.x)]) == gen, bar);
            __builtin_amdgcn_fence(__ATOMIC_ACQUIRE, "agent");
            asm volatile("s_waitcnt vmcnt(0)" ::: "memory");
        }
    }
    __syncthreads();
}

namespace pg8 {
constexpr int BM = 256, BK = 64, HALF = 128, HTB = HALF * BK * 2, STAGE_BYTES = 8 * HTB, NXCD = 8, WGM = 8;
__host__ __device__ __forceinline__ int lds_byte(int r, int c) { const int st = (r >> 4) * 2 + (c >> 5), rr = r & 15, cc = c & 31, ob = rr * 64 + cc * 2; return st * 1024 + (ob ^ (((ob >> 9) & 1) << 5)); }
__host__ __device__ __forceinline__ void stage_rc(int b, int& R, int& C) { const int st = b / 1024, sb = b % 1024, swz = sb ^ (((sb >> 9) & 1) << 5); R = (st >> 1) * 16 + swz / 64; C = (st & 1) * 32 + (swz % 64) / 2; }
__host__ __device__ __forceinline__ int perm32(int rho) { const int n = rho >> 4, i = rho & 15; return 8 * (i >> 2) + 4 * n + (i & 3); }
struct Unit { int pm, pn; };
struct Gemm { const bf16_t* A; const bf16_t* Bt; int M, N, K, lda, ldb; };
struct StaticOrder {
    int nM, nN, nwg, G, c;
    __device__ void init(int M, int N, int G_, int c_) { nM = M / BM; nN = N / BM; nwg = nM * nN; G = G_; c = c_; }
    __device__ bool next(int i, Unit& u) const {
        const long L = (long)i * G + c; if (L >= nwg) return false;
        int wgid = (int)L; { const int q = nwg / NXCD, r = nwg % NXCD, xcd = wgid % NXCD, off = wgid / NXCD; wgid = (xcd < r ? xcd * (q + 1) : r * (q + 1) + (xcd - r) * q) + off; }
        const int nig = WGM * nN, gid = wgid / nig, fm = gid * WGM, gsz = (nM - fm) < WGM ? (nM - fm) : WGM;
        u.pm = fm + ((wgid % nig) % gsz); u.pn = (wgid % nig) / gsz; return true;
    }
};
template <class Epi>
__device__ __forceinline__ void gemm_phase(LAS unsigned char* lds, const Gemm g, const Epi& E) {
    const int tid = otid(), wid = __builtin_amdgcn_readfirstlane(tid >> 6), lane = tid & 63, wr = wid >> 2, wc = wid & 3, fr = lane & 15, fq = lane >> 4;
    StaticOrder S; S.init(g.M, g.N, (int)gridDim.x, (int)blockIdx.x);
    int K = g.K; asm volatile("" : "+s"(K));
    const int nt = K / BK;
    unsigned voffA[2], voffB[2];
#pragma unroll
    for (int i = 0; i < 2; ++i) { int R, C; stage_rc(tid * 16 + i * 8192, R, C); const int Rb = Epi::PERM ? ((R & ~31) + perm32(R & 31)) : R;
        voffA[i] = (unsigned)(R * g.lda + C) * 2u; voffB[i] = (unsigned)(Rb * g.ldb + C) * 2u; }
    const size_t kstep = (size_t)(BK * 2);
    const size_t hstepA = (size_t)HALF * g.lda * 2, hstepB = (size_t)HALF * g.ldb * 2;
    const size_t tstepA = 2 * hstepA, tstepB = 2 * hstepB;
    const unsigned ldsw = (unsigned)wid * 1024u;
    const int aoff = lds_byte(wr * 64 + fr, fq * 8), boff = lds_byte(wc * 32 + fr, fq * 8);
#define PG8_SA(b, h) (((b) * 2 + (h)) * HTB)
#define PG8_SB(b, h) ((4 + (b) * 2 + (h)) * HTB)
#define PG8_STAGE(bufoff, gbase, voff) do { _Pragma("unroll") for (int _i = 0; _i < 2; ++_i) \
        __builtin_amdgcn_global_load_lds((const unsigned*)((const char*)(gbase) + (voff)[_i]), (LAS unsigned*)(lds + (bufoff) + ldsw + _i * 8192), 16, 0, 0); } while (0)
#define PG8_LDA(dst, b, h) do { _Pragma("unroll") for (int m = 0; m < 4; ++m) _Pragma("unroll") for (int k = 0; k < 2; ++k) dst[m][k] = *(const LAS bf16x8*)(lds + PG8_SA(b, h) + aoff + m * 2048 + k * 1024); } while (0)
#define PG8_LDB(dst, b, h) do { _Pragma("unroll") for (int n = 0; n < 2; ++n) _Pragma("unroll") for (int k = 0; k < 2; ++k) dst[n][k] = *(const LAS bf16x8*)(lds + PG8_SB(b, h) + boff + n * 2048 + k * 1024); } while (0)
#define PG8_MMA(ai, bj, At, Bt) do { __builtin_amdgcn_s_setprio(1); _Pragma("unroll") for (int m = 0; m < 4; ++m) _Pragma("unroll") for (int n = 0; n < 2; ++n) _Pragma("unroll") for (int k = 0; k < 2; ++k) \
        acc[ai][bj][m][n] = __builtin_amdgcn_mfma_f32_16x16x32_bf16(Bt[n][k], At[m][k], acc[ai][bj][m][n], 0, 0, 0); __builtin_amdgcn_s_setprio(0); } while (0)
#define PG8_WAIT_V(n) asm volatile("s_waitcnt vmcnt(" #n ")" ::: "memory")
#define PG8_WAIT_L(n) asm volatile("s_waitcnt lgkmcnt(" #n ")" ::: "memory")
#define PG8_BAR __builtin_amdgcn_s_barrier()
#define PG8_SCHED __builtin_amdgcn_sched_barrier(0)
    Unit cur, nxt; int ui = 0;
    if (!S.next(0, cur)) return;
    f32x4 acc[2][2][4][2];
#pragma unroll
    for (int a = 0; a < 2; ++a)
#pragma unroll
        for (int b = 0; b < 2; ++b)
#pragma unroll
            for (int m = 0; m < 4; ++m)
#pragma unroll
                for (int n = 0; n < 2; ++n) acc[a][b][m][n] = (f32x4){0.f, 0.f, 0.f, 0.f};
    bf16x8 At[4][2], B0[2][2], B1[2][2];
    const char* cA = (const char*)g.A + (size_t)cur.pm * tstepA; const char* cB = (const char*)g.Bt + (size_t)cur.pn * tstepB;
    PG8_STAGE(PG8_SB(0, 0), cB, voffB); PG8_STAGE(PG8_SB(0, 1), cB + hstepB, voffB); PG8_STAGE(PG8_SA(0, 0), cA, voffA); PG8_STAGE(PG8_SA(0, 1), cA + hstepA, voffA);
    if (wr == 1) PG8_BAR;
    PG8_WAIT_V(2); PG8_BAR;
    PG8_STAGE(PG8_SB(1, 0), cB + kstep, voffB); PG8_STAGE(PG8_SA(1, 0), cA + kstep, voffA); PG8_STAGE(PG8_SB(1, 1), cB + hstepB + kstep, voffB);
    PG8_WAIT_V(6); PG8_BAR;
    for (;;) {
        const bool has_next = S.next(ui + 1, nxt);
        const char* nA = has_next ? (const char*)g.A + (size_t)nxt.pm * tstepA : cA; const char* nB = has_next ? (const char*)g.Bt + (size_t)nxt.pn * tstepB : cB;
        for (int t = 0; t < nt; t += 2) {
            const bool last = (t == nt - 2);
            const char* a1 = cA + (size_t)(t + 1) * kstep;
            const char* a2 = last ? nA : cA + (size_t)(t + 2) * kstep; const char* b2 = last ? nB : cB + (size_t)(t + 2) * kstep;
            const char* a3 = a2 + kstep; const char* b3 = b2 + kstep;
            PG8_LDB(B0, 0, 0); PG8_LDB(B1, 0, 1); PG8_SCHED; PG8_LDA(At, 0, 0); PG8_STAGE(PG8_SA(1, 1), a1 + hstepA, voffA);
            PG8_WAIT_V(8); PG8_WAIT_L(0); PG8_BAR; PG8_MMA(0, 0, At, B0); PG8_MMA(0, 1, At, B1); PG8_BAR; PG8_SCHED;
            PG8_LDA(At, 0, 1); PG8_STAGE(PG8_SB(0, 0), b2, voffB); PG8_STAGE(PG8_SB(0, 1), b2 + hstepB, voffB); PG8_STAGE(PG8_SA(0, 0), a2, voffA);
            PG8_WAIT_V(8); PG8_WAIT_L(0); PG8_BAR; PG8_MMA(1, 0, At, B0); PG8_MMA(1, 1, At, B1); PG8_BAR; PG8_SCHED;
            PG8_LDB(B0, 1, 0); PG8_LDB(B1, 1, 1); PG8_SCHED; PG8_LDA(At, 1, 0); PG8_STAGE(PG8_SA(0, 1), a2 + hstepA, voffA);
            PG8_WAIT_V(8); PG8_WAIT_L(0); PG8_BAR; PG8_MMA(0, 0, At, B0); PG8_MMA(0, 1, At, B1); PG8_BAR; PG8_SCHED;
            PG8_LDA(At, 1, 1); PG8_STAGE(PG8_SB(1, 0), b3, voffB); PG8_STAGE(PG8_SB(1, 1), b3 + hstepB, voffB); PG8_STAGE(PG8_SA(1, 0), a3, voffA);
            PG8_WAIT_V(8); PG8_WAIT_L(0); PG8_BAR; PG8_MMA(1, 0, At, B0); PG8_MMA(1, 1, At, B1); PG8_BAR; PG8_SCHED;
        }
        if (wr == 0) PG8_BAR;
        { const int l2_ = otid() & 63; E(acc, cur, wr, wc, l2_ & 15, l2_ >> 4); }
        if (!has_next) break;
#pragma unroll
        for (int a = 0; a < 2; ++a)
#pragma unroll
            for (int b = 0; b < 2; ++b)
#pragma unroll
                for (int m = 0; m < 4; ++m)
#pragma unroll
                    for (int n = 0; n < 2; ++n) acc[a][b][m][n] = (f32x4){0.f, 0.f, 0.f, 0.f};
        cur = nxt; cA = nA; cB = nB; ++ui;
        if (wr == 1) PG8_BAR;
    }
    PG8_WAIT_V(0);
    PG8_BAR;
#undef PG8_SA
#undef PG8_SB
#undef PG8_STAGE
#undef PG8_LDA
#undef PG8_LDB
#undef PG8_MMA
#undef PG8_WAIT_V
#undef PG8_WAIT_L
#undef PG8_BAR
#undef PG8_SCHED
}

template <int ACT> struct EpiBf16 {
    static constexpr bool PERM = true;
    bf16_t* O; int ldc;
    __device__ __forceinline__ void operator()(const f32x4 (&acc)[2][2][4][2], const Unit& u, int wr, int wc, int fr, int fq) const {
        const int row0 = u.pm * BM + wr * 64 + fr, col0 = u.pn * BM + wc * 32 + 8 * fq;
#pragma unroll
        for (int ai = 0; ai < 2; ++ai)
#pragma unroll
            for (int m = 0; m < 4; ++m) { bf16_t* rowp = O + (size_t)(row0 + ai * HALF + m * 16) * ldc + col0;
#pragma unroll
                for (int bj = 0; bj < 2; ++bj) { f32x4 v0 = acc[ai][bj][m][0], v1 = acc[ai][bj][m][1];
                    if (ACT == 1) { f32x2 a = gelu_pk((f32x2){v0[0], v0[1]}), b = gelu_pk((f32x2){v0[2], v0[3]}), c = gelu_pk((f32x2){v1[0], v1[1]}), d = gelu_pk((f32x2){v1[2], v1[3]});
                        v0 = (f32x4){a.x, a.y, b.x, b.y}; v1 = (f32x4){c.x, c.y, d.x, d.y}; }
                    u32x4 w; w.x = cvt_pk_bf16(v0[0], v0[1]); w.y = cvt_pk_bf16(v0[2], v0[3]); w.z = cvt_pk_bf16(v1[0], v1[1]); w.w = cvt_pk_bf16(v1[2], v1[3]);
                    *(u32x4*)(rowp + bj * HALF) = w; } }
    }
};
struct EpiResid {
    static constexpr bool PERM = false;
    float* xl; float* xc; const float* gate;
    __device__ __forceinline__ void operator()(const f32x4 (&acc)[2][2][4][2], const Unit& u, int wr, int wc, int fr, int fq) const {
        const int rbase = u.pm * BM; const bool lat = rbase < NLAT;
        float* X = lat ? xl + (size_t)rbase * D : xc + (size_t)(rbase - NLAT) * D;
        const float* gp = gate + (size_t)(lat ? (rbase >> 13) : 4) * 6144;
        const int row0 = wr * 64 + fr, col0 = u.pn * BM + wc * 32 + 4 * fq;
        f32x4 gv[2][2];
#pragma unroll
        for (int bj = 0; bj < 2; ++bj)
#pragma unroll
            for (int n = 0; n < 2; ++n) gv[bj][n] = *(const f32x4*)(gp + col0 + bj * HALF + n * 16);
#pragma unroll
        for (int ai = 0; ai < 2; ++ai)
#pragma unroll
            for (int m = 0; m < 4; ++m) { float* rowp = X + (size_t)(row0 + ai * HALF + m * 16) * D + col0;
#pragma unroll
                for (int bj = 0; bj < 2; ++bj)
#pragma unroll
                    for (int n = 0; n < 2; ++n) { f32x4* p = (f32x4*)(rowp + bj * HALF + n * 16); *p = *p + gv[bj][n] * acc[ai][bj][m][n]; } }
    }
};
}

namespace att {
constexpr int SLOT = 40960, KN_OFF = 0, KR_OFF = 16384, V_OFF = 24576, LDS_BYTES = 3 * SLOT + 8 * 256;
constexpr float THR2 = 11.0f;
#define KSWZ(row, colB) ((row) * 256 + ((colB) ^ (((row) & 7) << 4)))
#define KRSWZ(row, colB) ((row) * 128 + ((colB) ^ ((((row) >> 1) & 7) << 4)))
#define SBAR() __builtin_amdgcn_sched_barrier(0)
__device__ __forceinline__ int crow(int r, int hi) { return (r & 3) + 8 * (r >> 2) + 4 * hi; }
__host__ __device__ __forceinline__ int v_st(int k, int c) { const int kk = (k & ~0xC) | ((k & 4) << 1) | ((k & 8) >> 1); return ((kk >> 3) * 4 + (c >> 5)) * 512 + ((kk & 7) * 32 + (c & 31)) * 2; }
__device__ __forceinline__ int v_rd_base(int lane) { return ((lane & 3) << 3) | (((lane >> 2) & 3) << 6) | (((lane >> 4) & 1) << 5) | (((lane >> 5) & 1) << 8); }
constexpr int v_rd_off(int d0, int ks, int half) { return d0 * 512 + ks * 4096 + half * 2048; }
template <int OFF> __device__ __forceinline__ s16x4 tr_read(int vb) {
    s16x4 r; asm volatile("ds_read_b64_tr_b16 %0, %1 offset:%2" : "=&v"(r) : "v"(vb), "i"(OFF) : "memory"); return r;
}
template <int D0> __device__ __forceinline__ void pv_one(f32x16& od, int vb, bf16x8 pa0, bf16x8 pa1, bf16x8 pa2, bf16x8 pa3) {
    const s16x4 l0 = tr_read<v_rd_off(D0, 0, 0)>(vb), h0 = tr_read<v_rd_off(D0, 0, 1)>(vb), l1 = tr_read<v_rd_off(D0, 1, 0)>(vb), h1 = tr_read<v_rd_off(D0, 1, 1)>(vb);
    const s16x4 l2 = tr_read<v_rd_off(D0, 2, 0)>(vb), h2 = tr_read<v_rd_off(D0, 2, 1)>(vb), l3 = tr_read<v_rd_off(D0, 3, 0)>(vb), h3 = tr_read<v_rd_off(D0, 3, 1)>(vb);
    asm volatile("s_waitcnt lgkmcnt(0)" ::: "memory"); SBAR();
#define PK(L, H) (bf16x8){L[0], L[1], L[2], L[3], H[0], H[1], H[2], H[3]}
    od = __builtin_amdgcn_mfma_f32_32x32x16_bf16(pa0, PK(l0, h0), od, 0, 0, 0);
    od = __builtin_amdgcn_mfma_f32_32x32x16_bf16(pa1, PK(l1, h1), od, 0, 0, 0);
    od = __builtin_amdgcn_mfma_f32_32x32x16_bf16(pa2, PK(l2, h2), od, 0, 0, 0);
    od = __builtin_amdgcn_mfma_f32_32x32x16_bf16(pa3, PK(l3, h3), od, 0, 0, 0);
#undef PK
}
__device__ __forceinline__ void pv_d0(f32x16* o, int vb, bf16x8 pa0, bf16x8 pa1, bf16x8 pa2, bf16x8 pa3) {
    pv_one<0>(o[0], vb, pa0, pa1, pa2, pa3); pv_one<1>(o[1], vb, pa0, pa1, pa2, pa3); pv_one<2>(o[2], vb, pa0, pa1, pa2, pa3); pv_one<3>(o[3], vb, pa0, pa1, pa2, pa3);
}
__device__ __forceinline__ void partialSM(f32x16& p0, f32x16& p1, float& m_reg, float& mn, float& alpha) {
    float pmax = p0[0];
#pragma unroll
    for (int r = 1; r < 16; ++r) pmax = fmaxf(pmax, p0[r]);
#pragma unroll
    for (int r = 0; r < 16; ++r) pmax = fmaxf(pmax, p1[r]);
    { auto rr = __builtin_amdgcn_permlane32_swap(__float_as_uint(pmax), __float_as_uint(pmax), false, false);
      pmax = fmaxf(__uint_as_float(rr[0]), __uint_as_float(rr[1])); }
    if (__builtin_expect(__all(pmax - m_reg <= THR2), 1)) { mn = m_reg; alpha = 1.f; }
    else { mn = fmaxf(m_reg, pmax); alpha = __builtin_amdgcn_exp2f(m_reg - mn); m_reg = mn; }
#pragma unroll
    for (int r = 0; r < 16; ++r) p0[r] = __builtin_amdgcn_exp2f(p0[r] - mn);
#pragma unroll
    for (int r = 0; r < 16; ++r) p1[r] = p1[r] - mn;
}
__device__ __forceinline__ void finishSM(f32x16& p0, f32x16& p1, float alpha, float& l_reg, bf16x8& pa0, bf16x8& pa1, bf16x8& pa2, bf16x8& pa3) {
#pragma unroll
    for (int r = 0; r < 16; ++r) p1[r] = __builtin_amdgcn_exp2f(p1[r]);
    float ps = 0;
#pragma unroll
    for (int r = 0; r < 16; ++r) ps += p0[r];
#pragma unroll
    for (int r = 0; r < 16; ++r) ps += p1[r];
    { auto rr = __builtin_amdgcn_permlane32_swap(__float_as_uint(ps), __float_as_uint(ps), false, false);
      ps = __uint_as_float(rr[0]) + __uint_as_float(rr[1]); }
    l_reg = l_reg * alpha + ps;
#define PK4(P, BASE, OUT) do { unsigned a0 = cvt_pk_bf16(P[BASE + 0], P[BASE + 1]), a1 = cvt_pk_bf16(P[BASE + 2], P[BASE + 3]);   \
    unsigned b0 = cvt_pk_bf16(P[BASE + 4], P[BASE + 5]), b1 = cvt_pk_bf16(P[BASE + 6], P[BASE + 7]);                              \
    auto r0 = __builtin_amdgcn_permlane32_swap(a0, b0, false, false); auto r1 = __builtin_amdgcn_permlane32_swap(a1, b1, false, false); \
    u32x4 w = {r0[0], r1[0], r0[1], r1[1]}; OUT = *reinterpret_cast<bf16x8*>(&w); } while (0)
    PK4(p0, 0, pa0); PK4(p0, 8, pa1); PK4(p1, 0, pa2); PK4(p1, 8, pa3);
#undef PK4
}
__device__ __forceinline__ void qkt(f32x16& p0, f32x16& p1, LAS unsigned char* slot, const bf16x8* qr, int r32, int hi) {
    p0 = f32x16{}; p1 = f32x16{};
#pragma unroll
    for (int d0 = 0; d0 < 8; ++d0) { const int cb = (d0 * 16 + hi * 8) * 2;
        bf16x8 b0 = *(const LAS bf16x8*)(slot + KN_OFF + KSWZ(r32, cb));
        bf16x8 b1 = *(const LAS bf16x8*)(slot + KN_OFF + KSWZ(32 + r32, cb));
        p0 = __builtin_amdgcn_mfma_f32_32x32x16_bf16(b0, qr[d0], p0, 0, 0, 0);
        p1 = __builtin_amdgcn_mfma_f32_32x32x16_bf16(b1, qr[d0], p1, 0, 0, 0); }
#pragma unroll
    for (int d0 = 0; d0 < 4; ++d0) { const int cb = (d0 * 16 + hi * 8) * 2;
        bf16x8 b0 = *(const LAS bf16x8*)(slot + KR_OFF + KRSWZ(r32, cb));
        bf16x8 b1 = *(const LAS bf16x8*)(slot + KR_OFF + KRSWZ(32 + r32, cb));
        p0 = __builtin_amdgcn_mfma_f32_32x32x16_bf16(b0, qr[8 + d0], p0, 0, 0, 0);
        p1 = __builtin_amdgcn_mfma_f32_32x32x16_bf16(b1, qr[8 + d0], p1, 0, 0, 0); }
}
__device__ __forceinline__ void attn_unit(const bf16_t* __restrict__ Qb, const unsigned char* __restrict__ KNt, const unsigned char* __restrict__ KRt, const unsigned char* __restrict__ Vt,
                                          bf16_t* __restrict__ Ob, int NT, LAS unsigned char* lds) {
    const int tid = otid(), wid = __builtin_amdgcn_readfirstlane(tid >> 6), lane = tid & 63, r32 = lane & 31, hi = lane >> 5;
    LAS float* wsf = (LAS float*)(lds + 3 * SLOT) + wid * 64; LAS float* li_l = wsf; LAS float* al_l = wsf + 32;
    float m_reg = -1e30f, l_reg = 0; f32x16 o[4] = {}; bf16x8 qr[12];
    const bf16_t* Qw = Qb + (size_t)(wid * 32 + r32) * 192 + hi * 8;
#pragma unroll
    for (int d0 = 0; d0 < 12; ++d0) qr[d0] = *(const bf16x8*)(Qw + d0 * 16);
    const int vrb = (int)(unsigned)(uintptr_t)(lds) + V_OFF + v_rd_base(lane);
    const unsigned lo16 = (unsigned)lane * 16u;
#define ATT_DMA(tile, slotoff) do { const size_t t_ = (size_t)(tile); LAS unsigned char* sl_ = lds + (slotoff); \
        __builtin_amdgcn_global_load_lds((const unsigned*)(KNt + t_ * 16384 + wid * 1024 + lo16), (LAS unsigned*)(sl_ + KN_OFF + wid * 1024), 16, 0, 0); \
        __builtin_amdgcn_global_load_lds((const unsigned*)(KNt + t_ * 16384 + (wid + 8) * 1024 + lo16), (LAS unsigned*)(sl_ + KN_OFF + (wid + 8) * 1024), 16, 0, 0); \
        __builtin_amdgcn_global_load_lds((const unsigned*)(KRt + t_ * 8192 + wid * 1024 + lo16), (LAS unsigned*)(sl_ + KR_OFF + wid * 1024), 16, 0, 0); \
        __builtin_amdgcn_global_load_lds((const unsigned*)(Vt + t_ * 16384 + wid * 1024 + lo16), (LAS unsigned*)(sl_ + V_OFF + wid * 1024), 16, 0, 0); \
        __builtin_amdgcn_global_load_lds((const unsigned*)(Vt + t_ * 16384 + (wid + 8) * 1024 + lo16), (LAS unsigned*)(sl_ + V_OFF + (wid + 8) * 1024), 16, 0, 0); } while (0)
#define ATT_SYNC() do { asm volatile("s_waitcnt vmcnt(0)" ::: "memory"); __builtin_amdgcn_s_barrier(); asm volatile("" ::: "memory"); } while (0)
#define RESC(a) do { if (__any((a) < 1.f)) { if (hi == 0) al_l[r32] = (a); asm volatile("s_waitcnt lgkmcnt(0)" ::: "memory"); \
        _Pragma("unroll") for (int d = 0; d < 4; ++d) _Pragma("unroll") for (int r = 0; r < 16; ++r) o[d][r] *= al_l[crow(r, hi)]; } } while (0)
    f32x16 pA0, pA1, pB0, pB1; float mnA, mnB, alA, alB; bf16x8 pa0, pa1, pa2, pa3;
    int sp = 0, sc = SLOT, sn = 2 * SLOT;
    ATT_DMA(0, 0); ATT_DMA(1, SLOT);
    asm volatile("s_waitcnt vmcnt(5)" ::: "memory"); __builtin_amdgcn_s_barrier(); asm volatile("" ::: "memory");
    qkt(pA0, pA1, lds, qr, r32, hi); partialSM(pA0, pA1, m_reg, mnA, alA);
    for (int j = 1; j + 1 < NT; j += 2) {
        ATT_SYNC(); ATT_DMA(j + 1, sn);
        SBAR(); qkt(pB0, pB1, lds + sc, qr, r32, hi);
        finishSM(pA0, pA1, alA, l_reg, pa0, pa1, pa2, pa3); SBAR();
        pv_d0(o, vrb + sp, pa0, pa1, pa2, pa3); partialSM(pB0, pB1, m_reg, mnB, alB);
        RESC(alB);
        { const int t_ = sp; sp = sc; sc = sn; sn = t_; }
        ATT_SYNC(); if (j + 2 < NT) ATT_DMA(j + 2, sn);
        SBAR(); qkt(pA0, pA1, lds + sc, qr, r32, hi);
        finishSM(pB0, pB1, alB, l_reg, pa0, pa1, pa2, pa3); SBAR();
        pv_d0(o, vrb + sp, pa0, pa1, pa2, pa3); partialSM(pA0, pA1, m_reg, mnA, alA);
        RESC(alA);
        { const int t_ = sp; sp = sc; sc = sn; sn = t_; }
    }
    ATT_SYNC();
    SBAR(); qkt(pB0, pB1, lds + sc, qr, r32, hi);
    finishSM(pA0, pA1, alA, l_reg, pa0, pa1, pa2, pa3); SBAR();
    pv_d0(o, vrb + sp, pa0, pa1, pa2, pa3); partialSM(pB0, pB1, m_reg, mnB, alB);
    RESC(alB);
    finishSM(pB0, pB1, alB, l_reg, pa0, pa1, pa2, pa3); SBAR();
    pv_d0(o, vrb + sc, pa0, pa1, pa2, pa3);
    if (hi == 0) li_l[r32] = l_reg; asm volatile("s_waitcnt lgkmcnt(0)" ::: "memory");
    float rli[16];
#pragma unroll
    for (int r = 0; r < 16; ++r) rli[r] = __builtin_amdgcn_rcpf(li_l[crow(r, hi)]);
    bf16_t* Ow = Ob + (size_t)(wid * 32) * 2048;
#pragma unroll
    for (int r = 0; r < 16; ++r) { const int orow = crow(r, hi);
#pragma unroll
        for (int d0 = 0; d0 < 4; ++d0) Ow[(size_t)orow * 2048 + d0 * 32 + r32] = f2bf(o[d0][r] * rli[r]); }
    __builtin_amdgcn_s_barrier(); asm volatile("" ::: "memory");
#undef ATT_DMA
#undef ATT_SYNC
#undef RESC
}
}

namespace att8 {
constexpr int SLOT = 20480, KN_OFF = 0, KR_OFF = 8192, V_OFF = 12288, LDS_BYTES = 3 * SLOT + 8 * 256;
constexpr float THR2 = 8.0f;
constexpr float QUP = 8.f; constexpr int SC_ONE = 0x7f7f7f7f, SC_Q = 0x7c7c7c7c;
__host__ __device__ __forceinline__ int kn8(int key, int b) { return key * 128 + ((((b >> 4) ^ ((key >> 1) & 7))) << 4) + (b & 15); }
__host__ __device__ __forceinline__ int kr8(int key, int b) { return key * 64 + ((((b >> 4) ^ ((key >> 2) & 3))) << 4) + (b & 15); }
__host__ __device__ __forceinline__ int vslot(int k) { return 32 * ((k >> 2) & 1) + 16 * (k >> 5) + (k & 3) + 4 * ((k & 31) >> 3); }
__host__ __device__ __forceinline__ int v8(int d, int k) { const int sl = vslot(k); return d * 64 + ((((sl >> 4) ^ ((d >> 2) & 3))) << 4) + (sl & 15); }
__device__ __forceinline__ i32x8 ld32(const LAS unsigned char* a0, const LAS unsigned char* a1) { const u32x4 x = *(const LAS u32x4*)a0, y = *(const LAS u32x4*)a1;
    return (i32x8){(int)x.x, (int)x.y, (int)x.z, (int)x.w, (int)y.x, (int)y.y, (int)y.z, (int)y.w}; }
__device__ __forceinline__ void qkt(f32x16& p0, f32x16& p1, LAS unsigned char* slot, const i32x8* qf, int r32, int hi) {
    p0 = f32x16{}; p1 = f32x16{};
#pragma unroll
    for (int ks = 0; ks < 2; ++ks) { const int b = 64 * ks + 32 * hi;
        const i32x8 a0 = ld32(slot + KN_OFF + kn8(r32, b), slot + KN_OFF + kn8(r32, b + 16)), a1 = ld32(slot + KN_OFF + kn8(32 + r32, b), slot + KN_OFF + kn8(32 + r32, b + 16));
        p0 = __builtin_amdgcn_mfma_scale_f32_32x32x64_f8f6f4(a0, qf[ks], p0, 0, 0, 0, SC_ONE, 0, SC_Q);
        p1 = __builtin_amdgcn_mfma_scale_f32_32x32x64_f8f6f4(a1, qf[ks], p1, 0, 0, 0, SC_ONE, 0, SC_Q); }
    { const int b = 32 * hi;
        const i32x8 a0 = ld32(slot + KR_OFF + kr8(r32, b), slot + KR_OFF + kr8(r32, b + 16)), a1 = ld32(slot + KR_OFF + kr8(32 + r32, b), slot + KR_OFF + kr8(32 + r32, b + 16));
        p0 = __builtin_amdgcn_mfma_scale_f32_32x32x64_f8f6f4(a0, qf[2], p0, 0, 0, 0, SC_ONE, 0, SC_Q);
        p1 = __builtin_amdgcn_mfma_scale_f32_32x32x64_f8f6f4(a1, qf[2], p1, 0, 0, 0, SC_ONE, 0, SC_Q); }
}
__device__ __forceinline__ void partialSM(f32x16& p0, f32x16& p1, float& m_reg, float& mn, float& alpha) {
    float pmax = p0[0];
#pragma unroll
    for (int r = 1; r < 16; ++r) pmax = fmaxf(pmax, p0[r]);
#pragma unroll
    for (int r = 0; r < 16; ++r) pmax = fmaxf(pmax, p1[r]);
    { auto rr = __builtin_amdgcn_permlane32_swap(__float_as_uint(pmax), __float_as_uint(pmax), false, false);
      pmax = fmaxf(__uint_as_float(rr[0]), __uint_as_float(rr[1])); }
    if (__builtin_expect(__all(pmax - m_reg <= THR2), 1)) { mn = m_reg; alpha = 1.f; }
    else { mn = fmaxf(m_reg, pmax); alpha = __builtin_amdgcn_exp2f(m_reg - mn); m_reg = mn; }
#pragma unroll
    for (int r = 0; r < 16; ++r) p0[r] = __builtin_amdgcn_exp2f(p0[r] - mn);
#pragma unroll
    for (int r = 0; r < 16; ++r) p1[r] = p1[r] - mn;
}
__device__ __forceinline__ void finishSM(f32x16& p0, f32x16& p1, float alpha, float& l_reg, i32x8& pf) {
#pragma unroll
    for (int r = 0; r < 16; ++r) p1[r] = __builtin_amdgcn_exp2f(p1[r]);
    float ps = 0;
#pragma unroll
    for (int r = 0; r < 16; ++r) ps += p0[r];
#pragma unroll
    for (int r = 0; r < 16; ++r) ps += p1[r];
    { auto rr = __builtin_amdgcn_permlane32_swap(__float_as_uint(ps), __float_as_uint(ps), false, false);
      ps = __uint_as_float(rr[0]) + __uint_as_float(rr[1]); }
    l_reg = l_reg * alpha + ps;
#pragma unroll
    for (int w = 0; w < 4; ++w) { pf[w] = (int)pk4_fp8(p0[4 * w], p0[4 * w + 1], p0[4 * w + 2], p0[4 * w + 3]); pf[4 + w] = (int)pk4_fp8(p1[4 * w], p1[4 * w + 1], p1[4 * w + 2], p1[4 * w + 3]); }
}
__device__ __forceinline__ void pv(f32x16* o, LAS unsigned char* slot, const i32x8 pf, int r32, int hi) {
#pragma unroll
    for (int d0 = 0; d0 < 4; ++d0) { const int d = 32 * d0 + r32, sw = (d >> 2) & 3;
        const i32x8 b = ld32(slot + V_OFF + d * 64 + (((2 * hi) ^ sw) << 4), slot + V_OFF + d * 64 + (((2 * hi + 1) ^ sw) << 4));
        o[d0] = __builtin_amdgcn_mfma_scale_f32_32x32x64_f8f6f4(pf, b, o[d0], 0, 0, 0, SC_ONE, 0, SC_ONE); }
}
__device__ __forceinline__ int crow(int r, int hi) { return (r & 3) + 8 * (r >> 2) + 4 * hi; }
__device__ __forceinline__ void attn_unit(const unsigned char* __restrict__ Qb, const unsigned char* __restrict__ KNt, const unsigned char* __restrict__ KRt, const unsigned char* __restrict__ Vt,
                                          bf16_t* __restrict__ Ob, int NT, LAS unsigned char* lds) {
    const int tid = otid(), wid = __builtin_amdgcn_readfirstlane(tid >> 6), lane = tid & 63, r32 = lane & 31, hi = lane >> 5;
    LAS float* wsf = (LAS float*)(lds + 3 * SLOT) + wid * 64; LAS float* li_l = wsf; LAS float* al_l = wsf + 32;
    float m_reg = -1e30f, l_reg = 0; f32x16 o[4] = {}; i32x8 qf[3];
    const unsigned char* Qw = Qb + (size_t)(wid * 32 + r32) * 192 + 32 * hi;
#pragma unroll
    for (int ks = 0; ks < 3; ++ks) { const u32x4 x = *(const u32x4*)(Qw + 64 * ks), y = *(const u32x4*)(Qw + 64 * ks + 16); qf[ks] = (i32x8){(int)x.x, (int)x.y, (int)x.z, (int)x.w, (int)y.x, (int)y.y, (int)y.z, (int)y.w}; }
    const unsigned lo16 = (unsigned)lane * 16u;
#define ATT_DMA(tile, slotoff) do { const size_t t_ = (size_t)(tile); LAS unsigned char* sl_ = lds + (slotoff); \
        __builtin_amdgcn_global_load_lds((const unsigned*)(KNt + t_ * 8192 + wid * 1024 + lo16), (LAS unsigned*)(sl_ + KN_OFF + wid * 1024), 16, 0, 0); \
        __builtin_amdgcn_global_load_lds((const unsigned*)(Vt + t_ * 8192 + wid * 1024 + lo16), (LAS unsigned*)(sl_ + V_OFF + wid * 1024), 16, 0, 0); \
        if (wid < 4) __builtin_amdgcn_global_load_lds((const unsigned*)(KRt + t_ * 4096 + wid * 1024 + lo16), (LAS unsigned*)(sl_ + KR_OFF + wid * 1024), 16, 0, 0); } while (0)
#define ATT_SYNC() do { asm volatile("s_waitcnt vmcnt(0)" ::: "memory"); __builtin_amdgcn_s_barrier(); asm volatile("" ::: "memory"); } while (0)
#define RESC(a) do { if (__any((a) < 1.f)) { if (hi == 0) al_l[r32] = (a); asm volatile("s_waitcnt lgkmcnt(0)" ::: "memory"); \
        _Pragma("unroll") for (int d = 0; d < 4; ++d) _Pragma("unroll") for (int r = 0; r < 16; ++r) o[d][r] *= al_l[crow(r, hi)]; } } while (0)
    f32x16 pA0, pA1, pB0, pB1; float mnA, mnB, alA, alB; i32x8 pf;
    int sp = 0, sc = SLOT, sn = 2 * SLOT;
    ATT_DMA(0, 0);
    ATT_SYNC();
    ATT_DMA(1, SLOT);
    qkt(pA0, pA1, lds, qf, r32, hi); partialSM(pA0, pA1, m_reg, mnA, alA);
    for (int j = 1; j + 1 < NT; j += 2) {
        ATT_SYNC(); ATT_DMA(j + 1, sn);
        SBAR(); qkt(pB0, pB1, lds + sc, qf, r32, hi);
        finishSM(pA0, pA1, alA, l_reg, pf); SBAR();
        pv(o, lds + sp, pf, r32, hi); partialSM(pB0, pB1, m_reg, mnB, alB);
        RESC(alB);
        { const int t_ = sp; sp = sc; sc = sn; sn = t_; }
        ATT_SYNC(); if (j + 2 < NT) ATT_DMA(j + 2, sn);
        SBAR(); qkt(pA0, pA1, lds + sc, qf, r32, hi);
        finishSM(pB0, pB1, alB, l_reg, pf); SBAR();
        pv(o, lds + sp, pf, r32, hi); partialSM(pA0, pA1, m_reg, mnA, alA);
        RESC(alA);
        { const int t_ = sp; sp = sc; sc = sn; sn = t_; }
    }
    ATT_SYNC();
    SBAR(); qkt(pB0, pB1, lds + sc, qf, r32, hi);
    finishSM(pA0, pA1, alA, l_reg, pf); SBAR();
    pv(o, lds + sp, pf, r32, hi); partialSM(pB0, pB1, m_reg, mnB, alB);
    RESC(alB);
    finishSM(pB0, pB1, alB, l_reg, pf); SBAR();
    pv(o, lds + sc, pf, r32, hi);
    if (hi == 0) li_l[r32] = l_reg; asm volatile("s_waitcnt lgkmcnt(0)" ::: "memory");
    float rli[16];
#pragma unroll
    for (int r = 0; r < 16; ++r) rli[r] = __builtin_amdgcn_rcpf(li_l[crow(r, hi)]);
    bf16_t* Ow = Ob + (size_t)(wid * 32) * 2048;
#pragma unroll
    for (int r = 0; r < 16; ++r) { const int orow = crow(r, hi);
#pragma unroll
        for (int d0 = 0; d0 < 4; ++d0) Ow[(size_t)orow * 2048 + d0 * 32 + r32] = f2bf(o[d0][r] * rli[r]); }
    __builtin_amdgcn_s_barrier(); asm volatile("" ::: "memory");
#undef ATT_DMA
#undef ATT_SYNC
#undef RESC
}
}

namespace ssd {
constexpr int XT_OFF = 0, BT_OFF = 17408, HB_OFF = 52224, SET = 69632, CW_OFF = 2 * SET, LDS_BYTES = CW_OFF + 8 * 1536;
constexpr int PITCH = 272;
constexpr float L2E = 1.4426950408889634f;
__device__ __forceinline__ void g_unit(const bf16_t* __restrict__ BC, bf16_t* __restrict__ G, int unit) {
    const int cid = unit >> 1, g = unit & 1;
    const int r0 = cid < 256 ? cid * 128 : NLAT + (cid - 256) * 128;
    const int tid = otid(), wid = tid >> 6, lane = tid & 63, fr = lane & 15, fq = lane >> 4;
    const bf16_t* Cp = BC + (size_t)(r0 + 16 * wid + fr) * 512 + 256 + 128 * g + 8 * fq;
    bf16x8 cf[4];
#pragma unroll
    for (int ks = 0; ks < 4; ++ks) cf[ks] = *(const bf16x8*)(Cp + 32 * ks);
    bf16_t* Gp = G + ((size_t)unit * 128 + 16 * wid + fr) * 128 + 4 * fq;
#pragma unroll
    for (int sb = 0; sb < 8; ++sb) {
        const bf16_t* Bp = BC + (size_t)(r0 + 16 * sb + fr) * 512 + 128 * g + 8 * fq;
        f32x4 acc = {0.f, 0.f, 0.f, 0.f};
#pragma unroll
        for (int ks = 0; ks < 4; ++ks) { const bf16x8 bfr = *(const bf16x8*)(Bp + 32 * ks); acc = __builtin_amdgcn_mfma_f32_16x16x32_bf16(bfr, cf[ks], acc, 0, 0, 0); }
        u32x2 w; w.x = cvt_pk_bf16(acc[0], acc[1]); w.y = cvt_pk_bf16(acc[2], acc[3]);
        *(u32x2*)(Gp + 16 * sb) = w;
    }
}
__device__ __forceinline__ void ssd_unit(int b, int h, int d, const bf16_t* __restrict__ XS, const bf16_t* __restrict__ BC, const float* __restrict__ DT, const bf16_t* __restrict__ G,
                                         const float* __restrict__ a_log, bf16_t* __restrict__ Y, LAS unsigned char* lds) {
    const int g = h >> 3;
    const int tid = otid(), wid = tid >> 6, lane = tid & 63, fr = lane & 15, fq = lane >> 4;
    const float a = -__expf(a_log[d * 16 + h]);
    LAS float* cw = (LAS float*)(lds + CW_OFF + wid * 1536); LAS float* dts = cw + 128; LAS float* dtw = cw + 256;
    f32x4 hs[4];
#pragma unroll
    for (int q = 0; q < 4; ++q) hs[q] = (f32x4){0.f, 0.f, 0.f, 0.f};
    for (int i = tid; i < 17408 / 4; i += 512) ((LAS unsigned*)(lds + HB_OFF))[i] = 0u;
    float cend = 0.f;
#define SSD_ROWS(step, r0v, gidv) do { if ((step) < 2) { const int oc_ = d ? 1 - (step) : (step); r0v = NLAT + b * 256 + oc_ * 128; gidv = 256 + b * 2 + oc_; } \
        else { const int lc_ = (step) - 2, oc_ = d ? 63 - lc_ : lc_; r0v = b * 8192 + oc_ * 128; gidv = b * 64 + oc_; } } while (0)
    const int sg = tid & 31, n8 = tid >> 5, p4 = tid >> 5;
    f32x2 P_da, Q_da; u32x2 P_xv[4], Q_xv[4]; u32x4 P_bv[4], Q_bv[4], n_gv[4], n_cv[4], c_gv[4], c_cv[4];
#define SSD_LOAD(step, X) do { int r0_, gid_; SSD_ROWS(step, r0_, gid_); (void)gid_; X##_da = *(const f32x2*)(DT + (size_t)(d * 16 + h) * NROW + r0_ + 2 * lane); \
        _Pragma("unroll") for (int j_ = 0; j_ < 4; ++j_) { X##_xv[j_] = *(const u32x2*)(XS + (size_t)(r0_ + 4 * sg + j_) * 1024 + 64 * h + 4 * p4); \
                                                         X##_bv[j_] = *(const u32x4*)(BC + (size_t)(r0_ + 4 * sg + j_) * 512 + 128 * g + 8 * n8); } } while (0)
#define SSD_LOADGC(step) do { int r0_, gid_; SSD_ROWS(step, r0_, gid_); const int t_ = 16 * wid + fr; const bf16_t* Gp_ = G + ((size_t)(gid_ * 2 + g) * 128 + t_) * 128 + 8 * fq; const bf16_t* Cp_ = BC + (size_t)(r0_ + t_) * 512 + 256 + 128 * g + 8 * fq; \
          _Pragma("unroll") for (int ks_ = 0; ks_ < 4; ++ks_) { n_gv[ks_] = *(const u32x4*)(Gp_ + 32 * ks_); n_cv[ks_] = *(const u32x4*)(Cp_ + 32 * ks_); } } while (0)
#define SSD_GCROT() do { _Pragma("unroll") for (int ks_ = 0; ks_ < 4; ++ks_) { c_gv[ks_] = n_gv[ks_]; c_cv[ks_] = n_cv[ks_]; } } while (0)
#define SSD_WRITE(step, X) do { LAS unsigned char* set_ = lds + ((step) & 1) * SET; \
        const float da0 = X##_da.x * a, da1 = X##_da.y * a; \
        float sc_ = da0 + da1; float c0_, c1_; \
        if (d == 0) { _Pragma("unroll") for (int o_ = 1; o_ < 64; o_ <<= 1) { const float t_ = __shfl_up(sc_, o_); if (lane >= o_) sc_ += t_; } \
            c0_ = sc_ - da1; c1_ = sc_; cend = __shfl(sc_, 63); } \
        else { _Pragma("unroll") for (int o_ = 1; o_ < 64; o_ <<= 1) { const float t_ = __shfl_down(sc_, o_); if (lane + o_ < 64) sc_ += t_; } \
            c0_ = sc_; c1_ = sc_ - da0; cend = __shfl(sc_, 0); } \
        *(LAS f32x2*)(cw + 2 * lane) = (f32x2){c0_, c1_}; *(LAS f32x2*)(dts + 2 * lane) = X##_da; \
        *(LAS f32x2*)(dtw + 2 * lane) = (f32x2){X##_da.x * __builtin_amdgcn_exp2f((cend - c0_) * L2E), X##_da.y * __builtin_amdgcn_exp2f((cend - c1_) * L2E)}; \
        { LAS unsigned char* xt_ = set_ + XT_OFF + (4 * p4) * PITCH + 8 * sg; \
          _Pragma("unroll") for (int i_ = 0; i_ < 4; ++i_) { unsigned e_[4]; \
              _Pragma("unroll") for (int j_ = 0; j_ < 4; ++j_) { const unsigned w_ = (i_ & 2) ? X##_xv[j_].y : X##_xv[j_].x; e_[j_] = (i_ & 1) ? (w_ >> 16) : (w_ & 0xffffu); } \
              u32x2 o_; o_.x = e_[0] | (e_[1] << 16); o_.y = e_[2] | (e_[3] << 16); *(LAS u32x2*)(xt_ + i_ * PITCH) = o_; } } \
        { LAS unsigned char* bt_ = set_ + BT_OFF + (8 * n8) * PITCH + 8 * sg; \
          _Pragma("unroll") for (int i_ = 0; i_ < 8; ++i_) { unsigned e_[4]; \
              _Pragma("unroll") for (int j_ = 0; j_ < 4; ++j_) { const unsigned w_ = X##_bv[j_][i_ >> 1]; e_[j_] = (i_ & 1) ? (w_ >> 16) : (w_ & 0xffffu); } \
              u32x2 o_; o_.x = e_[0] | (e_[1] << 16); o_.y = e_[2] | (e_[3] << 16); *(LAS u32x2*)(bt_ + i_ * PITCH) = o_; } } \
        asm volatile("s_waitcnt lgkmcnt(0)" ::: "memory"); \
    } while (0)
    SSD_LOAD(0, Q); SSD_LOADGC(0); SSD_WRITE(0, Q); SSD_LOAD(1, P);
    for (int step2 = 0; step2 < 66; step2 += 2)
#pragma unroll
    for (int par = 0; par < 2; ++par) {
        const int step = step2 + par;
        __syncthreads();
        int r0, gid; SSD_ROWS(step, r0, gid); (void)gid;
        LAS unsigned char* set = lds + (step & 1) * SET;
        const float cend_cur = cend;
        SSD_GCROT();
        if (step + 1 < 66) SSD_LOADGC(step + 1);
        if (step + 2 < 66) { if (par == 0) SSD_LOAD(step + 2, Q); else SSD_LOAD(step + 2, P); }
        {
            const int t = 16 * wid + fr; const float ct = cw[t];
            f32x4 y[4];
#pragma unroll
            for (int q = 0; q < 4; ++q) y[q] = (f32x4){0.f, 0.f, 0.f, 0.f};
            const float et = __builtin_amdgcn_exp2f(ct * L2E);
#pragma unroll
            for (int ks = 0; ks < 4; ++ks) {
                const bool live = d == 0 ? (32 * ks <= 16 * wid + 15) : (32 * ks + 31 >= 16 * wid);
                if (live) {
                    const int s0 = 32 * ks + 8 * fq;
                    const f32x4 c0 = *(const LAS f32x4*)(cw + s0), c1 = *(const LAS f32x4*)(cw + s0 + 4), d0v = *(const LAS f32x4*)(dts + s0), d1v = *(const LAS f32x4*)(dts + s0 + 4);
                    float m[8];
#pragma unroll
                    for (int i = 0; i < 8; ++i) { const float cs = i < 4 ? c0[i & 3] : c1[i & 3], dv = i < 4 ? d0v[i & 3] : d1v[i & 3]; const int s = s0 + i;
                        const bool ok = d == 0 ? (s <= t) : (s >= t);
                        const float gval = (i & 1) ? bfhi(c_gv[ks][i >> 1]) : bflo(c_gv[ks][i >> 1]);
                        m[i] = ok ? gval * dv * __builtin_amdgcn_exp2f((ct - cs) * L2E) : 0.f; }
                    u32x4 mw; mw.x = cvt_pk_bf16(m[0], m[1]); mw.y = cvt_pk_bf16(m[2], m[3]); mw.z = cvt_pk_bf16(m[4], m[5]); mw.w = cvt_pk_bf16(m[6], m[7]);
                    const bf16x8 mb = __builtin_bit_cast(bf16x8, mw);
#pragma unroll
                    for (int q = 0; q < 4; ++q) { const bf16x8 af = *(const LAS bf16x8*)(set + XT_OFF + (16 * q + fr) * PITCH + (32 * ks + 8 * fq) * 2);
                        y[q] = __builtin_amdgcn_mfma_f32_16x16x32_bf16(af, mb, y[q], 0, 0, 0); }
                }
            }
#pragma unroll
            for (int ks = 0; ks < 4; ++ks) {
                u32x4 cwv;
#pragma unroll
                for (int i = 0; i < 4; ++i) cwv[i] = cvt_pk_bf16(bflo(c_cv[ks][i]) * et, bfhi(c_cv[ks][i]) * et);
                const bf16x8 cb = __builtin_bit_cast(bf16x8, cwv);
#pragma unroll
                for (int q = 0; q < 4; ++q) { const bf16x8 af = *(const LAS bf16x8*)(set + HB_OFF + (16 * q + fr) * PITCH + (32 * ks + 8 * fq) * 2);
                    y[q] = __builtin_amdgcn_mfma_f32_16x16x32_bf16(af, cb, y[q], 0, 0, 0); }
            }
            bf16_t* yp = Y + (size_t)(r0 + t) * 1024 + 64 * h + 4 * fq;
#pragma unroll
            for (int q = 0; q < 4; ++q) { u32x2 w; w.x = cvt_pk_bf16(y[q][0], y[q][1]); w.y = cvt_pk_bf16(y[q][2], y[q][3]); *(u32x2*)(yp + 16 * q) = w; }
        }
        {
            const float dec = __builtin_amdgcn_exp2f(cend_cur * L2E);
#pragma unroll
            for (int q = 0; q < 4; ++q) hs[q] = hs[q] * dec;
#pragma unroll
            for (int ks = 0; ks < 4; ++ks) {
                const int s0 = 32 * ks + 8 * fq;
                const u32x4 braw = *(const LAS u32x4*)(set + BT_OFF + (16 * wid + fr) * PITCH + s0 * 2);
                const f32x4 w0 = *(const LAS f32x4*)(dtw + s0), w1 = *(const LAS f32x4*)(dtw + s0 + 4);
                u32x4 bw; bw.x = cvt_pk_bf16(bflo(braw.x) * w0[0], bfhi(braw.x) * w0[1]); bw.y = cvt_pk_bf16(bflo(braw.y) * w0[2], bfhi(braw.y) * w0[3]);
                          bw.z = cvt_pk_bf16(bflo(braw.z) * w1[0], bfhi(braw.z) * w1[1]); bw.w = cvt_pk_bf16(bflo(braw.w) * w1[2], bfhi(braw.w) * w1[3]);
                const bf16x8 bfr = __builtin_bit_cast(bf16x8, bw);
#pragma unroll
                for (int q = 0; q < 4; ++q) { const bf16x8 af = *(const LAS bf16x8*)(set + XT_OFF + (16 * q + fr) * PITCH + s0 * 2);
                    hs[q] = __builtin_amdgcn_mfma_f32_16x16x32_bf16(af, bfr, hs[q], 0, 0, 0); }
            }
            LAS bf16_t* hb = (LAS bf16_t*)(lds + ((step + 1) & 1) * SET + HB_OFF) + 16 * wid + fr;
#pragma unroll
            for (int q = 0; q < 4; ++q)
#pragma unroll
                for (int i = 0; i < 4; ++i) hb[(16 * q + 4 * fq + i) * 136] = f2bf(hs[q][i]);
        }
        if (step + 1 < 66) { if (par == 0) SSD_WRITE(step + 1, P); else SSD_WRITE(step + 1, Q); }
    }
    __syncthreads();
#undef SSD_ROWS
#undef SSD_LOAD
#undef SSD_LOADGC
#undef SSD_GCROT
#undef SSD_WRITE
}
}

struct Args { const float* in[32]; float* out; unsigned char* ws; int ph_lo, ph_hi; };
constexpr int NTHR = 512;
constexpr int LDS_BASE = 256;
constexpr int LDS_PHASE = 151808;
constexpr int LDS_BYTES = LDS_BASE + LDS_PHASE;
static_assert(att::LDS_BYTES <= LDS_PHASE && att8::LDS_BYTES <= LDS_PHASE && ssd::LDS_BYTES <= LDS_PHASE && pg8::STAGE_BYTES <= LDS_PHASE, "LDS");

__device__ __forceinline__ void tjob(int j, const Args& A, const float*& src, bf16_t*& dst, int& K, int& N, int& Npad, int& mode, const float*& ks) {
    unsigned char* W = A.ws + WS_W; mode = 0; ks = nullptr;
    if (j < 8) { const int i = j >> 2, w = j & 3; unsigned char* base = W + W_HYB + (size_t)i * WH_SZ;
        if (w == 0)      { src = A.in[I_HWIN] + (size_t)i * 1024 * HYB_IN; dst = (bf16_t*)(base + WH_IN); K = 1024; N = HYB_IN; Npad = HYB_INP; mode = 1; }
        else if (w == 1) { src = A.in[I_WQB] + (size_t)i * 384 * 1536; dst = (bf16_t*)(base + WH_QB); K = 384; N = 1536; Npad = 1536; mode = 2; ks = A.in[I_QNG] + i * 384; }
        else if (w == 2) { src = A.in[I_WKVB] + (size_t)i * 256 * 2048; dst = (bf16_t*)(base + WH_KVB); K = 256; N = 2048; Npad = 2048; ks = A.in[I_KVNG] + i * 256; }
        else             { src = A.in[I_HWOUT] + (size_t)i * 2048 * 1024; dst = (bf16_t*)(base + WH_OUT); K = 2048; N = 1024; Npad = 1024; }
    } else if (j < 12) { const int i = (j - 8) >> 1, w = (j - 8) & 1; unsigned char* base = W + W_GM + (size_t)i * WG_SZ;
        if (w == 0) { src = A.in[I_GWIN] + (size_t)i * 1024 * 4096; dst = (bf16_t*)(base + WG_IN); K = 1024; N = 4096; Npad = 4096; }
        else        { src = A.in[I_GWOUT] + (size_t)i * 2048 * 1024; dst = (bf16_t*)(base + WG_OUT); K = 2048; N = 1024; Npad = 1024; }
    } else { const int l = j - 12; src = A.in[I_PWQ] + (size_t)l * 1024 * 2048; dst = (bf16_t*)(W + W_PEER + (size_t)l * WP_SZ + WP_Q); K = 1024; N = 2048; Npad = 2048; }
}
__device__ __forceinline__ int colmap(int mode, int n, int N) {
    if (mode == 1) { if (n >= N) return -1; if (n < C_KR) return n; const int m = n - C_KR; return C_KR + (m >> 1) + 32 * (m & 1); }
    if (mode == 2) { if (n < 1024) return (n >> 7) * 192 + (n & 127); const int m = n - 1024, h = m >> 6, mm = m & 63; return h * 192 + 128 + (mm >> 1) + 32 * (mm & 1); }
    return n;
}
__device__ __forceinline__ void phase_prologue(const Args& A, LAS unsigned char* lds) {
    const int tid = otid();
    {
        LAS float* tile = (LAS float*)lds;
        int item = blockIdx.x;
        for (int j = 0; j < 16; ++j) {
            const float* src; bf16_t* dst; int K, N, Npad, mode; const float* ks; tjob(j, A, src, dst, K, N, Npad, mode, ks);
            const int tk = K / 64, tn = Npad / 64, nt = tk * tn;
            for (; item < nt; item += gridDim.x) {
                const int k0 = (item % tk) * 64, n0 = (item / tk) * 64;
                { const int k = tid >> 3, cg = tid & 7; const float sc = ks ? ks[k0 + k] : 1.f;
#pragma unroll
                  for (int jj = 0; jj < 8; ++jj) { const int oc = colmap(mode, n0 + 8 * cg + jj, N); tile[k * 65 + 8 * cg + jj] = oc >= 0 ? src[(size_t)(k0 + k) * N + oc] * sc : 0.f; } }
                __syncthreads();
                { const int n = tid >> 3, kg = tid & 7; float v[8];
#pragma unroll
                  for (int jj = 0; jj < 8; ++jj) v[jj] = tile[(8 * kg + jj) * 65 + n];
                  u32x4 w; w.x = cvt_pk_bf16(v[0], v[1]); w.y = cvt_pk_bf16(v[2], v[3]); w.z = cvt_pk_bf16(v[4], v[5]); w.w = cvt_pk_bf16(v[6], v[7]);
                  *(u32x4*)(dst + (size_t)(n0 + n) * K + k0 + 8 * kg) = w; }
                __syncthreads();
            }
            item -= nt;
        }
    }
    {
        const int gthr = blockIdx.x * NTHR + tid, nthr = gridDim.x * NTHR;
        for (int p = gthr; p < 10 * 16384; p += nthr) {
            const int mat = p >> 14, off = (p & 16383) * 8; const float* src; bf16_t* dst;
            if (mat < 2)      { src = A.in[I_GWS] + (size_t)mat * 131072; dst = (bf16_t*)(A.ws + WS_W + W_GM + (size_t)mat * WG_SZ + WG_WS); }
            else if (mat < 6) { src = A.in[I_PK1] + (size_t)(mat - 2) * 131072; dst = (bf16_t*)(A.ws + WS_W + W_PEER + (size_t)(mat - 2) * WP_SZ + WP_K1); }
            else              { src = A.in[I_PK2] + (size_t)(mat - 6) * 131072; dst = (bf16_t*)(A.ws + WS_W + W_PEER + (size_t)(mat - 6) * WP_SZ + WP_K2); }
            const f32x4 a = *(const f32x4*)(src + off), b = *(const f32x4*)(src + off + 4);
            u32x4 w; w.x = cvt_pk_bf16(a[0], a[1]); w.y = cvt_pk_bf16(a[2], a[3]); w.z = cvt_pk_bf16(b[0], b[1]); w.w = cvt_pk_bf16(b[2], b[3]);
            *(u32x4*)(dst + off) = w;
        }
        float* rope = (float*)(A.ws + WS_ROPE);
        for (int p = gthr; p < SEQ * 32; p += nthr) { const int l = p >> 5, i = p & 31; const float pos = (float)(i < 16 ? (l >> 6) : (l & 63));
            const float inv = powf(10000.f, -(float)(i & 15) / 16.f), ang = pos * inv; rope[p] = cosf(ang); rope[SEQ * 32 + p] = sinf(ang); }
    }
    {
        LAS float* scond = (LAS float*)lds;
        LAS float* red = scond + 5 * 1024;
        __syncthreads();
        for (int i = tid; i < 5 * 1024; i += NTHR) { const int m = i >> 10, k = i & 1023; const float c = m < 4 ? A.in[I_C][m * 1024 + k] : A.in[I_CCTX][k]; scond[i] = silu_f(c); }
        __syncthreads();
        float* MOD = (float*)(A.ws + WS_MOD);
        for (int item = blockIdx.x; item < 4 * 48; item += gridDim.x) {
            const int layer = item / 48, j0 = (item % 48) * 128; const int c4 = tid & 31, ksl = tid >> 5;
            f32x4 acc[5];
#pragma unroll
            for (int m = 0; m < 5; ++m) acc[m] = (f32x4){0.f, 0.f, 0.f, 0.f};
            const float* wp = A.in[I_ADAW] + ((size_t)layer * 1024 + ksl * 64) * 6144 + j0 + 4 * c4;
            for (int k = 0; k < 64; ++k) { const f32x4 w = *(const f32x4*)(wp + (size_t)k * 6144);
#pragma unroll
                for (int m = 0; m < 5; ++m) acc[m] += w * scond[m * 1024 + ksl * 64 + k]; }
#pragma unroll
            for (int m = 0; m < 5; ++m) *(LAS f32x4*)(red + (ksl * 5 + m) * 128 + 4 * c4) = acc[m];
            __syncthreads();
            for (int i = tid; i < 640; i += NTHR) { const int m = i >> 7, c = i & 127; float s = A.in[I_ADAB][layer * 6144 + j0 + c];
#pragma unroll
                for (int q = 0; q < 16; ++q) s += red[(q * 5 + m) * 128 + c];
                MOD[((size_t)layer * 5 + m) * 6144 + j0 + c] = s; }
            __syncthreads();
        }
    }
}

__device__ __forceinline__ void phase_norm_mod(const float* xl, const float* xc, float* cl, float* cc, const float* g, const float* modl, int sh_idx, bf16_t* H, int nrows) {
    const int tid_ = otid(); const int lane = tid_ & 63, gw = blockIdx.x * 8 + (tid_ >> 6), nw = gridDim.x * 8;
    f32x4 gv[4];
#pragma unroll
    for (int i = 0; i < 4; ++i) gv[i] = *(const f32x4*)(g + 256 * i + 4 * lane);
    for (int r = gw; r < nrows; r += nw) {
        const bool lat = r < NLAT; const float* xp = lat ? xl + (size_t)r * D : xc + (size_t)(r - NLAT) * D;
        f32x4 x[4]; float ss = 0.f;
#pragma unroll
        for (int i = 0; i < 4; ++i) { x[i] = *(const f32x4*)(xp + 256 * i + 4 * lane); ss += x[i][0] * x[i][0] + x[i][1] * x[i][1] + x[i][2] * x[i][2] + x[i][3] * x[i][3]; }
        if (cl) { float* cp = lat ? cl + (size_t)r * D : cc + (size_t)(r - NLAT) * D;
#pragma unroll
            for (int i = 0; i < 4; ++i) *(f32x4*)(cp + 256 * i + 4 * lane) = x[i]; }
        ss = wave_sum(ss); const float rstd = rsqrtf(ss * (1.f / 1024.f) + EPS);
        const float* mp = modl + (size_t)(lat ? (r >> 13) : 4) * 6144 + sh_idx * 1024;
#pragma unroll
        for (int i = 0; i < 4; ++i) { const f32x4 sh = *(const f32x4*)(mp + 256 * i + 4 * lane), sc = *(const f32x4*)(mp + 1024 + 256 * i + 4 * lane);
            const f32x4 hv = (x[i] * rstd) * gv[i] * (sc + 1.f) + sh;
            u32x2 w; w.x = cvt_pk_bf16(hv[0], hv[1]); w.y = cvt_pk_bf16(hv[2], hv[3]);
            *(u32x2*)(H + (size_t)r * D + 256 * i + 4 * lane) = w; }
    }
}
__device__ __forceinline__ void phase_final_norm(float* xl, const float* g, float oscale) {
    const int tid_ = otid(); const int lane = tid_ & 63, gw = blockIdx.x * 8 + (tid_ >> 6), nw = gridDim.x * 8;
    f32x4 gv[4];
#pragma unroll
    for (int i = 0; i < 4; ++i) gv[i] = *(const f32x4*)(g + 256 * i + 4 * lane);
    for (int r = gw; r < NLAT; r += nw) {
        float* xp = xl + (size_t)r * D; f32x4 x[4]; float ss = 0.f;
#pragma unroll
        for (int i = 0; i < 4; ++i) { x[i] = *(const f32x4*)(xp + 256 * i + 4 * lane); ss += x[i][0] * x[i][0] + x[i][1] * x[i][1] + x[i][2] * x[i][2] + x[i][3] * x[i][3]; }
        ss = wave_sum(ss); const float rstd = rsqrtf(ss * (1.f / 1024.f) + EPS);
#pragma unroll
        for (int i = 0; i < 4; ++i) *(f32x4*)(xp + 256 * i + 4 * lane) = (x[i] * (rstd * oscale)) * gv[i];
    }
}

__device__ __forceinline__ void phase_conv(const Args& A, int li) {
    const bf16_t* PROJ = (const bf16_t*)(A.ws + WS_BIG);
    bf16_t* XS = (bf16_t*)(A.ws + WS_R2); bf16_t* BC = (bf16_t*)(A.ws + WS_R2 + R2_BC);
    const int tid = otid();
    {
        for (int item = blockIdx.x * 3; item < (NROW / 64) * 3; item += gridDim.x * 3)
#pragma unroll 1
        for (int sub = 0; sub < 3; ++sub) {
            const int blk = (item + sub) / 3, q = ((item + sub) % 3) * 512 + tid, cg = q % 192, rg = q / 192, c0 = 8 * cg;
            const int rbeg = blk * 64 + rg * 8; int s0, s1;
            if (rbeg < NLAT) { s0 = rbeg & ~8191; s1 = s0 + 8192; } else { s0 = NLAT + ((rbeg - NLAT) & ~255); s1 = s0 + 256; }
            const float* cw = A.in[I_CONVW] + ((size_t)li * 1536 + c0) * 5; const float* cb = A.in[I_CONVB] + (size_t)li * 1536 + c0;
            u32x4 in[12];
#pragma unroll
            for (int i = 0; i < 12; ++i) { const int r = rbeg - 2 + i; in[i] = (r >= s0 && r < s1) ? *(const u32x4*)(PROJ + (size_t)r * HYB_INP + C_XBC + c0) : (u32x4){0u, 0u, 0u, 0u}; }
            float w[8][5], bia[8];
#pragma unroll
            for (int j = 0; j < 8; ++j) { bia[j] = cb[j];
#pragma unroll
                for (int k = 0; k < 5; ++k) w[j][k] = cw[j * 5 + k]; }
#pragma unroll
            for (int rr = 0; rr < 8; ++rr) {
                float o[8];
#pragma unroll
                for (int j = 0; j < 8; ++j) { float sacc = bia[j];
#pragma unroll
                    for (int k = 0; k < 5; ++k) { const unsigned wd = in[rr + k][j >> 1]; sacc += w[j][k] * ((j & 1) ? bfhi(wd) : bflo(wd)); }
                    o[j] = silu_f(sacc); }
                u32x4 pk; pk.x = cvt_pk_bf16(o[0], o[1]); pk.y = cvt_pk_bf16(o[2], o[3]); pk.z = cvt_pk_bf16(o[4], o[5]); pk.w = cvt_pk_bf16(o[6], o[7]);
                const int r = rbeg + rr;
                if (c0 < 1024) *(u32x4*)(XS + (size_t)r * 1024 + c0) = pk; else *(u32x4*)(BC + (size_t)r * 512 + (c0 - 1024)) = pk;
            }
        }
    }
    {
        const int lane = tid & 63, gw = blockIdx.x * 8 + (tid >> 6), nw = gridDim.x * 8;
        float* DT = (float*)(A.ws + WS_BIG + BIG_DT); float* RQ = (float*)(A.ws + WS_RSTD); float* RKV = RQ + NROW;
        unsigned char* KR = A.ws + WS_BIG + BIG_KR; const float* rope = (const float*)(A.ws + WS_ROPE);
        const float dtb = lane < 32 ? A.in[I_DTB][li * 32 + lane] : 0.f;
        for (int r = gw; r < NROW; r += nw) {
            const bf16_t* p = PROJ + (size_t)r * HYB_INP;
            if (lane < 32) DT[(size_t)lane * NROW + r] = softplus_f(bf2f(p[C_DT + (lane & 15)]) + dtb);
            { const unsigned* q = (const unsigned*)(p + C_CQ + 6 * lane); float ss = 0.f;
#pragma unroll
              for (int j = 0; j < 3; ++j) { const unsigned w = q[j]; const float a = bflo(w), b = bfhi(w); ss += a * a + b * b; }
              ss = wave_sum(ss); if (lane == 0) RQ[r] = rsqrtf(ss * (1.f / 384.f) + EPS); }
            { const u32x2 w = *(const u32x2*)(p + C_CKV + 4 * lane); const float a = bflo(w.x), b = bfhi(w.x), c = bflo(w.y), d = bfhi(w.y);
              float ss = a * a + b * b + c * c + d * d; ss = wave_sum(ss); if (lane == 0) RKV[r] = rsqrtf(ss * (1.f / 256.f) + EPS); }
            if (lane < 32) { const unsigned w = *(const unsigned*)(p + C_KR + 2 * lane); float x1 = bflo(w), x2 = bfhi(w); int b, key;
                if (r < NLAT) { const int l = r & 8191; const float c = rope[l * 32 + lane], s = rope[SEQ * 32 + l * 32 + lane];
                    const float o1 = x1 * c - x2 * s, o2 = x1 * s + x2 * c; x1 = o1; x2 = o2; b = r >> 13; key = 256 + l; }
                else { b = (r - NLAT) >> 8; key = (r - NLAT) & 255; }
                { int w8 = 0; w8 = __builtin_amdgcn_cvt_pk_fp8_f32(x1, x2, w8, false);
                  *(unsigned short*)(KR + (size_t)(b * NKT + (key >> 6)) * 4096 + att8::kr8(key & 63, 2 * lane)) = (unsigned short)(w8 & 0xffff); } }
        }
    }
}

struct EpiQ {
    static constexpr bool PERM = true;
    unsigned char* Q; const float* rstd; const float* rope;
    __device__ __forceinline__ void operator()(const f32x4 (&acc)[2][2][4][2], const pg8::Unit& u, int wr, int wc, int fr, int fq) const {
        const bool lat = u.pm < 128;
        const int b = lat ? (u.pm >> 5) : (u.pm - 128), q0 = lat ? 256 + ((u.pm & 31) << 8) : 0;
        const bool isrope = u.pn >= 4;
#pragma unroll
        for (int ai = 0; ai < 2; ++ai) {
            const int rl = 128 * ai + 64 * wr + fr;
            const float* rsp = rstd + u.pm * 256 + rl;
            const float* rp = rope + (size_t)(((u.pm & 31) << 8) + rl) * 32;
#pragma unroll
            for (int bj = 0; bj < 2; ++bj) {
                const int c0 = u.pn * 256 + 128 * bj + 32 * wc + 8 * fq; int h, dcol;
                if (!isrope) { h = c0 >> 7; dcol = c0 & 127; } else { const int mq = c0 - 1024; h = mq >> 6; dcol = 128 + (mq & 63); }
                unsigned char* dst = Q + ((size_t)(b * 8 + h) * NKEY + q0 + rl) * 192 + dcol;
                const int ro = (dcol - 128) >> 1;
#pragma unroll
                for (int m = 0; m < 4; ++m) {
                    const float rs = rsp[16 * m] * (QSCALE * att8::QUP);
                    f32x4 v0 = acc[ai][bj][m][0] * rs, v1 = acc[ai][bj][m][1] * rs;
                    if (isrope && lat) { const f32x4 cs = *(const f32x4*)(rp + 16 * m * 32 + ro), sn = *(const f32x4*)(rp + SEQ * 32 + 16 * m * 32 + ro);
                        const f32x4 a0 = v0, a1 = v1;
                        v0[0] = a0[0] * cs[0] - a0[1] * sn[0]; v0[1] = a0[0] * sn[0] + a0[1] * cs[0]; v0[2] = a0[2] * cs[1] - a0[3] * sn[1]; v0[3] = a0[2] * sn[1] + a0[3] * cs[1];
                        v1[0] = a1[0] * cs[2] - a1[1] * sn[2]; v1[1] = a1[0] * sn[2] + a1[1] * cs[2]; v1[2] = a1[2] * cs[3] - a1[3] * sn[3]; v1[3] = a1[2] * sn[3] + a1[3] * cs[3]; }
                    u32x2 w; w.x = pk4_fp8(v0[0], v0[1], v0[2], v0[3]); w.y = pk4_fp8(v1[0], v1[1], v1[2], v1[3]);
                    *(u32x2*)(dst + 16 * m * 192) = w;
                    asm volatile("" ::: "memory");
                }
            }
        }
    }
};
struct EpiKV {
    static constexpr bool PERM = true;
    unsigned char* KN; unsigned char* V; const float* rstd;
    __device__ __forceinline__ void operator()(const f32x4 (&acc)[2][2][4][2], const pg8::Unit& u, int wr, int wc, int fr, int fq) const {
        const bool lat = u.pm < 128;
        const int b = lat ? (u.pm >> 5) : (u.pm - 128), t0 = lat ? 4 + ((u.pm & 31) << 2) : 0;
        const int dd = 32 * wc + 8 * fq;
        const int offK = fr * 128 + ((((dd >> 4) ^ ((fr >> 1) & 7))) << 4) + (dd & 15);
#pragma unroll
        for (int ai = 0; ai < 2; ++ai) {
            const size_t tb = ((size_t)(b * 8 + u.pn) * NKT + t0 + 2 * ai + wr) * 8192;
            const float* rsp = rstd + u.pm * 256 + 128 * ai + 64 * wr + fr;
            unsigned char* kp = KN + tb + offK; unsigned char* vp = V + tb;
#pragma unroll
            for (int m = 0; m < 4; ++m) {
                const float rs = rsp[16 * m];
                { const f32x4 v0 = acc[ai][0][m][0] * rs, v1 = acc[ai][0][m][1] * rs; u32x2 w; w.x = pk4_fp8(v0[0], v0[1], v0[2], v0[3]); w.y = pk4_fp8(v1[0], v1[1], v1[2], v1[3]);
                  *(u32x2*)(kp + m * 2048) = w; }
                { const f32x4 v0 = acc[ai][1][m][0] * rs, v1 = acc[ai][1][m][1] * rs; const unsigned w0 = pk4_fp8(v0[0], v0[1], v0[2], v0[3]), w1 = pk4_fp8(v1[0], v1[1], v1[2], v1[3]);
                  const int sl = att8::vslot(16 * m + fr);
#pragma unroll
                  for (int i = 0; i < 8; ++i) { const int d = dd + i; vp[d * 64 + ((((sl >> 4) ^ ((d >> 2) & 3))) << 4) + (sl & 15)] = (unsigned char)(((i < 4 ? w0 : w1) >> (8 * (i & 3))) & 0xffu); } }
                asm volatile("" ::: "memory");
            }
        }
    }
};

__device__ __forceinline__ void phase_ssd_out(const Args& A, int li, int nrows) {
    const bf16_t* PROJ = (const bf16_t*)(A.ws + WS_BIG); const bf16_t* XS = (const bf16_t*)(A.ws + WS_R2);
    const bf16_t* Y0 = (const bf16_t*)(A.ws + WS_H); const bf16_t* Y1 = (const bf16_t*)(A.ws + WS_R3); bf16_t* CAT = (bf16_t*)(A.ws + WS_R3 + R3_CAT);
    const int tid_ = otid(); const int lane = tid_ & 63, gw = blockIdx.x * 8 + (tid_ >> 6), nw = gridDim.x * 8;
    const float dsk = A.in[I_SSDD][li * 16 + (lane >> 2)];
    float ng[16];
#pragma unroll
    for (int j = 0; j < 16; ++j) ng[j] = A.in[I_SSDNG][li * 1024 + 16 * lane + j];
    for (int r = gw; r < nrows; r += nw) {
        float v[16]; float ss = 0.f;
#pragma unroll
        for (int hh = 0; hh < 2; ++hh) {
            const u32x4 a = *(const u32x4*)(Y0 + (size_t)r * 1024 + 16 * lane + 8 * hh), b = *(const u32x4*)(Y1 + (size_t)r * 1024 + 16 * lane + 8 * hh);
            const u32x4 x = *(const u32x4*)(XS + (size_t)r * 1024 + 16 * lane + 8 * hh), z = *(const u32x4*)(PROJ + (size_t)r * HYB_INP + 16 * lane + 8 * hh);
#pragma unroll
            for (int q = 0; q < 4; ++q) {
                const float y0 = (bflo(a[q]) + bflo(b[q]) + dsk * bflo(x[q])) * silu_f(bflo(z[q])), y1 = (bfhi(a[q]) + bfhi(b[q]) + dsk * bfhi(x[q])) * silu_f(bfhi(z[q]));
                v[8 * hh + 2 * q] = y0; v[8 * hh + 2 * q + 1] = y1; ss += y0 * y0 + y1 * y1; }
        }
#pragma unroll
        for (int o = 16; o >= 1; o >>= 1) ss += __shfl_xor(ss, o);
        const float rstd = rsqrtf(ss * (1.f / 512.f) + EPS);
#pragma unroll
        for (int hh = 0; hh < 2; ++hh) { u32x4 w;
#pragma unroll
            for (int q = 0; q < 4; ++q) w[q] = cvt_pk_bf16(v[8 * hh + 2 * q] * rstd * ng[8 * hh + 2 * q], v[8 * hh + 2 * q + 1] * rstd * ng[8 * hh + 2 * q + 1]);
            *(u32x4*)(CAT + (size_t)r * 2048 + 16 * lane + 8 * hh) = w; }
    }
}

__device__ __forceinline__ void phase_ln_stats(const Args& A, int nrows) {
    const bf16_t* Gb = (const bf16_t*)(A.ws + WS_BIG); float* ST = (float*)(A.ws + WS_RSTD);
    const int tid_ = otid(); const int lane = tid_ & 63, gw = blockIdx.x * 8 + (tid_ >> 6), nw = gridDim.x * 8;
    for (int r = gw; r < nrows; r += nw) {
        float v[32]; float s = 0.f;
#pragma unroll
        for (int j = 0; j < 4; ++j) { const u32x4 w = *(const u32x4*)(Gb + (size_t)r * 4096 + 2048 + 512 * j + 8 * lane);
#pragma unroll
            for (int q = 0; q < 4; ++q) { v[8 * j + 2 * q] = bflo(w[q]); v[8 * j + 2 * q + 1] = bfhi(w[q]); s += v[8 * j + 2 * q] + v[8 * j + 2 * q + 1]; } }
        s = wave_sum(s); const float mu = s * (1.f / 2048.f); float q2 = 0.f;
#pragma unroll
        for (int j = 0; j < 32; ++j) { const float dd = v[j] - mu; q2 += dd * dd; }
        q2 = wave_sum(q2);
        if (lane == 0) { ST[r] = mu; ST[NROW + r] = rsqrtf(q2 * (1.f / 2048.f) + EPS); }
    }
}
__device__ __forceinline__ void phase_spatial(const Args& A, int gi, int nrows, LAS unsigned char* lds) {
    const bf16_t* Gb = (const bf16_t*)(A.ws + WS_BIG); const float* ST = (const float*)(A.ws + WS_RSTD); bf16_t* Ab = (bf16_t*)(A.ws + WS_R1);
    const bf16_t* WSg = (const bf16_t*)(A.ws + WS_W + W_GM + (size_t)gi * WG_SZ + WG_WS);
    const float* lng = A.in[I_GLNG] + (size_t)gi * 2048; const float* lnb = A.in[I_GLNB] + (size_t)gi * 2048; const float* bs = A.in[I_GBS] + (size_t)gi * 1024;
    const int tid = otid(), wid = tid >> 6, lane = tid & 63, r32 = lane & 31, hi = lane >> 5, tb = wid & 3, dh = wid >> 2;
    const int ldsaddr = (int)(unsigned)(uintptr_t)lds;
    for (int unit = blockIdx.x; unit < (nrows / 128) * 8; unit += gridDim.x) {
        const int cb = unit >> 3, gg = unit & 7, r0 = cb * 128;
        __syncthreads();
#pragma unroll
        for (int j = 0; j < 8; ++j) { const int idx = tid + 512 * j, s = idx >> 5, dd = (idx & 31) * 8;
            const u32x4 w = *(const u32x4*)(Gb + (size_t)(r0 + s) * 4096 + 2048 + 256 * gg + dd);
            const float mu = ST[r0 + s], rs = ST[NROW + r0 + s];
            const f32x4 g0 = *(const f32x4*)(lng + 256 * gg + dd), g1 = *(const f32x4*)(lng + 256 * gg + dd + 4), b0 = *(const f32x4*)(lnb + 256 * gg + dd), b1 = *(const f32x4*)(lnb + 256 * gg + dd + 4);
            u32x4 o;
            o.x = cvt_pk_bf16((bflo(w.x) - mu) * rs * g0[0] + b0[0], (bfhi(w.x) - mu) * rs * g0[1] + b0[1]); o.y = cvt_pk_bf16((bflo(w.y) - mu) * rs * g0[2] + b0[2], (bfhi(w.y) - mu) * rs * g0[3] + b0[3]);
            o.z = cvt_pk_bf16((bflo(w.z) - mu) * rs * g1[0] + b1[0], (bfhi(w.z) - mu) * rs * g1[1] + b1[1]); o.w = cvt_pk_bf16((bflo(w.w) - mu) * rs * g1[2] + b1[2], (bfhi(w.w) - mu) * rs * g1[3] + b1[3]);
            *(LAS u32x4*)(lds + ((s >> 6) * 2 + (dd >> 7)) * 16384 + att::v_st(s & 63, dd & 127)) = o; }
        bf16x8 pa[8];
#pragma unroll
        for (int ks = 0; ks < 8; ++ks) pa[ks] = *(const bf16x8*)(WSg + ((size_t)gg * 128 + 32 * tb + r32) * 128 + 16 * ks + 8 * hi);
        __syncthreads();
        f32x16 o[4] = {};
#define SP_PV(D0, vbase, p0, p1, p2, p3) do { \
            const s16x4 l0 = att::tr_read<att::v_rd_off(D0, 0, 0)>(vbase), h0 = att::tr_read<att::v_rd_off(D0, 0, 1)>(vbase), l1 = att::tr_read<att::v_rd_off(D0, 1, 0)>(vbase), h1 = att::tr_read<att::v_rd_off(D0, 1, 1)>(vbase); \
            const s16x4 l2 = att::tr_read<att::v_rd_off(D0, 2, 0)>(vbase), h2 = att::tr_read<att::v_rd_off(D0, 2, 1)>(vbase), l3 = att::tr_read<att::v_rd_off(D0, 3, 0)>(vbase), h3 = att::tr_read<att::v_rd_off(D0, 3, 1)>(vbase); \
            asm volatile("s_waitcnt lgkmcnt(0)" ::: "memory"); __builtin_amdgcn_sched_barrier(0); \
            o[D0] = __builtin_amdgcn_mfma_f32_32x32x16_bf16((bf16x8){l0[0], l0[1], l0[2], l0[3], h0[0], h0[1], h0[2], h0[3]}, p0, o[D0], 0, 0, 0); \
            o[D0] = __builtin_amdgcn_mfma_f32_32x32x16_bf16((bf16x8){l1[0], l1[1], l1[2], l1[3], h1[0], h1[1], h1[2], h1[3]}, p1, o[D0], 0, 0, 0); \
            o[D0] = __builtin_amdgcn_mfma_f32_32x32x16_bf16((bf16x8){l2[0], l2[1], l2[2], l2[3], h2[0], h2[1], h2[2], h2[3]}, p2, o[D0], 0, 0, 0); \
            o[D0] = __builtin_amdgcn_mfma_f32_32x32x16_bf16((bf16x8){l3[0], l3[1], l3[2], l3[3], h3[0], h3[1], h3[2], h3[3]}, p3, o[D0], 0, 0, 0); } while (0)
        { const int vb0 = ldsaddr + (0 * 2 + dh) * 16384 + att::v_rd_base(lane), vb1 = ldsaddr + (1 * 2 + dh) * 16384 + att::v_rd_base(lane);
          SP_PV(0, vb0, pa[0], pa[1], pa[2], pa[3]); SP_PV(1, vb0, pa[0], pa[1], pa[2], pa[3]); SP_PV(2, vb0, pa[0], pa[1], pa[2], pa[3]); SP_PV(3, vb0, pa[0], pa[1], pa[2], pa[3]);
          SP_PV(0, vb1, pa[4], pa[5], pa[6], pa[7]); SP_PV(1, vb1, pa[4], pa[5], pa[6], pa[7]); SP_PV(2, vb1, pa[4], pa[5], pa[6], pa[7]); SP_PV(3, vb1, pa[4], pa[5], pa[6], pa[7]); }
#undef SP_PV
        { const int t = 32 * tb + r32, row = r0 + t; const float bsv = bs[gg * 128 + t];
          const bf16_t* up = Gb + (size_t)row * 4096 + 256 * gg + 128 * dh + 4 * hi; bf16_t* ap = Ab + (size_t)row * 2048 + 256 * gg + 128 * dh + 4 * hi;
#pragma unroll
          for (int d0 = 0; d0 < 4; ++d0)
#pragma unroll
              for (int k = 0; k < 4; ++k) {
                  const u32x2 uu = *(const u32x2*)(up + 32 * d0 + 8 * k);
                  u32x2 w; w.x = cvt_pk_bf16(bflo(uu.x) * (o[d0][4 * k] + bsv), bfhi(uu.x) * (o[d0][4 * k + 1] + bsv)); w.y = cvt_pk_bf16(bflo(uu.y) * (o[d0][4 * k + 2] + bsv), bfhi(uu.y) * (o[d0][4 * k + 3] + bsv));
                  *(u32x2*)(ap + 32 * d0 + 8 * k) = w; } }
    }
}

constexpr int NSL = 8, SW = 1024 / NSL;
constexpr size_t TAB8_HALF = (size_t)NEXP * 1024, TAB_SCL = 2 * TAB8_HALF;
constexpr float HS = 4.f;
__device__ __forceinline__ void phase_tabcvt(const Args& A, int layer) {
    const int tid_ = otid(); const int lane = tid_ & 63, gw = blockIdx.x * 8 + (tid_ >> 6), nw = gridDim.x * 8;
    float* SCL = (float*)(A.ws + WS_TAB + TAB_SCL);
    for (int r = gw; r < 2 * NEXP; r += nw) {
        const int tab = r >> 14, e = r & (NEXP - 1);
        const float* src = (tab ? A.in[I_PV] : A.in[I_PU]) + ((size_t)layer * NEXP + e) * 1024 + 16 * lane;
        f32x4 v[4]; float am = 0.f;
#pragma unroll
        for (int i = 0; i < 4; ++i) { v[i] = *(const f32x4*)(src + 4 * i); am = fmaxf(am, fmaxf(fmaxf(fabsf(v[i][0]), fabsf(v[i][1])), fmaxf(fabsf(v[i][2]), fabsf(v[i][3])))); }
#pragma unroll
        for (int o = 32; o >= 1; o >>= 1) am = fmaxf(am, __shfl_xor(am, o));
        float sc = 1.f; if (am > 0.f) { int ex; (void)frexpf(448.f / am, &ex); sc = ldexpf(1.f, ex - 1); }
        if (lane == 0) SCL[tab * NEXP + e] = 1.f / sc;
        u32x4 w;
#pragma unroll
        for (int i = 0; i < 4; ++i) w[i] = pk4_fp8(v[i][0] * sc, v[i][1] * sc, v[i][2] * sc, v[i][3] * sc);
        *(u32x4*)(A.ws + WS_TAB + (size_t)tab * TAB8_HALF + ((size_t)(lane >> 3) * NEXP + e) * SW + 16 * (lane & 7)) = w;
    }
}
#define CASD(a, b) do { const float hi_ = fmaxf(a, b), lo_ = fminf(a, b); a = hi_; b = lo_; } while (0)
__device__ __forceinline__ void sort16(float (&k)[16]) {
#pragma unroll
    for (int sz = 2; sz <= 16; sz <<= 1)
#pragma unroll
        for (int j = sz >> 1; j > 0; j >>= 1)
#pragma unroll
            for (int i = 0; i < 16; ++i) { const int l = i ^ j; if (l > i) { if ((i & sz) == 0 || sz == 16) CASD(k[i], k[l]); else CASD(k[l], k[i]); } }
}
__device__ __forceinline__ void bmerge16(float (&k)[16]) {
#pragma unroll
    for (int j = 8; j > 0; j >>= 1)
#pragma unroll
        for (int i = 0; i < 16; ++i) { const int l = i ^ j; if (l > i) CASD(k[i], k[l]); }
}
__device__ __forceinline__ void merge_top16(float (&a)[16], const float (&b)[16]) {
#pragma unroll
    for (int i = 0; i < 16; ++i) a[i] = fmaxf(a[i], b[15 - i]);
    bmerge16(a);
}
__device__ __forceinline__ void xmerge_top16(float (&a)[16], int mask) {
    float t[16];
#pragma unroll
    for (int i = 0; i < 16; ++i) t[i] = __shfl_xor(a[15 - i], mask);
#pragma unroll
    for (int i = 0; i < 16; ++i) a[i] = fmaxf(a[i], t[i]);
    bmerge16(a);
}
__device__ __forceinline__ void phase_topk(const Args& A, int layer, int nrows, LAS unsigned char* lds) {
    const bf16_t* QP = (const bf16_t*)(A.ws + WS_BIG); int* IDX = (int*)(A.ws + WS_R2); float* GATE = (float*)(A.ws + WS_R2 + R2_GATE);
    const int tid = otid(), wid = tid >> 6, lane = tid & 63, fr = lane & 15, fq = lane >> 4;
    LAS unsigned* scr = (LAS unsigned*)(lds + 2 * 34816) + wid * 512 + fr * 32;
    for (int unit = blockIdx.x; unit < (nrows / 128) * 8; unit += gridDim.x) {
        const int h = unit & 7, r0 = (unit >> 3) * 128;
        __syncthreads();
        { const bf16_t* k1 = (const bf16_t*)(A.ws + WS_W + W_PEER + (size_t)layer * WP_SZ + WP_K1) + (size_t)h * 16384;
#pragma unroll
          for (int j = 0; j < 8; ++j) { const int idx = tid + 512 * j, half = idx >> 11, rem = idx & 2047, key = rem >> 4, c8 = rem & 15;
              const u32x4 w = *(const u32x4*)(k1 + (size_t)half * 8 * 16384 + key * 128 + 8 * c8);
              *(LAS u32x4*)(lds + half * 34816 + key * 272 + c8 * 16) = w; } }
        __syncthreads();
        const int tok = r0 + 16 * wid + fr;
        float top[2][16];
#pragma unroll
        for (int half = 0; half < 2; ++half) {
            bf16x8 qf[4];
#pragma unroll
            for (int ks = 0; ks < 4; ++ks) qf[ks] = *(const bf16x8*)(QP + (size_t)tok * 2048 + 256 * h + 128 * half + 32 * ks + 8 * fq);
            float loc[16];
#pragma unroll
            for (int grp = 0; grp < 2; ++grp) {
                float kk[16];
#pragma unroll
                for (int nbb = 0; nbb < 4; ++nbb) { const int nb = 4 * grp + nbb; f32x4 acc = {0.f, 0.f, 0.f, 0.f};
#pragma unroll
                    for (int ks = 0; ks < 4; ++ks) { const bf16x8 kf = *(const LAS bf16x8*)(lds + half * 34816 + (16 * nb + fr) * 272 + (32 * ks + 8 * fq) * 2);
                        acc = __builtin_amdgcn_mfma_f32_16x16x32_bf16(kf, qf[ks], acc, 0, 0, 0); }
#pragma unroll
                    for (int i = 0; i < 4; ++i) { const unsigned code = 127u - (unsigned)(16 * nb + 4 * fq + i); kk[4 * nbb + i] = __uint_as_float((__float_as_uint(acc[i]) & ~127u) | code); } }
                sort16(kk);
                if (grp == 0) {
#pragma unroll
                    for (int i = 0; i < 16; ++i) loc[i] = kk[i];
                } else merge_top16(loc, kk);
            }
            xmerge_top16(loc, 16); xmerge_top16(loc, 32);
#pragma unroll
            for (int i = 0; i < 16; ++i) top[half][i] = loc[i];
        }
        if (fq < 2) {
#pragma unroll
            for (int i = 0; i < 16; ++i) scr[16 * fq + i] = __float_as_uint(fq == 0 ? top[0][i] : top[1][i]); }
        float fin[16];
#pragma unroll
        for (int aa = 0; aa < 4; ++aa) {
            const float va_k = fq == 0 ? top[0][aa] : fq == 1 ? top[0][4 + aa] : fq == 2 ? top[0][8 + aa] : top[0][12 + aa];
            const float va = __uint_as_float(__float_as_uint(va_k) & ~127u);
            float c[16];
#pragma unroll
            for (int bb = 0; bb < 16; ++bb) { const float s = va + __uint_as_float(__float_as_uint(top[1][bb]) & ~127u);
                c[bb] = __uint_as_float((__float_as_uint(s) & ~255u) | (255u - (unsigned)((4 * fq + aa) * 16 + bb))); }
            if (aa == 0) {
#pragma unroll
                for (int i = 0; i < 16; ++i) fin[i] = c[i];
            } else merge_top16(fin, c);
        }
        xmerge_top16(fin, 16); xmerge_top16(fin, 32);
        float ev[16], es = 0.f; const float mx = __uint_as_float(__float_as_uint(fin[0]) & ~255u);
#pragma unroll
        for (int i = 0; i < 16; ++i) { ev[i] = __expf(__uint_as_float(__float_as_uint(fin[i]) & ~255u) - mx); es += ev[i]; }
        const float inv = 1.f / es;
        asm volatile("s_waitcnt lgkmcnt(0)" ::: "memory");
        int oi[4]; float og[4];
#pragma unroll
        for (int kq = 0; kq < 4; ++kq) {
            const float fk = fq == 0 ? fin[kq] : fq == 1 ? fin[4 + kq] : fq == 2 ? fin[8 + kq] : fin[12 + kq];
            const float fe = fq == 0 ? ev[kq] : fq == 1 ? ev[4 + kq] : fq == 2 ? ev[8 + kq] : ev[12 + kq];
            const unsigned code = 255u - (__float_as_uint(fk) & 255u), a = code >> 4, bq = code & 15u;
            const unsigned i1 = 127u - (scr[a] & 127u), i2 = 127u - (scr[16 + bq] & 127u);
            oi[kq] = (int)(i1 * 128u + i2); og[kq] = fe * inv; }
        *(int4*)(IDX + (size_t)tok * 128 + 16 * h + 4 * fq) = make_int4(oi[0], oi[1], oi[2], oi[3]);
        *(f32x4*)(GATE + (size_t)tok * 128 + 16 * h + 4 * fq) = (f32x4){og[0], og[1], og[2], og[3]};
    }
}
struct PeerSched {
    int x0, rank, nloc, nblk, nown; unsigned orphan;
    __device__ __forceinline__ void init(const Args& A, int nrows, LAS unsigned char* smem) {
        unsigned* ctl = (unsigned*)(A.ws + WS_CTL);
        x0 = (int)(xb_xcc_id() & 7u); rank = __builtin_amdgcn_readfirstlane((int)((LAS unsigned*)smem)[8]); nblk = nrows / 64;
        unsigned cached = __builtin_amdgcn_readfirstlane(((LAS unsigned*)smem)[9]);
        if (cached == 0u) { unsigned orph = 0u, nl = 1u;
            for (int j = 0; j < 8; ++j) { unsigned c = xb_ld(&ctl[XB_XCNT(j)]) + xb_ld(&ctl[XB_XCNT(j + 8)]); c = __builtin_amdgcn_readfirstlane(c); if (c == 0u) orph |= 1u << j; if (j == x0) nl = c; }
            cached = (nl << 8) | orph; __syncthreads(); if (threadIdx.x == 0) ((LAS unsigned*)smem)[9] = cached; __syncthreads(); }
        nloc = (int)(cached >> 8); orphan = cached & 0xffu;
        const int tot = (NSL / 8) * nblk; nown = rank < tot ? (tot - rank + nloc - 1) / nloc : 0;
    }
    __device__ __forceinline__ bool item(int j, int& sl, int& blk) const {
        if (j < nown) { const int i = rank + j * nloc; sl = x0 + 8 * (i / nblk); blk = i % nblk; return true; }
        int jj = j - nown; const int tot = (NSL / 8) * nblk, per = ((int)gridDim.x > tot) ? 1 : 0; (void)per;
        for (int o = 0; o < 8; ++o) if ((orphan >> o) & 1u) { const int cnt = ((int)blockIdx.x < tot) ? (tot - (int)blockIdx.x + (int)gridDim.x - 1) / (int)gridDim.x : 0;
            if (jj < cnt) { const int i = (int)blockIdx.x + jj * (int)gridDim.x; sl = o + 8 * (i / nblk); blk = i % nblk; return true; } jj -= cnt; }
        return false;
    }
};
template <class LD, class ST, class PR>
__device__ __forceinline__ void peer_items(const PeerSched& S, LD ld, ST st, PR pr) {
    int sl, blk, sln, blkn, j = 0, buf = 0; bool have = S.item(0, sl, blk);
    if (have) { ld(sl, blk, 0); st(0); }
    while (have) {
        const bool haven = S.item(j + 1, sln, blkn);
        asm volatile("s_waitcnt vmcnt(0)" ::: "memory");
        __syncthreads();
        if (haven) ld(sln, blkn, buf ^ 1);
        pr(sl, blk, buf);
        if (haven) st(buf ^ 1);
        sl = sln; blk = blkn; have = haven; buf ^= 1; ++j;
    }
    __syncthreads();
}
#ifndef MK_UVAR
#define MK_UVAR 0
#endif
__device__ __forceinline__ void phase_peer_u(const Args& A, int layer, int nrows, LAS unsigned char* smem, int rep) {
    const int var = rep ? MK_UVAR : 0;
    const bf16_t* H = (const bf16_t*)(A.ws + WS_H); const int* IDX = (const int*)(A.ws + WS_R2); float* PART = var ? (float*)(A.ws + WS_R1) : (float*)(A.ws + WS_BIG + BIG_PART);
    const unsigned char* U = A.ws + WS_TAB;
    LAS unsigned char* lds = smem + LDS_BASE;
    constexpr int BUF = 32768 + 64 * SW;
    const int tid = otid(), wid = tid >> 6, lane = tid & 63, fr = lane & 15, fq = lane >> 4;
    PeerSched S; S.init(A, nrows, smem);
    u32x4 ri[4], rh[2];
    peer_items(S,
        [&](int sl, int blk, int) {
#pragma unroll
            for (int i = 0; i < 4; ++i) ri[i] = *(const u32x4*)(IDX + (size_t)blk * 64 * 128 + 4 * (tid + 512 * i));
            const bf16_t* hp = H + (size_t)(blk * 64 + (tid >> 3)) * 1024 + SW * sl + 16 * (tid & 7);
            rh[0] = *(const u32x4*)hp; rh[1] = *(const u32x4*)(hp + 8); },
        [&](int buf) {
#pragma unroll
            for (int i = 0; i < 4; ++i) *(LAS u32x4*)(lds + buf * BUF + 16 * (tid + 512 * i)) = ri[i];
            u32x4 w;
#pragma unroll
            for (int i = 0; i < 2; ++i) { w[2 * i] = pk4_fp8(bflo(rh[i].x) * HS, bfhi(rh[i].x) * HS, bflo(rh[i].y) * HS, bfhi(rh[i].y) * HS);
                                          w[2 * i + 1] = pk4_fp8(bflo(rh[i].z) * HS, bfhi(rh[i].z) * HS, bflo(rh[i].w) * HS, bfhi(rh[i].w) * HS); }
            *(LAS u32x4*)(lds + buf * BUF + 32768 + 16 * tid) = w; },
        [&](int sl, int blk, int buf) {
            const unsigned char* ub = U + (size_t)sl * NEXP * SW + 32 * fq;
            const LAS int* ib = (const LAS int*)(lds + buf * BUF) + (wid * 8) * 128 + fr; const LAS unsigned char* hb = lds + buf * BUF + 32768 + (wid * 8) * SW + 32 * fq;
            u32x4 uf[2][8][2];
#define PU_ROWS(T, t) do { _Pragma("unroll") for (int g = 0; g < 8; ++g) { int e_ = ib[(t) * 128 + 16 * g]; if (var == 3) e_ &= 63; \
                _Pragma("unroll") for (int hh = 0; hh < 2; ++hh) { if (var == 4) uf[T][g][hh] = (u32x4){(unsigned)e_, (unsigned)e_, 0u, 0u}; else uf[T][g][hh] = *(const u32x4*)(ub + (size_t)e_ * SW + 16 * hh); } } } while (0)
            PU_ROWS(0, 0);
#define PU_TOKEN(T, t) do { \
                const u32x4 h0 = *(const LAS u32x4*)(hb + (t) * SW), h1 = *(const LAS u32x4*)(hb + (t) * SW + 16); \
                const i32x8 hv = {(int)h0.x, (int)h0.y, (int)h0.z, (int)h0.w, (int)h1.x, (int)h1.y, (int)h1.z, (int)h1.w}; \
                float v0 = 0.f, v1 = 0.f; \
                _Pragma("unroll") for (int g = 0; g < 8; ++g) { const u32x4 ua = uf[T][g][0], ub2 = uf[T][g][1]; \
                    const i32x8 uv = {(int)ua.x, (int)ua.y, (int)ua.z, (int)ua.w, (int)ub2.x, (int)ub2.y, (int)ub2.z, (int)ub2.w}; \
                    const f32x4 acc = __builtin_amdgcn_mfma_scale_f32_16x16x128_f8f6f4(hv, uv, (f32x4){0.f, 0.f, 0.f, 0.f}, 0, 0, 0, 0x7f7f7f7f, 0, 0x7f7f7f7f);     \
                    if (g < 4) v0 = fq == g ? acc[0] : v0; else v1 = fq == g - 4 ? acc[0] : v1; }        \
                float* pp = PART + ((size_t)sl * NROW + blk * 64 + wid * 8 + (t)) * 128 + 16 * fq + fr; \
                pp[0] = v0; pp[64] = v1; } while (0)
#pragma unroll 1
            for (int tp = 0; tp < 4; ++tp) {
                PU_ROWS(1, 2 * tp + 1);
                __builtin_amdgcn_sched_barrier(0);
                PU_TOKEN(0, 2 * tp);
                __builtin_amdgcn_sched_barrier(0);
                if (tp + 1 < 4) PU_ROWS(0, 2 * tp + 2);
                __builtin_amdgcn_sched_barrier(0);
                PU_TOKEN(1, 2 * tp + 1);
                __builtin_amdgcn_sched_barrier(0);
            }
#undef PU_TOKEN
#undef PU_ROWS
        });
}
__device__ __forceinline__ void phase_coef(const Args& A, int nrows) {
    const float* PART = (const float*)(A.ws + WS_BIG + BIG_PART); const float* GATE = (const float*)(A.ws + WS_R2 + R2_GATE); float* COEF = (float*)(A.ws + WS_R2 + R2_COEF);
    const int* IDX = (const int*)(A.ws + WS_R2); const float* SCL = (const float*)(A.ws + WS_TAB + TAB_SCL);
    const int gthr = blockIdx.x * NTHR + otid(), nthr = gridDim.x * NTHR;
    for (int p = gthr; p < nrows * 32; p += nthr) {
        f32x4 s = {0.f, 0.f, 0.f, 0.f};
#pragma unroll
        for (int x = 0; x < NSL; ++x) s += *(const f32x4*)(PART + (size_t)x * NROW * 128 + 4 * p);
        const i32x4 e = *(const i32x4*)(IDX + 4 * p); const f32x4 gt = *(const f32x4*)(GATE + 4 * p);
        const f32x4 su = {SCL[e.x], SCL[e.y], SCL[e.z], SCL[e.w]}, sv = {SCL[NEXP + e.x], SCL[NEXP + e.y], SCL[NEXP + e.z], SCL[NEXP + e.w]};
        const f32x4 a = s * (1.f / HS) * su; const f32x2 g0 = gelu_pk((f32x2){a[0], a[1]}), g1 = gelu_pk((f32x2){a[2], a[3]});
        *(f32x4*)(COEF + 4 * p) = gt * (f32x4){g0.x, g0.y, g1.x, g1.y} * sv; }

}
__device__ __forceinline__ void phase_peer_v(const Args& A, int layer, int nrows, LAS unsigned char* smem, int rep) {
    const int* IDX = (const int*)(A.ws + WS_R2); const float* COEF = (const float*)(A.ws + WS_R2 + R2_COEF);
    const unsigned char* V = A.ws + WS_TAB + TAB8_HALF; const float* MODL = (const float*)(A.ws + WS_MOD) + (size_t)layer * 5 * 6144 + 5 * 1024;
    float* XC = (float*)(A.ws + WS_XC);
    LAS unsigned char* lds = smem + LDS_BASE;
    constexpr int BUF = 65536;
    const int tid = otid(), wid = tid >> 6, lane = tid & 63, m = lane & 7, tk = lane >> 3;
    PeerSched S; S.init(A, nrows, smem);
    const int wu = __builtin_amdgcn_readfirstlane(wid);
    peer_items(S,
        [&](int sl, int blk, int buf) {
#pragma unroll
            for (int i = 0; i < 4; ++i) {
                __builtin_amdgcn_global_load_lds((const unsigned*)(IDX + (size_t)blk * 64 * 128 + 256 * (wu + 8 * i) + 4 * lane), (LAS unsigned*)(lds + buf * BUF + 1024 * (wu + 8 * i)), 16, 0, 0);
                __builtin_amdgcn_global_load_lds((const unsigned*)(COEF + (size_t)blk * 64 * 128 + 256 * (wu + 8 * i) + 4 * lane), (LAS unsigned*)(lds + buf * BUF + 32768 + 1024 * (wu + 8 * i)), 16, 0, 0); } },
        [&](int buf) { },
        [&](int sl, int blk, int buf) {
            const unsigned char* vb = V + (size_t)sl * NEXP * SW + 16 * m;
            const int tokl = wid * 8 + tk, tok = blk * 64 + tokl; const bool lat = tok < NLAT;
            const LAS int* ib = (const LAS int*)(lds + buf * BUF) + tokl * 128; const LAS float* cb = (const LAS float*)(lds + buf * BUF + 32768) + tokl * 128;
            float* xp = (lat ? A.out + (size_t)tok * D : XC + (size_t)(tok - NLAT) * D) + SW * sl + 16 * m;
            f32x4 xr[4];
#pragma unroll
            for (int j = 0; j < 4; ++j) xr[j] = *(f32x4*)(xp + 4 * j);
            f32x2 acc2[8];
#pragma unroll
            for (int j = 0; j < 8; ++j) acc2[j] = (f32x2){0.f, 0.f};
            u32x4 vv[2][8];
#define PV_ROWS(T, c) do { const i32x4 e0_ = *(const LAS i32x4*)(ib + 8 * (c)), e1_ = *(const LAS i32x4*)(ib + 8 * (c) + 4); \
                vv[T][0] = *(const u32x4*)(vb + (size_t)e0_.x * SW); vv[T][1] = *(const u32x4*)(vb + (size_t)e0_.y * SW); vv[T][2] = *(const u32x4*)(vb + (size_t)e0_.z * SW); vv[T][3] = *(const u32x4*)(vb + (size_t)e0_.w * SW); \
                vv[T][4] = *(const u32x4*)(vb + (size_t)e1_.x * SW); vv[T][5] = *(const u32x4*)(vb + (size_t)e1_.y * SW); vv[T][6] = *(const u32x4*)(vb + (size_t)e1_.z * SW); vv[T][7] = *(const u32x4*)(vb + (size_t)e1_.w * SW); } while (0)
#define PV_FMA(T, c) do { const f32x4 c0_ = *(const LAS f32x4*)(cb + 8 * (c)), c1_ = *(const LAS f32x4*)(cb + 8 * (c) + 4); \
                _Pragma("unroll") for (int k = 0; k < 8; ++k) { const float cf = k < 4 ? c0_[k & 3] : c1_[k & 3]; \
                    _Pragma("unroll") for (int j = 0; j < 4; ++j) { const int w = (int)vv[T][k][j]; \
                        const f32x2 lo = __builtin_amdgcn_cvt_pk_f32_fp8(w, false), hi = __builtin_amdgcn_cvt_pk_f32_fp8(w, true); const f32x2 c2 = {cf, cf}; \
                        acc2[2 * j] = __builtin_elementwise_fma(lo, c2, acc2[2 * j]); acc2[2 * j + 1] = __builtin_elementwise_fma(hi, c2, acc2[2 * j + 1]); } } } while (0)
            PV_ROWS(0, 0);
#pragma unroll 1
            for (int c = 0; c < 16; c += 2) {
                PV_ROWS(1, c + 1);
                __builtin_amdgcn_sched_barrier(0);
                PV_FMA(0, c);
                __builtin_amdgcn_sched_barrier(0);
                if (c + 2 < 16) PV_ROWS(0, c + 2);
                __builtin_amdgcn_sched_barrier(0);
                PV_FMA(1, c + 1);
                __builtin_amdgcn_sched_barrier(0);
            }
#undef PV_ROWS
#undef PV_FMA
            const float* gp = MODL + (size_t)(lat ? (tok >> 13) : 4) * 6144 + SW * sl + 16 * m;
#pragma unroll
            for (int j = 0; j < 4; ++j) { const f32x4 g = *(const f32x4*)(gp + 4 * j);
                *(f32x4*)(xp + 4 * j) = xr[j] + g * (f32x4){acc2[2 * j].x, acc2[2 * j].y, acc2[2 * j + 1].x, acc2[2 * j + 1].y}; }
        });
}

#ifdef MK_CHECK
constexpr int CW_CHK = 3840;
__device__ __forceinline__ float blk_sum(float v, LAS float* red) {
    const int t_ = otid(); v = wave_sum(v); __syncthreads(); if ((t_ & 63) == 0) red[t_ >> 6] = v; __syncthreads();
    float s = 0.f; for (int i = 0; i < 8; ++i) s += red[i]; __syncthreads(); return s;
}
__device__ __forceinline__ float fp8f(unsigned b) { const unsigned e = (b >> 3) & 15u, m = b & 7u; const float v = e ? ldexpf(1.f + (float)m * 0.125f, (int)e - 7) : ldexpf((float)m * 0.125f, -6); return (b & 0x80u) ? -v : v; }
__device__ __forceinline__ void check_attn(const Args& A, LAS unsigned char* lds) {
    const unsigned char* Q = A.ws + WS_R1 + R1_Q; const unsigned char* KN = A.ws + WS_R1 + R1_KN; const unsigned char* KR = A.ws + WS_BIG + BIG_KR; const unsigned char* V = A.ws + WS_R1 + R1_V;
    const bf16_t* CAT = (const bf16_t*)(A.ws + WS_R3 + R3_CAT); float* chk = (float*)(A.ws + WS_CTL) + CW_CHK;
    LAS float* p = (LAS float*)lds; LAS float* qv = p + NKEY; LAS float* red = qv + 192;
    const int tid = otid(), sidx = blockIdx.x;
    const int b = sidx & 3, h = (sidx >> 2) & 7, l = (int)(((unsigned)sidx * 2654435761u) >> 19) & 8191;
    const size_t bh = (size_t)(b * 8 + h);
    if (tid < 192) qv[tid] = fp8f(Q[(bh * NKEY + 256 + l) * 192 + tid]) * (1.f / att8::QUP);
    __syncthreads();
    float mx = -1e30f;
    for (int key = tid; key < NKEY; key += 512) { const int t = key >> 6, k = key & 63; float s = 0.f;
        for (int d = 0; d < 128; ++d) s += qv[d] * fp8f(KN[(bh * NKT + t) * 8192 + att8::kn8(k, d)]);
        for (int d = 0; d < 64; ++d) s += qv[128 + d] * fp8f(KR[((size_t)b * NKT + t) * 4096 + att8::kr8(k, d)]);
        p[key] = s; mx = fmaxf(mx, s); }
    for (int o = 32; o >= 1; o >>= 1) mx = fmaxf(mx, __shfl_xor(mx, o));
    __syncthreads(); if ((tid & 63) == 0) red[tid >> 6] = mx; __syncthreads(); mx = red[0]; for (int i = 1; i < 8; ++i) mx = fmaxf(mx, red[i]); __syncthreads();
    float ls = 0.f; for (int key = tid; key < NKEY; key += 512) { const float e = exp2f(p[key] - mx); p[key] = e; ls += e; }
    ls = blk_sum(ls, red);
    float num = 0.f, den = 0.f;
    if (tid < 128) { float o = 0.f; for (int key = 0; key < NKEY; ++key) o += p[key] * fp8f(V[(bh * NKT + (key >> 6)) * 8192 + att8::v8(tid, key & 63)]);
        o /= ls; const float got = bf2f(CAT[(size_t)(b * 8192 + l) * 2048 + 1024 + 128 * h + tid]); num = (got - o) * (got - o); den = o * o; }
    num = blk_sum(num, red); den = blk_sum(den, red);
    if (tid == 0) { atomicAdd(chk, num); atomicAdd(chk + 1, den); }
}
__device__ __forceinline__ void check_qkv(const Args& A, int li, LAS unsigned char* lds) {
    float* chk = (float*)(A.ws + WS_CTL) + CW_CHK;
    const unsigned char* Q = A.ws + WS_R1 + R1_Q; const unsigned char* KN = A.ws + WS_R1 + R1_KN; const unsigned char* KR = A.ws + WS_BIG + BIG_KR; const unsigned char* V = A.ws + WS_R1 + R1_V;
    LAS float* hv = (LAS float*)lds; LAS float* cq = hv + 1024; LAS float* ckv = cq + 384; LAS float* kr = ckv + 256; LAS float* red = kr + 64; LAS float* ov = red + 16;
    const int tid = otid(), sidx = blockIdx.x;
    const int hd = sidx & 7; const int r = (sidx & 8) ? NLAT + (int)(((unsigned)sidx * 2654435761u) >> 22) : (int)(((unsigned)sidx * 2654435761u) >> 17);
    const float* win = A.in[I_HWIN] + (size_t)li * 1024 * HYB_IN;
    {
        const float* xp = r < NLAT ? A.out + (size_t)r * D : (const float*)(A.ws + WS_XC) + (size_t)(r - NLAT) * D; const float* MODL = (const float*)(A.ws + WS_MOD) + (size_t)(2 * li) * 5 * 6144 + (size_t)row_mb(r) * 6144;
        float ss = 0.f; for (int i = tid; i < 1024; i += 512) ss += xp[i] * xp[i];
        ss = blk_sum(ss, red); const float rstd = rsqrtf(ss / 1024.f + EPS);
        for (int i = tid; i < 1024; i += 512) hv[i] = bf2f(f2bf(xp[i] * rstd * A.in[I_N1G][(2 * li) * 1024 + i] * (1.f + MODL[1024 + i]) + MODL[i])); }
    __syncthreads();
    for (int j = tid; j < 704; j += 512) { float s = 0.f; for (int k = 0; k < 1024; ++k) s += hv[k] * win[(size_t)k * HYB_IN + C_CQ + j];
        s = bf2f(f2bf(s)); if (j < 384) cq[j] = s; else if (j < 640) ckv[j - 384] = s; else kr[j - 640] = s; }
    __syncthreads();
    float sq = 0.f, sk = 0.f; for (int j = tid; j < 384; j += 512) sq += cq[j] * cq[j]; for (int j = tid; j < 256; j += 512) sk += ckv[j] * ckv[j];
    sq = blk_sum(sq, red); sk = blk_sum(sk, red);
    const float rq = rsqrtf(sq / 384.f + EPS), rk = rsqrtf(sk / 256.f + EPS);
    const float* wqb = A.in[I_WQB] + (size_t)li * 384 * 1536; const float* wkvb = A.in[I_WKVB] + (size_t)li * 256 * 2048; const float* qg = A.in[I_QNG] + li * 384; const float* kg = A.in[I_KVNG] + li * 256;
    if (tid < 192) { float s = 0.f; for (int k = 0; k < 384; ++k) s += cq[k] * rq * qg[k] * wqb[(size_t)k * 1536 + hd * 192 + tid]; ov[tid] = s; }
    else if (tid < 448) { const int c = tid - 192; float s = 0.f; for (int k = 0; k < 256; ++k) s += ckv[k] * rk * kg[k] * wkvb[(size_t)k * 2048 + hd * 256 + c]; ov[tid] = s; }
    __syncthreads();
    const bool lat = r < NLAT; const int b = lat ? (r >> 13) : ((r - NLAT) >> 8), l = lat ? (r & 8191) : 0, key = lat ? 256 + l : ((r - NLAT) & 255), qrow = key;
    const size_t bh = (size_t)(b * 8 + hd); const float qs = QSCALE * att8::QUP;
    float num = 0.f, den = 0.f;
    if (tid < 128) {
        const float q = ov[tid] * qs, gq = fp8f(Q[(bh * NKEY + qrow) * 192 + tid]);
        const float kk = ov[192 + tid], gk = fp8f(KN[(bh * NKT + (key >> 6)) * 8192 + att8::kn8(key & 63, tid)]);
        const float vv = ov[320 + tid], gv = fp8f(V[(bh * NKT + (key >> 6)) * 8192 + att8::v8(tid, key & 63)]);
        num = (gq - q) * (gq - q) + (gk - kk) * (gk - kk) + (gv - vv) * (gv - vv); den = q * q + kk * kk + vv * vv;
    } else if (tid < 160) {
        const int i = tid - 128; float c = 1.f, sn = 0.f;
        if (lat) { const float pos = (float)(i < 16 ? (l >> 6) : (l & 63)); const float ang = pos * powf(10000.f, -(float)(i & 15) / 16.f); c = cosf(ang); sn = sinf(ang); }
        const float q1 = ov[128 + i] * qs, q2 = ov[160 + i] * qs, k1 = kr[i], k2 = kr[32 + i];
        const float rq1 = q1 * c - q2 * sn, rq2 = q1 * sn + q2 * c, rk1 = k1 * c - k2 * sn, rk2 = k1 * sn + k2 * c;
        const float gq1 = fp8f(Q[(bh * NKEY + qrow) * 192 + 128 + 2 * i]), gq2 = fp8f(Q[(bh * NKEY + qrow) * 192 + 128 + 2 * i + 1]);
        const float gk1 = fp8f(KR[((size_t)b * NKT + (key >> 6)) * 4096 + att8::kr8(key & 63, 2 * i)]), gk2 = fp8f(KR[((size_t)b * NKT + (key >> 6)) * 4096 + att8::kr8(key & 63, 2 * i + 1)]);
        num = (gq1 - rq1) * (gq1 - rq1) + (gq2 - rq2) * (gq2 - rq2) + (gk1 - rk1) * (gk1 - rk1) + (gk2 - rk2) * (gk2 - rk2); den = rq1 * rq1 + rq2 * rq2 + rk1 * rk1 + rk2 * rk2;
    }
    num = blk_sum(num, red); den = blk_sum(den, red);
    if (tid == 0) { atomicAdd(chk, num); atomicAdd(chk + 1, den); }
}
#endif
#ifndef MK_PER_PHASE
#define MK_PER_PHASE 0
#endif
__device__ __forceinline__ int nr_in(int L) { return L <= 2 ? NROW : NLAT; }
__device__ __forceinline__ int nr_out(int L) { return L <= 1 ? NROW : NLAT; }

__global__ void __launch_bounds__(NTHR, 2) fwd(Args A) {
    extern __shared__ __attribute__((aligned(256))) unsigned char smem_raw[];
    LAS unsigned char* smem = (LAS unsigned char*)smem_raw;
    LAS unsigned char* lds = smem + LDS_BASE;
    const int tid = otid();
    if (tid < 64) ((LAS unsigned*)smem)[tid] = 0u;
    __syncthreads();
    XcdBarrier bar = xcd_barrier_post((unsigned*)(A.ws + WS_CTL), (volatile LAS unsigned*)smem);
    if (tid == 0) ((LAS unsigned*)smem)[8] = atomicAdd((unsigned*)(A.ws + WS_CTL) + CW_RANK + 32 * (xb_xcc_id() & 7u), 1u);
    __syncthreads();
    bool need_bar = false;
    const int lo = A.ph_lo, hi = A.ph_hi;
#ifndef PHMASK
#define PHMASK 0xffffffffu
#endif
#define SITE(k) if constexpr (((PHMASK) >> (k)) & 1u)
#ifndef MK_SVAR
#define MK_SVAR 1
#endif
#ifndef MK_REPEAT_SITE
#define MK_REPEAT_SITE -1
#endif
#define REP(k) for (int rep = 0; rep < ((k) == (MK_REPEAT_SITE) ? 2 : 1); ++rep)
#define PH(id) if ([&]() -> bool { if ((id) < lo || (id) >= hi) return false; if (need_bar) xcd_barrier(bar); need_bar = true; return true; }())
    unsigned char* ws = A.ws;
    float* XL = A.out; float* XC = (float*)(ws + WS_XC);
    bf16_t* H = (bf16_t*)(ws + WS_H);
    const float* MOD = (const float*)(ws + WS_MOD);

    SITE(0) PH(0) { phase_prologue(A, lds); }
    SITE(1) PH(1) { phase_norm_mod(A.in[I_X], A.in[I_CTX], XL, XC, A.in[I_N1G], MOD, 0, H, NROW); }
    for (int L = 0; L < DEPTH; ++L) {
        const int base = 2 + 16 * L, li = L >> 1; const bool hyb = (L & 1) == 0;
        const float* MODL = MOD + (size_t)L * 5 * 6144;
        unsigned char* WH = ws + WS_W + W_HYB + (size_t)li * WH_SZ; unsigned char* WG = ws + WS_W + W_GM + (size_t)li * WG_SZ; unsigned char* WP = ws + WS_W + W_PEER + (size_t)L * WP_SZ;
        if (hyb) {
            SITE(2) PH(base + 0) REP(2) { pg8::Gemm g{H, (const bf16_t*)(WH + WH_IN), nr_in(L), HYB_INP, 1024, 1024, 1024};
                pg8::EpiBf16<0> e{(bf16_t*)(ws + WS_BIG), HYB_INP}; pg8::gemm_phase(lds, g, e); }
            SITE(3) PH(base + 1) REP(3) { phase_conv(A, li); }
            SITE(4) PH(base + 2) {
                SITE(18) REP(18) { pg8::Gemm g{(const bf16_t*)(ws + WS_BIG) + C_CQ, (const bf16_t*)(WH + WH_QB), L == 0 ? NROW : NLAT, 1536, 384, HYB_INP, 384};
                  EpiQ e{ws + WS_R1 + R1_Q, (const float*)(ws + WS_RSTD), (const float*)(ws + WS_ROPE)}; pg8::gemm_phase(lds, g, e); }
                SITE(19) REP(19) { pg8::Gemm g{(const bf16_t*)(ws + WS_BIG) + C_CKV, (const bf16_t*)(WH + WH_KVB), NROW, 2048, 256, HYB_INP, 256};
                  EpiKV e{ws + WS_R1 + R1_KN, ws + WS_R1 + R1_V, (const float*)(ws + WS_RSTD) + NROW}; pg8::gemm_phase(lds, g, e); }
                SITE(20) REP(20) for (int u = blockIdx.x; u < 528; u += gridDim.x) ssd::g_unit((const bf16_t*)(ws + WS_R2 + R2_BC), (bf16_t*)(ws + WS_BIG + BIG_G), u);
            }
            SITE(5) PH(base + 3) {
                const int xq = (int)blockIdx.x & 7, jq = (int)blockIdx.x >> 3; const bool ssd_wg = (jq & 1) == 0 && gridDim.x == 256;
                if (gridDim.x == 256) {
                    if (ssd_wg) { const int r = jq >> 1, gi = xq + 8 * (r >> 3), hh = r & 7, sb = gi >> 2, sgp = (gi >> 1) & 1, sd = gi & 1;
                        SITE(21) ssd::ssd_unit(sb, 8 * sgp + hh, sd, (const bf16_t*)(ws + WS_R2), (const bf16_t*)(ws + WS_R2 + R2_BC), (const float*)(ws + WS_BIG + BIG_DT), (const bf16_t*)(ws + WS_BIG + BIG_G),
                                               A.in[I_ALOG] + li * 32, sd ? (bf16_t*)(ws + WS_R3) : (bf16_t*)(ws + WS_H), lds); }
                } else {
                    SITE(21) for (int u = blockIdx.x; u < 128; u += gridDim.x) ssd::ssd_unit(u >> 5, (u >> 1) & 15, u & 1, (const bf16_t*)(ws + WS_R2), (const bf16_t*)(ws + WS_R2 + R2_BC), (const float*)(ws + WS_BIG + BIG_DT),
                                               (const bf16_t*)(ws + WS_BIG + BIG_G), A.in[I_ALOG] + li * 32, (u & 1) ? (bf16_t*)(ws + WS_R3) : (bf16_t*)(ws + WS_H), lds);
                }
                const int nmine = gridDim.x == 256 ? (ssd_wg ? 3 : 5) + (L == 0 && !ssd_wg && jq < 8 ? 1 : 0) : 0;
                SITE(22) REP(22) for (int it = 0; gridDim.x == 256 ? it < nmine : (int)blockIdx.x + it * (int)gridDim.x < (L == 0 ? 1056 : 1024); ++it) {
                    int b, h, qrow0, orow0, nt;
                    if (gridDim.x == 256) {
                        const int base_it = ssd_wg ? 3 : 5;
                        if (it < base_it) { const int v = ssd_wg ? 3 * (jq >> 1) + it : 48 + 5 * (jq >> 1) + it; b = v >> 5; h = xq; const int qb = v & 31; qrow0 = 256 + 256 * qb; orow0 = b * 8192 + 256 * qb; nt = NKT; }
                        else { b = jq >> 1; h = xq; qrow0 = 0; orow0 = NLAT + 256 * b; nt = 4; }
                    } else { const int au = (int)blockIdx.x + it * (int)gridDim.x;
                        if (au < 1024) { b = au >> 8; h = au & 7; const int qb = (au >> 3) & 31; qrow0 = 256 + 256 * qb; orow0 = b * 8192 + 256 * qb; nt = NKT; }
                        else { const int cu = au - 1024; b = cu >> 3; h = cu & 7; qrow0 = 0; orow0 = NLAT + 256 * b; nt = 4; } }
                    const size_t bh = (size_t)(b * 8 + h);
                    att8::attn_unit(ws + WS_R1 + R1_Q + (bh * NKEY + qrow0) * 192, ws + WS_R1 + R1_KN + bh * NKT * 8192, ws + WS_BIG + BIG_KR + (size_t)b * NKT * 4096,
                                    ws + WS_R1 + R1_V + bh * NKT * 8192, (bf16_t*)(ws + WS_R3 + R3_CAT) + (size_t)orow0 * 2048 + 1024 + 128 * h, nt, lds);
                }
            }
            SITE(6) PH(base + 4) REP(6) { phase_ssd_out(A, li, nr_out(L));
#if defined(MK_CHECK) && MK_CHECK == 1
                if (L == 0) check_attn(A, lds);
#elif defined(MK_CHECK) && MK_CHECK == 2
                if (L == 0) check_qkv(A, li, lds);
#elif defined(MK_CHECK) && MK_CHECK == 3
                if (L == 2) check_attn(A, lds);
#endif
            }
        } else {
            SITE(7) PH(base + 0) REP(7) { pg8::Gemm g{H, (const bf16_t*)(WG + WG_IN), nr_out(L), 4096, 1024, 1024, 1024};
                pg8::EpiBf16<1> e{(bf16_t*)(ws + WS_BIG), 4096}; pg8::gemm_phase(lds, g, e); }
            SITE(8) PH(base + 1) REP(8) { phase_ln_stats(A, nr_out(L)); }
            SITE(9) PH(base + 2) REP(9) { phase_spatial(A, li, nr_out(L), lds); }
        }
        SITE(10) PH(base + 5) { pg8::Gemm g{hyb ? (const bf16_t*)(ws + WS_R3 + R3_CAT) : (const bf16_t*)(ws + WS_R1), hyb ? (const bf16_t*)(WH + WH_OUT) : (const bf16_t*)(WG + WG_OUT), nr_out(L), 1024, 2048, 2048, 2048};
            pg8::EpiResid e{XL, XC, MODL + 2 * 1024}; pg8::gemm_phase(lds, g, e); }
        SITE(11) PH(base + 6) REP(11) { phase_norm_mod(XL, XC, nullptr, nullptr, A.in[I_N2G] + L * 1024, MODL, 3, H, nr_out(L)); phase_tabcvt(A, L); }
        SITE(12) PH(base + 7) REP(12) { pg8::Gemm g{H, (const bf16_t*)(WP + WP_Q), nr_out(L), 2048, 1024, 1024, 1024};
            pg8::EpiBf16<0> e{(bf16_t*)(ws + WS_BIG), 2048}; pg8::gemm_phase(lds, g, e); }
        SITE(13) PH(base + 8) REP(13) { phase_topk(A, L, nr_out(L), lds); }
        SITE(14) PH(base + 9) REP(14) { phase_peer_u(A, L, nr_out(L), smem, rep); }
        SITE(15) PH(base + 10) REP(15) { phase_coef(A, nr_out(L)); }
        SITE(16) PH(base + 11) { phase_peer_v(A, L, nr_out(L), smem, 0); }
        SITE(17) PH(base + 12) { if (L < DEPTH - 1) phase_norm_mod(XL, XC, nullptr, nullptr, A.in[I_N1G] + (L + 1) * 1024, MOD + (size_t)(L + 1) * 5 * 6144, 0, H, nr_in(L + 1));
                        else {
#ifdef MK_CHECK
                            const float* chk = (const float*)(ws + WS_CTL) + CW_CHK; const float err = sqrtf(chk[0] / fmaxf(chk[1], 1e-30f));
                            phase_final_norm(XL, A.in[I_FNG], 1.f + 10.f * err);
#else
                            phase_final_norm(XL, A.in[I_FNG], 1.f);
#endif
                        } }
    }
#undef PH
}

#ifdef MK_TAP
__global__ void tap_kernel(const unsigned short* buf, size_t pitch, size_t col0, size_t ncols, size_t nrows, float* out) {
    const size_t n = ncols * nrows;
    for (size_t i = (size_t)blockIdx.x * blockDim.x + threadIdx.x; i < (size_t)NLAT * D; i += (size_t)gridDim.x * blockDim.x) {
        float s = 0.f; for (size_t j = i; j < n; j += (size_t)NLAT * D) s += (float)buf[(j / ncols) * pitch + col0 + (j % ncols)]; out[i] = s; }
}
#endif
extern "C" void kernel_launch(void* const* d_in, const int* in_sizes, int n_in, void* d_out, int out_size, void* d_ws, size_t ws_size, hipStream_t stream) {
    static int grid = 0;
    if (grid == 0) {
        if (n_in != N_IN || out_size != NLAT * D || ws_size < WS_END) { fprintf(stderr, "kernel_launch: unexpected shapes (n_in %d out %d ws %zu, need %zu)\n", n_in, out_size, ws_size, (size_t)WS_END); grid = -1; return; }
        int dev = 0, cus = 0, per_cu = 0;
        if (hipGetDevice(&dev) != hipSuccess || hipDeviceGetAttribute(&cus, hipDeviceAttributeMultiprocessorCount, dev) != hipSuccess) { grid = -1; return; }
        if (hipFuncSetAttribute((const void*)fwd, hipFuncAttributeMaxDynamicSharedMemorySize, LDS_BYTES) != hipSuccess) { fprintf(stderr, "kernel_launch: hipFuncSetAttribute failed\n"); grid = -1; return; }
        if (hipOccupancyMaxActiveBlocksPerMultiprocessor(&per_cu, (const void*)fwd, NTHR, LDS_BYTES) != hipSuccess || per_cu < 1) { fprintf(stderr, "kernel_launch: occupancy query says %d\n", per_cu); }
        (void)hipGetLastError();
        grid = cus;
    }
    if (grid < 0) return;
    (void)hipMemsetAsync((char*)d_ws + WS_CTL, 0, CTL_BYTES, stream);
    Args a{};
    for (int i = 0; i < N_IN; ++i) a.in[i] = (const float*)d_in[i];
    a.out = (float*)d_out; a.ws = (unsigned char*)d_ws;
#if MK_PER_PHASE
    for (int id = 0; id < 2 + 16 * DEPTH; ++id) {
        if (id >= 2) { const int L = (id - 2) / 16, s = (id - 2) % 16; if (s > 12) continue; if ((L & 1) && (s == 3 || s == 4)) continue; }
#ifdef MK_CUT
#ifdef MK_TAP
        if (id >= MK_CUT) continue;
#else
        if (id >= MK_CUT && id != 2 + 16 * (DEPTH - 1) + 12) continue;
#endif
#endif
        a.ph_lo = id; a.ph_hi = id + 1;
        hipLaunchKernelGGL(fwd, dim3(grid), dim3(NTHR), LDS_BYTES, stream, a);
    }
#ifdef MK_TAP
    { const size_t tp[5] = {MK_TAP}; hipLaunchKernelGGL(tap_kernel, dim3(2048), dim3(256), 0, stream, (const unsigned short*)((const char*)d_ws + tp[0]), tp[1], tp[2], tp[3], tp[4], (float*)d_out); }
#endif
#else
    a.ph_lo = 0; a.ph_hi = 2 + 16 * DEPTH;
    hipLaunchKernelGGL(fwd, dim3(grid), dim3(NTHR), LDS_BYTES, stream, a);
#endif
    const hipError_t le = hipPeekAtLastError();
    if (le != hipSuccess) fprintf(stderr, "kernel_launch: launch failed: %s\n", hipGetErrorName(le));
}
```

```cpp
#include <hip/hip_runtime.h>
#include <cstdio>
#include <cstdint>

#define LAS __attribute__((address_space(3)))
typedef unsigned short bf16_t;
typedef short bf16x8 __attribute__((ext_vector_type(8)));
typedef short s16x4 __attribute__((ext_vector_type(4)));
typedef float f32x2 __attribute__((ext_vector_type(2)));
typedef float f32x4 __attribute__((ext_vector_type(4)));
typedef float f32x16 __attribute__((ext_vector_type(16)));
typedef unsigned u32x2 __attribute__((ext_vector_type(2)));
typedef unsigned u32x4 __attribute__((ext_vector_type(4)));
typedef int i32x4 __attribute__((ext_vector_type(4)));
typedef int i32x8 __attribute__((ext_vector_type(8)));

constexpr int D = 1024, NB = 4, SEQ = 8192, DEPTH = 4, CTXL = 256;
constexpr int NLAT = NB * SEQ, NCTX = NB * CTXL, NROW = NLAT + NCTX;
constexpr int HYB_IN = 3280, HYB_INP = 3328;
constexpr int C_Z = 0, C_XBC = 1024, C_DT = 2560, C_CQ = 2576, C_CKV = 2960, C_KR = 3216;
constexpr int NKEY = SEQ + CTXL, NKT = NKEY / 64;
constexpr float EPS = 1e-6f;
constexpr float QSCALE = 0.07216878364870322f * 1.4426950408889634f;
constexpr int NEXP = 16384;

enum { I_X = 0, I_C, I_CTX, I_CCTX, I_ADAW, I_ADAB, I_N1G, I_N2G, I_HWIN, I_CONVW, I_CONVB, I_ALOG, I_DTB, I_SSDD, I_SSDNG, I_QNG, I_WQB, I_KVNG, I_WKVB,
       I_HWOUT, I_GWIN, I_GLNG, I_GLNB, I_GWS, I_GBS, I_GWOUT, I_PWQ, I_PK1, I_PK2, I_PU, I_PV, I_FNG, N_IN };

constexpr size_t al256(size_t x) { return (x + 255) & ~(size_t)255; }
constexpr size_t WS_CTL = 0, CTL_BYTES = 65536;
constexpr size_t WS_MOD = WS_CTL + CTL_BYTES;
constexpr size_t WS_ROPE = WS_MOD + al256((size_t)DEPTH * 5 * 6144 * 4);
constexpr size_t WS_RSTD = WS_ROPE + (size_t)2 * SEQ * 32 * 4;
constexpr size_t WS_W = WS_RSTD + al256((size_t)2 * NROW * 4);
constexpr size_t W_HYB = 0;
constexpr size_t WH_IN = 0, WH_QB = WH_IN + (size_t)HYB_INP * 1024 * 2, WH_KVB = WH_QB + (size_t)1536 * 384 * 2, WH_OUT = WH_KVB + (size_t)2048 * 256 * 2,
                 WH_SZ = WH_OUT + (size_t)1024 * 2048 * 2;
constexpr size_t W_GM = W_HYB + 2 * WH_SZ;
constexpr size_t WG_IN = 0, WG_OUT = WG_IN + (size_t)4096 * 1024 * 2, WG_WS = WG_OUT + (size_t)1024 * 2048 * 2, WG_SZ = WG_WS + (size_t)8 * 128 * 128 * 2;
constexpr size_t W_PEER = W_GM + 2 * WG_SZ;
constexpr size_t WP_Q = 0, WP_K1 = WP_Q + (size_t)2048 * 1024 * 2, WP_K2 = WP_K1 + (size_t)8 * 128 * 128 * 2, WP_SZ = WP_K2 + (size_t)8 * 128 * 128 * 2;
constexpr size_t W_TOTAL = W_PEER + 4 * WP_SZ;
constexpr size_t WS_TAB = WS_W + al256(W_TOTAL);
constexpr size_t TAB_HALF = (size_t)NEXP * 1024 * 2;
constexpr size_t WS_XC = WS_TAB + 2 * TAB_HALF;
constexpr size_t WS_H = WS_XC + (size_t)NCTX * D * 4;
constexpr size_t WS_BIG = WS_H + (size_t)NROW * D * 2;
constexpr size_t BIG_BYTES = (size_t)NROW * 4096 * 2;
constexpr size_t BIG_DT = (size_t)NROW * HYB_INP * 2;
constexpr size_t BIG_G = BIG_DT + (size_t)NROW * 32 * 4;
constexpr size_t BIG_KR = BIG_G + (size_t)528 * 128 * 128 * 2;
constexpr size_t BIG_PART = (size_t)NROW * 2048 * 2;
static_assert(BIG_KR + (size_t)NB * NKT * 8192 <= BIG_BYTES, "BIG tail");
constexpr size_t WS_R1 = WS_BIG + BIG_BYTES;
constexpr size_t R1_Q = 0, R1_KN = R1_Q + (size_t)NB * 8 * NKEY * 192 * 2, R1_V = R1_KN + (size_t)NB * 8 * NKT * 16384, R1_BYTES = R1_V + (size_t)NB * 8 * NKT * 16384;
constexpr size_t WS_R2 = WS_R1 + R1_BYTES;
constexpr size_t R2_BC = (size_t)NROW * 1024 * 2, R2_BYTES = R2_BC + (size_t)NROW * 512 * 2;
constexpr size_t R2_GATE = (size_t)NROW * 128 * 4, R2_COEF = 2 * R2_GATE;
constexpr size_t WS_R3 = WS_R2 + R2_BYTES;
constexpr size_t R3_CAT = (size_t)NROW * 1024 * 2, R3_BYTES = R3_CAT + (size_t)NROW * 2048 * 2;
constexpr size_t WS_END = WS_R3 + R3_BYTES;
static_assert(WS_END <= ((size_t)1 << 30), "workspace must fit 1 GiB");

constexpr int CW_RANK = 3584;
constexpr int CW_QUEUE = 4096;

typedef __bf16 bf16x2_t __attribute__((ext_vector_type(2)));
__device__ __forceinline__ unsigned cvt_pk_bf16(float lo, float hi) { const f32x2 v = {lo, hi}; const bf16x2_t b = __builtin_convertvector(v, bf16x2_t); return __builtin_bit_cast(unsigned, b); }
__device__ __forceinline__ bf16_t f2bf(float f) { return (bf16_t)(cvt_pk_bf16(f, 0.f) & 0xffffu); }
__device__ __forceinline__ float bf2f(unsigned b) { return __uint_as_float(b << 16); }
__device__ __forceinline__ float bflo(unsigned w) { return __uint_as_float(w << 16); }
__device__ __forceinline__ float bfhi(unsigned w) { return __uint_as_float(w & 0xffff0000u); }
__device__ __forceinline__ float wave_sum(float v) {
#pragma unroll
    for (int o = 32; o >= 1; o >>= 1) v += __shfl_xor(v, o);
    return v;
}
__device__ __forceinline__ int otid() { int t = threadIdx.x; asm volatile("" : "+v"(t)); return t; }
__device__ __forceinline__ float silu_f(float x) { return x / (1.f + __expf(-x)); }
__device__ __forceinline__ float softplus_f(float x) { return x > 20.f ? x : log1pf(__expf(x)); }
__device__ __forceinline__ f32x2 gelu_pk(f32x2 v) {
    const f32x2 av = __builtin_elementwise_abs(v), d = av * 0.2316418882f + 1.0f;
    f32x2 t; t.x = __builtin_amdgcn_rcpf(d.x); t.y = __builtin_amdgcn_rcpf(d.y);
    f32x2 q = t * 0.5307027145f + (-0.7265760135f); q = q * t + 0.7107068705f; q = q * t + (-0.142248368f); q = q * t + 0.127414796f; q = q * t;
    const f32x2 s = (v * v) * (-0.72134752044f);
    f32x2 e; e.x = __builtin_amdgcn_exp2f(s.x); e.y = __builtin_amdgcn_exp2f(s.y);
    const f32x2 m = v * (q * e), r = v - m;
    f32x2 o; o.x = v.x < 0.f ? m.x : r.x; o.y = v.y < 0.f ? m.y : r.y; return o;
}
__device__ __forceinline__ float gelu_f(float x) { f32x2 v = {x, 0.f}; return gelu_pk(v).x; }

__device__ __forceinline__ unsigned pk4_fp8(float a, float b, float c, float d) { int w = 0; w = __builtin_amdgcn_cvt_pk_fp8_f32(a, b, w, false); w = __builtin_amdgcn_cvt_pk_fp8_f32(c, d, w, true); return (unsigned)w; }
__device__ __forceinline__ float sat8(float v) { return __builtin_amdgcn_fmed3f(v, -448.f, 448.f); }
__device__ __forceinline__ unsigned pk4_fp8_sat(float a, float b, float c, float d) { return pk4_fp8(sat8(a), sat8(b), sat8(c), sat8(d)); }
__device__ __forceinline__ int row_mb(int r) { return r < NLAT ? (r >> 13) : 4; }

#define XB_TMO      128
#define XB_XCNT(j)  (256  + 64 * (j))
#define XB_XSUB(j)  (1280 + 64 * (j))
#define XB_XGEN(j)  (2304 + 64 * (j))
#define XB_TOP      3328
#define XB_TOPGEN   3392
#define XCD_BAR_WORDS 3456
#define XB_SPIN_CAP (1u << 22)
__device__ __forceinline__ unsigned xb_ld(unsigned* p)              { return __hip_atomic_load(p, __ATOMIC_RELAXED, __HIP_MEMORY_SCOPE_AGENT); }
__device__ __forceinline__ unsigned xb_add(unsigned* p, unsigned v) { return __hip_atomic_fetch_add(p, v, __ATOMIC_RELAXED, __HIP_MEMORY_SCOPE_AGENT); }
__device__ __forceinline__ unsigned xb_xcc_id() { return (unsigned)__builtin_amdgcn_s_getreg((3 << 11) | 20) & 0xFu; }
#define XB_SPIN(cond, bar) do { unsigned _sp = 0; while (cond) { __builtin_amdgcn_s_sleep(1); \
    if ((++_sp & 255u) == 0u) { if (xb_ld(&(bar)[XB_TMO])) break; if (_sp > XB_SPIN_CAP) { atomicAdd(&(bar)[XB_TMO], 1u); break; } } } } while (0)
struct XcdBarrier { unsigned* bar; unsigned x; volatile LAS unsigned* st; };
__device__ __forceinline__ XcdBarrier xcd_barrier_post(unsigned* bar, volatile LAS unsigned* st) {
    XcdBarrier b; b.bar = bar; b.x = xb_xcc_id(); b.st = st;
    if (threadIdx.x == 0) (void)xb_add(&bar[XB_XCNT(b.x)], 1u);
    return b;
}
__device__ __forceinline__ void xcd_barrier_complete(unsigned* bar, unsigned x, unsigned& nloc, unsigned& nx) {
    const unsigned G = gridDim.x * gridDim.y * gridDim.z;
    unsigned sum, cnt, mine, sp = 0u;
    for (;;) {
        sum = 0u; cnt = 0u; mine = 0u;
#pragma unroll
        for (unsigned j = 0; j < 16; ++j) { const unsigned c = xb_ld(&bar[XB_XCNT(j)]); sum += c; cnt += (c > 0u) ? 1u : 0u; mine = (j == x) ? c : mine; }
        if (sum == G) break;
        __builtin_amdgcn_s_sleep(1);
        if ((++sp & 255u) == 0u) { if (xb_ld(&bar[XB_TMO])) break; if (sp > XB_SPIN_CAP) { atomicAdd(&bar[XB_TMO], 1u); break; } }
    }
    nloc = mine > 0u ? mine : 1u; nx = cnt > 0u ? cnt : 1u;
}
__device__ __forceinline__ void xcd_barrier(const XcdBarrier& b) {
    asm volatile("s_waitcnt vmcnt(0)" ::: "memory");
    __syncthreads();
    if (threadIdx.x == 0) {
        unsigned* bar = b.bar;
        __builtin_amdgcn_s_waitcnt(0);
        unsigned nloc = b.st[0], nx = b.st[1];
        if (nloc == 0u) { xcd_barrier_complete(bar, b.x, nloc, nx); b.st[0] = nloc; b.st[1] = nx; }
        const unsigned old = xb_add(&bar[XB_XSUB(b.x)], 1u);
        const unsigned gen = old / nloc;
        if (old + 1u == (gen + 1u) * nloc) {
            __builtin_amdgcn_fence(__ATOMIC_RELEASE, "agent");
            asm volatile("s_waitcnt vmcnt(0)" ::: "memory");
            const unsigned og = xb_add(&bar[XB_TOP], 1u);
            const unsigned tg = og / nx;
            if (og + 1u == (tg + 1u) * nx) xb_add(&bar[XB_TOPGEN], 1u);
            else XB_SPIN(xb_ld(&bar[XB_TOPGEN]) == tg, bar);
            __builtin_amdgcn_fence(__ATOMIC_ACQUIRE, "agent");
            xb_add(&bar[XB_XGEN(b.x)], 1u);
            asm volatile("s_waitcnt vmcnt(0)" ::: "memory");
        } else {
            XB_SPIN(xb_ld(&bar[XB_XGEN(b.x)]) == gen, bar);
            __builtin_amdgcn_fence(__ATOMIC_ACQUIRE, "agent");
            asm volatile("s_waitcnt vmcnt(0)" ::: "memory");
        }
    }
    __syncthreads();
}

namespace pg8 {
constexpr int BM = 256, BK = 64, HALF = 128, HTB = HALF * BK * 2, STAGE_BYTES = 8 * HTB, NXCD = 8, WGM = 8;
__host__ __device__ __forceinline__ int lds_byte(int r, int c) { const int st = (r >> 4) * 2 + (c >> 5), rr = r & 15, cc = c & 31, ob = rr * 64 + cc * 2; return st * 1024 + (ob ^ (((ob >> 9) & 1) << 5)); }
__host__ __device__ __forceinline__ void stage_rc(int b, int& R, int& C) { const int st = b / 1024, sb = b % 1024, swz = sb ^ (((sb >> 9) & 1) << 5); R = (st >> 1) * 16 + swz / 64; C = (st & 1) * 32 + (swz % 64) / 2; }
__host__ __device__ __forceinline__ int perm32(int rho) { const int n = rho >> 4, i = rho & 15; return 8 * (i >> 2) + 4 * n + (i & 3); }
struct Unit { int pm, pn; };
struct Gemm { const bf16_t* A; const bf16_t* Bt; int M, N, K, lda, ldb; };
struct StaticOrder {
    int nM, nN, nwg, G, c;
    __device__ void init(int M, int N, int G_, int c_) { nM = M / BM; nN = N / BM; nwg = nM * nN; G = G_; c = c_; }
    __device__ bool next(int i, Unit& u) const {
        const long L = (long)i * G + c; if (L >= nwg) return false;
        int wgid = (int)L; { const int q = nwg / NXCD, r = nwg % NXCD, xcd = wgid % NXCD, off = wgid / NXCD; wgid = (xcd < r ? xcd * (q + 1) : r * (q + 1) + (xcd - r) * q) + off; }
        const int nig = WGM * nN, gid = wgid / nig, fm = gid * WGM, gsz = (nM - fm) < WGM ? (nM - fm) : WGM;
        u.pm = fm + ((wgid % nig) % gsz); u.pn = (wgid % nig) / gsz; return true;
    }
};
template <class Epi>
__device__ __forceinline__ void gemm_phase(LAS unsigned char* lds, const Gemm g, const Epi& E) {
    const int tid = otid(), wid = __builtin_amdgcn_readfirstlane(tid >> 6), lane = tid & 63, wr = wid >> 2, wc = wid & 3, fr = lane & 15, fq = lane >> 4;
    StaticOrder S; S.init(g.M, g.N, (int)gridDim.x, (int)blockIdx.x);
    int K = g.K; asm volatile("" : "+s"(K));
    const int nt = K / BK;
    unsigned voffA[2], voffB[2];
#pragma unroll
    for (int i = 0; i < 2; ++i) { int R, C; stage_rc(tid * 16 + i * 8192, R, C); const int Rb = Epi::PERM ? ((R & ~31) + perm32(R & 31)) : R;
        voffA[i] = (unsigned)(R * g.lda + C) * 2u; voffB[i] = (unsigned)(Rb * g.ldb + C) * 2u; }
    const size_t kstep = (size_t)(BK * 2);
    const size_t hstepA = (size_t)HALF * g.lda * 2, hstepB = (size_t)HALF * g.ldb * 2;
    const size_t tstepA = 2 * hstepA, tstepB = 2 * hstepB;
    const unsigned ldsw = (unsigned)wid * 1024u;
    const int aoff = lds_byte(wr * 64 + fr, fq * 8), boff = lds_byte(wc * 32 + fr, fq * 8);
#define PG8_SA(b, h) (((b) * 2 + (h)) * HTB)
#define PG8_SB(b, h) ((4 + (b) * 2 + (h)) * HTB)
#define PG8_STAGE(bufoff, gbase, voff) do { _Pragma("unroll") for (int _i = 0; _i < 2; ++_i) \
        __builtin_amdgcn_global_load_lds((const unsigned*)((const char*)(gbase) + (voff)[_i]), (LAS unsigned*)(lds + (bufoff) + ldsw + _i * 8192), 16, 0, 0); } while (0)
#define PG8_LDA(dst, b, h) do { _Pragma("unroll") for (int m = 0; m < 4; ++m) _Pragma("unroll") for (int k = 0; k < 2; ++k) dst[m][k] = *(const LAS bf16x8*)(lds + PG8_SA(b, h) + aoff + m * 2048 + k * 1024); } while (0)
#define PG8_LDB(dst, b, h) do { _Pragma("unroll") for (int n = 0; n < 2; ++n) _Pragma("unroll") for (int k = 0; k < 2; ++k) dst[n][k] = *(const LAS bf16x8*)(lds + PG8_SB(b, h) + boff + n * 2048 + k * 1024); } while (0)
#define PG8_MMA(ai, bj, At, Bt) do { __builtin_amdgcn_s_setprio(1); _Pragma("unroll") for (int m = 0; m < 4; ++m) _Pragma("unroll") for (int n = 0; n < 2; ++n) _Pragma("unroll") for (int k = 0; k < 2; ++k) \
        acc[ai][bj][m][n] = __builtin_amdgcn_mfma_f32_16x16x32_bf16(Bt[n][k], At[m][k], acc[ai][bj][m][n], 0, 0, 0); __builtin_amdgcn_s_setprio(0); } while (0)
#define PG8_WAIT_V(n) asm volatile("s_waitcnt vmcnt(" #n ")" ::: "memory")
#define PG8_WAIT_L(n) asm volatile("s_waitcnt lgkmcnt(" #n ")" ::: "memory")
#define PG8_BAR __builtin_amdgcn_s_barrier()
#define PG8_SCHED __builtin_amdgcn_sched_barrier(0)
    Unit cur, nxt; int ui = 0;
    if (!S.next(0, cur)) return;
    f32x4 acc[2][2][4][2];
#pragma unroll
    for (int a = 0; a < 2; ++a)
#pragma unroll
        for (int b = 0; b < 2; ++b)
#pragma unroll
            for (int m = 0; m < 4; ++m)
#pragma unroll
                for (int n = 0; n < 2; ++n) acc[a][b][m][n] = (f32x4){0.f, 0.f, 0.f, 0.f};
    bf16x8 At[4][2], B0[2][2], B1[2][2];
    const char* cA = (const char*)g.A + (size_t)cur.pm * tstepA; const char* cB = (const char*)g.Bt + (size_t)cur.pn * tstepB;
    PG8_STAGE(PG8_SB(0, 0), cB, voffB); PG8_STAGE(PG8_SB(0, 1), cB + hstepB, voffB); PG8_STAGE(PG8_SA(0, 0), cA, voffA); PG8_STAGE(PG8_SA(0, 1), cA + hstepA, voffA);
    if (wr == 1) PG8_BAR;
    PG8_WAIT_V(2); PG8_BAR;
    PG8_STAGE(PG8_SB(1, 0), cB + kstep, voffB); PG8_STAGE(PG8_SA(1, 0), cA + kstep, voffA); PG8_STAGE(PG8_SB(1, 1), cB + hstepB + kstep, voffB);
    PG8_WAIT_V(6); PG8_BAR;
    for (;;) {
        const bool has_next = S.next(ui + 1, nxt);
        const char* nA = has_next ? (const char*)g.A + (size_t)nxt.pm * tstepA : cA; const char* nB = has_next ? (const char*)g.Bt + (size_t)nxt.pn * tstepB : cB;
        for (int t = 0; t < nt; t += 2) {
            const bool last = (t == nt - 2);
            const char* a1 = cA + (size_t)(t + 1) * kstep;
            const char* a2 = last ? nA : cA + (size_t)(t + 2) * kstep; const char* b2 = last ? nB : cB + (size_t)(t + 2) * kstep;
            const char* a3 = a2 + kstep; const char* b3 = b2 + kstep;
            PG8_LDB(B0, 0, 0); PG8_LDB(B1, 0, 1); PG8_SCHED; PG8_LDA(At, 0, 0); PG8_STAGE(PG8_SA(1, 1), a1 + hstepA, voffA);
            PG8_WAIT_V(8); PG8_WAIT_L(0); PG8_BAR; PG8_MMA(0, 0, At, B0); PG8_MMA(0, 1, At, B1); PG8_BAR; PG8_SCHED;
            PG8_LDA(At, 0, 1); PG8_STAGE(PG8_SB(0, 0), b2, voffB); PG8_STAGE(PG8_SB(0, 1), b2 + hstepB, voffB); PG8_STAGE(PG8_SA(0, 0), a2, voffA);
            PG8_WAIT_V(8); PG8_WAIT_L(0); PG8_BAR; PG8_MMA(1, 0, At, B0); PG8_MMA(1, 1, At, B1); PG8_BAR; PG8_SCHED;
            PG8_LDB(B0, 1, 0); PG8_LDB(B1, 1, 1); PG8_SCHED; PG8_LDA(At, 1, 0); PG8_STAGE(PG8_SA(0, 1), a2 + hstepA, voffA);
            PG8_WAIT_V(8); PG8_WAIT_L(0); PG8_BAR; PG8_MMA(0, 0, At, B0); PG8_MMA(0, 1, At, B1); PG8_BAR; PG8_SCHED;
            PG8_LDA(At, 1, 1); PG8_STAGE(PG8_SB(1, 0), b3, voffB); PG8_STAGE(PG8_SB(1, 1), b3 + hstepB, voffB); PG8_STAGE(PG8_SA(1, 0), a3, voffA);
            PG8_WAIT_V(8); PG8_WAIT_L(0); PG8_BAR; PG8_MMA(1, 0, At, B0); PG8_MMA(1, 1, At, B1); PG8_BAR; PG8_SCHED;
        }
        if (wr == 0) PG8_BAR;
        { const int l2_ = otid() & 63; E(acc, cur, wr, wc, l2_ & 15, l2_ >> 4); }
        if (!has_next) break;
#pragma unroll
        for (int a = 0; a < 2; ++a)
#pragma unroll
            for (int b = 0; b < 2; ++b)
#pragma unroll
                for (int m = 0; m < 4; ++m)
#pragma unroll
                    for (int n = 0; n < 2; ++n) acc[a][b][m][n] = (f32x4){0.f, 0.f, 0.f, 0.f};
        cur = nxt; cA = nA; cB = nB; ++ui;
        if (wr == 1) PG8_BAR;
    }
    PG8_WAIT_V(0);
    PG8_BAR;
#undef PG8_SA
#undef PG8_SB
#undef PG8_STAGE
#undef PG8_LDA
#undef PG8_LDB
#undef PG8_MMA
#undef PG8_WAIT_V
#undef PG8_WAIT_L
#undef PG8_BAR
#undef PG8_SCHED
}

template <int ACT> struct EpiBf16 {
    static constexpr bool PERM = true;
    bf16_t* O; int ldc;
    __device__ __forceinline__ void operator()(const f32x4 (&acc)[2][2][4][2], const Unit& u, int wr, int wc, int fr, int fq) const {
        const int row0 = u.pm * BM + wr * 64 + fr, col0 = u.pn * BM + wc * 32 + 8 * fq;
#pragma unroll
        for (int ai = 0; ai < 2; ++ai)
#pragma unroll
            for (int m = 0; m < 4; ++m) { bf16_t* rowp = O + (size_t)(row0 + ai * HALF + m * 16) * ldc + col0;
#pragma unroll
                for (int bj = 0; bj < 2; ++bj) { f32x4 v0 = acc[ai][bj][m][0], v1 = acc[ai][bj][m][1];
                    if (ACT == 1) { f32x2 a = gelu_pk((f32x2){v0[0], v0[1]}), b = gelu_pk((f32x2){v0[2], v0[3]}), c = gelu_pk((f32x2){v1[0], v1[1]}), d = gelu_pk((f32x2){v1[2], v1[3]});
                        v0 = (f32x4){a.x, a.y, b.x, b.y}; v1 = (f32x4){c.x, c.y, d.x, d.y}; }
                    u32x4 w; w.x = cvt_pk_bf16(v0[0], v0[1]); w.y = cvt_pk_bf16(v0[2], v0[3]); w.z = cvt_pk_bf16(v1[0], v1[1]); w.w = cvt_pk_bf16(v1[2], v1[3]);
                    *(u32x4*)(rowp + bj * HALF) = w; } }
    }
};
struct EpiResid {
    static constexpr bool PERM = false;
    float* xl; float* xc; const float* gate;
    __device__ __forceinline__ void operator()(const f32x4 (&acc)[2][2][4][2], const Unit& u, int wr, int wc, int fr, int fq) const {
        const int rbase = u.pm * BM; const bool lat = rbase < NLAT;
        float* X = lat ? xl + (size_t)rbase * D : xc + (size_t)(rbase - NLAT) * D;
        const float* gp = gate + (size_t)(lat ? (rbase >> 13) : 4) * 6144;
        const int row0 = wr * 64 + fr, col0 = u.pn * BM + wc * 32 + 4 * fq;
        f32x4 gv[2][2];
#pragma unroll
        for (int bj = 0; bj < 2; ++bj)
#pragma unroll
            for (int n = 0; n < 2; ++n) gv[bj][n] = *(const f32x4*)(gp + col0 + bj * HALF + n * 16);
#pragma unroll
        for (int ai = 0; ai < 2; ++ai)
#pragma unroll
            for (int m = 0; m < 4; ++m) { float* rowp = X + (size_t)(row0 + ai * HALF + m * 16) * D + col0;
#pragma unroll
                for (int bj = 0; bj < 2; ++bj)
#pragma unroll
                    for (int n = 0; n < 2; ++n) { f32x4* p = (f32x4*)(rowp + bj * HALF + n * 16); *p = *p + gv[bj][n] * acc[ai][bj][m][n]; } }
    }
};
}

namespace att {
constexpr int SLOT = 40960, KN_OFF = 0, KR_OFF = 16384, V_OFF = 24576, LDS_BYTES = 3 * SLOT + 8 * 256;
constexpr float THR2 = 11.0f;
#define KSWZ(row, colB) ((row) * 256 + ((colB) ^ (((row) & 7) << 4)))
#define KRSWZ(row, colB) ((row) * 128 + ((colB) ^ ((((row) >> 1) & 7) << 4)))
#define SBAR() __builtin_amdgcn_sched_barrier(0)
__device__ __forceinline__ int crow(int r, int hi) { return (r & 3) + 8 * (r >> 2) + 4 * hi; }
__host__ __device__ __forceinline__ int v_st(int k, int c) { const int kk = (k & ~0xC) | ((k & 4) << 1) | ((k & 8) >> 1); return ((kk >> 3) * 4 + (c >> 5)) * 512 + ((kk & 7) * 32 + (c & 31)) * 2; }
__device__ __forceinline__ int v_rd_base(int lane) { return ((lane & 3) << 3) | (((lane >> 2) & 3) << 6) | (((lane >> 4) & 1) << 5) | (((lane >> 5) & 1) << 8); }
constexpr int v_rd_off(int d0, int ks, int half) { return d0 * 512 + ks * 4096 + half * 2048; }
template <int OFF> __device__ __forceinline__ s16x4 tr_read(int vb) {
    s16x4 r; asm volatile("ds_read_b64_tr_b16 %0, %1 offset:%2" : "=&v"(r) : "v"(vb), "i"(OFF) : "memory"); return r;
}
template <int D0> __device__ __forceinline__ void pv_one(f32x16& od, int vb, bf16x8 pa0, bf16x8 pa1, bf16x8 pa2, bf16x8 pa3) {
    const s16x4 l0 = tr_read<v_rd_off(D0, 0, 0)>(vb), h0 = tr_read<v_rd_off(D0, 0, 1)>(vb), l1 = tr_read<v_rd_off(D0, 1, 0)>(vb), h1 = tr_read<v_rd_off(D0, 1, 1)>(vb);
    const s16x4 l2 = tr_read<v_rd_off(D0, 2, 0)>(vb), h2 = tr_read<v_rd_off(D0, 2, 1)>(vb), l3 = tr_read<v_rd_off(D0, 3, 0)>(vb), h3 = tr_read<v_rd_off(D0, 3, 1)>(vb);
    asm volatile("s_waitcnt lgkmcnt(0)" ::: "memory"); SBAR();
#define PK(L, H) (bf16x8){L[0], L[1], L[2], L[3], H[0], H[1], H[2], H[3]}
    od = __builtin_amdgcn_mfma_f32_32x32x16_bf16(pa0, PK(l0, h0), od, 0, 0, 0);
    od = __builtin_amdgcn_mfma_f32_32x32x16_bf16(pa1, PK(l1, h1), od, 0, 0, 0);
    od = __builtin_amdgcn_mfma_f32_32x32x16_bf16(pa2, PK(l2, h2), od, 0, 0, 0);
    od = __builtin_amdgcn_mfma_f32_32x32x16_bf16(pa3, PK(l3, h3), od, 0, 0, 0);
#undef PK
}
__device__ __forceinline__ void pv_d0(f32x16* o, int vb, bf16x8 pa0, bf16x8 pa1, bf16x8 pa2, bf16x8 pa3) {
    pv_one<0>(o[0], vb, pa0, pa1, pa2, pa3); pv_one<1>(o[1], vb, pa0, pa1, pa2, pa3); pv_one<2>(o[2], vb, pa0, pa1, pa2, pa3); pv_one<3>(o[3], vb, pa0, pa1, pa2, pa3);
}
__device__ __forceinline__ void partialSM(f32x16& p0, f32x16& p1, float& m_reg, float& mn, float& alpha) {
    float pmax = p0[0];
#pragma unroll
    for (int r = 1; r < 16; ++r) pmax = fmaxf(pmax, p0[r]);
#pragma unroll
    for (int r = 0; r < 16; ++r) pmax = fmaxf(pmax, p1[r]);
    { auto rr = __builtin_amdgcn_permlane32_swap(__float_as_uint(pmax), __float_as_uint(pmax), false, false);
      pmax = fmaxf(__uint_as_float(rr[0]), __uint_as_float(rr[1])); }
    if (__builtin_expect(__all(pmax - m_reg <= THR2), 1)) { mn = m_reg; alpha = 1.f; }
    else { mn = fmaxf(m_reg, pmax); alpha = __builtin_amdgcn_exp2f(m_reg - mn); m_reg = mn; }
#pragma unroll
    for (int r = 0; r < 16; ++r) p0[r] = __builtin_amdgcn_exp2f(p0[r] - mn);
#pragma unroll
    for (int r = 0; r < 16; ++r) p1[r] = p1[r] - mn;
}
__device__ __forceinline__ void finishSM(f32x16& p0, f32x16& p1, float alpha, float& l_reg, bf16x8& pa0, bf16x8& pa1, bf16x8& pa2, bf16x8& pa3) {
#pragma unroll
    for (int r = 0; r < 16; ++r) p1[r] = __builtin_amdgcn_exp2f(p1[r]);
    float ps = 0;
#pragma unroll
    for (int r = 0; r < 16; ++r) ps += p0[r];
#pragma unroll
    for (int r = 0; r < 16; ++r) ps += p1[r];
    { auto rr = __builtin_amdgcn_permlane32_swap(__float_as_uint(ps), __float_as_uint(ps), false, false);
      ps = __uint_as_float(rr[0]) + __uint_as_float(rr[1]); }
    l_reg = l_reg * alpha + ps;
#define PK4(P, BASE, OUT) do { unsigned a0 = cvt_pk_bf16(P[BASE + 0], P[BASE + 1]), a1 = cvt_pk_bf16(P[BASE + 2], P[BASE + 3]);   \
    unsigned b0 = cvt_pk_bf16(P[BASE + 4], P[BASE + 5]), b1 = cvt_pk_bf16(P[BASE + 6], P[BASE + 7]);                              \
    auto r0 = __builtin_amdgcn_permlane32_swap(a0, b0, false, false); auto r1 = __builtin_amdgcn_permlane32_swap(a1, b1, false, false); \
    u32x4 w = {r0[0], r1[0], r0[1], r1[1]}; OUT = *reinterpret_cast<bf16x8*>(&w); } while (0)
    PK4(p0, 0, pa0); PK4(p0, 8, pa1); PK4(p1, 0, pa2); PK4(p1, 8, pa3);
#undef PK4
}
__device__ __forceinline__ void qkt(f32x16& p0, f32x16& p1, LAS unsigned char* slot, const bf16x8* qr, int r32, int hi) {
    p0 = f32x16{}; p1 = f32x16{};
#pragma unroll
    for (int d0 = 0; d0 < 8; ++d0) { const int cb = (d0 * 16 + hi * 8) * 2;
        bf16x8 b0 = *(const LAS bf16x8*)(slot + KN_OFF + KSWZ(r32, cb));
        bf16x8 b1 = *(const LAS bf16x8*)(slot + KN_OFF + KSWZ(32 + r32, cb));
        p0 = __builtin_amdgcn_mfma_f32_32x32x16_bf16(b0, qr[d0], p0, 0, 0, 0);
        p1 = __builtin_amdgcn_mfma_f32_32x32x16_bf16(b1, qr[d0], p1, 0, 0, 0); }
#pragma unroll
    for (int d0 = 0; d0 < 4; ++d0) { const int cb = (d0 * 16 + hi * 8) * 2;
        bf16x8 b0 = *(const LAS bf16x8*)(slot + KR_OFF + KRSWZ(r32, cb));
        bf16x8 b1 = *(const LAS bf16x8*)(slot + KR_OFF + KRSWZ(32 + r32, cb));
        p0 = __builtin_amdgcn_mfma_f32_32x32x16_bf16(b0, qr[8 + d0], p0, 0, 0, 0);
        p1 = __builtin_amdgcn_mfma_f32_32x32x16_bf16(b1, qr[8 + d0], p1, 0, 0, 0); }
}
__device__ __forceinline__ void attn_unit(const bf16_t* __restrict__ Qb, const unsigned char* __restrict__ KNt, const unsigned char* __restrict__ KRt, const unsigned char* __restrict__ Vt,
                                          bf16_t* __restrict__ Ob, int NT, LAS unsigned char* lds) {
    const int tid = otid(), wid = __builtin_amdgcn_readfirstlane(tid >> 6), lane = tid & 63, r32 = lane & 31, hi = lane >> 5;
    LAS float* wsf = (LAS float*)(lds + 3 * SLOT) + wid * 64; LAS float* li_l = wsf; LAS float* al_l = wsf + 32;
    float m_reg = -1e30f, l_reg = 0; f32x16 o[4] = {}; bf16x8 qr[12];
    const bf16_t* Qw = Qb + (size_t)(wid * 32 + r32) * 192 + hi * 8;
#pragma unroll
    for (int d0 = 0; d0 < 12; ++d0) qr[d0] = *(const bf16x8*)(Qw + d0 * 16);
    const int vrb = (int)(unsigned)(uintptr_t)(lds) + V_OFF + v_rd_base(lane);
    const unsigned lo16 = (unsigned)lane * 16u;
#define ATT_DMA(tile, slotoff) do { const size_t t_ = (size_t)(tile); LAS unsigned char* sl_ = lds + (slotoff); \
        __builtin_amdgcn_global_load_lds((const unsigned*)(KNt + t_ * 16384 + wid * 1024 + lo16), (LAS unsigned*)(sl_ + KN_OFF + wid * 1024), 16, 0, 0); \
        __builtin_amdgcn_global_load_lds((const unsigned*)(KNt + t_ * 16384 + (wid + 8) * 1024 + lo16), (LAS unsigned*)(sl_ + KN_OFF + (wid + 8) * 1024), 16, 0, 0); \
        __builtin_amdgcn_global_load_lds((const unsigned*)(KRt + t_ * 8192 + wid * 1024 + lo16), (LAS unsigned*)(sl_ + KR_OFF + wid * 1024), 16, 0, 0); \
        __builtin_amdgcn_global_load_lds((const unsigned*)(Vt + t_ * 16384 + wid * 1024 + lo16), (LAS unsigned*)(sl_ + V_OFF + wid * 1024), 16, 0, 0); \
        __builtin_amdgcn_global_load_lds((const unsigned*)(Vt + t_ * 16384 + (wid + 8) * 1024 + lo16), (LAS unsigned*)(sl_ + V_OFF + (wid + 8) * 1024), 16, 0, 0); } while (0)
#define ATT_SYNC() do { asm volatile("s_waitcnt vmcnt(0)" ::: "memory"); __builtin_amdgcn_s_barrier(); asm volatile("" ::: "memory"); } while (0)
#define RESC(a) do { if (__any((a) < 1.f)) { if (hi == 0) al_l[r32] = (a); asm volatile("s_waitcnt lgkmcnt(0)" ::: "memory"); \
        _Pragma("unroll") for (int d = 0; d < 4; ++d) _Pragma("unroll") for (int r = 0; r < 16; ++r) o[d][r] *= al_l[crow(r, hi)]; } } while (0)
    f32x16 pA0, pA1, pB0, pB1; float mnA, mnB, alA, alB; bf16x8 pa0, pa1, pa2, pa3;
    int sp = 0, sc = SLOT, sn = 2 * SLOT;
    ATT_DMA(0, 0); ATT_DMA(1, SLOT);
    asm volatile("s_waitcnt vmcnt(5)" ::: "memory"); __builtin_amdgcn_s_barrier(); asm volatile("" ::: "memory");
    qkt(pA0, pA1, lds, qr, r32, hi); partialSM(pA0, pA1, m_reg, mnA, alA);
    for (int j = 1; j + 1 < NT; j += 2) {
        ATT_SYNC(); ATT_DMA(j + 1, sn);
        SBAR(); qkt(pB0, pB1, lds + sc, qr, r32, hi);
        finishSM(pA0, pA1, alA, l_reg, pa0, pa1, pa2, pa3); SBAR();
        pv_d0(o, vrb + sp, pa0, pa1, pa2, pa3); partialSM(pB0, pB1, m_reg, mnB, alB);
        RESC(alB);
        { const int t_ = sp; sp = sc; sc = sn; sn = t_; }
        ATT_SYNC(); if (j + 2 < NT) ATT_DMA(j + 2, sn);
        SBAR(); qkt(pA0, pA1, lds + sc, qr, r32, hi);
        finishSM(pB0, pB1, alB, l_reg, pa0, pa1, pa2, pa3); SBAR();
        pv_d0(o, vrb + sp, pa0, pa1, pa2, pa3); partialSM(pA0, pA1, m_reg, mnA, alA);
        RESC(alA);
        { const int t_ = sp; sp = sc; sc = sn; sn = t_; }
    }
    ATT_SYNC();
    SBAR(); qkt(pB0, pB1, lds + sc, qr, r32, hi);
    finishSM(pA0, pA1, alA, l_reg, pa0, pa1, pa2, pa3); SBAR();
    pv_d0(o, vrb + sp, pa0, pa1, pa2, pa3); partialSM(pB0, pB1, m_reg, mnB, alB);
    RESC(alB);
    finishSM(pB0, pB1, alB, l_reg, pa0, pa1, pa2, pa3); SBAR();
    pv_d0(o, vrb + sc, pa0, pa1, pa2, pa3);
    if (hi == 0) li_l[r32] = l_reg; asm volatile("s_waitcnt lgkmcnt(0)" ::: "memory");
    float rli[16];
#pragma unroll
    for (int r = 0; r < 16; ++r) rli[r] = __builtin_amdgcn_rcpf(li_l[crow(r, hi)]);
    bf16_t* Ow = Ob + (size_t)(wid * 32) * 2048;
#pragma unroll
    for (int r = 0; r < 16; ++r) { const int orow = crow(r, hi);
#pragma unroll
        for (int d0 = 0; d0 < 4; ++d0) Ow[(size_t)orow * 2048 + d0 * 32 + r32] = f2bf(o[d0][r] * rli[r]); }
    __builtin_amdgcn_s_barrier(); asm volatile("" ::: "memory");
#undef ATT_DMA
#undef ATT_SYNC
#undef RESC
}
}

namespace att8 {
constexpr int SLOT = 20480, KN_OFF = 0, KR_OFF = 8192, V_OFF = 12288, LDS_BYTES = 3 * SLOT + 8 * 256;
constexpr float THR2 = 8.0f;
constexpr float QUP = 8.f; constexpr int SC_ONE = 0x7f7f7f7f, SC_Q = 0x7c7c7c7c;
__host__ __device__ __forceinline__ int kn8(int key, int b) { return key * 128 + ((((b >> 4) ^ ((key >> 1) & 7))) << 4) + (b & 15); }
__host__ __device__ __forceinline__ int kr8(int key, int b) { return key * 64 + ((((b >> 4) ^ ((key >> 2) & 3))) << 4) + (b & 15); }
__host__ __device__ __forceinline__ int vslot(int k) { return 32 * ((k >> 2) & 1) + 16 * (k >> 5) + (k & 3) + 4 * ((k & 31) >> 3); }
__host__ __device__ __forceinline__ int v8(int d, int k) { const int sl = vslot(k); return d * 64 + ((((sl >> 4) ^ ((d >> 2) & 3))) << 4) + (sl & 15); }
__device__ __forceinline__ i32x8 ld32(const LAS unsigned char* a0, const LAS unsigned char* a1) { const u32x4 x = *(const LAS u32x4*)a0, y = *(const LAS u32x4*)a1;
    return (i32x8){(int)x.x, (int)x.y, (int)x.z, (int)x.w, (int)y.x, (int)y.y, (int)y.z, (int)y.w}; }
__device__ __forceinline__ void qkt(f32x16& p0, f32x16& p1, LAS unsigned char* slot, const i32x8* qf, int r32, int hi) {
    p0 = f32x16{}; p1 = f32x16{};
#pragma unroll
    for (int ks = 0; ks < 2; ++ks) { const int b = 64 * ks + 32 * hi;
        const i32x8 a0 = ld32(slot + KN_OFF + kn8(r32, b), slot + KN_OFF + kn8(r32, b + 16)), a1 = ld32(slot + KN_OFF + kn8(32 + r32, b), slot + KN_OFF + kn8(32 + r32, b + 16));
        p0 = __builtin_amdgcn_mfma_scale_f32_32x32x64_f8f6f4(a0, qf[ks], p0, 0, 0, 0, SC_ONE, 0, SC_Q);
        p1 = __builtin_amdgcn_mfma_scale_f32_32x32x64_f8f6f4(a1, qf[ks], p1, 0, 0, 0, SC_ONE, 0, SC_Q); }
    { const int b = 32 * hi;
        const i32x8 a0 = ld32(slot + KR_OFF + kr8(r32, b), slot + KR_OFF + kr8(r32, b + 16)), a1 = ld32(slot + KR_OFF + kr8(32 + r32, b), slot + KR_OFF + kr8(32 + r32, b + 16));
        p0 = __builtin_amdgcn_mfma_scale_f32_32x32x64_f8f6f4(a0, qf[2], p0, 0, 0, 0, SC_ONE, 0, SC_Q);
        p1 = __builtin_amdgcn_mfma_scale_f32_32x32x64_f8f6f4(a1, qf[2], p1, 0, 0, 0, SC_ONE, 0, SC_Q); }
}
__device__ __forceinline__ void partialSM(f32x16& p0, f32x16& p1, float& m_reg, float& mn, float& alpha) {
    float pmax = p0[0];
#pragma unroll
    for (int r = 1; r < 16; ++r) pmax = fmaxf(pmax, p0[r]);
#pragma unroll
    for (int r = 0; r < 16; ++r) pmax = fmaxf(pmax, p1[r]);
    { auto rr = __builtin_amdgcn_permlane32_swap(__float_as_uint(pmax), __float_as_uint(pmax), false, false);
      pmax = fmaxf(__uint_as_float(rr[0]), __uint_as_float(rr[1])); }
    if (__builtin_expect(__all(pmax - m_reg <= THR2), 1)) { mn = m_reg; alpha = 1.f; }
    else { mn = fmaxf(m_reg, pmax); alpha = __builtin_amdgcn_exp2f(m_reg - mn); m_reg = mn; }
#pragma unroll
    for (int r = 0; r < 16; ++r) p0[r] = __builtin_amdgcn_exp2f(p0[r] - mn);
#pragma unroll
    for (int r = 0; r < 16; ++r) p1[r] = p1[r] - mn;
}
__device__ __forceinline__ void finishSM(f32x16& p0, f32x16& p1, float alpha, float& l_reg, i32x8& pf) {
#pragma unroll
    for (int r = 0; r < 16; ++r) p1[r] = __builtin_amdgcn_exp2f(p1[r]);
    float ps = 0;
#pragma unroll
    for (int r = 0; r < 16; ++r) ps += p0[r];
#pragma unroll
    for (int r = 0; r < 16; ++r) ps += p1[r];
    { auto rr = __builtin_amdgcn_permlane32_swap(__float_as_uint(ps), __float_as_uint(ps), false, false);
      ps = __uint_as_float(rr[0]) + __uint_as_float(rr[1]); }
    l_reg = l_reg * alpha + ps;
#pragma unroll
    for (int w = 0; w < 4; ++w) { pf[w] = (int)pk4_fp8(p0[4 * w], p0[4 * w + 1], p0[4 * w + 2], p0[4 * w + 3]); pf[4 + w] = (int)pk4_fp8(p1[4 * w], p1[4 * w + 1], p1[4 * w + 2], p1[4 * w + 3]); }
}
__device__ __forceinline__ void pv(f32x16* o, LAS unsigned char* slot, const i32x8 pf, int r32, int hi) {
#pragma unroll
    for (int d0 = 0; d0 < 4; ++d0) { const int d = 32 * d0 + r32, sw = (d >> 2) & 3;
        const i32x8 b = ld32(slot + V_OFF + d * 64 + (((2 * hi) ^ sw) << 4), slot + V_OFF + d * 64 + (((2 * hi + 1) ^ sw) << 4));
        o[d0] = __builtin_amdgcn_mfma_scale_f32_32x32x64_f8f6f4(pf, b, o[d0], 0, 0, 0, SC_ONE, 0, SC_ONE); }
}
__device__ __forceinline__ int crow(int r, int hi) { return (r & 3) + 8 * (r >> 2) + 4 * hi; }
__device__ __forceinline__ void attn_unit(const unsigned char* __restrict__ Qb, const unsigned char* __restrict__ KNt, const unsigned char* __restrict__ KRt, const unsigned char* __restrict__ Vt,
                                          bf16_t* __restrict__ Ob, int NT, LAS unsigned char* lds) {
    const int tid = otid(), wid = __builtin_amdgcn_readfirstlane(tid >> 6), lane = tid & 63, r32 = lane & 31, hi = lane >> 5;
    LAS float* wsf = (LAS float*)(lds + 3 * SLOT) + wid * 64; LAS float* li_l = wsf; LAS float* al_l = wsf + 32;
    float m_reg = -1e30f, l_reg = 0; f32x16 o[4] = {}; i32x8 qf[3];
    const unsigned char* Qw = Qb + (size_t)(wid * 32 + r32) * 192 + 32 * hi;
#pragma unroll
    for (int ks = 0; ks < 3; ++ks) { const u32x4 x = *(const u32x4*)(Qw + 64 * ks), y = *(const u32x4*)(Qw + 64 * ks + 16); qf[ks] = (i32x8){(int)x.x, (int)x.y, (int)x.z, (int)x.w, (int)y.x, (int)y.y, (int)y.z, (int)y.w}; }
    const unsigned lo16 = (unsigned)lane * 16u;
#define ATT_DMA(tile, slotoff) do { const size_t t_ = (size_t)(tile); LAS unsigned char* sl_ = lds + (slotoff); \
        __builtin_amdgcn_global_load_lds((const unsigned*)(KNt + t_ * 8192 + wid * 1024 + lo16), (LAS unsigned*)(sl_ + KN_OFF + wid * 1024), 16, 0, 0); \
        __builtin_amdgcn_global_load_lds((const unsigned*)(Vt + t_ * 8192 + wid * 1024 + lo16), (LAS unsigned*)(sl_ + V_OFF + wid * 1024), 16, 0, 0); \
        if (wid < 4) __builtin_amdgcn_global_load_lds((const unsigned*)(KRt + t_ * 4096 + wid * 1024 + lo16), (LAS unsigned*)(sl_ + KR_OFF + wid * 1024), 16, 0, 0); } while (0)
#define ATT_SYNC() do { asm volatile("s_waitcnt vmcnt(0)" ::: "memory"); __builtin_amdgcn_s_barrier(); asm volatile("" ::: "memory"); } while (0)
#define RESC(a) do { if (__any((a) < 1.f)) { if (hi == 0) al_l[r32] = (a); asm volatile("s_waitcnt lgkmcnt(0)" ::: "memory"); \
        _Pragma("unroll") for (int d = 0; d < 4; ++d) _Pragma("unroll") for (int r = 0; r < 16; ++r) o[d][r] *= al_l[crow(r, hi)]; } } while (0)
    f32x16 pA0, pA1, pB0, pB1; float mnA, mnB, alA, alB; i32x8 pf;
    int sp = 0, sc = SLOT, sn = 2 * SLOT;
    ATT_DMA(0, 0);
    ATT_SYNC();
    ATT_DMA(1, SLOT);
    qkt(pA0, pA1, lds, qf, r32, hi); partialSM(pA0, pA1, m_reg, mnA, alA);
    for (int j = 1; j + 1 < NT; j += 2) {
        ATT_SYNC(); ATT_DMA(j + 1, sn);
        SBAR(); qkt(pB0, pB1, lds + sc, qf, r32, hi);
        finishSM(pA0, pA1, alA, l_reg, pf); SBAR();
        pv(o, lds + sp, pf, r32, hi); partialSM(pB0, pB1, m_reg, mnB, alB);
        RESC(alB);
        { const int t_ = sp; sp = sc; sc = sn; sn = t_; }
        ATT_SYNC(); if (j + 2 < NT) ATT_DMA(j + 2, sn);
        SBAR(); qkt(pA0, pA1, lds + sc, qf, r32, hi);
        finishSM(pB0, pB1, alB, l_reg, pf); SBAR();
        pv(o, lds + sp, pf, r32, hi); partialSM(pA0, pA1, m_reg, mnA, alA);
        RESC(alA);
        { const int t_ = sp; sp = sc; sc = sn; sn = t_; }
    }
    ATT_SYNC();
    SBAR(); qkt(pB0, pB1, lds + sc, qf, r32, hi);
    finishSM(pA0, pA1, alA, l_reg, pf); SBAR();
    pv(o, lds + sp, pf, r32, hi); partialSM(pB0, pB1, m_reg, mnB, alB);
    RESC(alB);
    finishSM(pB0, pB1, alB, l_reg, pf); SBAR();
    pv(o, lds + sc, pf, r32, hi);
    if (hi == 0) li_l[r32] = l_reg; asm volatile("s_waitcnt lgkmcnt(0)" ::: "memory");
    float rli[16];
#pragma unroll
    for (int r = 0; r < 16; ++r) rli[r] = __builtin_amdgcn_rcpf(li_l[crow(r, hi)]);
    bf16_t* Ow = Ob + (size_t)(wid * 32) * 2048;
#pragma unroll
    for (int r = 0; r < 16; ++r) { const int orow = crow(r, hi);
#pragma unroll
        for (int d0 = 0; d0 < 4; ++d0) Ow[(size_t)orow * 2048 + d0 * 32 + r32] = f2bf(o[d0][r] * rli[r]); }
    __builtin_amdgcn_s_barrier(); asm volatile("" ::: "memory");
#undef ATT_DMA
#undef ATT_SYNC
#undef RESC
}
}

namespace ssd {
constexpr int XT_OFF = 0, BT_OFF = 17408, HB_OFF = 52224, SET = 69632, CW_OFF = 2 * SET, LDS_BYTES = CW_OFF + 8 * 1536;
constexpr int PITCH = 272;
constexpr float L2E = 1.4426950408889634f;
__device__ __forceinline__ void g_unit(const bf16_t* __restrict__ BC, bf16_t* __restrict__ G, int unit) {
    const int cid = unit >> 1, g = unit & 1;
    const int r0 = cid < 256 ? cid * 128 : NLAT + (cid - 256) * 128;
    const int tid = otid(), wid = tid >> 6, lane = tid & 63, fr = lane & 15, fq = lane >> 4;
    const bf16_t* Cp = BC + (size_t)(r0 + 16 * wid + fr) * 512 + 256 + 128 * g + 8 * fq;
    bf16x8 cf[4];
#pragma unroll
    for (int ks = 0; ks < 4; ++ks) cf[ks] = *(const bf16x8*)(Cp + 32 * ks);
    bf16_t* Gp = G + ((size_t)unit * 128 + 16 * wid + fr) * 128 + 4 * fq;
#pragma unroll
    for (int sb = 0; sb < 8; ++sb) {
        const bf16_t* Bp = BC + (size_t)(r0 + 16 * sb + fr) * 512 + 128 * g + 8 * fq;
        f32x4 acc = {0.f, 0.f, 0.f, 0.f};
#pragma unroll
        for (int ks = 0; ks < 4; ++ks) { const bf16x8 bfr = *(const bf16x8*)(Bp + 32 * ks); acc = __builtin_amdgcn_mfma_f32_16x16x32_bf16(bfr, cf[ks], acc, 0, 0, 0); }
        u32x2 w; w.x = cvt_pk_bf16(acc[0], acc[1]); w.y = cvt_pk_bf16(acc[2], acc[3]);
        *(u32x2*)(Gp + 16 * sb) = w;
    }
}
__device__ __forceinline__ void ssd_unit(int b, int h, int d, const bf16_t* __restrict__ XS, const bf16_t* __restrict__ BC, const float* __restrict__ DT, const bf16_t* __restrict__ G,
                                         const float* __restrict__ a_log, bf16_t* __restrict__ Y, LAS unsigned char* lds) {
    const int g = h >> 3;
    const int tid = otid(), wid = tid >> 6, lane = tid & 63, fr = lane & 15, fq = lane >> 4;
    const float a = -__expf(a_log[d * 16 + h]);
    LAS float* cw = (LAS float*)(lds + CW_OFF + wid * 1536); LAS float* dts = cw + 128; LAS float* dtw = cw + 256;
    f32x4 hs[4];
#pragma unroll
    for (int q = 0; q < 4; ++q) hs[q] = (f32x4){0.f, 0.f, 0.f, 0.f};
    for (int i = tid; i < 17408 / 4; i += 512) ((LAS unsigned*)(lds + HB_OFF))[i] = 0u;
    float cend = 0.f;
#define SSD_ROWS(step, r0v, gidv) do { if ((step) < 2) { const int oc_ = d ? 1 - (step) : (step); r0v = NLAT + b * 256 + oc_ * 128; gidv = 256 + b * 2 + oc_; } \
        else { const int lc_ = (step) - 2, oc_ = d ? 63 - lc_ : lc_; r0v = b * 8192 + oc_ * 128; gidv = b * 64 + oc_; } } while (0)
    const int sg = tid & 31, n8 = tid >> 5, p4 = tid >> 5;
    f32x2 P_da, Q_da; u32x2 P_xv[4], Q_xv[4]; u32x4 P_bv[4], Q_bv[4], n_gv[4], n_cv[4], c_gv[4], c_cv[4];
#define SSD_LOAD(step, X) do { int r0_, gid_; SSD_ROWS(step, r0_, gid_); (void)gid_; X##_da = *(const f32x2*)(DT + (size_t)(d * 16 + h) * NROW + r0_ + 2 * lane); \
        _Pragma("unroll") for (int j_ = 0; j_ < 4; ++j_) { X##_xv[j_] = *(const u32x2*)(XS + (size_t)(r0_ + 4 * sg + j_) * 1024 + 64 * h + 4 * p4); \
                                                         X##_bv[j_] = *(const u32x4*)(BC + (size_t)(r0_ + 4 * sg + j_) * 512 + 128 * g + 8 * n8); } } while (0)
#define SSD_LOADGC(step) do { int r0_, gid_; SSD_ROWS(step, r0_, gid_); const int t_ = 16 * wid + fr; const bf16_t* Gp_ = G + ((size_t)(gid_ * 2 + g) * 128 + t_) * 128 + 8 * fq; const bf16_t* Cp_ = BC + (size_t)(r0_ + t_) * 512 + 256 + 128 * g + 8 * fq; \
          _Pragma("unroll") for (int ks_ = 0; ks_ < 4; ++ks_) { n_gv[ks_] = *(const u32x4*)(Gp_ + 32 * ks_); n_cv[ks_] = *(const u32x4*)(Cp_ + 32 * ks_); } } while (0)
#define SSD_GCROT() do { _Pragma("unroll") for (int ks_ = 0; ks_ < 4; ++ks_) { c_gv[ks_] = n_gv[ks_]; c_cv[ks_] = n_cv[ks_]; } } while (0)
#define SSD_WRITE(step, X) do { LAS unsigned char* set_ = lds + ((step) & 1) * SET; \
        const float da0 = X##_da.x * a, da1 = X##_da.y * a; \
        float sc_ = da0 + da1; float c0_, c1_; \
        if (d == 0) { _Pragma("unroll") for (int o_ = 1; o_ < 64; o_ <<= 1) { const float t_ = __shfl_up(sc_, o_); if (lane >= o_) sc_ += t_; } \
            c0_ = sc_ - da1; c1_ = sc_; cend = __shfl(sc_, 63); } \
        else { _Pragma("unroll") for (int o_ = 1; o_ < 64; o_ <<= 1) { const float t_ = __shfl_down(sc_, o_); if (lane + o_ < 64) sc_ += t_; } \
            c0_ = sc_; c1_ = sc_ - da0; cend = __shfl(sc_, 0); } \
        *(LAS f32x2*)(cw + 2 * lane) = (f32x2){c0_, c1_}; *(LAS f32x2*)(dts + 2 * lane) = X##_da; \
        *(LAS f32x2*)(dtw + 2 * lane) = (f32x2){X##_da.x * __builtin_amdgcn_exp2f((cend - c0_) * L2E), X##_da.y * __builtin_amdgcn_exp2f((cend - c1_) * L2E)}; \
        { LAS unsigned char* xt_ = set_ + XT_OFF + (4 * p4) * PITCH + 8 * sg; \
          _Pragma("unroll") for (int i_ = 0; i_ < 4; ++i_) { unsigned e_[4]; \
              _Pragma("unroll") for (int j_ = 0; j_ < 4; ++j_) { const unsigned w_ = (i_ & 2) ? X##_xv[j_].y : X##_xv[j_].x; e_[j_] = (i_ & 1) ? (w_ >> 16) : (w_ & 0xffffu); } \
              u32x2 o_; o_.x = e_[0] | (e_[1] << 16); o_.y = e_[2] | (e_[3] << 16); *(LAS u32x2*)(xt_ + i_ * PITCH) = o_; } } \
        { LAS unsigned char* bt_ = set_ + BT_OFF + (8 * n8) * PITCH + 8 * sg; \
          _Pragma("unroll") for (int i_ = 0; i_ < 8; ++i_) { unsigned e_[4]; \
              _Pragma("unroll") for (int j_ = 0; j_ < 4; ++j_) { const unsigned w_ = X##_bv[j_][i_ >> 1]; e_[j_] = (i_ & 1) ? (w_ >> 16) : (w_ & 0xffffu); } \
              u32x2 o_; o_.x = e_[0] | (e_[1] << 16); o_.y = e_[2] | (e_[3] << 16); *(LAS u32x2*)(bt_ + i_ * PITCH) = o_; } } \
        asm volatile("s_waitcnt lgkmcnt(0)" ::: "memory"); \
    } while (0)
    SSD_LOAD(0, Q); SSD_LOADGC(0); SSD_WRITE(0, Q); SSD_LOAD(1, P);
    for (int step2 = 0; step2 < 66; step2 += 2)
#pragma unroll
    for (int par = 0; par < 2; ++par) {
        const int step = step2 + par;
        __syncthreads();
        int r0, gid; SSD_ROWS(step, r0, gid); (void)gid;
        LAS unsigned char* set = lds + (step & 1) * SET;
        const float cend_cur = cend;
        SSD_GCROT();
        if (step + 1 < 66) SSD_LOADGC(step + 1);
        if (step + 2 < 66) { if (par == 0) SSD_LOAD(step + 2, Q); else SSD_LOAD(step + 2, P); }
        {
            const int t = 16 * wid + fr; const float ct = cw[t];
            f32x4 y[4];
#pragma unroll
            for (int q = 0; q < 4; ++q) y[q] = (f32x4){0.f, 0.f, 0.f, 0.f};
            const float et = __builtin_amdgcn_exp2f(ct * L2E);
#pragma unroll
            for (int ks = 0; ks < 4; ++ks) {
                const bool live = d == 0 ? (32 * ks <= 16 * wid + 15) : (32 * ks + 31 >= 16 * wid);
                if (live) {
                    const int s0 = 32 * ks + 8 * fq;
                    const f32x4 c0 = *(const LAS f32x4*)(cw + s0), c1 = *(const LAS f32x4*)(cw + s0 + 4), d0v = *(const LAS f32x4*)(dts + s0), d1v = *(const LAS f32x4*)(dts + s0 + 4);
                    float m[8];
#pragma unroll
                    for (int i = 0; i < 8; ++i) { const float cs = i < 4 ? c0[i & 3] : c1[i & 3], dv = i < 4 ? d0v[i & 3] : d1v[i & 3]; const int s = s0 + i;
                        const bool ok = d == 0 ? (s <= t) : (s >= t);
                        const float gval = (i & 1) ? bfhi(c_gv[ks][i >> 1]) : bflo(c_gv[ks][i >> 1]);
                        m[i] = ok ? gval * dv * __builtin_amdgcn_exp2f((ct - cs) * L2E) : 0.f; }
                    u32x4 mw; mw.x = cvt_pk_bf16(m[0], m[1]); mw.y = cvt_pk_bf16(m[2], m[3]); mw.z = cvt_pk_bf16(m[4], m[5]); mw.w = cvt_pk_bf16(m[6], m[7]);
                    const bf16x8 mb = __builtin_bit_cast(bf16x8, mw);
#pragma unroll
                    for (int q = 0; q < 4; ++q) { const bf16x8 af = *(const LAS bf16x8*)(set + XT_OFF + (16 * q + fr) * PITCH + (32 * ks + 8 * fq) * 2);
                        y[q] = __builtin_amdgcn_mfma_f32_16x16x32_bf16(af, mb, y[q], 0, 0, 0); }
                }
            }
#pragma unroll
            for (int ks = 0; ks < 4; ++ks) {
                u32x4 cwv;
#pragma unroll
                for (int i = 0; i < 4; ++i) cwv[i] = cvt_pk_bf16(bflo(c_cv[ks][i]) * et, bfhi(c_cv[ks][i]) * et);
                const bf16x8 cb = __builtin_bit_cast(bf16x8, cwv);
#pragma unroll
                for (int q = 0; q < 4; ++q) { const bf16x8 af = *(const LAS bf16x8*)(set + HB_OFF + (16 * q + fr) * PITCH + (32 * ks + 8 * fq) * 2);
                    y[q] = __builtin_amdgcn_mfma_f32_16x16x32_bf16(af, cb, y[q], 0, 0, 0); }
            }
            bf16_t* yp = Y + (size_t)(r0 + t) * 1024 + 64 * h + 4 * fq;
#pragma unroll
            for (int q = 0; q < 4; ++q) { u32x2 w; w.x = cvt_pk_bf16(y[q][0], y[q][1]); w.y = cvt_pk_bf16(y[q][2], y[q][3]); *(u32x2*)(yp + 16 * q) = w; }
        }
        {
            const float dec = __builtin_amdgcn_exp2f(cend_cur * L2E);
#pragma unroll
            for (int q = 0; q < 4; ++q) hs[q] = hs[q] * dec;
#pragma unroll
            for (int ks = 0; ks < 4; ++ks) {
                const int s0 = 32 * ks + 8 * fq;
                const u32x4 braw = *(const LAS u32x4*)(set + BT_OFF + (16 * wid + fr) * PITCH + s0 * 2);
                const f32x4 w0 = *(const LAS f32x4*)(dtw + s0), w1 = *(const LAS f32x4*)(dtw + s0 + 4);
                u32x4 bw; bw.x = cvt_pk_bf16(bflo(braw.x) * w0[0], bfhi(braw.x) * w0[1]); bw.y = cvt_pk_bf16(bflo(braw.y) * w0[2], bfhi(braw.y) * w0[3]);
                          bw.z = cvt_pk_bf16(bflo(braw.z) * w1[0], bfhi(braw.z) * w1[1]); bw.w = cvt_pk_bf16(bflo(braw.w) * w1[2], bfhi(braw.w) * w1[3]);
                const bf16x8 bfr = __builtin_bit_cast(bf16x8, bw);
#pragma unroll
                for (int q = 0; q < 4; ++q) { const bf16x8 af = *(const LAS bf16x8*)(set + XT_OFF + (16 * q + fr) * PITCH + s0 * 2);
                    hs[q] = __builtin_amdgcn_mfma_f32_16x16x32_bf16(af, bfr, hs[q], 0, 0, 0); }
            }
            LAS bf16_t* hb = (LAS bf16_t*)(lds + ((step + 1) & 1) * SET + HB_OFF) + 16 * wid + fr;
#pragma unroll
            for (int q = 0; q < 4; ++q)
#pragma unroll
                for (int i = 0; i < 4; ++i) hb[(16 * q + 4 * fq + i) * 136] = f2bf(hs[q][i]);
        }
        if (step + 1 < 66) { if (par == 0) SSD_WRITE(step + 1, P); else SSD_WRITE(step + 1, Q); }
    }
    __syncthreads();
#undef SSD_ROWS
#undef SSD_LOAD
#undef SSD_LOADGC
#undef SSD_GCROT
#undef SSD_WRITE
}
}

struct Args { const float* in[32]; float* out; unsigned char* ws; int ph_lo, ph_hi; };
constexpr int NTHR = 512;
constexpr int LDS_BASE = 256;
constexpr int LDS_PHASE = 151808;
constexpr int LDS_BYTES = LDS_BASE + LDS_PHASE;
static_assert(att::LDS_BYTES <= LDS_PHASE && att8::LDS_BYTES <= LDS_PHASE && ssd::LDS_BYTES <= LDS_PHASE && pg8::STAGE_BYTES <= LDS_PHASE, "LDS");

__device__ __forceinline__ void tjob(int j, const Args& A, const float*& src, bf16_t*& dst, int& K, int& N, int& Npad, int& mode, const float*& ks) {
    unsigned char* W = A.ws + WS_W; mode = 0; ks = nullptr;
    if (j < 8) { const int i = j >> 2, w = j & 3; unsigned char* base = W + W_HYB + (size_t)i * WH_SZ;
        if (w == 0)      { src = A.in[I_HWIN] + (size_t)i * 1024 * HYB_IN; dst = (bf16_t*)(base + WH_IN); K = 1024; N = HYB_IN; Npad = HYB_INP; mode = 1; }
        else if (w == 1) { src = A.in[I_WQB] + (size_t)i * 384 * 1536; dst = (bf16_t*)(base + WH_QB); K = 384; N = 1536; Npad = 1536; mode = 2; ks = A.in[I_QNG] + i * 384; }
        else if (w == 2) { src = A.in[I_WKVB] + (size_t)i * 256 * 2048; dst = (bf16_t*)(base + WH_KVB); K = 256; N = 2048; Npad = 2048; ks = A.in[I_KVNG] + i * 256; }
        else             { src = A.in[I_HWOUT] + (size_t)i * 2048 * 1024; dst = (bf16_t*)(base + WH_OUT); K = 2048; N = 1024; Npad = 1024; }
    } else if (j < 12) { const int i = (j - 8) >> 1, w = (j - 8) & 1; unsigned char* base = W + W_GM + (size_t)i * WG_SZ;
        if (w == 0) { src = A.in[I_GWIN] + (size_t)i * 1024 * 4096; dst = (bf16_t*)(base + WG_IN); K = 1024; N = 4096; Npad = 4096; }
        else        { src = A.in[I_GWOUT] + (size_t)i * 2048 * 1024; dst = (bf16_t*)(base + WG_OUT); K = 2048; N = 1024; Npad = 1024; }
    } else { const int l = j - 12; src = A.in[I_PWQ] + (size_t)l * 1024 * 2048; dst = (bf16_t*)(W + W_PEER + (size_t)l * WP_SZ + WP_Q); K = 1024; N = 2048; Npad = 2048; }
}
__device__ __forceinline__ int colmap(int mode, int n, int N) {
    if (mode == 1) { if (n >= N) return -1; if (n < C_KR) return n; const int m = n - C_KR; return C_KR + (m >> 1) + 32 * (m & 1); }
    if (mode == 2) { if (n < 1024) return (n >> 7) * 192 + (n & 127); const int m = n - 1024, h = m >> 6, mm = m & 63; return h * 192 + 128 + (mm >> 1) + 32 * (mm & 1); }
    return n;
}
__device__ __forceinline__ void phase_prologue(const Args& A, LAS unsigned char* lds) {
    const int tid = otid();
    {
        LAS float* tile = (LAS float*)lds;
        int item = blockIdx.x;
        for (int j = 0; j < 16; ++j) {
            const float* src; bf16_t* dst; int K, N, Npad, mode; const float* ks; tjob(j, A, src, dst, K, N, Npad, mode, ks);
            const int tk = K / 64, tn = Npad / 64, nt = tk * tn;
            for (; item < nt; item += gridDim.x) {
                const int k0 = (item % tk) * 64, n0 = (item / tk) * 64;
                { const int k = tid >> 3, cg = tid & 7; const float sc = ks ? ks[k0 + k] : 1.f;
#pragma unroll
                  for (int jj = 0; jj < 8; ++jj) { const int oc = colmap(mode, n0 + 8 * cg + jj, N); tile[k * 65 + 8 * cg + jj] = oc >= 0 ? src[(size_t)(k0 + k) * N + oc] * sc : 0.f; } }
                __syncthreads();
                { const int n = tid >> 3, kg = tid & 7; float v[8];
#pragma unroll
                  for (int jj = 0; jj < 8; ++jj) v[jj] = tile[(8 * kg + jj) * 65 + n];
                  u32x4 w; w.x = cvt_pk_bf16(v[0], v[1]); w.y = cvt_pk_bf16(v[2], v[3]); w.z = cvt_pk_bf16(v[4], v[5]); w.w = cvt_pk_bf16(v[6], v[7]);
                  *(u32x4*)(dst + (size_t)(n0 + n) * K + k0 + 8 * kg) = w; }
                __syncthreads();
            }
            item -= nt;
        }
    }
    {
        const int gthr = blockIdx.x * NTHR + tid, nthr = gridDim.x * NTHR;
        for (int p = gthr; p < 10 * 16384; p += nthr) {
            const int mat = p >> 14, off = (p & 16383) * 8; const float* src; bf16_t* dst;
            if (mat < 2)      { src = A.in[I_GWS] + (size_t)mat * 131072; dst = (bf16_t*)(A.ws + WS_W + W_GM + (size_t)mat * WG_SZ + WG_WS); }
            else if (mat < 6) { src = A.in[I_PK1] + (size_t)(mat - 2) * 131072; dst = (bf16_t*)(A.ws + WS_W + W_PEER + (size_t)(mat - 2) * WP_SZ + WP_K1); }
            else              { src = A.in[I_PK2] + (size_t)(mat - 6) * 131072; dst = (bf16_t*)(A.ws + WS_W + W_PEER + (size_t)(mat - 6) * WP_SZ + WP_K2); }
            const f32x4 a = *(const f32x4*)(src + off), b = *(const f32x4*)(src + off + 4);
            u32x4 w; w.x = cvt_pk_bf16(a[0], a[1]); w.y = cvt_pk_bf16(a[2], a[3]); w.z = cvt_pk_bf16(b[0], b[1]); w.w = cvt_pk_bf16(b[2], b[3]);
            *(u32x4*)(dst + off) = w;
        }
        float* rope = (float*)(A.ws + WS_ROPE);
        for (int p = gthr; p < SEQ * 32; p += nthr) { const int l = p >> 5, i = p & 31; const float pos = (float)(i < 16 ? (l >> 6) : (l & 63));
            const float inv = powf(10000.f, -(float)(i & 15) / 16.f), ang = pos * inv; rope[p] = cosf(ang); rope[SEQ * 32 + p] = sinf(ang); }
    }
    {
        LAS float* scond = (LAS float*)lds;
        LAS float* red = scond + 5 * 1024;
        __syncthreads();
        for (int i = tid; i < 5 * 1024; i += NTHR) { const int m = i >> 10, k = i & 1023; const float c = m < 4 ? A.in[I_C][m * 1024 + k] : A.in[I_CCTX][k]; scond[i] = silu_f(c); }
        __syncthreads();
        float* MOD = (float*)(A.ws + WS_MOD);
        for (int item = blockIdx.x; item < 4 * 48; item += gridDim.x) {
            const int layer = item / 48, j0 = (item % 48) * 128; const int c4 = tid & 31, ksl = tid >> 5;
            f32x4 acc[5];
#pragma unroll
            for (int m = 0; m < 5; ++m) acc[m] = (f32x4){0.f, 0.f, 0.f, 0.f};
            const float* wp = A.in[I_ADAW] + ((size_t)layer * 1024 + ksl * 64) * 6144 + j0 + 4 * c4;
            for (int k = 0; k < 64; ++k) { const f32x4 w = *(const f32x4*)(wp + (size_t)k * 6144);
#pragma unroll
                for (int m = 0; m < 5; ++m) acc[m] += w * scond[m * 1024 + ksl * 64 + k]; }
#pragma unroll
            for (int m = 0; m < 5; ++m) *(LAS f32x4*)(red + (ksl * 5 + m) * 128 + 4 * c4) = acc[m];
            __syncthreads();
            for (int i = tid; i < 640; i += NTHR) { const int m = i >> 7, c = i & 127; float s = A.in[I_ADAB][layer * 6144 + j0 + c];
#pragma unroll
                for (int q = 0; q < 16; ++q) s += red[(q * 5 + m) * 128 + c];
                MOD[((size_t)layer * 5 + m) * 6144 + j0 + c] = s; }
            __syncthreads();
        }
    }
}

__device__ __forceinline__ void phase_norm_mod(const float* xl, const float* xc, float* cl, float* cc, const float* g, const float* modl, int sh_idx, bf16_t* H, int nrows) {
    const int tid_ = otid(); const int lane = tid_ & 63, gw = blockIdx.x * 8 + (tid_ >> 6), nw = gridDim.x * 8;
    f32x4 gv[4];
#pragma unroll
    for (int i = 0; i < 4; ++i) gv[i] = *(const f32x4*)(g + 256 * i + 4 * lane);
    for (int r = gw; r < nrows; r += nw) {
        const bool lat = r < NLAT; const float* xp = lat ? xl + (size_t)r * D : xc + (size_t)(r - NLAT) * D;
        f32x4 x[4]; float ss = 0.f;
#pragma unroll
        for (int i = 0; i < 4; ++i) { x[i] = *(const f32x4*)(xp + 256 * i + 4 * lane); ss += x[i][0] * x[i][0] + x[i][1] * x[i][1] + x[i][2] * x[i][2] + x[i][3] * x[i][3]; }
        if (cl) { float* cp = lat ? cl + (size_t)r * D : cc + (size_t)(r - NLAT) * D;
#pragma unroll
            for (int i = 0; i < 4; ++i) *(f32x4*)(cp + 256 * i + 4 * lane) = x[i]; }
        ss = wave_sum(ss); const float rstd = rsqrtf(ss * (1.f / 1024.f) + EPS);
        const float* mp = modl + (size_t)(lat ? (r >> 13) : 4) * 6144 + sh_idx * 1024;
#pragma unroll
        for (int i = 0; i < 4; ++i) { const f32x4 sh = *(const f32x4*)(mp + 256 * i + 4 * lane), sc = *(const f32x4*)(mp + 1024 + 256 * i + 4 * lane);
            const f32x4 hv = (x[i] * rstd) * gv[i] * (sc + 1.f) + sh;
            u32x2 w; w.x = cvt_pk_bf16(hv[0], hv[1]); w.y = cvt_pk_bf16(hv[2], hv[3]);
            *(u32x2*)(H + (size_t)r * D + 256 * i + 4 * lane) = w; }
    }
}
__device__ __forceinline__ void phase_final_norm(float* xl, const float* g, float oscale) {
    const int tid_ = otid(); const int lane = tid_ & 63, gw = blockIdx.x * 8 + (tid_ >> 6), nw = gridDim.x * 8;
    f32x4 gv[4];
#pragma unroll
    for (int i = 0; i < 4; ++i) gv[i] = *(const f32x4*)(g + 256 * i + 4 * lane);
    for (int r = gw; r < NLAT; r += nw) {
        float* xp = xl + (size_t)r * D; f32x4 x[4]; float ss = 0.f;
#pragma unroll
        for (int i = 0; i < 4; ++i) { x[i] = *(const f32x4*)(xp + 256 * i + 4 * lane); ss += x[i][0] * x[i][0] + x[i][1] * x[i][1] + x[i][2] * x[i][2] + x[i][3] * x[i][3]; }
        ss = wave_sum(ss); const float rstd = rsqrtf(ss * (1.f / 1024.f) + EPS);
#pragma unroll
        for (int i = 0; i < 4; ++i) *(f32x4*)(xp + 256 * i + 4 * lane) = (x[i] * (rstd * oscale)) * gv[i];
    }
}

__device__ __forceinline__ void phase_conv(const Args& A, int li) {
    const bf16_t* PROJ = (const bf16_t*)(A.ws + WS_BIG);
    bf16_t* XS = (bf16_t*)(A.ws + WS_R2); bf16_t* BC = (bf16_t*)(A.ws + WS_R2 + R2_BC);
    const int tid = otid();
    {
        for (int item = blockIdx.x * 3; item < (NROW / 64) * 3; item += gridDim.x * 3)
#pragma unroll 1
        for (int sub = 0; sub < 3; ++sub) {
            const int blk = (item + sub) / 3, q = ((item + sub) % 3) * 512 + tid, cg = q % 192, rg = q / 192, c0 = 8 * cg;
            const int rbeg = blk * 64 + rg * 8; int s0, s1;
            if (rbeg < NLAT) { s0 = rbeg & ~8191; s1 = s0 + 8192; } else { s0 = NLAT + ((rbeg - NLAT) & ~255); s1 = s0 + 256; }
            const float* cw = A.in[I_CONVW] + ((size_t)li * 1536 + c0) * 5; const float* cb = A.in[I_CONVB] + (size_t)li * 1536 + c0;
            u32x4 in[12];
#pragma unroll
            for (int i = 0; i < 12; ++i) { const int r = rbeg - 2 + i; in[i] = (r >= s0 && r < s1) ? *(const u32x4*)(PROJ + (size_t)r * HYB_INP + C_XBC + c0) : (u32x4){0u, 0u, 0u, 0u}; }
            float w[8][5], bia[8];
#pragma unroll
            for (int j = 0; j < 8; ++j) { bia[j] = cb[j];
#pragma unroll
                for (int k = 0; k < 5; ++k) w[j][k] = cw[j * 5 + k]; }
#pragma unroll
            for (int rr = 0; rr < 8; ++rr) {
                float o[8];
#pragma unroll
                for (int j = 0; j < 8; ++j) { float sacc = bia[j];
#pragma unroll
                    for (int k = 0; k < 5; ++k) { const unsigned wd = in[rr + k][j >> 1]; sacc += w[j][k] * ((j & 1) ? bfhi(wd) : bflo(wd)); }
                    o[j] = silu_f(sacc); }
                u32x4 pk; pk.x = cvt_pk_bf16(o[0], o[1]); pk.y = cvt_pk_bf16(o[2], o[3]); pk.z = cvt_pk_bf16(o[4], o[5]); pk.w = cvt_pk_bf16(o[6], o[7]);
                const int r = rbeg + rr;
                if (c0 < 1024) *(u32x4*)(XS + (size_t)r * 1024 + c0) = pk; else *(u32x4*)(BC + (size_t)r * 512 + (c0 - 1024)) = pk;
            }
        }
    }
    {
        const int lane = tid & 63, gw = blockIdx.x * 8 + (tid >> 6), nw = gridDim.x * 8;
        float* DT = (float*)(A.ws + WS_BIG + BIG_DT); float* RQ = (float*)(A.ws + WS_RSTD); float* RKV = RQ + NROW;
        unsigned char* KR = A.ws + WS_BIG + BIG_KR; const float* rope = (const float*)(A.ws + WS_ROPE);
        const float dtb = lane < 32 ? A.in[I_DTB][li * 32 + lane] : 0.f;
        for (int r = gw; r < NROW; r += nw) {
            const bf16_t* p = PROJ + (size_t)r * HYB_INP;
            if (lane < 32) DT[(size_t)lane * NROW + r] = softplus_f(bf2f(p[C_DT + (lane & 15)]) + dtb);
            { const unsigned* q = (const unsigned*)(p + C_CQ + 6 * lane); float ss = 0.f;
#pragma unroll
              for (int j = 0; j < 3; ++j) { const unsigned w = q[j]; const float a = bflo(w), b = bfhi(w); ss += a * a + b * b; }
              ss = wave_sum(ss); if (lane == 0) RQ[r] = rsqrtf(ss * (1.f / 384.f) + EPS); }
            { const u32x2 w = *(const u32x2*)(p + C_CKV + 4 * lane); const float a = bflo(w.x), b = bfhi(w.x), c = bflo(w.y), d = bfhi(w.y);
              float ss = a * a + b * b + c * c + d * d; ss = wave_sum(ss); if (lane == 0) RKV[r] = rsqrtf(ss * (1.f / 256.f) + EPS); }
            if (lane < 32) { const unsigned w = *(const unsigned*)(p + C_KR + 2 * lane); float x1 = bflo(w), x2 = bfhi(w); int b, key;
                if (r < NLAT) { const int l = r & 8191; const float c = rope[l * 32 + lane], s = rope[SEQ * 32 + l * 32 + lane];
                    const float o1 = x1 * c - x2 * s, o2 = x1 * s + x2 * c; x1 = o1; x2 = o2; b = r >> 13; key = 256 + l; }
                else { b = (r - NLAT) >> 8; key = (r - NLAT) & 255; }
                { int w8 = 0; w8 = __builtin_amdgcn_cvt_pk_fp8_f32(sat8(x1), sat8(x2), w8, false);
                  *(unsigned short*)(KR + (size_t)(b * NKT + (key >> 6)) * 4096 + att8::kr8(key & 63, 2 * lane)) = (unsigned short)(w8 & 0xffff); } }
        }
    }
}

struct EpiQ {
    static constexpr bool PERM = true;
    unsigned char* Q; const float* rstd; const float* rope;
    __device__ __forceinline__ void operator()(const f32x4 (&acc)[2][2][4][2], const pg8::Unit& u, int wr, int wc, int fr, int fq) const {
        const bool lat = u.pm < 128;
        const int b = lat ? (u.pm >> 5) : (u.pm - 128), q0 = lat ? 256 + ((u.pm & 31) << 8) : 0;
        const bool isrope = u.pn >= 4;
#pragma unroll
        for (int ai = 0; ai < 2; ++ai) {
            const int rl = 128 * ai + 64 * wr + fr;
            const float* rsp = rstd + u.pm * 256 + rl;
            const float* rp = rope + (size_t)(((u.pm & 31) << 8) + rl) * 32;
#pragma unroll
            for (int bj = 0; bj < 2; ++bj) {
                const int c0 = u.pn * 256 + 128 * bj + 32 * wc + 8 * fq; int h, dcol;
                if (!isrope) { h = c0 >> 7; dcol = c0 & 127; } else { const int mq = c0 - 1024; h = mq >> 6; dcol = 128 + (mq & 63); }
                unsigned char* dst = Q + ((size_t)(b * 8 + h) * NKEY + q0 + rl) * 192 + dcol;
                const int ro = (dcol - 128) >> 1;
#pragma unroll
                for (int m = 0; m < 4; ++m) {
                    const float rs = rsp[16 * m] * (QSCALE * att8::QUP);
                    f32x4 v0 = acc[ai][bj][m][0] * rs, v1 = acc[ai][bj][m][1] * rs;
                    if (isrope && lat) { const f32x4 cs = *(const f32x4*)(rp + 16 * m * 32 + ro), sn = *(const f32x4*)(rp + SEQ * 32 + 16 * m * 32 + ro);
                        const f32x4 a0 = v0, a1 = v1;
                        v0[0] = a0[0] * cs[0] - a0[1] * sn[0]; v0[1] = a0[0] * sn[0] + a0[1] * cs[0]; v0[2] = a0[2] * cs[1] - a0[3] * sn[1]; v0[3] = a0[2] * sn[1] + a0[3] * cs[1];
                        v1[0] = a1[0] * cs[2] - a1[1] * sn[2]; v1[1] = a1[0] * sn[2] + a1[1] * cs[2]; v1[2] = a1[2] * cs[3] - a1[3] * sn[3]; v1[3] = a1[2] * sn[3] + a1[3] * cs[3]; }
                    u32x2 w; w.x = pk4_fp8_sat(v0[0], v0[1], v0[2], v0[3]); w.y = pk4_fp8_sat(v1[0], v1[1], v1[2], v1[3]);
                    *(u32x2*)(dst + 16 * m * 192) = w;
                    asm volatile("" ::: "memory");
                }
            }
        }
    }
};
struct EpiKV {
    static constexpr bool PERM = true;
    unsigned char* KN; unsigned char* V; const float* rstd;
    __device__ __forceinline__ void operator()(const f32x4 (&acc)[2][2][4][2], const pg8::Unit& u, int wr, int wc, int fr, int fq) const {
        const bool lat = u.pm < 128;
        const int b = lat ? (u.pm >> 5) : (u.pm - 128), t0 = lat ? 4 + ((u.pm & 31) << 2) : 0;
        const int dd = 32 * wc + 8 * fq;
        const int offK = fr * 128 + ((((dd >> 4) ^ ((fr >> 1) & 7))) << 4) + (dd & 15);
#pragma unroll
        for (int ai = 0; ai < 2; ++ai) {
            const size_t tb = ((size_t)(b * 8 + u.pn) * NKT + t0 + 2 * ai + wr) * 8192;
            const float* rsp = rstd + u.pm * 256 + 128 * ai + 64 * wr + fr;
            unsigned char* kp = KN + tb + offK; unsigned char* vp = V + tb;
#pragma unroll
            for (int m = 0; m < 4; ++m) {
                const float rs = rsp[16 * m];
                { const f32x4 v0 = acc[ai][0][m][0] * rs, v1 = acc[ai][0][m][1] * rs; u32x2 w; w.x = pk4_fp8_sat(v0[0], v0[1], v0[2], v0[3]); w.y = pk4_fp8_sat(v1[0], v1[1], v1[2], v1[3]);
                  *(u32x2*)(kp + m * 2048) = w; }
                { const f32x4 v0 = acc[ai][1][m][0] * rs, v1 = acc[ai][1][m][1] * rs; const unsigned w0 = pk4_fp8_sat(v0[0], v0[1], v0[2], v0[3]), w1 = pk4_fp8_sat(v1[0], v1[1], v1[2], v1[3]);
                  const int sl = att8::vslot(16 * m + fr);
#pragma unroll
                  for (int i = 0; i < 8; ++i) { const int d = dd + i; vp[d * 64 + ((((sl >> 4) ^ ((d >> 2) & 3))) << 4) + (sl & 15)] = (unsigned char)(((i < 4 ? w0 : w1) >> (8 * (i & 3))) & 0xffu); } }
                asm volatile("" ::: "memory");
            }
        }
    }
};

__device__ __forceinline__ void phase_ssd_out(const Args& A, int li, int nrows) {
    const bf16_t* PROJ = (const bf16_t*)(A.ws + WS_BIG); const bf16_t* XS = (const bf16_t*)(A.ws + WS_R2);
    const bf16_t* Y0 = (const bf16_t*)(A.ws + WS_H); const bf16_t* Y1 = (const bf16_t*)(A.ws + WS_R3); bf16_t* CAT = (bf16_t*)(A.ws + WS_R3 + R3_CAT);
    const int tid_ = otid(); const int lane = tid_ & 63, gw = blockIdx.x * 8 + (tid_ >> 6), nw = gridDim.x * 8;
    const float dsk = A.in[I_SSDD][li * 16 + (lane >> 2)];
    float ng[16];
#pragma unroll
    for (int j = 0; j < 16; ++j) ng[j] = A.in[I_SSDNG][li * 1024 + 16 * lane + j];
    for (int r = gw; r < nrows; r += nw) {
        float v[16]; float ss = 0.f;
#pragma unroll
        for (int hh = 0; hh < 2; ++hh) {
            const u32x4 a = *(const u32x4*)(Y0 + (size_t)r * 1024 + 16 * lane + 8 * hh), b = *(const u32x4*)(Y1 + (size_t)r * 1024 + 16 * lane + 8 * hh);
            const u32x4 x = *(const u32x4*)(XS + (size_t)r * 1024 + 16 * lane + 8 * hh), z = *(const u32x4*)(PROJ + (size_t)r * HYB_INP + 16 * lane + 8 * hh);
#pragma unroll
            for (int q = 0; q < 4; ++q) {
                const float y0 = (bflo(a[q]) + bflo(b[q]) + dsk * bflo(x[q])) * silu_f(bflo(z[q])), y1 = (bfhi(a[q]) + bfhi(b[q]) + dsk * bfhi(x[q])) * silu_f(bfhi(z[q]));
                v[8 * hh + 2 * q] = y0; v[8 * hh + 2 * q + 1] = y1; ss += y0 * y0 + y1 * y1; }
        }
#pragma unroll
        for (int o = 16; o >= 1; o >>= 1) ss += __shfl_xor(ss, o);
        const float rstd = rsqrtf(ss * (1.f / 512.f) + EPS);
#pragma unroll
        for (int hh = 0; hh < 2; ++hh) { u32x4 w;
#pragma unroll
            for (int q = 0; q < 4; ++q) w[q] = cvt_pk_bf16(v[8 * hh + 2 * q] * rstd * ng[8 * hh + 2 * q], v[8 * hh + 2 * q + 1] * rstd * ng[8 * hh + 2 * q + 1]);
            *(u32x4*)(CAT + (size_t)r * 2048 + 16 * lane + 8 * hh) = w; }
    }
}

__device__ __forceinline__ void phase_ln_stats(const Args& A, int nrows) {
    const bf16_t* Gb = (const bf16_t*)(A.ws + WS_BIG); float* ST = (float*)(A.ws + WS_RSTD);
    const int tid_ = otid(); const int lane = tid_ & 63, gw = blockIdx.x * 8 + (tid_ >> 6), nw = gridDim.x * 8;
    for (int r = gw; r < nrows; r += nw) {
        float v[32]; float s = 0.f;
#pragma unroll
        for (int j = 0; j < 4; ++j) { const u32x4 w = *(const u32x4*)(Gb + (size_t)r * 4096 + 2048 + 512 * j + 8 * lane);
#pragma unroll
            for (int q = 0; q < 4; ++q) { v[8 * j + 2 * q] = bflo(w[q]); v[8 * j + 2 * q + 1] = bfhi(w[q]); s += v[8 * j + 2 * q] + v[8 * j + 2 * q + 1]; } }
        s = wave_sum(s); const float mu = s * (1.f / 2048.f); float q2 = 0.f;
#pragma unroll
        for (int j = 0; j < 32; ++j) { const float dd = v[j] - mu; q2 += dd * dd; }
        q2 = wave_sum(q2);
        if (lane == 0) { ST[r] = mu; ST[NROW + r] = rsqrtf(q2 * (1.f / 2048.f) + EPS); }
    }
}
__device__ __forceinline__ void phase_spatial(const Args& A, int gi, int nrows, LAS unsigned char* lds) {
    const bf16_t* Gb = (const bf16_t*)(A.ws + WS_BIG); const float* ST = (const float*)(A.ws + WS_RSTD); bf16_t* Ab = (bf16_t*)(A.ws + WS_R1);
    const bf16_t* WSg = (const bf16_t*)(A.ws + WS_W + W_GM + (size_t)gi * WG_SZ + WG_WS);
    const float* lng = A.in[I_GLNG] + (size_t)gi * 2048; const float* lnb = A.in[I_GLNB] + (size_t)gi * 2048; const float* bs = A.in[I_GBS] + (size_t)gi * 1024;
    const int tid = otid(), wid = tid >> 6, lane = tid & 63, r32 = lane & 31, hi = lane >> 5, tb = wid & 3, dh = wid >> 2;
    const int ldsaddr = (int)(unsigned)(uintptr_t)lds;
    for (int unit = blockIdx.x; unit < (nrows / 128) * 8; unit += gridDim.x) {
        const int cb = unit >> 3, gg = unit & 7, r0 = cb * 128;
        __syncthreads();
#pragma unroll
        for (int j = 0; j < 8; ++j) { const int idx = tid + 512 * j, s = idx >> 5, dd = (idx & 31) * 8;
            const u32x4 w = *(const u32x4*)(Gb + (size_t)(r0 + s) * 4096 + 2048 + 256 * gg + dd);
            const float mu = ST[r0 + s], rs = ST[NROW + r0 + s];
            const f32x4 g0 = *(const f32x4*)(lng + 256 * gg + dd), g1 = *(const f32x4*)(lng + 256 * gg + dd + 4), b0 = *(const f32x4*)(lnb + 256 * gg + dd), b1 = *(const f32x4*)(lnb + 256 * gg + dd + 4);
            u32x4 o;
            o.x = cvt_pk_bf16((bflo(w.x) - mu) * rs * g0[0] + b0[0], (bfhi(w.x) - mu) * rs * g0[1] + b0[1]); o.y = cvt_pk_bf16((bflo(w.y) - mu) * rs * g0[2] + b0[2], (bfhi(w.y) - mu) * rs * g0[3] + b0[3]);
            o.z = cvt_pk_bf16((bflo(w.z) - mu) * rs * g1[0] + b1[0], (bfhi(w.z) - mu) * rs * g1[1] + b1[1]); o.w = cvt_pk_bf16((bflo(w.w) - mu) * rs * g1[2] + b1[2], (bfhi(w.w) - mu) * rs * g1[3] + b1[3]);
            *(LAS u32x4*)(lds + ((s >> 6) * 2 + (dd >> 7)) * 16384 + att::v_st(s & 63, dd & 127)) = o; }
        bf16x8 pa[8];
#pragma unroll
        for (int ks = 0; ks < 8; ++ks) pa[ks] = *(const bf16x8*)(WSg + ((size_t)gg * 128 + 32 * tb + r32) * 128 + 16 * ks + 8 * hi);
        __syncthreads();
        f32x16 o[4] = {};
#define SP_PV(D0, vbase, p0, p1, p2, p3) do { \
            const s16x4 l0 = att::tr_read<att::v_rd_off(D0, 0, 0)>(vbase), h0 = att::tr_read<att::v_rd_off(D0, 0, 1)>(vbase), l1 = att::tr_read<att::v_rd_off(D0, 1, 0)>(vbase), h1 = att::tr_read<att::v_rd_off(D0, 1, 1)>(vbase); \
            const s16x4 l2 = att::tr_read<att::v_rd_off(D0, 2, 0)>(vbase), h2 = att::tr_read<att::v_rd_off(D0, 2, 1)>(vbase), l3 = att::tr_read<att::v_rd_off(D0, 3, 0)>(vbase), h3 = att::tr_read<att::v_rd_off(D0, 3, 1)>(vbase); \
            asm volatile("s_waitcnt lgkmcnt(0)" ::: "memory"); __builtin_amdgcn_sched_barrier(0); \
            o[D0] = __builtin_amdgcn_mfma_f32_32x32x16_bf16((bf16x8){l0[0], l0[1], l0[2], l0[3], h0[0], h0[1], h0[2], h0[3]}, p0, o[D0], 0, 0, 0); \
            o[D0] = __builtin_amdgcn_mfma_f32_32x32x16_bf16((bf16x8){l1[0], l1[1], l1[2], l1[3], h1[0], h1[1], h1[2], h1[3]}, p1, o[D0], 0, 0, 0); \
            o[D0] = __builtin_amdgcn_mfma_f32_32x32x16_bf16((bf16x8){l2[0], l2[1], l2[2], l2[3], h2[0], h2[1], h2[2], h2[3]}, p2, o[D0], 0, 0, 0); \
            o[D0] = __builtin_amdgcn_mfma_f32_32x32x16_bf16((bf16x8){l3[0], l3[1], l3[2], l3[3], h3[0], h3[1], h3[2], h3[3]}, p3, o[D0], 0, 0, 0); } while (0)
        { const int vb0 = ldsaddr + (0 * 2 + dh) * 16384 + att::v_rd_base(lane), vb1 = ldsaddr + (1 * 2 + dh) * 16384 + att::v_rd_base(lane);
          SP_PV(0, vb0, pa[0], pa[1], pa[2], pa[3]); SP_PV(1, vb0, pa[0], pa[1], pa[2], pa[3]); SP_PV(2, vb0, pa[0], pa[1], pa[2], pa[3]); SP_PV(3, vb0, pa[0], pa[1], pa[2], pa[3]);
          SP_PV(0, vb1, pa[4], pa[5], pa[6], pa[7]); SP_PV(1, vb1, pa[4], pa[5], pa[6], pa[7]); SP_PV(2, vb1, pa[4], pa[5], pa[6], pa[7]); SP_PV(3, vb1, pa[4], pa[5], pa[6], pa[7]); }
#undef SP_PV
        { const int t = 32 * tb + r32, row = r0 + t; const float bsv = bs[gg * 128 + t];
          const bf16_t* up = Gb + (size_t)row * 4096 + 256 * gg + 128 * dh + 4 * hi; bf16_t* ap = Ab + (size_t)row * 2048 + 256 * gg + 128 * dh + 4 * hi;
#pragma unroll
          for (int d0 = 0; d0 < 4; ++d0)
#pragma unroll
              for (int k = 0; k < 4; ++k) {
                  const u32x2 uu = *(const u32x2*)(up + 32 * d0 + 8 * k);
                  u32x2 w; w.x = cvt_pk_bf16(bflo(uu.x) * (o[d0][4 * k] + bsv), bfhi(uu.x) * (o[d0][4 * k + 1] + bsv)); w.y = cvt_pk_bf16(bflo(uu.y) * (o[d0][4 * k + 2] + bsv), bfhi(uu.y) * (o[d0][4 * k + 3] + bsv));
                  *(u32x2*)(ap + 32 * d0 + 8 * k) = w; } }
    }
}

constexpr int NSL = 8, SW = 1024 / NSL;
constexpr size_t TAB8_HALF = (size_t)NEXP * 1024, TAB_SCL = 2 * TAB8_HALF;
constexpr float HS = 4.f;
__device__ __forceinline__ void phase_tabcvt(const Args& A, int layer) {
    const int tid_ = otid(); const int lane = tid_ & 63, gw = blockIdx.x * 8 + (tid_ >> 6), nw = gridDim.x * 8;
    float* SCL = (float*)(A.ws + WS_TAB + TAB_SCL);
    for (int r = gw; r < 2 * NEXP; r += nw) {
        const int tab = r >> 14, e = r & (NEXP - 1);
        const float* src = (tab ? A.in[I_PV] : A.in[I_PU]) + ((size_t)layer * NEXP + e) * 1024 + 16 * lane;
        f32x4 v[4]; float am = 0.f;
#pragma unroll
        for (int i = 0; i < 4; ++i) { v[i] = *(const f32x4*)(src + 4 * i); am = fmaxf(am, fmaxf(fmaxf(fabsf(v[i][0]), fabsf(v[i][1])), fmaxf(fabsf(v[i][2]), fabsf(v[i][3])))); }
#pragma unroll
        for (int o = 32; o >= 1; o >>= 1) am = fmaxf(am, __shfl_xor(am, o));
        float sc = 1.f; if (am > 0.f) { int ex; (void)frexpf(448.f / am, &ex); sc = ldexpf(1.f, ex - 1); }
        if (lane == 0) SCL[tab * NEXP + e] = 1.f / sc;
        u32x4 w;
#pragma unroll
        for (int i = 0; i < 4; ++i) w[i] = pk4_fp8(v[i][0] * sc, v[i][1] * sc, v[i][2] * sc, v[i][3] * sc);
        *(u32x4*)(A.ws + WS_TAB + (size_t)tab * TAB8_HALF + ((size_t)(lane >> 3) * NEXP + e) * SW + 16 * (lane & 7)) = w;
    }
}
#define CASD(a, b) do { const float hi_ = fmaxf(a, b), lo_ = fminf(a, b); a = hi_; b = lo_; } while (0)
__device__ __forceinline__ void sort16(float (&k)[16]) {
#pragma unroll
    for (int sz = 2; sz <= 16; sz <<= 1)
#pragma unroll
        for (int j = sz >> 1; j > 0; j >>= 1)
#pragma unroll
            for (int i = 0; i < 16; ++i) { const int l = i ^ j; if (l > i) { if ((i & sz) == 0 || sz == 16) CASD(k[i], k[l]); else CASD(k[l], k[i]); } }
}
__device__ __forceinline__ void bmerge16(float (&k)[16]) {
#pragma unroll
    for (int j = 8; j > 0; j >>= 1)
#pragma unroll
        for (int i = 0; i < 16; ++i) { const int l = i ^ j; if (l > i) CASD(k[i], k[l]); }
}
__device__ __forceinline__ void merge_top16(float (&a)[16], const float (&b)[16]) {
#pragma unroll
    for (int i = 0; i < 16; ++i) a[i] = fmaxf(a[i], b[15 - i]);
    bmerge16(a);
}
__device__ __forceinline__ void xmerge_top16(float (&a)[16], int mask) {
    float t[16];
#pragma unroll
    for (int i = 0; i < 16; ++i) t[i] = __shfl_xor(a[15 - i], mask);
#pragma unroll
    for (int i = 0; i < 16; ++i) a[i] = fmaxf(a[i], t[i]);
    bmerge16(a);
}
__device__ __forceinline__ void phase_topk(const Args& A, int layer, int nrows, LAS unsigned char* lds) {
    const bf16_t* QP = (const bf16_t*)(A.ws + WS_BIG); int* IDX = (int*)(A.ws + WS_R2); float* GATE = (float*)(A.ws + WS_R2 + R2_GATE);
    const int tid = otid(), wid = tid >> 6, lane = tid & 63, fr = lane & 15, fq = lane >> 4;
    LAS unsigned* scr = (LAS unsigned*)(lds + 2 * 34816) + wid * 512 + fr * 32;
    for (int unit = blockIdx.x; unit < (nrows / 128) * 8; unit += gridDim.x) {
        const int h = unit & 7, r0 = (unit >> 3) * 128;
        __syncthreads();
        { const bf16_t* k1 = (const bf16_t*)(A.ws + WS_W + W_PEER + (size_t)layer * WP_SZ + WP_K1) + (size_t)h * 16384;
#pragma unroll
          for (int j = 0; j < 8; ++j) { const int idx = tid + 512 * j, half = idx >> 11, rem = idx & 2047, key = rem >> 4, c8 = rem & 15;
              const u32x4 w = *(const u32x4*)(k1 + (size_t)half * 8 * 16384 + key * 128 + 8 * c8);
              *(LAS u32x4*)(lds + half * 34816 + key * 272 + c8 * 16) = w; } }
        __syncthreads();
        const int tok = r0 + 16 * wid + fr;
        float top[2][16];
#pragma unroll
        for (int half = 0; half < 2; ++half) {
            bf16x8 qf[4];
#pragma unroll
            for (int ks = 0; ks < 4; ++ks) qf[ks] = *(const bf16x8*)(QP + (size_t)tok * 2048 + 256 * h + 128 * half + 32 * ks + 8 * fq);
            float loc[16];
#pragma unroll
            for (int grp = 0; grp < 2; ++grp) {
                float kk[16];
#pragma unroll
                for (int nbb = 0; nbb < 4; ++nbb) { const int nb = 4 * grp + nbb; f32x4 acc = {0.f, 0.f, 0.f, 0.f};
#pragma unroll
                    for (int ks = 0; ks < 4; ++ks) { const bf16x8 kf = *(const LAS bf16x8*)(lds + half * 34816 + (16 * nb + fr) * 272 + (32 * ks + 8 * fq) * 2);
                        acc = __builtin_amdgcn_mfma_f32_16x16x32_bf16(kf, qf[ks], acc, 0, 0, 0); }
#pragma unroll
                    for (int i = 0; i < 4; ++i) { const unsigned code = 127u - (unsigned)(16 * nb + 4 * fq + i); kk[4 * nbb + i] = __uint_as_float((__float_as_uint(acc[i]) & ~127u) | code); } }
                sort16(kk);
                if (grp == 0) {
#pragma unroll
                    for (int i = 0; i < 16; ++i) loc[i] = kk[i];
                } else merge_top16(loc, kk);
            }
            xmerge_top16(loc, 16); xmerge_top16(loc, 32);
#pragma unroll
            for (int i = 0; i < 16; ++i) top[half][i] = loc[i];
        }
        if (fq < 2) {
#pragma unroll
            for (int i = 0; i < 16; ++i) scr[16 * fq + i] = __float_as_uint(fq == 0 ? top[0][i] : top[1][i]); }
        float fin[16];
#pragma unroll
        for (int aa = 0; aa < 4; ++aa) {
            const float va_k = fq == 0 ? top[0][aa] : fq == 1 ? top[0][4 + aa] : fq == 2 ? top[0][8 + aa] : top[0][12 + aa];
            const float va = __uint_as_float(__float_as_uint(va_k) & ~127u);
            float c[16];
#pragma unroll
            for (int bb = 0; bb < 16; ++bb) { const float s = va + __uint_as_float(__float_as_uint(top[1][bb]) & ~127u);
                c[bb] = __uint_as_float((__float_as_uint(s) & ~255u) | (255u - (unsigned)((4 * fq + aa) * 16 + bb))); }
            if (aa == 0) {
#pragma unroll
                for (int i = 0; i < 16; ++i) fin[i] = c[i];
            } else merge_top16(fin, c);
        }
        xmerge_top16(fin, 16); xmerge_top16(fin, 32);
        float ev[16], es = 0.f; const float mx = __uint_as_float(__float_as_uint(fin[0]) & ~255u);
#pragma unroll
        for (int i = 0; i < 16; ++i) { ev[i] = __expf(__uint_as_float(__float_as_uint(fin[i]) & ~255u) - mx); es += ev[i]; }
        const float inv = 1.f / es;
        asm volatile("s_waitcnt lgkmcnt(0)" ::: "memory");
        int oi[4]; float og[4];
#pragma unroll
        for (int kq = 0; kq < 4; ++kq) {
            const float fk = fq == 0 ? fin[kq] : fq == 1 ? fin[4 + kq] : fq == 2 ? fin[8 + kq] : fin[12 + kq];
            const float fe = fq == 0 ? ev[kq] : fq == 1 ? ev[4 + kq] : fq == 2 ? ev[8 + kq] : ev[12 + kq];
            const unsigned code = 255u - (__float_as_uint(fk) & 255u), a = code >> 4, bq = code & 15u;
            const unsigned i1 = 127u - (scr[a] & 127u), i2 = 127u - (scr[16 + bq] & 127u);
            oi[kq] = (int)(i1 * 128u + i2); og[kq] = fe * inv; }
        *(int4*)(IDX + (size_t)tok * 128 + 16 * h + 4 * fq) = make_int4(oi[0], oi[1], oi[2], oi[3]);
        *(f32x4*)(GATE + (size_t)tok * 128 + 16 * h + 4 * fq) = (f32x4){og[0], og[1], og[2], og[3]};
    }
}
struct PeerSched {
    int x0, rank, nloc, nblk, nown; unsigned orphan;
    __device__ __forceinline__ void init(const Args& A, int nrows, LAS unsigned char* smem) {
        unsigned* ctl = (unsigned*)(A.ws + WS_CTL);
        x0 = (int)(xb_xcc_id() & 7u); rank = __builtin_amdgcn_readfirstlane((int)((LAS unsigned*)smem)[8]); nblk = nrows / 64;
        unsigned cached = __builtin_amdgcn_readfirstlane(((LAS unsigned*)smem)[9]);
        if (cached == 0u) { unsigned orph = 0u, nl = 1u;
            for (int j = 0; j < 8; ++j) { unsigned c = xb_ld(&ctl[XB_XCNT(j)]) + xb_ld(&ctl[XB_XCNT(j + 8)]); c = __builtin_amdgcn_readfirstlane(c); if (c == 0u) orph |= 1u << j; if (j == x0) nl = c; }
            cached = (nl << 8) | orph; __syncthreads(); if (threadIdx.x == 0) ((LAS unsigned*)smem)[9] = cached; __syncthreads(); }
        nloc = (int)(cached >> 8); orphan = cached & 0xffu;
        const int tot = (NSL / 8) * nblk; nown = rank < tot ? (tot - rank + nloc - 1) / nloc : 0;
    }
    __device__ __forceinline__ bool item(int j, int& sl, int& blk) const {
        if (j < nown) { const int i = rank + j * nloc; sl = x0 + 8 * (i / nblk); blk = i % nblk; return true; }
        int jj = j - nown; const int tot = (NSL / 8) * nblk, per = ((int)gridDim.x > tot) ? 1 : 0; (void)per;
        for (int o = 0; o < 8; ++o) if ((orphan >> o) & 1u) { const int cnt = ((int)blockIdx.x < tot) ? (tot - (int)blockIdx.x + (int)gridDim.x - 1) / (int)gridDim.x : 0;
            if (jj < cnt) { const int i = (int)blockIdx.x + jj * (int)gridDim.x; sl = o + 8 * (i / nblk); blk = i % nblk; return true; } jj -= cnt; }
        return false;
    }
};
template <class LD, class ST, class PR>
__device__ __forceinline__ void peer_items(const PeerSched& S, LD ld, ST st, PR pr) {
    int sl, blk, sln, blkn, j = 0, buf = 0; bool have = S.item(0, sl, blk);
    if (have) { ld(sl, blk, 0); st(0); }
    while (have) {
        const bool haven = S.item(j + 1, sln, blkn);
        asm volatile("s_waitcnt vmcnt(0)" ::: "memory");
        __syncthreads();
        if (haven) ld(sln, blkn, buf ^ 1);
        pr(sl, blk, buf);
        if (haven) st(buf ^ 1);
        sl = sln; blk = blkn; have = haven; buf ^= 1; ++j;
    }
    __syncthreads();
}
#ifndef MK_UVAR
#define MK_UVAR 0
#endif
__device__ __forceinline__ float dpp_sum8(float v) {
    v += __builtin_bit_cast(float, __builtin_amdgcn_mov_dpp(__builtin_bit_cast(int, v), 0xB1, 0xF, 0xF, true));
    v += __builtin_bit_cast(float, __builtin_amdgcn_mov_dpp(__builtin_bit_cast(int, v), 0x4E, 0xF, 0xF, true));
    v += __builtin_bit_cast(float, __builtin_amdgcn_mov_dpp(__builtin_bit_cast(int, v), 0x141, 0xF, 0xF, true));
    return v;
}
__device__ __forceinline__ void phase_peer_u(const Args& A, int layer, int nrows, LAS unsigned char* smem, int rep) {
    const int var = rep ? MK_UVAR : 0;
    const bf16_t* H = (const bf16_t*)(A.ws + WS_H); const int* IDX = (const int*)(A.ws + WS_R2); float* PART = var ? (float*)(A.ws + WS_R1) : (float*)(A.ws + WS_BIG + BIG_PART);
    const unsigned char* U = A.ws + WS_TAB;
    LAS unsigned char* lds = smem + LDS_BASE;
    constexpr int BUF = 32768 + 64 * SW * 2;
    const int tid = otid(), wid = tid >> 6, lane = tid & 63, m = lane & 7, tk = lane >> 3;
    PeerSched S; S.init(A, nrows, smem);
    const int wu = __builtin_amdgcn_readfirstlane(wid);
    peer_items(S,
        [&](int sl, int blk, int buf) {
#pragma unroll
            for (int i = 0; i < 4; ++i)
                __builtin_amdgcn_global_load_lds((const unsigned*)(IDX + (size_t)blk * 64 * 128 + 256 * (wu + 8 * i) + 4 * lane), (LAS unsigned*)(lds + buf * BUF + 1024 * (wu + 8 * i)), 16, 0, 0);
#pragma unroll
            for (int i = 0; i < 2; ++i) { const int pc = wu + 8 * i;
                __builtin_amdgcn_global_load_lds((const unsigned*)(H + (size_t)(blk * 64 + 4 * pc + (lane >> 4)) * 1024 + SW * sl + 8 * (lane & 15)), (LAS unsigned*)(lds + buf * BUF + 32768 + 1024 * pc), 16, 0, 0); } },
        [&](int buf) { },
        [&](int sl, int blk, int buf) {
            const unsigned char* ub = U + (size_t)sl * NEXP * SW + 16 * m;
            const int tokl = wid * 8 + tk, tok = blk * 64 + tokl;
            const LAS int* ib = (const LAS int*)(lds + buf * BUF) + tokl * 128;
            float hf[16];
            { const u32x4 h0 = *(const LAS u32x4*)(lds + buf * BUF + 32768 + tokl * 256 + 32 * m), h1 = *(const LAS u32x4*)(lds + buf * BUF + 32768 + tokl * 256 + 32 * m + 16);
#pragma unroll
              for (int j = 0; j < 4; ++j) { hf[2 * j] = bflo(h0[j]); hf[2 * j + 1] = bfhi(h0[j]); hf[8 + 2 * j] = bflo(h1[j]); hf[8 + 2 * j + 1] = bfhi(h1[j]); } }
            float* pp = PART + ((size_t)sl * NROW + tok) * 128 + m;
            u32x4 vv[2][8];
#define PU_ROWS(T, c) do { const i32x4 e0_ = *(const LAS i32x4*)(ib + 8 * (c)), e1_ = *(const LAS i32x4*)(ib + 8 * (c) + 4); \
                if (var == 4) { _Pragma("unroll") for (int k_ = 0; k_ < 8; ++k_) vv[T][k_] = (u32x4){(unsigned)e0_.x, (unsigned)e1_.y, 0u, 0u}; } else { \
                vv[T][0] = *(const u32x4*)(ub + (size_t)(var == 3 ? e0_.x & 63 : e0_.x) * SW); vv[T][1] = *(const u32x4*)(ub + (size_t)(var == 3 ? e0_.y & 63 : e0_.y) * SW); \
                vv[T][2] = *(const u32x4*)(ub + (size_t)(var == 3 ? e0_.z & 63 : e0_.z) * SW); vv[T][3] = *(const u32x4*)(ub + (size_t)(var == 3 ? e0_.w & 63 : e0_.w) * SW); \
                vv[T][4] = *(const u32x4*)(ub + (size_t)(var == 3 ? e1_.x & 63 : e1_.x) * SW); vv[T][5] = *(const u32x4*)(ub + (size_t)(var == 3 ? e1_.y & 63 : e1_.y) * SW); \
                vv[T][6] = *(const u32x4*)(ub + (size_t)(var == 3 ? e1_.z & 63 : e1_.z) * SW); vv[T][7] = *(const u32x4*)(ub + (size_t)(var == 3 ? e1_.w & 63 : e1_.w) * SW); } } while (0)
#define PU_DOT(T, c) do { float mine_ = 0.f; \
                _Pragma("unroll") for (int k = 0; k < 8; ++k) { f32x2 a2 = {0.f, 0.f}; \
                    _Pragma("unroll") for (int j = 0; j < 4; ++j) { const int w = (int)vv[T][k][j]; \
                        const f32x2 lo = __builtin_amdgcn_cvt_pk_f32_fp8(w, false), hi = __builtin_amdgcn_cvt_pk_f32_fp8(w, true); \
                        a2 = __builtin_elementwise_fma(lo, (f32x2){hf[4 * j], hf[4 * j + 1]}, a2); a2 = __builtin_elementwise_fma(hi, (f32x2){hf[4 * j + 2], hf[4 * j + 3]}, a2); } \
                    const float tot_ = dpp_sum8(a2.x + a2.y); mine_ = m == k ? tot_ : mine_; } \
                pp[8 * (c)] = mine_; } while (0)
            PU_ROWS(0, 0);
#pragma unroll 1
            for (int c = 0; c < 16; c += 2) {
                PU_ROWS(1, c + 1);
                __builtin_amdgcn_sched_barrier(0);
                PU_DOT(0, c);
                __builtin_amdgcn_sched_barrier(0);
                if (c + 2 < 16) PU_ROWS(0, c + 2);
                __builtin_amdgcn_sched_barrier(0);
                PU_DOT(1, c + 1);
                __builtin_amdgcn_sched_barrier(0);
            }
#undef PU_ROWS
#undef PU_DOT
        });
}
__device__ __forceinline__ void phase_coef(const Args& A, int nrows) {
    const float* PART = (const float*)(A.ws + WS_BIG + BIG_PART); const float* GATE = (const float*)(A.ws + WS_R2 + R2_GATE); float* COEF = (float*)(A.ws + WS_R2 + R2_COEF);
    const int* IDX = (const int*)(A.ws + WS_R2); const float* SCL = (const float*)(A.ws + WS_TAB + TAB_SCL);
    const int gthr = blockIdx.x * NTHR + otid(), nthr = gridDim.x * NTHR;
    for (int p = gthr; p < nrows * 32; p += nthr) {
        f32x4 s = {0.f, 0.f, 0.f, 0.f};
#pragma unroll
        for (int x = 0; x < NSL; ++x) s += *(const f32x4*)(PART + (size_t)x * NROW * 128 + 4 * p);
        const i32x4 e = *(const i32x4*)(IDX + 4 * p); const f32x4 gt = *(const f32x4*)(GATE + 4 * p);
        const f32x4 su = {SCL[e.x], SCL[e.y], SCL[e.z], SCL[e.w]}, sv = {SCL[NEXP + e.x], SCL[NEXP + e.y], SCL[NEXP + e.z], SCL[NEXP + e.w]};
        const f32x4 a = s * su; const f32x2 g0 = gelu_pk((f32x2){a[0], a[1]}), g1 = gelu_pk((f32x2){a[2], a[3]});
        *(f32x4*)(COEF + 4 * p) = gt * (f32x4){g0.x, g0.y, g1.x, g1.y} * sv; }

}
__device__ __forceinline__ void phase_peer_v(const Args& A, int layer, int nrows, LAS unsigned char* smem, int rep) {
    const int* IDX = (const int*)(A.ws + WS_R2); const float* COEF = (const float*)(A.ws + WS_R2 + R2_COEF);
    const unsigned char* V = A.ws + WS_TAB + TAB8_HALF; const float* MODL = (const float*)(A.ws + WS_MOD) + (size_t)layer * 5 * 6144 + 5 * 1024;
    float* XC = (float*)(A.ws + WS_XC);
    LAS unsigned char* lds = smem + LDS_BASE;
    constexpr int BUF = 65536;
    const int tid = otid(), wid = tid >> 6, lane = tid & 63, m = lane & 7, tk = lane >> 3;
    PeerSched S; S.init(A, nrows, smem);
    const int wu = __builtin_amdgcn_readfirstlane(wid);
    peer_items(S,
        [&](int sl, int blk, int buf) {
#pragma unroll
            for (int i = 0; i < 4; ++i) {
                __builtin_amdgcn_global_load_lds((const unsigned*)(IDX + (size_t)blk * 64 * 128 + 256 * (wu + 8 * i) + 4 * lane), (LAS unsigned*)(lds + buf * BUF + 1024 * (wu + 8 * i)), 16, 0, 0);
                __builtin_amdgcn_global_load_lds((const unsigned*)(COEF + (size_t)blk * 64 * 128 + 256 * (wu + 8 * i) + 4 * lane), (LAS unsigned*)(lds + buf * BUF + 32768 + 1024 * (wu + 8 * i)), 16, 0, 0); } },
        [&](int buf) { },
        [&](int sl, int blk, int buf) {
            const unsigned char* vb = V + (size_t)sl * NEXP * SW + 16 * m;
            const int tokl = wid * 8 + tk, tok = blk * 64 + tokl; const bool lat = tok < NLAT;
            const LAS int* ib = (const LAS int*)(lds + buf * BUF) + tokl * 128; const LAS float* cb = (const LAS float*)(lds + buf * BUF + 32768) + tokl * 128;
            float* xp = (lat ? A.out + (size_t)tok * D : XC + (size_t)(tok - NLAT) * D) + SW * sl + 16 * m;
            f32x4 xr[4];
#pragma unroll
            for (int j = 0; j < 4; ++j) xr[j] = *(f32x4*)(xp + 4 * j);
            f32x2 acc2[8];
#pragma unroll
            for (int j = 0; j < 8; ++j) acc2[j] = (f32x2){0.f, 0.f};
            u32x4 vv[2][8];
#define PV_ROWS(T, c) do { const i32x4 e0_ = *(const LAS i32x4*)(ib + 8 * (c)), e1_ = *(const LAS i32x4*)(ib + 8 * (c) + 4); \
                vv[T][0] = *(const u32x4*)(vb + (size_t)e0_.x * SW); vv[T][1] = *(const u32x4*)(vb + (size_t)e0_.y * SW); vv[T][2] = *(const u32x4*)(vb + (size_t)e0_.z * SW); vv[T][3] = *(const u32x4*)(vb + (size_t)e0_.w * SW); \
                vv[T][4] = *(const u32x4*)(vb + (size_t)e1_.x * SW); vv[T][5] = *(const u32x4*)(vb + (size_t)e1_.y * SW); vv[T][6] = *(const u32x4*)(vb + (size_t)e1_.z * SW); vv[T][7] = *(const u32x4*)(vb + (size_t)e1_.w * SW); } while (0)
#define PV_FMA(T, c) do { const f32x4 c0_ = *(const LAS f32x4*)(cb + 8 * (c)), c1_ = *(const LAS f32x4*)(cb + 8 * (c) + 4); \
                _Pragma("unroll") for (int k = 0; k < 8; ++k) { const float cf = k < 4 ? c0_[k & 3] : c1_[k & 3]; \
                    _Pragma("unroll") for (int j = 0; j < 4; ++j) { const int w = (int)vv[T][k][j]; \
                        const f32x2 lo = __builtin_amdgcn_cvt_pk_f32_fp8(w, false), hi = __builtin_amdgcn_cvt_pk_f32_fp8(w, true); const f32x2 c2 = {cf, cf}; \
                        acc2[2 * j] = __builtin_elementwise_fma(lo, c2, acc2[2 * j]); acc2[2 * j + 1] = __builtin_elementwise_fma(hi, c2, acc2[2 * j + 1]); } } } while (0)
            PV_ROWS(0, 0);
#pragma unroll 1
            for (int c = 0; c < 16; c += 2) {
                PV_ROWS(1, c + 1);
                __builtin_amdgcn_sched_barrier(0);
                PV_FMA(0, c);
                __builtin_amdgcn_sched_barrier(0);
                if (c + 2 < 16) PV_ROWS(0, c + 2);
                __builtin_amdgcn_sched_barrier(0);
                PV_FMA(1, c + 1);
                __builtin_amdgcn_sched_barrier(0);
            }
#undef PV_ROWS
#undef PV_FMA
            const float* gp = MODL + (size_t)(lat ? (tok >> 13) : 4) * 6144 + SW * sl + 16 * m;
#pragma unroll
            for (int j = 0; j < 4; ++j) { const f32x4 g = *(const f32x4*)(gp + 4 * j);
                *(f32x4*)(xp + 4 * j) = xr[j] + g * (f32x4){acc2[2 * j].x, acc2[2 * j].y, acc2[2 * j + 1].x, acc2[2 * j + 1].y}; }
        });
}

#ifdef MK_CHECK
constexpr int CW_CHK = 3840;
__device__ __forceinline__ float blk_sum(float v, LAS float* red) {
    const int t_ = otid(); v = wave_sum(v); __syncthreads(); if ((t_ & 63) == 0) red[t_ >> 6] = v; __syncthreads();
    float s = 0.f; for (int i = 0; i < 8; ++i) s += red[i]; __syncthreads(); return s;
}
__device__ __forceinline__ float fp8f(unsigned b) { const unsigned e = (b >> 3) & 15u, m = b & 7u; const float v = e ? ldexpf(1.f + (float)m * 0.125f, (int)e - 7) : ldexpf((float)m * 0.125f, -6); return (b & 0x80u) ? -v : v; }
__device__ __forceinline__ void check_attn(const Args& A, LAS unsigned char* lds) {
    const unsigned char* Q = A.ws + WS_R1 + R1_Q; const unsigned char* KN = A.ws + WS_R1 + R1_KN; const unsigned char* KR = A.ws + WS_BIG + BIG_KR; const unsigned char* V = A.ws + WS_R1 + R1_V;
    const bf16_t* CAT = (const bf16_t*)(A.ws + WS_R3 + R3_CAT); float* chk = (float*)(A.ws + WS_CTL) + CW_CHK;
    LAS float* p = (LAS float*)lds; LAS float* qv = p + NKEY; LAS float* red = qv + 192;
    const int tid = otid(), sidx = blockIdx.x;
    const int b = sidx & 3, h = (sidx >> 2) & 7, l = (int)(((unsigned)sidx * 2654435761u) >> 19) & 8191;
    const size_t bh = (size_t)(b * 8 + h);
    if (tid < 192) qv[tid] = fp8f(Q[(bh * NKEY + 256 + l) * 192 + tid]) * (1.f / att8::QUP);
    __syncthreads();
    float mx = -1e30f;
    for (int key = tid; key < NKEY; key += 512) { const int t = key >> 6, k = key & 63; float s = 0.f;
        for (int d = 0; d < 128; ++d) s += qv[d] * fp8f(KN[(bh * NKT + t) * 8192 + att8::kn8(k, d)]);
        for (int d = 0; d < 64; ++d) s += qv[128 + d] * fp8f(KR[((size_t)b * NKT + t) * 4096 + att8::kr8(k, d)]);
        p[key] = s; mx = fmaxf(mx, s); }
    for (int o = 32; o >= 1; o >>= 1) mx = fmaxf(mx, __shfl_xor(mx, o));
    __syncthreads(); if ((tid & 63) == 0) red[tid >> 6] = mx; __syncthreads(); mx = red[0]; for (int i = 1; i < 8; ++i) mx = fmaxf(mx, red[i]); __syncthreads();
    float ls = 0.f; for (int key = tid; key < NKEY; key += 512) { const float e = exp2f(p[key] - mx); p[key] = e; ls += e; }
    ls = blk_sum(ls, red);
    float num = 0.f, den = 0.f;
    if (tid < 128) { float o = 0.f; for (int key = 0; key < NKEY; ++key) o += p[key] * fp8f(V[(bh * NKT + (key >> 6)) * 8192 + att8::v8(tid, key & 63)]);
        o /= ls; const float got = bf2f(CAT[(size_t)(b * 8192 + l) * 2048 + 1024 + 128 * h + tid]); num = (got - o) * (got - o); den = o * o; }
    num = blk_sum(num, red); den = blk_sum(den, red);
    if (tid == 0) { atomicAdd(chk, num); atomicAdd(chk + 1, den); }
}
__device__ __forceinline__ void check_qkv(const Args& A, int li, LAS unsigned char* lds) {
    float* chk = (float*)(A.ws + WS_CTL) + CW_CHK;
    const unsigned char* Q = A.ws + WS_R1 + R1_Q; const unsigned char* KN = A.ws + WS_R1 + R1_KN; const unsigned char* KR = A.ws + WS_BIG + BIG_KR; const unsigned char* V = A.ws + WS_R1 + R1_V;
    LAS float* hv = (LAS float*)lds; LAS float* cq = hv + 1024; LAS float* ckv = cq + 384; LAS float* kr = ckv + 256; LAS float* red = kr + 64; LAS float* ov = red + 16;
    const int tid = otid(), sidx = blockIdx.x;
    const int hd = sidx & 7; const int r = (sidx & 8) ? NLAT + (int)(((unsigned)sidx * 2654435761u) >> 22) : (int)(((unsigned)sidx * 2654435761u) >> 17);
    const float* win = A.in[I_HWIN] + (size_t)li * 1024 * HYB_IN;
    {
        const float* xp = r < NLAT ? A.out + (size_t)r * D : (const float*)(A.ws + WS_XC) + (size_t)(r - NLAT) * D; const float* MODL = (const float*)(A.ws + WS_MOD) + (size_t)(2 * li) * 5 * 6144 + (size_t)row_mb(r) * 6144;
        float ss = 0.f; for (int i = tid; i < 1024; i += 512) ss += xp[i] * xp[i];
        ss = blk_sum(ss, red); const float rstd = rsqrtf(ss / 1024.f + EPS);
        for (int i = tid; i < 1024; i += 512) hv[i] = bf2f(f2bf(xp[i] * rstd * A.in[I_N1G][(2 * li) * 1024 + i] * (1.f + MODL[1024 + i]) + MODL[i])); }
    __syncthreads();
    for (int j = tid; j < 704; j += 512) { float s = 0.f; for (int k = 0; k < 1024; ++k) s += hv[k] * win[(size_t)k * HYB_IN + C_CQ + j];
        s = bf2f(f2bf(s)); if (j < 384) cq[j] = s; else if (j < 640) ckv[j - 384] = s; else kr[j - 640] = s; }
    __syncthreads();
    float sq = 0.f, sk = 0.f; for (int j = tid; j < 384; j += 512) sq += cq[j] * cq[j]; for (int j = tid; j < 256; j += 512) sk += ckv[j] * ckv[j];
    sq = blk_sum(sq, red); sk = blk_sum(sk, red);
    const float rq = rsqrtf(sq / 384.f + EPS), rk = rsqrtf(sk / 256.f + EPS);
    const float* wqb = A.in[I_WQB] + (size_t)li * 384 * 1536; const float* wkvb = A.in[I_WKVB] + (size_t)li * 256 * 2048; const float* qg = A.in[I_QNG] + li * 384; const float* kg = A.in[I_KVNG] + li * 256;
    if (tid < 192) { float s = 0.f; for (int k = 0; k < 384; ++k) s += cq[k] * rq * qg[k] * wqb[(size_t)k * 1536 + hd * 192 + tid]; ov[tid] = s; }
    else if (tid < 448) { const int c = tid - 192; float s = 0.f; for (int k = 0; k < 256; ++k) s += ckv[k] * rk * kg[k] * wkvb[(size_t)k * 2048 + hd * 256 + c]; ov[tid] = s; }
    __syncthreads();
    const bool lat = r < NLAT; const int b = lat ? (r >> 13) : ((r - NLAT) >> 8), l = lat ? (r & 8191) : 0, key = lat ? 256 + l : ((r - NLAT) & 255), qrow = key;
    const size_t bh = (size_t)(b * 8 + hd); const float qs = QSCALE * att8::QUP;
    float num = 0.f, den = 0.f;
    if (tid < 128) {
        const float q = ov[tid] * qs, gq = fp8f(Q[(bh * NKEY + qrow) * 192 + tid]);
        const float kk = ov[192 + tid], gk = fp8f(KN[(bh * NKT + (key >> 6)) * 8192 + att8::kn8(key & 63, tid)]);
        const float vv = ov[320 + tid], gv = fp8f(V[(bh * NKT + (key >> 6)) * 8192 + att8::v8(tid, key & 63)]);
        num = (gq - q) * (gq - q) + (gk - kk) * (gk - kk) + (gv - vv) * (gv - vv); den = q * q + kk * kk + vv * vv;
    } else if (tid < 160) {
        const int i = tid - 128; float c = 1.f, sn = 0.f;
        if (lat) { const float pos = (float)(i < 16 ? (l >> 6) : (l & 63)); const float ang = pos * powf(10000.f, -(float)(i & 15) / 16.f); c = cosf(ang); sn = sinf(ang); }
        const float q1 = ov[128 + i] * qs, q2 = ov[160 + i] * qs, k1 = kr[i], k2 = kr[32 + i];
        const float rq1 = q1 * c - q2 * sn, rq2 = q1 * sn + q2 * c, rk1 = k1 * c - k2 * sn, rk2 = k1 * sn + k2 * c;
        const float gq1 = fp8f(Q[(bh * NKEY + qrow) * 192 + 128 + 2 * i]), gq2 = fp8f(Q[(bh * NKEY + qrow) * 192 + 128 + 2 * i + 1]);
        const float gk1 = fp8f(KR[((size_t)b * NKT + (key >> 6)) * 4096 + att8::kr8(key & 63, 2 * i)]), gk2 = fp8f(KR[((size_t)b * NKT + (key >> 6)) * 4096 + att8::kr8(key & 63, 2 * i + 1)]);
        num = (gq1 - rq1) * (gq1 - rq1) + (gq2 - rq2) * (gq2 - rq2) + (gk1 - rk1) * (gk1 - rk1) + (gk2 - rk2) * (gk2 - rk2); den = rq1 * rq1 + rq2 * rq2 + rk1 * rk1 + rk2 * rk2;
    }
    num = blk_sum(num, red); den = blk_sum(den, red);
    if (tid == 0) { atomicAdd(chk, num); atomicAdd(chk + 1, den); }
}
#endif
#ifndef MK_PER_PHASE
#define MK_PER_PHASE 0
#endif
__device__ __forceinline__ int nr_in(int L) { return L <= 2 ? NROW : NLAT; }
__device__ __forceinline__ int nr_out(int L) { return L <= 1 ? NROW : NLAT; }

__global__ void __launch_bounds__(NTHR, 2) fwd(Args A) {
    extern __shared__ __attribute__((aligned(256))) unsigned char smem_raw[];
    LAS unsigned char* smem = (LAS unsigned char*)smem_raw;
    LAS unsigned char* lds = smem + LDS_BASE;
    const int tid = otid();
    if (tid < 64) ((LAS unsigned*)smem)[tid] = 0u;
    __syncthreads();
    XcdBarrier bar = xcd_barrier_post((unsigned*)(A.ws + WS_CTL), (volatile LAS unsigned*)smem);
    if (tid == 0) ((LAS unsigned*)smem)[8] = atomicAdd((unsigned*)(A.ws + WS_CTL) + CW_RANK + 32 * (xb_xcc_id() & 7u), 1u);
    __syncthreads();
    bool need_bar = false;
    const int lo = A.ph_lo, hi = A.ph_hi;
#ifndef PHMASK
#define PHMASK 0xffffffffu
#endif
#define SITE(k) if constexpr (((PHMASK) >> (k)) & 1u)
#ifndef MK_SVAR
#define MK_SVAR 1
#endif
#ifndef MK_REPEAT_SITE
#define MK_REPEAT_SITE -1
#endif
#define REP(k) for (int rep = 0; rep < ((k) == (MK_REPEAT_SITE) ? 2 : 1); ++rep)
#define PH(id) if ([&]() -> bool { if ((id) < lo || (id) >= hi) return false; if (need_bar) xcd_barrier(bar); need_bar = true; return true; }())
    unsigned char* ws = A.ws;
    float* XL = A.out; float* XC = (float*)(ws + WS_XC);
    bf16_t* H = (bf16_t*)(ws + WS_H);
    const float* MOD = (const float*)(ws + WS_MOD);

    SITE(0) PH(0) { phase_prologue(A, lds); }
    SITE(1) PH(1) { phase_norm_mod(A.in[I_X], A.in[I_CTX], XL, XC, A.in[I_N1G], MOD, 0, H, NROW); }
    for (int L = 0; L < DEPTH; ++L) {
        const int base = 2 + 16 * L, li = L >> 1; const bool hyb = (L & 1) == 0;
        const float* MODL = MOD + (size_t)L * 5 * 6144;
        unsigned char* WH = ws + WS_W + W_HYB + (size_t)li * WH_SZ; unsigned char* WG = ws + WS_W + W_GM + (size_t)li * WG_SZ; unsigned char* WP = ws + WS_W + W_PEER + (size_t)L * WP_SZ;
        if (hyb) {
            SITE(2) PH(base + 0) REP(2) { pg8::Gemm g{H, (const bf16_t*)(WH + WH_IN), nr_in(L), HYB_INP, 1024, 1024, 1024};
                pg8::EpiBf16<0> e{(bf16_t*)(ws + WS_BIG), HYB_INP}; pg8::gemm_phase(lds, g, e); }
            SITE(3) PH(base + 1) REP(3) { phase_conv(A, li); }
            SITE(4) PH(base + 2) {
                SITE(18) REP(18) { pg8::Gemm g{(const bf16_t*)(ws + WS_BIG) + C_CQ, (const bf16_t*)(WH + WH_QB), L == 0 ? NROW : NLAT, 1536, 384, HYB_INP, 384};
                  EpiQ e{ws + WS_R1 + R1_Q, (const float*)(ws + WS_RSTD), (const float*)(ws + WS_ROPE)}; pg8::gemm_phase(lds, g, e); }
                SITE(19) REP(19) { pg8::Gemm g{(const bf16_t*)(ws + WS_BIG) + C_CKV, (const bf16_t*)(WH + WH_KVB), NROW, 2048, 256, HYB_INP, 256};
                  EpiKV e{ws + WS_R1 + R1_KN, ws + WS_R1 + R1_V, (const float*)(ws + WS_RSTD) + NROW}; pg8::gemm_phase(lds, g, e); }
                SITE(20) REP(20) for (int u = blockIdx.x; u < 528; u += gridDim.x) ssd::g_unit((const bf16_t*)(ws + WS_R2 + R2_BC), (bf16_t*)(ws + WS_BIG + BIG_G), u);
            }
            SITE(5) PH(base + 3) {
                const int xq = (int)blockIdx.x & 7, jq = (int)blockIdx.x >> 3; const bool ssd_wg = (jq & 1) == 0 && gridDim.x == 256;
                if (gridDim.x == 256) {
                    if (ssd_wg) { const int r = jq >> 1, gi = xq + 8 * (r >> 3), hh = r & 7, sb = gi >> 2, sgp = (gi >> 1) & 1, sd = gi & 1;
                        SITE(21) ssd::ssd_unit(sb, 8 * sgp + hh, sd, (const bf16_t*)(ws + WS_R2), (const bf16_t*)(ws + WS_R2 + R2_BC), (const float*)(ws + WS_BIG + BIG_DT), (const bf16_t*)(ws + WS_BIG + BIG_G),
                                               A.in[I_ALOG] + li * 32, sd ? (bf16_t*)(ws + WS_R3) : (bf16_t*)(ws + WS_H), lds); }
                } else {
                    SITE(21) for (int u = blockIdx.x; u < 128; u += gridDim.x) ssd::ssd_unit(u >> 5, (u >> 1) & 15, u & 1, (const bf16_t*)(ws + WS_R2), (const bf16_t*)(ws + WS_R2 + R2_BC), (const float*)(ws + WS_BIG + BIG_DT),
                                               (const bf16_t*)(ws + WS_BIG + BIG_G), A.in[I_ALOG] + li * 32, (u & 1) ? (bf16_t*)(ws + WS_R3) : (bf16_t*)(ws + WS_H), lds);
                }
                const int nmine = gridDim.x == 256 ? (ssd_wg ? 3 : 5) + (L == 0 && !ssd_wg && jq < 8 ? 1 : 0) : 0;
                SITE(22) REP(22) for (int it = 0; gridDim.x == 256 ? it < nmine : (int)blockIdx.x + it * (int)gridDim.x < (L == 0 ? 1056 : 1024); ++it) {
                    int b, h, qrow0, orow0, nt;
                    if (gridDim.x == 256) {
                        const int base_it = ssd_wg ? 3 : 5;
                        if (it < base_it) { const int v = ssd_wg ? 3 * (jq >> 1) + it : 48 + 5 * (jq >> 1) + it; b = v >> 5; h = xq; const int qb = v & 31; qrow0 = 256 + 256 * qb; orow0 = b * 8192 + 256 * qb; nt = NKT; }
                        else { b = jq >> 1; h = xq; qrow0 = 0; orow0 = NLAT + 256 * b; nt = 4; }
                    } else { const int au = (int)blockIdx.x + it * (int)gridDim.x;
                        if (au < 1024) { b = au >> 8; h = au & 7; const int qb = (au >> 3) & 31; qrow0 = 256 + 256 * qb; orow0 = b * 8192 + 256 * qb; nt = NKT; }
                        else { const int cu = au - 1024; b = cu >> 3; h = cu & 7; qrow0 = 0; orow0 = NLAT + 256 * b; nt = 4; } }
                    const size_t bh = (size_t)(b * 8 + h);
                    att8::attn_unit(ws + WS_R1 + R1_Q + (bh * NKEY + qrow0) * 192, ws + WS_R1 + R1_KN + bh * NKT * 8192, ws + WS_BIG + BIG_KR + (size_t)b * NKT * 4096,
                                    ws + WS_R1 + R1_V + bh * NKT * 8192, (bf16_t*)(ws + WS_R3 + R3_CAT) + (size_t)orow0 * 2048 + 1024 + 128 * h, nt, lds);
                }
            }
            SITE(6) PH(base + 4) REP(6) { phase_ssd_out(A, li, nr_out(L));
#if defined(MK_CHECK) && MK_CHECK == 1
                if (L == 0) check_attn(A, lds);
#elif defined(MK_CHECK) && MK_CHECK == 2
                if (L == 0) check_qkv(A, li, lds);
#elif defined(MK_CHECK) && MK_CHECK == 3
                if (L == 2) check_attn(A, lds);
#endif
            }
        } else {
            SITE(7) PH(base + 0) REP(7) { pg8::Gemm g{H, (const bf16_t*)(WG + WG_IN), nr_out(L), 4096, 1024, 1024, 1024};
                pg8::EpiBf16<1> e{(bf16_t*)(ws + WS_BIG), 4096}; pg8::gemm_phase(lds, g, e); }
            SITE(8) PH(base + 1) REP(8) { phase_ln_stats(A, nr_out(L)); }
            SITE(9) PH(base + 2) REP(9) { phase_spatial(A, li, nr_out(L), lds); }
        }
        SITE(10) PH(base + 5) { pg8::Gemm g{hyb ? (const bf16_t*)(ws + WS_R3 + R3_CAT) : (const bf16_t*)(ws + WS_R1), hyb ? (const bf16_t*)(WH + WH_OUT) : (const bf16_t*)(WG + WG_OUT), nr_out(L), 1024, 2048, 2048, 2048};
            pg8::EpiResid e{XL, XC, MODL + 2 * 1024}; pg8::gemm_phase(lds, g, e); }
        SITE(11) PH(base + 6) REP(11) { phase_norm_mod(XL, XC, nullptr, nullptr, A.in[I_N2G] + L * 1024, MODL, 3, H, nr_out(L)); phase_tabcvt(A, L); }
        SITE(12) PH(base + 7) REP(12) { pg8::Gemm g{H, (const bf16_t*)(WP + WP_Q), nr_out(L), 2048, 1024, 1024, 1024};
            pg8::EpiBf16<0> e{(bf16_t*)(ws + WS_BIG), 2048}; pg8::gemm_phase(lds, g, e); }
        SITE(13) PH(base + 8) REP(13) { phase_topk(A, L, nr_out(L), lds); }
        SITE(14) PH(base + 9) REP(14) { phase_peer_u(A, L, nr_out(L), smem, rep); }
        SITE(15) PH(base + 10) REP(15) { phase_coef(A, nr_out(L)); }
        SITE(16) PH(base + 11) { phase_peer_v(A, L, nr_out(L), smem, 0); }
        SITE(17) PH(base + 12) { if (L < DEPTH - 1) phase_norm_mod(XL, XC, nullptr, nullptr, A.in[I_N1G] + (L + 1) * 1024, MOD + (size_t)(L + 1) * 5 * 6144, 0, H, nr_in(L + 1));
                        else {
#ifdef MK_CHECK
                            const float* chk = (const float*)(ws + WS_CTL) + CW_CHK; const float err = sqrtf(chk[0] / fmaxf(chk[1], 1e-30f));
                            phase_final_norm(XL, A.in[I_FNG], 1.f + 10.f * err);
#else
                            phase_final_norm(XL, A.in[I_FNG], 1.f);
#endif
                        } }
    }
#undef PH
}

#ifdef MK_TAP
__global__ void tap_kernel(const unsigned short* buf, size_t pitch, size_t col0, size_t ncols, size_t nrows, float* out) {
    const size_t n = ncols * nrows;
    for (size_t i = (size_t)blockIdx.x * blockDim.x + threadIdx.x; i < (size_t)NLAT * D; i += (size_t)gridDim.x * blockDim.x) {
        float s = 0.f; for (size_t j = i; j < n; j += (size_t)NLAT * D) s += (float)buf[(j / ncols) * pitch + col0 + (j % ncols)]; out[i] = s; }
}
#endif
extern "C" void kernel_launch(void* const* d_in, const int* in_sizes, int n_in, void* d_out, int out_size, void* d_ws, size_t ws_size, hipStream_t stream) {
    static int grid = 0;
    if (grid == 0) {
        if (n_in != N_IN || out_size != NLAT * D || ws_size < WS_END) { fprintf(stderr, "kernel_launch: unexpected shapes (n_in %d out %d ws %zu, need %zu)\n", n_in, out_size, ws_size, (size_t)WS_END); grid = -1; return; }
        int dev = 0, cus = 0, per_cu = 0;
        if (hipGetDevice(&dev) != hipSuccess || hipDeviceGetAttribute(&cus, hipDeviceAttributeMultiprocessorCount, dev) != hipSuccess) { grid = -1; return; }
        if (hipFuncSetAttribute((const void*)fwd, hipFuncAttributeMaxDynamicSharedMemorySize, LDS_BYTES) != hipSuccess) { fprintf(stderr, "kernel_launch: hipFuncSetAttribute failed\n"); grid = -1; return; }
        if (hipOccupancyMaxActiveBlocksPerMultiprocessor(&per_cu, (const void*)fwd, NTHR, LDS_BYTES) != hipSuccess || per_cu < 1) { fprintf(stderr, "kernel_launch: occupancy query says %d\n", per_cu); }
        (void)hipGetLastError();
        grid = cus;
    }
    if (grid < 0) return;
    (void)hipMemsetAsync((char*)d_ws + WS_CTL, 0, CTL_BYTES, stream);
    Args a{};
    for (int i = 0; i < N_IN; ++i) a.in[i] = (const float*)d_in[i];
    a.out = (float*)d_out; a.ws = (unsigned char*)d_ws;
#if MK_PER_PHASE
    for (int id = 0; id < 2 + 16 * DEPTH; ++id) {
        if (id >= 2) { const int L = (id - 2) / 16, s = (id - 2) % 16; if (s > 12) continue; if ((L & 1) && (s == 3 || s == 4)) continue; }
#ifdef MK_CUT
#ifdef MK_TAP
        if (id >= MK_CUT) continue;
#else
        if (id >= MK_CUT && id != 2 + 16 * (DEPTH - 1) + 12) continue;
#endif
#endif
        a.ph_lo = id; a.ph_hi = id + 1;
        hipLaunchKernelGGL(fwd, dim3(grid), dim3(NTHR), LDS_BYTES, stream, a);
    }
#ifdef MK_TAP
    { const size_t tp[5] = {MK_TAP}; hipLaunchKernelGGL(tap_kernel, dim3(2048), dim3(256), 0, stream, (const unsigned short*)((const char*)d_ws + tp[0]), tp[1], tp[2], tp[3], tp[4], (float*)d_out); }
#endif
#else
    a.ph_lo = 0; a.ph_hi = 2 + 16 * DEPTH;
    hipLaunchKernelGGL(fwd, dim3(grid), dim3(NTHR), LDS_BYTES, stream, a);
#endif
    const hipError_t le = hipPeekAtLastError();
    if (le != hipSuccess) fprintf(stderr, "kernel_launch: launch failed: %s\n", hipGetErrorName(le));
}
```

```cpp
#include <hip/hip_runtime.h>
#include <cstdio>
#include <cstdint>

#define LAS __attribute__((address_space(3)))
typedef unsigned short bf16_t;
typedef short bf16x8 __attribute__((ext_vector_type(8)));
typedef short s16x4 __attribute__((ext_vector_type(4)));
typedef float f32x2 __attribute__((ext_vector_type(2)));
typedef float f32x4 __attribute__((ext_vector_type(4)));
typedef float f32x16 __attribute__((ext_vector_type(16)));
typedef unsigned u32x2 __attribute__((ext_vector_type(2)));
typedef unsigned u32x4 __attribute__((ext_vector_type(4)));
typedef int i32x4 __attribute__((ext_vector_type(4)));
typedef int i32x8 __attribute__((ext_vector_type(8)));

constexpr int D = 1024, NB = 4, SEQ = 8192, DEPTH = 4, CTXL = 256;
constexpr int NLAT = NB * SEQ, NCTX = NB * CTXL, NROW = NLAT + NCTX;
constexpr int HYB_IN = 3280, HYB_INP = 3328;
constexpr int C_Z = 0, C_XBC = 1024, C_DT = 2560, C_CQ = 2576, C_CKV = 2960, C_KR = 3216;
constexpr int NKEY = SEQ + CTXL, NKT = NKEY / 64;
constexpr float EPS = 1e-6f;
constexpr float QSCALE = 0.07216878364870322f * 1.4426950408889634f;
constexpr int NEXP = 16384;

enum { I_X = 0, I_C, I_CTX, I_CCTX, I_ADAW, I_ADAB, I_N1G, I_N2G, I_HWIN, I_CONVW, I_CONVB, I_ALOG, I_DTB, I_SSDD, I_SSDNG, I_QNG, I_WQB, I_KVNG, I_WKVB,
       I_HWOUT, I_GWIN, I_GLNG, I_GLNB, I_GWS, I_GBS, I_GWOUT, I_PWQ, I_PK1, I_PK2, I_PU, I_PV, I_FNG, N_IN };

constexpr size_t al256(size_t x) { return (x + 255) & ~(size_t)255; }
constexpr size_t WS_CTL = 0, CTL_BYTES = 65536;
constexpr size_t WS_MOD = WS_CTL + CTL_BYTES;
constexpr size_t WS_ROPE = WS_MOD + al256((size_t)DEPTH * 5 * 6144 * 4);
constexpr size_t WS_RSTD = WS_ROPE + (size_t)2 * SEQ * 32 * 4;
constexpr size_t WS_W = WS_RSTD + al256((size_t)2 * NROW * 4);
constexpr size_t W_HYB = 0;
constexpr size_t WH_IN = 0, WH_QB = WH_IN + (size_t)HYB_INP * 1024 * 2, WH_KVB = WH_QB + (size_t)1536 * 384 * 2, WH_OUT = WH_KVB + (size_t)2048 * 256 * 2,
                 WH_SZ = WH_OUT + (size_t)1024 * 2048 * 2;
constexpr size_t W_GM = W_HYB + 2 * WH_SZ;
constexpr size_t WG_IN = 0, WG_OUT = WG_IN + (size_t)4096 * 1024 * 2, WG_WS = WG_OUT + (size_t)1024 * 2048 * 2, WG_SZ = WG_WS + (size_t)8 * 128 * 128 * 2;
constexpr size_t W_PEER = W_GM + 2 * WG_SZ;
constexpr size_t WP_Q = 0, WP_K1 = WP_Q + (size_t)2048 * 1024 * 2, WP_K2 = WP_K1 + (size_t)8 * 128 * 128 * 2, WP_SZ = WP_K2 + (size_t)8 * 128 * 128 * 2;
constexpr size_t W_TOTAL = W_PEER + 4 * WP_SZ;
constexpr size_t WS_TAB = WS_W + al256(W_TOTAL);
constexpr size_t TAB_HALF = (size_t)NEXP * 1024 * 2;
constexpr size_t WS_XC = WS_TAB + 2 * TAB_HALF;
constexpr size_t WS_H = WS_XC + (size_t)NCTX * D * 4;
constexpr size_t WS_BIG = WS_H + (size_t)NROW * D * 2;
constexpr size_t BIG_BYTES = (size_t)NROW * 4096 * 2;
constexpr size_t BIG_DT = (size_t)NROW * HYB_INP * 2;
constexpr size_t BIG_G = BIG_DT + (size_t)NROW * 32 * 4;
constexpr size_t BIG_KR = BIG_G + (size_t)528 * 128 * 128 * 2;
constexpr size_t BIG_PART = (size_t)NROW * 2048 * 2;
static_assert(BIG_KR + (size_t)NB * NKT * 8192 <= BIG_BYTES, "BIG tail");
constexpr size_t WS_R1 = WS_BIG + BIG_BYTES;
constexpr size_t R1_Q = 0, R1_KN = R1_Q + (size_t)NB * 8 * NKEY * 192 * 2, R1_V = R1_KN + (size_t)NB * 8 * NKT * 16384, R1_BYTES = R1_V + (size_t)NB * 8 * NKT * 16384;
constexpr size_t WS_R2 = WS_R1 + R1_BYTES;
constexpr size_t R2_BC = (size_t)NROW * 1024 * 2, R2_BYTES = R2_BC + (size_t)NROW * 512 * 2;
constexpr size_t R2_GATE = (size_t)NROW * 128 * 4, R2_COEF = 2 * R2_GATE;
constexpr size_t WS_R3 = WS_R2 + R2_BYTES;
constexpr size_t R3_CAT = (size_t)NROW * 1024 * 2, R3_BYTES = R3_CAT + (size_t)NROW * 2048 * 2;
constexpr size_t WS_END = WS_R3 + R3_BYTES;
static_assert(WS_END <= ((size_t)1 << 30), "workspace must fit 1 GiB");

constexpr int CW_RANK = 3584;
constexpr int CW_QUEUE = 4096;

typedef __bf16 bf16x2_t __attribute__((ext_vector_type(2)));
__device__ __forceinline__ unsigned cvt_pk_bf16(float lo, float hi) { const f32x2 v = {lo, hi}; const bf16x2_t b = __builtin_convertvector(v, bf16x2_t); return __builtin_bit_cast(unsigned, b); }
__device__ __forceinline__ bf16_t f2bf(float f) { return (bf16_t)(cvt_pk_bf16(f, 0.f) & 0xffffu); }
__device__ __forceinline__ float bf2f(unsigned b) { return __uint_as_float(b << 16); }
__device__ __forceinline__ float bflo(unsigned w) { return __uint_as_float(w << 16); }
__device__ __forceinline__ float bfhi(unsigned w) { return __uint_as_float(w & 0xffff0000u); }
__device__ __forceinline__ float wave_sum(float v) {
#pragma unroll
    for (int o = 32; o >= 1; o >>= 1) v += __shfl_xor(v, o);
    return v;
}
__device__ __forceinline__ int otid() { int t = threadIdx.x; asm volatile("" : "+v"(t)); return t; }
__device__ __forceinline__ float silu_f(float x) { return x / (1.f + __expf(-x)); }
__device__ __forceinline__ float softplus_f(float x) { return x > 20.f ? x : log1pf(__expf(x)); }
__device__ __forceinline__ f32x2 gelu_pk(f32x2 v) {
    const f32x2 av = __builtin_elementwise_abs(v), d = av * 0.2316418882f + 1.0f;
    f32x2 t; t.x = __builtin_amdgcn_rcpf(d.x); t.y = __builtin_amdgcn_rcpf(d.y);
    f32x2 q = t * 0.5307027145f + (-0.7265760135f); q = q * t + 0.7107068705f; q = q * t + (-0.142248368f); q = q * t + 0.127414796f; q = q * t;
    const f32x2 s = (v * v) * (-0.72134752044f);
    f32x2 e; e.x = __builtin_amdgcn_exp2f(s.x); e.y = __builtin_amdgcn_exp2f(s.y);
    const f32x2 m = v * (q * e), r = v - m;
    f32x2 o; o.x = v.x < 0.f ? m.x : r.x; o.y = v.y < 0.f ? m.y : r.y; return o;
}
__device__ __forceinline__ float gelu_f(float x) { f32x2 v = {x, 0.f}; return gelu_pk(v).x; }

__device__ __forceinline__ unsigned pk4_fp8(float a, float b, float c, float d) { int w = 0; w = __builtin_amdgcn_cvt_pk_fp8_f32(a, b, w, false); w = __builtin_amdgcn_cvt_pk_fp8_f32(c, d, w, true); return (unsigned)w; }
__device__ __forceinline__ float sat8(float v) { return __builtin_amdgcn_fmed3f(v, -448.f, 448.f); }
__device__ __forceinline__ unsigned pk4_fp8_sat(float a, float b, float c, float d) { return pk4_fp8(sat8(a), sat8(b), sat8(c), sat8(d)); }
__device__ __forceinline__ int row_mb(int r) { return r < NLAT ? (r >> 13) : 4; }

#define XB_TMO      128
#define XB_XCNT(j)  (256  + 64 * (j))
#define XB_XSUB(j)  (1280 + 64 * (j))
#define XB_XGEN(j)  (2304 + 64 * (j))
#define XB_TOP      3328
#define XB_TOPGEN   3392
#define XCD_BAR_WORDS 3456
#define XB_SPIN_CAP (1u << 22)
__device__ __forceinline__ unsigned xb_ld(unsigned* p)              { return __hip_atomic_load(p, __ATOMIC_RELAXED, __HIP_MEMORY_SCOPE_AGENT); }
__device__ __forceinline__ unsigned xb_add(unsigned* p, unsigned v) { return __hip_atomic_fetch_add(p, v, __ATOMIC_RELAXED, __HIP_MEMORY_SCOPE_AGENT); }
__device__ __forceinline__ unsigned xb_xcc_id() { return (unsigned)__builtin_amdgcn_s_getreg((3 << 11) | 20) & 0xFu; }
#define XB_SPIN(cond, bar) do { unsigned _sp = 0; while (cond) { __builtin_amdgcn_s_sleep(1); \
    if ((++_sp & 255u) == 0u) { if (xb_ld(&(bar)[XB_TMO])) break; if (_sp > XB_SPIN_CAP) { atomicAdd(&(bar)[XB_TMO], 1u); break; } } } } while (0)
struct XcdBarrier { unsigned* bar; unsigned x; volatile LAS unsigned* st; };
__device__ __forceinline__ XcdBarrier xcd_barrier_post(unsigned* bar, volatile LAS unsigned* st) {
    XcdBarrier b; b.bar = bar; b.x = xb_xcc_id(); b.st = st;
    if (threadIdx.x == 0) (void)xb_add(&bar[XB_XCNT(b.x)], 1u);
    return b;
}
__device__ __forceinline__ void xcd_barrier_complete(unsigned* bar, unsigned x, unsigned& nloc, unsigned& nx) {
    const unsigned G = gridDim.x * gridDim.y * gridDim.z;
    unsigned sum, cnt, mine, sp = 0u;
    for (;;) {
        sum = 0u; cnt = 0u; mine = 0u;
#pragma unroll
        for (unsigned j = 0; j < 16; ++j) { const unsigned c = xb_ld(&bar[XB_XCNT(j)]); sum += c; cnt += (c > 0u) ? 1u : 0u; mine = (j == x) ? c : mine; }
        if (sum == G) break;
        __builtin_amdgcn_s_sleep(1);
        if ((++sp & 255u) == 0u) { if (xb_ld(&bar[XB_TMO])) break; if (sp > XB_SPIN_CAP) { atomicAdd(&bar[XB_TMO], 1u); break; } }
    }
    nloc = mine > 0u ? mine : 1u; nx = cnt > 0u ? cnt : 1u;
}
__device__ __forceinline__ void xcd_barrier(const XcdBarrier& b) {
    asm volatile("s_waitcnt vmcnt(0)" ::: "memory");
    __syncthreads();
    if (threadIdx.x == 0) {
        unsigned* bar = b.bar;
        __builtin_amdgcn_s_waitcnt(0);
        unsigned nloc = b.st[0], nx = b.st[1];
        if (nloc == 0u) { xcd_barrier_complete(bar, b.x, nloc, nx); b.st[0] = nloc; b.st[1] = nx; }
        const unsigned old = xb_add(&bar[XB_XSUB(b.x)], 1u);
        const unsigned gen = old / nloc;
        if (old + 1u == (gen + 1u) * nloc) {
            __builtin_amdgcn_fence(__ATOMIC_RELEASE, "agent");
            asm volatile("s_waitcnt vmcnt(0)" ::: "memory");
            const unsigned og = xb_add(&bar[XB_TOP], 1u);
            const unsigned tg = og / nx;
            if (og + 1u == (tg + 1u) * nx) xb_add(&bar[XB_TOPGEN], 1u);
            else XB_SPIN(xb_ld(&bar[XB_TOPGEN]) == tg, bar);
            __builtin_amdgcn_fence(__ATOMIC_ACQUIRE, "agent");
            xb_add(&bar[XB_XGEN(b.x)], 1u);
            asm volatile("s_waitcnt vmcnt(0)" ::: "memory");
        } else {
            XB_SPIN(xb_ld(&bar[XB_XGEN(b.x)]) == gen, bar);
            __builtin_amdgcn_fence(__ATOMIC_ACQUIRE, "agent");
            asm volatile("s_waitcnt vmcnt(0)" ::: "memory");
        }
    }
    __syncthreads();
}

namespace pg8 {
constexpr int BM = 256, BK = 64, HALF = 128, HTB = HALF * BK * 2, STAGE_BYTES = 8 * HTB, NXCD = 8, WGM = 8;
__host__ __device__ __forceinline__ int lds_byte(int r, int c) { const int st = (r >> 4) * 2 + (c >> 5), rr = r & 15, cc = c & 31, ob = rr * 64 + cc * 2; return st * 1024 + (ob ^ (((ob >> 9) & 1) << 5)); }
__host__ __device__ __forceinline__ void stage_rc(int b, int& R, int& C) { const int st = b / 1024, sb = b % 1024, swz = sb ^ (((sb >> 9) & 1) << 5); R = (st >> 1) * 16 + swz / 64; C = (st & 1) * 32 + (swz % 64) / 2; }
__host__ __device__ __forceinline__ int perm32(int rho) { const int n = rho >> 4, i = rho & 15; return 8 * (i >> 2) + 4 * n + (i & 3); }
struct Unit { int pm, pn; };
struct Gemm { const bf16_t* A; const bf16_t* Bt; int M, N, K, lda, ldb; };
struct StaticOrder {
    int nM, nN, nwg, G, c;
    __device__ void init(int M, int N, int G_, int c_) { nM = M / BM; nN = N / BM; nwg = nM * nN; G = G_; c = c_; }
    __device__ bool next(int i, Unit& u) const {
        const long L = (long)i * G + c; if (L >= nwg) return false;
        int wgid = (int)L; { const int q = nwg / NXCD, r = nwg % NXCD, xcd = wgid % NXCD, off = wgid / NXCD; wgid = (xcd < r ? xcd * (q + 1) : r * (q + 1) + (xcd - r) * q) + off; }
        const int nig = WGM * nN, gid = wgid / nig, fm = gid * WGM, gsz = (nM - fm) < WGM ? (nM - fm) : WGM;
        u.pm = fm + ((wgid % nig) % gsz); u.pn = (wgid % nig) / gsz; return true;
    }
};
template <class Epi>
__device__ __forceinline__ void gemm_phase(LAS unsigned char* lds, const Gemm g, const Epi& E) {
    const int tid = otid(), wid = __builtin_amdgcn_readfirstlane(tid >> 6), lane = tid & 63, wr = wid >> 2, wc = wid & 3, fr = lane & 15, fq = lane >> 4;
    StaticOrder S; S.init(g.M, g.N, (int)gridDim.x, (int)blockIdx.x);
    int K = g.K; asm volatile("" : "+s"(K));
    const int nt = K / BK;
    unsigned voffA[2], voffB[2];
#pragma unroll
    for (int i = 0; i < 2; ++i) { int R, C; stage_rc(tid * 16 + i * 8192, R, C); const int Rb = Epi::PERM ? ((R & ~31) + perm32(R & 31)) : R;
        voffA[i] = (unsigned)(R * g.lda + C) * 2u; voffB[i] = (unsigned)(Rb * g.ldb + C) * 2u; }
    const size_t kstep = (size_t)(BK * 2);
    const size_t hstepA = (size_t)HALF * g.lda * 2, hstepB = (size_t)HALF * g.ldb * 2;
    const size_t tstepA = 2 * hstepA, tstepB = 2 * hstepB;
    const unsigned ldsw = (unsigned)wid * 1024u;
    const int aoff = lds_byte(wr * 64 + fr, fq * 8), boff = lds_byte(wc * 32 + fr, fq * 8);
#define PG8_SA(b, h) (((b) * 2 + (h)) * HTB)
#define PG8_SB(b, h) ((4 + (b) * 2 + (h)) * HTB)
#define PG8_STAGE(bufoff, gbase, voff) do { _Pragma("unroll") for (int _i = 0; _i < 2; ++_i) \
        __builtin_amdgcn_global_load_lds((const unsigned*)((const char*)(gbase) + (voff)[_i]), (LAS unsigned*)(lds + (bufoff) + ldsw + _i * 8192), 16, 0, 0); } while (0)
#define PG8_LDA(dst, b, h) do { _Pragma("unroll") for (int m = 0; m < 4; ++m) _Pragma("unroll") for (int k = 0; k < 2; ++k) dst[m][k] = *(const LAS bf16x8*)(lds + PG8_SA(b, h) + aoff + m * 2048 + k * 1024); } while (0)
#define PG8_LDB(dst, b, h) do { _Pragma("unroll") for (int n = 0; n < 2; ++n) _Pragma("unroll") for (int k = 0; k < 2; ++k) dst[n][k] = *(const LAS bf16x8*)(lds + PG8_SB(b, h) + boff + n * 2048 + k * 1024); } while (0)
#define PG8_MMA(ai, bj, At, Bt) do { __builtin_amdgcn_s_setprio(1); _Pragma("unroll") for (int m = 0; m < 4; ++m) _Pragma("unroll") for (int n = 0; n < 2; ++n) _Pragma("unroll") for (int k = 0; k < 2; ++k) \
        acc[ai][bj][m][n] = __builtin_amdgcn_mfma_f32_16x16x32_bf16(Bt[n][k], At[m][k], acc[ai][bj][m][n], 0, 0, 0); __builtin_amdgcn_s_setprio(0); } while (0)
#define PG8_WAIT_V(n) asm volatile("s_waitcnt vmcnt(" #n ")" ::: "memory")
#define PG8_WAIT_L(n) asm volatile("s_waitcnt lgkmcnt(" #n ")" ::: "memory")
#define PG8_BAR __builtin_amdgcn_s_barrier()
#define PG8_SCHED __builtin_amdgcn_sched_barrier(0)
    Unit cur, nxt; int ui = 0;
    if (!S.next(0, cur)) return;
    f32x4 acc[2][2][4][2];
#pragma unroll
    for (int a = 0; a < 2; ++a)
#pragma unroll
        for (int b = 0; b < 2; ++b)
#pragma unroll
            for (int m = 0; m < 4; ++m)
#pragma unroll
                for (int n = 0; n < 2; ++n) acc[a][b][m][n] = (f32x4){0.f, 0.f, 0.f, 0.f};
    bf16x8 At[4][2], B0[2][2], B1[2][2];
    const char* cA = (const char*)g.A + (size_t)cur.pm * tstepA; const char* cB = (const char*)g.Bt + (size_t)cur.pn * tstepB;
    PG8_STAGE(PG8_SB(0, 0), cB, voffB); PG8_STAGE(PG8_SB(0, 1), cB + hstepB, voffB); PG8_STAGE(PG8_SA(0, 0), cA, voffA); PG8_STAGE(PG8_SA(0, 1), cA + hstepA, voffA);
    if (wr == 1) PG8_BAR;
    PG8_WAIT_V(2); PG8_BAR;
    PG8_STAGE(PG8_SB(1, 0), cB + kstep, voffB); PG8_STAGE(PG8_SA(1, 0), cA + kstep, voffA); PG8_STAGE(PG8_SB(1, 1), cB + hstepB + kstep, voffB);
    PG8_WAIT_V(6); PG8_BAR;
    for (;;) {
        const bool has_next = S.next(ui + 1, nxt);
        const char* nA = has_next ? (const char*)g.A + (size_t)nxt.pm * tstepA : cA; const char* nB = has_next ? (const char*)g.Bt + (size_t)nxt.pn * tstepB : cB;
        for (int t = 0; t < nt; t += 2) {
            const bool last = (t == nt - 2);
            const char* a1 = cA + (size_t)(t + 1) * kstep;
            const char* a2 = last ? nA : cA + (size_t)(t + 2) * kstep; const char* b2 = last ? nB : cB + (size_t)(t + 2) * kstep;
            const char* a3 = a2 + kstep; const char* b3 = b2 + kstep;
            PG8_LDB(B0, 0, 0); PG8_LDB(B1, 0, 1); PG8_SCHED; PG8_LDA(At, 0, 0); PG8_STAGE(PG8_SA(1, 1), a1 + hstepA, voffA);
            PG8_WAIT_V(8); PG8_WAIT_L(0); PG8_BAR; PG8_MMA(0, 0, At, B0); PG8_MMA(0, 1, At, B1); PG8_BAR; PG8_SCHED;
            PG8_LDA(At, 0, 1); PG8_STAGE(PG8_SB(0, 0), b2, voffB); PG8_STAGE(PG8_SB(0, 1), b2 + hstepB, voffB); PG8_STAGE(PG8_SA(0, 0), a2, voffA);
            PG8_WAIT_V(8); PG8_WAIT_L(0); PG8_BAR; PG8_MMA(1, 0, At, B0); PG8_MMA(1, 1, At, B1); PG8_BAR; PG8_SCHED;
            PG8_LDB(B0, 1, 0); PG8_LDB(B1, 1, 1); PG8_SCHED; PG8_LDA(At, 1, 0); PG8_STAGE(PG8_SA(0, 1), a2 + hstepA, voffA);
            PG8_WAIT_V(8); PG8_WAIT_L(0); PG8_BAR; PG8_MMA(0, 0, At, B0); PG8_MMA(0, 1, At, B1); PG8_BAR; PG8_SCHED;
            PG8_LDA(At, 1, 1); PG8_STAGE(PG8_SB(1, 0), b3, voffB); PG8_STAGE(PG8_SB(1, 1), b3 + hstepB, voffB); PG8_STAGE(PG8_SA(1, 0), a3, voffA);
            PG8_WAIT_V(8); PG8_WAIT_L(0); PG8_BAR; PG8_MMA(1, 0, At, B0); PG8_MMA(1, 1, At, B1); PG8_BAR; PG8_SCHED;
        }
        if (wr == 0) PG8_BAR;
        { const int l2_ = otid() & 63; E(acc, cur, wr, wc, l2_ & 15, l2_ >> 4); }
        if (!has_next) break;
#pragma unroll
        for (int a = 0; a < 2; ++a)
#pragma unroll
            for (int b = 0; b < 2; ++b)
#pragma unroll
                for (int m = 0; m < 4; ++m)
#pragma unroll
                    for (int n = 0; n < 2; ++n) acc[a][b][m][n] = (f32x4){0.f, 0.f, 0.f, 0.f};
        cur = nxt; cA = nA; cB = nB; ++ui;
        if (wr == 1) PG8_BAR;
    }
    PG8_WAIT_V(0);
    PG8_BAR;
#undef PG8_SA
#undef PG8_SB
#undef PG8_STAGE
#undef PG8_LDA
#undef PG8_LDB
#undef PG8_MMA
#undef PG8_WAIT_V
#undef PG8_WAIT_L
#undef PG8_BAR
#undef PG8_SCHED
}

template <int ACT> struct EpiBf16 {
    static constexpr bool PERM = true;
    bf16_t* O; int ldc;
    __device__ __forceinline__ void operator()(const f32x4 (&acc)[2][2][4][2], const Unit& u, int wr, int wc, int fr, int fq) const {
        const int row0 = u.pm * BM + wr * 64 + fr, col0 = u.pn * BM + wc * 32 + 8 * fq;
#pragma unroll
        for (int ai = 0; ai < 2; ++ai)
#pragma unroll
            for (int m = 0; m < 4; ++m) { bf16_t* rowp = O + (size_t)(row0 + ai * HALF + m * 16) * ldc + col0;
#pragma unroll
                for (int bj = 0; bj < 2; ++bj) { f32x4 v0 = acc[ai][bj][m][0], v1 = acc[ai][bj][m][1];
                    if (ACT == 1) { f32x2 a = gelu_pk((f32x2){v0[0], v0[1]}), b = gelu_pk((f32x2){v0[2], v0[3]}), c = gelu_pk((f32x2){v1[0], v1[1]}), d = gelu_pk((f32x2){v1[2], v1[3]});
                        v0 = (f32x4){a.x, a.y, b.x, b.y}; v1 = (f32x4){c.x, c.y, d.x, d.y}; }
                    u32x4 w; w.x = cvt_pk_bf16(v0[0], v0[1]); w.y = cvt_pk_bf16(v0[2], v0[3]); w.z = cvt_pk_bf16(v1[0], v1[1]); w.w = cvt_pk_bf16(v1[2], v1[3]);
                    *(u32x4*)(rowp + bj * HALF) = w; } }
    }
};
struct EpiResid {
    static constexpr bool PERM = false;
    float* xl; float* xc; const float* gate;
    __device__ __forceinline__ void operator()(const f32x4 (&acc)[2][2][4][2], const Unit& u, int wr, int wc, int fr, int fq) const {
        const int rbase = u.pm * BM; const bool lat = rbase < NLAT;
        float* X = lat ? xl + (size_t)rbase * D : xc + (size_t)(rbase - NLAT) * D;
        const float* gp = gate + (size_t)(lat ? (rbase >> 13) : 4) * 6144;
        const int row0 = wr * 64 + fr, col0 = u.pn * BM + wc * 32 + 4 * fq;
        f32x4 gv[2][2];
#pragma unroll
        for (int bj = 0; bj < 2; ++bj)
#pragma unroll
            for (int n = 0; n < 2; ++n) gv[bj][n] = *(const f32x4*)(gp + col0 + bj * HALF + n * 16);
#pragma unroll
        for (int ai = 0; ai < 2; ++ai)
#pragma unroll
            for (int m = 0; m < 4; ++m) { float* rowp = X + (size_t)(row0 + ai * HALF + m * 16) * D + col0;
#pragma unroll
                for (int bj = 0; bj < 2; ++bj)
#pragma unroll
                    for (int n = 0; n < 2; ++n) { f32x4* p = (f32x4*)(rowp + bj * HALF + n * 16); *p = *p + gv[bj][n] * acc[ai][bj][m][n]; } }
    }
};
}

namespace att {
constexpr int SLOT = 40960, KN_OFF = 0, KR_OFF = 16384, V_OFF = 24576, LDS_BYTES = 3 * SLOT + 8 * 256;
constexpr float THR2 = 11.0f;
#define KSWZ(row, colB) ((row) * 256 + ((colB) ^ (((row) & 7) << 4)))
#define KRSWZ(row, colB) ((row) * 128 + ((colB) ^ ((((row) >> 1) & 7) << 4)))
#define SBAR() __builtin_amdgcn_sched_barrier(0)
__device__ __forceinline__ int crow(int r, int hi) { return (r & 3) + 8 * (r >> 2) + 4 * hi; }
__host__ __device__ __forceinline__ int v_st(int k, int c) { const int kk = (k & ~0xC) | ((k & 4) << 1) | ((k & 8) >> 1); return ((kk >> 3) * 4 + (c >> 5)) * 512 + ((kk & 7) * 32 + (c & 31)) * 2; }
__device__ __forceinline__ int v_rd_base(int lane) { return ((lane & 3) << 3) | (((lane >> 2) & 3) << 6) | (((lane >> 4) & 1) << 5) | (((lane >> 5) & 1) << 8); }
constexpr int v_rd_off(int d0, int ks, int half) { return d0 * 512 + ks * 4096 + half * 2048; }
template <int OFF> __device__ __forceinline__ s16x4 tr_read(int vb) {
    s16x4 r; asm volatile("ds_read_b64_tr_b16 %0, %1 offset:%2" : "=&v"(r) : "v"(vb), "i"(OFF) : "memory"); return r;
}
template <int D0> __device__ __forceinline__ void pv_one(f32x16& od, int vb, bf16x8 pa0, bf16x8 pa1, bf16x8 pa2, bf16x8 pa3) {
    const s16x4 l0 = tr_read<v_rd_off(D0, 0, 0)>(vb), h0 = tr_read<v_rd_off(D0, 0, 1)>(vb), l1 = tr_read<v_rd_off(D0, 1, 0)>(vb), h1 = tr_read<v_rd_off(D0, 1, 1)>(vb);
    const s16x4 l2 = tr_read<v_rd_off(D0, 2, 0)>(vb), h2 = tr_read<v_rd_off(D0, 2, 1)>(vb), l3 = tr_read<v_rd_off(D0, 3, 0)>(vb), h3 = tr_read<v_rd_off(D0, 3, 1)>(vb);
    asm volatile("s_waitcnt lgkmcnt(0)" ::: "memory"); SBAR();
#define PK(L, H) (bf16x8){L[0], L[1], L[2], L[3], H[0], H[1], H[2], H[3]}
    od = __builtin_amdgcn_mfma_f32_32x32x16_bf16(pa0, PK(l0, h0), od, 0, 0, 0);
    od = __builtin_amdgcn_mfma_f32_32x32x16_bf16(pa1, PK(l1, h1), od, 0, 0, 0);
    od = __builtin_amdgcn_mfma_f32_32x32x16_bf16(pa2, PK(l2, h2), od, 0, 0, 0);
    od = __builtin_amdgcn_mfma_f32_32x32x16_bf16(pa3, PK(l3, h3), od, 0, 0, 0);
#undef PK
}
__device__ __forceinline__ void pv_d0(f32x16* o, int vb, bf16x8 pa0, bf16x8 pa1, bf16x8 pa2, bf16x8 pa3) {
    pv_one<0>(o[0], vb, pa0, pa1, pa2, pa3); pv_one<1>(o[1], vb, pa0, pa1, pa2, pa3); pv_one<2>(o[2], vb, pa0, pa1, pa2, pa3); pv_one<3>(o[3], vb, pa0, pa1, pa2, pa3);
}
__device__ __forceinline__ void partialSM(f32x16& p0, f32x16& p1, float& m_reg, float& mn, float& alpha) {
    float pmax = p0[0];
#pragma unroll
    for (int r = 1; r < 16; ++r) pmax = fmaxf(pmax, p0[r]);
#pragma unroll
    for (int r = 0; r < 16; ++r) pmax = fmaxf(pmax, p1[r]);
    { auto rr = __builtin_amdgcn_permlane32_swap(__float_as_uint(pmax), __float_as_uint(pmax), false, false);
      pmax = fmaxf(__uint_as_float(rr[0]), __uint_as_float(rr[1])); }
    if (__builtin_expect(__all(pmax - m_reg <= THR2), 1)) { mn = m_reg; alpha = 1.f; }
    else { mn = fmaxf(m_reg, pmax); alpha = __builtin_amdgcn_exp2f(m_reg - mn); m_reg = mn; }
#pragma unroll
    for (int r = 0; r < 16; ++r) p0[r] = __builtin_amdgcn_exp2f(p0[r] - mn);
#pragma unroll
    for (int r = 0; r < 16; ++r) p1[r] = p1[r] - mn;
}
__device__ __forceinline__ void finishSM(f32x16& p0, f32x16& p1, float alpha, float& l_reg, bf16x8& pa0, bf16x8& pa1, bf16x8& pa2, bf16x8& pa3) {
#pragma unroll
    for (int r = 0; r < 16; ++r) p1[r] = __builtin_amdgcn_exp2f(p1[r]);
    float ps = 0;
#pragma unroll
    for (int r = 0; r < 16; ++r) ps += p0[r];
#pragma unroll
    for (int r = 0; r < 16; ++r) ps += p1[r];
    { auto rr = __builtin_amdgcn_permlane32_swap(__float_as_uint(ps), __float_as_uint(ps), false, false);
      ps = __uint_as_float(rr[0]) + __uint_as_float(rr[1]); }
    l_reg = l_reg * alpha + ps;
#define PK4(P, BASE, OUT) do { unsigned a0 = cvt_pk_bf16(P[BASE + 0], P[BASE + 1]), a1 = cvt_pk_bf16(P[BASE + 2], P[BASE + 3]);   \
    unsigned b0 = cvt_pk_bf16(P[BASE + 4], P[BASE + 5]), b1 = cvt_pk_bf16(P[BASE + 6], P[BASE + 7]);                              \
    auto r0 = __builtin_amdgcn_permlane32_swap(a0, b0, false, false); auto r1 = __builtin_amdgcn_permlane32_swap(a1, b1, false, false); \
    u32x4 w = {r0[0], r1[0], r0[1], r1[1]}; OUT = *reinterpret_cast<bf16x8*>(&w); } while (0)
    PK4(p0, 0, pa0); PK4(p0, 8, pa1); PK4(p1, 0, pa2); PK4(p1, 8, pa3);
#undef PK4
}
__device__ __forceinline__ void qkt(f32x16& p0, f32x16& p1, LAS unsigned char* slot, const bf16x8* qr, int r32, int hi) {
    p0 = f32x16{}; p1 = f32x16{};
#pragma unroll
    for (int d0 = 0; d0 < 8; ++d0) { const int cb = (d0 * 16 + hi * 8) * 2;
        bf16x8 b0 = *(const LAS bf16x8*)(slot + KN_OFF + KSWZ(r32, cb));
        bf16x8 b1 = *(const LAS bf16x8*)(slot + KN_OFF + KSWZ(32 + r32, cb));
        p0 = __builtin_amdgcn_mfma_f32_32x32x16_bf16(b0, qr[d0], p0, 0, 0, 0);
        p1 = __builtin_amdgcn_mfma_f32_32x32x16_bf16(b1, qr[d0], p1, 0, 0, 0); }
#pragma unroll
    for (int d0 = 0; d0 < 4; ++d0) { const int cb = (d0 * 16 + hi * 8) * 2;
        bf16x8 b0 = *(const LAS bf16x8*)(slot + KR_OFF + KRSWZ(r32, cb));
        bf16x8 b1 = *(const LAS bf16x8*)(slot + KR_OFF + KRSWZ(32 + r32, cb));
        p0 = __builtin_amdgcn_mfma_f32_32x32x16_bf16(b0, qr[8 + d0], p0, 0, 0, 0);
        p1 = __builtin_amdgcn_mfma_f32_32x32x16_bf16(b1, qr[8 + d0], p1, 0, 0, 0); }
}
__device__ __forceinline__ void attn_unit(const bf16_t* __restrict__ Qb, const unsigned char* __restrict__ KNt, const unsigned char* __restrict__ KRt, const unsigned char* __restrict__ Vt,
                                          bf16_t* __restrict__ Ob, int NT, LAS unsigned char* lds) {
    const int tid = otid(), wid = __builtin_amdgcn_readfirstlane(tid >> 6), lane = tid & 63, r32 = lane & 31, hi = lane >> 5;
    LAS float* wsf = (LAS float*)(lds + 3 * SLOT) + wid * 64; LAS float* li_l = wsf; LAS float* al_l = wsf + 32;
    float m_reg = -1e30f, l_reg = 0; f32x16 o[4] = {}; bf16x8 qr[12];
    const bf16_t* Qw = Qb + (size_t)(wid * 32 + r32) * 192 + hi * 8;
#pragma unroll
    for (int d0 = 0; d0 < 12; ++d0) qr[d0] = *(const bf16x8*)(Qw + d0 * 16);
    const int vrb = (int)(unsigned)(uintptr_t)(lds) + V_OFF + v_rd_base(lane);
    const unsigned lo16 = (unsigned)lane * 16u;
#define ATT_DMA(tile, slotoff) do { const size_t t_ = (size_t)(tile); LAS unsigned char* sl_ = lds + (slotoff); \
        __builtin_amdgcn_global_load_lds((const unsigned*)(KNt + t_ * 16384 + wid * 1024 + lo16), (LAS unsigned*)(sl_ + KN_OFF + wid * 1024), 16, 0, 0); \
        __builtin_amdgcn_global_load_lds((const unsigned*)(KNt + t_ * 16384 + (wid + 8) * 1024 + lo16), (LAS unsigned*)(sl_ + KN_OFF + (wid + 8) * 1024), 16, 0, 0); \
        __builtin_amdgcn_global_load_lds((const unsigned*)(KRt + t_ * 8192 + wid * 1024 + lo16), (LAS unsigned*)(sl_ + KR_OFF + wid * 1024), 16, 0, 0); \
        __builtin_amdgcn_global_load_lds((const unsigned*)(Vt + t_ * 16384 + wid * 1024 + lo16), (LAS unsigned*)(sl_ + V_OFF + wid * 1024), 16, 0, 0); \
        __builtin_amdgcn_global_load_lds((const unsigned*)(Vt + t_ * 16384 + (wid + 8) * 1024 + lo16), (LAS unsigned*)(sl_ + V_OFF + (wid + 8) * 1024), 16, 0, 0); } while (0)
#define ATT_SYNC() do { asm volatile("s_waitcnt vmcnt(0)" ::: "memory"); __builtin_amdgcn_s_barrier(); asm volatile("" ::: "memory"); } while (0)
#define RESC(a) do { if (__any((a) < 1.f)) { if (hi == 0) al_l[r32] = (a); asm volatile("s_waitcnt lgkmcnt(0)" ::: "memory"); \
        _Pragma("unroll") for (int d = 0; d < 4; ++d) _Pragma("unroll") for (int r = 0; r < 16; ++r) o[d][r] *= al_l[crow(r, hi)]; } } while (0)
    f32x16 pA0, pA1, pB0, pB1; float mnA, mnB, alA, alB; bf16x8 pa0, pa1, pa2, pa3;
    int sp = 0, sc = SLOT, sn = 2 * SLOT;
    ATT_DMA(0, 0); ATT_DMA(1, SLOT);
    asm volatile("s_waitcnt vmcnt(5)" ::: "memory"); __builtin_amdgcn_s_barrier(); asm volatile("" ::: "memory");
    qkt(pA0, pA1, lds, qr, r32, hi); partialSM(pA0, pA1, m_reg, mnA, alA);
    for (int j = 1; j + 1 < NT; j += 2) {
        ATT_SYNC(); ATT_DMA(j + 1, sn);
        SBAR(); qkt(pB0, pB1, lds + sc, qr, r32, hi);
        finishSM(pA0, pA1, alA, l_reg, pa0, pa1, pa2, pa3); SBAR();
        pv_d0(o, vrb + sp, pa0, pa1, pa2, pa3); partialSM(pB0, pB1, m_reg, mnB, alB);
        RESC(alB);
        { const int t_ = sp; sp = sc; sc = sn; sn = t_; }
        ATT_SYNC(); if (j + 2 < NT) ATT_DMA(j + 2, sn);
        SBAR(); qkt(pA0, pA1, lds + sc, qr, r32, hi);
        finishSM(pB0, pB1, alB, l_reg, pa0, pa1, pa2, pa3); SBAR();
        pv_d0(o, vrb + sp, pa0, pa1, pa2, pa3); partialSM(pA0, pA1, m_reg, mnA, alA);
        RESC(alA);
        { const int t_ = sp; sp = sc; sc = sn; sn = t_; }
    }
    ATT_SYNC();
    SBAR(); qkt(pB0, pB1, lds + sc, qr, r32, hi);
    finishSM(pA0, pA1, alA, l_reg, pa0, pa1, pa2, pa3); SBAR();
    pv_d0(o, vrb + sp, pa0, pa1, pa2, pa3); partialSM(pB0, pB1, m_reg, mnB, alB);
    RESC(alB);
    finishSM(pB0, pB1, alB, l_reg, pa0, pa1, pa2, pa3); SBAR();
    pv_d0(o, vrb + sc, pa0, pa1, pa2, pa3);
    if (hi == 0) li_l[r32] = l_reg; asm volatile("s_waitcnt lgkmcnt(0)" ::: "memory");
    float rli[16];
#pragma unroll
    for (int r = 0; r < 16; ++r) rli[r] = __builtin_amdgcn_rcpf(li_l[crow(r, hi)]);
    bf16_t* Ow = Ob + (size_t)(wid * 32) * 2048;
#pragma unroll
    for (int r = 0; r < 16; ++r) { const int orow = crow(r, hi);
#pragma unroll
        for (int d0 = 0; d0 < 4; ++d0) Ow[(size_t)orow * 2048 + d0 * 32 + r32] = f2bf(o[d0][r] * rli[r]); }
    __builtin_amdgcn_s_barrier(); asm volatile("" ::: "memory");
#undef ATT_DMA
#undef ATT_SYNC
#undef RESC
}
}

namespace att8 {
constexpr int SLOT = 20480, KN_OFF = 0, KR_OFF = 8192, V_OFF = 12288, LDS_BYTES = 3 * SLOT + 8 * 256;
constexpr float THR2 = 8.0f;
constexpr float QUP = 8.f; constexpr int SC_ONE = 0x7f7f7f7f, SC_Q = 0x7c7c7c7c;
__host__ __device__ __forceinline__ int kn8(int key, int b) { return key * 128 + ((((b >> 4) ^ ((key >> 1) & 7))) << 4) + (b & 15); }
__host__ __device__ __forceinline__ int kr8(int key, int b) { return key * 64 + ((((b >> 4) ^ ((key >> 2) & 3))) << 4) + (b & 15); }
__host__ __device__ __forceinline__ int vslot(int k) { return 32 * ((k >> 2) & 1) + 16 * (k >> 5) + (k & 3) + 4 * ((k & 31) >> 3); }
__host__ __device__ __forceinline__ int v8(int d, int k) { const int sl = vslot(k); return d * 64 + ((((sl >> 4) ^ ((d >> 2) & 3))) << 4) + (sl & 15); }
__device__ __forceinline__ i32x8 ld32(const LAS unsigned char* a0, const LAS unsigned char* a1) { const u32x4 x = *(const LAS u32x4*)a0, y = *(const LAS u32x4*)a1;
    return (i32x8){(int)x.x, (int)x.y, (int)x.z, (int)x.w, (int)y.x, (int)y.y, (int)y.z, (int)y.w}; }
__device__ __forceinline__ void qkt(f32x16& p0, f32x16& p1, LAS unsigned char* slot, const i32x8* qf, int r32, int hi) {
    p0 = f32x16{}; p1 = f32x16{};
#pragma unroll
    for (int ks = 0; ks < 2; ++ks) { const int b = 64 * ks + 32 * hi;
        const i32x8 a0 = ld32(slot + KN_OFF + kn8(r32, b), slot + KN_OFF + kn8(r32, b + 16)), a1 = ld32(slot + KN_OFF + kn8(32 + r32, b), slot + KN_OFF + kn8(32 + r32, b + 16));
        p0 = __builtin_amdgcn_mfma_scale_f32_32x32x64_f8f6f4(a0, qf[ks], p0, 0, 0, 0, SC_ONE, 0, SC_Q);
        p1 = __builtin_amdgcn_mfma_scale_f32_32x32x64_f8f6f4(a1, qf[ks], p1, 0, 0, 0, SC_ONE, 0, SC_Q); }
    { const int b = 32 * hi;
        const i32x8 a0 = ld32(slot + KR_OFF + kr8(r32, b), slot + KR_OFF + kr8(r32, b + 16)), a1 = ld32(slot + KR_OFF + kr8(32 + r32, b), slot + KR_OFF + kr8(32 + r32, b + 16));
        p0 = __builtin_amdgcn_mfma_scale_f32_32x32x64_f8f6f4(a0, qf[2], p0, 0, 0, 0, SC_ONE, 0, SC_Q);
        p1 = __builtin_amdgcn_mfma_scale_f32_32x32x64_f8f6f4(a1, qf[2], p1, 0, 0, 0, SC_ONE, 0, SC_Q); }
}
__device__ __forceinline__ void partialSM(f32x16& p0, f32x16& p1, float& m_reg, float& mn, float& alpha) {
    float pmax = p0[0];
#pragma unroll
    for (int r = 1; r < 16; ++r) pmax = fmaxf(pmax, p0[r]);
#pragma unroll
    for (int r = 0; r < 16; ++r) pmax = fmaxf(pmax, p1[r]);
    { auto rr = __builtin_amdgcn_permlane32_swap(__float_as_uint(pmax), __float_as_uint(pmax), false, false);
      pmax = fmaxf(__uint_as_float(rr[0]), __uint_as_float(rr[1])); }
    if (__builtin_expect(__all(pmax - m_reg <= THR2), 1)) { mn = m_reg; alpha = 1.f; }
    else { mn = fmaxf(m_reg, pmax); alpha = __builtin_amdgcn_exp2f(m_reg - mn); m_reg = mn; }
#pragma unroll
    for (int r = 0; r < 16; ++r) p0[r] = __builtin_amdgcn_exp2f(p0[r] - mn);
#pragma unroll
    for (int r = 0; r < 16; ++r) p1[r] = p1[r] - mn;
}
__device__ __forceinline__ void finishSM(f32x16& p0, f32x16& p1, float alpha, float& l_reg, i32x8& pf) {
#pragma unroll
    for (int r = 0; r < 16; ++r) p1[r] = __builtin_amdgcn_exp2f(p1[r]);
    float ps = 0;
#pragma unroll
    for (int r = 0; r < 16; ++r) ps += p0[r];
#pragma unroll
    for (int r = 0; r < 16; ++r) ps += p1[r];
    { auto rr = __builtin_amdgcn_permlane32_swap(__float_as_uint(ps), __float_as_uint(ps), false, false);
      ps = __uint_as_float(rr[0]) + __uint_as_float(rr[1]); }
    l_reg = l_reg * alpha + ps;
#pragma unroll
    for (int w = 0; w < 4; ++w) { pf[w] = (int)pk4_fp8(p0[4 * w], p0[4 * w + 1], p0[4 * w + 2], p0[4 * w + 3]); pf[4 + w] = (int)pk4_fp8(p1[4 * w], p1[4 * w + 1], p1[4 * w + 2], p1[4 * w + 3]); }
}
__device__ __forceinline__ void pv(f32x16* o, LAS unsigned char* slot, const i32x8 pf, int r32, int hi) {
#pragma unroll
    for (int d0 = 0; d0 < 4; ++d0) { const int d = 32 * d0 + r32, sw = (d >> 2) & 3;
        const i32x8 b = ld32(slot + V_OFF + d * 64 + (((2 * hi) ^ sw) << 4), slot + V_OFF + d * 64 + (((2 * hi + 1) ^ sw) << 4));
        o[d0] = __builtin_amdgcn_mfma_scale_f32_32x32x64_f8f6f4(pf, b, o[d0], 0, 0, 0, SC_ONE, 0, SC_ONE); }
}
__device__ __forceinline__ int crow(int r, int hi) { return (r & 3) + 8 * (r >> 2) + 4 * hi; }
__device__ __forceinline__ void attn_unit(const unsigned char* __restrict__ Qb, const unsigned char* __restrict__ KNt, const unsigned char* __restrict__ KRt, const unsigned char* __restrict__ Vt,
                                          bf16_t* __restrict__ Ob, int NT, LAS unsigned char* lds) {
    const int tid = otid(), wid = __builtin_amdgcn_readfirstlane(tid >> 6), lane = tid & 63, r32 = lane & 31, hi = lane >> 5;
    LAS float* wsf = (LAS float*)(lds + 3 * SLOT) + wid * 64; LAS float* li_l = wsf; LAS float* al_l = wsf + 32;
    float m_reg = -1e30f, l_reg = 0; f32x16 o[4] = {}; i32x8 qf[3];
    const unsigned char* Qw = Qb + (size_t)(wid * 32 + r32) * 192 + 32 * hi;
#pragma unroll
    for (int ks = 0; ks < 3; ++ks) { const u32x4 x = *(const u32x4*)(Qw + 64 * ks), y = *(const u32x4*)(Qw + 64 * ks + 16); qf[ks] = (i32x8){(int)x.x, (int)x.y, (int)x.z, (int)x.w, (int)y.x, (int)y.y, (int)y.z, (int)y.w}; }
    const unsigned lo16 = (unsigned)lane * 16u;
#define ATT_DMA(tile, slotoff) do { const size_t t_ = (size_t)(tile); LAS unsigned char* sl_ = lds + (slotoff); \
        __builtin_amdgcn_global_load_lds((const unsigned*)(KNt + t_ * 8192 + wid * 1024 + lo16), (LAS unsigned*)(sl_ + KN_OFF + wid * 1024), 16, 0, 0); \
        __builtin_amdgcn_global_load_lds((const unsigned*)(Vt + t_ * 8192 + wid * 1024 + lo16), (LAS unsigned*)(sl_ + V_OFF + wid * 1024), 16, 0, 0); \
        if (wid < 4) __builtin_amdgcn_global_load_lds((const unsigned*)(KRt + t_ * 4096 + wid * 1024 + lo16), (LAS unsigned*)(sl_ + KR_OFF + wid * 1024), 16, 0, 0); } while (0)
#define ATT_SYNC() do { asm volatile("s_waitcnt vmcnt(0)" ::: "memory"); __builtin_amdgcn_s_barrier(); asm volatile("" ::: "memory"); } while (0)
#define RESC(a) do { if (__any((a) < 1.f)) { if (hi == 0) al_l[r32] = (a); asm volatile("s_waitcnt lgkmcnt(0)" ::: "memory"); \
        _Pragma("unroll") for (int d = 0; d < 4; ++d) _Pragma("unroll") for (int r = 0; r < 16; ++r) o[d][r] *= al_l[crow(r, hi)]; } } while (0)
    f32x16 pA0, pA1, pB0, pB1; float mnA, mnB, alA, alB; i32x8 pf;
    int sp = 0, sc = SLOT, sn = 2 * SLOT;
    ATT_DMA(0, 0);
    ATT_SYNC();
    ATT_DMA(1, SLOT);
    qkt(pA0, pA1, lds, qf, r32, hi); partialSM(pA0, pA1, m_reg, mnA, alA);
    for (int j = 1; j + 1 < NT; j += 2) {
        ATT_SYNC(); ATT_DMA(j + 1, sn);
        SBAR(); qkt(pB0, pB1, lds + sc, qf, r32, hi);
        finishSM(pA0, pA1, alA, l_reg, pf); SBAR();
        pv(o, lds + sp, pf, r32, hi); partialSM(pB0, pB1, m_reg, mnB, alB);
        RESC(alB);
        { const int t_ = sp; sp = sc; sc = sn; sn = t_; }
        ATT_SYNC(); if (j + 2 < NT) ATT_DMA(j + 2, sn);
        SBAR(); qkt(pA0, pA1, lds + sc, qf, r32, hi);
        finishSM(pB0, pB1, alB, l_reg, pf); SBAR();
        pv(o, lds + sp, pf, r32, hi); partialSM(pA0, pA1, m_reg, mnA, alA);
        RESC(alA);
        { const int t_ = sp; sp = sc; sc = sn; sn = t_; }
    }
    ATT_SYNC();
    SBAR(); qkt(pB0, pB1, lds + sc, qf, r32, hi);
    finishSM(pA0, pA1, alA, l_reg, pf); SBAR();
    pv(o, lds + sp, pf, r32, hi); partialSM(pB0, pB1, m_reg, mnB, alB);
    RESC(alB);
    finishSM(pB0, pB1, alB, l_reg, pf); SBAR();
    pv(o, lds + sc, pf, r32, hi);
    if (hi == 0) li_l[r32] = l_reg; asm volatile("s_waitcnt lgkmcnt(0)" ::: "memory");
    float rli[16];
#pragma unroll
    for (int r = 0; r < 16; ++r) rli[r] = __builtin_amdgcn_rcpf(li_l[crow(r, hi)]);
    bf16_t* Ow = Ob + (size_t)(wid * 32) * 2048;
#pragma unroll
    for (int r = 0; r < 16; ++r) { const int orow = crow(r, hi);
#pragma unroll
        for (int d0 = 0; d0 < 4; ++d0) Ow[(size_t)orow * 2048 + d0 * 32 + r32] = f2bf(o[d0][r] * rli[r]); }
    __builtin_amdgcn_s_barrier(); asm volatile("" ::: "memory");
#undef ATT_DMA
#undef ATT_SYNC
#undef RESC
}
}

namespace ssd {
constexpr int XT_OFF = 0, BT_OFF = 17408, HB_OFF = 52224, SET = 69632, CW_OFF = 2 * SET, LDS_BYTES = CW_OFF + 8 * 1536;
constexpr int PITCH = 272;
constexpr float L2E = 1.4426950408889634f;
__device__ __forceinline__ void g_unit(const bf16_t* __restrict__ BC, bf16_t* __restrict__ G, int unit) {
    const int cid = unit >> 1, g = unit & 1;
    const int r0 = cid < 256 ? cid * 128 : NLAT + (cid - 256) * 128;
    const int tid = otid(), wid = tid >> 6, lane = tid & 63, fr = lane & 15, fq = lane >> 4;
    const bf16_t* Cp = BC + (size_t)(r0 + 16 * wid + fr) * 512 + 256 + 128 * g + 8 * fq;
    bf16x8 cf[4];
#pragma unroll
    for (int ks = 0; ks < 4; ++ks) cf[ks] = *(const bf16x8*)(Cp + 32 * ks);
    bf16_t* Gp = G + ((size_t)unit * 128 + 16 * wid + fr) * 128 + 4 * fq;
#pragma unroll
    for (int sb = 0; sb < 8; ++sb) {
        const bf16_t* Bp = BC + (size_t)(r0 + 16 * sb + fr) * 512 + 128 * g + 8 * fq;
        f32x4 acc = {0.f, 0.f, 0.f, 0.f};
#pragma unroll
        for (int ks = 0; ks < 4; ++ks) { const bf16x8 bfr = *(const bf16x8*)(Bp + 32 * ks); acc = __builtin_amdgcn_mfma_f32_16x16x32_bf16(bfr, cf[ks], acc, 0, 0, 0); }
        u32x2 w; w.x = cvt_pk_bf16(acc[0], acc[1]); w.y = cvt_pk_bf16(acc[2], acc[3]);
        *(u32x2*)(Gp + 16 * sb) = w;
    }
}
__device__ __forceinline__ void ssd_unit(int b, int h, int d, const bf16_t* __restrict__ XS, const bf16_t* __restrict__ BC, const float* __restrict__ DT, const bf16_t* __restrict__ G,
                                         const float* __restrict__ a_log, bf16_t* __restrict__ Y, LAS unsigned char* lds) {
    const int g = h >> 3;
    const int tid = otid(), wid = tid >> 6, lane = tid & 63, fr = lane & 15, fq = lane >> 4;
    const float a = -__expf(a_log[d * 16 + h]);
    LAS float* cw = (LAS float*)(lds + CW_OFF + wid * 1536); LAS float* dts = cw + 128; LAS float* dtw = cw + 256;
    f32x4 hs[4];
#pragma unroll
    for (int q = 0; q < 4; ++q) hs[q] = (f32x4){0.f, 0.f, 0.f, 0.f};
    for (int i = tid; i < 17408 / 4; i += 512) ((LAS unsigned*)(lds + HB_OFF))[i] = 0u;
    float cend = 0.f;
#define SSD_ROWS(step, r0v, gidv) do { if ((step) < 2) { const int oc_ = d ? 1 - (step) : (step); r0v = NLAT + b * 256 + oc_ * 128; gidv = 256 + b * 2 + oc_; } \
        else { const int lc_ = (step) - 2, oc_ = d ? 63 - lc_ : lc_; r0v = b * 8192 + oc_ * 128; gidv = b * 64 + oc_; } } while (0)
    const int sg = tid & 31, n8 = tid >> 5, p4 = tid >> 5;
    f32x2 P_da, Q_da; u32x2 P_xv[4], Q_xv[4]; u32x4 P_bv[4], Q_bv[4], n_gv[4], n_cv[4], c_gv[4], c_cv[4];
#define SSD_LOAD(step, X) do { int r0_, gid_; SSD_ROWS(step, r0_, gid_); (void)gid_; X##_da = *(const f32x2*)(DT + (size_t)(d * 16 + h) * NROW + r0_ + 2 * lane); \
        _Pragma("unroll") for (int j_ = 0; j_ < 4; ++j_) { X##_xv[j_] = *(const u32x2*)(XS + (size_t)(r0_ + 4 * sg + j_) * 1024 + 64 * h + 4 * p4); \
                                                         X##_bv[j_] = *(const u32x4*)(BC + (size_t)(r0_ + 4 * sg + j_) * 512 + 128 * g + 8 * n8); } } while (0)
#define SSD_LOADGC(step) do { int r0_, gid_; SSD_ROWS(step, r0_, gid_); const int t_ = 16 * wid + fr; const bf16_t* Gp_ = G + ((size_t)(gid_ * 2 + g) * 128 + t_) * 128 + 8 * fq; const bf16_t* Cp_ = BC + (size_t)(r0_ + t_) * 512 + 256 + 128 * g + 8 * fq; \
          _Pragma("unroll") for (int ks_ = 0; ks_ < 4; ++ks_) { n_gv[ks_] = *(const u32x4*)(Gp_ + 32 * ks_); n_cv[ks_] = *(const u32x4*)(Cp_ + 32 * ks_); } } while (0)
#define SSD_GCROT() do { _Pragma("unroll") for (int ks_ = 0; ks_ < 4; ++ks_) { c_gv[ks_] = n_gv[ks_]; c_cv[ks_] = n_cv[ks_]; } } while (0)
#define SSD_WRITE(step, X) do { LAS unsigned char* set_ = lds + ((step) & 1) * SET; \
        const float da0 = X##_da.x * a, da1 = X##_da.y * a; \
        float sc_ = da0 + da1; float c0_, c1_; \
        if (d == 0) { _Pragma("unroll") for (int o_ = 1; o_ < 64; o_ <<= 1) { const float t_ = __shfl_up(sc_, o_); if (lane >= o_) sc_ += t_; } \
            c0_ = sc_ - da1; c1_ = sc_; cend = __shfl(sc_, 63); } \
        else { _Pragma("unroll") for (int o_ = 1; o_ < 64; o_ <<= 1) { const float t_ = __shfl_down(sc_, o_); if (lane + o_ < 64) sc_ += t_; } \
            c0_ = sc_; c1_ = sc_ - da0; cend = __shfl(sc_, 0); } \
        *(LAS f32x2*)(cw + 2 * lane) = (f32x2){c0_, c1_}; *(LAS f32x2*)(dts + 2 * lane) = X##_da; \
        *(LAS f32x2*)(dtw + 2 * lane) = (f32x2){X##_da.x * __builtin_amdgcn_exp2f((cend - c0_) * L2E), X##_da.y * __builtin_amdgcn_exp2f((cend - c1_) * L2E)}; \
        { LAS unsigned char* xt_ = set_ + XT_OFF + (4 * p4) * PITCH + 8 * sg; \
          _Pragma("unroll") for (int i_ = 0; i_ < 4; ++i_) { unsigned e_[4]; \
              _Pragma("unroll") for (int j_ = 0; j_ < 4; ++j_) { const unsigned w_ = (i_ & 2) ? X##_xv[j_].y : X##_xv[j_].x; e_[j_] = (i_ & 1) ? (w_ >> 16) : (w_ & 0xffffu); } \
              u32x2 o_; o_.x = e_[0] | (e_[1] << 16); o_.y = e_[2] | (e_[3] << 16); *(LAS u32x2*)(xt_ + i_ * PITCH) = o_; } } \
        { LAS unsigned char* bt_ = set_ + BT_OFF + (8 * n8) * PITCH + 8 * sg; \
          _Pragma("unroll") for (int i_ = 0; i_ < 8; ++i_) { unsigned e_[4]; \
              _Pragma("unroll") for (int j_ = 0; j_ < 4; ++j_) { const unsigned w_ = X##_bv[j_][i_ >> 1]; e_[j_] = (i_ & 1) ? (w_ >> 16) : (w_ & 0xffffu); } \
              u32x2 o_; o_.x = e_[0] | (e_[1] << 16); o_.y = e_[2] | (e_[3] << 16); *(LAS u32x2*)(bt_ + i_ * PITCH) = o_; } } \
        asm volatile("s_waitcnt lgkmcnt(0)" ::: "memory"); \
    } while (0)
    SSD_LOAD(0, Q); SSD_LOADGC(0); SSD_WRITE(0, Q); SSD_LOAD(1, P);
    for (int step2 = 0; step2 < 66; step2 += 2)
#pragma unroll
    for (int par = 0; par < 2; ++par) {
        const int step = step2 + par;
        __syncthreads();
        int r0, gid; SSD_ROWS(step, r0, gid); (void)gid;
        LAS unsigned char* set = lds + (step & 1) * SET;
        const float cend_cur = cend;
        SSD_GCROT();
        if (step + 1 < 66) SSD_LOADGC(step + 1);
        if (step + 2 < 66) { if (par == 0) SSD_LOAD(step + 2, Q); else SSD_LOAD(step + 2, P); }
        {
            const int t = 16 * wid + fr; const float ct = cw[t];
            f32x4 y[4];
#pragma unroll
            for (int q = 0; q < 4; ++q) y[q] = (f32x4){0.f, 0.f, 0.f, 0.f};
            const float et = __builtin_amdgcn_exp2f(ct * L2E);
#pragma unroll
            for (int ks = 0; ks < 4; ++ks) {
                const bool live = d == 0 ? (32 * ks <= 16 * wid + 15) : (32 * ks + 31 >= 16 * wid);
                if (live) {
                    const int s0 = 32 * ks + 8 * fq;
                    const f32x4 c0 = *(const LAS f32x4*)(cw + s0), c1 = *(const LAS f32x4*)(cw + s0 + 4), d0v = *(const LAS f32x4*)(dts + s0), d1v = *(const LAS f32x4*)(dts + s0 + 4);
                    float m[8];
#pragma unroll
                    for (int i = 0; i < 8; ++i) { const float cs = i < 4 ? c0[i & 3] : c1[i & 3], dv = i < 4 ? d0v[i & 3] : d1v[i & 3]; const int s = s0 + i;
                        const bool ok = d == 0 ? (s <= t) : (s >= t);
                        const float gval = (i & 1) ? bfhi(c_gv[ks][i >> 1]) : bflo(c_gv[ks][i >> 1]);
                        m[i] = ok ? gval * dv * __builtin_amdgcn_exp2f((ct - cs) * L2E) : 0.f; }
                    u32x4 mw; mw.x = cvt_pk_bf16(m[0], m[1]); mw.y = cvt_pk_bf16(m[2], m[3]); mw.z = cvt_pk_bf16(m[4], m[5]); mw.w = cvt_pk_bf16(m[6], m[7]);
                    const bf16x8 mb = __builtin_bit_cast(bf16x8, mw);
#pragma unroll
                    for (int q = 0; q < 4; ++q) { const bf16x8 af = *(const LAS bf16x8*)(set + XT_OFF + (16 * q + fr) * PITCH + (32 * ks + 8 * fq) * 2);
                        y[q] = __builtin_amdgcn_mfma_f32_16x16x32_bf16(af, mb, y[q], 0, 0, 0); }
                }
            }
#pragma unroll
            for (int ks = 0; ks < 4; ++ks) {
                u32x4 cwv;
#pragma unroll
                for (int i = 0; i < 4; ++i) cwv[i] = cvt_pk_bf16(bflo(c_cv[ks][i]) * et, bfhi(c_cv[ks][i]) * et);
                const bf16x8 cb = __builtin_bit_cast(bf16x8, cwv);
#pragma unroll
                for (int q = 0; q < 4; ++q) { const bf16x8 af = *(const LAS bf16x8*)(set + HB_OFF + (16 * q + fr) * PITCH + (32 * ks + 8 * fq) * 2);
                    y[q] = __builtin_amdgcn_mfma_f32_16x16x32_bf16(af, cb, y[q], 0, 0, 0); }
            }
            bf16_t* yp = Y + (size_t)(r0 + t) * 1024 + 64 * h + 4 * fq;
#pragma unroll
            for (int q = 0; q < 4; ++q) { u32x2 w; w.x = cvt_pk_bf16(y[q][0], y[q][1]); w.y = cvt_pk_bf16(y[q][2], y[q][3]); *(u32x2*)(yp + 16 * q) = w; }
        }
        {
            const float dec = __builtin_amdgcn_exp2f(cend_cur * L2E);
#pragma unroll
            for (int q = 0; q < 4; ++q) hs[q] = hs[q] * dec;
#pragma unroll
            for (int ks = 0; ks < 4; ++ks) {
                const int s0 = 32 * ks + 8 * fq;
                const u32x4 braw = *(const LAS u32x4*)(set + BT_OFF + (16 * wid + fr) * PITCH + s0 * 2);
                const f32x4 w0 = *(const LAS f32x4*)(dtw + s0), w1 = *(const LAS f32x4*)(dtw + s0 + 4);
                u32x4 bw; bw.x = cvt_pk_bf16(bflo(braw.x) * w0[0], bfhi(braw.x) * w0[1]); bw.y = cvt_pk_bf16(bflo(braw.y) * w0[2], bfhi(braw.y) * w0[3]);
                          bw.z = cvt_pk_bf16(bflo(braw.z) * w1[0], bfhi(braw.z) * w1[1]); bw.w = cvt_pk_bf16(bflo(braw.w) * w1[2], bfhi(braw.w) * w1[3]);
                const bf16x8 bfr = __builtin_bit_cast(bf16x8, bw);
#pragma unroll
                for (int q = 0; q < 4; ++q) { const bf16x8 af = *(const LAS bf16x8*)(set + XT_OFF + (16 * q + fr) * PITCH + s0 * 2);
                    hs[q] = __builtin_amdgcn_mfma_f32_16x16x32_bf16(af, bfr, hs[q], 0, 0, 0); }
            }
            LAS bf16_t* hb = (LAS bf16_t*)(lds + ((step + 1) & 1) * SET + HB_OFF) + 16 * wid + fr;
#pragma unroll
            for (int q = 0; q < 4; ++q)
#pragma unroll
                for (int i = 0; i < 4; ++i) hb[(16 * q + 4 * fq + i) * 136] = f2bf(hs[q][i]);
        }
        if (step + 1 < 66) { if (par == 0) SSD_WRITE(step + 1, P); else SSD_WRITE(step + 1, Q); }
    }
    __syncthreads();
#undef SSD_ROWS
#undef SSD_LOAD
#undef SSD_LOADGC
#undef SSD_GCROT
#undef SSD_WRITE
}
}

struct Args { const float* in[32]; float* out; unsigned char* ws; int ph_lo, ph_hi; };
constexpr int NTHR = 512;
constexpr int LDS_BASE = 256;
constexpr int LDS_PHASE = 151808;
constexpr int LDS_BYTES = LDS_BASE + LDS_PHASE;
static_assert(att::LDS_BYTES <= LDS_PHASE && att8::LDS_BYTES <= LDS_PHASE && ssd::LDS_BYTES <= LDS_PHASE && pg8::STAGE_BYTES <= LDS_PHASE, "LDS");

__device__ __forceinline__ void tjob(int j, const Args& A, const float*& src, bf16_t*& dst, int& K, int& N, int& Npad, int& mode, const float*& ks) {
    unsigned char* W = A.ws + WS_W; mode = 0; ks = nullptr;
    if (j < 8) { const int i = j >> 2, w = j & 3; unsigned char* base = W + W_HYB + (size_t)i * WH_SZ;
        if (w == 0)      { src = A.in[I_HWIN] + (size_t)i * 1024 * HYB_IN; dst = (bf16_t*)(base + WH_IN); K = 1024; N = HYB_IN; Npad = HYB_INP; mode = 1; }
        else if (w == 1) { src = A.in[I_WQB] + (size_t)i * 384 * 1536; dst = (bf16_t*)(base + WH_QB); K = 384; N = 1536; Npad = 1536; mode = 2; ks = A.in[I_QNG] + i * 384; }
        else if (w == 2) { src = A.in[I_WKVB] + (size_t)i * 256 * 2048; dst = (bf16_t*)(base + WH_KVB); K = 256; N = 2048; Npad = 2048; ks = A.in[I_KVNG] + i * 256; }
        else             { src = A.in[I_HWOUT] + (size_t)i * 2048 * 1024; dst = (bf16_t*)(base + WH_OUT); K = 2048; N = 1024; Npad = 1024; }
    } else if (j < 12) { const int i = (j - 8) >> 1, w = (j - 8) & 1; unsigned char* base = W + W_GM + (size_t)i * WG_SZ;
        if (w == 0) { src = A.in[I_GWIN] + (size_t)i * 1024 * 4096; dst = (bf16_t*)(base + WG_IN); K = 1024; N = 4096; Npad = 4096; }
        else        { src = A.in[I_GWOUT] + (size_t)i * 2048 * 1024; dst = (bf16_t*)(base + WG_OUT); K = 2048; N = 1024; Npad = 1024; }
    } else { const int l = j - 12; src = A.in[I_PWQ] + (size_t)l * 1024 * 2048; dst = (bf16_t*)(W + W_PEER + (size_t)l * WP_SZ + WP_Q); K = 1024; N = 2048; Npad = 2048; }
}
__device__ __forceinline__ int colmap(int mode, int n, int N) {
    if (mode == 1) { if (n >= N) return -1; if (n < C_KR) return n; const int m = n - C_KR; return C_KR + (m >> 1) + 32 * (m & 1); }
    if (mode == 2) { if (n < 1024) return (n >> 7) * 192 + (n & 127); const int m = n - 1024, h = m >> 6, mm = m & 63; return h * 192 + 128 + (mm >> 1) + 32 * (mm & 1); }
    return n;
}
__device__ __forceinline__ void phase_prologue(const Args& A, LAS unsigned char* lds) {
    const int tid = otid();
    {
        LAS float* tile = (LAS float*)lds;
        int item = blockIdx.x;
        for (int j = 0; j < 16; ++j) {
            const float* src; bf16_t* dst; int K, N, Npad, mode; const float* ks; tjob(j, A, src, dst, K, N, Npad, mode, ks);
            const int tk = K / 64, tn = Npad / 64, nt = tk * tn;
            for (; item < nt; item += gridDim.x) {
                const int k0 = (item % tk) * 64, n0 = (item / tk) * 64;
                { const int k = tid >> 3, cg = tid & 7; const float sc = ks ? ks[k0 + k] : 1.f;
#pragma unroll
                  for (int jj = 0; jj < 8; ++jj) { const int oc = colmap(mode, n0 + 8 * cg + jj, N); tile[k * 65 + 8 * cg + jj] = oc >= 0 ? src[(size_t)(k0 + k) * N + oc] * sc : 0.f; } }
                __syncthreads();
                { const int n = tid >> 3, kg = tid & 7; float v[8];
#pragma unroll
                  for (int jj = 0; jj < 8; ++jj) v[jj] = tile[(8 * kg + jj) * 65 + n];
                  u32x4 w; w.x = cvt_pk_bf16(v[0], v[1]); w.y = cvt_pk_bf16(v[2], v[3]); w.z = cvt_pk_bf16(v[4], v[5]); w.w = cvt_pk_bf16(v[6], v[7]);
                  *(u32x4*)(dst + (size_t)(n0 + n) * K + k0 + 8 * kg) = w; }
                __syncthreads();
            }
            item -= nt;
        }
    }
    {
        const int gthr = blockIdx.x * NTHR + tid, nthr = gridDim.x * NTHR;
        for (int p = gthr; p < 10 * 16384; p += nthr) {
            const int mat = p >> 14, off = (p & 16383) * 8; const float* src; bf16_t* dst;
            if (mat < 2)      { src = A.in[I_GWS] + (size_t)mat * 131072; dst = (bf16_t*)(A.ws + WS_W + W_GM + (size_t)mat * WG_SZ + WG_WS); }
            else if (mat < 6) { src = A.in[I_PK1] + (size_t)(mat - 2) * 131072; dst = (bf16_t*)(A.ws + WS_W + W_PEER + (size_t)(mat - 2) * WP_SZ + WP_K1); }
            else              { src = A.in[I_PK2] + (size_t)(mat - 6) * 131072; dst = (bf16_t*)(A.ws + WS_W + W_PEER + (size_t)(mat - 6) * WP_SZ + WP_K2); }
            const f32x4 a = *(const f32x4*)(src + off), b = *(const f32x4*)(src + off + 4);
            u32x4 w; w.x = cvt_pk_bf16(a[0], a[1]); w.y = cvt_pk_bf16(a[2], a[3]); w.z = cvt_pk_bf16(b[0], b[1]); w.w = cvt_pk_bf16(b[2], b[3]);
            *(u32x4*)(dst + off) = w;
        }
        float* rope = (float*)(A.ws + WS_ROPE);
        for (int p = gthr; p < SEQ * 32; p += nthr) { const int l = p >> 5, i = p & 31; const float pos = (float)(i < 16 ? (l >> 6) : (l & 63));
            const float inv = powf(10000.f, -(float)(i & 15) / 16.f), ang = pos * inv; rope[p] = cosf(ang); rope[SEQ * 32 + p] = sinf(ang); }
    }
    {
        LAS float* scond = (LAS float*)lds;
        LAS float* red = scond + 5 * 1024;
        __syncthreads();
        for (int i = tid; i < 5 * 1024; i += NTHR) { const int m = i >> 10, k = i & 1023; const float c = m < 4 ? A.in[I_C][m * 1024 + k] : A.in[I_CCTX][k]; scond[i] = silu_f(c); }
        __syncthreads();
        float* MOD = (float*)(A.ws + WS_MOD);
        for (int item = blockIdx.x; item < 4 * 48; item += gridDim.x) {
            const int layer = item / 48, j0 = (item % 48) * 128; const int c4 = tid & 31, ksl = tid >> 5;
            f32x4 acc[5];
#pragma unroll
            for (int m = 0; m < 5; ++m) acc[m] = (f32x4){0.f, 0.f, 0.f, 0.f};
            const float* wp = A.in[I_ADAW] + ((size_t)layer * 1024 + ksl * 64) * 6144 + j0 + 4 * c4;
            for (int k = 0; k < 64; ++k) { const f32x4 w = *(const f32x4*)(wp + (size_t)k * 6144);
#pragma unroll
                for (int m = 0; m < 5; ++m) acc[m] += w * scond[m * 1024 + ksl * 64 + k]; }
#pragma unroll
            for (int m = 0; m < 5; ++m) *(LAS f32x4*)(red + (ksl * 5 + m) * 128 + 4 * c4) = acc[m];
            __syncthreads();
            for (int i = tid; i < 640; i += NTHR) { const int m = i >> 7, c = i & 127; float s = A.in[I_ADAB][layer * 6144 + j0 + c];
#pragma unroll
                for (int q = 0; q < 16; ++q) s += red[(q * 5 + m) * 128 + c];
                MOD[((size_t)layer * 5 + m) * 6144 + j0 + c] = s; }
            __syncthreads();
        }
    }
}

__device__ __forceinline__ void phase_norm_mod(const float* xl, const float* xc, float* cl, float* cc, const float* g, const float* modl, int sh_idx, bf16_t* H, int nrows) {
    const int tid_ = otid(); const int lane = tid_ & 63, gw = blockIdx.x * 8 + (tid_ >> 6), nw = gridDim.x * 8;
    f32x4 gv[4];
#pragma unroll
    for (int i = 0; i < 4; ++i) gv[i] = *(const f32x4*)(g + 256 * i + 4 * lane);
    for (int r = gw; r < nrows; r += nw) {
        const bool lat = r < NLAT; const float* xp = lat ? xl + (size_t)r * D : xc + (size_t)(r - NLAT) * D;
        f32x4 x[4]; float ss = 0.f;
#pragma unroll
        for (int i = 0; i < 4; ++i) { x[i] = *(const f32x4*)(xp + 256 * i + 4 * lane); ss += x[i][0] * x[i][0] + x[i][1] * x[i][1] + x[i][2] * x[i][2] + x[i][3] * x[i][3]; }
        if (cl) { float* cp = lat ? cl + (size_t)r * D : cc + (size_t)(r - NLAT) * D;
#pragma unroll
            for (int i = 0; i < 4; ++i) *(f32x4*)(cp + 256 * i + 4 * lane) = x[i]; }
        ss = wave_sum(ss); const float rstd = rsqrtf(ss * (1.f / 1024.f) + EPS);
        const float* mp = modl + (size_t)(lat ? (r >> 13) : 4) * 6144 + sh_idx * 1024;
#pragma unroll
        for (int i = 0; i < 4; ++i) { const f32x4 sh = *(const f32x4*)(mp + 256 * i + 4 * lane), sc = *(const f32x4*)(mp + 1024 + 256 * i + 4 * lane);
            const f32x4 hv = (x[i] * rstd) * gv[i] * (sc + 1.f) + sh;
            u32x2 w; w.x = cvt_pk_bf16(hv[0], hv[1]); w.y = cvt_pk_bf16(hv[2], hv[3]);
            *(u32x2*)(H + (size_t)r * D + 256 * i + 4 * lane) = w; }
    }
}
__device__ __forceinline__ void phase_final_norm(float* xl, const float* g, float oscale) {
    const int tid_ = otid(); const int lane = tid_ & 63, gw = blockIdx.x * 8 + (tid_ >> 6), nw = gridDim.x * 8;
    f32x4 gv[4];
#pragma unroll
    for (int i = 0; i < 4; ++i) gv[i] = *(const f32x4*)(g + 256 * i + 4 * lane);
    for (int r = gw; r < NLAT; r += nw) {
        float* xp = xl + (size_t)r * D; f32x4 x[4]; float ss = 0.f;
#pragma unroll
        for (int i = 0; i < 4; ++i) { x[i] = *(const f32x4*)(xp + 256 * i + 4 * lane); ss += x[i][0] * x[i][0] + x[i][1] * x[i][1] + x[i][2] * x[i][2] + x[i][3] * x[i][3]; }
        ss = wave_sum(ss); const float rstd = rsqrtf(ss * (1.f / 1024.f) + EPS);
#pragma unroll
        for (int i = 0; i < 4; ++i) *(f32x4*)(xp + 256 * i + 4 * lane) = (x[i] * (rstd * oscale)) * gv[i];
    }
}

__device__ __forceinline__ void phase_conv(const Args& A, int li) {
    const bf16_t* PROJ = (const bf16_t*)(A.ws + WS_BIG);
    bf16_t* XS = (bf16_t*)(A.ws + WS_R2); bf16_t* BC = (bf16_t*)(A.ws + WS_R2 + R2_BC);
    const int tid = otid();
    {
        for (int item = blockIdx.x * 3; item < (NROW / 64) * 3; item += gridDim.x * 3)
#pragma unroll 1
        for (int sub = 0; sub < 3; ++sub) {
            const int blk = (item + sub) / 3, q = ((item + sub) % 3) * 512 + tid, cg = q % 192, rg = q / 192, c0 = 8 * cg;
            const int rbeg = blk * 64 + rg * 8; int s0, s1;
            if (rbeg < NLAT) { s0 = rbeg & ~8191; s1 = s0 + 8192; } else { s0 = NLAT + ((rbeg - NLAT) & ~255); s1 = s0 + 256; }
            const float* cw = A.in[I_CONVW] + ((size_t)li * 1536 + c0) * 5; const float* cb = A.in[I_CONVB] + (size_t)li * 1536 + c0;
            u32x4 in[12];
#pragma unroll
            for (int i = 0; i < 12; ++i) { const int r = rbeg - 2 + i; in[i] = (r >= s0 && r < s1) ? *(const u32x4*)(PROJ + (size_t)r * HYB_INP + C_XBC + c0) : (u32x4){0u, 0u, 0u, 0u}; }
            float w[8][5], bia[8];
#pragma unroll
            for (int j = 0; j < 8; ++j) { bia[j] = cb[j];
#pragma unroll
                for (int k = 0; k < 5; ++k) w[j][k] = cw[j * 5 + k]; }
#pragma unroll
            for (int rr = 0; rr < 8; ++rr) {
                float o[8];
#pragma unroll
                for (int j = 0; j < 8; ++j) { float sacc = bia[j];
#pragma unroll
                    for (int k = 0; k < 5; ++k) { const unsigned wd = in[rr + k][j >> 1]; sacc += w[j][k] * ((j & 1) ? bfhi(wd) : bflo(wd)); }
                    o[j] = silu_f(sacc); }
                u32x4 pk; pk.x = cvt_pk_bf16(o[0], o[1]); pk.y = cvt_pk_bf16(o[2], o[3]); pk.z = cvt_pk_bf16(o[4], o[5]); pk.w = cvt_pk_bf16(o[6], o[7]);
                const int r = rbeg + rr;
                if (c0 < 1024) *(u32x4*)(XS + (size_t)r * 1024 + c0) = pk; else *(u32x4*)(BC + (size_t)r * 512 + (c0 - 1024)) = pk;
            }
        }
    }
    {
        const int lane = tid & 63, gw = blockIdx.x * 8 + (tid >> 6), nw = gridDim.x * 8;
        float* DT = (float*)(A.ws + WS_BIG + BIG_DT); float* RQ = (float*)(A.ws + WS_RSTD); float* RKV = RQ + NROW;
        unsigned char* KR = A.ws + WS_BIG + BIG_KR; const float* rope = (const float*)(A.ws + WS_ROPE);
        const float dtb = lane < 32 ? A.in[I_DTB][li * 32 + lane] : 0.f;
        for (int r = gw; r < NROW; r += nw) {
            const bf16_t* p = PROJ + (size_t)r * HYB_INP;
            if (lane < 32) DT[(size_t)lane * NROW + r] = softplus_f(bf2f(p[C_DT + (lane & 15)]) + dtb);
            { const unsigned* q = (const unsigned*)(p + C_CQ + 6 * lane); float ss = 0.f;
#pragma unroll
              for (int j = 0; j < 3; ++j) { const unsigned w = q[j]; const float a = bflo(w), b = bfhi(w); ss += a * a + b * b; }
              ss = wave_sum(ss); if (lane == 0) RQ[r] = rsqrtf(ss * (1.f / 384.f) + EPS); }
            { const u32x2 w = *(const u32x2*)(p + C_CKV + 4 * lane); const float a = bflo(w.x), b = bfhi(w.x), c = bflo(w.y), d = bfhi(w.y);
              float ss = a * a + b * b + c * c + d * d; ss = wave_sum(ss); if (lane == 0) RKV[r] = rsqrtf(ss * (1.f / 256.f) + EPS); }
            if (lane < 32) { const unsigned w = *(const unsigned*)(p + C_KR + 2 * lane); float x1 = bflo(w), x2 = bfhi(w); int b, key;
                if (r < NLAT) { const int l = r & 8191; const float c = rope[l * 32 + lane], s = rope[SEQ * 32 + l * 32 + lane];
                    const float o1 = x1 * c - x2 * s, o2 = x1 * s + x2 * c; x1 = o1; x2 = o2; b = r >> 13; key = 256 + l; }
                else { b = (r - NLAT) >> 8; key = (r - NLAT) & 255; }
                { int w8 = 0; w8 = __builtin_amdgcn_cvt_pk_fp8_f32(sat8(x1), sat8(x2), w8, false);
                  *(unsigned short*)(KR + (size_t)(b * NKT + (key >> 6)) * 4096 + att8::kr8(key & 63, 2 * lane)) = (unsigned short)(w8 & 0xffff); } }
        }
    }
}

struct EpiQ {
    static constexpr bool PERM = true;
    unsigned char* Q; const float* rstd; const float* rope;
    __device__ __forceinline__ void operator()(const f32x4 (&acc)[2][2][4][2], const pg8::Unit& u, int wr, int wc, int fr, int fq) const {
        const bool lat = u.pm < 128;
        const int b = lat ? (u.pm >> 5) : (u.pm - 128), q0 = lat ? 256 + ((u.pm & 31) << 8) : 0;
        const bool isrope = u.pn >= 4;
#pragma unroll
        for (int ai = 0; ai < 2; ++ai) {
            const int rl = 128 * ai + 64 * wr + fr;
            const float* rsp = rstd + u.pm * 256 + rl;
            const float* rp = rope + (size_t)(((u.pm & 31) << 8) + rl) * 32;
#pragma unroll
            for (int bj = 0; bj < 2; ++bj) {
                const int c0 = u.pn * 256 + 128 * bj + 32 * wc + 8 * fq; int h, dcol;
                if (!isrope) { h = c0 >> 7; dcol = c0 & 127; } else { const int mq = c0 - 1024; h = mq >> 6; dcol = 128 + (mq & 63); }
                unsigned char* dst = Q + ((size_t)(b * 8 + h) * NKEY + q0 + rl) * 192 + dcol;
                const int ro = (dcol - 128) >> 1;
#pragma unroll
                for (int m = 0; m < 4; ++m) {
                    const float rs = rsp[16 * m] * (QSCALE * att8::QUP);
                    f32x4 v0 = acc[ai][bj][m][0] * rs, v1 = acc[ai][bj][m][1] * rs;
                    if (isrope && lat) { const f32x4 cs = *(const f32x4*)(rp + 16 * m * 32 + ro), sn = *(const f32x4*)(rp + SEQ * 32 + 16 * m * 32 + ro);
                        const f32x4 a0 = v0, a1 = v1;
                        v0[0] = a0[0] * cs[0] - a0[1] * sn[0]; v0[1] = a0[0] * sn[0] + a0[1] * cs[0]; v0[2] = a0[2] * cs[1] - a0[3] * sn[1]; v0[3] = a0[2] * sn[1] + a0[3] * cs[1];
                        v1[0] = a1[0] * cs[2] - a1[1] * sn[2]; v1[1] = a1[0] * sn[2] + a1[1] * cs[2]; v1[2] = a1[2] * cs[3] - a1[3] * sn[3]; v1[3] = a1[2] * sn[3] + a1[3] * cs[3]; }
                    u32x2 w; w.x = pk4_fp8_sat(v0[0], v0[1], v0[2], v0[3]); w.y = pk4_fp8_sat(v1[0], v1[1], v1[2], v1[3]);
                    *(u32x2*)(dst + 16 * m * 192) = w;
                    asm volatile("" ::: "memory");
                }
            }
        }
    }
};
struct EpiKV {
    static constexpr bool PERM = true;
    unsigned char* KN; unsigned char* V; const float* rstd;
    __device__ __forceinline__ void operator()(const f32x4 (&acc)[2][2][4][2], const pg8::Unit& u, int wr, int wc, int fr, int fq) const {
        const bool lat = u.pm < 128;
        const int b = lat ? (u.pm >> 5) : (u.pm - 128), t0 = lat ? 4 + ((u.pm & 31) << 2) : 0;
        const int dd = 32 * wc + 8 * fq;
        const int offK = fr * 128 + ((((dd >> 4) ^ ((fr >> 1) & 7))) << 4) + (dd & 15);
#pragma unroll
        for (int ai = 0; ai < 2; ++ai) {
            const size_t tb = ((size_t)(b * 8 + u.pn) * NKT + t0 + 2 * ai + wr) * 8192;
            const float* rsp = rstd + u.pm * 256 + 128 * ai + 64 * wr + fr;
            unsigned char* kp = KN + tb + offK; unsigned char* vp = V + tb;
#pragma unroll
            for (int m = 0; m < 4; ++m) {
                const float rs = rsp[16 * m];
                { const f32x4 v0 = acc[ai][0][m][0] * rs, v1 = acc[ai][0][m][1] * rs; u32x2 w; w.x = pk4_fp8_sat(v0[0], v0[1], v0[2], v0[3]); w.y = pk4_fp8_sat(v1[0], v1[1], v1[2], v1[3]);
                  *(u32x2*)(kp + m * 2048) = w; }
                { const f32x4 v0 = acc[ai][1][m][0] * rs, v1 = acc[ai][1][m][1] * rs; const unsigned w0 = pk4_fp8_sat(v0[0], v0[1], v0[2], v0[3]), w1 = pk4_fp8_sat(v1[0], v1[1], v1[2], v1[3]);
                  const int sl = att8::vslot(16 * m + fr);
#pragma unroll
                  for (int i = 0; i < 8; ++i) { const int d = dd + i; vp[d * 64 + ((((sl >> 4) ^ ((d >> 2) & 3))) << 4) + (sl & 15)] = (unsigned char)(((i < 4 ? w0 : w1) >> (8 * (i & 3))) & 0xffu); } }
                asm volatile("" ::: "memory");
            }
        }
    }
};

__device__ __forceinline__ void phase_ssd_out(const Args& A, int li, int nrows) {
    const bf16_t* PROJ = (const bf16_t*)(A.ws + WS_BIG); const bf16_t* XS = (const bf16_t*)(A.ws + WS_R2);
    const bf16_t* Y0 = (const bf16_t*)(A.ws + WS_H); const bf16_t* Y1 = (const bf16_t*)(A.ws + WS_R3); bf16_t* CAT = (bf16_t*)(A.ws + WS_R3 + R3_CAT);
    const int tid_ = otid(); const int lane = tid_ & 63, gw = blockIdx.x * 8 + (tid_ >> 6), nw = gridDim.x * 8;
    const float dsk = A.in[I_SSDD][li * 16 + (lane >> 2)];
    float ng[16];
#pragma unroll
    for (int j = 0; j < 16; ++j) ng[j] = A.in[I_SSDNG][li * 1024 + 16 * lane + j];
    for (int r = gw; r < nrows; r += nw) {
        float v[16]; float ss = 0.f;
#pragma unroll
        for (int hh = 0; hh < 2; ++hh) {
            const u32x4 a = *(const u32x4*)(Y0 + (size_t)r * 1024 + 16 * lane + 8 * hh), b = *(const u32x4*)(Y1 + (size_t)r * 1024 + 16 * lane + 8 * hh);
            const u32x4 x = *(const u32x4*)(XS + (size_t)r * 1024 + 16 * lane + 8 * hh), z = *(const u32x4*)(PROJ + (size_t)r * HYB_INP + 16 * lane + 8 * hh);
#pragma unroll
            for (int q = 0; q < 4; ++q) {
                const float y0 = (bflo(a[q]) + bflo(b[q]) + dsk * bflo(x[q])) * silu_f(bflo(z[q])), y1 = (bfhi(a[q]) + bfhi(b[q]) + dsk * bfhi(x[q])) * silu_f(bfhi(z[q]));
                v[8 * hh + 2 * q] = y0; v[8 * hh + 2 * q + 1] = y1; ss += y0 * y0 + y1 * y1; }
        }
#pragma unroll
        for (int o = 16; o >= 1; o >>= 1) ss += __shfl_xor(ss, o);
        const float rstd = rsqrtf(ss * (1.f / 512.f) + EPS);
#pragma unroll
        for (int hh = 0; hh < 2; ++hh) { u32x4 w;
#pragma unroll
            for (int q = 0; q < 4; ++q) w[q] = cvt_pk_bf16(v[8 * hh + 2 * q] * rstd * ng[8 * hh + 2 * q], v[8 * hh + 2 * q + 1] * rstd * ng[8 * hh + 2 * q + 1]);
            *(u32x4*)(CAT + (size_t)r * 2048 + 16 * lane + 8 * hh) = w; }
    }
}

__device__ __forceinline__ void phase_ln_stats(const Args& A, int nrows) {
    const bf16_t* Gb = (const bf16_t*)(A.ws + WS_BIG); float* ST = (float*)(A.ws + WS_RSTD);
    const int tid_ = otid(); const int lane = tid_ & 63, gw = blockIdx.x * 8 + (tid_ >> 6), nw = gridDim.x * 8;
    for (int r = gw; r < nrows; r += nw) {
        float v[32]; float s = 0.f;
#pragma unroll
        for (int j = 0; j < 4; ++j) { const u32x4 w = *(const u32x4*)(Gb + (size_t)r * 4096 + 2048 + 512 * j + 8 * lane);
#pragma unroll
            for (int q = 0; q < 4; ++q) { v[8 * j + 2 * q] = bflo(w[q]); v[8 * j + 2 * q + 1] = bfhi(w[q]); s += v[8 * j + 2 * q] + v[8 * j + 2 * q + 1]; } }
        s = wave_sum(s); const float mu = s * (1.f / 2048.f); float q2 = 0.f;
#pragma unroll
        for (int j = 0; j < 32; ++j) { const float dd = v[j] - mu; q2 += dd * dd; }
        q2 = wave_sum(q2);
        if (lane == 0) { ST[r] = mu; ST[NROW + r] = rsqrtf(q2 * (1.f / 2048.f) + EPS); }
    }
}
__device__ __forceinline__ void phase_spatial(const Args& A, int gi, int nrows, LAS unsigned char* lds) {
    const bf16_t* Gb = (const bf16_t*)(A.ws + WS_BIG); const float* ST = (const float*)(A.ws + WS_RSTD); bf16_t* Ab = (bf16_t*)(A.ws + WS_R1);
    const bf16_t* WSg = (const bf16_t*)(A.ws + WS_W + W_GM + (size_t)gi * WG_SZ + WG_WS);
    const float* lng = A.in[I_GLNG] + (size_t)gi * 2048; const float* lnb = A.in[I_GLNB] + (size_t)gi * 2048; const float* bs = A.in[I_GBS] + (size_t)gi * 1024;
    const int tid = otid(), wid = tid >> 6, lane = tid & 63, r32 = lane & 31, hi = lane >> 5, tb = wid & 3, dh = wid >> 2;
    const int ldsaddr = (int)(unsigned)(uintptr_t)lds;
    u32x4 nv[8]; float nmu[8], nrs[8];
    const int nunits = (nrows / 128) * 8;
#define SP_LOADV(un) do { const int cb_ = (un) >> 3, gg_ = (un) & 7, r0_ = cb_ * 128; \
        _Pragma("unroll") for (int j = 0; j < 8; ++j) { const int idx = tid + 512 * j, s_ = idx >> 5, dd_ = (idx & 31) * 8; \
            nv[j] = *(const u32x4*)(Gb + (size_t)(r0_ + s_) * 4096 + 2048 + 256 * gg_ + dd_); nmu[j] = ST[r0_ + s_]; nrs[j] = ST[NROW + r0_ + s_]; } } while (0)
    if ((int)blockIdx.x < nunits) SP_LOADV((int)blockIdx.x);
    for (int unit = blockIdx.x; unit < nunits; unit += gridDim.x) {
        const int cb = unit >> 3, gg = unit & 7, r0 = cb * 128;
        __syncthreads();
#pragma unroll
        for (int j = 0; j < 8; ++j) { const int idx = tid + 512 * j, s = idx >> 5, dd = (idx & 31) * 8;
            const u32x4 w = nv[j];
            const float mu = nmu[j], rs = nrs[j];
            const f32x4 g0 = *(const f32x4*)(lng + 256 * gg + dd), g1 = *(const f32x4*)(lng + 256 * gg + dd + 4), b0 = *(const f32x4*)(lnb + 256 * gg + dd), b1 = *(const f32x4*)(lnb + 256 * gg + dd + 4);
            u32x4 o;
            o.x = cvt_pk_bf16((bflo(w.x) - mu) * rs * g0[0] + b0[0], (bfhi(w.x) - mu) * rs * g0[1] + b0[1]); o.y = cvt_pk_bf16((bflo(w.y) - mu) * rs * g0[2] + b0[2], (bfhi(w.y) - mu) * rs * g0[3] + b0[3]);
            o.z = cvt_pk_bf16((bflo(w.z) - mu) * rs * g1[0] + b1[0], (bfhi(w.z) - mu) * rs * g1[1] + b1[1]); o.w = cvt_pk_bf16((bflo(w.w) - mu) * rs * g1[2] + b1[2], (bfhi(w.w) - mu) * rs * g1[3] + b1[3]);
            *(LAS u32x4*)(lds + ((s >> 6) * 2 + (dd >> 7)) * 16384 + att::v_st(s & 63, dd & 127)) = o; }
        u32x2 uu[4][4];
        { const bf16_t* up = Gb + (size_t)(r0 + 32 * tb + r32) * 4096 + 256 * gg + 128 * dh + 4 * hi;
#pragma unroll
          for (int d0 = 0; d0 < 4; ++d0)
#pragma unroll
              for (int k = 0; k < 4; ++k) uu[d0][k] = *(const u32x2*)(up + 32 * d0 + 8 * k); }
        if (unit + (int)gridDim.x < nunits) SP_LOADV(unit + (int)gridDim.x);
        bf16x8 pa[8];
#pragma unroll
        for (int ks = 0; ks < 8; ++ks) pa[ks] = *(const bf16x8*)(WSg + ((size_t)gg * 128 + 32 * tb + r32) * 128 + 16 * ks + 8 * hi);
        __syncthreads();
        f32x16 o[4] = {};
#define SP_PV(D0, vbase, p0, p1, p2, p3) do { \
            const s16x4 l0 = att::tr_read<att::v_rd_off(D0, 0, 0)>(vbase), h0 = att::tr_read<att::v_rd_off(D0, 0, 1)>(vbase), l1 = att::tr_read<att::v_rd_off(D0, 1, 0)>(vbase), h1 = att::tr_read<att::v_rd_off(D0, 1, 1)>(vbase); \
            const s16x4 l2 = att::tr_read<att::v_rd_off(D0, 2, 0)>(vbase), h2 = att::tr_read<att::v_rd_off(D0, 2, 1)>(vbase), l3 = att::tr_read<att::v_rd_off(D0, 3, 0)>(vbase), h3 = att::tr_read<att::v_rd_off(D0, 3, 1)>(vbase); \
            asm volatile("s_waitcnt lgkmcnt(0)" ::: "memory"); __builtin_amdgcn_sched_barrier(0); \
            o[D0] = __builtin_amdgcn_mfma_f32_32x32x16_bf16((bf16x8){l0[0], l0[1], l0[2], l0[3], h0[0], h0[1], h0[2], h0[3]}, p0, o[D0], 0, 0, 0); \
            o[D0] = __builtin_amdgcn_mfma_f32_32x32x16_bf16((bf16x8){l1[0], l1[1], l1[2], l1[3], h1[0], h1[1], h1[2], h1[3]}, p1, o[D0], 0, 0, 0); \
            o[D0] = __builtin_amdgcn_mfma_f32_32x32x16_bf16((bf16x8){l2[0], l2[1], l2[2], l2[3], h2[0], h2[1], h2[2], h2[3]}, p2, o[D0], 0, 0, 0); \
            o[D0] = __builtin_amdgcn_mfma_f32_32x32x16_bf16((bf16x8){l3[0], l3[1], l3[2], l3[3], h3[0], h3[1], h3[2], h3[3]}, p3, o[D0], 0, 0, 0); } while (0)
        { const int vb0 = ldsaddr + (0 * 2 + dh) * 16384 + att::v_rd_base(lane), vb1 = ldsaddr + (1 * 2 + dh) * 16384 + att::v_rd_base(lane);
          SP_PV(0, vb0, pa[0], pa[1], pa[2], pa[3]); SP_PV(1, vb0, pa[0], pa[1], pa[2], pa[3]); SP_PV(2, vb0, pa[0], pa[1], pa[2], pa[3]); SP_PV(3, vb0, pa[0], pa[1], pa[2], pa[3]);
          SP_PV(0, vb1, pa[4], pa[5], pa[6], pa[7]); SP_PV(1, vb1, pa[4], pa[5], pa[6], pa[7]); SP_PV(2, vb1, pa[4], pa[5], pa[6], pa[7]); SP_PV(3, vb1, pa[4], pa[5], pa[6], pa[7]); }
#undef SP_PV
        { const int t = 32 * tb + r32, row = r0 + t; const float bsv = bs[gg * 128 + t];
          bf16_t* ap = Ab + (size_t)row * 2048 + 256 * gg + 128 * dh + 4 * hi;
#pragma unroll
          for (int d0 = 0; d0 < 4; ++d0)
#pragma unroll
              for (int k = 0; k < 4; ++k) {
                  const u32x2 u2 = uu[d0][k];
                  u32x2 w; w.x = cvt_pk_bf16(bflo(u2.x) * (o[d0][4 * k] + bsv), bfhi(u2.x) * (o[d0][4 * k + 1] + bsv)); w.y = cvt_pk_bf16(bflo(u2.y) * (o[d0][4 * k + 2] + bsv), bfhi(u2.y) * (o[d0][4 * k + 3] + bsv));
                  *(u32x2*)(ap + 32 * d0 + 8 * k) = w; } }
    }
#undef SP_LOADV
}

constexpr int NSL = 8, SW = 1024 / NSL;
constexpr size_t TAB8_HALF = (size_t)NEXP * 1024, TAB_SCL = 2 * TAB8_HALF;
constexpr float HS = 4.f;
__device__ __forceinline__ void phase_tabcvt(const Args& A, int layer, int wg, int nwg) {
    const int tid_ = otid(); const int lane = tid_ & 63, gw = wg * 8 + (tid_ >> 6), nw = nwg * 8;
    float* SCL = (float*)(A.ws + WS_TAB + TAB_SCL);
    for (int r = gw; r < 2 * NEXP; r += nw) {
        const int tab = r >> 14, e = r & (NEXP - 1);
        const float* src = (tab ? A.in[I_PV] : A.in[I_PU]) + ((size_t)layer * NEXP + e) * 1024 + 16 * lane;
        f32x4 v[4]; float am = 0.f;
#pragma unroll
        for (int i = 0; i < 4; ++i) { v[i] = *(const f32x4*)(src + 4 * i); am = fmaxf(am, fmaxf(fmaxf(fabsf(v[i][0]), fabsf(v[i][1])), fmaxf(fabsf(v[i][2]), fabsf(v[i][3])))); }
#pragma unroll
        for (int o = 32; o >= 1; o >>= 1) am = fmaxf(am, __shfl_xor(am, o));
        float sc = 1.f; if (am > 0.f) { int ex; (void)frexpf(448.f / am, &ex); sc = ldexpf(1.f, ex - 1); }
        if (lane == 0) SCL[tab * NEXP + e] = 1.f / sc;
        u32x4 w;
#pragma unroll
        for (int i = 0; i < 4; ++i) w[i] = pk4_fp8(v[i][0] * sc, v[i][1] * sc, v[i][2] * sc, v[i][3] * sc);
        *(u32x4*)(A.ws + WS_TAB + (size_t)tab * TAB8_HALF + ((size_t)(lane >> 3) * NEXP + e) * SW + 16 * (lane & 7)) = w;
    }
}
#define CASD(a, b) do { const float hi_ = fmaxf(a, b), lo_ = fminf(a, b); a = hi_; b = lo_; } while (0)
__device__ __forceinline__ void sort16(float (&k)[16]) {
#pragma unroll
    for (int sz = 2; sz <= 16; sz <<= 1)
#pragma unroll
        for (int j = sz >> 1; j > 0; j >>= 1)
#pragma unroll
            for (int i = 0; i < 16; ++i) { const int l = i ^ j; if (l > i) { if ((i & sz) == 0 || sz == 16) CASD(k[i], k[l]); else CASD(k[l], k[i]); } }
}
__device__ __forceinline__ void bmerge16(float (&k)[16]) {
#pragma unroll
    for (int j = 8; j > 0; j >>= 1)
#pragma unroll
        for (int i = 0; i < 16; ++i) { const int l = i ^ j; if (l > i) CASD(k[i], k[l]); }
}
__device__ __forceinline__ void merge_top16(float (&a)[16], const float (&b)[16]) {
#pragma unroll
    for (int i = 0; i < 16; ++i) a[i] = fmaxf(a[i], b[15 - i]);
    bmerge16(a);
}
__device__ __forceinline__ void xmerge_top16(float (&a)[16], int mask) {
    float t[16];
#pragma unroll
    for (int i = 0; i < 16; ++i) t[i] = __shfl_xor(a[15 - i], mask);
#pragma unroll
    for (int i = 0; i < 16; ++i) a[i] = fmaxf(a[i], t[i]);
    bmerge16(a);
}
__device__ __forceinline__ void phase_topk(const Args& A, int layer, int nrows, LAS unsigned char* lds) {
    const bf16_t* QP = (const bf16_t*)(A.ws + WS_BIG); int* IDX = (int*)(A.ws + WS_R2); float* GATE = (float*)(A.ws + WS_R2 + R2_GATE);
    const int tid = otid(), wid = tid >> 6, lane = tid & 63, fr = lane & 15, fq = lane >> 4;
    LAS unsigned* scr = (LAS unsigned*)(lds + 2 * 34816) + wid * 512 + fr * 32;
    int h_staged = -1;
    for (int unit = blockIdx.x; unit < (nrows / 128) * 8; unit += gridDim.x) {
        const int h = unit & 7, r0 = (unit >> 3) * 128;
        if (h != h_staged) { h_staged = h;
        __syncthreads();
        { const bf16_t* k1 = (const bf16_t*)(A.ws + WS_W + W_PEER + (size_t)layer * WP_SZ + WP_K1) + (size_t)h * 16384;
#pragma unroll
          for (int j = 0; j < 8; ++j) { const int idx = tid + 512 * j, half = idx >> 11, rem = idx & 2047, key = rem >> 4, c8 = rem & 15;
              const u32x4 w = *(const u32x4*)(k1 + (size_t)half * 8 * 16384 + key * 128 + 8 * c8);
              *(LAS u32x4*)(lds + half * 34816 + key * 272 + c8 * 16) = w; } }
        __syncthreads(); }
        const int tok = r0 + 16 * wid + fr;
        float top[2][16];
#pragma unroll
        for (int half = 0; half < 2; ++half) {
            bf16x8 qf[4];
#pragma unroll
            for (int ks = 0; ks < 4; ++ks) qf[ks] = *(const bf16x8*)(QP + (size_t)tok * 2048 + 256 * h + 128 * half + 32 * ks + 8 * fq);
            float loc[16];
#pragma unroll
            for (int grp = 0; grp < 2; ++grp) {
                float kk[16];
#pragma unroll
                for (int nbb = 0; nbb < 4; ++nbb) { const int nb = 4 * grp + nbb; f32x4 acc = {0.f, 0.f, 0.f, 0.f};
#pragma unroll
                    for (int ks = 0; ks < 4; ++ks) { const bf16x8 kf = *(const LAS bf16x8*)(lds + half * 34816 + (16 * nb + fr) * 272 + (32 * ks + 8 * fq) * 2);
                        acc = __builtin_amdgcn_mfma_f32_16x16x32_bf16(kf, qf[ks], acc, 0, 0, 0); }
#pragma unroll
                    for (int i = 0; i < 4; ++i) { const unsigned code = 127u - (unsigned)(16 * nb + 4 * fq + i); kk[4 * nbb + i] = __uint_as_float((__float_as_uint(acc[i]) & ~127u) | code); } }
                sort16(kk);
                if (grp == 0) {
#pragma unroll
                    for (int i = 0; i < 16; ++i) loc[i] = kk[i];
                } else merge_top16(loc, kk);
            }
            xmerge_top16(loc, 16); xmerge_top16(loc, 32);
#pragma unroll
            for (int i = 0; i < 16; ++i) top[half][i] = loc[i];
        }
        if (fq < 2) {
#pragma unroll
            for (int i = 0; i < 16; ++i) scr[16 * fq + i] = __float_as_uint(fq == 0 ? top[0][i] : top[1][i]); }
        float fin[16];
#pragma unroll
        for (int aa = 0; aa < 4; ++aa) {
            const float va_k = fq == 0 ? top[0][aa] : fq == 1 ? top[0][4 + aa] : fq == 2 ? top[0][8 + aa] : top[0][12 + aa];
            const float va = __uint_as_float(__float_as_uint(va_k) & ~127u);
            float c[16];
#pragma unroll
            for (int bb = 0; bb < 16; ++bb) { const float s = va + __uint_as_float(__float_as_uint(top[1][bb]) & ~127u);
                c[bb] = __uint_as_float((__float_as_uint(s) & ~255u) | (255u - (unsigned)((4 * fq + aa) * 16 + bb))); }
            if (aa == 0) {
#pragma unroll
                for (int i = 0; i < 16; ++i) fin[i] = c[i];
            } else merge_top16(fin, c);
        }
        xmerge_top16(fin, 16); xmerge_top16(fin, 32);
        float ev[16], es = 0.f; const float mx = __uint_as_float(__float_as_uint(fin[0]) & ~255u);
#pragma unroll
        for (int i = 0; i < 16; ++i) { ev[i] = __expf(__uint_as_float(__float_as_uint(fin[i]) & ~255u) - mx); es += ev[i]; }
        const float inv = 1.f / es;
        asm volatile("s_waitcnt lgkmcnt(0)" ::: "memory");
        int oi[4]; float og[4];
#pragma unroll
        for (int kq = 0; kq < 4; ++kq) {
            const float fk = fq == 0 ? fin[kq] : fq == 1 ? fin[4 + kq] : fq == 2 ? fin[8 + kq] : fin[12 + kq];
            const float fe = fq == 0 ? ev[kq] : fq == 1 ? ev[4 + kq] : fq == 2 ? ev[8 + kq] : ev[12 + kq];
            const unsigned code = 255u - (__float_as_uint(fk) & 255u), a = code >> 4, bq = code & 15u;
            const unsigned i1 = 127u - (scr[a] & 127u), i2 = 127u - (scr[16 + bq] & 127u);
            oi[kq] = (int)(i1 * 128u + i2); og[kq] = fe * inv; }
        *(int4*)(IDX + (size_t)tok * 128 + 16 * h + 4 * fq) = make_int4(oi[0], oi[1], oi[2], oi[3]);
        *(f32x4*)(GATE + (size_t)tok * 128 + 16 * h + 4 * fq) = (f32x4){og[0], og[1], og[2], og[3]};
    }
}
struct PeerSched {
    int x0, rank, nloc, nblk, nown; unsigned orphan;
    __device__ __forceinline__ void init(const Args& A, int nrows, LAS unsigned char* smem) {
        unsigned* ctl = (unsigned*)(A.ws + WS_CTL);
        x0 = (int)(xb_xcc_id() & 7u); rank = __builtin_amdgcn_readfirstlane((int)((LAS unsigned*)smem)[8]); nblk = nrows / 64;
        unsigned cached = __builtin_amdgcn_readfirstlane(((LAS unsigned*)smem)[9]);
        if (cached == 0u) { unsigned orph = 0u, nl = 1u;
            for (int j = 0; j < 8; ++j) { unsigned c = xb_ld(&ctl[XB_XCNT(j)]) + xb_ld(&ctl[XB_XCNT(j + 8)]); c = __builtin_amdgcn_readfirstlane(c); if (c == 0u) orph |= 1u << j; if (j == x0) nl = c; }
            cached = (nl << 8) | orph; __syncthreads(); if (threadIdx.x == 0) ((LAS unsigned*)smem)[9] = cached; __syncthreads(); }
        nloc = (int)(cached >> 8); orphan = cached & 0xffu;
        const int tot = (NSL / 8) * nblk; nown = rank < tot ? (tot - rank + nloc - 1) / nloc : 0;
    }
    __device__ __forceinline__ bool item(int j, int& sl, int& blk) const {
        if (j < nown) { const int i = rank + j * nloc; sl = x0 + 8 * (i / nblk); blk = i % nblk; return true; }
        int jj = j - nown; const int tot = (NSL / 8) * nblk, per = ((int)gridDim.x > tot) ? 1 : 0; (void)per;
        for (int o = 0; o < 8; ++o) if ((orphan >> o) & 1u) { const int cnt = ((int)blockIdx.x < tot) ? (tot - (int)blockIdx.x + (int)gridDim.x - 1) / (int)gridDim.x : 0;
            if (jj < cnt) { const int i = (int)blockIdx.x + jj * (int)gridDim.x; sl = o + 8 * (i / nblk); blk = i % nblk; return true; } jj -= cnt; }
        return false;
    }
};
template <class LD, class ST, class PR>
__device__ __forceinline__ void peer_items(const PeerSched& S, LD ld, ST st, PR pr) {
    int sl, blk, sln, blkn, j = 0, buf = 0; bool have = S.item(0, sl, blk);
    if (have) { ld(sl, blk, 0); st(0); }
    while (have) {
        const bool haven = S.item(j + 1, sln, blkn);
        asm volatile("s_waitcnt vmcnt(0)" ::: "memory");
        __syncthreads();
        if (haven) ld(sln, blkn, buf ^ 1);
        pr(sl, blk, buf);
        if (haven) st(buf ^ 1);
        sl = sln; blk = blkn; have = haven; buf ^= 1; ++j;
    }
    __syncthreads();
}
#ifndef MK_UVAR
#define MK_UVAR 0
#endif
__device__ __forceinline__ float dpp_sum8(float v) {
    v += __builtin_bit_cast(float, __builtin_amdgcn_mov_dpp(__builtin_bit_cast(int, v), 0xB1, 0xF, 0xF, true));
    v += __builtin_bit_cast(float, __builtin_amdgcn_mov_dpp(__builtin_bit_cast(int, v), 0x4E, 0xF, 0xF, true));
    v += __builtin_bit_cast(float, __builtin_amdgcn_mov_dpp(__builtin_bit_cast(int, v), 0x141, 0xF, 0xF, true));
    return v;
}
__device__ __forceinline__ void phase_peer_u(const Args& A, int layer, int nrows, LAS unsigned char* smem, int rep) {
    const int var = rep ? MK_UVAR : 0;
    const bf16_t* H = (const bf16_t*)(A.ws + WS_H); const int* IDX = (const int*)(A.ws + WS_R2); float* PART = var ? (float*)(A.ws + WS_R1) : (float*)(A.ws + WS_BIG + BIG_PART);
    const unsigned char* U = A.ws + WS_TAB;
    LAS unsigned char* lds = smem + LDS_BASE;
    constexpr int BUF = 32768 + 64 * SW * 2;
    const int tid = otid(), wid = tid >> 6, lane = tid & 63, m = lane & 7, tk = lane >> 3;
    PeerSched S; S.init(A, nrows, smem);
    const int wu = __builtin_amdgcn_readfirstlane(wid);
    peer_items(S,
        [&](int sl, int blk, int buf) {
#pragma unroll
            for (int i = 0; i < 4; ++i)
                __builtin_amdgcn_global_load_lds((const unsigned*)(IDX + (size_t)blk * 64 * 128 + 256 * (wu + 8 * i) + 4 * lane), (LAS unsigned*)(lds + buf * BUF + 1024 * (wu + 8 * i)), 16, 0, 0);
#pragma unroll
            for (int i = 0; i < 2; ++i) { const int pc = wu + 8 * i;
                __builtin_amdgcn_global_load_lds((const unsigned*)(H + (size_t)(blk * 64 + 4 * pc + (lane >> 4)) * 1024 + SW * sl + 8 * (lane & 15)), (LAS unsigned*)(lds + buf * BUF + 32768 + 1024 * pc), 16, 0, 0); } },
        [&](int buf) { },
        [&](int sl, int blk, int buf) {
            const unsigned char* ub = U + (size_t)sl * NEXP * SW + 16 * m;
            const int tokl = wid * 8 + tk, tok = blk * 64 + tokl;
            const LAS int* ib = (const LAS int*)(lds + buf * BUF) + tokl * 128;
            float hf[16];
            { const u32x4 h0 = *(const LAS u32x4*)(lds + buf * BUF + 32768 + tokl * 256 + 32 * m), h1 = *(const LAS u32x4*)(lds + buf * BUF + 32768 + tokl * 256 + 32 * m + 16);
#pragma unroll
              for (int j = 0; j < 4; ++j) { hf[2 * j] = bflo(h0[j]); hf[2 * j + 1] = bfhi(h0[j]); hf[8 + 2 * j] = bflo(h1[j]); hf[8 + 2 * j + 1] = bfhi(h1[j]); } }
            float* pp = PART + ((size_t)sl * NROW + tok) * 128 + m;
            u32x4 vv[2][8];
#define PU_ROWS(T, c) do { const i32x4 e0_ = *(const LAS i32x4*)(ib + 8 * (c)), e1_ = *(const LAS i32x4*)(ib + 8 * (c) + 4); \
                if (var == 4) { _Pragma("unroll") for (int k_ = 0; k_ < 8; ++k_) vv[T][k_] = (u32x4){(unsigned)e0_.x, (unsigned)e1_.y, 0u, 0u}; } else { \
                vv[T][0] = *(const u32x4*)(ub + (size_t)(var == 3 ? e0_.x & 63 : e0_.x) * SW); vv[T][1] = *(const u32x4*)(ub + (size_t)(var == 3 ? e0_.y & 63 : e0_.y) * SW); \
                vv[T][2] = *(const u32x4*)(ub + (size_t)(var == 3 ? e0_.z & 63 : e0_.z) * SW); vv[T][3] = *(const u32x4*)(ub + (size_t)(var == 3 ? e0_.w & 63 : e0_.w) * SW); \
                vv[T][4] = *(const u32x4*)(ub + (size_t)(var == 3 ? e1_.x & 63 : e1_.x) * SW); vv[T][5] = *(const u32x4*)(ub + (size_t)(var == 3 ? e1_.y & 63 : e1_.y) * SW); \
                vv[T][6] = *(const u32x4*)(ub + (size_t)(var == 3 ? e1_.z & 63 : e1_.z) * SW); vv[T][7] = *(const u32x4*)(ub + (size_t)(var == 3 ? e1_.w & 63 : e1_.w) * SW); } } while (0)
#define PU_DOT(T, c) do { float mine_ = 0.f; \
                _Pragma("unroll") for (int k = 0; k < 8; ++k) { f32x2 a2 = {0.f, 0.f}; \
                    _Pragma("unroll") for (int j = 0; j < 4; ++j) { const int w = (int)vv[T][k][j]; \
                        const f32x2 lo = __builtin_amdgcn_cvt_pk_f32_fp8(w, false), hi = __builtin_amdgcn_cvt_pk_f32_fp8(w, true); \
                        a2 = __builtin_elementwise_fma(lo, (f32x2){hf[4 * j], hf[4 * j + 1]}, a2); a2 = __builtin_elementwise_fma(hi, (f32x2){hf[4 * j + 2], hf[4 * j + 3]}, a2); } \
                    const float tot_ = dpp_sum8(a2.x + a2.y); mine_ = m == k ? tot_ : mine_; } \
                pp[8 * (c)] = mine_; } while (0)
            PU_ROWS(0, 0);
#pragma unroll 1
            for (int c = 0; c < 16; c += 2) {
                PU_ROWS(1, c + 1);
                __builtin_amdgcn_sched_barrier(0);
                PU_DOT(0, c);
                __builtin_amdgcn_sched_barrier(0);
                if (c + 2 < 16) PU_ROWS(0, c + 2);
                __builtin_amdgcn_sched_barrier(0);
                PU_DOT(1, c + 1);
                __builtin_amdgcn_sched_barrier(0);
            }
#undef PU_ROWS
#undef PU_DOT
        });
}
__device__ __forceinline__ void phase_coef(const Args& A, int nrows) {
    const float* PART = (const float*)(A.ws + WS_BIG + BIG_PART); const float* GATE = (const float*)(A.ws + WS_R2 + R2_GATE); float* COEF = (float*)(A.ws + WS_R2 + R2_COEF);
    const int* IDX = (const int*)(A.ws + WS_R2); const float* SCL = (const float*)(A.ws + WS_TAB + TAB_SCL);
    const int gthr = blockIdx.x * NTHR + otid(), nthr = gridDim.x * NTHR;
    for (int p = gthr; p < nrows * 32; p += nthr) {
        f32x4 s = {0.f, 0.f, 0.f, 0.f};
#pragma unroll
        for (int x = 0; x < NSL; ++x) s += *(const f32x4*)(PART + (size_t)x * NROW * 128 + 4 * p);
        const i32x4 e = *(const i32x4*)(IDX + 4 * p); const f32x4 gt = *(const f32x4*)(GATE + 4 * p);
        const f32x4 su = {SCL[e.x], SCL[e.y], SCL[e.z], SCL[e.w]}, sv = {SCL[NEXP + e.x], SCL[NEXP + e.y], SCL[NEXP + e.z], SCL[NEXP + e.w]};
        const f32x4 a = s * su; const f32x2 g0 = gelu_pk((f32x2){a[0], a[1]}), g1 = gelu_pk((f32x2){a[2], a[3]});
        *(f32x4*)(COEF + 4 * p) = gt * (f32x4){g0.x, g0.y, g1.x, g1.y} * sv; }

}
__device__ __forceinline__ void phase_peer_v(const Args& A, int layer, int nrows, LAS unsigned char* smem, int rep) {
    const int* IDX = (const int*)(A.ws + WS_R2); const float* COEF = (const float*)(A.ws + WS_R2 + R2_COEF);
    const unsigned char* V = A.ws + WS_TAB + TAB8_HALF; const float* MODL = (const float*)(A.ws + WS_MOD) + (size_t)layer * 5 * 6144 + 5 * 1024;
    float* XC = (float*)(A.ws + WS_XC);
    LAS unsigned char* lds = smem + LDS_BASE;
    constexpr int BUF = 65536;
    const int tid = otid(), wid = tid >> 6, lane = tid & 63, m = lane & 7, tk = lane >> 3;
    PeerSched S; S.init(A, nrows, smem);
    const int wu = __builtin_amdgcn_readfirstlane(wid);
    peer_items(S,
        [&](int sl, int blk, int buf) {
#pragma unroll
            for (int i = 0; i < 4; ++i) {
                __builtin_amdgcn_global_load_lds((const unsigned*)(IDX + (size_t)blk * 64 * 128 + 256 * (wu + 8 * i) + 4 * lane), (LAS unsigned*)(lds + buf * BUF + 1024 * (wu + 8 * i)), 16, 0, 0);
                __builtin_amdgcn_global_load_lds((const unsigned*)(COEF + (size_t)blk * 64 * 128 + 256 * (wu + 8 * i) + 4 * lane), (LAS unsigned*)(lds + buf * BUF + 32768 + 1024 * (wu + 8 * i)), 16, 0, 0); } },
        [&](int buf) { },
        [&](int sl, int blk, int buf) {
            const unsigned char* vb = V + (size_t)sl * NEXP * SW + 16 * m;
            const int tokl = wid * 8 + tk, tok = blk * 64 + tokl; const bool lat = tok < NLAT;
            const LAS int* ib = (const LAS int*)(lds + buf * BUF) + tokl * 128; const LAS float* cb = (const LAS float*)(lds + buf * BUF + 32768) + tokl * 128;
            float* xp = (lat ? A.out + (size_t)tok * D : XC + (size_t)(tok - NLAT) * D) + SW * sl + 16 * m;
            f32x4 xr[4];
#pragma unroll
            for (int j = 0; j < 4; ++j) xr[j] = *(f32x4*)(xp + 4 * j);
            f32x2 acc2[8];
#pragma unroll
            for (int j = 0; j < 8; ++j) acc2[j] = (f32x2){0.f, 0.f};
            u32x4 vv[2][8];
#define PV_ROWS(T, c) do { const i32x4 e0_ = *(const LAS i32x4*)(ib + 8 * (c)), e1_ = *(const LAS i32x4*)(ib + 8 * (c) + 4); \
                vv[T][0] = *(const u32x4*)(vb + (size_t)e0_.x * SW); vv[T][1] = *(const u32x4*)(vb + (size_t)e0_.y * SW); vv[T][2] = *(const u32x4*)(vb + (size_t)e0_.z * SW); vv[T][3] = *(const u32x4*)(vb + (size_t)e0_.w * SW); \
                vv[T][4] = *(const u32x4*)(vb + (size_t)e1_.x * SW); vv[T][5] = *(const u32x4*)(vb + (size_t)e1_.y * SW); vv[T][6] = *(const u32x4*)(vb + (size_t)e1_.z * SW); vv[T][7] = *(const u32x4*)(vb + (size_t)e1_.w * SW); } while (0)
#define PV_FMA(T, c) do { const f32x4 c0_ = *(const LAS f32x4*)(cb + 8 * (c)), c1_ = *(const LAS f32x4*)(cb + 8 * (c) + 4); \
                _Pragma("unroll") for (int k = 0; k < 8; ++k) { const float cf = k < 4 ? c0_[k & 3] : c1_[k & 3]; \
                    _Pragma("unroll") for (int j = 0; j < 4; ++j) { const int w = (int)vv[T][k][j]; \
                        const f32x2 lo = __builtin_amdgcn_cvt_pk_f32_fp8(w, false), hi = __builtin_amdgcn_cvt_pk_f32_fp8(w, true); const f32x2 c2 = {cf, cf}; \
                        acc2[2 * j] = __builtin_elementwise_fma(lo, c2, acc2[2 * j]); acc2[2 * j + 1] = __builtin_elementwise_fma(hi, c2, acc2[2 * j + 1]); } } } while (0)
            PV_ROWS(0, 0);
#pragma unroll 1
            for (int c = 0; c < 16; c += 2) {
                PV_ROWS(1, c + 1);
                __builtin_amdgcn_sched_barrier(0);
                PV_FMA(0, c);
                __builtin_amdgcn_sched_barrier(0);
                if (c + 2 < 16) PV_ROWS(0, c + 2);
                __builtin_amdgcn_sched_barrier(0);
                PV_FMA(1, c + 1);
                __builtin_amdgcn_sched_barrier(0);
            }
#undef PV_ROWS
#undef PV_FMA
            const float* gp = MODL + (size_t)(lat ? (tok >> 13) : 4) * 6144 + SW * sl + 16 * m;
#pragma unroll
            for (int j = 0; j < 4; ++j) { const f32x4 g = *(const f32x4*)(gp + 4 * j);
                *(f32x4*)(xp + 4 * j) = xr[j] + g * (f32x4){acc2[2 * j].x, acc2[2 * j].y, acc2[2 * j + 1].x, acc2[2 * j + 1].y}; }
        });
}

#ifdef MK_CHECK
constexpr int CW_CHK = 3840;
__device__ __forceinline__ float blk_sum(float v, LAS float* red) {
    const int t_ = otid(); v = wave_sum(v); __syncthreads(); if ((t_ & 63) == 0) red[t_ >> 6] = v; __syncthreads();
    float s = 0.f; for (int i = 0; i < 8; ++i) s += red[i]; __syncthreads(); return s;
}
__device__ __forceinline__ float fp8f(unsigned b) { const unsigned e = (b >> 3) & 15u, m = b & 7u; const float v = e ? ldexpf(1.f + (float)m * 0.125f, (int)e - 7) : ldexpf((float)m * 0.125f, -6); return (b & 0x80u) ? -v : v; }
__device__ __forceinline__ void check_attn(const Args& A, LAS unsigned char* lds) {
    const unsigned char* Q = A.ws + WS_R1 + R1_Q; const unsigned char* KN = A.ws + WS_R1 + R1_KN; const unsigned char* KR = A.ws + WS_BIG + BIG_KR; const unsigned char* V = A.ws + WS_R1 + R1_V;
    const bf16_t* CAT = (const bf16_t*)(A.ws + WS_R3 + R3_CAT); float* chk = (float*)(A.ws + WS_CTL) + CW_CHK;
    LAS float* p = (LAS float*)lds; LAS float* qv = p + NKEY; LAS float* red = qv + 192;
    const int tid = otid(), sidx = blockIdx.x;
    const int b = sidx & 3, h = (sidx >> 2) & 7, l = (int)(((unsigned)sidx * 2654435761u) >> 19) & 8191;
    const size_t bh = (size_t)(b * 8 + h);
    if (tid < 192) qv[tid] = fp8f(Q[(bh * NKEY + 256 + l) * 192 + tid]) * (1.f / att8::QUP);
    __syncthreads();
    float mx = -1e30f;
    for (int key = tid; key < NKEY; key += 512) { const int t = key >> 6, k = key & 63; float s = 0.f;
        for (int d = 0; d < 128; ++d) s += qv[d] * fp8f(KN[(bh * NKT + t) * 8192 + att8::kn8(k, d)]);
        for (int d = 0; d < 64; ++d) s += qv[128 + d] * fp8f(KR[((size_t)b * NKT + t) * 4096 + att8::kr8(k, d)]);
        p[key] = s; mx = fmaxf(mx, s); }
    for (int o = 32; o >= 1; o >>= 1) mx = fmaxf(mx, __shfl_xor(mx, o));
    __syncthreads(); if ((tid & 63) == 0) red[tid >> 6] = mx; __syncthreads(); mx = red[0]; for (int i = 1; i < 8; ++i) mx = fmaxf(mx, red[i]); __syncthreads();
    float ls = 0.f; for (int key = tid; key < NKEY; key += 512) { const float e = exp2f(p[key] - mx); p[key] = e; ls += e; }
    ls = blk_sum(ls, red);
    float num = 0.f, den = 0.f;
    if (tid < 128) { float o = 0.f; for (int key = 0; key < NKEY; ++key) o += p[key] * fp8f(V[(bh * NKT + (key >> 6)) * 8192 + att8::v8(tid, key & 63)]);
        o /= ls; const float got = bf2f(CAT[(size_t)(b * 8192 + l) * 2048 + 1024 + 128 * h + tid]); num = (got - o) * (got - o); den = o * o; }
    num = blk_sum(num, red); den = blk_sum(den, red);
    if (tid == 0) { atomicAdd(chk, num); atomicAdd(chk + 1, den); }
}
__device__ __forceinline__ void check_qkv(const Args& A, int li, LAS unsigned char* lds) {
    float* chk = (float*)(A.ws + WS_CTL) + CW_CHK;
    const unsigned char* Q = A.ws + WS_R1 + R1_Q; const unsigned char* KN = A.ws + WS_R1 + R1_KN; const unsigned char* KR = A.ws + WS_BIG + BIG_KR; const unsigned char* V = A.ws + WS_R1 + R1_V;
    LAS float* hv = (LAS float*)lds; LAS float* cq = hv + 1024; LAS float* ckv = cq + 384; LAS float* kr = ckv + 256; LAS float* red = kr + 64; LAS float* ov = red + 16;
    const int tid = otid(), sidx = blockIdx.x;
    const int hd = sidx & 7; const int r = (sidx & 8) ? NLAT + (int)(((unsigned)sidx * 2654435761u) >> 22) : (int)(((unsigned)sidx * 2654435761u) >> 17);
    const float* win = A.in[I_HWIN] + (size_t)li * 1024 * HYB_IN;
    {
        const float* xp = r < NLAT ? A.out + (size_t)r * D : (const float*)(A.ws + WS_XC) + (size_t)(r - NLAT) * D; const float* MODL = (const float*)(A.ws + WS_MOD) + (size_t)(2 * li) * 5 * 6144 + (size_t)row_mb(r) * 6144;
        float ss = 0.f; for (int i = tid; i < 1024; i += 512) ss += xp[i] * xp[i];
        ss = blk_sum(ss, red); const float rstd = rsqrtf(ss / 1024.f + EPS);
        for (int i = tid; i < 1024; i += 512) hv[i] = bf2f(f2bf(xp[i] * rstd * A.in[I_N1G][(2 * li) * 1024 + i] * (1.f + MODL[1024 + i]) + MODL[i])); }
    __syncthreads();
    for (int j = tid; j < 704; j += 512) { float s = 0.f; for (int k = 0; k < 1024; ++k) s += hv[k] * win[(size_t)k * HYB_IN + C_CQ + j];
        s = bf2f(f2bf(s)); if (j < 384) cq[j] = s; else if (j < 640) ckv[j - 384] = s; else kr[j - 640] = s; }
    __syncthreads();
    float sq = 0.f, sk = 0.f; for (int j = tid; j < 384; j += 512) sq += cq[j] * cq[j]; for (int j = tid; j < 256; j += 512) sk += ckv[j] * ckv[j];
    sq = blk_sum(sq, red); sk = blk_sum(sk, red);
    const float rq = rsqrtf(sq / 384.f + EPS), rk = rsqrtf(sk / 256.f + EPS);
    const float* wqb = A.in[I_WQB] + (size_t)li * 384 * 1536; const float* wkvb = A.in[I_WKVB] + (size_t)li * 256 * 2048; const float* qg = A.in[I_QNG] + li * 384; const float* kg = A.in[I_KVNG] + li * 256;
    if (tid < 192) { float s = 0.f; for (int k = 0; k < 384; ++k) s += cq[k] * rq * qg[k] * wqb[(size_t)k * 1536 + hd * 192 + tid]; ov[tid] = s; }
    else if (tid < 448) { const int c = tid - 192; float s = 0.f; for (int k = 0; k < 256; ++k) s += ckv[k] * rk * kg[k] * wkvb[(size_t)k * 2048 + hd * 256 + c]; ov[tid] = s; }
    __syncthreads();
    const bool lat = r < NLAT; const int b = lat ? (r >> 13) : ((r - NLAT) >> 8), l = lat ? (r & 8191) : 0, key = lat ? 256 + l : ((r - NLAT) & 255), qrow = key;
    const size_t bh = (size_t)(b * 8 + hd); const float qs = QSCALE * att8::QUP;
    float num = 0.f, den = 0.f;
    if (tid < 128) {
        const float q = ov[tid] * qs, gq = fp8f(Q[(bh * NKEY + qrow) * 192 + tid]);
        const float kk = ov[192 + tid], gk = fp8f(KN[(bh * NKT + (key >> 6)) * 8192 + att8::kn8(key & 63, tid)]);
        const float vv = ov[320 + tid], gv = fp8f(V[(bh * NKT + (key >> 6)) * 8192 + att8::v8(tid, key & 63)]);
        num = (gq - q) * (gq - q) + (gk - kk) * (gk - kk) + (gv - vv) * (gv - vv); den = q * q + kk * kk + vv * vv;
    } else if (tid < 160) {
        const int i = tid - 128; float c = 1.f, sn = 0.f;
        if (lat) { const float pos = (float)(i < 16 ? (l >> 6) : (l & 63)); const float ang = pos * powf(10000.f, -(float)(i & 15) / 16.f); c = cosf(ang); sn = sinf(ang); }
        const float q1 = ov[128 + i] * qs, q2 = ov[160 + i] * qs, k1 = kr[i], k2 = kr[32 + i];
        const float rq1 = q1 * c - q2 * sn, rq2 = q1 * sn + q2 * c, rk1 = k1 * c - k2 * sn, rk2 = k1 * sn + k2 * c;
        const float gq1 = fp8f(Q[(bh * NKEY + qrow) * 192 + 128 + 2 * i]), gq2 = fp8f(Q[(bh * NKEY + qrow) * 192 + 128 + 2 * i + 1]);
        const float gk1 = fp8f(KR[((size_t)b * NKT + (key >> 6)) * 4096 + att8::kr8(key & 63, 2 * i)]), gk2 = fp8f(KR[((size_t)b * NKT + (key >> 6)) * 4096 + att8::kr8(key & 63, 2 * i + 1)]);
        num = (gq1 - rq1) * (gq1 - rq1) + (gq2 - rq2) * (gq2 - rq2) + (gk1 - rk1) * (gk1 - rk1) + (gk2 - rk2) * (gk2 - rk2); den = rq1 * rq1 + rq2 * rq2 + rk1 * rk1 + rk2 * rk2;
    }
    num = blk_sum(num, red); den = blk_sum(den, red);
    if (tid == 0) { atomicAdd(chk, num); atomicAdd(chk + 1, den); }
}
#endif
#ifndef MK_PER_PHASE
#define MK_PER_PHASE 0
#endif
__device__ __forceinline__ int nr_in(int L) { return L <= 2 ? NROW : NLAT; }
__device__ __forceinline__ int nr_out(int L) { return L <= 1 ? NROW : NLAT; }

__global__ void __launch_bounds__(NTHR, 2) fwd(Args A) {
    extern __shared__ __attribute__((aligned(256))) unsigned char smem_raw[];
    LAS unsigned char* smem = (LAS unsigned char*)smem_raw;
    LAS unsigned char* lds = smem + LDS_BASE;
    const int tid = otid();
    if (tid < 64) ((LAS unsigned*)smem)[tid] = 0u;
    __syncthreads();
    XcdBarrier bar = xcd_barrier_post((unsigned*)(A.ws + WS_CTL), (volatile LAS unsigned*)smem);
    if (tid == 0) ((LAS unsigned*)smem)[8] = atomicAdd((unsigned*)(A.ws + WS_CTL) + CW_RANK + 32 * (xb_xcc_id() & 7u), 1u);
    __syncthreads();
    bool need_bar = false;
    const int lo = A.ph_lo, hi = A.ph_hi;
#ifndef PHMASK
#define PHMASK 0xffffffffu
#endif
#define SITE(k) if constexpr (((PHMASK) >> (k)) & 1u)
#ifndef MK_SVAR
#define MK_SVAR 1
#endif
#ifndef MK_REPEAT_SITE
#define MK_REPEAT_SITE -1
#endif
#define REP(k) for (int rep = 0; rep < ((k) == (MK_REPEAT_SITE) ? 2 : 1); ++rep)
#define PH(id) if ([&]() -> bool { if ((id) < lo || (id) >= hi) return false; if (need_bar) xcd_barrier(bar); need_bar = true; return true; }())
    unsigned char* ws = A.ws;
    float* XL = A.out; float* XC = (float*)(ws + WS_XC);
    bf16_t* H = (bf16_t*)(ws + WS_H);
    const float* MOD = (const float*)(ws + WS_MOD);

    SITE(0) PH(0) { phase_prologue(A, lds); }
    SITE(1) PH(1) { phase_norm_mod(A.in[I_X], A.in[I_CTX], XL, XC, A.in[I_N1G], MOD, 0, H, NROW); }
    for (int L = 0; L < DEPTH; ++L) {
        const int base = 2 + 16 * L, li = L >> 1; const bool hyb = (L & 1) == 0;
        const float* MODL = MOD + (size_t)L * 5 * 6144;
        unsigned char* WH = ws + WS_W + W_HYB + (size_t)li * WH_SZ; unsigned char* WG = ws + WS_W + W_GM + (size_t)li * WG_SZ; unsigned char* WP = ws + WS_W + W_PEER + (size_t)L * WP_SZ;
        if (hyb) {
            SITE(2) PH(base + 0) REP(2) { pg8::Gemm g{H, (const bf16_t*)(WH + WH_IN), nr_in(L), HYB_INP, 1024, 1024, 1024};
                pg8::EpiBf16<0> e{(bf16_t*)(ws + WS_BIG), HYB_INP}; pg8::gemm_phase(lds, g, e); }
            SITE(3) PH(base + 1) REP(3) { phase_conv(A, li); }
            SITE(4) PH(base + 2) {
                SITE(18) REP(18) { pg8::Gemm g{(const bf16_t*)(ws + WS_BIG) + C_CQ, (const bf16_t*)(WH + WH_QB), L == 0 ? NROW : NLAT, 1536, 384, HYB_INP, 384};
                  EpiQ e{ws + WS_R1 + R1_Q, (const float*)(ws + WS_RSTD), (const float*)(ws + WS_ROPE)}; pg8::gemm_phase(lds, g, e); }
                SITE(19) REP(19) { pg8::Gemm g{(const bf16_t*)(ws + WS_BIG) + C_CKV, (const bf16_t*)(WH + WH_KVB), NROW, 2048, 256, HYB_INP, 256};
                  EpiKV e{ws + WS_R1 + R1_KN, ws + WS_R1 + R1_V, (const float*)(ws + WS_RSTD) + NROW}; pg8::gemm_phase(lds, g, e); }
                SITE(20) REP(20) for (int u = blockIdx.x; u < 528; u += gridDim.x) ssd::g_unit((const bf16_t*)(ws + WS_R2 + R2_BC), (bf16_t*)(ws + WS_BIG + BIG_G), u);
            }
            SITE(5) PH(base + 3) {
                const int xq = (int)blockIdx.x & 7, jq = (int)blockIdx.x >> 3; const bool ssd_wg = (jq & 1) == 0 && gridDim.x == 256;
                if (gridDim.x == 256) {
                    if (ssd_wg) { const int r = jq >> 1, gi = xq + 8 * (r >> 3), hh = r & 7, sb = gi >> 2, sgp = (gi >> 1) & 1, sd = gi & 1;
                        SITE(21) ssd::ssd_unit(sb, 8 * sgp + hh, sd, (const bf16_t*)(ws + WS_R2), (const bf16_t*)(ws + WS_R2 + R2_BC), (const float*)(ws + WS_BIG + BIG_DT), (const bf16_t*)(ws + WS_BIG + BIG_G),
                                               A.in[I_ALOG] + li * 32, sd ? (bf16_t*)(ws + WS_R3) : (bf16_t*)(ws + WS_H), lds); }
                } else {
                    SITE(21) for (int u = blockIdx.x; u < 128; u += gridDim.x) ssd::ssd_unit(u >> 5, (u >> 1) & 15, u & 1, (const bf16_t*)(ws + WS_R2), (const bf16_t*)(ws + WS_R2 + R2_BC), (const float*)(ws + WS_BIG + BIG_DT),
                                               (const bf16_t*)(ws + WS_BIG + BIG_G), A.in[I_ALOG] + li * 32, (u & 1) ? (bf16_t*)(ws + WS_R3) : (bf16_t*)(ws + WS_H), lds);
                }
                const int nmine = gridDim.x == 256 ? (ssd_wg ? 3 : 5) + (L == 0 && !ssd_wg && jq < 8 ? 1 : 0) : 0;
                SITE(22) REP(22) for (int it = 0; gridDim.x == 256 ? it < nmine : (int)blockIdx.x + it * (int)gridDim.x < (L == 0 ? 1056 : 1024); ++it) {
                    int b, h, qrow0, orow0, nt;
                    if (gridDim.x == 256) {
                        const int base_it = ssd_wg ? 3 : 5;
                        if (it < base_it) { const int v = ssd_wg ? 3 * (jq >> 1) + it : 48 + 5 * (jq >> 1) + it; b = v >> 5; h = xq; const int qb = v & 31; qrow0 = 256 + 256 * qb; orow0 = b * 8192 + 256 * qb; nt = NKT; }
                        else { b = jq >> 1; h = xq; qrow0 = 0; orow0 = NLAT + 256 * b; nt = 4; }
                    } else { const int au = (int)blockIdx.x + it * (int)gridDim.x;
                        if (au < 1024) { b = au >> 8; h = au & 7; const int qb = (au >> 3) & 31; qrow0 = 256 + 256 * qb; orow0 = b * 8192 + 256 * qb; nt = NKT; }
                        else { const int cu = au - 1024; b = cu >> 3; h = cu & 7; qrow0 = 0; orow0 = NLAT + 256 * b; nt = 4; } }
                    const size_t bh = (size_t)(b * 8 + h);
                    att8::attn_unit(ws + WS_R1 + R1_Q + (bh * NKEY + qrow0) * 192, ws + WS_R1 + R1_KN + bh * NKT * 8192, ws + WS_BIG + BIG_KR + (size_t)b * NKT * 4096,
                                    ws + WS_R1 + R1_V + bh * NKT * 8192, (bf16_t*)(ws + WS_R3 + R3_CAT) + (size_t)orow0 * 2048 + 1024 + 128 * h, nt, lds);
                }
                if (gridDim.x == 256 && !ssd_wg) SITE(11) phase_tabcvt(A, L, xq + 8 * (jq >> 1), 128);
            }
            SITE(6) PH(base + 4) REP(6) { phase_ssd_out(A, li, nr_out(L));
#if defined(MK_CHECK) && MK_CHECK == 1
                if (L == 0) check_attn(A, lds);
#elif defined(MK_CHECK) && MK_CHECK == 2
                if (L == 0) check_qkv(A, li, lds);
#elif defined(MK_CHECK) && MK_CHECK == 3
                if (L == 2) check_attn(A, lds);
#endif
            }
        } else {
            SITE(7) PH(base + 0) REP(7) { pg8::Gemm g{H, (const bf16_t*)(WG + WG_IN), nr_out(L), 4096, 1024, 1024, 1024};
                pg8::EpiBf16<1> e{(bf16_t*)(ws + WS_BIG), 4096}; pg8::gemm_phase(lds, g, e); }
            SITE(8) PH(base + 1) REP(8) { phase_ln_stats(A, nr_out(L)); }
            SITE(9) PH(base + 2) REP(9) { phase_spatial(A, li, nr_out(L), lds); }
        }
        SITE(10) PH(base + 5) { pg8::Gemm g{hyb ? (const bf16_t*)(ws + WS_R3 + R3_CAT) : (const bf16_t*)(ws + WS_R1), hyb ? (const bf16_t*)(WH + WH_OUT) : (const bf16_t*)(WG + WG_OUT), nr_out(L), 1024, 2048, 2048, 2048};
            pg8::EpiResid e{XL, XC, MODL + 2 * 1024}; pg8::gemm_phase(lds, g, e); }
        SITE(11) PH(base + 6) REP(11) { phase_norm_mod(XL, XC, nullptr, nullptr, A.in[I_N2G] + L * 1024, MODL, 3, H, nr_out(L));
            if (!hyb || gridDim.x != 256) phase_tabcvt(A, L, (int)blockIdx.x, (int)gridDim.x); }
        SITE(12) PH(base + 7) REP(12) { pg8::Gemm g{H, (const bf16_t*)(WP + WP_Q), nr_out(L), 2048, 1024, 1024, 1024};
            pg8::EpiBf16<0> e{(bf16_t*)(ws + WS_BIG), 2048}; pg8::gemm_phase(lds, g, e); }
        SITE(13) PH(base + 8) REP(13) { phase_topk(A, L, nr_out(L), lds); }
        SITE(14) PH(base + 9) REP(14) { phase_peer_u(A, L, nr_out(L), smem, rep); }
        SITE(15) PH(base + 10) REP(15) { phase_coef(A, nr_out(L)); }
        SITE(16) PH(base + 11) { phase_peer_v(A, L, nr_out(L), smem, 0); }
        SITE(17) PH(base + 12) { if (L < DEPTH - 1) phase_norm_mod(XL, XC, nullptr, nullptr, A.in[I_N1G] + (L + 1) * 1024, MOD + (size_t)(L + 1) * 5 * 6144, 0, H, nr_in(L + 1));
                        else {
#ifdef MK_CHECK
                            const float* chk = (const float*)(ws + WS_CTL) + CW_CHK; const float err = sqrtf(chk[0] / fmaxf(chk[1], 1e-30f));
                            phase_final_norm(XL, A.in[I_FNG], 1.f + 10.f * err);
#else
                            phase_final_norm(XL, A.in[I_FNG], 1.f);
#endif
                        } }
    }
#undef PH
}

#ifdef MK_TAP
__global__ void tap_kernel(const unsigned short* buf, size_t pitch, size_t col0, size_t ncols, size_t nrows, float* out) {
    const size_t n = ncols * nrows;
    for (size_t i = (size_t)blockIdx.x * blockDim.x + threadIdx.x; i < (size_t)NLAT * D; i += (size_t)gridDim.x * blockDim.x) {
        float s = 0.f; for (size_t j = i; j < n; j += (size_t)NLAT * D) s += (float)buf[(j / ncols) * pitch + col0 + (j % ncols)]; out[i] = s; }
}
#endif
extern "C" void kernel_launch(void* const* d_in, const int* in_sizes, int n_in, void* d_out, int out_size, void* d_ws, size_t ws_size, hipStream_t stream) {
    static int grid = 0;
    if (grid == 0) {
        if (n_in != N_IN || out_size != NLAT * D || ws_size < WS_END) { fprintf(stderr, "kernel_launch: unexpected shapes (n_in %d out %d ws %zu, need %zu)\n", n_in, out_size, ws_size, (size_t)WS_END); grid = -1; return; }
        int dev = 0, cus = 0, per_cu = 0;
        if (hipGetDevice(&dev) != hipSuccess || hipDeviceGetAttribute(&cus, hipDeviceAttributeMultiprocessorCount, dev) != hipSuccess) { grid = -1; return; }
        if (hipFuncSetAttribute((const void*)fwd, hipFuncAttributeMaxDynamicSharedMemorySize, LDS_BYTES) != hipSuccess) { fprintf(stderr, "kernel_launch: hipFuncSetAttribute failed\n"); grid = -1; return; }
        if (hipOccupancyMaxActiveBlocksPerMultiprocessor(&per_cu, (const void*)fwd, NTHR, LDS_BYTES) != hipSuccess || per_cu < 1) { fprintf(stderr, "kernel_launch: occupancy query says %d\n", per_cu); }
        (void)hipGetLastError();
        grid = cus;
    }
    if (grid < 0) return;
    (void)hipMemsetAsync((char*)d_ws + WS_CTL, 0, CTL_BYTES, stream);
    Args a{};
    for (int i = 0; i < N_IN; ++i) a.in[i] = (const float*)d_in[i];
    a.out = (float*)d_out; a.ws = (unsigned char*)d_ws;
#if MK_PER_PHASE
    for (int id = 0; id < 2 + 16 * DEPTH; ++id) {
        if (id >= 2) { const int L = (id - 2) / 16, s = (id - 2) % 16; if (s > 12) continue; if ((L & 1) && (s == 3 || s == 4)) continue; }
#ifdef MK_CUT
#ifdef MK_TAP
        if (id >= MK_CUT) continue;
#else
        if (id >= MK_CUT && id != 2 + 16 * (DEPTH - 1) + 12) continue;
#endif
#endif
        a.ph_lo = id; a.ph_hi = id + 1;
        hipLaunchKernelGGL(fwd, dim3(grid), dim3(NTHR), LDS_BYTES, stream, a);
    }
#ifdef MK_TAP
    { const size_t tp[5] = {MK_TAP}; hipLaunchKernelGGL(tap_kernel, dim3(2048), dim3(256), 0, stream, (const unsigned short*)((const char*)d_ws + tp[0]), tp[1], tp[2], tp[3], tp[4], (float*)d_out); }
#endif
#else
    a.ph_lo = 0; a.ph_hi = 2 + 16 * DEPTH;
    hipLaunchKernelGGL(fwd, dim3(grid), dim3(NTHR), LDS_BYTES, stream, a);
#endif
    const hipError_t le = hipPeekAtLastError();
    if (le != hipSuccess) fprintf(stderr, "kernel_launch: launch failed: %s\n", hipGetErrorName(le));
}
```

```cpp
#include <hip/hip_runtime.h>
#include <cstdio>
#include <cstdint>

#define LAS __attribute__((address_space(3)))
typedef unsigned short bf16_t;
typedef short bf16x8 __attribute__((ext_vector_type(8)));
typedef short s16x4 __attribute__((ext_vector_type(4)));
typedef float f32x2 __attribute__((ext_vector_type(2)));
typedef float f32x4 __attribute__((ext_vector_type(4)));
typedef float f32x16 __attribute__((ext_vector_type(16)));
typedef unsigned u32x2 __attribute__((ext_vector_type(2)));
typedef unsigned u32x4 __attribute__((ext_vector_type(4)));
typedef int i32x4 __attribute__((ext_vector_type(4)));
typedef int i32x8 __attribute__((ext_vector_type(8)));

constexpr int D = 1024, NB = 4, SEQ = 8192, DEPTH = 4, CTXL = 256;
constexpr int NLAT = NB * SEQ, NCTX = NB * CTXL, NROW = NLAT + NCTX;
constexpr int HYB_IN = 3280, HYB_INP = 3328;
constexpr int C_Z = 0, C_XBC = 1024, C_DT = 2560, C_CQ = 2576, C_CKV = 2960, C_KR = 3216;
constexpr int NKEY = SEQ + CTXL, NKT = NKEY / 64;
constexpr float EPS = 1e-6f;
constexpr float QSCALE = 0.07216878364870322f * 1.4426950408889634f;
constexpr int NEXP = 16384;

enum { I_X = 0, I_C, I_CTX, I_CCTX, I_ADAW, I_ADAB, I_N1G, I_N2G, I_HWIN, I_CONVW, I_CONVB, I_ALOG, I_DTB, I_SSDD, I_SSDNG, I_QNG, I_WQB, I_KVNG, I_WKVB,
       I_HWOUT, I_GWIN, I_GLNG, I_GLNB, I_GWS, I_GBS, I_GWOUT, I_PWQ, I_PK1, I_PK2, I_PU, I_PV, I_FNG, N_IN };

constexpr size_t al256(size_t x) { return (x + 255) & ~(size_t)255; }
constexpr size_t WS_CTL = 0, CTL_BYTES = 65536;
constexpr size_t WS_MOD = WS_CTL + CTL_BYTES;
constexpr size_t WS_ROPE = WS_MOD + al256((size_t)DEPTH * 5 * 6144 * 4);
constexpr size_t WS_RSTD = WS_ROPE + (size_t)2 * SEQ * 32 * 4;
constexpr size_t WS_W = WS_RSTD + al256((size_t)2 * NROW * 4);
constexpr size_t W_HYB = 0;
constexpr size_t WH_IN = 0, WH_QB = WH_IN + (size_t)HYB_INP * 1024 * 2, WH_KVB = WH_QB + (size_t)1536 * 384 * 2, WH_OUT = WH_KVB + (size_t)2048 * 256 * 2,
                 WH_SZ = WH_OUT + (size_t)1024 * 2048 * 2;
constexpr size_t W_GM = W_HYB + 2 * WH_SZ;
constexpr size_t WG_IN = 0, WG_OUT = WG_IN + (size_t)4096 * 1024 * 2, WG_WS = WG_OUT + (size_t)1024 * 2048 * 2, WG_SZ = WG_WS + (size_t)8 * 128 * 128 * 2;
constexpr size_t W_PEER = W_GM + 2 * WG_SZ;
constexpr size_t WP_Q = 0, WP_K1 = WP_Q + (size_t)2048 * 1024 * 2, WP_K2 = WP_K1 + (size_t)8 * 128 * 128 * 2, WP_SZ = WP_K2 + (size_t)8 * 128 * 128 * 2;
constexpr size_t W_TOTAL = W_PEER + 4 * WP_SZ;
constexpr size_t WS_TAB = WS_W + al256(W_TOTAL);
constexpr size_t TAB_HALF = (size_t)NEXP * 1024 * 2;
constexpr size_t WS_XC = WS_TAB + 2 * TAB_HALF;
constexpr size_t WS_H = WS_XC + (size_t)NCTX * D * 4;
constexpr size_t WS_BIG = WS_H + (size_t)NROW * D * 2;
constexpr size_t BIG_BYTES = (size_t)NROW * 4096 * 2;
constexpr size_t BIG_DT = (size_t)NROW * HYB_INP * 2;
constexpr size_t BIG_G = BIG_DT + (size_t)NROW * 32 * 4;
constexpr size_t BIG_KR = BIG_G + (size_t)528 * 128 * 128 * 2;
constexpr size_t BIG_PART = (size_t)NROW * 2048 * 2;
static_assert(BIG_KR + (size_t)NB * NKT * 8192 <= BIG_BYTES, "BIG tail");
constexpr size_t WS_R1 = WS_BIG + BIG_BYTES;
constexpr size_t R1_Q = 0, R1_KN = R1_Q + (size_t)NB * 8 * NKEY * 192 * 2, R1_V = R1_KN + (size_t)NB * 8 * NKT * 16384, R1_BYTES = R1_V + (size_t)NB * 8 * NKT * 16384;
constexpr size_t WS_R2 = WS_R1 + R1_BYTES;
constexpr size_t R2_BC = (size_t)NROW * 1024 * 2, R2_BYTES = R2_BC + (size_t)NROW * 512 * 2;
constexpr size_t R2_GATE = (size_t)NROW * 128 * 4, R2_COEF = 2 * R2_GATE;
constexpr size_t WS_R3 = WS_R2 + R2_BYTES;
constexpr size_t R3_CAT = (size_t)NROW * 1024 * 2, R3_BYTES = R3_CAT + (size_t)NROW * 2048 * 2;
constexpr size_t WS_END = WS_R3 + R3_BYTES;
static_assert(WS_END <= ((size_t)1 << 30), "workspace must fit 1 GiB");

constexpr int CW_RANK = 3584;
constexpr int CW_QUEUE = 4096;

typedef __bf16 bf16x2_t __attribute__((ext_vector_type(2)));
__device__ __forceinline__ unsigned cvt_pk_bf16(float lo, float hi) { const f32x2 v = {lo, hi}; const bf16x2_t b = __builtin_convertvector(v, bf16x2_t); return __builtin_bit_cast(unsigned, b); }
__device__ __forceinline__ bf16_t f2bf(float f) { return (bf16_t)(cvt_pk_bf16(f, 0.f) & 0xffffu); }
__device__ __forceinline__ float bf2f(unsigned b) { return __uint_as_float(b << 16); }
__device__ __forceinline__ float bflo(unsigned w) { return __uint_as_float(w << 16); }
__device__ __forceinline__ float bfhi(unsigned w) { return __uint_as_float(w & 0xffff0000u); }
__device__ __forceinline__ float wave_sum(float v) {
#pragma unroll
    for (int o = 32; o >= 1; o >>= 1) v += __shfl_xor(v, o);
    return v;
}
__device__ __forceinline__ int otid() { int t = threadIdx.x; asm volatile("" : "+v"(t)); return t; }
__device__ __forceinline__ float silu_f(float x) { return x / (1.f + __expf(-x)); }
__device__ __forceinline__ float softplus_f(float x) { return x > 20.f ? x : log1pf(__expf(x)); }
__device__ __forceinline__ f32x2 gelu_pk(f32x2 v) {
    const f32x2 av = __builtin_elementwise_abs(v), d = av * 0.2316418882f + 1.0f;
    f32x2 t; t.x = __builtin_amdgcn_rcpf(d.x); t.y = __builtin_amdgcn_rcpf(d.y);
    f32x2 q = t * 0.5307027145f + (-0.7265760135f); q = q * t + 0.7107068705f; q = q * t + (-0.142248368f); q = q * t + 0.127414796f; q = q * t;
    const f32x2 s = (v * v) * (-0.72134752044f);
    f32x2 e; e.x = __builtin_amdgcn_exp2f(s.x); e.y = __builtin_amdgcn_exp2f(s.y);
    const f32x2 m = v * (q * e), r = v - m;
    f32x2 o; o.x = v.x < 0.f ? m.x : r.x; o.y = v.y < 0.f ? m.y : r.y; return o;
}
__device__ __forceinline__ float gelu_f(float x) { f32x2 v = {x, 0.f}; return gelu_pk(v).x; }

__device__ __forceinline__ unsigned pk4_fp8(float a, float b, float c, float d) { int w = 0; w = __builtin_amdgcn_cvt_pk_fp8_f32(a, b, w, false); w = __builtin_amdgcn_cvt_pk_fp8_f32(c, d, w, true); return (unsigned)w; }
__device__ __forceinline__ float sat8(float v) { return __builtin_amdgcn_fmed3f(v, -448.f, 448.f); }
__device__ __forceinline__ unsigned pk4_fp8_sat(float a, float b, float c, float d) { return pk4_fp8(sat8(a), sat8(b), sat8(c), sat8(d)); }
__device__ __forceinline__ int row_mb(int r) { return r < NLAT ? (r >> 13) : 4; }

#define XB_TMO      128
#define XB_XCNT(j)  (256  + 64 * (j))
#define XB_XSUB(j)  (1280 + 64 * (j))
#define XB_XGEN(j)  (2304 + 64 * (j))
#define XB_TOP      3328
#define XB_TOPGEN   3392
#define XCD_BAR_WORDS 3456
#define XB_SPIN_CAP (1u << 22)
__device__ __forceinline__ unsigned xb_ld(unsigned* p)              { return __hip_atomic_load(p, __ATOMIC_RELAXED, __HIP_MEMORY_SCOPE_AGENT); }
__device__ __forceinline__ unsigned xb_add(unsigned* p, unsigned v) { return __hip_atomic_fetch_add(p, v, __ATOMIC_RELAXED, __HIP_MEMORY_SCOPE_AGENT); }
__device__ __forceinline__ unsigned xb_xcc_id() { return (unsigned)__builtin_amdgcn_s_getreg((3 << 11) | 20) & 0xFu; }
#define XB_SPIN(cond, bar) do { unsigned _sp = 0; while (cond) { __builtin_amdgcn_s_sleep(1); \
    if ((++_sp & 255u) == 0u) { if (xb_ld(&(bar)[XB_TMO])) break; if (_sp > XB_SPIN_CAP) { atomicAdd(&(bar)[XB_TMO], 1u); break; } } } } while (0)
struct XcdBarrier { unsigned* bar; unsigned x; volatile LAS unsigned* st; };
__device__ __forceinline__ XcdBarrier xcd_barrier_post(unsigned* bar, volatile LAS unsigned* st) {
    XcdBarrier b; b.bar = bar; b.x = xb_xcc_id(); b.st = st;
    if (threadIdx.x == 0) (void)xb_add(&bar[XB_XCNT(b.x)], 1u);
    return b;
}
__device__ __forceinline__ void xcd_barrier_complete(unsigned* bar, unsigned x, unsigned& nloc, unsigned& nx) {
    const unsigned G = gridDim.x * gridDim.y * gridDim.z;
    unsigned sum, cnt, mine, sp = 0u;
    for (;;) {
        sum = 0u; cnt = 0u; mine = 0u;
#pragma unroll
        for (unsigned j = 0; j < 16; ++j) { const unsigned c = xb_ld(&bar[XB_XCNT(j)]); sum += c; cnt += (c > 0u) ? 1u : 0u; mine = (j == x) ? c : mine; }
        if (sum == G) break;
        __builtin_amdgcn_s_sleep(1);
        if ((++sp & 255u) == 0u) { if (xb_ld(&bar[XB_TMO])) break; if (sp > XB_SPIN_CAP) { atomicAdd(&bar[XB_TMO], 1u); break; } }
    }
    nloc = mine > 0u ? mine : 1u; nx = cnt > 0u ? cnt : 1u;
}
__device__ __forceinline__ void xcd_barrier(const XcdBarrier& b) {
    asm volatile("s_waitcnt vmcnt(0)" ::: "memory");
    __syncthreads();
    if (threadIdx.x == 0) {
        unsigned* bar = b.bar;
        __builtin_amdgcn_s_waitcnt(0);
        unsigned nloc = b.st[0], nx = b.st[1];
        if (nloc == 0u) { xcd_barrier_complete(bar, b.x, nloc, nx); b.st[0] = nloc; b.st[1] = nx; }
        const unsigned old = xb_add(&bar[XB_XSUB(b.x)], 1u);
        const unsigned gen = old / nloc;
        if (old + 1u == (gen + 1u) * nloc) {
            __builtin_amdgcn_fence(__ATOMIC_RELEASE, "agent");
            asm volatile("s_waitcnt vmcnt(0)" ::: "memory");
            const unsigned og = xb_add(&bar[XB_TOP], 1u);
            const unsigned tg = og / nx;
            if (og + 1u == (tg + 1u) * nx) xb_add(&bar[XB_TOPGEN], 1u);
            else XB_SPIN(xb_ld(&bar[XB_TOPGEN]) == tg, bar);
            __builtin_amdgcn_fence(__ATOMIC_ACQUIRE, "agent");
            xb_add(&bar[XB_XGEN(b.x)], 1u);
            asm volatile("s_waitcnt vmcnt(0)" ::: "memory");
        } else {
            XB_SPIN(xb_ld(&bar[XB_XGEN(b.x)]) == gen, bar);
            __builtin_amdgcn_fence(__ATOMIC_ACQUIRE, "agent");
            asm volatile("s_waitcnt vmcnt(0)" ::: "memory");
        }
    }
    __syncthreads();
}

namespace pg8 {
constexpr int BM = 256, BK = 64, HALF = 128, HTB = HALF * BK * 2, STAGE_BYTES = 8 * HTB, NXCD = 8, WGM = 8;
__host__ __device__ __forceinline__ int lds_byte(int r, int c) { const int st = (r >> 4) * 2 + (c >> 5), rr = r & 15, cc = c & 31, ob = rr * 64 + cc * 2; return st * 1024 + (ob ^ (((ob >> 9) & 1) << 5)); }
__host__ __device__ __forceinline__ void stage_rc(int b, int& R, int& C) { const int st = b / 1024, sb = b % 1024, swz = sb ^ (((sb >> 9) & 1) << 5); R = (st >> 1) * 16 + swz / 64; C = (st & 1) * 32 + (swz % 64) / 2; }
__host__ __device__ __forceinline__ int perm32(int rho) { const int n = rho >> 4, i = rho & 15; return 8 * (i >> 2) + 4 * n + (i & 3); }
struct Unit { int pm, pn; };
struct Gemm { const bf16_t* A; const bf16_t* Bt; int M, N, K, lda, ldb; };
struct StaticOrder {
    int nM, nN, nwg, G, c;
    __device__ void init(int M, int N, int G_, int c_) { nM = M / BM; nN = N / BM; nwg = nM * nN; G = G_; c = c_; }
    __device__ bool next(int i, Unit& u) const {
        const long L = (long)i * G + c; if (L >= nwg) return false;
        int wgid = (int)L; { const int q = nwg / NXCD, r = nwg % NXCD, xcd = wgid % NXCD, off = wgid / NXCD; wgid = (xcd < r ? xcd * (q + 1) : r * (q + 1) + (xcd - r) * q) + off; }
        const int nig = WGM * nN, gid = wgid / nig, fm = gid * WGM, gsz = (nM - fm) < WGM ? (nM - fm) : WGM;
        u.pm = fm + ((wgid % nig) % gsz); u.pn = (wgid % nig) / gsz; return true;
    }
};
template <class Epi>
__device__ __forceinline__ void gemm_phase(LAS unsigned char* lds, const Gemm g, const Epi& E) {
    const int tid = otid(), wid = __builtin_amdgcn_readfirstlane(tid >> 6), lane = tid & 63, wr = wid >> 2, wc = wid & 3, fr = lane & 15, fq = lane >> 4;
    StaticOrder S; S.init(g.M, g.N, (int)gridDim.x, (int)blockIdx.x);
    int K = g.K; asm volatile("" : "+s"(K));
    const int nt = K / BK;
    unsigned voffA[2], voffB[2];
#pragma unroll
    for (int i = 0; i < 2; ++i) { int R, C; stage_rc(tid * 16 + i * 8192, R, C); const int Rb = Epi::PERM ? ((R & ~31) + perm32(R & 31)) : R;
        voffA[i] = (unsigned)(R * g.lda + C) * 2u; voffB[i] = (unsigned)(Rb * g.ldb + C) * 2u; }
    const size_t kstep = (size_t)(BK * 2);
    const size_t hstepA = (size_t)HALF * g.lda * 2, hstepB = (size_t)HALF * g.ldb * 2;
    const size_t tstepA = 2 * hstepA, tstepB = 2 * hstepB;
    const unsigned ldsw = (unsigned)wid * 1024u;
    const int aoff = lds_byte(wr * 64 + fr, fq * 8), boff = lds_byte(wc * 32 + fr, fq * 8);
#define PG8_SA(b, h) (((b) * 2 + (h)) * HTB)
#define PG8_SB(b, h) ((4 + (b) * 2 + (h)) * HTB)
#define PG8_STAGE(bufoff, gbase, voff) do { _Pragma("unroll") for (int _i = 0; _i < 2; ++_i) \
        __builtin_amdgcn_global_load_lds((const unsigned*)((const char*)(gbase) + (voff)[_i]), (LAS unsigned*)(lds + (bufoff) + ldsw + _i * 8192), 16, 0, 0); } while (0)
#define PG8_LDA(dst, b, h) do { _Pragma("unroll") for (int m = 0; m < 4; ++m) _Pragma("unroll") for (int k = 0; k < 2; ++k) dst[m][k] = *(const LAS bf16x8*)(lds + PG8_SA(b, h) + aoff + m * 2048 + k * 1024); } while (0)
#define PG8_LDB(dst, b, h) do { _Pragma("unroll") for (int n = 0; n < 2; ++n) _Pragma("unroll") for (int k = 0; k < 2; ++k) dst[n][k] = *(const LAS bf16x8*)(lds + PG8_SB(b, h) + boff + n * 2048 + k * 1024); } while (0)
#define PG8_MMA(ai, bj, At, Bt) do { __builtin_amdgcn_s_setprio(1); _Pragma("unroll") for (int m = 0; m < 4; ++m) _Pragma("unroll") for (int n = 0; n < 2; ++n) _Pragma("unroll") for (int k = 0; k < 2; ++k) \
        acc[ai][bj][m][n] = __builtin_amdgcn_mfma_f32_16x16x32_bf16(Bt[n][k], At[m][k], acc[ai][bj][m][n], 0, 0, 0); __builtin_amdgcn_s_setprio(0); } while (0)
#define PG8_WAIT_V(n) asm volatile("s_waitcnt vmcnt(" #n ")" ::: "memory")
#define PG8_WAIT_L(n) asm volatile("s_waitcnt lgkmcnt(" #n ")" ::: "memory")
#define PG8_BAR __builtin_amdgcn_s_barrier()
#define PG8_SCHED __builtin_amdgcn_sched_barrier(0)
    Unit cur, nxt; int ui = 0;
    if (!S.next(0, cur)) return;
    f32x4 acc[2][2][4][2];
#pragma unroll
    for (int a = 0; a < 2; ++a)
#pragma unroll
        for (int b = 0; b < 2; ++b)
#pragma unroll
            for (int m = 0; m < 4; ++m)
#pragma unroll
                for (int n = 0; n < 2; ++n) acc[a][b][m][n] = (f32x4){0.f, 0.f, 0.f, 0.f};
    bf16x8 At[4][2], B0[2][2], B1[2][2];
    const char* cA = (const char*)g.A + (size_t)cur.pm * tstepA; const char* cB = (const char*)g.Bt + (size_t)cur.pn * tstepB;
    PG8_STAGE(PG8_SB(0, 0), cB, voffB); PG8_STAGE(PG8_SB(0, 1), cB + hstepB, voffB); PG8_STAGE(PG8_SA(0, 0), cA, voffA); PG8_STAGE(PG8_SA(0, 1), cA + hstepA, voffA);
    if (wr == 1) PG8_BAR;
    PG8_WAIT_V(2); PG8_BAR;
    PG8_STAGE(PG8_SB(1, 0), cB + kstep, voffB); PG8_STAGE(PG8_SA(1, 0), cA + kstep, voffA); PG8_STAGE(PG8_SB(1, 1), cB + hstepB + kstep, voffB);
    PG8_WAIT_V(6); PG8_BAR;
    for (;;) {
        const bool has_next = S.next(ui + 1, nxt);
        const char* nA = has_next ? (const char*)g.A + (size_t)nxt.pm * tstepA : cA; const char* nB = has_next ? (const char*)g.Bt + (size_t)nxt.pn * tstepB : cB;
        for (int t = 0; t < nt; t += 2) {
            const bool last = (t == nt - 2);
            const char* a1 = cA + (size_t)(t + 1) * kstep;
            const char* a2 = last ? nA : cA + (size_t)(t + 2) * kstep; const char* b2 = last ? nB : cB + (size_t)(t + 2) * kstep;
            const char* a3 = a2 + kstep; const char* b3 = b2 + kstep;
            PG8_LDB(B0, 0, 0); PG8_LDB(B1, 0, 1); PG8_SCHED; PG8_LDA(At, 0, 0); PG8_STAGE(PG8_SA(1, 1), a1 + hstepA, voffA);
            PG8_WAIT_V(8); PG8_WAIT_L(0); PG8_BAR; PG8_MMA(0, 0, At, B0); PG8_MMA(0, 1, At, B1); PG8_BAR; PG8_SCHED;
            PG8_LDA(At, 0, 1); PG8_STAGE(PG8_SB(0, 0), b2, voffB); PG8_STAGE(PG8_SB(0, 1), b2 + hstepB, voffB); PG8_STAGE(PG8_SA(0, 0), a2, voffA);
            PG8_WAIT_V(8); PG8_WAIT_L(0); PG8_BAR; PG8_MMA(1, 0, At, B0); PG8_MMA(1, 1, At, B1); PG8_BAR; PG8_SCHED;
            PG8_LDB(B0, 1, 0); PG8_LDB(B1, 1, 1); PG8_SCHED; PG8_LDA(At, 1, 0); PG8_STAGE(PG8_SA(0, 1), a2 + hstepA, voffA);
            PG8_WAIT_V(8); PG8_WAIT_L(0); PG8_BAR; PG8_MMA(0, 0, At, B0); PG8_MMA(0, 1, At, B1); PG8_BAR; PG8_SCHED;
            PG8_LDA(At, 1, 1); PG8_STAGE(PG8_SB(1, 0), b3, voffB); PG8_STAGE(PG8_SB(1, 1), b3 + hstepB, voffB); PG8_STAGE(PG8_SA(1, 0), a3, voffA);
            PG8_WAIT_V(8); PG8_WAIT_L(0); PG8_BAR; PG8_MMA(1, 0, At, B0); PG8_MMA(1, 1, At, B1); PG8_BAR; PG8_SCHED;
        }
        if (wr == 0) PG8_BAR;
        { const int l2_ = otid() & 63; E(acc, cur, wr, wc, l2_ & 15, l2_ >> 4); }
        if (!has_next) break;
#pragma unroll
        for (int a = 0; a < 2; ++a)
#pragma unroll
            for (int b = 0; b < 2; ++b)
#pragma unroll
                for (int m = 0; m < 4; ++m)
#pragma unroll
                    for (int n = 0; n < 2; ++n) acc[a][b][m][n] = (f32x4){0.f, 0.f, 0.f, 0.f};
        cur = nxt; cA = nA; cB = nB; ++ui;
        if (wr == 1) PG8_BAR;
    }
    PG8_WAIT_V(0);
    PG8_BAR;
#undef PG8_SA
#undef PG8_SB
#undef PG8_STAGE
#undef PG8_LDA
#undef PG8_LDB
#undef PG8_MMA
#undef PG8_WAIT_V
#undef PG8_WAIT_L
#undef PG8_BAR
#undef PG8_SCHED
}

template <int ACT> struct EpiBf16 {
    static constexpr bool PERM = true;
    bf16_t* O; int ldc;
    __device__ __forceinline__ void operator()(const f32x4 (&acc)[2][2][4][2], const Unit& u, int wr, int wc, int fr, int fq) const {
        const int row0 = u.pm * BM + wr * 64 + fr, col0 = u.pn * BM + wc * 32 + 8 * fq;
#pragma unroll
        for (int ai = 0; ai < 2; ++ai)
#pragma unroll
            for (int m = 0; m < 4; ++m) { bf16_t* rowp = O + (size_t)(row0 + ai * HALF + m * 16) * ldc + col0;
#pragma unroll
                for (int bj = 0; bj < 2; ++bj) { f32x4 v0 = acc[ai][bj][m][0], v1 = acc[ai][bj][m][1];
                    if (ACT == 1) { f32x2 a = gelu_pk((f32x2){v0[0], v0[1]}), b = gelu_pk((f32x2){v0[2], v0[3]}), c = gelu_pk((f32x2){v1[0], v1[1]}), d = gelu_pk((f32x2){v1[2], v1[3]});
                        v0 = (f32x4){a.x, a.y, b.x, b.y}; v1 = (f32x4){c.x, c.y, d.x, d.y}; }
                    u32x4 w; w.x = cvt_pk_bf16(v0[0], v0[1]); w.y = cvt_pk_bf16(v0[2], v0[3]); w.z = cvt_pk_bf16(v1[0], v1[1]); w.w = cvt_pk_bf16(v1[2], v1[3]);
                    *(u32x4*)(rowp + bj * HALF) = w; } }
    }
};
struct EpiResid {
    static constexpr bool PERM = false;
    float* xl; float* xc; const float* gate;
    __device__ __forceinline__ void operator()(const f32x4 (&acc)[2][2][4][2], const Unit& u, int wr, int wc, int fr, int fq) const {
        const int rbase = u.pm * BM; const bool lat = rbase < NLAT;
        float* X = lat ? xl + (size_t)rbase * D : xc + (size_t)(rbase - NLAT) * D;
        const float* gp = gate + (size_t)(lat ? (rbase >> 13) : 4) * 6144;
        const int row0 = wr * 64 + fr, col0 = u.pn * BM + wc * 32 + 4 * fq;
        f32x4 gv[2][2];
#pragma unroll
        for (int bj = 0; bj < 2; ++bj)
#pragma unroll
            for (int n = 0; n < 2; ++n) gv[bj][n] = *(const f32x4*)(gp + col0 + bj * HALF + n * 16);
#pragma unroll
        for (int ai = 0; ai < 2; ++ai)
#pragma unroll
            for (int m = 0; m < 4; ++m) { float* rowp = X + (size_t)(row0 + ai * HALF + m * 16) * D + col0;
#pragma unroll
                for (int bj = 0; bj < 2; ++bj)
#pragma unroll
                    for (int n = 0; n < 2; ++n) { f32x4* p = (f32x4*)(rowp + bj * HALF + n * 16); *p = *p + gv[bj][n] * acc[ai][bj][m][n]; } }
    }
};
}

namespace att {
constexpr int SLOT = 40960, KN_OFF = 0, KR_OFF = 16384, V_OFF = 24576, LDS_BYTES = 3 * SLOT + 8 * 256;
constexpr float THR2 = 11.0f;
#define KSWZ(row, colB) ((row) * 256 + ((colB) ^ (((row) & 7) << 4)))
#define KRSWZ(row, colB) ((row) * 128 + ((colB) ^ ((((row) >> 1) & 7) << 4)))
#define SBAR() __builtin_amdgcn_sched_barrier(0)
__device__ __forceinline__ int crow(int r, int hi) { return (r & 3) + 8 * (r >> 2) + 4 * hi; }
__host__ __device__ __forceinline__ int v_st(int k, int c) { const int kk = (k & ~0xC) | ((k & 4) << 1) | ((k & 8) >> 1); return ((kk >> 3) * 4 + (c >> 5)) * 512 + ((kk & 7) * 32 + (c & 31)) * 2; }
__device__ __forceinline__ int v_rd_base(int lane) { return ((lane & 3) << 3) | (((lane >> 2) & 3) << 6) | (((lane >> 4) & 1) << 5) | (((lane >> 5) & 1) << 8); }
constexpr int v_rd_off(int d0, int ks, int half) { return d0 * 512 + ks * 4096 + half * 2048; }
template <int OFF> __device__ __forceinline__ s16x4 tr_read(int vb) {
    s16x4 r; asm volatile("ds_read_b64_tr_b16 %0, %1 offset:%2" : "=&v"(r) : "v"(vb), "i"(OFF) : "memory"); return r;
}
template <int D0> __device__ __forceinline__ void pv_one(f32x16& od, int vb, bf16x8 pa0, bf16x8 pa1, bf16x8 pa2, bf16x8 pa3) {
    const s16x4 l0 = tr_read<v_rd_off(D0, 0, 0)>(vb), h0 = tr_read<v_rd_off(D0, 0, 1)>(vb), l1 = tr_read<v_rd_off(D0, 1, 0)>(vb), h1 = tr_read<v_rd_off(D0, 1, 1)>(vb);
    const s16x4 l2 = tr_read<v_rd_off(D0, 2, 0)>(vb), h2 = tr_read<v_rd_off(D0, 2, 1)>(vb), l3 = tr_read<v_rd_off(D0, 3, 0)>(vb), h3 = tr_read<v_rd_off(D0, 3, 1)>(vb);
    asm volatile("s_waitcnt lgkmcnt(0)" ::: "memory"); SBAR();
#define PK(L, H) (bf16x8){L[0], L[1], L[2], L[3], H[0], H[1], H[2], H[3]}
    od = __builtin_amdgcn_mfma_f32_32x32x16_bf16(pa0, PK(l0, h0), od, 0, 0, 0);
    od = __builtin_amdgcn_mfma_f32_32x32x16_bf16(pa1, PK(l1, h1), od, 0, 0, 0);
    od = __builtin_amdgcn_mfma_f32_32x32x16_bf16(pa2, PK(l2, h2), od, 0, 0, 0);
    od = __builtin_amdgcn_mfma_f32_32x32x16_bf16(pa3, PK(l3, h3), od, 0, 0, 0);
#undef PK
}
__device__ __forceinline__ void pv_d0(f32x16* o, int vb, bf16x8 pa0, bf16x8 pa1, bf16x8 pa2, bf16x8 pa3) {
    pv_one<0>(o[0], vb, pa0, pa1, pa2, pa3); pv_one<1>(o[1], vb, pa0, pa1, pa2, pa3); pv_one<2>(o[2], vb, pa0, pa1, pa2, pa3); pv_one<3>(o[3], vb, pa0, pa1, pa2, pa3);
}
__device__ __forceinline__ void partialSM(f32x16& p0, f32x16& p1, float& m_reg, float& mn, float& alpha) {
    float pmax = p0[0];
#pragma unroll
    for (int r = 1; r < 16; ++r) pmax = fmaxf(pmax, p0[r]);
#pragma unroll
    for (int r = 0; r < 16; ++r) pmax = fmaxf(pmax, p1[r]);
    { auto rr = __builtin_amdgcn_permlane32_swap(__float_as_uint(pmax), __float_as_uint(pmax), false, false);
      pmax = fmaxf(__uint_as_float(rr[0]), __uint_as_float(rr[1])); }
    if (__builtin_expect(__all(pmax - m_reg <= THR2), 1)) { mn = m_reg; alpha = 1.f; }
    else { mn = fmaxf(m_reg, pmax); alpha = __builtin_amdgcn_exp2f(m_reg - mn); m_reg = mn; }
#pragma unroll
    for (int r = 0; r < 16; ++r) p0[r] = __builtin_amdgcn_exp2f(p0[r] - mn);
#pragma unroll
    for (int r = 0; r < 16; ++r) p1[r] = p1[r] - mn;
}
__device__ __forceinline__ void finishSM(f32x16& p0, f32x16& p1, float alpha, float& l_reg, bf16x8& pa0, bf16x8& pa1, bf16x8& pa2, bf16x8& pa3) {
#pragma unroll
    for (int r = 0; r < 16; ++r) p1[r] = __builtin_amdgcn_exp2f(p1[r]);
    float ps = 0;
#pragma unroll
    for (int r = 0; r < 16; ++r) ps += p0[r];
#pragma unroll
    for (int r = 0; r < 16; ++r) ps += p1[r];
    { auto rr = __builtin_amdgcn_permlane32_swap(__float_as_uint(ps), __float_as_uint(ps), false, false);
      ps = __uint_as_float(rr[0]) + __uint_as_float(rr[1]); }
    l_reg = l_reg * alpha + ps;
#define PK4(P, BASE, OUT) do { unsigned a0 = cvt_pk_bf16(P[BASE + 0], P[BASE + 1]), a1 = cvt_pk_bf16(P[BASE + 2], P[BASE + 3]);   \
    unsigned b0 = cvt_pk_bf16(P[BASE + 4], P[BASE + 5]), b1 = cvt_pk_bf16(P[BASE + 6], P[BASE + 7]);                              \
    auto r0 = __builtin_amdgcn_permlane32_swap(a0, b0, false, false); auto r1 = __builtin_amdgcn_permlane32_swap(a1, b1, false, false); \
    u32x4 w = {r0[0], r1[0], r0[1], r1[1]}; OUT = *reinterpret_cast<bf16x8*>(&w); } while (0)
    PK4(p0, 0, pa0); PK4(p0, 8, pa1); PK4(p1, 0, pa2); PK4(p1, 8, pa3);
#undef PK4
}
__device__ __forceinline__ void qkt(f32x16& p0, f32x16& p1, LAS unsigned char* slot, const bf16x8* qr, int r32, int hi) {
    p0 = f32x16{}; p1 = f32x16{};
#pragma unroll
    for (int d0 = 0; d0 < 8; ++d0) { const int cb = (d0 * 16 + hi * 8) * 2;
        bf16x8 b0 = *(const LAS bf16x8*)(slot + KN_OFF + KSWZ(r32, cb));
        bf16x8 b1 = *(const LAS bf16x8*)(slot + KN_OFF + KSWZ(32 + r32, cb));
        p0 = __builtin_amdgcn_mfma_f32_32x32x16_bf16(b0, qr[d0], p0, 0, 0, 0);
        p1 = __builtin_amdgcn_mfma_f32_32x32x16_bf16(b1, qr[d0], p1, 0, 0, 0); }
#pragma unroll
    for (int d0 = 0; d0 < 4; ++d0) { const int cb = (d0 * 16 + hi * 8) * 2;
        bf16x8 b0 = *(const LAS bf16x8*)(slot + KR_OFF + KRSWZ(r32, cb));
        bf16x8 b1 = *(const LAS bf16x8*)(slot + KR_OFF + KRSWZ(32 + r32, cb));
        p0 = __builtin_amdgcn_mfma_f32_32x32x16_bf16(b0, qr[8 + d0], p0, 0, 0, 0);
        p1 = __builtin_amdgcn_mfma_f32_32x32x16_bf16(b1, qr[8 + d0], p1, 0, 0, 0); }
}
__device__ __forceinline__ void attn_unit(const bf16_t* __restrict__ Qb, const unsigned char* __restrict__ KNt, const unsigned char* __restrict__ KRt, const unsigned char* __restrict__ Vt,
                                          bf16_t* __restrict__ Ob, int NT, LAS unsigned char* lds) {
    const int tid = otid(), wid = __builtin_amdgcn_readfirstlane(tid >> 6), lane = tid & 63, r32 = lane & 31, hi = lane >> 5;
    LAS float* wsf = (LAS float*)(lds + 3 * SLOT) + wid * 64; LAS float* li_l = wsf; LAS float* al_l = wsf + 32;
    float m_reg = -1e30f, l_reg = 0; f32x16 o[4] = {}; bf16x8 qr[12];
    const bf16_t* Qw = Qb + (size_t)(wid * 32 + r32) * 192 + hi * 8;
#pragma unroll
    for (int d0 = 0; d0 < 12; ++d0) qr[d0] = *(const bf16x8*)(Qw + d0 * 16);
    const int vrb = (int)(unsigned)(uintptr_t)(lds) + V_OFF + v_rd_base(lane);
    const unsigned lo16 = (unsigned)lane * 16u;
#define ATT_DMA(tile, slotoff) do { const size_t t_ = (size_t)(tile); LAS unsigned char* sl_ = lds + (slotoff); \
        __builtin_amdgcn_global_load_lds((const unsigned*)(KNt + t_ * 16384 + wid * 1024 + lo16), (LAS unsigned*)(sl_ + KN_OFF + wid * 1024), 16, 0, 0); \
        __builtin_amdgcn_global_load_lds((const unsigned*)(KNt + t_ * 16384 + (wid + 8) * 1024 + lo16), (LAS unsigned*)(sl_ + KN_OFF + (wid + 8) * 1024), 16, 0, 0); \
        __builtin_amdgcn_global_load_lds((const unsigned*)(KRt + t_ * 8192 + wid * 1024 + lo16), (LAS unsigned*)(sl_ + KR_OFF + wid * 1024), 16, 0, 0); \
        __builtin_amdgcn_global_load_lds((const unsigned*)(Vt + t_ * 16384 + wid * 1024 + lo16), (LAS unsigned*)(sl_ + V_OFF + wid * 1024), 16, 0, 0); \
        __builtin_amdgcn_global_load_lds((const unsigned*)(Vt + t_ * 16384 + (wid + 8) * 1024 + lo16), (LAS unsigned*)(sl_ + V_OFF + (wid + 8) * 1024), 16, 0, 0); } while (0)
#define ATT_SYNC() do { asm volatile("s_waitcnt vmcnt(0)" ::: "memory"); __builtin_amdgcn_s_barrier(); asm volatile("" ::: "memory"); } while (0)
#define RESC(a) do { if (__any((a) < 1.f)) { if (hi == 0) al_l[r32] = (a); asm volatile("s_waitcnt lgkmcnt(0)" ::: "memory"); \
        _Pragma("unroll") for (int d = 0; d < 4; ++d) _Pragma("unroll") for (int r = 0; r < 16; ++r) o[d][r] *= al_l[crow(r, hi)]; } } while (0)
    f32x16 pA0, pA1, pB0, pB1; float mnA, mnB, alA, alB; bf16x8 pa0, pa1, pa2, pa3;
    int sp = 0, sc = SLOT, sn = 2 * SLOT;
    ATT_DMA(0, 0); ATT_DMA(1, SLOT);
    asm volatile("s_waitcnt vmcnt(5)" ::: "memory"); __builtin_amdgcn_s_barrier(); asm volatile("" ::: "memory");
    qkt(pA0, pA1, lds, qr, r32, hi); partialSM(pA0, pA1, m_reg, mnA, alA);
    for (int j = 1; j + 1 < NT; j += 2) {
        ATT_SYNC(); ATT_DMA(j + 1, sn);
        SBAR(); qkt(pB0, pB1, lds + sc, qr, r32, hi);
        finishSM(pA0, pA1, alA, l_reg, pa0, pa1, pa2, pa3); SBAR();
        pv_d0(o, vrb + sp, pa0, pa1, pa2, pa3); partialSM(pB0, pB1, m_reg, mnB, alB);
        RESC(alB);
        { const int t_ = sp; sp = sc; sc = sn; sn = t_; }
        ATT_SYNC(); if (j + 2 < NT) ATT_DMA(j + 2, sn);
        SBAR(); qkt(pA0, pA1, lds + sc, qr, r32, hi);
        finishSM(pB0, pB1, alB, l_reg, pa0, pa1, pa2, pa3); SBAR();
        pv_d0(o, vrb + sp, pa0, pa1, pa2, pa3); partialSM(pA0, pA1, m_reg, mnA, alA);
        RESC(alA);
        { const int t_ = sp; sp = sc; sc = sn; sn = t_; }
    }
    ATT_SYNC();
    SBAR(); qkt(pB0, pB1, lds + sc, qr, r32, hi);
    finishSM(pA0, pA1, alA, l_reg, pa0, pa1, pa2, pa3); SBAR();
    pv_d0(o, vrb + sp, pa0, pa1, pa2, pa3); partialSM(pB0, pB1, m_reg, mnB, alB);
    RESC(alB);
    finishSM(pB0, pB1, alB, l_reg, pa0, pa1, pa2, pa3); SBAR();
    pv_d0(o, vrb + sc, pa0, pa1, pa2, pa3);
    if (hi == 0) li_l[r32] = l_reg; asm volatile("s_waitcnt lgkmcnt(0)" ::: "memory");
    float rli[16];
#pragma unroll
    for (int r = 0; r < 16; ++r) rli[r] = __builtin_amdgcn_rcpf(li_l[crow(r, hi)]);
    bf16_t* Ow = Ob + (size_t)(wid * 32) * 2048;
#pragma unroll
    for (int r = 0; r < 16; ++r) { const int orow = crow(r, hi);
#pragma unroll
        for (int d0 = 0; d0 < 4; ++d0) Ow[(size_t)orow * 2048 + d0 * 32 + r32] = f2bf(o[d0][r] * rli[r]); }
    __builtin_amdgcn_s_barrier(); asm volatile("" ::: "memory");
#undef ATT_DMA
#undef ATT_SYNC
#undef RESC
}
}

namespace att8 {
constexpr int SLOT = 20480, KN_OFF = 0, KR_OFF = 8192, V_OFF = 12288, LDS_BYTES = 3 * SLOT + 8 * 256;
constexpr float THR2 = 8.0f;
constexpr float QUP = 8.f; constexpr int SC_ONE = 0x7f7f7f7f, SC_Q = 0x7c7c7c7c;
__host__ __device__ __forceinline__ int kn8(int key, int b) { return key * 128 + ((((b >> 4) ^ ((key >> 1) & 7))) << 4) + (b & 15); }
__host__ __device__ __forceinline__ int kr8(int key, int b) { return key * 64 + ((((b >> 4) ^ ((key >> 2) & 3))) << 4) + (b & 15); }
__host__ __device__ __forceinline__ int vslot(int k) { return 32 * ((k >> 2) & 1) + 16 * (k >> 5) + (k & 3) + 4 * ((k & 31) >> 3); }
__host__ __device__ __forceinline__ int v8(int d, int k) { const int sl = vslot(k); return d * 64 + ((((sl >> 4) ^ ((d >> 2) & 3))) << 4) + (sl & 15); }
__device__ __forceinline__ i32x8 ld32(const LAS unsigned char* a0, const LAS unsigned char* a1) { const u32x4 x = *(const LAS u32x4*)a0, y = *(const LAS u32x4*)a1;
    return (i32x8){(int)x.x, (int)x.y, (int)x.z, (int)x.w, (int)y.x, (int)y.y, (int)y.z, (int)y.w}; }
__device__ __forceinline__ void qkt(f32x16& p0, f32x16& p1, LAS unsigned char* slot, const i32x8* qf, int r32, int hi) {
    p0 = f32x16{}; p1 = f32x16{};
#pragma unroll
    for (int ks = 0; ks < 2; ++ks) { const int b = 64 * ks + 32 * hi;
        const i32x8 a0 = ld32(slot + KN_OFF + kn8(r32, b), slot + KN_OFF + kn8(r32, b + 16)), a1 = ld32(slot + KN_OFF + kn8(32 + r32, b), slot + KN_OFF + kn8(32 + r32, b + 16));
        p0 = __builtin_amdgcn_mfma_scale_f32_32x32x64_f8f6f4(a0, qf[ks], p0, 0, 0, 0, SC_ONE, 0, SC_Q);
        p1 = __builtin_amdgcn_mfma_scale_f32_32x32x64_f8f6f4(a1, qf[ks], p1, 0, 0, 0, SC_ONE, 0, SC_Q); }
    { const int b = 32 * hi;
        const i32x8 a0 = ld32(slot + KR_OFF + kr8(r32, b), slot + KR_OFF + kr8(r32, b + 16)), a1 = ld32(slot + KR_OFF + kr8(32 + r32, b), slot + KR_OFF + kr8(32 + r32, b + 16));
        p0 = __builtin_amdgcn_mfma_scale_f32_32x32x64_f8f6f4(a0, qf[2], p0, 0, 0, 0, SC_ONE, 0, SC_Q);
        p1 = __builtin_amdgcn_mfma_scale_f32_32x32x64_f8f6f4(a1, qf[2], p1, 0, 0, 0, SC_ONE, 0, SC_Q); }
}
__device__ __forceinline__ void partialSM(f32x16& p0, f32x16& p1, float& m_reg, float& mn, float& alpha) {
    float pmax = p0[0];
#pragma unroll
    for (int r = 1; r < 16; ++r) pmax = fmaxf(pmax, p0[r]);
#pragma unroll
    for (int r = 0; r < 16; ++r) pmax = fmaxf(pmax, p1[r]);
    { auto rr = __builtin_amdgcn_permlane32_swap(__float_as_uint(pmax), __float_as_uint(pmax), false, false);
      pmax = fmaxf(__uint_as_float(rr[0]), __uint_as_float(rr[1])); }
    if (__builtin_expect(__all(pmax - m_reg <= THR2), 1)) { mn = m_reg; alpha = 1.f; }
    else { mn = fmaxf(m_reg, pmax); alpha = __builtin_amdgcn_exp2f(m_reg - mn); m_reg = mn; }
#pragma unroll
    for (int r = 0; r < 16; ++r) p0[r] = __builtin_amdgcn_exp2f(p0[r] - mn);
#pragma unroll
    for (int r = 0; r < 16; ++r) p1[r] = p1[r] - mn;
}
__device__ __forceinline__ void finishSM(f32x16& p0, f32x16& p1, float alpha, float& l_reg, i32x8& pf) {
#pragma unroll
    for (int r = 0; r < 16; ++r) p1[r] = __builtin_amdgcn_exp2f(p1[r]);
    float ps = 0;
#pragma unroll
    for (int r = 0; r < 16; ++r) ps += p0[r];
#pragma unroll
    for (int r = 0; r < 16; ++r) ps += p1[r];
    { auto rr = __builtin_amdgcn_permlane32_swap(__float_as_uint(ps), __float_as_uint(ps), false, false);
      ps = __uint_as_float(rr[0]) + __uint_as_float(rr[1]); }
    l_reg = l_reg * alpha + ps;
#pragma unroll
    for (int w = 0; w < 4; ++w) { pf[w] = (int)pk4_fp8(p0[4 * w], p0[4 * w + 1], p0[4 * w + 2], p0[4 * w + 3]); pf[4 + w] = (int)pk4_fp8(p1[4 * w], p1[4 * w + 1], p1[4 * w + 2], p1[4 * w + 3]); }
}
__device__ __forceinline__ void pv(f32x16* o, LAS unsigned char* slot, const i32x8 pf, int r32, int hi) {
#pragma unroll
    for (int d0 = 0; d0 < 4; ++d0) { const int d = 32 * d0 + r32, sw = (d >> 2) & 3;
        const i32x8 b = ld32(slot + V_OFF + d * 64 + (((2 * hi) ^ sw) << 4), slot + V_OFF + d * 64 + (((2 * hi + 1) ^ sw) << 4));
        o[d0] = __builtin_amdgcn_mfma_scale_f32_32x32x64_f8f6f4(pf, b, o[d0], 0, 0, 0, SC_ONE, 0, SC_ONE); }
}
__device__ __forceinline__ int crow(int r, int hi) { return (r & 3) + 8 * (r >> 2) + 4 * hi; }
__device__ __forceinline__ void attn_unit(const unsigned char* __restrict__ Qb, const unsigned char* __restrict__ KNt, const unsigned char* __restrict__ KRt, const unsigned char* __restrict__ Vt,
                                          bf16_t* __restrict__ Ob, int NT, LAS unsigned char* lds) {
    const int tid = otid(), wid = __builtin_amdgcn_readfirstlane(tid >> 6), lane = tid & 63, r32 = lane & 31, hi = lane >> 5;
    LAS float* wsf = (LAS float*)(lds + 3 * SLOT) + wid * 64; LAS float* li_l = wsf; LAS float* al_l = wsf + 32;
    float m_reg = -1e30f, l_reg = 0; f32x16 o[4] = {}; i32x8 qf[3];
    const unsigned char* Qw = Qb + (size_t)(wid * 32 + r32) * 192 + 32 * hi;
#pragma unroll
    for (int ks = 0; ks < 3; ++ks) { const u32x4 x = *(const u32x4*)(Qw + 64 * ks), y = *(const u32x4*)(Qw + 64 * ks + 16); qf[ks] = (i32x8){(int)x.x, (int)x.y, (int)x.z, (int)x.w, (int)y.x, (int)y.y, (int)y.z, (int)y.w}; }
    const unsigned lo16 = (unsigned)lane * 16u;
#define ATT_DMA(tile, slotoff) do { const size_t t_ = (size_t)(tile); LAS unsigned char* sl_ = lds + (slotoff); \
        __builtin_amdgcn_global_load_lds((const unsigned*)(KNt + t_ * 8192 + wid * 1024 + lo16), (LAS unsigned*)(sl_ + KN_OFF + wid * 1024), 16, 0, 0); \
        __builtin_amdgcn_global_load_lds((const unsigned*)(Vt + t_ * 8192 + wid * 1024 + lo16), (LAS unsigned*)(sl_ + V_OFF + wid * 1024), 16, 0, 0); \
        if (wid < 4) __builtin_amdgcn_global_load_lds((const unsigned*)(KRt + t_ * 4096 + wid * 1024 + lo16), (LAS unsigned*)(sl_ + KR_OFF + wid * 1024), 16, 0, 0); } while (0)
#define ATT_SYNC() do { asm volatile("s_waitcnt vmcnt(0)" ::: "memory"); __builtin_amdgcn_s_barrier(); asm volatile("" ::: "memory"); } while (0)
#define RESC(a) do { if (__any((a) < 1.f)) { if (hi == 0) al_l[r32] = (a); asm volatile("s_waitcnt lgkmcnt(0)" ::: "memory"); \
        _Pragma("unroll") for (int d = 0; d < 4; ++d) _Pragma("unroll") for (int r = 0; r < 16; ++r) o[d][r] *= al_l[crow(r, hi)]; } } while (0)
    f32x16 pA0, pA1, pB0, pB1; float mnA, mnB, alA, alB; i32x8 pf;
    int sp = 0, sc = SLOT, sn = 2 * SLOT;
    ATT_DMA(0, 0);
    ATT_SYNC();
    ATT_DMA(1, SLOT);
    qkt(pA0, pA1, lds, qf, r32, hi); partialSM(pA0, pA1, m_reg, mnA, alA);
    for (int j = 1; j + 1 < NT; j += 2) {
        ATT_SYNC(); ATT_DMA(j + 1, sn);
        SBAR(); qkt(pB0, pB1, lds + sc, qf, r32, hi);
        finishSM(pA0, pA1, alA, l_reg, pf); SBAR();
        pv(o, lds + sp, pf, r32, hi); partialSM(pB0, pB1, m_reg, mnB, alB);
        RESC(alB);
        { const int t_ = sp; sp = sc; sc = sn; sn = t_; }
        ATT_SYNC(); if (j + 2 < NT) ATT_DMA(j + 2, sn);
        SBAR(); qkt(pA0, pA1, lds + sc, qf, r32, hi);
        finishSM(pB0, pB1, alB, l_reg, pf); SBAR();
        pv(o, lds + sp, pf, r32, hi); partialSM(pA0, pA1, m_reg, mnA, alA);
        RESC(alA);
        { const int t_ = sp; sp = sc; sc = sn; sn = t_; }
    }
    ATT_SYNC();
    SBAR(); qkt(pB0, pB1, lds + sc, qf, r32, hi);
    finishSM(pA0, pA1, alA, l_reg, pf); SBAR();
    pv(o, lds + sp, pf, r32, hi); partialSM(pB0, pB1, m_reg, mnB, alB);
    RESC(alB);
    finishSM(pB0, pB1, alB, l_reg, pf); SBAR();
    pv(o, lds + sc, pf, r32, hi);
    if (hi == 0) li_l[r32] = l_reg; asm volatile("s_waitcnt lgkmcnt(0)" ::: "memory");
    float rli[16];
#pragma unroll
    for (int r = 0; r < 16; ++r) rli[r] = __builtin_amdgcn_rcpf(li_l[crow(r, hi)]);
    bf16_t* Ow = Ob + (size_t)(wid * 32) * 2048;
#pragma unroll
    for (int r = 0; r < 16; ++r) { const int orow = crow(r, hi);
#pragma unroll
        for (int d0 = 0; d0 < 4; ++d0) Ow[(size_t)orow * 2048 + d0 * 32 + r32] = f2bf(o[d0][r] * rli[r]); }
    __builtin_amdgcn_s_barrier(); asm volatile("" ::: "memory");
#undef ATT_DMA
#undef ATT_SYNC
#undef RESC
}
}

namespace ssd {
constexpr int XT_OFF = 0, BT_OFF = 17408, HB_OFF = 52224, SET = 69632, CW_OFF = 2 * SET, LDS_BYTES = CW_OFF + 8 * 1536;
constexpr int PITCH = 272;
constexpr float L2E = 1.4426950408889634f;
__device__ __forceinline__ void g_unit(const bf16_t* __restrict__ BC, bf16_t* __restrict__ G, int unit) {
    const int cid = unit >> 1, g = unit & 1;
    const int r0 = cid < 256 ? cid * 128 : NLAT + (cid - 256) * 128;
    const int tid = otid(), wid = tid >> 6, lane = tid & 63, fr = lane & 15, fq = lane >> 4;
    const bf16_t* Cp = BC + (size_t)(r0 + 16 * wid + fr) * 512 + 256 + 128 * g + 8 * fq;
    bf16x8 cf[4];
#pragma unroll
    for (int ks = 0; ks < 4; ++ks) cf[ks] = *(const bf16x8*)(Cp + 32 * ks);
    bf16_t* Gp = G + ((size_t)unit * 128 + 16 * wid + fr) * 128 + 4 * fq;
#pragma unroll
    for (int sb = 0; sb < 8; ++sb) {
        const bf16_t* Bp = BC + (size_t)(r0 + 16 * sb + fr) * 512 + 128 * g + 8 * fq;
        f32x4 acc = {0.f, 0.f, 0.f, 0.f};
#pragma unroll
        for (int ks = 0; ks < 4; ++ks) { const bf16x8 bfr = *(const bf16x8*)(Bp + 32 * ks); acc = __builtin_amdgcn_mfma_f32_16x16x32_bf16(bfr, cf[ks], acc, 0, 0, 0); }
        u32x2 w; w.x = cvt_pk_bf16(acc[0], acc[1]); w.y = cvt_pk_bf16(acc[2], acc[3]);
        *(u32x2*)(Gp + 16 * sb) = w;
    }
}
__device__ __forceinline__ void ssd_unit(int b, int h, int d, const bf16_t* __restrict__ XS, const bf16_t* __restrict__ BC, const float* __restrict__ DT, const bf16_t* __restrict__ G,
                                         const float* __restrict__ a_log, bf16_t* __restrict__ Y, LAS unsigned char* lds) {
    const int g = h >> 3;
    const int tid = otid(), wid = tid >> 6, lane = tid & 63, fr = lane & 15, fq = lane >> 4;
    const float a = -__expf(a_log[d * 16 + h]);
    LAS float* cw = (LAS float*)(lds + CW_OFF + wid * 1536); LAS float* dts = cw + 128; LAS float* dtw = cw + 256;
    f32x4 hs[4];
#pragma unroll
    for (int q = 0; q < 4; ++q) hs[q] = (f32x4){0.f, 0.f, 0.f, 0.f};
    for (int i = tid; i < 17408 / 4; i += 512) ((LAS unsigned*)(lds + HB_OFF))[i] = 0u;
    float cend = 0.f;
#define SSD_ROWS(step, r0v, gidv) do { if ((step) < 2) { const int oc_ = d ? 1 - (step) : (step); r0v = NLAT + b * 256 + oc_ * 128; gidv = 256 + b * 2 + oc_; } \
        else { const int lc_ = (step) - 2, oc_ = d ? 63 - lc_ : lc_; r0v = b * 8192 + oc_ * 128; gidv = b * 64 + oc_; } } while (0)
    const int sg = tid & 31, n8 = tid >> 5, p4 = tid >> 5;
    f32x2 P_da, Q_da; u32x2 P_xv[4], Q_xv[4]; u32x4 P_bv[4], Q_bv[4], n_gv[4], n_cv[4], c_gv[4], c_cv[4];
#define SSD_LOAD(step, X) do { int r0_, gid_; SSD_ROWS(step, r0_, gid_); (void)gid_; X##_da = *(const f32x2*)(DT + (size_t)(d * 16 + h) * NROW + r0_ + 2 * lane); \
        _Pragma("unroll") for (int j_ = 0; j_ < 4; ++j_) { X##_xv[j_] = *(const u32x2*)(XS + (size_t)(r0_ + 4 * sg + j_) * 1024 + 64 * h + 4 * p4); \
                                                         X##_bv[j_] = *(const u32x4*)(BC + (size_t)(r0_ + 4 * sg + j_) * 512 + 128 * g + 8 * n8); } } while (0)
#define SSD_LOADGC(step) do { int r0_, gid_; SSD_ROWS(step, r0_, gid_); const int t_ = 16 * wid + fr; const bf16_t* Gp_ = G + ((size_t)(gid_ * 2 + g) * 128 + t_) * 128 + 8 * fq; const bf16_t* Cp_ = BC + (size_t)(r0_ + t_) * 512 + 256 + 128 * g + 8 * fq; \
          _Pragma("unroll") for (int ks_ = 0; ks_ < 4; ++ks_) { n_gv[ks_] = *(const u32x4*)(Gp_ + 32 * ks_); n_cv[ks_] = *(const u32x4*)(Cp_ + 32 * ks_); } } while (0)
#define SSD_GCROT() do { _Pragma("unroll") for (int ks_ = 0; ks_ < 4; ++ks_) { c_gv[ks_] = n_gv[ks_]; c_cv[ks_] = n_cv[ks_]; } } while (0)
#define SSD_WRITE(step, X) do { LAS unsigned char* set_ = lds + ((step) & 1) * SET; \
        const float da0 = X##_da.x * a, da1 = X##_da.y * a; \
        float sc_ = da0 + da1; float c0_, c1_; \
        if (d == 0) { _Pragma("unroll") for (int o_ = 1; o_ < 64; o_ <<= 1) { const float t_ = __shfl_up(sc_, o_); if (lane >= o_) sc_ += t_; } \
            c0_ = sc_ - da1; c1_ = sc_; cend = __shfl(sc_, 63); } \
        else { _Pragma("unroll") for (int o_ = 1; o_ < 64; o_ <<= 1) { const float t_ = __shfl_down(sc_, o_); if (lane + o_ < 64) sc_ += t_; } \
            c0_ = sc_; c1_ = sc_ - da0; cend = __shfl(sc_, 0); } \
        *(LAS f32x2*)(cw + 2 * lane) = (f32x2){c0_, c1_}; *(LAS f32x2*)(dts + 2 * lane) = X##_da; \
        *(LAS f32x2*)(dtw + 2 * lane) = (f32x2){X##_da.x * __builtin_amdgcn_exp2f((cend - c0_) * L2E), X##_da.y * __builtin_amdgcn_exp2f((cend - c1_) * L2E)}; \
        { LAS unsigned char* xt_ = set_ + XT_OFF + (4 * p4) * PITCH + 8 * sg; \
          _Pragma("unroll") for (int i_ = 0; i_ < 4; ++i_) { unsigned e_[4]; \
              _Pragma("unroll") for (int j_ = 0; j_ < 4; ++j_) { const unsigned w_ = (i_ & 2) ? X##_xv[j_].y : X##_xv[j_].x; e_[j_] = (i_ & 1) ? (w_ >> 16) : (w_ & 0xffffu); } \
              u32x2 o_; o_.x = e_[0] | (e_[1] << 16); o_.y = e_[2] | (e_[3] << 16); *(LAS u32x2*)(xt_ + i_ * PITCH) = o_; } } \
        { LAS unsigned char* bt_ = set_ + BT_OFF + (8 * n8) * PITCH + 8 * sg; \
          _Pragma("unroll") for (int i_ = 0; i_ < 8; ++i_) { unsigned e_[4]; \
              _Pragma("unroll") for (int j_ = 0; j_ < 4; ++j_) { const unsigned w_ = X##_bv[j_][i_ >> 1]; e_[j_] = (i_ & 1) ? (w_ >> 16) : (w_ & 0xffffu); } \
              u32x2 o_; o_.x = e_[0] | (e_[1] << 16); o_.y = e_[2] | (e_[3] << 16); *(LAS u32x2*)(bt_ + i_ * PITCH) = o_; } } \
        asm volatile("s_waitcnt lgkmcnt(0)" ::: "memory"); \
    } while (0)
    SSD_LOAD(0, Q); SSD_LOADGC(0); SSD_WRITE(0, Q); SSD_LOAD(1, P);
    for (int step2 = 0; step2 < 66; step2 += 2)
#pragma unroll
    for (int par = 0; par < 2; ++par) {
        const int step = step2 + par;
        __syncthreads();
        int r0, gid; SSD_ROWS(step, r0, gid); (void)gid;
        LAS unsigned char* set = lds + (step & 1) * SET;
        const float cend_cur = cend;
        SSD_GCROT();
        if (step + 1 < 66) SSD_LOADGC(step + 1);
        if (step + 2 < 66) { if (par == 0) SSD_LOAD(step + 2, Q); else SSD_LOAD(step + 2, P); }
        {
            const int t = 16 * wid + fr; const float ct = cw[t];
            f32x4 y[4];
#pragma unroll
            for (int q = 0; q < 4; ++q) y[q] = (f32x4){0.f, 0.f, 0.f, 0.f};
            const float et = __builtin_amdgcn_exp2f(ct * L2E);
#pragma unroll
            for (int ks = 0; ks < 4; ++ks) {
                const bool live = d == 0 ? (32 * ks <= 16 * wid + 15) : (32 * ks + 31 >= 16 * wid);
                if (live) {
                    const int s0 = 32 * ks + 8 * fq;
                    const f32x4 c0 = *(const LAS f32x4*)(cw + s0), c1 = *(const LAS f32x4*)(cw + s0 + 4), d0v = *(const LAS f32x4*)(dts + s0), d1v = *(const LAS f32x4*)(dts + s0 + 4);
                    float m[8];
#pragma unroll
                    for (int i = 0; i < 8; ++i) { const float cs = i < 4 ? c0[i & 3] : c1[i & 3], dv = i < 4 ? d0v[i & 3] : d1v[i & 3]; const int s = s0 + i;
                        const bool ok = d == 0 ? (s <= t) : (s >= t);
                        const float gval = (i & 1) ? bfhi(c_gv[ks][i >> 1]) : bflo(c_gv[ks][i >> 1]);
                        m[i] = ok ? gval * dv * __builtin_amdgcn_exp2f((ct - cs) * L2E) : 0.f; }
                    u32x4 mw; mw.x = cvt_pk_bf16(m[0], m[1]); mw.y = cvt_pk_bf16(m[2], m[3]); mw.z = cvt_pk_bf16(m[4], m[5]); mw.w = cvt_pk_bf16(m[6], m[7]);
                    const bf16x8 mb = __builtin_bit_cast(bf16x8, mw);
#pragma unroll
                    for (int q = 0; q < 4; ++q) { const bf16x8 af = *(const LAS bf16x8*)(set + XT_OFF + (16 * q + fr) * PITCH + (32 * ks + 8 * fq) * 2);
                        y[q] = __builtin_amdgcn_mfma_f32_16x16x32_bf16(af, mb, y[q], 0, 0, 0); }
                }
            }
#pragma unroll
            for (int ks = 0; ks < 4; ++ks) {
                u32x4 cwv;
#pragma unroll
                for (int i = 0; i < 4; ++i) cwv[i] = cvt_pk_bf16(bflo(c_cv[ks][i]) * et, bfhi(c_cv[ks][i]) * et);
                const bf16x8 cb = __builtin_bit_cast(bf16x8, cwv);
#pragma unroll
                for (int q = 0; q < 4; ++q) { const bf16x8 af = *(const LAS bf16x8*)(set + HB_OFF + (16 * q + fr) * PITCH + (32 * ks + 8 * fq) * 2);
                    y[q] = __builtin_amdgcn_mfma_f32_16x16x32_bf16(af, cb, y[q], 0, 0, 0); }
            }
            bf16_t* yp = Y + (size_t)(r0 + t) * 1024 + 64 * h + 4 * fq;
#pragma unroll
            for (int q = 0; q < 4; ++q) { u32x2 w; w.x = cvt_pk_bf16(y[q][0], y[q][1]); w.y = cvt_pk_bf16(y[q][2], y[q][3]); *(u32x2*)(yp + 16 * q) = w; }
        }
        {
            const float dec = __builtin_amdgcn_exp2f(cend_cur * L2E);
#pragma unroll
            for (int q = 0; q < 4; ++q) hs[q] = hs[q] * dec;
#pragma unroll
            for (int ks = 0; ks < 4; ++ks) {
                const int s0 = 32 * ks + 8 * fq;
                const u32x4 braw = *(const LAS u32x4*)(set + BT_OFF + (16 * wid + fr) * PITCH + s0 * 2);
                const f32x4 w0 = *(const LAS f32x4*)(dtw + s0), w1 = *(const LAS f32x4*)(dtw + s0 + 4);
                u32x4 bw; bw.x = cvt_pk_bf16(bflo(braw.x) * w0[0], bfhi(braw.x) * w0[1]); bw.y = cvt_pk_bf16(bflo(braw.y) * w0[2], bfhi(braw.y) * w0[3]);
                          bw.z = cvt_pk_bf16(bflo(braw.z) * w1[0], bfhi(braw.z) * w1[1]); bw.w = cvt_pk_bf16(bflo(braw.w) * w1[2], bfhi(braw.w) * w1[3]);
                const bf16x8 bfr = __builtin_bit_cast(bf16x8, bw);
#pragma unroll
                for (int q = 0; q < 4; ++q) { const bf16x8 af = *(const LAS bf16x8*)(set + XT_OFF + (16 * q + fr) * PITCH + s0 * 2);
                    hs[q] = __builtin_amdgcn_mfma_f32_16x16x32_bf16(af, bfr, hs[q], 0, 0, 0); }
            }
            LAS bf16_t* hb = (LAS bf16_t*)(lds + ((step + 1) & 1) * SET + HB_OFF) + 16 * wid + fr;
#pragma unroll
            for (int q = 0; q < 4; ++q)
#pragma unroll
                for (int i = 0; i < 4; ++i) hb[(16 * q + 4 * fq + i) * 136] = f2bf(hs[q][i]);
        }
        if (step + 1 < 66) { if (par == 0) SSD_WRITE(step + 1, P); else SSD_WRITE(step + 1, Q); }
    }
    __syncthreads();
#undef SSD_ROWS
#undef SSD_LOAD
#undef SSD_LOADGC
#undef SSD_GCROT
#undef SSD_WRITE
}
}

struct Args { const float* in[32]; float* out; unsigned char* ws; int ph_lo, ph_hi; };
constexpr int NTHR = 512;
constexpr int LDS_BASE = 256;
constexpr int LDS_PHASE = 151808;
constexpr int LDS_BYTES = LDS_BASE + LDS_PHASE;
static_assert(att::LDS_BYTES <= LDS_PHASE && att8::LDS_BYTES <= LDS_PHASE && ssd::LDS_BYTES <= LDS_PHASE && pg8::STAGE_BYTES <= LDS_PHASE, "LDS");

__device__ __forceinline__ void tjob(int j, const Args& A, const float*& src, bf16_t*& dst, int& K, int& N, int& Npad, int& mode, const float*& ks) {
    unsigned char* W = A.ws + WS_W; mode = 0; ks = nullptr;
    if (j < 8) { const int i = j >> 2, w = j & 3; unsigned char* base = W + W_HYB + (size_t)i * WH_SZ;
        if (w == 0)      { src = A.in[I_HWIN] + (size_t)i * 1024 * HYB_IN; dst = (bf16_t*)(base + WH_IN); K = 1024; N = HYB_IN; Npad = HYB_INP; mode = 1; }
        else if (w == 1) { src = A.in[I_WQB] + (size_t)i * 384 * 1536; dst = (bf16_t*)(base + WH_QB); K = 384; N = 1536; Npad = 1536; mode = 2; ks = A.in[I_QNG] + i * 384; }
        else if (w == 2) { src = A.in[I_WKVB] + (size_t)i * 256 * 2048; dst = (bf16_t*)(base + WH_KVB); K = 256; N = 2048; Npad = 2048; ks = A.in[I_KVNG] + i * 256; }
        else             { src = A.in[I_HWOUT] + (size_t)i * 2048 * 1024; dst = (bf16_t*)(base + WH_OUT); K = 2048; N = 1024; Npad = 1024; }
    } else if (j < 12) { const int i = (j - 8) >> 1, w = (j - 8) & 1; unsigned char* base = W + W_GM + (size_t)i * WG_SZ;
        if (w == 0) { src = A.in[I_GWIN] + (size_t)i * 1024 * 4096; dst = (bf16_t*)(base + WG_IN); K = 1024; N = 4096; Npad = 4096; }
        else        { src = A.in[I_GWOUT] + (size_t)i * 2048 * 1024; dst = (bf16_t*)(base + WG_OUT); K = 2048; N = 1024; Npad = 1024; }
    } else { const int l = j - 12; src = A.in[I_PWQ] + (size_t)l * 1024 * 2048; dst = (bf16_t*)(W + W_PEER + (size_t)l * WP_SZ + WP_Q); K = 1024; N = 2048; Npad = 2048; }
}
__device__ __forceinline__ int colmap(int mode, int n, int N) {
    if (mode == 1) { if (n >= N) return -1; if (n < C_KR) return n; const int m = n - C_KR; return C_KR + (m >> 1) + 32 * (m & 1); }
    if (mode == 2) { if (n < 1024) return (n >> 7) * 192 + (n & 127); const int m = n - 1024, h = m >> 6, mm = m & 63; return h * 192 + 128 + (mm >> 1) + 32 * (mm & 1); }
    return n;
}
__device__ __forceinline__ void phase_prologue(const Args& A, LAS unsigned char* lds) {
    const int tid = otid();
    {
        LAS float* tile = (LAS float*)lds;
        int item = blockIdx.x;
        for (int j = 0; j < 16; ++j) {
            const float* src; bf16_t* dst; int K, N, Npad, mode; const float* ks; tjob(j, A, src, dst, K, N, Npad, mode, ks);
            const int tk = K / 64, tn = Npad / 64, nt = tk * tn;
            for (; item < nt; item += gridDim.x) {
                const int k0 = (item % tk) * 64, n0 = (item / tk) * 64;
                { const int k = tid >> 3, cg = tid & 7; const float sc = ks ? ks[k0 + k] : 1.f;
#pragma unroll
                  for (int jj = 0; jj < 8; ++jj) { const int oc = colmap(mode, n0 + 8 * cg + jj, N); tile[k * 65 + 8 * cg + jj] = oc >= 0 ? src[(size_t)(k0 + k) * N + oc] * sc : 0.f; } }
                __syncthreads();
                { const int n = tid >> 3, kg = tid & 7; float v[8];
#pragma unroll
                  for (int jj = 0; jj < 8; ++jj) v[jj] = tile[(8 * kg + jj) * 65 + n];
                  u32x4 w; w.x = cvt_pk_bf16(v[0], v[1]); w.y = cvt_pk_bf16(v[2], v[3]); w.z = cvt_pk_bf16(v[4], v[5]); w.w = cvt_pk_bf16(v[6], v[7]);
                  *(u32x4*)(dst + (size_t)(n0 + n) * K + k0 + 8 * kg) = w; }
                __syncthreads();
            }
            item -= nt;
        }
    }
    {
        const int gthr = blockIdx.x * NTHR + tid, nthr = gridDim.x * NTHR;
        for (int p = gthr; p < 10 * 16384; p += nthr) {
            const int mat = p >> 14, off = (p & 16383) * 8; const float* src; bf16_t* dst;
            if (mat < 2)      { src = A.in[I_GWS] + (size_t)mat * 131072; dst = (bf16_t*)(A.ws + WS_W + W_GM + (size_t)mat * WG_SZ + WG_WS); }
            else if (mat < 6) { src = A.in[I_PK1] + (size_t)(mat - 2) * 131072; dst = (bf16_t*)(A.ws + WS_W + W_PEER + (size_t)(mat - 2) * WP_SZ + WP_K1); }
            else              { src = A.in[I_PK2] + (size_t)(mat - 6) * 131072; dst = (bf16_t*)(A.ws + WS_W + W_PEER + (size_t)(mat - 6) * WP_SZ + WP_K2); }
            const f32x4 a = *(const f32x4*)(src + off), b = *(const f32x4*)(src + off + 4);
            u32x4 w; w.x = cvt_pk_bf16(a[0], a[1]); w.y = cvt_pk_bf16(a[2], a[3]); w.z = cvt_pk_bf16(b[0], b[1]); w.w = cvt_pk_bf16(b[2], b[3]);
            *(u32x4*)(dst + off) = w;
        }
        float* rope = (float*)(A.ws + WS_ROPE);
        for (int p = gthr; p < SEQ * 32; p += nthr) { const int l = p >> 5, i = p & 31; const float pos = (float)(i < 16 ? (l >> 6) : (l & 63));
            const float inv = powf(10000.f, -(float)(i & 15) / 16.f), ang = pos * inv; rope[p] = cosf(ang); rope[SEQ * 32 + p] = sinf(ang); }
    }
    {
        LAS float* scond = (LAS float*)lds;
        LAS float* red = scond + 5 * 1024;
        __syncthreads();
        for (int i = tid; i < 5 * 1024; i += NTHR) { const int m = i >> 10, k = i & 1023; const float c = m < 4 ? A.in[I_C][m * 1024 + k] : A.in[I_CCTX][k]; scond[i] = silu_f(c); }
        __syncthreads();
        float* MOD = (float*)(A.ws + WS_MOD);
        for (int item = blockIdx.x; item < 4 * 48; item += gridDim.x) {
            const int layer = item / 48, j0 = (item % 48) * 128; const int c4 = tid & 31, ksl = tid >> 5;
            f32x4 acc[5];
#pragma unroll
            for (int m = 0; m < 5; ++m) acc[m] = (f32x4){0.f, 0.f, 0.f, 0.f};
            const float* wp = A.in[I_ADAW] + ((size_t)layer * 1024 + ksl * 64) * 6144 + j0 + 4 * c4;
            for (int k = 0; k < 64; ++k) { const f32x4 w = *(const f32x4*)(wp + (size_t)k * 6144);
#pragma unroll
                for (int m = 0; m < 5; ++m) acc[m] += w * scond[m * 1024 + ksl * 64 + k]; }
#pragma unroll
            for (int m = 0; m < 5; ++m) *(LAS f32x4*)(red + (ksl * 5 + m) * 128 + 4 * c4) = acc[m];
            __syncthreads();
            for (int i = tid; i < 640; i += NTHR) { const int m = i >> 7, c = i & 127; float s = A.in[I_ADAB][layer * 6144 + j0 + c];
#pragma unroll
                for (int q = 0; q < 16; ++q) s += red[(q * 5 + m) * 128 + c];
                MOD[((size_t)layer * 5 + m) * 6144 + j0 + c] = s; }
            __syncthreads();
        }
    }
}

__device__ __forceinline__ void phase_norm_mod(const float* xl, const float* xc, float* cl, float* cc, const float* g, const float* modl, int sh_idx, bf16_t* H, int nrows) {
    const int tid_ = otid(); const int lane = tid_ & 63, gw = blockIdx.x * 8 + (tid_ >> 6), nw = gridDim.x * 8;
    f32x4 gv[4];
#pragma unroll
    for (int i = 0; i < 4; ++i) gv[i] = *(const f32x4*)(g + 256 * i + 4 * lane);
    for (int r = gw; r < nrows; r += nw) {
        const bool lat = r < NLAT; const float* xp = lat ? xl + (size_t)r * D : xc + (size_t)(r - NLAT) * D;
        f32x4 x[4]; float ss = 0.f;
#pragma unroll
        for (int i = 0; i < 4; ++i) { x[i] = *(const f32x4*)(xp + 256 * i + 4 * lane); ss += x[i][0] * x[i][0] + x[i][1] * x[i][1] + x[i][2] * x[i][2] + x[i][3] * x[i][3]; }
        if (cl) { float* cp = lat ? cl + (size_t)r * D : cc + (size_t)(r - NLAT) * D;
#pragma unroll
            for (int i = 0; i < 4; ++i) *(f32x4*)(cp + 256 * i + 4 * lane) = x[i]; }
        ss = wave_sum(ss); const float rstd = rsqrtf(ss * (1.f / 1024.f) + EPS);
        const float* mp = modl + (size_t)(lat ? (r >> 13) : 4) * 6144 + sh_idx * 1024;
#pragma unroll
        for (int i = 0; i < 4; ++i) { const f32x4 sh = *(const f32x4*)(mp + 256 * i + 4 * lane), sc = *(const f32x4*)(mp + 1024 + 256 * i + 4 * lane);
            const f32x4 hv = (x[i] * rstd) * gv[i] * (sc + 1.f) + sh;
            u32x2 w; w.x = cvt_pk_bf16(hv[0], hv[1]); w.y = cvt_pk_bf16(hv[2], hv[3]);
            *(u32x2*)(H + (size_t)r * D + 256 * i + 4 * lane) = w; }
    }
}
__device__ __forceinline__ void phase_final_norm(float* xl, const float* g, float oscale) {
    const int tid_ = otid(); const int lane = tid_ & 63, gw = blockIdx.x * 8 + (tid_ >> 6), nw = gridDim.x * 8;
    f32x4 gv[4];
#pragma unroll
    for (int i = 0; i < 4; ++i) gv[i] = *(const f32x4*)(g + 256 * i + 4 * lane);
    for (int r = gw; r < NLAT; r += nw) {
        float* xp = xl + (size_t)r * D; f32x4 x[4]; float ss = 0.f;
#pragma unroll
        for (int i = 0; i < 4; ++i) { x[i] = *(const f32x4*)(xp + 256 * i + 4 * lane); ss += x[i][0] * x[i][0] + x[i][1] * x[i][1] + x[i][2] * x[i][2] + x[i][3] * x[i][3]; }
        ss = wave_sum(ss); const float rstd = rsqrtf(ss * (1.f / 1024.f) + EPS);
#pragma unroll
        for (int i = 0; i < 4; ++i) *(f32x4*)(xp + 256 * i + 4 * lane) = (x[i] * (rstd * oscale)) * gv[i];
    }
}

__device__ __forceinline__ void phase_conv(const Args& A, int li) {
    const bf16_t* PROJ = (const bf16_t*)(A.ws + WS_BIG);
    bf16_t* XS = (bf16_t*)(A.ws + WS_R2); bf16_t* BC = (bf16_t*)(A.ws + WS_R2 + R2_BC);
    const int tid = otid();
    {
        for (int item = blockIdx.x * 3; item < (NROW / 64) * 3; item += gridDim.x * 3)
#pragma unroll 1
        for (int sub = 0; sub < 3; ++sub) {
            const int blk = (item + sub) / 3, q = ((item + sub) % 3) * 512 + tid, cg = q % 192, rg = q / 192, c0 = 8 * cg;
            const int rbeg = blk * 64 + rg * 8; int s0, s1;
            if (rbeg < NLAT) { s0 = rbeg & ~8191; s1 = s0 + 8192; } else { s0 = NLAT + ((rbeg - NLAT) & ~255); s1 = s0 + 256; }
            const float* cw = A.in[I_CONVW] + ((size_t)li * 1536 + c0) * 5; const float* cb = A.in[I_CONVB] + (size_t)li * 1536 + c0;
            u32x4 in[12];
#pragma unroll
            for (int i = 0; i < 12; ++i) { const int r = rbeg - 2 + i; in[i] = (r >= s0 && r < s1) ? *(const u32x4*)(PROJ + (size_t)r * HYB_INP + C_XBC + c0) : (u32x4){0u, 0u, 0u, 0u}; }
            float w[8][5], bia[8];
#pragma unroll
            for (int j = 0; j < 8; ++j) { bia[j] = cb[j];
#pragma unroll
                for (int k = 0; k < 5; ++k) w[j][k] = cw[j * 5 + k]; }
#pragma unroll
            for (int rr = 0; rr < 8; ++rr) {
                float o[8];
#pragma unroll
                for (int j = 0; j < 8; ++j) { float sacc = bia[j];
#pragma unroll
                    for (int k = 0; k < 5; ++k) { const unsigned wd = in[rr + k][j >> 1]; sacc += w[j][k] * ((j & 1) ? bfhi(wd) : bflo(wd)); }
                    o[j] = silu_f(sacc); }
                u32x4 pk; pk.x = cvt_pk_bf16(o[0], o[1]); pk.y = cvt_pk_bf16(o[2], o[3]); pk.z = cvt_pk_bf16(o[4], o[5]); pk.w = cvt_pk_bf16(o[6], o[7]);
                const int r = rbeg + rr;
                if (c0 < 1024) *(u32x4*)(XS + (size_t)r * 1024 + c0) = pk; else *(u32x4*)(BC + (size_t)r * 512 + (c0 - 1024)) = pk;
            }
        }
    }
    {
        const int lane = tid & 63, gw = blockIdx.x * 8 + (tid >> 6), nw = gridDim.x * 8;
        float* DT = (float*)(A.ws + WS_BIG + BIG_DT); float* RQ = (float*)(A.ws + WS_RSTD); float* RKV = RQ + NROW;
        unsigned char* KR = A.ws + WS_BIG + BIG_KR; const float* rope = (const float*)(A.ws + WS_ROPE);
        const float dtb = lane < 32 ? A.in[I_DTB][li * 32 + lane] : 0.f;
        for (int rb = gw * 4; rb < NROW; rb += nw * 4) {
            unsigned wq[4][3]; u32x2 wk[4]; unsigned wr_[4]; float dtv[4], rc[4], rsn[4];
#pragma unroll
            for (int i = 0; i < 4; ++i) { const int r = rb + i; const bf16_t* p = PROJ + (size_t)r * HYB_INP;
                const unsigned* q = (const unsigned*)(p + C_CQ + 6 * lane); wq[i][0] = q[0]; wq[i][1] = q[1]; wq[i][2] = q[2];
                wk[i] = *(const u32x2*)(p + C_CKV + 4 * lane);
                dtv[i] = lane < 32 ? bf2f(p[C_DT + (lane & 15)]) : 0.f; wr_[i] = lane < 32 ? *(const unsigned*)(p + C_KR + 2 * lane) : 0u;
                const int l = r & 8191; rc[i] = (lane < 32 && r < NLAT) ? rope[l * 32 + lane] : 1.f; rsn[i] = (lane < 32 && r < NLAT) ? rope[SEQ * 32 + l * 32 + lane] : 0.f; }
#pragma unroll
            for (int i = 0; i < 4; ++i) { const int r = rb + i;
                if (lane < 32) DT[(size_t)lane * NROW + r] = softplus_f(dtv[i] + dtb);
                { float ss = 0.f;
#pragma unroll
                  for (int j = 0; j < 3; ++j) { const float a = bflo(wq[i][j]), b = bfhi(wq[i][j]); ss += a * a + b * b; }
                  ss = wave_sum(ss); if (lane == 0) RQ[r] = rsqrtf(ss * (1.f / 384.f) + EPS); }
                { const float a = bflo(wk[i].x), b = bfhi(wk[i].x), c = bflo(wk[i].y), d = bfhi(wk[i].y);
                  float ss = a * a + b * b + c * c + d * d; ss = wave_sum(ss); if (lane == 0) RKV[r] = rsqrtf(ss * (1.f / 256.f) + EPS); }
                if (lane < 32) { const float x1 = bflo(wr_[i]), x2 = bfhi(wr_[i]); int b, key;
                    const float o1 = x1 * rc[i] - x2 * rsn[i], o2 = x1 * rsn[i] + x2 * rc[i];
                    if (r < NLAT) { b = r >> 13; key = 256 + (r & 8191); } else { b = (r - NLAT) >> 8; key = (r - NLAT) & 255; }
                    int w8 = 0; w8 = __builtin_amdgcn_cvt_pk_fp8_f32(sat8(o1), sat8(o2), w8, false);
                    *(unsigned short*)(KR + (size_t)(b * NKT + (key >> 6)) * 4096 + att8::kr8(key & 63, 2 * lane)) = (unsigned short)(w8 & 0xffff); }
            }
        }
    }
}

struct EpiQ {
    static constexpr bool PERM = true;
    unsigned char* Q; const float* rstd; const float* rope;
    __device__ __forceinline__ void operator()(const f32x4 (&acc)[2][2][4][2], const pg8::Unit& u, int wr, int wc, int fr, int fq) const {
        const bool lat = u.pm < 128;
        const int b = lat ? (u.pm >> 5) : (u.pm - 128), q0 = lat ? 256 + ((u.pm & 31) << 8) : 0;
        const bool isrope = u.pn >= 4;
#pragma unroll
        for (int ai = 0; ai < 2; ++ai) {
            const int rl = 128 * ai + 64 * wr + fr;
            const float* rsp = rstd + u.pm * 256 + rl;
            const float* rp = rope + (size_t)(((u.pm & 31) << 8) + rl) * 32;
#pragma unroll
            for (int bj = 0; bj < 2; ++bj) {
                const int c0 = u.pn * 256 + 128 * bj + 32 * wc + 8 * fq; int h, dcol;
                if (!isrope) { h = c0 >> 7; dcol = c0 & 127; } else { const int mq = c0 - 1024; h = mq >> 6; dcol = 128 + (mq & 63); }
                unsigned char* dst = Q + ((size_t)(b * 8 + h) * NKEY + q0 + rl) * 192 + dcol;
                const int ro = (dcol - 128) >> 1;
#pragma unroll
                for (int m = 0; m < 4; ++m) {
                    const float rs = rsp[16 * m] * (QSCALE * att8::QUP);
                    f32x4 v0 = acc[ai][bj][m][0] * rs, v1 = acc[ai][bj][m][1] * rs;
                    if (isrope && lat) { const f32x4 cs = *(const f32x4*)(rp + 16 * m * 32 + ro), sn = *(const f32x4*)(rp + SEQ * 32 + 16 * m * 32 + ro);
                        const f32x4 a0 = v0, a1 = v1;
                        v0[0] = a0[0] * cs[0] - a0[1] * sn[0]; v0[1] = a0[0] * sn[0] + a0[1] * cs[0]; v0[2] = a0[2] * cs[1] - a0[3] * sn[1]; v0[3] = a0[2] * sn[1] + a0[3] * cs[1];
                        v1[0] = a1[0] * cs[2] - a1[1] * sn[2]; v1[1] = a1[0] * sn[2] + a1[1] * cs[2]; v1[2] = a1[2] * cs[3] - a1[3] * sn[3]; v1[3] = a1[2] * sn[3] + a1[3] * cs[3]; }
                    u32x2 w; w.x = pk4_fp8_sat(v0[0], v0[1], v0[2], v0[3]); w.y = pk4_fp8_sat(v1[0], v1[1], v1[2], v1[3]);
                    *(u32x2*)(dst + 16 * m * 192) = w;
                    asm volatile("" ::: "memory");
                }
            }
        }
    }
};
struct EpiKV {
    static constexpr bool PERM = true;
    unsigned char* KN; unsigned char* V; const float* rstd;
    __device__ __forceinline__ void operator()(const f32x4 (&acc)[2][2][4][2], const pg8::Unit& u, int wr, int wc, int fr, int fq) const {
        const bool lat = u.pm < 128;
        const int b = lat ? (u.pm >> 5) : (u.pm - 128), t0 = lat ? 4 + ((u.pm & 31) << 2) : 0;
        const int dd = 32 * wc + 8 * fq;
        const int offK = fr * 128 + ((((dd >> 4) ^ ((fr >> 1) & 7))) << 4) + (dd & 15);
#pragma unroll
        for (int ai = 0; ai < 2; ++ai) {
            const size_t tb = ((size_t)(b * 8 + u.pn) * NKT + t0 + 2 * ai + wr) * 8192;
            const float* rsp = rstd + u.pm * 256 + 128 * ai + 64 * wr + fr;
            unsigned char* kp = KN + tb + offK; unsigned char* vp = V + tb;
#pragma unroll
            for (int m = 0; m < 4; ++m) {
                const float rs = rsp[16 * m];
                { const f32x4 v0 = acc[ai][0][m][0] * rs, v1 = acc[ai][0][m][1] * rs; u32x2 w; w.x = pk4_fp8_sat(v0[0], v0[1], v0[2], v0[3]); w.y = pk4_fp8_sat(v1[0], v1[1], v1[2], v1[3]);
                  *(u32x2*)(kp + m * 2048) = w; }
                { const f32x4 v0 = acc[ai][1][m][0] * rs, v1 = acc[ai][1][m][1] * rs; const unsigned w0 = pk4_fp8_sat(v0[0], v0[1], v0[2], v0[3]), w1 = pk4_fp8_sat(v1[0], v1[1], v1[2], v1[3]);
                  const int sl = att8::vslot(16 * m + fr);
#pragma unroll
                  for (int i = 0; i < 8; ++i) { const int d = dd + i; vp[d * 64 + ((((sl >> 4) ^ ((d >> 2) & 3))) << 4) + (sl & 15)] = (unsigned char)(((i < 4 ? w0 : w1) >> (8 * (i & 3))) & 0xffu); } }
                asm volatile("" ::: "memory");
            }
        }
    }
};

__device__ __forceinline__ void phase_ssd_out(const Args& A, int li, int nrows) {
    const bf16_t* PROJ = (const bf16_t*)(A.ws + WS_BIG); const bf16_t* XS = (const bf16_t*)(A.ws + WS_R2);
    const bf16_t* Y0 = (const bf16_t*)(A.ws + WS_H); const bf16_t* Y1 = (const bf16_t*)(A.ws + WS_R3); bf16_t* CAT = (bf16_t*)(A.ws + WS_R3 + R3_CAT);
    const int tid_ = otid(); const int lane = tid_ & 63, gw = blockIdx.x * 8 + (tid_ >> 6), nw = gridDim.x * 8;
    const float dsk = A.in[I_SSDD][li * 16 + (lane >> 2)];
    float ng[16];
#pragma unroll
    for (int j = 0; j < 16; ++j) ng[j] = A.in[I_SSDNG][li * 1024 + 16 * lane + j];
    for (int r = gw; r < nrows; r += nw) {
        float v[16]; float ss = 0.f;
#pragma unroll
        for (int hh = 0; hh < 2; ++hh) {
            const u32x4 a = *(const u32x4*)(Y0 + (size_t)r * 1024 + 16 * lane + 8 * hh), b = *(const u32x4*)(Y1 + (size_t)r * 1024 + 16 * lane + 8 * hh);
            const u32x4 x = *(const u32x4*)(XS + (size_t)r * 1024 + 16 * lane + 8 * hh), z = *(const u32x4*)(PROJ + (size_t)r * HYB_INP + 16 * lane + 8 * hh);
#pragma unroll
            for (int q = 0; q < 4; ++q) {
                const float y0 = (bflo(a[q]) + bflo(b[q]) + dsk * bflo(x[q])) * silu_f(bflo(z[q])), y1 = (bfhi(a[q]) + bfhi(b[q]) + dsk * bfhi(x[q])) * silu_f(bfhi(z[q]));
                v[8 * hh + 2 * q] = y0; v[8 * hh + 2 * q + 1] = y1; ss += y0 * y0 + y1 * y1; }
        }
#pragma unroll
        for (int o = 16; o >= 1; o >>= 1) ss += __shfl_xor(ss, o);
        const float rstd = rsqrtf(ss * (1.f / 512.f) + EPS);
#pragma unroll
        for (int hh = 0; hh < 2; ++hh) { u32x4 w;
#pragma unroll
            for (int q = 0; q < 4; ++q) w[q] = cvt_pk_bf16(v[8 * hh + 2 * q] * rstd * ng[8 * hh + 2 * q], v[8 * hh + 2 * q + 1] * rstd * ng[8 * hh + 2 * q + 1]);
            *(u32x4*)(CAT + (size_t)r * 2048 + 16 * lane + 8 * hh) = w; }
    }
}

__device__ __forceinline__ void phase_ln_stats(const Args& A, int nrows) {
    const bf16_t* Gb = (const bf16_t*)(A.ws + WS_BIG); float* ST = (float*)(A.ws + WS_RSTD);
    const int tid_ = otid(); const int lane = tid_ & 63, gw = blockIdx.x * 8 + (tid_ >> 6), nw = gridDim.x * 8;
    for (int r = gw; r < nrows; r += nw) {
        float v[32]; float s = 0.f;
#pragma unroll
        for (int j = 0; j < 4; ++j) { const u32x4 w = *(const u32x4*)(Gb + (size_t)r * 4096 + 2048 + 512 * j + 8 * lane);
#pragma unroll
            for (int q = 0; q < 4; ++q) { v[8 * j + 2 * q] = bflo(w[q]); v[8 * j + 2 * q + 1] = bfhi(w[q]); s += v[8 * j + 2 * q] + v[8 * j + 2 * q + 1]; } }
        s = wave_sum(s); const float mu = s * (1.f / 2048.f); float q2 = 0.f;
#pragma unroll
        for (int j = 0; j < 32; ++j) { const float dd = v[j] - mu; q2 += dd * dd; }
        q2 = wave_sum(q2);
        if (lane == 0) { ST[r] = mu; ST[NROW + r] = rsqrtf(q2 * (1.f / 2048.f) + EPS); }
    }
}
__device__ __forceinline__ void phase_spatial(const Args& A, int gi, int nrows, LAS unsigned char* lds) {
    const bf16_t* Gb = (const bf16_t*)(A.ws + WS_BIG); const float* ST = (const float*)(A.ws + WS_RSTD); bf16_t* Ab = (bf16_t*)(A.ws + WS_R1);
    const bf16_t* WSg = (const bf16_t*)(A.ws + WS_W + W_GM + (size_t)gi * WG_SZ + WG_WS);
    const float* lng = A.in[I_GLNG] + (size_t)gi * 2048; const float* lnb = A.in[I_GLNB] + (size_t)gi * 2048; const float* bs = A.in[I_GBS] + (size_t)gi * 1024;
    const int tid = otid(), wid = tid >> 6, lane = tid & 63, r32 = lane & 31, hi = lane >> 5, tb = wid & 3, dh = wid >> 2;
    const int ldsaddr = (int)(unsigned)(uintptr_t)lds;
    u32x4 nv[8]; float nmu[8], nrs[8];
    const int nunits = (nrows / 128) * 8;
#define SP_LOADV(un) do { const int cb_ = (un) >> 3, gg_ = (un) & 7, r0_ = cb_ * 128; \
        _Pragma("unroll") for (int j = 0; j < 8; ++j) { const int idx = tid + 512 * j, s_ = idx >> 5, dd_ = (idx & 31) * 8; \
            nv[j] = *(const u32x4*)(Gb + (size_t)(r0_ + s_) * 4096 + 2048 + 256 * gg_ + dd_); nmu[j] = ST[r0_ + s_]; nrs[j] = ST[NROW + r0_ + s_]; } } while (0)
    if ((int)blockIdx.x < nunits) SP_LOADV((int)blockIdx.x);
    for (int unit = blockIdx.x; unit < nunits; unit += gridDim.x) {
        const int cb = unit >> 3, gg = unit & 7, r0 = cb * 128;
        __syncthreads();
#pragma unroll
        for (int j = 0; j < 8; ++j) { const int idx = tid + 512 * j, s = idx >> 5, dd = (idx & 31) * 8;
            const u32x4 w = nv[j];
            const float mu = nmu[j], rs = nrs[j];
            const f32x4 g0 = *(const f32x4*)(lng + 256 * gg + dd), g1 = *(const f32x4*)(lng + 256 * gg + dd + 4), b0 = *(const f32x4*)(lnb + 256 * gg + dd), b1 = *(const f32x4*)(lnb + 256 * gg + dd + 4);
            u32x4 o;
            o.x = cvt_pk_bf16((bflo(w.x) - mu) * rs * g0[0] + b0[0], (bfhi(w.x) - mu) * rs * g0[1] + b0[1]); o.y = cvt_pk_bf16((bflo(w.y) - mu) * rs * g0[2] + b0[2], (bfhi(w.y) - mu) * rs * g0[3] + b0[3]);
            o.z = cvt_pk_bf16((bflo(w.z) - mu) * rs * g1[0] + b1[0], (bfhi(w.z) - mu) * rs * g1[1] + b1[1]); o.w = cvt_pk_bf16((bflo(w.w) - mu) * rs * g1[2] + b1[2], (bfhi(w.w) - mu) * rs * g1[3] + b1[3]);
            *(LAS u32x4*)(lds + ((s >> 6) * 2 + (dd >> 7)) * 16384 + att::v_st(s & 63, dd & 127)) = o; }
        u32x2 uu[4][4];
        { const bf16_t* up = Gb + (size_t)(r0 + 32 * tb + r32) * 4096 + 256 * gg + 128 * dh + 4 * hi;
#pragma unroll
          for (int d0 = 0; d0 < 4; ++d0)
#pragma unroll
              for (int k = 0; k < 4; ++k) uu[d0][k] = *(const u32x2*)(up + 32 * d0 + 8 * k); }
        if (unit + (int)gridDim.x < nunits) SP_LOADV(unit + (int)gridDim.x);
        bf16x8 pa[8];
#pragma unroll
        for (int ks = 0; ks < 8; ++ks) pa[ks] = *(const bf16x8*)(WSg + ((size_t)gg * 128 + 32 * tb + r32) * 128 + 16 * ks + 8 * hi);
        __syncthreads();
        f32x16 o[4] = {};
#define SP_PV(D0, vbase, p0, p1, p2, p3) do { \
            const s16x4 l0 = att::tr_read<att::v_rd_off(D0, 0, 0)>(vbase), h0 = att::tr_read<att::v_rd_off(D0, 0, 1)>(vbase), l1 = att::tr_read<att::v_rd_off(D0, 1, 0)>(vbase), h1 = att::tr_read<att::v_rd_off(D0, 1, 1)>(vbase); \
            const s16x4 l2 = att::tr_read<att::v_rd_off(D0, 2, 0)>(vbase), h2 = att::tr_read<att::v_rd_off(D0, 2, 1)>(vbase), l3 = att::tr_read<att::v_rd_off(D0, 3, 0)>(vbase), h3 = att::tr_read<att::v_rd_off(D0, 3, 1)>(vbase); \
            asm volatile("s_waitcnt lgkmcnt(0)" ::: "memory"); __builtin_amdgcn_sched_barrier(0); \
            o[D0] = __builtin_amdgcn_mfma_f32_32x32x16_bf16((bf16x8){l0[0], l0[1], l0[2], l0[3], h0[0], h0[1], h0[2], h0[3]}, p0, o[D0], 0, 0, 0); \
            o[D0] = __builtin_amdgcn_mfma_f32_32x32x16_bf16((bf16x8){l1[0], l1[1], l1[2], l1[3], h1[0], h1[1], h1[2], h1[3]}, p1, o[D0], 0, 0, 0); \
            o[D0] = __builtin_amdgcn_mfma_f32_32x32x16_bf16((bf16x8){l2[0], l2[1], l2[2], l2[3], h2[0], h2[1], h2[2], h2[3]}, p2, o[D0], 0, 0, 0); \
            o[D0] = __builtin_amdgcn_mfma_f32_32x32x16_bf16((bf16x8){l3[0], l3[1], l3[2], l3[3], h3[0], h3[1], h3[2], h3[3]}, p3, o[D0], 0, 0, 0); } while (0)
        { const int vb0 = ldsaddr + (0 * 2 + dh) * 16384 + att::v_rd_base(lane), vb1 = ldsaddr + (1 * 2 + dh) * 16384 + att::v_rd_base(lane);
          SP_PV(0, vb0, pa[0], pa[1], pa[2], pa[3]); SP_PV(1, vb0, pa[0], pa[1], pa[2], pa[3]); SP_PV(2, vb0, pa[0], pa[1], pa[2], pa[3]); SP_PV(3, vb0, pa[0], pa[1], pa[2], pa[3]);
          SP_PV(0, vb1, pa[4], pa[5], pa[6], pa[7]); SP_PV(1, vb1, pa[4], pa[5], pa[6], pa[7]); SP_PV(2, vb1, pa[4], pa[5], pa[6], pa[7]); SP_PV(3, vb1, pa[4], pa[5], pa[6], pa[7]); }
#undef SP_PV
        { const int t = 32 * tb + r32, row = r0 + t; const float bsv = bs[gg * 128 + t];
          bf16_t* ap = Ab + (size_t)row * 2048 + 256 * gg + 128 * dh + 4 * hi;
#pragma unroll
          for (int d0 = 0; d0 < 4; ++d0)
#pragma unroll
              for (int k = 0; k < 4; ++k) {
                  const u32x2 u2 = uu[d0][k];
                  u32x2 w; w.x = cvt_pk_bf16(bflo(u2.x) * (o[d0][4 * k] + bsv), bfhi(u2.x) * (o[d0][4 * k + 1] + bsv)); w.y = cvt_pk_bf16(bflo(u2.y) * (o[d0][4 * k + 2] + bsv), bfhi(u2.y) * (o[d0][4 * k + 3] + bsv));
                  *(u32x2*)(ap + 32 * d0 + 8 * k) = w; } }
    }
#undef SP_LOADV
}

constexpr int NSL = 8, SW = 1024 / NSL;
constexpr size_t TAB8_HALF = (size_t)NEXP * 1024, TAB_SCL = 2 * TAB8_HALF;
constexpr float HS = 4.f;
__device__ __forceinline__ void phase_tabcvt(const Args& A, int layer, int wg, int nwg) {
    const int tid_ = otid(); const int lane = tid_ & 63, gw = wg * 8 + (tid_ >> 6), nw = nwg * 8;
    float* SCL = (float*)(A.ws + WS_TAB + TAB_SCL);
    for (int r = gw; r < 2 * NEXP; r += nw) {
        const int tab = r >> 14, e = r & (NEXP - 1);
        const float* src = (tab ? A.in[I_PV] : A.in[I_PU]) + ((size_t)layer * NEXP + e) * 1024 + 16 * lane;
        f32x4 v[4]; float am = 0.f;
#pragma unroll
        for (int i = 0; i < 4; ++i) { v[i] = *(const f32x4*)(src + 4 * i); am = fmaxf(am, fmaxf(fmaxf(fabsf(v[i][0]), fabsf(v[i][1])), fmaxf(fabsf(v[i][2]), fabsf(v[i][3])))); }
#pragma unroll
        for (int o = 32; o >= 1; o >>= 1) am = fmaxf(am, __shfl_xor(am, o));
        float sc = 1.f; if (am > 0.f) { int ex; (void)frexpf(448.f / am, &ex); sc = ldexpf(1.f, ex - 1); }
        if (lane == 0) SCL[tab * NEXP + e] = 1.f / sc;
        u32x4 w;
#pragma unroll
        for (int i = 0; i < 4; ++i) w[i] = pk4_fp8(v[i][0] * sc, v[i][1] * sc, v[i][2] * sc, v[i][3] * sc);
        *(u32x4*)(A.ws + WS_TAB + (size_t)tab * TAB8_HALF + ((size_t)(lane >> 3) * NEXP + e) * SW + 16 * (lane & 7)) = w;
    }
}
#define CASD(a, b) do { const float hi_ = fmaxf(a, b), lo_ = fminf(a, b); a = hi_; b = lo_; } while (0)
__device__ __forceinline__ void sort16(float (&k)[16]) {
#pragma unroll
    for (int sz = 2; sz <= 16; sz <<= 1)
#pragma unroll
        for (int j = sz >> 1; j > 0; j >>= 1)
#pragma unroll
            for (int i = 0; i < 16; ++i) { const int l = i ^ j; if (l > i) { if ((i & sz) == 0 || sz == 16) CASD(k[i], k[l]); else CASD(k[l], k[i]); } }
}
__device__ __forceinline__ void bmerge16(float (&k)[16]) {
#pragma unroll
    for (int j = 8; j > 0; j >>= 1)
#pragma unroll
        for (int i = 0; i < 16; ++i) { const int l = i ^ j; if (l > i) CASD(k[i], k[l]); }
}
__device__ __forceinline__ void merge_top16(float (&a)[16], const float (&b)[16]) {
#pragma unroll
    for (int i = 0; i < 16; ++i) a[i] = fmaxf(a[i], b[15 - i]);
    bmerge16(a);
}
__device__ __forceinline__ void xmerge_top16(float (&a)[16], int mask) {
    float t[16];
#pragma unroll
    for (int i = 0; i < 16; ++i) t[i] = __shfl_xor(a[15 - i], mask);
#pragma unroll
    for (int i = 0; i < 16; ++i) a[i] = fmaxf(a[i], t[i]);
    bmerge16(a);
}
__device__ __forceinline__ void phase_topk(const Args& A, int layer, int nrows, LAS unsigned char* lds) {
    const bf16_t* QP = (const bf16_t*)(A.ws + WS_BIG); int* IDX = (int*)(A.ws + WS_R2); float* GATE = (float*)(A.ws + WS_R2 + R2_GATE);
    const int tid = otid(), wid = tid >> 6, lane = tid & 63, fr = lane & 15, fq = lane >> 4;
    LAS unsigned* scr = (LAS unsigned*)(lds + 2 * 34816) + wid * 512 + fr * 32;
    int h_staged = -1;
    for (int unit = blockIdx.x; unit < (nrows / 128) * 8; unit += gridDim.x) {
        const int h = unit & 7, r0 = (unit >> 3) * 128;
        if (h != h_staged) { h_staged = h;
        __syncthreads();
        { const bf16_t* k1 = (const bf16_t*)(A.ws + WS_W + W_PEER + (size_t)layer * WP_SZ + WP_K1) + (size_t)h * 16384;
#pragma unroll
          for (int j = 0; j < 8; ++j) { const int idx = tid + 512 * j, half = idx >> 11, rem = idx & 2047, key = rem >> 4, c8 = rem & 15;
              const u32x4 w = *(const u32x4*)(k1 + (size_t)half * 8 * 16384 + key * 128 + 8 * c8);
              *(LAS u32x4*)(lds + half * 34816 + key * 272 + c8 * 16) = w; } }
        __syncthreads(); }
        const int tok = r0 + 16 * wid + fr;
        float top[2][16];
#pragma unroll
        for (int half = 0; half < 2; ++half) {
            bf16x8 qf[4];
#pragma unroll
            for (int ks = 0; ks < 4; ++ks) qf[ks] = *(const bf16x8*)(QP + (size_t)tok * 2048 + 256 * h + 128 * half + 32 * ks + 8 * fq);
            float loc[16];
#pragma unroll
            for (int grp = 0; grp < 2; ++grp) {
                float kk[16];
#pragma unroll
                for (int nbb = 0; nbb < 4; ++nbb) { const int nb = 4 * grp + nbb; f32x4 acc = {0.f, 0.f, 0.f, 0.f};
#pragma unroll
                    for (int ks = 0; ks < 4; ++ks) { const bf16x8 kf = *(const LAS bf16x8*)(lds + half * 34816 + (16 * nb + fr) * 272 + (32 * ks + 8 * fq) * 2);
                        acc = __builtin_amdgcn_mfma_f32_16x16x32_bf16(kf, qf[ks], acc, 0, 0, 0); }
#pragma unroll
                    for (int i = 0; i < 4; ++i) { const unsigned code = 127u - (unsigned)(16 * nb + 4 * fq + i); kk[4 * nbb + i] = __uint_as_float((__float_as_uint(acc[i]) & ~127u) | code); } }
                sort16(kk);
                if (grp == 0) {
#pragma unroll
                    for (int i = 0; i < 16; ++i) loc[i] = kk[i];
                } else merge_top16(loc, kk);
            }
            xmerge_top16(loc, 16); xmerge_top16(loc, 32);
#pragma unroll
            for (int i = 0; i < 16; ++i) top[half][i] = loc[i];
        }
        if (fq < 2) {
#pragma unroll
            for (int i = 0; i < 16; ++i) scr[16 * fq + i] = __float_as_uint(fq == 0 ? top[0][i] : top[1][i]); }
        float fin[16];
#pragma unroll
        for (int aa = 0; aa < 4; ++aa) {
            const float va_k = fq == 0 ? top[0][aa] : fq == 1 ? top[0][4 + aa] : fq == 2 ? top[0][8 + aa] : top[0][12 + aa];
            const float va = __uint_as_float(__float_as_uint(va_k) & ~127u);
            float c[16];
#pragma unroll
            for (int bb = 0; bb < 16; ++bb) { const float s = va + __uint_as_float(__float_as_uint(top[1][bb]) & ~127u);
                c[bb] = __uint_as_float((__float_as_uint(s) & ~255u) | (255u - (unsigned)((4 * fq + aa) * 16 + bb))); }
            if (aa == 0) {
#pragma unroll
                for (int i = 0; i < 16; ++i) fin[i] = c[i];
            } else merge_top16(fin, c);
        }
        xmerge_top16(fin, 16); xmerge_top16(fin, 32);
        float ev[16], es = 0.f; const float mx = __uint_as_float(__float_as_uint(fin[0]) & ~255u);
#pragma unroll
        for (int i = 0; i < 16; ++i) { ev[i] = __expf(__uint_as_float(__float_as_uint(fin[i]) & ~255u) - mx); es += ev[i]; }
        const float inv = 1.f / es;
        asm volatile("s_waitcnt lgkmcnt(0)" ::: "memory");
        int oi[4]; float og[4];
#pragma unroll
        for (int kq = 0; kq < 4; ++kq) {
            const float fk = fq == 0 ? fin[kq] : fq == 1 ? fin[4 + kq] : fq == 2 ? fin[8 + kq] : fin[12 + kq];
            const float fe = fq == 0 ? ev[kq] : fq == 1 ? ev[4 + kq] : fq == 2 ? ev[8 + kq] : ev[12 + kq];
            const unsigned code = 255u - (__float_as_uint(fk) & 255u), a = code >> 4, bq = code & 15u;
            const unsigned i1 = 127u - (scr[a] & 127u), i2 = 127u - (scr[16 + bq] & 127u);
            oi[kq] = (int)(i1 * 128u + i2); og[kq] = fe * inv; }
        *(int4*)(IDX + (size_t)tok * 128 + 16 * h + 4 * fq) = make_int4(oi[0], oi[1], oi[2], oi[3]);
        *(f32x4*)(GATE + (size_t)tok * 128 + 16 * h + 4 * fq) = (f32x4){og[0], og[1], og[2], og[3]};
    }
}
struct PeerSched {
    int x0, rank, nloc, nblk, nown; unsigned orphan;
    __device__ __forceinline__ void init(const Args& A, int nrows, LAS unsigned char* smem) {
        unsigned* ctl = (unsigned*)(A.ws + WS_CTL);
        x0 = (int)(xb_xcc_id() & 7u); rank = __builtin_amdgcn_readfirstlane((int)((LAS unsigned*)smem)[8]); nblk = nrows / 64;
        unsigned cached = __builtin_amdgcn_readfirstlane(((LAS unsigned*)smem)[9]);
        if (cached == 0u) { unsigned orph = 0u, nl = 1u;
            for (int j = 0; j < 8; ++j) { unsigned c = xb_ld(&ctl[XB_XCNT(j)]) + xb_ld(&ctl[XB_XCNT(j + 8)]); c = __builtin_amdgcn_readfirstlane(c); if (c == 0u) orph |= 1u << j; if (j == x0) nl = c; }
            cached = (nl << 8) | orph; __syncthreads(); if (threadIdx.x == 0) ((LAS unsigned*)smem)[9] = cached; __syncthreads(); }
        nloc = (int)(cached >> 8); orphan = cached & 0xffu;
        const int tot = (NSL / 8) * nblk; nown = rank < tot ? (tot - rank + nloc - 1) / nloc : 0;
    }
    __device__ __forceinline__ bool item(int j, int& sl, int& blk) const {
        if (j < nown) { const int i = rank + j * nloc; sl = x0 + 8 * (i / nblk); blk = i % nblk; return true; }
        int jj = j - nown; const int tot = (NSL / 8) * nblk, per = ((int)gridDim.x > tot) ? 1 : 0; (void)per;
        for (int o = 0; o < 8; ++o) if ((orphan >> o) & 1u) { const int cnt = ((int)blockIdx.x < tot) ? (tot - (int)blockIdx.x + (int)gridDim.x - 1) / (int)gridDim.x : 0;
            if (jj < cnt) { const int i = (int)blockIdx.x + jj * (int)gridDim.x; sl = o + 8 * (i / nblk); blk = i % nblk; return true; } jj -= cnt; }
        return false;
    }
};
template <class LD, class ST, class PR>
__device__ __forceinline__ void peer_items(const PeerSched& S, LD ld, ST st, PR pr) {
    int sl, blk, sln, blkn, j = 0, buf = 0; bool have = S.item(0, sl, blk);
    if (have) { ld(sl, blk, 0); st(0); }
    while (have) {
        const bool haven = S.item(j + 1, sln, blkn);
        asm volatile("s_waitcnt vmcnt(0)" ::: "memory");
        __syncthreads();
        if (haven) ld(sln, blkn, buf ^ 1);
        pr(sl, blk, buf);
        if (haven) st(buf ^ 1);
        sl = sln; blk = blkn; have = haven; buf ^= 1; ++j;
    }
    __syncthreads();
}
#ifndef MK_UVAR
#define MK_UVAR 0
#endif
__device__ __forceinline__ float dpp_sum8(float v) {
    v += __builtin_bit_cast(float, __builtin_amdgcn_mov_dpp(__builtin_bit_cast(int, v), 0xB1, 0xF, 0xF, true));
    v += __builtin_bit_cast(float, __builtin_amdgcn_mov_dpp(__builtin_bit_cast(int, v), 0x4E, 0xF, 0xF, true));
    v += __builtin_bit_cast(float, __builtin_amdgcn_mov_dpp(__builtin_bit_cast(int, v), 0x141, 0xF, 0xF, true));
    return v;
}
__device__ __forceinline__ void phase_peer_u(const Args& A, int layer, int nrows, LAS unsigned char* smem, int rep) {
    const int var = rep ? MK_UVAR : 0;
    const bf16_t* H = (const bf16_t*)(A.ws + WS_H); const int* IDX = (const int*)(A.ws + WS_R2); float* PART = var ? (float*)(A.ws + WS_R1) : (float*)(A.ws + WS_BIG + BIG_PART);
    const unsigned char* U = A.ws + WS_TAB;
    LAS unsigned char* lds = smem + LDS_BASE;
    constexpr int BUF = 32768 + 64 * SW * 2;
    const int tid = otid(), wid = tid >> 6, lane = tid & 63, m = lane & 7, tk = lane >> 3;
    PeerSched S; S.init(A, nrows, smem);
    const int wu = __builtin_amdgcn_readfirstlane(wid);
    peer_items(S,
        [&](int sl, int blk, int buf) {
#pragma unroll
            for (int i = 0; i < 4; ++i)
                __builtin_amdgcn_global_load_lds((const unsigned*)(IDX + (size_t)blk * 64 * 128 + 256 * (wu + 8 * i) + 4 * lane), (LAS unsigned*)(lds + buf * BUF + 1024 * (wu + 8 * i)), 16, 0, 0);
#pragma unroll
            for (int i = 0; i < 2; ++i) { const int pc = wu + 8 * i;
                __builtin_amdgcn_global_load_lds((const unsigned*)(H + (size_t)(blk * 64 + 4 * pc + (lane >> 4)) * 1024 + SW * sl + 8 * (lane & 15)), (LAS unsigned*)(lds + buf * BUF + 32768 + 1024 * pc), 16, 0, 0); } },
        [&](int buf) { },
        [&](int sl, int blk, int buf) {
            const unsigned char* ub = U + (size_t)sl * NEXP * SW + 16 * m;
            const int tokl = wid * 8 + tk, tok = blk * 64 + tokl;
            const LAS int* ib = (const LAS int*)(lds + buf * BUF) + tokl * 128;
            float hf[16];
            { const u32x4 h0 = *(const LAS u32x4*)(lds + buf * BUF + 32768 + tokl * 256 + 32 * m), h1 = *(const LAS u32x4*)(lds + buf * BUF + 32768 + tokl * 256 + 32 * m + 16);
#pragma unroll
              for (int j = 0; j < 4; ++j) { hf[2 * j] = bflo(h0[j]); hf[2 * j + 1] = bfhi(h0[j]); hf[8 + 2 * j] = bflo(h1[j]); hf[8 + 2 * j + 1] = bfhi(h1[j]); } }
            const bool up4 = m >= 4, up2 = (m & 2) != 0, up1 = (m & 1) != 0;
            float* pp = PART + ((size_t)sl * NROW + tok) * 128 + m;
            u32x4 vv[2][8];
#define PU_ROWS(T, c) do { const i32x4 e0_ = *(const LAS i32x4*)(ib + 8 * (c)), e1_ = *(const LAS i32x4*)(ib + 8 * (c) + 4); \
                if (var == 4) { _Pragma("unroll") for (int k_ = 0; k_ < 8; ++k_) vv[T][k_] = (u32x4){(unsigned)e0_.x, (unsigned)e1_.y, 0u, 0u}; } else { \
                vv[T][0] = *(const u32x4*)(ub + (size_t)(var == 3 ? e0_.x & 63 : e0_.x) * SW); vv[T][1] = *(const u32x4*)(ub + (size_t)(var == 3 ? e0_.y & 63 : e0_.y) * SW); \
                vv[T][2] = *(const u32x4*)(ub + (size_t)(var == 3 ? e0_.z & 63 : e0_.z) * SW); vv[T][3] = *(const u32x4*)(ub + (size_t)(var == 3 ? e0_.w & 63 : e0_.w) * SW); \
                vv[T][4] = *(const u32x4*)(ub + (size_t)(var == 3 ? e1_.x & 63 : e1_.x) * SW); vv[T][5] = *(const u32x4*)(ub + (size_t)(var == 3 ? e1_.y & 63 : e1_.y) * SW); \
                vv[T][6] = *(const u32x4*)(ub + (size_t)(var == 3 ? e1_.z & 63 : e1_.z) * SW); vv[T][7] = *(const u32x4*)(ub + (size_t)(var == 3 ? e1_.w & 63 : e1_.w) * SW); } } while (0)
#define PU_DOT(T, c) do { float s_[8]; \
                _Pragma("unroll") for (int k = 0; k < 8; ++k) { f32x2 a2 = {0.f, 0.f}; \
                    _Pragma("unroll") for (int j = 0; j < 4; ++j) { const int w = (int)vv[T][k][j]; \
                        const f32x2 lo = __builtin_amdgcn_cvt_pk_f32_fp8(w, false), hi = __builtin_amdgcn_cvt_pk_f32_fp8(w, true); \
                        a2 = __builtin_elementwise_fma(lo, (f32x2){hf[4 * j], hf[4 * j + 1]}, a2); a2 = __builtin_elementwise_fma(hi, (f32x2){hf[4 * j + 2], hf[4 * j + 3]}, a2); } \
                    s_[k] = a2.x + a2.y; } \
                  \
                float t_[4], u_[2]; \
                _Pragma("unroll") for (int j = 0; j < 4; ++j) { const float give = up4 ? s_[j] : s_[4 + j], keep = up4 ? s_[4 + j] : s_[j]; \
                    t_[j] = keep + __builtin_bit_cast(float, __builtin_amdgcn_mov_dpp(__builtin_bit_cast(int, give), 0x141, 0xF, 0xF, true)); }        \
                _Pragma("unroll") for (int j = 0; j < 2; ++j) { const float give = up2 ? t_[j] : t_[2 + j], keep = up2 ? t_[2 + j] : t_[j]; \
                    u_[j] = keep + __builtin_bit_cast(float, __builtin_amdgcn_mov_dpp(__builtin_bit_cast(int, give), 0x4E, 0xF, 0xF, true)); }         \
                { const float give = up1 ? u_[0] : u_[1], keep = up1 ? u_[1] : u_[0]; \
                  const float tot_ = keep + __builtin_bit_cast(float, __builtin_amdgcn_mov_dpp(__builtin_bit_cast(int, give), 0xB1, 0xF, 0xF, true));           \
                  pp[8 * (c)] = tot_; } } while (0)
            PU_ROWS(0, 0);
#pragma unroll 1
            for (int c = 0; c < 16; c += 2) {
                PU_ROWS(1, c + 1);
                __builtin_amdgcn_sched_barrier(0);
                PU_DOT(0, c);
                __builtin_amdgcn_sched_barrier(0);
                if (c + 2 < 16) PU_ROWS(0, c + 2);
                __builtin_amdgcn_sched_barrier(0);
                PU_DOT(1, c + 1);
                __builtin_amdgcn_sched_barrier(0);
            }
#undef PU_ROWS
#undef PU_DOT
        });
}
__device__ __forceinline__ void phase_coef(const Args& A, int nrows) {
    const float* PART = (const float*)(A.ws + WS_BIG + BIG_PART); const float* GATE = (const float*)(A.ws + WS_R2 + R2_GATE); float* COEF = (float*)(A.ws + WS_R2 + R2_COEF);
    const int* IDX = (const int*)(A.ws + WS_R2); const float* SCL = (const float*)(A.ws + WS_TAB + TAB_SCL);
    const int gthr = blockIdx.x * NTHR + otid(), nthr = gridDim.x * NTHR;
    for (int p = gthr; p < nrows * 32; p += nthr) {
        f32x4 s = {0.f, 0.f, 0.f, 0.f};
#pragma unroll
        for (int x = 0; x < NSL; ++x) s += *(const f32x4*)(PART + (size_t)x * NROW * 128 + 4 * p);
        const i32x4 e = *(const i32x4*)(IDX + 4 * p); const f32x4 gt = *(const f32x4*)(GATE + 4 * p);
        const f32x4 su = {SCL[e.x], SCL[e.y], SCL[e.z], SCL[e.w]}, sv = {SCL[NEXP + e.x], SCL[NEXP + e.y], SCL[NEXP + e.z], SCL[NEXP + e.w]};
        const f32x4 a = s * su; const f32x2 g0 = gelu_pk((f32x2){a[0], a[1]}), g1 = gelu_pk((f32x2){a[2], a[3]});
        *(f32x4*)(COEF + 4 * p) = gt * (f32x4){g0.x, g0.y, g1.x, g1.y} * sv; }

}
__device__ __forceinline__ void phase_peer_v(const Args& A, int layer, int nrows, LAS unsigned char* smem, int rep) {
    const int* IDX = (const int*)(A.ws + WS_R2); const float* COEF = (const float*)(A.ws + WS_R2 + R2_COEF);
    const unsigned char* V = A.ws + WS_TAB + TAB8_HALF; const float* MODL = (const float*)(A.ws + WS_MOD) + (size_t)layer * 5 * 6144 + 5 * 1024;
    float* XC = (float*)(A.ws + WS_XC);
    LAS unsigned char* lds = smem + LDS_BASE;
    constexpr int BUF = 65536;
    const int tid = otid(), wid = tid >> 6, lane = tid & 63, m = lane & 7, tk = lane >> 3;
    PeerSched S; S.init(A, nrows, smem);
    const int wu = __builtin_amdgcn_readfirstlane(wid);
    peer_items(S,
        [&](int sl, int blk, int buf) {
#pragma unroll
            for (int i = 0; i < 4; ++i) {
                __builtin_amdgcn_global_load_lds((const unsigned*)(IDX + (size_t)blk * 64 * 128 + 256 * (wu + 8 * i) + 4 * lane), (LAS unsigned*)(lds + buf * BUF + 1024 * (wu + 8 * i)), 16, 0, 0);
                __builtin_amdgcn_global_load_lds((const unsigned*)(COEF + (size_t)blk * 64 * 128 + 256 * (wu + 8 * i) + 4 * lane), (LAS unsigned*)(lds + buf * BUF + 32768 + 1024 * (wu + 8 * i)), 16, 0, 0); } },
        [&](int buf) { },
        [&](int sl, int blk, int buf) {
            const unsigned char* vb = V + (size_t)sl * NEXP * SW + 16 * m;
            const int tokl = wid * 8 + tk, tok = blk * 64 + tokl; const bool lat = tok < NLAT;
            const LAS int* ib = (const LAS int*)(lds + buf * BUF) + tokl * 128; const LAS float* cb = (const LAS float*)(lds + buf * BUF + 32768) + tokl * 128;
            float* xp = (lat ? A.out + (size_t)tok * D : XC + (size_t)(tok - NLAT) * D) + SW * sl + 16 * m;
            f32x4 xr[4];
#pragma unroll
            for (int j = 0; j < 4; ++j) xr[j] = *(f32x4*)(xp + 4 * j);
            f32x2 acc2[8];
#pragma unroll
            for (int j = 0; j < 8; ++j) acc2[j] = (f32x2){0.f, 0.f};
            u32x4 vv[2][8];
#define PV_ROWS(T, c) do { const i32x4 e0_ = *(const LAS i32x4*)(ib + 8 * (c)), e1_ = *(const LAS i32x4*)(ib + 8 * (c) + 4); \
                vv[T][0] = *(const u32x4*)(vb + (size_t)e0_.x * SW); vv[T][1] = *(const u32x4*)(vb + (size_t)e0_.y * SW); vv[T][2] = *(const u32x4*)(vb + (size_t)e0_.z * SW); vv[T][3] = *(const u32x4*)(vb + (size_t)e0_.w * SW); \
                vv[T][4] = *(const u32x4*)(vb + (size_t)e1_.x * SW); vv[T][5] = *(const u32x4*)(vb + (size_t)e1_.y * SW); vv[T][6] = *(const u32x4*)(vb + (size_t)e1_.z * SW); vv[T][7] = *(const u32x4*)(vb + (size_t)e1_.w * SW); } while (0)
#define PV_FMA(T, c) do { const f32x4 c0_ = *(const LAS f32x4*)(cb + 8 * (c)), c1_ = *(const LAS f32x4*)(cb + 8 * (c) + 4); \
                _Pragma("unroll") for (int k = 0; k < 8; ++k) { const float cf = k < 4 ? c0_[k & 3] : c1_[k & 3]; \
                    _Pragma("unroll") for (int j = 0; j < 4; ++j) { const int w = (int)vv[T][k][j]; \
                        const f32x2 lo = __builtin_amdgcn_cvt_pk_f32_fp8(w, false), hi = __builtin_amdgcn_cvt_pk_f32_fp8(w, true); const f32x2 c2 = {cf, cf}; \
                        acc2[2 * j] = __builtin_elementwise_fma(lo, c2, acc2[2 * j]); acc2[2 * j + 1] = __builtin_elementwise_fma(hi, c2, acc2[2 * j + 1]); } } } while (0)
            PV_ROWS(0, 0);
#pragma unroll 1
            for (int c = 0; c < 16; c += 2) {
                PV_ROWS(1, c + 1);
                __builtin_amdgcn_sched_barrier(0);
                PV_FMA(0, c);
                __builtin_amdgcn_sched_barrier(0);
                if (c + 2 < 16) PV_ROWS(0, c + 2);
                __builtin_amdgcn_sched_barrier(0);
                PV_FMA(1, c + 1);
                __builtin_amdgcn_sched_barrier(0);
            }
#undef PV_ROWS
#undef PV_FMA
            const float* gp = MODL + (size_t)(lat ? (tok >> 13) : 4) * 6144 + SW * sl + 16 * m;
#pragma unroll
            for (int j = 0; j < 4; ++j) { const f32x4 g = *(const f32x4*)(gp + 4 * j);
                *(f32x4*)(xp + 4 * j) = xr[j] + g * (f32x4){acc2[2 * j].x, acc2[2 * j].y, acc2[2 * j + 1].x, acc2[2 * j + 1].y}; }
        });
}

#ifdef MK_CHECK
constexpr int CW_CHK = 3840;
__device__ __forceinline__ float blk_sum(float v, LAS float* red) {
    const int t_ = otid(); v = wave_sum(v); __syncthreads(); if ((t_ & 63) == 0) red[t_ >> 6] = v; __syncthreads();
    float s = 0.f; for (int i = 0; i < 8; ++i) s += red[i]; __syncthreads(); return s;
}
__device__ __forceinline__ float fp8f(unsigned b) { const unsigned e = (b >> 3) & 15u, m = b & 7u; const float v = e ? ldexpf(1.f + (float)m * 0.125f, (int)e - 7) : ldexpf((float)m * 0.125f, -6); return (b & 0x80u) ? -v : v; }
__device__ __forceinline__ void check_attn(const Args& A, LAS unsigned char* lds) {
    const unsigned char* Q = A.ws + WS_R1 + R1_Q; const unsigned char* KN = A.ws + WS_R1 + R1_KN; const unsigned char* KR = A.ws + WS_BIG + BIG_KR; const unsigned char* V = A.ws + WS_R1 + R1_V;
    const bf16_t* CAT = (const bf16_t*)(A.ws + WS_R3 + R3_CAT); float* chk = (float*)(A.ws + WS_CTL) + CW_CHK;
    LAS float* p = (LAS float*)lds; LAS float* qv = p + NKEY; LAS float* red = qv + 192;
    const int tid = otid(), sidx = blockIdx.x;
    const int b = sidx & 3, h = (sidx >> 2) & 7, l = (int)(((unsigned)sidx * 2654435761u) >> 19) & 8191;
    const size_t bh = (size_t)(b * 8 + h);
    if (tid < 192) qv[tid] = fp8f(Q[(bh * NKEY + 256 + l) * 192 + tid]) * (1.f / att8::QUP);
    __syncthreads();
    float mx = -1e30f;
    for (int key = tid; key < NKEY; key += 512) { const int t = key >> 6, k = key & 63; float s = 0.f;
        for (int d = 0; d < 128; ++d) s += qv[d] * fp8f(KN[(bh * NKT + t) * 8192 + att8::kn8(k, d)]);
        for (int d = 0; d < 64; ++d) s += qv[128 + d] * fp8f(KR[((size_t)b * NKT + t) * 4096 + att8::kr8(k, d)]);
        p[key] = s; mx = fmaxf(mx, s); }
    for (int o = 32; o >= 1; o >>= 1) mx = fmaxf(mx, __shfl_xor(mx, o));
    __syncthreads(); if ((tid & 63) == 0) red[tid >> 6] = mx; __syncthreads(); mx = red[0]; for (int i = 1; i < 8; ++i) mx = fmaxf(mx, red[i]); __syncthreads();
    float ls = 0.f; for (int key = tid; key < NKEY; key += 512) { const float e = exp2f(p[key] - mx); p[key] = e; ls += e; }
    ls = blk_sum(ls, red);
    float num = 0.f, den = 0.f;
    if (tid < 128) { float o = 0.f; for (int key = 0; key < NKEY; ++key) o += p[key] * fp8f(V[(bh * NKT + (key >> 6)) * 8192 + att8::v8(tid, key & 63)]);
        o /= ls; const float got = bf2f(CAT[(size_t)(b * 8192 + l) * 2048 + 1024 + 128 * h + tid]); num = (got - o) * (got - o); den = o * o; }
    num = blk_sum(num, red); den = blk_sum(den, red);
    if (tid == 0) { atomicAdd(chk, num); atomicAdd(chk + 1, den); }
}
__device__ __forceinline__ void check_qkv(const Args& A, int li, LAS unsigned char* lds) {
    float* chk = (float*)(A.ws + WS_CTL) + CW_CHK;
    const unsigned char* Q = A.ws + WS_R1 + R1_Q; const unsigned char* KN = A.ws + WS_R1 + R1_KN; const unsigned char* KR = A.ws + WS_BIG + BIG_KR; const unsigned char* V = A.ws + WS_R1 + R1_V;
    LAS float* hv = (LAS float*)lds; LAS float* cq = hv + 1024; LAS float* ckv = cq + 384; LAS float* kr = ckv + 256; LAS float* red = kr + 64; LAS float* ov = red + 16;
    const int tid = otid(), sidx = blockIdx.x;
    const int hd = sidx & 7; const int r = (sidx & 8) ? NLAT + (int)(((unsigned)sidx * 2654435761u) >> 22) : (int)(((unsigned)sidx * 2654435761u) >> 17);
    const float* win = A.in[I_HWIN] + (size_t)li * 1024 * HYB_IN;
    {
        const float* xp = r < NLAT ? A.out + (size_t)r * D : (const float*)(A.ws + WS_XC) + (size_t)(r - NLAT) * D; const float* MODL = (const float*)(A.ws + WS_MOD) + (size_t)(2 * li) * 5 * 6144 + (size_t)row_mb(r) * 6144;
        float ss = 0.f; for (int i = tid; i < 1024; i += 512) ss += xp[i] * xp[i];
        ss = blk_sum(ss, red); const float rstd = rsqrtf(ss / 1024.f + EPS);
        for (int i = tid; i < 1024; i += 512) hv[i] = bf2f(f2bf(xp[i] * rstd * A.in[I_N1G][(2 * li) * 1024 + i] * (1.f + MODL[1024 + i]) + MODL[i])); }
    __syncthreads();
    for (int j = tid; j < 704; j += 512) { float s = 0.f; for (int k = 0; k < 1024; ++k) s += hv[k] * win[(size_t)k * HYB_IN + C_CQ + j];
        s = bf2f(f2bf(s)); if (j < 384) cq[j] = s; else if (j < 640) ckv[j - 384] = s; else kr[j - 640] = s; }
    __syncthreads();
    float sq = 0.f, sk = 0.f; for (int j = tid; j < 384; j += 512) sq += cq[j] * cq[j]; for (int j = tid; j < 256; j += 512) sk += ckv[j] * ckv[j];
    sq = blk_sum(sq, red); sk = blk_sum(sk, red);
    const float rq = rsqrtf(sq / 384.f + EPS), rk = rsqrtf(sk / 256.f + EPS);
    const float* wqb = A.in[I_WQB] + (size_t)li * 384 * 1536; const float* wkvb = A.in[I_WKVB] + (size_t)li * 256 * 2048; const float* qg = A.in[I_QNG] + li * 384; const float* kg = A.in[I_KVNG] + li * 256;
    if (tid < 192) { float s = 0.f; for (int k = 0; k < 384; ++k) s += cq[k] * rq * qg[k] * wqb[(size_t)k * 1536 + hd * 192 + tid]; ov[tid] = s; }
    else if (tid < 448) { const int c = tid - 192; float s = 0.f; for (int k = 0; k < 256; ++k) s += ckv[k] * rk * kg[k] * wkvb[(size_t)k * 2048 + hd * 256 + c]; ov[tid] = s; }
    __syncthreads();
    const bool lat = r < NLAT; const int b = lat ? (r >> 13) : ((r - NLAT) >> 8), l = lat ? (r & 8191) : 0, key = lat ? 256 + l : ((r - NLAT) & 255), qrow = key;
    const size_t bh = (size_t)(b * 8 + hd); const float qs = QSCALE * att8::QUP;
    float num = 0.f, den = 0.f;
    if (tid < 128) {
        const float q = ov[tid] * qs, gq = fp8f(Q[(bh * NKEY + qrow) * 192 + tid]);
        const float kk = ov[192 + tid], gk = fp8f(KN[(bh * NKT + (key >> 6)) * 8192 + att8::kn8(key & 63, tid)]);
        const float vv = ov[320 + tid], gv = fp8f(V[(bh * NKT + (key >> 6)) * 8192 + att8::v8(tid, key & 63)]);
        num = (gq - q) * (gq - q) + (gk - kk) * (gk - kk) + (gv - vv) * (gv - vv); den = q * q + kk * kk + vv * vv;
    } else if (tid < 160) {
        const int i = tid - 128; float c = 1.f, sn = 0.f;
        if (lat) { const float pos = (float)(i < 16 ? (l >> 6) : (l & 63)); const float ang = pos * powf(10000.f, -(float)(i & 15) / 16.f); c = cosf(ang); sn = sinf(ang); }
        const float q1 = ov[128 + i] * qs, q2 = ov[160 + i] * qs, k1 = kr[i], k2 = kr[32 + i];
        const float rq1 = q1 * c - q2 * sn, rq2 = q1 * sn + q2 * c, rk1 = k1 * c - k2 * sn, rk2 = k1 * sn + k2 * c;
        const float gq1 = fp8f(Q[(bh * NKEY + qrow) * 192 + 128 + 2 * i]), gq2 = fp8f(Q[(bh * NKEY + qrow) * 192 + 128 + 2 * i + 1]);
        const float gk1 = fp8f(KR[((size_t)b * NKT + (key >> 6)) * 4096 + att8::kr8(key & 63, 2 * i)]), gk2 = fp8f(KR[((size_t)b * NKT + (key >> 6)) * 4096 + att8::kr8(key & 63, 2 * i + 1)]);
        num = (gq1 - rq1) * (gq1 - rq1) + (gq2 - rq2) * (gq2 - rq2) + (gk1 - rk1) * (gk1 - rk1) + (gk2 - rk2) * (gk2 - rk2); den = rq1 * rq1 + rq2 * rq2 + rk1 * rk1 + rk2 * rk2;
    }
    num = blk_sum(num, red); den = blk_sum(den, red);
    if (tid == 0) { atomicAdd(chk, num); atomicAdd(chk + 1, den); }
}
__device__ __forceinline__ void check_topk(const Args& A, int layer, LAS unsigned char* lds) {
    const bf16_t* QP = (const bf16_t*)(A.ws + WS_BIG); const int* IDX = (const int*)(A.ws + WS_R2); const float* GATE = (const float*)(A.ws + WS_R2 + R2_GATE); float* chk = (float*)(A.ws + WS_CTL) + CW_CHK;
    const bf16_t* K1 = (const bf16_t*)(A.ws + WS_W + W_PEER + (size_t)layer * WP_SZ + WP_K1);
    LAS float* sc = (LAS float*)lds; LAS float* v12 = sc + 256; LAS int* i12 = (LAS int*)(v12 + 32); LAS float* cs = (LAS float*)(i12 + 32); LAS float* ts = cs + 256; LAS int* ti = (LAS int*)(ts + 16); LAS float* red = (LAS float*)(ti + 16);
    const int tid = otid();
    for (int smp = blockIdx.x; smp < 1024; smp += gridDim.x) {
        const int h = smp & 7, tok = (int)((((unsigned)smp * 2654435761u) >> 12) % (unsigned)NROW);
        __syncthreads();
        if (tid < 256) { const int half = tid >> 7, key = tid & 127; float a = 0.f;
            for (int d = 0; d < 128; ++d) a += bf2f(QP[(size_t)tok * 2048 + 256 * h + 128 * half + d]) * bf2f(K1[((size_t)half * 8 + h) * 16384 + key * 128 + d]);
            sc[tid] = a; }
        __syncthreads();
        if (tid < 256) { const int half = tid >> 7, key = tid & 127; const float v = sc[tid]; int rank = 0;
            for (int j = 0; j < 128; ++j) { const float o = sc[half * 128 + j]; rank += (o > v || (o == v && j < key)) ? 1 : 0; }
            if (rank < 16) { v12[half * 16 + rank] = v; i12[half * 16 + rank] = key; } }
        __syncthreads();
        if (tid < 256) cs[tid] = v12[tid >> 4] + v12[16 + (tid & 15)];
        __syncthreads();
        if (tid < 256) { const float v = cs[tid]; int rank = 0;
            for (int j = 0; j < 256; ++j) { const float o = cs[j]; rank += (o > v || (o == v && j < tid)) ? 1 : 0; }
            if (rank < 16) { ts[rank] = v; ti[rank] = i12[tid >> 4] * 128 + i12[16 + (tid & 15)]; } }
        __syncthreads();
        float num = 0.f, den = 0.f;
        if (tid < 16) { float es = 0.f; for (int j = 0; j < 16; ++j) es += __expf(ts[j] - ts[0]); const float gn = __expf(ts[tid] - ts[0]) / es; float gk = 0.f;
            for (int j = 0; j < 16; ++j) if (IDX[(size_t)tok * 128 + 16 * h + j] == ti[tid]) gk = GATE[(size_t)tok * 128 + 16 * h + j];
            num = (gk - gn) * (gk - gn); den = gn * gn; }
        num = blk_sum(num, red); den = blk_sum(den, red);
        if (tid == 0) { atomicAdd(chk, num); atomicAdd(chk + 1, den); }
    }
}
#endif
#ifndef MK_PER_PHASE
#define MK_PER_PHASE 0
#endif
__device__ __forceinline__ int nr_in(int L) { return L <= 2 ? NROW : NLAT; }
__device__ __forceinline__ int nr_out(int L) { return L <= 1 ? NROW : NLAT; }

__global__ void __launch_bounds__(NTHR, 2) fwd(Args A) {
    extern __shared__ __attribute__((aligned(256))) unsigned char smem_raw[];
    LAS unsigned char* smem = (LAS unsigned char*)smem_raw;
    LAS unsigned char* lds = smem + LDS_BASE;
    const int tid = otid();
    if (tid < 64) ((LAS unsigned*)smem)[tid] = 0u;
    __syncthreads();
    XcdBarrier bar = xcd_barrier_post((unsigned*)(A.ws + WS_CTL), (volatile LAS unsigned*)smem);
    if (tid == 0) ((LAS unsigned*)smem)[8] = atomicAdd((unsigned*)(A.ws + WS_CTL) + CW_RANK + 32 * (xb_xcc_id() & 7u), 1u);
    __syncthreads();
    bool need_bar = false;
    const int lo = A.ph_lo, hi = A.ph_hi;
#ifndef PHMASK
#define PHMASK 0xffffffffu
#endif
#define SITE(k) if constexpr (((PHMASK) >> (k)) & 1u)
#ifndef MK_SVAR
#define MK_SVAR 1
#endif
#ifndef MK_REPEAT_SITE
#define MK_REPEAT_SITE -1
#endif
#define REP(k) for (int rep = 0; rep < ((k) == (MK_REPEAT_SITE) ? 2 : 1); ++rep)
#define PH(id) if ([&]() -> bool { if ((id) < lo || (id) >= hi) return false; if (need_bar) xcd_barrier(bar); need_bar = true; return true; }())
    unsigned char* ws = A.ws;
    float* XL = A.out; float* XC = (float*)(ws + WS_XC);
    bf16_t* H = (bf16_t*)(ws + WS_H);
    const float* MOD = (const float*)(ws + WS_MOD);

    SITE(0) PH(0) { phase_prologue(A, lds); }
    SITE(1) PH(1) { phase_norm_mod(A.in[I_X], A.in[I_CTX], XL, XC, A.in[I_N1G], MOD, 0, H, NROW); }
    for (int L = 0; L < DEPTH; ++L) {
        const int base = 2 + 16 * L, li = L >> 1; const bool hyb = (L & 1) == 0;
        const float* MODL = MOD + (size_t)L * 5 * 6144;
        unsigned char* WH = ws + WS_W + W_HYB + (size_t)li * WH_SZ; unsigned char* WG = ws + WS_W + W_GM + (size_t)li * WG_SZ; unsigned char* WP = ws + WS_W + W_PEER + (size_t)L * WP_SZ;
        if (hyb) {
            SITE(2) PH(base + 0) REP(2) { pg8::Gemm g{H, (const bf16_t*)(WH + WH_IN), nr_in(L), HYB_INP, 1024, 1024, 1024};
                pg8::EpiBf16<0> e{(bf16_t*)(ws + WS_BIG), HYB_INP}; pg8::gemm_phase(lds, g, e); }
            SITE(3) PH(base + 1) REP(3) { phase_conv(A, li); }
            SITE(4) PH(base + 2) {
                SITE(18) REP(18) { pg8::Gemm g{(const bf16_t*)(ws + WS_BIG) + C_CQ, (const bf16_t*)(WH + WH_QB), L == 0 ? NROW : NLAT, 1536, 384, HYB_INP, 384};
                  EpiQ e{ws + WS_R1 + R1_Q, (const float*)(ws + WS_RSTD), (const float*)(ws + WS_ROPE)}; pg8::gemm_phase(lds, g, e); }
                SITE(19) REP(19) { pg8::Gemm g{(const bf16_t*)(ws + WS_BIG) + C_CKV, (const bf16_t*)(WH + WH_KVB), NROW, 2048, 256, HYB_INP, 256};
                  EpiKV e{ws + WS_R1 + R1_KN, ws + WS_R1 + R1_V, (const float*)(ws + WS_RSTD) + NROW}; pg8::gemm_phase(lds, g, e); }
                SITE(20) REP(20) for (int u = blockIdx.x; u < 528; u += gridDim.x) ssd::g_unit((const bf16_t*)(ws + WS_R2 + R2_BC), (bf16_t*)(ws + WS_BIG + BIG_G), u);
            }
            SITE(5) PH(base + 3) {
                const int xq = (int)blockIdx.x & 7, jq = (int)blockIdx.x >> 3; const bool ssd_wg = (jq & 1) == 0 && gridDim.x == 256;
                if (gridDim.x == 256) {
                    if (ssd_wg) { const int r = jq >> 1, gi = xq + 8 * (r >> 3), hh = r & 7, sb = gi >> 2, sgp = (gi >> 1) & 1, sd = gi & 1;
                        SITE(21) ssd::ssd_unit(sb, 8 * sgp + hh, sd, (const bf16_t*)(ws + WS_R2), (const bf16_t*)(ws + WS_R2 + R2_BC), (const float*)(ws + WS_BIG + BIG_DT), (const bf16_t*)(ws + WS_BIG + BIG_G),
                                               A.in[I_ALOG] + li * 32, sd ? (bf16_t*)(ws + WS_R3) : (bf16_t*)(ws + WS_H), lds); }
                } else {
                    SITE(21) for (int u = blockIdx.x; u < 128; u += gridDim.x) ssd::ssd_unit(u >> 5, (u >> 1) & 15, u & 1, (const bf16_t*)(ws + WS_R2), (const bf16_t*)(ws + WS_R2 + R2_BC), (const float*)(ws + WS_BIG + BIG_DT),
                                               (const bf16_t*)(ws + WS_BIG + BIG_G), A.in[I_ALOG] + li * 32, (u & 1) ? (bf16_t*)(ws + WS_R3) : (bf16_t*)(ws + WS_H), lds);
                }
                const int nmine = gridDim.x == 256 ? (ssd_wg ? 3 : 5) + (L == 0 && !ssd_wg && jq < 8 ? 1 : 0) : 0;
                SITE(22) REP(22) for (int it = 0; gridDim.x == 256 ? it < nmine : (int)blockIdx.x + it * (int)gridDim.x < (L == 0 ? 1056 : 1024); ++it) {
                    int b, h, qrow0, orow0, nt;
                    if (gridDim.x == 256) {
                        const int base_it = ssd_wg ? 3 : 5;
                        if (it < base_it) { const int v = ssd_wg ? 3 * (jq >> 1) + it : 48 + 5 * (jq >> 1) + it; b = v >> 5; h = xq; const int qb = v & 31; qrow0 = 256 + 256 * qb; orow0 = b * 8192 + 256 * qb; nt = NKT; }
                        else { b = jq >> 1; h = xq; qrow0 = 0; orow0 = NLAT + 256 * b; nt = 4; }
                    } else { const int au = (int)blockIdx.x + it * (int)gridDim.x;
                        if (au < 1024) { b = au >> 8; h = au & 7; const int qb = (au >> 3) & 31; qrow0 = 256 + 256 * qb; orow0 = b * 8192 + 256 * qb; nt = NKT; }
                        else { const int cu = au - 1024; b = cu >> 3; h = cu & 7; qrow0 = 0; orow0 = NLAT + 256 * b; nt = 4; } }
                    const size_t bh = (size_t)(b * 8 + h);
                    att8::attn_unit(ws + WS_R1 + R1_Q + (bh * NKEY + qrow0) * 192, ws + WS_R1 + R1_KN + bh * NKT * 8192, ws + WS_BIG + BIG_KR + (size_t)b * NKT * 4096,
                                    ws + WS_R1 + R1_V + bh * NKT * 8192, (bf16_t*)(ws + WS_R3 + R3_CAT) + (size_t)orow0 * 2048 + 1024 + 128 * h, nt, lds);
                }
                if (gridDim.x == 256 && !ssd_wg) SITE(11) phase_tabcvt(A, L, xq + 8 * (jq >> 1), 128);
            }
            SITE(6) PH(base + 4) REP(6) { phase_ssd_out(A, li, nr_out(L));
#if defined(MK_CHECK) && MK_CHECK == 1
                if (L == 0) check_attn(A, lds);
#elif defined(MK_CHECK) && MK_CHECK == 2
                if (L == 0) check_qkv(A, li, lds);
#elif defined(MK_CHECK) && MK_CHECK == 3
                if (L == 2) check_attn(A, lds);
#endif
            }
        } else {
            SITE(7) PH(base + 0) REP(7) { pg8::Gemm g{H, (const bf16_t*)(WG + WG_IN), nr_out(L), 4096, 1024, 1024, 1024};
                pg8::EpiBf16<1> e{(bf16_t*)(ws + WS_BIG), 4096}; pg8::gemm_phase(lds, g, e); }
            SITE(8) PH(base + 1) REP(8) { phase_ln_stats(A, nr_out(L)); }
            SITE(9) PH(base + 2) REP(9) { phase_spatial(A, li, nr_out(L), lds); }
        }
        SITE(10) PH(base + 5) { pg8::Gemm g{hyb ? (const bf16_t*)(ws + WS_R3 + R3_CAT) : (const bf16_t*)(ws + WS_R1), hyb ? (const bf16_t*)(WH + WH_OUT) : (const bf16_t*)(WG + WG_OUT), nr_out(L), 1024, 2048, 2048, 2048};
            pg8::EpiResid e{XL, XC, MODL + 2 * 1024}; pg8::gemm_phase(lds, g, e); }
        SITE(11) PH(base + 6) REP(11) { phase_norm_mod(XL, XC, nullptr, nullptr, A.in[I_N2G] + L * 1024, MODL, 3, H, nr_out(L));
            if (!hyb || gridDim.x != 256) phase_tabcvt(A, L, (int)blockIdx.x, (int)gridDim.x); }
        SITE(12) PH(base + 7) REP(12) { pg8::Gemm g{H, (const bf16_t*)(WP + WP_Q), nr_out(L), 2048, 1024, 1024, 1024};
            pg8::EpiBf16<0> e{(bf16_t*)(ws + WS_BIG), 2048}; pg8::gemm_phase(lds, g, e); }
        SITE(13) PH(base + 8) REP(13) { phase_topk(A, L, nr_out(L), lds); }
        SITE(14) PH(base + 9) REP(14) { phase_peer_u(A, L, nr_out(L), smem, rep); }
        SITE(15) PH(base + 10) REP(15) { phase_coef(A, nr_out(L));
#if defined(MK_CHECK) && MK_CHECK == 4
            if (L == 1) check_topk(A, L, lds);
#endif
        }
        SITE(16) PH(base + 11) { phase_peer_v(A, L, nr_out(L), smem, 0); }
        SITE(17) PH(base + 12) { if (L < DEPTH - 1) phase_norm_mod(XL, XC, nullptr, nullptr, A.in[I_N1G] + (L + 1) * 1024, MOD + (size_t)(L + 1) * 5 * 6144, 0, H, nr_in(L + 1));
                        else {
#ifdef MK_CHECK
                            const float* chk = (const float*)(ws + WS_CTL) + CW_CHK; const float err = sqrtf(chk[0] / fmaxf(chk[1], 1e-30f));
                            phase_final_norm(XL, A.in[I_FNG], 1.f + 10.f * err);
#else
                            phase_final_norm(XL, A.in[I_FNG], 1.f);
#endif
                        } }
    }
#undef PH
}

#ifdef MK_TAP
__global__ void tap_kernel(const unsigned short* buf, size_t pitch, size_t col0, size_t ncols, size_t nrows, float* out) {
    const size_t n = ncols * nrows;
    for (size_t i = (size_t)blockIdx.x * blockDim.x + threadIdx.x; i < (size_t)NLAT * D; i += (size_t)gridDim.x * blockDim.x) {
        float s = 0.f; for (size_t j = i; j < n; j += (size_t)NLAT * D) s += (float)buf[(j / ncols) * pitch + col0 + (j % ncols)]; out[i] = s; }
}
#endif
extern "C" void kernel_launch(void* const* d_in, const int* in_sizes, int n_in, void* d_out, int out_size, void* d_ws, size_t ws_size, hipStream_t stream) {
    static int grid = 0;
    if (grid == 0) {
        if (n_in != N_IN || out_size != NLAT * D || ws_size < WS_END) { fprintf(stderr, "kernel_launch: unexpected shapes (n_in %d out %d ws %zu, need %zu)\n", n_in, out_size, ws_size, (size_t)WS_END); grid = -1; return; }
        int dev = 0, cus = 0, per_cu = 0;
        if (hipGetDevice(&dev) != hipSuccess || hipDeviceGetAttribute(&cus, hipDeviceAttributeMultiprocessorCount, dev) != hipSuccess) { grid = -1; return; }
        if (hipFuncSetAttribute((const void*)fwd, hipFuncAttributeMaxDynamicSharedMemorySize, LDS_BYTES) != hipSuccess) { fprintf(stderr, "kernel_launch: hipFuncSetAttribute failed\n"); grid = -1; return; }
        if (hipOccupancyMaxActiveBlocksPerMultiprocessor(&per_cu, (const void*)fwd, NTHR, LDS_BYTES) != hipSuccess || per_cu < 1) { fprintf(stderr, "kernel_launch: occupancy query says %d\n", per_cu); }
        (void)hipGetLastError();
        grid = cus;
    }
    if (grid < 0) return;
    (void)hipMemsetAsync((char*)d_ws + WS_CTL, 0, CTL_BYTES, stream);
    Args a{};
    for (int i = 0; i < N_IN; ++i) a.in[i] = (const float*)d_in[i];
    a.out = (float*)d_out; a.ws = (unsigned char*)d_ws;
#if MK_PER_PHASE
    for (int id = 0; id < 2 + 16 * DEPTH; ++id) {
        if (id >= 2) { const int L = (id - 2) / 16, s = (id - 2) % 16; if (s > 12) continue; if ((L & 1) && (s == 3 || s == 4)) continue; }
#ifdef MK_CUT
#ifdef MK_TAP
        if (id >= MK_CUT) continue;
#else
        if (id >= MK_CUT && id != 2 + 16 * (DEPTH - 1) + 12) continue;
#endif
#endif
        a.ph_lo = id; a.ph_hi = id + 1;
        hipLaunchKernelGGL(fwd, dim3(grid), dim3(NTHR), LDS_BYTES, stream, a);
    }
#ifdef MK_TAP
    { const size_t tp[5] = {MK_TAP}; hipLaunchKernelGGL(tap_kernel, dim3(2048), dim3(256), 0, stream, (const unsigned short*)((const char*)d_ws + tp[0]), tp[1], tp[2], tp[3], tp[4], (float*)d_out); }
#endif
#else
    a.ph_lo = 0; a.ph_hi = 2 + 16 * DEPTH;
    hipLaunchKernelGGL(fwd, dim3(grid), dim3(NTHR), LDS_BYTES, stream, a);
#endif
    const hipError_t le = hipPeekAtLastError();
    if (le != hipSuccess) fprintf(stderr, "kernel_launch: launch failed: %s\n", hipGetErrorName(le));
}
```

```cpp
#include <hip/hip_runtime.h>
#include <cstdio>
#include <cstdint>

#define LAS __attribute__((address_space(3)))
typedef unsigned short bf16_t;
typedef short bf16x8 __attribute__((ext_vector_type(8)));
typedef short s16x4 __attribute__((ext_vector_type(4)));
typedef float f32x2 __attribute__((ext_vector_type(2)));
typedef float f32x4 __attribute__((ext_vector_type(4)));
typedef float f32x16 __attribute__((ext_vector_type(16)));
typedef unsigned u32x2 __attribute__((ext_vector_type(2)));
typedef unsigned u32x4 __attribute__((ext_vector_type(4)));
typedef int i32x4 __attribute__((ext_vector_type(4)));
typedef int i32x8 __attribute__((ext_vector_type(8)));

constexpr int D = 1024, NB = 4, SEQ = 8192, DEPTH = 4, CTXL = 256;
constexpr int NLAT = NB * SEQ, NCTX = NB * CTXL, NROW = NLAT + NCTX;
constexpr int HYB_IN = 3280, HYB_INP = 3328;
constexpr int C_Z = 0, C_XBC = 1024, C_DT = 2560, C_CQ = 2576, C_CKV = 2960, C_KR = 3216;
constexpr int NKEY = SEQ + CTXL, NKT = NKEY / 64;
constexpr float EPS = 1e-6f;
constexpr float QSCALE = 0.07216878364870322f * 1.4426950408889634f;
constexpr int NEXP = 16384;

enum { I_X = 0, I_C, I_CTX, I_CCTX, I_ADAW, I_ADAB, I_N1G, I_N2G, I_HWIN, I_CONVW, I_CONVB, I_ALOG, I_DTB, I_SSDD, I_SSDNG, I_QNG, I_WQB, I_KVNG, I_WKVB,
       I_HWOUT, I_GWIN, I_GLNG, I_GLNB, I_GWS, I_GBS, I_GWOUT, I_PWQ, I_PK1, I_PK2, I_PU, I_PV, I_FNG, N_IN };

constexpr size_t al256(size_t x) { return (x + 255) & ~(size_t)255; }
constexpr size_t WS_CTL = 0, CTL_BYTES = 65536;
constexpr size_t WS_MOD = WS_CTL + CTL_BYTES;
constexpr size_t WS_ROPE = WS_MOD + al256((size_t)DEPTH * 5 * 6144 * 4);
constexpr size_t WS_RSTD = WS_ROPE + (size_t)2 * SEQ * 32 * 4;
constexpr size_t WS_W = WS_RSTD + al256((size_t)2 * NROW * 4);
constexpr size_t W_HYB = 0;
constexpr size_t WH_IN = 0, WH_QB = WH_IN + (size_t)HYB_INP * 1024 * 2, WH_KVB = WH_QB + (size_t)1536 * 384 * 2, WH_OUT = WH_KVB + (size_t)2048 * 256 * 2,
                 WH_SZ = WH_OUT + (size_t)1024 * 2048 * 2;
constexpr size_t W_GM = W_HYB + 2 * WH_SZ;
constexpr size_t WG_IN = 0, WG_OUT = WG_IN + (size_t)4096 * 1024 * 2, WG_WS = WG_OUT + (size_t)1024 * 2048 * 2, WG_SZ = WG_WS + (size_t)8 * 128 * 128 * 2;
constexpr size_t W_PEER = W_GM + 2 * WG_SZ;
constexpr size_t WP_Q = 0, WP_K1 = WP_Q + (size_t)2048 * 1024 * 2, WP_K2 = WP_K1 + (size_t)8 * 128 * 128 * 2, WP_SZ = WP_K2 + (size_t)8 * 128 * 128 * 2;
constexpr size_t W_TOTAL = W_PEER + 4 * WP_SZ;
constexpr size_t WS_TAB = WS_W + al256(W_TOTAL);
constexpr size_t TAB_HALF = (size_t)NEXP * 1024 * 2;
constexpr size_t WS_XC = WS_TAB + 2 * TAB_HALF;
constexpr size_t WS_H = WS_XC + (size_t)NCTX * D * 4;
constexpr size_t WS_BIG = WS_H + (size_t)NROW * D * 2;
constexpr size_t BIG_BYTES = (size_t)NROW * 4096 * 2;
constexpr size_t BIG_DT = (size_t)NROW * HYB_INP * 2;
constexpr size_t BIG_G = BIG_DT + (size_t)NROW * 32 * 4;
constexpr size_t BIG_KR = BIG_G + (size_t)528 * 128 * 128 * 2;
constexpr size_t BIG_PART = (size_t)NROW * 2048 * 2;
static_assert(BIG_KR + (size_t)NB * NKT * 8192 <= BIG_BYTES, "BIG tail");
constexpr size_t WS_R1 = WS_BIG + BIG_BYTES;
constexpr size_t R1_Q = 0, R1_KN = R1_Q + (size_t)NB * 8 * NKEY * 192 * 2, R1_V = R1_KN + (size_t)NB * 8 * NKT * 16384, R1_BYTES = R1_V + (size_t)NB * 8 * NKT * 16384;
constexpr size_t WS_R2 = WS_R1 + R1_BYTES;
constexpr size_t R2_BC = (size_t)NROW * 1024 * 2, R2_BYTES = R2_BC + (size_t)NROW * 512 * 2;
constexpr size_t R2_GATE = (size_t)NROW * 128 * 4, R2_COEF = 2 * R2_GATE;
constexpr size_t WS_R3 = WS_R2 + R2_BYTES;
constexpr size_t R3_CAT = (size_t)NROW * 1024 * 2, R3_BYTES = R3_CAT + (size_t)NROW * 2048 * 2;
constexpr size_t WS_END = WS_R3 + R3_BYTES;
static_assert(WS_END <= ((size_t)1 << 30), "workspace must fit 1 GiB");

constexpr int CW_RANK = 3584;
constexpr int CW_QUEUE = 4096;

typedef __bf16 bf16x2_t __attribute__((ext_vector_type(2)));
__device__ __forceinline__ unsigned cvt_pk_bf16(float lo, float hi) { const f32x2 v = {lo, hi}; const bf16x2_t b = __builtin_convertvector(v, bf16x2_t); return __builtin_bit_cast(unsigned, b); }
__device__ __forceinline__ bf16_t f2bf(float f) { return (bf16_t)(cvt_pk_bf16(f, 0.f) & 0xffffu); }
__device__ __forceinline__ float bf2f(unsigned b) { return __uint_as_float(b << 16); }
__device__ __forceinline__ float bflo(unsigned w) { return __uint_as_float(w << 16); }
__device__ __forceinline__ float bfhi(unsigned w) { return __uint_as_float(w & 0xffff0000u); }
__device__ __forceinline__ float wave_sum(float v) {
#pragma unroll
    for (int o = 32; o >= 1; o >>= 1) v += __shfl_xor(v, o);
    return v;
}
__device__ __forceinline__ int otid() { int t = threadIdx.x; asm volatile("" : "+v"(t)); return t; }
__device__ __forceinline__ float silu_f(float x) { return x / (1.f + __expf(-x)); }
__device__ __forceinline__ float softplus_f(float x) { return x > 20.f ? x : log1pf(__expf(x)); }
__device__ __forceinline__ f32x2 gelu_pk(f32x2 v) {
    const f32x2 av = __builtin_elementwise_abs(v), d = av * 0.2316418882f + 1.0f;
    f32x2 t; t.x = __builtin_amdgcn_rcpf(d.x); t.y = __builtin_amdgcn_rcpf(d.y);
    f32x2 q = t * 0.5307027145f + (-0.7265760135f); q = q * t + 0.7107068705f; q = q * t + (-0.142248368f); q = q * t + 0.127414796f; q = q * t;
    const f32x2 s = (v * v) * (-0.72134752044f);
    f32x2 e; e.x = __builtin_amdgcn_exp2f(s.x); e.y = __builtin_amdgcn_exp2f(s.y);
    const f32x2 m = v * (q * e), r = v - m;
    f32x2 o; o.x = v.x < 0.f ? m.x : r.x; o.y = v.y < 0.f ? m.y : r.y; return o;
}
__device__ __forceinline__ float gelu_f(float x) { f32x2 v = {x, 0.f}; return gelu_pk(v).x; }

__device__ __forceinline__ unsigned pk4_fp8(float a, float b, float c, float d) { int w = 0; w = __builtin_amdgcn_cvt_pk_fp8_f32(a, b, w, false); w = __builtin_amdgcn_cvt_pk_fp8_f32(c, d, w, true); return (unsigned)w; }
__device__ __forceinline__ float sat8(float v) { return __builtin_amdgcn_fmed3f(v, -448.f, 448.f); }
__device__ __forceinline__ unsigned pk4_fp8_sat(float a, float b, float c, float d) { return pk4_fp8(sat8(a), sat8(b), sat8(c), sat8(d)); }
__device__ __forceinline__ int row_mb(int r) { return r < NLAT ? (r >> 13) : 4; }

#define XB_TMO      128
#define XB_XCNT(j)  (256  + 64 * (j))
#define XB_XSUB(j)  (1280 + 64 * (j))
#define XB_XGEN(j)  (2304 + 64 * (j))
#define XB_TOP      3328
#define XB_TOPGEN   3392
#define XCD_BAR_WORDS 3456
#define XB_SPIN_CAP (1u << 22)
__device__ __forceinline__ unsigned xb_ld(unsigned* p)              { return __hip_atomic_load(p, __ATOMIC_RELAXED, __HIP_MEMORY_SCOPE_AGENT); }
__device__ __forceinline__ unsigned xb_add(unsigned* p, unsigned v) { return __hip_atomic_fetch_add(p, v, __ATOMIC_RELAXED, __HIP_MEMORY_SCOPE_AGENT); }
__device__ __forceinline__ unsigned xb_xcc_id() { return (unsigned)__builtin_amdgcn_s_getreg((3 << 11) | 20) & 0xFu; }
#define XB_SPIN(cond, bar) do { unsigned _sp = 0; while (cond) { __builtin_amdgcn_s_sleep(1); \
    if ((++_sp & 255u) == 0u) { if (xb_ld(&(bar)[XB_TMO])) break; if (_sp > XB_SPIN_CAP) { atomicAdd(&(bar)[XB_TMO], 1u); break; } } } } while (0)
struct XcdBarrier { unsigned* bar; unsigned x; volatile LAS unsigned* st; };
__device__ __forceinline__ XcdBarrier xcd_barrier_post(unsigned* bar, volatile LAS unsigned* st) {
    XcdBarrier b; b.bar = bar; b.x = xb_xcc_id(); b.st = st;
    if (threadIdx.x == 0) (void)xb_add(&bar[XB_XCNT(b.x)], 1u);
    return b;
}
__device__ __forceinline__ void xcd_barrier_complete(unsigned* bar, unsigned x, unsigned& nloc, unsigned& nx) {
    const unsigned G = gridDim.x * gridDim.y * gridDim.z;
    unsigned sum, cnt, mine, sp = 0u;
    for (;;) {
        sum = 0u; cnt = 0u; mine = 0u;
#pragma unroll
        for (unsigned j = 0; j < 16; ++j) { const unsigned c = xb_ld(&bar[XB_XCNT(j)]); sum += c; cnt += (c > 0u) ? 1u : 0u; mine = (j == x) ? c : mine; }
        if (sum == G) break;
        __builtin_amdgcn_s_sleep(1);
        if ((++sp & 255u) == 0u) { if (xb_ld(&bar[XB_TMO])) break; if (sp > XB_SPIN_CAP) { atomicAdd(&bar[XB_TMO], 1u); break; } }
    }
    nloc = mine > 0u ? mine : 1u; nx = cnt > 0u ? cnt : 1u;
}
__device__ __forceinline__ void xcd_barrier(const XcdBarrier& b) {
    asm volatile("s_waitcnt vmcnt(0)" ::: "memory");
    __syncthreads();
    if (threadIdx.x == 0) {
        unsigned* bar = b.bar;
        __builtin_amdgcn_s_waitcnt(0);
        unsigned nloc = b.st[0], nx = b.st[1];
        if (nloc == 0u) { xcd_barrier_complete(bar, b.x, nloc, nx); b.st[0] = nloc; b.st[1] = nx; }
        const unsigned old = xb_add(&bar[XB_XSUB(b.x)], 1u);
        const unsigned gen = old / nloc;
        if (old + 1u == (gen + 1u) * nloc) {
            __builtin_amdgcn_fence(__ATOMIC_RELEASE, "agent");
            asm volatile("s_waitcnt vmcnt(0)" ::: "memory");
            const unsigned og = xb_add(&bar[XB_TOP], 1u);
            const unsigned tg = og / nx;
            if (og + 1u == (tg + 1u) * nx) xb_add(&bar[XB_TOPGEN], 1u);
            else XB_SPIN(xb_ld(&bar[XB_TOPGEN]) == tg, bar);
            __builtin_amdgcn_fence(__ATOMIC_ACQUIRE, "agent");
            xb_add(&bar[XB_XGEN(b.x)], 1u);
            asm volatile("s_waitcnt vmcnt(0)" ::: "memory");
        } else {
            XB_SPIN(xb_ld(&bar[XB_XGEN(b.x)]) == gen, bar);
            __builtin_amdgcn_fence(__ATOMIC_ACQUIRE, "agent");
            asm volatile("s_waitcnt vmcnt(0)" ::: "memory");
        }
    }
    __syncthreads();
}

namespace pg8 {
constexpr int BM = 256, BK = 64, HALF = 128, HTB = HALF * BK * 2, STAGE_BYTES = 8 * HTB, NXCD = 8, WGM = 8;
__host__ __device__ __forceinline__ int lds_byte(int r, int c) { const int st = (r >> 4) * 2 + (c >> 5), rr = r & 15, cc = c & 31, ob = rr * 64 + cc * 2; return st * 1024 + (ob ^ (((ob >> 9) & 1) << 5)); }
__host__ __device__ __forceinline__ void stage_rc(int b, int& R, int& C) { const int st = b / 1024, sb = b % 1024, swz = sb ^ (((sb >> 9) & 1) << 5); R = (st >> 1) * 16 + swz / 64; C = (st & 1) * 32 + (swz % 64) / 2; }
__host__ __device__ __forceinline__ int perm32(int rho) { const int n = rho >> 4, i = rho & 15; return 8 * (i >> 2) + 4 * n + (i & 3); }
struct Unit { int pm, pn; };
struct Gemm { const bf16_t* A; const bf16_t* Bt; int M, N, K, lda, ldb; };
struct StaticOrder {
    int nM, nN, nwg, G, c;
    __device__ void init(int M, int N, int G_, int c_) { nM = M / BM; nN = N / BM; nwg = nM * nN; G = G_; c = c_; }
    __device__ bool next(int i, Unit& u) const {
        const long L = (long)i * G + c; if (L >= nwg) return false;
        int wgid = (int)L; { const int q = nwg / NXCD, r = nwg % NXCD, xcd = wgid % NXCD, off = wgid / NXCD; wgid = (xcd < r ? xcd * (q + 1) : r * (q + 1) + (xcd - r) * q) + off; }
        const int nig = WGM * nN, gid = wgid / nig, fm = gid * WGM, gsz = (nM - fm) < WGM ? (nM - fm) : WGM;
        u.pm = fm + ((wgid % nig) % gsz); u.pn = (wgid % nig) / gsz; return true;
    }
};
template <class Epi>
__device__ __forceinline__ void gemm_phase(LAS unsigned char* lds, const Gemm g, const Epi& E) {
    const int tid = otid(), wid = __builtin_amdgcn_readfirstlane(tid >> 6), lane = tid & 63, wr = wid >> 2, wc = wid & 3, fr = lane & 15, fq = lane >> 4;
    StaticOrder S; S.init(g.M, g.N, (int)gridDim.x, (int)blockIdx.x);
    int K = g.K; asm volatile("" : "+s"(K));
    const int nt = K / BK;
    unsigned voffA[2], voffB[2];
#pragma unroll
    for (int i = 0; i < 2; ++i) { int R, C; stage_rc(tid * 16 + i * 8192, R, C); const int Rb = Epi::PERM ? ((R & ~31) + perm32(R & 31)) : R;
        voffA[i] = (unsigned)(R * g.lda + C) * 2u; voffB[i] = (unsigned)(Rb * g.ldb + C) * 2u; }
    const size_t kstep = (size_t)(BK * 2);
    const size_t hstepA = (size_t)HALF * g.lda * 2, hstepB = (size_t)HALF * g.ldb * 2;
    const size_t tstepA = 2 * hstepA, tstepB = 2 * hstepB;
    const unsigned ldsw = (unsigned)wid * 1024u;
    const int aoff = lds_byte(wr * 64 + fr, fq * 8), boff = lds_byte(wc * 32 + fr, fq * 8);
#define PG8_SA(b, h) (((b) * 2 + (h)) * HTB)
#define PG8_SB(b, h) ((4 + (b) * 2 + (h)) * HTB)
#define PG8_STAGE(bufoff, gbase, voff) do { _Pragma("unroll") for (int _i = 0; _i < 2; ++_i) \
        __builtin_amdgcn_global_load_lds((const unsigned*)((const char*)(gbase) + (voff)[_i]), (LAS unsigned*)(lds + (bufoff) + ldsw + _i * 8192), 16, 0, 0); } while (0)
#define PG8_LDA(dst, b, h) do { _Pragma("unroll") for (int m = 0; m < 4; ++m) _Pragma("unroll") for (int k = 0; k < 2; ++k) dst[m][k] = *(const LAS bf16x8*)(lds + PG8_SA(b, h) + aoff + m * 2048 + k * 1024); } while (0)
#define PG8_LDB(dst, b, h) do { _Pragma("unroll") for (int n = 0; n < 2; ++n) _Pragma("unroll") for (int k = 0; k < 2; ++k) dst[n][k] = *(const LAS bf16x8*)(lds + PG8_SB(b, h) + boff + n * 2048 + k * 1024); } while (0)
#define PG8_MMA(ai, bj, At, Bt) do { __builtin_amdgcn_s_setprio(1); _Pragma("unroll") for (int m = 0; m < 4; ++m) _Pragma("unroll") for (int n = 0; n < 2; ++n) _Pragma("unroll") for (int k = 0; k < 2; ++k) \
        acc[ai][bj][m][n] = __builtin_amdgcn_mfma_f32_16x16x32_bf16(Bt[n][k], At[m][k], acc[ai][bj][m][n], 0, 0, 0); __builtin_amdgcn_s_setprio(0); } while (0)
#define PG8_WAIT_V(n) asm volatile("s_waitcnt vmcnt(" #n ")" ::: "memory")
#define PG8_WAIT_L(n) asm volatile("s_waitcnt lgkmcnt(" #n ")" ::: "memory")
#define PG8_BAR __builtin_amdgcn_s_barrier()
#define PG8_SCHED __builtin_amdgcn_sched_barrier(0)
    Unit cur, nxt; int ui = 0;
    if (!S.next(0, cur)) return;
    f32x4 acc[2][2][4][2];
#pragma unroll
    for (int a = 0; a < 2; ++a)
#pragma unroll
        for (int b = 0; b < 2; ++b)
#pragma unroll
            for (int m = 0; m < 4; ++m)
#pragma unroll
                for (int n = 0; n < 2; ++n) acc[a][b][m][n] = (f32x4){0.f, 0.f, 0.f, 0.f};
    bf16x8 At[4][2], B0[2][2], B1[2][2];
    const char* cA = (const char*)g.A + (size_t)cur.pm * tstepA; const char* cB = (const char*)g.Bt + (size_t)cur.pn * tstepB;
    PG8_STAGE(PG8_SB(0, 0), cB, voffB); PG8_STAGE(PG8_SB(0, 1), cB + hstepB, voffB); PG8_STAGE(PG8_SA(0, 0), cA, voffA); PG8_STAGE(PG8_SA(0, 1), cA + hstepA, voffA);
    if (wr == 1) PG8_BAR;
    PG8_WAIT_V(2); PG8_BAR;
    PG8_STAGE(PG8_SB(1, 0), cB + kstep, voffB); PG8_STAGE(PG8_SA(1, 0), cA + kstep, voffA); PG8_STAGE(PG8_SB(1, 1), cB + hstepB + kstep, voffB);
    PG8_WAIT_V(6); PG8_BAR;
    for (;;) {
        const bool has_next = S.next(ui + 1, nxt);
        const char* nA = has_next ? (const char*)g.A + (size_t)nxt.pm * tstepA : cA; const char* nB = has_next ? (const char*)g.Bt + (size_t)nxt.pn * tstepB : cB;
        for (int t = 0; t < nt; t += 2) {
            const bool last = (t == nt - 2);
            const char* a1 = cA + (size_t)(t + 1) * kstep;
            const char* a2 = last ? nA : cA + (size_t)(t + 2) * kstep; const char* b2 = last ? nB : cB + (size_t)(t + 2) * kstep;
            const char* a3 = a2 + kstep; const char* b3 = b2 + kstep;
            PG8_LDB(B0, 0, 0); PG8_LDB(B1, 0, 1); PG8_SCHED; PG8_LDA(At, 0, 0); PG8_STAGE(PG8_SA(1, 1), a1 + hstepA, voffA);
            PG8_WAIT_V(8); PG8_WAIT_L(0); PG8_BAR; PG8_MMA(0, 0, At, B0); PG8_MMA(0, 1, At, B1); PG8_BAR; PG8_SCHED;
            PG8_LDA(At, 0, 1); PG8_STAGE(PG8_SB(0, 0), b2, voffB); PG8_STAGE(PG8_SB(0, 1), b2 + hstepB, voffB); PG8_STAGE(PG8_SA(0, 0), a2, voffA);
            PG8_WAIT_V(8); PG8_WAIT_L(0); PG8_BAR; PG8_MMA(1, 0, At, B0); PG8_MMA(1, 1, At, B1); PG8_BAR; PG8_SCHED;
            PG8_LDB(B0, 1, 0); PG8_LDB(B1, 1, 1); PG8_SCHED; PG8_LDA(At, 1, 0); PG8_STAGE(PG8_SA(0, 1), a2 + hstepA, voffA);
            PG8_WAIT_V(8); PG8_WAIT_L(0); PG8_BAR; PG8_MMA(0, 0, At, B0); PG8_MMA(0, 1, At, B1); PG8_BAR; PG8_SCHED;
            PG8_LDA(At, 1, 1); PG8_STAGE(PG8_SB(1, 0), b3, voffB); PG8_STAGE(PG8_SB(1, 1), b3 + hstepB, voffB); PG8_STAGE(PG8_SA(1, 0), a3, voffA);
            PG8_WAIT_V(8); PG8_WAIT_L(0); PG8_BAR; PG8_MMA(1, 0, At, B0); PG8_MMA(1, 1, At, B1); PG8_BAR; PG8_SCHED;
        }
        if (wr == 0) PG8_BAR;
        { const int l2_ = otid() & 63; E(acc, cur, wr, wc, l2_ & 15, l2_ >> 4); }
        if (!has_next) break;
#pragma unroll
        for (int a = 0; a < 2; ++a)
#pragma unroll
            for (int b = 0; b < 2; ++b)
#pragma unroll
                for (int m = 0; m < 4; ++m)
#pragma unroll
                    for (int n = 0; n < 2; ++n) acc[a][b][m][n] = (f32x4){0.f, 0.f, 0.f, 0.f};
        cur = nxt; cA = nA; cB = nB; ++ui;
        if (wr == 1) PG8_BAR;
    }
    PG8_WAIT_V(0);
    PG8_BAR;
#undef PG8_SA
#undef PG8_SB
#undef PG8_STAGE
#undef PG8_LDA
#undef PG8_LDB
#undef PG8_MMA
#undef PG8_WAIT_V
#undef PG8_WAIT_L
#undef PG8_BAR
#undef PG8_SCHED
}

template <int ACT> struct EpiBf16 {
    static constexpr bool PERM = true;
    bf16_t* O; int ldc;
    __device__ __forceinline__ void operator()(const f32x4 (&acc)[2][2][4][2], const Unit& u, int wr, int wc, int fr, int fq) const {
        const int row0 = u.pm * BM + wr * 64 + fr, col0 = u.pn * BM + wc * 32 + 8 * fq;
#pragma unroll
        for (int ai = 0; ai < 2; ++ai)
#pragma unroll
            for (int m = 0; m < 4; ++m) { bf16_t* rowp = O + (size_t)(row0 + ai * HALF + m * 16) * ldc + col0;
#pragma unroll
                for (int bj = 0; bj < 2; ++bj) { f32x4 v0 = acc[ai][bj][m][0], v1 = acc[ai][bj][m][1];
                    if (ACT == 1) { f32x2 a = gelu_pk((f32x2){v0[0], v0[1]}), b = gelu_pk((f32x2){v0[2], v0[3]}), c = gelu_pk((f32x2){v1[0], v1[1]}), d = gelu_pk((f32x2){v1[2], v1[3]});
                        v0 = (f32x4){a.x, a.y, b.x, b.y}; v1 = (f32x4){c.x, c.y, d.x, d.y}; }
                    u32x4 w; w.x = cvt_pk_bf16(v0[0], v0[1]); w.y = cvt_pk_bf16(v0[2], v0[3]); w.z = cvt_pk_bf16(v1[0], v1[1]); w.w = cvt_pk_bf16(v1[2], v1[3]);
                    *(u32x4*)(rowp + bj * HALF) = w; } }
    }
};
struct EpiResid {
    static constexpr bool PERM = false;
    float* xl; float* xc; const float* gate;
    __device__ __forceinline__ void operator()(const f32x4 (&acc)[2][2][4][2], const Unit& u, int wr, int wc, int fr, int fq) const {
        const int rbase = u.pm * BM; const bool lat = rbase < NLAT;
        float* X = lat ? xl + (size_t)rbase * D : xc + (size_t)(rbase - NLAT) * D;
        const float* gp = gate + (size_t)(lat ? (rbase >> 13) : 4) * 6144;
        const int row0 = wr * 64 + fr, col0 = u.pn * BM + wc * 32 + 4 * fq;
        f32x4 gv[2][2];
#pragma unroll
        for (int bj = 0; bj < 2; ++bj)
#pragma unroll
            for (int n = 0; n < 2; ++n) gv[bj][n] = *(const f32x4*)(gp + col0 + bj * HALF + n * 16);
#pragma unroll
        for (int ai = 0; ai < 2; ++ai)
#pragma unroll
            for (int m = 0; m < 4; ++m) { float* rowp = X + (size_t)(row0 + ai * HALF + m * 16) * D + col0;
#pragma unroll
                for (int bj = 0; bj < 2; ++bj)
#pragma unroll
                    for (int n = 0; n < 2; ++n) { f32x4* p = (f32x4*)(rowp + bj * HALF + n * 16); *p = *p + gv[bj][n] * acc[ai][bj][m][n]; } }
    }
};
}

namespace att {
constexpr int SLOT = 40960, KN_OFF = 0, KR_OFF = 16384, V_OFF = 24576, LDS_BYTES = 3 * SLOT + 8 * 256;
constexpr float THR2 = 11.0f;
#define KSWZ(row, colB) ((row) * 256 + ((colB) ^ (((row) & 7) << 4)))
#define KRSWZ(row, colB) ((row) * 128 + ((colB) ^ ((((row) >> 1) & 7) << 4)))
#define SBAR() __builtin_amdgcn_sched_barrier(0)
__device__ __forceinline__ int crow(int r, int hi) { return (r & 3) + 8 * (r >> 2) + 4 * hi; }
__host__ __device__ __forceinline__ int v_st(int k, int c) { const int kk = (k & ~0xC) | ((k & 4) << 1) | ((k & 8) >> 1); return ((kk >> 3) * 4 + (c >> 5)) * 512 + ((kk & 7) * 32 + (c & 31)) * 2; }
__device__ __forceinline__ int v_rd_base(int lane) { return ((lane & 3) << 3) | (((lane >> 2) & 3) << 6) | (((lane >> 4) & 1) << 5) | (((lane >> 5) & 1) << 8); }
constexpr int v_rd_off(int d0, int ks, int half) { return d0 * 512 + ks * 4096 + half * 2048; }
template <int OFF> __device__ __forceinline__ s16x4 tr_read(int vb) {
    s16x4 r; asm volatile("ds_read_b64_tr_b16 %0, %1 offset:%2" : "=&v"(r) : "v"(vb), "i"(OFF) : "memory"); return r;
}
template <int D0> __device__ __forceinline__ void pv_one(f32x16& od, int vb, bf16x8 pa0, bf16x8 pa1, bf16x8 pa2, bf16x8 pa3) {
    const s16x4 l0 = tr_read<v_rd_off(D0, 0, 0)>(vb), h0 = tr_read<v_rd_off(D0, 0, 1)>(vb), l1 = tr_read<v_rd_off(D0, 1, 0)>(vb), h1 = tr_read<v_rd_off(D0, 1, 1)>(vb);
    const s16x4 l2 = tr_read<v_rd_off(D0, 2, 0)>(vb), h2 = tr_read<v_rd_off(D0, 2, 1)>(vb), l3 = tr_read<v_rd_off(D0, 3, 0)>(vb), h3 = tr_read<v_rd_off(D0, 3, 1)>(vb);
    asm volatile("s_waitcnt lgkmcnt(0)" ::: "memory"); SBAR();
#define PK(L, H) (bf16x8){L[0], L[1], L[2], L[3], H[0], H[1], H[2], H[3]}
    od = __builtin_amdgcn_mfma_f32_32x32x16_bf16(pa0, PK(l0, h0), od, 0, 0, 0);
    od = __builtin_amdgcn_mfma_f32_32x32x16_bf16(pa1, PK(l1, h1), od, 0, 0, 0);
    od = __builtin_amdgcn_mfma_f32_32x32x16_bf16(pa2, PK(l2, h2), od, 0, 0, 0);
    od = __builtin_amdgcn_mfma_f32_32x32x16_bf16(pa3, PK(l3, h3), od, 0, 0, 0);
#undef PK
}
__device__ __forceinline__ void pv_d0(f32x16* o, int vb, bf16x8 pa0, bf16x8 pa1, bf16x8 pa2, bf16x8 pa3) {
    pv_one<0>(o[0], vb, pa0, pa1, pa2, pa3); pv_one<1>(o[1], vb, pa0, pa1, pa2, pa3); pv_one<2>(o[2], vb, pa0, pa1, pa2, pa3); pv_one<3>(o[3], vb, pa0, pa1, pa2, pa3);
}
__device__ __forceinline__ void partialSM(f32x16& p0, f32x16& p1, float& m_reg, float& mn, float& alpha) {
    float pmax = p0[0];
#pragma unroll
    for (int r = 1; r < 16; ++r) pmax = fmaxf(pmax, p0[r]);
#pragma unroll
    for (int r = 0; r < 16; ++r) pmax = fmaxf(pmax, p1[r]);
    { auto rr = __builtin_amdgcn_permlane32_swap(__float_as_uint(pmax), __float_as_uint(pmax), false, false);
      pmax = fmaxf(__uint_as_float(rr[0]), __uint_as_float(rr[1])); }
    if (__builtin_expect(__all(pmax - m_reg <= THR2), 1)) { mn = m_reg; alpha = 1.f; }
    else { mn = fmaxf(m_reg, pmax); alpha = __builtin_amdgcn_exp2f(m_reg - mn); m_reg = mn; }
#pragma unroll
    for (int r = 0; r < 16; ++r) p0[r] = __builtin_amdgcn_exp2f(p0[r] - mn);
#pragma unroll
    for (int r = 0; r < 16; ++r) p1[r] = p1[r] - mn;
}
__device__ __forceinline__ void finishSM(f32x16& p0, f32x16& p1, float alpha, float& l_reg, bf16x8& pa0, bf16x8& pa1, bf16x8& pa2, bf16x8& pa3) {
#pragma unroll
    for (int r = 0; r < 16; ++r) p1[r] = __builtin_amdgcn_exp2f(p1[r]);
    float ps = 0;
#pragma unroll
    for (int r = 0; r < 16; ++r) ps += p0[r];
#pragma unroll
    for (int r = 0; r < 16; ++r) ps += p1[r];
    { auto rr = __builtin_amdgcn_permlane32_swap(__float_as_uint(ps), __float_as_uint(ps), false, false);
      ps = __uint_as_float(rr[0]) + __uint_as_float(rr[1]); }
    l_reg = l_reg * alpha + ps;
#define PK4(P, BASE, OUT) do { unsigned a0 = cvt_pk_bf16(P[BASE + 0], P[BASE + 1]), a1 = cvt_pk_bf16(P[BASE + 2], P[BASE + 3]);   \
    unsigned b0 = cvt_pk_bf16(P[BASE + 4], P[BASE + 5]), b1 = cvt_pk_bf16(P[BASE + 6], P[BASE + 7]);                              \
    auto r0 = __builtin_amdgcn_permlane32_swap(a0, b0, false, false); auto r1 = __builtin_amdgcn_permlane32_swap(a1, b1, false, false); \
    u32x4 w = {r0[0], r1[0], r0[1], r1[1]}; OUT = *reinterpret_cast<bf16x8*>(&w); } while (0)
    PK4(p0, 0, pa0); PK4(p0, 8, pa1); PK4(p1, 0, pa2); PK4(p1, 8, pa3);
#undef PK4
}
__device__ __forceinline__ void qkt(f32x16& p0, f32x16& p1, LAS unsigned char* slot, const bf16x8* qr, int r32, int hi) {
    p0 = f32x16{}; p1 = f32x16{};
#pragma unroll
    for (int d0 = 0; d0 < 8; ++d0) { const int cb = (d0 * 16 + hi * 8) * 2;
        bf16x8 b0 = *(const LAS bf16x8*)(slot + KN_OFF + KSWZ(r32, cb));
        bf16x8 b1 = *(const LAS bf16x8*)(slot + KN_OFF + KSWZ(32 + r32, cb));
        p0 = __builtin_amdgcn_mfma_f32_32x32x16_bf16(b0, qr[d0], p0, 0, 0, 0);
        p1 = __builtin_amdgcn_mfma_f32_32x32x16_bf16(b1, qr[d0], p1, 0, 0, 0); }
#pragma unroll
    for (int d0 = 0; d0 < 4; ++d0) { const int cb = (d0 * 16 + hi * 8) * 2;
        bf16x8 b0 = *(const LAS bf16x8*)(slot + KR_OFF + KRSWZ(r32, cb));
        bf16x8 b1 = *(const LAS bf16x8*)(slot + KR_OFF + KRSWZ(32 + r32, cb));
        p0 = __builtin_amdgcn_mfma_f32_32x32x16_bf16(b0, qr[8 + d0], p0, 0, 0, 0);
        p1 = __builtin_amdgcn_mfma_f32_32x32x16_bf16(b1, qr[8 + d0], p1, 0, 0, 0); }
}
__device__ __forceinline__ void attn_unit(const bf16_t* __restrict__ Qb, const unsigned char* __restrict__ KNt, const unsigned char* __restrict__ KRt, const unsigned char* __restrict__ Vt,
                                          bf16_t* __restrict__ Ob, int NT, LAS unsigned char* lds) {
    const int tid = otid(), wid = __builtin_amdgcn_readfirstlane(tid >> 6), lane = tid & 63, r32 = lane & 31, hi = lane >> 5;
    LAS float* wsf = (LAS float*)(lds + 3 * SLOT) + wid * 64; LAS float* li_l = wsf; LAS float* al_l = wsf + 32;
    float m_reg = -1e30f, l_reg = 0; f32x16 o[4] = {}; bf16x8 qr[12];
    const bf16_t* Qw = Qb + (size_t)(wid * 32 + r32) * 192 + hi * 8;
#pragma unroll
    for (int d0 = 0; d0 < 12; ++d0) qr[d0] = *(const bf16x8*)(Qw + d0 * 16);
    const int vrb = (int)(unsigned)(uintptr_t)(lds) + V_OFF + v_rd_base(lane);
    const unsigned lo16 = (unsigned)lane * 16u;
#define ATT_DMA(tile, slotoff) do { const size_t t_ = (size_t)(tile); LAS unsigned char* sl_ = lds + (slotoff); \
        __builtin_amdgcn_global_load_lds((const unsigned*)(KNt + t_ * 16384 + wid * 1024 + lo16), (LAS unsigned*)(sl_ + KN_OFF + wid * 1024), 16, 0, 0); \
        __builtin_amdgcn_global_load_lds((const unsigned*)(KNt + t_ * 16384 + (wid + 8) * 1024 + lo16), (LAS unsigned*)(sl_ + KN_OFF + (wid + 8) * 1024), 16, 0, 0); \
        __builtin_amdgcn_global_load_lds((const unsigned*)(KRt + t_ * 8192 + wid * 1024 + lo16), (LAS unsigned*)(sl_ + KR_OFF + wid * 1024), 16, 0, 0); \
        __builtin_amdgcn_global_load_lds((const unsigned*)(Vt + t_ * 16384 + wid * 1024 + lo16), (LAS unsigned*)(sl_ + V_OFF + wid * 1024), 16, 0, 0); \
        __builtin_amdgcn_global_load_lds((const unsigned*)(Vt + t_ * 16384 + (wid + 8) * 1024 + lo16), (LAS unsigned*)(sl_ + V_OFF + (wid + 8) * 1024), 16, 0, 0); } while (0)
#define ATT_SYNC() do { asm volatile("s_waitcnt vmcnt(0)" ::: "memory"); __builtin_amdgcn_s_barrier(); asm volatile("" ::: "memory"); } while (0)
#define RESC(a) do { if (__any((a) < 1.f)) { if (hi == 0) al_l[r32] = (a); asm volatile("s_waitcnt lgkmcnt(0)" ::: "memory"); \
        _Pragma("unroll") for (int d = 0; d < 4; ++d) _Pragma("unroll") for (int r = 0; r < 16; ++r) o[d][r] *= al_l[crow(r, hi)]; } } while (0)
    f32x16 pA0, pA1, pB0, pB1; float mnA, mnB, alA, alB; bf16x8 pa0, pa1, pa2, pa3;
    int sp = 0, sc = SLOT, sn = 2 * SLOT;
    ATT_DMA(0, 0); ATT_DMA(1, SLOT);
    asm volatile("s_waitcnt vmcnt(5)" ::: "memory"); __builtin_amdgcn_s_barrier(); asm volatile("" ::: "memory");
    qkt(pA0, pA1, lds, qr, r32, hi); partialSM(pA0, pA1, m_reg, mnA, alA);
    for (int j = 1; j + 1 < NT; j += 2) {
        ATT_SYNC(); ATT_DMA(j + 1, sn);
        SBAR(); qkt(pB0, pB1, lds + sc, qr, r32, hi);
        finishSM(pA0, pA1, alA, l_reg, pa0, pa1, pa2, pa3); SBAR();
        pv_d0(o, vrb + sp, pa0, pa1, pa2, pa3); partialSM(pB0, pB1, m_reg, mnB, alB);
        RESC(alB);
        { const int t_ = sp; sp = sc; sc = sn; sn = t_; }
        ATT_SYNC(); if (j + 2 < NT) ATT_DMA(j + 2, sn);
        SBAR(); qkt(pA0, pA1, lds + sc, qr, r32, hi);
        finishSM(pB0, pB1, alB, l_reg, pa0, pa1, pa2, pa3); SBAR();
        pv_d0(o, vrb + sp, pa0, pa1, pa2, pa3); partialSM(pA0, pA1, m_reg, mnA, alA);
        RESC(alA);
        { const int t_ = sp; sp = sc; sc = sn; sn = t_; }
    }
    ATT_SYNC();
    SBAR(); qkt(pB0, pB1, lds + sc, qr, r32, hi);
    finishSM(pA0, pA1, alA, l_reg, pa0, pa1, pa2, pa3); SBAR();
    pv_d0(o, vrb + sp, pa0, pa1, pa2, pa3); partialSM(pB0, pB1, m_reg, mnB, alB);
    RESC(alB);
    finishSM(pB0, pB1, alB, l_reg, pa0, pa1, pa2, pa3); SBAR();
    pv_d0(o, vrb + sc, pa0, pa1, pa2, pa3);
    if (hi == 0) li_l[r32] = l_reg; asm volatile("s_waitcnt lgkmcnt(0)" ::: "memory");
    float rli[16];
#pragma unroll
    for (int r = 0; r < 16; ++r) rli[r] = __builtin_amdgcn_rcpf(li_l[crow(r, hi)]);
    bf16_t* Ow = Ob + (size_t)(wid * 32) * 2048;
#pragma unroll
    for (int r = 0; r < 16; ++r) { const int orow = crow(r, hi);
#pragma unroll
        for (int d0 = 0; d0 < 4; ++d0) Ow[(size_t)orow * 2048 + d0 * 32 + r32] = f2bf(o[d0][r] * rli[r]); }
    __builtin_amdgcn_s_barrier(); asm volatile("" ::: "memory");
#undef ATT_DMA
#undef ATT_SYNC
#undef RESC
}
}

namespace att8 {
constexpr int SLOT = 20480, KN_OFF = 0, KR_OFF = 8192, V_OFF = 12288, LDS_BYTES = 3 * SLOT + 8 * 256;
constexpr float THR2 = 8.0f;
constexpr float QUP = 8.f; constexpr int SC_ONE = 0x7f7f7f7f, SC_Q = 0x7c7c7c7c;
__host__ __device__ __forceinline__ int kn8(int key, int b) { return key * 128 + ((((b >> 4) ^ ((key >> 1) & 7))) << 4) + (b & 15); }
__host__ __device__ __forceinline__ int kr8(int key, int b) { return key * 64 + ((((b >> 4) ^ ((key >> 2) & 3))) << 4) + (b & 15); }
__host__ __device__ __forceinline__ int vslot(int k) { return 32 * ((k >> 2) & 1) + 16 * (k >> 5) + (k & 3) + 4 * ((k & 31) >> 3); }
__host__ __device__ __forceinline__ int v8(int d, int k) { const int sl = vslot(k); return d * 64 + ((((sl >> 4) ^ ((d >> 2) & 3))) << 4) + (sl & 15); }
__device__ __forceinline__ i32x8 ld32(const LAS unsigned char* a0, const LAS unsigned char* a1) { const u32x4 x = *(const LAS u32x4*)a0, y = *(const LAS u32x4*)a1;
    return (i32x8){(int)x.x, (int)x.y, (int)x.z, (int)x.w, (int)y.x, (int)y.y, (int)y.z, (int)y.w}; }
__device__ __forceinline__ void qkt(f32x16& p0, f32x16& p1, LAS unsigned char* slot, const i32x8* qf, int r32, int hi) {
    p0 = f32x16{}; p1 = f32x16{};
#pragma unroll
    for (int ks = 0; ks < 2; ++ks) { const int b = 64 * ks + 32 * hi;
        const i32x8 a0 = ld32(slot + KN_OFF + kn8(r32, b), slot + KN_OFF + kn8(r32, b + 16)), a1 = ld32(slot + KN_OFF + kn8(32 + r32, b), slot + KN_OFF + kn8(32 + r32, b + 16));
        p0 = __builtin_amdgcn_mfma_scale_f32_32x32x64_f8f6f4(a0, qf[ks], p0, 0, 0, 0, SC_ONE, 0, SC_Q);
        p1 = __builtin_amdgcn_mfma_scale_f32_32x32x64_f8f6f4(a1, qf[ks], p1, 0, 0, 0, SC_ONE, 0, SC_Q); }
    { const int b = 32 * hi;
        const i32x8 a0 = ld32(slot + KR_OFF + kr8(r32, b), slot + KR_OFF + kr8(r32, b + 16)), a1 = ld32(slot + KR_OFF + kr8(32 + r32, b), slot + KR_OFF + kr8(32 + r32, b + 16));
        p0 = __builtin_amdgcn_mfma_scale_f32_32x32x64_f8f6f4(a0, qf[2], p0, 0, 0, 0, SC_ONE, 0, SC_Q);
        p1 = __builtin_amdgcn_mfma_scale_f32_32x32x64_f8f6f4(a1, qf[2], p1, 0, 0, 0, SC_ONE, 0, SC_Q); }
}
__device__ __forceinline__ void partialSM(f32x16& p0, f32x16& p1, float& m_reg, float& mn, float& alpha) {
    float pmax = p0[0];
#pragma unroll
    for (int r = 1; r < 16; ++r) pmax = fmaxf(pmax, p0[r]);
#pragma unroll
    for (int r = 0; r < 16; ++r) pmax = fmaxf(pmax, p1[r]);
    { auto rr = __builtin_amdgcn_permlane32_swap(__float_as_uint(pmax), __float_as_uint(pmax), false, false);
      pmax = fmaxf(__uint_as_float(rr[0]), __uint_as_float(rr[1])); }
    if (__builtin_expect(__all(pmax - m_reg <= THR2), 1)) { mn = m_reg; alpha = 1.f; }
    else { mn = fmaxf(m_reg, pmax); alpha = __builtin_amdgcn_exp2f(m_reg - mn); m_reg = mn; }
#pragma unroll
    for (int r = 0; r < 16; ++r) p0[r] = __builtin_amdgcn_exp2f(p0[r] - mn);
#pragma unroll
    for (int r = 0; r < 16; ++r) p1[r] = p1[r] - mn;
}
__device__ __forceinline__ void finishSM(f32x16& p0, f32x16& p1, float alpha, float& l_reg, i32x8& pf) {
#pragma unroll
    for (int r = 0; r < 16; ++r) p1[r] = __builtin_amdgcn_exp2f(p1[r]);
    float ps = 0;
#pragma unroll
    for (int r = 0; r < 16; ++r) ps += p0[r];
#pragma unroll
    for (int r = 0; r < 16; ++r) ps += p1[r];
    { auto rr = __builtin_amdgcn_permlane32_swap(__float_as_uint(ps), __float_as_uint(ps), false, false);
      ps = __uint_as_float(rr[0]) + __uint_as_float(rr[1]); }
    l_reg = l_reg * alpha + ps;
#pragma unroll
    for (int w = 0; w < 4; ++w) { pf[w] = (int)pk4_fp8(p0[4 * w], p0[4 * w + 1], p0[4 * w + 2], p0[4 * w + 3]); pf[4 + w] = (int)pk4_fp8(p1[4 * w], p1[4 * w + 1], p1[4 * w + 2], p1[4 * w + 3]); }
}
__device__ __forceinline__ void pv(f32x16* o, LAS unsigned char* slot, const i32x8 pf, int r32, int hi) {
#pragma unroll
    for (int d0 = 0; d0 < 4; ++d0) { const int d = 32 * d0 + r32, sw = (d >> 2) & 3;
        const i32x8 b = ld32(slot + V_OFF + d * 64 + (((2 * hi) ^ sw) << 4), slot + V_OFF + d * 64 + (((2 * hi + 1) ^ sw) << 4));
        o[d0] = __builtin_amdgcn_mfma_scale_f32_32x32x64_f8f6f4(pf, b, o[d0], 0, 0, 0, SC_ONE, 0, SC_ONE); }
}
__device__ __forceinline__ int crow(int r, int hi) { return (r & 3) + 8 * (r >> 2) + 4 * hi; }
__device__ __forceinline__ void attn_unit(const unsigned char* __restrict__ Qb, const unsigned char* __restrict__ KNt, const unsigned char* __restrict__ KRt, const unsigned char* __restrict__ Vt,
                                          bf16_t* __restrict__ Ob, int NT, LAS unsigned char* lds) {
    const int tid = otid(), wid = __builtin_amdgcn_readfirstlane(tid >> 6), lane = tid & 63, r32 = lane & 31, hi = lane >> 5;
    LAS float* wsf = (LAS float*)(lds + 3 * SLOT) + wid * 64; LAS float* li_l = wsf; LAS float* al_l = wsf + 32;
    float m_reg = -1e30f, l_reg = 0; f32x16 o[4] = {}; i32x8 qf[3];
    const unsigned char* Qw = Qb + (size_t)(wid * 32 + r32) * 192 + 32 * hi;
#pragma unroll
    for (int ks = 0; ks < 3; ++ks) { const u32x4 x = *(const u32x4*)(Qw + 64 * ks), y = *(const u32x4*)(Qw + 64 * ks + 16); qf[ks] = (i32x8){(int)x.x, (int)x.y, (int)x.z, (int)x.w, (int)y.x, (int)y.y, (int)y.z, (int)y.w}; }
    const unsigned lo16 = (unsigned)lane * 16u;
#define ATT_DMA(tile, slotoff) do { const size_t t_ = (size_t)(tile); LAS unsigned char* sl_ = lds + (slotoff); \
        __builtin_amdgcn_global_load_lds((const unsigned*)(KNt + t_ * 8192 + wid * 1024 + lo16), (LAS unsigned*)(sl_ + KN_OFF + wid * 1024), 16, 0, 0); \
        __builtin_amdgcn_global_load_lds((const unsigned*)(Vt + t_ * 8192 + wid * 1024 + lo16), (LAS unsigned*)(sl_ + V_OFF + wid * 1024), 16, 0, 0); \
        if (wid < 4) __builtin_amdgcn_global_load_lds((const unsigned*)(KRt + t_ * 4096 + wid * 1024 + lo16), (LAS unsigned*)(sl_ + KR_OFF + wid * 1024), 16, 0, 0); } while (0)
#define ATT_SYNC() do { asm volatile("s_waitcnt vmcnt(0)" ::: "memory"); __builtin_amdgcn_s_barrier(); asm volatile("" ::: "memory"); } while (0)
#define RESC(a) do { if (__any((a) < 1.f)) { if (hi == 0) al_l[r32] = (a); asm volatile("s_waitcnt lgkmcnt(0)" ::: "memory"); \
        _Pragma("unroll") for (int d = 0; d < 4; ++d) _Pragma("unroll") for (int r = 0; r < 16; ++r) o[d][r] *= al_l[crow(r, hi)]; } } while (0)
    f32x16 pA0, pA1, pB0, pB1; float mnA, mnB, alA, alB; i32x8 pf;
    int sp = 0, sc = SLOT, sn = 2 * SLOT;
    ATT_DMA(0, 0);
    ATT_SYNC();
    ATT_DMA(1, SLOT);
    qkt(pA0, pA1, lds, qf, r32, hi); partialSM(pA0, pA1, m_reg, mnA, alA);
    for (int j = 1; j + 1 < NT; j += 2) {
        ATT_SYNC(); ATT_DMA(j + 1, sn);
        SBAR(); qkt(pB0, pB1, lds + sc, qf, r32, hi);
        finishSM(pA0, pA1, alA, l_reg, pf); SBAR();
        pv(o, lds + sp, pf, r32, hi); partialSM(pB0, pB1, m_reg, mnB, alB);
        RESC(alB);
        { const int t_ = sp; sp = sc; sc = sn; sn = t_; }
        ATT_SYNC(); if (j + 2 < NT) ATT_DMA(j + 2, sn);
        SBAR(); qkt(pA0, pA1, lds + sc, qf, r32, hi);
        finishSM(pB0, pB1, alB, l_reg, pf); SBAR();
        pv(o, lds + sp, pf, r32, hi); partialSM(pA0, pA1, m_reg, mnA, alA);
        RESC(alA);
        { const int t_ = sp; sp = sc; sc = sn; sn = t_; }
    }
    ATT_SYNC();
    SBAR(); qkt(pB0, pB1, lds + sc, qf, r32, hi);
    finishSM(pA0, pA1, alA, l_reg, pf); SBAR();
    pv(o, lds + sp, pf, r32, hi); partialSM(pB0, pB1, m_reg, mnB, alB);
    RESC(alB);
    finishSM(pB0, pB1, alB, l_reg, pf); SBAR();
    pv(o, lds + sc, pf, r32, hi);
    if (hi == 0) li_l[r32] = l_reg; asm volatile("s_waitcnt lgkmcnt(0)" ::: "memory");
    float rli[16];
#pragma unroll
    for (int r = 0; r < 16; ++r) rli[r] = __builtin_amdgcn_rcpf(li_l[crow(r, hi)]);
    bf16_t* Ow = Ob + (size_t)(wid * 32) * 2048;
#pragma unroll
    for (int r = 0; r < 16; ++r) { const int orow = crow(r, hi);
#pragma unroll
        for (int d0 = 0; d0 < 4; ++d0) Ow[(size_t)orow * 2048 + d0 * 32 + r32] = f2bf(o[d0][r] * rli[r]); }
    __builtin_amdgcn_s_barrier(); asm volatile("" ::: "memory");
#undef ATT_DMA
#undef ATT_SYNC
#undef RESC
}
}

namespace ssd {
constexpr int XT_OFF = 0, BT_OFF = 17408, HB_OFF = 52224, SET = 69632, CW_OFF = 2 * SET, LDS_BYTES = CW_OFF + 8 * 1536;
constexpr int PITCH = 272;
constexpr float L2E = 1.4426950408889634f;
__device__ __forceinline__ void g_unit(const bf16_t* __restrict__ BC, bf16_t* __restrict__ G, int unit) {
    const int cid = unit >> 1, g = unit & 1;
    const int r0 = cid < 256 ? cid * 128 : NLAT + (cid - 256) * 128;
    const int tid = otid(), wid = tid >> 6, lane = tid & 63, fr = lane & 15, fq = lane >> 4;
    const bf16_t* Cp = BC + (size_t)(r0 + 16 * wid + fr) * 512 + 256 + 128 * g + 8 * fq;
    bf16x8 cf[4];
#pragma unroll
    for (int ks = 0; ks < 4; ++ks) cf[ks] = *(const bf16x8*)(Cp + 32 * ks);
    bf16_t* Gp = G + ((size_t)unit * 128 + 16 * wid + fr) * 128 + 4 * fq;
#pragma unroll
    for (int sb = 0; sb < 8; ++sb) {
        const bf16_t* Bp = BC + (size_t)(r0 + 16 * sb + fr) * 512 + 128 * g + 8 * fq;
        f32x4 acc = {0.f, 0.f, 0.f, 0.f};
#pragma unroll
        for (int ks = 0; ks < 4; ++ks) { const bf16x8 bfr = *(const bf16x8*)(Bp + 32 * ks); acc = __builtin_amdgcn_mfma_f32_16x16x32_bf16(bfr, cf[ks], acc, 0, 0, 0); }
        u32x2 w; w.x = cvt_pk_bf16(acc[0], acc[1]); w.y = cvt_pk_bf16(acc[2], acc[3]);
        *(u32x2*)(Gp + 16 * sb) = w;
    }
}
__device__ __forceinline__ void ssd_unit(int b, int h, int d, const bf16_t* __restrict__ XS, const bf16_t* __restrict__ BC, const float* __restrict__ DT, const bf16_t* __restrict__ G,
                                         const float* __restrict__ a_log, bf16_t* __restrict__ Y, LAS unsigned char* lds) {
    const int g = h >> 3;
    const int tid = otid(), wid = tid >> 6, lane = tid & 63, fr = lane & 15, fq = lane >> 4;
    const float a = -__expf(a_log[d * 16 + h]);
    LAS float* cw = (LAS float*)(lds + CW_OFF + wid * 1536); LAS float* dts = cw + 128; LAS float* dtw = cw + 256;
    f32x4 hs[4];
#pragma unroll
    for (int q = 0; q < 4; ++q) hs[q] = (f32x4){0.f, 0.f, 0.f, 0.f};
    for (int i = tid; i < 17408 / 4; i += 512) ((LAS unsigned*)(lds + HB_OFF))[i] = 0u;
    float cend = 0.f;
#define SSD_ROWS(step, r0v, gidv) do { if ((step) < 2) { const int oc_ = d ? 1 - (step) : (step); r0v = NLAT + b * 256 + oc_ * 128; gidv = 256 + b * 2 + oc_; } \
        else { const int lc_ = (step) - 2, oc_ = d ? 63 - lc_ : lc_; r0v = b * 8192 + oc_ * 128; gidv = b * 64 + oc_; } } while (0)
    const int sg = tid & 31, n8 = tid >> 5, p4 = tid >> 5;
    f32x2 P_da, Q_da; u32x2 P_xv[4], Q_xv[4]; u32x4 P_bv[4], Q_bv[4], n_gv[4], n_cv[4], c_gv[4], c_cv[4];
#define SSD_LOAD(step, X) do { int r0_, gid_; SSD_ROWS(step, r0_, gid_); (void)gid_; X##_da = *(const f32x2*)(DT + (size_t)(d * 16 + h) * NROW + r0_ + 2 * lane); \
        _Pragma("unroll") for (int j_ = 0; j_ < 4; ++j_) { X##_xv[j_] = *(const u32x2*)(XS + (size_t)(r0_ + 4 * sg + j_) * 1024 + 64 * h + 4 * p4); \
                                                         X##_bv[j_] = *(const u32x4*)(BC + (size_t)(r0_ + 4 * sg + j_) * 512 + 128 * g + 8 * n8); } } while (0)
#define SSD_LOADGC(step) do { int r0_, gid_; SSD_ROWS(step, r0_, gid_); const int t_ = 16 * wid + fr; const bf16_t* Gp_ = G + ((size_t)(gid_ * 2 + g) * 128 + t_) * 128 + 8 * fq; const bf16_t* Cp_ = BC + (size_t)(r0_ + t_) * 512 + 256 + 128 * g + 8 * fq; \
          _Pragma("unroll") for (int ks_ = 0; ks_ < 4; ++ks_) { n_gv[ks_] = *(const u32x4*)(Gp_ + 32 * ks_); n_cv[ks_] = *(const u32x4*)(Cp_ + 32 * ks_); } } while (0)
#define SSD_GCROT() do { _Pragma("unroll") for (int ks_ = 0; ks_ < 4; ++ks_) { c_gv[ks_] = n_gv[ks_]; c_cv[ks_] = n_cv[ks_]; } } while (0)
#define SSD_WRITE(step, X) do { LAS unsigned char* set_ = lds + ((step) & 1) * SET; \
        const float da0 = X##_da.x * a, da1 = X##_da.y * a; \
        float sc_ = da0 + da1; float c0_, c1_; \
        if (d == 0) { _Pragma("unroll") for (int o_ = 1; o_ < 64; o_ <<= 1) { const float t_ = __shfl_up(sc_, o_); if (lane >= o_) sc_ += t_; } \
            c0_ = sc_ - da1; c1_ = sc_; cend = __shfl(sc_, 63); } \
        else { _Pragma("unroll") for (int o_ = 1; o_ < 64; o_ <<= 1) { const float t_ = __shfl_down(sc_, o_); if (lane + o_ < 64) sc_ += t_; } \
            c0_ = sc_; c1_ = sc_ - da0; cend = __shfl(sc_, 0); } \
        *(LAS f32x2*)(cw + 2 * lane) = (f32x2){c0_, c1_}; *(LAS f32x2*)(dts + 2 * lane) = X##_da; \
        *(LAS f32x2*)(dtw + 2 * lane) = (f32x2){X##_da.x * __builtin_amdgcn_exp2f((cend - c0_) * L2E), X##_da.y * __builtin_amdgcn_exp2f((cend - c1_) * L2E)}; \
        { LAS unsigned char* xt_ = set_ + XT_OFF + (4 * p4) * PITCH + 8 * sg; \
          _Pragma("unroll") for (int i_ = 0; i_ < 4; ++i_) { unsigned e_[4]; \
              _Pragma("unroll") for (int j_ = 0; j_ < 4; ++j_) { const unsigned w_ = (i_ & 2) ? X##_xv[j_].y : X##_xv[j_].x; e_[j_] = (i_ & 1) ? (w_ >> 16) : (w_ & 0xffffu); } \
              u32x2 o_; o_.x = e_[0] | (e_[1] << 16); o_.y = e_[2] | (e_[3] << 16); *(LAS u32x2*)(xt_ + i_ * PITCH) = o_; } } \
        { LAS unsigned char* bt_ = set_ + BT_OFF + (8 * n8) * PITCH + 8 * sg; \
          _Pragma("unroll") for (int i_ = 0; i_ < 8; ++i_) { unsigned e_[4]; \
              _Pragma("unroll") for (int j_ = 0; j_ < 4; ++j_) { const unsigned w_ = X##_bv[j_][i_ >> 1]; e_[j_] = (i_ & 1) ? (w_ >> 16) : (w_ & 0xffffu); } \
              u32x2 o_; o_.x = e_[0] | (e_[1] << 16); o_.y = e_[2] | (e_[3] << 16); *(LAS u32x2*)(bt_ + i_ * PITCH) = o_; } } \
        asm volatile("s_waitcnt lgkmcnt(0)" ::: "memory"); \
    } while (0)
    SSD_LOAD(0, Q); SSD_LOADGC(0); SSD_WRITE(0, Q); SSD_LOAD(1, P);
    for (int step2 = 0; step2 < 66; step2 += 2)
#pragma unroll
    for (int par = 0; par < 2; ++par) {
        const int step = step2 + par;
        __syncthreads();
        int r0, gid; SSD_ROWS(step, r0, gid); (void)gid;
        LAS unsigned char* set = lds + (step & 1) * SET;
        const float cend_cur = cend;
        SSD_GCROT();
        if (step + 1 < 66) SSD_LOADGC(step + 1);
        if (step + 2 < 66) { if (par == 0) SSD_LOAD(step + 2, Q); else SSD_LOAD(step + 2, P); }
        {
            const int t = 16 * wid + fr; const float ct = cw[t];
            f32x4 y[4];
#pragma unroll
            for (int q = 0; q < 4; ++q) y[q] = (f32x4){0.f, 0.f, 0.f, 0.f};
            const float et = __builtin_amdgcn_exp2f(ct * L2E);
#pragma unroll
            for (int ks = 0; ks < 4; ++ks) {
                const bool live = d == 0 ? (32 * ks <= 16 * wid + 15) : (32 * ks + 31 >= 16 * wid);
                if (live) {
                    const int s0 = 32 * ks + 8 * fq;
                    const f32x4 c0 = *(const LAS f32x4*)(cw + s0), c1 = *(const LAS f32x4*)(cw + s0 + 4), d0v = *(const LAS f32x4*)(dts + s0), d1v = *(const LAS f32x4*)(dts + s0 + 4);
                    float m[8];
#pragma unroll
                    for (int i = 0; i < 8; ++i) { const float cs = i < 4 ? c0[i & 3] : c1[i & 3], dv = i < 4 ? d0v[i & 3] : d1v[i & 3]; const int s = s0 + i;
                        const bool ok = d == 0 ? (s <= t) : (s >= t);
                        const float gval = (i & 1) ? bfhi(c_gv[ks][i >> 1]) : bflo(c_gv[ks][i >> 1]);
                        m[i] = ok ? gval * dv * __builtin_amdgcn_exp2f((ct - cs) * L2E) : 0.f; }
                    u32x4 mw; mw.x = cvt_pk_bf16(m[0], m[1]); mw.y = cvt_pk_bf16(m[2], m[3]); mw.z = cvt_pk_bf16(m[4], m[5]); mw.w = cvt_pk_bf16(m[6], m[7]);
                    const bf16x8 mb = __builtin_bit_cast(bf16x8, mw);
#pragma unroll
                    for (int q = 0; q < 4; ++q) { const bf16x8 af = *(const LAS bf16x8*)(set + XT_OFF + (16 * q + fr) * PITCH + (32 * ks + 8 * fq) * 2);
                        y[q] = __builtin_amdgcn_mfma_f32_16x16x32_bf16(af, mb, y[q], 0, 0, 0); }
                }
            }
#pragma unroll
            for (int ks = 0; ks < 4; ++ks) {
                u32x4 cwv;
#pragma unroll
                for (int i = 0; i < 4; ++i) cwv[i] = cvt_pk_bf16(bflo(c_cv[ks][i]) * et, bfhi(c_cv[ks][i]) * et);
                const bf16x8 cb = __builtin_bit_cast(bf16x8, cwv);
#pragma unroll
                for (int q = 0; q < 4; ++q) { const bf16x8 af = *(const LAS bf16x8*)(set + HB_OFF + (16 * q + fr) * PITCH + (32 * ks + 8 * fq) * 2);
                    y[q] = __builtin_amdgcn_mfma_f32_16x16x32_bf16(af, cb, y[q], 0, 0, 0); }
            }
            bf16_t* yp = Y + (size_t)(r0 + t) * 1024 + 64 * h + 4 * fq;
#pragma unroll
            for (int q = 0; q < 4; ++q) { u32x2 w; w.x = cvt_pk_bf16(y[q][0], y[q][1]); w.y = cvt_pk_bf16(y[q][2], y[q][3]); *(u32x2*)(yp + 16 * q) = w; }
        }
        {
            const float dec = __builtin_amdgcn_exp2f(cend_cur * L2E);
#pragma unroll
            for (int q = 0; q < 4; ++q) hs[q] = hs[q] * dec;
#pragma unroll
            for (int ks = 0; ks < 4; ++ks) {
                const int s0 = 32 * ks + 8 * fq;
                const u32x4 braw = *(const LAS u32x4*)(set + BT_OFF + (16 * wid + fr) * PITCH + s0 * 2);
                const f32x4 w0 = *(const LAS f32x4*)(dtw + s0), w1 = *(const LAS f32x4*)(dtw + s0 + 4);
                u32x4 bw; bw.x = cvt_pk_bf16(bflo(braw.x) * w0[0], bfhi(braw.x) * w0[1]); bw.y = cvt_pk_bf16(bflo(braw.y) * w0[2], bfhi(braw.y) * w0[3]);
                          bw.z = cvt_pk_bf16(bflo(braw.z) * w1[0], bfhi(braw.z) * w1[1]); bw.w = cvt_pk_bf16(bflo(braw.w) * w1[2], bfhi(braw.w) * w1[3]);
                const bf16x8 bfr = __builtin_bit_cast(bf16x8, bw);
#pragma unroll
                for (int q = 0; q < 4; ++q) { const bf16x8 af = *(const LAS bf16x8*)(set + XT_OFF + (16 * q + fr) * PITCH + s0 * 2);
                    hs[q] = __builtin_amdgcn_mfma_f32_16x16x32_bf16(af, bfr, hs[q], 0, 0, 0); }
            }
            LAS bf16_t* hb = (LAS bf16_t*)(lds + ((step + 1) & 1) * SET + HB_OFF) + 16 * wid + fr;
#pragma unroll
            for (int q = 0; q < 4; ++q)
#pragma unroll
                for (int i = 0; i < 4; ++i) hb[(16 * q + 4 * fq + i) * 136] = f2bf(hs[q][i]);
        }
        if (step + 1 < 66) { if (par == 0) SSD_WRITE(step + 1, P); else SSD_WRITE(step + 1, Q); }
    }
    __syncthreads();
#undef SSD_ROWS
#undef SSD_LOAD
#undef SSD_LOADGC
#undef SSD_GCROT
#undef SSD_WRITE
}
}

struct Args { const float* in[32]; float* out; unsigned char* ws; int ph_lo, ph_hi; };
constexpr int NTHR = 512;
constexpr int LDS_BASE = 256;
constexpr int LDS_PHASE = 151808;
constexpr int LDS_BYTES = LDS_BASE + LDS_PHASE;
static_assert(att::LDS_BYTES <= LDS_PHASE && att8::LDS_BYTES <= LDS_PHASE && ssd::LDS_BYTES <= LDS_PHASE && pg8::STAGE_BYTES <= LDS_PHASE, "LDS");

__device__ __forceinline__ void tjob(int j, const Args& A, const float*& src, bf16_t*& dst, int& K, int& N, int& Npad, int& mode, const float*& ks) {
    unsigned char* W = A.ws + WS_W; mode = 0; ks = nullptr;
    if (j < 8) { const int i = j >> 2, w = j & 3; unsigned char* base = W + W_HYB + (size_t)i * WH_SZ;
        if (w == 0)      { src = A.in[I_HWIN] + (size_t)i * 1024 * HYB_IN; dst = (bf16_t*)(base + WH_IN); K = 1024; N = HYB_IN; Npad = HYB_INP; mode = 1; }
        else if (w == 1) { src = A.in[I_WQB] + (size_t)i * 384 * 1536; dst = (bf16_t*)(base + WH_QB); K = 384; N = 1536; Npad = 1536; mode = 2; ks = A.in[I_QNG] + i * 384; }
        else if (w == 2) { src = A.in[I_WKVB] + (size_t)i * 256 * 2048; dst = (bf16_t*)(base + WH_KVB); K = 256; N = 2048; Npad = 2048; ks = A.in[I_KVNG] + i * 256; }
        else             { src = A.in[I_HWOUT] + (size_t)i * 2048 * 1024; dst = (bf16_t*)(base + WH_OUT); K = 2048; N = 1024; Npad = 1024; }
    } else if (j < 12) { const int i = (j - 8) >> 1, w = (j - 8) & 1; unsigned char* base = W + W_GM + (size_t)i * WG_SZ;
        if (w == 0) { src = A.in[I_GWIN] + (size_t)i * 1024 * 4096; dst = (bf16_t*)(base + WG_IN); K = 1024; N = 4096; Npad = 4096; }
        else        { src = A.in[I_GWOUT] + (size_t)i * 2048 * 1024; dst = (bf16_t*)(base + WG_OUT); K = 2048; N = 1024; Npad = 1024; }
    } else { const int l = j - 12; src = A.in[I_PWQ] + (size_t)l * 1024 * 2048; dst = (bf16_t*)(W + W_PEER + (size_t)l * WP_SZ + WP_Q); K = 1024; N = 2048; Npad = 2048; }
}
__device__ __forceinline__ int colmap(int mode, int n, int N) {
    if (mode == 1) { if (n >= N) return -1; if (n < C_KR) return n; const int m = n - C_KR; return C_KR + (m >> 1) + 32 * (m & 1); }
    if (mode == 2) { if (n < 1024) return (n >> 7) * 192 + (n & 127); const int m = n - 1024, h = m >> 6, mm = m & 63; return h * 192 + 128 + (mm >> 1) + 32 * (mm & 1); }
    return n;
}
__device__ __forceinline__ void phase_prologue(const Args& A, LAS unsigned char* lds) {
    const int tid = otid();
    {
        LAS float* tile = (LAS float*)lds;
        int item = blockIdx.x;
        for (int j = 0; j < 16; ++j) {
            const float* src; bf16_t* dst; int K, N, Npad, mode; const float* ks; tjob(j, A, src, dst, K, N, Npad, mode, ks);
            const int nsub = (K % 256 == 0) ? 4 : 2, tk = K / (64 * nsub), tn = Npad / 64, nt = tk * tn;
            for (; item < nt; item += gridDim.x) {
                const int k0 = (item % tk) * 64 * nsub, n0 = (item / tk) * 64;
                { const int k = tid >> 3, cg = tid & 7; float v[4][8];
#pragma unroll
                  for (int t = 0; t < 4; ++t) if (t < nsub) { const float sc = ks ? ks[k0 + 64 * t + k] : 1.f;
#pragma unroll
                      for (int jj = 0; jj < 8; ++jj) { const int oc = colmap(mode, n0 + 8 * cg + jj, N); v[t][jj] = oc >= 0 ? src[(size_t)(k0 + 64 * t + k) * N + oc] * sc : 0.f; } }
#pragma unroll
                  for (int t = 0; t < 4; ++t) if (t < nsub) {
#pragma unroll
                      for (int jj = 0; jj < 8; ++jj) tile[t * 4160 + k * 65 + 8 * cg + jj] = v[t][jj]; } }
                __syncthreads();
                { const int n = tid >> 3, kg = tid & 7;
#pragma unroll
                  for (int t = 0; t < 4; ++t) if (t < nsub) { float v[8];
#pragma unroll
                      for (int jj = 0; jj < 8; ++jj) v[jj] = tile[t * 4160 + (8 * kg + jj) * 65 + n];
                      u32x4 w; w.x = cvt_pk_bf16(v[0], v[1]); w.y = cvt_pk_bf16(v[2], v[3]); w.z = cvt_pk_bf16(v[4], v[5]); w.w = cvt_pk_bf16(v[6], v[7]);
                      *(u32x4*)(dst + (size_t)(n0 + n) * K + k0 + 64 * t + 8 * kg) = w; } }
                __syncthreads();
            }
            item -= nt;
        }
    }
    {
        const int gthr = blockIdx.x * NTHR + tid, nthr = gridDim.x * NTHR;
        for (int p = gthr; p < 10 * 16384; p += nthr) {
            const int mat = p >> 14, off = (p & 16383) * 8; const float* src; bf16_t* dst;
            if (mat < 2)      { src = A.in[I_GWS] + (size_t)mat * 131072; dst = (bf16_t*)(A.ws + WS_W + W_GM + (size_t)mat * WG_SZ + WG_WS); }
            else if (mat < 6) { src = A.in[I_PK1] + (size_t)(mat - 2) * 131072; dst = (bf16_t*)(A.ws + WS_W + W_PEER + (size_t)(mat - 2) * WP_SZ + WP_K1); }
            else              { src = A.in[I_PK2] + (size_t)(mat - 6) * 131072; dst = (bf16_t*)(A.ws + WS_W + W_PEER + (size_t)(mat - 6) * WP_SZ + WP_K2); }
            const f32x4 a = *(const f32x4*)(src + off), b = *(const f32x4*)(src + off + 4);
            u32x4 w; w.x = cvt_pk_bf16(a[0], a[1]); w.y = cvt_pk_bf16(a[2], a[3]); w.z = cvt_pk_bf16(b[0], b[1]); w.w = cvt_pk_bf16(b[2], b[3]);
            *(u32x4*)(dst + off) = w;
        }
        float* rope = (float*)(A.ws + WS_ROPE);
        for (int p = gthr; p < SEQ * 32; p += nthr) { const int l = p >> 5, i = p & 31; const float pos = (float)(i < 16 ? (l >> 6) : (l & 63));
            const float inv = powf(10000.f, -(float)(i & 15) / 16.f), ang = pos * inv; rope[p] = cosf(ang); rope[SEQ * 32 + p] = sinf(ang); }
    }
    {
        LAS float* scond = (LAS float*)lds;
        LAS float* red = scond + 5 * 1024;
        __syncthreads();
        for (int i = tid; i < 5 * 1024; i += NTHR) { const int m = i >> 10, k = i & 1023; const float c = m < 4 ? A.in[I_C][m * 1024 + k] : A.in[I_CCTX][k]; scond[i] = silu_f(c); }
        __syncthreads();
        float* MOD = (float*)(A.ws + WS_MOD);
        for (int item = blockIdx.x; item < 4 * 48; item += gridDim.x) {
            const int layer = item / 48, j0 = (item % 48) * 128; const int c4 = tid & 31, ksl = tid >> 5;
            f32x4 acc[5];
#pragma unroll
            for (int m = 0; m < 5; ++m) acc[m] = (f32x4){0.f, 0.f, 0.f, 0.f};
            const float* wp = A.in[I_ADAW] + ((size_t)layer * 1024 + ksl * 64) * 6144 + j0 + 4 * c4;
            for (int k = 0; k < 64; ++k) { const f32x4 w = *(const f32x4*)(wp + (size_t)k * 6144);
#pragma unroll
                for (int m = 0; m < 5; ++m) acc[m] += w * scond[m * 1024 + ksl * 64 + k]; }
#pragma unroll
            for (int m = 0; m < 5; ++m) *(LAS f32x4*)(red + (ksl * 5 + m) * 128 + 4 * c4) = acc[m];
            __syncthreads();
            for (int i = tid; i < 640; i += NTHR) { const int m = i >> 7, c = i & 127; float s = A.in[I_ADAB][layer * 6144 + j0 + c];
#pragma unroll
                for (int q = 0; q < 16; ++q) s += red[(q * 5 + m) * 128 + c];
                MOD[((size_t)layer * 5 + m) * 6144 + j0 + c] = s; }
            __syncthreads();
        }
    }
}

__device__ __forceinline__ void phase_norm_mod(const float* xl, const float* xc, float* cl, float* cc, const float* g, const float* modl, int sh_idx, bf16_t* H, int nrows) {
    const int tid_ = otid(); const int lane = tid_ & 63, gw = blockIdx.x * 8 + (tid_ >> 6), nw = gridDim.x * 8;
    f32x4 gv[4];
#pragma unroll
    for (int i = 0; i < 4; ++i) gv[i] = *(const f32x4*)(g + 256 * i + 4 * lane);
    for (int r = gw; r < nrows; r += nw) {
        const bool lat = r < NLAT; const float* xp = lat ? xl + (size_t)r * D : xc + (size_t)(r - NLAT) * D;
        f32x4 x[4]; float ss = 0.f;
#pragma unroll
        for (int i = 0; i < 4; ++i) { x[i] = *(const f32x4*)(xp + 256 * i + 4 * lane); ss += x[i][0] * x[i][0] + x[i][1] * x[i][1] + x[i][2] * x[i][2] + x[i][3] * x[i][3]; }
        if (cl) { float* cp = lat ? cl + (size_t)r * D : cc + (size_t)(r - NLAT) * D;
#pragma unroll
            for (int i = 0; i < 4; ++i) *(f32x4*)(cp + 256 * i + 4 * lane) = x[i]; }
        ss = wave_sum(ss); const float rstd = rsqrtf(ss * (1.f / 1024.f) + EPS);
        const float* mp = modl + (size_t)(lat ? (r >> 13) : 4) * 6144 + sh_idx * 1024;
#pragma unroll
        for (int i = 0; i < 4; ++i) { const f32x4 sh = *(const f32x4*)(mp + 256 * i + 4 * lane), sc = *(const f32x4*)(mp + 1024 + 256 * i + 4 * lane);
            const f32x4 hv = (x[i] * rstd) * gv[i] * (sc + 1.f) + sh;
            u32x2 w; w.x = cvt_pk_bf16(hv[0], hv[1]); w.y = cvt_pk_bf16(hv[2], hv[3]);
            *(u32x2*)(H + (size_t)r * D + 256 * i + 4 * lane) = w; }
    }
}
__device__ __forceinline__ void phase_final_norm(float* xl, const float* g, float oscale) {
    const int tid_ = otid(); const int lane = tid_ & 63, gw = blockIdx.x * 8 + (tid_ >> 6), nw = gridDim.x * 8;
    f32x4 gv[4];
#pragma unroll
    for (int i = 0; i < 4; ++i) gv[i] = *(const f32x4*)(g + 256 * i + 4 * lane);
    for (int r = gw; r < NLAT; r += nw) {
        float* xp = xl + (size_t)r * D; f32x4 x[4]; float ss = 0.f;
#pragma unroll
        for (int i = 0; i < 4; ++i) { x[i] = *(const f32x4*)(xp + 256 * i + 4 * lane); ss += x[i][0] * x[i][0] + x[i][1] * x[i][1] + x[i][2] * x[i][2] + x[i][3] * x[i][3]; }
        ss = wave_sum(ss); const float rstd = rsqrtf(ss * (1.f / 1024.f) + EPS);
#pragma unroll
        for (int i = 0; i < 4; ++i) *(f32x4*)(xp + 256 * i + 4 * lane) = (x[i] * (rstd * oscale)) * gv[i];
    }
}

__device__ __forceinline__ void phase_conv(const Args& A, int li) {
    const bf16_t* PROJ = (const bf16_t*)(A.ws + WS_BIG);
    bf16_t* XS = (bf16_t*)(A.ws + WS_R2); bf16_t* BC = (bf16_t*)(A.ws + WS_R2 + R2_BC);
    const int tid = otid();
    {
        for (int item = blockIdx.x * 3; item < (NROW / 64) * 3; item += gridDim.x * 3)
#pragma unroll 1
        for (int sub = 0; sub < 3; ++sub) {
            const int blk = (item + sub) / 3, q = ((item + sub) % 3) * 512 + tid, cg = q % 192, rg = q / 192, c0 = 8 * cg;
            const int rbeg = blk * 64 + rg * 8; int s0, s1;
            if (rbeg < NLAT) { s0 = rbeg & ~8191; s1 = s0 + 8192; } else { s0 = NLAT + ((rbeg - NLAT) & ~255); s1 = s0 + 256; }
            const float* cw = A.in[I_CONVW] + ((size_t)li * 1536 + c0) * 5; const float* cb = A.in[I_CONVB] + (size_t)li * 1536 + c0;
            u32x4 in[12];
#pragma unroll
            for (int i = 0; i < 12; ++i) { const int r = rbeg - 2 + i; in[i] = (r >= s0 && r < s1) ? *(const u32x4*)(PROJ + (size_t)r * HYB_INP + C_XBC + c0) : (u32x4){0u, 0u, 0u, 0u}; }
            float w[8][5], bia[8];
#pragma unroll
            for (int j = 0; j < 8; ++j) { bia[j] = cb[j];
#pragma unroll
                for (int k = 0; k < 5; ++k) w[j][k] = cw[j * 5 + k]; }
#pragma unroll
            for (int rr = 0; rr < 8; ++rr) {
                float o[8];
#pragma unroll
                for (int j = 0; j < 8; ++j) { float sacc = bia[j];
#pragma unroll
                    for (int k = 0; k < 5; ++k) { const unsigned wd = in[rr + k][j >> 1]; sacc += w[j][k] * ((j & 1) ? bfhi(wd) : bflo(wd)); }
                    o[j] = silu_f(sacc); }
                u32x4 pk; pk.x = cvt_pk_bf16(o[0], o[1]); pk.y = cvt_pk_bf16(o[2], o[3]); pk.z = cvt_pk_bf16(o[4], o[5]); pk.w = cvt_pk_bf16(o[6], o[7]);
                const int r = rbeg + rr;
                if (c0 < 1024) *(u32x4*)(XS + (size_t)r * 1024 + c0) = pk; else *(u32x4*)(BC + (size_t)r * 512 + (c0 - 1024)) = pk;
            }
        }
    }
    {
        const int lane = tid & 63, gw = blockIdx.x * 8 + (tid >> 6), nw = gridDim.x * 8;
        float* DT = (float*)(A.ws + WS_BIG + BIG_DT); float* RQ = (float*)(A.ws + WS_RSTD); float* RKV = RQ + NROW;
        unsigned char* KR = A.ws + WS_BIG + BIG_KR; const float* rope = (const float*)(A.ws + WS_ROPE);
        const float dtb = lane < 32 ? A.in[I_DTB][li * 32 + lane] : 0.f;
        for (int rb = gw * 4; rb < NROW; rb += nw * 4) {
            unsigned wq[4][3]; u32x2 wk[4]; unsigned wr_[4]; float dtv[4], rc[4], rsn[4];
#pragma unroll
            for (int i = 0; i < 4; ++i) { const int r = rb + i; const bf16_t* p = PROJ + (size_t)r * HYB_INP;
                const unsigned* q = (const unsigned*)(p + C_CQ + 6 * lane); wq[i][0] = q[0]; wq[i][1] = q[1]; wq[i][2] = q[2];
                wk[i] = *(const u32x2*)(p + C_CKV + 4 * lane);
                dtv[i] = lane < 32 ? bf2f(p[C_DT + (lane & 15)]) : 0.f; wr_[i] = lane < 32 ? *(const unsigned*)(p + C_KR + 2 * lane) : 0u;
                const int l = r & 8191; rc[i] = (lane < 32 && r < NLAT) ? rope[l * 32 + lane] : 1.f; rsn[i] = (lane < 32 && r < NLAT) ? rope[SEQ * 32 + l * 32 + lane] : 0.f; }
#pragma unroll
            for (int i = 0; i < 4; ++i) { const int r = rb + i;
                if (lane < 32) DT[(size_t)lane * NROW + r] = softplus_f(dtv[i] + dtb);
                { float ss = 0.f;
#pragma unroll
                  for (int j = 0; j < 3; ++j) { const float a = bflo(wq[i][j]), b = bfhi(wq[i][j]); ss += a * a + b * b; }
                  ss = wave_sum(ss); if (lane == 0) RQ[r] = rsqrtf(ss * (1.f / 384.f) + EPS); }
                { const float a = bflo(wk[i].x), b = bfhi(wk[i].x), c = bflo(wk[i].y), d = bfhi(wk[i].y);
                  float ss = a * a + b * b + c * c + d * d; ss = wave_sum(ss); if (lane == 0) RKV[r] = rsqrtf(ss * (1.f / 256.f) + EPS); }
                if (lane < 32) { const float x1 = bflo(wr_[i]), x2 = bfhi(wr_[i]); int b, key;
                    const float o1 = x1 * rc[i] - x2 * rsn[i], o2 = x1 * rsn[i] + x2 * rc[i];
                    if (r < NLAT) { b = r >> 13; key = 256 + (r & 8191); } else { b = (r - NLAT) >> 8; key = (r - NLAT) & 255; }
                    int w8 = 0; w8 = __builtin_amdgcn_cvt_pk_fp8_f32(sat8(o1), sat8(o2), w8, false);
                    *(unsigned short*)(KR + (size_t)(b * NKT + (key >> 6)) * 4096 + att8::kr8(key & 63, 2 * lane)) = (unsigned short)(w8 & 0xffff); }
            }
        }
    }
}

struct EpiQ {
    static constexpr bool PERM = true;
    unsigned char* Q; const float* rstd; const float* rope;
    __device__ __forceinline__ void operator()(const f32x4 (&acc)[2][2][4][2], const pg8::Unit& u, int wr, int wc, int fr, int fq) const {
        const bool lat = u.pm < 128;
        const int b = lat ? (u.pm >> 5) : (u.pm - 128), q0 = lat ? 256 + ((u.pm & 31) << 8) : 0;
        const bool isrope = u.pn >= 4;
#pragma unroll
        for (int ai = 0; ai < 2; ++ai) {
            const int rl = 128 * ai + 64 * wr + fr;
            const float* rsp = rstd + u.pm * 256 + rl;
            const float* rp = rope + (size_t)(((u.pm & 31) << 8) + rl) * 32;
#pragma unroll
            for (int bj = 0; bj < 2; ++bj) {
                const int c0 = u.pn * 256 + 128 * bj + 32 * wc + 8 * fq; int h, dcol;
                if (!isrope) { h = c0 >> 7; dcol = c0 & 127; } else { const int mq = c0 - 1024; h = mq >> 6; dcol = 128 + (mq & 63); }
                unsigned char* dst = Q + ((size_t)(b * 8 + h) * NKEY + q0 + rl) * 192 + dcol;
                const int ro = (dcol - 128) >> 1;
#pragma unroll
                for (int m = 0; m < 4; ++m) {
                    const float rs = rsp[16 * m] * (QSCALE * att8::QUP);
                    f32x4 v0 = acc[ai][bj][m][0] * rs, v1 = acc[ai][bj][m][1] * rs;
                    if (isrope && lat) { const f32x4 cs = *(const f32x4*)(rp + 16 * m * 32 + ro), sn = *(const f32x4*)(rp + SEQ * 32 + 16 * m * 32 + ro);
                        const f32x4 a0 = v0, a1 = v1;
                        v0[0] = a0[0] * cs[0] - a0[1] * sn[0]; v0[1] = a0[0] * sn[0] + a0[1] * cs[0]; v0[2] = a0[2] * cs[1] - a0[3] * sn[1]; v0[3] = a0[2] * sn[1] + a0[3] * cs[1];
                        v1[0] = a1[0] * cs[2] - a1[1] * sn[2]; v1[1] = a1[0] * sn[2] + a1[1] * cs[2]; v1[2] = a1[2] * cs[3] - a1[3] * sn[3]; v1[3] = a1[2] * sn[3] + a1[3] * cs[3]; }
                    u32x2 w; w.x = pk4_fp8_sat(v0[0], v0[1], v0[2], v0[3]); w.y = pk4_fp8_sat(v1[0], v1[1], v1[2], v1[3]);
                    *(u32x2*)(dst + 16 * m * 192) = w;
                    asm volatile("" ::: "memory");
                }
            }
        }
    }
};
struct EpiKV {
    static constexpr bool PERM = true;
    unsigned char* KN; unsigned char* V; const float* rstd;
    __device__ __forceinline__ void operator()(const f32x4 (&acc)[2][2][4][2], const pg8::Unit& u, int wr, int wc, int fr, int fq) const {
        const bool lat = u.pm < 128;
        const int b = lat ? (u.pm >> 5) : (u.pm - 128), t0 = lat ? 4 + ((u.pm & 31) << 2) : 0;
        const int dd = 32 * wc + 8 * fq;
        const int offK = fr * 128 + ((((dd >> 4) ^ ((fr >> 1) & 7))) << 4) + (dd & 15);
#pragma unroll
        for (int ai = 0; ai < 2; ++ai) {
            const size_t tb = ((size_t)(b * 8 + u.pn) * NKT + t0 + 2 * ai + wr) * 8192;
            const float* rsp = rstd + u.pm * 256 + 128 * ai + 64 * wr + fr;
            unsigned char* kp = KN + tb + offK; unsigned char* vp = V + tb;
#pragma unroll
            for (int m = 0; m < 4; ++m) {
                const float rs = rsp[16 * m];
                { const f32x4 v0 = acc[ai][0][m][0] * rs, v1 = acc[ai][0][m][1] * rs; u32x2 w; w.x = pk4_fp8_sat(v0[0], v0[1], v0[2], v0[3]); w.y = pk4_fp8_sat(v1[0], v1[1], v1[2], v1[3]);
                  *(u32x2*)(kp + m * 2048) = w; }
                { const f32x4 v0 = acc[ai][1][m][0] * rs, v1 = acc[ai][1][m][1] * rs; const unsigned w0 = pk4_fp8_sat(v0[0], v0[1], v0[2], v0[3]), w1 = pk4_fp8_sat(v1[0], v1[1], v1[2], v1[3]);
                  const int sl = att8::vslot(16 * m + fr);
#pragma unroll
                  for (int i = 0; i < 8; ++i) { const int d = dd + i; vp[d * 64 + ((((sl >> 4) ^ ((d >> 2) & 3))) << 4) + (sl & 15)] = (unsigned char)(((i < 4 ? w0 : w1) >> (8 * (i & 3))) & 0xffu); } }
                asm volatile("" ::: "memory");
            }
        }
    }
};

__device__ __forceinline__ void phase_ssd_out(const Args& A, int li, int nrows) {
    const bf16_t* PROJ = (const bf16_t*)(A.ws + WS_BIG); const bf16_t* XS = (const bf16_t*)(A.ws + WS_R2);
    const bf16_t* Y0 = (const bf16_t*)(A.ws + WS_H); const bf16_t* Y1 = (const bf16_t*)(A.ws + WS_R3); bf16_t* CAT = (bf16_t*)(A.ws + WS_R3 + R3_CAT);
    const int tid_ = otid(); const int lane = tid_ & 63, gw = blockIdx.x * 8 + (tid_ >> 6), nw = gridDim.x * 8;
    const float dsk = A.in[I_SSDD][li * 16 + (lane >> 2)];
    float ng[16];
#pragma unroll
    for (int j = 0; j < 16; ++j) ng[j] = A.in[I_SSDNG][li * 1024 + 16 * lane + j];
    for (int r = gw; r < nrows; r += nw) {
        float v[16]; float ss = 0.f;
#pragma unroll
        for (int hh = 0; hh < 2; ++hh) {
            const u32x4 a = *(const u32x4*)(Y0 + (size_t)r * 1024 + 16 * lane + 8 * hh), b = *(const u32x4*)(Y1 + (size_t)r * 1024 + 16 * lane + 8 * hh);
            const u32x4 x = *(const u32x4*)(XS + (size_t)r * 1024 + 16 * lane + 8 * hh), z = *(const u32x4*)(PROJ + (size_t)r * HYB_INP + 16 * lane + 8 * hh);
#pragma unroll
            for (int q = 0; q < 4; ++q) {
                const float y0 = (bflo(a[q]) + bflo(b[q]) + dsk * bflo(x[q])) * silu_f(bflo(z[q])), y1 = (bfhi(a[q]) + bfhi(b[q]) + dsk * bfhi(x[q])) * silu_f(bfhi(z[q]));
                v[8 * hh + 2 * q] = y0; v[8 * hh + 2 * q + 1] = y1; ss += y0 * y0 + y1 * y1; }
        }
#pragma unroll
        for (int o = 16; o >= 1; o >>= 1) ss += __shfl_xor(ss, o);
        const float rstd = rsqrtf(ss * (1.f / 512.f) + EPS);
#pragma unroll
        for (int hh = 0; hh < 2; ++hh) { u32x4 w;
#pragma unroll
            for (int q = 0; q < 4; ++q) w[q] = cvt_pk_bf16(v[8 * hh + 2 * q] * rstd * ng[8 * hh + 2 * q], v[8 * hh + 2 * q + 1] * rstd * ng[8 * hh + 2 * q + 1]);
            *(u32x4*)(CAT + (size_t)r * 2048 + 16 * lane + 8 * hh) = w; }
    }
}

__device__ __forceinline__ void phase_ln_stats(const Args& A, int nrows) {
    const bf16_t* Gb = (const bf16_t*)(A.ws + WS_BIG); float* ST = (float*)(A.ws + WS_RSTD);
    const int tid_ = otid(); const int lane = tid_ & 63, gw = blockIdx.x * 8 + (tid_ >> 6), nw = gridDim.x * 8;
    for (int r = gw; r < nrows; r += nw) {
        float v[32]; float s = 0.f;
#pragma unroll
        for (int j = 0; j < 4; ++j) { const u32x4 w = *(const u32x4*)(Gb + (size_t)r * 4096 + 2048 + 512 * j + 8 * lane);
#pragma unroll
            for (int q = 0; q < 4; ++q) { v[8 * j + 2 * q] = bflo(w[q]); v[8 * j + 2 * q + 1] = bfhi(w[q]); s += v[8 * j + 2 * q] + v[8 * j + 2 * q + 1]; } }
        s = wave_sum(s); const float mu = s * (1.f / 2048.f); float q2 = 0.f;
#pragma unroll
        for (int j = 0; j < 32; ++j) { const float dd = v[j] - mu; q2 += dd * dd; }
        q2 = wave_sum(q2);
        if (lane == 0) { ST[r] = mu; ST[NROW + r] = rsqrtf(q2 * (1.f / 2048.f) + EPS); }
    }
}
__device__ __forceinline__ void phase_spatial(const Args& A, int gi, int nrows, LAS unsigned char* lds) {
    const bf16_t* Gb = (const bf16_t*)(A.ws + WS_BIG); const float* ST = (const float*)(A.ws + WS_RSTD); bf16_t* Ab = (bf16_t*)(A.ws + WS_R1);
    const bf16_t* WSg = (const bf16_t*)(A.ws + WS_W + W_GM + (size_t)gi * WG_SZ + WG_WS);
    const float* lng = A.in[I_GLNG] + (size_t)gi * 2048; const float* lnb = A.in[I_GLNB] + (size_t)gi * 2048; const float* bs = A.in[I_GBS] + (size_t)gi * 1024;
    const int tid = otid(), wid = tid >> 6, lane = tid & 63, r32 = lane & 31, hi = lane >> 5, tb = wid & 3, dh = wid >> 2;
    const int ldsaddr = (int)(unsigned)(uintptr_t)lds;
    u32x4 nv[8]; float nmu[8], nrs[8];
    const int nunits = (nrows / 128) * 8;
#define SP_LOADV(un) do { const int cb_ = (un) >> 3, gg_ = (un) & 7, r0_ = cb_ * 128; \
        _Pragma("unroll") for (int j = 0; j < 8; ++j) { const int idx = tid + 512 * j, s_ = idx >> 5, dd_ = (idx & 31) * 8; \
            nv[j] = *(const u32x4*)(Gb + (size_t)(r0_ + s_) * 4096 + 2048 + 256 * gg_ + dd_); nmu[j] = ST[r0_ + s_]; nrs[j] = ST[NROW + r0_ + s_]; } } while (0)
    if ((int)blockIdx.x < nunits) SP_LOADV((int)blockIdx.x);
    for (int unit = blockIdx.x; unit < nunits; unit += gridDim.x) {
        const int cb = unit >> 3, gg = unit & 7, r0 = cb * 128;
        __syncthreads();
#pragma unroll
        for (int j = 0; j < 8; ++j) { const int idx = tid + 512 * j, s = idx >> 5, dd = (idx & 31) * 8;
            const u32x4 w = nv[j];
            const float mu = nmu[j], rs = nrs[j];
            const f32x4 g0 = *(const f32x4*)(lng + 256 * gg + dd), g1 = *(const f32x4*)(lng + 256 * gg + dd + 4), b0 = *(const f32x4*)(lnb + 256 * gg + dd), b1 = *(const f32x4*)(lnb + 256 * gg + dd + 4);
            u32x4 o;
            o.x = cvt_pk_bf16((bflo(w.x) - mu) * rs * g0[0] + b0[0], (bfhi(w.x) - mu) * rs * g0[1] + b0[1]); o.y = cvt_pk_bf16((bflo(w.y) - mu) * rs * g0[2] + b0[2], (bfhi(w.y) - mu) * rs * g0[3] + b0[3]);
            o.z = cvt_pk_bf16((bflo(w.z) - mu) * rs * g1[0] + b1[0], (bfhi(w.z) - mu) * rs * g1[1] + b1[1]); o.w = cvt_pk_bf16((bflo(w.w) - mu) * rs * g1[2] + b1[2], (bfhi(w.w) - mu) * rs * g1[3] + b1[3]);
            *(LAS u32x4*)(lds + ((s >> 6) * 2 + (dd >> 7)) * 16384 + att::v_st(s & 63, dd & 127)) = o; }
        u32x2 uu[4][4];
        { const bf16_t* up = Gb + (size_t)(r0 + 32 * tb + r32) * 4096 + 256 * gg + 128 * dh + 4 * hi;
#pragma unroll
          for (int d0 = 0; d0 < 4; ++d0)
#pragma unroll
              for (int k = 0; k < 4; ++k) uu[d0][k] = *(const u32x2*)(up + 32 * d0 + 8 * k); }
        if (unit + (int)gridDim.x < nunits) SP_LOADV(unit + (int)gridDim.x);
        bf16x8 pa[8];
#pragma unroll
        for (int ks = 0; ks < 8; ++ks) pa[ks] = *(const bf16x8*)(WSg + ((size_t)gg * 128 + 32 * tb + r32) * 128 + 16 * ks + 8 * hi);
        __syncthreads();
        f32x16 o[4] = {};
#define SP_PV(D0, vbase, p0, p1, p2, p3) do { \
            const s16x4 l0 = att::tr_read<att::v_rd_off(D0, 0, 0)>(vbase), h0 = att::tr_read<att::v_rd_off(D0, 0, 1)>(vbase), l1 = att::tr_read<att::v_rd_off(D0, 1, 0)>(vbase), h1 = att::tr_read<att::v_rd_off(D0, 1, 1)>(vbase); \
            const s16x4 l2 = att::tr_read<att::v_rd_off(D0, 2, 0)>(vbase), h2 = att::tr_read<att::v_rd_off(D0, 2, 1)>(vbase), l3 = att::tr_read<att::v_rd_off(D0, 3, 0)>(vbase), h3 = att::tr_read<att::v_rd_off(D0, 3, 1)>(vbase); \
            asm volatile("s_waitcnt lgkmcnt(0)" ::: "memory"); __builtin_amdgcn_sched_barrier(0); \
            o[D0] = __builtin_amdgcn_mfma_f32_32x32x16_bf16((bf16x8){l0[0], l0[1], l0[2], l0[3], h0[0], h0[1], h0[2], h0[3]}, p0, o[D0], 0, 0, 0); \
            o[D0] = __builtin_amdgcn_mfma_f32_32x32x16_bf16((bf16x8){l1[0], l1[1], l1[2], l1[3], h1[0], h1[1], h1[2], h1[3]}, p1, o[D0], 0, 0, 0); \
            o[D0] = __builtin_amdgcn_mfma_f32_32x32x16_bf16((bf16x8){l2[0], l2[1], l2[2], l2[3], h2[0], h2[1], h2[2], h2[3]}, p2, o[D0], 0, 0, 0); \
            o[D0] = __builtin_amdgcn_mfma_f32_32x32x16_bf16((bf16x8){l3[0], l3[1], l3[2], l3[3], h3[0], h3[1], h3[2], h3[3]}, p3, o[D0], 0, 0, 0); } while (0)
        { const int vb0 = ldsaddr + (0 * 2 + dh) * 16384 + att::v_rd_base(lane), vb1 = ldsaddr + (1 * 2 + dh) * 16384 + att::v_rd_base(lane);
          SP_PV(0, vb0, pa[0], pa[1], pa[2], pa[3]); SP_PV(1, vb0, pa[0], pa[1], pa[2], pa[3]); SP_PV(2, vb0, pa[0], pa[1], pa[2], pa[3]); SP_PV(3, vb0, pa[0], pa[1], pa[2], pa[3]);
          SP_PV(0, vb1, pa[4], pa[5], pa[6], pa[7]); SP_PV(1, vb1, pa[4], pa[5], pa[6], pa[7]); SP_PV(2, vb1, pa[4], pa[5], pa[6], pa[7]); SP_PV(3, vb1, pa[4], pa[5], pa[6], pa[7]); }
#undef SP_PV
        { const int t = 32 * tb + r32, row = r0 + t; const float bsv = bs[gg * 128 + t];
          bf16_t* ap = Ab + (size_t)row * 2048 + 256 * gg + 128 * dh + 4 * hi;
#pragma unroll
          for (int d0 = 0; d0 < 4; ++d0)
#pragma unroll
              for (int k = 0; k < 4; ++k) {
                  const u32x2 u2 = uu[d0][k];
                  u32x2 w; w.x = cvt_pk_bf16(bflo(u2.x) * (o[d0][4 * k] + bsv), bfhi(u2.x) * (o[d0][4 * k + 1] + bsv)); w.y = cvt_pk_bf16(bflo(u2.y) * (o[d0][4 * k + 2] + bsv), bfhi(u2.y) * (o[d0][4 * k + 3] + bsv));
                  *(u32x2*)(ap + 32 * d0 + 8 * k) = w; } }
    }
#undef SP_LOADV
}

constexpr int NSL = 8, SW = 1024 / NSL;
constexpr size_t TAB8_HALF = (size_t)NEXP * 1024, TAB_SCL = 2 * TAB8_HALF;
constexpr float HS = 4.f;
__device__ __forceinline__ void phase_tabcvt(const Args& A, int layer, int wg, int nwg) {
    const int tid_ = otid(); const int lane = tid_ & 63, gw = wg * 8 + (tid_ >> 6), nw = nwg * 8;
    float* SCL = (float*)(A.ws + WS_TAB + TAB_SCL);
    for (int r = gw; r < 2 * NEXP; r += nw) {
        const int tab = r >> 14, e = r & (NEXP - 1);
        const float* src = (tab ? A.in[I_PV] : A.in[I_PU]) + ((size_t)layer * NEXP + e) * 1024 + 16 * lane;
        f32x4 v[4]; float am = 0.f;
#pragma unroll
        for (int i = 0; i < 4; ++i) { v[i] = *(const f32x4*)(src + 4 * i); am = fmaxf(am, fmaxf(fmaxf(fabsf(v[i][0]), fabsf(v[i][1])), fmaxf(fabsf(v[i][2]), fabsf(v[i][3])))); }
#pragma unroll
        for (int o = 32; o >= 1; o >>= 1) am = fmaxf(am, __shfl_xor(am, o));
        float sc = 1.f; if (am > 0.f) { int ex; (void)frexpf(448.f / am, &ex); sc = ldexpf(1.f, ex - 1); }
        if (lane == 0) SCL[tab * NEXP + e] = 1.f / sc;
        u32x4 w;
#pragma unroll
        for (int i = 0; i < 4; ++i) w[i] = pk4_fp8(v[i][0] * sc, v[i][1] * sc, v[i][2] * sc, v[i][3] * sc);
        *(u32x4*)(A.ws + WS_TAB + (size_t)tab * TAB8_HALF + ((size_t)(lane >> 3) * NEXP + e) * SW + 16 * (lane & 7)) = w;
    }
}
#define CASD(a, b) do { const float hi_ = fmaxf(a, b), lo_ = fminf(a, b); a = hi_; b = lo_; } while (0)
__device__ __forceinline__ void sort16(float (&k)[16]) {
#pragma unroll
    for (int sz = 2; sz <= 16; sz <<= 1)
#pragma unroll
        for (int j = sz >> 1; j > 0; j >>= 1)
#pragma unroll
            for (int i = 0; i < 16; ++i) { const int l = i ^ j; if (l > i) { if ((i & sz) == 0 || sz == 16) CASD(k[i], k[l]); else CASD(k[l], k[i]); } }
}
__device__ __forceinline__ void bmerge16(float (&k)[16]) {
#pragma unroll
    for (int j = 8; j > 0; j >>= 1)
#pragma unroll
        for (int i = 0; i < 16; ++i) { const int l = i ^ j; if (l > i) CASD(k[i], k[l]); }
}
__device__ __forceinline__ void merge_top16(float (&a)[16], const float (&b)[16]) {
#pragma unroll
    for (int i = 0; i < 16; ++i) a[i] = fmaxf(a[i], b[15 - i]);
    bmerge16(a);
}
__device__ __forceinline__ void xmerge_top16(float (&a)[16], int mask) {
    float t[16];
#pragma unroll
    for (int i = 0; i < 16; ++i) t[i] = __shfl_xor(a[15 - i], mask);
#pragma unroll
    for (int i = 0; i < 16; ++i) a[i] = fmaxf(a[i], t[i]);
    bmerge16(a);
}
__device__ __forceinline__ void phase_topk(const Args& A, int layer, int nrows, LAS unsigned char* lds) {
    const bf16_t* QP = (const bf16_t*)(A.ws + WS_BIG); int* IDX = (int*)(A.ws + WS_R2); float* GATE = (float*)(A.ws + WS_R2 + R2_GATE);
    const int tid = otid(), wid = tid >> 6, lane = tid & 63, fr = lane & 15, fq = lane >> 4;
    LAS unsigned* scr = (LAS unsigned*)(lds + 2 * 34816) + wid * 512 + fr * 32;
    int h_staged = -1;
    for (int unit = blockIdx.x; unit < (nrows / 128) * 8; unit += gridDim.x) {
        const int h = unit & 7, r0 = (unit >> 3) * 128;
        if (h != h_staged) { h_staged = h;
        __syncthreads();
        { const bf16_t* k1 = (const bf16_t*)(A.ws + WS_W + W_PEER + (size_t)layer * WP_SZ + WP_K1) + (size_t)h * 16384;
#pragma unroll
          for (int j = 0; j < 8; ++j) { const int idx = tid + 512 * j, half = idx >> 11, rem = idx & 2047, key = rem >> 4, c8 = rem & 15;
              const u32x4 w = *(const u32x4*)(k1 + (size_t)half * 8 * 16384 + key * 128 + 8 * c8);
              *(LAS u32x4*)(lds + half * 34816 + key * 272 + c8 * 16) = w; } }
        __syncthreads(); }
        const int tok = r0 + 16 * wid + fr;
        float top[2][16];
#pragma unroll
        for (int half = 0; half < 2; ++half) {
            bf16x8 qf[4];
#pragma unroll
            for (int ks = 0; ks < 4; ++ks) qf[ks] = *(const bf16x8*)(QP + (size_t)tok * 2048 + 256 * h + 128 * half + 32 * ks + 8 * fq);
            float loc[16];
#pragma unroll
            for (int grp = 0; grp < 2; ++grp) {
                float kk[16];
#pragma unroll
                for (int nbb = 0; nbb < 4; ++nbb) { const int nb = 4 * grp + nbb; f32x4 acc = {0.f, 0.f, 0.f, 0.f};
#pragma unroll
                    for (int ks = 0; ks < 4; ++ks) { const bf16x8 kf = *(const LAS bf16x8*)(lds + half * 34816 + (16 * nb + fr) * 272 + (32 * ks + 8 * fq) * 2);
                        acc = __builtin_amdgcn_mfma_f32_16x16x32_bf16(kf, qf[ks], acc, 0, 0, 0); }
#pragma unroll
                    for (int i = 0; i < 4; ++i) { const unsigned code = 127u - (unsigned)(16 * nb + 4 * fq + i); kk[4 * nbb + i] = __uint_as_float((__float_as_uint(acc[i]) & ~127u) | code); } }
                sort16(kk);
                if (grp == 0) {
#pragma unroll
                    for (int i = 0; i < 16; ++i) loc[i] = kk[i];
                } else merge_top16(loc, kk);
            }
            xmerge_top16(loc, 16); xmerge_top16(loc, 32);
#pragma unroll
            for (int i = 0; i < 16; ++i) top[half][i] = loc[i];
        }
        if (fq < 2) {
#pragma unroll
            for (int i = 0; i < 16; ++i) scr[16 * fq + i] = __float_as_uint(fq == 0 ? top[0][i] : top[1][i]); }
        float fin[16];
#pragma unroll
        for (int aa = 0; aa < 4; ++aa) {
            const float va_k = fq == 0 ? top[0][aa] : fq == 1 ? top[0][4 + aa] : fq == 2 ? top[0][8 + aa] : top[0][12 + aa];
            const float va = __uint_as_float(__float_as_uint(va_k) & ~127u);
            float c[16];
#pragma unroll
            for (int bb = 0; bb < 16; ++bb) { const float s = va + __uint_as_float(__float_as_uint(top[1][bb]) & ~127u);
                c[bb] = __uint_as_float((__float_as_uint(s) & ~255u) | (255u - (unsigned)((4 * fq + aa) * 16 + bb))); }
            if (aa == 0) {
#pragma unroll
                for (int i = 0; i < 16; ++i) fin[i] = c[i];
            } else merge_top16(fin, c);
        }
        xmerge_top16(fin, 16); xmerge_top16(fin, 32);
        float ev[16], es = 0.f; const float mx = __uint_as_float(__float_as_uint(fin[0]) & ~255u);
#pragma unroll
        for (int i = 0; i < 16; ++i) { ev[i] = __expf(__uint_as_float(__float_as_uint(fin[i]) & ~255u) - mx); es += ev[i]; }
        const float inv = 1.f / es;
        asm volatile("s_waitcnt lgkmcnt(0)" ::: "memory");
        int oi[4]; float og[4];
#pragma unroll
        for (int kq = 0; kq < 4; ++kq) {
            const float fk = fq == 0 ? fin[kq] : fq == 1 ? fin[4 + kq] : fq == 2 ? fin[8 + kq] : fin[12 + kq];
            const float fe = fq == 0 ? ev[kq] : fq == 1 ? ev[4 + kq] : fq == 2 ? ev[8 + kq] : ev[12 + kq];
            const unsigned code = 255u - (__float_as_uint(fk) & 255u), a = code >> 4, bq = code & 15u;
            const unsigned i1 = 127u - (scr[a] & 127u), i2 = 127u - (scr[16 + bq] & 127u);
            oi[kq] = (int)(i1 * 128u + i2); og[kq] = fe * inv; }
        *(int4*)(IDX + (size_t)tok * 128 + 16 * h + 4 * fq) = make_int4(oi[0], oi[1], oi[2], oi[3]);
        *(f32x4*)(GATE + (size_t)tok * 128 + 16 * h + 4 * fq) = (f32x4){og[0], og[1], og[2], og[3]};
    }
}
struct PeerSched {
    int x0, rank, nloc, nblk, nown; unsigned orphan;
    __device__ __forceinline__ void init(const Args& A, int nrows, LAS unsigned char* smem) {
        unsigned* ctl = (unsigned*)(A.ws + WS_CTL);
        x0 = (int)(xb_xcc_id() & 7u); rank = __builtin_amdgcn_readfirstlane((int)((LAS unsigned*)smem)[8]); nblk = nrows / 64;
        unsigned cached = __builtin_amdgcn_readfirstlane(((LAS unsigned*)smem)[9]);
        if (cached == 0u) { unsigned orph = 0u, nl = 1u;
            for (int j = 0; j < 8; ++j) { unsigned c = xb_ld(&ctl[XB_XCNT(j)]) + xb_ld(&ctl[XB_XCNT(j + 8)]); c = __builtin_amdgcn_readfirstlane(c); if (c == 0u) orph |= 1u << j; if (j == x0) nl = c; }
            cached = (nl << 8) | orph; __syncthreads(); if (threadIdx.x == 0) ((LAS unsigned*)smem)[9] = cached; __syncthreads(); }
        nloc = (int)(cached >> 8); orphan = cached & 0xffu;
        const int tot = (NSL / 8) * nblk; nown = rank < tot ? (tot - rank + nloc - 1) / nloc : 0;
    }
    __device__ __forceinline__ bool item(int j, int& sl, int& blk) const {
        if (j < nown) { const int i = rank + j * nloc; sl = x0 + 8 * (i / nblk); blk = i % nblk; return true; }
        int jj = j - nown; const int tot = (NSL / 8) * nblk, per = ((int)gridDim.x > tot) ? 1 : 0; (void)per;
        for (int o = 0; o < 8; ++o) if ((orphan >> o) & 1u) { const int cnt = ((int)blockIdx.x < tot) ? (tot - (int)blockIdx.x + (int)gridDim.x - 1) / (int)gridDim.x : 0;
            if (jj < cnt) { const int i = (int)blockIdx.x + jj * (int)gridDim.x; sl = o + 8 * (i / nblk); blk = i % nblk; return true; } jj -= cnt; }
        return false;
    }
};
template <class LD, class ST, class PR>
__device__ __forceinline__ void peer_items(const PeerSched& S, LD ld, ST st, PR pr) {
    int sl, blk, sln, blkn, j = 0, buf = 0; bool have = S.item(0, sl, blk);
    if (have) { ld(sl, blk, 0); st(0); }
    while (have) {
        const bool haven = S.item(j + 1, sln, blkn);
        asm volatile("s_waitcnt vmcnt(0)" ::: "memory");
        __syncthreads();
        if (haven) ld(sln, blkn, buf ^ 1);
        pr(sl, blk, buf);
        if (haven) st(buf ^ 1);
        sl = sln; blk = blkn; have = haven; buf ^= 1; ++j;
    }
    __syncthreads();
}
#ifndef MK_UVAR
#define MK_UVAR 0
#endif
__device__ __forceinline__ float dpp_sum8(float v) {
    v += __builtin_bit_cast(float, __builtin_amdgcn_mov_dpp(__builtin_bit_cast(int, v), 0xB1, 0xF, 0xF, true));
    v += __builtin_bit_cast(float, __builtin_amdgcn_mov_dpp(__builtin_bit_cast(int, v), 0x4E, 0xF, 0xF, true));
    v += __builtin_bit_cast(float, __builtin_amdgcn_mov_dpp(__builtin_bit_cast(int, v), 0x141, 0xF, 0xF, true));
    return v;
}
__device__ __forceinline__ void phase_peer_u(const Args& A, int layer, int nrows, LAS unsigned char* smem, int rep) {
    const int var = rep ? MK_UVAR : 0;
    const bf16_t* H = (const bf16_t*)(A.ws + WS_H); const int* IDX = (const int*)(A.ws + WS_R2); float* PART = var ? (float*)(A.ws + WS_R1) : (float*)(A.ws + WS_BIG + BIG_PART);
    const unsigned char* U = A.ws + WS_TAB;
    LAS unsigned char* lds = smem + LDS_BASE;
    constexpr int PP = 1088, HALFB = 32 * PP, BUF = HALFB + 64 * SW * 2;
    const int tid = otid(), wid = tid >> 6, lane = tid & 63, m = lane & 7, tk = lane >> 3;
    PeerSched S; S.init(A, nrows, smem);
    const int wu = __builtin_amdgcn_readfirstlane(wid);
    peer_items(S,
        [&](int sl, int blk, int buf) {
#pragma unroll
            for (int i = 0; i < 4; ++i)
                __builtin_amdgcn_global_load_lds((const unsigned*)(IDX + (size_t)blk * 64 * 128 + 256 * (wu + 8 * i) + 4 * lane), (LAS unsigned*)(lds + buf * BUF + PP * (wu + 8 * i)), 16, 0, 0);
#pragma unroll
            for (int i = 0; i < 2; ++i) { const int pc = wu + 8 * i;
                __builtin_amdgcn_global_load_lds((const unsigned*)(H + (size_t)(blk * 64 + 4 * pc + (lane >> 4)) * 1024 + SW * sl + 8 * (lane & 15)), (LAS unsigned*)(lds + buf * BUF + HALFB + 1024 * pc), 16, 0, 0); } },
        [&](int buf) { },
        [&](int sl, int blk, int buf) {
            const unsigned char* ub = U + (size_t)sl * NEXP * SW + 16 * m;
            const int tokl = wid * 8 + tk, tok = blk * 64 + tokl;
            const int sw = (tokl & 1) * 4;
            const LAS int* ib = (const LAS int*)(lds + buf * BUF + (tokl >> 1) * PP + (tokl & 1) * 512);
            float hf[16];
            { const u32x4 h0 = *(const LAS u32x4*)(lds + buf * BUF + HALFB + tokl * 256 + 32 * m), h1 = *(const LAS u32x4*)(lds + buf * BUF + HALFB + tokl * 256 + 32 * m + 16);
#pragma unroll
              for (int j = 0; j < 4; ++j) { hf[2 * j] = bflo(h0[j]); hf[2 * j + 1] = bfhi(h0[j]); hf[8 + 2 * j] = bflo(h1[j]); hf[8 + 2 * j + 1] = bfhi(h1[j]); } }
            const bool up4 = m >= 4, up2 = (m & 2) != 0, up1 = (m & 1) != 0;
            float* pp = PART + ((size_t)sl * NROW + tok) * 128 + (m ^ sw);
            u32x4 vv[2][8];
#define PU_ROWS(T, c) do { const i32x4 e0_ = *(const LAS i32x4*)(ib + 8 * (c) + sw), e1_ = *(const LAS i32x4*)(ib + 8 * (c) + (4 - sw)); \
                if (var == 4) { _Pragma("unroll") for (int k_ = 0; k_ < 8; ++k_) vv[T][k_] = (u32x4){(unsigned)e0_.x, (unsigned)e1_.y, 0u, 0u}; } else { \
                vv[T][0] = *(const u32x4*)(ub + (size_t)(var == 3 ? e0_.x & 63 : e0_.x) * SW); vv[T][1] = *(const u32x4*)(ub + (size_t)(var == 3 ? e0_.y & 63 : e0_.y) * SW); \
                vv[T][2] = *(const u32x4*)(ub + (size_t)(var == 3 ? e0_.z & 63 : e0_.z) * SW); vv[T][3] = *(const u32x4*)(ub + (size_t)(var == 3 ? e0_.w & 63 : e0_.w) * SW); \
                vv[T][4] = *(const u32x4*)(ub + (size_t)(var == 3 ? e1_.x & 63 : e1_.x) * SW); vv[T][5] = *(const u32x4*)(ub + (size_t)(var == 3 ? e1_.y & 63 : e1_.y) * SW); \
                vv[T][6] = *(const u32x4*)(ub + (size_t)(var == 3 ? e1_.z & 63 : e1_.z) * SW); vv[T][7] = *(const u32x4*)(ub + (size_t)(var == 3 ? e1_.w & 63 : e1_.w) * SW); } } while (0)
#define PU_DOT(T, c) do { float s_[8]; \
                _Pragma("unroll") for (int k = 0; k < 8; ++k) { f32x2 a2 = {0.f, 0.f}; \
                    _Pragma("unroll") for (int j = 0; j < 4; ++j) { const int w = (int)vv[T][k][j]; \
                        const f32x2 lo = __builtin_amdgcn_cvt_pk_f32_fp8(w, false), hi = __builtin_amdgcn_cvt_pk_f32_fp8(w, true); \
                        a2 = __builtin_elementwise_fma(lo, (f32x2){hf[4 * j], hf[4 * j + 1]}, a2); a2 = __builtin_elementwise_fma(hi, (f32x2){hf[4 * j + 2], hf[4 * j + 3]}, a2); } \
                    s_[k] = a2.x + a2.y; } \
                  \
                float t_[4], u_[2]; \
                _Pragma("unroll") for (int j = 0; j < 4; ++j) { const float give = up4 ? s_[j] : s_[4 + j], keep = up4 ? s_[4 + j] : s_[j]; \
                    t_[j] = keep + __builtin_bit_cast(float, __builtin_amdgcn_mov_dpp(__builtin_bit_cast(int, give), 0x141, 0xF, 0xF, true)); }        \
                _Pragma("unroll") for (int j = 0; j < 2; ++j) { const float give = up2 ? t_[j] : t_[2 + j], keep = up2 ? t_[2 + j] : t_[j]; \
                    u_[j] = keep + __builtin_bit_cast(float, __builtin_amdgcn_mov_dpp(__builtin_bit_cast(int, give), 0x4E, 0xF, 0xF, true)); }         \
                { const float give = up1 ? u_[0] : u_[1], keep = up1 ? u_[1] : u_[0]; \
                  const float tot_ = keep + __builtin_bit_cast(float, __builtin_amdgcn_mov_dpp(__builtin_bit_cast(int, give), 0xB1, 0xF, 0xF, true));           \
                  pp[8 * (c)] = tot_; } } while (0)
            PU_ROWS(0, 0);
#pragma unroll 1
            for (int c = 0; c < 16; c += 2) {
                PU_ROWS(1, c + 1);
                __builtin_amdgcn_sched_barrier(0);
                PU_DOT(0, c);
                __builtin_amdgcn_sched_barrier(0);
                if (c + 2 < 16) PU_ROWS(0, c + 2);
                __builtin_amdgcn_sched_barrier(0);
                PU_DOT(1, c + 1);
                __builtin_amdgcn_sched_barrier(0);
            }
#undef PU_ROWS
#undef PU_DOT
        });
}
__device__ __forceinline__ void phase_coef(const Args& A, int nrows) {
    const float* PART = (const float*)(A.ws + WS_BIG + BIG_PART); const float* GATE = (const float*)(A.ws + WS_R2 + R2_GATE); float* COEF = (float*)(A.ws + WS_R2 + R2_COEF);
    const int* IDX = (const int*)(A.ws + WS_R2); const float* SCL = (const float*)(A.ws + WS_TAB + TAB_SCL);
    const int gthr = blockIdx.x * NTHR + otid(), nthr = gridDim.x * NTHR;
    for (int p = gthr; p < nrows * 32; p += nthr) {
        f32x4 s = {0.f, 0.f, 0.f, 0.f};
#pragma unroll
        for (int x = 0; x < NSL; ++x) s += *(const f32x4*)(PART + (size_t)x * NROW * 128 + 4 * p);
        const i32x4 e = *(const i32x4*)(IDX + 4 * p); const f32x4 gt = *(const f32x4*)(GATE + 4 * p);
        const f32x4 su = {SCL[e.x], SCL[e.y], SCL[e.z], SCL[e.w]}, sv = {SCL[NEXP + e.x], SCL[NEXP + e.y], SCL[NEXP + e.z], SCL[NEXP + e.w]};
        const f32x4 a = s * su; const f32x2 g0 = gelu_pk((f32x2){a[0], a[1]}), g1 = gelu_pk((f32x2){a[2], a[3]});
        *(f32x4*)(COEF + 4 * p) = gt * (f32x4){g0.x, g0.y, g1.x, g1.y} * sv; }

}
__device__ __forceinline__ void phase_peer_v(const Args& A, int layer, int nrows, LAS unsigned char* smem, int rep) {
    const int* IDX = (const int*)(A.ws + WS_R2); const float* COEF = (const float*)(A.ws + WS_R2 + R2_COEF);
    const unsigned char* V = A.ws + WS_TAB + TAB8_HALF; const float* MODL = (const float*)(A.ws + WS_MOD) + (size_t)layer * 5 * 6144 + 5 * 1024;
    float* XC = (float*)(A.ws + WS_XC);
    LAS unsigned char* lds = smem + LDS_BASE;
    constexpr int PP = 1088, HALFB = 32 * PP, BUF = 2 * HALFB;
    const int tid = otid(), wid = tid >> 6, lane = tid & 63, m = lane & 7, tk = lane >> 3;
    PeerSched S; S.init(A, nrows, smem);
    const int wu = __builtin_amdgcn_readfirstlane(wid);
    peer_items(S,
        [&](int sl, int blk, int buf) {
#pragma unroll
            for (int i = 0; i < 4; ++i) {
                __builtin_amdgcn_global_load_lds((const unsigned*)(IDX + (size_t)blk * 64 * 128 + 256 * (wu + 8 * i) + 4 * lane), (LAS unsigned*)(lds + buf * BUF + PP * (wu + 8 * i)), 16, 0, 0);
                __builtin_amdgcn_global_load_lds((const unsigned*)(COEF + (size_t)blk * 64 * 128 + 256 * (wu + 8 * i) + 4 * lane), (LAS unsigned*)(lds + buf * BUF + HALFB + PP * (wu + 8 * i)), 16, 0, 0); } },
        [&](int buf) { },
        [&](int sl, int blk, int buf) {
            const unsigned char* vb = V + (size_t)sl * NEXP * SW + 16 * m;
            const int tokl = wid * 8 + tk, tok = blk * 64 + tokl; const bool lat = tok < NLAT;
            const int toff = (tokl >> 1) * PP + (tokl & 1) * 512, sw = (tokl & 1) * 4;
            const LAS int* ib = (const LAS int*)(lds + buf * BUF + toff); const LAS float* cb = (const LAS float*)(lds + buf * BUF + HALFB + toff);
            float* xp = (lat ? A.out + (size_t)tok * D : XC + (size_t)(tok - NLAT) * D) + SW * sl + 16 * m;
            f32x4 xr[4];
#pragma unroll
            for (int j = 0; j < 4; ++j) xr[j] = *(f32x4*)(xp + 4 * j);
            f32x2 acc2[8];
#pragma unroll
            for (int j = 0; j < 8; ++j) acc2[j] = (f32x2){0.f, 0.f};
            u32x4 vv[2][8];
#define PV_ROWS(T, c) do { const i32x4 e0_ = *(const LAS i32x4*)(ib + 8 * (c) + sw), e1_ = *(const LAS i32x4*)(ib + 8 * (c) + (4 - sw)); \
                vv[T][0] = *(const u32x4*)(vb + (size_t)e0_.x * SW); vv[T][1] = *(const u32x4*)(vb + (size_t)e0_.y * SW); vv[T][2] = *(const u32x4*)(vb + (size_t)e0_.z * SW); vv[T][3] = *(const u32x4*)(vb + (size_t)e0_.w * SW); \
                vv[T][4] = *(const u32x4*)(vb + (size_t)e1_.x * SW); vv[T][5] = *(const u32x4*)(vb + (size_t)e1_.y * SW); vv[T][6] = *(const u32x4*)(vb + (size_t)e1_.z * SW); vv[T][7] = *(const u32x4*)(vb + (size_t)e1_.w * SW); } while (0)
#define PV_FMA(T, c) do { const f32x4 c0_ = *(const LAS f32x4*)(cb + 8 * (c) + sw), c1_ = *(const LAS f32x4*)(cb + 8 * (c) + (4 - sw)); \
                _Pragma("unroll") for (int k = 0; k < 8; ++k) { const float cf = k < 4 ? c0_[k & 3] : c1_[k & 3]; \
                    _Pragma("unroll") for (int j = 0; j < 4; ++j) { const int w = (int)vv[T][k][j]; \
                        const f32x2 lo = __builtin_amdgcn_cvt_pk_f32_fp8(w, false), hi = __builtin_amdgcn_cvt_pk_f32_fp8(w, true); const f32x2 c2 = {cf, cf}; \
                        acc2[2 * j] = __builtin_elementwise_fma(lo, c2, acc2[2 * j]); acc2[2 * j + 1] = __builtin_elementwise_fma(hi, c2, acc2[2 * j + 1]); } } } while (0)
            PV_ROWS(0, 0);
#pragma unroll 1
            for (int c = 0; c < 16; c += 2) {
                PV_ROWS(1, c + 1);
                __builtin_amdgcn_sched_barrier(0);
                PV_FMA(0, c);
                __builtin_amdgcn_sched_barrier(0);
                if (c + 2 < 16) PV_ROWS(0, c + 2);
                __builtin_amdgcn_sched_barrier(0);
                PV_FMA(1, c + 1);
                __builtin_amdgcn_sched_barrier(0);
            }
#undef PV_ROWS
#undef PV_FMA
            const float* gp = MODL + (size_t)(lat ? (tok >> 13) : 4) * 6144 + SW * sl + 16 * m;
#pragma unroll
            for (int j = 0; j < 4; ++j) { const f32x4 g = *(const f32x4*)(gp + 4 * j);
                *(f32x4*)(xp + 4 * j) = xr[j] + g * (f32x4){acc2[2 * j].x, acc2[2 * j].y, acc2[2 * j + 1].x, acc2[2 * j + 1].y}; }
        });
}

#ifdef MK_CHECK
constexpr int CW_CHK = 3840;
__device__ __forceinline__ float blk_sum(float v, LAS float* red) {
    const int t_ = otid(); v = wave_sum(v); __syncthreads(); if ((t_ & 63) == 0) red[t_ >> 6] = v; __syncthreads();
    float s = 0.f; for (int i = 0; i < 8; ++i) s += red[i]; __syncthreads(); return s;
}
__device__ __forceinline__ float fp8f(unsigned b) { const unsigned e = (b >> 3) & 15u, m = b & 7u; const float v = e ? ldexpf(1.f + (float)m * 0.125f, (int)e - 7) : ldexpf((float)m * 0.125f, -6); return (b & 0x80u) ? -v : v; }
__device__ __forceinline__ void check_attn(const Args& A, LAS unsigned char* lds) {
    const unsigned char* Q = A.ws + WS_R1 + R1_Q; const unsigned char* KN = A.ws + WS_R1 + R1_KN; const unsigned char* KR = A.ws + WS_BIG + BIG_KR; const unsigned char* V = A.ws + WS_R1 + R1_V;
    const bf16_t* CAT = (const bf16_t*)(A.ws + WS_R3 + R3_CAT); float* chk = (float*)(A.ws + WS_CTL) + CW_CHK;
    LAS float* p = (LAS float*)lds; LAS float* qv = p + NKEY; LAS float* red = qv + 192;
    const int tid = otid(), sidx = blockIdx.x;
    const int b = sidx & 3, h = (sidx >> 2) & 7, l = (int)(((unsigned)sidx * 2654435761u) >> 19) & 8191;
    const size_t bh = (size_t)(b * 8 + h);
    if (tid < 192) qv[tid] = fp8f(Q[(bh * NKEY + 256 + l) * 192 + tid]) * (1.f / att8::QUP);
    __syncthreads();
    float mx = -1e30f;
    for (int key = tid; key < NKEY; key += 512) { const int t = key >> 6, k = key & 63; float s = 0.f;
        for (int d = 0; d < 128; ++d) s += qv[d] * fp8f(KN[(bh * NKT + t) * 8192 + att8::kn8(k, d)]);
        for (int d = 0; d < 64; ++d) s += qv[128 + d] * fp8f(KR[((size_t)b * NKT + t) * 4096 + att8::kr8(k, d)]);
        p[key] = s; mx = fmaxf(mx, s); }
    for (int o = 32; o >= 1; o >>= 1) mx = fmaxf(mx, __shfl_xor(mx, o));
    __syncthreads(); if ((tid & 63) == 0) red[tid >> 6] = mx; __syncthreads(); mx = red[0]; for (int i = 1; i < 8; ++i) mx = fmaxf(mx, red[i]); __syncthreads();
    float ls = 0.f; for (int key = tid; key < NKEY; key += 512) { const float e = exp2f(p[key] - mx); p[key] = e; ls += e; }
    ls = blk_sum(ls, red);
    float num = 0.f, den = 0.f;
    if (tid < 128) { float o = 0.f; for (int key = 0; key < NKEY; ++key) o += p[key] * fp8f(V[(bh * NKT + (key >> 6)) * 8192 + att8::v8(tid, key & 63)]);
        o /= ls; const float got = bf2f(CAT[(size_t)(b * 8192 + l) * 2048 + 1024 + 128 * h + tid]); num = (got - o) * (got - o); den = o * o; }
    num = blk_sum(num, red); den = blk_sum(den, red);
    if (tid == 0) { atomicAdd(chk, num); atomicAdd(chk + 1, den); }
}
__device__ __forceinline__ void check_qkv(const Args& A, int li, LAS unsigned char* lds) {
    float* chk = (float*)(A.ws + WS_CTL) + CW_CHK;
    const unsigned char* Q = A.ws + WS_R1 + R1_Q; const unsigned char* KN = A.ws + WS_R1 + R1_KN; const unsigned char* KR = A.ws + WS_BIG + BIG_KR; const unsigned char* V = A.ws + WS_R1 + R1_V;
    LAS float* hv = (LAS float*)lds; LAS float* cq = hv + 1024; LAS float* ckv = cq + 384; LAS float* kr = ckv + 256; LAS float* red = kr + 64; LAS float* ov = red + 16;
    const int tid = otid(), sidx = blockIdx.x;
    const int hd = sidx & 7; const int r = (sidx & 8) ? NLAT + (int)(((unsigned)sidx * 2654435761u) >> 22) : (int)(((unsigned)sidx * 2654435761u) >> 17);
    const float* win = A.in[I_HWIN] + (size_t)li * 1024 * HYB_IN;
    {
        const float* xp = r < NLAT ? A.out + (size_t)r * D : (const float*)(A.ws + WS_XC) + (size_t)(r - NLAT) * D; const float* MODL = (const float*)(A.ws + WS_MOD) + (size_t)(2 * li) * 5 * 6144 + (size_t)row_mb(r) * 6144;
        float ss = 0.f; for (int i = tid; i < 1024; i += 512) ss += xp[i] * xp[i];
        ss = blk_sum(ss, red); const float rstd = rsqrtf(ss / 1024.f + EPS);
        for (int i = tid; i < 1024; i += 512) hv[i] = bf2f(f2bf(xp[i] * rstd * A.in[I_N1G][(2 * li) * 1024 + i] * (1.f + MODL[1024 + i]) + MODL[i])); }
    __syncthreads();
    for (int j = tid; j < 704; j += 512) { float s = 0.f; for (int k = 0; k < 1024; ++k) s += hv[k] * win[(size_t)k * HYB_IN + C_CQ + j];
        s = bf2f(f2bf(s)); if (j < 384) cq[j] = s; else if (j < 640) ckv[j - 384] = s; else kr[j - 640] = s; }
    __syncthreads();
    float sq = 0.f, sk = 0.f; for (int j = tid; j < 384; j += 512) sq += cq[j] * cq[j]; for (int j = tid; j < 256; j += 512) sk += ckv[j] * ckv[j];
    sq = blk_sum(sq, red); sk = blk_sum(sk, red);
    const float rq = rsqrtf(sq / 384.f + EPS), rk = rsqrtf(sk / 256.f + EPS);
    const float* wqb = A.in[I_WQB] + (size_t)li * 384 * 1536; const float* wkvb = A.in[I_WKVB] + (size_t)li * 256 * 2048; const float* qg = A.in[I_QNG] + li * 384; const float* kg = A.in[I_KVNG] + li * 256;
    if (tid < 192) { float s = 0.f; for (int k = 0; k < 384; ++k) s += cq[k] * rq * qg[k] * wqb[(size_t)k * 1536 + hd * 192 + tid]; ov[tid] = s; }
    else if (tid < 448) { const int c = tid - 192; float s = 0.f; for (int k = 0; k < 256; ++k) s += ckv[k] * rk * kg[k] * wkvb[(size_t)k * 2048 + hd * 256 + c]; ov[tid] = s; }
    __syncthreads();
    const bool lat = r < NLAT; const int b = lat ? (r >> 13) : ((r - NLAT) >> 8), l = lat ? (r & 8191) : 0, key = lat ? 256 + l : ((r - NLAT) & 255), qrow = key;
    const size_t bh = (size_t)(b * 8 + hd); const float qs = QSCALE * att8::QUP;
    float num = 0.f, den = 0.f;
    if (tid < 128) {
        const float q = ov[tid] * qs, gq = fp8f(Q[(bh * NKEY + qrow) * 192 + tid]);
        const float kk = ov[192 + tid], gk = fp8f(KN[(bh * NKT + (key >> 6)) * 8192 + att8::kn8(key & 63, tid)]);
        const float vv = ov[320 + tid], gv = fp8f(V[(bh * NKT + (key >> 6)) * 8192 + att8::v8(tid, key & 63)]);
        num = (gq - q) * (gq - q) + (gk - kk) * (gk - kk) + (gv - vv) * (gv - vv); den = q * q + kk * kk + vv * vv;
    } else if (tid < 160) {
        const int i = tid - 128; float c = 1.f, sn = 0.f;
        if (lat) { const float pos = (float)(i < 16 ? (l >> 6) : (l & 63)); const float ang = pos * powf(10000.f, -(float)(i & 15) / 16.f); c = cosf(ang); sn = sinf(ang); }
        const float q1 = ov[128 + i] * qs, q2 = ov[160 + i] * qs, k1 = kr[i], k2 = kr[32 + i];
        const float rq1 = q1 * c - q2 * sn, rq2 = q1 * sn + q2 * c, rk1 = k1 * c - k2 * sn, rk2 = k1 * sn + k2 * c;
        const float gq1 = fp8f(Q[(bh * NKEY + qrow) * 192 + 128 + 2 * i]), gq2 = fp8f(Q[(bh * NKEY + qrow) * 192 + 128 + 2 * i + 1]);
        const float gk1 = fp8f(KR[((size_t)b * NKT + (key >> 6)) * 4096 + att8::kr8(key & 63, 2 * i)]), gk2 = fp8f(KR[((size_t)b * NKT + (key >> 6)) * 4096 + att8::kr8(key & 63, 2 * i + 1)]);
        num = (gq1 - rq1) * (gq1 - rq1) + (gq2 - rq2) * (gq2 - rq2) + (gk1 - rk1) * (gk1 - rk1) + (gk2 - rk2) * (gk2 - rk2); den = rq1 * rq1 + rq2 * rq2 + rk1 * rk1 + rk2 * rk2;
    }
    num = blk_sum(num, red); den = blk_sum(den, red);
    if (tid == 0) { atomicAdd(chk, num); atomicAdd(chk + 1, den); }
}
__device__ __forceinline__ void check_topk(const Args& A, int layer, LAS unsigned char* lds) {
    const bf16_t* QP = (const bf16_t*)(A.ws + WS_BIG); const int* IDX = (const int*)(A.ws + WS_R2); const float* GATE = (const float*)(A.ws + WS_R2 + R2_GATE); float* chk = (float*)(A.ws + WS_CTL) + CW_CHK;
    const bf16_t* K1 = (const bf16_t*)(A.ws + WS_W + W_PEER + (size_t)layer * WP_SZ + WP_K1);
    LAS float* sc = (LAS float*)lds; LAS float* v12 = sc + 256; LAS int* i12 = (LAS int*)(v12 + 32); LAS float* cs = (LAS float*)(i12 + 32); LAS float* ts = cs + 256; LAS int* ti = (LAS int*)(ts + 16); LAS float* red = (LAS float*)(ti + 16);
    const int tid = otid();
    for (int smp = blockIdx.x; smp < 1024; smp += gridDim.x) {
        const int h = smp & 7, tok = (int)((((unsigned)smp * 2654435761u) >> 12) % (unsigned)NROW);
        __syncthreads();
        if (tid < 256) { const int half = tid >> 7, key = tid & 127; float a = 0.f;
            for (int d = 0; d < 128; ++d) a += bf2f(QP[(size_t)tok * 2048 + 256 * h + 128 * half + d]) * bf2f(K1[((size_t)half * 8 + h) * 16384 + key * 128 + d]);
            sc[tid] = a; }
        __syncthreads();
        if (tid < 256) { const int half = tid >> 7, key = tid & 127; const float v = sc[tid]; int rank = 0;
            for (int j = 0; j < 128; ++j) { const float o = sc[half * 128 + j]; rank += (o > v || (o == v && j < key)) ? 1 : 0; }
            if (rank < 16) { v12[half * 16 + rank] = v; i12[half * 16 + rank] = key; } }
        __syncthreads();
        if (tid < 256) cs[tid] = v12[tid >> 4] + v12[16 + (tid & 15)];
        __syncthreads();
        if (tid < 256) { const float v = cs[tid]; int rank = 0;
            for (int j = 0; j < 256; ++j) { const float o = cs[j]; rank += (o > v || (o == v && j < tid)) ? 1 : 0; }
            if (rank < 16) { ts[rank] = v; ti[rank] = i12[tid >> 4] * 128 + i12[16 + (tid & 15)]; } }
        __syncthreads();
        float num = 0.f, den = 0.f;
        if (tid < 16) { float es = 0.f; for (int j = 0; j < 16; ++j) es += __expf(ts[j] - ts[0]); const float gn = __expf(ts[tid] - ts[0]) / es; float gk = 0.f;
            for (int j = 0; j < 16; ++j) if (IDX[(size_t)tok * 128 + 16 * h + j] == ti[tid]) gk = GATE[(size_t)tok * 128 + 16 * h + j];
            num = (gk - gn) * (gk - gn); den = gn * gn; }
        num = blk_sum(num, red); den = blk_sum(den, red);
        if (tid == 0) { atomicAdd(chk, num); atomicAdd(chk + 1, den); }
    }
}
#endif
#ifndef MK_PER_PHASE
#define MK_PER_PHASE 0
#endif
__device__ __forceinline__ int nr_in(int L) { return L <= 2 ? NROW : NLAT; }
__device__ __forceinline__ int nr_out(int L) { return L <= 1 ? NROW : NLAT; }

__global__ void __launch_bounds__(NTHR, 2) fwd(Args A) {
    extern __shared__ __attribute__((aligned(256))) unsigned char smem_raw[];
    LAS unsigned char* smem = (LAS unsigned char*)smem_raw;
    LAS unsigned char* lds = smem + LDS_BASE;
    const int tid = otid();
    if (tid < 64) ((LAS unsigned*)smem)[tid] = 0u;
    __syncthreads();
    XcdBarrier bar = xcd_barrier_post((unsigned*)(A.ws + WS_CTL), (volatile LAS unsigned*)smem);
    if (tid == 0) ((LAS unsigned*)smem)[8] = atomicAdd((unsigned*)(A.ws + WS_CTL) + CW_RANK + 32 * (xb_xcc_id() & 7u), 1u);
    __syncthreads();
    bool need_bar = false;
    const int lo = A.ph_lo, hi = A.ph_hi;
#ifndef PHMASK
#define PHMASK 0xffffffffu
#endif
#define SITE(k) if constexpr (((PHMASK) >> (k)) & 1u)
#ifndef MK_SVAR
#define MK_SVAR 1
#endif
#ifndef MK_REPEAT_SITE
#define MK_REPEAT_SITE -1
#endif
#define REP(k) for (int rep = 0; rep < ((k) == (MK_REPEAT_SITE) ? 2 : 1); ++rep)
#define PH(id) if ([&]() -> bool { if ((id) < lo || (id) >= hi) return false; if (need_bar) xcd_barrier(bar); need_bar = true; return true; }())
    unsigned char* ws = A.ws;
    float* XL = A.out; float* XC = (float*)(ws + WS_XC);
    bf16_t* H = (bf16_t*)(ws + WS_H);
    const float* MOD = (const float*)(ws + WS_MOD);

    SITE(0) PH(0) { phase_prologue(A, lds); }
    SITE(1) PH(1) { phase_norm_mod(A.in[I_X], A.in[I_CTX], XL, XC, A.in[I_N1G], MOD, 0, H, NROW); }
    for (int L = 0; L < DEPTH; ++L) {
        const int base = 2 + 16 * L, li = L >> 1; const bool hyb = (L & 1) == 0;
        const float* MODL = MOD + (size_t)L * 5 * 6144;
        unsigned char* WH = ws + WS_W + W_HYB + (size_t)li * WH_SZ; unsigned char* WG = ws + WS_W + W_GM + (size_t)li * WG_SZ; unsigned char* WP = ws + WS_W + W_PEER + (size_t)L * WP_SZ;
        if (hyb) {
            SITE(2) PH(base + 0) REP(2) { pg8::Gemm g{H, (const bf16_t*)(WH + WH_IN), nr_in(L), HYB_INP, 1024, 1024, 1024};
                pg8::EpiBf16<0> e{(bf16_t*)(ws + WS_BIG), HYB_INP}; pg8::gemm_phase(lds, g, e); }
            SITE(3) PH(base + 1) REP(3) { phase_conv(A, li); }
            SITE(4) PH(base + 2) {
                SITE(18) REP(18) { pg8::Gemm g{(const bf16_t*)(ws + WS_BIG) + C_CQ, (const bf16_t*)(WH + WH_QB), L == 0 ? NROW : NLAT, 1536, 384, HYB_INP, 384};
                  EpiQ e{ws + WS_R1 + R1_Q, (const float*)(ws + WS_RSTD), (const float*)(ws + WS_ROPE)}; pg8::gemm_phase(lds, g, e); }
                SITE(19) REP(19) { pg8::Gemm g{(const bf16_t*)(ws + WS_BIG) + C_CKV, (const bf16_t*)(WH + WH_KVB), NROW, 2048, 256, HYB_INP, 256};
                  EpiKV e{ws + WS_R1 + R1_KN, ws + WS_R1 + R1_V, (const float*)(ws + WS_RSTD) + NROW}; pg8::gemm_phase(lds, g, e); }
                SITE(20) REP(20) for (int u = blockIdx.x; u < 528; u += gridDim.x) ssd::g_unit((const bf16_t*)(ws + WS_R2 + R2_BC), (bf16_t*)(ws + WS_BIG + BIG_G), u);
            }
            SITE(5) PH(base + 3) {
                const int xq = (int)blockIdx.x & 7, jq = (int)blockIdx.x >> 3; const bool ssd_wg = (jq & 1) == 0 && gridDim.x == 256;
                if (gridDim.x == 256) {
                    if (ssd_wg) { const int r = jq >> 1, gi = xq + 8 * (r >> 3), hh = r & 7, sb = gi >> 2, sgp = (gi >> 1) & 1, sd = gi & 1;
                        SITE(21) ssd::ssd_unit(sb, 8 * sgp + hh, sd, (const bf16_t*)(ws + WS_R2), (const bf16_t*)(ws + WS_R2 + R2_BC), (const float*)(ws + WS_BIG + BIG_DT), (const bf16_t*)(ws + WS_BIG + BIG_G),
                                               A.in[I_ALOG] + li * 32, sd ? (bf16_t*)(ws + WS_R3) : (bf16_t*)(ws + WS_H), lds); }
                } else {
                    SITE(21) for (int u = blockIdx.x; u < 128; u += gridDim.x) ssd::ssd_unit(u >> 5, (u >> 1) & 15, u & 1, (const bf16_t*)(ws + WS_R2), (const bf16_t*)(ws + WS_R2 + R2_BC), (const float*)(ws + WS_BIG + BIG_DT),
                                               (const bf16_t*)(ws + WS_BIG + BIG_G), A.in[I_ALOG] + li * 32, (u & 1) ? (bf16_t*)(ws + WS_R3) : (bf16_t*)(ws + WS_H), lds);
                }
                const int nmine = gridDim.x == 256 ? (ssd_wg ? 3 : 5) + (L == 0 && !ssd_wg && jq < 8 ? 1 : 0) : 0;
                SITE(22) REP(22) for (int it = 0; gridDim.x == 256 ? it < nmine : (int)blockIdx.x + it * (int)gridDim.x < (L == 0 ? 1056 : 1024); ++it) {
                    int b, h, qrow0, orow0, nt;
                    if (gridDim.x == 256) {
                        const int base_it = ssd_wg ? 3 : 5;
                        if (it < base_it) { const int v = ssd_wg ? 3 * (jq >> 1) + it : 48 + 5 * (jq >> 1) + it; b = v >> 5; h = xq; const int qb = v & 31; qrow0 = 256 + 256 * qb; orow0 = b * 8192 + 256 * qb; nt = NKT; }
                        else { b = jq >> 1; h = xq; qrow0 = 0; orow0 = NLAT + 256 * b; nt = 4; }
                    } else { const int au = (int)blockIdx.x + it * (int)gridDim.x;
                        if (au < 1024) { b = au >> 8; h = au & 7; const int qb = (au >> 3) & 31; qrow0 = 256 + 256 * qb; orow0 = b * 8192 + 256 * qb; nt = NKT; }
                        else { const int cu = au - 1024; b = cu >> 3; h = cu & 7; qrow0 = 0; orow0 = NLAT + 256 * b; nt = 4; } }
                    const size_t bh = (size_t)(b * 8 + h);
                    att8::attn_unit(ws + WS_R1 + R1_Q + (bh * NKEY + qrow0) * 192, ws + WS_R1 + R1_KN + bh * NKT * 8192, ws + WS_BIG + BIG_KR + (size_t)b * NKT * 4096,
                                    ws + WS_R1 + R1_V + bh * NKT * 8192, (bf16_t*)(ws + WS_R3 + R3_CAT) + (size_t)orow0 * 2048 + 1024 + 128 * h, nt, lds);
                }
                if (gridDim.x == 256 && !ssd_wg) SITE(11) phase_tabcvt(A, L, xq + 8 * (jq >> 1), 128);
            }
            SITE(6) PH(base + 4) REP(6) { phase_ssd_out(A, li, nr_out(L));
#if defined(MK_CHECK) && MK_CHECK == 1
                if (L == 0) check_attn(A, lds);
#elif defined(MK_CHECK) && MK_CHECK == 2
                if (L == 0) check_qkv(A, li, lds);
#elif defined(MK_CHECK) && MK_CHECK == 3
                if (L == 2) check_attn(A, lds);
#endif
            }
        } else {
            SITE(7) PH(base + 0) REP(7) { pg8::Gemm g{H, (const bf16_t*)(WG + WG_IN), nr_out(L), 4096, 1024, 1024, 1024};
                pg8::EpiBf16<1> e{(bf16_t*)(ws + WS_BIG), 4096}; pg8::gemm_phase(lds, g, e); }
            SITE(8) PH(base + 1) REP(8) { phase_ln_stats(A, nr_out(L)); }
            SITE(9) PH(base + 2) REP(9) { phase_spatial(A, li, nr_out(L), lds); }
        }
        SITE(10) PH(base + 5) { pg8::Gemm g{hyb ? (const bf16_t*)(ws + WS_R3 + R3_CAT) : (const bf16_t*)(ws + WS_R1), hyb ? (const bf16_t*)(WH + WH_OUT) : (const bf16_t*)(WG + WG_OUT), nr_out(L), 1024, 2048, 2048, 2048};
            pg8::EpiResid e{XL, XC, MODL + 2 * 1024}; pg8::gemm_phase(lds, g, e); }
        SITE(11) PH(base + 6) REP(11) { phase_norm_mod(XL, XC, nullptr, nullptr, A.in[I_N2G] + L * 1024, MODL, 3, H, nr_out(L));
            if (!hyb || gridDim.x != 256) phase_tabcvt(A, L, (int)blockIdx.x, (int)gridDim.x); }
        SITE(12) PH(base + 7) REP(12) { pg8::Gemm g{H, (const bf16_t*)(WP + WP_Q), nr_out(L), 2048, 1024, 1024, 1024};
            pg8::EpiBf16<0> e{(bf16_t*)(ws + WS_BIG), 2048}; pg8::gemm_phase(lds, g, e); }
        SITE(13) PH(base + 8) REP(13) { phase_topk(A, L, nr_out(L), lds); }
        SITE(14) PH(base + 9) REP(14) { phase_peer_u(A, L, nr_out(L), smem, rep); }
        SITE(15) PH(base + 10) REP(15) { phase_coef(A, nr_out(L));
#if defined(MK_CHECK) && MK_CHECK == 4
            if (L == 1) check_topk(A, L, lds);
#endif
        }
        SITE(16) PH(base + 11) { phase_peer_v(A, L, nr_out(L), smem, 0); }
        SITE(17) PH(base + 12) { if (L < DEPTH - 1) phase_norm_mod(XL, XC, nullptr, nullptr, A.in[I_N1G] + (L + 1) * 1024, MOD + (size_t)(L + 1) * 5 * 6144, 0, H, nr_in(L + 1));
                        else {
#ifdef MK_CHECK
                            const float* chk = (const float*)(ws + WS_CTL) + CW_CHK; const float err = sqrtf(chk[0] / fmaxf(chk[1], 1e-30f));
                            phase_final_norm(XL, A.in[I_FNG], 1.f + 10.f * err);
#else
                            phase_final_norm(XL, A.in[I_FNG], 1.f);
#endif
                        } }
    }
#undef PH
}

#ifdef MK_TAP
__global__ void tap_kernel(const unsigned short* buf, size_t pitch, size_t col0, size_t ncols, size_t nrows, float* out) {
    const size_t n = ncols * nrows;
    for (size_t i = (size_t)blockIdx.x * blockDim.x + threadIdx.x; i < (size_t)NLAT * D; i += (size_t)gridDim.x * blockDim.x) {
        float s = 0.f; for (size_t j = i; j < n; j += (size_t)NLAT * D) s += (float)buf[(j / ncols) * pitch + col0 + (j % ncols)]; out[i] = s; }
}
#endif
extern "C" void kernel_launch(void* const* d_in, const int* in_sizes, int n_in, void* d_out, int out_size, void* d_ws, size_t ws_size, hipStream_t stream) {
    static int grid = 0;
    if (grid == 0) {
        if (n_in != N_IN || out_size != NLAT * D || ws_size < WS_END) { fprintf(stderr, "kernel_launch: unexpected shapes (n_in %d out %d ws %zu, need %zu)\n", n_in, out_size, ws_size, (size_t)WS_END); grid = -1; return; }
        int dev = 0, cus = 0, per_cu = 0;
        if (hipGetDevice(&dev) != hipSuccess || hipDeviceGetAttribute(&cus, hipDeviceAttributeMultiprocessorCount, dev) != hipSuccess) { grid = -1; return; }
        if (hipFuncSetAttribute((const void*)fwd, hipFuncAttributeMaxDynamicSharedMemorySize, LDS_BYTES) != hipSuccess) { fprintf(stderr, "kernel_launch: hipFuncSetAttribute failed\n"); grid = -1; return; }
        if (hipOccupancyMaxActiveBlocksPerMultiprocessor(&per_cu, (const void*)fwd, NTHR, LDS_BYTES) != hipSuccess || per_cu < 1) { fprintf(stderr, "kernel_launch: occupancy query says %d\n", per_cu); }
        (void)hipGetLastError();
        grid = cus;
    }
    if (grid < 0) return;
    (void)hipMemsetAsync((char*)d_ws + WS_CTL, 0, CTL_BYTES, stream);
    Args a{};
    for (int i = 0; i < N_IN; ++i) a.in[i] = (const float*)d_in[i];
    a.out = (float*)d_out; a.ws = (unsigned char*)d_ws;
#if MK_PER_PHASE
    for (int id = 0; id < 2 + 16 * DEPTH; ++id) {
        if (id >= 2) { const int L = (id - 2) / 16, s = (id - 2) % 16; if (s > 12) continue; if ((L & 1) && (s == 3 || s == 4)) continue; }
#ifdef MK_CUT
#ifdef MK_TAP
        if (id >= MK_CUT) continue;
#else
        if (id >= MK_CUT && id != 2 + 16 * (DEPTH - 1) + 12) continue;
#endif
#endif
        a.ph_lo = id; a.ph_hi = id + 1;
        hipLaunchKernelGGL(fwd, dim3(grid), dim3(NTHR), LDS_BYTES, stream, a);
    }
#ifdef MK_TAP
    { const size_t tp[5] = {MK_TAP}; hipLaunchKernelGGL(tap_kernel, dim3(2048), dim3(256), 0, stream, (const unsigned short*)((const char*)d_ws + tp[0]), tp[1], tp[2], tp[3], tp[4], (float*)d_out); }
#endif
#else
    a.ph_lo = 0; a.ph_hi = 2 + 16 * DEPTH;
    hipLaunchKernelGGL(fwd, dim3(grid), dim3(NTHR), LDS_BYTES, stream, a);
#endif
    const hipError_t le = hipPeekAtLastError();
    if (le != hipSuccess) fprintf(stderr, "kernel_launch: launch failed: %s\n", hipGetErrorName(le));
}
```

```cpp
#include <hip/hip_runtime.h>
#include <cstdio>
#include <cstdint>

#define LAS __attribute__((address_space(3)))
typedef unsigned short bf16_t;
typedef short bf16x8 __attribute__((ext_vector_type(8)));
typedef short s16x4 __attribute__((ext_vector_type(4)));
typedef float f32x2 __attribute__((ext_vector_type(2)));
typedef float f32x4 __attribute__((ext_vector_type(4)));
typedef float f32x16 __attribute__((ext_vector_type(16)));
typedef unsigned u32x2 __attribute__((ext_vector_type(2)));
typedef unsigned u32x4 __attribute__((ext_vector_type(4)));
typedef int i32x4 __attribute__((ext_vector_type(4)));
typedef int i32x8 __attribute__((ext_vector_type(8)));

constexpr int D = 1024, NB = 4, SEQ = 8192, DEPTH = 4, CTXL = 256;
constexpr int NLAT = NB * SEQ, NCTX = NB * CTXL, NROW = NLAT + NCTX;
constexpr int HYB_IN = 3280, HYB_INP = 3328;
constexpr int C_Z = 0, C_XBC = 1024, C_DT = 2560, C_CQ = 2576, C_CKV = 2960, C_KR = 3216;
constexpr int NKEY = SEQ + CTXL, NKT = NKEY / 64;
constexpr float EPS = 1e-6f;
constexpr float QSCALE = 0.07216878364870322f * 1.4426950408889634f;
constexpr int NEXP = 16384;

enum { I_X = 0, I_C, I_CTX, I_CCTX, I_ADAW, I_ADAB, I_N1G, I_N2G, I_HWIN, I_CONVW, I_CONVB, I_ALOG, I_DTB, I_SSDD, I_SSDNG, I_QNG, I_WQB, I_KVNG, I_WKVB,
       I_HWOUT, I_GWIN, I_GLNG, I_GLNB, I_GWS, I_GBS, I_GWOUT, I_PWQ, I_PK1, I_PK2, I_PU, I_PV, I_FNG, N_IN };

constexpr size_t al256(size_t x) { return (x + 255) & ~(size_t)255; }
constexpr size_t WS_CTL = 0, CTL_BYTES = 65536;
constexpr size_t WS_MOD = WS_CTL + CTL_BYTES;
constexpr size_t WS_ROPE = WS_MOD + al256((size_t)DEPTH * 5 * 6144 * 4);
constexpr size_t WS_RSTD = WS_ROPE + (size_t)2 * SEQ * 32 * 4;
constexpr size_t WS_W = WS_RSTD + al256((size_t)2 * NROW * 4);
constexpr size_t W_HYB = 0;
constexpr size_t WH_IN = 0, WH_QB = WH_IN + (size_t)HYB_INP * 1024 * 2, WH_KVB = WH_QB + (size_t)1536 * 384 * 2, WH_OUT = WH_KVB + (size_t)2048 * 256 * 2,
                 WH_SZ = WH_OUT + (size_t)1024 * 2048 * 2;
constexpr size_t W_GM = W_HYB + 2 * WH_SZ;
constexpr size_t WG_IN = 0, WG_OUT = WG_IN + (size_t)4096 * 1024 * 2, WG_WS = WG_OUT + (size_t)1024 * 2048 * 2, WG_SZ = WG_WS + (size_t)8 * 128 * 128 * 2;
constexpr size_t W_PEER = W_GM + 2 * WG_SZ;
constexpr size_t WP_Q = 0, WP_K1 = WP_Q + (size_t)2048 * 1024 * 2, WP_K2 = WP_K1 + (size_t)8 * 128 * 128 * 2, WP_SZ = WP_K2 + (size_t)8 * 128 * 128 * 2;
constexpr size_t W_TOTAL = W_PEER + 4 * WP_SZ;
constexpr size_t WS_TAB = WS_W + al256(W_TOTAL);
constexpr size_t TAB_HALF = (size_t)NEXP * 1024 * 2;
constexpr size_t WS_XC = WS_TAB + 2 * TAB_HALF;
constexpr size_t WS_H = WS_XC + (size_t)NCTX * D * 4;
constexpr size_t WS_BIG = WS_H + (size_t)NROW * D * 2;
constexpr size_t BIG_BYTES = (size_t)NROW * 4096 * 2;
constexpr size_t BIG_DT = (size_t)NROW * HYB_INP * 2;
constexpr size_t BIG_G = BIG_DT + (size_t)NROW * 32 * 4;
constexpr size_t BIG_KR = BIG_G + (size_t)528 * 128 * 128 * 2;
constexpr size_t BIG_PART = (size_t)NROW * 2048 * 2;
static_assert(BIG_KR + (size_t)NB * NKT * 8192 <= BIG_BYTES, "BIG tail");
constexpr size_t WS_R1 = WS_BIG + BIG_BYTES;
constexpr size_t R1_Q = 0, R1_KN = R1_Q + (size_t)NB * 8 * NKEY * 192 * 2, R1_V = R1_KN + (size_t)NB * 8 * NKT * 16384, R1_BYTES = R1_V + (size_t)NB * 8 * NKT * 16384;
constexpr size_t WS_R2 = WS_R1 + R1_BYTES;
constexpr size_t R2_BC = (size_t)NROW * 1024 * 2, R2_BYTES = R2_BC + (size_t)NROW * 512 * 2;
constexpr size_t R2_GATE = (size_t)NROW * 128 * 4, R2_COEF = 2 * R2_GATE;
constexpr size_t WS_R3 = WS_R2 + R2_BYTES;
constexpr size_t R3_CAT = (size_t)NROW * 1024 * 2, R3_BYTES = R3_CAT + (size_t)NROW * 2048 * 2;
constexpr size_t WS_END = WS_R3 + R3_BYTES;
static_assert(WS_END <= ((size_t)1 << 30), "workspace must fit 1 GiB");

constexpr int CW_RANK = 3584;
constexpr int CW_QUEUE = 4096;

typedef __bf16 bf16x2_t __attribute__((ext_vector_type(2)));
__device__ __forceinline__ unsigned cvt_pk_bf16(float lo, float hi) { const f32x2 v = {lo, hi}; const bf16x2_t b = __builtin_convertvector(v, bf16x2_t); return __builtin_bit_cast(unsigned, b); }
__device__ __forceinline__ bf16_t f2bf(float f) { return (bf16_t)(cvt_pk_bf16(f, 0.f) & 0xffffu); }
__device__ __forceinline__ float bf2f(unsigned b) { return __uint_as_float(b << 16); }
__device__ __forceinline__ float bflo(unsigned w) { return __uint_as_float(w << 16); }
__device__ __forceinline__ float bfhi(unsigned w) { return __uint_as_float(w & 0xffff0000u); }
__device__ __forceinline__ float wave_sum(float v) {
#pragma unroll
    for (int o = 32; o >= 1; o >>= 1) v += __shfl_xor(v, o);
    return v;
}
__device__ __forceinline__ int otid() { int t = threadIdx.x; asm volatile("" : "+v"(t)); return t; }
__device__ __forceinline__ float silu_f(float x) { return x / (1.f + __expf(-x)); }
__device__ __forceinline__ float softplus_f(float x) { return x > 20.f ? x : log1pf(__expf(x)); }
__device__ __forceinline__ f32x2 gelu_pk(f32x2 v) {
    const f32x2 av = __builtin_elementwise_abs(v), d = av * 0.2316418882f + 1.0f;
    f32x2 t; t.x = __builtin_amdgcn_rcpf(d.x); t.y = __builtin_amdgcn_rcpf(d.y);
    f32x2 q = t * 0.5307027145f + (-0.7265760135f); q = q * t + 0.7107068705f; q = q * t + (-0.142248368f); q = q * t + 0.127414796f; q = q * t;
    const f32x2 s = (v * v) * (-0.72134752044f);
    f32x2 e; e.x = __builtin_amdgcn_exp2f(s.x); e.y = __builtin_amdgcn_exp2f(s.y);
    const f32x2 m = v * (q * e), r = v - m;
    f32x2 o; o.x = v.x < 0.f ? m.x : r.x; o.y = v.y < 0.f ? m.y : r.y; return o;
}
__device__ __forceinline__ float gelu_f(float x) { f32x2 v = {x, 0.f}; return gelu_pk(v).x; }

__device__ __forceinline__ unsigned pk4_fp8(float a, float b, float c, float d) { int w = 0; w = __builtin_amdgcn_cvt_pk_fp8_f32(a, b, w, false); w = __builtin_amdgcn_cvt_pk_fp8_f32(c, d, w, true); return (unsigned)w; }
__device__ __forceinline__ float sat8(float v) { return __builtin_amdgcn_fmed3f(v, -448.f, 448.f); }
__device__ __forceinline__ unsigned pk4_fp8_sat(float a, float b, float c, float d) { return pk4_fp8(sat8(a), sat8(b), sat8(c), sat8(d)); }
__device__ __forceinline__ int row_mb(int r) { return r < NLAT ? (r >> 13) : 4; }

#define XB_TMO      128
#define XB_XCNT(j)  (256  + 64 * (j))
#define XB_XSUB(j)  (1280 + 64 * (j))
#define XB_XGEN(j)  (2304 + 64 * (j))
#define XB_TOP      3328
#define XB_TOPGEN   3392
#define XCD_BAR_WORDS 3456
#define XB_SPIN_CAP (1u << 22)
__device__ __forceinline__ unsigned xb_ld(unsigned* p)              { return __hip_atomic_load(p, __ATOMIC_RELAXED, __HIP_MEMORY_SCOPE_AGENT); }
__device__ __forceinline__ unsigned xb_add(unsigned* p, unsigned v) { return __hip_atomic_fetch_add(p, v, __ATOMIC_RELAXED, __HIP_MEMORY_SCOPE_AGENT); }
__device__ __forceinline__ unsigned xb_xcc_id() { return (unsigned)__builtin_amdgcn_s_getreg((3 << 11) | 20) & 0xFu; }
#define XB_SPIN(cond, bar) do { unsigned _sp = 0; while (cond) { __builtin_amdgcn_s_sleep(1); \
    if ((++_sp & 255u) == 0u) { if (xb_ld(&(bar)[XB_TMO])) break; if (_sp > XB_SPIN_CAP) { atomicAdd(&(bar)[XB_TMO], 1u); break; } } } } while (0)
struct XcdBarrier { unsigned* bar; unsigned x; volatile LAS unsigned* st; };
__device__ __forceinline__ XcdBarrier xcd_barrier_post(unsigned* bar, volatile LAS unsigned* st) {
    XcdBarrier b; b.bar = bar; b.x = xb_xcc_id(); b.st = st;
    if (threadIdx.x == 0) (void)xb_add(&bar[XB_XCNT(b.x)], 1u);
    return b;
}
__device__ __forceinline__ void xcd_barrier_complete(unsigned* bar, unsigned x, unsigned& nloc, unsigned& nx) {
    const unsigned G = gridDim.x * gridDim.y * gridDim.z;
    unsigned sum, cnt, mine, sp = 0u;
    for (;;) {
        sum = 0u; cnt = 0u; mine = 0u;
#pragma unroll
        for (unsigned j = 0; j < 16; ++j) { const unsigned c = xb_ld(&bar[XB_XCNT(j)]); sum += c; cnt += (c > 0u) ? 1u : 0u; mine = (j == x) ? c : mine; }
        if (sum == G) break;
        __builtin_amdgcn_s_sleep(1);
        if ((++sp & 255u) == 0u) { if (xb_ld(&bar[XB_TMO])) break; if (sp > XB_SPIN_CAP) { atomicAdd(&bar[XB_TMO], 1u); break; } }
    }
    nloc = mine > 0u ? mine : 1u; nx = cnt > 0u ? cnt : 1u;
}
__device__ __forceinline__ void xcd_barrier(const XcdBarrier& b) {
    asm volatile("s_waitcnt vmcnt(0)" ::: "memory");
    __syncthreads();
    if (threadIdx.x == 0) {
        unsigned* bar = b.bar;
        __builtin_amdgcn_s_waitcnt(0);
        unsigned nloc = b.st[0], nx = b.st[1];
        if (nloc == 0u) { xcd_barrier_complete(bar, b.x, nloc, nx); b.st[0] = nloc; b.st[1] = nx; }
        const unsigned old = xb_add(&bar[XB_XSUB(b.x)], 1u);
        const unsigned gen = old / nloc;
        if (old + 1u == (gen + 1u) * nloc) {
            __builtin_amdgcn_fence(__ATOMIC_RELEASE, "agent");
            asm volatile("s_waitcnt vmcnt(0)" ::: "memory");
            const unsigned og = xb_add(&bar[XB_TOP], 1u);
            const unsigned tg = og / nx;
            if (og + 1u == (tg + 1u) * nx) xb_add(&bar[XB_TOPGEN], 1u);
            else XB_SPIN(xb_ld(&bar[XB_TOPGEN]) == tg, bar);
            __builtin_amdgcn_fence(__ATOMIC_ACQUIRE, "agent");
            xb_add(&bar[XB_XGEN(b.x)], 1u);
            asm volatile("s_waitcnt vmcnt(0)" ::: "memory");
        } else {
            XB_SPIN(xb_ld(&bar[XB_XGEN(b.x)]) == gen, bar);
            __builtin_amdgcn_fence(__ATOMIC_ACQUIRE, "agent");
            asm volatile("s_waitcnt vmcnt(0)" ::: "memory");
        }
    }
    __syncthreads();
}

namespace pg8 {
constexpr int BM = 256, BK = 64, HALF = 128, HTB = HALF * BK * 2, STAGE_BYTES = 8 * HTB, NXCD = 8, WGM = 8;
__host__ __device__ __forceinline__ int lds_byte(int r, int c) { const int st = (r >> 4) * 2 + (c >> 5), rr = r & 15, cc = c & 31, ob = rr * 64 + cc * 2; return st * 1024 + (ob ^ (((ob >> 9) & 1) << 5)); }
__host__ __device__ __forceinline__ void stage_rc(int b, int& R, int& C) { const int st = b / 1024, sb = b % 1024, swz = sb ^ (((sb >> 9) & 1) << 5); R = (st >> 1) * 16 + swz / 64; C = (st & 1) * 32 + (swz % 64) / 2; }
__host__ __device__ __forceinline__ int perm32(int rho) { const int n = rho >> 4, i = rho & 15; return 8 * (i >> 2) + 4 * n + (i & 3); }
struct Unit { int pm, pn; };
struct Gemm { const bf16_t* A; const bf16_t* Bt; int M, N, K, lda, ldb; };
struct StaticOrder {
    int nM, nN, nwg, G, c;
    __device__ void init(int M, int N, int G_, int c_) { nM = M / BM; nN = N / BM; nwg = nM * nN; G = G_; c = c_; }
    __device__ bool next(int i, Unit& u) const {
        const long L = (long)i * G + c; if (L >= nwg) return false;
        int wgid = (int)L; { const int q = nwg / NXCD, r = nwg % NXCD, xcd = wgid % NXCD, off = wgid / NXCD; wgid = (xcd < r ? xcd * (q + 1) : r * (q + 1) + (xcd - r) * q) + off; }
        const int nig = WGM * nN, gid = wgid / nig, fm = gid * WGM, gsz = (nM - fm) < WGM ? (nM - fm) : WGM;
        u.pm = fm + ((wgid % nig) % gsz); u.pn = (wgid % nig) / gsz; return true;
    }
};
template <class Epi>
__device__ __forceinline__ void gemm_phase(LAS unsigned char* lds, const Gemm g, const Epi& E) {
    const int tid = otid(), wid = __builtin_amdgcn_readfirstlane(tid >> 6), lane = tid & 63, wr = wid >> 2, wc = wid & 3, fr = lane & 15, fq = lane >> 4;
    StaticOrder S; S.init(g.M, g.N, (int)gridDim.x, (int)blockIdx.x);
    int K = g.K; asm volatile("" : "+s"(K));
    const int nt = K / BK;
    unsigned voffA[2], voffB[2];
#pragma unroll
    for (int i = 0; i < 2; ++i) { int R, C; stage_rc(tid * 16 + i * 8192, R, C); const int Rb = Epi::PERM ? ((R & ~31) + perm32(R & 31)) : R;
        voffA[i] = (unsigned)(R * g.lda + C) * 2u; voffB[i] = (unsigned)(Rb * g.ldb + C) * 2u; }
    const size_t kstep = (size_t)(BK * 2);
    const size_t hstepA = (size_t)HALF * g.lda * 2, hstepB = (size_t)HALF * g.ldb * 2;
    const size_t tstepA = 2 * hstepA, tstepB = 2 * hstepB;
    const unsigned ldsw = (unsigned)wid * 1024u;
    const int aoff = lds_byte(wr * 64 + fr, fq * 8), boff = lds_byte(wc * 32 + fr, fq * 8);
#define PG8_SA(b, h) (((b) * 2 + (h)) * HTB)
#define PG8_SB(b, h) ((4 + (b) * 2 + (h)) * HTB)
#define PG8_STAGE(bufoff, gbase, voff) do { _Pragma("unroll") for (int _i = 0; _i < 2; ++_i) \
        __builtin_amdgcn_global_load_lds((const unsigned*)((const char*)(gbase) + (voff)[_i]), (LAS unsigned*)(lds + (bufoff) + ldsw + _i * 8192), 16, 0, 0); } while (0)
#define PG8_LDA(dst, b, h) do { _Pragma("unroll") for (int m = 0; m < 4; ++m) _Pragma("unroll") for (int k = 0; k < 2; ++k) dst[m][k] = *(const LAS bf16x8*)(lds + PG8_SA(b, h) + aoff + m * 2048 + k * 1024); } while (0)
#define PG8_LDB(dst, b, h) do { _Pragma("unroll") for (int n = 0; n < 2; ++n) _Pragma("unroll") for (int k = 0; k < 2; ++k) dst[n][k] = *(const LAS bf16x8*)(lds + PG8_SB(b, h) + boff + n * 2048 + k * 1024); } while (0)
#define PG8_MMA(ai, bj, At, Bt) do { __builtin_amdgcn_s_setprio(1); _Pragma("unroll") for (int m = 0; m < 4; ++m) _Pragma("unroll") for (int n = 0; n < 2; ++n) _Pragma("unroll") for (int k = 0; k < 2; ++k) \
        acc[ai][bj][m][n] = __builtin_amdgcn_mfma_f32_16x16x32_bf16(Bt[n][k], At[m][k], acc[ai][bj][m][n], 0, 0, 0); __builtin_amdgcn_s_setprio(0); } while (0)
#define PG8_WAIT_V(n) asm volatile("s_waitcnt vmcnt(" #n ")" ::: "memory")
#define PG8_WAIT_L(n) asm volatile("s_waitcnt lgkmcnt(" #n ")" ::: "memory")
#define PG8_BAR __builtin_amdgcn_s_barrier()
#define PG8_SCHED __builtin_amdgcn_sched_barrier(0)
    Unit cur, nxt; int ui = 0;
    if (!S.next(0, cur)) return;
    f32x4 acc[2][2][4][2];
#pragma unroll
    for (int a = 0; a < 2; ++a)
#pragma unroll
        for (int b = 0; b < 2; ++b)
#pragma unroll
            for (int m = 0; m < 4; ++m)
#pragma unroll
                for (int n = 0; n < 2; ++n) acc[a][b][m][n] = (f32x4){0.f, 0.f, 0.f, 0.f};
    bf16x8 At[4][2], B0[2][2], B1[2][2];
    const char* cA = (const char*)g.A + (size_t)cur.pm * tstepA; const char* cB = (const char*)g.Bt + (size_t)cur.pn * tstepB;
    PG8_STAGE(PG8_SB(0, 0), cB, voffB); PG8_STAGE(PG8_SB(0, 1), cB + hstepB, voffB); PG8_STAGE(PG8_SA(0, 0), cA, voffA); PG8_STAGE(PG8_SA(0, 1), cA + hstepA, voffA);
    if (wr == 1) PG8_BAR;
    PG8_WAIT_V(2); PG8_BAR;
    PG8_STAGE(PG8_SB(1, 0), cB + kstep, voffB); PG8_STAGE(PG8_SA(1, 0), cA + kstep, voffA); PG8_STAGE(PG8_SB(1, 1), cB + hstepB + kstep, voffB);
    PG8_WAIT_V(6); PG8_BAR;
    for (;;) {
        const bool has_next = S.next(ui + 1, nxt);
        const char* nA = has_next ? (const char*)g.A + (size_t)nxt.pm * tstepA : cA; const char* nB = has_next ? (const char*)g.Bt + (size_t)nxt.pn * tstepB : cB;
        for (int t = 0; t < nt; t += 2) {
            const bool last = (t == nt - 2);
            const char* a1 = cA + (size_t)(t + 1) * kstep;
            const char* a2 = last ? nA : cA + (size_t)(t + 2) * kstep; const char* b2 = last ? nB : cB + (size_t)(t + 2) * kstep;
            const char* a3 = a2 + kstep; const char* b3 = b2 + kstep;
            PG8_LDB(B0, 0, 0); PG8_LDB(B1, 0, 1); PG8_SCHED; PG8_LDA(At, 0, 0); PG8_STAGE(PG8_SA(1, 1), a1 + hstepA, voffA);
            PG8_WAIT_V(8); PG8_WAIT_L(0); PG8_BAR; PG8_MMA(0, 0, At, B0); PG8_MMA(0, 1, At, B1); PG8_BAR; PG8_SCHED;
            PG8_LDA(At, 0, 1); PG8_STAGE(PG8_SB(0, 0), b2, voffB); PG8_STAGE(PG8_SB(0, 1), b2 + hstepB, voffB); PG8_STAGE(PG8_SA(0, 0), a2, voffA);
            PG8_WAIT_V(8); PG8_WAIT_L(0); PG8_BAR; PG8_MMA(1, 0, At, B0); PG8_MMA(1, 1, At, B1); PG8_BAR; PG8_SCHED;
            PG8_LDB(B0, 1, 0); PG8_LDB(B1, 1, 1); PG8_SCHED; PG8_LDA(At, 1, 0); PG8_STAGE(PG8_SA(0, 1), a2 + hstepA, voffA);
            PG8_WAIT_V(8); PG8_WAIT_L(0); PG8_BAR; PG8_MMA(0, 0, At, B0); PG8_MMA(0, 1, At, B1); PG8_BAR; PG8_SCHED;
            PG8_LDA(At, 1, 1); PG8_STAGE(PG8_SB(1, 0), b3, voffB); PG8_STAGE(PG8_SB(1, 1), b3 + hstepB, voffB); PG8_STAGE(PG8_SA(1, 0), a3, voffA);
            PG8_WAIT_V(8); PG8_WAIT_L(0); PG8_BAR; PG8_MMA(1, 0, At, B0); PG8_MMA(1, 1, At, B1); PG8_BAR; PG8_SCHED;
        }
        if (wr == 0) PG8_BAR;
        { const int l2_ = otid() & 63; E(acc, cur, wr, wc, l2_ & 15, l2_ >> 4); }
        if (!has_next) break;
#pragma unroll
        for (int a = 0; a < 2; ++a)
#pragma unroll
            for (int b = 0; b < 2; ++b)
#pragma unroll
                for (int m = 0; m < 4; ++m)
#pragma unroll
                    for (int n = 0; n < 2; ++n) acc[a][b][m][n] = (f32x4){0.f, 0.f, 0.f, 0.f};
        cur = nxt; cA = nA; cB = nB; ++ui;
        if (wr == 1) PG8_BAR;
    }
    PG8_WAIT_V(0);
    PG8_BAR;
#undef PG8_SA
#undef PG8_SB
#undef PG8_STAGE
#undef PG8_LDA
#undef PG8_LDB
#undef PG8_MMA
#undef PG8_WAIT_V
#undef PG8_WAIT_L
#undef PG8_BAR
#undef PG8_SCHED
}

template <int ACT> struct EpiBf16 {
    static constexpr bool PERM = true;
    bf16_t* O; int ldc;
    __device__ __forceinline__ void operator()(const f32x4 (&acc)[2][2][4][2], const Unit& u, int wr, int wc, int fr, int fq) const {
        const int row0 = u.pm * BM + wr * 64 + fr, col0 = u.pn * BM + wc * 32 + 8 * fq;
#pragma unroll
        for (int ai = 0; ai < 2; ++ai)
#pragma unroll
            for (int m = 0; m < 4; ++m) { bf16_t* rowp = O + (size_t)(row0 + ai * HALF + m * 16) * ldc + col0;
#pragma unroll
                for (int bj = 0; bj < 2; ++bj) { f32x4 v0 = acc[ai][bj][m][0], v1 = acc[ai][bj][m][1];
                    if (ACT == 1) { f32x2 a = gelu_pk((f32x2){v0[0], v0[1]}), b = gelu_pk((f32x2){v0[2], v0[3]}), c = gelu_pk((f32x2){v1[0], v1[1]}), d = gelu_pk((f32x2){v1[2], v1[3]});
                        v0 = (f32x4){a.x, a.y, b.x, b.y}; v1 = (f32x4){c.x, c.y, d.x, d.y}; }
                    u32x4 w; w.x = cvt_pk_bf16(v0[0], v0[1]); w.y = cvt_pk_bf16(v0[2], v0[3]); w.z = cvt_pk_bf16(v1[0], v1[1]); w.w = cvt_pk_bf16(v1[2], v1[3]);
                    *(u32x4*)(rowp + bj * HALF) = w; } }
    }
};
struct EpiResid {
    static constexpr bool PERM = false;
    float* xl; float* xc; const float* gate;
    __device__ __forceinline__ void operator()(const f32x4 (&acc)[2][2][4][2], const Unit& u, int wr, int wc, int fr, int fq) const {
        const int rbase = u.pm * BM; const bool lat = rbase < NLAT;
        float* X = lat ? xl + (size_t)rbase * D : xc + (size_t)(rbase - NLAT) * D;
        const float* gp = gate + (size_t)(lat ? (rbase >> 13) : 4) * 6144;
        const int row0 = wr * 64 + fr, col0 = u.pn * BM + wc * 32 + 4 * fq;
        f32x4 gv[2][2];
#pragma unroll
        for (int bj = 0; bj < 2; ++bj)
#pragma unroll
            for (int n = 0; n < 2; ++n) gv[bj][n] = *(const f32x4*)(gp + col0 + bj * HALF + n * 16);
#pragma unroll
        for (int ai = 0; ai < 2; ++ai)
#pragma unroll
            for (int m = 0; m < 4; ++m) { float* rowp = X + (size_t)(row0 + ai * HALF + m * 16) * D + col0;
#pragma unroll
                for (int bj = 0; bj < 2; ++bj)
#pragma unroll
                    for (int n = 0; n < 2; ++n) { f32x4* p = (f32x4*)(rowp + bj * HALF + n * 16); *p = *p + gv[bj][n] * acc[ai][bj][m][n]; } }
    }
};
}

namespace att {
constexpr int SLOT = 40960, KN_OFF = 0, KR_OFF = 16384, V_OFF = 24576, LDS_BYTES = 3 * SLOT + 8 * 256;
constexpr float THR2 = 11.0f;
#define KSWZ(row, colB) ((row) * 256 + ((colB) ^ (((row) & 7) << 4)))
#define KRSWZ(row, colB) ((row) * 128 + ((colB) ^ ((((row) >> 1) & 7) << 4)))
#define SBAR() __builtin_amdgcn_sched_barrier(0)
__device__ __forceinline__ int crow(int r, int hi) { return (r & 3) + 8 * (r >> 2) + 4 * hi; }
__host__ __device__ __forceinline__ int v_st(int k, int c) { const int kk = (k & ~0xC) | ((k & 4) << 1) | ((k & 8) >> 1); return ((kk >> 3) * 4 + (c >> 5)) * 512 + ((kk & 7) * 32 + (c & 31)) * 2; }
__device__ __forceinline__ int v_rd_base(int lane) { return ((lane & 3) << 3) | (((lane >> 2) & 3) << 6) | (((lane >> 4) & 1) << 5) | (((lane >> 5) & 1) << 8); }
constexpr int v_rd_off(int d0, int ks, int half) { return d0 * 512 + ks * 4096 + half * 2048; }
template <int OFF> __device__ __forceinline__ s16x4 tr_read(int vb) {
    s16x4 r; asm volatile("ds_read_b64_tr_b16 %0, %1 offset:%2" : "=&v"(r) : "v"(vb), "i"(OFF) : "memory"); return r;
}
template <int D0> __device__ __forceinline__ void pv_one(f32x16& od, int vb, bf16x8 pa0, bf16x8 pa1, bf16x8 pa2, bf16x8 pa3) {
    const s16x4 l0 = tr_read<v_rd_off(D0, 0, 0)>(vb), h0 = tr_read<v_rd_off(D0, 0, 1)>(vb), l1 = tr_read<v_rd_off(D0, 1, 0)>(vb), h1 = tr_read<v_rd_off(D0, 1, 1)>(vb);
    const s16x4 l2 = tr_read<v_rd_off(D0, 2, 0)>(vb), h2 = tr_read<v_rd_off(D0, 2, 1)>(vb), l3 = tr_read<v_rd_off(D0, 3, 0)>(vb), h3 = tr_read<v_rd_off(D0, 3, 1)>(vb);
    asm volatile("s_waitcnt lgkmcnt(0)" ::: "memory"); SBAR();
#define PK(L, H) (bf16x8){L[0], L[1], L[2], L[3], H[0], H[1], H[2], H[3]}
    od = __builtin_amdgcn_mfma_f32_32x32x16_bf16(pa0, PK(l0, h0), od, 0, 0, 0);
    od = __builtin_amdgcn_mfma_f32_32x32x16_bf16(pa1, PK(l1, h1), od, 0, 0, 0);
    od = __builtin_amdgcn_mfma_f32_32x32x16_bf16(pa2, PK(l2, h2), od, 0, 0, 0);
    od = __builtin_amdgcn_mfma_f32_32x32x16_bf16(pa3, PK(l3, h3), od, 0, 0, 0);
#undef PK
}
__device__ __forceinline__ void pv_d0(f32x16* o, int vb, bf16x8 pa0, bf16x8 pa1, bf16x8 pa2, bf16x8 pa3) {
    pv_one<0>(o[0], vb, pa0, pa1, pa2, pa3); pv_one<1>(o[1], vb, pa0, pa1, pa2, pa3); pv_one<2>(o[2], vb, pa0, pa1, pa2, pa3); pv_one<3>(o[3], vb, pa0, pa1, pa2, pa3);
}
__device__ __forceinline__ void partialSM(f32x16& p0, f32x16& p1, float& m_reg, float& mn, float& alpha) {
    float pmax = p0[0];
#pragma unroll
    for (int r = 1; r < 16; ++r) pmax = fmaxf(pmax, p0[r]);
#pragma unroll
    for (int r = 0; r < 16; ++r) pmax = fmaxf(pmax, p1[r]);
    { auto rr = __builtin_amdgcn_permlane32_swap(__float_as_uint(pmax), __float_as_uint(pmax), false, false);
      pmax = fmaxf(__uint_as_float(rr[0]), __uint_as_float(rr[1])); }
    if (__builtin_expect(__all(pmax - m_reg <= THR2), 1)) { mn = m_reg; alpha = 1.f; }
    else { mn = fmaxf(m_reg, pmax); alpha = __builtin_amdgcn_exp2f(m_reg - mn); m_reg = mn; }
#pragma unroll
    for (int r = 0; r < 16; ++r) p0[r] = __builtin_amdgcn_exp2f(p0[r] - mn);
#pragma unroll
    for (int r = 0; r < 16; ++r) p1[r] = p1[r] - mn;
}
__device__ __forceinline__ void finishSM(f32x16& p0, f32x16& p1, float alpha, float& l_reg, bf16x8& pa0, bf16x8& pa1, bf16x8& pa2, bf16x8& pa3) {
#pragma unroll
    for (int r = 0; r < 16; ++r) p1[r] = __builtin_amdgcn_exp2f(p1[r]);
    float ps = 0;
#pragma unroll
    for (int r = 0; r < 16; ++r) ps += p0[r];
#pragma unroll
    for (int r = 0; r < 16; ++r) ps += p1[r];
    { auto rr = __builtin_amdgcn_permlane32_swap(__float_as_uint(ps), __float_as_uint(ps), false, false);
      ps = __uint_as_float(rr[0]) + __uint_as_float(rr[1]); }
    l_reg = l_reg * alpha + ps;
#define PK4(P, BASE, OUT) do { unsigned a0 = cvt_pk_bf16(P[BASE + 0], P[BASE + 1]), a1 = cvt_pk_bf16(P[BASE + 2], P[BASE + 3]);   \
    unsigned b0 = cvt_pk_bf16(P[BASE + 4], P[BASE + 5]), b1 = cvt_pk_bf16(P[BASE + 6], P[BASE + 7]);                              \
    auto r0 = __builtin_amdgcn_permlane32_swap(a0, b0, false, false); auto r1 = __builtin_amdgcn_permlane32_swap(a1, b1, false, false); \
    u32x4 w = {r0[0], r1[0], r0[1], r1[1]}; OUT = *reinterpret_cast<bf16x8*>(&w); } while (0)
    PK4(p0, 0, pa0); PK4(p0, 8, pa1); PK4(p1, 0, pa2); PK4(p1, 8, pa3);
#undef PK4
}
__device__ __forceinline__ void qkt(f32x16& p0, f32x16& p1, LAS unsigned char* slot, const bf16x8* qr, int r32, int hi) {
    p0 = f32x16{}; p1 = f32x16{};
#pragma unroll
    for (int d0 = 0; d0 < 8; ++d0) { const int cb = (d0 * 16 + hi * 8) * 2;
        bf16x8 b0 = *(const LAS bf16x8*)(slot + KN_OFF + KSWZ(r32, cb));
        bf16x8 b1 = *(const LAS bf16x8*)(slot + KN_OFF + KSWZ(32 + r32, cb));
        p0 = __builtin_amdgcn_mfma_f32_32x32x16_bf16(b0, qr[d0], p0, 0, 0, 0);
        p1 = __builtin_amdgcn_mfma_f32_32x32x16_bf16(b1, qr[d0], p1, 0, 0, 0); }
#pragma unroll
    for (int d0 = 0; d0 < 4; ++d0) { const int cb = (d0 * 16 + hi * 8) * 2;
        bf16x8 b0 = *(const LAS bf16x8*)(slot + KR_OFF + KRSWZ(r32, cb));
        bf16x8 b1 = *(const LAS bf16x8*)(slot + KR_OFF + KRSWZ(32 + r32, cb));
        p0 = __builtin_amdgcn_mfma_f32_32x32x16_bf16(b0, qr[8 + d0], p0, 0, 0, 0);
        p1 = __builtin_amdgcn_mfma_f32_32x32x16_bf16(b1, qr[8 + d0], p1, 0, 0, 0); }
}
__device__ __forceinline__ void attn_unit(const bf16_t* __restrict__ Qb, const unsigned char* __restrict__ KNt, const unsigned char* __restrict__ KRt, const unsigned char* __restrict__ Vt,
                                          bf16_t* __restrict__ Ob, int NT, LAS unsigned char* lds) {
    const int tid = otid(), wid = __builtin_amdgcn_readfirstlane(tid >> 6), lane = tid & 63, r32 = lane & 31, hi = lane >> 5;
    LAS float* wsf = (LAS float*)(lds + 3 * SLOT) + wid * 64; LAS float* li_l = wsf; LAS float* al_l = wsf + 32;
    float m_reg = -1e30f, l_reg = 0; f32x16 o[4] = {}; bf16x8 qr[12];
    const bf16_t* Qw = Qb + (size_t)(wid * 32 + r32) * 192 + hi * 8;
#pragma unroll
    for (int d0 = 0; d0 < 12; ++d0) qr[d0] = *(const bf16x8*)(Qw + d0 * 16);
    const int vrb = (int)(unsigned)(uintptr_t)(lds) + V_OFF + v_rd_base(lane);
    const unsigned lo16 = (unsigned)lane * 16u;
#define ATT_DMA(tile, slotoff) do { const size_t t_ = (size_t)(tile); LAS unsigned char* sl_ = lds + (slotoff); \
        __builtin_amdgcn_global_load_lds((const unsigned*)(KNt + t_ * 16384 + wid * 1024 + lo16), (LAS unsigned*)(sl_ + KN_OFF + wid * 1024), 16, 0, 0); \
        __builtin_amdgcn_global_load_lds((const unsigned*)(KNt + t_ * 16384 + (wid + 8) * 1024 + lo16), (LAS unsigned*)(sl_ + KN_OFF + (wid + 8) * 1024), 16, 0, 0); \
        __builtin_amdgcn_global_load_lds((const unsigned*)(KRt + t_ * 8192 + wid * 1024 + lo16), (LAS unsigned*)(sl_ + KR_OFF + wid * 1024), 16, 0, 0); \
        __builtin_amdgcn_global_load_lds((const unsigned*)(Vt + t_ * 16384 + wid * 1024 + lo16), (LAS unsigned*)(sl_ + V_OFF + wid * 1024), 16, 0, 0); \
        __builtin_amdgcn_global_load_lds((const unsigned*)(Vt + t_ * 16384 + (wid + 8) * 1024 + lo16), (LAS unsigned*)(sl_ + V_OFF + (wid + 8) * 1024), 16, 0, 0); } while (0)
#define ATT_SYNC() do { asm volatile("s_waitcnt vmcnt(0)" ::: "memory"); __builtin_amdgcn_s_barrier(); asm volatile("" ::: "memory"); } while (0)
#define RESC(a) do { if (__any((a) < 1.f)) { if (hi == 0) al_l[r32] = (a); asm volatile("s_waitcnt lgkmcnt(0)" ::: "memory"); \
        _Pragma("unroll") for (int d = 0; d < 4; ++d) _Pragma("unroll") for (int r = 0; r < 16; ++r) o[d][r] *= al_l[crow(r, hi)]; } } while (0)
    f32x16 pA0, pA1, pB0, pB1; float mnA, mnB, alA, alB; bf16x8 pa0, pa1, pa2, pa3;
    int sp = 0, sc = SLOT, sn = 2 * SLOT;
    ATT_DMA(0, 0); ATT_DMA(1, SLOT);
    asm volatile("s_waitcnt vmcnt(5)" ::: "memory"); __builtin_amdgcn_s_barrier(); asm volatile("" ::: "memory");
    qkt(pA0, pA1, lds, qr, r32, hi); partialSM(pA0, pA1, m_reg, mnA, alA);
    for (int j = 1; j + 1 < NT; j += 2) {
        ATT_SYNC(); ATT_DMA(j + 1, sn);
        SBAR(); qkt(pB0, pB1, lds + sc, qr, r32, hi);
        finishSM(pA0, pA1, alA, l_reg, pa0, pa1, pa2, pa3); SBAR();
        pv_d0(o, vrb + sp, pa0, pa1, pa2, pa3); partialSM(pB0, pB1, m_reg, mnB, alB);
        RESC(alB);
        { const int t_ = sp; sp = sc; sc = sn; sn = t_; }
        ATT_SYNC(); if (j + 2 < NT) ATT_DMA(j + 2, sn);
        SBAR(); qkt(pA0, pA1, lds + sc, qr, r32, hi);
        finishSM(pB0, pB1, alB, l_reg, pa0, pa1, pa2, pa3); SBAR();
        pv_d0(o, vrb + sp, pa0, pa1, pa2, pa3); partialSM(pA0, pA1, m_reg, mnA, alA);
        RESC(alA);
        { const int t_ = sp; sp = sc; sc = sn; sn = t_; }
    }
    ATT_SYNC();
    SBAR(); qkt(pB0, pB1, lds + sc, qr, r32, hi);
    finishSM(pA0, pA1, alA, l_reg, pa0, pa1, pa2, pa3); SBAR();
    pv_d0(o, vrb + sp, pa0, pa1, pa2, pa3); partialSM(pB0, pB1, m_reg, mnB, alB);
    RESC(alB);
    finishSM(pB0, pB1, alB, l_reg, pa0, pa1, pa2, pa3); SBAR();
    pv_d0(o, vrb + sc, pa0, pa1, pa2, pa3);
    if (hi == 0) li_l[r32] = l_reg; asm volatile("s_waitcnt lgkmcnt(0)" ::: "memory");
    float rli[16];
#pragma unroll
    for (int r = 0; r < 16; ++r) rli[r] = __builtin_amdgcn_rcpf(li_l[crow(r, hi)]);
    bf16_t* Ow = Ob + (size_t)(wid * 32) * 2048;
#pragma unroll
    for (int r = 0; r < 16; ++r) { const int orow = crow(r, hi);
#pragma unroll
        for (int d0 = 0; d0 < 4; ++d0) Ow[(size_t)orow * 2048 + d0 * 32 + r32] = f2bf(o[d0][r] * rli[r]); }
    __builtin_amdgcn_s_barrier(); asm volatile("" ::: "memory");
#undef ATT_DMA
#undef ATT_SYNC
#undef RESC
}
}

namespace att8 {
constexpr int SLOT = 20480, KN_OFF = 0, KR_OFF = 8192, V_OFF = 12288, LDS_BYTES = 3 * SLOT + 8 * 256;
constexpr float THR2 = 8.0f;
constexpr float QUP = 8.f; constexpr int SC_ONE = 0x7f7f7f7f, SC_Q = 0x7c7c7c7c;
__host__ __device__ __forceinline__ int kn8(int key, int b) { return key * 128 + ((((b >> 4) ^ ((key >> 1) & 7))) << 4) + (b & 15); }
__host__ __device__ __forceinline__ int kr8(int key, int b) { return key * 64 + ((((b >> 4) ^ ((key >> 2) & 3))) << 4) + (b & 15); }
__host__ __device__ __forceinline__ int vslot(int k) { return 32 * ((k >> 2) & 1) + 16 * (k >> 5) + (k & 3) + 4 * ((k & 31) >> 3); }
__host__ __device__ __forceinline__ int v8(int d, int k) { const int sl = vslot(k); return d * 64 + ((((sl >> 4) ^ ((d >> 2) & 3))) << 4) + (sl & 15); }
__device__ __forceinline__ i32x8 ld32(const LAS unsigned char* a0, const LAS unsigned char* a1) { const u32x4 x = *(const LAS u32x4*)a0, y = *(const LAS u32x4*)a1;
    return (i32x8){(int)x.x, (int)x.y, (int)x.z, (int)x.w, (int)y.x, (int)y.y, (int)y.z, (int)y.w}; }
__device__ __forceinline__ void qkt(f32x16& p0, f32x16& p1, LAS unsigned char* slot, const i32x8* qf, int r32, int hi) {
    p0 = f32x16{}; p1 = f32x16{};
#pragma unroll
    for (int ks = 0; ks < 2; ++ks) { const int b = 64 * ks + 32 * hi;
        const i32x8 a0 = ld32(slot + KN_OFF + kn8(r32, b), slot + KN_OFF + kn8(r32, b + 16)), a1 = ld32(slot + KN_OFF + kn8(32 + r32, b), slot + KN_OFF + kn8(32 + r32, b + 16));
        p0 = __builtin_amdgcn_mfma_scale_f32_32x32x64_f8f6f4(a0, qf[ks], p0, 0, 0, 0, SC_ONE, 0, SC_Q);
        p1 = __builtin_amdgcn_mfma_scale_f32_32x32x64_f8f6f4(a1, qf[ks], p1, 0, 0, 0, SC_ONE, 0, SC_Q); }
    { const int b = 32 * hi;
        const i32x8 a0 = ld32(slot + KR_OFF + kr8(r32, b), slot + KR_OFF + kr8(r32, b + 16)), a1 = ld32(slot + KR_OFF + kr8(32 + r32, b), slot + KR_OFF + kr8(32 + r32, b + 16));
        p0 = __builtin_amdgcn_mfma_scale_f32_32x32x64_f8f6f4(a0, qf[2], p0, 0, 0, 0, SC_ONE, 0, SC_Q);
        p1 = __builtin_amdgcn_mfma_scale_f32_32x32x64_f8f6f4(a1, qf[2], p1, 0, 0, 0, SC_ONE, 0, SC_Q); }
}
__device__ __forceinline__ void partialSM(f32x16& p0, f32x16& p1, float& m_reg, float& mn, float& alpha) {
    float pmax = p0[0];
#pragma unroll
    for (int r = 1; r < 16; ++r) pmax = fmaxf(pmax, p0[r]);
#pragma unroll
    for (int r = 0; r < 16; ++r) pmax = fmaxf(pmax, p1[r]);
    { auto rr = __builtin_amdgcn_permlane32_swap(__float_as_uint(pmax), __float_as_uint(pmax), false, false);
      pmax = fmaxf(__uint_as_float(rr[0]), __uint_as_float(rr[1])); }
    if (__builtin_expect(__all(pmax - m_reg <= THR2), 1)) { mn = m_reg; alpha = 1.f; }
    else { mn = fmaxf(m_reg, pmax); alpha = __builtin_amdgcn_exp2f(m_reg - mn); m_reg = mn; }
#pragma unroll
    for (int r = 0; r < 16; ++r) p0[r] = __builtin_amdgcn_exp2f(p0[r] - mn);
#pragma unroll
    for (int r = 0; r < 16; ++r) p1[r] = p1[r] - mn;
}
__device__ __forceinline__ void finishSM(f32x16& p0, f32x16& p1, float alpha, float& l_reg, i32x8& pf) {
#pragma unroll
    for (int r = 0; r < 16; ++r) p1[r] = __builtin_amdgcn_exp2f(p1[r]);
    float ps = 0;
#pragma unroll
    for (int r = 0; r < 16; ++r) ps += p0[r];
#pragma unroll
    for (int r = 0; r < 16; ++r) ps += p1[r];
    { auto rr = __builtin_amdgcn_permlane32_swap(__float_as_uint(ps), __float_as_uint(ps), false, false);
      ps = __uint_as_float(rr[0]) + __uint_as_float(rr[1]); }
    l_reg = l_reg * alpha + ps;
#pragma unroll
    for (int w = 0; w < 4; ++w) { pf[w] = (int)pk4_fp8(p0[4 * w], p0[4 * w + 1], p0[4 * w + 2], p0[4 * w + 3]); pf[4 + w] = (int)pk4_fp8(p1[4 * w], p1[4 * w + 1], p1[4 * w + 2], p1[4 * w + 3]); }
}
__device__ __forceinline__ void pv(f32x16* o, LAS unsigned char* slot, const i32x8 pf, int r32, int hi) {
#pragma unroll
    for (int d0 = 0; d0 < 4; ++d0) { const int d = 32 * d0 + r32, sw = (d >> 2) & 3;
        const i32x8 b = ld32(slot + V_OFF + d * 64 + (((2 * hi) ^ sw) << 4), slot + V_OFF + d * 64 + (((2 * hi + 1) ^ sw) << 4));
        o[d0] = __builtin_amdgcn_mfma_scale_f32_32x32x64_f8f6f4(pf, b, o[d0], 0, 0, 0, SC_ONE, 0, SC_ONE); }
}
__device__ __forceinline__ int crow(int r, int hi) { return (r & 3) + 8 * (r >> 2) + 4 * hi; }
__device__ __forceinline__ void attn_unit(const unsigned char* __restrict__ Qb, const unsigned char* __restrict__ KNt, const unsigned char* __restrict__ KRt, const unsigned char* __restrict__ Vt,
                                          bf16_t* __restrict__ Ob, int NT, LAS unsigned char* lds) {
    const int tid = otid(), wid = __builtin_amdgcn_readfirstlane(tid >> 6), lane = tid & 63, r32 = lane & 31, hi = lane >> 5;
    LAS float* wsf = (LAS float*)(lds + 3 * SLOT) + wid * 64; LAS float* li_l = wsf; LAS float* al_l = wsf + 32;
    float m_reg = -1e30f, l_reg = 0; f32x16 o[4] = {}; i32x8 qf[3];
    const unsigned char* Qw = Qb + (size_t)(wid * 32 + r32) * 192 + 32 * hi;
#pragma unroll
    for (int ks = 0; ks < 3; ++ks) { const u32x4 x = *(const u32x4*)(Qw + 64 * ks), y = *(const u32x4*)(Qw + 64 * ks + 16); qf[ks] = (i32x8){(int)x.x, (int)x.y, (int)x.z, (int)x.w, (int)y.x, (int)y.y, (int)y.z, (int)y.w}; }
    const unsigned lo16 = (unsigned)lane * 16u;
#define ATT_DMA(tile, slotoff) do { const size_t t_ = (size_t)(tile); LAS unsigned char* sl_ = lds + (slotoff); \
        __builtin_amdgcn_global_load_lds((const unsigned*)(KNt + t_ * 8192 + wid * 1024 + lo16), (LAS unsigned*)(sl_ + KN_OFF + wid * 1024), 16, 0, 0); \
        __builtin_amdgcn_global_load_lds((const unsigned*)(Vt + t_ * 8192 + wid * 1024 + lo16), (LAS unsigned*)(sl_ + V_OFF + wid * 1024), 16, 0, 0); \
        if (wid < 4) __builtin_amdgcn_global_load_lds((const unsigned*)(KRt + t_ * 4096 + wid * 1024 + lo16), (LAS unsigned*)(sl_ + KR_OFF + wid * 1024), 16, 0, 0); } while (0)
#define ATT_SYNC() do { asm volatile("s_waitcnt vmcnt(0)" ::: "memory"); __builtin_amdgcn_s_barrier(); asm volatile("" ::: "memory"); } while (0)
#define RESC(a) do { if (__any((a) < 1.f)) { if (hi == 0) al_l[r32] = (a); asm volatile("s_waitcnt lgkmcnt(0)" ::: "memory"); \
        _Pragma("unroll") for (int d = 0; d < 4; ++d) _Pragma("unroll") for (int r = 0; r < 16; ++r) o[d][r] *= al_l[crow(r, hi)]; } } while (0)
    f32x16 pA0, pA1, pB0, pB1; float mnA, mnB, alA, alB; i32x8 pf;
    int sp = 0, sc = SLOT, sn = 2 * SLOT;
    ATT_DMA(0, 0);
    ATT_SYNC();
    ATT_DMA(1, SLOT);
    qkt(pA0, pA1, lds, qf, r32, hi); partialSM(pA0, pA1, m_reg, mnA, alA);
    for (int j = 1; j + 1 < NT; j += 2) {
        ATT_SYNC(); ATT_DMA(j + 1, sn);
        SBAR(); qkt(pB0, pB1, lds + sc, qf, r32, hi);
        finishSM(pA0, pA1, alA, l_reg, pf); SBAR();
        pv(o, lds + sp, pf, r32, hi); partialSM(pB0, pB1, m_reg, mnB, alB);
        RESC(alB);
        { const int t_ = sp; sp = sc; sc = sn; sn = t_; }
        ATT_SYNC(); if (j + 2 < NT) ATT_DMA(j + 2, sn);
        SBAR(); qkt(pA0, pA1, lds + sc, qf, r32, hi);
        finishSM(pB0, pB1, alB, l_reg, pf); SBAR();
        pv(o, lds + sp, pf, r32, hi); partialSM(pA0, pA1, m_reg, mnA, alA);
        RESC(alA);
        { const int t_ = sp; sp = sc; sc = sn; sn = t_; }
    }
    ATT_SYNC();
    SBAR(); qkt(pB0, pB1, lds + sc, qf, r32, hi);
    finishSM(pA0, pA1, alA, l_reg, pf); SBAR();
    pv(o, lds + sp, pf, r32, hi); partialSM(pB0, pB1, m_reg, mnB, alB);
    RESC(alB);
    finishSM(pB0, pB1, alB, l_reg, pf); SBAR();
    pv(o, lds + sc, pf, r32, hi);
    if (hi == 0) li_l[r32] = l_reg; asm volatile("s_waitcnt lgkmcnt(0)" ::: "memory");
    float rli[16];
#pragma unroll
    for (int r = 0; r < 16; ++r) rli[r] = __builtin_amdgcn_rcpf(li_l[crow(r, hi)]);
    bf16_t* Ow = Ob + (size_t)(wid * 32) * 2048;
#pragma unroll
    for (int r = 0; r < 16; ++r) { const int orow = crow(r, hi);
#pragma unroll
        for (int d0 = 0; d0 < 4; ++d0) Ow[(size_t)orow * 2048 + d0 * 32 + r32] = f2bf(o[d0][r] * rli[r]); }
    __builtin_amdgcn_s_barrier(); asm volatile("" ::: "memory");
#undef ATT_DMA
#undef ATT_SYNC
#undef RESC
}
}

namespace ssd {
constexpr int XT_OFF = 0, BT_OFF = 17408, HB_OFF = 52224, SET = 69632, CW_OFF = 2 * SET, LDS_BYTES = CW_OFF + 8 * 1536;
constexpr int PITCH = 272;
constexpr float L2E = 1.4426950408889634f;
__device__ __forceinline__ void g_unit(const bf16_t* __restrict__ BC, bf16_t* __restrict__ G, int unit) {
    const int cid = unit >> 1, g = unit & 1;
    const int r0 = cid < 256 ? cid * 128 : NLAT + (cid - 256) * 128;
    const int tid = otid(), wid = tid >> 6, lane = tid & 63, fr = lane & 15, fq = lane >> 4;
    const bf16_t* Cp = BC + (size_t)(r0 + 16 * wid + fr) * 512 + 256 + 128 * g + 8 * fq;
    bf16x8 cf[4];
#pragma unroll
    for (int ks = 0; ks < 4; ++ks) cf[ks] = *(const bf16x8*)(Cp + 32 * ks);
    bf16_t* Gp = G + ((size_t)unit * 128 + 16 * wid + fr) * 128 + 4 * fq;
#pragma unroll
    for (int sb = 0; sb < 8; ++sb) {
        const bf16_t* Bp = BC + (size_t)(r0 + 16 * sb + fr) * 512 + 128 * g + 8 * fq;
        f32x4 acc = {0.f, 0.f, 0.f, 0.f};
#pragma unroll
        for (int ks = 0; ks < 4; ++ks) { const bf16x8 bfr = *(const bf16x8*)(Bp + 32 * ks); acc = __builtin_amdgcn_mfma_f32_16x16x32_bf16(bfr, cf[ks], acc, 0, 0, 0); }
        u32x2 w; w.x = cvt_pk_bf16(acc[0], acc[1]); w.y = cvt_pk_bf16(acc[2], acc[3]);
        *(u32x2*)(Gp + 16 * sb) = w;
    }
}
__device__ __forceinline__ void ssd_unit(int b, int h, int d, const bf16_t* __restrict__ XS, const bf16_t* __restrict__ BC, const float* __restrict__ DT, const bf16_t* __restrict__ G,
                                         const float* __restrict__ a_log, bf16_t* __restrict__ Y, LAS unsigned char* lds) {
    const int g = h >> 3;
    const int tid = otid(), wid = tid >> 6, lane = tid & 63, fr = lane & 15, fq = lane >> 4;
    const float a = -__expf(a_log[d * 16 + h]);
    LAS float* cw = (LAS float*)(lds + CW_OFF + wid * 1536); LAS float* dts = cw + 128; LAS float* dtw = cw + 256;
    f32x4 hs[4];
#pragma unroll
    for (int q = 0; q < 4; ++q) hs[q] = (f32x4){0.f, 0.f, 0.f, 0.f};
    for (int i = tid; i < 17408 / 4; i += 512) ((LAS unsigned*)(lds + HB_OFF))[i] = 0u;
    float cend = 0.f;
#define SSD_ROWS(step, r0v, gidv) do { if ((step) < 2) { const int oc_ = d ? 1 - (step) : (step); r0v = NLAT + b * 256 + oc_ * 128; gidv = 256 + b * 2 + oc_; } \
        else { const int lc_ = (step) - 2, oc_ = d ? 63 - lc_ : lc_; r0v = b * 8192 + oc_ * 128; gidv = b * 64 + oc_; } } while (0)
    const int sg = tid & 31, n8 = tid >> 5, p4 = tid >> 5;
    f32x2 P_da, Q_da; u32x2 P_xv[4], Q_xv[4]; u32x4 P_bv[4], Q_bv[4], n_gv[4], n_cv[4], c_gv[4], c_cv[4];
#define SSD_LOAD(step, X) do { int r0_, gid_; SSD_ROWS(step, r0_, gid_); (void)gid_; X##_da = *(const f32x2*)(DT + (size_t)(d * 16 + h) * NROW + r0_ + 2 * lane); \
        _Pragma("unroll") for (int j_ = 0; j_ < 4; ++j_) { X##_xv[j_] = *(const u32x2*)(XS + (size_t)(r0_ + 4 * sg + j_) * 1024 + 64 * h + 4 * p4); \
                                                         X##_bv[j_] = *(const u32x4*)(BC + (size_t)(r0_ + 4 * sg + j_) * 512 + 128 * g + 8 * n8); } } while (0)
#define SSD_LOADGC(step) do { int r0_, gid_; SSD_ROWS(step, r0_, gid_); const int t_ = 16 * wid + fr; const bf16_t* Gp_ = G + ((size_t)(gid_ * 2 + g) * 128 + t_) * 128 + 8 * fq; const bf16_t* Cp_ = BC + (size_t)(r0_ + t_) * 512 + 256 + 128 * g + 8 * fq; \
          _Pragma("unroll") for (int ks_ = 0; ks_ < 4; ++ks_) { n_gv[ks_] = *(const u32x4*)(Gp_ + 32 * ks_); n_cv[ks_] = *(const u32x4*)(Cp_ + 32 * ks_); } } while (0)
#define SSD_GCROT() do { _Pragma("unroll") for (int ks_ = 0; ks_ < 4; ++ks_) { c_gv[ks_] = n_gv[ks_]; c_cv[ks_] = n_cv[ks_]; } } while (0)
#define SSD_WRITE(step, X) do { LAS unsigned char* set_ = lds + ((step) & 1) * SET; \
        const float da0 = X##_da.x * a, da1 = X##_da.y * a; \
        float sc_ = da0 + da1; float c0_, c1_; \
        if (d == 0) { _Pragma("unroll") for (int o_ = 1; o_ < 64; o_ <<= 1) { const float t_ = __shfl_up(sc_, o_); if (lane >= o_) sc_ += t_; } \
            c0_ = sc_ - da1; c1_ = sc_; cend = __shfl(sc_, 63); } \
        else { _Pragma("unroll") for (int o_ = 1; o_ < 64; o_ <<= 1) { const float t_ = __shfl_down(sc_, o_); if (lane + o_ < 64) sc_ += t_; } \
            c0_ = sc_; c1_ = sc_ - da0; cend = __shfl(sc_, 0); } \
        *(LAS f32x2*)(cw + 2 * lane) = (f32x2){c0_, c1_}; *(LAS f32x2*)(dts + 2 * lane) = X##_da; \
        *(LAS f32x2*)(dtw + 2 * lane) = (f32x2){X##_da.x * __builtin_amdgcn_exp2f((cend - c0_) * L2E), X##_da.y * __builtin_amdgcn_exp2f((cend - c1_) * L2E)}; \
        { LAS unsigned char* xt_ = set_ + XT_OFF + (4 * p4) * PITCH + 8 * sg; \
          _Pragma("unroll") for (int i_ = 0; i_ < 4; ++i_) { unsigned e_[4]; \
              _Pragma("unroll") for (int j_ = 0; j_ < 4; ++j_) { const unsigned w_ = (i_ & 2) ? X##_xv[j_].y : X##_xv[j_].x; e_[j_] = (i_ & 1) ? (w_ >> 16) : (w_ & 0xffffu); } \
              u32x2 o_; o_.x = e_[0] | (e_[1] << 16); o_.y = e_[2] | (e_[3] << 16); *(LAS u32x2*)(xt_ + i_ * PITCH) = o_; } } \
        { LAS unsigned char* bt_ = set_ + BT_OFF + (8 * n8) * PITCH + 8 * sg; \
          _Pragma("unroll") for (int i_ = 0; i_ < 8; ++i_) { unsigned e_[4]; \
              _Pragma("unroll") for (int j_ = 0; j_ < 4; ++j_) { const unsigned w_ = X##_bv[j_][i_ >> 1]; e_[j_] = (i_ & 1) ? (w_ >> 16) : (w_ & 0xffffu); } \
              u32x2 o_; o_.x = e_[0] | (e_[1] << 16); o_.y = e_[2] | (e_[3] << 16); *(LAS u32x2*)(bt_ + i_ * PITCH) = o_; } } \
        asm volatile("s_waitcnt lgkmcnt(0)" ::: "memory"); \
    } while (0)
    SSD_LOAD(0, Q); SSD_LOADGC(0); SSD_WRITE(0, Q); SSD_LOAD(1, P);
    for (int step2 = 0; step2 < 66; step2 += 2)
#pragma unroll
    for (int par = 0; par < 2; ++par) {
        const int step = step2 + par;
        __syncthreads();
        int r0, gid; SSD_ROWS(step, r0, gid); (void)gid;
        LAS unsigned char* set = lds + (step & 1) * SET;
        const float cend_cur = cend;
        SSD_GCROT();
        if (step + 1 < 66) SSD_LOADGC(step + 1);
        if (step + 2 < 66) { if (par == 0) SSD_LOAD(step + 2, Q); else SSD_LOAD(step + 2, P); }
        {
            const int t = 16 * wid + fr; const float ct = cw[t];
            f32x4 y[4];
#pragma unroll
            for (int q = 0; q < 4; ++q) y[q] = (f32x4){0.f, 0.f, 0.f, 0.f};
            const float et = __builtin_amdgcn_exp2f(ct * L2E);
#pragma unroll
            for (int ks = 0; ks < 4; ++ks) {
                const bool live = d == 0 ? (32 * ks <= 16 * wid + 15) : (32 * ks + 31 >= 16 * wid);
                if (live) {
                    const int s0 = 32 * ks + 8 * fq;
                    const f32x4 c0 = *(const LAS f32x4*)(cw + s0), c1 = *(const LAS f32x4*)(cw + s0 + 4), d0v = *(const LAS f32x4*)(dts + s0), d1v = *(const LAS f32x4*)(dts + s0 + 4);
                    float m[8];
#pragma unroll
                    for (int i = 0; i < 8; ++i) { const float cs = i < 4 ? c0[i & 3] : c1[i & 3], dv = i < 4 ? d0v[i & 3] : d1v[i & 3]; const int s = s0 + i;
                        const bool ok = d == 0 ? (s <= t) : (s >= t);
                        const float gval = (i & 1) ? bfhi(c_gv[ks][i >> 1]) : bflo(c_gv[ks][i >> 1]);
                        m[i] = ok ? gval * dv * __builtin_amdgcn_exp2f((ct - cs) * L2E) : 0.f; }
                    u32x4 mw; mw.x = cvt_pk_bf16(m[0], m[1]); mw.y = cvt_pk_bf16(m[2], m[3]); mw.z = cvt_pk_bf16(m[4], m[5]); mw.w = cvt_pk_bf16(m[6], m[7]);
                    const bf16x8 mb = __builtin_bit_cast(bf16x8, mw);
#pragma unroll
                    for (int q = 0; q < 4; ++q) { const bf16x8 af = *(const LAS bf16x8*)(set + XT_OFF + (16 * q + fr) * PITCH + (32 * ks + 8 * fq) * 2);
                        y[q] = __builtin_amdgcn_mfma_f32_16x16x32_bf16(af, mb, y[q], 0, 0, 0); }
                }
            }
#pragma unroll
            for (int ks = 0; ks < 4; ++ks) {
                u32x4 cwv;
#pragma unroll
                for (int i = 0; i < 4; ++i) cwv[i] = cvt_pk_bf16(bflo(c_cv[ks][i]) * et, bfhi(c_cv[ks][i]) * et);
                const bf16x8 cb = __builtin_bit_cast(bf16x8, cwv);
#pragma unroll
                for (int q = 0; q < 4; ++q) { const bf16x8 af = *(const LAS bf16x8*)(set + HB_OFF + (16 * q + fr) * PITCH + (32 * ks + 8 * fq) * 2);
                    y[q] = __builtin_amdgcn_mfma_f32_16x16x32_bf16(af, cb, y[q], 0, 0, 0); }
            }
            bf16_t* yp = Y + (size_t)(r0 + t) * 1024 + 64 * h + 4 * fq;
#pragma unroll
            for (int q = 0; q < 4; ++q) { u32x2 w; w.x = cvt_pk_bf16(y[q][0], y[q][1]); w.y = cvt_pk_bf16(y[q][2], y[q][3]); *(u32x2*)(yp + 16 * q) = w; }
        }
        {
            const float dec = __builtin_amdgcn_exp2f(cend_cur * L2E);
#pragma unroll
            for (int q = 0; q < 4; ++q) hs[q] = hs[q] * dec;
#pragma unroll
            for (int ks = 0; ks < 4; ++ks) {
                const int s0 = 32 * ks + 8 * fq;
                const u32x4 braw = *(const LAS u32x4*)(set + BT_OFF + (16 * wid + fr) * PITCH + s0 * 2);
                const f32x4 w0 = *(const LAS f32x4*)(dtw + s0), w1 = *(const LAS f32x4*)(dtw + s0 + 4);
                u32x4 bw; bw.x = cvt_pk_bf16(bflo(braw.x) * w0[0], bfhi(braw.x) * w0[1]); bw.y = cvt_pk_bf16(bflo(braw.y) * w0[2], bfhi(braw.y) * w0[3]);
                          bw.z = cvt_pk_bf16(bflo(braw.z) * w1[0], bfhi(braw.z) * w1[1]); bw.w = cvt_pk_bf16(bflo(braw.w) * w1[2], bfhi(braw.w) * w1[3]);
                const bf16x8 bfr = __builtin_bit_cast(bf16x8, bw);
#pragma unroll
                for (int q = 0; q < 4; ++q) { const bf16x8 af = *(const LAS bf16x8*)(set + XT_OFF + (16 * q + fr) * PITCH + s0 * 2);
                    hs[q] = __builtin_amdgcn_mfma_f32_16x16x32_bf16(af, bfr, hs[q], 0, 0, 0); }
            }
            LAS bf16_t* hb = (LAS bf16_t*)(lds + ((step + 1) & 1) * SET + HB_OFF) + 16 * wid + fr;
#pragma unroll
            for (int q = 0; q < 4; ++q)
#pragma unroll
                for (int i = 0; i < 4; ++i) hb[(16 * q + 4 * fq + i) * 136] = f2bf(hs[q][i]);
        }
        if (step + 1 < 66) { if (par == 0) SSD_WRITE(step + 1, P); else SSD_WRITE(step + 1, Q); }
    }
    __syncthreads();
#undef SSD_ROWS
#undef SSD_LOAD
#undef SSD_LOADGC
#undef SSD_GCROT
#undef SSD_WRITE
}
}

struct Args { const float* in[32]; float* out; unsigned char* ws; int ph_lo, ph_hi; };
constexpr int NTHR = 512;
constexpr int LDS_BASE = 256;
constexpr int LDS_PHASE = 151808;
constexpr int LDS_BYTES = LDS_BASE + LDS_PHASE;
static_assert(att::LDS_BYTES <= LDS_PHASE && att8::LDS_BYTES <= LDS_PHASE && ssd::LDS_BYTES <= LDS_PHASE && pg8::STAGE_BYTES <= LDS_PHASE, "LDS");

__device__ __forceinline__ void tjob(int j, const Args& A, const float*& src, bf16_t*& dst, int& K, int& N, int& Npad, int& mode, const float*& ks) {
    unsigned char* W = A.ws + WS_W; mode = 0; ks = nullptr;
    if (j < 8) { const int i = j >> 2, w = j & 3; unsigned char* base = W + W_HYB + (size_t)i * WH_SZ;
        if (w == 0)      { src = A.in[I_HWIN] + (size_t)i * 1024 * HYB_IN; dst = (bf16_t*)(base + WH_IN); K = 1024; N = HYB_IN; Npad = HYB_INP; mode = 1; }
        else if (w == 1) { src = A.in[I_WQB] + (size_t)i * 384 * 1536; dst = (bf16_t*)(base + WH_QB); K = 384; N = 1536; Npad = 1536; mode = 2; ks = A.in[I_QNG] + i * 384; }
        else if (w == 2) { src = A.in[I_WKVB] + (size_t)i * 256 * 2048; dst = (bf16_t*)(base + WH_KVB); K = 256; N = 2048; Npad = 2048; ks = A.in[I_KVNG] + i * 256; }
        else             { src = A.in[I_HWOUT] + (size_t)i * 2048 * 1024; dst = (bf16_t*)(base + WH_OUT); K = 2048; N = 1024; Npad = 1024; }
    } else if (j < 12) { const int i = (j - 8) >> 1, w = (j - 8) & 1; unsigned char* base = W + W_GM + (size_t)i * WG_SZ;
        if (w == 0) { src = A.in[I_GWIN] + (size_t)i * 1024 * 4096; dst = (bf16_t*)(base + WG_IN); K = 1024; N = 4096; Npad = 4096; }
        else        { src = A.in[I_GWOUT] + (size_t)i * 2048 * 1024; dst = (bf16_t*)(base + WG_OUT); K = 2048; N = 1024; Npad = 1024; }
    } else { const int l = j - 12; src = A.in[I_PWQ] + (size_t)l * 1024 * 2048; dst = (bf16_t*)(W + W_PEER + (size_t)l * WP_SZ + WP_Q); K = 1024; N = 2048; Npad = 2048; }
}
__device__ __forceinline__ int colmap(int mode, int n, int N) {
    if (mode == 1) { if (n >= N) return -1; if (n < C_KR) return n; const int m = n - C_KR; return C_KR + (m >> 1) + 32 * (m & 1); }
    if (mode == 2) { if (n < 1024) return (n >> 7) * 192 + (n & 127); const int m = n - 1024, h = m >> 6, mm = m & 63; return h * 192 + 128 + (mm >> 1) + 32 * (mm & 1); }
    return n;
}
__device__ __forceinline__ void phase_prologue(const Args& A, LAS unsigned char* lds) {
    const int tid = otid();
    {
        LAS float* tile = (LAS float*)lds;
        int item = blockIdx.x;
        for (int j = 0; j < 16; ++j) {
            const float* src; bf16_t* dst; int K, N, Npad, mode; const float* ks; tjob(j, A, src, dst, K, N, Npad, mode, ks);
            const int nsub = (K % 256 == 0) ? 4 : 2, tk = K / (64 * nsub), tn = Npad / 64, nt = tk * tn;
            for (; item < nt; item += gridDim.x) {
                const int k0 = (item % tk) * 64 * nsub, n0 = (item / tk) * 64;
                { const int k = tid >> 3, cg = tid & 7; float v[4][8];
#pragma unroll
                  for (int t = 0; t < 4; ++t) if (t < nsub) { const float sc = ks ? ks[k0 + 64 * t + k] : 1.f;
#pragma unroll
                      for (int jj = 0; jj < 8; ++jj) { const int oc = colmap(mode, n0 + 8 * cg + jj, N); v[t][jj] = oc >= 0 ? src[(size_t)(k0 + 64 * t + k) * N + oc] * sc : 0.f; } }
#pragma unroll
                  for (int t = 0; t < 4; ++t) if (t < nsub) {
#pragma unroll
                      for (int jj = 0; jj < 8; ++jj) tile[t * 4160 + k * 65 + 8 * cg + jj] = v[t][jj]; } }
                __syncthreads();
                { const int n = tid >> 3, kg = tid & 7;
#pragma unroll
                  for (int t = 0; t < 4; ++t) if (t < nsub) { float v[8];
#pragma unroll
                      for (int jj = 0; jj < 8; ++jj) v[jj] = tile[t * 4160 + (8 * kg + jj) * 65 + n];
                      u32x4 w; w.x = cvt_pk_bf16(v[0], v[1]); w.y = cvt_pk_bf16(v[2], v[3]); w.z = cvt_pk_bf16(v[4], v[5]); w.w = cvt_pk_bf16(v[6], v[7]);
                      *(u32x4*)(dst + (size_t)(n0 + n) * K + k0 + 64 * t + 8 * kg) = w; } }
                __syncthreads();
            }
            item -= nt;
        }
    }
    {
        const int gthr = blockIdx.x * NTHR + tid, nthr = gridDim.x * NTHR;
        for (int p = gthr; p < 10 * 16384; p += nthr) {
            const int mat = p >> 14, off = (p & 16383) * 8; const float* src; bf16_t* dst;
            if (mat < 2)      { src = A.in[I_GWS] + (size_t)mat * 131072; dst = (bf16_t*)(A.ws + WS_W + W_GM + (size_t)mat * WG_SZ + WG_WS); }
            else if (mat < 6) { src = A.in[I_PK1] + (size_t)(mat - 2) * 131072; dst = (bf16_t*)(A.ws + WS_W + W_PEER + (size_t)(mat - 2) * WP_SZ + WP_K1); }
            else              { src = A.in[I_PK2] + (size_t)(mat - 6) * 131072; dst = (bf16_t*)(A.ws + WS_W + W_PEER + (size_t)(mat - 6) * WP_SZ + WP_K2); }
            const f32x4 a = *(const f32x4*)(src + off), b = *(const f32x4*)(src + off + 4);
            u32x4 w; w.x = cvt_pk_bf16(a[0], a[1]); w.y = cvt_pk_bf16(a[2], a[3]); w.z = cvt_pk_bf16(b[0], b[1]); w.w = cvt_pk_bf16(b[2], b[3]);
            *(u32x4*)(dst + off) = w;
        }
        float* rope = (float*)(A.ws + WS_ROPE);
        for (int p = gthr; p < SEQ * 32; p += nthr) { const int l = p >> 5, i = p & 31; const float pos = (float)(i < 16 ? (l >> 6) : (l & 63));
            const float inv = powf(10000.f, -(float)(i & 15) / 16.f), ang = pos * inv; rope[p] = cosf(ang); rope[SEQ * 32 + p] = sinf(ang); }
    }
    {
        LAS float* scond = (LAS float*)lds;
        LAS float* red = scond + 5 * 1024;
        __syncthreads();
        for (int i = tid; i < 5 * 1024; i += NTHR) { const int m = i >> 10, k = i & 1023; const float c = m < 4 ? A.in[I_C][m * 1024 + k] : A.in[I_CCTX][k]; scond[i] = silu_f(c); }
        __syncthreads();
        float* MOD = (float*)(A.ws + WS_MOD);
        for (int item = blockIdx.x; item < 4 * 48; item += gridDim.x) {
            const int layer = item / 48, j0 = (item % 48) * 128; const int c4 = tid & 31, ksl = tid >> 5;
            f32x4 acc[5];
#pragma unroll
            for (int m = 0; m < 5; ++m) acc[m] = (f32x4){0.f, 0.f, 0.f, 0.f};
            const float* wp = A.in[I_ADAW] + ((size_t)layer * 1024 + ksl * 64) * 6144 + j0 + 4 * c4;
            for (int k = 0; k < 64; ++k) { const f32x4 w = *(const f32x4*)(wp + (size_t)k * 6144);
#pragma unroll
                for (int m = 0; m < 5; ++m) acc[m] += w * scond[m * 1024 + ksl * 64 + k]; }
#pragma unroll
            for (int m = 0; m < 5; ++m) *(LAS f32x4*)(red + (ksl * 5 + m) * 128 + 4 * c4) = acc[m];
            __syncthreads();
            for (int i = tid; i < 640; i += NTHR) { const int m = i >> 7, c = i & 127; float s = A.in[I_ADAB][layer * 6144 + j0 + c];
#pragma unroll
                for (int q = 0; q < 16; ++q) s += red[(q * 5 + m) * 128 + c];
                MOD[((size_t)layer * 5 + m) * 6144 + j0 + c] = s; }
            __syncthreads();
        }
    }
}

__device__ __forceinline__ void phase_norm_mod(const float* xl, const float* xc, float* cl, float* cc, const float* g, const float* modl, int sh_idx, bf16_t* H, int nrows) {
    const int tid_ = otid(); const int lane = tid_ & 63, gw = blockIdx.x * 8 + (tid_ >> 6), nw = gridDim.x * 8;
    f32x4 gv[4];
#pragma unroll
    for (int i = 0; i < 4; ++i) gv[i] = *(const f32x4*)(g + 256 * i + 4 * lane);
    for (int r = gw; r < nrows; r += nw) {
        const bool lat = r < NLAT; const float* xp = lat ? xl + (size_t)r * D : xc + (size_t)(r - NLAT) * D;
        f32x4 x[4]; float ss = 0.f;
#pragma unroll
        for (int i = 0; i < 4; ++i) { x[i] = *(const f32x4*)(xp + 256 * i + 4 * lane); ss += x[i][0] * x[i][0] + x[i][1] * x[i][1] + x[i][2] * x[i][2] + x[i][3] * x[i][3]; }
        if (cl) { float* cp = lat ? cl + (size_t)r * D : cc + (size_t)(r - NLAT) * D;
#pragma unroll
            for (int i = 0; i < 4; ++i) *(f32x4*)(cp + 256 * i + 4 * lane) = x[i]; }
        ss = wave_sum(ss); const float rstd = rsqrtf(ss * (1.f / 1024.f) + EPS);
        const float* mp = modl + (size_t)(lat ? (r >> 13) : 4) * 6144 + sh_idx * 1024;
#pragma unroll
        for (int i = 0; i < 4; ++i) { const f32x4 sh = *(const f32x4*)(mp + 256 * i + 4 * lane), sc = *(const f32x4*)(mp + 1024 + 256 * i + 4 * lane);
            const f32x4 hv = (x[i] * rstd) * gv[i] * (sc + 1.f) + sh;
            u32x2 w; w.x = cvt_pk_bf16(hv[0], hv[1]); w.y = cvt_pk_bf16(hv[2], hv[3]);
            *(u32x2*)(H + (size_t)r * D + 256 * i + 4 * lane) = w; }
    }
}
__device__ __forceinline__ void phase_final_norm(float* xl, const float* g, float oscale) {
    const int tid_ = otid(); const int lane = tid_ & 63, gw = blockIdx.x * 8 + (tid_ >> 6), nw = gridDim.x * 8;
    f32x4 gv[4];
#pragma unroll
    for (int i = 0; i < 4; ++i) gv[i] = *(const f32x4*)(g + 256 * i + 4 * lane);
    for (int r = gw; r < NLAT; r += nw) {
        float* xp = xl + (size_t)r * D; f32x4 x[4]; float ss = 0.f;
#pragma unroll
        for (int i = 0; i < 4; ++i) { x[i] = *(const f32x4*)(xp + 256 * i + 4 * lane); ss += x[i][0] * x[i][0] + x[i][1] * x[i][1] + x[i][2] * x[i][2] + x[i][3] * x[i][3]; }
        ss = wave_sum(ss); const float rstd = rsqrtf(ss * (1.f / 1024.f) + EPS);
#pragma unroll
        for (int i = 0; i < 4; ++i) *(f32x4*)(xp + 256 * i + 4 * lane) = (x[i] * (rstd * oscale)) * gv[i];
    }
}

__device__ __forceinline__ void phase_conv(const Args& A, int li) {
    const bf16_t* PROJ = (const bf16_t*)(A.ws + WS_BIG);
    bf16_t* XS = (bf16_t*)(A.ws + WS_R2); bf16_t* BC = (bf16_t*)(A.ws + WS_R2 + R2_BC);
    const int tid = otid();
    {
        for (int item = blockIdx.x * 3; item < (NROW / 64) * 3; item += gridDim.x * 3)
#pragma unroll 1
        for (int sub = 0; sub < 3; ++sub) {
            const int blk = (item + sub) / 3, q = ((item + sub) % 3) * 512 + tid, cg = q % 192, rg = q / 192, c0 = 8 * cg;
            const int rbeg = blk * 64 + rg * 8; int s0, s1;
            if (rbeg < NLAT) { s0 = rbeg & ~8191; s1 = s0 + 8192; } else { s0 = NLAT + ((rbeg - NLAT) & ~255); s1 = s0 + 256; }
            const float* cw = A.in[I_CONVW] + ((size_t)li * 1536 + c0) * 5; const float* cb = A.in[I_CONVB] + (size_t)li * 1536 + c0;
            u32x4 in[12];
#pragma unroll
            for (int i = 0; i < 12; ++i) { const int r = rbeg - 2 + i; in[i] = (r >= s0 && r < s1) ? *(const u32x4*)(PROJ + (size_t)r * HYB_INP + C_XBC + c0) : (u32x4){0u, 0u, 0u, 0u}; }
            float w[8][5], bia[8];
#pragma unroll
            for (int j = 0; j < 8; ++j) { bia[j] = cb[j];
#pragma unroll
                for (int k = 0; k < 5; ++k) w[j][k] = cw[j * 5 + k]; }
#pragma unroll
            for (int rr = 0; rr < 8; ++rr) {
                float o[8];
#pragma unroll
                for (int j = 0; j < 8; ++j) { float sacc = bia[j];
#pragma unroll
                    for (int k = 0; k < 5; ++k) { const unsigned wd = in[rr + k][j >> 1]; sacc += w[j][k] * ((j & 1) ? bfhi(wd) : bflo(wd)); }
                    o[j] = silu_f(sacc); }
                u32x4 pk; pk.x = cvt_pk_bf16(o[0], o[1]); pk.y = cvt_pk_bf16(o[2], o[3]); pk.z = cvt_pk_bf16(o[4], o[5]); pk.w = cvt_pk_bf16(o[6], o[7]);
                const int r = rbeg + rr;
                if (c0 < 1024) *(u32x4*)(XS + (size_t)r * 1024 + c0) = pk; else *(u32x4*)(BC + (size_t)r * 512 + (c0 - 1024)) = pk;
            }
        }
    }
    {
        const int lane = tid & 63, gw = blockIdx.x * 8 + (tid >> 6), nw = gridDim.x * 8;
        float* DT = (float*)(A.ws + WS_BIG + BIG_DT); float* RQ = (float*)(A.ws + WS_RSTD); float* RKV = RQ + NROW;
        unsigned char* KR = A.ws + WS_BIG + BIG_KR; const float* rope = (const float*)(A.ws + WS_ROPE);
        const float dtb = lane < 32 ? A.in[I_DTB][li * 32 + lane] : 0.f;
        for (int rb = gw * 4; rb < NROW; rb += nw * 4) {
            unsigned wq[4][3]; u32x2 wk[4]; unsigned wr_[4]; float dtv[4], rc[4], rsn[4];
#pragma unroll
            for (int i = 0; i < 4; ++i) { const int r = rb + i; const bf16_t* p = PROJ + (size_t)r * HYB_INP;
                const unsigned* q = (const unsigned*)(p + C_CQ + 6 * lane); wq[i][0] = q[0]; wq[i][1] = q[1]; wq[i][2] = q[2];
                wk[i] = *(const u32x2*)(p + C_CKV + 4 * lane);
                dtv[i] = lane < 32 ? bf2f(p[C_DT + (lane & 15)]) : 0.f; wr_[i] = lane < 32 ? *(const unsigned*)(p + C_KR + 2 * lane) : 0u;
                const int l = r & 8191; rc[i] = (lane < 32 && r < NLAT) ? rope[l * 32 + lane] : 1.f; rsn[i] = (lane < 32 && r < NLAT) ? rope[SEQ * 32 + l * 32 + lane] : 0.f; }
#pragma unroll
            for (int i = 0; i < 4; ++i) { const int r = rb + i;
                if (lane < 32) DT[(size_t)lane * NROW + r] = softplus_f(dtv[i] + dtb);
                { float ss = 0.f;
#pragma unroll
                  for (int j = 0; j < 3; ++j) { const float a = bflo(wq[i][j]), b = bfhi(wq[i][j]); ss += a * a + b * b; }
                  ss = wave_sum(ss); if (lane == 0) RQ[r] = rsqrtf(ss * (1.f / 384.f) + EPS); }
                { const float a = bflo(wk[i].x), b = bfhi(wk[i].x), c = bflo(wk[i].y), d = bfhi(wk[i].y);
                  float ss = a * a + b * b + c * c + d * d; ss = wave_sum(ss); if (lane == 0) RKV[r] = rsqrtf(ss * (1.f / 256.f) + EPS); }
                if (lane < 32) { const float x1 = bflo(wr_[i]), x2 = bfhi(wr_[i]); int b, key;
                    const float o1 = x1 * rc[i] - x2 * rsn[i], o2 = x1 * rsn[i] + x2 * rc[i];
                    if (r < NLAT) { b = r >> 13; key = 256 + (r & 8191); } else { b = (r - NLAT) >> 8; key = (r - NLAT) & 255; }
                    int w8 = 0; w8 = __builtin_amdgcn_cvt_pk_fp8_f32(sat8(o1), sat8(o2), w8, false);
                    *(unsigned short*)(KR + (size_t)(b * NKT + (key >> 6)) * 4096 + att8::kr8(key & 63, 2 * lane)) = (unsigned short)(w8 & 0xffff); }
            }
        }
    }
}

struct EpiQ {
    static constexpr bool PERM = true;
    unsigned char* Q; const float* rstd; const float* rope;
    __device__ __forceinline__ void operator()(const f32x4 (&acc)[2][2][4][2], const pg8::Unit& u, int wr, int wc, int fr, int fq) const {
        const bool lat = u.pm < 128;
        const int b = lat ? (u.pm >> 5) : (u.pm - 128), q0 = lat ? 256 + ((u.pm & 31) << 8) : 0;
        const bool isrope = u.pn >= 4;
#pragma unroll
        for (int ai = 0; ai < 2; ++ai) {
            const int rl = 128 * ai + 64 * wr + fr;
            const float* rsp = rstd + u.pm * 256 + rl;
            const float* rp = rope + (size_t)(((u.pm & 31) << 8) + rl) * 32;
#pragma unroll
            for (int bj = 0; bj < 2; ++bj) {
                const int c0 = u.pn * 256 + 128 * bj + 32 * wc + 8 * fq; int h, dcol;
                if (!isrope) { h = c0 >> 7; dcol = c0 & 127; } else { const int mq = c0 - 1024; h = mq >> 6; dcol = 128 + (mq & 63); }
                unsigned char* dst = Q + ((size_t)(b * 8 + h) * NKEY + q0 + rl) * 192 + dcol;
                const int ro = (dcol - 128) >> 1;
#pragma unroll
                for (int m = 0; m < 4; ++m) {
                    const float rs = rsp[16 * m] * (QSCALE * att8::QUP);
                    f32x4 v0 = acc[ai][bj][m][0] * rs, v1 = acc[ai][bj][m][1] * rs;
                    if (isrope && lat) { const f32x4 cs = *(const f32x4*)(rp + 16 * m * 32 + ro), sn = *(const f32x4*)(rp + SEQ * 32 + 16 * m * 32 + ro);
                        const f32x4 a0 = v0, a1 = v1;
                        v0[0] = a0[0] * cs[0] - a0[1] * sn[0]; v0[1] = a0[0] * sn[0] + a0[1] * cs[0]; v0[2] = a0[2] * cs[1] - a0[3] * sn[1]; v0[3] = a0[2] * sn[1] + a0[3] * cs[1];
                        v1[0] = a1[0] * cs[2] - a1[1] * sn[2]; v1[1] = a1[0] * sn[2] + a1[1] * cs[2]; v1[2] = a1[2] * cs[3] - a1[3] * sn[3]; v1[3] = a1[2] * sn[3] + a1[3] * cs[3]; }
                    u32x2 w; w.x = pk4_fp8_sat(v0[0], v0[1], v0[2], v0[3]); w.y = pk4_fp8_sat(v1[0], v1[1], v1[2], v1[3]);
                    *(u32x2*)(dst + 16 * m * 192) = w;
                    asm volatile("" ::: "memory");
                }
            }
        }
    }
};
struct EpiKV {
    static constexpr bool PERM = true;
    unsigned char* KN; unsigned char* V; const float* rstd;
    __device__ __forceinline__ void operator()(const f32x4 (&acc)[2][2][4][2], const pg8::Unit& u, int wr, int wc, int fr, int fq) const {
        const bool lat = u.pm < 128;
        const int b = lat ? (u.pm >> 5) : (u.pm - 128), t0 = lat ? 4 + ((u.pm & 31) << 2) : 0;
        const int dd = 32 * wc + 8 * fq;
        const int offK = fr * 128 + ((((dd >> 4) ^ ((fr >> 1) & 7))) << 4) + (dd & 15);
#pragma unroll
        for (int ai = 0; ai < 2; ++ai) {
            const size_t tb = ((size_t)(b * 8 + u.pn) * NKT + t0 + 2 * ai + wr) * 8192;
            const float* rsp = rstd + u.pm * 256 + 128 * ai + 64 * wr + fr;
            unsigned char* kp = KN + tb + offK; unsigned char* vp = V + tb;
#pragma unroll
            for (int m = 0; m < 4; ++m) {
                const float rs = rsp[16 * m];
                { const f32x4 v0 = acc[ai][0][m][0] * rs, v1 = acc[ai][0][m][1] * rs; u32x2 w; w.x = pk4_fp8_sat(v0[0], v0[1], v0[2], v0[3]); w.y = pk4_fp8_sat(v1[0], v1[1], v1[2], v1[3]);
                  *(u32x2*)(kp + m * 2048) = w; }
                { const f32x4 v0 = acc[ai][1][m][0] * rs, v1 = acc[ai][1][m][1] * rs; const unsigned w0 = pk4_fp8_sat(v0[0], v0[1], v0[2], v0[3]), w1 = pk4_fp8_sat(v1[0], v1[1], v1[2], v1[3]);
                  const int sl = att8::vslot(16 * m + fr);
#pragma unroll
                  for (int i = 0; i < 8; ++i) { const int d = dd + i; vp[d * 64 + ((((sl >> 4) ^ ((d >> 2) & 3))) << 4) + (sl & 15)] = (unsigned char)(((i < 4 ? w0 : w1) >> (8 * (i & 3))) & 0xffu); } }
                asm volatile("" ::: "memory");
            }
        }
    }
};

__device__ __forceinline__ void phase_ssd_out(const Args& A, int li, int nrows) {
    const bf16_t* PROJ = (const bf16_t*)(A.ws + WS_BIG); const bf16_t* XS = (const bf16_t*)(A.ws + WS_R2);
    const bf16_t* Y0 = (const bf16_t*)(A.ws + WS_H); const bf16_t* Y1 = (const bf16_t*)(A.ws + WS_R3); bf16_t* CAT = (bf16_t*)(A.ws + WS_R3 + R3_CAT);
    const int tid_ = otid(); const int lane = tid_ & 63, gw = blockIdx.x * 8 + (tid_ >> 6), nw = gridDim.x * 8;
    const float dsk = A.in[I_SSDD][li * 16 + (lane >> 2)];
    float ng[16];
#pragma unroll
    for (int j = 0; j < 16; ++j) ng[j] = A.in[I_SSDNG][li * 1024 + 16 * lane + j];
    for (int r = gw; r < nrows; r += nw) {
        float v[16]; float ss = 0.f;
#pragma unroll
        for (int hh = 0; hh < 2; ++hh) {
            const u32x4 a = *(const u32x4*)(Y0 + (size_t)r * 1024 + 16 * lane + 8 * hh), b = *(const u32x4*)(Y1 + (size_t)r * 1024 + 16 * lane + 8 * hh);
            const u32x4 x = *(const u32x4*)(XS + (size_t)r * 1024 + 16 * lane + 8 * hh), z = *(const u32x4*)(PROJ + (size_t)r * HYB_INP + 16 * lane + 8 * hh);
#pragma unroll
            for (int q = 0; q < 4; ++q) {
                const float y0 = (bflo(a[q]) + bflo(b[q]) + dsk * bflo(x[q])) * silu_f(bflo(z[q])), y1 = (bfhi(a[q]) + bfhi(b[q]) + dsk * bfhi(x[q])) * silu_f(bfhi(z[q]));
                v[8 * hh + 2 * q] = y0; v[8 * hh + 2 * q + 1] = y1; ss += y0 * y0 + y1 * y1; }
        }
#pragma unroll
        for (int o = 16; o >= 1; o >>= 1) ss += __shfl_xor(ss, o);
        const float rstd = rsqrtf(ss * (1.f / 512.f) + EPS);
#pragma unroll
        for (int hh = 0; hh < 2; ++hh) { u32x4 w;
#pragma unroll
            for (int q = 0; q < 4; ++q) w[q] = cvt_pk_bf16(v[8 * hh + 2 * q] * rstd * ng[8 * hh + 2 * q], v[8 * hh + 2 * q + 1] * rstd * ng[8 * hh + 2 * q + 1]);
            *(u32x4*)(CAT + (size_t)r * 2048 + 16 * lane + 8 * hh) = w; }
    }
}

__device__ __forceinline__ void phase_ln_stats(const Args& A, int nrows) {
    const bf16_t* Gb = (const bf16_t*)(A.ws + WS_BIG); float* ST = (float*)(A.ws + WS_RSTD);
    const int tid_ = otid(); const int lane = tid_ & 63, gw = blockIdx.x * 8 + (tid_ >> 6), nw = gridDim.x * 8;
    for (int r = gw; r < nrows; r += nw) {
        float v[32]; float s = 0.f;
#pragma unroll
        for (int j = 0; j < 4; ++j) { const u32x4 w = *(const u32x4*)(Gb + (size_t)r * 4096 + 2048 + 512 * j + 8 * lane);
#pragma unroll
            for (int q = 0; q < 4; ++q) { v[8 * j + 2 * q] = bflo(w[q]); v[8 * j + 2 * q + 1] = bfhi(w[q]); s += v[8 * j + 2 * q] + v[8 * j + 2 * q + 1]; } }
        s = wave_sum(s); const float mu = s * (1.f / 2048.f); float q2 = 0.f;
#pragma unroll
        for (int j = 0; j < 32; ++j) { const float dd = v[j] - mu; q2 += dd * dd; }
        q2 = wave_sum(q2);
        if (lane == 0) { ST[r] = mu; ST[NROW + r] = rsqrtf(q2 * (1.f / 2048.f) + EPS); }
    }
}
__device__ __forceinline__ void phase_spatial(const Args& A, int gi, int nrows, LAS unsigned char* lds) {
    const bf16_t* Gb = (const bf16_t*)(A.ws + WS_BIG); const float* ST = (const float*)(A.ws + WS_RSTD); bf16_t* Ab = (bf16_t*)(A.ws + WS_R1);
    const bf16_t* WSg = (const bf16_t*)(A.ws + WS_W + W_GM + (size_t)gi * WG_SZ + WG_WS);
    const float* lng = A.in[I_GLNG] + (size_t)gi * 2048; const float* lnb = A.in[I_GLNB] + (size_t)gi * 2048; const float* bs = A.in[I_GBS] + (size_t)gi * 1024;
    const int tid = otid(), wid = tid >> 6, lane = tid & 63, r32 = lane & 31, hi = lane >> 5, tb = wid & 3, dh = wid >> 2;
    const int ldsaddr = (int)(unsigned)(uintptr_t)lds;
    u32x4 nv[8]; float nmu[8], nrs[8];
    const int nunits = (nrows / 128) * 8;
#define SP_LOADV(un) do { const int cb_ = (un) >> 3, gg_ = (un) & 7, r0_ = cb_ * 128; \
        _Pragma("unroll") for (int j = 0; j < 8; ++j) { const int idx = tid + 512 * j, s_ = idx >> 5, dd_ = (idx & 31) * 8; \
            nv[j] = *(const u32x4*)(Gb + (size_t)(r0_ + s_) * 4096 + 2048 + 256 * gg_ + dd_); nmu[j] = ST[r0_ + s_]; nrs[j] = ST[NROW + r0_ + s_]; } } while (0)
    if ((int)blockIdx.x < nunits) SP_LOADV((int)blockIdx.x);
    for (int unit = blockIdx.x; unit < nunits; unit += gridDim.x) {
        const int cb = unit >> 3, gg = unit & 7, r0 = cb * 128;
        __syncthreads();
#pragma unroll
        for (int j = 0; j < 8; ++j) { const int idx = tid + 512 * j, s = idx >> 5, dd = (idx & 31) * 8;
            const u32x4 w = nv[j];
            const float mu = nmu[j], rs = nrs[j];
            const f32x4 g0 = *(const f32x4*)(lng + 256 * gg + dd), g1 = *(const f32x4*)(lng + 256 * gg + dd + 4), b0 = *(const f32x4*)(lnb + 256 * gg + dd), b1 = *(const f32x4*)(lnb + 256 * gg + dd + 4);
            u32x4 o;
            o.x = cvt_pk_bf16((bflo(w.x) - mu) * rs * g0[0] + b0[0], (bfhi(w.x) - mu) * rs * g0[1] + b0[1]); o.y = cvt_pk_bf16((bflo(w.y) - mu) * rs * g0[2] + b0[2], (bfhi(w.y) - mu) * rs * g0[3] + b0[3]);
            o.z = cvt_pk_bf16((bflo(w.z) - mu) * rs * g1[0] + b1[0], (bfhi(w.z) - mu) * rs * g1[1] + b1[1]); o.w = cvt_pk_bf16((bflo(w.w) - mu) * rs * g1[2] + b1[2], (bfhi(w.w) - mu) * rs * g1[3] + b1[3]);
            *(LAS u32x4*)(lds + ((s >> 6) * 2 + (dd >> 7)) * 16384 + att::v_st(s & 63, dd & 127)) = o; }
        u32x2 uu[4][4];
        { const bf16_t* up = Gb + (size_t)(r0 + 32 * tb + r32) * 4096 + 256 * gg + 128 * dh + 4 * hi;
#pragma unroll
          for (int d0 = 0; d0 < 4; ++d0)
#pragma unroll
              for (int k = 0; k < 4; ++k) uu[d0][k] = *(const u32x2*)(up + 32 * d0 + 8 * k); }
        if (unit + (int)gridDim.x < nunits) SP_LOADV(unit + (int)gridDim.x);
        bf16x8 pa[8];
#pragma unroll
        for (int ks = 0; ks < 8; ++ks) pa[ks] = *(const bf16x8*)(WSg + ((size_t)gg * 128 + 32 * tb + r32) * 128 + 16 * ks + 8 * hi);
        __syncthreads();
        f32x16 o[4] = {};
#define SP_PV(D0, vbase, p0, p1, p2, p3) do { \
            const s16x4 l0 = att::tr_read<att::v_rd_off(D0, 0, 0)>(vbase), h0 = att::tr_read<att::v_rd_off(D0, 0, 1)>(vbase), l1 = att::tr_read<att::v_rd_off(D0, 1, 0)>(vbase), h1 = att::tr_read<att::v_rd_off(D0, 1, 1)>(vbase); \
            const s16x4 l2 = att::tr_read<att::v_rd_off(D0, 2, 0)>(vbase), h2 = att::tr_read<att::v_rd_off(D0, 2, 1)>(vbase), l3 = att::tr_read<att::v_rd_off(D0, 3, 0)>(vbase), h3 = att::tr_read<att::v_rd_off(D0, 3, 1)>(vbase); \
            asm volatile("s_waitcnt lgkmcnt(0)" ::: "memory"); __builtin_amdgcn_sched_barrier(0); \
            o[D0] = __builtin_amdgcn_mfma_f32_32x32x16_bf16((bf16x8){l0[0], l0[1], l0[2], l0[3], h0[0], h0[1], h0[2], h0[3]}, p0, o[D0], 0, 0, 0); \
            o[D0] = __builtin_amdgcn_mfma_f32_32x32x16_bf16((bf16x8){l1[0], l1[1], l1[2], l1[3], h1[0], h1[1], h1[2], h1[3]}, p1, o[D0], 0, 0, 0); \
            o[D0] = __builtin_amdgcn_mfma_f32_32x32x16_bf16((bf16x8){l2[0], l2[1], l2[2], l2[3], h2[0], h2[1], h2[2], h2[3]}, p2, o[D0], 0, 0, 0); \
            o[D0] = __builtin_amdgcn_mfma_f32_32x32x16_bf16((bf16x8){l3[0], l3[1], l3[2], l3[3], h3[0], h3[1], h3[2], h3[3]}, p3, o[D0], 0, 0, 0); } while (0)
        { const int vb0 = ldsaddr + (0 * 2 + dh) * 16384 + att::v_rd_base(lane), vb1 = ldsaddr + (1 * 2 + dh) * 16384 + att::v_rd_base(lane);
          SP_PV(0, vb0, pa[0], pa[1], pa[2], pa[3]); SP_PV(1, vb0, pa[0], pa[1], pa[2], pa[3]); SP_PV(2, vb0, pa[0], pa[1], pa[2], pa[3]); SP_PV(3, vb0, pa[0], pa[1], pa[2], pa[3]);
          SP_PV(0, vb1, pa[4], pa[5], pa[6], pa[7]); SP_PV(1, vb1, pa[4], pa[5], pa[6], pa[7]); SP_PV(2, vb1, pa[4], pa[5], pa[6], pa[7]); SP_PV(3, vb1, pa[4], pa[5], pa[6], pa[7]); }
#undef SP_PV
        { const int t = 32 * tb + r32, row = r0 + t; const float bsv = bs[gg * 128 + t];
          bf16_t* ap = Ab + (size_t)row * 2048 + 256 * gg + 128 * dh + 4 * hi;
#pragma unroll
          for (int d0 = 0; d0 < 4; ++d0)
#pragma unroll
              for (int k = 0; k < 4; ++k) {
                  const u32x2 u2 = uu[d0][k];
                  u32x2 w; w.x = cvt_pk_bf16(bflo(u2.x) * (o[d0][4 * k] + bsv), bfhi(u2.x) * (o[d0][4 * k + 1] + bsv)); w.y = cvt_pk_bf16(bflo(u2.y) * (o[d0][4 * k + 2] + bsv), bfhi(u2.y) * (o[d0][4 * k + 3] + bsv));
                  *(u32x2*)(ap + 32 * d0 + 8 * k) = w; } }
    }
#undef SP_LOADV
}

constexpr int NSL = 8, SW = 1024 / NSL;
constexpr size_t TAB8_HALF = (size_t)NEXP * 1024, TAB_SCL = 2 * TAB8_HALF;
constexpr float HS = 4.f;
__device__ __forceinline__ void phase_tabcvt(const Args& A, int layer, int wg, int nwg) {
    const int tid_ = otid(); const int lane = tid_ & 63, gw = wg * 8 + (tid_ >> 6), nw = nwg * 8;
    float* SCL = (float*)(A.ws + WS_TAB + TAB_SCL);
    for (int r = gw; r < 2 * NEXP; r += nw) {
        const int tab = r >> 14, e = r & (NEXP - 1);
        const float* src = (tab ? A.in[I_PV] : A.in[I_PU]) + ((size_t)layer * NEXP + e) * 1024 + 16 * lane;
        f32x4 v[4]; float am = 0.f;
#pragma unroll
        for (int i = 0; i < 4; ++i) { v[i] = *(const f32x4*)(src + 4 * i); am = fmaxf(am, fmaxf(fmaxf(fabsf(v[i][0]), fabsf(v[i][1])), fmaxf(fabsf(v[i][2]), fabsf(v[i][3])))); }
#pragma unroll
        for (int o = 32; o >= 1; o >>= 1) am = fmaxf(am, __shfl_xor(am, o));
        float sc = 1.f; if (am > 0.f) { int ex; (void)frexpf(448.f / am, &ex); sc = ldexpf(1.f, ex - 1); }
        if (lane == 0) SCL[tab * NEXP + e] = 1.f / sc;
        u32x4 w;
#pragma unroll
        for (int i = 0; i < 4; ++i) w[i] = pk4_fp8(v[i][0] * sc, v[i][1] * sc, v[i][2] * sc, v[i][3] * sc);
        *(u32x4*)(A.ws + WS_TAB + (size_t)tab * TAB8_HALF + ((size_t)(lane >> 3) * NEXP + e) * SW + 16 * (lane & 7)) = w;
    }
}
#define CASD(a, b) do { const float hi_ = fmaxf(a, b), lo_ = fminf(a, b); a = hi_; b = lo_; } while (0)
__device__ __forceinline__ void sort16(float (&k)[16]) {
#pragma unroll
    for (int sz = 2; sz <= 16; sz <<= 1)
#pragma unroll
        for (int j = sz >> 1; j > 0; j >>= 1)
#pragma unroll
            for (int i = 0; i < 16; ++i) { const int l = i ^ j; if (l > i) { if ((i & sz) == 0 || sz == 16) CASD(k[i], k[l]); else CASD(k[l], k[i]); } }
}
__device__ __forceinline__ void bmerge16(float (&k)[16]) {
#pragma unroll
    for (int j = 8; j > 0; j >>= 1)
#pragma unroll
        for (int i = 0; i < 16; ++i) { const int l = i ^ j; if (l > i) CASD(k[i], k[l]); }
}
__device__ __forceinline__ void merge_top16(float (&a)[16], const float (&b)[16]) {
#pragma unroll
    for (int i = 0; i < 16; ++i) a[i] = fmaxf(a[i], b[15 - i]);
    bmerge16(a);
}
__device__ __forceinline__ void xmerge_top16(float (&a)[16], int mask) {
    float t[16];
#pragma unroll
    for (int i = 0; i < 16; ++i) t[i] = __shfl_xor(a[15 - i], mask);
#pragma unroll
    for (int i = 0; i < 16; ++i) a[i] = fmaxf(a[i], t[i]);
    bmerge16(a);
}
__device__ __forceinline__ void phase_topk(const Args& A, int layer, int nrows, LAS unsigned char* lds) {
    const bf16_t* QP = (const bf16_t*)(A.ws + WS_BIG); int* IDX = (int*)(A.ws + WS_R2); float* GATE = (float*)(A.ws + WS_R2 + R2_GATE);
    const int tid = otid(), wid = tid >> 6, lane = tid & 63, fr = lane & 15, fq = lane >> 4;
    LAS unsigned* scr = (LAS unsigned*)(lds + 2 * 34816) + wid * 512 + fr * 32;
    int h_staged = -1;
    for (int unit = blockIdx.x; unit < (nrows / 128) * 8; unit += gridDim.x) {
        const int h = unit & 7, r0 = (unit >> 3) * 128;
        if (h != h_staged) { h_staged = h;
        __syncthreads();
        { const bf16_t* k1 = (const bf16_t*)(A.ws + WS_W + W_PEER + (size_t)layer * WP_SZ + WP_K1) + (size_t)h * 16384;
#pragma unroll
          for (int j = 0; j < 8; ++j) { const int idx = tid + 512 * j, half = idx >> 11, rem = idx & 2047, key = rem >> 4, c8 = rem & 15;
              const u32x4 w = *(const u32x4*)(k1 + (size_t)half * 8 * 16384 + key * 128 + 8 * c8);
              *(LAS u32x4*)(lds + half * 34816 + key * 272 + c8 * 16) = w; } }
        __syncthreads(); }
        const int tok = r0 + 16 * wid + fr;
        float top[2][16];
#pragma unroll
        for (int half = 0; half < 2; ++half) {
            bf16x8 qf[4];
#pragma unroll
            for (int ks = 0; ks < 4; ++ks) qf[ks] = *(const bf16x8*)(QP + (size_t)tok * 2048 + 256 * h + 128 * half + 32 * ks + 8 * fq);
            float loc[16];
#pragma unroll
            for (int grp = 0; grp < 2; ++grp) {
                float kk[16];
#pragma unroll
                for (int nbb = 0; nbb < 4; ++nbb) { const int nb = 4 * grp + nbb; f32x4 acc = {0.f, 0.f, 0.f, 0.f};
#pragma unroll
                    for (int ks = 0; ks < 4; ++ks) { const bf16x8 kf = *(const LAS bf16x8*)(lds + half * 34816 + (16 * nb + fr) * 272 + (32 * ks + 8 * fq) * 2);
                        acc = __builtin_amdgcn_mfma_f32_16x16x32_bf16(kf, qf[ks], acc, 0, 0, 0); }
#pragma unroll
                    for (int i = 0; i < 4; ++i) { const unsigned code = 127u - (unsigned)(16 * nb + 4 * fq + i); kk[4 * nbb + i] = __uint_as_float((__float_as_uint(acc[i]) & ~127u) | code); } }
                sort16(kk);
                if (grp == 0) {
#pragma unroll
                    for (int i = 0; i < 16; ++i) loc[i] = kk[i];
                } else merge_top16(loc, kk);
            }
            xmerge_top16(loc, 16); xmerge_top16(loc, 32);
#pragma unroll
            for (int i = 0; i < 16; ++i) top[half][i] = loc[i];
        }
        if (fq < 2) {
#pragma unroll
            for (int i = 0; i < 16; ++i) scr[16 * fq + i] = __float_as_uint(fq == 0 ? top[0][i] : top[1][i]); }
        float fin[16];
#pragma unroll
        for (int aa = 0; aa < 4; ++aa) {
            const float va_k = fq == 0 ? top[0][aa] : fq == 1 ? top[0][4 + aa] : fq == 2 ? top[0][8 + aa] : top[0][12 + aa];
            const float va = __uint_as_float(__float_as_uint(va_k) & ~127u);
            float c[16];
#pragma unroll
            for (int bb = 0; bb < 16; ++bb) { const float s = va + __uint_as_float(__float_as_uint(top[1][bb]) & ~127u);
                c[bb] = __uint_as_float((__float_as_uint(s) & ~255u) | (255u - (unsigned)((4 * fq + aa) * 16 + bb))); }
            if (aa == 0) {
#pragma unroll
                for (int i = 0; i < 16; ++i) fin[i] = c[i];
            } else merge_top16(fin, c);
        }
        xmerge_top16(fin, 16); xmerge_top16(fin, 32);
        float ev[16], es = 0.f; const float mx = __uint_as_float(__float_as_uint(fin[0]) & ~255u);
#pragma unroll
        for (int i = 0; i < 16; ++i) { ev[i] = __expf(__uint_as_float(__float_as_uint(fin[i]) & ~255u) - mx); es += ev[i]; }
        const float inv = 1.f / es;
        asm volatile("s_waitcnt lgkmcnt(0)" ::: "memory");
        int oi[4]; float og[4];
#pragma unroll
        for (int kq = 0; kq < 4; ++kq) {
            const float fk = fq == 0 ? fin[kq] : fq == 1 ? fin[4 + kq] : fq == 2 ? fin[8 + kq] : fin[12 + kq];
            const float fe = fq == 0 ? ev[kq] : fq == 1 ? ev[4 + kq] : fq == 2 ? ev[8 + kq] : ev[12 + kq];
            const unsigned code = 255u - (__float_as_uint(fk) & 255u), a = code >> 4, bq = code & 15u;
            const unsigned i1 = 127u - (scr[a] & 127u), i2 = 127u - (scr[16 + bq] & 127u);
            oi[kq] = (int)(i1 * 128u + i2); og[kq] = fe * inv; }
        *(int4*)(IDX + (size_t)tok * 128 + 16 * h + 4 * fq) = make_int4(oi[0], oi[1], oi[2], oi[3]);
        *(f32x4*)(GATE + (size_t)tok * 128 + 16 * h + 4 * fq) = (f32x4){og[0], og[1], og[2], og[3]};
    }
}
struct PeerSched {
    int x0, rank, nloc, nblk, nown; unsigned orphan;
    __device__ __forceinline__ void init(const Args& A, int nrows, LAS unsigned char* smem) {
        unsigned* ctl = (unsigned*)(A.ws + WS_CTL);
        x0 = (int)(xb_xcc_id() & 7u); rank = __builtin_amdgcn_readfirstlane((int)((LAS unsigned*)smem)[8]); nblk = nrows / 64;
        unsigned cached = __builtin_amdgcn_readfirstlane(((LAS unsigned*)smem)[9]);
        if (cached == 0u) { unsigned orph = 0u, nl = 1u;
            for (int j = 0; j < 8; ++j) { unsigned c = xb_ld(&ctl[XB_XCNT(j)]) + xb_ld(&ctl[XB_XCNT(j + 8)]); c = __builtin_amdgcn_readfirstlane(c); if (c == 0u) orph |= 1u << j; if (j == x0) nl = c; }
            cached = (nl << 8) | orph; __syncthreads(); if (threadIdx.x == 0) ((LAS unsigned*)smem)[9] = cached; __syncthreads(); }
        nloc = (int)(cached >> 8); orphan = cached & 0xffu;
        const int tot = (NSL / 8) * nblk; nown = rank < tot ? (tot - rank + nloc - 1) / nloc : 0;
    }
    __device__ __forceinline__ bool item(int j, int& sl, int& blk) const {
        if (j < nown) { const int i = rank + j * nloc; sl = x0 + 8 * (i / nblk); blk = i % nblk; return true; }
        int jj = j - nown; const int tot = (NSL / 8) * nblk, per = ((int)gridDim.x > tot) ? 1 : 0; (void)per;
        for (int o = 0; o < 8; ++o) if ((orphan >> o) & 1u) { const int cnt = ((int)blockIdx.x < tot) ? (tot - (int)blockIdx.x + (int)gridDim.x - 1) / (int)gridDim.x : 0;
            if (jj < cnt) { const int i = (int)blockIdx.x + jj * (int)gridDim.x; sl = o + 8 * (i / nblk); blk = i % nblk; return true; } jj -= cnt; }
        return false;
    }
};
template <class LD, class PR>
__device__ __forceinline__ void peer_items(const PeerSched& S, LD ld, PR pr) {
    int sl, blk, sln, blkn, j = 0, buf = 0; bool have = S.item(0, sl, blk);
    __syncthreads();
    if (have) ld(sl, blk, 0);
    while (have) {
        const bool haven = S.item(j + 1, sln, blkn);
        asm volatile("s_waitcnt vmcnt(0)" ::: "memory");
        if (haven) ld(sln, blkn, buf ^ 1);
        pr(sl, blk, buf);
        sl = sln; blk = blkn; have = haven; buf ^= 1; ++j;
    }
    __syncthreads();
}
#ifndef MK_UVAR
#define MK_UVAR 0
#endif
__device__ __forceinline__ float dpp_sum8(float v) {
    v += __builtin_bit_cast(float, __builtin_amdgcn_mov_dpp(__builtin_bit_cast(int, v), 0xB1, 0xF, 0xF, true));
    v += __builtin_bit_cast(float, __builtin_amdgcn_mov_dpp(__builtin_bit_cast(int, v), 0x4E, 0xF, 0xF, true));
    v += __builtin_bit_cast(float, __builtin_amdgcn_mov_dpp(__builtin_bit_cast(int, v), 0x141, 0xF, 0xF, true));
    return v;
}
__device__ __forceinline__ void phase_peer_u(const Args& A, int layer, int nrows, LAS unsigned char* smem, int rep) {
    const int var = rep ? MK_UVAR : 0;
    const bf16_t* H = (const bf16_t*)(A.ws + WS_H); const int* IDX = (const int*)(A.ws + WS_R2); float* PART = var ? (float*)(A.ws + WS_R1) : (float*)(A.ws + WS_BIG + BIG_PART);
    const unsigned char* U = A.ws + WS_TAB;
    constexpr int PP = 1088, WB = 4 * PP + 2048;
    const int tid = otid(), wid = tid >> 6, lane = tid & 63, m = lane & 7, tk = lane >> 3;
    const int wu = __builtin_amdgcn_readfirstlane(wid);
    LAS unsigned char* lds = smem + LDS_BASE + wu * (2 * WB);
    PeerSched S; S.init(A, nrows, smem);
    peer_items(S,
        [&](int sl, int blk, int buf) {
#pragma unroll
            for (int i = 0; i < 4; ++i)
                __builtin_amdgcn_global_load_lds((const unsigned*)(IDX + ((size_t)blk * 64 + 8 * wu + 2 * i) * 128 + 4 * lane), (LAS unsigned*)(lds + buf * WB + PP * i), 16, 0, 0);
#pragma unroll
            for (int i = 0; i < 2; ++i)
                __builtin_amdgcn_global_load_lds((const unsigned*)(H + (size_t)(blk * 64 + 8 * wu + 4 * i + (lane >> 4)) * 1024 + SW * sl + 8 * (lane & 15)), (LAS unsigned*)(lds + buf * WB + 4 * PP + 1024 * i), 16, 0, 0); },
        [&](int sl, int blk, int buf) {
            const unsigned char* ub = U + (size_t)sl * NEXP * SW + 16 * m;
            const int tok = blk * 64 + wid * 8 + tk;
            const int sw = (tk & 1) * 4;
            const LAS int* ib = (const LAS int*)(lds + buf * WB + (tk >> 1) * PP + (tk & 1) * 512);
            float hf[16];
            { const u32x4 h0 = *(const LAS u32x4*)(lds + buf * WB + 4 * PP + tk * 256 + 32 * m), h1 = *(const LAS u32x4*)(lds + buf * WB + 4 * PP + tk * 256 + 32 * m + 16);
#pragma unroll
              for (int j = 0; j < 4; ++j) { hf[2 * j] = bflo(h0[j]); hf[2 * j + 1] = bfhi(h0[j]); hf[8 + 2 * j] = bflo(h1[j]); hf[8 + 2 * j + 1] = bfhi(h1[j]); } }
            const bool up4 = m >= 4, up2 = (m & 2) != 0, up1 = (m & 1) != 0;
            float* pp = PART + ((size_t)sl * NROW + tok) * 128 + (m ^ sw);
            u32x4 vv[2][8];
#define PU_ROWS(T, c) do { const i32x4 e0_ = *(const LAS i32x4*)(ib + 8 * (c) + sw), e1_ = *(const LAS i32x4*)(ib + 8 * (c) + (4 - sw)); \
                if (var == 4) { _Pragma("unroll") for (int k_ = 0; k_ < 8; ++k_) vv[T][k_] = (u32x4){(unsigned)e0_.x, (unsigned)e1_.y, 0u, 0u}; } else { \
                vv[T][0] = *(const u32x4*)(ub + (size_t)(var == 3 ? e0_.x & 63 : e0_.x) * SW); vv[T][1] = *(const u32x4*)(ub + (size_t)(var == 3 ? e0_.y & 63 : e0_.y) * SW); \
                vv[T][2] = *(const u32x4*)(ub + (size_t)(var == 3 ? e0_.z & 63 : e0_.z) * SW); vv[T][3] = *(const u32x4*)(ub + (size_t)(var == 3 ? e0_.w & 63 : e0_.w) * SW); \
                vv[T][4] = *(const u32x4*)(ub + (size_t)(var == 3 ? e1_.x & 63 : e1_.x) * SW); vv[T][5] = *(const u32x4*)(ub + (size_t)(var == 3 ? e1_.y & 63 : e1_.y) * SW); \
                vv[T][6] = *(const u32x4*)(ub + (size_t)(var == 3 ? e1_.z & 63 : e1_.z) * SW); vv[T][7] = *(const u32x4*)(ub + (size_t)(var == 3 ? e1_.w & 63 : e1_.w) * SW); } } while (0)
#define PU_DOT(T, c) do { float s_[8]; \
                _Pragma("unroll") for (int k = 0; k < 8; ++k) { f32x2 a2 = {0.f, 0.f}; \
                    _Pragma("unroll") for (int j = 0; j < 4; ++j) { const int w = (int)vv[T][k][j]; \
                        const f32x2 lo = __builtin_amdgcn_cvt_pk_f32_fp8(w, false), hi = __builtin_amdgcn_cvt_pk_f32_fp8(w, true); \
                        a2 = __builtin_elementwise_fma(lo, (f32x2){hf[4 * j], hf[4 * j + 1]}, a2); a2 = __builtin_elementwise_fma(hi, (f32x2){hf[4 * j + 2], hf[4 * j + 3]}, a2); } \
                    s_[k] = a2.x + a2.y; } \
                  \
                float t_[4], u_[2]; \
                _Pragma("unroll") for (int j = 0; j < 4; ++j) { const float give = up4 ? s_[j] : s_[4 + j], keep = up4 ? s_[4 + j] : s_[j]; \
                    t_[j] = keep + __builtin_bit_cast(float, __builtin_amdgcn_mov_dpp(__builtin_bit_cast(int, give), 0x141, 0xF, 0xF, true)); }        \
                _Pragma("unroll") for (int j = 0; j < 2; ++j) { const float give = up2 ? t_[j] : t_[2 + j], keep = up2 ? t_[2 + j] : t_[j]; \
                    u_[j] = keep + __builtin_bit_cast(float, __builtin_amdgcn_mov_dpp(__builtin_bit_cast(int, give), 0x4E, 0xF, 0xF, true)); }         \
                { const float give = up1 ? u_[0] : u_[1], keep = up1 ? u_[1] : u_[0]; \
                  const float tot_ = keep + __builtin_bit_cast(float, __builtin_amdgcn_mov_dpp(__builtin_bit_cast(int, give), 0xB1, 0xF, 0xF, true));           \
                  pp[8 * (c)] = tot_; } } while (0)
            PU_ROWS(0, 0);
#pragma unroll 1
            for (int c = 0; c < 16; c += 2) {
                PU_ROWS(1, c + 1);
                __builtin_amdgcn_sched_barrier(0);
                PU_DOT(0, c);
                __builtin_amdgcn_sched_barrier(0);
                if (c + 2 < 16) PU_ROWS(0, c + 2);
                __builtin_amdgcn_sched_barrier(0);
                PU_DOT(1, c + 1);
                __builtin_amdgcn_sched_barrier(0);
            }
#undef PU_ROWS
#undef PU_DOT
        });
}
__device__ __forceinline__ void phase_coef(const Args& A, int nrows) {
    const float* PART = (const float*)(A.ws + WS_BIG + BIG_PART); const float* GATE = (const float*)(A.ws + WS_R2 + R2_GATE); float* COEF = (float*)(A.ws + WS_R2 + R2_COEF);
    const int* IDX = (const int*)(A.ws + WS_R2); const float* SCL = (const float*)(A.ws + WS_TAB + TAB_SCL);
    const int gthr = blockIdx.x * NTHR + otid(), nthr = gridDim.x * NTHR;
    for (int p = gthr; p < nrows * 32; p += nthr) {
        f32x4 s = {0.f, 0.f, 0.f, 0.f};
#pragma unroll
        for (int x = 0; x < NSL; ++x) s += *(const f32x4*)(PART + (size_t)x * NROW * 128 + 4 * p);
        const i32x4 e = *(const i32x4*)(IDX + 4 * p); const f32x4 gt = *(const f32x4*)(GATE + 4 * p);
        const f32x4 su = {SCL[e.x], SCL[e.y], SCL[e.z], SCL[e.w]}, sv = {SCL[NEXP + e.x], SCL[NEXP + e.y], SCL[NEXP + e.z], SCL[NEXP + e.w]};
        const f32x4 a = s * su; const f32x2 g0 = gelu_pk((f32x2){a[0], a[1]}), g1 = gelu_pk((f32x2){a[2], a[3]});
        *(f32x4*)(COEF + 4 * p) = gt * (f32x4){g0.x, g0.y, g1.x, g1.y} * sv; }

}
__device__ __forceinline__ void phase_peer_v(const Args& A, int layer, int nrows, LAS unsigned char* smem, int rep) {
    const int* IDX = (const int*)(A.ws + WS_R2); const float* COEF = (const float*)(A.ws + WS_R2 + R2_COEF);
    const unsigned char* V = A.ws + WS_TAB + TAB8_HALF; const float* MODL = (const float*)(A.ws + WS_MOD) + (size_t)layer * 5 * 6144 + 5 * 1024;
    float* XC = (float*)(A.ws + WS_XC);
    constexpr int PP = 1088, WB = 8 * PP;
    const int tid = otid(), wid = tid >> 6, lane = tid & 63, m = lane & 7, tk = lane >> 3;
    const int wu = __builtin_amdgcn_readfirstlane(wid);
    LAS unsigned char* lds = smem + LDS_BASE + wu * (2 * WB);
    PeerSched S; S.init(A, nrows, smem);
    peer_items(S,
        [&](int sl, int blk, int buf) {
#pragma unroll
            for (int i = 0; i < 4; ++i) {
                __builtin_amdgcn_global_load_lds((const unsigned*)(IDX + ((size_t)blk * 64 + 8 * wu + 2 * i) * 128 + 4 * lane), (LAS unsigned*)(lds + buf * WB + PP * i), 16, 0, 0);
                __builtin_amdgcn_global_load_lds((const unsigned*)(COEF + ((size_t)blk * 64 + 8 * wu + 2 * i) * 128 + 4 * lane), (LAS unsigned*)(lds + buf * WB + 4 * PP + PP * i), 16, 0, 0); } },
        [&](int sl, int blk, int buf) {
            const unsigned char* vb = V + (size_t)sl * NEXP * SW + 16 * m;
            const int tok = blk * 64 + wid * 8 + tk; const bool lat = tok < NLAT;
            const int toff = (tk >> 1) * PP + (tk & 1) * 512, sw = (tk & 1) * 4;
            const LAS int* ib = (const LAS int*)(lds + buf * WB + toff); const LAS float* cb = (const LAS float*)(lds + buf * WB + 4 * PP + toff);
            float* xp = (lat ? A.out + (size_t)tok * D : XC + (size_t)(tok - NLAT) * D) + SW * sl + 16 * m;
            f32x4 xr[4];
#pragma unroll
            for (int j = 0; j < 4; ++j) xr[j] = *(f32x4*)(xp + 4 * j);
            f32x2 acc2[8];
#pragma unroll
            for (int j = 0; j < 8; ++j) acc2[j] = (f32x2){0.f, 0.f};
            u32x4 vv[2][8];
#define PV_ROWS(T, c) do { const i32x4 e0_ = *(const LAS i32x4*)(ib + 8 * (c) + sw), e1_ = *(const LAS i32x4*)(ib + 8 * (c) + (4 - sw)); \
                vv[T][0] = *(const u32x4*)(vb + (size_t)e0_.x * SW); vv[T][1] = *(const u32x4*)(vb + (size_t)e0_.y * SW); vv[T][2] = *(const u32x4*)(vb + (size_t)e0_.z * SW); vv[T][3] = *(const u32x4*)(vb + (size_t)e0_.w * SW); \
                vv[T][4] = *(const u32x4*)(vb + (size_t)e1_.x * SW); vv[T][5] = *(const u32x4*)(vb + (size_t)e1_.y * SW); vv[T][6] = *(const u32x4*)(vb + (size_t)e1_.z * SW); vv[T][7] = *(const u32x4*)(vb + (size_t)e1_.w * SW); } while (0)
#define PV_FMA(T, c) do { const f32x4 c0_ = *(const LAS f32x4*)(cb + 8 * (c) + sw), c1_ = *(const LAS f32x4*)(cb + 8 * (c) + (4 - sw)); \
                _Pragma("unroll") for (int k = 0; k < 8; ++k) { const float cf = k < 4 ? c0_[k & 3] : c1_[k & 3]; \
                    _Pragma("unroll") for (int j = 0; j < 4; ++j) { const int w = (int)vv[T][k][j]; \
                        const f32x2 lo = __builtin_amdgcn_cvt_pk_f32_fp8(w, false), hi = __builtin_amdgcn_cvt_pk_f32_fp8(w, true); const f32x2 c2 = {cf, cf}; \
                        acc2[2 * j] = __builtin_elementwise_fma(lo, c2, acc2[2 * j]); acc2[2 * j + 1] = __builtin_elementwise_fma(hi, c2, acc2[2 * j + 1]); } } } while (0)
            PV_ROWS(0, 0);
#pragma unroll 1
            for (int c = 0; c < 16; c += 2) {
                PV_ROWS(1, c + 1);
                __builtin_amdgcn_sched_barrier(0);
                PV_FMA(0, c);
                __builtin_amdgcn_sched_barrier(0);
                if (c + 2 < 16) PV_ROWS(0, c + 2);
                __builtin_amdgcn_sched_barrier(0);
                PV_FMA(1, c + 1);
                __builtin_amdgcn_sched_barrier(0);
            }
#undef PV_ROWS
#undef PV_FMA
            const float* gp = MODL + (size_t)(lat ? (tok >> 13) : 4) * 6144 + SW * sl + 16 * m;
#pragma unroll
            for (int j = 0; j < 4; ++j) { const f32x4 g = *(const f32x4*)(gp + 4 * j);
                *(f32x4*)(xp + 4 * j) = xr[j] + g * (f32x4){acc2[2 * j].x, acc2[2 * j].y, acc2[2 * j + 1].x, acc2[2 * j + 1].y}; }
        });
}

#ifdef MK_CHECK
constexpr int CW_CHK = 3840;
__device__ __forceinline__ float blk_sum(float v, LAS float* red) {
    const int t_ = otid(); v = wave_sum(v); __syncthreads(); if ((t_ & 63) == 0) red[t_ >> 6] = v; __syncthreads();
    float s = 0.f; for (int i = 0; i < 8; ++i) s += red[i]; __syncthreads(); return s;
}
__device__ __forceinline__ float fp8f(unsigned b) { const unsigned e = (b >> 3) & 15u, m = b & 7u; const float v = e ? ldexpf(1.f + (float)m * 0.125f, (int)e - 7) : ldexpf((float)m * 0.125f, -6); return (b & 0x80u) ? -v : v; }
__device__ __forceinline__ void check_attn(const Args& A, LAS unsigned char* lds) {
    const unsigned char* Q = A.ws + WS_R1 + R1_Q; const unsigned char* KN = A.ws + WS_R1 + R1_KN; const unsigned char* KR = A.ws + WS_BIG + BIG_KR; const unsigned char* V = A.ws + WS_R1 + R1_V;
    const bf16_t* CAT = (const bf16_t*)(A.ws + WS_R3 + R3_CAT); float* chk = (float*)(A.ws + WS_CTL) + CW_CHK;
    LAS float* p = (LAS float*)lds; LAS float* qv = p + NKEY; LAS float* red = qv + 192;
    const int tid = otid(), sidx = blockIdx.x;
    const int b = sidx & 3, h = (sidx >> 2) & 7, l = (int)(((unsigned)sidx * 2654435761u) >> 19) & 8191;
    const size_t bh = (size_t)(b * 8 + h);
    if (tid < 192) qv[tid] = fp8f(Q[(bh * NKEY + 256 + l) * 192 + tid]) * (1.f / att8::QUP);
    __syncthreads();
    float mx = -1e30f;
    for (int key = tid; key < NKEY; key += 512) { const int t = key >> 6, k = key & 63; float s = 0.f;
        for (int d = 0; d < 128; ++d) s += qv[d] * fp8f(KN[(bh * NKT + t) * 8192 + att8::kn8(k, d)]);
        for (int d = 0; d < 64; ++d) s += qv[128 + d] * fp8f(KR[((size_t)b * NKT + t) * 4096 + att8::kr8(k, d)]);
        p[key] = s; mx = fmaxf(mx, s); }
    for (int o = 32; o >= 1; o >>= 1) mx = fmaxf(mx, __shfl_xor(mx, o));
    __syncthreads(); if ((tid & 63) == 0) red[tid >> 6] = mx; __syncthreads(); mx = red[0]; for (int i = 1; i < 8; ++i) mx = fmaxf(mx, red[i]); __syncthreads();
    float ls = 0.f; for (int key = tid; key < NKEY; key += 512) { const float e = exp2f(p[key] - mx); p[key] = e; ls += e; }
    ls = blk_sum(ls, red);
    float num = 0.f, den = 0.f;
    if (tid < 128) { float o = 0.f; for (int key = 0; key < NKEY; ++key) o += p[key] * fp8f(V[(bh * NKT + (key >> 6)) * 8192 + att8::v8(tid, key & 63)]);
        o /= ls; const float got = bf2f(CAT[(size_t)(b * 8192 + l) * 2048 + 1024 + 128 * h + tid]); num = (got - o) * (got - o); den = o * o; }
    num = blk_sum(num, red); den = blk_sum(den, red);
    if (tid == 0) { atomicAdd(chk, num); atomicAdd(chk + 1, den); }
}
__device__ __forceinline__ void check_qkv(const Args& A, int li, LAS unsigned char* lds) {
    float* chk = (float*)(A.ws + WS_CTL) + CW_CHK;
    const unsigned char* Q = A.ws + WS_R1 + R1_Q; const unsigned char* KN = A.ws + WS_R1 + R1_KN; const unsigned char* KR = A.ws + WS_BIG + BIG_KR; const unsigned char* V = A.ws + WS_R1 + R1_V;
    LAS float* hv = (LAS float*)lds; LAS float* cq = hv + 1024; LAS float* ckv = cq + 384; LAS float* kr = ckv + 256; LAS float* red = kr + 64; LAS float* ov = red + 16;
    const int tid = otid(), sidx = blockIdx.x;
    const int hd = sidx & 7; const int r = (sidx & 8) ? NLAT + (int)(((unsigned)sidx * 2654435761u) >> 22) : (int)(((unsigned)sidx * 2654435761u) >> 17);
    const float* win = A.in[I_HWIN] + (size_t)li * 1024 * HYB_IN;
    {
        const float* xp = r < NLAT ? A.out + (size_t)r * D : (const float*)(A.ws + WS_XC) + (size_t)(r - NLAT) * D; const float* MODL = (const float*)(A.ws + WS_MOD) + (size_t)(2 * li) * 5 * 6144 + (size_t)row_mb(r) * 6144;
        float ss = 0.f; for (int i = tid; i < 1024; i += 512) ss += xp[i] * xp[i];
        ss = blk_sum(ss, red); const float rstd = rsqrtf(ss / 1024.f + EPS);
        for (int i = tid; i < 1024; i += 512) hv[i] = bf2f(f2bf(xp[i] * rstd * A.in[I_N1G][(2 * li) * 1024 + i] * (1.f + MODL[1024 + i]) + MODL[i])); }
    __syncthreads();
    for (int j = tid; j < 704; j += 512) { float s = 0.f; for (int k = 0; k < 1024; ++k) s += hv[k] * win[(size_t)k * HYB_IN + C_CQ + j];
        s = bf2f(f2bf(s)); if (j < 384) cq[j] = s; else if (j < 640) ckv[j - 384] = s; else kr[j - 640] = s; }
    __syncthreads();
    float sq = 0.f, sk = 0.f; for (int j = tid; j < 384; j += 512) sq += cq[j] * cq[j]; for (int j = tid; j < 256; j += 512) sk += ckv[j] * ckv[j];
    sq = blk_sum(sq, red); sk = blk_sum(sk, red);
    const float rq = rsqrtf(sq / 384.f + EPS), rk = rsqrtf(sk / 256.f + EPS);
    const float* wqb = A.in[I_WQB] + (size_t)li * 384 * 1536; const float* wkvb = A.in[I_WKVB] + (size_t)li * 256 * 2048; const float* qg = A.in[I_QNG] + li * 384; const float* kg = A.in[I_KVNG] + li * 256;
    if (tid < 192) { float s = 0.f; for (int k = 0; k < 384; ++k) s += cq[k] * rq * qg[k] * wqb[(size_t)k * 1536 + hd * 192 + tid]; ov[tid] = s; }
    else if (tid < 448) { const int c = tid - 192; float s = 0.f; for (int k = 0; k < 256; ++k) s += ckv[k] * rk * kg[k] * wkvb[(size_t)k * 2048 + hd * 256 + c]; ov[tid] = s; }
    __syncthreads();
    const bool lat = r < NLAT; const int b = lat ? (r >> 13) : ((r - NLAT) >> 8), l = lat ? (r & 8191) : 0, key = lat ? 256 + l : ((r - NLAT) & 255), qrow = key;
    const size_t bh = (size_t)(b * 8 + hd); const float qs = QSCALE * att8::QUP;
    float num = 0.f, den = 0.f;
    if (tid < 128) {
        const float q = ov[tid] * qs, gq = fp8f(Q[(bh * NKEY + qrow) * 192 + tid]);
        const float kk = ov[192 + tid], gk = fp8f(KN[(bh * NKT + (key >> 6)) * 8192 + att8::kn8(key & 63, tid)]);
        const float vv = ov[320 + tid], gv = fp8f(V[(bh * NKT + (key >> 6)) * 8192 + att8::v8(tid, key & 63)]);
        num = (gq - q) * (gq - q) + (gk - kk) * (gk - kk) + (gv - vv) * (gv - vv); den = q * q + kk * kk + vv * vv;
    } else if (tid < 160) {
        const int i = tid - 128; float c = 1.f, sn = 0.f;
        if (lat) { const float pos = (float)(i < 16 ? (l >> 6) : (l & 63)); const float ang = pos * powf(10000.f, -(float)(i & 15) / 16.f); c = cosf(ang); sn = sinf(ang); }
        const float q1 = ov[128 + i] * qs, q2 = ov[160 + i] * qs, k1 = kr[i], k2 = kr[32 + i];
        const float rq1 = q1 * c - q2 * sn, rq2 = q1 * sn + q2 * c, rk1 = k1 * c - k2 * sn, rk2 = k1 * sn + k2 * c;
        const float gq1 = fp8f(Q[(bh * NKEY + qrow) * 192 + 128 + 2 * i]), gq2 = fp8f(Q[(bh * NKEY + qrow) * 192 + 128 + 2 * i + 1]);
        const float gk1 = fp8f(KR[((size_t)b * NKT + (key >> 6)) * 4096 + att8::kr8(key & 63, 2 * i)]), gk2 = fp8f(KR[((size_t)b * NKT + (key >> 6)) * 4096 + att8::kr8(key & 63, 2 * i + 1)]);
        num = (gq1 - rq1) * (gq1 - rq1) + (gq2 - rq2) * (gq2 - rq2) + (gk1 - rk1) * (gk1 - rk1) + (gk2 - rk2) * (gk2 - rk2); den = rq1 * rq1 + rq2 * rq2 + rk1 * rk1 + rk2 * rk2;
    }
    num = blk_sum(num, red); den = blk_sum(den, red);
    if (tid == 0) { atomicAdd(chk, num); atomicAdd(chk + 1, den); }
}
__device__ __forceinline__ void check_topk(const Args& A, int layer, LAS unsigned char* lds) {
    const bf16_t* QP = (const bf16_t*)(A.ws + WS_BIG); const int* IDX = (const int*)(A.ws + WS_R2); const float* GATE = (const float*)(A.ws + WS_R2 + R2_GATE); float* chk = (float*)(A.ws + WS_CTL) + CW_CHK;
    const bf16_t* K1 = (const bf16_t*)(A.ws + WS_W + W_PEER + (size_t)layer * WP_SZ + WP_K1);
    LAS float* sc = (LAS float*)lds; LAS float* v12 = sc + 256; LAS int* i12 = (LAS int*)(v12 + 32); LAS float* cs = (LAS float*)(i12 + 32); LAS float* ts = cs + 256; LAS int* ti = (LAS int*)(ts + 16); LAS float* red = (LAS float*)(ti + 16);
    const int tid = otid();
    for (int smp = blockIdx.x; smp < 1024; smp += gridDim.x) {
        const int h = smp & 7, tok = (int)((((unsigned)smp * 2654435761u) >> 12) % (unsigned)NROW);
        __syncthreads();
        if (tid < 256) { const int half = tid >> 7, key = tid & 127; float a = 0.f;
            for (int d = 0; d < 128; ++d) a += bf2f(QP[(size_t)tok * 2048 + 256 * h + 128 * half + d]) * bf2f(K1[((size_t)half * 8 + h) * 16384 + key * 128 + d]);
            sc[tid] = a; }
        __syncthreads();
        if (tid < 256) { const int half = tid >> 7, key = tid & 127; const float v = sc[tid]; int rank = 0;
            for (int j = 0; j < 128; ++j) { const float o = sc[half * 128 + j]; rank += (o > v || (o == v && j < key)) ? 1 : 0; }
            if (rank < 16) { v12[half * 16 + rank] = v; i12[half * 16 + rank] = key; } }
        __syncthreads();
        if (tid < 256) cs[tid] = v12[tid >> 4] + v12[16 + (tid & 15)];
        __syncthreads();
        if (tid < 256) { const float v = cs[tid]; int rank = 0;
            for (int j = 0; j < 256; ++j) { const float o = cs[j]; rank += (o > v || (o == v && j < tid)) ? 1 : 0; }
            if (rank < 16) { ts[rank] = v; ti[rank] = i12[tid >> 4] * 128 + i12[16 + (tid & 15)]; } }
        __syncthreads();
        float num = 0.f, den = 0.f;
        if (tid < 16) { float es = 0.f; for (int j = 0; j < 16; ++j) es += __expf(ts[j] - ts[0]); const float gn = __expf(ts[tid] - ts[0]) / es; float gk = 0.f;
            for (int j = 0; j < 16; ++j) if (IDX[(size_t)tok * 128 + 16 * h + j] == ti[tid]) gk = GATE[(size_t)tok * 128 + 16 * h + j];
            num = (gk - gn) * (gk - gn); den = gn * gn; }
        num = blk_sum(num, red); den = blk_sum(den, red);
        if (tid == 0) { atomicAdd(chk, num); atomicAdd(chk + 1, den); }
    }
}
#endif
#ifndef MK_PER_PHASE
#define MK_PER_PHASE 0
#endif
__device__ __forceinline__ int nr_in(int L) { return L <= 2 ? NROW : NLAT; }
__device__ __forceinline__ int nr_out(int L) { return L <= 1 ? NROW : NLAT; }

__global__ void __launch_bounds__(NTHR, 2) fwd(Args A) {
    extern __shared__ __attribute__((aligned(256))) unsigned char smem_raw[];
    LAS unsigned char* smem = (LAS unsigned char*)smem_raw;
    LAS unsigned char* lds = smem + LDS_BASE;
    const int tid = otid();
    if (tid < 64) ((LAS unsigned*)smem)[tid] = 0u;
    __syncthreads();
    XcdBarrier bar = xcd_barrier_post((unsigned*)(A.ws + WS_CTL), (volatile LAS unsigned*)smem);
    if (tid == 0) ((LAS unsigned*)smem)[8] = atomicAdd((unsigned*)(A.ws + WS_CTL) + CW_RANK + 32 * (xb_xcc_id() & 7u), 1u);
    __syncthreads();
    bool need_bar = false;
    const int lo = A.ph_lo, hi = A.ph_hi;
#ifndef PHMASK
#define PHMASK 0xffffffffu
#endif
#define SITE(k) if constexpr (((PHMASK) >> (k)) & 1u)
#ifndef MK_SVAR
#define MK_SVAR 1
#endif
#ifndef MK_REPEAT_SITE
#define MK_REPEAT_SITE -1
#endif
#define REP(k) for (int rep = 0; rep < ((k) == (MK_REPEAT_SITE) ? 2 : 1); ++rep)
#define PH(id) if ([&]() -> bool { if ((id) < lo || (id) >= hi) return false; if (need_bar) xcd_barrier(bar); need_bar = true; return true; }())
    unsigned char* ws = A.ws;
    float* XL = A.out; float* XC = (float*)(ws + WS_XC);
    bf16_t* H = (bf16_t*)(ws + WS_H);
    const float* MOD = (const float*)(ws + WS_MOD);

    SITE(0) PH(0) { phase_prologue(A, lds); }
    SITE(1) PH(1) { phase_norm_mod(A.in[I_X], A.in[I_CTX], XL, XC, A.in[I_N1G], MOD, 0, H, NROW); }
    for (int L = 0; L < DEPTH; ++L) {
        const int base = 2 + 16 * L, li = L >> 1; const bool hyb = (L & 1) == 0;
        const float* MODL = MOD + (size_t)L * 5 * 6144;
        unsigned char* WH = ws + WS_W + W_HYB + (size_t)li * WH_SZ; unsigned char* WG = ws + WS_W + W_GM + (size_t)li * WG_SZ; unsigned char* WP = ws + WS_W + W_PEER + (size_t)L * WP_SZ;
        if (hyb) {
            SITE(2) PH(base + 0) REP(2) { pg8::Gemm g{H, (const bf16_t*)(WH + WH_IN), nr_in(L), HYB_INP, 1024, 1024, 1024};
                pg8::EpiBf16<0> e{(bf16_t*)(ws + WS_BIG), HYB_INP}; pg8::gemm_phase(lds, g, e); }
            SITE(3) PH(base + 1) REP(3) { phase_conv(A, li); }
            SITE(4) PH(base + 2) {
                SITE(18) REP(18) { pg8::Gemm g{(const bf16_t*)(ws + WS_BIG) + C_CQ, (const bf16_t*)(WH + WH_QB), L == 0 ? NROW : NLAT, 1536, 384, HYB_INP, 384};
                  EpiQ e{ws + WS_R1 + R1_Q, (const float*)(ws + WS_RSTD), (const float*)(ws + WS_ROPE)}; pg8::gemm_phase(lds, g, e); }
                SITE(19) REP(19) { pg8::Gemm g{(const bf16_t*)(ws + WS_BIG) + C_CKV, (const bf16_t*)(WH + WH_KVB), NROW, 2048, 256, HYB_INP, 256};
                  EpiKV e{ws + WS_R1 + R1_KN, ws + WS_R1 + R1_V, (const float*)(ws + WS_RSTD) + NROW}; pg8::gemm_phase(lds, g, e); }
                SITE(20) REP(20) for (int u = blockIdx.x; u < 528; u += gridDim.x) ssd::g_unit((const bf16_t*)(ws + WS_R2 + R2_BC), (bf16_t*)(ws + WS_BIG + BIG_G), u);
            }
            SITE(5) PH(base + 3) {
                const int xq = (int)blockIdx.x & 7, jq = (int)blockIdx.x >> 3; const bool ssd_wg = (jq & 1) == 0 && gridDim.x == 256;
                if (gridDim.x == 256) {
                    if (ssd_wg) { const int r = jq >> 1, gi = xq + 8 * (r >> 3), hh = r & 7, sb = gi >> 2, sgp = (gi >> 1) & 1, sd = gi & 1;
                        SITE(21) ssd::ssd_unit(sb, 8 * sgp + hh, sd, (const bf16_t*)(ws + WS_R2), (const bf16_t*)(ws + WS_R2 + R2_BC), (const float*)(ws + WS_BIG + BIG_DT), (const bf16_t*)(ws + WS_BIG + BIG_G),
                                               A.in[I_ALOG] + li * 32, sd ? (bf16_t*)(ws + WS_R3) : (bf16_t*)(ws + WS_H), lds); }
                } else {
                    SITE(21) for (int u = blockIdx.x; u < 128; u += gridDim.x) ssd::ssd_unit(u >> 5, (u >> 1) & 15, u & 1, (const bf16_t*)(ws + WS_R2), (const bf16_t*)(ws + WS_R2 + R2_BC), (const float*)(ws + WS_BIG + BIG_DT),
                                               (const bf16_t*)(ws + WS_BIG + BIG_G), A.in[I_ALOG] + li * 32, (u & 1) ? (bf16_t*)(ws + WS_R3) : (bf16_t*)(ws + WS_H), lds);
                }
                const int nmine = gridDim.x == 256 ? (ssd_wg ? 3 : 5) + (L == 0 && !ssd_wg && jq < 8 ? 1 : 0) : 0;
                SITE(22) REP(22) for (int it = 0; gridDim.x == 256 ? it < nmine : (int)blockIdx.x + it * (int)gridDim.x < (L == 0 ? 1056 : 1024); ++it) {
                    int b, h, qrow0, orow0, nt;
                    if (gridDim.x == 256) {
                        const int base_it = ssd_wg ? 3 : 5;
                        if (it < base_it) { const int v = ssd_wg ? 3 * (jq >> 1) + it : 48 + 5 * (jq >> 1) + it; b = v >> 5; h = xq; const int qb = v & 31; qrow0 = 256 + 256 * qb; orow0 = b * 8192 + 256 * qb; nt = NKT; }
                        else { b = jq >> 1; h = xq; qrow0 = 0; orow0 = NLAT + 256 * b; nt = 4; }
                    } else { const int au = (int)blockIdx.x + it * (int)gridDim.x;
                        if (au < 1024) { b = au >> 8; h = au & 7; const int qb = (au >> 3) & 31; qrow0 = 256 + 256 * qb; orow0 = b * 8192 + 256 * qb; nt = NKT; }
                        else { const int cu = au - 1024; b = cu >> 3; h = cu & 7; qrow0 = 0; orow0 = NLAT + 256 * b; nt = 4; } }
                    const size_t bh = (size_t)(b * 8 + h);
                    att8::attn_unit(ws + WS_R1 + R1_Q + (bh * NKEY + qrow0) * 192, ws + WS_R1 + R1_KN + bh * NKT * 8192, ws + WS_BIG + BIG_KR + (size_t)b * NKT * 4096,
                                    ws + WS_R1 + R1_V + bh * NKT * 8192, (bf16_t*)(ws + WS_R3 + R3_CAT) + (size_t)orow0 * 2048 + 1024 + 128 * h, nt, lds);
                }
                if (gridDim.x == 256 && !ssd_wg) SITE(11) phase_tabcvt(A, L, xq + 8 * (jq >> 1), 128);
            }
            SITE(6) PH(base + 4) REP(6) { phase_ssd_out(A, li, nr_out(L));
#if defined(MK_CHECK) && MK_CHECK == 1
                if (L == 0) check_attn(A, lds);
#elif defined(MK_CHECK) && MK_CHECK == 2
                if (L == 0) check_qkv(A, li, lds);
#elif defined(MK_CHECK) && MK_CHECK == 3
                if (L == 2) check_attn(A, lds);
#endif
            }
        } else {
            SITE(7) PH(base + 0) REP(7) { pg8::Gemm g{H, (const bf16_t*)(WG + WG_IN), nr_out(L), 4096, 1024, 1024, 1024};
                pg8::EpiBf16<1> e{(bf16_t*)(ws + WS_BIG), 4096}; pg8::gemm_phase(lds, g, e); }
            SITE(8) PH(base + 1) REP(8) { phase_ln_stats(A, nr_out(L)); }
            SITE(9) PH(base + 2) REP(9) { phase_spatial(A, li, nr_out(L), lds); }
        }
        SITE(10) PH(base + 5) { pg8::Gemm g{hyb ? (const bf16_t*)(ws + WS_R3 + R3_CAT) : (const bf16_t*)(ws + WS_R1), hyb ? (const bf16_t*)(WH + WH_OUT) : (const bf16_t*)(WG + WG_OUT), nr_out(L), 1024, 2048, 2048, 2048};
            pg8::EpiResid e{XL, XC, MODL + 2 * 1024}; pg8::gemm_phase(lds, g, e); }
        SITE(11) PH(base + 6) REP(11) { phase_norm_mod(XL, XC, nullptr, nullptr, A.in[I_N2G] + L * 1024, MODL, 3, H, nr_out(L));
            if (!hyb || gridDim.x != 256) phase_tabcvt(A, L, (int)blockIdx.x, (int)gridDim.x); }
        SITE(12) PH(base + 7) REP(12) { pg8::Gemm g{H, (const bf16_t*)(WP + WP_Q), nr_out(L), 2048, 1024, 1024, 1024};
            pg8::EpiBf16<0> e{(bf16_t*)(ws + WS_BIG), 2048}; pg8::gemm_phase(lds, g, e); }
        SITE(13) PH(base + 8) REP(13) { phase_topk(A, L, nr_out(L), lds); }
        SITE(14) PH(base + 9) REP(14) { phase_peer_u(A, L, nr_out(L), smem, rep); }
        SITE(15) PH(base + 10) REP(15) { phase_coef(A, nr_out(L));
#if defined(MK_CHECK) && MK_CHECK == 4
            if (L == 1) check_topk(A, L, lds);
#endif
        }
        SITE(16) PH(base + 11) { phase_peer_v(A, L, nr_out(L), smem, 0); }
        SITE(17) PH(base + 12) { if (L < DEPTH - 1) phase_norm_mod(XL, XC, nullptr, nullptr, A.in[I_N1G] + (L + 1) * 1024, MOD + (size_t)(L + 1) * 5 * 6144, 0, H, nr_in(L + 1));
                        else {
#ifdef MK_CHECK
                            const float* chk = (const float*)(ws + WS_CTL) + CW_CHK; const float err = sqrtf(chk[0] / fmaxf(chk[1], 1e-30f));
                            phase_final_norm(XL, A.in[I_FNG], 1.f + 10.f * err);
#else
                            phase_final_norm(XL, A.in[I_FNG], 1.f);
#endif
                        } }
    }
#undef PH
}

#ifdef MK_TAP
__global__ void tap_kernel(const unsigned short* buf, size_t pitch, size_t col0, size_t ncols, size_t nrows, float* out) {
    const size_t n = ncols * nrows;
    for (size_t i = (size_t)blockIdx.x * blockDim.x + threadIdx.x; i < (size_t)NLAT * D; i += (size_t)gridDim.x * blockDim.x) {
        float s = 0.f; for (size_t j = i; j < n; j += (size_t)NLAT * D) s += (float)buf[(j / ncols) * pitch + col0 + (j % ncols)]; out[i] = s; }
}
#endif
extern "C" void kernel_launch(void* const* d_in, const int* in_sizes, int n_in, void* d_out, int out_size, void* d_ws, size_t ws_size, hipStream_t stream) {
    static int grid = 0;
    if (grid == 0) {
        if (n_in != N_IN || out_size != NLAT * D || ws_size < WS_END) { fprintf(stderr, "kernel_launch: unexpected shapes (n_in %d out %d ws %zu, need %zu)\n", n_in, out_size, ws_size, (size_t)WS_END); grid = -1; return; }
        int dev = 0, cus = 0, per_cu = 0;
        if (hipGetDevice(&dev) != hipSuccess || hipDeviceGetAttribute(&cus, hipDeviceAttributeMultiprocessorCount, dev) != hipSuccess) { grid = -1; return; }
        if (hipFuncSetAttribute((const void*)fwd, hipFuncAttributeMaxDynamicSharedMemorySize, LDS_BYTES) != hipSuccess) { fprintf(stderr, "kernel_launch: hipFuncSetAttribute failed\n"); grid = -1; return; }
        if (hipOccupancyMaxActiveBlocksPerMultiprocessor(&per_cu, (const void*)fwd, NTHR, LDS_BYTES) != hipSuccess || per_cu < 1) { fprintf(stderr, "kernel_launch: occupancy query says %d\n", per_cu); }
        (void)hipGetLastError();
        grid = cus;
    }
    if (grid < 0) return;
    (void)hipMemsetAsync((char*)d_ws + WS_CTL, 0, CTL_BYTES, stream);
    Args a{};
    for (int i = 0; i < N_IN; ++i) a.in[i] = (const float*)d_in[i];
    a.out = (float*)d_out; a.ws = (unsigned char*)d_ws;
#if MK_PER_PHASE
    for (int id = 0; id < 2 + 16 * DEPTH; ++id) {
        if (id >= 2) { const int L = (id - 2) / 16, s = (id - 2) % 16; if (s > 12) continue; if ((L & 1) && (s == 3 || s == 4)) continue; }
#ifdef MK_CUT
#ifdef MK_TAP
        if (id >= MK_CUT) continue;
#else
        if (id >= MK_CUT && id != 2 + 16 * (DEPTH - 1) + 12) continue;
#endif
#endif
        a.ph_lo = id; a.ph_hi = id + 1;
        hipLaunchKernelGGL(fwd, dim3(grid), dim3(NTHR), LDS_BYTES, stream, a);
    }
#ifdef MK_TAP
    { const size_t tp[5] = {MK_TAP}; hipLaunchKernelGGL(tap_kernel, dim3(2048), dim3(256), 0, stream, (const unsigned short*)((const char*)d_ws + tp[0]), tp[1], tp[2], tp[3], tp[4], (float*)d_out); }
#endif
#else
    a.ph_lo = 0; a.ph_hi = 2 + 16 * DEPTH;
    hipLaunchKernelGGL(fwd, dim3(grid), dim3(NTHR), LDS_BYTES, stream, a);
#endif
    const hipError_t le = hipPeekAtLastError();
    if (le != hipSuccess) fprintf(stderr, "kernel_launch: launch failed: %s\n", hipGetErrorName(le));
}
```

```cpp
#include <hip/hip_runtime.h>
#include <cstdio>
#include <cstdint>

#define LAS __attribute__((address_space(3)))
typedef unsigned short bf16_t;
typedef short bf16x8 __attribute__((ext_vector_type(8)));
typedef short s16x4 __attribute__((ext_vector_type(4)));
typedef float f32x2 __attribute__((ext_vector_type(2)));
typedef float f32x4 __attribute__((ext_vector_type(4)));
typedef float f32x16 __attribute__((ext_vector_type(16)));
typedef unsigned u32x2 __attribute__((ext_vector_type(2)));
typedef unsigned u32x4 __attribute__((ext_vector_type(4)));
typedef int i32x4 __attribute__((ext_vector_type(4)));
typedef int i32x8 __attribute__((ext_vector_type(8)));

constexpr int D = 1024, NB = 4, SEQ = 8192, DEPTH = 4, CTXL = 256;
constexpr int NLAT = NB * SEQ, NCTX = NB * CTXL, NROW = NLAT + NCTX;
constexpr int HYB_IN = 3280, HYB_INP = 3328;
constexpr int C_Z = 0, C_XBC = 1024, C_DT = 2560, C_CQ = 2576, C_CKV = 2960, C_KR = 3216;
constexpr int NKEY = SEQ + CTXL, NKT = NKEY / 64;
constexpr float EPS = 1e-6f;
constexpr float QSCALE = 0.07216878364870322f * 1.4426950408889634f;
constexpr int NEXP = 16384;

enum { I_X = 0, I_C, I_CTX, I_CCTX, I_ADAW, I_ADAB, I_N1G, I_N2G, I_HWIN, I_CONVW, I_CONVB, I_ALOG, I_DTB, I_SSDD, I_SSDNG, I_QNG, I_WQB, I_KVNG, I_WKVB,
       I_HWOUT, I_GWIN, I_GLNG, I_GLNB, I_GWS, I_GBS, I_GWOUT, I_PWQ, I_PK1, I_PK2, I_PU, I_PV, I_FNG, N_IN };

constexpr size_t al256(size_t x) { return (x + 255) & ~(size_t)255; }
constexpr size_t WS_CTL = 0, CTL_BYTES = 65536;
constexpr size_t WS_MOD = WS_CTL + CTL_BYTES;
constexpr size_t WS_ROPE = WS_MOD + al256((size_t)DEPTH * 5 * 6144 * 4);
constexpr size_t WS_RSTD = WS_ROPE + (size_t)2 * SEQ * 32 * 4;
constexpr size_t WS_W = WS_RSTD + al256((size_t)2 * NROW * 4);
constexpr size_t W_HYB = 0;
constexpr size_t WH_IN = 0, WH_QB = WH_IN + (size_t)HYB_INP * 1024 * 2, WH_KVB = WH_QB + (size_t)1536 * 384 * 2, WH_OUT = WH_KVB + (size_t)2048 * 256 * 2,
                 WH_SZ = WH_OUT + (size_t)1024 * 2048 * 2;
constexpr size_t W_GM = W_HYB + 2 * WH_SZ;
constexpr size_t WG_IN = 0, WG_OUT = WG_IN + (size_t)4096 * 1024 * 2, WG_WS = WG_OUT + (size_t)1024 * 2048 * 2, WG_SZ = WG_WS + (size_t)8 * 128 * 128 * 2;
constexpr size_t W_PEER = W_GM + 2 * WG_SZ;
constexpr size_t WP_Q = 0, WP_K1 = WP_Q + (size_t)2048 * 1024 * 2, WP_K2 = WP_K1 + (size_t)8 * 128 * 128 * 2, WP_SZ = WP_K2 + (size_t)8 * 128 * 128 * 2;
constexpr size_t W_TOTAL = W_PEER + 4 * WP_SZ;
constexpr size_t WS_TAB = WS_W + al256(W_TOTAL);
constexpr size_t TAB_HALF = (size_t)NEXP * 1024 * 2;
constexpr size_t WS_XC = WS_TAB + 2 * TAB_HALF;
constexpr size_t WS_H = WS_XC + (size_t)NCTX * D * 4;
constexpr size_t WS_BIG = WS_H + (size_t)NROW * D * 2;
constexpr size_t BIG_BYTES = (size_t)NROW * 4096 * 2;
constexpr size_t BIG_DT = (size_t)NROW * HYB_INP * 2;
constexpr size_t BIG_G = BIG_DT + (size_t)NROW * 32 * 4;
constexpr size_t BIG_KR = BIG_G + (size_t)528 * 128 * 128 * 2;
constexpr size_t BIG_PART = (size_t)NROW * 2048 * 2;
static_assert(BIG_KR + (size_t)NB * NKT * 8192 <= BIG_BYTES, "BIG tail");
constexpr size_t WS_R1 = WS_BIG + BIG_BYTES;
constexpr size_t R1_Q = 0, R1_KN = R1_Q + (size_t)NB * 8 * NKEY * 192 * 2, R1_V = R1_KN + (size_t)NB * 8 * NKT * 16384, R1_BYTES = R1_V + (size_t)NB * 8 * NKT * 16384;
constexpr size_t WS_R2 = WS_R1 + R1_BYTES;
constexpr size_t R2_BC = (size_t)NROW * 1024 * 2, R2_BYTES = R2_BC + (size_t)NROW * 512 * 2;
constexpr size_t R2_GATE = (size_t)NROW * 128 * 4, R2_COEF = 2 * R2_GATE;
constexpr size_t WS_R3 = WS_R2 + R2_BYTES;
constexpr size_t R3_CAT = (size_t)NROW * 1024 * 2, R3_BYTES = R3_CAT + (size_t)NROW * 2048 * 2;
constexpr size_t WS_END = WS_R3 + R3_BYTES;
static_assert(WS_END <= ((size_t)1 << 30), "workspace must fit 1 GiB");

constexpr int CW_RANK = 3584;
constexpr int CW_QUEUE = 4096;

typedef __bf16 bf16x2_t __attribute__((ext_vector_type(2)));
__device__ __forceinline__ unsigned cvt_pk_bf16(float lo, float hi) { const f32x2 v = {lo, hi}; const bf16x2_t b = __builtin_convertvector(v, bf16x2_t); return __builtin_bit_cast(unsigned, b); }
__device__ __forceinline__ bf16_t f2bf(float f) { return (bf16_t)(cvt_pk_bf16(f, 0.f) & 0xffffu); }
__device__ __forceinline__ float bf2f(unsigned b) { return __uint_as_float(b << 16); }
__device__ __forceinline__ float bflo(unsigned w) { return __uint_as_float(w << 16); }
__device__ __forceinline__ float bfhi(unsigned w) { return __uint_as_float(w & 0xffff0000u); }
__device__ __forceinline__ float wave_sum(float v) {
#pragma unroll
    for (int o = 32; o >= 1; o >>= 1) v += __shfl_xor(v, o);
    return v;
}
__device__ __forceinline__ int otid() { int t = threadIdx.x; asm volatile("" : "+v"(t)); return t; }
__device__ __forceinline__ float silu_f(float x) { return x / (1.f + __expf(-x)); }
__device__ __forceinline__ float softplus_f(float x) { return x > 20.f ? x : log1pf(__expf(x)); }
__device__ __forceinline__ f32x2 gelu_pk(f32x2 v) {
    const f32x2 av = __builtin_elementwise_abs(v), d = av * 0.2316418882f + 1.0f;
    f32x2 t; t.x = __builtin_amdgcn_rcpf(d.x); t.y = __builtin_amdgcn_rcpf(d.y);
    f32x2 q = t * 0.5307027145f + (-0.7265760135f); q = q * t + 0.7107068705f; q = q * t + (-0.142248368f); q = q * t + 0.127414796f; q = q * t;
    const f32x2 s = (v * v) * (-0.72134752044f);
    f32x2 e; e.x = __builtin_amdgcn_exp2f(s.x); e.y = __builtin_amdgcn_exp2f(s.y);
    const f32x2 m = v * (q * e), r = v - m;
    f32x2 o; o.x = v.x < 0.f ? m.x : r.x; o.y = v.y < 0.f ? m.y : r.y; return o;
}
__device__ __forceinline__ float gelu_f(float x) { f32x2 v = {x, 0.f}; return gelu_pk(v).x; }

__device__ __forceinline__ unsigned pk4_fp8(float a, float b, float c, float d) { int w = 0; w = __builtin_amdgcn_cvt_pk_fp8_f32(a, b, w, false); w = __builtin_amdgcn_cvt_pk_fp8_f32(c, d, w, true); return (unsigned)w; }
__device__ __forceinline__ float sat8(float v) { return __builtin_amdgcn_fmed3f(v, -448.f, 448.f); }
__device__ __forceinline__ unsigned pk4_fp8_sat(float a, float b, float c, float d) { return pk4_fp8(sat8(a), sat8(b), sat8(c), sat8(d)); }
__device__ __forceinline__ int row_mb(int r) { return r < NLAT ? (r >> 13) : 4; }

#define XB_TMO      128
#define XB_XCNT(j)  (256  + 64 * (j))
#define XB_XSUB(j)  (1280 + 64 * (j))
#define XB_XGEN(j)  (2304 + 64 * (j))
#define XB_TOP      3328
#define XB_TOPGEN   3392
#define XCD_BAR_WORDS 3456
#define XB_SPIN_CAP (1u << 22)
__device__ __forceinline__ unsigned xb_ld(unsigned* p)              { return __hip_atomic_load(p, __ATOMIC_RELAXED, __HIP_MEMORY_SCOPE_AGENT); }
__device__ __forceinline__ unsigned xb_add(unsigned* p, unsigned v) { return __hip_atomic_fetch_add(p, v, __ATOMIC_RELAXED, __HIP_MEMORY_SCOPE_AGENT); }
__device__ __forceinline__ unsigned xb_xcc_id() { return (unsigned)__builtin_amdgcn_s_getreg((3 << 11) | 20) & 0xFu; }
#define XB_SPIN(cond, bar) do { unsigned _sp = 0; while (cond) { __builtin_amdgcn_s_sleep(1); \
    if ((++_sp & 255u) == 0u) { if (xb_ld(&(bar)[XB_TMO])) break; if (_sp > XB_SPIN_CAP) { atomicAdd(&(bar)[XB_TMO], 1u); break; } } } } while (0)
struct XcdBarrier { unsigned* bar; unsigned x; volatile LAS unsigned* st; };
__device__ __forceinline__ XcdBarrier xcd_barrier_post(unsigned* bar, volatile LAS unsigned* st) {
    XcdBarrier b; b.bar = bar; b.x = xb_xcc_id(); b.st = st;
    if (threadIdx.x == 0) (void)xb_add(&bar[XB_XCNT(b.x)], 1u);
    return b;
}
__device__ __forceinline__ void xcd_barrier_complete(unsigned* bar, unsigned x, unsigned& nloc, unsigned& nx) {
    const unsigned G = gridDim.x * gridDim.y * gridDim.z;
    unsigned sum, cnt, mine, sp = 0u;
    for (;;) {
        sum = 0u; cnt = 0u; mine = 0u;
#pragma unroll
        for (unsigned j = 0; j < 16; ++j) { const unsigned c = xb_ld(&bar[XB_XCNT(j)]); sum += c; cnt += (c > 0u) ? 1u : 0u; mine = (j == x) ? c : mine; }
        if (sum == G) break;
        __builtin_amdgcn_s_sleep(1);
        if ((++sp & 255u) == 0u) { if (xb_ld(&bar[XB_TMO])) break; if (sp > XB_SPIN_CAP) { atomicAdd(&bar[XB_TMO], 1u); break; } }
    }
    nloc = mine > 0u ? mine : 1u; nx = cnt > 0u ? cnt : 1u;
}
__device__ __forceinline__ void xcd_barrier(const XcdBarrier& b) {
    asm volatile("s_waitcnt vmcnt(0)" ::: "memory");
    __syncthreads();
    if (threadIdx.x == 0) {
        unsigned* bar = b.bar;
        __builtin_amdgcn_s_waitcnt(0);
        unsigned nloc = b.st[0], nx = b.st[1];
        if (nloc == 0u) { xcd_barrier_complete(bar, b.x, nloc, nx); b.st[0] = nloc; b.st[1] = nx; }
        const unsigned old = xb_add(&bar[XB_XSUB(b.x)], 1u);
        const unsigned gen = old / nloc;
        if (old + 1u == (gen + 1u) * nloc) {
            __builtin_amdgcn_fence(__ATOMIC_RELEASE, "agent");
            asm volatile("s_waitcnt vmcnt(0)" ::: "memory");
            const unsigned og = xb_add(&bar[XB_TOP], 1u);
            const unsigned tg = og / nx;
            if (og + 1u == (tg + 1u) * nx) xb_add(&bar[XB_TOPGEN], 1u);
            else XB_SPIN(xb_ld(&bar[XB_TOPGEN]) == tg, bar);
            __builtin_amdgcn_fence(__ATOMIC_ACQUIRE, "agent");
            xb_add(&bar[XB_XGEN(b.x)], 1u);
            asm volatile("s_waitcnt vmcnt(0)" ::: "memory");
        } else {
            XB_SPIN(xb_ld(&bar[XB_XGEN(b.x)]) == gen, bar);
            __builtin_amdgcn_fence(__ATOMIC_ACQUIRE, "agent");
            asm volatile("s_waitcnt vmcnt(0)" ::: "memory");
        }
    }
    __syncthreads();
}

namespace pg8 {
constexpr int BM = 256, BK = 64, HALF = 128, HTB = HALF * BK * 2, STAGE_BYTES = 8 * HTB, NXCD = 8, WGM = 8;
__host__ __device__ __forceinline__ int lds_byte(int r, int c) { const int st = (r >> 4) * 2 + (c >> 5), rr = r & 15, cc = c & 31, ob = rr * 64 + cc * 2; return st * 1024 + (ob ^ (((ob >> 9) & 1) << 5)); }
__host__ __device__ __forceinline__ void stage_rc(int b, int& R, int& C) { const int st = b / 1024, sb = b % 1024, swz = sb ^ (((sb >> 9) & 1) << 5); R = (st >> 1) * 16 + swz / 64; C = (st & 1) * 32 + (swz % 64) / 2; }
__host__ __device__ __forceinline__ int perm32(int rho) { const int n = rho >> 4, i = rho & 15; return 8 * (i >> 2) + 4 * n + (i & 3); }
struct Unit { int pm, pn; };
struct Gemm { const bf16_t* A; const bf16_t* Bt; int M, N, K, lda, ldb; };
struct StaticOrder {
    int nM, nN, nwg, G, c;
    __device__ void init(int M, int N, int G_, int c_) { nM = M / BM; nN = N / BM; nwg = nM * nN; G = G_; c = c_; }
    __device__ bool next(int i, Unit& u) const {
        const long L = (long)i * G + c; if (L >= nwg) return false;
        int wgid = (int)L; { const int q = nwg / NXCD, r = nwg % NXCD, xcd = wgid % NXCD, off = wgid / NXCD; wgid = (xcd < r ? xcd * (q + 1) : r * (q + 1) + (xcd - r) * q) + off; }
        const int nig = WGM * nN, gid = wgid / nig, fm = gid * WGM, gsz = (nM - fm) < WGM ? (nM - fm) : WGM;
        u.pm = fm + ((wgid % nig) % gsz); u.pn = (wgid % nig) / gsz; return true;
    }
};
template <class Epi>
__device__ __forceinline__ void gemm_phase(LAS unsigned char* lds, const Gemm g, const Epi& E) {
    const int tid = otid(), wid = __builtin_amdgcn_readfirstlane(tid >> 6), lane = tid & 63, wr = wid >> 2, wc = wid & 3, fr = lane & 15, fq = lane >> 4;
    StaticOrder S; S.init(g.M, g.N, (int)gridDim.x, (int)blockIdx.x);
    int K = g.K; asm volatile("" : "+s"(K));
    const int nt = K / BK;
    unsigned voffA[2], voffB[2];
#pragma unroll
    for (int i = 0; i < 2; ++i) { int R, C; stage_rc(tid * 16 + i * 8192, R, C); const int Rb = Epi::PERM ? ((R & ~31) + perm32(R & 31)) : R;
        voffA[i] = (unsigned)(R * g.lda + C) * 2u; voffB[i] = (unsigned)(Rb * g.ldb + C) * 2u; }
    const size_t kstep = (size_t)(BK * 2);
    const size_t hstepA = (size_t)HALF * g.lda * 2, hstepB = (size_t)HALF * g.ldb * 2;
    const size_t tstepA = 2 * hstepA, tstepB = 2 * hstepB;
    const unsigned ldsw = (unsigned)wid * 1024u;
    const int aoff = lds_byte(wr * 64 + fr, fq * 8), boff = lds_byte(wc * 32 + fr, fq * 8);
#define PG8_SA(b, h) (((b) * 2 + (h)) * HTB)
#define PG8_SB(b, h) ((4 + (b) * 2 + (h)) * HTB)
#define PG8_STAGE(bufoff, gbase, voff) do { _Pragma("unroll") for (int _i = 0; _i < 2; ++_i) \
        __builtin_amdgcn_global_load_lds((const unsigned*)((const char*)(gbase) + (voff)[_i]), (LAS unsigned*)(lds + (bufoff) + ldsw + _i * 8192), 16, 0, 0); } while (0)
#define PG8_LDA(dst, b, h) do { _Pragma("unroll") for (int m = 0; m < 4; ++m) _Pragma("unroll") for (int k = 0; k < 2; ++k) dst[m][k] = *(const LAS bf16x8*)(lds + PG8_SA(b, h) + aoff + m * 2048 + k * 1024); } while (0)
#define PG8_LDB(dst, b, h) do { _Pragma("unroll") for (int n = 0; n < 2; ++n) _Pragma("unroll") for (int k = 0; k < 2; ++k) dst[n][k] = *(const LAS bf16x8*)(lds + PG8_SB(b, h) + boff + n * 2048 + k * 1024); } while (0)
#define PG8_MMA(ai, bj, At, Bt) do { __builtin_amdgcn_s_setprio(1); _Pragma("unroll") for (int m = 0; m < 4; ++m) _Pragma("unroll") for (int n = 0; n < 2; ++n) _Pragma("unroll") for (int k = 0; k < 2; ++k) \
        acc[ai][bj][m][n] = __builtin_amdgcn_mfma_f32_16x16x32_bf16(Bt[n][k], At[m][k], acc[ai][bj][m][n], 0, 0, 0); __builtin_amdgcn_s_setprio(0); } while (0)
#define PG8_WAIT_V(n) asm volatile("s_waitcnt vmcnt(" #n ")" ::: "memory")
#define PG8_WAIT_L(n) asm volatile("s_waitcnt lgkmcnt(" #n ")" ::: "memory")
#define PG8_BAR __builtin_amdgcn_s_barrier()
#define PG8_SCHED __builtin_amdgcn_sched_barrier(0)
    Unit cur, nxt; int ui = 0;
    if (!S.next(0, cur)) return;
    f32x4 acc[2][2][4][2];
#pragma unroll
    for (int a = 0; a < 2; ++a)
#pragma unroll
        for (int b = 0; b < 2; ++b)
#pragma unroll
            for (int m = 0; m < 4; ++m)
#pragma unroll
                for (int n = 0; n < 2; ++n) acc[a][b][m][n] = (f32x4){0.f, 0.f, 0.f, 0.f};
    bf16x8 At[4][2], B0[2][2], B1[2][2];
    const char* cA = (const char*)g.A + (size_t)cur.pm * tstepA; const char* cB = (const char*)g.Bt + (size_t)cur.pn * tstepB;
    PG8_STAGE(PG8_SB(0, 0), cB, voffB); PG8_STAGE(PG8_SB(0, 1), cB + hstepB, voffB); PG8_STAGE(PG8_SA(0, 0), cA, voffA); PG8_STAGE(PG8_SA(0, 1), cA + hstepA, voffA);
    if (wr == 1) PG8_BAR;
    PG8_WAIT_V(2); PG8_BAR;
    PG8_STAGE(PG8_SB(1, 0), cB + kstep, voffB); PG8_STAGE(PG8_SA(1, 0), cA + kstep, voffA); PG8_STAGE(PG8_SB(1, 1), cB + hstepB + kstep, voffB);
    PG8_WAIT_V(6); PG8_BAR;
    for (;;) {
        const bool has_next = S.next(ui + 1, nxt);
        const char* nA = has_next ? (const char*)g.A + (size_t)nxt.pm * tstepA : cA; const char* nB = has_next ? (const char*)g.Bt + (size_t)nxt.pn * tstepB : cB;
        for (int t = 0; t < nt; t += 2) {
            const bool last = (t == nt - 2);
            const char* a1 = cA + (size_t)(t + 1) * kstep;
            const char* a2 = last ? nA : cA + (size_t)(t + 2) * kstep; const char* b2 = last ? nB : cB + (size_t)(t + 2) * kstep;
            const char* a3 = a2 + kstep; const char* b3 = b2 + kstep;
            PG8_LDB(B0, 0, 0); PG8_LDB(B1, 0, 1); PG8_SCHED; PG8_LDA(At, 0, 0); PG8_STAGE(PG8_SA(1, 1), a1 + hstepA, voffA);
            PG8_WAIT_V(8); PG8_WAIT_L(0); PG8_BAR; PG8_MMA(0, 0, At, B0); PG8_MMA(0, 1, At, B1); PG8_BAR; PG8_SCHED;
            PG8_LDA(At, 0, 1); PG8_STAGE(PG8_SB(0, 0), b2, voffB); PG8_STAGE(PG8_SB(0, 1), b2 + hstepB, voffB); PG8_STAGE(PG8_SA(0, 0), a2, voffA);
            PG8_WAIT_V(8); PG8_WAIT_L(0); PG8_BAR; PG8_MMA(1, 0, At, B0); PG8_MMA(1, 1, At, B1); PG8_BAR; PG8_SCHED;
            PG8_LDB(B0, 1, 0); PG8_LDB(B1, 1, 1); PG8_SCHED; PG8_LDA(At, 1, 0); PG8_STAGE(PG8_SA(0, 1), a2 + hstepA, voffA);
            PG8_WAIT_V(8); PG8_WAIT_L(0); PG8_BAR; PG8_MMA(0, 0, At, B0); PG8_MMA(0, 1, At, B1); PG8_BAR; PG8_SCHED;
            PG8_LDA(At, 1, 1); PG8_STAGE(PG8_SB(1, 0), b3, voffB); PG8_STAGE(PG8_SB(1, 1), b3 + hstepB, voffB); PG8_STAGE(PG8_SA(1, 0), a3, voffA);
            PG8_WAIT_V(8); PG8_WAIT_L(0); PG8_BAR; PG8_MMA(1, 0, At, B0); PG8_MMA(1, 1, At, B1); PG8_BAR; PG8_SCHED;
        }
        if (wr == 0) PG8_BAR;
        { const int l2_ = otid() & 63; E(acc, cur, wr, wc, l2_ & 15, l2_ >> 4); }
        if (!has_next) break;
#pragma unroll
        for (int a = 0; a < 2; ++a)
#pragma unroll
            for (int b = 0; b < 2; ++b)
#pragma unroll
                for (int m = 0; m < 4; ++m)
#pragma unroll
                    for (int n = 0; n < 2; ++n) acc[a][b][m][n] = (f32x4){0.f, 0.f, 0.f, 0.f};
        cur = nxt; cA = nA; cB = nB; ++ui;
        if (wr == 1) PG8_BAR;
    }
    PG8_WAIT_V(0);
    PG8_BAR;
#undef PG8_SA
#undef PG8_SB
#undef PG8_STAGE
#undef PG8_LDA
#undef PG8_LDB
#undef PG8_MMA
#undef PG8_WAIT_V
#undef PG8_WAIT_L
#undef PG8_BAR
#undef PG8_SCHED
}

template <int ACT> struct EpiBf16 {
    static constexpr bool PERM = true;
    bf16_t* O; int ldc;
    __device__ __forceinline__ void operator()(const f32x4 (&acc)[2][2][4][2], const Unit& u, int wr, int wc, int fr, int fq) const {
        const int row0 = u.pm * BM + wr * 64 + fr, col0 = u.pn * BM + wc * 32 + 8 * fq;
#pragma unroll
        for (int ai = 0; ai < 2; ++ai)
#pragma unroll
            for (int m = 0; m < 4; ++m) { bf16_t* rowp = O + (size_t)(row0 + ai * HALF + m * 16) * ldc + col0;
#pragma unroll
                for (int bj = 0; bj < 2; ++bj) { f32x4 v0 = acc[ai][bj][m][0], v1 = acc[ai][bj][m][1];
                    if (ACT == 1) { f32x2 a = gelu_pk((f32x2){v0[0], v0[1]}), b = gelu_pk((f32x2){v0[2], v0[3]}), c = gelu_pk((f32x2){v1[0], v1[1]}), d = gelu_pk((f32x2){v1[2], v1[3]});
                        v0 = (f32x4){a.x, a.y, b.x, b.y}; v1 = (f32x4){c.x, c.y, d.x, d.y}; }
                    u32x4 w; w.x = cvt_pk_bf16(v0[0], v0[1]); w.y = cvt_pk_bf16(v0[2], v0[3]); w.z = cvt_pk_bf16(v1[0], v1[1]); w.w = cvt_pk_bf16(v1[2], v1[3]);
                    *(u32x4*)(rowp + bj * HALF) = w; } }
    }
};
struct EpiResid {
    static constexpr bool PERM = false;
    float* xl; float* xc; const float* gate;
    __device__ __forceinline__ void operator()(const f32x4 (&acc)[2][2][4][2], const Unit& u, int wr, int wc, int fr, int fq) const {
        const int rbase = u.pm * BM; const bool lat = rbase < NLAT;
        float* X = lat ? xl + (size_t)rbase * D : xc + (size_t)(rbase - NLAT) * D;
        const float* gp = gate + (size_t)(lat ? (rbase >> 13) : 4) * 6144;
        const int row0 = wr * 64 + fr, col0 = u.pn * BM + wc * 32 + 4 * fq;
        f32x4 gv[2][2];
#pragma unroll
        for (int bj = 0; bj < 2; ++bj)
#pragma unroll
            for (int n = 0; n < 2; ++n) gv[bj][n] = *(const f32x4*)(gp + col0 + bj * HALF + n * 16);
#pragma unroll
        for (int ai = 0; ai < 2; ++ai)
#pragma unroll
            for (int m = 0; m < 4; ++m) { float* rowp = X + (size_t)(row0 + ai * HALF + m * 16) * D + col0;
#pragma unroll
                for (int bj = 0; bj < 2; ++bj)
#pragma unroll
                    for (int n = 0; n < 2; ++n) { f32x4* p = (f32x4*)(rowp + bj * HALF + n * 16); *p = *p + gv[bj][n] * acc[ai][bj][m][n]; } }
    }
};
}

namespace att {
#define KSWZ(row, colB) ((row) * 256 + ((colB) ^ (((row) & 7) << 4)))
#define KRSWZ(row, colB) ((row) * 128 + ((colB) ^ ((((row) >> 1) & 7) << 4)))
#define SBAR() __builtin_amdgcn_sched_barrier(0)
__device__ __forceinline__ int crow(int r, int hi) { return (r & 3) + 8 * (r >> 2) + 4 * hi; }
__host__ __device__ __forceinline__ int v_st(int k, int c) { const int kk = (k & ~0xC) | ((k & 4) << 1) | ((k & 8) >> 1); return ((kk >> 3) * 4 + (c >> 5)) * 512 + ((kk & 7) * 32 + (c & 31)) * 2; }
__device__ __forceinline__ int v_rd_base(int lane) { return ((lane & 3) << 3) | (((lane >> 2) & 3) << 6) | (((lane >> 4) & 1) << 5) | (((lane >> 5) & 1) << 8); }
constexpr int v_rd_off(int d0, int ks, int half) { return d0 * 512 + ks * 4096 + half * 2048; }
template <int OFF> __device__ __forceinline__ s16x4 tr_read(int vb) {
    s16x4 r; asm volatile("ds_read_b64_tr_b16 %0, %1 offset:%2" : "=&v"(r) : "v"(vb), "i"(OFF) : "memory"); return r;
}
template <int D0> __device__ __forceinline__ void pv_one(f32x16& od, int vb, bf16x8 pa0, bf16x8 pa1, bf16x8 pa2, bf16x8 pa3) {
    const s16x4 l0 = tr_read<v_rd_off(D0, 0, 0)>(vb), h0 = tr_read<v_rd_off(D0, 0, 1)>(vb), l1 = tr_read<v_rd_off(D0, 1, 0)>(vb), h1 = tr_read<v_rd_off(D0, 1, 1)>(vb);
    const s16x4 l2 = tr_read<v_rd_off(D0, 2, 0)>(vb), h2 = tr_read<v_rd_off(D0, 2, 1)>(vb), l3 = tr_read<v_rd_off(D0, 3, 0)>(vb), h3 = tr_read<v_rd_off(D0, 3, 1)>(vb);
    asm volatile("s_waitcnt lgkmcnt(0)" ::: "memory"); SBAR();
#define PK(L, H) (bf16x8){L[0], L[1], L[2], L[3], H[0], H[1], H[2], H[3]}
    od = __builtin_amdgcn_mfma_f32_32x32x16_bf16(pa0, PK(l0, h0), od, 0, 0, 0);
    od = __builtin_amdgcn_mfma_f32_32x32x16_bf16(pa1, PK(l1, h1), od, 0, 0, 0);
    od = __builtin_amdgcn_mfma_f32_32x32x16_bf16(pa2, PK(l2, h2), od, 0, 0, 0);
    od = __builtin_amdgcn_mfma_f32_32x32x16_bf16(pa3, PK(l3, h3), od, 0, 0, 0);
#undef PK
}
__device__ __forceinline__ void pv_d0(f32x16* o, int vb, bf16x8 pa0, bf16x8 pa1, bf16x8 pa2, bf16x8 pa3) {
    pv_one<0>(o[0], vb, pa0, pa1, pa2, pa3); pv_one<1>(o[1], vb, pa0, pa1, pa2, pa3); pv_one<2>(o[2], vb, pa0, pa1, pa2, pa3); pv_one<3>(o[3], vb, pa0, pa1, pa2, pa3);
}
}

namespace att8 {
constexpr int SLOT = 20480, KN_OFF = 0, KR_OFF = 8192, V_OFF = 12288, LDS_BYTES = 3 * SLOT + 8 * 256;
constexpr float THR2 = 8.0f;
constexpr float QUP = 8.f; constexpr int SC_ONE = 0x7f7f7f7f, SC_Q = 0x7c7c7c7c;
__host__ __device__ __forceinline__ int kn8(int key, int b) { return key * 128 + ((((b >> 4) ^ ((key >> 1) & 7))) << 4) + (b & 15); }
__host__ __device__ __forceinline__ int kr8(int key, int b) { return key * 64 + ((((b >> 4) ^ ((key >> 2) & 3))) << 4) + (b & 15); }
__host__ __device__ __forceinline__ int vslot(int k) { return 32 * ((k >> 2) & 1) + 16 * (k >> 5) + (k & 3) + 4 * ((k & 31) >> 3); }
__host__ __device__ __forceinline__ int v8(int d, int k) { const int sl = vslot(k); return d * 64 + ((((sl >> 4) ^ ((d >> 2) & 3))) << 4) + (sl & 15); }
__device__ __forceinline__ i32x8 ld32(const LAS unsigned char* a0, const LAS unsigned char* a1) { const u32x4 x = *(const LAS u32x4*)a0, y = *(const LAS u32x4*)a1;
    return (i32x8){(int)x.x, (int)x.y, (int)x.z, (int)x.w, (int)y.x, (int)y.y, (int)y.z, (int)y.w}; }
__device__ __forceinline__ void qkt(f32x16& p0, f32x16& p1, LAS unsigned char* slot, const i32x8* qf, int r32, int hi) {
    p0 = f32x16{}; p1 = f32x16{};
#pragma unroll
    for (int ks = 0; ks < 2; ++ks) { const int b = 64 * ks + 32 * hi;
        const i32x8 a0 = ld32(slot + KN_OFF + kn8(r32, b), slot + KN_OFF + kn8(r32, b + 16)), a1 = ld32(slot + KN_OFF + kn8(32 + r32, b), slot + KN_OFF + kn8(32 + r32, b + 16));
        p0 = __builtin_amdgcn_mfma_scale_f32_32x32x64_f8f6f4(a0, qf[ks], p0, 0, 0, 0, SC_ONE, 0, SC_Q);
        p1 = __builtin_amdgcn_mfma_scale_f32_32x32x64_f8f6f4(a1, qf[ks], p1, 0, 0, 0, SC_ONE, 0, SC_Q); }
    { const int b = 32 * hi;
        const i32x8 a0 = ld32(slot + KR_OFF + kr8(r32, b), slot + KR_OFF + kr8(r32, b + 16)), a1 = ld32(slot + KR_OFF + kr8(32 + r32, b), slot + KR_OFF + kr8(32 + r32, b + 16));
        p0 = __builtin_amdgcn_mfma_scale_f32_32x32x64_f8f6f4(a0, qf[2], p0, 0, 0, 0, SC_ONE, 0, SC_Q);
        p1 = __builtin_amdgcn_mfma_scale_f32_32x32x64_f8f6f4(a1, qf[2], p1, 0, 0, 0, SC_ONE, 0, SC_Q); }
}
__device__ __forceinline__ void partialSM(f32x16& p0, f32x16& p1, float& m_reg, float& mn, float& alpha) {
    float pmax = p0[0];
#pragma unroll
    for (int r = 1; r < 16; ++r) pmax = fmaxf(pmax, p0[r]);
#pragma unroll
    for (int r = 0; r < 16; ++r) pmax = fmaxf(pmax, p1[r]);
    { auto rr = __builtin_amdgcn_permlane32_swap(__float_as_uint(pmax), __float_as_uint(pmax), false, false);
      pmax = fmaxf(__uint_as_float(rr[0]), __uint_as_float(rr[1])); }
    if (__builtin_expect(__all(pmax - m_reg <= THR2), 1)) { mn = m_reg; alpha = 1.f; }
    else { mn = fmaxf(m_reg, pmax); alpha = __builtin_amdgcn_exp2f(m_reg - mn); m_reg = mn; }
#pragma unroll
    for (int r = 0; r < 16; ++r) p0[r] = __builtin_amdgcn_exp2f(p0[r] - mn);
#pragma unroll
    for (int r = 0; r < 16; ++r) p1[r] = p1[r] - mn;
}
__device__ __forceinline__ void finishSM(f32x16& p0, f32x16& p1, float alpha, float& l_reg, i32x8& pf) {
#pragma unroll
    for (int r = 0; r < 16; ++r) p1[r] = __builtin_amdgcn_exp2f(p1[r]);
    float ps = 0;
#pragma unroll
    for (int r = 0; r < 16; ++r) ps += p0[r];
#pragma unroll
    for (int r = 0; r < 16; ++r) ps += p1[r];
    { auto rr = __builtin_amdgcn_permlane32_swap(__float_as_uint(ps), __float_as_uint(ps), false, false);
      ps = __uint_as_float(rr[0]) + __uint_as_float(rr[1]); }
    l_reg = l_reg * alpha + ps;
#pragma unroll
    for (int w = 0; w < 4; ++w) { pf[w] = (int)pk4_fp8(p0[4 * w], p0[4 * w + 1], p0[4 * w + 2], p0[4 * w + 3]); pf[4 + w] = (int)pk4_fp8(p1[4 * w], p1[4 * w + 1], p1[4 * w + 2], p1[4 * w + 3]); }
}
__device__ __forceinline__ void pv(f32x16* o, LAS unsigned char* slot, const i32x8 pf, int r32, int hi) {
#pragma unroll
    for (int d0 = 0; d0 < 4; ++d0) { const int d = 32 * d0 + r32, sw = (d >> 2) & 3;
        const i32x8 b = ld32(slot + V_OFF + d * 64 + (((2 * hi) ^ sw) << 4), slot + V_OFF + d * 64 + (((2 * hi + 1) ^ sw) << 4));
        o[d0] = __builtin_amdgcn_mfma_scale_f32_32x32x64_f8f6f4(pf, b, o[d0], 0, 0, 0, SC_ONE, 0, SC_ONE); }
}
__device__ __forceinline__ int crow(int r, int hi) { return (r & 3) + 8 * (r >> 2) + 4 * hi; }
__device__ __forceinline__ void attn_unit(const unsigned char* __restrict__ Qb, const unsigned char* __restrict__ KNt, const unsigned char* __restrict__ KRt, const unsigned char* __restrict__ Vt,
                                          bf16_t* __restrict__ Ob, int NT, LAS unsigned char* lds) {
    const int tid = otid(), wid = __builtin_amdgcn_readfirstlane(tid >> 6), lane = tid & 63, r32 = lane & 31, hi = lane >> 5;
    LAS float* wsf = (LAS float*)(lds + 3 * SLOT) + wid * 64; LAS float* li_l = wsf; LAS float* al_l = wsf + 32;
    float m_reg = -1e30f, l_reg = 0; f32x16 o[4] = {}; i32x8 qf[3];
    const unsigned char* Qw = Qb + (size_t)(wid * 32 + r32) * 192 + 32 * hi;
#pragma unroll
    for (int ks = 0; ks < 3; ++ks) { const u32x4 x = *(const u32x4*)(Qw + 64 * ks), y = *(const u32x4*)(Qw + 64 * ks + 16); qf[ks] = (i32x8){(int)x.x, (int)x.y, (int)x.z, (int)x.w, (int)y.x, (int)y.y, (int)y.z, (int)y.w}; }
    const unsigned lo16 = (unsigned)lane * 16u;
#define ATT_DMA(tile, slotoff) do { const size_t t_ = (size_t)(tile); LAS unsigned char* sl_ = lds + (slotoff); \
        __builtin_amdgcn_global_load_lds((const unsigned*)(KNt + t_ * 8192 + wid * 1024 + lo16), (LAS unsigned*)(sl_ + KN_OFF + wid * 1024), 16, 0, 0); \
        __builtin_amdgcn_global_load_lds((const unsigned*)(Vt + t_ * 8192 + wid * 1024 + lo16), (LAS unsigned*)(sl_ + V_OFF + wid * 1024), 16, 0, 0); \
        if (wid < 4) __builtin_amdgcn_global_load_lds((const unsigned*)(KRt + t_ * 4096 + wid * 1024 + lo16), (LAS unsigned*)(sl_ + KR_OFF + wid * 1024), 16, 0, 0); } while (0)
#define ATT_SYNC() do { asm volatile("s_waitcnt vmcnt(0)" ::: "memory"); __builtin_amdgcn_s_barrier(); asm volatile("" ::: "memory"); } while (0)
#define RESC(a) do { if (__any((a) < 1.f)) { if (hi == 0) al_l[r32] = (a); asm volatile("s_waitcnt lgkmcnt(0)" ::: "memory"); \
        _Pragma("unroll") for (int d = 0; d < 4; ++d) _Pragma("unroll") for (int r = 0; r < 16; ++r) o[d][r] *= al_l[crow(r, hi)]; } } while (0)
    f32x16 pA0, pA1, pB0, pB1; float mnA, mnB, alA, alB; i32x8 pf;
    int sp = 0, sc = SLOT, sn = 2 * SLOT;
    ATT_DMA(0, 0);
    ATT_SYNC();
    ATT_DMA(1, SLOT);
    qkt(pA0, pA1, lds, qf, r32, hi); partialSM(pA0, pA1, m_reg, mnA, alA);
    for (int j = 1; j + 1 < NT; j += 2) {
        ATT_SYNC(); ATT_DMA(j + 1, sn);
        SBAR(); qkt(pB0, pB1, lds + sc, qf, r32, hi);
        finishSM(pA0, pA1, alA, l_reg, pf); SBAR();
        pv(o, lds + sp, pf, r32, hi); partialSM(pB0, pB1, m_reg, mnB, alB);
        RESC(alB);
        { const int t_ = sp; sp = sc; sc = sn; sn = t_; }
        ATT_SYNC(); if (j + 2 < NT) ATT_DMA(j + 2, sn);
        SBAR(); qkt(pA0, pA1, lds + sc, qf, r32, hi);
        finishSM(pB0, pB1, alB, l_reg, pf); SBAR();
        pv(o, lds + sp, pf, r32, hi); partialSM(pA0, pA1, m_reg, mnA, alA);
        RESC(alA);
        { const int t_ = sp; sp = sc; sc = sn; sn = t_; }
    }
    ATT_SYNC();
    SBAR(); qkt(pB0, pB1, lds + sc, qf, r32, hi);
    finishSM(pA0, pA1, alA, l_reg, pf); SBAR();
    pv(o, lds + sp, pf, r32, hi); partialSM(pB0, pB1, m_reg, mnB, alB);
    RESC(alB);
    finishSM(pB0, pB1, alB, l_reg, pf); SBAR();
    pv(o, lds + sc, pf, r32, hi);
    if (hi == 0) li_l[r32] = l_reg; asm volatile("s_waitcnt lgkmcnt(0)" ::: "memory");
    float rli[16];
#pragma unroll
    for (int r = 0; r < 16; ++r) rli[r] = __builtin_amdgcn_rcpf(li_l[crow(r, hi)]);
    bf16_t* Ow = Ob + (size_t)(wid * 32) * 2048;
#pragma unroll
    for (int r = 0; r < 16; ++r) { const int orow = crow(r, hi);
#pragma unroll
        for (int d0 = 0; d0 < 4; ++d0) Ow[(size_t)orow * 2048 + d0 * 32 + r32] = f2bf(o[d0][r] * rli[r]); }
    __builtin_amdgcn_s_barrier(); asm volatile("" ::: "memory");
#undef ATT_DMA
#undef ATT_SYNC
#undef RESC
}
}

namespace ssd {
constexpr int XT_OFF = 0, BT_OFF = 17408, HB_OFF = 52224, SET = 69632, CW_OFF = 2 * SET, LDS_BYTES = CW_OFF + 8 * 1536;
constexpr int PITCH = 272;
constexpr float L2E = 1.4426950408889634f;
__device__ __forceinline__ void g_unit(const bf16_t* __restrict__ BC, bf16_t* __restrict__ G, int unit) {
    const int cid = unit >> 1, g = unit & 1;
    const int r0 = cid < 256 ? cid * 128 : NLAT + (cid - 256) * 128;
    const int tid = otid(), wid = tid >> 6, lane = tid & 63, fr = lane & 15, fq = lane >> 4;
    const bf16_t* Cp = BC + (size_t)(r0 + 16 * wid + fr) * 512 + 256 + 128 * g + 8 * fq;
    bf16x8 cf[4];
#pragma unroll
    for (int ks = 0; ks < 4; ++ks) cf[ks] = *(const bf16x8*)(Cp + 32 * ks);
    bf16_t* Gp = G + ((size_t)unit * 128 + 16 * wid + fr) * 128 + 4 * fq;
#pragma unroll
    for (int sb = 0; sb < 8; ++sb) {
        const bf16_t* Bp = BC + (size_t)(r0 + 16 * sb + fr) * 512 + 128 * g + 8 * fq;
        f32x4 acc = {0.f, 0.f, 0.f, 0.f};
#pragma unroll
        for (int ks = 0; ks < 4; ++ks) { const bf16x8 bfr = *(const bf16x8*)(Bp + 32 * ks); acc = __builtin_amdgcn_mfma_f32_16x16x32_bf16(bfr, cf[ks], acc, 0, 0, 0); }
        u32x2 w; w.x = cvt_pk_bf16(acc[0], acc[1]); w.y = cvt_pk_bf16(acc[2], acc[3]);
        *(u32x2*)(Gp + 16 * sb) = w;
    }
}
__device__ __forceinline__ void ssd_unit(int b, int h, int d, const bf16_t* __restrict__ XS, const bf16_t* __restrict__ BC, const float* __restrict__ DT, const bf16_t* __restrict__ G,
                                         const float* __restrict__ a_log, bf16_t* __restrict__ Y, LAS unsigned char* lds) {
    const int g = h >> 3;
    const int tid = otid(), wid = tid >> 6, lane = tid & 63, fr = lane & 15, fq = lane >> 4;
    const float a = -__expf(a_log[d * 16 + h]);
    LAS float* cw = (LAS float*)(lds + CW_OFF + wid * 1536); LAS float* dts = cw + 128; LAS float* dtw = cw + 256;
    f32x4 hs[4];
#pragma unroll
    for (int q = 0; q < 4; ++q) hs[q] = (f32x4){0.f, 0.f, 0.f, 0.f};
    for (int i = tid; i < 17408 / 4; i += 512) ((LAS unsigned*)(lds + HB_OFF))[i] = 0u;
    float cend = 0.f;
#define SSD_ROWS(step, r0v, gidv) do { if ((step) < 2) { const int oc_ = d ? 1 - (step) : (step); r0v = NLAT + b * 256 + oc_ * 128; gidv = 256 + b * 2 + oc_; } \
        else { const int lc_ = (step) - 2, oc_ = d ? 63 - lc_ : lc_; r0v = b * 8192 + oc_ * 128; gidv = b * 64 + oc_; } } while (0)
    const int sg = tid & 31, n8 = tid >> 5, p4 = tid >> 5;
    f32x2 P_da, Q_da; u32x2 P_xv[4], Q_xv[4]; u32x4 P_bv[4], Q_bv[4], n_gv[4], n_cv[4], c_gv[4], c_cv[4];
#define SSD_LOAD(step, X) do { int r0_, gid_; SSD_ROWS(step, r0_, gid_); (void)gid_; X##_da = *(const f32x2*)(DT + (size_t)(d * 16 + h) * NROW + r0_ + 2 * lane); \
        _Pragma("unroll") for (int j_ = 0; j_ < 4; ++j_) { X##_xv[j_] = *(const u32x2*)(XS + (size_t)(r0_ + 4 * sg + j_) * 1024 + 64 * h + 4 * p4); \
                                                         X##_bv[j_] = *(const u32x4*)(BC + (size_t)(r0_ + 4 * sg + j_) * 512 + 128 * g + 8 * n8); } } while (0)
#define SSD_LOADGC(step) do { int r0_, gid_; SSD_ROWS(step, r0_, gid_); const int t_ = 16 * wid + fr; const bf16_t* Gp_ = G + ((size_t)(gid_ * 2 + g) * 128 + t_) * 128 + 8 * fq; const bf16_t* Cp_ = BC + (size_t)(r0_ + t_) * 512 + 256 + 128 * g + 8 * fq; \
          _Pragma("unroll") for (int ks_ = 0; ks_ < 4; ++ks_) { n_gv[ks_] = *(const u32x4*)(Gp_ + 32 * ks_); n_cv[ks_] = *(const u32x4*)(Cp_ + 32 * ks_); } } while (0)
#define SSD_GCROT() do { _Pragma("unroll") for (int ks_ = 0; ks_ < 4; ++ks_) { c_gv[ks_] = n_gv[ks_]; c_cv[ks_] = n_cv[ks_]; } } while (0)
#define SSD_WRITE(step, X) do { LAS unsigned char* set_ = lds + ((step) & 1) * SET; \
        const float da0 = X##_da.x * a, da1 = X##_da.y * a; \
        float sc_ = da0 + da1; float c0_, c1_; \
        if (d == 0) { _Pragma("unroll") for (int o_ = 1; o_ < 64; o_ <<= 1) { const float t_ = __shfl_up(sc_, o_); if (lane >= o_) sc_ += t_; } \
            c0_ = sc_ - da1; c1_ = sc_; cend = __shfl(sc_, 63); } \
        else { _Pragma("unroll") for (int o_ = 1; o_ < 64; o_ <<= 1) { const float t_ = __shfl_down(sc_, o_); if (lane + o_ < 64) sc_ += t_; } \
            c0_ = sc_; c1_ = sc_ - da0; cend = __shfl(sc_, 0); } \
        *(LAS f32x2*)(cw + 2 * lane) = (f32x2){c0_, c1_}; *(LAS f32x2*)(dts + 2 * lane) = X##_da; \
        *(LAS f32x2*)(dtw + 2 * lane) = (f32x2){X##_da.x * __builtin_amdgcn_exp2f((cend - c0_) * L2E), X##_da.y * __builtin_amdgcn_exp2f((cend - c1_) * L2E)}; \
        { LAS unsigned char* xt_ = set_ + XT_OFF + (4 * p4) * PITCH + 8 * sg; \
          _Pragma("unroll") for (int i_ = 0; i_ < 4; ++i_) { unsigned e_[4]; \
              _Pragma("unroll") for (int j_ = 0; j_ < 4; ++j_) { const unsigned w_ = (i_ & 2) ? X##_xv[j_].y : X##_xv[j_].x; e_[j_] = (i_ & 1) ? (w_ >> 16) : (w_ & 0xffffu); } \
              u32x2 o_; o_.x = e_[0] | (e_[1] << 16); o_.y = e_[2] | (e_[3] << 16); *(LAS u32x2*)(xt_ + i_ * PITCH) = o_; } } \
        { LAS unsigned char* bt_ = set_ + BT_OFF + (8 * n8) * PITCH + 8 * sg; \
          _Pragma("unroll") for (int i_ = 0; i_ < 8; ++i_) { unsigned e_[4]; \
              _Pragma("unroll") for (int j_ = 0; j_ < 4; ++j_) { const unsigned w_ = X##_bv[j_][i_ >> 1]; e_[j_] = (i_ & 1) ? (w_ >> 16) : (w_ & 0xffffu); } \
              u32x2 o_; o_.x = e_[0] | (e_[1] << 16); o_.y = e_[2] | (e_[3] << 16); *(LAS u32x2*)(bt_ + i_ * PITCH) = o_; } } \
        asm volatile("s_waitcnt lgkmcnt(0)" ::: "memory"); \
    } while (0)
    SSD_LOAD(0, Q); SSD_LOADGC(0); SSD_WRITE(0, Q); SSD_LOAD(1, P);
    for (int step2 = 0; step2 < 66; step2 += 2)
#pragma unroll
    for (int par = 0; par < 2; ++par) {
        const int step = step2 + par;
        __syncthreads();
        int r0, gid; SSD_ROWS(step, r0, gid); (void)gid;
        LAS unsigned char* set = lds + (step & 1) * SET;
        const float cend_cur = cend;
        SSD_GCROT();
        if (step + 1 < 66) SSD_LOADGC(step + 1);
        if (step + 2 < 66) { if (par == 0) SSD_LOAD(step + 2, Q); else SSD_LOAD(step + 2, P); }
        {
            const int t = 16 * wid + fr; const float ct = cw[t];
            f32x4 y[4];
#pragma unroll
            for (int q = 0; q < 4; ++q) y[q] = (f32x4){0.f, 0.f, 0.f, 0.f};
            const float et = __builtin_amdgcn_exp2f(ct * L2E);
#pragma unroll
            for (int ks = 0; ks < 4; ++ks) {
                const bool live = d == 0 ? (32 * ks <= 16 * wid + 15) : (32 * ks + 31 >= 16 * wid);
                if (live) {
                    const int s0 = 32 * ks + 8 * fq;
                    const f32x4 c0 = *(const LAS f32x4*)(cw + s0), c1 = *(const LAS f32x4*)(cw + s0 + 4), d0v = *(const LAS f32x4*)(dts + s0), d1v = *(const LAS f32x4*)(dts + s0 + 4);
                    float m[8];
#pragma unroll
                    for (int i = 0; i < 8; ++i) { const float cs = i < 4 ? c0[i & 3] : c1[i & 3], dv = i < 4 ? d0v[i & 3] : d1v[i & 3]; const int s = s0 + i;
                        const bool ok = d == 0 ? (s <= t) : (s >= t);
                        const float gval = (i & 1) ? bfhi(c_gv[ks][i >> 1]) : bflo(c_gv[ks][i >> 1]);
                        m[i] = ok ? gval * dv * __builtin_amdgcn_exp2f((ct - cs) * L2E) : 0.f; }
                    u32x4 mw; mw.x = cvt_pk_bf16(m[0], m[1]); mw.y = cvt_pk_bf16(m[2], m[3]); mw.z = cvt_pk_bf16(m[4], m[5]); mw.w = cvt_pk_bf16(m[6], m[7]);
                    const bf16x8 mb = __builtin_bit_cast(bf16x8, mw);
#pragma unroll
                    for (int q = 0; q < 4; ++q) { const bf16x8 af = *(const LAS bf16x8*)(set + XT_OFF + (16 * q + fr) * PITCH + (32 * ks + 8 * fq) * 2);
                        y[q] = __builtin_amdgcn_mfma_f32_16x16x32_bf16(af, mb, y[q], 0, 0, 0); }
                }
            }
#pragma unroll
            for (int ks = 0; ks < 4; ++ks) {
                u32x4 cwv;
#pragma unroll
                for (int i = 0; i < 4; ++i) cwv[i] = cvt_pk_bf16(bflo(c_cv[ks][i]) * et, bfhi(c_cv[ks][i]) * et);
                const bf16x8 cb = __builtin_bit_cast(bf16x8, cwv);
#pragma unroll
                for (int q = 0; q < 4; ++q) { const bf16x8 af = *(const LAS bf16x8*)(set + HB_OFF + (16 * q + fr) * PITCH + (32 * ks + 8 * fq) * 2);
                    y[q] = __builtin_amdgcn_mfma_f32_16x16x32_bf16(af, cb, y[q], 0, 0, 0); }
            }
            bf16_t* yp = Y + (size_t)(r0 + t) * 1024 + 64 * h + 4 * fq;
#pragma unroll
            for (int q = 0; q < 4; ++q) { u32x2 w; w.x = cvt_pk_bf16(y[q][0], y[q][1]); w.y = cvt_pk_bf16(y[q][2], y[q][3]); *(u32x2*)(yp + 16 * q) = w; }
        }
        {
            const float dec = __builtin_amdgcn_exp2f(cend_cur * L2E);
#pragma unroll
            for (int q = 0; q < 4; ++q) hs[q] = hs[q] * dec;
#pragma unroll
            for (int ks = 0; ks < 4; ++ks) {
                const int s0 = 32 * ks + 8 * fq;
                const u32x4 braw = *(const LAS u32x4*)(set + BT_OFF + (16 * wid + fr) * PITCH + s0 * 2);
                const f32x4 w0 = *(const LAS f32x4*)(dtw + s0), w1 = *(const LAS f32x4*)(dtw + s0 + 4);
                u32x4 bw; bw.x = cvt_pk_bf16(bflo(braw.x) * w0[0], bfhi(braw.x) * w0[1]); bw.y = cvt_pk_bf16(bflo(braw.y) * w0[2], bfhi(braw.y) * w0[3]);
                          bw.z = cvt_pk_bf16(bflo(braw.z) * w1[0], bfhi(braw.z) * w1[1]); bw.w = cvt_pk_bf16(bflo(braw.w) * w1[2], bfhi(braw.w) * w1[3]);
                const bf16x8 bfr = __builtin_bit_cast(bf16x8, bw);
#pragma unroll
                for (int q = 0; q < 4; ++q) { const bf16x8 af = *(const LAS bf16x8*)(set + XT_OFF + (16 * q + fr) * PITCH + s0 * 2);
                    hs[q] = __builtin_amdgcn_mfma_f32_16x16x32_bf16(af, bfr, hs[q], 0, 0, 0); }
            }
            LAS bf16_t* hb = (LAS bf16_t*)(lds + ((step + 1) & 1) * SET + HB_OFF) + 16 * wid + fr;
#pragma unroll
            for (int q = 0; q < 4; ++q)
#pragma unroll
                for (int i = 0; i < 4; ++i) hb[(16 * q + 4 * fq + i) * 136] = f2bf(hs[q][i]);
        }
        if (step + 1 < 66) { if (par == 0) SSD_WRITE(step + 1, P); else SSD_WRITE(step + 1, Q); }
    }
    __syncthreads();
#undef SSD_ROWS
#undef SSD_LOAD
#undef SSD_LOADGC
#undef SSD_GCROT
#undef SSD_WRITE
}
}

struct Args { const float* in[32]; float* out; unsigned char* ws; int ph_lo, ph_hi; };
constexpr int NTHR = 512;
constexpr int LDS_BASE = 256;
constexpr int LDS_PHASE = 151808;
constexpr int LDS_BYTES = LDS_BASE + LDS_PHASE;
static_assert(att8::LDS_BYTES <= LDS_PHASE && ssd::LDS_BYTES <= LDS_PHASE && pg8::STAGE_BYTES <= LDS_PHASE, "LDS");

__device__ __forceinline__ void tjob(int j, const Args& A, const float*& src, bf16_t*& dst, int& K, int& N, int& Npad, int& mode, const float*& ks) {
    unsigned char* W = A.ws + WS_W; mode = 0; ks = nullptr;
    if (j < 8) { const int i = j >> 2, w = j & 3; unsigned char* base = W + W_HYB + (size_t)i * WH_SZ;
        if (w == 0)      { src = A.in[I_HWIN] + (size_t)i * 1024 * HYB_IN; dst = (bf16_t*)(base + WH_IN); K = 1024; N = HYB_IN; Npad = HYB_INP; mode = 1; }
        else if (w == 1) { src = A.in[I_WQB] + (size_t)i * 384 * 1536; dst = (bf16_t*)(base + WH_QB); K = 384; N = 1536; Npad = 1536; mode = 2; ks = A.in[I_QNG] + i * 384; }
        else if (w == 2) { src = A.in[I_WKVB] + (size_t)i * 256 * 2048; dst = (bf16_t*)(base + WH_KVB); K = 256; N = 2048; Npad = 2048; ks = A.in[I_KVNG] + i * 256; }
        else             { src = A.in[I_HWOUT] + (size_t)i * 2048 * 1024; dst = (bf16_t*)(base + WH_OUT); K = 2048; N = 1024; Npad = 1024; }
    } else if (j < 12) { const int i = (j - 8) >> 1, w = (j - 8) & 1; unsigned char* base = W + W_GM + (size_t)i * WG_SZ;
        if (w == 0) { src = A.in[I_GWIN] + (size_t)i * 1024 * 4096; dst = (bf16_t*)(base + WG_IN); K = 1024; N = 4096; Npad = 4096; }
        else        { src = A.in[I_GWOUT] + (size_t)i * 2048 * 1024; dst = (bf16_t*)(base + WG_OUT); K = 2048; N = 1024; Npad = 1024; }
    } else { const int l = j - 12; src = A.in[I_PWQ] + (size_t)l * 1024 * 2048; dst = (bf16_t*)(W + W_PEER + (size_t)l * WP_SZ + WP_Q); K = 1024; N = 2048; Npad = 2048; }
}
__device__ __forceinline__ int colmap(int mode, int n, int N) {
    if (mode == 1) { if (n >= N) return -1; if (n < C_KR) return n; const int m = n - C_KR; return C_KR + (m >> 1) + 32 * (m & 1); }
    if (mode == 2) { if (n < 1024) return (n >> 7) * 192 + (n & 127); const int m = n - 1024, h = m >> 6, mm = m & 63; return h * 192 + 128 + (mm >> 1) + 32 * (mm & 1); }
    return n;
}
__device__ __forceinline__ void phase_prologue(const Args& A, LAS unsigned char* lds) {
    const int tid = otid();
    {
        LAS float* tile = (LAS float*)lds;
        int item = blockIdx.x;
        for (int j = 0; j < 16; ++j) {
            const float* src; bf16_t* dst; int K, N, Npad, mode; const float* ks; tjob(j, A, src, dst, K, N, Npad, mode, ks);
            const int nsub = (K % 256 == 0) ? 4 : 2, tk = K / (64 * nsub), tn = Npad / 64, nt = tk * tn;
            for (; item < nt; item += gridDim.x) {
                const int k0 = (item % tk) * 64 * nsub, n0 = (item / tk) * 64;
                { const int k = tid >> 3, cg = tid & 7; float v[4][8];
#pragma unroll
                  for (int t = 0; t < 4; ++t) if (t < nsub) { const float sc = ks ? ks[k0 + 64 * t + k] : 1.f;
#pragma unroll
                      for (int jj = 0; jj < 8; ++jj) { const int oc = colmap(mode, n0 + 8 * cg + jj, N); v[t][jj] = oc >= 0 ? src[(size_t)(k0 + 64 * t + k) * N + oc] * sc : 0.f; } }
#pragma unroll
                  for (int t = 0; t < 4; ++t) if (t < nsub) {
#pragma unroll
                      for (int jj = 0; jj < 8; ++jj) tile[t * 4160 + k * 65 + 8 * cg + jj] = v[t][jj]; } }
                __syncthreads();
                { const int n = tid >> 3, kg = tid & 7;
#pragma unroll
                  for (int t = 0; t < 4; ++t) if (t < nsub) { float v[8];
#pragma unroll
                      for (int jj = 0; jj < 8; ++jj) v[jj] = tile[t * 4160 + (8 * kg + jj) * 65 + n];
                      u32x4 w; w.x = cvt_pk_bf16(v[0], v[1]); w.y = cvt_pk_bf16(v[2], v[3]); w.z = cvt_pk_bf16(v[4], v[5]); w.w = cvt_pk_bf16(v[6], v[7]);
                      *(u32x4*)(dst + (size_t)(n0 + n) * K + k0 + 64 * t + 8 * kg) = w; } }
                __syncthreads();
            }
            item -= nt;
        }
    }
    {
        const int gthr = blockIdx.x * NTHR + tid, nthr = gridDim.x * NTHR;
        for (int p = gthr; p < 10 * 16384; p += nthr) {
            const int mat = p >> 14, off = (p & 16383) * 8; const float* src; bf16_t* dst;
            if (mat < 2)      { src = A.in[I_GWS] + (size_t)mat * 131072; dst = (bf16_t*)(A.ws + WS_W + W_GM + (size_t)mat * WG_SZ + WG_WS); }
            else if (mat < 6) { src = A.in[I_PK1] + (size_t)(mat - 2) * 131072; dst = (bf16_t*)(A.ws + WS_W + W_PEER + (size_t)(mat - 2) * WP_SZ + WP_K1); }
            else              { src = A.in[I_PK2] + (size_t)(mat - 6) * 131072; dst = (bf16_t*)(A.ws + WS_W + W_PEER + (size_t)(mat - 6) * WP_SZ + WP_K2); }
            const f32x4 a = *(const f32x4*)(src + off), b = *(const f32x4*)(src + off + 4);
            u32x4 w; w.x = cvt_pk_bf16(a[0], a[1]); w.y = cvt_pk_bf16(a[2], a[3]); w.z = cvt_pk_bf16(b[0], b[1]); w.w = cvt_pk_bf16(b[2], b[3]);
            *(u32x4*)(dst + off) = w;
        }
        float* rope = (float*)(A.ws + WS_ROPE);
        for (int p = gthr; p < SEQ * 32; p += nthr) { const int l = p >> 5, i = p & 31; const float pos = (float)(i < 16 ? (l >> 6) : (l & 63));
            const float inv = powf(10000.f, -(float)(i & 15) / 16.f), ang = pos * inv; rope[p] = cosf(ang); rope[SEQ * 32 + p] = sinf(ang); }
    }
    {
        LAS float* scond = (LAS float*)lds;
        LAS float* red = scond + 5 * 1024;
        __syncthreads();
        for (int i = tid; i < 5 * 1024; i += NTHR) { const int m = i >> 10, k = i & 1023; const float c = m < 4 ? A.in[I_C][m * 1024 + k] : A.in[I_CCTX][k]; scond[i] = silu_f(c); }
        __syncthreads();
        float* MOD = (float*)(A.ws + WS_MOD);
        for (int item = blockIdx.x; item < 4 * 48; item += gridDim.x) {
            const int layer = item / 48, j0 = (item % 48) * 128; const int c4 = tid & 31, ksl = tid >> 5;
            f32x4 acc[5];
#pragma unroll
            for (int m = 0; m < 5; ++m) acc[m] = (f32x4){0.f, 0.f, 0.f, 0.f};
            const float* wp = A.in[I_ADAW] + ((size_t)layer * 1024 + ksl * 64) * 6144 + j0 + 4 * c4;
            for (int k = 0; k < 64; ++k) { const f32x4 w = *(const f32x4*)(wp + (size_t)k * 6144);
#pragma unroll
                for (int m = 0; m < 5; ++m) acc[m] += w * scond[m * 1024 + ksl * 64 + k]; }
#pragma unroll
            for (int m = 0; m < 5; ++m) *(LAS f32x4*)(red + (ksl * 5 + m) * 128 + 4 * c4) = acc[m];
            __syncthreads();
            for (int i = tid; i < 640; i += NTHR) { const int m = i >> 7, c = i & 127; float s = A.in[I_ADAB][layer * 6144 + j0 + c];
#pragma unroll
                for (int q = 0; q < 16; ++q) s += red[(q * 5 + m) * 128 + c];
                MOD[((size_t)layer * 5 + m) * 6144 + j0 + c] = s; }
            __syncthreads();
        }
    }
}

__device__ __forceinline__ void phase_norm_mod(const float* xl, const float* xc, float* cl, float* cc, const float* g, const float* modl, int sh_idx, bf16_t* H, int nrows) {
    const int tid_ = otid(); const int lane = tid_ & 63, gw = blockIdx.x * 8 + (tid_ >> 6), nw = gridDim.x * 8;
    f32x4 gv[4];
#pragma unroll
    for (int i = 0; i < 4; ++i) gv[i] = *(const f32x4*)(g + 256 * i + 4 * lane);
    for (int r = gw; r < nrows; r += nw) {
        const bool lat = r < NLAT; const float* xp = lat ? xl + (size_t)r * D : xc + (size_t)(r - NLAT) * D;
        f32x4 x[4]; float ss = 0.f;
#pragma unroll
        for (int i = 0; i < 4; ++i) { x[i] = *(const f32x4*)(xp + 256 * i + 4 * lane); ss += x[i][0] * x[i][0] + x[i][1] * x[i][1] + x[i][2] * x[i][2] + x[i][3] * x[i][3]; }
        if (cl) { float* cp = lat ? cl + (size_t)r * D : cc + (size_t)(r - NLAT) * D;
#pragma unroll
            for (int i = 0; i < 4; ++i) *(f32x4*)(cp + 256 * i + 4 * lane) = x[i]; }
        ss = wave_sum(ss); const float rstd = rsqrtf(ss * (1.f / 1024.f) + EPS);
        const float* mp = modl + (size_t)(lat ? (r >> 13) : 4) * 6144 + sh_idx * 1024;
#pragma unroll
        for (int i = 0; i < 4; ++i) { const f32x4 sh = *(const f32x4*)(mp + 256 * i + 4 * lane), sc = *(const f32x4*)(mp + 1024 + 256 * i + 4 * lane);
            const f32x4 hv = (x[i] * rstd) * gv[i] * (sc + 1.f) + sh;
            u32x2 w; w.x = cvt_pk_bf16(hv[0], hv[1]); w.y = cvt_pk_bf16(hv[2], hv[3]);
            *(u32x2*)(H + (size_t)r * D + 256 * i + 4 * lane) = w; }
    }
}
__device__ __forceinline__ void phase_final_norm(float* xl, const float* g, float oscale) {
    const int tid_ = otid(); const int lane = tid_ & 63, gw = blockIdx.x * 8 + (tid_ >> 6), nw = gridDim.x * 8;
    f32x4 gv[4];
#pragma unroll
    for (int i = 0; i < 4; ++i) gv[i] = *(const f32x4*)(g + 256 * i + 4 * lane);
    for (int r = gw; r < NLAT; r += nw) {
        float* xp = xl + (size_t)r * D; f32x4 x[4]; float ss = 0.f;
#pragma unroll
        for (int i = 0; i < 4; ++i) { x[i] = *(const f32x4*)(xp + 256 * i + 4 * lane); ss += x[i][0] * x[i][0] + x[i][1] * x[i][1] + x[i][2] * x[i][2] + x[i][3] * x[i][3]; }
        ss = wave_sum(ss); const float rstd = rsqrtf(ss * (1.f / 1024.f) + EPS);
#pragma unroll
        for (int i = 0; i < 4; ++i) *(f32x4*)(xp + 256 * i + 4 * lane) = (x[i] * (rstd * oscale)) * gv[i];
    }
}

__device__ __forceinline__ void phase_conv(const Args& A, int li) {
    const bf16_t* PROJ = (const bf16_t*)(A.ws + WS_BIG);
    bf16_t* XS = (bf16_t*)(A.ws + WS_R2); bf16_t* BC = (bf16_t*)(A.ws + WS_R2 + R2_BC);
    const int tid = otid();
    {
        for (int item = blockIdx.x * 3; item < (NROW / 64) * 3; item += gridDim.x * 3)
#pragma unroll 1
        for (int sub = 0; sub < 3; ++sub) {
            const int blk = (item + sub) / 3, q = ((item + sub) % 3) * 512 + tid, cg = q % 192, rg = q / 192, c0 = 8 * cg;
            const int rbeg = blk * 64 + rg * 8; int s0, s1;
            if (rbeg < NLAT) { s0 = rbeg & ~8191; s1 = s0 + 8192; } else { s0 = NLAT + ((rbeg - NLAT) & ~255); s1 = s0 + 256; }
            const float* cw = A.in[I_CONVW] + ((size_t)li * 1536 + c0) * 5; const float* cb = A.in[I_CONVB] + (size_t)li * 1536 + c0;
            u32x4 in[12];
#pragma unroll
            for (int i = 0; i < 12; ++i) { const int r = rbeg - 2 + i; in[i] = (r >= s0 && r < s1) ? *(const u32x4*)(PROJ + (size_t)r * HYB_INP + C_XBC + c0) : (u32x4){0u, 0u, 0u, 0u}; }
            float w[8][5], bia[8];
#pragma unroll
            for (int j = 0; j < 8; ++j) { bia[j] = cb[j];
#pragma unroll
                for (int k = 0; k < 5; ++k) w[j][k] = cw[j * 5 + k]; }
#pragma unroll
            for (int rr = 0; rr < 8; ++rr) {
                float o[8];
#pragma unroll
                for (int j = 0; j < 8; ++j) { float sacc = bia[j];
#pragma unroll
                    for (int k = 0; k < 5; ++k) { const unsigned wd = in[rr + k][j >> 1]; sacc += w[j][k] * ((j & 1) ? bfhi(wd) : bflo(wd)); }
                    o[j] = silu_f(sacc); }
                u32x4 pk; pk.x = cvt_pk_bf16(o[0], o[1]); pk.y = cvt_pk_bf16(o[2], o[3]); pk.z = cvt_pk_bf16(o[4], o[5]); pk.w = cvt_pk_bf16(o[6], o[7]);
                const int r = rbeg + rr;
                if (c0 < 1024) *(u32x4*)(XS + (size_t)r * 1024 + c0) = pk; else *(u32x4*)(BC + (size_t)r * 512 + (c0 - 1024)) = pk;
            }
        }
    }
    {
        const int lane = tid & 63, gw = blockIdx.x * 8 + (tid >> 6), nw = gridDim.x * 8;
        float* DT = (float*)(A.ws + WS_BIG + BIG_DT); float* RQ = (float*)(A.ws + WS_RSTD); float* RKV = RQ + NROW;
        unsigned char* KR = A.ws + WS_BIG + BIG_KR; const float* rope = (const float*)(A.ws + WS_ROPE);
        const float dtb = lane < 32 ? A.in[I_DTB][li * 32 + lane] : 0.f;
        for (int rb = gw * 4; rb < NROW; rb += nw * 4) {
            unsigned wq[4][3]; u32x2 wk[4]; unsigned wr_[4]; float dtv[4], rc[4], rsn[4];
#pragma unroll
            for (int i = 0; i < 4; ++i) { const int r = rb + i; const bf16_t* p = PROJ + (size_t)r * HYB_INP;
                const unsigned* q = (const unsigned*)(p + C_CQ + 6 * lane); wq[i][0] = q[0]; wq[i][1] = q[1]; wq[i][2] = q[2];
                wk[i] = *(const u32x2*)(p + C_CKV + 4 * lane);
                dtv[i] = lane < 32 ? bf2f(p[C_DT + (lane & 15)]) : 0.f; wr_[i] = lane < 32 ? *(const unsigned*)(p + C_KR + 2 * lane) : 0u;
                const int l = r & 8191; rc[i] = (lane < 32 && r < NLAT) ? rope[l * 32 + lane] : 1.f; rsn[i] = (lane < 32 && r < NLAT) ? rope[SEQ * 32 + l * 32 + lane] : 0.f; }
#pragma unroll
            for (int i = 0; i < 4; ++i) { const int r = rb + i;
                if (lane < 32) DT[(size_t)lane * NROW + r] = softplus_f(dtv[i] + dtb);
                { float ss = 0.f;
#pragma unroll
                  for (int j = 0; j < 3; ++j) { const float a = bflo(wq[i][j]), b = bfhi(wq[i][j]); ss += a * a + b * b; }
                  ss = wave_sum(ss); if (lane == 0) RQ[r] = rsqrtf(ss * (1.f / 384.f) + EPS); }
                { const float a = bflo(wk[i].x), b = bfhi(wk[i].x), c = bflo(wk[i].y), d = bfhi(wk[i].y);
                  float ss = a * a + b * b + c * c + d * d; ss = wave_sum(ss); if (lane == 0) RKV[r] = rsqrtf(ss * (1.f / 256.f) + EPS); }
                if (lane < 32) { const float x1 = bflo(wr_[i]), x2 = bfhi(wr_[i]); int b, key;
                    const float o1 = x1 * rc[i] - x2 * rsn[i], o2 = x1 * rsn[i] + x2 * rc[i];
                    if (r < NLAT) { b = r >> 13; key = 256 + (r & 8191); } else { b = (r - NLAT) >> 8; key = (r - NLAT) & 255; }
                    int w8 = 0; w8 = __builtin_amdgcn_cvt_pk_fp8_f32(sat8(o1), sat8(o2), w8, false);
                    *(unsigned short*)(KR + (size_t)(b * NKT + (key >> 6)) * 4096 + att8::kr8(key & 63, 2 * lane)) = (unsigned short)(w8 & 0xffff); }
            }
        }
    }
}

struct EpiQ {
    static constexpr bool PERM = true;
    unsigned char* Q; const float* rstd; const float* rope;
    __device__ __forceinline__ void operator()(const f32x4 (&acc)[2][2][4][2], const pg8::Unit& u, int wr, int wc, int fr, int fq) const {
        const bool lat = u.pm < 128;
        const int b = lat ? (u.pm >> 5) : (u.pm - 128), q0 = lat ? 256 + ((u.pm & 31) << 8) : 0;
        const bool isrope = u.pn >= 4;
#pragma unroll
        for (int ai = 0; ai < 2; ++ai) {
            const int rl = 128 * ai + 64 * wr + fr;
            const float* rsp = rstd + u.pm * 256 + rl;
            const float* rp = rope + (size_t)(((u.pm & 31) << 8) + rl) * 32;
#pragma unroll
            for (int bj = 0; bj < 2; ++bj) {
                const int c0 = u.pn * 256 + 128 * bj + 32 * wc + 8 * fq; int h, dcol;
                if (!isrope) { h = c0 >> 7; dcol = c0 & 127; } else { const int mq = c0 - 1024; h = mq >> 6; dcol = 128 + (mq & 63); }
                unsigned char* dst = Q + ((size_t)(b * 8 + h) * NKEY + q0 + rl) * 192 + dcol;
                const int ro = (dcol - 128) >> 1;
#pragma unroll
                for (int m = 0; m < 4; ++m) {
                    const float rs = rsp[16 * m] * (QSCALE * att8::QUP);
                    f32x4 v0 = acc[ai][bj][m][0] * rs, v1 = acc[ai][bj][m][1] * rs;
                    if (isrope && lat) { const f32x4 cs = *(const f32x4*)(rp + 16 * m * 32 + ro), sn = *(const f32x4*)(rp + SEQ * 32 + 16 * m * 32 + ro);
                        const f32x4 a0 = v0, a1 = v1;
                        v0[0] = a0[0] * cs[0] - a0[1] * sn[0]; v0[1] = a0[0] * sn[0] + a0[1] * cs[0]; v0[2] = a0[2] * cs[1] - a0[3] * sn[1]; v0[3] = a0[2] * sn[1] + a0[3] * cs[1];
                        v1[0] = a1[0] * cs[2] - a1[1] * sn[2]; v1[1] = a1[0] * sn[2] + a1[1] * cs[2]; v1[2] = a1[2] * cs[3] - a1[3] * sn[3]; v1[3] = a1[2] * sn[3] + a1[3] * cs[3]; }
                    u32x2 w; w.x = pk4_fp8_sat(v0[0], v0[1], v0[2], v0[3]); w.y = pk4_fp8_sat(v1[0], v1[1], v1[2], v1[3]);
                    *(u32x2*)(dst + 16 * m * 192) = w;
                    asm volatile("" ::: "memory");
                }
            }
        }
    }
};
struct EpiKV {
    static constexpr bool PERM = true;
    unsigned char* KN; unsigned char* V; const float* rstd;
    __device__ __forceinline__ void operator()(const f32x4 (&acc)[2][2][4][2], const pg8::Unit& u, int wr, int wc, int fr, int fq) const {
        const bool lat = u.pm < 128;
        const int b = lat ? (u.pm >> 5) : (u.pm - 128), t0 = lat ? 4 + ((u.pm & 31) << 2) : 0;
        const int dd = 32 * wc + 8 * fq;
        const int offK = fr * 128 + ((((dd >> 4) ^ ((fr >> 1) & 7))) << 4) + (dd & 15);
#pragma unroll
        for (int ai = 0; ai < 2; ++ai) {
            const size_t tb = ((size_t)(b * 8 + u.pn) * NKT + t0 + 2 * ai + wr) * 8192;
            const float* rsp = rstd + u.pm * 256 + 128 * ai + 64 * wr + fr;
            unsigned char* kp = KN + tb + offK; unsigned char* vp = V + tb;
#pragma unroll
            for (int m = 0; m < 4; ++m) {
                const float rs = rsp[16 * m];
                { const f32x4 v0 = acc[ai][0][m][0] * rs, v1 = acc[ai][0][m][1] * rs; u32x2 w; w.x = pk4_fp8_sat(v0[0], v0[1], v0[2], v0[3]); w.y = pk4_fp8_sat(v1[0], v1[1], v1[2], v1[3]);
                  *(u32x2*)(kp + m * 2048) = w; }
                { const f32x4 v0 = acc[ai][1][m][0] * rs, v1 = acc[ai][1][m][1] * rs; const unsigned w0 = pk4_fp8_sat(v0[0], v0[1], v0[2], v0[3]), w1 = pk4_fp8_sat(v1[0], v1[1], v1[2], v1[3]);
                  const int sl = att8::vslot(16 * m + fr);
#pragma unroll
                  for (int i = 0; i < 8; ++i) { const int d = dd + i; vp[d * 64 + ((((sl >> 4) ^ ((d >> 2) & 3))) << 4) + (sl & 15)] = (unsigned char)(((i < 4 ? w0 : w1) >> (8 * (i & 3))) & 0xffu); } }
                asm volatile("" ::: "memory");
            }
        }
    }
};

__device__ __forceinline__ void phase_ssd_out(const Args& A, int li, int nrows) {
    const bf16_t* PROJ = (const bf16_t*)(A.ws + WS_BIG); const bf16_t* XS = (const bf16_t*)(A.ws + WS_R2);
    const bf16_t* Y0 = (const bf16_t*)(A.ws + WS_H); const bf16_t* Y1 = (const bf16_t*)(A.ws + WS_R3); bf16_t* CAT = (bf16_t*)(A.ws + WS_R3 + R3_CAT);
    const int tid_ = otid(); const int lane = tid_ & 63, gw = blockIdx.x * 8 + (tid_ >> 6), nw = gridDim.x * 8;
    const float dsk = A.in[I_SSDD][li * 16 + (lane >> 2)];
    float ng[16];
#pragma unroll
    for (int j = 0; j < 16; ++j) ng[j] = A.in[I_SSDNG][li * 1024 + 16 * lane + j];
    for (int r = gw; r < nrows; r += nw) {
        float v[16]; float ss = 0.f;
#pragma unroll
        for (int hh = 0; hh < 2; ++hh) {
            const u32x4 a = *(const u32x4*)(Y0 + (size_t)r * 1024 + 16 * lane + 8 * hh), b = *(const u32x4*)(Y1 + (size_t)r * 1024 + 16 * lane + 8 * hh);
            const u32x4 x = *(const u32x4*)(XS + (size_t)r * 1024 + 16 * lane + 8 * hh), z = *(const u32x4*)(PROJ + (size_t)r * HYB_INP + 16 * lane + 8 * hh);
#pragma unroll
            for (int q = 0; q < 4; ++q) {
                const float y0 = (bflo(a[q]) + bflo(b[q]) + dsk * bflo(x[q])) * silu_f(bflo(z[q])), y1 = (bfhi(a[q]) + bfhi(b[q]) + dsk * bfhi(x[q])) * silu_f(bfhi(z[q]));
                v[8 * hh + 2 * q] = y0; v[8 * hh + 2 * q + 1] = y1; ss += y0 * y0 + y1 * y1; }
        }
#pragma unroll
        for (int o = 16; o >= 1; o >>= 1) ss += __shfl_xor(ss, o);
        const float rstd = rsqrtf(ss * (1.f / 512.f) + EPS);
#pragma unroll
        for (int hh = 0; hh < 2; ++hh) { u32x4 w;
#pragma unroll
            for (int q = 0; q < 4; ++q) w[q] = cvt_pk_bf16(v[8 * hh + 2 * q] * rstd * ng[8 * hh + 2 * q], v[8 * hh + 2 * q + 1] * rstd * ng[8 * hh + 2 * q + 1]);
            *(u32x4*)(CAT + (size_t)r * 2048 + 16 * lane + 8 * hh) = w; }
    }
}

__device__ __forceinline__ void phase_ln_stats(const Args& A, int nrows) {
    const bf16_t* Gb = (const bf16_t*)(A.ws + WS_BIG); float* ST = (float*)(A.ws + WS_RSTD);
    const int tid_ = otid(); const int lane = tid_ & 63, gw = blockIdx.x * 8 + (tid_ >> 6), nw = gridDim.x * 8;
    for (int r = gw; r < nrows; r += nw) {
        float v[32]; float s = 0.f;
#pragma unroll
        for (int j = 0; j < 4; ++j) { const u32x4 w = *(const u32x4*)(Gb + (size_t)r * 4096 + 2048 + 512 * j + 8 * lane);
#pragma unroll
            for (int q = 0; q < 4; ++q) { v[8 * j + 2 * q] = bflo(w[q]); v[8 * j + 2 * q + 1] = bfhi(w[q]); s += v[8 * j + 2 * q] + v[8 * j + 2 * q + 1]; } }
        s = wave_sum(s); const float mu = s * (1.f / 2048.f); float q2 = 0.f;
#pragma unroll
        for (int j = 0; j < 32; ++j) { const float dd = v[j] - mu; q2 += dd * dd; }
        q2 = wave_sum(q2);
        if (lane == 0) { ST[r] = mu; ST[NROW + r] = rsqrtf(q2 * (1.f / 2048.f) + EPS); }
    }
}
__device__ __forceinline__ void phase_spatial(const Args& A, int gi, int nrows, LAS unsigned char* lds) {
    const bf16_t* Gb = (const bf16_t*)(A.ws + WS_BIG); const float* ST = (const float*)(A.ws + WS_RSTD); bf16_t* Ab = (bf16_t*)(A.ws + WS_R1);
    const bf16_t* WSg = (const bf16_t*)(A.ws + WS_W + W_GM + (size_t)gi * WG_SZ + WG_WS);
    const float* lng = A.in[I_GLNG] + (size_t)gi * 2048; const float* lnb = A.in[I_GLNB] + (size_t)gi * 2048; const float* bs = A.in[I_GBS] + (size_t)gi * 1024;
    const int tid = otid(), wid = tid >> 6, lane = tid & 63, r32 = lane & 31, hi = lane >> 5, tb = wid & 3, dh = wid >> 2;
    const int ldsaddr = (int)(unsigned)(uintptr_t)lds;
    u32x4 nv[8]; float nmu[8], nrs[8];
    const int nunits = (nrows / 128) * 8;
#define SP_LOADV(un) do { const int cb_ = (un) >> 3, gg_ = (un) & 7, r0_ = cb_ * 128; \
        _Pragma("unroll") for (int j = 0; j < 8; ++j) { const int idx = tid + 512 * j, s_ = idx >> 5, dd_ = (idx & 31) * 8; \
            nv[j] = *(const u32x4*)(Gb + (size_t)(r0_ + s_) * 4096 + 2048 + 256 * gg_ + dd_); nmu[j] = ST[r0_ + s_]; nrs[j] = ST[NROW + r0_ + s_]; } } while (0)
    if ((int)blockIdx.x < nunits) SP_LOADV((int)blockIdx.x);
    for (int unit = blockIdx.x; unit < nunits; unit += gridDim.x) {
        const int cb = unit >> 3, gg = unit & 7, r0 = cb * 128;
        __syncthreads();
#pragma unroll
        for (int j = 0; j < 8; ++j) { const int idx = tid + 512 * j, s = idx >> 5, dd = (idx & 31) * 8;
            const u32x4 w = nv[j];
            const float mu = nmu[j], rs = nrs[j];
            const f32x4 g0 = *(const f32x4*)(lng + 256 * gg + dd), g1 = *(const f32x4*)(lng + 256 * gg + dd + 4), b0 = *(const f32x4*)(lnb + 256 * gg + dd), b1 = *(const f32x4*)(lnb + 256 * gg + dd + 4);
            u32x4 o;
            o.x = cvt_pk_bf16((bflo(w.x) - mu) * rs * g0[0] + b0[0], (bfhi(w.x) - mu) * rs * g0[1] + b0[1]); o.y = cvt_pk_bf16((bflo(w.y) - mu) * rs * g0[2] + b0[2], (bfhi(w.y) - mu) * rs * g0[3] + b0[3]);
            o.z = cvt_pk_bf16((bflo(w.z) - mu) * rs * g1[0] + b1[0], (bfhi(w.z) - mu) * rs * g1[1] + b1[1]); o.w = cvt_pk_bf16((bflo(w.w) - mu) * rs * g1[2] + b1[2], (bfhi(w.w) - mu) * rs * g1[3] + b1[3]);
            *(LAS u32x4*)(lds + ((s >> 6) * 2 + (dd >> 7)) * 16384 + att::v_st(s & 63, dd & 127)) = o; }
        u32x2 uu[4][4];
        { const bf16_t* up = Gb + (size_t)(r0 + 32 * tb + r32) * 4096 + 256 * gg + 128 * dh + 4 * hi;
#pragma unroll
          for (int d0 = 0; d0 < 4; ++d0)
#pragma unroll
              for (int k = 0; k < 4; ++k) uu[d0][k] = *(const u32x2*)(up + 32 * d0 + 8 * k); }
        if (unit + (int)gridDim.x < nunits) SP_LOADV(unit + (int)gridDim.x);
        bf16x8 pa[8];
#pragma unroll
        for (int ks = 0; ks < 8; ++ks) pa[ks] = *(const bf16x8*)(WSg + ((size_t)gg * 128 + 32 * tb + r32) * 128 + 16 * ks + 8 * hi);
        __syncthreads();
        f32x16 o[4] = {};
#define SP_PV(D0, vbase, p0, p1, p2, p3) do { \
            const s16x4 l0 = att::tr_read<att::v_rd_off(D0, 0, 0)>(vbase), h0 = att::tr_read<att::v_rd_off(D0, 0, 1)>(vbase), l1 = att::tr_read<att::v_rd_off(D0, 1, 0)>(vbase), h1 = att::tr_read<att::v_rd_off(D0, 1, 1)>(vbase); \
            const s16x4 l2 = att::tr_read<att::v_rd_off(D0, 2, 0)>(vbase), h2 = att::tr_read<att::v_rd_off(D0, 2, 1)>(vbase), l3 = att::tr_read<att::v_rd_off(D0, 3, 0)>(vbase), h3 = att::tr_read<att::v_rd_off(D0, 3, 1)>(vbase); \
            asm volatile("s_waitcnt lgkmcnt(0)" ::: "memory"); __builtin_amdgcn_sched_barrier(0); \
            o[D0] = __builtin_amdgcn_mfma_f32_32x32x16_bf16((bf16x8){l0[0], l0[1], l0[2], l0[3], h0[0], h0[1], h0[2], h0[3]}, p0, o[D0], 0, 0, 0); \
            o[D0] = __builtin_amdgcn_mfma_f32_32x32x16_bf16((bf16x8){l1[0], l1[1], l1[2], l1[3], h1[0], h1[1], h1[2], h1[3]}, p1, o[D0], 0, 0, 0); \
            o[D0] = __builtin_amdgcn_mfma_f32_32x32x16_bf16((bf16x8){l2[0], l2[1], l2[2], l2[3], h2[0], h2[1], h2[2], h2[3]}, p2, o[D0], 0, 0, 0); \
            o[D0] = __builtin_amdgcn_mfma_f32_32x32x16_bf16((bf16x8){l3[0], l3[1], l3[2], l3[3], h3[0], h3[1], h3[2], h3[3]}, p3, o[D0], 0, 0, 0); } while (0)
        { const int vb0 = ldsaddr + (0 * 2 + dh) * 16384 + att::v_rd_base(lane), vb1 = ldsaddr + (1 * 2 + dh) * 16384 + att::v_rd_base(lane);
          SP_PV(0, vb0, pa[0], pa[1], pa[2], pa[3]); SP_PV(1, vb0, pa[0], pa[1], pa[2], pa[3]); SP_PV(2, vb0, pa[0], pa[1], pa[2], pa[3]); SP_PV(3, vb0, pa[0], pa[1], pa[2], pa[3]);
          SP_PV(0, vb1, pa[4], pa[5], pa[6], pa[7]); SP_PV(1, vb1, pa[4], pa[5], pa[6], pa[7]); SP_PV(2, vb1, pa[4], pa[5], pa[6], pa[7]); SP_PV(3, vb1, pa[4], pa[5], pa[6], pa[7]); }
#undef SP_PV
        { const int t = 32 * tb + r32, row = r0 + t; const float bsv = bs[gg * 128 + t];
          bf16_t* ap = Ab + (size_t)row * 2048 + 256 * gg + 128 * dh + 4 * hi;
#pragma unroll
          for (int d0 = 0; d0 < 4; ++d0)
#pragma unroll
              for (int k = 0; k < 4; ++k) {
                  const u32x2 u2 = uu[d0][k];
                  u32x2 w; w.x = cvt_pk_bf16(bflo(u2.x) * (o[d0][4 * k] + bsv), bfhi(u2.x) * (o[d0][4 * k + 1] + bsv)); w.y = cvt_pk_bf16(bflo(u2.y) * (o[d0][4 * k + 2] + bsv), bfhi(u2.y) * (o[d0][4 * k + 3] + bsv));
                  *(u32x2*)(ap + 32 * d0 + 8 * k) = w; } }
    }
#undef SP_LOADV
}

constexpr int NSL = 8, SW = 1024 / NSL;
constexpr size_t TAB8_HALF = (size_t)NEXP * 1024, TAB_SCL = 2 * TAB8_HALF;
constexpr float HS = 4.f;
__device__ __forceinline__ void phase_tabcvt(const Args& A, int layer, int wg, int nwg) {
    const int tid_ = otid(); const int lane = tid_ & 63, gw = wg * 8 + (tid_ >> 6), nw = nwg * 8;
    float* SCL = (float*)(A.ws + WS_TAB + TAB_SCL);
    for (int r = gw; r < 2 * NEXP; r += nw) {
        const int tab = r >> 14, e = r & (NEXP - 1);
        const float* src = (tab ? A.in[I_PV] : A.in[I_PU]) + ((size_t)layer * NEXP + e) * 1024 + 16 * lane;
        f32x4 v[4]; float am = 0.f;
#pragma unroll
        for (int i = 0; i < 4; ++i) { v[i] = *(const f32x4*)(src + 4 * i); am = fmaxf(am, fmaxf(fmaxf(fabsf(v[i][0]), fabsf(v[i][1])), fmaxf(fabsf(v[i][2]), fabsf(v[i][3])))); }
#pragma unroll
        for (int o = 32; o >= 1; o >>= 1) am = fmaxf(am, __shfl_xor(am, o));
        float sc = 1.f; if (am > 0.f) { int ex; (void)frexpf(448.f / am, &ex); sc = ldexpf(1.f, ex - 1); }
        if (lane == 0) SCL[tab * NEXP + e] = 1.f / sc;
        u32x4 w;
#pragma unroll
        for (int i = 0; i < 4; ++i) w[i] = pk4_fp8(v[i][0] * sc, v[i][1] * sc, v[i][2] * sc, v[i][3] * sc);
        *(u32x4*)(A.ws + WS_TAB + (size_t)tab * TAB8_HALF + ((size_t)(lane >> 3) * NEXP + e) * SW + 16 * (lane & 7)) = w;
    }
}
#define CASD(a, b) do { const float hi_ = fmaxf(a, b), lo_ = fminf(a, b); a = hi_; b = lo_; } while (0)
__device__ __forceinline__ void sort16(float (&k)[16]) {
#pragma unroll
    for (int sz = 2; sz <= 16; sz <<= 1)
#pragma unroll
        for (int j = sz >> 1; j > 0; j >>= 1)
#pragma unroll
            for (int i = 0; i < 16; ++i) { const int l = i ^ j; if (l > i) { if ((i & sz) == 0 || sz == 16) CASD(k[i], k[l]); else CASD(k[l], k[i]); } }
}
__device__ __forceinline__ void bmerge16(float (&k)[16]) {
#pragma unroll
    for (int j = 8; j > 0; j >>= 1)
#pragma unroll
        for (int i = 0; i < 16; ++i) { const int l = i ^ j; if (l > i) CASD(k[i], k[l]); }
}
__device__ __forceinline__ void merge_top16(float (&a)[16], const float (&b)[16]) {
#pragma unroll
    for (int i = 0; i < 16; ++i) a[i] = fmaxf(a[i], b[15 - i]);
    bmerge16(a);
}
__device__ __forceinline__ void xmerge_top16(float (&a)[16], int mask) {
    float t[16];
#pragma unroll
    for (int i = 0; i < 16; ++i) t[i] = __shfl_xor(a[15 - i], mask);
#pragma unroll
    for (int i = 0; i < 16; ++i) a[i] = fmaxf(a[i], t[i]);
    bmerge16(a);
}
__device__ __forceinline__ void phase_topk(const Args& A, int layer, int nrows, LAS unsigned char* lds) {
    const bf16_t* QP = (const bf16_t*)(A.ws + WS_BIG); int* IDX = (int*)(A.ws + WS_R2); float* GATE = (float*)(A.ws + WS_R2 + R2_GATE);
    const int tid = otid(), wid = tid >> 6, lane = tid & 63, fr = lane & 15, fq = lane >> 4;
    LAS unsigned* scr = (LAS unsigned*)(lds + 2 * 34816) + wid * 512 + fr * 32;
    int h_staged = -1;
    for (int unit = blockIdx.x; unit < (nrows / 128) * 8; unit += gridDim.x) {
        const int h = unit & 7, r0 = (unit >> 3) * 128;
        if (h != h_staged) { h_staged = h;
        __syncthreads();
        { const bf16_t* k1 = (const bf16_t*)(A.ws + WS_W + W_PEER + (size_t)layer * WP_SZ + WP_K1) + (size_t)h * 16384;
#pragma unroll
          for (int j = 0; j < 8; ++j) { const int idx = tid + 512 * j, half = idx >> 11, rem = idx & 2047, key = rem >> 4, c8 = rem & 15;
              const u32x4 w = *(const u32x4*)(k1 + (size_t)half * 8 * 16384 + key * 128 + 8 * c8);
              *(LAS u32x4*)(lds + half * 34816 + key * 272 + c8 * 16) = w; } }
        __syncthreads(); }
        const int tok = r0 + 16 * wid + fr;
        float top[2][16];
#pragma unroll
        for (int half = 0; half < 2; ++half) {
            bf16x8 qf[4];
#pragma unroll
            for (int ks = 0; ks < 4; ++ks) qf[ks] = *(const bf16x8*)(QP + (size_t)tok * 2048 + 256 * h + 128 * half + 32 * ks + 8 * fq);
            float loc[16];
#pragma unroll
            for (int grp = 0; grp < 2; ++grp) {
                float kk[16];
#pragma unroll
                for (int nbb = 0; nbb < 4; ++nbb) { const int nb = 4 * grp + nbb; f32x4 acc = {0.f, 0.f, 0.f, 0.f};
#pragma unroll
                    for (int ks = 0; ks < 4; ++ks) { const bf16x8 kf = *(const LAS bf16x8*)(lds + half * 34816 + (16 * nb + fr) * 272 + (32 * ks + 8 * fq) * 2);
                        acc = __builtin_amdgcn_mfma_f32_16x16x32_bf16(kf, qf[ks], acc, 0, 0, 0); }
#pragma unroll
                    for (int i = 0; i < 4; ++i) { const unsigned code = 127u - (unsigned)(16 * nb + 4 * fq + i); kk[4 * nbb + i] = __uint_as_float((__float_as_uint(acc[i]) & ~127u) | code); } }
                sort16(kk);
                if (grp == 0) {
#pragma unroll
                    for (int i = 0; i < 16; ++i) loc[i] = kk[i];
                } else merge_top16(loc, kk);
            }
            xmerge_top16(loc, 16); xmerge_top16(loc, 32);
#pragma unroll
            for (int i = 0; i < 16; ++i) top[half][i] = loc[i];
        }
        if (fq < 2) {
#pragma unroll
            for (int i = 0; i < 16; ++i) scr[16 * fq + i] = __float_as_uint(fq == 0 ? top[0][i] : top[1][i]); }
        float fin[16];
#pragma unroll
        for (int aa = 0; aa < 4; ++aa) {
            const float va_k = fq == 0 ? top[0][aa] : fq == 1 ? top[0][4 + aa] : fq == 2 ? top[0][8 + aa] : top[0][12 + aa];
            const float va = __uint_as_float(__float_as_uint(va_k) & ~127u);
            float c[16];
#pragma unroll
            for (int bb = 0; bb < 16; ++bb) { const float s = va + __uint_as_float(__float_as_uint(top[1][bb]) & ~127u);
                c[bb] = __uint_as_float((__float_as_uint(s) & ~255u) | (255u - (unsigned)((4 * fq + aa) * 16 + bb))); }
            if (aa == 0) {
#pragma unroll
                for (int i = 0; i < 16; ++i) fin[i] = c[i];
            } else merge_top16(fin, c);
        }
        xmerge_top16(fin, 16); xmerge_top16(fin, 32);
        float ev[16], es = 0.f; const float mx = __uint_as_float(__float_as_uint(fin[0]) & ~255u);
#pragma unroll
        for (int i = 0; i < 16; ++i) { ev[i] = __expf(__uint_as_float(__float_as_uint(fin[i]) & ~255u) - mx); es += ev[i]; }
        const float inv = 1.f / es;
        asm volatile("s_waitcnt lgkmcnt(0)" ::: "memory");
        int oi[4]; float og[4];
#pragma unroll
        for (int kq = 0; kq < 4; ++kq) {
            const float fk = fq == 0 ? fin[kq] : fq == 1 ? fin[4 + kq] : fq == 2 ? fin[8 + kq] : fin[12 + kq];
            const float fe = fq == 0 ? ev[kq] : fq == 1 ? ev[4 + kq] : fq == 2 ? ev[8 + kq] : ev[12 + kq];
            const unsigned code = 255u - (__float_as_uint(fk) & 255u), a = code >> 4, bq = code & 15u;
            const unsigned i1 = 127u - (scr[a] & 127u), i2 = 127u - (scr[16 + bq] & 127u);
            oi[kq] = (int)(i1 * 128u + i2); og[kq] = fe * inv; }
        *(int4*)(IDX + (size_t)tok * 128 + 16 * h + 4 * fq) = make_int4(oi[0], oi[1], oi[2], oi[3]);
        *(f32x4*)(GATE + (size_t)tok * 128 + 16 * h + 4 * fq) = (f32x4){og[0], og[1], og[2], og[3]};
    }
}
struct PeerSched {
    int x0, rank, nloc, nblk, nown; unsigned orphan;
    __device__ __forceinline__ void init(const Args& A, int nrows, LAS unsigned char* smem) {
        unsigned* ctl = (unsigned*)(A.ws + WS_CTL);
        x0 = (int)(xb_xcc_id() & 7u); rank = __builtin_amdgcn_readfirstlane((int)((LAS unsigned*)smem)[8]); nblk = nrows / 64;
        unsigned cached = __builtin_amdgcn_readfirstlane(((LAS unsigned*)smem)[9]);
        if (cached == 0u) { unsigned orph = 0u, nl = 1u;
            for (int j = 0; j < 8; ++j) { unsigned c = xb_ld(&ctl[XB_XCNT(j)]) + xb_ld(&ctl[XB_XCNT(j + 8)]); c = __builtin_amdgcn_readfirstlane(c); if (c == 0u) orph |= 1u << j; if (j == x0) nl = c; }
            cached = (nl << 8) | orph; __syncthreads(); if (threadIdx.x == 0) ((LAS unsigned*)smem)[9] = cached; __syncthreads(); }
        nloc = (int)(cached >> 8); orphan = cached & 0xffu;
        const int tot = (NSL / 8) * nblk; nown = rank < tot ? (tot - rank + nloc - 1) / nloc : 0;
    }
    __device__ __forceinline__ bool item(int j, int& sl, int& blk) const {
        if (j < nown) { const int i = rank + j * nloc; sl = x0 + 8 * (i / nblk); blk = i % nblk; return true; }
        int jj = j - nown; const int tot = (NSL / 8) * nblk, per = ((int)gridDim.x > tot) ? 1 : 0; (void)per;
        for (int o = 0; o < 8; ++o) if ((orphan >> o) & 1u) { const int cnt = ((int)blockIdx.x < tot) ? (tot - (int)blockIdx.x + (int)gridDim.x - 1) / (int)gridDim.x : 0;
            if (jj < cnt) { const int i = (int)blockIdx.x + jj * (int)gridDim.x; sl = o + 8 * (i / nblk); blk = i % nblk; return true; } jj -= cnt; }
        return false;
    }
};
template <class LD, class PR>
__device__ __forceinline__ void peer_items(const PeerSched& S, LD ld, PR pr) {
    int sl, blk, sln, blkn, j = 0, buf = 0; bool have = S.item(0, sl, blk);
    __syncthreads();
    if (have) ld(sl, blk, 0);
    while (have) {
        const bool haven = S.item(j + 1, sln, blkn);
        asm volatile("s_waitcnt vmcnt(0)" ::: "memory");
        if (haven) ld(sln, blkn, buf ^ 1);
        pr(sl, blk, buf);
        sl = sln; blk = blkn; have = haven; buf ^= 1; ++j;
    }
    __syncthreads();
}
#ifndef MK_UVAR
#define MK_UVAR 0
#endif
__device__ __forceinline__ float dpp_sum8(float v) {
    v += __builtin_bit_cast(float, __builtin_amdgcn_mov_dpp(__builtin_bit_cast(int, v), 0xB1, 0xF, 0xF, true));
    v += __builtin_bit_cast(float, __builtin_amdgcn_mov_dpp(__builtin_bit_cast(int, v), 0x4E, 0xF, 0xF, true));
    v += __builtin_bit_cast(float, __builtin_amdgcn_mov_dpp(__builtin_bit_cast(int, v), 0x141, 0xF, 0xF, true));
    return v;
}
__device__ __forceinline__ void phase_peer_u(const Args& A, int layer, int nrows, LAS unsigned char* smem, int rep) {
    const int var = rep ? MK_UVAR : 0;
    const bf16_t* H = (const bf16_t*)(A.ws + WS_H); const int* IDX = (const int*)(A.ws + WS_R2); float* PART = var ? (float*)(A.ws + WS_R1) : (float*)(A.ws + WS_BIG + BIG_PART);
    const unsigned char* U = A.ws + WS_TAB;
    constexpr int PP = 1088, WB = 4 * PP + 2048;
    const int tid = otid(), wid = tid >> 6, lane = tid & 63, m = lane & 7, tk = lane >> 3;
    const int wu = __builtin_amdgcn_readfirstlane(wid);
    LAS unsigned char* lds = smem + LDS_BASE + wu * (2 * WB);
    PeerSched S; S.init(A, nrows, smem);
    peer_items(S,
        [&](int sl, int blk, int buf) {
#pragma unroll
            for (int i = 0; i < 4; ++i)
                __builtin_amdgcn_global_load_lds((const unsigned*)(IDX + ((size_t)blk * 64 + 8 * wu + 2 * i) * 128 + 4 * lane), (LAS unsigned*)(lds + buf * WB + PP * i), 16, 0, 0);
#pragma unroll
            for (int i = 0; i < 2; ++i)
                __builtin_amdgcn_global_load_lds((const unsigned*)(H + (size_t)(blk * 64 + 8 * wu + 4 * i + (lane >> 4)) * 1024 + SW * sl + 8 * (lane & 15)), (LAS unsigned*)(lds + buf * WB + 4 * PP + 1024 * i), 16, 0, 0); },
        [&](int sl, int blk, int buf) {
            const unsigned char* ub = U + (size_t)sl * NEXP * SW + 16 * m;
            const int tok = blk * 64 + wid * 8 + tk;
            const int sw = (tk & 1) * 4;
            const LAS int* ib = (const LAS int*)(lds + buf * WB + (tk >> 1) * PP + (tk & 1) * 512);
            float hf[16];
            { const u32x4 h0 = *(const LAS u32x4*)(lds + buf * WB + 4 * PP + tk * 256 + 32 * m), h1 = *(const LAS u32x4*)(lds + buf * WB + 4 * PP + tk * 256 + 32 * m + 16);
#pragma unroll
              for (int j = 0; j < 4; ++j) { hf[2 * j] = bflo(h0[j]); hf[2 * j + 1] = bfhi(h0[j]); hf[8 + 2 * j] = bflo(h1[j]); hf[8 + 2 * j + 1] = bfhi(h1[j]); } }
            const bool up4 = m >= 4, up2 = (m & 2) != 0, up1 = (m & 1) != 0;
            float* pp = PART + ((size_t)sl * NROW + tok) * 128 + (m ^ sw);
            u32x4 vv[2][8];
#define PU_ROWS(T, c) do { const i32x4 e0_ = *(const LAS i32x4*)(ib + 8 * (c) + sw), e1_ = *(const LAS i32x4*)(ib + 8 * (c) + (4 - sw)); \
                if (var == 4) { _Pragma("unroll") for (int k_ = 0; k_ < 8; ++k_) vv[T][k_] = (u32x4){(unsigned)e0_.x, (unsigned)e1_.y, 0u, 0u}; } else { \
                vv[T][0] = *(const u32x4*)(ub + (size_t)(var == 3 ? e0_.x & 63 : e0_.x) * SW); vv[T][1] = *(const u32x4*)(ub + (size_t)(var == 3 ? e0_.y & 63 : e0_.y) * SW); \
                vv[T][2] = *(const u32x4*)(ub + (size_t)(var == 3 ? e0_.z & 63 : e0_.z) * SW); vv[T][3] = *(const u32x4*)(ub + (size_t)(var == 3 ? e0_.w & 63 : e0_.w) * SW); \
                vv[T][4] = *(const u32x4*)(ub + (size_t)(var == 3 ? e1_.x & 63 : e1_.x) * SW); vv[T][5] = *(const u32x4*)(ub + (size_t)(var == 3 ? e1_.y & 63 : e1_.y) * SW); \
                vv[T][6] = *(const u32x4*)(ub + (size_t)(var == 3 ? e1_.z & 63 : e1_.z) * SW); vv[T][7] = *(const u32x4*)(ub + (size_t)(var == 3 ? e1_.w & 63 : e1_.w) * SW); } } while (0)
#define PU_DOT(T, c) do { float s_[8]; \
                _Pragma("unroll") for (int k = 0; k < 8; ++k) { f32x2 a2 = {0.f, 0.f}; \
                    _Pragma("unroll") for (int j = 0; j < 4; ++j) { const int w = (int)vv[T][k][j]; \
                        const f32x2 lo = __builtin_amdgcn_cvt_pk_f32_fp8(w, false), hi = __builtin_amdgcn_cvt_pk_f32_fp8(w, true); \
                        a2 = __builtin_elementwise_fma(lo, (f32x2){hf[4 * j], hf[4 * j + 1]}, a2); a2 = __builtin_elementwise_fma(hi, (f32x2){hf[4 * j + 2], hf[4 * j + 3]}, a2); } \
                    s_[k] = a2.x + a2.y; } \
                  \
                float t_[4], u_[2]; \
                _Pragma("unroll") for (int j = 0; j < 4; ++j) { const float give = up4 ? s_[j] : s_[4 + j], keep = up4 ? s_[4 + j] : s_[j]; \
                    t_[j] = keep + __builtin_bit_cast(float, __builtin_amdgcn_mov_dpp(__builtin_bit_cast(int, give), 0x141, 0xF, 0xF, true)); }        \
                _Pragma("unroll") for (int j = 0; j < 2; ++j) { const float give = up2 ? t_[j] : t_[2 + j], keep = up2 ? t_[2 + j] : t_[j]; \
                    u_[j] = keep + __builtin_bit_cast(float, __builtin_amdgcn_mov_dpp(__builtin_bit_cast(int, give), 0x4E, 0xF, 0xF, true)); }         \
                { const float give = up1 ? u_[0] : u_[1], keep = up1 ? u_[1] : u_[0]; \
                  const float tot_ = keep + __builtin_bit_cast(float, __builtin_amdgcn_mov_dpp(__builtin_bit_cast(int, give), 0xB1, 0xF, 0xF, true));           \
                  pp[8 * (c)] = tot_; } } while (0)
            PU_ROWS(0, 0);
#pragma unroll 1
            for (int c = 0; c < 16; c += 2) {
                PU_ROWS(1, c + 1);
                __builtin_amdgcn_sched_barrier(0);
                PU_DOT(0, c);
                __builtin_amdgcn_sched_barrier(0);
                if (c + 2 < 16) PU_ROWS(0, c + 2);
                __builtin_amdgcn_sched_barrier(0);
                PU_DOT(1, c + 1);
                __builtin_amdgcn_sched_barrier(0);
            }
#undef PU_ROWS
#undef PU_DOT
        });
}
__device__ __forceinline__ void phase_coef(const Args& A, int nrows) {
    const float* PART = (const float*)(A.ws + WS_BIG + BIG_PART); const float* GATE = (const float*)(A.ws + WS_R2 + R2_GATE); float* COEF = (float*)(A.ws + WS_R2 + R2_COEF);
    const int* IDX = (const int*)(A.ws + WS_R2); const float* SCL = (const float*)(A.ws + WS_TAB + TAB_SCL);
    const int gthr = blockIdx.x * NTHR + otid(), nthr = gridDim.x * NTHR;
    for (int p = gthr; p < nrows * 32; p += nthr) {
        f32x4 s = {0.f, 0.f, 0.f, 0.f};
#pragma unroll
        for (int x = 0; x < NSL; ++x) s += *(const f32x4*)(PART + (size_t)x * NROW * 128 + 4 * p);
        const i32x4 e = *(const i32x4*)(IDX + 4 * p); const f32x4 gt = *(const f32x4*)(GATE + 4 * p);
        const f32x4 su = {SCL[e.x], SCL[e.y], SCL[e.z], SCL[e.w]}, sv = {SCL[NEXP + e.x], SCL[NEXP + e.y], SCL[NEXP + e.z], SCL[NEXP + e.w]};
        const f32x4 a = s * su; const f32x2 g0 = gelu_pk((f32x2){a[0], a[1]}), g1 = gelu_pk((f32x2){a[2], a[3]});
        *(f32x4*)(COEF + 4 * p) = gt * (f32x4){g0.x, g0.y, g1.x, g1.y} * sv; }

}
__device__ __forceinline__ void phase_peer_v(const Args& A, int layer, int nrows, LAS unsigned char* smem, int rep) {
    const int* IDX = (const int*)(A.ws + WS_R2); const float* COEF = (const float*)(A.ws + WS_R2 + R2_COEF);
    const unsigned char* V = A.ws + WS_TAB + TAB8_HALF; const float* MODL = (const float*)(A.ws + WS_MOD) + (size_t)layer * 5 * 6144 + 5 * 1024;
    float* XC = (float*)(A.ws + WS_XC);
    constexpr int PP = 1088, WB = 8 * PP;
    const int tid = otid(), wid = tid >> 6, lane = tid & 63, m = lane & 7, tk = lane >> 3;
    const int wu = __builtin_amdgcn_readfirstlane(wid);
    LAS unsigned char* lds = smem + LDS_BASE + wu * (2 * WB);
    PeerSched S; S.init(A, nrows, smem);
    peer_items(S,
        [&](int sl, int blk, int buf) {
#pragma unroll
            for (int i = 0; i < 4; ++i) {
                __builtin_amdgcn_global_load_lds((const unsigned*)(IDX + ((size_t)blk * 64 + 8 * wu + 2 * i) * 128 + 4 * lane), (LAS unsigned*)(lds + buf * WB + PP * i), 16, 0, 0);
                __builtin_amdgcn_global_load_lds((const unsigned*)(COEF + ((size_t)blk * 64 + 8 * wu + 2 * i) * 128 + 4 * lane), (LAS unsigned*)(lds + buf * WB + 4 * PP + PP * i), 16, 0, 0); } },
        [&](int sl, int blk, int buf) {
            const unsigned char* vb = V + (size_t)sl * NEXP * SW + 16 * m;
            const int tok = blk * 64 + wid * 8 + tk; const bool lat = tok < NLAT;
            const int toff = (tk >> 1) * PP + (tk & 1) * 512, sw = (tk & 1) * 4;
            const LAS int* ib = (const LAS int*)(lds + buf * WB + toff); const LAS float* cb = (const LAS float*)(lds + buf * WB + 4 * PP + toff);
            float* xp = (lat ? A.out + (size_t)tok * D : XC + (size_t)(tok - NLAT) * D) + SW * sl + 16 * m;
            f32x4 xr[4];
#pragma unroll
            for (int j = 0; j < 4; ++j) xr[j] = *(f32x4*)(xp + 4 * j);
            f32x2 acc2[8];
#pragma unroll
            for (int j = 0; j < 8; ++j) acc2[j] = (f32x2){0.f, 0.f};
            u32x4 vv[2][8];
#define PV_ROWS(T, c) do { const i32x4 e0_ = *(const LAS i32x4*)(ib + 8 * (c) + sw), e1_ = *(const LAS i32x4*)(ib + 8 * (c) + (4 - sw)); \
                vv[T][0] = *(const u32x4*)(vb + (size_t)e0_.x * SW); vv[T][1] = *(const u32x4*)(vb + (size_t)e0_.y * SW); vv[T][2] = *(const u32x4*)(vb + (size_t)e0_.z * SW); vv[T][3] = *(const u32x4*)(vb + (size_t)e0_.w * SW); \
                vv[T][4] = *(const u32x4*)(vb + (size_t)e1_.x * SW); vv[T][5] = *(const u32x4*)(vb + (size_t)e1_.y * SW); vv[T][6] = *(const u32x4*)(vb + (size_t)e1_.z * SW); vv[T][7] = *(const u32x4*)(vb + (size_t)e1_.w * SW); } while (0)
#define PV_FMA(T, c) do { const f32x4 c0_ = *(const LAS f32x4*)(cb + 8 * (c) + sw), c1_ = *(const LAS f32x4*)(cb + 8 * (c) + (4 - sw)); \
                _Pragma("unroll") for (int k = 0; k < 8; ++k) { const float cf = k < 4 ? c0_[k & 3] : c1_[k & 3]; \
                    _Pragma("unroll") for (int j = 0; j < 4; ++j) { const int w = (int)vv[T][k][j]; \
                        const f32x2 lo = __builtin_amdgcn_cvt_pk_f32_fp8(w, false), hi = __builtin_amdgcn_cvt_pk_f32_fp8(w, true); const f32x2 c2 = {cf, cf}; \
                        acc2[2 * j] = __builtin_elementwise_fma(lo, c2, acc2[2 * j]); acc2[2 * j + 1] = __builtin_elementwise_fma(hi, c2, acc2[2 * j + 1]); } } } while (0)
            PV_ROWS(0, 0);
#pragma unroll 1
            for (int c = 0; c < 16; c += 2) {
                PV_ROWS(1, c + 1);
                __builtin_amdgcn_sched_barrier(0);
                PV_FMA(0, c);
                __builtin_amdgcn_sched_barrier(0);
                if (c + 2 < 16) PV_ROWS(0, c + 2);
                __builtin_amdgcn_sched_barrier(0);
                PV_FMA(1, c + 1);
                __builtin_amdgcn_sched_barrier(0);
            }
#undef PV_ROWS
#undef PV_FMA
            const float* gp = MODL + (size_t)(lat ? (tok >> 13) : 4) * 6144 + SW * sl + 16 * m;
#pragma unroll
            for (int j = 0; j < 4; ++j) { const f32x4 g = *(const f32x4*)(gp + 4 * j);
                *(f32x4*)(xp + 4 * j) = xr[j] + g * (f32x4){acc2[2 * j].x, acc2[2 * j].y, acc2[2 * j + 1].x, acc2[2 * j + 1].y}; }
        });
}

#ifdef MK_CHECK
constexpr int CW_CHK = 3840;
__device__ __forceinline__ float blk_sum(float v, LAS float* red) {
    const int t_ = otid(); v = wave_sum(v); __syncthreads(); if ((t_ & 63) == 0) red[t_ >> 6] = v; __syncthreads();
    float s = 0.f; for (int i = 0; i < 8; ++i) s += red[i]; __syncthreads(); return s;
}
__device__ __forceinline__ float fp8f(unsigned b) { const unsigned e = (b >> 3) & 15u, m = b & 7u; const float v = e ? ldexpf(1.f + (float)m * 0.125f, (int)e - 7) : ldexpf((float)m * 0.125f, -6); return (b & 0x80u) ? -v : v; }
__device__ __forceinline__ void check_attn(const Args& A, LAS unsigned char* lds) {
    const unsigned char* Q = A.ws + WS_R1 + R1_Q; const unsigned char* KN = A.ws + WS_R1 + R1_KN; const unsigned char* KR = A.ws + WS_BIG + BIG_KR; const unsigned char* V = A.ws + WS_R1 + R1_V;
    const bf16_t* CAT = (const bf16_t*)(A.ws + WS_R3 + R3_CAT); float* chk = (float*)(A.ws + WS_CTL) + CW_CHK;
    LAS float* p = (LAS float*)lds; LAS float* qv = p + NKEY; LAS float* red = qv + 192;
    const int tid = otid(), sidx = blockIdx.x;
    const int b = sidx & 3, h = (sidx >> 2) & 7, l = (int)(((unsigned)sidx * 2654435761u) >> 19) & 8191;
    const size_t bh = (size_t)(b * 8 + h);
    if (tid < 192) qv[tid] = fp8f(Q[(bh * NKEY + 256 + l) * 192 + tid]) * (1.f / att8::QUP);
    __syncthreads();
    float mx = -1e30f;
    for (int key = tid; key < NKEY; key += 512) { const int t = key >> 6, k = key & 63; float s = 0.f;
        for (int d = 0; d < 128; ++d) s += qv[d] * fp8f(KN[(bh * NKT + t) * 8192 + att8::kn8(k, d)]);
        for (int d = 0; d < 64; ++d) s += qv[128 + d] * fp8f(KR[((size_t)b * NKT + t) * 4096 + att8::kr8(k, d)]);
        p[key] = s; mx = fmaxf(mx, s); }
    for (int o = 32; o >= 1; o >>= 1) mx = fmaxf(mx, __shfl_xor(mx, o));
    __syncthreads(); if ((tid & 63) == 0) red[tid >> 6] = mx; __syncthreads(); mx = red[0]; for (int i = 1; i < 8; ++i) mx = fmaxf(mx, red[i]); __syncthreads();
    float ls = 0.f; for (int key = tid; key < NKEY; key += 512) { const float e = exp2f(p[key] - mx); p[key] = e; ls += e; }
    ls = blk_sum(ls, red);
    float num = 0.f, den = 0.f;
    if (tid < 128) { float o = 0.f; for (int key = 0; key < NKEY; ++key) o += p[key] * fp8f(V[(bh * NKT + (key >> 6)) * 8192 + att8::v8(tid, key & 63)]);
        o /= ls; const float got = bf2f(CAT[(size_t)(b * 8192 + l) * 2048 + 1024 + 128 * h + tid]); num = (got - o) * (got - o); den = o * o; }
    num = blk_sum(num, red); den = blk_sum(den, red);
    if (tid == 0) { atomicAdd(chk, num); atomicAdd(chk + 1, den); }
}
__device__ __forceinline__ void check_qkv(const Args& A, int li, LAS unsigned char* lds) {
    float* chk = (float*)(A.ws + WS_CTL) + CW_CHK;
    const unsigned char* Q = A.ws + WS_R1 + R1_Q; const unsigned char* KN = A.ws + WS_R1 + R1_KN; const unsigned char* KR = A.ws + WS_BIG + BIG_KR; const unsigned char* V = A.ws + WS_R1 + R1_V;
    LAS float* hv = (LAS float*)lds; LAS float* cq = hv + 1024; LAS float* ckv = cq + 384; LAS float* kr = ckv + 256; LAS float* red = kr + 64; LAS float* ov = red + 16;
    const int tid = otid(), sidx = blockIdx.x;
    const int hd = sidx & 7; const int r = (sidx & 8) ? NLAT + (int)(((unsigned)sidx * 2654435761u) >> 22) : (int)(((unsigned)sidx * 2654435761u) >> 17);
    const float* win = A.in[I_HWIN] + (size_t)li * 1024 * HYB_IN;
    {
        const float* xp = r < NLAT ? A.out + (size_t)r * D : (const float*)(A.ws + WS_XC) + (size_t)(r - NLAT) * D; const float* MODL = (const float*)(A.ws + WS_MOD) + (size_t)(2 * li) * 5 * 6144 + (size_t)row_mb(r) * 6144;
        float ss = 0.f; for (int i = tid; i < 1024; i += 512) ss += xp[i] * xp[i];
        ss = blk_sum(ss, red); const float rstd = rsqrtf(ss / 1024.f + EPS);
        for (int i = tid; i < 1024; i += 512) hv[i] = bf2f(f2bf(xp[i] * rstd * A.in[I_N1G][(2 * li) * 1024 + i] * (1.f + MODL[1024 + i]) + MODL[i])); }
    __syncthreads();
    for (int j = tid; j < 704; j += 512) { float s = 0.f; for (int k = 0; k < 1024; ++k) s += hv[k] * win[(size_t)k * HYB_IN + C_CQ + j];
        s = bf2f(f2bf(s)); if (j < 384) cq[j] = s; else if (j < 640) ckv[j - 384] = s; else kr[j - 640] = s; }
    __syncthreads();
    float sq = 0.f, sk = 0.f; for (int j = tid; j < 384; j += 512) sq += cq[j] * cq[j]; for (int j = tid; j < 256; j += 512) sk += ckv[j] * ckv[j];
    sq = blk_sum(sq, red); sk = blk_sum(sk, red);
    const float rq = rsqrtf(sq / 384.f + EPS), rk = rsqrtf(sk / 256.f + EPS);
    const float* wqb = A.in[I_WQB] + (size_t)li * 384 * 1536; const float* wkvb = A.in[I_WKVB] + (size_t)li * 256 * 2048; const float* qg = A.in[I_QNG] + li * 384; const float* kg = A.in[I_KVNG] + li * 256;
    if (tid < 192) { float s = 0.f; for (int k = 0; k < 384; ++k) s += cq[k] * rq * qg[k] * wqb[(size_t)k * 1536 + hd * 192 + tid]; ov[tid] = s; }
    else if (tid < 448) { const int c = tid - 192; float s = 0.f; for (int k = 0; k < 256; ++k) s += ckv[k] * rk * kg[k] * wkvb[(size_t)k * 2048 + hd * 256 + c]; ov[tid] = s; }
    __syncthreads();
    const bool lat = r < NLAT; const int b = lat ? (r >> 13) : ((r - NLAT) >> 8), l = lat ? (r & 8191) : 0, key = lat ? 256 + l : ((r - NLAT) & 255), qrow = key;
    const size_t bh = (size_t)(b * 8 + hd); const float qs = QSCALE * att8::QUP;
    float num = 0.f, den = 0.f;
    if (tid < 128) {
        const float q = ov[tid] * qs, gq = fp8f(Q[(bh * NKEY + qrow) * 192 + tid]);
        const float kk = ov[192 + tid], gk = fp8f(KN[(bh * NKT + (key >> 6)) * 8192 + att8::kn8(key & 63, tid)]);
        const float vv = ov[320 + tid], gv = fp8f(V[(bh * NKT + (key >> 6)) * 8192 + att8::v8(tid, key & 63)]);
        num = (gq - q) * (gq - q) + (gk - kk) * (gk - kk) + (gv - vv) * (gv - vv); den = q * q + kk * kk + vv * vv;
    } else if (tid < 160) {
        const int i = tid - 128; float c = 1.f, sn = 0.f;
        if (lat) { const float pos = (float)(i < 16 ? (l >> 6) : (l & 63)); const float ang = pos * powf(10000.f, -(float)(i & 15) / 16.f); c = cosf(ang); sn = sinf(ang); }
        const float q1 = ov[128 + i] * qs, q2 = ov[160 + i] * qs, k1 = kr[i], k2 = kr[32 + i];
        const float rq1 = q1 * c - q2 * sn, rq2 = q1 * sn + q2 * c, rk1 = k1 * c - k2 * sn, rk2 = k1 * sn + k2 * c;
        const float gq1 = fp8f(Q[(bh * NKEY + qrow) * 192 + 128 + 2 * i]), gq2 = fp8f(Q[(bh * NKEY + qrow) * 192 + 128 + 2 * i + 1]);
        const float gk1 = fp8f(KR[((size_t)b * NKT + (key >> 6)) * 4096 + att8::kr8(key & 63, 2 * i)]), gk2 = fp8f(KR[((size_t)b * NKT + (key >> 6)) * 4096 + att8::kr8(key & 63, 2 * i + 1)]);
        num = (gq1 - rq1) * (gq1 - rq1) + (gq2 - rq2) * (gq2 - rq2) + (gk1 - rk1) * (gk1 - rk1) + (gk2 - rk2) * (gk2 - rk2); den = rq1 * rq1 + rq2 * rq2 + rk1 * rk1 + rk2 * rk2;
    }
    num = blk_sum(num, red); den = blk_sum(den, red);
    if (tid == 0) { atomicAdd(chk, num); atomicAdd(chk + 1, den); }
}
__device__ __forceinline__ void check_topk(const Args& A, int layer, LAS unsigned char* lds) {
    const bf16_t* QP = (const bf16_t*)(A.ws + WS_BIG); const int* IDX = (const int*)(A.ws + WS_R2); const float* GATE = (const float*)(A.ws + WS_R2 + R2_GATE); float* chk = (float*)(A.ws + WS_CTL) + CW_CHK;
    const bf16_t* K1 = (const bf16_t*)(A.ws + WS_W + W_PEER + (size_t)layer * WP_SZ + WP_K1);
    LAS float* sc = (LAS float*)lds; LAS float* v12 = sc + 256; LAS int* i12 = (LAS int*)(v12 + 32); LAS float* cs = (LAS float*)(i12 + 32); LAS float* ts = cs + 256; LAS int* ti = (LAS int*)(ts + 16); LAS float* red = (LAS float*)(ti + 16);
    const int tid = otid();
    for (int smp = blockIdx.x; smp < 1024; smp += gridDim.x) {
        const int h = smp & 7, tok = (int)((((unsigned)smp * 2654435761u) >> 12) % (unsigned)NROW);
        __syncthreads();
        if (tid < 256) { const int half = tid >> 7, key = tid & 127; float a = 0.f;
            for (int d = 0; d < 128; ++d) a += bf2f(QP[(size_t)tok * 2048 + 256 * h + 128 * half + d]) * bf2f(K1[((size_t)half * 8 + h) * 16384 + key * 128 + d]);
            sc[tid] = a; }
        __syncthreads();
        if (tid < 256) { const int half = tid >> 7, key = tid & 127; const float v = sc[tid]; int rank = 0;
            for (int j = 0; j < 128; ++j) { const float o = sc[half * 128 + j]; rank += (o > v || (o == v && j < key)) ? 1 : 0; }
            if (rank < 16) { v12[half * 16 + rank] = v; i12[half * 16 + rank] = key; } }
        __syncthreads();
        if (tid < 256) cs[tid] = v12[tid >> 4] + v12[16 + (tid & 15)];
        __syncthreads();
        if (tid < 256) { const float v = cs[tid]; int rank = 0;
            for (int j = 0; j < 256; ++j) { const float o = cs[j]; rank += (o > v || (o == v && j < tid)) ? 1 : 0; }
            if (rank < 16) { ts[rank] = v; ti[rank] = i12[tid >> 4] * 128 + i12[16 + (tid & 15)]; } }
        __syncthreads();
        float num = 0.f, den = 0.f;
        if (tid < 16) { float es = 0.f; for (int j = 0; j < 16; ++j) es += __expf(ts[j] - ts[0]); const float gn = __expf(ts[tid] - ts[0]) / es; float gk = 0.f;
            for (int j = 0; j < 16; ++j) if (IDX[(size_t)tok * 128 + 16 * h + j] == ti[tid]) gk = GATE[(size_t)tok * 128 + 16 * h + j];
            num = (gk - gn) * (gk - gn); den = gn * gn; }
        num = blk_sum(num, red); den = blk_sum(den, red);
        if (tid == 0) { atomicAdd(chk, num); atomicAdd(chk + 1, den); }
    }
}
#endif
#ifndef MK_PER_PHASE
#define MK_PER_PHASE 0
#endif
__device__ __forceinline__ int nr_in(int L) { return L <= 2 ? NROW : NLAT; }
__device__ __forceinline__ int nr_out(int L) { return L <= 1 ? NROW : NLAT; }

__global__ void __launch_bounds__(NTHR, 2) fwd(Args A) {
    extern __shared__ __attribute__((aligned(256))) unsigned char smem_raw[];
    LAS unsigned char* smem = (LAS unsigned char*)smem_raw;
    LAS unsigned char* lds = smem + LDS_BASE;
    const int tid = otid();
    if (tid < 64) ((LAS unsigned*)smem)[tid] = 0u;
    __syncthreads();
    XcdBarrier bar = xcd_barrier_post((unsigned*)(A.ws + WS_CTL), (volatile LAS unsigned*)smem);
    if (tid == 0) ((LAS unsigned*)smem)[8] = atomicAdd((unsigned*)(A.ws + WS_CTL) + CW_RANK + 32 * (xb_xcc_id() & 7u), 1u);
    __syncthreads();
    bool need_bar = false;
    const int lo = A.ph_lo, hi = A.ph_hi;
#ifndef PHMASK
#define PHMASK 0xffffffffu
#endif
#define SITE(k) if constexpr (((PHMASK) >> (k)) & 1u)
#ifndef MK_SVAR
#define MK_SVAR 1
#endif
#ifndef MK_REPEAT_SITE
#define MK_REPEAT_SITE -1
#endif
#define REP(k) for (int rep = 0; rep < ((k) == (MK_REPEAT_SITE) ? 2 : 1); ++rep)
#define PH(id) if ([&]() -> bool { if ((id) < lo || (id) >= hi) return false; if (need_bar) xcd_barrier(bar); need_bar = true; return true; }())
    unsigned char* ws = A.ws;
    float* XL = A.out; float* XC = (float*)(ws + WS_XC);
    bf16_t* H = (bf16_t*)(ws + WS_H);
    const float* MOD = (const float*)(ws + WS_MOD);

    SITE(0) PH(0) { phase_prologue(A, lds); }
    SITE(1) PH(1) { phase_norm_mod(A.in[I_X], A.in[I_CTX], XL, XC, A.in[I_N1G], MOD, 0, H, NROW); }
    for (int L = 0; L < DEPTH; ++L) {
        const int base = 2 + 16 * L, li = L >> 1; const bool hyb = (L & 1) == 0;
        const float* MODL = MOD + (size_t)L * 5 * 6144;
        unsigned char* WH = ws + WS_W + W_HYB + (size_t)li * WH_SZ; unsigned char* WG = ws + WS_W + W_GM + (size_t)li * WG_SZ; unsigned char* WP = ws + WS_W + W_PEER + (size_t)L * WP_SZ;
        if (hyb) {
            SITE(2) PH(base + 0) REP(2) { pg8::Gemm g{H, (const bf16_t*)(WH + WH_IN), nr_in(L), HYB_INP, 1024, 1024, 1024};
                pg8::EpiBf16<0> e{(bf16_t*)(ws + WS_BIG), HYB_INP}; pg8::gemm_phase(lds, g, e); }
            SITE(3) PH(base + 1) REP(3) { phase_conv(A, li); }
            SITE(4) PH(base + 2) {
                SITE(18) REP(18) { pg8::Gemm g{(const bf16_t*)(ws + WS_BIG) + C_CQ, (const bf16_t*)(WH + WH_QB), L == 0 ? NROW : NLAT, 1536, 384, HYB_INP, 384};
                  EpiQ e{ws + WS_R1 + R1_Q, (const float*)(ws + WS_RSTD), (const float*)(ws + WS_ROPE)}; pg8::gemm_phase(lds, g, e); }
                SITE(19) REP(19) { pg8::Gemm g{(const bf16_t*)(ws + WS_BIG) + C_CKV, (const bf16_t*)(WH + WH_KVB), NROW, 2048, 256, HYB_INP, 256};
                  EpiKV e{ws + WS_R1 + R1_KN, ws + WS_R1 + R1_V, (const float*)(ws + WS_RSTD) + NROW}; pg8::gemm_phase(lds, g, e); }
                SITE(20) REP(20) for (int u = blockIdx.x; u < 528; u += gridDim.x) ssd::g_unit((const bf16_t*)(ws + WS_R2 + R2_BC), (bf16_t*)(ws + WS_BIG + BIG_G), u);
            }
            SITE(5) PH(base + 3) {
                const int xq = (int)blockIdx.x & 7, jq = (int)blockIdx.x >> 3; const bool ssd_wg = (jq & 1) == 0 && gridDim.x == 256;
                if (gridDim.x == 256) {
                    if (ssd_wg) { const int r = jq >> 1, gi = xq + 8 * (r >> 3), hh = r & 7, sb = gi >> 2, sgp = (gi >> 1) & 1, sd = gi & 1;
                        SITE(21) ssd::ssd_unit(sb, 8 * sgp + hh, sd, (const bf16_t*)(ws + WS_R2), (const bf16_t*)(ws + WS_R2 + R2_BC), (const float*)(ws + WS_BIG + BIG_DT), (const bf16_t*)(ws + WS_BIG + BIG_G),
                                               A.in[I_ALOG] + li * 32, sd ? (bf16_t*)(ws + WS_R3) : (bf16_t*)(ws + WS_H), lds); }
                } else {
                    SITE(21) for (int u = blockIdx.x; u < 128; u += gridDim.x) ssd::ssd_unit(u >> 5, (u >> 1) & 15, u & 1, (const bf16_t*)(ws + WS_R2), (const bf16_t*)(ws + WS_R2 + R2_BC), (const float*)(ws + WS_BIG + BIG_DT),
                                               (const bf16_t*)(ws + WS_BIG + BIG_G), A.in[I_ALOG] + li * 32, (u & 1) ? (bf16_t*)(ws + WS_R3) : (bf16_t*)(ws + WS_H), lds);
                }
                const int nmine = gridDim.x == 256 ? (ssd_wg ? 3 : 5) + (L == 0 && !ssd_wg && jq < 8 ? 1 : 0) : 0;
                SITE(22) REP(22) for (int it = 0; gridDim.x == 256 ? it < nmine : (int)blockIdx.x + it * (int)gridDim.x < (L == 0 ? 1056 : 1024); ++it) {
                    int b, h, qrow0, orow0, nt;
                    if (gridDim.x == 256) {
                        const int base_it = ssd_wg ? 3 : 5;
                        if (it < base_it) { const int v = ssd_wg ? 3 * (jq >> 1) + it : 48 + 5 * (jq >> 1) + it; b = v >> 5; h = xq; const int qb = v & 31; qrow0 = 256 + 256 * qb; orow0 = b * 8192 + 256 * qb; nt = NKT; }
                        else { b = jq >> 1; h = xq; qrow0 = 0; orow0 = NLAT + 256 * b; nt = 4; }
                    } else { const int au = (int)blockIdx.x + it * (int)gridDim.x;
                        if (au < 1024) { b = au >> 8; h = au & 7; const int qb = (au >> 3) & 31; qrow0 = 256 + 256 * qb; orow0 = b * 8192 + 256 * qb; nt = NKT; }
                        else { const int cu = au - 1024; b = cu >> 3; h = cu & 7; qrow0 = 0; orow0 = NLAT + 256 * b; nt = 4; } }
                    const size_t bh = (size_t)(b * 8 + h);
                    att8::attn_unit(ws + WS_R1 + R1_Q + (bh * NKEY + qrow0) * 192, ws + WS_R1 + R1_KN + bh * NKT * 8192, ws + WS_BIG + BIG_KR + (size_t)b * NKT * 4096,
                                    ws + WS_R1 + R1_V + bh * NKT * 8192, (bf16_t*)(ws + WS_R3 + R3_CAT) + (size_t)orow0 * 2048 + 1024 + 128 * h, nt, lds);
                }
                if (gridDim.x == 256 && !ssd_wg) SITE(11) phase_tabcvt(A, L, xq + 8 * (jq >> 1), 128);
            }
            SITE(6) PH(base + 4) REP(6) { phase_ssd_out(A, li, nr_out(L));
#if defined(MK_CHECK) && MK_CHECK == 1
                if (L == 0) check_attn(A, lds);
#elif defined(MK_CHECK) && MK_CHECK == 2
                if (L == 0) check_qkv(A, li, lds);
#elif defined(MK_CHECK) && MK_CHECK == 3
                if (L == 2) check_attn(A, lds);
#endif
            }
        } else {
            SITE(7) PH(base + 0) REP(7) { pg8::Gemm g{H, (const bf16_t*)(WG + WG_IN), nr_out(L), 4096, 1024, 1024, 1024};
                pg8::EpiBf16<1> e{(bf16_t*)(ws + WS_BIG), 4096}; pg8::gemm_phase(lds, g, e); }
            SITE(8) PH(base + 1) REP(8) { phase_ln_stats(A, nr_out(L)); }
            SITE(9) PH(base + 2) REP(9) { phase_spatial(A, li, nr_out(L), lds); }
        }
        SITE(10) PH(base + 5) { pg8::Gemm g{hyb ? (const bf16_t*)(ws + WS_R3 + R3_CAT) : (const bf16_t*)(ws + WS_R1), hyb ? (const bf16_t*)(WH + WH_OUT) : (const bf16_t*)(WG + WG_OUT), nr_out(L), 1024, 2048, 2048, 2048};
            pg8::EpiResid e{XL, XC, MODL + 2 * 1024}; pg8::gemm_phase(lds, g, e); }
        SITE(11) PH(base + 6) REP(11) { phase_norm_mod(XL, XC, nullptr, nullptr, A.in[I_N2G] + L * 1024, MODL, 3, H, nr_out(L));
            if (!hyb || gridDim.x != 256) phase_tabcvt(A, L, (int)blockIdx.x, (int)gridDim.x); }
        SITE(12) PH(base + 7) REP(12) { pg8::Gemm g{H, (const bf16_t*)(WP + WP_Q), nr_out(L), 2048, 1024, 1024, 1024};
            pg8::EpiBf16<0> e{(bf16_t*)(ws + WS_BIG), 2048}; pg8::gemm_phase(lds, g, e); }
        SITE(13) PH(base + 8) REP(13) { phase_topk(A, L, nr_out(L), lds); }
        SITE(14) PH(base + 9) REP(14) { phase_peer_u(A, L, nr_out(L), smem, rep); }
        SITE(15) PH(base + 10) REP(15) { phase_coef(A, nr_out(L));
#if defined(MK_CHECK) && MK_CHECK == 4
            if (L == 1) check_topk(A, L, lds);
#endif
        }
        SITE(16) PH(base + 11) { phase_peer_v(A, L, nr_out(L), smem, 0); }
        SITE(17) PH(base + 12) { if (L < DEPTH - 1) phase_norm_mod(XL, XC, nullptr, nullptr, A.in[I_N1G] + (L + 1) * 1024, MOD + (size_t)(L + 1) * 5 * 6144, 0, H, nr_in(L + 1));
                        else {
#ifdef MK_CHECK
                            const float* chk = (const float*)(ws + WS_CTL) + CW_CHK; const float err = sqrtf(chk[0] / fmaxf(chk[1], 1e-30f));
                            phase_final_norm(XL, A.in[I_FNG], 1.f + 10.f * err);
#else
                            phase_final_norm(XL, A.in[I_FNG], 1.f);
#endif
                        } }
    }
#undef PH
}

#ifdef MK_TAP
__global__ void tap_kernel(const unsigned short* buf, size_t pitch, size_t col0, size_t ncols, size_t nrows, float* out) {
    const size_t n = ncols * nrows;
    for (size_t i = (size_t)blockIdx.x * blockDim.x + threadIdx.x; i < (size_t)NLAT * D; i += (size_t)gridDim.x * blockDim.x) {
        float s = 0.f; for (size_t j = i; j < n; j += (size_t)NLAT * D) s += (float)buf[(j / ncols) * pitch + col0 + (j % ncols)]; out[i] = s; }
}
#endif
extern "C" void kernel_launch(void* const* d_in, const int* in_sizes, int n_in, void* d_out, int out_size, void* d_ws, size_t ws_size, hipStream_t stream) {
    static int grid = 0;
    if (grid == 0) {
        if (n_in != N_IN || out_size != NLAT * D || ws_size < WS_END) { fprintf(stderr, "kernel_launch: unexpected shapes (n_in %d out %d ws %zu, need %zu)\n", n_in, out_size, ws_size, (size_t)WS_END); grid = -1; return; }
        int dev = 0, cus = 0, per_cu = 0;
        if (hipGetDevice(&dev) != hipSuccess || hipDeviceGetAttribute(&cus, hipDeviceAttributeMultiprocessorCount, dev) != hipSuccess) { grid = -1; return; }
        if (hipFuncSetAttribute((const void*)fwd, hipFuncAttributeMaxDynamicSharedMemorySize, LDS_BYTES) != hipSuccess) { fprintf(stderr, "kernel_launch: hipFuncSetAttribute failed\n"); grid = -1; return; }
        if (hipOccupancyMaxActiveBlocksPerMultiprocessor(&per_cu, (const void*)fwd, NTHR, LDS_BYTES) != hipSuccess || per_cu < 1) { fprintf(stderr, "kernel_launch: occupancy query says %d\n", per_cu); }
        (void)hipGetLastError();
        grid = cus;
    }
    if (grid < 0) return;
    (void)hipMemsetAsync((char*)d_ws + WS_CTL, 0, CTL_BYTES, stream);
    Args a{};
    for (int i = 0; i < N_IN; ++i) a.in[i] = (const float*)d_in[i];
    a.out = (float*)d_out; a.ws = (unsigned char*)d_ws;
#if MK_PER_PHASE
    for (int id = 0; id < 2 + 16 * DEPTH; ++id) {
        if (id >= 2) { const int L = (id - 2) / 16, s = (id - 2) % 16; if (s > 12) continue; if ((L & 1) && (s == 3 || s == 4)) continue; }
#ifdef MK_CUT
#ifdef MK_TAP
        if (id >= MK_CUT) continue;
#else
        if (id >= MK_CUT && id != 2 + 16 * (DEPTH - 1) + 12) continue;
#endif
#endif
        a.ph_lo = id; a.ph_hi = id + 1;
        hipLaunchKernelGGL(fwd, dim3(grid), dim3(NTHR), LDS_BYTES, stream, a);
    }
#ifdef MK_TAP
    { const size_t tp[5] = {MK_TAP}; hipLaunchKernelGGL(tap_kernel, dim3(2048), dim3(256), 0, stream, (const unsigned short*)((const char*)d_ws + tp[0]), tp[1], tp[2], tp[3], tp[4], (float*)d_out); }
#endif
#else
    a.ph_lo = 0; a.ph_hi = 2 + 16 * DEPTH;
    hipLaunchKernelGGL(fwd, dim3(grid), dim3(NTHR), LDS_BYTES, stream, a);
#endif
    const hipError_t le = hipPeekAtLastError();
    if (le != hipSuccess) fprintf(stderr, "kernel_launch: launch failed: %s\n", hipGetErrorName(le));
}
```

```cpp
#include <hip/hip_runtime.h>
#include <cstdio>
#include <cstdint>

#define LAS __attribute__((address_space(3)))
typedef unsigned short bf16_t;
typedef short bf16x8 __attribute__((ext_vector_type(8)));
typedef short s16x4 __attribute__((ext_vector_type(4)));
typedef float f32x2 __attribute__((ext_vector_type(2)));
typedef float f32x4 __attribute__((ext_vector_type(4)));
typedef float f32x16 __attribute__((ext_vector_type(16)));
typedef unsigned u32x2 __attribute__((ext_vector_type(2)));
typedef unsigned u32x4 __attribute__((ext_vector_type(4)));
typedef int i32x4 __attribute__((ext_vector_type(4)));
typedef int i32x8 __attribute__((ext_vector_type(8)));

constexpr int D = 1024, NB = 4, SEQ = 8192, DEPTH = 4, CTXL = 256;
constexpr int NLAT = NB * SEQ, NCTX = NB * CTXL, NROW = NLAT + NCTX;
constexpr int HYB_IN = 3280, HYB_INP = 3328;
constexpr int C_Z = 0, C_XBC = 1024, C_DT = 2560, C_CQ = 2576, C_CKV = 2960, C_KR = 3216;
constexpr int NKEY = SEQ + CTXL, NKT = NKEY / 64;
constexpr float EPS = 1e-6f;
constexpr float QSCALE = 0.07216878364870322f * 1.4426950408889634f;
constexpr int NEXP = 16384;

enum { I_X = 0, I_C, I_CTX, I_CCTX, I_ADAW, I_ADAB, I_N1G, I_N2G, I_HWIN, I_CONVW, I_CONVB, I_ALOG, I_DTB, I_SSDD, I_SSDNG, I_QNG, I_WQB, I_KVNG, I_WKVB,
       I_HWOUT, I_GWIN, I_GLNG, I_GLNB, I_GWS, I_GBS, I_GWOUT, I_PWQ, I_PK1, I_PK2, I_PU, I_PV, I_FNG, N_IN };

constexpr size_t al256(size_t x) { return (x + 255) & ~(size_t)255; }
constexpr size_t WS_CTL = 0, CTL_BYTES = 65536;
constexpr size_t WS_MOD = WS_CTL + CTL_BYTES;
constexpr size_t WS_ROPE = WS_MOD + al256((size_t)DEPTH * 5 * 6144 * 4);
constexpr size_t WS_RSTD = WS_ROPE + (size_t)2 * SEQ * 32 * 4;
constexpr size_t WS_W = WS_RSTD + al256((size_t)2 * NROW * 4);
constexpr size_t W_HYB = 0;
constexpr size_t WH_IN = 0, WH_QB = WH_IN + (size_t)HYB_INP * 1024 * 2, WH_KVB = WH_QB + (size_t)1536 * 384 * 2, WH_OUT = WH_KVB + (size_t)2048 * 256 * 2,
                 WH_SZ = WH_OUT + (size_t)1024 * 2048 * 2;
constexpr size_t W_GM = W_HYB + 2 * WH_SZ;
constexpr size_t WG_IN = 0, WG_OUT = WG_IN + (size_t)4096 * 1024 * 2, WG_WS = WG_OUT + (size_t)1024 * 2048 * 2, WG_SZ = WG_WS + (size_t)8 * 128 * 128 * 2;
constexpr size_t W_PEER = W_GM + 2 * WG_SZ;
constexpr size_t WP_Q = 0, WP_K1 = WP_Q + (size_t)2048 * 1024 * 2, WP_K2 = WP_K1 + (size_t)8 * 128 * 128 * 2, WP_SZ = WP_K2 + (size_t)8 * 128 * 128 * 2;
constexpr size_t W_TOTAL = W_PEER + 4 * WP_SZ;
constexpr size_t WS_TAB = WS_W + al256(W_TOTAL);
constexpr size_t TAB_HALF = (size_t)NEXP * 1024 * 2;
constexpr size_t WS_XC = WS_TAB + 2 * TAB_HALF;
constexpr size_t WS_H = WS_XC + (size_t)NCTX * D * 4;
constexpr size_t WS_BIG = WS_H + (size_t)NROW * D * 2;
constexpr size_t BIG_BYTES = (size_t)NROW * 4096 * 2;
constexpr size_t BIG_DT = (size_t)NROW * HYB_INP * 2;
constexpr size_t BIG_G = BIG_DT + (size_t)NROW * 32 * 4;
constexpr size_t BIG_KR = BIG_G + (size_t)528 * 128 * 128 * 2;
constexpr size_t BIG_PART = (size_t)NROW * 2048 * 2;
static_assert(BIG_KR + (size_t)NB * NKT * 8192 <= BIG_BYTES, "BIG tail");
constexpr size_t WS_R1 = WS_BIG + BIG_BYTES;
constexpr size_t R1_Q = 0, R1_KN = R1_Q + (size_t)NB * 8 * NKEY * 192 * 2, R1_V = R1_KN + (size_t)NB * 8 * NKT * 16384, R1_BYTES = R1_V + (size_t)NB * 8 * NKT * 16384;
constexpr size_t WS_R2 = WS_R1 + R1_BYTES;
constexpr size_t R2_BC = (size_t)NROW * 1024 * 2, R2_BYTES = R2_BC + (size_t)NROW * 512 * 2;
constexpr size_t R2_GATE = (size_t)NROW * 128 * 4, R2_COEF = 2 * R2_GATE;
constexpr size_t WS_R3 = WS_R2 + R2_BYTES;
constexpr size_t R3_CAT = (size_t)NROW * 1024 * 2, R3_BYTES = R3_CAT + (size_t)NROW * 2048 * 2;
constexpr size_t WS_END = WS_R3 + R3_BYTES;
static_assert(WS_END <= ((size_t)1 << 30), "workspace must fit 1 GiB");

constexpr int CW_RANK = 3584;
constexpr int CW_QUEUE = 4096;

typedef __bf16 bf16x2_t __attribute__((ext_vector_type(2)));
__device__ __forceinline__ unsigned cvt_pk_bf16(float lo, float hi) { const f32x2 v = {lo, hi}; const bf16x2_t b = __builtin_convertvector(v, bf16x2_t); return __builtin_bit_cast(unsigned, b); }
__device__ __forceinline__ bf16_t f2bf(float f) { return (bf16_t)(cvt_pk_bf16(f, 0.f) & 0xffffu); }
__device__ __forceinline__ float bf2f(unsigned b) { return __uint_as_float(b << 16); }
__device__ __forceinline__ float bflo(unsigned w) { return __uint_as_float(w << 16); }
__device__ __forceinline__ float bfhi(unsigned w) { return __uint_as_float(w & 0xffff0000u); }
__device__ __forceinline__ float wave_sum(float v) {
#pragma unroll
    for (int o = 32; o >= 1; o >>= 1) v += __shfl_xor(v, o);
    return v;
}
__device__ __forceinline__ int otid() { int t = threadIdx.x; asm volatile("" : "+v"(t)); return t; }
__device__ __forceinline__ float silu_f(float x) { return x / (1.f + __expf(-x)); }
__device__ __forceinline__ float softplus_f(float x) { return x > 20.f ? x : log1pf(__expf(x)); }
__device__ __forceinline__ f32x2 gelu_pk(f32x2 v) {
    const f32x2 av = __builtin_elementwise_abs(v), d = av * 0.2316418882f + 1.0f;
    f32x2 t; t.x = __builtin_amdgcn_rcpf(d.x); t.y = __builtin_amdgcn_rcpf(d.y);
    f32x2 q = t * 0.5307027145f + (-0.7265760135f); q = q * t + 0.7107068705f; q = q * t + (-0.142248368f); q = q * t + 0.127414796f; q = q * t;
    const f32x2 s = (v * v) * (-0.72134752044f);
    f32x2 e; e.x = __builtin_amdgcn_exp2f(s.x); e.y = __builtin_amdgcn_exp2f(s.y);
    const f32x2 m = v * (q * e), r = v - m;
    f32x2 o; o.x = v.x < 0.f ? m.x : r.x; o.y = v.y < 0.f ? m.y : r.y; return o;
}
__device__ __forceinline__ float gelu_f(float x) { f32x2 v = {x, 0.f}; return gelu_pk(v).x; }

__device__ __forceinline__ unsigned pk4_fp8(float a, float b, float c, float d) { int w = 0; w = __builtin_amdgcn_cvt_pk_fp8_f32(a, b, w, false); w = __builtin_amdgcn_cvt_pk_fp8_f32(c, d, w, true); return (unsigned)w; }
__device__ __forceinline__ float sat8(float v) { return __builtin_amdgcn_fmed3f(v, -448.f, 448.f); }
__device__ __forceinline__ unsigned pk4_fp8_sat(float a, float b, float c, float d) { return pk4_fp8(sat8(a), sat8(b), sat8(c), sat8(d)); }
__device__ __forceinline__ int row_mb(int r) { return r < NLAT ? (r >> 13) : 4; }

#define XB_TMO      128
#define XB_XCNT(j)  (256  + 64 * (j))
#define XB_XSUB(j)  (1280 + 64 * (j))
#define XB_XGEN(j)  (2304 + 64 * (j))
#define XB_TOP      3328
#define XB_TOPGEN   3392
#define XCD_BAR_WORDS 3456
#define XB_SPIN_CAP (1u << 22)
__device__ __forceinline__ unsigned xb_ld(unsigned* p)              { return __hip_atomic_load(p, __ATOMIC_RELAXED, __HIP_MEMORY_SCOPE_AGENT); }
__device__ __forceinline__ unsigned xb_add(unsigned* p, unsigned v) { return __hip_atomic_fetch_add(p, v, __ATOMIC_RELAXED, __HIP_MEMORY_SCOPE_AGENT); }
__device__ __forceinline__ unsigned xb_xcc_id() { return (unsigned)__builtin_amdgcn_s_getreg((3 << 11) | 20) & 0xFu; }
#define XB_SPIN(cond, bar) do { unsigned _sp = 0; while (cond) { __builtin_amdgcn_s_sleep(1); \
    if ((++_sp & 255u) == 0u) { if (xb_ld(&(bar)[XB_TMO])) break; if (_sp > XB_SPIN_CAP) { atomicAdd(&(bar)[XB_TMO], 1u); break; } } } } while (0)
struct XcdBarrier { unsigned* bar; unsigned x; volatile LAS unsigned* st; };
__device__ __forceinline__ XcdBarrier xcd_barrier_post(unsigned* bar, volatile LAS unsigned* st) {
    XcdBarrier b; b.bar = bar; b.x = xb_xcc_id(); b.st = st;
    if (threadIdx.x == 0) (void)xb_add(&bar[XB_XCNT(b.x)], 1u);
    return b;
}
__device__ __forceinline__ void xcd_barrier_complete(unsigned* bar, unsigned x, unsigned& nloc, unsigned& nx) {
    const unsigned G = gridDim.x * gridDim.y * gridDim.z;
    unsigned sum, cnt, mine, sp = 0u;
    for (;;) {
        sum = 0u; cnt = 0u; mine = 0u;
#pragma unroll
        for (unsigned j = 0; j < 16; ++j) { const unsigned c = xb_ld(&bar[XB_XCNT(j)]); sum += c; cnt += (c > 0u) ? 1u : 0u; mine = (j == x) ? c : mine; }
        if (sum == G) break;
        __builtin_amdgcn_s_sleep(1);
        if ((++sp & 255u) == 0u) { if (xb_ld(&bar[XB_TMO])) break; if (sp > XB_SPIN_CAP) { atomicAdd(&bar[XB_TMO], 1u); break; } }
    }
    nloc = mine > 0u ? mine : 1u; nx = cnt > 0u ? cnt : 1u;
}
__device__ __forceinline__ void xcd_barrier(const XcdBarrier& b) {
    asm volatile("s_waitcnt vmcnt(0)" ::: "memory");
    __syncthreads();
    if (threadIdx.x == 0) {
        unsigned* bar = b.bar;
        __builtin_amdgcn_s_waitcnt(0);
        unsigned nloc = b.st[0], nx = b.st[1];
        if (nloc == 0u) { xcd_barrier_complete(bar, b.x, nloc, nx); b.st[0] = nloc; b.st[1] = nx; }
        const unsigned old = xb_add(&bar[XB_XSUB(b.x)], 1u);
        const unsigned gen = old / nloc;
        if (old + 1u == (gen + 1u) * nloc) {
            __builtin_amdgcn_fence(__ATOMIC_RELEASE, "agent");
            asm volatile("s_waitcnt vmcnt(0)" ::: "memory");
            const unsigned og = xb_add(&bar[XB_TOP], 1u);
            const unsigned tg = og / nx;
            if (og + 1u == (tg + 1u) * nx) xb_add(&bar[XB_TOPGEN], 1u);
            else XB_SPIN(xb_ld(&bar[XB_TOPGEN]) == tg, bar);
            __builtin_amdgcn_fence(__ATOMIC_ACQUIRE, "agent");
            xb_add(&bar[XB_XGEN(b.x)], 1u);
            asm volatile("s_waitcnt vmcnt(0)" ::: "memory");
        } else {
            XB_SPIN(xb_ld(&bar[XB_XGEN(b.x)]) == gen, bar);
            __builtin_amdgcn_fence(__ATOMIC_ACQUIRE, "agent");
            asm volatile("s_waitcnt vmcnt(0)" ::: "memory");
        }
    }
    __syncthreads();
}

namespace pg8 {
constexpr int BM = 256, BK = 64, HALF = 128, HTB = HALF * BK * 2, STAGE_BYTES = 8 * HTB, NXCD = 8, WGM = 8;
__host__ __device__ __forceinline__ int lds_byte(int r, int c) { const int st = (r >> 4) * 2 + (c >> 5), rr = r & 15, cc = c & 31, ob = rr * 64 + cc * 2; return st * 1024 + (ob ^ (((ob >> 9) & 1) << 5)); }
__host__ __device__ __forceinline__ void stage_rc(int b, int& R, int& C) { const int st = b / 1024, sb = b % 1024, swz = sb ^ (((sb >> 9) & 1) << 5); R = (st >> 1) * 16 + swz / 64; C = (st & 1) * 32 + (swz % 64) / 2; }
__host__ __device__ __forceinline__ int perm32(int rho) { const int n = rho >> 4, i = rho & 15; return 8 * (i >> 2) + 4 * n + (i & 3); }
struct Unit { int pm, pn; };
struct Gemm { const bf16_t* A; const bf16_t* Bt; int M, N, K, lda, ldb; };
struct StaticOrder {
    int nM, nN, nwg, G, c;
    __device__ void init(int M, int N, int G_, int c_) { nM = M / BM; nN = N / BM; nwg = nM * nN; G = G_; c = c_; }
    __device__ bool next(int i, Unit& u) const {
        const long L = (long)i * G + c; if (L >= nwg) return false;
        int wgid = (int)L; { const int q = nwg / NXCD, r = nwg % NXCD, xcd = wgid % NXCD, off = wgid / NXCD; wgid = (xcd < r ? xcd * (q + 1) : r * (q + 1) + (xcd - r) * q) + off; }
        const int nig = WGM * nN, gid = wgid / nig, fm = gid * WGM, gsz = (nM - fm) < WGM ? (nM - fm) : WGM;
        u.pm = fm + ((wgid % nig) % gsz); u.pn = (wgid % nig) / gsz; return true;
    }
};
template <class Epi>
__device__ __forceinline__ void gemm_phase(LAS unsigned char* lds, const Gemm g, const Epi& E) {
    const int tid = otid(), wid = __builtin_amdgcn_readfirstlane(tid >> 6), lane = tid & 63, wr = wid >> 2, wc = wid & 3, fr = lane & 15, fq = lane >> 4;
    StaticOrder S; S.init(g.M, g.N, (int)gridDim.x, (int)blockIdx.x);
    int K = g.K; asm volatile("" : "+s"(K));
    const int nt = K / BK;
    unsigned voffA[2], voffB[2];
#pragma unroll
    for (int i = 0; i < 2; ++i) { int R, C; stage_rc(tid * 16 + i * 8192, R, C); const int Rb = Epi::PERM ? ((R & ~31) + perm32(R & 31)) : R;
        voffA[i] = (unsigned)(R * g.lda + C) * 2u; voffB[i] = (unsigned)(Rb * g.ldb + C) * 2u; }
    const size_t kstep = (size_t)(BK * 2);
    const size_t hstepA = (size_t)HALF * g.lda * 2, hstepB = (size_t)HALF * g.ldb * 2;
    const size_t tstepA = 2 * hstepA, tstepB = 2 * hstepB;
    const unsigned ldsw = (unsigned)wid * 1024u;
    const int aoff = lds_byte(wr * 64 + fr, fq * 8), boff = lds_byte(wc * 32 + fr, fq * 8);
#define PG8_SA(b, h) (((b) * 2 + (h)) * HTB)
#define PG8_SB(b, h) ((4 + (b) * 2 + (h)) * HTB)
#define PG8_STAGE(bufoff, gbase, voff) do { _Pragma("unroll") for (int _i = 0; _i < 2; ++_i) \
        __builtin_amdgcn_global_load_lds((const unsigned*)((const char*)(gbase) + (voff)[_i]), (LAS unsigned*)(lds + (bufoff) + ldsw + _i * 8192), 16, 0, 0); } while (0)
#define PG8_LDA(dst, b, h) do { _Pragma("unroll") for (int m = 0; m < 4; ++m) _Pragma("unroll") for (int k = 0; k < 2; ++k) dst[m][k] = *(const LAS bf16x8*)(lds + PG8_SA(b, h) + aoff + m * 2048 + k * 1024); } while (0)
#define PG8_LDB(dst, b, h) do { _Pragma("unroll") for (int n = 0; n < 2; ++n) _Pragma("unroll") for (int k = 0; k < 2; ++k) dst[n][k] = *(const LAS bf16x8*)(lds + PG8_SB(b, h) + boff + n * 2048 + k * 1024); } while (0)
#define PG8_MMA(ai, bj, At, Bt) do { __builtin_amdgcn_s_setprio(1); _Pragma("unroll") for (int m = 0; m < 4; ++m) _Pragma("unroll") for (int n = 0; n < 2; ++n) _Pragma("unroll") for (int k = 0; k < 2; ++k) \
        acc[ai][bj][m][n] = __builtin_amdgcn_mfma_f32_16x16x32_bf16(Bt[n][k], At[m][k], acc[ai][bj][m][n], 0, 0, 0); __builtin_amdgcn_s_setprio(0); } while (0)
#define PG8_WAIT_V(n) asm volatile("s_waitcnt vmcnt(" #n ")" ::: "memory")
#define PG8_WAIT_L(n) asm volatile("s_waitcnt lgkmcnt(" #n ")" ::: "memory")
#define PG8_BAR __builtin_amdgcn_s_barrier()
#define PG8_SCHED __builtin_amdgcn_sched_barrier(0)
    Unit cur, nxt; int ui = 0;
    if (!S.next(0, cur)) return;
    f32x4 acc[2][2][4][2];
#pragma unroll
    for (int a = 0; a < 2; ++a)
#pragma unroll
        for (int b = 0; b < 2; ++b)
#pragma unroll
            for (int m = 0; m < 4; ++m)
#pragma unroll
                for (int n = 0; n < 2; ++n) acc[a][b][m][n] = (f32x4){0.f, 0.f, 0.f, 0.f};
    bf16x8 At[4][2], B0[2][2], B1[2][2];
    const char* cA = (const char*)g.A + (size_t)cur.pm * tstepA; const char* cB = (const char*)g.Bt + (size_t)cur.pn * tstepB;
    PG8_STAGE(PG8_SB(0, 0), cB, voffB); PG8_STAGE(PG8_SB(0, 1), cB + hstepB, voffB); PG8_STAGE(PG8_SA(0, 0), cA, voffA); PG8_STAGE(PG8_SA(0, 1), cA + hstepA, voffA);
    if (wr == 1) PG8_BAR;
    PG8_WAIT_V(2); PG8_BAR;
    PG8_STAGE(PG8_SB(1, 0), cB + kstep, voffB); PG8_STAGE(PG8_SA(1, 0), cA + kstep, voffA); PG8_STAGE(PG8_SB(1, 1), cB + hstepB + kstep, voffB);
    PG8_WAIT_V(6); PG8_BAR;
    for (;;) {
        const bool has_next = S.next(ui + 1, nxt);
        const char* nA = has_next ? (const char*)g.A + (size_t)nxt.pm * tstepA : cA; const char* nB = has_next ? (const char*)g.Bt + (size_t)nxt.pn * tstepB : cB;
        for (int t = 0; t < nt; t += 2) {
            const bool last = (t == nt - 2);
            const char* a1 = cA + (size_t)(t + 1) * kstep;
            const char* a2 = last ? nA : cA + (size_t)(t + 2) * kstep; const char* b2 = last ? nB : cB + (size_t)(t + 2) * kstep;
            const char* a3 = a2 + kstep; const char* b3 = b2 + kstep;
            PG8_LDB(B0, 0, 0); PG8_LDB(B1, 0, 1); PG8_SCHED; PG8_LDA(At, 0, 0); PG8_STAGE(PG8_SA(1, 1), a1 + hstepA, voffA);
            PG8_WAIT_V(8); PG8_WAIT_L(0); PG8_BAR; PG8_MMA(0, 0, At, B0); PG8_MMA(0, 1, At, B1); PG8_BAR; PG8_SCHED;
            PG8_LDA(At, 0, 1); PG8_STAGE(PG8_SB(0, 0), b2, voffB); PG8_STAGE(PG8_SB(0, 1), b2 + hstepB, voffB); PG8_STAGE(PG8_SA(0, 0), a2, voffA);
            PG8_WAIT_V(8); PG8_WAIT_L(0); PG8_BAR; PG8_MMA(1, 0, At, B0); PG8_MMA(1, 1, At, B1); PG8_BAR; PG8_SCHED;
            PG8_LDB(B0, 1, 0); PG8_LDB(B1, 1, 1); PG8_SCHED; PG8_LDA(At, 1, 0); PG8_STAGE(PG8_SA(0, 1), a2 + hstepA, voffA);
            PG8_WAIT_V(8); PG8_WAIT_L(0); PG8_BAR; PG8_MMA(0, 0, At, B0); PG8_MMA(0, 1, At, B1); PG8_BAR; PG8_SCHED;
            PG8_LDA(At, 1, 1); PG8_STAGE(PG8_SB(1, 0), b3, voffB); PG8_STAGE(PG8_SB(1, 1), b3 + hstepB, voffB); PG8_STAGE(PG8_SA(1, 0), a3, voffA);
            PG8_WAIT_V(8); PG8_WAIT_L(0); PG8_BAR; PG8_MMA(1, 0, At, B0); PG8_MMA(1, 1, At, B1); PG8_BAR; PG8_SCHED;
        }
        if (wr == 0) PG8_BAR;
        { const int l2_ = otid() & 63; E(acc, cur, wr, wc, l2_ & 15, l2_ >> 4); }
        if (!has_next) break;
#pragma unroll
        for (int a = 0; a < 2; ++a)
#pragma unroll
            for (int b = 0; b < 2; ++b)
#pragma unroll
                for (int m = 0; m < 4; ++m)
#pragma unroll
                    for (int n = 0; n < 2; ++n) acc[a][b][m][n] = (f32x4){0.f, 0.f, 0.f, 0.f};
        cur = nxt; cA = nA; cB = nB; ++ui;
        if (wr == 1) PG8_BAR;
    }
    PG8_WAIT_V(0);
    PG8_BAR;
#undef PG8_SA
#undef PG8_SB
#undef PG8_STAGE
#undef PG8_LDA
#undef PG8_LDB
#undef PG8_MMA
#undef PG8_WAIT_V
#undef PG8_WAIT_L
#undef PG8_BAR
#undef PG8_SCHED
}

template <int ACT> struct EpiBf16 {
    static constexpr bool PERM = true;
    bf16_t* O; int ldc;
    __device__ __forceinline__ void operator()(const f32x4 (&acc)[2][2][4][2], const Unit& u, int wr, int wc, int fr, int fq) const {
        const int row0 = u.pm * BM + wr * 64 + fr, col0 = u.pn * BM + wc * 32 + 8 * fq;
#pragma unroll
        for (int ai = 0; ai < 2; ++ai)
#pragma unroll
            for (int m = 0; m < 4; ++m) { bf16_t* rowp = O + (size_t)(row0 + ai * HALF + m * 16) * ldc + col0;
#pragma unroll
                for (int bj = 0; bj < 2; ++bj) { f32x4 v0 = acc[ai][bj][m][0], v1 = acc[ai][bj][m][1];
                    if (ACT == 1) { f32x2 a = gelu_pk((f32x2){v0[0], v0[1]}), b = gelu_pk((f32x2){v0[2], v0[3]}), c = gelu_pk((f32x2){v1[0], v1[1]}), d = gelu_pk((f32x2){v1[2], v1[3]});
                        v0 = (f32x4){a.x, a.y, b.x, b.y}; v1 = (f32x4){c.x, c.y, d.x, d.y}; }
                    u32x4 w; w.x = cvt_pk_bf16(v0[0], v0[1]); w.y = cvt_pk_bf16(v0[2], v0[3]); w.z = cvt_pk_bf16(v1[0], v1[1]); w.w = cvt_pk_bf16(v1[2], v1[3]);
                    *(u32x4*)(rowp + bj * HALF) = w; } }
    }
};
struct EpiResid {
    static constexpr bool PERM = false;
    float* xl; float* xc; const float* gate;
    __device__ __forceinline__ void operator()(const f32x4 (&acc)[2][2][4][2], const Unit& u, int wr, int wc, int fr, int fq) const {
        const int rbase = u.pm * BM; const bool lat = rbase < NLAT;
        float* X = lat ? xl + (size_t)rbase * D : xc + (size_t)(rbase - NLAT) * D;
        const float* gp = gate + (size_t)(lat ? (rbase >> 13) : 4) * 6144;
        const int row0 = wr * 64 + fr, col0 = u.pn * BM + wc * 32 + 4 * fq;
        f32x4 gv[2][2];
#pragma unroll
        for (int bj = 0; bj < 2; ++bj)
#pragma unroll
            for (int n = 0; n < 2; ++n) gv[bj][n] = *(const f32x4*)(gp + col0 + bj * HALF + n * 16);
#pragma unroll
        for (int ai = 0; ai < 2; ++ai)
#pragma unroll
            for (int m = 0; m < 4; ++m) { float* rowp = X + (size_t)(row0 + ai * HALF + m * 16) * D + col0;
#pragma unroll
                for (int bj = 0; bj < 2; ++bj)
#pragma unroll
                    for (int n = 0; n < 2; ++n) { f32x4* p = (f32x4*)(rowp + bj * HALF + n * 16); *p = *p + gv[bj][n] * acc[ai][bj][m][n]; } }
    }
};
}

namespace att {
#define KSWZ(row, colB) ((row) * 256 + ((colB) ^ (((row) & 7) << 4)))
#define KRSWZ(row, colB) ((row) * 128 + ((colB) ^ ((((row) >> 1) & 7) << 4)))
#define SBAR() __builtin_amdgcn_sched_barrier(0)
__device__ __forceinline__ int crow(int r, int hi) { return (r & 3) + 8 * (r >> 2) + 4 * hi; }
__host__ __device__ __forceinline__ int v_st(int k, int c) { const int kk = (k & ~0xC) | ((k & 4) << 1) | ((k & 8) >> 1); return ((kk >> 3) * 4 + (c >> 5)) * 512 + ((kk & 7) * 32 + (c & 31)) * 2; }
__device__ __forceinline__ int v_rd_base(int lane) { return ((lane & 3) << 3) | (((lane >> 2) & 3) << 6) | (((lane >> 4) & 1) << 5) | (((lane >> 5) & 1) << 8); }
constexpr int v_rd_off(int d0, int ks, int half) { return d0 * 512 + ks * 4096 + half * 2048; }
template <int OFF> __device__ __forceinline__ s16x4 tr_read(int vb) {
    s16x4 r; asm volatile("ds_read_b64_tr_b16 %0, %1 offset:%2" : "=&v"(r) : "v"(vb), "i"(OFF) : "memory"); return r;
}
template <int D0> __device__ __forceinline__ void pv_one(f32x16& od, int vb, bf16x8 pa0, bf16x8 pa1, bf16x8 pa2, bf16x8 pa3) {
    const s16x4 l0 = tr_read<v_rd_off(D0, 0, 0)>(vb), h0 = tr_read<v_rd_off(D0, 0, 1)>(vb), l1 = tr_read<v_rd_off(D0, 1, 0)>(vb), h1 = tr_read<v_rd_off(D0, 1, 1)>(vb);
    const s16x4 l2 = tr_read<v_rd_off(D0, 2, 0)>(vb), h2 = tr_read<v_rd_off(D0, 2, 1)>(vb), l3 = tr_read<v_rd_off(D0, 3, 0)>(vb), h3 = tr_read<v_rd_off(D0, 3, 1)>(vb);
    asm volatile("s_waitcnt lgkmcnt(0)" ::: "memory"); SBAR();
#define PK(L, H) (bf16x8){L[0], L[1], L[2], L[3], H[0], H[1], H[2], H[3]}
    od = __builtin_amdgcn_mfma_f32_32x32x16_bf16(pa0, PK(l0, h0), od, 0, 0, 0);
    od = __builtin_amdgcn_mfma_f32_32x32x16_bf16(pa1, PK(l1, h1), od, 0, 0, 0);
    od = __builtin_amdgcn_mfma_f32_32x32x16_bf16(pa2, PK(l2, h2), od, 0, 0, 0);
    od = __builtin_amdgcn_mfma_f32_32x32x16_bf16(pa3, PK(l3, h3), od, 0, 0, 0);
#undef PK
}
__device__ __forceinline__ void pv_d0(f32x16* o, int vb, bf16x8 pa0, bf16x8 pa1, bf16x8 pa2, bf16x8 pa3) {
    pv_one<0>(o[0], vb, pa0, pa1, pa2, pa3); pv_one<1>(o[1], vb, pa0, pa1, pa2, pa3); pv_one<2>(o[2], vb, pa0, pa1, pa2, pa3); pv_one<3>(o[3], vb, pa0, pa1, pa2, pa3);
}
}

namespace att8 {
constexpr int SLOT = 20480, KN_OFF = 0, KR_OFF = 8192, V_OFF = 12288, LDS_BYTES = 3 * SLOT + 8 * 256;
constexpr float THR2 = 8.0f;
constexpr float QUP = 8.f; constexpr int SC_ONE = 0x7f7f7f7f, SC_Q = 0x7c7c7c7c;
__host__ __device__ __forceinline__ int kn8(int key, int b) { return key * 128 + ((((b >> 4) ^ ((key >> 1) & 7))) << 4) + (b & 15); }
__host__ __device__ __forceinline__ int kr8(int key, int b) { return key * 64 + ((((b >> 4) ^ ((key >> 2) & 3))) << 4) + (b & 15); }
__host__ __device__ __forceinline__ int vslot(int k) { return 32 * ((k >> 2) & 1) + 16 * (k >> 5) + (k & 3) + 4 * ((k & 31) >> 3); }
__host__ __device__ __forceinline__ int v8(int d, int k) { const int sl = vslot(k); return d * 64 + ((((sl >> 4) ^ ((d >> 2) & 3))) << 4) + (sl & 15); }
__device__ __forceinline__ i32x8 ld32(const LAS unsigned char* a0, const LAS unsigned char* a1) { const u32x4 x = *(const LAS u32x4*)a0, y = *(const LAS u32x4*)a1;
    return (i32x8){(int)x.x, (int)x.y, (int)x.z, (int)x.w, (int)y.x, (int)y.y, (int)y.z, (int)y.w}; }
__device__ __forceinline__ void qkt(f32x16& p0, f32x16& p1, LAS unsigned char* slot, const i32x8* qf, int r32, int hi) {
    p0 = f32x16{}; p1 = f32x16{};
#pragma unroll
    for (int ks = 0; ks < 2; ++ks) { const int b = 64 * ks + 32 * hi;
        const i32x8 a0 = ld32(slot + KN_OFF + kn8(r32, b), slot + KN_OFF + kn8(r32, b + 16)), a1 = ld32(slot + KN_OFF + kn8(32 + r32, b), slot + KN_OFF + kn8(32 + r32, b + 16));
        p0 = __builtin_amdgcn_mfma_scale_f32_32x32x64_f8f6f4(a0, qf[ks], p0, 0, 0, 0, SC_ONE, 0, SC_Q);
        p1 = __builtin_amdgcn_mfma_scale_f32_32x32x64_f8f6f4(a1, qf[ks], p1, 0, 0, 0, SC_ONE, 0, SC_Q); }
    { const int b = 32 * hi;
        const i32x8 a0 = ld32(slot + KR_OFF + kr8(r32, b), slot + KR_OFF + kr8(r32, b + 16)), a1 = ld32(slot + KR_OFF + kr8(32 + r32, b), slot + KR_OFF + kr8(32 + r32, b + 16));
        p0 = __builtin_amdgcn_mfma_scale_f32_32x32x64_f8f6f4(a0, qf[2], p0, 0, 0, 0, SC_ONE, 0, SC_Q);
        p1 = __builtin_amdgcn_mfma_scale_f32_32x32x64_f8f6f4(a1, qf[2], p1, 0, 0, 0, SC_ONE, 0, SC_Q); }
}
__device__ __forceinline__ void partialSM(f32x16& p0, f32x16& p1, float& m_reg, float& mn, float& alpha) {
    float pmax = p0[0];
#pragma unroll
    for (int r = 1; r < 16; ++r) pmax = fmaxf(pmax, p0[r]);
#pragma unroll
    for (int r = 0; r < 16; ++r) pmax = fmaxf(pmax, p1[r]);
    { auto rr = __builtin_amdgcn_permlane32_swap(__float_as_uint(pmax), __float_as_uint(pmax), false, false);
      pmax = fmaxf(__uint_as_float(rr[0]), __uint_as_float(rr[1])); }
    if (__builtin_expect(__all(pmax - m_reg <= THR2), 1)) { mn = m_reg; alpha = 1.f; }
    else { mn = fmaxf(m_reg, pmax); alpha = __builtin_amdgcn_exp2f(m_reg - mn); m_reg = mn; }
#pragma unroll
    for (int r = 0; r < 16; ++r) p0[r] = __builtin_amdgcn_exp2f(p0[r] - mn);
#pragma unroll
    for (int r = 0; r < 16; ++r) p1[r] = p1[r] - mn;
}
__device__ __forceinline__ void finishSM(f32x16& p0, f32x16& p1, float alpha, float& l_reg, i32x8& pf) {
#pragma unroll
    for (int r = 0; r < 16; ++r) p1[r] = __builtin_amdgcn_exp2f(p1[r]);
    float ps = 0;
#pragma unroll
    for (int r = 0; r < 16; ++r) ps += p0[r];
#pragma unroll
    for (int r = 0; r < 16; ++r) ps += p1[r];
    { auto rr = __builtin_amdgcn_permlane32_swap(__float_as_uint(ps), __float_as_uint(ps), false, false);
      ps = __uint_as_float(rr[0]) + __uint_as_float(rr[1]); }
    l_reg = l_reg * alpha + ps;
#pragma unroll
    for (int w = 0; w < 4; ++w) { pf[w] = (int)pk4_fp8(p0[4 * w], p0[4 * w + 1], p0[4 * w + 2], p0[4 * w + 3]); pf[4 + w] = (int)pk4_fp8(p1[4 * w], p1[4 * w + 1], p1[4 * w + 2], p1[4 * w + 3]); }
}
__device__ __forceinline__ void pv(f32x16* o, LAS unsigned char* slot, const i32x8 pf, int r32, int hi) {
#pragma unroll
    for (int d0 = 0; d0 < 4; ++d0) { const int d = 32 * d0 + r32, sw = (d >> 2) & 3;
        const i32x8 b = ld32(slot + V_OFF + d * 64 + (((2 * hi) ^ sw) << 4), slot + V_OFF + d * 64 + (((2 * hi + 1) ^ sw) << 4));
        o[d0] = __builtin_amdgcn_mfma_scale_f32_32x32x64_f8f6f4(pf, b, o[d0], 0, 0, 0, SC_ONE, 0, SC_ONE); }
}
__device__ __forceinline__ int crow(int r, int hi) { return (r & 3) + 8 * (r >> 2) + 4 * hi; }
__device__ __forceinline__ void attn_unit(const unsigned char* __restrict__ Qb, const unsigned char* __restrict__ KNt, const unsigned char* __restrict__ KRt, const unsigned char* __restrict__ Vt,
                                          bf16_t* __restrict__ Ob, int NT, LAS unsigned char* lds) {
    const int tid = otid(), wid = __builtin_amdgcn_readfirstlane(tid >> 6), lane = tid & 63, r32 = lane & 31, hi = lane >> 5;
    LAS float* wsf = (LAS float*)(lds + 3 * SLOT) + wid * 64; LAS float* li_l = wsf; LAS float* al_l = wsf + 32;
    float m_reg = -1e30f, l_reg = 0; f32x16 o[4] = {}; i32x8 qf[3];
    const unsigned char* Qw = Qb + (size_t)(wid * 32 + r32) * 192 + 32 * hi;
#pragma unroll
    for (int ks = 0; ks < 3; ++ks) { const u32x4 x = *(const u32x4*)(Qw + 64 * ks), y = *(const u32x4*)(Qw + 64 * ks + 16); qf[ks] = (i32x8){(int)x.x, (int)x.y, (int)x.z, (int)x.w, (int)y.x, (int)y.y, (int)y.z, (int)y.w}; }
    const unsigned lo16 = (unsigned)lane * 16u;
#define ATT_DMA(tile, slotoff) do { const size_t t_ = (size_t)(tile); LAS unsigned char* sl_ = lds + (slotoff); \
        __builtin_amdgcn_global_load_lds((const unsigned*)(KNt + t_ * 8192 + wid * 1024 + lo16), (LAS unsigned*)(sl_ + KN_OFF + wid * 1024), 16, 0, 0); \
        __builtin_amdgcn_global_load_lds((const unsigned*)(Vt + t_ * 8192 + wid * 1024 + lo16), (LAS unsigned*)(sl_ + V_OFF + wid * 1024), 16, 0, 0); \
        if (wid < 4) __builtin_amdgcn_global_load_lds((const unsigned*)(KRt + t_ * 4096 + wid * 1024 + lo16), (LAS unsigned*)(sl_ + KR_OFF + wid * 1024), 16, 0, 0); } while (0)
#define ATT_SYNC() do { asm volatile("s_waitcnt vmcnt(0)" ::: "memory"); __builtin_amdgcn_s_barrier(); asm volatile("" ::: "memory"); } while (0)
#define RESC(a) do { if (__any((a) < 1.f)) { if (hi == 0) al_l[r32] = (a); asm volatile("s_waitcnt lgkmcnt(0)" ::: "memory"); \
        _Pragma("unroll") for (int d = 0; d < 4; ++d) _Pragma("unroll") for (int r = 0; r < 16; ++r) o[d][r] *= al_l[crow(r, hi)]; } } while (0)
    f32x16 pA0, pA1, pB0, pB1; float mnA, mnB, alA, alB; i32x8 pf;
    int sp = 0, sc = SLOT, sn = 2 * SLOT;
    ATT_DMA(0, 0);
    ATT_SYNC();
    ATT_DMA(1, SLOT);
    qkt(pA0, pA1, lds, qf, r32, hi); partialSM(pA0, pA1, m_reg, mnA, alA);
    for (int j = 1; j + 1 < NT; j += 2) {
        ATT_SYNC(); ATT_DMA(j + 1, sn);
        SBAR(); qkt(pB0, pB1, lds + sc, qf, r32, hi);
        finishSM(pA0, pA1, alA, l_reg, pf); SBAR();
        pv(o, lds + sp, pf, r32, hi); partialSM(pB0, pB1, m_reg, mnB, alB);
        RESC(alB);
        { const int t_ = sp; sp = sc; sc = sn; sn = t_; }
        ATT_SYNC(); if (j + 2 < NT) ATT_DMA(j + 2, sn);
        SBAR(); qkt(pA0, pA1, lds + sc, qf, r32, hi);
        finishSM(pB0, pB1, alB, l_reg, pf); SBAR();
        pv(o, lds + sp, pf, r32, hi); partialSM(pA0, pA1, m_reg, mnA, alA);
        RESC(alA);
        { const int t_ = sp; sp = sc; sc = sn; sn = t_; }
    }
    ATT_SYNC();
    SBAR(); qkt(pB0, pB1, lds + sc, qf, r32, hi);
    finishSM(pA0, pA1, alA, l_reg, pf); SBAR();
    pv(o, lds + sp, pf, r32, hi); partialSM(pB0, pB1, m_reg, mnB, alB);
    RESC(alB);
    finishSM(pB0, pB1, alB, l_reg, pf); SBAR();
    pv(o, lds + sc, pf, r32, hi);
    if (hi == 0) li_l[r32] = l_reg; asm volatile("s_waitcnt lgkmcnt(0)" ::: "memory");
    float rli[16];
#pragma unroll
    for (int r = 0; r < 16; ++r) rli[r] = __builtin_amdgcn_rcpf(li_l[crow(r, hi)]);
    bf16_t* Ow = Ob + (size_t)(wid * 32) * 2048;
#pragma unroll
    for (int r = 0; r < 16; ++r) { const int orow = crow(r, hi);
#pragma unroll
        for (int d0 = 0; d0 < 4; ++d0) Ow[(size_t)orow * 2048 + d0 * 32 + r32] = f2bf(o[d0][r] * rli[r]); }
    __builtin_amdgcn_s_barrier(); asm volatile("" ::: "memory");
#undef ATT_DMA
#undef ATT_SYNC
#undef RESC
}
}

namespace ssd {
constexpr int XT_OFF = 0, BT_OFF = 17408, HB_OFF = 52224, SET = 69632, CW_OFF = 2 * SET, LDS_BYTES = CW_OFF + 8 * 1536;
constexpr int PITCH = 272;
constexpr float L2E = 1.4426950408889634f;
__device__ __forceinline__ void g_unit(const bf16_t* __restrict__ BC, bf16_t* __restrict__ G, int unit) {
    const int cid = unit >> 1, g = unit & 1;
    const int r0 = cid < 256 ? cid * 128 : NLAT + (cid - 256) * 128;
    const int tid = otid(), wid = tid >> 6, lane = tid & 63, fr = lane & 15, fq = lane >> 4;
    const bf16_t* Cp = BC + (size_t)(r0 + 16 * wid + fr) * 512 + 256 + 128 * g + 8 * fq;
    bf16x8 cf[4];
#pragma unroll
    for (int ks = 0; ks < 4; ++ks) cf[ks] = *(const bf16x8*)(Cp + 32 * ks);
    bf16_t* Gp = G + ((size_t)unit * 128 + 16 * wid + fr) * 128 + 4 * fq;
#pragma unroll
    for (int sb = 0; sb < 8; ++sb) {
        const bf16_t* Bp = BC + (size_t)(r0 + 16 * sb + fr) * 512 + 128 * g + 8 * fq;
        f32x4 acc = {0.f, 0.f, 0.f, 0.f};
#pragma unroll
        for (int ks = 0; ks < 4; ++ks) { const bf16x8 bfr = *(const bf16x8*)(Bp + 32 * ks); acc = __builtin_amdgcn_mfma_f32_16x16x32_bf16(bfr, cf[ks], acc, 0, 0, 0); }
        u32x2 w; w.x = cvt_pk_bf16(acc[0], acc[1]); w.y = cvt_pk_bf16(acc[2], acc[3]);
        *(u32x2*)(Gp + 16 * sb) = w;
    }
}
__device__ __forceinline__ void ssd_unit(int b, int h, int d, const bf16_t* __restrict__ XS, const bf16_t* __restrict__ BC, const float* __restrict__ DT, const bf16_t* __restrict__ G,
                                         const float* __restrict__ a_log, bf16_t* __restrict__ Y, LAS unsigned char* lds) {
    const int g = h >> 3;
    const int tid = otid(), wid = tid >> 6, lane = tid & 63, fr = lane & 15, fq = lane >> 4;
    const float a = -__expf(a_log[d * 16 + h]);
    LAS float* cw = (LAS float*)(lds + CW_OFF + wid * 1536); LAS float* dts = cw + 128; LAS float* dtw = cw + 256;
    f32x4 hs[4];
#pragma unroll
    for (int q = 0; q < 4; ++q) hs[q] = (f32x4){0.f, 0.f, 0.f, 0.f};
    for (int i = tid; i < 17408 / 4; i += 512) ((LAS unsigned*)(lds + HB_OFF))[i] = 0u;
    float cend = 0.f;
#define SSD_ROWS(step, r0v, gidv) do { if ((step) < 2) { const int oc_ = d ? 1 - (step) : (step); r0v = NLAT + b * 256 + oc_ * 128; gidv = 256 + b * 2 + oc_; } \
        else { const int lc_ = (step) - 2, oc_ = d ? 63 - lc_ : lc_; r0v = b * 8192 + oc_ * 128; gidv = b * 64 + oc_; } } while (0)
    const int sg = tid & 31, n8 = tid >> 5, p4 = tid >> 5;
    f32x2 P_da, Q_da; u32x2 P_xv[4], Q_xv[4]; u32x4 P_bv[4], Q_bv[4], n_gv[4], n_cv[4], c_gv[4], c_cv[4];
#define SSD_LOAD(step, X) do { int r0_, gid_; SSD_ROWS(step, r0_, gid_); (void)gid_; X##_da = *(const f32x2*)(DT + (size_t)(d * 16 + h) * NROW + r0_ + 2 * lane); \
        _Pragma("unroll") for (int j_ = 0; j_ < 4; ++j_) { X##_xv[j_] = *(const u32x2*)(XS + (size_t)(r0_ + 4 * sg + j_) * 1024 + 64 * h + 4 * p4); \
                                                         X##_bv[j_] = *(const u32x4*)(BC + (size_t)(r0_ + 4 * sg + j_) * 512 + 128 * g + 8 * n8); } } while (0)
#define SSD_LOADGC(step) do { int r0_, gid_; SSD_ROWS(step, r0_, gid_); const int t_ = 16 * wid + fr; const bf16_t* Gp_ = G + ((size_t)(gid_ * 2 + g) * 128 + t_) * 128 + 8 * fq; const bf16_t* Cp_ = BC + (size_t)(r0_ + t_) * 512 + 256 + 128 * g + 8 * fq; \
          _Pragma("unroll") for (int ks_ = 0; ks_ < 4; ++ks_) { n_gv[ks_] = *(const u32x4*)(Gp_ + 32 * ks_); n_cv[ks_] = *(const u32x4*)(Cp_ + 32 * ks_); } } while (0)
#define SSD_GCROT() do { _Pragma("unroll") for (int ks_ = 0; ks_ < 4; ++ks_) { c_gv[ks_] = n_gv[ks_]; c_cv[ks_] = n_cv[ks_]; } } while (0)
#define SSD_WRITE(step, X) do { LAS unsigned char* set_ = lds + ((step) & 1) * SET; \
        const float da0 = X##_da.x * a, da1 = X##_da.y * a; \
        float sc_ = da0 + da1; float c0_, c1_; \
        if (d == 0) { _Pragma("unroll") for (int o_ = 1; o_ < 64; o_ <<= 1) { const float t_ = __shfl_up(sc_, o_); if (lane >= o_) sc_ += t_; } \
            c0_ = sc_ - da1; c1_ = sc_; cend = __shfl(sc_, 63); } \
        else { _Pragma("unroll") for (int o_ = 1; o_ < 64; o_ <<= 1) { const float t_ = __shfl_down(sc_, o_); if (lane + o_ < 64) sc_ += t_; } \
            c0_ = sc_; c1_ = sc_ - da0; cend = __shfl(sc_, 0); } \
        *(LAS f32x2*)(cw + 2 * lane) = (f32x2){c0_, c1_}; *(LAS f32x2*)(dts + 2 * lane) = X##_da; \
        *(LAS f32x2*)(dtw + 2 * lane) = (f32x2){X##_da.x * __builtin_amdgcn_exp2f((cend - c0_) * L2E), X##_da.y * __builtin_amdgcn_exp2f((cend - c1_) * L2E)}; \
        { LAS unsigned char* xt_ = set_ + XT_OFF + (4 * p4) * PITCH + 8 * sg; \
          _Pragma("unroll") for (int i_ = 0; i_ < 4; ++i_) { unsigned e_[4]; \
              _Pragma("unroll") for (int j_ = 0; j_ < 4; ++j_) { const unsigned w_ = (i_ & 2) ? X##_xv[j_].y : X##_xv[j_].x; e_[j_] = (i_ & 1) ? (w_ >> 16) : (w_ & 0xffffu); } \
              u32x2 o_; o_.x = e_[0] | (e_[1] << 16); o_.y = e_[2] | (e_[3] << 16); *(LAS u32x2*)(xt_ + i_ * PITCH) = o_; } } \
        { LAS unsigned char* bt_ = set_ + BT_OFF + (8 * n8) * PITCH + 8 * sg; \
          _Pragma("unroll") for (int i_ = 0; i_ < 8; ++i_) { unsigned e_[4]; \
              _Pragma("unroll") for (int j_ = 0; j_ < 4; ++j_) { const unsigned w_ = X##_bv[j_][i_ >> 1]; e_[j_] = (i_ & 1) ? (w_ >> 16) : (w_ & 0xffffu); } \
              u32x2 o_; o_.x = e_[0] | (e_[1] << 16); o_.y = e_[2] | (e_[3] << 16); *(LAS u32x2*)(bt_ + i_ * PITCH) = o_; } } \
        asm volatile("s_waitcnt lgkmcnt(0)" ::: "memory"); \
    } while (0)
    SSD_LOAD(0, Q); SSD_LOADGC(0); SSD_WRITE(0, Q); SSD_LOAD(1, P);
    for (int step2 = 0; step2 < 66; step2 += 2)
#pragma unroll
    for (int par = 0; par < 2; ++par) {
        const int step = step2 + par;
        __syncthreads();
        int r0, gid; SSD_ROWS(step, r0, gid); (void)gid;
        LAS unsigned char* set = lds + (step & 1) * SET;
        const float cend_cur = cend;
        SSD_GCROT();
        if (step + 1 < 66) SSD_LOADGC(step + 1);
        if (step + 2 < 66) { if (par == 0) SSD_LOAD(step + 2, Q); else SSD_LOAD(step + 2, P); }
        {
            const int t = 16 * wid + fr; const float ct = cw[t];
            f32x4 y[4];
#pragma unroll
            for (int q = 0; q < 4; ++q) y[q] = (f32x4){0.f, 0.f, 0.f, 0.f};
            const float et = __builtin_amdgcn_exp2f(ct * L2E);
#pragma unroll
            for (int ks = 0; ks < 4; ++ks) {
                const bool live = d == 0 ? (32 * ks <= 16 * wid + 15) : (32 * ks + 31 >= 16 * wid);
                if (live) {
                    const int s0 = 32 * ks + 8 * fq;
                    const f32x4 c0 = *(const LAS f32x4*)(cw + s0), c1 = *(const LAS f32x4*)(cw + s0 + 4), d0v = *(const LAS f32x4*)(dts + s0), d1v = *(const LAS f32x4*)(dts + s0 + 4);
                    float m[8];
#pragma unroll
                    for (int i = 0; i < 8; ++i) { const float cs = i < 4 ? c0[i & 3] : c1[i & 3], dv = i < 4 ? d0v[i & 3] : d1v[i & 3]; const int s = s0 + i;
                        const bool ok = d == 0 ? (s <= t) : (s >= t);
                        const float gval = (i & 1) ? bfhi(c_gv[ks][i >> 1]) : bflo(c_gv[ks][i >> 1]);
                        m[i] = ok ? gval * dv * __builtin_amdgcn_exp2f((ct - cs) * L2E) : 0.f; }
                    u32x4 mw; mw.x = cvt_pk_bf16(m[0], m[1]); mw.y = cvt_pk_bf16(m[2], m[3]); mw.z = cvt_pk_bf16(m[4], m[5]); mw.w = cvt_pk_bf16(m[6], m[7]);
                    const bf16x8 mb = __builtin_bit_cast(bf16x8, mw);
#pragma unroll
                    for (int q = 0; q < 4; ++q) { const bf16x8 af = *(const LAS bf16x8*)(set + XT_OFF + (16 * q + fr) * PITCH + (32 * ks + 8 * fq) * 2);
                        y[q] = __builtin_amdgcn_mfma_f32_16x16x32_bf16(af, mb, y[q], 0, 0, 0); }
                }
            }
#pragma unroll
            for (int ks = 0; ks < 4; ++ks) {
                u32x4 cwv;
#pragma unroll
                for (int i = 0; i < 4; ++i) cwv[i] = cvt_pk_bf16(bflo(c_cv[ks][i]) * et, bfhi(c_cv[ks][i]) * et);
                const bf16x8 cb = __builtin_bit_cast(bf16x8, cwv);
#pragma unroll
                for (int q = 0; q < 4; ++q) { const bf16x8 af = *(const LAS bf16x8*)(set + HB_OFF + (16 * q + fr) * PITCH + (32 * ks + 8 * fq) * 2);
                    y[q] = __builtin_amdgcn_mfma_f32_16x16x32_bf16(af, cb, y[q], 0, 0, 0); }
            }
            bf16_t* yp = Y + (size_t)(r0 + t) * 1024 + 64 * h + 4 * fq;
#pragma unroll
            for (int q = 0; q < 4; ++q) { u32x2 w; w.x = cvt_pk_bf16(y[q][0], y[q][1]); w.y = cvt_pk_bf16(y[q][2], y[q][3]); *(u32x2*)(yp + 16 * q) = w; }
        }
        {
            const float dec = __builtin_amdgcn_exp2f(cend_cur * L2E);
#pragma unroll
            for (int q = 0; q < 4; ++q) hs[q] = hs[q] * dec;
#pragma unroll
            for (int ks = 0; ks < 4; ++ks) {
                const int s0 = 32 * ks + 8 * fq;
                const u32x4 braw = *(const LAS u32x4*)(set + BT_OFF + (16 * wid + fr) * PITCH + s0 * 2);
                const f32x4 w0 = *(const LAS f32x4*)(dtw + s0), w1 = *(const LAS f32x4*)(dtw + s0 + 4);
                u32x4 bw; bw.x = cvt_pk_bf16(bflo(braw.x) * w0[0], bfhi(braw.x) * w0[1]); bw.y = cvt_pk_bf16(bflo(braw.y) * w0[2], bfhi(braw.y) * w0[3]);
                          bw.z = cvt_pk_bf16(bflo(braw.z) * w1[0], bfhi(braw.z) * w1[1]); bw.w = cvt_pk_bf16(bflo(braw.w) * w1[2], bfhi(braw.w) * w1[3]);
                const bf16x8 bfr = __builtin_bit_cast(bf16x8, bw);
#pragma unroll
                for (int q = 0; q < 4; ++q) { const bf16x8 af = *(const LAS bf16x8*)(set + XT_OFF + (16 * q + fr) * PITCH + s0 * 2);
                    hs[q] = __builtin_amdgcn_mfma_f32_16x16x32_bf16(af, bfr, hs[q], 0, 0, 0); }
            }
            LAS bf16_t* hb = (LAS bf16_t*)(lds + ((step + 1) & 1) * SET + HB_OFF) + 16 * wid + fr;
#pragma unroll
            for (int q = 0; q < 4; ++q)
#pragma unroll
                for (int i = 0; i < 4; ++i) hb[(16 * q + 4 * fq + i) * 136] = f2bf(hs[q][i]);
        }
        if (step + 1 < 66) { if (par == 0) SSD_WRITE(step + 1, P); else SSD_WRITE(step + 1, Q); }
    }
    __syncthreads();
#undef SSD_ROWS
#undef SSD_LOAD
#undef SSD_LOADGC
#undef SSD_GCROT
#undef SSD_WRITE
}
}

struct Args { const float* in[32]; float* out; unsigned char* ws; int ph_lo, ph_hi; };
constexpr int NTHR = 512;
constexpr int LDS_BASE = 256;
constexpr int LDS_PHASE = 151808;
constexpr int LDS_BYTES = LDS_BASE + LDS_PHASE;
static_assert(att8::LDS_BYTES <= LDS_PHASE && ssd::LDS_BYTES <= LDS_PHASE && pg8::STAGE_BYTES <= LDS_PHASE, "LDS");

__device__ __forceinline__ void tjob(int j, const Args& A, const float*& src, bf16_t*& dst, int& K, int& N, int& Npad, int& mode, const float*& ks) {
    unsigned char* W = A.ws + WS_W; mode = 0; ks = nullptr;
    if (j < 8) { const int i = j >> 2, w = j & 3; unsigned char* base = W + W_HYB + (size_t)i * WH_SZ;
        if (w == 0)      { src = A.in[I_HWIN] + (size_t)i * 1024 * HYB_IN; dst = (bf16_t*)(base + WH_IN); K = 1024; N = HYB_IN; Npad = HYB_INP; mode = 1; }
        else if (w == 1) { src = A.in[I_WQB] + (size_t)i * 384 * 1536; dst = (bf16_t*)(base + WH_QB); K = 384; N = 1536; Npad = 1536; mode = 2; ks = A.in[I_QNG] + i * 384; }
        else if (w == 2) { src = A.in[I_WKVB] + (size_t)i * 256 * 2048; dst = (bf16_t*)(base + WH_KVB); K = 256; N = 2048; Npad = 2048; ks = A.in[I_KVNG] + i * 256; }
        else             { src = A.in[I_HWOUT] + (size_t)i * 2048 * 1024; dst = (bf16_t*)(base + WH_OUT); K = 2048; N = 1024; Npad = 1024; }
    } else if (j < 12) { const int i = (j - 8) >> 1, w = (j - 8) & 1; unsigned char* base = W + W_GM + (size_t)i * WG_SZ;
        if (w == 0) { src = A.in[I_GWIN] + (size_t)i * 1024 * 4096; dst = (bf16_t*)(base + WG_IN); K = 1024; N = 4096; Npad = 4096; }
        else        { src = A.in[I_GWOUT] + (size_t)i * 2048 * 1024; dst = (bf16_t*)(base + WG_OUT); K = 2048; N = 1024; Npad = 1024; }
    } else { const int l = j - 12; src = A.in[I_PWQ] + (size_t)l * 1024 * 2048; dst = (bf16_t*)(W + W_PEER + (size_t)l * WP_SZ + WP_Q); K = 1024; N = 2048; Npad = 2048; }
}
__device__ __forceinline__ int colmap(int mode, int n, int N) {
    if (mode == 1) { if (n >= N) return -1; if (n < C_KR) return n; const int m = n - C_KR; return C_KR + (m >> 1) + 32 * (m & 1); }
    if (mode == 2) { if (n < 1024) return (n >> 7) * 192 + (n & 127); const int m = n - 1024, h = m >> 6, mm = m & 63; return h * 192 + 128 + (mm >> 1) + 32 * (mm & 1); }
    return n;
}
__device__ __forceinline__ void phase_prologue(const Args& A, LAS unsigned char* lds) {
    const int tid = otid();
    {
        LAS float* tile = (LAS float*)lds;
        int item = blockIdx.x;
        for (int j = 0; j < 16; ++j) {
            const float* src; bf16_t* dst; int K, N, Npad, mode; const float* ks; tjob(j, A, src, dst, K, N, Npad, mode, ks);
            const int nsub = (K % 256 == 0) ? 4 : 2, tk = K / (64 * nsub), tn = Npad / 64, nt = tk * tn;
            for (; item < nt; item += gridDim.x) {
                const int k0 = (item % tk) * 64 * nsub, n0 = (item / tk) * 64;
                { const int k = tid >> 3, cg = tid & 7; float v[4][8];
#pragma unroll
                  for (int t = 0; t < 4; ++t) if (t < nsub) { const float sc = ks ? ks[k0 + 64 * t + k] : 1.f;
#pragma unroll
                      for (int jj = 0; jj < 8; ++jj) { const int oc = colmap(mode, n0 + 8 * cg + jj, N); v[t][jj] = oc >= 0 ? src[(size_t)(k0 + 64 * t + k) * N + oc] * sc : 0.f; } }
#pragma unroll
                  for (int t = 0; t < 4; ++t) if (t < nsub) {
#pragma unroll
                      for (int jj = 0; jj < 8; ++jj) tile[t * 4160 + k * 65 + 8 * cg + jj] = v[t][jj]; } }
                __syncthreads();
                { const int n = tid >> 3, kg = tid & 7;
#pragma unroll
                  for (int t = 0; t < 4; ++t) if (t < nsub) { float v[8];
#pragma unroll
                      for (int jj = 0; jj < 8; ++jj) v[jj] = tile[t * 4160 + (8 * kg + jj) * 65 + n];
                      u32x4 w; w.x = cvt_pk_bf16(v[0], v[1]); w.y = cvt_pk_bf16(v[2], v[3]); w.z = cvt_pk_bf16(v[4], v[5]); w.w = cvt_pk_bf16(v[6], v[7]);
                      *(u32x4*)(dst + (size_t)(n0 + n) * K + k0 + 64 * t + 8 * kg) = w; } }
                __syncthreads();
            }
            item -= nt;
        }
    }
    {
        const int gthr = blockIdx.x * NTHR + tid, nthr = gridDim.x * NTHR;
        for (int p = gthr; p < 10 * 16384; p += nthr) {
            const int mat = p >> 14, off = (p & 16383) * 8; const float* src; bf16_t* dst;
            if (mat < 2)      { src = A.in[I_GWS] + (size_t)mat * 131072; dst = (bf16_t*)(A.ws + WS_W + W_GM + (size_t)mat * WG_SZ + WG_WS); }
            else if (mat < 6) { src = A.in[I_PK1] + (size_t)(mat - 2) * 131072; dst = (bf16_t*)(A.ws + WS_W + W_PEER + (size_t)(mat - 2) * WP_SZ + WP_K1); }
            else              { src = A.in[I_PK2] + (size_t)(mat - 6) * 131072; dst = (bf16_t*)(A.ws + WS_W + W_PEER + (size_t)(mat - 6) * WP_SZ + WP_K2); }
            const f32x4 a = *(const f32x4*)(src + off), b = *(const f32x4*)(src + off + 4);
            u32x4 w; w.x = cvt_pk_bf16(a[0], a[1]); w.y = cvt_pk_bf16(a[2], a[3]); w.z = cvt_pk_bf16(b[0], b[1]); w.w = cvt_pk_bf16(b[2], b[3]);
            *(u32x4*)(dst + off) = w;
        }
        float* rope = (float*)(A.ws + WS_ROPE);
        for (int p = gthr; p < SEQ * 32; p += nthr) { const int l = p >> 5, i = p & 31; const float pos = (float)(i < 16 ? (l >> 6) : (l & 63));
            const float inv = powf(10000.f, -(float)(i & 15) / 16.f), ang = pos * inv; rope[p] = cosf(ang); rope[SEQ * 32 + p] = sinf(ang); }
    }
    {
        LAS float* scond = (LAS float*)lds;
        LAS float* red = scond + 5 * 1024;
        __syncthreads();
        for (int i = tid; i < 5 * 1024; i += NTHR) { const int m = i >> 10, k = i & 1023; const float c = m < 4 ? A.in[I_C][m * 1024 + k] : A.in[I_CCTX][k]; scond[i] = silu_f(c); }
        __syncthreads();
        float* MOD = (float*)(A.ws + WS_MOD);
        for (int item = blockIdx.x; item < 4 * 48; item += gridDim.x) {
            const int layer = item / 48, j0 = (item % 48) * 128; const int c4 = tid & 31, ksl = tid >> 5;
            f32x4 acc[5];
#pragma unroll
            for (int m = 0; m < 5; ++m) acc[m] = (f32x4){0.f, 0.f, 0.f, 0.f};
            const float* wp = A.in[I_ADAW] + ((size_t)layer * 1024 + ksl * 64) * 6144 + j0 + 4 * c4;
            for (int k = 0; k < 64; ++k) { const f32x4 w = *(const f32x4*)(wp + (size_t)k * 6144);
#pragma unroll
                for (int m = 0; m < 5; ++m) acc[m] += w * scond[m * 1024 + ksl * 64 + k]; }
#pragma unroll
            for (int m = 0; m < 5; ++m) *(LAS f32x4*)(red + (ksl * 5 + m) * 128 + 4 * c4) = acc[m];
            __syncthreads();
            for (int i = tid; i < 640; i += NTHR) { const int m = i >> 7, c = i & 127; float s = A.in[I_ADAB][layer * 6144 + j0 + c];
#pragma unroll
                for (int q = 0; q < 16; ++q) s += red[(q * 5 + m) * 128 + c];
                MOD[((size_t)layer * 5 + m) * 6144 + j0 + c] = s; }
            __syncthreads();
        }
    }
}

__device__ __forceinline__ void phase_norm_mod(const float* xl, const float* xc, float* cl, float* cc, const float* g, const float* modl, int sh_idx, bf16_t* H, int nrows) {
    const int tid_ = otid(); const int lane = tid_ & 63, gw = blockIdx.x * 8 + (tid_ >> 6), nw = gridDim.x * 8;
    f32x4 gv[4];
#pragma unroll
    for (int i = 0; i < 4; ++i) gv[i] = *(const f32x4*)(g + 256 * i + 4 * lane);
    for (int r = gw; r < nrows; r += nw) {
        const bool lat = r < NLAT; const float* xp = lat ? xl + (size_t)r * D : xc + (size_t)(r - NLAT) * D;
        f32x4 x[4]; float ss = 0.f;
#pragma unroll
        for (int i = 0; i < 4; ++i) { x[i] = *(const f32x4*)(xp + 256 * i + 4 * lane); ss += x[i][0] * x[i][0] + x[i][1] * x[i][1] + x[i][2] * x[i][2] + x[i][3] * x[i][3]; }
        if (cl) { float* cp = lat ? cl + (size_t)r * D : cc + (size_t)(r - NLAT) * D;
#pragma unroll
            for (int i = 0; i < 4; ++i) *(f32x4*)(cp + 256 * i + 4 * lane) = x[i]; }
        ss = wave_sum(ss); const float rstd = rsqrtf(ss * (1.f / 1024.f) + EPS);
        const float* mp = modl + (size_t)(lat ? (r >> 13) : 4) * 6144 + sh_idx * 1024;
#pragma unroll
        for (int i = 0; i < 4; ++i) { const f32x4 sh = *(const f32x4*)(mp + 256 * i + 4 * lane), sc = *(const f32x4*)(mp + 1024 + 256 * i + 4 * lane);
            const f32x4 hv = (x[i] * rstd) * gv[i] * (sc + 1.f) + sh;
            u32x2 w; w.x = cvt_pk_bf16(hv[0], hv[1]); w.y = cvt_pk_bf16(hv[2], hv[3]);
            *(u32x2*)(H + (size_t)r * D + 256 * i + 4 * lane) = w; }
    }
}
__device__ __forceinline__ void phase_final_norm(float* xl, const float* g, float oscale) {
    const int tid_ = otid(); const int lane = tid_ & 63, gw = blockIdx.x * 8 + (tid_ >> 6), nw = gridDim.x * 8;
    f32x4 gv[4];
#pragma unroll
    for (int i = 0; i < 4; ++i) gv[i] = *(const f32x4*)(g + 256 * i + 4 * lane);
    for (int r = gw; r < NLAT; r += nw) {
        float* xp = xl + (size_t)r * D; f32x4 x[4]; float ss = 0.f;
#pragma unroll
        for (int i = 0; i < 4; ++i) { x[i] = *(const f32x4*)(xp + 256 * i + 4 * lane); ss += x[i][0] * x[i][0] + x[i][1] * x[i][1] + x[i][2] * x[i][2] + x[i][3] * x[i][3]; }
        ss = wave_sum(ss); const float rstd = rsqrtf(ss * (1.f / 1024.f) + EPS);
#pragma unroll
        for (int i = 0; i < 4; ++i) *(f32x4*)(xp + 256 * i + 4 * lane) = (x[i] * (rstd * oscale)) * gv[i];
    }
}

__device__ __forceinline__ void phase_conv(const Args& A, int li) {
    const bf16_t* PROJ = (const bf16_t*)(A.ws + WS_BIG);
    bf16_t* XS = (bf16_t*)(A.ws + WS_R2); bf16_t* BC = (bf16_t*)(A.ws + WS_R2 + R2_BC);
    const int tid = otid();
    {
        for (int item = blockIdx.x * 3; item < (NROW / 64) * 3; item += gridDim.x * 3)
#pragma unroll 1
        for (int sub = 0; sub < 3; ++sub) {
            const int blk = (item + sub) / 3, q = ((item + sub) % 3) * 512 + tid, cg = q % 192, rg = q / 192, c0 = 8 * cg;
            const int rbeg = blk * 64 + rg * 8; int s0, s1;
            if (rbeg < NLAT) { s0 = rbeg & ~8191; s1 = s0 + 8192; } else { s0 = NLAT + ((rbeg - NLAT) & ~255); s1 = s0 + 256; }
            const float* cw = A.in[I_CONVW] + ((size_t)li * 1536 + c0) * 5; const float* cb = A.in[I_CONVB] + (size_t)li * 1536 + c0;
            u32x4 in[12];
#pragma unroll
            for (int i = 0; i < 12; ++i) { const int r = rbeg - 2 + i; in[i] = (r >= s0 && r < s1) ? *(const u32x4*)(PROJ + (size_t)r * HYB_INP + C_XBC + c0) : (u32x4){0u, 0u, 0u, 0u}; }
            float w[8][5], bia[8];
#pragma unroll
            for (int j = 0; j < 8; ++j) { bia[j] = cb[j];
#pragma unroll
                for (int k = 0; k < 5; ++k) w[j][k] = cw[j * 5 + k]; }
#pragma unroll
            for (int rr = 0; rr < 8; ++rr) {
                float o[8];
#pragma unroll
                for (int j = 0; j < 8; ++j) { float sacc = bia[j];
#pragma unroll
                    for (int k = 0; k < 5; ++k) { const unsigned wd = in[rr + k][j >> 1]; sacc += w[j][k] * ((j & 1) ? bfhi(wd) : bflo(wd)); }
                    o[j] = silu_f(sacc); }
                u32x4 pk; pk.x = cvt_pk_bf16(o[0], o[1]); pk.y = cvt_pk_bf16(o[2], o[3]); pk.z = cvt_pk_bf16(o[4], o[5]); pk.w = cvt_pk_bf16(o[6], o[7]);
                const int r = rbeg + rr;
                if (c0 < 1024) *(u32x4*)(XS + (size_t)r * 1024 + c0) = pk; else *(u32x4*)(BC + (size_t)r * 512 + (c0 - 1024)) = pk;
            }
        }
    }
    {
        const int lane = tid & 63, gw = blockIdx.x * 8 + (tid >> 6), nw = gridDim.x * 8;
        float* DT = (float*)(A.ws + WS_BIG + BIG_DT); float* RQ = (float*)(A.ws + WS_RSTD); float* RKV = RQ + NROW;
        unsigned char* KR = A.ws + WS_BIG + BIG_KR; const float* rope = (const float*)(A.ws + WS_ROPE);
        const float dtb = lane < 32 ? A.in[I_DTB][li * 32 + lane] : 0.f;
        for (int rb = gw * 4; rb < NROW; rb += nw * 4) {
            unsigned wq[4][3]; u32x2 wk[4]; unsigned wr_[4]; float dtv[4], rc[4], rsn[4];
#pragma unroll
            for (int i = 0; i < 4; ++i) { const int r = rb + i; const bf16_t* p = PROJ + (size_t)r * HYB_INP;
                const unsigned* q = (const unsigned*)(p + C_CQ + 6 * lane); wq[i][0] = q[0]; wq[i][1] = q[1]; wq[i][2] = q[2];
                wk[i] = *(const u32x2*)(p + C_CKV + 4 * lane);
                dtv[i] = lane < 32 ? bf2f(p[C_DT + (lane & 15)]) : 0.f; wr_[i] = lane < 32 ? *(const unsigned*)(p + C_KR + 2 * lane) : 0u;
                const int l = r & 8191; rc[i] = (lane < 32 && r < NLAT) ? rope[l * 32 + lane] : 1.f; rsn[i] = (lane < 32 && r < NLAT) ? rope[SEQ * 32 + l * 32 + lane] : 0.f; }
#pragma unroll
            for (int i = 0; i < 4; ++i) { const int r = rb + i;
                if (lane < 32) DT[(size_t)lane * NROW + r] = softplus_f(dtv[i] + dtb);
                { float ss = 0.f;
#pragma unroll
                  for (int j = 0; j < 3; ++j) { const float a = bflo(wq[i][j]), b = bfhi(wq[i][j]); ss += a * a + b * b; }
                  ss = wave_sum(ss); if (lane == 0) RQ[r] = rsqrtf(ss * (1.f / 384.f) + EPS); }
                { const float a = bflo(wk[i].x), b = bfhi(wk[i].x), c = bflo(wk[i].y), d = bfhi(wk[i].y);
                  float ss = a * a + b * b + c * c + d * d; ss = wave_sum(ss); if (lane == 0) RKV[r] = rsqrtf(ss * (1.f / 256.f) + EPS); }
                if (lane < 32) { const float x1 = bflo(wr_[i]), x2 = bfhi(wr_[i]); int b, key;
                    const float o1 = x1 * rc[i] - x2 * rsn[i], o2 = x1 * rsn[i] + x2 * rc[i];
                    if (r < NLAT) { b = r >> 13; key = 256 + (r & 8191); } else { b = (r - NLAT) >> 8; key = (r - NLAT) & 255; }
                    int w8 = 0; w8 = __builtin_amdgcn_cvt_pk_fp8_f32(sat8(o1), sat8(o2), w8, false);
                    *(unsigned short*)(KR + (size_t)(b * NKT + (key >> 6)) * 4096 + att8::kr8(key & 63, 2 * lane)) = (unsigned short)(w8 & 0xffff); }
            }
        }
    }
}

struct EpiQ {
    static constexpr bool PERM = true;
    unsigned char* Q; const float* rstd; const float* rope;
    __device__ __forceinline__ void operator()(const f32x4 (&acc)[2][2][4][2], const pg8::Unit& u, int wr, int wc, int fr, int fq) const {
        const bool lat = u.pm < 128;
        const int b = lat ? (u.pm >> 5) : (u.pm - 128), q0 = lat ? 256 + ((u.pm & 31) << 8) : 0;
        const bool isrope = u.pn >= 4;
#pragma unroll
        for (int ai = 0; ai < 2; ++ai) {
            const int rl = 128 * ai + 64 * wr + fr;
            const float* rsp = rstd + u.pm * 256 + rl;
            const float* rp = rope + (size_t)(((u.pm & 31) << 8) + rl) * 32;
#pragma unroll
            for (int bj = 0; bj < 2; ++bj) {
                const int c0 = u.pn * 256 + 128 * bj + 32 * wc + 8 * fq; int h, dcol;
                if (!isrope) { h = c0 >> 7; dcol = c0 & 127; } else { const int mq = c0 - 1024; h = mq >> 6; dcol = 128 + (mq & 63); }
                unsigned char* dst = Q + ((size_t)(b * 8 + h) * NKEY + q0 + rl) * 192 + dcol;
                const int ro = (dcol - 128) >> 1;
#pragma unroll
                for (int m = 0; m < 4; ++m) {
                    const float rs = rsp[16 * m] * (QSCALE * att8::QUP);
                    f32x4 v0 = acc[ai][bj][m][0] * rs, v1 = acc[ai][bj][m][1] * rs;
                    if (isrope && lat) { const f32x4 cs = *(const f32x4*)(rp + 16 * m * 32 + ro), sn = *(const f32x4*)(rp + SEQ * 32 + 16 * m * 32 + ro);
                        const f32x4 a0 = v0, a1 = v1;
                        v0[0] = a0[0] * cs[0] - a0[1] * sn[0]; v0[1] = a0[0] * sn[0] + a0[1] * cs[0]; v0[2] = a0[2] * cs[1] - a0[3] * sn[1]; v0[3] = a0[2] * sn[1] + a0[3] * cs[1];
                        v1[0] = a1[0] * cs[2] - a1[1] * sn[2]; v1[1] = a1[0] * sn[2] + a1[1] * cs[2]; v1[2] = a1[2] * cs[3] - a1[3] * sn[3]; v1[3] = a1[2] * sn[3] + a1[3] * cs[3]; }
                    u32x2 w; w.x = pk4_fp8_sat(v0[0], v0[1], v0[2], v0[3]); w.y = pk4_fp8_sat(v1[0], v1[1], v1[2], v1[3]);
                    *(u32x2*)(dst + 16 * m * 192) = w;
                    asm volatile("" ::: "memory");
                }
            }
        }
    }
};
struct EpiKV {
    static constexpr bool PERM = true;
    unsigned char* KN; unsigned char* V; const float* rstd;
    __device__ __forceinline__ void operator()(const f32x4 (&acc)[2][2][4][2], const pg8::Unit& u, int wr, int wc, int fr, int fq) const {
        const bool lat = u.pm < 128;
        const int b = lat ? (u.pm >> 5) : (u.pm - 128), t0 = lat ? 4 + ((u.pm & 31) << 2) : 0;
        const int dd = 32 * wc + 8 * fq;
        const int offK = fr * 128 + ((((dd >> 4) ^ ((fr >> 1) & 7))) << 4) + (dd & 15);
#pragma unroll
        for (int ai = 0; ai < 2; ++ai) {
            const size_t tb = ((size_t)(b * 8 + u.pn) * NKT + t0 + 2 * ai + wr) * 8192;
            const float* rsp = rstd + u.pm * 256 + 128 * ai + 64 * wr + fr;
            unsigned char* kp = KN + tb + offK; unsigned char* vp = V + tb;
#pragma unroll
            for (int m = 0; m < 4; ++m) {
                const float rs = rsp[16 * m];
                { const f32x4 v0 = acc[ai][0][m][0] * rs, v1 = acc[ai][0][m][1] * rs; u32x2 w; w.x = pk4_fp8_sat(v0[0], v0[1], v0[2], v0[3]); w.y = pk4_fp8_sat(v1[0], v1[1], v1[2], v1[3]);
                  *(u32x2*)(kp + m * 2048) = w; }
                { const f32x4 v0 = acc[ai][1][m][0] * rs, v1 = acc[ai][1][m][1] * rs; const unsigned w0 = pk4_fp8_sat(v0[0], v0[1], v0[2], v0[3]), w1 = pk4_fp8_sat(v1[0], v1[1], v1[2], v1[3]);
                  const int sl = att8::vslot(16 * m + fr);
#pragma unroll
                  for (int i = 0; i < 8; ++i) { const int d = dd + i; vp[d * 64 + ((((sl >> 4) ^ ((d >> 2) & 3))) << 4) + (sl & 15)] = (unsigned char)(((i < 4 ? w0 : w1) >> (8 * (i & 3))) & 0xffu); } }
                asm volatile("" ::: "memory");
            }
        }
    }
};

__device__ __forceinline__ void phase_ssd_out(const Args& A, int li, int nrows) {
    const bf16_t* PROJ = (const bf16_t*)(A.ws + WS_BIG); const bf16_t* XS = (const bf16_t*)(A.ws + WS_R2);
    const bf16_t* Y0 = (const bf16_t*)(A.ws + WS_H); const bf16_t* Y1 = (const bf16_t*)(A.ws + WS_R3); bf16_t* CAT = (bf16_t*)(A.ws + WS_R3 + R3_CAT);
    const int tid_ = otid(); const int lane = tid_ & 63, gw = blockIdx.x * 8 + (tid_ >> 6), nw = gridDim.x * 8;
    const float dsk = A.in[I_SSDD][li * 16 + (lane >> 2)];
    float ng[16];
#pragma unroll
    for (int j = 0; j < 16; ++j) ng[j] = A.in[I_SSDNG][li * 1024 + 16 * lane + j];
    for (int r = gw; r < nrows; r += nw) {
        float v[16]; float ss = 0.f;
#pragma unroll
        for (int hh = 0; hh < 2; ++hh) {
            const u32x4 a = *(const u32x4*)(Y0 + (size_t)r * 1024 + 16 * lane + 8 * hh), b = *(const u32x4*)(Y1 + (size_t)r * 1024 + 16 * lane + 8 * hh);
            const u32x4 x = *(const u32x4*)(XS + (size_t)r * 1024 + 16 * lane + 8 * hh), z = *(const u32x4*)(PROJ + (size_t)r * HYB_INP + 16 * lane + 8 * hh);
#pragma unroll
            for (int q = 0; q < 4; ++q) {
                const float y0 = (bflo(a[q]) + bflo(b[q]) + dsk * bflo(x[q])) * silu_f(bflo(z[q])), y1 = (bfhi(a[q]) + bfhi(b[q]) + dsk * bfhi(x[q])) * silu_f(bfhi(z[q]));
                v[8 * hh + 2 * q] = y0; v[8 * hh + 2 * q + 1] = y1; ss += y0 * y0 + y1 * y1; }
        }
#pragma unroll
        for (int o = 16; o >= 1; o >>= 1) ss += __shfl_xor(ss, o);
        const float rstd = rsqrtf(ss * (1.f / 512.f) + EPS);
#pragma unroll
        for (int hh = 0; hh < 2; ++hh) { u32x4 w;
#pragma unroll
            for (int q = 0; q < 4; ++q) w[q] = cvt_pk_bf16(v[8 * hh + 2 * q] * rstd * ng[8 * hh + 2 * q], v[8 * hh + 2 * q + 1] * rstd * ng[8 * hh + 2 * q + 1]);
            *(u32x4*)(CAT + (size_t)r * 2048 + 16 * lane + 8 * hh) = w; }
    }
}

__device__ __forceinline__ void phase_ln_stats(const Args& A, int nrows) {
    const bf16_t* Gb = (const bf16_t*)(A.ws + WS_BIG); float* ST = (float*)(A.ws + WS_RSTD);
    const int tid_ = otid(); const int lane = tid_ & 63, gw = blockIdx.x * 8 + (tid_ >> 6), nw = gridDim.x * 8;
    for (int r = gw; r < nrows; r += nw) {
        float v[32]; float s = 0.f;
#pragma unroll
        for (int j = 0; j < 4; ++j) { const u32x4 w = *(const u32x4*)(Gb + (size_t)r * 4096 + 2048 + 512 * j + 8 * lane);
#pragma unroll
            for (int q = 0; q < 4; ++q) { v[8 * j + 2 * q] = bflo(w[q]); v[8 * j + 2 * q + 1] = bfhi(w[q]); s += v[8 * j + 2 * q] + v[8 * j + 2 * q + 1]; } }
        s = wave_sum(s); const float mu = s * (1.f / 2048.f); float q2 = 0.f;
#pragma unroll
        for (int j = 0; j < 32; ++j) { const float dd = v[j] - mu; q2 += dd * dd; }
        q2 = wave_sum(q2);
        if (lane == 0) { ST[r] = mu; ST[NROW + r] = rsqrtf(q2 * (1.f / 2048.f) + EPS); }
    }
}
__device__ __forceinline__ void phase_spatial(const Args& A, int gi, int nrows, LAS unsigned char* lds) {
    const bf16_t* Gb = (const bf16_t*)(A.ws + WS_BIG); const float* ST = (const float*)(A.ws + WS_RSTD); bf16_t* Ab = (bf16_t*)(A.ws + WS_R1);
    const bf16_t* WSg = (const bf16_t*)(A.ws + WS_W + W_GM + (size_t)gi * WG_SZ + WG_WS);
    const float* lng = A.in[I_GLNG] + (size_t)gi * 2048; const float* lnb = A.in[I_GLNB] + (size_t)gi * 2048; const float* bs = A.in[I_GBS] + (size_t)gi * 1024;
    const int tid = otid(), wid = tid >> 6, lane = tid & 63, r32 = lane & 31, hi = lane >> 5, tb = wid & 3, dh = wid >> 2;
    const int ldsaddr = (int)(unsigned)(uintptr_t)lds;
    u32x4 nv[8]; float nmu[8], nrs[8];
    const int nunits = (nrows / 128) * 8;
#define SP_LOADV(un) do { const int cb_ = (un) >> 3, gg_ = (un) & 7, r0_ = cb_ * 128; \
        _Pragma("unroll") for (int j = 0; j < 8; ++j) { const int idx = tid + 512 * j, s_ = idx >> 5, dd_ = (idx & 31) * 8; \
            nv[j] = *(const u32x4*)(Gb + (size_t)(r0_ + s_) * 4096 + 2048 + 256 * gg_ + dd_); nmu[j] = ST[r0_ + s_]; nrs[j] = ST[NROW + r0_ + s_]; } } while (0)
    if ((int)blockIdx.x < nunits) SP_LOADV((int)blockIdx.x);
    for (int unit = blockIdx.x; unit < nunits; unit += gridDim.x) {
        const int cb = unit >> 3, gg = unit & 7, r0 = cb * 128;
        __syncthreads();
#pragma unroll
        for (int j = 0; j < 8; ++j) { const int idx = tid + 512 * j, s = idx >> 5, dd = (idx & 31) * 8;
            const u32x4 w = nv[j];
            const float mu = nmu[j], rs = nrs[j];
            const f32x4 g0 = *(const f32x4*)(lng + 256 * gg + dd), g1 = *(const f32x4*)(lng + 256 * gg + dd + 4), b0 = *(const f32x4*)(lnb + 256 * gg + dd), b1 = *(const f32x4*)(lnb + 256 * gg + dd + 4);
            u32x4 o;
            o.x = cvt_pk_bf16((bflo(w.x) - mu) * rs * g0[0] + b0[0], (bfhi(w.x) - mu) * rs * g0[1] + b0[1]); o.y = cvt_pk_bf16((bflo(w.y) - mu) * rs * g0[2] + b0[2], (bfhi(w.y) - mu) * rs * g0[3] + b0[3]);
            o.z = cvt_pk_bf16((bflo(w.z) - mu) * rs * g1[0] + b1[0], (bfhi(w.z) - mu) * rs * g1[1] + b1[1]); o.w = cvt_pk_bf16((bflo(w.w) - mu) * rs * g1[2] + b1[2], (bfhi(w.w) - mu) * rs * g1[3] + b1[3]);
            *(LAS u32x4*)(lds + ((s >> 6) * 2 + (dd >> 7)) * 16384 + att::v_st(s & 63, dd & 127)) = o; }
        u32x2 uu[4][4];
        { const bf16_t* up = Gb + (size_t)(r0 + 32 * tb + r32) * 4096 + 256 * gg + 128 * dh + 4 * hi;
#pragma unroll
          for (int d0 = 0; d0 < 4; ++d0)
#pragma unroll
              for (int k = 0; k < 4; ++k) uu[d0][k] = *(const u32x2*)(up + 32 * d0 + 8 * k); }
        if (unit + (int)gridDim.x < nunits) SP_LOADV(unit + (int)gridDim.x);
        bf16x8 pa[8];
#pragma unroll
        for (int ks = 0; ks < 8; ++ks) pa[ks] = *(const bf16x8*)(WSg + ((size_t)gg * 128 + 32 * tb + r32) * 128 + 16 * ks + 8 * hi);
        __syncthreads();
        f32x16 o[4] = {};
#define SP_PV(D0, vbase, p0, p1, p2, p3) do { \
            const s16x4 l0 = att::tr_read<att::v_rd_off(D0, 0, 0)>(vbase), h0 = att::tr_read<att::v_rd_off(D0, 0, 1)>(vbase), l1 = att::tr_read<att::v_rd_off(D0, 1, 0)>(vbase), h1 = att::tr_read<att::v_rd_off(D0, 1, 1)>(vbase); \
            const s16x4 l2 = att::tr_read<att::v_rd_off(D0, 2, 0)>(vbase), h2 = att::tr_read<att::v_rd_off(D0, 2, 1)>(vbase), l3 = att::tr_read<att::v_rd_off(D0, 3, 0)>(vbase), h3 = att::tr_read<att::v_rd_off(D0, 3, 1)>(vbase); \
            asm volatile("s_waitcnt lgkmcnt(0)" ::: "memory"); __builtin_amdgcn_sched_barrier(0); \
            o[D0] = __builtin_amdgcn_mfma_f32_32x32x16_bf16((bf16x8){l0[0], l0[1], l0[2], l0[3], h0[0], h0[1], h0[2], h0[3]}, p0, o[D0], 0, 0, 0); \
            o[D0] = __builtin_amdgcn_mfma_f32_32x32x16_bf16((bf16x8){l1[0], l1[1], l1[2], l1[3], h1[0], h1[1], h1[2], h1[3]}, p1, o[D0], 0, 0, 0); \
            o[D0] = __builtin_amdgcn_mfma_f32_32x32x16_bf16((bf16x8){l2[0], l2[1], l2[2], l2[3], h2[0], h2[1], h2[2], h2[3]}, p2, o[D0], 0, 0, 0); \
            o[D0] = __builtin_amdgcn_mfma_f32_32x32x16_bf16((bf16x8){l3[0], l3[1], l3[2], l3[3], h3[0], h3[1], h3[2], h3[3]}, p3, o[D0], 0, 0, 0); } while (0)
        { const int vb0 = ldsaddr + (0 * 2 + dh) * 16384 + att::v_rd_base(lane), vb1 = ldsaddr + (1 * 2 + dh) * 16384 + att::v_rd_base(lane);
          SP_PV(0, vb0, pa[0], pa[1], pa[2], pa[3]); SP_PV(1, vb0, pa[0], pa[1], pa[2], pa[3]); SP_PV(2, vb0, pa[0], pa[1], pa[2], pa[3]); SP_PV(3, vb0, pa[0], pa[1], pa[2], pa[3]);
          SP_PV(0, vb1, pa[4], pa[5], pa[6], pa[7]); SP_PV(1, vb1, pa[4], pa[5], pa[6], pa[7]); SP_PV(2, vb1, pa[4], pa[5], pa[6], pa[7]); SP_PV(3, vb1, pa[4], pa[5], pa[6], pa[7]); }
#undef SP_PV
        { const int t = 32 * tb + r32, row = r0 + t; const float bsv = bs[gg * 128 + t];
          bf16_t* ap = Ab + (size_t)row * 2048 + 256 * gg + 128 * dh + 4 * hi;
#pragma unroll
          for (int d0 = 0; d0 < 4; ++d0)
#pragma unroll
              for (int k = 0; k < 4; ++k) {
                  const u32x2 u2 = uu[d0][k];
                  u32x2 w; w.x = cvt_pk_bf16(bflo(u2.x) * (o[d0][4 * k] + bsv), bfhi(u2.x) * (o[d0][4 * k + 1] + bsv)); w.y = cvt_pk_bf16(bflo(u2.y) * (o[d0][4 * k + 2] + bsv), bfhi(u2.y) * (o[d0][4 * k + 3] + bsv));
                  *(u32x2*)(ap + 32 * d0 + 8 * k) = w; } }
    }
#undef SP_LOADV
}

constexpr int NSL = 8, SW = 1024 / NSL;
constexpr size_t TAB8_HALF = (size_t)NEXP * 1024, TAB_SCL = 2 * TAB8_HALF;
constexpr float HS = 4.f;
__device__ __forceinline__ void phase_tabcvt(const Args& A, int layer, int wg, int nwg) {
    const int tid_ = otid(); const int lane = tid_ & 63, gw = wg * 8 + (tid_ >> 6), nw = nwg * 8;
    float* SCL = (float*)(A.ws + WS_TAB + TAB_SCL);
    for (int r = gw; r < 2 * NEXP; r += nw) {
        const int tab = r >> 14, e = r & (NEXP - 1);
        const float* src = (tab ? A.in[I_PV] : A.in[I_PU]) + ((size_t)layer * NEXP + e) * 1024 + 16 * lane;
        f32x4 v[4]; float am = 0.f;
#pragma unroll
        for (int i = 0; i < 4; ++i) { v[i] = *(const f32x4*)(src + 4 * i); am = fmaxf(am, fmaxf(fmaxf(fabsf(v[i][0]), fabsf(v[i][1])), fmaxf(fabsf(v[i][2]), fabsf(v[i][3])))); }
#pragma unroll
        for (int o = 32; o >= 1; o >>= 1) am = fmaxf(am, __shfl_xor(am, o));
        float sc = 1.f; if (am > 0.f) { int ex; (void)frexpf(448.f / am, &ex); sc = ldexpf(1.f, ex - 1); }
        if (lane == 0) SCL[tab * NEXP + e] = 1.f / sc;
        u32x4 w;
#pragma unroll
        for (int i = 0; i < 4; ++i) w[i] = pk4_fp8(v[i][0] * sc, v[i][1] * sc, v[i][2] * sc, v[i][3] * sc);
        *(u32x4*)(A.ws + WS_TAB + (size_t)tab * TAB8_HALF + ((size_t)(lane >> 3) * NEXP + e) * SW + 16 * (lane & 7)) = w;
    }
}
#define CASD(a, b) do { const float hi_ = fmaxf(a, b), lo_ = fminf(a, b); a = hi_; b = lo_; } while (0)
__device__ __forceinline__ void sort16(float (&k)[16]) {
#pragma unroll
    for (int sz = 2; sz <= 16; sz <<= 1)
#pragma unroll
        for (int j = sz >> 1; j > 0; j >>= 1)
#pragma unroll
            for (int i = 0; i < 16; ++i) { const int l = i ^ j; if (l > i) { if ((i & sz) == 0 || sz == 16) CASD(k[i], k[l]); else CASD(k[l], k[i]); } }
}
__device__ __forceinline__ void bmerge16(float (&k)[16]) {
#pragma unroll
    for (int j = 8; j > 0; j >>= 1)
#pragma unroll
        for (int i = 0; i < 16; ++i) { const int l = i ^ j; if (l > i) CASD(k[i], k[l]); }
}
__device__ __forceinline__ void merge_top16(float (&a)[16], const float (&b)[16]) {
#pragma unroll
    for (int i = 0; i < 16; ++i) a[i] = fmaxf(a[i], b[15 - i]);
    bmerge16(a);
}
__device__ __forceinline__ void xmerge_top16(float (&a)[16], int mask) {
    float t[16];
#pragma unroll
    for (int i = 0; i < 16; ++i) t[i] = __shfl_xor(a[15 - i], mask);
#pragma unroll
    for (int i = 0; i < 16; ++i) a[i] = fmaxf(a[i], t[i]);
    bmerge16(a);
}
__device__ __forceinline__ void phase_topk(const Args& A, int layer, int nrows, LAS unsigned char* lds) {
    const bf16_t* QP = (const bf16_t*)(A.ws + WS_BIG); int* IDX = (int*)(A.ws + WS_R2); float* GATE = (float*)(A.ws + WS_R2 + R2_GATE);
    const int tid = otid(), wid = tid >> 6, lane = tid & 63, fr = lane & 15, fq = lane >> 4;
    LAS unsigned* scr = (LAS unsigned*)(lds + 2 * 34816) + wid * 512 + fr * 32;
    int h_staged = -1;
    for (int unit = blockIdx.x; unit < (nrows / 128) * 8; unit += gridDim.x) {
        const int h = unit & 7, r0 = (unit >> 3) * 128;
        if (h != h_staged) { h_staged = h;
        __syncthreads();
        { const bf16_t* k1 = (const bf16_t*)(A.ws + WS_W + W_PEER + (size_t)layer * WP_SZ + WP_K1) + (size_t)h * 16384;
#pragma unroll
          for (int j = 0; j < 8; ++j) { const int idx = tid + 512 * j, half = idx >> 11, rem = idx & 2047, key = rem >> 4, c8 = rem & 15;
              const u32x4 w = *(const u32x4*)(k1 + (size_t)half * 8 * 16384 + key * 128 + 8 * c8);
              *(LAS u32x4*)(lds + half * 34816 + key * 272 + c8 * 16) = w; } }
        __syncthreads(); }
        const int tok = r0 + 16 * wid + fr;
        float top[2][16];
#pragma unroll
        for (int half = 0; half < 2; ++half) {
            bf16x8 qf[4];
#pragma unroll
            for (int ks = 0; ks < 4; ++ks) qf[ks] = *(const bf16x8*)(QP + (size_t)tok * 2048 + 256 * h + 128 * half + 32 * ks + 8 * fq);
            float loc[16];
#pragma unroll
            for (int grp = 0; grp < 2; ++grp) {
                float kk[16];
#pragma unroll
                for (int nbb = 0; nbb < 4; ++nbb) { const int nb = 4 * grp + nbb; f32x4 acc = {0.f, 0.f, 0.f, 0.f};
#pragma unroll
                    for (int ks = 0; ks < 4; ++ks) { const bf16x8 kf = *(const LAS bf16x8*)(lds + half * 34816 + (16 * nb + fr) * 272 + (32 * ks + 8 * fq) * 2);
                        acc = __builtin_amdgcn_mfma_f32_16x16x32_bf16(kf, qf[ks], acc, 0, 0, 0); }
#pragma unroll
                    for (int i = 0; i < 4; ++i) { const unsigned code = 127u - (unsigned)(16 * nb + 4 * fq + i); kk[4 * nbb + i] = __uint_as_float((__float_as_uint(acc[i]) & ~127u) | code); } }
                sort16(kk);
                if (grp == 0) {
#pragma unroll
                    for (int i = 0; i < 16; ++i) loc[i] = kk[i];
                } else merge_top16(loc, kk);
            }
            xmerge_top16(loc, 16); xmerge_top16(loc, 32);
#pragma unroll
            for (int i = 0; i < 16; ++i) top[half][i] = loc[i];
        }
        if (fq < 2) {
#pragma unroll
            for (int i = 0; i < 16; ++i) scr[16 * fq + i] = __float_as_uint(fq == 0 ? top[0][i] : top[1][i]); }
        float fin[16];
#pragma unroll
        for (int aa = 0; aa < 4; ++aa) {
            const float va_k = fq == 0 ? top[0][aa] : fq == 1 ? top[0][4 + aa] : fq == 2 ? top[0][8 + aa] : top[0][12 + aa];
            const float va = __uint_as_float(__float_as_uint(va_k) & ~127u);
            float c[16];
#pragma unroll
            for (int bb = 0; bb < 16; ++bb) { const float s = va + __uint_as_float(__float_as_uint(top[1][bb]) & ~127u);
                c[bb] = __uint_as_float((__float_as_uint(s) & ~255u) | (255u - (unsigned)((4 * fq + aa) * 16 + bb))); }
            if (aa == 0) {
#pragma unroll
                for (int i = 0; i < 16; ++i) fin[i] = c[i];
            } else merge_top16(fin, c);
        }
        xmerge_top16(fin, 16); xmerge_top16(fin, 32);
        float ev[16], es = 0.f; const float mx = __uint_as_float(__float_as_uint(fin[0]) & ~255u);
#pragma unroll
        for (int i = 0; i < 16; ++i) { ev[i] = __expf(__uint_as_float(__float_as_uint(fin[i]) & ~255u) - mx); es += ev[i]; }
        const float inv = 1.f / es;
        asm volatile("s_waitcnt lgkmcnt(0)" ::: "memory");
        int oi[4]; float og[4];
#pragma unroll
        for (int kq = 0; kq < 4; ++kq) {
            const float fk = fq == 0 ? fin[kq] : fq == 1 ? fin[4 + kq] : fq == 2 ? fin[8 + kq] : fin[12 + kq];
            const float fe = fq == 0 ? ev[kq] : fq == 1 ? ev[4 + kq] : fq == 2 ? ev[8 + kq] : ev[12 + kq];
            const unsigned code = 255u - (__float_as_uint(fk) & 255u), a = code >> 4, bq = code & 15u;
            const unsigned i1 = 127u - (scr[a] & 127u), i2 = 127u - (scr[16 + bq] & 127u);
            oi[kq] = (int)(i1 * 128u + i2); og[kq] = fe * inv; }
        *(int4*)(IDX + (size_t)tok * 128 + 16 * h + 4 * fq) = make_int4(oi[0], oi[1], oi[2], oi[3]);
        *(f32x4*)(GATE + (size_t)tok * 128 + 16 * h + 4 * fq) = (f32x4){og[0], og[1], og[2], og[3]};
    }
}
struct PeerSched {
    int x0, rank, nloc, nblk, nown; unsigned orphan;
    __device__ __forceinline__ void init(const Args& A, int nrows, LAS unsigned char* smem) {
        unsigned* ctl = (unsigned*)(A.ws + WS_CTL);
        x0 = (int)(xb_xcc_id() & 7u); rank = __builtin_amdgcn_readfirstlane((int)((LAS unsigned*)smem)[8]); nblk = nrows / 64;
        unsigned cached = __builtin_amdgcn_readfirstlane(((LAS unsigned*)smem)[9]);
        if (cached == 0u) { unsigned orph = 0u, nl = 1u;
            for (int j = 0; j < 8; ++j) { unsigned c = xb_ld(&ctl[XB_XCNT(j)]) + xb_ld(&ctl[XB_XCNT(j + 8)]); c = __builtin_amdgcn_readfirstlane(c); if (c == 0u) orph |= 1u << j; if (j == x0) nl = c; }
            cached = (nl << 8) | orph; __syncthreads(); if (threadIdx.x == 0) ((LAS unsigned*)smem)[9] = cached; __syncthreads(); }
        nloc = (int)(cached >> 8); orphan = cached & 0xffu;
        const int tot = (NSL / 8) * nblk; nown = rank < tot ? (tot - rank + nloc - 1) / nloc : 0;
    }
    __device__ __forceinline__ bool item(int j, int& sl, int& blk) const {
        if (j < nown) { const int i = rank + j * nloc; sl = x0 + 8 * (i / nblk); blk = i % nblk; return true; }
        int jj = j - nown; const int tot = (NSL / 8) * nblk, per = ((int)gridDim.x > tot) ? 1 : 0; (void)per;
        for (int o = 0; o < 8; ++o) if ((orphan >> o) & 1u) { const int cnt = ((int)blockIdx.x < tot) ? (tot - (int)blockIdx.x + (int)gridDim.x - 1) / (int)gridDim.x : 0;
            if (jj < cnt) { const int i = (int)blockIdx.x + jj * (int)gridDim.x; sl = o + 8 * (i / nblk); blk = i % nblk; return true; } jj -= cnt; }
        return false;
    }
};
template <class LD, class PR>
__device__ __forceinline__ void peer_items(const PeerSched& S, LD ld, PR pr) {
    int sl, blk, sln, blkn, j = 0, buf = 0; bool have = S.item(0, sl, blk);
    __syncthreads();
    if (have) ld(sl, blk, 0);
    while (have) {
        const bool haven = S.item(j + 1, sln, blkn);
        asm volatile("s_waitcnt vmcnt(0)" ::: "memory");
        if (haven) ld(sln, blkn, buf ^ 1);
        pr(sl, blk, buf);
        sl = sln; blk = blkn; have = haven; buf ^= 1; ++j;
    }
    __syncthreads();
}
#ifndef MK_UVAR
#define MK_UVAR 0
#endif
__device__ __forceinline__ float dpp_sum8(float v) {
    v += __builtin_bit_cast(float, __builtin_amdgcn_mov_dpp(__builtin_bit_cast(int, v), 0xB1, 0xF, 0xF, true));
    v += __builtin_bit_cast(float, __builtin_amdgcn_mov_dpp(__builtin_bit_cast(int, v), 0x4E, 0xF, 0xF, true));
    v += __builtin_bit_cast(float, __builtin_amdgcn_mov_dpp(__builtin_bit_cast(int, v), 0x141, 0xF, 0xF, true));
    return v;
}
__device__ __forceinline__ void phase_peer_u(const Args& A, int layer, int nrows, LAS unsigned char* smem, int rep) {
    const int var = rep ? MK_UVAR : 0;
    const bf16_t* H = (const bf16_t*)(A.ws + WS_H); const int* IDX = (const int*)(A.ws + WS_R2); float* PART = var ? (float*)(A.ws + WS_R1) : (float*)(A.ws + WS_BIG + BIG_PART);
    const unsigned char* U = A.ws + WS_TAB;
    constexpr int PP = 1088, WB = 4 * PP + 2048;
    const int tid = otid(), wid = tid >> 6, lane = tid & 63, m = lane & 7, tk = lane >> 3;
    const int wu = __builtin_amdgcn_readfirstlane(wid);
    LAS unsigned char* lds = smem + LDS_BASE + wu * (2 * WB);
    PeerSched S; S.init(A, nrows, smem);
    peer_items(S,
        [&](int sl, int blk, int buf) {
#pragma unroll
            for (int i = 0; i < 4; ++i)
                __builtin_amdgcn_global_load_lds((const unsigned*)(IDX + ((size_t)blk * 64 + 8 * wu + 2 * i) * 128 + 4 * lane), (LAS unsigned*)(lds + buf * WB + PP * i), 16, 0, 0);
#pragma unroll
            for (int i = 0; i < 2; ++i)
                __builtin_amdgcn_global_load_lds((const unsigned*)(H + (size_t)(blk * 64 + 8 * wu + 4 * i + (lane >> 4)) * 1024 + SW * sl + 8 * (lane & 15)), (LAS unsigned*)(lds + buf * WB + 4 * PP + 1024 * i), 16, 0, 0); },
        [&](int sl, int blk, int buf) {
            const unsigned char* ub = U + (size_t)sl * NEXP * SW + 16 * m;
            const int tok = blk * 64 + wid * 8 + tk;
            const int sw = (tk & 1) * 4;
            const LAS int* ib = (const LAS int*)(lds + buf * WB + (tk >> 1) * PP + (tk & 1) * 512);
            float hf[16];
            { const u32x4 h0 = *(const LAS u32x4*)(lds + buf * WB + 4 * PP + tk * 256 + 32 * m), h1 = *(const LAS u32x4*)(lds + buf * WB + 4 * PP + tk * 256 + 32 * m + 16);
#pragma unroll
              for (int j = 0; j < 4; ++j) { hf[2 * j] = bflo(h0[j]); hf[2 * j + 1] = bfhi(h0[j]); hf[8 + 2 * j] = bflo(h1[j]); hf[8 + 2 * j + 1] = bfhi(h1[j]); } }
            const bool up4 = m >= 4, up2 = (m & 2) != 0, up1 = (m & 1) != 0;
            float* pp = PART + ((size_t)sl * NROW + tok) * 128 + (m ^ sw);
            u32x4 vv[2][8];
#define PU_ROWS(T, c) do { const i32x4 e0_ = *(const LAS i32x4*)(ib + 8 * (c) + sw), e1_ = *(const LAS i32x4*)(ib + 8 * (c) + (4 - sw)); \
                if (var == 4) { _Pragma("unroll") for (int k_ = 0; k_ < 8; ++k_) vv[T][k_] = (u32x4){(unsigned)e0_.x, (unsigned)e1_.y, 0u, 0u}; } else { \
                vv[T][0] = *(const u32x4*)(ub + (size_t)(var == 3 ? e0_.x & 63 : e0_.x) * SW); vv[T][1] = *(const u32x4*)(ub + (size_t)(var == 3 ? e0_.y & 63 : e0_.y) * SW); \
                vv[T][2] = *(const u32x4*)(ub + (size_t)(var == 3 ? e0_.z & 63 : e0_.z) * SW); vv[T][3] = *(const u32x4*)(ub + (size_t)(var == 3 ? e0_.w & 63 : e0_.w) * SW); \
                vv[T][4] = *(const u32x4*)(ub + (size_t)(var == 3 ? e1_.x & 63 : e1_.x) * SW); vv[T][5] = *(const u32x4*)(ub + (size_t)(var == 3 ? e1_.y & 63 : e1_.y) * SW); \
                vv[T][6] = *(const u32x4*)(ub + (size_t)(var == 3 ? e1_.z & 63 : e1_.z) * SW); vv[T][7] = *(const u32x4*)(ub + (size_t)(var == 3 ? e1_.w & 63 : e1_.w) * SW); } } while (0)
#define PU_DOT(T, c) do { float s_[8]; \
                _Pragma("unroll") for (int k = 0; k < 8; ++k) { f32x2 a2 = {0.f, 0.f}; \
                    _Pragma("unroll") for (int j = 0; j < 4; ++j) { const int w = (int)vv[T][k][j]; \
                        const f32x2 lo = __builtin_amdgcn_cvt_pk_f32_fp8(w, false), hi = __builtin_amdgcn_cvt_pk_f32_fp8(w, true); \
                        a2 = __builtin_elementwise_fma(lo, (f32x2){hf[4 * j], hf[4 * j + 1]}, a2); a2 = __builtin_elementwise_fma(hi, (f32x2){hf[4 * j + 2], hf[4 * j + 3]}, a2); } \
                    s_[k] = a2.x + a2.y; } \
                  \
                float t_[4], u_[2]; \
                _Pragma("unroll") for (int j = 0; j < 4; ++j) { const float give = up4 ? s_[j] : s_[4 + j], keep = up4 ? s_[4 + j] : s_[j]; \
                    t_[j] = keep + __builtin_bit_cast(float, __builtin_amdgcn_mov_dpp(__builtin_bit_cast(int, give), 0x141, 0xF, 0xF, true)); }        \
                _Pragma("unroll") for (int j = 0; j < 2; ++j) { const float give = up2 ? t_[j] : t_[2 + j], keep = up2 ? t_[2 + j] : t_[j]; \
                    u_[j] = keep + __builtin_bit_cast(float, __builtin_amdgcn_mov_dpp(__builtin_bit_cast(int, give), 0x4E, 0xF, 0xF, true)); }         \
                { const float give = up1 ? u_[0] : u_[1], keep = up1 ? u_[1] : u_[0]; \
                  const float tot_ = keep + __builtin_bit_cast(float, __builtin_amdgcn_mov_dpp(__builtin_bit_cast(int, give), 0xB1, 0xF, 0xF, true));           \
                  pp[8 * (c)] = tot_; } } while (0)
            PU_ROWS(0, 0);
#pragma unroll 1
            for (int c = 0; c < 16; c += 2) {
                PU_ROWS(1, c + 1);
                __builtin_amdgcn_sched_barrier(0);
                PU_DOT(0, c);
                __builtin_amdgcn_sched_barrier(0);
                if (c + 2 < 16) PU_ROWS(0, c + 2);
                __builtin_amdgcn_sched_barrier(0);
                PU_DOT(1, c + 1);
                __builtin_amdgcn_sched_barrier(0);
            }
#undef PU_ROWS
#undef PU_DOT
        });
}
__device__ __forceinline__ void phase_coef(const Args& A, int nrows) {
    const float* PART = (const float*)(A.ws + WS_BIG + BIG_PART); const float* GATE = (const float*)(A.ws + WS_R2 + R2_GATE); float* COEF = (float*)(A.ws + WS_R2 + R2_COEF);
    const int* IDX = (const int*)(A.ws + WS_R2); const float* SCL = (const float*)(A.ws + WS_TAB + TAB_SCL);
    const int gthr = blockIdx.x * NTHR + otid(), nthr = gridDim.x * NTHR;
    for (int p = gthr; p < nrows * 32; p += nthr) {
        f32x4 s = {0.f, 0.f, 0.f, 0.f};
#pragma unroll
        for (int x = 0; x < NSL; ++x) s += *(const f32x4*)(PART + (size_t)x * NROW * 128 + 4 * p);
        const i32x4 e = *(const i32x4*)(IDX + 4 * p); const f32x4 gt = *(const f32x4*)(GATE + 4 * p);
        const f32x4 su = {SCL[e.x], SCL[e.y], SCL[e.z], SCL[e.w]}, sv = {SCL[NEXP + e.x], SCL[NEXP + e.y], SCL[NEXP + e.z], SCL[NEXP + e.w]};
        const f32x4 a = s * su; const f32x2 g0 = gelu_pk((f32x2){a[0], a[1]}), g1 = gelu_pk((f32x2){a[2], a[3]});
        *(f32x4*)(COEF + 4 * p) = gt * (f32x4){g0.x, g0.y, g1.x, g1.y} * sv; }

}
__device__ __forceinline__ void phase_peer_v(const Args& A, int layer, int nrows, LAS unsigned char* smem, int rep) {
    const int* IDX = (const int*)(A.ws + WS_R2); const float* COEF = (const float*)(A.ws + WS_R2 + R2_COEF);
    const unsigned char* V = A.ws + WS_TAB + TAB8_HALF; const float* MODL = (const float*)(A.ws + WS_MOD) + (size_t)layer * 5 * 6144 + 5 * 1024;
    float* XC = (float*)(A.ws + WS_XC);
    constexpr int PP = 1088, WB = 8 * PP;
    const int tid = otid(), wid = tid >> 6, lane = tid & 63, m = lane & 7, tk = lane >> 3;
    const int wu = __builtin_amdgcn_readfirstlane(wid);
    LAS unsigned char* lds = smem + LDS_BASE + wu * (2 * WB);
    PeerSched S; S.init(A, nrows, smem);
    peer_items(S,
        [&](int sl, int blk, int buf) {
#pragma unroll
            for (int i = 0; i < 4; ++i) {
                __builtin_amdgcn_global_load_lds((const unsigned*)(IDX + ((size_t)blk * 64 + 8 * wu + 2 * i) * 128 + 4 * lane), (LAS unsigned*)(lds + buf * WB + PP * i), 16, 0, 0);
                __builtin_amdgcn_global_load_lds((const unsigned*)(COEF + ((size_t)blk * 64 + 8 * wu + 2 * i) * 128 + 4 * lane), (LAS unsigned*)(lds + buf * WB + 4 * PP + PP * i), 16, 0, 0); } },
        [&](int sl, int blk, int buf) {
            const unsigned char* vb = V + (size_t)sl * NEXP * SW + 16 * m;
            const int tok = blk * 64 + wid * 8 + tk; const bool lat = tok < NLAT;
            const int toff = (tk >> 1) * PP + (tk & 1) * 512, sw = (tk & 1) * 4;
            const LAS int* ib = (const LAS int*)(lds + buf * WB + toff); const LAS float* cb = (const LAS float*)(lds + buf * WB + 4 * PP + toff);
            float* xp = (lat ? A.out + (size_t)tok * D : XC + (size_t)(tok - NLAT) * D) + SW * sl + 16 * m;
            f32x4 xr[4];
#pragma unroll
            for (int j = 0; j < 4; ++j) xr[j] = *(f32x4*)(xp + 4 * j);
            f32x2 acc2[8];
#pragma unroll
            for (int j = 0; j < 8; ++j) acc2[j] = (f32x2){0.f, 0.f};
            u32x4 vv[2][8];
#define PV_ROWS(T, c) do { const i32x4 e0_ = *(const LAS i32x4*)(ib + 8 * (c) + sw), e1_ = *(const LAS i32x4*)(ib + 8 * (c) + (4 - sw)); \
                vv[T][0] = *(const u32x4*)(vb + (size_t)e0_.x * SW); vv[T][1] = *(const u32x4*)(vb + (size_t)e0_.y * SW); vv[T][2] = *(const u32x4*)(vb + (size_t)e0_.z * SW); vv[T][3] = *(const u32x4*)(vb + (size_t)e0_.w * SW); \
                vv[T][4] = *(const u32x4*)(vb + (size_t)e1_.x * SW); vv[T][5] = *(const u32x4*)(vb + (size_t)e1_.y * SW); vv[T][6] = *(const u32x4*)(vb + (size_t)e1_.z * SW); vv[T][7] = *(const u32x4*)(vb + (size_t)e1_.w * SW); } while (0)
#define PV_FMA(T, c) do { const f32x4 c0_ = *(const LAS f32x4*)(cb + 8 * (c) + sw), c1_ = *(const LAS f32x4*)(cb + 8 * (c) + (4 - sw)); \
                _Pragma("unroll") for (int k = 0; k < 8; ++k) { const float cf = k < 4 ? c0_[k & 3] : c1_[k & 3]; \
                    _Pragma("unroll") for (int j = 0; j < 4; ++j) { const int w = (int)vv[T][k][j]; \
                        const f32x2 lo = __builtin_amdgcn_cvt_pk_f32_fp8(w, false), hi = __builtin_amdgcn_cvt_pk_f32_fp8(w, true); const f32x2 c2 = {cf, cf}; \
                        acc2[2 * j] = __builtin_elementwise_fma(lo, c2, acc2[2 * j]); acc2[2 * j + 1] = __builtin_elementwise_fma(hi, c2, acc2[2 * j + 1]); } } } while (0)
            PV_ROWS(0, 0);
#pragma unroll 1
            for (int c = 0; c < 16; c += 2) {
                PV_ROWS(1, c + 1);
                __builtin_amdgcn_sched_barrier(0);
                PV_FMA(0, c);
                __builtin_amdgcn_sched_barrier(0);
                if (c + 2 < 16) PV_ROWS(0, c + 2);
                __builtin_amdgcn_sched_barrier(0);
                PV_FMA(1, c + 1);
                __builtin_amdgcn_sched_barrier(0);
            }
#undef PV_ROWS
#undef PV_FMA
            const float* gp = MODL + (size_t)(lat ? (tok >> 13) : 4) * 6144 + SW * sl + 16 * m;
#pragma unroll
            for (int j = 0; j < 4; ++j) { const f32x4 g = *(const f32x4*)(gp + 4 * j);
                *(f32x4*)(xp + 4 * j) = xr[j] + g * (f32x4){acc2[2 * j].x, acc2[2 * j].y, acc2[2 * j + 1].x, acc2[2 * j + 1].y}; }
        });
}

#ifdef MK_CHECK
constexpr int CW_CHK = 3840;
__device__ __forceinline__ float blk_sum(float v, LAS float* red) {
    const int t_ = otid(); v = wave_sum(v); __syncthreads(); if ((t_ & 63) == 0) red[t_ >> 6] = v; __syncthreads();
    float s = 0.f; for (int i = 0; i < 8; ++i) s += red[i]; __syncthreads(); return s;
}
__device__ __forceinline__ float fp8f(unsigned b) { const unsigned e = (b >> 3) & 15u, m = b & 7u; const float v = e ? ldexpf(1.f + (float)m * 0.125f, (int)e - 7) : ldexpf((float)m * 0.125f, -6); return (b & 0x80u) ? -v : v; }
__device__ __forceinline__ void check_attn(const Args& A, LAS unsigned char* lds, bool with_ctx) {
    const unsigned char* Q = A.ws + WS_R1 + R1_Q; const unsigned char* KN = A.ws + WS_R1 + R1_KN; const unsigned char* KR = A.ws + WS_BIG + BIG_KR; const unsigned char* V = A.ws + WS_R1 + R1_V;
    const bf16_t* CAT = (const bf16_t*)(A.ws + WS_R3 + R3_CAT); float* chk = (float*)(A.ws + WS_CTL) + CW_CHK;
    LAS float* p = (LAS float*)lds; LAS float* qv = p + NKEY; LAS float* red = qv + 192;
    const int tid = otid();
    for (int au = blockIdx.x; au < (with_ctx ? 1056 : 1024); au += gridDim.x) {
        int b, h, qrow, orow, nkey;
        if (au < 1024) { b = au >> 8; h = au & 7; const int qb = (au >> 3) & 31, l = 256 * qb + (int)((((unsigned)au * 2654435761u) >> 20) & 255u); qrow = 256 + l; orow = b * 8192 + l; nkey = NKEY; }
        else { const int cu = au - 1024; b = cu >> 3; h = cu & 7; const int lc = (int)((((unsigned)au * 2654435761u) >> 20) & 255u); qrow = lc; orow = NLAT + 256 * b + lc; nkey = 256; }
        const size_t bh = (size_t)(b * 8 + h);
        __syncthreads();
        if (tid < 192) qv[tid] = fp8f(Q[(bh * NKEY + qrow) * 192 + tid]) * (1.f / att8::QUP);
        __syncthreads();
        float mx = -1e30f;
        for (int key = tid; key < nkey; key += 512) { const int t = key >> 6, k = key & 63; float sacc = 0.f;
            for (int d = 0; d < 128; ++d) sacc += qv[d] * fp8f(KN[(bh * NKT + t) * 8192 + att8::kn8(k, d)]);
            for (int d = 0; d < 64; ++d) sacc += qv[128 + d] * fp8f(KR[((size_t)b * NKT + t) * 4096 + att8::kr8(k, d)]);
            p[key] = sacc; mx = fmaxf(mx, sacc); }
        for (int o = 32; o >= 1; o >>= 1) mx = fmaxf(mx, __shfl_xor(mx, o));
        __syncthreads(); if ((tid & 63) == 0) red[tid >> 6] = mx; __syncthreads(); mx = red[0]; for (int i = 1; i < 8; ++i) mx = fmaxf(mx, red[i]); __syncthreads();
        float ls = 0.f; for (int key = tid; key < nkey; key += 512) { const float e = exp2f(p[key] - mx); p[key] = e; ls += e; }
        ls = blk_sum(ls, red);
        float num = 0.f, den = 0.f;
        if (tid < 128) { float o = 0.f; for (int key = 0; key < nkey; ++key) o += p[key] * fp8f(V[(bh * NKT + (key >> 6)) * 8192 + att8::v8(tid, key & 63)]);
            o /= ls; const float got = bf2f(CAT[(size_t)orow * 2048 + 1024 + 128 * h + tid]); num = (got - o) * (got - o); den = o * o; }
        num = blk_sum(num, red); den = blk_sum(den, red);
        if (tid == 0) { atomicAdd(chk, num); atomicAdd(chk + 1, den); }
    }
}
__device__ __forceinline__ void check_qkv(const Args& A, int li, LAS unsigned char* lds) {
    float* chk = (float*)(A.ws + WS_CTL) + CW_CHK;
    const unsigned char* Q = A.ws + WS_R1 + R1_Q; const unsigned char* KN = A.ws + WS_R1 + R1_KN; const unsigned char* KR = A.ws + WS_BIG + BIG_KR; const unsigned char* V = A.ws + WS_R1 + R1_V;
    LAS float* hv = (LAS float*)lds; LAS float* cq = hv + 1024; LAS float* ckv = cq + 384; LAS float* kr = ckv + 256; LAS float* red = kr + 64; LAS float* ov = red + 16;
    const int tid = otid(), sidx = blockIdx.x;
    const int hd = sidx & 7; const int r = (sidx & 8) ? NLAT + (int)(((unsigned)sidx * 2654435761u) >> 22) : (int)(((unsigned)sidx * 2654435761u) >> 17);
    const float* win = A.in[I_HWIN] + (size_t)li * 1024 * HYB_IN;
    {
        const float* xp = r < NLAT ? A.out + (size_t)r * D : (const float*)(A.ws + WS_XC) + (size_t)(r - NLAT) * D; const float* MODL = (const float*)(A.ws + WS_MOD) + (size_t)(2 * li) * 5 * 6144 + (size_t)row_mb(r) * 6144;
        float ss = 0.f; for (int i = tid; i < 1024; i += 512) ss += xp[i] * xp[i];
        ss = blk_sum(ss, red); const float rstd = rsqrtf(ss / 1024.f + EPS);
        for (int i = tid; i < 1024; i += 512) hv[i] = bf2f(f2bf(xp[i] * rstd * A.in[I_N1G][(2 * li) * 1024 + i] * (1.f + MODL[1024 + i]) + MODL[i])); }
    __syncthreads();
    for (int j = tid; j < 704; j += 512) { float s = 0.f; for (int k = 0; k < 1024; ++k) s += hv[k] * win[(size_t)k * HYB_IN + C_CQ + j];
        s = bf2f(f2bf(s)); if (j < 384) cq[j] = s; else if (j < 640) ckv[j - 384] = s; else kr[j - 640] = s; }
    __syncthreads();
    float sq = 0.f, sk = 0.f; for (int j = tid; j < 384; j += 512) sq += cq[j] * cq[j]; for (int j = tid; j < 256; j += 512) sk += ckv[j] * ckv[j];
    sq = blk_sum(sq, red); sk = blk_sum(sk, red);
    const float rq = rsqrtf(sq / 384.f + EPS), rk = rsqrtf(sk / 256.f + EPS);
    const float* wqb = A.in[I_WQB] + (size_t)li * 384 * 1536; const float* wkvb = A.in[I_WKVB] + (size_t)li * 256 * 2048; const float* qg = A.in[I_QNG] + li * 384; const float* kg = A.in[I_KVNG] + li * 256;
    if (tid < 192) { float s = 0.f; for (int k = 0; k < 384; ++k) s += cq[k] * rq * qg[k] * wqb[(size_t)k * 1536 + hd * 192 + tid]; ov[tid] = s; }
    else if (tid < 448) { const int c = tid - 192; float s = 0.f; for (int k = 0; k < 256; ++k) s += ckv[k] * rk * kg[k] * wkvb[(size_t)k * 2048 + hd * 256 + c]; ov[tid] = s; }
    __syncthreads();
    const bool lat = r < NLAT; const int b = lat ? (r >> 13) : ((r - NLAT) >> 8), l = lat ? (r & 8191) : 0, key = lat ? 256 + l : ((r - NLAT) & 255), qrow = key;
    const size_t bh = (size_t)(b * 8 + hd); const float qs = QSCALE * att8::QUP;
    float num = 0.f, den = 0.f;
    if (tid < 128) {
        const float q = ov[tid] * qs, gq = fp8f(Q[(bh * NKEY + qrow) * 192 + tid]);
        const float kk = ov[192 + tid], gk = fp8f(KN[(bh * NKT + (key >> 6)) * 8192 + att8::kn8(key & 63, tid)]);
        const float vv = ov[320 + tid], gv = fp8f(V[(bh * NKT + (key >> 6)) * 8192 + att8::v8(tid, key & 63)]);
        num = (gq - q) * (gq - q) + (gk - kk) * (gk - kk) + (gv - vv) * (gv - vv); den = q * q + kk * kk + vv * vv;
    } else if (tid < 160) {
        const int i = tid - 128; float c = 1.f, sn = 0.f;
        if (lat) { const float pos = (float)(i < 16 ? (l >> 6) : (l & 63)); const float ang = pos * powf(10000.f, -(float)(i & 15) / 16.f); c = cosf(ang); sn = sinf(ang); }
        const float q1 = ov[128 + i] * qs, q2 = ov[160 + i] * qs, k1 = kr[i], k2 = kr[32 + i];
        const float rq1 = q1 * c - q2 * sn, rq2 = q1 * sn + q2 * c, rk1 = k1 * c - k2 * sn, rk2 = k1 * sn + k2 * c;
        const float gq1 = fp8f(Q[(bh * NKEY + qrow) * 192 + 128 + 2 * i]), gq2 = fp8f(Q[(bh * NKEY + qrow) * 192 + 128 + 2 * i + 1]);
        const float gk1 = fp8f(KR[((size_t)b * NKT + (key >> 6)) * 4096 + att8::kr8(key & 63, 2 * i)]), gk2 = fp8f(KR[((size_t)b * NKT + (key >> 6)) * 4096 + att8::kr8(key & 63, 2 * i + 1)]);
        num = (gq1 - rq1) * (gq1 - rq1) + (gq2 - rq2) * (gq2 - rq2) + (gk1 - rk1) * (gk1 - rk1) + (gk2 - rk2) * (gk2 - rk2); den = rq1 * rq1 + rq2 * rq2 + rk1 * rk1 + rk2 * rk2;
    }
    num = blk_sum(num, red); den = blk_sum(den, red);
    if (tid == 0) { atomicAdd(chk, num); atomicAdd(chk + 1, den); }
}
__device__ __forceinline__ void check_topk(const Args& A, int layer, LAS unsigned char* lds) {
    const bf16_t* QP = (const bf16_t*)(A.ws + WS_BIG); const int* IDX = (const int*)(A.ws + WS_R2); const float* GATE = (const float*)(A.ws + WS_R2 + R2_GATE); float* chk = (float*)(A.ws + WS_CTL) + CW_CHK;
    const bf16_t* K1 = (const bf16_t*)(A.ws + WS_W + W_PEER + (size_t)layer * WP_SZ + WP_K1);
    LAS float* sc = (LAS float*)lds; LAS float* v12 = sc + 256; LAS int* i12 = (LAS int*)(v12 + 32); LAS float* cs = (LAS float*)(i12 + 32); LAS float* ts = cs + 256; LAS int* ti = (LAS int*)(ts + 16); LAS float* red = (LAS float*)(ti + 16);
    const int tid = otid();
    for (int smp = blockIdx.x; smp < 1024; smp += gridDim.x) {
        const int h = smp & 7, tok = (int)((((unsigned)smp * 2654435761u) >> 12) % (unsigned)NROW);
        __syncthreads();
        if (tid < 256) { const int half = tid >> 7, key = tid & 127; float a = 0.f;
            for (int d = 0; d < 128; ++d) a += bf2f(QP[(size_t)tok * 2048 + 256 * h + 128 * half + d]) * bf2f(K1[((size_t)half * 8 + h) * 16384 + key * 128 + d]);
            sc[tid] = a; }
        __syncthreads();
        if (tid < 256) { const int half = tid >> 7, key = tid & 127; const float v = sc[tid]; int rank = 0;
            for (int j = 0; j < 128; ++j) { const float o = sc[half * 128 + j]; rank += (o > v || (o == v && j < key)) ? 1 : 0; }
            if (rank < 16) { v12[half * 16 + rank] = v; i12[half * 16 + rank] = key; } }
        __syncthreads();
        if (tid < 256) cs[tid] = v12[tid >> 4] + v12[16 + (tid & 15)];
        __syncthreads();
        if (tid < 256) { const float v = cs[tid]; int rank = 0;
            for (int j = 0; j < 256; ++j) { const float o = cs[j]; rank += (o > v || (o == v && j < tid)) ? 1 : 0; }
            if (rank < 16) { ts[rank] = v; ti[rank] = i12[tid >> 4] * 128 + i12[16 + (tid & 15)]; } }
        __syncthreads();
        float num = 0.f, den = 0.f;
        if (tid < 16) { float es = 0.f; for (int j = 0; j < 16; ++j) es += __expf(ts[j] - ts[0]); const float gn = __expf(ts[tid] - ts[0]) / es; float gk = 0.f;
            for (int j = 0; j < 16; ++j) if (IDX[(size_t)tok * 128 + 16 * h + j] == ti[tid]) gk = GATE[(size_t)tok * 128 + 16 * h + j];
            num = (gk - gn) * (gk - gn); den = gn * gn; }
        num = blk_sum(num, red); den = blk_sum(den, red);
        if (tid == 0) { atomicAdd(chk, num); atomicAdd(chk + 1, den); }
    }
}
__device__ __forceinline__ void check_ssd(const Args& A, int li, LAS unsigned char* lds) {
    const bf16_t* XS = (const bf16_t*)(A.ws + WS_R2); const bf16_t* BC = (const bf16_t*)(A.ws + WS_R2 + R2_BC); const float* DT = (const float*)(A.ws + WS_BIG + BIG_DT);
    const bf16_t* Y0 = (const bf16_t*)(A.ws + WS_H); const bf16_t* Y1 = (const bf16_t*)(A.ws + WS_R3); float* chk = (float*)(A.ws + WS_CTL) + CW_CHK;
    LAS float* red = (LAS float*)lds;
    const int tid = otid(), sidx = blockIdx.x;
    const int b = sidx & 3, d = (sidx >> 2) & 1, h = (sidx >> 3) & 15, p = (int)((((unsigned)sidx * 2654435761u) >> 20) & 63u), g = h >> 3;
    const float a = -__expf(A.in[I_ALOG][li * 32 + d * 16 + h]);
    const bf16_t* Y = d ? Y1 : Y0;
    float hst = 0.f, num = 0.f, den = 0.f;
    for (int step = 0; step < 8448; ++step) {
        int r;
        if (step < 256) r = NLAT + b * 256 + (d ? 255 - step : step); else { const int q = step - 256; r = b * 8192 + (d ? 8191 - q : q); }
        const float dt = DT[(size_t)(d * 16 + h) * NROW + r], x = bf2f(XS[(size_t)r * 1024 + 64 * h + p]);
        float contrib = 0.f;
        if (tid < 128) { hst = __expf(dt * a) * hst + dt * x * bf2f(BC[(size_t)r * 512 + 128 * g + tid]); contrib = hst * bf2f(BC[(size_t)r * 512 + 256 + 128 * g + tid]); }
        if (step % 61 == 0) { const float y = blk_sum(contrib, red); const float got = bf2f(Y[(size_t)r * 1024 + 64 * h + p]); if (tid == 0) { num += (got - y) * (got - y); den += y * y; } }
    }
    if (tid == 0) { atomicAdd(chk, num); atomicAdd(chk + 1, den); }
}
#endif
#ifndef MK_PER_PHASE
#define MK_PER_PHASE 0
#endif
__device__ __forceinline__ int nr_in(int L) { return L <= 2 ? NROW : NLAT; }
__device__ __forceinline__ int nr_out(int L) { return L <= 1 ? NROW : NLAT; }

__global__ void __launch_bounds__(NTHR, 2) fwd(Args A) {
    extern __shared__ __attribute__((aligned(256))) unsigned char smem_raw[];
    LAS unsigned char* smem = (LAS unsigned char*)smem_raw;
    LAS unsigned char* lds = smem + LDS_BASE;
    const int tid = otid();
    if (tid < 64) ((LAS unsigned*)smem)[tid] = 0u;
    __syncthreads();
    XcdBarrier bar = xcd_barrier_post((unsigned*)(A.ws + WS_CTL), (volatile LAS unsigned*)smem);
    if (tid == 0) ((LAS unsigned*)smem)[8] = atomicAdd((unsigned*)(A.ws + WS_CTL) + CW_RANK + 32 * (xb_xcc_id() & 7u), 1u);
    __syncthreads();
    bool need_bar = false;
    const int lo = A.ph_lo, hi = A.ph_hi;
#ifndef PHMASK
#define PHMASK 0xffffffffu
#endif
#define SITE(k) if constexpr (((PHMASK) >> (k)) & 1u)
#ifndef MK_SVAR
#define MK_SVAR 1
#endif
#ifndef MK_REPEAT_SITE
#define MK_REPEAT_SITE -1
#endif
#define REP(k) for (int rep = 0; rep < ((k) == (MK_REPEAT_SITE) ? 2 : 1); ++rep)
#define PH(id) if ([&]() -> bool { if ((id) < lo || (id) >= hi) return false; if (need_bar) xcd_barrier(bar); need_bar = true; return true; }())
    unsigned char* ws = A.ws;
    float* XL = A.out; float* XC = (float*)(ws + WS_XC);
    bf16_t* H = (bf16_t*)(ws + WS_H);
    const float* MOD = (const float*)(ws + WS_MOD);

    SITE(0) PH(0) { phase_prologue(A, lds); }
    SITE(1) PH(1) { phase_norm_mod(A.in[I_X], A.in[I_CTX], XL, XC, A.in[I_N1G], MOD, 0, H, NROW); }
    for (int L = 0; L < DEPTH; ++L) {
        const int base = 2 + 16 * L, li = L >> 1; const bool hyb = (L & 1) == 0;
        const float* MODL = MOD + (size_t)L * 5 * 6144;
        unsigned char* WH = ws + WS_W + W_HYB + (size_t)li * WH_SZ; unsigned char* WG = ws + WS_W + W_GM + (size_t)li * WG_SZ; unsigned char* WP = ws + WS_W + W_PEER + (size_t)L * WP_SZ;
        if (hyb) {
            SITE(2) PH(base + 0) REP(2) { pg8::Gemm g{H, (const bf16_t*)(WH + WH_IN), nr_in(L), HYB_INP, 1024, 1024, 1024};
                pg8::EpiBf16<0> e{(bf16_t*)(ws + WS_BIG), HYB_INP}; pg8::gemm_phase(lds, g, e); }
            SITE(3) PH(base + 1) REP(3) { phase_conv(A, li); }
            SITE(4) PH(base + 2) {
                SITE(18) REP(18) { pg8::Gemm g{(const bf16_t*)(ws + WS_BIG) + C_CQ, (const bf16_t*)(WH + WH_QB), L == 0 ? NROW : NLAT, 1536, 384, HYB_INP, 384};
                  EpiQ e{ws + WS_R1 + R1_Q, (const float*)(ws + WS_RSTD), (const float*)(ws + WS_ROPE)}; pg8::gemm_phase(lds, g, e); }
                SITE(19) REP(19) { pg8::Gemm g{(const bf16_t*)(ws + WS_BIG) + C_CKV, (const bf16_t*)(WH + WH_KVB), NROW, 2048, 256, HYB_INP, 256};
                  EpiKV e{ws + WS_R1 + R1_KN, ws + WS_R1 + R1_V, (const float*)(ws + WS_RSTD) + NROW}; pg8::gemm_phase(lds, g, e); }
                SITE(20) REP(20) for (int u = blockIdx.x; u < 528; u += gridDim.x) ssd::g_unit((const bf16_t*)(ws + WS_R2 + R2_BC), (bf16_t*)(ws + WS_BIG + BIG_G), u);
            }
            SITE(5) PH(base + 3) {
                const int xq = (int)blockIdx.x & 7, jq = (int)blockIdx.x >> 3; const bool ssd_wg = (jq & 1) == 0 && gridDim.x == 256;
                if (gridDim.x == 256) {
                    if (ssd_wg) { const int r = jq >> 1, gi = xq + 8 * (r >> 3), hh = r & 7, sb = gi >> 2, sgp = (gi >> 1) & 1, sd = gi & 1;
                        SITE(21) ssd::ssd_unit(sb, 8 * sgp + hh, sd, (const bf16_t*)(ws + WS_R2), (const bf16_t*)(ws + WS_R2 + R2_BC), (const float*)(ws + WS_BIG + BIG_DT), (const bf16_t*)(ws + WS_BIG + BIG_G),
                                               A.in[I_ALOG] + li * 32, sd ? (bf16_t*)(ws + WS_R3) : (bf16_t*)(ws + WS_H), lds); }
                } else {
                    SITE(21) for (int u = blockIdx.x; u < 128; u += gridDim.x) ssd::ssd_unit(u >> 5, (u >> 1) & 15, u & 1, (const bf16_t*)(ws + WS_R2), (const bf16_t*)(ws + WS_R2 + R2_BC), (const float*)(ws + WS_BIG + BIG_DT),
                                               (const bf16_t*)(ws + WS_BIG + BIG_G), A.in[I_ALOG] + li * 32, (u & 1) ? (bf16_t*)(ws + WS_R3) : (bf16_t*)(ws + WS_H), lds);
                }
                const int nmine = gridDim.x == 256 ? (ssd_wg ? 3 : 5) + (L == 0 && !ssd_wg && jq < 8 ? 1 : 0) : 0;
                SITE(22) REP(22) for (int it = 0; gridDim.x == 256 ? it < nmine : (int)blockIdx.x + it * (int)gridDim.x < (L == 0 ? 1056 : 1024); ++it) {
                    int b, h, qrow0, orow0, nt;
                    if (gridDim.x == 256) {
                        const int base_it = ssd_wg ? 3 : 5;
                        if (it < base_it) { const int v = ssd_wg ? 3 * (jq >> 1) + it : 48 + 5 * (jq >> 1) + it; b = v >> 5; h = xq; const int qb = v & 31; qrow0 = 256 + 256 * qb; orow0 = b * 8192 + 256 * qb; nt = NKT; }
                        else { b = jq >> 1; h = xq; qrow0 = 0; orow0 = NLAT + 256 * b; nt = 4; }
                    } else { const int au = (int)blockIdx.x + it * (int)gridDim.x;
                        if (au < 1024) { b = au >> 8; h = au & 7; const int qb = (au >> 3) & 31; qrow0 = 256 + 256 * qb; orow0 = b * 8192 + 256 * qb; nt = NKT; }
                        else { const int cu = au - 1024; b = cu >> 3; h = cu & 7; qrow0 = 0; orow0 = NLAT + 256 * b; nt = 4; } }
                    const size_t bh = (size_t)(b * 8 + h);
                    att8::attn_unit(ws + WS_R1 + R1_Q + (bh * NKEY + qrow0) * 192, ws + WS_R1 + R1_KN + bh * NKT * 8192, ws + WS_BIG + BIG_KR + (size_t)b * NKT * 4096,
                                    ws + WS_R1 + R1_V + bh * NKT * 8192, (bf16_t*)(ws + WS_R3 + R3_CAT) + (size_t)orow0 * 2048 + 1024 + 128 * h, nt, lds);
                }
                if (gridDim.x == 256 && !ssd_wg) SITE(11) phase_tabcvt(A, L, xq + 8 * (jq >> 1), 128);
            }
            SITE(6) PH(base + 4) REP(6) { phase_ssd_out(A, li, nr_out(L));
#if defined(MK_CHECK) && MK_CHECK == 1
                if (L == 0) check_attn(A, lds, true);
#elif defined(MK_CHECK) && MK_CHECK == 2
                if (L == 0) check_qkv(A, li, lds);
#elif defined(MK_CHECK) && MK_CHECK == 3
                if (L == 2) check_attn(A, lds, false);
#elif defined(MK_CHECK) && MK_CHECK == 5
                if (L == 0) check_ssd(A, li, lds);
#elif defined(MK_CHECK) && MK_CHECK == 6
                if (L == 2) check_ssd(A, li, lds);
#endif
            }
        } else {
            SITE(7) PH(base + 0) REP(7) { pg8::Gemm g{H, (const bf16_t*)(WG + WG_IN), nr_out(L), 4096, 1024, 1024, 1024};
                pg8::EpiBf16<1> e{(bf16_t*)(ws + WS_BIG), 4096}; pg8::gemm_phase(lds, g, e); }
            SITE(8) PH(base + 1) REP(8) { phase_ln_stats(A, nr_out(L)); }
            SITE(9) PH(base + 2) REP(9) { phase_spatial(A, li, nr_out(L), lds); }
        }
        SITE(10) PH(base + 5) { pg8::Gemm g{hyb ? (const bf16_t*)(ws + WS_R3 + R3_CAT) : (const bf16_t*)(ws + WS_R1), hyb ? (const bf16_t*)(WH + WH_OUT) : (const bf16_t*)(WG + WG_OUT), nr_out(L), 1024, 2048, 2048, 2048};
            pg8::EpiResid e{XL, XC, MODL + 2 * 1024}; pg8::gemm_phase(lds, g, e); }
        SITE(11) PH(base + 6) REP(11) { phase_norm_mod(XL, XC, nullptr, nullptr, A.in[I_N2G] + L * 1024, MODL, 3, H, nr_out(L));
            if (!hyb || gridDim.x != 256) phase_tabcvt(A, L, (int)blockIdx.x, (int)gridDim.x); }
        SITE(12) PH(base + 7) REP(12) { pg8::Gemm g{H, (const bf16_t*)(WP + WP_Q), nr_out(L), 2048, 1024, 1024, 1024};
            pg8::EpiBf16<0> e{(bf16_t*)(ws + WS_BIG), 2048}; pg8::gemm_phase(lds, g, e); }
        SITE(13) PH(base + 8) REP(13) { phase_topk(A, L, nr_out(L), lds); }
        SITE(14) PH(base + 9) REP(14) { phase_peer_u(A, L, nr_out(L), smem, rep); }
        SITE(15) PH(base + 10) REP(15) { phase_coef(A, nr_out(L));
#if defined(MK_CHECK) && MK_CHECK == 4
            if (L == 1) check_topk(A, L, lds);
#endif
        }
        SITE(16) PH(base + 11) { phase_peer_v(A, L, nr_out(L), smem, 0); }
        SITE(17) PH(base + 12) { if (L < DEPTH - 1) phase_norm_mod(XL, XC, nullptr, nullptr, A.in[I_N1G] + (L + 1) * 1024, MOD + (size_t)(L + 1) * 5 * 6144, 0, H, nr_in(L + 1));
                        else {
#ifdef MK_CHECK
                            const float* chk = (const float*)(ws + WS_CTL) + CW_CHK; const float err = sqrtf(chk[0] / fmaxf(chk[1], 1e-30f));
                            phase_final_norm(XL, A.in[I_FNG], 1.f + 10.f * err);
#else
                            phase_final_norm(XL, A.in[I_FNG], 1.f);
#endif
                        } }
    }
#undef PH
}

#ifdef MK_TAP
__global__ void tap_kernel(const unsigned short* buf, size_t pitch, size_t col0, size_t ncols, size_t nrows, float* out) {
    const size_t n = ncols * nrows;
    for (size_t i = (size_t)blockIdx.x * blockDim.x + threadIdx.x; i < (size_t)NLAT * D; i += (size_t)gridDim.x * blockDim.x) {
        float s = 0.f; for (size_t j = i; j < n; j += (size_t)NLAT * D) s += (float)buf[(j / ncols) * pitch + col0 + (j % ncols)]; out[i] = s; }
}
#endif
extern "C" void kernel_launch(void* const* d_in, const int* in_sizes, int n_in, void* d_out, int out_size, void* d_ws, size_t ws_size, hipStream_t stream) {
    static int grid = 0;
    if (grid == 0) {
        if (n_in != N_IN || out_size != NLAT * D || ws_size < WS_END) { fprintf(stderr, "kernel_launch: unexpected shapes (n_in %d out %d ws %zu, need %zu)\n", n_in, out_size, ws_size, (size_t)WS_END); grid = -1; return; }
        int dev = 0, cus = 0, per_cu = 0;
        if (hipGetDevice(&dev) != hipSuccess || hipDeviceGetAttribute(&cus, hipDeviceAttributeMultiprocessorCount, dev) != hipSuccess) { grid = -1; return; }
        if (hipFuncSetAttribute((const void*)fwd, hipFuncAttributeMaxDynamicSharedMemorySize, LDS_BYTES) != hipSuccess) { fprintf(stderr, "kernel_launch: hipFuncSetAttribute failed\n"); grid = -1; return; }
        if (hipOccupancyMaxActiveBlocksPerMultiprocessor(&per_cu, (const void*)fwd, NTHR, LDS_BYTES) != hipSuccess || per_cu < 1) { fprintf(stderr, "kernel_launch: occupancy query says %d\n", per_cu); }
        (void)hipGetLastError();
        grid = cus;
    }
    if (grid < 0) return;
    (void)hipMemsetAsync((char*)d_ws + WS_CTL, 0, CTL_BYTES, stream);
    Args a{};
    for (int i = 0; i < N_IN; ++i) a.in[i] = (const float*)d_in[i];
    a.out = (float*)d_out; a.ws = (unsigned char*)d_ws;
#if MK_PER_PHASE
    for (int id = 0; id < 2 + 16 * DEPTH; ++id) {
        if (id >= 2) { const int L = (id - 2) / 16, s = (id - 2) % 16; if (s > 12) continue; if ((L & 1) && (s == 3 || s == 4)) continue; }
#ifdef MK_CUT
#ifdef MK_TAP
        if (id >= MK_CUT) continue;
#else
        if (id >= MK_CUT && id != 2 + 16 * (DEPTH - 1) + 12) continue;
#endif
#endif
        a.ph_lo = id; a.ph_hi = id + 1;
        hipLaunchKernelGGL(fwd, dim3(grid), dim3(NTHR), LDS_BYTES, stream, a);
    }
#ifdef MK_TAP
    { const size_t tp[5] = {MK_TAP}; hipLaunchKernelGGL(tap_kernel, dim3(2048), dim3(256), 0, stream, (const unsigned short*)((const char*)d_ws + tp[0]), tp[1], tp[2], tp[3], tp[4], (float*)d_out); }
#endif
#else
    a.ph_lo = 0; a.ph_hi = 2 + 16 * DEPTH;
    hipLaunchKernelGGL(fwd, dim3(grid), dim3(NTHR), LDS_BYTES, stream, a);
#endif
    const hipError_t le = hipPeekAtLastError();
    if (le != hipSuccess) fprintf(stderr, "kernel_launch: launch failed: %s\n", hipGetErrorName(le));
}
```

```cpp
#include <hip/hip_runtime.h>
#include <cstdio>
#include <cstdint>

#define LAS __attribute__((address_space(3)))
typedef unsigned short bf16_t;
typedef short bf16x8 __attribute__((ext_vector_type(8)));
typedef short s16x4 __attribute__((ext_vector_type(4)));
typedef float f32x2 __attribute__((ext_vector_type(2)));
typedef float f32x4 __attribute__((ext_vector_type(4)));
typedef float f32x16 __attribute__((ext_vector_type(16)));
typedef unsigned u32x2 __attribute__((ext_vector_type(2)));
typedef unsigned u32x4 __attribute__((ext_vector_type(4)));
typedef int i32x4 __attribute__((ext_vector_type(4)));
typedef int i32x8 __attribute__((ext_vector_type(8)));

constexpr int D = 1024, NB = 4, SEQ = 8192, DEPTH = 4, CTXL = 256;
constexpr int NLAT = NB * SEQ, NCTX = NB * CTXL, NROW = NLAT + NCTX;
constexpr int HYB_IN = 3280, HYB_INP = 3328;
constexpr int C_Z = 0, C_XBC = 1024, C_DT = 2560, C_CQ = 2576, C_CKV = 2960, C_KR = 3216;
constexpr int NKEY = SEQ + CTXL, NKT = NKEY / 64;
constexpr float EPS = 1e-6f;
constexpr float QSCALE = 0.07216878364870322f * 1.4426950408889634f;
constexpr int NEXP = 16384;

enum { I_X = 0, I_C, I_CTX, I_CCTX, I_ADAW, I_ADAB, I_N1G, I_N2G, I_HWIN, I_CONVW, I_CONVB, I_ALOG, I_DTB, I_SSDD, I_SSDNG, I_QNG, I_WQB, I_KVNG, I_WKVB,
       I_HWOUT, I_GWIN, I_GLNG, I_GLNB, I_GWS, I_GBS, I_GWOUT, I_PWQ, I_PK1, I_PK2, I_PU, I_PV, I_FNG, N_IN };

constexpr size_t al256(size_t x) { return (x + 255) & ~(size_t)255; }
constexpr size_t WS_CTL = 0, CTL_BYTES = 65536;
constexpr size_t WS_MOD = WS_CTL + CTL_BYTES;
constexpr size_t WS_ROPE = WS_MOD + al256((size_t)DEPTH * 5 * 6144 * 4);
constexpr size_t WS_RSTD = WS_ROPE + (size_t)2 * SEQ * 32 * 4;
constexpr size_t WS_W = WS_RSTD + al256((size_t)2 * NROW * 4);
constexpr size_t W_HYB = 0;
constexpr size_t WH_IN = 0, WH_QB = WH_IN + (size_t)HYB_INP * 1024 * 2, WH_KVB = WH_QB + (size_t)1536 * 384 * 2, WH_OUT = WH_KVB + (size_t)2048 * 256 * 2,
                 WH_SZ = WH_OUT + (size_t)1024 * 2048 * 2;
constexpr size_t W_GM = W_HYB + 2 * WH_SZ;
constexpr size_t WG_IN = 0, WG_OUT = WG_IN + (size_t)4096 * 1024 * 2, WG_WS = WG_OUT + (size_t)1024 * 2048 * 2, WG_SZ = WG_WS + (size_t)8 * 128 * 128 * 2;
constexpr size_t W_PEER = W_GM + 2 * WG_SZ;
constexpr size_t WP_Q = 0, WP_K1 = WP_Q + (size_t)2048 * 1024 * 2, WP_K2 = WP_K1 + (size_t)8 * 128 * 128 * 2, WP_SZ = WP_K2 + (size_t)8 * 128 * 128 * 2;
constexpr size_t W_TOTAL = W_PEER + 4 * WP_SZ;
constexpr size_t WS_TAB = WS_W + al256(W_TOTAL);
constexpr size_t TAB_HALF = (size_t)NEXP * 1024 * 2;
constexpr size_t TAB_REGION = 2 * TAB_HALF + 524288;
constexpr size_t WS_XC = WS_TAB + TAB_REGION;
constexpr size_t WS_H = WS_XC + (size_t)NCTX * D * 4;
constexpr size_t WS_BIG = WS_H + (size_t)NROW * D * 2;
constexpr size_t BIG_BYTES = (size_t)NROW * 4096 * 2;
constexpr size_t BIG_DT = (size_t)NROW * HYB_INP * 2;
constexpr size_t BIG_G = BIG_DT + (size_t)NROW * 32 * 4;
constexpr size_t BIG_KR = BIG_G + (size_t)528 * 128 * 128 * 2;
constexpr size_t BIG_PART = (size_t)NROW * 2048 * 2;
static_assert(BIG_KR + (size_t)NB * NKT * 8192 <= BIG_BYTES, "BIG tail");
constexpr size_t WS_R1 = WS_BIG + BIG_BYTES;
constexpr size_t R1_Q = 0, R1_KN = R1_Q + (size_t)NB * 8 * NKEY * 192 * 2, R1_V = R1_KN + (size_t)NB * 8 * NKT * 16384, R1_BYTES = R1_V + (size_t)NB * 8 * NKT * 16384;
constexpr size_t WS_R2 = WS_R1 + R1_BYTES;
constexpr size_t R2_BC = (size_t)NROW * 1024 * 2, R2_BYTES = R2_BC + (size_t)NROW * 512 * 2;
constexpr size_t R2_GATE = (size_t)NROW * 128 * 4, R2_COEF = 2 * R2_GATE;
constexpr size_t WS_R3 = WS_R2 + R2_BYTES;
constexpr size_t R3_CAT = (size_t)NROW * 1024 * 2, R3_BYTES = R3_CAT + (size_t)NROW * 2048 * 2;
constexpr size_t WS_END = WS_R3 + R3_BYTES;
static_assert(WS_END <= ((size_t)1 << 30), "workspace must fit 1 GiB");

constexpr int CW_RANK = 3584;
constexpr int CW_QUEUE = 4096;

typedef __bf16 bf16x2_t __attribute__((ext_vector_type(2)));
__device__ __forceinline__ unsigned cvt_pk_bf16(float lo, float hi) { const f32x2 v = {lo, hi}; const bf16x2_t b = __builtin_convertvector(v, bf16x2_t); return __builtin_bit_cast(unsigned, b); }
__device__ __forceinline__ bf16_t f2bf(float f) { return (bf16_t)(cvt_pk_bf16(f, 0.f) & 0xffffu); }
__device__ __forceinline__ float bf2f(unsigned b) { return __uint_as_float(b << 16); }
__device__ __forceinline__ float bflo(unsigned w) { return __uint_as_float(w << 16); }
__device__ __forceinline__ float bfhi(unsigned w) { return __uint_as_float(w & 0xffff0000u); }
__device__ __forceinline__ float wave_sum(float v) {
#pragma unroll
    for (int o = 32; o >= 1; o >>= 1) v += __shfl_xor(v, o);
    return v;
}
__device__ __forceinline__ int otid() { int t = threadIdx.x; asm volatile("" : "+v"(t)); return t; }
__device__ __forceinline__ float silu_f(float x) { return x / (1.f + __expf(-x)); }
__device__ __forceinline__ float softplus_f(float x) { return x > 20.f ? x : log1pf(__expf(x)); }
__device__ __forceinline__ f32x2 gelu_pk(f32x2 v) {
    const f32x2 av = __builtin_elementwise_abs(v), d = av * 0.2316418882f + 1.0f;
    f32x2 t; t.x = __builtin_amdgcn_rcpf(d.x); t.y = __builtin_amdgcn_rcpf(d.y);
    f32x2 q = t * 0.5307027145f + (-0.7265760135f); q = q * t + 0.7107068705f; q = q * t + (-0.142248368f); q = q * t + 0.127414796f; q = q * t;
    const f32x2 s = (v * v) * (-0.72134752044f);
    f32x2 e; e.x = __builtin_amdgcn_exp2f(s.x); e.y = __builtin_amdgcn_exp2f(s.y);
    const f32x2 m = v * (q * e), r = v - m;
    f32x2 o; o.x = v.x < 0.f ? m.x : r.x; o.y = v.y < 0.f ? m.y : r.y; return o;
}
__device__ __forceinline__ float gelu_f(float x) { f32x2 v = {x, 0.f}; return gelu_pk(v).x; }

__device__ __forceinline__ unsigned pk4_fp8(float a, float b, float c, float d) { int w = 0; w = __builtin_amdgcn_cvt_pk_fp8_f32(a, b, w, false); w = __builtin_amdgcn_cvt_pk_fp8_f32(c, d, w, true); return (unsigned)w; }
__device__ __forceinline__ float sat8(float v) { return __builtin_amdgcn_fmed3f(v, -448.f, 448.f); }
__device__ __forceinline__ unsigned pk4_fp8_sat(float a, float b, float c, float d) { return pk4_fp8(sat8(a), sat8(b), sat8(c), sat8(d)); }
__device__ __forceinline__ int row_mb(int r) { return r < NLAT ? (r >> 13) : 4; }

#define XB_TMO      128
#define XB_XCNT(j)  (256  + 64 * (j))
#define XB_XSUB(j)  (1280 + 64 * (j))
#define XB_XGEN(j)  (2304 + 64 * (j))
#define XB_TOP      3328
#define XB_TOPGEN   3392
#define XCD_BAR_WORDS 3456
#define XB_SPIN_CAP (1u << 22)
__device__ __forceinline__ unsigned xb_ld(unsigned* p)              { return __hip_atomic_load(p, __ATOMIC_RELAXED, __HIP_MEMORY_SCOPE_AGENT); }
__device__ __forceinline__ unsigned xb_add(unsigned* p, unsigned v) { return __hip_atomic_fetch_add(p, v, __ATOMIC_RELAXED, __HIP_MEMORY_SCOPE_AGENT); }
__device__ __forceinline__ unsigned xb_xcc_id() { return (unsigned)__builtin_amdgcn_s_getreg((3 << 11) | 20) & 0xFu; }
#define XB_SPIN(cond, bar) do { unsigned _sp = 0; while (cond) { __builtin_amdgcn_s_sleep(1); \
    if ((++_sp & 255u) == 0u) { if (xb_ld(&(bar)[XB_TMO])) break; if (_sp > XB_SPIN_CAP) { atomicAdd(&(bar)[XB_TMO], 1u); break; } } } } while (0)
struct XcdBarrier { unsigned* bar; unsigned x; volatile LAS unsigned* st; };
__device__ __forceinline__ XcdBarrier xcd_barrier_post(unsigned* bar, volatile LAS unsigned* st) {
    XcdBarrier b; b.bar = bar; b.x = xb_xcc_id(); b.st = st;
    if (threadIdx.x == 0) (void)xb_add(&bar[XB_XCNT(b.x)], 1u);
    return b;
}
__device__ __forceinline__ void xcd_barrier_complete(unsigned* bar, unsigned x, unsigned& nloc, unsigned& nx) {
    const unsigned G = gridDim.x * gridDim.y * gridDim.z;
    unsigned sum, cnt, mine, sp = 0u;
    for (;;) {
        sum = 0u; cnt = 0u; mine = 0u;
#pragma unroll
        for (unsigned j = 0; j < 16; ++j) { const unsigned c = xb_ld(&bar[XB_XCNT(j)]); sum += c; cnt += (c > 0u) ? 1u : 0u; mine = (j == x) ? c : mine; }
        if (sum == G) break;
        __builtin_amdgcn_s_sleep(1);
        if ((++sp & 255u) == 0u) { if (xb_ld(&bar[XB_TMO])) break; if (sp > XB_SPIN_CAP) { atomicAdd(&bar[XB_TMO], 1u); break; } }
    }
    nloc = mine > 0u ? mine : 1u; nx = cnt > 0u ? cnt : 1u;
}
__device__ __forceinline__ void xcd_barrier(const XcdBarrier& b) {
    asm volatile("s_waitcnt vmcnt(0)" ::: "memory");
    __syncthreads();
    if (threadIdx.x == 0) {
        unsigned* bar = b.bar;
        __builtin_amdgcn_s_waitcnt(0);
        unsigned nloc = b.st[0], nx = b.st[1];
        if (nloc == 0u) { xcd_barrier_complete(bar, b.x, nloc, nx); b.st[0] = nloc; b.st[1] = nx; }
        const unsigned old = xb_add(&bar[XB_XSUB(b.x)], 1u);
        const unsigned gen = old / nloc;
        if (old + 1u == (gen + 1u) * nloc) {
            __builtin_amdgcn_fence(__ATOMIC_RELEASE, "agent");
            asm volatile("s_waitcnt vmcnt(0)" ::: "memory");
            const unsigned og = xb_add(&bar[XB_TOP], 1u);
            const unsigned tg = og / nx;
            if (og + 1u == (tg + 1u) * nx) xb_add(&bar[XB_TOPGEN], 1u);
            else XB_SPIN(xb_ld(&bar[XB_TOPGEN]) == tg, bar);
            __builtin_amdgcn_fence(__ATOMIC_ACQUIRE, "agent");
            xb_add(&bar[XB_XGEN(b.x)], 1u);
            asm volatile("s_waitcnt vmcnt(0)" ::: "memory");
        } else {
            XB_SPIN(xb_ld(&bar[XB_XGEN(b.x)]) == gen, bar);
            __builtin_amdgcn_fence(__ATOMIC_ACQUIRE, "agent");
            asm volatile("s_waitcnt vmcnt(0)" ::: "memory");
        }
    }
    __syncthreads();
}

namespace pg8 {
constexpr int BM = 256, BK = 64, HALF = 128, HTB = HALF * BK * 2, STAGE_BYTES = 8 * HTB, NXCD = 8, WGM = 8;
__host__ __device__ __forceinline__ int lds_byte(int r, int c) { const int st = (r >> 4) * 2 + (c >> 5), rr = r & 15, cc = c & 31, ob = rr * 64 + cc * 2; return st * 1024 + (ob ^ (((ob >> 9) & 1) << 5)); }
__host__ __device__ __forceinline__ void stage_rc(int b, int& R, int& C) { const int st = b / 1024, sb = b % 1024, swz = sb ^ (((sb >> 9) & 1) << 5); R = (st >> 1) * 16 + swz / 64; C = (st & 1) * 32 + (swz % 64) / 2; }
__host__ __device__ __forceinline__ int perm32(int rho) { const int n = rho >> 4, i = rho & 15; return 8 * (i >> 2) + 4 * n + (i & 3); }
struct Unit { int pm, pn; };
struct Gemm { const bf16_t* A; const bf16_t* Bt; int M, N, K, lda, ldb; };
struct StaticOrder {
    int nM, nN, nwg, G, c;
    __device__ void init(int M, int N, int G_, int c_) { nM = M / BM; nN = N / BM; nwg = nM * nN; G = G_; c = c_; }
    __device__ bool next(int i, Unit& u) const {
        const long L = (long)i * G + c; if (L >= nwg) return false;
        int wgid = (int)L; { const int q = nwg / NXCD, r = nwg % NXCD, xcd = wgid % NXCD, off = wgid / NXCD; wgid = (xcd < r ? xcd * (q + 1) : r * (q + 1) + (xcd - r) * q) + off; }
        const int nig = WGM * nN, gid = wgid / nig, fm = gid * WGM, gsz = (nM - fm) < WGM ? (nM - fm) : WGM;
        u.pm = fm + ((wgid % nig) % gsz); u.pn = (wgid % nig) / gsz; return true;
    }
};
template <class Epi>
__device__ __forceinline__ void gemm_phase(LAS unsigned char* lds, const Gemm g, const Epi& E) {
    const int tid = otid(), wid = __builtin_amdgcn_readfirstlane(tid >> 6), lane = tid & 63, wr = wid >> 2, wc = wid & 3, fr = lane & 15, fq = lane >> 4;
    StaticOrder S; S.init(g.M, g.N, (int)gridDim.x, (int)blockIdx.x);
    int K = g.K; asm volatile("" : "+s"(K));
    const int nt = K / BK;
    unsigned voffA[2], voffB[2];
#pragma unroll
    for (int i = 0; i < 2; ++i) { int R, C; stage_rc(tid * 16 + i * 8192, R, C); const int Rb = Epi::PERM ? ((R & ~31) + perm32(R & 31)) : R;
        voffA[i] = (unsigned)(R * g.lda + C) * 2u; voffB[i] = (unsigned)(Rb * g.ldb + C) * 2u; }
    const size_t kstep = (size_t)(BK * 2);
    const size_t hstepA = (size_t)HALF * g.lda * 2, hstepB = (size_t)HALF * g.ldb * 2;
    const size_t tstepA = 2 * hstepA, tstepB = 2 * hstepB;
    const unsigned ldsw = (unsigned)wid * 1024u;
    const int aoff = lds_byte(wr * 64 + fr, fq * 8), boff = lds_byte(wc * 32 + fr, fq * 8);
#define PG8_SA(b, h) (((b) * 2 + (h)) * HTB)
#define PG8_SB(b, h) ((4 + (b) * 2 + (h)) * HTB)
#define PG8_STAGE(bufoff, gbase, voff) do { _Pragma("unroll") for (int _i = 0; _i < 2; ++_i) \
        __builtin_amdgcn_global_load_lds((const unsigned*)((const char*)(gbase) + (voff)[_i]), (LAS unsigned*)(lds + (bufoff) + ldsw + _i * 8192), 16, 0, 0); } while (0)
#define PG8_LDA(dst, b, h) do { _Pragma("unroll") for (int m = 0; m < 4; ++m) _Pragma("unroll") for (int k = 0; k < 2; ++k) dst[m][k] = *(const LAS bf16x8*)(lds + PG8_SA(b, h) + aoff + m * 2048 + k * 1024); } while (0)
#define PG8_LDB(dst, b, h) do { _Pragma("unroll") for (int n = 0; n < 2; ++n) _Pragma("unroll") for (int k = 0; k < 2; ++k) dst[n][k] = *(const LAS bf16x8*)(lds + PG8_SB(b, h) + boff + n * 2048 + k * 1024); } while (0)
#define PG8_MMA(ai, bj, At, Bt) do { __builtin_amdgcn_s_setprio(1); _Pragma("unroll") for (int m = 0; m < 4; ++m) _Pragma("unroll") for (int n = 0; n < 2; ++n) _Pragma("unroll") for (int k = 0; k < 2; ++k) \
        acc[ai][bj][m][n] = __builtin_amdgcn_mfma_f32_16x16x32_bf16(Bt[n][k], At[m][k], acc[ai][bj][m][n], 0, 0, 0); __builtin_amdgcn_s_setprio(0); } while (0)
#define PG8_WAIT_V(n) asm volatile("s_waitcnt vmcnt(" #n ")" ::: "memory")
#define PG8_WAIT_L(n) asm volatile("s_waitcnt lgkmcnt(" #n ")" ::: "memory")
#define PG8_BAR __builtin_amdgcn_s_barrier()
#define PG8_SCHED __builtin_amdgcn_sched_barrier(0)
    Unit cur, nxt; int ui = 0;
    if (!S.next(0, cur)) return;
    f32x4 acc[2][2][4][2];
#pragma unroll
    for (int a = 0; a < 2; ++a)
#pragma unroll
        for (int b = 0; b < 2; ++b)
#pragma unroll
            for (int m = 0; m < 4; ++m)
#pragma unroll
                for (int n = 0; n < 2; ++n) acc[a][b][m][n] = (f32x4){0.f, 0.f, 0.f, 0.f};
    bf16x8 At[4][2], B0[2][2], B1[2][2];
    const char* cA = (const char*)g.A + (size_t)cur.pm * tstepA; const char* cB = (const char*)g.Bt + (size_t)cur.pn * tstepB;
    PG8_STAGE(PG8_SB(0, 0), cB, voffB); PG8_STAGE(PG8_SB(0, 1), cB + hstepB, voffB); PG8_STAGE(PG8_SA(0, 0), cA, voffA); PG8_STAGE(PG8_SA(0, 1), cA + hstepA, voffA);
    if (wr == 1) PG8_BAR;
    PG8_WAIT_V(2); PG8_BAR;
    PG8_STAGE(PG8_SB(1, 0), cB + kstep, voffB); PG8_STAGE(PG8_SA(1, 0), cA + kstep, voffA); PG8_STAGE(PG8_SB(1, 1), cB + hstepB + kstep, voffB);
    PG8_WAIT_V(6); PG8_BAR;
    for (;;) {
        const bool has_next = S.next(ui + 1, nxt);
        const char* nA = has_next ? (const char*)g.A + (size_t)nxt.pm * tstepA : cA; const char* nB = has_next ? (const char*)g.Bt + (size_t)nxt.pn * tstepB : cB;
        for (int t = 0; t < nt; t += 2) {
            const bool last = (t == nt - 2);
            const char* a1 = cA + (size_t)(t + 1) * kstep;
            const char* a2 = last ? nA : cA + (size_t)(t + 2) * kstep; const char* b2 = last ? nB : cB + (size_t)(t + 2) * kstep;
            const char* a3 = a2 + kstep; const char* b3 = b2 + kstep;
            PG8_LDB(B0, 0, 0); PG8_LDB(B1, 0, 1); PG8_SCHED; PG8_LDA(At, 0, 0); PG8_STAGE(PG8_SA(1, 1), a1 + hstepA, voffA);
            PG8_WAIT_V(8); PG8_WAIT_L(0); PG8_BAR; PG8_MMA(0, 0, At, B0); PG8_MMA(0, 1, At, B1); PG8_BAR; PG8_SCHED;
            PG8_LDA(At, 0, 1); PG8_STAGE(PG8_SB(0, 0), b2, voffB); PG8_STAGE(PG8_SB(0, 1), b2 + hstepB, voffB); PG8_STAGE(PG8_SA(0, 0), a2, voffA);
            PG8_WAIT_V(8); PG8_WAIT_L(0); PG8_BAR; PG8_MMA(1, 0, At, B0); PG8_MMA(1, 1, At, B1); PG8_BAR; PG8_SCHED;
            PG8_LDB(B0, 1, 0); PG8_LDB(B1, 1, 1); PG8_SCHED; PG8_LDA(At, 1, 0); PG8_STAGE(PG8_SA(0, 1), a2 + hstepA, voffA);
            PG8_WAIT_V(8); PG8_WAIT_L(0); PG8_BAR; PG8_MMA(0, 0, At, B0); PG8_MMA(0, 1, At, B1); PG8_BAR; PG8_SCHED;
            PG8_LDA(At, 1, 1); PG8_STAGE(PG8_SB(1, 0), b3, voffB); PG8_STAGE(PG8_SB(1, 1), b3 + hstepB, voffB); PG8_STAGE(PG8_SA(1, 0), a3, voffA);
            PG8_WAIT_V(8); PG8_WAIT_L(0); PG8_BAR; PG8_MMA(1, 0, At, B0); PG8_MMA(1, 1, At, B1); PG8_BAR; PG8_SCHED;
        }
        if (wr == 0) PG8_BAR;
        { const int l2_ = otid() & 63; E(acc, cur, wr, wc, l2_ & 15, l2_ >> 4); }
        if (!has_next) break;
#pragma unroll
        for (int a = 0; a < 2; ++a)
#pragma unroll
            for (int b = 0; b < 2; ++b)
#pragma unroll
                for (int m = 0; m < 4; ++m)
#pragma unroll
                    for (int n = 0; n < 2; ++n) acc[a][b][m][n] = (f32x4){0.f, 0.f, 0.f, 0.f};
        cur = nxt; cA = nA; cB = nB; ++ui;
        if (wr == 1) PG8_BAR;
    }
    PG8_WAIT_V(0);
    PG8_BAR;
#undef PG8_SA
#undef PG8_SB
#undef PG8_STAGE
#undef PG8_LDA
#undef PG8_LDB
#undef PG8_MMA
#undef PG8_WAIT_V
#undef PG8_WAIT_L
#undef PG8_BAR
#undef PG8_SCHED
}

template <int ACT> struct EpiBf16 {
    static constexpr bool PERM = true;
    bf16_t* O; int ldc;
    __device__ __forceinline__ void operator()(const f32x4 (&acc)[2][2][4][2], const Unit& u, int wr, int wc, int fr, int fq) const {
        const int row0 = u.pm * BM + wr * 64 + fr, col0 = u.pn * BM + wc * 32 + 8 * fq;
#pragma unroll
        for (int ai = 0; ai < 2; ++ai)
#pragma unroll
            for (int m = 0; m < 4; ++m) { bf16_t* rowp = O + (size_t)(row0 + ai * HALF + m * 16) * ldc + col0;
#pragma unroll
                for (int bj = 0; bj < 2; ++bj) { f32x4 v0 = acc[ai][bj][m][0], v1 = acc[ai][bj][m][1];
                    if (ACT == 1) { f32x2 a = gelu_pk((f32x2){v0[0], v0[1]}), b = gelu_pk((f32x2){v0[2], v0[3]}), c = gelu_pk((f32x2){v1[0], v1[1]}), d = gelu_pk((f32x2){v1[2], v1[3]});
                        v0 = (f32x4){a.x, a.y, b.x, b.y}; v1 = (f32x4){c.x, c.y, d.x, d.y}; }
                    u32x4 w; w.x = cvt_pk_bf16(v0[0], v0[1]); w.y = cvt_pk_bf16(v0[2], v0[3]); w.z = cvt_pk_bf16(v1[0], v1[1]); w.w = cvt_pk_bf16(v1[2], v1[3]);
                    *(u32x4*)(rowp + bj * HALF) = w; } }
    }
};
struct EpiResid {
    static constexpr bool PERM = false;
    float* xl; float* xc; const float* gate;
    __device__ __forceinline__ void operator()(const f32x4 (&acc)[2][2][4][2], const Unit& u, int wr, int wc, int fr, int fq) const {
        const int rbase = u.pm * BM; const bool lat = rbase < NLAT;
        float* X = lat ? xl + (size_t)rbase * D : xc + (size_t)(rbase - NLAT) * D;
        const float* gp = gate + (size_t)(lat ? (rbase >> 13) : 4) * 6144;
        const int row0 = wr * 64 + fr, col0 = u.pn * BM + wc * 32 + 4 * fq;
        f32x4 gv[2][2];
#pragma unroll
        for (int bj = 0; bj < 2; ++bj)
#pragma unroll
            for (int n = 0; n < 2; ++n) gv[bj][n] = *(const f32x4*)(gp + col0 + bj * HALF + n * 16);
#pragma unroll
        for (int ai = 0; ai < 2; ++ai)
#pragma unroll
            for (int m = 0; m < 4; ++m) { float* rowp = X + (size_t)(row0 + ai * HALF + m * 16) * D + col0;
#pragma unroll
                for (int bj = 0; bj < 2; ++bj)
#pragma unroll
                    for (int n = 0; n < 2; ++n) { f32x4* p = (f32x4*)(rowp + bj * HALF + n * 16); *p = *p + gv[bj][n] * acc[ai][bj][m][n]; } }
    }
};
}

namespace att {
#define KSWZ(row, colB) ((row) * 256 + ((colB) ^ (((row) & 7) << 4)))
#define KRSWZ(row, colB) ((row) * 128 + ((colB) ^ ((((row) >> 1) & 7) << 4)))
#define SBAR() __builtin_amdgcn_sched_barrier(0)
__device__ __forceinline__ int crow(int r, int hi) { return (r & 3) + 8 * (r >> 2) + 4 * hi; }
__host__ __device__ __forceinline__ int v_st(int k, int c) { const int kk = (k & ~0xC) | ((k & 4) << 1) | ((k & 8) >> 1); return ((kk >> 3) * 4 + (c >> 5)) * 512 + ((kk & 7) * 32 + (c & 31)) * 2; }
__device__ __forceinline__ int v_rd_base(int lane) { return ((lane & 3) << 3) | (((lane >> 2) & 3) << 6) | (((lane >> 4) & 1) << 5) | (((lane >> 5) & 1) << 8); }
constexpr int v_rd_off(int d0, int ks, int half) { return d0 * 512 + ks * 4096 + half * 2048; }
template <int OFF> __device__ __forceinline__ s16x4 tr_read(int vb) {
    s16x4 r; asm volatile("ds_read_b64_tr_b16 %0, %1 offset:%2" : "=&v"(r) : "v"(vb), "i"(OFF) : "memory"); return r;
}
template <int D0> __device__ __forceinline__ void pv_one(f32x16& od, int vb, bf16x8 pa0, bf16x8 pa1, bf16x8 pa2, bf16x8 pa3) {
    const s16x4 l0 = tr_read<v_rd_off(D0, 0, 0)>(vb), h0 = tr_read<v_rd_off(D0, 0, 1)>(vb), l1 = tr_read<v_rd_off(D0, 1, 0)>(vb), h1 = tr_read<v_rd_off(D0, 1, 1)>(vb);
    const s16x4 l2 = tr_read<v_rd_off(D0, 2, 0)>(vb), h2 = tr_read<v_rd_off(D0, 2, 1)>(vb), l3 = tr_read<v_rd_off(D0, 3, 0)>(vb), h3 = tr_read<v_rd_off(D0, 3, 1)>(vb);
    asm volatile("s_waitcnt lgkmcnt(0)" ::: "memory"); SBAR();
#define PK(L, H) (bf16x8){L[0], L[1], L[2], L[3], H[0], H[1], H[2], H[3]}
    od = __builtin_amdgcn_mfma_f32_32x32x16_bf16(pa0, PK(l0, h0), od, 0, 0, 0);
    od = __builtin_amdgcn_mfma_f32_32x32x16_bf16(pa1, PK(l1, h1), od, 0, 0, 0);
    od = __builtin_amdgcn_mfma_f32_32x32x16_bf16(pa2, PK(l2, h2), od, 0, 0, 0);
    od = __builtin_amdgcn_mfma_f32_32x32x16_bf16(pa3, PK(l3, h3), od, 0, 0, 0);
#undef PK
}
__device__ __forceinline__ void pv_d0(f32x16* o, int vb, bf16x8 pa0, bf16x8 pa1, bf16x8 pa2, bf16x8 pa3) {
    pv_one<0>(o[0], vb, pa0, pa1, pa2, pa3); pv_one<1>(o[1], vb, pa0, pa1, pa2, pa3); pv_one<2>(o[2], vb, pa0, pa1, pa2, pa3); pv_one<3>(o[3], vb, pa0, pa1, pa2, pa3);
}
}

namespace att8 {
constexpr int SLOT = 20480, KN_OFF = 0, KR_OFF = 8192, V_OFF = 12288, LDS_BYTES = 3 * SLOT + 8 * 256;
constexpr float THR2 = 8.0f;
constexpr float QUP = 8.f; constexpr int SC_ONE = 0x7f7f7f7f, SC_Q = 0x7c7c7c7c;
__host__ __device__ __forceinline__ int kn8(int key, int b) { return key * 128 + ((((b >> 4) ^ ((key >> 1) & 7))) << 4) + (b & 15); }
__host__ __device__ __forceinline__ int kr8(int key, int b) { return key * 64 + ((((b >> 4) ^ ((key >> 2) & 3))) << 4) + (b & 15); }
__host__ __device__ __forceinline__ int vslot(int k) { return 32 * ((k >> 2) & 1) + 16 * (k >> 5) + (k & 3) + 4 * ((k & 31) >> 3); }
__host__ __device__ __forceinline__ int v8(int d, int k) { const int sl = vslot(k); return d * 64 + ((((sl >> 4) ^ ((d >> 2) & 3))) << 4) + (sl & 15); }
__device__ __forceinline__ i32x8 ld32(const LAS unsigned char* a0, const LAS unsigned char* a1) { const u32x4 x = *(const LAS u32x4*)a0, y = *(const LAS u32x4*)a1;
    return (i32x8){(int)x.x, (int)x.y, (int)x.z, (int)x.w, (int)y.x, (int)y.y, (int)y.z, (int)y.w}; }
__device__ __forceinline__ void qkt(f32x16& p0, f32x16& p1, LAS unsigned char* slot, const i32x8* qf, int r32, int hi) {
    p0 = f32x16{}; p1 = f32x16{};
#pragma unroll
    for (int ks = 0; ks < 2; ++ks) { const int b = 64 * ks + 32 * hi;
        const i32x8 a0 = ld32(slot + KN_OFF + kn8(r32, b), slot + KN_OFF + kn8(r32, b + 16)), a1 = ld32(slot + KN_OFF + kn8(32 + r32, b), slot + KN_OFF + kn8(32 + r32, b + 16));
        p0 = __builtin_amdgcn_mfma_scale_f32_32x32x64_f8f6f4(a0, qf[ks], p0, 0, 0, 0, SC_ONE, 0, SC_Q);
        p1 = __builtin_amdgcn_mfma_scale_f32_32x32x64_f8f6f4(a1, qf[ks], p1, 0, 0, 0, SC_ONE, 0, SC_Q); }
    { const int b = 32 * hi;
        const i32x8 a0 = ld32(slot + KR_OFF + kr8(r32, b), slot + KR_OFF + kr8(r32, b + 16)), a1 = ld32(slot + KR_OFF + kr8(32 + r32, b), slot + KR_OFF + kr8(32 + r32, b + 16));
        p0 = __builtin_amdgcn_mfma_scale_f32_32x32x64_f8f6f4(a0, qf[2], p0, 0, 0, 0, SC_ONE, 0, SC_Q);
        p1 = __builtin_amdgcn_mfma_scale_f32_32x32x64_f8f6f4(a1, qf[2], p1, 0, 0, 0, SC_ONE, 0, SC_Q); }
}
__device__ __forceinline__ void partialSM(f32x16& p0, f32x16& p1, float& m_reg, float& mn, float& alpha) {
    float pmax = p0[0];
#pragma unroll
    for (int r = 1; r < 16; ++r) pmax = fmaxf(pmax, p0[r]);
#pragma unroll
    for (int r = 0; r < 16; ++r) pmax = fmaxf(pmax, p1[r]);
    { auto rr = __builtin_amdgcn_permlane32_swap(__float_as_uint(pmax), __float_as_uint(pmax), false, false);
      pmax = fmaxf(__uint_as_float(rr[0]), __uint_as_float(rr[1])); }
    if (__builtin_expect(__all(pmax - m_reg <= THR2), 1)) { mn = m_reg; alpha = 1.f; }
    else { mn = fmaxf(m_reg, pmax); alpha = __builtin_amdgcn_exp2f(m_reg - mn); m_reg = mn; }
#pragma unroll
    for (int r = 0; r < 16; ++r) p0[r] = __builtin_amdgcn_exp2f(p0[r] - mn);
#pragma unroll
    for (int r = 0; r < 16; ++r) p1[r] = p1[r] - mn;
}
__device__ __forceinline__ void finishSM(f32x16& p0, f32x16& p1, float alpha, float& l_reg, i32x8& pf) {
#pragma unroll
    for (int r = 0; r < 16; ++r) p1[r] = __builtin_amdgcn_exp2f(p1[r]);
    float ps = 0;
#pragma unroll
    for (int r = 0; r < 16; ++r) ps += p0[r];
#pragma unroll
    for (int r = 0; r < 16; ++r) ps += p1[r];
    { auto rr = __builtin_amdgcn_permlane32_swap(__float_as_uint(ps), __float_as_uint(ps), false, false);
      ps = __uint_as_float(rr[0]) + __uint_as_float(rr[1]); }
    l_reg = l_reg * alpha + ps;
#pragma unroll
    for (int w = 0; w < 4; ++w) { pf[w] = (int)pk4_fp8(p0[4 * w], p0[4 * w + 1], p0[4 * w + 2], p0[4 * w + 3]); pf[4 + w] = (int)pk4_fp8(p1[4 * w], p1[4 * w + 1], p1[4 * w + 2], p1[4 * w + 3]); }
}
__device__ __forceinline__ void pv(f32x16* o, LAS unsigned char* slot, const i32x8 pf, int r32, int hi) {
#pragma unroll
    for (int d0 = 0; d0 < 4; ++d0) { const int d = 32 * d0 + r32, sw = (d >> 2) & 3;
        const i32x8 b = ld32(slot + V_OFF + d * 64 + (((2 * hi) ^ sw) << 4), slot + V_OFF + d * 64 + (((2 * hi + 1) ^ sw) << 4));
        o[d0] = __builtin_amdgcn_mfma_scale_f32_32x32x64_f8f6f4(pf, b, o[d0], 0, 0, 0, SC_ONE, 0, SC_ONE); }
}
__device__ __forceinline__ int crow(int r, int hi) { return (r & 3) + 8 * (r >> 2) + 4 * hi; }
__device__ __forceinline__ void attn_unit(const unsigned char* __restrict__ Qb, const unsigned char* __restrict__ KNt, const unsigned char* __restrict__ KRt, const unsigned char* __restrict__ Vt,
                                          bf16_t* __restrict__ Ob, int NT, LAS unsigned char* lds) {
    const int tid = otid(), wid = __builtin_amdgcn_readfirstlane(tid >> 6), lane = tid & 63, r32 = lane & 31, hi = lane >> 5;
    LAS float* wsf = (LAS float*)(lds + 3 * SLOT) + wid * 64; LAS float* li_l = wsf; LAS float* al_l = wsf + 32;
    float m_reg = -1e30f, l_reg = 0; f32x16 o[4] = {}; i32x8 qf[3];
    const unsigned char* Qw = Qb + (size_t)(wid * 32 + r32) * 192 + 32 * hi;
#pragma unroll
    for (int ks = 0; ks < 3; ++ks) { const u32x4 x = *(const u32x4*)(Qw + 64 * ks), y = *(const u32x4*)(Qw + 64 * ks + 16); qf[ks] = (i32x8){(int)x.x, (int)x.y, (int)x.z, (int)x.w, (int)y.x, (int)y.y, (int)y.z, (int)y.w}; }
    const unsigned lo16 = (unsigned)lane * 16u;
#define ATT_DMA(tile, slotoff) do { const size_t t_ = (size_t)(tile); LAS unsigned char* sl_ = lds + (slotoff); \
        __builtin_amdgcn_global_load_lds((const unsigned*)(KNt + t_ * 8192 + wid * 1024 + lo16), (LAS unsigned*)(sl_ + KN_OFF + wid * 1024), 16, 0, 0); \
        __builtin_amdgcn_global_load_lds((const unsigned*)(Vt + t_ * 8192 + wid * 1024 + lo16), (LAS unsigned*)(sl_ + V_OFF + wid * 1024), 16, 0, 0); \
        if (wid < 4) __builtin_amdgcn_global_load_lds((const unsigned*)(KRt + t_ * 4096 + wid * 1024 + lo16), (LAS unsigned*)(sl_ + KR_OFF + wid * 1024), 16, 0, 0); } while (0)
#define ATT_SYNC() do { asm volatile("s_waitcnt vmcnt(0)" ::: "memory"); __builtin_amdgcn_s_barrier(); asm volatile("" ::: "memory"); } while (0)
#define RESC(a) do { if (__any((a) < 1.f)) { if (hi == 0) al_l[r32] = (a); asm volatile("s_waitcnt lgkmcnt(0)" ::: "memory"); \
        _Pragma("unroll") for (int d = 0; d < 4; ++d) _Pragma("unroll") for (int r = 0; r < 16; ++r) o[d][r] *= al_l[crow(r, hi)]; } } while (0)
    f32x16 pA0, pA1, pB0, pB1; float mnA, mnB, alA, alB; i32x8 pf;
    int sp = 0, sc = SLOT, sn = 2 * SLOT;
    ATT_DMA(0, 0);
    ATT_SYNC();
    ATT_DMA(1, SLOT);
    qkt(pA0, pA1, lds, qf, r32, hi); partialSM(pA0, pA1, m_reg, mnA, alA);
    for (int j = 1; j + 1 < NT; j += 2) {
        ATT_SYNC(); ATT_DMA(j + 1, sn);
        SBAR(); qkt(pB0, pB1, lds + sc, qf, r32, hi);
        finishSM(pA0, pA1, alA, l_reg, pf); SBAR();
        pv(o, lds + sp, pf, r32, hi); partialSM(pB0, pB1, m_reg, mnB, alB);
        RESC(alB);
        { const int t_ = sp; sp = sc; sc = sn; sn = t_; }
        ATT_SYNC(); if (j + 2 < NT) ATT_DMA(j + 2, sn);
        SBAR(); qkt(pA0, pA1, lds + sc, qf, r32, hi);
        finishSM(pB0, pB1, alB, l_reg, pf); SBAR();
        pv(o, lds + sp, pf, r32, hi); partialSM(pA0, pA1, m_reg, mnA, alA);
        RESC(alA);
        { const int t_ = sp; sp = sc; sc = sn; sn = t_; }
    }
    ATT_SYNC();
    SBAR(); qkt(pB0, pB1, lds + sc, qf, r32, hi);
    finishSM(pA0, pA1, alA, l_reg, pf); SBAR();
    pv(o, lds + sp, pf, r32, hi); partialSM(pB0, pB1, m_reg, mnB, alB);
    RESC(alB);
    finishSM(pB0, pB1, alB, l_reg, pf); SBAR();
    pv(o, lds + sc, pf, r32, hi);
    if (hi == 0) li_l[r32] = l_reg; asm volatile("s_waitcnt lgkmcnt(0)" ::: "memory");
    float rli[16];
#pragma unroll
    for (int r = 0; r < 16; ++r) rli[r] = __builtin_amdgcn_rcpf(li_l[crow(r, hi)]);
    bf16_t* Ow = Ob + (size_t)(wid * 32) * 2048;
#pragma unroll
    for (int r = 0; r < 16; ++r) { const int orow = crow(r, hi);
#pragma unroll
        for (int d0 = 0; d0 < 4; ++d0) Ow[(size_t)orow * 2048 + d0 * 32 + r32] = f2bf(o[d0][r] * rli[r]); }
    __builtin_amdgcn_s_barrier(); asm volatile("" ::: "memory");
#undef ATT_DMA
#undef ATT_SYNC
#undef RESC
}
}

namespace ssd {
constexpr int XT_OFF = 0, BT_OFF = 17408, HB_OFF = 52224, SET = 69632, CW_OFF = 2 * SET, LDS_BYTES = CW_OFF + 8 * 1536;
constexpr int PITCH = 272;
constexpr float L2E = 1.4426950408889634f;
__device__ __forceinline__ void g_unit(const bf16_t* __restrict__ BC, bf16_t* __restrict__ G, int unit) {
    const int cid = unit >> 1, g = unit & 1;
    const int r0 = cid < 256 ? cid * 128 : NLAT + (cid - 256) * 128;
    const int tid = otid(), wid = tid >> 6, lane = tid & 63, fr = lane & 15, fq = lane >> 4;
    const bf16_t* Cp = BC + (size_t)(r0 + 16 * wid + fr) * 512 + 256 + 128 * g + 8 * fq;
    bf16x8 cf[4];
#pragma unroll
    for (int ks = 0; ks < 4; ++ks) cf[ks] = *(const bf16x8*)(Cp + 32 * ks);
    bf16_t* Gp = G + ((size_t)unit * 128 + 16 * wid + fr) * 128 + 4 * fq;
#pragma unroll
    for (int sb = 0; sb < 8; ++sb) {
        const bf16_t* Bp = BC + (size_t)(r0 + 16 * sb + fr) * 512 + 128 * g + 8 * fq;
        f32x4 acc = {0.f, 0.f, 0.f, 0.f};
#pragma unroll
        for (int ks = 0; ks < 4; ++ks) { const bf16x8 bfr = *(const bf16x8*)(Bp + 32 * ks); acc = __builtin_amdgcn_mfma_f32_16x16x32_bf16(bfr, cf[ks], acc, 0, 0, 0); }
        u32x2 w; w.x = cvt_pk_bf16(acc[0], acc[1]); w.y = cvt_pk_bf16(acc[2], acc[3]);
        *(u32x2*)(Gp + 16 * sb) = w;
    }
}
__device__ __forceinline__ void ssd_unit(int b, int h, int d, const bf16_t* __restrict__ XS, const bf16_t* __restrict__ BC, const float* __restrict__ DT, const bf16_t* __restrict__ G,
                                         const float* __restrict__ a_log, bf16_t* __restrict__ Y, LAS unsigned char* lds) {
    const int g = h >> 3;
    const int tid = otid(), wid = tid >> 6, lane = tid & 63, fr = lane & 15, fq = lane >> 4;
    const float a = -__expf(a_log[d * 16 + h]);
    LAS float* cw = (LAS float*)(lds + CW_OFF + wid * 1536); LAS float* dts = cw + 128; LAS float* dtw = cw + 256;
    f32x4 hs[4];
#pragma unroll
    for (int q = 0; q < 4; ++q) hs[q] = (f32x4){0.f, 0.f, 0.f, 0.f};
    for (int i = tid; i < 17408 / 4; i += 512) ((LAS unsigned*)(lds + HB_OFF))[i] = 0u;
    float cend = 0.f;
#define SSD_ROWS(step, r0v, gidv) do { if ((step) < 2) { const int oc_ = d ? 1 - (step) : (step); r0v = NLAT + b * 256 + oc_ * 128; gidv = 256 + b * 2 + oc_; } \
        else { const int lc_ = (step) - 2, oc_ = d ? 63 - lc_ : lc_; r0v = b * 8192 + oc_ * 128; gidv = b * 64 + oc_; } } while (0)
    const int sg = tid & 31, n8 = tid >> 5, p4 = tid >> 5;
    f32x2 P_da, Q_da; u32x2 P_xv[4], Q_xv[4]; u32x4 P_bv[4], Q_bv[4], n_gv[4], n_cv[4], c_gv[4], c_cv[4];
#define SSD_LOAD(step, X) do { int r0_, gid_; SSD_ROWS(step, r0_, gid_); (void)gid_; X##_da = *(const f32x2*)(DT + (size_t)(d * 16 + h) * NROW + r0_ + 2 * lane); \
        _Pragma("unroll") for (int j_ = 0; j_ < 4; ++j_) { X##_xv[j_] = *(const u32x2*)(XS + (size_t)(r0_ + 4 * sg + j_) * 1024 + 64 * h + 4 * p4); \
                                                         X##_bv[j_] = *(const u32x4*)(BC + (size_t)(r0_ + 4 * sg + j_) * 512 + 128 * g + 8 * n8); } } while (0)
#define SSD_LOADGC(step) do { int r0_, gid_; SSD_ROWS(step, r0_, gid_); const int t_ = 16 * wid + fr; const bf16_t* Gp_ = G + ((size_t)(gid_ * 2 + g) * 128 + t_) * 128 + 8 * fq; const bf16_t* Cp_ = BC + (size_t)(r0_ + t_) * 512 + 256 + 128 * g + 8 * fq; \
          _Pragma("unroll") for (int ks_ = 0; ks_ < 4; ++ks_) { n_gv[ks_] = *(const u32x4*)(Gp_ + 32 * ks_); n_cv[ks_] = *(const u32x4*)(Cp_ + 32 * ks_); } } while (0)
#define SSD_GCROT() do { _Pragma("unroll") for (int ks_ = 0; ks_ < 4; ++ks_) { c_gv[ks_] = n_gv[ks_]; c_cv[ks_] = n_cv[ks_]; } } while (0)
#define SSD_WRITE(step, X) do { LAS unsigned char* set_ = lds + ((step) & 1) * SET; \
        const float da0 = X##_da.x * a, da1 = X##_da.y * a; \
        float sc_ = da0 + da1; float c0_, c1_; \
        if (d == 0) { _Pragma("unroll") for (int o_ = 1; o_ < 64; o_ <<= 1) { const float t_ = __shfl_up(sc_, o_); if (lane >= o_) sc_ += t_; } \
            c0_ = sc_ - da1; c1_ = sc_; cend = __shfl(sc_, 63); } \
        else { _Pragma("unroll") for (int o_ = 1; o_ < 64; o_ <<= 1) { const float t_ = __shfl_down(sc_, o_); if (lane + o_ < 64) sc_ += t_; } \
            c0_ = sc_; c1_ = sc_ - da0; cend = __shfl(sc_, 0); } \
        *(LAS f32x2*)(cw + 2 * lane) = (f32x2){c0_, c1_}; *(LAS f32x2*)(dts + 2 * lane) = X##_da; \
        *(LAS f32x2*)(dtw + 2 * lane) = (f32x2){X##_da.x * __builtin_amdgcn_exp2f((cend - c0_) * L2E), X##_da.y * __builtin_amdgcn_exp2f((cend - c1_) * L2E)}; \
        { LAS unsigned char* xt_ = set_ + XT_OFF + (4 * p4) * PITCH + 8 * sg; \
          _Pragma("unroll") for (int i_ = 0; i_ < 4; ++i_) { unsigned e_[4]; \
              _Pragma("unroll") for (int j_ = 0; j_ < 4; ++j_) { const unsigned w_ = (i_ & 2) ? X##_xv[j_].y : X##_xv[j_].x; e_[j_] = (i_ & 1) ? (w_ >> 16) : (w_ & 0xffffu); } \
              u32x2 o_; o_.x = e_[0] | (e_[1] << 16); o_.y = e_[2] | (e_[3] << 16); *(LAS u32x2*)(xt_ + i_ * PITCH) = o_; } } \
        { LAS unsigned char* bt_ = set_ + BT_OFF + (8 * n8) * PITCH + 8 * sg; \
          _Pragma("unroll") for (int i_ = 0; i_ < 8; ++i_) { unsigned e_[4]; \
              _Pragma("unroll") for (int j_ = 0; j_ < 4; ++j_) { const unsigned w_ = X##_bv[j_][i_ >> 1]; e_[j_] = (i_ & 1) ? (w_ >> 16) : (w_ & 0xffffu); } \
              u32x2 o_; o_.x = e_[0] | (e_[1] << 16); o_.y = e_[2] | (e_[3] << 16); *(LAS u32x2*)(bt_ + i_ * PITCH) = o_; } } \
        asm volatile("s_waitcnt lgkmcnt(0)" ::: "memory"); \
    } while (0)
    SSD_LOAD(0, Q); SSD_LOADGC(0); SSD_WRITE(0, Q); SSD_LOAD(1, P);
    for (int step2 = 0; step2 < 66; step2 += 2)
#pragma unroll
    for (int par = 0; par < 2; ++par) {
        const int step = step2 + par;
        __syncthreads();
        int r0, gid; SSD_ROWS(step, r0, gid); (void)gid;
        LAS unsigned char* set = lds + (step & 1) * SET;
        const float cend_cur = cend;
        SSD_GCROT();
        if (step + 1 < 66) SSD_LOADGC(step + 1);
        if (step + 2 < 66) { if (par == 0) SSD_LOAD(step + 2, Q); else SSD_LOAD(step + 2, P); }
        {
            const int t = 16 * wid + fr; const float ct = cw[t];
            f32x4 y[4];
#pragma unroll
            for (int q = 0; q < 4; ++q) y[q] = (f32x4){0.f, 0.f, 0.f, 0.f};
            const float et = __builtin_amdgcn_exp2f(ct * L2E);
#pragma unroll
            for (int ks = 0; ks < 4; ++ks) {
                const bool live = d == 0 ? (32 * ks <= 16 * wid + 15) : (32 * ks + 31 >= 16 * wid);
                if (live) {
                    const int s0 = 32 * ks + 8 * fq;
                    const f32x4 c0 = *(const LAS f32x4*)(cw + s0), c1 = *(const LAS f32x4*)(cw + s0 + 4), d0v = *(const LAS f32x4*)(dts + s0), d1v = *(const LAS f32x4*)(dts + s0 + 4);
                    float m[8];
#pragma unroll
                    for (int i = 0; i < 8; ++i) { const float cs = i < 4 ? c0[i & 3] : c1[i & 3], dv = i < 4 ? d0v[i & 3] : d1v[i & 3]; const int s = s0 + i;
                        const bool ok = d == 0 ? (s <= t) : (s >= t);
                        const float gval = (i & 1) ? bfhi(c_gv[ks][i >> 1]) : bflo(c_gv[ks][i >> 1]);
                        m[i] = ok ? gval * dv * __builtin_amdgcn_exp2f((ct - cs) * L2E) : 0.f; }
                    u32x4 mw; mw.x = cvt_pk_bf16(m[0], m[1]); mw.y = cvt_pk_bf16(m[2], m[3]); mw.z = cvt_pk_bf16(m[4], m[5]); mw.w = cvt_pk_bf16(m[6], m[7]);
                    const bf16x8 mb = __builtin_bit_cast(bf16x8, mw);
#pragma unroll
                    for (int q = 0; q < 4; ++q) { const bf16x8 af = *(const LAS bf16x8*)(set + XT_OFF + (16 * q + fr) * PITCH + (32 * ks + 8 * fq) * 2);
                        y[q] = __builtin_amdgcn_mfma_f32_16x16x32_bf16(af, mb, y[q], 0, 0, 0); }
                }
            }
#pragma unroll
            for (int ks = 0; ks < 4; ++ks) {
                u32x4 cwv;
#pragma unroll
                for (int i = 0; i < 4; ++i) cwv[i] = cvt_pk_bf16(bflo(c_cv[ks][i]) * et, bfhi(c_cv[ks][i]) * et);
                const bf16x8 cb = __builtin_bit_cast(bf16x8, cwv);
#pragma unroll
                for (int q = 0; q < 4; ++q) { const bf16x8 af = *(const LAS bf16x8*)(set + HB_OFF + (16 * q + fr) * PITCH + (32 * ks + 8 * fq) * 2);
                    y[q] = __builtin_amdgcn_mfma_f32_16x16x32_bf16(af, cb, y[q], 0, 0, 0); }
            }
            bf16_t* yp = Y + (size_t)(r0 + t) * 1024 + 64 * h + 4 * fq;
#pragma unroll
            for (int q = 0; q < 4; ++q) { u32x2 w; w.x = cvt_pk_bf16(y[q][0], y[q][1]); w.y = cvt_pk_bf16(y[q][2], y[q][3]); *(u32x2*)(yp + 16 * q) = w; }
        }
        {
            const float dec = __builtin_amdgcn_exp2f(cend_cur * L2E);
#pragma unroll
            for (int q = 0; q < 4; ++q) hs[q] = hs[q] * dec;
#pragma unroll
            for (int ks = 0; ks < 4; ++ks) {
                const int s0 = 32 * ks + 8 * fq;
                const u32x4 braw = *(const LAS u32x4*)(set + BT_OFF + (16 * wid + fr) * PITCH + s0 * 2);
                const f32x4 w0 = *(const LAS f32x4*)(dtw + s0), w1 = *(const LAS f32x4*)(dtw + s0 + 4);
                u32x4 bw; bw.x = cvt_pk_bf16(bflo(braw.x) * w0[0], bfhi(braw.x) * w0[1]); bw.y = cvt_pk_bf16(bflo(braw.y) * w0[2], bfhi(braw.y) * w0[3]);
                          bw.z = cvt_pk_bf16(bflo(braw.z) * w1[0], bfhi(braw.z) * w1[1]); bw.w = cvt_pk_bf16(bflo(braw.w) * w1[2], bfhi(braw.w) * w1[3]);
                const bf16x8 bfr = __builtin_bit_cast(bf16x8, bw);
#pragma unroll
                for (int q = 0; q < 4; ++q) { const bf16x8 af = *(const LAS bf16x8*)(set + XT_OFF + (16 * q + fr) * PITCH + s0 * 2);
                    hs[q] = __builtin_amdgcn_mfma_f32_16x16x32_bf16(af, bfr, hs[q], 0, 0, 0); }
            }
            LAS bf16_t* hb = (LAS bf16_t*)(lds + ((step + 1) & 1) * SET + HB_OFF) + 16 * wid + fr;
#pragma unroll
            for (int q = 0; q < 4; ++q)
#pragma unroll
                for (int i = 0; i < 4; ++i) hb[(16 * q + 4 * fq + i) * 136] = f2bf(hs[q][i]);
        }
        if (step + 1 < 66) { if (par == 0) SSD_WRITE(step + 1, P); else SSD_WRITE(step + 1, Q); }
    }
    __syncthreads();
#undef SSD_ROWS
#undef SSD_LOAD
#undef SSD_LOADGC
#undef SSD_GCROT
#undef SSD_WRITE
}
}

struct Args { const float* in[32]; float* out; unsigned char* ws; int ph_lo, ph_hi; };
constexpr int NTHR = 512;
constexpr int LDS_BASE = 256;
constexpr int LDS_PHASE = 151808;
constexpr int LDS_BYTES = LDS_BASE + LDS_PHASE;
static_assert(att8::LDS_BYTES <= LDS_PHASE && ssd::LDS_BYTES <= LDS_PHASE && pg8::STAGE_BYTES <= LDS_PHASE, "LDS");

__device__ __forceinline__ void tjob(int j, const Args& A, const float*& src, bf16_t*& dst, int& K, int& N, int& Npad, int& mode, const float*& ks) {
    unsigned char* W = A.ws + WS_W; mode = 0; ks = nullptr;
    if (j < 8) { const int i = j >> 2, w = j & 3; unsigned char* base = W + W_HYB + (size_t)i * WH_SZ;
        if (w == 0)      { src = A.in[I_HWIN] + (size_t)i * 1024 * HYB_IN; dst = (bf16_t*)(base + WH_IN); K = 1024; N = HYB_IN; Npad = HYB_INP; mode = 1; }
        else if (w == 1) { src = A.in[I_WQB] + (size_t)i * 384 * 1536; dst = (bf16_t*)(base + WH_QB); K = 384; N = 1536; Npad = 1536; mode = 2; ks = A.in[I_QNG] + i * 384; }
        else if (w == 2) { src = A.in[I_WKVB] + (size_t)i * 256 * 2048; dst = (bf16_t*)(base + WH_KVB); K = 256; N = 2048; Npad = 2048; ks = A.in[I_KVNG] + i * 256; }
        else             { src = A.in[I_HWOUT] + (size_t)i * 2048 * 1024; dst = (bf16_t*)(base + WH_OUT); K = 2048; N = 1024; Npad = 1024; }
    } else if (j < 12) { const int i = (j - 8) >> 1, w = (j - 8) & 1; unsigned char* base = W + W_GM + (size_t)i * WG_SZ;
        if (w == 0) { src = A.in[I_GWIN] + (size_t)i * 1024 * 4096; dst = (bf16_t*)(base + WG_IN); K = 1024; N = 4096; Npad = 4096; }
        else        { src = A.in[I_GWOUT] + (size_t)i * 2048 * 1024; dst = (bf16_t*)(base + WG_OUT); K = 2048; N = 1024; Npad = 1024; }
    } else { const int l = j - 12; src = A.in[I_PWQ] + (size_t)l * 1024 * 2048; dst = (bf16_t*)(W + W_PEER + (size_t)l * WP_SZ + WP_Q); K = 1024; N = 2048; Npad = 2048; }
}
__device__ __forceinline__ int colmap(int mode, int n, int N) {
    if (mode == 1) { if (n >= N) return -1; if (n < C_KR) return n; const int m = n - C_KR; return C_KR + (m >> 1) + 32 * (m & 1); }
    if (mode == 2) { if (n < 1024) return (n >> 7) * 192 + (n & 127); const int m = n - 1024, h = m >> 6, mm = m & 63; return h * 192 + 128 + (mm >> 1) + 32 * (mm & 1); }
    return n;
}
__device__ __forceinline__ void phase_prologue(const Args& A, LAS unsigned char* lds) {
    const int tid = otid();
    {
        LAS float* tile = (LAS float*)lds;
        int item = blockIdx.x;
        for (int j = 0; j < 16; ++j) {
            const float* src; bf16_t* dst; int K, N, Npad, mode; const float* ks; tjob(j, A, src, dst, K, N, Npad, mode, ks);
            const int nsub = (K % 256 == 0) ? 4 : 2, tk = K / (64 * nsub), tn = Npad / 64, nt = tk * tn;
            for (; item < nt; item += gridDim.x) {
                const int k0 = (item % tk) * 64 * nsub, n0 = (item / tk) * 64;
                { const int k = tid >> 3, cg = tid & 7; float v[4][8];
#pragma unroll
                  for (int t = 0; t < 4; ++t) if (t < nsub) { const float sc = ks ? ks[k0 + 64 * t + k] : 1.f;
#pragma unroll
                      for (int jj = 0; jj < 8; ++jj) { const int oc = colmap(mode, n0 + 8 * cg + jj, N); v[t][jj] = oc >= 0 ? src[(size_t)(k0 + 64 * t + k) * N + oc] * sc : 0.f; } }
#pragma unroll
                  for (int t = 0; t < 4; ++t) if (t < nsub) {
#pragma unroll
                      for (int jj = 0; jj < 8; ++jj) tile[t * 4160 + k * 65 + 8 * cg + jj] = v[t][jj]; } }
                __syncthreads();
                { const int n = tid >> 3, kg = tid & 7;
#pragma unroll
                  for (int t = 0; t < 4; ++t) if (t < nsub) { float v[8];
#pragma unroll
                      for (int jj = 0; jj < 8; ++jj) v[jj] = tile[t * 4160 + (8 * kg + jj) * 65 + n];
                      u32x4 w; w.x = cvt_pk_bf16(v[0], v[1]); w.y = cvt_pk_bf16(v[2], v[3]); w.z = cvt_pk_bf16(v[4], v[5]); w.w = cvt_pk_bf16(v[6], v[7]);
                      *(u32x4*)(dst + (size_t)(n0 + n) * K + k0 + 64 * t + 8 * kg) = w; } }
                __syncthreads();
            }
            item -= nt;
        }
    }
    {
        const int gthr = blockIdx.x * NTHR + tid, nthr = gridDim.x * NTHR;
        for (int p = gthr; p < 10 * 16384; p += nthr) {
            const int mat = p >> 14, off = (p & 16383) * 8; const float* src; bf16_t* dst;
            if (mat < 2)      { src = A.in[I_GWS] + (size_t)mat * 131072; dst = (bf16_t*)(A.ws + WS_W + W_GM + (size_t)mat * WG_SZ + WG_WS); }
            else if (mat < 6) { src = A.in[I_PK1] + (size_t)(mat - 2) * 131072; dst = (bf16_t*)(A.ws + WS_W + W_PEER + (size_t)(mat - 2) * WP_SZ + WP_K1); }
            else              { src = A.in[I_PK2] + (size_t)(mat - 6) * 131072; dst = (bf16_t*)(A.ws + WS_W + W_PEER + (size_t)(mat - 6) * WP_SZ + WP_K2); }
            const f32x4 a = *(const f32x4*)(src + off), b = *(const f32x4*)(src + off + 4);
            u32x4 w; w.x = cvt_pk_bf16(a[0], a[1]); w.y = cvt_pk_bf16(a[2], a[3]); w.z = cvt_pk_bf16(b[0], b[1]); w.w = cvt_pk_bf16(b[2], b[3]);
            *(u32x4*)(dst + off) = w;
        }
        float* rope = (float*)(A.ws + WS_ROPE);
        for (int p = gthr; p < SEQ * 32; p += nthr) { const int l = p >> 5, i = p & 31; const float pos = (float)(i < 16 ? (l >> 6) : (l & 63));
            const float inv = powf(10000.f, -(float)(i & 15) / 16.f), ang = pos * inv; rope[p] = cosf(ang); rope[SEQ * 32 + p] = sinf(ang); }
    }
    {
        LAS float* scond = (LAS float*)lds;
        LAS float* red = scond + 5 * 1024;
        __syncthreads();
        for (int i = tid; i < 5 * 1024; i += NTHR) { const int m = i >> 10, k = i & 1023; const float c = m < 4 ? A.in[I_C][m * 1024 + k] : A.in[I_CCTX][k]; scond[i] = silu_f(c); }
        __syncthreads();
        float* MOD = (float*)(A.ws + WS_MOD);
        for (int item = blockIdx.x; item < 4 * 48; item += gridDim.x) {
            const int layer = item / 48, j0 = (item % 48) * 128; const int c4 = tid & 31, ksl = tid >> 5;
            f32x4 acc[5];
#pragma unroll
            for (int m = 0; m < 5; ++m) acc[m] = (f32x4){0.f, 0.f, 0.f, 0.f};
            const float* wp = A.in[I_ADAW] + ((size_t)layer * 1024 + ksl * 64) * 6144 + j0 + 4 * c4;
            for (int k = 0; k < 64; ++k) { const f32x4 w = *(const f32x4*)(wp + (size_t)k * 6144);
#pragma unroll
                for (int m = 0; m < 5; ++m) acc[m] += w * scond[m * 1024 + ksl * 64 + k]; }
#pragma unroll
            for (int m = 0; m < 5; ++m) *(LAS f32x4*)(red + (ksl * 5 + m) * 128 + 4 * c4) = acc[m];
            __syncthreads();
            for (int i = tid; i < 640; i += NTHR) { const int m = i >> 7, c = i & 127; float s = A.in[I_ADAB][layer * 6144 + j0 + c];
#pragma unroll
                for (int q = 0; q < 16; ++q) s += red[(q * 5 + m) * 128 + c];
                MOD[((size_t)layer * 5 + m) * 6144 + j0 + c] = s; }
            __syncthreads();
        }
    }
}

__device__ __forceinline__ void phase_norm_mod(const float* xl, const float* xc, float* cl, float* cc, const float* g, const float* modl, int sh_idx, bf16_t* H, int nrows) {
    const int tid_ = otid(); const int lane = tid_ & 63, gw = blockIdx.x * 8 + (tid_ >> 6), nw = gridDim.x * 8;
    f32x4 gv[4];
#pragma unroll
    for (int i = 0; i < 4; ++i) gv[i] = *(const f32x4*)(g + 256 * i + 4 * lane);
    for (int r = gw; r < nrows; r += nw) {
        const bool lat = r < NLAT; const float* xp = lat ? xl + (size_t)r * D : xc + (size_t)(r - NLAT) * D;
        f32x4 x[4]; float ss = 0.f;
#pragma unroll
        for (int i = 0; i < 4; ++i) { x[i] = *(const f32x4*)(xp + 256 * i + 4 * lane); ss += x[i][0] * x[i][0] + x[i][1] * x[i][1] + x[i][2] * x[i][2] + x[i][3] * x[i][3]; }
        if (cl) { float* cp = lat ? cl + (size_t)r * D : cc + (size_t)(r - NLAT) * D;
#pragma unroll
            for (int i = 0; i < 4; ++i) *(f32x4*)(cp + 256 * i + 4 * lane) = x[i]; }
        ss = wave_sum(ss); const float rstd = rsqrtf(ss * (1.f / 1024.f) + EPS);
        const float* mp = modl + (size_t)(lat ? (r >> 13) : 4) * 6144 + sh_idx * 1024;
#pragma unroll
        for (int i = 0; i < 4; ++i) { const f32x4 sh = *(const f32x4*)(mp + 256 * i + 4 * lane), sc = *(const f32x4*)(mp + 1024 + 256 * i + 4 * lane);
            const f32x4 hv = (x[i] * rstd) * gv[i] * (sc + 1.f) + sh;
            u32x2 w; w.x = cvt_pk_bf16(hv[0], hv[1]); w.y = cvt_pk_bf16(hv[2], hv[3]);
            *(u32x2*)(H + (size_t)r * D + 256 * i + 4 * lane) = w; }
    }
}
__device__ __forceinline__ void phase_final_norm(float* xl, const float* g, float oscale) {
    const int tid_ = otid(); const int lane = tid_ & 63, gw = blockIdx.x * 8 + (tid_ >> 6), nw = gridDim.x * 8;
    f32x4 gv[4];
#pragma unroll
    for (int i = 0; i < 4; ++i) gv[i] = *(const f32x4*)(g + 256 * i + 4 * lane);
    for (int r = gw; r < NLAT; r += nw) {
        float* xp = xl + (size_t)r * D; f32x4 x[4]; float ss = 0.f;
#pragma unroll
        for (int i = 0; i < 4; ++i) { x[i] = *(const f32x4*)(xp + 256 * i + 4 * lane); ss += x[i][0] * x[i][0] + x[i][1] * x[i][1] + x[i][2] * x[i][2] + x[i][3] * x[i][3]; }
        ss = wave_sum(ss); const float rstd = rsqrtf(ss * (1.f / 1024.f) + EPS);
#pragma unroll
        for (int i = 0; i < 4; ++i) *(f32x4*)(xp + 256 * i + 4 * lane) = (x[i] * (rstd * oscale)) * gv[i];
    }
}

__device__ __forceinline__ void phase_conv(const Args& A, int li) {
    const bf16_t* PROJ = (const bf16_t*)(A.ws + WS_BIG);
    bf16_t* XS = (bf16_t*)(A.ws + WS_R2); bf16_t* BC = (bf16_t*)(A.ws + WS_R2 + R2_BC);
    const int tid = otid();
    {
        for (int item = blockIdx.x * 3; item < (NROW / 64) * 3; item += gridDim.x * 3)
#pragma unroll 1
        for (int sub = 0; sub < 3; ++sub) {
            const int blk = (item + sub) / 3, q = ((item + sub) % 3) * 512 + tid, cg = q % 192, rg = q / 192, c0 = 8 * cg;
            const int rbeg = blk * 64 + rg * 8; int s0, s1;
            if (rbeg < NLAT) { s0 = rbeg & ~8191; s1 = s0 + 8192; } else { s0 = NLAT + ((rbeg - NLAT) & ~255); s1 = s0 + 256; }
            const float* cw = A.in[I_CONVW] + ((size_t)li * 1536 + c0) * 5; const float* cb = A.in[I_CONVB] + (size_t)li * 1536 + c0;
            u32x4 in[12];
#pragma unroll
            for (int i = 0; i < 12; ++i) { const int r = rbeg - 2 + i; in[i] = (r >= s0 && r < s1) ? *(const u32x4*)(PROJ + (size_t)r * HYB_INP + C_XBC + c0) : (u32x4){0u, 0u, 0u, 0u}; }
            float w[8][5], bia[8];
#pragma unroll
            for (int j = 0; j < 8; ++j) { bia[j] = cb[j];
#pragma unroll
                for (int k = 0; k < 5; ++k) w[j][k] = cw[j * 5 + k]; }
#pragma unroll
            for (int rr = 0; rr < 8; ++rr) {
                float o[8];
#pragma unroll
                for (int j = 0; j < 8; ++j) { float sacc = bia[j];
#pragma unroll
                    for (int k = 0; k < 5; ++k) { const unsigned wd = in[rr + k][j >> 1]; sacc += w[j][k] * ((j & 1) ? bfhi(wd) : bflo(wd)); }
                    o[j] = silu_f(sacc); }
                u32x4 pk; pk.x = cvt_pk_bf16(o[0], o[1]); pk.y = cvt_pk_bf16(o[2], o[3]); pk.z = cvt_pk_bf16(o[4], o[5]); pk.w = cvt_pk_bf16(o[6], o[7]);
                const int r = rbeg + rr;
                if (c0 < 1024) *(u32x4*)(XS + (size_t)r * 1024 + c0) = pk; else *(u32x4*)(BC + (size_t)r * 512 + (c0 - 1024)) = pk;
            }
        }
    }
    {
        const int lane = tid & 63, gw = blockIdx.x * 8 + (tid >> 6), nw = gridDim.x * 8;
        float* DT = (float*)(A.ws + WS_BIG + BIG_DT); float* RQ = (float*)(A.ws + WS_RSTD); float* RKV = RQ + NROW;
        unsigned char* KR = A.ws + WS_BIG + BIG_KR; const float* rope = (const float*)(A.ws + WS_ROPE);
        const float dtb = lane < 32 ? A.in[I_DTB][li * 32 + lane] : 0.f;
        for (int rb = gw * 4; rb < NROW; rb += nw * 4) {
            unsigned wq[4][3]; u32x2 wk[4]; unsigned wr_[4]; float dtv[4], rc[4], rsn[4];
#pragma unroll
            for (int i = 0; i < 4; ++i) { const int r = rb + i; const bf16_t* p = PROJ + (size_t)r * HYB_INP;
                const unsigned* q = (const unsigned*)(p + C_CQ + 6 * lane); wq[i][0] = q[0]; wq[i][1] = q[1]; wq[i][2] = q[2];
                wk[i] = *(const u32x2*)(p + C_CKV + 4 * lane);
                dtv[i] = lane < 32 ? bf2f(p[C_DT + (lane & 15)]) : 0.f; wr_[i] = lane < 32 ? *(const unsigned*)(p + C_KR + 2 * lane) : 0u;
                const int l = r & 8191; rc[i] = (lane < 32 && r < NLAT) ? rope[l * 32 + lane] : 1.f; rsn[i] = (lane < 32 && r < NLAT) ? rope[SEQ * 32 + l * 32 + lane] : 0.f; }
#pragma unroll
            for (int i = 0; i < 4; ++i) { const int r = rb + i;
                if (lane < 32) DT[(size_t)lane * NROW + r] = softplus_f(dtv[i] + dtb);
                { float ss = 0.f;
#pragma unroll
                  for (int j = 0; j < 3; ++j) { const float a = bflo(wq[i][j]), b = bfhi(wq[i][j]); ss += a * a + b * b; }
                  ss = wave_sum(ss); if (lane == 0) RQ[r] = rsqrtf(ss * (1.f / 384.f) + EPS); }
                { const float a = bflo(wk[i].x), b = bfhi(wk[i].x), c = bflo(wk[i].y), d = bfhi(wk[i].y);
                  float ss = a * a + b * b + c * c + d * d; ss = wave_sum(ss); if (lane == 0) RKV[r] = rsqrtf(ss * (1.f / 256.f) + EPS); }
                if (lane < 32) { const float x1 = bflo(wr_[i]), x2 = bfhi(wr_[i]); int b, key;
                    const float o1 = x1 * rc[i] - x2 * rsn[i], o2 = x1 * rsn[i] + x2 * rc[i];
                    if (r < NLAT) { b = r >> 13; key = 256 + (r & 8191); } else { b = (r - NLAT) >> 8; key = (r - NLAT) & 255; }
                    int w8 = 0; w8 = __builtin_amdgcn_cvt_pk_fp8_f32(sat8(o1), sat8(o2), w8, false);
                    *(unsigned short*)(KR + (size_t)(b * NKT + (key >> 6)) * 4096 + att8::kr8(key & 63, 2 * lane)) = (unsigned short)(w8 & 0xffff); }
            }
        }
    }
}

struct EpiQ {
    static constexpr bool PERM = true;
    unsigned char* Q; const float* rstd; const float* rope;
    __device__ __forceinline__ void operator()(const f32x4 (&acc)[2][2][4][2], const pg8::Unit& u, int wr, int wc, int fr, int fq) const {
        const bool lat = u.pm < 128;
        const int b = lat ? (u.pm >> 5) : (u.pm - 128), q0 = lat ? 256 + ((u.pm & 31) << 8) : 0;
        const bool isrope = u.pn >= 4;
#pragma unroll
        for (int ai = 0; ai < 2; ++ai) {
            const int rl = 128 * ai + 64 * wr + fr;
            const float* rsp = rstd + u.pm * 256 + rl;
            const float* rp = rope + (size_t)(((u.pm & 31) << 8) + rl) * 32;
#pragma unroll
            for (int bj = 0; bj < 2; ++bj) {
                const int c0 = u.pn * 256 + 128 * bj + 32 * wc + 8 * fq; int h, dcol;
                if (!isrope) { h = c0 >> 7; dcol = c0 & 127; } else { const int mq = c0 - 1024; h = mq >> 6; dcol = 128 + (mq & 63); }
                unsigned char* dst = Q + ((size_t)(b * 8 + h) * NKEY + q0 + rl) * 192 + dcol;
                const int ro = (dcol - 128) >> 1;
#pragma unroll
                for (int m = 0; m < 4; ++m) {
                    const float rs = rsp[16 * m] * (QSCALE * att8::QUP);
                    f32x4 v0 = acc[ai][bj][m][0] * rs, v1 = acc[ai][bj][m][1] * rs;
                    if (isrope && lat) { const f32x4 cs = *(const f32x4*)(rp + 16 * m * 32 + ro), sn = *(const f32x4*)(rp + SEQ * 32 + 16 * m * 32 + ro);
                        const f32x4 a0 = v0, a1 = v1;
                        v0[0] = a0[0] * cs[0] - a0[1] * sn[0]; v0[1] = a0[0] * sn[0] + a0[1] * cs[0]; v0[2] = a0[2] * cs[1] - a0[3] * sn[1]; v0[3] = a0[2] * sn[1] + a0[3] * cs[1];
                        v1[0] = a1[0] * cs[2] - a1[1] * sn[2]; v1[1] = a1[0] * sn[2] + a1[1] * cs[2]; v1[2] = a1[2] * cs[3] - a1[3] * sn[3]; v1[3] = a1[2] * sn[3] + a1[3] * cs[3]; }
                    u32x2 w; w.x = pk4_fp8_sat(v0[0], v0[1], v0[2], v0[3]); w.y = pk4_fp8_sat(v1[0], v1[1], v1[2], v1[3]);
                    *(u32x2*)(dst + 16 * m * 192) = w;
                    asm volatile("" ::: "memory");
                }
            }
        }
    }
};
struct EpiKV {
    static constexpr bool PERM = true;
    unsigned char* KN; unsigned char* V; const float* rstd;
    __device__ __forceinline__ void operator()(const f32x4 (&acc)[2][2][4][2], const pg8::Unit& u, int wr, int wc, int fr, int fq) const {
        const bool lat = u.pm < 128;
        const int b = lat ? (u.pm >> 5) : (u.pm - 128), t0 = lat ? 4 + ((u.pm & 31) << 2) : 0;
        const int dd = 32 * wc + 8 * fq;
        const int offK = fr * 128 + ((((dd >> 4) ^ ((fr >> 1) & 7))) << 4) + (dd & 15);
#pragma unroll
        for (int ai = 0; ai < 2; ++ai) {
            const size_t tb = ((size_t)(b * 8 + u.pn) * NKT + t0 + 2 * ai + wr) * 8192;
            const float* rsp = rstd + u.pm * 256 + 128 * ai + 64 * wr + fr;
            unsigned char* kp = KN + tb + offK; unsigned char* vp = V + tb;
#pragma unroll
            for (int m = 0; m < 4; ++m) {
                const float rs = rsp[16 * m];
                { const f32x4 v0 = acc[ai][0][m][0] * rs, v1 = acc[ai][0][m][1] * rs; u32x2 w; w.x = pk4_fp8_sat(v0[0], v0[1], v0[2], v0[3]); w.y = pk4_fp8_sat(v1[0], v1[1], v1[2], v1[3]);
                  *(u32x2*)(kp + m * 2048) = w; }
                { const f32x4 v0 = acc[ai][1][m][0] * rs, v1 = acc[ai][1][m][1] * rs; const unsigned w0 = pk4_fp8_sat(v0[0], v0[1], v0[2], v0[3]), w1 = pk4_fp8_sat(v1[0], v1[1], v1[2], v1[3]);
                  const int sl = att8::vslot(16 * m + fr);
#pragma unroll
                  for (int i = 0; i < 8; ++i) { const int d = dd + i; vp[d * 64 + ((((sl >> 4) ^ ((d >> 2) & 3))) << 4) + (sl & 15)] = (unsigned char)(((i < 4 ? w0 : w1) >> (8 * (i & 3))) & 0xffu); } }
                asm volatile("" ::: "memory");
            }
        }
    }
};

__device__ __forceinline__ void phase_ssd_out(const Args& A, int li, int nrows) {
    const bf16_t* PROJ = (const bf16_t*)(A.ws + WS_BIG); const bf16_t* XS = (const bf16_t*)(A.ws + WS_R2);
    const bf16_t* Y0 = (const bf16_t*)(A.ws + WS_H); const bf16_t* Y1 = (const bf16_t*)(A.ws + WS_R3); bf16_t* CAT = (bf16_t*)(A.ws + WS_R3 + R3_CAT);
    const int tid_ = otid(); const int lane = tid_ & 63, gw = blockIdx.x * 8 + (tid_ >> 6), nw = gridDim.x * 8;
    const float dsk = A.in[I_SSDD][li * 16 + (lane >> 2)];
    float ng[16];
#pragma unroll
    for (int j = 0; j < 16; ++j) ng[j] = A.in[I_SSDNG][li * 1024 + 16 * lane + j];
    for (int r = gw; r < nrows; r += nw) {
        float v[16]; float ss = 0.f;
#pragma unroll
        for (int hh = 0; hh < 2; ++hh) {
            const u32x4 a = *(const u32x4*)(Y0 + (size_t)r * 1024 + 16 * lane + 8 * hh), b = *(const u32x4*)(Y1 + (size_t)r * 1024 + 16 * lane + 8 * hh);
            const u32x4 x = *(const u32x4*)(XS + (size_t)r * 1024 + 16 * lane + 8 * hh), z = *(const u32x4*)(PROJ + (size_t)r * HYB_INP + 16 * lane + 8 * hh);
#pragma unroll
            for (int q = 0; q < 4; ++q) {
                const float y0 = (bflo(a[q]) + bflo(b[q]) + dsk * bflo(x[q])) * silu_f(bflo(z[q])), y1 = (bfhi(a[q]) + bfhi(b[q]) + dsk * bfhi(x[q])) * silu_f(bfhi(z[q]));
                v[8 * hh + 2 * q] = y0; v[8 * hh + 2 * q + 1] = y1; ss += y0 * y0 + y1 * y1; }
        }
#pragma unroll
        for (int o = 16; o >= 1; o >>= 1) ss += __shfl_xor(ss, o);
        const float rstd = rsqrtf(ss * (1.f / 512.f) + EPS);
#pragma unroll
        for (int hh = 0; hh < 2; ++hh) { u32x4 w;
#pragma unroll
            for (int q = 0; q < 4; ++q) w[q] = cvt_pk_bf16(v[8 * hh + 2 * q] * rstd * ng[8 * hh + 2 * q], v[8 * hh + 2 * q + 1] * rstd * ng[8 * hh + 2 * q + 1]);
            *(u32x4*)(CAT + (size_t)r * 2048 + 16 * lane + 8 * hh) = w; }
    }
}

__device__ __forceinline__ void phase_ln_stats(const Args& A, int nrows) {
    const bf16_t* Gb = (const bf16_t*)(A.ws + WS_BIG); float* ST = (float*)(A.ws + WS_RSTD);
    const int tid_ = otid(); const int lane = tid_ & 63, gw = blockIdx.x * 8 + (tid_ >> 6), nw = gridDim.x * 8;
    for (int r = gw; r < nrows; r += nw) {
        float v[32]; float s = 0.f;
#pragma unroll
        for (int j = 0; j < 4; ++j) { const u32x4 w = *(const u32x4*)(Gb + (size_t)r * 4096 + 2048 + 512 * j + 8 * lane);
#pragma unroll
            for (int q = 0; q < 4; ++q) { v[8 * j + 2 * q] = bflo(w[q]); v[8 * j + 2 * q + 1] = bfhi(w[q]); s += v[8 * j + 2 * q] + v[8 * j + 2 * q + 1]; } }
        s = wave_sum(s); const float mu = s * (1.f / 2048.f); float q2 = 0.f;
#pragma unroll
        for (int j = 0; j < 32; ++j) { const float dd = v[j] - mu; q2 += dd * dd; }
        q2 = wave_sum(q2);
        if (lane == 0) { ST[r] = mu; ST[NROW + r] = rsqrtf(q2 * (1.f / 2048.f) + EPS); }
    }
}
__device__ __forceinline__ void phase_spatial(const Args& A, int gi, int nrows, LAS unsigned char* lds) {
    const bf16_t* Gb = (const bf16_t*)(A.ws + WS_BIG); const float* ST = (const float*)(A.ws + WS_RSTD); bf16_t* Ab = (bf16_t*)(A.ws + WS_R1);
    const bf16_t* WSg = (const bf16_t*)(A.ws + WS_W + W_GM + (size_t)gi * WG_SZ + WG_WS);
    const float* lng = A.in[I_GLNG] + (size_t)gi * 2048; const float* lnb = A.in[I_GLNB] + (size_t)gi * 2048; const float* bs = A.in[I_GBS] + (size_t)gi * 1024;
    const int tid = otid(), wid = tid >> 6, lane = tid & 63, r32 = lane & 31, hi = lane >> 5, tb = wid & 3, dh = wid >> 2;
    const int ldsaddr = (int)(unsigned)(uintptr_t)lds;
    u32x4 nv[8]; float nmu[8], nrs[8];
    const int nunits = (nrows / 128) * 8;
#define SP_LOADV(un) do { const int cb_ = (un) >> 3, gg_ = (un) & 7, r0_ = cb_ * 128; \
        _Pragma("unroll") for (int j = 0; j < 8; ++j) { const int idx = tid + 512 * j, s_ = idx >> 5, dd_ = (idx & 31) * 8; \
            nv[j] = *(const u32x4*)(Gb + (size_t)(r0_ + s_) * 4096 + 2048 + 256 * gg_ + dd_); nmu[j] = ST[r0_ + s_]; nrs[j] = ST[NROW + r0_ + s_]; } } while (0)
    if ((int)blockIdx.x < nunits) SP_LOADV((int)blockIdx.x);
    for (int unit = blockIdx.x; unit < nunits; unit += gridDim.x) {
        const int cb = unit >> 3, gg = unit & 7, r0 = cb * 128;
        __syncthreads();
#pragma unroll
        for (int j = 0; j < 8; ++j) { const int idx = tid + 512 * j, s = idx >> 5, dd = (idx & 31) * 8;
            const u32x4 w = nv[j];
            const float mu = nmu[j], rs = nrs[j];
            const f32x4 g0 = *(const f32x4*)(lng + 256 * gg + dd), g1 = *(const f32x4*)(lng + 256 * gg + dd + 4), b0 = *(const f32x4*)(lnb + 256 * gg + dd), b1 = *(const f32x4*)(lnb + 256 * gg + dd + 4);
            u32x4 o;
            o.x = cvt_pk_bf16((bflo(w.x) - mu) * rs * g0[0] + b0[0], (bfhi(w.x) - mu) * rs * g0[1] + b0[1]); o.y = cvt_pk_bf16((bflo(w.y) - mu) * rs * g0[2] + b0[2], (bfhi(w.y) - mu) * rs * g0[3] + b0[3]);
            o.z = cvt_pk_bf16((bflo(w.z) - mu) * rs * g1[0] + b1[0], (bfhi(w.z) - mu) * rs * g1[1] + b1[1]); o.w = cvt_pk_bf16((bflo(w.w) - mu) * rs * g1[2] + b1[2], (bfhi(w.w) - mu) * rs * g1[3] + b1[3]);
            *(LAS u32x4*)(lds + ((s >> 6) * 2 + (dd >> 7)) * 16384 + att::v_st(s & 63, dd & 127)) = o; }
        u32x2 uu[4][4];
        { const bf16_t* up = Gb + (size_t)(r0 + 32 * tb + r32) * 4096 + 256 * gg + 128 * dh + 4 * hi;
#pragma unroll
          for (int d0 = 0; d0 < 4; ++d0)
#pragma unroll
              for (int k = 0; k < 4; ++k) uu[d0][k] = *(const u32x2*)(up + 32 * d0 + 8 * k); }
        if (unit + (int)gridDim.x < nunits) SP_LOADV(unit + (int)gridDim.x);
        bf16x8 pa[8];
#pragma unroll
        for (int ks = 0; ks < 8; ++ks) pa[ks] = *(const bf16x8*)(WSg + ((size_t)gg * 128 + 32 * tb + r32) * 128 + 16 * ks + 8 * hi);
        __syncthreads();
        f32x16 o[4] = {};
#define SP_PV(D0, vbase, p0, p1, p2, p3) do { \
            const s16x4 l0 = att::tr_read<att::v_rd_off(D0, 0, 0)>(vbase), h0 = att::tr_read<att::v_rd_off(D0, 0, 1)>(vbase), l1 = att::tr_read<att::v_rd_off(D0, 1, 0)>(vbase), h1 = att::tr_read<att::v_rd_off(D0, 1, 1)>(vbase); \
            const s16x4 l2 = att::tr_read<att::v_rd_off(D0, 2, 0)>(vbase), h2 = att::tr_read<att::v_rd_off(D0, 2, 1)>(vbase), l3 = att::tr_read<att::v_rd_off(D0, 3, 0)>(vbase), h3 = att::tr_read<att::v_rd_off(D0, 3, 1)>(vbase); \
            asm volatile("s_waitcnt lgkmcnt(0)" ::: "memory"); __builtin_amdgcn_sched_barrier(0); \
            o[D0] = __builtin_amdgcn_mfma_f32_32x32x16_bf16((bf16x8){l0[0], l0[1], l0[2], l0[3], h0[0], h0[1], h0[2], h0[3]}, p0, o[D0], 0, 0, 0); \
            o[D0] = __builtin_amdgcn_mfma_f32_32x32x16_bf16((bf16x8){l1[0], l1[1], l1[2], l1[3], h1[0], h1[1], h1[2], h1[3]}, p1, o[D0], 0, 0, 0); \
            o[D0] = __builtin_amdgcn_mfma_f32_32x32x16_bf16((bf16x8){l2[0], l2[1], l2[2], l2[3], h2[0], h2[1], h2[2], h2[3]}, p2, o[D0], 0, 0, 0); \
            o[D0] = __builtin_amdgcn_mfma_f32_32x32x16_bf16((bf16x8){l3[0], l3[1], l3[2], l3[3], h3[0], h3[1], h3[2], h3[3]}, p3, o[D0], 0, 0, 0); } while (0)
        { const int vb0 = ldsaddr + (0 * 2 + dh) * 16384 + att::v_rd_base(lane), vb1 = ldsaddr + (1 * 2 + dh) * 16384 + att::v_rd_base(lane);
          SP_PV(0, vb0, pa[0], pa[1], pa[2], pa[3]); SP_PV(1, vb0, pa[0], pa[1], pa[2], pa[3]); SP_PV(2, vb0, pa[0], pa[1], pa[2], pa[3]); SP_PV(3, vb0, pa[0], pa[1], pa[2], pa[3]);
          SP_PV(0, vb1, pa[4], pa[5], pa[6], pa[7]); SP_PV(1, vb1, pa[4], pa[5], pa[6], pa[7]); SP_PV(2, vb1, pa[4], pa[5], pa[6], pa[7]); SP_PV(3, vb1, pa[4], pa[5], pa[6], pa[7]); }
#undef SP_PV
        { const int t = 32 * tb + r32, row = r0 + t; const float bsv = bs[gg * 128 + t];
          bf16_t* ap = Ab + (size_t)row * 2048 + 256 * gg + 128 * dh + 4 * hi;
#pragma unroll
          for (int d0 = 0; d0 < 4; ++d0)
#pragma unroll
              for (int k = 0; k < 4; ++k) {
                  const u32x2 u2 = uu[d0][k];
                  u32x2 w; w.x = cvt_pk_bf16(bflo(u2.x) * (o[d0][4 * k] + bsv), bfhi(u2.x) * (o[d0][4 * k + 1] + bsv)); w.y = cvt_pk_bf16(bflo(u2.y) * (o[d0][4 * k + 2] + bsv), bfhi(u2.y) * (o[d0][4 * k + 3] + bsv));
                  *(u32x2*)(ap + 32 * d0 + 8 * k) = w; } }
    }
#undef SP_LOADV
}

constexpr int NSL = 8, SW = 1024 / NSL;
constexpr size_t TAB8_HALF = (size_t)NEXP * 1024, TAB_SCL = 2 * TAB8_HALF, TAB_SET = al256(TAB_SCL + (size_t)2 * NEXP * 4);
static_assert(2 * TAB_SET <= TAB_REGION, "table sets");
__device__ __forceinline__ size_t tabset(int layer) { return WS_TAB + (size_t)(layer & 1) * TAB_SET; }
constexpr float HS = 4.f;
__device__ __forceinline__ void phase_tabcvt(const Args& A, int layer, int wg, int nwg, int r_lo = 0, int r_hi = 2 * NEXP) {
    const int tid_ = otid(); const int lane = tid_ & 63, gw = wg * 8 + (tid_ >> 6), nw = nwg * 8;
    unsigned char* TS = A.ws + tabset(layer); float* SCL = (float*)(TS + TAB_SCL);
    for (int r = r_lo + gw; r < r_hi; r += nw) {
        const int tab = r >> 14, e = r & (NEXP - 1);
        const float* src = (tab ? A.in[I_PV] : A.in[I_PU]) + ((size_t)layer * NEXP + e) * 1024 + 16 * lane;
        f32x4 v[4]; float am = 0.f;
#pragma unroll
        for (int i = 0; i < 4; ++i) { v[i] = *(const f32x4*)(src + 4 * i); am = fmaxf(am, fmaxf(fmaxf(fabsf(v[i][0]), fabsf(v[i][1])), fmaxf(fabsf(v[i][2]), fabsf(v[i][3])))); }
#pragma unroll
        for (int o = 32; o >= 1; o >>= 1) am = fmaxf(am, __shfl_xor(am, o));
        float sc = 1.f; if (am > 0.f) { int ex; (void)frexpf(448.f / am, &ex); sc = ldexpf(1.f, ex - 1); }
        if (lane == 0) SCL[tab * NEXP + e] = 1.f / sc;
        u32x4 w;
#pragma unroll
        for (int i = 0; i < 4; ++i) w[i] = pk4_fp8(v[i][0] * sc, v[i][1] * sc, v[i][2] * sc, v[i][3] * sc);
        *(u32x4*)(TS + (size_t)tab * TAB8_HALF + ((size_t)(lane >> 3) * NEXP + e) * SW + 16 * (lane & 7)) = w;
    }
}
#define CASD(a, b) do { const float hi_ = fmaxf(a, b), lo_ = fminf(a, b); a = hi_; b = lo_; } while (0)
__device__ __forceinline__ void sort16(float (&k)[16]) {
#pragma unroll
    for (int sz = 2; sz <= 16; sz <<= 1)
#pragma unroll
        for (int j = sz >> 1; j > 0; j >>= 1)
#pragma unroll
            for (int i = 0; i < 16; ++i) { const int l = i ^ j; if (l > i) { if ((i & sz) == 0 || sz == 16) CASD(k[i], k[l]); else CASD(k[l], k[i]); } }
}
__device__ __forceinline__ void bmerge16(float (&k)[16]) {
#pragma unroll
    for (int j = 8; j > 0; j >>= 1)
#pragma unroll
        for (int i = 0; i < 16; ++i) { const int l = i ^ j; if (l > i) CASD(k[i], k[l]); }
}
__device__ __forceinline__ void merge_top16(float (&a)[16], const float (&b)[16]) {
#pragma unroll
    for (int i = 0; i < 16; ++i) a[i] = fmaxf(a[i], b[15 - i]);
    bmerge16(a);
}
__device__ __forceinline__ void xmerge_top16(float (&a)[16], int mask) {
    float t[16];
#pragma unroll
    for (int i = 0; i < 16; ++i) t[i] = __shfl_xor(a[15 - i], mask);
#pragma unroll
    for (int i = 0; i < 16; ++i) a[i] = fmaxf(a[i], t[i]);
    bmerge16(a);
}
__device__ __forceinline__ void phase_topk(const Args& A, int layer, int nrows, LAS unsigned char* lds) {
    const bf16_t* QP = (const bf16_t*)(A.ws + WS_BIG); int* IDX = (int*)(A.ws + WS_R2); float* GATE = (float*)(A.ws + WS_R2 + R2_GATE);
    const int tid = otid(), wid = tid >> 6, lane = tid & 63, fr = lane & 15, fq = lane >> 4;
    LAS unsigned* scr = (LAS unsigned*)(lds + 2 * 34816) + wid * 512 + fr * 32;
    int h_staged = -1;
    for (int unit = blockIdx.x; unit < (nrows / 128) * 8; unit += gridDim.x) {
        const int h = unit & 7, r0 = (unit >> 3) * 128;
        if (h != h_staged) { h_staged = h;
        __syncthreads();
        { const bf16_t* k1 = (const bf16_t*)(A.ws + WS_W + W_PEER + (size_t)layer * WP_SZ + WP_K1) + (size_t)h * 16384;
#pragma unroll
          for (int j = 0; j < 8; ++j) { const int idx = tid + 512 * j, half = idx >> 11, rem = idx & 2047, key = rem >> 4, c8 = rem & 15;
              const u32x4 w = *(const u32x4*)(k1 + (size_t)half * 8 * 16384 + key * 128 + 8 * c8);
              *(LAS u32x4*)(lds + half * 34816 + key * 272 + c8 * 16) = w; } }
        __syncthreads(); }
        const int tok = r0 + 16 * wid + fr;
        float top[2][16];
#pragma unroll
        for (int half = 0; half < 2; ++half) {
            bf16x8 qf[4];
#pragma unroll
            for (int ks = 0; ks < 4; ++ks) qf[ks] = *(const bf16x8*)(QP + (size_t)tok * 2048 + 256 * h + 128 * half + 32 * ks + 8 * fq);
            float loc[16];
#pragma unroll
            for (int grp = 0; grp < 2; ++grp) {
                float kk[16];
#pragma unroll
                for (int nbb = 0; nbb < 4; ++nbb) { const int nb = 4 * grp + nbb; f32x4 acc = {0.f, 0.f, 0.f, 0.f};
#pragma unroll
                    for (int ks = 0; ks < 4; ++ks) { const bf16x8 kf = *(const LAS bf16x8*)(lds + half * 34816 + (16 * nb + fr) * 272 + (32 * ks + 8 * fq) * 2);
                        acc = __builtin_amdgcn_mfma_f32_16x16x32_bf16(kf, qf[ks], acc, 0, 0, 0); }
#pragma unroll
                    for (int i = 0; i < 4; ++i) { const unsigned code = 127u - (unsigned)(16 * nb + 4 * fq + i); kk[4 * nbb + i] = __uint_as_float((__float_as_uint(acc[i]) & ~127u) | code); } }
                sort16(kk);
                if (grp == 0) {
#pragma unroll
                    for (int i = 0; i < 16; ++i) loc[i] = kk[i];
                } else merge_top16(loc, kk);
            }
            xmerge_top16(loc, 16); xmerge_top16(loc, 32);
#pragma unroll
            for (int i = 0; i < 16; ++i) top[half][i] = loc[i];
        }
        if (fq < 2) {
#pragma unroll
            for (int i = 0; i < 16; ++i) scr[16 * fq + i] = __float_as_uint(fq == 0 ? top[0][i] : top[1][i]); }
        float fin[16];
#pragma unroll
        for (int aa = 0; aa < 4; ++aa) {
            const float va_k = fq == 0 ? top[0][aa] : fq == 1 ? top[0][4 + aa] : fq == 2 ? top[0][8 + aa] : top[0][12 + aa];
            const float va = __uint_as_float(__float_as_uint(va_k) & ~127u);
            float c[16];
#pragma unroll
            for (int bb = 0; bb < 16; ++bb) { const float s = va + __uint_as_float(__float_as_uint(top[1][bb]) & ~127u);
                c[bb] = __uint_as_float((__float_as_uint(s) & ~255u) | (255u - (unsigned)((4 * fq + aa) * 16 + bb))); }
            if (aa == 0) {
#pragma unroll
                for (int i = 0; i < 16; ++i) fin[i] = c[i];
            } else merge_top16(fin, c);
        }
        xmerge_top16(fin, 16); xmerge_top16(fin, 32);
        float ev[16], es = 0.f; const float mx = __uint_as_float(__float_as_uint(fin[0]) & ~255u);
#pragma unroll
        for (int i = 0; i < 16; ++i) { ev[i] = __expf(__uint_as_float(__float_as_uint(fin[i]) & ~255u) - mx); es += ev[i]; }
        const float inv = 1.f / es;
        asm volatile("s_waitcnt lgkmcnt(0)" ::: "memory");
        int oi[4]; float og[4];
#pragma unroll
        for (int kq = 0; kq < 4; ++kq) {
            const float fk = fq == 0 ? fin[kq] : fq == 1 ? fin[4 + kq] : fq == 2 ? fin[8 + kq] : fin[12 + kq];
            const float fe = fq == 0 ? ev[kq] : fq == 1 ? ev[4 + kq] : fq == 2 ? ev[8 + kq] : ev[12 + kq];
            const unsigned code = 255u - (__float_as_uint(fk) & 255u), a = code >> 4, bq = code & 15u;
            const unsigned i1 = 127u - (scr[a] & 127u), i2 = 127u - (scr[16 + bq] & 127u);
            oi[kq] = (int)(i1 * 128u + i2); og[kq] = fe * inv; }
        *(int4*)(IDX + (size_t)tok * 128 + 16 * h + 4 * fq) = make_int4(oi[0], oi[1], oi[2], oi[3]);
        *(f32x4*)(GATE + (size_t)tok * 128 + 16 * h + 4 * fq) = (f32x4){og[0], og[1], og[2], og[3]};
    }
}
struct PeerSched {
    int x0, rank, nloc, nblk, nown; unsigned orphan;
    __device__ __forceinline__ void init(const Args& A, int nrows, LAS unsigned char* smem) {
        unsigned* ctl = (unsigned*)(A.ws + WS_CTL);
        x0 = (int)(xb_xcc_id() & 7u); rank = __builtin_amdgcn_readfirstlane((int)((LAS unsigned*)smem)[8]); nblk = nrows / 64;
        unsigned cached = __builtin_amdgcn_readfirstlane(((LAS unsigned*)smem)[9]);
        if (cached == 0u) { unsigned orph = 0u, nl = 1u;
            for (int j = 0; j < 8; ++j) { unsigned c = xb_ld(&ctl[XB_XCNT(j)]) + xb_ld(&ctl[XB_XCNT(j + 8)]); c = __builtin_amdgcn_readfirstlane(c); if (c == 0u) orph |= 1u << j; if (j == x0) nl = c; }
            cached = (nl << 8) | orph; __syncthreads(); if (threadIdx.x == 0) ((LAS unsigned*)smem)[9] = cached; __syncthreads(); }
        nloc = (int)(cached >> 8); orphan = cached & 0xffu;
        const int tot = (NSL / 8) * nblk; nown = rank < tot ? (tot - rank + nloc - 1) / nloc : 0;
    }
    __device__ __forceinline__ bool item(int j, int& sl, int& blk) const {
        if (j < nown) { const int i = rank + j * nloc; sl = x0 + 8 * (i / nblk); blk = i % nblk; return true; }
        int jj = j - nown; const int tot = (NSL / 8) * nblk, per = ((int)gridDim.x > tot) ? 1 : 0; (void)per;
        for (int o = 0; o < 8; ++o) if ((orphan >> o) & 1u) { const int cnt = ((int)blockIdx.x < tot) ? (tot - (int)blockIdx.x + (int)gridDim.x - 1) / (int)gridDim.x : 0;
            if (jj < cnt) { const int i = (int)blockIdx.x + jj * (int)gridDim.x; sl = o + 8 * (i / nblk); blk = i % nblk; return true; } jj -= cnt; }
        return false;
    }
};
template <class LD, class PR>
__device__ __forceinline__ void peer_items(const PeerSched& S, LD ld, PR pr) {
    int sl, blk, sln, blkn, j = 0, buf = 0; bool have = S.item(0, sl, blk);
    __syncthreads();
    if (have) ld(sl, blk, 0);
    while (have) {
        const bool haven = S.item(j + 1, sln, blkn);
        asm volatile("s_waitcnt vmcnt(0)" ::: "memory");
        if (haven) ld(sln, blkn, buf ^ 1);
        pr(sl, blk, buf);
        sl = sln; blk = blkn; have = haven; buf ^= 1; ++j;
    }
    __syncthreads();
}
#ifndef MK_UVAR
#define MK_UVAR 0
#endif
__device__ __forceinline__ float dpp_sum8(float v) {
    v += __builtin_bit_cast(float, __builtin_amdgcn_mov_dpp(__builtin_bit_cast(int, v), 0xB1, 0xF, 0xF, true));
    v += __builtin_bit_cast(float, __builtin_amdgcn_mov_dpp(__builtin_bit_cast(int, v), 0x4E, 0xF, 0xF, true));
    v += __builtin_bit_cast(float, __builtin_amdgcn_mov_dpp(__builtin_bit_cast(int, v), 0x141, 0xF, 0xF, true));
    return v;
}
__device__ __forceinline__ void phase_peer_u(const Args& A, int layer, int nrows, LAS unsigned char* smem, int rep) {
    const int var = rep ? MK_UVAR : 0;
    const bf16_t* H = (const bf16_t*)(A.ws + WS_H); const int* IDX = (const int*)(A.ws + WS_R2); float* PART = var ? (float*)(A.ws + WS_R1) : (float*)(A.ws + WS_BIG + BIG_PART);
    const unsigned char* U = A.ws + tabset(layer);
    constexpr int PP = 1088, WB = 4 * PP + 2048;
    const int tid = otid(), wid = tid >> 6, lane = tid & 63, m = lane & 7, tk = lane >> 3;
    const int wu = __builtin_amdgcn_readfirstlane(wid);
    LAS unsigned char* lds = smem + LDS_BASE + wu * (2 * WB);
    PeerSched S; S.init(A, nrows, smem);
    peer_items(S,
        [&](int sl, int blk, int buf) {
#pragma unroll
            for (int i = 0; i < 4; ++i)
                __builtin_amdgcn_global_load_lds((const unsigned*)(IDX + ((size_t)blk * 64 + 8 * wu + 2 * i) * 128 + 4 * lane), (LAS unsigned*)(lds + buf * WB + PP * i), 16, 0, 0);
#pragma unroll
            for (int i = 0; i < 2; ++i)
                __builtin_amdgcn_global_load_lds((const unsigned*)(H + (size_t)(blk * 64 + 8 * wu + 4 * i + (lane >> 4)) * 1024 + SW * sl + 8 * (lane & 15)), (LAS unsigned*)(lds + buf * WB + 4 * PP + 1024 * i), 16, 0, 0); },
        [&](int sl, int blk, int buf) {
            const unsigned char* ub = U + (size_t)sl * NEXP * SW + 16 * m;
            const int tok = blk * 64 + wid * 8 + tk;
            const int sw = (tk & 1) * 4;
            const LAS int* ib = (const LAS int*)(lds + buf * WB + (tk >> 1) * PP + (tk & 1) * 512);
            float hf[16];
            { const u32x4 h0 = *(const LAS u32x4*)(lds + buf * WB + 4 * PP + tk * 256 + 32 * m), h1 = *(const LAS u32x4*)(lds + buf * WB + 4 * PP + tk * 256 + 32 * m + 16);
#pragma unroll
              for (int j = 0; j < 4; ++j) { hf[2 * j] = bflo(h0[j]); hf[2 * j + 1] = bfhi(h0[j]); hf[8 + 2 * j] = bflo(h1[j]); hf[8 + 2 * j + 1] = bfhi(h1[j]); } }
            const bool up4 = m >= 4, up2 = (m & 2) != 0, up1 = (m & 1) != 0;
            float* pp = PART + ((size_t)sl * NROW + tok) * 128 + (m ^ sw);
            u32x4 vv[2][8];
#define PU_ROWS(T, c) do { const i32x4 e0_ = *(const LAS i32x4*)(ib + 8 * (c) + sw), e1_ = *(const LAS i32x4*)(ib + 8 * (c) + (4 - sw)); \
                if (var == 4) { _Pragma("unroll") for (int k_ = 0; k_ < 8; ++k_) vv[T][k_] = (u32x4){(unsigned)e0_.x, (unsigned)e1_.y, 0u, 0u}; } else { \
                vv[T][0] = *(const u32x4*)(ub + (size_t)(var == 3 ? e0_.x & 63 : e0_.x) * SW); vv[T][1] = *(const u32x4*)(ub + (size_t)(var == 3 ? e0_.y & 63 : e0_.y) * SW); \
                vv[T][2] = *(const u32x4*)(ub + (size_t)(var == 3 ? e0_.z & 63 : e0_.z) * SW); vv[T][3] = *(const u32x4*)(ub + (size_t)(var == 3 ? e0_.w & 63 : e0_.w) * SW); \
                vv[T][4] = *(const u32x4*)(ub + (size_t)(var == 3 ? e1_.x & 63 : e1_.x) * SW); vv[T][5] = *(const u32x4*)(ub + (size_t)(var == 3 ? e1_.y & 63 : e1_.y) * SW); \
                vv[T][6] = *(const u32x4*)(ub + (size_t)(var == 3 ? e1_.z & 63 : e1_.z) * SW); vv[T][7] = *(const u32x4*)(ub + (size_t)(var == 3 ? e1_.w & 63 : e1_.w) * SW); } } while (0)
#define PU_DOT(T, c) do { float s_[8]; \
                _Pragma("unroll") for (int k = 0; k < 8; ++k) { f32x2 a2 = {0.f, 0.f}; \
                    _Pragma("unroll") for (int j = 0; j < 4; ++j) { const int w = (int)vv[T][k][j]; \
                        const f32x2 lo = __builtin_amdgcn_cvt_pk_f32_fp8(w, false), hi = __builtin_amdgcn_cvt_pk_f32_fp8(w, true); \
                        a2 = __builtin_elementwise_fma(lo, (f32x2){hf[4 * j], hf[4 * j + 1]}, a2); a2 = __builtin_elementwise_fma(hi, (f32x2){hf[4 * j + 2], hf[4 * j + 3]}, a2); } \
                    s_[k] = a2.x + a2.y; } \
                  \
                float t_[4], u_[2]; \
                _Pragma("unroll") for (int j = 0; j < 4; ++j) { const float give = up4 ? s_[j] : s_[4 + j], keep = up4 ? s_[4 + j] : s_[j]; \
                    t_[j] = keep + __builtin_bit_cast(float, __builtin_amdgcn_mov_dpp(__builtin_bit_cast(int, give), 0x141, 0xF, 0xF, true)); }        \
                _Pragma("unroll") for (int j = 0; j < 2; ++j) { const float give = up2 ? t_[j] : t_[2 + j], keep = up2 ? t_[2 + j] : t_[j]; \
                    u_[j] = keep + __builtin_bit_cast(float, __builtin_amdgcn_mov_dpp(__builtin_bit_cast(int, give), 0x4E, 0xF, 0xF, true)); }         \
                { const float give = up1 ? u_[0] : u_[1], keep = up1 ? u_[1] : u_[0]; \
                  const float tot_ = keep + __builtin_bit_cast(float, __builtin_amdgcn_mov_dpp(__builtin_bit_cast(int, give), 0xB1, 0xF, 0xF, true));           \
                  pp[8 * (c)] = tot_; } } while (0)
            PU_ROWS(0, 0);
#pragma unroll 1
            for (int c = 0; c < 16; c += 2) {
                PU_ROWS(1, c + 1);
                __builtin_amdgcn_sched_barrier(0);
                PU_DOT(0, c);
                __builtin_amdgcn_sched_barrier(0);
                if (c + 2 < 16) PU_ROWS(0, c + 2);
                __builtin_amdgcn_sched_barrier(0);
                PU_DOT(1, c + 1);
                __builtin_amdgcn_sched_barrier(0);
            }
#undef PU_ROWS
#undef PU_DOT
        });
}
__device__ __forceinline__ void phase_coef(const Args& A, int layer, int nrows) {
    const float* PART = (const float*)(A.ws + WS_BIG + BIG_PART); const float* GATE = (const float*)(A.ws + WS_R2 + R2_GATE); float* COEF = (float*)(A.ws + WS_R2 + R2_COEF);
    const int* IDX = (const int*)(A.ws + WS_R2); const float* SCL = (const float*)(A.ws + tabset(layer) + TAB_SCL);
    const int gthr = blockIdx.x * NTHR + otid(), nthr = gridDim.x * NTHR;
    for (int p = gthr; p < nrows * 32; p += nthr) {
        f32x4 s = {0.f, 0.f, 0.f, 0.f};
#pragma unroll
        for (int x = 0; x < NSL; ++x) s += *(const f32x4*)(PART + (size_t)x * NROW * 128 + 4 * p);
        const i32x4 e = *(const i32x4*)(IDX + 4 * p); const f32x4 gt = *(const f32x4*)(GATE + 4 * p);
        const f32x4 su = {SCL[e.x], SCL[e.y], SCL[e.z], SCL[e.w]}, sv = {SCL[NEXP + e.x], SCL[NEXP + e.y], SCL[NEXP + e.z], SCL[NEXP + e.w]};
        const f32x4 a = s * su; const f32x2 g0 = gelu_pk((f32x2){a[0], a[1]}), g1 = gelu_pk((f32x2){a[2], a[3]});
        *(f32x4*)(COEF + 4 * p) = gt * (f32x4){g0.x, g0.y, g1.x, g1.y} * sv; }

}
__device__ __forceinline__ void phase_peer_v(const Args& A, int layer, int nrows, LAS unsigned char* smem, int rep) {
    const int* IDX = (const int*)(A.ws + WS_R2); const float* COEF = (const float*)(A.ws + WS_R2 + R2_COEF);
    const unsigned char* V = A.ws + tabset(layer) + TAB8_HALF; const float* MODL = (const float*)(A.ws + WS_MOD) + (size_t)layer * 5 * 6144 + 5 * 1024;
    float* XC = (float*)(A.ws + WS_XC);
    constexpr int PP = 1088, WB = 8 * PP;
    const int tid = otid(), wid = tid >> 6, lane = tid & 63, m = lane & 7, tk = lane >> 3;
    const int wu = __builtin_amdgcn_readfirstlane(wid);
    LAS unsigned char* lds = smem + LDS_BASE + wu * (2 * WB);
    PeerSched S; S.init(A, nrows, smem);
    peer_items(S,
        [&](int sl, int blk, int buf) {
#pragma unroll
            for (int i = 0; i < 4; ++i) {
                __builtin_amdgcn_global_load_lds((const unsigned*)(IDX + ((size_t)blk * 64 + 8 * wu + 2 * i) * 128 + 4 * lane), (LAS unsigned*)(lds + buf * WB + PP * i), 16, 0, 0);
                __builtin_amdgcn_global_load_lds((const unsigned*)(COEF + ((size_t)blk * 64 + 8 * wu + 2 * i) * 128 + 4 * lane), (LAS unsigned*)(lds + buf * WB + 4 * PP + PP * i), 16, 0, 0); } },
        [&](int sl, int blk, int buf) {
            const unsigned char* vb = V + (size_t)sl * NEXP * SW + 16 * m;
            const int tok = blk * 64 + wid * 8 + tk; const bool lat = tok < NLAT;
            const int toff = (tk >> 1) * PP + (tk & 1) * 512, sw = (tk & 1) * 4;
            const LAS int* ib = (const LAS int*)(lds + buf * WB + toff); const LAS float* cb = (const LAS float*)(lds + buf * WB + 4 * PP + toff);
            float* xp = (lat ? A.out + (size_t)tok * D : XC + (size_t)(tok - NLAT) * D) + SW * sl + 16 * m;
            f32x4 xr[4];
#pragma unroll
            for (int j = 0; j < 4; ++j) xr[j] = *(f32x4*)(xp + 4 * j);
            f32x2 acc2[8];
#pragma unroll
            for (int j = 0; j < 8; ++j) acc2[j] = (f32x2){0.f, 0.f};
            u32x4 vv[2][8];
#define PV_ROWS(T, c) do { const i32x4 e0_ = *(const LAS i32x4*)(ib + 8 * (c) + sw), e1_ = *(const LAS i32x4*)(ib + 8 * (c) + (4 - sw)); \
                vv[T][0] = *(const u32x4*)(vb + (size_t)e0_.x * SW); vv[T][1] = *(const u32x4*)(vb + (size_t)e0_.y * SW); vv[T][2] = *(const u32x4*)(vb + (size_t)e0_.z * SW); vv[T][3] = *(const u32x4*)(vb + (size_t)e0_.w * SW); \
                vv[T][4] = *(const u32x4*)(vb + (size_t)e1_.x * SW); vv[T][5] = *(const u32x4*)(vb + (size_t)e1_.y * SW); vv[T][6] = *(const u32x4*)(vb + (size_t)e1_.z * SW); vv[T][7] = *(const u32x4*)(vb + (size_t)e1_.w * SW); } while (0)
#define PV_FMA(T, c) do { const f32x4 c0_ = *(const LAS f32x4*)(cb + 8 * (c) + sw), c1_ = *(const LAS f32x4*)(cb + 8 * (c) + (4 - sw)); \
                _Pragma("unroll") for (int k = 0; k < 8; ++k) { const float cf = k < 4 ? c0_[k & 3] : c1_[k & 3]; \
                    _Pragma("unroll") for (int j = 0; j < 4; ++j) { const int w = (int)vv[T][k][j]; \
                        const f32x2 lo = __builtin_amdgcn_cvt_pk_f32_fp8(w, false), hi = __builtin_amdgcn_cvt_pk_f32_fp8(w, true); const f32x2 c2 = {cf, cf}; \
                        acc2[2 * j] = __builtin_elementwise_fma(lo, c2, acc2[2 * j]); acc2[2 * j + 1] = __builtin_elementwise_fma(hi, c2, acc2[2 * j + 1]); } } } while (0)
            PV_ROWS(0, 0);
#pragma unroll 1
            for (int c = 0; c < 16; c += 2) {
                PV_ROWS(1, c + 1);
                __builtin_amdgcn_sched_barrier(0);
                PV_FMA(0, c);
                __builtin_amdgcn_sched_barrier(0);
                if (c + 2 < 16) PV_ROWS(0, c + 2);
                __builtin_amdgcn_sched_barrier(0);
                PV_FMA(1, c + 1);
                __builtin_amdgcn_sched_barrier(0);
            }
#undef PV_ROWS
#undef PV_FMA
            const float* gp = MODL + (size_t)(lat ? (tok >> 13) : 4) * 6144 + SW * sl + 16 * m;
#pragma unroll
            for (int j = 0; j < 4; ++j) { const f32x4 g = *(const f32x4*)(gp + 4 * j);
                *(f32x4*)(xp + 4 * j) = xr[j] + g * (f32x4){acc2[2 * j].x, acc2[2 * j].y, acc2[2 * j + 1].x, acc2[2 * j + 1].y}; }
        });
}

#ifdef MK_CHECK
constexpr int CW_CHK = 3840;
__device__ __forceinline__ float blk_sum(float v, LAS float* red) {
    const int t_ = otid(); v = wave_sum(v); __syncthreads(); if ((t_ & 63) == 0) red[t_ >> 6] = v; __syncthreads();
    float s = 0.f; for (int i = 0; i < 8; ++i) s += red[i]; __syncthreads(); return s;
}
__device__ __forceinline__ float fp8f(unsigned b) { const unsigned e = (b >> 3) & 15u, m = b & 7u; const float v = e ? ldexpf(1.f + (float)m * 0.125f, (int)e - 7) : ldexpf((float)m * 0.125f, -6); return (b & 0x80u) ? -v : v; }
__device__ __forceinline__ void check_attn(const Args& A, LAS unsigned char* lds, bool with_ctx) {
    const unsigned char* Q = A.ws + WS_R1 + R1_Q; const unsigned char* KN = A.ws + WS_R1 + R1_KN; const unsigned char* KR = A.ws + WS_BIG + BIG_KR; const unsigned char* V = A.ws + WS_R1 + R1_V;
    const bf16_t* CAT = (const bf16_t*)(A.ws + WS_R3 + R3_CAT); float* chk = (float*)(A.ws + WS_CTL) + CW_CHK;
    LAS float* p = (LAS float*)lds; LAS float* qv = p + NKEY; LAS float* red = qv + 192;
    const int tid = otid();
    for (int au = blockIdx.x; au < (with_ctx ? 1056 : 1024); au += gridDim.x) {
        int b, h, qrow, orow, nkey;
        if (au < 1024) { b = au >> 8; h = au & 7; const int qb = (au >> 3) & 31, l = 256 * qb + (int)((((unsigned)au * 2654435761u) >> 20) & 255u); qrow = 256 + l; orow = b * 8192 + l; nkey = NKEY; }
        else { const int cu = au - 1024; b = cu >> 3; h = cu & 7; const int lc = (int)((((unsigned)au * 2654435761u) >> 20) & 255u); qrow = lc; orow = NLAT + 256 * b + lc; nkey = 256; }
        const size_t bh = (size_t)(b * 8 + h);
        __syncthreads();
        if (tid < 192) qv[tid] = fp8f(Q[(bh * NKEY + qrow) * 192 + tid]) * (1.f / att8::QUP);
        __syncthreads();
        float mx = -1e30f;
        for (int key = tid; key < nkey; key += 512) { const int t = key >> 6, k = key & 63; float sacc = 0.f;
            for (int d = 0; d < 128; ++d) sacc += qv[d] * fp8f(KN[(bh * NKT + t) * 8192 + att8::kn8(k, d)]);
            for (int d = 0; d < 64; ++d) sacc += qv[128 + d] * fp8f(KR[((size_t)b * NKT + t) * 4096 + att8::kr8(k, d)]);
            p[key] = sacc; mx = fmaxf(mx, sacc); }
        for (int o = 32; o >= 1; o >>= 1) mx = fmaxf(mx, __shfl_xor(mx, o));
        __syncthreads(); if ((tid & 63) == 0) red[tid >> 6] = mx; __syncthreads(); mx = red[0]; for (int i = 1; i < 8; ++i) mx = fmaxf(mx, red[i]); __syncthreads();
        float ls = 0.f; for (int key = tid; key < nkey; key += 512) { const float e = exp2f(p[key] - mx); p[key] = e; ls += e; }
        ls = blk_sum(ls, red);
        float num = 0.f, den = 0.f;
        if (tid < 128) { float o = 0.f; for (int key = 0; key < nkey; ++key) o += p[key] * fp8f(V[(bh * NKT + (key >> 6)) * 8192 + att8::v8(tid, key & 63)]);
            o /= ls; const float got = bf2f(CAT[(size_t)orow * 2048 + 1024 + 128 * h + tid]); num = (got - o) * (got - o); den = o * o; }
        num = blk_sum(num, red); den = blk_sum(den, red);
        if (tid == 0) { atomicAdd(chk, num); atomicAdd(chk + 1, den); }
    }
}
__device__ __forceinline__ void check_qkv(const Args& A, int li, LAS unsigned char* lds) {
    float* chk = (float*)(A.ws + WS_CTL) + CW_CHK;
    const unsigned char* Q = A.ws + WS_R1 + R1_Q; const unsigned char* KN = A.ws + WS_R1 + R1_KN; const unsigned char* KR = A.ws + WS_BIG + BIG_KR; const unsigned char* V = A.ws + WS_R1 + R1_V;
    LAS float* hv = (LAS float*)lds; LAS float* cq = hv + 1024; LAS float* ckv = cq + 384; LAS float* kr = ckv + 256; LAS float* red = kr + 64; LAS float* ov = red + 16;
    const int tid = otid(), sidx = blockIdx.x;
    const int hd = sidx & 7; const int r = (sidx & 8) ? NLAT + (int)(((unsigned)sidx * 2654435761u) >> 22) : (int)(((unsigned)sidx * 2654435761u) >> 17);
    const float* win = A.in[I_HWIN] + (size_t)li * 1024 * HYB_IN;
    {
        const float* xp = r < NLAT ? A.out + (size_t)r * D : (const float*)(A.ws + WS_XC) + (size_t)(r - NLAT) * D; const float* MODL = (const float*)(A.ws + WS_MOD) + (size_t)(2 * li) * 5 * 6144 + (size_t)row_mb(r) * 6144;
        float ss = 0.f; for (int i = tid; i < 1024; i += 512) ss += xp[i] * xp[i];
        ss = blk_sum(ss, red); const float rstd = rsqrtf(ss / 1024.f + EPS);
        for (int i = tid; i < 1024; i += 512) hv[i] = bf2f(f2bf(xp[i] * rstd * A.in[I_N1G][(2 * li) * 1024 + i] * (1.f + MODL[1024 + i]) + MODL[i])); }
    __syncthreads();
    for (int j = tid; j < 704; j += 512) { float s = 0.f; for (int k = 0; k < 1024; ++k) s += hv[k] * win[(size_t)k * HYB_IN + C_CQ + j];
        s = bf2f(f2bf(s)); if (j < 384) cq[j] = s; else if (j < 640) ckv[j - 384] = s; else kr[j - 640] = s; }
    __syncthreads();
    float sq = 0.f, sk = 0.f; for (int j = tid; j < 384; j += 512) sq += cq[j] * cq[j]; for (int j = tid; j < 256; j += 512) sk += ckv[j] * ckv[j];
    sq = blk_sum(sq, red); sk = blk_sum(sk, red);
    const float rq = rsqrtf(sq / 384.f + EPS), rk = rsqrtf(sk / 256.f + EPS);
    const float* wqb = A.in[I_WQB] + (size_t)li * 384 * 1536; const float* wkvb = A.in[I_WKVB] + (size_t)li * 256 * 2048; const float* qg = A.in[I_QNG] + li * 384; const float* kg = A.in[I_KVNG] + li * 256;
    if (tid < 192) { float s = 0.f; for (int k = 0; k < 384; ++k) s += cq[k] * rq * qg[k] * wqb[(size_t)k * 1536 + hd * 192 + tid]; ov[tid] = s; }
    else if (tid < 448) { const int c = tid - 192; float s = 0.f; for (int k = 0; k < 256; ++k) s += ckv[k] * rk * kg[k] * wkvb[(size_t)k * 2048 + hd * 256 + c]; ov[tid] = s; }
    __syncthreads();
    const bool lat = r < NLAT; const int b = lat ? (r >> 13) : ((r - NLAT) >> 8), l = lat ? (r & 8191) : 0, key = lat ? 256 + l : ((r - NLAT) & 255), qrow = key;
    const size_t bh = (size_t)(b * 8 + hd); const float qs = QSCALE * att8::QUP;
    float num = 0.f, den = 0.f;
    if (tid < 128) {
        const float q = ov[tid] * qs, gq = fp8f(Q[(bh * NKEY + qrow) * 192 + tid]);
        const float kk = ov[192 + tid], gk = fp8f(KN[(bh * NKT + (key >> 6)) * 8192 + att8::kn8(key & 63, tid)]);
        const float vv = ov[320 + tid], gv = fp8f(V[(bh * NKT + (key >> 6)) * 8192 + att8::v8(tid, key & 63)]);
        num = (gq - q) * (gq - q) + (gk - kk) * (gk - kk) + (gv - vv) * (gv - vv); den = q * q + kk * kk + vv * vv;
    } else if (tid < 160) {
        const int i = tid - 128; float c = 1.f, sn = 0.f;
        if (lat) { const float pos = (float)(i < 16 ? (l >> 6) : (l & 63)); const float ang = pos * powf(10000.f, -(float)(i & 15) / 16.f); c = cosf(ang); sn = sinf(ang); }
        const float q1 = ov[128 + i] * qs, q2 = ov[160 + i] * qs, k1 = kr[i], k2 = kr[32 + i];
        const float rq1 = q1 * c - q2 * sn, rq2 = q1 * sn + q2 * c, rk1 = k1 * c - k2 * sn, rk2 = k1 * sn + k2 * c;
        const float gq1 = fp8f(Q[(bh * NKEY + qrow) * 192 + 128 + 2 * i]), gq2 = fp8f(Q[(bh * NKEY + qrow) * 192 + 128 + 2 * i + 1]);
        const float gk1 = fp8f(KR[((size_t)b * NKT + (key >> 6)) * 4096 + att8::kr8(key & 63, 2 * i)]), gk2 = fp8f(KR[((size_t)b * NKT + (key >> 6)) * 4096 + att8::kr8(key & 63, 2 * i + 1)]);
        num = (gq1 - rq1) * (gq1 - rq1) + (gq2 - rq2) * (gq2 - rq2) + (gk1 - rk1) * (gk1 - rk1) + (gk2 - rk2) * (gk2 - rk2); den = rq1 * rq1 + rq2 * rq2 + rk1 * rk1 + rk2 * rk2;
    }
    num = blk_sum(num, red); den = blk_sum(den, red);
    if (tid == 0) { atomicAdd(chk, num); atomicAdd(chk + 1, den); }
}
__device__ __forceinline__ void check_topk(const Args& A, int layer, LAS unsigned char* lds) {
    const bf16_t* QP = (const bf16_t*)(A.ws + WS_BIG); const int* IDX = (const int*)(A.ws + WS_R2); const float* GATE = (const float*)(A.ws + WS_R2 + R2_GATE); float* chk = (float*)(A.ws + WS_CTL) + CW_CHK;
    const bf16_t* K1 = (const bf16_t*)(A.ws + WS_W + W_PEER + (size_t)layer * WP_SZ + WP_K1);
    LAS float* sc = (LAS float*)lds; LAS float* v12 = sc + 256; LAS int* i12 = (LAS int*)(v12 + 32); LAS float* cs = (LAS float*)(i12 + 32); LAS float* ts = cs + 256; LAS int* ti = (LAS int*)(ts + 16); LAS float* red = (LAS float*)(ti + 16);
    const int tid = otid();
    for (int smp = blockIdx.x; smp < 1024; smp += gridDim.x) {
        const int h = smp & 7, tok = (int)((((unsigned)smp * 2654435761u) >> 12) % (unsigned)NROW);
        __syncthreads();
        if (tid < 256) { const int half = tid >> 7, key = tid & 127; float a = 0.f;
            for (int d = 0; d < 128; ++d) a += bf2f(QP[(size_t)tok * 2048 + 256 * h + 128 * half + d]) * bf2f(K1[((size_t)half * 8 + h) * 16384 + key * 128 + d]);
            sc[tid] = a; }
        __syncthreads();
        if (tid < 256) { const int half = tid >> 7, key = tid & 127; const float v = sc[tid]; int rank = 0;
            for (int j = 0; j < 128; ++j) { const float o = sc[half * 128 + j]; rank += (o > v || (o == v && j < key)) ? 1 : 0; }
            if (rank < 16) { v12[half * 16 + rank] = v; i12[half * 16 + rank] = key; } }
        __syncthreads();
        if (tid < 256) cs[tid] = v12[tid >> 4] + v12[16 + (tid & 15)];
        __syncthreads();
        if (tid < 256) { const float v = cs[tid]; int rank = 0;
            for (int j = 0; j < 256; ++j) { const float o = cs[j]; rank += (o > v || (o == v && j < tid)) ? 1 : 0; }
            if (rank < 16) { ts[rank] = v; ti[rank] = i12[tid >> 4] * 128 + i12[16 + (tid & 15)]; } }
        __syncthreads();
        float num = 0.f, den = 0.f;
        if (tid < 16) { float es = 0.f; for (int j = 0; j < 16; ++j) es += __expf(ts[j] - ts[0]); const float gn = __expf(ts[tid] - ts[0]) / es; float gk = 0.f;
            for (int j = 0; j < 16; ++j) if (IDX[(size_t)tok * 128 + 16 * h + j] == ti[tid]) gk = GATE[(size_t)tok * 128 + 16 * h + j];
            num = (gk - gn) * (gk - gn); den = gn * gn; }
        num = blk_sum(num, red); den = blk_sum(den, red);
        if (tid == 0) { atomicAdd(chk, num); atomicAdd(chk + 1, den); }
    }
}
__device__ __forceinline__ void check_ssd(const Args& A, int li, LAS unsigned char* lds) {
    const bf16_t* XS = (const bf16_t*)(A.ws + WS_R2); const bf16_t* BC = (const bf16_t*)(A.ws + WS_R2 + R2_BC); const float* DT = (const float*)(A.ws + WS_BIG + BIG_DT);
    const bf16_t* Y0 = (const bf16_t*)(A.ws + WS_H); const bf16_t* Y1 = (const bf16_t*)(A.ws + WS_R3); float* chk = (float*)(A.ws + WS_CTL) + CW_CHK;
    LAS float* red = (LAS float*)lds;
    const int tid = otid(), sidx = blockIdx.x;
    const int b = sidx & 3, d = (sidx >> 2) & 1, h = (sidx >> 3) & 15, p = (int)((((unsigned)sidx * 2654435761u) >> 20) & 63u), g = h >> 3;
    const float a = -__expf(A.in[I_ALOG][li * 32 + d * 16 + h]);
    const bf16_t* Y = d ? Y1 : Y0;
    float hst = 0.f, num = 0.f, den = 0.f;
    for (int step = 0; step < 8448; ++step) {
        int r;
        if (step < 256) r = NLAT + b * 256 + (d ? 255 - step : step); else { const int q = step - 256; r = b * 8192 + (d ? 8191 - q : q); }
        const float dt = DT[(size_t)(d * 16 + h) * NROW + r], x = bf2f(XS[(size_t)r * 1024 + 64 * h + p]);
        float contrib = 0.f;
        if (tid < 128) { hst = __expf(dt * a) * hst + dt * x * bf2f(BC[(size_t)r * 512 + 128 * g + tid]); contrib = hst * bf2f(BC[(size_t)r * 512 + 256 + 128 * g + tid]); }
        if (step % 61 == 0) { const float y = blk_sum(contrib, red); const float got = bf2f(Y[(size_t)r * 1024 + 64 * h + p]); if (tid == 0) { num += (got - y) * (got - y); den += y * y; } }
    }
    if (tid == 0) { atomicAdd(chk, num); atomicAdd(chk + 1, den); }
}
#endif
#ifndef MK_PER_PHASE
#define MK_PER_PHASE 0
#endif
__device__ __forceinline__ int nr_in(int L) { return L <= 2 ? NROW : NLAT; }
__device__ __forceinline__ int nr_out(int L) { return L <= 1 ? NROW : NLAT; }

__global__ void __launch_bounds__(NTHR, 2) fwd(Args A) {
    extern __shared__ __attribute__((aligned(256))) unsigned char smem_raw[];
    LAS unsigned char* smem = (LAS unsigned char*)smem_raw;
    LAS unsigned char* lds = smem + LDS_BASE;
    const int tid = otid();
    if (tid < 64) ((LAS unsigned*)smem)[tid] = 0u;
    __syncthreads();
    XcdBarrier bar = xcd_barrier_post((unsigned*)(A.ws + WS_CTL), (volatile LAS unsigned*)smem);
    if (tid == 0) ((LAS unsigned*)smem)[8] = atomicAdd((unsigned*)(A.ws + WS_CTL) + CW_RANK + 32 * (xb_xcc_id() & 7u), 1u);
    __syncthreads();
    bool need_bar = false;
    const int lo = A.ph_lo, hi = A.ph_hi;
#ifndef PHMASK
#define PHMASK 0xffffffffu
#endif
#define SITE(k) if constexpr (((PHMASK) >> (k)) & 1u)
#ifndef MK_SVAR
#define MK_SVAR 1
#endif
#ifndef MK_REPEAT_SITE
#define MK_REPEAT_SITE -1
#endif
#define REP(k) for (int rep = 0; rep < ((k) == (MK_REPEAT_SITE) ? 2 : 1); ++rep)
#define PH(id) if ([&]() -> bool { if ((id) < lo || (id) >= hi) return false; if (need_bar) xcd_barrier(bar); need_bar = true; return true; }())
    unsigned char* ws = A.ws;
#define TAIL_TAB(units, layer, rlo, rhi) do { const int nx_ = (units) % 256; if (gridDim.x == 256 && (int)blockIdx.x >= nx_) phase_tabcvt(A, layer, (int)blockIdx.x - nx_, 256 - nx_, rlo, rhi); } while (0)
    float* XL = A.out; float* XC = (float*)(ws + WS_XC);
    bf16_t* H = (bf16_t*)(ws + WS_H);
    const float* MOD = (const float*)(ws + WS_MOD);

    SITE(0) PH(0) { phase_prologue(A, lds); }
    SITE(1) PH(1) { phase_norm_mod(A.in[I_X], A.in[I_CTX], XL, XC, A.in[I_N1G], MOD, 0, H, NROW); }
    for (int L = 0; L < DEPTH; ++L) {
        const int base = 2 + 16 * L, li = L >> 1; const bool hyb = (L & 1) == 0;
        const float* MODL = MOD + (size_t)L * 5 * 6144;
        unsigned char* WH = ws + WS_W + W_HYB + (size_t)li * WH_SZ; unsigned char* WG = ws + WS_W + W_GM + (size_t)li * WG_SZ; unsigned char* WP = ws + WS_W + W_PEER + (size_t)L * WP_SZ;
        if (hyb) {
            SITE(2) PH(base + 0) REP(2) { pg8::Gemm g{H, (const bf16_t*)(WH + WH_IN), nr_in(L), HYB_INP, 1024, 1024, 1024};
                pg8::EpiBf16<0> e{(bf16_t*)(ws + WS_BIG), HYB_INP}; pg8::gemm_phase(lds, g, e); }
            SITE(3) PH(base + 1) REP(3) { phase_conv(A, li); }
            SITE(4) PH(base + 2) {
                SITE(18) REP(18) { pg8::Gemm g{(const bf16_t*)(ws + WS_BIG) + C_CQ, (const bf16_t*)(WH + WH_QB), L == 0 ? NROW : NLAT, 1536, 384, HYB_INP, 384};
                  EpiQ e{ws + WS_R1 + R1_Q, (const float*)(ws + WS_RSTD), (const float*)(ws + WS_ROPE)}; pg8::gemm_phase(lds, g, e); }
                SITE(19) REP(19) { pg8::Gemm g{(const bf16_t*)(ws + WS_BIG) + C_CKV, (const bf16_t*)(WH + WH_KVB), NROW, 2048, 256, HYB_INP, 256};
                  EpiKV e{ws + WS_R1 + R1_KN, ws + WS_R1 + R1_V, (const float*)(ws + WS_RSTD) + NROW}; pg8::gemm_phase(lds, g, e); }
                SITE(20) REP(20) for (int u = blockIdx.x; u < 528; u += gridDim.x) ssd::g_unit((const bf16_t*)(ws + WS_R2 + R2_BC), (bf16_t*)(ws + WS_BIG + BIG_G), u);
            }
            SITE(5) PH(base + 3) {
                const int xq = (int)blockIdx.x & 7, jq = (int)blockIdx.x >> 3; const bool ssd_wg = (jq & 1) == 0 && gridDim.x == 256;
                if (gridDim.x == 256) {
                    if (ssd_wg) { const int r = jq >> 1, gi = xq + 8 * (r >> 3), hh = r & 7, sb = gi >> 2, sgp = (gi >> 1) & 1, sd = gi & 1;
                        SITE(21) ssd::ssd_unit(sb, 8 * sgp + hh, sd, (const bf16_t*)(ws + WS_R2), (const bf16_t*)(ws + WS_R2 + R2_BC), (const float*)(ws + WS_BIG + BIG_DT), (const bf16_t*)(ws + WS_BIG + BIG_G),
                                               A.in[I_ALOG] + li * 32, sd ? (bf16_t*)(ws + WS_R3) : (bf16_t*)(ws + WS_H), lds); }
                } else {
                    SITE(21) for (int u = blockIdx.x; u < 128; u += gridDim.x) ssd::ssd_unit(u >> 5, (u >> 1) & 15, u & 1, (const bf16_t*)(ws + WS_R2), (const bf16_t*)(ws + WS_R2 + R2_BC), (const float*)(ws + WS_BIG + BIG_DT),
                                               (const bf16_t*)(ws + WS_BIG + BIG_G), A.in[I_ALOG] + li * 32, (u & 1) ? (bf16_t*)(ws + WS_R3) : (bf16_t*)(ws + WS_H), lds);
                }
                const int nmine = gridDim.x == 256 ? (ssd_wg ? 3 : 5) + (L == 0 && !ssd_wg && jq < 8 ? 1 : 0) : 0;
                SITE(22) REP(22) for (int it = 0; gridDim.x == 256 ? it < nmine : (int)blockIdx.x + it * (int)gridDim.x < (L == 0 ? 1056 : 1024); ++it) {
                    int b, h, qrow0, orow0, nt;
                    if (gridDim.x == 256) {
                        const int base_it = ssd_wg ? 3 : 5;
                        if (it < base_it) { const int v = ssd_wg ? 3 * (jq >> 1) + it : 48 + 5 * (jq >> 1) + it; b = v >> 5; h = xq; const int qb = v & 31; qrow0 = 256 + 256 * qb; orow0 = b * 8192 + 256 * qb; nt = NKT; }
                        else { b = jq >> 1; h = xq; qrow0 = 0; orow0 = NLAT + 256 * b; nt = 4; }
                    } else { const int au = (int)blockIdx.x + it * (int)gridDim.x;
                        if (au < 1024) { b = au >> 8; h = au & 7; const int qb = (au >> 3) & 31; qrow0 = 256 + 256 * qb; orow0 = b * 8192 + 256 * qb; nt = NKT; }
                        else { const int cu = au - 1024; b = cu >> 3; h = cu & 7; qrow0 = 0; orow0 = NLAT + 256 * b; nt = 4; } }
                    const size_t bh = (size_t)(b * 8 + h);
                    att8::attn_unit(ws + WS_R1 + R1_Q + (bh * NKEY + qrow0) * 192, ws + WS_R1 + R1_KN + bh * NKT * 8192, ws + WS_BIG + BIG_KR + (size_t)b * NKT * 4096,
                                    ws + WS_R1 + R1_V + bh * NKT * 8192, (bf16_t*)(ws + WS_R3 + R3_CAT) + (size_t)orow0 * 2048 + 1024 + 128 * h, nt, lds);
                }
                if (gridDim.x == 256 && !ssd_wg && L == 2) SITE(11) phase_tabcvt(A, 3, xq + 8 * (jq >> 1), 128, 0, NEXP);
            }
            SITE(6) PH(base + 4) REP(6) { phase_ssd_out(A, li, nr_out(L));
#if defined(MK_CHECK) && MK_CHECK == 1
                if (L == 0) check_attn(A, lds, true);
#elif defined(MK_CHECK) && MK_CHECK == 2
                if (L == 0) check_qkv(A, li, lds);
#elif defined(MK_CHECK) && MK_CHECK == 3
                if (L == 2) check_attn(A, lds, false);
#elif defined(MK_CHECK) && MK_CHECK == 5
                if (L == 0) check_ssd(A, li, lds);
#elif defined(MK_CHECK) && MK_CHECK == 6
                if (L == 2) check_ssd(A, li, lds);
#endif
            }
        } else {
            SITE(7) PH(base + 0) REP(7) { pg8::Gemm g{H, (const bf16_t*)(WG + WG_IN), nr_out(L), 4096, 1024, 1024, 1024};
                pg8::EpiBf16<1> e{(bf16_t*)(ws + WS_BIG), 4096}; pg8::gemm_phase(lds, g, e);
                if (rep == 0 && L == 1) TAIL_TAB((nr_out(L) / 256) * 16, 1, NEXP, 2 * NEXP); }
            SITE(8) PH(base + 1) REP(8) { phase_ln_stats(A, nr_out(L)); }
            SITE(9) PH(base + 2) REP(9) { phase_spatial(A, li, nr_out(L), lds); }
        }
        SITE(10) PH(base + 5) { pg8::Gemm g{hyb ? (const bf16_t*)(ws + WS_R3 + R3_CAT) : (const bf16_t*)(ws + WS_R1), hyb ? (const bf16_t*)(WH + WH_OUT) : (const bf16_t*)(WG + WG_OUT), nr_out(L), 1024, 2048, 2048, 2048};
            pg8::EpiResid e{XL, XC, MODL + 2 * 1024}; pg8::gemm_phase(lds, g, e);
            if (L == 0) TAIL_TAB((nr_out(L) / 256) * 4, 0, 0, 2 * NEXP); else if (L == 1) TAIL_TAB((nr_out(L) / 256) * 4, 2, 0, 2 * NEXP); }
        SITE(11) PH(base + 6) REP(11) { phase_norm_mod(XL, XC, nullptr, nullptr, A.in[I_N2G] + L * 1024, MODL, 3, H, nr_out(L));
            if (gridDim.x != 256) phase_tabcvt(A, L, (int)blockIdx.x, (int)gridDim.x);
            else if (L == 3) phase_tabcvt(A, 3, (int)blockIdx.x, 256, NEXP, 2 * NEXP); }
        SITE(12) PH(base + 7) REP(12) { pg8::Gemm g{H, (const bf16_t*)(WP + WP_Q), nr_out(L), 2048, 1024, 1024, 1024};
            pg8::EpiBf16<0> e{(bf16_t*)(ws + WS_BIG), 2048}; pg8::gemm_phase(lds, g, e);
            if (rep == 0 && L == 0) TAIL_TAB((nr_out(L) / 256) * 8, 1, 0, NEXP); }
        SITE(13) PH(base + 8) REP(13) { phase_topk(A, L, nr_out(L), lds); }
        SITE(14) PH(base + 9) REP(14) { phase_peer_u(A, L, nr_out(L), smem, rep); }
        SITE(15) PH(base + 10) REP(15) { phase_coef(A, L, nr_out(L));
#if defined(MK_CHECK) && MK_CHECK == 4
            if (L == 1) check_topk(A, L, lds);
#endif
        }
        SITE(16) PH(base + 11) { phase_peer_v(A, L, nr_out(L), smem, 0); }
        SITE(17) PH(base + 12) { if (L < DEPTH - 1) phase_norm_mod(XL, XC, nullptr, nullptr, A.in[I_N1G] + (L + 1) * 1024, MOD + (size_t)(L + 1) * 5 * 6144, 0, H, nr_in(L + 1));
                        else {
#ifdef MK_CHECK
                            const float* chk = (const float*)(ws + WS_CTL) + CW_CHK; const float err = sqrtf(chk[0] / fmaxf(chk[1], 1e-30f));
                            phase_final_norm(XL, A.in[I_FNG], 1.f + 10.f * err);
#else
                            phase_final_norm(XL, A.in[I_FNG], 1.f);
#endif
                        } }
    }
#undef PH
}

#ifdef MK_TAP
__global__ void tap_kernel(const unsigned short* buf, size_t pitch, size_t col0, size_t ncols, size_t nrows, float* out) {
    const size_t n = ncols * nrows;
    for (size_t i = (size_t)blockIdx.x * blockDim.x + threadIdx.x; i < (size_t)NLAT * D; i += (size_t)gridDim.x * blockDim.x) {
        float s = 0.f; for (size_t j = i; j < n; j += (size_t)NLAT * D) s += (float)buf[(j / ncols) * pitch + col0 + (j % ncols)]; out[i] = s; }
}
#endif
extern "C" void kernel_launch(void* const* d_in, const int* in_sizes, int n_in, void* d_out, int out_size, void* d_ws, size_t ws_size, hipStream_t stream) {
    static int grid = 0;
    if (grid == 0) {
        if (n_in != N_IN || out_size != NLAT * D || ws_size < WS_END) { fprintf(stderr, "kernel_launch: unexpected shapes (n_in %d out %d ws %zu, need %zu)\n", n_in, out_size, ws_size, (size_t)WS_END); grid = -1; return; }
        int dev = 0, cus = 0, per_cu = 0;
        if (hipGetDevice(&dev) != hipSuccess || hipDeviceGetAttribute(&cus, hipDeviceAttributeMultiprocessorCount, dev) != hipSuccess) { grid = -1; return; }
        if (hipFuncSetAttribute((const void*)fwd, hipFuncAttributeMaxDynamicSharedMemorySize, LDS_BYTES) != hipSuccess) { fprintf(stderr, "kernel_launch: hipFuncSetAttribute failed\n"); grid = -1; return; }
        if (hipOccupancyMaxActiveBlocksPerMultiprocessor(&per_cu, (const void*)fwd, NTHR, LDS_BYTES) != hipSuccess || per_cu < 1) { fprintf(stderr, "kernel_launch: occupancy query says %d\n", per_cu); }
        (void)hipGetLastError();
        grid = cus;
    }
    if (grid < 0) return;
    (void)hipMemsetAsync((char*)d_ws + WS_CTL, 0, CTL_BYTES, stream);
    Args a{};
    for (int i = 0; i < N_IN; ++i) a.in[i] = (const float*)d_in[i];
    a.out = (float*)d_out; a.ws = (unsigned char*)d_ws;
#if MK_PER_PHASE
    for (int id = 0; id < 2 + 16 * DEPTH; ++id) {
        if (id >= 2) { const int L = (id - 2) / 16, s = (id - 2) % 16; if (s > 12) continue; if ((L & 1) && (s == 3 || s == 4)) continue; }
#ifdef MK_CUT
#ifdef MK_TAP
        if (id >= MK_CUT) continue;
#else
        if (id >= MK_CUT && id != 2 + 16 * (DEPTH - 1) + 12) continue;
#endif
#endif
        a.ph_lo = id; a.ph_hi = id + 1;
        hipLaunchKernelGGL(fwd, dim3(grid), dim3(NTHR), LDS_BYTES, stream, a);
    }
#ifdef MK_TAP
    { const size_t tp[5] = {MK_TAP}; hipLaunchKernelGGL(tap_kernel, dim3(2048), dim3(256), 0, stream, (const unsigned short*)((const char*)d_ws + tp[0]), tp[1], tp[2], tp[3], tp[4], (float*)d_out); }
#endif
#else
    a.ph_lo = 0; a.ph_hi = 2 + 16 * DEPTH;
    hipLaunchKernelGGL(fwd, dim3(grid), dim3(NTHR), LDS_BYTES, stream, a);
#endif
    const hipError_t le = hipPeekAtLastError();
    if (le != hipSuccess) fprintf(stderr, "kernel_launch: launch failed: %s\n", hipGetErrorName(le));
}
```

```cpp
#include <hip/hip_runtime.h>
#include <cstdio>
#include <cstdint>

#define LAS __attribute__((address_space(3)))
typedef unsigned short bf16_t;
typedef short bf16x8 __attribute__((ext_vector_type(8)));
typedef short s16x4 __attribute__((ext_vector_type(4)));
typedef float f32x2 __attribute__((ext_vector_type(2)));
typedef float f32x4 __attribute__((ext_vector_type(4)));
typedef float f32x16 __attribute__((ext_vector_type(16)));
typedef unsigned u32x2 __attribute__((ext_vector_type(2)));
typedef unsigned u32x4 __attribute__((ext_vector_type(4)));
typedef int i32x4 __attribute__((ext_vector_type(4)));
typedef int i32x8 __attribute__((ext_vector_type(8)));

constexpr int D = 1024, NB = 4, SEQ = 8192, DEPTH = 4, CTXL = 256;
constexpr int NLAT = NB * SEQ, NCTX = NB * CTXL, NROW = NLAT + NCTX;
constexpr int HYB_IN = 3280, HYB_INP = 3328;
constexpr int C_Z = 0, C_XBC = 1024, C_DT = 2560, C_CQ = 2576, C_CKV = 2960, C_KR = 3216;
constexpr int NKEY = SEQ + CTXL, NKT = NKEY / 64;
constexpr float EPS = 1e-6f;
constexpr float QSCALE = 0.07216878364870322f * 1.4426950408889634f;
constexpr int NEXP = 16384;

enum { I_X = 0, I_C, I_CTX, I_CCTX, I_ADAW, I_ADAB, I_N1G, I_N2G, I_HWIN, I_CONVW, I_CONVB, I_ALOG, I_DTB, I_SSDD, I_SSDNG, I_QNG, I_WQB, I_KVNG, I_WKVB,
       I_HWOUT, I_GWIN, I_GLNG, I_GLNB, I_GWS, I_GBS, I_GWOUT, I_PWQ, I_PK1, I_PK2, I_PU, I_PV, I_FNG, N_IN };

constexpr size_t al256(size_t x) { return (x + 255) & ~(size_t)255; }
constexpr size_t WS_CTL = 0, CTL_BYTES = 65536;
constexpr size_t WS_MOD = WS_CTL + CTL_BYTES;
constexpr size_t WS_ROPE = WS_MOD + al256((size_t)DEPTH * 5 * 6144 * 4);
constexpr size_t WS_RSTD = WS_ROPE + (size_t)2 * SEQ * 32 * 4;
constexpr size_t WS_W = WS_RSTD + al256((size_t)2 * NROW * 4);
constexpr size_t W_HYB = 0;
constexpr size_t WH_IN = 0, WH_QB = WH_IN + (size_t)HYB_INP * 1024 * 2, WH_KVB = WH_QB + (size_t)1536 * 384 * 2, WH_OUT = WH_KVB + (size_t)2048 * 256 * 2,
                 WH_SZ = WH_OUT + (size_t)1024 * 2048 * 2;
constexpr size_t W_GM = W_HYB + 2 * WH_SZ;
constexpr size_t WG_IN = 0, WG_OUT = WG_IN + (size_t)4096 * 1024 * 2, WG_WS = WG_OUT + (size_t)1024 * 2048 * 2, WG_SZ = WG_WS + (size_t)8 * 128 * 128 * 2;
constexpr size_t W_PEER = W_GM + 2 * WG_SZ;
constexpr size_t WP_Q = 0, WP_K1 = WP_Q + (size_t)2048 * 1024 * 2, WP_K2 = WP_K1 + (size_t)8 * 128 * 128 * 2, WP_SZ = WP_K2 + (size_t)8 * 128 * 128 * 2;
constexpr size_t W_TOTAL = W_PEER + 4 * WP_SZ;
constexpr size_t WS_TAB = WS_W + al256(W_TOTAL);
constexpr size_t TAB_HALF = (size_t)NEXP * 1024 * 2;
constexpr size_t TAB_REGION = 2 * TAB_HALF + 524288;
constexpr size_t WS_XC = WS_TAB + TAB_REGION;
constexpr size_t WS_H = WS_XC + (size_t)NCTX * D * 4;
constexpr size_t WS_BIG = WS_H + (size_t)NROW * D * 2;
constexpr size_t BIG_BYTES = (size_t)NROW * 4096 * 2;
constexpr size_t BIG_DT = (size_t)NROW * HYB_INP * 2;
constexpr size_t BIG_G = BIG_DT + (size_t)NROW * 32 * 4;
constexpr size_t BIG_KR = BIG_G + (size_t)528 * 128 * 128 * 2;
constexpr size_t BIG_PART = (size_t)NROW * 2048 * 2;
static_assert(BIG_KR + (size_t)NB * NKT * 8192 <= BIG_BYTES, "BIG tail");
constexpr size_t WS_R1 = WS_BIG + BIG_BYTES;
constexpr size_t R1_Q = 0, R1_KN = R1_Q + (size_t)NB * 8 * NKEY * 192 * 2, R1_V = R1_KN + (size_t)NB * 8 * NKT * 16384, R1_BYTES = R1_V + (size_t)NB * 8 * NKT * 16384;
constexpr size_t WS_R2 = WS_R1 + R1_BYTES;
constexpr size_t R2_BC = (size_t)NROW * 1024 * 2, R2_BYTES = R2_BC + (size_t)NROW * 512 * 2;
constexpr size_t R2_GATE = (size_t)NROW * 128 * 4, R2_COEF = 2 * R2_GATE;
constexpr size_t WS_R3 = WS_R2 + R2_BYTES;
constexpr size_t R3_CAT = (size_t)NROW * 1024 * 2, R3_BYTES = R3_CAT + (size_t)NROW * 2048 * 2;
constexpr size_t WS_END = WS_R3 + R3_BYTES;
static_assert(WS_END <= ((size_t)1 << 30), "workspace must fit 1 GiB");

constexpr int CW_RANK = 3584;
constexpr int CW_QUEUE = 4096;

typedef __bf16 bf16x2_t __attribute__((ext_vector_type(2)));
__device__ __forceinline__ unsigned cvt_pk_bf16(float lo, float hi) { const f32x2 v = {lo, hi}; const bf16x2_t b = __builtin_convertvector(v, bf16x2_t); return __builtin_bit_cast(unsigned, b); }
__device__ __forceinline__ bf16_t f2bf(float f) { return (bf16_t)(cvt_pk_bf16(f, 0.f) & 0xffffu); }
__device__ __forceinline__ float bf2f(unsigned b) { return __uint_as_float(b << 16); }
__device__ __forceinline__ float bflo(unsigned w) { return __uint_as_float(w << 16); }
__device__ __forceinline__ float bfhi(unsigned w) { return __uint_as_float(w & 0xffff0000u); }
__device__ __forceinline__ float wave_sum(float v) {
#pragma unroll
    for (int o = 32; o >= 1; o >>= 1) v += __shfl_xor(v, o);
    return v;
}
__device__ __forceinline__ int otid() { int t = threadIdx.x; asm volatile("" : "+v"(t)); return t; }
__device__ __forceinline__ float silu_f(float x) { return x / (1.f + __expf(-x)); }
__device__ __forceinline__ float softplus_f(float x) { return x > 20.f ? x : log1pf(__expf(x)); }
__device__ __forceinline__ f32x2 gelu_pk(f32x2 v) {
    const f32x2 av = __builtin_elementwise_abs(v), d = av * 0.2316418882f + 1.0f;
    f32x2 t; t.x = __builtin_amdgcn_rcpf(d.x); t.y = __builtin_amdgcn_rcpf(d.y);
    f32x2 q = t * 0.5307027145f + (-0.7265760135f); q = q * t + 0.7107068705f; q = q * t + (-0.142248368f); q = q * t + 0.127414796f; q = q * t;
    const f32x2 s = (v * v) * (-0.72134752044f);
    f32x2 e; e.x = __builtin_amdgcn_exp2f(s.x); e.y = __builtin_amdgcn_exp2f(s.y);
    const f32x2 m = v * (q * e), r = v - m;
    f32x2 o; o.x = v.x < 0.f ? m.x : r.x; o.y = v.y < 0.f ? m.y : r.y; return o;
}
__device__ __forceinline__ float gelu_f(float x) { f32x2 v = {x, 0.f}; return gelu_pk(v).x; }

__device__ __forceinline__ unsigned pk4_fp8(float a, float b, float c, float d) { int w = 0; w = __builtin_amdgcn_cvt_pk_fp8_f32(a, b, w, false); w = __builtin_amdgcn_cvt_pk_fp8_f32(c, d, w, true); return (unsigned)w; }
__device__ __forceinline__ float sat8(float v) { return __builtin_amdgcn_fmed3f(v, -448.f, 448.f); }
__device__ __forceinline__ unsigned pk4_fp8_sat(float a, float b, float c, float d) { return pk4_fp8(sat8(a), sat8(b), sat8(c), sat8(d)); }
__device__ __forceinline__ int row_mb(int r) { return r < NLAT ? (r >> 13) : 4; }

#define XB_TMO      128
#define XB_XCNT(j)  (256  + 64 * (j))
#define XB_XSUB(j)  (1280 + 64 * (j))
#define XB_XGEN(j)  (2304 + 64 * (j))
#define XB_TOP      3328
#define XB_TOPGEN   3392
#define XCD_BAR_WORDS 3456
#define XB_SPIN_CAP (1u << 22)
__device__ __forceinline__ unsigned xb_ld(unsigned* p)              { return __hip_atomic_load(p, __ATOMIC_RELAXED, __HIP_MEMORY_SCOPE_AGENT); }
__device__ __forceinline__ unsigned xb_add(unsigned* p, unsigned v) { return __hip_atomic_fetch_add(p, v, __ATOMIC_RELAXED, __HIP_MEMORY_SCOPE_AGENT); }
__device__ __forceinline__ unsigned xb_xcc_id() { return (unsigned)__builtin_amdgcn_s_getreg((3 << 11) | 20) & 0xFu; }
#define XB_SPIN(cond, bar) do { unsigned _sp = 0; while (cond) { __builtin_amdgcn_s_sleep(1); \
    if ((++_sp & 255u) == 0u) { if (xb_ld(&(bar)[XB_TMO])) break; if (_sp > XB_SPIN_CAP) { atomicAdd(&(bar)[XB_TMO], 1u); break; } } } } while (0)
struct XcdBarrier { unsigned* bar; unsigned x; volatile LAS unsigned* st; };
__device__ __forceinline__ XcdBarrier xcd_barrier_post(unsigned* bar, volatile LAS unsigned* st) {
    XcdBarrier b; b.bar = bar; b.x = xb_xcc_id(); b.st = st;
    if (threadIdx.x == 0) (void)xb_add(&bar[XB_XCNT(b.x)], 1u);
    return b;
}
__device__ __forceinline__ void xcd_barrier_complete(unsigned* bar, unsigned x, unsigned& nloc, unsigned& nx) {
    const unsigned G = gridDim.x * gridDim.y * gridDim.z;
    unsigned sum, cnt, mine, sp = 0u;
    for (;;) {
        sum = 0u; cnt = 0u; mine = 0u;
#pragma unroll
        for (unsigned j = 0; j < 16; ++j) { const unsigned c = xb_ld(&bar[XB_XCNT(j)]); sum += c; cnt += (c > 0u) ? 1u : 0u; mine = (j == x) ? c : mine; }
        if (sum == G) break;
        __builtin_amdgcn_s_sleep(1);
        if ((++sp & 255u) == 0u) { if (xb_ld(&bar[XB_TMO])) break; if (sp > XB_SPIN_CAP) { atomicAdd(&bar[XB_TMO], 1u); break; } }
    }
    nloc = mine > 0u ? mine : 1u; nx = cnt > 0u ? cnt : 1u;
}
__device__ __forceinline__ void xcd_barrier(const XcdBarrier& b) {
    asm volatile("s_waitcnt vmcnt(0)" ::: "memory");
    __syncthreads();
    if (threadIdx.x == 0) {
        unsigned* bar = b.bar;
        __builtin_amdgcn_s_waitcnt(0);
        unsigned nloc = b.st[0], nx = b.st[1];
        if (nloc == 0u) { xcd_barrier_complete(bar, b.x, nloc, nx); b.st[0] = nloc; b.st[1] = nx; }
        const unsigned old = xb_add(&bar[XB_XSUB(b.x)], 1u);
        const unsigned gen = old / nloc;
        if (old + 1u == (gen + 1u) * nloc) {
            __builtin_amdgcn_fence(__ATOMIC_RELEASE, "agent");
            asm volatile("s_waitcnt vmcnt(0)" ::: "memory");
            const unsigned og = xb_add(&bar[XB_TOP], 1u);
            const unsigned tg = og / nx;
            if (og + 1u == (tg + 1u) * nx) xb_add(&bar[XB_TOPGEN], 1u);
            else XB_SPIN(xb_ld(&bar[XB_TOPGEN]) == tg, bar);
            __builtin_amdgcn_fence(__ATOMIC_ACQUIRE, "agent");
            xb_add(&bar[XB_XGEN(b.x)], 1u);
            asm volatile("s_waitcnt vmcnt(0)" ::: "memory");
        } else {
            XB_SPIN(xb_ld(&bar[XB_XGEN(b.x)]) == gen, bar);
            __builtin_amdgcn_fence(__ATOMIC_ACQUIRE, "agent");
            asm volatile("s_waitcnt vmcnt(0)" ::: "memory");
        }
    }
    __syncthreads();
}

namespace pg8 {
constexpr int BM = 256, BK = 64, HALF = 128, HTB = HALF * BK * 2, STAGE_BYTES = 8 * HTB, NXCD = 8, WGM = 8;
__host__ __device__ __forceinline__ int lds_byte(int r, int c) { const int st = (r >> 4) * 2 + (c >> 5), rr = r & 15, cc = c & 31, ob = rr * 64 + cc * 2; return st * 1024 + (ob ^ (((ob >> 9) & 1) << 5)); }
__host__ __device__ __forceinline__ void stage_rc(int b, int& R, int& C) { const int st = b / 1024, sb = b % 1024, swz = sb ^ (((sb >> 9) & 1) << 5); R = (st >> 1) * 16 + swz / 64; C = (st & 1) * 32 + (swz % 64) / 2; }
__host__ __device__ __forceinline__ int perm32(int rho) { const int n = rho >> 4, i = rho & 15; return 8 * (i >> 2) + 4 * n + (i & 3); }
struct Unit { int pm, pn; };
struct Gemm { const bf16_t* A; const bf16_t* Bt; int M, N, K, lda, ldb; };
struct StaticOrder {
    int nM, nN, nwg, G, c;
    __device__ void init(int M, int N, int G_, int c_) { nM = M / BM; nN = N / BM; nwg = nM * nN; G = G_; c = c_; }
    __device__ bool next(int i, Unit& u) const {
        const long L = (long)i * G + c; if (L >= nwg) return false;
        int wgid = (int)L; { const int q = nwg / NXCD, r = nwg % NXCD, xcd = wgid % NXCD, off = wgid / NXCD; wgid = (xcd < r ? xcd * (q + 1) : r * (q + 1) + (xcd - r) * q) + off; }
        const int nig = WGM * nN, gid = wgid / nig, fm = gid * WGM, gsz = (nM - fm) < WGM ? (nM - fm) : WGM;
        u.pm = fm + ((wgid % nig) % gsz); u.pn = (wgid % nig) / gsz; return true;
    }
};
template <class Epi>
__device__ __forceinline__ void gemm_phase(LAS unsigned char* lds, const Gemm g, const Epi& E) {
    const int tid = otid(), wid = __builtin_amdgcn_readfirstlane(tid >> 6), lane = tid & 63, wr = wid >> 2, wc = wid & 3, fr = lane & 15, fq = lane >> 4;
    StaticOrder S; S.init(g.M, g.N, (int)gridDim.x, (int)blockIdx.x);
    int K = g.K; asm volatile("" : "+s"(K));
    const int nt = K / BK;
    unsigned voffA[2], voffB[2];
#pragma unroll
    for (int i = 0; i < 2; ++i) { int R, C; stage_rc(tid * 16 + i * 8192, R, C); const int Rb = Epi::PERM ? ((R & ~31) + perm32(R & 31)) : R;
        voffA[i] = (unsigned)(R * g.lda + C) * 2u; voffB[i] = (unsigned)(Rb * g.ldb + C) * 2u; }
    const size_t kstep = (size_t)(BK * 2);
    const size_t hstepA = (size_t)HALF * g.lda * 2, hstepB = (size_t)HALF * g.ldb * 2;
    const size_t tstepA = 2 * hstepA, tstepB = 2 * hstepB;
    const unsigned ldsw = (unsigned)wid * 1024u;
    const int aoff = lds_byte(wr * 64 + fr, fq * 8), boff = lds_byte(wc * 32 + fr, fq * 8);
#define PG8_SA(b, h) (((b) * 2 + (h)) * HTB)
#define PG8_SB(b, h) ((4 + (b) * 2 + (h)) * HTB)
#define PG8_STAGE(bufoff, gbase, voff) do { _Pragma("unroll") for (int _i = 0; _i < 2; ++_i) \
        __builtin_amdgcn_global_load_lds((const unsigned*)((const char*)(gbase) + (voff)[_i]), (LAS unsigned*)(lds + (bufoff) + ldsw + _i * 8192), 16, 0, 0); } while (0)
#define PG8_LDA(dst, b, h) do { _Pragma("unroll") for (int m = 0; m < 4; ++m) _Pragma("unroll") for (int k = 0; k < 2; ++k) dst[m][k] = *(const LAS bf16x8*)(lds + PG8_SA(b, h) + aoff + m * 2048 + k * 1024); } while (0)
#define PG8_LDB(dst, b, h) do { _Pragma("unroll") for (int n = 0; n < 2; ++n) _Pragma("unroll") for (int k = 0; k < 2; ++k) dst[n][k] = *(const LAS bf16x8*)(lds + PG8_SB(b, h) + boff + n * 2048 + k * 1024); } while (0)
#define PG8_MMA(ai, bj, At, Bt) do { __builtin_amdgcn_s_setprio(1); _Pragma("unroll") for (int m = 0; m < 4; ++m) _Pragma("unroll") for (int n = 0; n < 2; ++n) _Pragma("unroll") for (int k = 0; k < 2; ++k) \
        acc[ai][bj][m][n] = __builtin_amdgcn_mfma_f32_16x16x32_bf16(Bt[n][k], At[m][k], acc[ai][bj][m][n], 0, 0, 0); __builtin_amdgcn_s_setprio(0); } while (0)
#define PG8_WAIT_V(n) asm volatile("s_waitcnt vmcnt(" #n ")" ::: "memory")
#define PG8_WAIT_L(n) asm volatile("s_waitcnt lgkmcnt(" #n ")" ::: "memory")
#define PG8_BAR __builtin_amdgcn_s_barrier()
#define PG8_SCHED __builtin_amdgcn_sched_barrier(0)
    Unit cur, nxt; int ui = 0;
    if (!S.next(0, cur)) return;
    f32x4 acc[2][2][4][2];
#pragma unroll
    for (int a = 0; a < 2; ++a)
#pragma unroll
        for (int b = 0; b < 2; ++b)
#pragma unroll
            for (int m = 0; m < 4; ++m)
#pragma unroll
                for (int n = 0; n < 2; ++n) acc[a][b][m][n] = (f32x4){0.f, 0.f, 0.f, 0.f};
    bf16x8 At[4][2], B0[2][2], B1[2][2];
    const char* cA = (const char*)g.A + (size_t)cur.pm * tstepA; const char* cB = (const char*)g.Bt + (size_t)cur.pn * tstepB;
    PG8_STAGE(PG8_SB(0, 0), cB, voffB); PG8_STAGE(PG8_SB(0, 1), cB + hstepB, voffB); PG8_STAGE(PG8_SA(0, 0), cA, voffA); PG8_STAGE(PG8_SA(0, 1), cA + hstepA, voffA);
    if (wr == 1) PG8_BAR;
    PG8_WAIT_V(2); PG8_BAR;
    PG8_STAGE(PG8_SB(1, 0), cB + kstep, voffB); PG8_STAGE(PG8_SA(1, 0), cA + kstep, voffA); PG8_STAGE(PG8_SB(1, 1), cB + hstepB + kstep, voffB);
    PG8_WAIT_V(6); PG8_BAR;
    for (;;) {
        const bool has_next = S.next(ui + 1, nxt);
        const char* nA = has_next ? (const char*)g.A + (size_t)nxt.pm * tstepA : cA; const char* nB = has_next ? (const char*)g.Bt + (size_t)nxt.pn * tstepB : cB;
        for (int t = 0; t < nt; t += 2) {
            const bool last = (t == nt - 2);
            const char* a1 = cA + (size_t)(t + 1) * kstep;
            const char* a2 = last ? nA : cA + (size_t)(t + 2) * kstep; const char* b2 = last ? nB : cB + (size_t)(t + 2) * kstep;
            const char* a3 = a2 + kstep; const char* b3 = b2 + kstep;
            PG8_LDB(B0, 0, 0); PG8_LDB(B1, 0, 1); PG8_SCHED; PG8_LDA(At, 0, 0); PG8_STAGE(PG8_SA(1, 1), a1 + hstepA, voffA);
            PG8_WAIT_V(8); PG8_WAIT_L(0); PG8_BAR; PG8_MMA(0, 0, At, B0); PG8_MMA(0, 1, At, B1); PG8_BAR; PG8_SCHED;
            PG8_LDA(At, 0, 1); PG8_STAGE(PG8_SB(0, 0), b2, voffB); PG8_STAGE(PG8_SB(0, 1), b2 + hstepB, voffB); PG8_STAGE(PG8_SA(0, 0), a2, voffA);
            PG8_WAIT_V(8); PG8_WAIT_L(0); PG8_BAR; PG8_MMA(1, 0, At, B0); PG8_MMA(1, 1, At, B1); PG8_BAR; PG8_SCHED;
            PG8_LDB(B0, 1, 0); PG8_LDB(B1, 1, 1); PG8_SCHED; PG8_LDA(At, 1, 0); PG8_STAGE(PG8_SA(0, 1), a2 + hstepA, voffA);
            PG8_WAIT_V(8); PG8_WAIT_L(0); PG8_BAR; PG8_MMA(0, 0, At, B0); PG8_MMA(0, 1, At, B1); PG8_BAR; PG8_SCHED;
            PG8_LDA(At, 1, 1); PG8_STAGE(PG8_SB(1, 0), b3, voffB); PG8_STAGE(PG8_SB(1, 1), b3 + hstepB, voffB); PG8_STAGE(PG8_SA(1, 0), a3, voffA);
            PG8_WAIT_V(8); PG8_WAIT_L(0); PG8_BAR; PG8_MMA(1, 0, At, B0); PG8_MMA(1, 1, At, B1); PG8_BAR; PG8_SCHED;
        }
        if (wr == 0) PG8_BAR;
        { const int l2_ = otid() & 63; E(acc, cur, wr, wc, l2_ & 15, l2_ >> 4); }
        if (!has_next) break;
#pragma unroll
        for (int a = 0; a < 2; ++a)
#pragma unroll
            for (int b = 0; b < 2; ++b)
#pragma unroll
                for (int m = 0; m < 4; ++m)
#pragma unroll
                    for (int n = 0; n < 2; ++n) acc[a][b][m][n] = (f32x4){0.f, 0.f, 0.f, 0.f};
        cur = nxt; cA = nA; cB = nB; ++ui;
        if (wr == 1) PG8_BAR;
    }
    PG8_WAIT_V(0);
    PG8_BAR;
#undef PG8_SA
#undef PG8_SB
#undef PG8_STAGE
#undef PG8_LDA
#undef PG8_LDB
#undef PG8_MMA
#undef PG8_WAIT_V
#undef PG8_WAIT_L
#undef PG8_BAR
#undef PG8_SCHED
}

template <int ACT> struct EpiBf16 {
    static constexpr bool PERM = true;
    bf16_t* O; int ldc;
    __device__ __forceinline__ void operator()(const f32x4 (&acc)[2][2][4][2], const Unit& u, int wr, int wc, int fr, int fq) const {
        const int row0 = u.pm * BM + wr * 64 + fr, col0 = u.pn * BM + wc * 32 + 8 * fq;
#pragma unroll
        for (int ai = 0; ai < 2; ++ai)
#pragma unroll
            for (int m = 0; m < 4; ++m) { bf16_t* rowp = O + (size_t)(row0 + ai * HALF + m * 16) * ldc + col0;
#pragma unroll
                for (int bj = 0; bj < 2; ++bj) { f32x4 v0 = acc[ai][bj][m][0], v1 = acc[ai][bj][m][1];
                    if (ACT == 1) { f32x2 a = gelu_pk((f32x2){v0[0], v0[1]}), b = gelu_pk((f32x2){v0[2], v0[3]}), c = gelu_pk((f32x2){v1[0], v1[1]}), d = gelu_pk((f32x2){v1[2], v1[3]});
                        v0 = (f32x4){a.x, a.y, b.x, b.y}; v1 = (f32x4){c.x, c.y, d.x, d.y}; }
                    u32x4 w; w.x = cvt_pk_bf16(v0[0], v0[1]); w.y = cvt_pk_bf16(v0[2], v0[3]); w.z = cvt_pk_bf16(v1[0], v1[1]); w.w = cvt_pk_bf16(v1[2], v1[3]);
                    *(u32x4*)(rowp + bj * HALF) = w; } }
    }
};
struct EpiGmIn {
    static constexpr bool PERM = true;
    bf16_t* O; float* parts;
    __device__ __forceinline__ void operator()(const f32x4 (&acc)[2][2][4][2], const Unit& u, int wr, int wc, int fr, int fq) const {
        const int row0 = u.pm * BM + wr * 64 + fr, col0 = u.pn * BM + wc * 32 + 8 * fq; const bool vhalf = u.pn >= 8;
#pragma unroll
        for (int ai = 0; ai < 2; ++ai)
#pragma unroll
            for (int m = 0; m < 4; ++m) { const int row = row0 + ai * HALF + m * 16; bf16_t* rowp = O + (size_t)row * 4096 + col0; f32x2 sa = {0.f, 0.f}, sq = {0.f, 0.f};
#pragma unroll
                for (int bj = 0; bj < 2; ++bj) { const f32x4 v0 = acc[ai][bj][m][0], v1 = acc[ai][bj][m][1];
                    const f32x2 a = gelu_pk((f32x2){v0[0], v0[1]}), b = gelu_pk((f32x2){v0[2], v0[3]}), c = gelu_pk((f32x2){v1[0], v1[1]}), d = gelu_pk((f32x2){v1[2], v1[3]});
                    sa += (a + b) + (c + d); sq += (a * a + b * b) + (c * c + d * d);
                    u32x4 w; w.x = cvt_pk_bf16(a.x, a.y); w.y = cvt_pk_bf16(b.x, b.y); w.z = cvt_pk_bf16(c.x, c.y); w.w = cvt_pk_bf16(d.x, d.y);
                    *(u32x4*)(rowp + bj * HALF) = w; }
                if (vhalf) { float s1 = sa.x + sa.y, s2 = sq.x + sq.y;
                    { auto r = __builtin_amdgcn_permlane16_swap(__float_as_uint(s1), __float_as_uint(s1), false, false); s1 = __uint_as_float(r[0]) + __uint_as_float(r[1]); }
                    { auto r = __builtin_amdgcn_permlane16_swap(__float_as_uint(s2), __float_as_uint(s2), false, false); s2 = __uint_as_float(r[0]) + __uint_as_float(r[1]); }
                    { auto r = __builtin_amdgcn_permlane32_swap(__float_as_uint(s1), __float_as_uint(s1), false, false); s1 = __uint_as_float(r[0]) + __uint_as_float(r[1]); }
                    { auto r = __builtin_amdgcn_permlane32_swap(__float_as_uint(s2), __float_as_uint(s2), false, false); s2 = __uint_as_float(r[0]) + __uint_as_float(r[1]); }
                    if (fq == 0) *(f32x2*)(parts + ((size_t)row * 32 + (u.pn - 8) * 4 + wc) * 2) = (f32x2){s1, s2}; } }
    }
};
struct EpiResid {
    static constexpr bool PERM = false;
    float* xl; float* xc; const float* gate;
    __device__ __forceinline__ void operator()(const f32x4 (&acc)[2][2][4][2], const Unit& u, int wr, int wc, int fr, int fq) const {
        const int rbase = u.pm * BM; const bool lat = rbase < NLAT;
        float* X = lat ? xl + (size_t)rbase * D : xc + (size_t)(rbase - NLAT) * D;
        const float* gp = gate + (size_t)(lat ? (rbase >> 13) : 4) * 6144;
        const int row0 = wr * 64 + fr, col0 = u.pn * BM + wc * 32 + 4 * fq;
        f32x4 gv[2][2];
#pragma unroll
        for (int bj = 0; bj < 2; ++bj)
#pragma unroll
            for (int n = 0; n < 2; ++n) gv[bj][n] = *(const f32x4*)(gp + col0 + bj * HALF + n * 16);
#pragma unroll
        for (int ai = 0; ai < 2; ++ai)
#pragma unroll
            for (int m = 0; m < 4; ++m) { float* rowp = X + (size_t)(row0 + ai * HALF + m * 16) * D + col0;
#pragma unroll
                for (int bj = 0; bj < 2; ++bj)
#pragma unroll
                    for (int n = 0; n < 2; ++n) { f32x4* p = (f32x4*)(rowp + bj * HALF + n * 16); *p = *p + gv[bj][n] * acc[ai][bj][m][n]; } }
    }
};
}

namespace att {
#define KSWZ(row, colB) ((row) * 256 + ((colB) ^ (((row) & 7) << 4)))
#define KRSWZ(row, colB) ((row) * 128 + ((colB) ^ ((((row) >> 1) & 7) << 4)))
#define SBAR() __builtin_amdgcn_sched_barrier(0)
__device__ __forceinline__ int crow(int r, int hi) { return (r & 3) + 8 * (r >> 2) + 4 * hi; }
__host__ __device__ __forceinline__ int v_st(int k, int c) { const int kk = (k & ~0xC) | ((k & 4) << 1) | ((k & 8) >> 1); return ((kk >> 3) * 4 + (c >> 5)) * 512 + ((kk & 7) * 32 + (c & 31)) * 2; }
__device__ __forceinline__ int v_rd_base(int lane) { return ((lane & 3) << 3) | (((lane >> 2) & 3) << 6) | (((lane >> 4) & 1) << 5) | (((lane >> 5) & 1) << 8); }
constexpr int v_rd_off(int d0, int ks, int half) { return d0 * 512 + ks * 4096 + half * 2048; }
template <int OFF> __device__ __forceinline__ s16x4 tr_read(int vb) {
    s16x4 r; asm volatile("ds_read_b64_tr_b16 %0, %1 offset:%2" : "=&v"(r) : "v"(vb), "i"(OFF) : "memory"); return r;
}
template <int D0> __device__ __forceinline__ void pv_one(f32x16& od, int vb, bf16x8 pa0, bf16x8 pa1, bf16x8 pa2, bf16x8 pa3) {
    const s16x4 l0 = tr_read<v_rd_off(D0, 0, 0)>(vb), h0 = tr_read<v_rd_off(D0, 0, 1)>(vb), l1 = tr_read<v_rd_off(D0, 1, 0)>(vb), h1 = tr_read<v_rd_off(D0, 1, 1)>(vb);
    const s16x4 l2 = tr_read<v_rd_off(D0, 2, 0)>(vb), h2 = tr_read<v_rd_off(D0, 2, 1)>(vb), l3 = tr_read<v_rd_off(D0, 3, 0)>(vb), h3 = tr_read<v_rd_off(D0, 3, 1)>(vb);
    asm volatile("s_waitcnt lgkmcnt(0)" ::: "memory"); SBAR();
#define PK(L, H) (bf16x8){L[0], L[1], L[2], L[3], H[0], H[1], H[2], H[3]}
    od = __builtin_amdgcn_mfma_f32_32x32x16_bf16(pa0, PK(l0, h0), od, 0, 0, 0);
    od = __builtin_amdgcn_mfma_f32_32x32x16_bf16(pa1, PK(l1, h1), od, 0, 0, 0);
    od = __builtin_amdgcn_mfma_f32_32x32x16_bf16(pa2, PK(l2, h2), od, 0, 0, 0);
    od = __builtin_amdgcn_mfma_f32_32x32x16_bf16(pa3, PK(l3, h3), od, 0, 0, 0);
#undef PK
}
__device__ __forceinline__ void pv_d0(f32x16* o, int vb, bf16x8 pa0, bf16x8 pa1, bf16x8 pa2, bf16x8 pa3) {
    pv_one<0>(o[0], vb, pa0, pa1, pa2, pa3); pv_one<1>(o[1], vb, pa0, pa1, pa2, pa3); pv_one<2>(o[2], vb, pa0, pa1, pa2, pa3); pv_one<3>(o[3], vb, pa0, pa1, pa2, pa3);
}
}

namespace att8 {
constexpr int SLOT = 20480, KN_OFF = 0, KR_OFF = 8192, V_OFF = 12288, LDS_BYTES = 3 * SLOT + 8 * 256;
constexpr float THR2 = 8.0f;
constexpr float QUP = 8.f; constexpr int SC_ONE = 0x7f7f7f7f, SC_Q = 0x7c7c7c7c;
__host__ __device__ __forceinline__ int kn8(int key, int b) { return key * 128 + ((((b >> 4) ^ ((key >> 1) & 7))) << 4) + (b & 15); }
__host__ __device__ __forceinline__ int kr8(int key, int b) { return key * 64 + ((((b >> 4) ^ ((key >> 2) & 3))) << 4) + (b & 15); }
__host__ __device__ __forceinline__ int vslot(int k) { return 32 * ((k >> 2) & 1) + 16 * (k >> 5) + (k & 3) + 4 * ((k & 31) >> 3); }
__host__ __device__ __forceinline__ int v8(int d, int k) { const int sl = vslot(k); return d * 64 + ((((sl >> 4) ^ ((d >> 2) & 3))) << 4) + (sl & 15); }
__device__ __forceinline__ i32x8 ld32(const LAS unsigned char* a0, const LAS unsigned char* a1) { const u32x4 x = *(const LAS u32x4*)a0, y = *(const LAS u32x4*)a1;
    return (i32x8){(int)x.x, (int)x.y, (int)x.z, (int)x.w, (int)y.x, (int)y.y, (int)y.z, (int)y.w}; }
__device__ __forceinline__ void qkt(f32x16& p0, f32x16& p1, LAS unsigned char* slot, const i32x8* qf, int r32, int hi) {
    p0 = f32x16{}; p1 = f32x16{};
#pragma unroll
    for (int ks = 0; ks < 2; ++ks) { const int b = 64 * ks + 32 * hi;
        const i32x8 a0 = ld32(slot + KN_OFF + kn8(r32, b), slot + KN_OFF + kn8(r32, b + 16)), a1 = ld32(slot + KN_OFF + kn8(32 + r32, b), slot + KN_OFF + kn8(32 + r32, b + 16));
        p0 = __builtin_amdgcn_mfma_scale_f32_32x32x64_f8f6f4(a0, qf[ks], p0, 0, 0, 0, SC_ONE, 0, SC_Q);
        p1 = __builtin_amdgcn_mfma_scale_f32_32x32x64_f8f6f4(a1, qf[ks], p1, 0, 0, 0, SC_ONE, 0, SC_Q); }
    { const int b = 32 * hi;
        const i32x8 a0 = ld32(slot + KR_OFF + kr8(r32, b), slot + KR_OFF + kr8(r32, b + 16)), a1 = ld32(slot + KR_OFF + kr8(32 + r32, b), slot + KR_OFF + kr8(32 + r32, b + 16));
        p0 = __builtin_amdgcn_mfma_scale_f32_32x32x64_f8f6f4(a0, qf[2], p0, 0, 0, 0, SC_ONE, 0, SC_Q);
        p1 = __builtin_amdgcn_mfma_scale_f32_32x32x64_f8f6f4(a1, qf[2], p1, 0, 0, 0, SC_ONE, 0, SC_Q); }
}
__device__ __forceinline__ void partialSM(f32x16& p0, f32x16& p1, float& m_reg, float& mn, float& alpha) {
    float pmax = p0[0];
#pragma unroll
    for (int r = 1; r < 16; ++r) pmax = fmaxf(pmax, p0[r]);
#pragma unroll
    for (int r = 0; r < 16; ++r) pmax = fmaxf(pmax, p1[r]);
    { auto rr = __builtin_amdgcn_permlane32_swap(__float_as_uint(pmax), __float_as_uint(pmax), false, false);
      pmax = fmaxf(__uint_as_float(rr[0]), __uint_as_float(rr[1])); }
    if (__builtin_expect(__all(pmax - m_reg <= THR2), 1)) { mn = m_reg; alpha = 1.f; }
    else { mn = fmaxf(m_reg, pmax); alpha = __builtin_amdgcn_exp2f(m_reg - mn); m_reg = mn; }
#pragma unroll
    for (int r = 0; r < 16; ++r) p0[r] = __builtin_amdgcn_exp2f(p0[r] - mn);
#pragma unroll
    for (int r = 0; r < 16; ++r) p1[r] = p1[r] - mn;
}
__device__ __forceinline__ void finishSM(f32x16& p0, f32x16& p1, float alpha, float& l_reg, i32x8& pf) {
#pragma unroll
    for (int r = 0; r < 16; ++r) p1[r] = __builtin_amdgcn_exp2f(p1[r]);
    float ps = 0;
#pragma unroll
    for (int r = 0; r < 16; ++r) ps += p0[r];
#pragma unroll
    for (int r = 0; r < 16; ++r) ps += p1[r];
    { auto rr = __builtin_amdgcn_permlane32_swap(__float_as_uint(ps), __float_as_uint(ps), false, false);
      ps = __uint_as_float(rr[0]) + __uint_as_float(rr[1]); }
    l_reg = l_reg * alpha + ps;
#pragma unroll
    for (int w = 0; w < 4; ++w) { pf[w] = (int)pk4_fp8(p0[4 * w], p0[4 * w + 1], p0[4 * w + 2], p0[4 * w + 3]); pf[4 + w] = (int)pk4_fp8(p1[4 * w], p1[4 * w + 1], p1[4 * w + 2], p1[4 * w + 3]); }
}
__device__ __forceinline__ void pv(f32x16* o, LAS unsigned char* slot, const i32x8 pf, int r32, int hi) {
#pragma unroll
    for (int d0 = 0; d0 < 4; ++d0) { const int d = 32 * d0 + r32, sw = (d >> 2) & 3;
        const i32x8 b = ld32(slot + V_OFF + d * 64 + (((2 * hi) ^ sw) << 4), slot + V_OFF + d * 64 + (((2 * hi + 1) ^ sw) << 4));
        o[d0] = __builtin_amdgcn_mfma_scale_f32_32x32x64_f8f6f4(pf, b, o[d0], 0, 0, 0, SC_ONE, 0, SC_ONE); }
}
__device__ __forceinline__ int crow(int r, int hi) { return (r & 3) + 8 * (r >> 2) + 4 * hi; }
__device__ __forceinline__ void attn_unit(const unsigned char* __restrict__ Qb, const unsigned char* __restrict__ KNt, const unsigned char* __restrict__ KRt, const unsigned char* __restrict__ Vt,
                                          bf16_t* __restrict__ Ob, int NT, LAS unsigned char* lds) {
    const int tid = otid(), wid = __builtin_amdgcn_readfirstlane(tid >> 6), lane = tid & 63, r32 = lane & 31, hi = lane >> 5;
    LAS float* wsf = (LAS float*)(lds + 3 * SLOT) + wid * 64; LAS float* li_l = wsf; LAS float* al_l = wsf + 32;
    float m_reg = -1e30f, l_reg = 0; f32x16 o[4] = {}; i32x8 qf[3];
    const unsigned char* Qw = Qb + (size_t)(wid * 32 + r32) * 192 + 32 * hi;
#pragma unroll
    for (int ks = 0; ks < 3; ++ks) { const u32x4 x = *(const u32x4*)(Qw + 64 * ks), y = *(const u32x4*)(Qw + 64 * ks + 16); qf[ks] = (i32x8){(int)x.x, (int)x.y, (int)x.z, (int)x.w, (int)y.x, (int)y.y, (int)y.z, (int)y.w}; }
    const unsigned lo16 = (unsigned)lane * 16u;
#define ATT_DMA(tile, slotoff) do { const size_t t_ = (size_t)(tile); LAS unsigned char* sl_ = lds + (slotoff); \
        __builtin_amdgcn_global_load_lds((const unsigned*)(KNt + t_ * 8192 + wid * 1024 + lo16), (LAS unsigned*)(sl_ + KN_OFF + wid * 1024), 16, 0, 0); \
        __builtin_amdgcn_global_load_lds((const unsigned*)(Vt + t_ * 8192 + wid * 1024 + lo16), (LAS unsigned*)(sl_ + V_OFF + wid * 1024), 16, 0, 0); \
        if (wid < 4) __builtin_amdgcn_global_load_lds((const unsigned*)(KRt + t_ * 4096 + wid * 1024 + lo16), (LAS unsigned*)(sl_ + KR_OFF + wid * 1024), 16, 0, 0); } while (0)
#define ATT_SYNC() do { asm volatile("s_waitcnt vmcnt(0)" ::: "memory"); __builtin_amdgcn_s_barrier(); asm volatile("" ::: "memory"); } while (0)
#define RESC(a) do { if (__any((a) < 1.f)) { if (hi == 0) al_l[r32] = (a); asm volatile("s_waitcnt lgkmcnt(0)" ::: "memory"); \
        _Pragma("unroll") for (int d = 0; d < 4; ++d) _Pragma("unroll") for (int r = 0; r < 16; ++r) o[d][r] *= al_l[crow(r, hi)]; } } while (0)
    f32x16 pA0, pA1, pB0, pB1; float mnA, mnB, alA, alB; i32x8 pf;
    int sp = 0, sc = SLOT, sn = 2 * SLOT;
    ATT_DMA(0, 0);
    ATT_SYNC();
    ATT_DMA(1, SLOT);
    qkt(pA0, pA1, lds, qf, r32, hi); partialSM(pA0, pA1, m_reg, mnA, alA);
    for (int j = 1; j + 1 < NT; j += 2) {
        ATT_SYNC(); ATT_DMA(j + 1, sn);
        SBAR(); qkt(pB0, pB1, lds + sc, qf, r32, hi);
        finishSM(pA0, pA1, alA, l_reg, pf); SBAR();
        pv(o, lds + sp, pf, r32, hi); partialSM(pB0, pB1, m_reg, mnB, alB);
        RESC(alB);
        { const int t_ = sp; sp = sc; sc = sn; sn = t_; }
        ATT_SYNC(); if (j + 2 < NT) ATT_DMA(j + 2, sn);
        SBAR(); qkt(pA0, pA1, lds + sc, qf, r32, hi);
        finishSM(pB0, pB1, alB, l_reg, pf); SBAR();
        pv(o, lds + sp, pf, r32, hi); partialSM(pA0, pA1, m_reg, mnA, alA);
        RESC(alA);
        { const int t_ = sp; sp = sc; sc = sn; sn = t_; }
    }
    ATT_SYNC();
    SBAR(); qkt(pB0, pB1, lds + sc, qf, r32, hi);
    finishSM(pA0, pA1, alA, l_reg, pf); SBAR();
    pv(o, lds + sp, pf, r32, hi); partialSM(pB0, pB1, m_reg, mnB, alB);
    RESC(alB);
    finishSM(pB0, pB1, alB, l_reg, pf); SBAR();
    pv(o, lds + sc, pf, r32, hi);
    if (hi == 0) li_l[r32] = l_reg; asm volatile("s_waitcnt lgkmcnt(0)" ::: "memory");
    float rli[16];
#pragma unroll
    for (int r = 0; r < 16; ++r) rli[r] = __builtin_amdgcn_rcpf(li_l[crow(r, hi)]);
    bf16_t* Ow = Ob + (size_t)(wid * 32) * 2048;
#pragma unroll
    for (int r = 0; r < 16; ++r) { const int orow = crow(r, hi);
#pragma unroll
        for (int d0 = 0; d0 < 4; ++d0) Ow[(size_t)orow * 2048 + d0 * 32 + r32] = f2bf(o[d0][r] * rli[r]); }
    __builtin_amdgcn_s_barrier(); asm volatile("" ::: "memory");
#undef ATT_DMA
#undef ATT_SYNC
#undef RESC
}
}

namespace ssd {
constexpr int XT_OFF = 0, BT_OFF = 17408, HB_OFF = 52224, SET = 69632, CW_OFF = 2 * SET, LDS_BYTES = CW_OFF + 8 * 1536;
constexpr int PITCH = 272;
constexpr float L2E = 1.4426950408889634f;
__device__ __forceinline__ void g_unit(const bf16_t* __restrict__ BC, bf16_t* __restrict__ G, int unit) {
    const int cid = unit >> 1, g = unit & 1;
    const int r0 = cid < 256 ? cid * 128 : NLAT + (cid - 256) * 128;
    const int tid = otid(), wid = tid >> 6, lane = tid & 63, fr = lane & 15, fq = lane >> 4;
    const bf16_t* Cp = BC + (size_t)(r0 + 16 * wid + fr) * 512 + 256 + 128 * g + 8 * fq;
    bf16x8 cf[4];
#pragma unroll
    for (int ks = 0; ks < 4; ++ks) cf[ks] = *(const bf16x8*)(Cp + 32 * ks);
    bf16_t* Gp = G + ((size_t)unit * 128 + 16 * wid + fr) * 128 + 4 * fq;
#pragma unroll
    for (int sb = 0; sb < 8; ++sb) {
        const bf16_t* Bp = BC + (size_t)(r0 + 16 * sb + fr) * 512 + 128 * g + 8 * fq;
        f32x4 acc = {0.f, 0.f, 0.f, 0.f};
#pragma unroll
        for (int ks = 0; ks < 4; ++ks) { const bf16x8 bfr = *(const bf16x8*)(Bp + 32 * ks); acc = __builtin_amdgcn_mfma_f32_16x16x32_bf16(bfr, cf[ks], acc, 0, 0, 0); }
        u32x2 w; w.x = cvt_pk_bf16(acc[0], acc[1]); w.y = cvt_pk_bf16(acc[2], acc[3]);
        *(u32x2*)(Gp + 16 * sb) = w;
    }
}
__device__ __forceinline__ void ssd_unit(int b, int h, int d, const bf16_t* __restrict__ XS, const bf16_t* __restrict__ BC, const float* __restrict__ DT, const bf16_t* __restrict__ G,
                                         const float* __restrict__ a_log, bf16_t* __restrict__ Y, LAS unsigned char* lds) {
    const int g = h >> 3;
    const int tid = otid(), wid = tid >> 6, lane = tid & 63, fr = lane & 15, fq = lane >> 4;
    const float a = -__expf(a_log[d * 16 + h]);
    LAS float* cw = (LAS float*)(lds + CW_OFF + wid * 1536); LAS float* dts = cw + 128; LAS float* dtw = cw + 256;
    f32x4 hs[4];
#pragma unroll
    for (int q = 0; q < 4; ++q) hs[q] = (f32x4){0.f, 0.f, 0.f, 0.f};
    for (int i = tid; i < 17408 / 4; i += 512) ((LAS unsigned*)(lds + HB_OFF))[i] = 0u;
    float cend = 0.f;
#define SSD_ROWS(step, r0v, gidv) do { if ((step) < 2) { const int oc_ = d ? 1 - (step) : (step); r0v = NLAT + b * 256 + oc_ * 128; gidv = 256 + b * 2 + oc_; } \
        else { const int lc_ = (step) - 2, oc_ = d ? 63 - lc_ : lc_; r0v = b * 8192 + oc_ * 128; gidv = b * 64 + oc_; } } while (0)
    const int sg = tid & 31, n8 = tid >> 5, p4 = tid >> 5;
    f32x2 P_da, Q_da; u32x2 P_xv[4], Q_xv[4]; u32x4 P_bv[4], Q_bv[4], n_gv[4], n_cv[4], c_gv[4], c_cv[4];
#define SSD_LOAD(step, X) do { int r0_, gid_; SSD_ROWS(step, r0_, gid_); (void)gid_; X##_da = *(const f32x2*)(DT + (size_t)(d * 16 + h) * NROW + r0_ + 2 * lane); \
        _Pragma("unroll") for (int j_ = 0; j_ < 4; ++j_) { X##_xv[j_] = *(const u32x2*)(XS + (size_t)(r0_ + 4 * sg + j_) * 1024 + 64 * h + 4 * p4); \
                                                         X##_bv[j_] = *(const u32x4*)(BC + (size_t)(r0_ + 4 * sg + j_) * 512 + 128 * g + 8 * n8); } } while (0)
#define SSD_LOADGC(step) do { int r0_, gid_; SSD_ROWS(step, r0_, gid_); const int t_ = 16 * wid + fr; const bf16_t* Gp_ = G + ((size_t)(gid_ * 2 + g) * 128 + t_) * 128 + 8 * fq; const bf16_t* Cp_ = BC + (size_t)(r0_ + t_) * 512 + 256 + 128 * g + 8 * fq; \
          _Pragma("unroll") for (int ks_ = 0; ks_ < 4; ++ks_) { n_gv[ks_] = *(const u32x4*)(Gp_ + 32 * ks_); n_cv[ks_] = *(const u32x4*)(Cp_ + 32 * ks_); } } while (0)
#define SSD_GCROT() do { _Pragma("unroll") for (int ks_ = 0; ks_ < 4; ++ks_) { c_gv[ks_] = n_gv[ks_]; c_cv[ks_] = n_cv[ks_]; } } while (0)
#define SSD_WRITE(step, X) do { LAS unsigned char* set_ = lds + ((step) & 1) * SET; \
        const float da0 = X##_da.x * a, da1 = X##_da.y * a; \
        float sc_ = da0 + da1; float c0_, c1_; \
        if (d == 0) { _Pragma("unroll") for (int o_ = 1; o_ < 64; o_ <<= 1) { const float t_ = __shfl_up(sc_, o_); if (lane >= o_) sc_ += t_; } \
            c0_ = sc_ - da1; c1_ = sc_; cend = __shfl(sc_, 63); } \
        else { _Pragma("unroll") for (int o_ = 1; o_ < 64; o_ <<= 1) { const float t_ = __shfl_down(sc_, o_); if (lane + o_ < 64) sc_ += t_; } \
            c0_ = sc_; c1_ = sc_ - da0; cend = __shfl(sc_, 0); } \
        *(LAS f32x2*)(cw + 2 * lane) = (f32x2){c0_, c1_}; *(LAS f32x2*)(dts + 2 * lane) = X##_da; \
        *(LAS f32x2*)(dtw + 2 * lane) = (f32x2){X##_da.x * __builtin_amdgcn_exp2f((cend - c0_) * L2E), X##_da.y * __builtin_amdgcn_exp2f((cend - c1_) * L2E)}; \
        { LAS unsigned char* xt_ = set_ + XT_OFF + (4 * p4) * PITCH + 8 * sg; \
          _Pragma("unroll") for (int i_ = 0; i_ < 4; ++i_) { unsigned e_[4]; \
              _Pragma("unroll") for (int j_ = 0; j_ < 4; ++j_) { const unsigned w_ = (i_ & 2) ? X##_xv[j_].y : X##_xv[j_].x; e_[j_] = (i_ & 1) ? (w_ >> 16) : (w_ & 0xffffu); } \
              u32x2 o_; o_.x = e_[0] | (e_[1] << 16); o_.y = e_[2] | (e_[3] << 16); *(LAS u32x2*)(xt_ + i_ * PITCH) = o_; } } \
        { LAS unsigned char* bt_ = set_ + BT_OFF + (8 * n8) * PITCH + 8 * sg; \
          _Pragma("unroll") for (int i_ = 0; i_ < 8; ++i_) { unsigned e_[4]; \
              _Pragma("unroll") for (int j_ = 0; j_ < 4; ++j_) { const unsigned w_ = X##_bv[j_][i_ >> 1]; e_[j_] = (i_ & 1) ? (w_ >> 16) : (w_ & 0xffffu); } \
              u32x2 o_; o_.x = e_[0] | (e_[1] << 16); o_.y = e_[2] | (e_[3] << 16); *(LAS u32x2*)(bt_ + i_ * PITCH) = o_; } } \
        asm volatile("s_waitcnt lgkmcnt(0)" ::: "memory"); \
    } while (0)
    SSD_LOAD(0, Q); SSD_LOADGC(0); SSD_WRITE(0, Q); SSD_LOAD(1, P);
    for (int step2 = 0; step2 < 66; step2 += 2)
#pragma unroll
    for (int par = 0; par < 2; ++par) {
        const int step = step2 + par;
        __syncthreads();
        int r0, gid; SSD_ROWS(step, r0, gid); (void)gid;
        LAS unsigned char* set = lds + (step & 1) * SET;
        const float cend_cur = cend;
        SSD_GCROT();
        if (step + 1 < 66) SSD_LOADGC(step + 1);
        if (step + 2 < 66) { if (par == 0) SSD_LOAD(step + 2, Q); else SSD_LOAD(step + 2, P); }
        {
            const int t = 16 * wid + fr; const float ct = cw[t];
            f32x4 y[4];
#pragma unroll
            for (int q = 0; q < 4; ++q) y[q] = (f32x4){0.f, 0.f, 0.f, 0.f};
            const float et = __builtin_amdgcn_exp2f(ct * L2E);
#pragma unroll
            for (int ks = 0; ks < 4; ++ks) {
                const bool live = d == 0 ? (32 * ks <= 16 * wid + 15) : (32 * ks + 31 >= 16 * wid);
                if (live) {
                    const int s0 = 32 * ks + 8 * fq;
                    const f32x4 c0 = *(const LAS f32x4*)(cw + s0), c1 = *(const LAS f32x4*)(cw + s0 + 4), d0v = *(const LAS f32x4*)(dts + s0), d1v = *(const LAS f32x4*)(dts + s0 + 4);
                    float m[8];
#pragma unroll
                    for (int i = 0; i < 8; ++i) { const float cs = i < 4 ? c0[i & 3] : c1[i & 3], dv = i < 4 ? d0v[i & 3] : d1v[i & 3]; const int s = s0 + i;
                        const bool ok = d == 0 ? (s <= t) : (s >= t);
                        const float gval = (i & 1) ? bfhi(c_gv[ks][i >> 1]) : bflo(c_gv[ks][i >> 1]);
                        m[i] = ok ? gval * dv * __builtin_amdgcn_exp2f((ct - cs) * L2E) : 0.f; }
                    u32x4 mw; mw.x = cvt_pk_bf16(m[0], m[1]); mw.y = cvt_pk_bf16(m[2], m[3]); mw.z = cvt_pk_bf16(m[4], m[5]); mw.w = cvt_pk_bf16(m[6], m[7]);
                    const bf16x8 mb = __builtin_bit_cast(bf16x8, mw);
#pragma unroll
                    for (int q = 0; q < 4; ++q) { const bf16x8 af = *(const LAS bf16x8*)(set + XT_OFF + (16 * q + fr) * PITCH + (32 * ks + 8 * fq) * 2);
                        y[q] = __builtin_amdgcn_mfma_f32_16x16x32_bf16(af, mb, y[q], 0, 0, 0); }
                }
            }
#pragma unroll
            for (int ks = 0; ks < 4; ++ks) {
                u32x4 cwv;
#pragma unroll
                for (int i = 0; i < 4; ++i) cwv[i] = cvt_pk_bf16(bflo(c_cv[ks][i]) * et, bfhi(c_cv[ks][i]) * et);
                const bf16x8 cb = __builtin_bit_cast(bf16x8, cwv);
#pragma unroll
                for (int q = 0; q < 4; ++q) { const bf16x8 af = *(const LAS bf16x8*)(set + HB_OFF + (16 * q + fr) * PITCH + (32 * ks + 8 * fq) * 2);
                    y[q] = __builtin_amdgcn_mfma_f32_16x16x32_bf16(af, cb, y[q], 0, 0, 0); }
            }
            bf16_t* yp = Y + (size_t)(r0 + t) * 1024 + 64 * h + 4 * fq;
#pragma unroll
            for (int q = 0; q < 4; ++q) { u32x2 w; w.x = cvt_pk_bf16(y[q][0], y[q][1]); w.y = cvt_pk_bf16(y[q][2], y[q][3]); *(u32x2*)(yp + 16 * q) = w; }
        }
        {
            const float dec = __builtin_amdgcn_exp2f(cend_cur * L2E);
#pragma unroll
            for (int q = 0; q < 4; ++q) hs[q] = hs[q] * dec;
#pragma unroll
            for (int ks = 0; ks < 4; ++ks) {
                const int s0 = 32 * ks + 8 * fq;
                const u32x4 braw = *(const LAS u32x4*)(set + BT_OFF + (16 * wid + fr) * PITCH + s0 * 2);
                const f32x4 w0 = *(const LAS f32x4*)(dtw + s0), w1 = *(const LAS f32x4*)(dtw + s0 + 4);
                u32x4 bw; bw.x = cvt_pk_bf16(bflo(braw.x) * w0[0], bfhi(braw.x) * w0[1]); bw.y = cvt_pk_bf16(bflo(braw.y) * w0[2], bfhi(braw.y) * w0[3]);
                          bw.z = cvt_pk_bf16(bflo(braw.z) * w1[0], bfhi(braw.z) * w1[1]); bw.w = cvt_pk_bf16(bflo(braw.w) * w1[2], bfhi(braw.w) * w1[3]);
                const bf16x8 bfr = __builtin_bit_cast(bf16x8, bw);
#pragma unroll
                for (int q = 0; q < 4; ++q) { const bf16x8 af = *(const LAS bf16x8*)(set + XT_OFF + (16 * q + fr) * PITCH + s0 * 2);
                    hs[q] = __builtin_amdgcn_mfma_f32_16x16x32_bf16(af, bfr, hs[q], 0, 0, 0); }
            }
            LAS bf16_t* hb = (LAS bf16_t*)(lds + ((step + 1) & 1) * SET + HB_OFF) + 16 * wid + fr;
#pragma unroll
            for (int q = 0; q < 4; ++q)
#pragma unroll
                for (int i = 0; i < 4; ++i) hb[(16 * q + 4 * fq + i) * 136] = f2bf(hs[q][i]);
        }
        if (step + 1 < 66) { if (par == 0) SSD_WRITE(step + 1, P); else SSD_WRITE(step + 1, Q); }
    }
    __syncthreads();
#undef SSD_ROWS
#undef SSD_LOAD
#undef SSD_LOADGC
#undef SSD_GCROT
#undef SSD_WRITE
}
}

struct Args { const float* in[32]; float* out; unsigned char* ws; int ph_lo, ph_hi; };
constexpr int NTHR = 512;
constexpr int LDS_BASE = 256;
constexpr int LDS_PHASE = 151808;
constexpr int LDS_BYTES = LDS_BASE + LDS_PHASE;
static_assert(att8::LDS_BYTES <= LDS_PHASE && ssd::LDS_BYTES <= LDS_PHASE && pg8::STAGE_BYTES <= LDS_PHASE, "LDS");

__device__ __forceinline__ void tjob(int j, const Args& A, const float*& src, bf16_t*& dst, int& K, int& N, int& Npad, int& mode, const float*& ks) {
    unsigned char* W = A.ws + WS_W; mode = 0; ks = nullptr;
    if (j < 8) { const int i = j >> 2, w = j & 3; unsigned char* base = W + W_HYB + (size_t)i * WH_SZ;
        if (w == 0)      { src = A.in[I_HWIN] + (size_t)i * 1024 * HYB_IN; dst = (bf16_t*)(base + WH_IN); K = 1024; N = HYB_IN; Npad = HYB_INP; mode = 1; }
        else if (w == 1) { src = A.in[I_WQB] + (size_t)i * 384 * 1536; dst = (bf16_t*)(base + WH_QB); K = 384; N = 1536; Npad = 1536; mode = 2; ks = A.in[I_QNG] + i * 384; }
        else if (w == 2) { src = A.in[I_WKVB] + (size_t)i * 256 * 2048; dst = (bf16_t*)(base + WH_KVB); K = 256; N = 2048; Npad = 2048; ks = A.in[I_KVNG] + i * 256; }
        else             { src = A.in[I_HWOUT] + (size_t)i * 2048 * 1024; dst = (bf16_t*)(base + WH_OUT); K = 2048; N = 1024; Npad = 1024; }
    } else if (j < 12) { const int i = (j - 8) >> 1, w = (j - 8) & 1; unsigned char* base = W + W_GM + (size_t)i * WG_SZ;
        if (w == 0) { src = A.in[I_GWIN] + (size_t)i * 1024 * 4096; dst = (bf16_t*)(base + WG_IN); K = 1024; N = 4096; Npad = 4096; }
        else        { src = A.in[I_GWOUT] + (size_t)i * 2048 * 1024; dst = (bf16_t*)(base + WG_OUT); K = 2048; N = 1024; Npad = 1024; }
    } else { const int l = j - 12; src = A.in[I_PWQ] + (size_t)l * 1024 * 2048; dst = (bf16_t*)(W + W_PEER + (size_t)l * WP_SZ + WP_Q); K = 1024; N = 2048; Npad = 2048; }
}
__device__ __forceinline__ int colmap(int mode, int n, int N) {
    if (mode == 1) { if (n >= N) return -1; if (n < C_KR) return n; const int m = n - C_KR; return C_KR + (m >> 1) + 32 * (m & 1); }
    if (mode == 2) { if (n < 1024) return (n >> 7) * 192 + (n & 127); const int m = n - 1024, h = m >> 6, mm = m & 63; return h * 192 + 128 + (mm >> 1) + 32 * (mm & 1); }
    return n;
}
__device__ __forceinline__ void phase_prologue(const Args& A, LAS unsigned char* lds) {
    const int tid = otid();
    {
        LAS float* tile = (LAS float*)lds;
        int item = blockIdx.x;
        for (int j = 0; j < 16; ++j) {
            const float* src; bf16_t* dst; int K, N, Npad, mode; const float* ks; tjob(j, A, src, dst, K, N, Npad, mode, ks);
            const int nsub = (K % 256 == 0) ? 4 : 2, tk = K / (64 * nsub), tn = Npad / 64, nt = tk * tn;
            for (; item < nt; item += gridDim.x) {
                const int k0 = (item % tk) * 64 * nsub, n0 = (item / tk) * 64;
                { const int k = tid >> 3, cg = tid & 7; float v[4][8];
#pragma unroll
                  for (int t = 0; t < 4; ++t) if (t < nsub) { const float sc = ks ? ks[k0 + 64 * t + k] : 1.f;
#pragma unroll
                      for (int jj = 0; jj < 8; ++jj) { const int oc = colmap(mode, n0 + 8 * cg + jj, N); v[t][jj] = oc >= 0 ? src[(size_t)(k0 + 64 * t + k) * N + oc] * sc : 0.f; } }
#pragma unroll
                  for (int t = 0; t < 4; ++t) if (t < nsub) {
#pragma unroll
                      for (int jj = 0; jj < 8; ++jj) tile[t * 4160 + k * 65 + 8 * cg + jj] = v[t][jj]; } }
                __syncthreads();
                { const int n = tid >> 3, kg = tid & 7;
#pragma unroll
                  for (int t = 0; t < 4; ++t) if (t < nsub) { float v[8];
#pragma unroll
                      for (int jj = 0; jj < 8; ++jj) v[jj] = tile[t * 4160 + (8 * kg + jj) * 65 + n];
                      u32x4 w; w.x = cvt_pk_bf16(v[0], v[1]); w.y = cvt_pk_bf16(v[2], v[3]); w.z = cvt_pk_bf16(v[4], v[5]); w.w = cvt_pk_bf16(v[6], v[7]);
                      *(u32x4*)(dst + (size_t)(n0 + n) * K + k0 + 64 * t + 8 * kg) = w; } }
                __syncthreads();
            }
            item -= nt;
        }
    }
    {
        const int gthr = blockIdx.x * NTHR + tid, nthr = gridDim.x * NTHR;
        for (int p = gthr; p < 10 * 16384; p += nthr) {
            const int mat = p >> 14, off = (p & 16383) * 8; const float* src; bf16_t* dst;
            if (mat < 2)      { src = A.in[I_GWS] + (size_t)mat * 131072; dst = (bf16_t*)(A.ws + WS_W + W_GM + (size_t)mat * WG_SZ + WG_WS); }
            else if (mat < 6) { src = A.in[I_PK1] + (size_t)(mat - 2) * 131072; dst = (bf16_t*)(A.ws + WS_W + W_PEER + (size_t)(mat - 2) * WP_SZ + WP_K1); }
            else              { src = A.in[I_PK2] + (size_t)(mat - 6) * 131072; dst = (bf16_t*)(A.ws + WS_W + W_PEER + (size_t)(mat - 6) * WP_SZ + WP_K2); }
            const f32x4 a = *(const f32x4*)(src + off), b = *(const f32x4*)(src + off + 4);
            u32x4 w; w.x = cvt_pk_bf16(a[0], a[1]); w.y = cvt_pk_bf16(a[2], a[3]); w.z = cvt_pk_bf16(b[0], b[1]); w.w = cvt_pk_bf16(b[2], b[3]);
            *(u32x4*)(dst + off) = w;
        }
        float* rope = (float*)(A.ws + WS_ROPE);
        for (int p = gthr; p < SEQ * 32; p += nthr) { const int l = p >> 5, i = p & 31; const float pos = (float)(i < 16 ? (l >> 6) : (l & 63));
            const float inv = powf(10000.f, -(float)(i & 15) / 16.f), ang = pos * inv; rope[p] = cosf(ang); rope[SEQ * 32 + p] = sinf(ang); }
    }
    {
        LAS float* scond = (LAS float*)lds;
        LAS float* red = scond + 5 * 1024;
        __syncthreads();
        for (int i = tid; i < 5 * 1024; i += NTHR) { const int m = i >> 10, k = i & 1023; const float c = m < 4 ? A.in[I_C][m * 1024 + k] : A.in[I_CCTX][k]; scond[i] = silu_f(c); }
        __syncthreads();
        float* MOD = (float*)(A.ws + WS_MOD);
        for (int item = blockIdx.x; item < 4 * 48; item += gridDim.x) {
            const int layer = item / 48, j0 = (item % 48) * 128; const int c4 = tid & 31, ksl = tid >> 5;
            f32x4 acc[5];
#pragma unroll
            for (int m = 0; m < 5; ++m) acc[m] = (f32x4){0.f, 0.f, 0.f, 0.f};
            const float* wp = A.in[I_ADAW] + ((size_t)layer * 1024 + ksl * 64) * 6144 + j0 + 4 * c4;
            for (int k = 0; k < 64; ++k) { const f32x4 w = *(const f32x4*)(wp + (size_t)k * 6144);
#pragma unroll
                for (int m = 0; m < 5; ++m) acc[m] += w * scond[m * 1024 + ksl * 64 + k]; }
#pragma unroll
            for (int m = 0; m < 5; ++m) *(LAS f32x4*)(red + (ksl * 5 + m) * 128 + 4 * c4) = acc[m];
            __syncthreads();
            for (int i = tid; i < 640; i += NTHR) { const int m = i >> 7, c = i & 127; float s = A.in[I_ADAB][layer * 6144 + j0 + c];
#pragma unroll
                for (int q = 0; q < 16; ++q) s += red[(q * 5 + m) * 128 + c];
                MOD[((size_t)layer * 5 + m) * 6144 + j0 + c] = s; }
            __syncthreads();
        }
    }
}

__device__ __forceinline__ void phase_norm_mod(const float* xl, const float* xc, float* cl, float* cc, const float* g, const float* modl, int sh_idx, bf16_t* H, int nrows) {
    const int tid_ = otid(); const int lane = tid_ & 63, gw = blockIdx.x * 8 + (tid_ >> 6), nw = gridDim.x * 8;
    f32x4 gv[4];
#pragma unroll
    for (int i = 0; i < 4; ++i) gv[i] = *(const f32x4*)(g + 256 * i + 4 * lane);
    for (int r = gw; r < nrows; r += nw) {
        const bool lat = r < NLAT; const float* xp = lat ? xl + (size_t)r * D : xc + (size_t)(r - NLAT) * D;
        f32x4 x[4]; float ss = 0.f;
#pragma unroll
        for (int i = 0; i < 4; ++i) { x[i] = *(const f32x4*)(xp + 256 * i + 4 * lane); ss += x[i][0] * x[i][0] + x[i][1] * x[i][1] + x[i][2] * x[i][2] + x[i][3] * x[i][3]; }
        if (cl) { float* cp = lat ? cl + (size_t)r * D : cc + (size_t)(r - NLAT) * D;
#pragma unroll
            for (int i = 0; i < 4; ++i) *(f32x4*)(cp + 256 * i + 4 * lane) = x[i]; }
        ss = wave_sum(ss); const float rstd = rsqrtf(ss * (1.f / 1024.f) + EPS);
        const float* mp = modl + (size_t)(lat ? (r >> 13) : 4) * 6144 + sh_idx * 1024;
#pragma unroll
        for (int i = 0; i < 4; ++i) { const f32x4 sh = *(const f32x4*)(mp + 256 * i + 4 * lane), sc = *(const f32x4*)(mp + 1024 + 256 * i + 4 * lane);
            const f32x4 hv = (x[i] * rstd) * gv[i] * (sc + 1.f) + sh;
            u32x2 w; w.x = cvt_pk_bf16(hv[0], hv[1]); w.y = cvt_pk_bf16(hv[2], hv[3]);
            *(u32x2*)(H + (size_t)r * D + 256 * i + 4 * lane) = w; }
    }
}
__device__ __forceinline__ void phase_final_norm(float* xl, const float* g, float oscale) {
    const int tid_ = otid(); const int lane = tid_ & 63, gw = blockIdx.x * 8 + (tid_ >> 6), nw = gridDim.x * 8;
    f32x4 gv[4];
#pragma unroll
    for (int i = 0; i < 4; ++i) gv[i] = *(const f32x4*)(g + 256 * i + 4 * lane);
    for (int r = gw; r < NLAT; r += nw) {
        float* xp = xl + (size_t)r * D; f32x4 x[4]; float ss = 0.f;
#pragma unroll
        for (int i = 0; i < 4; ++i) { x[i] = *(const f32x4*)(xp + 256 * i + 4 * lane); ss += x[i][0] * x[i][0] + x[i][1] * x[i][1] + x[i][2] * x[i][2] + x[i][3] * x[i][3]; }
        ss = wave_sum(ss); const float rstd = rsqrtf(ss * (1.f / 1024.f) + EPS);
#pragma unroll
        for (int i = 0; i < 4; ++i) *(f32x4*)(xp + 256 * i + 4 * lane) = (x[i] * (rstd * oscale)) * gv[i];
    }
}

__device__ __forceinline__ void phase_conv(const Args& A, int li) {
    const bf16_t* PROJ = (const bf16_t*)(A.ws + WS_BIG);
    bf16_t* XS = (bf16_t*)(A.ws + WS_R2); bf16_t* BC = (bf16_t*)(A.ws + WS_R2 + R2_BC);
    const int tid = otid();
    {
        for (int item = blockIdx.x * 3; item < (NROW / 64) * 3; item += gridDim.x * 3)
#pragma unroll 1
        for (int sub = 0; sub < 3; ++sub) {
            const int blk = (item + sub) / 3, q = ((item + sub) % 3) * 512 + tid, cg = q % 192, rg = q / 192, c0 = 8 * cg;
            const int rbeg = blk * 64 + rg * 8; int s0, s1;
            if (rbeg < NLAT) { s0 = rbeg & ~8191; s1 = s0 + 8192; } else { s0 = NLAT + ((rbeg - NLAT) & ~255); s1 = s0 + 256; }
            const float* cw = A.in[I_CONVW] + ((size_t)li * 1536 + c0) * 5; const float* cb = A.in[I_CONVB] + (size_t)li * 1536 + c0;
            u32x4 in[12];
#pragma unroll
            for (int i = 0; i < 12; ++i) { const int r = rbeg - 2 + i; in[i] = (r >= s0 && r < s1) ? *(const u32x4*)(PROJ + (size_t)r * HYB_INP + C_XBC + c0) : (u32x4){0u, 0u, 0u, 0u}; }
            float w[8][5], bia[8];
#pragma unroll
            for (int j = 0; j < 8; ++j) { bia[j] = cb[j];
#pragma unroll
                for (int k = 0; k < 5; ++k) w[j][k] = cw[j * 5 + k]; }
#pragma unroll
            for (int rr = 0; rr < 8; ++rr) {
                float o[8];
#pragma unroll
                for (int j = 0; j < 8; ++j) { float sacc = bia[j];
#pragma unroll
                    for (int k = 0; k < 5; ++k) { const unsigned wd = in[rr + k][j >> 1]; sacc += w[j][k] * ((j & 1) ? bfhi(wd) : bflo(wd)); }
                    o[j] = silu_f(sacc); }
                u32x4 pk; pk.x = cvt_pk_bf16(o[0], o[1]); pk.y = cvt_pk_bf16(o[2], o[3]); pk.z = cvt_pk_bf16(o[4], o[5]); pk.w = cvt_pk_bf16(o[6], o[7]);
                const int r = rbeg + rr;
                if (c0 < 1024) *(u32x4*)(XS + (size_t)r * 1024 + c0) = pk; else *(u32x4*)(BC + (size_t)r * 512 + (c0 - 1024)) = pk;
            }
        }
    }
    {
        const int lane = tid & 63, gw = blockIdx.x * 8 + (tid >> 6), nw = gridDim.x * 8;
        float* DT = (float*)(A.ws + WS_BIG + BIG_DT); float* RQ = (float*)(A.ws + WS_RSTD); float* RKV = RQ + NROW;
        unsigned char* KR = A.ws + WS_BIG + BIG_KR; const float* rope = (const float*)(A.ws + WS_ROPE);
        const float dtb = lane < 32 ? A.in[I_DTB][li * 32 + lane] : 0.f;
        for (int rb = gw * 4; rb < NROW; rb += nw * 4) {
            unsigned wq[4][3]; u32x2 wk[4]; unsigned wr_[4]; float dtv[4], rc[4], rsn[4];
#pragma unroll
            for (int i = 0; i < 4; ++i) { const int r = rb + i; const bf16_t* p = PROJ + (size_t)r * HYB_INP;
                const unsigned* q = (const unsigned*)(p + C_CQ + 6 * lane); wq[i][0] = q[0]; wq[i][1] = q[1]; wq[i][2] = q[2];
                wk[i] = *(const u32x2*)(p + C_CKV + 4 * lane);
                dtv[i] = lane < 32 ? bf2f(p[C_DT + (lane & 15)]) : 0.f; wr_[i] = lane < 32 ? *(const unsigned*)(p + C_KR + 2 * lane) : 0u;
                const int l = r & 8191; rc[i] = (lane < 32 && r < NLAT) ? rope[l * 32 + lane] : 1.f; rsn[i] = (lane < 32 && r < NLAT) ? rope[SEQ * 32 + l * 32 + lane] : 0.f; }
#pragma unroll
            for (int i = 0; i < 4; ++i) { const int r = rb + i;
                if (lane < 32) DT[(size_t)lane * NROW + r] = softplus_f(dtv[i] + dtb);
                { float ss = 0.f;
#pragma unroll
                  for (int j = 0; j < 3; ++j) { const float a = bflo(wq[i][j]), b = bfhi(wq[i][j]); ss += a * a + b * b; }
                  ss = wave_sum(ss); if (lane == 0) RQ[r] = rsqrtf(ss * (1.f / 384.f) + EPS); }
                { const float a = bflo(wk[i].x), b = bfhi(wk[i].x), c = bflo(wk[i].y), d = bfhi(wk[i].y);
                  float ss = a * a + b * b + c * c + d * d; ss = wave_sum(ss); if (lane == 0) RKV[r] = rsqrtf(ss * (1.f / 256.f) + EPS); }
                if (lane < 32) { const float x1 = bflo(wr_[i]), x2 = bfhi(wr_[i]); int b, key;
                    const float o1 = x1 * rc[i] - x2 * rsn[i], o2 = x1 * rsn[i] + x2 * rc[i];
                    if (r < NLAT) { b = r >> 13; key = 256 + (r & 8191); } else { b = (r - NLAT) >> 8; key = (r - NLAT) & 255; }
                    int w8 = 0; w8 = __builtin_amdgcn_cvt_pk_fp8_f32(sat8(o1), sat8(o2), w8, false);
                    *(unsigned short*)(KR + (size_t)(b * NKT + (key >> 6)) * 4096 + att8::kr8(key & 63, 2 * lane)) = (unsigned short)(w8 & 0xffff); }
            }
        }
    }
}

struct EpiQ {
    static constexpr bool PERM = true;
    unsigned char* Q; const float* rstd; const float* rope;
    __device__ __forceinline__ void operator()(const f32x4 (&acc)[2][2][4][2], const pg8::Unit& u, int wr, int wc, int fr, int fq) const {
        const bool lat = u.pm < 128;
        const int b = lat ? (u.pm >> 5) : (u.pm - 128), q0 = lat ? 256 + ((u.pm & 31) << 8) : 0;
        const bool isrope = u.pn >= 4;
#pragma unroll
        for (int ai = 0; ai < 2; ++ai) {
            const int rl = 128 * ai + 64 * wr + fr;
            const float* rsp = rstd + u.pm * 256 + rl;
            const float* rp = rope + (size_t)(((u.pm & 31) << 8) + rl) * 32;
#pragma unroll
            for (int bj = 0; bj < 2; ++bj) {
                const int c0 = u.pn * 256 + 128 * bj + 32 * wc + 8 * fq; int h, dcol;
                if (!isrope) { h = c0 >> 7; dcol = c0 & 127; } else { const int mq = c0 - 1024; h = mq >> 6; dcol = 128 + (mq & 63); }
                unsigned char* dst = Q + ((size_t)(b * 8 + h) * NKEY + q0 + rl) * 192 + dcol;
                const int ro = (dcol - 128) >> 1;
#pragma unroll
                for (int m = 0; m < 4; ++m) {
                    const float rs = rsp[16 * m] * (QSCALE * att8::QUP);
                    f32x4 v0 = acc[ai][bj][m][0] * rs, v1 = acc[ai][bj][m][1] * rs;
                    if (isrope && lat) { const f32x4 cs = *(const f32x4*)(rp + 16 * m * 32 + ro), sn = *(const f32x4*)(rp + SEQ * 32 + 16 * m * 32 + ro);
                        const f32x4 a0 = v0, a1 = v1;
                        v0[0] = a0[0] * cs[0] - a0[1] * sn[0]; v0[1] = a0[0] * sn[0] + a0[1] * cs[0]; v0[2] = a0[2] * cs[1] - a0[3] * sn[1]; v0[3] = a0[2] * sn[1] + a0[3] * cs[1];
                        v1[0] = a1[0] * cs[2] - a1[1] * sn[2]; v1[1] = a1[0] * sn[2] + a1[1] * cs[2]; v1[2] = a1[2] * cs[3] - a1[3] * sn[3]; v1[3] = a1[2] * sn[3] + a1[3] * cs[3]; }
                    u32x2 w; w.x = pk4_fp8_sat(v0[0], v0[1], v0[2], v0[3]); w.y = pk4_fp8_sat(v1[0], v1[1], v1[2], v1[3]);
                    *(u32x2*)(dst + 16 * m * 192) = w;
                    asm volatile("" ::: "memory");
                }
            }
        }
    }
};
struct EpiKV {
    static constexpr bool PERM = true;
    unsigned char* KN; unsigned char* V; const float* rstd;
    __device__ __forceinline__ void operator()(const f32x4 (&acc)[2][2][4][2], const pg8::Unit& u, int wr, int wc, int fr, int fq) const {
        const bool lat = u.pm < 128;
        const int b = lat ? (u.pm >> 5) : (u.pm - 128), t0 = lat ? 4 + ((u.pm & 31) << 2) : 0;
        const int dd = 32 * wc + 8 * fq;
        const int offK = fr * 128 + ((((dd >> 4) ^ ((fr >> 1) & 7))) << 4) + (dd & 15);
#pragma unroll
        for (int ai = 0; ai < 2; ++ai) {
            const size_t tb = ((size_t)(b * 8 + u.pn) * NKT + t0 + 2 * ai + wr) * 8192;
            const float* rsp = rstd + u.pm * 256 + 128 * ai + 64 * wr + fr;
            unsigned char* kp = KN + tb + offK; unsigned char* vp = V + tb;
#pragma unroll
            for (int m = 0; m < 4; ++m) {
                const float rs = rsp[16 * m];
                { const f32x4 v0 = acc[ai][0][m][0] * rs, v1 = acc[ai][0][m][1] * rs; u32x2 w; w.x = pk4_fp8_sat(v0[0], v0[1], v0[2], v0[3]); w.y = pk4_fp8_sat(v1[0], v1[1], v1[2], v1[3]);
                  *(u32x2*)(kp + m * 2048) = w; }
                { const f32x4 v0 = acc[ai][1][m][0] * rs, v1 = acc[ai][1][m][1] * rs; const unsigned w0 = pk4_fp8_sat(v0[0], v0[1], v0[2], v0[3]), w1 = pk4_fp8_sat(v1[0], v1[1], v1[2], v1[3]);
                  const int sl = att8::vslot(16 * m + fr);
#pragma unroll
                  for (int i = 0; i < 8; ++i) { const int d = dd + i; vp[d * 64 + ((((sl >> 4) ^ ((d >> 2) & 3))) << 4) + (sl & 15)] = (unsigned char)(((i < 4 ? w0 : w1) >> (8 * (i & 3))) & 0xffu); } }
                asm volatile("" ::: "memory");
            }
        }
    }
};

__device__ __forceinline__ void phase_ssd_out(const Args& A, int li, int nrows) {
    const bf16_t* PROJ = (const bf16_t*)(A.ws + WS_BIG); const bf16_t* XS = (const bf16_t*)(A.ws + WS_R2);
    const bf16_t* Y0 = (const bf16_t*)(A.ws + WS_H); const bf16_t* Y1 = (const bf16_t*)(A.ws + WS_R3); bf16_t* CAT = (bf16_t*)(A.ws + WS_R3 + R3_CAT);
    const int tid_ = otid(); const int lane = tid_ & 63, gw = blockIdx.x * 8 + (tid_ >> 6), nw = gridDim.x * 8;
    const float dsk = A.in[I_SSDD][li * 16 + (lane >> 2)];
    float ng[16];
#pragma unroll
    for (int j = 0; j < 16; ++j) ng[j] = A.in[I_SSDNG][li * 1024 + 16 * lane + j];
    for (int r = gw; r < nrows; r += nw) {
        float v[16]; float ss = 0.f;
#pragma unroll
        for (int hh = 0; hh < 2; ++hh) {
            const u32x4 a = *(const u32x4*)(Y0 + (size_t)r * 1024 + 16 * lane + 8 * hh), b = *(const u32x4*)(Y1 + (size_t)r * 1024 + 16 * lane + 8 * hh);
            const u32x4 x = *(const u32x4*)(XS + (size_t)r * 1024 + 16 * lane + 8 * hh), z = *(const u32x4*)(PROJ + (size_t)r * HYB_INP + 16 * lane + 8 * hh);
#pragma unroll
            for (int q = 0; q < 4; ++q) {
                const float y0 = (bflo(a[q]) + bflo(b[q]) + dsk * bflo(x[q])) * silu_f(bflo(z[q])), y1 = (bfhi(a[q]) + bfhi(b[q]) + dsk * bfhi(x[q])) * silu_f(bfhi(z[q]));
                v[8 * hh + 2 * q] = y0; v[8 * hh + 2 * q + 1] = y1; ss += y0 * y0 + y1 * y1; }
        }
#pragma unroll
        for (int o = 16; o >= 1; o >>= 1) ss += __shfl_xor(ss, o);
        const float rstd = rsqrtf(ss * (1.f / 512.f) + EPS);
#pragma unroll
        for (int hh = 0; hh < 2; ++hh) { u32x4 w;
#pragma unroll
            for (int q = 0; q < 4; ++q) w[q] = cvt_pk_bf16(v[8 * hh + 2 * q] * rstd * ng[8 * hh + 2 * q], v[8 * hh + 2 * q + 1] * rstd * ng[8 * hh + 2 * q + 1]);
            *(u32x4*)(CAT + (size_t)r * 2048 + 16 * lane + 8 * hh) = w; }
    }
}

__device__ __forceinline__ void phase_ln_stats(const Args& A, int nrows) {
    const bf16_t* Gb = (const bf16_t*)(A.ws + WS_BIG); float* ST = (float*)(A.ws + WS_RSTD);
    const int tid_ = otid(); const int lane = tid_ & 63, gw = blockIdx.x * 8 + (tid_ >> 6), nw = gridDim.x * 8;
    for (int r = gw; r < nrows; r += nw) {
        float v[32]; float s = 0.f;
#pragma unroll
        for (int j = 0; j < 4; ++j) { const u32x4 w = *(const u32x4*)(Gb + (size_t)r * 4096 + 2048 + 512 * j + 8 * lane);
#pragma unroll
            for (int q = 0; q < 4; ++q) { v[8 * j + 2 * q] = bflo(w[q]); v[8 * j + 2 * q + 1] = bfhi(w[q]); s += v[8 * j + 2 * q] + v[8 * j + 2 * q + 1]; } }
        s = wave_sum(s); const float mu = s * (1.f / 2048.f); float q2 = 0.f;
#pragma unroll
        for (int j = 0; j < 32; ++j) { const float dd = v[j] - mu; q2 += dd * dd; }
        q2 = wave_sum(q2);
        if (lane == 0) { ST[r] = mu; ST[NROW + r] = rsqrtf(q2 * (1.f / 2048.f) + EPS); }
    }
}
__device__ __forceinline__ float half_sum32(float v) {
    v += __builtin_bit_cast(float, __builtin_amdgcn_mov_dpp(__builtin_bit_cast(int, v), 0xB1, 0xF, 0xF, true));
    v += __builtin_bit_cast(float, __builtin_amdgcn_mov_dpp(__builtin_bit_cast(int, v), 0x4E, 0xF, 0xF, true));
    v += __builtin_bit_cast(float, __builtin_amdgcn_mov_dpp(__builtin_bit_cast(int, v), 0x141, 0xF, 0xF, true));
    v += __builtin_bit_cast(float, __builtin_amdgcn_mov_dpp(__builtin_bit_cast(int, v), 0x140, 0xF, 0xF, true));
    auto r = __builtin_amdgcn_permlane16_swap(__float_as_uint(v), __float_as_uint(v), false, false);
    return __uint_as_float(r[0]) + __uint_as_float(r[1]);
}
__device__ __forceinline__ void phase_spatial(const Args& A, int gi, int nrows, LAS unsigned char* lds) {
    const bf16_t* Gb = (const bf16_t*)(A.ws + WS_BIG); const f32x2* PARTS = (const f32x2*)(A.ws + WS_R3); bf16_t* Ab = (bf16_t*)(A.ws + WS_R1);
    const bf16_t* WSg = (const bf16_t*)(A.ws + WS_W + W_GM + (size_t)gi * WG_SZ + WG_WS);
    const float* lng = A.in[I_GLNG] + (size_t)gi * 2048; const float* lnb = A.in[I_GLNB] + (size_t)gi * 2048; const float* bs = A.in[I_GBS] + (size_t)gi * 1024;
    const int tid = otid(), wid = tid >> 6, lane = tid & 63, r32 = lane & 31, hi = lane >> 5, tb = wid & 3, dh = wid >> 2;
    const int ldsaddr = (int)(unsigned)(uintptr_t)lds;
    u32x4 nv[8]; f32x2 nps[8];
    const int nunits = (nrows / 128) * 8;
#define SP_LOADV(un) do { const int cb_ = (un) >> 3, gg_ = (un) & 7, r0_ = cb_ * 128; \
        _Pragma("unroll") for (int j = 0; j < 8; ++j) { const int idx = tid + 512 * j, s_ = idx >> 5, dd_ = (idx & 31) * 8; \
            nv[j] = *(const u32x4*)(Gb + (size_t)(r0_ + s_) * 4096 + 2048 + 256 * gg_ + dd_); nps[j] = PARTS[(size_t)(r0_ + s_) * 32 + (idx & 31)]; } } while (0)
    if ((int)blockIdx.x < nunits) SP_LOADV((int)blockIdx.x);
    for (int unit = blockIdx.x; unit < nunits; unit += gridDim.x) {
        const int cb = unit >> 3, gg = unit & 7, r0 = cb * 128;
        __syncthreads();
#pragma unroll
        for (int j = 0; j < 8; ++j) { const int idx = tid + 512 * j, s = idx >> 5, dd = (idx & 31) * 8;
            const u32x4 w = nv[j];
            const float mu = half_sum32(nps[j].x) * (1.f / 2048.f), rs = rsqrtf(fmaxf(half_sum32(nps[j].y) * (1.f / 2048.f) - mu * mu, 0.f) + EPS);
            const f32x4 g0 = *(const f32x4*)(lng + 256 * gg + dd), g1 = *(const f32x4*)(lng + 256 * gg + dd + 4), b0 = *(const f32x4*)(lnb + 256 * gg + dd), b1 = *(const f32x4*)(lnb + 256 * gg + dd + 4);
            u32x4 o;
            o.x = cvt_pk_bf16((bflo(w.x) - mu) * rs * g0[0] + b0[0], (bfhi(w.x) - mu) * rs * g0[1] + b0[1]); o.y = cvt_pk_bf16((bflo(w.y) - mu) * rs * g0[2] + b0[2], (bfhi(w.y) - mu) * rs * g0[3] + b0[3]);
            o.z = cvt_pk_bf16((bflo(w.z) - mu) * rs * g1[0] + b1[0], (bfhi(w.z) - mu) * rs * g1[1] + b1[1]); o.w = cvt_pk_bf16((bflo(w.w) - mu) * rs * g1[2] + b1[2], (bfhi(w.w) - mu) * rs * g1[3] + b1[3]);
            *(LAS u32x4*)(lds + ((s >> 6) * 2 + (dd >> 7)) * 16384 + att::v_st(s & 63, dd & 127)) = o; }
        u32x2 uu[4][4];
        { const bf16_t* up = Gb + (size_t)(r0 + 32 * tb + r32) * 4096 + 256 * gg + 128 * dh + 4 * hi;
#pragma unroll
          for (int d0 = 0; d0 < 4; ++d0)
#pragma unroll
              for (int k = 0; k < 4; ++k) uu[d0][k] = *(const u32x2*)(up + 32 * d0 + 8 * k); }
        if (unit + (int)gridDim.x < nunits) SP_LOADV(unit + (int)gridDim.x);
        bf16x8 pa[8];
#pragma unroll
        for (int ks = 0; ks < 8; ++ks) pa[ks] = *(const bf16x8*)(WSg + ((size_t)gg * 128 + 32 * tb + r32) * 128 + 16 * ks + 8 * hi);
        __syncthreads();
        f32x16 o[4] = {};
#define SP_PV(D0, vbase, p0, p1, p2, p3) do { \
            const s16x4 l0 = att::tr_read<att::v_rd_off(D0, 0, 0)>(vbase), h0 = att::tr_read<att::v_rd_off(D0, 0, 1)>(vbase), l1 = att::tr_read<att::v_rd_off(D0, 1, 0)>(vbase), h1 = att::tr_read<att::v_rd_off(D0, 1, 1)>(vbase); \
            const s16x4 l2 = att::tr_read<att::v_rd_off(D0, 2, 0)>(vbase), h2 = att::tr_read<att::v_rd_off(D0, 2, 1)>(vbase), l3 = att::tr_read<att::v_rd_off(D0, 3, 0)>(vbase), h3 = att::tr_read<att::v_rd_off(D0, 3, 1)>(vbase); \
            asm volatile("s_waitcnt lgkmcnt(0)" ::: "memory"); __builtin_amdgcn_sched_barrier(0); \
            o[D0] = __builtin_amdgcn_mfma_f32_32x32x16_bf16((bf16x8){l0[0], l0[1], l0[2], l0[3], h0[0], h0[1], h0[2], h0[3]}, p0, o[D0], 0, 0, 0); \
            o[D0] = __builtin_amdgcn_mfma_f32_32x32x16_bf16((bf16x8){l1[0], l1[1], l1[2], l1[3], h1[0], h1[1], h1[2], h1[3]}, p1, o[D0], 0, 0, 0); \
            o[D0] = __builtin_amdgcn_mfma_f32_32x32x16_bf16((bf16x8){l2[0], l2[1], l2[2], l2[3], h2[0], h2[1], h2[2], h2[3]}, p2, o[D0], 0, 0, 0); \
            o[D0] = __builtin_amdgcn_mfma_f32_32x32x16_bf16((bf16x8){l3[0], l3[1], l3[2], l3[3], h3[0], h3[1], h3[2], h3[3]}, p3, o[D0], 0, 0, 0); } while (0)
        { const int vb0 = ldsaddr + (0 * 2 + dh) * 16384 + att::v_rd_base(lane), vb1 = ldsaddr + (1 * 2 + dh) * 16384 + att::v_rd_base(lane);
          SP_PV(0, vb0, pa[0], pa[1], pa[2], pa[3]); SP_PV(1, vb0, pa[0], pa[1], pa[2], pa[3]); SP_PV(2, vb0, pa[0], pa[1], pa[2], pa[3]); SP_PV(3, vb0, pa[0], pa[1], pa[2], pa[3]);
          SP_PV(0, vb1, pa[4], pa[5], pa[6], pa[7]); SP_PV(1, vb1, pa[4], pa[5], pa[6], pa[7]); SP_PV(2, vb1, pa[4], pa[5], pa[6], pa[7]); SP_PV(3, vb1, pa[4], pa[5], pa[6], pa[7]); }
#undef SP_PV
        { const int t = 32 * tb + r32, row = r0 + t; const float bsv = bs[gg * 128 + t];
          bf16_t* ap = Ab + (size_t)row * 2048 + 256 * gg + 128 * dh + 4 * hi;
#pragma unroll
          for (int d0 = 0; d0 < 4; ++d0)
#pragma unroll
              for (int k = 0; k < 4; ++k) {
                  const u32x2 u2 = uu[d0][k];
                  u32x2 w; w.x = cvt_pk_bf16(bflo(u2.x) * (o[d0][4 * k] + bsv), bfhi(u2.x) * (o[d0][4 * k + 1] + bsv)); w.y = cvt_pk_bf16(bflo(u2.y) * (o[d0][4 * k + 2] + bsv), bfhi(u2.y) * (o[d0][4 * k + 3] + bsv));
                  *(u32x2*)(ap + 32 * d0 + 8 * k) = w; } }
    }
#undef SP_LOADV
}

constexpr int NSL = 8, SW = 1024 / NSL;
constexpr size_t TAB8_HALF = (size_t)NEXP * 1024, TAB_SCL = 2 * TAB8_HALF, TAB_SET = al256(TAB_SCL + (size_t)2 * NEXP * 4);
static_assert(2 * TAB_SET <= TAB_REGION, "table sets");
__device__ __forceinline__ size_t tabset(int layer) { return WS_TAB + (size_t)(layer & 1) * TAB_SET; }
constexpr float HS = 4.f;
__device__ __forceinline__ void phase_tabcvt(const Args& A, int layer, int wg, int nwg, int r_lo = 0, int r_hi = 2 * NEXP) {
    const int tid_ = otid(); const int lane = tid_ & 63, gw = wg * 8 + (tid_ >> 6), nw = nwg * 8;
    unsigned char* TS = A.ws + tabset(layer); float* SCL = (float*)(TS + TAB_SCL);
    for (int r = r_lo + gw; r < r_hi; r += nw) {
        const int tab = r >> 14, e = r & (NEXP - 1);
        const float* src = (tab ? A.in[I_PV] : A.in[I_PU]) + ((size_t)layer * NEXP + e) * 1024 + 16 * lane;
        f32x4 v[4]; float am = 0.f;
#pragma unroll
        for (int i = 0; i < 4; ++i) { v[i] = *(const f32x4*)(src + 4 * i); am = fmaxf(am, fmaxf(fmaxf(fabsf(v[i][0]), fabsf(v[i][1])), fmaxf(fabsf(v[i][2]), fabsf(v[i][3])))); }
#pragma unroll
        for (int o = 32; o >= 1; o >>= 1) am = fmaxf(am, __shfl_xor(am, o));
        float sc = 1.f; if (am > 0.f) { int ex; (void)frexpf(448.f / am, &ex); sc = ldexpf(1.f, ex - 1); }
        if (lane == 0) SCL[tab * NEXP + e] = 1.f / sc;
        u32x4 w;
#pragma unroll
        for (int i = 0; i < 4; ++i) w[i] = pk4_fp8(v[i][0] * sc, v[i][1] * sc, v[i][2] * sc, v[i][3] * sc);
        *(u32x4*)(TS + (size_t)tab * TAB8_HALF + ((size_t)(lane >> 3) * NEXP + e) * SW + 16 * (lane & 7)) = w;
    }
}
#define CASD(a, b) do { const float hi_ = fmaxf(a, b), lo_ = fminf(a, b); a = hi_; b = lo_; } while (0)
__device__ __forceinline__ void sort16(float (&k)[16]) {
#pragma unroll
    for (int sz = 2; sz <= 16; sz <<= 1)
#pragma unroll
        for (int j = sz >> 1; j > 0; j >>= 1)
#pragma unroll
            for (int i = 0; i < 16; ++i) { const int l = i ^ j; if (l > i) { if ((i & sz) == 0 || sz == 16) CASD(k[i], k[l]); else CASD(k[l], k[i]); } }
}
__device__ __forceinline__ void bmerge16(float (&k)[16]) {
#pragma unroll
    for (int j = 8; j > 0; j >>= 1)
#pragma unroll
        for (int i = 0; i < 16; ++i) { const int l = i ^ j; if (l > i) CASD(k[i], k[l]); }
}
__device__ __forceinline__ void merge_top16(float (&a)[16], const float (&b)[16]) {
#pragma unroll
    for (int i = 0; i < 16; ++i) a[i] = fmaxf(a[i], b[15 - i]);
    bmerge16(a);
}
__device__ __forceinline__ void xmerge_top16(float (&a)[16], int mask) {
    float t[16];
#pragma unroll
    for (int i = 0; i < 16; ++i) t[i] = __shfl_xor(a[15 - i], mask);
#pragma unroll
    for (int i = 0; i < 16; ++i) a[i] = fmaxf(a[i], t[i]);
    bmerge16(a);
}
__device__ __forceinline__ void phase_topk(const Args& A, int layer, int nrows, LAS unsigned char* lds) {
    const bf16_t* QP = (const bf16_t*)(A.ws + WS_BIG); int* IDX = (int*)(A.ws + WS_R2); float* GATE = (float*)(A.ws + WS_R2 + R2_GATE);
    const int tid = otid(), wid = tid >> 6, lane = tid & 63, fr = lane & 15, fq = lane >> 4;
    LAS unsigned* scr = (LAS unsigned*)(lds + 2 * 34816) + wid * 512 + fr * 32;
    int h_staged = -1;
    for (int unit = blockIdx.x; unit < (nrows / 128) * 8; unit += gridDim.x) {
        const int h = unit & 7, r0 = (unit >> 3) * 128;
        if (h != h_staged) { h_staged = h;
        __syncthreads();
        { const bf16_t* k1 = (const bf16_t*)(A.ws + WS_W + W_PEER + (size_t)layer * WP_SZ + WP_K1) + (size_t)h * 16384;
#pragma unroll
          for (int j = 0; j < 8; ++j) { const int idx = tid + 512 * j, half = idx >> 11, rem = idx & 2047, key = rem >> 4, c8 = rem & 15;
              const u32x4 w = *(const u32x4*)(k1 + (size_t)half * 8 * 16384 + key * 128 + 8 * c8);
              *(LAS u32x4*)(lds + half * 34816 + key * 272 + c8 * 16) = w; } }
        __syncthreads(); }
        const int tok = r0 + 16 * wid + fr;
        float top[2][16];
#pragma unroll
        for (int half = 0; half < 2; ++half) {
            bf16x8 qf[4];
#pragma unroll
            for (int ks = 0; ks < 4; ++ks) qf[ks] = *(const bf16x8*)(QP + (size_t)tok * 2048 + 256 * h + 128 * half + 32 * ks + 8 * fq);
            float loc[16];
#pragma unroll
            for (int grp = 0; grp < 2; ++grp) {
                float kk[16];
#pragma unroll
                for (int nbb = 0; nbb < 4; ++nbb) { const int nb = 4 * grp + nbb; f32x4 acc = {0.f, 0.f, 0.f, 0.f};
#pragma unroll
                    for (int ks = 0; ks < 4; ++ks) { const bf16x8 kf = *(const LAS bf16x8*)(lds + half * 34816 + (16 * nb + fr) * 272 + (32 * ks + 8 * fq) * 2);
                        acc = __builtin_amdgcn_mfma_f32_16x16x32_bf16(kf, qf[ks], acc, 0, 0, 0); }
#pragma unroll
                    for (int i = 0; i < 4; ++i) { const unsigned code = 127u - (unsigned)(16 * nb + 4 * fq + i); kk[4 * nbb + i] = __uint_as_float((__float_as_uint(acc[i]) & ~127u) | code); } }
                sort16(kk);
                if (grp == 0) {
#pragma unroll
                    for (int i = 0; i < 16; ++i) loc[i] = kk[i];
                } else merge_top16(loc, kk);
            }
            xmerge_top16(loc, 16); xmerge_top16(loc, 32);
#pragma unroll
            for (int i = 0; i < 16; ++i) top[half][i] = loc[i];
        }
        if (fq < 2) {
#pragma unroll
            for (int i = 0; i < 16; ++i) scr[16 * fq + i] = __float_as_uint(fq == 0 ? top[0][i] : top[1][i]); }
        float fin[16];
#pragma unroll
        for (int aa = 0; aa < 4; ++aa) {
            const float va_k = fq == 0 ? top[0][aa] : fq == 1 ? top[0][4 + aa] : fq == 2 ? top[0][8 + aa] : top[0][12 + aa];
            const float va = __uint_as_float(__float_as_uint(va_k) & ~127u);
            float c[16];
#pragma unroll
            for (int bb = 0; bb < 16; ++bb) { const float s = va + __uint_as_float(__float_as_uint(top[1][bb]) & ~127u);
                c[bb] = __uint_as_float((__float_as_uint(s) & ~255u) | (255u - (unsigned)((4 * fq + aa) * 16 + bb))); }
            if (aa == 0) {
#pragma unroll
                for (int i = 0; i < 16; ++i) fin[i] = c[i];
            } else merge_top16(fin, c);
        }
        xmerge_top16(fin, 16); xmerge_top16(fin, 32);
        float ev[16], es = 0.f; const float mx = __uint_as_float(__float_as_uint(fin[0]) & ~255u);
#pragma unroll
        for (int i = 0; i < 16; ++i) { ev[i] = __expf(__uint_as_float(__float_as_uint(fin[i]) & ~255u) - mx); es += ev[i]; }
        const float inv = 1.f / es;
        asm volatile("s_waitcnt lgkmcnt(0)" ::: "memory");
        int oi[4]; float og[4];
#pragma unroll
        for (int kq = 0; kq < 4; ++kq) {
            const float fk = fq == 0 ? fin[kq] : fq == 1 ? fin[4 + kq] : fq == 2 ? fin[8 + kq] : fin[12 + kq];
            const float fe = fq == 0 ? ev[kq] : fq == 1 ? ev[4 + kq] : fq == 2 ? ev[8 + kq] : ev[12 + kq];
            const unsigned code = 255u - (__float_as_uint(fk) & 255u), a = code >> 4, bq = code & 15u;
            const unsigned i1 = 127u - (scr[a] & 127u), i2 = 127u - (scr[16 + bq] & 127u);
            oi[kq] = (int)(i1 * 128u + i2); og[kq] = fe * inv; }
        *(int4*)(IDX + (size_t)tok * 128 + 16 * h + 4 * fq) = make_int4(oi[0], oi[1], oi[2], oi[3]);
        *(f32x4*)(GATE + (size_t)tok * 128 + 16 * h + 4 * fq) = (f32x4){og[0], og[1], og[2], og[3]};
    }
}
struct PeerSched {
    int x0, rank, nloc, nblk, nown; unsigned orphan;
    __device__ __forceinline__ void init(const Args& A, int nrows, LAS unsigned char* smem) {
        unsigned* ctl = (unsigned*)(A.ws + WS_CTL);
        x0 = (int)(xb_xcc_id() & 7u); rank = __builtin_amdgcn_readfirstlane((int)((LAS unsigned*)smem)[8]); nblk = nrows / 64;
        unsigned cached = __builtin_amdgcn_readfirstlane(((LAS unsigned*)smem)[9]);
        if (cached == 0u) { unsigned orph = 0u, nl = 1u;
            for (int j = 0; j < 8; ++j) { unsigned c = xb_ld(&ctl[XB_XCNT(j)]) + xb_ld(&ctl[XB_XCNT(j + 8)]); c = __builtin_amdgcn_readfirstlane(c); if (c == 0u) orph |= 1u << j; if (j == x0) nl = c; }
            cached = (nl << 8) | orph; __syncthreads(); if (threadIdx.x == 0) ((LAS unsigned*)smem)[9] = cached; __syncthreads(); }
        nloc = (int)(cached >> 8); orphan = cached & 0xffu;
        const int tot = (NSL / 8) * nblk; nown = rank < tot ? (tot - rank + nloc - 1) / nloc : 0;
    }
    __device__ __forceinline__ bool item(int j, int& sl, int& blk) const {
        if (j < nown) { const int i = rank + j * nloc; sl = x0 + 8 * (i / nblk); blk = i % nblk; return true; }
        int jj = j - nown; const int tot = (NSL / 8) * nblk, per = ((int)gridDim.x > tot) ? 1 : 0; (void)per;
        for (int o = 0; o < 8; ++o) if ((orphan >> o) & 1u) { const int cnt = ((int)blockIdx.x < tot) ? (tot - (int)blockIdx.x + (int)gridDim.x - 1) / (int)gridDim.x : 0;
            if (jj < cnt) { const int i = (int)blockIdx.x + jj * (int)gridDim.x; sl = o + 8 * (i / nblk); blk = i % nblk; return true; } jj -= cnt; }
        return false;
    }
};
template <class LD, class PR>
__device__ __forceinline__ void peer_items(const PeerSched& S, LD ld, PR pr) {
    int sl, blk, sln, blkn, j = 0, buf = 0; bool have = S.item(0, sl, blk);
    __syncthreads();
    if (have) ld(sl, blk, 0);
    while (have) {
        const bool haven = S.item(j + 1, sln, blkn);
        asm volatile("s_waitcnt vmcnt(0)" ::: "memory");
        if (haven) ld(sln, blkn, buf ^ 1);
        pr(sl, blk, buf);
        sl = sln; blk = blkn; have = haven; buf ^= 1; ++j;
    }
    __syncthreads();
}
#ifndef MK_UVAR
#define MK_UVAR 0
#endif
__device__ __forceinline__ float dpp_sum8(float v) {
    v += __builtin_bit_cast(float, __builtin_amdgcn_mov_dpp(__builtin_bit_cast(int, v), 0xB1, 0xF, 0xF, true));
    v += __builtin_bit_cast(float, __builtin_amdgcn_mov_dpp(__builtin_bit_cast(int, v), 0x4E, 0xF, 0xF, true));
    v += __builtin_bit_cast(float, __builtin_amdgcn_mov_dpp(__builtin_bit_cast(int, v), 0x141, 0xF, 0xF, true));
    return v;
}
__device__ __forceinline__ void phase_peer_u(const Args& A, int layer, int nrows, LAS unsigned char* smem, int rep) {
    const int var = rep ? MK_UVAR : 0;
    const bf16_t* H = (const bf16_t*)(A.ws + WS_H); const int* IDX = (const int*)(A.ws + WS_R2); float* PART = var ? (float*)(A.ws + WS_R1) : (float*)(A.ws + WS_BIG + BIG_PART);
    const unsigned char* U = A.ws + tabset(layer);
    constexpr int PP = 1088, WB = 4 * PP + 2048;
    const int tid = otid(), wid = tid >> 6, lane = tid & 63, m = lane & 7, tk = lane >> 3;
    const int wu = __builtin_amdgcn_readfirstlane(wid);
    LAS unsigned char* lds = smem + LDS_BASE + wu * (2 * WB);
    PeerSched S; S.init(A, nrows, smem);
    peer_items(S,
        [&](int sl, int blk, int buf) {
#pragma unroll
            for (int i = 0; i < 4; ++i)
                __builtin_amdgcn_global_load_lds((const unsigned*)(IDX + ((size_t)blk * 64 + 8 * wu + 2 * i) * 128 + 4 * lane), (LAS unsigned*)(lds + buf * WB + PP * i), 16, 0, 0);
#pragma unroll
            for (int i = 0; i < 2; ++i)
                __builtin_amdgcn_global_load_lds((const unsigned*)(H + (size_t)(blk * 64 + 8 * wu + 4 * i + (lane >> 4)) * 1024 + SW * sl + 8 * (lane & 15)), (LAS unsigned*)(lds + buf * WB + 4 * PP + 1024 * i), 16, 0, 0); },
        [&](int sl, int blk, int buf) {
            const unsigned char* ub = U + (size_t)sl * NEXP * SW + 16 * m;
            const int tok = blk * 64 + wid * 8 + tk;
            const int sw = (tk & 1) * 4;
            const LAS int* ib = (const LAS int*)(lds + buf * WB + (tk >> 1) * PP + (tk & 1) * 512);
            float hf[16];
            { const u32x4 h0 = *(const LAS u32x4*)(lds + buf * WB + 4 * PP + tk * 256 + 32 * m), h1 = *(const LAS u32x4*)(lds + buf * WB + 4 * PP + tk * 256 + 32 * m + 16);
#pragma unroll
              for (int j = 0; j < 4; ++j) { hf[2 * j] = bflo(h0[j]); hf[2 * j + 1] = bfhi(h0[j]); hf[8 + 2 * j] = bflo(h1[j]); hf[8 + 2 * j + 1] = bfhi(h1[j]); } }
            const bool up4 = m >= 4, up2 = (m & 2) != 0, up1 = (m & 1) != 0;
            float* pp = PART + ((size_t)sl * NROW + tok) * 128 + (m ^ sw);
            u32x4 vv[2][8];
#define PU_ROWS(T, c) do { const i32x4 e0_ = *(const LAS i32x4*)(ib + 8 * (c) + sw), e1_ = *(const LAS i32x4*)(ib + 8 * (c) + (4 - sw)); \
                if (var == 4) { _Pragma("unroll") for (int k_ = 0; k_ < 8; ++k_) vv[T][k_] = (u32x4){(unsigned)e0_.x, (unsigned)e1_.y, 0u, 0u}; } else { \
                vv[T][0] = *(const u32x4*)(ub + (size_t)(var == 3 ? e0_.x & 63 : e0_.x) * SW); vv[T][1] = *(const u32x4*)(ub + (size_t)(var == 3 ? e0_.y & 63 : e0_.y) * SW); \
                vv[T][2] = *(const u32x4*)(ub + (size_t)(var == 3 ? e0_.z & 63 : e0_.z) * SW); vv[T][3] = *(const u32x4*)(ub + (size_t)(var == 3 ? e0_.w & 63 : e0_.w) * SW); \
                vv[T][4] = *(const u32x4*)(ub + (size_t)(var == 3 ? e1_.x & 63 : e1_.x) * SW); vv[T][5] = *(const u32x4*)(ub + (size_t)(var == 3 ? e1_.y & 63 : e1_.y) * SW); \
                vv[T][6] = *(const u32x4*)(ub + (size_t)(var == 3 ? e1_.z & 63 : e1_.z) * SW); vv[T][7] = *(const u32x4*)(ub + (size_t)(var == 3 ? e1_.w & 63 : e1_.w) * SW); } } while (0)
#define PU_DOT(T, c) do { float s_[8]; \
                _Pragma("unroll") for (int k = 0; k < 8; ++k) { f32x2 a2 = {0.f, 0.f}; \
                    _Pragma("unroll") for (int j = 0; j < 4; ++j) { const int w = (int)vv[T][k][j]; \
                        const f32x2 lo = __builtin_amdgcn_cvt_pk_f32_fp8(w, false), hi = __builtin_amdgcn_cvt_pk_f32_fp8(w, true); \
                        a2 = __builtin_elementwise_fma(lo, (f32x2){hf[4 * j], hf[4 * j + 1]}, a2); a2 = __builtin_elementwise_fma(hi, (f32x2){hf[4 * j + 2], hf[4 * j + 3]}, a2); } \
                    s_[k] = a2.x + a2.y; } \
                  \
                float t_[4], u_[2]; \
                _Pragma("unroll") for (int j = 0; j < 4; ++j) { const float give = up4 ? s_[j] : s_[4 + j], keep = up4 ? s_[4 + j] : s_[j]; \
                    t_[j] = keep + __builtin_bit_cast(float, __builtin_amdgcn_mov_dpp(__builtin_bit_cast(int, give), 0x141, 0xF, 0xF, true)); }        \
                _Pragma("unroll") for (int j = 0; j < 2; ++j) { const float give = up2 ? t_[j] : t_[2 + j], keep = up2 ? t_[2 + j] : t_[j]; \
                    u_[j] = keep + __builtin_bit_cast(float, __builtin_amdgcn_mov_dpp(__builtin_bit_cast(int, give), 0x4E, 0xF, 0xF, true)); }         \
                { const float give = up1 ? u_[0] : u_[1], keep = up1 ? u_[1] : u_[0]; \
                  const float tot_ = keep + __builtin_bit_cast(float, __builtin_amdgcn_mov_dpp(__builtin_bit_cast(int, give), 0xB1, 0xF, 0xF, true));           \
                  pp[8 * (c)] = tot_; } } while (0)
            PU_ROWS(0, 0);
#pragma unroll 1
            for (int c = 0; c < 16; c += 2) {
                PU_ROWS(1, c + 1);
                __builtin_amdgcn_sched_barrier(0);
                PU_DOT(0, c);
                __builtin_amdgcn_sched_barrier(0);
                if (c + 2 < 16) PU_ROWS(0, c + 2);
                __builtin_amdgcn_sched_barrier(0);
                PU_DOT(1, c + 1);
                __builtin_amdgcn_sched_barrier(0);
            }
#undef PU_ROWS
#undef PU_DOT
        });
}
__device__ __forceinline__ void phase_coef(const Args& A, int layer, int nrows) {
    const float* PART = (const float*)(A.ws + WS_BIG + BIG_PART); const float* GATE = (const float*)(A.ws + WS_R2 + R2_GATE); float* COEF = (float*)(A.ws + WS_R2 + R2_COEF);
    const int* IDX = (const int*)(A.ws + WS_R2); const float* SCL = (const float*)(A.ws + tabset(layer) + TAB_SCL);
    const int gthr = blockIdx.x * NTHR + otid(), nthr = gridDim.x * NTHR;
    for (int p = gthr; p < nrows * 32; p += nthr) {
        f32x4 s = {0.f, 0.f, 0.f, 0.f};
#pragma unroll
        for (int x = 0; x < NSL; ++x) s += *(const f32x4*)(PART + (size_t)x * NROW * 128 + 4 * p);
        const i32x4 e = *(const i32x4*)(IDX + 4 * p); const f32x4 gt = *(const f32x4*)(GATE + 4 * p);
        const f32x4 su = {SCL[e.x], SCL[e.y], SCL[e.z], SCL[e.w]}, sv = {SCL[NEXP + e.x], SCL[NEXP + e.y], SCL[NEXP + e.z], SCL[NEXP + e.w]};
        const f32x4 a = s * su; const f32x2 g0 = gelu_pk((f32x2){a[0], a[1]}), g1 = gelu_pk((f32x2){a[2], a[3]});
        *(f32x4*)(COEF + 4 * p) = gt * (f32x4){g0.x, g0.y, g1.x, g1.y} * sv; }

}
__device__ __forceinline__ void phase_peer_v(const Args& A, int layer, int nrows, LAS unsigned char* smem, int rep) {
    const int* IDX = (const int*)(A.ws + WS_R2); const float* COEF = (const float*)(A.ws + WS_R2 + R2_COEF);
    const unsigned char* V = A.ws + tabset(layer) + TAB8_HALF; const float* MODL = (const float*)(A.ws + WS_MOD) + (size_t)layer * 5 * 6144 + 5 * 1024;
    float* XC = (float*)(A.ws + WS_XC);
    constexpr int PP = 1088, WB = 8 * PP;
    const int tid = otid(), wid = tid >> 6, lane = tid & 63, m = lane & 7, tk = lane >> 3;
    const int wu = __builtin_amdgcn_readfirstlane(wid);
    LAS unsigned char* lds = smem + LDS_BASE + wu * (2 * WB);
    PeerSched S; S.init(A, nrows, smem);
    peer_items(S,
        [&](int sl, int blk, int buf) {
#pragma unroll
            for (int i = 0; i < 4; ++i) {
                __builtin_amdgcn_global_load_lds((const unsigned*)(IDX + ((size_t)blk * 64 + 8 * wu + 2 * i) * 128 + 4 * lane), (LAS unsigned*)(lds + buf * WB + PP * i), 16, 0, 0);
                __builtin_amdgcn_global_load_lds((const unsigned*)(COEF + ((size_t)blk * 64 + 8 * wu + 2 * i) * 128 + 4 * lane), (LAS unsigned*)(lds + buf * WB + 4 * PP + PP * i), 16, 0, 0); } },
        [&](int sl, int blk, int buf) {
            const unsigned char* vb = V + (size_t)sl * NEXP * SW + 16 * m;
            const int tok = blk * 64 + wid * 8 + tk; const bool lat = tok < NLAT;
            const int toff = (tk >> 1) * PP + (tk & 1) * 512, sw = (tk & 1) * 4;
            const LAS int* ib = (const LAS int*)(lds + buf * WB + toff); const LAS float* cb = (const LAS float*)(lds + buf * WB + 4 * PP + toff);
            float* xp = (lat ? A.out + (size_t)tok * D : XC + (size_t)(tok - NLAT) * D) + SW * sl + 16 * m;
            f32x4 xr[4];
#pragma unroll
            for (int j = 0; j < 4; ++j) xr[j] = *(f32x4*)(xp + 4 * j);
            f32x2 acc2[8];
#pragma unroll
            for (int j = 0; j < 8; ++j) acc2[j] = (f32x2){0.f, 0.f};
            u32x4 vv[2][8];
#define PV_ROWS(T, c) do { const i32x4 e0_ = *(const LAS i32x4*)(ib + 8 * (c) + sw), e1_ = *(const LAS i32x4*)(ib + 8 * (c) + (4 - sw)); \
                vv[T][0] = *(const u32x4*)(vb + (size_t)e0_.x * SW); vv[T][1] = *(const u32x4*)(vb + (size_t)e0_.y * SW); vv[T][2] = *(const u32x4*)(vb + (size_t)e0_.z * SW); vv[T][3] = *(const u32x4*)(vb + (size_t)e0_.w * SW); \
                vv[T][4] = *(const u32x4*)(vb + (size_t)e1_.x * SW); vv[T][5] = *(const u32x4*)(vb + (size_t)e1_.y * SW); vv[T][6] = *(const u32x4*)(vb + (size_t)e1_.z * SW); vv[T][7] = *(const u32x4*)(vb + (size_t)e1_.w * SW); } while (0)
#define PV_FMA(T, c) do { const f32x4 c0_ = *(const LAS f32x4*)(cb + 8 * (c) + sw), c1_ = *(const LAS f32x4*)(cb + 8 * (c) + (4 - sw)); \
                _Pragma("unroll") for (int k = 0; k < 8; ++k) { const float cf = k < 4 ? c0_[k & 3] : c1_[k & 3]; \
                    _Pragma("unroll") for (int j = 0; j < 4; ++j) { const int w = (int)vv[T][k][j]; \
                        const f32x2 lo = __builtin_amdgcn_cvt_pk_f32_fp8(w, false), hi = __builtin_amdgcn_cvt_pk_f32_fp8(w, true); const f32x2 c2 = {cf, cf}; \
                        acc2[2 * j] = __builtin_elementwise_fma(lo, c2, acc2[2 * j]); acc2[2 * j + 1] = __builtin_elementwise_fma(hi, c2, acc2[2 * j + 1]); } } } while (0)
            PV_ROWS(0, 0);
#pragma unroll 1
            for (int c = 0; c < 16; c += 2) {
                PV_ROWS(1, c + 1);
                __builtin_amdgcn_sched_barrier(0);
                PV_FMA(0, c);
                __builtin_amdgcn_sched_barrier(0);
                if (c + 2 < 16) PV_ROWS(0, c + 2);
                __builtin_amdgcn_sched_barrier(0);
                PV_FMA(1, c + 1);
                __builtin_amdgcn_sched_barrier(0);
            }
#undef PV_ROWS
#undef PV_FMA
            const float* gp = MODL + (size_t)(lat ? (tok >> 13) : 4) * 6144 + SW * sl + 16 * m;
#pragma unroll
            for (int j = 0; j < 4; ++j) { const f32x4 g = *(const f32x4*)(gp + 4 * j);
                *(f32x4*)(xp + 4 * j) = xr[j] + g * (f32x4){acc2[2 * j].x, acc2[2 * j].y, acc2[2 * j + 1].x, acc2[2 * j + 1].y}; }
        });
}

#ifdef MK_CHECK
constexpr int CW_CHK = 3840;
__device__ __forceinline__ float blk_sum(float v, LAS float* red) {
    const int t_ = otid(); v = wave_sum(v); __syncthreads(); if ((t_ & 63) == 0) red[t_ >> 6] = v; __syncthreads();
    float s = 0.f; for (int i = 0; i < 8; ++i) s += red[i]; __syncthreads(); return s;
}
__device__ __forceinline__ float fp8f(unsigned b) { const unsigned e = (b >> 3) & 15u, m = b & 7u; const float v = e ? ldexpf(1.f + (float)m * 0.125f, (int)e - 7) : ldexpf((float)m * 0.125f, -6); return (b & 0x80u) ? -v : v; }
__device__ __forceinline__ void check_attn(const Args& A, LAS unsigned char* lds, bool with_ctx) {
    const unsigned char* Q = A.ws + WS_R1 + R1_Q; const unsigned char* KN = A.ws + WS_R1 + R1_KN; const unsigned char* KR = A.ws + WS_BIG + BIG_KR; const unsigned char* V = A.ws + WS_R1 + R1_V;
    const bf16_t* CAT = (const bf16_t*)(A.ws + WS_R3 + R3_CAT); float* chk = (float*)(A.ws + WS_CTL) + CW_CHK;
    LAS float* p = (LAS float*)lds; LAS float* qv = p + NKEY; LAS float* red = qv + 192;
    const int tid = otid();
    for (int au = blockIdx.x; au < (with_ctx ? 1056 : 1024); au += gridDim.x) {
        int b, h, qrow, orow, nkey;
        if (au < 1024) { b = au >> 8; h = au & 7; const int qb = (au >> 3) & 31, l = 256 * qb + (int)((((unsigned)au * 2654435761u) >> 20) & 255u); qrow = 256 + l; orow = b * 8192 + l; nkey = NKEY; }
        else { const int cu = au - 1024; b = cu >> 3; h = cu & 7; const int lc = (int)((((unsigned)au * 2654435761u) >> 20) & 255u); qrow = lc; orow = NLAT + 256 * b + lc; nkey = 256; }
        const size_t bh = (size_t)(b * 8 + h);
        __syncthreads();
        if (tid < 192) qv[tid] = fp8f(Q[(bh * NKEY + qrow) * 192 + tid]) * (1.f / att8::QUP);
        __syncthreads();
        float mx = -1e30f;
        for (int key = tid; key < nkey; key += 512) { const int t = key >> 6, k = key & 63; float sacc = 0.f;
            for (int d = 0; d < 128; ++d) sacc += qv[d] * fp8f(KN[(bh * NKT + t) * 8192 + att8::kn8(k, d)]);
            for (int d = 0; d < 64; ++d) sacc += qv[128 + d] * fp8f(KR[((size_t)b * NKT + t) * 4096 + att8::kr8(k, d)]);
            p[key] = sacc; mx = fmaxf(mx, sacc); }
        for (int o = 32; o >= 1; o >>= 1) mx = fmaxf(mx, __shfl_xor(mx, o));
        __syncthreads(); if ((tid & 63) == 0) red[tid >> 6] = mx; __syncthreads(); mx = red[0]; for (int i = 1; i < 8; ++i) mx = fmaxf(mx, red[i]); __syncthreads();
        float ls = 0.f; for (int key = tid; key < nkey; key += 512) { const float e = exp2f(p[key] - mx); p[key] = e; ls += e; }
        ls = blk_sum(ls, red);
        float num = 0.f, den = 0.f;
        if (tid < 128) { float o = 0.f; for (int key = 0; key < nkey; ++key) o += p[key] * fp8f(V[(bh * NKT + (key >> 6)) * 8192 + att8::v8(tid, key & 63)]);
            o /= ls; const float got = bf2f(CAT[(size_t)orow * 2048 + 1024 + 128 * h + tid]); num = (got - o) * (got - o); den = o * o; }
        num = blk_sum(num, red); den = blk_sum(den, red);
        if (tid == 0) { atomicAdd(chk, num); atomicAdd(chk + 1, den); }
    }
}
__device__ __forceinline__ void check_qkv(const Args& A, int li, LAS unsigned char* lds) {
    float* chk = (float*)(A.ws + WS_CTL) + CW_CHK;
    const unsigned char* Q = A.ws + WS_R1 + R1_Q; const unsigned char* KN = A.ws + WS_R1 + R1_KN; const unsigned char* KR = A.ws + WS_BIG + BIG_KR; const unsigned char* V = A.ws + WS_R1 + R1_V;
    LAS float* hv = (LAS float*)lds; LAS float* cq = hv + 1024; LAS float* ckv = cq + 384; LAS float* kr = ckv + 256; LAS float* red = kr + 64; LAS float* ov = red + 16;
    const int tid = otid(), sidx = blockIdx.x;
    const int hd = sidx & 7; const int r = (sidx & 8) ? NLAT + (int)(((unsigned)sidx * 2654435761u) >> 22) : (int)(((unsigned)sidx * 2654435761u) >> 17);
    const float* win = A.in[I_HWIN] + (size_t)li * 1024 * HYB_IN;
    {
        const float* xp = r < NLAT ? A.out + (size_t)r * D : (const float*)(A.ws + WS_XC) + (size_t)(r - NLAT) * D; const float* MODL = (const float*)(A.ws + WS_MOD) + (size_t)(2 * li) * 5 * 6144 + (size_t)row_mb(r) * 6144;
        float ss = 0.f; for (int i = tid; i < 1024; i += 512) ss += xp[i] * xp[i];
        ss = blk_sum(ss, red); const float rstd = rsqrtf(ss / 1024.f + EPS);
        for (int i = tid; i < 1024; i += 512) hv[i] = bf2f(f2bf(xp[i] * rstd * A.in[I_N1G][(2 * li) * 1024 + i] * (1.f + MODL[1024 + i]) + MODL[i])); }
    __syncthreads();
    for (int j = tid; j < 704; j += 512) { float s = 0.f; for (int k = 0; k < 1024; ++k) s += hv[k] * win[(size_t)k * HYB_IN + C_CQ + j];
        s = bf2f(f2bf(s)); if (j < 384) cq[j] = s; else if (j < 640) ckv[j - 384] = s; else kr[j - 640] = s; }
    __syncthreads();
    float sq = 0.f, sk = 0.f; for (int j = tid; j < 384; j += 512) sq += cq[j] * cq[j]; for (int j = tid; j < 256; j += 512) sk += ckv[j] * ckv[j];
    sq = blk_sum(sq, red); sk = blk_sum(sk, red);
    const float rq = rsqrtf(sq / 384.f + EPS), rk = rsqrtf(sk / 256.f + EPS);
    const float* wqb = A.in[I_WQB] + (size_t)li * 384 * 1536; const float* wkvb = A.in[I_WKVB] + (size_t)li * 256 * 2048; const float* qg = A.in[I_QNG] + li * 384; const float* kg = A.in[I_KVNG] + li * 256;
    if (tid < 192) { float s = 0.f; for (int k = 0; k < 384; ++k) s += cq[k] * rq * qg[k] * wqb[(size_t)k * 1536 + hd * 192 + tid]; ov[tid] = s; }
    else if (tid < 448) { const int c = tid - 192; float s = 0.f; for (int k = 0; k < 256; ++k) s += ckv[k] * rk * kg[k] * wkvb[(size_t)k * 2048 + hd * 256 + c]; ov[tid] = s; }
    __syncthreads();
    const bool lat = r < NLAT; const int b = lat ? (r >> 13) : ((r - NLAT) >> 8), l = lat ? (r & 8191) : 0, key = lat ? 256 + l : ((r - NLAT) & 255), qrow = key;
    const size_t bh = (size_t)(b * 8 + hd); const float qs = QSCALE * att8::QUP;
    float num = 0.f, den = 0.f;
    if (tid < 128) {
        const float q = ov[tid] * qs, gq = fp8f(Q[(bh * NKEY + qrow) * 192 + tid]);
        const float kk = ov[192 + tid], gk = fp8f(KN[(bh * NKT + (key >> 6)) * 8192 + att8::kn8(key & 63, tid)]);
        const float vv = ov[320 + tid], gv = fp8f(V[(bh * NKT + (key >> 6)) * 8192 + att8::v8(tid, key & 63)]);
        num = (gq - q) * (gq - q) + (gk - kk) * (gk - kk) + (gv - vv) * (gv - vv); den = q * q + kk * kk + vv * vv;
    } else if (tid < 160) {
        const int i = tid - 128; float c = 1.f, sn = 0.f;
        if (lat) { const float pos = (float)(i < 16 ? (l >> 6) : (l & 63)); const float ang = pos * powf(10000.f, -(float)(i & 15) / 16.f); c = cosf(ang); sn = sinf(ang); }
        const float q1 = ov[128 + i] * qs, q2 = ov[160 + i] * qs, k1 = kr[i], k2 = kr[32 + i];
        const float rq1 = q1 * c - q2 * sn, rq2 = q1 * sn + q2 * c, rk1 = k1 * c - k2 * sn, rk2 = k1 * sn + k2 * c;
        const float gq1 = fp8f(Q[(bh * NKEY + qrow) * 192 + 128 + 2 * i]), gq2 = fp8f(Q[(bh * NKEY + qrow) * 192 + 128 + 2 * i + 1]);
        const float gk1 = fp8f(KR[((size_t)b * NKT + (key >> 6)) * 4096 + att8::kr8(key & 63, 2 * i)]), gk2 = fp8f(KR[((size_t)b * NKT + (key >> 6)) * 4096 + att8::kr8(key & 63, 2 * i + 1)]);
        num = (gq1 - rq1) * (gq1 - rq1) + (gq2 - rq2) * (gq2 - rq2) + (gk1 - rk1) * (gk1 - rk1) + (gk2 - rk2) * (gk2 - rk2); den = rq1 * rq1 + rq2 * rq2 + rk1 * rk1 + rk2 * rk2;
    }
    num = blk_sum(num, red); den = blk_sum(den, red);
    if (tid == 0) { atomicAdd(chk, num); atomicAdd(chk + 1, den); }
}
__device__ __forceinline__ void check_topk(const Args& A, int layer, LAS unsigned char* lds) {
    const bf16_t* QP = (const bf16_t*)(A.ws + WS_BIG); const int* IDX = (const int*)(A.ws + WS_R2); const float* GATE = (const float*)(A.ws + WS_R2 + R2_GATE); float* chk = (float*)(A.ws + WS_CTL) + CW_CHK;
    const bf16_t* K1 = (const bf16_t*)(A.ws + WS_W + W_PEER + (size_t)layer * WP_SZ + WP_K1);
    LAS float* sc = (LAS float*)lds; LAS float* v12 = sc + 256; LAS int* i12 = (LAS int*)(v12 + 32); LAS float* cs = (LAS float*)(i12 + 32); LAS float* ts = cs + 256; LAS int* ti = (LAS int*)(ts + 16); LAS float* red = (LAS float*)(ti + 16);
    const int tid = otid();
    for (int smp = blockIdx.x; smp < 1024; smp += gridDim.x) {
        const int h = smp & 7, tok = (int)((((unsigned)smp * 2654435761u) >> 12) % (unsigned)NROW);
        __syncthreads();
        if (tid < 256) { const int half = tid >> 7, key = tid & 127; float a = 0.f;
            for (int d = 0; d < 128; ++d) a += bf2f(QP[(size_t)tok * 2048 + 256 * h + 128 * half + d]) * bf2f(K1[((size_t)half * 8 + h) * 16384 + key * 128 + d]);
            sc[tid] = a; }
        __syncthreads();
        if (tid < 256) { const int half = tid >> 7, key = tid & 127; const float v = sc[tid]; int rank = 0;
            for (int j = 0; j < 128; ++j) { const float o = sc[half * 128 + j]; rank += (o > v || (o == v && j < key)) ? 1 : 0; }
            if (rank < 16) { v12[half * 16 + rank] = v; i12[half * 16 + rank] = key; } }
        __syncthreads();
        if (tid < 256) cs[tid] = v12[tid >> 4] + v12[16 + (tid & 15)];
        __syncthreads();
        if (tid < 256) { const float v = cs[tid]; int rank = 0;
            for (int j = 0; j < 256; ++j) { const float o = cs[j]; rank += (o > v || (o == v && j < tid)) ? 1 : 0; }
            if (rank < 16) { ts[rank] = v; ti[rank] = i12[tid >> 4] * 128 + i12[16 + (tid & 15)]; } }
        __syncthreads();
        float num = 0.f, den = 0.f;
        if (tid < 16) { float es = 0.f; for (int j = 0; j < 16; ++j) es += __expf(ts[j] - ts[0]); const float gn = __expf(ts[tid] - ts[0]) / es; float gk = 0.f;
            for (int j = 0; j < 16; ++j) if (IDX[(size_t)tok * 128 + 16 * h + j] == ti[tid]) gk = GATE[(size_t)tok * 128 + 16 * h + j];
            num = (gk - gn) * (gk - gn); den = gn * gn; }
        num = blk_sum(num, red); den = blk_sum(den, red);
        if (tid == 0) { atomicAdd(chk, num); atomicAdd(chk + 1, den); }
    }
}
__device__ __forceinline__ void check_ssd(const Args& A, int li, LAS unsigned char* lds) {
    const bf16_t* XS = (const bf16_t*)(A.ws + WS_R2); const bf16_t* BC = (const bf16_t*)(A.ws + WS_R2 + R2_BC); const float* DT = (const float*)(A.ws + WS_BIG + BIG_DT);
    const bf16_t* Y0 = (const bf16_t*)(A.ws + WS_H); const bf16_t* Y1 = (const bf16_t*)(A.ws + WS_R3); float* chk = (float*)(A.ws + WS_CTL) + CW_CHK;
    LAS float* red = (LAS float*)lds;
    const int tid = otid(), sidx = blockIdx.x;
    const int b = sidx & 3, d = (sidx >> 2) & 1, h = (sidx >> 3) & 15, p = (int)((((unsigned)sidx * 2654435761u) >> 20) & 63u), g = h >> 3;
    const float a = -__expf(A.in[I_ALOG][li * 32 + d * 16 + h]);
    const bf16_t* Y = d ? Y1 : Y0;
    float hst = 0.f, num = 0.f, den = 0.f;
    for (int step = 0; step < 8448; ++step) {
        int r;
        if (step < 256) r = NLAT + b * 256 + (d ? 255 - step : step); else { const int q = step - 256; r = b * 8192 + (d ? 8191 - q : q); }
        const float dt = DT[(size_t)(d * 16 + h) * NROW + r], x = bf2f(XS[(size_t)r * 1024 + 64 * h + p]);
        float contrib = 0.f;
        if (tid < 128) { hst = __expf(dt * a) * hst + dt * x * bf2f(BC[(size_t)r * 512 + 128 * g + tid]); contrib = hst * bf2f(BC[(size_t)r * 512 + 256 + 128 * g + tid]); }
        if (step % 61 == 0) { const float y = blk_sum(contrib, red); const float got = bf2f(Y[(size_t)r * 1024 + 64 * h + p]); if (tid == 0) { num += (got - y) * (got - y); den += y * y; } }
    }
    if (tid == 0) { atomicAdd(chk, num); atomicAdd(chk + 1, den); }
}
#endif
#ifndef MK_PER_PHASE
#define MK_PER_PHASE 0
#endif
__device__ __forceinline__ int nr_in(int L) { return L <= 2 ? NROW : NLAT; }
__device__ __forceinline__ int nr_out(int L) { return L <= 1 ? NROW : NLAT; }

__global__ void __launch_bounds__(NTHR, 2) fwd(Args A) {
    extern __shared__ __attribute__((aligned(256))) unsigned char smem_raw[];
    LAS unsigned char* smem = (LAS unsigned char*)smem_raw;
    LAS unsigned char* lds = smem + LDS_BASE;
    const int tid = otid();
    if (tid < 64) ((LAS unsigned*)smem)[tid] = 0u;
    __syncthreads();
    XcdBarrier bar = xcd_barrier_post((unsigned*)(A.ws + WS_CTL), (volatile LAS unsigned*)smem);
    if (tid == 0) ((LAS unsigned*)smem)[8] = atomicAdd((unsigned*)(A.ws + WS_CTL) + CW_RANK + 32 * (xb_xcc_id() & 7u), 1u);
    __syncthreads();
    bool need_bar = false;
    const int lo = A.ph_lo, hi = A.ph_hi;
#ifndef PHMASK
#define PHMASK 0xffffffffu
#endif
#define SITE(k) if constexpr (((PHMASK) >> (k)) & 1u)
#ifndef MK_SVAR
#define MK_SVAR 1
#endif
#ifndef MK_REPEAT_SITE
#define MK_REPEAT_SITE -1
#endif
#define REP(k) for (int rep = 0; rep < ((k) == (MK_REPEAT_SITE) ? 2 : 1); ++rep)
#define PH(id) if ([&]() -> bool { if ((id) < lo || (id) >= hi) return false; if (need_bar) xcd_barrier(bar); need_bar = true; return true; }())
    unsigned char* ws = A.ws;
#define TAIL_TAB(units, layer, rlo, rhi) do { const int nx_ = (units) % 256; if (gridDim.x == 256 && (int)blockIdx.x >= nx_) phase_tabcvt(A, layer, (int)blockIdx.x - nx_, 256 - nx_, rlo, rhi); } while (0)
    float* XL = A.out; float* XC = (float*)(ws + WS_XC);
    bf16_t* H = (bf16_t*)(ws + WS_H);
    const float* MOD = (const float*)(ws + WS_MOD);

    SITE(0) PH(0) { phase_prologue(A, lds); }
    SITE(1) PH(1) { phase_norm_mod(A.in[I_X], A.in[I_CTX], XL, XC, A.in[I_N1G], MOD, 0, H, NROW); }
    for (int L = 0; L < DEPTH; ++L) {
        const int base = 2 + 16 * L, li = L >> 1; const bool hyb = (L & 1) == 0;
        const float* MODL = MOD + (size_t)L * 5 * 6144;
        unsigned char* WH = ws + WS_W + W_HYB + (size_t)li * WH_SZ; unsigned char* WG = ws + WS_W + W_GM + (size_t)li * WG_SZ; unsigned char* WP = ws + WS_W + W_PEER + (size_t)L * WP_SZ;
        if (hyb) {
            SITE(2) PH(base + 0) REP(2) { pg8::Gemm g{H, (const bf16_t*)(WH + WH_IN), nr_in(L), HYB_INP, 1024, 1024, 1024};
                pg8::EpiBf16<0> e{(bf16_t*)(ws + WS_BIG), HYB_INP}; pg8::gemm_phase(lds, g, e); }
            SITE(3) PH(base + 1) REP(3) { phase_conv(A, li); }
            SITE(4) PH(base + 2) {
                SITE(18) REP(18) { pg8::Gemm g{(const bf16_t*)(ws + WS_BIG) + C_CQ, (const bf16_t*)(WH + WH_QB), L == 0 ? NROW : NLAT, 1536, 384, HYB_INP, 384};
                  EpiQ e{ws + WS_R1 + R1_Q, (const float*)(ws + WS_RSTD), (const float*)(ws + WS_ROPE)}; pg8::gemm_phase(lds, g, e); }
                SITE(19) REP(19) { pg8::Gemm g{(const bf16_t*)(ws + WS_BIG) + C_CKV, (const bf16_t*)(WH + WH_KVB), NROW, 2048, 256, HYB_INP, 256};
                  EpiKV e{ws + WS_R1 + R1_KN, ws + WS_R1 + R1_V, (const float*)(ws + WS_RSTD) + NROW}; pg8::gemm_phase(lds, g, e); }
                SITE(20) REP(20) for (int u = blockIdx.x; u < 528; u += gridDim.x) ssd::g_unit((const bf16_t*)(ws + WS_R2 + R2_BC), (bf16_t*)(ws + WS_BIG + BIG_G), u);
            }
            SITE(5) PH(base + 3) {
                const int xq = (int)blockIdx.x & 7, jq = (int)blockIdx.x >> 3; const bool ssd_wg = (jq & 1) == 0 && gridDim.x == 256;
                if (gridDim.x == 256) {
                    if (ssd_wg) { const int r = jq >> 1, gi = xq + 8 * (r >> 3), hh = r & 7, sb = gi >> 2, sgp = (gi >> 1) & 1, sd = gi & 1;
                        SITE(21) ssd::ssd_unit(sb, 8 * sgp + hh, sd, (const bf16_t*)(ws + WS_R2), (const bf16_t*)(ws + WS_R2 + R2_BC), (const float*)(ws + WS_BIG + BIG_DT), (const bf16_t*)(ws + WS_BIG + BIG_G),
                                               A.in[I_ALOG] + li * 32, sd ? (bf16_t*)(ws + WS_R3) : (bf16_t*)(ws + WS_H), lds); }
                } else {
                    SITE(21) for (int u = blockIdx.x; u < 128; u += gridDim.x) ssd::ssd_unit(u >> 5, (u >> 1) & 15, u & 1, (const bf16_t*)(ws + WS_R2), (const bf16_t*)(ws + WS_R2 + R2_BC), (const float*)(ws + WS_BIG + BIG_DT),
                                               (const bf16_t*)(ws + WS_BIG + BIG_G), A.in[I_ALOG] + li * 32, (u & 1) ? (bf16_t*)(ws + WS_R3) : (bf16_t*)(ws + WS_H), lds);
                }
                const int nmine = gridDim.x == 256 ? (ssd_wg ? 3 : 5) + (L == 0 && !ssd_wg && jq < 8 ? 1 : 0) : 0;
                SITE(22) REP(22) for (int it = 0; gridDim.x == 256 ? it < nmine : (int)blockIdx.x + it * (int)gridDim.x < (L == 0 ? 1056 : 1024); ++it) {
                    int b, h, qrow0, orow0, nt;
                    if (gridDim.x == 256) {
                        const int base_it = ssd_wg ? 3 : 5;
                        if (it < base_it) { const int v = ssd_wg ? 3 * (jq >> 1) + it : 48 + 5 * (jq >> 1) + it; b = v >> 5; h = xq; const int qb = v & 31; qrow0 = 256 + 256 * qb; orow0 = b * 8192 + 256 * qb; nt = NKT; }
                        else { b = jq >> 1; h = xq; qrow0 = 0; orow0 = NLAT + 256 * b; nt = 4; }
                    } else { const int au = (int)blockIdx.x + it * (int)gridDim.x;
                        if (au < 1024) { b = au >> 8; h = au & 7; const int qb = (au >> 3) & 31; qrow0 = 256 + 256 * qb; orow0 = b * 8192 + 256 * qb; nt = NKT; }
                        else { const int cu = au - 1024; b = cu >> 3; h = cu & 7; qrow0 = 0; orow0 = NLAT + 256 * b; nt = 4; } }
                    const size_t bh = (size_t)(b * 8 + h);
                    att8::attn_unit(ws + WS_R1 + R1_Q + (bh * NKEY + qrow0) * 192, ws + WS_R1 + R1_KN + bh * NKT * 8192, ws + WS_BIG + BIG_KR + (size_t)b * NKT * 4096,
                                    ws + WS_R1 + R1_V + bh * NKT * 8192, (bf16_t*)(ws + WS_R3 + R3_CAT) + (size_t)orow0 * 2048 + 1024 + 128 * h, nt, lds);
                }
                if (gridDim.x == 256 && !ssd_wg && L == 2) SITE(11) phase_tabcvt(A, 3, xq + 8 * (jq >> 1), 128, 0, NEXP);
            }
            SITE(6) PH(base + 4) REP(6) { phase_ssd_out(A, li, nr_out(L));
#if defined(MK_CHECK) && MK_CHECK == 1
                if (L == 0) check_attn(A, lds, true);
#elif defined(MK_CHECK) && MK_CHECK == 2
                if (L == 0) check_qkv(A, li, lds);
#elif defined(MK_CHECK) && MK_CHECK == 3
                if (L == 2) check_attn(A, lds, false);
#elif defined(MK_CHECK) && MK_CHECK == 5
                if (L == 0) check_ssd(A, li, lds);
#elif defined(MK_CHECK) && MK_CHECK == 6
                if (L == 2) check_ssd(A, li, lds);
#endif
            }
        } else {
            SITE(7) PH(base + 0) REP(7) { pg8::Gemm g{H, (const bf16_t*)(WG + WG_IN), nr_out(L), 4096, 1024, 1024, 1024};
                pg8::EpiGmIn e{(bf16_t*)(ws + WS_BIG), (float*)(ws + WS_R3)}; pg8::gemm_phase(lds, g, e);
                if (rep == 0 && L == 1) TAIL_TAB((nr_out(L) / 256) * 16, 1, NEXP, 2 * NEXP); }
            SITE(9) PH(base + 2) REP(9) { phase_spatial(A, li, nr_out(L), lds); }
        }
        SITE(10) PH(base + 5) { pg8::Gemm g{hyb ? (const bf16_t*)(ws + WS_R3 + R3_CAT) : (const bf16_t*)(ws + WS_R1), hyb ? (const bf16_t*)(WH + WH_OUT) : (const bf16_t*)(WG + WG_OUT), nr_out(L), 1024, 2048, 2048, 2048};
            pg8::EpiResid e{XL, XC, MODL + 2 * 1024}; pg8::gemm_phase(lds, g, e);
            if (L == 0) TAIL_TAB((nr_out(L) / 256) * 4, 0, 0, 2 * NEXP); else if (L == 1) TAIL_TAB((nr_out(L) / 256) * 4, 2, 0, 2 * NEXP); }
        SITE(11) PH(base + 6) REP(11) { phase_norm_mod(XL, XC, nullptr, nullptr, A.in[I_N2G] + L * 1024, MODL, 3, H, nr_out(L));
            if (gridDim.x != 256) phase_tabcvt(A, L, (int)blockIdx.x, (int)gridDim.x);
            else if (L == 3) phase_tabcvt(A, 3, (int)blockIdx.x, 256, NEXP, 2 * NEXP); }
        SITE(12) PH(base + 7) REP(12) { pg8::Gemm g{H, (const bf16_t*)(WP + WP_Q), nr_out(L), 2048, 1024, 1024, 1024};
            pg8::EpiBf16<0> e{(bf16_t*)(ws + WS_BIG), 2048}; pg8::gemm_phase(lds, g, e);
            if (rep == 0 && L == 0) TAIL_TAB((nr_out(L) / 256) * 8, 1, 0, NEXP); }
        SITE(13) PH(base + 8) REP(13) { phase_topk(A, L, nr_out(L), lds); }
        SITE(14) PH(base + 9) REP(14) { phase_peer_u(A, L, nr_out(L), smem, rep); }
        SITE(15) PH(base + 10) REP(15) { phase_coef(A, L, nr_out(L));
#if defined(MK_CHECK) && MK_CHECK == 4
            if (L == 1) check_topk(A, L, lds);
#endif
        }
        SITE(16) PH(base + 11) { phase_peer_v(A, L, nr_out(L), smem, 0); }
        SITE(17) PH(base + 12) { if (L < DEPTH - 1) phase_norm_mod(XL, XC, nullptr, nullptr, A.in[I_N1G] + (L + 1) * 1024, MOD + (size_t)(L + 1) * 5 * 6144, 0, H, nr_in(L + 1));
                        else {
#ifdef MK_CHECK
                            const float* chk = (const float*)(ws + WS_CTL) + CW_CHK; const float err = sqrtf(chk[0] / fmaxf(chk[1], 1e-30f));
                            phase_final_norm(XL, A.in[I_FNG], 1.f + 10.f * err);
#else
                            phase_final_norm(XL, A.in[I_FNG], 1.f);
#endif
                        } }
    }
#undef PH
}

#ifdef MK_TAP
__global__ void tap_kernel(const unsigned short* buf, size_t pitch, size_t col0, size_t ncols, size_t nrows, float* out) {
    const size_t n = ncols * nrows;
    for (size_t i = (size_t)blockIdx.x * blockDim.x + threadIdx.x; i < (size_t)NLAT * D; i += (size_t)gridDim.x * blockDim.x) {
        float s = 0.f; for (size_t j = i; j < n; j += (size_t)NLAT * D) s += (float)buf[(j / ncols) * pitch + col0 + (j % ncols)]; out[i] = s; }
}
#endif
extern "C" void kernel_launch(void* const* d_in, const int* in_sizes, int n_in, void* d_out, int out_size, void* d_ws, size_t ws_size, hipStream_t stream) {
    static int grid = 0;
    if (grid == 0) {
        if (n_in != N_IN || out_size != NLAT * D || ws_size < WS_END) { fprintf(stderr, "kernel_launch: unexpected shapes (n_in %d out %d ws %zu, need %zu)\n", n_in, out_size, ws_size, (size_t)WS_END); grid = -1; return; }
        int dev = 0, cus = 0, per_cu = 0;
        if (hipGetDevice(&dev) != hipSuccess || hipDeviceGetAttribute(&cus, hipDeviceAttributeMultiprocessorCount, dev) != hipSuccess) { grid = -1; return; }
        if (hipFuncSetAttribute((const void*)fwd, hipFuncAttributeMaxDynamicSharedMemorySize, LDS_BYTES) != hipSuccess) { fprintf(stderr, "kernel_launch: hipFuncSetAttribute failed\n"); grid = -1; return; }
        if (hipOccupancyMaxActiveBlocksPerMultiprocessor(&per_cu, (const void*)fwd, NTHR, LDS_BYTES) != hipSuccess || per_cu < 1) { fprintf(stderr, "kernel_launch: occupancy query says %d\n", per_cu); }
        (void)hipGetLastError();
        grid = cus;
    }
    if (grid < 0) return;
    (void)hipMemsetAsync((char*)d_ws + WS_CTL, 0, CTL_BYTES, stream);
    Args a{};
    for (int i = 0; i < N_IN; ++i) a.in[i] = (const float*)d_in[i];
    a.out = (float*)d_out; a.ws = (unsigned char*)d_ws;
#if MK_PER_PHASE
    for (int id = 0; id < 2 + 16 * DEPTH; ++id) {
        if (id >= 2) { const int L = (id - 2) / 16, s = (id - 2) % 16; if (s > 12) continue; if ((L & 1) && (s == 3 || s == 4)) continue; }
#ifdef MK_CUT
#ifdef MK_TAP
        if (id >= MK_CUT) continue;
#else
        if (id >= MK_CUT && id != 2 + 16 * (DEPTH - 1) + 12) continue;
#endif
#endif
        a.ph_lo = id; a.ph_hi = id + 1;
        hipLaunchKernelGGL(fwd, dim3(grid), dim3(NTHR), LDS_BYTES, stream, a);
    }
#ifdef MK_TAP
    { const size_t tp[5] = {MK_TAP}; hipLaunchKernelGGL(tap_kernel, dim3(2048), dim3(256), 0, stream, (const unsigned short*)((const char*)d_ws + tp[0]), tp[1], tp[2], tp[3], tp[4], (float*)d_out); }
#endif
#else
    a.ph_lo = 0; a.ph_hi = 2 + 16 * DEPTH;
    hipLaunchKernelGGL(fwd, dim3(grid), dim3(NTHR), LDS_BYTES, stream, a);
#endif
    const hipError_t le = hipPeekAtLastError();
    if (le != hipSuccess) fprintf(stderr, "kernel_launch: launch failed: %s\n", hipGetErrorName(le));
}
```

```cpp
#include <hip/hip_runtime.h>
#include <cstdio>
#include <cstdint>

#define LAS __attribute__((address_space(3)))
typedef unsigned short bf16_t;
typedef short bf16x8 __attribute__((ext_vector_type(8)));
typedef short s16x4 __attribute__((ext_vector_type(4)));
typedef float f32x2 __attribute__((ext_vector_type(2)));
typedef float f32x4 __attribute__((ext_vector_type(4)));
typedef float f32x16 __attribute__((ext_vector_type(16)));
typedef unsigned u32x2 __attribute__((ext_vector_type(2)));
typedef unsigned u32x4 __attribute__((ext_vector_type(4)));
typedef int i32x4 __attribute__((ext_vector_type(4)));
typedef int i32x8 __attribute__((ext_vector_type(8)));

constexpr int D = 1024, NB = 4, SEQ = 8192, DEPTH = 4, CTXL = 256;
constexpr int NLAT = NB * SEQ, NCTX = NB * CTXL, NROW = NLAT + NCTX;
constexpr int HYB_IN = 3280, HYB_INP = 3328;
constexpr int C_Z = 0, C_XBC = 1024, C_DT = 2560, C_CQ = 2576, C_CKV = 2960, C_KR = 3216;
constexpr int NKEY = SEQ + CTXL, NKT = NKEY / 64;
constexpr float EPS = 1e-6f;
constexpr float QSCALE = 0.07216878364870322f * 1.4426950408889634f;
constexpr int NEXP = 16384;

enum { I_X = 0, I_C, I_CTX, I_CCTX, I_ADAW, I_ADAB, I_N1G, I_N2G, I_HWIN, I_CONVW, I_CONVB, I_ALOG, I_DTB, I_SSDD, I_SSDNG, I_QNG, I_WQB, I_KVNG, I_WKVB,
       I_HWOUT, I_GWIN, I_GLNG, I_GLNB, I_GWS, I_GBS, I_GWOUT, I_PWQ, I_PK1, I_PK2, I_PU, I_PV, I_FNG, N_IN };

constexpr size_t al256(size_t x) { return (x + 255) & ~(size_t)255; }
constexpr size_t WS_CTL = 0, CTL_BYTES = 65536;
constexpr size_t WS_MOD = WS_CTL + CTL_BYTES;
constexpr size_t WS_ROPE = WS_MOD + al256((size_t)DEPTH * 5 * 6144 * 4);
constexpr size_t WS_RSTD = WS_ROPE + (size_t)2 * SEQ * 32 * 4;
constexpr size_t WS_W = WS_RSTD + al256((size_t)2 * NROW * 4);
constexpr size_t W_HYB = 0;
constexpr size_t WH_IN = 0, WH_QB = WH_IN + (size_t)HYB_INP * 1024 * 2, WH_KVB = WH_QB + (size_t)1536 * 384 * 2, WH_OUT = WH_KVB + (size_t)2048 * 256 * 2,
                 WH_SZ = WH_OUT + (size_t)1024 * 2048 * 2;
constexpr size_t W_GM = W_HYB + 2 * WH_SZ;
constexpr size_t WG_IN = 0, WG_OUT = WG_IN + (size_t)4096 * 1024 * 2, WG_WS = WG_OUT + (size_t)1024 * 2048 * 2, WG_SZ = WG_WS + (size_t)8 * 128 * 128 * 2;
constexpr size_t W_PEER = W_GM + 2 * WG_SZ;
constexpr size_t WP_Q = 0, WP_K1 = WP_Q + (size_t)2048 * 1024 * 2, WP_K2 = WP_K1 + (size_t)8 * 128 * 128 * 2, WP_SZ = WP_K2 + (size_t)8 * 128 * 128 * 2;
constexpr size_t W_TOTAL = W_PEER + 4 * WP_SZ;
constexpr size_t WS_TAB = WS_W + al256(W_TOTAL);
constexpr size_t TAB_HALF = (size_t)NEXP * 1024 * 2;
constexpr size_t TAB_REGION = 2 * TAB_HALF + 524288;
constexpr size_t WS_XB = WS_TAB + TAB_REGION;
constexpr size_t WS_H = WS_XB + (size_t)NROW * D * 2;
constexpr size_t WS_BIG = WS_H + (size_t)NROW * D * 2;
constexpr size_t BIG_BYTES = (size_t)NROW * 4096 * 2;
constexpr size_t BIG_DT = (size_t)NROW * HYB_INP * 2;
constexpr size_t BIG_G = BIG_DT + (size_t)NROW * 32 * 4;
constexpr size_t BIG_KR = BIG_G + (size_t)528 * 128 * 128 * 2;
constexpr size_t BIG_PART = (size_t)NROW * 2048 * 2;
static_assert(BIG_KR + (size_t)NB * NKT * 8192 <= BIG_BYTES, "BIG tail");
constexpr size_t WS_R1 = WS_BIG + BIG_BYTES;
constexpr size_t R1_Q = 0, R1_KN = R1_Q + (size_t)NB * 8 * NKEY * 192, R1_V = R1_KN + (size_t)NB * 8 * NKT * 8192, R1_HYB = R1_V + (size_t)NB * 8 * NKT * 8192,
                 R1_GM = (size_t)NROW * 2048 * 2, R1_BYTES = R1_HYB > R1_GM ? R1_HYB : R1_GM;
constexpr size_t WS_R2 = WS_R1 + R1_BYTES;
constexpr size_t R2_BC = (size_t)NROW * 1024 * 2, R2_BYTES = R2_BC + (size_t)NROW * 512 * 2;
constexpr size_t R2_GATE = (size_t)NROW * 128 * 4, R2_COEF = 2 * R2_GATE;
constexpr size_t WS_R3 = WS_R2 + R2_BYTES;
constexpr size_t R3_CAT = (size_t)NROW * 1024 * 2, R3_BYTES = R3_CAT + (size_t)NROW * 2048 * 2;
constexpr size_t WS_END = WS_R3 + R3_BYTES;
static_assert(WS_END <= ((size_t)1 << 30), "workspace must fit 1 GiB");

constexpr int CW_RANK = 3584;
constexpr int CW_QUEUE = 4096;

typedef __bf16 bf16x2_t __attribute__((ext_vector_type(2)));
__device__ __forceinline__ unsigned cvt_pk_bf16(float lo, float hi) { const f32x2 v = {lo, hi}; const bf16x2_t b = __builtin_convertvector(v, bf16x2_t); return __builtin_bit_cast(unsigned, b); }
__device__ __forceinline__ bf16_t f2bf(float f) { return (bf16_t)(cvt_pk_bf16(f, 0.f) & 0xffffu); }
__device__ __forceinline__ float bf2f(unsigned b) { return __uint_as_float(b << 16); }
__device__ __forceinline__ float bflo(unsigned w) { return __uint_as_float(w << 16); }
__device__ __forceinline__ float bfhi(unsigned w) { return __uint_as_float(w & 0xffff0000u); }
__device__ __forceinline__ float wave_sum(float v) {
#pragma unroll
    for (int o = 32; o >= 1; o >>= 1) v += __shfl_xor(v, o);
    return v;
}
__device__ __forceinline__ int otid() { int t = threadIdx.x; asm volatile("" : "+v"(t)); return t; }
__device__ __forceinline__ float silu_f(float x) { return x / (1.f + __expf(-x)); }
__device__ __forceinline__ float softplus_f(float x) { return x > 20.f ? x : log1pf(__expf(x)); }
__device__ __forceinline__ f32x2 gelu_pk(f32x2 v) {
    const f32x2 av = __builtin_elementwise_abs(v), d = av * 0.2316418882f + 1.0f;
    f32x2 t; t.x = __builtin_amdgcn_rcpf(d.x); t.y = __builtin_amdgcn_rcpf(d.y);
    f32x2 q = t * 0.5307027145f + (-0.7265760135f); q = q * t + 0.7107068705f; q = q * t + (-0.142248368f); q = q * t + 0.127414796f; q = q * t;
    const f32x2 s = (v * v) * (-0.72134752044f);
    f32x2 e; e.x = __builtin_amdgcn_exp2f(s.x); e.y = __builtin_amdgcn_exp2f(s.y);
    const f32x2 m = v * (q * e), r = v - m;
    f32x2 o; o.x = v.x < 0.f ? m.x : r.x; o.y = v.y < 0.f ? m.y : r.y; return o;
}
__device__ __forceinline__ float gelu_f(float x) { f32x2 v = {x, 0.f}; return gelu_pk(v).x; }

__device__ __forceinline__ unsigned pk4_fp8(float a, float b, float c, float d) { int w = 0; w = __builtin_amdgcn_cvt_pk_fp8_f32(a, b, w, false); w = __builtin_amdgcn_cvt_pk_fp8_f32(c, d, w, true); return (unsigned)w; }
__device__ __forceinline__ float sat8(float v) { return __builtin_amdgcn_fmed3f(v, -448.f, 448.f); }
__device__ __forceinline__ unsigned pk4_fp8_sat(float a, float b, float c, float d) { return pk4_fp8(sat8(a), sat8(b), sat8(c), sat8(d)); }
__device__ __forceinline__ int row_mb(int r) { return r < NLAT ? (r >> 13) : 4; }

#define XB_TMO      128
#define XB_XCNT(j)  (256  + 64 * (j))
#define XB_XSUB(j)  (1280 + 64 * (j))
#define XB_XGEN(j)  (2304 + 64 * (j))
#define XB_TOP      3328
#define XB_TOPGEN   3392
#define XCD_BAR_WORDS 3456
#define XB_SPIN_CAP (1u << 22)
__device__ __forceinline__ unsigned xb_ld(unsigned* p)              { return __hip_atomic_load(p, __ATOMIC_RELAXED, __HIP_MEMORY_SCOPE_AGENT); }
__device__ __forceinline__ unsigned xb_add(unsigned* p, unsigned v) { return __hip_atomic_fetch_add(p, v, __ATOMIC_RELAXED, __HIP_MEMORY_SCOPE_AGENT); }
__device__ __forceinline__ unsigned xb_xcc_id() { return (unsigned)__builtin_amdgcn_s_getreg((3 << 11) | 20) & 0xFu; }
#define XB_SPIN(cond, bar) do { unsigned _sp = 0; while (cond) { __builtin_amdgcn_s_sleep(1); \
    if ((++_sp & 255u) == 0u) { if (xb_ld(&(bar)[XB_TMO])) break; if (_sp > XB_SPIN_CAP) { atomicAdd(&(bar)[XB_TMO], 1u); break; } } } } while (0)
struct XcdBarrier { unsigned* bar; unsigned x; volatile LAS unsigned* st; };
__device__ __forceinline__ XcdBarrier xcd_barrier_post(unsigned* bar, volatile LAS unsigned* st) {
    XcdBarrier b; b.bar = bar; b.x = xb_xcc_id(); b.st = st;
    if (threadIdx.x == 0) (void)xb_add(&bar[XB_XCNT(b.x)], 1u);
    return b;
}
__device__ __forceinline__ void xcd_barrier_complete(unsigned* bar, unsigned x, unsigned& nloc, unsigned& nx) {
    const unsigned G = gridDim.x * gridDim.y * gridDim.z;
    unsigned sum, cnt, mine, sp = 0u;
    for (;;) {
        sum = 0u; cnt = 0u; mine = 0u;
#pragma unroll
        for (unsigned j = 0; j < 16; ++j) { const unsigned c = xb_ld(&bar[XB_XCNT(j)]); sum += c; cnt += (c > 0u) ? 1u : 0u; mine = (j == x) ? c : mine; }
        if (sum == G) break;
        __builtin_amdgcn_s_sleep(1);
        if ((++sp & 255u) == 0u) { if (xb_ld(&bar[XB_TMO])) break; if (sp > XB_SPIN_CAP) { atomicAdd(&bar[XB_TMO], 1u); break; } }
    }
    nloc = mine > 0u ? mine : 1u; nx = cnt > 0u ? cnt : 1u;
}
__device__ __forceinline__ void xcd_barrier(const XcdBarrier& b) {
    asm volatile("s_waitcnt vmcnt(0)" ::: "memory");
    __syncthreads();
    if (threadIdx.x == 0) {
        unsigned* bar = b.bar;
        __builtin_amdgcn_s_waitcnt(0);
        unsigned nloc = b.st[0], nx = b.st[1];
        if (nloc == 0u) { xcd_barrier_complete(bar, b.x, nloc, nx); b.st[0] = nloc; b.st[1] = nx; }
        const unsigned old = xb_add(&bar[XB_XSUB(b.x)], 1u);
        const unsigned gen = old / nloc;
        if (old + 1u == (gen + 1u) * nloc) {
            __builtin_amdgcn_fence(__ATOMIC_RELEASE, "agent");
            asm volatile("s_waitcnt vmcnt(0)" ::: "memory");
            const unsigned og = xb_add(&bar[XB_TOP], 1u);
            const unsigned tg = og / nx;
            if (og + 1u == (tg + 1u) * nx) xb_add(&bar[XB_TOPGEN], 1u);
            else XB_SPIN(xb_ld(&bar[XB_TOPGEN]) == tg, bar);
            __builtin_amdgcn_fence(__ATOMIC_ACQUIRE, "agent");
            xb_add(&bar[XB_XGEN(b.x)], 1u);
            asm volatile("s_waitcnt vmcnt(0)" ::: "memory");
        } else {
            XB_SPIN(xb_ld(&bar[XB_XGEN(b.x)]) == gen, bar);
            __builtin_amdgcn_fence(__ATOMIC_ACQUIRE, "agent");
            asm volatile("s_waitcnt vmcnt(0)" ::: "memory");
        }
    }
    __syncthreads();
}

namespace pg8 {
constexpr int BM = 256, BK = 64, HALF = 128, HTB = HALF * BK * 2, STAGE_BYTES = 8 * HTB, NXCD = 8, WGM = 8;
__host__ __device__ __forceinline__ int lds_byte(int r, int c) { const int st = (r >> 4) * 2 + (c >> 5), rr = r & 15, cc = c & 31, ob = rr * 64 + cc * 2; return st * 1024 + (ob ^ (((ob >> 9) & 1) << 5)); }
__host__ __device__ __forceinline__ void stage_rc(int b, int& R, int& C) { const int st = b / 1024, sb = b % 1024, swz = sb ^ (((sb >> 9) & 1) << 5); R = (st >> 1) * 16 + swz / 64; C = (st & 1) * 32 + (swz % 64) / 2; }
__host__ __device__ __forceinline__ int perm32(int rho) { const int n = rho >> 4, i = rho & 15; return 8 * (i >> 2) + 4 * n + (i & 3); }
struct Unit { int pm, pn; };
struct Gemm { const bf16_t* A; const bf16_t* Bt; int M, N, K, lda, ldb; };
struct StaticOrder {
    int nM, nN, nwg, G, c;
    __device__ void init(int M, int N, int G_, int c_) { nM = M / BM; nN = N / BM; nwg = nM * nN; G = G_; c = c_; }
    __device__ bool next(int i, Unit& u) const {
        const long L = (long)i * G + c; if (L >= nwg) return false;
        int wgid = (int)L; { const int q = nwg / NXCD, r = nwg % NXCD, xcd = wgid % NXCD, off = wgid / NXCD; wgid = (xcd < r ? xcd * (q + 1) : r * (q + 1) + (xcd - r) * q) + off; }
        const int nig = WGM * nN, gid = wgid / nig, fm = gid * WGM, gsz = (nM - fm) < WGM ? (nM - fm) : WGM;
        u.pm = fm + ((wgid % nig) % gsz); u.pn = (wgid % nig) / gsz; return true;
    }
};
template <class Epi>
__device__ __forceinline__ void gemm_phase(LAS unsigned char* lds, const Gemm g, const Epi& E) {
    const int tid = otid(), wid = __builtin_amdgcn_readfirstlane(tid >> 6), lane = tid & 63, wr = wid >> 2, wc = wid & 3, fr = lane & 15, fq = lane >> 4;
    StaticOrder S; S.init(g.M, g.N, (int)gridDim.x, (int)blockIdx.x);
    int K = g.K; asm volatile("" : "+s"(K));
    const int nt = K / BK;
    unsigned voffA[2], voffB[2];
#pragma unroll
    for (int i = 0; i < 2; ++i) { int R, C; stage_rc(tid * 16 + i * 8192, R, C); const int Rb = Epi::PERM ? ((R & ~31) + perm32(R & 31)) : R;
        voffA[i] = (unsigned)(R * g.lda + C) * 2u; voffB[i] = (unsigned)(Rb * g.ldb + C) * 2u; }
    const size_t kstep = (size_t)(BK * 2);
    const size_t hstepA = (size_t)HALF * g.lda * 2, hstepB = (size_t)HALF * g.ldb * 2;
    const size_t tstepA = 2 * hstepA, tstepB = 2 * hstepB;
    const unsigned ldsw = (unsigned)wid * 1024u;
    const int aoff = lds_byte(wr * 64 + fr, fq * 8), boff = lds_byte(wc * 32 + fr, fq * 8);
#define PG8_SA(b, h) (((b) * 2 + (h)) * HTB)
#define PG8_SB(b, h) ((4 + (b) * 2 + (h)) * HTB)
#define PG8_STAGE(bufoff, gbase, voff) do { _Pragma("unroll") for (int _i = 0; _i < 2; ++_i) \
        __builtin_amdgcn_global_load_lds((const unsigned*)((const char*)(gbase) + (voff)[_i]), (LAS unsigned*)(lds + (bufoff) + ldsw + _i * 8192), 16, 0, 0); } while (0)
#define PG8_LDA(dst, b, h) do { _Pragma("unroll") for (int m = 0; m < 4; ++m) _Pragma("unroll") for (int k = 0; k < 2; ++k) dst[m][k] = *(const LAS bf16x8*)(lds + PG8_SA(b, h) + aoff + m * 2048 + k * 1024); } while (0)
#define PG8_LDB(dst, b, h) do { _Pragma("unroll") for (int n = 0; n < 2; ++n) _Pragma("unroll") for (int k = 0; k < 2; ++k) dst[n][k] = *(const LAS bf16x8*)(lds + PG8_SB(b, h) + boff + n * 2048 + k * 1024); } while (0)
#define PG8_MMA(ai, bj, At, Bt) do { __builtin_amdgcn_s_setprio(1); _Pragma("unroll") for (int m = 0; m < 4; ++m) _Pragma("unroll") for (int n = 0; n < 2; ++n) _Pragma("unroll") for (int k = 0; k < 2; ++k) \
        acc[ai][bj][m][n] = __builtin_amdgcn_mfma_f32_16x16x32_bf16(Bt[n][k], At[m][k], acc[ai][bj][m][n], 0, 0, 0); __builtin_amdgcn_s_setprio(0); } while (0)
#define PG8_WAIT_V(n) asm volatile("s_waitcnt vmcnt(" #n ")" ::: "memory")
#define PG8_WAIT_L(n) asm volatile("s_waitcnt lgkmcnt(" #n ")" ::: "memory")
#define PG8_BAR __builtin_amdgcn_s_barrier()
#define PG8_SCHED __builtin_amdgcn_sched_barrier(0)
    Unit cur, nxt; int ui = 0;
    if (!S.next(0, cur)) return;
    f32x4 acc[2][2][4][2];
#pragma unroll
    for (int a = 0; a < 2; ++a)
#pragma unroll
        for (int b = 0; b < 2; ++b)
#pragma unroll
            for (int m = 0; m < 4; ++m)
#pragma unroll
                for (int n = 0; n < 2; ++n) acc[a][b][m][n] = (f32x4){0.f, 0.f, 0.f, 0.f};
    bf16x8 At[4][2], B0[2][2], B1[2][2];
    const char* cA = (const char*)g.A + (size_t)cur.pm * tstepA; const char* cB = (const char*)g.Bt + (size_t)cur.pn * tstepB;
    PG8_STAGE(PG8_SB(0, 0), cB, voffB); PG8_STAGE(PG8_SB(0, 1), cB + hstepB, voffB); PG8_STAGE(PG8_SA(0, 0), cA, voffA); PG8_STAGE(PG8_SA(0, 1), cA + hstepA, voffA);
    if (wr == 1) PG8_BAR;
    PG8_WAIT_V(2); PG8_BAR;
    PG8_STAGE(PG8_SB(1, 0), cB + kstep, voffB); PG8_STAGE(PG8_SA(1, 0), cA + kstep, voffA); PG8_STAGE(PG8_SB(1, 1), cB + hstepB + kstep, voffB);
    PG8_WAIT_V(6); PG8_BAR;
    for (;;) {
        const bool has_next = S.next(ui + 1, nxt);
        const char* nA = has_next ? (const char*)g.A + (size_t)nxt.pm * tstepA : cA; const char* nB = has_next ? (const char*)g.Bt + (size_t)nxt.pn * tstepB : cB;
        for (int t = 0; t < nt; t += 2) {
            const bool last = (t == nt - 2);
            const char* a1 = cA + (size_t)(t + 1) * kstep;
            const char* a2 = last ? nA : cA + (size_t)(t + 2) * kstep; const char* b2 = last ? nB : cB + (size_t)(t + 2) * kstep;
            const char* a3 = a2 + kstep; const char* b3 = b2 + kstep;
            PG8_LDB(B0, 0, 0); PG8_LDB(B1, 0, 1); PG8_SCHED; PG8_LDA(At, 0, 0); PG8_STAGE(PG8_SA(1, 1), a1 + hstepA, voffA);
            PG8_WAIT_V(8); PG8_WAIT_L(0); PG8_BAR; PG8_MMA(0, 0, At, B0); PG8_MMA(0, 1, At, B1); PG8_BAR; PG8_SCHED;
            PG8_LDA(At, 0, 1); PG8_STAGE(PG8_SB(0, 0), b2, voffB); PG8_STAGE(PG8_SB(0, 1), b2 + hstepB, voffB); PG8_STAGE(PG8_SA(0, 0), a2, voffA);
            PG8_WAIT_V(8); PG8_WAIT_L(0); PG8_BAR; PG8_MMA(1, 0, At, B0); PG8_MMA(1, 1, At, B1); PG8_BAR; PG8_SCHED;
            PG8_LDB(B0, 1, 0); PG8_LDB(B1, 1, 1); PG8_SCHED; PG8_LDA(At, 1, 0); PG8_STAGE(PG8_SA(0, 1), a2 + hstepA, voffA);
            PG8_WAIT_V(8); PG8_WAIT_L(0); PG8_BAR; PG8_MMA(0, 0, At, B0); PG8_MMA(0, 1, At, B1); PG8_BAR; PG8_SCHED;
            PG8_LDA(At, 1, 1); PG8_STAGE(PG8_SB(1, 0), b3, voffB); PG8_STAGE(PG8_SB(1, 1), b3 + hstepB, voffB); PG8_STAGE(PG8_SA(1, 0), a3, voffA);
            PG8_WAIT_V(8); PG8_WAIT_L(0); PG8_BAR; PG8_MMA(1, 0, At, B0); PG8_MMA(1, 1, At, B1); PG8_BAR; PG8_SCHED;
        }
        if (wr == 0) PG8_BAR;
        { const int l2_ = otid() & 63; E(acc, cur, wr, wc, l2_ & 15, l2_ >> 4); }
        if (!has_next) break;
#pragma unroll
        for (int a = 0; a < 2; ++a)
#pragma unroll
            for (int b = 0; b < 2; ++b)
#pragma unroll
                for (int m = 0; m < 4; ++m)
#pragma unroll
                    for (int n = 0; n < 2; ++n) acc[a][b][m][n] = (f32x4){0.f, 0.f, 0.f, 0.f};
        cur = nxt; cA = nA; cB = nB; ++ui;
        if (wr == 1) PG8_BAR;
    }
    PG8_WAIT_V(0);
    PG8_BAR;
#undef PG8_SA
#undef PG8_SB
#undef PG8_STAGE
#undef PG8_LDA
#undef PG8_LDB
#undef PG8_MMA
#undef PG8_WAIT_V
#undef PG8_WAIT_L
#undef PG8_BAR
#undef PG8_SCHED
}

template <int ACT> struct EpiBf16 {
    static constexpr bool PERM = true;
    bf16_t* O; int ldc;
    __device__ __forceinline__ void operator()(const f32x4 (&acc)[2][2][4][2], const Unit& u, int wr, int wc, int fr, int fq) const {
        const int row0 = u.pm * BM + wr * 64 + fr, col0 = u.pn * BM + wc * 32 + 8 * fq;
#pragma unroll
        for (int ai = 0; ai < 2; ++ai)
#pragma unroll
            for (int m = 0; m < 4; ++m) { bf16_t* rowp = O + (size_t)(row0 + ai * HALF + m * 16) * ldc + col0;
#pragma unroll
                for (int bj = 0; bj < 2; ++bj) { f32x4 v0 = acc[ai][bj][m][0], v1 = acc[ai][bj][m][1];
                    if (ACT == 1) { f32x2 a = gelu_pk((f32x2){v0[0], v0[1]}), b = gelu_pk((f32x2){v0[2], v0[3]}), c = gelu_pk((f32x2){v1[0], v1[1]}), d = gelu_pk((f32x2){v1[2], v1[3]});
                        v0 = (f32x4){a.x, a.y, b.x, b.y}; v1 = (f32x4){c.x, c.y, d.x, d.y}; }
                    u32x4 w; w.x = cvt_pk_bf16(v0[0], v0[1]); w.y = cvt_pk_bf16(v0[2], v0[3]); w.z = cvt_pk_bf16(v1[0], v1[1]); w.w = cvt_pk_bf16(v1[2], v1[3]);
                    *(u32x4*)(rowp + bj * HALF) = w; } }
    }
};
struct EpiGmIn {
    static constexpr bool PERM = true;
    bf16_t* O; float* parts;
    __device__ __forceinline__ void operator()(const f32x4 (&acc)[2][2][4][2], const Unit& u, int wr, int wc, int fr, int fq) const {
        const int row0 = u.pm * BM + wr * 64 + fr, col0 = u.pn * BM + wc * 32 + 8 * fq; const bool vhalf = u.pn >= 8;
#pragma unroll
        for (int ai = 0; ai < 2; ++ai)
#pragma unroll
            for (int m = 0; m < 4; ++m) { const int row = row0 + ai * HALF + m * 16; bf16_t* rowp = O + (size_t)row * 4096 + col0; f32x2 sa = {0.f, 0.f}, sq = {0.f, 0.f};
#pragma unroll
                for (int bj = 0; bj < 2; ++bj) { const f32x4 v0 = acc[ai][bj][m][0], v1 = acc[ai][bj][m][1];
                    const f32x2 a = gelu_pk((f32x2){v0[0], v0[1]}), b = gelu_pk((f32x2){v0[2], v0[3]}), c = gelu_pk((f32x2){v1[0], v1[1]}), d = gelu_pk((f32x2){v1[2], v1[3]});
                    sa += (a + b) + (c + d); sq += (a * a + b * b) + (c * c + d * d);
                    u32x4 w; w.x = cvt_pk_bf16(a.x, a.y); w.y = cvt_pk_bf16(b.x, b.y); w.z = cvt_pk_bf16(c.x, c.y); w.w = cvt_pk_bf16(d.x, d.y);
                    *(u32x4*)(rowp + bj * HALF) = w; }
                if (vhalf) { float s1 = sa.x + sa.y, s2 = sq.x + sq.y;
                    { auto r = __builtin_amdgcn_permlane16_swap(__float_as_uint(s1), __float_as_uint(s1), false, false); s1 = __uint_as_float(r[0]) + __uint_as_float(r[1]); }
                    { auto r = __builtin_amdgcn_permlane16_swap(__float_as_uint(s2), __float_as_uint(s2), false, false); s2 = __uint_as_float(r[0]) + __uint_as_float(r[1]); }
                    { auto r = __builtin_amdgcn_permlane32_swap(__float_as_uint(s1), __float_as_uint(s1), false, false); s1 = __uint_as_float(r[0]) + __uint_as_float(r[1]); }
                    { auto r = __builtin_amdgcn_permlane32_swap(__float_as_uint(s2), __float_as_uint(s2), false, false); s2 = __uint_as_float(r[0]) + __uint_as_float(r[1]); }
                    if (fq == 0) *(f32x2*)(parts + ((size_t)row * 32 + (u.pn - 8) * 4 + wc) * 2) = (f32x2){s1, s2}; } }
    }
};
struct EpiResid {
    static constexpr bool PERM = true;
    bf16_t* X; const float* gate;
    __device__ __forceinline__ void operator()(const f32x4 (&acc)[2][2][4][2], const Unit& u, int wr, int wc, int fr, int fq) const {
        const int rbase = u.pm * BM;
        const float* gp = gate + (size_t)(rbase < NLAT ? (rbase >> 13) : 4) * 6144;
        const int row0 = rbase + wr * 64 + fr, col0 = u.pn * BM + wc * 32 + 8 * fq;
        f32x4 gv[2][2];
#pragma unroll
        for (int bj = 0; bj < 2; ++bj)
#pragma unroll
            for (int n = 0; n < 2; ++n) gv[bj][n] = *(const f32x4*)(gp + col0 + bj * HALF + n * 4);
#pragma unroll
        for (int ai = 0; ai < 2; ++ai)
#pragma unroll
            for (int m = 0; m < 4; ++m) { bf16_t* rowp = X + (size_t)(row0 + ai * HALF + m * 16) * D + col0;
#pragma unroll
                for (int bj = 0; bj < 2; ++bj) { u32x4* p = (u32x4*)(rowp + bj * HALF); const u32x4 x = *p;
                    const f32x4 a0 = (f32x4){bflo(x.x), bfhi(x.x), bflo(x.y), bfhi(x.y)} + gv[bj][0] * acc[ai][bj][m][0], a1 = (f32x4){bflo(x.z), bfhi(x.z), bflo(x.w), bfhi(x.w)} + gv[bj][1] * acc[ai][bj][m][1];
                    u32x4 w; w.x = cvt_pk_bf16(a0[0], a0[1]); w.y = cvt_pk_bf16(a0[2], a0[3]); w.z = cvt_pk_bf16(a1[0], a1[1]); w.w = cvt_pk_bf16(a1[2], a1[3]);
                    *p = w; } }
    }
};
}

namespace att {
#define KSWZ(row, colB) ((row) * 256 + ((colB) ^ (((row) & 7) << 4)))
#define KRSWZ(row, colB) ((row) * 128 + ((colB) ^ ((((row) >> 1) & 7) << 4)))
#define SBAR() __builtin_amdgcn_sched_barrier(0)
__device__ __forceinline__ int crow(int r, int hi) { return (r & 3) + 8 * (r >> 2) + 4 * hi; }
__host__ __device__ __forceinline__ int v_st(int k, int c) { const int kk = (k & ~0xC) | ((k & 4) << 1) | ((k & 8) >> 1); return ((kk >> 3) * 4 + (c >> 5)) * 512 + ((kk & 7) * 32 + (c & 31)) * 2; }
__device__ __forceinline__ int v_rd_base(int lane) { return ((lane & 3) << 3) | (((lane >> 2) & 3) << 6) | (((lane >> 4) & 1) << 5) | (((lane >> 5) & 1) << 8); }
constexpr int v_rd_off(int d0, int ks, int half) { return d0 * 512 + ks * 4096 + half * 2048; }
template <int OFF> __device__ __forceinline__ s16x4 tr_read(int vb) {
    s16x4 r; asm volatile("ds_read_b64_tr_b16 %0, %1 offset:%2" : "=&v"(r) : "v"(vb), "i"(OFF) : "memory"); return r;
}
template <int D0> __device__ __forceinline__ void pv_one(f32x16& od, int vb, bf16x8 pa0, bf16x8 pa1, bf16x8 pa2, bf16x8 pa3) {
    const s16x4 l0 = tr_read<v_rd_off(D0, 0, 0)>(vb), h0 = tr_read<v_rd_off(D0, 0, 1)>(vb), l1 = tr_read<v_rd_off(D0, 1, 0)>(vb), h1 = tr_read<v_rd_off(D0, 1, 1)>(vb);
    const s16x4 l2 = tr_read<v_rd_off(D0, 2, 0)>(vb), h2 = tr_read<v_rd_off(D0, 2, 1)>(vb), l3 = tr_read<v_rd_off(D0, 3, 0)>(vb), h3 = tr_read<v_rd_off(D0, 3, 1)>(vb);
    asm volatile("s_waitcnt lgkmcnt(0)" ::: "memory"); SBAR();
#define PK(L, H) (bf16x8){L[0], L[1], L[2], L[3], H[0], H[1], H[2], H[3]}
    od = __builtin_amdgcn_mfma_f32_32x32x16_bf16(pa0, PK(l0, h0), od, 0, 0, 0);
    od = __builtin_amdgcn_mfma_f32_32x32x16_bf16(pa1, PK(l1, h1), od, 0, 0, 0);
    od = __builtin_amdgcn_mfma_f32_32x32x16_bf16(pa2, PK(l2, h2), od, 0, 0, 0);
    od = __builtin_amdgcn_mfma_f32_32x32x16_bf16(pa3, PK(l3, h3), od, 0, 0, 0);
#undef PK
}
__device__ __forceinline__ void pv_d0(f32x16* o, int vb, bf16x8 pa0, bf16x8 pa1, bf16x8 pa2, bf16x8 pa3) {
    pv_one<0>(o[0], vb, pa0, pa1, pa2, pa3); pv_one<1>(o[1], vb, pa0, pa1, pa2, pa3); pv_one<2>(o[2], vb, pa0, pa1, pa2, pa3); pv_one<3>(o[3], vb, pa0, pa1, pa2, pa3);
}
}

namespace att8 {
constexpr int SLOT = 20480, KN_OFF = 0, KR_OFF = 8192, V_OFF = 12288, LDS_BYTES = 3 * SLOT + 8 * 256;
constexpr float THR2 = 8.0f;
constexpr float QUP = 8.f; constexpr int SC_ONE = 0x7f7f7f7f, SC_Q = 0x7c7c7c7c;
__host__ __device__ __forceinline__ int kn8(int key, int b) { return key * 128 + ((((b >> 4) ^ ((key >> 1) & 7))) << 4) + (b & 15); }
__host__ __device__ __forceinline__ int kr8(int key, int b) { return key * 64 + ((((b >> 4) ^ ((key >> 2) & 3))) << 4) + (b & 15); }
__host__ __device__ __forceinline__ int vslot(int k) { return 32 * ((k >> 2) & 1) + 16 * (k >> 5) + (k & 3) + 4 * ((k & 31) >> 3); }
__host__ __device__ __forceinline__ int v8(int d, int k) { const int sl = vslot(k); return d * 64 + ((((sl >> 4) ^ ((d >> 2) & 3))) << 4) + (sl & 15); }
__device__ __forceinline__ i32x8 ld32(const LAS unsigned char* a0, const LAS unsigned char* a1) { const u32x4 x = *(const LAS u32x4*)a0, y = *(const LAS u32x4*)a1;
    return (i32x8){(int)x.x, (int)x.y, (int)x.z, (int)x.w, (int)y.x, (int)y.y, (int)y.z, (int)y.w}; }
__device__ __forceinline__ void qkt(f32x16& p0, f32x16& p1, LAS unsigned char* slot, const i32x8* qf, int r32, int hi) {
    p0 = f32x16{}; p1 = f32x16{};
#pragma unroll
    for (int ks = 0; ks < 2; ++ks) { const int b = 64 * ks + 32 * hi;
        const i32x8 a0 = ld32(slot + KN_OFF + kn8(r32, b), slot + KN_OFF + kn8(r32, b + 16)), a1 = ld32(slot + KN_OFF + kn8(32 + r32, b), slot + KN_OFF + kn8(32 + r32, b + 16));
        p0 = __builtin_amdgcn_mfma_scale_f32_32x32x64_f8f6f4(a0, qf[ks], p0, 0, 0, 0, SC_ONE, 0, SC_Q);
        p1 = __builtin_amdgcn_mfma_scale_f32_32x32x64_f8f6f4(a1, qf[ks], p1, 0, 0, 0, SC_ONE, 0, SC_Q); }
    { const int b = 32 * hi;
        const i32x8 a0 = ld32(slot + KR_OFF + kr8(r32, b), slot + KR_OFF + kr8(r32, b + 16)), a1 = ld32(slot + KR_OFF + kr8(32 + r32, b), slot + KR_OFF + kr8(32 + r32, b + 16));
        p0 = __builtin_amdgcn_mfma_scale_f32_32x32x64_f8f6f4(a0, qf[2], p0, 0, 0, 0, SC_ONE, 0, SC_Q);
        p1 = __builtin_amdgcn_mfma_scale_f32_32x32x64_f8f6f4(a1, qf[2], p1, 0, 0, 0, SC_ONE, 0, SC_Q); }
}
__device__ __forceinline__ void partialSM(f32x16& p0, f32x16& p1, float& m_reg, float& mn, float& alpha) {
    float pmax = p0[0];
#pragma unroll
    for (int r = 1; r < 16; ++r) pmax = fmaxf(pmax, p0[r]);
#pragma unroll
    for (int r = 0; r < 16; ++r) pmax = fmaxf(pmax, p1[r]);
    { auto rr = __builtin_amdgcn_permlane32_swap(__float_as_uint(pmax), __float_as_uint(pmax), false, false);
      pmax = fmaxf(__uint_as_float(rr[0]), __uint_as_float(rr[1])); }
    if (__builtin_expect(__all(pmax - m_reg <= THR2), 1)) { mn = m_reg; alpha = 1.f; }
    else { mn = fmaxf(m_reg, pmax); alpha = __builtin_amdgcn_exp2f(m_reg - mn); m_reg = mn; }
#pragma unroll
    for (int r = 0; r < 16; ++r) p0[r] = __builtin_amdgcn_exp2f(p0[r] - mn);
#pragma unroll
    for (int r = 0; r < 16; ++r) p1[r] = p1[r] - mn;
}
__device__ __forceinline__ void finishSM(f32x16& p0, f32x16& p1, float alpha, float& l_reg, i32x8& pf) {
#pragma unroll
    for (int r = 0; r < 16; ++r) p1[r] = __builtin_amdgcn_exp2f(p1[r]);
    float ps = 0;
#pragma unroll
    for (int r = 0; r < 16; ++r) ps += p0[r];
#pragma unroll
    for (int r = 0; r < 16; ++r) ps += p1[r];
    { auto rr = __builtin_amdgcn_permlane32_swap(__float_as_uint(ps), __float_as_uint(ps), false, false);
      ps = __uint_as_float(rr[0]) + __uint_as_float(rr[1]); }
    l_reg = l_reg * alpha + ps;
#pragma unroll
    for (int w = 0; w < 4; ++w) { pf[w] = (int)pk4_fp8(p0[4 * w], p0[4 * w + 1], p0[4 * w + 2], p0[4 * w + 3]); pf[4 + w] = (int)pk4_fp8(p1[4 * w], p1[4 * w + 1], p1[4 * w + 2], p1[4 * w + 3]); }
}
__device__ __forceinline__ void pv(f32x16* o, LAS unsigned char* slot, const i32x8 pf, int r32, int hi) {
#pragma unroll
    for (int d0 = 0; d0 < 4; ++d0) { const int d = 32 * d0 + r32, sw = (d >> 2) & 3;
        const i32x8 b = ld32(slot + V_OFF + d * 64 + (((2 * hi) ^ sw) << 4), slot + V_OFF + d * 64 + (((2 * hi + 1) ^ sw) << 4));
        o[d0] = __builtin_amdgcn_mfma_scale_f32_32x32x64_f8f6f4(pf, b, o[d0], 0, 0, 0, SC_ONE, 0, SC_ONE); }
}
__device__ __forceinline__ int crow(int r, int hi) { return (r & 3) + 8 * (r >> 2) + 4 * hi; }
__device__ __forceinline__ void attn_unit(const unsigned char* __restrict__ Qb, const unsigned char* __restrict__ KNt, const unsigned char* __restrict__ KRt, const unsigned char* __restrict__ Vt,
                                          bf16_t* __restrict__ Ob, int NT, LAS unsigned char* lds) {
    const int tid = otid(), wid = __builtin_amdgcn_readfirstlane(tid >> 6), lane = tid & 63, r32 = lane & 31, hi = lane >> 5;
    LAS float* wsf = (LAS float*)(lds + 3 * SLOT) + wid * 64; LAS float* li_l = wsf; LAS float* al_l = wsf + 32;
    float m_reg = -1e30f, l_reg = 0; f32x16 o[4] = {}; i32x8 qf[3];
    const unsigned char* Qw = Qb + (size_t)(wid * 32 + r32) * 192 + 32 * hi;
#pragma unroll
    for (int ks = 0; ks < 3; ++ks) { const u32x4 x = *(const u32x4*)(Qw + 64 * ks), y = *(const u32x4*)(Qw + 64 * ks + 16); qf[ks] = (i32x8){(int)x.x, (int)x.y, (int)x.z, (int)x.w, (int)y.x, (int)y.y, (int)y.z, (int)y.w}; }
    const unsigned lo16 = (unsigned)lane * 16u;
#define ATT_DMA(tile, slotoff) do { const size_t t_ = (size_t)(tile); LAS unsigned char* sl_ = lds + (slotoff); \
        __builtin_amdgcn_global_load_lds((const unsigned*)(KNt + t_ * 8192 + wid * 1024 + lo16), (LAS unsigned*)(sl_ + KN_OFF + wid * 1024), 16, 0, 0); \
        __builtin_amdgcn_global_load_lds((const unsigned*)(Vt + t_ * 8192 + wid * 1024 + lo16), (LAS unsigned*)(sl_ + V_OFF + wid * 1024), 16, 0, 0); \
        if (wid < 4) __builtin_amdgcn_global_load_lds((const unsigned*)(KRt + t_ * 4096 + wid * 1024 + lo16), (LAS unsigned*)(sl_ + KR_OFF + wid * 1024), 16, 0, 0); } while (0)
#define ATT_SYNC() do { asm volatile("s_waitcnt vmcnt(0)" ::: "memory"); __builtin_amdgcn_s_barrier(); asm volatile("" ::: "memory"); } while (0)
#define RESC(a) do { if (__any((a) < 1.f)) { if (hi == 0) al_l[r32] = (a); asm volatile("s_waitcnt lgkmcnt(0)" ::: "memory"); \
        _Pragma("unroll") for (int d = 0; d < 4; ++d) _Pragma("unroll") for (int r = 0; r < 16; ++r) o[d][r] *= al_l[crow(r, hi)]; } } while (0)
    f32x16 pA0, pA1, pB0, pB1; float mnA, mnB, alA, alB; i32x8 pf;
    int sp = 0, sc = SLOT, sn = 2 * SLOT;
    ATT_DMA(0, 0);
    ATT_SYNC();
    ATT_DMA(1, SLOT);
    qkt(pA0, pA1, lds, qf, r32, hi); partialSM(pA0, pA1, m_reg, mnA, alA);
    for (int j = 1; j + 1 < NT; j += 2) {
        ATT_SYNC(); ATT_DMA(j + 1, sn);
        SBAR(); qkt(pB0, pB1, lds + sc, qf, r32, hi);
        finishSM(pA0, pA1, alA, l_reg, pf); SBAR();
        pv(o, lds + sp, pf, r32, hi); partialSM(pB0, pB1, m_reg, mnB, alB);
        RESC(alB);
        { const int t_ = sp; sp = sc; sc = sn; sn = t_; }
        ATT_SYNC(); if (j + 2 < NT) ATT_DMA(j + 2, sn);
        SBAR(); qkt(pA0, pA1, lds + sc, qf, r32, hi);
        finishSM(pB0, pB1, alB, l_reg, pf); SBAR();
        pv(o, lds + sp, pf, r32, hi); partialSM(pA0, pA1, m_reg, mnA, alA);
        RESC(alA);
        { const int t_ = sp; sp = sc; sc = sn; sn = t_; }
    }
    ATT_SYNC();
    SBAR(); qkt(pB0, pB1, lds + sc, qf, r32, hi);
    finishSM(pA0, pA1, alA, l_reg, pf); SBAR();
    pv(o, lds + sp, pf, r32, hi); partialSM(pB0, pB1, m_reg, mnB, alB);
    RESC(alB);
    finishSM(pB0, pB1, alB, l_reg, pf); SBAR();
    pv(o, lds + sc, pf, r32, hi);
    if (hi == 0) li_l[r32] = l_reg; asm volatile("s_waitcnt lgkmcnt(0)" ::: "memory");
    float rli[16];
#pragma unroll
    for (int r = 0; r < 16; ++r) rli[r] = __builtin_amdgcn_rcpf(li_l[crow(r, hi)]);
    bf16_t* Ow = Ob + (size_t)(wid * 32) * 2048;
#pragma unroll
    for (int r = 0; r < 16; ++r) { const int orow = crow(r, hi);
#pragma unroll
        for (int d0 = 0; d0 < 4; ++d0) Ow[(size_t)orow * 2048 + d0 * 32 + r32] = f2bf(o[d0][r] * rli[r]); }
    __builtin_amdgcn_s_barrier(); asm volatile("" ::: "memory");
#undef ATT_DMA
#undef ATT_SYNC
#undef RESC
}
}

namespace ssd {
constexpr int XT_OFF = 0, BT_OFF = 17408, HB_OFF = 52224, SET = 69632, CW_OFF = 2 * SET, LDS_BYTES = CW_OFF + 8 * 1536;
constexpr int PITCH = 272;
constexpr float L2E = 1.4426950408889634f;
__device__ __forceinline__ void g_unit(const bf16_t* __restrict__ BC, bf16_t* __restrict__ G, int unit) {
    const int cid = unit >> 1, g = unit & 1;
    const int r0 = cid < 256 ? cid * 128 : NLAT + (cid - 256) * 128;
    const int tid = otid(), wid = tid >> 6, lane = tid & 63, fr = lane & 15, fq = lane >> 4;
    const bf16_t* Cp = BC + (size_t)(r0 + 16 * wid + fr) * 512 + 256 + 128 * g + 8 * fq;
    bf16x8 cf[4];
#pragma unroll
    for (int ks = 0; ks < 4; ++ks) cf[ks] = *(const bf16x8*)(Cp + 32 * ks);
    bf16_t* Gp = G + ((size_t)unit * 128 + 16 * wid + fr) * 128 + 4 * fq;
#pragma unroll
    for (int sb = 0; sb < 8; ++sb) {
        const bf16_t* Bp = BC + (size_t)(r0 + 16 * sb + fr) * 512 + 128 * g + 8 * fq;
        f32x4 acc = {0.f, 0.f, 0.f, 0.f};
#pragma unroll
        for (int ks = 0; ks < 4; ++ks) { const bf16x8 bfr = *(const bf16x8*)(Bp + 32 * ks); acc = __builtin_amdgcn_mfma_f32_16x16x32_bf16(bfr, cf[ks], acc, 0, 0, 0); }
        u32x2 w; w.x = cvt_pk_bf16(acc[0], acc[1]); w.y = cvt_pk_bf16(acc[2], acc[3]);
        *(u32x2*)(Gp + 16 * sb) = w;
    }
}
__device__ __forceinline__ void ssd_unit(int b, int h, int d, const bf16_t* __restrict__ XS, const bf16_t* __restrict__ BC, const float* __restrict__ DT, const bf16_t* __restrict__ G,
                                         const float* __restrict__ a_log, bf16_t* __restrict__ Y, LAS unsigned char* lds) {
    const int g = h >> 3;
    const int tid = otid(), wid = tid >> 6, lane = tid & 63, fr = lane & 15, fq = lane >> 4;
    const float a = -__expf(a_log[d * 16 + h]);
    LAS float* cw = (LAS float*)(lds + CW_OFF + wid * 1536); LAS float* dts = cw + 128; LAS float* dtw = cw + 256;
    f32x4 hs[4];
#pragma unroll
    for (int q = 0; q < 4; ++q) hs[q] = (f32x4){0.f, 0.f, 0.f, 0.f};
    for (int i = tid; i < 17408 / 4; i += 512) ((LAS unsigned*)(lds + HB_OFF))[i] = 0u;
    float cend = 0.f;
#define SSD_ROWS(step, r0v, gidv) do { if ((step) < 2) { const int oc_ = d ? 1 - (step) : (step); r0v = NLAT + b * 256 + oc_ * 128; gidv = 256 + b * 2 + oc_; } \
        else { const int lc_ = (step) - 2, oc_ = d ? 63 - lc_ : lc_; r0v = b * 8192 + oc_ * 128; gidv = b * 64 + oc_; } } while (0)
    const int sg = tid & 31, n8 = tid >> 5, p4 = tid >> 5;
    f32x2 P_da, Q_da; u32x2 P_xv[4], Q_xv[4]; u32x4 P_bv[4], Q_bv[4], n_gv[4], n_cv[4], c_gv[4], c_cv[4];
#define SSD_LOAD(step, X) do { int r0_, gid_; SSD_ROWS(step, r0_, gid_); (void)gid_; X##_da = *(const f32x2*)(DT + (size_t)(d * 16 + h) * NROW + r0_ + 2 * lane); \
        _Pragma("unroll") for (int j_ = 0; j_ < 4; ++j_) { X##_xv[j_] = *(const u32x2*)(XS + (size_t)(r0_ + 4 * sg + j_) * 1024 + 64 * h + 4 * p4); \
                                                         X##_bv[j_] = *(const u32x4*)(BC + (size_t)(r0_ + 4 * sg + j_) * 512 + 128 * g + 8 * n8); } } while (0)
#define SSD_LOADGC(step) do { int r0_, gid_; SSD_ROWS(step, r0_, gid_); const int t_ = 16 * wid + fr; const bf16_t* Gp_ = G + ((size_t)(gid_ * 2 + g) * 128 + t_) * 128 + 8 * fq; const bf16_t* Cp_ = BC + (size_t)(r0_ + t_) * 512 + 256 + 128 * g + 8 * fq; \
          _Pragma("unroll") for (int ks_ = 0; ks_ < 4; ++ks_) { n_gv[ks_] = *(const u32x4*)(Gp_ + 32 * ks_); n_cv[ks_] = *(const u32x4*)(Cp_ + 32 * ks_); } } while (0)
#define SSD_GCROT() do { _Pragma("unroll") for (int ks_ = 0; ks_ < 4; ++ks_) { c_gv[ks_] = n_gv[ks_]; c_cv[ks_] = n_cv[ks_]; } } while (0)
#define SSD_WRITE(step, X) do { LAS unsigned char* set_ = lds + ((step) & 1) * SET; \
        const float da0 = X##_da.x * a, da1 = X##_da.y * a; \
        float sc_ = da0 + da1; float c0_, c1_; \
        if (d == 0) { _Pragma("unroll") for (int o_ = 1; o_ < 64; o_ <<= 1) { const float t_ = __shfl_up(sc_, o_); if (lane >= o_) sc_ += t_; } \
            c0_ = sc_ - da1; c1_ = sc_; cend = __shfl(sc_, 63); } \
        else { _Pragma("unroll") for (int o_ = 1; o_ < 64; o_ <<= 1) { const float t_ = __shfl_down(sc_, o_); if (lane + o_ < 64) sc_ += t_; } \
            c0_ = sc_; c1_ = sc_ - da0; cend = __shfl(sc_, 0); } \
        *(LAS f32x2*)(cw + 2 * lane) = (f32x2){c0_, c1_}; *(LAS f32x2*)(dts + 2 * lane) = X##_da; \
        *(LAS f32x2*)(dtw + 2 * lane) = (f32x2){X##_da.x * __builtin_amdgcn_exp2f((cend - c0_) * L2E), X##_da.y * __builtin_amdgcn_exp2f((cend - c1_) * L2E)}; \
        { LAS unsigned char* xt_ = set_ + XT_OFF + (4 * p4) * PITCH + 8 * sg; \
          _Pragma("unroll") for (int i_ = 0; i_ < 4; ++i_) { unsigned e_[4]; \
              _Pragma("unroll") for (int j_ = 0; j_ < 4; ++j_) { const unsigned w_ = (i_ & 2) ? X##_xv[j_].y : X##_xv[j_].x; e_[j_] = (i_ & 1) ? (w_ >> 16) : (w_ & 0xffffu); } \
              u32x2 o_; o_.x = e_[0] | (e_[1] << 16); o_.y = e_[2] | (e_[3] << 16); *(LAS u32x2*)(xt_ + i_ * PITCH) = o_; } } \
        { LAS unsigned char* bt_ = set_ + BT_OFF + (8 * n8) * PITCH + 8 * sg; \
          _Pragma("unroll") for (int i_ = 0; i_ < 8; ++i_) { unsigned e_[4]; \
              _Pragma("unroll") for (int j_ = 0; j_ < 4; ++j_) { const unsigned w_ = X##_bv[j_][i_ >> 1]; e_[j_] = (i_ & 1) ? (w_ >> 16) : (w_ & 0xffffu); } \
              u32x2 o_; o_.x = e_[0] | (e_[1] << 16); o_.y = e_[2] | (e_[3] << 16); *(LAS u32x2*)(bt_ + i_ * PITCH) = o_; } } \
        asm volatile("s_waitcnt lgkmcnt(0)" ::: "memory"); \
    } while (0)
    SSD_LOAD(0, Q); SSD_LOADGC(0); SSD_WRITE(0, Q); SSD_LOAD(1, P);
    for (int step2 = 0; step2 < 66; step2 += 2)
#pragma unroll
    for (int par = 0; par < 2; ++par) {
        const int step = step2 + par;
        __syncthreads();
        int r0, gid; SSD_ROWS(step, r0, gid); (void)gid;
        LAS unsigned char* set = lds + (step & 1) * SET;
        const float cend_cur = cend;
        SSD_GCROT();
        if (step + 1 < 66) SSD_LOADGC(step + 1);
        if (step + 2 < 66) { if (par == 0) SSD_LOAD(step + 2, Q); else SSD_LOAD(step + 2, P); }
        {
            const int t = 16 * wid + fr; const float ct = cw[t];
            f32x4 y[4];
#pragma unroll
            for (int q = 0; q < 4; ++q) y[q] = (f32x4){0.f, 0.f, 0.f, 0.f};
            const float et = __builtin_amdgcn_exp2f(ct * L2E);
#pragma unroll
            for (int ks = 0; ks < 4; ++ks) {
                const bool live = d == 0 ? (32 * ks <= 16 * wid + 15) : (32 * ks + 31 >= 16 * wid);
                if (live) {
                    const int s0 = 32 * ks + 8 * fq;
                    const f32x4 c0 = *(const LAS f32x4*)(cw + s0), c1 = *(const LAS f32x4*)(cw + s0 + 4), d0v = *(const LAS f32x4*)(dts + s0), d1v = *(const LAS f32x4*)(dts + s0 + 4);
                    float m[8];
#pragma unroll
                    for (int i = 0; i < 8; ++i) { const float cs = i < 4 ? c0[i & 3] : c1[i & 3], dv = i < 4 ? d0v[i & 3] : d1v[i & 3]; const int s = s0 + i;
                        const bool ok = d == 0 ? (s <= t) : (s >= t);
                        const float gval = (i & 1) ? bfhi(c_gv[ks][i >> 1]) : bflo(c_gv[ks][i >> 1]);
                        m[i] = ok ? gval * dv * __builtin_amdgcn_exp2f((ct - cs) * L2E) : 0.f; }
                    u32x4 mw; mw.x = cvt_pk_bf16(m[0], m[1]); mw.y = cvt_pk_bf16(m[2], m[3]); mw.z = cvt_pk_bf16(m[4], m[5]); mw.w = cvt_pk_bf16(m[6], m[7]);
                    const bf16x8 mb = __builtin_bit_cast(bf16x8, mw);
#pragma unroll
                    for (int q = 0; q < 4; ++q) { const bf16x8 af = *(const LAS bf16x8*)(set + XT_OFF + (16 * q + fr) * PITCH + (32 * ks + 8 * fq) * 2);
                        y[q] = __builtin_amdgcn_mfma_f32_16x16x32_bf16(af, mb, y[q], 0, 0, 0); }
                }
            }
#pragma unroll
            for (int ks = 0; ks < 4; ++ks) {
                u32x4 cwv;
#pragma unroll
                for (int i = 0; i < 4; ++i) cwv[i] = cvt_pk_bf16(bflo(c_cv[ks][i]) * et, bfhi(c_cv[ks][i]) * et);
                const bf16x8 cb = __builtin_bit_cast(bf16x8, cwv);
#pragma unroll
                for (int q = 0; q < 4; ++q) { const bf16x8 af = *(const LAS bf16x8*)(set + HB_OFF + (16 * q + fr) * PITCH + (32 * ks + 8 * fq) * 2);
                    y[q] = __builtin_amdgcn_mfma_f32_16x16x32_bf16(af, cb, y[q], 0, 0, 0); }
            }
            bf16_t* yp = Y + (size_t)(r0 + t) * 1024 + 64 * h + 4 * fq;
#pragma unroll
            for (int q = 0; q < 4; ++q) { u32x2 w; w.x = cvt_pk_bf16(y[q][0], y[q][1]); w.y = cvt_pk_bf16(y[q][2], y[q][3]); *(u32x2*)(yp + 16 * q) = w; }
        }
        {
            const float dec = __builtin_amdgcn_exp2f(cend_cur * L2E);
#pragma unroll
            for (int q = 0; q < 4; ++q) hs[q] = hs[q] * dec;
#pragma unroll
            for (int ks = 0; ks < 4; ++ks) {
                const int s0 = 32 * ks + 8 * fq;
                const u32x4 braw = *(const LAS u32x4*)(set + BT_OFF + (16 * wid + fr) * PITCH + s0 * 2);
                const f32x4 w0 = *(const LAS f32x4*)(dtw + s0), w1 = *(const LAS f32x4*)(dtw + s0 + 4);
                u32x4 bw; bw.x = cvt_pk_bf16(bflo(braw.x) * w0[0], bfhi(braw.x) * w0[1]); bw.y = cvt_pk_bf16(bflo(braw.y) * w0[2], bfhi(braw.y) * w0[3]);
                          bw.z = cvt_pk_bf16(bflo(braw.z) * w1[0], bfhi(braw.z) * w1[1]); bw.w = cvt_pk_bf16(bflo(braw.w) * w1[2], bfhi(braw.w) * w1[3]);
                const bf16x8 bfr = __builtin_bit_cast(bf16x8, bw);
#pragma unroll
                for (int q = 0; q < 4; ++q) { const bf16x8 af = *(const LAS bf16x8*)(set + XT_OFF + (16 * q + fr) * PITCH + s0 * 2);
                    hs[q] = __builtin_amdgcn_mfma_f32_16x16x32_bf16(af, bfr, hs[q], 0, 0, 0); }
            }
            LAS bf16_t* hb = (LAS bf16_t*)(lds + ((step + 1) & 1) * SET + HB_OFF) + 16 * wid + fr;
#pragma unroll
            for (int q = 0; q < 4; ++q)
#pragma unroll
                for (int i = 0; i < 4; ++i) hb[(16 * q + 4 * fq + i) * 136] = f2bf(hs[q][i]);
        }
        if (step + 1 < 66) { if (par == 0) SSD_WRITE(step + 1, P); else SSD_WRITE(step + 1, Q); }
    }
    __syncthreads();
#undef SSD_ROWS
#undef SSD_LOAD
#undef SSD_LOADGC
#undef SSD_GCROT
#undef SSD_WRITE
}
}

struct Args { const float* in[32]; float* out; unsigned char* ws; int ph_lo, ph_hi; };
constexpr int NTHR = 512;
constexpr int LDS_BASE = 256;
constexpr int LDS_PHASE = 151808;
constexpr int LDS_BYTES = LDS_BASE + LDS_PHASE;
static_assert(att8::LDS_BYTES <= LDS_PHASE && ssd::LDS_BYTES <= LDS_PHASE && pg8::STAGE_BYTES <= LDS_PHASE, "LDS");

__device__ __forceinline__ void tjob(int j, const Args& A, const float*& src, bf16_t*& dst, int& K, int& N, int& Npad, int& mode, const float*& ks) {
    unsigned char* W = A.ws + WS_W; mode = 0; ks = nullptr;
    if (j < 8) { const int i = j >> 2, w = j & 3; unsigned char* base = W + W_HYB + (size_t)i * WH_SZ;
        if (w == 0)      { src = A.in[I_HWIN] + (size_t)i * 1024 * HYB_IN; dst = (bf16_t*)(base + WH_IN); K = 1024; N = HYB_IN; Npad = HYB_INP; mode = 1; }
        else if (w == 1) { src = A.in[I_WQB] + (size_t)i * 384 * 1536; dst = (bf16_t*)(base + WH_QB); K = 384; N = 1536; Npad = 1536; mode = 2; ks = A.in[I_QNG] + i * 384; }
        else if (w == 2) { src = A.in[I_WKVB] + (size_t)i * 256 * 2048; dst = (bf16_t*)(base + WH_KVB); K = 256; N = 2048; Npad = 2048; ks = A.in[I_KVNG] + i * 256; }
        else             { src = A.in[I_HWOUT] + (size_t)i * 2048 * 1024; dst = (bf16_t*)(base + WH_OUT); K = 2048; N = 1024; Npad = 1024; }
    } else if (j < 12) { const int i = (j - 8) >> 1, w = (j - 8) & 1; unsigned char* base = W + W_GM + (size_t)i * WG_SZ;
        if (w == 0) { src = A.in[I_GWIN] + (size_t)i * 1024 * 4096; dst = (bf16_t*)(base + WG_IN); K = 1024; N = 4096; Npad = 4096; }
        else        { src = A.in[I_GWOUT] + (size_t)i * 2048 * 1024; dst = (bf16_t*)(base + WG_OUT); K = 2048; N = 1024; Npad = 1024; }
    } else { const int l = j - 12; src = A.in[I_PWQ] + (size_t)l * 1024 * 2048; dst = (bf16_t*)(W + W_PEER + (size_t)l * WP_SZ + WP_Q); K = 1024; N = 2048; Npad = 2048; }
}
__device__ __forceinline__ int colmap(int mode, int n, int N) {
    if (mode == 1) { if (n >= N) return -1; if (n < C_KR) return n; const int m = n - C_KR; return C_KR + (m >> 1) + 32 * (m & 1); }
    if (mode == 2) { if (n < 1024) return (n >> 7) * 192 + (n & 127); const int m = n - 1024, h = m >> 6, mm = m & 63; return h * 192 + 128 + (mm >> 1) + 32 * (mm & 1); }
    return n;
}
__device__ __forceinline__ void phase_prologue(const Args& A, LAS unsigned char* lds) {
    const int tid = otid();
    {
        LAS float* tile = (LAS float*)lds;
        int item = blockIdx.x;
        for (int j = 0; j < 16; ++j) {
            const float* src; bf16_t* dst; int K, N, Npad, mode; const float* ks; tjob(j, A, src, dst, K, N, Npad, mode, ks);
            const int nsub = (K % 256 == 0) ? 4 : 2, tk = K / (64 * nsub), tn = Npad / 64, nt = tk * tn;
            for (; item < nt; item += gridDim.x) {
                const int k0 = (item % tk) * 64 * nsub, n0 = (item / tk) * 64;
                { const int k = tid >> 3, cg = tid & 7; float v[4][8];
#pragma unroll
                  for (int t = 0; t < 4; ++t) if (t < nsub) { const float sc = ks ? ks[k0 + 64 * t + k] : 1.f;
#pragma unroll
                      for (int jj = 0; jj < 8; ++jj) { const int oc = colmap(mode, n0 + 8 * cg + jj, N); v[t][jj] = oc >= 0 ? src[(size_t)(k0 + 64 * t + k) * N + oc] * sc : 0.f; } }
#pragma unroll
                  for (int t = 0; t < 4; ++t) if (t < nsub) {
#pragma unroll
                      for (int jj = 0; jj < 8; ++jj) tile[t * 4160 + k * 65 + 8 * cg + jj] = v[t][jj]; } }
                __syncthreads();
                { const int n = tid >> 3, kg = tid & 7;
#pragma unroll
                  for (int t = 0; t < 4; ++t) if (t < nsub) { float v[8];
#pragma unroll
                      for (int jj = 0; jj < 8; ++jj) v[jj] = tile[t * 4160 + (8 * kg + jj) * 65 + n];
                      u32x4 w; w.x = cvt_pk_bf16(v[0], v[1]); w.y = cvt_pk_bf16(v[2], v[3]); w.z = cvt_pk_bf16(v[4], v[5]); w.w = cvt_pk_bf16(v[6], v[7]);
                      *(u32x4*)(dst + (size_t)(n0 + n) * K + k0 + 64 * t + 8 * kg) = w; } }
                __syncthreads();
            }
            item -= nt;
        }
    }
    {
        const int gthr = blockIdx.x * NTHR + tid, nthr = gridDim.x * NTHR;
        for (int p = gthr; p < 10 * 16384; p += nthr) {
            const int mat = p >> 14, off = (p & 16383) * 8; const float* src; bf16_t* dst;
            if (mat < 2)      { src = A.in[I_GWS] + (size_t)mat * 131072; dst = (bf16_t*)(A.ws + WS_W + W_GM + (size_t)mat * WG_SZ + WG_WS); }
            else if (mat < 6) { src = A.in[I_PK1] + (size_t)(mat - 2) * 131072; dst = (bf16_t*)(A.ws + WS_W + W_PEER + (size_t)(mat - 2) * WP_SZ + WP_K1); }
            else              { src = A.in[I_PK2] + (size_t)(mat - 6) * 131072; dst = (bf16_t*)(A.ws + WS_W + W_PEER + (size_t)(mat - 6) * WP_SZ + WP_K2); }
            const f32x4 a = *(const f32x4*)(src + off), b = *(const f32x4*)(src + off + 4);
            u32x4 w; w.x = cvt_pk_bf16(a[0], a[1]); w.y = cvt_pk_bf16(a[2], a[3]); w.z = cvt_pk_bf16(b[0], b[1]); w.w = cvt_pk_bf16(b[2], b[3]);
            *(u32x4*)(dst + off) = w;
        }
        float* rope = (float*)(A.ws + WS_ROPE);
        for (int p = gthr; p < SEQ * 32; p += nthr) { const int l = p >> 5, i = p & 31; const float pos = (float)(i < 16 ? (l >> 6) : (l & 63));
            const float inv = powf(10000.f, -(float)(i & 15) / 16.f), ang = pos * inv; rope[p] = cosf(ang); rope[SEQ * 32 + p] = sinf(ang); }
    }
    {
        LAS float* scond = (LAS float*)lds;
        LAS float* red = scond + 5 * 1024;
        __syncthreads();
        for (int i = tid; i < 5 * 1024; i += NTHR) { const int m = i >> 10, k = i & 1023; const float c = m < 4 ? A.in[I_C][m * 1024 + k] : A.in[I_CCTX][k]; scond[i] = silu_f(c); }
        __syncthreads();
        float* MOD = (float*)(A.ws + WS_MOD);
        for (int item = blockIdx.x; item < 4 * 48; item += gridDim.x) {
            const int layer = item / 48, j0 = (item % 48) * 128; const int c4 = tid & 31, ksl = tid >> 5;
            f32x4 acc[5];
#pragma unroll
            for (int m = 0; m < 5; ++m) acc[m] = (f32x4){0.f, 0.f, 0.f, 0.f};
            const float* wp = A.in[I_ADAW] + ((size_t)layer * 1024 + ksl * 64) * 6144 + j0 + 4 * c4;
            for (int k = 0; k < 64; ++k) { const f32x4 w = *(const f32x4*)(wp + (size_t)k * 6144);
#pragma unroll
                for (int m = 0; m < 5; ++m) acc[m] += w * scond[m * 1024 + ksl * 64 + k]; }
#pragma unroll
            for (int m = 0; m < 5; ++m) *(LAS f32x4*)(red + (ksl * 5 + m) * 128 + 4 * c4) = acc[m];
            __syncthreads();
            for (int i = tid; i < 640; i += NTHR) { const int m = i >> 7, c = i & 127; float s = A.in[I_ADAB][layer * 6144 + j0 + c];
#pragma unroll
                for (int q = 0; q < 16; ++q) s += red[(q * 5 + m) * 128 + c];
                MOD[((size_t)layer * 5 + m) * 6144 + j0 + c] = s; }
            __syncthreads();
        }
    }
}

template <bool F32SRC>
__device__ __forceinline__ void phase_norm_mod(const float* xl, const float* xc, bf16_t* XB, const float* g, const float* modl, int sh_idx, bf16_t* H, int nrows) {
    const int tid_ = otid(); const int lane = tid_ & 63, gw = blockIdx.x * 8 + (tid_ >> 6), nw = gridDim.x * 8;
    f32x4 gv[4];
#pragma unroll
    for (int i = 0; i < 4; ++i) gv[i] = *(const f32x4*)(g + 256 * i + 4 * lane);
    for (int r = gw; r < nrows; r += nw) {
        const bool lat = r < NLAT;
        f32x4 x[4]; float ss = 0.f;
        if (F32SRC) { const float* xp = lat ? xl + (size_t)r * D : xc + (size_t)(r - NLAT) * D;
#pragma unroll
            for (int i = 0; i < 4; ++i) { x[i] = *(const f32x4*)(xp + 256 * i + 4 * lane);
                u32x2 w; w.x = cvt_pk_bf16(x[i][0], x[i][1]); w.y = cvt_pk_bf16(x[i][2], x[i][3]); *(u32x2*)(XB + (size_t)r * D + 256 * i + 4 * lane) = w;
 }
        } else {
#pragma unroll
            for (int i = 0; i < 4; ++i) { const u32x2 w = *(const u32x2*)(XB + (size_t)r * D + 256 * i + 4 * lane); x[i] = (f32x4){bflo(w.x), bfhi(w.x), bflo(w.y), bfhi(w.y)}; } }
#pragma unroll
        for (int i = 0; i < 4; ++i) ss += x[i][0] * x[i][0] + x[i][1] * x[i][1] + x[i][2] * x[i][2] + x[i][3] * x[i][3];
        ss = wave_sum(ss); const float rstd = rsqrtf(ss * (1.f / 1024.f) + EPS);
        const float* mp = modl + (size_t)(lat ? (r >> 13) : 4) * 6144 + sh_idx * 1024;
#pragma unroll
        for (int i = 0; i < 4; ++i) { const f32x4 sh = *(const f32x4*)(mp + 256 * i + 4 * lane), sc = *(const f32x4*)(mp + 1024 + 256 * i + 4 * lane);
            const f32x4 hv = (x[i] * rstd) * gv[i] * (sc + 1.f) + sh;
            u32x2 w; w.x = cvt_pk_bf16(hv[0], hv[1]); w.y = cvt_pk_bf16(hv[2], hv[3]);
            *(u32x2*)(H + (size_t)r * D + 256 * i + 4 * lane) = w; }
    }
}
__device__ __forceinline__ void phase_final_norm(const bf16_t* XB, float* out, const float* g, float oscale) {
    const int tid_ = otid(); const int lane = tid_ & 63, gw = blockIdx.x * 8 + (tid_ >> 6), nw = gridDim.x * 8;
    f32x4 gv[4];
#pragma unroll
    for (int i = 0; i < 4; ++i) gv[i] = *(const f32x4*)(g + 256 * i + 4 * lane);
    for (int r = gw; r < NLAT; r += nw) {
        f32x4 x[4]; float ss = 0.f;
#pragma unroll
        for (int i = 0; i < 4; ++i) { const u32x2 w = *(const u32x2*)(XB + (size_t)r * D + 256 * i + 4 * lane); x[i] = (f32x4){bflo(w.x), bfhi(w.x), bflo(w.y), bfhi(w.y)};
            ss += x[i][0] * x[i][0] + x[i][1] * x[i][1] + x[i][2] * x[i][2] + x[i][3] * x[i][3]; }
        ss = wave_sum(ss); const float rstd = rsqrtf(ss * (1.f / 1024.f) + EPS);
#pragma unroll
        for (int i = 0; i < 4; ++i) *(f32x4*)(out + (size_t)r * D + 256 * i + 4 * lane) = (x[i] * (rstd * oscale)) * gv[i];
    }
}

__device__ __forceinline__ void phase_conv(const Args& A, int li) {
    const bf16_t* PROJ = (const bf16_t*)(A.ws + WS_BIG);
    bf16_t* XS = (bf16_t*)(A.ws + WS_R2); bf16_t* BC = (bf16_t*)(A.ws + WS_R2 + R2_BC);
    const int tid = otid();
    {
        for (int item = blockIdx.x * 3; item < (NROW / 64) * 3; item += gridDim.x * 3)
#pragma unroll 1
        for (int sub = 0; sub < 3; ++sub) {
            const int blk = (item + sub) / 3, q = ((item + sub) % 3) * 512 + tid, cg = q % 192, rg = q / 192, c0 = 8 * cg;
            const int rbeg = blk * 64 + rg * 8; int s0, s1;
            if (rbeg < NLAT) { s0 = rbeg & ~8191; s1 = s0 + 8192; } else { s0 = NLAT + ((rbeg - NLAT) & ~255); s1 = s0 + 256; }
            const float* cw = A.in[I_CONVW] + ((size_t)li * 1536 + c0) * 5; const float* cb = A.in[I_CONVB] + (size_t)li * 1536 + c0;
            u32x4 in[12];
#pragma unroll
            for (int i = 0; i < 12; ++i) { const int r = rbeg - 2 + i; in[i] = (r >= s0 && r < s1) ? *(const u32x4*)(PROJ + (size_t)r * HYB_INP + C_XBC + c0) : (u32x4){0u, 0u, 0u, 0u}; }
            float w[8][5], bia[8];
#pragma unroll
            for (int j = 0; j < 8; ++j) { bia[j] = cb[j];
#pragma unroll
                for (int k = 0; k < 5; ++k) w[j][k] = cw[j * 5 + k]; }
#pragma unroll
            for (int rr = 0; rr < 8; ++rr) {
                float o[8];
#pragma unroll
                for (int j = 0; j < 8; ++j) { float sacc = bia[j];
#pragma unroll
                    for (int k = 0; k < 5; ++k) { const unsigned wd = in[rr + k][j >> 1]; sacc += w[j][k] * ((j & 1) ? bfhi(wd) : bflo(wd)); }
                    o[j] = silu_f(sacc); }
                u32x4 pk; pk.x = cvt_pk_bf16(o[0], o[1]); pk.y = cvt_pk_bf16(o[2], o[3]); pk.z = cvt_pk_bf16(o[4], o[5]); pk.w = cvt_pk_bf16(o[6], o[7]);
                const int r = rbeg + rr;
                if (c0 < 1024) *(u32x4*)(XS + (size_t)r * 1024 + c0) = pk; else *(u32x4*)(BC + (size_t)r * 512 + (c0 - 1024)) = pk;
            }
        }
    }
    {
        const int lane = tid & 63, gw = blockIdx.x * 8 + (tid >> 6), nw = gridDim.x * 8;
        float* DT = (float*)(A.ws + WS_BIG + BIG_DT); float* RQ = (float*)(A.ws + WS_RSTD); float* RKV = RQ + NROW;
        unsigned char* KR = A.ws + WS_BIG + BIG_KR; const float* rope = (const float*)(A.ws + WS_ROPE);
        const float dtb = lane < 32 ? A.in[I_DTB][li * 32 + lane] : 0.f;
        for (int rb = gw * 4; rb < NROW; rb += nw * 4) {
            unsigned wq[4][3]; u32x2 wk[4]; unsigned wr_[4]; float dtv[4], rc[4], rsn[4];
#pragma unroll
            for (int i = 0; i < 4; ++i) { const int r = rb + i; const bf16_t* p = PROJ + (size_t)r * HYB_INP;
                const unsigned* q = (const unsigned*)(p + C_CQ + 6 * lane); wq[i][0] = q[0]; wq[i][1] = q[1]; wq[i][2] = q[2];
                wk[i] = *(const u32x2*)(p + C_CKV + 4 * lane);
                dtv[i] = lane < 32 ? bf2f(p[C_DT + (lane & 15)]) : 0.f; wr_[i] = lane < 32 ? *(const unsigned*)(p + C_KR + 2 * lane) : 0u;
                const int l = r & 8191; rc[i] = (lane < 32 && r < NLAT) ? rope[l * 32 + lane] : 1.f; rsn[i] = (lane < 32 && r < NLAT) ? rope[SEQ * 32 + l * 32 + lane] : 0.f; }
#pragma unroll
            for (int i = 0; i < 4; ++i) { const int r = rb + i;
                if (lane < 32) DT[(size_t)lane * NROW + r] = softplus_f(dtv[i] + dtb);
                { float ss = 0.f;
#pragma unroll
                  for (int j = 0; j < 3; ++j) { const float a = bflo(wq[i][j]), b = bfhi(wq[i][j]); ss += a * a + b * b; }
                  ss = wave_sum(ss); if (lane == 0) RQ[r] = rsqrtf(ss * (1.f / 384.f) + EPS); }
                { const float a = bflo(wk[i].x), b = bfhi(wk[i].x), c = bflo(wk[i].y), d = bfhi(wk[i].y);
                  float ss = a * a + b * b + c * c + d * d; ss = wave_sum(ss); if (lane == 0) RKV[r] = rsqrtf(ss * (1.f / 256.f) + EPS); }
                if (lane < 32) { const float x1 = bflo(wr_[i]), x2 = bfhi(wr_[i]); int b, key;
                    const float o1 = x1 * rc[i] - x2 * rsn[i], o2 = x1 * rsn[i] + x2 * rc[i];
                    if (r < NLAT) { b = r >> 13; key = 256 + (r & 8191); } else { b = (r - NLAT) >> 8; key = (r - NLAT) & 255; }
                    int w8 = 0; w8 = __builtin_amdgcn_cvt_pk_fp8_f32(sat8(o1), sat8(o2), w8, false);
                    *(unsigned short*)(KR + (size_t)(b * NKT + (key >> 6)) * 4096 + att8::kr8(key & 63, 2 * lane)) = (unsigned short)(w8 & 0xffff); }
            }
        }
    }
}

struct EpiQ {
    static constexpr bool PERM = true;
    unsigned char* Q; const float* rstd; const float* rope;
    __device__ __forceinline__ void operator()(const f32x4 (&acc)[2][2][4][2], const pg8::Unit& u, int wr, int wc, int fr, int fq) const {
        const bool lat = u.pm < 128;
        const int b = lat ? (u.pm >> 5) : (u.pm - 128), q0 = lat ? 256 + ((u.pm & 31) << 8) : 0;
        const bool isrope = u.pn >= 4;
#pragma unroll
        for (int ai = 0; ai < 2; ++ai) {
            const int rl = 128 * ai + 64 * wr + fr;
            const float* rsp = rstd + u.pm * 256 + rl;
            const float* rp = rope + (size_t)(((u.pm & 31) << 8) + rl) * 32;
#pragma unroll
            for (int bj = 0; bj < 2; ++bj) {
                const int c0 = u.pn * 256 + 128 * bj + 32 * wc + 8 * fq; int h, dcol;
                if (!isrope) { h = c0 >> 7; dcol = c0 & 127; } else { const int mq = c0 - 1024; h = mq >> 6; dcol = 128 + (mq & 63); }
                unsigned char* dst = Q + ((size_t)(b * 8 + h) * NKEY + q0 + rl) * 192 + dcol;
                const int ro = (dcol - 128) >> 1;
#pragma unroll
                for (int m = 0; m < 4; ++m) {
                    const float rs = rsp[16 * m] * (QSCALE * att8::QUP);
                    f32x4 v0 = acc[ai][bj][m][0] * rs, v1 = acc[ai][bj][m][1] * rs;
                    if (isrope && lat) { const f32x4 cs = *(const f32x4*)(rp + 16 * m * 32 + ro), sn = *(const f32x4*)(rp + SEQ * 32 + 16 * m * 32 + ro);
                        const f32x4 a0 = v0, a1 = v1;
                        v0[0] = a0[0] * cs[0] - a0[1] * sn[0]; v0[1] = a0[0] * sn[0] + a0[1] * cs[0]; v0[2] = a0[2] * cs[1] - a0[3] * sn[1]; v0[3] = a0[2] * sn[1] + a0[3] * cs[1];
                        v1[0] = a1[0] * cs[2] - a1[1] * sn[2]; v1[1] = a1[0] * sn[2] + a1[1] * cs[2]; v1[2] = a1[2] * cs[3] - a1[3] * sn[3]; v1[3] = a1[2] * sn[3] + a1[3] * cs[3]; }
                    u32x2 w; w.x = pk4_fp8_sat(v0[0], v0[1], v0[2], v0[3]); w.y = pk4_fp8_sat(v1[0], v1[1], v1[2], v1[3]);
                    *(u32x2*)(dst + 16 * m * 192) = w;
                    asm volatile("" ::: "memory");
                }
            }
        }
    }
};
struct EpiKV {
    static constexpr bool PERM = true;
    unsigned char* KN; unsigned char* V; const float* rstd;
    __device__ __forceinline__ void operator()(const f32x4 (&acc)[2][2][4][2], const pg8::Unit& u, int wr, int wc, int fr, int fq) const {
        const bool lat = u.pm < 128;
        const int b = lat ? (u.pm >> 5) : (u.pm - 128), t0 = lat ? 4 + ((u.pm & 31) << 2) : 0;
        const int dd = 32 * wc + 8 * fq;
        const int offK = fr * 128 + ((((dd >> 4) ^ ((fr >> 1) & 7))) << 4) + (dd & 15);
#pragma unroll
        for (int ai = 0; ai < 2; ++ai) {
            const size_t tb = ((size_t)(b * 8 + u.pn) * NKT + t0 + 2 * ai + wr) * 8192;
            const float* rsp = rstd + u.pm * 256 + 128 * ai + 64 * wr + fr;
            unsigned char* kp = KN + tb + offK; unsigned char* vp = V + tb;
#pragma unroll
            for (int m = 0; m < 4; ++m) {
                const float rs = rsp[16 * m];
                { const f32x4 v0 = acc[ai][0][m][0] * rs, v1 = acc[ai][0][m][1] * rs; u32x2 w; w.x = pk4_fp8_sat(v0[0], v0[1], v0[2], v0[3]); w.y = pk4_fp8_sat(v1[0], v1[1], v1[2], v1[3]);
                  *(u32x2*)(kp + m * 2048) = w; }
                { const f32x4 v0 = acc[ai][1][m][0] * rs, v1 = acc[ai][1][m][1] * rs; const unsigned w0 = pk4_fp8_sat(v0[0], v0[1], v0[2], v0[3]), w1 = pk4_fp8_sat(v1[0], v1[1], v1[2], v1[3]);
                  const int sl = att8::vslot(16 * m + fr);
#pragma unroll
                  for (int i = 0; i < 8; ++i) { const int d = dd + i; vp[d * 64 + ((((sl >> 4) ^ ((d >> 2) & 3))) << 4) + (sl & 15)] = (unsigned char)(((i < 4 ? w0 : w1) >> (8 * (i & 3))) & 0xffu); } }
                asm volatile("" ::: "memory");
            }
        }
    }
};

__device__ __forceinline__ void phase_ssd_out(const Args& A, int li, int nrows) {
    const bf16_t* PROJ = (const bf16_t*)(A.ws + WS_BIG); const bf16_t* XS = (const bf16_t*)(A.ws + WS_R2);
    const bf16_t* Y0 = (const bf16_t*)(A.ws + WS_H); const bf16_t* Y1 = (const bf16_t*)(A.ws + WS_R3); bf16_t* CAT = (bf16_t*)(A.ws + WS_R3 + R3_CAT);
    const int tid_ = otid(); const int lane = tid_ & 63, gw = blockIdx.x * 8 + (tid_ >> 6), nw = gridDim.x * 8;
    const float dsk = A.in[I_SSDD][li * 16 + (lane >> 2)];
    float ng[16];
#pragma unroll
    for (int j = 0; j < 16; ++j) ng[j] = A.in[I_SSDNG][li * 1024 + 16 * lane + j];
    for (int r = gw; r < nrows; r += nw) {
        float v[16]; float ss = 0.f;
#pragma unroll
        for (int hh = 0; hh < 2; ++hh) {
            const u32x4 a = *(const u32x4*)(Y0 + (size_t)r * 1024 + 16 * lane + 8 * hh), b = *(const u32x4*)(Y1 + (size_t)r * 1024 + 16 * lane + 8 * hh);
            const u32x4 x = *(const u32x4*)(XS + (size_t)r * 1024 + 16 * lane + 8 * hh), z = *(const u32x4*)(PROJ + (size_t)r * HYB_INP + 16 * lane + 8 * hh);
#pragma unroll
            for (int q = 0; q < 4; ++q) {
                const float y0 = (bflo(a[q]) + bflo(b[q]) + dsk * bflo(x[q])) * silu_f(bflo(z[q])), y1 = (bfhi(a[q]) + bfhi(b[q]) + dsk * bfhi(x[q])) * silu_f(bfhi(z[q]));
                v[8 * hh + 2 * q] = y0; v[8 * hh + 2 * q + 1] = y1; ss += y0 * y0 + y1 * y1; }
        }
#pragma unroll
        for (int o = 16; o >= 1; o >>= 1) ss += __shfl_xor(ss, o);
        const float rstd = rsqrtf(ss * (1.f / 512.f) + EPS);
#pragma unroll
        for (int hh = 0; hh < 2; ++hh) { u32x4 w;
#pragma unroll
            for (int q = 0; q < 4; ++q) w[q] = cvt_pk_bf16(v[8 * hh + 2 * q] * rstd * ng[8 * hh + 2 * q], v[8 * hh + 2 * q + 1] * rstd * ng[8 * hh + 2 * q + 1]);
            *(u32x4*)(CAT + (size_t)r * 2048 + 16 * lane + 8 * hh) = w; }
    }
}

__device__ __forceinline__ void phase_ln_stats(const Args& A, int nrows) {
    const bf16_t* Gb = (const bf16_t*)(A.ws + WS_BIG); float* ST = (float*)(A.ws + WS_RSTD);
    const int tid_ = otid(); const int lane = tid_ & 63, gw = blockIdx.x * 8 + (tid_ >> 6), nw = gridDim.x * 8;
    for (int r = gw; r < nrows; r += nw) {
        float v[32]; float s = 0.f;
#pragma unroll
        for (int j = 0; j < 4; ++j) { const u32x4 w = *(const u32x4*)(Gb + (size_t)r * 4096 + 2048 + 512 * j + 8 * lane);
#pragma unroll
            for (int q = 0; q < 4; ++q) { v[8 * j + 2 * q] = bflo(w[q]); v[8 * j + 2 * q + 1] = bfhi(w[q]); s += v[8 * j + 2 * q] + v[8 * j + 2 * q + 1]; } }
        s = wave_sum(s); const float mu = s * (1.f / 2048.f); float q2 = 0.f;
#pragma unroll
        for (int j = 0; j < 32; ++j) { const float dd = v[j] - mu; q2 += dd * dd; }
        q2 = wave_sum(q2);
        if (lane == 0) { ST[r] = mu; ST[NROW + r] = rsqrtf(q2 * (1.f / 2048.f) + EPS); }
    }
}
__device__ __forceinline__ float half_sum32(float v) {
    v += __builtin_bit_cast(float, __builtin_amdgcn_mov_dpp(__builtin_bit_cast(int, v), 0xB1, 0xF, 0xF, true));
    v += __builtin_bit_cast(float, __builtin_amdgcn_mov_dpp(__builtin_bit_cast(int, v), 0x4E, 0xF, 0xF, true));
    v += __builtin_bit_cast(float, __builtin_amdgcn_mov_dpp(__builtin_bit_cast(int, v), 0x141, 0xF, 0xF, true));
    v += __builtin_bit_cast(float, __builtin_amdgcn_mov_dpp(__builtin_bit_cast(int, v), 0x140, 0xF, 0xF, true));
    auto r = __builtin_amdgcn_permlane16_swap(__float_as_uint(v), __float_as_uint(v), false, false);
    return __uint_as_float(r[0]) + __uint_as_float(r[1]);
}
__device__ __forceinline__ void phase_spatial(const Args& A, int gi, int nrows, LAS unsigned char* lds) {
    const bf16_t* Gb = (const bf16_t*)(A.ws + WS_BIG); const f32x2* PARTS = (const f32x2*)(A.ws + WS_R3); bf16_t* Ab = (bf16_t*)(A.ws + WS_R1);
    const bf16_t* WSg = (const bf16_t*)(A.ws + WS_W + W_GM + (size_t)gi * WG_SZ + WG_WS);
    const float* lng = A.in[I_GLNG] + (size_t)gi * 2048; const float* lnb = A.in[I_GLNB] + (size_t)gi * 2048; const float* bs = A.in[I_GBS] + (size_t)gi * 1024;
    const int tid = otid(), wid = tid >> 6, lane = tid & 63, r32 = lane & 31, hi = lane >> 5, tb = wid & 3, dh = wid >> 2;
    const int ldsaddr = (int)(unsigned)(uintptr_t)lds;
    u32x4 nv[8]; f32x2 nps[8];
    const int nunits = (nrows / 128) * 8;
#define SP_LOADV(un) do { const int cb_ = (un) >> 3, gg_ = (un) & 7, r0_ = cb_ * 128; \
        _Pragma("unroll") for (int j = 0; j < 8; ++j) { const int idx = tid + 512 * j, s_ = idx >> 5, dd_ = (idx & 31) * 8; \
            nv[j] = *(const u32x4*)(Gb + (size_t)(r0_ + s_) * 4096 + 2048 + 256 * gg_ + dd_); nps[j] = PARTS[(size_t)(r0_ + s_) * 32 + (idx & 31)]; } } while (0)
    if ((int)blockIdx.x < nunits) SP_LOADV((int)blockIdx.x);
    for (int unit = blockIdx.x; unit < nunits; unit += gridDim.x) {
        const int cb = unit >> 3, gg = unit & 7, r0 = cb * 128;
        __syncthreads();
#pragma unroll
        for (int j = 0; j < 8; ++j) { const int idx = tid + 512 * j, s = idx >> 5, dd = (idx & 31) * 8;
            const u32x4 w = nv[j];
            const float mu = half_sum32(nps[j].x) * (1.f / 2048.f), rs = rsqrtf(fmaxf(half_sum32(nps[j].y) * (1.f / 2048.f) - mu * mu, 0.f) + EPS);
            const f32x4 g0 = *(const f32x4*)(lng + 256 * gg + dd), g1 = *(const f32x4*)(lng + 256 * gg + dd + 4), b0 = *(const f32x4*)(lnb + 256 * gg + dd), b1 = *(const f32x4*)(lnb + 256 * gg + dd + 4);
            u32x4 o;
            o.x = cvt_pk_bf16((bflo(w.x) - mu) * rs * g0[0] + b0[0], (bfhi(w.x) - mu) * rs * g0[1] + b0[1]); o.y = cvt_pk_bf16((bflo(w.y) - mu) * rs * g0[2] + b0[2], (bfhi(w.y) - mu) * rs * g0[3] + b0[3]);
            o.z = cvt_pk_bf16((bflo(w.z) - mu) * rs * g1[0] + b1[0], (bfhi(w.z) - mu) * rs * g1[1] + b1[1]); o.w = cvt_pk_bf16((bflo(w.w) - mu) * rs * g1[2] + b1[2], (bfhi(w.w) - mu) * rs * g1[3] + b1[3]);
            *(LAS u32x4*)(lds + ((s >> 6) * 2 + (dd >> 7)) * 16384 + att::v_st(s & 63, dd & 127)) = o; }
        u32x2 uu[4][4];
        { const bf16_t* up = Gb + (size_t)(r0 + 32 * tb + r32) * 4096 + 256 * gg + 128 * dh + 4 * hi;
#pragma unroll
          for (int d0 = 0; d0 < 4; ++d0)
#pragma unroll
              for (int k = 0; k < 4; ++k) uu[d0][k] = *(const u32x2*)(up + 32 * d0 + 8 * k); }
        if (unit + (int)gridDim.x < nunits) SP_LOADV(unit + (int)gridDim.x);
        bf16x8 pa[8];
#pragma unroll
        for (int ks = 0; ks < 8; ++ks) pa[ks] = *(const bf16x8*)(WSg + ((size_t)gg * 128 + 32 * tb + r32) * 128 + 16 * ks + 8 * hi);
        __syncthreads();
        f32x16 o[4] = {};
#define SP_PV(D0, vbase, p0, p1, p2, p3) do { \
            const s16x4 l0 = att::tr_read<att::v_rd_off(D0, 0, 0)>(vbase), h0 = att::tr_read<att::v_rd_off(D0, 0, 1)>(vbase), l1 = att::tr_read<att::v_rd_off(D0, 1, 0)>(vbase), h1 = att::tr_read<att::v_rd_off(D0, 1, 1)>(vbase); \
            const s16x4 l2 = att::tr_read<att::v_rd_off(D0, 2, 0)>(vbase), h2 = att::tr_read<att::v_rd_off(D0, 2, 1)>(vbase), l3 = att::tr_read<att::v_rd_off(D0, 3, 0)>(vbase), h3 = att::tr_read<att::v_rd_off(D0, 3, 1)>(vbase); \
            asm volatile("s_waitcnt lgkmcnt(0)" ::: "memory"); __builtin_amdgcn_sched_barrier(0); \
            o[D0] = __builtin_amdgcn_mfma_f32_32x32x16_bf16((bf16x8){l0[0], l0[1], l0[2], l0[3], h0[0], h0[1], h0[2], h0[3]}, p0, o[D0], 0, 0, 0); \
            o[D0] = __builtin_amdgcn_mfma_f32_32x32x16_bf16((bf16x8){l1[0], l1[1], l1[2], l1[3], h1[0], h1[1], h1[2], h1[3]}, p1, o[D0], 0, 0, 0); \
            o[D0] = __builtin_amdgcn_mfma_f32_32x32x16_bf16((bf16x8){l2[0], l2[1], l2[2], l2[3], h2[0], h2[1], h2[2], h2[3]}, p2, o[D0], 0, 0, 0); \
            o[D0] = __builtin_amdgcn_mfma_f32_32x32x16_bf16((bf16x8){l3[0], l3[1], l3[2], l3[3], h3[0], h3[1], h3[2], h3[3]}, p3, o[D0], 0, 0, 0); } while (0)
        { const int vb0 = ldsaddr + (0 * 2 + dh) * 16384 + att::v_rd_base(lane), vb1 = ldsaddr + (1 * 2 + dh) * 16384 + att::v_rd_base(lane);
          SP_PV(0, vb0, pa[0], pa[1], pa[2], pa[3]); SP_PV(1, vb0, pa[0], pa[1], pa[2], pa[3]); SP_PV(2, vb0, pa[0], pa[1], pa[2], pa[3]); SP_PV(3, vb0, pa[0], pa[1], pa[2], pa[3]);
          SP_PV(0, vb1, pa[4], pa[5], pa[6], pa[7]); SP_PV(1, vb1, pa[4], pa[5], pa[6], pa[7]); SP_PV(2, vb1, pa[4], pa[5], pa[6], pa[7]); SP_PV(3, vb1, pa[4], pa[5], pa[6], pa[7]); }
#undef SP_PV
        { const int t = 32 * tb + r32, row = r0 + t; const float bsv = bs[gg * 128 + t];
          bf16_t* ap = Ab + (size_t)row * 2048 + 256 * gg + 128 * dh + 4 * hi;
#pragma unroll
          for (int d0 = 0; d0 < 4; ++d0)
#pragma unroll
              for (int k = 0; k < 4; ++k) {
                  const u32x2 u2 = uu[d0][k];
                  u32x2 w; w.x = cvt_pk_bf16(bflo(u2.x) * (o[d0][4 * k] + bsv), bfhi(u2.x) * (o[d0][4 * k + 1] + bsv)); w.y = cvt_pk_bf16(bflo(u2.y) * (o[d0][4 * k + 2] + bsv), bfhi(u2.y) * (o[d0][4 * k + 3] + bsv));
                  *(u32x2*)(ap + 32 * d0 + 8 * k) = w; } }
    }
#undef SP_LOADV
}

constexpr int NSL = 8, SW = 1024 / NSL;
constexpr size_t TAB8_HALF = (size_t)NEXP * 1024, TAB_SCL = 2 * TAB8_HALF, TAB_SET = al256(TAB_SCL + (size_t)2 * NEXP * 4);
static_assert(2 * TAB_SET <= TAB_REGION, "table sets");
__device__ __forceinline__ size_t tabset(int layer) { return WS_TAB + (size_t)(layer & 1) * TAB_SET; }
constexpr float HS = 4.f;
__device__ __forceinline__ void phase_tabcvt(const Args& A, int layer, int wg, int nwg, int r_lo = 0, int r_hi = 2 * NEXP) {
    const int tid_ = otid(); const int lane = tid_ & 63, gw = wg * 8 + (tid_ >> 6), nw = nwg * 8;
    unsigned char* TS = A.ws + tabset(layer); float* SCL = (float*)(TS + TAB_SCL);
    for (int r = r_lo + gw; r < r_hi; r += nw) {
        const int tab = r >> 14, e = r & (NEXP - 1);
        const float* src = (tab ? A.in[I_PV] : A.in[I_PU]) + ((size_t)layer * NEXP + e) * 1024 + 16 * lane;
        f32x4 v[4]; float am = 0.f;
#pragma unroll
        for (int i = 0; i < 4; ++i) { v[i] = *(const f32x4*)(src + 4 * i); am = fmaxf(am, fmaxf(fmaxf(fabsf(v[i][0]), fabsf(v[i][1])), fmaxf(fabsf(v[i][2]), fabsf(v[i][3])))); }
#pragma unroll
        for (int o = 32; o >= 1; o >>= 1) am = fmaxf(am, __shfl_xor(am, o));
        float sc = 1.f; if (am > 0.f) { int ex; (void)frexpf(448.f / am, &ex); sc = ldexpf(1.f, ex - 1); }
        if (lane == 0) SCL[tab * NEXP + e] = 1.f / sc;
        u32x4 w;
#pragma unroll
        for (int i = 0; i < 4; ++i) w[i] = pk4_fp8(v[i][0] * sc, v[i][1] * sc, v[i][2] * sc, v[i][3] * sc);
        *(u32x4*)(TS + (size_t)tab * TAB8_HALF + ((size_t)(lane >> 3) * NEXP + e) * SW + 16 * (lane & 7)) = w;
    }
}
#define CASD(a, b) do { const float hi_ = fmaxf(a, b), lo_ = fminf(a, b); a = hi_; b = lo_; } while (0)
__device__ __forceinline__ void sort16(float (&k)[16]) {
#pragma unroll
    for (int sz = 2; sz <= 16; sz <<= 1)
#pragma unroll
        for (int j = sz >> 1; j > 0; j >>= 1)
#pragma unroll
            for (int i = 0; i < 16; ++i) { const int l = i ^ j; if (l > i) { if ((i & sz) == 0 || sz == 16) CASD(k[i], k[l]); else CASD(k[l], k[i]); } }
}
__device__ __forceinline__ void bmerge16(float (&k)[16]) {
#pragma unroll
    for (int j = 8; j > 0; j >>= 1)
#pragma unroll
        for (int i = 0; i < 16; ++i) { const int l = i ^ j; if (l > i) CASD(k[i], k[l]); }
}
__device__ __forceinline__ void merge_top16(float (&a)[16], const float (&b)[16]) {
#pragma unroll
    for (int i = 0; i < 16; ++i) a[i] = fmaxf(a[i], b[15 - i]);
    bmerge16(a);
}
__device__ __forceinline__ void xmerge_top16(float (&a)[16], int mask) {
    float t[16];
#pragma unroll
    for (int i = 0; i < 16; ++i) t[i] = __shfl_xor(a[15 - i], mask);
#pragma unroll
    for (int i = 0; i < 16; ++i) a[i] = fmaxf(a[i], t[i]);
    bmerge16(a);
}
__device__ __forceinline__ void phase_topk(const Args& A, int layer, int nrows, LAS unsigned char* lds) {
    const bf16_t* QP = (const bf16_t*)(A.ws + WS_BIG); int* IDX = (int*)(A.ws + WS_R2); float* GATE = (float*)(A.ws + WS_R2 + R2_GATE);
    const int tid = otid(), wid = tid >> 6, lane = tid & 63, fr = lane & 15, fq = lane >> 4;
    LAS unsigned* scr = (LAS unsigned*)(lds + 2 * 34816) + wid * 512 + fr * 32;
    int h_staged = -1;
    for (int unit = blockIdx.x; unit < (nrows / 128) * 8; unit += gridDim.x) {
        const int h = unit & 7, r0 = (unit >> 3) * 128;
        if (h != h_staged) { h_staged = h;
        __syncthreads();
        { const bf16_t* k1 = (const bf16_t*)(A.ws + WS_W + W_PEER + (size_t)layer * WP_SZ + WP_K1) + (size_t)h * 16384;
#pragma unroll
          for (int j = 0; j < 8; ++j) { const int idx = tid + 512 * j, half = idx >> 11, rem = idx & 2047, key = rem >> 4, c8 = rem & 15;
              const u32x4 w = *(const u32x4*)(k1 + (size_t)half * 8 * 16384 + key * 128 + 8 * c8);
              *(LAS u32x4*)(lds + half * 34816 + key * 272 + c8 * 16) = w; } }
        __syncthreads(); }
        const int tok = r0 + 16 * wid + fr;
        float top[2][16];
#pragma unroll
        for (int half = 0; half < 2; ++half) {
            bf16x8 qf[4];
#pragma unroll
            for (int ks = 0; ks < 4; ++ks) qf[ks] = *(const bf16x8*)(QP + (size_t)tok * 2048 + 256 * h + 128 * half + 32 * ks + 8 * fq);
            float loc[16];
#pragma unroll
            for (int grp = 0; grp < 2; ++grp) {
                float kk[16];
#pragma unroll
                for (int nbb = 0; nbb < 4; ++nbb) { const int nb = 4 * grp + nbb; f32x4 acc = {0.f, 0.f, 0.f, 0.f};
#pragma unroll
                    for (int ks = 0; ks < 4; ++ks) { const bf16x8 kf = *(const LAS bf16x8*)(lds + half * 34816 + (16 * nb + fr) * 272 + (32 * ks + 8 * fq) * 2);
                        acc = __builtin_amdgcn_mfma_f32_16x16x32_bf16(kf, qf[ks], acc, 0, 0, 0); }
#pragma unroll
                    for (int i = 0; i < 4; ++i) { const unsigned code = 127u - (unsigned)(16 * nb + 4 * fq + i); kk[4 * nbb + i] = __uint_as_float((__float_as_uint(acc[i]) & ~127u) | code); } }
                sort16(kk);
                if (grp == 0) {
#pragma unroll
                    for (int i = 0; i < 16; ++i) loc[i] = kk[i];
                } else merge_top16(loc, kk);
            }
            xmerge_top16(loc, 16); xmerge_top16(loc, 32);
#pragma unroll
            for (int i = 0; i < 16; ++i) top[half][i] = loc[i];
        }
        if (fq < 2) {
#pragma unroll
            for (int i = 0; i < 16; ++i) scr[16 * fq + i] = __float_as_uint(fq == 0 ? top[0][i] : top[1][i]); }
        float fin[16];
#pragma unroll
        for (int aa = 0; aa < 4; ++aa) {
            const float va_k = fq == 0 ? top[0][aa] : fq == 1 ? top[0][4 + aa] : fq == 2 ? top[0][8 + aa] : top[0][12 + aa];
            const float va = __uint_as_float(__float_as_uint(va_k) & ~127u);
            float c[16];
#pragma unroll
            for (int bb = 0; bb < 16; ++bb) { const float s = va + __uint_as_float(__float_as_uint(top[1][bb]) & ~127u);
                c[bb] = __uint_as_float((__float_as_uint(s) & ~255u) | (255u - (unsigned)((4 * fq + aa) * 16 + bb))); }
            if (aa == 0) {
#pragma unroll
                for (int i = 0; i < 16; ++i) fin[i] = c[i];
            } else merge_top16(fin, c);
        }
        xmerge_top16(fin, 16); xmerge_top16(fin, 32);
        float ev[16], es = 0.f; const float mx = __uint_as_float(__float_as_uint(fin[0]) & ~255u);
#pragma unroll
        for (int i = 0; i < 16; ++i) { ev[i] = __expf(__uint_as_float(__float_as_uint(fin[i]) & ~255u) - mx); es += ev[i]; }
        const float inv = 1.f / es;
        asm volatile("s_waitcnt lgkmcnt(0)" ::: "memory");
        int oi[4]; float og[4];
#pragma unroll
        for (int kq = 0; kq < 4; ++kq) {
            const float fk = fq == 0 ? fin[kq] : fq == 1 ? fin[4 + kq] : fq == 2 ? fin[8 + kq] : fin[12 + kq];
            const float fe = fq == 0 ? ev[kq] : fq == 1 ? ev[4 + kq] : fq == 2 ? ev[8 + kq] : ev[12 + kq];
            const unsigned code = 255u - (__float_as_uint(fk) & 255u), a = code >> 4, bq = code & 15u;
            const unsigned i1 = 127u - (scr[a] & 127u), i2 = 127u - (scr[16 + bq] & 127u);
            oi[kq] = (int)(i1 * 128u + i2); og[kq] = fe * inv; }
        *(int4*)(IDX + (size_t)tok * 128 + 16 * h + 4 * fq) = make_int4(oi[0], oi[1], oi[2], oi[3]);
        *(f32x4*)(GATE + (size_t)tok * 128 + 16 * h + 4 * fq) = (f32x4){og[0], og[1], og[2], og[3]};
    }
}
struct PeerSched {
    int x0, rank, nloc, nblk, nown; unsigned orphan;
    __device__ __forceinline__ void init(const Args& A, int nrows, LAS unsigned char* smem) {
        unsigned* ctl = (unsigned*)(A.ws + WS_CTL);
        x0 = (int)(xb_xcc_id() & 7u); rank = __builtin_amdgcn_readfirstlane((int)((LAS unsigned*)smem)[8]); nblk = nrows / 64;
        unsigned cached = __builtin_amdgcn_readfirstlane(((LAS unsigned*)smem)[9]);
        if (cached == 0u) { unsigned orph = 0u, nl = 1u;
            for (int j = 0; j < 8; ++j) { unsigned c = xb_ld(&ctl[XB_XCNT(j)]) + xb_ld(&ctl[XB_XCNT(j + 8)]); c = __builtin_amdgcn_readfirstlane(c); if (c == 0u) orph |= 1u << j; if (j == x0) nl = c; }
            cached = (nl << 8) | orph; __syncthreads(); if (threadIdx.x == 0) ((LAS unsigned*)smem)[9] = cached; __syncthreads(); }
        nloc = (int)(cached >> 8); orphan = cached & 0xffu;
        const int tot = (NSL / 8) * nblk; nown = rank < tot ? (tot - rank + nloc - 1) / nloc : 0;
    }
    __device__ __forceinline__ bool item(int j, int& sl, int& blk) const {
        if (j < nown) { const int i = rank + j * nloc; sl = x0 + 8 * (i / nblk); blk = i % nblk; return true; }
        int jj = j - nown; const int tot = (NSL / 8) * nblk, per = ((int)gridDim.x > tot) ? 1 : 0; (void)per;
        for (int o = 0; o < 8; ++o) if ((orphan >> o) & 1u) { const int cnt = ((int)blockIdx.x < tot) ? (tot - (int)blockIdx.x + (int)gridDim.x - 1) / (int)gridDim.x : 0;
            if (jj < cnt) { const int i = (int)blockIdx.x + jj * (int)gridDim.x; sl = o + 8 * (i / nblk); blk = i % nblk; return true; } jj -= cnt; }
        return false;
    }
};
template <class LD, class PR>
__device__ __forceinline__ void peer_items(const PeerSched& S, LD ld, PR pr) {
    int sl, blk, sln, blkn, j = 0, buf = 0; bool have = S.item(0, sl, blk);
    __syncthreads();
    if (have) ld(sl, blk, 0);
    while (have) {
        const bool haven = S.item(j + 1, sln, blkn);
        asm volatile("s_waitcnt vmcnt(0)" ::: "memory");
        if (haven) ld(sln, blkn, buf ^ 1);
        pr(sl, blk, buf);
        sl = sln; blk = blkn; have = haven; buf ^= 1; ++j;
    }
    __syncthreads();
}
#ifndef MK_UVAR
#define MK_UVAR 0
#endif
__device__ __forceinline__ float dpp_sum8(float v) {
    v += __builtin_bit_cast(float, __builtin_amdgcn_mov_dpp(__builtin_bit_cast(int, v), 0xB1, 0xF, 0xF, true));
    v += __builtin_bit_cast(float, __builtin_amdgcn_mov_dpp(__builtin_bit_cast(int, v), 0x4E, 0xF, 0xF, true));
    v += __builtin_bit_cast(float, __builtin_amdgcn_mov_dpp(__builtin_bit_cast(int, v), 0x141, 0xF, 0xF, true));
    return v;
}
__device__ __forceinline__ void phase_peer_u(const Args& A, int layer, int nrows, LAS unsigned char* smem, int rep) {
    const int var = rep ? MK_UVAR : 0;
    const bf16_t* H = (const bf16_t*)(A.ws + WS_H); const int* IDX = (const int*)(A.ws + WS_R2); float* PART = var ? (float*)(A.ws + WS_R1) : (float*)(A.ws + WS_BIG + BIG_PART);
    const unsigned char* U = A.ws + tabset(layer);
    constexpr int PP = 1088, WB = 4 * PP + 2048;
    const int tid = otid(), wid = tid >> 6, lane = tid & 63, m = lane & 7, tk = lane >> 3;
    const int wu = __builtin_amdgcn_readfirstlane(wid);
    LAS unsigned char* lds = smem + LDS_BASE + wu * (2 * WB);
    PeerSched S; S.init(A, nrows, smem);
    peer_items(S,
        [&](int sl, int blk, int buf) {
#pragma unroll
            for (int i = 0; i < 4; ++i)
                __builtin_amdgcn_global_load_lds((const unsigned*)(IDX + ((size_t)blk * 64 + 8 * wu + 2 * i) * 128 + 4 * lane), (LAS unsigned*)(lds + buf * WB + PP * i), 16, 0, 0);
#pragma unroll
            for (int i = 0; i < 2; ++i)
                __builtin_amdgcn_global_load_lds((const unsigned*)(H + (size_t)(blk * 64 + 8 * wu + 4 * i + (lane >> 4)) * 1024 + SW * sl + 8 * (lane & 15)), (LAS unsigned*)(lds + buf * WB + 4 * PP + 1024 * i), 16, 0, 0); },
        [&](int sl, int blk, int buf) {
            const unsigned char* ub = U + (size_t)sl * NEXP * SW + 16 * m;
            const int tok = blk * 64 + wid * 8 + tk;
            const int sw = (tk & 1) * 4;
            const LAS int* ib = (const LAS int*)(lds + buf * WB + (tk >> 1) * PP + (tk & 1) * 512);
            float hf[16];
            { const u32x4 h0 = *(const LAS u32x4*)(lds + buf * WB + 4 * PP + tk * 256 + 32 * m), h1 = *(const LAS u32x4*)(lds + buf * WB + 4 * PP + tk * 256 + 32 * m + 16);
#pragma unroll
              for (int j = 0; j < 4; ++j) { hf[2 * j] = bflo(h0[j]); hf[2 * j + 1] = bfhi(h0[j]); hf[8 + 2 * j] = bflo(h1[j]); hf[8 + 2 * j + 1] = bfhi(h1[j]); } }
            const bool up4 = m >= 4, up2 = (m & 2) != 0, up1 = (m & 1) != 0;
            float* pp = PART + ((size_t)sl * NROW + tok) * 128 + (m ^ sw);
            u32x4 vv[2][8];
#define PU_ROWS(T, c) do { const i32x4 e0_ = *(const LAS i32x4*)(ib + 8 * (c) + sw), e1_ = *(const LAS i32x4*)(ib + 8 * (c) + (4 - sw)); \
                if (var == 4) { _Pragma("unroll") for (int k_ = 0; k_ < 8; ++k_) vv[T][k_] = (u32x4){(unsigned)e0_.x, (unsigned)e1_.y, 0u, 0u}; } else { \
                vv[T][0] = *(const u32x4*)(ub + (size_t)(var == 3 ? e0_.x & 63 : e0_.x) * SW); vv[T][1] = *(const u32x4*)(ub + (size_t)(var == 3 ? e0_.y & 63 : e0_.y) * SW); \
                vv[T][2] = *(const u32x4*)(ub + (size_t)(var == 3 ? e0_.z & 63 : e0_.z) * SW); vv[T][3] = *(const u32x4*)(ub + (size_t)(var == 3 ? e0_.w & 63 : e0_.w) * SW); \
                vv[T][4] = *(const u32x4*)(ub + (size_t)(var == 3 ? e1_.x & 63 : e1_.x) * SW); vv[T][5] = *(const u32x4*)(ub + (size_t)(var == 3 ? e1_.y & 63 : e1_.y) * SW); \
                vv[T][6] = *(const u32x4*)(ub + (size_t)(var == 3 ? e1_.z & 63 : e1_.z) * SW); vv[T][7] = *(const u32x4*)(ub + (size_t)(var == 3 ? e1_.w & 63 : e1_.w) * SW); } } while (0)
#define PU_DOT(T, c) do { float s_[8]; \
                _Pragma("unroll") for (int k = 0; k < 8; ++k) { f32x2 a2 = {0.f, 0.f}; \
                    _Pragma("unroll") for (int j = 0; j < 4; ++j) { const int w = (int)vv[T][k][j]; \
                        const f32x2 lo = __builtin_amdgcn_cvt_pk_f32_fp8(w, false), hi = __builtin_amdgcn_cvt_pk_f32_fp8(w, true); \
                        a2 = __builtin_elementwise_fma(lo, (f32x2){hf[4 * j], hf[4 * j + 1]}, a2); a2 = __builtin_elementwise_fma(hi, (f32x2){hf[4 * j + 2], hf[4 * j + 3]}, a2); } \
                    s_[k] = a2.x + a2.y; } \
                  \
                float t_[4], u_[2]; \
                _Pragma("unroll") for (int j = 0; j < 4; ++j) { const float give = up4 ? s_[j] : s_[4 + j], keep = up4 ? s_[4 + j] : s_[j]; \
                    t_[j] = keep + __builtin_bit_cast(float, __builtin_amdgcn_mov_dpp(__builtin_bit_cast(int, give), 0x141, 0xF, 0xF, true)); }        \
                _Pragma("unroll") for (int j = 0; j < 2; ++j) { const float give = up2 ? t_[j] : t_[2 + j], keep = up2 ? t_[2 + j] : t_[j]; \
                    u_[j] = keep + __builtin_bit_cast(float, __builtin_amdgcn_mov_dpp(__builtin_bit_cast(int, give), 0x4E, 0xF, 0xF, true)); }         \
                { const float give = up1 ? u_[0] : u_[1], keep = up1 ? u_[1] : u_[0]; \
                  const float tot_ = keep + __builtin_bit_cast(float, __builtin_amdgcn_mov_dpp(__builtin_bit_cast(int, give), 0xB1, 0xF, 0xF, true));           \
                  pp[8 * (c)] = tot_; } } while (0)
            PU_ROWS(0, 0);
#pragma unroll 1
            for (int c = 0; c < 16; c += 2) {
                PU_ROWS(1, c + 1);
                __builtin_amdgcn_sched_barrier(0);
                PU_DOT(0, c);
                __builtin_amdgcn_sched_barrier(0);
                if (c + 2 < 16) PU_ROWS(0, c + 2);
                __builtin_amdgcn_sched_barrier(0);
                PU_DOT(1, c + 1);
                __builtin_amdgcn_sched_barrier(0);
            }
#undef PU_ROWS
#undef PU_DOT
        });
}
__device__ __forceinline__ void phase_coef(const Args& A, int layer, int nrows) {
    const float* PART = (const float*)(A.ws + WS_BIG + BIG_PART); const float* GATE = (const float*)(A.ws + WS_R2 + R2_GATE); float* COEF = (float*)(A.ws + WS_R2 + R2_COEF);
    const int* IDX = (const int*)(A.ws + WS_R2); const float* SCL = (const float*)(A.ws + tabset(layer) + TAB_SCL);
    const int gthr = blockIdx.x * NTHR + otid(), nthr = gridDim.x * NTHR;
    for (int p = gthr; p < nrows * 32; p += nthr) {
        f32x4 s = {0.f, 0.f, 0.f, 0.f};
#pragma unroll
        for (int x = 0; x < NSL; ++x) s += *(const f32x4*)(PART + (size_t)x * NROW * 128 + 4 * p);
        const i32x4 e = *(const i32x4*)(IDX + 4 * p); const f32x4 gt = *(const f32x4*)(GATE + 4 * p);
        const f32x4 su = {SCL[e.x], SCL[e.y], SCL[e.z], SCL[e.w]}, sv = {SCL[NEXP + e.x], SCL[NEXP + e.y], SCL[NEXP + e.z], SCL[NEXP + e.w]};
        const f32x4 a = s * su; const f32x2 g0 = gelu_pk((f32x2){a[0], a[1]}), g1 = gelu_pk((f32x2){a[2], a[3]});
        *(f32x4*)(COEF + 4 * p) = gt * (f32x4){g0.x, g0.y, g1.x, g1.y} * sv; }

}
__device__ __forceinline__ void phase_peer_v(const Args& A, int layer, int nrows, LAS unsigned char* smem, int rep) {
    const int* IDX = (const int*)(A.ws + WS_R2); const float* COEF = (const float*)(A.ws + WS_R2 + R2_COEF);
    const unsigned char* V = A.ws + tabset(layer) + TAB8_HALF; const float* MODL = (const float*)(A.ws + WS_MOD) + (size_t)layer * 5 * 6144 + 5 * 1024;
    bf16_t* XB = (bf16_t*)(A.ws + WS_XB);
    constexpr int PP = 1088, WB = 8 * PP;
    const int tid = otid(), wid = tid >> 6, lane = tid & 63, m = lane & 7, tk = lane >> 3;
    const int wu = __builtin_amdgcn_readfirstlane(wid);
    LAS unsigned char* lds = smem + LDS_BASE + wu * (2 * WB);
    PeerSched S; S.init(A, nrows, smem);
    peer_items(S,
        [&](int sl, int blk, int buf) {
#pragma unroll
            for (int i = 0; i < 4; ++i) {
                __builtin_amdgcn_global_load_lds((const unsigned*)(IDX + ((size_t)blk * 64 + 8 * wu + 2 * i) * 128 + 4 * lane), (LAS unsigned*)(lds + buf * WB + PP * i), 16, 0, 0);
                __builtin_amdgcn_global_load_lds((const unsigned*)(COEF + ((size_t)blk * 64 + 8 * wu + 2 * i) * 128 + 4 * lane), (LAS unsigned*)(lds + buf * WB + 4 * PP + PP * i), 16, 0, 0); } },
        [&](int sl, int blk, int buf) {
            const unsigned char* vb = V + (size_t)sl * NEXP * SW + 16 * m;
            const int tok = blk * 64 + wid * 8 + tk; const bool lat = tok < NLAT;
            const int toff = (tk >> 1) * PP + (tk & 1) * 512, sw = (tk & 1) * 4;
            const LAS int* ib = (const LAS int*)(lds + buf * WB + toff); const LAS float* cb = (const LAS float*)(lds + buf * WB + 4 * PP + toff);
            bf16_t* xp = XB + (size_t)tok * D + SW * sl + 16 * m;
            const u32x4 xr0 = *(const u32x4*)xp, xr1 = *(const u32x4*)(xp + 8);
            f32x2 acc2[8];
#pragma unroll
            for (int j = 0; j < 8; ++j) acc2[j] = (f32x2){0.f, 0.f};
            u32x4 vv[2][8];
#define PV_ROWS(T, c) do { const i32x4 e0_ = *(const LAS i32x4*)(ib + 8 * (c) + sw), e1_ = *(const LAS i32x4*)(ib + 8 * (c) + (4 - sw)); \
                vv[T][0] = *(const u32x4*)(vb + (size_t)e0_.x * SW); vv[T][1] = *(const u32x4*)(vb + (size_t)e0_.y * SW); vv[T][2] = *(const u32x4*)(vb + (size_t)e0_.z * SW); vv[T][3] = *(const u32x4*)(vb + (size_t)e0_.w * SW); \
                vv[T][4] = *(const u32x4*)(vb + (size_t)e1_.x * SW); vv[T][5] = *(const u32x4*)(vb + (size_t)e1_.y * SW); vv[T][6] = *(const u32x4*)(vb + (size_t)e1_.z * SW); vv[T][7] = *(const u32x4*)(vb + (size_t)e1_.w * SW); } while (0)
#define PV_FMA(T, c) do { const f32x4 c0_ = *(const LAS f32x4*)(cb + 8 * (c) + sw), c1_ = *(const LAS f32x4*)(cb + 8 * (c) + (4 - sw)); \
                _Pragma("unroll") for (int k = 0; k < 8; ++k) { const float cf = k < 4 ? c0_[k & 3] : c1_[k & 3]; \
                    _Pragma("unroll") for (int j = 0; j < 4; ++j) { const int w = (int)vv[T][k][j]; \
                        const f32x2 lo = __builtin_amdgcn_cvt_pk_f32_fp8(w, false), hi = __builtin_amdgcn_cvt_pk_f32_fp8(w, true); const f32x2 c2 = {cf, cf}; \
                        acc2[2 * j] = __builtin_elementwise_fma(lo, c2, acc2[2 * j]); acc2[2 * j + 1] = __builtin_elementwise_fma(hi, c2, acc2[2 * j + 1]); } } } while (0)
            PV_ROWS(0, 0);
#pragma unroll 1
            for (int c = 0; c < 16; c += 2) {
                PV_ROWS(1, c + 1);
                __builtin_amdgcn_sched_barrier(0);
                PV_FMA(0, c);
                __builtin_amdgcn_sched_barrier(0);
                if (c + 2 < 16) PV_ROWS(0, c + 2);
                __builtin_amdgcn_sched_barrier(0);
                PV_FMA(1, c + 1);
                __builtin_amdgcn_sched_barrier(0);
            }
#undef PV_ROWS
#undef PV_FMA
            const float* gp = MODL + (size_t)(lat ? (tok >> 13) : 4) * 6144 + SW * sl + 16 * m;
#pragma unroll
            for (int j = 0; j < 4; ++j) { const f32x4 g = *(const f32x4*)(gp + 4 * j); const unsigned w0 = j == 0 ? xr0.x : j == 1 ? xr0.z : j == 2 ? xr1.x : xr1.z, w1 = j == 0 ? xr0.y : j == 1 ? xr0.w : j == 2 ? xr1.y : xr1.w;
                const f32x4 o = (f32x4){bflo(w0), bfhi(w0), bflo(w1), bfhi(w1)} + g * (f32x4){acc2[2 * j].x, acc2[2 * j].y, acc2[2 * j + 1].x, acc2[2 * j + 1].y};
                u32x2 w; w.x = cvt_pk_bf16(o[0], o[1]); w.y = cvt_pk_bf16(o[2], o[3]); *(u32x2*)(xp + 4 * j) = w; }
        });
}

#ifdef MK_CHECK
constexpr int CW_CHK = 3840;
__device__ __forceinline__ float blk_sum(float v, LAS float* red) {
    const int t_ = otid(); v = wave_sum(v); __syncthreads(); if ((t_ & 63) == 0) red[t_ >> 6] = v; __syncthreads();
    float s = 0.f; for (int i = 0; i < 8; ++i) s += red[i]; __syncthreads(); return s;
}
__device__ __forceinline__ float fp8f(unsigned b) { const unsigned e = (b >> 3) & 15u, m = b & 7u; const float v = e ? ldexpf(1.f + (float)m * 0.125f, (int)e - 7) : ldexpf((float)m * 0.125f, -6); return (b & 0x80u) ? -v : v; }
__device__ __forceinline__ void check_attn(const Args& A, LAS unsigned char* lds, bool with_ctx) {
    const unsigned char* Q = A.ws + WS_R1 + R1_Q; const unsigned char* KN = A.ws + WS_R1 + R1_KN; const unsigned char* KR = A.ws + WS_BIG + BIG_KR; const unsigned char* V = A.ws + WS_R1 + R1_V;
    const bf16_t* CAT = (const bf16_t*)(A.ws + WS_R3 + R3_CAT); float* chk = (float*)(A.ws + WS_CTL) + CW_CHK;
    LAS float* p = (LAS float*)lds; LAS float* qv = p + NKEY; LAS float* red = qv + 192;
    const int tid = otid();
    for (int au = blockIdx.x; au < (with_ctx ? 1056 : 1024); au += gridDim.x) {
        int b, h, qrow, orow, nkey;
        if (au < 1024) { b = au >> 8; h = au & 7; const int qb = (au >> 3) & 31, l = 256 * qb + (int)((((unsigned)au * 2654435761u) >> 20) & 255u); qrow = 256 + l; orow = b * 8192 + l; nkey = NKEY; }
        else { const int cu = au - 1024; b = cu >> 3; h = cu & 7; const int lc = (int)((((unsigned)au * 2654435761u) >> 20) & 255u); qrow = lc; orow = NLAT + 256 * b + lc; nkey = 256; }
        const size_t bh = (size_t)(b * 8 + h);
        __syncthreads();
        if (tid < 192) qv[tid] = fp8f(Q[(bh * NKEY + qrow) * 192 + tid]) * (1.f / att8::QUP);
        __syncthreads();
        float mx = -1e30f;
        for (int key = tid; key < nkey; key += 512) { const int t = key >> 6, k = key & 63; float sacc = 0.f;
            for (int d = 0; d < 128; ++d) sacc += qv[d] * fp8f(KN[(bh * NKT + t) * 8192 + att8::kn8(k, d)]);
            for (int d = 0; d < 64; ++d) sacc += qv[128 + d] * fp8f(KR[((size_t)b * NKT + t) * 4096 + att8::kr8(k, d)]);
            p[key] = sacc; mx = fmaxf(mx, sacc); }
        for (int o = 32; o >= 1; o >>= 1) mx = fmaxf(mx, __shfl_xor(mx, o));
        __syncthreads(); if ((tid & 63) == 0) red[tid >> 6] = mx; __syncthreads(); mx = red[0]; for (int i = 1; i < 8; ++i) mx = fmaxf(mx, red[i]); __syncthreads();
        float ls = 0.f; for (int key = tid; key < nkey; key += 512) { const float e = exp2f(p[key] - mx); p[key] = e; ls += e; }
        ls = blk_sum(ls, red);
        float num = 0.f, den = 0.f;
        if (tid < 128) { float o = 0.f; for (int key = 0; key < nkey; ++key) o += p[key] * fp8f(V[(bh * NKT + (key >> 6)) * 8192 + att8::v8(tid, key & 63)]);
            o /= ls; const float got = bf2f(CAT[(size_t)orow * 2048 + 1024 + 128 * h + tid]); num = (got - o) * (got - o); den = o * o; }
        num = blk_sum(num, red); den = blk_sum(den, red);
        if (tid == 0) { atomicAdd(chk, num); atomicAdd(chk + 1, den); }
    }
}
__device__ __forceinline__ void check_qkv(const Args& A, int li, LAS unsigned char* lds) {
    float* chk = (float*)(A.ws + WS_CTL) + CW_CHK;
    const unsigned char* Q = A.ws + WS_R1 + R1_Q; const unsigned char* KN = A.ws + WS_R1 + R1_KN; const unsigned char* KR = A.ws + WS_BIG + BIG_KR; const unsigned char* V = A.ws + WS_R1 + R1_V;
    LAS float* hv = (LAS float*)lds; LAS float* cq = hv + 1024; LAS float* ckv = cq + 384; LAS float* kr = ckv + 256; LAS float* red = kr + 64; LAS float* ov = red + 16;
    const int tid = otid(), sidx = blockIdx.x;
    const int hd = sidx & 7; const int r = (sidx & 8) ? NLAT + (int)(((unsigned)sidx * 2654435761u) >> 22) : (int)(((unsigned)sidx * 2654435761u) >> 17);
    const float* win = A.in[I_HWIN] + (size_t)li * 1024 * HYB_IN;
    {
        const bf16_t* xp = (const bf16_t*)(A.ws + WS_XB) + (size_t)r * D; const float* MODL = (const float*)(A.ws + WS_MOD) + (size_t)(2 * li) * 5 * 6144 + (size_t)row_mb(r) * 6144;
        float ss = 0.f; for (int i = tid; i < 1024; i += 512) ss += bf2f(xp[i]) * bf2f(xp[i]);
        ss = blk_sum(ss, red); const float rstd = rsqrtf(ss / 1024.f + EPS);
        for (int i = tid; i < 1024; i += 512) hv[i] = bf2f(f2bf(bf2f(xp[i]) * rstd * A.in[I_N1G][(2 * li) * 1024 + i] * (1.f + MODL[1024 + i]) + MODL[i])); }
    __syncthreads();
    for (int j = tid; j < 704; j += 512) { float s = 0.f; for (int k = 0; k < 1024; ++k) s += hv[k] * win[(size_t)k * HYB_IN + C_CQ + j];
        s = bf2f(f2bf(s)); if (j < 384) cq[j] = s; else if (j < 640) ckv[j - 384] = s; else kr[j - 640] = s; }
    __syncthreads();
    float sq = 0.f, sk = 0.f; for (int j = tid; j < 384; j += 512) sq += cq[j] * cq[j]; for (int j = tid; j < 256; j += 512) sk += ckv[j] * ckv[j];
    sq = blk_sum(sq, red); sk = blk_sum(sk, red);
    const float rq = rsqrtf(sq / 384.f + EPS), rk = rsqrtf(sk / 256.f + EPS);
    const float* wqb = A.in[I_WQB] + (size_t)li * 384 * 1536; const float* wkvb = A.in[I_WKVB] + (size_t)li * 256 * 2048; const float* qg = A.in[I_QNG] + li * 384; const float* kg = A.in[I_KVNG] + li * 256;
    if (tid < 192) { float s = 0.f; for (int k = 0; k < 384; ++k) s += cq[k] * rq * qg[k] * wqb[(size_t)k * 1536 + hd * 192 + tid]; ov[tid] = s; }
    else if (tid < 448) { const int c = tid - 192; float s = 0.f; for (int k = 0; k < 256; ++k) s += ckv[k] * rk * kg[k] * wkvb[(size_t)k * 2048 + hd * 256 + c]; ov[tid] = s; }
    __syncthreads();
    const bool lat = r < NLAT; const int b = lat ? (r >> 13) : ((r - NLAT) >> 8), l = lat ? (r & 8191) : 0, key = lat ? 256 + l : ((r - NLAT) & 255), qrow = key;
    const size_t bh = (size_t)(b * 8 + hd); const float qs = QSCALE * att8::QUP;
    float num = 0.f, den = 0.f;
    if (tid < 128) {
        const float q = ov[tid] * qs, gq = fp8f(Q[(bh * NKEY + qrow) * 192 + tid]);
        const float kk = ov[192 + tid], gk = fp8f(KN[(bh * NKT + (key >> 6)) * 8192 + att8::kn8(key & 63, tid)]);
        const float vv = ov[320 + tid], gv = fp8f(V[(bh * NKT + (key >> 6)) * 8192 + att8::v8(tid, key & 63)]);
        num = (gq - q) * (gq - q) + (gk - kk) * (gk - kk) + (gv - vv) * (gv - vv); den = q * q + kk * kk + vv * vv;
    } else if (tid < 160) {
        const int i = tid - 128; float c = 1.f, sn = 0.f;
        if (lat) { const float pos = (float)(i < 16 ? (l >> 6) : (l & 63)); const float ang = pos * powf(10000.f, -(float)(i & 15) / 16.f); c = cosf(ang); sn = sinf(ang); }
        const float q1 = ov[128 + i] * qs, q2 = ov[160 + i] * qs, k1 = kr[i], k2 = kr[32 + i];
        const float rq1 = q1 * c - q2 * sn, rq2 = q1 * sn + q2 * c, rk1 = k1 * c - k2 * sn, rk2 = k1 * sn + k2 * c;
        const float gq1 = fp8f(Q[(bh * NKEY + qrow) * 192 + 128 + 2 * i]), gq2 = fp8f(Q[(bh * NKEY + qrow) * 192 + 128 + 2 * i + 1]);
        const float gk1 = fp8f(KR[((size_t)b * NKT + (key >> 6)) * 4096 + att8::kr8(key & 63, 2 * i)]), gk2 = fp8f(KR[((size_t)b * NKT + (key >> 6)) * 4096 + att8::kr8(key & 63, 2 * i + 1)]);
        num = (gq1 - rq1) * (gq1 - rq1) + (gq2 - rq2) * (gq2 - rq2) + (gk1 - rk1) * (gk1 - rk1) + (gk2 - rk2) * (gk2 - rk2); den = rq1 * rq1 + rq2 * rq2 + rk1 * rk1 + rk2 * rk2;
    }
    num = blk_sum(num, red); den = blk_sum(den, red);
    if (tid == 0) { atomicAdd(chk, num); atomicAdd(chk + 1, den); }
}
__device__ __forceinline__ void check_topk(const Args& A, int layer, LAS unsigned char* lds) {
    const bf16_t* QP = (const bf16_t*)(A.ws + WS_BIG); const int* IDX = (const int*)(A.ws + WS_R2); const float* GATE = (const float*)(A.ws + WS_R2 + R2_GATE); float* chk = (float*)(A.ws + WS_CTL) + CW_CHK;
    const bf16_t* K1 = (const bf16_t*)(A.ws + WS_W + W_PEER + (size_t)layer * WP_SZ + WP_K1);
    LAS float* sc = (LAS float*)lds; LAS float* v12 = sc + 256; LAS int* i12 = (LAS int*)(v12 + 32); LAS float* cs = (LAS float*)(i12 + 32); LAS float* ts = cs + 256; LAS int* ti = (LAS int*)(ts + 16); LAS float* red = (LAS float*)(ti + 16);
    const int tid = otid();
    for (int smp = blockIdx.x; smp < 1024; smp += gridDim.x) {
        const int h = smp & 7, tok = (int)((((unsigned)smp * 2654435761u) >> 12) % (unsigned)NROW);
        __syncthreads();
        if (tid < 256) { const int half = tid >> 7, key = tid & 127; float a = 0.f;
            for (int d = 0; d < 128; ++d) a += bf2f(QP[(size_t)tok * 2048 + 256 * h + 128 * half + d]) * bf2f(K1[((size_t)half * 8 + h) * 16384 + key * 128 + d]);
            sc[tid] = a; }
        __syncthreads();
        if (tid < 256) { const int half = tid >> 7, key = tid & 127; const float v = sc[tid]; int rank = 0;
            for (int j = 0; j < 128; ++j) { const float o = sc[half * 128 + j]; rank += (o > v || (o == v && j < key)) ? 1 : 0; }
            if (rank < 16) { v12[half * 16 + rank] = v; i12[half * 16 + rank] = key; } }
        __syncthreads();
        if (tid < 256) cs[tid] = v12[tid >> 4] + v12[16 + (tid & 15)];
        __syncthreads();
        if (tid < 256) { const float v = cs[tid]; int rank = 0;
            for (int j = 0; j < 256; ++j) { const float o = cs[j]; rank += (o > v || (o == v && j < tid)) ? 1 : 0; }
            if (rank < 16) { ts[rank] = v; ti[rank] = i12[tid >> 4] * 128 + i12[16 + (tid & 15)]; } }
        __syncthreads();
        float num = 0.f, den = 0.f;
        if (tid < 16) { float es = 0.f; for (int j = 0; j < 16; ++j) es += __expf(ts[j] - ts[0]); const float gn = __expf(ts[tid] - ts[0]) / es; float gk = 0.f;
            for (int j = 0; j < 16; ++j) if (IDX[(size_t)tok * 128 + 16 * h + j] == ti[tid]) gk = GATE[(size_t)tok * 128 + 16 * h + j];
            num = (gk - gn) * (gk - gn); den = gn * gn; }
        num = blk_sum(num, red); den = blk_sum(den, red);
        if (tid == 0) { atomicAdd(chk, num); atomicAdd(chk + 1, den); }
    }
}
__device__ __forceinline__ void check_ssd(const Args& A, int li, LAS unsigned char* lds) {
    const bf16_t* XS = (const bf16_t*)(A.ws + WS_R2); const bf16_t* BC = (const bf16_t*)(A.ws + WS_R2 + R2_BC); const float* DT = (const float*)(A.ws + WS_BIG + BIG_DT);
    const bf16_t* Y0 = (const bf16_t*)(A.ws + WS_H); const bf16_t* Y1 = (const bf16_t*)(A.ws + WS_R3); float* chk = (float*)(A.ws + WS_CTL) + CW_CHK;
    LAS float* red = (LAS float*)lds;
    const int tid = otid(), sidx = blockIdx.x;
    const int b = sidx & 3, d = (sidx >> 2) & 1, h = (sidx >> 3) & 15, p = (int)((((unsigned)sidx * 2654435761u) >> 20) & 63u), g = h >> 3;
    const float a = -__expf(A.in[I_ALOG][li * 32 + d * 16 + h]);
    const bf16_t* Y = d ? Y1 : Y0;
    float hst = 0.f, num = 0.f, den = 0.f;
    for (int step = 0; step < 8448; ++step) {
        int r;
        if (step < 256) r = NLAT + b * 256 + (d ? 255 - step : step); else { const int q = step - 256; r = b * 8192 + (d ? 8191 - q : q); }
        const float dt = DT[(size_t)(d * 16 + h) * NROW + r], x = bf2f(XS[(size_t)r * 1024 + 64 * h + p]);
        float contrib = 0.f;
        if (tid < 128) { hst = __expf(dt * a) * hst + dt * x * bf2f(BC[(size_t)r * 512 + 128 * g + tid]); contrib = hst * bf2f(BC[(size_t)r * 512 + 256 + 128 * g + tid]); }
        if (step % 61 == 0) { const float y = blk_sum(contrib, red); const float got = bf2f(Y[(size_t)r * 1024 + 64 * h + p]); if (tid == 0) { num += (got - y) * (got - y); den += y * y; } }
    }
    if (tid == 0) { atomicAdd(chk, num); atomicAdd(chk + 1, den); }
}
#endif
#ifndef MK_PER_PHASE
#define MK_PER_PHASE 0
#endif
__device__ __forceinline__ int nr_in(int L) { return L <= 2 ? NROW : NLAT; }
__device__ __forceinline__ int nr_out(int L) { return L <= 1 ? NROW : NLAT; }

__global__ void __launch_bounds__(NTHR, 2) fwd(Args A) {
    extern __shared__ __attribute__((aligned(256))) unsigned char smem_raw[];
    LAS unsigned char* smem = (LAS unsigned char*)smem_raw;
    LAS unsigned char* lds = smem + LDS_BASE;
    const int tid = otid();
    if (tid < 64) ((LAS unsigned*)smem)[tid] = 0u;
    __syncthreads();
    XcdBarrier bar = xcd_barrier_post((unsigned*)(A.ws + WS_CTL), (volatile LAS unsigned*)smem);
    if (tid == 0) ((LAS unsigned*)smem)[8] = atomicAdd((unsigned*)(A.ws + WS_CTL) + CW_RANK + 32 * (xb_xcc_id() & 7u), 1u);
    __syncthreads();
    bool need_bar = false;
    const int lo = A.ph_lo, hi = A.ph_hi;
#ifndef PHMASK
#define PHMASK 0xffffffffu
#endif
#define SITE(k) if constexpr (((PHMASK) >> (k)) & 1u)
#ifndef MK_SVAR
#define MK_SVAR 1
#endif
#ifndef MK_REPEAT_SITE
#define MK_REPEAT_SITE -1
#endif
#define REP(k) for (int rep = 0; rep < ((k) == (MK_REPEAT_SITE) ? 2 : 1); ++rep)
#define PH(id) if ([&]() -> bool { if ((id) < lo || (id) >= hi) return false; if (need_bar) xcd_barrier(bar); need_bar = true; return true; }())
    unsigned char* ws = A.ws;
#define TAIL_TAB(units, layer, rlo, rhi) do { const int nx_ = (units) % 256; if (gridDim.x == 256 && (int)blockIdx.x >= nx_) phase_tabcvt(A, layer, (int)blockIdx.x - nx_, 256 - nx_, rlo, rhi); } while (0)
    bf16_t* XB = (bf16_t*)(ws + WS_XB);
    bf16_t* H = (bf16_t*)(ws + WS_H);
    const float* MOD = (const float*)(ws + WS_MOD);

    SITE(0) PH(0) { phase_prologue(A, lds); }
    SITE(1) PH(1) { phase_norm_mod<true>(A.in[I_X], A.in[I_CTX], XB, A.in[I_N1G], MOD, 0, H, NROW); }
    for (int L = 0; L < DEPTH; ++L) {
        const int base = 2 + 16 * L, li = L >> 1; const bool hyb = (L & 1) == 0;
        const float* MODL = MOD + (size_t)L * 5 * 6144;
        unsigned char* WH = ws + WS_W + W_HYB + (size_t)li * WH_SZ; unsigned char* WG = ws + WS_W + W_GM + (size_t)li * WG_SZ; unsigned char* WP = ws + WS_W + W_PEER + (size_t)L * WP_SZ;
        if (hyb) {
            SITE(2) PH(base + 0) REP(2) { pg8::Gemm g{H, (const bf16_t*)(WH + WH_IN), nr_in(L), HYB_INP, 1024, 1024, 1024};
                pg8::EpiBf16<0> e{(bf16_t*)(ws + WS_BIG), HYB_INP}; pg8::gemm_phase(lds, g, e); }
            SITE(3) PH(base + 1) REP(3) { phase_conv(A, li); }
            SITE(4) PH(base + 2) {
                SITE(18) REP(18) { pg8::Gemm g{(const bf16_t*)(ws + WS_BIG) + C_CQ, (const bf16_t*)(WH + WH_QB), L == 0 ? NROW : NLAT, 1536, 384, HYB_INP, 384};
                  EpiQ e{ws + WS_R1 + R1_Q, (const float*)(ws + WS_RSTD), (const float*)(ws + WS_ROPE)}; pg8::gemm_phase(lds, g, e); }
                SITE(19) REP(19) { pg8::Gemm g{(const bf16_t*)(ws + WS_BIG) + C_CKV, (const bf16_t*)(WH + WH_KVB), NROW, 2048, 256, HYB_INP, 256};
                  EpiKV e{ws + WS_R1 + R1_KN, ws + WS_R1 + R1_V, (const float*)(ws + WS_RSTD) + NROW}; pg8::gemm_phase(lds, g, e); }
                SITE(20) REP(20) for (int u = blockIdx.x; u < 528; u += gridDim.x) ssd::g_unit((const bf16_t*)(ws + WS_R2 + R2_BC), (bf16_t*)(ws + WS_BIG + BIG_G), u);
            }
            SITE(5) PH(base + 3) {
                const int xq = (int)blockIdx.x & 7, jq = (int)blockIdx.x >> 3; const bool ssd_wg = (jq & 1) == 0 && gridDim.x == 256;
                if (gridDim.x == 256) {
                    if (ssd_wg) { const int r = jq >> 1, gi = xq + 8 * (r >> 3), hh = r & 7, sb = gi >> 2, sgp = (gi >> 1) & 1, sd = gi & 1;
                        SITE(21) ssd::ssd_unit(sb, 8 * sgp + hh, sd, (const bf16_t*)(ws + WS_R2), (const bf16_t*)(ws + WS_R2 + R2_BC), (const float*)(ws + WS_BIG + BIG_DT), (const bf16_t*)(ws + WS_BIG + BIG_G),
                                               A.in[I_ALOG] + li * 32, sd ? (bf16_t*)(ws + WS_R3) : (bf16_t*)(ws + WS_H), lds); }
                } else {
                    SITE(21) for (int u = blockIdx.x; u < 128; u += gridDim.x) ssd::ssd_unit(u >> 5, (u >> 1) & 15, u & 1, (const bf16_t*)(ws + WS_R2), (const bf16_t*)(ws + WS_R2 + R2_BC), (const float*)(ws + WS_BIG + BIG_DT),
                                               (const bf16_t*)(ws + WS_BIG + BIG_G), A.in[I_ALOG] + li * 32, (u & 1) ? (bf16_t*)(ws + WS_R3) : (bf16_t*)(ws + WS_H), lds);
                }
                const int nmine = gridDim.x == 256 ? (ssd_wg ? 3 : 5) + (L == 0 && !ssd_wg && jq < 8 ? 1 : 0) : 0;
                SITE(22) REP(22) for (int it = 0; gridDim.x == 256 ? it < nmine : (int)blockIdx.x + it * (int)gridDim.x < (L == 0 ? 1056 : 1024); ++it) {
                    int b, h, qrow0, orow0, nt;
                    if (gridDim.x == 256) {
                        const int base_it = ssd_wg ? 3 : 5;
                        if (it < base_it) { const int v = ssd_wg ? 3 * (jq >> 1) + it : 48 + 5 * (jq >> 1) + it; b = v >> 5; h = xq; const int qb = v & 31; qrow0 = 256 + 256 * qb; orow0 = b * 8192 + 256 * qb; nt = NKT; }
                        else { b = jq >> 1; h = xq; qrow0 = 0; orow0 = NLAT + 256 * b; nt = 4; }
                    } else { const int au = (int)blockIdx.x + it * (int)gridDim.x;
                        if (au < 1024) { b = au >> 8; h = au & 7; const int qb = (au >> 3) & 31; qrow0 = 256 + 256 * qb; orow0 = b * 8192 + 256 * qb; nt = NKT; }
                        else { const int cu = au - 1024; b = cu >> 3; h = cu & 7; qrow0 = 0; orow0 = NLAT + 256 * b; nt = 4; } }
                    const size_t bh = (size_t)(b * 8 + h);
                    att8::attn_unit(ws + WS_R1 + R1_Q + (bh * NKEY + qrow0) * 192, ws + WS_R1 + R1_KN + bh * NKT * 8192, ws + WS_BIG + BIG_KR + (size_t)b * NKT * 4096,
                                    ws + WS_R1 + R1_V + bh * NKT * 8192, (bf16_t*)(ws + WS_R3 + R3_CAT) + (size_t)orow0 * 2048 + 1024 + 128 * h, nt, lds);
                }
                if (gridDim.x == 256 && !ssd_wg && L == 2) SITE(11) phase_tabcvt(A, 3, xq + 8 * (jq >> 1), 128, 0, NEXP);
            }
            SITE(6) PH(base + 4) REP(6) { phase_ssd_out(A, li, nr_out(L));
#if defined(MK_CHECK) && MK_CHECK == 1
                if (L == 0) check_attn(A, lds, true);
#elif defined(MK_CHECK) && MK_CHECK == 2
                if (L == 0) check_qkv(A, li, lds);
#elif defined(MK_CHECK) && MK_CHECK == 3
                if (L == 2) check_attn(A, lds, false);
#elif defined(MK_CHECK) && MK_CHECK == 5
                if (L == 0) check_ssd(A, li, lds);
#elif defined(MK_CHECK) && MK_CHECK == 6
                if (L == 2) check_ssd(A, li, lds);
#endif
            }
        } else {
            SITE(7) PH(base + 0) REP(7) { pg8::Gemm g{H, (const bf16_t*)(WG + WG_IN), nr_out(L), 4096, 1024, 1024, 1024};
                pg8::EpiGmIn e{(bf16_t*)(ws + WS_BIG), (float*)(ws + WS_R3)}; pg8::gemm_phase(lds, g, e);
                if (rep == 0 && L == 1) TAIL_TAB((nr_out(L) / 256) * 16, 1, NEXP, 2 * NEXP); }
            SITE(9) PH(base + 2) REP(9) { phase_spatial(A, li, nr_out(L), lds); }
        }
        SITE(10) PH(base + 5) { pg8::Gemm g{hyb ? (const bf16_t*)(ws + WS_R3 + R3_CAT) : (const bf16_t*)(ws + WS_R1), hyb ? (const bf16_t*)(WH + WH_OUT) : (const bf16_t*)(WG + WG_OUT), nr_out(L), 1024, 2048, 2048, 2048};
            pg8::EpiResid e{XB, MODL + 2 * 1024}; pg8::gemm_phase(lds, g, e);
            if (L == 0) TAIL_TAB((nr_out(L) / 256) * 4, 0, 0, 2 * NEXP); else if (L == 1) TAIL_TAB((nr_out(L) / 256) * 4, 2, 0, 2 * NEXP); }
        SITE(11) PH(base + 6) REP(11) { phase_norm_mod<false>(nullptr, nullptr, XB, A.in[I_N2G] + L * 1024, MODL, 3, H, nr_out(L));
            if (gridDim.x != 256) phase_tabcvt(A, L, (int)blockIdx.x, (int)gridDim.x);
            else if (L == 3) phase_tabcvt(A, 3, (int)blockIdx.x, 256, NEXP, 2 * NEXP); }
        SITE(12) PH(base + 7) REP(12) { pg8::Gemm g{H, (const bf16_t*)(WP + WP_Q), nr_out(L), 2048, 1024, 1024, 1024};
            pg8::EpiBf16<0> e{(bf16_t*)(ws + WS_BIG), 2048}; pg8::gemm_phase(lds, g, e);
            if (rep == 0 && L == 0) TAIL_TAB((nr_out(L) / 256) * 8, 1, 0, NEXP); }
        SITE(13) PH(base + 8) REP(13) { phase_topk(A, L, nr_out(L), lds); }
        SITE(14) PH(base + 9) REP(14) { phase_peer_u(A, L, nr_out(L), smem, rep); }
        SITE(15) PH(base + 10) REP(15) { phase_coef(A, L, nr_out(L));
#if defined(MK_CHECK) && MK_CHECK == 4
            if (L == 1) check_topk(A, L, lds);
#endif
        }
        SITE(16) PH(base + 11) { phase_peer_v(A, L, nr_out(L), smem, 0); }
        SITE(17) PH(base + 12) { if (L < DEPTH - 1) phase_norm_mod<false>(nullptr, nullptr, XB, A.in[I_N1G] + (L + 1) * 1024, MOD + (size_t)(L + 1) * 5 * 6144, 0, H, nr_in(L + 1));
                        else {
#ifdef MK_CHECK
                            const float* chk = (const float*)(ws + WS_CTL) + CW_CHK; const float err = sqrtf(chk[0] / fmaxf(chk[1], 1e-30f));
                            phase_final_norm(XB, A.out, A.in[I_FNG], 1.f + 10.f * err);
#else
                            phase_final_norm(XB, A.out, A.in[I_FNG], 1.f);
#endif
                        } }
    }
#undef PH
}

#ifdef MK_TAP
__global__ void tap_kernel(const unsigned short* buf, size_t pitch, size_t col0, size_t ncols, size_t nrows, float* out) {
    const size_t n = ncols * nrows;
    for (size_t i = (size_t)blockIdx.x * blockDim.x + threadIdx.x; i < (size_t)NLAT * D; i += (size_t)gridDim.x * blockDim.x) {
        float s = 0.f; for (size_t j = i; j < n; j += (size_t)NLAT * D) s += (float)buf[(j / ncols) * pitch + col0 + (j % ncols)]; out[i] = s; }
}
#endif
extern "C" void kernel_launch(void* const* d_in, const int* in_sizes, int n_in, void* d_out, int out_size, void* d_ws, size_t ws_size, hipStream_t stream) {
    static int grid = 0;
    if (grid == 0) {
        if (n_in != N_IN || out_size != NLAT * D || ws_size < WS_END) { fprintf(stderr, "kernel_launch: unexpected shapes (n_in %d out %d ws %zu, need %zu)\n", n_in, out_size, ws_size, (size_t)WS_END); grid = -1; return; }
        int dev = 0, cus = 0, per_cu = 0;
        if (hipGetDevice(&dev) != hipSuccess || hipDeviceGetAttribute(&cus, hipDeviceAttributeMultiprocessorCount, dev) != hipSuccess) { grid = -1; return; }
        if (hipFuncSetAttribute((const void*)fwd, hipFuncAttributeMaxDynamicSharedMemorySize, LDS_BYTES) != hipSuccess) { fprintf(stderr, "kernel_launch: hipFuncSetAttribute failed\n"); grid = -1; return; }
        if (hipOccupancyMaxActiveBlocksPerMultiprocessor(&per_cu, (const void*)fwd, NTHR, LDS_BYTES) != hipSuccess || per_cu < 1) { fprintf(stderr, "kernel_launch: occupancy query says %d\n", per_cu); }
        (void)hipGetLastError();
        grid = cus;
    }
    if (grid < 0) return;
    (void)hipMemsetAsync((char*)d_ws + WS_CTL, 0, CTL_BYTES, stream);
    Args a{};
    for (int i = 0; i < N_IN; ++i) a.in[i] = (const float*)d_in[i];
    a.out = (float*)d_out; a.ws = (unsigned char*)d_ws;
#if MK_PER_PHASE
    for (int id = 0; id < 2 + 16 * DEPTH; ++id) {
        if (id >= 2) { const int L = (id - 2) / 16, s = (id - 2) % 16; if (s > 12) continue; if ((L & 1) && (s == 3 || s == 4)) continue; }
#ifdef MK_CUT
#ifdef MK_TAP
        if (id >= MK_CUT) continue;
#else
        if (id >= MK_CUT && id != 2 + 16 * (DEPTH - 1) + 12) continue;
#endif
#endif
        a.ph_lo = id; a.ph_hi = id + 1;
        hipLaunchKernelGGL(fwd, dim3(grid), dim3(NTHR), LDS_BYTES, stream, a);
    }
#ifdef MK_TAP
    { const size_t tp[5] = {MK_TAP}; hipLaunchKernelGGL(tap_kernel, dim3(2048), dim3(256), 0, stream, (const unsigned short*)((const char*)d_ws + tp[0]), tp[1], tp[2], tp[3], tp[4], (float*)d_out); }
#endif
#else
    a.ph_lo = 0; a.ph_hi = 2 + 16 * DEPTH;
    hipLaunchKernelGGL(fwd, dim3(grid), dim3(NTHR), LDS_BYTES, stream, a);
#endif
    const hipError_t le = hipPeekAtLastError();
    if (le != hipSuccess) fprintf(stderr, "kernel_launch: launch failed: %s\n", hipGetErrorName(le));
}
```

```cpp
#include <hip/hip_runtime.h>
#include <cstdio>
#include <cstdint>

#define LAS __attribute__((address_space(3)))
typedef unsigned short bf16_t;
typedef short bf16x8 __attribute__((ext_vector_type(8)));
typedef short s16x4 __attribute__((ext_vector_type(4)));
typedef float f32x2 __attribute__((ext_vector_type(2)));
typedef float f32x4 __attribute__((ext_vector_type(4)));
typedef float f32x16 __attribute__((ext_vector_type(16)));
typedef unsigned u32x2 __attribute__((ext_vector_type(2)));
typedef unsigned u32x4 __attribute__((ext_vector_type(4)));
typedef int i32x4 __attribute__((ext_vector_type(4)));
typedef int i32x8 __attribute__((ext_vector_type(8)));

constexpr int D = 1024, NB = 4, SEQ = 8192, DEPTH = 4, CTXL = 256;
constexpr int NLAT = NB * SEQ, NCTX = NB * CTXL, NROW = NLAT + NCTX;
constexpr int HYB_IN = 3280, HYB_INP = 3328;
constexpr int C_Z = 0, C_XBC = 1024, C_DT = 2560, C_CQ = 2576, C_CKV = 2960, C_KR = 3216;
constexpr int NKEY = SEQ + CTXL, NKT = NKEY / 64;
constexpr float EPS = 1e-6f;
constexpr float QSCALE = 0.07216878364870322f * 1.4426950408889634f;
constexpr int NEXP = 16384;

enum { I_X = 0, I_C, I_CTX, I_CCTX, I_ADAW, I_ADAB, I_N1G, I_N2G, I_HWIN, I_CONVW, I_CONVB, I_ALOG, I_DTB, I_SSDD, I_SSDNG, I_QNG, I_WQB, I_KVNG, I_WKVB,
       I_HWOUT, I_GWIN, I_GLNG, I_GLNB, I_GWS, I_GBS, I_GWOUT, I_PWQ, I_PK1, I_PK2, I_PU, I_PV, I_FNG, N_IN };

constexpr size_t al256(size_t x) { return (x + 255) & ~(size_t)255; }
constexpr size_t WS_CTL = 0, CTL_BYTES = 65536;
constexpr size_t WS_MOD = WS_CTL + CTL_BYTES;
constexpr size_t WS_ROPE = WS_MOD + al256((size_t)DEPTH * 5 * 6144 * 4);
constexpr size_t WS_RSTD = WS_ROPE + (size_t)2 * SEQ * 32 * 4;
constexpr size_t WS_W = WS_RSTD + al256((size_t)2 * NROW * 4);
constexpr size_t W_HYB = 0;
constexpr size_t WH_IN = 0, WH_QB = WH_IN + (size_t)HYB_INP * 1024 * 2, WH_KVB = WH_QB + (size_t)1536 * 384 * 2, WH_OUT = WH_KVB + (size_t)2048 * 256 * 2,
                 WH_SZ = WH_OUT + (size_t)1024 * 2048 * 2;
constexpr size_t W_GM = W_HYB + 2 * WH_SZ;
constexpr size_t WG_IN = 0, WG_OUT = WG_IN + (size_t)4096 * 1024 * 2, WG_WS = WG_OUT + (size_t)1024 * 2048 * 2, WG_SZ = WG_WS + (size_t)8 * 128 * 128 * 2;
constexpr size_t W_PEER = W_GM + 2 * WG_SZ;
constexpr size_t WP_Q = 0, WP_K1 = WP_Q + (size_t)2048 * 1024 * 2, WP_K2 = WP_K1 + (size_t)8 * 128 * 128 * 2, WP_SZ = WP_K2 + (size_t)8 * 128 * 128 * 2;
constexpr size_t W_TOTAL = W_PEER + 4 * WP_SZ;
constexpr size_t WS_TAB = WS_W + al256(W_TOTAL);
constexpr size_t TAB_HALF = (size_t)NEXP * 1024 * 2;
constexpr size_t TAB_REGION = 2 * TAB_HALF + 524288;
constexpr size_t WS_XB = WS_TAB + TAB_REGION;
constexpr size_t WS_H = WS_XB + (size_t)NROW * D * 2;
constexpr size_t WS_BIG = WS_H + (size_t)NROW * D * 2;
constexpr size_t BIG_BYTES = (size_t)NROW * 4096 * 2;
constexpr size_t BIG_DT = (size_t)NROW * HYB_INP * 2;
constexpr size_t BIG_G = BIG_DT + (size_t)NROW * 32 * 4;
constexpr size_t BIG_KR = BIG_G + (size_t)528 * 128 * 128 * 2;
constexpr size_t BIG_PART = (size_t)NROW * 2048 * 2;
static_assert(BIG_KR + (size_t)NB * NKT * 8192 <= BIG_BYTES, "BIG tail");
constexpr size_t WS_R1 = WS_BIG + BIG_BYTES;
constexpr size_t R1_Q = 0, R1_KN = R1_Q + (size_t)NB * 8 * NKEY * 192, R1_V = R1_KN + (size_t)NB * 8 * NKT * 8192, R1_HYB = R1_V + (size_t)NB * 8 * NKT * 8192,
                 R1_GM = (size_t)NROW * 2048 * 2, R1_BYTES = R1_HYB > R1_GM ? R1_HYB : R1_GM;
constexpr size_t WS_R2 = WS_R1 + R1_BYTES;
constexpr size_t R2_BC = (size_t)NROW * 1024 * 2, R2_BYTES = R2_BC + (size_t)NROW * 512 * 2;
constexpr size_t R2_GATE = (size_t)NROW * 128 * 4, R2_COEF = 2 * R2_GATE;
constexpr size_t WS_R3 = WS_R2 + R2_BYTES;
constexpr size_t R3_CAT = (size_t)NROW * 1024 * 2, R3_BYTES = R3_CAT + (size_t)NROW * 2048 * 2;
constexpr size_t WS_END = WS_R3 + R3_BYTES;
static_assert(WS_END <= ((size_t)1 << 30), "workspace must fit 1 GiB");

constexpr int CW_RANK = 3584;
constexpr int CW_QUEUE = 4096;

typedef __bf16 bf16x2_t __attribute__((ext_vector_type(2)));
__device__ __forceinline__ unsigned cvt_pk_bf16(float lo, float hi) { const f32x2 v = {lo, hi}; const bf16x2_t b = __builtin_convertvector(v, bf16x2_t); return __builtin_bit_cast(unsigned, b); }
__device__ __forceinline__ bf16_t f2bf(float f) { return (bf16_t)(cvt_pk_bf16(f, 0.f) & 0xffffu); }
__device__ __forceinline__ float bf2f(unsigned b) { return __uint_as_float(b << 16); }
__device__ __forceinline__ float bflo(unsigned w) { return __uint_as_float(w << 16); }
__device__ __forceinline__ float bfhi(unsigned w) { return __uint_as_float(w & 0xffff0000u); }
__device__ __forceinline__ float wave_sum(float v) {
#pragma unroll
    for (int o = 32; o >= 1; o >>= 1) v += __shfl_xor(v, o);
    return v;
}
__device__ __forceinline__ int otid() { int t = threadIdx.x; asm volatile("" : "+v"(t)); return t; }
__device__ __forceinline__ float silu_f(float x) { return x * __builtin_amdgcn_rcpf(1.f + __expf(-x)); }
__device__ __forceinline__ float softplus_f(float x) { return x > 20.f ? x : log1pf(__expf(x)); }
__device__ __forceinline__ f32x2 gelu_pk(f32x2 v) {
    const f32x2 av = __builtin_elementwise_abs(v), d = av * 0.2316418882f + 1.0f;
    f32x2 t; t.x = __builtin_amdgcn_rcpf(d.x); t.y = __builtin_amdgcn_rcpf(d.y);
    f32x2 q = t * 0.5307027145f + (-0.7265760135f); q = q * t + 0.7107068705f; q = q * t + (-0.142248368f); q = q * t + 0.127414796f; q = q * t;
    const f32x2 s = (v * v) * (-0.72134752044f);
    f32x2 e; e.x = __builtin_amdgcn_exp2f(s.x); e.y = __builtin_amdgcn_exp2f(s.y);
    const f32x2 m = v * (q * e), r = v - m;
    f32x2 o; o.x = v.x < 0.f ? m.x : r.x; o.y = v.y < 0.f ? m.y : r.y; return o;
}
__device__ __forceinline__ float gelu_f(float x) { f32x2 v = {x, 0.f}; return gelu_pk(v).x; }

__device__ __forceinline__ unsigned pk4_fp8(float a, float b, float c, float d) { int w = 0; w = __builtin_amdgcn_cvt_pk_fp8_f32(a, b, w, false); w = __builtin_amdgcn_cvt_pk_fp8_f32(c, d, w, true); return (unsigned)w; }
__device__ __forceinline__ float sat8(float v) { return __builtin_amdgcn_fmed3f(v, -448.f, 448.f); }
__device__ __forceinline__ unsigned pk4_fp8_sat(float a, float b, float c, float d) { return pk4_fp8(sat8(a), sat8(b), sat8(c), sat8(d)); }
__device__ __forceinline__ int row_mb(int r) { return r < NLAT ? (r >> 13) : 4; }

#define XB_TMO      128
#define XB_XCNT(j)  (256  + 64 * (j))
#define XB_XSUB(j)  (1280 + 64 * (j))
#define XB_XGEN(j)  (2304 + 64 * (j))
#define XB_TOP      3328
#define XB_TOPGEN   3392
#define XCD_BAR_WORDS 3456
#define XB_SPIN_CAP (1u << 22)
__device__ __forceinline__ unsigned xb_ld(unsigned* p)              { return __hip_atomic_load(p, __ATOMIC_RELAXED, __HIP_MEMORY_SCOPE_AGENT); }
__device__ __forceinline__ unsigned xb_add(unsigned* p, unsigned v) { return __hip_atomic_fetch_add(p, v, __ATOMIC_RELAXED, __HIP_MEMORY_SCOPE_AGENT); }
__device__ __forceinline__ unsigned xb_xcc_id() { return (unsigned)__builtin_amdgcn_s_getreg((3 << 11) | 20) & 0xFu; }
#define XB_SPIN(cond, bar) do { unsigned _sp = 0; while (cond) { __builtin_amdgcn_s_sleep(1); \
    if ((++_sp & 255u) == 0u) { if (xb_ld(&(bar)[XB_TMO])) break; if (_sp > XB_SPIN_CAP) { atomicAdd(&(bar)[XB_TMO], 1u); break; } } } } while (0)
struct XcdBarrier { unsigned* bar; unsigned x; volatile LAS unsigned* st; };
__device__ __forceinline__ XcdBarrier xcd_barrier_post(unsigned* bar, volatile LAS unsigned* st) {
    XcdBarrier b; b.bar = bar; b.x = xb_xcc_id(); b.st = st;
    if (threadIdx.x == 0) (void)xb_add(&bar[XB_XCNT(b.x)], 1u);
    return b;
}
__device__ __forceinline__ void xcd_barrier_complete(unsigned* bar, unsigned x, unsigned& nloc, unsigned& nx) {
    const unsigned G = gridDim.x * gridDim.y * gridDim.z;
    unsigned sum, cnt, mine, sp = 0u;
    for (;;) {
        sum = 0u; cnt = 0u; mine = 0u;
#pragma unroll
        for (unsigned j = 0; j < 16; ++j) { const unsigned c = xb_ld(&bar[XB_XCNT(j)]); sum += c; cnt += (c > 0u) ? 1u : 0u; mine = (j == x) ? c : mine; }
        if (sum == G) break;
        __builtin_amdgcn_s_sleep(1);
        if ((++sp & 255u) == 0u) { if (xb_ld(&bar[XB_TMO])) break; if (sp > XB_SPIN_CAP) { atomicAdd(&bar[XB_TMO], 1u); break; } }
    }
    nloc = mine > 0u ? mine : 1u; nx = cnt > 0u ? cnt : 1u;
}
__device__ __forceinline__ void xcd_barrier(const XcdBarrier& b) {
    asm volatile("s_waitcnt vmcnt(0)" ::: "memory");
    __syncthreads();
    if (threadIdx.x == 0) {
        unsigned* bar = b.bar;
        __builtin_amdgcn_s_waitcnt(0);
        unsigned nloc = b.st[0], nx = b.st[1];
        if (nloc == 0u) { xcd_barrier_complete(bar, b.x, nloc, nx); b.st[0] = nloc; b.st[1] = nx; }
        const unsigned old = xb_add(&bar[XB_XSUB(b.x)], 1u);
        const unsigned gen = old / nloc;
        if (old + 1u == (gen + 1u) * nloc) {
            __builtin_amdgcn_fence(__ATOMIC_RELEASE, "agent");
            asm volatile("s_waitcnt vmcnt(0)" ::: "memory");
            const unsigned og = xb_add(&bar[XB_TOP], 1u);
            const unsigned tg = og / nx;
            if (og + 1u == (tg + 1u) * nx) xb_add(&bar[XB_TOPGEN], 1u);
            else XB_SPIN(xb_ld(&bar[XB_TOPGEN]) == tg, bar);
            __builtin_amdgcn_fence(__ATOMIC_ACQUIRE, "agent");
            xb_add(&bar[XB_XGEN(b.x)], 1u);
            asm volatile("s_waitcnt vmcnt(0)" ::: "memory");
        } else {
            XB_SPIN(xb_ld(&bar[XB_XGEN(b.x)]) == gen, bar);
            __builtin_amdgcn_fence(__ATOMIC_ACQUIRE, "agent");
            asm volatile("s_waitcnt vmcnt(0)" ::: "memory");
        }
    }
    __syncthreads();
}

namespace pg8 {
constexpr int BM = 256, BK = 64, HALF = 128, HTB = HALF * BK * 2, STAGE_BYTES = 8 * HTB, NXCD = 8, WGM = 8;
__host__ __device__ __forceinline__ int lds_byte(int r, int c) { const int st = (r >> 4) * 2 + (c >> 5), rr = r & 15, cc = c & 31, ob = rr * 64 + cc * 2; return st * 1024 + (ob ^ (((ob >> 9) & 1) << 5)); }
__host__ __device__ __forceinline__ void stage_rc(int b, int& R, int& C) { const int st = b / 1024, sb = b % 1024, swz = sb ^ (((sb >> 9) & 1) << 5); R = (st >> 1) * 16 + swz / 64; C = (st & 1) * 32 + (swz % 64) / 2; }
__host__ __device__ __forceinline__ int perm32(int rho) { const int n = rho >> 4, i = rho & 15; return 8 * (i >> 2) + 4 * n + (i & 3); }
struct Unit { int pm, pn; };
struct Gemm { const bf16_t* A; const bf16_t* Bt; int M, N, K, lda, ldb; };
struct StaticOrder {
    int nM, nN, nwg, G, c;
    __device__ void init(int M, int N, int G_, int c_) { nM = M / BM; nN = N / BM; nwg = nM * nN; G = G_; c = c_; }
    __device__ bool next(int i, Unit& u) const {
        const long L = (long)i * G + c; if (L >= nwg) return false;
        int wgid = (int)L; { const int q = nwg / NXCD, r = nwg % NXCD, xcd = wgid % NXCD, off = wgid / NXCD; wgid = (xcd < r ? xcd * (q + 1) : r * (q + 1) + (xcd - r) * q) + off; }
        const int nig = WGM * nN, gid = wgid / nig, fm = gid * WGM, gsz = (nM - fm) < WGM ? (nM - fm) : WGM;
        u.pm = fm + ((wgid % nig) % gsz); u.pn = (wgid % nig) / gsz; return true;
    }
};
template <class Epi>
__device__ __forceinline__ void gemm_phase(LAS unsigned char* lds, const Gemm g, const Epi& E) {
    const int tid = otid(), wid = __builtin_amdgcn_readfirstlane(tid >> 6), lane = tid & 63, wr = wid >> 2, wc = wid & 3, fr = lane & 15, fq = lane >> 4;
    StaticOrder S; S.init(g.M, g.N, (int)gridDim.x, (int)blockIdx.x);
    int K = g.K; asm volatile("" : "+s"(K));
    const int nt = K / BK;
    unsigned voffA[2], voffB[2];
#pragma unroll
    for (int i = 0; i < 2; ++i) { int R, C; stage_rc(tid * 16 + i * 8192, R, C); const int Rb = Epi::PERM ? ((R & ~31) + perm32(R & 31)) : R;
        voffA[i] = (unsigned)(R * g.lda + C) * 2u; voffB[i] = (unsigned)(Rb * g.ldb + C) * 2u; }
    const size_t kstep = (size_t)(BK * 2);
    const size_t hstepA = (size_t)HALF * g.lda * 2, hstepB = (size_t)HALF * g.ldb * 2;
    const size_t tstepA = 2 * hstepA, tstepB = 2 * hstepB;
    const unsigned ldsw = (unsigned)wid * 1024u;
    const int aoff = lds_byte(wr * 64 + fr, fq * 8), boff = lds_byte(wc * 32 + fr, fq * 8);
#define PG8_SA(b, h) (((b) * 2 + (h)) * HTB)
#define PG8_SB(b, h) ((4 + (b) * 2 + (h)) * HTB)
#define PG8_STAGE(bufoff, gbase, voff) do { _Pragma("unroll") for (int _i = 0; _i < 2; ++_i) \
        __builtin_amdgcn_global_load_lds((const unsigned*)((const char*)(gbase) + (voff)[_i]), (LAS unsigned*)(lds + (bufoff) + ldsw + _i * 8192), 16, 0, 0); } while (0)
#define PG8_LDA(dst, b, h) do { _Pragma("unroll") for (int m = 0; m < 4; ++m) _Pragma("unroll") for (int k = 0; k < 2; ++k) dst[m][k] = *(const LAS bf16x8*)(lds + PG8_SA(b, h) + aoff + m * 2048 + k * 1024); } while (0)
#define PG8_LDB(dst, b, h) do { _Pragma("unroll") for (int n = 0; n < 2; ++n) _Pragma("unroll") for (int k = 0; k < 2; ++k) dst[n][k] = *(const LAS bf16x8*)(lds + PG8_SB(b, h) + boff + n * 2048 + k * 1024); } while (0)
#define PG8_MMA(ai, bj, At, Bt) do { __builtin_amdgcn_s_setprio(1); _Pragma("unroll") for (int m = 0; m < 4; ++m) _Pragma("unroll") for (int n = 0; n < 2; ++n) _Pragma("unroll") for (int k = 0; k < 2; ++k) \
        acc[ai][bj][m][n] = __builtin_amdgcn_mfma_f32_16x16x32_bf16(Bt[n][k], At[m][k], acc[ai][bj][m][n], 0, 0, 0); __builtin_amdgcn_s_setprio(0); } while (0)
#define PG8_WAIT_V(n) asm volatile("s_waitcnt vmcnt(" #n ")" ::: "memory")
#define PG8_WAIT_L(n) asm volatile("s_waitcnt lgkmcnt(" #n ")" ::: "memory")
#define PG8_BAR __builtin_amdgcn_s_barrier()
#define PG8_SCHED __builtin_amdgcn_sched_barrier(0)
    Unit cur, nxt; int ui = 0;
    if (!S.next(0, cur)) return;
    f32x4 acc[2][2][4][2];
#pragma unroll
    for (int a = 0; a < 2; ++a)
#pragma unroll
        for (int b = 0; b < 2; ++b)
#pragma unroll
            for (int m = 0; m < 4; ++m)
#pragma unroll
                for (int n = 0; n < 2; ++n) acc[a][b][m][n] = (f32x4){0.f, 0.f, 0.f, 0.f};
    bf16x8 At[4][2], B0[2][2], B1[2][2];
    const char* cA = (const char*)g.A + (size_t)cur.pm * tstepA; const char* cB = (const char*)g.Bt + (size_t)cur.pn * tstepB;
    PG8_STAGE(PG8_SB(0, 0), cB, voffB); PG8_STAGE(PG8_SB(0, 1), cB + hstepB, voffB); PG8_STAGE(PG8_SA(0, 0), cA, voffA); PG8_STAGE(PG8_SA(0, 1), cA + hstepA, voffA);
    if (wr == 1) PG8_BAR;
    PG8_WAIT_V(2); PG8_BAR;
    PG8_STAGE(PG8_SB(1, 0), cB + kstep, voffB); PG8_STAGE(PG8_SA(1, 0), cA + kstep, voffA); PG8_STAGE(PG8_SB(1, 1), cB + hstepB + kstep, voffB);
    PG8_WAIT_V(6); PG8_BAR;
    for (;;) {
        const bool has_next = S.next(ui + 1, nxt);
        const char* nA = has_next ? (const char*)g.A + (size_t)nxt.pm * tstepA : cA; const char* nB = has_next ? (const char*)g.Bt + (size_t)nxt.pn * tstepB : cB;
        for (int t = 0; t < nt; t += 2) {
            const bool last = (t == nt - 2);
            const char* a1 = cA + (size_t)(t + 1) * kstep;
            const char* a2 = last ? nA : cA + (size_t)(t + 2) * kstep; const char* b2 = last ? nB : cB + (size_t)(t + 2) * kstep;
            const char* a3 = a2 + kstep; const char* b3 = b2 + kstep;
            PG8_LDB(B0, 0, 0); PG8_LDB(B1, 0, 1); PG8_SCHED; PG8_LDA(At, 0, 0); PG8_STAGE(PG8_SA(1, 1), a1 + hstepA, voffA);
            PG8_WAIT_V(8); PG8_WAIT_L(0); PG8_BAR; PG8_MMA(0, 0, At, B0); PG8_MMA(0, 1, At, B1); PG8_BAR; PG8_SCHED;
            PG8_LDA(At, 0, 1); PG8_STAGE(PG8_SB(0, 0), b2, voffB); PG8_STAGE(PG8_SB(0, 1), b2 + hstepB, voffB); PG8_STAGE(PG8_SA(0, 0), a2, voffA);
            PG8_WAIT_V(8); PG8_WAIT_L(0); PG8_BAR; PG8_MMA(1, 0, At, B0); PG8_MMA(1, 1, At, B1); PG8_BAR; PG8_SCHED;
            PG8_LDB(B0, 1, 0); PG8_LDB(B1, 1, 1); PG8_SCHED; PG8_LDA(At, 1, 0); PG8_STAGE(PG8_SA(0, 1), a2 + hstepA, voffA);
            PG8_WAIT_V(8); PG8_WAIT_L(0); PG8_BAR; PG8_MMA(0, 0, At, B0); PG8_MMA(0, 1, At, B1); PG8_BAR; PG8_SCHED;
            PG8_LDA(At, 1, 1); PG8_STAGE(PG8_SB(1, 0), b3, voffB); PG8_STAGE(PG8_SB(1, 1), b3 + hstepB, voffB); PG8_STAGE(PG8_SA(1, 0), a3, voffA);
            PG8_WAIT_V(8); PG8_WAIT_L(0); PG8_BAR; PG8_MMA(1, 0, At, B0); PG8_MMA(1, 1, At, B1); PG8_BAR; PG8_SCHED;
        }
        if (wr == 0) PG8_BAR;
        { const int l2_ = otid() & 63; E(acc, cur, wr, wc, l2_ & 15, l2_ >> 4); }
        if (!has_next) break;
#pragma unroll
        for (int a = 0; a < 2; ++a)
#pragma unroll
            for (int b = 0; b < 2; ++b)
#pragma unroll
                for (int m = 0; m < 4; ++m)
#pragma unroll
                    for (int n = 0; n < 2; ++n) acc[a][b][m][n] = (f32x4){0.f, 0.f, 0.f, 0.f};
        cur = nxt; cA = nA; cB = nB; ++ui;
        if (wr == 1) PG8_BAR;
    }
    PG8_WAIT_V(0);
    PG8_BAR;
#undef PG8_SA
#undef PG8_SB
#undef PG8_STAGE
#undef PG8_LDA
#undef PG8_LDB
#undef PG8_MMA
#undef PG8_WAIT_V
#undef PG8_WAIT_L
#undef PG8_BAR
#undef PG8_SCHED
}

template <int ACT> struct EpiBf16 {
    static constexpr bool PERM = true;
    bf16_t* O; int ldc;
    __device__ __forceinline__ void operator()(const f32x4 (&acc)[2][2][4][2], const Unit& u, int wr, int wc, int fr, int fq) const {
        const int row0 = u.pm * BM + wr * 64 + fr, col0 = u.pn * BM + wc * 32 + 8 * fq;
#pragma unroll
        for (int ai = 0; ai < 2; ++ai)
#pragma unroll
            for (int m = 0; m < 4; ++m) { bf16_t* rowp = O + (size_t)(row0 + ai * HALF + m * 16) * ldc + col0;
#pragma unroll
                for (int bj = 0; bj < 2; ++bj) { f32x4 v0 = acc[ai][bj][m][0], v1 = acc[ai][bj][m][1];
                    if (ACT == 1) { f32x2 a = gelu_pk((f32x2){v0[0], v0[1]}), b = gelu_pk((f32x2){v0[2], v0[3]}), c = gelu_pk((f32x2){v1[0], v1[1]}), d = gelu_pk((f32x2){v1[2], v1[3]});
                        v0 = (f32x4){a.x, a.y, b.x, b.y}; v1 = (f32x4){c.x, c.y, d.x, d.y}; }
                    u32x4 w; w.x = cvt_pk_bf16(v0[0], v0[1]); w.y = cvt_pk_bf16(v0[2], v0[3]); w.z = cvt_pk_bf16(v1[0], v1[1]); w.w = cvt_pk_bf16(v1[2], v1[3]);
                    *(u32x4*)(rowp + bj * HALF) = w; } }
    }
};
struct EpiGmIn {
    static constexpr bool PERM = true;
    bf16_t* O; float* parts;
    __device__ __forceinline__ void operator()(const f32x4 (&acc)[2][2][4][2], const Unit& u, int wr, int wc, int fr, int fq) const {
        const int row0 = u.pm * BM + wr * 64 + fr, col0 = u.pn * BM + wc * 32 + 8 * fq; const bool vhalf = u.pn >= 8;
#pragma unroll
        for (int ai = 0; ai < 2; ++ai)
#pragma unroll
            for (int m = 0; m < 4; ++m) { const int row = row0 + ai * HALF + m * 16; bf16_t* rowp = O + (size_t)row * 4096 + col0; f32x2 sa = {0.f, 0.f}, sq = {0.f, 0.f};
#pragma unroll
                for (int bj = 0; bj < 2; ++bj) { const f32x4 v0 = acc[ai][bj][m][0], v1 = acc[ai][bj][m][1];
                    const f32x2 a = gelu_pk((f32x2){v0[0], v0[1]}), b = gelu_pk((f32x2){v0[2], v0[3]}), c = gelu_pk((f32x2){v1[0], v1[1]}), d = gelu_pk((f32x2){v1[2], v1[3]});
                    sa += (a + b) + (c + d); sq += (a * a + b * b) + (c * c + d * d);
                    u32x4 w; w.x = cvt_pk_bf16(a.x, a.y); w.y = cvt_pk_bf16(b.x, b.y); w.z = cvt_pk_bf16(c.x, c.y); w.w = cvt_pk_bf16(d.x, d.y);
                    *(u32x4*)(rowp + bj * HALF) = w; }
                if (vhalf) { float s1 = sa.x + sa.y, s2 = sq.x + sq.y;
                    { auto r = __builtin_amdgcn_permlane16_swap(__float_as_uint(s1), __float_as_uint(s1), false, false); s1 = __uint_as_float(r[0]) + __uint_as_float(r[1]); }
                    { auto r = __builtin_amdgcn_permlane16_swap(__float_as_uint(s2), __float_as_uint(s2), false, false); s2 = __uint_as_float(r[0]) + __uint_as_float(r[1]); }
                    { auto r = __builtin_amdgcn_permlane32_swap(__float_as_uint(s1), __float_as_uint(s1), false, false); s1 = __uint_as_float(r[0]) + __uint_as_float(r[1]); }
                    { auto r = __builtin_amdgcn_permlane32_swap(__float_as_uint(s2), __float_as_uint(s2), false, false); s2 = __uint_as_float(r[0]) + __uint_as_float(r[1]); }
                    if (fq == 0) *(f32x2*)(parts + ((size_t)row * 32 + (u.pn - 8) * 4 + wc) * 2) = (f32x2){s1, s2}; } }
    }
};
struct EpiResid {
    static constexpr bool PERM = true;
    bf16_t* X; const float* gate;
    __device__ __forceinline__ void operator()(const f32x4 (&acc)[2][2][4][2], const Unit& u, int wr, int wc, int fr, int fq) const {
        const int rbase = u.pm * BM;
        const float* gp = gate + (size_t)(rbase < NLAT ? (rbase >> 13) : 4) * 6144;
        const int row0 = rbase + wr * 64 + fr, col0 = u.pn * BM + wc * 32 + 8 * fq;
        f32x4 gv[2][2];
#pragma unroll
        for (int bj = 0; bj < 2; ++bj)
#pragma unroll
            for (int n = 0; n < 2; ++n) gv[bj][n] = *(const f32x4*)(gp + col0 + bj * HALF + n * 4);
#pragma unroll
        for (int ai = 0; ai < 2; ++ai)
#pragma unroll
            for (int m = 0; m < 4; ++m) { bf16_t* rowp = X + (size_t)(row0 + ai * HALF + m * 16) * D + col0;
#pragma unroll
                for (int bj = 0; bj < 2; ++bj) { u32x4* p = (u32x4*)(rowp + bj * HALF); const u32x4 x = *p;
                    const f32x4 a0 = (f32x4){bflo(x.x), bfhi(x.x), bflo(x.y), bfhi(x.y)} + gv[bj][0] * acc[ai][bj][m][0], a1 = (f32x4){bflo(x.z), bfhi(x.z), bflo(x.w), bfhi(x.w)} + gv[bj][1] * acc[ai][bj][m][1];
                    u32x4 w; w.x = cvt_pk_bf16(a0[0], a0[1]); w.y = cvt_pk_bf16(a0[2], a0[3]); w.z = cvt_pk_bf16(a1[0], a1[1]); w.w = cvt_pk_bf16(a1[2], a1[3]);
                    *p = w; } }
    }
};
}

namespace att {
#define KSWZ(row, colB) ((row) * 256 + ((colB) ^ (((row) & 7) << 4)))
#define KRSWZ(row, colB) ((row) * 128 + ((colB) ^ ((((row) >> 1) & 7) << 4)))
#define SBAR() __builtin_amdgcn_sched_barrier(0)
__device__ __forceinline__ int crow(int r, int hi) { return (r & 3) + 8 * (r >> 2) + 4 * hi; }
__host__ __device__ __forceinline__ int v_st(int k, int c) { const int kk = (k & ~0xC) | ((k & 4) << 1) | ((k & 8) >> 1); return ((kk >> 3) * 4 + (c >> 5)) * 512 + ((kk & 7) * 32 + (c & 31)) * 2; }
__device__ __forceinline__ int v_rd_base(int lane) { return ((lane & 3) << 3) | (((lane >> 2) & 3) << 6) | (((lane >> 4) & 1) << 5) | (((lane >> 5) & 1) << 8); }
constexpr int v_rd_off(int d0, int ks, int half) { return d0 * 512 + ks * 4096 + half * 2048; }
template <int OFF> __device__ __forceinline__ s16x4 tr_read(int vb) {
    s16x4 r; asm volatile("ds_read_b64_tr_b16 %0, %1 offset:%2" : "=&v"(r) : "v"(vb), "i"(OFF) : "memory"); return r;
}
template <int D0> __device__ __forceinline__ void pv_one(f32x16& od, int vb, bf16x8 pa0, bf16x8 pa1, bf16x8 pa2, bf16x8 pa3) {
    const s16x4 l0 = tr_read<v_rd_off(D0, 0, 0)>(vb), h0 = tr_read<v_rd_off(D0, 0, 1)>(vb), l1 = tr_read<v_rd_off(D0, 1, 0)>(vb), h1 = tr_read<v_rd_off(D0, 1, 1)>(vb);
    const s16x4 l2 = tr_read<v_rd_off(D0, 2, 0)>(vb), h2 = tr_read<v_rd_off(D0, 2, 1)>(vb), l3 = tr_read<v_rd_off(D0, 3, 0)>(vb), h3 = tr_read<v_rd_off(D0, 3, 1)>(vb);
    asm volatile("s_waitcnt lgkmcnt(0)" ::: "memory"); SBAR();
#define PK(L, H) (bf16x8){L[0], L[1], L[2], L[3], H[0], H[1], H[2], H[3]}
    od = __builtin_amdgcn_mfma_f32_32x32x16_bf16(pa0, PK(l0, h0), od, 0, 0, 0);
    od = __builtin_amdgcn_mfma_f32_32x32x16_bf16(pa1, PK(l1, h1), od, 0, 0, 0);
    od = __builtin_amdgcn_mfma_f32_32x32x16_bf16(pa2, PK(l2, h2), od, 0, 0, 0);
    od = __builtin_amdgcn_mfma_f32_32x32x16_bf16(pa3, PK(l3, h3), od, 0, 0, 0);
#undef PK
}
__device__ __forceinline__ void pv_d0(f32x16* o, int vb, bf16x8 pa0, bf16x8 pa1, bf16x8 pa2, bf16x8 pa3) {
    pv_one<0>(o[0], vb, pa0, pa1, pa2, pa3); pv_one<1>(o[1], vb, pa0, pa1, pa2, pa3); pv_one<2>(o[2], vb, pa0, pa1, pa2, pa3); pv_one<3>(o[3], vb, pa0, pa1, pa2, pa3);
}
}

namespace att8 {
constexpr int SLOT = 20480, KN_OFF = 0, KR_OFF = 8192, V_OFF = 12288, LDS_BYTES = 3 * SLOT + 8 * 256;
constexpr float THR2 = 8.0f;
constexpr float QUP = 8.f; constexpr int SC_ONE = 0x7f7f7f7f, SC_Q = 0x7c7c7c7c;
__host__ __device__ __forceinline__ int kn8(int key, int b) { return key * 128 + ((((b >> 4) ^ ((key >> 1) & 7))) << 4) + (b & 15); }
__host__ __device__ __forceinline__ int kr8(int key, int b) { return key * 64 + ((((b >> 4) ^ ((key >> 2) & 3))) << 4) + (b & 15); }
__host__ __device__ __forceinline__ int vslot(int k) { return 32 * ((k >> 2) & 1) + 16 * (k >> 5) + (k & 3) + 4 * ((k & 31) >> 3); }
__host__ __device__ __forceinline__ int v8(int d, int k) { const int sl = vslot(k); return d * 64 + ((((sl >> 4) ^ ((d >> 2) & 3))) << 4) + (sl & 15); }
__device__ __forceinline__ i32x8 ld32(const LAS unsigned char* a0, const LAS unsigned char* a1) { const u32x4 x = *(const LAS u32x4*)a0, y = *(const LAS u32x4*)a1;
    return (i32x8){(int)x.x, (int)x.y, (int)x.z, (int)x.w, (int)y.x, (int)y.y, (int)y.z, (int)y.w}; }
__device__ __forceinline__ void qkt(f32x16& p0, f32x16& p1, LAS unsigned char* slot, const i32x8* qf, int r32, int hi) {
    p0 = f32x16{}; p1 = f32x16{};
#pragma unroll
    for (int ks = 0; ks < 2; ++ks) { const int b = 64 * ks + 32 * hi;
        const i32x8 a0 = ld32(slot + KN_OFF + kn8(r32, b), slot + KN_OFF + kn8(r32, b + 16)), a1 = ld32(slot + KN_OFF + kn8(32 + r32, b), slot + KN_OFF + kn8(32 + r32, b + 16));
        p0 = __builtin_amdgcn_mfma_scale_f32_32x32x64_f8f6f4(a0, qf[ks], p0, 0, 0, 0, SC_ONE, 0, SC_Q);
        p1 = __builtin_amdgcn_mfma_scale_f32_32x32x64_f8f6f4(a1, qf[ks], p1, 0, 0, 0, SC_ONE, 0, SC_Q); }
    { const int b = 32 * hi;
        const i32x8 a0 = ld32(slot + KR_OFF + kr8(r32, b), slot + KR_OFF + kr8(r32, b + 16)), a1 = ld32(slot + KR_OFF + kr8(32 + r32, b), slot + KR_OFF + kr8(32 + r32, b + 16));
        p0 = __builtin_amdgcn_mfma_scale_f32_32x32x64_f8f6f4(a0, qf[2], p0, 0, 0, 0, SC_ONE, 0, SC_Q);
        p1 = __builtin_amdgcn_mfma_scale_f32_32x32x64_f8f6f4(a1, qf[2], p1, 0, 0, 0, SC_ONE, 0, SC_Q); }
}
__device__ __forceinline__ void partialSM(f32x16& p0, f32x16& p1, float& m_reg, float& mn, float& alpha) {
    float pmax = p0[0];
#pragma unroll
    for (int r = 1; r < 16; ++r) pmax = fmaxf(pmax, p0[r]);
#pragma unroll
    for (int r = 0; r < 16; ++r) pmax = fmaxf(pmax, p1[r]);
    { auto rr = __builtin_amdgcn_permlane32_swap(__float_as_uint(pmax), __float_as_uint(pmax), false, false);
      pmax = fmaxf(__uint_as_float(rr[0]), __uint_as_float(rr[1])); }
    if (__builtin_expect(__all(pmax - m_reg <= THR2), 1)) { mn = m_reg; alpha = 1.f; }
    else { mn = fmaxf(m_reg, pmax); alpha = __builtin_amdgcn_exp2f(m_reg - mn); m_reg = mn; }
#pragma unroll
    for (int r = 0; r < 16; ++r) p0[r] = __builtin_amdgcn_exp2f(p0[r] - mn);
#pragma unroll
    for (int r = 0; r < 16; ++r) p1[r] = p1[r] - mn;
}
__device__ __forceinline__ void finishSM(f32x16& p0, f32x16& p1, float alpha, float& l_reg, i32x8& pf) {
#pragma unroll
    for (int r = 0; r < 16; ++r) p1[r] = __builtin_amdgcn_exp2f(p1[r]);
    float ps = 0;
#pragma unroll
    for (int r = 0; r < 16; ++r) ps += p0[r];
#pragma unroll
    for (int r = 0; r < 16; ++r) ps += p1[r];
    { auto rr = __builtin_amdgcn_permlane32_swap(__float_as_uint(ps), __float_as_uint(ps), false, false);
      ps = __uint_as_float(rr[0]) + __uint_as_float(rr[1]); }
    l_reg = l_reg * alpha + ps;
#pragma unroll
    for (int w = 0; w < 4; ++w) { pf[w] = (int)pk4_fp8(p0[4 * w], p0[4 * w + 1], p0[4 * w + 2], p0[4 * w + 3]); pf[4 + w] = (int)pk4_fp8(p1[4 * w], p1[4 * w + 1], p1[4 * w + 2], p1[4 * w + 3]); }
}
__device__ __forceinline__ void pv(f32x16* o, LAS unsigned char* slot, const i32x8 pf, int r32, int hi) {
#pragma unroll
    for (int d0 = 0; d0 < 4; ++d0) { const int d = 32 * d0 + r32, sw = (d >> 2) & 3;
        const i32x8 b = ld32(slot + V_OFF + d * 64 + (((2 * hi) ^ sw) << 4), slot + V_OFF + d * 64 + (((2 * hi + 1) ^ sw) << 4));
        o[d0] = __builtin_amdgcn_mfma_scale_f32_32x32x64_f8f6f4(pf, b, o[d0], 0, 0, 0, SC_ONE, 0, SC_ONE); }
}
__device__ __forceinline__ int crow(int r, int hi) { return (r & 3) + 8 * (r >> 2) + 4 * hi; }
__device__ __forceinline__ void attn_unit(const unsigned char* __restrict__ Qb, const unsigned char* __restrict__ KNt, const unsigned char* __restrict__ KRt, const unsigned char* __restrict__ Vt,
                                          bf16_t* __restrict__ Ob, int NT, LAS unsigned char* lds) {
    const int tid = otid(), wid = __builtin_amdgcn_readfirstlane(tid >> 6), lane = tid & 63, r32 = lane & 31, hi = lane >> 5;
    LAS float* wsf = (LAS float*)(lds + 3 * SLOT) + wid * 64; LAS float* li_l = wsf; LAS float* al_l = wsf + 32;
    float m_reg = -1e30f, l_reg = 0; f32x16 o[4] = {}; i32x8 qf[3];
    const unsigned char* Qw = Qb + (size_t)(wid * 32 + r32) * 192 + 32 * hi;
#pragma unroll
    for (int ks = 0; ks < 3; ++ks) { const u32x4 x = *(const u32x4*)(Qw + 64 * ks), y = *(const u32x4*)(Qw + 64 * ks + 16); qf[ks] = (i32x8){(int)x.x, (int)x.y, (int)x.z, (int)x.w, (int)y.x, (int)y.y, (int)y.z, (int)y.w}; }
    const unsigned lo16 = (unsigned)lane * 16u;
#define ATT_DMA(tile, slotoff) do { const size_t t_ = (size_t)(tile); LAS unsigned char* sl_ = lds + (slotoff); \
        __builtin_amdgcn_global_load_lds((const unsigned*)(KNt + t_ * 8192 + wid * 1024 + lo16), (LAS unsigned*)(sl_ + KN_OFF + wid * 1024), 16, 0, 0); \
        __builtin_amdgcn_global_load_lds((const unsigned*)(Vt + t_ * 8192 + wid * 1024 + lo16), (LAS unsigned*)(sl_ + V_OFF + wid * 1024), 16, 0, 0); \
        if (wid < 4) __builtin_amdgcn_global_load_lds((const unsigned*)(KRt + t_ * 4096 + wid * 1024 + lo16), (LAS unsigned*)(sl_ + KR_OFF + wid * 1024), 16, 0, 0); } while (0)
#define ATT_SYNC() do { asm volatile("s_waitcnt vmcnt(0)" ::: "memory"); __builtin_amdgcn_s_barrier(); asm volatile("" ::: "memory"); } while (0)
#define RESC(a) do { if (__any((a) < 1.f)) { if (hi == 0) al_l[r32] = (a); asm volatile("s_waitcnt lgkmcnt(0)" ::: "memory"); \
        _Pragma("unroll") for (int d = 0; d < 4; ++d) _Pragma("unroll") for (int r = 0; r < 16; ++r) o[d][r] *= al_l[crow(r, hi)]; } } while (0)
    f32x16 pA0, pA1, pB0, pB1; float mnA, mnB, alA, alB; i32x8 pf;
    int sp = 0, sc = SLOT, sn = 2 * SLOT;
    ATT_DMA(0, 0);
    ATT_SYNC();
    ATT_DMA(1, SLOT);
    qkt(pA0, pA1, lds, qf, r32, hi); partialSM(pA0, pA1, m_reg, mnA, alA);
    for (int j = 1; j + 1 < NT; j += 2) {
        ATT_SYNC(); ATT_DMA(j + 1, sn);
        SBAR(); qkt(pB0, pB1, lds + sc, qf, r32, hi);
        finishSM(pA0, pA1, alA, l_reg, pf); SBAR();
        pv(o, lds + sp, pf, r32, hi); partialSM(pB0, pB1, m_reg, mnB, alB);
        RESC(alB);
        { const int t_ = sp; sp = sc; sc = sn; sn = t_; }
        ATT_SYNC(); if (j + 2 < NT) ATT_DMA(j + 2, sn);
        SBAR(); qkt(pA0, pA1, lds + sc, qf, r32, hi);
        finishSM(pB0, pB1, alB, l_reg, pf); SBAR();
        pv(o, lds + sp, pf, r32, hi); partialSM(pA0, pA1, m_reg, mnA, alA);
        RESC(alA);
        { const int t_ = sp; sp = sc; sc = sn; sn = t_; }
    }
    ATT_SYNC();
    SBAR(); qkt(pB0, pB1, lds + sc, qf, r32, hi);
    finishSM(pA0, pA1, alA, l_reg, pf); SBAR();
    pv(o, lds + sp, pf, r32, hi); partialSM(pB0, pB1, m_reg, mnB, alB);
    RESC(alB);
    finishSM(pB0, pB1, alB, l_reg, pf); SBAR();
    pv(o, lds + sc, pf, r32, hi);
    if (hi == 0) li_l[r32] = l_reg; asm volatile("s_waitcnt lgkmcnt(0)" ::: "memory");
    float rli[16];
#pragma unroll
    for (int r = 0; r < 16; ++r) rli[r] = __builtin_amdgcn_rcpf(li_l[crow(r, hi)]);
    bf16_t* Ow = Ob + (size_t)(wid * 32) * 2048;
#pragma unroll
    for (int r = 0; r < 16; ++r) { const int orow = crow(r, hi);
#pragma unroll
        for (int d0 = 0; d0 < 4; ++d0) Ow[(size_t)orow * 2048 + d0 * 32 + r32] = f2bf(o[d0][r] * rli[r]); }
    __builtin_amdgcn_s_barrier(); asm volatile("" ::: "memory");
#undef ATT_DMA
#undef ATT_SYNC
#undef RESC
}
}

namespace ssd {
constexpr int XT_OFF = 0, BT_OFF = 17408, HB_OFF = 52224, SET = 69632, CW_OFF = 2 * SET, LDS_BYTES = CW_OFF + 8 * 1536;
constexpr int PITCH = 272;
constexpr float L2E = 1.4426950408889634f;
__device__ __forceinline__ void g_unit(const bf16_t* __restrict__ BC, bf16_t* __restrict__ G, int unit) {
    const int cid = unit >> 1, g = unit & 1;
    const int r0 = cid < 256 ? cid * 128 : NLAT + (cid - 256) * 128;
    const int tid = otid(), wid = tid >> 6, lane = tid & 63, fr = lane & 15, fq = lane >> 4;
    const bf16_t* Cp = BC + (size_t)(r0 + 16 * wid + fr) * 512 + 256 + 128 * g + 8 * fq;
    bf16x8 cf[4];
#pragma unroll
    for (int ks = 0; ks < 4; ++ks) cf[ks] = *(const bf16x8*)(Cp + 32 * ks);
    bf16_t* Gp = G + ((size_t)unit * 128 + 16 * wid + fr) * 128 + 4 * fq;
#pragma unroll
    for (int sb = 0; sb < 8; ++sb) {
        const bf16_t* Bp = BC + (size_t)(r0 + 16 * sb + fr) * 512 + 128 * g + 8 * fq;
        f32x4 acc = {0.f, 0.f, 0.f, 0.f};
#pragma unroll
        for (int ks = 0; ks < 4; ++ks) { const bf16x8 bfr = *(const bf16x8*)(Bp + 32 * ks); acc = __builtin_amdgcn_mfma_f32_16x16x32_bf16(bfr, cf[ks], acc, 0, 0, 0); }
        u32x2 w; w.x = cvt_pk_bf16(acc[0], acc[1]); w.y = cvt_pk_bf16(acc[2], acc[3]);
        *(u32x2*)(Gp + 16 * sb) = w;
    }
}
__device__ __forceinline__ void ssd_unit(int b, int h, int d, const bf16_t* __restrict__ XS, const bf16_t* __restrict__ BC, const float* __restrict__ DT, const bf16_t* __restrict__ G,
                                         const float* __restrict__ a_log, bf16_t* __restrict__ Y, LAS unsigned char* lds) {
    const int g = h >> 3;
    const int tid = otid(), wid = tid >> 6, lane = tid & 63, fr = lane & 15, fq = lane >> 4;
    const float a = -__expf(a_log[d * 16 + h]);
    LAS float* cw = (LAS float*)(lds + CW_OFF + wid * 1536); LAS float* dts = cw + 128; LAS float* dtw = cw + 256;
    f32x4 hs[4];
#pragma unroll
    for (int q = 0; q < 4; ++q) hs[q] = (f32x4){0.f, 0.f, 0.f, 0.f};
    for (int i = tid; i < 17408 / 4; i += 512) ((LAS unsigned*)(lds + HB_OFF))[i] = 0u;
    float cend = 0.f;
#define SSD_ROWS(step, r0v, gidv) do { if ((step) < 2) { const int oc_ = d ? 1 - (step) : (step); r0v = NLAT + b * 256 + oc_ * 128; gidv = 256 + b * 2 + oc_; } \
        else { const int lc_ = (step) - 2, oc_ = d ? 63 - lc_ : lc_; r0v = b * 8192 + oc_ * 128; gidv = b * 64 + oc_; } } while (0)
    const int sg = tid & 31, n8 = tid >> 5, p4 = tid >> 5;
    f32x2 P_da, Q_da; u32x2 P_xv[4], Q_xv[4]; u32x4 P_bv[4], Q_bv[4], n_gv[4], n_cv[4], c_gv[4], c_cv[4];
#define SSD_LOAD(step, X) do { int r0_, gid_; SSD_ROWS(step, r0_, gid_); (void)gid_; X##_da = *(const f32x2*)(DT + (size_t)(d * 16 + h) * NROW + r0_ + 2 * lane); \
        _Pragma("unroll") for (int j_ = 0; j_ < 4; ++j_) { X##_xv[j_] = *(const u32x2*)(XS + (size_t)(r0_ + 4 * sg + j_) * 1024 + 64 * h + 4 * p4); \
                                                         X##_bv[j_] = *(const u32x4*)(BC + (size_t)(r0_ + 4 * sg + j_) * 512 + 128 * g + 8 * n8); } } while (0)
#define SSD_LOADGC(step) do { int r0_, gid_; SSD_ROWS(step, r0_, gid_); const int t_ = 16 * wid + fr; const bf16_t* Gp_ = G + ((size_t)(gid_ * 2 + g) * 128 + t_) * 128 + 8 * fq; const bf16_t* Cp_ = BC + (size_t)(r0_ + t_) * 512 + 256 + 128 * g + 8 * fq; \
          _Pragma("unroll") for (int ks_ = 0; ks_ < 4; ++ks_) { n_gv[ks_] = *(const u32x4*)(Gp_ + 32 * ks_); n_cv[ks_] = *(const u32x4*)(Cp_ + 32 * ks_); } } while (0)
#define SSD_GCROT() do { _Pragma("unroll") for (int ks_ = 0; ks_ < 4; ++ks_) { c_gv[ks_] = n_gv[ks_]; c_cv[ks_] = n_cv[ks_]; } } while (0)
#define SSD_WRITE(step, X) do { LAS unsigned char* set_ = lds + ((step) & 1) * SET; \
        const float da0 = X##_da.x * a, da1 = X##_da.y * a; \
        float sc_ = da0 + da1; float c0_, c1_; \
        if (d == 0) { _Pragma("unroll") for (int o_ = 1; o_ < 64; o_ <<= 1) { const float t_ = __shfl_up(sc_, o_); if (lane >= o_) sc_ += t_; } \
            c0_ = sc_ - da1; c1_ = sc_; cend = __shfl(sc_, 63); } \
        else { _Pragma("unroll") for (int o_ = 1; o_ < 64; o_ <<= 1) { const float t_ = __shfl_down(sc_, o_); if (lane + o_ < 64) sc_ += t_; } \
            c0_ = sc_; c1_ = sc_ - da0; cend = __shfl(sc_, 0); } \
        *(LAS f32x2*)(cw + 2 * lane) = (f32x2){c0_, c1_}; *(LAS f32x2*)(dts + 2 * lane) = X##_da; \
        *(LAS f32x2*)(dtw + 2 * lane) = (f32x2){X##_da.x * __builtin_amdgcn_exp2f((cend - c0_) * L2E), X##_da.y * __builtin_amdgcn_exp2f((cend - c1_) * L2E)}; \
        { LAS unsigned char* xt_ = set_ + XT_OFF + (4 * p4) * PITCH + 8 * sg; \
          _Pragma("unroll") for (int i_ = 0; i_ < 4; ++i_) { unsigned e_[4]; \
              _Pragma("unroll") for (int j_ = 0; j_ < 4; ++j_) { const unsigned w_ = (i_ & 2) ? X##_xv[j_].y : X##_xv[j_].x; e_[j_] = (i_ & 1) ? (w_ >> 16) : (w_ & 0xffffu); } \
              u32x2 o_; o_.x = e_[0] | (e_[1] << 16); o_.y = e_[2] | (e_[3] << 16); *(LAS u32x2*)(xt_ + i_ * PITCH) = o_; } } \
        { LAS unsigned char* bt_ = set_ + BT_OFF + (8 * n8) * PITCH + 8 * sg; \
          _Pragma("unroll") for (int i_ = 0; i_ < 8; ++i_) { unsigned e_[4]; \
              _Pragma("unroll") for (int j_ = 0; j_ < 4; ++j_) { const unsigned w_ = X##_bv[j_][i_ >> 1]; e_[j_] = (i_ & 1) ? (w_ >> 16) : (w_ & 0xffffu); } \
              u32x2 o_; o_.x = e_[0] | (e_[1] << 16); o_.y = e_[2] | (e_[3] << 16); *(LAS u32x2*)(bt_ + i_ * PITCH) = o_; } } \
        asm volatile("s_waitcnt lgkmcnt(0)" ::: "memory"); \
    } while (0)
    SSD_LOAD(0, Q); SSD_LOADGC(0); SSD_WRITE(0, Q); SSD_LOAD(1, P);
    for (int step2 = 0; step2 < 66; step2 += 2)
#pragma unroll
    for (int par = 0; par < 2; ++par) {
        const int step = step2 + par;
        __syncthreads();
        int r0, gid; SSD_ROWS(step, r0, gid); (void)gid;
        LAS unsigned char* set = lds + (step & 1) * SET;
        const float cend_cur = cend;
        SSD_GCROT();
        if (step + 1 < 66) SSD_LOADGC(step + 1);
        if (step + 2 < 66) { if (par == 0) SSD_LOAD(step + 2, Q); else SSD_LOAD(step + 2, P); }
        {
            const int t = 16 * wid + fr; const float ct = cw[t];
            f32x4 y[4];
#pragma unroll
            for (int q = 0; q < 4; ++q) y[q] = (f32x4){0.f, 0.f, 0.f, 0.f};
            const float et = __builtin_amdgcn_exp2f(ct * L2E);
#pragma unroll
            for (int ks = 0; ks < 4; ++ks) {
                const bool live = d == 0 ? (32 * ks <= 16 * wid + 15) : (32 * ks + 31 >= 16 * wid);
                if (live) {
                    const int s0 = 32 * ks + 8 * fq;
                    const f32x4 c0 = *(const LAS f32x4*)(cw + s0), c1 = *(const LAS f32x4*)(cw + s0 + 4), d0v = *(const LAS f32x4*)(dts + s0), d1v = *(const LAS f32x4*)(dts + s0 + 4);
                    float m[8];
#pragma unroll
                    for (int i = 0; i < 8; ++i) { const float cs = i < 4 ? c0[i & 3] : c1[i & 3], dv = i < 4 ? d0v[i & 3] : d1v[i & 3]; const int s = s0 + i;
                        const bool ok = d == 0 ? (s <= t) : (s >= t);
                        const float gval = (i & 1) ? bfhi(c_gv[ks][i >> 1]) : bflo(c_gv[ks][i >> 1]);
                        m[i] = ok ? gval * dv * __builtin_amdgcn_exp2f((ct - cs) * L2E) : 0.f; }
                    u32x4 mw; mw.x = cvt_pk_bf16(m[0], m[1]); mw.y = cvt_pk_bf16(m[2], m[3]); mw.z = cvt_pk_bf16(m[4], m[5]); mw.w = cvt_pk_bf16(m[6], m[7]);
                    const bf16x8 mb = __builtin_bit_cast(bf16x8, mw);
#pragma unroll
                    for (int q = 0; q < 4; ++q) { const bf16x8 af = *(const LAS bf16x8*)(set + XT_OFF + (16 * q + fr) * PITCH + (32 * ks + 8 * fq) * 2);
                        y[q] = __builtin_amdgcn_mfma_f32_16x16x32_bf16(af, mb, y[q], 0, 0, 0); }
                }
            }
#pragma unroll
            for (int ks = 0; ks < 4; ++ks) {
                u32x4 cwv;
#pragma unroll
                for (int i = 0; i < 4; ++i) cwv[i] = cvt_pk_bf16(bflo(c_cv[ks][i]) * et, bfhi(c_cv[ks][i]) * et);
                const bf16x8 cb = __builtin_bit_cast(bf16x8, cwv);
#pragma unroll
                for (int q = 0; q < 4; ++q) { const bf16x8 af = *(const LAS bf16x8*)(set + HB_OFF + (16 * q + fr) * PITCH + (32 * ks + 8 * fq) * 2);
                    y[q] = __builtin_amdgcn_mfma_f32_16x16x32_bf16(af, cb, y[q], 0, 0, 0); }
            }
            bf16_t* yp = Y + (size_t)(r0 + t) * 1024 + 64 * h + 4 * fq;
#pragma unroll
            for (int q = 0; q < 4; ++q) { u32x2 w; w.x = cvt_pk_bf16(y[q][0], y[q][1]); w.y = cvt_pk_bf16(y[q][2], y[q][3]); *(u32x2*)(yp + 16 * q) = w; }
        }
        {
            const float dec = __builtin_amdgcn_exp2f(cend_cur * L2E);
#pragma unroll
            for (int q = 0; q < 4; ++q) hs[q] = hs[q] * dec;
#pragma unroll
            for (int ks = 0; ks < 4; ++ks) {
                const int s0 = 32 * ks + 8 * fq;
                const u32x4 braw = *(const LAS u32x4*)(set + BT_OFF + (16 * wid + fr) * PITCH + s0 * 2);
                const f32x4 w0 = *(const LAS f32x4*)(dtw + s0), w1 = *(const LAS f32x4*)(dtw + s0 + 4);
                u32x4 bw; bw.x = cvt_pk_bf16(bflo(braw.x) * w0[0], bfhi(braw.x) * w0[1]); bw.y = cvt_pk_bf16(bflo(braw.y) * w0[2], bfhi(braw.y) * w0[3]);
                          bw.z = cvt_pk_bf16(bflo(braw.z) * w1[0], bfhi(braw.z) * w1[1]); bw.w = cvt_pk_bf16(bflo(braw.w) * w1[2], bfhi(braw.w) * w1[3]);
                const bf16x8 bfr = __builtin_bit_cast(bf16x8, bw);
#pragma unroll
                for (int q = 0; q < 4; ++q) { const bf16x8 af = *(const LAS bf16x8*)(set + XT_OFF + (16 * q + fr) * PITCH + s0 * 2);
                    hs[q] = __builtin_amdgcn_mfma_f32_16x16x32_bf16(af, bfr, hs[q], 0, 0, 0); }
            }
            LAS bf16_t* hb = (LAS bf16_t*)(lds + ((step + 1) & 1) * SET + HB_OFF) + 16 * wid + fr;
#pragma unroll
            for (int q = 0; q < 4; ++q)
#pragma unroll
                for (int i = 0; i < 4; ++i) hb[(16 * q + 4 * fq + i) * 136] = f2bf(hs[q][i]);
        }
        if (step + 1 < 66) { if (par == 0) SSD_WRITE(step + 1, P); else SSD_WRITE(step + 1, Q); }
    }
    __syncthreads();
#undef SSD_ROWS
#undef SSD_LOAD
#undef SSD_LOADGC
#undef SSD_GCROT
#undef SSD_WRITE
}
}

struct Args { const float* in[32]; float* out; unsigned char* ws; int ph_lo, ph_hi; };
constexpr int NTHR = 512;
constexpr int LDS_BASE = 256;
constexpr int LDS_PHASE = 151808;
constexpr int LDS_BYTES = LDS_BASE + LDS_PHASE;
static_assert(att8::LDS_BYTES <= LDS_PHASE && ssd::LDS_BYTES <= LDS_PHASE && pg8::STAGE_BYTES <= LDS_PHASE, "LDS");

__device__ __forceinline__ void tjob(int j, const Args& A, const float*& src, bf16_t*& dst, int& K, int& N, int& Npad, int& mode, const float*& ks) {
    unsigned char* W = A.ws + WS_W; mode = 0; ks = nullptr;
    if (j < 8) { const int i = j >> 2, w = j & 3; unsigned char* base = W + W_HYB + (size_t)i * WH_SZ;
        if (w == 0)      { src = A.in[I_HWIN] + (size_t)i * 1024 * HYB_IN; dst = (bf16_t*)(base + WH_IN); K = 1024; N = HYB_IN; Npad = HYB_INP; mode = 1; }
        else if (w == 1) { src = A.in[I_WQB] + (size_t)i * 384 * 1536; dst = (bf16_t*)(base + WH_QB); K = 384; N = 1536; Npad = 1536; mode = 2; ks = A.in[I_QNG] + i * 384; }
        else if (w == 2) { src = A.in[I_WKVB] + (size_t)i * 256 * 2048; dst = (bf16_t*)(base + WH_KVB); K = 256; N = 2048; Npad = 2048; ks = A.in[I_KVNG] + i * 256; }
        else             { src = A.in[I_HWOUT] + (size_t)i * 2048 * 1024; dst = (bf16_t*)(base + WH_OUT); K = 2048; N = 1024; Npad = 1024; }
    } else if (j < 12) { const int i = (j - 8) >> 1, w = (j - 8) & 1; unsigned char* base = W + W_GM + (size_t)i * WG_SZ;
        if (w == 0) { src = A.in[I_GWIN] + (size_t)i * 1024 * 4096; dst = (bf16_t*)(base + WG_IN); K = 1024; N = 4096; Npad = 4096; }
        else        { src = A.in[I_GWOUT] + (size_t)i * 2048 * 1024; dst = (bf16_t*)(base + WG_OUT); K = 2048; N = 1024; Npad = 1024; }
    } else { const int l = j - 12; src = A.in[I_PWQ] + (size_t)l * 1024 * 2048; dst = (bf16_t*)(W + W_PEER + (size_t)l * WP_SZ + WP_Q); K = 1024; N = 2048; Npad = 2048; }
}
__device__ __forceinline__ int colmap(int mode, int n, int N) {
    if (mode == 1) { if (n >= N) return -1; if (n < C_KR) return n; const int m = n - C_KR; return C_KR + (m >> 1) + 32 * (m & 1); }
    if (mode == 2) { if (n < 1024) return (n >> 7) * 192 + (n & 127); const int m = n - 1024, h = m >> 6, mm = m & 63; return h * 192 + 128 + (mm >> 1) + 32 * (mm & 1); }
    return n;
}
__device__ __forceinline__ void phase_prologue(const Args& A, LAS unsigned char* lds) {
    const int tid = otid();
    {
        LAS float* tile = (LAS float*)lds;
        int item = blockIdx.x;
        for (int j = 0; j < 16; ++j) {
            const float* src; bf16_t* dst; int K, N, Npad, mode; const float* ks; tjob(j, A, src, dst, K, N, Npad, mode, ks);
            const int nsub = (K % 256 == 0) ? 4 : 2, tk = K / (64 * nsub), tn = Npad / 64, nt = tk * tn;
            for (; item < nt; item += gridDim.x) {
                const int k0 = (item % tk) * 64 * nsub, n0 = (item / tk) * 64;
                { const int k = tid >> 3, cg = tid & 7; float v[4][8];
#pragma unroll
                  for (int t = 0; t < 4; ++t) if (t < nsub) { const float sc = ks ? ks[k0 + 64 * t + k] : 1.f;
#pragma unroll
                      for (int jj = 0; jj < 8; ++jj) { const int oc = colmap(mode, n0 + 8 * cg + jj, N); v[t][jj] = oc >= 0 ? src[(size_t)(k0 + 64 * t + k) * N + oc] * sc : 0.f; } }
#pragma unroll
                  for (int t = 0; t < 4; ++t) if (t < nsub) {
#pragma unroll
                      for (int jj = 0; jj < 8; ++jj) tile[t * 4160 + k * 65 + 8 * cg + jj] = v[t][jj]; } }
                __syncthreads();
                { const int n = tid >> 3, kg = tid & 7;
#pragma unroll
                  for (int t = 0; t < 4; ++t) if (t < nsub) { float v[8];
#pragma unroll
                      for (int jj = 0; jj < 8; ++jj) v[jj] = tile[t * 4160 + (8 * kg + jj) * 65 + n];
                      u32x4 w; w.x = cvt_pk_bf16(v[0], v[1]); w.y = cvt_pk_bf16(v[2], v[3]); w.z = cvt_pk_bf16(v[4], v[5]); w.w = cvt_pk_bf16(v[6], v[7]);
                      *(u32x4*)(dst + (size_t)(n0 + n) * K + k0 + 64 * t + 8 * kg) = w; } }
                __syncthreads();
            }
            item -= nt;
        }
    }
    {
        const int gthr = blockIdx.x * NTHR + tid, nthr = gridDim.x * NTHR;
        for (int p = gthr; p < 10 * 16384; p += nthr) {
            const int mat = p >> 14, off = (p & 16383) * 8; const float* src; bf16_t* dst;
            if (mat < 2)      { src = A.in[I_GWS] + (size_t)mat * 131072; dst = (bf16_t*)(A.ws + WS_W + W_GM + (size_t)mat * WG_SZ + WG_WS); }
            else if (mat < 6) { src = A.in[I_PK1] + (size_t)(mat - 2) * 131072; dst = (bf16_t*)(A.ws + WS_W + W_PEER + (size_t)(mat - 2) * WP_SZ + WP_K1); }
            else              { src = A.in[I_PK2] + (size_t)(mat - 6) * 131072; dst = (bf16_t*)(A.ws + WS_W + W_PEER + (size_t)(mat - 6) * WP_SZ + WP_K2); }
            const f32x4 a = *(const f32x4*)(src + off), b = *(const f32x4*)(src + off + 4);
            u32x4 w; w.x = cvt_pk_bf16(a[0], a[1]); w.y = cvt_pk_bf16(a[2], a[3]); w.z = cvt_pk_bf16(b[0], b[1]); w.w = cvt_pk_bf16(b[2], b[3]);
            *(u32x4*)(dst + off) = w;
        }
        float* rope = (float*)(A.ws + WS_ROPE);
        for (int p = gthr; p < SEQ * 32; p += nthr) { const int l = p >> 5, i = p & 31; const float pos = (float)(i < 16 ? (l >> 6) : (l & 63));
            const float inv = powf(10000.f, -(float)(i & 15) / 16.f), ang = pos * inv; rope[p] = cosf(ang); rope[SEQ * 32 + p] = sinf(ang); }
    }
    {
        LAS float* scond = (LAS float*)lds;
        LAS float* red = scond + 5 * 1024;
        __syncthreads();
        for (int i = tid; i < 5 * 1024; i += NTHR) { const int m = i >> 10, k = i & 1023; const float c = m < 4 ? A.in[I_C][m * 1024 + k] : A.in[I_CCTX][k]; scond[i] = silu_f(c); }
        __syncthreads();
        float* MOD = (float*)(A.ws + WS_MOD);
        for (int item = blockIdx.x; item < 4 * 48; item += gridDim.x) {
            const int layer = item / 48, j0 = (item % 48) * 128; const int c4 = tid & 31, ksl = tid >> 5;
            f32x4 acc[5];
#pragma unroll
            for (int m = 0; m < 5; ++m) acc[m] = (f32x4){0.f, 0.f, 0.f, 0.f};
            const float* wp = A.in[I_ADAW] + ((size_t)layer * 1024 + ksl * 64) * 6144 + j0 + 4 * c4;
            for (int k = 0; k < 64; ++k) { const f32x4 w = *(const f32x4*)(wp + (size_t)k * 6144);
#pragma unroll
                for (int m = 0; m < 5; ++m) acc[m] += w * scond[m * 1024 + ksl * 64 + k]; }
#pragma unroll
            for (int m = 0; m < 5; ++m) *(LAS f32x4*)(red + (ksl * 5 + m) * 128 + 4 * c4) = acc[m];
            __syncthreads();
            for (int i = tid; i < 640; i += NTHR) { const int m = i >> 7, c = i & 127; float s = A.in[I_ADAB][layer * 6144 + j0 + c];
#pragma unroll
                for (int q = 0; q < 16; ++q) s += red[(q * 5 + m) * 128 + c];
                MOD[((size_t)layer * 5 + m) * 6144 + j0 + c] = s; }
            __syncthreads();
        }
    }
}

template <bool F32SRC>
__device__ __forceinline__ void phase_norm_mod(const float* xl, const float* xc, bf16_t* XB, const float* g, const float* modl, int sh_idx, bf16_t* H, int nrows) {
    const int tid_ = otid(); const int lane = tid_ & 63, gw = blockIdx.x * 8 + (tid_ >> 6), nw = gridDim.x * 8;
    f32x4 gv[4];
#pragma unroll
    for (int i = 0; i < 4; ++i) gv[i] = *(const f32x4*)(g + 256 * i + 4 * lane);
    for (int r = gw; r < nrows; r += nw) {
        const bool lat = r < NLAT;
        f32x4 x[4]; float ss = 0.f;
        if (F32SRC) { const float* xp = lat ? xl + (size_t)r * D : xc + (size_t)(r - NLAT) * D;
#pragma unroll
            for (int i = 0; i < 4; ++i) { x[i] = *(const f32x4*)(xp + 256 * i + 4 * lane);
                u32x2 w; w.x = cvt_pk_bf16(x[i][0], x[i][1]); w.y = cvt_pk_bf16(x[i][2], x[i][3]); *(u32x2*)(XB + (size_t)r * D + 256 * i + 4 * lane) = w;
 }
        } else {
#pragma unroll
            for (int i = 0; i < 4; ++i) { const u32x2 w = *(const u32x2*)(XB + (size_t)r * D + 256 * i + 4 * lane); x[i] = (f32x4){bflo(w.x), bfhi(w.x), bflo(w.y), bfhi(w.y)}; } }
#pragma unroll
        for (int i = 0; i < 4; ++i) ss += x[i][0] * x[i][0] + x[i][1] * x[i][1] + x[i][2] * x[i][2] + x[i][3] * x[i][3];
        ss = wave_sum(ss); const float rstd = rsqrtf(ss * (1.f / 1024.f) + EPS);
        const float* mp = modl + (size_t)(lat ? (r >> 13) : 4) * 6144 + sh_idx * 1024;
#pragma unroll
        for (int i = 0; i < 4; ++i) { const f32x4 sh = *(const f32x4*)(mp + 256 * i + 4 * lane), sc = *(const f32x4*)(mp + 1024 + 256 * i + 4 * lane);
            const f32x4 hv = (x[i] * rstd) * gv[i] * (sc + 1.f) + sh;
            u32x2 w; w.x = cvt_pk_bf16(hv[0], hv[1]); w.y = cvt_pk_bf16(hv[2], hv[3]);
            *(u32x2*)(H + (size_t)r * D + 256 * i + 4 * lane) = w; }
    }
}
__device__ __forceinline__ void phase_final_norm(const bf16_t* XB, float* out, const float* g, float oscale) {
    const int tid_ = otid(); const int lane = tid_ & 63, gw = blockIdx.x * 8 + (tid_ >> 6), nw = gridDim.x * 8;
    f32x4 gv[4];
#pragma unroll
    for (int i = 0; i < 4; ++i) gv[i] = *(const f32x4*)(g + 256 * i + 4 * lane);
    for (int r = gw; r < NLAT; r += nw) {
        f32x4 x[4]; float ss = 0.f;
#pragma unroll
        for (int i = 0; i < 4; ++i) { const u32x2 w = *(const u32x2*)(XB + (size_t)r * D + 256 * i + 4 * lane); x[i] = (f32x4){bflo(w.x), bfhi(w.x), bflo(w.y), bfhi(w.y)};
            ss += x[i][0] * x[i][0] + x[i][1] * x[i][1] + x[i][2] * x[i][2] + x[i][3] * x[i][3]; }
        ss = wave_sum(ss); const float rstd = rsqrtf(ss * (1.f / 1024.f) + EPS);
#pragma unroll
        for (int i = 0; i < 4; ++i) *(f32x4*)(out + (size_t)r * D + 256 * i + 4 * lane) = (x[i] * (rstd * oscale)) * gv[i];
    }
}

#ifndef MK_CVAR
#define MK_CVAR 0
#endif
__device__ __forceinline__ void phase_conv(const Args& A, int li, int rep = 0) {
    const int cvar = rep ? MK_CVAR : 0;
    const bf16_t* PROJ = (const bf16_t*)(A.ws + WS_BIG);
    bf16_t* XS = (bf16_t*)(A.ws + WS_R2); bf16_t* BC = (bf16_t*)(A.ws + WS_R2 + R2_BC);
    const int tid = otid();
    if (cvar != 2) {
        for (int item = blockIdx.x * 3; item < (NROW / 64) * 3; item += gridDim.x * 3)
#pragma unroll 1
        for (int sub = 0; sub < 3; ++sub) {
            const int blk = (item + sub) / 3, q = ((item + sub) % 3) * 512 + tid, cg = q % 192, rg = q / 192, c0 = 8 * cg;
            const int rbeg = blk * 64 + rg * 8; int s0, s1;
            if (rbeg < NLAT) { s0 = rbeg & ~8191; s1 = s0 + 8192; } else { s0 = NLAT + ((rbeg - NLAT) & ~255); s1 = s0 + 256; }
            const float* cw = A.in[I_CONVW] + ((size_t)li * 1536 + c0) * 5; const float* cb = A.in[I_CONVB] + (size_t)li * 1536 + c0;
            u32x4 in[12];
#pragma unroll
            for (int i = 0; i < 12; ++i) { const int r = rbeg - 2 + i; in[i] = (r >= s0 && r < s1) ? *(const u32x4*)(PROJ + (size_t)r * HYB_INP + C_XBC + c0) : (u32x4){0u, 0u, 0u, 0u}; }
            float w[8][5], bia[8];
#pragma unroll
            for (int j = 0; j < 8; ++j) { bia[j] = cb[j];
#pragma unroll
                for (int k = 0; k < 5; ++k) w[j][k] = cw[j * 5 + k]; }
#pragma unroll
            for (int rr = 0; rr < 8; ++rr) {
                float o[8];
#pragma unroll
                for (int j = 0; j < 8; ++j) { float sacc = bia[j];
#pragma unroll
                    for (int k = 0; k < 5; ++k) { const unsigned wd = in[rr + k][j >> 1]; sacc += w[j][k] * ((j & 1) ? bfhi(wd) : bflo(wd)); }
                    o[j] = silu_f(sacc); }
                u32x4 pk; pk.x = cvt_pk_bf16(o[0], o[1]); pk.y = cvt_pk_bf16(o[2], o[3]); pk.z = cvt_pk_bf16(o[4], o[5]); pk.w = cvt_pk_bf16(o[6], o[7]);
                const int r = rbeg + rr;
                if (c0 < 1024) *(u32x4*)(XS + (size_t)r * 1024 + c0) = pk; else *(u32x4*)(BC + (size_t)r * 512 + (c0 - 1024)) = pk;
            }
        }
    }
    if (cvar != 1) {
        const int lane = tid & 63, gw = blockIdx.x * 8 + (tid >> 6), nw = gridDim.x * 8;
        float* DT = (float*)(A.ws + WS_BIG + BIG_DT); float* RQ = (float*)(A.ws + WS_RSTD); float* RKV = RQ + NROW;
        unsigned char* KR = A.ws + WS_BIG + BIG_KR; const float* rope = (const float*)(A.ws + WS_ROPE);
        const float dtb = lane < 32 ? A.in[I_DTB][li * 32 + lane] : 0.f;
        for (int rb = gw * 4; rb < NROW; rb += nw * 4) {
            unsigned wq[4][3]; u32x2 wk[4]; unsigned wr_[4]; float dtv[4], rc[4], rsn[4];
#pragma unroll
            for (int i = 0; i < 4; ++i) { const int r = rb + i; const bf16_t* p = PROJ + (size_t)r * HYB_INP;
                const unsigned* q = (const unsigned*)(p + C_CQ + 6 * lane); wq[i][0] = q[0]; wq[i][1] = q[1]; wq[i][2] = q[2];
                wk[i] = *(const u32x2*)(p + C_CKV + 4 * lane);
                dtv[i] = lane < 32 ? bf2f(p[C_DT + (lane & 15)]) : 0.f; wr_[i] = lane < 32 ? *(const unsigned*)(p + C_KR + 2 * lane) : 0u;
                const int l = r & 8191; rc[i] = (lane < 32 && r < NLAT) ? rope[l * 32 + lane] : 1.f; rsn[i] = (lane < 32 && r < NLAT) ? rope[SEQ * 32 + l * 32 + lane] : 0.f; }
#pragma unroll
            for (int i = 0; i < 4; ++i) { const int r = rb + i;
                if (lane < 32) DT[(size_t)lane * NROW + r] = softplus_f(dtv[i] + dtb);
                { float ss = 0.f;
#pragma unroll
                  for (int j = 0; j < 3; ++j) { const float a = bflo(wq[i][j]), b = bfhi(wq[i][j]); ss += a * a + b * b; }
                  ss = wave_sum(ss); if (lane == 0) RQ[r] = rsqrtf(ss * (1.f / 384.f) + EPS); }
                { const float a = bflo(wk[i].x), b = bfhi(wk[i].x), c = bflo(wk[i].y), d = bfhi(wk[i].y);
                  float ss = a * a + b * b + c * c + d * d; ss = wave_sum(ss); if (lane == 0) RKV[r] = rsqrtf(ss * (1.f / 256.f) + EPS); }
                if (lane < 32) { const float x1 = bflo(wr_[i]), x2 = bfhi(wr_[i]); int b, key;
                    const float o1 = x1 * rc[i] - x2 * rsn[i], o2 = x1 * rsn[i] + x2 * rc[i];
                    if (r < NLAT) { b = r >> 13; key = 256 + (r & 8191); } else { b = (r - NLAT) >> 8; key = (r - NLAT) & 255; }
                    int w8 = 0; w8 = __builtin_amdgcn_cvt_pk_fp8_f32(sat8(o1), sat8(o2), w8, false);
                    *(unsigned short*)(KR + (size_t)(b * NKT + (key >> 6)) * 4096 + att8::kr8(key & 63, 2 * lane)) = (unsigned short)(w8 & 0xffff); }
            }
        }
    }
}

struct EpiQ {
    static constexpr bool PERM = true;
    unsigned char* Q; const float* rstd; const float* rope;
    __device__ __forceinline__ void operator()(const f32x4 (&acc)[2][2][4][2], const pg8::Unit& u, int wr, int wc, int fr, int fq) const {
        const bool lat = u.pm < 128;
        const int b = lat ? (u.pm >> 5) : (u.pm - 128), q0 = lat ? 256 + ((u.pm & 31) << 8) : 0;
        const bool isrope = u.pn >= 4;
#pragma unroll
        for (int ai = 0; ai < 2; ++ai) {
            const int rl = 128 * ai + 64 * wr + fr;
            const float* rsp = rstd + u.pm * 256 + rl;
            const float* rp = rope + (size_t)(((u.pm & 31) << 8) + rl) * 32;
#pragma unroll
            for (int bj = 0; bj < 2; ++bj) {
                const int c0 = u.pn * 256 + 128 * bj + 32 * wc + 8 * fq; int h, dcol;
                if (!isrope) { h = c0 >> 7; dcol = c0 & 127; } else { const int mq = c0 - 1024; h = mq >> 6; dcol = 128 + (mq & 63); }
                unsigned char* dst = Q + ((size_t)(b * 8 + h) * NKEY + q0 + rl) * 192 + dcol;
                const int ro = (dcol - 128) >> 1;
#pragma unroll
                for (int m = 0; m < 4; ++m) {
                    const float rs = rsp[16 * m] * (QSCALE * att8::QUP);
                    f32x4 v0 = acc[ai][bj][m][0] * rs, v1 = acc[ai][bj][m][1] * rs;
                    if (isrope && lat) { const f32x4 cs = *(const f32x4*)(rp + 16 * m * 32 + ro), sn = *(const f32x4*)(rp + SEQ * 32 + 16 * m * 32 + ro);
                        const f32x4 a0 = v0, a1 = v1;
                        v0[0] = a0[0] * cs[0] - a0[1] * sn[0]; v0[1] = a0[0] * sn[0] + a0[1] * cs[0]; v0[2] = a0[2] * cs[1] - a0[3] * sn[1]; v0[3] = a0[2] * sn[1] + a0[3] * cs[1];
                        v1[0] = a1[0] * cs[2] - a1[1] * sn[2]; v1[1] = a1[0] * sn[2] + a1[1] * cs[2]; v1[2] = a1[2] * cs[3] - a1[3] * sn[3]; v1[3] = a1[2] * sn[3] + a1[3] * cs[3]; }
                    u32x2 w; w.x = pk4_fp8_sat(v0[0], v0[1], v0[2], v0[3]); w.y = pk4_fp8_sat(v1[0], v1[1], v1[2], v1[3]);
                    *(u32x2*)(dst + 16 * m * 192) = w;
                    asm volatile("" ::: "memory");
                }
            }
        }
    }
};
struct EpiKV {
    static constexpr bool PERM = true;
    unsigned char* KN; unsigned char* V; const float* rstd;
    __device__ __forceinline__ void operator()(const f32x4 (&acc)[2][2][4][2], const pg8::Unit& u, int wr, int wc, int fr, int fq) const {
        const bool lat = u.pm < 128;
        const int b = lat ? (u.pm >> 5) : (u.pm - 128), t0 = lat ? 4 + ((u.pm & 31) << 2) : 0;
        const int dd = 32 * wc + 8 * fq;
        const int offK = fr * 128 + ((((dd >> 4) ^ ((fr >> 1) & 7))) << 4) + (dd & 15);
#pragma unroll
        for (int ai = 0; ai < 2; ++ai) {
            const size_t tb = ((size_t)(b * 8 + u.pn) * NKT + t0 + 2 * ai + wr) * 8192;
            const float* rsp = rstd + u.pm * 256 + 128 * ai + 64 * wr + fr;
            unsigned char* kp = KN + tb + offK; unsigned char* vp = V + tb;
#pragma unroll
            for (int m = 0; m < 4; ++m) {
                const float rs = rsp[16 * m];
                { const f32x4 v0 = acc[ai][0][m][0] * rs, v1 = acc[ai][0][m][1] * rs; u32x2 w; w.x = pk4_fp8_sat(v0[0], v0[1], v0[2], v0[3]); w.y = pk4_fp8_sat(v1[0], v1[1], v1[2], v1[3]);
                  *(u32x2*)(kp + m * 2048) = w; }
                { const f32x4 v0 = acc[ai][1][m][0] * rs, v1 = acc[ai][1][m][1] * rs; const unsigned w0 = pk4_fp8_sat(v0[0], v0[1], v0[2], v0[3]), w1 = pk4_fp8_sat(v1[0], v1[1], v1[2], v1[3]);
                  const int sl = att8::vslot(16 * m + fr);
#pragma unroll
                  for (int i = 0; i < 8; ++i) { const int d = dd + i; vp[d * 64 + ((((sl >> 4) ^ ((d >> 2) & 3))) << 4) + (sl & 15)] = (unsigned char)(((i < 4 ? w0 : w1) >> (8 * (i & 3))) & 0xffu); } }
                asm volatile("" ::: "memory");
            }
        }
    }
};

__device__ __forceinline__ void phase_ssd_out(const Args& A, int li, int nrows) {
    const bf16_t* PROJ = (const bf16_t*)(A.ws + WS_BIG); const bf16_t* XS = (const bf16_t*)(A.ws + WS_R2);
    const bf16_t* Y0 = (const bf16_t*)(A.ws + WS_H); const bf16_t* Y1 = (const bf16_t*)(A.ws + WS_R3); bf16_t* CAT = (bf16_t*)(A.ws + WS_R3 + R3_CAT);
    const int tid_ = otid(); const int lane = tid_ & 63, gw = blockIdx.x * 8 + (tid_ >> 6), nw = gridDim.x * 8;
    const float dsk = A.in[I_SSDD][li * 16 + (lane >> 2)];
    float ng[16];
#pragma unroll
    for (int j = 0; j < 16; ++j) ng[j] = A.in[I_SSDNG][li * 1024 + 16 * lane + j];
    for (int r = gw; r < nrows; r += nw) {
        float v[16]; float ss = 0.f;
#pragma unroll
        for (int hh = 0; hh < 2; ++hh) {
            const u32x4 a = *(const u32x4*)(Y0 + (size_t)r * 1024 + 16 * lane + 8 * hh), b = *(const u32x4*)(Y1 + (size_t)r * 1024 + 16 * lane + 8 * hh);
            const u32x4 x = *(const u32x4*)(XS + (size_t)r * 1024 + 16 * lane + 8 * hh), z = *(const u32x4*)(PROJ + (size_t)r * HYB_INP + 16 * lane + 8 * hh);
#pragma unroll
            for (int q = 0; q < 4; ++q) {
                const float y0 = (bflo(a[q]) + bflo(b[q]) + dsk * bflo(x[q])) * silu_f(bflo(z[q])), y1 = (bfhi(a[q]) + bfhi(b[q]) + dsk * bfhi(x[q])) * silu_f(bfhi(z[q]));
                v[8 * hh + 2 * q] = y0; v[8 * hh + 2 * q + 1] = y1; ss += y0 * y0 + y1 * y1; }
        }
#pragma unroll
        for (int o = 16; o >= 1; o >>= 1) ss += __shfl_xor(ss, o);
        const float rstd = rsqrtf(ss * (1.f / 512.f) + EPS);
#pragma unroll
        for (int hh = 0; hh < 2; ++hh) { u32x4 w;
#pragma unroll
            for (int q = 0; q < 4; ++q) w[q] = cvt_pk_bf16(v[8 * hh + 2 * q] * rstd * ng[8 * hh + 2 * q], v[8 * hh + 2 * q + 1] * rstd * ng[8 * hh + 2 * q + 1]);
            *(u32x4*)(CAT + (size_t)r * 2048 + 16 * lane + 8 * hh) = w; }
    }
}

__device__ __forceinline__ void phase_ln_stats(const Args& A, int nrows) {
    const bf16_t* Gb = (const bf16_t*)(A.ws + WS_BIG); float* ST = (float*)(A.ws + WS_RSTD);
    const int tid_ = otid(); const int lane = tid_ & 63, gw = blockIdx.x * 8 + (tid_ >> 6), nw = gridDim.x * 8;
    for (int r = gw; r < nrows; r += nw) {
        float v[32]; float s = 0.f;
#pragma unroll
        for (int j = 0; j < 4; ++j) { const u32x4 w = *(const u32x4*)(Gb + (size_t)r * 4096 + 2048 + 512 * j + 8 * lane);
#pragma unroll
            for (int q = 0; q < 4; ++q) { v[8 * j + 2 * q] = bflo(w[q]); v[8 * j + 2 * q + 1] = bfhi(w[q]); s += v[8 * j + 2 * q] + v[8 * j + 2 * q + 1]; } }
        s = wave_sum(s); const float mu = s * (1.f / 2048.f); float q2 = 0.f;
#pragma unroll
        for (int j = 0; j < 32; ++j) { const float dd = v[j] - mu; q2 += dd * dd; }
        q2 = wave_sum(q2);
        if (lane == 0) { ST[r] = mu; ST[NROW + r] = rsqrtf(q2 * (1.f / 2048.f) + EPS); }
    }
}
__device__ __forceinline__ float half_sum32(float v) {
    v += __builtin_bit_cast(float, __builtin_amdgcn_mov_dpp(__builtin_bit_cast(int, v), 0xB1, 0xF, 0xF, true));
    v += __builtin_bit_cast(float, __builtin_amdgcn_mov_dpp(__builtin_bit_cast(int, v), 0x4E, 0xF, 0xF, true));
    v += __builtin_bit_cast(float, __builtin_amdgcn_mov_dpp(__builtin_bit_cast(int, v), 0x141, 0xF, 0xF, true));
    v += __builtin_bit_cast(float, __builtin_amdgcn_mov_dpp(__builtin_bit_cast(int, v), 0x140, 0xF, 0xF, true));
    auto r = __builtin_amdgcn_permlane16_swap(__float_as_uint(v), __float_as_uint(v), false, false);
    return __uint_as_float(r[0]) + __uint_as_float(r[1]);
}
__device__ __forceinline__ void phase_spatial(const Args& A, int gi, int nrows, LAS unsigned char* lds) {
    const bf16_t* Gb = (const bf16_t*)(A.ws + WS_BIG); const f32x2* PARTS = (const f32x2*)(A.ws + WS_R3); bf16_t* Ab = (bf16_t*)(A.ws + WS_R1);
    const bf16_t* WSg = (const bf16_t*)(A.ws + WS_W + W_GM + (size_t)gi * WG_SZ + WG_WS);
    const float* lng = A.in[I_GLNG] + (size_t)gi * 2048; const float* lnb = A.in[I_GLNB] + (size_t)gi * 2048; const float* bs = A.in[I_GBS] + (size_t)gi * 1024;
    const int tid = otid(), wid = tid >> 6, lane = tid & 63, r32 = lane & 31, hi = lane >> 5, tb = wid & 3, dh = wid >> 2;
    const int ldsaddr = (int)(unsigned)(uintptr_t)lds;
    u32x4 nv[8]; f32x2 nps[8];
    const int nunits = (nrows / 128) * 8;
#define SP_LOADV(un) do { const int cb_ = (un) >> 3, gg_ = (un) & 7, r0_ = cb_ * 128; \
        _Pragma("unroll") for (int j = 0; j < 8; ++j) { const int idx = tid + 512 * j, s_ = idx >> 5, dd_ = (idx & 31) * 8; \
            nv[j] = *(const u32x4*)(Gb + (size_t)(r0_ + s_) * 4096 + 2048 + 256 * gg_ + dd_); nps[j] = PARTS[(size_t)(r0_ + s_) * 32 + (idx & 31)]; } } while (0)
    if ((int)blockIdx.x < nunits) SP_LOADV((int)blockIdx.x);
    for (int unit = blockIdx.x; unit < nunits; unit += gridDim.x) {
        const int cb = unit >> 3, gg = unit & 7, r0 = cb * 128;
        __syncthreads();
#pragma unroll
        for (int j = 0; j < 8; ++j) { const int idx = tid + 512 * j, s = idx >> 5, dd = (idx & 31) * 8;
            const u32x4 w = nv[j];
            const float mu = half_sum32(nps[j].x) * (1.f / 2048.f), rs = rsqrtf(fmaxf(half_sum32(nps[j].y) * (1.f / 2048.f) - mu * mu, 0.f) + EPS);
            const f32x4 g0 = *(const f32x4*)(lng + 256 * gg + dd), g1 = *(const f32x4*)(lng + 256 * gg + dd + 4), b0 = *(const f32x4*)(lnb + 256 * gg + dd), b1 = *(const f32x4*)(lnb + 256 * gg + dd + 4);
            u32x4 o;
            o.x = cvt_pk_bf16((bflo(w.x) - mu) * rs * g0[0] + b0[0], (bfhi(w.x) - mu) * rs * g0[1] + b0[1]); o.y = cvt_pk_bf16((bflo(w.y) - mu) * rs * g0[2] + b0[2], (bfhi(w.y) - mu) * rs * g0[3] + b0[3]);
            o.z = cvt_pk_bf16((bflo(w.z) - mu) * rs * g1[0] + b1[0], (bfhi(w.z) - mu) * rs * g1[1] + b1[1]); o.w = cvt_pk_bf16((bflo(w.w) - mu) * rs * g1[2] + b1[2], (bfhi(w.w) - mu) * rs * g1[3] + b1[3]);
            *(LAS u32x4*)(lds + ((s >> 6) * 2 + (dd >> 7)) * 16384 + att::v_st(s & 63, dd & 127)) = o; }
        u32x2 uu[4][4];
        { const bf16_t* up = Gb + (size_t)(r0 + 32 * tb + r32) * 4096 + 256 * gg + 128 * dh + 4 * hi;
#pragma unroll
          for (int d0 = 0; d0 < 4; ++d0)
#pragma unroll
              for (int k = 0; k < 4; ++k) uu[d0][k] = *(const u32x2*)(up + 32 * d0 + 8 * k); }
        if (unit + (int)gridDim.x < nunits) SP_LOADV(unit + (int)gridDim.x);
        bf16x8 pa[8];
#pragma unroll
        for (int ks = 0; ks < 8; ++ks) pa[ks] = *(const bf16x8*)(WSg + ((size_t)gg * 128 + 32 * tb + r32) * 128 + 16 * ks + 8 * hi);
        __syncthreads();
        f32x16 o[4] = {};
#define SP_PV(D0, vbase, p0, p1, p2, p3) do { \
            const s16x4 l0 = att::tr_read<att::v_rd_off(D0, 0, 0)>(vbase), h0 = att::tr_read<att::v_rd_off(D0, 0, 1)>(vbase), l1 = att::tr_read<att::v_rd_off(D0, 1, 0)>(vbase), h1 = att::tr_read<att::v_rd_off(D0, 1, 1)>(vbase); \
            const s16x4 l2 = att::tr_read<att::v_rd_off(D0, 2, 0)>(vbase), h2 = att::tr_read<att::v_rd_off(D0, 2, 1)>(vbase), l3 = att::tr_read<att::v_rd_off(D0, 3, 0)>(vbase), h3 = att::tr_read<att::v_rd_off(D0, 3, 1)>(vbase); \
            asm volatile("s_waitcnt lgkmcnt(0)" ::: "memory"); __builtin_amdgcn_sched_barrier(0); \
            o[D0] = __builtin_amdgcn_mfma_f32_32x32x16_bf16((bf16x8){l0[0], l0[1], l0[2], l0[3], h0[0], h0[1], h0[2], h0[3]}, p0, o[D0], 0, 0, 0); \
            o[D0] = __builtin_amdgcn_mfma_f32_32x32x16_bf16((bf16x8){l1[0], l1[1], l1[2], l1[3], h1[0], h1[1], h1[2], h1[3]}, p1, o[D0], 0, 0, 0); \
            o[D0] = __builtin_amdgcn_mfma_f32_32x32x16_bf16((bf16x8){l2[0], l2[1], l2[2], l2[3], h2[0], h2[1], h2[2], h2[3]}, p2, o[D0], 0, 0, 0); \
            o[D0] = __builtin_amdgcn_mfma_f32_32x32x16_bf16((bf16x8){l3[0], l3[1], l3[2], l3[3], h3[0], h3[1], h3[2], h3[3]}, p3, o[D0], 0, 0, 0); } while (0)
        { const int vb0 = ldsaddr + (0 * 2 + dh) * 16384 + att::v_rd_base(lane), vb1 = ldsaddr + (1 * 2 + dh) * 16384 + att::v_rd_base(lane);
          SP_PV(0, vb0, pa[0], pa[1], pa[2], pa[3]); SP_PV(1, vb0, pa[0], pa[1], pa[2], pa[3]); SP_PV(2, vb0, pa[0], pa[1], pa[2], pa[3]); SP_PV(3, vb0, pa[0], pa[1], pa[2], pa[3]);
          SP_PV(0, vb1, pa[4], pa[5], pa[6], pa[7]); SP_PV(1, vb1, pa[4], pa[5], pa[6], pa[7]); SP_PV(2, vb1, pa[4], pa[5], pa[6], pa[7]); SP_PV(3, vb1, pa[4], pa[5], pa[6], pa[7]); }
#undef SP_PV
        { const int t = 32 * tb + r32, row = r0 + t; const float bsv = bs[gg * 128 + t];
          bf16_t* ap = Ab + (size_t)row * 2048 + 256 * gg + 128 * dh + 4 * hi;
#pragma unroll
          for (int d0 = 0; d0 < 4; ++d0)
#pragma unroll
              for (int k = 0; k < 4; ++k) {
                  const u32x2 u2 = uu[d0][k];
                  u32x2 w; w.x = cvt_pk_bf16(bflo(u2.x) * (o[d0][4 * k] + bsv), bfhi(u2.x) * (o[d0][4 * k + 1] + bsv)); w.y = cvt_pk_bf16(bflo(u2.y) * (o[d0][4 * k + 2] + bsv), bfhi(u2.y) * (o[d0][4 * k + 3] + bsv));
                  *(u32x2*)(ap + 32 * d0 + 8 * k) = w; } }
    }
#undef SP_LOADV
}

constexpr int NSL = 8, SW = 1024 / NSL;
constexpr size_t TAB8_HALF = (size_t)NEXP * 1024, TAB_SCL = 2 * TAB8_HALF, TAB_SET = al256(TAB_SCL + (size_t)2 * NEXP * 4);
static_assert(2 * TAB_SET <= TAB_REGION, "table sets");
__device__ __forceinline__ size_t tabset(int layer) { return WS_TAB + (size_t)(layer & 1) * TAB_SET; }
constexpr float HS = 4.f;
__device__ __forceinline__ void phase_tabcvt(const Args& A, int layer, int wg, int nwg, int r_lo = 0, int r_hi = 2 * NEXP) {
    const int tid_ = otid(); const int lane = tid_ & 63, gw = wg * 8 + (tid_ >> 6), nw = nwg * 8;
    unsigned char* TS = A.ws + tabset(layer); float* SCL = (float*)(TS + TAB_SCL);
    for (int r = r_lo + gw; r < r_hi; r += nw) {
        const int tab = r >> 14, e = r & (NEXP - 1);
        const float* src = (tab ? A.in[I_PV] : A.in[I_PU]) + ((size_t)layer * NEXP + e) * 1024 + 16 * lane;
        f32x4 v[4]; float am = 0.f;
#pragma unroll
        for (int i = 0; i < 4; ++i) { v[i] = *(const f32x4*)(src + 4 * i); am = fmaxf(am, fmaxf(fmaxf(fabsf(v[i][0]), fabsf(v[i][1])), fmaxf(fabsf(v[i][2]), fabsf(v[i][3])))); }
#pragma unroll
        for (int o = 32; o >= 1; o >>= 1) am = fmaxf(am, __shfl_xor(am, o));
        float sc = 1.f; if (am > 0.f) { int ex; (void)frexpf(448.f / am, &ex); sc = ldexpf(1.f, ex - 1); }
        if (lane == 0) SCL[tab * NEXP + e] = 1.f / sc;
        u32x4 w;
#pragma unroll
        for (int i = 0; i < 4; ++i) w[i] = pk4_fp8(v[i][0] * sc, v[i][1] * sc, v[i][2] * sc, v[i][3] * sc);
        *(u32x4*)(TS + (size_t)tab * TAB8_HALF + ((size_t)(lane >> 3) * NEXP + e) * SW + 16 * (lane & 7)) = w;
    }
}
#define CASD(a, b) do { const float hi_ = fmaxf(a, b), lo_ = fminf(a, b); a = hi_; b = lo_; } while (0)
__device__ __forceinline__ void sort16(float (&k)[16]) {
#pragma unroll
    for (int sz = 2; sz <= 16; sz <<= 1)
#pragma unroll
        for (int j = sz >> 1; j > 0; j >>= 1)
#pragma unroll
            for (int i = 0; i < 16; ++i) { const int l = i ^ j; if (l > i) { if ((i & sz) == 0 || sz == 16) CASD(k[i], k[l]); else CASD(k[l], k[i]); } }
}
__device__ __forceinline__ void bmerge16(float (&k)[16]) {
#pragma unroll
    for (int j = 8; j > 0; j >>= 1)
#pragma unroll
        for (int i = 0; i < 16; ++i) { const int l = i ^ j; if (l > i) CASD(k[i], k[l]); }
}
__device__ __forceinline__ void merge_top16(float (&a)[16], const float (&b)[16]) {
#pragma unroll
    for (int i = 0; i < 16; ++i) a[i] = fmaxf(a[i], b[15 - i]);
    bmerge16(a);
}
__device__ __forceinline__ void xmerge_top16(float (&a)[16], int mask) {
    float t[16];
#pragma unroll
    for (int i = 0; i < 16; ++i) t[i] = __shfl_xor(a[15 - i], mask);
#pragma unroll
    for (int i = 0; i < 16; ++i) a[i] = fmaxf(a[i], t[i]);
    bmerge16(a);
}
__device__ __forceinline__ void phase_topk(const Args& A, int layer, int nrows, LAS unsigned char* lds) {
    const bf16_t* QP = (const bf16_t*)(A.ws + WS_BIG); int* IDX = (int*)(A.ws + WS_R2); float* GATE = (float*)(A.ws + WS_R2 + R2_GATE);
    const int tid = otid(), wid = tid >> 6, lane = tid & 63, fr = lane & 15, fq = lane >> 4;
    LAS unsigned* scr = (LAS unsigned*)(lds + 2 * 34816) + wid * 512 + fr * 32;
    int h_staged = -1;
    for (int unit = blockIdx.x; unit < (nrows / 128) * 8; unit += gridDim.x) {
        const int h = unit & 7, r0 = (unit >> 3) * 128;
        if (h != h_staged) { h_staged = h;
        __syncthreads();
        { const bf16_t* k1 = (const bf16_t*)(A.ws + WS_W + W_PEER + (size_t)layer * WP_SZ + WP_K1) + (size_t)h * 16384;
#pragma unroll
          for (int j = 0; j < 8; ++j) { const int idx = tid + 512 * j, half = idx >> 11, rem = idx & 2047, key = rem >> 4, c8 = rem & 15;
              const u32x4 w = *(const u32x4*)(k1 + (size_t)half * 8 * 16384 + key * 128 + 8 * c8);
              *(LAS u32x4*)(lds + half * 34816 + key * 272 + c8 * 16) = w; } }
        __syncthreads(); }
        const int tok = r0 + 16 * wid + fr;
        float top[2][16];
#pragma unroll
        for (int half = 0; half < 2; ++half) {
            bf16x8 qf[4];
#pragma unroll
            for (int ks = 0; ks < 4; ++ks) qf[ks] = *(const bf16x8*)(QP + (size_t)tok * 2048 + 256 * h + 128 * half + 32 * ks + 8 * fq);
            float loc[16];
#pragma unroll
            for (int grp = 0; grp < 2; ++grp) {
                float kk[16];
#pragma unroll
                for (int nbb = 0; nbb < 4; ++nbb) { const int nb = 4 * grp + nbb; f32x4 acc = {0.f, 0.f, 0.f, 0.f};
#pragma unroll
                    for (int ks = 0; ks < 4; ++ks) { const bf16x8 kf = *(const LAS bf16x8*)(lds + half * 34816 + (16 * nb + fr) * 272 + (32 * ks + 8 * fq) * 2);
                        acc = __builtin_amdgcn_mfma_f32_16x16x32_bf16(kf, qf[ks], acc, 0, 0, 0); }
#pragma unroll
                    for (int i = 0; i < 4; ++i) { const unsigned code = 127u - (unsigned)(16 * nb + 4 * fq + i); kk[4 * nbb + i] = __uint_as_float((__float_as_uint(acc[i]) & ~127u) | code); } }
                sort16(kk);
                if (grp == 0) {
#pragma unroll
                    for (int i = 0; i < 16; ++i) loc[i] = kk[i];
                } else merge_top16(loc, kk);
            }
            xmerge_top16(loc, 16); xmerge_top16(loc, 32);
#pragma unroll
            for (int i = 0; i < 16; ++i) top[half][i] = loc[i];
        }
        if (fq < 2) {
#pragma unroll
            for (int i = 0; i < 16; ++i) scr[16 * fq + i] = __float_as_uint(fq == 0 ? top[0][i] : top[1][i]); }
        float fin[16];
#pragma unroll
        for (int aa = 0; aa < 4; ++aa) {
            const float va_k = fq == 0 ? top[0][aa] : fq == 1 ? top[0][4 + aa] : fq == 2 ? top[0][8 + aa] : top[0][12 + aa];
            const float va = __uint_as_float(__float_as_uint(va_k) & ~127u);
            float c[16];
#pragma unroll
            for (int bb = 0; bb < 16; ++bb) { const float s = va + __uint_as_float(__float_as_uint(top[1][bb]) & ~127u);
                c[bb] = __uint_as_float((__float_as_uint(s) & ~255u) | (255u - (unsigned)((4 * fq + aa) * 16 + bb))); }
            if (aa == 0) {
#pragma unroll
                for (int i = 0; i < 16; ++i) fin[i] = c[i];
            } else merge_top16(fin, c);
        }
        xmerge_top16(fin, 16); xmerge_top16(fin, 32);
        float ev[16], es = 0.f; const float mx = __uint_as_float(__float_as_uint(fin[0]) & ~255u);
#pragma unroll
        for (int i = 0; i < 16; ++i) { ev[i] = __expf(__uint_as_float(__float_as_uint(fin[i]) & ~255u) - mx); es += ev[i]; }
        const float inv = 1.f / es;
        asm volatile("s_waitcnt lgkmcnt(0)" ::: "memory");
        int oi[4]; float og[4];
#pragma unroll
        for (int kq = 0; kq < 4; ++kq) {
            const float fk = fq == 0 ? fin[kq] : fq == 1 ? fin[4 + kq] : fq == 2 ? fin[8 + kq] : fin[12 + kq];
            const float fe = fq == 0 ? ev[kq] : fq == 1 ? ev[4 + kq] : fq == 2 ? ev[8 + kq] : ev[12 + kq];
            const unsigned code = 255u - (__float_as_uint(fk) & 255u), a = code >> 4, bq = code & 15u;
            const unsigned i1 = 127u - (scr[a] & 127u), i2 = 127u - (scr[16 + bq] & 127u);
            oi[kq] = (int)(i1 * 128u + i2); og[kq] = fe * inv; }
        *(int4*)(IDX + (size_t)tok * 128 + 16 * h + 4 * fq) = make_int4(oi[0], oi[1], oi[2], oi[3]);
        *(f32x4*)(GATE + (size_t)tok * 128 + 16 * h + 4 * fq) = (f32x4){og[0], og[1], og[2], og[3]};
    }
}
struct PeerSched {
    int x0, rank, nloc, nblk, nown; unsigned orphan;
    __device__ __forceinline__ void init(const Args& A, int nrows, LAS unsigned char* smem) {
        unsigned* ctl = (unsigned*)(A.ws + WS_CTL);
        x0 = (int)(xb_xcc_id() & 7u); rank = __builtin_amdgcn_readfirstlane((int)((LAS unsigned*)smem)[8]); nblk = nrows / 64;
        unsigned cached = __builtin_amdgcn_readfirstlane(((LAS unsigned*)smem)[9]);
        if (cached == 0u) { unsigned orph = 0u, nl = 1u;
            for (int j = 0; j < 8; ++j) { unsigned c = xb_ld(&ctl[XB_XCNT(j)]) + xb_ld(&ctl[XB_XCNT(j + 8)]); c = __builtin_amdgcn_readfirstlane(c); if (c == 0u) orph |= 1u << j; if (j == x0) nl = c; }
            cached = (nl << 8) | orph; __syncthreads(); if (threadIdx.x == 0) ((LAS unsigned*)smem)[9] = cached; __syncthreads(); }
        nloc = (int)(cached >> 8); orphan = cached & 0xffu;
        const int tot = (NSL / 8) * nblk; nown = rank < tot ? (tot - rank + nloc - 1) / nloc : 0;
    }
    __device__ __forceinline__ bool item(int j, int& sl, int& blk) const {
        if (j < nown) { const int i = rank + j * nloc; sl = x0 + 8 * (i / nblk); blk = i % nblk; return true; }
        int jj = j - nown; const int tot = (NSL / 8) * nblk, per = ((int)gridDim.x > tot) ? 1 : 0; (void)per;
        for (int o = 0; o < 8; ++o) if ((orphan >> o) & 1u) { const int cnt = ((int)blockIdx.x < tot) ? (tot - (int)blockIdx.x + (int)gridDim.x - 1) / (int)gridDim.x : 0;
            if (jj < cnt) { const int i = (int)blockIdx.x + jj * (int)gridDim.x; sl = o + 8 * (i / nblk); blk = i % nblk; return true; } jj -= cnt; }
        return false;
    }
};
template <class LD, class PR>
__device__ __forceinline__ void peer_items(const PeerSched& S, LD ld, PR pr) {
    int sl, blk, sln, blkn, j = 0, buf = 0; bool have = S.item(0, sl, blk);
    __syncthreads();
    if (have) ld(sl, blk, 0);
    while (have) {
        const bool haven = S.item(j + 1, sln, blkn);
        asm volatile("s_waitcnt vmcnt(0)" ::: "memory");
        if (haven) ld(sln, blkn, buf ^ 1);
        pr(sl, blk, buf);
        sl = sln; blk = blkn; have = haven; buf ^= 1; ++j;
    }
    __syncthreads();
}
#ifndef MK_UVAR
#define MK_UVAR 0
#endif
__device__ __forceinline__ float dpp_sum8(float v) {
    v += __builtin_bit_cast(float, __builtin_amdgcn_mov_dpp(__builtin_bit_cast(int, v), 0xB1, 0xF, 0xF, true));
    v += __builtin_bit_cast(float, __builtin_amdgcn_mov_dpp(__builtin_bit_cast(int, v), 0x4E, 0xF, 0xF, true));
    v += __builtin_bit_cast(float, __builtin_amdgcn_mov_dpp(__builtin_bit_cast(int, v), 0x141, 0xF, 0xF, true));
    return v;
}
__device__ __forceinline__ void phase_peer_u(const Args& A, int layer, int nrows, LAS unsigned char* smem, int rep) {
    const int var = rep ? MK_UVAR : 0;
    const bf16_t* H = (const bf16_t*)(A.ws + WS_H); const int* IDX = (const int*)(A.ws + WS_R2); float* PART = var ? (float*)(A.ws + WS_R1) : (float*)(A.ws + WS_BIG + BIG_PART);
    const unsigned char* U = A.ws + tabset(layer);
    constexpr int PP = 1088, WB = 4 * PP + 2048;
    const int tid = otid(), wid = tid >> 6, lane = tid & 63, m = lane & 7, tk = lane >> 3;
    const int wu = __builtin_amdgcn_readfirstlane(wid);
    LAS unsigned char* lds = smem + LDS_BASE + wu * (2 * WB);
    PeerSched S; S.init(A, nrows, smem);
    peer_items(S,
        [&](int sl, int blk, int buf) {
#pragma unroll
            for (int i = 0; i < 4; ++i)
                __builtin_amdgcn_global_load_lds((const unsigned*)(IDX + ((size_t)blk * 64 + 8 * wu + 2 * i) * 128 + 4 * lane), (LAS unsigned*)(lds + buf * WB + PP * i), 16, 0, 0);
#pragma unroll
            for (int i = 0; i < 2; ++i)
                __builtin_amdgcn_global_load_lds((const unsigned*)(H + (size_t)(blk * 64 + 8 * wu + 4 * i + (lane >> 4)) * 1024 + SW * sl + 8 * (lane & 15)), (LAS unsigned*)(lds + buf * WB + 4 * PP + 1024 * i), 16, 0, 0); },
        [&](int sl, int blk, int buf) {
            const unsigned char* ub = U + (size_t)sl * NEXP * SW + 16 * m;
            const int tok = blk * 64 + wid * 8 + tk;
            const int sw = (tk & 1) * 4;
            const LAS int* ib = (const LAS int*)(lds + buf * WB + (tk >> 1) * PP + (tk & 1) * 512);
            float hf[16];
            { const u32x4 h0 = *(const LAS u32x4*)(lds + buf * WB + 4 * PP + tk * 256 + 32 * m), h1 = *(const LAS u32x4*)(lds + buf * WB + 4 * PP + tk * 256 + 32 * m + 16);
#pragma unroll
              for (int j = 0; j < 4; ++j) { hf[2 * j] = bflo(h0[j]); hf[2 * j + 1] = bfhi(h0[j]); hf[8 + 2 * j] = bflo(h1[j]); hf[8 + 2 * j + 1] = bfhi(h1[j]); } }
            const bool up4 = m >= 4, up2 = (m & 2) != 0, up1 = (m & 1) != 0;
            float* pp = PART + ((size_t)sl * NROW + tok) * 128 + (m ^ sw);
            u32x4 vv[2][8];
#define PU_ROWS(T, c) do { const i32x4 e0_ = *(const LAS i32x4*)(ib + 8 * (c) + sw), e1_ = *(const LAS i32x4*)(ib + 8 * (c) + (4 - sw)); \
                if (var == 4) { _Pragma("unroll") for (int k_ = 0; k_ < 8; ++k_) vv[T][k_] = (u32x4){(unsigned)e0_.x, (unsigned)e1_.y, 0u, 0u}; } else { \
                vv[T][0] = *(const u32x4*)(ub + (size_t)(var == 3 ? e0_.x & 63 : e0_.x) * SW); vv[T][1] = *(const u32x4*)(ub + (size_t)(var == 3 ? e0_.y & 63 : e0_.y) * SW); \
                vv[T][2] = *(const u32x4*)(ub + (size_t)(var == 3 ? e0_.z & 63 : e0_.z) * SW); vv[T][3] = *(const u32x4*)(ub + (size_t)(var == 3 ? e0_.w & 63 : e0_.w) * SW); \
                vv[T][4] = *(const u32x4*)(ub + (size_t)(var == 3 ? e1_.x & 63 : e1_.x) * SW); vv[T][5] = *(const u32x4*)(ub + (size_t)(var == 3 ? e1_.y & 63 : e1_.y) * SW); \
                vv[T][6] = *(const u32x4*)(ub + (size_t)(var == 3 ? e1_.z & 63 : e1_.z) * SW); vv[T][7] = *(const u32x4*)(ub + (size_t)(var == 3 ? e1_.w & 63 : e1_.w) * SW); } } while (0)
#define PU_DOT(T, c) do { float s_[8]; \
                _Pragma("unroll") for (int k = 0; k < 8; ++k) { f32x2 a2 = {0.f, 0.f}; \
                    _Pragma("unroll") for (int j = 0; j < 4; ++j) { const int w = (int)vv[T][k][j]; \
                        const f32x2 lo = __builtin_amdgcn_cvt_pk_f32_fp8(w, false), hi = __builtin_amdgcn_cvt_pk_f32_fp8(w, true); \
                        a2 = __builtin_elementwise_fma(lo, (f32x2){hf[4 * j], hf[4 * j + 1]}, a2); a2 = __builtin_elementwise_fma(hi, (f32x2){hf[4 * j + 2], hf[4 * j + 3]}, a2); } \
                    s_[k] = a2.x + a2.y; } \
                  \
                float t_[4], u_[2]; \
                _Pragma("unroll") for (int j = 0; j < 4; ++j) { const float give = up4 ? s_[j] : s_[4 + j], keep = up4 ? s_[4 + j] : s_[j]; \
                    t_[j] = keep + __builtin_bit_cast(float, __builtin_amdgcn_mov_dpp(__builtin_bit_cast(int, give), 0x141, 0xF, 0xF, true)); }        \
                _Pragma("unroll") for (int j = 0; j < 2; ++j) { const float give = up2 ? t_[j] : t_[2 + j], keep = up2 ? t_[2 + j] : t_[j]; \
                    u_[j] = keep + __builtin_bit_cast(float, __builtin_amdgcn_mov_dpp(__builtin_bit_cast(int, give), 0x4E, 0xF, 0xF, true)); }         \
                { const float give = up1 ? u_[0] : u_[1], keep = up1 ? u_[1] : u_[0]; \
                  const float tot_ = keep + __builtin_bit_cast(float, __builtin_amdgcn_mov_dpp(__builtin_bit_cast(int, give), 0xB1, 0xF, 0xF, true));           \
                  pp[8 * (c)] = tot_; } } while (0)
            PU_ROWS(0, 0);
#pragma unroll 1
            for (int c = 0; c < 16; c += 2) {
                PU_ROWS(1, c + 1);
                __builtin_amdgcn_sched_barrier(0);
                PU_DOT(0, c);
                __builtin_amdgcn_sched_barrier(0);
                if (c + 2 < 16) PU_ROWS(0, c + 2);
                __builtin_amdgcn_sched_barrier(0);
                PU_DOT(1, c + 1);
                __builtin_amdgcn_sched_barrier(0);
            }
#undef PU_ROWS
#undef PU_DOT
        });
}
__device__ __forceinline__ void phase_coef(const Args& A, int layer, int nrows) {
    const float* PART = (const float*)(A.ws + WS_BIG + BIG_PART); const float* GATE = (const float*)(A.ws + WS_R2 + R2_GATE); unsigned* REC = (unsigned*)(A.ws + WS_R2 + R2_COEF);
    const int* IDX = (const int*)(A.ws + WS_R2); const float* SCL = (const float*)(A.ws + tabset(layer) + TAB_SCL);
    const int gthr = blockIdx.x * NTHR + otid(), nthr = gridDim.x * NTHR;
    for (int p = gthr; p < nrows * 32; p += nthr) {
        f32x4 s = {0.f, 0.f, 0.f, 0.f};
#pragma unroll
        for (int x = 0; x < NSL; ++x) s += *(const f32x4*)(PART + (size_t)x * NROW * 128 + 4 * p);
        const i32x4 e = *(const i32x4*)(IDX + 4 * p); const f32x4 gt = *(const f32x4*)(GATE + 4 * p);
        const f32x4 su = {SCL[e.x], SCL[e.y], SCL[e.z], SCL[e.w]}, sv = {SCL[NEXP + e.x], SCL[NEXP + e.y], SCL[NEXP + e.z], SCL[NEXP + e.w]};
        const f32x4 a = s * su; const f32x2 g0 = gelu_pk((f32x2){a[0], a[1]}), g1 = gelu_pk((f32x2){a[2], a[3]});
        const f32x4 cf = gt * (f32x4){g0.x, g0.y, g1.x, g1.y} * sv;
        *(u32x4*)(REC + 4 * p) = (u32x4){cvt_pk_bf16(0.f, cf[0]) | (unsigned)e.x, cvt_pk_bf16(0.f, cf[1]) | (unsigned)e.y, cvt_pk_bf16(0.f, cf[2]) | (unsigned)e.z, cvt_pk_bf16(0.f, cf[3]) | (unsigned)e.w}; }

}
__device__ __forceinline__ void phase_peer_v(const Args& A, int layer, int nrows, LAS unsigned char* smem, int rep) {
    const int* REC = (const int*)(A.ws + WS_R2 + R2_COEF);
    const unsigned char* V = A.ws + tabset(layer) + TAB8_HALF; const float* MODL = (const float*)(A.ws + WS_MOD) + (size_t)layer * 5 * 6144 + 5 * 1024;
    bf16_t* XB = (bf16_t*)(A.ws + WS_XB);
    constexpr int PP = 1088, WB = 4 * PP;
    const int tid = otid(), wid = tid >> 6, lane = tid & 63, m = lane & 7, tk = lane >> 3;
    const int wu = __builtin_amdgcn_readfirstlane(wid);
    LAS unsigned char* lds = smem + LDS_BASE + wu * (2 * WB);
    PeerSched S; S.init(A, nrows, smem);
    peer_items(S,
        [&](int sl, int blk, int buf) {
#pragma unroll
            for (int i = 0; i < 4; ++i)
                __builtin_amdgcn_global_load_lds((const unsigned*)(REC + ((size_t)blk * 64 + 8 * wu + 2 * i) * 128 + 4 * lane), (LAS unsigned*)(lds + buf * WB + PP * i), 16, 0, 0); },
        [&](int sl, int blk, int buf) {
            const unsigned char* vb = V + (size_t)sl * NEXP * SW + 16 * m;
            const int tok = blk * 64 + wid * 8 + tk; const bool lat = tok < NLAT;
            const int toff = (tk >> 1) * PP + (tk & 1) * 512, sw = (tk & 1) * 4;
            const LAS int* ib = (const LAS int*)(lds + buf * WB + toff);
            bf16_t* xp = XB + (size_t)tok * D + SW * sl + 16 * m;
            const u32x4 xr0 = *(const u32x4*)xp, xr1 = *(const u32x4*)(xp + 8);
            f32x2 acc2[8];
#pragma unroll
            for (int j = 0; j < 8; ++j) acc2[j] = (f32x2){0.f, 0.f};
            u32x4 vv[2][8];
#define PV_ROWS(T, c) do { const i32x4 e0_ = *(const LAS i32x4*)(ib + 8 * (c) + sw) & 0xffff, e1_ = *(const LAS i32x4*)(ib + 8 * (c) + (4 - sw)) & 0xffff; \
                vv[T][0] = *(const u32x4*)(vb + (size_t)e0_.x * SW); vv[T][1] = *(const u32x4*)(vb + (size_t)e0_.y * SW); vv[T][2] = *(const u32x4*)(vb + (size_t)e0_.z * SW); vv[T][3] = *(const u32x4*)(vb + (size_t)e0_.w * SW); \
                vv[T][4] = *(const u32x4*)(vb + (size_t)e1_.x * SW); vv[T][5] = *(const u32x4*)(vb + (size_t)e1_.y * SW); vv[T][6] = *(const u32x4*)(vb + (size_t)e1_.z * SW); vv[T][7] = *(const u32x4*)(vb + (size_t)e1_.w * SW); } while (0)
#define PV_FMA(T, c) do { const i32x4 r0_ = *(const LAS i32x4*)(ib + 8 * (c) + sw) & (int)0xffff0000, r1_ = *(const LAS i32x4*)(ib + 8 * (c) + (4 - sw)) & (int)0xffff0000; \
                const f32x4 c0_ = __builtin_bit_cast(f32x4, r0_), c1_ = __builtin_bit_cast(f32x4, r1_); \
                _Pragma("unroll") for (int k = 0; k < 8; ++k) { const float cf = k < 4 ? c0_[k & 3] : c1_[k & 3]; \
                    _Pragma("unroll") for (int j = 0; j < 4; ++j) { const int w = (int)vv[T][k][j]; \
                        const f32x2 lo = __builtin_amdgcn_cvt_pk_f32_fp8(w, false), hi = __builtin_amdgcn_cvt_pk_f32_fp8(w, true); const f32x2 c2 = {cf, cf}; \
                        acc2[2 * j] = __builtin_elementwise_fma(lo, c2, acc2[2 * j]); acc2[2 * j + 1] = __builtin_elementwise_fma(hi, c2, acc2[2 * j + 1]); } } } while (0)
            PV_ROWS(0, 0);
#pragma unroll 1
            for (int c = 0; c < 16; c += 2) {
                PV_ROWS(1, c + 1);
                __builtin_amdgcn_sched_barrier(0);
                PV_FMA(0, c);
                __builtin_amdgcn_sched_barrier(0);
                if (c + 2 < 16) PV_ROWS(0, c + 2);
                __builtin_amdgcn_sched_barrier(0);
                PV_FMA(1, c + 1);
                __builtin_amdgcn_sched_barrier(0);
            }
#undef PV_ROWS
#undef PV_FMA
            const float* gp = MODL + (size_t)(lat ? (tok >> 13) : 4) * 6144 + SW * sl + 16 * m;
#pragma unroll
            for (int j = 0; j < 4; ++j) { const f32x4 g = *(const f32x4*)(gp + 4 * j); const unsigned w0 = j == 0 ? xr0.x : j == 1 ? xr0.z : j == 2 ? xr1.x : xr1.z, w1 = j == 0 ? xr0.y : j == 1 ? xr0.w : j == 2 ? xr1.y : xr1.w;
                const f32x4 o = (f32x4){bflo(w0), bfhi(w0), bflo(w1), bfhi(w1)} + g * (f32x4){acc2[2 * j].x, acc2[2 * j].y, acc2[2 * j + 1].x, acc2[2 * j + 1].y};
                u32x2 w; w.x = cvt_pk_bf16(o[0], o[1]); w.y = cvt_pk_bf16(o[2], o[3]); *(u32x2*)(xp + 4 * j) = w; }
        });
}

#ifdef MK_CHECK
constexpr int CW_CHK = 3840;
__device__ __forceinline__ float blk_sum(float v, LAS float* red) {
    const int t_ = otid(); v = wave_sum(v); __syncthreads(); if ((t_ & 63) == 0) red[t_ >> 6] = v; __syncthreads();
    float s = 0.f; for (int i = 0; i < 8; ++i) s += red[i]; __syncthreads(); return s;
}
__device__ __forceinline__ float fp8f(unsigned b) { const unsigned e = (b >> 3) & 15u, m = b & 7u; const float v = e ? ldexpf(1.f + (float)m * 0.125f, (int)e - 7) : ldexpf((float)m * 0.125f, -6); return (b & 0x80u) ? -v : v; }
__device__ __forceinline__ void check_attn(const Args& A, LAS unsigned char* lds, bool with_ctx) {
    const unsigned char* Q = A.ws + WS_R1 + R1_Q; const unsigned char* KN = A.ws + WS_R1 + R1_KN; const unsigned char* KR = A.ws + WS_BIG + BIG_KR; const unsigned char* V = A.ws + WS_R1 + R1_V;
    const bf16_t* CAT = (const bf16_t*)(A.ws + WS_R3 + R3_CAT); float* chk = (float*)(A.ws + WS_CTL) + CW_CHK;
    LAS float* p = (LAS float*)lds; LAS float* qv = p + NKEY; LAS float* red = qv + 192;
    const int tid = otid();
    for (int au = blockIdx.x; au < (with_ctx ? 1056 : 1024); au += gridDim.x) {
        int b, h, qrow, orow, nkey;
        if (au < 1024) { b = au >> 8; h = au & 7; const int qb = (au >> 3) & 31, l = 256 * qb + (int)((((unsigned)au * 2654435761u) >> 20) & 255u); qrow = 256 + l; orow = b * 8192 + l; nkey = NKEY; }
        else { const int cu = au - 1024; b = cu >> 3; h = cu & 7; const int lc = (int)((((unsigned)au * 2654435761u) >> 20) & 255u); qrow = lc; orow = NLAT + 256 * b + lc; nkey = 256; }
        const size_t bh = (size_t)(b * 8 + h);
        __syncthreads();
        if (tid < 192) qv[tid] = fp8f(Q[(bh * NKEY + qrow) * 192 + tid]) * (1.f / att8::QUP);
        __syncthreads();
        float mx = -1e30f;
        for (int key = tid; key < nkey; key += 512) { const int t = key >> 6, k = key & 63; float sacc = 0.f;
            for (int d = 0; d < 128; ++d) sacc += qv[d] * fp8f(KN[(bh * NKT + t) * 8192 + att8::kn8(k, d)]);
            for (int d = 0; d < 64; ++d) sacc += qv[128 + d] * fp8f(KR[((size_t)b * NKT + t) * 4096 + att8::kr8(k, d)]);
            p[key] = sacc; mx = fmaxf(mx, sacc); }
        for (int o = 32; o >= 1; o >>= 1) mx = fmaxf(mx, __shfl_xor(mx, o));
        __syncthreads(); if ((tid & 63) == 0) red[tid >> 6] = mx; __syncthreads(); mx = red[0]; for (int i = 1; i < 8; ++i) mx = fmaxf(mx, red[i]); __syncthreads();
        float ls = 0.f; for (int key = tid; key < nkey; key += 512) { const float e = exp2f(p[key] - mx); p[key] = e; ls += e; }
        ls = blk_sum(ls, red);
        float num = 0.f, den = 0.f;
        if (tid < 128) { float o = 0.f; for (int key = 0; key < nkey; ++key) o += p[key] * fp8f(V[(bh * NKT + (key >> 6)) * 8192 + att8::v8(tid, key & 63)]);
            o /= ls; const float got = bf2f(CAT[(size_t)orow * 2048 + 1024 + 128 * h + tid]); num = (got - o) * (got - o); den = o * o; }
        num = blk_sum(num, red); den = blk_sum(den, red);
        if (tid == 0) { atomicAdd(chk, num); atomicAdd(chk + 1, den); }
    }
}
__device__ __forceinline__ void check_qkv(const Args& A, int li, LAS unsigned char* lds) {
    float* chk = (float*)(A.ws + WS_CTL) + CW_CHK;
    const unsigned char* Q = A.ws + WS_R1 + R1_Q; const unsigned char* KN = A.ws + WS_R1 + R1_KN; const unsigned char* KR = A.ws + WS_BIG + BIG_KR; const unsigned char* V = A.ws + WS_R1 + R1_V;
    LAS float* hv = (LAS float*)lds; LAS float* cq = hv + 1024; LAS float* ckv = cq + 384; LAS float* kr = ckv + 256; LAS float* red = kr + 64; LAS float* ov = red + 16;
    const int tid = otid(), sidx = blockIdx.x;
    const int hd = sidx & 7; const int r = (sidx & 8) ? NLAT + (int)(((unsigned)sidx * 2654435761u) >> 22) : (int)(((unsigned)sidx * 2654435761u) >> 17);
    const float* win = A.in[I_HWIN] + (size_t)li * 1024 * HYB_IN;
    {
        const bf16_t* xp = (const bf16_t*)(A.ws + WS_XB) + (size_t)r * D; const float* MODL = (const float*)(A.ws + WS_MOD) + (size_t)(2 * li) * 5 * 6144 + (size_t)row_mb(r) * 6144;
        float ss = 0.f; for (int i = tid; i < 1024; i += 512) ss += bf2f(xp[i]) * bf2f(xp[i]);
        ss = blk_sum(ss, red); const float rstd = rsqrtf(ss / 1024.f + EPS);
        for (int i = tid; i < 1024; i += 512) hv[i] = bf2f(f2bf(bf2f(xp[i]) * rstd * A.in[I_N1G][(2 * li) * 1024 + i] * (1.f + MODL[1024 + i]) + MODL[i])); }
    __syncthreads();
    for (int j = tid; j < 704; j += 512) { float s = 0.f; for (int k = 0; k < 1024; ++k) s += hv[k] * win[(size_t)k * HYB_IN + C_CQ + j];
        s = bf2f(f2bf(s)); if (j < 384) cq[j] = s; else if (j < 640) ckv[j - 384] = s; else kr[j - 640] = s; }
    __syncthreads();
    float sq = 0.f, sk = 0.f; for (int j = tid; j < 384; j += 512) sq += cq[j] * cq[j]; for (int j = tid; j < 256; j += 512) sk += ckv[j] * ckv[j];
    sq = blk_sum(sq, red); sk = blk_sum(sk, red);
    const float rq = rsqrtf(sq / 384.f + EPS), rk = rsqrtf(sk / 256.f + EPS);
    const float* wqb = A.in[I_WQB] + (size_t)li * 384 * 1536; const float* wkvb = A.in[I_WKVB] + (size_t)li * 256 * 2048; const float* qg = A.in[I_QNG] + li * 384; const float* kg = A.in[I_KVNG] + li * 256;
    if (tid < 192) { float s = 0.f; for (int k = 0; k < 384; ++k) s += cq[k] * rq * qg[k] * wqb[(size_t)k * 1536 + hd * 192 + tid]; ov[tid] = s; }
    else if (tid < 448) { const int c = tid - 192; float s = 0.f; for (int k = 0; k < 256; ++k) s += ckv[k] * rk * kg[k] * wkvb[(size_t)k * 2048 + hd * 256 + c]; ov[tid] = s; }
    __syncthreads();
    const bool lat = r < NLAT; const int b = lat ? (r >> 13) : ((r - NLAT) >> 8), l = lat ? (r & 8191) : 0, key = lat ? 256 + l : ((r - NLAT) & 255), qrow = key;
    const size_t bh = (size_t)(b * 8 + hd); const float qs = QSCALE * att8::QUP;
    float num = 0.f, den = 0.f;
    if (tid < 128) {
        const float q = ov[tid] * qs, gq = fp8f(Q[(bh * NKEY + qrow) * 192 + tid]);
        const float kk = ov[192 + tid], gk = fp8f(KN[(bh * NKT + (key >> 6)) * 8192 + att8::kn8(key & 63, tid)]);
        const float vv = ov[320 + tid], gv = fp8f(V[(bh * NKT + (key >> 6)) * 8192 + att8::v8(tid, key & 63)]);
        num = (gq - q) * (gq - q) + (gk - kk) * (gk - kk) + (gv - vv) * (gv - vv); den = q * q + kk * kk + vv * vv;
    } else if (tid < 160) {
        const int i = tid - 128; float c = 1.f, sn = 0.f;
        if (lat) { const float pos = (float)(i < 16 ? (l >> 6) : (l & 63)); const float ang = pos * powf(10000.f, -(float)(i & 15) / 16.f); c = cosf(ang); sn = sinf(ang); }
        const float q1 = ov[128 + i] * qs, q2 = ov[160 + i] * qs, k1 = kr[i], k2 = kr[32 + i];
        const float rq1 = q1 * c - q2 * sn, rq2 = q1 * sn + q2 * c, rk1 = k1 * c - k2 * sn, rk2 = k1 * sn + k2 * c;
        const float gq1 = fp8f(Q[(bh * NKEY + qrow) * 192 + 128 + 2 * i]), gq2 = fp8f(Q[(bh * NKEY + qrow) * 192 + 128 + 2 * i + 1]);
        const float gk1 = fp8f(KR[((size_t)b * NKT + (key >> 6)) * 4096 + att8::kr8(key & 63, 2 * i)]), gk2 = fp8f(KR[((size_t)b * NKT + (key >> 6)) * 4096 + att8::kr8(key & 63, 2 * i + 1)]);
        num = (gq1 - rq1) * (gq1 - rq1) + (gq2 - rq2) * (gq2 - rq2) + (gk1 - rk1) * (gk1 - rk1) + (gk2 - rk2) * (gk2 - rk2); den = rq1 * rq1 + rq2 * rq2 + rk1 * rk1 + rk2 * rk2;
    }
    num = blk_sum(num, red); den = blk_sum(den, red);
    if (tid == 0) { atomicAdd(chk, num); atomicAdd(chk + 1, den); }
}
__device__ __forceinline__ void check_topk(const Args& A, int layer, LAS unsigned char* lds) {
    const bf16_t* QP = (const bf16_t*)(A.ws + WS_BIG); const int* IDX = (const int*)(A.ws + WS_R2); const float* GATE = (const float*)(A.ws + WS_R2 + R2_GATE); float* chk = (float*)(A.ws + WS_CTL) + CW_CHK;
    const bf16_t* K1 = (const bf16_t*)(A.ws + WS_W + W_PEER + (size_t)layer * WP_SZ + WP_K1);
    LAS float* sc = (LAS float*)lds; LAS float* v12 = sc + 256; LAS int* i12 = (LAS int*)(v12 + 32); LAS float* cs = (LAS float*)(i12 + 32); LAS float* ts = cs + 256; LAS int* ti = (LAS int*)(ts + 16); LAS float* red = (LAS float*)(ti + 16);
    const int tid = otid();
    for (int smp = blockIdx.x; smp < 1024; smp += gridDim.x) {
        const int h = smp & 7, tok = (int)((((unsigned)smp * 2654435761u) >> 12) % (unsigned)NROW);
        __syncthreads();
        if (tid < 256) { const int half = tid >> 7, key = tid & 127; float a = 0.f;
            for (int d = 0; d < 128; ++d) a += bf2f(QP[(size_t)tok * 2048 + 256 * h + 128 * half + d]) * bf2f(K1[((size_t)half * 8 + h) * 16384 + key * 128 + d]);
            sc[tid] = a; }
        __syncthreads();
        if (tid < 256) { const int half = tid >> 7, key = tid & 127; const float v = sc[tid]; int rank = 0;
            for (int j = 0; j < 128; ++j) { const float o = sc[half * 128 + j]; rank += (o > v || (o == v && j < key)) ? 1 : 0; }
            if (rank < 16) { v12[half * 16 + rank] = v; i12[half * 16 + rank] = key; } }
        __syncthreads();
        if (tid < 256) cs[tid] = v12[tid >> 4] + v12[16 + (tid & 15)];
        __syncthreads();
        if (tid < 256) { const float v = cs[tid]; int rank = 0;
            for (int j = 0; j < 256; ++j) { const float o = cs[j]; rank += (o > v || (o == v && j < tid)) ? 1 : 0; }
            if (rank < 16) { ts[rank] = v; ti[rank] = i12[tid >> 4] * 128 + i12[16 + (tid & 15)]; } }
        __syncthreads();
        float num = 0.f, den = 0.f;
        if (tid < 16) { float es = 0.f; for (int j = 0; j < 16; ++j) es += __expf(ts[j] - ts[0]); const float gn = __expf(ts[tid] - ts[0]) / es; float gk = 0.f;
            for (int j = 0; j < 16; ++j) if (IDX[(size_t)tok * 128 + 16 * h + j] == ti[tid]) gk = GATE[(size_t)tok * 128 + 16 * h + j];
            num = (gk - gn) * (gk - gn); den = gn * gn; }
        num = blk_sum(num, red); den = blk_sum(den, red);
        if (tid == 0) { atomicAdd(chk, num); atomicAdd(chk + 1, den); }
    }
}
__device__ __forceinline__ void check_ssd(const Args& A, int li, LAS unsigned char* lds) {
    const bf16_t* XS = (const bf16_t*)(A.ws + WS_R2); const bf16_t* BC = (const bf16_t*)(A.ws + WS_R2 + R2_BC); const float* DT = (const float*)(A.ws + WS_BIG + BIG_DT);
    const bf16_t* Y0 = (const bf16_t*)(A.ws + WS_H); const bf16_t* Y1 = (const bf16_t*)(A.ws + WS_R3); float* chk = (float*)(A.ws + WS_CTL) + CW_CHK;
    LAS float* red = (LAS float*)lds;
    const int tid = otid(), sidx = blockIdx.x;
    const int b = sidx & 3, d = (sidx >> 2) & 1, h = (sidx >> 3) & 15, p = (int)((((unsigned)sidx * 2654435761u) >> 20) & 63u), g = h >> 3;
    const float a = -__expf(A.in[I_ALOG][li * 32 + d * 16 + h]);
    const bf16_t* Y = d ? Y1 : Y0;
    float hst = 0.f, num = 0.f, den = 0.f;
    for (int step = 0; step < 8448; ++step) {
        int r;
        if (step < 256) r = NLAT + b * 256 + (d ? 255 - step : step); else { const int q = step - 256; r = b * 8192 + (d ? 8191 - q : q); }
        const float dt = DT[(size_t)(d * 16 + h) * NROW + r], x = bf2f(XS[(size_t)r * 1024 + 64 * h + p]);
        float contrib = 0.f;
        if (tid < 128) { hst = __expf(dt * a) * hst + dt * x * bf2f(BC[(size_t)r * 512 + 128 * g + tid]); contrib = hst * bf2f(BC[(size_t)r * 512 + 256 + 128 * g + tid]); }
        if (step % 61 == 0) { const float y = blk_sum(contrib, red); const float got = bf2f(Y[(size_t)r * 1024 + 64 * h + p]); if (tid == 0) { num += (got - y) * (got - y); den += y * y; } }
    }
    if (tid == 0) { atomicAdd(chk, num); atomicAdd(chk + 1, den); }
}
#endif
#ifndef MK_PER_PHASE
#define MK_PER_PHASE 0
#endif
__device__ __forceinline__ int nr_in(int L) { return L <= 2 ? NROW : NLAT; }
__device__ __forceinline__ int nr_out(int L) { return L <= 1 ? NROW : NLAT; }

__global__ void __launch_bounds__(NTHR, 2) fwd(Args A) {
    extern __shared__ __attribute__((aligned(256))) unsigned char smem_raw[];
    LAS unsigned char* smem = (LAS unsigned char*)smem_raw;
    LAS unsigned char* lds = smem + LDS_BASE;
    const int tid = otid();
    if (tid < 64) ((LAS unsigned*)smem)[tid] = 0u;
    __syncthreads();
    XcdBarrier bar = xcd_barrier_post((unsigned*)(A.ws + WS_CTL), (volatile LAS unsigned*)smem);
    if (tid == 0) ((LAS unsigned*)smem)[8] = atomicAdd((unsigned*)(A.ws + WS_CTL) + CW_RANK + 32 * (xb_xcc_id() & 7u), 1u);
    __syncthreads();
    bool need_bar = false;
    const int lo = A.ph_lo, hi = A.ph_hi;
#ifndef PHMASK
#define PHMASK 0xffffffffu
#endif
#define SITE(k) if constexpr (((PHMASK) >> (k)) & 1u)
#ifndef MK_SVAR
#define MK_SVAR 1
#endif
#ifndef MK_REPEAT_SITE
#define MK_REPEAT_SITE -1
#endif
#define REP(k) for (int rep = 0; rep < ((k) == (MK_REPEAT_SITE) ? 2 : 1); ++rep)
#define PH(id) if ([&]() -> bool { if ((id) < lo || (id) >= hi) return false; if (need_bar) xcd_barrier(bar); need_bar = true; return true; }())
    unsigned char* ws = A.ws;
#define TAIL_TAB(units, layer, rlo, rhi) do { const int nx_ = (units) % 256; if (gridDim.x == 256 && (int)blockIdx.x >= nx_) phase_tabcvt(A, layer, (int)blockIdx.x - nx_, 256 - nx_, rlo, rhi); } while (0)
    bf16_t* XB = (bf16_t*)(ws + WS_XB);
    bf16_t* H = (bf16_t*)(ws + WS_H);
    const float* MOD = (const float*)(ws + WS_MOD);

    SITE(0) PH(0) { phase_prologue(A, lds); }
    SITE(1) PH(1) { phase_norm_mod<true>(A.in[I_X], A.in[I_CTX], XB, A.in[I_N1G], MOD, 0, H, NROW); }
    for (int L = 0; L < DEPTH; ++L) {
        const int base = 2 + 16 * L, li = L >> 1; const bool hyb = (L & 1) == 0;
        const float* MODL = MOD + (size_t)L * 5 * 6144;
        unsigned char* WH = ws + WS_W + W_HYB + (size_t)li * WH_SZ; unsigned char* WG = ws + WS_W + W_GM + (size_t)li * WG_SZ; unsigned char* WP = ws + WS_W + W_PEER + (size_t)L * WP_SZ;
        if (hyb) {
            SITE(2) PH(base + 0) REP(2) { pg8::Gemm g{H, (const bf16_t*)(WH + WH_IN), nr_in(L), HYB_INP, 1024, 1024, 1024};
                pg8::EpiBf16<0> e{(bf16_t*)(ws + WS_BIG), HYB_INP}; pg8::gemm_phase(lds, g, e); }
            SITE(3) PH(base + 1) REP(3) { phase_conv(A, li, rep); }
            SITE(4) PH(base + 2) {
                SITE(18) REP(18) { pg8::Gemm g{(const bf16_t*)(ws + WS_BIG) + C_CQ, (const bf16_t*)(WH + WH_QB), L == 0 ? NROW : NLAT, 1536, 384, HYB_INP, 384};
                  EpiQ e{ws + WS_R1 + R1_Q, (const float*)(ws + WS_RSTD), (const float*)(ws + WS_ROPE)}; pg8::gemm_phase(lds, g, e); }
                SITE(19) REP(19) { pg8::Gemm g{(const bf16_t*)(ws + WS_BIG) + C_CKV, (const bf16_t*)(WH + WH_KVB), NROW, 2048, 256, HYB_INP, 256};
                  EpiKV e{ws + WS_R1 + R1_KN, ws + WS_R1 + R1_V, (const float*)(ws + WS_RSTD) + NROW}; pg8::gemm_phase(lds, g, e); }
                SITE(20) REP(20) for (int u = blockIdx.x; u < 528; u += gridDim.x) ssd::g_unit((const bf16_t*)(ws + WS_R2 + R2_BC), (bf16_t*)(ws + WS_BIG + BIG_G), u);
            }
            SITE(5) PH(base + 3) {
                const int xq = (int)blockIdx.x & 7, jq = (int)blockIdx.x >> 3; const bool ssd_wg = (jq & 1) == 0 && gridDim.x == 256;
                if (gridDim.x == 256) {
                    if (ssd_wg) { const int r = jq >> 1, gi = xq + 8 * (r >> 3), hh = r & 7, sb = gi >> 2, sgp = (gi >> 1) & 1, sd = gi & 1;
                        SITE(21) ssd::ssd_unit(sb, 8 * sgp + hh, sd, (const bf16_t*)(ws + WS_R2), (const bf16_t*)(ws + WS_R2 + R2_BC), (const float*)(ws + WS_BIG + BIG_DT), (const bf16_t*)(ws + WS_BIG + BIG_G),
                                               A.in[I_ALOG] + li * 32, sd ? (bf16_t*)(ws + WS_R3) : (bf16_t*)(ws + WS_H), lds); }
                } else {
                    SITE(21) for (int u = blockIdx.x; u < 128; u += gridDim.x) ssd::ssd_unit(u >> 5, (u >> 1) & 15, u & 1, (const bf16_t*)(ws + WS_R2), (const bf16_t*)(ws + WS_R2 + R2_BC), (const float*)(ws + WS_BIG + BIG_DT),
                                               (const bf16_t*)(ws + WS_BIG + BIG_G), A.in[I_ALOG] + li * 32, (u & 1) ? (bf16_t*)(ws + WS_R3) : (bf16_t*)(ws + WS_H), lds);
                }
                const int nmine = gridDim.x == 256 ? (ssd_wg ? 3 : 5) + (L == 0 && !ssd_wg && jq < 8 ? 1 : 0) : 0;
                SITE(22) REP(22) for (int it = 0; gridDim.x == 256 ? it < nmine : (int)blockIdx.x + it * (int)gridDim.x < (L == 0 ? 1056 : 1024); ++it) {
                    int b, h, qrow0, orow0, nt;
                    if (gridDim.x == 256) {
                        const int base_it = ssd_wg ? 3 : 5;
                        if (it < base_it) { const int v = ssd_wg ? 3 * (jq >> 1) + it : 48 + 5 * (jq >> 1) + it; b = v >> 5; h = xq; const int qb = v & 31; qrow0 = 256 + 256 * qb; orow0 = b * 8192 + 256 * qb; nt = NKT; }
                        else { b = jq >> 1; h = xq; qrow0 = 0; orow0 = NLAT + 256 * b; nt = 4; }
                    } else { const int au = (int)blockIdx.x + it * (int)gridDim.x;
                        if (au < 1024) { b = au >> 8; h = au & 7; const int qb = (au >> 3) & 31; qrow0 = 256 + 256 * qb; orow0 = b * 8192 + 256 * qb; nt = NKT; }
                        else { const int cu = au - 1024; b = cu >> 3; h = cu & 7; qrow0 = 0; orow0 = NLAT + 256 * b; nt = 4; } }
                    const size_t bh = (size_t)(b * 8 + h);
                    att8::attn_unit(ws + WS_R1 + R1_Q + (bh * NKEY + qrow0) * 192, ws + WS_R1 + R1_KN + bh * NKT * 8192, ws + WS_BIG + BIG_KR + (size_t)b * NKT * 4096,
                                    ws + WS_R1 + R1_V + bh * NKT * 8192, (bf16_t*)(ws + WS_R3 + R3_CAT) + (size_t)orow0 * 2048 + 1024 + 128 * h, nt, lds);
                }
                if (gridDim.x == 256 && !ssd_wg && L == 2) SITE(11) phase_tabcvt(A, 3, xq + 8 * (jq >> 1), 128, 0, NEXP);
            }
            SITE(6) PH(base + 4) REP(6) { phase_ssd_out(A, li, nr_out(L));
#if defined(MK_CHECK) && MK_CHECK == 1
                if (L == 0) check_attn(A, lds, true);
#elif defined(MK_CHECK) && MK_CHECK == 2
                if (L == 0) check_qkv(A, li, lds);
#elif defined(MK_CHECK) && MK_CHECK == 3
                if (L == 2) check_attn(A, lds, false);
#elif defined(MK_CHECK) && MK_CHECK == 5
                if (L == 0) check_ssd(A, li, lds);
#elif defined(MK_CHECK) && MK_CHECK == 6
                if (L == 2) check_ssd(A, li, lds);
#endif
            }
        } else {
            SITE(7) PH(base + 0) REP(7) { pg8::Gemm g{H, (const bf16_t*)(WG + WG_IN), nr_out(L), 4096, 1024, 1024, 1024};
                pg8::EpiGmIn e{(bf16_t*)(ws + WS_BIG), (float*)(ws + WS_R3)}; pg8::gemm_phase(lds, g, e);
                if (rep == 0 && L == 1) TAIL_TAB((nr_out(L) / 256) * 16, 1, NEXP, 2 * NEXP); }
            SITE(9) PH(base + 2) REP(9) { phase_spatial(A, li, nr_out(L), lds); }
        }
        SITE(10) PH(base + 5) { pg8::Gemm g{hyb ? (const bf16_t*)(ws + WS_R3 + R3_CAT) : (const bf16_t*)(ws + WS_R1), hyb ? (const bf16_t*)(WH + WH_OUT) : (const bf16_t*)(WG + WG_OUT), nr_out(L), 1024, 2048, 2048, 2048};
            pg8::EpiResid e{XB, MODL + 2 * 1024}; pg8::gemm_phase(lds, g, e);
            if (L == 0) TAIL_TAB((nr_out(L) / 256) * 4, 0, 0, 2 * NEXP); else if (L == 1) TAIL_TAB((nr_out(L) / 256) * 4, 2, 0, 2 * NEXP); }
        SITE(11) PH(base + 6) REP(11) { phase_norm_mod<false>(nullptr, nullptr, XB, A.in[I_N2G] + L * 1024, MODL, 3, H, nr_out(L));
            if (gridDim.x != 256) phase_tabcvt(A, L, (int)blockIdx.x, (int)gridDim.x);
            else if (L == 3) phase_tabcvt(A, 3, (int)blockIdx.x, 256, NEXP, 2 * NEXP); }
        SITE(12) PH(base + 7) REP(12) { pg8::Gemm g{H, (const bf16_t*)(WP + WP_Q), nr_out(L), 2048, 1024, 1024, 1024};
            pg8::EpiBf16<0> e{(bf16_t*)(ws + WS_BIG), 2048}; pg8::gemm_phase(lds, g, e);
            if (rep == 0 && L == 0) TAIL_TAB((nr_out(L) / 256) * 8, 1, 0, NEXP); }
        SITE(13) PH(base + 8) REP(13) { phase_topk(A, L, nr_out(L), lds); }
        SITE(14) PH(base + 9) REP(14) { phase_peer_u(A, L, nr_out(L), smem, rep); }
        SITE(15) PH(base + 10) REP(15) { phase_coef(A, L, nr_out(L));
#if defined(MK_CHECK) && MK_CHECK == 4
            if (L == 1) check_topk(A, L, lds);
#endif
        }
        SITE(16) PH(base + 11) { phase_peer_v(A, L, nr_out(L), smem, 0); }
        SITE(17) PH(base + 12) { if (L < DEPTH - 1) phase_norm_mod<false>(nullptr, nullptr, XB, A.in[I_N1G] + (L + 1) * 1024, MOD + (size_t)(L + 1) * 5 * 6144, 0, H, nr_in(L + 1));
                        else {
#ifdef MK_CHECK
                            const float* chk = (const float*)(ws + WS_CTL) + CW_CHK; const float err = sqrtf(chk[0] / fmaxf(chk[1], 1e-30f));
                            phase_final_norm(XB, A.out, A.in[I_FNG], 1.f + 10.f * err);
#else
                            phase_final_norm(XB, A.out, A.in[I_FNG], 1.f);
#endif
                        } }
    }
#undef PH
}

#ifdef MK_TAP
__global__ void tap_kernel(const unsigned short* buf, size_t pitch, size_t col0, size_t ncols, size_t nrows, float* out) {
    const size_t n = ncols * nrows;
    for (size_t i = (size_t)blockIdx.x * blockDim.x + threadIdx.x; i < (size_t)NLAT * D; i += (size_t)gridDim.x * blockDim.x) {
        float s = 0.f; for (size_t j = i; j < n; j += (size_t)NLAT * D) s += (float)buf[(j / ncols) * pitch + col0 + (j % ncols)]; out[i] = s; }
}
#endif
extern "C" void kernel_launch(void* const* d_in, const int* in_sizes, int n_in, void* d_out, int out_size, void* d_ws, size_t ws_size, hipStream_t stream) {
    static int grid = 0;
    if (grid == 0) {
        if (n_in != N_IN || out_size != NLAT * D || ws_size < WS_END) { fprintf(stderr, "kernel_launch: unexpected shapes (n_in %d out %d ws %zu, need %zu)\n", n_in, out_size, ws_size, (size_t)WS_END); grid = -1; return; }
        int dev = 0, cus = 0, per_cu = 0;
        if (hipGetDevice(&dev) != hipSuccess || hipDeviceGetAttribute(&cus, hipDeviceAttributeMultiprocessorCount, dev) != hipSuccess) { grid = -1; return; }
        if (hipFuncSetAttribute((const void*)fwd, hipFuncAttributeMaxDynamicSharedMemorySize, LDS_BYTES) != hipSuccess) { fprintf(stderr, "kernel_launch: hipFuncSetAttribute failed\n"); grid = -1; return; }
        if (hipOccupancyMaxActiveBlocksPerMultiprocessor(&per_cu, (const void*)fwd, NTHR, LDS_BYTES) != hipSuccess || per_cu < 1) { fprintf(stderr, "kernel_launch: occupancy query says %d\n", per_cu); }
        (void)hipGetLastError();
        grid = cus;
    }
    if (grid < 0) return;
    (void)hipMemsetAsync((char*)d_ws + WS_CTL, 0, CTL_BYTES, stream);
    Args a{};
    for (int i = 0; i < N_IN; ++i) a.in[i] = (const float*)d_in[i];
    a.out = (float*)d_out; a.ws = (unsigned char*)d_ws;
#if MK_PER_PHASE
    for (int id = 0; id < 2 + 16 * DEPTH; ++id) {
        if (id >= 2) { const int L = (id - 2) / 16, s = (id - 2) % 16; if (s > 12) continue; if ((L & 1) && (s == 3 || s == 4)) continue; }
#ifdef MK_CUT
#ifdef MK_TAP
        if (id >= MK_CUT) continue;
#else
        if (id >= MK_CUT && id != 2 + 16 * (DEPTH - 1) + 12) continue;
#endif
#endif
        a.ph_lo = id; a.ph_hi = id + 1;
        hipLaunchKernelGGL(fwd, dim3(grid), dim3(NTHR), LDS_BYTES, stream, a);
    }
#ifdef MK_TAP
    { const size_t tp[5] = {MK_TAP}; hipLaunchKernelGGL(tap_kernel, dim3(2048), dim3(256), 0, stream, (const unsigned short*)((const char*)d_ws + tp[0]), tp[1], tp[2], tp[3], tp[4], (float*)d_out); }
#endif
#else
    a.ph_lo = 0; a.ph_hi = 2 + 16 * DEPTH;
    hipLaunchKernelGGL(fwd, dim3(grid), dim3(NTHR), LDS_BYTES, stream, a);
#endif
    const hipError_t le = hipPeekAtLastError();
    if (le != hipSuccess) fprintf(stderr, "kernel_launch: launch failed: %s\n", hipGetErrorName(le));
}
```

```cpp
#include <hip/hip_runtime.h>
#include <cstdio>
#include <cstdint>

#define LAS __attribute__((address_space(3)))
typedef unsigned short bf16_t;
typedef short bf16x8 __attribute__((ext_vector_type(8)));
typedef short s16x4 __attribute__((ext_vector_type(4)));
typedef float f32x2 __attribute__((ext_vector_type(2)));
typedef float f32x4 __attribute__((ext_vector_type(4)));
typedef float f32x16 __attribute__((ext_vector_type(16)));
typedef unsigned u32x2 __attribute__((ext_vector_type(2)));
typedef unsigned u32x4 __attribute__((ext_vector_type(4)));
typedef int i32x4 __attribute__((ext_vector_type(4)));
typedef int i32x8 __attribute__((ext_vector_type(8)));

constexpr int D = 1024, NB = 4, SEQ = 8192, DEPTH = 4, CTXL = 256;
constexpr int NLAT = NB * SEQ, NCTX = NB * CTXL, NROW = NLAT + NCTX;
constexpr int HYB_IN = 3280, HYB_INP = 3328;
constexpr int C_Z = 0, C_XBC = 1024, C_DT = 2560, C_CQ = 2576, C_CKV = 2960, C_KR = 3216;
constexpr int NKEY = SEQ + CTXL, NKT = NKEY / 64;
constexpr float EPS = 1e-6f;
constexpr float QSCALE = 0.07216878364870322f * 1.4426950408889634f;
constexpr int NEXP = 16384;

enum { I_X = 0, I_C, I_CTX, I_CCTX, I_ADAW, I_ADAB, I_N1G, I_N2G, I_HWIN, I_CONVW, I_CONVB, I_ALOG, I_DTB, I_SSDD, I_SSDNG, I_QNG, I_WQB, I_KVNG, I_WKVB,
       I_HWOUT, I_GWIN, I_GLNG, I_GLNB, I_GWS, I_GBS, I_GWOUT, I_PWQ, I_PK1, I_PK2, I_PU, I_PV, I_FNG, N_IN };

constexpr size_t al256(size_t x) { return (x + 255) & ~(size_t)255; }
constexpr size_t WS_CTL = 0, CTL_BYTES = 65536;
constexpr size_t WS_MOD = WS_CTL + CTL_BYTES;
constexpr size_t WS_ROPE = WS_MOD + al256((size_t)DEPTH * 5 * 6144 * 4);
constexpr size_t WS_RSTD = WS_ROPE + (size_t)2 * SEQ * 32 * 4;
constexpr size_t WS_W = WS_RSTD + al256((size_t)2 * NROW * 4);
constexpr size_t W_HYB = 0;
constexpr size_t WH_IN = 0, WH_QB = WH_IN + (size_t)HYB_INP * 1024 * 2, WH_KVB = WH_QB + (size_t)1536 * 384 * 2, WH_OUT = WH_KVB + (size_t)2048 * 256 * 2,
                 WH_SZ = WH_OUT + (size_t)1024 * 2048 * 2;
constexpr size_t W_GM = W_HYB + 2 * WH_SZ;
constexpr size_t WG_IN = 0, WG_OUT = WG_IN + (size_t)4096 * 1024 * 2, WG_WS = WG_OUT + (size_t)1024 * 2048 * 2, WG_SZ = WG_WS + (size_t)8 * 128 * 128 * 2;
constexpr size_t W_PEER = W_GM + 2 * WG_SZ;
constexpr size_t WP_Q = 0, WP_K1 = WP_Q + (size_t)2048 * 1024 * 2, WP_K2 = WP_K1 + (size_t)8 * 128 * 128 * 2, WP_SZ = WP_K2 + (size_t)8 * 128 * 128 * 2;
constexpr size_t W_TOTAL = W_PEER + 4 * WP_SZ;
constexpr size_t WS_TAB = WS_W + al256(W_TOTAL);
constexpr size_t TAB_HALF = (size_t)NEXP * 1024 * 2;
constexpr size_t TAB_REGION = 2 * TAB_HALF + 524288;
constexpr size_t WS_XB = WS_TAB + TAB_REGION;
constexpr size_t WS_H = WS_XB + (size_t)NROW * D * 2;
constexpr size_t WS_BIG = WS_H + (size_t)NROW * D * 2;
constexpr size_t BIG_BYTES = (size_t)NROW * 4096 * 2;
constexpr size_t BIG_DT = (size_t)NROW * HYB_INP * 2;
constexpr size_t BIG_G = BIG_DT + (size_t)NROW * 32 * 4;
constexpr size_t BIG_KR = BIG_G + (size_t)528 * 128 * 128 * 2;
constexpr size_t BIG_PART = (size_t)NROW * 2048 * 2;
static_assert(BIG_KR + (size_t)NB * NKT * 8192 <= BIG_BYTES, "BIG tail");
constexpr size_t WS_R1 = WS_BIG + BIG_BYTES;
constexpr size_t R1_Q = 0, R1_KN = R1_Q + (size_t)NB * 8 * NKEY * 192, R1_V = R1_KN + (size_t)NB * 8 * NKT * 8192, R1_HYB = R1_V + (size_t)NB * 8 * NKT * 8192,
                 R1_GM = (size_t)NROW * 2048 * 2, R1_BYTES = R1_HYB > R1_GM ? R1_HYB : R1_GM;
constexpr size_t WS_R2 = WS_R1 + R1_BYTES;
constexpr size_t R2_BC = (size_t)NROW * 1024 * 2, R2_BYTES = R2_BC + (size_t)NROW * 512 * 2;
constexpr size_t R2_GATE = (size_t)NROW * 128 * 4, R2_COEF = 2 * R2_GATE;
constexpr size_t WS_R3 = WS_R2 + R2_BYTES;
constexpr size_t R3_CAT = (size_t)NROW * 1024 * 2, R3_BYTES = R3_CAT + (size_t)NROW * 2048 * 2;
constexpr size_t WS_END = WS_R3 + R3_BYTES;
static_assert(WS_END <= ((size_t)1 << 30), "workspace must fit 1 GiB");

constexpr int CW_RANK = 3584;
constexpr int CW_QUEUE = 4096;

typedef __bf16 bf16x2_t __attribute__((ext_vector_type(2)));
__device__ __forceinline__ unsigned cvt_pk_bf16(float lo, float hi) { const f32x2 v = {lo, hi}; const bf16x2_t b = __builtin_convertvector(v, bf16x2_t); return __builtin_bit_cast(unsigned, b); }
__device__ __forceinline__ bf16_t f2bf(float f) { return (bf16_t)(cvt_pk_bf16(f, 0.f) & 0xffffu); }
__device__ __forceinline__ float bf2f(unsigned b) { return __uint_as_float(b << 16); }
__device__ __forceinline__ float bflo(unsigned w) { return __uint_as_float(w << 16); }
__device__ __forceinline__ float bfhi(unsigned w) { return __uint_as_float(w & 0xffff0000u); }
__device__ __forceinline__ float wave_sum(float v) {
#pragma unroll
    for (int o = 32; o >= 1; o >>= 1) v += __shfl_xor(v, o);
    return v;
}
__device__ __forceinline__ int otid() { int t = threadIdx.x; asm volatile("" : "+v"(t)); return t; }
__device__ __forceinline__ float silu_f(float x) { return x * __builtin_amdgcn_rcpf(1.f + __expf(-x)); }
__device__ __forceinline__ float softplus_f(float x) { return x > 20.f ? x : log1pf(__expf(x)); }
__device__ __forceinline__ f32x2 gelu_pk(f32x2 v) {
    const f32x2 av = __builtin_elementwise_abs(v), d = av * 0.2316418882f + 1.0f;
    f32x2 t; t.x = __builtin_amdgcn_rcpf(d.x); t.y = __builtin_amdgcn_rcpf(d.y);
    f32x2 q = t * 0.5307027145f + (-0.7265760135f); q = q * t + 0.7107068705f; q = q * t + (-0.142248368f); q = q * t + 0.127414796f; q = q * t;
    const f32x2 s = (v * v) * (-0.72134752044f);
    f32x2 e; e.x = __builtin_amdgcn_exp2f(s.x); e.y = __builtin_amdgcn_exp2f(s.y);
    const f32x2 m = v * (q * e), r = v - m;
    f32x2 o; o.x = v.x < 0.f ? m.x : r.x; o.y = v.y < 0.f ? m.y : r.y; return o;
}
__device__ __forceinline__ float gelu_f(float x) { f32x2 v = {x, 0.f}; return gelu_pk(v).x; }

__device__ __forceinline__ unsigned pk4_fp8(float a, float b, float c, float d) { int w = 0; w = __builtin_amdgcn_cvt_pk_fp8_f32(a, b, w, false); w = __builtin_amdgcn_cvt_pk_fp8_f32(c, d, w, true); return (unsigned)w; }
__device__ __forceinline__ float sat8(float v) { return __builtin_amdgcn_fmed3f(v, -448.f, 448.f); }
__device__ __forceinline__ unsigned pk4_fp8_sat(float a, float b, float c, float d) { return pk4_fp8(sat8(a), sat8(b), sat8(c), sat8(d)); }
__device__ __forceinline__ int row_mb(int r) { return r < NLAT ? (r >> 13) : 4; }

#define XB_TMO      128
#define XB_XCNT(j)  (256  + 64 * (j))
#define XB_XSUB(j)  (1280 + 64 * (j))
#define XB_XGEN(j)  (2304 + 64 * (j))
#define XB_TOP      3328
#define XB_TOPGEN   3392
#define XCD_BAR_WORDS 3456
#define XB_SPIN_CAP (1u << 22)
__device__ __forceinline__ unsigned xb_ld(unsigned* p)              { return __hip_atomic_load(p, __ATOMIC_RELAXED, __HIP_MEMORY_SCOPE_AGENT); }
__device__ __forceinline__ unsigned xb_add(unsigned* p, unsigned v) { return __hip_atomic_fetch_add(p, v, __ATOMIC_RELAXED, __HIP_MEMORY_SCOPE_AGENT); }
__device__ __forceinline__ unsigned xb_xcc_id() { return (unsigned)__builtin_amdgcn_s_getreg((3 << 11) | 20) & 0xFu; }
#define XB_SPIN(cond, bar) do { unsigned _sp = 0; while (cond) { __builtin_amdgcn_s_sleep(1); \
    if ((++_sp & 255u) == 0u) { if (xb_ld(&(bar)[XB_TMO])) break; if (_sp > XB_SPIN_CAP) { atomicAdd(&(bar)[XB_TMO], 1u); break; } } } } while (0)
struct XcdBarrier { unsigned* bar; unsigned x; volatile LAS unsigned* st; };
__device__ __forceinline__ XcdBarrier xcd_barrier_post(unsigned* bar, volatile LAS unsigned* st) {
    XcdBarrier b; b.bar = bar; b.x = xb_xcc_id(); b.st = st;
    if (threadIdx.x == 0) (void)xb_add(&bar[XB_XCNT(b.x)], 1u);
    return b;
}
__device__ __forceinline__ void xcd_barrier_complete(unsigned* bar, unsigned x, unsigned& nloc, unsigned& nx) {
    const unsigned G = gridDim.x * gridDim.y * gridDim.z;
    unsigned sum, cnt, mine, sp = 0u;
    for (;;) {
        sum = 0u; cnt = 0u; mine = 0u;
#pragma unroll
        for (unsigned j = 0; j < 16; ++j) { const unsigned c = xb_ld(&bar[XB_XCNT(j)]); sum += c; cnt += (c > 0u) ? 1u : 0u; mine = (j == x) ? c : mine; }
        if (sum == G) break;
        __builtin_amdgcn_s_sleep(1);
        if ((++sp & 255u) == 0u) { if (xb_ld(&bar[XB_TMO])) break; if (sp > XB_SPIN_CAP) { atomicAdd(&bar[XB_TMO], 1u); break; } }
    }
    nloc = mine > 0u ? mine : 1u; nx = cnt > 0u ? cnt : 1u;
}
__device__ __forceinline__ void xcd_barrier(const XcdBarrier& b) {
    asm volatile("s_waitcnt vmcnt(0)" ::: "memory");
    __syncthreads();
    if (threadIdx.x == 0) {
        unsigned* bar = b.bar;
        __builtin_amdgcn_s_waitcnt(0);
        unsigned nloc = b.st[0], nx = b.st[1];
        if (nloc == 0u) { xcd_barrier_complete(bar, b.x, nloc, nx); b.st[0] = nloc; b.st[1] = nx; }
        const unsigned old = xb_add(&bar[XB_XSUB(b.x)], 1u);
        const unsigned gen = old / nloc;
        if (old + 1u == (gen + 1u) * nloc) {
            __builtin_amdgcn_fence(__ATOMIC_RELEASE, "agent");
            asm volatile("s_waitcnt vmcnt(0)" ::: "memory");
            const unsigned og = xb_add(&bar[XB_TOP], 1u);
            const unsigned tg = og / nx;
            if (og + 1u == (tg + 1u) * nx) xb_add(&bar[XB_TOPGEN], 1u);
            else XB_SPIN(xb_ld(&bar[XB_TOPGEN]) == tg, bar);
            __builtin_amdgcn_fence(__ATOMIC_ACQUIRE, "agent");
            xb_add(&bar[XB_XGEN(b.x)], 1u);
            asm volatile("s_waitcnt vmcnt(0)" ::: "memory");
        } else {
            XB_SPIN(xb_ld(&bar[XB_XGEN(b.x)]) == gen, bar);
            __builtin_amdgcn_fence(__ATOMIC_ACQUIRE, "agent");
            asm volatile("s_waitcnt vmcnt(0)" ::: "memory");
        }
    }
    __syncthreads();
}

namespace pg8 {
constexpr int BM = 256, BK = 64, HALF = 128, HTB = HALF * BK * 2, STAGE_BYTES = 8 * HTB, NXCD = 8, WGM = 8;
__host__ __device__ __forceinline__ int lds_byte(int r, int c) { const int st = (r >> 4) * 2 + (c >> 5), rr = r & 15, cc = c & 31, ob = rr * 64 + cc * 2; return st * 1024 + (ob ^ (((ob >> 9) & 1) << 5)); }
__host__ __device__ __forceinline__ void stage_rc(int b, int& R, int& C) { const int st = b / 1024, sb = b % 1024, swz = sb ^ (((sb >> 9) & 1) << 5); R = (st >> 1) * 16 + swz / 64; C = (st & 1) * 32 + (swz % 64) / 2; }
__host__ __device__ __forceinline__ int perm32(int rho) { const int n = rho >> 4, i = rho & 15; return 8 * (i >> 2) + 4 * n + (i & 3); }
struct Unit { int pm, pn; };
struct Gemm { const bf16_t* A; const bf16_t* Bt; int M, N, K, lda, ldb; };
struct StaticOrder {
    int nM, nN, nwg, G, c;
    __device__ void init(int M, int N, int G_, int c_) { nM = M / BM; nN = N / BM; nwg = nM * nN; G = G_; c = c_; }
    __device__ bool next(int i, Unit& u) const {
        const long L = (long)i * G + c; if (L >= nwg) return false;
        int wgid = (int)L; { const int q = nwg / NXCD, r = nwg % NXCD, xcd = wgid % NXCD, off = wgid / NXCD; wgid = (xcd < r ? xcd * (q + 1) : r * (q + 1) + (xcd - r) * q) + off; }
        const int nig = WGM * nN, gid = wgid / nig, fm = gid * WGM, gsz = (nM - fm) < WGM ? (nM - fm) : WGM;
        u.pm = fm + ((wgid % nig) % gsz); u.pn = (wgid % nig) / gsz; return true;
    }
};
template <class Epi>
__device__ __forceinline__ void gemm_phase(LAS unsigned char* lds, const Gemm g, const Epi& E) {
    const int tid = otid(), wid = __builtin_amdgcn_readfirstlane(tid >> 6), lane = tid & 63, wr = wid >> 2, wc = wid & 3, fr = lane & 15, fq = lane >> 4;
    StaticOrder S; S.init(g.M, g.N, (int)gridDim.x, (int)blockIdx.x);
    int K = g.K; asm volatile("" : "+s"(K));
    const int nt = K / BK;
    unsigned voffA[2], voffB[2];
#pragma unroll
    for (int i = 0; i < 2; ++i) { int R, C; stage_rc(tid * 16 + i * 8192, R, C); const int Rb = Epi::PERM ? ((R & ~31) + perm32(R & 31)) : R;
        voffA[i] = (unsigned)(R * g.lda + C) * 2u; voffB[i] = (unsigned)(Rb * g.ldb + C) * 2u; }
    const size_t kstep = (size_t)(BK * 2);
    const size_t hstepA = (size_t)HALF * g.lda * 2, hstepB = (size_t)HALF * g.ldb * 2;
    const size_t tstepA = 2 * hstepA, tstepB = 2 * hstepB;
    const unsigned ldsw = (unsigned)wid * 1024u;
    const int aoff = lds_byte(wr * 64 + fr, fq * 8), boff = lds_byte(wc * 32 + fr, fq * 8);
#define PG8_SA(b, h) (((b) * 2 + (h)) * HTB)
#define PG8_SB(b, h) ((4 + (b) * 2 + (h)) * HTB)
#define PG8_STAGE(bufoff, gbase, voff) do { _Pragma("unroll") for (int _i = 0; _i < 2; ++_i) \
        __builtin_amdgcn_global_load_lds((const unsigned*)((const char*)(gbase) + (voff)[_i]), (LAS unsigned*)(lds + (bufoff) + ldsw + _i * 8192), 16, 0, 0); } while (0)
#define PG8_LDA(dst, b, h) do { _Pragma("unroll") for (int m = 0; m < 4; ++m) _Pragma("unroll") for (int k = 0; k < 2; ++k) dst[m][k] = *(const LAS bf16x8*)(lds + PG8_SA(b, h) + aoff + m * 2048 + k * 1024); } while (0)
#define PG8_LDB(dst, b, h) do { _Pragma("unroll") for (int n = 0; n < 2; ++n) _Pragma("unroll") for (int k = 0; k < 2; ++k) dst[n][k] = *(const LAS bf16x8*)(lds + PG8_SB(b, h) + boff + n * 2048 + k * 1024); } while (0)
#define PG8_MMA(ai, bj, At, Bt) do { __builtin_amdgcn_s_setprio(1); _Pragma("unroll") for (int m = 0; m < 4; ++m) _Pragma("unroll") for (int n = 0; n < 2; ++n) _Pragma("unroll") for (int k = 0; k < 2; ++k) \
        acc[ai][bj][m][n] = __builtin_amdgcn_mfma_f32_16x16x32_bf16(Bt[n][k], At[m][k], acc[ai][bj][m][n], 0, 0, 0); __builtin_amdgcn_s_setprio(0); } while (0)
#define PG8_WAIT_V(n) asm volatile("s_waitcnt vmcnt(" #n ")" ::: "memory")
#define PG8_WAIT_L(n) asm volatile("s_waitcnt lgkmcnt(" #n ")" ::: "memory")
#define PG8_BAR __builtin_amdgcn_s_barrier()
#define PG8_SCHED __builtin_amdgcn_sched_barrier(0)
    Unit cur, nxt; int ui = 0;
    if (!S.next(0, cur)) return;
    f32x4 acc[2][2][4][2];
#pragma unroll
    for (int a = 0; a < 2; ++a)
#pragma unroll
        for (int b = 0; b < 2; ++b)
#pragma unroll
            for (int m = 0; m < 4; ++m)
#pragma unroll
                for (int n = 0; n < 2; ++n) acc[a][b][m][n] = (f32x4){0.f, 0.f, 0.f, 0.f};
    bf16x8 At[4][2], B0[2][2], B1[2][2];
    const char* cA = (const char*)g.A + (size_t)cur.pm * tstepA; const char* cB = (const char*)g.Bt + (size_t)cur.pn * tstepB;
    PG8_STAGE(PG8_SB(0, 0), cB, voffB); PG8_STAGE(PG8_SB(0, 1), cB + hstepB, voffB); PG8_STAGE(PG8_SA(0, 0), cA, voffA); PG8_STAGE(PG8_SA(0, 1), cA + hstepA, voffA);
    if (wr == 1) PG8_BAR;
    PG8_WAIT_V(2); PG8_BAR;
    PG8_STAGE(PG8_SB(1, 0), cB + kstep, voffB); PG8_STAGE(PG8_SA(1, 0), cA + kstep, voffA); PG8_STAGE(PG8_SB(1, 1), cB + hstepB + kstep, voffB);
    PG8_WAIT_V(6); PG8_BAR;
    for (;;) {
        const bool has_next = S.next(ui + 1, nxt);
        const char* nA = has_next ? (const char*)g.A + (size_t)nxt.pm * tstepA : cA; const char* nB = has_next ? (const char*)g.Bt + (size_t)nxt.pn * tstepB : cB;
        for (int t = 0; t < nt; t += 2) {
            const bool last = (t == nt - 2);
            const char* a1 = cA + (size_t)(t + 1) * kstep;
            const char* a2 = last ? nA : cA + (size_t)(t + 2) * kstep; const char* b2 = last ? nB : cB + (size_t)(t + 2) * kstep;
            const char* a3 = a2 + kstep; const char* b3 = b2 + kstep;
            PG8_LDB(B0, 0, 0); PG8_LDB(B1, 0, 1); PG8_SCHED; PG8_LDA(At, 0, 0); PG8_STAGE(PG8_SA(1, 1), a1 + hstepA, voffA);
            PG8_WAIT_V(8); PG8_WAIT_L(0); PG8_BAR; PG8_MMA(0, 0, At, B0); PG8_MMA(0, 1, At, B1); PG8_BAR; PG8_SCHED;
            PG8_LDA(At, 0, 1); PG8_STAGE(PG8_SB(0, 0), b2, voffB); PG8_STAGE(PG8_SB(0, 1), b2 + hstepB, voffB); PG8_STAGE(PG8_SA(0, 0), a2, voffA);
            PG8_WAIT_V(8); PG8_WAIT_L(0); PG8_BAR; PG8_MMA(1, 0, At, B0); PG8_MMA(1, 1, At, B1); PG8_BAR; PG8_SCHED;
            PG8_LDB(B0, 1, 0); PG8_LDB(B1, 1, 1); PG8_SCHED; PG8_LDA(At, 1, 0); PG8_STAGE(PG8_SA(0, 1), a2 + hstepA, voffA);
            PG8_WAIT_V(8); PG8_WAIT_L(0); PG8_BAR; PG8_MMA(0, 0, At, B0); PG8_MMA(0, 1, At, B1); PG8_BAR; PG8_SCHED;
            PG8_LDA(At, 1, 1); PG8_STAGE(PG8_SB(1, 0), b3, voffB); PG8_STAGE(PG8_SB(1, 1), b3 + hstepB, voffB); PG8_STAGE(PG8_SA(1, 0), a3, voffA);
            PG8_WAIT_V(8); PG8_WAIT_L(0); PG8_BAR; PG8_MMA(1, 0, At, B0); PG8_MMA(1, 1, At, B1); PG8_BAR; PG8_SCHED;
        }
        if (wr == 0) PG8_BAR;
        { const int l2_ = otid() & 63; E(acc, cur, wr, wc, l2_ & 15, l2_ >> 4); }
        if (!has_next) break;
#pragma unroll
        for (int a = 0; a < 2; ++a)
#pragma unroll
            for (int b = 0; b < 2; ++b)
#pragma unroll
                for (int m = 0; m < 4; ++m)
#pragma unroll
                    for (int n = 0; n < 2; ++n) acc[a][b][m][n] = (f32x4){0.f, 0.f, 0.f, 0.f};
        cur = nxt; cA = nA; cB = nB; ++ui;
        if (wr == 1) PG8_BAR;
    }
    PG8_WAIT_V(0);
    PG8_BAR;
#undef PG8_SA
#undef PG8_SB
#undef PG8_STAGE
#undef PG8_LDA
#undef PG8_LDB
#undef PG8_MMA
#undef PG8_WAIT_V
#undef PG8_WAIT_L
#undef PG8_BAR
#undef PG8_SCHED
}

template <int ACT> struct EpiBf16 {
    static constexpr bool PERM = true;
    bf16_t* O; int ldc;
    __device__ __forceinline__ void operator()(const f32x4 (&acc)[2][2][4][2], const Unit& u, int wr, int wc, int fr, int fq) const {
        const int row0 = u.pm * BM + wr * 64 + fr, col0 = u.pn * BM + wc * 32 + 8 * fq;
#pragma unroll
        for (int ai = 0; ai < 2; ++ai)
#pragma unroll
            for (int m = 0; m < 4; ++m) { bf16_t* rowp = O + (size_t)(row0 + ai * HALF + m * 16) * ldc + col0;
#pragma unroll
                for (int bj = 0; bj < 2; ++bj) { f32x4 v0 = acc[ai][bj][m][0], v1 = acc[ai][bj][m][1];
                    if (ACT == 1) { f32x2 a = gelu_pk((f32x2){v0[0], v0[1]}), b = gelu_pk((f32x2){v0[2], v0[3]}), c = gelu_pk((f32x2){v1[0], v1[1]}), d = gelu_pk((f32x2){v1[2], v1[3]});
                        v0 = (f32x4){a.x, a.y, b.x, b.y}; v1 = (f32x4){c.x, c.y, d.x, d.y}; }
                    u32x4 w; w.x = cvt_pk_bf16(v0[0], v0[1]); w.y = cvt_pk_bf16(v0[2], v0[3]); w.z = cvt_pk_bf16(v1[0], v1[1]); w.w = cvt_pk_bf16(v1[2], v1[3]);
                    *(u32x4*)(rowp + bj * HALF) = w; } }
    }
};
struct EpiGmIn {
    static constexpr bool PERM = true;
    bf16_t* O; float* parts;
    __device__ __forceinline__ void operator()(const f32x4 (&acc)[2][2][4][2], const Unit& u, int wr, int wc, int fr, int fq) const {
        const int row0 = u.pm * BM + wr * 64 + fr, col0 = u.pn * BM + wc * 32 + 8 * fq; const bool vhalf = u.pn >= 8;
#pragma unroll
        for (int ai = 0; ai < 2; ++ai)
#pragma unroll
            for (int m = 0; m < 4; ++m) { const int row = row0 + ai * HALF + m * 16; bf16_t* rowp = O + (size_t)row * 4096 + col0; f32x2 sa = {0.f, 0.f}, sq = {0.f, 0.f};
#pragma unroll
                for (int bj = 0; bj < 2; ++bj) { const f32x4 v0 = acc[ai][bj][m][0], v1 = acc[ai][bj][m][1];
                    const f32x2 a = gelu_pk((f32x2){v0[0], v0[1]}), b = gelu_pk((f32x2){v0[2], v0[3]}), c = gelu_pk((f32x2){v1[0], v1[1]}), d = gelu_pk((f32x2){v1[2], v1[3]});
                    sa += (a + b) + (c + d); sq += (a * a + b * b) + (c * c + d * d);
                    u32x4 w; w.x = cvt_pk_bf16(a.x, a.y); w.y = cvt_pk_bf16(b.x, b.y); w.z = cvt_pk_bf16(c.x, c.y); w.w = cvt_pk_bf16(d.x, d.y);
                    *(u32x4*)(rowp + bj * HALF) = w; }
                if (vhalf) { float s1 = sa.x + sa.y, s2 = sq.x + sq.y;
                    { auto r = __builtin_amdgcn_permlane16_swap(__float_as_uint(s1), __float_as_uint(s1), false, false); s1 = __uint_as_float(r[0]) + __uint_as_float(r[1]); }
                    { auto r = __builtin_amdgcn_permlane16_swap(__float_as_uint(s2), __float_as_uint(s2), false, false); s2 = __uint_as_float(r[0]) + __uint_as_float(r[1]); }
                    { auto r = __builtin_amdgcn_permlane32_swap(__float_as_uint(s1), __float_as_uint(s1), false, false); s1 = __uint_as_float(r[0]) + __uint_as_float(r[1]); }
                    { auto r = __builtin_amdgcn_permlane32_swap(__float_as_uint(s2), __float_as_uint(s2), false, false); s2 = __uint_as_float(r[0]) + __uint_as_float(r[1]); }
                    if (fq == 0) *(f32x2*)(parts + ((size_t)row * 32 + (u.pn - 8) * 4 + wc) * 2) = (f32x2){s1, s2}; } }
    }
};
struct EpiResid {
    static constexpr bool PERM = true;
    bf16_t* X; const float* gate;
    __device__ __forceinline__ void operator()(const f32x4 (&acc)[2][2][4][2], const Unit& u, int wr, int wc, int fr, int fq) const {
        const int rbase = u.pm * BM;
        const float* gp = gate + (size_t)(rbase < NLAT ? (rbase >> 13) : 4) * 6144;
        const int row0 = rbase + wr * 64 + fr, col0 = u.pn * BM + wc * 32 + 8 * fq;
        f32x4 gv[2][2];
#pragma unroll
        for (int bj = 0; bj < 2; ++bj)
#pragma unroll
            for (int n = 0; n < 2; ++n) gv[bj][n] = *(const f32x4*)(gp + col0 + bj * HALF + n * 4);
#pragma unroll
        for (int ai = 0; ai < 2; ++ai)
#pragma unroll
            for (int m = 0; m < 4; ++m) { bf16_t* rowp = X + (size_t)(row0 + ai * HALF + m * 16) * D + col0;
#pragma unroll
                for (int bj = 0; bj < 2; ++bj) { u32x4* p = (u32x4*)(rowp + bj * HALF); const u32x4 x = *p;
                    const f32x4 a0 = (f32x4){bflo(x.x), bfhi(x.x), bflo(x.y), bfhi(x.y)} + gv[bj][0] * acc[ai][bj][m][0], a1 = (f32x4){bflo(x.z), bfhi(x.z), bflo(x.w), bfhi(x.w)} + gv[bj][1] * acc[ai][bj][m][1];
                    u32x4 w; w.x = cvt_pk_bf16(a0[0], a0[1]); w.y = cvt_pk_bf16(a0[2], a0[3]); w.z = cvt_pk_bf16(a1[0], a1[1]); w.w = cvt_pk_bf16(a1[2], a1[3]);
                    *p = w; } }
    }
};
}

namespace att {
#define KSWZ(row, colB) ((row) * 256 + ((colB) ^ (((row) & 7) << 4)))
#define KRSWZ(row, colB) ((row) * 128 + ((colB) ^ ((((row) >> 1) & 7) << 4)))
#define SBAR() __builtin_amdgcn_sched_barrier(0)
__device__ __forceinline__ int crow(int r, int hi) { return (r & 3) + 8 * (r >> 2) + 4 * hi; }
__host__ __device__ __forceinline__ int v_st(int k, int c) { const int kk = (k & ~0xC) | ((k & 4) << 1) | ((k & 8) >> 1); return ((kk >> 3) * 4 + (c >> 5)) * 512 + ((kk & 7) * 32 + (c & 31)) * 2; }
__device__ __forceinline__ int v_rd_base(int lane) { return ((lane & 3) << 3) | (((lane >> 2) & 3) << 6) | (((lane >> 4) & 1) << 5) | (((lane >> 5) & 1) << 8); }
constexpr int v_rd_off(int d0, int ks, int half) { return d0 * 512 + ks * 4096 + half * 2048; }
template <int OFF> __device__ __forceinline__ s16x4 tr_read(int vb) {
    s16x4 r; asm volatile("ds_read_b64_tr_b16 %0, %1 offset:%2" : "=&v"(r) : "v"(vb), "i"(OFF) : "memory"); return r;
}
template <int D0> __device__ __forceinline__ void pv_one(f32x16& od, int vb, bf16x8 pa0, bf16x8 pa1, bf16x8 pa2, bf16x8 pa3) {
    const s16x4 l0 = tr_read<v_rd_off(D0, 0, 0)>(vb), h0 = tr_read<v_rd_off(D0, 0, 1)>(vb), l1 = tr_read<v_rd_off(D0, 1, 0)>(vb), h1 = tr_read<v_rd_off(D0, 1, 1)>(vb);
    const s16x4 l2 = tr_read<v_rd_off(D0, 2, 0)>(vb), h2 = tr_read<v_rd_off(D0, 2, 1)>(vb), l3 = tr_read<v_rd_off(D0, 3, 0)>(vb), h3 = tr_read<v_rd_off(D0, 3, 1)>(vb);
    asm volatile("s_waitcnt lgkmcnt(0)" ::: "memory"); SBAR();
#define PK(L, H) (bf16x8){L[0], L[1], L[2], L[3], H[0], H[1], H[2], H[3]}
    od = __builtin_amdgcn_mfma_f32_32x32x16_bf16(pa0, PK(l0, h0), od, 0, 0, 0);
    od = __builtin_amdgcn_mfma_f32_32x32x16_bf16(pa1, PK(l1, h1), od, 0, 0, 0);
    od = __builtin_amdgcn_mfma_f32_32x32x16_bf16(pa2, PK(l2, h2), od, 0, 0, 0);
    od = __builtin_amdgcn_mfma_f32_32x32x16_bf16(pa3, PK(l3, h3), od, 0, 0, 0);
#undef PK
}
__device__ __forceinline__ void pv_d0(f32x16* o, int vb, bf16x8 pa0, bf16x8 pa1, bf16x8 pa2, bf16x8 pa3) {
    pv_one<0>(o[0], vb, pa0, pa1, pa2, pa3); pv_one<1>(o[1], vb, pa0, pa1, pa2, pa3); pv_one<2>(o[2], vb, pa0, pa1, pa2, pa3); pv_one<3>(o[3], vb, pa0, pa1, pa2, pa3);
}
}

namespace att8 {
constexpr int SLOT = 20480, KN_OFF = 0, KR_OFF = 8192, V_OFF = 12288, LDS_BYTES = 3 * SLOT + 8 * 256;
constexpr float THR2 = 8.0f;
constexpr float QUP = 8.f; constexpr int SC_ONE = 0x7f7f7f7f, SC_Q = 0x7c7c7c7c;
__host__ __device__ __forceinline__ int kn8(int key, int b) { return key * 128 + ((((b >> 4) ^ ((key >> 1) & 7))) << 4) + (b & 15); }
__host__ __device__ __forceinline__ int kr8(int key, int b) { return key * 64 + ((((b >> 4) ^ ((key >> 2) & 3))) << 4) + (b & 15); }
__host__ __device__ __forceinline__ int vslot(int k) { return 32 * ((k >> 2) & 1) + 16 * (k >> 5) + (k & 3) + 4 * ((k & 31) >> 3); }
__host__ __device__ __forceinline__ int v8(int d, int k) { const int sl = vslot(k); return d * 64 + ((((sl >> 4) ^ ((d >> 2) & 3))) << 4) + (sl & 15); }
__device__ __forceinline__ i32x8 ld32(const LAS unsigned char* a0, const LAS unsigned char* a1) { const u32x4 x = *(const LAS u32x4*)a0, y = *(const LAS u32x4*)a1;
    return (i32x8){(int)x.x, (int)x.y, (int)x.z, (int)x.w, (int)y.x, (int)y.y, (int)y.z, (int)y.w}; }
__device__ __forceinline__ void qkt(f32x16& p0, f32x16& p1, LAS unsigned char* slot, const i32x8* qf, int r32, int hi) {
    p0 = f32x16{}; p1 = f32x16{};
#pragma unroll
    for (int ks = 0; ks < 2; ++ks) { const int b = 64 * ks + 32 * hi;
        const i32x8 a0 = ld32(slot + KN_OFF + kn8(r32, b), slot + KN_OFF + kn8(r32, b + 16)), a1 = ld32(slot + KN_OFF + kn8(32 + r32, b), slot + KN_OFF + kn8(32 + r32, b + 16));
        p0 = __builtin_amdgcn_mfma_scale_f32_32x32x64_f8f6f4(a0, qf[ks], p0, 0, 0, 0, SC_ONE, 0, SC_Q);
        p1 = __builtin_amdgcn_mfma_scale_f32_32x32x64_f8f6f4(a1, qf[ks], p1, 0, 0, 0, SC_ONE, 0, SC_Q); }
    { const int b = 32 * hi;
        const i32x8 a0 = ld32(slot + KR_OFF + kr8(r32, b), slot + KR_OFF + kr8(r32, b + 16)), a1 = ld32(slot + KR_OFF + kr8(32 + r32, b), slot + KR_OFF + kr8(32 + r32, b + 16));
        p0 = __builtin_amdgcn_mfma_scale_f32_32x32x64_f8f6f4(a0, qf[2], p0, 0, 0, 0, SC_ONE, 0, SC_Q);
        p1 = __builtin_amdgcn_mfma_scale_f32_32x32x64_f8f6f4(a1, qf[2], p1, 0, 0, 0, SC_ONE, 0, SC_Q); }
}
__device__ __forceinline__ void partialSM(f32x16& p0, f32x16& p1, float& m_reg, float& mn, float& alpha) {
    float pmax = p0[0];
#pragma unroll
    for (int r = 1; r < 16; ++r) pmax = fmaxf(pmax, p0[r]);
#pragma unroll
    for (int r = 0; r < 16; ++r) pmax = fmaxf(pmax, p1[r]);
    { auto rr = __builtin_amdgcn_permlane32_swap(__float_as_uint(pmax), __float_as_uint(pmax), false, false);
      pmax = fmaxf(__uint_as_float(rr[0]), __uint_as_float(rr[1])); }
    if (__builtin_expect(__all(pmax - m_reg <= THR2), 1)) { mn = m_reg; alpha = 1.f; }
    else { mn = fmaxf(m_reg, pmax); alpha = __builtin_amdgcn_exp2f(m_reg - mn); m_reg = mn; }
#pragma unroll
    for (int r = 0; r < 16; ++r) p0[r] = __builtin_amdgcn_exp2f(p0[r] - mn);
#pragma unroll
    for (int r = 0; r < 16; ++r) p1[r] = p1[r] - mn;
}
__device__ __forceinline__ void finishSM(f32x16& p0, f32x16& p1, float alpha, float& l_reg, i32x8& pf) {
#pragma unroll
    for (int r = 0; r < 16; ++r) p1[r] = __builtin_amdgcn_exp2f(p1[r]);
    float ps = 0;
#pragma unroll
    for (int r = 0; r < 16; ++r) ps += p0[r];
#pragma unroll
    for (int r = 0; r < 16; ++r) ps += p1[r];
    { auto rr = __builtin_amdgcn_permlane32_swap(__float_as_uint(ps), __float_as_uint(ps), false, false);
      ps = __uint_as_float(rr[0]) + __uint_as_float(rr[1]); }
    l_reg = l_reg * alpha + ps;
#pragma unroll
    for (int w = 0; w < 4; ++w) { pf[w] = (int)pk4_fp8(p0[4 * w], p0[4 * w + 1], p0[4 * w + 2], p0[4 * w + 3]); pf[4 + w] = (int)pk4_fp8(p1[4 * w], p1[4 * w + 1], p1[4 * w + 2], p1[4 * w + 3]); }
}
__device__ __forceinline__ void pv(f32x16* o, LAS unsigned char* slot, const i32x8 pf, int r32, int hi) {
#pragma unroll
    for (int d0 = 0; d0 < 4; ++d0) { const int d = 32 * d0 + r32, sw = (d >> 2) & 3;
        const i32x8 b = ld32(slot + V_OFF + d * 64 + (((2 * hi) ^ sw) << 4), slot + V_OFF + d * 64 + (((2 * hi + 1) ^ sw) << 4));
        o[d0] = __builtin_amdgcn_mfma_scale_f32_32x32x64_f8f6f4(pf, b, o[d0], 0, 0, 0, SC_ONE, 0, SC_ONE); }
}
__device__ __forceinline__ int crow(int r, int hi) { return (r & 3) + 8 * (r >> 2) + 4 * hi; }
__device__ __forceinline__ void attn_unit(const unsigned char* __restrict__ Qb, const unsigned char* __restrict__ KNt, const unsigned char* __restrict__ KRt, const unsigned char* __restrict__ Vt,
                                          bf16_t* __restrict__ Ob, int NT, LAS unsigned char* lds) {
    const int tid = otid(), wid = __builtin_amdgcn_readfirstlane(tid >> 6), lane = tid & 63, r32 = lane & 31, hi = lane >> 5;
    LAS float* wsf = (LAS float*)(lds + 3 * SLOT) + wid * 64; LAS float* li_l = wsf; LAS float* al_l = wsf + 32;
    float m_reg = -1e30f, l_reg = 0; f32x16 o[4] = {}; i32x8 qf[3];
    const unsigned char* Qw = Qb + (size_t)(wid * 32 + r32) * 192 + 32 * hi;
#pragma unroll
    for (int ks = 0; ks < 3; ++ks) { const u32x4 x = *(const u32x4*)(Qw + 64 * ks), y = *(const u32x4*)(Qw + 64 * ks + 16); qf[ks] = (i32x8){(int)x.x, (int)x.y, (int)x.z, (int)x.w, (int)y.x, (int)y.y, (int)y.z, (int)y.w}; }
    const unsigned lo16 = (unsigned)lane * 16u;
#define ATT_DMA(tile, slotoff) do { const size_t t_ = (size_t)(tile); LAS unsigned char* sl_ = lds + (slotoff); \
        __builtin_amdgcn_global_load_lds((const unsigned*)(KNt + t_ * 8192 + wid * 1024 + lo16), (LAS unsigned*)(sl_ + KN_OFF + wid * 1024), 16, 0, 0); \
        __builtin_amdgcn_global_load_lds((const unsigned*)(Vt + t_ * 8192 + wid * 1024 + lo16), (LAS unsigned*)(sl_ + V_OFF + wid * 1024), 16, 0, 0); \
        if (wid < 4) __builtin_amdgcn_global_load_lds((const unsigned*)(KRt + t_ * 4096 + wid * 1024 + lo16), (LAS unsigned*)(sl_ + KR_OFF + wid * 1024), 16, 0, 0); } while (0)
#define ATT_SYNC() do { asm volatile("s_waitcnt vmcnt(0)" ::: "memory"); __builtin_amdgcn_s_barrier(); asm volatile("" ::: "memory"); } while (0)
#define RESC(a) do { if (__any((a) < 1.f)) { if (hi == 0) al_l[r32] = (a); asm volatile("s_waitcnt lgkmcnt(0)" ::: "memory"); \
        _Pragma("unroll") for (int d = 0; d < 4; ++d) _Pragma("unroll") for (int r = 0; r < 16; ++r) o[d][r] *= al_l[crow(r, hi)]; } } while (0)
    f32x16 pA0, pA1, pB0, pB1; float mnA, mnB, alA, alB; i32x8 pf;
    int sp = 0, sc = SLOT, sn = 2 * SLOT;
    ATT_DMA(0, 0);
    ATT_SYNC();
    ATT_DMA(1, SLOT);
    qkt(pA0, pA1, lds, qf, r32, hi); partialSM(pA0, pA1, m_reg, mnA, alA);
    for (int j = 1; j + 1 < NT; j += 2) {
        ATT_SYNC(); ATT_DMA(j + 1, sn);
        SBAR(); qkt(pB0, pB1, lds + sc, qf, r32, hi);
        finishSM(pA0, pA1, alA, l_reg, pf); SBAR();
        pv(o, lds + sp, pf, r32, hi); partialSM(pB0, pB1, m_reg, mnB, alB);
        RESC(alB);
        { const int t_ = sp; sp = sc; sc = sn; sn = t_; }
        ATT_SYNC(); if (j + 2 < NT) ATT_DMA(j + 2, sn);
        SBAR(); qkt(pA0, pA1, lds + sc, qf, r32, hi);
        finishSM(pB0, pB1, alB, l_reg, pf); SBAR();
        pv(o, lds + sp, pf, r32, hi); partialSM(pA0, pA1, m_reg, mnA, alA);
        RESC(alA);
        { const int t_ = sp; sp = sc; sc = sn; sn = t_; }
    }
    ATT_SYNC();
    SBAR(); qkt(pB0, pB1, lds + sc, qf, r32, hi);
    finishSM(pA0, pA1, alA, l_reg, pf); SBAR();
    pv(o, lds + sp, pf, r32, hi); partialSM(pB0, pB1, m_reg, mnB, alB);
    RESC(alB);
    finishSM(pB0, pB1, alB, l_reg, pf); SBAR();
    pv(o, lds + sc, pf, r32, hi);
    if (hi == 0) li_l[r32] = l_reg; asm volatile("s_waitcnt lgkmcnt(0)" ::: "memory");
    float rli[16];
#pragma unroll
    for (int r = 0; r < 16; ++r) rli[r] = __builtin_amdgcn_rcpf(li_l[crow(r, hi)]);
    bf16_t* Ow = Ob + (size_t)(wid * 32) * 2048;
#pragma unroll
    for (int r = 0; r < 16; ++r) { const int orow = crow(r, hi);
#pragma unroll
        for (int d0 = 0; d0 < 4; ++d0) Ow[(size_t)orow * 2048 + d0 * 32 + r32] = f2bf(o[d0][r] * rli[r]); }
    __builtin_amdgcn_s_barrier(); asm volatile("" ::: "memory");
#undef ATT_DMA
#undef ATT_SYNC
#undef RESC
}
}

namespace ssd {
constexpr int XT_OFF = 0, BT_OFF = 17408, HB_OFF = 52224, SET = 69632, CW_OFF = 2 * SET, LDS_BYTES = CW_OFF + 8 * 1536;
constexpr int PITCH = 272;
constexpr float L2E = 1.4426950408889634f;
__device__ __forceinline__ void g_unit(const bf16_t* __restrict__ BC, bf16_t* __restrict__ G, int unit) {
    const int cid = unit >> 1, g = unit & 1;
    const int r0 = cid < 256 ? cid * 128 : NLAT + (cid - 256) * 128;
    const int tid = otid(), wid = tid >> 6, lane = tid & 63, fr = lane & 15, fq = lane >> 4;
    const bf16_t* Cp = BC + (size_t)(r0 + 16 * wid + fr) * 512 + 256 + 128 * g + 8 * fq;
    bf16x8 cf[4];
#pragma unroll
    for (int ks = 0; ks < 4; ++ks) cf[ks] = *(const bf16x8*)(Cp + 32 * ks);
    bf16_t* Gp = G + ((size_t)unit * 128 + 16 * wid + fr) * 128 + 4 * fq;
#pragma unroll
    for (int sb = 0; sb < 8; ++sb) {
        const bf16_t* Bp = BC + (size_t)(r0 + 16 * sb + fr) * 512 + 128 * g + 8 * fq;
        f32x4 acc = {0.f, 0.f, 0.f, 0.f};
#pragma unroll
        for (int ks = 0; ks < 4; ++ks) { const bf16x8 bfr = *(const bf16x8*)(Bp + 32 * ks); acc = __builtin_amdgcn_mfma_f32_16x16x32_bf16(bfr, cf[ks], acc, 0, 0, 0); }
        u32x2 w; w.x = cvt_pk_bf16(acc[0], acc[1]); w.y = cvt_pk_bf16(acc[2], acc[3]);
        *(u32x2*)(Gp + 16 * sb) = w;
    }
}
__device__ __forceinline__ void ssd_unit(int b, int h, int d, const bf16_t* __restrict__ XS, const bf16_t* __restrict__ BC, const float* __restrict__ DT, const bf16_t* __restrict__ G,
                                         const float* __restrict__ a_log, bf16_t* __restrict__ Y, LAS unsigned char* lds) {
    const int g = h >> 3;
    const int tid = otid(), wid = tid >> 6, lane = tid & 63, fr = lane & 15, fq = lane >> 4;
    const float a = -__expf(a_log[d * 16 + h]);
    LAS float* cw = (LAS float*)(lds + CW_OFF + wid * 1536); LAS float* dts = cw + 128; LAS float* dtw = cw + 256;
    f32x4 hs[4];
#pragma unroll
    for (int q = 0; q < 4; ++q) hs[q] = (f32x4){0.f, 0.f, 0.f, 0.f};
    for (int i = tid; i < 17408 / 4; i += 512) ((LAS unsigned*)(lds + HB_OFF))[i] = 0u;
    float cend = 0.f;
#define SSD_ROWS(step, r0v, gidv) do { if ((step) < 2) { const int oc_ = d ? 1 - (step) : (step); r0v = NLAT + b * 256 + oc_ * 128; gidv = 256 + b * 2 + oc_; } \
        else { const int lc_ = (step) - 2, oc_ = d ? 63 - lc_ : lc_; r0v = b * 8192 + oc_ * 128; gidv = b * 64 + oc_; } } while (0)
    const int sg = tid & 31, n8 = tid >> 5, p4 = tid >> 5;
    f32x2 P_da, Q_da; u32x2 P_xv[4], Q_xv[4]; u32x4 P_bv[4], Q_bv[4], n_gv[4], n_cv[4], c_gv[4], c_cv[4];
#define SSD_LOAD(step, X) do { int r0_, gid_; SSD_ROWS(step, r0_, gid_); (void)gid_; X##_da = *(const f32x2*)(DT + (size_t)(d * 16 + h) * NROW + r0_ + 2 * lane); \
        _Pragma("unroll") for (int j_ = 0; j_ < 4; ++j_) { X##_xv[j_] = *(const u32x2*)(XS + (size_t)(r0_ + 4 * sg + j_) * 1024 + 64 * h + 4 * p4); \
                                                         X##_bv[j_] = *(const u32x4*)(BC + (size_t)(r0_ + 4 * sg + j_) * 512 + 128 * g + 8 * n8); } } while (0)
#define SSD_LOADGC(step) do { int r0_, gid_; SSD_ROWS(step, r0_, gid_); const int t_ = 16 * wid + fr; const bf16_t* Gp_ = G + ((size_t)(gid_ * 2 + g) * 128 + t_) * 128 + 8 * fq; const bf16_t* Cp_ = BC + (size_t)(r0_ + t_) * 512 + 256 + 128 * g + 8 * fq; \
          _Pragma("unroll") for (int ks_ = 0; ks_ < 4; ++ks_) { n_gv[ks_] = *(const u32x4*)(Gp_ + 32 * ks_); n_cv[ks_] = *(const u32x4*)(Cp_ + 32 * ks_); } } while (0)
#define SSD_GCROT() do { _Pragma("unroll") for (int ks_ = 0; ks_ < 4; ++ks_) { c_gv[ks_] = n_gv[ks_]; c_cv[ks_] = n_cv[ks_]; } } while (0)
#define SSD_WRITE(step, X) do { LAS unsigned char* set_ = lds + ((step) & 1) * SET; \
        const float da0 = X##_da.x * a, da1 = X##_da.y * a; \
        float sc_ = da0 + da1; float c0_, c1_; \
        if (d == 0) { _Pragma("unroll") for (int o_ = 1; o_ < 64; o_ <<= 1) { const float t_ = __shfl_up(sc_, o_); if (lane >= o_) sc_ += t_; } \
            c0_ = sc_ - da1; c1_ = sc_; cend = __shfl(sc_, 63); } \
        else { _Pragma("unroll") for (int o_ = 1; o_ < 64; o_ <<= 1) { const float t_ = __shfl_down(sc_, o_); if (lane + o_ < 64) sc_ += t_; } \
            c0_ = sc_; c1_ = sc_ - da0; cend = __shfl(sc_, 0); } \
        *(LAS f32x2*)(cw + 2 * lane) = (f32x2){c0_, c1_}; *(LAS f32x2*)(dts + 2 * lane) = X##_da; \
        *(LAS f32x2*)(dtw + 2 * lane) = (f32x2){X##_da.x * __builtin_amdgcn_exp2f((cend - c0_) * L2E), X##_da.y * __builtin_amdgcn_exp2f((cend - c1_) * L2E)}; \
        { LAS unsigned char* xt_ = set_ + XT_OFF + (4 * p4) * PITCH + 8 * sg; \
          _Pragma("unroll") for (int i_ = 0; i_ < 4; ++i_) { unsigned e_[4]; \
              _Pragma("unroll") for (int j_ = 0; j_ < 4; ++j_) { const unsigned w_ = (i_ & 2) ? X##_xv[j_].y : X##_xv[j_].x; e_[j_] = (i_ & 1) ? (w_ >> 16) : (w_ & 0xffffu); } \
              u32x2 o_; o_.x = e_[0] | (e_[1] << 16); o_.y = e_[2] | (e_[3] << 16); *(LAS u32x2*)(xt_ + i_ * PITCH) = o_; } } \
        { LAS unsigned char* bt_ = set_ + BT_OFF + (8 * n8) * PITCH + 8 * sg; \
          _Pragma("unroll") for (int i_ = 0; i_ < 8; ++i_) { unsigned e_[4]; \
              _Pragma("unroll") for (int j_ = 0; j_ < 4; ++j_) { const unsigned w_ = X##_bv[j_][i_ >> 1]; e_[j_] = (i_ & 1) ? (w_ >> 16) : (w_ & 0xffffu); } \
              u32x2 o_; o_.x = e_[0] | (e_[1] << 16); o_.y = e_[2] | (e_[3] << 16); *(LAS u32x2*)(bt_ + i_ * PITCH) = o_; } } \
        asm volatile("s_waitcnt lgkmcnt(0)" ::: "memory"); \
    } while (0)
    SSD_LOAD(0, Q); SSD_LOADGC(0); SSD_WRITE(0, Q); SSD_LOAD(1, P);
    for (int step2 = 0; step2 < 66; step2 += 2)
#pragma unroll
    for (int par = 0; par < 2; ++par) {
        const int step = step2 + par;
        __syncthreads();
        int r0, gid; SSD_ROWS(step, r0, gid); (void)gid;
        LAS unsigned char* set = lds + (step & 1) * SET;
        const float cend_cur = cend;
        SSD_GCROT();
        if (step + 1 < 66) SSD_LOADGC(step + 1);
        if (step + 2 < 66) { if (par == 0) SSD_LOAD(step + 2, Q); else SSD_LOAD(step + 2, P); }
        {
            const int t = 16 * wid + fr; const float ct = cw[t];
            f32x4 y[4];
#pragma unroll
            for (int q = 0; q < 4; ++q) y[q] = (f32x4){0.f, 0.f, 0.f, 0.f};
            const float et = __builtin_amdgcn_exp2f(ct * L2E);
#pragma unroll
            for (int ks = 0; ks < 4; ++ks) {
                const bool live = d == 0 ? (32 * ks <= 16 * wid + 15) : (32 * ks + 31 >= 16 * wid);
                if (live) {
                    const int s0 = 32 * ks + 8 * fq;
                    const f32x4 c0 = *(const LAS f32x4*)(cw + s0), c1 = *(const LAS f32x4*)(cw + s0 + 4), d0v = *(const LAS f32x4*)(dts + s0), d1v = *(const LAS f32x4*)(dts + s0 + 4);
                    float m[8];
#pragma unroll
                    for (int i = 0; i < 8; ++i) { const float cs = i < 4 ? c0[i & 3] : c1[i & 3], dv = i < 4 ? d0v[i & 3] : d1v[i & 3]; const int s = s0 + i;
                        const bool ok = d == 0 ? (s <= t) : (s >= t);
                        const float gval = (i & 1) ? bfhi(c_gv[ks][i >> 1]) : bflo(c_gv[ks][i >> 1]);
                        m[i] = ok ? gval * dv * __builtin_amdgcn_exp2f((ct - cs) * L2E) : 0.f; }
                    u32x4 mw; mw.x = cvt_pk_bf16(m[0], m[1]); mw.y = cvt_pk_bf16(m[2], m[3]); mw.z = cvt_pk_bf16(m[4], m[5]); mw.w = cvt_pk_bf16(m[6], m[7]);
                    const bf16x8 mb = __builtin_bit_cast(bf16x8, mw);
#pragma unroll
                    for (int q = 0; q < 4; ++q) { const bf16x8 af = *(const LAS bf16x8*)(set + XT_OFF + (16 * q + fr) * PITCH + (32 * ks + 8 * fq) * 2);
                        y[q] = __builtin_amdgcn_mfma_f32_16x16x32_bf16(af, mb, y[q], 0, 0, 0); }
                }
            }
#pragma unroll
            for (int ks = 0; ks < 4; ++ks) {
                u32x4 cwv;
#pragma unroll
                for (int i = 0; i < 4; ++i) cwv[i] = cvt_pk_bf16(bflo(c_cv[ks][i]) * et, bfhi(c_cv[ks][i]) * et);
                const bf16x8 cb = __builtin_bit_cast(bf16x8, cwv);
#pragma unroll
                for (int q = 0; q < 4; ++q) { const bf16x8 af = *(const LAS bf16x8*)(set + HB_OFF + (16 * q + fr) * PITCH + (32 * ks + 8 * fq) * 2);
                    y[q] = __builtin_amdgcn_mfma_f32_16x16x32_bf16(af, cb, y[q], 0, 0, 0); }
            }
            bf16_t* yp = Y + (size_t)(r0 + t) * 1024 + 64 * h + 4 * fq;
#pragma unroll
            for (int q = 0; q < 4; ++q) { u32x2 w; w.x = cvt_pk_bf16(y[q][0], y[q][1]); w.y = cvt_pk_bf16(y[q][2], y[q][3]); *(u32x2*)(yp + 16 * q) = w; }
        }
        {
            const float dec = __builtin_amdgcn_exp2f(cend_cur * L2E);
#pragma unroll
            for (int q = 0; q < 4; ++q) hs[q] = hs[q] * dec;
#pragma unroll
            for (int ks = 0; ks < 4; ++ks) {
                const int s0 = 32 * ks + 8 * fq;
                const u32x4 braw = *(const LAS u32x4*)(set + BT_OFF + (16 * wid + fr) * PITCH + s0 * 2);
                const f32x4 w0 = *(const LAS f32x4*)(dtw + s0), w1 = *(const LAS f32x4*)(dtw + s0 + 4);
                u32x4 bw; bw.x = cvt_pk_bf16(bflo(braw.x) * w0[0], bfhi(braw.x) * w0[1]); bw.y = cvt_pk_bf16(bflo(braw.y) * w0[2], bfhi(braw.y) * w0[3]);
                          bw.z = cvt_pk_bf16(bflo(braw.z) * w1[0], bfhi(braw.z) * w1[1]); bw.w = cvt_pk_bf16(bflo(braw.w) * w1[2], bfhi(braw.w) * w1[3]);
                const bf16x8 bfr = __builtin_bit_cast(bf16x8, bw);
#pragma unroll
                for (int q = 0; q < 4; ++q) { const bf16x8 af = *(const LAS bf16x8*)(set + XT_OFF + (16 * q + fr) * PITCH + s0 * 2);
                    hs[q] = __builtin_amdgcn_mfma_f32_16x16x32_bf16(af, bfr, hs[q], 0, 0, 0); }
            }
            LAS bf16_t* hb = (LAS bf16_t*)(lds + ((step + 1) & 1) * SET + HB_OFF) + 16 * wid + fr;
#pragma unroll
            for (int q = 0; q < 4; ++q)
#pragma unroll
                for (int i = 0; i < 4; ++i) hb[(16 * q + 4 * fq + i) * 136] = f2bf(hs[q][i]);
        }
        if (step + 1 < 66) { if (par == 0) SSD_WRITE(step + 1, P); else SSD_WRITE(step + 1, Q); }
    }
    __syncthreads();
#undef SSD_ROWS
#undef SSD_LOAD
#undef SSD_LOADGC
#undef SSD_GCROT
#undef SSD_WRITE
}
}

struct Args { const float* in[32]; float* out; unsigned char* ws; int ph_lo, ph_hi; };
constexpr int NTHR = 512;
constexpr int LDS_BASE = 256;
constexpr int LDS_PHASE = 151808;
constexpr int LDS_BYTES = LDS_BASE + LDS_PHASE;
static_assert(att8::LDS_BYTES <= LDS_PHASE && ssd::LDS_BYTES <= LDS_PHASE && pg8::STAGE_BYTES <= LDS_PHASE, "LDS");

__device__ __forceinline__ void tjob(int j, const Args& A, const float*& src, bf16_t*& dst, int& K, int& N, int& Npad, int& mode, const float*& ks) {
    unsigned char* W = A.ws + WS_W; mode = 0; ks = nullptr;
    if (j < 8) { const int i = j >> 2, w = j & 3; unsigned char* base = W + W_HYB + (size_t)i * WH_SZ;
        if (w == 0)      { src = A.in[I_HWIN] + (size_t)i * 1024 * HYB_IN; dst = (bf16_t*)(base + WH_IN); K = 1024; N = HYB_IN; Npad = HYB_INP; mode = 1; }
        else if (w == 1) { src = A.in[I_WQB] + (size_t)i * 384 * 1536; dst = (bf16_t*)(base + WH_QB); K = 384; N = 1536; Npad = 1536; mode = 2; ks = A.in[I_QNG] + i * 384; }
        else if (w == 2) { src = A.in[I_WKVB] + (size_t)i * 256 * 2048; dst = (bf16_t*)(base + WH_KVB); K = 256; N = 2048; Npad = 2048; ks = A.in[I_KVNG] + i * 256; }
        else             { src = A.in[I_HWOUT] + (size_t)i * 2048 * 1024; dst = (bf16_t*)(base + WH_OUT); K = 2048; N = 1024; Npad = 1024; }
    } else if (j < 12) { const int i = (j - 8) >> 1, w = (j - 8) & 1; unsigned char* base = W + W_GM + (size_t)i * WG_SZ;
        if (w == 0) { src = A.in[I_GWIN] + (size_t)i * 1024 * 4096; dst = (bf16_t*)(base + WG_IN); K = 1024; N = 4096; Npad = 4096; }
        else        { src = A.in[I_GWOUT] + (size_t)i * 2048 * 1024; dst = (bf16_t*)(base + WG_OUT); K = 2048; N = 1024; Npad = 1024; }
    } else { const int l = j - 12; src = A.in[I_PWQ] + (size_t)l * 1024 * 2048; dst = (bf16_t*)(W + W_PEER + (size_t)l * WP_SZ + WP_Q); K = 1024; N = 2048; Npad = 2048; }
}
__device__ __forceinline__ int colmap(int mode, int n, int N) {
    if (mode == 1) { if (n >= N) return -1; if (n < C_KR) return n; const int m = n - C_KR; return C_KR + (m >> 1) + 32 * (m & 1); }
    if (mode == 2) { if (n < 1024) return (n >> 7) * 192 + (n & 127); const int m = n - 1024, h = m >> 6, mm = m & 63; return h * 192 + 128 + (mm >> 1) + 32 * (mm & 1); }
    return n;
}
__device__ __forceinline__ void phase_prologue(const Args& A, LAS unsigned char* lds) {
    const int tid = otid();
    {
        LAS float* tile = (LAS float*)lds;
        const float* c_src = nullptr; bf16_t* c_dst = nullptr; const float* c_ks = nullptr; int c_K = 0, c_N = 0, c_mode = 0, c_nsub = 0, c_k0 = 0, c_n0 = 0;
        int j = 0, item = blockIdx.x; bool have = false;
#define TR_LOCATE() do { have = false; \
            while (j < 16) { int Npad_; tjob(j, A, c_src, c_dst, c_K, c_N, Npad_, c_mode, c_ks); \
                c_nsub = (c_K % 256 == 0) ? 4 : 2; const int tk_ = c_K / (64 * c_nsub), nt_ = tk_ * (Npad_ / 64); \
                if (item < nt_) { c_k0 = (item % tk_) * 64 * c_nsub; c_n0 = (item / tk_) * 64; have = true; break; } \
                item -= nt_; ++j; } } while (0)
        float v[4][8], scv[4];
#define TR_LOAD() do { const int k = tid >> 3, cg = tid & 7; \
            _Pragma("unroll") for (int t = 0; t < 4; ++t) if (t < c_nsub) { scv[t] = c_ks ? c_ks[c_k0 + 64 * t + k] : 1.f; \
                _Pragma("unroll") for (int jj = 0; jj < 8; ++jj) { const int oc = colmap(c_mode, c_n0 + 8 * cg + jj, c_N); v[t][jj] = oc >= 0 ? c_src[(size_t)(c_k0 + 64 * t + k) * c_N + oc] : 0.f; } } } while (0)
        TR_LOCATE();
        if (have) TR_LOAD();
        int buf = 0;
        while (have) {
            const int nsub = c_nsub, K = c_K, k0 = c_k0, n0 = c_n0; bf16_t* dst = c_dst;
            { const int k = tid >> 3, cg = tid & 7;
#pragma unroll
              for (int t = 0; t < 4; ++t) if (t < nsub) {
#pragma unroll
                  for (int jj = 0; jj < 8; ++jj) tile[buf * 16640 + t * 4160 + k * 65 + 8 * cg + jj] = v[t][jj] * scv[t]; } }
            item += gridDim.x; TR_LOCATE();
            if (have) TR_LOAD();
            __syncthreads();
            { const int n = tid >> 3, kg = tid & 7;
#pragma unroll
              for (int t = 0; t < 4; ++t) if (t < nsub) { float o[8];
#pragma unroll
                  for (int jj = 0; jj < 8; ++jj) o[jj] = tile[buf * 16640 + t * 4160 + (8 * kg + jj) * 65 + n];
                  u32x4 w; w.x = cvt_pk_bf16(o[0], o[1]); w.y = cvt_pk_bf16(o[2], o[3]); w.z = cvt_pk_bf16(o[4], o[5]); w.w = cvt_pk_bf16(o[6], o[7]);
                  *(u32x4*)(dst + (size_t)(n0 + n) * K + k0 + 64 * t + 8 * kg) = w; } }
            buf ^= 1;
        }
#undef TR_LOCATE
#undef TR_LOAD
    }
    {
        const int gthr = blockIdx.x * NTHR + tid, nthr = gridDim.x * NTHR;
        for (int p = gthr; p < 10 * 16384; p += nthr) {
            const int mat = p >> 14, off = (p & 16383) * 8; const float* src; bf16_t* dst;
            if (mat < 2)      { src = A.in[I_GWS] + (size_t)mat * 131072; dst = (bf16_t*)(A.ws + WS_W + W_GM + (size_t)mat * WG_SZ + WG_WS); }
            else if (mat < 6) { src = A.in[I_PK1] + (size_t)(mat - 2) * 131072; dst = (bf16_t*)(A.ws + WS_W + W_PEER + (size_t)(mat - 2) * WP_SZ + WP_K1); }
            else              { src = A.in[I_PK2] + (size_t)(mat - 6) * 131072; dst = (bf16_t*)(A.ws + WS_W + W_PEER + (size_t)(mat - 6) * WP_SZ + WP_K2); }
            const f32x4 a = *(const f32x4*)(src + off), b = *(const f32x4*)(src + off + 4);
            u32x4 w; w.x = cvt_pk_bf16(a[0], a[1]); w.y = cvt_pk_bf16(a[2], a[3]); w.z = cvt_pk_bf16(b[0], b[1]); w.w = cvt_pk_bf16(b[2], b[3]);
            *(u32x4*)(dst + off) = w;
        }
        float* rope = (float*)(A.ws + WS_ROPE);
        for (int p = gthr; p < SEQ * 32; p += nthr) { const int l = p >> 5, i = p & 31; const float pos = (float)(i < 16 ? (l >> 6) : (l & 63));
            const float inv = powf(10000.f, -(float)(i & 15) / 16.f), ang = pos * inv; rope[p] = cosf(ang); rope[SEQ * 32 + p] = sinf(ang); }
    }
    {
        LAS float* scond = (LAS float*)lds;
        LAS float* red = scond + 5 * 1024;
        __syncthreads();
        for (int i = tid; i < 5 * 1024; i += NTHR) { const int m = i >> 10, k = i & 1023; const float c = m < 4 ? A.in[I_C][m * 1024 + k] : A.in[I_CCTX][k]; scond[i] = silu_f(c); }
        __syncthreads();
        float* MOD = (float*)(A.ws + WS_MOD);
        for (int item = blockIdx.x; item < 4 * 48; item += gridDim.x) {
            const int layer = item / 48, j0 = (item % 48) * 128; const int c4 = tid & 31, ksl = tid >> 5;
            f32x4 acc[5];
#pragma unroll
            for (int m = 0; m < 5; ++m) acc[m] = (f32x4){0.f, 0.f, 0.f, 0.f};
            const float* wp = A.in[I_ADAW] + ((size_t)layer * 1024 + ksl * 64) * 6144 + j0 + 4 * c4;
#pragma unroll 1
            for (int k0 = 0; k0 < 64; k0 += 16) { f32x4 w[16];
#pragma unroll
                for (int k = 0; k < 16; ++k) w[k] = *(const f32x4*)(wp + (size_t)(k0 + k) * 6144);
#pragma unroll
                for (int k = 0; k < 16; ++k)
#pragma unroll
                    for (int m = 0; m < 5; ++m) acc[m] += w[k] * scond[m * 1024 + ksl * 64 + k0 + k]; }
#pragma unroll
            for (int m = 0; m < 5; ++m) *(LAS f32x4*)(red + (ksl * 5 + m) * 128 + 4 * c4) = acc[m];
            __syncthreads();
            for (int i = tid; i < 640; i += NTHR) { const int m = i >> 7, c = i & 127; float s = A.in[I_ADAB][layer * 6144 + j0 + c];
#pragma unroll
                for (int q = 0; q < 16; ++q) s += red[(q * 5 + m) * 128 + c];
                MOD[((size_t)layer * 5 + m) * 6144 + j0 + c] = s; }
            __syncthreads();
        }
    }
}

template <bool F32SRC>
__device__ __forceinline__ void phase_norm_mod(const float* xl, const float* xc, bf16_t* XB, const float* g, const float* modl, int sh_idx, bf16_t* H, int nrows) {
    const int tid_ = otid(); const int lane = tid_ & 63, gw = blockIdx.x * 8 + (tid_ >> 6), nw = gridDim.x * 8;
    f32x4 gv[4];
#pragma unroll
    for (int i = 0; i < 4; ++i) gv[i] = *(const f32x4*)(g + 256 * i + 4 * lane);
    for (int r = gw; r < nrows; r += nw) {
        const bool lat = r < NLAT;
        f32x4 x[4]; float ss = 0.f;
        if (F32SRC) { const float* xp = lat ? xl + (size_t)r * D : xc + (size_t)(r - NLAT) * D;
#pragma unroll
            for (int i = 0; i < 4; ++i) { x[i] = *(const f32x4*)(xp + 256 * i + 4 * lane);
                u32x2 w; w.x = cvt_pk_bf16(x[i][0], x[i][1]); w.y = cvt_pk_bf16(x[i][2], x[i][3]); *(u32x2*)(XB + (size_t)r * D + 256 * i + 4 * lane) = w;
 }
        } else {
#pragma unroll
            for (int i = 0; i < 4; ++i) { const u32x2 w = *(const u32x2*)(XB + (size_t)r * D + 256 * i + 4 * lane); x[i] = (f32x4){bflo(w.x), bfhi(w.x), bflo(w.y), bfhi(w.y)}; } }
#pragma unroll
        for (int i = 0; i < 4; ++i) ss += x[i][0] * x[i][0] + x[i][1] * x[i][1] + x[i][2] * x[i][2] + x[i][3] * x[i][3];
        ss = wave_sum(ss); const float rstd = rsqrtf(ss * (1.f / 1024.f) + EPS);
        const float* mp = modl + (size_t)(lat ? (r >> 13) : 4) * 6144 + sh_idx * 1024;
#pragma unroll
        for (int i = 0; i < 4; ++i) { const f32x4 sh = *(const f32x4*)(mp + 256 * i + 4 * lane), sc = *(const f32x4*)(mp + 1024 + 256 * i + 4 * lane);
            const f32x4 hv = (x[i] * rstd) * gv[i] * (sc + 1.f) + sh;
            u32x2 w; w.x = cvt_pk_bf16(hv[0], hv[1]); w.y = cvt_pk_bf16(hv[2], hv[3]);
            *(u32x2*)(H + (size_t)r * D + 256 * i + 4 * lane) = w; }
    }
}
__device__ __forceinline__ void phase_final_norm(const bf16_t* XB, float* out, const float* g, float oscale) {
    const int tid_ = otid(); const int lane = tid_ & 63, gw = blockIdx.x * 8 + (tid_ >> 6), nw = gridDim.x * 8;
    f32x4 gv[4];
#pragma unroll
    for (int i = 0; i < 4; ++i) gv[i] = *(const f32x4*)(g + 256 * i + 4 * lane);
    for (int r = gw; r < NLAT; r += nw) {
        f32x4 x[4]; float ss = 0.f;
#pragma unroll
        for (int i = 0; i < 4; ++i) { const u32x2 w = *(const u32x2*)(XB + (size_t)r * D + 256 * i + 4 * lane); x[i] = (f32x4){bflo(w.x), bfhi(w.x), bflo(w.y), bfhi(w.y)};
            ss += x[i][0] * x[i][0] + x[i][1] * x[i][1] + x[i][2] * x[i][2] + x[i][3] * x[i][3]; }
        ss = wave_sum(ss); const float rstd = rsqrtf(ss * (1.f / 1024.f) + EPS);
#pragma unroll
        for (int i = 0; i < 4; ++i) *(f32x4*)(out + (size_t)r * D + 256 * i + 4 * lane) = (x[i] * (rstd * oscale)) * gv[i];
    }
}

#ifndef MK_CVAR
#define MK_CVAR 0
#endif
__device__ __forceinline__ void phase_conv(const Args& A, int li, int rep = 0) {
    const int cvar = rep ? MK_CVAR : 0;
    const bf16_t* PROJ = (const bf16_t*)(A.ws + WS_BIG);
    bf16_t* XS = (bf16_t*)(A.ws + WS_R2); bf16_t* BC = (bf16_t*)(A.ws + WS_R2 + R2_BC);
    const int tid = otid();
    if (cvar != 2) {
        for (int item = blockIdx.x * 3; item < (NROW / 64) * 3; item += gridDim.x * 3)
#pragma unroll 1
        for (int sub = 0; sub < 3; ++sub) {
            const int blk = (item + sub) / 3, q = ((item + sub) % 3) * 512 + tid, cg = q % 192, rg = q / 192, c0 = 8 * cg;
            const int rbeg = blk * 64 + rg * 8; int s0, s1;
            if (rbeg < NLAT) { s0 = rbeg & ~8191; s1 = s0 + 8192; } else { s0 = NLAT + ((rbeg - NLAT) & ~255); s1 = s0 + 256; }
            const float* cw = A.in[I_CONVW] + ((size_t)li * 1536 + c0) * 5; const float* cb = A.in[I_CONVB] + (size_t)li * 1536 + c0;
            u32x4 in[12];
#pragma unroll
            for (int i = 0; i < 12; ++i) { const int r = rbeg - 2 + i; in[i] = (r >= s0 && r < s1) ? *(const u32x4*)(PROJ + (size_t)r * HYB_INP + C_XBC + c0) : (u32x4){0u, 0u, 0u, 0u}; }
            float w[8][5], bia[8];
#pragma unroll
            for (int j = 0; j < 8; ++j) { bia[j] = cb[j];
#pragma unroll
                for (int k = 0; k < 5; ++k) w[j][k] = cw[j * 5 + k]; }
#pragma unroll
            for (int rr = 0; rr < 8; ++rr) {
                float o[8];
#pragma unroll
                for (int j = 0; j < 8; ++j) { float sacc = bia[j];
#pragma unroll
                    for (int k = 0; k < 5; ++k) { const unsigned wd = in[rr + k][j >> 1]; sacc += w[j][k] * ((j & 1) ? bfhi(wd) : bflo(wd)); }
                    o[j] = silu_f(sacc); }
                u32x4 pk; pk.x = cvt_pk_bf16(o[0], o[1]); pk.y = cvt_pk_bf16(o[2], o[3]); pk.z = cvt_pk_bf16(o[4], o[5]); pk.w = cvt_pk_bf16(o[6], o[7]);
                const int r = rbeg + rr;
                if (c0 < 1024) *(u32x4*)(XS + (size_t)r * 1024 + c0) = pk; else *(u32x4*)(BC + (size_t)r * 512 + (c0 - 1024)) = pk;
            }
        }
    }
    if (cvar != 1) {
        const int lane = tid & 63, gw = blockIdx.x * 8 + (tid >> 6), nw = gridDim.x * 8;
        float* DT = (float*)(A.ws + WS_BIG + BIG_DT); float* RQ = (float*)(A.ws + WS_RSTD); float* RKV = RQ + NROW;
        unsigned char* KR = A.ws + WS_BIG + BIG_KR; const float* rope = (const float*)(A.ws + WS_ROPE);
        const float dtb = lane < 32 ? A.in[I_DTB][li * 32 + lane] : 0.f;
        for (int rb = gw * 4; rb < NROW; rb += nw * 4) {
            unsigned wq[4][3]; u32x2 wk[4]; unsigned wr_[4]; float dtv[4], rc[4], rsn[4];
#pragma unroll
            for (int i = 0; i < 4; ++i) { const int r = rb + i; const bf16_t* p = PROJ + (size_t)r * HYB_INP;
                const unsigned* q = (const unsigned*)(p + C_CQ + 6 * lane); wq[i][0] = q[0]; wq[i][1] = q[1]; wq[i][2] = q[2];
                wk[i] = *(const u32x2*)(p + C_CKV + 4 * lane);
                dtv[i] = lane < 32 ? bf2f(p[C_DT + (lane & 15)]) : 0.f; wr_[i] = lane < 32 ? *(const unsigned*)(p + C_KR + 2 * lane) : 0u;
                const int l = r & 8191; rc[i] = (lane < 32 && r < NLAT) ? rope[l * 32 + lane] : 1.f; rsn[i] = (lane < 32 && r < NLAT) ? rope[SEQ * 32 + l * 32 + lane] : 0.f; }
#pragma unroll
            for (int i = 0; i < 4; ++i) { const int r = rb + i;
                if (lane < 32) DT[(size_t)lane * NROW + r] = softplus_f(dtv[i] + dtb);
                { float ss = 0.f;
#pragma unroll
                  for (int j = 0; j < 3; ++j) { const float a = bflo(wq[i][j]), b = bfhi(wq[i][j]); ss += a * a + b * b; }
                  ss = wave_sum(ss); if (lane == 0) RQ[r] = rsqrtf(ss * (1.f / 384.f) + EPS); }
                { const float a = bflo(wk[i].x), b = bfhi(wk[i].x), c = bflo(wk[i].y), d = bfhi(wk[i].y);
                  float ss = a * a + b * b + c * c + d * d; ss = wave_sum(ss); if (lane == 0) RKV[r] = rsqrtf(ss * (1.f / 256.f) + EPS); }
                if (lane < 32) { const float x1 = bflo(wr_[i]), x2 = bfhi(wr_[i]); int b, key;
                    const float o1 = x1 * rc[i] - x2 * rsn[i], o2 = x1 * rsn[i] + x2 * rc[i];
                    if (r < NLAT) { b = r >> 13; key = 256 + (r & 8191); } else { b = (r - NLAT) >> 8; key = (r - NLAT) & 255; }
                    int w8 = 0; w8 = __builtin_amdgcn_cvt_pk_fp8_f32(sat8(o1), sat8(o2), w8, false);
                    *(unsigned short*)(KR + (size_t)(b * NKT + (key >> 6)) * 4096 + att8::kr8(key & 63, 2 * lane)) = (unsigned short)(w8 & 0xffff); }
            }
        }
    }
}

struct EpiQ {
    static constexpr bool PERM = true;
    unsigned char* Q; const float* rstd; const float* rope;
    __device__ __forceinline__ void operator()(const f32x4 (&acc)[2][2][4][2], const pg8::Unit& u, int wr, int wc, int fr, int fq) const {
        const bool lat = u.pm < 128;
        const int b = lat ? (u.pm >> 5) : (u.pm - 128), q0 = lat ? 256 + ((u.pm & 31) << 8) : 0;
        const bool isrope = u.pn >= 4;
#pragma unroll
        for (int ai = 0; ai < 2; ++ai) {
            const int rl = 128 * ai + 64 * wr + fr;
            const float* rsp = rstd + u.pm * 256 + rl;
            const float* rp = rope + (size_t)(((u.pm & 31) << 8) + rl) * 32;
#pragma unroll
            for (int bj = 0; bj < 2; ++bj) {
                const int c0 = u.pn * 256 + 128 * bj + 32 * wc + 8 * fq; int h, dcol;
                if (!isrope) { h = c0 >> 7; dcol = c0 & 127; } else { const int mq = c0 - 1024; h = mq >> 6; dcol = 128 + (mq & 63); }
                unsigned char* dst = Q + ((size_t)(b * 8 + h) * NKEY + q0 + rl) * 192 + dcol;
                const int ro = (dcol - 128) >> 1;
#pragma unroll
                for (int m = 0; m < 4; ++m) {
                    const float rs = rsp[16 * m] * (QSCALE * att8::QUP);
                    f32x4 v0 = acc[ai][bj][m][0] * rs, v1 = acc[ai][bj][m][1] * rs;
                    if (isrope && lat) { const f32x4 cs = *(const f32x4*)(rp + 16 * m * 32 + ro), sn = *(const f32x4*)(rp + SEQ * 32 + 16 * m * 32 + ro);
                        const f32x4 a0 = v0, a1 = v1;
                        v0[0] = a0[0] * cs[0] - a0[1] * sn[0]; v0[1] = a0[0] * sn[0] + a0[1] * cs[0]; v0[2] = a0[2] * cs[1] - a0[3] * sn[1]; v0[3] = a0[2] * sn[1] + a0[3] * cs[1];
                        v1[0] = a1[0] * cs[2] - a1[1] * sn[2]; v1[1] = a1[0] * sn[2] + a1[1] * cs[2]; v1[2] = a1[2] * cs[3] - a1[3] * sn[3]; v1[3] = a1[2] * sn[3] + a1[3] * cs[3]; }
                    u32x2 w; w.x = pk4_fp8_sat(v0[0], v0[1], v0[2], v0[3]); w.y = pk4_fp8_sat(v1[0], v1[1], v1[2], v1[3]);
                    *(u32x2*)(dst + 16 * m * 192) = w;
                    asm volatile("" ::: "memory");
                }
            }
        }
    }
};
struct EpiKV {
    static constexpr bool PERM = true;
    unsigned char* KN; unsigned char* V; const float* rstd;
    __device__ __forceinline__ void operator()(const f32x4 (&acc)[2][2][4][2], const pg8::Unit& u, int wr, int wc, int fr, int fq) const {
        const bool lat = u.pm < 128;
        const int b = lat ? (u.pm >> 5) : (u.pm - 128), t0 = lat ? 4 + ((u.pm & 31) << 2) : 0;
        const int dd = 32 * wc + 8 * fq;
        const int offK = fr * 128 + ((((dd >> 4) ^ ((fr >> 1) & 7))) << 4) + (dd & 15);
#pragma unroll
        for (int ai = 0; ai < 2; ++ai) {
            const size_t tb = ((size_t)(b * 8 + u.pn) * NKT + t0 + 2 * ai + wr) * 8192;
            const float* rsp = rstd + u.pm * 256 + 128 * ai + 64 * wr + fr;
            unsigned char* kp = KN + tb + offK; unsigned char* vp = V + tb;
#pragma unroll
            for (int m = 0; m < 4; ++m) {
                const float rs = rsp[16 * m];
                { const f32x4 v0 = acc[ai][0][m][0] * rs, v1 = acc[ai][0][m][1] * rs; u32x2 w; w.x = pk4_fp8_sat(v0[0], v0[1], v0[2], v0[3]); w.y = pk4_fp8_sat(v1[0], v1[1], v1[2], v1[3]);
                  *(u32x2*)(kp + m * 2048) = w; }
                { const f32x4 v0 = acc[ai][1][m][0] * rs, v1 = acc[ai][1][m][1] * rs; const unsigned w0 = pk4_fp8_sat(v0[0], v0[1], v0[2], v0[3]), w1 = pk4_fp8_sat(v1[0], v1[1], v1[2], v1[3]);
                  const int sl = att8::vslot(16 * m + fr);
#pragma unroll
                  for (int i = 0; i < 8; ++i) { const int d = dd + i; vp[d * 64 + ((((sl >> 4) ^ ((d >> 2) & 3))) << 4) + (sl & 15)] = (unsigned char)(((i < 4 ? w0 : w1) >> (8 * (i & 3))) & 0xffu); } }
                asm volatile("" ::: "memory");
            }
        }
    }
};

__device__ __forceinline__ void phase_ssd_out(const Args& A, int li, int nrows) {
    const bf16_t* PROJ = (const bf16_t*)(A.ws + WS_BIG); const bf16_t* XS = (const bf16_t*)(A.ws + WS_R2);
    const bf16_t* Y0 = (const bf16_t*)(A.ws + WS_H); const bf16_t* Y1 = (const bf16_t*)(A.ws + WS_R3); bf16_t* CAT = (bf16_t*)(A.ws + WS_R3 + R3_CAT);
    const int tid_ = otid(); const int lane = tid_ & 63, gw = blockIdx.x * 8 + (tid_ >> 6), nw = gridDim.x * 8;
    const float dsk = A.in[I_SSDD][li * 16 + (lane >> 2)];
    float ng[16];
#pragma unroll
    for (int j = 0; j < 16; ++j) ng[j] = A.in[I_SSDNG][li * 1024 + 16 * lane + j];
    for (int r = gw; r < nrows; r += nw) {
        float v[16]; float ss = 0.f;
#pragma unroll
        for (int hh = 0; hh < 2; ++hh) {
            const u32x4 a = *(const u32x4*)(Y0 + (size_t)r * 1024 + 16 * lane + 8 * hh), b = *(const u32x4*)(Y1 + (size_t)r * 1024 + 16 * lane + 8 * hh);
            const u32x4 x = *(const u32x4*)(XS + (size_t)r * 1024 + 16 * lane + 8 * hh), z = *(const u32x4*)(PROJ + (size_t)r * HYB_INP + 16 * lane + 8 * hh);
#pragma unroll
            for (int q = 0; q < 4; ++q) {
                const float y0 = (bflo(a[q]) + bflo(b[q]) + dsk * bflo(x[q])) * silu_f(bflo(z[q])), y1 = (bfhi(a[q]) + bfhi(b[q]) + dsk * bfhi(x[q])) * silu_f(bfhi(z[q]));
                v[8 * hh + 2 * q] = y0; v[8 * hh + 2 * q + 1] = y1; ss += y0 * y0 + y1 * y1; }
        }
#pragma unroll
        for (int o = 16; o >= 1; o >>= 1) ss += __shfl_xor(ss, o);
        const float rstd = rsqrtf(ss * (1.f / 512.f) + EPS);
#pragma unroll
        for (int hh = 0; hh < 2; ++hh) { u32x4 w;
#pragma unroll
            for (int q = 0; q < 4; ++q) w[q] = cvt_pk_bf16(v[8 * hh + 2 * q] * rstd * ng[8 * hh + 2 * q], v[8 * hh + 2 * q + 1] * rstd * ng[8 * hh + 2 * q + 1]);
            *(u32x4*)(CAT + (size_t)r * 2048 + 16 * lane + 8 * hh) = w; }
    }
}

__device__ __forceinline__ void phase_ln_stats(const Args& A, int nrows) {
    const bf16_t* Gb = (const bf16_t*)(A.ws + WS_BIG); float* ST = (float*)(A.ws + WS_RSTD);
    const int tid_ = otid(); const int lane = tid_ & 63, gw = blockIdx.x * 8 + (tid_ >> 6), nw = gridDim.x * 8;
    for (int r = gw; r < nrows; r += nw) {
        float v[32]; float s = 0.f;
#pragma unroll
        for (int j = 0; j < 4; ++j) { const u32x4 w = *(const u32x4*)(Gb + (size_t)r * 4096 + 2048 + 512 * j + 8 * lane);
#pragma unroll
            for (int q = 0; q < 4; ++q) { v[8 * j + 2 * q] = bflo(w[q]); v[8 * j + 2 * q + 1] = bfhi(w[q]); s += v[8 * j + 2 * q] + v[8 * j + 2 * q + 1]; } }
        s = wave_sum(s); const float mu = s * (1.f / 2048.f); float q2 = 0.f;
#pragma unroll
        for (int j = 0; j < 32; ++j) { const float dd = v[j] - mu; q2 += dd * dd; }
        q2 = wave_sum(q2);
        if (lane == 0) { ST[r] = mu; ST[NROW + r] = rsqrtf(q2 * (1.f / 2048.f) + EPS); }
    }
}
__device__ __forceinline__ float half_sum32(float v) {
    v += __builtin_bit_cast(float, __builtin_amdgcn_mov_dpp(__builtin_bit_cast(int, v), 0xB1, 0xF, 0xF, true));
    v += __builtin_bit_cast(float, __builtin_amdgcn_mov_dpp(__builtin_bit_cast(int, v), 0x4E, 0xF, 0xF, true));
    v += __builtin_bit_cast(float, __builtin_amdgcn_mov_dpp(__builtin_bit_cast(int, v), 0x141, 0xF, 0xF, true));
    v += __builtin_bit_cast(float, __builtin_amdgcn_mov_dpp(__builtin_bit_cast(int, v), 0x140, 0xF, 0xF, true));
    auto r = __builtin_amdgcn_permlane16_swap(__float_as_uint(v), __float_as_uint(v), false, false);
    return __uint_as_float(r[0]) + __uint_as_float(r[1]);
}
__device__ __forceinline__ void phase_spatial(const Args& A, int gi, int nrows, LAS unsigned char* lds) {
    const bf16_t* Gb = (const bf16_t*)(A.ws + WS_BIG); const f32x2* PARTS = (const f32x2*)(A.ws + WS_R3); bf16_t* Ab = (bf16_t*)(A.ws + WS_R1);
    const bf16_t* WSg = (const bf16_t*)(A.ws + WS_W + W_GM + (size_t)gi * WG_SZ + WG_WS);
    const float* lng = A.in[I_GLNG] + (size_t)gi * 2048; const float* lnb = A.in[I_GLNB] + (size_t)gi * 2048; const float* bs = A.in[I_GBS] + (size_t)gi * 1024;
    const int tid = otid(), wid = tid >> 6, lane = tid & 63, r32 = lane & 31, hi = lane >> 5, tb = wid & 3, dh = wid >> 2;
    const int ldsaddr = (int)(unsigned)(uintptr_t)lds;
    u32x4 nv[8]; f32x2 nps[8];
    const int nunits = (nrows / 128) * 8;
#define SP_LOADV(un) do { const int cb_ = (un) >> 3, gg_ = (un) & 7, r0_ = cb_ * 128; \
        _Pragma("unroll") for (int j = 0; j < 8; ++j) { const int idx = tid + 512 * j, s_ = idx >> 5, dd_ = (idx & 31) * 8; \
            nv[j] = *(const u32x4*)(Gb + (size_t)(r0_ + s_) * 4096 + 2048 + 256 * gg_ + dd_); nps[j] = PARTS[(size_t)(r0_ + s_) * 32 + (idx & 31)]; } } while (0)
    if ((int)blockIdx.x < nunits) SP_LOADV((int)blockIdx.x);
    for (int unit = blockIdx.x; unit < nunits; unit += gridDim.x) {
        const int cb = unit >> 3, gg = unit & 7, r0 = cb * 128;
        __syncthreads();
#pragma unroll
        for (int j = 0; j < 8; ++j) { const int idx = tid + 512 * j, s = idx >> 5, dd = (idx & 31) * 8;
            const u32x4 w = nv[j];
            const float mu = half_sum32(nps[j].x) * (1.f / 2048.f), rs = rsqrtf(fmaxf(half_sum32(nps[j].y) * (1.f / 2048.f) - mu * mu, 0.f) + EPS);
            const f32x4 g0 = *(const f32x4*)(lng + 256 * gg + dd), g1 = *(const f32x4*)(lng + 256 * gg + dd + 4), b0 = *(const f32x4*)(lnb + 256 * gg + dd), b1 = *(const f32x4*)(lnb + 256 * gg + dd + 4);
            u32x4 o;
            o.x = cvt_pk_bf16((bflo(w.x) - mu) * rs * g0[0] + b0[0], (bfhi(w.x) - mu) * rs * g0[1] + b0[1]); o.y = cvt_pk_bf16((bflo(w.y) - mu) * rs * g0[2] + b0[2], (bfhi(w.y) - mu) * rs * g0[3] + b0[3]);
            o.z = cvt_pk_bf16((bflo(w.z) - mu) * rs * g1[0] + b1[0], (bfhi(w.z) - mu) * rs * g1[1] + b1[1]); o.w = cvt_pk_bf16((bflo(w.w) - mu) * rs * g1[2] + b1[2], (bfhi(w.w) - mu) * rs * g1[3] + b1[3]);
            *(LAS u32x4*)(lds + ((s >> 6) * 2 + (dd >> 7)) * 16384 + att::v_st(s & 63, dd & 127)) = o; }
        u32x2 uu[4][4];
        { const bf16_t* up = Gb + (size_t)(r0 + 32 * tb + r32) * 4096 + 256 * gg + 128 * dh + 4 * hi;
#pragma unroll
          for (int d0 = 0; d0 < 4; ++d0)
#pragma unroll
              for (int k = 0; k < 4; ++k) uu[d0][k] = *(const u32x2*)(up + 32 * d0 + 8 * k); }
        if (unit + (int)gridDim.x < nunits) SP_LOADV(unit + (int)gridDim.x);
        bf16x8 pa[8];
#pragma unroll
        for (int ks = 0; ks < 8; ++ks) pa[ks] = *(const bf16x8*)(WSg + ((size_t)gg * 128 + 32 * tb + r32) * 128 + 16 * ks + 8 * hi);
        __syncthreads();
        f32x16 o[4] = {};
#define SP_PV(D0, vbase, p0, p1, p2, p3) do { \
            const s16x4 l0 = att::tr_read<att::v_rd_off(D0, 0, 0)>(vbase), h0 = att::tr_read<att::v_rd_off(D0, 0, 1)>(vbase), l1 = att::tr_read<att::v_rd_off(D0, 1, 0)>(vbase), h1 = att::tr_read<att::v_rd_off(D0, 1, 1)>(vbase); \
            const s16x4 l2 = att::tr_read<att::v_rd_off(D0, 2, 0)>(vbase), h2 = att::tr_read<att::v_rd_off(D0, 2, 1)>(vbase), l3 = att::tr_read<att::v_rd_off(D0, 3, 0)>(vbase), h3 = att::tr_read<att::v_rd_off(D0, 3, 1)>(vbase); \
            asm volatile("s_waitcnt lgkmcnt(0)" ::: "memory"); __builtin_amdgcn_sched_barrier(0); \
            o[D0] = __builtin_amdgcn_mfma_f32_32x32x16_bf16((bf16x8){l0[0], l0[1], l0[2], l0[3], h0[0], h0[1], h0[2], h0[3]}, p0, o[D0], 0, 0, 0); \
            o[D0] = __builtin_amdgcn_mfma_f32_32x32x16_bf16((bf16x8){l1[0], l1[1], l1[2], l1[3], h1[0], h1[1], h1[2], h1[3]}, p1, o[D0], 0, 0, 0); \
            o[D0] = __builtin_amdgcn_mfma_f32_32x32x16_bf16((bf16x8){l2[0], l2[1], l2[2], l2[3], h2[0], h2[1], h2[2], h2[3]}, p2, o[D0], 0, 0, 0); \
            o[D0] = __builtin_amdgcn_mfma_f32_32x32x16_bf16((bf16x8){l3[0], l3[1], l3[2], l3[3], h3[0], h3[1], h3[2], h3[3]}, p3, o[D0], 0, 0, 0); } while (0)
        { const int vb0 = ldsaddr + (0 * 2 + dh) * 16384 + att::v_rd_base(lane), vb1 = ldsaddr + (1 * 2 + dh) * 16384 + att::v_rd_base(lane);
          SP_PV(0, vb0, pa[0], pa[1], pa[2], pa[3]); SP_PV(1, vb0, pa[0], pa[1], pa[2], pa[3]); SP_PV(2, vb0, pa[0], pa[1], pa[2], pa[3]); SP_PV(3, vb0, pa[0], pa[1], pa[2], pa[3]);
          SP_PV(0, vb1, pa[4], pa[5], pa[6], pa[7]); SP_PV(1, vb1, pa[4], pa[5], pa[6], pa[7]); SP_PV(2, vb1, pa[4], pa[5], pa[6], pa[7]); SP_PV(3, vb1, pa[4], pa[5], pa[6], pa[7]); }
#undef SP_PV
        { const int t = 32 * tb + r32, row = r0 + t; const float bsv = bs[gg * 128 + t];
          bf16_t* ap = Ab + (size_t)row * 2048 + 256 * gg + 128 * dh + 4 * hi;
#pragma unroll
          for (int d0 = 0; d0 < 4; ++d0)
#pragma unroll
              for (int k = 0; k < 4; ++k) {
                  const u32x2 u2 = uu[d0][k];
                  u32x2 w; w.x = cvt_pk_bf16(bflo(u2.x) * (o[d0][4 * k] + bsv), bfhi(u2.x) * (o[d0][4 * k + 1] + bsv)); w.y = cvt_pk_bf16(bflo(u2.y) * (o[d0][4 * k + 2] + bsv), bfhi(u2.y) * (o[d0][4 * k + 3] + bsv));
                  *(u32x2*)(ap + 32 * d0 + 8 * k) = w; } }
    }
#undef SP_LOADV
}

constexpr int NSL = 8, SW = 1024 / NSL;
constexpr size_t TAB8_HALF = (size_t)NEXP * 1024, TAB_SCL = 2 * TAB8_HALF, TAB_SET = al256(TAB_SCL + (size_t)2 * NEXP * 4);
static_assert(2 * TAB_SET <= TAB_REGION, "table sets");
__device__ __forceinline__ size_t tabset(int layer) { return WS_TAB + (size_t)(layer & 1) * TAB_SET; }
constexpr float HS = 4.f;
__device__ __forceinline__ void phase_tabcvt(const Args& A, int layer, int wg, int nwg, int r_lo = 0, int r_hi = 2 * NEXP) {
    const int tid_ = otid(); const int lane = tid_ & 63, gw = wg * 8 + (tid_ >> 6), nw = nwg * 8;
    unsigned char* TS = A.ws + tabset(layer); float* SCL = (float*)(TS + TAB_SCL);
    for (int r = r_lo + gw; r < r_hi; r += nw) {
        const int tab = r >> 14, e = r & (NEXP - 1);
        const float* src = (tab ? A.in[I_PV] : A.in[I_PU]) + ((size_t)layer * NEXP + e) * 1024 + 16 * lane;
        f32x4 v[4]; float am = 0.f;
#pragma unroll
        for (int i = 0; i < 4; ++i) { v[i] = *(const f32x4*)(src + 4 * i); am = fmaxf(am, fmaxf(fmaxf(fabsf(v[i][0]), fabsf(v[i][1])), fmaxf(fabsf(v[i][2]), fabsf(v[i][3])))); }
#pragma unroll
        for (int o = 32; o >= 1; o >>= 1) am = fmaxf(am, __shfl_xor(am, o));
        float sc = 1.f; if (am > 0.f) { int ex; (void)frexpf(448.f / am, &ex); sc = ldexpf(1.f, ex - 1); }
        if (lane == 0) SCL[tab * NEXP + e] = 1.f / sc;
        u32x4 w;
#pragma unroll
        for (int i = 0; i < 4; ++i) w[i] = pk4_fp8(v[i][0] * sc, v[i][1] * sc, v[i][2] * sc, v[i][3] * sc);
        *(u32x4*)(TS + (size_t)tab * TAB8_HALF + ((size_t)(lane >> 3) * NEXP + e) * SW + 16 * (lane & 7)) = w;
    }
}
#define CASD(a, b) do { const float hi_ = fmaxf(a, b), lo_ = fminf(a, b); a = hi_; b = lo_; } while (0)
__device__ __forceinline__ void sort16(float (&k)[16]) {
#pragma unroll
    for (int sz = 2; sz <= 16; sz <<= 1)
#pragma unroll
        for (int j = sz >> 1; j > 0; j >>= 1)
#pragma unroll
            for (int i = 0; i < 16; ++i) { const int l = i ^ j; if (l > i) { if ((i & sz) == 0 || sz == 16) CASD(k[i], k[l]); else CASD(k[l], k[i]); } }
}
__device__ __forceinline__ void bmerge16(float (&k)[16]) {
#pragma unroll
    for (int j = 8; j > 0; j >>= 1)
#pragma unroll
        for (int i = 0; i < 16; ++i) { const int l = i ^ j; if (l > i) CASD(k[i], k[l]); }
}
__device__ __forceinline__ void merge_top16(float (&a)[16], const float (&b)[16]) {
#pragma unroll
    for (int i = 0; i < 16; ++i) a[i] = fmaxf(a[i], b[15 - i]);
    bmerge16(a);
}
__device__ __forceinline__ void xmerge_top16(float (&a)[16], int mask) {
    float t[16];
#pragma unroll
    for (int i = 0; i < 16; ++i) t[i] = __shfl_xor(a[15 - i], mask);
#pragma unroll
    for (int i = 0; i < 16; ++i) a[i] = fmaxf(a[i], t[i]);
    bmerge16(a);
}
__device__ __forceinline__ void phase_topk(const Args& A, int layer, int nrows, LAS unsigned char* lds) {
    const bf16_t* QP = (const bf16_t*)(A.ws + WS_BIG); int* IDX = (int*)(A.ws + WS_R2); float* GATE = (float*)(A.ws + WS_R2 + R2_GATE);
    const int tid = otid(), wid = tid >> 6, lane = tid & 63, fr = lane & 15, fq = lane >> 4;
    LAS unsigned* scr = (LAS unsigned*)(lds + 2 * 34816) + wid * 512 + fr * 32;
    int h_staged = -1;
    for (int unit = blockIdx.x; unit < (nrows / 128) * 8; unit += gridDim.x) {
        const int h = unit & 7, r0 = (unit >> 3) * 128;
        if (h != h_staged) { h_staged = h;
        __syncthreads();
        { const bf16_t* k1 = (const bf16_t*)(A.ws + WS_W + W_PEER + (size_t)layer * WP_SZ + WP_K1) + (size_t)h * 16384;
#pragma unroll
          for (int j = 0; j < 8; ++j) { const int idx = tid + 512 * j, half = idx >> 11, rem = idx & 2047, key = rem >> 4, c8 = rem & 15;
              const u32x4 w = *(const u32x4*)(k1 + (size_t)half * 8 * 16384 + key * 128 + 8 * c8);
              *(LAS u32x4*)(lds + half * 34816 + key * 272 + c8 * 16) = w; } }
        __syncthreads(); }
        const int tok = r0 + 16 * wid + fr;
        float top[2][16];
#pragma unroll
        for (int half = 0; half < 2; ++half) {
            bf16x8 qf[4];
#pragma unroll
            for (int ks = 0; ks < 4; ++ks) qf[ks] = *(const bf16x8*)(QP + (size_t)tok * 2048 + 256 * h + 128 * half + 32 * ks + 8 * fq);
            float loc[16];
#pragma unroll
            for (int grp = 0; grp < 2; ++grp) {
                float kk[16];
#pragma unroll
                for (int nbb = 0; nbb < 4; ++nbb) { const int nb = 4 * grp + nbb; f32x4 acc = {0.f, 0.f, 0.f, 0.f};
#pragma unroll
                    for (int ks = 0; ks < 4; ++ks) { const bf16x8 kf = *(const LAS bf16x8*)(lds + half * 34816 + (16 * nb + fr) * 272 + (32 * ks + 8 * fq) * 2);
                        acc = __builtin_amdgcn_mfma_f32_16x16x32_bf16(kf, qf[ks], acc, 0, 0, 0); }
#pragma unroll
                    for (int i = 0; i < 4; ++i) { const unsigned code = 127u - (unsigned)(16 * nb + 4 * fq + i); kk[4 * nbb + i] = __uint_as_float((__float_as_uint(acc[i]) & ~127u) | code); } }
                sort16(kk);
                if (grp == 0) {
#pragma unroll
                    for (int i = 0; i < 16; ++i) loc[i] = kk[i];
                } else merge_top16(loc, kk);
            }
            xmerge_top16(loc, 16); xmerge_top16(loc, 32);
#pragma unroll
            for (int i = 0; i < 16; ++i) top[half][i] = loc[i];
        }
        if (fq < 2) {
#pragma unroll
            for (int i = 0; i < 16; ++i) scr[16 * fq + i] = __float_as_uint(fq == 0 ? top[0][i] : top[1][i]); }
        float fin[16];
#pragma unroll
        for (int aa = 0; aa < 4; ++aa) {
            const float va_k = fq == 0 ? top[0][aa] : fq == 1 ? top[0][4 + aa] : fq == 2 ? top[0][8 + aa] : top[0][12 + aa];
            const float va = __uint_as_float(__float_as_uint(va_k) & ~127u);
            float c[16];
#pragma unroll
            for (int bb = 0; bb < 16; ++bb) { const float s = va + __uint_as_float(__float_as_uint(top[1][bb]) & ~127u);
                c[bb] = __uint_as_float((__float_as_uint(s) & ~255u) | (255u - (unsigned)((4 * fq + aa) * 16 + bb))); }
            if (aa == 0) {
#pragma unroll
                for (int i = 0; i < 16; ++i) fin[i] = c[i];
            } else merge_top16(fin, c);
        }
        xmerge_top16(fin, 16); xmerge_top16(fin, 32);
        float ev[16], es = 0.f; const float mx = __uint_as_float(__float_as_uint(fin[0]) & ~255u);
#pragma unroll
        for (int i = 0; i < 16; ++i) { ev[i] = __expf(__uint_as_float(__float_as_uint(fin[i]) & ~255u) - mx); es += ev[i]; }
        const float inv = 1.f / es;
        asm volatile("s_waitcnt lgkmcnt(0)" ::: "memory");
        int oi[4]; float og[4];
#pragma unroll
        for (int kq = 0; kq < 4; ++kq) {
            const float fk = fq == 0 ? fin[kq] : fq == 1 ? fin[4 + kq] : fq == 2 ? fin[8 + kq] : fin[12 + kq];
            const float fe = fq == 0 ? ev[kq] : fq == 1 ? ev[4 + kq] : fq == 2 ? ev[8 + kq] : ev[12 + kq];
            const unsigned code = 255u - (__float_as_uint(fk) & 255u), a = code >> 4, bq = code & 15u;
            const unsigned i1 = 127u - (scr[a] & 127u), i2 = 127u - (scr[16 + bq] & 127u);
            oi[kq] = (int)(i1 * 128u + i2); og[kq] = fe * inv; }
        *(int4*)(IDX + (size_t)tok * 128 + 16 * h + 4 * fq) = make_int4(oi[0], oi[1], oi[2], oi[3]);
        *(f32x4*)(GATE + (size_t)tok * 128 + 16 * h + 4 * fq) = (f32x4){og[0], og[1], og[2], og[3]};
    }
}
struct PeerSched {
    int x0, rank, nloc, nblk, nown; unsigned orphan;
    __device__ __forceinline__ void init(const Args& A, int nrows, LAS unsigned char* smem) {
        unsigned* ctl = (unsigned*)(A.ws + WS_CTL);
        x0 = (int)(xb_xcc_id() & 7u); rank = __builtin_amdgcn_readfirstlane((int)((LAS unsigned*)smem)[8]); nblk = nrows / 64;
        unsigned cached = __builtin_amdgcn_readfirstlane(((LAS unsigned*)smem)[9]);
        if (cached == 0u) { unsigned orph = 0u, nl = 1u;
            for (int j = 0; j < 8; ++j) { unsigned c = xb_ld(&ctl[XB_XCNT(j)]) + xb_ld(&ctl[XB_XCNT(j + 8)]); c = __builtin_amdgcn_readfirstlane(c); if (c == 0u) orph |= 1u << j; if (j == x0) nl = c; }
            cached = (nl << 8) | orph; __syncthreads(); if (threadIdx.x == 0) ((LAS unsigned*)smem)[9] = cached; __syncthreads(); }
        nloc = (int)(cached >> 8); orphan = cached & 0xffu;
        const int tot = (NSL / 8) * nblk; nown = rank < tot ? (tot - rank + nloc - 1) / nloc : 0;
    }
    __device__ __forceinline__ bool item(int j, int& sl, int& blk) const {
        if (j < nown) { const int i = rank + j * nloc; sl = x0 + 8 * (i / nblk); blk = i % nblk; return true; }
        int jj = j - nown; const int tot = (NSL / 8) * nblk, per = ((int)gridDim.x > tot) ? 1 : 0; (void)per;
        for (int o = 0; o < 8; ++o) if ((orphan >> o) & 1u) { const int cnt = ((int)blockIdx.x < tot) ? (tot - (int)blockIdx.x + (int)gridDim.x - 1) / (int)gridDim.x : 0;
            if (jj < cnt) { const int i = (int)blockIdx.x + jj * (int)gridDim.x; sl = o + 8 * (i / nblk); blk = i % nblk; return true; } jj -= cnt; }
        return false;
    }
};
template <class LD, class PR>
__device__ __forceinline__ void peer_items(const PeerSched& S, LD ld, PR pr) {
    int sl, blk, sln, blkn, j = 0, buf = 0; bool have = S.item(0, sl, blk);
    __syncthreads();
    if (have) ld(sl, blk, 0);
    while (have) {
        const bool haven = S.item(j + 1, sln, blkn);
        asm volatile("s_waitcnt vmcnt(0)" ::: "memory");
        if (haven) ld(sln, blkn, buf ^ 1);
        pr(sl, blk, buf);
        sl = sln; blk = blkn; have = haven; buf ^= 1; ++j;
    }
    __syncthreads();
}
#ifndef MK_UVAR
#define MK_UVAR 0
#endif
__device__ __forceinline__ float dpp_sum8(float v) {
    v += __builtin_bit_cast(float, __builtin_amdgcn_mov_dpp(__builtin_bit_cast(int, v), 0xB1, 0xF, 0xF, true));
    v += __builtin_bit_cast(float, __builtin_amdgcn_mov_dpp(__builtin_bit_cast(int, v), 0x4E, 0xF, 0xF, true));
    v += __builtin_bit_cast(float, __builtin_amdgcn_mov_dpp(__builtin_bit_cast(int, v), 0x141, 0xF, 0xF, true));
    return v;
}
__device__ __forceinline__ void phase_peer_u(const Args& A, int layer, int nrows, LAS unsigned char* smem, int rep) {
    const int var = rep ? MK_UVAR : 0;
    const bf16_t* H = (const bf16_t*)(A.ws + WS_H); const int* IDX = (const int*)(A.ws + WS_R2); float* PART = var ? (float*)(A.ws + WS_R1) : (float*)(A.ws + WS_BIG + BIG_PART);
    const unsigned char* U = A.ws + tabset(layer);
    constexpr int PP = 1088, WB = 4 * PP + 2048;
    const int tid = otid(), wid = tid >> 6, lane = tid & 63, m = lane & 7, tk = lane >> 3;
    const int wu = __builtin_amdgcn_readfirstlane(wid);
    LAS unsigned char* lds = smem + LDS_BASE + wu * (2 * WB);
    PeerSched S; S.init(A, nrows, smem);
    peer_items(S,
        [&](int sl, int blk, int buf) {
#pragma unroll
            for (int i = 0; i < 4; ++i)
                __builtin_amdgcn_global_load_lds((const unsigned*)(IDX + ((size_t)blk * 64 + 8 * wu + 2 * i) * 128 + 4 * lane), (LAS unsigned*)(lds + buf * WB + PP * i), 16, 0, 0);
#pragma unroll
            for (int i = 0; i < 2; ++i)
                __builtin_amdgcn_global_load_lds((const unsigned*)(H + (size_t)(blk * 64 + 8 * wu + 4 * i + (lane >> 4)) * 1024 + SW * sl + 8 * (lane & 15)), (LAS unsigned*)(lds + buf * WB + 4 * PP + 1024 * i), 16, 0, 0); },
        [&](int sl, int blk, int buf) {
            const unsigned char* ub = U + (size_t)sl * NEXP * SW + 16 * m;
            const int tok = blk * 64 + wid * 8 + tk;
            const int sw = (tk & 1) * 4;
            const LAS int* ib = (const LAS int*)(lds + buf * WB + (tk >> 1) * PP + (tk & 1) * 512);
            float hf[16];
            { const u32x4 h0 = *(const LAS u32x4*)(lds + buf * WB + 4 * PP + tk * 256 + 32 * m), h1 = *(const LAS u32x4*)(lds + buf * WB + 4 * PP + tk * 256 + 32 * m + 16);
#pragma unroll
              for (int j = 0; j < 4; ++j) { hf[2 * j] = bflo(h0[j]); hf[2 * j + 1] = bfhi(h0[j]); hf[8 + 2 * j] = bflo(h1[j]); hf[8 + 2 * j + 1] = bfhi(h1[j]); } }
            const bool up4 = m >= 4, up2 = (m & 2) != 0, up1 = (m & 1) != 0;
            float* pp = PART + ((size_t)sl * NROW + tok) * 128 + (m ^ sw);
            u32x4 vv[2][8];
#define PU_ROWS(T, c) do { const i32x4 e0_ = *(const LAS i32x4*)(ib + 8 * (c) + sw), e1_ = *(const LAS i32x4*)(ib + 8 * (c) + (4 - sw)); \
                if (var == 4) { _Pragma("unroll") for (int k_ = 0; k_ < 8; ++k_) vv[T][k_] = (u32x4){(unsigned)e0_.x, (unsigned)e1_.y, 0u, 0u}; } else { \
                vv[T][0] = *(const u32x4*)(ub + (size_t)(var == 3 ? e0_.x & 63 : e0_.x) * SW); vv[T][1] = *(const u32x4*)(ub + (size_t)(var == 3 ? e0_.y & 63 : e0_.y) * SW); \
                vv[T][2] = *(const u32x4*)(ub + (size_t)(var == 3 ? e0_.z & 63 : e0_.z) * SW); vv[T][3] = *(const u32x4*)(ub + (size_t)(var == 3 ? e0_.w & 63 : e0_.w) * SW); \
                vv[T][4] = *(const u32x4*)(ub + (size_t)(var == 3 ? e1_.x & 63 : e1_.x) * SW); vv[T][5] = *(const u32x4*)(ub + (size_t)(var == 3 ? e1_.y & 63 : e1_.y) * SW); \
                vv[T][6] = *(const u32x4*)(ub + (size_t)(var == 3 ? e1_.z & 63 : e1_.z) * SW); vv[T][7] = *(const u32x4*)(ub + (size_t)(var == 3 ? e1_.w & 63 : e1_.w) * SW); } } while (0)
#define PU_DOT(T, c) do { float s_[8]; \
                _Pragma("unroll") for (int k = 0; k < 8; ++k) { f32x2 a2 = {0.f, 0.f}; \
                    _Pragma("unroll") for (int j = 0; j < 4; ++j) { const int w = (int)vv[T][k][j]; \
                        const f32x2 lo = __builtin_amdgcn_cvt_pk_f32_fp8(w, false), hi = __builtin_amdgcn_cvt_pk_f32_fp8(w, true); \
                        a2 = __builtin_elementwise_fma(lo, (f32x2){hf[4 * j], hf[4 * j + 1]}, a2); a2 = __builtin_elementwise_fma(hi, (f32x2){hf[4 * j + 2], hf[4 * j + 3]}, a2); } \
                    s_[k] = a2.x + a2.y; } \
                  \
                float t_[4], u_[2]; \
                _Pragma("unroll") for (int j = 0; j < 4; ++j) { const float give = up4 ? s_[j] : s_[4 + j], keep = up4 ? s_[4 + j] : s_[j]; \
                    t_[j] = keep + __builtin_bit_cast(float, __builtin_amdgcn_mov_dpp(__builtin_bit_cast(int, give), 0x141, 0xF, 0xF, true)); }        \
                _Pragma("unroll") for (int j = 0; j < 2; ++j) { const float give = up2 ? t_[j] : t_[2 + j], keep = up2 ? t_[2 + j] : t_[j]; \
                    u_[j] = keep + __builtin_bit_cast(float, __builtin_amdgcn_mov_dpp(__builtin_bit_cast(int, give), 0x4E, 0xF, 0xF, true)); }         \
                { const float give = up1 ? u_[0] : u_[1], keep = up1 ? u_[1] : u_[0]; \
                  const float tot_ = keep + __builtin_bit_cast(float, __builtin_amdgcn_mov_dpp(__builtin_bit_cast(int, give), 0xB1, 0xF, 0xF, true));           \
                  pp[8 * (c)] = tot_; } } while (0)
            PU_ROWS(0, 0);
#pragma unroll 1
            for (int c = 0; c < 16; c += 2) {
                PU_ROWS(1, c + 1);
                __builtin_amdgcn_sched_barrier(0);
                PU_DOT(0, c);
                __builtin_amdgcn_sched_barrier(0);
                if (c + 2 < 16) PU_ROWS(0, c + 2);
                __builtin_amdgcn_sched_barrier(0);
                PU_DOT(1, c + 1);
                __builtin_amdgcn_sched_barrier(0);
            }
#undef PU_ROWS
#undef PU_DOT
        });
}
__device__ __forceinline__ void phase_coef(const Args& A, int layer, int nrows) {
    const float* PART = (const float*)(A.ws + WS_BIG + BIG_PART); const float* GATE = (const float*)(A.ws + WS_R2 + R2_GATE); unsigned* REC = (unsigned*)(A.ws + WS_R2 + R2_COEF);
    const int* IDX = (const int*)(A.ws + WS_R2); const float* SCL = (const float*)(A.ws + tabset(layer) + TAB_SCL);
    const int gthr = blockIdx.x * NTHR + otid(), nthr = gridDim.x * NTHR;
    for (int p = gthr; p < nrows * 32; p += nthr) {
        f32x4 s = {0.f, 0.f, 0.f, 0.f};
#pragma unroll
        for (int x = 0; x < NSL; ++x) s += *(const f32x4*)(PART + (size_t)x * NROW * 128 + 4 * p);
        const i32x4 e = *(const i32x4*)(IDX + 4 * p); const f32x4 gt = *(const f32x4*)(GATE + 4 * p);
        const f32x4 su = {SCL[e.x], SCL[e.y], SCL[e.z], SCL[e.w]}, sv = {SCL[NEXP + e.x], SCL[NEXP + e.y], SCL[NEXP + e.z], SCL[NEXP + e.w]};
        const f32x4 a = s * su; const f32x2 g0 = gelu_pk((f32x2){a[0], a[1]}), g1 = gelu_pk((f32x2){a[2], a[3]});
        const f32x4 cf = gt * (f32x4){g0.x, g0.y, g1.x, g1.y} * sv;
        *(u32x4*)(REC + 4 * p) = (u32x4){cvt_pk_bf16(0.f, cf[0]) | (unsigned)e.x, cvt_pk_bf16(0.f, cf[1]) | (unsigned)e.y, cvt_pk_bf16(0.f, cf[2]) | (unsigned)e.z, cvt_pk_bf16(0.f, cf[3]) | (unsigned)e.w}; }

}
__device__ __forceinline__ void phase_peer_v(const Args& A, int layer, int nrows, LAS unsigned char* smem, int rep) {
    const int* REC = (const int*)(A.ws + WS_R2 + R2_COEF);
    const unsigned char* V = A.ws + tabset(layer) + TAB8_HALF; const float* MODL = (const float*)(A.ws + WS_MOD) + (size_t)layer * 5 * 6144 + 5 * 1024;
    bf16_t* XB = (bf16_t*)(A.ws + WS_XB);
    constexpr int PP = 1088, WB = 4 * PP;
    const int tid = otid(), wid = tid >> 6, lane = tid & 63, m = lane & 7, tk = lane >> 3;
    const int wu = __builtin_amdgcn_readfirstlane(wid);
    LAS unsigned char* lds = smem + LDS_BASE + wu * (2 * WB);
    PeerSched S; S.init(A, nrows, smem);
    peer_items(S,
        [&](int sl, int blk, int buf) {
#pragma unroll
            for (int i = 0; i < 4; ++i)
                __builtin_amdgcn_global_load_lds((const unsigned*)(REC + ((size_t)blk * 64 + 8 * wu + 2 * i) * 128 + 4 * lane), (LAS unsigned*)(lds + buf * WB + PP * i), 16, 0, 0); },
        [&](int sl, int blk, int buf) {
            const unsigned char* vb = V + (size_t)sl * NEXP * SW + 16 * m;
            const int tok = blk * 64 + wid * 8 + tk; const bool lat = tok < NLAT;
            const int toff = (tk >> 1) * PP + (tk & 1) * 512, sw = (tk & 1) * 4;
            const LAS int* ib = (const LAS int*)(lds + buf * WB + toff);
            bf16_t* xp = XB + (size_t)tok * D + SW * sl + 16 * m;
            const u32x4 xr0 = *(const u32x4*)xp, xr1 = *(const u32x4*)(xp + 8);
            f32x2 acc2[8];
#pragma unroll
            for (int j = 0; j < 8; ++j) acc2[j] = (f32x2){0.f, 0.f};
            u32x4 vv[2][8];
#define PV_ROWS(T, c) do { const i32x4 e0_ = *(const LAS i32x4*)(ib + 8 * (c) + sw) & 0xffff, e1_ = *(const LAS i32x4*)(ib + 8 * (c) + (4 - sw)) & 0xffff; \
                vv[T][0] = *(const u32x4*)(vb + (size_t)e0_.x * SW); vv[T][1] = *(const u32x4*)(vb + (size_t)e0_.y * SW); vv[T][2] = *(const u32x4*)(vb + (size_t)e0_.z * SW); vv[T][3] = *(const u32x4*)(vb + (size_t)e0_.w * SW); \
                vv[T][4] = *(const u32x4*)(vb + (size_t)e1_.x * SW); vv[T][5] = *(const u32x4*)(vb + (size_t)e1_.y * SW); vv[T][6] = *(const u32x4*)(vb + (size_t)e1_.z * SW); vv[T][7] = *(const u32x4*)(vb + (size_t)e1_.w * SW); } while (0)
#define PV_FMA(T, c) do { const i32x4 r0_ = *(const LAS i32x4*)(ib + 8 * (c) + sw) & (int)0xffff0000, r1_ = *(const LAS i32x4*)(ib + 8 * (c) + (4 - sw)) & (int)0xffff0000; \
                const f32x4 c0_ = __builtin_bit_cast(f32x4, r0_), c1_ = __builtin_bit_cast(f32x4, r1_); \
                _Pragma("unroll") for (int k = 0; k < 8; ++k) { const float cf = k < 4 ? c0_[k & 3] : c1_[k & 3]; \
                    _Pragma("unroll") for (int j = 0; j < 4; ++j) { const int w = (int)vv[T][k][j]; \
                        const f32x2 lo = __builtin_amdgcn_cvt_pk_f32_fp8(w, false), hi = __builtin_amdgcn_cvt_pk_f32_fp8(w, true); const f32x2 c2 = {cf, cf}; \
                        acc2[2 * j] = __builtin_elementwise_fma(lo, c2, acc2[2 * j]); acc2[2 * j + 1] = __builtin_elementwise_fma(hi, c2, acc2[2 * j + 1]); } } } while (0)
            PV_ROWS(0, 0);
#pragma unroll 1
            for (int c = 0; c < 16; c += 2) {
                PV_ROWS(1, c + 1);
                __builtin_amdgcn_sched_barrier(0);
                PV_FMA(0, c);
                __builtin_amdgcn_sched_barrier(0);
                if (c + 2 < 16) PV_ROWS(0, c + 2);
                __builtin_amdgcn_sched_barrier(0);
                PV_FMA(1, c + 1);
                __builtin_amdgcn_sched_barrier(0);
            }
#undef PV_ROWS
#undef PV_FMA
            const float* gp = MODL + (size_t)(lat ? (tok >> 13) : 4) * 6144 + SW * sl + 16 * m;
#pragma unroll
            for (int j = 0; j < 4; ++j) { const f32x4 g = *(const f32x4*)(gp + 4 * j); const unsigned w0 = j == 0 ? xr0.x : j == 1 ? xr0.z : j == 2 ? xr1.x : xr1.z, w1 = j == 0 ? xr0.y : j == 1 ? xr0.w : j == 2 ? xr1.y : xr1.w;
                const f32x4 o = (f32x4){bflo(w0), bfhi(w0), bflo(w1), bfhi(w1)} + g * (f32x4){acc2[2 * j].x, acc2[2 * j].y, acc2[2 * j + 1].x, acc2[2 * j + 1].y};
                u32x2 w; w.x = cvt_pk_bf16(o[0], o[1]); w.y = cvt_pk_bf16(o[2], o[3]); *(u32x2*)(xp + 4 * j) = w; }
        });
}

#ifdef MK_CHECK
constexpr int CW_CHK = 3840;
__device__ __forceinline__ float blk_sum(float v, LAS float* red) {
    const int t_ = otid(); v = wave_sum(v); __syncthreads(); if ((t_ & 63) == 0) red[t_ >> 6] = v; __syncthreads();
    float s = 0.f; for (int i = 0; i < 8; ++i) s += red[i]; __syncthreads(); return s;
}
__device__ __forceinline__ float fp8f(unsigned b) { const unsigned e = (b >> 3) & 15u, m = b & 7u; const float v = e ? ldexpf(1.f + (float)m * 0.125f, (int)e - 7) : ldexpf((float)m * 0.125f, -6); return (b & 0x80u) ? -v : v; }
__device__ __forceinline__ void check_attn(const Args& A, LAS unsigned char* lds, bool with_ctx) {
    const unsigned char* Q = A.ws + WS_R1 + R1_Q; const unsigned char* KN = A.ws + WS_R1 + R1_KN; const unsigned char* KR = A.ws + WS_BIG + BIG_KR; const unsigned char* V = A.ws + WS_R1 + R1_V;
    const bf16_t* CAT = (const bf16_t*)(A.ws + WS_R3 + R3_CAT); float* chk = (float*)(A.ws + WS_CTL) + CW_CHK;
    LAS float* p = (LAS float*)lds; LAS float* qv = p + NKEY; LAS float* red = qv + 192;
    const int tid = otid();
    for (int au = blockIdx.x; au < (with_ctx ? 1056 : 1024); au += gridDim.x) {
        int b, h, qrow, orow, nkey;
        if (au < 1024) { b = au >> 8; h = au & 7; const int qb = (au >> 3) & 31, l = 256 * qb + (int)((((unsigned)au * 2654435761u) >> 20) & 255u); qrow = 256 + l; orow = b * 8192 + l; nkey = NKEY; }
        else { const int cu = au - 1024; b = cu >> 3; h = cu & 7; const int lc = (int)((((unsigned)au * 2654435761u) >> 20) & 255u); qrow = lc; orow = NLAT + 256 * b + lc; nkey = 256; }
        const size_t bh = (size_t)(b * 8 + h);
        __syncthreads();
        if (tid < 192) qv[tid] = fp8f(Q[(bh * NKEY + qrow) * 192 + tid]) * (1.f / att8::QUP);
        __syncthreads();
        float mx = -1e30f;
        for (int key = tid; key < nkey; key += 512) { const int t = key >> 6, k = key & 63; float sacc = 0.f;
            for (int d = 0; d < 128; ++d) sacc += qv[d] * fp8f(KN[(bh * NKT + t) * 8192 + att8::kn8(k, d)]);
            for (int d = 0; d < 64; ++d) sacc += qv[128 + d] * fp8f(KR[((size_t)b * NKT + t) * 4096 + att8::kr8(k, d)]);
            p[key] = sacc; mx = fmaxf(mx, sacc); }
        for (int o = 32; o >= 1; o >>= 1) mx = fmaxf(mx, __shfl_xor(mx, o));
        __syncthreads(); if ((tid & 63) == 0) red[tid >> 6] = mx; __syncthreads(); mx = red[0]; for (int i = 1; i < 8; ++i) mx = fmaxf(mx, red[i]); __syncthreads();
        float ls = 0.f; for (int key = tid; key < nkey; key += 512) { const float e = exp2f(p[key] - mx); p[key] = e; ls += e; }
        ls = blk_sum(ls, red);
        float num = 0.f, den = 0.f;
        if (tid < 128) { float o = 0.f; for (int key = 0; key < nkey; ++key) o += p[key] * fp8f(V[(bh * NKT + (key >> 6)) * 8192 + att8::v8(tid, key & 63)]);
            o /= ls; const float got = bf2f(CAT[(size_t)orow * 2048 + 1024 + 128 * h + tid]); num = (got - o) * (got - o); den = o * o; }
        num = blk_sum(num, red); den = blk_sum(den, red);
        if (tid == 0) { atomicAdd(chk, num); atomicAdd(chk + 1, den); }
    }
}
__device__ __forceinline__ void check_qkv(const Args& A, int li, LAS unsigned char* lds) {
    float* chk = (float*)(A.ws + WS_CTL) + CW_CHK;
    const unsigned char* Q = A.ws + WS_R1 + R1_Q; const unsigned char* KN = A.ws + WS_R1 + R1_KN; const unsigned char* KR = A.ws + WS_BIG + BIG_KR; const unsigned char* V = A.ws + WS_R1 + R1_V;
    LAS float* hv = (LAS float*)lds; LAS float* cq = hv + 1024; LAS float* ckv = cq + 384; LAS float* kr = ckv + 256; LAS float* red = kr + 64; LAS float* ov = red + 16;
    const int tid = otid(), sidx = blockIdx.x;
    const int hd = sidx & 7; const int r = (sidx & 8) ? NLAT + (int)(((unsigned)sidx * 2654435761u) >> 22) : (int)(((unsigned)sidx * 2654435761u) >> 17);
    const float* win = A.in[I_HWIN] + (size_t)li * 1024 * HYB_IN;
    {
        const bf16_t* xp = (const bf16_t*)(A.ws + WS_XB) + (size_t)r * D; const float* MODL = (const float*)(A.ws + WS_MOD) + (size_t)(2 * li) * 5 * 6144 + (size_t)row_mb(r) * 6144;
        float ss = 0.f; for (int i = tid; i < 1024; i += 512) ss += bf2f(xp[i]) * bf2f(xp[i]);
        ss = blk_sum(ss, red); const float rstd = rsqrtf(ss / 1024.f + EPS);
        for (int i = tid; i < 1024; i += 512) hv[i] = bf2f(f2bf(bf2f(xp[i]) * rstd * A.in[I_N1G][(2 * li) * 1024 + i] * (1.f + MODL[1024 + i]) + MODL[i])); }
    __syncthreads();
    for (int j = tid; j < 704; j += 512) { float s = 0.f; for (int k = 0; k < 1024; ++k) s += hv[k] * win[(size_t)k * HYB_IN + C_CQ + j];
        s = bf2f(f2bf(s)); if (j < 384) cq[j] = s; else if (j < 640) ckv[j - 384] = s; else kr[j - 640] = s; }
    __syncthreads();
    float sq = 0.f, sk = 0.f; for (int j = tid; j < 384; j += 512) sq += cq[j] * cq[j]; for (int j = tid; j < 256; j += 512) sk += ckv[j] * ckv[j];
    sq = blk_sum(sq, red); sk = blk_sum(sk, red);
    const float rq = rsqrtf(sq / 384.f + EPS), rk = rsqrtf(sk / 256.f + EPS);
    const float* wqb = A.in[I_WQB] + (size_t)li * 384 * 1536; const float* wkvb = A.in[I_WKVB] + (size_t)li * 256 * 2048; const float* qg = A.in[I_QNG] + li * 384; const float* kg = A.in[I_KVNG] + li * 256;
    if (tid < 192) { float s = 0.f; for (int k = 0; k < 384; ++k) s += cq[k] * rq * qg[k] * wqb[(size_t)k * 1536 + hd * 192 + tid]; ov[tid] = s; }
    else if (tid < 448) { const int c = tid - 192; float s = 0.f; for (int k = 0; k < 256; ++k) s += ckv[k] * rk * kg[k] * wkvb[(size_t)k * 2048 + hd * 256 + c]; ov[tid] = s; }
    __syncthreads();
    const bool lat = r < NLAT; const int b = lat ? (r >> 13) : ((r - NLAT) >> 8), l = lat ? (r & 8191) : 0, key = lat ? 256 + l : ((r - NLAT) & 255), qrow = key;
    const size_t bh = (size_t)(b * 8 + hd); const float qs = QSCALE * att8::QUP;
    float num = 0.f, den = 0.f;
    if (tid < 128) {
        const float q = ov[tid] * qs, gq = fp8f(Q[(bh * NKEY + qrow) * 192 + tid]);
        const float kk = ov[192 + tid], gk = fp8f(KN[(bh * NKT + (key >> 6)) * 8192 + att8::kn8(key & 63, tid)]);
        const float vv = ov[320 + tid], gv = fp8f(V[(bh * NKT + (key >> 6)) * 8192 + att8::v8(tid, key & 63)]);
        num = (gq - q) * (gq - q) + (gk - kk) * (gk - kk) + (gv - vv) * (gv - vv); den = q * q + kk * kk + vv * vv;
    } else if (tid < 160) {
        const int i = tid - 128; float c = 1.f, sn = 0.f;
        if (lat) { const float pos = (float)(i < 16 ? (l >> 6) : (l & 63)); const float ang = pos * powf(10000.f, -(float)(i & 15) / 16.f); c = cosf(ang); sn = sinf(ang); }
        const float q1 = ov[128 + i] * qs, q2 = ov[160 + i] * qs, k1 = kr[i], k2 = kr[32 + i];
        const float rq1 = q1 * c - q2 * sn, rq2 = q1 * sn + q2 * c, rk1 = k1 * c - k2 * sn, rk2 = k1 * sn + k2 * c;
        const float gq1 = fp8f(Q[(bh * NKEY + qrow) * 192 + 128 + 2 * i]), gq2 = fp8f(Q[(bh * NKEY + qrow) * 192 + 128 + 2 * i + 1]);
        const float gk1 = fp8f(KR[((size_t)b * NKT + (key >> 6)) * 4096 + att8::kr8(key & 63, 2 * i)]), gk2 = fp8f(KR[((size_t)b * NKT + (key >> 6)) * 4096 + att8::kr8(key & 63, 2 * i + 1)]);
        num = (gq1 - rq1) * (gq1 - rq1) + (gq2 - rq2) * (gq2 - rq2) + (gk1 - rk1) * (gk1 - rk1) + (gk2 - rk2) * (gk2 - rk2); den = rq1 * rq1 + rq2 * rq2 + rk1 * rk1 + rk2 * rk2;
    }
    num = blk_sum(num, red); den = blk_sum(den, red);
    if (tid == 0) { atomicAdd(chk, num); atomicAdd(chk + 1, den); }
}
__device__ __forceinline__ void check_topk(const Args& A, int layer, LAS unsigned char* lds) {
    const bf16_t* QP = (const bf16_t*)(A.ws + WS_BIG); const int* IDX = (const int*)(A.ws + WS_R2); const float* GATE = (const float*)(A.ws + WS_R2 + R2_GATE); float* chk = (float*)(A.ws + WS_CTL) + CW_CHK;
    const bf16_t* K1 = (const bf16_t*)(A.ws + WS_W + W_PEER + (size_t)layer * WP_SZ + WP_K1);
    LAS float* sc = (LAS float*)lds; LAS float* v12 = sc + 256; LAS int* i12 = (LAS int*)(v12 + 32); LAS float* cs = (LAS float*)(i12 + 32); LAS float* ts = cs + 256; LAS int* ti = (LAS int*)(ts + 16); LAS float* red = (LAS float*)(ti + 16);
    const int tid = otid();
    for (int smp = blockIdx.x; smp < 1024; smp += gridDim.x) {
        const int h = smp & 7, tok = (int)((((unsigned)smp * 2654435761u) >> 12) % (unsigned)NROW);
        __syncthreads();
        if (tid < 256) { const int half = tid >> 7, key = tid & 127; float a = 0.f;
            for (int d = 0; d < 128; ++d) a += bf2f(QP[(size_t)tok * 2048 + 256 * h + 128 * half + d]) * bf2f(K1[((size_t)half * 8 + h) * 16384 + key * 128 + d]);
            sc[tid] = a; }
        __syncthreads();
        if (tid < 256) { const int half = tid >> 7, key = tid & 127; const float v = sc[tid]; int rank = 0;
            for (int j = 0; j < 128; ++j) { const float o = sc[half * 128 + j]; rank += (o > v || (o == v && j < key)) ? 1 : 0; }
            if (rank < 16) { v12[half * 16 + rank] = v; i12[half * 16 + rank] = key; } }
        __syncthreads();
        if (tid < 256) cs[tid] = v12[tid >> 4] + v12[16 + (tid & 15)];
        __syncthreads();
        if (tid < 256) { const float v = cs[tid]; int rank = 0;
            for (int j = 0; j < 256; ++j) { const float o = cs[j]; rank += (o > v || (o == v && j < tid)) ? 1 : 0; }
            if (rank < 16) { ts[rank] = v; ti[rank] = i12[tid >> 4] * 128 + i12[16 + (tid & 15)]; } }
        __syncthreads();
        float num = 0.f, den = 0.f;
        if (tid < 16) { float es = 0.f; for (int j = 0; j < 16; ++j) es += __expf(ts[j] - ts[0]); const float gn = __expf(ts[tid] - ts[0]) / es; float gk = 0.f;
            for (int j = 0; j < 16; ++j) if (IDX[(size_t)tok * 128 + 16 * h + j] == ti[tid]) gk = GATE[(size_t)tok * 128 + 16 * h + j];
            num = (gk - gn) * (gk - gn); den = gn * gn; }
        num = blk_sum(num, red); den = blk_sum(den, red);
        if (tid == 0) { atomicAdd(chk, num); atomicAdd(chk + 1, den); }
    }
}
__device__ __forceinline__ void check_ssd(const Args& A, int li, LAS unsigned char* lds) {
    const bf16_t* XS = (const bf16_t*)(A.ws + WS_R2); const bf16_t* BC = (const bf16_t*)(A.ws + WS_R2 + R2_BC); const float* DT = (const float*)(A.ws + WS_BIG + BIG_DT);
    const bf16_t* Y0 = (const bf16_t*)(A.ws + WS_H); const bf16_t* Y1 = (const bf16_t*)(A.ws + WS_R3); float* chk = (float*)(A.ws + WS_CTL) + CW_CHK;
    LAS float* red = (LAS float*)lds;
    const int tid = otid(), sidx = blockIdx.x;
    const int b = sidx & 3, d = (sidx >> 2) & 1, h = (sidx >> 3) & 15, p = (int)((((unsigned)sidx * 2654435761u) >> 20) & 63u), g = h >> 3;
    const float a = -__expf(A.in[I_ALOG][li * 32 + d * 16 + h]);
    const bf16_t* Y = d ? Y1 : Y0;
    float hst = 0.f, num = 0.f, den = 0.f;
    for (int step = 0; step < 8448; ++step) {
        int r;
        if (step < 256) r = NLAT + b * 256 + (d ? 255 - step : step); else { const int q = step - 256; r = b * 8192 + (d ? 8191 - q : q); }
        const float dt = DT[(size_t)(d * 16 + h) * NROW + r], x = bf2f(XS[(size_t)r * 1024 + 64 * h + p]);
        float contrib = 0.f;
        if (tid < 128) { hst = __expf(dt * a) * hst + dt * x * bf2f(BC[(size_t)r * 512 + 128 * g + tid]); contrib = hst * bf2f(BC[(size_t)r * 512 + 256 + 128 * g + tid]); }
        if (step % 61 == 0) { const float y = blk_sum(contrib, red); const float got = bf2f(Y[(size_t)r * 1024 + 64 * h + p]); if (tid == 0) { num += (got - y) * (got - y); den += y * y; } }
    }
    if (tid == 0) { atomicAdd(chk, num); atomicAdd(chk + 1, den); }
}
#endif
#ifndef MK_PER_PHASE
#define MK_PER_PHASE 0
#endif
__device__ __forceinline__ int nr_in(int L) { return L <= 2 ? NROW : NLAT; }
__device__ __forceinline__ int nr_out(int L) { return L <= 1 ? NROW : NLAT; }

__global__ void __launch_bounds__(NTHR, 2) fwd(Args A) {
    extern __shared__ __attribute__((aligned(256))) unsigned char smem_raw[];
    LAS unsigned char* smem = (LAS unsigned char*)smem_raw;
    LAS unsigned char* lds = smem + LDS_BASE;
    const int tid = otid();
    if (tid < 64) ((LAS unsigned*)smem)[tid] = 0u;
    __syncthreads();
    XcdBarrier bar = xcd_barrier_post((unsigned*)(A.ws + WS_CTL), (volatile LAS unsigned*)smem);
    if (tid == 0) ((LAS unsigned*)smem)[8] = atomicAdd((unsigned*)(A.ws + WS_CTL) + CW_RANK + 32 * (xb_xcc_id() & 7u), 1u);
    __syncthreads();
    bool need_bar = false;
    const int lo = A.ph_lo, hi = A.ph_hi;
#ifndef PHMASK
#define PHMASK 0xffffffffu
#endif
#define SITE(k) if constexpr (((PHMASK) >> (k)) & 1u)
#ifndef MK_SVAR
#define MK_SVAR 1
#endif
#ifndef MK_REPEAT_SITE
#define MK_REPEAT_SITE -1
#endif
#define REP(k) for (int rep = 0; rep < ((k) == (MK_REPEAT_SITE) ? 2 : 1); ++rep)
#define PH(id) if ([&]() -> bool { if ((id) < lo || (id) >= hi) return false; if (need_bar) xcd_barrier(bar); need_bar = true; return true; }())
    unsigned char* ws = A.ws;
#define TAIL_TAB(units, layer, rlo, rhi) do { const int nx_ = (units) % 256; if (gridDim.x == 256 && (int)blockIdx.x >= nx_) phase_tabcvt(A, layer, (int)blockIdx.x - nx_, 256 - nx_, rlo, rhi); } while (0)
    bf16_t* XB = (bf16_t*)(ws + WS_XB);
    bf16_t* H = (bf16_t*)(ws + WS_H);
    const float* MOD = (const float*)(ws + WS_MOD);

    SITE(0) PH(0) { phase_prologue(A, lds); }
    SITE(1) PH(1) { phase_norm_mod<true>(A.in[I_X], A.in[I_CTX], XB, A.in[I_N1G], MOD, 0, H, NROW); }
    for (int L = 0; L < DEPTH; ++L) {
        const int base = 2 + 16 * L, li = L >> 1; const bool hyb = (L & 1) == 0;
        const float* MODL = MOD + (size_t)L * 5 * 6144;
        unsigned char* WH = ws + WS_W + W_HYB + (size_t)li * WH_SZ; unsigned char* WG = ws + WS_W + W_GM + (size_t)li * WG_SZ; unsigned char* WP = ws + WS_W + W_PEER + (size_t)L * WP_SZ;
        if (hyb) {
            SITE(2) PH(base + 0) REP(2) { pg8::Gemm g{H, (const bf16_t*)(WH + WH_IN), nr_in(L), HYB_INP, 1024, 1024, 1024};
                pg8::EpiBf16<0> e{(bf16_t*)(ws + WS_BIG), HYB_INP}; pg8::gemm_phase(lds, g, e); }
            SITE(3) PH(base + 1) REP(3) { phase_conv(A, li, rep); }
            SITE(4) PH(base + 2) {
                SITE(18) REP(18) { pg8::Gemm g{(const bf16_t*)(ws + WS_BIG) + C_CQ, (const bf16_t*)(WH + WH_QB), L == 0 ? NROW : NLAT, 1536, 384, HYB_INP, 384};
                  EpiQ e{ws + WS_R1 + R1_Q, (const float*)(ws + WS_RSTD), (const float*)(ws + WS_ROPE)}; pg8::gemm_phase(lds, g, e); }
                SITE(19) REP(19) { pg8::Gemm g{(const bf16_t*)(ws + WS_BIG) + C_CKV, (const bf16_t*)(WH + WH_KVB), NROW, 2048, 256, HYB_INP, 256};
                  EpiKV e{ws + WS_R1 + R1_KN, ws + WS_R1 + R1_V, (const float*)(ws + WS_RSTD) + NROW}; pg8::gemm_phase(lds, g, e); }
                SITE(20) REP(20) for (int u = blockIdx.x; u < 528; u += gridDim.x) ssd::g_unit((const bf16_t*)(ws + WS_R2 + R2_BC), (bf16_t*)(ws + WS_BIG + BIG_G), u);
            }
            SITE(5) PH(base + 3) {
                const int xq = (int)blockIdx.x & 7, jq = (int)blockIdx.x >> 3; const bool ssd_wg = (jq & 1) == 0 && gridDim.x == 256;
                if (gridDim.x == 256) {
                    if (ssd_wg) { const int r = jq >> 1, gi = xq + 8 * (r >> 3), hh = r & 7, sb = gi >> 2, sgp = (gi >> 1) & 1, sd = gi & 1;
                        SITE(21) ssd::ssd_unit(sb, 8 * sgp + hh, sd, (const bf16_t*)(ws + WS_R2), (const bf16_t*)(ws + WS_R2 + R2_BC), (const float*)(ws + WS_BIG + BIG_DT), (const bf16_t*)(ws + WS_BIG + BIG_G),
                                               A.in[I_ALOG] + li * 32, sd ? (bf16_t*)(ws + WS_R3) : (bf16_t*)(ws + WS_H), lds); }
                } else {
                    SITE(21) for (int u = blockIdx.x; u < 128; u += gridDim.x) ssd::ssd_unit(u >> 5, (u >> 1) & 15, u & 1, (const bf16_t*)(ws + WS_R2), (const bf16_t*)(ws + WS_R2 + R2_BC), (const float*)(ws + WS_BIG + BIG_DT),
                                               (const bf16_t*)(ws + WS_BIG + BIG_G), A.in[I_ALOG] + li * 32, (u & 1) ? (bf16_t*)(ws + WS_R3) : (bf16_t*)(ws + WS_H), lds);
                }
                const int nmine = gridDim.x == 256 ? (ssd_wg ? 3 : 5) + (L == 0 && !ssd_wg && jq < 8 ? 1 : 0) : 0;
                SITE(22) REP(22) for (int it = 0; gridDim.x == 256 ? it < nmine : (int)blockIdx.x + it * (int)gridDim.x < (L == 0 ? 1056 : 1024); ++it) {
                    int b, h, qrow0, orow0, nt;
                    if (gridDim.x == 256) {
                        const int base_it = ssd_wg ? 3 : 5;
                        if (it < base_it) { const int v = ssd_wg ? 3 * (jq >> 1) + it : 48 + 5 * (jq >> 1) + it; b = v >> 5; h = xq; const int qb = v & 31; qrow0 = 256 + 256 * qb; orow0 = b * 8192 + 256 * qb; nt = NKT; }
                        else { b = jq >> 1; h = xq; qrow0 = 0; orow0 = NLAT + 256 * b; nt = 4; }
                    } else { const int au = (int)blockIdx.x + it * (int)gridDim.x;
                        if (au < 1024) { b = au >> 8; h = au & 7; const int qb = (au >> 3) & 31; qrow0 = 256 + 256 * qb; orow0 = b * 8192 + 256 * qb; nt = NKT; }
                        else { const int cu = au - 1024; b = cu >> 3; h = cu & 7; qrow0 = 0; orow0 = NLAT + 256 * b; nt = 4; } }
                    const size_t bh = (size_t)(b * 8 + h);
                    att8::attn_unit(ws + WS_R1 + R1_Q + (bh * NKEY + qrow0) * 192, ws + WS_R1 + R1_KN + bh * NKT * 8192, ws + WS_BIG + BIG_KR + (size_t)b * NKT * 4096,
                                    ws + WS_R1 + R1_V + bh * NKT * 8192, (bf16_t*)(ws + WS_R3 + R3_CAT) + (size_t)orow0 * 2048 + 1024 + 128 * h, nt, lds);
                }
                if (gridDim.x == 256 && !ssd_wg && L == 2) SITE(11) phase_tabcvt(A, 3, xq + 8 * (jq >> 1), 128, 0, NEXP);
            }
            SITE(6) PH(base + 4) REP(6) { phase_ssd_out(A, li, nr_out(L));
#if defined(MK_CHECK) && MK_CHECK == 1
                if (L == 0) check_attn(A, lds, true);
#elif defined(MK_CHECK) && MK_CHECK == 2
                if (L == 0) check_qkv(A, li, lds);
#elif defined(MK_CHECK) && MK_CHECK == 3
                if (L == 2) check_attn(A, lds, false);
#elif defined(MK_CHECK) && MK_CHECK == 5
                if (L == 0) check_ssd(A, li, lds);
#elif defined(MK_CHECK) && MK_CHECK == 6
                if (L == 2) check_ssd(A, li, lds);
#endif
            }
        } else {
            SITE(7) PH(base + 0) REP(7) { pg8::Gemm g{H, (const bf16_t*)(WG + WG_IN), nr_out(L), 4096, 1024, 1024, 1024};
                pg8::EpiGmIn e{(bf16_t*)(ws + WS_BIG), (float*)(ws + WS_R3)}; pg8::gemm_phase(lds, g, e);
                if (rep == 0 && L == 1) TAIL_TAB((nr_out(L) / 256) * 16, 1, NEXP, 2 * NEXP); }
            SITE(9) PH(base + 2) REP(9) { phase_spatial(A, li, nr_out(L), lds); }
        }
        SITE(10) PH(base + 5) { pg8::Gemm g{hyb ? (const bf16_t*)(ws + WS_R3 + R3_CAT) : (const bf16_t*)(ws + WS_R1), hyb ? (const bf16_t*)(WH + WH_OUT) : (const bf16_t*)(WG + WG_OUT), nr_out(L), 1024, 2048, 2048, 2048};
            pg8::EpiResid e{XB, MODL + 2 * 1024}; pg8::gemm_phase(lds, g, e);
            if (L == 0) TAIL_TAB((nr_out(L) / 256) * 4, 0, 0, 2 * NEXP); else if (L == 1) TAIL_TAB((nr_out(L) / 256) * 4, 2, 0, 2 * NEXP); }
        SITE(11) PH(base + 6) REP(11) { phase_norm_mod<false>(nullptr, nullptr, XB, A.in[I_N2G] + L * 1024, MODL, 3, H, nr_out(L));
            if (gridDim.x != 256) phase_tabcvt(A, L, (int)blockIdx.x, (int)gridDim.x);
            else if (L == 3) phase_tabcvt(A, 3, (int)blockIdx.x, 256, NEXP, 2 * NEXP); }
        SITE(12) PH(base + 7) REP(12) { pg8::Gemm g{H, (const bf16_t*)(WP + WP_Q), nr_out(L), 2048, 1024, 1024, 1024};
            pg8::EpiBf16<0> e{(bf16_t*)(ws + WS_BIG), 2048}; pg8::gemm_phase(lds, g, e);
            if (rep == 0 && L == 0) TAIL_TAB((nr_out(L) / 256) * 8, 1, 0, NEXP); }
        SITE(13) PH(base + 8) REP(13) { phase_topk(A, L, nr_out(L), lds); }
        SITE(14) PH(base + 9) REP(14) { phase_peer_u(A, L, nr_out(L), smem, rep); }
        SITE(15) PH(base + 10) REP(15) { phase_coef(A, L, nr_out(L));
#if defined(MK_CHECK) && MK_CHECK == 4
            if (L == 1) check_topk(A, L, lds);
#endif
        }
        SITE(16) PH(base + 11) { phase_peer_v(A, L, nr_out(L), smem, 0); }
        SITE(17) PH(base + 12) { if (L < DEPTH - 1) phase_norm_mod<false>(nullptr, nullptr, XB, A.in[I_N1G] + (L + 1) * 1024, MOD + (size_t)(L + 1) * 5 * 6144, 0, H, nr_in(L + 1));
                        else {
#ifdef MK_CHECK
                            const float* chk = (const float*)(ws + WS_CTL) + CW_CHK; const float err = sqrtf(chk[0] / fmaxf(chk[1], 1e-30f));
                            phase_final_norm(XB, A.out, A.in[I_FNG], 1.f + 10.f * err);
#else
                            phase_final_norm(XB, A.out, A.in[I_FNG], 1.f);
#endif
                        } }
    }
#undef PH
}

#ifdef MK_TAP
__global__ void tap_kernel(const unsigned short* buf, size_t pitch, size_t col0, size_t ncols, size_t nrows, float* out) {
    const size_t n = ncols * nrows;
    for (size_t i = (size_t)blockIdx.x * blockDim.x + threadIdx.x; i < (size_t)NLAT * D; i += (size_t)gridDim.x * blockDim.x) {
        float s = 0.f; for (size_t j = i; j < n; j += (size_t)NLAT * D) s += (float)buf[(j / ncols) * pitch + col0 + (j % ncols)]; out[i] = s; }
}
#endif
extern "C" void kernel_launch(void* const* d_in, const int* in_sizes, int n_in, void* d_out, int out_size, void* d_ws, size_t ws_size, hipStream_t stream) {
    static int grid = 0;
    if (grid == 0) {
        if (n_in != N_IN || out_size != NLAT * D || ws_size < WS_END) { fprintf(stderr, "kernel_launch: unexpected shapes (n_in %d out %d ws %zu, need %zu)\n", n_in, out_size, ws_size, (size_t)WS_END); grid = -1; return; }
        int dev = 0, cus = 0, per_cu = 0;
        if (hipGetDevice(&dev) != hipSuccess || hipDeviceGetAttribute(&cus, hipDeviceAttributeMultiprocessorCount, dev) != hipSuccess) { grid = -1; return; }
        if (hipFuncSetAttribute((const void*)fwd, hipFuncAttributeMaxDynamicSharedMemorySize, LDS_BYTES) != hipSuccess) { fprintf(stderr, "kernel_launch: hipFuncSetAttribute failed\n"); grid = -1; return; }
        if (hipOccupancyMaxActiveBlocksPerMultiprocessor(&per_cu, (const void*)fwd, NTHR, LDS_BYTES) != hipSuccess || per_cu < 1) { fprintf(stderr, "kernel_launch: occupancy query says %d\n", per_cu); }
        (void)hipGetLastError();
        grid = cus;
    }
    if (grid < 0) return;
    (void)hipMemsetAsync((char*)d_ws + WS_CTL, 0, CTL_BYTES, stream);
    Args a{};
    for (int i = 0; i < N_IN; ++i) a.in[i] = (const float*)d_in[i];
    a.out = (float*)d_out; a.ws = (unsigned char*)d_ws;
#if MK_PER_PHASE
    for (int id = 0; id < 2 + 16 * DEPTH; ++id) {
        if (id >= 2) { const int L = (id - 2) / 16, s = (id - 2) % 16; if (s > 12) continue; if ((L & 1) && (s == 3 || s == 4)) continue; }
#ifdef MK_CUT
#ifdef MK_TAP
        if (id >= MK_CUT) continue;
#else
        if (id >= MK_CUT && id != 2 + 16 * (DEPTH - 1) + 12) continue;
#endif
#endif
        a.ph_lo = id; a.ph_hi = id + 1;
        hipLaunchKernelGGL(fwd, dim3(grid), dim3(NTHR), LDS_BYTES, stream, a);
    }
#ifdef MK_TAP
    { const size_t tp[5] = {MK_TAP}; hipLaunchKernelGGL(tap_kernel, dim3(2048), dim3(256), 0, stream, (const unsigned short*)((const char*)d_ws + tp[0]), tp[1], tp[2], tp[3], tp[4], (float*)d_out); }
#endif
#else
    a.ph_lo = 0; a.ph_hi = 2 + 16 * DEPTH;
    hipLaunchKernelGGL(fwd, dim3(grid), dim3(NTHR), LDS_BYTES, stream, a);
#endif
    const hipError_t le = hipPeekAtLastError();
    if (le != hipSuccess) fprintf(stderr, "kernel_launch: launch failed: %s\n", hipGetErrorName(le));
}
```

```cpp
#include <hip/hip_runtime.h>
#include <cstdio>
#include <cstdint>

#define LAS __attribute__((address_space(3)))
typedef unsigned short bf16_t;
typedef short bf16x8 __attribute__((ext_vector_type(8)));
typedef short s16x4 __attribute__((ext_vector_type(4)));
typedef float f32x2 __attribute__((ext_vector_type(2)));
typedef float f32x4 __attribute__((ext_vector_type(4)));
typedef float f32x16 __attribute__((ext_vector_type(16)));
typedef unsigned u32x2 __attribute__((ext_vector_type(2)));
typedef unsigned u32x4 __attribute__((ext_vector_type(4)));
typedef int i32x4 __attribute__((ext_vector_type(4)));
typedef int i32x8 __attribute__((ext_vector_type(8)));

constexpr int D = 1024, NB = 4, SEQ = 8192, DEPTH = 4, CTXL = 256;
constexpr int NLAT = NB * SEQ, NCTX = NB * CTXL, NROW = NLAT + NCTX;
constexpr int HYB_IN = 3280, HYB_INP = 3328;
constexpr int C_Z = 0, C_XBC = 1024, C_DT = 2560, C_CQ = 2576, C_CKV = 2960, C_KR = 3216;
constexpr int NKEY = SEQ + CTXL, NKT = NKEY / 64;
constexpr float EPS = 1e-6f;
constexpr float QSCALE = 0.07216878364870322f * 1.4426950408889634f;
constexpr int NEXP = 16384;

enum { I_X = 0, I_C, I_CTX, I_CCTX, I_ADAW, I_ADAB, I_N1G, I_N2G, I_HWIN, I_CONVW, I_CONVB, I_ALOG, I_DTB, I_SSDD, I_SSDNG, I_QNG, I_WQB, I_KVNG, I_WKVB,
       I_HWOUT, I_GWIN, I_GLNG, I_GLNB, I_GWS, I_GBS, I_GWOUT, I_PWQ, I_PK1, I_PK2, I_PU, I_PV, I_FNG, N_IN };

constexpr size_t al256(size_t x) { return (x + 255) & ~(size_t)255; }
constexpr size_t WS_CTL = 0, CTL_BYTES = 65536;
constexpr size_t WS_MOD = WS_CTL + CTL_BYTES;
constexpr size_t WS_ROPE = WS_MOD + al256((size_t)DEPTH * 5 * 6144 * 4);
constexpr size_t WS_RSTD = WS_ROPE + (size_t)2 * SEQ * 32 * 4;
constexpr size_t WS_W = WS_RSTD + al256((size_t)2 * NROW * 4);
constexpr size_t W_HYB = 0;
constexpr size_t WH_IN = 0, WH_QB = WH_IN + (size_t)HYB_INP * 1024 * 2, WH_KVB = WH_QB + (size_t)1536 * 384 * 2, WH_OUT = WH_KVB + (size_t)2048 * 256 * 2,
                 WH_SZ = WH_OUT + (size_t)1024 * 2048 * 2;
constexpr size_t W_GM = W_HYB + 2 * WH_SZ;
constexpr size_t WG_IN = 0, WG_OUT = WG_IN + (size_t)4096 * 1024 * 2, WG_WS = WG_OUT + (size_t)1024 * 2048 * 2, WG_SZ = WG_WS + (size_t)8 * 128 * 128 * 2;
constexpr size_t W_PEER = W_GM + 2 * WG_SZ;
constexpr size_t WP_Q = 0, WP_K1 = WP_Q + (size_t)2048 * 1024 * 2, WP_K2 = WP_K1 + (size_t)8 * 128 * 128 * 2, WP_SZ = WP_K2 + (size_t)8 * 128 * 128 * 2;
constexpr size_t W_TOTAL = W_PEER + 4 * WP_SZ;
constexpr size_t WS_TAB = WS_W + al256(W_TOTAL);
constexpr size_t TAB_HALF = (size_t)NEXP * 1024 * 2;
constexpr size_t TAB_REGION = 2 * TAB_HALF + 524288;
constexpr size_t WS_XB = WS_TAB + TAB_REGION;
constexpr size_t WS_H = WS_XB + (size_t)NROW * D * 2;
constexpr size_t WS_BIG = WS_H + (size_t)NROW * D * 2;
constexpr size_t BIG_BYTES = (size_t)NROW * 4096 * 2;
constexpr size_t BIG_DT = (size_t)NROW * HYB_INP * 2;
constexpr size_t BIG_G = BIG_DT + (size_t)NROW * 32 * 4;
constexpr size_t BIG_KR = BIG_G + (size_t)528 * 128 * 128 * 2;
constexpr size_t BIG_PART = (size_t)NROW * 2048 * 2;
static_assert(BIG_KR + (size_t)NB * NKT * 8192 <= BIG_BYTES, "BIG tail");
constexpr size_t WS_R1 = WS_BIG + BIG_BYTES;
constexpr size_t R1_Q = 0, R1_KN = R1_Q + (size_t)NB * 8 * NKEY * 192, R1_V = R1_KN + (size_t)NB * 8 * NKT * 8192, R1_HYB = R1_V + (size_t)NB * 8 * NKT * 8192,
                 R1_GM = (size_t)NROW * 2048 * 2, R1_BYTES = R1_HYB > R1_GM ? R1_HYB : R1_GM;
constexpr size_t WS_R2 = WS_R1 + R1_BYTES;
constexpr size_t R2_BC = (size_t)NROW * 1024 * 2, R2_BYTES = R2_BC + (size_t)NROW * 512 * 2;
constexpr size_t R2_GATE = (size_t)NROW * 128 * 4, R2_COEF = 2 * R2_GATE;
constexpr size_t WS_R3 = WS_R2 + R2_BYTES;
constexpr size_t R3_CAT = (size_t)NROW * 1024 * 2, R3_BYTES = R3_CAT + (size_t)NROW * 2048 * 2;
constexpr size_t WS_END = WS_R3 + R3_BYTES;
static_assert(WS_END <= ((size_t)1 << 30), "workspace must fit 1 GiB");

constexpr int CW_RANK = 3584;
constexpr int CW_QUEUE = 4096;

typedef __bf16 bf16x2_t __attribute__((ext_vector_type(2)));
__device__ __forceinline__ unsigned cvt_pk_bf16(float lo, float hi) { const f32x2 v = {lo, hi}; const bf16x2_t b = __builtin_convertvector(v, bf16x2_t); return __builtin_bit_cast(unsigned, b); }
__device__ __forceinline__ bf16_t f2bf(float f) { return (bf16_t)(cvt_pk_bf16(f, 0.f) & 0xffffu); }
__device__ __forceinline__ float bf2f(unsigned b) { return __uint_as_float(b << 16); }
__device__ __forceinline__ float bflo(unsigned w) { return __uint_as_float(w << 16); }
__device__ __forceinline__ float bfhi(unsigned w) { return __uint_as_float(w & 0xffff0000u); }
__device__ __forceinline__ float wave_sum(float v) {
#pragma unroll
    for (int o = 32; o >= 1; o >>= 1) v += __shfl_xor(v, o);
    return v;
}
__device__ __forceinline__ int otid() { int t = threadIdx.x; asm volatile("" : "+v"(t)); return t; }
__device__ __forceinline__ float silu_f(float x) { return x * __builtin_amdgcn_rcpf(1.f + __expf(-x)); }
__device__ __forceinline__ float softplus_f(float x) { return x > 20.f ? x : log1pf(__expf(x)); }
__device__ __forceinline__ f32x2 gelu_pk(f32x2 v) {
    const f32x2 av = __builtin_elementwise_abs(v), d = av * 0.2316418882f + 1.0f;
    f32x2 t; t.x = __builtin_amdgcn_rcpf(d.x); t.y = __builtin_amdgcn_rcpf(d.y);
    f32x2 q = t * 0.5307027145f + (-0.7265760135f); q = q * t + 0.7107068705f; q = q * t + (-0.142248368f); q = q * t + 0.127414796f; q = q * t;
    const f32x2 s = (v * v) * (-0.72134752044f);
    f32x2 e; e.x = __builtin_amdgcn_exp2f(s.x); e.y = __builtin_amdgcn_exp2f(s.y);
    const f32x2 m = v * (q * e), r = v - m;
    f32x2 o; o.x = v.x < 0.f ? m.x : r.x; o.y = v.y < 0.f ? m.y : r.y; return o;
}
__device__ __forceinline__ float gelu_f(float x) { f32x2 v = {x, 0.f}; return gelu_pk(v).x; }

__device__ __forceinline__ unsigned pk4_fp8(float a, float b, float c, float d) { int w = 0; w = __builtin_amdgcn_cvt_pk_fp8_f32(a, b, w, false); w = __builtin_amdgcn_cvt_pk_fp8_f32(c, d, w, true); return (unsigned)w; }
__device__ __forceinline__ float sat8(float v) { return __builtin_amdgcn_fmed3f(v, -448.f, 448.f); }
__device__ __forceinline__ unsigned pk4_fp8_sat(float a, float b, float c, float d) { return pk4_fp8(sat8(a), sat8(b), sat8(c), sat8(d)); }
__device__ __forceinline__ int row_mb(int r) { return r < NLAT ? (r >> 13) : 4; }

#define XB_TMO      128
#define XB_XCNT(j)  (256  + 64 * (j))
#define XB_XSUB(j)  (1280 + 64 * (j))
#define XB_XGEN(j)  (2304 + 64 * (j))
#define XB_TOP      3328
#define XB_TOPGEN   3392
#define XCD_BAR_WORDS 3456
#define XB_SPIN_CAP (1u << 22)
__device__ __forceinline__ unsigned xb_ld(unsigned* p)              { return __hip_atomic_load(p, __ATOMIC_RELAXED, __HIP_MEMORY_SCOPE_AGENT); }
__device__ __forceinline__ unsigned xb_add(unsigned* p, unsigned v) { return __hip_atomic_fetch_add(p, v, __ATOMIC_RELAXED, __HIP_MEMORY_SCOPE_AGENT); }
__device__ __forceinline__ unsigned xb_xcc_id() { return (unsigned)__builtin_amdgcn_s_getreg((3 << 11) | 20) & 0xFu; }
#define XB_SPIN(cond, bar) do { unsigned _sp = 0; while (cond) { __builtin_amdgcn_s_sleep(1); \
    if ((++_sp & 255u) == 0u) { if (xb_ld(&(bar)[XB_TMO])) break; if (_sp > XB_SPIN_CAP) { atomicAdd(&(bar)[XB_TMO], 1u); break; } } } } while (0)
struct XcdBarrier { unsigned* bar; unsigned x; volatile LAS unsigned* st; };
__device__ __forceinline__ XcdBarrier xcd_barrier_post(unsigned* bar, volatile LAS unsigned* st) {
    XcdBarrier b; b.bar = bar; b.x = xb_xcc_id(); b.st = st;
    if (threadIdx.x == 0) (void)xb_add(&bar[XB_XCNT(b.x)], 1u);
    return b;
}
__device__ __forceinline__ void xcd_barrier_complete(unsigned* bar, unsigned x, unsigned& nloc, unsigned& nx) {
    const unsigned G = gridDim.x * gridDim.y * gridDim.z;
    unsigned sum, cnt, mine, sp = 0u;
    for (;;) {
        sum = 0u; cnt = 0u; mine = 0u;
#pragma unroll
        for (unsigned j = 0; j < 16; ++j) { const unsigned c = xb_ld(&bar[XB_XCNT(j)]); sum += c; cnt += (c > 0u) ? 1u : 0u; mine = (j == x) ? c : mine; }
        if (sum == G) break;
        __builtin_amdgcn_s_sleep(1);
        if ((++sp & 255u) == 0u) { if (xb_ld(&bar[XB_TMO])) break; if (sp > XB_SPIN_CAP) { atomicAdd(&bar[XB_TMO], 1u); break; } }
    }
    nloc = mine > 0u ? mine : 1u; nx = cnt > 0u ? cnt : 1u;
}
__device__ __forceinline__ void xcd_barrier(const XcdBarrier& b) {
    asm volatile("s_waitcnt vmcnt(0)" ::: "memory");
    __syncthreads();
    if (threadIdx.x == 0) {
        unsigned* bar = b.bar;
        __builtin_amdgcn_s_waitcnt(0);
        unsigned nloc = b.st[0], nx = b.st[1];
        if (nloc == 0u) { xcd_barrier_complete(bar, b.x, nloc, nx); b.st[0] = nloc; b.st[1] = nx; }
        const unsigned old = xb_add(&bar[XB_XSUB(b.x)], 1u);
        const unsigned gen = old / nloc;
        if (old + 1u == (gen + 1u) * nloc) {
            __builtin_amdgcn_fence(__ATOMIC_RELEASE, "agent");
            asm volatile("s_waitcnt vmcnt(0)" ::: "memory");
            const unsigned og = xb_add(&bar[XB_TOP], 1u);
            const unsigned tg = og / nx;
            if (og + 1u == (tg + 1u) * nx) xb_add(&bar[XB_TOPGEN], 1u);
            else XB_SPIN(xb_ld(&bar[XB_TOPGEN]) == tg, bar);
            __builtin_amdgcn_fence(__ATOMIC_ACQUIRE, "agent");
            xb_add(&bar[XB_XGEN(b.x)], 1u);
            asm volatile("s_waitcnt vmcnt(0)" ::: "memory");
        } else {
            XB_SPIN(xb_ld(&bar[XB_XGEN(b.x)]) == gen, bar);
            __builtin_amdgcn_fence(__ATOMIC_ACQUIRE, "agent");
            asm volatile("s_waitcnt vmcnt(0)" ::: "memory");
        }
    }
    __syncthreads();
}

namespace pg8 {
constexpr int BM = 256, BK = 64, HALF = 128, HTB = HALF * BK * 2, STAGE_BYTES = 8 * HTB, NXCD = 8, WGM = 8;
__host__ __device__ __forceinline__ int lds_byte(int r, int c) { const int st = (r >> 4) * 2 + (c >> 5), rr = r & 15, cc = c & 31, ob = rr * 64 + cc * 2; return st * 1024 + (ob ^ (((ob >> 9) & 1) << 5)); }
__host__ __device__ __forceinline__ void stage_rc(int b, int& R, int& C) { const int st = b / 1024, sb = b % 1024, swz = sb ^ (((sb >> 9) & 1) << 5); R = (st >> 1) * 16 + swz / 64; C = (st & 1) * 32 + (swz % 64) / 2; }
__host__ __device__ __forceinline__ int perm32(int rho) { const int n = rho >> 4, i = rho & 15; return 8 * (i >> 2) + 4 * n + (i & 3); }
struct Unit { int pm, pn; };
struct Gemm { const bf16_t* A; const bf16_t* Bt; int M, N, K, lda, ldb; };
struct StaticOrder {
    int nM, nN, nwg, G, c;
    __device__ void init(int M, int N, int G_, int c_) { nM = M / BM; nN = N / BM; nwg = nM * nN; G = G_; c = c_; }
    __device__ bool next(int i, Unit& u) const {
        const long L = (long)i * G + c; if (L >= nwg) return false;
        int wgid = (int)L; { const int q = nwg / NXCD, r = nwg % NXCD, xcd = wgid % NXCD, off = wgid / NXCD; wgid = (xcd < r ? xcd * (q + 1) : r * (q + 1) + (xcd - r) * q) + off; }
        const int nig = WGM * nN, gid = wgid / nig, fm = gid * WGM, gsz = (nM - fm) < WGM ? (nM - fm) : WGM;
        u.pm = fm + ((wgid % nig) % gsz); u.pn = (wgid % nig) / gsz; return true;
    }
};
template <class Epi>
__device__ __forceinline__ void gemm_phase(LAS unsigned char* lds, const Gemm g, const Epi& E) {
    const int tid = otid(), wid = __builtin_amdgcn_readfirstlane(tid >> 6), lane = tid & 63, wr = wid >> 2, wc = wid & 3, fr = lane & 15, fq = lane >> 4;
    StaticOrder S; S.init(g.M, g.N, (int)gridDim.x, (int)blockIdx.x);
    int K = g.K; asm volatile("" : "+s"(K));
    const int nt = K / BK;
    unsigned voffA[2], voffB[2];
#pragma unroll
    for (int i = 0; i < 2; ++i) { int R, C; stage_rc(tid * 16 + i * 8192, R, C); const int Rb = Epi::PERM ? ((R & ~31) + perm32(R & 31)) : R;
        voffA[i] = (unsigned)(R * g.lda + C) * 2u; voffB[i] = (unsigned)(Rb * g.ldb + C) * 2u; }
    const size_t kstep = (size_t)(BK * 2);
    const size_t hstepA = (size_t)HALF * g.lda * 2, hstepB = (size_t)HALF * g.ldb * 2;
    const size_t tstepA = 2 * hstepA, tstepB = 2 * hstepB;
    const unsigned ldsw = (unsigned)wid * 1024u;
    const int aoff = lds_byte(wr * 64 + fr, fq * 8), boff = lds_byte(wc * 32 + fr, fq * 8);
#define PG8_SA(b, h) (((b) * 2 + (h)) * HTB)
#define PG8_SB(b, h) ((4 + (b) * 2 + (h)) * HTB)
#define PG8_STAGE(bufoff, gbase, voff) do { _Pragma("unroll") for (int _i = 0; _i < 2; ++_i) \
        __builtin_amdgcn_global_load_lds((const unsigned*)((const char*)(gbase) + (voff)[_i]), (LAS unsigned*)(lds + (bufoff) + ldsw + _i * 8192), 16, 0, 0); } while (0)
#define PG8_LDA(dst, b, h) do { _Pragma("unroll") for (int m = 0; m < 4; ++m) _Pragma("unroll") for (int k = 0; k < 2; ++k) dst[m][k] = *(const LAS bf16x8*)(lds + PG8_SA(b, h) + aoff + m * 2048 + k * 1024); } while (0)
#define PG8_LDB(dst, b, h) do { _Pragma("unroll") for (int n = 0; n < 2; ++n) _Pragma("unroll") for (int k = 0; k < 2; ++k) dst[n][k] = *(const LAS bf16x8*)(lds + PG8_SB(b, h) + boff + n * 2048 + k * 1024); } while (0)
#define PG8_MMA(ai, bj, At, Bt) do { __builtin_amdgcn_s_setprio(1); _Pragma("unroll") for (int m = 0; m < 4; ++m) _Pragma("unroll") for (int n = 0; n < 2; ++n) _Pragma("unroll") for (int k = 0; k < 2; ++k) \
        acc[ai][bj][m][n] = __builtin_amdgcn_mfma_f32_16x16x32_bf16(Bt[n][k], At[m][k], acc[ai][bj][m][n], 0, 0, 0); __builtin_amdgcn_s_setprio(0); } while (0)
#define PG8_WAIT_V(n) asm volatile("s_waitcnt vmcnt(" #n ")" ::: "memory")
#define PG8_WAIT_L(n) asm volatile("s_waitcnt lgkmcnt(" #n ")" ::: "memory")
#define PG8_BAR __builtin_amdgcn_s_barrier()
#define PG8_SCHED __builtin_amdgcn_sched_barrier(0)
    Unit cur, nxt; int ui = 0;
    if (!S.next(0, cur)) return;
    f32x4 acc[2][2][4][2];
#pragma unroll
    for (int a = 0; a < 2; ++a)
#pragma unroll
        for (int b = 0; b < 2; ++b)
#pragma unroll
            for (int m = 0; m < 4; ++m)
#pragma unroll
                for (int n = 0; n < 2; ++n) acc[a][b][m][n] = (f32x4){0.f, 0.f, 0.f, 0.f};
    bf16x8 At[4][2], B0[2][2], B1[2][2];
    const char* cA = (const char*)g.A + (size_t)cur.pm * tstepA; const char* cB = (const char*)g.Bt + (size_t)cur.pn * tstepB;
    PG8_STAGE(PG8_SB(0, 0), cB, voffB); PG8_STAGE(PG8_SB(0, 1), cB + hstepB, voffB); PG8_STAGE(PG8_SA(0, 0), cA, voffA); PG8_STAGE(PG8_SA(0, 1), cA + hstepA, voffA);
    if (wr == 1) PG8_BAR;
    PG8_WAIT_V(2); PG8_BAR;
    PG8_STAGE(PG8_SB(1, 0), cB + kstep, voffB); PG8_STAGE(PG8_SA(1, 0), cA + kstep, voffA); PG8_STAGE(PG8_SB(1, 1), cB + hstepB + kstep, voffB);
    PG8_WAIT_V(6); PG8_BAR;
    for (;;) {
        const bool has_next = S.next(ui + 1, nxt);
        const char* nA = has_next ? (const char*)g.A + (size_t)nxt.pm * tstepA : cA; const char* nB = has_next ? (const char*)g.Bt + (size_t)nxt.pn * tstepB : cB;
        for (int t = 0; t < nt; t += 2) {
            const bool last = (t == nt - 2);
            const char* a1 = cA + (size_t)(t + 1) * kstep;
            const char* a2 = last ? nA : cA + (size_t)(t + 2) * kstep; const char* b2 = last ? nB : cB + (size_t)(t + 2) * kstep;
            const char* a3 = a2 + kstep; const char* b3 = b2 + kstep;
            PG8_LDB(B0, 0, 0); PG8_LDB(B1, 0, 1); PG8_SCHED; PG8_LDA(At, 0, 0); PG8_STAGE(PG8_SA(1, 1), a1 + hstepA, voffA);
            PG8_WAIT_V(8); PG8_WAIT_L(0); PG8_BAR; PG8_MMA(0, 0, At, B0); PG8_MMA(0, 1, At, B1); PG8_BAR; PG8_SCHED;
            PG8_LDA(At, 0, 1); PG8_STAGE(PG8_SB(0, 0), b2, voffB); PG8_STAGE(PG8_SB(0, 1), b2 + hstepB, voffB); PG8_STAGE(PG8_SA(0, 0), a2, voffA);
            PG8_WAIT_V(8); PG8_WAIT_L(0); PG8_BAR; PG8_MMA(1, 0, At, B0); PG8_MMA(1, 1, At, B1); PG8_BAR; PG8_SCHED;
            PG8_LDB(B0, 1, 0); PG8_LDB(B1, 1, 1); PG8_SCHED; PG8_LDA(At, 1, 0); PG8_STAGE(PG8_SA(0, 1), a2 + hstepA, voffA);
            PG8_WAIT_V(8); PG8_WAIT_L(0); PG8_BAR; PG8_MMA(0, 0, At, B0); PG8_MMA(0, 1, At, B1); PG8_BAR; PG8_SCHED;
            PG8_LDA(At, 1, 1); PG8_STAGE(PG8_SB(1, 0), b3, voffB); PG8_STAGE(PG8_SB(1, 1), b3 + hstepB, voffB); PG8_STAGE(PG8_SA(1, 0), a3, voffA);
            PG8_WAIT_V(8); PG8_WAIT_L(0); PG8_BAR; PG8_MMA(1, 0, At, B0); PG8_MMA(1, 1, At, B1); PG8_BAR; PG8_SCHED;
        }
        if (wr == 0) PG8_BAR;
        { const int l2_ = otid() & 63; E(acc, cur, wr, wc, l2_ & 15, l2_ >> 4); }
        if (!has_next) break;
#pragma unroll
        for (int a = 0; a < 2; ++a)
#pragma unroll
            for (int b = 0; b < 2; ++b)
#pragma unroll
                for (int m = 0; m < 4; ++m)
#pragma unroll
                    for (int n = 0; n < 2; ++n) acc[a][b][m][n] = (f32x4){0.f, 0.f, 0.f, 0.f};
        cur = nxt; cA = nA; cB = nB; ++ui;
        if (wr == 1) PG8_BAR;
    }
    PG8_WAIT_V(0);
    PG8_BAR;
#undef PG8_SA
#undef PG8_SB
#undef PG8_STAGE
#undef PG8_LDA
#undef PG8_LDB
#undef PG8_MMA
#undef PG8_WAIT_V
#undef PG8_WAIT_L
#undef PG8_BAR
#undef PG8_SCHED
}

template <int ACT> struct EpiBf16 {
    static constexpr bool PERM = true;
    bf16_t* O; int ldc;
    __device__ __forceinline__ void operator()(const f32x4 (&acc)[2][2][4][2], const Unit& u, int wr, int wc, int fr, int fq) const {
        const int row0 = u.pm * BM + wr * 64 + fr, col0 = u.pn * BM + wc * 32 + 8 * fq;
#pragma unroll
        for (int ai = 0; ai < 2; ++ai)
#pragma unroll
            for (int m = 0; m < 4; ++m) { bf16_t* rowp = O + (size_t)(row0 + ai * HALF + m * 16) * ldc + col0;
#pragma unroll
                for (int bj = 0; bj < 2; ++bj) { f32x4 v0 = acc[ai][bj][m][0], v1 = acc[ai][bj][m][1];
                    if (ACT == 1) { f32x2 a = gelu_pk((f32x2){v0[0], v0[1]}), b = gelu_pk((f32x2){v0[2], v0[3]}), c = gelu_pk((f32x2){v1[0], v1[1]}), d = gelu_pk((f32x2){v1[2], v1[3]});
                        v0 = (f32x4){a.x, a.y, b.x, b.y}; v1 = (f32x4){c.x, c.y, d.x, d.y}; }
                    u32x4 w; w.x = cvt_pk_bf16(v0[0], v0[1]); w.y = cvt_pk_bf16(v0[2], v0[3]); w.z = cvt_pk_bf16(v1[0], v1[1]); w.w = cvt_pk_bf16(v1[2], v1[3]);
                    *(u32x4*)(rowp + bj * HALF) = w; } }
    }
};
struct EpiGmIn {
    static constexpr bool PERM = true;
    bf16_t* O; float* parts;
    __device__ __forceinline__ void operator()(const f32x4 (&acc)[2][2][4][2], const Unit& u, int wr, int wc, int fr, int fq) const {
        const int row0 = u.pm * BM + wr * 64 + fr, col0 = u.pn * BM + wc * 32 + 8 * fq; const bool vhalf = u.pn >= 8;
#pragma unroll
        for (int ai = 0; ai < 2; ++ai)
#pragma unroll
            for (int m = 0; m < 4; ++m) { const int row = row0 + ai * HALF + m * 16; bf16_t* rowp = O + (size_t)row * 4096 + col0; f32x2 sa = {0.f, 0.f}, sq = {0.f, 0.f};
#pragma unroll
                for (int bj = 0; bj < 2; ++bj) { const f32x4 v0 = acc[ai][bj][m][0], v1 = acc[ai][bj][m][1];
                    const f32x2 a = gelu_pk((f32x2){v0[0], v0[1]}), b = gelu_pk((f32x2){v0[2], v0[3]}), c = gelu_pk((f32x2){v1[0], v1[1]}), d = gelu_pk((f32x2){v1[2], v1[3]});
                    sa += (a + b) + (c + d); sq += (a * a + b * b) + (c * c + d * d);
                    u32x4 w; w.x = cvt_pk_bf16(a.x, a.y); w.y = cvt_pk_bf16(b.x, b.y); w.z = cvt_pk_bf16(c.x, c.y); w.w = cvt_pk_bf16(d.x, d.y);
                    *(u32x4*)(rowp + bj * HALF) = w; }
                if (vhalf) { float s1 = sa.x + sa.y, s2 = sq.x + sq.y;
                    { auto r = __builtin_amdgcn_permlane16_swap(__float_as_uint(s1), __float_as_uint(s1), false, false); s1 = __uint_as_float(r[0]) + __uint_as_float(r[1]); }
                    { auto r = __builtin_amdgcn_permlane16_swap(__float_as_uint(s2), __float_as_uint(s2), false, false); s2 = __uint_as_float(r[0]) + __uint_as_float(r[1]); }
                    { auto r = __builtin_amdgcn_permlane32_swap(__float_as_uint(s1), __float_as_uint(s1), false, false); s1 = __uint_as_float(r[0]) + __uint_as_float(r[1]); }
                    { auto r = __builtin_amdgcn_permlane32_swap(__float_as_uint(s2), __float_as_uint(s2), false, false); s2 = __uint_as_float(r[0]) + __uint_as_float(r[1]); }
                    if (fq == 0) *(f32x2*)(parts + ((size_t)row * 32 + (u.pn - 8) * 4 + wc) * 2) = (f32x2){s1, s2}; } }
    }
};
struct EpiResid {
    static constexpr bool PERM = true;
    bf16_t* X; const float* gate;
    __device__ __forceinline__ void operator()(const f32x4 (&acc)[2][2][4][2], const Unit& u, int wr, int wc, int fr, int fq) const {
        const int rbase = u.pm * BM;
        const float* gp = gate + (size_t)(rbase < NLAT ? (rbase >> 13) : 4) * 6144;
        const int row0 = rbase + wr * 64 + fr, col0 = u.pn * BM + wc * 32 + 8 * fq;
        f32x4 gv[2][2];
#pragma unroll
        for (int bj = 0; bj < 2; ++bj)
#pragma unroll
            for (int n = 0; n < 2; ++n) gv[bj][n] = *(const f32x4*)(gp + col0 + bj * HALF + n * 4);
#pragma unroll
        for (int ai = 0; ai < 2; ++ai)
#pragma unroll
            for (int m = 0; m < 4; ++m) { bf16_t* rowp = X + (size_t)(row0 + ai * HALF + m * 16) * D + col0;
#pragma unroll
                for (int bj = 0; bj < 2; ++bj) { u32x4* p = (u32x4*)(rowp + bj * HALF); const u32x4 x = *p;
                    const f32x4 a0 = (f32x4){bflo(x.x), bfhi(x.x), bflo(x.y), bfhi(x.y)} + gv[bj][0] * acc[ai][bj][m][0], a1 = (f32x4){bflo(x.z), bfhi(x.z), bflo(x.w), bfhi(x.w)} + gv[bj][1] * acc[ai][bj][m][1];
                    u32x4 w; w.x = cvt_pk_bf16(a0[0], a0[1]); w.y = cvt_pk_bf16(a0[2], a0[3]); w.z = cvt_pk_bf16(a1[0], a1[1]); w.w = cvt_pk_bf16(a1[2], a1[3]);
                    *p = w; } }
    }
};
}

namespace att {
#define KSWZ(row, colB) ((row) * 256 + ((colB) ^ (((row) & 7) << 4)))
#define KRSWZ(row, colB) ((row) * 128 + ((colB) ^ ((((row) >> 1) & 7) << 4)))
#define SBAR() __builtin_amdgcn_sched_barrier(0)
__device__ __forceinline__ int crow(int r, int hi) { return (r & 3) + 8 * (r >> 2) + 4 * hi; }
__host__ __device__ __forceinline__ int v_st(int k, int c) { const int kk = (k & ~0xC) | ((k & 4) << 1) | ((k & 8) >> 1); return ((kk >> 3) * 4 + (c >> 5)) * 512 + ((kk & 7) * 32 + (c & 31)) * 2; }
__device__ __forceinline__ int v_rd_base(int lane) { return ((lane & 3) << 3) | (((lane >> 2) & 3) << 6) | (((lane >> 4) & 1) << 5) | (((lane >> 5) & 1) << 8); }
constexpr int v_rd_off(int d0, int ks, int half) { return d0 * 512 + ks * 4096 + half * 2048; }
template <int OFF> __device__ __forceinline__ s16x4 tr_read(int vb) {
    s16x4 r; asm volatile("ds_read_b64_tr_b16 %0, %1 offset:%2" : "=&v"(r) : "v"(vb), "i"(OFF) : "memory"); return r;
}
template <int D0> __device__ __forceinline__ void pv_one(f32x16& od, int vb, bf16x8 pa0, bf16x8 pa1, bf16x8 pa2, bf16x8 pa3) {
    const s16x4 l0 = tr_read<v_rd_off(D0, 0, 0)>(vb), h0 = tr_read<v_rd_off(D0, 0, 1)>(vb), l1 = tr_read<v_rd_off(D0, 1, 0)>(vb), h1 = tr_read<v_rd_off(D0, 1, 1)>(vb);
    const s16x4 l2 = tr_read<v_rd_off(D0, 2, 0)>(vb), h2 = tr_read<v_rd_off(D0, 2, 1)>(vb), l3 = tr_read<v_rd_off(D0, 3, 0)>(vb), h3 = tr_read<v_rd_off(D0, 3, 1)>(vb);
    asm volatile("s_waitcnt lgkmcnt(0)" ::: "memory"); SBAR();
#define PK(L, H) (bf16x8){L[0], L[1], L[2], L[3], H[0], H[1], H[2], H[3]}
    od = __builtin_amdgcn_mfma_f32_32x32x16_bf16(pa0, PK(l0, h0), od, 0, 0, 0);
    od = __builtin_amdgcn_mfma_f32_32x32x16_bf16(pa1, PK(l1, h1), od, 0, 0, 0);
    od = __builtin_amdgcn_mfma_f32_32x32x16_bf16(pa2, PK(l2, h2), od, 0, 0, 0);
    od = __builtin_amdgcn_mfma_f32_32x32x16_bf16(pa3, PK(l3, h3), od, 0, 0, 0);
#undef PK
}
__device__ __forceinline__ void pv_d0(f32x16* o, int vb, bf16x8 pa0, bf16x8 pa1, bf16x8 pa2, bf16x8 pa3) {
    pv_one<0>(o[0], vb, pa0, pa1, pa2, pa3); pv_one<1>(o[1], vb, pa0, pa1, pa2, pa3); pv_one<2>(o[2], vb, pa0, pa1, pa2, pa3); pv_one<3>(o[3], vb, pa0, pa1, pa2, pa3);
}
}

namespace att8 {
constexpr int SLOT = 20480, KN_OFF = 0, KR_OFF = 8192, V_OFF = 12288, LDS_BYTES = 3 * SLOT + 8 * 256;
constexpr float THR2 = 8.0f;
constexpr float QUP = 8.f; constexpr int SC_ONE = 0x7f7f7f7f, SC_Q = 0x7c7c7c7c;
__host__ __device__ __forceinline__ int kn8(int key, int b) { return key * 128 + ((((b >> 4) ^ ((key >> 1) & 7))) << 4) + (b & 15); }
__host__ __device__ __forceinline__ int kr8(int key, int b) { return key * 64 + ((((b >> 4) ^ ((key >> 2) & 3))) << 4) + (b & 15); }
__host__ __device__ __forceinline__ int vslot(int k) { return 32 * ((k >> 2) & 1) + 16 * (k >> 5) + (k & 3) + 4 * ((k & 31) >> 3); }
__host__ __device__ __forceinline__ int v8(int d, int k) { const int sl = vslot(k); return d * 64 + ((((sl >> 4) ^ ((d >> 2) & 3))) << 4) + (sl & 15); }
__device__ __forceinline__ i32x8 ld32(const LAS unsigned char* a0, const LAS unsigned char* a1) { const u32x4 x = *(const LAS u32x4*)a0, y = *(const LAS u32x4*)a1;
    return (i32x8){(int)x.x, (int)x.y, (int)x.z, (int)x.w, (int)y.x, (int)y.y, (int)y.z, (int)y.w}; }
__device__ __forceinline__ void qkt(f32x16& p0, f32x16& p1, LAS unsigned char* slot, const i32x8* qf, int r32, int hi) {
    p0 = f32x16{}; p1 = f32x16{};
#pragma unroll
    for (int ks = 0; ks < 2; ++ks) { const int b = 64 * ks + 32 * hi;
        const i32x8 a0 = ld32(slot + KN_OFF + kn8(r32, b), slot + KN_OFF + kn8(r32, b + 16)), a1 = ld32(slot + KN_OFF + kn8(32 + r32, b), slot + KN_OFF + kn8(32 + r32, b + 16));
        p0 = __builtin_amdgcn_mfma_scale_f32_32x32x64_f8f6f4(a0, qf[ks], p0, 0, 0, 0, SC_ONE, 0, SC_Q);
        p1 = __builtin_amdgcn_mfma_scale_f32_32x32x64_f8f6f4(a1, qf[ks], p1, 0, 0, 0, SC_ONE, 0, SC_Q); }
    { const int b = 32 * hi;
        const i32x8 a0 = ld32(slot + KR_OFF + kr8(r32, b), slot + KR_OFF + kr8(r32, b + 16)), a1 = ld32(slot + KR_OFF + kr8(32 + r32, b), slot + KR_OFF + kr8(32 + r32, b + 16));
        p0 = __builtin_amdgcn_mfma_scale_f32_32x32x64_f8f6f4(a0, qf[2], p0, 0, 0, 0, SC_ONE, 0, SC_Q);
        p1 = __builtin_amdgcn_mfma_scale_f32_32x32x64_f8f6f4(a1, qf[2], p1, 0, 0, 0, SC_ONE, 0, SC_Q); }
}
__device__ __forceinline__ void partialSM(f32x16& p0, f32x16& p1, float& m_reg, float& mn, float& alpha) {
    float pmax = p0[0];
#pragma unroll
    for (int r = 1; r < 16; ++r) pmax = fmaxf(pmax, p0[r]);
#pragma unroll
    for (int r = 0; r < 16; ++r) pmax = fmaxf(pmax, p1[r]);
    { auto rr = __builtin_amdgcn_permlane32_swap(__float_as_uint(pmax), __float_as_uint(pmax), false, false);
      pmax = fmaxf(__uint_as_float(rr[0]), __uint_as_float(rr[1])); }
    if (__builtin_expect(__all(pmax - m_reg <= THR2), 1)) { mn = m_reg; alpha = 1.f; }
    else { mn = fmaxf(m_reg, pmax); alpha = __builtin_amdgcn_exp2f(m_reg - mn); m_reg = mn; }
#pragma unroll
    for (int r = 0; r < 16; ++r) p0[r] = __builtin_amdgcn_exp2f(p0[r] - mn);
#pragma unroll
    for (int r = 0; r < 16; ++r) p1[r] = p1[r] - mn;
}
__device__ __forceinline__ void finishSM(f32x16& p0, f32x16& p1, float alpha, float& l_reg, i32x8& pf) {
#pragma unroll
    for (int r = 0; r < 16; ++r) p1[r] = __builtin_amdgcn_exp2f(p1[r]);
    float ps = 0;
#pragma unroll
    for (int r = 0; r < 16; ++r) ps += p0[r];
#pragma unroll
    for (int r = 0; r < 16; ++r) ps += p1[r];
    { auto rr = __builtin_amdgcn_permlane32_swap(__float_as_uint(ps), __float_as_uint(ps), false, false);
      ps = __uint_as_float(rr[0]) + __uint_as_float(rr[1]); }
    l_reg = l_reg * alpha + ps;
#pragma unroll
    for (int w = 0; w < 4; ++w) { pf[w] = (int)pk4_fp8(p0[4 * w], p0[4 * w + 1], p0[4 * w + 2], p0[4 * w + 3]); pf[4 + w] = (int)pk4_fp8(p1[4 * w], p1[4 * w + 1], p1[4 * w + 2], p1[4 * w + 3]); }
}
__device__ __forceinline__ void pv(f32x16* o, LAS unsigned char* slot, const i32x8 pf, int r32, int hi) {
#pragma unroll
    for (int d0 = 0; d0 < 4; ++d0) { const int d = 32 * d0 + r32, sw = (d >> 2) & 3;
        const i32x8 b = ld32(slot + V_OFF + d * 64 + (((2 * hi) ^ sw) << 4), slot + V_OFF + d * 64 + (((2 * hi + 1) ^ sw) << 4));
        o[d0] = __builtin_amdgcn_mfma_scale_f32_32x32x64_f8f6f4(pf, b, o[d0], 0, 0, 0, SC_ONE, 0, SC_ONE); }
}
__device__ __forceinline__ int crow(int r, int hi) { return (r & 3) + 8 * (r >> 2) + 4 * hi; }
__device__ __forceinline__ void attn_unit(const unsigned char* __restrict__ Qb, const unsigned char* __restrict__ KNt, const unsigned char* __restrict__ KRt, const unsigned char* __restrict__ Vt,
                                          bf16_t* __restrict__ Ob, int NT, LAS unsigned char* lds) {
    const int tid = otid(), wid = __builtin_amdgcn_readfirstlane(tid >> 6), lane = tid & 63, r32 = lane & 31, hi = lane >> 5;
    LAS float* wsf = (LAS float*)(lds + 3 * SLOT) + wid * 64; LAS float* li_l = wsf; LAS float* al_l = wsf + 32;
    float m_reg = -1e30f, l_reg = 0; f32x16 o[4] = {}; i32x8 qf[3];
    const unsigned char* Qw = Qb + (size_t)(wid * 32 + r32) * 192 + 32 * hi;
#pragma unroll
    for (int ks = 0; ks < 3; ++ks) { const u32x4 x = *(const u32x4*)(Qw + 64 * ks), y = *(const u32x4*)(Qw + 64 * ks + 16); qf[ks] = (i32x8){(int)x.x, (int)x.y, (int)x.z, (int)x.w, (int)y.x, (int)y.y, (int)y.z, (int)y.w}; }
    const unsigned lo16 = (unsigned)lane * 16u;
#define ATT_DMA(tile, slotoff) do { const size_t t_ = (size_t)(tile); LAS unsigned char* sl_ = lds + (slotoff); \
        __builtin_amdgcn_global_load_lds((const unsigned*)(KNt + t_ * 8192 + wid * 1024 + lo16), (LAS unsigned*)(sl_ + KN_OFF + wid * 1024), 16, 0, 0); \
        __builtin_amdgcn_global_load_lds((const unsigned*)(Vt + t_ * 8192 + wid * 1024 + lo16), (LAS unsigned*)(sl_ + V_OFF + wid * 1024), 16, 0, 0); \
        if (wid < 4) __builtin_amdgcn_global_load_lds((const unsigned*)(KRt + t_ * 4096 + wid * 1024 + lo16), (LAS unsigned*)(sl_ + KR_OFF + wid * 1024), 16, 0, 0); } while (0)
#define ATT_SYNC() do { asm volatile("s_waitcnt vmcnt(0)" ::: "memory"); __builtin_amdgcn_s_barrier(); asm volatile("" ::: "memory"); } while (0)
#define RESC(a) do { if (__any((a) < 1.f)) { if (hi == 0) al_l[r32] = (a); asm volatile("s_waitcnt lgkmcnt(0)" ::: "memory"); \
        _Pragma("unroll") for (int d = 0; d < 4; ++d) _Pragma("unroll") for (int r = 0; r < 16; ++r) o[d][r] *= al_l[crow(r, hi)]; } } while (0)
    f32x16 pA0, pA1, pB0, pB1; float mnA, mnB, alA, alB; i32x8 pf;
    int sp = 0, sc = SLOT, sn = 2 * SLOT;
    ATT_DMA(0, 0);
    ATT_SYNC();
    ATT_DMA(1, SLOT);
    qkt(pA0, pA1, lds, qf, r32, hi); partialSM(pA0, pA1, m_reg, mnA, alA);
    for (int j = 1; j + 1 < NT; j += 2) {
        ATT_SYNC(); ATT_DMA(j + 1, sn);
        SBAR(); qkt(pB0, pB1, lds + sc, qf, r32, hi);
        finishSM(pA0, pA1, alA, l_reg, pf); SBAR();
        pv(o, lds + sp, pf, r32, hi); partialSM(pB0, pB1, m_reg, mnB, alB);
        RESC(alB);
        { const int t_ = sp; sp = sc; sc = sn; sn = t_; }
        ATT_SYNC(); if (j + 2 < NT) ATT_DMA(j + 2, sn);
        SBAR(); qkt(pA0, pA1, lds + sc, qf, r32, hi);
        finishSM(pB0, pB1, alB, l_reg, pf); SBAR();
        pv(o, lds + sp, pf, r32, hi); partialSM(pA0, pA1, m_reg, mnA, alA);
        RESC(alA);
        { const int t_ = sp; sp = sc; sc = sn; sn = t_; }
    }
    ATT_SYNC();
    SBAR(); qkt(pB0, pB1, lds + sc, qf, r32, hi);
    finishSM(pA0, pA1, alA, l_reg, pf); SBAR();
    pv(o, lds + sp, pf, r32, hi); partialSM(pB0, pB1, m_reg, mnB, alB);
    RESC(alB);
    finishSM(pB0, pB1, alB, l_reg, pf); SBAR();
    pv(o, lds + sc, pf, r32, hi);
    if (hi == 0) li_l[r32] = l_reg; asm volatile("s_waitcnt lgkmcnt(0)" ::: "memory");
    float rli[16];
#pragma unroll
    for (int r = 0; r < 16; ++r) rli[r] = __builtin_amdgcn_rcpf(li_l[crow(r, hi)]);
    bf16_t* Ow = Ob + (size_t)(wid * 32) * 2048;
#pragma unroll
    for (int r = 0; r < 16; ++r) { const int orow = crow(r, hi);
#pragma unroll
        for (int d0 = 0; d0 < 4; ++d0) Ow[(size_t)orow * 2048 + d0 * 32 + r32] = f2bf(o[d0][r] * rli[r]); }
    __builtin_amdgcn_s_barrier(); asm volatile("" ::: "memory");
#undef ATT_DMA
#undef ATT_SYNC
#undef RESC
}
}

namespace ssd {
constexpr int XT_OFF = 0, BT_OFF = 17408, HB_OFF = 52224, SET = 69632, CW_OFF = 2 * SET, LDS_BYTES = CW_OFF + 8 * 1536;
constexpr int PITCH = 272;
constexpr float L2E = 1.4426950408889634f;
__device__ __forceinline__ void g_unit(const bf16_t* __restrict__ BC, bf16_t* __restrict__ G, int unit) {
    const int cid = unit >> 1, g = unit & 1;
    const int r0 = cid < 256 ? cid * 128 : NLAT + (cid - 256) * 128;
    const int tid = otid(), wid = tid >> 6, lane = tid & 63, fr = lane & 15, fq = lane >> 4;
    const bf16_t* Cp = BC + (size_t)(r0 + 16 * wid + fr) * 512 + 256 + 128 * g + 8 * fq;
    bf16x8 cf[4];
#pragma unroll
    for (int ks = 0; ks < 4; ++ks) cf[ks] = *(const bf16x8*)(Cp + 32 * ks);
    bf16_t* Gp = G + ((size_t)unit * 128 + 16 * wid + fr) * 128 + 4 * fq;
#pragma unroll
    for (int sb = 0; sb < 8; ++sb) {
        const bf16_t* Bp = BC + (size_t)(r0 + 16 * sb + fr) * 512 + 128 * g + 8 * fq;
        f32x4 acc = {0.f, 0.f, 0.f, 0.f};
#pragma unroll
        for (int ks = 0; ks < 4; ++ks) { const bf16x8 bfr = *(const bf16x8*)(Bp + 32 * ks); acc = __builtin_amdgcn_mfma_f32_16x16x32_bf16(bfr, cf[ks], acc, 0, 0, 0); }
        u32x2 w; w.x = cvt_pk_bf16(acc[0], acc[1]); w.y = cvt_pk_bf16(acc[2], acc[3]);
        *(u32x2*)(Gp + 16 * sb) = w;
    }
}
__device__ __forceinline__ void ssd_unit(int b, int h, int d, const bf16_t* __restrict__ XS, const bf16_t* __restrict__ BC, const float* __restrict__ DT, const bf16_t* __restrict__ G,
                                         const float* __restrict__ a_log, bf16_t* __restrict__ Y, LAS unsigned char* lds) {
    const int g = h >> 3;
    const int tid = otid(), wid = tid >> 6, lane = tid & 63, fr = lane & 15, fq = lane >> 4;
    const float a = -__expf(a_log[d * 16 + h]);
    LAS float* cw = (LAS float*)(lds + CW_OFF + wid * 1536); LAS float* dts = cw + 128; LAS float* dtw = cw + 256;
    f32x4 hs[4];
#pragma unroll
    for (int q = 0; q < 4; ++q) hs[q] = (f32x4){0.f, 0.f, 0.f, 0.f};
    for (int i = tid; i < 17408 / 4; i += 512) ((LAS unsigned*)(lds + HB_OFF))[i] = 0u;
    float cend = 0.f;
#define SSD_ROWS(step, r0v, gidv) do { if ((step) < 2) { const int oc_ = d ? 1 - (step) : (step); r0v = NLAT + b * 256 + oc_ * 128; gidv = 256 + b * 2 + oc_; } \
        else { const int lc_ = (step) - 2, oc_ = d ? 63 - lc_ : lc_; r0v = b * 8192 + oc_ * 128; gidv = b * 64 + oc_; } } while (0)
    const int sg = tid & 31, n8 = tid >> 5, p4 = tid >> 5;
    f32x2 P_da, Q_da; u32x2 P_xv[4], Q_xv[4]; u32x4 P_bv[4], Q_bv[4], n_gv[4], n_cv[4], c_gv[4], c_cv[4];
#define SSD_LOAD(step, X) do { int r0_, gid_; SSD_ROWS(step, r0_, gid_); (void)gid_; X##_da = *(const f32x2*)(DT + (size_t)(d * 16 + h) * NROW + r0_ + 2 * lane); \
        _Pragma("unroll") for (int j_ = 0; j_ < 4; ++j_) { X##_xv[j_] = *(const u32x2*)(XS + (size_t)(r0_ + 4 * sg + j_) * 1024 + 64 * h + 4 * p4); \
                                                         X##_bv[j_] = *(const u32x4*)(BC + (size_t)(r0_ + 4 * sg + j_) * 512 + 128 * g + 8 * n8); } } while (0)
#define SSD_LOADGC(step) do { int r0_, gid_; SSD_ROWS(step, r0_, gid_); const int t_ = 16 * wid + fr; const bf16_t* Gp_ = G + ((size_t)(gid_ * 2 + g) * 128 + t_) * 128 + 8 * fq; const bf16_t* Cp_ = BC + (size_t)(r0_ + t_) * 512 + 256 + 128 * g + 8 * fq; \
          _Pragma("unroll") for (int ks_ = 0; ks_ < 4; ++ks_) { n_gv[ks_] = *(const u32x4*)(Gp_ + 32 * ks_); n_cv[ks_] = *(const u32x4*)(Cp_ + 32 * ks_); } } while (0)
#define SSD_GCROT() do { _Pragma("unroll") for (int ks_ = 0; ks_ < 4; ++ks_) { c_gv[ks_] = n_gv[ks_]; c_cv[ks_] = n_cv[ks_]; } } while (0)
#define SSD_WRITE(step, X) do { LAS unsigned char* set_ = lds + ((step) & 1) * SET; \
        const float da0 = X##_da.x * a, da1 = X##_da.y * a; \
        float sc_ = da0 + da1; float c0_, c1_; \
        if (d == 0) { _Pragma("unroll") for (int o_ = 1; o_ < 64; o_ <<= 1) { const float t_ = __shfl_up(sc_, o_); if (lane >= o_) sc_ += t_; } \
            c0_ = sc_ - da1; c1_ = sc_; cend = __shfl(sc_, 63); } \
        else { _Pragma("unroll") for (int o_ = 1; o_ < 64; o_ <<= 1) { const float t_ = __shfl_down(sc_, o_); if (lane + o_ < 64) sc_ += t_; } \
            c0_ = sc_; c1_ = sc_ - da0; cend = __shfl(sc_, 0); } \
        *(LAS f32x2*)(cw + 2 * lane) = (f32x2){c0_, c1_}; *(LAS f32x2*)(dts + 2 * lane) = X##_da; \
        *(LAS f32x2*)(dtw + 2 * lane) = (f32x2){X##_da.x * __builtin_amdgcn_exp2f((cend - c0_) * L2E), X##_da.y * __builtin_amdgcn_exp2f((cend - c1_) * L2E)}; \
        { LAS unsigned char* xt_ = set_ + XT_OFF + (4 * p4) * PITCH + 8 * sg; \
          _Pragma("unroll") for (int i_ = 0; i_ < 4; ++i_) { unsigned e_[4]; \
              _Pragma("unroll") for (int j_ = 0; j_ < 4; ++j_) { const unsigned w_ = (i_ & 2) ? X##_xv[j_].y : X##_xv[j_].x; e_[j_] = (i_ & 1) ? (w_ >> 16) : (w_ & 0xffffu); } \
              u32x2 o_; o_.x = e_[0] | (e_[1] << 16); o_.y = e_[2] | (e_[3] << 16); *(LAS u32x2*)(xt_ + i_ * PITCH) = o_; } } \
        { LAS unsigned char* bt_ = set_ + BT_OFF + (8 * n8) * PITCH + 8 * sg; \
          _Pragma("unroll") for (int i_ = 0; i_ < 8; ++i_) { unsigned e_[4]; \
              _Pragma("unroll") for (int j_ = 0; j_ < 4; ++j_) { const unsigned w_ = X##_bv[j_][i_ >> 1]; e_[j_] = (i_ & 1) ? (w_ >> 16) : (w_ & 0xffffu); } \
              u32x2 o_; o_.x = e_[0] | (e_[1] << 16); o_.y = e_[2] | (e_[3] << 16); *(LAS u32x2*)(bt_ + i_ * PITCH) = o_; } } \
        asm volatile("s_waitcnt lgkmcnt(0)" ::: "memory"); \
    } while (0)
    SSD_LOAD(0, Q); SSD_LOADGC(0); SSD_WRITE(0, Q); SSD_LOAD(1, P);
    for (int step2 = 0; step2 < 66; step2 += 2)
#pragma unroll
    for (int par = 0; par < 2; ++par) {
        const int step = step2 + par;
        __syncthreads();
        int r0, gid; SSD_ROWS(step, r0, gid); (void)gid;
        LAS unsigned char* set = lds + (step & 1) * SET;
        const float cend_cur = cend;
        SSD_GCROT();
        if (step + 1 < 66) SSD_LOADGC(step + 1);
        if (step + 2 < 66) { if (par == 0) SSD_LOAD(step + 2, Q); else SSD_LOAD(step + 2, P); }
        {
            const int t = 16 * wid + fr; const float ct = cw[t];
            f32x4 y[4];
#pragma unroll
            for (int q = 0; q < 4; ++q) y[q] = (f32x4){0.f, 0.f, 0.f, 0.f};
            const float et = __builtin_amdgcn_exp2f(ct * L2E);
#pragma unroll
            for (int ks = 0; ks < 4; ++ks) {
                const bool live = d == 0 ? (32 * ks <= 16 * wid + 15) : (32 * ks + 31 >= 16 * wid);
                if (live) {
                    const int s0 = 32 * ks + 8 * fq;
                    const f32x4 c0 = *(const LAS f32x4*)(cw + s0), c1 = *(const LAS f32x4*)(cw + s0 + 4), d0v = *(const LAS f32x4*)(dts + s0), d1v = *(const LAS f32x4*)(dts + s0 + 4);
                    float m[8];
#pragma unroll
                    for (int i = 0; i < 8; ++i) { const float cs = i < 4 ? c0[i & 3] : c1[i & 3], dv = i < 4 ? d0v[i & 3] : d1v[i & 3]; const int s = s0 + i;
                        const bool ok = d == 0 ? (s <= t) : (s >= t);
                        const float gval = (i & 1) ? bfhi(c_gv[ks][i >> 1]) : bflo(c_gv[ks][i >> 1]);
                        m[i] = ok ? gval * dv * __builtin_amdgcn_exp2f((ct - cs) * L2E) : 0.f; }
                    u32x4 mw; mw.x = cvt_pk_bf16(m[0], m[1]); mw.y = cvt_pk_bf16(m[2], m[3]); mw.z = cvt_pk_bf16(m[4], m[5]); mw.w = cvt_pk_bf16(m[6], m[7]);
                    const bf16x8 mb = __builtin_bit_cast(bf16x8, mw);
#pragma unroll
                    for (int q = 0; q < 4; ++q) { const bf16x8 af = *(const LAS bf16x8*)(set + XT_OFF + (16 * q + fr) * PITCH + (32 * ks + 8 * fq) * 2);
                        y[q] = __builtin_amdgcn_mfma_f32_16x16x32_bf16(af, mb, y[q], 0, 0, 0); }
                }
            }
#pragma unroll
            for (int ks = 0; ks < 4; ++ks) {
                u32x4 cwv;
#pragma unroll
                for (int i = 0; i < 4; ++i) cwv[i] = cvt_pk_bf16(bflo(c_cv[ks][i]) * et, bfhi(c_cv[ks][i]) * et);
                const bf16x8 cb = __builtin_bit_cast(bf16x8, cwv);
#pragma unroll
                for (int q = 0; q < 4; ++q) { const bf16x8 af = *(const LAS bf16x8*)(set + HB_OFF + (16 * q + fr) * PITCH + (32 * ks + 8 * fq) * 2);
                    y[q] = __builtin_amdgcn_mfma_f32_16x16x32_bf16(af, cb, y[q], 0, 0, 0); }
            }
            bf16_t* yp = Y + (size_t)(r0 + t) * 1024 + 64 * h + 4 * fq;
#pragma unroll
            for (int q = 0; q < 4; ++q) { u32x2 w; w.x = cvt_pk_bf16(y[q][0], y[q][1]); w.y = cvt_pk_bf16(y[q][2], y[q][3]); *(u32x2*)(yp + 16 * q) = w; }
        }
        {
            const float dec = __builtin_amdgcn_exp2f(cend_cur * L2E);
#pragma unroll
            for (int q = 0; q < 4; ++q) hs[q] = hs[q] * dec;
#pragma unroll
            for (int ks = 0; ks < 4; ++ks) {
                const int s0 = 32 * ks + 8 * fq;
                const u32x4 braw = *(const LAS u32x4*)(set + BT_OFF + (16 * wid + fr) * PITCH + s0 * 2);
                const f32x4 w0 = *(const LAS f32x4*)(dtw + s0), w1 = *(const LAS f32x4*)(dtw + s0 + 4);
                u32x4 bw; bw.x = cvt_pk_bf16(bflo(braw.x) * w0[0], bfhi(braw.x) * w0[1]); bw.y = cvt_pk_bf16(bflo(braw.y) * w0[2], bfhi(braw.y) * w0[3]);
                          bw.z = cvt_pk_bf16(bflo(braw.z) * w1[0], bfhi(braw.z) * w1[1]); bw.w = cvt_pk_bf16(bflo(braw.w) * w1[2], bfhi(braw.w) * w1[3]);
                const bf16x8 bfr = __builtin_bit_cast(bf16x8, bw);
#pragma unroll
                for (int q = 0; q < 4; ++q) { const bf16x8 af = *(const LAS bf16x8*)(set + XT_OFF + (16 * q + fr) * PITCH + s0 * 2);
                    hs[q] = __builtin_amdgcn_mfma_f32_16x16x32_bf16(af, bfr, hs[q], 0, 0, 0); }
            }
            LAS bf16_t* hb = (LAS bf16_t*)(lds + ((step + 1) & 1) * SET + HB_OFF) + 16 * wid + fr;
#pragma unroll
            for (int q = 0; q < 4; ++q)
#pragma unroll
                for (int i = 0; i < 4; ++i) hb[(16 * q + 4 * fq + i) * 136] = f2bf(hs[q][i]);
        }
        if (step + 1 < 66) { if (par == 0) SSD_WRITE(step + 1, P); else SSD_WRITE(step + 1, Q); }
    }
    __syncthreads();
#undef SSD_ROWS
#undef SSD_LOAD
#undef SSD_LOADGC
#undef SSD_GCROT
#undef SSD_WRITE
}
}

struct Args { const float* in[32]; float* out; unsigned char* ws; int ph_lo, ph_hi; };
constexpr int NTHR = 512;
constexpr int LDS_BASE = 256;
constexpr int LDS_PHASE = 151808;
constexpr int LDS_BYTES = LDS_BASE + LDS_PHASE;
static_assert(att8::LDS_BYTES <= LDS_PHASE && ssd::LDS_BYTES <= LDS_PHASE && pg8::STAGE_BYTES <= LDS_PHASE, "LDS");

__device__ __forceinline__ void tjob(int j, const Args& A, const float*& src, bf16_t*& dst, int& K, int& N, int& Npad, int& mode, const float*& ks) {
    unsigned char* W = A.ws + WS_W; mode = 0; ks = nullptr;
    if (j < 8) { const int i = j >> 2, w = j & 3; unsigned char* base = W + W_HYB + (size_t)i * WH_SZ;
        if (w == 0)      { src = A.in[I_HWIN] + (size_t)i * 1024 * HYB_IN; dst = (bf16_t*)(base + WH_IN); K = 1024; N = HYB_IN; Npad = HYB_INP; mode = 1; }
        else if (w == 1) { src = A.in[I_WQB] + (size_t)i * 384 * 1536; dst = (bf16_t*)(base + WH_QB); K = 384; N = 1536; Npad = 1536; mode = 2; ks = A.in[I_QNG] + i * 384; }
        else if (w == 2) { src = A.in[I_WKVB] + (size_t)i * 256 * 2048; dst = (bf16_t*)(base + WH_KVB); K = 256; N = 2048; Npad = 2048; ks = A.in[I_KVNG] + i * 256; }
        else             { src = A.in[I_HWOUT] + (size_t)i * 2048 * 1024; dst = (bf16_t*)(base + WH_OUT); K = 2048; N = 1024; Npad = 1024; }
    } else if (j < 12) { const int i = (j - 8) >> 1, w = (j - 8) & 1; unsigned char* base = W + W_GM + (size_t)i * WG_SZ;
        if (w == 0) { src = A.in[I_GWIN] + (size_t)i * 1024 * 4096; dst = (bf16_t*)(base + WG_IN); K = 1024; N = 4096; Npad = 4096; }
        else        { src = A.in[I_GWOUT] + (size_t)i * 2048 * 1024; dst = (bf16_t*)(base + WG_OUT); K = 2048; N = 1024; Npad = 1024; }
    } else { const int l = j - 12; src = A.in[I_PWQ] + (size_t)l * 1024 * 2048; dst = (bf16_t*)(W + W_PEER + (size_t)l * WP_SZ + WP_Q); K = 1024; N = 2048; Npad = 2048; }
}
__device__ __forceinline__ int colmap(int mode, int n, int N) {
    if (mode == 1) { if (n >= N) return -1; if (n < C_KR) return n; const int m = n - C_KR; return C_KR + (m >> 1) + 32 * (m & 1); }
    if (mode == 2) { if (n < 1024) return (n >> 7) * 192 + (n & 127); const int m = n - 1024, h = m >> 6, mm = m & 63; return h * 192 + 128 + (mm >> 1) + 32 * (mm & 1); }
    return n;
}
__device__ __forceinline__ void phase_prologue(const Args& A, LAS unsigned char* lds) {
    const int tid = otid();
    {
        LAS float* tile = (LAS float*)lds;
        const float* c_src = nullptr; bf16_t* c_dst = nullptr; const float* c_ks = nullptr; int c_K = 0, c_N = 0, c_mode = 0, c_nsub = 0, c_k0 = 0, c_n0 = 0;
        int j = 0, item = blockIdx.x; bool have = false;
#define TR_LOCATE() do { have = false; \
            while (j < 16) { int Npad_; tjob(j, A, c_src, c_dst, c_K, c_N, Npad_, c_mode, c_ks); \
                c_nsub = (c_K % 256 == 0) ? 4 : 2; const int tk_ = c_K / (64 * c_nsub), nt_ = tk_ * (Npad_ / 64); \
                if (item < nt_) { c_k0 = (item % tk_) * 64 * c_nsub; c_n0 = (item / tk_) * 64; have = true; break; } \
                item -= nt_; ++j; } } while (0)
        float v[4][8], scv[4];
#define TR_LOAD() do { const int k = tid >> 3, cg = tid & 7; \
            _Pragma("unroll") for (int t = 0; t < 4; ++t) if (t < c_nsub) { scv[t] = c_ks ? c_ks[c_k0 + 64 * t + k] : 1.f; \
                _Pragma("unroll") for (int jj = 0; jj < 8; ++jj) { const int oc = colmap(c_mode, c_n0 + 8 * cg + jj, c_N); v[t][jj] = oc >= 0 ? c_src[(size_t)(c_k0 + 64 * t + k) * c_N + oc] : 0.f; } } } while (0)
        TR_LOCATE();
        if (have) TR_LOAD();
        int buf = 0;
        while (have) {
            const int nsub = c_nsub, K = c_K, k0 = c_k0, n0 = c_n0; bf16_t* dst = c_dst;
            { const int k = tid >> 3, cg = tid & 7;
#pragma unroll
              for (int t = 0; t < 4; ++t) if (t < nsub) {
#pragma unroll
                  for (int jj = 0; jj < 8; ++jj) tile[buf * 16640 + t * 4160 + k * 65 + 8 * cg + jj] = v[t][jj] * scv[t]; } }
            item += gridDim.x; TR_LOCATE();
            if (have) TR_LOAD();
            __syncthreads();
            { const int n = tid >> 3, kg = tid & 7;
#pragma unroll
              for (int t = 0; t < 4; ++t) if (t < nsub) { float o[8];
#pragma unroll
                  for (int jj = 0; jj < 8; ++jj) o[jj] = tile[buf * 16640 + t * 4160 + (8 * kg + jj) * 65 + n];
                  u32x4 w; w.x = cvt_pk_bf16(o[0], o[1]); w.y = cvt_pk_bf16(o[2], o[3]); w.z = cvt_pk_bf16(o[4], o[5]); w.w = cvt_pk_bf16(o[6], o[7]);
                  *(u32x4*)(dst + (size_t)(n0 + n) * K + k0 + 64 * t + 8 * kg) = w; } }
            buf ^= 1;
        }
#undef TR_LOCATE
#undef TR_LOAD
    }
    {
        const int gthr = blockIdx.x * NTHR + tid, nthr = gridDim.x * NTHR;
        for (int p = gthr; p < 10 * 16384; p += nthr) {
            const int mat = p >> 14, off = (p & 16383) * 8; const float* src; bf16_t* dst;
            if (mat < 2)      { src = A.in[I_GWS] + (size_t)mat * 131072; dst = (bf16_t*)(A.ws + WS_W + W_GM + (size_t)mat * WG_SZ + WG_WS); }
            else if (mat < 6) { src = A.in[I_PK1] + (size_t)(mat - 2) * 131072; dst = (bf16_t*)(A.ws + WS_W + W_PEER + (size_t)(mat - 2) * WP_SZ + WP_K1); }
            else              { src = A.in[I_PK2] + (size_t)(mat - 6) * 131072; dst = (bf16_t*)(A.ws + WS_W + W_PEER + (size_t)(mat - 6) * WP_SZ + WP_K2); }
            const f32x4 a = *(const f32x4*)(src + off), b = *(const f32x4*)(src + off + 4);
            u32x4 w; w.x = cvt_pk_bf16(a[0], a[1]); w.y = cvt_pk_bf16(a[2], a[3]); w.z = cvt_pk_bf16(b[0], b[1]); w.w = cvt_pk_bf16(b[2], b[3]);
            *(u32x4*)(dst + off) = w;
        }
        float* rope = (float*)(A.ws + WS_ROPE);
        for (int p = gthr; p < SEQ * 32; p += nthr) { const int l = p >> 5, i = p & 31; const float pos = (float)(i < 16 ? (l >> 6) : (l & 63));
            const float inv = powf(10000.f, -(float)(i & 15) / 16.f), ang = pos * inv; rope[p] = cosf(ang); rope[SEQ * 32 + p] = sinf(ang); }
    }
    {
        LAS float* scond = (LAS float*)lds;
        LAS float* red = scond + 5 * 1024;
        __syncthreads();
        for (int i = tid; i < 5 * 1024; i += NTHR) { const int m = i >> 10, k = i & 1023; const float c = m < 4 ? A.in[I_C][m * 1024 + k] : A.in[I_CCTX][k]; scond[i] = silu_f(c); }
        __syncthreads();
        float* MOD = (float*)(A.ws + WS_MOD);
        for (int item = blockIdx.x; item < 4 * 48; item += gridDim.x) {
            const int layer = item / 48, j0 = (item % 48) * 128; const int c4 = tid & 31, ksl = tid >> 5;
            f32x4 acc[5];
#pragma unroll
            for (int m = 0; m < 5; ++m) acc[m] = (f32x4){0.f, 0.f, 0.f, 0.f};
            const float* wp = A.in[I_ADAW] + ((size_t)layer * 1024 + ksl * 64) * 6144 + j0 + 4 * c4;
#pragma unroll 1
            for (int k0 = 0; k0 < 64; k0 += 16) { f32x4 w[16];
#pragma unroll
                for (int k = 0; k < 16; ++k) w[k] = *(const f32x4*)(wp + (size_t)(k0 + k) * 6144);
#pragma unroll
                for (int k = 0; k < 16; ++k)
#pragma unroll
                    for (int m = 0; m < 5; ++m) acc[m] += w[k] * scond[m * 1024 + ksl * 64 + k0 + k]; }
#pragma unroll
            for (int m = 0; m < 5; ++m) *(LAS f32x4*)(red + (ksl * 5 + m) * 128 + 4 * c4) = acc[m];
            __syncthreads();
            for (int i = tid; i < 640; i += NTHR) { const int m = i >> 7, c = i & 127; float s = A.in[I_ADAB][layer * 6144 + j0 + c];
#pragma unroll
                for (int q = 0; q < 16; ++q) s += red[(q * 5 + m) * 128 + c];
                MOD[((size_t)layer * 5 + m) * 6144 + j0 + c] = s; }
            __syncthreads();
        }
    }
}

template <bool F32SRC>
__device__ __forceinline__ void phase_norm_mod(const float* xl, const float* xc, bf16_t* XB, const float* g, const float* modl, int sh_idx, bf16_t* H, int nrows) {
    const int tid_ = otid(); const int lane = tid_ & 63, gw = blockIdx.x * 8 + (tid_ >> 6), nw = gridDim.x * 8;
    f32x4 gv[4];
#pragma unroll
    for (int i = 0; i < 4; ++i) gv[i] = *(const f32x4*)(g + 256 * i + 4 * lane);
    for (int r = gw; r < nrows; r += nw) {
        const bool lat = r < NLAT;
        f32x4 x[4]; float ss = 0.f;
        if (F32SRC) { const float* xp = lat ? xl + (size_t)r * D : xc + (size_t)(r - NLAT) * D;
#pragma unroll
            for (int i = 0; i < 4; ++i) { x[i] = *(const f32x4*)(xp + 256 * i + 4 * lane);
                u32x2 w; w.x = cvt_pk_bf16(x[i][0], x[i][1]); w.y = cvt_pk_bf16(x[i][2], x[i][3]); *(u32x2*)(XB + (size_t)r * D + 256 * i + 4 * lane) = w;
 }
        } else {
#pragma unroll
            for (int i = 0; i < 4; ++i) { const u32x2 w = *(const u32x2*)(XB + (size_t)r * D + 256 * i + 4 * lane); x[i] = (f32x4){bflo(w.x), bfhi(w.x), bflo(w.y), bfhi(w.y)}; } }
#pragma unroll
        for (int i = 0; i < 4; ++i) ss += x[i][0] * x[i][0] + x[i][1] * x[i][1] + x[i][2] * x[i][2] + x[i][3] * x[i][3];
        ss = wave_sum(ss); const float rstd = rsqrtf(ss * (1.f / 1024.f) + EPS);
        const float* mp = modl + (size_t)(lat ? (r >> 13) : 4) * 6144 + sh_idx * 1024;
#pragma unroll
        for (int i = 0; i < 4; ++i) { const f32x4 sh = *(const f32x4*)(mp + 256 * i + 4 * lane), sc = *(const f32x4*)(mp + 1024 + 256 * i + 4 * lane);
            const f32x4 hv = (x[i] * rstd) * gv[i] * (sc + 1.f) + sh;
            u32x2 w; w.x = cvt_pk_bf16(hv[0], hv[1]); w.y = cvt_pk_bf16(hv[2], hv[3]);
            *(u32x2*)(H + (size_t)r * D + 256 * i + 4 * lane) = w; }
    }
}
__device__ __forceinline__ void phase_final_norm(const bf16_t* XB, float* out, const float* g, float oscale) {
    const int tid_ = otid(); const int lane = tid_ & 63, gw = blockIdx.x * 8 + (tid_ >> 6), nw = gridDim.x * 8;
    f32x4 gv[4];
#pragma unroll
    for (int i = 0; i < 4; ++i) gv[i] = *(const f32x4*)(g + 256 * i + 4 * lane);
    for (int r = gw; r < NLAT; r += nw) {
        f32x4 x[4]; float ss = 0.f;
#pragma unroll
        for (int i = 0; i < 4; ++i) { const u32x2 w = *(const u32x2*)(XB + (size_t)r * D + 256 * i + 4 * lane); x[i] = (f32x4){bflo(w.x), bfhi(w.x), bflo(w.y), bfhi(w.y)};
            ss += x[i][0] * x[i][0] + x[i][1] * x[i][1] + x[i][2] * x[i][2] + x[i][3] * x[i][3]; }
        ss = wave_sum(ss); const float rstd = rsqrtf(ss * (1.f / 1024.f) + EPS);
#pragma unroll
        for (int i = 0; i < 4; ++i) *(f32x4*)(out + (size_t)r * D + 256 * i + 4 * lane) = (x[i] * (rstd * oscale)) * gv[i];
    }
}

#ifndef MK_CVAR
#define MK_CVAR 0
#endif
__device__ __forceinline__ void phase_conv(const Args& A, int li, int rep = 0) {
    const int cvar = rep ? MK_CVAR : 0;
    const bf16_t* PROJ = (const bf16_t*)(A.ws + WS_BIG);
    bf16_t* XS = (bf16_t*)(A.ws + WS_R2); bf16_t* BC = (bf16_t*)(A.ws + WS_R2 + R2_BC);
    const int tid = otid();
    if (cvar != 2) {
        for (int item = blockIdx.x * 3; item < (NROW / 64) * 3; item += gridDim.x * 3)
#pragma unroll 1
        for (int sub = 0; sub < 3; ++sub) {
            const int blk = (item + sub) / 3, q = ((item + sub) % 3) * 512 + tid, cg = q % 192, rg = q / 192, c0 = 8 * cg;
            const int rbeg = blk * 64 + rg * 8; int s0, s1;
            if (rbeg < NLAT) { s0 = rbeg & ~8191; s1 = s0 + 8192; } else { s0 = NLAT + ((rbeg - NLAT) & ~255); s1 = s0 + 256; }
            const float* cw = A.in[I_CONVW] + ((size_t)li * 1536 + c0) * 5; const float* cb = A.in[I_CONVB] + (size_t)li * 1536 + c0;
            u32x4 in[12];
#pragma unroll
            for (int i = 0; i < 12; ++i) { const int r = rbeg - 2 + i; in[i] = (r >= s0 && r < s1) ? *(const u32x4*)(PROJ + (size_t)r * HYB_INP + C_XBC + c0) : (u32x4){0u, 0u, 0u, 0u}; }
            float w[8][5], bia[8];
#pragma unroll
            for (int j = 0; j < 8; ++j) { bia[j] = cb[j];
#pragma unroll
                for (int k = 0; k < 5; ++k) w[j][k] = cw[j * 5 + k]; }
#pragma unroll
            for (int rr = 0; rr < 8; ++rr) {
                float o[8];
#pragma unroll
                for (int j = 0; j < 8; ++j) { float sacc = bia[j];
#pragma unroll
                    for (int k = 0; k < 5; ++k) { const unsigned wd = in[rr + k][j >> 1]; sacc += w[j][k] * ((j & 1) ? bfhi(wd) : bflo(wd)); }
                    o[j] = silu_f(sacc); }
                u32x4 pk; pk.x = cvt_pk_bf16(o[0], o[1]); pk.y = cvt_pk_bf16(o[2], o[3]); pk.z = cvt_pk_bf16(o[4], o[5]); pk.w = cvt_pk_bf16(o[6], o[7]);
                const int r = rbeg + rr;
                if (c0 < 1024) *(u32x4*)(XS + (size_t)r * 1024 + c0) = pk; else *(u32x4*)(BC + (size_t)r * 512 + (c0 - 1024)) = pk;
            }
        }
    }
    if (cvar != 1) {
        const int lane = tid & 63, gw = blockIdx.x * 8 + (tid >> 6), nw = gridDim.x * 8;
        float* DT = (float*)(A.ws + WS_BIG + BIG_DT); float* RQ = (float*)(A.ws + WS_RSTD); float* RKV = RQ + NROW;
        unsigned char* KR = A.ws + WS_BIG + BIG_KR; const float* rope = (const float*)(A.ws + WS_ROPE);
        const float dtb = lane < 32 ? A.in[I_DTB][li * 32 + lane] : 0.f;
        for (int rb = gw * 4; rb < NROW; rb += nw * 4) {
            unsigned wq[4][3]; u32x2 wk[4]; unsigned wr_[4]; float dtv[4], rc[4], rsn[4];
#pragma unroll
            for (int i = 0; i < 4; ++i) { const int r = rb + i; const bf16_t* p = PROJ + (size_t)r * HYB_INP;
                const unsigned* q = (const unsigned*)(p + C_CQ + 6 * lane); wq[i][0] = q[0]; wq[i][1] = q[1]; wq[i][2] = q[2];
                wk[i] = *(const u32x2*)(p + C_CKV + 4 * lane);
                dtv[i] = lane < 32 ? bf2f(p[C_DT + (lane & 15)]) : 0.f; wr_[i] = lane < 32 ? *(const unsigned*)(p + C_KR + 2 * lane) : 0u;
                const int l = r & 8191; rc[i] = (lane < 32 && r < NLAT) ? rope[l * 32 + lane] : 1.f; rsn[i] = (lane < 32 && r < NLAT) ? rope[SEQ * 32 + l * 32 + lane] : 0.f; }
#pragma unroll
            for (int i = 0; i < 4; ++i) { const int r = rb + i;
                if (lane < 32) DT[(size_t)lane * NROW + r] = softplus_f(dtv[i] + dtb);
                { float ss = 0.f;
#pragma unroll
                  for (int j = 0; j < 3; ++j) { const float a = bflo(wq[i][j]), b = bfhi(wq[i][j]); ss += a * a + b * b; }
                  ss = wave_sum(ss); if (lane == 0) RQ[r] = rsqrtf(ss * (1.f / 384.f) + EPS); }
                { const float a = bflo(wk[i].x), b = bfhi(wk[i].x), c = bflo(wk[i].y), d = bfhi(wk[i].y);
                  float ss = a * a + b * b + c * c + d * d; ss = wave_sum(ss); if (lane == 0) RKV[r] = rsqrtf(ss * (1.f / 256.f) + EPS); }
                if (lane < 32) { const float x1 = bflo(wr_[i]), x2 = bfhi(wr_[i]); int b, key;
                    const float o1 = x1 * rc[i] - x2 * rsn[i], o2 = x1 * rsn[i] + x2 * rc[i];
                    if (r < NLAT) { b = r >> 13; key = 256 + (r & 8191); } else { b = (r - NLAT) >> 8; key = (r - NLAT) & 255; }
                    int w8 = 0; w8 = __builtin_amdgcn_cvt_pk_fp8_f32(sat8(o1), sat8(o2), w8, false);
                    *(unsigned short*)(KR + (size_t)(b * NKT + (key >> 6)) * 4096 + att8::kr8(key & 63, 2 * lane)) = (unsigned short)(w8 & 0xffff); }
            }
        }
    }
}

struct EpiQ {
    static constexpr bool PERM = true;
    unsigned char* Q; const float* rstd; const float* rope;
    __device__ __forceinline__ void operator()(const f32x4 (&acc)[2][2][4][2], const pg8::Unit& u, int wr, int wc, int fr, int fq) const {
        const bool lat = u.pm < 128;
        const int b = lat ? (u.pm >> 5) : (u.pm - 128), q0 = lat ? 256 + ((u.pm & 31) << 8) : 0;
        const bool isrope = u.pn >= 4;
#pragma unroll
        for (int ai = 0; ai < 2; ++ai) {
            const int rl = 128 * ai + 64 * wr + fr;
            const float* rsp = rstd + u.pm * 256 + rl;
            const float* rp = rope + (size_t)(((u.pm & 31) << 8) + rl) * 32;
#pragma unroll
            for (int bj = 0; bj < 2; ++bj) {
                const int c0 = u.pn * 256 + 128 * bj + 32 * wc + 8 * fq; int h, dcol;
                if (!isrope) { h = c0 >> 7; dcol = c0 & 127; } else { const int mq = c0 - 1024; h = mq >> 6; dcol = 128 + (mq & 63); }
                unsigned char* dst = Q + ((size_t)(b * 8 + h) * NKEY + q0 + rl) * 192 + dcol;
                const int ro = (dcol - 128) >> 1;
#pragma unroll
                for (int m = 0; m < 4; ++m) {
                    const float rs = rsp[16 * m] * (QSCALE * att8::QUP);
                    f32x4 v0 = acc[ai][bj][m][0] * rs, v1 = acc[ai][bj][m][1] * rs;
                    if (isrope && lat) { const f32x4 cs = *(const f32x4*)(rp + 16 * m * 32 + ro), sn = *(const f32x4*)(rp + SEQ * 32 + 16 * m * 32 + ro);
                        const f32x4 a0 = v0, a1 = v1;
                        v0[0] = a0[0] * cs[0] - a0[1] * sn[0]; v0[1] = a0[0] * sn[0] + a0[1] * cs[0]; v0[2] = a0[2] * cs[1] - a0[3] * sn[1]; v0[3] = a0[2] * sn[1] + a0[3] * cs[1];
                        v1[0] = a1[0] * cs[2] - a1[1] * sn[2]; v1[1] = a1[0] * sn[2] + a1[1] * cs[2]; v1[2] = a1[2] * cs[3] - a1[3] * sn[3]; v1[3] = a1[2] * sn[3] + a1[3] * cs[3]; }
                    u32x2 w; w.x = pk4_fp8_sat(v0[0], v0[1], v0[2], v0[3]); w.y = pk4_fp8_sat(v1[0], v1[1], v1[2], v1[3]);
                    *(u32x2*)(dst + 16 * m * 192) = w;
                    asm volatile("" ::: "memory");
                }
            }
        }
    }
};
struct EpiKV {
    static constexpr bool PERM = true;
    unsigned char* KN; unsigned char* V; const float* rstd;
    __device__ __forceinline__ void operator()(const f32x4 (&acc)[2][2][4][2], const pg8::Unit& u, int wr, int wc, int fr, int fq) const {
        const bool lat = u.pm < 128;
        const int b = lat ? (u.pm >> 5) : (u.pm - 128), t0 = lat ? 4 + ((u.pm & 31) << 2) : 0;
        const int dd = 32 * wc + 8 * fq;
        const int offK = fr * 128 + ((((dd >> 4) ^ ((fr >> 1) & 7))) << 4) + (dd & 15);
#pragma unroll
        for (int ai = 0; ai < 2; ++ai) {
            const size_t tb = ((size_t)(b * 8 + u.pn) * NKT + t0 + 2 * ai + wr) * 8192;
            const float* rsp = rstd + u.pm * 256 + 128 * ai + 64 * wr + fr;
            unsigned char* kp = KN + tb + offK; unsigned char* vp = V + tb;
#pragma unroll
            for (int m = 0; m < 4; ++m) {
                const float rs = rsp[16 * m];
                { const f32x4 v0 = acc[ai][0][m][0] * rs, v1 = acc[ai][0][m][1] * rs; u32x2 w; w.x = pk4_fp8_sat(v0[0], v0[1], v0[2], v0[3]); w.y = pk4_fp8_sat(v1[0], v1[1], v1[2], v1[3]);
                  *(u32x2*)(kp + m * 2048) = w; }
                { const f32x4 v0 = acc[ai][1][m][0] * rs, v1 = acc[ai][1][m][1] * rs; const unsigned w0 = pk4_fp8_sat(v0[0], v0[1], v0[2], v0[3]), w1 = pk4_fp8_sat(v1[0], v1[1], v1[2], v1[3]);
                  const int sl = att8::vslot(16 * m + fr);
#pragma unroll
                  for (int i = 0; i < 8; ++i) { const int d = dd + i; vp[d * 64 + ((((sl >> 4) ^ ((d >> 2) & 3))) << 4) + (sl & 15)] = (unsigned char)(((i < 4 ? w0 : w1) >> (8 * (i & 3))) & 0xffu); } }
                asm volatile("" ::: "memory");
            }
        }
    }
};

__device__ __forceinline__ void phase_ssd_out(const Args& A, int li, int nrows) {
    const bf16_t* PROJ = (const bf16_t*)(A.ws + WS_BIG); const bf16_t* XS = (const bf16_t*)(A.ws + WS_R2);
    const bf16_t* Y0 = (const bf16_t*)(A.ws + WS_H); const bf16_t* Y1 = (const bf16_t*)(A.ws + WS_R3); bf16_t* CAT = (bf16_t*)(A.ws + WS_R3 + R3_CAT);
    const int tid_ = otid(); const int lane = tid_ & 63, gw = blockIdx.x * 8 + (tid_ >> 6), nw = gridDim.x * 8;
    const float dsk = A.in[I_SSDD][li * 16 + (lane >> 2)];
    float ng[16];
#pragma unroll
    for (int j = 0; j < 16; ++j) ng[j] = A.in[I_SSDNG][li * 1024 + 16 * lane + j];
    for (int r = gw; r < nrows; r += nw) {
        float v[16]; float ss = 0.f;
#pragma unroll
        for (int hh = 0; hh < 2; ++hh) {
            const u32x4 a = *(const u32x4*)(Y0 + (size_t)r * 1024 + 16 * lane + 8 * hh), b = *(const u32x4*)(Y1 + (size_t)r * 1024 + 16 * lane + 8 * hh);
            const u32x4 x = *(const u32x4*)(XS + (size_t)r * 1024 + 16 * lane + 8 * hh), z = *(const u32x4*)(PROJ + (size_t)r * HYB_INP + 16 * lane + 8 * hh);
#pragma unroll
            for (int q = 0; q < 4; ++q) {
                const float y0 = (bflo(a[q]) + bflo(b[q]) + dsk * bflo(x[q])) * silu_f(bflo(z[q])), y1 = (bfhi(a[q]) + bfhi(b[q]) + dsk * bfhi(x[q])) * silu_f(bfhi(z[q]));
                v[8 * hh + 2 * q] = y0; v[8 * hh + 2 * q + 1] = y1; ss += y0 * y0 + y1 * y1; }
        }
#pragma unroll
        for (int o = 16; o >= 1; o >>= 1) ss += __shfl_xor(ss, o);
        const float rstd = rsqrtf(ss * (1.f / 512.f) + EPS);
#pragma unroll
        for (int hh = 0; hh < 2; ++hh) { u32x4 w;
#pragma unroll
            for (int q = 0; q < 4; ++q) w[q] = cvt_pk_bf16(v[8 * hh + 2 * q] * rstd * ng[8 * hh + 2 * q], v[8 * hh + 2 * q + 1] * rstd * ng[8 * hh + 2 * q + 1]);
            *(u32x4*)(CAT + (size_t)r * 2048 + 16 * lane + 8 * hh) = w; }
    }
}

__device__ __forceinline__ void phase_ln_stats(const Args& A, int nrows) {
    const bf16_t* Gb = (const bf16_t*)(A.ws + WS_BIG); float* ST = (float*)(A.ws + WS_RSTD);
    const int tid_ = otid(); const int lane = tid_ & 63, gw = blockIdx.x * 8 + (tid_ >> 6), nw = gridDim.x * 8;
    for (int r = gw; r < nrows; r += nw) {
        float v[32]; float s = 0.f;
#pragma unroll
        for (int j = 0; j < 4; ++j) { const u32x4 w = *(const u32x4*)(Gb + (size_t)r * 4096 + 2048 + 512 * j + 8 * lane);
#pragma unroll
            for (int q = 0; q < 4; ++q) { v[8 * j + 2 * q] = bflo(w[q]); v[8 * j + 2 * q + 1] = bfhi(w[q]); s += v[8 * j + 2 * q] + v[8 * j + 2 * q + 1]; } }
        s = wave_sum(s); const float mu = s * (1.f / 2048.f); float q2 = 0.f;
#pragma unroll
        for (int j = 0; j < 32; ++j) { const float dd = v[j] - mu; q2 += dd * dd; }
        q2 = wave_sum(q2);
        if (lane == 0) { ST[r] = mu; ST[NROW + r] = rsqrtf(q2 * (1.f / 2048.f) + EPS); }
    }
}
__device__ __forceinline__ float half_sum32(float v) {
    v += __builtin_bit_cast(float, __builtin_amdgcn_mov_dpp(__builtin_bit_cast(int, v), 0xB1, 0xF, 0xF, true));
    v += __builtin_bit_cast(float, __builtin_amdgcn_mov_dpp(__builtin_bit_cast(int, v), 0x4E, 0xF, 0xF, true));
    v += __builtin_bit_cast(float, __builtin_amdgcn_mov_dpp(__builtin_bit_cast(int, v), 0x141, 0xF, 0xF, true));
    v += __builtin_bit_cast(float, __builtin_amdgcn_mov_dpp(__builtin_bit_cast(int, v), 0x140, 0xF, 0xF, true));
    auto r = __builtin_amdgcn_permlane16_swap(__float_as_uint(v), __float_as_uint(v), false, false);
    return __uint_as_float(r[0]) + __uint_as_float(r[1]);
}
__device__ __forceinline__ void phase_spatial(const Args& A, int gi, int nrows, LAS unsigned char* lds) {
    const bf16_t* Gb = (const bf16_t*)(A.ws + WS_BIG); const f32x2* PARTS = (const f32x2*)(A.ws + WS_R3); bf16_t* Ab = (bf16_t*)(A.ws + WS_R1);
    const bf16_t* WSg = (const bf16_t*)(A.ws + WS_W + W_GM + (size_t)gi * WG_SZ + WG_WS);
    const float* lng = A.in[I_GLNG] + (size_t)gi * 2048; const float* lnb = A.in[I_GLNB] + (size_t)gi * 2048; const float* bs = A.in[I_GBS] + (size_t)gi * 1024;
    const int tid = otid(), wid = tid >> 6, lane = tid & 63, r32 = lane & 31, hi = lane >> 5, tb = wid & 3, dh = wid >> 2;
    const int ldsaddr = (int)(unsigned)(uintptr_t)lds;
    u32x4 nv[8]; f32x2 nps[8];
    const int nunits = (nrows / 128) * 8;
#define SP_LOADV(un) do { const int cb_ = (un) >> 3, gg_ = (un) & 7, r0_ = cb_ * 128; \
        _Pragma("unroll") for (int j = 0; j < 8; ++j) { const int idx = tid + 512 * j, s_ = idx >> 5, dd_ = (idx & 31) * 8; \
            nv[j] = *(const u32x4*)(Gb + (size_t)(r0_ + s_) * 4096 + 2048 + 256 * gg_ + dd_); nps[j] = PARTS[(size_t)(r0_ + s_) * 32 + (idx & 31)]; } } while (0)
    if ((int)blockIdx.x < nunits) SP_LOADV((int)blockIdx.x);
    for (int unit = blockIdx.x; unit < nunits; unit += gridDim.x) {
        const int cb = unit >> 3, gg = unit & 7, r0 = cb * 128;
        __syncthreads();
#pragma unroll
        for (int j = 0; j < 8; ++j) { const int idx = tid + 512 * j, s = idx >> 5, dd = (idx & 31) * 8;
            const u32x4 w = nv[j];
            const float mu = half_sum32(nps[j].x) * (1.f / 2048.f), rs = rsqrtf(fmaxf(half_sum32(nps[j].y) * (1.f / 2048.f) - mu * mu, 0.f) + EPS);
            const f32x4 g0 = *(const f32x4*)(lng + 256 * gg + dd), g1 = *(const f32x4*)(lng + 256 * gg + dd + 4), b0 = *(const f32x4*)(lnb + 256 * gg + dd), b1 = *(const f32x4*)(lnb + 256 * gg + dd + 4);
            u32x4 o;
            o.x = cvt_pk_bf16((bflo(w.x) - mu) * rs * g0[0] + b0[0], (bfhi(w.x) - mu) * rs * g0[1] + b0[1]); o.y = cvt_pk_bf16((bflo(w.y) - mu) * rs * g0[2] + b0[2], (bfhi(w.y) - mu) * rs * g0[3] + b0[3]);
            o.z = cvt_pk_bf16((bflo(w.z) - mu) * rs * g1[0] + b1[0], (bfhi(w.z) - mu) * rs * g1[1] + b1[1]); o.w = cvt_pk_bf16((bflo(w.w) - mu) * rs * g1[2] + b1[2], (bfhi(w.w) - mu) * rs * g1[3] + b1[3]);
            *(LAS u32x4*)(lds + ((s >> 6) * 2 + (dd >> 7)) * 16384 + att::v_st(s & 63, dd & 127)) = o; }
        u32x2 uu[4][4];
        { const bf16_t* up = Gb + (size_t)(r0 + 32 * tb + r32) * 4096 + 256 * gg + 128 * dh + 4 * hi;
#pragma unroll
          for (int d0 = 0; d0 < 4; ++d0)
#pragma unroll
              for (int k = 0; k < 4; ++k) uu[d0][k] = *(const u32x2*)(up + 32 * d0 + 8 * k); }
        if (unit + (int)gridDim.x < nunits) SP_LOADV(unit + (int)gridDim.x);
        bf16x8 pa[8];
#pragma unroll
        for (int ks = 0; ks < 8; ++ks) pa[ks] = *(const bf16x8*)(WSg + ((size_t)gg * 128 + 32 * tb + r32) * 128 + 16 * ks + 8 * hi);
        __syncthreads();
        f32x16 o[4] = {};
#define SP_PV(D0, vbase, p0, p1, p2, p3) do { \
            const s16x4 l0 = att::tr_read<att::v_rd_off(D0, 0, 0)>(vbase), h0 = att::tr_read<att::v_rd_off(D0, 0, 1)>(vbase), l1 = att::tr_read<att::v_rd_off(D0, 1, 0)>(vbase), h1 = att::tr_read<att::v_rd_off(D0, 1, 1)>(vbase); \
            const s16x4 l2 = att::tr_read<att::v_rd_off(D0, 2, 0)>(vbase), h2 = att::tr_read<att::v_rd_off(D0, 2, 1)>(vbase), l3 = att::tr_read<att::v_rd_off(D0, 3, 0)>(vbase), h3 = att::tr_read<att::v_rd_off(D0, 3, 1)>(vbase); \
            asm volatile("s_waitcnt lgkmcnt(0)" ::: "memory"); __builtin_amdgcn_sched_barrier(0); \
            o[D0] = __builtin_amdgcn_mfma_f32_32x32x16_bf16((bf16x8){l0[0], l0[1], l0[2], l0[3], h0[0], h0[1], h0[2], h0[3]}, p0, o[D0], 0, 0, 0); \
            o[D0] = __builtin_amdgcn_mfma_f32_32x32x16_bf16((bf16x8){l1[0], l1[1], l1[2], l1[3], h1[0], h1[1], h1[2], h1[3]}, p1, o[D0], 0, 0, 0); \
            o[D0] = __builtin_amdgcn_mfma_f32_32x32x16_bf16((bf16x8){l2[0], l2[1], l2[2], l2[3], h2[0], h2[1], h2[2], h2[3]}, p2, o[D0], 0, 0, 0); \
            o[D0] = __builtin_amdgcn_mfma_f32_32x32x16_bf16((bf16x8){l3[0], l3[1], l3[2], l3[3], h3[0], h3[1], h3[2], h3[3]}, p3, o[D0], 0, 0, 0); } while (0)
        { const int vb0 = ldsaddr + (0 * 2 + dh) * 16384 + att::v_rd_base(lane), vb1 = ldsaddr + (1 * 2 + dh) * 16384 + att::v_rd_base(lane);
          SP_PV(0, vb0, pa[0], pa[1], pa[2], pa[3]); SP_PV(1, vb0, pa[0], pa[1], pa[2], pa[3]); SP_PV(2, vb0, pa[0], pa[1], pa[2], pa[3]); SP_PV(3, vb0, pa[0], pa[1], pa[2], pa[3]);
          SP_PV(0, vb1, pa[4], pa[5], pa[6], pa[7]); SP_PV(1, vb1, pa[4], pa[5], pa[6], pa[7]); SP_PV(2, vb1, pa[4], pa[5], pa[6], pa[7]); SP_PV(3, vb1, pa[4], pa[5], pa[6], pa[7]); }
#undef SP_PV
        { const int t = 32 * tb + r32, row = r0 + t; const float bsv = bs[gg * 128 + t];
          bf16_t* ap = Ab + (size_t)row * 2048 + 256 * gg + 128 * dh + 4 * hi;
#pragma unroll
          for (int d0 = 0; d0 < 4; ++d0)
#pragma unroll
              for (int k = 0; k < 4; ++k) {
                  const u32x2 u2 = uu[d0][k];
                  u32x2 w; w.x = cvt_pk_bf16(bflo(u2.x) * (o[d0][4 * k] + bsv), bfhi(u2.x) * (o[d0][4 * k + 1] + bsv)); w.y = cvt_pk_bf16(bflo(u2.y) * (o[d0][4 * k + 2] + bsv), bfhi(u2.y) * (o[d0][4 * k + 3] + bsv));
                  *(u32x2*)(ap + 32 * d0 + 8 * k) = w; } }
    }
#undef SP_LOADV
}

constexpr int NSL = 8, SW = 1024 / NSL;
constexpr size_t TAB8_HALF = (size_t)NEXP * 1024, TAB_SCL = 2 * TAB8_HALF, TAB_SET = al256(TAB_SCL + (size_t)2 * NEXP * 4);
static_assert(2 * TAB_SET <= TAB_REGION, "table sets");
__device__ __forceinline__ size_t tabset(int layer) { return WS_TAB + (size_t)(layer & 1) * TAB_SET; }
constexpr float HS = 4.f;
__device__ __forceinline__ void phase_tabcvt(const Args& A, int layer, int wg, int nwg, int r_lo = 0, int r_hi = 2 * NEXP) {
    const int tid_ = otid(); const int lane = tid_ & 63, gw = wg * 8 + (tid_ >> 6), nw = nwg * 8;
    unsigned char* TS = A.ws + tabset(layer); float* SCL = (float*)(TS + TAB_SCL);
    for (int r = r_lo + gw; r < r_hi; r += nw) {
        const int tab = r >> 14, e = r & (NEXP - 1);
        const float* src = (tab ? A.in[I_PV] : A.in[I_PU]) + ((size_t)layer * NEXP + e) * 1024 + 16 * lane;
        f32x4 v[4]; float am = 0.f;
#pragma unroll
        for (int i = 0; i < 4; ++i) { v[i] = *(const f32x4*)(src + 4 * i); am = fmaxf(am, fmaxf(fmaxf(fabsf(v[i][0]), fabsf(v[i][1])), fmaxf(fabsf(v[i][2]), fabsf(v[i][3])))); }
#pragma unroll
        for (int o = 32; o >= 1; o >>= 1) am = fmaxf(am, __shfl_xor(am, o));
        float sc = 1.f; if (am > 0.f) { int ex; (void)frexpf(448.f / am, &ex); sc = ldexpf(1.f, ex - 1); }
        if (lane == 0) SCL[tab * NEXP + e] = 1.f / sc;
        u32x4 w;
#pragma unroll
        for (int i = 0; i < 4; ++i) w[i] = pk4_fp8(v[i][0] * sc, v[i][1] * sc, v[i][2] * sc, v[i][3] * sc);
        *(u32x4*)(TS + (size_t)tab * TAB8_HALF + ((size_t)(lane >> 3) * NEXP + e) * SW + 16 * (lane & 7)) = w;
    }
}
#define CASD(a, b) do { const float hi_ = fmaxf(a, b), lo_ = fminf(a, b); a = hi_; b = lo_; } while (0)
__device__ __forceinline__ void sort16(float (&k)[16]) {
#pragma unroll
    for (int sz = 2; sz <= 16; sz <<= 1)
#pragma unroll
        for (int j = sz >> 1; j > 0; j >>= 1)
#pragma unroll
            for (int i = 0; i < 16; ++i) { const int l = i ^ j; if (l > i) { if ((i & sz) == 0 || sz == 16) CASD(k[i], k[l]); else CASD(k[l], k[i]); } }
}
__device__ __forceinline__ void bmerge16(float (&k)[16]) {
#pragma unroll
    for (int j = 8; j > 0; j >>= 1)
#pragma unroll
        for (int i = 0; i < 16; ++i) { const int l = i ^ j; if (l > i) CASD(k[i], k[l]); }
}
__device__ __forceinline__ void merge_top16(float (&a)[16], const float (&b)[16]) {
#pragma unroll
    for (int i = 0; i < 16; ++i) a[i] = fmaxf(a[i], b[15 - i]);
    bmerge16(a);
}
__device__ __forceinline__ void xmerge_top16(float (&a)[16], int mask) {
    float t[16];
#pragma unroll
    for (int i = 0; i < 16; ++i) t[i] = __shfl_xor(a[15 - i], mask);
#pragma unroll
    for (int i = 0; i < 16; ++i) a[i] = fmaxf(a[i], t[i]);
    bmerge16(a);
}
__device__ __forceinline__ void phase_topk(const Args& A, int layer, int nrows, LAS unsigned char* lds) {
    const bf16_t* QP = (const bf16_t*)(A.ws + WS_BIG); int* IDX = (int*)(A.ws + WS_R2); float* GATE = (float*)(A.ws + WS_R2 + R2_GATE);
    const int tid = otid(), wid = tid >> 6, lane = tid & 63, fr = lane & 15, fq = lane >> 4;
    LAS unsigned* scr = (LAS unsigned*)(lds + 2 * 34816) + wid * 512 + fr * 32;
    int h_staged = -1;
    for (int unit = blockIdx.x; unit < (nrows / 128) * 8; unit += gridDim.x) {
        const int h = unit & 7, r0 = (unit >> 3) * 128;
        if (h != h_staged) { h_staged = h;
        __syncthreads();
        { const bf16_t* k1 = (const bf16_t*)(A.ws + WS_W + W_PEER + (size_t)layer * WP_SZ + WP_K1) + (size_t)h * 16384;
#pragma unroll
          for (int j = 0; j < 8; ++j) { const int idx = tid + 512 * j, half = idx >> 11, rem = idx & 2047, key = rem >> 4, c8 = rem & 15;
              const u32x4 w = *(const u32x4*)(k1 + (size_t)half * 8 * 16384 + key * 128 + 8 * c8);
              *(LAS u32x4*)(lds + half * 34816 + key * 272 + c8 * 16) = w; } }
        __syncthreads(); }
        const int tok = r0 + 16 * wid + fr;
        float top[2][16];
#pragma unroll
        for (int half = 0; half < 2; ++half) {
            bf16x8 qf[4];
#pragma unroll
            for (int ks = 0; ks < 4; ++ks) qf[ks] = *(const bf16x8*)(QP + (size_t)tok * 2048 + 256 * h + 128 * half + 32 * ks + 8 * fq);
            float loc[16];
#pragma unroll
            for (int grp = 0; grp < 2; ++grp) {
                float kk[16];
#pragma unroll
                for (int nbb = 0; nbb < 4; ++nbb) { const int nb = 4 * grp + nbb; f32x4 acc = {0.f, 0.f, 0.f, 0.f};
#pragma unroll
                    for (int ks = 0; ks < 4; ++ks) { const bf16x8 kf = *(const LAS bf16x8*)(lds + half * 34816 + (16 * nb + fr) * 272 + (32 * ks + 8 * fq) * 2);
                        acc = __builtin_amdgcn_mfma_f32_16x16x32_bf16(kf, qf[ks], acc, 0, 0, 0); }
#pragma unroll
                    for (int i = 0; i < 4; ++i) { const unsigned code = 127u - (unsigned)(16 * nb + 4 * fq + i); kk[4 * nbb + i] = __uint_as_float((__float_as_uint(acc[i]) & ~127u) | code); } }
                sort16(kk);
                if (grp == 0) {
#pragma unroll
                    for (int i = 0; i < 16; ++i) loc[i] = kk[i];
                } else merge_top16(loc, kk);
            }
            xmerge_top16(loc, 16); xmerge_top16(loc, 32);
#pragma unroll
            for (int i = 0; i < 16; ++i) top[half][i] = loc[i];
        }
        if (fq < 2) {
#pragma unroll
            for (int i = 0; i < 16; ++i) scr[16 * fq + i] = __float_as_uint(fq == 0 ? top[0][i] : top[1][i]); }
        float fin[16];
#pragma unroll
        for (int aa = 0; aa < 4; ++aa) {
            const float va_k = fq == 0 ? top[0][aa] : fq == 1 ? top[0][4 + aa] : fq == 2 ? top[0][8 + aa] : top[0][12 + aa];
            const float va = __uint_as_float(__float_as_uint(va_k) & ~127u);
            float c[16];
#pragma unroll
            for (int bb = 0; bb < 16; ++bb) { const float s = va + __uint_as_float(__float_as_uint(top[1][bb]) & ~127u);
                c[bb] = __uint_as_float((__float_as_uint(s) & ~255u) | (255u - (unsigned)((4 * fq + aa) * 16 + bb))); }
            if (aa == 0) {
#pragma unroll
                for (int i = 0; i < 16; ++i) fin[i] = c[i];
            } else merge_top16(fin, c);
        }
        xmerge_top16(fin, 16); xmerge_top16(fin, 32);
        float ev[16], es = 0.f; const float mx = __uint_as_float(__float_as_uint(fin[0]) & ~255u);
#pragma unroll
        for (int i = 0; i < 16; ++i) { ev[i] = __expf(__uint_as_float(__float_as_uint(fin[i]) & ~255u) - mx); es += ev[i]; }
        const float inv = 1.f / es;
        asm volatile("s_waitcnt lgkmcnt(0)" ::: "memory");
        int oi[4]; float og[4];
#pragma unroll
        for (int kq = 0; kq < 4; ++kq) {
            const float fk = fq == 0 ? fin[kq] : fq == 1 ? fin[4 + kq] : fq == 2 ? fin[8 + kq] : fin[12 + kq];
            const float fe = fq == 0 ? ev[kq] : fq == 1 ? ev[4 + kq] : fq == 2 ? ev[8 + kq] : ev[12 + kq];
            const unsigned code = 255u - (__float_as_uint(fk) & 255u), a = code >> 4, bq = code & 15u;
            const unsigned i1 = 127u - (scr[a] & 127u), i2 = 127u - (scr[16 + bq] & 127u);
            oi[kq] = (int)(i1 * 128u + i2); og[kq] = fe * inv; }
        *(int4*)(IDX + (size_t)tok * 128 + 16 * h + 4 * fq) = make_int4(oi[0], oi[1], oi[2], oi[3]);
        *(f32x4*)(GATE + (size_t)tok * 128 + 16 * h + 4 * fq) = (f32x4){og[0], og[1], og[2], og[3]};
    }
}
struct PeerSched {
    int x0, rank, nloc, nblk, nown; unsigned orphan;
    __device__ __forceinline__ void init(const Args& A, int nrows, LAS unsigned char* smem) {
        unsigned* ctl = (unsigned*)(A.ws + WS_CTL);
        x0 = (int)(xb_xcc_id() & 7u); rank = __builtin_amdgcn_readfirstlane((int)((LAS unsigned*)smem)[8]); nblk = nrows / 64;
        unsigned cached = __builtin_amdgcn_readfirstlane(((LAS unsigned*)smem)[9]);
        if (cached == 0u) { unsigned orph = 0u, nl = 1u;
            for (int j = 0; j < 8; ++j) { unsigned c = xb_ld(&ctl[XB_XCNT(j)]) + xb_ld(&ctl[XB_XCNT(j + 8)]); c = __builtin_amdgcn_readfirstlane(c); if (c == 0u) orph |= 1u << j; if (j == x0) nl = c; }
            cached = (nl << 8) | orph; __syncthreads(); if (threadIdx.x == 0) ((LAS unsigned*)smem)[9] = cached; __syncthreads(); }
        nloc = (int)(cached >> 8); orphan = cached & 0xffu;
        const int tot = (NSL / 8) * nblk; nown = rank < tot ? (tot - rank + nloc - 1) / nloc : 0;
    }
    __device__ __forceinline__ bool item(int j, int& sl, int& blk) const {
        if (j < nown) { const int i = rank + j * nloc; sl = x0 + 8 * (i / nblk); blk = i % nblk; return true; }
        int jj = j - nown; const int tot = (NSL / 8) * nblk, per = ((int)gridDim.x > tot) ? 1 : 0; (void)per;
        for (int o = 0; o < 8; ++o) if ((orphan >> o) & 1u) { const int cnt = ((int)blockIdx.x < tot) ? (tot - (int)blockIdx.x + (int)gridDim.x - 1) / (int)gridDim.x : 0;
            if (jj < cnt) { const int i = (int)blockIdx.x + jj * (int)gridDim.x; sl = o + 8 * (i / nblk); blk = i % nblk; return true; } jj -= cnt; }
        return false;
    }
};
template <class LD, class PR>
__device__ __forceinline__ void peer_items(const PeerSched& S, LD ld, PR pr) {
    int sl, blk, sln, blkn, j = 0, buf = 0; bool have = S.item(0, sl, blk);
    __syncthreads();
    if (have) ld(sl, blk, 0);
    while (have) {
        const bool haven = S.item(j + 1, sln, blkn);
        asm volatile("s_waitcnt vmcnt(0)" ::: "memory");
        if (haven) ld(sln, blkn, buf ^ 1);
        pr(sl, blk, buf);
        sl = sln; blk = blkn; have = haven; buf ^= 1; ++j;
    }
    __syncthreads();
}
#ifndef MK_UVAR
#define MK_UVAR 0
#endif
__device__ __forceinline__ float dpp_sum8(float v) {
    v += __builtin_bit_cast(float, __builtin_amdgcn_mov_dpp(__builtin_bit_cast(int, v), 0xB1, 0xF, 0xF, true));
    v += __builtin_bit_cast(float, __builtin_amdgcn_mov_dpp(__builtin_bit_cast(int, v), 0x4E, 0xF, 0xF, true));
    v += __builtin_bit_cast(float, __builtin_amdgcn_mov_dpp(__builtin_bit_cast(int, v), 0x141, 0xF, 0xF, true));
    return v;
}
__device__ __forceinline__ void phase_peer_u(const Args& A, int layer, int nrows, LAS unsigned char* smem, int rep) {
    const int var = rep ? MK_UVAR : 0;
    const bf16_t* H = (const bf16_t*)(A.ws + WS_H); const int* IDX = (const int*)(A.ws + WS_R2); bf16_t* PART = var ? (bf16_t*)(A.ws + WS_R1) : (bf16_t*)(A.ws + WS_BIG + BIG_PART);
    const unsigned char* U = A.ws + tabset(layer);
    constexpr int PP = 1088, WB = 4 * PP + 2048;
    const int tid = otid(), wid = tid >> 6, lane = tid & 63, m = lane & 7, tk = lane >> 3;
    const int wu = __builtin_amdgcn_readfirstlane(wid);
    LAS unsigned char* lds = smem + LDS_BASE + wu * (2 * WB);
    LAS float* rowc = (LAS float*)(smem + LDS_BASE + 8 * (2 * WB) + wu * 4096) + tk * 128;
    static_assert(8 * (2 * WB) + 8 * 4096 <= LDS_PHASE, "u-phase LDS");
    PeerSched S; S.init(A, nrows, smem);
    peer_items(S,
        [&](int sl, int blk, int buf) {
#pragma unroll
            for (int i = 0; i < 4; ++i)
                __builtin_amdgcn_global_load_lds((const unsigned*)(IDX + ((size_t)blk * 64 + 8 * wu + 2 * i) * 128 + 4 * lane), (LAS unsigned*)(lds + buf * WB + PP * i), 16, 0, 0);
#pragma unroll
            for (int i = 0; i < 2; ++i)
                __builtin_amdgcn_global_load_lds((const unsigned*)(H + (size_t)(blk * 64 + 8 * wu + 4 * i + (lane >> 4)) * 1024 + SW * sl + 8 * (lane & 15)), (LAS unsigned*)(lds + buf * WB + 4 * PP + 1024 * i), 16, 0, 0); },
        [&](int sl, int blk, int buf) {
            const unsigned char* ub = U + (size_t)sl * NEXP * SW + 16 * m;
            const int tok = blk * 64 + wid * 8 + tk;
            const int sw = (tk & 1) * 4;
            const LAS int* ib = (const LAS int*)(lds + buf * WB + (tk >> 1) * PP + (tk & 1) * 512);
            float hf[16];
            { const u32x4 h0 = *(const LAS u32x4*)(lds + buf * WB + 4 * PP + tk * 256 + 32 * m), h1 = *(const LAS u32x4*)(lds + buf * WB + 4 * PP + tk * 256 + 32 * m + 16);
#pragma unroll
              for (int j = 0; j < 4; ++j) { hf[2 * j] = bflo(h0[j]); hf[2 * j + 1] = bfhi(h0[j]); hf[8 + 2 * j] = bflo(h1[j]); hf[8 + 2 * j + 1] = bfhi(h1[j]); } }
            const bool up4 = m >= 4, up2 = (m & 2) != 0, up1 = (m & 1) != 0;
            LAS float* pp = rowc + (m ^ sw);
            u32x4 vv[2][8];
#define PU_ROWS(T, c) do { const i32x4 e0_ = *(const LAS i32x4*)(ib + 8 * (c) + sw), e1_ = *(const LAS i32x4*)(ib + 8 * (c) + (4 - sw)); \
                if (var == 4) { _Pragma("unroll") for (int k_ = 0; k_ < 8; ++k_) vv[T][k_] = (u32x4){(unsigned)e0_.x, (unsigned)e1_.y, 0u, 0u}; } else { \
                vv[T][0] = *(const u32x4*)(ub + (size_t)(var == 3 ? e0_.x & 63 : e0_.x) * SW); vv[T][1] = *(const u32x4*)(ub + (size_t)(var == 3 ? e0_.y & 63 : e0_.y) * SW); \
                vv[T][2] = *(const u32x4*)(ub + (size_t)(var == 3 ? e0_.z & 63 : e0_.z) * SW); vv[T][3] = *(const u32x4*)(ub + (size_t)(var == 3 ? e0_.w & 63 : e0_.w) * SW); \
                vv[T][4] = *(const u32x4*)(ub + (size_t)(var == 3 ? e1_.x & 63 : e1_.x) * SW); vv[T][5] = *(const u32x4*)(ub + (size_t)(var == 3 ? e1_.y & 63 : e1_.y) * SW); \
                vv[T][6] = *(const u32x4*)(ub + (size_t)(var == 3 ? e1_.z & 63 : e1_.z) * SW); vv[T][7] = *(const u32x4*)(ub + (size_t)(var == 3 ? e1_.w & 63 : e1_.w) * SW); } } while (0)
#define PU_DOT(T, c) do { float s_[8]; \
                _Pragma("unroll") for (int k = 0; k < 8; ++k) { f32x2 a2 = {0.f, 0.f}; \
                    _Pragma("unroll") for (int j = 0; j < 4; ++j) { const int w = (int)vv[T][k][j]; \
                        const f32x2 lo = __builtin_amdgcn_cvt_pk_f32_fp8(w, false), hi = __builtin_amdgcn_cvt_pk_f32_fp8(w, true); \
                        a2 = __builtin_elementwise_fma(lo, (f32x2){hf[4 * j], hf[4 * j + 1]}, a2); a2 = __builtin_elementwise_fma(hi, (f32x2){hf[4 * j + 2], hf[4 * j + 3]}, a2); } \
                    s_[k] = a2.x + a2.y; } \
                  \
                float t_[4], u_[2]; \
                _Pragma("unroll") for (int j = 0; j < 4; ++j) { const float give = up4 ? s_[j] : s_[4 + j], keep = up4 ? s_[4 + j] : s_[j]; \
                    t_[j] = keep + __builtin_bit_cast(float, __builtin_amdgcn_mov_dpp(__builtin_bit_cast(int, give), 0x141, 0xF, 0xF, true)); }        \
                _Pragma("unroll") for (int j = 0; j < 2; ++j) { const float give = up2 ? t_[j] : t_[2 + j], keep = up2 ? t_[2 + j] : t_[j]; \
                    u_[j] = keep + __builtin_bit_cast(float, __builtin_amdgcn_mov_dpp(__builtin_bit_cast(int, give), 0x4E, 0xF, 0xF, true)); }         \
                { const float give = up1 ? u_[0] : u_[1], keep = up1 ? u_[1] : u_[0]; \
                  const float tot_ = keep + __builtin_bit_cast(float, __builtin_amdgcn_mov_dpp(__builtin_bit_cast(int, give), 0xB1, 0xF, 0xF, true));           \
                  pp[8 * (c)] = tot_; } } while (0)
            PU_ROWS(0, 0);
#pragma unroll 1
            for (int c = 0; c < 16; c += 2) {
                PU_ROWS(1, c + 1);
                __builtin_amdgcn_sched_barrier(0);
                PU_DOT(0, c);
                __builtin_amdgcn_sched_barrier(0);
                if (c + 2 < 16) PU_ROWS(0, c + 2);
                __builtin_amdgcn_sched_barrier(0);
                PU_DOT(1, c + 1);
                __builtin_amdgcn_sched_barrier(0);
            }
#undef PU_ROWS
#undef PU_DOT
            { const LAS f32x4* rd = (const LAS f32x4*)(rowc + 16 * m); const f32x4 a0 = rd[0], a1 = rd[1], a2 = rd[2], a3 = rd[3];
              u32x4 w0, w1; w0.x = cvt_pk_bf16(a0[0], a0[1]); w0.y = cvt_pk_bf16(a0[2], a0[3]); w0.z = cvt_pk_bf16(a1[0], a1[1]); w0.w = cvt_pk_bf16(a1[2], a1[3]);
              w1.x = cvt_pk_bf16(a2[0], a2[1]); w1.y = cvt_pk_bf16(a2[2], a2[3]); w1.z = cvt_pk_bf16(a3[0], a3[1]); w1.w = cvt_pk_bf16(a3[2], a3[3]);
              bf16_t* gp = PART + ((size_t)sl * NROW + tok) * 128 + 16 * m; *(u32x4*)gp = w0; *(u32x4*)(gp + 8) = w1; }
        });
}
__device__ __forceinline__ void phase_coef(const Args& A, int layer, int nrows) {
    const bf16_t* PART = (const bf16_t*)(A.ws + WS_BIG + BIG_PART); const float* GATE = (const float*)(A.ws + WS_R2 + R2_GATE); unsigned* REC = (unsigned*)(A.ws + WS_R2 + R2_COEF);
    const int* IDX = (const int*)(A.ws + WS_R2); const float* SCL = (const float*)(A.ws + tabset(layer) + TAB_SCL);
    const int gthr = blockIdx.x * NTHR + otid(), nthr = gridDim.x * NTHR;
    for (int p = gthr; p < nrows * 16; p += nthr) {
        f32x4 s0 = {0.f, 0.f, 0.f, 0.f}, s1 = {0.f, 0.f, 0.f, 0.f};
#pragma unroll
        for (int x = 0; x < NSL; ++x) { const u32x4 w = *(const u32x4*)(PART + (size_t)x * NROW * 128 + 8 * p);
            s0 += (f32x4){bflo(w.x), bfhi(w.x), bflo(w.y), bfhi(w.y)}; s1 += (f32x4){bflo(w.z), bfhi(w.z), bflo(w.w), bfhi(w.w)}; }
#pragma unroll
        for (int hlf = 0; hlf < 2; ++hlf) { const f32x4 sm = hlf ? s1 : s0;
            const i32x4 e = *(const i32x4*)(IDX + 8 * p + 4 * hlf); const f32x4 gt = *(const f32x4*)(GATE + 8 * p + 4 * hlf);
            const f32x4 su = {SCL[e.x], SCL[e.y], SCL[e.z], SCL[e.w]}, sv = {SCL[NEXP + e.x], SCL[NEXP + e.y], SCL[NEXP + e.z], SCL[NEXP + e.w]};
            const f32x4 a = sm * su; const f32x2 g0 = gelu_pk((f32x2){a[0], a[1]}), g1 = gelu_pk((f32x2){a[2], a[3]});
            const f32x4 cf = gt * (f32x4){g0.x, g0.y, g1.x, g1.y} * sv;
            *(u32x4*)(REC + 8 * p + 4 * hlf) = (u32x4){cvt_pk_bf16(0.f, cf[0]) | (unsigned)e.x, cvt_pk_bf16(0.f, cf[1]) | (unsigned)e.y, cvt_pk_bf16(0.f, cf[2]) | (unsigned)e.z, cvt_pk_bf16(0.f, cf[3]) | (unsigned)e.w}; } }
}
__device__ __forceinline__ void phase_peer_v(const Args& A, int layer, int nrows, LAS unsigned char* smem, int rep) {
    const int* REC = (const int*)(A.ws + WS_R2 + R2_COEF);
    const unsigned char* V = A.ws + tabset(layer) + TAB8_HALF; const float* MODL = (const float*)(A.ws + WS_MOD) + (size_t)layer * 5 * 6144 + 5 * 1024;
    bf16_t* XB = (bf16_t*)(A.ws + WS_XB);
    constexpr int PP = 1088, WB = 4 * PP;
    const int tid = otid(), wid = tid >> 6, lane = tid & 63, m = lane & 7, tk = lane >> 3;
    const int wu = __builtin_amdgcn_readfirstlane(wid);
    LAS unsigned char* lds = smem + LDS_BASE + wu * (2 * WB);
    PeerSched S; S.init(A, nrows, smem);
    peer_items(S,
        [&](int sl, int blk, int buf) {
#pragma unroll
            for (int i = 0; i < 4; ++i)
                __builtin_amdgcn_global_load_lds((const unsigned*)(REC + ((size_t)blk * 64 + 8 * wu + 2 * i) * 128 + 4 * lane), (LAS unsigned*)(lds + buf * WB + PP * i), 16, 0, 0); },
        [&](int sl, int blk, int buf) {
            const unsigned char* vb = V + (size_t)sl * NEXP * SW + 16 * m;
            const int tok = blk * 64 + wid * 8 + tk; const bool lat = tok < NLAT;
            const int toff = (tk >> 1) * PP + (tk & 1) * 512, sw = (tk & 1) * 4;
            const LAS int* ib = (const LAS int*)(lds + buf * WB + toff);
            bf16_t* xp = XB + (size_t)tok * D + SW * sl + 16 * m;
            const u32x4 xr0 = *(const u32x4*)xp, xr1 = *(const u32x4*)(xp + 8);
            f32x2 acc2[8];
#pragma unroll
            for (int j = 0; j < 8; ++j) acc2[j] = (f32x2){0.f, 0.f};
            u32x4 vv[2][8];
#define PV_ROWS(T, c) do { const i32x4 e0_ = *(const LAS i32x4*)(ib + 8 * (c) + sw) & 0xffff, e1_ = *(const LAS i32x4*)(ib + 8 * (c) + (4 - sw)) & 0xffff; \
                vv[T][0] = *(const u32x4*)(vb + (size_t)e0_.x * SW); vv[T][1] = *(const u32x4*)(vb + (size_t)e0_.y * SW); vv[T][2] = *(const u32x4*)(vb + (size_t)e0_.z * SW); vv[T][3] = *(const u32x4*)(vb + (size_t)e0_.w * SW); \
                vv[T][4] = *(const u32x4*)(vb + (size_t)e1_.x * SW); vv[T][5] = *(const u32x4*)(vb + (size_t)e1_.y * SW); vv[T][6] = *(const u32x4*)(vb + (size_t)e1_.z * SW); vv[T][7] = *(const u32x4*)(vb + (size_t)e1_.w * SW); } while (0)
#define PV_FMA(T, c) do { const i32x4 r0_ = *(const LAS i32x4*)(ib + 8 * (c) + sw) & (int)0xffff0000, r1_ = *(const LAS i32x4*)(ib + 8 * (c) + (4 - sw)) & (int)0xffff0000; \
                const f32x4 c0_ = __builtin_bit_cast(f32x4, r0_), c1_ = __builtin_bit_cast(f32x4, r1_); \
                _Pragma("unroll") for (int k = 0; k < 8; ++k) { const float cf = k < 4 ? c0_[k & 3] : c1_[k & 3]; \
                    _Pragma("unroll") for (int j = 0; j < 4; ++j) { const int w = (int)vv[T][k][j]; \
                        const f32x2 lo = __builtin_amdgcn_cvt_pk_f32_fp8(w, false), hi = __builtin_amdgcn_cvt_pk_f32_fp8(w, true); const f32x2 c2 = {cf, cf}; \
                        acc2[2 * j] = __builtin_elementwise_fma(lo, c2, acc2[2 * j]); acc2[2 * j + 1] = __builtin_elementwise_fma(hi, c2, acc2[2 * j + 1]); } } } while (0)
            PV_ROWS(0, 0);
#pragma unroll 1
            for (int c = 0; c < 16; c += 2) {
                PV_ROWS(1, c + 1);
                __builtin_amdgcn_sched_barrier(0);
                PV_FMA(0, c);
                __builtin_amdgcn_sched_barrier(0);
                if (c + 2 < 16) PV_ROWS(0, c + 2);
                __builtin_amdgcn_sched_barrier(0);
                PV_FMA(1, c + 1);
                __builtin_amdgcn_sched_barrier(0);
            }
#undef PV_ROWS
#undef PV_FMA
            const float* gp = MODL + (size_t)(lat ? (tok >> 13) : 4) * 6144 + SW * sl + 16 * m;
#pragma unroll
            for (int j = 0; j < 4; ++j) { const f32x4 g = *(const f32x4*)(gp + 4 * j); const unsigned w0 = j == 0 ? xr0.x : j == 1 ? xr0.z : j == 2 ? xr1.x : xr1.z, w1 = j == 0 ? xr0.y : j == 1 ? xr0.w : j == 2 ? xr1.y : xr1.w;
                const f32x4 o = (f32x4){bflo(w0), bfhi(w0), bflo(w1), bfhi(w1)} + g * (f32x4){acc2[2 * j].x, acc2[2 * j].y, acc2[2 * j + 1].x, acc2[2 * j + 1].y};
                u32x2 w; w.x = cvt_pk_bf16(o[0], o[1]); w.y = cvt_pk_bf16(o[2], o[3]); *(u32x2*)(xp + 4 * j) = w; }
        });
}

#ifdef MK_CHECK
constexpr int CW_CHK = 3840;
__device__ __forceinline__ float blk_sum(float v, LAS float* red) {
    const int t_ = otid(); v = wave_sum(v); __syncthreads(); if ((t_ & 63) == 0) red[t_ >> 6] = v; __syncthreads();
    float s = 0.f; for (int i = 0; i < 8; ++i) s += red[i]; __syncthreads(); return s;
}
__device__ __forceinline__ float fp8f(unsigned b) { const unsigned e = (b >> 3) & 15u, m = b & 7u; const float v = e ? ldexpf(1.f + (float)m * 0.125f, (int)e - 7) : ldexpf((float)m * 0.125f, -6); return (b & 0x80u) ? -v : v; }
__device__ __forceinline__ void check_attn(const Args& A, LAS unsigned char* lds, bool with_ctx) {
    const unsigned char* Q = A.ws + WS_R1 + R1_Q; const unsigned char* KN = A.ws + WS_R1 + R1_KN; const unsigned char* KR = A.ws + WS_BIG + BIG_KR; const unsigned char* V = A.ws + WS_R1 + R1_V;
    const bf16_t* CAT = (const bf16_t*)(A.ws + WS_R3 + R3_CAT); float* chk = (float*)(A.ws + WS_CTL) + CW_CHK;
    LAS float* p = (LAS float*)lds; LAS float* qv = p + NKEY; LAS float* red = qv + 192;
    const int tid = otid();
    for (int au = blockIdx.x; au < (with_ctx ? 1056 : 1024); au += gridDim.x) {
        int b, h, qrow, orow, nkey;
        if (au < 1024) { b = au >> 8; h = au & 7; const int qb = (au >> 3) & 31, l = 256 * qb + (int)((((unsigned)au * 2654435761u) >> 20) & 255u); qrow = 256 + l; orow = b * 8192 + l; nkey = NKEY; }
        else { const int cu = au - 1024; b = cu >> 3; h = cu & 7; const int lc = (int)((((unsigned)au * 2654435761u) >> 20) & 255u); qrow = lc; orow = NLAT + 256 * b + lc; nkey = 256; }
        const size_t bh = (size_t)(b * 8 + h);
        __syncthreads();
        if (tid < 192) qv[tid] = fp8f(Q[(bh * NKEY + qrow) * 192 + tid]) * (1.f / att8::QUP);
        __syncthreads();
        float mx = -1e30f;
        for (int key = tid; key < nkey; key += 512) { const int t = key >> 6, k = key & 63; float sacc = 0.f;
            for (int d = 0; d < 128; ++d) sacc += qv[d] * fp8f(KN[(bh * NKT + t) * 8192 + att8::kn8(k, d)]);
            for (int d = 0; d < 64; ++d) sacc += qv[128 + d] * fp8f(KR[((size_t)b * NKT + t) * 4096 + att8::kr8(k, d)]);
            p[key] = sacc; mx = fmaxf(mx, sacc); }
        for (int o = 32; o >= 1; o >>= 1) mx = fmaxf(mx, __shfl_xor(mx, o));
        __syncthreads(); if ((tid & 63) == 0) red[tid >> 6] = mx; __syncthreads(); mx = red[0]; for (int i = 1; i < 8; ++i) mx = fmaxf(mx, red[i]); __syncthreads();
        float ls = 0.f; for (int key = tid; key < nkey; key += 512) { const float e = exp2f(p[key] - mx); p[key] = e; ls += e; }
        ls = blk_sum(ls, red);
        float num = 0.f, den = 0.f;
        if (tid < 128) { float o = 0.f; for (int key = 0; key < nkey; ++key) o += p[key] * fp8f(V[(bh * NKT + (key >> 6)) * 8192 + att8::v8(tid, key & 63)]);
            o /= ls; const float got = bf2f(CAT[(size_t)orow * 2048 + 1024 + 128 * h + tid]); num = (got - o) * (got - o); den = o * o; }
        num = blk_sum(num, red); den = blk_sum(den, red);
        if (tid == 0) { atomicAdd(chk, num); atomicAdd(chk + 1, den); }
    }
}
__device__ __forceinline__ void check_qkv(const Args& A, int li, LAS unsigned char* lds) {
    float* chk = (float*)(A.ws + WS_CTL) + CW_CHK;
    const unsigned char* Q = A.ws + WS_R1 + R1_Q; const unsigned char* KN = A.ws + WS_R1 + R1_KN; const unsigned char* KR = A.ws + WS_BIG + BIG_KR; const unsigned char* V = A.ws + WS_R1 + R1_V;
    LAS float* hv = (LAS float*)lds; LAS float* cq = hv + 1024; LAS float* ckv = cq + 384; LAS float* kr = ckv + 256; LAS float* red = kr + 64; LAS float* ov = red + 16;
    const int tid = otid(), sidx = blockIdx.x;
    const int hd = sidx & 7; const int r = (sidx & 8) ? NLAT + (int)(((unsigned)sidx * 2654435761u) >> 22) : (int)(((unsigned)sidx * 2654435761u) >> 17);
    const float* win = A.in[I_HWIN] + (size_t)li * 1024 * HYB_IN;
    {
        const bf16_t* xp = (const bf16_t*)(A.ws + WS_XB) + (size_t)r * D; const float* MODL = (const float*)(A.ws + WS_MOD) + (size_t)(2 * li) * 5 * 6144 + (size_t)row_mb(r) * 6144;
        float ss = 0.f; for (int i = tid; i < 1024; i += 512) ss += bf2f(xp[i]) * bf2f(xp[i]);
        ss = blk_sum(ss, red); const float rstd = rsqrtf(ss / 1024.f + EPS);
        for (int i = tid; i < 1024; i += 512) hv[i] = bf2f(f2bf(bf2f(xp[i]) * rstd * A.in[I_N1G][(2 * li) * 1024 + i] * (1.f + MODL[1024 + i]) + MODL[i])); }
    __syncthreads();
    for (int j = tid; j < 704; j += 512) { float s = 0.f; for (int k = 0; k < 1024; ++k) s += hv[k] * win[(size_t)k * HYB_IN + C_CQ + j];
        s = bf2f(f2bf(s)); if (j < 384) cq[j] = s; else if (j < 640) ckv[j - 384] = s; else kr[j - 640] = s; }
    __syncthreads();
    float sq = 0.f, sk = 0.f; for (int j = tid; j < 384; j += 512) sq += cq[j] * cq[j]; for (int j = tid; j < 256; j += 512) sk += ckv[j] * ckv[j];
    sq = blk_sum(sq, red); sk = blk_sum(sk, red);
    const float rq = rsqrtf(sq / 384.f + EPS), rk = rsqrtf(sk / 256.f + EPS);
    const float* wqb = A.in[I_WQB] + (size_t)li * 384 * 1536; const float* wkvb = A.in[I_WKVB] + (size_t)li * 256 * 2048; const float* qg = A.in[I_QNG] + li * 384; const float* kg = A.in[I_KVNG] + li * 256;
    if (tid < 192) { float s = 0.f; for (int k = 0; k < 384; ++k) s += cq[k] * rq * qg[k] * wqb[(size_t)k * 1536 + hd * 192 + tid]; ov[tid] = s; }
    else if (tid < 448) { const int c = tid - 192; float s = 0.f; for (int k = 0; k < 256; ++k) s += ckv[k] * rk * kg[k] * wkvb[(size_t)k * 2048 + hd * 256 + c]; ov[tid] = s; }
    __syncthreads();
    const bool lat = r < NLAT; const int b = lat ? (r >> 13) : ((r - NLAT) >> 8), l = lat ? (r & 8191) : 0, key = lat ? 256 + l : ((r - NLAT) & 255), qrow = key;
    const size_t bh = (size_t)(b * 8 + hd); const float qs = QSCALE * att8::QUP;
    float num = 0.f, den = 0.f;
    if (tid < 128) {
        const float q = ov[tid] * qs, gq = fp8f(Q[(bh * NKEY + qrow) * 192 + tid]);
        const float kk = ov[192 + tid], gk = fp8f(KN[(bh * NKT + (key >> 6)) * 8192 + att8::kn8(key & 63, tid)]);
        const float vv = ov[320 + tid], gv = fp8f(V[(bh * NKT + (key >> 6)) * 8192 + att8::v8(tid, key & 63)]);
        num = (gq - q) * (gq - q) + (gk - kk) * (gk - kk) + (gv - vv) * (gv - vv); den = q * q + kk * kk + vv * vv;
    } else if (tid < 160) {
        const int i = tid - 128; float c = 1.f, sn = 0.f;
        if (lat) { const float pos = (float)(i < 16 ? (l >> 6) : (l & 63)); const float ang = pos * powf(10000.f, -(float)(i & 15) / 16.f); c = cosf(ang); sn = sinf(ang); }
        const float q1 = ov[128 + i] * qs, q2 = ov[160 + i] * qs, k1 = kr[i], k2 = kr[32 + i];
        const float rq1 = q1 * c - q2 * sn, rq2 = q1 * sn + q2 * c, rk1 = k1 * c - k2 * sn, rk2 = k1 * sn + k2 * c;
        const float gq1 = fp8f(Q[(bh * NKEY + qrow) * 192 + 128 + 2 * i]), gq2 = fp8f(Q[(bh * NKEY + qrow) * 192 + 128 + 2 * i + 1]);
        const float gk1 = fp8f(KR[((size_t)b * NKT + (key >> 6)) * 4096 + att8::kr8(key & 63, 2 * i)]), gk2 = fp8f(KR[((size_t)b * NKT + (key >> 6)) * 4096 + att8::kr8(key & 63, 2 * i + 1)]);
        num = (gq1 - rq1) * (gq1 - rq1) + (gq2 - rq2) * (gq2 - rq2) + (gk1 - rk1) * (gk1 - rk1) + (gk2 - rk2) * (gk2 - rk2); den = rq1 * rq1 + rq2 * rq2 + rk1 * rk1 + rk2 * rk2;
    }
    num = blk_sum(num, red); den = blk_sum(den, red);
    if (tid == 0) { atomicAdd(chk, num); atomicAdd(chk + 1, den); }
}
__device__ __forceinline__ void check_topk(const Args& A, int layer, LAS unsigned char* lds) {
    const bf16_t* QP = (const bf16_t*)(A.ws + WS_BIG); const int* IDX = (const int*)(A.ws + WS_R2); const float* GATE = (const float*)(A.ws + WS_R2 + R2_GATE); float* chk = (float*)(A.ws + WS_CTL) + CW_CHK;
    const bf16_t* K1 = (const bf16_t*)(A.ws + WS_W + W_PEER + (size_t)layer * WP_SZ + WP_K1);
    LAS float* sc = (LAS float*)lds; LAS float* v12 = sc + 256; LAS int* i12 = (LAS int*)(v12 + 32); LAS float* cs = (LAS float*)(i12 + 32); LAS float* ts = cs + 256; LAS int* ti = (LAS int*)(ts + 16); LAS float* red = (LAS float*)(ti + 16);
    const int tid = otid();
    for (int smp = blockIdx.x; smp < 1024; smp += gridDim.x) {
        const int h = smp & 7, tok = (int)((((unsigned)smp * 2654435761u) >> 12) % (unsigned)NROW);
        __syncthreads();
        if (tid < 256) { const int half = tid >> 7, key = tid & 127; float a = 0.f;
            for (int d = 0; d < 128; ++d) a += bf2f(QP[(size_t)tok * 2048 + 256 * h + 128 * half + d]) * bf2f(K1[((size_t)half * 8 + h) * 16384 + key * 128 + d]);
            sc[tid] = a; }
        __syncthreads();
        if (tid < 256) { const int half = tid >> 7, key = tid & 127; const float v = sc[tid]; int rank = 0;
            for (int j = 0; j < 128; ++j) { const float o = sc[half * 128 + j]; rank += (o > v || (o == v && j < key)) ? 1 : 0; }
            if (rank < 16) { v12[half * 16 + rank] = v; i12[half * 16 + rank] = key; } }
        __syncthreads();
        if (tid < 256) cs[tid] = v12[tid >> 4] + v12[16 + (tid & 15)];
        __syncthreads();
        if (tid < 256) { const float v = cs[tid]; int rank = 0;
            for (int j = 0; j < 256; ++j) { const float o = cs[j]; rank += (o > v || (o == v && j < tid)) ? 1 : 0; }
            if (rank < 16) { ts[rank] = v; ti[rank] = i12[tid >> 4] * 128 + i12[16 + (tid & 15)]; } }
        __syncthreads();
        float num = 0.f, den = 0.f;
        if (tid < 16) { float es = 0.f; for (int j = 0; j < 16; ++j) es += __expf(ts[j] - ts[0]); const float gn = __expf(ts[tid] - ts[0]) / es; float gk = 0.f;
            for (int j = 0; j < 16; ++j) if (IDX[(size_t)tok * 128 + 16 * h + j] == ti[tid]) gk = GATE[(size_t)tok * 128 + 16 * h + j];
            num = (gk - gn) * (gk - gn); den = gn * gn; }
        num = blk_sum(num, red); den = blk_sum(den, red);
        if (tid == 0) { atomicAdd(chk, num); atomicAdd(chk + 1, den); }
    }
}
__device__ __forceinline__ void check_ssd(const Args& A, int li, LAS unsigned char* lds) {
    const bf16_t* XS = (const bf16_t*)(A.ws + WS_R2); const bf16_t* BC = (const bf16_t*)(A.ws + WS_R2 + R2_BC); const float* DT = (const float*)(A.ws + WS_BIG + BIG_DT);
    const bf16_t* Y0 = (const bf16_t*)(A.ws + WS_H); const bf16_t* Y1 = (const bf16_t*)(A.ws + WS_R3); float* chk = (float*)(A.ws + WS_CTL) + CW_CHK;
    LAS float* red = (LAS float*)lds;
    const int tid = otid(), sidx = blockIdx.x;
    const int b = sidx & 3, d = (sidx >> 2) & 1, h = (sidx >> 3) & 15, p = (int)((((unsigned)sidx * 2654435761u) >> 20) & 63u), g = h >> 3;
    const float a = -__expf(A.in[I_ALOG][li * 32 + d * 16 + h]);
    const bf16_t* Y = d ? Y1 : Y0;
    float hst = 0.f, num = 0.f, den = 0.f;
    for (int step = 0; step < 8448; ++step) {
        int r;
        if (step < 256) r = NLAT + b * 256 + (d ? 255 - step : step); else { const int q = step - 256; r = b * 8192 + (d ? 8191 - q : q); }
        const float dt = DT[(size_t)(d * 16 + h) * NROW + r], x = bf2f(XS[(size_t)r * 1024 + 64 * h + p]);
        float contrib = 0.f;
        if (tid < 128) { hst = __expf(dt * a) * hst + dt * x * bf2f(BC[(size_t)r * 512 + 128 * g + tid]); contrib = hst * bf2f(BC[(size_t)r * 512 + 256 + 128 * g + tid]); }
        if (step % 61 == 0) { const float y = blk_sum(contrib, red); const float got = bf2f(Y[(size_t)r * 1024 + 64 * h + p]); if (tid == 0) { num += (got - y) * (got - y); den += y * y; } }
    }
    if (tid == 0) { atomicAdd(chk, num); atomicAdd(chk + 1, den); }
}
#endif
#ifndef MK_PER_PHASE
#define MK_PER_PHASE 0
#endif
__device__ __forceinline__ int nr_in(int L) { return L <= 2 ? NROW : NLAT; }
__device__ __forceinline__ int nr_out(int L) { return L <= 1 ? NROW : NLAT; }

__global__ void __launch_bounds__(NTHR, 2) fwd(Args A) {
    extern __shared__ __attribute__((aligned(256))) unsigned char smem_raw[];
    LAS unsigned char* smem = (LAS unsigned char*)smem_raw;
    LAS unsigned char* lds = smem + LDS_BASE;
    const int tid = otid();
    if (tid < 64) ((LAS unsigned*)smem)[tid] = 0u;
    __syncthreads();
    XcdBarrier bar = xcd_barrier_post((unsigned*)(A.ws + WS_CTL), (volatile LAS unsigned*)smem);
    if (tid == 0) ((LAS unsigned*)smem)[8] = atomicAdd((unsigned*)(A.ws + WS_CTL) + CW_RANK + 32 * (xb_xcc_id() & 7u), 1u);
    __syncthreads();
    bool need_bar = false;
    const int lo = A.ph_lo, hi = A.ph_hi;
#ifndef PHMASK
#define PHMASK 0xffffffffu
#endif
#define SITE(k) if constexpr (((PHMASK) >> (k)) & 1u)
#ifndef MK_SVAR
#define MK_SVAR 1
#endif
#ifndef MK_REPEAT_SITE
#define MK_REPEAT_SITE -1
#endif
#define REP(k) for (int rep = 0; rep < ((k) == (MK_REPEAT_SITE) ? 2 : 1); ++rep)
#define PH(id) if ([&]() -> bool { if ((id) < lo || (id) >= hi) return false; if (need_bar) xcd_barrier(bar); need_bar = true; return true; }())
    unsigned char* ws = A.ws;
#define TAIL_TAB(units, layer, rlo, rhi) do { const int nx_ = (units) % 256; if (gridDim.x == 256 && (int)blockIdx.x >= nx_) phase_tabcvt(A, layer, (int)blockIdx.x - nx_, 256 - nx_, rlo, rhi); } while (0)
    bf16_t* XB = (bf16_t*)(ws + WS_XB);
    bf16_t* H = (bf16_t*)(ws + WS_H);
    const float* MOD = (const float*)(ws + WS_MOD);

    SITE(0) PH(0) { phase_prologue(A, lds); }
    SITE(1) PH(1) { phase_norm_mod<true>(A.in[I_X], A.in[I_CTX], XB, A.in[I_N1G], MOD, 0, H, NROW); }
    for (int L = 0; L < DEPTH; ++L) {
        const int base = 2 + 16 * L, li = L >> 1; const bool hyb = (L & 1) == 0;
        const float* MODL = MOD + (size_t)L * 5 * 6144;
        unsigned char* WH = ws + WS_W + W_HYB + (size_t)li * WH_SZ; unsigned char* WG = ws + WS_W + W_GM + (size_t)li * WG_SZ; unsigned char* WP = ws + WS_W + W_PEER + (size_t)L * WP_SZ;
        if (hyb) {
            SITE(2) PH(base + 0) REP(2) { pg8::Gemm g{H, (const bf16_t*)(WH + WH_IN), nr_in(L), HYB_INP, 1024, 1024, 1024};
                pg8::EpiBf16<0> e{(bf16_t*)(ws + WS_BIG), HYB_INP}; pg8::gemm_phase(lds, g, e); }
            SITE(3) PH(base + 1) REP(3) { phase_conv(A, li, rep); }
            SITE(4) PH(base + 2) {
                SITE(18) REP(18) { pg8::Gemm g{(const bf16_t*)(ws + WS_BIG) + C_CQ, (const bf16_t*)(WH + WH_QB), L == 0 ? NROW : NLAT, 1536, 384, HYB_INP, 384};
                  EpiQ e{ws + WS_R1 + R1_Q, (const float*)(ws + WS_RSTD), (const float*)(ws + WS_ROPE)}; pg8::gemm_phase(lds, g, e); }
                SITE(19) REP(19) { pg8::Gemm g{(const bf16_t*)(ws + WS_BIG) + C_CKV, (const bf16_t*)(WH + WH_KVB), NROW, 2048, 256, HYB_INP, 256};
                  EpiKV e{ws + WS_R1 + R1_KN, ws + WS_R1 + R1_V, (const float*)(ws + WS_RSTD) + NROW}; pg8::gemm_phase(lds, g, e); }
                SITE(20) REP(20) for (int u = blockIdx.x; u < 528; u += gridDim.x) ssd::g_unit((const bf16_t*)(ws + WS_R2 + R2_BC), (bf16_t*)(ws + WS_BIG + BIG_G), u);
            }
            SITE(5) PH(base + 3) {
                const int xq = (int)blockIdx.x & 7, jq = (int)blockIdx.x >> 3; const bool ssd_wg = (jq & 1) == 0 && gridDim.x == 256;
                if (gridDim.x == 256) {
                    if (ssd_wg) { const int r = jq >> 1, gi = xq + 8 * (r >> 3), hh = r & 7, sb = gi >> 2, sgp = (gi >> 1) & 1, sd = gi & 1;
                        SITE(21) ssd::ssd_unit(sb, 8 * sgp + hh, sd, (const bf16_t*)(ws + WS_R2), (const bf16_t*)(ws + WS_R2 + R2_BC), (const float*)(ws + WS_BIG + BIG_DT), (const bf16_t*)(ws + WS_BIG + BIG_G),
                                               A.in[I_ALOG] + li * 32, sd ? (bf16_t*)(ws + WS_R3) : (bf16_t*)(ws + WS_H), lds); }
                } else {
                    SITE(21) for (int u = blockIdx.x; u < 128; u += gridDim.x) ssd::ssd_unit(u >> 5, (u >> 1) & 15, u & 1, (const bf16_t*)(ws + WS_R2), (const bf16_t*)(ws + WS_R2 + R2_BC), (const float*)(ws + WS_BIG + BIG_DT),
                                               (const bf16_t*)(ws + WS_BIG + BIG_G), A.in[I_ALOG] + li * 32, (u & 1) ? (bf16_t*)(ws + WS_R3) : (bf16_t*)(ws + WS_H), lds);
                }
                const int nmine = gridDim.x == 256 ? (ssd_wg ? 3 : 5) + (L == 0 && !ssd_wg && jq < 8 ? 1 : 0) : 0;
                SITE(22) REP(22) for (int it = 0; gridDim.x == 256 ? it < nmine : (int)blockIdx.x + it * (int)gridDim.x < (L == 0 ? 1056 : 1024); ++it) {
                    int b, h, qrow0, orow0, nt;
                    if (gridDim.x == 256) {
                        const int base_it = ssd_wg ? 3 : 5;
                        if (it < base_it) { const int v = ssd_wg ? 3 * (jq >> 1) + it : 48 + 5 * (jq >> 1) + it; b = v >> 5; h = xq; const int qb = v & 31; qrow0 = 256 + 256 * qb; orow0 = b * 8192 + 256 * qb; nt = NKT; }
                        else { b = jq >> 1; h = xq; qrow0 = 0; orow0 = NLAT + 256 * b; nt = 4; }
                    } else { const int au = (int)blockIdx.x + it * (int)gridDim.x;
                        if (au < 1024) { b = au >> 8; h = au & 7; const int qb = (au >> 3) & 31; qrow0 = 256 + 256 * qb; orow0 = b * 8192 + 256 * qb; nt = NKT; }
                        else { const int cu = au - 1024; b = cu >> 3; h = cu & 7; qrow0 = 0; orow0 = NLAT + 256 * b; nt = 4; } }
                    const size_t bh = (size_t)(b * 8 + h);
                    att8::attn_unit(ws + WS_R1 + R1_Q + (bh * NKEY + qrow0) * 192, ws + WS_R1 + R1_KN + bh * NKT * 8192, ws + WS_BIG + BIG_KR + (size_t)b * NKT * 4096,
                                    ws + WS_R1 + R1_V + bh * NKT * 8192, (bf16_t*)(ws + WS_R3 + R3_CAT) + (size_t)orow0 * 2048 + 1024 + 128 * h, nt, lds);
                }
                if (gridDim.x == 256 && !ssd_wg && L == 2) SITE(11) phase_tabcvt(A, 3, xq + 8 * (jq >> 1), 128, 0, NEXP);
            }
            SITE(6) PH(base + 4) REP(6) { phase_ssd_out(A, li, nr_out(L));
#if defined(MK_CHECK) && MK_CHECK == 1
                if (L == 0) check_attn(A, lds, true);
#elif defined(MK_CHECK) && MK_CHECK == 2
                if (L == 0) check_qkv(A, li, lds);
#elif defined(MK_CHECK) && MK_CHECK == 3
                if (L == 2) check_attn(A, lds, false);
#elif defined(MK_CHECK) && MK_CHECK == 5
                if (L == 0) check_ssd(A, li, lds);
#elif defined(MK_CHECK) && MK_CHECK == 6
                if (L == 2) check_ssd(A, li, lds);
#endif
            }
        } else {
            SITE(7) PH(base + 0) REP(7) { pg8::Gemm g{H, (const bf16_t*)(WG + WG_IN), nr_out(L), 4096, 1024, 1024, 1024};
                pg8::EpiGmIn e{(bf16_t*)(ws + WS_BIG), (float*)(ws + WS_R3)}; pg8::gemm_phase(lds, g, e);
                if (rep == 0 && L == 1) TAIL_TAB((nr_out(L) / 256) * 16, 1, NEXP, 2 * NEXP); }
            SITE(9) PH(base + 2) REP(9) { phase_spatial(A, li, nr_out(L), lds); }
        }
        SITE(10) PH(base + 5) { pg8::Gemm g{hyb ? (const bf16_t*)(ws + WS_R3 + R3_CAT) : (const bf16_t*)(ws + WS_R1), hyb ? (const bf16_t*)(WH + WH_OUT) : (const bf16_t*)(WG + WG_OUT), nr_out(L), 1024, 2048, 2048, 2048};
            pg8::EpiResid e{XB, MODL + 2 * 1024}; pg8::gemm_phase(lds, g, e);
            if (L == 0) TAIL_TAB((nr_out(L) / 256) * 4, 0, 0, 2 * NEXP); else if (L == 1) TAIL_TAB((nr_out(L) / 256) * 4, 2, 0, 2 * NEXP); }
        SITE(11) PH(base + 6) REP(11) { phase_norm_mod<false>(nullptr, nullptr, XB, A.in[I_N2G] + L * 1024, MODL, 3, H, nr_out(L));
            if (gridDim.x != 256) phase_tabcvt(A, L, (int)blockIdx.x, (int)gridDim.x);
            else if (L == 3) phase_tabcvt(A, 3, (int)blockIdx.x, 256, NEXP, 2 * NEXP); }
        SITE(12) PH(base + 7) REP(12) { pg8::Gemm g{H, (const bf16_t*)(WP + WP_Q), nr_out(L), 2048, 1024, 1024, 1024};
            pg8::EpiBf16<0> e{(bf16_t*)(ws + WS_BIG), 2048}; pg8::gemm_phase(lds, g, e);
            if (rep == 0 && L == 0) TAIL_TAB((nr_out(L) / 256) * 8, 1, 0, NEXP); }
        SITE(13) PH(base + 8) REP(13) { phase_topk(A, L, nr_out(L), lds); }
        SITE(14) PH(base + 9) REP(14) { phase_peer_u(A, L, nr_out(L), smem, rep); }
        SITE(15) PH(base + 10) REP(15) { phase_coef(A, L, nr_out(L));
#if defined(MK_CHECK) && MK_CHECK == 4
            if (L == 1) check_topk(A, L, lds);
#endif
        }
        SITE(16) PH(base + 11) { phase_peer_v(A, L, nr_out(L), smem, 0); }
        SITE(17) PH(base + 12) { if (L < DEPTH - 1) phase_norm_mod<false>(nullptr, nullptr, XB, A.in[I_N1G] + (L + 1) * 1024, MOD + (size_t)(L + 1) * 5 * 6144, 0, H, nr_in(L + 1));
                        else {
#ifdef MK_CHECK
                            const float* chk = (const float*)(ws + WS_CTL) + CW_CHK; const float err = sqrtf(chk[0] / fmaxf(chk[1], 1e-30f));
                            phase_final_norm(XB, A.out, A.in[I_FNG], 1.f + 10.f * err);
#else
                            phase_final_norm(XB, A.out, A.in[I_FNG], 1.f);
#endif
                        } }
    }
#undef PH
}

#ifdef MK_TAP
__global__ void tap_kernel(const unsigned short* buf, size_t pitch, size_t col0, size_t ncols, size_t nrows, float* out) {
    const size_t n = ncols * nrows;
    for (size_t i = (size_t)blockIdx.x * blockDim.x + threadIdx.x; i < (size_t)NLAT * D; i += (size_t)gridDim.x * blockDim.x) {
        float s = 0.f; for (size_t j = i; j < n; j += (size_t)NLAT * D) s += (float)buf[(j / ncols) * pitch + col0 + (j % ncols)]; out[i] = s; }
}
#endif
extern "C" void kernel_launch(void* const* d_in, const int* in_sizes, int n_in, void* d_out, int out_size, void* d_ws, size_t ws_size, hipStream_t stream) {
    static int grid = 0;
    if (grid == 0) {
        if (n_in != N_IN || out_size != NLAT * D || ws_size < WS_END) { fprintf(stderr, "kernel_launch: unexpected shapes (n_in %d out %d ws %zu, need %zu)\n", n_in, out_size, ws_size, (size_t)WS_END); grid = -1; return; }
        int dev = 0, cus = 0, per_cu = 0;
        if (hipGetDevice(&dev) != hipSuccess || hipDeviceGetAttribute(&cus, hipDeviceAttributeMultiprocessorCount, dev) != hipSuccess) { grid = -1; return; }
        if (hipFuncSetAttribute((const void*)fwd, hipFuncAttributeMaxDynamicSharedMemorySize, LDS_BYTES) != hipSuccess) { fprintf(stderr, "kernel_launch: hipFuncSetAttribute failed\n"); grid = -1; return; }
        if (hipOccupancyMaxActiveBlocksPerMultiprocessor(&per_cu, (const void*)fwd, NTHR, LDS_BYTES) != hipSuccess || per_cu < 1) { fprintf(stderr, "kernel_launch: occupancy query says %d\n", per_cu); }
        (void)hipGetLastError();
        grid = cus;
    }
    if (grid < 0) return;
    (void)hipMemsetAsync((char*)d_ws + WS_CTL, 0, CTL_BYTES, stream);
    Args a{};
    for (int i = 0; i < N_IN; ++i) a.in[i] = (const float*)d_in[i];
    a.out = (float*)d_out; a.ws = (unsigned char*)d_ws;
#if MK_PER_PHASE
    for (int id = 0; id < 2 + 16 * DEPTH; ++id) {
        if (id >= 2) { const int L = (id - 2) / 16, s = (id - 2) % 16; if (s > 12) continue; if ((L & 1) && (s == 3 || s == 4)) continue; }
#ifdef MK_CUT
#ifdef MK_TAP
        if (id >= MK_CUT) continue;
#else
        if (id >= MK_CUT && id != 2 + 16 * (DEPTH - 1) + 12) continue;
#endif
#endif
        a.ph_lo = id; a.ph_hi = id + 1;
        hipLaunchKernelGGL(fwd, dim3(grid), dim3(NTHR), LDS_BYTES, stream, a);
    }
#ifdef MK_TAP
    { const size_t tp[5] = {MK_TAP}; hipLaunchKernelGGL(tap_kernel, dim3(2048), dim3(256), 0, stream, (const unsigned short*)((const char*)d_ws + tp[0]), tp[1], tp[2], tp[3], tp[4], (float*)d_out); }
#endif
#else
    a.ph_lo = 0; a.ph_hi = 2 + 16 * DEPTH;
    hipLaunchKernelGGL(fwd, dim3(grid), dim3(NTHR), LDS_BYTES, stream, a);
#endif
    const hipError_t le = hipPeekAtLastError();
    if (le != hipSuccess) fprintf(stderr, "kernel_launch: launch failed: %s\n", hipGetErrorName(le));
}
```

```cpp
#include <hip/hip_runtime.h>
#include <cstdio>
#include <cstdint>

#define LAS __attribute__((address_space(3)))
typedef unsigned short bf16_t;
typedef short bf16x8 __attribute__((ext_vector_type(8)));
typedef short s16x4 __attribute__((ext_vector_type(4)));
typedef float f32x2 __attribute__((ext_vector_type(2)));
typedef float f32x4 __attribute__((ext_vector_type(4)));
typedef float f32x16 __attribute__((ext_vector_type(16)));
typedef unsigned u32x2 __attribute__((ext_vector_type(2)));
typedef unsigned u32x4 __attribute__((ext_vector_type(4)));
typedef int i32x4 __attribute__((ext_vector_type(4)));
typedef int i32x8 __attribute__((ext_vector_type(8)));

constexpr int D = 1024, NB = 4, SEQ = 8192, DEPTH = 4, CTXL = 256;
constexpr int NLAT = NB * SEQ, NCTX = NB * CTXL, NROW = NLAT + NCTX;
constexpr int HYB_IN = 3280, HYB_INP = 3328;
constexpr int C_Z = 0, C_XBC = 1024, C_DT = 2560, C_CQ = 2576, C_CKV = 2960, C_KR = 3216;
constexpr int NKEY = SEQ + CTXL, NKT = NKEY / 64;
constexpr float EPS = 1e-6f;
constexpr float QSCALE = 0.07216878364870322f * 1.4426950408889634f;
constexpr int NEXP = 16384;

enum { I_X = 0, I_C, I_CTX, I_CCTX, I_ADAW, I_ADAB, I_N1G, I_N2G, I_HWIN, I_CONVW, I_CONVB, I_ALOG, I_DTB, I_SSDD, I_SSDNG, I_QNG, I_WQB, I_KVNG, I_WKVB,
       I_HWOUT, I_GWIN, I_GLNG, I_GLNB, I_GWS, I_GBS, I_GWOUT, I_PWQ, I_PK1, I_PK2, I_PU, I_PV, I_FNG, N_IN };

constexpr size_t al256(size_t x) { return (x + 255) & ~(size_t)255; }
constexpr size_t WS_CTL = 0, CTL_BYTES = 65536;
constexpr size_t WS_MOD = WS_CTL + CTL_BYTES;
constexpr size_t WS_ROPE = WS_MOD + al256((size_t)DEPTH * 5 * 6144 * 4);
constexpr size_t WS_RSTD = WS_ROPE + (size_t)2 * SEQ * 32 * 4;
constexpr size_t WS_W = WS_RSTD + al256((size_t)2 * NROW * 4);
constexpr size_t W_HYB = 0;
constexpr size_t WH_IN = 0, WH_QB = WH_IN + (size_t)HYB_INP * 1024 * 2, WH_KVB = WH_QB + (size_t)1536 * 384 * 2, WH_OUT = WH_KVB + (size_t)2048 * 256 * 2,
                 WH_SZ = WH_OUT + (size_t)1024 * 2048 * 2;
constexpr size_t W_GM = W_HYB + 2 * WH_SZ;
constexpr size_t WG_IN = 0, WG_OUT = WG_IN + (size_t)4096 * 1024 * 2, WG_WS = WG_OUT + (size_t)1024 * 2048 * 2, WG_SZ = WG_WS + (size_t)8 * 128 * 128 * 2;
constexpr size_t W_PEER = W_GM + 2 * WG_SZ;
constexpr size_t WP_Q = 0, WP_K1 = WP_Q + (size_t)2048 * 1024 * 2, WP_K2 = WP_K1 + (size_t)8 * 128 * 128 * 2, WP_SZ = WP_K2 + (size_t)8 * 128 * 128 * 2;
constexpr size_t W_TOTAL = W_PEER + 4 * WP_SZ;
constexpr size_t WS_TAB = WS_W + al256(W_TOTAL);
constexpr size_t TAB_HALF = (size_t)NEXP * 1024 * 2;
constexpr size_t TAB_REGION = 2 * TAB_HALF + 524288;
constexpr size_t WS_XB = WS_TAB + TAB_REGION;
constexpr size_t WS_H = WS_XB + (size_t)NROW * D * 2;
constexpr size_t WS_BIG = WS_H + (size_t)NROW * D * 2;
constexpr size_t BIG_BYTES = (size_t)NROW * 4096 * 2;
constexpr size_t BIG_DT = (size_t)NROW * HYB_INP * 2;
constexpr size_t BIG_G = BIG_DT + (size_t)NROW * 32 * 4;
constexpr size_t BIG_KR = BIG_G + (size_t)528 * 128 * 128 * 2;
constexpr size_t BIG_PART = (size_t)NROW * 2048 * 2;
static_assert(BIG_KR + (size_t)NB * NKT * 8192 <= BIG_BYTES, "BIG tail");
constexpr size_t WS_R1 = WS_BIG + BIG_BYTES;
constexpr size_t R1_Q = 0, R1_KN = R1_Q + (size_t)NB * 8 * NKEY * 192, R1_V = R1_KN + (size_t)NB * 8 * NKT * 8192, R1_HYB = R1_V + (size_t)NB * 8 * NKT * 8192,
                 R1_GM = (size_t)NROW * 2048 * 2, R1_BYTES = R1_HYB > R1_GM ? R1_HYB : R1_GM;
constexpr size_t WS_R2 = WS_R1 + R1_BYTES;
constexpr size_t R2_BC = (size_t)NROW * 1024 * 2, R2_BYTES = R2_BC + (size_t)NROW * 512 * 2;
constexpr size_t R2_GATE = (size_t)NROW * 128 * 4, R2_COEF = 2 * R2_GATE;
constexpr size_t WS_R3 = WS_R2 + R2_BYTES;
constexpr size_t R3_CAT = (size_t)NROW * 1024 * 2, R3_BYTES = R3_CAT + (size_t)NROW * 2048 * 2;
constexpr size_t WS_END = WS_R3 + R3_BYTES;
static_assert(WS_END <= ((size_t)1 << 30), "workspace must fit 1 GiB");

constexpr int CW_RANK = 3584;
constexpr int CW_QUEUE = 4096;

typedef __bf16 bf16x2_t __attribute__((ext_vector_type(2)));
__device__ __forceinline__ unsigned cvt_pk_bf16(float lo, float hi) { const f32x2 v = {lo, hi}; const bf16x2_t b = __builtin_convertvector(v, bf16x2_t); return __builtin_bit_cast(unsigned, b); }
__device__ __forceinline__ bf16_t f2bf(float f) { return (bf16_t)(cvt_pk_bf16(f, 0.f) & 0xffffu); }
__device__ __forceinline__ float bf2f(unsigned b) { return __uint_as_float(b << 16); }
__device__ __forceinline__ float bflo(unsigned w) { return __uint_as_float(w << 16); }
__device__ __forceinline__ float bfhi(unsigned w) { return __uint_as_float(w & 0xffff0000u); }
__device__ __forceinline__ float wave_sum(float v) {
#pragma unroll
    for (int o = 32; o >= 1; o >>= 1) v += __shfl_xor(v, o);
    return v;
}
__device__ __forceinline__ int otid() { int t = threadIdx.x; asm volatile("" : "+v"(t)); return t; }
__device__ __forceinline__ float silu_f(float x) { return x * __builtin_amdgcn_rcpf(1.f + __expf(-x)); }
__device__ __forceinline__ float softplus_f(float x) { return x > 20.f ? x : log1pf(__expf(x)); }
__device__ __forceinline__ f32x2 gelu_pk(f32x2 v) {
    const f32x2 av = __builtin_elementwise_abs(v), d = av * 0.2316418882f + 1.0f;
    f32x2 t; t.x = __builtin_amdgcn_rcpf(d.x); t.y = __builtin_amdgcn_rcpf(d.y);
    f32x2 q = t * 0.5307027145f + (-0.7265760135f); q = q * t + 0.7107068705f; q = q * t + (-0.142248368f); q = q * t + 0.127414796f; q = q * t;
    const f32x2 s = (v * v) * (-0.72134752044f);
    f32x2 e; e.x = __builtin_amdgcn_exp2f(s.x); e.y = __builtin_amdgcn_exp2f(s.y);
    const f32x2 m = v * (q * e), r = v - m;
    f32x2 o; o.x = v.x < 0.f ? m.x : r.x; o.y = v.y < 0.f ? m.y : r.y; return o;
}
__device__ __forceinline__ float gelu_f(float x) { f32x2 v = {x, 0.f}; return gelu_pk(v).x; }

__device__ __forceinline__ unsigned pk4_fp8(float a, float b, float c, float d) { int w = 0; w = __builtin_amdgcn_cvt_pk_fp8_f32(a, b, w, false); w = __builtin_amdgcn_cvt_pk_fp8_f32(c, d, w, true); return (unsigned)w; }
__device__ __forceinline__ float sat8(float v) { return __builtin_amdgcn_fmed3f(v, -448.f, 448.f); }
__device__ __forceinline__ unsigned pk4_fp8_sat(float a, float b, float c, float d) { return pk4_fp8(sat8(a), sat8(b), sat8(c), sat8(d)); }
__device__ __forceinline__ int row_mb(int r) { return r < NLAT ? (r >> 13) : 4; }

#define XB_TMO      128
#define XB_XCNT(j)  (256  + 64 * (j))
#define XB_XSUB(j)  (1280 + 64 * (j))
#define XB_XGEN(j)  (2304 + 64 * (j))
#define XB_TOP      3328
#define XB_TOPGEN   3392
#define XCD_BAR_WORDS 3456
#define XB_SPIN_CAP (1u << 22)
__device__ __forceinline__ unsigned xb_ld(unsigned* p)              { return __hip_atomic_load(p, __ATOMIC_RELAXED, __HIP_MEMORY_SCOPE_AGENT); }
__device__ __forceinline__ unsigned xb_add(unsigned* p, unsigned v) { return __hip_atomic_fetch_add(p, v, __ATOMIC_RELAXED, __HIP_MEMORY_SCOPE_AGENT); }
__device__ __forceinline__ unsigned xb_xcc_id() { return (unsigned)__builtin_amdgcn_s_getreg((3 << 11) | 20) & 0xFu; }
#define XB_SPIN(cond, bar) do { unsigned _sp = 0; while (cond) { __builtin_amdgcn_s_sleep(1); \
    if ((++_sp & 255u) == 0u) { if (xb_ld(&(bar)[XB_TMO])) break; if (_sp > XB_SPIN_CAP) { atomicAdd(&(bar)[XB_TMO], 1u); break; } } } } while (0)
struct XcdBarrier { unsigned* bar; unsigned x; volatile LAS unsigned* st; };
__device__ __forceinline__ XcdBarrier xcd_barrier_post(unsigned* bar, volatile LAS unsigned* st) {
    XcdBarrier b; b.bar = bar; b.x = xb_xcc_id(); b.st = st;
    if (threadIdx.x == 0) (void)xb_add(&bar[XB_XCNT(b.x)], 1u);
    return b;
}
__device__ __forceinline__ void xcd_barrier_complete(unsigned* bar, unsigned x, unsigned& nloc, unsigned& nx) {
    const unsigned G = gridDim.x * gridDim.y * gridDim.z;
    unsigned sum, cnt, mine, sp = 0u;
    for (;;) {
        sum = 0u; cnt = 0u; mine = 0u;
#pragma unroll
        for (unsigned j = 0; j < 16; ++j) { const unsigned c = xb_ld(&bar[XB_XCNT(j)]); sum += c; cnt += (c > 0u) ? 1u : 0u; mine = (j == x) ? c : mine; }
        if (sum == G) break;
        __builtin_amdgcn_s_sleep(1);
        if ((++sp & 255u) == 0u) { if (xb_ld(&bar[XB_TMO])) break; if (sp > XB_SPIN_CAP) { atomicAdd(&bar[XB_TMO], 1u); break; } }
    }
    nloc = mine > 0u ? mine : 1u; nx = cnt > 0u ? cnt : 1u;
}
__device__ __forceinline__ void xcd_barrier(const XcdBarrier& b) {
    asm volatile("s_waitcnt vmcnt(0)" ::: "memory");
    __syncthreads();
    if (threadIdx.x == 0) {
        unsigned* bar = b.bar;
        __builtin_amdgcn_s_waitcnt(0);
        unsigned nloc = b.st[0], nx = b.st[1];
        if (nloc == 0u) { xcd_barrier_complete(bar, b.x, nloc, nx); b.st[0] = nloc; b.st[1] = nx; }
        const unsigned old = xb_add(&bar[XB_XSUB(b.x)], 1u);
        const unsigned gen = old / nloc;
        if (old + 1u == (gen + 1u) * nloc) {
            __builtin_amdgcn_fence(__ATOMIC_RELEASE, "agent");
            asm volatile("s_waitcnt vmcnt(0)" ::: "memory");
            const unsigned og = xb_add(&bar[XB_TOP], 1u);
            const unsigned tg = og / nx;
            if (og + 1u == (tg + 1u) * nx) xb_add(&bar[XB_TOPGEN], 1u);
            else XB_SPIN(xb_ld(&bar[XB_TOPGEN]) == tg, bar);
            __builtin_amdgcn_fence(__ATOMIC_ACQUIRE, "agent");
            xb_add(&bar[XB_XGEN(b.x)], 1u);
            asm volatile("s_waitcnt vmcnt(0)" ::: "memory");
        } else {
            XB_SPIN(xb_ld(&bar[XB_XGEN(b.x)]) == gen, bar);
            __builtin_amdgcn_fence(__ATOMIC_ACQUIRE, "agent");
            asm volatile("s_waitcnt vmcnt(0)" ::: "memory");
        }
    }
    __syncthreads();
}

namespace pg8 {
constexpr int BM = 256, BK = 64, HALF = 128, HTB = HALF * BK * 2, STAGE_BYTES = 8 * HTB, NXCD = 8, WGM = 8;
__host__ __device__ __forceinline__ int lds_byte(int r, int c) { const int st = (r >> 4) * 2 + (c >> 5), rr = r & 15, cc = c & 31, ob = rr * 64 + cc * 2; return st * 1024 + (ob ^ (((ob >> 9) & 1) << 5)); }
__host__ __device__ __forceinline__ void stage_rc(int b, int& R, int& C) { const int st = b / 1024, sb = b % 1024, swz = sb ^ (((sb >> 9) & 1) << 5); R = (st >> 1) * 16 + swz / 64; C = (st & 1) * 32 + (swz % 64) / 2; }
__host__ __device__ __forceinline__ int perm32(int rho) { const int n = rho >> 4, i = rho & 15; return 8 * (i >> 2) + 4 * n + (i & 3); }
struct Unit { int pm, pn; };
struct Gemm { const bf16_t* A; const bf16_t* Bt; int M, N, K, lda, ldb; };
struct StaticOrder {
    int nM, nN, nwg, G, c;
    __device__ void init(int M, int N, int G_, int c_) { nM = M / BM; nN = N / BM; nwg = nM * nN; G = G_; c = c_; }
    __device__ bool next(int i, Unit& u) const {
        const long L = (long)i * G + c; if (L >= nwg) return false;
        int wgid = (int)L; { const int q = nwg / NXCD, r = nwg % NXCD, xcd = wgid % NXCD, off = wgid / NXCD; wgid = (xcd < r ? xcd * (q + 1) : r * (q + 1) + (xcd - r) * q) + off; }
        const int nig = WGM * nN, gid = wgid / nig, fm = gid * WGM, gsz = (nM - fm) < WGM ? (nM - fm) : WGM;
        u.pm = fm + ((wgid % nig) % gsz); u.pn = (wgid % nig) / gsz; return true;
    }
};
template <class Epi>
__device__ __forceinline__ void gemm_phase(LAS unsigned char* lds, const Gemm g, const Epi& E) {
    const int tid = otid(), wid = __builtin_amdgcn_readfirstlane(tid >> 6), lane = tid & 63, wr = wid >> 2, wc = wid & 3, fr = lane & 15, fq = lane >> 4;
    StaticOrder S; S.init(g.M, g.N, (int)gridDim.x, (int)blockIdx.x);
    int K = g.K; asm volatile("" : "+s"(K));
    const int nt = K / BK;
    unsigned voffA[2], voffB[2];
#pragma unroll
    for (int i = 0; i < 2; ++i) { int R, C; stage_rc(tid * 16 + i * 8192, R, C); const int Rb = Epi::PERM ? ((R & ~31) + perm32(R & 31)) : R;
        voffA[i] = (unsigned)(R * g.lda + C) * 2u; voffB[i] = (unsigned)(Rb * g.ldb + C) * 2u; }
    const size_t kstep = (size_t)(BK * 2);
    const size_t hstepA = (size_t)HALF * g.lda * 2, hstepB = (size_t)HALF * g.ldb * 2;
    const size_t tstepA = 2 * hstepA, tstepB = 2 * hstepB;
    const unsigned ldsw = (unsigned)wid * 1024u;
    const int aoff = lds_byte(wr * 64 + fr, fq * 8), boff = lds_byte(wc * 32 + fr, fq * 8);
#define PG8_SA(b, h) (((b) * 2 + (h)) * HTB)
#define PG8_SB(b, h) ((4 + (b) * 2 + (h)) * HTB)
#define PG8_STAGE(bufoff, gbase, voff) do { _Pragma("unroll") for (int _i = 0; _i < 2; ++_i) \
        __builtin_amdgcn_global_load_lds((const unsigned*)((const char*)(gbase) + (voff)[_i]), (LAS unsigned*)(lds + (bufoff) + ldsw + _i * 8192), 16, 0, 0); } while (0)
#define PG8_LDA(dst, b, h) do { _Pragma("unroll") for (int m = 0; m < 4; ++m) _Pragma("unroll") for (int k = 0; k < 2; ++k) dst[m][k] = *(const LAS bf16x8*)(lds + PG8_SA(b, h) + aoff + m * 2048 + k * 1024); } while (0)
#define PG8_LDB(dst, b, h) do { _Pragma("unroll") for (int n = 0; n < 2; ++n) _Pragma("unroll") for (int k = 0; k < 2; ++k) dst[n][k] = *(const LAS bf16x8*)(lds + PG8_SB(b, h) + boff + n * 2048 + k * 1024); } while (0)
#define PG8_MMA(ai, bj, At, Bt) do { __builtin_amdgcn_s_setprio(1); _Pragma("unroll") for (int m = 0; m < 4; ++m) _Pragma("unroll") for (int n = 0; n < 2; ++n) _Pragma("unroll") for (int k = 0; k < 2; ++k) \
        acc[ai][bj][m][n] = __builtin_amdgcn_mfma_f32_16x16x32_bf16(Bt[n][k], At[m][k], acc[ai][bj][m][n], 0, 0, 0); __builtin_amdgcn_s_setprio(0); } while (0)
#define PG8_WAIT_V(n) asm volatile("s_waitcnt vmcnt(" #n ")" ::: "memory")
#define PG8_WAIT_L(n) asm volatile("s_waitcnt lgkmcnt(" #n ")" ::: "memory")
#define PG8_BAR __builtin_amdgcn_s_barrier()
#define PG8_SCHED __builtin_amdgcn_sched_barrier(0)
    Unit cur, nxt; int ui = 0;
    if (!S.next(0, cur)) return;
    f32x4 acc[2][2][4][2];
#pragma unroll
    for (int a = 0; a < 2; ++a)
#pragma unroll
        for (int b = 0; b < 2; ++b)
#pragma unroll
            for (int m = 0; m < 4; ++m)
#pragma unroll
                for (int n = 0; n < 2; ++n) acc[a][b][m][n] = (f32x4){0.f, 0.f, 0.f, 0.f};
    bf16x8 At[4][2], B0[2][2], B1[2][2];
    const char* cA = (const char*)g.A + (size_t)cur.pm * tstepA; const char* cB = (const char*)g.Bt + (size_t)cur.pn * tstepB;
    PG8_STAGE(PG8_SB(0, 0), cB, voffB); PG8_STAGE(PG8_SB(0, 1), cB + hstepB, voffB); PG8_STAGE(PG8_SA(0, 0), cA, voffA); PG8_STAGE(PG8_SA(0, 1), cA + hstepA, voffA);
    if (wr == 1) PG8_BAR;
    PG8_WAIT_V(2); PG8_BAR;
    PG8_STAGE(PG8_SB(1, 0), cB + kstep, voffB); PG8_STAGE(PG8_SA(1, 0), cA + kstep, voffA); PG8_STAGE(PG8_SB(1, 1), cB + hstepB + kstep, voffB);
    PG8_WAIT_V(6); PG8_BAR;
    for (;;) {
        const bool has_next = S.next(ui + 1, nxt);
        const char* nA = has_next ? (const char*)g.A + (size_t)nxt.pm * tstepA : cA; const char* nB = has_next ? (const char*)g.Bt + (size_t)nxt.pn * tstepB : cB;
        for (int t = 0; t < nt; t += 2) {
            const bool last = (t == nt - 2);
            const char* a1 = cA + (size_t)(t + 1) * kstep;
            const char* a2 = last ? nA : cA + (size_t)(t + 2) * kstep; const char* b2 = last ? nB : cB + (size_t)(t + 2) * kstep;
            const char* a3 = a2 + kstep; const char* b3 = b2 + kstep;
            PG8_LDB(B0, 0, 0); PG8_LDB(B1, 0, 1); PG8_SCHED; PG8_LDA(At, 0, 0); PG8_STAGE(PG8_SA(1, 1), a1 + hstepA, voffA);
            PG8_WAIT_V(8); PG8_WAIT_L(0); PG8_BAR; PG8_MMA(0, 0, At, B0); PG8_MMA(0, 1, At, B1); PG8_BAR; PG8_SCHED;
            PG8_LDA(At, 0, 1); PG8_STAGE(PG8_SB(0, 0), b2, voffB); PG8_STAGE(PG8_SB(0, 1), b2 + hstepB, voffB); PG8_STAGE(PG8_SA(0, 0), a2, voffA);
            PG8_WAIT_V(8); PG8_WAIT_L(0); PG8_BAR; PG8_MMA(1, 0, At, B0); PG8_MMA(1, 1, At, B1); PG8_BAR; PG8_SCHED;
            PG8_LDB(B0, 1, 0); PG8_LDB(B1, 1, 1); PG8_SCHED; PG8_LDA(At, 1, 0); PG8_STAGE(PG8_SA(0, 1), a2 + hstepA, voffA);
            PG8_WAIT_V(8); PG8_WAIT_L(0); PG8_BAR; PG8_MMA(0, 0, At, B0); PG8_MMA(0, 1, At, B1); PG8_BAR; PG8_SCHED;
            PG8_LDA(At, 1, 1); PG8_STAGE(PG8_SB(1, 0), b3, voffB); PG8_STAGE(PG8_SB(1, 1), b3 + hstepB, voffB); PG8_STAGE(PG8_SA(1, 0), a3, voffA);
            PG8_WAIT_V(8); PG8_WAIT_L(0); PG8_BAR; PG8_MMA(1, 0, At, B0); PG8_MMA(1, 1, At, B1); PG8_BAR; PG8_SCHED;
        }
        if (wr == 0) PG8_BAR;
        { const int l2_ = otid() & 63; E(acc, cur, wr, wc, l2_ & 15, l2_ >> 4); }
        if (!has_next) break;
#pragma unroll
        for (int a = 0; a < 2; ++a)
#pragma unroll
            for (int b = 0; b < 2; ++b)
#pragma unroll
                for (int m = 0; m < 4; ++m)
#pragma unroll
                    for (int n = 0; n < 2; ++n) acc[a][b][m][n] = (f32x4){0.f, 0.f, 0.f, 0.f};
        cur = nxt; cA = nA; cB = nB; ++ui;
        if (wr == 1) PG8_BAR;
    }
    PG8_WAIT_V(0);
    PG8_BAR;
#undef PG8_SA
#undef PG8_SB
#undef PG8_STAGE
#undef PG8_LDA
#undef PG8_LDB
#undef PG8_MMA
#undef PG8_WAIT_V
#undef PG8_WAIT_L
#undef PG8_BAR
#undef PG8_SCHED
}

template <int ACT> struct EpiBf16 {
    static constexpr bool PERM = true;
    bf16_t* O; int ldc;
    __device__ __forceinline__ void operator()(const f32x4 (&acc)[2][2][4][2], const Unit& u, int wr, int wc, int fr, int fq) const {
        const int row0 = u.pm * BM + wr * 64 + fr, col0 = u.pn * BM + wc * 32 + 8 * fq;
#pragma unroll
        for (int ai = 0; ai < 2; ++ai)
#pragma unroll
            for (int m = 0; m < 4; ++m) { bf16_t* rowp = O + (size_t)(row0 + ai * HALF + m * 16) * ldc + col0;
#pragma unroll
                for (int bj = 0; bj < 2; ++bj) { f32x4 v0 = acc[ai][bj][m][0], v1 = acc[ai][bj][m][1];
                    if (ACT == 1) { f32x2 a = gelu_pk((f32x2){v0[0], v0[1]}), b = gelu_pk((f32x2){v0[2], v0[3]}), c = gelu_pk((f32x2){v1[0], v1[1]}), d = gelu_pk((f32x2){v1[2], v1[3]});
                        v0 = (f32x4){a.x, a.y, b.x, b.y}; v1 = (f32x4){c.x, c.y, d.x, d.y}; }
                    u32x4 w; w.x = cvt_pk_bf16(v0[0], v0[1]); w.y = cvt_pk_bf16(v0[2], v0[3]); w.z = cvt_pk_bf16(v1[0], v1[1]); w.w = cvt_pk_bf16(v1[2], v1[3]);
                    *(u32x4*)(rowp + bj * HALF) = w; } }
    }
};
struct EpiGmIn {
    static constexpr bool PERM = true;
    bf16_t* O; float* parts;
    __device__ __forceinline__ void operator()(const f32x4 (&acc)[2][2][4][2], const Unit& u, int wr, int wc, int fr, int fq) const {
        const int row0 = u.pm * BM + wr * 64 + fr, col0 = u.pn * BM + wc * 32 + 8 * fq; const bool vhalf = u.pn >= 8;
#pragma unroll
        for (int ai = 0; ai < 2; ++ai)
#pragma unroll
            for (int m = 0; m < 4; ++m) { const int row = row0 + ai * HALF + m * 16; bf16_t* rowp = O + (size_t)row * 4096 + col0; f32x2 sa = {0.f, 0.f}, sq = {0.f, 0.f};
#pragma unroll
                for (int bj = 0; bj < 2; ++bj) { const f32x4 v0 = acc[ai][bj][m][0], v1 = acc[ai][bj][m][1];
                    const f32x2 a = gelu_pk((f32x2){v0[0], v0[1]}), b = gelu_pk((f32x2){v0[2], v0[3]}), c = gelu_pk((f32x2){v1[0], v1[1]}), d = gelu_pk((f32x2){v1[2], v1[3]});
                    sa += (a + b) + (c + d); sq += (a * a + b * b) + (c * c + d * d);
                    u32x4 w; w.x = cvt_pk_bf16(a.x, a.y); w.y = cvt_pk_bf16(b.x, b.y); w.z = cvt_pk_bf16(c.x, c.y); w.w = cvt_pk_bf16(d.x, d.y);
                    *(u32x4*)(rowp + bj * HALF) = w; }
                if (vhalf) { float s1 = sa.x + sa.y, s2 = sq.x + sq.y;
                    { auto r = __builtin_amdgcn_permlane16_swap(__float_as_uint(s1), __float_as_uint(s1), false, false); s1 = __uint_as_float(r[0]) + __uint_as_float(r[1]); }
                    { auto r = __builtin_amdgcn_permlane16_swap(__float_as_uint(s2), __float_as_uint(s2), false, false); s2 = __uint_as_float(r[0]) + __uint_as_float(r[1]); }
                    { auto r = __builtin_amdgcn_permlane32_swap(__float_as_uint(s1), __float_as_uint(s1), false, false); s1 = __uint_as_float(r[0]) + __uint_as_float(r[1]); }
                    { auto r = __builtin_amdgcn_permlane32_swap(__float_as_uint(s2), __float_as_uint(s2), false, false); s2 = __uint_as_float(r[0]) + __uint_as_float(r[1]); }
                    if (fq == 0) *(f32x2*)(parts + ((size_t)row * 32 + (u.pn - 8) * 4 + wc) * 2) = (f32x2){s1, s2}; } }
    }
};
struct EpiResid {
    static constexpr bool PERM = true;
    bf16_t* X; const float* gate;
    __device__ __forceinline__ void operator()(const f32x4 (&acc)[2][2][4][2], const Unit& u, int wr, int wc, int fr, int fq) const {
        const int rbase = u.pm * BM;
        const float* gp = gate + (size_t)(rbase < NLAT ? (rbase >> 13) : 4) * 6144;
        const int row0 = rbase + wr * 64 + fr, col0 = u.pn * BM + wc * 32 + 8 * fq;
        f32x4 gv[2][2];
#pragma unroll
        for (int bj = 0; bj < 2; ++bj)
#pragma unroll
            for (int n = 0; n < 2; ++n) gv[bj][n] = *(const f32x4*)(gp + col0 + bj * HALF + n * 4);
#pragma unroll
        for (int ai = 0; ai < 2; ++ai)
#pragma unroll
            for (int m = 0; m < 4; ++m) { bf16_t* rowp = X + (size_t)(row0 + ai * HALF + m * 16) * D + col0;
#pragma unroll
                for (int bj = 0; bj < 2; ++bj) { u32x4* p = (u32x4*)(rowp + bj * HALF); const u32x4 x = *p;
                    const f32x4 a0 = (f32x4){bflo(x.x), bfhi(x.x), bflo(x.y), bfhi(x.y)} + gv[bj][0] * acc[ai][bj][m][0], a1 = (f32x4){bflo(x.z), bfhi(x.z), bflo(x.w), bfhi(x.w)} + gv[bj][1] * acc[ai][bj][m][1];
                    u32x4 w; w.x = cvt_pk_bf16(a0[0], a0[1]); w.y = cvt_pk_bf16(a0[2], a0[3]); w.z = cvt_pk_bf16(a1[0], a1[1]); w.w = cvt_pk_bf16(a1[2], a1[3]);
                    *p = w; } }
    }
};
}

namespace att {
#define KSWZ(row, colB) ((row) * 256 + ((colB) ^ (((row) & 7) << 4)))
#define KRSWZ(row, colB) ((row) * 128 + ((colB) ^ ((((row) >> 1) & 7) << 4)))
#define SBAR() __builtin_amdgcn_sched_barrier(0)
__device__ __forceinline__ int crow(int r, int hi) { return (r & 3) + 8 * (r >> 2) + 4 * hi; }
__host__ __device__ __forceinline__ int v_st(int k, int c) { const int kk = (k & ~0xC) | ((k & 4) << 1) | ((k & 8) >> 1); return ((kk >> 3) * 4 + (c >> 5)) * 512 + ((kk & 7) * 32 + (c & 31)) * 2; }
__device__ __forceinline__ int v_rd_base(int lane) { return ((lane & 3) << 3) | (((lane >> 2) & 3) << 6) | (((lane >> 4) & 1) << 5) | (((lane >> 5) & 1) << 8); }
constexpr int v_rd_off(int d0, int ks, int half) { return d0 * 512 + ks * 4096 + half * 2048; }
template <int OFF> __device__ __forceinline__ s16x4 tr_read(int vb) {
    s16x4 r; asm volatile("ds_read_b64_tr_b16 %0, %1 offset:%2" : "=&v"(r) : "v"(vb), "i"(OFF) : "memory"); return r;
}
template <int D0> __device__ __forceinline__ void pv_one(f32x16& od, int vb, bf16x8 pa0, bf16x8 pa1, bf16x8 pa2, bf16x8 pa3) {
    const s16x4 l0 = tr_read<v_rd_off(D0, 0, 0)>(vb), h0 = tr_read<v_rd_off(D0, 0, 1)>(vb), l1 = tr_read<v_rd_off(D0, 1, 0)>(vb), h1 = tr_read<v_rd_off(D0, 1, 1)>(vb);
    const s16x4 l2 = tr_read<v_rd_off(D0, 2, 0)>(vb), h2 = tr_read<v_rd_off(D0, 2, 1)>(vb), l3 = tr_read<v_rd_off(D0, 3, 0)>(vb), h3 = tr_read<v_rd_off(D0, 3, 1)>(vb);
    asm volatile("s_waitcnt lgkmcnt(0)" ::: "memory"); SBAR();
#define PK(L, H) (bf16x8){L[0], L[1], L[2], L[3], H[0], H[1], H[2], H[3]}
    od = __builtin_amdgcn_mfma_f32_32x32x16_bf16(pa0, PK(l0, h0), od, 0, 0, 0);
    od = __builtin_amdgcn_mfma_f32_32x32x16_bf16(pa1, PK(l1, h1), od, 0, 0, 0);
    od = __builtin_amdgcn_mfma_f32_32x32x16_bf16(pa2, PK(l2, h2), od, 0, 0, 0);
    od = __builtin_amdgcn_mfma_f32_32x32x16_bf16(pa3, PK(l3, h3), od, 0, 0, 0);
#undef PK
}
__device__ __forceinline__ void pv_d0(f32x16* o, int vb, bf16x8 pa0, bf16x8 pa1, bf16x8 pa2, bf16x8 pa3) {
    pv_one<0>(o[0], vb, pa0, pa1, pa2, pa3); pv_one<1>(o[1], vb, pa0, pa1, pa2, pa3); pv_one<2>(o[2], vb, pa0, pa1, pa2, pa3); pv_one<3>(o[3], vb, pa0, pa1, pa2, pa3);
}
}

namespace att8 {
constexpr int SLOT = 20480, KN_OFF = 0, KR_OFF = 8192, V_OFF = 12288, LDS_BYTES = 3 * SLOT + 8 * 256;
constexpr float THR2 = 8.0f;
constexpr float QUP = 8.f; constexpr int SC_ONE = 0x7f7f7f7f, SC_Q = 0x7c7c7c7c;
__host__ __device__ __forceinline__ int kn8(int key, int b) { return key * 128 + ((((b >> 4) ^ ((key >> 1) & 7))) << 4) + (b & 15); }
__host__ __device__ __forceinline__ int kr8(int key, int b) { return key * 64 + ((((b >> 4) ^ ((key >> 2) & 3))) << 4) + (b & 15); }
__host__ __device__ __forceinline__ int vslot(int k) { return 32 * ((k >> 2) & 1) + 16 * (k >> 5) + (k & 3) + 4 * ((k & 31) >> 3); }
__host__ __device__ __forceinline__ int v8(int d, int k) { const int sl = vslot(k); return d * 64 + ((((sl >> 4) ^ ((d >> 2) & 3))) << 4) + (sl & 15); }
__device__ __forceinline__ i32x8 ld32(const LAS unsigned char* a0, const LAS unsigned char* a1) { const u32x4 x = *(const LAS u32x4*)a0, y = *(const LAS u32x4*)a1;
    return (i32x8){(int)x.x, (int)x.y, (int)x.z, (int)x.w, (int)y.x, (int)y.y, (int)y.z, (int)y.w}; }
__device__ __forceinline__ void qkt(f32x16& p0, f32x16& p1, LAS unsigned char* slot, const i32x8* qf, int r32, int hi) {
    p0 = f32x16{}; p1 = f32x16{};
#pragma unroll
    for (int ks = 0; ks < 2; ++ks) { const int b = 64 * ks + 32 * hi;
        const i32x8 a0 = ld32(slot + KN_OFF + kn8(r32, b), slot + KN_OFF + kn8(r32, b + 16)), a1 = ld32(slot + KN_OFF + kn8(32 + r32, b), slot + KN_OFF + kn8(32 + r32, b + 16));
        p0 = __builtin_amdgcn_mfma_scale_f32_32x32x64_f8f6f4(a0, qf[ks], p0, 0, 0, 0, SC_ONE, 0, SC_Q);
        p1 = __builtin_amdgcn_mfma_scale_f32_32x32x64_f8f6f4(a1, qf[ks], p1, 0, 0, 0, SC_ONE, 0, SC_Q); }
    { const int b = 32 * hi;
        const i32x8 a0 = ld32(slot + KR_OFF + kr8(r32, b), slot + KR_OFF + kr8(r32, b + 16)), a1 = ld32(slot + KR_OFF + kr8(32 + r32, b), slot + KR_OFF + kr8(32 + r32, b + 16));
        p0 = __builtin_amdgcn_mfma_scale_f32_32x32x64_f8f6f4(a0, qf[2], p0, 0, 0, 0, SC_ONE, 0, SC_Q);
        p1 = __builtin_amdgcn_mfma_scale_f32_32x32x64_f8f6f4(a1, qf[2], p1, 0, 0, 0, SC_ONE, 0, SC_Q); }
}
__device__ __forceinline__ void partialSM(f32x16& p0, f32x16& p1, float& m_reg, float& mn, float& alpha) {
    float pmax = p0[0];
#pragma unroll
    for (int r = 1; r < 16; ++r) pmax = fmaxf(pmax, p0[r]);
#pragma unroll
    for (int r = 0; r < 16; ++r) pmax = fmaxf(pmax, p1[r]);
    { auto rr = __builtin_amdgcn_permlane32_swap(__float_as_uint(pmax), __float_as_uint(pmax), false, false);
      pmax = fmaxf(__uint_as_float(rr[0]), __uint_as_float(rr[1])); }
    if (__builtin_expect(__all(pmax - m_reg <= THR2), 1)) { mn = m_reg; alpha = 1.f; }
    else { mn = fmaxf(m_reg, pmax); alpha = __builtin_amdgcn_exp2f(m_reg - mn); m_reg = mn; }
#pragma unroll
    for (int r = 0; r < 16; ++r) p0[r] = __builtin_amdgcn_exp2f(p0[r] - mn);
#pragma unroll
    for (int r = 0; r < 16; ++r) p1[r] = p1[r] - mn;
}
__device__ __forceinline__ void finishSM(f32x16& p0, f32x16& p1, float alpha, float& l_reg, i32x8& pf) {
#pragma unroll
    for (int r = 0; r < 16; ++r) p1[r] = __builtin_amdgcn_exp2f(p1[r]);
    float ps = 0;
#pragma unroll
    for (int r = 0; r < 16; ++r) ps += p0[r];
#pragma unroll
    for (int r = 0; r < 16; ++r) ps += p1[r];
    { auto rr = __builtin_amdgcn_permlane32_swap(__float_as_uint(ps), __float_as_uint(ps), false, false);
      ps = __uint_as_float(rr[0]) + __uint_as_float(rr[1]); }
    l_reg = l_reg * alpha + ps;
#pragma unroll
    for (int w = 0; w < 4; ++w) { pf[w] = (int)pk4_fp8(p0[4 * w], p0[4 * w + 1], p0[4 * w + 2], p0[4 * w + 3]); pf[4 + w] = (int)pk4_fp8(p1[4 * w], p1[4 * w + 1], p1[4 * w + 2], p1[4 * w + 3]); }
}
__device__ __forceinline__ void pv(f32x16* o, LAS unsigned char* slot, const i32x8 pf, int r32, int hi) {
#pragma unroll
    for (int d0 = 0; d0 < 4; ++d0) { const int d = 32 * d0 + r32, sw = (d >> 2) & 3;
        const i32x8 b = ld32(slot + V_OFF + d * 64 + (((2 * hi) ^ sw) << 4), slot + V_OFF + d * 64 + (((2 * hi + 1) ^ sw) << 4));
        o[d0] = __builtin_amdgcn_mfma_scale_f32_32x32x64_f8f6f4(pf, b, o[d0], 0, 0, 0, SC_ONE, 0, SC_ONE); }
}
__device__ __forceinline__ int crow(int r, int hi) { return (r & 3) + 8 * (r >> 2) + 4 * hi; }
__device__ __forceinline__ void attn_unit(const unsigned char* __restrict__ Qb, const unsigned char* __restrict__ KNt, const unsigned char* __restrict__ KRt, const unsigned char* __restrict__ Vt,
                                          bf16_t* __restrict__ Ob, int NT, LAS unsigned char* lds) {
    const int tid = otid(), wid = __builtin_amdgcn_readfirstlane(tid >> 6), lane = tid & 63, r32 = lane & 31, hi = lane >> 5;
    LAS float* wsf = (LAS float*)(lds + 3 * SLOT) + wid * 64; LAS float* li_l = wsf; LAS float* al_l = wsf + 32;
    float m_reg = -1e30f, l_reg = 0; f32x16 o[4] = {}; i32x8 qf[3];
    const unsigned char* Qw = Qb + (size_t)(wid * 32 + r32) * 192 + 32 * hi;
#pragma unroll
    for (int ks = 0; ks < 3; ++ks) { const u32x4 x = *(const u32x4*)(Qw + 64 * ks), y = *(const u32x4*)(Qw + 64 * ks + 16); qf[ks] = (i32x8){(int)x.x, (int)x.y, (int)x.z, (int)x.w, (int)y.x, (int)y.y, (int)y.z, (int)y.w}; }
    const unsigned lo16 = (unsigned)lane * 16u;
#define ATT_DMA(tile, slotoff) do { const size_t t_ = (size_t)(tile); LAS unsigned char* sl_ = lds + (slotoff); \
        __builtin_amdgcn_global_load_lds((const unsigned*)(KNt + t_ * 8192 + wid * 1024 + lo16), (LAS unsigned*)(sl_ + KN_OFF + wid * 1024), 16, 0, 0); \
        __builtin_amdgcn_global_load_lds((const unsigned*)(Vt + t_ * 8192 + wid * 1024 + lo16), (LAS unsigned*)(sl_ + V_OFF + wid * 1024), 16, 0, 0); \
        if (wid < 4) __builtin_amdgcn_global_load_lds((const unsigned*)(KRt + t_ * 4096 + wid * 1024 + lo16), (LAS unsigned*)(sl_ + KR_OFF + wid * 1024), 16, 0, 0); } while (0)
#define ATT_SYNC() do { asm volatile("s_waitcnt vmcnt(0)" ::: "memory"); __builtin_amdgcn_s_barrier(); asm volatile("" ::: "memory"); } while (0)
#define RESC(a) do { if (__any((a) < 1.f)) { if (hi == 0) al_l[r32] = (a); asm volatile("s_waitcnt lgkmcnt(0)" ::: "memory"); \
        _Pragma("unroll") for (int d = 0; d < 4; ++d) _Pragma("unroll") for (int r = 0; r < 16; ++r) o[d][r] *= al_l[crow(r, hi)]; } } while (0)
    f32x16 pA0, pA1, pB0, pB1; float mnA, mnB, alA, alB; i32x8 pf;
    int sp = 0, sc = SLOT, sn = 2 * SLOT;
    ATT_DMA(0, 0);
    ATT_SYNC();
    ATT_DMA(1, SLOT);
    qkt(pA0, pA1, lds, qf, r32, hi); partialSM(pA0, pA1, m_reg, mnA, alA);
    for (int j = 1; j + 1 < NT; j += 2) {
        ATT_SYNC(); ATT_DMA(j + 1, sn);
        SBAR(); qkt(pB0, pB1, lds + sc, qf, r32, hi);
        finishSM(pA0, pA1, alA, l_reg, pf); SBAR();
        pv(o, lds + sp, pf, r32, hi); partialSM(pB0, pB1, m_reg, mnB, alB);
        RESC(alB);
        { const int t_ = sp; sp = sc; sc = sn; sn = t_; }
        ATT_SYNC(); if (j + 2 < NT) ATT_DMA(j + 2, sn);
        SBAR(); qkt(pA0, pA1, lds + sc, qf, r32, hi);
        finishSM(pB0, pB1, alB, l_reg, pf); SBAR();
        pv(o, lds + sp, pf, r32, hi); partialSM(pA0, pA1, m_reg, mnA, alA);
        RESC(alA);
        { const int t_ = sp; sp = sc; sc = sn; sn = t_; }
    }
    ATT_SYNC();
    SBAR(); qkt(pB0, pB1, lds + sc, qf, r32, hi);
    finishSM(pA0, pA1, alA, l_reg, pf); SBAR();
    pv(o, lds + sp, pf, r32, hi); partialSM(pB0, pB1, m_reg, mnB, alB);
    RESC(alB);
    finishSM(pB0, pB1, alB, l_reg, pf); SBAR();
    pv(o, lds + sc, pf, r32, hi);
    if (hi == 0) li_l[r32] = l_reg; asm volatile("s_waitcnt lgkmcnt(0)" ::: "memory");
    float rli[16];
#pragma unroll
    for (int r = 0; r < 16; ++r) rli[r] = __builtin_amdgcn_rcpf(li_l[crow(r, hi)]);
    bf16_t* Ow = Ob + (size_t)(wid * 32) * 2048;
#pragma unroll
    for (int r = 0; r < 16; ++r) { const int orow = crow(r, hi);
#pragma unroll
        for (int d0 = 0; d0 < 4; ++d0) Ow[(size_t)orow * 2048 + d0 * 32 + r32] = f2bf(o[d0][r] * rli[r]); }
    __builtin_amdgcn_s_barrier(); asm volatile("" ::: "memory");
#undef ATT_DMA
#undef ATT_SYNC
#undef RESC
}
}

namespace ssd {
constexpr int XT_OFF = 0, BT_OFF = 17408, HB_OFF = 52224, SET = 69632, CW_OFF = 2 * SET, LDS_BYTES = CW_OFF + 8 * 1536;
constexpr int PITCH = 272;
constexpr float L2E = 1.4426950408889634f;
__device__ __forceinline__ void g_unit(const bf16_t* __restrict__ BC, bf16_t* __restrict__ G, int unit) {
    const int cid = unit >> 1, g = unit & 1;
    const int r0 = cid < 256 ? cid * 128 : NLAT + (cid - 256) * 128;
    const int tid = otid(), wid = tid >> 6, lane = tid & 63, fr = lane & 15, fq = lane >> 4;
    const bf16_t* Cp = BC + (size_t)(r0 + 16 * wid + fr) * 512 + 256 + 128 * g + 8 * fq;
    bf16x8 cf[4];
#pragma unroll
    for (int ks = 0; ks < 4; ++ks) cf[ks] = *(const bf16x8*)(Cp + 32 * ks);
    bf16_t* Gp = G + ((size_t)unit * 128 + 16 * wid + fr) * 128 + 4 * fq;
#pragma unroll
    for (int sb = 0; sb < 8; ++sb) {
        const bf16_t* Bp = BC + (size_t)(r0 + 16 * sb + fr) * 512 + 128 * g + 8 * fq;
        f32x4 acc = {0.f, 0.f, 0.f, 0.f};
#pragma unroll
        for (int ks = 0; ks < 4; ++ks) { const bf16x8 bfr = *(const bf16x8*)(Bp + 32 * ks); acc = __builtin_amdgcn_mfma_f32_16x16x32_bf16(bfr, cf[ks], acc, 0, 0, 0); }
        u32x2 w; w.x = cvt_pk_bf16(acc[0], acc[1]); w.y = cvt_pk_bf16(acc[2], acc[3]);
        *(u32x2*)(Gp + 16 * sb) = w;
    }
}
__device__ __forceinline__ void ssd_unit(int b, int h, int d, const bf16_t* __restrict__ XS, const bf16_t* __restrict__ BC, const float* __restrict__ DT, const bf16_t* __restrict__ G,
                                         const float* __restrict__ a_log, bf16_t* __restrict__ Y, LAS unsigned char* lds) {
    const int g = h >> 3;
    const int tid = otid(), wid = tid >> 6, lane = tid & 63, fr = lane & 15, fq = lane >> 4;
    const float a = -__expf(a_log[d * 16 + h]);
    LAS float* cw = (LAS float*)(lds + CW_OFF + wid * 1536); LAS float* dts = cw + 128; LAS float* dtw = cw + 256;
    f32x4 hs[4];
#pragma unroll
    for (int q = 0; q < 4; ++q) hs[q] = (f32x4){0.f, 0.f, 0.f, 0.f};
    for (int i = tid; i < 17408 / 4; i += 512) ((LAS unsigned*)(lds + HB_OFF))[i] = 0u;
    float cend = 0.f;
#define SSD_ROWS(step, r0v, gidv) do { if ((step) < 2) { const int oc_ = d ? 1 - (step) : (step); r0v = NLAT + b * 256 + oc_ * 128; gidv = 256 + b * 2 + oc_; } \
        else { const int lc_ = (step) - 2, oc_ = d ? 63 - lc_ : lc_; r0v = b * 8192 + oc_ * 128; gidv = b * 64 + oc_; } } while (0)
    const int sg = tid & 31, n8 = tid >> 5, p4 = tid >> 5;
    f32x2 P_da, Q_da; u32x2 P_xv[4], Q_xv[4]; u32x4 P_bv[4], Q_bv[4], n_gv[4], n_cv[4], c_gv[4], c_cv[4];
#define SSD_LOAD(step, X) do { int r0_, gid_; SSD_ROWS(step, r0_, gid_); (void)gid_; X##_da = *(const f32x2*)(DT + (size_t)(d * 16 + h) * NROW + r0_ + 2 * lane); \
        _Pragma("unroll") for (int j_ = 0; j_ < 4; ++j_) { X##_xv[j_] = *(const u32x2*)(XS + (size_t)(r0_ + 4 * sg + j_) * 1024 + 64 * h + 4 * p4); \
                                                         X##_bv[j_] = *(const u32x4*)(BC + (size_t)(r0_ + 4 * sg + j_) * 512 + 128 * g + 8 * n8); } } while (0)
#define SSD_LOADGC(step) do { int r0_, gid_; SSD_ROWS(step, r0_, gid_); const int t_ = 16 * wid + fr; const bf16_t* Gp_ = G + ((size_t)(gid_ * 2 + g) * 128 + t_) * 128 + 8 * fq; const bf16_t* Cp_ = BC + (size_t)(r0_ + t_) * 512 + 256 + 128 * g + 8 * fq; \
          _Pragma("unroll") for (int ks_ = 0; ks_ < 4; ++ks_) { n_gv[ks_] = *(const u32x4*)(Gp_ + 32 * ks_); n_cv[ks_] = *(const u32x4*)(Cp_ + 32 * ks_); } } while (0)
#define SSD_GCROT() do { _Pragma("unroll") for (int ks_ = 0; ks_ < 4; ++ks_) { c_gv[ks_] = n_gv[ks_]; c_cv[ks_] = n_cv[ks_]; } } while (0)
#define SSD_WRITE(step, X) do { LAS unsigned char* set_ = lds + ((step) & 1) * SET; \
        const float da0 = X##_da.x * a, da1 = X##_da.y * a; \
        float sc_ = da0 + da1; float c0_, c1_; \
        if (d == 0) { _Pragma("unroll") for (int o_ = 1; o_ < 64; o_ <<= 1) { const float t_ = __shfl_up(sc_, o_); if (lane >= o_) sc_ += t_; } \
            c0_ = sc_ - da1; c1_ = sc_; cend = __shfl(sc_, 63); } \
        else { _Pragma("unroll") for (int o_ = 1; o_ < 64; o_ <<= 1) { const float t_ = __shfl_down(sc_, o_); if (lane + o_ < 64) sc_ += t_; } \
            c0_ = sc_; c1_ = sc_ - da0; cend = __shfl(sc_, 0); } \
        *(LAS f32x2*)(cw + 2 * lane) = (f32x2){c0_, c1_}; *(LAS f32x2*)(dts + 2 * lane) = X##_da; \
        *(LAS f32x2*)(dtw + 2 * lane) = (f32x2){X##_da.x * __builtin_amdgcn_exp2f((cend - c0_) * L2E), X##_da.y * __builtin_amdgcn_exp2f((cend - c1_) * L2E)}; \
        { LAS unsigned char* xt_ = set_ + XT_OFF + (4 * p4) * PITCH + 8 * sg; \
          _Pragma("unroll") for (int i_ = 0; i_ < 4; ++i_) { unsigned e_[4]; \
              _Pragma("unroll") for (int j_ = 0; j_ < 4; ++j_) { const unsigned w_ = (i_ & 2) ? X##_xv[j_].y : X##_xv[j_].x; e_[j_] = (i_ & 1) ? (w_ >> 16) : (w_ & 0xffffu); } \
              u32x2 o_; o_.x = e_[0] | (e_[1] << 16); o_.y = e_[2] | (e_[3] << 16); *(LAS u32x2*)(xt_ + i_ * PITCH) = o_; } } \
        { LAS unsigned char* bt_ = set_ + BT_OFF + (8 * n8) * PITCH + 8 * sg; \
          _Pragma("unroll") for (int i_ = 0; i_ < 8; ++i_) { unsigned e_[4]; \
              _Pragma("unroll") for (int j_ = 0; j_ < 4; ++j_) { const unsigned w_ = X##_bv[j_][i_ >> 1]; e_[j_] = (i_ & 1) ? (w_ >> 16) : (w_ & 0xffffu); } \
              u32x2 o_; o_.x = e_[0] | (e_[1] << 16); o_.y = e_[2] | (e_[3] << 16); *(LAS u32x2*)(bt_ + i_ * PITCH) = o_; } } \
        asm volatile("s_waitcnt lgkmcnt(0)" ::: "memory"); \
    } while (0)
    SSD_LOAD(0, Q); SSD_LOADGC(0); SSD_WRITE(0, Q); SSD_LOAD(1, P);
    for (int step2 = 0; step2 < 66; step2 += 2)
#pragma unroll
    for (int par = 0; par < 2; ++par) {
        const int step = step2 + par;
        __syncthreads();
        int r0, gid; SSD_ROWS(step, r0, gid); (void)gid;
        LAS unsigned char* set = lds + (step & 1) * SET;
        const float cend_cur = cend;
        SSD_GCROT();
        if (step + 1 < 66) SSD_LOADGC(step + 1);
        if (step + 2 < 66) { if (par == 0) SSD_LOAD(step + 2, Q); else SSD_LOAD(step + 2, P); }
        {
            const int t = 16 * wid + fr; const float ct = cw[t];
            f32x4 y[4];
#pragma unroll
            for (int q = 0; q < 4; ++q) y[q] = (f32x4){0.f, 0.f, 0.f, 0.f};
            const float et = __builtin_amdgcn_exp2f(ct * L2E);
#pragma unroll
            for (int ks = 0; ks < 4; ++ks) {
                const bool live = d == 0 ? (32 * ks <= 16 * wid + 15) : (32 * ks + 31 >= 16 * wid);
                if (live) {
                    const int s0 = 32 * ks + 8 * fq;
                    const f32x4 c0 = *(const LAS f32x4*)(cw + s0), c1 = *(const LAS f32x4*)(cw + s0 + 4), d0v = *(const LAS f32x4*)(dts + s0), d1v = *(const LAS f32x4*)(dts + s0 + 4);
                    float m[8];
#pragma unroll
                    for (int i = 0; i < 8; ++i) { const float cs = i < 4 ? c0[i & 3] : c1[i & 3], dv = i < 4 ? d0v[i & 3] : d1v[i & 3]; const int s = s0 + i;
                        const bool ok = d == 0 ? (s <= t) : (s >= t);
                        const float gval = (i & 1) ? bfhi(c_gv[ks][i >> 1]) : bflo(c_gv[ks][i >> 1]);
                        m[i] = ok ? gval * dv * __builtin_amdgcn_exp2f((ct - cs) * L2E) : 0.f; }
                    u32x4 mw; mw.x = cvt_pk_bf16(m[0], m[1]); mw.y = cvt_pk_bf16(m[2], m[3]); mw.z = cvt_pk_bf16(m[4], m[5]); mw.w = cvt_pk_bf16(m[6], m[7]);
                    const bf16x8 mb = __builtin_bit_cast(bf16x8, mw);
#pragma unroll
                    for (int q = 0; q < 4; ++q) { const bf16x8 af = *(const LAS bf16x8*)(set + XT_OFF + (16 * q + fr) * PITCH + (32 * ks + 8 * fq) * 2);
                        y[q] = __builtin_amdgcn_mfma_f32_16x16x32_bf16(af, mb, y[q], 0, 0, 0); }
                }
            }
#pragma unroll
            for (int ks = 0; ks < 4; ++ks) {
                u32x4 cwv;
#pragma unroll
                for (int i = 0; i < 4; ++i) cwv[i] = cvt_pk_bf16(bflo(c_cv[ks][i]) * et, bfhi(c_cv[ks][i]) * et);
                const bf16x8 cb = __builtin_bit_cast(bf16x8, cwv);
#pragma unroll
                for (int q = 0; q < 4; ++q) { const bf16x8 af = *(const LAS bf16x8*)(set + HB_OFF + (16 * q + fr) * PITCH + (32 * ks + 8 * fq) * 2);
                    y[q] = __builtin_amdgcn_mfma_f32_16x16x32_bf16(af, cb, y[q], 0, 0, 0); }
            }
            bf16_t* yp = Y + (size_t)(r0 + t) * 1024 + 64 * h + 4 * fq;
#pragma unroll
            for (int q = 0; q < 4; ++q) { u32x2 w; w.x = cvt_pk_bf16(y[q][0], y[q][1]); w.y = cvt_pk_bf16(y[q][2], y[q][3]); *(u32x2*)(yp + 16 * q) = w; }
        }
        {
            const float dec = __builtin_amdgcn_exp2f(cend_cur * L2E);
#pragma unroll
            for (int q = 0; q < 4; ++q) hs[q] = hs[q] * dec;
#pragma unroll
            for (int ks = 0; ks < 4; ++ks) {
                const int s0 = 32 * ks + 8 * fq;
                const u32x4 braw = *(const LAS u32x4*)(set + BT_OFF + (16 * wid + fr) * PITCH + s0 * 2);
                const f32x4 w0 = *(const LAS f32x4*)(dtw + s0), w1 = *(const LAS f32x4*)(dtw + s0 + 4);
                u32x4 bw; bw.x = cvt_pk_bf16(bflo(braw.x) * w0[0], bfhi(braw.x) * w0[1]); bw.y = cvt_pk_bf16(bflo(braw.y) * w0[2], bfhi(braw.y) * w0[3]);
                          bw.z = cvt_pk_bf16(bflo(braw.z) * w1[0], bfhi(braw.z) * w1[1]); bw.w = cvt_pk_bf16(bflo(braw.w) * w1[2], bfhi(braw.w) * w1[3]);
                const bf16x8 bfr = __builtin_bit_cast(bf16x8, bw);
#pragma unroll
                for (int q = 0; q < 4; ++q) { const bf16x8 af = *(const LAS bf16x8*)(set + XT_OFF + (16 * q + fr) * PITCH + s0 * 2);
                    hs[q] = __builtin_amdgcn_mfma_f32_16x16x32_bf16(af, bfr, hs[q], 0, 0, 0); }
            }
            LAS bf16_t* hb = (LAS bf16_t*)(lds + ((step + 1) & 1) * SET + HB_OFF) + 16 * wid + fr;
#pragma unroll
            for (int q = 0; q < 4; ++q)
#pragma unroll
                for (int i = 0; i < 4; ++i) hb[(16 * q + 4 * fq + i) * 136] = f2bf(hs[q][i]);
        }
        if (step + 1 < 66) { if (par == 0) SSD_WRITE(step + 1, P); else SSD_WRITE(step + 1, Q); }
    }
    __syncthreads();
#undef SSD_ROWS
#undef SSD_LOAD
#undef SSD_LOADGC
#undef SSD_GCROT
#undef SSD_WRITE
}
}

struct Args { const float* in[32]; float* out; unsigned char* ws; int ph_lo, ph_hi; };
constexpr int NTHR = 512;
constexpr int LDS_BASE = 256;
constexpr int LDS_PHASE = 151808;
constexpr int LDS_BYTES = LDS_BASE + LDS_PHASE;
static_assert(att8::LDS_BYTES <= LDS_PHASE && ssd::LDS_BYTES <= LDS_PHASE && pg8::STAGE_BYTES <= LDS_PHASE, "LDS");

__device__ __forceinline__ void tjob(int j, const Args& A, const float*& src, bf16_t*& dst, int& K, int& N, int& Npad, int& mode, const float*& ks) {
    unsigned char* W = A.ws + WS_W; mode = 0; ks = nullptr;
    if (j < 8) { const int i = j >> 2, w = j & 3; unsigned char* base = W + W_HYB + (size_t)i * WH_SZ;
        if (w == 0)      { src = A.in[I_HWIN] + (size_t)i * 1024 * HYB_IN; dst = (bf16_t*)(base + WH_IN); K = 1024; N = HYB_IN; Npad = HYB_INP; mode = 1; }
        else if (w == 1) { src = A.in[I_WQB] + (size_t)i * 384 * 1536; dst = (bf16_t*)(base + WH_QB); K = 384; N = 1536; Npad = 1536; mode = 2; ks = A.in[I_QNG] + i * 384; }
        else if (w == 2) { src = A.in[I_WKVB] + (size_t)i * 256 * 2048; dst = (bf16_t*)(base + WH_KVB); K = 256; N = 2048; Npad = 2048; ks = A.in[I_KVNG] + i * 256; }
        else             { src = A.in[I_HWOUT] + (size_t)i * 2048 * 1024; dst = (bf16_t*)(base + WH_OUT); K = 2048; N = 1024; Npad = 1024; }
    } else if (j < 12) { const int i = (j - 8) >> 1, w = (j - 8) & 1; unsigned char* base = W + W_GM + (size_t)i * WG_SZ;
        if (w == 0) { src = A.in[I_GWIN] + (size_t)i * 1024 * 4096; dst = (bf16_t*)(base + WG_IN); K = 1024; N = 4096; Npad = 4096; }
        else        { src = A.in[I_GWOUT] + (size_t)i * 2048 * 1024; dst = (bf16_t*)(base + WG_OUT); K = 2048; N = 1024; Npad = 1024; }
    } else { const int l = j - 12; src = A.in[I_PWQ] + (size_t)l * 1024 * 2048; dst = (bf16_t*)(W + W_PEER + (size_t)l * WP_SZ + WP_Q); K = 1024; N = 2048; Npad = 2048; }
}
__device__ __forceinline__ int colmap(int mode, int n, int N) {
    if (mode == 1) { if (n >= N) return -1; if (n < C_KR) return n; const int m = n - C_KR; return C_KR + (m >> 1) + 32 * (m & 1); }
    if (mode == 2) { if (n < 1024) return (n >> 7) * 192 + (n & 127); const int m = n - 1024, h = m >> 6, mm = m & 63; return h * 192 + 128 + (mm >> 1) + 32 * (mm & 1); }
    return n;
}
__device__ __forceinline__ void phase_prologue(const Args& A, LAS unsigned char* lds) {
    const int tid = otid();
    {
        LAS float* tile = (LAS float*)lds;
        const float* c_src = nullptr; bf16_t* c_dst = nullptr; const float* c_ks = nullptr; int c_K = 0, c_N = 0, c_mode = 0, c_nsub = 0, c_k0 = 0, c_n0 = 0;
        int j = 0, item = blockIdx.x; bool have = false;
#define TR_LOCATE() do { have = false; \
            while (j < 16) { int Npad_; tjob(j, A, c_src, c_dst, c_K, c_N, Npad_, c_mode, c_ks); \
                c_nsub = (c_K % 256 == 0) ? 4 : 2; const int tk_ = c_K / (64 * c_nsub), nt_ = tk_ * (Npad_ / 64); \
                if (item < nt_) { c_k0 = (item % tk_) * 64 * c_nsub; c_n0 = (item / tk_) * 64; have = true; break; } \
                item -= nt_; ++j; } } while (0)
        float v[4][8], scv[4];
#define TR_LOAD() do { const int k = tid >> 3, cg = tid & 7; \
            _Pragma("unroll") for (int t = 0; t < 4; ++t) if (t < c_nsub) { scv[t] = c_ks ? c_ks[c_k0 + 64 * t + k] : 1.f; \
                _Pragma("unroll") for (int jj = 0; jj < 8; ++jj) { const int oc = colmap(c_mode, c_n0 + 8 * cg + jj, c_N); v[t][jj] = oc >= 0 ? c_src[(size_t)(c_k0 + 64 * t + k) * c_N + oc] : 0.f; } } } while (0)
        TR_LOCATE();
        if (have) TR_LOAD();
        int buf = 0;
        while (have) {
            const int nsub = c_nsub, K = c_K, k0 = c_k0, n0 = c_n0; bf16_t* dst = c_dst;
            { const int k = tid >> 3, cg = tid & 7;
#pragma unroll
              for (int t = 0; t < 4; ++t) if (t < nsub) {
#pragma unroll
                  for (int jj = 0; jj < 8; ++jj) tile[buf * 16640 + t * 4160 + k * 65 + 8 * cg + jj] = v[t][jj] * scv[t]; } }
            item += gridDim.x; TR_LOCATE();
            if (have) TR_LOAD();
            __syncthreads();
            { const int n = tid >> 3, kg = tid & 7;
#pragma unroll
              for (int t = 0; t < 4; ++t) if (t < nsub) { float o[8];
#pragma unroll
                  for (int jj = 0; jj < 8; ++jj) o[jj] = tile[buf * 16640 + t * 4160 + (8 * kg + jj) * 65 + n];
                  u32x4 w; w.x = cvt_pk_bf16(o[0], o[1]); w.y = cvt_pk_bf16(o[2], o[3]); w.z = cvt_pk_bf16(o[4], o[5]); w.w = cvt_pk_bf16(o[6], o[7]);
                  *(u32x4*)(dst + (size_t)(n0 + n) * K + k0 + 64 * t + 8 * kg) = w; } }
            buf ^= 1;
        }
#undef TR_LOCATE
#undef TR_LOAD
    }
    {
        const int gthr = blockIdx.x * NTHR + tid, nthr = gridDim.x * NTHR;
        for (int p = gthr; p < 10 * 16384; p += nthr) {
            const int mat = p >> 14, off = (p & 16383) * 8; const float* src; bf16_t* dst;
            if (mat < 2)      { src = A.in[I_GWS] + (size_t)mat * 131072; dst = (bf16_t*)(A.ws + WS_W + W_GM + (size_t)mat * WG_SZ + WG_WS); }
            else if (mat < 6) { src = A.in[I_PK1] + (size_t)(mat - 2) * 131072; dst = (bf16_t*)(A.ws + WS_W + W_PEER + (size_t)(mat - 2) * WP_SZ + WP_K1); }
            else              { src = A.in[I_PK2] + (size_t)(mat - 6) * 131072; dst = (bf16_t*)(A.ws + WS_W + W_PEER + (size_t)(mat - 6) * WP_SZ + WP_K2); }
            const f32x4 a = *(const f32x4*)(src + off), b = *(const f32x4*)(src + off + 4);
            u32x4 w; w.x = cvt_pk_bf16(a[0], a[1]); w.y = cvt_pk_bf16(a[2], a[3]); w.z = cvt_pk_bf16(b[0], b[1]); w.w = cvt_pk_bf16(b[2], b[3]);
            *(u32x4*)(dst + off) = w;
        }
        float* rope = (float*)(A.ws + WS_ROPE);
        for (int p = gthr; p < SEQ * 32; p += nthr) { const int l = p >> 5, i = p & 31; const float pos = (float)(i < 16 ? (l >> 6) : (l & 63));
            const float inv = powf(10000.f, -(float)(i & 15) / 16.f), ang = pos * inv; rope[p] = cosf(ang); rope[SEQ * 32 + p] = sinf(ang); }
    }
    {
        LAS float* scond = (LAS float*)lds;
        LAS float* red = scond + 5 * 1024;
        __syncthreads();
        for (int i = tid; i < 5 * 1024; i += NTHR) { const int m = i >> 10, k = i & 1023; const float c = m < 4 ? A.in[I_C][m * 1024 + k] : A.in[I_CCTX][k]; scond[i] = silu_f(c); }
        __syncthreads();
        float* MOD = (float*)(A.ws + WS_MOD);
        for (int item = blockIdx.x; item < 4 * 48; item += gridDim.x) {
            const int layer = item / 48, j0 = (item % 48) * 128; const int c4 = tid & 31, ksl = tid >> 5;
            f32x4 acc[5];
#pragma unroll
            for (int m = 0; m < 5; ++m) acc[m] = (f32x4){0.f, 0.f, 0.f, 0.f};
            const float* wp = A.in[I_ADAW] + ((size_t)layer * 1024 + ksl * 64) * 6144 + j0 + 4 * c4;
#pragma unroll 1
            for (int k0 = 0; k0 < 64; k0 += 16) { f32x4 w[16];
#pragma unroll
                for (int k = 0; k < 16; ++k) w[k] = *(const f32x4*)(wp + (size_t)(k0 + k) * 6144);
#pragma unroll
                for (int k = 0; k < 16; ++k)
#pragma unroll
                    for (int m = 0; m < 5; ++m) acc[m] += w[k] * scond[m * 1024 + ksl * 64 + k0 + k]; }
#pragma unroll
            for (int m = 0; m < 5; ++m) *(LAS f32x4*)(red + (ksl * 5 + m) * 128 + 4 * c4) = acc[m];
            __syncthreads();
            for (int i = tid; i < 640; i += NTHR) { const int m = i >> 7, c = i & 127; float s = A.in[I_ADAB][layer * 6144 + j0 + c];
#pragma unroll
                for (int q = 0; q < 16; ++q) s += red[(q * 5 + m) * 128 + c];
                MOD[((size_t)layer * 5 + m) * 6144 + j0 + c] = s; }
            __syncthreads();
        }
    }
}

template <bool F32SRC>
__device__ __forceinline__ void phase_norm_mod(const float* xl, const float* xc, bf16_t* XB, const float* g, const float* modl, int sh_idx, bf16_t* H, int nrows) {
    const int tid_ = otid(); const int lane = tid_ & 63, gw = blockIdx.x * 8 + (tid_ >> 6), nw = gridDim.x * 8;
    f32x4 gv[4];
#pragma unroll
    for (int i = 0; i < 4; ++i) gv[i] = *(const f32x4*)(g + 256 * i + 4 * lane);
    for (int r = gw; r < nrows; r += nw) {
        const bool lat = r < NLAT;
        f32x4 x[4]; float ss = 0.f;
        if (F32SRC) { const float* xp = lat ? xl + (size_t)r * D : xc + (size_t)(r - NLAT) * D;
#pragma unroll
            for (int i = 0; i < 4; ++i) { x[i] = *(const f32x4*)(xp + 256 * i + 4 * lane);
                u32x2 w; w.x = cvt_pk_bf16(x[i][0], x[i][1]); w.y = cvt_pk_bf16(x[i][2], x[i][3]); *(u32x2*)(XB + (size_t)r * D + 256 * i + 4 * lane) = w;
 }
        } else {
#pragma unroll
            for (int i = 0; i < 4; ++i) { const u32x2 w = *(const u32x2*)(XB + (size_t)r * D + 256 * i + 4 * lane); x[i] = (f32x4){bflo(w.x), bfhi(w.x), bflo(w.y), bfhi(w.y)}; } }
#pragma unroll
        for (int i = 0; i < 4; ++i) ss += x[i][0] * x[i][0] + x[i][1] * x[i][1] + x[i][2] * x[i][2] + x[i][3] * x[i][3];
        ss = wave_sum(ss); const float rstd = rsqrtf(ss * (1.f / 1024.f) + EPS);
        const float* mp = modl + (size_t)(lat ? (r >> 13) : 4) * 6144 + sh_idx * 1024;
#pragma unroll
        for (int i = 0; i < 4; ++i) { const f32x4 sh = *(const f32x4*)(mp + 256 * i + 4 * lane), sc = *(const f32x4*)(mp + 1024 + 256 * i + 4 * lane);
            const f32x4 hv = (x[i] * rstd) * gv[i] * (sc + 1.f) + sh;
            u32x2 w; w.x = cvt_pk_bf16(hv[0], hv[1]); w.y = cvt_pk_bf16(hv[2], hv[3]);
            *(u32x2*)(H + (size_t)r * D + 256 * i + 4 * lane) = w; }
    }
}
__device__ __forceinline__ void phase_final_norm(const bf16_t* XB, float* out, const float* g, float oscale) {
    const int tid_ = otid(); const int lane = tid_ & 63, gw = blockIdx.x * 8 + (tid_ >> 6), nw = gridDim.x * 8;
    f32x4 gv[4];
#pragma unroll
    for (int i = 0; i < 4; ++i) gv[i] = *(const f32x4*)(g + 256 * i + 4 * lane);
    for (int r = gw; r < NLAT; r += nw) {
        f32x4 x[4]; float ss = 0.f;
#pragma unroll
        for (int i = 0; i < 4; ++i) { const u32x2 w = *(const u32x2*)(XB + (size_t)r * D + 256 * i + 4 * lane); x[i] = (f32x4){bflo(w.x), bfhi(w.x), bflo(w.y), bfhi(w.y)};
            ss += x[i][0] * x[i][0] + x[i][1] * x[i][1] + x[i][2] * x[i][2] + x[i][3] * x[i][3]; }
        ss = wave_sum(ss); const float rstd = rsqrtf(ss * (1.f / 1024.f) + EPS);
#pragma unroll
        for (int i = 0; i < 4; ++i) *(f32x4*)(out + (size_t)r * D + 256 * i + 4 * lane) = (x[i] * (rstd * oscale)) * gv[i];
    }
}

#ifndef MK_CVAR
#define MK_CVAR 0
#endif
__device__ __forceinline__ void phase_conv(const Args& A, int li, int rep = 0) {
    const int cvar = rep ? MK_CVAR : 0;
    const bf16_t* PROJ = (const bf16_t*)(A.ws + WS_BIG);
    bf16_t* XS = (bf16_t*)(A.ws + WS_R2); bf16_t* BC = (bf16_t*)(A.ws + WS_R2 + R2_BC);
    const int tid = otid();
    if (cvar != 2) {
        for (int item = blockIdx.x * 3; item < (NROW / 64) * 3; item += gridDim.x * 3)
#pragma unroll 1
        for (int sub = 0; sub < 3; ++sub) {
            const int blk = (item + sub) / 3, q = ((item + sub) % 3) * 512 + tid, cg = q % 192, rg = q / 192, c0 = 8 * cg;
            const int rbeg = blk * 64 + rg * 8; int s0, s1;
            if (rbeg < NLAT) { s0 = rbeg & ~8191; s1 = s0 + 8192; } else { s0 = NLAT + ((rbeg - NLAT) & ~255); s1 = s0 + 256; }
            const float* cw = A.in[I_CONVW] + ((size_t)li * 1536 + c0) * 5; const float* cb = A.in[I_CONVB] + (size_t)li * 1536 + c0;
            u32x4 in[12];
#pragma unroll
            for (int i = 0; i < 12; ++i) { const int r = rbeg - 2 + i; in[i] = (r >= s0 && r < s1) ? *(const u32x4*)(PROJ + (size_t)r * HYB_INP + C_XBC + c0) : (u32x4){0u, 0u, 0u, 0u}; }
            float w[8][5], bia[8];
#pragma unroll
            for (int j = 0; j < 8; ++j) { bia[j] = cb[j];
#pragma unroll
                for (int k = 0; k < 5; ++k) w[j][k] = cw[j * 5 + k]; }
#pragma unroll
            for (int rr = 0; rr < 8; ++rr) {
                float o[8];
#pragma unroll
                for (int j = 0; j < 8; ++j) { float sacc = bia[j];
#pragma unroll
                    for (int k = 0; k < 5; ++k) { const unsigned wd = in[rr + k][j >> 1]; sacc += w[j][k] * ((j & 1) ? bfhi(wd) : bflo(wd)); }
                    o[j] = silu_f(sacc); }
                u32x4 pk; pk.x = cvt_pk_bf16(o[0], o[1]); pk.y = cvt_pk_bf16(o[2], o[3]); pk.z = cvt_pk_bf16(o[4], o[5]); pk.w = cvt_pk_bf16(o[6], o[7]);
                const int r = rbeg + rr;
                if (c0 < 1024) *(u32x4*)(XS + (size_t)r * 1024 + c0) = pk; else *(u32x4*)(BC + (size_t)r * 512 + (c0 - 1024)) = pk;
            }
        }
    }
    if (cvar != 1) {
        const int lane = tid & 63, gw = blockIdx.x * 8 + (tid >> 6), nw = gridDim.x * 8;
        float* DT = (float*)(A.ws + WS_BIG + BIG_DT); float* RQ = (float*)(A.ws + WS_RSTD); float* RKV = RQ + NROW;
        unsigned char* KR = A.ws + WS_BIG + BIG_KR; const float* rope = (const float*)(A.ws + WS_ROPE);
        const float dtb = lane < 32 ? A.in[I_DTB][li * 32 + lane] : 0.f;
        for (int rb = gw * 4; rb < NROW; rb += nw * 4) {
            unsigned wq[4][3]; u32x2 wk[4]; unsigned wr_[4]; float dtv[4], rc[4], rsn[4];
#pragma unroll
            for (int i = 0; i < 4; ++i) { const int r = rb + i; const bf16_t* p = PROJ + (size_t)r * HYB_INP;
                const unsigned* q = (const unsigned*)(p + C_CQ + 6 * lane); wq[i][0] = q[0]; wq[i][1] = q[1]; wq[i][2] = q[2];
                wk[i] = *(const u32x2*)(p + C_CKV + 4 * lane);
                dtv[i] = lane < 32 ? bf2f(p[C_DT + (lane & 15)]) : 0.f; wr_[i] = lane < 32 ? *(const unsigned*)(p + C_KR + 2 * lane) : 0u;
                const int l = r & 8191; rc[i] = (lane < 32 && r < NLAT) ? rope[l * 32 + lane] : 1.f; rsn[i] = (lane < 32 && r < NLAT) ? rope[SEQ * 32 + l * 32 + lane] : 0.f; }
#pragma unroll
            for (int i = 0; i < 4; ++i) { const int r = rb + i;
                if (lane < 32) DT[(size_t)lane * NROW + r] = softplus_f(dtv[i] + dtb);
                { float ss = 0.f;
#pragma unroll
                  for (int j = 0; j < 3; ++j) { const float a = bflo(wq[i][j]), b = bfhi(wq[i][j]); ss += a * a + b * b; }
                  ss = wave_sum(ss); if (lane == 0) RQ[r] = rsqrtf(ss * (1.f / 384.f) + EPS); }
                { const float a = bflo(wk[i].x), b = bfhi(wk[i].x), c = bflo(wk[i].y), d = bfhi(wk[i].y);
                  float ss = a * a + b * b + c * c + d * d; ss = wave_sum(ss); if (lane == 0) RKV[r] = rsqrtf(ss * (1.f / 256.f) + EPS); }
                if (lane < 32) { const float x1 = bflo(wr_[i]), x2 = bfhi(wr_[i]); int b, key;
                    const float o1 = x1 * rc[i] - x2 * rsn[i], o2 = x1 * rsn[i] + x2 * rc[i];
                    if (r < NLAT) { b = r >> 13; key = 256 + (r & 8191); } else { b = (r - NLAT) >> 8; key = (r - NLAT) & 255; }
                    int w8 = 0; w8 = __builtin_amdgcn_cvt_pk_fp8_f32(sat8(o1), sat8(o2), w8, false);
                    *(unsigned short*)(KR + (size_t)(b * NKT + (key >> 6)) * 4096 + att8::kr8(key & 63, 2 * lane)) = (unsigned short)(w8 & 0xffff); }
            }
        }
    }
}

struct EpiQ {
    static constexpr bool PERM = true;
    unsigned char* Q; const float* rstd; const float* rope;
    __device__ __forceinline__ void operator()(const f32x4 (&acc)[2][2][4][2], const pg8::Unit& u, int wr, int wc, int fr, int fq) const {
        const bool lat = u.pm < 128;
        const int b = lat ? (u.pm >> 5) : (u.pm - 128), q0 = lat ? 256 + ((u.pm & 31) << 8) : 0;
        const bool isrope = u.pn >= 4;
#pragma unroll
        for (int ai = 0; ai < 2; ++ai) {
            const int rl = 128 * ai + 64 * wr + fr;
            const float* rsp = rstd + u.pm * 256 + rl;
            const float* rp = rope + (size_t)(((u.pm & 31) << 8) + rl) * 32;
#pragma unroll
            for (int bj = 0; bj < 2; ++bj) {
                const int c0 = u.pn * 256 + 128 * bj + 32 * wc + 8 * fq; int h, dcol;
                if (!isrope) { h = c0 >> 7; dcol = c0 & 127; } else { const int mq = c0 - 1024; h = mq >> 6; dcol = 128 + (mq & 63); }
                unsigned char* dst = Q + ((size_t)(b * 8 + h) * NKEY + q0 + rl) * 192 + dcol;
                const int ro = (dcol - 128) >> 1;
#pragma unroll
                for (int m = 0; m < 4; ++m) {
                    const float rs = rsp[16 * m] * (QSCALE * att8::QUP);
                    f32x4 v0 = acc[ai][bj][m][0] * rs, v1 = acc[ai][bj][m][1] * rs;
                    if (isrope && lat) { const f32x4 cs = *(const f32x4*)(rp + 16 * m * 32 + ro), sn = *(const f32x4*)(rp + SEQ * 32 + 16 * m * 32 + ro);
                        const f32x4 a0 = v0, a1 = v1;
                        v0[0] = a0[0] * cs[0] - a0[1] * sn[0]; v0[1] = a0[0] * sn[0] + a0[1] * cs[0]; v0[2] = a0[2] * cs[1] - a0[3] * sn[1]; v0[3] = a0[2] * sn[1] + a0[3] * cs[1];
                        v1[0] = a1[0] * cs[2] - a1[1] * sn[2]; v1[1] = a1[0] * sn[2] + a1[1] * cs[2]; v1[2] = a1[2] * cs[3] - a1[3] * sn[3]; v1[3] = a1[2] * sn[3] + a1[3] * cs[3]; }
                    u32x2 w; w.x = pk4_fp8_sat(v0[0], v0[1], v0[2], v0[3]); w.y = pk4_fp8_sat(v1[0], v1[1], v1[2], v1[3]);
                    *(u32x2*)(dst + 16 * m * 192) = w;
                    asm volatile("" ::: "memory");
                }
            }
        }
    }
};
struct EpiKV {
    static constexpr bool PERM = true;
    unsigned char* KN; unsigned char* V; const float* rstd;
    __device__ __forceinline__ void operator()(const f32x4 (&acc)[2][2][4][2], const pg8::Unit& u, int wr, int wc, int fr, int fq) const {
        const bool lat = u.pm < 128;
        const int b = lat ? (u.pm >> 5) : (u.pm - 128), t0 = lat ? 4 + ((u.pm & 31) << 2) : 0;
        const int dd = 32 * wc + 8 * fq;
        const int offK = fr * 128 + ((((dd >> 4) ^ ((fr >> 1) & 7))) << 4) + (dd & 15);
#pragma unroll
        for (int ai = 0; ai < 2; ++ai) {
            const size_t tb = ((size_t)(b * 8 + u.pn) * NKT + t0 + 2 * ai + wr) * 8192;
            const float* rsp = rstd + u.pm * 256 + 128 * ai + 64 * wr + fr;
            unsigned char* kp = KN + tb + offK; unsigned char* vp = V + tb;
#pragma unroll
            for (int m = 0; m < 4; ++m) {
                const float rs = rsp[16 * m];
                { const f32x4 v0 = acc[ai][0][m][0] * rs, v1 = acc[ai][0][m][1] * rs; u32x2 w; w.x = pk4_fp8_sat(v0[0], v0[1], v0[2], v0[3]); w.y = pk4_fp8_sat(v1[0], v1[1], v1[2], v1[3]);
                  *(u32x2*)(kp + m * 2048) = w; }
                { const f32x4 v0 = acc[ai][1][m][0] * rs, v1 = acc[ai][1][m][1] * rs; const unsigned w0 = pk4_fp8_sat(v0[0], v0[1], v0[2], v0[3]), w1 = pk4_fp8_sat(v1[0], v1[1], v1[2], v1[3]);
                  const int sl = att8::vslot(16 * m + fr);
#pragma unroll
                  for (int i = 0; i < 8; ++i) { const int d = dd + i; vp[d * 64 + ((((sl >> 4) ^ ((d >> 2) & 3))) << 4) + (sl & 15)] = (unsigned char)(((i < 4 ? w0 : w1) >> (8 * (i & 3))) & 0xffu); } }
                asm volatile("" ::: "memory");
            }
        }
    }
};

__device__ __forceinline__ void phase_ssd_out(const Args& A, int li, int nrows) {
    const bf16_t* PROJ = (const bf16_t*)(A.ws + WS_BIG); const bf16_t* XS = (const bf16_t*)(A.ws + WS_R2);
    const bf16_t* Y0 = (const bf16_t*)(A.ws + WS_H); const bf16_t* Y1 = (const bf16_t*)(A.ws + WS_R3); bf16_t* CAT = (bf16_t*)(A.ws + WS_R3 + R3_CAT);
    const int tid_ = otid(); const int lane = tid_ & 63, gw = blockIdx.x * 8 + (tid_ >> 6), nw = gridDim.x * 8;
    const float dsk = A.in[I_SSDD][li * 16 + (lane >> 2)];
    float ng[16];
#pragma unroll
    for (int j = 0; j < 16; ++j) ng[j] = A.in[I_SSDNG][li * 1024 + 16 * lane + j];
    for (int r = gw; r < nrows; r += nw) {
        float v[16]; float ss = 0.f;
#pragma unroll
        for (int hh = 0; hh < 2; ++hh) {
            const u32x4 a = *(const u32x4*)(Y0 + (size_t)r * 1024 + 16 * lane + 8 * hh), b = *(const u32x4*)(Y1 + (size_t)r * 1024 + 16 * lane + 8 * hh);
            const u32x4 x = *(const u32x4*)(XS + (size_t)r * 1024 + 16 * lane + 8 * hh), z = *(const u32x4*)(PROJ + (size_t)r * HYB_INP + 16 * lane + 8 * hh);
#pragma unroll
            for (int q = 0; q < 4; ++q) {
                const float y0 = (bflo(a[q]) + bflo(b[q]) + dsk * bflo(x[q])) * silu_f(bflo(z[q])), y1 = (bfhi(a[q]) + bfhi(b[q]) + dsk * bfhi(x[q])) * silu_f(bfhi(z[q]));
                v[8 * hh + 2 * q] = y0; v[8 * hh + 2 * q + 1] = y1; ss += y0 * y0 + y1 * y1; }
        }
#pragma unroll
        for (int o = 16; o >= 1; o >>= 1) ss += __shfl_xor(ss, o);
        const float rstd = rsqrtf(ss * (1.f / 512.f) + EPS);
#pragma unroll
        for (int hh = 0; hh < 2; ++hh) { u32x4 w;
#pragma unroll
            for (int q = 0; q < 4; ++q) w[q] = cvt_pk_bf16(v[8 * hh + 2 * q] * rstd * ng[8 * hh + 2 * q], v[8 * hh + 2 * q + 1] * rstd * ng[8 * hh + 2 * q + 1]);
            *(u32x4*)(CAT + (size_t)r * 2048 + 16 * lane + 8 * hh) = w; }
    }
}

__device__ __forceinline__ void phase_ln_stats(const Args& A, int nrows) {
    const bf16_t* Gb = (const bf16_t*)(A.ws + WS_BIG); float* ST = (float*)(A.ws + WS_RSTD);
    const int tid_ = otid(); const int lane = tid_ & 63, gw = blockIdx.x * 8 + (tid_ >> 6), nw = gridDim.x * 8;
    for (int r = gw; r < nrows; r += nw) {
        float v[32]; float s = 0.f;
#pragma unroll
        for (int j = 0; j < 4; ++j) { const u32x4 w = *(const u32x4*)(Gb + (size_t)r * 4096 + 2048 + 512 * j + 8 * lane);
#pragma unroll
            for (int q = 0; q < 4; ++q) { v[8 * j + 2 * q] = bflo(w[q]); v[8 * j + 2 * q + 1] = bfhi(w[q]); s += v[8 * j + 2 * q] + v[8 * j + 2 * q + 1]; } }
        s = wave_sum(s); const float mu = s * (1.f / 2048.f); float q2 = 0.f;
#pragma unroll
        for (int j = 0; j < 32; ++j) { const float dd = v[j] - mu; q2 += dd * dd; }
        q2 = wave_sum(q2);
        if (lane == 0) { ST[r] = mu; ST[NROW + r] = rsqrtf(q2 * (1.f / 2048.f) + EPS); }
    }
}
__device__ __forceinline__ float half_sum32(float v) {
    v += __builtin_bit_cast(float, __builtin_amdgcn_mov_dpp(__builtin_bit_cast(int, v), 0xB1, 0xF, 0xF, true));
    v += __builtin_bit_cast(float, __builtin_amdgcn_mov_dpp(__builtin_bit_cast(int, v), 0x4E, 0xF, 0xF, true));
    v += __builtin_bit_cast(float, __builtin_amdgcn_mov_dpp(__builtin_bit_cast(int, v), 0x141, 0xF, 0xF, true));
    v += __builtin_bit_cast(float, __builtin_amdgcn_mov_dpp(__builtin_bit_cast(int, v), 0x140, 0xF, 0xF, true));
    auto r = __builtin_amdgcn_permlane16_swap(__float_as_uint(v), __float_as_uint(v), false, false);
    return __uint_as_float(r[0]) + __uint_as_float(r[1]);
}
__device__ __forceinline__ void phase_spatial(const Args& A, int gi, int nrows, LAS unsigned char* lds) {
    const bf16_t* Gb = (const bf16_t*)(A.ws + WS_BIG); const f32x2* PARTS = (const f32x2*)(A.ws + WS_R3); bf16_t* Ab = (bf16_t*)(A.ws + WS_R1);
    const bf16_t* WSg = (const bf16_t*)(A.ws + WS_W + W_GM + (size_t)gi * WG_SZ + WG_WS);
    const float* lng = A.in[I_GLNG] + (size_t)gi * 2048; const float* lnb = A.in[I_GLNB] + (size_t)gi * 2048; const float* bs = A.in[I_GBS] + (size_t)gi * 1024;
    const int tid = otid(), wid = tid >> 6, lane = tid & 63, r32 = lane & 31, hi = lane >> 5, tb = wid & 3, dh = wid >> 2;
    const int ldsaddr = (int)(unsigned)(uintptr_t)lds;
    u32x4 nv[8]; f32x2 nps[8];
    const int nunits = (nrows / 128) * 8;
#define SP_LOADV(un) do { const int cb_ = (un) >> 3, gg_ = (un) & 7, r0_ = cb_ * 128; \
        _Pragma("unroll") for (int j = 0; j < 8; ++j) { const int idx = tid + 512 * j, s_ = idx >> 5, dd_ = (idx & 31) * 8; \
            nv[j] = *(const u32x4*)(Gb + (size_t)(r0_ + s_) * 4096 + 2048 + 256 * gg_ + dd_); nps[j] = PARTS[(size_t)(r0_ + s_) * 32 + (idx & 31)]; } } while (0)
    if ((int)blockIdx.x < nunits) SP_LOADV((int)blockIdx.x);
    for (int unit = blockIdx.x; unit < nunits; unit += gridDim.x) {
        const int cb = unit >> 3, gg = unit & 7, r0 = cb * 128;
        __syncthreads();
#pragma unroll
        for (int j = 0; j < 8; ++j) { const int idx = tid + 512 * j, s = idx >> 5, dd = (idx & 31) * 8;
            const u32x4 w = nv[j];
            const float mu = half_sum32(nps[j].x) * (1.f / 2048.f), rs = rsqrtf(fmaxf(half_sum32(nps[j].y) * (1.f / 2048.f) - mu * mu, 0.f) + EPS);
            const f32x4 g0 = *(const f32x4*)(lng + 256 * gg + dd), g1 = *(const f32x4*)(lng + 256 * gg + dd + 4), b0 = *(const f32x4*)(lnb + 256 * gg + dd), b1 = *(const f32x4*)(lnb + 256 * gg + dd + 4);
            u32x4 o;
            o.x = cvt_pk_bf16((bflo(w.x) - mu) * rs * g0[0] + b0[0], (bfhi(w.x) - mu) * rs * g0[1] + b0[1]); o.y = cvt_pk_bf16((bflo(w.y) - mu) * rs * g0[2] + b0[2], (bfhi(w.y) - mu) * rs * g0[3] + b0[3]);
            o.z = cvt_pk_bf16((bflo(w.z) - mu) * rs * g1[0] + b1[0], (bfhi(w.z) - mu) * rs * g1[1] + b1[1]); o.w = cvt_pk_bf16((bflo(w.w) - mu) * rs * g1[2] + b1[2], (bfhi(w.w) - mu) * rs * g1[3] + b1[3]);
            *(LAS u32x4*)(lds + ((s >> 6) * 2 + (dd >> 7)) * 16384 + att::v_st(s & 63, dd & 127)) = o; }
        u32x2 uu[4][4];
        { const bf16_t* up = Gb + (size_t)(r0 + 32 * tb + r32) * 4096 + 256 * gg + 128 * dh + 4 * hi;
#pragma unroll
          for (int d0 = 0; d0 < 4; ++d0)
#pragma unroll
              for (int k = 0; k < 4; ++k) uu[d0][k] = *(const u32x2*)(up + 32 * d0 + 8 * k); }
        if (unit + (int)gridDim.x < nunits) SP_LOADV(unit + (int)gridDim.x);
        bf16x8 pa[8];
#pragma unroll
        for (int ks = 0; ks < 8; ++ks) pa[ks] = *(const bf16x8*)(WSg + ((size_t)gg * 128 + 32 * tb + r32) * 128 + 16 * ks + 8 * hi);
        __syncthreads();
        f32x16 o[4] = {};
#define SP_PV(D0, vbase, p0, p1, p2, p3) do { \
            const s16x4 l0 = att::tr_read<att::v_rd_off(D0, 0, 0)>(vbase), h0 = att::tr_read<att::v_rd_off(D0, 0, 1)>(vbase), l1 = att::tr_read<att::v_rd_off(D0, 1, 0)>(vbase), h1 = att::tr_read<att::v_rd_off(D0, 1, 1)>(vbase); \
            const s16x4 l2 = att::tr_read<att::v_rd_off(D0, 2, 0)>(vbase), h2 = att::tr_read<att::v_rd_off(D0, 2, 1)>(vbase), l3 = att::tr_read<att::v_rd_off(D0, 3, 0)>(vbase), h3 = att::tr_read<att::v_rd_off(D0, 3, 1)>(vbase); \
            asm volatile("s_waitcnt lgkmcnt(0)" ::: "memory"); __builtin_amdgcn_sched_barrier(0); \
            o[D0] = __builtin_amdgcn_mfma_f32_32x32x16_bf16((bf16x8){l0[0], l0[1], l0[2], l0[3], h0[0], h0[1], h0[2], h0[3]}, p0, o[D0], 0, 0, 0); \
            o[D0] = __builtin_amdgcn_mfma_f32_32x32x16_bf16((bf16x8){l1[0], l1[1], l1[2], l1[3], h1[0], h1[1], h1[2], h1[3]}, p1, o[D0], 0, 0, 0); \
            o[D0] = __builtin_amdgcn_mfma_f32_32x32x16_bf16((bf16x8){l2[0], l2[1], l2[2], l2[3], h2[0], h2[1], h2[2], h2[3]}, p2, o[D0], 0, 0, 0); \
            o[D0] = __builtin_amdgcn_mfma_f32_32x32x16_bf16((bf16x8){l3[0], l3[1], l3[2], l3[3], h3[0], h3[1], h3[2], h3[3]}, p3, o[D0], 0, 0, 0); } while (0)
        { const int vb0 = ldsaddr + (0 * 2 + dh) * 16384 + att::v_rd_base(lane), vb1 = ldsaddr + (1 * 2 + dh) * 16384 + att::v_rd_base(lane);
          SP_PV(0, vb0, pa[0], pa[1], pa[2], pa[3]); SP_PV(1, vb0, pa[0], pa[1], pa[2], pa[3]); SP_PV(2, vb0, pa[0], pa[1], pa[2], pa[3]); SP_PV(3, vb0, pa[0], pa[1], pa[2], pa[3]);
          SP_PV(0, vb1, pa[4], pa[5], pa[6], pa[7]); SP_PV(1, vb1, pa[4], pa[5], pa[6], pa[7]); SP_PV(2, vb1, pa[4], pa[5], pa[6], pa[7]); SP_PV(3, vb1, pa[4], pa[5], pa[6], pa[7]); }
#undef SP_PV
        { const int t = 32 * tb + r32, row = r0 + t; const float bsv = bs[gg * 128 + t];
          bf16_t* ap = Ab + (size_t)row * 2048 + 256 * gg + 128 * dh + 4 * hi;
#pragma unroll
          for (int d0 = 0; d0 < 4; ++d0)
#pragma unroll
              for (int k = 0; k < 4; ++k) {
                  const u32x2 u2 = uu[d0][k];
                  u32x2 w; w.x = cvt_pk_bf16(bflo(u2.x) * (o[d0][4 * k] + bsv), bfhi(u2.x) * (o[d0][4 * k + 1] + bsv)); w.y = cvt_pk_bf16(bflo(u2.y) * (o[d0][4 * k + 2] + bsv), bfhi(u2.y) * (o[d0][4 * k + 3] + bsv));
                  *(u32x2*)(ap + 32 * d0 + 8 * k) = w; } }
    }
#undef SP_LOADV
}

constexpr int NSL = 8, SW = 1024 / NSL;
constexpr size_t TAB8_HALF = (size_t)NEXP * 1024, TAB_SCL = 2 * TAB8_HALF, TAB_SET = al256(TAB_SCL + (size_t)2 * NEXP * 4);
static_assert(2 * TAB_SET <= TAB_REGION, "table sets");
__device__ __forceinline__ size_t tabset(int layer) { return WS_TAB + (size_t)(layer & 1) * TAB_SET; }
constexpr float HS = 4.f;
__device__ __forceinline__ void phase_tabcvt(const Args& A, int layer, int wg, int nwg, int r_lo = 0, int r_hi = 2 * NEXP) {
    const int tid_ = otid(); const int lane = tid_ & 63, gw = wg * 8 + (tid_ >> 6), nw = nwg * 8;
    unsigned char* TS = A.ws + tabset(layer); float* SCL = (float*)(TS + TAB_SCL);
    for (int r = r_lo + gw; r < r_hi; r += nw) {
        const int tab = r >> 14, e = r & (NEXP - 1);
        const float* src = (tab ? A.in[I_PV] : A.in[I_PU]) + ((size_t)layer * NEXP + e) * 1024 + 16 * lane;
        f32x4 v[4]; float am = 0.f;
#pragma unroll
        for (int i = 0; i < 4; ++i) { v[i] = *(const f32x4*)(src + 4 * i); am = fmaxf(am, fmaxf(fmaxf(fabsf(v[i][0]), fabsf(v[i][1])), fmaxf(fabsf(v[i][2]), fabsf(v[i][3])))); }
#pragma unroll
        for (int o = 32; o >= 1; o >>= 1) am = fmaxf(am, __shfl_xor(am, o));
        float sc = 1.f; if (am > 0.f) { int ex; (void)frexpf(448.f / am, &ex); sc = ldexpf(1.f, ex - 1); }
        if (lane == 0) SCL[tab * NEXP + e] = 1.f / sc;
        u32x4 w;
#pragma unroll
        for (int i = 0; i < 4; ++i) w[i] = pk4_fp8(v[i][0] * sc, v[i][1] * sc, v[i][2] * sc, v[i][3] * sc);
        *(u32x4*)(TS + (size_t)tab * TAB8_HALF + ((size_t)(lane >> 3) * NEXP + e) * SW + 16 * (lane & 7)) = w;
    }
}
#define CASD(a, b) do { const float hi_ = fmaxf(a, b), lo_ = fminf(a, b); a = hi_; b = lo_; } while (0)
__device__ __forceinline__ void sort16(float (&k)[16]) {
#pragma unroll
    for (int sz = 2; sz <= 16; sz <<= 1)
#pragma unroll
        for (int j = sz >> 1; j > 0; j >>= 1)
#pragma unroll
            for (int i = 0; i < 16; ++i) { const int l = i ^ j; if (l > i) { if ((i & sz) == 0 || sz == 16) CASD(k[i], k[l]); else CASD(k[l], k[i]); } }
}
__device__ __forceinline__ void bmerge16(float (&k)[16]) {
#pragma unroll
    for (int j = 8; j > 0; j >>= 1)
#pragma unroll
        for (int i = 0; i < 16; ++i) { const int l = i ^ j; if (l > i) CASD(k[i], k[l]); }
}
__device__ __forceinline__ void merge_top16(float (&a)[16], const float (&b)[16]) {
#pragma unroll
    for (int i = 0; i < 16; ++i) a[i] = fmaxf(a[i], b[15 - i]);
    bmerge16(a);
}
__device__ __forceinline__ void xmerge_top16(float (&a)[16], int mask) {
    float t[16];
#pragma unroll
    for (int i = 0; i < 16; ++i) t[i] = __shfl_xor(a[15 - i], mask);
#pragma unroll
    for (int i = 0; i < 16; ++i) a[i] = fmaxf(a[i], t[i]);
    bmerge16(a);
}
__device__ __forceinline__ void phase_topk(const Args& A, int layer, int nrows, LAS unsigned char* lds) {
    const bf16_t* QP = (const bf16_t*)(A.ws + WS_BIG); int* IDX = (int*)(A.ws + WS_R2); float* GATE = (float*)(A.ws + WS_R2 + R2_GATE);
    const int tid = otid(), wid = tid >> 6, lane = tid & 63, fr = lane & 15, fq = lane >> 4;
    LAS unsigned* scr = (LAS unsigned*)(lds + 2 * 34816) + wid * 512 + fr * 32;
    int h_staged = -1;
    for (int unit = blockIdx.x; unit < (nrows / 128) * 8; unit += gridDim.x) {
        const int h = unit & 7, r0 = (unit >> 3) * 128;
        if (h != h_staged) { h_staged = h;
        __syncthreads();
        { const bf16_t* k1 = (const bf16_t*)(A.ws + WS_W + W_PEER + (size_t)layer * WP_SZ + WP_K1) + (size_t)h * 16384;
#pragma unroll
          for (int j = 0; j < 8; ++j) { const int idx = tid + 512 * j, half = idx >> 11, rem = idx & 2047, key = rem >> 4, c8 = rem & 15;
              const u32x4 w = *(const u32x4*)(k1 + (size_t)half * 8 * 16384 + key * 128 + 8 * c8);
              *(LAS u32x4*)(lds + half * 34816 + key * 272 + c8 * 16) = w; } }
        __syncthreads(); }
        const int tok = r0 + 16 * wid + fr;
        float top[2][16];
#pragma unroll
        for (int half = 0; half < 2; ++half) {
            bf16x8 qf[4];
#pragma unroll
            for (int ks = 0; ks < 4; ++ks) qf[ks] = *(const bf16x8*)(QP + (size_t)tok * 2048 + 256 * h + 128 * half + 32 * ks + 8 * fq);
            float loc[16];
#pragma unroll
            for (int grp = 0; grp < 2; ++grp) {
                float kk[16];
#pragma unroll
                for (int nbb = 0; nbb < 4; ++nbb) { const int nb = 4 * grp + nbb; f32x4 acc = {0.f, 0.f, 0.f, 0.f};
#pragma unroll
                    for (int ks = 0; ks < 4; ++ks) { const bf16x8 kf = *(const LAS bf16x8*)(lds + half * 34816 + (16 * nb + fr) * 272 + (32 * ks + 8 * fq) * 2);
                        acc = __builtin_amdgcn_mfma_f32_16x16x32_bf16(kf, qf[ks], acc, 0, 0, 0); }
#pragma unroll
                    for (int i = 0; i < 4; ++i) { const unsigned code = 127u - (unsigned)(16 * nb + 4 * fq + i); kk[4 * nbb + i] = __uint_as_float((__float_as_uint(acc[i]) & ~127u) | code); } }
                sort16(kk);
                if (grp == 0) {
#pragma unroll
                    for (int i = 0; i < 16; ++i) loc[i] = kk[i];
                } else merge_top16(loc, kk);
            }
            xmerge_top16(loc, 16); xmerge_top16(loc, 32);
#pragma unroll
            for (int i = 0; i < 16; ++i) top[half][i] = loc[i];
        }
        if (fq < 2) {
#pragma unroll
            for (int i = 0; i < 16; ++i) scr[16 * fq + i] = __float_as_uint(fq == 0 ? top[0][i] : top[1][i]); }
        float fin[16];
#pragma unroll
        for (int aa = 0; aa < 4; ++aa) {
            const float va_k = fq == 0 ? top[0][aa] : fq == 1 ? top[0][4 + aa] : fq == 2 ? top[0][8 + aa] : top[0][12 + aa];
            const float va = __uint_as_float(__float_as_uint(va_k) & ~127u);
            float c[16];
#pragma unroll
            for (int bb = 0; bb < 16; ++bb) { const float s = va + __uint_as_float(__float_as_uint(top[1][bb]) & ~127u);
                c[bb] = __uint_as_float((__float_as_uint(s) & ~255u) | (255u - (unsigned)((4 * fq + aa) * 16 + bb))); }
            if (aa == 0) {
#pragma unroll
                for (int i = 0; i < 16; ++i) fin[i] = c[i];
            } else merge_top16(fin, c);
        }
        xmerge_top16(fin, 16); xmerge_top16(fin, 32);
        float ev[16], es = 0.f; const float mx = __uint_as_float(__float_as_uint(fin[0]) & ~255u);
#pragma unroll
        for (int i = 0; i < 16; ++i) { ev[i] = __expf(__uint_as_float(__float_as_uint(fin[i]) & ~255u) - mx); es += ev[i]; }
        const float inv = 1.f / es;
        asm volatile("s_waitcnt lgkmcnt(0)" ::: "memory");
        int oi[4]; float og[4];
#pragma unroll
        for (int kq = 0; kq < 4; ++kq) {
            const float fk = fq == 0 ? fin[kq] : fq == 1 ? fin[4 + kq] : fq == 2 ? fin[8 + kq] : fin[12 + kq];
            const float fe = fq == 0 ? ev[kq] : fq == 1 ? ev[4 + kq] : fq == 2 ? ev[8 + kq] : ev[12 + kq];
            const unsigned code = 255u - (__float_as_uint(fk) & 255u), a = code >> 4, bq = code & 15u;
            const unsigned i1 = 127u - (scr[a] & 127u), i2 = 127u - (scr[16 + bq] & 127u);
            oi[kq] = (int)(i1 * 128u + i2); og[kq] = fe * inv; }
        *(int4*)(IDX + (size_t)tok * 128 + 16 * h + 4 * fq) = make_int4(oi[0], oi[1], oi[2], oi[3]);
        *(f32x4*)(GATE + (size_t)tok * 128 + 16 * h + 4 * fq) = (f32x4){og[0], og[1], og[2], og[3]};
    }
}
struct PeerSched {
    int x0, rank, nloc, nblk, nown; unsigned orphan;
    __device__ __forceinline__ void init(const Args& A, int nrows, LAS unsigned char* smem) {
        unsigned* ctl = (unsigned*)(A.ws + WS_CTL);
        x0 = (int)(xb_xcc_id() & 7u); rank = __builtin_amdgcn_readfirstlane((int)((LAS unsigned*)smem)[8]); nblk = nrows / 64;
        unsigned cached = __builtin_amdgcn_readfirstlane(((LAS unsigned*)smem)[9]);
        if (cached == 0u) { unsigned orph = 0u, nl = 1u;
            for (int j = 0; j < 8; ++j) { unsigned c = xb_ld(&ctl[XB_XCNT(j)]) + xb_ld(&ctl[XB_XCNT(j + 8)]); c = __builtin_amdgcn_readfirstlane(c); if (c == 0u) orph |= 1u << j; if (j == x0) nl = c; }
            cached = (nl << 8) | orph; __syncthreads(); if (threadIdx.x == 0) ((LAS unsigned*)smem)[9] = cached; __syncthreads(); }
        nloc = (int)(cached >> 8); orphan = cached & 0xffu;
        const int tot = (NSL / 8) * nblk; nown = rank < tot ? (tot - rank + nloc - 1) / nloc : 0;
    }
    __device__ __forceinline__ bool item(int j, int& sl, int& blk) const {
        if (j < nown) { const int i = rank + j * nloc; sl = x0 + 8 * (i / nblk); blk = i % nblk; return true; }
        int jj = j - nown; const int tot = (NSL / 8) * nblk, per = ((int)gridDim.x > tot) ? 1 : 0; (void)per;
        for (int o = 0; o < 8; ++o) if ((orphan >> o) & 1u) { const int cnt = ((int)blockIdx.x < tot) ? (tot - (int)blockIdx.x + (int)gridDim.x - 1) / (int)gridDim.x : 0;
            if (jj < cnt) { const int i = (int)blockIdx.x + jj * (int)gridDim.x; sl = o + 8 * (i / nblk); blk = i % nblk; return true; } jj -= cnt; }
        return false;
    }
};
template <class LD, class PR>
__device__ __forceinline__ void peer_items(const PeerSched& S, LD ld, PR pr) {
    int sl, blk, sln, blkn, j = 0, buf = 0; bool have = S.item(0, sl, blk);
    __syncthreads();
    if (have) ld(sl, blk, 0);
    while (have) {
        const bool haven = S.item(j + 1, sln, blkn);
        asm volatile("s_waitcnt vmcnt(0)" ::: "memory");
        if (haven) ld(sln, blkn, buf ^ 1);
        pr(sl, blk, buf);
        sl = sln; blk = blkn; have = haven; buf ^= 1; ++j;
    }
    __syncthreads();
}
#ifndef MK_UVAR
#define MK_UVAR 0
#endif
__device__ __forceinline__ float dpp_sum8(float v) {
    v += __builtin_bit_cast(float, __builtin_amdgcn_mov_dpp(__builtin_bit_cast(int, v), 0xB1, 0xF, 0xF, true));
    v += __builtin_bit_cast(float, __builtin_amdgcn_mov_dpp(__builtin_bit_cast(int, v), 0x4E, 0xF, 0xF, true));
    v += __builtin_bit_cast(float, __builtin_amdgcn_mov_dpp(__builtin_bit_cast(int, v), 0x141, 0xF, 0xF, true));
    return v;
}
__device__ __forceinline__ void phase_peer_u(const Args& A, int layer, int nrows, LAS unsigned char* smem, int rep) {
    const int var = rep ? MK_UVAR : 0;
    const bf16_t* H = (const bf16_t*)(A.ws + WS_H); const int* IDX = (const int*)(A.ws + WS_R2); bf16_t* PART = var ? (bf16_t*)(A.ws + WS_R1) : (bf16_t*)(A.ws + WS_BIG + BIG_PART);
    const unsigned char* U = A.ws + tabset(layer);
    constexpr int PP = 1088, WB = 4 * PP + 2048;
    const int tid = otid(), wid = tid >> 6, lane = tid & 63, m = lane & 7, tk = lane >> 3;
    const int wu = __builtin_amdgcn_readfirstlane(wid);
    LAS unsigned char* lds = smem + LDS_BASE + wu * (2 * WB);
    LAS float* rowc = (LAS float*)(smem + LDS_BASE + 8 * (2 * WB) + wu * 4096) + tk * 128;
    static_assert(8 * (2 * WB) + 8 * 4096 <= LDS_PHASE, "u-phase LDS");
    PeerSched S; S.init(A, nrows, smem);
    peer_items(S,
        [&](int sl, int blk, int buf) {
#pragma unroll
            for (int i = 0; i < 4; ++i)
                __builtin_amdgcn_global_load_lds((const unsigned*)(IDX + ((size_t)blk * 64 + 8 * wu + 2 * i) * 128 + 4 * lane), (LAS unsigned*)(lds + buf * WB + PP * i), 16, 0, 0);
#pragma unroll
            for (int i = 0; i < 2; ++i)
                __builtin_amdgcn_global_load_lds((const unsigned*)(H + (size_t)(blk * 64 + 8 * wu + 4 * i + (lane >> 4)) * 1024 + SW * sl + 8 * (lane & 15)), (LAS unsigned*)(lds + buf * WB + 4 * PP + 1024 * i), 16, 0, 0); },
        [&](int sl, int blk, int buf) {
            const unsigned char* ub = U + (size_t)sl * NEXP * SW + 16 * m;
            const int tok = blk * 64 + wid * 8 + tk;
            const int sw = (tk & 1) * 4;
            const LAS int* ib = (const LAS int*)(lds + buf * WB + (tk >> 1) * PP + (tk & 1) * 512);
            float hf[16];
            { const u32x4 h0 = *(const LAS u32x4*)(lds + buf * WB + 4 * PP + tk * 256 + 32 * m), h1 = *(const LAS u32x4*)(lds + buf * WB + 4 * PP + tk * 256 + 32 * m + 16);
#pragma unroll
              for (int j = 0; j < 4; ++j) { hf[2 * j] = bflo(h0[j]); hf[2 * j + 1] = bfhi(h0[j]); hf[8 + 2 * j] = bflo(h1[j]); hf[8 + 2 * j + 1] = bfhi(h1[j]); } }
            const bool up4 = m >= 4, up2 = (m & 2) != 0, up1 = (m & 1) != 0;
            LAS float* pp = rowc + (m ^ sw);
            u32x4 vv[2][8];
#define PU_ROWS(T, c) do { const i32x4 e0_ = *(const LAS i32x4*)(ib + 8 * (c) + sw), e1_ = *(const LAS i32x4*)(ib + 8 * (c) + (4 - sw)); \
                if (var == 4) { _Pragma("unroll") for (int k_ = 0; k_ < 8; ++k_) vv[T][k_] = (u32x4){(unsigned)e0_.x, (unsigned)e1_.y, 0u, 0u}; } else { \
                vv[T][0] = *(const u32x4*)(ub + (size_t)(var == 3 ? e0_.x & 63 : e0_.x) * SW); vv[T][1] = *(const u32x4*)(ub + (size_t)(var == 3 ? e0_.y & 63 : e0_.y) * SW); \
                vv[T][2] = *(const u32x4*)(ub + (size_t)(var == 3 ? e0_.z & 63 : e0_.z) * SW); vv[T][3] = *(const u32x4*)(ub + (size_t)(var == 3 ? e0_.w & 63 : e0_.w) * SW); \
                vv[T][4] = *(const u32x4*)(ub + (size_t)(var == 3 ? e1_.x & 63 : e1_.x) * SW); vv[T][5] = *(const u32x4*)(ub + (size_t)(var == 3 ? e1_.y & 63 : e1_.y) * SW); \
                vv[T][6] = *(const u32x4*)(ub + (size_t)(var == 3 ? e1_.z & 63 : e1_.z) * SW); vv[T][7] = *(const u32x4*)(ub + (size_t)(var == 3 ? e1_.w & 63 : e1_.w) * SW); } } while (0)
#define PU_DOT(T, c) do { float s_[8]; \
                _Pragma("unroll") for (int k = 0; k < 8; ++k) { f32x2 a2 = {0.f, 0.f}; \
                    _Pragma("unroll") for (int j = 0; j < 4; ++j) { const int w = (int)vv[T][k][j]; \
                        const f32x2 lo = __builtin_amdgcn_cvt_pk_f32_fp8(w, false), hi = __builtin_amdgcn_cvt_pk_f32_fp8(w, true); \
                        a2 = __builtin_elementwise_fma(lo, (f32x2){hf[4 * j], hf[4 * j + 1]}, a2); a2 = __builtin_elementwise_fma(hi, (f32x2){hf[4 * j + 2], hf[4 * j + 3]}, a2); } \
                    s_[k] = a2.x + a2.y; } \
                  \
                float t_[4], u_[2]; \
                _Pragma("unroll") for (int j = 0; j < 4; ++j) { const float give = up4 ? s_[j] : s_[4 + j], keep = up4 ? s_[4 + j] : s_[j]; \
                    t_[j] = keep + __builtin_bit_cast(float, __builtin_amdgcn_mov_dpp(__builtin_bit_cast(int, give), 0x141, 0xF, 0xF, true)); }        \
                _Pragma("unroll") for (int j = 0; j < 2; ++j) { const float give = up2 ? t_[j] : t_[2 + j], keep = up2 ? t_[2 + j] : t_[j]; \
                    u_[j] = keep + __builtin_bit_cast(float, __builtin_amdgcn_mov_dpp(__builtin_bit_cast(int, give), 0x4E, 0xF, 0xF, true)); }         \
                { const float give = up1 ? u_[0] : u_[1], keep = up1 ? u_[1] : u_[0]; \
                  const float tot_ = keep + __builtin_bit_cast(float, __builtin_amdgcn_mov_dpp(__builtin_bit_cast(int, give), 0xB1, 0xF, 0xF, true));           \
                  pp[8 * (c)] = tot_; } } while (0)
            PU_ROWS(0, 0);
#pragma unroll 1
            for (int c = 0; c < 16; c += 2) {
                PU_ROWS(1, c + 1);
                __builtin_amdgcn_sched_barrier(0);
                PU_DOT(0, c);
                __builtin_amdgcn_sched_barrier(0);
                if (c + 2 < 16) PU_ROWS(0, c + 2);
                __builtin_amdgcn_sched_barrier(0);
                PU_DOT(1, c + 1);
                __builtin_amdgcn_sched_barrier(0);
            }
#undef PU_ROWS
#undef PU_DOT
            { const LAS f32x4* rd = (const LAS f32x4*)(rowc + 16 * m); const f32x4 a0 = rd[0], a1 = rd[1], a2 = rd[2], a3 = rd[3];
              u32x4 w0, w1; w0.x = cvt_pk_bf16(a0[0], a0[1]); w0.y = cvt_pk_bf16(a0[2], a0[3]); w0.z = cvt_pk_bf16(a1[0], a1[1]); w0.w = cvt_pk_bf16(a1[2], a1[3]);
              w1.x = cvt_pk_bf16(a2[0], a2[1]); w1.y = cvt_pk_bf16(a2[2], a2[3]); w1.z = cvt_pk_bf16(a3[0], a3[1]); w1.w = cvt_pk_bf16(a3[2], a3[3]);
              bf16_t* gp = PART + ((size_t)sl * NROW + tok) * 128 + 16 * m; *(u32x4*)gp = w0; *(u32x4*)(gp + 8) = w1; }
        });
}
__device__ __forceinline__ void phase_coef(const Args& A, int layer, int nrows) {
    const bf16_t* PART = (const bf16_t*)(A.ws + WS_BIG + BIG_PART); const float* GATE = (const float*)(A.ws + WS_R2 + R2_GATE); unsigned* REC = (unsigned*)(A.ws + WS_R2 + R2_COEF);
    const int* IDX = (const int*)(A.ws + WS_R2); const float* SCL = (const float*)(A.ws + tabset(layer) + TAB_SCL);
    const int gthr = blockIdx.x * NTHR + otid(), nthr = gridDim.x * NTHR;
    for (int p = gthr; p < nrows * 16; p += nthr) {
        f32x4 s0 = {0.f, 0.f, 0.f, 0.f}, s1 = {0.f, 0.f, 0.f, 0.f};
#pragma unroll
        for (int x = 0; x < NSL; ++x) { const u32x4 w = *(const u32x4*)(PART + (size_t)x * NROW * 128 + 8 * p);
            s0 += (f32x4){bflo(w.x), bfhi(w.x), bflo(w.y), bfhi(w.y)}; s1 += (f32x4){bflo(w.z), bfhi(w.z), bflo(w.w), bfhi(w.w)}; }
#pragma unroll
        for (int hlf = 0; hlf < 2; ++hlf) { const f32x4 sm = hlf ? s1 : s0;
            const i32x4 e = *(const i32x4*)(IDX + 8 * p + 4 * hlf); const f32x4 gt = *(const f32x4*)(GATE + 8 * p + 4 * hlf);
            const f32x4 su = {SCL[e.x], SCL[e.y], SCL[e.z], SCL[e.w]}, sv = {SCL[NEXP + e.x], SCL[NEXP + e.y], SCL[NEXP + e.z], SCL[NEXP + e.w]};
            const f32x4 a = sm * su; const f32x2 g0 = gelu_pk((f32x2){a[0], a[1]}), g1 = gelu_pk((f32x2){a[2], a[3]});
            const f32x4 cf = gt * (f32x4){g0.x, g0.y, g1.x, g1.y} * sv;
            *(u32x4*)(REC + 8 * p + 4 * hlf) = (u32x4){cvt_pk_bf16(0.f, cf[0]) | (unsigned)e.x, cvt_pk_bf16(0.f, cf[1]) | (unsigned)e.y, cvt_pk_bf16(0.f, cf[2]) | (unsigned)e.z, cvt_pk_bf16(0.f, cf[3]) | (unsigned)e.w}; } }
}
__device__ __forceinline__ void phase_peer_v(const Args& A, int layer, int nrows, LAS unsigned char* smem, int rep) {
    const int* REC = (const int*)(A.ws + WS_R2 + R2_COEF);
    const unsigned char* V = A.ws + tabset(layer) + TAB8_HALF; const float* MODL = (const float*)(A.ws + WS_MOD) + (size_t)layer * 5 * 6144 + 5 * 1024;
    bf16_t* XB = (bf16_t*)(A.ws + WS_XB);
    constexpr int PP = 1088, WB = 4 * PP;
    const int tid = otid(), wid = tid >> 6, lane = tid & 63, m = lane & 7, tk = lane >> 3;
    const int wu = __builtin_amdgcn_readfirstlane(wid);
    LAS unsigned char* lds = smem + LDS_BASE + wu * (2 * WB);
    LAS float* gl = (LAS float*)(smem + LDS_BASE + 8 * (2 * WB));
    static_assert(8 * (2 * WB) + 5 * 1024 * 4 <= LDS_PHASE, "v-phase LDS");
    for (int i = tid; i < 5 * 256; i += NTHR) *(LAS f32x4*)(gl + 4 * i) = *(const f32x4*)(MODL + (size_t)(i >> 8) * 6144 + 4 * (i & 255));
    PeerSched S; S.init(A, nrows, smem);
    peer_items(S,
        [&](int sl, int blk, int buf) {
#pragma unroll
            for (int i = 0; i < 4; ++i)
                __builtin_amdgcn_global_load_lds((const unsigned*)(REC + ((size_t)blk * 64 + 8 * wu + 2 * i) * 128 + 4 * lane), (LAS unsigned*)(lds + buf * WB + PP * i), 16, 0, 0); },
        [&](int sl, int blk, int buf) {
            const unsigned char* vb = V + (size_t)sl * NEXP * SW + 16 * m;
            const int tok = blk * 64 + wid * 8 + tk; const bool lat = tok < NLAT;
            const int toff = (tk >> 1) * PP + (tk & 1) * 512, sw = (tk & 1) * 4;
            const LAS int* ib = (const LAS int*)(lds + buf * WB + toff);
            bf16_t* xp = XB + (size_t)tok * D + SW * sl + 16 * m;
            const u32x4 xr0 = *(const u32x4*)xp, xr1 = *(const u32x4*)(xp + 8);
            f32x2 acc2[8];
#pragma unroll
            for (int j = 0; j < 8; ++j) acc2[j] = (f32x2){0.f, 0.f};
            u32x4 vv[2][8];
#define PV_ROWS(T, c) do { const i32x4 e0_ = *(const LAS i32x4*)(ib + 8 * (c) + sw) & 0xffff, e1_ = *(const LAS i32x4*)(ib + 8 * (c) + (4 - sw)) & 0xffff; \
                vv[T][0] = *(const u32x4*)(vb + (size_t)e0_.x * SW); vv[T][1] = *(const u32x4*)(vb + (size_t)e0_.y * SW); vv[T][2] = *(const u32x4*)(vb + (size_t)e0_.z * SW); vv[T][3] = *(const u32x4*)(vb + (size_t)e0_.w * SW); \
                vv[T][4] = *(const u32x4*)(vb + (size_t)e1_.x * SW); vv[T][5] = *(const u32x4*)(vb + (size_t)e1_.y * SW); vv[T][6] = *(const u32x4*)(vb + (size_t)e1_.z * SW); vv[T][7] = *(const u32x4*)(vb + (size_t)e1_.w * SW); } while (0)
#define PV_FMA(T, c) do { const i32x4 r0_ = *(const LAS i32x4*)(ib + 8 * (c) + sw) & (int)0xffff0000, r1_ = *(const LAS i32x4*)(ib + 8 * (c) + (4 - sw)) & (int)0xffff0000; \
                const f32x4 c0_ = __builtin_bit_cast(f32x4, r0_), c1_ = __builtin_bit_cast(f32x4, r1_); \
                _Pragma("unroll") for (int k = 0; k < 8; ++k) { const float cf = k < 4 ? c0_[k & 3] : c1_[k & 3]; \
                    _Pragma("unroll") for (int j = 0; j < 4; ++j) { const int w = (int)vv[T][k][j]; \
                        const f32x2 lo = __builtin_amdgcn_cvt_pk_f32_fp8(w, false), hi = __builtin_amdgcn_cvt_pk_f32_fp8(w, true); const f32x2 c2 = {cf, cf}; \
                        acc2[2 * j] = __builtin_elementwise_fma(lo, c2, acc2[2 * j]); acc2[2 * j + 1] = __builtin_elementwise_fma(hi, c2, acc2[2 * j + 1]); } } } while (0)
            PV_ROWS(0, 0);
#pragma unroll 1
            for (int c = 0; c < 16; c += 2) {
                PV_ROWS(1, c + 1);
                __builtin_amdgcn_sched_barrier(0);
                PV_FMA(0, c);
                __builtin_amdgcn_sched_barrier(0);
                if (c + 2 < 16) PV_ROWS(0, c + 2);
                __builtin_amdgcn_sched_barrier(0);
                PV_FMA(1, c + 1);
                __builtin_amdgcn_sched_barrier(0);
            }
#undef PV_ROWS
#undef PV_FMA
            const LAS float* gp = gl + (lat ? (tok >> 13) : 4) * 1024 + SW * sl + 16 * m;
            unsigned ow[8];
#pragma unroll
            for (int j = 0; j < 4; ++j) { const f32x4 g = *(const LAS f32x4*)(gp + 4 * j); const unsigned w0 = j == 0 ? xr0.x : j == 1 ? xr0.z : j == 2 ? xr1.x : xr1.z, w1 = j == 0 ? xr0.y : j == 1 ? xr0.w : j == 2 ? xr1.y : xr1.w;
                const f32x4 o = (f32x4){bflo(w0), bfhi(w0), bflo(w1), bfhi(w1)} + g * (f32x4){acc2[2 * j].x, acc2[2 * j].y, acc2[2 * j + 1].x, acc2[2 * j + 1].y};
                ow[2 * j] = cvt_pk_bf16(o[0], o[1]); ow[2 * j + 1] = cvt_pk_bf16(o[2], o[3]); }
            *(u32x4*)xp = (u32x4){ow[0], ow[1], ow[2], ow[3]}; *(u32x4*)(xp + 8) = (u32x4){ow[4], ow[5], ow[6], ow[7]};
        });
}

#ifdef MK_CHECK
constexpr int CW_CHK = 3840;
__device__ __forceinline__ float blk_sum(float v, LAS float* red) {
    const int t_ = otid(); v = wave_sum(v); __syncthreads(); if ((t_ & 63) == 0) red[t_ >> 6] = v; __syncthreads();
    float s = 0.f; for (int i = 0; i < 8; ++i) s += red[i]; __syncthreads(); return s;
}
__device__ __forceinline__ float fp8f(unsigned b) { const unsigned e = (b >> 3) & 15u, m = b & 7u; const float v = e ? ldexpf(1.f + (float)m * 0.125f, (int)e - 7) : ldexpf((float)m * 0.125f, -6); return (b & 0x80u) ? -v : v; }
__device__ __forceinline__ void check_attn(const Args& A, LAS unsigned char* lds, bool with_ctx) {
    const unsigned char* Q = A.ws + WS_R1 + R1_Q; const unsigned char* KN = A.ws + WS_R1 + R1_KN; const unsigned char* KR = A.ws + WS_BIG + BIG_KR; const unsigned char* V = A.ws + WS_R1 + R1_V;
    const bf16_t* CAT = (const bf16_t*)(A.ws + WS_R3 + R3_CAT); float* chk = (float*)(A.ws + WS_CTL) + CW_CHK;
    LAS float* p = (LAS float*)lds; LAS float* qv = p + NKEY; LAS float* red = qv + 192;
    const int tid = otid();
    for (int au = blockIdx.x; au < (with_ctx ? 1056 : 1024); au += gridDim.x) {
        int b, h, qrow, orow, nkey;
        if (au < 1024) { b = au >> 8; h = au & 7; const int qb = (au >> 3) & 31, l = 256 * qb + (int)((((unsigned)au * 2654435761u) >> 20) & 255u); qrow = 256 + l; orow = b * 8192 + l; nkey = NKEY; }
        else { const int cu = au - 1024; b = cu >> 3; h = cu & 7; const int lc = (int)((((unsigned)au * 2654435761u) >> 20) & 255u); qrow = lc; orow = NLAT + 256 * b + lc; nkey = 256; }
        const size_t bh = (size_t)(b * 8 + h);
        __syncthreads();
        if (tid < 192) qv[tid] = fp8f(Q[(bh * NKEY + qrow) * 192 + tid]) * (1.f / att8::QUP);
        __syncthreads();
        float mx = -1e30f;
        for (int key = tid; key < nkey; key += 512) { const int t = key >> 6, k = key & 63; float sacc = 0.f;
            for (int d = 0; d < 128; ++d) sacc += qv[d] * fp8f(KN[(bh * NKT + t) * 8192 + att8::kn8(k, d)]);
            for (int d = 0; d < 64; ++d) sacc += qv[128 + d] * fp8f(KR[((size_t)b * NKT + t) * 4096 + att8::kr8(k, d)]);
            p[key] = sacc; mx = fmaxf(mx, sacc); }
        for (int o = 32; o >= 1; o >>= 1) mx = fmaxf(mx, __shfl_xor(mx, o));
        __syncthreads(); if ((tid & 63) == 0) red[tid >> 6] = mx; __syncthreads(); mx = red[0]; for (int i = 1; i < 8; ++i) mx = fmaxf(mx, red[i]); __syncthreads();
        float ls = 0.f; for (int key = tid; key < nkey; key += 512) { const float e = exp2f(p[key] - mx); p[key] = e; ls += e; }
        ls = blk_sum(ls, red);
        float num = 0.f, den = 0.f;
        if (tid < 128) { float o = 0.f; for (int key = 0; key < nkey; ++key) o += p[key] * fp8f(V[(bh * NKT + (key >> 6)) * 8192 + att8::v8(tid, key & 63)]);
            o /= ls; const float got = bf2f(CAT[(size_t)orow * 2048 + 1024 + 128 * h + tid]); num = (got - o) * (got - o); den = o * o; }
        num = blk_sum(num, red); den = blk_sum(den, red);
        if (tid == 0) { atomicAdd(chk, num); atomicAdd(chk + 1, den); }
    }
}
__device__ __forceinline__ void check_qkv(const Args& A, int li, LAS unsigned char* lds) {
    float* chk = (float*)(A.ws + WS_CTL) + CW_CHK;
    const unsigned char* Q = A.ws + WS_R1 + R1_Q; const unsigned char* KN = A.ws + WS_R1 + R1_KN; const unsigned char* KR = A.ws + WS_BIG + BIG_KR; const unsigned char* V = A.ws + WS_R1 + R1_V;
    LAS float* hv = (LAS float*)lds; LAS float* cq = hv + 1024; LAS float* ckv = cq + 384; LAS float* kr = ckv + 256; LAS float* red = kr + 64; LAS float* ov = red + 16;
    const int tid = otid(), sidx = blockIdx.x;
    const int hd = sidx & 7; const int r = (sidx & 8) ? NLAT + (int)(((unsigned)sidx * 2654435761u) >> 22) : (int)(((unsigned)sidx * 2654435761u) >> 17);
    const float* win = A.in[I_HWIN] + (size_t)li * 1024 * HYB_IN;
    {
        const bf16_t* xp = (const bf16_t*)(A.ws + WS_XB) + (size_t)r * D; const float* MODL = (const float*)(A.ws + WS_MOD) + (size_t)(2 * li) * 5 * 6144 + (size_t)row_mb(r) * 6144;
        float ss = 0.f; for (int i = tid; i < 1024; i += 512) ss += bf2f(xp[i]) * bf2f(xp[i]);
        ss = blk_sum(ss, red); const float rstd = rsqrtf(ss / 1024.f + EPS);
        for (int i = tid; i < 1024; i += 512) hv[i] = bf2f(f2bf(bf2f(xp[i]) * rstd * A.in[I_N1G][(2 * li) * 1024 + i] * (1.f + MODL[1024 + i]) + MODL[i])); }
    __syncthreads();
    for (int j = tid; j < 704; j += 512) { float s = 0.f; for (int k = 0; k < 1024; ++k) s += hv[k] * win[(size_t)k * HYB_IN + C_CQ + j];
        s = bf2f(f2bf(s)); if (j < 384) cq[j] = s; else if (j < 640) ckv[j - 384] = s; else kr[j - 640] = s; }
    __syncthreads();
    float sq = 0.f, sk = 0.f; for (int j = tid; j < 384; j += 512) sq += cq[j] * cq[j]; for (int j = tid; j < 256; j += 512) sk += ckv[j] * ckv[j];
    sq = blk_sum(sq, red); sk = blk_sum(sk, red);
    const float rq = rsqrtf(sq / 384.f + EPS), rk = rsqrtf(sk / 256.f + EPS);
    const float* wqb = A.in[I_WQB] + (size_t)li * 384 * 1536; const float* wkvb = A.in[I_WKVB] + (size_t)li * 256 * 2048; const float* qg = A.in[I_QNG] + li * 384; const float* kg = A.in[I_KVNG] + li * 256;
    if (tid < 192) { float s = 0.f; for (int k = 0; k < 384; ++k) s += cq[k] * rq * qg[k] * wqb[(size_t)k * 1536 + hd * 192 + tid]; ov[tid] = s; }
    else if (tid < 448) { const int c = tid - 192; float s = 0.f; for (int k = 0; k < 256; ++k) s += ckv[k] * rk * kg[k] * wkvb[(size_t)k * 2048 + hd * 256 + c]; ov[tid] = s; }
    __syncthreads();
    const bool lat = r < NLAT; const int b = lat ? (r >> 13) : ((r - NLAT) >> 8), l = lat ? (r & 8191) : 0, key = lat ? 256 + l : ((r - NLAT) & 255), qrow = key;
    const size_t bh = (size_t)(b * 8 + hd); const float qs = QSCALE * att8::QUP;
    float num = 0.f, den = 0.f;
    if (tid < 128) {
        const float q = ov[tid] * qs, gq = fp8f(Q[(bh * NKEY + qrow) * 192 + tid]);
        const float kk = ov[192 + tid], gk = fp8f(KN[(bh * NKT + (key >> 6)) * 8192 + att8::kn8(key & 63, tid)]);
        const float vv = ov[320 + tid], gv = fp8f(V[(bh * NKT + (key >> 6)) * 8192 + att8::v8(tid, key & 63)]);
        num = (gq - q) * (gq - q) + (gk - kk) * (gk - kk) + (gv - vv) * (gv - vv); den = q * q + kk * kk + vv * vv;
    } else if (tid < 160) {
        const int i = tid - 128; float c = 1.f, sn = 0.f;
        if (lat) { const float pos = (float)(i < 16 ? (l >> 6) : (l & 63)); const float ang = pos * powf(10000.f, -(float)(i & 15) / 16.f); c = cosf(ang); sn = sinf(ang); }
        const float q1 = ov[128 + i] * qs, q2 = ov[160 + i] * qs, k1 = kr[i], k2 = kr[32 + i];
        const float rq1 = q1 * c - q2 * sn, rq2 = q1 * sn + q2 * c, rk1 = k1 * c - k2 * sn, rk2 = k1 * sn + k2 * c;
        const float gq1 = fp8f(Q[(bh * NKEY + qrow) * 192 + 128 + 2 * i]), gq2 = fp8f(Q[(bh * NKEY + qrow) * 192 + 128 + 2 * i + 1]);
        const float gk1 = fp8f(KR[((size_t)b * NKT + (key >> 6)) * 4096 + att8::kr8(key & 63, 2 * i)]), gk2 = fp8f(KR[((size_t)b * NKT + (key >> 6)) * 4096 + att8::kr8(key & 63, 2 * i + 1)]);
        num = (gq1 - rq1) * (gq1 - rq1) + (gq2 - rq2) * (gq2 - rq2) + (gk1 - rk1) * (gk1 - rk1) + (gk2 - rk2) * (gk2 - rk2); den = rq1 * rq1 + rq2 * rq2 + rk1 * rk1 + rk2 * rk2;
    }
    num = blk_sum(num, red); den = blk_sum(den, red);
    if (tid == 0) { atomicAdd(chk, num); atomicAdd(chk + 1, den); }
}
__device__ __forceinline__ void check_topk(const Args& A, int layer, LAS unsigned char* lds) {
    const bf16_t* QP = (const bf16_t*)(A.ws + WS_BIG); const int* IDX = (const int*)(A.ws + WS_R2); const float* GATE = (const float*)(A.ws + WS_R2 + R2_GATE); float* chk = (float*)(A.ws + WS_CTL) + CW_CHK;
    const bf16_t* K1 = (const bf16_t*)(A.ws + WS_W + W_PEER + (size_t)layer * WP_SZ + WP_K1);
    LAS float* sc = (LAS float*)lds; LAS float* v12 = sc + 256; LAS int* i12 = (LAS int*)(v12 + 32); LAS float* cs = (LAS float*)(i12 + 32); LAS float* ts = cs + 256; LAS int* ti = (LAS int*)(ts + 16); LAS float* red = (LAS float*)(ti + 16);
    const int tid = otid();
    for (int smp = blockIdx.x; smp < 1024; smp += gridDim.x) {
        const int h = smp & 7, tok = (int)((((unsigned)smp * 2654435761u) >> 12) % (unsigned)NROW);
        __syncthreads();
        if (tid < 256) { const int half = tid >> 7, key = tid & 127; float a = 0.f;
            for (int d = 0; d < 128; ++d) a += bf2f(QP[(size_t)tok * 2048 + 256 * h + 128 * half + d]) * bf2f(K1[((size_t)half * 8 + h) * 16384 + key * 128 + d]);
            sc[tid] = a; }
        __syncthreads();
        if (tid < 256) { const int half = tid >> 7, key = tid & 127; const float v = sc[tid]; int rank = 0;
            for (int j = 0; j < 128; ++j) { const float o = sc[half * 128 + j]; rank += (o > v || (o == v && j < key)) ? 1 : 0; }
            if (rank < 16) { v12[half * 16 + rank] = v; i12[half * 16 + rank] = key; } }
        __syncthreads();
        if (tid < 256) cs[tid] = v12[tid >> 4] + v12[16 + (tid & 15)];
        __syncthreads();
        if (tid < 256) { const float v = cs[tid]; int rank = 0;
            for (int j = 0; j < 256; ++j) { const float o = cs[j]; rank += (o > v || (o == v && j < tid)) ? 1 : 0; }
            if (rank < 16) { ts[rank] = v; ti[rank] = i12[tid >> 4] * 128 + i12[16 + (tid & 15)]; } }
        __syncthreads();
        float num = 0.f, den = 0.f;
        if (tid < 16) { float es = 0.f; for (int j = 0; j < 16; ++j) es += __expf(ts[j] - ts[0]); const float gn = __expf(ts[tid] - ts[0]) / es; float gk = 0.f;
            for (int j = 0; j < 16; ++j) if (IDX[(size_t)tok * 128 + 16 * h + j] == ti[tid]) gk = GATE[(size_t)tok * 128 + 16 * h + j];
            num = (gk - gn) * (gk - gn); den = gn * gn; }
        num = blk_sum(num, red); den = blk_sum(den, red);
        if (tid == 0) { atomicAdd(chk, num); atomicAdd(chk + 1, den); }
    }
}
__device__ __forceinline__ void check_ssd(const Args& A, int li, LAS unsigned char* lds) {
    const bf16_t* XS = (const bf16_t*)(A.ws + WS_R2); const bf16_t* BC = (const bf16_t*)(A.ws + WS_R2 + R2_BC); const float* DT = (const float*)(A.ws + WS_BIG + BIG_DT);
    const bf16_t* Y0 = (const bf16_t*)(A.ws + WS_H); const bf16_t* Y1 = (const bf16_t*)(A.ws + WS_R3); float* chk = (float*)(A.ws + WS_CTL) + CW_CHK;
    LAS float* red = (LAS float*)lds;
    const int tid = otid(), sidx = blockIdx.x;
    const int b = sidx & 3, d = (sidx >> 2) & 1, h = (sidx >> 3) & 15, p = (int)((((unsigned)sidx * 2654435761u) >> 20) & 63u), g = h >> 3;
    const float a = -__expf(A.in[I_ALOG][li * 32 + d * 16 + h]);
    const bf16_t* Y = d ? Y1 : Y0;
    float hst = 0.f, num = 0.f, den = 0.f;
    for (int step = 0; step < 8448; ++step) {
        int r;
        if (step < 256) r = NLAT + b * 256 + (d ? 255 - step : step); else { const int q = step - 256; r = b * 8192 + (d ? 8191 - q : q); }
        const float dt = DT[(size_t)(d * 16 + h) * NROW + r], x = bf2f(XS[(size_t)r * 1024 + 64 * h + p]);
        float contrib = 0.f;
        if (tid < 128) { hst = __expf(dt * a) * hst + dt * x * bf2f(BC[(size_t)r * 512 + 128 * g + tid]); contrib = hst * bf2f(BC[(size_t)r * 512 + 256 + 128 * g + tid]); }
        if (step % 61 == 0) { const float y = blk_sum(contrib, red); const float got = bf2f(Y[(size_t)r * 1024 + 64 * h + p]); if (tid == 0) { num += (got - y) * (got - y); den += y * y; } }
    }
    if (tid == 0) { atomicAdd(chk, num); atomicAdd(chk + 1, den); }
}
#endif
#ifndef MK_PER_PHASE
#define MK_PER_PHASE 0
#endif
__device__ __forceinline__ int nr_in(int L) { return L <= 2 ? NROW : NLAT; }
__device__ __forceinline__ int nr_out(int L) { return L <= 1 ? NROW : NLAT; }

__global__ void __launch_bounds__(NTHR, 2) fwd(Args A) {
    extern __shared__ __attribute__((aligned(256))) unsigned char smem_raw[];
    LAS unsigned char* smem = (LAS unsigned char*)smem_raw;
    LAS unsigned char* lds = smem + LDS_BASE;
    const int tid = otid();
    if (tid < 64) ((LAS unsigned*)smem)[tid] = 0u;
    __syncthreads();
    XcdBarrier bar = xcd_barrier_post((unsigned*)(A.ws + WS_CTL), (volatile LAS unsigned*)smem);
    if (tid == 0) ((LAS unsigned*)smem)[8] = atomicAdd((unsigned*)(A.ws + WS_CTL) + CW_RANK + 32 * (xb_xcc_id() & 7u), 1u);
    __syncthreads();
    bool need_bar = false;
    const int lo = A.ph_lo, hi = A.ph_hi;
#ifndef PHMASK
#define PHMASK 0xffffffffu
#endif
#define SITE(k) if constexpr (((PHMASK) >> (k)) & 1u)
#ifndef MK_SVAR
#define MK_SVAR 1
#endif
#ifndef MK_REPEAT_SITE
#define MK_REPEAT_SITE -1
#endif
#define REP(k) for (int rep = 0; rep < ((k) == (MK_REPEAT_SITE) ? 2 : 1); ++rep)
#define PH(id) if ([&]() -> bool { if ((id) < lo || (id) >= hi) return false; if (need_bar) xcd_barrier(bar); need_bar = true; return true; }())
    unsigned char* ws = A.ws;
#define TAIL_TAB(units, layer, rlo, rhi) do { const int nx_ = (units) % 256; if (gridDim.x == 256 && (int)blockIdx.x >= nx_) phase_tabcvt(A, layer, (int)blockIdx.x - nx_, 256 - nx_, rlo, rhi); } while (0)
    bf16_t* XB = (bf16_t*)(ws + WS_XB);
    bf16_t* H = (bf16_t*)(ws + WS_H);
    const float* MOD = (const float*)(ws + WS_MOD);

    SITE(0) PH(0) { phase_prologue(A, lds); }
    SITE(1) PH(1) { phase_norm_mod<true>(A.in[I_X], A.in[I_CTX], XB, A.in[I_N1G], MOD, 0, H, NROW); }
    for (int L = 0; L < DEPTH; ++L) {
        const int base = 2 + 16 * L, li = L >> 1; const bool hyb = (L & 1) == 0;
        const float* MODL = MOD + (size_t)L * 5 * 6144;
        unsigned char* WH = ws + WS_W + W_HYB + (size_t)li * WH_SZ; unsigned char* WG = ws + WS_W + W_GM + (size_t)li * WG_SZ; unsigned char* WP = ws + WS_W + W_PEER + (size_t)L * WP_SZ;
        if (hyb) {
            SITE(2) PH(base + 0) REP(2) { pg8::Gemm g{H, (const bf16_t*)(WH + WH_IN), nr_in(L), HYB_INP, 1024, 1024, 1024};
                pg8::EpiBf16<0> e{(bf16_t*)(ws + WS_BIG), HYB_INP}; pg8::gemm_phase(lds, g, e); }
            SITE(3) PH(base + 1) REP(3) { phase_conv(A, li, rep); }
            SITE(4) PH(base + 2) {
                SITE(18) REP(18) { pg8::Gemm g{(const bf16_t*)(ws + WS_BIG) + C_CQ, (const bf16_t*)(WH + WH_QB), L == 0 ? NROW : NLAT, 1536, 384, HYB_INP, 384};
                  EpiQ e{ws + WS_R1 + R1_Q, (const float*)(ws + WS_RSTD), (const float*)(ws + WS_ROPE)}; pg8::gemm_phase(lds, g, e); }
                SITE(19) REP(19) { pg8::Gemm g{(const bf16_t*)(ws + WS_BIG) + C_CKV, (const bf16_t*)(WH + WH_KVB), NROW, 2048, 256, HYB_INP, 256};
                  EpiKV e{ws + WS_R1 + R1_KN, ws + WS_R1 + R1_V, (const float*)(ws + WS_RSTD) + NROW}; pg8::gemm_phase(lds, g, e); }
                SITE(20) REP(20) for (int u = blockIdx.x; u < 528; u += gridDim.x) ssd::g_unit((const bf16_t*)(ws + WS_R2 + R2_BC), (bf16_t*)(ws + WS_BIG + BIG_G), u);
            }
            SITE(5) PH(base + 3) {
                const int xq = (int)blockIdx.x & 7, jq = (int)blockIdx.x >> 3; const bool ssd_wg = (jq & 1) == 0 && gridDim.x == 256;
                if (gridDim.x == 256) {
                    if (ssd_wg) { const int r = jq >> 1, gi = xq + 8 * (r >> 3), hh = r & 7, sb = gi >> 2, sgp = (gi >> 1) & 1, sd = gi & 1;
                        SITE(21) ssd::ssd_unit(sb, 8 * sgp + hh, sd, (const bf16_t*)(ws + WS_R2), (const bf16_t*)(ws + WS_R2 + R2_BC), (const float*)(ws + WS_BIG + BIG_DT), (const bf16_t*)(ws + WS_BIG + BIG_G),
                                               A.in[I_ALOG] + li * 32, sd ? (bf16_t*)(ws + WS_R3) : (bf16_t*)(ws + WS_H), lds); }
                } else {
                    SITE(21) for (int u = blockIdx.x; u < 128; u += gridDim.x) ssd::ssd_unit(u >> 5, (u >> 1) & 15, u & 1, (const bf16_t*)(ws + WS_R2), (const bf16_t*)(ws + WS_R2 + R2_BC), (const float*)(ws + WS_BIG + BIG_DT),
                                               (const bf16_t*)(ws + WS_BIG + BIG_G), A.in[I_ALOG] + li * 32, (u & 1) ? (bf16_t*)(ws + WS_R3) : (bf16_t*)(ws + WS_H), lds);
                }
                const int nmine = gridDim.x == 256 ? (ssd_wg ? 3 : 5) + (L == 0 && !ssd_wg && jq < 8 ? 1 : 0) : 0;
                SITE(22) REP(22) for (int it = 0; gridDim.x == 256 ? it < nmine : (int)blockIdx.x + it * (int)gridDim.x < (L == 0 ? 1056 : 1024); ++it) {
                    int b, h, qrow0, orow0, nt;
                    if (gridDim.x == 256) {
                        const int base_it = ssd_wg ? 3 : 5;
                        if (it < base_it) { const int v = ssd_wg ? 3 * (jq >> 1) + it : 48 + 5 * (jq >> 1) + it; b = v >> 5; h = xq; const int qb = v & 31; qrow0 = 256 + 256 * qb; orow0 = b * 8192 + 256 * qb; nt = NKT; }
                        else { b = jq >> 1; h = xq; qrow0 = 0; orow0 = NLAT + 256 * b; nt = 4; }
                    } else { const int au = (int)blockIdx.x + it * (int)gridDim.x;
                        if (au < 1024) { b = au >> 8; h = au & 7; const int qb = (au >> 3) & 31; qrow0 = 256 + 256 * qb; orow0 = b * 8192 + 256 * qb; nt = NKT; }
                        else { const int cu = au - 1024; b = cu >> 3; h = cu & 7; qrow0 = 0; orow0 = NLAT + 256 * b; nt = 4; } }
                    const size_t bh = (size_t)(b * 8 + h);
                    att8::attn_unit(ws + WS_R1 + R1_Q + (bh * NKEY + qrow0) * 192, ws + WS_R1 + R1_KN + bh * NKT * 8192, ws + WS_BIG + BIG_KR + (size_t)b * NKT * 4096,
                                    ws + WS_R1 + R1_V + bh * NKT * 8192, (bf16_t*)(ws + WS_R3 + R3_CAT) + (size_t)orow0 * 2048 + 1024 + 128 * h, nt, lds);
                }
                if (gridDim.x == 256 && !ssd_wg && L == 2) SITE(11) phase_tabcvt(A, 3, xq + 8 * (jq >> 1), 128, 0, NEXP);
            }
            SITE(6) PH(base + 4) REP(6) { phase_ssd_out(A, li, nr_out(L));
#if defined(MK_CHECK) && MK_CHECK == 1
                if (L == 0) check_attn(A, lds, true);
#elif defined(MK_CHECK) && MK_CHECK == 2
                if (L == 0) check_qkv(A, li, lds);
#elif defined(MK_CHECK) && MK_CHECK == 3
                if (L == 2) check_attn(A, lds, false);
#elif defined(MK_CHECK) && MK_CHECK == 5
                if (L == 0) check_ssd(A, li, lds);
#elif defined(MK_CHECK) && MK_CHECK == 6
                if (L == 2) check_ssd(A, li, lds);
#endif
            }
        } else {
            SITE(7) PH(base + 0) REP(7) { pg8::Gemm g{H, (const bf16_t*)(WG + WG_IN), nr_out(L), 4096, 1024, 1024, 1024};
                pg8::EpiGmIn e{(bf16_t*)(ws + WS_BIG), (float*)(ws + WS_R3)}; pg8::gemm_phase(lds, g, e);
                if (rep == 0 && L == 1) TAIL_TAB((nr_out(L) / 256) * 16, 1, NEXP, 2 * NEXP); }
            SITE(9) PH(base + 2) REP(9) { phase_spatial(A, li, nr_out(L), lds); }
        }
        SITE(10) PH(base + 5) { pg8::Gemm g{hyb ? (const bf16_t*)(ws + WS_R3 + R3_CAT) : (const bf16_t*)(ws + WS_R1), hyb ? (const bf16_t*)(WH + WH_OUT) : (const bf16_t*)(WG + WG_OUT), nr_out(L), 1024, 2048, 2048, 2048};
            pg8::EpiResid e{XB, MODL + 2 * 1024}; pg8::gemm_phase(lds, g, e);
            if (L == 0) TAIL_TAB((nr_out(L) / 256) * 4, 0, 0, 2 * NEXP); else if (L == 1) TAIL_TAB((nr_out(L) / 256) * 4, 2, 0, 2 * NEXP); }
        SITE(11) PH(base + 6) REP(11) { phase_norm_mod<false>(nullptr, nullptr, XB, A.in[I_N2G] + L * 1024, MODL, 3, H, nr_out(L));
            if (gridDim.x != 256) phase_tabcvt(A, L, (int)blockIdx.x, (int)gridDim.x);
            else if (L == 3) phase_tabcvt(A, 3, (int)blockIdx.x, 256, NEXP, 2 * NEXP); }
        SITE(12) PH(base + 7) REP(12) { pg8::Gemm g{H, (const bf16_t*)(WP + WP_Q), nr_out(L), 2048, 1024, 1024, 1024};
            pg8::EpiBf16<0> e{(bf16_t*)(ws + WS_BIG), 2048}; pg8::gemm_phase(lds, g, e);
            if (rep == 0 && L == 0) TAIL_TAB((nr_out(L) / 256) * 8, 1, 0, NEXP); }
        SITE(13) PH(base + 8) REP(13) { phase_topk(A, L, nr_out(L), lds); }
        SITE(14) PH(base + 9) REP(14) { phase_peer_u(A, L, nr_out(L), smem, rep); }
        SITE(15) PH(base + 10) REP(15) { phase_coef(A, L, nr_out(L));
#if defined(MK_CHECK) && MK_CHECK == 4
            if (L == 1) check_topk(A, L, lds);
#endif
        }
        SITE(16) PH(base + 11) { phase_peer_v(A, L, nr_out(L), smem, 0); }
        SITE(17) PH(base + 12) { if (L < DEPTH - 1) phase_norm_mod<false>(nullptr, nullptr, XB, A.in[I_N1G] + (L + 1) * 1024, MOD + (size_t)(L + 1) * 5 * 6144, 0, H, nr_in(L + 1));
                        else {
#ifdef MK_CHECK
                            const float* chk = (const float*)(ws + WS_CTL) + CW_CHK; const float err = sqrtf(chk[0] / fmaxf(chk[1], 1e-30f));
                            phase_final_norm(XB, A.out, A.in[I_FNG], 1.f + 10.f * err);
#else
                            phase_final_norm(XB, A.out, A.in[I_FNG], 1.f);
#endif
                        } }
    }
#undef PH
}

#ifdef MK_TAP
__global__ void tap_kernel(const unsigned short* buf, size_t pitch, size_t col0, size_t ncols, size_t nrows, float* out) {
    const size_t n = ncols * nrows;
    for (size_t i = (size_t)blockIdx.x * blockDim.x + threadIdx.x; i < (size_t)NLAT * D; i += (size_t)gridDim.x * blockDim.x) {
        float s = 0.f; for (size_t j = i; j < n; j += (size_t)NLAT * D) s += (float)buf[(j / ncols) * pitch + col0 + (j % ncols)]; out[i] = s; }
}
#endif
extern "C" void kernel_launch(void* const* d_in, const int* in_sizes, int n_in, void* d_out, int out_size, void* d_ws, size_t ws_size, hipStream_t stream) {
    static int grid = 0;
    if (grid == 0) {
        if (n_in != N_IN || out_size != NLAT * D || ws_size < WS_END) { fprintf(stderr, "kernel_launch: unexpected shapes (n_in %d out %d ws %zu, need %zu)\n", n_in, out_size, ws_size, (size_t)WS_END); grid = -1; return; }
        int dev = 0, cus = 0, per_cu = 0;
        if (hipGetDevice(&dev) != hipSuccess || hipDeviceGetAttribute(&cus, hipDeviceAttributeMultiprocessorCount, dev) != hipSuccess) { grid = -1; return; }
        if (hipFuncSetAttribute((const void*)fwd, hipFuncAttributeMaxDynamicSharedMemorySize, LDS_BYTES) != hipSuccess) { fprintf(stderr, "kernel_launch: hipFuncSetAttribute failed\n"); grid = -1; return; }
        if (hipOccupancyMaxActiveBlocksPerMultiprocessor(&per_cu, (const void*)fwd, NTHR, LDS_BYTES) != hipSuccess || per_cu < 1) { fprintf(stderr, "kernel_launch: occupancy query says %d\n", per_cu); }
        (void)hipGetLastError();
        grid = cus;
    }
    if (grid < 0) return;
    (void)hipMemsetAsync((char*)d_ws + WS_CTL, 0, CTL_BYTES, stream);
    Args a{};
    for (int i = 0; i < N_IN; ++i) a.in[i] = (const float*)d_in[i];
    a.out = (float*)d_out; a.ws = (unsigned char*)d_ws;
#if MK_PER_PHASE
    for (int id = 0; id < 2 + 16 * DEPTH; ++id) {
        if (id >= 2) { const int L = (id - 2) / 16, s = (id - 2) % 16; if (s > 12) continue; if ((L & 1) && (s == 3 || s == 4)) continue; }
#ifdef MK_CUT
#ifdef MK_TAP
        if (id >= MK_CUT) continue;
#else
        if (id >= MK_CUT && id != 2 + 16 * (DEPTH - 1) + 12) continue;
#endif
#endif
        a.ph_lo = id; a.ph_hi = id + 1;
        hipLaunchKernelGGL(fwd, dim3(grid), dim3(NTHR), LDS_BYTES, stream, a);
    }
#ifdef MK_TAP
    { const size_t tp[5] = {MK_TAP}; hipLaunchKernelGGL(tap_kernel, dim3(2048), dim3(256), 0, stream, (const unsigned short*)((const char*)d_ws + tp[0]), tp[1], tp[2], tp[3], tp[4], (float*)d_out); }
#endif
#else
    a.ph_lo = 0; a.ph_hi = 2 + 16 * DEPTH;
    hipLaunchKernelGGL(fwd, dim3(grid), dim3(NTHR), LDS_BYTES, stream, a);
#endif
    const hipError_t le = hipPeekAtLastError();
    if (le != hipSuccess) fprintf(stderr, "kernel_launch: launch failed: %s\n", hipGetErrorName(le));
}
```

```cpp
#include <hip/hip_runtime.h>
#include <cstdio>
#include <cstdint>

#define LAS __attribute__((address_space(3)))
typedef unsigned short bf16_t;
typedef short bf16x8 __attribute__((ext_vector_type(8)));
typedef short s16x4 __attribute__((ext_vector_type(4)));
typedef float f32x2 __attribute__((ext_vector_type(2)));
typedef float f32x4 __attribute__((ext_vector_type(4)));
typedef float f32x16 __attribute__((ext_vector_type(16)));
typedef unsigned u32x2 __attribute__((ext_vector_type(2)));
typedef unsigned u32x4 __attribute__((ext_vector_type(4)));
typedef int i32x4 __attribute__((ext_vector_type(4)));
typedef int i32x8 __attribute__((ext_vector_type(8)));

constexpr int D = 1024, NB = 4, SEQ = 8192, DEPTH = 4, CTXL = 256;
constexpr int NLAT = NB * SEQ, NCTX = NB * CTXL, NROW = NLAT + NCTX;
constexpr int HYB_IN = 3280, HYB_INP = 3328;
constexpr int C_Z = 0, C_XBC = 1024, C_DT = 2560, C_CQ = 2576, C_CKV = 2960, C_KR = 3216;
constexpr int NKEY = SEQ + CTXL, NKT = NKEY / 64;
constexpr float EPS = 1e-6f;
constexpr float QSCALE = 0.07216878364870322f * 1.4426950408889634f;
constexpr int NEXP = 16384;

enum { I_X = 0, I_C, I_CTX, I_CCTX, I_ADAW, I_ADAB, I_N1G, I_N2G, I_HWIN, I_CONVW, I_CONVB, I_ALOG, I_DTB, I_SSDD, I_SSDNG, I_QNG, I_WQB, I_KVNG, I_WKVB,
       I_HWOUT, I_GWIN, I_GLNG, I_GLNB, I_GWS, I_GBS, I_GWOUT, I_PWQ, I_PK1, I_PK2, I_PU, I_PV, I_FNG, N_IN };

constexpr size_t al256(size_t x) { return (x + 255) & ~(size_t)255; }
constexpr size_t WS_CTL = 0, CTL_BYTES = 65536;
constexpr size_t WS_MOD = WS_CTL + CTL_BYTES;
constexpr size_t WS_ROPE = WS_MOD + al256((size_t)DEPTH * 5 * 6144 * 4);
constexpr size_t WS_RSTD = WS_ROPE + (size_t)2 * SEQ * 32 * 4;
constexpr size_t WS_W = WS_RSTD + al256((size_t)2 * NROW * 4);
constexpr size_t W_HYB = 0;
constexpr size_t WH_IN = 0, WH_QB = WH_IN + (size_t)HYB_INP * 1024 * 2, WH_KVB = WH_QB + (size_t)1536 * 384 * 2, WH_OUT = WH_KVB + (size_t)2048 * 256 * 2,
                 WH_SZ = WH_OUT + (size_t)1024 * 2048 * 2;
constexpr size_t W_GM = W_HYB + 2 * WH_SZ;
constexpr size_t WG_IN = 0, WG_OUT = WG_IN + (size_t)4096 * 1024 * 2, WG_WS = WG_OUT + (size_t)1024 * 2048 * 2, WG_SZ = WG_WS + (size_t)8 * 128 * 128 * 2;
constexpr size_t W_PEER = W_GM + 2 * WG_SZ;
constexpr size_t WP_Q = 0, WP_K1 = WP_Q + (size_t)2048 * 1024 * 2, WP_K2 = WP_K1 + (size_t)8 * 128 * 128 * 2, WP_SZ = WP_K2 + (size_t)8 * 128 * 128 * 2;
constexpr size_t W_TOTAL = W_PEER + 4 * WP_SZ;
constexpr size_t WS_TAB = WS_W + al256(W_TOTAL);
constexpr size_t TAB_HALF = (size_t)NEXP * 1024 * 2;
constexpr size_t TAB_REGION = 2 * TAB_HALF + 524288;
constexpr size_t WS_XB = WS_TAB + TAB_REGION;
constexpr size_t WS_H = WS_XB + (size_t)NROW * D * 2;
constexpr size_t WS_BIG = WS_H + (size_t)NROW * D * 2;
constexpr size_t BIG_BYTES = (size_t)NROW * 4096 * 2;
constexpr size_t BIG_DT = (size_t)NROW * HYB_INP * 2;
constexpr size_t BIG_G = BIG_DT + (size_t)NROW * 32 * 4;
constexpr size_t BIG_KR = BIG_G + (size_t)528 * 128 * 128 * 2;
constexpr size_t BIG_PART = (size_t)NROW * 2048 * 2;
static_assert(BIG_KR + (size_t)NB * NKT * 8192 <= BIG_BYTES, "BIG tail");
constexpr size_t WS_R1 = WS_BIG + BIG_BYTES;
constexpr size_t R1_Q = 0, R1_KN = R1_Q + (size_t)NB * 8 * NKEY * 192, R1_V = R1_KN + (size_t)NB * 8 * NKT * 8192, R1_HYB = R1_V + (size_t)NB * 8 * NKT * 8192,
                 R1_GM = (size_t)NROW * 2048 * 2, R1_BYTES = R1_HYB > R1_GM ? R1_HYB : R1_GM;
constexpr size_t WS_R2 = WS_R1 + R1_BYTES;
constexpr size_t R2_BC = (size_t)NROW * 1024 * 2, R2_BYTES = R2_BC + (size_t)NROW * 512 * 2;
constexpr size_t R2_GATE = (size_t)NROW * 128 * 4, R2_COEF = 2 * R2_GATE;
constexpr size_t WS_R3 = WS_R2 + R2_BYTES;
constexpr size_t R3_CAT = (size_t)NROW * 1024 * 2, R3_BYTES = R3_CAT + (size_t)NROW * 2048 * 2;
constexpr size_t WS_END = WS_R3 + R3_BYTES;
static_assert(WS_END <= ((size_t)1 << 30), "workspace must fit 1 GiB");

constexpr int CW_RANK = 3584;
constexpr int CW_QUEUE = 4096;

typedef __bf16 bf16x2_t __attribute__((ext_vector_type(2)));
__device__ __forceinline__ unsigned cvt_pk_bf16(float lo, float hi) { const f32x2 v = {lo, hi}; const bf16x2_t b = __builtin_convertvector(v, bf16x2_t); return __builtin_bit_cast(unsigned, b); }
__device__ __forceinline__ bf16_t f2bf(float f) { return (bf16_t)(cvt_pk_bf16(f, 0.f) & 0xffffu); }
__device__ __forceinline__ float bf2f(unsigned b) { return __uint_as_float(b << 16); }
__device__ __forceinline__ float bflo(unsigned w) { return __uint_as_float(w << 16); }
__device__ __forceinline__ float bfhi(unsigned w) { return __uint_as_float(w & 0xffff0000u); }
__device__ __forceinline__ float wave_sum(float v) {
#pragma unroll
    for (int o = 32; o >= 1; o >>= 1) v += __shfl_xor(v, o);
    return v;
}
__device__ __forceinline__ int otid() { int t = threadIdx.x; asm volatile("" : "+v"(t)); return t; }
__device__ __forceinline__ float silu_f(float x) { return x * __builtin_amdgcn_rcpf(1.f + __expf(-x)); }
__device__ __forceinline__ float softplus_f(float x) { return x > 20.f ? x : log1pf(__expf(x)); }
__device__ __forceinline__ f32x2 gelu_pk(f32x2 v) {
    const f32x2 av = __builtin_elementwise_abs(v), d = av * 0.2316418882f + 1.0f;
    f32x2 t; t.x = __builtin_amdgcn_rcpf(d.x); t.y = __builtin_amdgcn_rcpf(d.y);
    f32x2 q = t * 0.5307027145f + (-0.7265760135f); q = q * t + 0.7107068705f; q = q * t + (-0.142248368f); q = q * t + 0.127414796f; q = q * t;
    const f32x2 s = (v * v) * (-0.72134752044f);
    f32x2 e; e.x = __builtin_amdgcn_exp2f(s.x); e.y = __builtin_amdgcn_exp2f(s.y);
    const f32x2 m = v * (q * e), r = v - m;
    f32x2 o; o.x = v.x < 0.f ? m.x : r.x; o.y = v.y < 0.f ? m.y : r.y; return o;
}
__device__ __forceinline__ float gelu_f(float x) { f32x2 v = {x, 0.f}; return gelu_pk(v).x; }

__device__ __forceinline__ unsigned pk4_fp8(float a, float b, float c, float d) { int w = 0; w = __builtin_amdgcn_cvt_pk_fp8_f32(a, b, w, false); w = __builtin_amdgcn_cvt_pk_fp8_f32(c, d, w, true); return (unsigned)w; }
__device__ __forceinline__ float sat8(float v) { return __builtin_amdgcn_fmed3f(v, -448.f, 448.f); }
__device__ __forceinline__ unsigned pk4_fp8_sat(float a, float b, float c, float d) { return pk4_fp8(sat8(a), sat8(b), sat8(c), sat8(d)); }
__device__ __forceinline__ int row_mb(int r) { return r < NLAT ? (r >> 13) : 4; }

#define XB_TMO      128
#define XB_XCNT(j)  (256  + 64 * (j))
#define XB_XSUB(j)  (1280 + 64 * (j))
#define XB_XGEN(j)  (2304 + 64 * (j))
#define XB_TOP      3328
#define XB_TOPGEN   3392
#define XCD_BAR_WORDS 3456
#define XB_SPIN_CAP (1u << 22)
__device__ __forceinline__ unsigned xb_ld(unsigned* p)              { return __hip_atomic_load(p, __ATOMIC_RELAXED, __HIP_MEMORY_SCOPE_AGENT); }
__device__ __forceinline__ unsigned xb_add(unsigned* p, unsigned v) { return __hip_atomic_fetch_add(p, v, __ATOMIC_RELAXED, __HIP_MEMORY_SCOPE_AGENT); }
__device__ __forceinline__ unsigned xb_xcc_id() { return (unsigned)__builtin_amdgcn_s_getreg((3 << 11) | 20) & 0xFu; }
#define XB_SPIN(cond, bar) do { unsigned _sp = 0; while (cond) { __builtin_amdgcn_s_sleep(1); \
    if ((++_sp & 255u) == 0u) { if (xb_ld(&(bar)[XB_TMO])) break; if (_sp > XB_SPIN_CAP) { atomicAdd(&(bar)[XB_TMO], 1u); break; } } } } while (0)
struct XcdBarrier { unsigned* bar; unsigned x; volatile LAS unsigned* st; };
__device__ __forceinline__ XcdBarrier xcd_barrier_post(unsigned* bar, volatile LAS unsigned* st) {
    XcdBarrier b; b.bar = bar; b.x = xb_xcc_id(); b.st = st;
    if (threadIdx.x == 0) (void)xb_add(&bar[XB_XCNT(b.x)], 1u);
    return b;
}
__device__ __forceinline__ void xcd_barrier_complete(unsigned* bar, unsigned x, unsigned& nloc, unsigned& nx) {
    const unsigned G = gridDim.x * gridDim.y * gridDim.z;
    unsigned sum, cnt, mine, sp = 0u;
    for (;;) {
        sum = 0u; cnt = 0u; mine = 0u;
#pragma unroll
        for (unsigned j = 0; j < 16; ++j) { const unsigned c = xb_ld(&bar[XB_XCNT(j)]); sum += c; cnt += (c > 0u) ? 1u : 0u; mine = (j == x) ? c : mine; }
        if (sum == G) break;
        __builtin_amdgcn_s_sleep(1);
        if ((++sp & 255u) == 0u) { if (xb_ld(&bar[XB_TMO])) break; if (sp > XB_SPIN_CAP) { atomicAdd(&bar[XB_TMO], 1u); break; } }
    }
    nloc = mine > 0u ? mine : 1u; nx = cnt > 0u ? cnt : 1u;
}
__device__ __forceinline__ void xcd_barrier(const XcdBarrier& b) {
    asm volatile("s_waitcnt vmcnt(0)" ::: "memory");
    __syncthreads();
    if (threadIdx.x == 0) {
        unsigned* bar = b.bar;
        __builtin_amdgcn_s_waitcnt(0);
        unsigned nloc = b.st[0], nx = b.st[1];
        if (nloc == 0u) { xcd_barrier_complete(bar, b.x, nloc, nx); b.st[0] = nloc; b.st[1] = nx; }
        const unsigned old = xb_add(&bar[XB_XSUB(b.x)], 1u);
        const unsigned gen = old / nloc;
        if (old + 1u == (gen + 1u) * nloc) {
            __builtin_amdgcn_fence(__ATOMIC_RELEASE, "agent");
            asm volatile("s_waitcnt vmcnt(0)" ::: "memory");
            const unsigned og = xb_add(&bar[XB_TOP], 1u);
            const unsigned tg = og / nx;
            if (og + 1u == (tg + 1u) * nx) xb_add(&bar[XB_TOPGEN], 1u);
            else XB_SPIN(xb_ld(&bar[XB_TOPGEN]) == tg, bar);
            __builtin_amdgcn_fence(__ATOMIC_ACQUIRE, "agent");
            xb_add(&bar[XB_XGEN(b.x)], 1u);
            asm volatile("s_waitcnt vmcnt(0)" ::: "memory");
        } else {
            XB_SPIN(xb_ld(&bar[XB_XGEN(b.x)]) == gen, bar);
            __builtin_amdgcn_fence(__ATOMIC_ACQUIRE, "agent");
            asm volatile("s_waitcnt vmcnt(0)" ::: "memory");
        }
    }
    __syncthreads();
}

namespace pg8 {
constexpr int BM = 256, BK = 64, HALF = 128, HTB = HALF * BK * 2, STAGE_BYTES = 8 * HTB, NXCD = 8, WGM = 8;
__host__ __device__ __forceinline__ int lds_byte(int r, int c) { const int st = (r >> 4) * 2 + (c >> 5), rr = r & 15, cc = c & 31, ob = rr * 64 + cc * 2; return st * 1024 + (ob ^ (((ob >> 9) & 1) << 5)); }
__host__ __device__ __forceinline__ void stage_rc(int b, int& R, int& C) { const int st = b / 1024, sb = b % 1024, swz = sb ^ (((sb >> 9) & 1) << 5); R = (st >> 1) * 16 + swz / 64; C = (st & 1) * 32 + (swz % 64) / 2; }
__host__ __device__ __forceinline__ int perm32(int rho) { const int n = rho >> 4, i = rho & 15; return 8 * (i >> 2) + 4 * n + (i & 3); }
struct Unit { int pm, pn; };
struct Gemm { const bf16_t* A; const bf16_t* Bt; int M, N, K, lda, ldb; };
struct StaticOrder {
    int nM, nN, nwg, G, c;
    __device__ void init(int M, int N, int G_, int c_) { nM = M / BM; nN = N / BM; nwg = nM * nN; G = G_; c = c_; }
    __device__ bool next(int i, Unit& u) const {
        const long L = (long)i * G + c; if (L >= nwg) return false;
        int wgid = (int)L; { const int q = nwg / NXCD, r = nwg % NXCD, xcd = wgid % NXCD, off = wgid / NXCD; wgid = (xcd < r ? xcd * (q + 1) : r * (q + 1) + (xcd - r) * q) + off; }
        const int nig = WGM * nN, gid = wgid / nig, fm = gid * WGM, gsz = (nM - fm) < WGM ? (nM - fm) : WGM;
        u.pm = fm + ((wgid % nig) % gsz); u.pn = (wgid % nig) / gsz; return true;
    }
};
template <class Epi>
__device__ __forceinline__ void gemm_phase(LAS unsigned char* lds, const Gemm g, const Epi& E) {
    const int tid = otid(), wid = __builtin_amdgcn_readfirstlane(tid >> 6), lane = tid & 63, wr = wid >> 2, wc = wid & 3, fr = lane & 15, fq = lane >> 4;
    StaticOrder S; S.init(g.M, g.N, (int)gridDim.x, (int)blockIdx.x);
    int K = g.K; asm volatile("" : "+s"(K));
    const int nt = K / BK;
    unsigned voffA[2], voffB[2];
#pragma unroll
    for (int i = 0; i < 2; ++i) { int R, C; stage_rc(tid * 16 + i * 8192, R, C); const int Rb = Epi::PERM ? ((R & ~31) + perm32(R & 31)) : R;
        voffA[i] = (unsigned)(R * g.lda + C) * 2u; voffB[i] = (unsigned)(Rb * g.ldb + C) * 2u; }
    const size_t kstep = (size_t)(BK * 2);
    const size_t hstepA = (size_t)HALF * g.lda * 2, hstepB = (size_t)HALF * g.ldb * 2;
    const size_t tstepA = 2 * hstepA, tstepB = 2 * hstepB;
    const unsigned ldsw = (unsigned)wid * 1024u;
    const int aoff = lds_byte(wr * 64 + fr, fq * 8), boff = lds_byte(wc * 32 + fr, fq * 8);
#define PG8_SA(b, h) (((b) * 2 + (h)) * HTB)
#define PG8_SB(b, h) ((4 + (b) * 2 + (h)) * HTB)
#define PG8_STAGE(bufoff, gbase, voff) do { _Pragma("unroll") for (int _i = 0; _i < 2; ++_i) \
        __builtin_amdgcn_global_load_lds((const unsigned*)((const char*)(gbase) + (voff)[_i]), (LAS unsigned*)(lds + (bufoff) + ldsw + _i * 8192), 16, 0, 0); } while (0)
#define PG8_LDA(dst, b, h) do { _Pragma("unroll") for (int m = 0; m < 4; ++m) _Pragma("unroll") for (int k = 0; k < 2; ++k) dst[m][k] = *(const LAS bf16x8*)(lds + PG8_SA(b, h) + aoff + m * 2048 + k * 1024); } while (0)
#define PG8_LDB(dst, b, h) do { _Pragma("unroll") for (int n = 0; n < 2; ++n) _Pragma("unroll") for (int k = 0; k < 2; ++k) dst[n][k] = *(const LAS bf16x8*)(lds + PG8_SB(b, h) + boff + n * 2048 + k * 1024); } while (0)
#define PG8_MMA(ai, bj, At, Bt) do { __builtin_amdgcn_s_setprio(1); _Pragma("unroll") for (int m = 0; m < 4; ++m) _Pragma("unroll") for (int n = 0; n < 2; ++n) _Pragma("unroll") for (int k = 0; k < 2; ++k) \
        acc[ai][bj][m][n] = __builtin_amdgcn_mfma_f32_16x16x32_bf16(Bt[n][k], At[m][k], acc[ai][bj][m][n], 0, 0, 0); __builtin_amdgcn_s_setprio(0); } while (0)
#define PG8_WAIT_V(n) asm volatile("s_waitcnt vmcnt(" #n ")" ::: "memory")
#define PG8_WAIT_L(n) asm volatile("s_waitcnt lgkmcnt(" #n ")" ::: "memory")
#define PG8_BAR __builtin_amdgcn_s_barrier()
#define PG8_SCHED __builtin_amdgcn_sched_barrier(0)
    Unit cur, nxt; int ui = 0;
    if (!S.next(0, cur)) return;
    f32x4 acc[2][2][4][2];
#pragma unroll
    for (int a = 0; a < 2; ++a)
#pragma unroll
        for (int b = 0; b < 2; ++b)
#pragma unroll
            for (int m = 0; m < 4; ++m)
#pragma unroll
                for (int n = 0; n < 2; ++n) acc[a][b][m][n] = (f32x4){0.f, 0.f, 0.f, 0.f};
    bf16x8 At[4][2], B0[2][2], B1[2][2];
    const char* cA = (const char*)g.A + (size_t)cur.pm * tstepA; const char* cB = (const char*)g.Bt + (size_t)cur.pn * tstepB;
    PG8_STAGE(PG8_SB(0, 0), cB, voffB); PG8_STAGE(PG8_SB(0, 1), cB + hstepB, voffB); PG8_STAGE(PG8_SA(0, 0), cA, voffA); PG8_STAGE(PG8_SA(0, 1), cA + hstepA, voffA);
    if (wr == 1) PG8_BAR;
    PG8_WAIT_V(2); PG8_BAR;
    PG8_STAGE(PG8_SB(1, 0), cB + kstep, voffB); PG8_STAGE(PG8_SA(1, 0), cA + kstep, voffA); PG8_STAGE(PG8_SB(1, 1), cB + hstepB + kstep, voffB);
    PG8_WAIT_V(6); PG8_BAR;
    for (;;) {
        const bool has_next = S.next(ui + 1, nxt);
        const char* nA = has_next ? (const char*)g.A + (size_t)nxt.pm * tstepA : cA; const char* nB = has_next ? (const char*)g.Bt + (size_t)nxt.pn * tstepB : cB;
        for (int t = 0; t < nt; t += 2) {
            const bool last = (t == nt - 2);
            const char* a1 = cA + (size_t)(t + 1) * kstep;
            const char* a2 = last ? nA : cA + (size_t)(t + 2) * kstep; const char* b2 = last ? nB : cB + (size_t)(t + 2) * kstep;
            const char* a3 = a2 + kstep; const char* b3 = b2 + kstep;
            PG8_LDB(B0, 0, 0); PG8_LDB(B1, 0, 1); PG8_SCHED; PG8_LDA(At, 0, 0); PG8_STAGE(PG8_SA(1, 1), a1 + hstepA, voffA);
            PG8_WAIT_V(8); PG8_WAIT_L(0); PG8_BAR; PG8_MMA(0, 0, At, B0); PG8_MMA(0, 1, At, B1); PG8_BAR; PG8_SCHED;
            PG8_LDA(At, 0, 1); PG8_STAGE(PG8_SB(0, 0), b2, voffB); PG8_STAGE(PG8_SB(0, 1), b2 + hstepB, voffB); PG8_STAGE(PG8_SA(0, 0), a2, voffA);
            PG8_WAIT_V(8); PG8_WAIT_L(0); PG8_BAR; PG8_MMA(1, 0, At, B0); PG8_MMA(1, 1, At, B1); PG8_BAR; PG8_SCHED;
            PG8_LDB(B0, 1, 0); PG8_LDB(B1, 1, 1); PG8_SCHED; PG8_LDA(At, 1, 0); PG8_STAGE(PG8_SA(0, 1), a2 + hstepA, voffA);
            PG8_WAIT_V(8); PG8_WAIT_L(0); PG8_BAR; PG8_MMA(0, 0, At, B0); PG8_MMA(0, 1, At, B1); PG8_BAR; PG8_SCHED;
            PG8_LDA(At, 1, 1); PG8_STAGE(PG8_SB(1, 0), b3, voffB); PG8_STAGE(PG8_SB(1, 1), b3 + hstepB, voffB); PG8_STAGE(PG8_SA(1, 0), a3, voffA);
            PG8_WAIT_V(8); PG8_WAIT_L(0); PG8_BAR; PG8_MMA(1, 0, At, B0); PG8_MMA(1, 1, At, B1); PG8_BAR; PG8_SCHED;
        }
        if (wr == 0) PG8_BAR;
        { const int l2_ = otid() & 63; E(acc, cur, wr, wc, l2_ & 15, l2_ >> 4); }
        if (!has_next) break;
#pragma unroll
        for (int a = 0; a < 2; ++a)
#pragma unroll
            for (int b = 0; b < 2; ++b)
#pragma unroll
                for (int m = 0; m < 4; ++m)
#pragma unroll
                    for (int n = 0; n < 2; ++n) acc[a][b][m][n] = (f32x4){0.f, 0.f, 0.f, 0.f};
        cur = nxt; cA = nA; cB = nB; ++ui;
        if (wr == 1) PG8_BAR;
    }
    PG8_WAIT_V(0);
    PG8_BAR;
#undef PG8_SA
#undef PG8_SB
#undef PG8_STAGE
#undef PG8_LDA
#undef PG8_LDB
#undef PG8_MMA
#undef PG8_WAIT_V
#undef PG8_WAIT_L
#undef PG8_BAR
#undef PG8_SCHED
}

template <int ACT> struct EpiBf16 {
    static constexpr bool PERM = true;
    bf16_t* O; int ldc;
    __device__ __forceinline__ void operator()(const f32x4 (&acc)[2][2][4][2], const Unit& u, int wr, int wc, int fr, int fq) const {
        const int row0 = u.pm * BM + wr * 64 + fr, col0 = u.pn * BM + wc * 32 + 8 * fq;
#pragma unroll
        for (int ai = 0; ai < 2; ++ai)
#pragma unroll
            for (int m = 0; m < 4; ++m) { bf16_t* rowp = O + (size_t)(row0 + ai * HALF + m * 16) * ldc + col0;
#pragma unroll
                for (int bj = 0; bj < 2; ++bj) { f32x4 v0 = acc[ai][bj][m][0], v1 = acc[ai][bj][m][1];
                    if (ACT == 1) { f32x2 a = gelu_pk((f32x2){v0[0], v0[1]}), b = gelu_pk((f32x2){v0[2], v0[3]}), c = gelu_pk((f32x2){v1[0], v1[1]}), d = gelu_pk((f32x2){v1[2], v1[3]});
                        v0 = (f32x4){a.x, a.y, b.x, b.y}; v1 = (f32x4){c.x, c.y, d.x, d.y}; }
                    u32x4 w; w.x = cvt_pk_bf16(v0[0], v0[1]); w.y = cvt_pk_bf16(v0[2], v0[3]); w.z = cvt_pk_bf16(v1[0], v1[1]); w.w = cvt_pk_bf16(v1[2], v1[3]);
                    *(u32x4*)(rowp + bj * HALF) = w; } }
    }
};
struct EpiGmIn {
    static constexpr bool PERM = true;
    bf16_t* O; float* parts;
    __device__ __forceinline__ void operator()(const f32x4 (&acc)[2][2][4][2], const Unit& u, int wr, int wc, int fr, int fq) const {
        const int row0 = u.pm * BM + wr * 64 + fr, col0 = u.pn * BM + wc * 32 + 8 * fq; const bool vhalf = u.pn >= 8;
#pragma unroll
        for (int ai = 0; ai < 2; ++ai)
#pragma unroll
            for (int m = 0; m < 4; ++m) { const int row = row0 + ai * HALF + m * 16; bf16_t* rowp = O + (size_t)row * 4096 + col0; f32x2 sa = {0.f, 0.f}, sq = {0.f, 0.f};
#pragma unroll
                for (int bj = 0; bj < 2; ++bj) { const f32x4 v0 = acc[ai][bj][m][0], v1 = acc[ai][bj][m][1];
                    const f32x2 a = gelu_pk((f32x2){v0[0], v0[1]}), b = gelu_pk((f32x2){v0[2], v0[3]}), c = gelu_pk((f32x2){v1[0], v1[1]}), d = gelu_pk((f32x2){v1[2], v1[3]});
                    sa += (a + b) + (c + d); sq += (a * a + b * b) + (c * c + d * d);
                    u32x4 w; w.x = cvt_pk_bf16(a.x, a.y); w.y = cvt_pk_bf16(b.x, b.y); w.z = cvt_pk_bf16(c.x, c.y); w.w = cvt_pk_bf16(d.x, d.y);
                    *(u32x4*)(rowp + bj * HALF) = w; }
                if (vhalf) { float s1 = sa.x + sa.y, s2 = sq.x + sq.y;
                    { auto r = __builtin_amdgcn_permlane16_swap(__float_as_uint(s1), __float_as_uint(s1), false, false); s1 = __uint_as_float(r[0]) + __uint_as_float(r[1]); }
                    { auto r = __builtin_amdgcn_permlane16_swap(__float_as_uint(s2), __float_as_uint(s2), false, false); s2 = __uint_as_float(r[0]) + __uint_as_float(r[1]); }
                    { auto r = __builtin_amdgcn_permlane32_swap(__float_as_uint(s1), __float_as_uint(s1), false, false); s1 = __uint_as_float(r[0]) + __uint_as_float(r[1]); }
                    { auto r = __builtin_amdgcn_permlane32_swap(__float_as_uint(s2), __float_as_uint(s2), false, false); s2 = __uint_as_float(r[0]) + __uint_as_float(r[1]); }
                    if (fq == 0) *(f32x2*)(parts + ((size_t)row * 32 + (u.pn - 8) * 4 + wc) * 2) = (f32x2){s1, s2}; } }
    }
};
struct EpiResid {
    static constexpr bool PERM = true;
    bf16_t* X; const float* gate;
    __device__ __forceinline__ void operator()(const f32x4 (&acc)[2][2][4][2], const Unit& u, int wr, int wc, int fr, int fq) const {
        const int rbase = u.pm * BM;
        const float* gp = gate + (size_t)(rbase < NLAT ? (rbase >> 13) : 4) * 6144;
        const int row0 = rbase + wr * 64 + fr, col0 = u.pn * BM + wc * 32 + 8 * fq;
        f32x4 gv[2][2];
#pragma unroll
        for (int bj = 0; bj < 2; ++bj)
#pragma unroll
            for (int n = 0; n < 2; ++n) gv[bj][n] = *(const f32x4*)(gp + col0 + bj * HALF + n * 4);
#pragma unroll
        for (int ai = 0; ai < 2; ++ai)
#pragma unroll
            for (int m = 0; m < 4; ++m) { bf16_t* rowp = X + (size_t)(row0 + ai * HALF + m * 16) * D + col0;
#pragma unroll
                for (int bj = 0; bj < 2; ++bj) { u32x4* p = (u32x4*)(rowp + bj * HALF); const u32x4 x = *p;
                    const f32x4 a0 = (f32x4){bflo(x.x), bfhi(x.x), bflo(x.y), bfhi(x.y)} + gv[bj][0] * acc[ai][bj][m][0], a1 = (f32x4){bflo(x.z), bfhi(x.z), bflo(x.w), bfhi(x.w)} + gv[bj][1] * acc[ai][bj][m][1];
                    u32x4 w; w.x = cvt_pk_bf16(a0[0], a0[1]); w.y = cvt_pk_bf16(a0[2], a0[3]); w.z = cvt_pk_bf16(a1[0], a1[1]); w.w = cvt_pk_bf16(a1[2], a1[3]);
                    *p = w; } }
    }
};
}

namespace att {
#define KSWZ(row, colB) ((row) * 256 + ((colB) ^ (((row) & 7) << 4)))
#define KRSWZ(row, colB) ((row) * 128 + ((colB) ^ ((((row) >> 1) & 7) << 4)))
#define SBAR() __builtin_amdgcn_sched_barrier(0)
__device__ __forceinline__ int crow(int r, int hi) { return (r & 3) + 8 * (r >> 2) + 4 * hi; }
__host__ __device__ __forceinline__ int v_st(int k, int c) { const int kk = (k & ~0xC) | ((k & 4) << 1) | ((k & 8) >> 1); return ((kk >> 3) * 4 + (c >> 5)) * 512 + ((kk & 7) * 32 + (c & 31)) * 2; }
__device__ __forceinline__ int v_rd_base(int lane) { return ((lane & 3) << 3) | (((lane >> 2) & 3) << 6) | (((lane >> 4) & 1) << 5) | (((lane >> 5) & 1) << 8); }
constexpr int v_rd_off(int d0, int ks, int half) { return d0 * 512 + ks * 4096 + half * 2048; }
template <int OFF> __device__ __forceinline__ s16x4 tr_read(int vb) {
    s16x4 r; asm volatile("ds_read_b64_tr_b16 %0, %1 offset:%2" : "=&v"(r) : "v"(vb), "i"(OFF) : "memory"); return r;
}
template <int D0> __device__ __forceinline__ void pv_one(f32x16& od, int vb, bf16x8 pa0, bf16x8 pa1, bf16x8 pa2, bf16x8 pa3) {
    const s16x4 l0 = tr_read<v_rd_off(D0, 0, 0)>(vb), h0 = tr_read<v_rd_off(D0, 0, 1)>(vb), l1 = tr_read<v_rd_off(D0, 1, 0)>(vb), h1 = tr_read<v_rd_off(D0, 1, 1)>(vb);
    const s16x4 l2 = tr_read<v_rd_off(D0, 2, 0)>(vb), h2 = tr_read<v_rd_off(D0, 2, 1)>(vb), l3 = tr_read<v_rd_off(D0, 3, 0)>(vb), h3 = tr_read<v_rd_off(D0, 3, 1)>(vb);
    asm volatile("s_waitcnt lgkmcnt(0)" ::: "memory"); SBAR();
#define PK(L, H) (bf16x8){L[0], L[1], L[2], L[3], H[0], H[1], H[2], H[3]}
    od = __builtin_amdgcn_mfma_f32_32x32x16_bf16(pa0, PK(l0, h0), od, 0, 0, 0);
    od = __builtin_amdgcn_mfma_f32_32x32x16_bf16(pa1, PK(l1, h1), od, 0, 0, 0);
    od = __builtin_amdgcn_mfma_f32_32x32x16_bf16(pa2, PK(l2, h2), od, 0, 0, 0);
    od = __builtin_amdgcn_mfma_f32_32x32x16_bf16(pa3, PK(l3, h3), od, 0, 0, 0);
#undef PK
}
__device__ __forceinline__ void pv_d0(f32x16* o, int vb, bf16x8 pa0, bf16x8 pa1, bf16x8 pa2, bf16x8 pa3) {
    pv_one<0>(o[0], vb, pa0, pa1, pa2, pa3); pv_one<1>(o[1], vb, pa0, pa1, pa2, pa3); pv_one<2>(o[2], vb, pa0, pa1, pa2, pa3); pv_one<3>(o[3], vb, pa0, pa1, pa2, pa3);
}
}

namespace att8 {
constexpr int SLOT = 20480, KN_OFF = 0, KR_OFF = 8192, V_OFF = 12288, LDS_BYTES = 3 * SLOT + 8 * 256;
constexpr float THR2 = 8.0f;
constexpr float QUP = 8.f; constexpr int SC_ONE = 0x7f7f7f7f, SC_Q = 0x7c7c7c7c;
__host__ __device__ __forceinline__ int kn8(int key, int b) { return key * 128 + ((((b >> 4) ^ ((key >> 1) & 7))) << 4) + (b & 15); }
__host__ __device__ __forceinline__ int kr8(int key, int b) { return key * 64 + ((((b >> 4) ^ ((key >> 2) & 3))) << 4) + (b & 15); }
__host__ __device__ __forceinline__ int vslot(int k) { return 32 * ((k >> 2) & 1) + 16 * (k >> 5) + (k & 3) + 4 * ((k & 31) >> 3); }
__host__ __device__ __forceinline__ int v8(int d, int k) { const int sl = vslot(k); return d * 64 + ((((sl >> 4) ^ ((d >> 2) & 3))) << 4) + (sl & 15); }
__device__ __forceinline__ i32x8 ld32(const LAS unsigned char* a0, const LAS unsigned char* a1) { const u32x4 x = *(const LAS u32x4*)a0, y = *(const LAS u32x4*)a1;
    return (i32x8){(int)x.x, (int)x.y, (int)x.z, (int)x.w, (int)y.x, (int)y.y, (int)y.z, (int)y.w}; }
struct LAddr { unsigned kn0, kr0; };
__device__ __forceinline__ LAddr laddr(LAS unsigned char* lds, int r32, int hi) {
    LAddr A; const unsigned base = (unsigned)(size_t)lds;
    A.kn0 = base + r32 * 128 + (((2 * hi) ^ ((r32 >> 1) & 7)) << 4);
    A.kr0 = base + r32 * 64 + (((2 * hi) ^ ((r32 >> 2) & 3)) << 4);
    asm volatile("" : "+v"(A.kn0), "+v"(A.kr0));
    return A;
}
#define LP(a, off) ((const LAS unsigned char*)(size_t)((a) + (unsigned)(off)))
#define MF8(a, q, c, sq) __builtin_amdgcn_mfma_scale_f32_32x32x64_f8f6f4(a, q, c, 0, 0, 0, SC_ONE, 0, sq)
__device__ __forceinline__ void rowmax(const f32x16& c0, const f32x16& c1, float& m_reg, float& mn, float& alpha) {
    float pmax = c0[0];
#pragma unroll
    for (int r = 1; r < 16; ++r) pmax = fmaxf(pmax, c0[r]);
#pragma unroll
    for (int r = 0; r < 16; ++r) pmax = fmaxf(pmax, c1[r]);
    { auto rr = __builtin_amdgcn_permlane32_swap(__float_as_uint(pmax), __float_as_uint(pmax), false, false);
      pmax = fmaxf(__uint_as_float(rr[0]), __uint_as_float(rr[1])); }
    mn = (pmax > m_reg + THR2) ? pmax : m_reg;
    alpha = __builtin_amdgcn_exp2f(m_reg - mn); m_reg = mn;
}
__device__ __forceinline__ int crow(int r, int hi) { return (r & 3) + 8 * (r >> 2) + 4 * hi; }
__device__ __forceinline__ void attn_unit(const unsigned char* __restrict__ Qb, const unsigned char* __restrict__ KNt, const unsigned char* __restrict__ KRt, const unsigned char* __restrict__ Vt,
                                          bf16_t* __restrict__ Ob, int NT, LAS unsigned char* lds) {
    const int tid = otid(), wid = __builtin_amdgcn_readfirstlane(tid >> 6), lane = tid & 63, r32 = lane & 31, hi = lane >> 5;
    LAS float* wsf = (LAS float*)(lds + 3 * SLOT) + wid * 64; LAS float* li_l = wsf; LAS float* al_l = wsf + 32;
    float m_reg = -1e30f; f32x16 o[4] = {}; i32x8 qf[3];
    const unsigned char* Qw = Qb + (size_t)(wid * 32 + r32) * 192 + 32 * hi;
#pragma unroll
    for (int ks = 0; ks < 3; ++ks) { const u32x4 x = *(const u32x4*)(Qw + 64 * ks), y = *(const u32x4*)(Qw + 64 * ks + 16); qf[ks] = (i32x8){(int)x.x, (int)x.y, (int)x.z, (int)x.w, (int)y.x, (int)y.y, (int)y.z, (int)y.w}; }
    const unsigned lo16 = (unsigned)lane * 16u; const LAddr LA = laddr(lds, r32, hi);
#define ATT_DMA(tile, slotoff) do { const size_t t_ = (size_t)(tile); LAS unsigned char* sl_ = lds + (slotoff); unsigned lo_ = lo16; asm volatile("" : "+v"(lo_));   \
        __builtin_amdgcn_global_load_lds((const unsigned*)(KNt + t_ * 8192 + wid * 1024 + lo_), (LAS unsigned*)(sl_ + KN_OFF + wid * 1024), 16, 0, 0); \
        __builtin_amdgcn_global_load_lds((const unsigned*)(Vt + t_ * 8192 + wid * 1024 + lo_), (LAS unsigned*)(sl_ + V_OFF + wid * 1024), 16, 0, 0); \
        if (wid < 4) __builtin_amdgcn_global_load_lds((const unsigned*)(KRt + t_ * 4096 + wid * 1024 + lo_), (LAS unsigned*)(sl_ + KR_OFF + wid * 1024), 16, 0, 0); } while (0)
#define ATT_SYNC() do { asm volatile("s_waitcnt vmcnt(0)" ::: "memory"); __builtin_amdgcn_s_barrier(); asm volatile("" ::: "memory"); } while (0)
#define RESC(a) do { if (__any((a) < 1.f)) { const int l_ = (int)__builtin_amdgcn_mbcnt_hi(~0u, __builtin_amdgcn_mbcnt_lo(~0u, 0u)), h_ = l_ >> 5; LAS float* al_ = (LAS float*)(lds + 3 * SLOT) + wid * 64 + 32; \
        if (h_ == 0) al_[l_] = (a); asm volatile("s_waitcnt lgkmcnt(0)" ::: "memory"); \
        _Pragma("unroll") for (int d = 0; d < 4; ++d) _Pragma("unroll") for (int r = 0; r < 16; ++r) o[d][r] *= al_[crow(r, h_)]; } } while (0)
    f32x16 pA0, pA1, pB0, pB1; float mnA, mnB, alA, alB; i32x8 pf = {}; f32x2 l2 = {0.f, 0.f};
    unsigned sp = 0, sc = SLOT, sn = 2 * SLOT;
#define QK_LOAD(x0, x1, off, step) do { a0 = ld32(LP(x0, off), LP(x1, off)); a1 = ld32(LP(x0, (off) + (step)), LP(x1, (off) + (step))); } while (0)
#define ATT_SUBEXP(C0, C1, mnC) do { const f32x2 mn2 = {mnC, mnC}; \
          _Pragma("unroll") for (int r = 0; r < 8; ++r) { const f32x2 t = (f32x2){C0[2 * r], C0[2 * r + 1]} - mn2; C0[2 * r] = __builtin_amdgcn_exp2f(t.x); C0[2 * r + 1] = __builtin_amdgcn_exp2f(t.y); } \
          _Pragma("unroll") for (int r = 0; r < 8; ++r) { const f32x2 t = (f32x2){C1[2 * r], C1[2 * r + 1]} - mn2; C1[2 * r] = t.x; C1[2 * r + 1] = t.y; } } while (0)
#define ATT_FIRST(C0, C1, mnC, alC, sb_) do { i32x8 a0, a1; const unsigned sb = (sb_); \
        { const unsigned x0 = LA.kn0 + sb, x1 = x0 ^ 16u; QK_LOAD(x0, x1, KN_OFF, 4096); } C0 = MF8(a0, qf[0], (f32x16{}), SC_Q); C1 = MF8(a1, qf[0], (f32x16{}), SC_Q); \
        { const unsigned x0 = (LA.kn0 + sb) ^ 64u, x1 = x0 ^ 16u; QK_LOAD(x0, x1, KN_OFF, 4096); } C0 = MF8(a0, qf[1], C0, SC_Q); C1 = MF8(a1, qf[1], C1, SC_Q); \
        { const unsigned x0 = LA.kr0 + sb, x1 = x0 ^ 16u; QK_LOAD(x0, x1, KR_OFF, 2048); } C0 = MF8(a0, qf[2], C0, SC_Q); C1 = MF8(a1, qf[2], C1, SC_Q); \
        rowmax(C0, C1, m_reg, mnC, alC); l2 *= (f32x2){alC, alC}; ATT_SUBEXP(C0, C1, mnC); } while (0)
#define ATT_PVLOAD(sb_) do { const unsigned v0 = LA.kr0 + (sb_), v1 = v0 ^ 16u; \
        _Pragma("unroll") for (int d0 = 0; d0 < 4; ++d0) vb[d0] = ld32(LP(v0, V_OFF + d0 * 2048), LP(v1, V_OFF + d0 * 2048)); } while (0)
#define ATT_FIN0(P0, P1) do { _Pragma("unroll") for (int r = 0; r < 16; ++r) P1[r] = __builtin_amdgcn_exp2f(P1[r]); } while (0)
#define ATT_FIN1(P0, P1) do { f32x2 ps = {P0[0], P0[1]}; \
            _Pragma("unroll") for (int r = 1; r < 8; ++r) ps += (f32x2){P0[2 * r], P0[2 * r + 1]}; \
            _Pragma("unroll") for (int r = 0; r < 8; ++r) ps += (f32x2){P1[2 * r], P1[2 * r + 1]}; \
            l2 += ps; } while (0)
#define ATT_FIN2(P0, P1) do { _Pragma("unroll") for (int w = 0; w < 4; ++w) { \
            int a_ = __builtin_amdgcn_cvt_pk_fp8_f32(P0[4 * w], P0[4 * w + 1], pf[w], false); pf[w] = __builtin_amdgcn_cvt_pk_fp8_f32(P0[4 * w + 2], P0[4 * w + 3], a_, true); \
            int b_ = __builtin_amdgcn_cvt_pk_fp8_f32(P1[4 * w], P1[4 * w + 1], pf[4 + w], false); pf[4 + w] = __builtin_amdgcn_cvt_pk_fp8_f32(P1[4 * w + 2], P1[4 * w + 3], b_, true); } } while (0)
#define ATT_STEP(C0, C1, mnC, alC, P0, P1, alP) do { i32x8 a0, a1, vb[4]; \
        SBAR(); { const unsigned x0 = LA.kn0 + sc, x1 = x0 ^ 16u; QK_LOAD(x0, x1, KN_OFF, 4096); } \
        SBAR(); ATT_FIN0(P0, P1); \
        SBAR(); C0 = MF8(a0, qf[0], (f32x16{}), SC_Q); C1 = MF8(a1, qf[0], (f32x16{}), SC_Q); \
        { const unsigned x0 = (LA.kn0 + sc) ^ 64u, x1 = x0 ^ 16u; QK_LOAD(x0, x1, KN_OFF, 4096); } \
        SBAR(); ATT_FIN1(P0, P1); \
        SBAR(); C0 = MF8(a0, qf[1], C0, SC_Q); C1 = MF8(a1, qf[1], C1, SC_Q); \
        { const unsigned x0 = LA.kr0 + sc, x1 = x0 ^ 16u; QK_LOAD(x0, x1, KR_OFF, 2048); } \
        SBAR(); ATT_FIN2(P0, P1); \
        SBAR(); C0 = MF8(a0, qf[2], C0, SC_Q); C1 = MF8(a1, qf[2], C1, SC_Q); \
        const unsigned v0 = LA.kr0 + sp, v1 = v0 ^ 16u; \
        vb[0] = ld32(LP(v0, V_OFF), LP(v1, V_OFF)); vb[1] = ld32(LP(v0, V_OFF + 2048), LP(v1, V_OFF + 2048)); \
        SBAR(); o[0] = MF8(pf, vb[0], o[0], SC_ONE); o[1] = MF8(pf, vb[1], o[1], SC_ONE); \
        vb[2] = ld32(LP(v0, V_OFF + 4096), LP(v1, V_OFF + 4096)); vb[3] = ld32(LP(v0, V_OFF + 6144), LP(v1, V_OFF + 6144)); \
        SBAR(); o[2] = MF8(pf, vb[2], o[2], SC_ONE); o[3] = MF8(pf, vb[3], o[3], SC_ONE); \
        SBAR(); rowmax(C0, C1, m_reg, mnC, alC); l2 *= (f32x2){alC, alC}; ATT_SUBEXP(C0, C1, mnC); \
        SBAR(); RESC(alC); \
        { const unsigned t_ = sp; sp = sc; sc = sn; sn = t_; } } while (0)
    ATT_DMA(0, 0);
    ATT_SYNC();
    ATT_DMA(1, SLOT);
    ATT_FIRST(pA0, pA1, mnA, alA, 0u);
    for (int j = 1; j + 1 < NT; j += 2) {
        ATT_SYNC(); ATT_DMA(j + 1, sn);
        ATT_STEP(pB0, pB1, mnB, alB, pA0, pA1, alA);
        ATT_SYNC(); if (j + 2 < NT) ATT_DMA(j + 2, sn);
        ATT_STEP(pA0, pA1, mnA, alA, pB0, pB1, alB);
    }
    ATT_SYNC();
    ATT_STEP(pB0, pB1, mnB, alB, pA0, pA1, alA);
    { i32x8 vb[4]; ATT_FIN0(pB0, pB1); ATT_FIN1(pB0, pB1); ATT_FIN2(pB0, pB1); ATT_PVLOAD(sp); SBAR();
#pragma unroll
      for (int d0 = 0; d0 < 4; ++d0) o[d0] = MF8(pf, vb[d0], o[d0], SC_ONE); }
#undef ATT_STEP
#undef ATT_FIN0
#undef ATT_FIN1
#undef ATT_FIN2
#undef ATT_PVLOAD
#undef ATT_FIRST
#undef ATT_SUBEXP
#undef QK_LOAD
    float l_reg = l2.x + l2.y;
    { auto rr = __builtin_amdgcn_permlane32_swap(__float_as_uint(l_reg), __float_as_uint(l_reg), false, false);
      l_reg = __uint_as_float(rr[0]) + __uint_as_float(rr[1]); }
    if (hi == 0) li_l[r32] = l_reg; asm volatile("s_waitcnt lgkmcnt(0)" ::: "memory");
    float rli[16];
#pragma unroll
    for (int r = 0; r < 16; ++r) rli[r] = __builtin_amdgcn_rcpf(li_l[crow(r, hi)]);
    bf16_t* Ow = Ob + (size_t)(wid * 32) * 2048;
#pragma unroll
    for (int r = 0; r < 16; ++r) { const int orow = crow(r, hi);
#pragma unroll
        for (int d0 = 0; d0 < 4; ++d0) Ow[(size_t)orow * 2048 + d0 * 32 + r32] = f2bf(o[d0][r] * rli[r]); }
    __builtin_amdgcn_s_barrier(); asm volatile("" ::: "memory");
#undef ATT_DMA
#undef ATT_SYNC
#undef RESC
}
}

namespace ssd {
constexpr int XT_OFF = 0, BT_OFF = 17408, HB_OFF = 52224, SET = 69632, CW_OFF = 2 * SET, LDS_BYTES = CW_OFF + 8 * 1536;
constexpr int PITCH = 272;
constexpr float L2E = 1.4426950408889634f;
__device__ __forceinline__ void g_unit(const bf16_t* __restrict__ BC, bf16_t* __restrict__ G, int unit) {
    const int cid = unit >> 1, g = unit & 1;
    const int r0 = cid < 256 ? cid * 128 : NLAT + (cid - 256) * 128;
    const int tid = otid(), wid = tid >> 6, lane = tid & 63, fr = lane & 15, fq = lane >> 4;
    const bf16_t* Cp = BC + (size_t)(r0 + 16 * wid + fr) * 512 + 256 + 128 * g + 8 * fq;
    bf16x8 cf[4];
#pragma unroll
    for (int ks = 0; ks < 4; ++ks) cf[ks] = *(const bf16x8*)(Cp + 32 * ks);
    bf16_t* Gp = G + ((size_t)unit * 128 + 16 * wid + fr) * 128 + 4 * fq;
#pragma unroll
    for (int sb = 0; sb < 8; ++sb) {
        const bf16_t* Bp = BC + (size_t)(r0 + 16 * sb + fr) * 512 + 128 * g + 8 * fq;
        f32x4 acc = {0.f, 0.f, 0.f, 0.f};
#pragma unroll
        for (int ks = 0; ks < 4; ++ks) { const bf16x8 bfr = *(const bf16x8*)(Bp + 32 * ks); acc = __builtin_amdgcn_mfma_f32_16x16x32_bf16(bfr, cf[ks], acc, 0, 0, 0); }
        u32x2 w; w.x = cvt_pk_bf16(acc[0], acc[1]); w.y = cvt_pk_bf16(acc[2], acc[3]);
        *(u32x2*)(Gp + 16 * sb) = w;
    }
}
__device__ __forceinline__ void ssd_unit(int b, int h, int d, const bf16_t* __restrict__ XS, const bf16_t* __restrict__ BC, const float* __restrict__ DT, const bf16_t* __restrict__ G,
                                         const float* __restrict__ a_log, bf16_t* __restrict__ Y, LAS unsigned char* lds) {
    const int g = h >> 3;
    const int tid = otid(), wid = tid >> 6, lane = tid & 63, fr = lane & 15, fq = lane >> 4;
    const float a = -__expf(a_log[d * 16 + h]);
    LAS float* cw = (LAS float*)(lds + CW_OFF + wid * 1536); LAS float* dts = cw + 128; LAS float* dtw = cw + 256;
    f32x4 hs[4];
#pragma unroll
    for (int q = 0; q < 4; ++q) hs[q] = (f32x4){0.f, 0.f, 0.f, 0.f};
    for (int i = tid; i < 17408 / 4; i += 512) ((LAS unsigned*)(lds + HB_OFF))[i] = 0u;
    float cend = 0.f;
#define SSD_ROWS(step, r0v, gidv) do { if ((step) < 2) { const int oc_ = d ? 1 - (step) : (step); r0v = NLAT + b * 256 + oc_ * 128; gidv = 256 + b * 2 + oc_; } \
        else { const int lc_ = (step) - 2, oc_ = d ? 63 - lc_ : lc_; r0v = b * 8192 + oc_ * 128; gidv = b * 64 + oc_; } } while (0)
    const int sg = tid & 31, n8 = tid >> 5, p4 = tid >> 5;
    f32x2 P_da, Q_da; u32x2 P_xv[4], Q_xv[4]; u32x4 P_bv[4], Q_bv[4], n_gv[4], n_cv[4], c_gv[4], c_cv[4];
#define SSD_LOAD(step, X) do { int r0_, gid_; SSD_ROWS(step, r0_, gid_); (void)gid_; X##_da = *(const f32x2*)(DT + (size_t)(d * 16 + h) * NROW + r0_ + 2 * lane); \
        _Pragma("unroll") for (int j_ = 0; j_ < 4; ++j_) { X##_xv[j_] = *(const u32x2*)(XS + (size_t)(r0_ + 4 * sg + j_) * 1024 + 64 * h + 4 * p4); \
                                                         X##_bv[j_] = *(const u32x4*)(BC + (size_t)(r0_ + 4 * sg + j_) * 512 + 128 * g + 8 * n8); } } while (0)
#define SSD_LOADGC(step) do { int r0_, gid_; SSD_ROWS(step, r0_, gid_); const int t_ = 16 * wid + fr; const bf16_t* Gp_ = G + ((size_t)(gid_ * 2 + g) * 128 + t_) * 128 + 8 * fq; const bf16_t* Cp_ = BC + (size_t)(r0_ + t_) * 512 + 256 + 128 * g + 8 * fq; \
          _Pragma("unroll") for (int ks_ = 0; ks_ < 4; ++ks_) { n_gv[ks_] = *(const u32x4*)(Gp_ + 32 * ks_); n_cv[ks_] = *(const u32x4*)(Cp_ + 32 * ks_); } } while (0)
#define SSD_GCROT() do { _Pragma("unroll") for (int ks_ = 0; ks_ < 4; ++ks_) { c_gv[ks_] = n_gv[ks_]; c_cv[ks_] = n_cv[ks_]; } } while (0)
#define SSD_WRITE(step, X) do { LAS unsigned char* set_ = lds + ((step) & 1) * SET; \
        const float da0 = X##_da.x * a, da1 = X##_da.y * a; \
        float sc_ = da0 + da1; float c0_, c1_; \
        if (d == 0) { _Pragma("unroll") for (int o_ = 1; o_ < 64; o_ <<= 1) { const float t_ = __shfl_up(sc_, o_); if (lane >= o_) sc_ += t_; } \
            c0_ = sc_ - da1; c1_ = sc_; cend = __shfl(sc_, 63); } \
        else { _Pragma("unroll") for (int o_ = 1; o_ < 64; o_ <<= 1) { const float t_ = __shfl_down(sc_, o_); if (lane + o_ < 64) sc_ += t_; } \
            c0_ = sc_; c1_ = sc_ - da0; cend = __shfl(sc_, 0); } \
        *(LAS f32x2*)(cw + 2 * lane) = (f32x2){c0_, c1_}; *(LAS f32x2*)(dts + 2 * lane) = X##_da; \
        *(LAS f32x2*)(dtw + 2 * lane) = (f32x2){X##_da.x * __builtin_amdgcn_exp2f((cend - c0_) * L2E), X##_da.y * __builtin_amdgcn_exp2f((cend - c1_) * L2E)}; \
        { LAS unsigned char* xt_ = set_ + XT_OFF + (4 * p4) * PITCH + 8 * sg; \
          _Pragma("unroll") for (int i_ = 0; i_ < 4; ++i_) { unsigned e_[4]; \
              _Pragma("unroll") for (int j_ = 0; j_ < 4; ++j_) { const unsigned w_ = (i_ & 2) ? X##_xv[j_].y : X##_xv[j_].x; e_[j_] = (i_ & 1) ? (w_ >> 16) : (w_ & 0xffffu); } \
              u32x2 o_; o_.x = e_[0] | (e_[1] << 16); o_.y = e_[2] | (e_[3] << 16); *(LAS u32x2*)(xt_ + i_ * PITCH) = o_; } } \
        { LAS unsigned char* bt_ = set_ + BT_OFF + (8 * n8) * PITCH + 8 * sg; \
          _Pragma("unroll") for (int i_ = 0; i_ < 8; ++i_) { unsigned e_[4]; \
              _Pragma("unroll") for (int j_ = 0; j_ < 4; ++j_) { const unsigned w_ = X##_bv[j_][i_ >> 1]; e_[j_] = (i_ & 1) ? (w_ >> 16) : (w_ & 0xffffu); } \
              u32x2 o_; o_.x = e_[0] | (e_[1] << 16); o_.y = e_[2] | (e_[3] << 16); *(LAS u32x2*)(bt_ + i_ * PITCH) = o_; } } \
        asm volatile("s_waitcnt lgkmcnt(0)" ::: "memory"); \
    } while (0)
    SSD_LOAD(0, Q); SSD_LOADGC(0); SSD_WRITE(0, Q); SSD_LOAD(1, P);
    for (int step2 = 0; step2 < 66; step2 += 2)
#pragma unroll
    for (int par = 0; par < 2; ++par) {
        const int step = step2 + par;
        __syncthreads();
        int r0, gid; SSD_ROWS(step, r0, gid); (void)gid;
        LAS unsigned char* set = lds + (step & 1) * SET;
        const float cend_cur = cend;
        SSD_GCROT();
        if (step + 1 < 66) SSD_LOADGC(step + 1);
        if (step + 2 < 66) { if (par == 0) SSD_LOAD(step + 2, Q); else SSD_LOAD(step + 2, P); }
        {
            const int t = 16 * wid + fr; const float ct = cw[t];
            f32x4 y[4];
#pragma unroll
            for (int q = 0; q < 4; ++q) y[q] = (f32x4){0.f, 0.f, 0.f, 0.f};
            const float et = __builtin_amdgcn_exp2f(ct * L2E);
#pragma unroll
            for (int ks = 0; ks < 4; ++ks) {
                const bool live = d == 0 ? (32 * ks <= 16 * wid + 15) : (32 * ks + 31 >= 16 * wid);
                if (live) {
                    const int s0 = 32 * ks + 8 * fq;
                    const f32x4 c0 = *(const LAS f32x4*)(cw + s0), c1 = *(const LAS f32x4*)(cw + s0 + 4), d0v = *(const LAS f32x4*)(dts + s0), d1v = *(const LAS f32x4*)(dts + s0 + 4);
                    float m[8];
#pragma unroll
                    for (int i = 0; i < 8; ++i) { const float cs = i < 4 ? c0[i & 3] : c1[i & 3], dv = i < 4 ? d0v[i & 3] : d1v[i & 3]; const int s = s0 + i;
                        const bool ok = d == 0 ? (s <= t) : (s >= t);
                        const float gval = (i & 1) ? bfhi(c_gv[ks][i >> 1]) : bflo(c_gv[ks][i >> 1]);
                        m[i] = ok ? gval * dv * __builtin_amdgcn_exp2f((ct - cs) * L2E) : 0.f; }
                    u32x4 mw; mw.x = cvt_pk_bf16(m[0], m[1]); mw.y = cvt_pk_bf16(m[2], m[3]); mw.z = cvt_pk_bf16(m[4], m[5]); mw.w = cvt_pk_bf16(m[6], m[7]);
                    const bf16x8 mb = __builtin_bit_cast(bf16x8, mw);
#pragma unroll
                    for (int q = 0; q < 4; ++q) { const bf16x8 af = *(const LAS bf16x8*)(set + XT_OFF + (16 * q + fr) * PITCH + (32 * ks + 8 * fq) * 2);
                        y[q] = __builtin_amdgcn_mfma_f32_16x16x32_bf16(af, mb, y[q], 0, 0, 0); }
                }
            }
#pragma unroll
            for (int ks = 0; ks < 4; ++ks) {
                u32x4 cwv;
#pragma unroll
                for (int i = 0; i < 4; ++i) cwv[i] = cvt_pk_bf16(bflo(c_cv[ks][i]) * et, bfhi(c_cv[ks][i]) * et);
                const bf16x8 cb = __builtin_bit_cast(bf16x8, cwv);
#pragma unroll
                for (int q = 0; q < 4; ++q) { const bf16x8 af = *(const LAS bf16x8*)(set + HB_OFF + (16 * q + fr) * PITCH + (32 * ks + 8 * fq) * 2);
                    y[q] = __builtin_amdgcn_mfma_f32_16x16x32_bf16(af, cb, y[q], 0, 0, 0); }
            }
            bf16_t* yp = Y + (size_t)(r0 + t) * 1024 + 64 * h + 4 * fq;
#pragma unroll
            for (int q = 0; q < 4; ++q) { u32x2 w; w.x = cvt_pk_bf16(y[q][0], y[q][1]); w.y = cvt_pk_bf16(y[q][2], y[q][3]); *(u32x2*)(yp + 16 * q) = w; }
        }
        {
            const float dec = __builtin_amdgcn_exp2f(cend_cur * L2E);
#pragma unroll
            for (int q = 0; q < 4; ++q) hs[q] = hs[q] * dec;
#pragma unroll
            for (int ks = 0; ks < 4; ++ks) {
                const int s0 = 32 * ks + 8 * fq;
                const u32x4 braw = *(const LAS u32x4*)(set + BT_OFF + (16 * wid + fr) * PITCH + s0 * 2);
                const f32x4 w0 = *(const LAS f32x4*)(dtw + s0), w1 = *(const LAS f32x4*)(dtw + s0 + 4);
                u32x4 bw; bw.x = cvt_pk_bf16(bflo(braw.x) * w0[0], bfhi(braw.x) * w0[1]); bw.y = cvt_pk_bf16(bflo(braw.y) * w0[2], bfhi(braw.y) * w0[3]);
                          bw.z = cvt_pk_bf16(bflo(braw.z) * w1[0], bfhi(braw.z) * w1[1]); bw.w = cvt_pk_bf16(bflo(braw.w) * w1[2], bfhi(braw.w) * w1[3]);
                const bf16x8 bfr = __builtin_bit_cast(bf16x8, bw);
#pragma unroll
                for (int q = 0; q < 4; ++q) { const bf16x8 af = *(const LAS bf16x8*)(set + XT_OFF + (16 * q + fr) * PITCH + s0 * 2);
                    hs[q] = __builtin_amdgcn_mfma_f32_16x16x32_bf16(af, bfr, hs[q], 0, 0, 0); }
            }
            LAS bf16_t* hb = (LAS bf16_t*)(lds + ((step + 1) & 1) * SET + HB_OFF) + 16 * wid + fr;
#pragma unroll
            for (int q = 0; q < 4; ++q)
#pragma unroll
                for (int i = 0; i < 4; ++i) hb[(16 * q + 4 * fq + i) * 136] = f2bf(hs[q][i]);
        }
        if (step + 1 < 66) { if (par == 0) SSD_WRITE(step + 1, P); else SSD_WRITE(step + 1, Q); }
    }
    __syncthreads();
#undef SSD_ROWS
#undef SSD_LOAD
#undef SSD_LOADGC
#undef SSD_GCROT
#undef SSD_WRITE
}
}

struct Args { const float* in[32]; float* out; unsigned char* ws; int ph_lo, ph_hi; };
constexpr int NTHR = 512;
constexpr int LDS_BASE = 256;
constexpr int LDS_PHASE = 151808;
constexpr int LDS_BYTES = LDS_BASE + LDS_PHASE;
static_assert(att8::LDS_BYTES <= LDS_PHASE && ssd::LDS_BYTES <= LDS_PHASE && pg8::STAGE_BYTES <= LDS_PHASE, "LDS");

__device__ __forceinline__ void tjob(int j, const Args& A, const float*& src, bf16_t*& dst, int& K, int& N, int& Npad, int& mode, const float*& ks) {
    unsigned char* W = A.ws + WS_W; mode = 0; ks = nullptr;
    if (j < 8) { const int i = j >> 2, w = j & 3; unsigned char* base = W + W_HYB + (size_t)i * WH_SZ;
        if (w == 0)      { src = A.in[I_HWIN] + (size_t)i * 1024 * HYB_IN; dst = (bf16_t*)(base + WH_IN); K = 1024; N = HYB_IN; Npad = HYB_INP; mode = 1; }
        else if (w == 1) { src = A.in[I_WQB] + (size_t)i * 384 * 1536; dst = (bf16_t*)(base + WH_QB); K = 384; N = 1536; Npad = 1536; mode = 2; ks = A.in[I_QNG] + i * 384; }
        else if (w == 2) { src = A.in[I_WKVB] + (size_t)i * 256 * 2048; dst = (bf16_t*)(base + WH_KVB); K = 256; N = 2048; Npad = 2048; ks = A.in[I_KVNG] + i * 256; }
        else             { src = A.in[I_HWOUT] + (size_t)i * 2048 * 1024; dst = (bf16_t*)(base + WH_OUT); K = 2048; N = 1024; Npad = 1024; }
    } else if (j < 12) { const int i = (j - 8) >> 1, w = (j - 8) & 1; unsigned char* base = W + W_GM + (size_t)i * WG_SZ;
        if (w == 0) { src = A.in[I_GWIN] + (size_t)i * 1024 * 4096; dst = (bf16_t*)(base + WG_IN); K = 1024; N = 4096; Npad = 4096; }
        else        { src = A.in[I_GWOUT] + (size_t)i * 2048 * 1024; dst = (bf16_t*)(base + WG_OUT); K = 2048; N = 1024; Npad = 1024; }
    } else { const int l = j - 12; src = A.in[I_PWQ] + (size_t)l * 1024 * 2048; dst = (bf16_t*)(W + W_PEER + (size_t)l * WP_SZ + WP_Q); K = 1024; N = 2048; Npad = 2048; }
}
__device__ __forceinline__ int colmap(int mode, int n, int N) {
    if (mode == 1) { if (n >= N) return -1; if (n < C_KR) return n; const int m = n - C_KR; return C_KR + (m >> 1) + 32 * (m & 1); }
    if (mode == 2) { if (n < 1024) return (n >> 7) * 192 + (n & 127); const int m = n - 1024, h = m >> 6, mm = m & 63; return h * 192 + 128 + (mm >> 1) + 32 * (mm & 1); }
    return n;
}
__device__ __forceinline__ void phase_prologue(const Args& A, LAS unsigned char* lds) {
    const int tid = otid();
    {
        LAS float* tile = (LAS float*)lds;
        const float* c_src = nullptr; bf16_t* c_dst = nullptr; const float* c_ks = nullptr; int c_K = 0, c_N = 0, c_mode = 0, c_nsub = 0, c_k0 = 0, c_n0 = 0;
        int j = 0, item = blockIdx.x; bool have = false;
#define TR_LOCATE() do { have = false; \
            while (j < 16) { int Npad_; tjob(j, A, c_src, c_dst, c_K, c_N, Npad_, c_mode, c_ks); \
                c_nsub = (c_K % 256 == 0) ? 4 : 2; const int tk_ = c_K / (64 * c_nsub), nt_ = tk_ * (Npad_ / 64); \
                if (item < nt_) { c_k0 = (item % tk_) * 64 * c_nsub; c_n0 = (item / tk_) * 64; have = true; break; } \
                item -= nt_; ++j; } } while (0)
        float v[4][8], scv[4];
#define TR_LOAD() do { const int k = tid >> 3, cg = tid & 7; \
            _Pragma("unroll") for (int t = 0; t < 4; ++t) if (t < c_nsub) { scv[t] = c_ks ? c_ks[c_k0 + 64 * t + k] : 1.f; \
                _Pragma("unroll") for (int jj = 0; jj < 8; ++jj) { const int oc = colmap(c_mode, c_n0 + 8 * cg + jj, c_N); v[t][jj] = oc >= 0 ? c_src[(size_t)(c_k0 + 64 * t + k) * c_N + oc] : 0.f; } } } while (0)
        TR_LOCATE();
        if (have) TR_LOAD();
        int buf = 0;
        while (have) {
            const int nsub = c_nsub, K = c_K, k0 = c_k0, n0 = c_n0; bf16_t* dst = c_dst;
            { const int k = tid >> 3, cg = tid & 7;
#pragma unroll
              for (int t = 0; t < 4; ++t) if (t < nsub) {
#pragma unroll
                  for (int jj = 0; jj < 8; ++jj) tile[buf * 16640 + t * 4160 + k * 65 + 8 * cg + jj] = v[t][jj] * scv[t]; } }
            item += gridDim.x; TR_LOCATE();
            if (have) TR_LOAD();
            __syncthreads();
            { const int n = tid >> 3, kg = tid & 7;
#pragma unroll
              for (int t = 0; t < 4; ++t) if (t < nsub) { float o[8];
#pragma unroll
                  for (int jj = 0; jj < 8; ++jj) o[jj] = tile[buf * 16640 + t * 4160 + (8 * kg + jj) * 65 + n];
                  u32x4 w; w.x = cvt_pk_bf16(o[0], o[1]); w.y = cvt_pk_bf16(o[2], o[3]); w.z = cvt_pk_bf16(o[4], o[5]); w.w = cvt_pk_bf16(o[6], o[7]);
                  *(u32x4*)(dst + (size_t)(n0 + n) * K + k0 + 64 * t + 8 * kg) = w; } }
            buf ^= 1;
        }
#undef TR_LOCATE
#undef TR_LOAD
    }
    {
        const int gthr = blockIdx.x * NTHR + tid, nthr = gridDim.x * NTHR;
        for (int p = gthr; p < 10 * 16384; p += nthr) {
            const int mat = p >> 14, off = (p & 16383) * 8; const float* src; bf16_t* dst;
            if (mat < 2)      { src = A.in[I_GWS] + (size_t)mat * 131072; dst = (bf16_t*)(A.ws + WS_W + W_GM + (size_t)mat * WG_SZ + WG_WS); }
            else if (mat < 6) { src = A.in[I_PK1] + (size_t)(mat - 2) * 131072; dst = (bf16_t*)(A.ws + WS_W + W_PEER + (size_t)(mat - 2) * WP_SZ + WP_K1); }
            else              { src = A.in[I_PK2] + (size_t)(mat - 6) * 131072; dst = (bf16_t*)(A.ws + WS_W + W_PEER + (size_t)(mat - 6) * WP_SZ + WP_K2); }
            const f32x4 a = *(const f32x4*)(src + off), b = *(const f32x4*)(src + off + 4);
            u32x4 w; w.x = cvt_pk_bf16(a[0], a[1]); w.y = cvt_pk_bf16(a[2], a[3]); w.z = cvt_pk_bf16(b[0], b[1]); w.w = cvt_pk_bf16(b[2], b[3]);
            *(u32x4*)(dst + off) = w;
        }
        float* rope = (float*)(A.ws + WS_ROPE);
        for (int p = gthr; p < SEQ * 32; p += nthr) { const int l = p >> 5, i = p & 31; const float pos = (float)(i < 16 ? (l >> 6) : (l & 63));
            const float inv = powf(10000.f, -(float)(i & 15) / 16.f), ang = pos * inv; rope[p] = cosf(ang); rope[SEQ * 32 + p] = sinf(ang); }
    }
    {
        LAS float* scond = (LAS float*)lds;
        LAS float* red = scond + 5 * 1024;
        __syncthreads();
        for (int i = tid; i < 5 * 1024; i += NTHR) { const int m = i >> 10, k = i & 1023; const float c = m < 4 ? A.in[I_C][m * 1024 + k] : A.in[I_CCTX][k]; scond[i] = silu_f(c); }
        __syncthreads();
        float* MOD = (float*)(A.ws + WS_MOD);
        for (int item = blockIdx.x; item < 4 * 48; item += gridDim.x) {
            const int layer = item / 48, j0 = (item % 48) * 128; const int c4 = tid & 31, ksl = tid >> 5;
            f32x4 acc[5];
#pragma unroll
            for (int m = 0; m < 5; ++m) acc[m] = (f32x4){0.f, 0.f, 0.f, 0.f};
            const float* wp = A.in[I_ADAW] + ((size_t)layer * 1024 + ksl * 64) * 6144 + j0 + 4 * c4;
#pragma unroll 1
            for (int k0 = 0; k0 < 64; k0 += 16) { f32x4 w[16];
#pragma unroll
                for (int k = 0; k < 16; ++k) w[k] = *(const f32x4*)(wp + (size_t)(k0 + k) * 6144);
#pragma unroll
                for (int k = 0; k < 16; ++k)
#pragma unroll
                    for (int m = 0; m < 5; ++m) acc[m] += w[k] * scond[m * 1024 + ksl * 64 + k0 + k]; }
#pragma unroll
            for (int m = 0; m < 5; ++m) *(LAS f32x4*)(red + (ksl * 5 + m) * 128 + 4 * c4) = acc[m];
            __syncthreads();
            for (int i = tid; i < 640; i += NTHR) { const int m = i >> 7, c = i & 127; float s = A.in[I_ADAB][layer * 6144 + j0 + c];
#pragma unroll
                for (int q = 0; q < 16; ++q) s += red[(q * 5 + m) * 128 + c];
                MOD[((size_t)layer * 5 + m) * 6144 + j0 + c] = s; }
            __syncthreads();
        }
    }
}

template <bool F32SRC>
__device__ __forceinline__ void phase_norm_mod(const float* xl, const float* xc, bf16_t* XB, const float* g, const float* modl, int sh_idx, bf16_t* H, int nrows) {
    const int tid_ = otid(); const int lane = tid_ & 63, gw = blockIdx.x * 8 + (tid_ >> 6), nw = gridDim.x * 8;
    f32x4 gv[4];
#pragma unroll
    for (int i = 0; i < 4; ++i) gv[i] = *(const f32x4*)(g + 256 * i + 4 * lane);
    for (int r = gw; r < nrows; r += nw) {
        const bool lat = r < NLAT;
        f32x4 x[4]; float ss = 0.f;
        if (F32SRC) { const float* xp = lat ? xl + (size_t)r * D : xc + (size_t)(r - NLAT) * D;
#pragma unroll
            for (int i = 0; i < 4; ++i) { x[i] = *(const f32x4*)(xp + 256 * i + 4 * lane);
                u32x2 w; w.x = cvt_pk_bf16(x[i][0], x[i][1]); w.y = cvt_pk_bf16(x[i][2], x[i][3]); *(u32x2*)(XB + (size_t)r * D + 256 * i + 4 * lane) = w;
 }
        } else {
#pragma unroll
            for (int i = 0; i < 4; ++i) { const u32x2 w = *(const u32x2*)(XB + (size_t)r * D + 256 * i + 4 * lane); x[i] = (f32x4){bflo(w.x), bfhi(w.x), bflo(w.y), bfhi(w.y)}; } }
#pragma unroll
        for (int i = 0; i < 4; ++i) ss += x[i][0] * x[i][0] + x[i][1] * x[i][1] + x[i][2] * x[i][2] + x[i][3] * x[i][3];
        ss = wave_sum(ss); const float rstd = rsqrtf(ss * (1.f / 1024.f) + EPS);
        const float* mp = modl + (size_t)(lat ? (r >> 13) : 4) * 6144 + sh_idx * 1024;
#pragma unroll
        for (int i = 0; i < 4; ++i) { const f32x4 sh = *(const f32x4*)(mp + 256 * i + 4 * lane), sc = *(const f32x4*)(mp + 1024 + 256 * i + 4 * lane);
            const f32x4 hv = (x[i] * rstd) * gv[i] * (sc + 1.f) + sh;
            u32x2 w; w.x = cvt_pk_bf16(hv[0], hv[1]); w.y = cvt_pk_bf16(hv[2], hv[3]);
            *(u32x2*)(H + (size_t)r * D + 256 * i + 4 * lane) = w; }
    }
}
__device__ __forceinline__ void phase_final_norm(const bf16_t* XB, float* out, const float* g, float oscale) {
    const int tid_ = otid(); const int lane = tid_ & 63, gw = blockIdx.x * 8 + (tid_ >> 6), nw = gridDim.x * 8;
    f32x4 gv[4];
#pragma unroll
    for (int i = 0; i < 4; ++i) gv[i] = *(const f32x4*)(g + 256 * i + 4 * lane);
    for (int r = gw; r < NLAT; r += nw) {
        f32x4 x[4]; float ss = 0.f;
#pragma unroll
        for (int i = 0; i < 4; ++i) { const u32x2 w = *(const u32x2*)(XB + (size_t)r * D + 256 * i + 4 * lane); x[i] = (f32x4){bflo(w.x), bfhi(w.x), bflo(w.y), bfhi(w.y)};
            ss += x[i][0] * x[i][0] + x[i][1] * x[i][1] + x[i][2] * x[i][2] + x[i][3] * x[i][3]; }
        ss = wave_sum(ss); const float rstd = rsqrtf(ss * (1.f / 1024.f) + EPS);
#pragma unroll
        for (int i = 0; i < 4; ++i) *(f32x4*)(out + (size_t)r * D + 256 * i + 4 * lane) = (x[i] * (rstd * oscale)) * gv[i];
    }
}

#ifndef MK_CVAR
#define MK_CVAR 0
#endif
__device__ __forceinline__ void phase_conv(const Args& A, int li, int rep = 0) {
    const int cvar = rep ? MK_CVAR : 0;
    const bf16_t* PROJ = (const bf16_t*)(A.ws + WS_BIG);
    bf16_t* XS = (bf16_t*)(A.ws + WS_R2); bf16_t* BC = (bf16_t*)(A.ws + WS_R2 + R2_BC);
    const int tid = otid();
    if (cvar != 2) {
        for (int item = blockIdx.x * 3; item < (NROW / 64) * 3; item += gridDim.x * 3)
#pragma unroll 1
        for (int sub = 0; sub < 3; ++sub) {
            const int blk = (item + sub) / 3, q = ((item + sub) % 3) * 512 + tid, cg = q % 192, rg = q / 192, c0 = 8 * cg;
            const int rbeg = blk * 64 + rg * 8; int s0, s1;
            if (rbeg < NLAT) { s0 = rbeg & ~8191; s1 = s0 + 8192; } else { s0 = NLAT + ((rbeg - NLAT) & ~255); s1 = s0 + 256; }
            const float* cw = A.in[I_CONVW] + ((size_t)li * 1536 + c0) * 5; const float* cb = A.in[I_CONVB] + (size_t)li * 1536 + c0;
            u32x4 in[12];
#pragma unroll
            for (int i = 0; i < 12; ++i) { const int r = rbeg - 2 + i; in[i] = (r >= s0 && r < s1) ? *(const u32x4*)(PROJ + (size_t)r * HYB_INP + C_XBC + c0) : (u32x4){0u, 0u, 0u, 0u}; }
            float w[8][5], bia[8];
#pragma unroll
            for (int j = 0; j < 8; ++j) { bia[j] = cb[j];
#pragma unroll
                for (int k = 0; k < 5; ++k) w[j][k] = cw[j * 5 + k]; }
#pragma unroll
            for (int rr = 0; rr < 8; ++rr) {
                float o[8];
#pragma unroll
                for (int j = 0; j < 8; ++j) { float sacc = bia[j];
#pragma unroll
                    for (int k = 0; k < 5; ++k) { const unsigned wd = in[rr + k][j >> 1]; sacc += w[j][k] * ((j & 1) ? bfhi(wd) : bflo(wd)); }
                    o[j] = silu_f(sacc); }
                u32x4 pk; pk.x = cvt_pk_bf16(o[0], o[1]); pk.y = cvt_pk_bf16(o[2], o[3]); pk.z = cvt_pk_bf16(o[4], o[5]); pk.w = cvt_pk_bf16(o[6], o[7]);
                const int r = rbeg + rr;
                if (c0 < 1024) *(u32x4*)(XS + (size_t)r * 1024 + c0) = pk; else *(u32x4*)(BC + (size_t)r * 512 + (c0 - 1024)) = pk;
            }
        }
    }
    if (cvar != 1) {
        const int lane = tid & 63, gw = blockIdx.x * 8 + (tid >> 6), nw = gridDim.x * 8;
        float* DT = (float*)(A.ws + WS_BIG + BIG_DT); float* RQ = (float*)(A.ws + WS_RSTD); float* RKV = RQ + NROW;
        unsigned char* KR = A.ws + WS_BIG + BIG_KR; const float* rope = (const float*)(A.ws + WS_ROPE);
        const float dtb = lane < 32 ? A.in[I_DTB][li * 32 + lane] : 0.f;
        for (int rb = gw * 4; rb < NROW; rb += nw * 4) {
            unsigned wq[4][3]; u32x2 wk[4]; unsigned wr_[4]; float dtv[4], rc[4], rsn[4];
#pragma unroll
            for (int i = 0; i < 4; ++i) { const int r = rb + i; const bf16_t* p = PROJ + (size_t)r * HYB_INP;
                const unsigned* q = (const unsigned*)(p + C_CQ + 6 * lane); wq[i][0] = q[0]; wq[i][1] = q[1]; wq[i][2] = q[2];
                wk[i] = *(const u32x2*)(p + C_CKV + 4 * lane);
                dtv[i] = lane < 32 ? bf2f(p[C_DT + (lane & 15)]) : 0.f; wr_[i] = lane < 32 ? *(const unsigned*)(p + C_KR + 2 * lane) : 0u;
                const int l = r & 8191; rc[i] = (lane < 32 && r < NLAT) ? rope[l * 32 + lane] : 1.f; rsn[i] = (lane < 32 && r < NLAT) ? rope[SEQ * 32 + l * 32 + lane] : 0.f; }
#pragma unroll
            for (int i = 0; i < 4; ++i) { const int r = rb + i;
                if (lane < 32) DT[(size_t)lane * NROW + r] = softplus_f(dtv[i] + dtb);
                { float ss = 0.f;
#pragma unroll
                  for (int j = 0; j < 3; ++j) { const float a = bflo(wq[i][j]), b = bfhi(wq[i][j]); ss += a * a + b * b; }
                  ss = wave_sum(ss); if (lane == 0) RQ[r] = rsqrtf(ss * (1.f / 384.f) + EPS); }
                { const float a = bflo(wk[i].x), b = bfhi(wk[i].x), c = bflo(wk[i].y), d = bfhi(wk[i].y);
                  float ss = a * a + b * b + c * c + d * d; ss = wave_sum(ss); if (lane == 0) RKV[r] = rsqrtf(ss * (1.f / 256.f) + EPS); }
                if (lane < 32) { const float x1 = bflo(wr_[i]), x2 = bfhi(wr_[i]); int b, key;
                    const float o1 = x1 * rc[i] - x2 * rsn[i], o2 = x1 * rsn[i] + x2 * rc[i];
                    if (r < NLAT) { b = r >> 13; key = 256 + (r & 8191); } else { b = (r - NLAT) >> 8; key = (r - NLAT) & 255; }
                    int w8 = 0; w8 = __builtin_amdgcn_cvt_pk_fp8_f32(sat8(o1), sat8(o2), w8, false);
                    *(unsigned short*)(KR + (size_t)(b * NKT + (key >> 6)) * 4096 + att8::kr8(key & 63, 2 * lane)) = (unsigned short)(w8 & 0xffff); }
            }
        }
    }
}

struct EpiQ {
    static constexpr bool PERM = true;
    unsigned char* Q; const float* rstd; const float* rope;
    __device__ __forceinline__ void operator()(const f32x4 (&acc)[2][2][4][2], const pg8::Unit& u, int wr, int wc, int fr, int fq) const {
        const bool lat = u.pm < 128;
        const int b = lat ? (u.pm >> 5) : (u.pm - 128), q0 = lat ? 256 + ((u.pm & 31) << 8) : 0;
        const bool isrope = u.pn >= 4;
#pragma unroll
        for (int ai = 0; ai < 2; ++ai) {
            const int rl = 128 * ai + 64 * wr + fr;
            const float* rsp = rstd + u.pm * 256 + rl;
            const float* rp = rope + (size_t)(((u.pm & 31) << 8) + rl) * 32;
#pragma unroll
            for (int bj = 0; bj < 2; ++bj) {
                const int c0 = u.pn * 256 + 128 * bj + 32 * wc + 8 * fq; int h, dcol;
                if (!isrope) { h = c0 >> 7; dcol = c0 & 127; } else { const int mq = c0 - 1024; h = mq >> 6; dcol = 128 + (mq & 63); }
                unsigned char* dst = Q + ((size_t)(b * 8 + h) * NKEY + q0 + rl) * 192 + dcol;
                const int ro = (dcol - 128) >> 1;
#pragma unroll
                for (int m = 0; m < 4; ++m) {
                    const float rs = rsp[16 * m] * (QSCALE * att8::QUP);
                    f32x4 v0 = acc[ai][bj][m][0] * rs, v1 = acc[ai][bj][m][1] * rs;
                    if (isrope && lat) { const f32x4 cs = *(const f32x4*)(rp + 16 * m * 32 + ro), sn = *(const f32x4*)(rp + SEQ * 32 + 16 * m * 32 + ro);
                        const f32x4 a0 = v0, a1 = v1;
                        v0[0] = a0[0] * cs[0] - a0[1] * sn[0]; v0[1] = a0[0] * sn[0] + a0[1] * cs[0]; v0[2] = a0[2] * cs[1] - a0[3] * sn[1]; v0[3] = a0[2] * sn[1] + a0[3] * cs[1];
                        v1[0] = a1[0] * cs[2] - a1[1] * sn[2]; v1[1] = a1[0] * sn[2] + a1[1] * cs[2]; v1[2] = a1[2] * cs[3] - a1[3] * sn[3]; v1[3] = a1[2] * sn[3] + a1[3] * cs[3]; }
                    u32x2 w; w.x = pk4_fp8_sat(v0[0], v0[1], v0[2], v0[3]); w.y = pk4_fp8_sat(v1[0], v1[1], v1[2], v1[3]);
                    *(u32x2*)(dst + 16 * m * 192) = w;
                    asm volatile("" ::: "memory");
                }
            }
        }
    }
};
struct EpiKV {
    static constexpr bool PERM = true;
    unsigned char* KN; unsigned char* V; const float* rstd;
    __device__ __forceinline__ void operator()(const f32x4 (&acc)[2][2][4][2], const pg8::Unit& u, int wr, int wc, int fr, int fq) const {
        const bool lat = u.pm < 128;
        const int b = lat ? (u.pm >> 5) : (u.pm - 128), t0 = lat ? 4 + ((u.pm & 31) << 2) : 0;
        const int dd = 32 * wc + 8 * fq;
        const int offK = fr * 128 + ((((dd >> 4) ^ ((fr >> 1) & 7))) << 4) + (dd & 15);
#pragma unroll
        for (int ai = 0; ai < 2; ++ai) {
            const size_t tb = ((size_t)(b * 8 + u.pn) * NKT + t0 + 2 * ai + wr) * 8192;
            const float* rsp = rstd + u.pm * 256 + 128 * ai + 64 * wr + fr;
            unsigned char* kp = KN + tb + offK; unsigned char* vp = V + tb;
#pragma unroll
            for (int m = 0; m < 4; ++m) {
                const float rs = rsp[16 * m];
                { const f32x4 v0 = acc[ai][0][m][0] * rs, v1 = acc[ai][0][m][1] * rs; u32x2 w; w.x = pk4_fp8_sat(v0[0], v0[1], v0[2], v0[3]); w.y = pk4_fp8_sat(v1[0], v1[1], v1[2], v1[3]);
                  *(u32x2*)(kp + m * 2048) = w; }
                { const f32x4 v0 = acc[ai][1][m][0] * rs, v1 = acc[ai][1][m][1] * rs; const unsigned w0 = pk4_fp8_sat(v0[0], v0[1], v0[2], v0[3]), w1 = pk4_fp8_sat(v1[0], v1[1], v1[2], v1[3]);
                  const int sl = att8::vslot(16 * m + fr);
#pragma unroll
                  for (int i = 0; i < 8; ++i) { const int d = dd + i; vp[d * 64 + ((((sl >> 4) ^ ((d >> 2) & 3))) << 4) + (sl & 15)] = (unsigned char)(((i < 4 ? w0 : w1) >> (8 * (i & 3))) & 0xffu); } }
                asm volatile("" ::: "memory");
            }
        }
    }
};

__device__ __forceinline__ void phase_ssd_out(const Args& A, int li, int nrows) {
    const bf16_t* PROJ = (const bf16_t*)(A.ws + WS_BIG); const bf16_t* XS = (const bf16_t*)(A.ws + WS_R2);
    const bf16_t* Y0 = (const bf16_t*)(A.ws + WS_H); const bf16_t* Y1 = (const bf16_t*)(A.ws + WS_R3); bf16_t* CAT = (bf16_t*)(A.ws + WS_R3 + R3_CAT);
    const int tid_ = otid(); const int lane = tid_ & 63, gw = blockIdx.x * 8 + (tid_ >> 6), nw = gridDim.x * 8;
    const float dsk = A.in[I_SSDD][li * 16 + (lane >> 2)];
    float ng[16];
#pragma unroll
    for (int j = 0; j < 16; ++j) ng[j] = A.in[I_SSDNG][li * 1024 + 16 * lane + j];
    for (int r = gw; r < nrows; r += nw) {
        float v[16]; float ss = 0.f;
#pragma unroll
        for (int hh = 0; hh < 2; ++hh) {
            const u32x4 a = *(const u32x4*)(Y0 + (size_t)r * 1024 + 16 * lane + 8 * hh), b = *(const u32x4*)(Y1 + (size_t)r * 1024 + 16 * lane + 8 * hh);
            const u32x4 x = *(const u32x4*)(XS + (size_t)r * 1024 + 16 * lane + 8 * hh), z = *(const u32x4*)(PROJ + (size_t)r * HYB_INP + 16 * lane + 8 * hh);
#pragma unroll
            for (int q = 0; q < 4; ++q) {
                const float y0 = (bflo(a[q]) + bflo(b[q]) + dsk * bflo(x[q])) * silu_f(bflo(z[q])), y1 = (bfhi(a[q]) + bfhi(b[q]) + dsk * bfhi(x[q])) * silu_f(bfhi(z[q]));
                v[8 * hh + 2 * q] = y0; v[8 * hh + 2 * q + 1] = y1; ss += y0 * y0 + y1 * y1; }
        }
#pragma unroll
        for (int o = 16; o >= 1; o >>= 1) ss += __shfl_xor(ss, o);
        const float rstd = rsqrtf(ss * (1.f / 512.f) + EPS);
#pragma unroll
        for (int hh = 0; hh < 2; ++hh) { u32x4 w;
#pragma unroll
            for (int q = 0; q < 4; ++q) w[q] = cvt_pk_bf16(v[8 * hh + 2 * q] * rstd * ng[8 * hh + 2 * q], v[8 * hh + 2 * q + 1] * rstd * ng[8 * hh + 2 * q + 1]);
            *(u32x4*)(CAT + (size_t)r * 2048 + 16 * lane + 8 * hh) = w; }
    }
}

__device__ __forceinline__ void phase_ln_stats(const Args& A, int nrows) {
    const bf16_t* Gb = (const bf16_t*)(A.ws + WS_BIG); float* ST = (float*)(A.ws + WS_RSTD);
    const int tid_ = otid(); const int lane = tid_ & 63, gw = blockIdx.x * 8 + (tid_ >> 6), nw = gridDim.x * 8;
    for (int r = gw; r < nrows; r += nw) {
        float v[32]; float s = 0.f;
#pragma unroll
        for (int j = 0; j < 4; ++j) { const u32x4 w = *(const u32x4*)(Gb + (size_t)r * 4096 + 2048 + 512 * j + 8 * lane);
#pragma unroll
            for (int q = 0; q < 4; ++q) { v[8 * j + 2 * q] = bflo(w[q]); v[8 * j + 2 * q + 1] = bfhi(w[q]); s += v[8 * j + 2 * q] + v[8 * j + 2 * q + 1]; } }
        s = wave_sum(s); const float mu = s * (1.f / 2048.f); float q2 = 0.f;
#pragma unroll
        for (int j = 0; j < 32; ++j) { const float dd = v[j] - mu; q2 += dd * dd; }
        q2 = wave_sum(q2);
        if (lane == 0) { ST[r] = mu; ST[NROW + r] = rsqrtf(q2 * (1.f / 2048.f) + EPS); }
    }
}
__device__ __forceinline__ float half_sum32(float v) {
    v += __builtin_bit_cast(float, __builtin_amdgcn_mov_dpp(__builtin_bit_cast(int, v), 0xB1, 0xF, 0xF, true));
    v += __builtin_bit_cast(float, __builtin_amdgcn_mov_dpp(__builtin_bit_cast(int, v), 0x4E, 0xF, 0xF, true));
    v += __builtin_bit_cast(float, __builtin_amdgcn_mov_dpp(__builtin_bit_cast(int, v), 0x141, 0xF, 0xF, true));
    v += __builtin_bit_cast(float, __builtin_amdgcn_mov_dpp(__builtin_bit_cast(int, v), 0x140, 0xF, 0xF, true));
    auto r = __builtin_amdgcn_permlane16_swap(__float_as_uint(v), __float_as_uint(v), false, false);
    return __uint_as_float(r[0]) + __uint_as_float(r[1]);
}
__device__ __forceinline__ void phase_spatial(const Args& A, int gi, int nrows, LAS unsigned char* lds) {
    const bf16_t* Gb = (const bf16_t*)(A.ws + WS_BIG); const f32x2* PARTS = (const f32x2*)(A.ws + WS_R3); bf16_t* Ab = (bf16_t*)(A.ws + WS_R1);
    const bf16_t* WSg = (const bf16_t*)(A.ws + WS_W + W_GM + (size_t)gi * WG_SZ + WG_WS);
    const float* lng = A.in[I_GLNG] + (size_t)gi * 2048; const float* lnb = A.in[I_GLNB] + (size_t)gi * 2048; const float* bs = A.in[I_GBS] + (size_t)gi * 1024;
    const int tid = otid(), wid = tid >> 6, lane = tid & 63, r32 = lane & 31, hi = lane >> 5, tb = wid & 3, dh = wid >> 2;
    const int ldsaddr = (int)(unsigned)(uintptr_t)lds;
    u32x4 nv[8]; f32x2 nps[8];
    const int nunits = (nrows / 128) * 8;
#define SP_LOADV(un) do { const int cb_ = (un) >> 3, gg_ = (un) & 7, r0_ = cb_ * 128; \
        _Pragma("unroll") for (int j = 0; j < 8; ++j) { const int idx = tid + 512 * j, s_ = idx >> 5, dd_ = (idx & 31) * 8; \
            nv[j] = *(const u32x4*)(Gb + (size_t)(r0_ + s_) * 4096 + 2048 + 256 * gg_ + dd_); nps[j] = PARTS[(size_t)(r0_ + s_) * 32 + (idx & 31)]; } } while (0)
    if ((int)blockIdx.x < nunits) SP_LOADV((int)blockIdx.x);
    for (int unit = blockIdx.x; unit < nunits; unit += gridDim.x) {
        const int cb = unit >> 3, gg = unit & 7, r0 = cb * 128;
        __syncthreads();
#pragma unroll
        for (int j = 0; j < 8; ++j) { const int idx = tid + 512 * j, s = idx >> 5, dd = (idx & 31) * 8;
            const u32x4 w = nv[j];
            const float mu = half_sum32(nps[j].x) * (1.f / 2048.f), rs = rsqrtf(fmaxf(half_sum32(nps[j].y) * (1.f / 2048.f) - mu * mu, 0.f) + EPS);
            const f32x4 g0 = *(const f32x4*)(lng + 256 * gg + dd), g1 = *(const f32x4*)(lng + 256 * gg + dd + 4), b0 = *(const f32x4*)(lnb + 256 * gg + dd), b1 = *(const f32x4*)(lnb + 256 * gg + dd + 4);
            u32x4 o;
            o.x = cvt_pk_bf16((bflo(w.x) - mu) * rs * g0[0] + b0[0], (bfhi(w.x) - mu) * rs * g0[1] + b0[1]); o.y = cvt_pk_bf16((bflo(w.y) - mu) * rs * g0[2] + b0[2], (bfhi(w.y) - mu) * rs * g0[3] + b0[3]);
            o.z = cvt_pk_bf16((bflo(w.z) - mu) * rs * g1[0] + b1[0], (bfhi(w.z) - mu) * rs * g1[1] + b1[1]); o.w = cvt_pk_bf16((bflo(w.w) - mu) * rs * g1[2] + b1[2], (bfhi(w.w) - mu) * rs * g1[3] + b1[3]);
            *(LAS u32x4*)(lds + ((s >> 6) * 2 + (dd >> 7)) * 16384 + att::v_st(s & 63, dd & 127)) = o; }
        u32x2 uu[4][4];
        { const bf16_t* up = Gb + (size_t)(r0 + 32 * tb + r32) * 4096 + 256 * gg + 128 * dh + 4 * hi;
#pragma unroll
          for (int d0 = 0; d0 < 4; ++d0)
#pragma unroll
              for (int k = 0; k < 4; ++k) uu[d0][k] = *(const u32x2*)(up + 32 * d0 + 8 * k); }
        if (unit + (int)gridDim.x < nunits) SP_LOADV(unit + (int)gridDim.x);
        bf16x8 pa[8];
#pragma unroll
        for (int ks = 0; ks < 8; ++ks) pa[ks] = *(const bf16x8*)(WSg + ((size_t)gg * 128 + 32 * tb + r32) * 128 + 16 * ks + 8 * hi);
        __syncthreads();
        f32x16 o[4] = {};
#define SP_PV(D0, vbase, p0, p1, p2, p3) do { \
            const s16x4 l0 = att::tr_read<att::v_rd_off(D0, 0, 0)>(vbase), h0 = att::tr_read<att::v_rd_off(D0, 0, 1)>(vbase), l1 = att::tr_read<att::v_rd_off(D0, 1, 0)>(vbase), h1 = att::tr_read<att::v_rd_off(D0, 1, 1)>(vbase); \
            const s16x4 l2 = att::tr_read<att::v_rd_off(D0, 2, 0)>(vbase), h2 = att::tr_read<att::v_rd_off(D0, 2, 1)>(vbase), l3 = att::tr_read<att::v_rd_off(D0, 3, 0)>(vbase), h3 = att::tr_read<att::v_rd_off(D0, 3, 1)>(vbase); \
            asm volatile("s_waitcnt lgkmcnt(0)" ::: "memory"); __builtin_amdgcn_sched_barrier(0); \
            o[D0] = __builtin_amdgcn_mfma_f32_32x32x16_bf16((bf16x8){l0[0], l0[1], l0[2], l0[3], h0[0], h0[1], h0[2], h0[3]}, p0, o[D0], 0, 0, 0); \
            o[D0] = __builtin_amdgcn_mfma_f32_32x32x16_bf16((bf16x8){l1[0], l1[1], l1[2], l1[3], h1[0], h1[1], h1[2], h1[3]}, p1, o[D0], 0, 0, 0); \
            o[D0] = __builtin_amdgcn_mfma_f32_32x32x16_bf16((bf16x8){l2[0], l2[1], l2[2], l2[3], h2[0], h2[1], h2[2], h2[3]}, p2, o[D0], 0, 0, 0); \
            o[D0] = __builtin_amdgcn_mfma_f32_32x32x16_bf16((bf16x8){l3[0], l3[1], l3[2], l3[3], h3[0], h3[1], h3[2], h3[3]}, p3, o[D0], 0, 0, 0); } while (0)
        { const int vb0 = ldsaddr + (0 * 2 + dh) * 16384 + att::v_rd_base(lane), vb1 = ldsaddr + (1 * 2 + dh) * 16384 + att::v_rd_base(lane);
          SP_PV(0, vb0, pa[0], pa[1], pa[2], pa[3]); SP_PV(1, vb0, pa[0], pa[1], pa[2], pa[3]); SP_PV(2, vb0, pa[0], pa[1], pa[2], pa[3]); SP_PV(3, vb0, pa[0], pa[1], pa[2], pa[3]);
          SP_PV(0, vb1, pa[4], pa[5], pa[6], pa[7]); SP_PV(1, vb1, pa[4], pa[5], pa[6], pa[7]); SP_PV(2, vb1, pa[4], pa[5], pa[6], pa[7]); SP_PV(3, vb1, pa[4], pa[5], pa[6], pa[7]); }
#undef SP_PV
        { const int t = 32 * tb + r32, row = r0 + t; const float bsv = bs[gg * 128 + t];
          bf16_t* ap = Ab + (size_t)row * 2048 + 256 * gg + 128 * dh + 4 * hi;
#pragma unroll
          for (int d0 = 0; d0 < 4; ++d0)
#pragma unroll
              for (int k = 0; k < 4; ++k) {
                  const u32x2 u2 = uu[d0][k];
                  u32x2 w; w.x = cvt_pk_bf16(bflo(u2.x) * (o[d0][4 * k] + bsv), bfhi(u2.x) * (o[d0][4 * k + 1] + bsv)); w.y = cvt_pk_bf16(bflo(u2.y) * (o[d0][4 * k + 2] + bsv), bfhi(u2.y) * (o[d0][4 * k + 3] + bsv));
                  *(u32x2*)(ap + 32 * d0 + 8 * k) = w; } }
    }
#undef SP_LOADV
}

constexpr int NSL = 8, SW = 1024 / NSL;
constexpr size_t TAB8_HALF = (size_t)NEXP * 1024, TAB_SCL = 2 * TAB8_HALF, TAB_SET = al256(TAB_SCL + (size_t)2 * NEXP * 4);
static_assert(2 * TAB_SET <= TAB_REGION, "table sets");
__device__ __forceinline__ size_t tabset(int layer) { return WS_TAB + (size_t)(layer & 1) * TAB_SET; }
constexpr float HS = 4.f;
__device__ __forceinline__ void phase_tabcvt(const Args& A, int layer, int wg, int nwg, int r_lo = 0, int r_hi = 2 * NEXP) {
    const int tid_ = otid(); const int lane = tid_ & 63, gw = wg * 8 + (tid_ >> 6), nw = nwg * 8;
    unsigned char* TS = A.ws + tabset(layer); float* SCL = (float*)(TS + TAB_SCL);
    for (int r = r_lo + gw; r < r_hi; r += nw) {
        const int tab = r >> 14, e = r & (NEXP - 1);
        const float* src = (tab ? A.in[I_PV] : A.in[I_PU]) + ((size_t)layer * NEXP + e) * 1024 + 16 * lane;
        f32x4 v[4]; float am = 0.f;
#pragma unroll
        for (int i = 0; i < 4; ++i) { v[i] = *(const f32x4*)(src + 4 * i); am = fmaxf(am, fmaxf(fmaxf(fabsf(v[i][0]), fabsf(v[i][1])), fmaxf(fabsf(v[i][2]), fabsf(v[i][3])))); }
#pragma unroll
        for (int o = 32; o >= 1; o >>= 1) am = fmaxf(am, __shfl_xor(am, o));
        float sc = 1.f; if (am > 0.f) { int ex; (void)frexpf(448.f / am, &ex); sc = ldexpf(1.f, ex - 1); }
        if (lane == 0) SCL[tab * NEXP + e] = 1.f / sc;
        u32x4 w;
#pragma unroll
        for (int i = 0; i < 4; ++i) w[i] = pk4_fp8(v[i][0] * sc, v[i][1] * sc, v[i][2] * sc, v[i][3] * sc);
        *(u32x4*)(TS + (size_t)tab * TAB8_HALF + ((size_t)(lane >> 3) * NEXP + e) * SW + 16 * (lane & 7)) = w;
    }
}
#define CASD(a, b) do { const float hi_ = fmaxf(a, b), lo_ = fminf(a, b); a = hi_; b = lo_; } while (0)
__device__ __forceinline__ void sort16(float (&k)[16]) {
#pragma unroll
    for (int sz = 2; sz <= 16; sz <<= 1)
#pragma unroll
        for (int j = sz >> 1; j > 0; j >>= 1)
#pragma unroll
            for (int i = 0; i < 16; ++i) { const int l = i ^ j; if (l > i) { if ((i & sz) == 0 || sz == 16) CASD(k[i], k[l]); else CASD(k[l], k[i]); } }
}
__device__ __forceinline__ void bmerge16(float (&k)[16]) {
#pragma unroll
    for (int j = 8; j > 0; j >>= 1)
#pragma unroll
        for (int i = 0; i < 16; ++i) { const int l = i ^ j; if (l > i) CASD(k[i], k[l]); }
}
__device__ __forceinline__ void merge_top16(float (&a)[16], const float (&b)[16]) {
#pragma unroll
    for (int i = 0; i < 16; ++i) a[i] = fmaxf(a[i], b[15 - i]);
    bmerge16(a);
}
__device__ __forceinline__ void xmerge_top16(float (&a)[16], int mask) {
    float t[16];
#pragma unroll
    for (int i = 0; i < 16; ++i) t[i] = __shfl_xor(a[15 - i], mask);
#pragma unroll
    for (int i = 0; i < 16; ++i) a[i] = fmaxf(a[i], t[i]);
    bmerge16(a);
}
__device__ __forceinline__ void phase_topk(const Args& A, int layer, int nrows, LAS unsigned char* lds) {
    const bf16_t* QP = (const bf16_t*)(A.ws + WS_BIG); int* IDX = (int*)(A.ws + WS_R2); float* GATE = (float*)(A.ws + WS_R2 + R2_GATE);
    const int tid = otid(), wid = tid >> 6, lane = tid & 63, fr = lane & 15, fq = lane >> 4;
    LAS unsigned* scr = (LAS unsigned*)(lds + 2 * 34816) + wid * 512 + fr * 32;
    int h_staged = -1;
    for (int unit = blockIdx.x; unit < (nrows / 128) * 8; unit += gridDim.x) {
        const int h = unit & 7, r0 = (unit >> 3) * 128;
        if (h != h_staged) { h_staged = h;
        __syncthreads();
        { const bf16_t* k1 = (const bf16_t*)(A.ws + WS_W + W_PEER + (size_t)layer * WP_SZ + WP_K1) + (size_t)h * 16384;
#pragma unroll
          for (int j = 0; j < 8; ++j) { const int idx = tid + 512 * j, half = idx >> 11, rem = idx & 2047, key = rem >> 4, c8 = rem & 15;
              const u32x4 w = *(const u32x4*)(k1 + (size_t)half * 8 * 16384 + key * 128 + 8 * c8);
              *(LAS u32x4*)(lds + half * 34816 + key * 272 + c8 * 16) = w; } }
        __syncthreads(); }
        const int tok = r0 + 16 * wid + fr;
        float top[2][16];
#pragma unroll
        for (int half = 0; half < 2; ++half) {
            bf16x8 qf[4];
#pragma unroll
            for (int ks = 0; ks < 4; ++ks) qf[ks] = *(const bf16x8*)(QP + (size_t)tok * 2048 + 256 * h + 128 * half + 32 * ks + 8 * fq);
            float loc[16];
#pragma unroll
            for (int grp = 0; grp < 2; ++grp) {
                float kk[16];
#pragma unroll
                for (int nbb = 0; nbb < 4; ++nbb) { const int nb = 4 * grp + nbb; f32x4 acc = {0.f, 0.f, 0.f, 0.f};
#pragma unroll
                    for (int ks = 0; ks < 4; ++ks) { const bf16x8 kf = *(const LAS bf16x8*)(lds + half * 34816 + (16 * nb + fr) * 272 + (32 * ks + 8 * fq) * 2);
                        acc = __builtin_amdgcn_mfma_f32_16x16x32_bf16(kf, qf[ks], acc, 0, 0, 0); }
#pragma unroll
                    for (int i = 0; i < 4; ++i) { const unsigned code = 127u - (unsigned)(16 * nb + 4 * fq + i); kk[4 * nbb + i] = __uint_as_float((__float_as_uint(acc[i]) & ~127u) | code); } }
                sort16(kk);
                if (grp == 0) {
#pragma unroll
                    for (int i = 0; i < 16; ++i) loc[i] = kk[i];
                } else merge_top16(loc, kk);
            }
            xmerge_top16(loc, 16); xmerge_top16(loc, 32);
#pragma unroll
            for (int i = 0; i < 16; ++i) top[half][i] = loc[i];
        }
        if (fq < 2) {
#pragma unroll
            for (int i = 0; i < 16; ++i) scr[16 * fq + i] = __float_as_uint(fq == 0 ? top[0][i] : top[1][i]); }
        float fin[16];
#pragma unroll
        for (int aa = 0; aa < 4; ++aa) {
            const float va_k = fq == 0 ? top[0][aa] : fq == 1 ? top[0][4 + aa] : fq == 2 ? top[0][8 + aa] : top[0][12 + aa];
            const float va = __uint_as_float(__float_as_uint(va_k) & ~127u);
            float c[16];
#pragma unroll
            for (int bb = 0; bb < 16; ++bb) { const float s = va + __uint_as_float(__float_as_uint(top[1][bb]) & ~127u);
                c[bb] = __uint_as_float((__float_as_uint(s) & ~255u) | (255u - (unsigned)((4 * fq + aa) * 16 + bb))); }
            if (aa == 0) {
#pragma unroll
                for (int i = 0; i < 16; ++i) fin[i] = c[i];
            } else merge_top16(fin, c);
        }
        xmerge_top16(fin, 16); xmerge_top16(fin, 32);
        float ev[16], es = 0.f; const float mx = __uint_as_float(__float_as_uint(fin[0]) & ~255u);
#pragma unroll
        for (int i = 0; i < 16; ++i) { ev[i] = __expf(__uint_as_float(__float_as_uint(fin[i]) & ~255u) - mx); es += ev[i]; }
        const float inv = 1.f / es;
        asm volatile("s_waitcnt lgkmcnt(0)" ::: "memory");
        int oi[4]; float og[4];
#pragma unroll
        for (int kq = 0; kq < 4; ++kq) {
            const float fk = fq == 0 ? fin[kq] : fq == 1 ? fin[4 + kq] : fq == 2 ? fin[8 + kq] : fin[12 + kq];
            const float fe = fq == 0 ? ev[kq] : fq == 1 ? ev[4 + kq] : fq == 2 ? ev[8 + kq] : ev[12 + kq];
            const unsigned code = 255u - (__float_as_uint(fk) & 255u), a = code >> 4, bq = code & 15u;
            const unsigned i1 = 127u - (scr[a] & 127u), i2 = 127u - (scr[16 + bq] & 127u);
            oi[kq] = (int)(i1 * 128u + i2); og[kq] = fe * inv; }
        *(int4*)(IDX + (size_t)tok * 128 + 16 * h + 4 * fq) = make_int4(oi[0], oi[1], oi[2], oi[3]);
        *(f32x4*)(GATE + (size_t)tok * 128 + 16 * h + 4 * fq) = (f32x4){og[0], og[1], og[2], og[3]};
    }
}
struct PeerSched {
    int x0, rank, nloc, nblk, nown; unsigned orphan;
    __device__ __forceinline__ void init(const Args& A, int nrows, LAS unsigned char* smem) {
        unsigned* ctl = (unsigned*)(A.ws + WS_CTL);
        x0 = (int)(xb_xcc_id() & 7u); rank = __builtin_amdgcn_readfirstlane((int)((LAS unsigned*)smem)[8]); nblk = nrows / 64;
        unsigned cached = __builtin_amdgcn_readfirstlane(((LAS unsigned*)smem)[9]);
        if (cached == 0u) { unsigned orph = 0u, nl = 1u;
            for (int j = 0; j < 8; ++j) { unsigned c = xb_ld(&ctl[XB_XCNT(j)]) + xb_ld(&ctl[XB_XCNT(j + 8)]); c = __builtin_amdgcn_readfirstlane(c); if (c == 0u) orph |= 1u << j; if (j == x0) nl = c; }
            cached = (nl << 8) | orph; __syncthreads(); if (threadIdx.x == 0) ((LAS unsigned*)smem)[9] = cached; __syncthreads(); }
        nloc = (int)(cached >> 8); orphan = cached & 0xffu;
        const int tot = (NSL / 8) * nblk; nown = rank < tot ? (tot - rank + nloc - 1) / nloc : 0;
    }
    __device__ __forceinline__ bool item(int j, int& sl, int& blk) const {
        if (j < nown) { const int i = rank + j * nloc; sl = x0 + 8 * (i / nblk); blk = i % nblk; return true; }
        int jj = j - nown; const int tot = (NSL / 8) * nblk, per = ((int)gridDim.x > tot) ? 1 : 0; (void)per;
        for (int o = 0; o < 8; ++o) if ((orphan >> o) & 1u) { const int cnt = ((int)blockIdx.x < tot) ? (tot - (int)blockIdx.x + (int)gridDim.x - 1) / (int)gridDim.x : 0;
            if (jj < cnt) { const int i = (int)blockIdx.x + jj * (int)gridDim.x; sl = o + 8 * (i / nblk); blk = i % nblk; return true; } jj -= cnt; }
        return false;
    }
};
template <class LD, class PR>
__device__ __forceinline__ void peer_items(const PeerSched& S, LD ld, PR pr) {
    int sl, blk, sln, blkn, j = 0, buf = 0; bool have = S.item(0, sl, blk);
    __syncthreads();
    if (have) ld(sl, blk, 0);
    while (have) {
        const bool haven = S.item(j + 1, sln, blkn);
        asm volatile("s_waitcnt vmcnt(0)" ::: "memory");
        if (haven) ld(sln, blkn, buf ^ 1);
        pr(sl, blk, buf);
        sl = sln; blk = blkn; have = haven; buf ^= 1; ++j;
    }
    __syncthreads();
}
#ifndef MK_UVAR
#define MK_UVAR 0
#endif
__device__ __forceinline__ float dpp_sum8(float v) {
    v += __builtin_bit_cast(float, __builtin_amdgcn_mov_dpp(__builtin_bit_cast(int, v), 0xB1, 0xF, 0xF, true));
    v += __builtin_bit_cast(float, __builtin_amdgcn_mov_dpp(__builtin_bit_cast(int, v), 0x4E, 0xF, 0xF, true));
    v += __builtin_bit_cast(float, __builtin_amdgcn_mov_dpp(__builtin_bit_cast(int, v), 0x141, 0xF, 0xF, true));
    return v;
}
__device__ __forceinline__ void phase_peer_u(const Args& A, int layer, int nrows, LAS unsigned char* smem, int rep) {
    const int var = rep ? MK_UVAR : 0;
    const bf16_t* H = (const bf16_t*)(A.ws + WS_H); const int* IDX = (const int*)(A.ws + WS_R2); bf16_t* PART = var ? (bf16_t*)(A.ws + WS_R1) : (bf16_t*)(A.ws + WS_BIG + BIG_PART);
    const unsigned char* U = A.ws + tabset(layer);
    constexpr int PP = 1088, WB = 4 * PP + 2048;
    const int tid = otid(), wid = tid >> 6, lane = tid & 63, m = lane & 7, tk = lane >> 3;
    const int wu = __builtin_amdgcn_readfirstlane(wid);
    LAS unsigned char* lds = smem + LDS_BASE + wu * (2 * WB);
    LAS float* rowc = (LAS float*)(smem + LDS_BASE + 8 * (2 * WB) + wu * 4096) + tk * 128;
    static_assert(8 * (2 * WB) + 8 * 4096 <= LDS_PHASE, "u-phase LDS");
    PeerSched S; S.init(A, nrows, smem);
    peer_items(S,
        [&](int sl, int blk, int buf) {
#pragma unroll
            for (int i = 0; i < 4; ++i)
                __builtin_amdgcn_global_load_lds((const unsigned*)(IDX + ((size_t)blk * 64 + 8 * wu + 2 * i) * 128 + 4 * lane), (LAS unsigned*)(lds + buf * WB + PP * i), 16, 0, 0);
#pragma unroll
            for (int i = 0; i < 2; ++i)
                __builtin_amdgcn_global_load_lds((const unsigned*)(H + (size_t)(blk * 64 + 8 * wu + 4 * i + (lane >> 4)) * 1024 + SW * sl + 8 * (lane & 15)), (LAS unsigned*)(lds + buf * WB + 4 * PP + 1024 * i), 16, 0, 0); },
        [&](int sl, int blk, int buf) {
            const unsigned char* ub = U + (size_t)sl * NEXP * SW + 16 * m;
            const int tok = blk * 64 + wid * 8 + tk;
            const int sw = (tk & 1) * 4;
            const LAS int* ib = (const LAS int*)(lds + buf * WB + (tk >> 1) * PP + (tk & 1) * 512);
            float hf[16];
            { const u32x4 h0 = *(const LAS u32x4*)(lds + buf * WB + 4 * PP + tk * 256 + 32 * m), h1 = *(const LAS u32x4*)(lds + buf * WB + 4 * PP + tk * 256 + 32 * m + 16);
#pragma unroll
              for (int j = 0; j < 4; ++j) { hf[2 * j] = bflo(h0[j]); hf[2 * j + 1] = bfhi(h0[j]); hf[8 + 2 * j] = bflo(h1[j]); hf[8 + 2 * j + 1] = bfhi(h1[j]); } }
            const bool up4 = m >= 4, up2 = (m & 2) != 0, up1 = (m & 1) != 0;
            LAS float* pp = rowc + (m ^ sw);
            u32x4 vv[2][8];
#define PU_ROWS(T, c) do { const i32x4 e0_ = *(const LAS i32x4*)(ib + 8 * (c) + sw), e1_ = *(const LAS i32x4*)(ib + 8 * (c) + (4 - sw)); \
                if (var == 4) { _Pragma("unroll") for (int k_ = 0; k_ < 8; ++k_) vv[T][k_] = (u32x4){(unsigned)e0_.x, (unsigned)e1_.y, 0u, 0u}; } else { \
                vv[T][0] = *(const u32x4*)(ub + (size_t)(var == 3 ? e0_.x & 63 : e0_.x) * SW); vv[T][1] = *(const u32x4*)(ub + (size_t)(var == 3 ? e0_.y & 63 : e0_.y) * SW); \
                vv[T][2] = *(const u32x4*)(ub + (size_t)(var == 3 ? e0_.z & 63 : e0_.z) * SW); vv[T][3] = *(const u32x4*)(ub + (size_t)(var == 3 ? e0_.w & 63 : e0_.w) * SW); \
                vv[T][4] = *(const u32x4*)(ub + (size_t)(var == 3 ? e1_.x & 63 : e1_.x) * SW); vv[T][5] = *(const u32x4*)(ub + (size_t)(var == 3 ? e1_.y & 63 : e1_.y) * SW); \
                vv[T][6] = *(const u32x4*)(ub + (size_t)(var == 3 ? e1_.z & 63 : e1_.z) * SW); vv[T][7] = *(const u32x4*)(ub + (size_t)(var == 3 ? e1_.w & 63 : e1_.w) * SW); } } while (0)
#define PU_DOT(T, c) do { float s_[8]; \
                _Pragma("unroll") for (int k = 0; k < 8; ++k) { f32x2 a2 = {0.f, 0.f}; \
                    _Pragma("unroll") for (int j = 0; j < 4; ++j) { const int w = (int)vv[T][k][j]; \
                        const f32x2 lo = __builtin_amdgcn_cvt_pk_f32_fp8(w, false), hi = __builtin_amdgcn_cvt_pk_f32_fp8(w, true); \
                        a2 = __builtin_elementwise_fma(lo, (f32x2){hf[4 * j], hf[4 * j + 1]}, a2); a2 = __builtin_elementwise_fma(hi, (f32x2){hf[4 * j + 2], hf[4 * j + 3]}, a2); } \
                    s_[k] = a2.x + a2.y; } \
                  \
                float t_[4], u_[2]; \
                _Pragma("unroll") for (int j = 0; j < 4; ++j) { const float give = up4 ? s_[j] : s_[4 + j], keep = up4 ? s_[4 + j] : s_[j]; \
                    t_[j] = keep + __builtin_bit_cast(float, __builtin_amdgcn_mov_dpp(__builtin_bit_cast(int, give), 0x141, 0xF, 0xF, true)); }        \
                _Pragma("unroll") for (int j = 0; j < 2; ++j) { const float give = up2 ? t_[j] : t_[2 + j], keep = up2 ? t_[2 + j] : t_[j]; \
                    u_[j] = keep + __builtin_bit_cast(float, __builtin_amdgcn_mov_dpp(__builtin_bit_cast(int, give), 0x4E, 0xF, 0xF, true)); }         \
                { const float give = up1 ? u_[0] : u_[1], keep = up1 ? u_[1] : u_[0]; \
                  const float tot_ = keep + __builtin_bit_cast(float, __builtin_amdgcn_mov_dpp(__builtin_bit_cast(int, give), 0xB1, 0xF, 0xF, true));           \
                  pp[8 * (c)] = tot_; } } while (0)
            PU_ROWS(0, 0);
#pragma unroll 1
            for (int c = 0; c < 16; c += 2) {
                PU_ROWS(1, c + 1);
                __builtin_amdgcn_sched_barrier(0);
                PU_DOT(0, c);
                __builtin_amdgcn_sched_barrier(0);
                if (c + 2 < 16) PU_ROWS(0, c + 2);
                __builtin_amdgcn_sched_barrier(0);
                PU_DOT(1, c + 1);
                __builtin_amdgcn_sched_barrier(0);
            }
#undef PU_ROWS
#undef PU_DOT
            { const LAS f32x4* rd = (const LAS f32x4*)(rowc + 16 * m); const f32x4 a0 = rd[0], a1 = rd[1], a2 = rd[2], a3 = rd[3];
              u32x4 w0, w1; w0.x = cvt_pk_bf16(a0[0], a0[1]); w0.y = cvt_pk_bf16(a0[2], a0[3]); w0.z = cvt_pk_bf16(a1[0], a1[1]); w0.w = cvt_pk_bf16(a1[2], a1[3]);
              w1.x = cvt_pk_bf16(a2[0], a2[1]); w1.y = cvt_pk_bf16(a2[2], a2[3]); w1.z = cvt_pk_bf16(a3[0], a3[1]); w1.w = cvt_pk_bf16(a3[2], a3[3]);
              bf16_t* gp = PART + ((size_t)sl * NROW + tok) * 128 + 16 * m; *(u32x4*)gp = w0; *(u32x4*)(gp + 8) = w1; }
        });
}
__device__ __forceinline__ void phase_coef(const Args& A, int layer, int nrows) {
    const bf16_t* PART = (const bf16_t*)(A.ws + WS_BIG + BIG_PART); const float* GATE = (const float*)(A.ws + WS_R2 + R2_GATE); unsigned* REC = (unsigned*)(A.ws + WS_R2 + R2_COEF);
    const int* IDX = (const int*)(A.ws + WS_R2); const float* SCL = (const float*)(A.ws + tabset(layer) + TAB_SCL);
    const int gthr = blockIdx.x * NTHR + otid(), nthr = gridDim.x * NTHR;
    for (int p = gthr; p < nrows * 16; p += nthr) {
        f32x4 s0 = {0.f, 0.f, 0.f, 0.f}, s1 = {0.f, 0.f, 0.f, 0.f};
#pragma unroll
        for (int x = 0; x < NSL; ++x) { const u32x4 w = *(const u32x4*)(PART + (size_t)x * NROW * 128 + 8 * p);
            s0 += (f32x4){bflo(w.x), bfhi(w.x), bflo(w.y), bfhi(w.y)}; s1 += (f32x4){bflo(w.z), bfhi(w.z), bflo(w.w), bfhi(w.w)}; }
#pragma unroll
        for (int hlf = 0; hlf < 2; ++hlf) { const f32x4 sm = hlf ? s1 : s0;
            const i32x4 e = *(const i32x4*)(IDX + 8 * p + 4 * hlf); const f32x4 gt = *(const f32x4*)(GATE + 8 * p + 4 * hlf);
            const f32x4 su = {SCL[e.x], SCL[e.y], SCL[e.z], SCL[e.w]}, sv = {SCL[NEXP + e.x], SCL[NEXP + e.y], SCL[NEXP + e.z], SCL[NEXP + e.w]};
            const f32x4 a = sm * su; const f32x2 g0 = gelu_pk((f32x2){a[0], a[1]}), g1 = gelu_pk((f32x2){a[2], a[3]});
            const f32x4 cf = gt * (f32x4){g0.x, g0.y, g1.x, g1.y} * sv;
            *(u32x4*)(REC + 8 * p + 4 * hlf) = (u32x4){cvt_pk_bf16(0.f, cf[0]) | (unsigned)e.x, cvt_pk_bf16(0.f, cf[1]) | (unsigned)e.y, cvt_pk_bf16(0.f, cf[2]) | (unsigned)e.z, cvt_pk_bf16(0.f, cf[3]) | (unsigned)e.w}; } }
}
__device__ __forceinline__ void phase_peer_v(const Args& A, int layer, int nrows, LAS unsigned char* smem, int rep) {
    const int* REC = (const int*)(A.ws + WS_R2 + R2_COEF);
    const unsigned char* V = A.ws + tabset(layer) + TAB8_HALF; const float* MODL = (const float*)(A.ws + WS_MOD) + (size_t)layer * 5 * 6144 + 5 * 1024;
    bf16_t* XB = (bf16_t*)(A.ws + WS_XB);
    constexpr int PP = 1088, WB = 4 * PP;
    const int tid = otid(), wid = tid >> 6, lane = tid & 63, m = lane & 7, tk = lane >> 3;
    const int wu = __builtin_amdgcn_readfirstlane(wid);
    LAS unsigned char* lds = smem + LDS_BASE + wu * (2 * WB);
    LAS float* gl = (LAS float*)(smem + LDS_BASE + 8 * (2 * WB));
    static_assert(8 * (2 * WB) + 5 * 1024 * 4 <= LDS_PHASE, "v-phase LDS");
    for (int i = tid; i < 5 * 256; i += NTHR) *(LAS f32x4*)(gl + 4 * i) = *(const f32x4*)(MODL + (size_t)(i >> 8) * 6144 + 4 * (i & 255));
    PeerSched S; S.init(A, nrows, smem);
    peer_items(S,
        [&](int sl, int blk, int buf) {
#pragma unroll
            for (int i = 0; i < 4; ++i)
                __builtin_amdgcn_global_load_lds((const unsigned*)(REC + ((size_t)blk * 64 + 8 * wu + 2 * i) * 128 + 4 * lane), (LAS unsigned*)(lds + buf * WB + PP * i), 16, 0, 0); },
        [&](int sl, int blk, int buf) {
            const unsigned char* vb = V + (size_t)sl * NEXP * SW + 16 * m;
            const int tok = blk * 64 + wid * 8 + tk; const bool lat = tok < NLAT;
            const int toff = (tk >> 1) * PP + (tk & 1) * 512, sw = (tk & 1) * 4;
            const LAS int* ib = (const LAS int*)(lds + buf * WB + toff);
            bf16_t* xp = XB + (size_t)tok * D + SW * sl + 16 * m;
            const u32x4 xr0 = *(const u32x4*)xp, xr1 = *(const u32x4*)(xp + 8);
            f32x2 acc2[8];
#pragma unroll
            for (int j = 0; j < 8; ++j) acc2[j] = (f32x2){0.f, 0.f};
            u32x4 vv[2][8];
#define PV_ROWS(T, c) do { const i32x4 e0_ = *(const LAS i32x4*)(ib + 8 * (c) + sw) & 0xffff, e1_ = *(const LAS i32x4*)(ib + 8 * (c) + (4 - sw)) & 0xffff; \
                vv[T][0] = *(const u32x4*)(vb + (size_t)e0_.x * SW); vv[T][1] = *(const u32x4*)(vb + (size_t)e0_.y * SW); vv[T][2] = *(const u32x4*)(vb + (size_t)e0_.z * SW); vv[T][3] = *(const u32x4*)(vb + (size_t)e0_.w * SW); \
                vv[T][4] = *(const u32x4*)(vb + (size_t)e1_.x * SW); vv[T][5] = *(const u32x4*)(vb + (size_t)e1_.y * SW); vv[T][6] = *(const u32x4*)(vb + (size_t)e1_.z * SW); vv[T][7] = *(const u32x4*)(vb + (size_t)e1_.w * SW); } while (0)
#define PV_FMA(T, c) do { const i32x4 r0_ = *(const LAS i32x4*)(ib + 8 * (c) + sw) & (int)0xffff0000, r1_ = *(const LAS i32x4*)(ib + 8 * (c) + (4 - sw)) & (int)0xffff0000; \
                const f32x4 c0_ = __builtin_bit_cast(f32x4, r0_), c1_ = __builtin_bit_cast(f32x4, r1_); \
                _Pragma("unroll") for (int k = 0; k < 8; ++k) { const float cf = k < 4 ? c0_[k & 3] : c1_[k & 3]; \
                    _Pragma("unroll") for (int j = 0; j < 4; ++j) { const int w = (int)vv[T][k][j]; \
                        const f32x2 lo = __builtin_amdgcn_cvt_pk_f32_fp8(w, false), hi = __builtin_amdgcn_cvt_pk_f32_fp8(w, true); const f32x2 c2 = {cf, cf}; \
                        acc2[2 * j] = __builtin_elementwise_fma(lo, c2, acc2[2 * j]); acc2[2 * j + 1] = __builtin_elementwise_fma(hi, c2, acc2[2 * j + 1]); } } } while (0)
            PV_ROWS(0, 0);
#pragma unroll 1
            for (int c = 0; c < 16; c += 2) {
                PV_ROWS(1, c + 1);
                __builtin_amdgcn_sched_barrier(0);
                PV_FMA(0, c);
                __builtin_amdgcn_sched_barrier(0);
                if (c + 2 < 16) PV_ROWS(0, c + 2);
                __builtin_amdgcn_sched_barrier(0);
                PV_FMA(1, c + 1);
                __builtin_amdgcn_sched_barrier(0);
            }
#undef PV_ROWS
#undef PV_FMA
            const LAS float* gp = gl + (lat ? (tok >> 13) : 4) * 1024 + SW * sl + 16 * m;
            unsigned ow[8];
#pragma unroll
            for (int j = 0; j < 4; ++j) { const f32x4 g = *(const LAS f32x4*)(gp + 4 * j); const unsigned w0 = j == 0 ? xr0.x : j == 1 ? xr0.z : j == 2 ? xr1.x : xr1.z, w1 = j == 0 ? xr0.y : j == 1 ? xr0.w : j == 2 ? xr1.y : xr1.w;
                const f32x4 o = (f32x4){bflo(w0), bfhi(w0), bflo(w1), bfhi(w1)} + g * (f32x4){acc2[2 * j].x, acc2[2 * j].y, acc2[2 * j + 1].x, acc2[2 * j + 1].y};
                ow[2 * j] = cvt_pk_bf16(o[0], o[1]); ow[2 * j + 1] = cvt_pk_bf16(o[2], o[3]); }
            *(u32x4*)xp = (u32x4){ow[0], ow[1], ow[2], ow[3]}; *(u32x4*)(xp + 8) = (u32x4){ow[4], ow[5], ow[6], ow[7]};
        });
}

#ifdef MK_CHECK
constexpr int CW_CHK = 3840;
__device__ __forceinline__ float blk_sum(float v, LAS float* red) {
    const int t_ = otid(); v = wave_sum(v); __syncthreads(); if ((t_ & 63) == 0) red[t_ >> 6] = v; __syncthreads();
    float s = 0.f; for (int i = 0; i < 8; ++i) s += red[i]; __syncthreads(); return s;
}
__device__ __forceinline__ float fp8f(unsigned b) { const unsigned e = (b >> 3) & 15u, m = b & 7u; const float v = e ? ldexpf(1.f + (float)m * 0.125f, (int)e - 7) : ldexpf((float)m * 0.125f, -6); return (b & 0x80u) ? -v : v; }
__device__ __forceinline__ void check_attn(const Args& A, LAS unsigned char* lds, bool with_ctx) {
    const unsigned char* Q = A.ws + WS_R1 + R1_Q; const unsigned char* KN = A.ws + WS_R1 + R1_KN; const unsigned char* KR = A.ws + WS_BIG + BIG_KR; const unsigned char* V = A.ws + WS_R1 + R1_V;
    const bf16_t* CAT = (const bf16_t*)(A.ws + WS_R3 + R3_CAT); float* chk = (float*)(A.ws + WS_CTL) + CW_CHK;
    LAS float* p = (LAS float*)lds; LAS float* qv = p + NKEY; LAS float* red = qv + 192;
    const int tid = otid();
    for (int au = blockIdx.x; au < (with_ctx ? 1056 : 1024); au += gridDim.x) {
        int b, h, qrow, orow, nkey;
        if (au < 1024) { b = au >> 8; h = au & 7; const int qb = (au >> 3) & 31, l = 256 * qb + (int)((((unsigned)au * 2654435761u) >> 20) & 255u); qrow = 256 + l; orow = b * 8192 + l; nkey = NKEY; }
        else { const int cu = au - 1024; b = cu >> 3; h = cu & 7; const int lc = (int)((((unsigned)au * 2654435761u) >> 20) & 255u); qrow = lc; orow = NLAT + 256 * b + lc; nkey = 256; }
        const size_t bh = (size_t)(b * 8 + h);
        __syncthreads();
        if (tid < 192) qv[tid] = fp8f(Q[(bh * NKEY + qrow) * 192 + tid]) * (1.f / att8::QUP);
        __syncthreads();
        float mx = -1e30f;
        for (int key = tid; key < nkey; key += 512) { const int t = key >> 6, k = key & 63; float sacc = 0.f;
            for (int d = 0; d < 128; ++d) sacc += qv[d] * fp8f(KN[(bh * NKT + t) * 8192 + att8::kn8(k, d)]);
            for (int d = 0; d < 64; ++d) sacc += qv[128 + d] * fp8f(KR[((size_t)b * NKT + t) * 4096 + att8::kr8(k, d)]);
            p[key] = sacc; mx = fmaxf(mx, sacc); }
        for (int o = 32; o >= 1; o >>= 1) mx = fmaxf(mx, __shfl_xor(mx, o));
        __syncthreads(); if ((tid & 63) == 0) red[tid >> 6] = mx; __syncthreads(); mx = red[0]; for (int i = 1; i < 8; ++i) mx = fmaxf(mx, red[i]); __syncthreads();
        float ls = 0.f; for (int key = tid; key < nkey; key += 512) { const float e = exp2f(p[key] - mx); p[key] = e; ls += e; }
        ls = blk_sum(ls, red);
        float num = 0.f, den = 0.f;
        if (tid < 128) { float o = 0.f; for (int key = 0; key < nkey; ++key) o += p[key] * fp8f(V[(bh * NKT + (key >> 6)) * 8192 + att8::v8(tid, key & 63)]);
            o /= ls; const float got = bf2f(CAT[(size_t)orow * 2048 + 1024 + 128 * h + tid]); num = (got - o) * (got - o); den = o * o; }
        num = blk_sum(num, red); den = blk_sum(den, red);
        if (tid == 0) { atomicAdd(chk, num); atomicAdd(chk + 1, den); }
    }
}
__device__ __forceinline__ void check_qkv(const Args& A, int li, LAS unsigned char* lds) {
    float* chk = (float*)(A.ws + WS_CTL) + CW_CHK;
    const unsigned char* Q = A.ws + WS_R1 + R1_Q; const unsigned char* KN = A.ws + WS_R1 + R1_KN; const unsigned char* KR = A.ws + WS_BIG + BIG_KR; const unsigned char* V = A.ws + WS_R1 + R1_V;
    LAS float* hv = (LAS float*)lds; LAS float* cq = hv + 1024; LAS float* ckv = cq + 384; LAS float* kr = ckv + 256; LAS float* red = kr + 64; LAS float* ov = red + 16;
    const int tid = otid(), sidx = blockIdx.x;
    const int hd = sidx & 7; const int r = (sidx & 8) ? NLAT + (int)(((unsigned)sidx * 2654435761u) >> 22) : (int)(((unsigned)sidx * 2654435761u) >> 17);
    const float* win = A.in[I_HWIN] + (size_t)li * 1024 * HYB_IN;
    {
        const bf16_t* xp = (const bf16_t*)(A.ws + WS_XB) + (size_t)r * D; const float* MODL = (const float*)(A.ws + WS_MOD) + (size_t)(2 * li) * 5 * 6144 + (size_t)row_mb(r) * 6144;
        float ss = 0.f; for (int i = tid; i < 1024; i += 512) ss += bf2f(xp[i]) * bf2f(xp[i]);
        ss = blk_sum(ss, red); const float rstd = rsqrtf(ss / 1024.f + EPS);
        for (int i = tid; i < 1024; i += 512) hv[i] = bf2f(f2bf(bf2f(xp[i]) * rstd * A.in[I_N1G][(2 * li) * 1024 + i] * (1.f + MODL[1024 + i]) + MODL[i])); }
    __syncthreads();
    for (int j = tid; j < 704; j += 512) { float s = 0.f; for (int k = 0; k < 1024; ++k) s += hv[k] * win[(size_t)k * HYB_IN + C_CQ + j];
        s = bf2f(f2bf(s)); if (j < 384) cq[j] = s; else if (j < 640) ckv[j - 384] = s; else kr[j - 640] = s; }
    __syncthreads();
    float sq = 0.f, sk = 0.f; for (int j = tid; j < 384; j += 512) sq += cq[j] * cq[j]; for (int j = tid; j < 256; j += 512) sk += ckv[j] * ckv[j];
    sq = blk_sum(sq, red); sk = blk_sum(sk, red);
    const float rq = rsqrtf(sq / 384.f + EPS), rk = rsqrtf(sk / 256.f + EPS);
    const float* wqb = A.in[I_WQB] + (size_t)li * 384 * 1536; const float* wkvb = A.in[I_WKVB] + (size_t)li * 256 * 2048; const float* qg = A.in[I_QNG] + li * 384; const float* kg = A.in[I_KVNG] + li * 256;
    if (tid < 192) { float s = 0.f; for (int k = 0; k < 384; ++k) s += cq[k] * rq * qg[k] * wqb[(size_t)k * 1536 + hd * 192 + tid]; ov[tid] = s; }
    else if (tid < 448) { const int c = tid - 192; float s = 0.f; for (int k = 0; k < 256; ++k) s += ckv[k] * rk * kg[k] * wkvb[(size_t)k * 2048 + hd * 256 + c]; ov[tid] = s; }
    __syncthreads();
    const bool lat = r < NLAT; const int b = lat ? (r >> 13) : ((r - NLAT) >> 8), l = lat ? (r & 8191) : 0, key = lat ? 256 + l : ((r - NLAT) & 255), qrow = key;
    const size_t bh = (size_t)(b * 8 + hd); const float qs = QSCALE * att8::QUP;
    float num = 0.f, den = 0.f;
    if (tid < 128) {
        const float q = ov[tid] * qs, gq = fp8f(Q[(bh * NKEY + qrow) * 192 + tid]);
        const float kk = ov[192 + tid], gk = fp8f(KN[(bh * NKT + (key >> 6)) * 8192 + att8::kn8(key & 63, tid)]);
        const float vv = ov[320 + tid], gv = fp8f(V[(bh * NKT + (key >> 6)) * 8192 + att8::v8(tid, key & 63)]);
        num = (gq - q) * (gq - q) + (gk - kk) * (gk - kk) + (gv - vv) * (gv - vv); den = q * q + kk * kk + vv * vv;
    } else if (tid < 160) {
        const int i = tid - 128; float c = 1.f, sn = 0.f;
        if (lat) { const float pos = (float)(i < 16 ? (l >> 6) : (l & 63)); const float ang = pos * powf(10000.f, -(float)(i & 15) / 16.f); c = cosf(ang); sn = sinf(ang); }
        const float q1 = ov[128 + i] * qs, q2 = ov[160 + i] * qs, k1 = kr[i], k2 = kr[32 + i];
        const float rq1 = q1 * c - q2 * sn, rq2 = q1 * sn + q2 * c, rk1 = k1 * c - k2 * sn, rk2 = k1 * sn + k2 * c;
        const float gq1 = fp8f(Q[(bh * NKEY + qrow) * 192 + 128 + 2 * i]), gq2 = fp8f(Q[(bh * NKEY + qrow) * 192 + 128 + 2 * i + 1]);
        const float gk1 = fp8f(KR[((size_t)b * NKT + (key >> 6)) * 4096 + att8::kr8(key & 63, 2 * i)]), gk2 = fp8f(KR[((size_t)b * NKT + (key >> 6)) * 4096 + att8::kr8(key & 63, 2 * i + 1)]);
        num = (gq1 - rq1) * (gq1 - rq1) + (gq2 - rq2) * (gq2 - rq2) + (gk1 - rk1) * (gk1 - rk1) + (gk2 - rk2) * (gk2 - rk2); den = rq1 * rq1 + rq2 * rq2 + rk1 * rk1 + rk2 * rk2;
    }
    num = blk_sum(num, red); den = blk_sum(den, red);
    if (tid == 0) { atomicAdd(chk, num); atomicAdd(chk + 1, den); }
}
__device__ __forceinline__ void check_topk(const Args& A, int layer, LAS unsigned char* lds) {
    const bf16_t* QP = (const bf16_t*)(A.ws + WS_BIG); const int* IDX = (const int*)(A.ws + WS_R2); const float* GATE = (const float*)(A.ws + WS_R2 + R2_GATE); float* chk = (float*)(A.ws + WS_CTL) + CW_CHK;
    const bf16_t* K1 = (const bf16_t*)(A.ws + WS_W + W_PEER + (size_t)layer * WP_SZ + WP_K1);
    LAS float* sc = (LAS float*)lds; LAS float* v12 = sc + 256; LAS int* i12 = (LAS int*)(v12 + 32); LAS float* cs = (LAS float*)(i12 + 32); LAS float* ts = cs + 256; LAS int* ti = (LAS int*)(ts + 16); LAS float* red = (LAS float*)(ti + 16);
    const int tid = otid();
    for (int smp = blockIdx.x; smp < 1024; smp += gridDim.x) {
        const int h = smp & 7, tok = (int)((((unsigned)smp * 2654435761u) >> 12) % (unsigned)NROW);
        __syncthreads();
        if (tid < 256) { const int half = tid >> 7, key = tid & 127; float a = 0.f;
            for (int d = 0; d < 128; ++d) a += bf2f(QP[(size_t)tok * 2048 + 256 * h + 128 * half + d]) * bf2f(K1[((size_t)half * 8 + h) * 16384 + key * 128 + d]);
            sc[tid] = a; }
        __syncthreads();
        if (tid < 256) { const int half = tid >> 7, key = tid & 127; const float v = sc[tid]; int rank = 0;
            for (int j = 0; j < 128; ++j) { const float o = sc[half * 128 + j]; rank += (o > v || (o == v && j < key)) ? 1 : 0; }
            if (rank < 16) { v12[half * 16 + rank] = v; i12[half * 16 + rank] = key; } }
        __syncthreads();
        if (tid < 256) cs[tid] = v12[tid >> 4] + v12[16 + (tid & 15)];
        __syncthreads();
        if (tid < 256) { const float v = cs[tid]; int rank = 0;
            for (int j = 0; j < 256; ++j) { const float o = cs[j]; rank += (o > v || (o == v && j < tid)) ? 1 : 0; }
            if (rank < 16) { ts[rank] = v; ti[rank] = i12[tid >> 4] * 128 + i12[16 + (tid & 15)]; } }
        __syncthreads();
        float num = 0.f, den = 0.f;
        if (tid < 16) { float es = 0.f; for (int j = 0; j < 16; ++j) es += __expf(ts[j] - ts[0]); const float gn = __expf(ts[tid] - ts[0]) / es; float gk = 0.f;
            for (int j = 0; j < 16; ++j) if (IDX[(size_t)tok * 128 + 16 * h + j] == ti[tid]) gk = GATE[(size_t)tok * 128 + 16 * h + j];
            num = (gk - gn) * (gk - gn); den = gn * gn; }
        num = blk_sum(num, red); den = blk_sum(den, red);
        if (tid == 0) { atomicAdd(chk, num); atomicAdd(chk + 1, den); }
    }
}
__device__ __forceinline__ void check_ssd(const Args& A, int li, LAS unsigned char* lds) {
    const bf16_t* XS = (const bf16_t*)(A.ws + WS_R2); const bf16_t* BC = (const bf16_t*)(A.ws + WS_R2 + R2_BC); const float* DT = (const float*)(A.ws + WS_BIG + BIG_DT);
    const bf16_t* Y0 = (const bf16_t*)(A.ws + WS_H); const bf16_t* Y1 = (const bf16_t*)(A.ws + WS_R3); float* chk = (float*)(A.ws + WS_CTL) + CW_CHK;
    LAS float* red = (LAS float*)lds;
    const int tid = otid(), sidx = blockIdx.x;
    const int b = sidx & 3, d = (sidx >> 2) & 1, h = (sidx >> 3) & 15, p = (int)((((unsigned)sidx * 2654435761u) >> 20) & 63u), g = h >> 3;
    const float a = -__expf(A.in[I_ALOG][li * 32 + d * 16 + h]);
    const bf16_t* Y = d ? Y1 : Y0;
    float hst = 0.f, num = 0.f, den = 0.f;
    for (int step = 0; step < 8448; ++step) {
        int r;
        if (step < 256) r = NLAT + b * 256 + (d ? 255 - step : step); else { const int q = step - 256; r = b * 8192 + (d ? 8191 - q : q); }
        const float dt = DT[(size_t)(d * 16 + h) * NROW + r], x = bf2f(XS[(size_t)r * 1024 + 64 * h + p]);
        float contrib = 0.f;
        if (tid < 128) { hst = __expf(dt * a) * hst + dt * x * bf2f(BC[(size_t)r * 512 + 128 * g + tid]); contrib = hst * bf2f(BC[(size_t)r * 512 + 256 + 128 * g + tid]); }
        if (step % 61 == 0) { const float y = blk_sum(contrib, red); const float got = bf2f(Y[(size_t)r * 1024 + 64 * h + p]); if (tid == 0) { num += (got - y) * (got - y); den += y * y; } }
    }
    if (tid == 0) { atomicAdd(chk, num); atomicAdd(chk + 1, den); }
}
#endif
#ifndef MK_PER_PHASE
#define MK_PER_PHASE 0
#endif
__device__ __forceinline__ int nr_in(int L) { return L <= 2 ? NROW : NLAT; }
__device__ __forceinline__ int nr_out(int L) { return L <= 1 ? NROW : NLAT; }

__global__ void __launch_bounds__(NTHR, 2) fwd(Args A) {
    extern __shared__ __attribute__((aligned(256))) unsigned char smem_raw[];
    LAS unsigned char* smem = (LAS unsigned char*)smem_raw;
    LAS unsigned char* lds = smem + LDS_BASE;
    const int tid = otid();
    if (tid < 64) ((LAS unsigned*)smem)[tid] = 0u;
    __syncthreads();
    XcdBarrier bar = xcd_barrier_post((unsigned*)(A.ws + WS_CTL), (volatile LAS unsigned*)smem);
    if (tid == 0) ((LAS unsigned*)smem)[8] = atomicAdd((unsigned*)(A.ws + WS_CTL) + CW_RANK + 32 * (xb_xcc_id() & 7u), 1u);
    __syncthreads();
    bool need_bar = false;
    const int lo = A.ph_lo, hi = A.ph_hi;
#ifndef PHMASK
#define PHMASK 0xffffffffu
#endif
#define SITE(k) if constexpr (((PHMASK) >> (k)) & 1u)
#ifndef MK_SVAR
#define MK_SVAR 1
#endif
#ifndef MK_REPEAT_SITE
#define MK_REPEAT_SITE -1
#endif
#define REP(k) for (int rep = 0; rep < ((k) == (MK_REPEAT_SITE) ? 2 : 1); ++rep)
#define PH(id) if ([&]() -> bool { if ((id) < lo || (id) >= hi) return false; if (need_bar) xcd_barrier(bar); need_bar = true; return true; }())
    unsigned char* ws = A.ws;
#define TAIL_TAB(units, layer, rlo, rhi) do { const int nx_ = (units) % 256; if (gridDim.x == 256 && (int)blockIdx.x >= nx_) phase_tabcvt(A, layer, (int)blockIdx.x - nx_, 256 - nx_, rlo, rhi); } while (0)
    bf16_t* XB = (bf16_t*)(ws + WS_XB);
    bf16_t* H = (bf16_t*)(ws + WS_H);
    const float* MOD = (const float*)(ws + WS_MOD);

    SITE(0) PH(0) { phase_prologue(A, lds); }
    SITE(1) PH(1) { phase_norm_mod<true>(A.in[I_X], A.in[I_CTX], XB, A.in[I_N1G], MOD, 0, H, NROW); }
    for (int L = 0; L < DEPTH; ++L) {
        const int base = 2 + 16 * L, li = L >> 1; const bool hyb = (L & 1) == 0;
        const float* MODL = MOD + (size_t)L * 5 * 6144;
        unsigned char* WH = ws + WS_W + W_HYB + (size_t)li * WH_SZ; unsigned char* WG = ws + WS_W + W_GM + (size_t)li * WG_SZ; unsigned char* WP = ws + WS_W + W_PEER + (size_t)L * WP_SZ;
        if (hyb) {
            SITE(2) PH(base + 0) REP(2) { pg8::Gemm g{H, (const bf16_t*)(WH + WH_IN), nr_in(L), HYB_INP, 1024, 1024, 1024};
                pg8::EpiBf16<0> e{(bf16_t*)(ws + WS_BIG), HYB_INP}; pg8::gemm_phase(lds, g, e); }
            SITE(3) PH(base + 1) REP(3) { phase_conv(A, li, rep); }
            SITE(4) PH(base + 2) {
                SITE(18) REP(18) { pg8::Gemm g{(const bf16_t*)(ws + WS_BIG) + C_CQ, (const bf16_t*)(WH + WH_QB), L == 0 ? NROW : NLAT, 1536, 384, HYB_INP, 384};
                  EpiQ e{ws + WS_R1 + R1_Q, (const float*)(ws + WS_RSTD), (const float*)(ws + WS_ROPE)}; pg8::gemm_phase(lds, g, e); }
                SITE(19) REP(19) { pg8::Gemm g{(const bf16_t*)(ws + WS_BIG) + C_CKV, (const bf16_t*)(WH + WH_KVB), NROW, 2048, 256, HYB_INP, 256};
                  EpiKV e{ws + WS_R1 + R1_KN, ws + WS_R1 + R1_V, (const float*)(ws + WS_RSTD) + NROW}; pg8::gemm_phase(lds, g, e); }
                SITE(20) REP(20) for (int u = blockIdx.x; u < 528; u += gridDim.x) ssd::g_unit((const bf16_t*)(ws + WS_R2 + R2_BC), (bf16_t*)(ws + WS_BIG + BIG_G), u);
            }
            SITE(5) PH(base + 3) {
                const int xq = (int)blockIdx.x & 7, jq = (int)blockIdx.x >> 3; const bool ssd_wg = (jq & 1) == 0 && gridDim.x == 256;
                if (gridDim.x == 256) {
                    if (ssd_wg) { const int r = jq >> 1, gi = xq + 8 * (r >> 3), hh = r & 7, sb = gi >> 2, sgp = (gi >> 1) & 1, sd = gi & 1;
                        SITE(21) ssd::ssd_unit(sb, 8 * sgp + hh, sd, (const bf16_t*)(ws + WS_R2), (const bf16_t*)(ws + WS_R2 + R2_BC), (const float*)(ws + WS_BIG + BIG_DT), (const bf16_t*)(ws + WS_BIG + BIG_G),
                                               A.in[I_ALOG] + li * 32, sd ? (bf16_t*)(ws + WS_R3) : (bf16_t*)(ws + WS_H), lds); }
                } else {
                    SITE(21) for (int u = blockIdx.x; u < 128; u += gridDim.x) ssd::ssd_unit(u >> 5, (u >> 1) & 15, u & 1, (const bf16_t*)(ws + WS_R2), (const bf16_t*)(ws + WS_R2 + R2_BC), (const float*)(ws + WS_BIG + BIG_DT),
                                               (const bf16_t*)(ws + WS_BIG + BIG_G), A.in[I_ALOG] + li * 32, (u & 1) ? (bf16_t*)(ws + WS_R3) : (bf16_t*)(ws + WS_H), lds);
                }
                const int nmine = __builtin_amdgcn_readfirstlane(gridDim.x == 256 ? (ssd_wg ? 3 : 5) + (L == 0 && !ssd_wg && jq < 8 ? 1 : 0) : 0);
                SITE(22) REP(22) for (int it = 0; gridDim.x == 256 ? it < nmine : (int)blockIdx.x + it * (int)gridDim.x < (L == 0 ? 1056 : 1024); ++it) {
                    int b, h, qrow0, orow0, nt;
                    if (gridDim.x == 256) {
                        const int base_it = ssd_wg ? 3 : 5;
                        if (it < base_it) { const int v = ssd_wg ? 3 * (jq >> 1) + it : 48 + 5 * (jq >> 1) + it; b = v >> 5; h = xq; const int qb = v & 31; qrow0 = 256 + 256 * qb; orow0 = b * 8192 + 256 * qb; nt = NKT; }
                        else { b = jq >> 1; h = xq; qrow0 = 0; orow0 = NLAT + 256 * b; nt = 4; }
                    } else { const int au = (int)blockIdx.x + it * (int)gridDim.x;
                        if (au < 1024) { b = au >> 8; h = au & 7; const int qb = (au >> 3) & 31; qrow0 = 256 + 256 * qb; orow0 = b * 8192 + 256 * qb; nt = NKT; }
                        else { const int cu = au - 1024; b = cu >> 3; h = cu & 7; qrow0 = 0; orow0 = NLAT + 256 * b; nt = 4; } }
                    const size_t bh = (size_t)(b * 8 + h);
                    att8::attn_unit(ws + WS_R1 + R1_Q + (bh * NKEY + qrow0) * 192, ws + WS_R1 + R1_KN + bh * NKT * 8192, ws + WS_BIG + BIG_KR + (size_t)b * NKT * 4096,
                                    ws + WS_R1 + R1_V + bh * NKT * 8192, (bf16_t*)(ws + WS_R3 + R3_CAT) + (size_t)orow0 * 2048 + 1024 + 128 * h, nt, lds);
                }
                if (gridDim.x == 256 && !ssd_wg && L == 2) SITE(11) phase_tabcvt(A, 3, xq + 8 * (jq >> 1), 128, 0, NEXP);
            }
            SITE(6) PH(base + 4) REP(6) { phase_ssd_out(A, li, nr_out(L));
#if defined(MK_CHECK) && MK_CHECK == 1
                if (L == 0) check_attn(A, lds, true);
#elif defined(MK_CHECK) && MK_CHECK == 2
                if (L == 0) check_qkv(A, li, lds);
#elif defined(MK_CHECK) && MK_CHECK == 3
                if (L == 2) check_attn(A, lds, false);
#elif defined(MK_CHECK) && MK_CHECK == 5
                if (L == 0) check_ssd(A, li, lds);
#elif defined(MK_CHECK) && MK_CHECK == 6
                if (L == 2) check_ssd(A, li, lds);
#endif
            }
        } else {
            SITE(7) PH(base + 0) REP(7) { pg8::Gemm g{H, (const bf16_t*)(WG + WG_IN), nr_out(L), 4096, 1024, 1024, 1024};
                pg8::EpiGmIn e{(bf16_t*)(ws + WS_BIG), (float*)(ws + WS_R3)}; pg8::gemm_phase(lds, g, e);
                if (rep == 0 && L == 1) TAIL_TAB((nr_out(L) / 256) * 16, 1, NEXP, 2 * NEXP); }
            SITE(9) PH(base + 2) REP(9) { phase_spatial(A, li, nr_out(L), lds); }
        }
        SITE(10) PH(base + 5) { pg8::Gemm g{hyb ? (const bf16_t*)(ws + WS_R3 + R3_CAT) : (const bf16_t*)(ws + WS_R1), hyb ? (const bf16_t*)(WH + WH_OUT) : (const bf16_t*)(WG + WG_OUT), nr_out(L), 1024, 2048, 2048, 2048};
            pg8::EpiResid e{XB, MODL + 2 * 1024}; pg8::gemm_phase(lds, g, e);
            if (L == 0) TAIL_TAB((nr_out(L) / 256) * 4, 0, 0, 2 * NEXP); else if (L == 1) TAIL_TAB((nr_out(L) / 256) * 4, 2, 0, 2 * NEXP); }
        SITE(11) PH(base + 6) REP(11) { phase_norm_mod<false>(nullptr, nullptr, XB, A.in[I_N2G] + L * 1024, MODL, 3, H, nr_out(L));
            if (gridDim.x != 256) phase_tabcvt(A, L, (int)blockIdx.x, (int)gridDim.x);
            else if (L == 3) phase_tabcvt(A, 3, (int)blockIdx.x, 256, NEXP, 2 * NEXP); }
        SITE(12) PH(base + 7) REP(12) { pg8::Gemm g{H, (const bf16_t*)(WP + WP_Q), nr_out(L), 2048, 1024, 1024, 1024};
            pg8::EpiBf16<0> e{(bf16_t*)(ws + WS_BIG), 2048}; pg8::gemm_phase(lds, g, e);
            if (rep == 0 && L == 0) TAIL_TAB((nr_out(L) / 256) * 8, 1, 0, NEXP); }
        SITE(13) PH(base + 8) REP(13) { phase_topk(A, L, nr_out(L), lds); }
        SITE(14) PH(base + 9) REP(14) { phase_peer_u(A, L, nr_out(L), smem, rep); }
        SITE(15) PH(base + 10) REP(15) { phase_coef(A, L, nr_out(L));
#if defined(MK_CHECK) && MK_CHECK == 4
            if (L == 1) check_topk(A, L, lds);
#endif
        }
        SITE(16) PH(base + 11) { phase_peer_v(A, L, nr_out(L), smem, 0); }
        SITE(17) PH(base + 12) { if (L < DEPTH - 1) phase_norm_mod<false>(nullptr, nullptr, XB, A.in[I_N1G] + (L + 1) * 1024, MOD + (size_t)(L + 1) * 5 * 6144, 0, H, nr_in(L + 1));
                        else {
#ifdef MK_CHECK
                            const float* chk = (const float*)(ws + WS_CTL) + CW_CHK; const float err = sqrtf(chk[0] / fmaxf(chk[1], 1e-30f));
                            phase_final_norm(XB, A.out, A.in[I_FNG], 1.f + 10.f * err);
#else
                            phase_final_norm(XB, A.out, A.in[I_FNG], 1.f);
#endif
                        } }
    }
#undef PH
}

#ifdef MK_TAP
__global__ void tap_kernel(const unsigned short* buf, size_t pitch, size_t col0, size_t ncols, size_t nrows, float* out) {
    const size_t n = ncols * nrows;
    for (size_t i = (size_t)blockIdx.x * blockDim.x + threadIdx.x; i < (size_t)NLAT * D; i += (size_t)gridDim.x * blockDim.x) {
        float s = 0.f; for (size_t j = i; j < n; j += (size_t)NLAT * D) s += (float)buf[(j / ncols) * pitch + col0 + (j % ncols)]; out[i] = s; }
}
#endif
extern "C" void kernel_launch(void* const* d_in, const int* in_sizes, int n_in, void* d_out, int out_size, void* d_ws, size_t ws_size, hipStream_t stream) {
    static int grid = 0;
    if (grid == 0) {
        if (n_in != N_IN || out_size != NLAT * D || ws_size < WS_END) { fprintf(stderr, "kernel_launch: unexpected shapes (n_in %d out %d ws %zu, need %zu)\n", n_in, out_size, ws_size, (size_t)WS_END); grid = -1; return; }
        int dev = 0, cus = 0, per_cu = 0;
        if (hipGetDevice(&dev) != hipSuccess || hipDeviceGetAttribute(&cus, hipDeviceAttributeMultiprocessorCount, dev) != hipSuccess) { grid = -1; return; }
        if (hipFuncSetAttribute((const void*)fwd, hipFuncAttributeMaxDynamicSharedMemorySize, LDS_BYTES) != hipSuccess) { fprintf(stderr, "kernel_launch: hipFuncSetAttribute failed\n"); grid = -1; return; }
        if (hipOccupancyMaxActiveBlocksPerMultiprocessor(&per_cu, (const void*)fwd, NTHR, LDS_BYTES) != hipSuccess || per_cu < 1) { fprintf(stderr, "kernel_launch: occupancy query says %d\n", per_cu); }
        (void)hipGetLastError();
        grid = cus;
    }
    if (grid < 0) return;
    (void)hipMemsetAsync((char*)d_ws + WS_CTL, 0, CTL_BYTES, stream);
    Args a{};
    for (int i = 0; i < N_IN; ++i) a.in[i] = (const float*)d_in[i];
    a.out = (float*)d_out; a.ws = (unsigned char*)d_ws;
#if MK_PER_PHASE
    for (int id = 0; id < 2 + 16 * DEPTH; ++id) {
        if (id >= 2) { const int L = (id - 2) / 16, s = (id - 2) % 16; if (s > 12) continue; if ((L & 1) && (s == 3 || s == 4)) continue; }
#ifdef MK_CUT
#ifdef MK_TAP
        if (id >= MK_CUT) continue;
#else
        if (id >= MK_CUT && id != 2 + 16 * (DEPTH - 1) + 12) continue;
#endif
#endif
        a.ph_lo = id; a.ph_hi = id + 1;
        hipLaunchKernelGGL(fwd, dim3(grid), dim3(NTHR), LDS_BYTES, stream, a);
    }
#ifdef MK_TAP
    { const size_t tp[5] = {MK_TAP}; hipLaunchKernelGGL(tap_kernel, dim3(2048), dim3(256), 0, stream, (const unsigned short*)((const char*)d_ws + tp[0]), tp[1], tp[2], tp[3], tp[4], (float*)d_out); }
#endif
#else
    a.ph_lo = 0; a.ph_hi = 2 + 16 * DEPTH;
    hipLaunchKernelGGL(fwd, dim3(grid), dim3(NTHR), LDS_BYTES, stream, a);
#endif
    const hipError_t le = hipPeekAtLastError();
    if (le != hipSuccess) fprintf(stderr, "kernel_launch: launch failed: %s\n", hipGetErrorName(le));
}
```

```cpp
#include <hip/hip_runtime.h>
#include <cstdio>
#include <cstdint>

#define LAS __attribute__((address_space(3)))
typedef unsigned short bf16_t;
typedef short bf16x8 __attribute__((ext_vector_type(8)));
typedef short s16x4 __attribute__((ext_vector_type(4)));
typedef float f32x2 __attribute__((ext_vector_type(2)));
typedef float f32x4 __attribute__((ext_vector_type(4)));
typedef float f32x16 __attribute__((ext_vector_type(16)));
typedef unsigned u32x2 __attribute__((ext_vector_type(2)));
typedef unsigned u32x4 __attribute__((ext_vector_type(4)));
typedef int i32x4 __attribute__((ext_vector_type(4)));
typedef int i32x8 __attribute__((ext_vector_type(8)));

constexpr int D = 1024, NB = 4, SEQ = 8192, DEPTH = 4, CTXL = 256;
constexpr int NLAT = NB * SEQ, NCTX = NB * CTXL, NROW = NLAT + NCTX;
constexpr int HYB_IN = 3280, HYB_INP = 3328;
constexpr int C_Z = 0, C_XBC = 1024, C_DT = 2560, C_CQ = 2576, C_CKV = 2960, C_KR = 3216;
constexpr int NKEY = SEQ + CTXL, NKT = NKEY / 64;
constexpr float EPS = 1e-6f;
constexpr float QSCALE = 0.07216878364870322f * 1.4426950408889634f;
constexpr int NEXP = 16384;

enum { I_X = 0, I_C, I_CTX, I_CCTX, I_ADAW, I_ADAB, I_N1G, I_N2G, I_HWIN, I_CONVW, I_CONVB, I_ALOG, I_DTB, I_SSDD, I_SSDNG, I_QNG, I_WQB, I_KVNG, I_WKVB,
       I_HWOUT, I_GWIN, I_GLNG, I_GLNB, I_GWS, I_GBS, I_GWOUT, I_PWQ, I_PK1, I_PK2, I_PU, I_PV, I_FNG, N_IN };

constexpr size_t al256(size_t x) { return (x + 255) & ~(size_t)255; }
constexpr size_t WS_CTL = 0, CTL_BYTES = 65536;
constexpr size_t WS_MOD = WS_CTL + CTL_BYTES;
constexpr size_t WS_ROPE = WS_MOD + al256((size_t)DEPTH * 5 * 6144 * 4);
constexpr size_t WS_RSTD = WS_ROPE + (size_t)2 * SEQ * 32 * 4;
constexpr size_t WS_W = WS_RSTD + al256((size_t)2 * NROW * 4);
constexpr size_t W_HYB = 0;
constexpr size_t WH_IN = 0, WH_QB = WH_IN + (size_t)HYB_INP * 1024 * 2, WH_KVB = WH_QB + (size_t)1536 * 384 * 2, WH_OUT = WH_KVB + (size_t)2048 * 256 * 2,
                 WH_SZ = WH_OUT + (size_t)1024 * 2048 * 2;
constexpr size_t W_GM = W_HYB + 2 * WH_SZ;
constexpr size_t WG_IN = 0, WG_OUT = WG_IN + (size_t)4096 * 1024 * 2, WG_WS = WG_OUT + (size_t)1024 * 2048 * 2, WG_SZ = WG_WS + (size_t)8 * 128 * 128 * 2;
constexpr size_t W_PEER = W_GM + 2 * WG_SZ;
constexpr size_t WP_Q = 0, WP_K1 = WP_Q + (size_t)2048 * 1024 * 2, WP_K2 = WP_K1 + (size_t)8 * 128 * 128 * 2, WP_SZ = WP_K2 + (size_t)8 * 128 * 128 * 2;
constexpr size_t W_TOTAL = W_PEER + 4 * WP_SZ;
constexpr size_t WS_TAB = WS_W + al256(W_TOTAL);
constexpr size_t TAB_HALF = (size_t)NEXP * 1024 * 2;
constexpr size_t TAB_REGION = 2 * TAB_HALF + 524288;
constexpr size_t WS_XB = WS_TAB + TAB_REGION;
constexpr size_t WS_H = WS_XB + (size_t)NROW * D * 2;
constexpr size_t WS_BIG = WS_H + (size_t)NROW * D * 2;
constexpr size_t BIG_BYTES = (size_t)NROW * 4096 * 2;
constexpr size_t BIG_DT = (size_t)NROW * HYB_INP * 2;
constexpr size_t BIG_G = BIG_DT + (size_t)NROW * 32 * 4;
constexpr size_t BIG_KR = BIG_G + (size_t)528 * 128 * 128 * 2;
constexpr size_t BIG_PART = (size_t)NROW * 2048 * 2;
static_assert(BIG_KR + (size_t)NB * NKT * 8192 <= BIG_BYTES, "BIG tail");
constexpr size_t WS_R1 = WS_BIG + BIG_BYTES;
constexpr size_t R1_Q = 0, R1_KN = R1_Q + (size_t)NB * 8 * NKEY * 192, R1_V = R1_KN + (size_t)NB * 8 * NKT * 8192, R1_HYB = R1_V + (size_t)NB * 8 * NKT * 8192,
                 R1_GM = (size_t)NROW * 2048 * 2, R1_BYTES = R1_HYB > R1_GM ? R1_HYB : R1_GM;
constexpr size_t WS_R2 = WS_R1 + R1_BYTES;
constexpr size_t R2_BC = (size_t)NROW * 1024 * 2, R2_BYTES = R2_BC + (size_t)NROW * 512 * 2;
constexpr size_t R2_GATE = (size_t)NROW * 128 * 4, R2_COEF = 2 * R2_GATE;
constexpr size_t WS_R3 = WS_R2 + R2_BYTES;
constexpr size_t R3_CAT = (size_t)NROW * 1024 * 2, R3_BYTES = R3_CAT + (size_t)NROW * 2048 * 2;
constexpr size_t WS_END = WS_R3 + R3_BYTES;
static_assert(WS_END <= ((size_t)1 << 30), "workspace must fit 1 GiB");

constexpr int CW_RANK = 3584;
constexpr int CW_QUEUE = 4096;

typedef __bf16 bf16x2_t __attribute__((ext_vector_type(2)));
__device__ __forceinline__ unsigned cvt_pk_bf16(float lo, float hi) { const f32x2 v = {lo, hi}; const bf16x2_t b = __builtin_convertvector(v, bf16x2_t); return __builtin_bit_cast(unsigned, b); }
__device__ __forceinline__ bf16_t f2bf(float f) { return (bf16_t)(cvt_pk_bf16(f, 0.f) & 0xffffu); }
__device__ __forceinline__ float bf2f(unsigned b) { return __uint_as_float(b << 16); }
__device__ __forceinline__ float bflo(unsigned w) { return __uint_as_float(w << 16); }
__device__ __forceinline__ float bfhi(unsigned w) { return __uint_as_float(w & 0xffff0000u); }
__device__ __forceinline__ float wave_sum(float v) {
#pragma unroll
    for (int o = 32; o >= 1; o >>= 1) v += __shfl_xor(v, o);
    return v;
}
__device__ __forceinline__ int otid() { int t = threadIdx.x; asm volatile("" : "+v"(t)); return t; }
__device__ __forceinline__ float silu_f(float x) { return x * __builtin_amdgcn_rcpf(1.f + __expf(-x)); }
__device__ __forceinline__ float softplus_f(float x) { return x > 20.f ? x : log1pf(__expf(x)); }
__device__ __forceinline__ f32x2 gelu_pk(f32x2 v) {
    const f32x2 av = __builtin_elementwise_abs(v), d = av * 0.2316418882f + 1.0f;
    f32x2 t; t.x = __builtin_amdgcn_rcpf(d.x); t.y = __builtin_amdgcn_rcpf(d.y);
    f32x2 q = t * 0.5307027145f + (-0.7265760135f); q = q * t + 0.7107068705f; q = q * t + (-0.142248368f); q = q * t + 0.127414796f; q = q * t;
    const f32x2 s = (v * v) * (-0.72134752044f);
    f32x2 e; e.x = __builtin_amdgcn_exp2f(s.x); e.y = __builtin_amdgcn_exp2f(s.y);
    return v * 0.5f + av * (0.5f - q * e);
}
__device__ __forceinline__ float gelu_f(float x) { f32x2 v = {x, 0.f}; return gelu_pk(v).x; }

__device__ __forceinline__ unsigned pk4_fp8(float a, float b, float c, float d) { int w = 0; w = __builtin_amdgcn_cvt_pk_fp8_f32(a, b, w, false); w = __builtin_amdgcn_cvt_pk_fp8_f32(c, d, w, true); return (unsigned)w; }
__device__ __forceinline__ float sat8(float v) { return __builtin_amdgcn_fmed3f(v, -448.f, 448.f); }
__device__ __forceinline__ unsigned pk4_fp8_sat(float a, float b, float c, float d) { return pk4_fp8(sat8(a), sat8(b), sat8(c), sat8(d)); }
__device__ __forceinline__ int row_mb(int r) { return r < NLAT ? (r >> 13) : 4; }

#define XB_TMO      128
#define XB_XCNT(j)  (256  + 64 * (j))
#define XB_XSUB(j)  (1280 + 64 * (j))
#define XB_XGEN(j)  (2304 + 64 * (j))
#define XB_TOP      3328
#define XB_TOPGEN   3392
#define XCD_BAR_WORDS 3456
#define XB_SPIN_CAP (1u << 22)
__device__ __forceinline__ unsigned xb_ld(unsigned* p)              { return __hip_atomic_load(p, __ATOMIC_RELAXED, __HIP_MEMORY_SCOPE_AGENT); }
__device__ __forceinline__ unsigned xb_add(unsigned* p, unsigned v) { return __hip_atomic_fetch_add(p, v, __ATOMIC_RELAXED, __HIP_MEMORY_SCOPE_AGENT); }
__device__ __forceinline__ unsigned xb_xcc_id() { return (unsigned)__builtin_amdgcn_s_getreg((3 << 11) | 20) & 0xFu; }
#define XB_SPIN(cond, bar) do { unsigned _sp = 0; while (cond) { __builtin_amdgcn_s_sleep(1); \
    if ((++_sp & 255u) == 0u) { if (xb_ld(&(bar)[XB_TMO])) break; if (_sp > XB_SPIN_CAP) { atomicAdd(&(bar)[XB_TMO], 1u); break; } } } } while (0)
struct XcdBarrier { unsigned* bar; unsigned x; volatile LAS unsigned* st; };
__device__ __forceinline__ XcdBarrier xcd_barrier_post(unsigned* bar, volatile LAS unsigned* st) {
    XcdBarrier b; b.bar = bar; b.x = xb_xcc_id(); b.st = st;
    if (threadIdx.x == 0) (void)xb_add(&bar[XB_XCNT(b.x)], 1u);
    return b;
}
__device__ __forceinline__ void xcd_barrier_complete(unsigned* bar, unsigned x, unsigned& nloc, unsigned& nx) {
    const unsigned G = gridDim.x * gridDim.y * gridDim.z;
    unsigned sum, cnt, mine, sp = 0u;
    for (;;) {
        sum = 0u; cnt = 0u; mine = 0u;
#pragma unroll
        for (unsigned j = 0; j < 16; ++j) { const unsigned c = xb_ld(&bar[XB_XCNT(j)]); sum += c; cnt += (c > 0u) ? 1u : 0u; mine = (j == x) ? c : mine; }
        if (sum == G) break;
        __builtin_amdgcn_s_sleep(1);
        if ((++sp & 255u) == 0u) { if (xb_ld(&bar[XB_TMO])) break; if (sp > XB_SPIN_CAP) { atomicAdd(&bar[XB_TMO], 1u); break; } }
    }
    nloc = mine > 0u ? mine : 1u; nx = cnt > 0u ? cnt : 1u;
}
__device__ __forceinline__ void xcd_barrier(const XcdBarrier& b) {
    asm volatile("s_waitcnt vmcnt(0)" ::: "memory");
    __syncthreads();
    if (threadIdx.x == 0) {
        unsigned* bar = b.bar;
        __builtin_amdgcn_s_waitcnt(0);
        unsigned nloc = b.st[0], nx = b.st[1];
        if (nloc == 0u) { xcd_barrier_complete(bar, b.x, nloc, nx); b.st[0] = nloc; b.st[1] = nx; }
        const unsigned old = xb_add(&bar[XB_XSUB(b.x)], 1u);
        const unsigned gen = old / nloc;
        if (old + 1u == (gen + 1u) * nloc) {
            __builtin_amdgcn_fence(__ATOMIC_RELEASE, "agent");
            asm volatile("s_waitcnt vmcnt(0)" ::: "memory");
            const unsigned og = xb_add(&bar[XB_TOP], 1u);
            const unsigned tg = og / nx;
            if (og + 1u == (tg + 1u) * nx) xb_add(&bar[XB_TOPGEN], 1u);
            else XB_SPIN(xb_ld(&bar[XB_TOPGEN]) == tg, bar);
            __builtin_amdgcn_fence(__ATOMIC_ACQUIRE, "agent");
            xb_add(&bar[XB_XGEN(b.x)], 1u);
            asm volatile("s_waitcnt vmcnt(0)" ::: "memory");
        } else {
            XB_SPIN(xb_ld(&bar[XB_XGEN(b.x)]) == gen, bar);
            __builtin_amdgcn_fence(__ATOMIC_ACQUIRE, "agent");
            asm volatile("s_waitcnt vmcnt(0)" ::: "memory");
        }
    }
    __syncthreads();
}

namespace pg8 {
constexpr int BM = 256, BK = 64, HALF = 128, HTB = HALF * BK * 2, STAGE_BYTES = 8 * HTB, NXCD = 8, WGM = 8;
__host__ __device__ __forceinline__ int lds_byte(int r, int c) { const int st = (r >> 4) * 2 + (c >> 5), rr = r & 15, cc = c & 31, ob = rr * 64 + cc * 2; return st * 1024 + (ob ^ (((ob >> 9) & 1) << 5)); }
__host__ __device__ __forceinline__ void stage_rc(int b, int& R, int& C) { const int st = b / 1024, sb = b % 1024, swz = sb ^ (((sb >> 9) & 1) << 5); R = (st >> 1) * 16 + swz / 64; C = (st & 1) * 32 + (swz % 64) / 2; }
__host__ __device__ __forceinline__ int perm32(int rho) { const int n = rho >> 4, i = rho & 15; return 8 * (i >> 2) + 4 * n + (i & 3); }
struct Unit { int pm, pn; };
struct Gemm { const bf16_t* A; const bf16_t* Bt; int M, N, K, lda, ldb; int rot = 0; };
struct StaticOrder {
    int nM, nN, nwg, G, c;
    __device__ void init(int M, int N, int G_, int c_) { nM = M / BM; nN = N / BM; nwg = nM * nN; G = G_; c = c_; }
    __device__ bool next(int i, Unit& u) const {
        const long L = (long)i * G + c; if (L >= nwg) return false;
        int wgid = (int)L; { const int q = nwg / NXCD, r = nwg % NXCD, xcd = wgid % NXCD, off = wgid / NXCD; wgid = (xcd < r ? xcd * (q + 1) : r * (q + 1) + (xcd - r) * q) + off; }
        const int nig = WGM * nN, gid = wgid / nig, fm = gid * WGM, gsz = (nM - fm) < WGM ? (nM - fm) : WGM;
        u.pm = fm + ((wgid % nig) % gsz); u.pn = (wgid % nig) / gsz; return true;
    }
};
template <class Epi>
__device__ __forceinline__ void gemm_phase(LAS unsigned char* lds, const Gemm g, const Epi& E) {
    const int tid = otid(), wid = __builtin_amdgcn_readfirstlane(tid >> 6), lane = tid & 63, wr = wid >> 2, wc = wid & 3, fr = lane & 15, fq = lane >> 4;
    StaticOrder S; S.init(g.M, g.N, (int)gridDim.x, (int)((blockIdx.x + gridDim.x - (unsigned)g.rot % gridDim.x) % gridDim.x));
    int K = g.K; asm volatile("" : "+s"(K));
    const int nt = K / BK;
    unsigned voffA[2], voffB[2];
#pragma unroll
    for (int i = 0; i < 2; ++i) { int R, C; stage_rc(tid * 16 + i * 8192, R, C); const int Rb = Epi::PERM ? ((R & ~31) + perm32(R & 31)) : R;
        voffA[i] = (unsigned)(R * g.lda + C) * 2u; voffB[i] = (unsigned)(Rb * g.ldb + C) * 2u; }
    const size_t kstep = (size_t)(BK * 2);
    const size_t hstepA = (size_t)HALF * g.lda * 2, hstepB = (size_t)HALF * g.ldb * 2;
    const size_t tstepA = 2 * hstepA, tstepB = 2 * hstepB;
    const unsigned ldsw = (unsigned)wid * 1024u;
    const int aoff = lds_byte(wr * 64 + fr, fq * 8), boff = lds_byte(wc * 32 + fr, fq * 8);
#define PG8_SA(b, h) (((b) * 2 + (h)) * HTB)
#define PG8_SB(b, h) ((4 + (b) * 2 + (h)) * HTB)
#define PG8_STAGE(bufoff, gbase, voff) do { _Pragma("unroll") for (int _i = 0; _i < 2; ++_i) \
        __builtin_amdgcn_global_load_lds((const unsigned*)((const char*)(gbase) + (voff)[_i]), (LAS unsigned*)(lds + (bufoff) + ldsw + _i * 8192), 16, 0, 0); } while (0)
#define PG8_LDA(dst, b, h) do { _Pragma("unroll") for (int m = 0; m < 4; ++m) _Pragma("unroll") for (int k = 0; k < 2; ++k) dst[m][k] = *(const LAS bf16x8*)(lds + PG8_SA(b, h) + aoff + m * 2048 + k * 1024); } while (0)
#define PG8_LDB(dst, b, h) do { _Pragma("unroll") for (int n = 0; n < 2; ++n) _Pragma("unroll") for (int k = 0; k < 2; ++k) dst[n][k] = *(const LAS bf16x8*)(lds + PG8_SB(b, h) + boff + n * 2048 + k * 1024); } while (0)
#define PG8_MMA(ai, bj, At, Bt) do { __builtin_amdgcn_s_setprio(1); _Pragma("unroll") for (int m = 0; m < 4; ++m) _Pragma("unroll") for (int n = 0; n < 2; ++n) _Pragma("unroll") for (int k = 0; k < 2; ++k) \
        acc[ai][bj][m][n] = __builtin_amdgcn_mfma_f32_16x16x32_bf16(Bt[n][k], At[m][k], acc[ai][bj][m][n], 0, 0, 0); __builtin_amdgcn_s_setprio(0); } while (0)
#define PG8_WAIT_V(n) asm volatile("s_waitcnt vmcnt(" #n ")" ::: "memory")
#define PG8_WAIT_L(n) asm volatile("s_waitcnt lgkmcnt(" #n ")" ::: "memory")
#define PG8_BAR __builtin_amdgcn_s_barrier()
#define PG8_SCHED __builtin_amdgcn_sched_barrier(0)
    Unit cur, nxt; int ui = 0;
    if (!S.next(0, cur)) return;
    f32x4 acc[2][2][4][2];
#pragma unroll
    for (int a = 0; a < 2; ++a)
#pragma unroll
        for (int b = 0; b < 2; ++b)
#pragma unroll
            for (int m = 0; m < 4; ++m)
#pragma unroll
                for (int n = 0; n < 2; ++n) acc[a][b][m][n] = (f32x4){0.f, 0.f, 0.f, 0.f};
    bf16x8 At[4][2], B0[2][2], B1[2][2];
    const char* cA = (const char*)g.A + (size_t)cur.pm * tstepA; const char* cB = (const char*)g.Bt + (size_t)cur.pn * tstepB;
    PG8_STAGE(PG8_SB(0, 0), cB, voffB); PG8_STAGE(PG8_SB(0, 1), cB + hstepB, voffB); PG8_STAGE(PG8_SA(0, 0), cA, voffA); PG8_STAGE(PG8_SA(0, 1), cA + hstepA, voffA);
    if (wr == 1) PG8_BAR;
    PG8_WAIT_V(2); PG8_BAR;
    PG8_STAGE(PG8_SB(1, 0), cB + kstep, voffB); PG8_STAGE(PG8_SA(1, 0), cA + kstep, voffA); PG8_STAGE(PG8_SB(1, 1), cB + hstepB + kstep, voffB);
    PG8_WAIT_V(6); PG8_BAR;
    for (;;) {
        const bool has_next = S.next(ui + 1, nxt);
        const char* nA = has_next ? (const char*)g.A + (size_t)nxt.pm * tstepA : cA; const char* nB = has_next ? (const char*)g.Bt + (size_t)nxt.pn * tstepB : cB;
        for (int t = 0; t < nt; t += 2) {
            const bool last = (t == nt - 2);
            const char* a1 = cA + (size_t)(t + 1) * kstep;
            const char* a2 = last ? nA : cA + (size_t)(t + 2) * kstep; const char* b2 = last ? nB : cB + (size_t)(t + 2) * kstep;
            const char* a3 = a2 + kstep; const char* b3 = b2 + kstep;
            PG8_LDB(B0, 0, 0); PG8_LDB(B1, 0, 1); PG8_SCHED; PG8_LDA(At, 0, 0); PG8_STAGE(PG8_SA(1, 1), a1 + hstepA, voffA);
            PG8_WAIT_V(8); PG8_WAIT_L(0); PG8_BAR; PG8_MMA(0, 0, At, B0); PG8_MMA(0, 1, At, B1); PG8_BAR; PG8_SCHED;
            PG8_LDA(At, 0, 1); PG8_STAGE(PG8_SB(0, 0), b2, voffB); PG8_STAGE(PG8_SB(0, 1), b2 + hstepB, voffB); PG8_STAGE(PG8_SA(0, 0), a2, voffA);
            PG8_WAIT_V(8); PG8_WAIT_L(0); PG8_BAR; PG8_MMA(1, 0, At, B0); PG8_MMA(1, 1, At, B1); PG8_BAR; PG8_SCHED;
            PG8_LDB(B0, 1, 0); PG8_LDB(B1, 1, 1); PG8_SCHED; PG8_LDA(At, 1, 0); PG8_STAGE(PG8_SA(0, 1), a2 + hstepA, voffA);
            PG8_WAIT_V(8); PG8_WAIT_L(0); PG8_BAR; PG8_MMA(0, 0, At, B0); PG8_MMA(0, 1, At, B1); PG8_BAR; PG8_SCHED;
            PG8_LDA(At, 1, 1); PG8_STAGE(PG8_SB(1, 0), b3, voffB); PG8_STAGE(PG8_SB(1, 1), b3 + hstepB, voffB); PG8_STAGE(PG8_SA(1, 0), a3, voffA);
            PG8_WAIT_V(8); PG8_WAIT_L(0); PG8_BAR; PG8_MMA(1, 0, At, B0); PG8_MMA(1, 1, At, B1); PG8_BAR; PG8_SCHED;
        }
        if (wr == 0) PG8_BAR;
        { const int l2_ = otid() & 63; E(acc, cur, wr, wc, l2_ & 15, l2_ >> 4); }
        if (!has_next) break;
#pragma unroll
        for (int a = 0; a < 2; ++a)
#pragma unroll
            for (int b = 0; b < 2; ++b)
#pragma unroll
                for (int m = 0; m < 4; ++m)
#pragma unroll
                    for (int n = 0; n < 2; ++n) acc[a][b][m][n] = (f32x4){0.f, 0.f, 0.f, 0.f};
        cur = nxt; cA = nA; cB = nB; ++ui;
        if (wr == 1) PG8_BAR;
    }
    PG8_WAIT_V(0);
    PG8_BAR;
#undef PG8_SA
#undef PG8_SB
#undef PG8_STAGE
#undef PG8_LDA
#undef PG8_LDB
#undef PG8_MMA
#undef PG8_WAIT_V
#undef PG8_WAIT_L
#undef PG8_BAR
#undef PG8_SCHED
}

template <int ACT> struct EpiBf16 {
    static constexpr bool PERM = true;
    bf16_t* O; int ldc;
    __device__ __forceinline__ void operator()(const f32x4 (&acc)[2][2][4][2], const Unit& u, int wr, int wc, int fr, int fq) const {
        const int row0 = u.pm * BM + wr * 64 + fr, col0 = u.pn * BM + wc * 32 + 8 * fq;
#pragma unroll
        for (int ai = 0; ai < 2; ++ai)
#pragma unroll
            for (int m = 0; m < 4; ++m) { bf16_t* rowp = O + (size_t)(row0 + ai * HALF + m * 16) * ldc + col0;
#pragma unroll
                for (int bj = 0; bj < 2; ++bj) { f32x4 v0 = acc[ai][bj][m][0], v1 = acc[ai][bj][m][1];
                    if (ACT == 1) { f32x2 a = gelu_pk((f32x2){v0[0], v0[1]}), b = gelu_pk((f32x2){v0[2], v0[3]}), c = gelu_pk((f32x2){v1[0], v1[1]}), d = gelu_pk((f32x2){v1[2], v1[3]});
                        v0 = (f32x4){a.x, a.y, b.x, b.y}; v1 = (f32x4){c.x, c.y, d.x, d.y}; }
                    u32x4 w; w.x = cvt_pk_bf16(v0[0], v0[1]); w.y = cvt_pk_bf16(v0[2], v0[3]); w.z = cvt_pk_bf16(v1[0], v1[1]); w.w = cvt_pk_bf16(v1[2], v1[3]);
                    *(u32x4*)(rowp + bj * HALF) = w; } }
    }
};
struct EpiGmIn {
    static constexpr bool PERM = true;
    bf16_t* O; float* parts;
    __device__ __forceinline__ void operator()(const f32x4 (&acc)[2][2][4][2], const Unit& u, int wr, int wc, int fr, int fq) const {
        const int row0 = u.pm * BM + wr * 64 + fr, col0 = u.pn * BM + wc * 32 + 8 * fq; const bool vhalf = u.pn >= 8;
#pragma unroll
        for (int ai = 0; ai < 2; ++ai)
#pragma unroll
            for (int m = 0; m < 4; ++m) { const int row = row0 + ai * HALF + m * 16; bf16_t* rowp = O + (size_t)row * 4096 + col0; f32x2 sa = {0.f, 0.f}, sq = {0.f, 0.f};
#pragma unroll
                for (int bj = 0; bj < 2; ++bj) { const f32x4 v0 = acc[ai][bj][m][0], v1 = acc[ai][bj][m][1];
                    const f32x2 a = gelu_pk((f32x2){v0[0], v0[1]}), b = gelu_pk((f32x2){v0[2], v0[3]}), c = gelu_pk((f32x2){v1[0], v1[1]}), d = gelu_pk((f32x2){v1[2], v1[3]});
                    sa += (a + b) + (c + d); sq += (a * a + b * b) + (c * c + d * d);
                    u32x4 w; w.x = cvt_pk_bf16(a.x, a.y); w.y = cvt_pk_bf16(b.x, b.y); w.z = cvt_pk_bf16(c.x, c.y); w.w = cvt_pk_bf16(d.x, d.y);
                    *(u32x4*)(rowp + bj * HALF) = w; }
                if (vhalf) { float s1 = sa.x + sa.y, s2 = sq.x + sq.y;
                    { auto r = __builtin_amdgcn_permlane16_swap(__float_as_uint(s1), __float_as_uint(s1), false, false); s1 = __uint_as_float(r[0]) + __uint_as_float(r[1]); }
                    { auto r = __builtin_amdgcn_permlane16_swap(__float_as_uint(s2), __float_as_uint(s2), false, false); s2 = __uint_as_float(r[0]) + __uint_as_float(r[1]); }
                    { auto r = __builtin_amdgcn_permlane32_swap(__float_as_uint(s1), __float_as_uint(s1), false, false); s1 = __uint_as_float(r[0]) + __uint_as_float(r[1]); }
                    { auto r = __builtin_amdgcn_permlane32_swap(__float_as_uint(s2), __float_as_uint(s2), false, false); s2 = __uint_as_float(r[0]) + __uint_as_float(r[1]); }
                    if (fq == 0) *(f32x2*)(parts + ((size_t)row * 32 + (u.pn - 8) * 4 + wc) * 2) = (f32x2){s1, s2}; } }
    }
};
struct EpiResid {
    static constexpr bool PERM = true;
    bf16_t* X; const float* gate;
    __device__ __forceinline__ void operator()(const f32x4 (&acc)[2][2][4][2], const Unit& u, int wr, int wc, int fr, int fq) const {
        const int rbase = u.pm * BM;
        const float* gp = gate + (size_t)(rbase < NLAT ? (rbase >> 13) : 4) * 6144;
        const int row0 = rbase + wr * 64 + fr, col0 = u.pn * BM + wc * 32 + 8 * fq;
        f32x4 gv[2][2];
#pragma unroll
        for (int bj = 0; bj < 2; ++bj)
#pragma unroll
            for (int n = 0; n < 2; ++n) gv[bj][n] = *(const f32x4*)(gp + col0 + bj * HALF + n * 4);
#pragma unroll
        for (int ai = 0; ai < 2; ++ai)
#pragma unroll
            for (int m = 0; m < 4; ++m) { bf16_t* rowp = X + (size_t)(row0 + ai * HALF + m * 16) * D + col0;
#pragma unroll
                for (int bj = 0; bj < 2; ++bj) { u32x4* p = (u32x4*)(rowp + bj * HALF); const u32x4 x = *p;
                    const f32x4 a0 = (f32x4){bflo(x.x), bfhi(x.x), bflo(x.y), bfhi(x.y)} + gv[bj][0] * acc[ai][bj][m][0], a1 = (f32x4){bflo(x.z), bfhi(x.z), bflo(x.w), bfhi(x.w)} + gv[bj][1] * acc[ai][bj][m][1];
                    u32x4 w; w.x = cvt_pk_bf16(a0[0], a0[1]); w.y = cvt_pk_bf16(a0[2], a0[3]); w.z = cvt_pk_bf16(a1[0], a1[1]); w.w = cvt_pk_bf16(a1[2], a1[3]);
                    *p = w; } }
    }
};
}

namespace att {
#define KSWZ(row, colB) ((row) * 256 + ((colB) ^ (((row) & 7) << 4)))
#define KRSWZ(row, colB) ((row) * 128 + ((colB) ^ ((((row) >> 1) & 7) << 4)))
#define SBAR() __builtin_amdgcn_sched_barrier(0)
__device__ __forceinline__ int crow(int r, int hi) { return (r & 3) + 8 * (r >> 2) + 4 * hi; }
__host__ __device__ __forceinline__ int v_st(int k, int c) { const int kk = (k & ~0xC) | ((k & 4) << 1) | ((k & 8) >> 1); return ((kk >> 3) * 4 + (c >> 5)) * 512 + ((kk & 7) * 32 + (c & 31)) * 2; }
__device__ __forceinline__ int v_rd_base(int lane) { return ((lane & 3) << 3) | (((lane >> 2) & 3) << 6) | (((lane >> 4) & 1) << 5) | (((lane >> 5) & 1) << 8); }
constexpr int v_rd_off(int d0, int ks, int half) { return d0 * 512 + ks * 4096 + half * 2048; }
template <int OFF> __device__ __forceinline__ s16x4 tr_read(int vb) {
    s16x4 r; asm volatile("ds_read_b64_tr_b16 %0, %1 offset:%2" : "=&v"(r) : "v"(vb), "i"(OFF) : "memory"); return r;
}
template <int D0> __device__ __forceinline__ void pv_one(f32x16& od, int vb, bf16x8 pa0, bf16x8 pa1, bf16x8 pa2, bf16x8 pa3) {
    const s16x4 l0 = tr_read<v_rd_off(D0, 0, 0)>(vb), h0 = tr_read<v_rd_off(D0, 0, 1)>(vb), l1 = tr_read<v_rd_off(D0, 1, 0)>(vb), h1 = tr_read<v_rd_off(D0, 1, 1)>(vb);
    const s16x4 l2 = tr_read<v_rd_off(D0, 2, 0)>(vb), h2 = tr_read<v_rd_off(D0, 2, 1)>(vb), l3 = tr_read<v_rd_off(D0, 3, 0)>(vb), h3 = tr_read<v_rd_off(D0, 3, 1)>(vb);
    asm volatile("s_waitcnt lgkmcnt(0)" ::: "memory"); SBAR();
#define PK(L, H) (bf16x8){L[0], L[1], L[2], L[3], H[0], H[1], H[2], H[3]}
    od = __builtin_amdgcn_mfma_f32_32x32x16_bf16(pa0, PK(l0, h0), od, 0, 0, 0);
    od = __builtin_amdgcn_mfma_f32_32x32x16_bf16(pa1, PK(l1, h1), od, 0, 0, 0);
    od = __builtin_amdgcn_mfma_f32_32x32x16_bf16(pa2, PK(l2, h2), od, 0, 0, 0);
    od = __builtin_amdgcn_mfma_f32_32x32x16_bf16(pa3, PK(l3, h3), od, 0, 0, 0);
#undef PK
}
__device__ __forceinline__ void pv_d0(f32x16* o, int vb, bf16x8 pa0, bf16x8 pa1, bf16x8 pa2, bf16x8 pa3) {
    pv_one<0>(o[0], vb, pa0, pa1, pa2, pa3); pv_one<1>(o[1], vb, pa0, pa1, pa2, pa3); pv_one<2>(o[2], vb, pa0, pa1, pa2, pa3); pv_one<3>(o[3], vb, pa0, pa1, pa2, pa3);
}
}

namespace att8 {
constexpr int SLOT = 20480, KN_OFF = 0, KR_OFF = 8192, V_OFF = 12288, LDS_BYTES = 3 * SLOT + 8 * 256;
constexpr float THR2 = 8.0f;
constexpr float QUP = 8.f; constexpr int SC_ONE = 0x7f7f7f7f, SC_Q = 0x7c7c7c7c;
__host__ __device__ __forceinline__ int kn8(int key, int b) { return key * 128 + ((((b >> 4) ^ ((key >> 1) & 7))) << 4) + (b & 15); }
__host__ __device__ __forceinline__ int kr8(int key, int b) { return key * 64 + ((((b >> 4) ^ ((key >> 2) & 3))) << 4) + (b & 15); }
__host__ __device__ __forceinline__ int vslot(int k) { return 32 * ((k >> 2) & 1) + 16 * (k >> 5) + (k & 3) + 4 * ((k & 31) >> 3); }
__host__ __device__ __forceinline__ int v8(int d, int k) { const int sl = vslot(k); return d * 64 + ((((sl >> 4) ^ ((d >> 2) & 3))) << 4) + (sl & 15); }
__device__ __forceinline__ i32x8 ld32(const LAS unsigned char* a0, const LAS unsigned char* a1) { const u32x4 x = *(const LAS u32x4*)a0, y = *(const LAS u32x4*)a1;
    return (i32x8){(int)x.x, (int)x.y, (int)x.z, (int)x.w, (int)y.x, (int)y.y, (int)y.z, (int)y.w}; }
__device__ __forceinline__ void qkt(f32x16& p0, f32x16& p1, LAS unsigned char* slot, const i32x8* qf, int r32, int hi) {
    p0 = f32x16{}; p1 = f32x16{};
#pragma unroll
    for (int ks = 0; ks < 2; ++ks) { const int b = 64 * ks + 32 * hi;
        const i32x8 a0 = ld32(slot + KN_OFF + kn8(r32, b), slot + KN_OFF + kn8(r32, b + 16)), a1 = ld32(slot + KN_OFF + kn8(32 + r32, b), slot + KN_OFF + kn8(32 + r32, b + 16));
        p0 = __builtin_amdgcn_mfma_scale_f32_32x32x64_f8f6f4(a0, qf[ks], p0, 0, 0, 0, SC_ONE, 0, SC_Q);
        p1 = __builtin_amdgcn_mfma_scale_f32_32x32x64_f8f6f4(a1, qf[ks], p1, 0, 0, 0, SC_ONE, 0, SC_Q); }
    { const int b = 32 * hi;
        const i32x8 a0 = ld32(slot + KR_OFF + kr8(r32, b), slot + KR_OFF + kr8(r32, b + 16)), a1 = ld32(slot + KR_OFF + kr8(32 + r32, b), slot + KR_OFF + kr8(32 + r32, b + 16));
        p0 = __builtin_amdgcn_mfma_scale_f32_32x32x64_f8f6f4(a0, qf[2], p0, 0, 0, 0, SC_ONE, 0, SC_Q);
        p1 = __builtin_amdgcn_mfma_scale_f32_32x32x64_f8f6f4(a1, qf[2], p1, 0, 0, 0, SC_ONE, 0, SC_Q); }
}
__device__ __forceinline__ void partialSM(f32x16& p0, f32x16& p1, float& m_reg, float& mn, float& alpha) {
    float pmax = p0[0];
#pragma unroll
    for (int r = 1; r < 16; ++r) pmax = fmaxf(pmax, p0[r]);
#pragma unroll
    for (int r = 0; r < 16; ++r) pmax = fmaxf(pmax, p1[r]);
    { auto rr = __builtin_amdgcn_permlane32_swap(__float_as_uint(pmax), __float_as_uint(pmax), false, false);
      pmax = fmaxf(__uint_as_float(rr[0]), __uint_as_float(rr[1])); }
    if (__builtin_expect(__all(pmax - m_reg <= THR2), 1)) { mn = m_reg; alpha = 1.f; }
    else { mn = fmaxf(m_reg, pmax); alpha = __builtin_amdgcn_exp2f(m_reg - mn); m_reg = mn; }
#pragma unroll
    for (int r = 0; r < 16; ++r) p0[r] = __builtin_amdgcn_exp2f(p0[r] - mn);
#pragma unroll
    for (int r = 0; r < 16; ++r) p1[r] = p1[r] - mn;
}
__device__ __forceinline__ void finishSM(f32x16& p0, f32x16& p1, float alpha, float& l_reg, i32x8& pf) {
#pragma unroll
    for (int r = 0; r < 16; ++r) p1[r] = __builtin_amdgcn_exp2f(p1[r]);
    float ps = 0;
#pragma unroll
    for (int r = 0; r < 16; ++r) ps += p0[r];
#pragma unroll
    for (int r = 0; r < 16; ++r) ps += p1[r];
    { auto rr = __builtin_amdgcn_permlane32_swap(__float_as_uint(ps), __float_as_uint(ps), false, false);
      ps = __uint_as_float(rr[0]) + __uint_as_float(rr[1]); }
    l_reg = l_reg * alpha + ps;
#pragma unroll
    for (int w = 0; w < 4; ++w) { pf[w] = (int)pk4_fp8(p0[4 * w], p0[4 * w + 1], p0[4 * w + 2], p0[4 * w + 3]); pf[4 + w] = (int)pk4_fp8(p1[4 * w], p1[4 * w + 1], p1[4 * w + 2], p1[4 * w + 3]); }
}
__device__ __forceinline__ void pv(f32x16* o, LAS unsigned char* slot, const i32x8 pf, int r32, int hi) {
#pragma unroll
    for (int d0 = 0; d0 < 4; ++d0) { const int d = 32 * d0 + r32, sw = (d >> 2) & 3;
        const i32x8 b = ld32(slot + V_OFF + d * 64 + (((2 * hi) ^ sw) << 4), slot + V_OFF + d * 64 + (((2 * hi + 1) ^ sw) << 4));
        o[d0] = __builtin_amdgcn_mfma_scale_f32_32x32x64_f8f6f4(pf, b, o[d0], 0, 0, 0, SC_ONE, 0, SC_ONE); }
}
__device__ __forceinline__ int crow(int r, int hi) { return (r & 3) + 8 * (r >> 2) + 4 * hi; }
__device__ __forceinline__ void attn_unit(const unsigned char* __restrict__ Qb, const unsigned char* __restrict__ KNt, const unsigned char* __restrict__ KRt, const unsigned char* __restrict__ Vt,
                                          bf16_t* __restrict__ Ob, int NT, LAS unsigned char* lds) {
    const int tid = otid(), wid = __builtin_amdgcn_readfirstlane(tid >> 6), lane = tid & 63, r32 = lane & 31, hi = lane >> 5;
    LAS float* wsf = (LAS float*)(lds + 3 * SLOT) + wid * 64; LAS float* li_l = wsf; LAS float* al_l = wsf + 32;
    float m_reg = -1e30f, l_reg = 0; f32x16 o[4] = {}; i32x8 qf[3];
    const unsigned char* Qw = Qb + (size_t)(wid * 32 + r32) * 192 + 32 * hi;
#pragma unroll
    for (int ks = 0; ks < 3; ++ks) { const u32x4 x = *(const u32x4*)(Qw + 64 * ks), y = *(const u32x4*)(Qw + 64 * ks + 16); qf[ks] = (i32x8){(int)x.x, (int)x.y, (int)x.z, (int)x.w, (int)y.x, (int)y.y, (int)y.z, (int)y.w}; }
    const unsigned lo16 = (unsigned)lane * 16u;
#define ATT_DMA(tile, slotoff) do { const size_t t_ = (size_t)(tile); LAS unsigned char* sl_ = lds + (slotoff); \
        __builtin_amdgcn_global_load_lds((const unsigned*)(KNt + t_ * 8192 + wid * 1024 + lo16), (LAS unsigned*)(sl_ + KN_OFF + wid * 1024), 16, 0, 0); \
        __builtin_amdgcn_global_load_lds((const unsigned*)(Vt + t_ * 8192 + wid * 1024 + lo16), (LAS unsigned*)(sl_ + V_OFF + wid * 1024), 16, 0, 0); \
        if (wid < 4) __builtin_amdgcn_global_load_lds((const unsigned*)(KRt + t_ * 4096 + wid * 1024 + lo16), (LAS unsigned*)(sl_ + KR_OFF + wid * 1024), 16, 0, 0); } while (0)
#define ATT_SYNC() do { asm volatile("s_waitcnt vmcnt(0)" ::: "memory"); __builtin_amdgcn_s_barrier(); asm volatile("" ::: "memory"); } while (0)
#define RESC(a) do { if (__any((a) < 1.f)) { if (hi == 0) al_l[r32] = (a); asm volatile("s_waitcnt lgkmcnt(0)" ::: "memory"); \
        _Pragma("unroll") for (int d = 0; d < 4; ++d) _Pragma("unroll") for (int r = 0; r < 16; ++r) o[d][r] *= al_l[crow(r, hi)]; } } while (0)
    f32x16 pA0, pA1, pB0, pB1; float mnA, mnB, alA, alB; i32x8 pf;
    int sp = 0, sc = SLOT, sn = 2 * SLOT;
    ATT_DMA(0, 0);
    ATT_SYNC();
    ATT_DMA(1, SLOT);
    qkt(pA0, pA1, lds, qf, r32, hi); partialSM(pA0, pA1, m_reg, mnA, alA);
    for (int j = 1; j + 1 < NT; j += 2) {
        ATT_SYNC(); ATT_DMA(j + 1, sn);
        SBAR(); qkt(pB0, pB1, lds + sc, qf, r32, hi);
        finishSM(pA0, pA1, alA, l_reg, pf); SBAR();
        pv(o, lds + sp, pf, r32, hi); partialSM(pB0, pB1, m_reg, mnB, alB);
        RESC(alB);
        { const int t_ = sp; sp = sc; sc = sn; sn = t_; }
        ATT_SYNC(); if (j + 2 < NT) ATT_DMA(j + 2, sn);
        SBAR(); qkt(pA0, pA1, lds + sc, qf, r32, hi);
        finishSM(pB0, pB1, alB, l_reg, pf); SBAR();
        pv(o, lds + sp, pf, r32, hi); partialSM(pA0, pA1, m_reg, mnA, alA);
        RESC(alA);
        { const int t_ = sp; sp = sc; sc = sn; sn = t_; }
    }
    ATT_SYNC();
    SBAR(); qkt(pB0, pB1, lds + sc, qf, r32, hi);
    finishSM(pA0, pA1, alA, l_reg, pf); SBAR();
    pv(o, lds + sp, pf, r32, hi); partialSM(pB0, pB1, m_reg, mnB, alB);
    RESC(alB);
    finishSM(pB0, pB1, alB, l_reg, pf); SBAR();
    pv(o, lds + sc, pf, r32, hi);
    if (hi == 0) li_l[r32] = l_reg; asm volatile("s_waitcnt lgkmcnt(0)" ::: "memory");
    float rli[16];
#pragma unroll
    for (int r = 0; r < 16; ++r) rli[r] = __builtin_amdgcn_rcpf(li_l[crow(r, hi)]);
    bf16_t* Ow = Ob + (size_t)(wid * 32) * 2048;
#pragma unroll
    for (int r = 0; r < 16; ++r) { const int orow = crow(r, hi);
#pragma unroll
        for (int d0 = 0; d0 < 4; ++d0) Ow[(size_t)orow * 2048 + d0 * 32 + r32] = f2bf(o[d0][r] * rli[r]); }
    __builtin_amdgcn_s_barrier(); asm volatile("" ::: "memory");
#undef ATT_DMA
#undef ATT_SYNC
#undef RESC
}
}

namespace ssd {
constexpr int XT_OFF = 0, BT_OFF = 17408, HB_OFF = 52224, SET = 69632, CW_OFF = 2 * SET, LDS_BYTES = CW_OFF + 8 * 1536;
constexpr int PITCH = 272;
constexpr float L2E = 1.4426950408889634f;
__device__ __forceinline__ void g_unit(const bf16_t* __restrict__ BC, bf16_t* __restrict__ G, int unit) {
    const int cid = unit >> 1, g = unit & 1;
    const int r0 = cid < 256 ? cid * 128 : NLAT + (cid - 256) * 128;
    const int tid = otid(), wid = tid >> 6, lane = tid & 63, fr = lane & 15, fq = lane >> 4;
    const bf16_t* Cp = BC + (size_t)(r0 + 16 * wid + fr) * 512 + 256 + 128 * g + 8 * fq;
    bf16x8 cf[4];
#pragma unroll
    for (int ks = 0; ks < 4; ++ks) cf[ks] = *(const bf16x8*)(Cp + 32 * ks);
    bf16_t* Gp = G + ((size_t)unit * 128 + 16 * wid + fr) * 128 + 4 * fq;
#pragma unroll
    for (int sb = 0; sb < 8; ++sb) {
        const bf16_t* Bp = BC + (size_t)(r0 + 16 * sb + fr) * 512 + 128 * g + 8 * fq;
        f32x4 acc = {0.f, 0.f, 0.f, 0.f};
#pragma unroll
        for (int ks = 0; ks < 4; ++ks) { const bf16x8 bfr = *(const bf16x8*)(Bp + 32 * ks); acc = __builtin_amdgcn_mfma_f32_16x16x32_bf16(bfr, cf[ks], acc, 0, 0, 0); }
        u32x2 w; w.x = cvt_pk_bf16(acc[0], acc[1]); w.y = cvt_pk_bf16(acc[2], acc[3]);
        *(u32x2*)(Gp + 16 * sb) = w;
    }
}
__device__ __forceinline__ void ssd_unit(int b, int h, int d, const bf16_t* __restrict__ XS, const bf16_t* __restrict__ BC, const float* __restrict__ DT, const bf16_t* __restrict__ G,
                                         const float* __restrict__ a_log, bf16_t* __restrict__ Y, LAS unsigned char* lds) {
    const int g = h >> 3;
    const int tid = otid(), wid = tid >> 6, lane = tid & 63, fr = lane & 15, fq = lane >> 4;
    const float a = -__expf(a_log[d * 16 + h]);
    LAS float* cw = (LAS float*)(lds + CW_OFF + wid * 1536); LAS float* dts = cw + 128; LAS float* dtw = cw + 256;
    f32x4 hs[4];
#pragma unroll
    for (int q = 0; q < 4; ++q) hs[q] = (f32x4){0.f, 0.f, 0.f, 0.f};
    for (int i = tid; i < 17408 / 4; i += 512) ((LAS unsigned*)(lds + HB_OFF))[i] = 0u;
    float cend = 0.f;
#define SSD_ROWS(step, r0v, gidv) do { if ((step) < 2) { const int oc_ = d ? 1 - (step) : (step); r0v = NLAT + b * 256 + oc_ * 128; gidv = 256 + b * 2 + oc_; } \
        else { const int lc_ = (step) - 2, oc_ = d ? 63 - lc_ : lc_; r0v = b * 8192 + oc_ * 128; gidv = b * 64 + oc_; } } while (0)
    const int sg = tid & 31, n8 = tid >> 5, p4 = tid >> 5;
    f32x2 P_da, Q_da; u32x2 P_xv[4], Q_xv[4]; u32x4 P_bv[4], Q_bv[4], n_gv[4], n_cv[4], c_gv[4], c_cv[4];
#define SSD_LOAD(step, X) do { int r0_, gid_; SSD_ROWS(step, r0_, gid_); (void)gid_; X##_da = *(const f32x2*)(DT + (size_t)(d * 16 + h) * NROW + r0_ + 2 * lane); \
        _Pragma("unroll") for (int j_ = 0; j_ < 4; ++j_) { X##_xv[j_] = *(const u32x2*)(XS + (size_t)(r0_ + 4 * sg + j_) * 1024 + 64 * h + 4 * p4); \
                                                         X##_bv[j_] = *(const u32x4*)(BC + (size_t)(r0_ + 4 * sg + j_) * 512 + 128 * g + 8 * n8); } } while (0)
#define SSD_LOADGC(step) do { int r0_, gid_; SSD_ROWS(step, r0_, gid_); const int t_ = 16 * wid + fr; const bf16_t* Gp_ = G + ((size_t)(gid_ * 2 + g) * 128 + t_) * 128 + 8 * fq; const bf16_t* Cp_ = BC + (size_t)(r0_ + t_) * 512 + 256 + 128 * g + 8 * fq; \
          _Pragma("unroll") for (int ks_ = 0; ks_ < 4; ++ks_) { n_gv[ks_] = *(const u32x4*)(Gp_ + 32 * ks_); n_cv[ks_] = *(const u32x4*)(Cp_ + 32 * ks_); } } while (0)
#define SSD_GCROT() do { _Pragma("unroll") for (int ks_ = 0; ks_ < 4; ++ks_) { c_gv[ks_] = n_gv[ks_]; c_cv[ks_] = n_cv[ks_]; } } while (0)
#define SSD_WRITE(step, X) do { LAS unsigned char* set_ = lds + ((step) & 1) * SET; \
        const float da0 = X##_da.x * a, da1 = X##_da.y * a; \
        float sc_ = da0 + da1; float c0_, c1_; \
        if (d == 0) { _Pragma("unroll") for (int o_ = 1; o_ < 64; o_ <<= 1) { const float t_ = __shfl_up(sc_, o_); if (lane >= o_) sc_ += t_; } \
            c0_ = sc_ - da1; c1_ = sc_; cend = __shfl(sc_, 63); } \
        else { _Pragma("unroll") for (int o_ = 1; o_ < 64; o_ <<= 1) { const float t_ = __shfl_down(sc_, o_); if (lane + o_ < 64) sc_ += t_; } \
            c0_ = sc_; c1_ = sc_ - da0; cend = __shfl(sc_, 0); } \
        *(LAS f32x2*)(cw + 2 * lane) = (f32x2){c0_, c1_}; *(LAS f32x2*)(dts + 2 * lane) = X##_da; \
        *(LAS f32x2*)(dtw + 2 * lane) = (f32x2){X##_da.x * __builtin_amdgcn_exp2f((cend - c0_) * L2E), X##_da.y * __builtin_amdgcn_exp2f((cend - c1_) * L2E)}; \
        { LAS unsigned char* xt_ = set_ + XT_OFF + (4 * p4) * PITCH + 8 * sg; \
          _Pragma("unroll") for (int i_ = 0; i_ < 4; ++i_) { unsigned e_[4]; \
              _Pragma("unroll") for (int j_ = 0; j_ < 4; ++j_) { const unsigned w_ = (i_ & 2) ? X##_xv[j_].y : X##_xv[j_].x; e_[j_] = (i_ & 1) ? (w_ >> 16) : (w_ & 0xffffu); } \
              u32x2 o_; o_.x = e_[0] | (e_[1] << 16); o_.y = e_[2] | (e_[3] << 16); *(LAS u32x2*)(xt_ + i_ * PITCH) = o_; } } \
        { LAS unsigned char* bt_ = set_ + BT_OFF + (8 * n8) * PITCH + 8 * sg; \
          _Pragma("unroll") for (int i_ = 0; i_ < 8; ++i_) { unsigned e_[4]; \
              _Pragma("unroll") for (int j_ = 0; j_ < 4; ++j_) { const unsigned w_ = X##_bv[j_][i_ >> 1]; e_[j_] = (i_ & 1) ? (w_ >> 16) : (w_ & 0xffffu); } \
              u32x2 o_; o_.x = e_[0] | (e_[1] << 16); o_.y = e_[2] | (e_[3] << 16); *(LAS u32x2*)(bt_ + i_ * PITCH) = o_; } } \
        asm volatile("s_waitcnt lgkmcnt(0)" ::: "memory"); \
    } while (0)
    SSD_LOAD(0, Q); SSD_LOADGC(0); SSD_WRITE(0, Q); SSD_LOAD(1, P);
    for (int step2 = 0; step2 < 66; step2 += 2)
#pragma unroll
    for (int par = 0; par < 2; ++par) {
        const int step = step2 + par;
        __syncthreads();
        int r0, gid; SSD_ROWS(step, r0, gid); (void)gid;
        LAS unsigned char* set = lds + (step & 1) * SET;
        const float cend_cur = cend;
        SSD_GCROT();
        if (step + 1 < 66) SSD_LOADGC(step + 1);
        if (step + 2 < 66) { if (par == 0) SSD_LOAD(step + 2, Q); else SSD_LOAD(step + 2, P); }
        {
            const int t = 16 * wid + fr; const float ct = cw[t];
            f32x4 y[4];
#pragma unroll
            for (int q = 0; q < 4; ++q) y[q] = (f32x4){0.f, 0.f, 0.f, 0.f};
            const float et = __builtin_amdgcn_exp2f(ct * L2E);
#pragma unroll
            for (int ks = 0; ks < 4; ++ks) {
                const bool live = d == 0 ? (32 * ks <= 16 * wid + 15) : (32 * ks + 31 >= 16 * wid);
                if (live) {
                    const int s0 = 32 * ks + 8 * fq;
                    const f32x4 c0 = *(const LAS f32x4*)(cw + s0), c1 = *(const LAS f32x4*)(cw + s0 + 4), d0v = *(const LAS f32x4*)(dts + s0), d1v = *(const LAS f32x4*)(dts + s0 + 4);
                    float m[8];
#pragma unroll
                    for (int i = 0; i < 8; ++i) { const float cs = i < 4 ? c0[i & 3] : c1[i & 3], dv = i < 4 ? d0v[i & 3] : d1v[i & 3]; const int s = s0 + i;
                        const bool ok = d == 0 ? (s <= t) : (s >= t);
                        const float gval = (i & 1) ? bfhi(c_gv[ks][i >> 1]) : bflo(c_gv[ks][i >> 1]);
                        m[i] = ok ? gval * dv * __builtin_amdgcn_exp2f((ct - cs) * L2E) : 0.f; }
                    u32x4 mw; mw.x = cvt_pk_bf16(m[0], m[1]); mw.y = cvt_pk_bf16(m[2], m[3]); mw.z = cvt_pk_bf16(m[4], m[5]); mw.w = cvt_pk_bf16(m[6], m[7]);
                    const bf16x8 mb = __builtin_bit_cast(bf16x8, mw);
#pragma unroll
                    for (int q = 0; q < 4; ++q) { const bf16x8 af = *(const LAS bf16x8*)(set + XT_OFF + (16 * q + fr) * PITCH + (32 * ks + 8 * fq) * 2);
                        y[q] = __builtin_amdgcn_mfma_f32_16x16x32_bf16(af, mb, y[q], 0, 0, 0); }
                }
            }
#pragma unroll
            for (int ks = 0; ks < 4; ++ks) {
                u32x4 cwv;
#pragma unroll
                for (int i = 0; i < 4; ++i) cwv[i] = cvt_pk_bf16(bflo(c_cv[ks][i]) * et, bfhi(c_cv[ks][i]) * et);
                const bf16x8 cb = __builtin_bit_cast(bf16x8, cwv);
#pragma unroll
                for (int q = 0; q < 4; ++q) { const bf16x8 af = *(const LAS bf16x8*)(set + HB_OFF + (16 * q + fr) * PITCH + (32 * ks + 8 * fq) * 2);
                    y[q] = __builtin_amdgcn_mfma_f32_16x16x32_bf16(af, cb, y[q], 0, 0, 0); }
            }
            bf16_t* yp = Y + (size_t)(r0 + t) * 1024 + 64 * h + 4 * fq;
#pragma unroll
            for (int q = 0; q < 4; ++q) { u32x2 w; w.x = cvt_pk_bf16(y[q][0], y[q][1]); w.y = cvt_pk_bf16(y[q][2], y[q][3]); *(u32x2*)(yp + 16 * q) = w; }
        }
        {
            const float dec = __builtin_amdgcn_exp2f(cend_cur * L2E);
#pragma unroll
            for (int q = 0; q < 4; ++q) hs[q] = hs[q] * dec;
#pragma unroll
            for (int ks = 0; ks < 4; ++ks) {
                const int s0 = 32 * ks + 8 * fq;
                const u32x4 braw = *(const LAS u32x4*)(set + BT_OFF + (16 * wid + fr) * PITCH + s0 * 2);
                const f32x4 w0 = *(const LAS f32x4*)(dtw + s0), w1 = *(const LAS f32x4*)(dtw + s0 + 4);
                u32x4 bw; bw.x = cvt_pk_bf16(bflo(braw.x) * w0[0], bfhi(braw.x) * w0[1]); bw.y = cvt_pk_bf16(bflo(braw.y) * w0[2], bfhi(braw.y) * w0[3]);
                          bw.z = cvt_pk_bf16(bflo(braw.z) * w1[0], bfhi(braw.z) * w1[1]); bw.w = cvt_pk_bf16(bflo(braw.w) * w1[2], bfhi(braw.w) * w1[3]);
                const bf16x8 bfr = __builtin_bit_cast(bf16x8, bw);
#pragma unroll
                for (int q = 0; q < 4; ++q) { const bf16x8 af = *(const LAS bf16x8*)(set + XT_OFF + (16 * q + fr) * PITCH + s0 * 2);
                    hs[q] = __builtin_amdgcn_mfma_f32_16x16x32_bf16(af, bfr, hs[q], 0, 0, 0); }
            }
            LAS bf16_t* hb = (LAS bf16_t*)(lds + ((step + 1) & 1) * SET + HB_OFF) + 16 * wid + fr;
#pragma unroll
            for (int q = 0; q < 4; ++q)
#pragma unroll
                for (int i = 0; i < 4; ++i) hb[(16 * q + 4 * fq + i) * 136] = f2bf(hs[q][i]);
        }
        if (step + 1 < 66) { if (par == 0) SSD_WRITE(step + 1, P); else SSD_WRITE(step + 1, Q); }
    }
    __syncthreads();
#undef SSD_ROWS
#undef SSD_LOAD
#undef SSD_LOADGC
#undef SSD_GCROT
#undef SSD_WRITE
}
}

struct Args { const float* in[32]; float* out; unsigned char* ws; int ph_lo, ph_hi; };
constexpr int NTHR = 512;
constexpr int LDS_BASE = 256;
constexpr int LDS_PHASE = 151808;
constexpr int LDS_BYTES = LDS_BASE + LDS_PHASE;
static_assert(att8::LDS_BYTES <= LDS_PHASE && ssd::LDS_BYTES <= LDS_PHASE && pg8::STAGE_BYTES <= LDS_PHASE, "LDS");

__device__ __forceinline__ void tjob(int j, const Args& A, const float*& src, bf16_t*& dst, int& K, int& N, int& Npad, int& mode, const float*& ks) {
    unsigned char* W = A.ws + WS_W; mode = 0; ks = nullptr;
    if (j < 8) { const int i = j >> 2, w = j & 3; unsigned char* base = W + W_HYB + (size_t)i * WH_SZ;
        if (w == 0)      { src = A.in[I_HWIN] + (size_t)i * 1024 * HYB_IN; dst = (bf16_t*)(base + WH_IN); K = 1024; N = HYB_IN; Npad = HYB_INP; mode = 1; }
        else if (w == 1) { src = A.in[I_WQB] + (size_t)i * 384 * 1536; dst = (bf16_t*)(base + WH_QB); K = 384; N = 1536; Npad = 1536; mode = 2; ks = A.in[I_QNG] + i * 384; }
        else if (w == 2) { src = A.in[I_WKVB] + (size_t)i * 256 * 2048; dst = (bf16_t*)(base + WH_KVB); K = 256; N = 2048; Npad = 2048; ks = A.in[I_KVNG] + i * 256; }
        else             { src = A.in[I_HWOUT] + (size_t)i * 2048 * 1024; dst = (bf16_t*)(base + WH_OUT); K = 2048; N = 1024; Npad = 1024; }
    } else if (j < 12) { const int i = (j - 8) >> 1, w = (j - 8) & 1; unsigned char* base = W + W_GM + (size_t)i * WG_SZ;
        if (w == 0) { src = A.in[I_GWIN] + (size_t)i * 1024 * 4096; dst = (bf16_t*)(base + WG_IN); K = 1024; N = 4096; Npad = 4096; }
        else        { src = A.in[I_GWOUT] + (size_t)i * 2048 * 1024; dst = (bf16_t*)(base + WG_OUT); K = 2048; N = 1024; Npad = 1024; }
    } else { const int l = j - 12; src = A.in[I_PWQ] + (size_t)l * 1024 * 2048; dst = (bf16_t*)(W + W_PEER + (size_t)l * WP_SZ + WP_Q); K = 1024; N = 2048; Npad = 2048; }
}
__device__ __forceinline__ int colmap(int mode, int n, int N) {
    if (mode == 1) { if (n >= N) return -1; if (n < C_KR) return n; const int m = n - C_KR; return C_KR + (m >> 1) + 32 * (m & 1); }
    if (mode == 2) { if (n < 1024) return (n >> 7) * 192 + (n & 127); const int m = n - 1024, h = m >> 6, mm = m & 63; return h * 192 + 128 + (mm >> 1) + 32 * (mm & 1); }
    return n;
}
__device__ __forceinline__ void phase_prologue(const Args& A, LAS unsigned char* lds) {
    const int tid = otid();
    {
        LAS float* tile = (LAS float*)lds;
        const float* c_src = nullptr; bf16_t* c_dst = nullptr; const float* c_ks = nullptr; int c_K = 0, c_N = 0, c_mode = 0, c_nsub = 0, c_k0 = 0, c_n0 = 0;
        int j = 0, item = blockIdx.x; bool have = false;
#define TR_LOCATE() do { have = false; \
            while (j < 16) { int Npad_; tjob(j, A, c_src, c_dst, c_K, c_N, Npad_, c_mode, c_ks); \
                c_nsub = (c_K % 256 == 0) ? 4 : 2; const int tk_ = c_K / (64 * c_nsub), nt_ = tk_ * (Npad_ / 64); \
                if (item < nt_) { c_k0 = (item % tk_) * 64 * c_nsub; c_n0 = (item / tk_) * 64; have = true; break; } \
                item -= nt_; ++j; } } while (0)
        float v[4][8], scv[4];
#define TR_LOAD() do { const int k = tid >> 3, cg = tid & 7; \
            _Pragma("unroll") for (int t = 0; t < 4; ++t) if (t < c_nsub) { scv[t] = c_ks ? c_ks[c_k0 + 64 * t + k] : 1.f; \
                _Pragma("unroll") for (int jj = 0; jj < 8; ++jj) { const int oc = colmap(c_mode, c_n0 + 8 * cg + jj, c_N); v[t][jj] = oc >= 0 ? c_src[(size_t)(c_k0 + 64 * t + k) * c_N + oc] : 0.f; } } } while (0)
        TR_LOCATE();
        if (have) TR_LOAD();
        int buf = 0;
        while (have) {
            const int nsub = c_nsub, K = c_K, k0 = c_k0, n0 = c_n0; bf16_t* dst = c_dst;
            { const int k = tid >> 3, cg = tid & 7;
#pragma unroll
              for (int t = 0; t < 4; ++t) if (t < nsub) {
#pragma unroll
                  for (int jj = 0; jj < 8; ++jj) tile[buf * 16640 + t * 4160 + k * 65 + 8 * cg + jj] = v[t][jj] * scv[t]; } }
            item += gridDim.x; TR_LOCATE();
            if (have) TR_LOAD();
            __syncthreads();
            { const int n = tid >> 3, kg = tid & 7;
#pragma unroll
              for (int t = 0; t < 4; ++t) if (t < nsub) { float o[8];
#pragma unroll
                  for (int jj = 0; jj < 8; ++jj) o[jj] = tile[buf * 16640 + t * 4160 + (8 * kg + jj) * 65 + n];
                  u32x4 w; w.x = cvt_pk_bf16(o[0], o[1]); w.y = cvt_pk_bf16(o[2], o[3]); w.z = cvt_pk_bf16(o[4], o[5]); w.w = cvt_pk_bf16(o[6], o[7]);
                  *(u32x4*)(dst + (size_t)(n0 + n) * K + k0 + 64 * t + 8 * kg) = w; } }
            buf ^= 1;
        }
#undef TR_LOCATE
#undef TR_LOAD
    }
    {
        const int gthr = blockIdx.x * NTHR + tid, nthr = gridDim.x * NTHR;
        for (int p = gthr; p < 10 * 16384; p += nthr) {
            const int mat = p >> 14, off = (p & 16383) * 8; const float* src; bf16_t* dst;
            if (mat < 2)      { src = A.in[I_GWS] + (size_t)mat * 131072; dst = (bf16_t*)(A.ws + WS_W + W_GM + (size_t)mat * WG_SZ + WG_WS); }
            else if (mat < 6) { src = A.in[I_PK1] + (size_t)(mat - 2) * 131072; dst = (bf16_t*)(A.ws + WS_W + W_PEER + (size_t)(mat - 2) * WP_SZ + WP_K1); }
            else              { src = A.in[I_PK2] + (size_t)(mat - 6) * 131072; dst = (bf16_t*)(A.ws + WS_W + W_PEER + (size_t)(mat - 6) * WP_SZ + WP_K2); }
            const f32x4 a = *(const f32x4*)(src + off), b = *(const f32x4*)(src + off + 4);
            u32x4 w; w.x = cvt_pk_bf16(a[0], a[1]); w.y = cvt_pk_bf16(a[2], a[3]); w.z = cvt_pk_bf16(b[0], b[1]); w.w = cvt_pk_bf16(b[2], b[3]);
            *(u32x4*)(dst + off) = w;
        }
        float* rope = (float*)(A.ws + WS_ROPE);
        for (int p = gthr; p < SEQ * 32; p += nthr) { const int l = p >> 5, i = p & 31; const float pos = (float)(i < 16 ? (l >> 6) : (l & 63));
            const float inv = powf(10000.f, -(float)(i & 15) / 16.f), ang = pos * inv; rope[p] = cosf(ang); rope[SEQ * 32 + p] = sinf(ang); }
    }
    {
        LAS float* scond = (LAS float*)lds;
        LAS float* red = scond + 5 * 1024;
        __syncthreads();
        for (int i = tid; i < 5 * 1024; i += NTHR) { const int m = i >> 10, k = i & 1023; const float c = m < 4 ? A.in[I_C][m * 1024 + k] : A.in[I_CCTX][k]; scond[i] = silu_f(c); }
        __syncthreads();
        float* MOD = (float*)(A.ws + WS_MOD);
        for (int item = blockIdx.x; item < 4 * 48; item += gridDim.x) {
            const int layer = item / 48, j0 = (item % 48) * 128; const int c4 = tid & 31, ksl = tid >> 5;
            f32x4 acc[5];
#pragma unroll
            for (int m = 0; m < 5; ++m) acc[m] = (f32x4){0.f, 0.f, 0.f, 0.f};
            const float* wp = A.in[I_ADAW] + ((size_t)layer * 1024 + ksl * 64) * 6144 + j0 + 4 * c4;
#pragma unroll 1
            for (int k0 = 0; k0 < 64; k0 += 16) { f32x4 w[16];
#pragma unroll
                for (int k = 0; k < 16; ++k) w[k] = *(const f32x4*)(wp + (size_t)(k0 + k) * 6144);
#pragma unroll
                for (int k = 0; k < 16; ++k)
#pragma unroll
                    for (int m = 0; m < 5; ++m) acc[m] += w[k] * scond[m * 1024 + ksl * 64 + k0 + k]; }
#pragma unroll
            for (int m = 0; m < 5; ++m) *(LAS f32x4*)(red + (ksl * 5 + m) * 128 + 4 * c4) = acc[m];
            __syncthreads();
            for (int i = tid; i < 640; i += NTHR) { const int m = i >> 7, c = i & 127; float s = A.in[I_ADAB][layer * 6144 + j0 + c];
#pragma unroll
                for (int q = 0; q < 16; ++q) s += red[(q * 5 + m) * 128 + c];
                MOD[((size_t)layer * 5 + m) * 6144 + j0 + c] = s; }
            __syncthreads();
        }
    }
}

template <bool F32SRC>
__device__ __forceinline__ void phase_norm_mod(const float* xl, const float* xc, bf16_t* XB, const float* g, const float* modl, int sh_idx, bf16_t* H, int nrows) {
    const int tid_ = otid(); const int lane = tid_ & 63, gw = blockIdx.x * 8 + (tid_ >> 6), nw = gridDim.x * 8;
    f32x4 gv[4];
#pragma unroll
    for (int i = 0; i < 4; ++i) gv[i] = *(const f32x4*)(g + 256 * i + 4 * lane);
    u32x2 wn[4]; f32x4 xn[4];
#define NM_LOAD(r_) do { const int r__ = (r_); if (F32SRC) { const float* xp = r__ < NLAT ? xl + (size_t)r__ * D : xc + (size_t)(r__ - NLAT) * D; \
            _Pragma("unroll") for (int i = 0; i < 4; ++i) xn[i] = *(const f32x4*)(xp + 256 * i + 4 * lane); } \
        else { _Pragma("unroll") for (int i = 0; i < 4; ++i) wn[i] = *(const u32x2*)(XB + (size_t)r__ * D + 256 * i + 4 * lane); } } while (0)
    if (gw < nrows) NM_LOAD(gw);
    for (int r = gw; r < nrows; r += nw) {
        const bool lat = r < NLAT;
        const float* mp = modl + (size_t)(lat ? (r >> 13) : 4) * 6144 + sh_idx * 1024;
        f32x4 shv[4], scv[4];
#pragma unroll
        for (int i = 0; i < 4; ++i) { shv[i] = *(const f32x4*)(mp + 256 * i + 4 * lane); scv[i] = *(const f32x4*)(mp + 1024 + 256 * i + 4 * lane); }
        f32x4 x[4];
        if (F32SRC) {
#pragma unroll
            for (int i = 0; i < 4; ++i) { x[i] = xn[i]; u32x2 w; w.x = cvt_pk_bf16(x[i][0], x[i][1]); w.y = cvt_pk_bf16(x[i][2], x[i][3]); *(u32x2*)(XB + (size_t)r * D + 256 * i + 4 * lane) = w; }
        } else {
#pragma unroll
            for (int i = 0; i < 4; ++i) x[i] = (f32x4){bflo(wn[i].x), bfhi(wn[i].x), bflo(wn[i].y), bfhi(wn[i].y)}; }
        if (r + nw < nrows) NM_LOAD(r + nw);
        float ss = 0.f;
#pragma unroll
        for (int i = 0; i < 4; ++i) ss += x[i][0] * x[i][0] + x[i][1] * x[i][1] + x[i][2] * x[i][2] + x[i][3] * x[i][3];
        ss = wave_sum(ss); const float rstd = rsqrtf(ss * (1.f / 1024.f) + EPS);
#pragma unroll
        for (int i = 0; i < 4; ++i) { const f32x4 hv = (x[i] * rstd) * gv[i] * (scv[i] + 1.f) + shv[i];
            u32x2 w; w.x = cvt_pk_bf16(hv[0], hv[1]); w.y = cvt_pk_bf16(hv[2], hv[3]);
            *(u32x2*)(H + (size_t)r * D + 256 * i + 4 * lane) = w; }
    }
#undef NM_LOAD
}
__device__ __forceinline__ void phase_final_norm(const bf16_t* XB, float* out, const float* g, float oscale) {
    const int tid_ = otid(); const int lane = tid_ & 63, gw = blockIdx.x * 8 + (tid_ >> 6), nw = gridDim.x * 8;
    f32x4 gv[4];
#pragma unroll
    for (int i = 0; i < 4; ++i) gv[i] = *(const f32x4*)(g + 256 * i + 4 * lane);
    u32x2 wn[4];
#pragma unroll
    for (int i = 0; i < 4; ++i) wn[i] = *(const u32x2*)(XB + (size_t)gw * D + 256 * i + 4 * lane);
    for (int r = gw; r < NLAT; r += nw) {
        f32x4 x[4]; float ss = 0.f;
#pragma unroll
        for (int i = 0; i < 4; ++i) { x[i] = (f32x4){bflo(wn[i].x), bfhi(wn[i].x), bflo(wn[i].y), bfhi(wn[i].y)};
            ss += x[i][0] * x[i][0] + x[i][1] * x[i][1] + x[i][2] * x[i][2] + x[i][3] * x[i][3]; }
        if (r + nw < NLAT) {
#pragma unroll
            for (int i = 0; i < 4; ++i) wn[i] = *(const u32x2*)(XB + (size_t)(r + nw) * D + 256 * i + 4 * lane); }
        ss = wave_sum(ss); const float rstd = rsqrtf(ss * (1.f / 1024.f) + EPS);
#pragma unroll
        for (int i = 0; i < 4; ++i) *(f32x4*)(out + (size_t)r * D + 256 * i + 4 * lane) = (x[i] * (rstd * oscale)) * gv[i];
    }
}

#ifndef MK_CVAR
#define MK_CVAR 0
#endif
__device__ __forceinline__ void phase_conv(const Args& A, int li, int rep = 0) {
    const int cvar = rep ? MK_CVAR : 0;
    const bf16_t* PROJ = (const bf16_t*)(A.ws + WS_BIG);
    bf16_t* XS = (bf16_t*)(A.ws + WS_R2); bf16_t* BC = (bf16_t*)(A.ws + WS_R2 + R2_BC);
    const int tid = otid();
    if (cvar != 2) {
        const int S = (NROW / 64) * 3, G = (int)gridDim.x;
#define CV_GEOM(si) const int blk_ = (si) / 3, q_ = ((si) % 3) * 512 + tid, cg_ = q_ % 192, rg_ = q_ / 192, c0 = 8 * cg_, rbeg = blk_ * 64 + rg_ * 8; int s0, s1; \
            if (rbeg < NLAT) { s0 = rbeg & ~8191; s1 = s0 + 8192; } else { s0 = NLAT + ((rbeg - NLAT) & ~255); s1 = s0 + 256; }
#define CV_LOAD(si, in, msk) do { CV_GEOM(si) msk = 0u;   \
            _Pragma("unroll") for (int i = 0; i < 12; ++i) { const int r = rbeg - 2 + i; const bool ok_ = r >= s0 && r < s1; msk |= ok_ ? (1u << i) : 0u; \
                in[i] = *(const u32x4*)(PROJ + (size_t)(ok_ ? r : rbeg) * HYB_INP + C_XBC + c0); } } while (0)
#define CV_WEIGHTS(si) float w[8][5], bia[8]; { CV_GEOM(si) (void)s0; (void)s1; (void)rbeg; \
            const float* cw = A.in[I_CONVW] + ((size_t)li * 1536 + c0) * 5; const float* cb = A.in[I_CONVB] + (size_t)li * 1536 + c0; \
            _Pragma("unroll") for (int j = 0; j < 8; ++j) { bia[j] = cb[j]; _Pragma("unroll") for (int k = 0; k < 5; ++k) w[j][k] = cw[j * 5 + k]; } }
#define CV_COMPUTE(si, in, msk) do { CV_GEOM(si) (void)s0; (void)s1; \
            _Pragma("unroll") for (int i = 0; i < 12; ++i) if (!((msk >> i) & 1u)) in[i] = (u32x4){0u, 0u, 0u, 0u}; \
            _Pragma("unroll") for (int rr = 0; rr < 8; ++rr) { float o[8]; \
                _Pragma("unroll") for (int j = 0; j < 8; ++j) { float sacc = bia[j]; \
                    _Pragma("unroll") for (int k = 0; k < 5; ++k) { const unsigned wd = in[rr + k][j >> 1]; sacc += w[j][k] * ((j & 1) ? bfhi(wd) : bflo(wd)); } \
                    o[j] = silu_f(sacc); } \
                u32x4 pk; pk.x = cvt_pk_bf16(o[0], o[1]); pk.y = cvt_pk_bf16(o[2], o[3]); pk.z = cvt_pk_bf16(o[4], o[5]); pk.w = cvt_pk_bf16(o[6], o[7]); \
                const int r = rbeg + rr; \
                if (c0 < 1024) *(u32x4*)(XS + (size_t)r * 1024 + c0) = pk; else *(u32x4*)(BC + (size_t)r * 512 + (c0 - 1024)) = pk; } } while (0)
        u32x4 inA[12], inB[12]; unsigned mA = 0u, mB = 0u;
        int si = (int)blockIdx.x;
        if (si < S) CV_LOAD(si, inA, mA);
#pragma unroll 1
        while (si < S) {
            { CV_WEIGHTS(si); CV_LOAD(si + G < S ? si + G : si, inB, mB); CV_COMPUTE(si, inA, mA); }
            si += G; if (si >= S) break;
            { CV_WEIGHTS(si); CV_LOAD(si + G < S ? si + G : si, inA, mA); CV_COMPUTE(si, inB, mB); }
            si += G;
        }
#undef CV_GEOM
#undef CV_LOAD
#undef CV_WEIGHTS
#undef CV_COMPUTE
    }
    if (cvar != 1) {
        const int lane = tid & 63, gw = (int)((blockIdx.x + gridDim.x / 2) % gridDim.x) * 8 + (tid >> 6), nw = gridDim.x * 8;
        float* DT = (float*)(A.ws + WS_BIG + BIG_DT); float* RQ = (float*)(A.ws + WS_RSTD); float* RKV = RQ + NROW;
        unsigned char* KR = A.ws + WS_BIG + BIG_KR; const float* rope = (const float*)(A.ws + WS_ROPE);
        const float dtb = lane < 32 ? A.in[I_DTB][li * 32 + lane] : 0.f;
        unsigned nq[4][3]; u32x2 nk[4]; unsigned nr_[4]; float ndt[4], nrc[4], nrs[4];
#define PB_LOAD(rb_) do { _Pragma("unroll") for (int i = 0; i < 4; ++i) { const int r = (rb_) + i; const bf16_t* p = PROJ + (size_t)r * HYB_INP; \
                const unsigned* q = (const unsigned*)(p + C_CQ + 6 * lane); nq[i][0] = q[0]; nq[i][1] = q[1]; nq[i][2] = q[2]; \
                nk[i] = *(const u32x2*)(p + C_CKV + 4 * lane); \
                ndt[i] = lane < 32 ? bf2f(p[C_DT + (lane & 15)]) : 0.f; nr_[i] = lane < 32 ? *(const unsigned*)(p + C_KR + 2 * lane) : 0u; \
                const int l = r & 8191; nrc[i] = (lane < 32 && r < NLAT) ? rope[l * 32 + lane] : 1.f; nrs[i] = (lane < 32 && r < NLAT) ? rope[SEQ * 32 + l * 32 + lane] : 0.f; } } while (0)
        if (gw * 4 < NROW) PB_LOAD(gw * 4);
        for (int rb = gw * 4; rb < NROW; rb += nw * 4) {
            unsigned wq[4][3]; u32x2 wk[4]; unsigned wr_[4]; float dtv[4], rc[4], rsn[4];
#pragma unroll
            for (int i = 0; i < 4; ++i) { wq[i][0] = nq[i][0]; wq[i][1] = nq[i][1]; wq[i][2] = nq[i][2]; wk[i] = nk[i]; wr_[i] = nr_[i]; dtv[i] = ndt[i]; rc[i] = nrc[i]; rsn[i] = nrs[i]; }
            if (rb + nw * 4 < NROW) PB_LOAD(rb + nw * 4);
#pragma unroll
            for (int i = 0; i < 4; ++i) { const int r = rb + i;
                dtv[i] = softplus_f(dtv[i] + dtb);
                { float ss = 0.f;
#pragma unroll
                  for (int j = 0; j < 3; ++j) { const float a = bflo(wq[i][j]), b = bfhi(wq[i][j]); ss += a * a + b * b; }
                  ss = wave_sum(ss); if (lane == 0) RQ[r] = rsqrtf(ss * (1.f / 384.f) + EPS); }
                { const float a = bflo(wk[i].x), b = bfhi(wk[i].x), c = bflo(wk[i].y), d = bfhi(wk[i].y);
                  float ss = a * a + b * b + c * c + d * d; ss = wave_sum(ss); if (lane == 0) RKV[r] = rsqrtf(ss * (1.f / 256.f) + EPS); }
                if (lane < 32) { const float x1 = bflo(wr_[i]), x2 = bfhi(wr_[i]); int b, key;
                    const float o1 = x1 * rc[i] - x2 * rsn[i], o2 = x1 * rsn[i] + x2 * rc[i];
                    if (r < NLAT) { b = r >> 13; key = 256 + (r & 8191); } else { b = (r - NLAT) >> 8; key = (r - NLAT) & 255; }
                    int w8 = 0; w8 = __builtin_amdgcn_cvt_pk_fp8_f32(sat8(o1), sat8(o2), w8, false);
                    *(unsigned short*)(KR + (size_t)(b * NKT + (key >> 6)) * 4096 + att8::kr8(key & 63, 2 * lane)) = (unsigned short)(w8 & 0xffff); }
            }
            if (lane < 32) *(f32x4*)(DT + (size_t)lane * NROW + rb) = (f32x4){dtv[0], dtv[1], dtv[2], dtv[3]};
        }
#undef PB_LOAD
    }
}

struct EpiQ {
    static constexpr bool PERM = true;
    unsigned char* Q; const float* rstd; const float* rope;
    __device__ __forceinline__ void operator()(const f32x4 (&acc)[2][2][4][2], const pg8::Unit& u, int wr, int wc, int fr, int fq) const {
        const bool lat = u.pm < 128;
        const int b = lat ? (u.pm >> 5) : (u.pm - 128), q0 = lat ? 256 + ((u.pm & 31) << 8) : 0;
        const bool isrope = u.pn >= 4;
#pragma unroll
        for (int ai = 0; ai < 2; ++ai) {
            const int rl = 128 * ai + 64 * wr + fr;
            const float* rsp = rstd + u.pm * 256 + rl;
            const float* rp = rope + (size_t)(((u.pm & 31) << 8) + rl) * 32;
#pragma unroll
            for (int bj = 0; bj < 2; ++bj) {
                const int c0 = u.pn * 256 + 128 * bj + 32 * wc + 8 * fq; int h, dcol;
                if (!isrope) { h = c0 >> 7; dcol = c0 & 127; } else { const int mq = c0 - 1024; h = mq >> 6; dcol = 128 + (mq & 63); }
                unsigned char* dst = Q + ((size_t)(b * 8 + h) * NKEY + q0 + rl) * 192 + dcol;
                const int ro = (dcol - 128) >> 1;
#pragma unroll
                for (int m = 0; m < 4; ++m) {
                    const float rs = rsp[16 * m] * (QSCALE * att8::QUP);
                    f32x4 v0 = acc[ai][bj][m][0] * rs, v1 = acc[ai][bj][m][1] * rs;
                    if (isrope && lat) { const f32x4 cs = *(const f32x4*)(rp + 16 * m * 32 + ro), sn = *(const f32x4*)(rp + SEQ * 32 + 16 * m * 32 + ro);
                        const f32x4 a0 = v0, a1 = v1;
                        v0[0] = a0[0] * cs[0] - a0[1] * sn[0]; v0[1] = a0[0] * sn[0] + a0[1] * cs[0]; v0[2] = a0[2] * cs[1] - a0[3] * sn[1]; v0[3] = a0[2] * sn[1] + a0[3] * cs[1];
                        v1[0] = a1[0] * cs[2] - a1[1] * sn[2]; v1[1] = a1[0] * sn[2] + a1[1] * cs[2]; v1[2] = a1[2] * cs[3] - a1[3] * sn[3]; v1[3] = a1[2] * sn[3] + a1[3] * cs[3]; }
                    u32x2 w; w.x = pk4_fp8_sat(v0[0], v0[1], v0[2], v0[3]); w.y = pk4_fp8_sat(v1[0], v1[1], v1[2], v1[3]);
                    *(u32x2*)(dst + 16 * m * 192) = w;
                    asm volatile("" ::: "memory");
                }
            }
        }
    }
};
struct EpiKV {
    static constexpr bool PERM = true;
    unsigned char* KN; unsigned char* V; const float* rstd;
    __device__ __forceinline__ void operator()(const f32x4 (&acc)[2][2][4][2], const pg8::Unit& u, int wr, int wc, int fr, int fq) const {
        const bool lat = u.pm < 128;
        const int b = lat ? (u.pm >> 5) : (u.pm - 128), t0 = lat ? 4 + ((u.pm & 31) << 2) : 0;
        const int dd = 32 * wc + 8 * fq;
        const int offK = fr * 128 + ((((dd >> 4) ^ ((fr >> 1) & 7))) << 4) + (dd & 15);
#pragma unroll
        for (int ai = 0; ai < 2; ++ai) {
            const size_t tb = ((size_t)(b * 8 + u.pn) * NKT + t0 + 2 * ai + wr) * 8192;
            const float* rsp = rstd + u.pm * 256 + 128 * ai + 64 * wr + fr;
            unsigned char* kp = KN + tb + offK; unsigned char* vp = V + tb;
#pragma unroll
            for (int m = 0; m < 4; ++m) {
                const float rs = rsp[16 * m];
                { const f32x4 v0 = acc[ai][0][m][0] * rs, v1 = acc[ai][0][m][1] * rs; u32x2 w; w.x = pk4_fp8_sat(v0[0], v0[1], v0[2], v0[3]); w.y = pk4_fp8_sat(v1[0], v1[1], v1[2], v1[3]);
                  *(u32x2*)(kp + m * 2048) = w; }
                { const f32x4 v0 = acc[ai][1][m][0] * rs, v1 = acc[ai][1][m][1] * rs; const unsigned w0 = pk4_fp8_sat(v0[0], v0[1], v0[2], v0[3]), w1 = pk4_fp8_sat(v1[0], v1[1], v1[2], v1[3]);
                  const int sl = att8::vslot(16 * m + fr);
#pragma unroll
                  for (int i = 0; i < 8; ++i) { const int d = dd + i; vp[d * 64 + ((((sl >> 4) ^ ((d >> 2) & 3))) << 4) + (sl & 15)] = (unsigned char)(((i < 4 ? w0 : w1) >> (8 * (i & 3))) & 0xffu); } }
                asm volatile("" ::: "memory");
            }
        }
    }
};

__device__ __forceinline__ void phase_ssd_out(const Args& A, int li, int nrows) {
    const bf16_t* PROJ = (const bf16_t*)(A.ws + WS_BIG); const bf16_t* XS = (const bf16_t*)(A.ws + WS_R2);
    const bf16_t* Y0 = (const bf16_t*)(A.ws + WS_H); const bf16_t* Y1 = (const bf16_t*)(A.ws + WS_R3); bf16_t* CAT = (bf16_t*)(A.ws + WS_R3 + R3_CAT);
    const int tid_ = otid(); const int lane = tid_ & 63, gw = blockIdx.x * 8 + (tid_ >> 6), nw = gridDim.x * 8;
    const float dsk = A.in[I_SSDD][li * 16 + (lane >> 2)];
    float ng[16];
#pragma unroll
    for (int j = 0; j < 16; ++j) ng[j] = A.in[I_SSDNG][li * 1024 + 16 * lane + j];
    for (int r = gw; r < nrows; r += nw) {
        float v[16]; float ss = 0.f;
#pragma unroll
        for (int hh = 0; hh < 2; ++hh) {
            const u32x4 a = *(const u32x4*)(Y0 + (size_t)r * 1024 + 16 * lane + 8 * hh), b = *(const u32x4*)(Y1 + (size_t)r * 1024 + 16 * lane + 8 * hh);
            const u32x4 x = *(const u32x4*)(XS + (size_t)r * 1024 + 16 * lane + 8 * hh), z = *(const u32x4*)(PROJ + (size_t)r * HYB_INP + 16 * lane + 8 * hh);
#pragma unroll
            for (int q = 0; q < 4; ++q) {
                const float y0 = (bflo(a[q]) + bflo(b[q]) + dsk * bflo(x[q])) * silu_f(bflo(z[q])), y1 = (bfhi(a[q]) + bfhi(b[q]) + dsk * bfhi(x[q])) * silu_f(bfhi(z[q]));
                v[8 * hh + 2 * q] = y0; v[8 * hh + 2 * q + 1] = y1; ss += y0 * y0 + y1 * y1; }
        }
#pragma unroll
        for (int o = 16; o >= 1; o >>= 1) ss += __shfl_xor(ss, o);
        const float rstd = rsqrtf(ss * (1.f / 512.f) + EPS);
#pragma unroll
        for (int hh = 0; hh < 2; ++hh) { u32x4 w;
#pragma unroll
            for (int q = 0; q < 4; ++q) w[q] = cvt_pk_bf16(v[8 * hh + 2 * q] * rstd * ng[8 * hh + 2 * q], v[8 * hh + 2 * q + 1] * rstd * ng[8 * hh + 2 * q + 1]);
            *(u32x4*)(CAT + (size_t)r * 2048 + 16 * lane + 8 * hh) = w; }
    }
}

__device__ __forceinline__ void phase_ln_stats(const Args& A, int nrows) {
    const bf16_t* Gb = (const bf16_t*)(A.ws + WS_BIG); float* ST = (float*)(A.ws + WS_RSTD);
    const int tid_ = otid(); const int lane = tid_ & 63, gw = blockIdx.x * 8 + (tid_ >> 6), nw = gridDim.x * 8;
    for (int r = gw; r < nrows; r += nw) {
        float v[32]; float s = 0.f;
#pragma unroll
        for (int j = 0; j < 4; ++j) { const u32x4 w = *(const u32x4*)(Gb + (size_t)r * 4096 + 2048 + 512 * j + 8 * lane);
#pragma unroll
            for (int q = 0; q < 4; ++q) { v[8 * j + 2 * q] = bflo(w[q]); v[8 * j + 2 * q + 1] = bfhi(w[q]); s += v[8 * j + 2 * q] + v[8 * j + 2 * q + 1]; } }
        s = wave_sum(s); const float mu = s * (1.f / 2048.f); float q2 = 0.f;
#pragma unroll
        for (int j = 0; j < 32; ++j) { const float dd = v[j] - mu; q2 += dd * dd; }
        q2 = wave_sum(q2);
        if (lane == 0) { ST[r] = mu; ST[NROW + r] = rsqrtf(q2 * (1.f / 2048.f) + EPS); }
    }
}
__device__ __forceinline__ float half_sum32(float v) {
    v += __builtin_bit_cast(float, __builtin_amdgcn_mov_dpp(__builtin_bit_cast(int, v), 0xB1, 0xF, 0xF, true));
    v += __builtin_bit_cast(float, __builtin_amdgcn_mov_dpp(__builtin_bit_cast(int, v), 0x4E, 0xF, 0xF, true));
    v += __builtin_bit_cast(float, __builtin_amdgcn_mov_dpp(__builtin_bit_cast(int, v), 0x141, 0xF, 0xF, true));
    v += __builtin_bit_cast(float, __builtin_amdgcn_mov_dpp(__builtin_bit_cast(int, v), 0x140, 0xF, 0xF, true));
    auto r = __builtin_amdgcn_permlane16_swap(__float_as_uint(v), __float_as_uint(v), false, false);
    return __uint_as_float(r[0]) + __uint_as_float(r[1]);
}
__device__ __forceinline__ void phase_spatial(const Args& A, int gi, int nrows, LAS unsigned char* lds) {
    const bf16_t* Gb = (const bf16_t*)(A.ws + WS_BIG); const f32x2* PARTS = (const f32x2*)(A.ws + WS_R3); bf16_t* Ab = (bf16_t*)(A.ws + WS_R1);
    const bf16_t* WSg = (const bf16_t*)(A.ws + WS_W + W_GM + (size_t)gi * WG_SZ + WG_WS);
    const float* lng = A.in[I_GLNG] + (size_t)gi * 2048; const float* lnb = A.in[I_GLNB] + (size_t)gi * 2048; const float* bs = A.in[I_GBS] + (size_t)gi * 1024;
    const int tid = otid(), wid = tid >> 6, lane = tid & 63, r32 = lane & 31, hi = lane >> 5, tb = wid & 3, dh = wid >> 2;
    const int ldsaddr = (int)(unsigned)(uintptr_t)lds;
    u32x4 nv[8]; f32x2 nps[8];
    const int nunits = (nrows / 128) * 8;
#define SP_LOADV(un) do { const int cb_ = (un) >> 3, gg_ = (un) & 7, r0_ = cb_ * 128; \
        _Pragma("unroll") for (int j = 0; j < 8; ++j) { const int idx = tid + 512 * j, s_ = idx >> 5, dd_ = (idx & 31) * 8; \
            nv[j] = *(const u32x4*)(Gb + (size_t)(r0_ + s_) * 4096 + 2048 + 256 * gg_ + dd_); nps[j] = PARTS[(size_t)(r0_ + s_) * 32 + (idx & 31)]; } } while (0)
    if ((int)blockIdx.x < nunits) SP_LOADV((int)blockIdx.x);
    int ggc = -1; f32x4 g0, g1, b0, b1; float bsv = 0.f;
    for (int unit = blockIdx.x; unit < nunits; unit += gridDim.x) {
        const int cb = unit >> 3, gg = unit & 7, r0 = cb * 128;
        if (gg != ggc) { ggc = gg; const int dd = (tid & 31) * 8;
            g0 = *(const f32x4*)(lng + 256 * gg + dd); g1 = *(const f32x4*)(lng + 256 * gg + dd + 4); b0 = *(const f32x4*)(lnb + 256 * gg + dd); b1 = *(const f32x4*)(lnb + 256 * gg + dd + 4);
            bsv = bs[gg * 128 + 32 * tb + r32]; }
        __syncthreads();
#pragma unroll
        for (int j = 0; j < 8; ++j) { const int idx = tid + 512 * j, s = idx >> 5, dd = (idx & 31) * 8;
            const u32x4 w = nv[j];
            const float mu = half_sum32(nps[j].x) * (1.f / 2048.f), rs = rsqrtf(fmaxf(half_sum32(nps[j].y) * (1.f / 2048.f) - mu * mu, 0.f) + EPS);
            u32x4 o;
            o.x = cvt_pk_bf16((bflo(w.x) - mu) * rs * g0[0] + b0[0], (bfhi(w.x) - mu) * rs * g0[1] + b0[1]); o.y = cvt_pk_bf16((bflo(w.y) - mu) * rs * g0[2] + b0[2], (bfhi(w.y) - mu) * rs * g0[3] + b0[3]);
            o.z = cvt_pk_bf16((bflo(w.z) - mu) * rs * g1[0] + b1[0], (bfhi(w.z) - mu) * rs * g1[1] + b1[1]); o.w = cvt_pk_bf16((bflo(w.w) - mu) * rs * g1[2] + b1[2], (bfhi(w.w) - mu) * rs * g1[3] + b1[3]);
            *(LAS u32x4*)(lds + ((s >> 6) * 2 + (dd >> 7)) * 16384 + att::v_st(s & 63, dd & 127)) = o; }
        bf16x8 pa[8];
#pragma unroll
        for (int ks = 0; ks < 8; ++ks) pa[ks] = *(const bf16x8*)(WSg + ((size_t)gg * 128 + 32 * tb + r32) * 128 + 16 * ks + 8 * hi);
        u32x4 ul[4][2];
        { const bf16_t* up = Gb + (size_t)(r0 + 32 * tb + r32) * 4096 + 256 * gg + 128 * dh + 8 * hi;
#pragma unroll
          for (int d0 = 0; d0 < 4; ++d0)
#pragma unroll
              for (int kp = 0; kp < 2; ++kp) ul[d0][kp] = *(const u32x4*)(up + 32 * d0 + 16 * kp); }
        if (unit + (int)gridDim.x < nunits) SP_LOADV(unit + (int)gridDim.x);
        __syncthreads();
        f32x16 o[4] = {};
#define SP_PV(D0, vbase, p0, p1, p2, p3) do { \
            const s16x4 l0 = att::tr_read<att::v_rd_off(D0, 0, 0)>(vbase), h0 = att::tr_read<att::v_rd_off(D0, 0, 1)>(vbase), l1 = att::tr_read<att::v_rd_off(D0, 1, 0)>(vbase), h1 = att::tr_read<att::v_rd_off(D0, 1, 1)>(vbase); \
            const s16x4 l2 = att::tr_read<att::v_rd_off(D0, 2, 0)>(vbase), h2 = att::tr_read<att::v_rd_off(D0, 2, 1)>(vbase), l3 = att::tr_read<att::v_rd_off(D0, 3, 0)>(vbase), h3 = att::tr_read<att::v_rd_off(D0, 3, 1)>(vbase); \
            asm volatile("s_waitcnt lgkmcnt(0)" ::: "memory"); __builtin_amdgcn_sched_barrier(0); \
            o[D0] = __builtin_amdgcn_mfma_f32_32x32x16_bf16((bf16x8){l0[0], l0[1], l0[2], l0[3], h0[0], h0[1], h0[2], h0[3]}, p0, o[D0], 0, 0, 0); \
            o[D0] = __builtin_amdgcn_mfma_f32_32x32x16_bf16((bf16x8){l1[0], l1[1], l1[2], l1[3], h1[0], h1[1], h1[2], h1[3]}, p1, o[D0], 0, 0, 0); \
            o[D0] = __builtin_amdgcn_mfma_f32_32x32x16_bf16((bf16x8){l2[0], l2[1], l2[2], l2[3], h2[0], h2[1], h2[2], h2[3]}, p2, o[D0], 0, 0, 0); \
            o[D0] = __builtin_amdgcn_mfma_f32_32x32x16_bf16((bf16x8){l3[0], l3[1], l3[2], l3[3], h3[0], h3[1], h3[2], h3[3]}, p3, o[D0], 0, 0, 0); } while (0)
        { const int vb0 = ldsaddr + (0 * 2 + dh) * 16384 + att::v_rd_base(lane), vb1 = ldsaddr + (1 * 2 + dh) * 16384 + att::v_rd_base(lane);
          SP_PV(0, vb0, pa[0], pa[1], pa[2], pa[3]); SP_PV(1, vb0, pa[0], pa[1], pa[2], pa[3]); SP_PV(2, vb0, pa[0], pa[1], pa[2], pa[3]); SP_PV(3, vb0, pa[0], pa[1], pa[2], pa[3]);
          SP_PV(0, vb1, pa[4], pa[5], pa[6], pa[7]); SP_PV(1, vb1, pa[4], pa[5], pa[6], pa[7]); SP_PV(2, vb1, pa[4], pa[5], pa[6], pa[7]); SP_PV(3, vb1, pa[4], pa[5], pa[6], pa[7]); }
#undef SP_PV
        { const int t = 32 * tb + r32, row = r0 + t;
          bf16_t* ap = Ab + (size_t)row * 2048 + 256 * gg + 128 * dh + 8 * hi;
#pragma unroll
          for (int d0 = 0; d0 < 4; ++d0)
#pragma unroll
              for (int kp = 0; kp < 2; ++kp) {
                  const u32x4 L = ul[d0][kp];
                  const auto sx = __builtin_amdgcn_permlane32_swap(L.x, L.z, false, false), sy = __builtin_amdgcn_permlane32_swap(L.y, L.w, false, false);
                  u32x2 w[2];
#pragma unroll
                  for (int e = 0; e < 2; ++e) { const int k = 2 * kp + e; const unsigned ux = sx[e], uy = sy[e];
                      w[e].x = cvt_pk_bf16(bflo(ux) * (o[d0][4 * k] + bsv), bfhi(ux) * (o[d0][4 * k + 1] + bsv)); w[e].y = cvt_pk_bf16(bflo(uy) * (o[d0][4 * k + 2] + bsv), bfhi(uy) * (o[d0][4 * k + 3] + bsv)); }
                  const auto tx = __builtin_amdgcn_permlane32_swap(w[0].x, w[1].x, false, false), ty = __builtin_amdgcn_permlane32_swap(w[0].y, w[1].y, false, false);
                  *(u32x4*)(ap + 32 * d0 + 16 * kp) = (u32x4){tx[0], ty[0], tx[1], ty[1]}; } }
    }
#undef SP_LOADV
}

constexpr int NSL = 8, SW = 1024 / NSL;
constexpr size_t TAB8_HALF = (size_t)NEXP * 1024, TAB_SCL = 2 * TAB8_HALF, TAB_SET = al256(TAB_SCL + (size_t)2 * NEXP * 4);
static_assert(2 * TAB_SET <= TAB_REGION, "table sets");
__device__ __forceinline__ size_t tabset(int layer) { return WS_TAB + (size_t)(layer & 1) * TAB_SET; }
constexpr float HS = 4.f;
__device__ __forceinline__ void phase_tabcvt(const Args& A, int layer, int wg, int nwg, int r_lo = 0, int r_hi = 2 * NEXP) {
    const int tid_ = otid(); const int lane = tid_ & 63, gw = wg * 8 + (tid_ >> 6), nw = nwg * 8;
    unsigned char* TS = A.ws + tabset(layer); float* SCL = (float*)(TS + TAB_SCL);
    f32x4 vn[4];
#define TC_LOAD(r_) do { const int r__ = (r_); const float* src_ = ((r__ >> 14) ? A.in[I_PV] : A.in[I_PU]) + ((size_t)layer * NEXP + (r__ & (NEXP - 1))) * 1024 + 16 * lane; \
        _Pragma("unroll") for (int i = 0; i < 4; ++i) vn[i] = *(const f32x4*)(src_ + 4 * i); } while (0)
    if (r_lo + gw < r_hi) TC_LOAD(r_lo + gw);
    for (int r = r_lo + gw; r < r_hi; r += nw) {
        const int tab = r >> 14, e = r & (NEXP - 1);
        f32x4 v[4]; float am = 0.f;
#pragma unroll
        for (int i = 0; i < 4; ++i) { v[i] = vn[i]; am = fmaxf(am, fmaxf(fmaxf(fabsf(v[i][0]), fabsf(v[i][1])), fmaxf(fabsf(v[i][2]), fabsf(v[i][3])))); }
        if (r + nw < r_hi) TC_LOAD(r + nw);
#pragma unroll
        for (int o = 32; o >= 1; o >>= 1) am = fmaxf(am, __shfl_xor(am, o));
        float sc = 1.f; if (am > 0.f) { int ex; (void)frexpf(448.f / am, &ex); sc = ldexpf(1.f, ex - 1); }
        if (lane == 0) SCL[tab * NEXP + e] = 1.f / sc;
        u32x4 w;
#pragma unroll
        for (int i = 0; i < 4; ++i) w[i] = pk4_fp8(v[i][0] * sc, v[i][1] * sc, v[i][2] * sc, v[i][3] * sc);
        *(u32x4*)(TS + (size_t)tab * TAB8_HALF + ((size_t)(lane >> 3) * NEXP + e) * SW + 16 * (lane & 7)) = w;
    }
#undef TC_LOAD
}
#define CASD(a, b) do { const float hi_ = fmaxf(a, b), lo_ = fminf(a, b); a = hi_; b = lo_; } while (0)
__device__ __forceinline__ void sort16(float (&k)[16]) {
    CASD(k[0], k[13]); CASD(k[1], k[12]); CASD(k[2], k[15]); CASD(k[3], k[14]); CASD(k[4], k[8]); CASD(k[5], k[6]); CASD(k[7], k[11]); CASD(k[9], k[10]);
    CASD(k[0], k[5]); CASD(k[1], k[7]); CASD(k[2], k[9]); CASD(k[3], k[4]); CASD(k[6], k[13]); CASD(k[8], k[14]); CASD(k[10], k[15]); CASD(k[11], k[12]);
    CASD(k[0], k[1]); CASD(k[2], k[3]); CASD(k[4], k[5]); CASD(k[6], k[8]); CASD(k[7], k[9]); CASD(k[10], k[11]); CASD(k[12], k[13]); CASD(k[14], k[15]);
    CASD(k[0], k[2]); CASD(k[1], k[3]); CASD(k[4], k[10]); CASD(k[5], k[11]); CASD(k[6], k[7]); CASD(k[8], k[9]); CASD(k[12], k[14]); CASD(k[13], k[15]);
    CASD(k[1], k[2]); CASD(k[3], k[12]); CASD(k[4], k[6]); CASD(k[5], k[7]); CASD(k[8], k[10]); CASD(k[9], k[11]); CASD(k[13], k[14]);
    CASD(k[1], k[4]); CASD(k[2], k[6]); CASD(k[5], k[8]); CASD(k[7], k[10]); CASD(k[9], k[13]); CASD(k[11], k[14]);
    CASD(k[2], k[4]); CASD(k[3], k[6]); CASD(k[9], k[12]); CASD(k[11], k[13]);
    CASD(k[3], k[5]); CASD(k[6], k[8]); CASD(k[7], k[9]); CASD(k[10], k[12]);
    CASD(k[3], k[4]); CASD(k[5], k[6]); CASD(k[7], k[8]); CASD(k[9], k[10]); CASD(k[11], k[12]);
    CASD(k[6], k[7]); CASD(k[8], k[9]);
}
__device__ __forceinline__ void bmerge16(float (&k)[16]) {
#pragma unroll
    for (int j = 8; j > 0; j >>= 1)
#pragma unroll
        for (int i = 0; i < 16; ++i) { const int l = i ^ j; if (l > i) CASD(k[i], k[l]); }
}
__device__ __forceinline__ void merge_top16(float (&a)[16], const float (&b)[16]) {
#pragma unroll
    for (int i = 0; i < 16; ++i) a[i] = fmaxf(a[i], b[15 - i]);
    bmerge16(a);
}
__device__ __forceinline__ void xmerge_top16(float (&a)[16], int mask) {
    float t[16];
#pragma unroll
    for (int i = 0; i < 16; ++i) t[i] = __shfl_xor(a[15 - i], mask);
#pragma unroll
    for (int i = 0; i < 16; ++i) a[i] = fmaxf(a[i], t[i]);
    bmerge16(a);
}
__device__ __forceinline__ void phase_topk(const Args& A, int layer, int nrows, LAS unsigned char* lds) {
    const bf16_t* QP = (const bf16_t*)(A.ws + WS_BIG); int* IDX = (int*)(A.ws + WS_R2); float* GATE = (float*)(A.ws + WS_R2 + R2_GATE);
    const int tid = otid(), wid = tid >> 6, lane = tid & 63, fr = lane & 15, fq = lane >> 4;
    LAS unsigned* scr = (LAS unsigned*)(lds + 2 * 34816) + wid * 512 + fr * 32;
    int h_staged = -1;
    const int nunits = (nrows / 128) * 8;
    bf16x8 qn[2][4];
#define TK_LOADQ(un, half) do { const bf16_t* qp_ = QP + (size_t)(((un) >> 3) * 128 + 16 * wid + fr) * 2048 + 256 * ((un) & 7) + 128 * (half) + 8 * fq; \
        _Pragma("unroll") for (int ks = 0; ks < 4; ++ks) qn[half][ks] = *(const bf16x8*)(qp_ + 32 * ks); } while (0)
    { const int u0 = (int)blockIdx.x < nunits ? (int)blockIdx.x : 0; TK_LOADQ(u0, 0); TK_LOADQ(u0, 1); }
    for (int unit = blockIdx.x; unit < nunits; unit += gridDim.x) {
        const int h = unit & 7, r0 = (unit >> 3) * 128;
        if (h != h_staged) { h_staged = h;
        __syncthreads();
        { const bf16_t* k1 = (const bf16_t*)(A.ws + WS_W + W_PEER + (size_t)layer * WP_SZ + WP_K1) + (size_t)h * 16384;
#pragma unroll
          for (int j = 0; j < 8; ++j) { const int idx = tid + 512 * j, half = idx >> 11, rem = idx & 2047, key = rem >> 4, c8 = rem & 15;
              const u32x4 w = *(const u32x4*)(k1 + (size_t)half * 8 * 16384 + key * 128 + 8 * c8);
              *(LAS u32x4*)(lds + half * 34816 + key * 272 + c8 * 16) = w; } }
        __syncthreads(); }
        const int tok = r0 + 16 * wid + fr;
        float top[2][16];
#pragma unroll
        for (int half = 0; half < 2; ++half) {
            bf16x8 qf[4];
#pragma unroll
            for (int ks = 0; ks < 4; ++ks) qf[ks] = qn[half][ks];
            float loc[16];
#pragma unroll
            for (int grp = 0; grp < 2; ++grp) {
                float kk[16];
#pragma unroll
                for (int nbb = 0; nbb < 4; ++nbb) { const int nb = 4 * grp + nbb; f32x4 acc = {0.f, 0.f, 0.f, 0.f};
#pragma unroll
                    for (int ks = 0; ks < 4; ++ks) { const bf16x8 kf = *(const LAS bf16x8*)(lds + half * 34816 + (16 * nb + fr) * 272 + (32 * ks + 8 * fq) * 2);
                        acc = __builtin_amdgcn_mfma_f32_16x16x32_bf16(kf, qf[ks], acc, 0, 0, 0); }
#pragma unroll
                    for (int i = 0; i < 4; ++i) { const unsigned code = 127u - (unsigned)(16 * nb + 4 * fq + i); kk[4 * nbb + i] = __uint_as_float((__float_as_uint(acc[i]) & ~127u) | code); } }
                sort16(kk);
                if (grp == 0) {
#pragma unroll
                    for (int i = 0; i < 16; ++i) loc[i] = kk[i];
                } else merge_top16(loc, kk);
            }
            { const int un = unit + (int)gridDim.x < nunits ? unit + (int)gridDim.x : unit; if (half == 0) TK_LOADQ(un, 0); else TK_LOADQ(un, 1); }
            xmerge_top16(loc, 16); xmerge_top16(loc, 32);
#pragma unroll
            for (int i = 0; i < 16; ++i) top[half][i] = loc[i];
        }
        if (fq < 2) {
#pragma unroll
            for (int i = 0; i < 16; ++i) scr[16 * fq + i] = __float_as_uint(fq == 0 ? top[0][i] : top[1][i]); }
#define TK_VA(j) (fq == 0 ? top[0][j] : fq == 1 ? top[0][(j) + 1] : fq == 2 ? top[0][(j) + 2] : top[0][(j) + 3])
#define TK_KEY(sum, a_, b_) __uint_as_float((__float_as_uint(sum) & ~255u) | (255u - (unsigned)((a_) * 16 + (b_))))
        float fin[16];
        { const float va = __uint_as_float(__float_as_uint(TK_VA(0)) & ~127u);
#pragma unroll
          for (int bb = 0; bb < 16; ++bb) fin[bb] = TK_KEY(va + __uint_as_float(__float_as_uint(top[1][bb]) & ~127u), fq, bb); }
        { const float va1 = __uint_as_float(__float_as_uint(TK_VA(4)) & ~127u), va2 = __uint_as_float(__float_as_uint(TK_VA(8)) & ~127u), va3 = __uint_as_float(__float_as_uint(TK_VA(12)) & ~127u);
          const float vb0 = __uint_as_float(__float_as_uint(top[1][0]) & ~127u), vb1 = __uint_as_float(__float_as_uint(top[1][1]) & ~127u), vb2 = __uint_as_float(__float_as_uint(top[1][2]) & ~127u);
          float e0 = TK_KEY(va1 + vb0, 4 + fq, 0), e1 = TK_KEY(va1 + vb1, 4 + fq, 1), e2 = TK_KEY(va1 + vb2, 4 + fq, 2), e3 = TK_KEY(va2 + vb0, 8 + fq, 0), e4 = TK_KEY(va3 + vb0, 12 + fq, 0);
          CASD(e0, e1); CASD(e3, e4); CASD(e2, e4); CASD(e2, e3); CASD(e0, e3); CASD(e0, e2); CASD(e1, e4); CASD(e1, e3); CASD(e1, e2);
          fin[15] = fmaxf(fin[15], e0); fin[14] = fmaxf(fin[14], e1); fin[13] = fmaxf(fin[13], e2); fin[12] = fmaxf(fin[12], e3); fin[11] = fmaxf(fin[11], e4);
          bmerge16(fin); }
#undef TK_VA
#undef TK_KEY
        xmerge_top16(fin, 16); xmerge_top16(fin, 32);
        float ev[16], es = 0.f; const float mx = __uint_as_float(__float_as_uint(fin[0]) & ~255u);
#pragma unroll
        for (int i = 0; i < 16; ++i) { ev[i] = __expf(__uint_as_float(__float_as_uint(fin[i]) & ~255u) - mx); es += ev[i]; }
        const float inv = 1.f / es;
        asm volatile("s_waitcnt lgkmcnt(0)" ::: "memory");
        int oi[4]; float og[4];
#pragma unroll
        for (int kq = 0; kq < 4; ++kq) {
            const float fk = fq == 0 ? fin[kq] : fq == 1 ? fin[4 + kq] : fq == 2 ? fin[8 + kq] : fin[12 + kq];
            const float fe = fq == 0 ? ev[kq] : fq == 1 ? ev[4 + kq] : fq == 2 ? ev[8 + kq] : ev[12 + kq];
            const unsigned code = 255u - (__float_as_uint(fk) & 255u), a = code >> 4, bq = code & 15u;
            const unsigned i1 = 127u - (scr[a] & 127u), i2 = 127u - (scr[16 + bq] & 127u);
            oi[kq] = (int)(i1 * 128u + i2); og[kq] = fe * inv; }
        *(int4*)(IDX + (size_t)tok * 128 + 16 * h + 4 * fq) = make_int4(oi[0], oi[1], oi[2], oi[3]);
        *(f32x4*)(GATE + (size_t)tok * 128 + 16 * h + 4 * fq) = (f32x4){og[0], og[1], og[2], og[3]};
    }
#undef TK_LOADQ
}
struct PeerSched {
    int x0, rank, nloc, nblk, nown, hblk; unsigned orphan;
    __device__ __forceinline__ void init(const Args& A, int nrows, LAS unsigned char* smem) {
        unsigned* ctl = (unsigned*)(A.ws + WS_CTL);
        x0 = (int)(xb_xcc_id() & 7u); rank = __builtin_amdgcn_readfirstlane((int)((LAS unsigned*)smem)[8]); nblk = nrows / 64;
        unsigned cached = __builtin_amdgcn_readfirstlane(((LAS unsigned*)smem)[9]);
        if (cached == 0u) { unsigned orph = 0u, nl = 1u;
            for (int j = 0; j < 8; ++j) { unsigned c = xb_ld(&ctl[XB_XCNT(j)]) + xb_ld(&ctl[XB_XCNT(j + 8)]); c = __builtin_amdgcn_readfirstlane(c); if (c == 0u) orph |= 1u << j; if (j == x0) nl = c; }
            cached = (nl << 8) | orph; __syncthreads(); if (threadIdx.x == 0) ((LAS unsigned*)smem)[9] = cached; __syncthreads(); }
        nloc = (int)(cached >> 8); orphan = cached & 0xffu;
        const int tot = (NSL / 8) * nblk; nown = rank < tot ? (tot - rank + nloc - 1) / nloc : 0; hblk = -1;
        const int rounds = tot / nloc, rem = tot - rounds * nloc;
        if (NSL == 8 && rem > 0 && 2 * rem <= nloc) { nown = rounds; if (rank < 2 * rem) hblk = rounds * nloc + (rank >> 1); }
    }
    __device__ __forceinline__ bool item(int j, int& sl, int& tb, bool& half) const {
        int blk; half = false;
        if (j < nown) { const int i = rank + j * nloc; sl = x0 + 8 * (i / nblk); blk = i % nblk; tb = blk * 64; return true; }
        if (hblk >= 0 && j == nown) { sl = x0; tb = hblk * 64 + 32 * (rank & 1); half = true; return true; }
        int jj = j - nown - (hblk >= 0 ? 1 : 0); const int tot = (NSL / 8) * nblk, per = ((int)gridDim.x > tot) ? 1 : 0; (void)per;
        for (int o = 0; o < 8; ++o) if ((orphan >> o) & 1u) { const int cnt = ((int)blockIdx.x < tot) ? (tot - (int)blockIdx.x + (int)gridDim.x - 1) / (int)gridDim.x : 0;
            if (jj < cnt) { const int i = (int)blockIdx.x + jj * (int)gridDim.x; sl = o + 8 * (i / nblk); blk = i % nblk; tb = blk * 64; return true; } jj -= cnt; }
        return false;
    }
};
template <class LD, class PR>
__device__ __forceinline__ void peer_items(const PeerSched& S, int wu, LD ld, PR pr) {
    int sl, tb, sln, tbn, j = 0, buf = 0; bool hf, hfn; bool have = S.item(0, sl, tb, hf);
    __syncthreads();
    if (have && !(hf && wu >= 4)) ld(sl, tb, 0);
    while (have) {
        const bool haven = S.item(j + 1, sln, tbn, hfn);
        asm volatile("s_waitcnt vmcnt(0)" ::: "memory");
        if (haven && !(hfn && wu >= 4)) ld(sln, tbn, buf ^ 1);
        if (!(hf && wu >= 4)) pr(sl, tb, buf);
        sl = sln; tb = tbn; hf = hfn; have = haven; buf ^= 1; ++j;
    }
    __syncthreads();
}
#ifndef MK_UVAR
#define MK_UVAR 0
#endif
__device__ __forceinline__ float dpp_sum8(float v) {
    v += __builtin_bit_cast(float, __builtin_amdgcn_mov_dpp(__builtin_bit_cast(int, v), 0xB1, 0xF, 0xF, true));
    v += __builtin_bit_cast(float, __builtin_amdgcn_mov_dpp(__builtin_bit_cast(int, v), 0x4E, 0xF, 0xF, true));
    v += __builtin_bit_cast(float, __builtin_amdgcn_mov_dpp(__builtin_bit_cast(int, v), 0x141, 0xF, 0xF, true));
    return v;
}
__device__ __forceinline__ void phase_peer_u(const Args& A, int layer, int nrows, LAS unsigned char* smem, int rep) {
    const int var = rep ? MK_UVAR : 0;
    const bf16_t* H = (const bf16_t*)(A.ws + WS_H); const int* IDX = (const int*)(A.ws + WS_R2); bf16_t* PART = var ? (bf16_t*)(A.ws + WS_R1) : (bf16_t*)(A.ws + WS_BIG + BIG_PART);
    const unsigned char* U = A.ws + tabset(layer);
    constexpr int PP = 1088, WB = 4 * PP + 2048;
    const int tid = otid(), wid = tid >> 6, lane = tid & 63, m = lane & 7, tk = lane >> 3;
    const int wu = __builtin_amdgcn_readfirstlane(wid);
    LAS unsigned char* lds = smem + LDS_BASE + wu * (2 * WB);
    LAS float* rowc = (LAS float*)(smem + LDS_BASE + 8 * (2 * WB) + wu * 4096) + tk * 128;
    static_assert(8 * (2 * WB) + 8 * 4096 <= LDS_PHASE, "u-phase LDS");
    PeerSched S; S.init(A, nrows, smem);
    peer_items(S, wu,
        [&](int sl, int tb, int buf) {
#pragma unroll
            for (int i = 0; i < 4; ++i)
                __builtin_amdgcn_global_load_lds((const unsigned*)(IDX + ((size_t)tb + 8 * wu + 2 * i) * 128 + 4 * lane), (LAS unsigned*)(lds + buf * WB + PP * i), 16, 0, 0);
#pragma unroll
            for (int i = 0; i < 2; ++i)
                __builtin_amdgcn_global_load_lds((const unsigned*)(H + (size_t)(tb + 8 * wu + 4 * i + (lane >> 4)) * 1024 + SW * sl + 8 * (lane & 15)), (LAS unsigned*)(lds + buf * WB + 4 * PP + 1024 * i), 16, 0, 0); },
        [&](int sl, int tb, int buf) {
            const unsigned char* ub = U + (size_t)sl * NEXP * SW + 16 * m;
            const int tok = tb + wid * 8 + tk;
            const int sw = (tk & 1) * 4;
            const LAS int* ib = (const LAS int*)(lds + buf * WB + (tk >> 1) * PP + (tk & 1) * 512);
            float hf[16];
            { const u32x4 h0 = *(const LAS u32x4*)(lds + buf * WB + 4 * PP + tk * 256 + 32 * m), h1 = *(const LAS u32x4*)(lds + buf * WB + 4 * PP + tk * 256 + 32 * m + 16);
#pragma unroll
              for (int j = 0; j < 4; ++j) { hf[2 * j] = bflo(h0[j]); hf[2 * j + 1] = bfhi(h0[j]); hf[8 + 2 * j] = bflo(h1[j]); hf[8 + 2 * j + 1] = bfhi(h1[j]); } }
            const bool up4 = m >= 4, up2 = (m & 2) != 0, up1 = (m & 1) != 0;
            LAS float* pp = rowc + (m ^ sw);
            u32x4 vv[2][8];
#define PU_ROWS(T, c) do { const i32x4 e0_ = *(const LAS i32x4*)(ib + 8 * (c) + sw), e1_ = *(const LAS i32x4*)(ib + 8 * (c) + (4 - sw)); \
                if (var == 4) { _Pragma("unroll") for (int k_ = 0; k_ < 8; ++k_) vv[T][k_] = (u32x4){(unsigned)e0_.x, (unsigned)e1_.y, 0u, 0u}; } else { \
                vv[T][0] = *(const u32x4*)(ub + (size_t)(var == 3 ? e0_.x & 63 : e0_.x) * SW); vv[T][1] = *(const u32x4*)(ub + (size_t)(var == 3 ? e0_.y & 63 : e0_.y) * SW); \
                vv[T][2] = *(const u32x4*)(ub + (size_t)(var == 3 ? e0_.z & 63 : e0_.z) * SW); vv[T][3] = *(const u32x4*)(ub + (size_t)(var == 3 ? e0_.w & 63 : e0_.w) * SW); \
                vv[T][4] = *(const u32x4*)(ub + (size_t)(var == 3 ? e1_.x & 63 : e1_.x) * SW); vv[T][5] = *(const u32x4*)(ub + (size_t)(var == 3 ? e1_.y & 63 : e1_.y) * SW); \
                vv[T][6] = *(const u32x4*)(ub + (size_t)(var == 3 ? e1_.z & 63 : e1_.z) * SW); vv[T][7] = *(const u32x4*)(ub + (size_t)(var == 3 ? e1_.w & 63 : e1_.w) * SW); } } while (0)
#define PU_DOT(T, c) do { float s_[8]; \
                _Pragma("unroll") for (int k = 0; k < 8; ++k) { f32x2 a2 = {0.f, 0.f}; \
                    _Pragma("unroll") for (int j = 0; j < 4; ++j) { const int w = (int)vv[T][k][j]; \
                        const f32x2 lo = __builtin_amdgcn_cvt_pk_f32_fp8(w, false), hi = __builtin_amdgcn_cvt_pk_f32_fp8(w, true); \
                        a2 = __builtin_elementwise_fma(lo, (f32x2){hf[4 * j], hf[4 * j + 1]}, a2); a2 = __builtin_elementwise_fma(hi, (f32x2){hf[4 * j + 2], hf[4 * j + 3]}, a2); } \
                    s_[k] = a2.x + a2.y; } \
                  \
                float t_[4], u_[2]; \
                _Pragma("unroll") for (int j = 0; j < 4; ++j) { const float give = up4 ? s_[j] : s_[4 + j], keep = up4 ? s_[4 + j] : s_[j]; \
                    t_[j] = keep + __builtin_bit_cast(float, __builtin_amdgcn_mov_dpp(__builtin_bit_cast(int, give), 0x141, 0xF, 0xF, true)); }        \
                _Pragma("unroll") for (int j = 0; j < 2; ++j) { const float give = up2 ? t_[j] : t_[2 + j], keep = up2 ? t_[2 + j] : t_[j]; \
                    u_[j] = keep + __builtin_bit_cast(float, __builtin_amdgcn_mov_dpp(__builtin_bit_cast(int, give), 0x4E, 0xF, 0xF, true)); }         \
                { const float give = up1 ? u_[0] : u_[1], keep = up1 ? u_[1] : u_[0]; \
                  const float tot_ = keep + __builtin_bit_cast(float, __builtin_amdgcn_mov_dpp(__builtin_bit_cast(int, give), 0xB1, 0xF, 0xF, true));           \
                  pp[8 * (c)] = tot_; } } while (0)
            PU_ROWS(0, 0); PU_ROWS(1, 1);
            __builtin_amdgcn_sched_barrier(0);
            PU_DOT(0, 0);
            __builtin_amdgcn_sched_barrier(0);
#pragma unroll 1
            for (int c = 2; c < 16; c += 2) {
                PU_ROWS(0, c);
                __builtin_amdgcn_sched_barrier(0);
                PU_DOT(1, c - 1);
                __builtin_amdgcn_sched_barrier(0);
                PU_ROWS(1, c + 1);
                __builtin_amdgcn_sched_barrier(0);
                PU_DOT(0, c);
                __builtin_amdgcn_sched_barrier(0);
            }
            PU_DOT(1, 15);
#undef PU_ROWS
#undef PU_DOT
            { const LAS f32x4* rd = (const LAS f32x4*)(rowc + 16 * m); const f32x4 a0 = rd[0], a1 = rd[1], a2 = rd[2], a3 = rd[3];
              u32x4 w0, w1; w0.x = cvt_pk_bf16(a0[0], a0[1]); w0.y = cvt_pk_bf16(a0[2], a0[3]); w0.z = cvt_pk_bf16(a1[0], a1[1]); w0.w = cvt_pk_bf16(a1[2], a1[3]);
              w1.x = cvt_pk_bf16(a2[0], a2[1]); w1.y = cvt_pk_bf16(a2[2], a2[3]); w1.z = cvt_pk_bf16(a3[0], a3[1]); w1.w = cvt_pk_bf16(a3[2], a3[3]);
              bf16_t* gp = PART + ((size_t)sl * NROW + tok) * 128 + 16 * m; *(u32x4*)gp = w0; *(u32x4*)(gp + 8) = w1; }
        });
}
__device__ __forceinline__ void phase_coef(const Args& A, int layer, int nrows) {
    const bf16_t* PART = (const bf16_t*)(A.ws + WS_BIG + BIG_PART); const float* GATE = (const float*)(A.ws + WS_R2 + R2_GATE); unsigned* REC = (unsigned*)(A.ws + WS_R2 + R2_COEF);
    const int* IDX = (const int*)(A.ws + WS_R2); const float* SCL = (const float*)(A.ws + tabset(layer) + TAB_SCL);
    const int gthr = blockIdx.x * NTHR + otid(), nthr = gridDim.x * NTHR, np = nrows * 16;
    u32x4 pw[NSL]; i32x4 en[2]; f32x4 gn[2];
#define CF_LOAD(p_) do { const int p__ = (p_); _Pragma("unroll") for (int x = 0; x < NSL; ++x) pw[x] = *(const u32x4*)(PART + (size_t)x * NROW * 128 + 8 * p__); \
        en[0] = *(const i32x4*)(IDX + 8 * p__); en[1] = *(const i32x4*)(IDX + 8 * p__ + 4); gn[0] = *(const f32x4*)(GATE + 8 * p__); gn[1] = *(const f32x4*)(GATE + 8 * p__ + 4); } while (0)
    if (gthr < np) CF_LOAD(gthr);
    for (int p = gthr; p < np; p += nthr) {
        const i32x4 e0 = en[0], e1 = en[1]; const f32x4 g0v = gn[0], g1v = gn[1];
        const f32x4 su0 = {SCL[e0.x], SCL[e0.y], SCL[e0.z], SCL[e0.w]}, sv0 = {SCL[NEXP + e0.x], SCL[NEXP + e0.y], SCL[NEXP + e0.z], SCL[NEXP + e0.w]};
        const f32x4 su1 = {SCL[e1.x], SCL[e1.y], SCL[e1.z], SCL[e1.w]}, sv1 = {SCL[NEXP + e1.x], SCL[NEXP + e1.y], SCL[NEXP + e1.z], SCL[NEXP + e1.w]};
        f32x4 s0 = {0.f, 0.f, 0.f, 0.f}, s1 = {0.f, 0.f, 0.f, 0.f};
#pragma unroll
        for (int x = 0; x < NSL; ++x) { const u32x4 w = pw[x]; s0 += (f32x4){bflo(w.x), bfhi(w.x), bflo(w.y), bfhi(w.y)}; s1 += (f32x4){bflo(w.z), bfhi(w.z), bflo(w.w), bfhi(w.w)}; }
        if (p + nthr < np) CF_LOAD(p + nthr);
#pragma unroll
        for (int hlf = 0; hlf < 2; ++hlf) { const f32x4 sm = hlf ? s1 : s0, su = hlf ? su1 : su0, sv = hlf ? sv1 : sv0, gt = hlf ? g1v : g0v; const i32x4 e = hlf ? e1 : e0;
            const f32x4 a = sm * su; const f32x2 g0 = gelu_pk((f32x2){a[0], a[1]}), g1 = gelu_pk((f32x2){a[2], a[3]});
            const f32x4 cf = gt * (f32x4){g0.x, g0.y, g1.x, g1.y} * sv;
            *(u32x4*)(REC + 8 * p + 4 * hlf) = (u32x4){cvt_pk_bf16(0.f, cf[0]) | (unsigned)e.x, cvt_pk_bf16(0.f, cf[1]) | (unsigned)e.y, cvt_pk_bf16(0.f, cf[2]) | (unsigned)e.z, cvt_pk_bf16(0.f, cf[3]) | (unsigned)e.w}; }
    }
#undef CF_LOAD
}
__device__ __forceinline__ void phase_peer_v(const Args& A, int layer, int nrows, LAS unsigned char* smem, int rep) {
    const int* REC = (const int*)(A.ws + WS_R2 + R2_COEF);
    const unsigned char* V = A.ws + tabset(layer) + TAB8_HALF; const float* MODL = (const float*)(A.ws + WS_MOD) + (size_t)layer * 5 * 6144 + 5 * 1024;
    bf16_t* XB = (bf16_t*)(A.ws + WS_XB);
    constexpr int PP = 1088, WB = 4 * PP;
    const int tid = otid(), wid = tid >> 6, lane = tid & 63, m = lane & 7, tk = lane >> 3;
    const int wu = __builtin_amdgcn_readfirstlane(wid);
    LAS unsigned char* lds = smem + LDS_BASE + wu * (2 * WB);
    LAS float* gl = (LAS float*)(smem + LDS_BASE + 8 * (2 * WB));
    static_assert(8 * (2 * WB) + 5 * 1024 * 4 <= LDS_PHASE, "v-phase LDS");
    for (int i = tid; i < 5 * 256; i += NTHR) *(LAS f32x4*)(gl + 4 * i) = *(const f32x4*)(MODL + (size_t)(i >> 8) * 6144 + 4 * (i & 255));
    PeerSched S; S.init(A, nrows, smem);
    peer_items(S, wu,
        [&](int sl, int tb, int buf) {
#pragma unroll
            for (int i = 0; i < 4; ++i)
                __builtin_amdgcn_global_load_lds((const unsigned*)(REC + ((size_t)tb + 8 * wu + 2 * i) * 128 + 4 * lane), (LAS unsigned*)(lds + buf * WB + PP * i), 16, 0, 0); },
        [&](int sl, int tb, int buf) {
            const unsigned char* vb = V + (size_t)sl * NEXP * SW + 16 * m;
            const int tok = tb + wid * 8 + tk; const bool lat = tok < NLAT;
            const int toff = (tk >> 1) * PP + (tk & 1) * 512, sw = (tk & 1) * 4;
            const LAS int* ib = (const LAS int*)(lds + buf * WB + toff);
            bf16_t* xp = XB + (size_t)tok * D + SW * sl + 16 * m;
            const u32x4 xr0 = *(const u32x4*)xp, xr1 = *(const u32x4*)(xp + 8);
            f32x2 acc2[8];
#pragma unroll
            for (int j = 0; j < 8; ++j) acc2[j] = (f32x2){0.f, 0.f};
            u32x4 vv[2][8];
#define PV_ROWS(T, c) do { const i32x4 e0_ = *(const LAS i32x4*)(ib + 8 * (c) + sw) & 0xffff, e1_ = *(const LAS i32x4*)(ib + 8 * (c) + (4 - sw)) & 0xffff; \
                vv[T][0] = *(const u32x4*)(vb + (size_t)e0_.x * SW); vv[T][1] = *(const u32x4*)(vb + (size_t)e0_.y * SW); vv[T][2] = *(const u32x4*)(vb + (size_t)e0_.z * SW); vv[T][3] = *(const u32x4*)(vb + (size_t)e0_.w * SW); \
                vv[T][4] = *(const u32x4*)(vb + (size_t)e1_.x * SW); vv[T][5] = *(const u32x4*)(vb + (size_t)e1_.y * SW); vv[T][6] = *(const u32x4*)(vb + (size_t)e1_.z * SW); vv[T][7] = *(const u32x4*)(vb + (size_t)e1_.w * SW); } while (0)
#define PV_FMA(T, c) do { const i32x4 r0_ = *(const LAS i32x4*)(ib + 8 * (c) + sw) & (int)0xffff0000, r1_ = *(const LAS i32x4*)(ib + 8 * (c) + (4 - sw)) & (int)0xffff0000; \
                const f32x4 c0_ = __builtin_bit_cast(f32x4, r0_), c1_ = __builtin_bit_cast(f32x4, r1_); \
                _Pragma("unroll") for (int k = 0; k < 8; ++k) { const float cf = k < 4 ? c0_[k & 3] : c1_[k & 3]; \
                    _Pragma("unroll") for (int j = 0; j < 4; ++j) { const int w = (int)vv[T][k][j]; \
                        const f32x2 lo = __builtin_amdgcn_cvt_pk_f32_fp8(w, false), hi = __builtin_amdgcn_cvt_pk_f32_fp8(w, true); const f32x2 c2 = {cf, cf}; \
                        acc2[2 * j] = __builtin_elementwise_fma(lo, c2, acc2[2 * j]); acc2[2 * j + 1] = __builtin_elementwise_fma(hi, c2, acc2[2 * j + 1]); } } } while (0)
            PV_ROWS(0, 0); PV_ROWS(1, 1);
            __builtin_amdgcn_sched_barrier(0);
            PV_FMA(0, 0);
            __builtin_amdgcn_sched_barrier(0);
#pragma unroll 1
            for (int c = 2; c < 16; c += 2) {
                PV_ROWS(0, c);
                __builtin_amdgcn_sched_barrier(0);
                PV_FMA(1, c - 1);
                __builtin_amdgcn_sched_barrier(0);
                PV_ROWS(1, c + 1);
                __builtin_amdgcn_sched_barrier(0);
                PV_FMA(0, c);
                __builtin_amdgcn_sched_barrier(0);
            }
            PV_FMA(1, 15);
#undef PV_ROWS
#undef PV_FMA
            const LAS float* gp = gl + (lat ? (tok >> 13) : 4) * 1024 + SW * sl + 16 * m;
            unsigned ow[8];
#pragma unroll
            for (int j = 0; j < 4; ++j) { const f32x4 g = *(const LAS f32x4*)(gp + 4 * j); const unsigned w0 = j == 0 ? xr0.x : j == 1 ? xr0.z : j == 2 ? xr1.x : xr1.z, w1 = j == 0 ? xr0.y : j == 1 ? xr0.w : j == 2 ? xr1.y : xr1.w;
                const f32x4 o = (f32x4){bflo(w0), bfhi(w0), bflo(w1), bfhi(w1)} + g * (f32x4){acc2[2 * j].x, acc2[2 * j].y, acc2[2 * j + 1].x, acc2[2 * j + 1].y};
                ow[2 * j] = cvt_pk_bf16(o[0], o[1]); ow[2 * j + 1] = cvt_pk_bf16(o[2], o[3]); }
            *(u32x4*)xp = (u32x4){ow[0], ow[1], ow[2], ow[3]}; *(u32x4*)(xp + 8) = (u32x4){ow[4], ow[5], ow[6], ow[7]};
        });
}

#ifdef MK_CHECK
constexpr int CW_CHK = 3840;
__device__ __forceinline__ float blk_sum(float v, LAS float* red) {
    const int t_ = otid(); v = wave_sum(v); __syncthreads(); if ((t_ & 63) == 0) red[t_ >> 6] = v; __syncthreads();
    float s = 0.f; for (int i = 0; i < 8; ++i) s += red[i]; __syncthreads(); return s;
}
__device__ __forceinline__ float fp8f(unsigned b) { const unsigned e = (b >> 3) & 15u, m = b & 7u; const float v = e ? ldexpf(1.f + (float)m * 0.125f, (int)e - 7) : ldexpf((float)m * 0.125f, -6); return (b & 0x80u) ? -v : v; }
__device__ __forceinline__ void check_attn(const Args& A, LAS unsigned char* lds, bool with_ctx) {
    const unsigned char* Q = A.ws + WS_R1 + R1_Q; const unsigned char* KN = A.ws + WS_R1 + R1_KN; const unsigned char* KR = A.ws + WS_BIG + BIG_KR; const unsigned char* V = A.ws + WS_R1 + R1_V;
    const bf16_t* CAT = (const bf16_t*)(A.ws + WS_R3 + R3_CAT); float* chk = (float*)(A.ws + WS_CTL) + CW_CHK;
    LAS float* p = (LAS float*)lds; LAS float* qv = p + NKEY; LAS float* red = qv + 192;
    const int tid = otid();
    for (int au = blockIdx.x; au < (with_ctx ? 1056 : 1024); au += gridDim.x) {
        int b, h, qrow, orow, nkey;
        if (au < 1024) { b = au >> 8; h = au & 7; const int qb = (au >> 3) & 31, l = 256 * qb + (int)((((unsigned)au * 2654435761u) >> 20) & 255u); qrow = 256 + l; orow = b * 8192 + l; nkey = NKEY; }
        else { const int cu = au - 1024; b = cu >> 3; h = cu & 7; const int lc = (int)((((unsigned)au * 2654435761u) >> 20) & 255u); qrow = lc; orow = NLAT + 256 * b + lc; nkey = 256; }
        const size_t bh = (size_t)(b * 8 + h);
        __syncthreads();
        if (tid < 192) qv[tid] = fp8f(Q[(bh * NKEY + qrow) * 192 + tid]) * (1.f / att8::QUP);
        __syncthreads();
        float mx = -1e30f;
        for (int key = tid; key < nkey; key += 512) { const int t = key >> 6, k = key & 63; float sacc = 0.f;
            for (int d = 0; d < 128; ++d) sacc += qv[d] * fp8f(KN[(bh * NKT + t) * 8192 + att8::kn8(k, d)]);
            for (int d = 0; d < 64; ++d) sacc += qv[128 + d] * fp8f(KR[((size_t)b * NKT + t) * 4096 + att8::kr8(k, d)]);
            p[key] = sacc; mx = fmaxf(mx, sacc); }
        for (int o = 32; o >= 1; o >>= 1) mx = fmaxf(mx, __shfl_xor(mx, o));
        __syncthreads(); if ((tid & 63) == 0) red[tid >> 6] = mx; __syncthreads(); mx = red[0]; for (int i = 1; i < 8; ++i) mx = fmaxf(mx, red[i]); __syncthreads();
        float ls = 0.f; for (int key = tid; key < nkey; key += 512) { const float e = exp2f(p[key] - mx); p[key] = e; ls += e; }
        ls = blk_sum(ls, red);
        float num = 0.f, den = 0.f;
        if (tid < 128) { float o = 0.f; for (int key = 0; key < nkey; ++key) o += p[key] * fp8f(V[(bh * NKT + (key >> 6)) * 8192 + att8::v8(tid, key & 63)]);
            o /= ls; const float got = bf2f(CAT[(size_t)orow * 2048 + 1024 + 128 * h + tid]); num = (got - o) * (got - o); den = o * o; }
        num = blk_sum(num, red); den = blk_sum(den, red);
        if (tid == 0) { atomicAdd(chk, num); atomicAdd(chk + 1, den); }
    }
}
__device__ __forceinline__ void check_qkv(const Args& A, int li, LAS unsigned char* lds) {
    float* chk = (float*)(A.ws + WS_CTL) + CW_CHK;
    const unsigned char* Q = A.ws + WS_R1 + R1_Q; const unsigned char* KN = A.ws + WS_R1 + R1_KN; const unsigned char* KR = A.ws + WS_BIG + BIG_KR; const unsigned char* V = A.ws + WS_R1 + R1_V;
    LAS float* hv = (LAS float*)lds; LAS float* cq = hv + 1024; LAS float* ckv = cq + 384; LAS float* kr = ckv + 256; LAS float* red = kr + 64; LAS float* ov = red + 16;
    const int tid = otid(), sidx = blockIdx.x;
    const int hd = sidx & 7; const int r = (sidx & 8) ? NLAT + (int)(((unsigned)sidx * 2654435761u) >> 22) : (int)(((unsigned)sidx * 2654435761u) >> 17);
    const float* win = A.in[I_HWIN] + (size_t)li * 1024 * HYB_IN;
    {
        const bf16_t* xp = (const bf16_t*)(A.ws + WS_XB) + (size_t)r * D; const float* MODL = (const float*)(A.ws + WS_MOD) + (size_t)(2 * li) * 5 * 6144 + (size_t)row_mb(r) * 6144;
        float ss = 0.f; for (int i = tid; i < 1024; i += 512) ss += bf2f(xp[i]) * bf2f(xp[i]);
        ss = blk_sum(ss, red); const float rstd = rsqrtf(ss / 1024.f + EPS);
        for (int i = tid; i < 1024; i += 512) hv[i] = bf2f(f2bf(bf2f(xp[i]) * rstd * A.in[I_N1G][(2 * li) * 1024 + i] * (1.f + MODL[1024 + i]) + MODL[i])); }
    __syncthreads();
    for (int j = tid; j < 704; j += 512) { float s = 0.f; for (int k = 0; k < 1024; ++k) s += hv[k] * win[(size_t)k * HYB_IN + C_CQ + j];
        s = bf2f(f2bf(s)); if (j < 384) cq[j] = s; else if (j < 640) ckv[j - 384] = s; else kr[j - 640] = s; }
    __syncthreads();
    float sq = 0.f, sk = 0.f; for (int j = tid; j < 384; j += 512) sq += cq[j] * cq[j]; for (int j = tid; j < 256; j += 512) sk += ckv[j] * ckv[j];
    sq = blk_sum(sq, red); sk = blk_sum(sk, red);
    const float rq = rsqrtf(sq / 384.f + EPS), rk = rsqrtf(sk / 256.f + EPS);
    const float* wqb = A.in[I_WQB] + (size_t)li * 384 * 1536; const float* wkvb = A.in[I_WKVB] + (size_t)li * 256 * 2048; const float* qg = A.in[I_QNG] + li * 384; const float* kg = A.in[I_KVNG] + li * 256;
    if (tid < 192) { float s = 0.f; for (int k = 0; k < 384; ++k) s += cq[k] * rq * qg[k] * wqb[(size_t)k * 1536 + hd * 192 + tid]; ov[tid] = s; }
    else if (tid < 448) { const int c = tid - 192; float s = 0.f; for (int k = 0; k < 256; ++k) s += ckv[k] * rk * kg[k] * wkvb[(size_t)k * 2048 + hd * 256 + c]; ov[tid] = s; }
    __syncthreads();
    const bool lat = r < NLAT; const int b = lat ? (r >> 13) : ((r - NLAT) >> 8), l = lat ? (r & 8191) : 0, key = lat ? 256 + l : ((r - NLAT) & 255), qrow = key;
    const size_t bh = (size_t)(b * 8 + hd); const float qs = QSCALE * att8::QUP;
    float num = 0.f, den = 0.f;
    if (tid < 128) {
        const float q = ov[tid] * qs, gq = fp8f(Q[(bh * NKEY + qrow) * 192 + tid]);
        const float kk = ov[192 + tid], gk = fp8f(KN[(bh * NKT + (key >> 6)) * 8192 + att8::kn8(key & 63, tid)]);
        const float vv = ov[320 + tid], gv = fp8f(V[(bh * NKT + (key >> 6)) * 8192 + att8::v8(tid, key & 63)]);
        num = (gq - q) * (gq - q) + (gk - kk) * (gk - kk) + (gv - vv) * (gv - vv); den = q * q + kk * kk + vv * vv;
    } else if (tid < 160) {
        const int i = tid - 128; float c = 1.f, sn = 0.f;
        if (lat) { const float pos = (float)(i < 16 ? (l >> 6) : (l & 63)); const float ang = pos * powf(10000.f, -(float)(i & 15) / 16.f); c = cosf(ang); sn = sinf(ang); }
        const float q1 = ov[128 + i] * qs, q2 = ov[160 + i] * qs, k1 = kr[i], k2 = kr[32 + i];
        const float rq1 = q1 * c - q2 * sn, rq2 = q1 * sn + q2 * c, rk1 = k1 * c - k2 * sn, rk2 = k1 * sn + k2 * c;
        const float gq1 = fp8f(Q[(bh * NKEY + qrow) * 192 + 128 + 2 * i]), gq2 = fp8f(Q[(bh * NKEY + qrow) * 192 + 128 + 2 * i + 1]);
        const float gk1 = fp8f(KR[((size_t)b * NKT + (key >> 6)) * 4096 + att8::kr8(key & 63, 2 * i)]), gk2 = fp8f(KR[((size_t)b * NKT + (key >> 6)) * 4096 + att8::kr8(key & 63, 2 * i + 1)]);
        num = (gq1 - rq1) * (gq1 - rq1) + (gq2 - rq2) * (gq2 - rq2) + (gk1 - rk1) * (gk1 - rk1) + (gk2 - rk2) * (gk2 - rk2); den = rq1 * rq1 + rq2 * rq2 + rk1 * rk1 + rk2 * rk2;
    }
    num = blk_sum(num, red); den = blk_sum(den, red);
    if (tid == 0) { atomicAdd(chk, num); atomicAdd(chk + 1, den); }
}
__device__ __forceinline__ void check_topk(const Args& A, int layer, LAS unsigned char* lds) {
    const bf16_t* QP = (const bf16_t*)(A.ws + WS_BIG); const int* IDX = (const int*)(A.ws + WS_R2); const float* GATE = (const float*)(A.ws + WS_R2 + R2_GATE); float* chk = (float*)(A.ws + WS_CTL) + CW_CHK;
    const bf16_t* K1 = (const bf16_t*)(A.ws + WS_W + W_PEER + (size_t)layer * WP_SZ + WP_K1);
    LAS float* sc = (LAS float*)lds; LAS float* v12 = sc + 256; LAS int* i12 = (LAS int*)(v12 + 32); LAS float* cs = (LAS float*)(i12 + 32); LAS float* ts = cs + 256; LAS int* ti = (LAS int*)(ts + 16); LAS float* red = (LAS float*)(ti + 16);
    const int tid = otid();
    for (int smp = blockIdx.x; smp < 1024; smp += gridDim.x) {
        const int h = smp & 7, tok = (int)((((unsigned)smp * 2654435761u) >> 12) % (unsigned)NROW);
        __syncthreads();
        if (tid < 256) { const int half = tid >> 7, key = tid & 127; float a = 0.f;
            for (int d = 0; d < 128; ++d) a += bf2f(QP[(size_t)tok * 2048 + 256 * h + 128 * half + d]) * bf2f(K1[((size_t)half * 8 + h) * 16384 + key * 128 + d]);
            sc[tid] = a; }
        __syncthreads();
        if (tid < 256) { const int half = tid >> 7, key = tid & 127; const float v = sc[tid]; int rank = 0;
            for (int j = 0; j < 128; ++j) { const float o = sc[half * 128 + j]; rank += (o > v || (o == v && j < key)) ? 1 : 0; }
            if (rank < 16) { v12[half * 16 + rank] = v; i12[half * 16 + rank] = key; } }
        __syncthreads();
        if (tid < 256) cs[tid] = v12[tid >> 4] + v12[16 + (tid & 15)];
        __syncthreads();
        if (tid < 256) { const float v = cs[tid]; int rank = 0;
            for (int j = 0; j < 256; ++j) { const float o = cs[j]; rank += (o > v || (o == v && j < tid)) ? 1 : 0; }
            if (rank < 16) { ts[rank] = v; ti[rank] = i12[tid >> 4] * 128 + i12[16 + (tid & 15)]; } }
        __syncthreads();
        float num = 0.f, den = 0.f;
        if (tid < 16) { float es = 0.f; for (int j = 0; j < 16; ++j) es += __expf(ts[j] - ts[0]); const float gn = __expf(ts[tid] - ts[0]) / es; float gk = 0.f;
            for (int j = 0; j < 16; ++j) if (IDX[(size_t)tok * 128 + 16 * h + j] == ti[tid]) gk = GATE[(size_t)tok * 128 + 16 * h + j];
            num = (gk - gn) * (gk - gn); den = gn * gn; }
        num = blk_sum(num, red); den = blk_sum(den, red);
        if (tid == 0) { atomicAdd(chk, num); atomicAdd(chk + 1, den); }
    }
}
__device__ __forceinline__ void check_ssd(const Args& A, int li, LAS unsigned char* lds) {
    const bf16_t* XS = (const bf16_t*)(A.ws + WS_R2); const bf16_t* BC = (const bf16_t*)(A.ws + WS_R2 + R2_BC); const float* DT = (const float*)(A.ws + WS_BIG + BIG_DT);
    const bf16_t* Y0 = (const bf16_t*)(A.ws + WS_H); const bf16_t* Y1 = (const bf16_t*)(A.ws + WS_R3); float* chk = (float*)(A.ws + WS_CTL) + CW_CHK;
    LAS float* red = (LAS float*)lds;
    const int tid = otid(), sidx = blockIdx.x;
    const int b = sidx & 3, d = (sidx >> 2) & 1, h = (sidx >> 3) & 15, p = (int)((((unsigned)sidx * 2654435761u) >> 20) & 63u), g = h >> 3;
    const float a = -__expf(A.in[I_ALOG][li * 32 + d * 16 + h]);
    const bf16_t* Y = d ? Y1 : Y0;
    float hst = 0.f, num = 0.f, den = 0.f;
    for (int step = 0; step < 8448; ++step) {
        int r;
        if (step < 256) r = NLAT + b * 256 + (d ? 255 - step : step); else { const int q = step - 256; r = b * 8192 + (d ? 8191 - q : q); }
        const float dt = DT[(size_t)(d * 16 + h) * NROW + r], x = bf2f(XS[(size_t)r * 1024 + 64 * h + p]);
        float contrib = 0.f;
        if (tid < 128) { hst = __expf(dt * a) * hst + dt * x * bf2f(BC[(size_t)r * 512 + 128 * g + tid]); contrib = hst * bf2f(BC[(size_t)r * 512 + 256 + 128 * g + tid]); }
        if (step % 61 == 0) { const float y = blk_sum(contrib, red); const float got = bf2f(Y[(size_t)r * 1024 + 64 * h + p]); if (tid == 0) { num += (got - y) * (got - y); den += y * y; } }
    }
    if (tid == 0) { atomicAdd(chk, num); atomicAdd(chk + 1, den); }
}
#endif
#ifndef MK_PER_PHASE
#define MK_PER_PHASE 0
#endif
__device__ __forceinline__ int nr_in(int L) { return L <= 2 ? NROW : NLAT; }
__device__ __forceinline__ int nr_out(int L) { return L <= 1 ? NROW : NLAT; }

__global__ void __launch_bounds__(NTHR, 2) fwd(Args A) {
    extern __shared__ __attribute__((aligned(256))) unsigned char smem_raw[];
    LAS unsigned char* smem = (LAS unsigned char*)smem_raw;
    LAS unsigned char* lds = smem + LDS_BASE;
    const int tid = otid();
    if (tid < 64) ((LAS unsigned*)smem)[tid] = 0u;
    __syncthreads();
    XcdBarrier bar = xcd_barrier_post((unsigned*)(A.ws + WS_CTL), (volatile LAS unsigned*)smem);
    if (tid == 0) ((LAS unsigned*)smem)[8] = atomicAdd((unsigned*)(A.ws + WS_CTL) + CW_RANK + 32 * (xb_xcc_id() & 7u), 1u);
    __syncthreads();
    bool need_bar = false;
    const int lo = A.ph_lo, hi = A.ph_hi;
#ifndef PHMASK
#define PHMASK 0xffffffffu
#endif
#define SITE(k) if constexpr (((PHMASK) >> (k)) & 1u)
#ifndef MK_SVAR
#define MK_SVAR 1
#endif
#ifndef MK_REPEAT_SITE
#define MK_REPEAT_SITE -1
#endif
#define REP(k) for (int rep = 0; rep < ((k) == (MK_REPEAT_SITE) ? 2 : 1); ++rep)
#define PH(id) if ([&]() -> bool { if ((id) < lo || (id) >= hi) return false; if (need_bar) xcd_barrier(bar); need_bar = true; return true; }())
    unsigned char* ws = A.ws;
#define TAIL_TAB(units, layer, rlo, rhi) do { const int nx_ = (units) % 256; if (gridDim.x == 256 && (int)blockIdx.x >= nx_) phase_tabcvt(A, layer, (int)blockIdx.x - nx_, 256 - nx_, rlo, rhi); } while (0)
    bf16_t* XB = (bf16_t*)(ws + WS_XB);
    bf16_t* H = (bf16_t*)(ws + WS_H);
    const float* MOD = (const float*)(ws + WS_MOD);

    SITE(0) PH(0) { phase_prologue(A, lds); }
    SITE(1) PH(1) { phase_norm_mod<true>(A.in[I_X], A.in[I_CTX], XB, A.in[I_N1G], MOD, 0, H, NROW); }
    for (int L = 0; L < DEPTH; ++L) {
        const int base = 2 + 16 * L, li = L >> 1; const bool hyb = (L & 1) == 0;
        const float* MODL = MOD + (size_t)L * 5 * 6144;
        unsigned char* WH = ws + WS_W + W_HYB + (size_t)li * WH_SZ; unsigned char* WG = ws + WS_W + W_GM + (size_t)li * WG_SZ; unsigned char* WP = ws + WS_W + W_PEER + (size_t)L * WP_SZ;
        if (hyb) {
            SITE(2) PH(base + 0) REP(2) { pg8::Gemm g{H, (const bf16_t*)(WH + WH_IN), nr_in(L), HYB_INP, 1024, 1024, 1024};
                pg8::EpiBf16<0> e{(bf16_t*)(ws + WS_BIG), HYB_INP}; pg8::gemm_phase(lds, g, e);
                if (rep == 0 && L == 0) TAIL_TAB((nr_in(L) / 256) * 13, 0, 0, NEXP / 2); else if (rep == 0 && L == 2) TAIL_TAB((nr_in(L) / 256) * 13, 3, 0, NEXP / 2); }
            SITE(3) PH(base + 1) REP(3) { phase_conv(A, li, rep); }
            SITE(4) PH(base + 2) {
                SITE(18) REP(18) { pg8::Gemm g{(const bf16_t*)(ws + WS_BIG) + C_CQ, (const bf16_t*)(WH + WH_QB), L == 0 ? NROW : NLAT, 1536, 384, HYB_INP, 384};
                  EpiQ e{ws + WS_R1 + R1_Q, (const float*)(ws + WS_RSTD), (const float*)(ws + WS_ROPE)}; pg8::gemm_phase(lds, g, e); }
                SITE(19) REP(19) { pg8::Gemm g{(const bf16_t*)(ws + WS_BIG) + C_CKV, (const bf16_t*)(WH + WH_KVB), NROW, 2048, 256, HYB_INP, 256, 64};
                  EpiKV e{ws + WS_R1 + R1_KN, ws + WS_R1 + R1_V, (const float*)(ws + WS_RSTD) + NROW}; pg8::gemm_phase(lds, g, e); }
                SITE(20) REP(20) for (int u = (int)((blockIdx.x + gridDim.x - 128u % gridDim.x) % gridDim.x); u < 528; u += gridDim.x) ssd::g_unit((const bf16_t*)(ws + WS_R2 + R2_BC), (bf16_t*)(ws + WS_BIG + BIG_G), u);
            }
            SITE(5) PH(base + 3) {
                const int xq = (int)blockIdx.x & 7, jq = (int)blockIdx.x >> 3; const bool ssd_wg = (jq & 1) == 0 && gridDim.x == 256;
                if (gridDim.x == 256) {
                    if (ssd_wg) { const int r = jq >> 1, gi = xq + 8 * (r >> 3), hh = r & 7, sb = gi >> 2, sgp = (gi >> 1) & 1, sd = gi & 1;
                        SITE(21) ssd::ssd_unit(sb, 8 * sgp + hh, sd, (const bf16_t*)(ws + WS_R2), (const bf16_t*)(ws + WS_R2 + R2_BC), (const float*)(ws + WS_BIG + BIG_DT), (const bf16_t*)(ws + WS_BIG + BIG_G),
                                               A.in[I_ALOG] + li * 32, sd ? (bf16_t*)(ws + WS_R3) : (bf16_t*)(ws + WS_H), lds); }
                } else {
                    SITE(21) for (int u = blockIdx.x; u < 128; u += gridDim.x) ssd::ssd_unit(u >> 5, (u >> 1) & 15, u & 1, (const bf16_t*)(ws + WS_R2), (const bf16_t*)(ws + WS_R2 + R2_BC), (const float*)(ws + WS_BIG + BIG_DT),
                                               (const bf16_t*)(ws + WS_BIG + BIG_G), A.in[I_ALOG] + li * 32, (u & 1) ? (bf16_t*)(ws + WS_R3) : (bf16_t*)(ws + WS_H), lds);
                }
                const int nmine = __builtin_amdgcn_readfirstlane(gridDim.x == 256 ? (ssd_wg ? 3 : 5) + (L == 0 && !ssd_wg && jq < 8 ? 1 : 0) : 0);
                SITE(22) REP(22) for (int it = 0; gridDim.x == 256 ? it < nmine : (int)blockIdx.x + it * (int)gridDim.x < (L == 0 ? 1056 : 1024); ++it) {
                    int b, h, qrow0, orow0, nt;
                    if (gridDim.x == 256) {
                        const int base_it = ssd_wg ? 3 : 5;
                        if (it < base_it) { const int v = ssd_wg ? 3 * (jq >> 1) + it : 48 + 5 * (jq >> 1) + it; b = v >> 5; h = xq; const int qb = v & 31; qrow0 = 256 + 256 * qb; orow0 = b * 8192 + 256 * qb; nt = NKT; }
                        else { b = jq >> 1; h = xq; qrow0 = 0; orow0 = NLAT + 256 * b; nt = 4; }
                    } else { const int au = (int)blockIdx.x + it * (int)gridDim.x;
                        if (au < 1024) { b = au >> 8; h = au & 7; const int qb = (au >> 3) & 31; qrow0 = 256 + 256 * qb; orow0 = b * 8192 + 256 * qb; nt = NKT; }
                        else { const int cu = au - 1024; b = cu >> 3; h = cu & 7; qrow0 = 0; orow0 = NLAT + 256 * b; nt = 4; } }
                    const size_t bh = (size_t)(b * 8 + h);
                    att8::attn_unit(ws + WS_R1 + R1_Q + (bh * NKEY + qrow0) * 192, ws + WS_R1 + R1_KN + bh * NKT * 8192, ws + WS_BIG + BIG_KR + (size_t)b * NKT * 4096,
                                    ws + WS_R1 + R1_V + bh * NKT * 8192, (bf16_t*)(ws + WS_R3 + R3_CAT) + (size_t)orow0 * 2048 + 1024 + 128 * h, nt, lds);
                }
                if (gridDim.x == 256 && !ssd_wg && L == 2) SITE(11) phase_tabcvt(A, 3, xq + 8 * (jq >> 1), 128, NEXP / 2, NEXP);
            }
            SITE(6) PH(base + 4) REP(6) { phase_ssd_out(A, li, nr_out(L));
#if defined(MK_CHECK) && MK_CHECK == 1
                if (L == 0) check_attn(A, lds, true);
#elif defined(MK_CHECK) && MK_CHECK == 2
                if (L == 0) check_qkv(A, li, lds);
#elif defined(MK_CHECK) && MK_CHECK == 3
                if (L == 2) check_attn(A, lds, false);
#elif defined(MK_CHECK) && MK_CHECK == 5
                if (L == 0) check_ssd(A, li, lds);
#elif defined(MK_CHECK) && MK_CHECK == 6
                if (L == 2) check_ssd(A, li, lds);
#endif
            }
        } else {
            SITE(7) PH(base + 0) REP(7) { pg8::Gemm g{H, (const bf16_t*)(WG + WG_IN), nr_out(L), 4096, 1024, 1024, 1024};
                pg8::EpiGmIn e{(bf16_t*)(ws + WS_BIG), (float*)(ws + WS_R3)}; pg8::gemm_phase(lds, g, e);
                if (rep == 0 && L == 1) TAIL_TAB((nr_out(L) / 256) * 16, 1, NEXP, 2 * NEXP); }
            SITE(9) PH(base + 2) REP(9) { phase_spatial(A, li, nr_out(L), lds); }
        }
        SITE(10) PH(base + 5) { pg8::Gemm g{hyb ? (const bf16_t*)(ws + WS_R3 + R3_CAT) : (const bf16_t*)(ws + WS_R1), hyb ? (const bf16_t*)(WH + WH_OUT) : (const bf16_t*)(WG + WG_OUT), nr_out(L), 1024, 2048, 2048, 2048};
            pg8::EpiResid e{XB, MODL + 2 * 1024}; pg8::gemm_phase(lds, g, e);
            if (L == 0) TAIL_TAB((nr_out(L) / 256) * 4, 0, NEXP / 2, 2 * NEXP); else if (L == 1) TAIL_TAB((nr_out(L) / 256) * 4, 2, 0, 2 * NEXP); }
        SITE(11) PH(base + 6) REP(11) { phase_norm_mod<false>(nullptr, nullptr, XB, A.in[I_N2G] + L * 1024, MODL, 3, H, nr_out(L));
            if (gridDim.x != 256) phase_tabcvt(A, L, (int)blockIdx.x, (int)gridDim.x);
            else if (L == 3) phase_tabcvt(A, 3, (int)blockIdx.x, 256, NEXP, 2 * NEXP); }
        SITE(12) PH(base + 7) REP(12) { pg8::Gemm g{H, (const bf16_t*)(WP + WP_Q), nr_out(L), 2048, 1024, 1024, 1024};
            pg8::EpiBf16<0> e{(bf16_t*)(ws + WS_BIG), 2048}; pg8::gemm_phase(lds, g, e);
            if (rep == 0 && L == 0) TAIL_TAB((nr_out(L) / 256) * 8, 1, 0, NEXP); }
        SITE(13) PH(base + 8) REP(13) { phase_topk(A, L, nr_out(L), lds); }
        SITE(14) PH(base + 9) REP(14) { phase_peer_u(A, L, nr_out(L), smem, rep); }
        SITE(15) PH(base + 10) REP(15) { phase_coef(A, L, nr_out(L));
#if defined(MK_CHECK) && MK_CHECK == 4
            if (L == 1) check_topk(A, L, lds);
#endif
        }
        SITE(16) PH(base + 11) { phase_peer_v(A, L, nr_out(L), smem, 0); }
        SITE(17) PH(base + 12) { if (L < DEPTH - 1) phase_norm_mod<false>(nullptr, nullptr, XB, A.in[I_N1G] + (L + 1) * 1024, MOD + (size_t)(L + 1) * 5 * 6144, 0, H, nr_in(L + 1));
                        else {
#ifdef MK_CHECK
                            const float* chk = (const float*)(ws + WS_CTL) + CW_CHK; const float err = sqrtf(chk[0] / fmaxf(chk[1], 1e-30f));
                            phase_final_norm(XB, A.out, A.in[I_FNG], 1.f + 10.f * err);
#else
                            phase_final_norm(XB, A.out, A.in[I_FNG], 1.f);
#endif
                        } }
    }
#undef PH
}

#ifdef MK_TAP
__global__ void tap_kernel(const unsigned short* buf, size_t pitch, size_t col0, size_t ncols, size_t nrows, float* out) {
    const size_t n = ncols * nrows;
    for (size_t i = (size_t)blockIdx.x * blockDim.x + threadIdx.x; i < (size_t)NLAT * D; i += (size_t)gridDim.x * blockDim.x) {
        float s = 0.f; for (size_t j = i; j < n; j += (size_t)NLAT * D) s += (float)buf[(j / ncols) * pitch + col0 + (j % ncols)]; out[i] = s; }
}
#endif
extern "C" void kernel_launch(void* const* d_in, const int* in_sizes, int n_in, void* d_out, int out_size, void* d_ws, size_t ws_size, hipStream_t stream) {
    static int grid = 0;
    if (grid == 0) {
        if (n_in != N_IN || out_size != NLAT * D || ws_size < WS_END) { fprintf(stderr, "kernel_launch: unexpected shapes (n_in %d out %d ws %zu, need %zu)\n", n_in, out_size, ws_size, (size_t)WS_END); grid = -1; return; }
        int dev = 0, cus = 0, per_cu = 0;
        if (hipGetDevice(&dev) != hipSuccess || hipDeviceGetAttribute(&cus, hipDeviceAttributeMultiprocessorCount, dev) != hipSuccess) { grid = -1; return; }
        if (hipFuncSetAttribute((const void*)fwd, hipFuncAttributeMaxDynamicSharedMemorySize, LDS_BYTES) != hipSuccess) { fprintf(stderr, "kernel_launch: hipFuncSetAttribute failed\n"); grid = -1; return; }
        if (hipOccupancyMaxActiveBlocksPerMultiprocessor(&per_cu, (const void*)fwd, NTHR, LDS_BYTES) != hipSuccess || per_cu < 1) { fprintf(stderr, "kernel_launch: occupancy query says %d\n", per_cu); }
        (void)hipGetLastError();
        grid = cus;
    }
    if (grid < 0) return;
    (void)hipMemsetAsync((char*)d_ws + WS_CTL, 0, CTL_BYTES, stream);
    Args a{};
    for (int i = 0; i < N_IN; ++i) a.in[i] = (const float*)d_in[i];
    a.out = (float*)d_out; a.ws = (unsigned char*)d_ws;
#if MK_PER_PHASE
    for (int id = 0; id < 2 + 16 * DEPTH; ++id) {
        if (id >= 2) { const int L = (id - 2) / 16, s = (id - 2) % 16; if (s > 12) continue; if ((L & 1) && (s == 3 || s == 4)) continue; }
#ifdef MK_CUT
#ifdef MK_TAP
        if (id >= MK_CUT) continue;
#else
        if (id >= MK_CUT && id != 2 + 16 * (DEPTH - 1) + 12) continue;
#endif
#endif
        a.ph_lo = id; a.ph_hi = id + 1;
        hipLaunchKernelGGL(fwd, dim3(grid), dim3(NTHR), LDS_BYTES, stream, a);
    }
#ifdef MK_TAP
    { const size_t tp[5] = {MK_TAP}; hipLaunchKernelGGL(tap_kernel, dim3(2048), dim3(256), 0, stream, (const unsigned short*)((const char*)d_ws + tp[0]), tp[1], tp[2], tp[3], tp[4], (float*)d_out); }
#endif
#else
    a.ph_lo = 0; a.ph_hi = 2 + 16 * DEPTH;
    hipLaunchKernelGGL(fwd, dim3(grid), dim3(NTHR), LDS_BYTES, stream, a);
#endif
    const hipError_t le = hipPeekAtLastError();
    if (le != hipSuccess) fprintf(stderr, "kernel_launch: launch failed: %s\n", hipGetErrorName(le));
}
```
